# Optimizing an MI355X kernel written in HIP

```python
import jax
import jax.numpy as jnp
from jax import lax
import numpy as np


D_MODEL = 1024
BATCH = 4
SEQ = 4096
DEPTH = 1

MEM_LEN = 256
MIX_W = D_MODEL
LRU_W = MIX_W // 2
RWKV_W = MIX_W - LRU_W
LRU_BLOCKS = 8
LRU_BLOCK = LRU_W // LRU_BLOCKS
CONV_W = 4
LRU_C = 8.0
RWKV_HEAD = 64
RWKV_HEADS = RWKV_W // RWKV_HEAD
DECAY_LORA = 64
AAA_LORA = 64
GATE_LORA = 128
RWKV_IN = 3 * RWKV_W + DECAY_LORA + AAA_LORA + GATE_LORA
IN_W = 2 * LRU_W + RWKV_IN
XA_HEADS = 4
XA_HEAD = D_MODEL // XA_HEADS
N_EXPERTS = 32
TOP_K = 4
D_FF = D_MODEL
SWIGLU_LIMIT = 7.0
SWIGLU_ALPHA = 1.702
MOE_BLOCK = 256
EPS = 1e-6
GN_EPS = 64e-5

kernel_name = 'hymba_rglru_rwkv7_xattn_moe'


def rmsnorm(x, g):
    xf = x.astype(jnp.float32)
    y = xf * lax.rsqrt(jnp.mean(xf * xf, axis=-1, keepdims=True) + EPS)
    return (y * g.astype(jnp.float32)).astype(x.dtype)


def token_shift(u):
    return jnp.pad(u, ((0, 0), (1, 0), (0, 0)))[:, :-1]


def causal_dwconv(x, w, b):
    c = x.shape[-1]
    y = lax.conv_general_dilated(x, w[:, None, :].astype(x.dtype), window_strides=(1,),
                                 padding=[(CONV_W - 1, 0)],
                                 dimension_numbers=('NWC', 'WIO', 'NWC'),
                                 feature_group_count=c)
    return y + b


def rg_lru(xc, wx, bx, wa, ba, lam):
    bsz, s, _ = xc.shape
    xb = xc.reshape(bsz, s, LRU_BLOCKS, LRU_BLOCK)
    gx = jax.nn.sigmoid(jnp.einsum('bsni,nij->bsnj', xb, wx).reshape(bsz, s, LRU_W) + bx)
    ga = jax.nn.sigmoid(jnp.einsum('bsni,nij->bsnj', xb, wa).reshape(bsz, s, LRU_W) + ba)
    log_a = -LRU_C * ga.astype(jnp.float32) * jax.nn.softplus(-lam.astype(jnp.float32))
    a = jnp.exp(log_a)
    bt = jnp.sqrt(-jnp.expm1(2.0 * log_a)) * gx.astype(jnp.float32) * xc.astype(jnp.float32)

    def combine(left, right):
        a1, b1 = left
        a2, b2 = right
        return a1 * a2, a2 * b1 + b2

    _, h = lax.associative_scan(combine, (a, bt), axis=1)
    return h.astype(xc.dtype)


def rwkv7_mix(u, mu, w0, w_up, a0, a_up, g_up, k_k, k_a, r_k, lnx_g, lnx_b):
    bsz, s, _ = u.shape
    u = u + (token_shift(u) - u) * mu
    c1 = RWKV_W
    c2 = 2 * RWKV_W
    c3 = 3 * RWKV_W
    c4 = c3 + DECAY_LORA
    c5 = c4 + AAA_LORA
    r, k, v, dw, da, dg = jnp.split(u, [c1, c2, c3, c4, c5], axis=-1)
    w = -jax.nn.softplus(-(w0 + jnp.tanh(dw) @ w_up)) - 0.5
    decay = jnp.exp(-jnp.exp(w.astype(jnp.float32)))
    a = jax.nn.sigmoid(a0 + da @ a_up)
    g = jax.nn.sigmoid(dg) @ g_up

    def hs(t):
        return t.reshape(bsz, s, RWKV_HEADS, RWKV_HEAD).astype(jnp.float32)

    kk = hs(k * k_k)
    kk = kk / jnp.maximum(jnp.sqrt(jnp.sum(kk * kk, axis=-1, keepdims=True)), 1e-12)
    k = k * (1.0 + (a - 1.0) * k_a)
    rh, kh, vh, ah, wh = hs(r), hs(k), hs(v), hs(a), hs(decay)

    def step(state, inp):
        r_t, w_t, k_t, v_t, kk_t, a_t = inp
        sa = jnp.einsum('bhvk,bhk->bhv', state, -kk_t)
        state = (state * w_t[:, :, None, :]
                 + sa[..., None] * (kk_t * a_t)[:, :, None, :]
                 + v_t[..., None] * k_t[:, :, None, :])
        y_t = jnp.einsum('bhvk,bhk->bhv', state, r_t)
        return state, y_t

    def tm(t):
        return jnp.swapaxes(t, 0, 1)

    s0 = jnp.zeros((bsz, RWKV_HEADS, RWKV_HEAD, RWKV_HEAD), jnp.float32)
    _, y = lax.scan(step, s0, (tm(rh), tm(wh), tm(kh), tm(vh), tm(kk), tm(ah)))
    y = tm(y)
    mean = jnp.mean(y, axis=-1, keepdims=True)
    var = jnp.mean(jnp.square(y - mean), axis=-1, keepdims=True)
    y = ((y - mean) * lax.rsqrt(var + GN_EPS) * lnx_g.reshape(RWKV_HEADS, RWKV_HEAD).astype(jnp.float32)
         + lnx_b.reshape(RWKV_HEADS, RWKV_HEAD).astype(jnp.float32))
    y = y + jnp.sum(rh * kh * r_k.astype(jnp.float32), axis=-1, keepdims=True) * vh
    return (y.reshape(bsz, s, RWKV_W) * g.astype(jnp.float32)).astype(u.dtype)


def cross_attn(h, mem_h, wq, wk, wv, wo):
    bsz, s, d = h.shape
    m = mem_h.shape[1]
    q = (h @ wq).reshape(bsz, s, XA_HEADS, XA_HEAD)
    k = (mem_h @ wk).reshape(bsz, m, XA_HEADS, XA_HEAD)
    v = (mem_h @ wv).reshape(bsz, m, XA_HEADS, XA_HEAD)
    sc = jnp.einsum('bshd,bmhd->bhsm', q, k).astype(jnp.float32) * (XA_HEAD ** -0.5)
    p = jax.nn.softmax(sc, axis=-1).astype(h.dtype)
    o = jnp.einsum('bhsm,bmhd->bshd', p, v).reshape(bsz, s, d)
    return o @ wo


def clamped_swiglu(gu):
    gate, up = jnp.split(gu, 2, axis=-1)
    gate = jnp.minimum(gate, SWIGLU_LIMIT)
    up = jnp.clip(up, -SWIGLU_LIMIT, SWIGLU_LIMIT)
    return (up + 1.0) * (gate * jax.nn.sigmoid(SWIGLU_ALPHA * gate))


def moe(h, w_router, b_router, w_gu, b_gu, w_dn, b_dn):
    bsz, s, d = h.shape
    t = bsz * s
    xt = h.reshape(t, d)
    logits = (xt @ w_router + b_router).astype(jnp.float32)
    top_val, top_idx = lax.top_k(logits, TOP_K)
    gates = jax.nn.softmax(top_val, axis=-1)
    n_assign = t * TOP_K
    e_flat = top_idx.reshape(n_assign)
    tok_flat = jnp.repeat(jnp.arange(t, dtype=jnp.int32), TOP_K)
    g_flat = gates.reshape(n_assign)
    order = jnp.argsort(e_flat)
    e_s = e_flat[order]
    tok_s = tok_flat[order]
    g_s = g_flat[order]
    counts = jnp.bincount(e_flat, length=N_EXPERTS)
    starts = jnp.cumsum(counts) - counts
    padded = (counts + MOE_BLOCK - 1) // MOE_BLOCK * MOE_BLOCK
    pends = jnp.cumsum(padded)
    pstarts = pends - padded
    dest = pstarts[e_s] + (jnp.arange(n_assign) - starts[e_s])
    n_blocks = (n_assign + N_EXPERTS * (MOE_BLOCK - 1) + MOE_BLOCK - 1) // MOE_BLOCK
    rows = n_blocks * MOE_BLOCK
    buf_tok = jnp.full((rows,), t, jnp.int32).at[dest].set(tok_s)
    buf_g = jnp.zeros((rows,), jnp.float32).at[dest].set(g_s)
    block_e = jnp.minimum(jnp.searchsorted(pends, jnp.arange(n_blocks) * MOE_BLOCK, side='right'),
                          N_EXPERTS - 1).astype(jnp.int32)
    x_pad = jnp.concatenate([xt, jnp.zeros((1, d), xt.dtype)], axis=0)

    def block_fn(args):
        tok_b, g_b, e = args
        xb = x_pad[tok_b]
        act = clamped_swiglu(xb @ w_gu[e] + b_gu[e])
        y = act @ w_dn[e] + b_dn[e]
        return y * g_b[:, None].astype(y.dtype)

    ys = lax.map(block_fn, (buf_tok.reshape(n_blocks, MOE_BLOCK),
                            buf_g.reshape(n_blocks, MOE_BLOCK), block_e))
    out = jnp.zeros((t + 1, d), ys.dtype).at[buf_tok].add(ys.reshape(rows, d))[:t]
    return out.reshape(bsz, s, d).astype(h.dtype)


def setup_inputs(seed: int = 0) -> dict:
    key = jax.random.key(seed)
    ks = iter(jax.random.split(key, 48))
    f32 = jnp.float32

    def nrm(shape, scale):
        return jax.random.normal(next(ks), shape, f32) * scale

    def gain(shape):
        return 1.0 + 0.05 * jax.random.normal(next(ks), shape, f32)

    L = DEPTH
    u_lam = jax.random.uniform(next(ks), (L, LRU_W), f32, 0.9, 0.999)
    a_base = u_lam ** (1.0 / LRU_C)
    lru_lambda = jnp.log(a_base) - jnp.log1p(-a_base)
    return {
        'x': nrm((BATCH, SEQ, D_MODEL), 1.0),
        'mem': nrm((BATCH, MEM_LEN, D_MODEL), 1.0),
        'norm_mix_g': gain((L, D_MODEL)),
        'w_in': nrm((L, D_MODEL, IN_W), D_MODEL ** -0.5),
        'conv_w': nrm((L, CONV_W, LRU_W), CONV_W ** -0.5),
        'conv_b': nrm((L, LRU_W), 0.02),
        'lru_wx': nrm((L, LRU_BLOCKS, LRU_BLOCK, LRU_BLOCK), LRU_BLOCK ** -0.5),
        'lru_bx': nrm((L, LRU_W), 0.02),
        'lru_wa': nrm((L, LRU_BLOCKS, LRU_BLOCK, LRU_BLOCK), LRU_BLOCK ** -0.5),
        'lru_ba': nrm((L, LRU_W), 0.02),
        'lru_lambda': lru_lambda,
        'rwkv_mu': jax.random.uniform(next(ks), (L, RWKV_IN), f32, 0.0, 1.0),
        'rwkv_w0': jax.random.uniform(next(ks), (L, RWKV_W), f32, -4.0, 1.0),
        'rwkv_w_up': nrm((L, DECAY_LORA, RWKV_W), 0.1 * DECAY_LORA ** -0.5),
        'rwkv_a0': nrm((L, RWKV_W), 0.5),
        'rwkv_a_up': nrm((L, AAA_LORA, RWKV_W), 0.1 * AAA_LORA ** -0.5),
        'rwkv_g_up': nrm((L, GATE_LORA, RWKV_W), GATE_LORA ** -0.5),
        'rwkv_k_k': 0.85 + 0.05 * jax.random.normal(next(ks), (L, RWKV_W), f32),
        'rwkv_k_a': gain((L, RWKV_W)),
        'rwkv_r_k': nrm((L, RWKV_HEADS, RWKV_HEAD), 0.1),
        'rwkv_lnx_g': gain((L, RWKV_W)),
        'rwkv_lnx_b': nrm((L, RWKV_W), 0.02),
        'w_out': nrm((L, MIX_W, D_MODEL), MIX_W ** -0.5),
        'norm_xa_g': gain((L, D_MODEL)),
        'norm_mem_g': gain((L, D_MODEL)),
        'xa_wq': nrm((L, D_MODEL, D_MODEL), D_MODEL ** -0.5),
        'xa_wk': nrm((L, D_MODEL, D_MODEL), D_MODEL ** -0.5),
        'xa_wv': nrm((L, D_MODEL, D_MODEL), D_MODEL ** -0.5),
        'xa_wo': nrm((L, D_MODEL, D_MODEL), D_MODEL ** -0.5),
        'norm_ffn_g': gain((L, D_MODEL)),
        'w_router': nrm((L, D_MODEL, N_EXPERTS), D_MODEL ** -0.5),
        'b_router': nrm((L, N_EXPERTS), 0.01),
        'w_gu': nrm((L, N_EXPERTS, D_MODEL, 2 * D_FF), D_MODEL ** -0.5),
        'b_gu': nrm((L, N_EXPERTS, 2 * D_FF), 0.02),
        'w_dn': nrm((L, N_EXPERTS, D_FF, D_MODEL), D_FF ** -0.5),
        'b_dn': nrm((L, N_EXPERTS, D_MODEL), 0.02),
        'final_norm_g': gain((D_MODEL,)),
    }


def reference(x, mem, norm_mix_g, w_in, conv_w, conv_b, lru_wx, lru_bx, lru_wa, lru_ba,
              lru_lambda, rwkv_mu, rwkv_w0, rwkv_w_up, rwkv_a0, rwkv_a_up, rwkv_g_up,
              rwkv_k_k, rwkv_k_a, rwkv_r_k, rwkv_lnx_g, rwkv_lnx_b, w_out, norm_xa_g,
              norm_mem_g, xa_wq, xa_wk, xa_wv, xa_wo, norm_ffn_g, w_router, b_router,
              w_gu, b_gu, w_dn, b_dn, final_norm_g):
    for l in range(DEPTH):
        h = rmsnorm(x, norm_mix_g[l])
        u = h @ w_in[l]
        x_lru, g_lru, u_rwkv = jnp.split(u, [LRU_W, 2 * LRU_W], axis=-1)
        xc = causal_dwconv(x_lru, conv_w[l], conv_b[l])
        y_lru = rg_lru(xc, lru_wx[l], lru_bx[l], lru_wa[l], lru_ba[l], lru_lambda[l]) * jax.nn.gelu(g_lru)
        y_rwkv = rwkv7_mix(u_rwkv, rwkv_mu[l], rwkv_w0[l], rwkv_w_up[l], rwkv_a0[l], rwkv_a_up[l],
                           rwkv_g_up[l], rwkv_k_k[l], rwkv_k_a[l], rwkv_r_k[l],
                           rwkv_lnx_g[l], rwkv_lnx_b[l])
        x = x + jnp.concatenate([y_lru, y_rwkv], axis=-1) @ w_out[l]
        x = x + cross_attn(rmsnorm(x, norm_xa_g[l]), rmsnorm(mem, norm_mem_g[l]),
                           xa_wq[l], xa_wk[l], xa_wv[l], xa_wo[l])
        x = x + moe(rmsnorm(x, norm_ffn_g[l]), w_router[l], b_router[l],
                    w_gu[l], b_gu[l], w_dn[l], b_dn[l])
    return rmsnorm(x, final_norm_g)
```

```cpp
#include <hip/hip_runtime.h>
#include <cstdio>
#include <cstdint>

#ifndef MK_ONE_LAUNCH
#define MK_ONE_LAUNCH 1
#endif

#define DI __device__ __forceinline__
#define GAS __attribute__((address_space(1)))
#define LAS __attribute__((address_space(3)))
typedef unsigned short bf16;
typedef short bf16x8 __attribute__((ext_vector_type(8)));
typedef float f32x4 __attribute__((ext_vector_type(4)));
typedef float f32x2 __attribute__((ext_vector_type(2)));
typedef unsigned u32x4 __attribute__((ext_vector_type(4)));
typedef unsigned u32x2 __attribute__((ext_vector_type(2)));

constexpr int D = 1024, NB = 4, SEQ = 4096, M = NB * SEQ;
constexpr int MEML = 256, MROWS = NB * MEML;
constexpr int LRU_W = 512, RW = 512, NH = 8, HD = 64;
constexpr int INW = 2816;
constexpr int XH = 4, XHD = 256;
constexpr int NE = 32, TOPK = 4, DFF = 1024;
constexpr int NASSIGN = M * TOPK;
constexpr int MAXTILES = 288, MAXROWS = MAXTILES * 256;
constexpr float EPS = 1e-6f, GN_EPS = 64e-5f;

namespace pg8 {
constexpr int BM = 256, BK = 64, HALF = 128, HTB = HALF * BK * 2, STAGE_BYTES = 8 * HTB, NXCD = 8, WGM = 8;
__host__ __device__ __forceinline__ int lds_byte(int r, int c) { const int st = (r >> 4) * 2 + (c >> 5), rr = r & 15, cc = c & 31, ob = rr * 64 + cc * 2; return st * 1024 + (ob ^ (((ob >> 9) & 1) << 5)); }
__host__ __device__ __forceinline__ void stage_rc(int b, int& R, int& C) { const int st = b / 1024, sb = b % 1024, swz = sb ^ (((sb >> 9) & 1) << 5); R = (st >> 1) * 16 + swz / 64; C = (st & 1) * 32 + (swz % 64) / 2; }
__host__ __device__ __forceinline__ int perm32(int rho) { const int n = rho >> 4, i = rho & 15; return 8 * (i >> 2) + 4 * n + (i & 3); }

struct Unit { int pm, pn, e; };

struct StaticOrder {
    int nM, nN, nwg, G, c;
    __host__ __device__ void init_tiles(int nM_, int nN_, int G_, int c_) { nM = nM_; nN = nN_; nwg = nM * nN; G = G_; c = c_; }
    __host__ __device__ bool next(int i, Unit& u) const {
        const long L = (long)i * G + c; if (L >= nwg) return false;
        int wgid = (int)L; { const int q = nwg / NXCD, r = nwg % NXCD, xcd = wgid % NXCD, off = wgid / NXCD; wgid = (xcd < r ? xcd * (q + 1) : r * (q + 1) + (xcd - r) * q) + off; }
        const int nig = WGM * nN, gid = wgid / nig, fm = gid * WGM, gsz = (nM - fm) < WGM ? (nM - fm) : WGM;
        u.pm = fm + ((wgid % nig) % gsz); u.pn = (wgid % nig) / gsz; u.e = 0; return true;
    }
};
struct DenseSched {
    StaticOrder o; const char* A; const char* B; size_t tstep;
    DI bool next(int i, Unit& u) const { return o.next(i, u); }
    DI const char* a_ptr(const Unit& u) const { return A + (size_t)u.pm * tstep; }
    DI const char* b_ptr(const Unit& u) const { return B + (size_t)u.pn * tstep; }
};
struct MoeSched {
    StaticOrder o; const char* A; const char* B; const int* tile_e; size_t tstep, estep;
    DI bool next(int i, Unit& u) const { if (!o.next(i, u)) return false; u.e = tile_e[u.pm]; return true; }
    DI const char* a_ptr(const Unit& u) const { return A + (size_t)u.pm * tstep; }
    DI const char* b_ptr(const Unit& u) const { return B + (size_t)u.e * estep + (size_t)u.pn * tstep; }
};

DI unsigned cvt_pk_bf16(float lo, float hi) { unsigned r; asm volatile("v_cvt_pk_bf16_f32 %0, %1, %2" : "=v"(r) : "v"(lo), "v"(hi)); return r; }

template <class Epi, class Sched, bool ALIGN_EPI = true, bool SP2 = true>
DI void gemm_phase(LAS unsigned char* lds, const int K, const Sched& S, const Epi& E) {
    const int tid = threadIdx.x, wid = __builtin_amdgcn_readfirstlane(tid >> 6), lane = tid & 63, wr = wid >> 2, wc = wid & 3, fr = lane & 15, fq = lane >> 4;
    const int nt = K / BK;
    unsigned voffA[2], voffB[2];
#pragma unroll
    for (int i = 0; i < 2; ++i) { int R, C; stage_rc(tid * 16 + i * 8192, R, C); const int Rb = Epi::PERM ? ((R & ~31) + perm32(R & 31)) : R;
        voffA[i] = (unsigned)(R * K + C) * 2u; voffB[i] = (unsigned)(Rb * K + C) * 2u; }
    const size_t kstep = (size_t)(BK * 2);
    const size_t hstep = (size_t)HALF * K * 2;
    const unsigned ldsw = (unsigned)wid * 1024u;
    const int aoff = lds_byte(wr * 64 + fr, fq * 8), boff = lds_byte(wc * 32 + fr, fq * 8);
#define PG8_SA(b, h) (((b) * 2 + (h)) * HTB)
#define PG8_SB(b, h) ((4 + (b) * 2 + (h)) * HTB)
#define PG8_STAGE(bufoff, gbase, voff) do { _Pragma("unroll") for (int _i = 0; _i < 2; ++_i) \
        __builtin_amdgcn_global_load_lds((const unsigned*)((const char*)(gbase) + (voff)[_i]), (LAS unsigned*)(lds + (bufoff) + ldsw + _i * 8192), 16, 0, 0); } while (0)
#define PG8_LDA(dst, b, h) do { _Pragma("unroll") for (int m = 0; m < 4; ++m) _Pragma("unroll") for (int k = 0; k < 2; ++k) dst[m][k] = *(const LAS bf16x8*)(lds + PG8_SA(b, h) + aoff + m * 2048 + k * 1024); } while (0)
#define PG8_LDB(dst, b, h) do { _Pragma("unroll") for (int n = 0; n < 2; ++n) _Pragma("unroll") for (int k = 0; k < 2; ++k) dst[n][k] = *(const LAS bf16x8*)(lds + PG8_SB(b, h) + boff + n * 2048 + k * 1024); } while (0)
#define PG8_MMA(ai, bj, At, Bt) do { __builtin_amdgcn_s_setprio(1); _Pragma("unroll") for (int m = 0; m < 4; ++m) _Pragma("unroll") for (int n = 0; n < 2; ++n) _Pragma("unroll") for (int k = 0; k < 2; ++k) \
        acc[ai][bj][m][n] = __builtin_amdgcn_mfma_f32_16x16x32_bf16(Bt[n][k], At[m][k], acc[ai][bj][m][n], 0, 0, 0); __builtin_amdgcn_s_setprio(0); } while (0)
#define PG8_WAIT_V(n) asm volatile("s_waitcnt vmcnt(" #n ")" ::: "memory")
#define PG8_WAIT_L(n) asm volatile("s_waitcnt lgkmcnt(" #n ")" ::: "memory")
#define PG8_BAR __builtin_amdgcn_s_barrier()
#define PG8_SCHED __builtin_amdgcn_sched_barrier(0)
    Unit cur, nxt; int ui = 0;
    if (!S.next(0, cur)) return;
    f32x4 acc[2][2][4][2];
#pragma unroll
    for (int a = 0; a < 2; ++a)
#pragma unroll
        for (int b = 0; b < 2; ++b)
#pragma unroll
            for (int m = 0; m < 4; ++m)
#pragma unroll
                for (int n = 0; n < 2; ++n) acc[a][b][m][n] = (f32x4){0.f, 0.f, 0.f, 0.f};
    bf16x8 At[4][2], B0[2][2], B1[2][2];
    const char* cA = S.a_ptr(cur); const char* cB = S.b_ptr(cur);
    if constexpr (SP2) {
        PG8_STAGE(PG8_SB(0, 0), cB, voffB); PG8_STAGE(PG8_SB(0, 1), cB + hstep, voffB); PG8_STAGE(PG8_SA(0, 0), cA, voffA); PG8_STAGE(PG8_SA(0, 1), cA + hstep, voffA);
        if (wr == 1) PG8_BAR;
        PG8_WAIT_V(2); PG8_BAR;
        PG8_STAGE(PG8_SB(1, 0), cB + kstep, voffB); PG8_STAGE(PG8_SA(1, 0), cA + kstep, voffA); PG8_STAGE(PG8_SB(1, 1), cB + hstep + kstep, voffB);
        PG8_WAIT_V(6); PG8_BAR;
    } else {
        PG8_STAGE(PG8_SB(0, 0), cB, voffB); PG8_STAGE(PG8_SA(0, 0), cA, voffA); PG8_STAGE(PG8_SB(0, 1), cB + hstep, voffB); PG8_STAGE(PG8_SA(0, 1), cA + hstep, voffA);
        if (wr == 1) PG8_BAR;
        PG8_WAIT_V(4); PG8_BAR;
        PG8_STAGE(PG8_SB(1, 0), cB + kstep, voffB); PG8_STAGE(PG8_SA(1, 0), cA + kstep, voffA); PG8_STAGE(PG8_SB(1, 1), cB + hstep + kstep, voffB);
        PG8_WAIT_V(6); PG8_BAR;
    }
    for (;;) {
        const bool has_next = S.next(ui + 1, nxt);
        const char* nA = has_next ? S.a_ptr(nxt) : cA; const char* nB = has_next ? S.b_ptr(nxt) : cB;
        for (int t = 0; t < nt; t += 2) {
            const bool last = (t == nt - 2);
            const char* a1 = cA + (size_t)(t + 1) * kstep;
            const char* a2 = last ? nA : cA + (size_t)(t + 2) * kstep; const char* b2 = last ? nB : cB + (size_t)(t + 2) * kstep;
            const char* a3 = a2 + kstep; const char* b3 = b2 + kstep;
            if constexpr (SP2) {
            PG8_LDB(B0, 0, 0); PG8_LDB(B1, 0, 1); PG8_SCHED; PG8_LDA(At, 0, 0); PG8_STAGE(PG8_SA(1, 1), a1 + hstep, voffA);
            PG8_WAIT_V(8); PG8_WAIT_L(0); PG8_BAR; PG8_MMA(0, 0, At, B0); PG8_MMA(0, 1, At, B1); PG8_BAR; PG8_SCHED;
            PG8_LDA(At, 0, 1); PG8_STAGE(PG8_SB(0, 0), b2, voffB); PG8_STAGE(PG8_SB(0, 1), b2 + hstep, voffB); PG8_STAGE(PG8_SA(0, 0), a2, voffA);
            PG8_WAIT_V(8); PG8_WAIT_L(0); PG8_BAR; PG8_MMA(1, 0, At, B0); PG8_MMA(1, 1, At, B1); PG8_BAR; PG8_SCHED;
            PG8_LDB(B0, 1, 0); PG8_LDB(B1, 1, 1); PG8_SCHED; PG8_LDA(At, 1, 0); PG8_STAGE(PG8_SA(0, 1), a2 + hstep, voffA);
            PG8_WAIT_V(8); PG8_WAIT_L(0); PG8_BAR; PG8_MMA(0, 0, At, B0); PG8_MMA(0, 1, At, B1); PG8_BAR; PG8_SCHED;
            PG8_LDA(At, 1, 1); PG8_STAGE(PG8_SB(1, 0), b3, voffB); PG8_STAGE(PG8_SB(1, 1), b3 + hstep, voffB); PG8_STAGE(PG8_SA(1, 0), a3, voffA);
            PG8_WAIT_V(8); PG8_WAIT_L(0); PG8_BAR; PG8_MMA(1, 0, At, B0); PG8_MMA(1, 1, At, B1); PG8_BAR; PG8_SCHED;
            } else {
            PG8_LDB(B0, 0, 0); PG8_SCHED; PG8_LDA(At, 0, 0); PG8_STAGE(PG8_SA(1, 1), a1 + hstep, voffA);
            PG8_WAIT_L(8); PG8_BAR; PG8_WAIT_L(0); PG8_MMA(0, 0, At, B0); PG8_BAR; PG8_SCHED;
            PG8_LDB(B1, 0, 1); PG8_STAGE(PG8_SB(0, 0), b2, voffB);
            PG8_BAR; PG8_WAIT_L(0); PG8_MMA(0, 1, At, B1); PG8_BAR;
            PG8_LDA(At, 0, 1); PG8_STAGE(PG8_SA(0, 0), a2, voffA);
            PG8_BAR; PG8_WAIT_L(0); PG8_MMA(1, 0, At, B0); PG8_BAR; PG8_SCHED;
            PG8_STAGE(PG8_SB(0, 1), b2 + hstep, voffB);
            PG8_WAIT_V(6); PG8_BAR; PG8_MMA(1, 1, At, B1); PG8_BAR;
            PG8_LDB(B0, 1, 0); PG8_SCHED; PG8_LDA(At, 1, 0); PG8_STAGE(PG8_SA(0, 1), a2 + hstep, voffA);
            PG8_WAIT_L(8); PG8_BAR; PG8_WAIT_L(0); PG8_MMA(0, 0, At, B0); PG8_BAR; PG8_SCHED;
            PG8_LDB(B1, 1, 1); PG8_STAGE(PG8_SB(1, 0), b3, voffB);
            PG8_BAR; PG8_WAIT_L(0); PG8_MMA(0, 1, At, B1); PG8_BAR;
            PG8_LDA(At, 1, 1); PG8_STAGE(PG8_SA(1, 0), a3, voffA);
            PG8_BAR; PG8_WAIT_L(0); PG8_MMA(1, 0, At, B0); PG8_BAR; PG8_SCHED;
            PG8_STAGE(PG8_SB(1, 1), b3 + hstep, voffB);
            PG8_WAIT_V(6); PG8_BAR; PG8_MMA(1, 1, At, B1); PG8_BAR;
            }
        }
        if constexpr (ALIGN_EPI) { if (wr == 0) PG8_BAR; }
        E(acc, cur, wr, wc, fr, fq);
        if (!has_next) break;
#pragma unroll
        for (int a = 0; a < 2; ++a)
#pragma unroll
            for (int b = 0; b < 2; ++b)
#pragma unroll
                for (int m = 0; m < 4; ++m)
#pragma unroll
                    for (int n = 0; n < 2; ++n) acc[a][b][m][n] = (f32x4){0.f, 0.f, 0.f, 0.f};
        cur = nxt; cA = nA; cB = nB; ++ui;
        if constexpr (ALIGN_EPI) { if (wr == 1) PG8_BAR; }
    }
    PG8_WAIT_V(0);
    if constexpr (!ALIGN_EPI) { if (wr == 0) PG8_BAR; }
    PG8_BAR;
#undef PG8_SA
#undef PG8_SB
#undef PG8_STAGE
#undef PG8_LDA
#undef PG8_LDB
#undef PG8_MMA
#undef PG8_WAIT_V
#undef PG8_WAIT_L
#undef PG8_BAR
#undef PG8_SCHED
}
}
using pg8::Unit;
using pg8::cvt_pk_bf16;

DI float bflo(unsigned w) { return __uint_as_float(w << 16); }
DI float bfhi(unsigned w) { return __uint_as_float(w & 0xffff0000u); }
DI float bf2f(bf16 b) { return __uint_as_float(((unsigned)b) << 16); }
DI unsigned f2bf(float f) { unsigned u = __float_as_uint(f); return (u + 0x7fffu + ((u >> 16) & 1u)) >> 16; }
DI unsigned pk2(float lo, float hi) { return f2bf(lo) | (f2bf(hi) << 16); }
DI float sigmoid_f(float x) { return 1.0f / (1.0f + __expf(-x)); }
DI float softplus_f(float x) { return fmaxf(x, 0.f) + log1pf(__expf(-fabsf(x))); }
DI float softplus_fast(float x) { return fmaxf(x, 0.f) + __logf(1.0f + __expf(-fabsf(x))); }
DI float gelu_tanh_f(float x) { const float u = 0.7978845608028654f * (x + 0.044715f * x * x * x); return 0.5f * x * (1.0f + tanhf(u)); }
DI int fresh_tid() { int t = threadIdx.x; asm volatile("" : "+v"(t)); return t; }
DI float wave_sum(float v) {
#pragma unroll
    for (int o = 1; o < 64; o <<= 1) v += __shfl_xor(v, o);
    return v;
}

struct EpiBf16Plain {
    static constexpr bool PERM = true;
    bf16* O; int ldc; float scale;
    DI void operator()(const f32x4 (&acc)[2][2][4][2], const Unit& u, int wr, int wc, int fr, int fq) const {
        const int row0 = u.pm * 256 + wr * 64 + fr, col0 = u.pn * 256 + wc * 32 + 8 * fq;
#pragma unroll
        for (int ai = 0; ai < 2; ++ai)
#pragma unroll
            for (int m = 0; m < 4; ++m) { bf16* rowp = O + (size_t)(row0 + ai * 128 + m * 16) * ldc + col0;
#pragma unroll
                for (int bj = 0; bj < 2; ++bj) { const f32x4 v0 = acc[ai][bj][m][0] * scale, v1 = acc[ai][bj][m][1] * scale;
                    u32x4 w; w.x = cvt_pk_bf16(v0[0], v0[1]); w.y = cvt_pk_bf16(v0[2], v0[3]); w.z = cvt_pk_bf16(v1[0], v1[1]); w.w = cvt_pk_bf16(v1[2], v1[3]);
                    *(u32x4*)(rowp + bj * 128) = w; } }
    }
};
struct EpiF32Res {
    static constexpr bool PERM = false;
    const float* Rz; float* C; int ldc;
    DI void operator()(const f32x4 (&acc)[2][2][4][2], const Unit& u, int wr, int wc, int fr, int fq) const {
        const int row0 = u.pm * 256 + wr * 64 + fr, col0 = u.pn * 256 + wc * 32 + 4 * fq;
#pragma unroll
        for (int ai = 0; ai < 2; ++ai)
#pragma unroll
            for (int m = 0; m < 4; ++m) { const size_t off = (size_t)(row0 + ai * 128 + m * 16) * ldc + col0;
#pragma unroll
                for (int bj = 0; bj < 2; ++bj)
#pragma unroll
                    for (int n = 0; n < 2; ++n) { const f32x4 r = *(const f32x4*)(Rz + off + bj * 128 + n * 16); *(f32x4*)(C + off + bj * 128 + n * 16) = r + acc[ai][bj][m][n]; } }
    }
};
struct EpiLora {
    static constexpr bool PERM = false;
    float* WD3; const float* w0; const float* a0;
    DI void operator()(const f32x4 (&acc)[2][2][4][2], const Unit& u, int wr, int wc, int fr, int fq) const {
        const int kind = u.pn >> 1;
        const int row0 = u.pm * 256 + wr * 64 + fr, col0 = (u.pn & 1) * 256 + wc * 32 + 4 * fq;
        float* dst = WD3 + (size_t)kind * (size_t)(8u << 20);
#pragma unroll
        for (int bj = 0; bj < 2; ++bj)
#pragma unroll
            for (int n = 0; n < 2; ++n) {
                const int c = col0 + bj * 128 + n * 16;
                f32x4 bias = (f32x4){0.f, 0.f, 0.f, 0.f};
                if (kind == 0) bias = *(const f32x4*)(w0 + c); else if (kind == 1) bias = *(const f32x4*)(a0 + c);
#pragma unroll
                for (int ai = 0; ai < 2; ++ai)
#pragma unroll
                    for (int m = 0; m < 4; ++m) {
                        f32x4 v = acc[ai][bj][m][n] + bias;
                        if (kind == 0) {
#pragma unroll
                            for (int j = 0; j < 4; ++j) { const float w = -softplus_fast(-v[j]) - 0.5f; v[j] = __expf(-__expf(w)); }
                        } else if (kind == 1) {
#pragma unroll
                            for (int j = 0; j < 4; ++j) v[j] = sigmoid_f(v[j]);
                        }
                        *(f32x4*)(dst + (size_t)(row0 + ai * 128 + m * 16) * 512 + c) = v;
                    }
            }
    }
};
struct EpiSwiglu {
    static constexpr bool PERM = true;
    bf16* ACT; const float* b_gu;
    DI void operator()(const f32x4 (&acc)[2][2][4][2], const Unit& u, int wr, int wc, int fr, int fq) const {
        const int row0 = u.pm * 256 + wr * 64 + fr, j0 = u.pn * 128 + wc * 32 + 8 * fq;
        const float* bg = b_gu + (size_t)u.e * 2048 + j0; const float* bu = bg + 1024;
        const f32x4 bg0 = *(const f32x4*)bg, bg1 = *(const f32x4*)(bg + 4), bu0 = *(const f32x4*)bu, bu1 = *(const f32x4*)(bu + 4);
#pragma unroll
        for (int ai = 0; ai < 2; ++ai)
#pragma unroll
            for (int m = 0; m < 4; ++m) {
                float o[8];
#pragma unroll
                for (int n = 0; n < 2; ++n) { const f32x4 g4 = acc[ai][0][m][n] + (n ? bg1 : bg0), u4 = acc[ai][1][m][n] + (n ? bu1 : bu0);
#pragma unroll
                    for (int j = 0; j < 4; ++j) { const float g = fminf(g4[j], 7.0f), up = fminf(fmaxf(u4[j], -7.0f), 7.0f); o[n * 4 + j] = (up + 1.0f) * (g * sigmoid_f(1.702f * g)); } }
                u32x4 w; w.x = cvt_pk_bf16(o[0], o[1]); w.y = cvt_pk_bf16(o[2], o[3]); w.z = cvt_pk_bf16(o[4], o[5]); w.w = cvt_pk_bf16(o[6], o[7]);
                *(u32x4*)(ACT + (size_t)(row0 + ai * 128 + m * 16) * 1024 + j0) = w;
            }
    }
};
struct EpiDown {
    static constexpr bool PERM = true;
    bf16* YS; const float* b_dn; const int* row_slot; const float* row_gate;
    DI void operator()(const f32x4 (&acc)[2][2][4][2], const Unit& u, int wr, int wc, int fr, int fq) const {
        const int row0 = u.pm * 256 + wr * 64 + fr, col0 = u.pn * 256 + wc * 32 + 8 * fq;
        const float* bb = b_dn + (size_t)u.e * 1024 + col0;
        f32x4 bv[2][2];
#pragma unroll
        for (int bj = 0; bj < 2; ++bj)
#pragma unroll
            for (int n = 0; n < 2; ++n) bv[bj][n] = *(const f32x4*)(bb + bj * 128 + 4 * n);
#pragma unroll
        for (int ai = 0; ai < 2; ++ai)
#pragma unroll
            for (int m = 0; m < 4; ++m) {
                const int r = row0 + ai * 128 + m * 16; const int slot = row_slot[r]; const float gt = row_gate[r];
                if (slot >= 0) { bf16* rowp = YS + (size_t)slot * 1024 + col0;
#pragma unroll
                    for (int bj = 0; bj < 2; ++bj) { const f32x4 v0 = (acc[ai][bj][m][0] + bv[bj][0]) * gt, v1 = (acc[ai][bj][m][1] + bv[bj][1]) * gt;
                        u32x4 w; w.x = cvt_pk_bf16(v0[0], v0[1]); w.y = cvt_pk_bf16(v0[2], v0[3]); w.z = cvt_pk_bf16(v1[0], v1[1]); w.w = cvt_pk_bf16(v1[2], v1[3]);
                        *(u32x4*)(rowp + bj * 128) = w; } }
            }
    }
};

constexpr size_t MiB = 1u << 20;
constexpr size_t WS_CTL = 0, CTL_ZERO_BYTES = 1 * MiB;
constexpr size_t WS_WIN = 1 * MiB, WS_WOUT = 7 * MiB, WS_WQ = 9 * MiB, WS_WK = 11 * MiB, WS_WV = 13 * MiB, WS_WO = 15 * MiB, WS_LORAB = 17 * MiB, WS_LRUW = 18 * MiB;
constexpr size_t WS_ROUTE = 19 * MiB;
constexpr size_t WS_WGU = 22 * MiB, WS_WDN = 150 * MiB;
constexpr size_t WS_HN = 214 * MiB, WS_MEMN = 246 * MiB, WS_KM = 248 * MiB, WS_VT = 250 * MiB;
constexpr size_t WS_X1 = 252 * MiB, WS_X2 = 316 * MiB;
constexpr size_t WS_U = 380 * MiB, WS_R = 468 * MiB, WS_KRAW = 500 * MiB, WS_V = 532 * MiB, WS_KKN = 564 * MiB, WS_WD = 596 * MiB, WS_AA = 628 * MiB, WS_G = 660 * MiB;
constexpr size_t WS_LA = 692 * MiB, WS_LB = 724 * MiB, WS_AP = 756 * MiB, WS_CAT = 764 * MiB, WS_Q = 796 * MiB;
constexpr size_t WS_XS = 380 * MiB, WS_ACT = 524 * MiB, WS_YS = 668 * MiB, WS_END = 828 * MiB;
static_assert(WS_AA == WS_WD + 32 * MiB && WS_G == WS_AA + 32 * MiB, "EpiLora strides");
static_assert(WS_U + (size_t)M * INW * 2 <= WS_R && WS_XS + (size_t)MAXROWS * 2048 <= WS_ACT && WS_ACT + (size_t)MAXROWS * 2048 <= WS_YS && WS_YS + (size_t)NASSIGN * 2048 <= WS_Q, "ws map");
constexpr size_t RT_E = 0, RT_POS = 256 * 1024, RT_G = 512 * 1024, RT_SLOT = 768 * 1024, RT_GATE = 1088 * 1024, RT_TILE = 1408 * 1024;
constexpr int CW_BAR = 4096, CW_CNT = 8192;

constexpr int RING_BYTES = 131072, MISC_OFF = RING_BYTES + 320, LDS_BYTES = 147456;
constexpr int NWAVES = 8, NTHREADS = 512;

#define XB_TMO      128
#define XB_XCNT(j)  (256  + 64 * (j))
#define XB_XSUB(j)  (1280 + 64 * (j))
#define XB_XGEN(j)  (2304 + 64 * (j))
#define XB_TOP      3328
#define XB_TOPGEN   3392
#define XCD_BAR_WORDS 3456
#define XB_SPIN_CAP (1u << 18)
DI unsigned xb_ld(unsigned* p)              { return __hip_atomic_load(p, __ATOMIC_RELAXED, __HIP_MEMORY_SCOPE_AGENT); }
DI unsigned xb_add(unsigned* p, unsigned v) { return __hip_atomic_fetch_add(p, v, __ATOMIC_RELAXED, __HIP_MEMORY_SCOPE_AGENT); }
DI unsigned xb_xcc_id() { return (unsigned)__builtin_amdgcn_s_getreg((3 << 11) | 20) & 0xFu; }
#define XB_SPIN(cond, bar) do { unsigned _sp = 0; while (cond) { __builtin_amdgcn_s_sleep(1); \
    if ((++_sp & 255u) == 0u) { if (xb_ld(&(bar)[XB_TMO])) break; if (_sp > XB_SPIN_CAP) { atomicAdd(&(bar)[XB_TMO], 1u); break; } } } } while (0)
struct XcdBarrier { unsigned* bar; unsigned x; volatile LAS unsigned* st; };
DI XcdBarrier xcd_barrier_post(unsigned* bar, volatile LAS unsigned* st) {
    XcdBarrier b; b.bar = bar; b.x = xb_xcc_id(); b.st = st;
    if (threadIdx.x == 0) (void)xb_add(&bar[XB_XCNT(b.x)], 1u);
    return b;
}
DI void xcd_barrier_complete(unsigned* bar, unsigned x, unsigned& nloc, unsigned& nx) {
    const unsigned G = gridDim.x * gridDim.y * gridDim.z;
    unsigned sum, cnt, mine, sp = 0u;
    for (;;) {
        sum = 0u; cnt = 0u; mine = 0u;
#pragma unroll
        for (unsigned j = 0; j < 16; ++j) { const unsigned c = xb_ld(&bar[XB_XCNT(j)]); sum += c; cnt += (c > 0u) ? 1u : 0u; mine = (j == x) ? c : mine; }
        if (sum == G) break;
        __builtin_amdgcn_s_sleep(1);
        if ((++sp & 255u) == 0u) { if (xb_ld(&bar[XB_TMO])) break; if (sp > XB_SPIN_CAP) { atomicAdd(&bar[XB_TMO], 1u); break; } }
    }
    nloc = mine > 0u ? mine : 1u; nx = cnt > 0u ? cnt : 1u;
}
DI void xcd_barrier(const XcdBarrier& b) {
    asm volatile("s_waitcnt vmcnt(0)" ::: "memory");
    __syncthreads();
    if (threadIdx.x == 0) {
        unsigned* bar = b.bar;
        __builtin_amdgcn_s_waitcnt(0);
        unsigned nloc = b.st[0], nx = b.st[1];
        if (nloc == 0u) { xcd_barrier_complete(bar, b.x, nloc, nx); b.st[0] = nloc; b.st[1] = nx; }
        const unsigned old = xb_add(&bar[XB_XSUB(b.x)], 1u);
        const unsigned gen = old / nloc;
        if (old + 1u == (gen + 1u) * nloc) {
            __builtin_amdgcn_fence(__ATOMIC_RELEASE, "agent");
            asm volatile("s_waitcnt vmcnt(0)" ::: "memory");
            const unsigned og = xb_add(&bar[XB_TOP], 1u);
            const unsigned tg = og / nx;
            if (og + 1u == (tg + 1u) * nx) xb_add(&bar[XB_TOPGEN], 1u);
            else XB_SPIN(xb_ld(&bar[XB_TOPGEN]) == tg, bar);
            __builtin_amdgcn_fence(__ATOMIC_ACQUIRE, "agent");
            xb_add(&bar[XB_XGEN(b.x)], 1u);
            asm volatile("s_waitcnt vmcnt(0)" ::: "memory");
        } else {
            XB_SPIN(xb_ld(&bar[XB_XGEN(b.x)]) == gen, bar);
            __builtin_amdgcn_fence(__ATOMIC_ACQUIRE, "agent");
            asm volatile("s_waitcnt vmcnt(0)" ::: "memory");
        }
    }
    __syncthreads();
}

struct Args { const float* in[37]; float* out; unsigned char* ws; int ph_lo, ph_hi; };
enum { I_X = 0, I_MEM, I_NMIXG, I_WIN, I_CONVW, I_CONVB, I_LWX, I_LBX, I_LWA, I_LBA, I_LAM, I_MU, I_W0, I_WUP, I_A0, I_AUP, I_GUP, I_KK, I_KA, I_RK, I_LNG, I_LNB,
       I_WOUT, I_NXAG, I_NMEMG, I_WQ, I_WK, I_WV, I_WO, I_NFFG, I_WR, I_BR, I_WGU, I_BGU, I_WDN, I_BDN, I_FNG };

DI void transpose_item(const float* W, int ldw, int K, bf16* WT, int k0, int n0, int drow0, LAS float* scr, int lane) {
#pragma unroll 8
    for (int i = 0; i < 32; ++i) { const int kk = 2 * i + (lane >> 5); scr[kk * 33 + (lane & 31)] = W[(size_t)(k0 + kk) * ldw + n0 + (lane & 31)]; }
    asm volatile("s_waitcnt lgkmcnt(0)" ::: "memory");
    const int c = lane & 7;
#pragma unroll
    for (int j = 0; j < 4; ++j) { const int n = (lane >> 3) + 8 * j; const LAS float* s = scr + (8 * c) * 33 + n;
        u32x4 o; o.x = pk2(s[0 * 33], s[1 * 33]); o.y = pk2(s[2 * 33], s[3 * 33]); o.z = pk2(s[4 * 33], s[5 * 33]); o.w = pk2(s[6 * 33], s[7 * 33]);
        *(u32x4*)(WT + (size_t)(drow0 + n) * K + k0 + 8 * c) = o; }
    asm volatile("s_waitcnt lgkmcnt(0)" ::: "memory");
}
DI void rms_row_to_bf16(const float* xrow, const float* g, bf16* orow, int lane) {
    const f32x4* xr = (const f32x4*)xrow + lane; const f32x4* gr = (const f32x4*)g + lane;
    f32x4 v[4]; float s = 0.f;
#pragma unroll
    for (int j = 0; j < 4; ++j) { v[j] = xr[64 * j]; s += (v[j].x * v[j].x + v[j].y * v[j].y) + (v[j].z * v[j].z + v[j].w * v[j].w); }
    const float rstd = 1.0f / sqrtf(wave_sum(s) * (1.f / D) + EPS);
    u32x2* o8 = (u32x2*)orow + lane;
#pragma unroll
    for (int j = 0; j < 4; ++j) { const f32x4 gg = gr[64 * j]; u32x2 w; w.x = pk2(v[j].x * rstd * gg.x, v[j].y * rstd * gg.y); w.y = pk2(v[j].z * rstd * gg.z, v[j].w * rstd * gg.w); o8[64 * j] = w; }
}

__global__ void __launch_bounds__(NTHREADS, 2) fwd(Args args) {
    extern __shared__ __attribute__((aligned(16))) unsigned char lds_raw[];
    LAS unsigned char* lds = (LAS unsigned char*)lds_raw;
    volatile LAS unsigned* MISC = (volatile LAS unsigned*)(lds + MISC_OFF);
    const int G = gridDim.x, bid = blockIdx.x, NGW = G * NWAVES;
#define PHASE_IDS const int tid = fresh_tid(), lane = tid & 63, wave = __builtin_amdgcn_readfirstlane(tid >> 6), gw = bid * NWAVES + wave; (void)tid; (void)lane; (void)wave; (void)gw
    unsigned char* ws = args.ws;
    unsigned* ctl = (unsigned*)(ws + WS_CTL);
    const int lo = args.ph_lo, hi = args.ph_hi;

    for (int u = threadIdx.x; u < (LDS_BYTES - RING_BYTES) / 4; u += NTHREADS) ((LAS unsigned*)(lds + RING_BYTES))[u] = 0u;
    __syncthreads();
    XcdBarrier bar; bar.bar = ctl + CW_BAR; bar.x = 0; bar.st = nullptr;
    if (hi - lo > 1) bar = xcd_barrier_post(ctl + CW_BAR, MISC + 8);
#define IN(k) (lo <= (k) && (k) < hi)
#define SEAM(k) do { if (IN(k) && IN((k) + 1)) xcd_barrier(bar); } while (0)

#define Win_t ((bf16*)(ws + WS_WIN))
#define Wout_t ((bf16*)(ws + WS_WOUT))
#define Wq_t ((bf16*)(ws + WS_WQ))
#define Wk_t ((bf16*)(ws + WS_WK))
#define Wv_t ((bf16*)(ws + WS_WV))
#define Wo_t ((bf16*)(ws + WS_WO))
#define LoraB ((bf16*)(ws + WS_LORAB))
#define LruW ((bf16*)(ws + WS_LRUW))
#define Wgu_t ((bf16*)(ws + WS_WGU))
#define Wdn_t ((bf16*)(ws + WS_WDN))
#define HN ((bf16*)(ws + WS_HN))
#define MEMN ((bf16*)(ws + WS_MEMN))
#define KM ((bf16*)(ws + WS_KM))
#define VT ((bf16*)(ws + WS_VT))
#define X1 ((float*)(ws + WS_X1))
#define X2 ((float*)(ws + WS_X2))
#define U ((bf16*)(ws + WS_U))
#define Rr ((float*)(ws + WS_R))
#define KRAW ((float*)(ws + WS_KRAW))
#define Vv ((float*)(ws + WS_V))
#define KKN ((float*)(ws + WS_KKN))
#define WD ((float*)(ws + WS_WD))
#define AA ((float*)(ws + WS_AA))
#define GG ((float*)(ws + WS_G))
#define LA ((float*)(ws + WS_LA))
#define LB ((float*)(ws + WS_LB))
#define AP ((bf16*)(ws + WS_AP))
#define CAT ((bf16*)(ws + WS_CAT))
#define Qb ((bf16*)(ws + WS_Q))
#define Ob CAT
#define XS ((bf16*)(ws + WS_XS))
#define ACT ((bf16*)(ws + WS_ACT))
#define YS ((bf16*)(ws + WS_YS))
#define route_e ((int*)(ws + WS_ROUTE + RT_E))
#define route_pos ((int*)(ws + WS_ROUTE + RT_POS))
#define route_g ((float*)(ws + WS_ROUTE + RT_G))
#define row_slot ((int*)(ws + WS_ROUTE + RT_SLOT))
#define row_gate ((float*)(ws + WS_ROUTE + RT_GATE))
#define tile_tab ((int*)(ws + WS_ROUTE + RT_TILE))
#define ecnt (ctl + CW_CNT)

    if (IN(0)) { PHASE_IDS;
        LAS float* scr = (LAS float*)(lds + wave * 16384);
        constexpr int I_IN = 16 * (INW / 32), I_SQ = 16 * 32, I_GU = 16 * 64, I_DN = 16 * 32;
        constexpr int N_ITEMS = I_IN + 5 * I_SQ + NE * I_GU + NE * I_DN;
        for (int it = gw; it < N_ITEMS; it += NGW) {
            int r = it;
            if (r < I_IN) { const int nblk = INW / 32, kb = r / nblk, nb = r % nblk; transpose_item(args.in[I_WIN], INW, D, Win_t, 64 * kb, 32 * nb, 32 * nb, scr, lane); continue; } r -= I_IN;
            if (r < 5 * I_SQ) { const int w = r / I_SQ, q = r % I_SQ, kb = q / 32, nb = q % 32;
                const float* src = w == 0 ? args.in[I_WOUT] : w == 1 ? args.in[I_WQ] : w == 2 ? args.in[I_WK] : w == 3 ? args.in[I_WV] : args.in[I_WO];
                bf16* dst = w == 0 ? Wout_t : w == 1 ? Wq_t : w == 2 ? Wk_t : w == 3 ? Wv_t : Wo_t;
                transpose_item(src, D, D, dst, 64 * kb, 32 * nb, 32 * nb, scr, lane); continue; } r -= 5 * I_SQ;
            if (r < NE * I_GU) { const int e = r / I_GU, q = r % I_GU, kb = q / 64, nb = q % 64; const int n0 = 32 * nb;
                const int drow = n0 < 1024 ? (256 * (n0 >> 7) + (n0 & 127)) : (256 * ((n0 - 1024) >> 7) + 128 + ((n0 - 1024) & 127));
                transpose_item(args.in[I_WGU] + (size_t)e * D * 2048, 2048, D, Wgu_t + (size_t)e * 2048 * D, 64 * kb, n0, drow, scr, lane); continue; } r -= NE * I_GU;
            { const int e = r / I_DN, q = r % I_DN, kb = q / 32, nb = q % 32;
              transpose_item(args.in[I_WDN] + (size_t)e * DFF * D, D, DFF, Wdn_t + (size_t)e * D * DFF, 64 * kb, 32 * nb, 32 * nb, scr, lane); }
        }
        for (int idx = bid * NTHREADS + tid; idx < 1536 * 256; idx += G * NTHREADS) {
            const int n = idx >> 8, k = idx & 255; float v = 0.f;
            if (n < 512) { if (k < 64) v = args.in[I_WUP][k * 512 + n]; }
            else if (n < 1024) { if (k >= 64 && k < 128) v = args.in[I_AUP][(k - 64) * 512 + (n - 512)]; }
            else { if (k >= 128) v = args.in[I_GUP][(k - 128) * 512 + (n - 1024)]; }
            LoraB[idx] = (bf16)f2bf(v);
        }
        for (int idx = bid * NTHREADS + tid; idx < 8 * 128 * 64; idx += G * NTHREADS) {
            const int nb = idx >> 13, col = (idx >> 6) & 127, k = idx & 63;
            const float v = col < 64 ? args.in[I_LWX][nb * 4096 + k * 64 + col] : args.in[I_LWA][nb * 4096 + k * 64 + (col - 64)];
            LruW[idx] = (bf16)f2bf(v);
        }
        for (int m = gw; m < M; m += NGW) rms_row_to_bf16(args.in[I_X] + (size_t)m * D, args.in[I_NMIXG], HN + (size_t)m * D, lane);
        for (int m = gw; m < MROWS; m += NGW) rms_row_to_bf16(args.in[I_MEM] + (size_t)m * D, args.in[I_NMEMG], MEMN + (size_t)m * D, lane);
    }
    SEAM(0);

    if (IN(1)) { PHASE_IDS;
        { pg8::DenseSched S; S.o.init_tiles(M / 256, INW / 256, G, bid); S.A = (const char*)HN; S.B = (const char*)Win_t; S.tstep = (size_t)256 * D * 2;
          EpiBf16Plain E{U, INW, 1.0f}; pg8::gemm_phase(lds, D, S, E); }
        { pg8::DenseSched S; S.o.init_tiles(MROWS / 256, D / 256, G, (bid + 64) & (G - 1)); S.A = (const char*)MEMN; S.B = (const char*)Wk_t; S.tstep = (size_t)256 * D * 2;
          EpiBf16Plain E{KM, D, 1.0f}; pg8::gemm_phase(lds, D, S, E); }
        { pg8::DenseSched S; S.o.init_tiles(D / 256, MROWS / 256, G, (bid + 48) & (G - 1)); S.A = (const char*)Wv_t; S.B = (const char*)MEMN; S.tstep = (size_t)256 * D * 2;
          EpiBf16Plain E{VT, MROWS, 1.0f}; pg8::gemm_phase(lds, D, S, E); }
    }
    SEAM(1);

    if (IN(2)) { PHASE_IDS;
        const float* mu = args.in[I_MU]; const float* k_k = args.in[I_KK];
        for (int m = gw; m < M; m += NGW) {
            const bool hp = (m & (SEQ - 1)) != 0;
            const bf16* ur = U + (size_t)m * INW + 1024; const bf16* up = ur - INW;
#pragma unroll
            for (int j = 0; j < 7; ++j) {
                const int c = 4 * (64 * j + lane);
                const u32x2 cu = *(const u32x2*)(ur + c); u32x2 pu = (u32x2){0u, 0u}; if (hp) pu = *(const u32x2*)(up + c);
                const f32x4 m4 = *(const f32x4*)(mu + c);
                f32x4 uu; { const float a0 = bflo(cu.x), a1 = bfhi(cu.x), a2 = bflo(cu.y), a3 = bfhi(cu.y), p0 = bflo(pu.x), p1 = bfhi(pu.x), p2 = bflo(pu.y), p3 = bfhi(pu.y);
                    uu.x = a0 + (p0 - a0) * m4.x; uu.y = a1 + (p1 - a1) * m4.y; uu.z = a2 + (p2 - a2) * m4.z; uu.w = a3 + (p3 - a3) * m4.w; }
                if (j < 2) { *(f32x4*)(Rr + (size_t)m * 512 + c) = uu; }
                else if (j < 4) { const int cc = c - 512; *(f32x4*)(KRAW + (size_t)m * 512 + cc) = uu;
                    const f32x4 kk4 = *(const f32x4*)(k_k + cc); f32x4 kk = uu * kk4; float ss = (kk.x * kk.x + kk.y * kk.y) + (kk.z * kk.z + kk.w * kk.w);
                    ss += __shfl_xor(ss, 1); ss += __shfl_xor(ss, 2); ss += __shfl_xor(ss, 4); ss += __shfl_xor(ss, 8);
                    const float inv = 1.0f / fmaxf(sqrtf(ss), 1e-12f); *(f32x4*)(KKN + (size_t)m * 512 + cc) = kk * inv; }
                else if (j < 6) { const int cc = c - 1024; *(f32x4*)(Vv + (size_t)m * 512 + cc) = uu; }
                else { f32x4 o = uu;
                    if (lane < 16) { o.x = tanhf(uu.x); o.y = tanhf(uu.y); o.z = tanhf(uu.z); o.w = tanhf(uu.w); }
                    else if (lane >= 32) { o.x = sigmoid_f(uu.x); o.y = sigmoid_f(uu.y); o.z = sigmoid_f(uu.z); o.w = sigmoid_f(uu.w); }
                    u32x2 w; w.x = pk2(o.x, o.y); w.y = pk2(o.z, o.w); *(u32x2*)(AP + (size_t)m * 256 + 4 * lane) = w; }
            }
        }
        {
            const float* conv_w = args.in[I_CONVW]; const float* conv_b = args.in[I_CONVB]; const float* bx = args.in[I_LBX]; const float* ba = args.in[I_LBA]; const float* lam = args.in[I_LAM];
            LAS float* xs = (LAS float*)(lds + wave * 4096);
            const int i = lane & 15, kg = lane >> 4;
            for (int unit = gw; unit < (M / 16) * 2; unit += NGW) {
                const int tile = unit >> 1, nb0 = (unit & 1) * 4, m0 = tile * 16, s0 = m0 & (SEQ - 1);
                for (int nb = nb0; nb < nb0 + 4; ++nb) {
                    bf16x8 af[2];
#pragma unroll
                    for (int ks = 0; ks < 2; ++ks) {
                        const int chb = nb * 64 + 32 * ks + 8 * kg;
                        f32x4 x0 = *(const f32x4*)(conv_b + chb), x1 = *(const f32x4*)(conv_b + chb + 4);
#pragma unroll
                        for (int j = 0; j < 4; ++j) {
                            if (s0 + i - 3 + j >= 0) {
                                const u32x4 uw = *(const u32x4*)(U + (size_t)(m0 + i - 3 + j) * INW + chb);
                                const f32x4 w0 = *(const f32x4*)(conv_w + j * 512 + chb), w1 = *(const f32x4*)(conv_w + j * 512 + chb + 4);
                                x0.x += w0.x * bflo(uw.x); x0.y += w0.y * bfhi(uw.x); x0.z += w0.z * bflo(uw.y); x0.w += w0.w * bfhi(uw.y);
                                x1.x += w1.x * bflo(uw.z); x1.y += w1.y * bfhi(uw.z); x1.z += w1.z * bflo(uw.w); x1.w += w1.w * bfhi(uw.w);
                            }
                        }
                        *(LAS f32x4*)(xs + i * 64 + 32 * ks + 8 * kg) = x0; *(LAS f32x4*)(xs + i * 64 + 32 * ks + 8 * kg + 4) = x1;
                        u32x4 p; p.x = pk2(x0.x, x0.y); p.y = pk2(x0.z, x0.w); p.z = pk2(x1.x, x1.y); p.w = pk2(x1.z, x1.w);
                        af[ks] = __builtin_bit_cast(bf16x8, p);
                    }
                    f32x4 acc[8];
#pragma unroll
                    for (int ct = 0; ct < 8; ++ct) { acc[ct] = (f32x4){0.f, 0.f, 0.f, 0.f};
#pragma unroll
                        for (int ks = 0; ks < 2; ++ks) { const bf16x8 bfr = *(const bf16x8*)(LruW + ((size_t)(nb * 128 + 16 * ct + i) * 64 + 32 * ks + 8 * kg));
                            acc[ct] = __builtin_amdgcn_mfma_f32_16x16x32_bf16(af[ks], bfr, acc[ct], 0, 0, 0); } }
                    asm volatile("s_waitcnt lgkmcnt(0)" ::: "memory");
#pragma unroll
                    for (int ct = 0; ct < 4; ++ct) {
                        const int col = 16 * ct + i, ch = nb * 64 + col;
                        const float bxv = bx[ch], bav = ba[ch], sp = softplus_f(-lam[ch]);
#pragma unroll
                        for (int e = 0; e < 4; ++e) {
                            const int tok = 4 * kg + e;
                            const float gx = sigmoid_f(acc[ct][e] + bxv), ga = sigmoid_f(acc[ct + 4][e] + bav);
                            const float la = -8.0f * ga * sp, a = __expf(la), xcv = xs[tok * 64 + col];
                            const float bt = sqrtf(fmaxf(-expm1f(2.0f * la), 0.f)) * gx * xcv;
                            LA[(size_t)(m0 + tok) * 512 + ch] = a; LB[(size_t)(m0 + tok) * 512 + ch] = bt;
                        }
                    }
                }
            }
        }
    }
    SEAM(2);

    if (IN(3)) { PHASE_IDS;
        pg8::DenseSched S; S.o.init_tiles(M / 256, 1536 / 256, G, bid); S.A = (const char*)AP; S.B = (const char*)LoraB; S.tstep = (size_t)256 * 256 * 2;
        EpiLora E{WD, args.in[I_W0], args.in[I_A0]}; pg8::gemm_phase(lds, 256, S, E);
    }
    SEAM(3);

    if (IN(4)) { PHASE_IDS;
        if (bid < 32) {
            const int b = bid >> 3, h = bid & 7;
            LAS float* buf0 = (LAS float*)lds; LAS float* buf1 = buf0 + 12288; LAS float* ybuf = buf1 + 12288;
            const int tl_ld = tid >> 4, c4 = (tid & 15) * 4;
            const f32x4 ka4 = *(const f32x4*)(args.in[I_KA] + h * 64 + c4);
            const int r8 = lane >> 3, q = lane & 7, vi = 8 * wave + r8;
            const float lng = args.in[I_LNG][h * 64 + lane], lnb = args.in[I_LNB][h * 64 + lane], rkv = args.in[I_RK][h * 64 + lane];
            float s[8];
#pragma unroll
            for (int j = 0; j < 8; ++j) s[j] = 0.f;
            f32x4 rg[6];
#define RW_LOAD(c) do { const size_t off = (size_t)(b * SEQ + (c) * 32 + tl_ld) * 512 + h * 64 + c4; \
                rg[0] = *(const f32x4*)(Rr + off); rg[1] = *(const f32x4*)(WD + off); rg[2] = *(const f32x4*)(KRAW + off); rg[3] = *(const f32x4*)(Vv + off); rg[4] = *(const f32x4*)(KKN + off); rg[5] = *(const f32x4*)(AA + off); } while (0)
#define RW_STASH(buf) do { const int idx = tl_ld * 64 + c4; \
                *(LAS f32x4*)((buf) + idx) = rg[0]; *(LAS f32x4*)((buf) + 2048 + idx) = rg[1]; \
                *(LAS f32x4*)((buf) + 4096 + idx) = rg[2] * (1.0f + (rg[5] - 1.0f) * ka4); *(LAS f32x4*)((buf) + 6144 + idx) = rg[3]; \
                *(LAS f32x4*)((buf) + 8192 + idx) = -rg[4]; *(LAS f32x4*)((buf) + 10240 + idx) = rg[4] * rg[5]; } while (0)
            RW_LOAD(0); RW_STASH(buf0);
            __syncthreads();
            for (int c = 0; c < SEQ / 32; ++c) {
                LAS float* buf = (c & 1) ? buf1 : buf0; LAS float* nbuf = (c & 1) ? buf0 : buf1;
                if (c + 1 < SEQ / 32) RW_LOAD(c + 1);
                for (int tl = 0; tl < 32; ++tl) {
                    const LAS float* base = buf + tl * 64 + 8 * q;
                    const f32x4 r0 = *(const LAS f32x4*)(base), r1 = *(const LAS f32x4*)(base + 4);
                    const f32x4 w0 = *(const LAS f32x4*)(base + 2048), w1 = *(const LAS f32x4*)(base + 2048 + 4);
                    const f32x4 k0 = *(const LAS f32x4*)(base + 4096), k1 = *(const LAS f32x4*)(base + 4096 + 4);
                    const f32x4 n0 = *(const LAS f32x4*)(base + 8192), n1 = *(const LAS f32x4*)(base + 8192 + 4);
                    const f32x4 b0 = *(const LAS f32x4*)(base + 10240), b1 = *(const LAS f32x4*)(base + 10240 + 4);
                    const float vv = buf[6144 + tl * 64 + vi];
                    float sa = ((s[0] * n0.x + s[1] * n0.y) + (s[2] * n0.z + s[3] * n0.w)) + ((s[4] * n1.x + s[5] * n1.y) + (s[6] * n1.z + s[7] * n1.w));
                    sa += __shfl_xor(sa, 1); sa += __shfl_xor(sa, 2); sa += __shfl_xor(sa, 4);
                    s[0] = s[0] * w0.x + sa * b0.x + vv * k0.x; s[1] = s[1] * w0.y + sa * b0.y + vv * k0.y; s[2] = s[2] * w0.z + sa * b0.z + vv * k0.z; s[3] = s[3] * w0.w + sa * b0.w + vv * k0.w;
                    s[4] = s[4] * w1.x + sa * b1.x + vv * k1.x; s[5] = s[5] * w1.y + sa * b1.y + vv * k1.y; s[6] = s[6] * w1.z + sa * b1.z + vv * k1.z; s[7] = s[7] * w1.w + sa * b1.w + vv * k1.w;
                    float y = ((s[0] * r0.x + s[1] * r0.y) + (s[2] * r0.z + s[3] * r0.w)) + ((s[4] * r1.x + s[5] * r1.y) + (s[6] * r1.z + s[7] * r1.w));
                    y += __shfl_xor(y, 1); y += __shfl_xor(y, 2); y += __shfl_xor(y, 4);
                    if (q == 0) ybuf[tl * 64 + vi] = y;
                }
                __syncthreads();
#pragma unroll
                for (int t4 = 0; t4 < 4; ++t4) {
                    const int tl = 4 * wave + t4; const size_t m = (size_t)b * SEQ + c * 32 + tl;
                    const float y = ybuf[tl * 64 + lane];
                    const float mean = wave_sum(y) * (1.0f / 64.0f), d = y - mean, var = wave_sum(d * d) * (1.0f / 64.0f);
                    const float yn = d * (1.0f / sqrtf(var + GN_EPS)) * lng + lnb;
                    const float rr = buf[tl * 64 + lane], kk = buf[4096 + tl * 64 + lane], vv = buf[6144 + tl * 64 + lane];
                    const float bonus = wave_sum(rr * kk * rkv);
                    const float o = (yn + bonus * vv) * GG[m * 512 + h * 64 + lane];
                    CAT[m * 1024 + 512 + h * 64 + lane] = (bf16)f2bf(o);
                }
                if (c + 1 < SEQ / 32) RW_STASH(nbuf);
                __syncthreads();
            }
#undef RW_LOAD
#undef RW_STASH
        } else if (bid < 64) {
            const int idx = bid - 32, b = idx >> 3, cg = idx & 7, ch = cg * 64 + lane;
            LAS float* seg = (LAS float*)lds;
            const size_t mb = (size_t)b * SEQ + wave * 512;
            float A = 1.f, B = 0.f;
#pragma unroll 8
            for (int t = 0; t < 512; ++t) { const float a = LA[(mb + t) * 512 + ch], bt = LB[(mb + t) * 512 + ch]; B = a * B + bt; A *= a; }
            seg[(wave * 64 + lane) * 2] = A; seg[(wave * 64 + lane) * 2 + 1] = B;
            __syncthreads();
            float hst = 0.f;
            for (int sgi = 0; sgi < wave; ++sgi) hst = seg[(sgi * 64 + lane) * 2] * hst + seg[(sgi * 64 + lane) * 2 + 1];
#pragma unroll 8
            for (int t = 0; t < 512; ++t) { const float a = LA[(mb + t) * 512 + ch], bt = LB[(mb + t) * 512 + ch]; hst = a * hst + bt;
                const float g = bf2f(U[(mb + t) * INW + 512 + ch]); CAT[(mb + t) * 1024 + ch] = (bf16)f2bf(hst * gelu_tanh_f(g)); }
            __syncthreads();
        }
    }
    SEAM(4);

    if (IN(5)) { PHASE_IDS;
        pg8::DenseSched S; S.o.init_tiles(M / 256, D / 256, G, bid); S.A = (const char*)CAT; S.B = (const char*)Wout_t; S.tstep = (size_t)256 * D * 2;
        EpiF32Res E{args.in[I_X], X1, D}; pg8::gemm_phase(lds, D, S, E);
    }
    SEAM(5);
    if (IN(6)) { PHASE_IDS; for (int m = gw; m < M; m += NGW) rms_row_to_bf16(X1 + (size_t)m * D, args.in[I_NXAG], HN + (size_t)m * D, lane); }
    SEAM(6);
    if (IN(7)) { PHASE_IDS;
        pg8::DenseSched S; S.o.init_tiles(M / 256, D / 256, G, bid); S.A = (const char*)HN; S.B = (const char*)Wq_t; S.tstep = (size_t)256 * D * 2;
        EpiBf16Plain E{Qb, D, 0.0625f}; pg8::gemm_phase(lds, D, S, E);
    }
    SEAM(7);
    if (IN(8)) { PHASE_IDS;
        const int l15 = lane & 15, g4 = lane >> 4;
        for (int unit = gw; unit < NB * XH * (SEQ / 16); unit += NGW) {
            const int qt16 = unit % (SEQ / 16), bh = unit / (SEQ / 16), h = bh & 3, b = bh >> 2;
            const bf16* qbase = Qb + (size_t)(b * SEQ + qt16 * 16 + l15) * D + h * XHD + 8 * g4;
            const bf16* kbase = KM + (size_t)(b * MEML + l15) * D + h * XHD + 8 * g4;
            f32x4 sc[16];
#pragma unroll
            for (int kt = 0; kt < 16; ++kt) sc[kt] = (f32x4){0.f, 0.f, 0.f, 0.f};
#pragma unroll 1
            for (int ks = 0; ks < 8; ++ks) {
                const bf16x8 q0 = *(const bf16x8*)(qbase + 32 * ks);
                const bf16* kp = kbase + 32 * ks;
#pragma unroll
                for (int kt = 0; kt < 16; ++kt) { const bf16x8 kf = *(const bf16x8*)(kp + (size_t)(16 * kt) * D);
                    sc[kt] = __builtin_amdgcn_mfma_f32_16x16x32_bf16(kf, q0, sc[kt], 0, 0, 0); }
            }
            bf16x8 pf[8];
            {
                float mx = -3.0e38f;
#pragma unroll
                for (int kt = 0; kt < 16; ++kt) mx = fmaxf(mx, fmaxf(fmaxf(sc[kt][0], sc[kt][1]), fmaxf(sc[kt][2], sc[kt][3])));
                mx = fmaxf(mx, __shfl_xor(mx, 16)); mx = fmaxf(mx, __shfl_xor(mx, 32));
                float sum = 0.f;
#pragma unroll
                for (int kt = 0; kt < 16; ++kt) {
#pragma unroll
                    for (int e = 0; e < 4; ++e) { const float p = __expf(sc[kt][e] - mx); sc[kt][e] = p; sum += p; } }
                sum += __shfl_xor(sum, 16); sum += __shfl_xor(sum, 32);
                const float inv = 1.0f / sum;
#pragma unroll
                for (int s2 = 0; s2 < 8; ++s2) { const f32x4 a = sc[2 * s2] * inv, c = sc[2 * s2 + 1] * inv;
                    u32x4 p; p.x = pk2(a[0], a[1]); p.y = pk2(a[2], a[3]); p.z = pk2(c[0], c[1]); p.w = pk2(c[2], c[3]); pf[s2] = __builtin_bit_cast(bf16x8, p); }
            }
            const bf16* vbase = VT + (size_t)(h * XHD + l15) * MROWS + b * MEML + 4 * g4;
            bf16* obase = Ob + (size_t)(b * SEQ + qt16 * 16 + l15) * D + h * XHD + 4 * g4;
#pragma unroll 1
            for (int dt = 0; dt < 16; ++dt) {
                const bf16* vp = vbase + (size_t)(16 * dt) * MROWS;
                f32x4 oc = (f32x4){0.f, 0.f, 0.f, 0.f};
#pragma unroll
                for (int s2 = 0; s2 < 8; ++s2) {
                    const u32x2 v0 = *(const u32x2*)(vp + 32 * s2), v1 = *(const u32x2*)(vp + 32 * s2 + 16);
                    u32x4 vv; vv.x = v0.x; vv.y = v0.y; vv.z = v1.x; vv.w = v1.y; const bf16x8 vf = __builtin_bit_cast(bf16x8, vv);
                    oc = __builtin_amdgcn_mfma_f32_16x16x32_bf16(vf, pf[s2], oc, 0, 0, 0);
                }
                u32x2 w; w.x = pk2(oc[0], oc[1]); w.y = pk2(oc[2], oc[3]);
                *(u32x2*)(obase + 16 * dt) = w;
            }
        }
    }
    SEAM(8);
    if (IN(9)) { PHASE_IDS;
        pg8::DenseSched S; S.o.init_tiles(M / 256, D / 256, G, bid); S.A = (const char*)Ob; S.B = (const char*)Wo_t; S.tstep = (size_t)256 * D * 2;
        EpiF32Res E{X1, X2, D}; pg8::gemm_phase(lds, D, S, E);
    }
    SEAM(9);
    if (IN(10)) { PHASE_IDS;
        LAS float* hs = (LAS float*)(lds + wave * 16384);
        const float* gfn = args.in[I_NFFG]; const float* wr_ = args.in[I_WR]; const float* br = args.in[I_BR];
        const int e = lane & 31, half = lane >> 5;
        for (int grp = gw; grp < M / 4; grp += NGW) {
            const int m0 = grp * 4;
#pragma unroll
            for (int rr = 0; rr < 4; ++rr) {
                const f32x4* xr = (const f32x4*)(X2 + (size_t)(m0 + rr) * D) + lane; const f32x4* gr = (const f32x4*)gfn + lane;
                f32x4 v[4]; float s = 0.f;
#pragma unroll
                for (int j = 0; j < 4; ++j) { v[j] = xr[64 * j]; s += (v[j].x * v[j].x + v[j].y * v[j].y) + (v[j].z * v[j].z + v[j].w * v[j].w); }
                const float rstd = 1.0f / sqrtf(wave_sum(s) * (1.f / D) + EPS);
                u32x2* o8 = (u32x2*)(HN + (size_t)(m0 + rr) * D) + lane;
#pragma unroll
                for (int j = 0; j < 4; ++j) { const f32x4 gg = gr[64 * j]; f32x4 hv = v[j] * rstd * gg; *(LAS f32x4*)(hs + rr * 1024 + 256 * j + 4 * lane) = hv;
                    u32x2 w; w.x = pk2(hv.x, hv.y); w.y = pk2(hv.z, hv.w); o8[64 * j] = w; }
            }
            asm volatile("s_waitcnt lgkmcnt(0)" ::: "memory");
            float lg[4] = {0.f, 0.f, 0.f, 0.f};
#pragma unroll 4
            for (int d = half * 512; d < half * 512 + 512; d += 4) {
                const float w0 = wr_[(d + 0) * 32 + e], w1 = wr_[(d + 1) * 32 + e], w2 = wr_[(d + 2) * 32 + e], w3 = wr_[(d + 3) * 32 + e];
#pragma unroll
                for (int rr = 0; rr < 4; ++rr) { const f32x4 h4 = *(const LAS f32x4*)(hs + rr * 1024 + d); lg[rr] += (h4.x * w0 + h4.y * w1) + (h4.z * w2 + h4.w * w3); }
            }
            const float brv = br[e];
#pragma unroll
            for (int rr = 0; rr < 4; ++rr) {
                float v = lg[rr] + __shfl_xor(lg[rr], 32) + brv;
                float selv[4]; int sele[4];
#pragma unroll
                for (int k = 0; k < 4; ++k) {
                    float mv = v; int mi = e;
#pragma unroll
                    for (int o = 1; o < 32; o <<= 1) { const float ov = __shfl_xor(mv, o); const int oi = __shfl_xor(mi, o); if (ov > mv || (ov == mv && oi < mi)) { mv = ov; mi = oi; } }
                    selv[k] = mv; sele[k] = mi; if (e == mi) v = -3.0e38f;
                }
                const float e1 = __expf(selv[1] - selv[0]), e2 = __expf(selv[2] - selv[0]), e3 = __expf(selv[3] - selv[0]);
                const float inv = 1.0f / (1.0f + e1 + e2 + e3);
                if (lane < 4) {
                    const int me = lane == 0 ? sele[0] : lane == 1 ? sele[1] : lane == 2 ? sele[2] : sele[3];
                    const float mg = (lane == 0 ? 1.0f : lane == 1 ? e1 : lane == 2 ? e2 : e3) * inv;
                    const int pos = (int)atomicAdd(ecnt + me, 1u);
                    const int ai = (m0 + rr) * 4 + lane; route_e[ai] = me; route_pos[ai] = pos; route_g[ai] = mg;
                }
            }
        }
    }
    SEAM(10);
    if (IN(11)) { PHASE_IDS;
        LAS int* pst = (LAS int*)lds;
        if (tid == 0) { int acc = 0; for (int e = 0; e < NE; ++e) { const int c = (int)__hip_atomic_load(ecnt + e, __ATOMIC_RELAXED, __HIP_MEMORY_SCOPE_AGENT); pst[e] = acc; pst[64 + e] = c; acc += (c + 255) & ~255; } pst[32] = acc; }
        __syncthreads();
        for (int t = gw; t < M; t += NGW) {
            int row = 0;
            if (lane < 4) { const int ai = t * 4 + lane; const int e = route_e[ai]; row = pst[e] + route_pos[ai]; row_slot[row] = ai; row_gate[row] = route_g[ai]; }
            const u32x4* src = (const u32x4*)(HN + (size_t)t * D);
            const u32x4 a = src[lane], c = src[64 + lane];
#pragma unroll
            for (int k = 0; k < 4; ++k) { const int rk = __shfl(row, k); u32x4* dst = (u32x4*)(XS + (size_t)rk * D); dst[lane] = a; dst[64 + lane] = c; }
        }
        if (bid < NE) { const int e = bid, c = pst[64 + e], pe = (c + 255) & ~255; for (int p = c + tid; p < pe; p += NTHREADS) { row_slot[pst[e] + p] = -1; row_gate[pst[e] + p] = 0.f; } }
        if (bid == 0 && tid == 0) { int nt = 0; for (int e = 0; e < NE; ++e) { const int n = ((pst[64 + e] + 255) & ~255) >> 8; for (int j = 0; j < n; ++j) tile_tab[16 + nt++] = e; } tile_tab[0] = nt; }
        __syncthreads();
    }
    SEAM(11);
    if (IN(12)) { PHASE_IDS;
        const int ntiles = tile_tab[0];
        pg8::MoeSched S; S.o.init_tiles(ntiles, 2048 / 256, G, bid); S.A = (const char*)XS; S.B = (const char*)Wgu_t; S.tile_e = tile_tab + 16; S.tstep = (size_t)256 * D * 2; S.estep = (size_t)2048 * D * 2;
        EpiSwiglu E{ACT, args.in[I_BGU]}; pg8::gemm_phase(lds, D, S, E);
    }
    SEAM(12);
    if (IN(13)) { PHASE_IDS;
        const int ntiles = tile_tab[0];
        pg8::MoeSched S; S.o.init_tiles(ntiles, D / 256, G, bid); S.A = (const char*)ACT; S.B = (const char*)Wdn_t; S.tile_e = tile_tab + 16; S.tstep = (size_t)256 * DFF * 2; S.estep = (size_t)D * DFF * 2;
        EpiDown E{YS, args.in[I_BDN], row_slot, row_gate}; pg8::gemm_phase(lds, DFF, S, E);
    }
    SEAM(13);
    if (IN(14)) { PHASE_IDS;
        const f32x4* gr = (const f32x4*)args.in[I_FNG] + lane;
        for (int m = gw; m < M; m += NGW) {
            const f32x4* xr = (const f32x4*)(X2 + (size_t)m * D) + lane;
            f32x4 v[4]; float s = 0.f;
#pragma unroll
            for (int j = 0; j < 4; ++j) { v[j] = xr[64 * j];
#pragma unroll
                for (int k = 0; k < 4; ++k) { const u32x2 y = *((const u32x2*)(YS + (size_t)(m * 4 + k) * D) + 64 * j + lane); v[j].x += bflo(y.x); v[j].y += bfhi(y.x); v[j].z += bflo(y.y); v[j].w += bfhi(y.y); }
                s += (v[j].x * v[j].x + v[j].y * v[j].y) + (v[j].z * v[j].z + v[j].w * v[j].w); }
            const float rstd = 1.0f / sqrtf(wave_sum(s) * (1.f / D) + EPS);
            f32x4* o = (f32x4*)(args.out + (size_t)m * D) + lane;
#pragma unroll
            for (int j = 0; j < 4; ++j) o[64 * j] = v[j] * rstd * gr[64 * j];
        }
    }
#undef IN
#undef SEAM
}

constexpr int N_PHASES = 15;
extern "C" void kernel_launch(void* const* d_in, const int* in_sizes, int n_in, void* d_out, int out_size, void* d_ws, size_t ws_size, hipStream_t stream) {
    static int grid = 0;
    if (grid == 0) {
        if (n_in != 37 || out_size != M * D || ws_size < WS_END) { fprintf(stderr, "kernel_launch: unexpected shapes (n_in %d, out %d, ws %zu); nothing launched\n", n_in, out_size, ws_size); grid = -1; return; }
        int dev = 0, cus = 0, per_cu = 0;
        if (hipGetDevice(&dev) != hipSuccess || hipDeviceGetAttribute(&cus, hipDeviceAttributeMultiprocessorCount, dev) != hipSuccess) { grid = -1; return; }
        if (hipFuncSetAttribute((const void*)fwd, hipFuncAttributeMaxDynamicSharedMemorySize, LDS_BYTES) != hipSuccess) { fprintf(stderr, "kernel_launch: hipFuncSetAttribute failed\n"); grid = -1; return; }
        if (hipOccupancyMaxActiveBlocksPerMultiprocessor(&per_cu, (const void*)fwd, NTHREADS, LDS_BYTES) != hipSuccess || per_cu < 1) fprintf(stderr, "kernel_launch: occupancy query says %d\n", per_cu);
        (void)hipGetLastError();
        grid = cus > 256 ? 256 : cus;
    }
    if (grid < 0) return;
    if (hipMemsetAsync((char*)d_ws + WS_CTL, 0, CTL_ZERO_BYTES, stream) != hipSuccess) return;
    Args a{};
    for (int i = 0; i < 37; ++i) a.in[i] = (const float*)d_in[i];
    a.out = (float*)d_out; a.ws = (unsigned char*)d_ws;
#if MK_ONE_LAUNCH
    a.ph_lo = 0; a.ph_hi = N_PHASES;
    hipLaunchKernelGGL(fwd, dim3(grid), dim3(NTHREADS), LDS_BYTES, stream, a);
#else
    for (int p = 0; p < N_PHASES; ++p) { a.ph_lo = p; a.ph_hi = p + 1; hipLaunchKernelGGL(fwd, dim3(grid), dim3(NTHREADS), LDS_BYTES, stream, a); }
#endif
}
```

```cpp
#include <hip/hip_runtime.h>
#include <cstdio>
#include <cstdint>

#ifndef MK_ONE_LAUNCH
#define MK_ONE_LAUNCH 1
#endif

#define DI __device__ __forceinline__
#define GAS __attribute__((address_space(1)))
#define LAS __attribute__((address_space(3)))
typedef unsigned short bf16;
typedef short bf16x8 __attribute__((ext_vector_type(8)));
typedef float f32x4 __attribute__((ext_vector_type(4)));
typedef float f32x2 __attribute__((ext_vector_type(2)));
typedef unsigned u32x4 __attribute__((ext_vector_type(4)));
typedef unsigned u32x2 __attribute__((ext_vector_type(2)));

constexpr int D = 1024, NB = 4, SEQ = 4096, M = NB * SEQ;
constexpr int MEML = 256, MROWS = NB * MEML;
constexpr int LRU_W = 512, RW = 512, NH = 8, HD = 64;
constexpr int INW = 2816;
constexpr int XH = 4, XHD = 256;
constexpr int NE = 32, TOPK = 4, DFF = 1024;
constexpr int NASSIGN = M * TOPK;
constexpr int MAXTILES = 288, MAXROWS = MAXTILES * 256;
constexpr float EPS = 1e-6f, GN_EPS = 64e-5f;

namespace pg8 {
constexpr int BM = 256, BK = 64, HALF = 128, HTB = HALF * BK * 2, STAGE_BYTES = 8 * HTB, NXCD = 8, WGM = 8;
__host__ __device__ __forceinline__ int lds_byte(int r, int c) { const int st = (r >> 4) * 2 + (c >> 5), rr = r & 15, cc = c & 31, ob = rr * 64 + cc * 2; return st * 1024 + (ob ^ (((ob >> 9) & 1) << 5)); }
__host__ __device__ __forceinline__ void stage_rc(int b, int& R, int& C) { const int st = b / 1024, sb = b % 1024, swz = sb ^ (((sb >> 9) & 1) << 5); R = (st >> 1) * 16 + swz / 64; C = (st & 1) * 32 + (swz % 64) / 2; }
__host__ __device__ __forceinline__ int perm32(int rho) { const int n = rho >> 4, i = rho & 15; return 8 * (i >> 2) + 4 * n + (i & 3); }

struct Unit { int pm, pn, e; };

struct StaticOrder {
    int nM, nN, nwg, G, c;
    __host__ __device__ void init_tiles(int nM_, int nN_, int G_, int c_) { nM = nM_; nN = nN_; nwg = nM * nN; G = G_; c = c_; }
    __host__ __device__ bool next(int i, Unit& u) const {
        const long L = (long)i * G + c; if (L >= nwg) return false;
        int wgid = (int)L; { const int q = nwg / NXCD, r = nwg % NXCD, xcd = wgid % NXCD, off = wgid / NXCD; wgid = (xcd < r ? xcd * (q + 1) : r * (q + 1) + (xcd - r) * q) + off; }
        const int nig = WGM * nN, gid = wgid / nig, fm = gid * WGM, gsz = (nM - fm) < WGM ? (nM - fm) : WGM;
        u.pm = fm + ((wgid % nig) % gsz); u.pn = (wgid % nig) / gsz; u.e = 0; return true;
    }
};
struct DenseSched {
    StaticOrder o; const char* A; const char* B; size_t tstep;
    DI bool next(int i, Unit& u) const { return o.next(i, u); }
    DI const char* a_ptr(const Unit& u) const { return A + (size_t)u.pm * tstep; }
    DI const char* b_ptr(const Unit& u) const { return B + (size_t)u.pn * tstep; }
};
struct MoeSched {
    StaticOrder o; const char* A; const char* B; const int* tile_e; size_t tstep, estep;
    DI bool next(int i, Unit& u) const { if (!o.next(i, u)) return false; u.e = tile_e[u.pm]; return true; }
    DI const char* a_ptr(const Unit& u) const { return A + (size_t)u.pm * tstep; }
    DI const char* b_ptr(const Unit& u) const { return B + (size_t)u.e * estep + (size_t)u.pn * tstep; }
};

DI unsigned cvt_pk_bf16(float lo, float hi) { unsigned r; asm volatile("v_cvt_pk_bf16_f32 %0, %1, %2" : "=v"(r) : "v"(lo), "v"(hi)); return r; }

template <class Epi, class Sched, bool ALIGN_EPI = true, bool SP2 = true>
DI void gemm_phase(LAS unsigned char* lds, const int K, const Sched& S, const Epi& E) {
    const int tid = threadIdx.x, wid = __builtin_amdgcn_readfirstlane(tid >> 6), lane = tid & 63, wr = wid >> 2, wc = wid & 3, fr = lane & 15, fq = lane >> 4;
    const int nt = K / BK;
    unsigned voffA[2], voffB[2];
#pragma unroll
    for (int i = 0; i < 2; ++i) { int R, C; stage_rc(tid * 16 + i * 8192, R, C); const int Rb = Epi::PERM ? ((R & ~31) + perm32(R & 31)) : R;
        voffA[i] = (unsigned)(R * K + C) * 2u; voffB[i] = (unsigned)(Rb * K + C) * 2u; }
    const size_t kstep = (size_t)(BK * 2);
    const size_t hstep = (size_t)HALF * K * 2;
    const unsigned ldsw = (unsigned)wid * 1024u;
    const int aoff = lds_byte(wr * 64 + fr, fq * 8), boff = lds_byte(wc * 32 + fr, fq * 8);
#define PG8_SA(b, h) (((b) * 2 + (h)) * HTB)
#define PG8_SB(b, h) ((4 + (b) * 2 + (h)) * HTB)
#define PG8_STAGE(bufoff, gbase, voff) do { _Pragma("unroll") for (int _i = 0; _i < 2; ++_i) \
        __builtin_amdgcn_global_load_lds((const unsigned*)((const char*)(gbase) + (voff)[_i]), (LAS unsigned*)(lds + (bufoff) + ldsw + _i * 8192), 16, 0, 0); } while (0)
#define PG8_LDA(dst, b, h) do { _Pragma("unroll") for (int m = 0; m < 4; ++m) _Pragma("unroll") for (int k = 0; k < 2; ++k) dst[m][k] = *(const LAS bf16x8*)(lds + PG8_SA(b, h) + aoff + m * 2048 + k * 1024); } while (0)
#define PG8_LDB(dst, b, h) do { _Pragma("unroll") for (int n = 0; n < 2; ++n) _Pragma("unroll") for (int k = 0; k < 2; ++k) dst[n][k] = *(const LAS bf16x8*)(lds + PG8_SB(b, h) + boff + n * 2048 + k * 1024); } while (0)
#define PG8_MMA(ai, bj, At, Bt) do { __builtin_amdgcn_s_setprio(1); _Pragma("unroll") for (int m = 0; m < 4; ++m) _Pragma("unroll") for (int n = 0; n < 2; ++n) _Pragma("unroll") for (int k = 0; k < 2; ++k) \
        acc[ai][bj][m][n] = __builtin_amdgcn_mfma_f32_16x16x32_bf16(Bt[n][k], At[m][k], acc[ai][bj][m][n], 0, 0, 0); __builtin_amdgcn_s_setprio(0); } while (0)
#define PG8_WAIT_V(n) asm volatile("s_waitcnt vmcnt(" #n ")" ::: "memory")
#define PG8_WAIT_L(n) asm volatile("s_waitcnt lgkmcnt(" #n ")" ::: "memory")
#define PG8_BAR __builtin_amdgcn_s_barrier()
#define PG8_SCHED __builtin_amdgcn_sched_barrier(0)
    Unit cur, nxt; int ui = 0;
    if (!S.next(0, cur)) return;
    f32x4 acc[2][2][4][2];
#pragma unroll
    for (int a = 0; a < 2; ++a)
#pragma unroll
        for (int b = 0; b < 2; ++b)
#pragma unroll
            for (int m = 0; m < 4; ++m)
#pragma unroll
                for (int n = 0; n < 2; ++n) acc[a][b][m][n] = (f32x4){0.f, 0.f, 0.f, 0.f};
    bf16x8 At[4][2], B0[2][2], B1[2][2];
    const char* cA = S.a_ptr(cur); const char* cB = S.b_ptr(cur);
    if constexpr (SP2) {
        PG8_STAGE(PG8_SB(0, 0), cB, voffB); PG8_STAGE(PG8_SB(0, 1), cB + hstep, voffB); PG8_STAGE(PG8_SA(0, 0), cA, voffA); PG8_STAGE(PG8_SA(0, 1), cA + hstep, voffA);
        if (wr == 1) PG8_BAR;
        PG8_WAIT_V(2); PG8_BAR;
        PG8_STAGE(PG8_SB(1, 0), cB + kstep, voffB); PG8_STAGE(PG8_SA(1, 0), cA + kstep, voffA); PG8_STAGE(PG8_SB(1, 1), cB + hstep + kstep, voffB);
        PG8_WAIT_V(6); PG8_BAR;
    } else {
        PG8_STAGE(PG8_SB(0, 0), cB, voffB); PG8_STAGE(PG8_SA(0, 0), cA, voffA); PG8_STAGE(PG8_SB(0, 1), cB + hstep, voffB); PG8_STAGE(PG8_SA(0, 1), cA + hstep, voffA);
        if (wr == 1) PG8_BAR;
        PG8_WAIT_V(4); PG8_BAR;
        PG8_STAGE(PG8_SB(1, 0), cB + kstep, voffB); PG8_STAGE(PG8_SA(1, 0), cA + kstep, voffA); PG8_STAGE(PG8_SB(1, 1), cB + hstep + kstep, voffB);
        PG8_WAIT_V(6); PG8_BAR;
    }
    for (;;) {
        const bool has_next = S.next(ui + 1, nxt);
        const char* nA = has_next ? S.a_ptr(nxt) : cA; const char* nB = has_next ? S.b_ptr(nxt) : cB;
        for (int t = 0; t < nt; t += 2) {
            const bool last = (t == nt - 2);
            const char* a1 = cA + (size_t)(t + 1) * kstep;
            const char* a2 = last ? nA : cA + (size_t)(t + 2) * kstep; const char* b2 = last ? nB : cB + (size_t)(t + 2) * kstep;
            const char* a3 = a2 + kstep; const char* b3 = b2 + kstep;
            if constexpr (SP2) {
            PG8_LDB(B0, 0, 0); PG8_LDB(B1, 0, 1); PG8_SCHED; PG8_LDA(At, 0, 0); PG8_STAGE(PG8_SA(1, 1), a1 + hstep, voffA);
            PG8_WAIT_V(8); PG8_WAIT_L(0); PG8_BAR; PG8_MMA(0, 0, At, B0); PG8_MMA(0, 1, At, B1); PG8_BAR; PG8_SCHED;
            PG8_LDA(At, 0, 1); PG8_STAGE(PG8_SB(0, 0), b2, voffB); PG8_STAGE(PG8_SB(0, 1), b2 + hstep, voffB); PG8_STAGE(PG8_SA(0, 0), a2, voffA);
            PG8_WAIT_V(8); PG8_WAIT_L(0); PG8_BAR; PG8_MMA(1, 0, At, B0); PG8_MMA(1, 1, At, B1); PG8_BAR; PG8_SCHED;
            PG8_LDB(B0, 1, 0); PG8_LDB(B1, 1, 1); PG8_SCHED; PG8_LDA(At, 1, 0); PG8_STAGE(PG8_SA(0, 1), a2 + hstep, voffA);
            PG8_WAIT_V(8); PG8_WAIT_L(0); PG8_BAR; PG8_MMA(0, 0, At, B0); PG8_MMA(0, 1, At, B1); PG8_BAR; PG8_SCHED;
            PG8_LDA(At, 1, 1); PG8_STAGE(PG8_SB(1, 0), b3, voffB); PG8_STAGE(PG8_SB(1, 1), b3 + hstep, voffB); PG8_STAGE(PG8_SA(1, 0), a3, voffA);
            PG8_WAIT_V(8); PG8_WAIT_L(0); PG8_BAR; PG8_MMA(1, 0, At, B0); PG8_MMA(1, 1, At, B1); PG8_BAR; PG8_SCHED;
            } else {
            PG8_LDB(B0, 0, 0); PG8_SCHED; PG8_LDA(At, 0, 0); PG8_STAGE(PG8_SA(1, 1), a1 + hstep, voffA);
            PG8_WAIT_L(8); PG8_BAR; PG8_WAIT_L(0); PG8_MMA(0, 0, At, B0); PG8_BAR; PG8_SCHED;
            PG8_LDB(B1, 0, 1); PG8_STAGE(PG8_SB(0, 0), b2, voffB);
            PG8_BAR; PG8_WAIT_L(0); PG8_MMA(0, 1, At, B1); PG8_BAR;
            PG8_LDA(At, 0, 1); PG8_STAGE(PG8_SA(0, 0), a2, voffA);
            PG8_BAR; PG8_WAIT_L(0); PG8_MMA(1, 0, At, B0); PG8_BAR; PG8_SCHED;
            PG8_STAGE(PG8_SB(0, 1), b2 + hstep, voffB);
            PG8_WAIT_V(6); PG8_BAR; PG8_MMA(1, 1, At, B1); PG8_BAR;
            PG8_LDB(B0, 1, 0); PG8_SCHED; PG8_LDA(At, 1, 0); PG8_STAGE(PG8_SA(0, 1), a2 + hstep, voffA);
            PG8_WAIT_L(8); PG8_BAR; PG8_WAIT_L(0); PG8_MMA(0, 0, At, B0); PG8_BAR; PG8_SCHED;
            PG8_LDB(B1, 1, 1); PG8_STAGE(PG8_SB(1, 0), b3, voffB);
            PG8_BAR; PG8_WAIT_L(0); PG8_MMA(0, 1, At, B1); PG8_BAR;
            PG8_LDA(At, 1, 1); PG8_STAGE(PG8_SA(1, 0), a3, voffA);
            PG8_BAR; PG8_WAIT_L(0); PG8_MMA(1, 0, At, B0); PG8_BAR; PG8_SCHED;
            PG8_STAGE(PG8_SB(1, 1), b3 + hstep, voffB);
            PG8_WAIT_V(6); PG8_BAR; PG8_MMA(1, 1, At, B1); PG8_BAR;
            }
        }
        if constexpr (ALIGN_EPI) { if (wr == 0) PG8_BAR; }
        E(acc, cur, wr, wc, fr, fq);
        if (!has_next) break;
#pragma unroll
        for (int a = 0; a < 2; ++a)
#pragma unroll
            for (int b = 0; b < 2; ++b)
#pragma unroll
                for (int m = 0; m < 4; ++m)
#pragma unroll
                    for (int n = 0; n < 2; ++n) acc[a][b][m][n] = (f32x4){0.f, 0.f, 0.f, 0.f};
        cur = nxt; cA = nA; cB = nB; ++ui;
        if constexpr (ALIGN_EPI) { if (wr == 1) PG8_BAR; }
    }
    PG8_WAIT_V(0);
    if constexpr (!ALIGN_EPI) { if (wr == 0) PG8_BAR; }
    PG8_BAR;
#undef PG8_SA
#undef PG8_SB
#undef PG8_STAGE
#undef PG8_LDA
#undef PG8_LDB
#undef PG8_MMA
#undef PG8_WAIT_V
#undef PG8_WAIT_L
#undef PG8_BAR
#undef PG8_SCHED
}
}
using pg8::Unit;
using pg8::cvt_pk_bf16;

DI float bflo(unsigned w) { return __uint_as_float(w << 16); }
DI float bfhi(unsigned w) { return __uint_as_float(w & 0xffff0000u); }
DI float bf2f(bf16 b) { return __uint_as_float(((unsigned)b) << 16); }
DI unsigned f2bf(float f) { unsigned u = __float_as_uint(f); return (u + 0x7fffu + ((u >> 16) & 1u)) >> 16; }
DI unsigned pk2(float lo, float hi) { return f2bf(lo) | (f2bf(hi) << 16); }
DI float sigmoid_f(float x) { return 1.0f / (1.0f + __expf(-x)); }
DI float softplus_f(float x) { return fmaxf(x, 0.f) + log1pf(__expf(-fabsf(x))); }
DI float softplus_fast(float x) { return fmaxf(x, 0.f) + __logf(1.0f + __expf(-fabsf(x))); }
DI float gelu_tanh_f(float x) { const float u = 0.7978845608028654f * (x + 0.044715f * x * x * x); return 0.5f * x * (1.0f + tanhf(u)); }
DI int fresh_tid() { int t = threadIdx.x; asm volatile("" : "+v"(t)); return t; }
DI float wave_sum(float v) {
#pragma unroll
    for (int o = 1; o < 64; o <<= 1) v += __shfl_xor(v, o);
    return v;
}

struct EpiBf16Plain {
    static constexpr bool PERM = true;
    bf16* O; int ldc; float scale;
    DI void operator()(const f32x4 (&acc)[2][2][4][2], const Unit& u, int wr, int wc, int fr, int fq) const {
        const int row0 = u.pm * 256 + wr * 64 + fr, col0 = u.pn * 256 + wc * 32 + 8 * fq;
#pragma unroll
        for (int ai = 0; ai < 2; ++ai)
#pragma unroll
            for (int m = 0; m < 4; ++m) { bf16* rowp = O + (size_t)(row0 + ai * 128 + m * 16) * ldc + col0;
#pragma unroll
                for (int bj = 0; bj < 2; ++bj) { const f32x4 v0 = acc[ai][bj][m][0] * scale, v1 = acc[ai][bj][m][1] * scale;
                    u32x4 w; w.x = cvt_pk_bf16(v0[0], v0[1]); w.y = cvt_pk_bf16(v0[2], v0[3]); w.z = cvt_pk_bf16(v1[0], v1[1]); w.w = cvt_pk_bf16(v1[2], v1[3]);
                    *(u32x4*)(rowp + bj * 128) = w; } }
    }
};
struct EpiF32Res {
    static constexpr bool PERM = false;
    const float* Rz; float* C; int ldc;
    DI void operator()(const f32x4 (&acc)[2][2][4][2], const Unit& u, int wr, int wc, int fr, int fq) const {
        const int row0 = u.pm * 256 + wr * 64 + fr, col0 = u.pn * 256 + wc * 32 + 4 * fq;
#pragma unroll
        for (int ai = 0; ai < 2; ++ai)
#pragma unroll
            for (int m = 0; m < 4; ++m) { const size_t off = (size_t)(row0 + ai * 128 + m * 16) * ldc + col0;
#pragma unroll
                for (int bj = 0; bj < 2; ++bj)
#pragma unroll
                    for (int n = 0; n < 2; ++n) { const f32x4 r = *(const f32x4*)(Rz + off + bj * 128 + n * 16); *(f32x4*)(C + off + bj * 128 + n * 16) = r + acc[ai][bj][m][n]; } }
    }
};
struct EpiLora {
    static constexpr bool PERM = false;
    float* WD3; const float* w0; const float* a0;
    DI void operator()(const f32x4 (&acc)[2][2][4][2], const Unit& u, int wr, int wc, int fr, int fq) const {
        const int kind = u.pn >> 1;
        const int row0 = u.pm * 256 + wr * 64 + fr, col0 = (u.pn & 1) * 256 + wc * 32 + 4 * fq;
        float* dst = WD3 + (size_t)kind * (size_t)(8u << 20);
#pragma unroll
        for (int bj = 0; bj < 2; ++bj)
#pragma unroll
            for (int n = 0; n < 2; ++n) {
                const int c = col0 + bj * 128 + n * 16;
                f32x4 bias = (f32x4){0.f, 0.f, 0.f, 0.f};
                if (kind == 0) bias = *(const f32x4*)(w0 + c); else if (kind == 1) bias = *(const f32x4*)(a0 + c);
#pragma unroll
                for (int ai = 0; ai < 2; ++ai)
#pragma unroll
                    for (int m = 0; m < 4; ++m) {
                        f32x4 v = acc[ai][bj][m][n] + bias;
                        if (kind == 0) {
#pragma unroll
                            for (int j = 0; j < 4; ++j) { const float w = -softplus_fast(-v[j]) - 0.5f; v[j] = -__expf(w);     }
                        } else if (kind == 1) {
#pragma unroll
                            for (int j = 0; j < 4; ++j) v[j] = sigmoid_f(v[j]);
                        }
                        *(f32x4*)(dst + (size_t)(row0 + ai * 128 + m * 16) * 512 + c) = v;
                    }
            }
    }
};
struct EpiSwiglu {
    static constexpr bool PERM = true;
    bf16* ACT; const float* b_gu;
    DI void operator()(const f32x4 (&acc)[2][2][4][2], const Unit& u, int wr, int wc, int fr, int fq) const {
        const int row0 = u.pm * 256 + wr * 64 + fr, j0 = u.pn * 128 + wc * 32 + 8 * fq;
        const float* bg = b_gu + (size_t)u.e * 2048 + j0; const float* bu = bg + 1024;
        const f32x4 bg0 = *(const f32x4*)bg, bg1 = *(const f32x4*)(bg + 4), bu0 = *(const f32x4*)bu, bu1 = *(const f32x4*)(bu + 4);
#pragma unroll
        for (int ai = 0; ai < 2; ++ai)
#pragma unroll
            for (int m = 0; m < 4; ++m) {
                float o[8];
#pragma unroll
                for (int n = 0; n < 2; ++n) { const f32x4 g4 = acc[ai][0][m][n] + (n ? bg1 : bg0), u4 = acc[ai][1][m][n] + (n ? bu1 : bu0);
#pragma unroll
                    for (int j = 0; j < 4; ++j) { const float g = fminf(g4[j], 7.0f), up = fminf(fmaxf(u4[j], -7.0f), 7.0f); o[n * 4 + j] = (up + 1.0f) * (g * sigmoid_f(1.702f * g)); } }
                u32x4 w; w.x = cvt_pk_bf16(o[0], o[1]); w.y = cvt_pk_bf16(o[2], o[3]); w.z = cvt_pk_bf16(o[4], o[5]); w.w = cvt_pk_bf16(o[6], o[7]);
                *(u32x4*)(ACT + (size_t)(row0 + ai * 128 + m * 16) * 1024 + j0) = w;
            }
    }
};
struct EpiDown {
    static constexpr bool PERM = true;
    bf16* YS; const float* b_dn; const int* row_slot; const float* row_gate;
    DI void operator()(const f32x4 (&acc)[2][2][4][2], const Unit& u, int wr, int wc, int fr, int fq) const {
        const int row0 = u.pm * 256 + wr * 64 + fr, col0 = u.pn * 256 + wc * 32 + 8 * fq;
        const float* bb = b_dn + (size_t)u.e * 1024 + col0;
        f32x4 bv[2][2];
#pragma unroll
        for (int bj = 0; bj < 2; ++bj)
#pragma unroll
            for (int n = 0; n < 2; ++n) bv[bj][n] = *(const f32x4*)(bb + bj * 128 + 4 * n);
#pragma unroll
        for (int ai = 0; ai < 2; ++ai)
#pragma unroll
            for (int m = 0; m < 4; ++m) {
                const int r = row0 + ai * 128 + m * 16; const int slot = row_slot[r]; const float gt = row_gate[r];
                if (slot >= 0) { bf16* rowp = YS + (size_t)slot * 1024 + col0;
#pragma unroll
                    for (int bj = 0; bj < 2; ++bj) { const f32x4 v0 = (acc[ai][bj][m][0] + bv[bj][0]) * gt, v1 = (acc[ai][bj][m][1] + bv[bj][1]) * gt;
                        u32x4 w; w.x = cvt_pk_bf16(v0[0], v0[1]); w.y = cvt_pk_bf16(v0[2], v0[3]); w.z = cvt_pk_bf16(v1[0], v1[1]); w.w = cvt_pk_bf16(v1[2], v1[3]);
                        *(u32x4*)(rowp + bj * 128) = w; } }
            }
    }
};

constexpr size_t MiB = 1u << 20;
constexpr size_t WS_CTL = 0, CTL_ZERO_BYTES = 1 * MiB;
constexpr size_t WS_WIN = 1 * MiB, WS_WOUT = 7 * MiB, WS_WQ = 9 * MiB, WS_WK = 11 * MiB, WS_WV = 13 * MiB, WS_WO = 15 * MiB, WS_LORAB = 17 * MiB, WS_LRUW = 18 * MiB;
constexpr size_t WS_ROUTE = 19 * MiB;
constexpr size_t WS_WGU = 22 * MiB, WS_WDN = 150 * MiB;
constexpr size_t WS_HN = 214 * MiB, WS_MEMN = 246 * MiB, WS_KM = 248 * MiB, WS_VT = 250 * MiB;
constexpr size_t WS_X1 = 252 * MiB, WS_X2 = 316 * MiB;
constexpr size_t WS_U = 380 * MiB, WS_R = 468 * MiB, WS_KRAW = 500 * MiB, WS_V = 532 * MiB, WS_KKN = 564 * MiB, WS_WD = 596 * MiB, WS_AA = 628 * MiB, WS_G = 660 * MiB;
constexpr size_t WS_LA = 692 * MiB, WS_LB = 724 * MiB, WS_AP = 756 * MiB, WS_CAT = 764 * MiB, WS_Q = 796 * MiB;
constexpr size_t WS_XS = 380 * MiB, WS_ACT = 524 * MiB, WS_YS = 668 * MiB;
constexpr size_t WS_GP = 796 * MiB, WS_HF = 860 * MiB, WS_RP = 924 * MiB, WS_Y1F = 940 * MiB, WS_ADD = 972 * MiB, WS_END = 1004 * MiB;
constexpr size_t WS_GC = 468 * MiB, WS_HC = 484 * MiB, WS_ZS = 500 * MiB;
static_assert(WS_AA == WS_WD + 32 * MiB && WS_G == WS_AA + 32 * MiB, "EpiLora strides");
static_assert(WS_U + (size_t)M * INW * 2 <= WS_R && WS_XS + (size_t)MAXROWS * 2048 <= WS_ACT && WS_ACT + (size_t)MAXROWS * 2048 <= WS_YS && WS_YS + (size_t)NASSIGN * 2048 <= WS_Q, "ws map");
constexpr size_t RT_E = 0, RT_POS = 256 * 1024, RT_G = 512 * 1024, RT_SLOT = 768 * 1024, RT_GATE = 1088 * 1024, RT_TILE = 1408 * 1024;
constexpr int CW_BAR = 4096, CW_CNT = 8192;

constexpr int RING_BYTES = 131072, MISC_OFF = RING_BYTES + 320, LDS_BYTES = 147456;
constexpr int NWAVES = 8, NTHREADS = 512;

#define XB_TMO      128
#define XB_XCNT(j)  (256  + 64 * (j))
#define XB_XSUB(j)  (1280 + 64 * (j))
#define XB_XGEN(j)  (2304 + 64 * (j))
#define XB_TOP      3328
#define XB_TOPGEN   3392
#define XCD_BAR_WORDS 3456
#define XB_SPIN_CAP (1u << 18)
DI unsigned xb_ld(unsigned* p)              { return __hip_atomic_load(p, __ATOMIC_RELAXED, __HIP_MEMORY_SCOPE_AGENT); }
DI unsigned xb_add(unsigned* p, unsigned v) { return __hip_atomic_fetch_add(p, v, __ATOMIC_RELAXED, __HIP_MEMORY_SCOPE_AGENT); }
DI unsigned xb_xcc_id() { return (unsigned)__builtin_amdgcn_s_getreg((3 << 11) | 20) & 0xFu; }
#define XB_SPIN(cond, bar) do { unsigned _sp = 0; while (cond) { __builtin_amdgcn_s_sleep(1); \
    if ((++_sp & 255u) == 0u) { if (xb_ld(&(bar)[XB_TMO])) break; if (_sp > XB_SPIN_CAP) { atomicAdd(&(bar)[XB_TMO], 1u); break; } } } } while (0)
struct XcdBarrier { unsigned* bar; unsigned x; volatile LAS unsigned* st; };
DI XcdBarrier xcd_barrier_post(unsigned* bar, volatile LAS unsigned* st) {
    XcdBarrier b; b.bar = bar; b.x = xb_xcc_id(); b.st = st;
    if (threadIdx.x == 0) (void)xb_add(&bar[XB_XCNT(b.x)], 1u);
    return b;
}
DI void xcd_barrier_complete(unsigned* bar, unsigned x, unsigned& nloc, unsigned& nx) {
    const unsigned G = gridDim.x * gridDim.y * gridDim.z;
    unsigned sum, cnt, mine, sp = 0u;
    for (;;) {
        sum = 0u; cnt = 0u; mine = 0u;
#pragma unroll
        for (unsigned j = 0; j < 16; ++j) { const unsigned c = xb_ld(&bar[XB_XCNT(j)]); sum += c; cnt += (c > 0u) ? 1u : 0u; mine = (j == x) ? c : mine; }
        if (sum == G) break;
        __builtin_amdgcn_s_sleep(1);
        if ((++sp & 255u) == 0u) { if (xb_ld(&bar[XB_TMO])) break; if (sp > XB_SPIN_CAP) { atomicAdd(&bar[XB_TMO], 1u); break; } }
    }
    nloc = mine > 0u ? mine : 1u; nx = cnt > 0u ? cnt : 1u;
}
DI void xcd_barrier(const XcdBarrier& b) {
    asm volatile("s_waitcnt vmcnt(0)" ::: "memory");
    __syncthreads();
    if (threadIdx.x == 0) {
        unsigned* bar = b.bar;
        __builtin_amdgcn_s_waitcnt(0);
        unsigned nloc = b.st[0], nx = b.st[1];
        if (nloc == 0u) { xcd_barrier_complete(bar, b.x, nloc, nx); b.st[0] = nloc; b.st[1] = nx; }
        const unsigned old = xb_add(&bar[XB_XSUB(b.x)], 1u);
        const unsigned gen = old / nloc;
        if (old + 1u == (gen + 1u) * nloc) {
            __builtin_amdgcn_fence(__ATOMIC_RELEASE, "agent");
            asm volatile("s_waitcnt vmcnt(0)" ::: "memory");
            const unsigned og = xb_add(&bar[XB_TOP], 1u);
            const unsigned tg = og / nx;
            if (og + 1u == (tg + 1u) * nx) xb_add(&bar[XB_TOPGEN], 1u);
            else XB_SPIN(xb_ld(&bar[XB_TOPGEN]) == tg, bar);
            __builtin_amdgcn_fence(__ATOMIC_ACQUIRE, "agent");
            xb_add(&bar[XB_XGEN(b.x)], 1u);
            asm volatile("s_waitcnt vmcnt(0)" ::: "memory");
        } else {
            XB_SPIN(xb_ld(&bar[XB_XGEN(b.x)]) == gen, bar);
            __builtin_amdgcn_fence(__ATOMIC_ACQUIRE, "agent");
            asm volatile("s_waitcnt vmcnt(0)" ::: "memory");
        }
    }
    __syncthreads();
}

struct Args { const float* in[37]; float* out; unsigned char* ws; int ph_lo, ph_hi; };
enum { I_X = 0, I_MEM, I_NMIXG, I_WIN, I_CONVW, I_CONVB, I_LWX, I_LBX, I_LWA, I_LBA, I_LAM, I_MU, I_W0, I_WUP, I_A0, I_AUP, I_GUP, I_KK, I_KA, I_RK, I_LNG, I_LNB,
       I_WOUT, I_NXAG, I_NMEMG, I_WQ, I_WK, I_WV, I_WO, I_NFFG, I_WR, I_BR, I_WGU, I_BGU, I_WDN, I_BDN, I_FNG };

DI void transpose_item(const float* W, int ldw, int K, bf16* WT, int k0, int n0, int drow0, LAS float* scr, int lane) {
#pragma unroll 8
    for (int i = 0; i < 32; ++i) { const int kk = 2 * i + (lane >> 5); scr[kk * 33 + (lane & 31)] = W[(size_t)(k0 + kk) * ldw + n0 + (lane & 31)]; }
    asm volatile("s_waitcnt lgkmcnt(0)" ::: "memory");
    const int c = lane & 7;
#pragma unroll
    for (int j = 0; j < 4; ++j) { const int n = (lane >> 3) + 8 * j; const LAS float* s = scr + (8 * c) * 33 + n;
        u32x4 o; o.x = pk2(s[0 * 33], s[1 * 33]); o.y = pk2(s[2 * 33], s[3 * 33]); o.z = pk2(s[4 * 33], s[5 * 33]); o.w = pk2(s[6 * 33], s[7 * 33]);
        *(u32x4*)(WT + (size_t)(drow0 + n) * K + k0 + 8 * c) = o; }
    asm volatile("s_waitcnt lgkmcnt(0)" ::: "memory");
}
DI void rms_row_to_bf16(const float* xrow, const float* g, bf16* orow, int lane) {
    const f32x4* xr = (const f32x4*)xrow + lane; const f32x4* gr = (const f32x4*)g + lane;
    f32x4 v[4]; float s = 0.f;
#pragma unroll
    for (int j = 0; j < 4; ++j) { v[j] = xr[64 * j]; s += (v[j].x * v[j].x + v[j].y * v[j].y) + (v[j].z * v[j].z + v[j].w * v[j].w); }
    const float rstd = 1.0f / sqrtf(wave_sum(s) * (1.f / D) + EPS);
    u32x2* o8 = (u32x2*)orow + lane;
#pragma unroll
    for (int j = 0; j < 4; ++j) { const f32x4 gg = gr[64 * j]; u32x2 w; w.x = pk2(v[j].x * rstd * gg.x, v[j].y * rstd * gg.y); w.y = pk2(v[j].z * rstd * gg.z, v[j].w * rstd * gg.w); o8[64 * j] = w; }
}

__global__ void __launch_bounds__(NTHREADS, 2) fwd(Args args) {
    extern __shared__ __attribute__((aligned(16))) unsigned char lds_raw[];
    LAS unsigned char* lds = (LAS unsigned char*)lds_raw;
    volatile LAS unsigned* MISC = (volatile LAS unsigned*)(lds + MISC_OFF);
    const int G = gridDim.x, bid = blockIdx.x, NGW = G * NWAVES;
#define PHASE_IDS const int tid = fresh_tid(), lane = tid & 63, wave = __builtin_amdgcn_readfirstlane(tid >> 6), gw = bid * NWAVES + wave; (void)tid; (void)lane; (void)wave; (void)gw
    unsigned char* ws = args.ws;
    unsigned* ctl = (unsigned*)(ws + WS_CTL);
    const int lo = args.ph_lo, hi = args.ph_hi;

    for (int u = threadIdx.x; u < (LDS_BYTES - RING_BYTES) / 4; u += NTHREADS) ((LAS unsigned*)(lds + RING_BYTES))[u] = 0u;
    __syncthreads();
    XcdBarrier bar; bar.bar = ctl + CW_BAR; bar.x = 0; bar.st = nullptr;
    if (hi - lo > 1) bar = xcd_barrier_post(ctl + CW_BAR, MISC + 8);
#define IN(k) (lo <= (k) && (k) < hi)
#define SEAM(k) do { if (IN(k) && IN((k) + 1)) xcd_barrier(bar); } while (0)

#define Win_t ((bf16*)(ws + WS_WIN))
#define Wout_t ((bf16*)(ws + WS_WOUT))
#define Wq_t ((bf16*)(ws + WS_WQ))
#define Wk_t ((bf16*)(ws + WS_WK))
#define Wv_t ((bf16*)(ws + WS_WV))
#define Wo_t ((bf16*)(ws + WS_WO))
#define LoraB ((bf16*)(ws + WS_LORAB))
#define LruW ((bf16*)(ws + WS_LRUW))
#define Wgu_t ((bf16*)(ws + WS_WGU))
#define Wdn_t ((bf16*)(ws + WS_WDN))
#define HN ((bf16*)(ws + WS_HN))
#define MEMN ((bf16*)(ws + WS_MEMN))
#define KM ((bf16*)(ws + WS_KM))
#define VT ((bf16*)(ws + WS_VT))
#define X1 ((float*)(ws + WS_X1))
#define X2 ((float*)(ws + WS_X2))
#define U ((bf16*)(ws + WS_U))
#define Rr ((float*)(ws + WS_R))
#define KRAW ((float*)(ws + WS_KRAW))
#define Vv ((float*)(ws + WS_V))
#define KKN ((float*)(ws + WS_KKN))
#define WD ((float*)(ws + WS_WD))
#define AA ((float*)(ws + WS_AA))
#define GG ((float*)(ws + WS_G))
#define LA ((float*)(ws + WS_LA))
#define LB ((float*)(ws + WS_LB))
#define AP ((bf16*)(ws + WS_AP))
#define CAT ((bf16*)(ws + WS_CAT))
#define Qb ((bf16*)(ws + WS_Q))
#define Ob CAT
#define XS ((bf16*)(ws + WS_XS))
#define ACT ((bf16*)(ws + WS_ACT))
#define YS ((bf16*)(ws + WS_YS))
#define route_e ((int*)(ws + WS_ROUTE + RT_E))
#define route_pos ((int*)(ws + WS_ROUTE + RT_POS))
#define route_g ((float*)(ws + WS_ROUTE + RT_G))
#define row_slot ((int*)(ws + WS_ROUTE + RT_SLOT))
#define row_gate ((float*)(ws + WS_ROUTE + RT_GATE))
#define tile_tab ((int*)(ws + WS_ROUTE + RT_TILE))
#define ecnt (ctl + CW_CNT)

    if (IN(0)) { PHASE_IDS;
        LAS float* scr = (LAS float*)(lds + wave * 16384);
        constexpr int I_IN = 16 * (INW / 32), I_SQ = 16 * 32, I_GU = 16 * 64, I_DN = 16 * 32;
        constexpr int N_ITEMS = I_IN + 5 * I_SQ + NE * I_GU + NE * I_DN;
        for (int it = gw; it < N_ITEMS; it += NGW) {
            int r = it;
            if (r < I_IN) { const int nblk = INW / 32, kb = r / nblk, nb = r % nblk; transpose_item(args.in[I_WIN], INW, D, Win_t, 64 * kb, 32 * nb, 32 * nb, scr, lane); continue; } r -= I_IN;
            if (r < 5 * I_SQ) { const int w = r / I_SQ, q = r % I_SQ, kb = q / 32, nb = q % 32;
                const float* src = w == 0 ? args.in[I_WOUT] : w == 1 ? args.in[I_WQ] : w == 2 ? args.in[I_WK] : w == 3 ? args.in[I_WV] : args.in[I_WO];
                bf16* dst = w == 0 ? Wout_t : w == 1 ? Wq_t : w == 2 ? Wk_t : w == 3 ? Wv_t : Wo_t;
                transpose_item(src, D, D, dst, 64 * kb, 32 * nb, 32 * nb, scr, lane); continue; } r -= 5 * I_SQ;
            if (r < NE * I_GU) { const int e = r / I_GU, q = r % I_GU, kb = q / 64, nb = q % 64; const int n0 = 32 * nb;
                const int drow = n0 < 1024 ? (256 * (n0 >> 7) + (n0 & 127)) : (256 * ((n0 - 1024) >> 7) + 128 + ((n0 - 1024) & 127));
                transpose_item(args.in[I_WGU] + (size_t)e * D * 2048, 2048, D, Wgu_t + (size_t)e * 2048 * D, 64 * kb, n0, drow, scr, lane); continue; } r -= NE * I_GU;
            { const int e = r / I_DN, q = r % I_DN, kb = q / 32, nb = q % 32;
              transpose_item(args.in[I_WDN] + (size_t)e * DFF * D, D, DFF, Wdn_t + (size_t)e * D * DFF, 64 * kb, 32 * nb, 32 * nb, scr, lane); }
        }
        for (int idx = bid * NTHREADS + tid; idx < 1536 * 256; idx += G * NTHREADS) {
            const int n = idx >> 8, k = idx & 255; float v = 0.f;
            if (n < 512) { if (k < 64) v = args.in[I_WUP][k * 512 + n]; }
            else if (n < 1024) { if (k >= 64 && k < 128) v = args.in[I_AUP][(k - 64) * 512 + (n - 512)]; }
            else { if (k >= 128) v = args.in[I_GUP][(k - 128) * 512 + (n - 1024)]; }
            LoraB[idx] = (bf16)f2bf(v);
        }
        for (int idx = bid * NTHREADS + tid; idx < 8 * 128 * 64; idx += G * NTHREADS) {
            const int nb = idx >> 13, col = (idx >> 6) & 127, k = idx & 63;
            const float v = col < 64 ? args.in[I_LWX][nb * 4096 + k * 64 + col] : args.in[I_LWA][nb * 4096 + k * 64 + (col - 64)];
            LruW[idx] = (bf16)f2bf(v);
        }
        for (int m = gw; m < M; m += NGW) rms_row_to_bf16(args.in[I_X] + (size_t)m * D, args.in[I_NMIXG], HN + (size_t)m * D, lane);
        for (int m = gw; m < MROWS; m += NGW) rms_row_to_bf16(args.in[I_MEM] + (size_t)m * D, args.in[I_NMEMG], MEMN + (size_t)m * D, lane);
    }
    SEAM(0);

    if (IN(1)) { PHASE_IDS;
        { pg8::DenseSched S; S.o.init_tiles(M / 256, INW / 256, G, bid); S.A = (const char*)HN; S.B = (const char*)Win_t; S.tstep = (size_t)256 * D * 2;
          EpiBf16Plain E{U, INW, 1.0f}; pg8::gemm_phase(lds, D, S, E); }
        { pg8::DenseSched S; S.o.init_tiles(MROWS / 256, D / 256, G, (bid + 64) & (G - 1)); S.A = (const char*)MEMN; S.B = (const char*)Wk_t; S.tstep = (size_t)256 * D * 2;
          EpiBf16Plain E{KM, D, 1.0f}; pg8::gemm_phase(lds, D, S, E); }
        { pg8::DenseSched S; S.o.init_tiles(D / 256, MROWS / 256, G, (bid + 48) & (G - 1)); S.A = (const char*)Wv_t; S.B = (const char*)MEMN; S.tstep = (size_t)256 * D * 2;
          EpiBf16Plain E{VT, MROWS, 1.0f}; pg8::gemm_phase(lds, D, S, E); }
    }
    SEAM(1);

    if (IN(2)) { PHASE_IDS;
        const float* mu = args.in[I_MU]; const float* k_k = args.in[I_KK];
        for (int m = gw; m < M; m += NGW) {
            const bool hp = (m & (SEQ - 1)) != 0;
            const bf16* ur = U + (size_t)m * INW + 1024; const bf16* up = ur - INW;
#pragma unroll
            for (int j = 0; j < 7; ++j) {
                const int c = 4 * (64 * j + lane);
                const u32x2 cu = *(const u32x2*)(ur + c); u32x2 pu = (u32x2){0u, 0u}; if (hp) pu = *(const u32x2*)(up + c);
                const f32x4 m4 = *(const f32x4*)(mu + c);
                f32x4 uu; { const float a0 = bflo(cu.x), a1 = bfhi(cu.x), a2 = bflo(cu.y), a3 = bfhi(cu.y), p0 = bflo(pu.x), p1 = bfhi(pu.x), p2 = bflo(pu.y), p3 = bfhi(pu.y);
                    uu.x = a0 + (p0 - a0) * m4.x; uu.y = a1 + (p1 - a1) * m4.y; uu.z = a2 + (p2 - a2) * m4.z; uu.w = a3 + (p3 - a3) * m4.w; }
                if (j < 2) { *(f32x4*)(Rr + (size_t)m * 512 + c) = uu; }
                else if (j < 4) { const int cc = c - 512; *(f32x4*)(KRAW + (size_t)m * 512 + cc) = uu;
                    const f32x4 kk4 = *(const f32x4*)(k_k + cc); f32x4 kk = uu * kk4; float ss = (kk.x * kk.x + kk.y * kk.y) + (kk.z * kk.z + kk.w * kk.w);
                    ss += __shfl_xor(ss, 1); ss += __shfl_xor(ss, 2); ss += __shfl_xor(ss, 4); ss += __shfl_xor(ss, 8);
                    const float inv = 1.0f / fmaxf(sqrtf(ss), 1e-12f); *(f32x4*)(KKN + (size_t)m * 512 + cc) = kk * inv; }
                else if (j < 6) { const int cc = c - 1024; *(f32x4*)(Vv + (size_t)m * 512 + cc) = uu; }
                else { f32x4 o = uu;
                    if (lane < 16) { o.x = tanhf(uu.x); o.y = tanhf(uu.y); o.z = tanhf(uu.z); o.w = tanhf(uu.w); }
                    else if (lane >= 32) { o.x = sigmoid_f(uu.x); o.y = sigmoid_f(uu.y); o.z = sigmoid_f(uu.z); o.w = sigmoid_f(uu.w); }
                    u32x2 w; w.x = pk2(o.x, o.y); w.y = pk2(o.z, o.w); *(u32x2*)(AP + (size_t)m * 256 + 4 * lane) = w; }
            }
        }
        {
            const float* conv_w = args.in[I_CONVW]; const float* conv_b = args.in[I_CONVB]; const float* bx = args.in[I_LBX]; const float* ba = args.in[I_LBA]; const float* lam = args.in[I_LAM];
            LAS float* xs = (LAS float*)(lds + wave * 4096);
            const int i = lane & 15, kg = lane >> 4;
            for (int unit = gw; unit < (M / 16) * 2; unit += NGW) {
                const int tile = unit >> 1, nb0 = (unit & 1) * 4, m0 = tile * 16, s0 = m0 & (SEQ - 1);
                for (int nb = nb0; nb < nb0 + 4; ++nb) {
                    bf16x8 af[2];
#pragma unroll
                    for (int ks = 0; ks < 2; ++ks) {
                        const int chb = nb * 64 + 32 * ks + 8 * kg;
                        f32x4 x0 = *(const f32x4*)(conv_b + chb), x1 = *(const f32x4*)(conv_b + chb + 4);
#pragma unroll
                        for (int j = 0; j < 4; ++j) {
                            if (s0 + i - 3 + j >= 0) {
                                const u32x4 uw = *(const u32x4*)(U + (size_t)(m0 + i - 3 + j) * INW + chb);
                                const f32x4 w0 = *(const f32x4*)(conv_w + j * 512 + chb), w1 = *(const f32x4*)(conv_w + j * 512 + chb + 4);
                                x0.x += w0.x * bflo(uw.x); x0.y += w0.y * bfhi(uw.x); x0.z += w0.z * bflo(uw.y); x0.w += w0.w * bfhi(uw.y);
                                x1.x += w1.x * bflo(uw.z); x1.y += w1.y * bfhi(uw.z); x1.z += w1.z * bflo(uw.w); x1.w += w1.w * bfhi(uw.w);
                            }
                        }
                        *(LAS f32x4*)(xs + i * 64 + 32 * ks + 8 * kg) = x0; *(LAS f32x4*)(xs + i * 64 + 32 * ks + 8 * kg + 4) = x1;
                        u32x4 p; p.x = pk2(x0.x, x0.y); p.y = pk2(x0.z, x0.w); p.z = pk2(x1.x, x1.y); p.w = pk2(x1.z, x1.w);
                        af[ks] = __builtin_bit_cast(bf16x8, p);
                    }
                    f32x4 acc[8];
#pragma unroll
                    for (int ct = 0; ct < 8; ++ct) { acc[ct] = (f32x4){0.f, 0.f, 0.f, 0.f};
#pragma unroll
                        for (int ks = 0; ks < 2; ++ks) { const bf16x8 bfr = *(const bf16x8*)(LruW + ((size_t)(nb * 128 + 16 * ct + i) * 64 + 32 * ks + 8 * kg));
                            acc[ct] = __builtin_amdgcn_mfma_f32_16x16x32_bf16(af[ks], bfr, acc[ct], 0, 0, 0); } }
                    asm volatile("s_waitcnt lgkmcnt(0)" ::: "memory");
#pragma unroll
                    for (int ct = 0; ct < 4; ++ct) {
                        const int col = 16 * ct + i, ch = nb * 64 + col;
                        const float bxv = bx[ch], bav = ba[ch], sp = softplus_f(-lam[ch]);
#pragma unroll
                        for (int e = 0; e < 4; ++e) {
                            const int tok = 4 * kg + e;
                            const float gx = sigmoid_f(acc[ct][e] + bxv), ga = sigmoid_f(acc[ct + 4][e] + bav);
                            const float la = -8.0f * ga * sp, a = __expf(la), xcv = xs[tok * 64 + col];
                            const float bt = sqrtf(fmaxf(-expm1f(2.0f * la), 0.f)) * gx * xcv;
                            LA[(size_t)(m0 + tok) * 512 + ch] = a; LB[(size_t)(m0 + tok) * 512 + ch] = bt;
                        }
                    }
                }
            }
        }
    }
    SEAM(2);

    if (IN(3)) { PHASE_IDS;
        pg8::DenseSched S; S.o.init_tiles(M / 256, 1536 / 256, G, bid); S.A = (const char*)AP; S.B = (const char*)LoraB; S.tstep = (size_t)256 * 256 * 2;
        EpiLora E{WD, args.in[I_W0], args.in[I_A0]}; pg8::gemm_phase(lds, 256, S, E);
    }
    SEAM(3);

    if (IN(4)) { PHASE_IDS;
        LAS unsigned char* wl = lds + wave * 16384;
        LAS bf16* Arm = (LAS bf16*)(wl); LAS bf16* Brm = (LAS bf16*)(wl + 2048); LAS bf16* Krm = (LAS bf16*)(wl + 4096); LAS bf16* Rrm = (LAS bf16*)(wl + 6144);
        LAS bf16* ATt = (LAS bf16*)(wl + 8192); LAS bf16* BTt = (LAS bf16*)(wl + 10240); LAS bf16* KTt = (LAS bf16*)(wl + 12288); LAS bf16* VTt = (LAS bf16*)(wl + 14336);
        LAS float* MabT = (LAS float*)(wl); LAS bf16* Mak = (LAS bf16*)(wl + 1024); LAS bf16* Mrb = (LAS bf16*)(wl + 1536); LAS bf16* Mrk = (LAS bf16*)(wl + 2048); LAS bf16* Tm = (LAS bf16*)(wl + 2560);
        LAS float* PLs = (LAS float*)(wl + 3072); LAS bf16* Q0T = (LAS bf16*)(wl + 4096);
        const int l15 = lane & 15, g = lane >> 4, te = lane >> 2, kq = lane & 3;
        const bf16x8 z8 = (bf16x8){0, 0, 0, 0, 0, 0, 0, 0};
        const f32x4 z4 = (f32x4){0.f, 0.f, 0.f, 0.f};
        for (int un = gw; un < NB * NH * (SEQ / 16); un += NGW) {
            const int bh = un >> 8, c = un & 255, b = bh >> 3, h = bh & 7;
            const size_t mrow = (size_t)b * SEQ + c * 16 + te, off = mrow * 512 + h * 64 + 16 * kq;
            const int hc = h * 64 + 16 * kq;
            float cl[16], eP[16];
            {
                float lwv[16];
#pragma unroll
                for (int j4 = 0; j4 < 4; ++j4) { const f32x4 x = *(const f32x4*)(WD + off + 4 * j4); lwv[4 * j4] = x.x; lwv[4 * j4 + 1] = x.y; lwv[4 * j4 + 2] = x.z; lwv[4 * j4 + 3] = x.w; }
#pragma unroll
                for (int j = 0; j < 16; ++j) { float x = lwv[j];
#pragma unroll
                    for (int sft = 4; sft < 64; sft <<= 1) { const float y = __shfl_up(x, sft); if (lane >= sft) x += y; }
                    cl[j] = x; }
                float bon = 0.f;
                u32x4 pa[2], pb[2], pk[2], pr[2];
#pragma unroll
                for (int j4 = 0; j4 < 4; ++j4) {
                    const f32x4 kn = *(const f32x4*)(KKN + off + 4 * j4), av = *(const f32x4*)(AA + off + 4 * j4), kr = *(const f32x4*)(KRAW + off + 4 * j4), rv = *(const f32x4*)(Rr + off + 4 * j4), vv = *(const f32x4*)(Vv + off + 4 * j4);
                    const f32x4 ka = *(const f32x4*)(args.in[I_KA] + hc + 4 * j4), rk = *(const f32x4*)(args.in[I_RK] + hc + 4 * j4);
                    float at4[4], bt4[4], kt4[4], rt4[4], vt4[4];
#pragma unroll
                    for (int q = 0; q < 4; ++q) { const int j = 4 * j4 + q;
                        const float p = __expf(cl[j]), pn = __expf(-cl[j]), pm1 = __expf(cl[j] - lwv[j]); eP[j] = p;
                        const float kp = kr[q] * (1.0f + (av[q] - 1.0f) * ka[q]);
                        at4[q] = -kn[q] * pm1; bt4[q] = kn[q] * av[q] * pn; kt4[q] = kp * pn; rt4[q] = rv[q] * p; vt4[q] = vv[q];
                        bon += rv[q] * kp * rk[q];
                        const int kk = 16 * kq + j;
                        ATt[kk * 16 + te] = (bf16)f2bf(at4[q]); BTt[kk * 16 + te] = (bf16)f2bf(bt4[q]); KTt[kk * 16 + te] = (bf16)f2bf(kt4[q]); VTt[kk * 16 + te] = (bf16)f2bf(vt4[q]); }
                    const int hh = j4 >> 1, w2 = (j4 & 1) * 2;
                    pa[hh][w2] = pk2(at4[0], at4[1]); pa[hh][w2 + 1] = pk2(at4[2], at4[3]); pb[hh][w2] = pk2(bt4[0], bt4[1]); pb[hh][w2 + 1] = pk2(bt4[2], bt4[3]);
                    pk[hh][w2] = pk2(kt4[0], kt4[1]); pk[hh][w2 + 1] = pk2(kt4[2], kt4[3]); pr[hh][w2] = pk2(rt4[0], rt4[1]); pr[hh][w2 + 1] = pk2(rt4[2], rt4[3]);
                }
#pragma unroll
                for (int hh = 0; hh < 2; ++hh) { const int po = te * 64 + 8 * ((2 * kq + hh) ^ (te & 7));
                    *(LAS u32x4*)(Arm + po) = pa[hh]; *(LAS u32x4*)(Brm + po) = pb[hh]; *(LAS u32x4*)(Krm + po) = pk[hh]; *(LAS u32x4*)(Rrm + po) = pr[hh]; }
                bon += __shfl_xor(bon, 1); bon += __shfl_xor(bon, 2);
#pragma unroll
                for (int j4 = 0; j4 < 4; ++j4) { const f32x4 vv = *(const f32x4*)(Vv + off + 4 * j4), gg = *(const f32x4*)(GG + off + 4 * j4), lb = *(const f32x4*)(args.in[I_LNB] + hc + 4 * j4);
                    *(f32x4*)((float*)(ws + WS_ADD) + off + 4 * j4) = (lb + vv * bon) * gg; }
            }
            asm volatile("s_waitcnt lgkmcnt(0)" ::: "memory");
            {
                bf16x8 fa[2], fr[2], fb[2], fk[2];
#pragma unroll
                for (int ks = 0; ks < 2; ++ks) { const int po = l15 * 64 + 8 * ((4 * ks + g) ^ (l15 & 7));
                    fa[ks] = *(const LAS bf16x8*)(Arm + po); fr[ks] = *(const LAS bf16x8*)(Rrm + po); fb[ks] = *(const LAS bf16x8*)(Brm + po); fk[ks] = *(const LAS bf16x8*)(Krm + po); }
                f32x4 mab = z4, mak = z4, mrb = z4, mrk = z4;
#pragma unroll
                for (int ks = 0; ks < 2; ++ks) { mab = __builtin_amdgcn_mfma_f32_16x16x32_bf16(fb[ks], fa[ks], mab, 0, 0, 0); mak = __builtin_amdgcn_mfma_f32_16x16x32_bf16(fk[ks], fa[ks], mak, 0, 0, 0);
                    mrb = __builtin_amdgcn_mfma_f32_16x16x32_bf16(fb[ks], fr[ks], mrb, 0, 0, 0); mrk = __builtin_amdgcn_mfma_f32_16x16x32_bf16(fk[ks], fr[ks], mrk, 0, 0, 0); }
#pragma unroll
                for (int e = 0; e < 4; ++e) { const int i = 4 * g + e; if (!(i < l15)) { mab[e] = 0.f; mak[e] = 0.f; } if (!(i <= l15)) { mrb[e] = 0.f; mrk[e] = 0.f; } }
                asm volatile("s_waitcnt lgkmcnt(0)" ::: "memory");
#pragma unroll
                for (int e = 0; e < 4; ++e) MabT[(4 * g + e) * 16 + l15] = mab[e];
                u32x2 w; w.x = pk2(mak[0], mak[1]); w.y = pk2(mak[2], mak[3]); *(LAS u32x2*)(Mak + l15 * 16 + 4 * g) = w;
                w.x = pk2(mrb[0], mrb[1]); w.y = pk2(mrb[2], mrb[3]); *(LAS u32x2*)(Mrb + l15 * 16 + 4 * g) = w;
                w.x = pk2(mrk[0], mrk[1]); w.y = pk2(mrk[2], mrk[3]); *(LAS u32x2*)(Mrk + l15 * 16 + 4 * g) = w;
                if (te == 15) {
#pragma unroll
                    for (int j = 0; j < 16; ++j) PLs[16 * kq + j] = eP[j]; }
            }
            asm volatile("s_waitcnt lgkmcnt(0)" ::: "memory");
            {
                float y[16];
#pragma unroll
                for (int j = 15; j >= 0; --j) {
                    float acc = (j == l15) ? 1.0f : 0.0f;
                    float row[16];
#pragma unroll
                    for (int q = 0; q < 4; ++q) { const f32x4 x = *(const LAS f32x4*)(MabT + j * 16 + 4 * q); row[4 * q] = x.x; row[4 * q + 1] = x.y; row[4 * q + 2] = x.z; row[4 * q + 3] = x.w; }
#pragma unroll
                    for (int i = j + 1; i < 16; ++i) acc += y[i] * row[i];
                    y[j] = acc;
                }
                if (g == 0) { u32x4 t0, t1; t0.x = pk2(y[0], y[1]); t0.y = pk2(y[2], y[3]); t0.z = pk2(y[4], y[5]); t0.w = pk2(y[6], y[7]); t1.x = pk2(y[8], y[9]); t1.y = pk2(y[10], y[11]); t1.z = pk2(y[12], y[13]); t1.w = pk2(y[14], y[15]);
                    *(LAS u32x4*)(Tm + l15 * 16) = t0; *(LAS u32x4*)(Tm + l15 * 16 + 8) = t1; }
            }
            asm volatile("s_waitcnt lgkmcnt(0)" ::: "memory");
            {
                const bool act = g < 2; const int fo = l15 * 16 + 8 * g;
                const bf16x8 fT = act ? *(const LAS bf16x8*)(Tm + fo) : z8, fMak = act ? *(const LAS bf16x8*)(Mak + fo) : z8, fMrb = act ? *(const LAS bf16x8*)(Mrb + fo) : z8, fMrk = act ? *(const LAS bf16x8*)(Mrk + fo) : z8;
                bf16x8 fV[4], fQ1[4], fAh[4], fBT[4], fKT[4];
#pragma unroll
                for (int vt = 0; vt < 4; ++vt) { fV[vt] = act ? *(const LAS bf16x8*)(VTt + vt * 256 + fo) : z8; fBT[vt] = act ? *(const LAS bf16x8*)(BTt + vt * 256 + fo) : z8; fKT[vt] = act ? *(const LAS bf16x8*)(KTt + vt * 256 + fo) : z8; }
#pragma unroll
                for (int vt = 0; vt < 4; ++vt) { const f32x4 q0 = __builtin_amdgcn_mfma_f32_16x16x32_bf16(fMak, fV[vt], z4, 0, 0, 0);
                    u32x2 w; w.x = pk2(q0[0], q0[1]); w.y = pk2(q0[2], q0[3]); *(LAS u32x2*)(Q0T + vt * 256 + l15 * 16 + 4 * g) = w; }
#pragma unroll
                for (int kt = 0; kt < 4; ++kt) { const bf16x8 fA = act ? *(const LAS bf16x8*)(ATt + kt * 256 + fo) : z8; const f32x4 ah = __builtin_amdgcn_mfma_f32_16x16x32_bf16(fT, fA, z4, 0, 0, 0);
                    u32x2 w; w.x = pk2(ah[0], ah[1]); w.y = pk2(ah[2], ah[3]); *(LAS u32x2*)(ATt + kt * 256 + l15 * 16 + 4 * g) = w; }
                asm volatile("s_waitcnt lgkmcnt(0)" ::: "memory");
#pragma unroll
                for (int vt = 0; vt < 4; ++vt) { const bf16x8 fQ0 = act ? *(const LAS bf16x8*)(Q0T + vt * 256 + fo) : z8; const f32x4 q1 = __builtin_amdgcn_mfma_f32_16x16x32_bf16(fT, fQ0, z4, 0, 0, 0);
                    u32x2 w; w.x = pk2(q1[0], q1[1]); w.y = pk2(q1[2], q1[3]); *(LAS u32x2*)(Q0T + vt * 256 + l15 * 16 + 4 * g) = w; }
                asm volatile("s_waitcnt lgkmcnt(0)" ::: "memory");
#pragma unroll
                for (int vt = 0; vt < 4; ++vt) { fQ1[vt] = act ? *(const LAS bf16x8*)(Q0T + vt * 256 + fo) : z8; fAh[vt] = act ? *(const LAS bf16x8*)(ATt + vt * 256 + fo) : z8; }
                bf16* rp = (bf16*)(ws + WS_RP) + (size_t)un * 1024 + l15 * 64;
#pragma unroll
                for (int kt = 0; kt < 4; ++kt) {
                    const u32x2 rr = *(const LAS u32x2*)(Rrm + l15 * 64 + 8 * ((2 * kt + (g >> 1)) ^ (l15 & 7)) + 4 * (g & 1));
                    f32x4 ini; ini[0] = bflo(rr.x); ini[1] = bfhi(rr.x); ini[2] = bflo(rr.y); ini[3] = bfhi(rr.y);
                    const f32x4 rh = __builtin_amdgcn_mfma_f32_16x16x32_bf16(fAh[kt], fMrb, ini, 0, 0, 0);
                    u32x2 w; w.x = pk2(rh[0], rh[1]); w.y = pk2(rh[2], rh[3]); *(u32x2*)(rp + 32 * (kt >> 1) + 8 * g + 4 * (kt & 1)) = w;
                }
#pragma unroll
                for (int vt = 0; vt < 4; ++vt) { f32x4 y1 = __builtin_amdgcn_mfma_f32_16x16x32_bf16(fMrb, fQ1[vt], z4, 0, 0, 0); y1 = __builtin_amdgcn_mfma_f32_16x16x32_bf16(fMrk, fV[vt], y1, 0, 0, 0);
                    *(f32x4*)((float*)(ws + WS_Y1F) + ((size_t)(un * 4 + vt) * 64 + lane) * 4) = y1; }
                bf16* gp = (bf16*)(ws + WS_GP) + (size_t)un * 4096;
#pragma unroll
                for (int krt = 0; krt < 4; ++krt) { const float pl = PLs[16 * krt + l15];
#pragma unroll
                    for (int kct = 0; kct < 4; ++kct) { f32x4 ga = __builtin_amdgcn_mfma_f32_16x16x32_bf16(fAh[kct], fBT[krt], z4, 0, 0, 0);
                        if (kct == krt) {
#pragma unroll
                            for (int e = 0; e < 4; ++e) if (4 * g + e == l15) ga[e] += 1.0f; }
                        u32x2 w; w.x = pk2(ga[0] * pl, ga[1] * pl); w.y = pk2(ga[2] * pl, ga[3] * pl);
                        *(u32x2*)(gp + (16 * krt + l15) * 64 + 32 * (kct >> 1) + 8 * g + 4 * (kct & 1)) = w; } }
#pragma unroll
                for (int mt = 0; mt < 4; ++mt) { const f32x4 pl4 = *(const LAS f32x4*)(PLs + 16 * mt + 4 * g);
#pragma unroll
                    for (int vt = 0; vt < 4; ++vt) { f32x4 ha = __builtin_amdgcn_mfma_f32_16x16x32_bf16(fBT[mt], fQ1[vt], z4, 0, 0, 0); ha = __builtin_amdgcn_mfma_f32_16x16x32_bf16(fKT[mt], fV[vt], ha, 0, 0, 0);
                        u32x2 w; w.x = pk2(ha[0] * pl4[0], ha[1] * pl4[1]); w.y = pk2(ha[2] * pl4[2], ha[3] * pl4[3]);
                        *(u32x2*)((bf16*)(ws + WS_HF) + ((size_t)((un * 4 + vt) * 4 + mt) * 64 + lane) * 4) = w; } }
            }
            asm volatile("s_waitcnt lgkmcnt(0)" ::: "memory");
        }
    }
    SEAM(4);

#define RW_ZB(zz, zb) do { _Pragma("unroll") for (int ks_ = 0; ks_ < 2; ++ks_) { u32x4 p_; p_.x = pk2(zz[2 * ks_][0], zz[2 * ks_][1]); p_.y = pk2(zz[2 * ks_][2], zz[2 * ks_][3]); \
        p_.z = pk2(zz[2 * ks_ + 1][0], zz[2 * ks_ + 1][1]); p_.w = pk2(zz[2 * ks_ + 1][2], zz[2 * ks_ + 1][3]); zb[ks_] = __builtin_bit_cast(bf16x8, p_); } } while (0)
    if (IN(5)) { PHASE_IDS;
        const int l15 = lane & 15, g = lane >> 4;
        for (int u2 = gw; u2 < 2 * NB * NH * (SEQ / 64); u2 += NGW) {
            const int u64 = u2 >> 1, part = u2 & 1;
            f32x4 z[4][4];
#pragma unroll
            for (int sl = 0; sl < 4; ++sl)
#pragma unroll
                for (int mt = 0; mt < 4; ++mt)
#pragma unroll
                    for (int e = 0; e < 4; ++e) z[sl][mt][e] = (part == 0 && sl == mt && 4 * g + e == l15) ? 1.0f : 0.0f;
#pragma unroll 1
            for (int j = 0; j < 4; ++j) {
                const size_t un = (size_t)u64 * 4 + j;
                const bf16* gp = (const bf16*)(ws + WS_GP) + un * 4096 + l15 * 64 + 8 * g;
                bf16x8 gf[4][2];
#pragma unroll
                for (int mt = 0; mt < 4; ++mt) { gf[mt][0] = *(const bf16x8*)(gp + mt * 1024); gf[mt][1] = *(const bf16x8*)(gp + mt * 1024 + 32); }
#pragma unroll
                for (int sl = 0; sl < 4; ++sl) {
                    bf16x8 zb[2]; RW_ZB(z[sl], zb);
#pragma unroll
                    for (int mt = 0; mt < 4; ++mt) {
                        f32x4 a = (f32x4){0.f, 0.f, 0.f, 0.f};
                        if (part) { const u32x2 hh = *(const u32x2*)((const bf16*)(ws + WS_HF) + ((size_t)((un * 4 + sl) * 4 + mt) * 64 + lane) * 4); a[0] = bflo(hh.x); a[1] = bfhi(hh.x); a[2] = bflo(hh.y); a[3] = bfhi(hh.y); }
                        a = __builtin_amdgcn_mfma_f32_16x16x32_bf16(gf[mt][0], zb[0], a, 0, 0, 0); a = __builtin_amdgcn_mfma_f32_16x16x32_bf16(gf[mt][1], zb[1], a, 0, 0, 0);
                        z[sl][mt] = a;
                    }
                }
            }
            if (part == 0) {
                bf16* gc = (bf16*)(ws + WS_GC) + (size_t)u64 * 4096;
#pragma unroll
                for (int sl = 0; sl < 4; ++sl) { const int pc = 32 * (sl >> 1) + 8 * (l15 >> 2) + 4 * (sl & 1) + (l15 & 3);
#pragma unroll
                    for (int mt = 0; mt < 4; ++mt)
#pragma unroll
                        for (int e = 0; e < 4; ++e) gc[(16 * mt + 4 * g + e) * 64 + pc] = (bf16)f2bf(z[sl][mt][e]); }
            } else {
#pragma unroll
                for (int sl = 0; sl < 4; ++sl)
#pragma unroll
                    for (int mt = 0; mt < 4; ++mt) { u32x2 w; w.x = pk2(z[sl][mt][0], z[sl][mt][1]); w.y = pk2(z[sl][mt][2], z[sl][mt][3]);
                        *(u32x2*)((bf16*)(ws + WS_HC) + ((size_t)((u64 * 4 + sl) * 4 + mt) * 64 + lane) * 4) = w; }
            }
        }
    }
    SEAM(5);

    if (IN(6)) { PHASE_IDS;
        if (bid < 128) {
            if (wave == 0) {
                const int l15 = lane & 15, g = lane >> 4, bh = bid >> 2, vs = bid & 3;
                f32x4 z[4];
#pragma unroll
                for (int mt = 0; mt < 4; ++mt) z[mt] = (f32x4){0.f, 0.f, 0.f, 0.f};
                bf16x8 gA[4][2], gB[4][2]; u32x2 hA[4], hB[4];
#define SC_LOAD(gf, hf, C) do { const size_t u64_ = (size_t)bh * 64 + (C); const bf16* gp_ = (const bf16*)(ws + WS_GC) + u64_ * 4096 + l15 * 64 + 8 * g; \
                    _Pragma("unroll") for (int mt = 0; mt < 4; ++mt) { gf[mt][0] = *(const bf16x8*)(gp_ + mt * 1024); gf[mt][1] = *(const bf16x8*)(gp_ + mt * 1024 + 32); \
                        hf[mt] = *(const u32x2*)((const bf16*)(ws + WS_HC) + ((size_t)((u64_ * 4 + vs) * 4 + mt) * 64 + lane) * 4); } } while (0)
#define SC_STEP(gf, hf, C) do { const size_t u64_ = (size_t)bh * 64 + (C); float* zs_ = (float*)(ws + WS_ZS) + ((size_t)((u64_ * 4 + vs) * 4) * 64 + lane) * 4; \
                    _Pragma("unroll") for (int mt = 0; mt < 4; ++mt) *(f32x4*)(zs_ + mt * 256) = z[mt]; \
                    bf16x8 zb[2]; RW_ZB(z, zb); \
                    _Pragma("unroll") for (int mt = 0; mt < 4; ++mt) { f32x4 a; a[0] = bflo(hf[mt].x); a[1] = bfhi(hf[mt].x); a[2] = bflo(hf[mt].y); a[3] = bfhi(hf[mt].y); \
                        a = __builtin_amdgcn_mfma_f32_16x16x32_bf16(gf[mt][0], zb[0], a, 0, 0, 0); a = __builtin_amdgcn_mfma_f32_16x16x32_bf16(gf[mt][1], zb[1], a, 0, 0, 0); z[mt] = a; } } while (0)
                SC_LOAD(gA, hA, 0);
#pragma unroll 1
                for (int C = 0; C < 64; C += 2) {
                    SC_LOAD(gB, hB, C + 1);
                    SC_STEP(gA, hA, C);
                    if (C + 2 < 64) SC_LOAD(gA, hA, C + 2);
                    SC_STEP(gB, hB, C + 1);
                }
#undef SC_LOAD
#undef SC_STEP
            }
        } else if (bid < 160) {
            const int idx = bid - 128, b = idx >> 3, cg = idx & 7, ch = cg * 64 + lane;
            LAS float* seg = (LAS float*)lds;
            const size_t mb = (size_t)b * SEQ + wave * 512;
            float A = 1.f, B = 0.f;
#pragma unroll 8
            for (int t = 0; t < 512; ++t) { const float a = LA[(mb + t) * 512 + ch], bt = LB[(mb + t) * 512 + ch]; B = a * B + bt; A *= a; }
            seg[(wave * 64 + lane) * 2] = A; seg[(wave * 64 + lane) * 2 + 1] = B;
            __syncthreads();
            float hst = 0.f;
            for (int sgi = 0; sgi < wave; ++sgi) hst = seg[(sgi * 64 + lane) * 2] * hst + seg[(sgi * 64 + lane) * 2 + 1];
#pragma unroll 8
            for (int t = 0; t < 512; ++t) { const float a = LA[(mb + t) * 512 + ch], bt = LB[(mb + t) * 512 + ch]; hst = a * hst + bt;
                const float gl = bf2f(U[(mb + t) * INW + 512 + ch]); CAT[(mb + t) * 1024 + ch] = (bf16)f2bf(hst * gelu_tanh_f(gl)); }
            __syncthreads();
        }
    }
    SEAM(6);

    if (IN(7)) { PHASE_IDS;
        const int l15 = lane & 15, g = lane >> 4;
        for (int u64 = gw; u64 < NB * NH * (SEQ / 64); u64 += NGW) {
            const int bh = u64 >> 6, C = u64 & 63, b = bh >> 3, h = bh & 7;
            f32x4 z[4][4];
#pragma unroll
            for (int sl = 0; sl < 4; ++sl)
#pragma unroll
                for (int mt = 0; mt < 4; ++mt) z[sl][mt] = *(const f32x4*)((const float*)(ws + WS_ZS) + ((size_t)((u64 * 4 + sl) * 4 + mt) * 64 + lane) * 4);
            float lg4[4];
#pragma unroll
            for (int sl = 0; sl < 4; ++sl) lg4[sl] = args.in[I_LNG][h * 64 + 16 * sl + l15];
#pragma unroll 1
            for (int j = 0; j < 4; ++j) {
                const size_t un = (size_t)u64 * 4 + j; const size_t m0 = (size_t)b * SEQ + (C * 4 + j) * 16;
                const bf16* rp = (const bf16*)(ws + WS_RP) + un * 1024 + l15 * 64 + 8 * g;
                const bf16x8 rf0 = *(const bf16x8*)rp, rf1 = *(const bf16x8*)(rp + 32);
                f32x4 y[4];
#pragma unroll
                for (int sl = 0; sl < 4; ++sl) { bf16x8 zb[2]; RW_ZB(z[sl], zb);
                    f32x4 a = *(const f32x4*)((const float*)(ws + WS_Y1F) + ((size_t)(un * 4 + sl) * 64 + lane) * 4);
                    a = __builtin_amdgcn_mfma_f32_16x16x32_bf16(rf0, zb[0], a, 0, 0, 0); a = __builtin_amdgcn_mfma_f32_16x16x32_bf16(rf1, zb[1], a, 0, 0, 0); y[sl] = a; }
#pragma unroll
                for (int e = 0; e < 4; ++e) {
                    float s1 = (y[0][e] + y[1][e]) + (y[2][e] + y[3][e]);
                    s1 += __shfl_xor(s1, 1); s1 += __shfl_xor(s1, 2); s1 += __shfl_xor(s1, 4); s1 += __shfl_xor(s1, 8);
                    const float mean = s1 * (1.0f / 64.0f);
                    float d0 = y[0][e] - mean, d1 = y[1][e] - mean, d2 = y[2][e] - mean, d3 = y[3][e] - mean;
                    float s2 = (d0 * d0 + d1 * d1) + (d2 * d2 + d3 * d3);
                    s2 += __shfl_xor(s2, 1); s2 += __shfl_xor(s2, 2); s2 += __shfl_xor(s2, 4); s2 += __shfl_xor(s2, 8);
                    const float rstd = 1.0f / sqrtf(s2 * (1.0f / 64.0f) + GN_EPS);
                    const size_t ro = (m0 + 4 * g + e) * 512 + h * 64 + l15;
                    const float dd[4] = {d0, d1, d2, d3};
#pragma unroll
                    for (int sl = 0; sl < 4; ++sl) { const float gg = GG[ro + 16 * sl], ad = ((const float*)(ws + WS_ADD))[ro + 16 * sl];
                        const float o = dd[sl] * rstd * lg4[sl] * gg + ad;
                        CAT[(m0 + 4 * g + e) * 1024 + 512 + h * 64 + 16 * sl + l15] = (bf16)f2bf(o); }
                }
                if (j < 3) {
                    const bf16* gp = (const bf16*)(ws + WS_GP) + un * 4096 + l15 * 64 + 8 * g;
                    bf16x8 gf[4][2];
#pragma unroll
                    for (int mt = 0; mt < 4; ++mt) { gf[mt][0] = *(const bf16x8*)(gp + mt * 1024); gf[mt][1] = *(const bf16x8*)(gp + mt * 1024 + 32); }
#pragma unroll
                    for (int sl = 0; sl < 4; ++sl) { bf16x8 zb[2]; RW_ZB(z[sl], zb);
#pragma unroll
                        for (int mt = 0; mt < 4; ++mt) { const u32x2 hh = *(const u32x2*)((const bf16*)(ws + WS_HF) + ((size_t)((un * 4 + sl) * 4 + mt) * 64 + lane) * 4);
                            f32x4 a; a[0] = bflo(hh.x); a[1] = bfhi(hh.x); a[2] = bflo(hh.y); a[3] = bfhi(hh.y);
                            a = __builtin_amdgcn_mfma_f32_16x16x32_bf16(gf[mt][0], zb[0], a, 0, 0, 0); a = __builtin_amdgcn_mfma_f32_16x16x32_bf16(gf[mt][1], zb[1], a, 0, 0, 0); z[sl][mt] = a; } }
                }
            }
        }
    }
    SEAM(7);
#undef RW_ZB


    if (IN(8)) { PHASE_IDS;
        pg8::DenseSched S; S.o.init_tiles(M / 256, D / 256, G, bid); S.A = (const char*)CAT; S.B = (const char*)Wout_t; S.tstep = (size_t)256 * D * 2;
        EpiF32Res E{args.in[I_X], X1, D}; pg8::gemm_phase(lds, D, S, E);
    }
    SEAM(8);
    if (IN(9)) { PHASE_IDS; for (int m = gw; m < M; m += NGW) rms_row_to_bf16(X1 + (size_t)m * D, args.in[I_NXAG], HN + (size_t)m * D, lane); }
    SEAM(9);
    if (IN(10)) { PHASE_IDS;
        pg8::DenseSched S; S.o.init_tiles(M / 256, D / 256, G, bid); S.A = (const char*)HN; S.B = (const char*)Wq_t; S.tstep = (size_t)256 * D * 2;
        EpiBf16Plain E{Qb, D, 0.0625f}; pg8::gemm_phase(lds, D, S, E);
    }
    SEAM(10);
    if (IN(11)) { PHASE_IDS;
        const int l15 = lane & 15, g4 = lane >> 4;
        for (int unit = gw; unit < NB * XH * (SEQ / 16); unit += NGW) {
            const int qt16 = unit % (SEQ / 16), bh = unit / (SEQ / 16), h = bh & 3, b = bh >> 2;
            const bf16* qbase = Qb + (size_t)(b * SEQ + qt16 * 16 + l15) * D + h * XHD + 8 * g4;
            const bf16* kbase = KM + (size_t)(b * MEML + l15) * D + h * XHD + 8 * g4;
            f32x4 sc[16];
#pragma unroll
            for (int kt = 0; kt < 16; ++kt) sc[kt] = (f32x4){0.f, 0.f, 0.f, 0.f};
#pragma unroll 1
            for (int ks = 0; ks < 8; ++ks) {
                const bf16x8 q0 = *(const bf16x8*)(qbase + 32 * ks);
                const bf16* kp = kbase + 32 * ks;
#pragma unroll
                for (int kt = 0; kt < 16; ++kt) { const bf16x8 kf = *(const bf16x8*)(kp + (size_t)(16 * kt) * D);
                    sc[kt] = __builtin_amdgcn_mfma_f32_16x16x32_bf16(kf, q0, sc[kt], 0, 0, 0); }
            }
            bf16x8 pf[8];
            {
                float mx = -3.0e38f;
#pragma unroll
                for (int kt = 0; kt < 16; ++kt) mx = fmaxf(mx, fmaxf(fmaxf(sc[kt][0], sc[kt][1]), fmaxf(sc[kt][2], sc[kt][3])));
                mx = fmaxf(mx, __shfl_xor(mx, 16)); mx = fmaxf(mx, __shfl_xor(mx, 32));
                float sum = 0.f;
#pragma unroll
                for (int kt = 0; kt < 16; ++kt) {
#pragma unroll
                    for (int e = 0; e < 4; ++e) { const float p = __expf(sc[kt][e] - mx); sc[kt][e] = p; sum += p; } }
                sum += __shfl_xor(sum, 16); sum += __shfl_xor(sum, 32);
                const float inv = 1.0f / sum;
#pragma unroll
                for (int s2 = 0; s2 < 8; ++s2) { const f32x4 a = sc[2 * s2] * inv, c = sc[2 * s2 + 1] * inv;
                    u32x4 p; p.x = pk2(a[0], a[1]); p.y = pk2(a[2], a[3]); p.z = pk2(c[0], c[1]); p.w = pk2(c[2], c[3]); pf[s2] = __builtin_bit_cast(bf16x8, p); }
            }
            const bf16* vbase = VT + (size_t)(h * XHD + l15) * MROWS + b * MEML + 4 * g4;
            bf16* obase = Ob + (size_t)(b * SEQ + qt16 * 16 + l15) * D + h * XHD + 4 * g4;
#pragma unroll 1
            for (int dt = 0; dt < 16; ++dt) {
                const bf16* vp = vbase + (size_t)(16 * dt) * MROWS;
                f32x4 oc = (f32x4){0.f, 0.f, 0.f, 0.f};
#pragma unroll
                for (int s2 = 0; s2 < 8; ++s2) {
                    const u32x2 v0 = *(const u32x2*)(vp + 32 * s2), v1 = *(const u32x2*)(vp + 32 * s2 + 16);
                    u32x4 vv; vv.x = v0.x; vv.y = v0.y; vv.z = v1.x; vv.w = v1.y; const bf16x8 vf = __builtin_bit_cast(bf16x8, vv);
                    oc = __builtin_amdgcn_mfma_f32_16x16x32_bf16(vf, pf[s2], oc, 0, 0, 0);
                }
                u32x2 w; w.x = pk2(oc[0], oc[1]); w.y = pk2(oc[2], oc[3]);
                *(u32x2*)(obase + 16 * dt) = w;
            }
        }
    }
    SEAM(11);
    if (IN(12)) { PHASE_IDS;
        pg8::DenseSched S; S.o.init_tiles(M / 256, D / 256, G, bid); S.A = (const char*)Ob; S.B = (const char*)Wo_t; S.tstep = (size_t)256 * D * 2;
        EpiF32Res E{X1, X2, D}; pg8::gemm_phase(lds, D, S, E);
    }
    SEAM(12);
    if (IN(13)) { PHASE_IDS;
        LAS float* hs = (LAS float*)(lds + wave * 16384);
        const float* gfn = args.in[I_NFFG]; const float* wr_ = args.in[I_WR]; const float* br = args.in[I_BR];
        const int e = lane & 31, half = lane >> 5;
        for (int grp = gw; grp < M / 4; grp += NGW) {
            const int m0 = grp * 4;
#pragma unroll
            for (int rr = 0; rr < 4; ++rr) {
                const f32x4* xr = (const f32x4*)(X2 + (size_t)(m0 + rr) * D) + lane; const f32x4* gr = (const f32x4*)gfn + lane;
                f32x4 v[4]; float s = 0.f;
#pragma unroll
                for (int j = 0; j < 4; ++j) { v[j] = xr[64 * j]; s += (v[j].x * v[j].x + v[j].y * v[j].y) + (v[j].z * v[j].z + v[j].w * v[j].w); }
                const float rstd = 1.0f / sqrtf(wave_sum(s) * (1.f / D) + EPS);
                u32x2* o8 = (u32x2*)(HN + (size_t)(m0 + rr) * D) + lane;
#pragma unroll
                for (int j = 0; j < 4; ++j) { const f32x4 gg = gr[64 * j]; f32x4 hv = v[j] * rstd * gg; *(LAS f32x4*)(hs + rr * 1024 + 256 * j + 4 * lane) = hv;
                    u32x2 w; w.x = pk2(hv.x, hv.y); w.y = pk2(hv.z, hv.w); o8[64 * j] = w; }
            }
            asm volatile("s_waitcnt lgkmcnt(0)" ::: "memory");
            float lg[4] = {0.f, 0.f, 0.f, 0.f};
#pragma unroll 4
            for (int d = half * 512; d < half * 512 + 512; d += 4) {
                const float w0 = wr_[(d + 0) * 32 + e], w1 = wr_[(d + 1) * 32 + e], w2 = wr_[(d + 2) * 32 + e], w3 = wr_[(d + 3) * 32 + e];
#pragma unroll
                for (int rr = 0; rr < 4; ++rr) { const f32x4 h4 = *(const LAS f32x4*)(hs + rr * 1024 + d); lg[rr] += (h4.x * w0 + h4.y * w1) + (h4.z * w2 + h4.w * w3); }
            }
            const float brv = br[e];
#pragma unroll
            for (int rr = 0; rr < 4; ++rr) {
                float v = lg[rr] + __shfl_xor(lg[rr], 32) + brv;
                float selv[4]; int sele[4];
#pragma unroll
                for (int k = 0; k < 4; ++k) {
                    float mv = v; int mi = e;
#pragma unroll
                    for (int o = 1; o < 32; o <<= 1) { const float ov = __shfl_xor(mv, o); const int oi = __shfl_xor(mi, o); if (ov > mv || (ov == mv && oi < mi)) { mv = ov; mi = oi; } }
                    selv[k] = mv; sele[k] = mi; if (e == mi) v = -3.0e38f;
                }
                const float e1 = __expf(selv[1] - selv[0]), e2 = __expf(selv[2] - selv[0]), e3 = __expf(selv[3] - selv[0]);
                const float inv = 1.0f / (1.0f + e1 + e2 + e3);
                if (lane < 4) {
                    const int me = lane == 0 ? sele[0] : lane == 1 ? sele[1] : lane == 2 ? sele[2] : sele[3];
                    const float mg = (lane == 0 ? 1.0f : lane == 1 ? e1 : lane == 2 ? e2 : e3) * inv;
                    const int pos = (int)atomicAdd(ecnt + me, 1u);
                    const int ai = (m0 + rr) * 4 + lane; route_e[ai] = me; route_pos[ai] = pos; route_g[ai] = mg;
                }
            }
        }
    }
    SEAM(13);
    if (IN(14)) { PHASE_IDS;
        LAS int* pst = (LAS int*)lds;
        if (tid == 0) { int acc = 0; for (int e = 0; e < NE; ++e) { const int c = (int)__hip_atomic_load(ecnt + e, __ATOMIC_RELAXED, __HIP_MEMORY_SCOPE_AGENT); pst[e] = acc; pst[64 + e] = c; acc += (c + 255) & ~255; } pst[32] = acc; }
        __syncthreads();
        for (int t = gw; t < M; t += NGW) {
            int row = 0;
            if (lane < 4) { const int ai = t * 4 + lane; const int e = route_e[ai]; row = pst[e] + route_pos[ai]; row_slot[row] = ai; row_gate[row] = route_g[ai]; }
            const u32x4* src = (const u32x4*)(HN + (size_t)t * D);
            const u32x4 a = src[lane], c = src[64 + lane];
#pragma unroll
            for (int k = 0; k < 4; ++k) { const int rk = __shfl(row, k); u32x4* dst = (u32x4*)(XS + (size_t)rk * D); dst[lane] = a; dst[64 + lane] = c; }
        }
        if (bid < NE) { const int e = bid, c = pst[64 + e], pe = (c + 255) & ~255; for (int p = c + tid; p < pe; p += NTHREADS) { row_slot[pst[e] + p] = -1; row_gate[pst[e] + p] = 0.f; } }
        if (bid == 0 && tid == 0) { int nt = 0; for (int e = 0; e < NE; ++e) { const int n = ((pst[64 + e] + 255) & ~255) >> 8; for (int j = 0; j < n; ++j) tile_tab[16 + nt++] = e; } tile_tab[0] = nt; }
        __syncthreads();
    }
    SEAM(14);
    if (IN(15)) { PHASE_IDS;
        const int ntiles = tile_tab[0];
        pg8::MoeSched S; S.o.init_tiles(ntiles, 2048 / 256, G, bid); S.A = (const char*)XS; S.B = (const char*)Wgu_t; S.tile_e = tile_tab + 16; S.tstep = (size_t)256 * D * 2; S.estep = (size_t)2048 * D * 2;
        EpiSwiglu E{ACT, args.in[I_BGU]}; pg8::gemm_phase(lds, D, S, E);
    }
    SEAM(15);
    if (IN(16)) { PHASE_IDS;
        const int ntiles = tile_tab[0];
        pg8::MoeSched S; S.o.init_tiles(ntiles, D / 256, G, bid); S.A = (const char*)ACT; S.B = (const char*)Wdn_t; S.tile_e = tile_tab + 16; S.tstep = (size_t)256 * DFF * 2; S.estep = (size_t)D * DFF * 2;
        EpiDown E{YS, args.in[I_BDN], row_slot, row_gate}; pg8::gemm_phase(lds, DFF, S, E);
    }
    SEAM(16);
    if (IN(17)) { PHASE_IDS;
        const f32x4* gr = (const f32x4*)args.in[I_FNG] + lane;
        for (int m = gw; m < M; m += NGW) {
            const f32x4* xr = (const f32x4*)(X2 + (size_t)m * D) + lane;
            f32x4 v[4]; float s = 0.f;
#pragma unroll
            for (int j = 0; j < 4; ++j) { v[j] = xr[64 * j];
#pragma unroll
                for (int k = 0; k < 4; ++k) { const u32x2 y = *((const u32x2*)(YS + (size_t)(m * 4 + k) * D) + 64 * j + lane); v[j].x += bflo(y.x); v[j].y += bfhi(y.x); v[j].z += bflo(y.y); v[j].w += bfhi(y.y); }
                s += (v[j].x * v[j].x + v[j].y * v[j].y) + (v[j].z * v[j].z + v[j].w * v[j].w); }
            const float rstd = 1.0f / sqrtf(wave_sum(s) * (1.f / D) + EPS);
            f32x4* o = (f32x4*)(args.out + (size_t)m * D) + lane;
#pragma unroll
            for (int j = 0; j < 4; ++j) o[64 * j] = v[j] * rstd * gr[64 * j];
        }
    }
#undef IN
#undef SEAM
}

constexpr int N_PHASES = 18;
extern "C" void kernel_launch(void* const* d_in, const int* in_sizes, int n_in, void* d_out, int out_size, void* d_ws, size_t ws_size, hipStream_t stream) {
    static int grid = 0;
    if (grid == 0) {
        if (n_in != 37 || out_size != M * D || ws_size < WS_END) { fprintf(stderr, "kernel_launch: unexpected shapes (n_in %d, out %d, ws %zu); nothing launched\n", n_in, out_size, ws_size); grid = -1; return; }
        int dev = 0, cus = 0, per_cu = 0;
        if (hipGetDevice(&dev) != hipSuccess || hipDeviceGetAttribute(&cus, hipDeviceAttributeMultiprocessorCount, dev) != hipSuccess) { grid = -1; return; }
        if (hipFuncSetAttribute((const void*)fwd, hipFuncAttributeMaxDynamicSharedMemorySize, LDS_BYTES) != hipSuccess) { fprintf(stderr, "kernel_launch: hipFuncSetAttribute failed\n"); grid = -1; return; }
        if (hipOccupancyMaxActiveBlocksPerMultiprocessor(&per_cu, (const void*)fwd, NTHREADS, LDS_BYTES) != hipSuccess || per_cu < 1) fprintf(stderr, "kernel_launch: occupancy query says %d\n", per_cu);
        (void)hipGetLastError();
        grid = cus > 256 ? 256 : cus;
    }
    if (grid < 0) return;
    if (hipMemsetAsync((char*)d_ws + WS_CTL, 0, CTL_ZERO_BYTES, stream) != hipSuccess) return;
    Args a{};
    for (int i = 0; i < 37; ++i) a.in[i] = (const float*)d_in[i];
    a.out = (float*)d_out; a.ws = (unsigned char*)d_ws;
#if MK_ONE_LAUNCH
    a.ph_lo = 0; a.ph_hi = N_PHASES;
    hipLaunchKernelGGL(fwd, dim3(grid), dim3(NTHREADS), LDS_BYTES, stream, a);
#else
    for (int p = 0; p < N_PHASES; ++p) { a.ph_lo = p; a.ph_hi = p + 1; hipLaunchKernelGGL(fwd, dim3(grid), dim3(NTHREADS), LDS_BYTES, stream, a);
#ifdef PROBE_REPEAT_PHASE
        if (p == PROBE_REPEAT_PHASE) hipLaunchKernelGGL(fwd, dim3(grid), dim3(NTHREADS), LDS_BYTES, stream, a);
#endif
    }
#endif
}
```

```cpp
#include <hip/hip_runtime.h>
#include <cstdio>
#include <cstdint>

#ifndef MK_ONE_LAUNCH
#define MK_ONE_LAUNCH 1
#endif

#define DI __device__ __forceinline__
#define GAS __attribute__((address_space(1)))
#define LAS __attribute__((address_space(3)))
typedef unsigned short bf16;
typedef short bf16x8 __attribute__((ext_vector_type(8)));
typedef float f32x4 __attribute__((ext_vector_type(4)));
typedef float f32x2 __attribute__((ext_vector_type(2)));
typedef unsigned u32x4 __attribute__((ext_vector_type(4)));
typedef unsigned u32x2 __attribute__((ext_vector_type(2)));

constexpr int D = 1024, NB = 4, SEQ = 4096, M = NB * SEQ;
constexpr int MEML = 256, MROWS = NB * MEML;
constexpr int LRU_W = 512, RW = 512, NH = 8, HD = 64;
constexpr int INW = 2816;
constexpr int XH = 4, XHD = 256;
constexpr int NE = 32, TOPK = 4, DFF = 1024;
constexpr int NASSIGN = M * TOPK;
constexpr int MAXTILES = 288, MAXROWS = MAXTILES * 256;
constexpr float EPS = 1e-6f, GN_EPS = 64e-5f;

namespace pg8 {
constexpr int BM = 256, BK = 64, HALF = 128, HTB = HALF * BK * 2, STAGE_BYTES = 8 * HTB, NXCD = 8, WGM = 8;
__host__ __device__ __forceinline__ int lds_byte(int r, int c) { const int st = (r >> 4) * 2 + (c >> 5), rr = r & 15, cc = c & 31, ob = rr * 64 + cc * 2; return st * 1024 + (ob ^ (((ob >> 9) & 1) << 5)); }
__host__ __device__ __forceinline__ void stage_rc(int b, int& R, int& C) { const int st = b / 1024, sb = b % 1024, swz = sb ^ (((sb >> 9) & 1) << 5); R = (st >> 1) * 16 + swz / 64; C = (st & 1) * 32 + (swz % 64) / 2; }
__host__ __device__ __forceinline__ int perm32(int rho) { const int n = rho >> 4, i = rho & 15; return 8 * (i >> 2) + 4 * n + (i & 3); }

struct Unit { int pm, pn, e; };

struct StaticOrder {
    int nM, nN, nwg, G, c;
    __host__ __device__ void init_tiles(int nM_, int nN_, int G_, int c_) { nM = nM_; nN = nN_; nwg = nM * nN; G = G_; c = c_; }
    __host__ __device__ bool next(int i, Unit& u) const {
        const long L = (long)i * G + c; if (L >= nwg) return false;
        int wgid = (int)L; { const int q = nwg / NXCD, r = nwg % NXCD, xcd = wgid % NXCD, off = wgid / NXCD; wgid = (xcd < r ? xcd * (q + 1) : r * (q + 1) + (xcd - r) * q) + off; }
        const int nig = WGM * nN, gid = wgid / nig, fm = gid * WGM, gsz = (nM - fm) < WGM ? (nM - fm) : WGM;
        u.pm = fm + ((wgid % nig) % gsz); u.pn = (wgid % nig) / gsz; u.e = 0; return true;
    }
};
struct DenseSched {
    StaticOrder o; const char* A; const char* B; size_t tstep;
    DI bool next(int i, Unit& u) const { return o.next(i, u); }
    DI const char* a_ptr(const Unit& u) const { return A + (size_t)u.pm * tstep; }
    DI const char* b_ptr(const Unit& u) const { return B + (size_t)u.pn * tstep; }
};
struct MoeSched {
    StaticOrder o; const char* A; const char* B; const int* tile_e; size_t tstep, estep;
    DI bool next(int i, Unit& u) const { if (!o.next(i, u)) return false; u.e = tile_e[u.pm]; return true; }
    DI const char* a_ptr(const Unit& u) const { return A + (size_t)u.pm * tstep; }
    DI const char* b_ptr(const Unit& u) const { return B + (size_t)u.e * estep + (size_t)u.pn * tstep; }
};

DI unsigned cvt_pk_bf16(float lo, float hi) { unsigned r; asm volatile("v_cvt_pk_bf16_f32 %0, %1, %2" : "=v"(r) : "v"(lo), "v"(hi)); return r; }

template <class Epi, class Sched, bool ALIGN_EPI = true, bool SP2 = true>
DI void gemm_phase(LAS unsigned char* lds, const int K, const Sched& S, const Epi& E) {
    const int tid = threadIdx.x, wid = __builtin_amdgcn_readfirstlane(tid >> 6), lane = tid & 63, wr = wid >> 2, wc = wid & 3, fr = lane & 15, fq = lane >> 4;
    const int nt = K / BK;
    unsigned voffA[2], voffB[2];
#pragma unroll
    for (int i = 0; i < 2; ++i) { int R, C; stage_rc(tid * 16 + i * 8192, R, C); const int Rb = Epi::PERM ? ((R & ~31) + perm32(R & 31)) : R;
        voffA[i] = (unsigned)(R * K + C) * 2u; voffB[i] = (unsigned)(Rb * K + C) * 2u; }
    const size_t kstep = (size_t)(BK * 2);
    const size_t hstep = (size_t)HALF * K * 2;
    const unsigned ldsw = (unsigned)wid * 1024u;
    const int aoff = lds_byte(wr * 64 + fr, fq * 8), boff = lds_byte(wc * 32 + fr, fq * 8);
#define PG8_SA(b, h) (((b) * 2 + (h)) * HTB)
#define PG8_SB(b, h) ((4 + (b) * 2 + (h)) * HTB)
#define PG8_STAGE(bufoff, gbase, voff) do { _Pragma("unroll") for (int _i = 0; _i < 2; ++_i) \
        __builtin_amdgcn_global_load_lds((const unsigned*)((const char*)(gbase) + (voff)[_i]), (LAS unsigned*)(lds + (bufoff) + ldsw + _i * 8192), 16, 0, 0); } while (0)
#define PG8_LDA(dst, b, h) do { _Pragma("unroll") for (int m = 0; m < 4; ++m) _Pragma("unroll") for (int k = 0; k < 2; ++k) dst[m][k] = *(const LAS bf16x8*)(lds + PG8_SA(b, h) + aoff + m * 2048 + k * 1024); } while (0)
#define PG8_LDB(dst, b, h) do { _Pragma("unroll") for (int n = 0; n < 2; ++n) _Pragma("unroll") for (int k = 0; k < 2; ++k) dst[n][k] = *(const LAS bf16x8*)(lds + PG8_SB(b, h) + boff + n * 2048 + k * 1024); } while (0)
#define PG8_MMA(ai, bj, At, Bt) do { __builtin_amdgcn_s_setprio(1); _Pragma("unroll") for (int m = 0; m < 4; ++m) _Pragma("unroll") for (int n = 0; n < 2; ++n) _Pragma("unroll") for (int k = 0; k < 2; ++k) \
        acc[ai][bj][m][n] = __builtin_amdgcn_mfma_f32_16x16x32_bf16(Bt[n][k], At[m][k], acc[ai][bj][m][n], 0, 0, 0); __builtin_amdgcn_s_setprio(0); } while (0)
#define PG8_WAIT_V(n) asm volatile("s_waitcnt vmcnt(" #n ")" ::: "memory")
#define PG8_WAIT_L(n) asm volatile("s_waitcnt lgkmcnt(" #n ")" ::: "memory")
#define PG8_BAR __builtin_amdgcn_s_barrier()
#define PG8_SCHED __builtin_amdgcn_sched_barrier(0)
    Unit cur, nxt; int ui = 0;
    if (!S.next(0, cur)) return;
    f32x4 acc[2][2][4][2];
#pragma unroll
    for (int a = 0; a < 2; ++a)
#pragma unroll
        for (int b = 0; b < 2; ++b)
#pragma unroll
            for (int m = 0; m < 4; ++m)
#pragma unroll
                for (int n = 0; n < 2; ++n) acc[a][b][m][n] = (f32x4){0.f, 0.f, 0.f, 0.f};
    bf16x8 At[4][2], B0[2][2], B1[2][2];
    const char* cA = S.a_ptr(cur); const char* cB = S.b_ptr(cur);
    if constexpr (SP2) {
        PG8_STAGE(PG8_SB(0, 0), cB, voffB); PG8_STAGE(PG8_SB(0, 1), cB + hstep, voffB); PG8_STAGE(PG8_SA(0, 0), cA, voffA); PG8_STAGE(PG8_SA(0, 1), cA + hstep, voffA);
        if (wr == 1) PG8_BAR;
        PG8_WAIT_V(2); PG8_BAR;
        PG8_STAGE(PG8_SB(1, 0), cB + kstep, voffB); PG8_STAGE(PG8_SA(1, 0), cA + kstep, voffA); PG8_STAGE(PG8_SB(1, 1), cB + hstep + kstep, voffB);
        PG8_WAIT_V(6); PG8_BAR;
    } else {
        PG8_STAGE(PG8_SB(0, 0), cB, voffB); PG8_STAGE(PG8_SA(0, 0), cA, voffA); PG8_STAGE(PG8_SB(0, 1), cB + hstep, voffB); PG8_STAGE(PG8_SA(0, 1), cA + hstep, voffA);
        if (wr == 1) PG8_BAR;
        PG8_WAIT_V(4); PG8_BAR;
        PG8_STAGE(PG8_SB(1, 0), cB + kstep, voffB); PG8_STAGE(PG8_SA(1, 0), cA + kstep, voffA); PG8_STAGE(PG8_SB(1, 1), cB + hstep + kstep, voffB);
        PG8_WAIT_V(6); PG8_BAR;
    }
    for (;;) {
        const bool has_next = S.next(ui + 1, nxt);
        const char* nA = has_next ? S.a_ptr(nxt) : cA; const char* nB = has_next ? S.b_ptr(nxt) : cB;
        for (int t = 0; t < nt; t += 2) {
            const bool last = (t == nt - 2);
            const char* a1 = cA + (size_t)(t + 1) * kstep;
            const char* a2 = last ? nA : cA + (size_t)(t + 2) * kstep; const char* b2 = last ? nB : cB + (size_t)(t + 2) * kstep;
            const char* a3 = a2 + kstep; const char* b3 = b2 + kstep;
            if constexpr (SP2) {
            PG8_LDB(B0, 0, 0); PG8_LDB(B1, 0, 1); PG8_SCHED; PG8_LDA(At, 0, 0); PG8_STAGE(PG8_SA(1, 1), a1 + hstep, voffA);
            PG8_WAIT_V(8); PG8_WAIT_L(0); PG8_BAR; PG8_MMA(0, 0, At, B0); PG8_MMA(0, 1, At, B1); PG8_BAR; PG8_SCHED;
            PG8_LDA(At, 0, 1); PG8_STAGE(PG8_SB(0, 0), b2, voffB); PG8_STAGE(PG8_SB(0, 1), b2 + hstep, voffB); PG8_STAGE(PG8_SA(0, 0), a2, voffA);
            PG8_WAIT_V(8); PG8_WAIT_L(0); PG8_BAR; PG8_MMA(1, 0, At, B0); PG8_MMA(1, 1, At, B1); PG8_BAR; PG8_SCHED;
            PG8_LDB(B0, 1, 0); PG8_LDB(B1, 1, 1); PG8_SCHED; PG8_LDA(At, 1, 0); PG8_STAGE(PG8_SA(0, 1), a2 + hstep, voffA);
            PG8_WAIT_V(8); PG8_WAIT_L(0); PG8_BAR; PG8_MMA(0, 0, At, B0); PG8_MMA(0, 1, At, B1); PG8_BAR; PG8_SCHED;
            PG8_LDA(At, 1, 1); PG8_STAGE(PG8_SB(1, 0), b3, voffB); PG8_STAGE(PG8_SB(1, 1), b3 + hstep, voffB); PG8_STAGE(PG8_SA(1, 0), a3, voffA);
            PG8_WAIT_V(8); PG8_WAIT_L(0); PG8_BAR; PG8_MMA(1, 0, At, B0); PG8_MMA(1, 1, At, B1); PG8_BAR; PG8_SCHED;
            } else {
            PG8_LDB(B0, 0, 0); PG8_SCHED; PG8_LDA(At, 0, 0); PG8_STAGE(PG8_SA(1, 1), a1 + hstep, voffA);
            PG8_WAIT_L(8); PG8_BAR; PG8_WAIT_L(0); PG8_MMA(0, 0, At, B0); PG8_BAR; PG8_SCHED;
            PG8_LDB(B1, 0, 1); PG8_STAGE(PG8_SB(0, 0), b2, voffB);
            PG8_BAR; PG8_WAIT_L(0); PG8_MMA(0, 1, At, B1); PG8_BAR;
            PG8_LDA(At, 0, 1); PG8_STAGE(PG8_SA(0, 0), a2, voffA);
            PG8_BAR; PG8_WAIT_L(0); PG8_MMA(1, 0, At, B0); PG8_BAR; PG8_SCHED;
            PG8_STAGE(PG8_SB(0, 1), b2 + hstep, voffB);
            PG8_WAIT_V(6); PG8_BAR; PG8_MMA(1, 1, At, B1); PG8_BAR;
            PG8_LDB(B0, 1, 0); PG8_SCHED; PG8_LDA(At, 1, 0); PG8_STAGE(PG8_SA(0, 1), a2 + hstep, voffA);
            PG8_WAIT_L(8); PG8_BAR; PG8_WAIT_L(0); PG8_MMA(0, 0, At, B0); PG8_BAR; PG8_SCHED;
            PG8_LDB(B1, 1, 1); PG8_STAGE(PG8_SB(1, 0), b3, voffB);
            PG8_BAR; PG8_WAIT_L(0); PG8_MMA(0, 1, At, B1); PG8_BAR;
            PG8_LDA(At, 1, 1); PG8_STAGE(PG8_SA(1, 0), a3, voffA);
            PG8_BAR; PG8_WAIT_L(0); PG8_MMA(1, 0, At, B0); PG8_BAR; PG8_SCHED;
            PG8_STAGE(PG8_SB(1, 1), b3 + hstep, voffB);
            PG8_WAIT_V(6); PG8_BAR; PG8_MMA(1, 1, At, B1); PG8_BAR;
            }
        }
        if constexpr (ALIGN_EPI) { if (wr == 0) PG8_BAR; }
        E(acc, cur, wr, wc, fr, fq);
        if (!has_next) break;
#pragma unroll
        for (int a = 0; a < 2; ++a)
#pragma unroll
            for (int b = 0; b < 2; ++b)
#pragma unroll
                for (int m = 0; m < 4; ++m)
#pragma unroll
                    for (int n = 0; n < 2; ++n) acc[a][b][m][n] = (f32x4){0.f, 0.f, 0.f, 0.f};
        cur = nxt; cA = nA; cB = nB; ++ui;
        if constexpr (ALIGN_EPI) { if (wr == 1) PG8_BAR; }
    }
    PG8_WAIT_V(0);
    if constexpr (!ALIGN_EPI) { if (wr == 0) PG8_BAR; }
    PG8_BAR;
#undef PG8_SA
#undef PG8_SB
#undef PG8_STAGE
#undef PG8_LDA
#undef PG8_LDB
#undef PG8_MMA
#undef PG8_WAIT_V
#undef PG8_WAIT_L
#undef PG8_BAR
#undef PG8_SCHED
}
}
using pg8::Unit;
using pg8::cvt_pk_bf16;

DI float bflo(unsigned w) { return __uint_as_float(w << 16); }
DI float bfhi(unsigned w) { return __uint_as_float(w & 0xffff0000u); }
DI float bf2f(bf16 b) { return __uint_as_float(((unsigned)b) << 16); }
DI unsigned f2bf(float f) { unsigned u = __float_as_uint(f); return (u + 0x7fffu + ((u >> 16) & 1u)) >> 16; }
DI unsigned pk2(float lo, float hi) { return f2bf(lo) | (f2bf(hi) << 16); }
DI float sigmoid_f(float x) { return 1.0f / (1.0f + __expf(-x)); }
DI float softplus_f(float x) { return fmaxf(x, 0.f) + log1pf(__expf(-fabsf(x))); }
DI float softplus_fast(float x) { return fmaxf(x, 0.f) + __logf(1.0f + __expf(-fabsf(x))); }
DI float gelu_tanh_f(float x) { const float u = 0.7978845608028654f * (x + 0.044715f * x * x * x); return 0.5f * x * (1.0f + tanhf(u)); }
DI int fresh_tid() { int t = threadIdx.x; asm volatile("" : "+v"(t)); return t; }
DI float wave_sum(float v) {
#pragma unroll
    for (int o = 1; o < 64; o <<= 1) v += __shfl_xor(v, o);
    return v;
}

struct EpiBf16Plain {
    static constexpr bool PERM = true;
    bf16* O; int ldc; float scale;
    DI void operator()(const f32x4 (&acc)[2][2][4][2], const Unit& u, int wr, int wc, int fr, int fq) const {
        const int row0 = u.pm * 256 + wr * 64 + fr, col0 = u.pn * 256 + wc * 32 + 8 * fq;
#pragma unroll
        for (int ai = 0; ai < 2; ++ai)
#pragma unroll
            for (int m = 0; m < 4; ++m) { bf16* rowp = O + (size_t)(row0 + ai * 128 + m * 16) * ldc + col0;
#pragma unroll
                for (int bj = 0; bj < 2; ++bj) { const f32x4 v0 = acc[ai][bj][m][0] * scale, v1 = acc[ai][bj][m][1] * scale;
                    u32x4 w; w.x = cvt_pk_bf16(v0[0], v0[1]); w.y = cvt_pk_bf16(v0[2], v0[3]); w.z = cvt_pk_bf16(v1[0], v1[1]); w.w = cvt_pk_bf16(v1[2], v1[3]);
                    *(u32x4*)(rowp + bj * 128) = w; } }
    }
};
struct EpiF32Res {
    static constexpr bool PERM = false;
    const float* Rz; float* C; int ldc;
    DI void operator()(const f32x4 (&acc)[2][2][4][2], const Unit& u, int wr, int wc, int fr, int fq) const {
        const int row0 = u.pm * 256 + wr * 64 + fr, col0 = u.pn * 256 + wc * 32 + 4 * fq;
#pragma unroll
        for (int ai = 0; ai < 2; ++ai)
#pragma unroll
            for (int m = 0; m < 4; ++m) { const size_t off = (size_t)(row0 + ai * 128 + m * 16) * ldc + col0;
#pragma unroll
                for (int bj = 0; bj < 2; ++bj)
#pragma unroll
                    for (int n = 0; n < 2; ++n) { const f32x4 r = *(const f32x4*)(Rz + off + bj * 128 + n * 16); *(f32x4*)(C + off + bj * 128 + n * 16) = r + acc[ai][bj][m][n]; } }
    }
};
struct EpiLora {
    static constexpr bool PERM = false;
    float* WD3; const float* w0; const float* a0;
    DI void operator()(const f32x4 (&acc)[2][2][4][2], const Unit& u, int wr, int wc, int fr, int fq) const {
        const int kind = u.pn >> 1;
        const int row0 = u.pm * 256 + wr * 64 + fr, col0 = (u.pn & 1) * 256 + wc * 32 + 4 * fq;
        float* dst = WD3 + (size_t)kind * (size_t)(8u << 20);
#pragma unroll
        for (int bj = 0; bj < 2; ++bj)
#pragma unroll
            for (int n = 0; n < 2; ++n) {
                const int c = col0 + bj * 128 + n * 16;
                f32x4 bias = (f32x4){0.f, 0.f, 0.f, 0.f};
                if (kind == 0) bias = *(const f32x4*)(w0 + c); else if (kind == 1) bias = *(const f32x4*)(a0 + c);
#pragma unroll
                for (int ai = 0; ai < 2; ++ai)
#pragma unroll
                    for (int m = 0; m < 4; ++m) {
                        f32x4 v = acc[ai][bj][m][n] + bias;
                        if (kind == 0) {
#pragma unroll
                            for (int j = 0; j < 4; ++j) { const float w = -softplus_fast(-v[j]) - 0.5f; v[j] = -__expf(w);     }
                        } else if (kind == 1) {
#pragma unroll
                            for (int j = 0; j < 4; ++j) v[j] = sigmoid_f(v[j]);
                        }
                        *(f32x4*)(dst + (size_t)(row0 + ai * 128 + m * 16) * 512 + c) = v;
                    }
            }
    }
};
struct EpiSwiglu {
    static constexpr bool PERM = true;
    bf16* ACT; const float* b_gu;
    DI void operator()(const f32x4 (&acc)[2][2][4][2], const Unit& u, int wr, int wc, int fr, int fq) const {
        const int row0 = u.pm * 256 + wr * 64 + fr, j0 = u.pn * 128 + wc * 32 + 8 * fq;
        const float* bg = b_gu + (size_t)u.e * 2048 + j0; const float* bu = bg + 1024;
        const f32x4 bg0 = *(const f32x4*)bg, bg1 = *(const f32x4*)(bg + 4), bu0 = *(const f32x4*)bu, bu1 = *(const f32x4*)(bu + 4);
#pragma unroll
        for (int ai = 0; ai < 2; ++ai)
#pragma unroll
            for (int m = 0; m < 4; ++m) {
                float o[8];
#pragma unroll
                for (int n = 0; n < 2; ++n) { const f32x4 g4 = acc[ai][0][m][n] + (n ? bg1 : bg0), u4 = acc[ai][1][m][n] + (n ? bu1 : bu0);
#pragma unroll
                    for (int j = 0; j < 4; ++j) { const float g = fminf(g4[j], 7.0f), up = fminf(fmaxf(u4[j], -7.0f), 7.0f); o[n * 4 + j] = (up + 1.0f) * (g * sigmoid_f(1.702f * g)); } }
                u32x4 w; w.x = cvt_pk_bf16(o[0], o[1]); w.y = cvt_pk_bf16(o[2], o[3]); w.z = cvt_pk_bf16(o[4], o[5]); w.w = cvt_pk_bf16(o[6], o[7]);
                *(u32x4*)(ACT + (size_t)(row0 + ai * 128 + m * 16) * 1024 + j0) = w;
            }
    }
};
struct EpiDown {
    static constexpr bool PERM = true;
    bf16* YS; const float* b_dn; const int* row_slot; const float* row_gate;
    DI void operator()(const f32x4 (&acc)[2][2][4][2], const Unit& u, int wr, int wc, int fr, int fq) const {
        const int row0 = u.pm * 256 + wr * 64 + fr, col0 = u.pn * 256 + wc * 32 + 8 * fq;
        const float* bb = b_dn + (size_t)u.e * 1024 + col0;
        f32x4 bv[2][2];
#pragma unroll
        for (int bj = 0; bj < 2; ++bj)
#pragma unroll
            for (int n = 0; n < 2; ++n) bv[bj][n] = *(const f32x4*)(bb + bj * 128 + 4 * n);
#pragma unroll
        for (int ai = 0; ai < 2; ++ai)
#pragma unroll
            for (int m = 0; m < 4; ++m) {
                const int r = row0 + ai * 128 + m * 16; const int slot = row_slot[r]; const float gt = row_gate[r];
                if (slot >= 0) { bf16* rowp = YS + (size_t)slot * 1024 + col0;
#pragma unroll
                    for (int bj = 0; bj < 2; ++bj) { const f32x4 v0 = (acc[ai][bj][m][0] + bv[bj][0]) * gt, v1 = (acc[ai][bj][m][1] + bv[bj][1]) * gt;
                        u32x4 w; w.x = cvt_pk_bf16(v0[0], v0[1]); w.y = cvt_pk_bf16(v0[2], v0[3]); w.z = cvt_pk_bf16(v1[0], v1[1]); w.w = cvt_pk_bf16(v1[2], v1[3]);
                        *(u32x4*)(rowp + bj * 128) = w; } }
            }
    }
};

constexpr size_t MiB = 1u << 20;
constexpr size_t WS_CTL = 0, CTL_ZERO_BYTES = 1 * MiB;
constexpr size_t WS_WIN = 1 * MiB, WS_WOUT = 7 * MiB, WS_WQ = 9 * MiB, WS_WK = 11 * MiB, WS_WV = 13 * MiB, WS_WO = 15 * MiB, WS_LORAB = 17 * MiB, WS_LRUW = 18 * MiB;
constexpr size_t WS_ROUTE = 19 * MiB;
constexpr size_t WS_WGU = 22 * MiB, WS_WDN = 150 * MiB;
constexpr size_t WS_HN = 214 * MiB, WS_MEMN = 246 * MiB, WS_KM = 248 * MiB, WS_VT = 250 * MiB;
constexpr size_t WS_X1 = 252 * MiB, WS_X2 = 316 * MiB;
constexpr size_t WS_U = 380 * MiB, WS_R = 468 * MiB, WS_KRAW = 500 * MiB, WS_V = 532 * MiB, WS_KKN = 564 * MiB, WS_WD = 596 * MiB, WS_AA = 628 * MiB, WS_G = 660 * MiB;
constexpr size_t WS_LA = 692 * MiB, WS_LB = 724 * MiB, WS_AP = 756 * MiB, WS_CAT = 764 * MiB, WS_Q = 796 * MiB;
constexpr size_t WS_XS = 380 * MiB, WS_ACT = 524 * MiB, WS_YS = 668 * MiB;
constexpr size_t WS_GP = 796 * MiB, WS_HF = 860 * MiB, WS_RP = 924 * MiB, WS_Y1F = 940 * MiB, WS_ADD = 972 * MiB, WS_END = 1004 * MiB;
constexpr size_t WS_GC = 468 * MiB, WS_HC = 484 * MiB, WS_ZS = 500 * MiB;
static_assert(WS_AA == WS_WD + 32 * MiB && WS_G == WS_AA + 32 * MiB, "EpiLora strides");
static_assert(WS_U + (size_t)M * INW * 2 <= WS_R && WS_XS + (size_t)MAXROWS * 2048 <= WS_ACT && WS_ACT + (size_t)MAXROWS * 2048 <= WS_YS && WS_YS + (size_t)NASSIGN * 2048 <= WS_Q, "ws map");
constexpr size_t RT_E = 0, RT_POS = 256 * 1024, RT_G = 512 * 1024, RT_SLOT = 768 * 1024, RT_GATE = 1088 * 1024, RT_TILE = 1408 * 1024;
constexpr int CW_BAR = 4096, CW_CNT = 8192;

constexpr int RING_BYTES = 131072, MISC_OFF = RING_BYTES + 320, LDS_BYTES = 147456;
constexpr int NWAVES = 8, NTHREADS = 512;

#define XB_TMO      128
#define XB_XCNT(j)  (256  + 64 * (j))
#define XB_XSUB(j)  (1280 + 64 * (j))
#define XB_XGEN(j)  (2304 + 64 * (j))
#define XB_TOP      3328
#define XB_TOPGEN   3392
#define XCD_BAR_WORDS 3456
#define XB_SPIN_CAP (1u << 18)
DI unsigned xb_ld(unsigned* p)              { return __hip_atomic_load(p, __ATOMIC_RELAXED, __HIP_MEMORY_SCOPE_AGENT); }
DI unsigned xb_add(unsigned* p, unsigned v) { return __hip_atomic_fetch_add(p, v, __ATOMIC_RELAXED, __HIP_MEMORY_SCOPE_AGENT); }
DI unsigned xb_xcc_id() { return (unsigned)__builtin_amdgcn_s_getreg((3 << 11) | 20) & 0xFu; }
#define XB_SPIN(cond, bar) do { unsigned _sp = 0; while (cond) { __builtin_amdgcn_s_sleep(1); \
    if ((++_sp & 255u) == 0u) { if (xb_ld(&(bar)[XB_TMO])) break; if (_sp > XB_SPIN_CAP) { atomicAdd(&(bar)[XB_TMO], 1u); break; } } } } while (0)
struct XcdBarrier { unsigned* bar; unsigned x; volatile LAS unsigned* st; };
DI XcdBarrier xcd_barrier_post(unsigned* bar, volatile LAS unsigned* st) {
    XcdBarrier b; b.bar = bar; b.x = xb_xcc_id(); b.st = st;
    if (threadIdx.x == 0) (void)xb_add(&bar[XB_XCNT(b.x)], 1u);
    return b;
}
DI void xcd_barrier_complete(unsigned* bar, unsigned x, unsigned& nloc, unsigned& nx) {
    const unsigned G = gridDim.x * gridDim.y * gridDim.z;
    unsigned sum, cnt, mine, sp = 0u;
    for (;;) {
        sum = 0u; cnt = 0u; mine = 0u;
#pragma unroll
        for (unsigned j = 0; j < 16; ++j) { const unsigned c = xb_ld(&bar[XB_XCNT(j)]); sum += c; cnt += (c > 0u) ? 1u : 0u; mine = (j == x) ? c : mine; }
        if (sum == G) break;
        __builtin_amdgcn_s_sleep(1);
        if ((++sp & 255u) == 0u) { if (xb_ld(&bar[XB_TMO])) break; if (sp > XB_SPIN_CAP) { atomicAdd(&bar[XB_TMO], 1u); break; } }
    }
    nloc = mine > 0u ? mine : 1u; nx = cnt > 0u ? cnt : 1u;
}
DI void xcd_barrier(const XcdBarrier& b) {
    asm volatile("s_waitcnt vmcnt(0)" ::: "memory");
    __syncthreads();
    if (threadIdx.x == 0) {
        unsigned* bar = b.bar;
        __builtin_amdgcn_s_waitcnt(0);
        unsigned nloc = b.st[0], nx = b.st[1];
        if (nloc == 0u) { xcd_barrier_complete(bar, b.x, nloc, nx); b.st[0] = nloc; b.st[1] = nx; }
        const unsigned old = xb_add(&bar[XB_XSUB(b.x)], 1u);
        const unsigned gen = old / nloc;
        if (old + 1u == (gen + 1u) * nloc) {
            __builtin_amdgcn_fence(__ATOMIC_RELEASE, "agent");
            asm volatile("s_waitcnt vmcnt(0)" ::: "memory");
            const unsigned og = xb_add(&bar[XB_TOP], 1u);
            const unsigned tg = og / nx;
            if (og + 1u == (tg + 1u) * nx) xb_add(&bar[XB_TOPGEN], 1u);
            else XB_SPIN(xb_ld(&bar[XB_TOPGEN]) == tg, bar);
            __builtin_amdgcn_fence(__ATOMIC_ACQUIRE, "agent");
            xb_add(&bar[XB_XGEN(b.x)], 1u);
            asm volatile("s_waitcnt vmcnt(0)" ::: "memory");
        } else {
            XB_SPIN(xb_ld(&bar[XB_XGEN(b.x)]) == gen, bar);
            __builtin_amdgcn_fence(__ATOMIC_ACQUIRE, "agent");
            asm volatile("s_waitcnt vmcnt(0)" ::: "memory");
        }
    }
    __syncthreads();
}

struct Args { const float* in[37]; float* out; unsigned char* ws; int ph_lo, ph_hi; };
enum { I_X = 0, I_MEM, I_NMIXG, I_WIN, I_CONVW, I_CONVB, I_LWX, I_LBX, I_LWA, I_LBA, I_LAM, I_MU, I_W0, I_WUP, I_A0, I_AUP, I_GUP, I_KK, I_KA, I_RK, I_LNG, I_LNB,
       I_WOUT, I_NXAG, I_NMEMG, I_WQ, I_WK, I_WV, I_WO, I_NFFG, I_WR, I_BR, I_WGU, I_BGU, I_WDN, I_BDN, I_FNG };

DI void transpose_item(const float* W, int ldw, int K, bf16* WT, int k0, int n0, int drow0, LAS float* scr, int lane) {
#pragma unroll 8
    for (int i = 0; i < 32; ++i) { const int kk = 2 * i + (lane >> 5); scr[kk * 33 + (lane & 31)] = W[(size_t)(k0 + kk) * ldw + n0 + (lane & 31)]; }
    asm volatile("s_waitcnt lgkmcnt(0)" ::: "memory");
    const int c = lane & 7;
#pragma unroll
    for (int j = 0; j < 4; ++j) { const int n = (lane >> 3) + 8 * j; const LAS float* s = scr + (8 * c) * 33 + n;
        u32x4 o; o.x = pk2(s[0 * 33], s[1 * 33]); o.y = pk2(s[2 * 33], s[3 * 33]); o.z = pk2(s[4 * 33], s[5 * 33]); o.w = pk2(s[6 * 33], s[7 * 33]);
        *(u32x4*)(WT + (size_t)(drow0 + n) * K + k0 + 8 * c) = o; }
    asm volatile("s_waitcnt lgkmcnt(0)" ::: "memory");
}
DI void rms_row_to_bf16(const float* xrow, const float* g, bf16* orow, int lane) {
    const f32x4* xr = (const f32x4*)xrow + lane; const f32x4* gr = (const f32x4*)g + lane;
    f32x4 v[4]; float s = 0.f;
#pragma unroll
    for (int j = 0; j < 4; ++j) { v[j] = xr[64 * j]; s += (v[j].x * v[j].x + v[j].y * v[j].y) + (v[j].z * v[j].z + v[j].w * v[j].w); }
    const float rstd = 1.0f / sqrtf(wave_sum(s) * (1.f / D) + EPS);
    u32x2* o8 = (u32x2*)orow + lane;
#pragma unroll
    for (int j = 0; j < 4; ++j) { const f32x4 gg = gr[64 * j]; u32x2 w; w.x = pk2(v[j].x * rstd * gg.x, v[j].y * rstd * gg.y); w.y = pk2(v[j].z * rstd * gg.z, v[j].w * rstd * gg.w); o8[64 * j] = w; }
}

__global__ void __launch_bounds__(NTHREADS, 2) fwd(Args args) {
    extern __shared__ __attribute__((aligned(16))) unsigned char lds_raw[];
    LAS unsigned char* lds = (LAS unsigned char*)lds_raw;
    volatile LAS unsigned* MISC = (volatile LAS unsigned*)(lds + MISC_OFF);
    const int G = gridDim.x, bid = blockIdx.x, NGW = G * NWAVES;
#define PHASE_IDS const int tid = fresh_tid(), lane = tid & 63, wave = __builtin_amdgcn_readfirstlane(tid >> 6), gw = bid * NWAVES + wave; (void)tid; (void)lane; (void)wave; (void)gw
    unsigned char* ws = args.ws;
    unsigned* ctl = (unsigned*)(ws + WS_CTL);
    const int lo = args.ph_lo, hi = args.ph_hi;

    for (int u = threadIdx.x; u < (LDS_BYTES - RING_BYTES) / 4; u += NTHREADS) ((LAS unsigned*)(lds + RING_BYTES))[u] = 0u;
    __syncthreads();
    XcdBarrier bar; bar.bar = ctl + CW_BAR; bar.x = 0; bar.st = nullptr;
    if (hi - lo > 1) bar = xcd_barrier_post(ctl + CW_BAR, MISC + 8);
#define IN(k) (lo <= (k) && (k) < hi)
#define SEAM(k) do { if (IN(k) && IN((k) + 1)) xcd_barrier(bar); } while (0)

#define Win_t ((bf16*)(ws + WS_WIN))
#define Wout_t ((bf16*)(ws + WS_WOUT))
#define Wq_t ((bf16*)(ws + WS_WQ))
#define Wk_t ((bf16*)(ws + WS_WK))
#define Wv_t ((bf16*)(ws + WS_WV))
#define Wo_t ((bf16*)(ws + WS_WO))
#define LoraB ((bf16*)(ws + WS_LORAB))
#define LruW ((bf16*)(ws + WS_LRUW))
#define Wgu_t ((bf16*)(ws + WS_WGU))
#define Wdn_t ((bf16*)(ws + WS_WDN))
#define HN ((bf16*)(ws + WS_HN))
#define MEMN ((bf16*)(ws + WS_MEMN))
#define KM ((bf16*)(ws + WS_KM))
#define VT ((bf16*)(ws + WS_VT))
#define X1 ((float*)(ws + WS_X1))
#define X2 ((float*)(ws + WS_X2))
#define U ((bf16*)(ws + WS_U))
#define Rr ((float*)(ws + WS_R))
#define KRAW ((float*)(ws + WS_KRAW))
#define Vv ((float*)(ws + WS_V))
#define KKN ((float*)(ws + WS_KKN))
#define WD ((float*)(ws + WS_WD))
#define AA ((float*)(ws + WS_AA))
#define GG ((float*)(ws + WS_G))
#define LA ((float*)(ws + WS_LA))
#define LB ((float*)(ws + WS_LB))
#define AP ((bf16*)(ws + WS_AP))
#define CAT ((bf16*)(ws + WS_CAT))
#define Qb ((bf16*)(ws + WS_Q))
#define Ob CAT
#define XS ((bf16*)(ws + WS_XS))
#define ACT ((bf16*)(ws + WS_ACT))
#define YS ((bf16*)(ws + WS_YS))
#define route_e ((int*)(ws + WS_ROUTE + RT_E))
#define route_pos ((int*)(ws + WS_ROUTE + RT_POS))
#define route_g ((float*)(ws + WS_ROUTE + RT_G))
#define row_slot ((int*)(ws + WS_ROUTE + RT_SLOT))
#define row_gate ((float*)(ws + WS_ROUTE + RT_GATE))
#define tile_tab ((int*)(ws + WS_ROUTE + RT_TILE))
#define ecnt (ctl + CW_CNT)

    if (IN(0)) { PHASE_IDS;
        LAS float* scr = (LAS float*)(lds + wave * 16384);
        constexpr int I_IN = 16 * (INW / 32), I_SQ = 16 * 32;
        constexpr int N_ITEMS = I_IN + 5 * I_SQ;
        for (int it = gw; it < N_ITEMS; it += NGW) {
            int r = it;
            if (r < I_IN) { const int nblk = INW / 32, kb = r / nblk, nb = r % nblk; transpose_item(args.in[I_WIN], INW, D, Win_t, 64 * kb, 32 * nb, 32 * nb, scr, lane); continue; } r -= I_IN;
            { const int w = r / I_SQ, q = r % I_SQ, kb = q / 32, nb = q % 32;
                const float* src = w == 0 ? args.in[I_WOUT] : w == 1 ? args.in[I_WQ] : w == 2 ? args.in[I_WK] : w == 3 ? args.in[I_WV] : args.in[I_WO];
                bf16* dst = w == 0 ? Wout_t : w == 1 ? Wq_t : w == 2 ? Wk_t : w == 3 ? Wv_t : Wo_t;
                transpose_item(src, D, D, dst, 64 * kb, 32 * nb, 32 * nb, scr, lane); }
        }
        for (int idx = bid * NTHREADS + tid; idx < 1536 * 256; idx += G * NTHREADS) {
            const int n = idx >> 8, k = idx & 255; float v = 0.f;
            if (n < 512) { if (k < 64) v = args.in[I_WUP][k * 512 + n]; }
            else if (n < 1024) { if (k >= 64 && k < 128) v = args.in[I_AUP][(k - 64) * 512 + (n - 512)]; }
            else { if (k >= 128) v = args.in[I_GUP][(k - 128) * 512 + (n - 1024)]; }
            LoraB[idx] = (bf16)f2bf(v);
        }
        for (int idx = bid * NTHREADS + tid; idx < 8 * 128 * 64; idx += G * NTHREADS) {
            const int nb = idx >> 13, col = (idx >> 6) & 127, k = idx & 63;
            const float v = col < 64 ? args.in[I_LWX][nb * 4096 + k * 64 + col] : args.in[I_LWA][nb * 4096 + k * 64 + (col - 64)];
            LruW[idx] = (bf16)f2bf(v);
        }
        for (int m = gw; m < M; m += NGW) rms_row_to_bf16(args.in[I_X] + (size_t)m * D, args.in[I_NMIXG], HN + (size_t)m * D, lane);
        for (int m = gw; m < MROWS; m += NGW) rms_row_to_bf16(args.in[I_MEM] + (size_t)m * D, args.in[I_NMEMG], MEMN + (size_t)m * D, lane);
    }
    SEAM(0);

    if (IN(1)) { PHASE_IDS;
        { pg8::DenseSched S; S.o.init_tiles(M / 256, INW / 256, G, bid); S.A = (const char*)HN; S.B = (const char*)Win_t; S.tstep = (size_t)256 * D * 2;
          EpiBf16Plain E{U, INW, 1.0f}; pg8::gemm_phase(lds, D, S, E); }
        { pg8::DenseSched S; S.o.init_tiles(MROWS / 256, D / 256, G, (bid + 64) & (G - 1)); S.A = (const char*)MEMN; S.B = (const char*)Wk_t; S.tstep = (size_t)256 * D * 2;
          EpiBf16Plain E{KM, D, 1.0f}; pg8::gemm_phase(lds, D, S, E); }
        { pg8::DenseSched S; S.o.init_tiles(D / 256, MROWS / 256, G, (bid + 48) & (G - 1)); S.A = (const char*)Wv_t; S.B = (const char*)MEMN; S.tstep = (size_t)256 * D * 2;
          EpiBf16Plain E{VT, MROWS, 1.0f}; pg8::gemm_phase(lds, D, S, E); }
    }
    SEAM(1);

    if (IN(2)) { PHASE_IDS;
        const float* mu = args.in[I_MU]; const float* k_k = args.in[I_KK];
        for (int m = gw; m < M; m += NGW) {
            const bool hp = (m & (SEQ - 1)) != 0;
            const bf16* ur = U + (size_t)m * INW + 1024; const bf16* up = ur - INW;
#pragma unroll
            for (int j = 0; j < 7; ++j) {
                const int c = 4 * (64 * j + lane);
                const u32x2 cu = *(const u32x2*)(ur + c); u32x2 pu = (u32x2){0u, 0u}; if (hp) pu = *(const u32x2*)(up + c);
                const f32x4 m4 = *(const f32x4*)(mu + c);
                f32x4 uu; { const float a0 = bflo(cu.x), a1 = bfhi(cu.x), a2 = bflo(cu.y), a3 = bfhi(cu.y), p0 = bflo(pu.x), p1 = bfhi(pu.x), p2 = bflo(pu.y), p3 = bfhi(pu.y);
                    uu.x = a0 + (p0 - a0) * m4.x; uu.y = a1 + (p1 - a1) * m4.y; uu.z = a2 + (p2 - a2) * m4.z; uu.w = a3 + (p3 - a3) * m4.w; }
                if (j < 2) { *(f32x4*)(Rr + (size_t)m * 512 + c) = uu; }
                else if (j < 4) { const int cc = c - 512; *(f32x4*)(KRAW + (size_t)m * 512 + cc) = uu;
                    const f32x4 kk4 = *(const f32x4*)(k_k + cc); f32x4 kk = uu * kk4; float ss = (kk.x * kk.x + kk.y * kk.y) + (kk.z * kk.z + kk.w * kk.w);
                    ss += __shfl_xor(ss, 1); ss += __shfl_xor(ss, 2); ss += __shfl_xor(ss, 4); ss += __shfl_xor(ss, 8);
                    const float inv = 1.0f / fmaxf(sqrtf(ss), 1e-12f); *(f32x4*)(KKN + (size_t)m * 512 + cc) = kk * inv; }
                else if (j < 6) { const int cc = c - 1024; *(f32x4*)(Vv + (size_t)m * 512 + cc) = uu; }
                else { f32x4 o = uu;
                    if (lane < 16) { o.x = tanhf(uu.x); o.y = tanhf(uu.y); o.z = tanhf(uu.z); o.w = tanhf(uu.w); }
                    else if (lane >= 32) { o.x = sigmoid_f(uu.x); o.y = sigmoid_f(uu.y); o.z = sigmoid_f(uu.z); o.w = sigmoid_f(uu.w); }
                    u32x2 w; w.x = pk2(o.x, o.y); w.y = pk2(o.z, o.w); *(u32x2*)(AP + (size_t)m * 256 + 4 * lane) = w; }
            }
        }
        {
            const float* conv_w = args.in[I_CONVW]; const float* conv_b = args.in[I_CONVB]; const float* bx = args.in[I_LBX]; const float* ba = args.in[I_LBA]; const float* lam = args.in[I_LAM];
            LAS float* xs = (LAS float*)(lds + wave * 4096);
            const int i = lane & 15, kg = lane >> 4;
            for (int unit = gw; unit < (M / 16) * 2; unit += NGW) {
                const int tile = unit >> 1, nb0 = (unit & 1) * 4, m0 = tile * 16, s0 = m0 & (SEQ - 1);
                for (int nb = nb0; nb < nb0 + 4; ++nb) {
                    bf16x8 af[2];
#pragma unroll
                    for (int ks = 0; ks < 2; ++ks) {
                        const int chb = nb * 64 + 32 * ks + 8 * kg;
                        f32x4 x0 = *(const f32x4*)(conv_b + chb), x1 = *(const f32x4*)(conv_b + chb + 4);
#pragma unroll
                        for (int j = 0; j < 4; ++j) {
                            if (s0 + i - 3 + j >= 0) {
                                const u32x4 uw = *(const u32x4*)(U + (size_t)(m0 + i - 3 + j) * INW + chb);
                                const f32x4 w0 = *(const f32x4*)(conv_w + j * 512 + chb), w1 = *(const f32x4*)(conv_w + j * 512 + chb + 4);
                                x0.x += w0.x * bflo(uw.x); x0.y += w0.y * bfhi(uw.x); x0.z += w0.z * bflo(uw.y); x0.w += w0.w * bfhi(uw.y);
                                x1.x += w1.x * bflo(uw.z); x1.y += w1.y * bfhi(uw.z); x1.z += w1.z * bflo(uw.w); x1.w += w1.w * bfhi(uw.w);
                            }
                        }
                        *(LAS f32x4*)(xs + i * 64 + 32 * ks + 8 * kg) = x0; *(LAS f32x4*)(xs + i * 64 + 32 * ks + 8 * kg + 4) = x1;
                        u32x4 p; p.x = pk2(x0.x, x0.y); p.y = pk2(x0.z, x0.w); p.z = pk2(x1.x, x1.y); p.w = pk2(x1.z, x1.w);
                        af[ks] = __builtin_bit_cast(bf16x8, p);
                    }
                    f32x4 acc[8];
#pragma unroll
                    for (int ct = 0; ct < 8; ++ct) { acc[ct] = (f32x4){0.f, 0.f, 0.f, 0.f};
#pragma unroll
                        for (int ks = 0; ks < 2; ++ks) { const bf16x8 bfr = *(const bf16x8*)(LruW + ((size_t)(nb * 128 + 16 * ct + i) * 64 + 32 * ks + 8 * kg));
                            acc[ct] = __builtin_amdgcn_mfma_f32_16x16x32_bf16(af[ks], bfr, acc[ct], 0, 0, 0); } }
                    asm volatile("s_waitcnt lgkmcnt(0)" ::: "memory");
#pragma unroll
                    for (int ct = 0; ct < 4; ++ct) {
                        const int col = 16 * ct + i, ch = nb * 64 + col;
                        const float bxv = bx[ch], bav = ba[ch], sp = softplus_f(-lam[ch]);
#pragma unroll
                        for (int e = 0; e < 4; ++e) {
                            const int tok = 4 * kg + e;
                            const float gx = sigmoid_f(acc[ct][e] + bxv), ga = sigmoid_f(acc[ct + 4][e] + bav);
                            const float la = -8.0f * ga * sp, a = __expf(la), xcv = xs[tok * 64 + col];
                            const float bt = sqrtf(fmaxf(-expm1f(2.0f * la), 0.f)) * gx * xcv;
                            LA[(size_t)(m0 + tok) * 512 + ch] = a; LB[(size_t)(m0 + tok) * 512 + ch] = bt;
                        }
                    }
                }
            }
        }
    }
    SEAM(2);

    if (IN(3)) { PHASE_IDS;
        pg8::DenseSched S; S.o.init_tiles(M / 256, 1536 / 256, G, bid); S.A = (const char*)AP; S.B = (const char*)LoraB; S.tstep = (size_t)256 * 256 * 2;
        EpiLora E{WD, args.in[I_W0], args.in[I_A0]}; pg8::gemm_phase(lds, 256, S, E);
    }
    SEAM(3);

    if (IN(4)) { PHASE_IDS;
        LAS unsigned char* wl = lds + wave * 16384;
        LAS bf16* Arm = (LAS bf16*)(wl); LAS bf16* Brm = (LAS bf16*)(wl + 2048); LAS bf16* Krm = (LAS bf16*)(wl + 4096); LAS bf16* Rrm = (LAS bf16*)(wl + 6144);
        LAS bf16* ATt = (LAS bf16*)(wl + 8192); LAS bf16* BTt = (LAS bf16*)(wl + 10240); LAS bf16* KTt = (LAS bf16*)(wl + 12288); LAS bf16* VTt = (LAS bf16*)(wl + 14336);
        LAS float* MabT = (LAS float*)(wl); LAS bf16* Mak = (LAS bf16*)(wl + 1024); LAS bf16* Mrb = (LAS bf16*)(wl + 1536); LAS bf16* Mrk = (LAS bf16*)(wl + 2048); LAS bf16* Tm = (LAS bf16*)(wl + 2560);
        LAS float* PLs = (LAS float*)(wl + 3072); LAS bf16* Q0T = (LAS bf16*)(wl + 4096);
        const int l15 = lane & 15, g = lane >> 4, te = lane >> 2, kq = lane & 3;
        const bf16x8 z8 = (bf16x8){0, 0, 0, 0, 0, 0, 0, 0};
        const f32x4 z4 = (f32x4){0.f, 0.f, 0.f, 0.f};
        for (int un = gw; un < NB * NH * (SEQ / 16); un += NGW) {
            const int bh = un >> 8, c = un & 255, b = bh >> 3, h = bh & 7;
            const size_t mrow = (size_t)b * SEQ + c * 16 + te, off = mrow * 512 + h * 64 + 16 * kq;
            const int hc = h * 64 + 16 * kq;
            float cl[16], eP[16];
            {
                float lwv[16];
#pragma unroll
                for (int j4 = 0; j4 < 4; ++j4) { const f32x4 x = *(const f32x4*)(WD + off + 4 * j4); lwv[4 * j4] = x.x; lwv[4 * j4 + 1] = x.y; lwv[4 * j4 + 2] = x.z; lwv[4 * j4 + 3] = x.w; }
#pragma unroll
                for (int j = 0; j < 16; ++j) { float x = lwv[j];
#pragma unroll
                    for (int sft = 4; sft < 64; sft <<= 1) { const float y = __shfl_up(x, sft); if (lane >= sft) x += y; }
                    cl[j] = x; }
                float bon = 0.f;
                u32x4 pa[2], pb[2], pk[2], pr[2];
#pragma unroll
                for (int j4 = 0; j4 < 4; ++j4) {
                    const f32x4 kn = *(const f32x4*)(KKN + off + 4 * j4), av = *(const f32x4*)(AA + off + 4 * j4), kr = *(const f32x4*)(KRAW + off + 4 * j4), rv = *(const f32x4*)(Rr + off + 4 * j4), vv = *(const f32x4*)(Vv + off + 4 * j4);
                    const f32x4 ka = *(const f32x4*)(args.in[I_KA] + hc + 4 * j4), rk = *(const f32x4*)(args.in[I_RK] + hc + 4 * j4);
                    float at4[4], bt4[4], kt4[4], rt4[4], vt4[4];
#pragma unroll
                    for (int q = 0; q < 4; ++q) { const int j = 4 * j4 + q;
                        const float p = __expf(cl[j]), pn = __expf(-cl[j]), pm1 = __expf(cl[j] - lwv[j]); eP[j] = p;
                        const float kp = kr[q] * (1.0f + (av[q] - 1.0f) * ka[q]);
                        at4[q] = -kn[q] * pm1; bt4[q] = kn[q] * av[q] * pn; kt4[q] = kp * pn; rt4[q] = rv[q] * p; vt4[q] = vv[q];
                        bon += rv[q] * kp * rk[q];
                        const int kk = 16 * kq + j;
                        ATt[kk * 16 + te] = (bf16)f2bf(at4[q]); BTt[kk * 16 + te] = (bf16)f2bf(bt4[q]); KTt[kk * 16 + te] = (bf16)f2bf(kt4[q]); VTt[kk * 16 + te] = (bf16)f2bf(vt4[q]); }
                    const int hh = j4 >> 1, w2 = (j4 & 1) * 2;
                    pa[hh][w2] = pk2(at4[0], at4[1]); pa[hh][w2 + 1] = pk2(at4[2], at4[3]); pb[hh][w2] = pk2(bt4[0], bt4[1]); pb[hh][w2 + 1] = pk2(bt4[2], bt4[3]);
                    pk[hh][w2] = pk2(kt4[0], kt4[1]); pk[hh][w2 + 1] = pk2(kt4[2], kt4[3]); pr[hh][w2] = pk2(rt4[0], rt4[1]); pr[hh][w2 + 1] = pk2(rt4[2], rt4[3]);
                }
#pragma unroll
                for (int hh = 0; hh < 2; ++hh) { const int po = te * 64 + 8 * ((2 * kq + hh) ^ (te & 7));
                    *(LAS u32x4*)(Arm + po) = pa[hh]; *(LAS u32x4*)(Brm + po) = pb[hh]; *(LAS u32x4*)(Krm + po) = pk[hh]; *(LAS u32x4*)(Rrm + po) = pr[hh]; }
                bon += __shfl_xor(bon, 1); bon += __shfl_xor(bon, 2);
#pragma unroll
                for (int j4 = 0; j4 < 4; ++j4) { const f32x4 vv = *(const f32x4*)(Vv + off + 4 * j4), gg = *(const f32x4*)(GG + off + 4 * j4), lb = *(const f32x4*)(args.in[I_LNB] + hc + 4 * j4);
                    *(f32x4*)((float*)(ws + WS_ADD) + off + 4 * j4) = (lb + vv * bon) * gg; }
            }
            asm volatile("s_waitcnt lgkmcnt(0)" ::: "memory");
            {
                bf16x8 fa[2], fr[2], fb[2], fk[2];
#pragma unroll
                for (int ks = 0; ks < 2; ++ks) { const int po = l15 * 64 + 8 * ((4 * ks + g) ^ (l15 & 7));
                    fa[ks] = *(const LAS bf16x8*)(Arm + po); fr[ks] = *(const LAS bf16x8*)(Rrm + po); fb[ks] = *(const LAS bf16x8*)(Brm + po); fk[ks] = *(const LAS bf16x8*)(Krm + po); }
                f32x4 mab = z4, mak = z4, mrb = z4, mrk = z4;
#pragma unroll
                for (int ks = 0; ks < 2; ++ks) { mab = __builtin_amdgcn_mfma_f32_16x16x32_bf16(fb[ks], fa[ks], mab, 0, 0, 0); mak = __builtin_amdgcn_mfma_f32_16x16x32_bf16(fk[ks], fa[ks], mak, 0, 0, 0);
                    mrb = __builtin_amdgcn_mfma_f32_16x16x32_bf16(fb[ks], fr[ks], mrb, 0, 0, 0); mrk = __builtin_amdgcn_mfma_f32_16x16x32_bf16(fk[ks], fr[ks], mrk, 0, 0, 0); }
#pragma unroll
                for (int e = 0; e < 4; ++e) { const int i = 4 * g + e; if (!(i < l15)) { mab[e] = 0.f; mak[e] = 0.f; } if (!(i <= l15)) { mrb[e] = 0.f; mrk[e] = 0.f; } }
                asm volatile("s_waitcnt lgkmcnt(0)" ::: "memory");
#pragma unroll
                for (int e = 0; e < 4; ++e) MabT[(4 * g + e) * 16 + l15] = mab[e];
                u32x2 w; w.x = pk2(mak[0], mak[1]); w.y = pk2(mak[2], mak[3]); *(LAS u32x2*)(Mak + l15 * 16 + 4 * g) = w;
                w.x = pk2(mrb[0], mrb[1]); w.y = pk2(mrb[2], mrb[3]); *(LAS u32x2*)(Mrb + l15 * 16 + 4 * g) = w;
                w.x = pk2(mrk[0], mrk[1]); w.y = pk2(mrk[2], mrk[3]); *(LAS u32x2*)(Mrk + l15 * 16 + 4 * g) = w;
                if (te == 15) {
#pragma unroll
                    for (int j = 0; j < 16; ++j) PLs[16 * kq + j] = eP[j]; }
            }
            asm volatile("s_waitcnt lgkmcnt(0)" ::: "memory");
            {
                float y[16];
#pragma unroll
                for (int j = 15; j >= 0; --j) {
                    float acc = (j == l15) ? 1.0f : 0.0f;
                    float row[16];
#pragma unroll
                    for (int q = 0; q < 4; ++q) { const f32x4 x = *(const LAS f32x4*)(MabT + j * 16 + 4 * q); row[4 * q] = x.x; row[4 * q + 1] = x.y; row[4 * q + 2] = x.z; row[4 * q + 3] = x.w; }
#pragma unroll
                    for (int i = j + 1; i < 16; ++i) acc += y[i] * row[i];
                    y[j] = acc;
                }
                if (g == 0) { u32x4 t0, t1; t0.x = pk2(y[0], y[1]); t0.y = pk2(y[2], y[3]); t0.z = pk2(y[4], y[5]); t0.w = pk2(y[6], y[7]); t1.x = pk2(y[8], y[9]); t1.y = pk2(y[10], y[11]); t1.z = pk2(y[12], y[13]); t1.w = pk2(y[14], y[15]);
                    *(LAS u32x4*)(Tm + l15 * 16) = t0; *(LAS u32x4*)(Tm + l15 * 16 + 8) = t1; }
            }
            asm volatile("s_waitcnt lgkmcnt(0)" ::: "memory");
            {
                const bool act = g < 2; const int fo = l15 * 16 + 8 * g;
                const bf16x8 fT = act ? *(const LAS bf16x8*)(Tm + fo) : z8, fMak = act ? *(const LAS bf16x8*)(Mak + fo) : z8, fMrb = act ? *(const LAS bf16x8*)(Mrb + fo) : z8, fMrk = act ? *(const LAS bf16x8*)(Mrk + fo) : z8;
                bf16x8 fV[4], fQ1[4], fAh[4], fBT[4], fKT[4];
#pragma unroll
                for (int vt = 0; vt < 4; ++vt) { fV[vt] = act ? *(const LAS bf16x8*)(VTt + vt * 256 + fo) : z8; fBT[vt] = act ? *(const LAS bf16x8*)(BTt + vt * 256 + fo) : z8; fKT[vt] = act ? *(const LAS bf16x8*)(KTt + vt * 256 + fo) : z8; }
#pragma unroll
                for (int vt = 0; vt < 4; ++vt) { const f32x4 q0 = __builtin_amdgcn_mfma_f32_16x16x32_bf16(fMak, fV[vt], z4, 0, 0, 0);
                    u32x2 w; w.x = pk2(q0[0], q0[1]); w.y = pk2(q0[2], q0[3]); *(LAS u32x2*)(Q0T + vt * 256 + l15 * 16 + 4 * g) = w; }
#pragma unroll
                for (int kt = 0; kt < 4; ++kt) { const bf16x8 fA = act ? *(const LAS bf16x8*)(ATt + kt * 256 + fo) : z8; const f32x4 ah = __builtin_amdgcn_mfma_f32_16x16x32_bf16(fT, fA, z4, 0, 0, 0);
                    u32x2 w; w.x = pk2(ah[0], ah[1]); w.y = pk2(ah[2], ah[3]); *(LAS u32x2*)(ATt + kt * 256 + l15 * 16 + 4 * g) = w; }
                asm volatile("s_waitcnt lgkmcnt(0)" ::: "memory");
#pragma unroll
                for (int vt = 0; vt < 4; ++vt) { const bf16x8 fQ0 = act ? *(const LAS bf16x8*)(Q0T + vt * 256 + fo) : z8; const f32x4 q1 = __builtin_amdgcn_mfma_f32_16x16x32_bf16(fT, fQ0, z4, 0, 0, 0);
                    u32x2 w; w.x = pk2(q1[0], q1[1]); w.y = pk2(q1[2], q1[3]); *(LAS u32x2*)(Q0T + vt * 256 + l15 * 16 + 4 * g) = w; }
                asm volatile("s_waitcnt lgkmcnt(0)" ::: "memory");
#pragma unroll
                for (int vt = 0; vt < 4; ++vt) { fQ1[vt] = act ? *(const LAS bf16x8*)(Q0T + vt * 256 + fo) : z8; fAh[vt] = act ? *(const LAS bf16x8*)(ATt + vt * 256 + fo) : z8; }
                bf16* rp = (bf16*)(ws + WS_RP) + (size_t)un * 1024 + l15 * 64;
#pragma unroll
                for (int kt = 0; kt < 4; ++kt) {
                    const u32x2 rr = *(const LAS u32x2*)(Rrm + l15 * 64 + 8 * ((2 * kt + (g >> 1)) ^ (l15 & 7)) + 4 * (g & 1));
                    f32x4 ini; ini[0] = bflo(rr.x); ini[1] = bfhi(rr.x); ini[2] = bflo(rr.y); ini[3] = bfhi(rr.y);
                    const f32x4 rh = __builtin_amdgcn_mfma_f32_16x16x32_bf16(fAh[kt], fMrb, ini, 0, 0, 0);
                    u32x2 w; w.x = pk2(rh[0], rh[1]); w.y = pk2(rh[2], rh[3]); *(u32x2*)(rp + 32 * (kt >> 1) + 8 * g + 4 * (kt & 1)) = w;
                }
#pragma unroll
                for (int vt = 0; vt < 4; ++vt) { f32x4 y1 = __builtin_amdgcn_mfma_f32_16x16x32_bf16(fMrb, fQ1[vt], z4, 0, 0, 0); y1 = __builtin_amdgcn_mfma_f32_16x16x32_bf16(fMrk, fV[vt], y1, 0, 0, 0);
                    *(f32x4*)((float*)(ws + WS_Y1F) + ((size_t)(un * 4 + vt) * 64 + lane) * 4) = y1; }
                bf16* gp = (bf16*)(ws + WS_GP) + (size_t)un * 4096;
#pragma unroll
                for (int krt = 0; krt < 4; ++krt) { const float pl = PLs[16 * krt + l15];
#pragma unroll
                    for (int kct = 0; kct < 4; ++kct) { f32x4 ga = __builtin_amdgcn_mfma_f32_16x16x32_bf16(fAh[kct], fBT[krt], z4, 0, 0, 0);
                        if (kct == krt) {
#pragma unroll
                            for (int e = 0; e < 4; ++e) if (4 * g + e == l15) ga[e] += 1.0f; }
                        u32x2 w; w.x = pk2(ga[0] * pl, ga[1] * pl); w.y = pk2(ga[2] * pl, ga[3] * pl);
                        *(u32x2*)(gp + (16 * krt + l15) * 64 + 32 * (kct >> 1) + 8 * g + 4 * (kct & 1)) = w; } }
#pragma unroll
                for (int mt = 0; mt < 4; ++mt) { const f32x4 pl4 = *(const LAS f32x4*)(PLs + 16 * mt + 4 * g);
#pragma unroll
                    for (int vt = 0; vt < 4; ++vt) { f32x4 ha = __builtin_amdgcn_mfma_f32_16x16x32_bf16(fBT[mt], fQ1[vt], z4, 0, 0, 0); ha = __builtin_amdgcn_mfma_f32_16x16x32_bf16(fKT[mt], fV[vt], ha, 0, 0, 0);
                        u32x2 w; w.x = pk2(ha[0] * pl4[0], ha[1] * pl4[1]); w.y = pk2(ha[2] * pl4[2], ha[3] * pl4[3]);
                        *(u32x2*)((bf16*)(ws + WS_HF) + ((size_t)((un * 4 + vt) * 4 + mt) * 64 + lane) * 4) = w; } }
            }
            asm volatile("s_waitcnt lgkmcnt(0)" ::: "memory");
        }
    }
    SEAM(4);

#define RW_ZB(zz, zb) do { _Pragma("unroll") for (int ks_ = 0; ks_ < 2; ++ks_) { u32x4 p_; p_.x = pk2(zz[2 * ks_][0], zz[2 * ks_][1]); p_.y = pk2(zz[2 * ks_][2], zz[2 * ks_][3]); \
        p_.z = pk2(zz[2 * ks_ + 1][0], zz[2 * ks_ + 1][1]); p_.w = pk2(zz[2 * ks_ + 1][2], zz[2 * ks_ + 1][3]); zb[ks_] = __builtin_bit_cast(bf16x8, p_); } } while (0)
    if (IN(5)) { PHASE_IDS;
        const int l15 = lane & 15, g = lane >> 4;
        for (int u2 = gw; u2 < 2 * NB * NH * (SEQ / 64); u2 += NGW) {
            const int u64 = u2 >> 1, part = u2 & 1;
            f32x4 z[4][4];
#pragma unroll
            for (int sl = 0; sl < 4; ++sl)
#pragma unroll
                for (int mt = 0; mt < 4; ++mt)
#pragma unroll
                    for (int e = 0; e < 4; ++e) z[sl][mt][e] = (part == 0 && sl == mt && 4 * g + e == l15) ? 1.0f : 0.0f;
#pragma unroll 1
            for (int j = 0; j < 4; ++j) {
                const size_t un = (size_t)u64 * 4 + j;
                const bf16* gp = (const bf16*)(ws + WS_GP) + un * 4096 + l15 * 64 + 8 * g;
                bf16x8 gf[4][2];
#pragma unroll
                for (int mt = 0; mt < 4; ++mt) { gf[mt][0] = *(const bf16x8*)(gp + mt * 1024); gf[mt][1] = *(const bf16x8*)(gp + mt * 1024 + 32); }
#pragma unroll
                for (int sl = 0; sl < 4; ++sl) {
                    bf16x8 zb[2]; RW_ZB(z[sl], zb);
#pragma unroll
                    for (int mt = 0; mt < 4; ++mt) {
                        f32x4 a = (f32x4){0.f, 0.f, 0.f, 0.f};
                        if (part) { const u32x2 hh = *(const u32x2*)((const bf16*)(ws + WS_HF) + ((size_t)((un * 4 + sl) * 4 + mt) * 64 + lane) * 4); a[0] = bflo(hh.x); a[1] = bfhi(hh.x); a[2] = bflo(hh.y); a[3] = bfhi(hh.y); }
                        a = __builtin_amdgcn_mfma_f32_16x16x32_bf16(gf[mt][0], zb[0], a, 0, 0, 0); a = __builtin_amdgcn_mfma_f32_16x16x32_bf16(gf[mt][1], zb[1], a, 0, 0, 0);
                        z[sl][mt] = a;
                    }
                }
            }
            if (part == 0) {
                bf16* gc = (bf16*)(ws + WS_GC) + (size_t)u64 * 4096;
#pragma unroll
                for (int sl = 0; sl < 4; ++sl) { const int pc = 32 * (sl >> 1) + 8 * (l15 >> 2) + 4 * (sl & 1) + (l15 & 3);
#pragma unroll
                    for (int mt = 0; mt < 4; ++mt)
#pragma unroll
                        for (int e = 0; e < 4; ++e) gc[(16 * mt + 4 * g + e) * 64 + pc] = (bf16)f2bf(z[sl][mt][e]); }
            } else {
#pragma unroll
                for (int sl = 0; sl < 4; ++sl)
#pragma unroll
                    for (int mt = 0; mt < 4; ++mt) { u32x2 w; w.x = pk2(z[sl][mt][0], z[sl][mt][1]); w.y = pk2(z[sl][mt][2], z[sl][mt][3]);
                        *(u32x2*)((bf16*)(ws + WS_HC) + ((size_t)((u64 * 4 + sl) * 4 + mt) * 64 + lane) * 4) = w; }
            }
        }
    }
    SEAM(5);

    if (IN(6)) { PHASE_IDS;
        if ((bid < 128 && wave != 0) || bid >= 160) {
            LAS float* scr = (LAS float*)(lds + wave * 16384);
            const int wi = bid < 128 ? bid * 7 + (wave - 1) : 896 + (bid - 160) * 8 + wave, NW = 896 + (G - 160) * 8;
            constexpr int I_GU = 16 * 64, I_DN = 16 * 32;
            for (int it = wi; it < NE * (I_GU + I_DN); it += NW) {
                int r = it;
                if (r < NE * I_GU) { const int e = r / I_GU, q = r % I_GU, kb = q / 64, nb = q % 64; const int n0 = 32 * nb;
                    const int drow = n0 < 1024 ? (256 * (n0 >> 7) + (n0 & 127)) : (256 * ((n0 - 1024) >> 7) + 128 + ((n0 - 1024) & 127));
                    transpose_item(args.in[I_WGU] + (size_t)e * D * 2048, 2048, D, Wgu_t + (size_t)e * 2048 * D, 64 * kb, n0, drow, scr, lane); continue; } r -= NE * I_GU;
                { const int e = r / I_DN, q = r % I_DN, kb = q / 32, nb = q % 32;
                  transpose_item(args.in[I_WDN] + (size_t)e * DFF * D, D, DFF, Wdn_t + (size_t)e * D * DFF, 64 * kb, 32 * nb, 32 * nb, scr, lane); }
            }
        }
        if (bid < 128) {
            if (wave == 0) {
                const int l15 = lane & 15, g = lane >> 4, bh = bid >> 2, vs = bid & 3;
                f32x4 z[4];
#pragma unroll
                for (int mt = 0; mt < 4; ++mt) z[mt] = (f32x4){0.f, 0.f, 0.f, 0.f};
                bf16x8 gA[4][2], gB[4][2]; u32x2 hA[4], hB[4];
#define SC_LOAD(gf, hf, C) do { const size_t u64_ = (size_t)bh * 64 + (C); const bf16* gp_ = (const bf16*)(ws + WS_GC) + u64_ * 4096 + l15 * 64 + 8 * g; \
                    _Pragma("unroll") for (int mt = 0; mt < 4; ++mt) { gf[mt][0] = *(const bf16x8*)(gp_ + mt * 1024); gf[mt][1] = *(const bf16x8*)(gp_ + mt * 1024 + 32); \
                        hf[mt] = *(const u32x2*)((const bf16*)(ws + WS_HC) + ((size_t)((u64_ * 4 + vs) * 4 + mt) * 64 + lane) * 4); } } while (0)
#define SC_STEP(gf, hf, C) do { const size_t u64_ = (size_t)bh * 64 + (C); float* zs_ = (float*)(ws + WS_ZS) + ((size_t)((u64_ * 4 + vs) * 4) * 64 + lane) * 4; \
                    _Pragma("unroll") for (int mt = 0; mt < 4; ++mt) *(f32x4*)(zs_ + mt * 256) = z[mt]; \
                    bf16x8 zb[2]; RW_ZB(z, zb); \
                    _Pragma("unroll") for (int mt = 0; mt < 4; ++mt) { f32x4 a; a[0] = bflo(hf[mt].x); a[1] = bfhi(hf[mt].x); a[2] = bflo(hf[mt].y); a[3] = bfhi(hf[mt].y); \
                        a = __builtin_amdgcn_mfma_f32_16x16x32_bf16(gf[mt][0], zb[0], a, 0, 0, 0); a = __builtin_amdgcn_mfma_f32_16x16x32_bf16(gf[mt][1], zb[1], a, 0, 0, 0); z[mt] = a; } } while (0)
                SC_LOAD(gA, hA, 0);
#pragma unroll 1
                for (int C = 0; C < 64; C += 2) {
                    SC_LOAD(gB, hB, C + 1);
                    SC_STEP(gA, hA, C);
                    if (C + 2 < 64) SC_LOAD(gA, hA, C + 2);
                    SC_STEP(gB, hB, C + 1);
                }
#undef SC_LOAD
#undef SC_STEP
            }
        } else if (bid < 160) {
            const int idx = bid - 128, b = idx >> 3, cg = idx & 7, ch = cg * 64 + lane;
            LAS float* seg = (LAS float*)lds;
            const size_t mb = (size_t)b * SEQ + wave * 512;
            float A = 1.f, B = 0.f;
#pragma unroll 8
            for (int t = 0; t < 512; ++t) { const float a = LA[(mb + t) * 512 + ch], bt = LB[(mb + t) * 512 + ch]; B = a * B + bt; A *= a; }
            seg[(wave * 64 + lane) * 2] = A; seg[(wave * 64 + lane) * 2 + 1] = B;
            __syncthreads();
            float hst = 0.f;
            for (int sgi = 0; sgi < wave; ++sgi) hst = seg[(sgi * 64 + lane) * 2] * hst + seg[(sgi * 64 + lane) * 2 + 1];
#pragma unroll 8
            for (int t = 0; t < 512; ++t) { const float a = LA[(mb + t) * 512 + ch], bt = LB[(mb + t) * 512 + ch]; hst = a * hst + bt;
                const float gl = bf2f(U[(mb + t) * INW + 512 + ch]); CAT[(mb + t) * 1024 + ch] = (bf16)f2bf(hst * gelu_tanh_f(gl)); }
            __syncthreads();
        }
    }
    SEAM(6);

    if (IN(7)) { PHASE_IDS;
        const int l15 = lane & 15, g = lane >> 4;
        for (int u64 = gw; u64 < NB * NH * (SEQ / 64); u64 += NGW) {
            const int bh = u64 >> 6, C = u64 & 63, b = bh >> 3, h = bh & 7;
            f32x4 z[4][4];
#pragma unroll
            for (int sl = 0; sl < 4; ++sl)
#pragma unroll
                for (int mt = 0; mt < 4; ++mt) z[sl][mt] = *(const f32x4*)((const float*)(ws + WS_ZS) + ((size_t)((u64 * 4 + sl) * 4 + mt) * 64 + lane) * 4);
            float lg4[4];
#pragma unroll
            for (int sl = 0; sl < 4; ++sl) lg4[sl] = args.in[I_LNG][h * 64 + 16 * sl + l15];
#pragma unroll 1
            for (int j = 0; j < 4; ++j) {
                const size_t un = (size_t)u64 * 4 + j; const size_t m0 = (size_t)b * SEQ + (C * 4 + j) * 16;
                const bf16* rp = (const bf16*)(ws + WS_RP) + un * 1024 + l15 * 64 + 8 * g;
                const bf16x8 rf0 = *(const bf16x8*)rp, rf1 = *(const bf16x8*)(rp + 32);
                f32x4 y[4];
#pragma unroll
                for (int sl = 0; sl < 4; ++sl) { bf16x8 zb[2]; RW_ZB(z[sl], zb);
                    f32x4 a = *(const f32x4*)((const float*)(ws + WS_Y1F) + ((size_t)(un * 4 + sl) * 64 + lane) * 4);
                    a = __builtin_amdgcn_mfma_f32_16x16x32_bf16(rf0, zb[0], a, 0, 0, 0); a = __builtin_amdgcn_mfma_f32_16x16x32_bf16(rf1, zb[1], a, 0, 0, 0); y[sl] = a; }
#pragma unroll
                for (int e = 0; e < 4; ++e) {
                    float s1 = (y[0][e] + y[1][e]) + (y[2][e] + y[3][e]);
                    s1 += __shfl_xor(s1, 1); s1 += __shfl_xor(s1, 2); s1 += __shfl_xor(s1, 4); s1 += __shfl_xor(s1, 8);
                    const float mean = s1 * (1.0f / 64.0f);
                    float d0 = y[0][e] - mean, d1 = y[1][e] - mean, d2 = y[2][e] - mean, d3 = y[3][e] - mean;
                    float s2 = (d0 * d0 + d1 * d1) + (d2 * d2 + d3 * d3);
                    s2 += __shfl_xor(s2, 1); s2 += __shfl_xor(s2, 2); s2 += __shfl_xor(s2, 4); s2 += __shfl_xor(s2, 8);
                    const float rstd = 1.0f / sqrtf(s2 * (1.0f / 64.0f) + GN_EPS);
                    const size_t ro = (m0 + 4 * g + e) * 512 + h * 64 + l15;
                    const float dd[4] = {d0, d1, d2, d3};
#pragma unroll
                    for (int sl = 0; sl < 4; ++sl) { const float gg = GG[ro + 16 * sl], ad = ((const float*)(ws + WS_ADD))[ro + 16 * sl];
                        const float o = dd[sl] * rstd * lg4[sl] * gg + ad;
                        CAT[(m0 + 4 * g + e) * 1024 + 512 + h * 64 + 16 * sl + l15] = (bf16)f2bf(o); }
                }
                if (j < 3) {
                    const bf16* gp = (const bf16*)(ws + WS_GP) + un * 4096 + l15 * 64 + 8 * g;
                    bf16x8 gf[4][2];
#pragma unroll
                    for (int mt = 0; mt < 4; ++mt) { gf[mt][0] = *(const bf16x8*)(gp + mt * 1024); gf[mt][1] = *(const bf16x8*)(gp + mt * 1024 + 32); }
#pragma unroll
                    for (int sl = 0; sl < 4; ++sl) { bf16x8 zb[2]; RW_ZB(z[sl], zb);
#pragma unroll
                        for (int mt = 0; mt < 4; ++mt) { const u32x2 hh = *(const u32x2*)((const bf16*)(ws + WS_HF) + ((size_t)((un * 4 + sl) * 4 + mt) * 64 + lane) * 4);
                            f32x4 a; a[0] = bflo(hh.x); a[1] = bfhi(hh.x); a[2] = bflo(hh.y); a[3] = bfhi(hh.y);
                            a = __builtin_amdgcn_mfma_f32_16x16x32_bf16(gf[mt][0], zb[0], a, 0, 0, 0); a = __builtin_amdgcn_mfma_f32_16x16x32_bf16(gf[mt][1], zb[1], a, 0, 0, 0); z[sl][mt] = a; } }
                }
            }
        }
    }
    SEAM(7);
#undef RW_ZB


    if (IN(8)) { PHASE_IDS;
        pg8::DenseSched S; S.o.init_tiles(M / 256, D / 256, G, bid); S.A = (const char*)CAT; S.B = (const char*)Wout_t; S.tstep = (size_t)256 * D * 2;
        EpiF32Res E{args.in[I_X], X1, D}; pg8::gemm_phase(lds, D, S, E);
    }
    SEAM(8);
    if (IN(9)) { PHASE_IDS; for (int m = gw; m < M; m += NGW) rms_row_to_bf16(X1 + (size_t)m * D, args.in[I_NXAG], HN + (size_t)m * D, lane); }
    SEAM(9);
    if (IN(10)) { PHASE_IDS;
        pg8::DenseSched S; S.o.init_tiles(M / 256, D / 256, G, bid); S.A = (const char*)HN; S.B = (const char*)Wq_t; S.tstep = (size_t)256 * D * 2;
        EpiBf16Plain E{Qb, D, 0.0625f}; pg8::gemm_phase(lds, D, S, E);
    }
    SEAM(10);
    if (IN(11)) { PHASE_IDS;
        const int l15 = lane & 15, g4 = lane >> 4;
        for (int unit = gw; unit < NB * XH * (SEQ / 16); unit += NGW) {
            const int qt16 = unit % (SEQ / 16), bh = unit / (SEQ / 16), h = bh & 3, b = bh >> 2;
            const bf16* qbase = Qb + (size_t)(b * SEQ + qt16 * 16 + l15) * D + h * XHD + 8 * g4;
            const bf16* kbase = KM + (size_t)(b * MEML + l15) * D + h * XHD + 8 * g4;
            f32x4 sc[16];
#pragma unroll
            for (int kt = 0; kt < 16; ++kt) sc[kt] = (f32x4){0.f, 0.f, 0.f, 0.f};
#pragma unroll 1
            for (int ks = 0; ks < 8; ++ks) {
                const bf16x8 q0 = *(const bf16x8*)(qbase + 32 * ks);
                const bf16* kp = kbase + 32 * ks;
#pragma unroll
                for (int kt = 0; kt < 16; ++kt) { const bf16x8 kf = *(const bf16x8*)(kp + (size_t)(16 * kt) * D);
                    sc[kt] = __builtin_amdgcn_mfma_f32_16x16x32_bf16(kf, q0, sc[kt], 0, 0, 0); }
            }
            bf16x8 pf[8];
            {
                float mx = -3.0e38f;
#pragma unroll
                for (int kt = 0; kt < 16; ++kt) mx = fmaxf(mx, fmaxf(fmaxf(sc[kt][0], sc[kt][1]), fmaxf(sc[kt][2], sc[kt][3])));
                mx = fmaxf(mx, __shfl_xor(mx, 16)); mx = fmaxf(mx, __shfl_xor(mx, 32));
                float sum = 0.f;
#pragma unroll
                for (int kt = 0; kt < 16; ++kt) {
#pragma unroll
                    for (int e = 0; e < 4; ++e) { const float p = __expf(sc[kt][e] - mx); sc[kt][e] = p; sum += p; } }
                sum += __shfl_xor(sum, 16); sum += __shfl_xor(sum, 32);
                const float inv = 1.0f / sum;
#pragma unroll
                for (int s2 = 0; s2 < 8; ++s2) { const f32x4 a = sc[2 * s2] * inv, c = sc[2 * s2 + 1] * inv;
                    u32x4 p; p.x = pk2(a[0], a[1]); p.y = pk2(a[2], a[3]); p.z = pk2(c[0], c[1]); p.w = pk2(c[2], c[3]); pf[s2] = __builtin_bit_cast(bf16x8, p); }
            }
            const bf16* vbase = VT + (size_t)(h * XHD + l15) * MROWS + b * MEML + 4 * g4;
            bf16* obase = Ob + (size_t)(b * SEQ + qt16 * 16 + l15) * D + h * XHD + 4 * g4;
#pragma unroll 1
            for (int dt = 0; dt < 16; ++dt) {
                const bf16* vp = vbase + (size_t)(16 * dt) * MROWS;
                f32x4 oc = (f32x4){0.f, 0.f, 0.f, 0.f};
#pragma unroll
                for (int s2 = 0; s2 < 8; ++s2) {
                    const u32x2 v0 = *(const u32x2*)(vp + 32 * s2), v1 = *(const u32x2*)(vp + 32 * s2 + 16);
                    u32x4 vv; vv.x = v0.x; vv.y = v0.y; vv.z = v1.x; vv.w = v1.y; const bf16x8 vf = __builtin_bit_cast(bf16x8, vv);
                    oc = __builtin_amdgcn_mfma_f32_16x16x32_bf16(vf, pf[s2], oc, 0, 0, 0);
                }
                u32x2 w; w.x = pk2(oc[0], oc[1]); w.y = pk2(oc[2], oc[3]);
                *(u32x2*)(obase + 16 * dt) = w;
            }
        }
    }
    SEAM(11);
    if (IN(12)) { PHASE_IDS;
        pg8::DenseSched S; S.o.init_tiles(M / 256, D / 256, G, bid); S.A = (const char*)Ob; S.B = (const char*)Wo_t; S.tstep = (size_t)256 * D * 2;
        EpiF32Res E{X1, X2, D}; pg8::gemm_phase(lds, D, S, E);
    }
    SEAM(12);
    if (IN(13)) { PHASE_IDS;
        LAS float* hs = (LAS float*)(lds + wave * 16384);
        const float* gfn = args.in[I_NFFG]; const float* wr_ = args.in[I_WR]; const float* br = args.in[I_BR];
        const int e = lane & 31, half = lane >> 5;
        for (int grp = gw; grp < M / 4; grp += NGW) {
            const int m0 = grp * 4;
#pragma unroll
            for (int rr = 0; rr < 4; ++rr) {
                const f32x4* xr = (const f32x4*)(X2 + (size_t)(m0 + rr) * D) + lane; const f32x4* gr = (const f32x4*)gfn + lane;
                f32x4 v[4]; float s = 0.f;
#pragma unroll
                for (int j = 0; j < 4; ++j) { v[j] = xr[64 * j]; s += (v[j].x * v[j].x + v[j].y * v[j].y) + (v[j].z * v[j].z + v[j].w * v[j].w); }
                const float rstd = 1.0f / sqrtf(wave_sum(s) * (1.f / D) + EPS);
                u32x2* o8 = (u32x2*)(HN + (size_t)(m0 + rr) * D) + lane;
#pragma unroll
                for (int j = 0; j < 4; ++j) { const f32x4 gg = gr[64 * j]; f32x4 hv = v[j] * rstd * gg; *(LAS f32x4*)(hs + rr * 1024 + 256 * j + 4 * lane) = hv;
                    u32x2 w; w.x = pk2(hv.x, hv.y); w.y = pk2(hv.z, hv.w); o8[64 * j] = w; }
            }
            asm volatile("s_waitcnt lgkmcnt(0)" ::: "memory");
            float lg[4] = {0.f, 0.f, 0.f, 0.f};
#pragma unroll 4
            for (int d = half * 512; d < half * 512 + 512; d += 4) {
                const float w0 = wr_[(d + 0) * 32 + e], w1 = wr_[(d + 1) * 32 + e], w2 = wr_[(d + 2) * 32 + e], w3 = wr_[(d + 3) * 32 + e];
#pragma unroll
                for (int rr = 0; rr < 4; ++rr) { const f32x4 h4 = *(const LAS f32x4*)(hs + rr * 1024 + d); lg[rr] += (h4.x * w0 + h4.y * w1) + (h4.z * w2 + h4.w * w3); }
            }
            const float brv = br[e];
#pragma unroll
            for (int rr = 0; rr < 4; ++rr) {
                float v = lg[rr] + __shfl_xor(lg[rr], 32) + brv;
                float selv[4]; int sele[4];
#pragma unroll
                for (int k = 0; k < 4; ++k) {
                    float mv = v; int mi = e;
#pragma unroll
                    for (int o = 1; o < 32; o <<= 1) { const float ov = __shfl_xor(mv, o); const int oi = __shfl_xor(mi, o); if (ov > mv || (ov == mv && oi < mi)) { mv = ov; mi = oi; } }
                    selv[k] = mv; sele[k] = mi; if (e == mi) v = -3.0e38f;
                }
                const float e1 = __expf(selv[1] - selv[0]), e2 = __expf(selv[2] - selv[0]), e3 = __expf(selv[3] - selv[0]);
                const float inv = 1.0f / (1.0f + e1 + e2 + e3);
                if (lane < 4) {
                    const int me = lane == 0 ? sele[0] : lane == 1 ? sele[1] : lane == 2 ? sele[2] : sele[3];
                    const float mg = (lane == 0 ? 1.0f : lane == 1 ? e1 : lane == 2 ? e2 : e3) * inv;
                    const int pos = (int)atomicAdd(ecnt + me, 1u);
                    const int ai = (m0 + rr) * 4 + lane; route_e[ai] = me; route_pos[ai] = pos; route_g[ai] = mg;
                }
            }
        }
    }
    SEAM(13);
    if (IN(14)) { PHASE_IDS;
        LAS int* pst = (LAS int*)lds;
        if (tid == 0) { int acc = 0; for (int e = 0; e < NE; ++e) { const int c = (int)__hip_atomic_load(ecnt + e, __ATOMIC_RELAXED, __HIP_MEMORY_SCOPE_AGENT); pst[e] = acc; pst[64 + e] = c; acc += (c + 255) & ~255; } pst[32] = acc; }
        __syncthreads();
        for (int t = gw; t < M; t += NGW) {
            int row = 0;
            if (lane < 4) { const int ai = t * 4 + lane; const int e = route_e[ai]; row = pst[e] + route_pos[ai]; row_slot[row] = ai; row_gate[row] = route_g[ai]; }
            const u32x4* src = (const u32x4*)(HN + (size_t)t * D);
            const u32x4 a = src[lane], c = src[64 + lane];
#pragma unroll
            for (int k = 0; k < 4; ++k) { const int rk = __shfl(row, k); u32x4* dst = (u32x4*)(XS + (size_t)rk * D); dst[lane] = a; dst[64 + lane] = c; }
        }
        if (bid < NE) { const int e = bid, c = pst[64 + e], pe = (c + 255) & ~255; for (int p = c + tid; p < pe; p += NTHREADS) { row_slot[pst[e] + p] = -1; row_gate[pst[e] + p] = 0.f; } }
        if (bid == 0 && tid == 0) { int nt = 0; for (int e = 0; e < NE; ++e) { const int n = ((pst[64 + e] + 255) & ~255) >> 8; for (int j = 0; j < n; ++j) tile_tab[16 + nt++] = e; } tile_tab[0] = nt; }
        __syncthreads();
    }
    SEAM(14);
    if (IN(15)) { PHASE_IDS;
        const int ntiles = tile_tab[0];
        pg8::MoeSched S; S.o.init_tiles(ntiles, 2048 / 256, G, bid); S.A = (const char*)XS; S.B = (const char*)Wgu_t; S.tile_e = tile_tab + 16; S.tstep = (size_t)256 * D * 2; S.estep = (size_t)2048 * D * 2;
        EpiSwiglu E{ACT, args.in[I_BGU]}; pg8::gemm_phase(lds, D, S, E);
    }
    SEAM(15);
    if (IN(16)) { PHASE_IDS;
        const int ntiles = tile_tab[0];
        pg8::MoeSched S; S.o.init_tiles(ntiles, D / 256, G, bid); S.A = (const char*)ACT; S.B = (const char*)Wdn_t; S.tile_e = tile_tab + 16; S.tstep = (size_t)256 * DFF * 2; S.estep = (size_t)D * DFF * 2;
        EpiDown E{YS, args.in[I_BDN], row_slot, row_gate}; pg8::gemm_phase(lds, DFF, S, E);
    }
    SEAM(16);
    if (IN(17)) { PHASE_IDS;
        const f32x4* gr = (const f32x4*)args.in[I_FNG] + lane;
        for (int m = gw; m < M; m += NGW) {
            const f32x4* xr = (const f32x4*)(X2 + (size_t)m * D) + lane;
            f32x4 v[4]; float s = 0.f;
#pragma unroll
            for (int j = 0; j < 4; ++j) { v[j] = xr[64 * j];
#pragma unroll
                for (int k = 0; k < 4; ++k) { const u32x2 y = *((const u32x2*)(YS + (size_t)(m * 4 + k) * D) + 64 * j + lane); v[j].x += bflo(y.x); v[j].y += bfhi(y.x); v[j].z += bflo(y.y); v[j].w += bfhi(y.y); }
                s += (v[j].x * v[j].x + v[j].y * v[j].y) + (v[j].z * v[j].z + v[j].w * v[j].w); }
            const float rstd = 1.0f / sqrtf(wave_sum(s) * (1.f / D) + EPS);
            f32x4* o = (f32x4*)(args.out + (size_t)m * D) + lane;
#pragma unroll
            for (int j = 0; j < 4; ++j) o[64 * j] = v[j] * rstd * gr[64 * j];
        }
    }
#undef IN
#undef SEAM
}

constexpr int N_PHASES = 18;
extern "C" void kernel_launch(void* const* d_in, const int* in_sizes, int n_in, void* d_out, int out_size, void* d_ws, size_t ws_size, hipStream_t stream) {
    static int grid = 0;
    if (grid == 0) {
        if (n_in != 37 || out_size != M * D || ws_size < WS_END) { fprintf(stderr, "kernel_launch: unexpected shapes (n_in %d, out %d, ws %zu); nothing launched\n", n_in, out_size, ws_size); grid = -1; return; }
        int dev = 0, cus = 0, per_cu = 0;
        if (hipGetDevice(&dev) != hipSuccess || hipDeviceGetAttribute(&cus, hipDeviceAttributeMultiprocessorCount, dev) != hipSuccess) { grid = -1; return; }
        if (hipFuncSetAttribute((const void*)fwd, hipFuncAttributeMaxDynamicSharedMemorySize, LDS_BYTES) != hipSuccess) { fprintf(stderr, "kernel_launch: hipFuncSetAttribute failed\n"); grid = -1; return; }
        if (hipOccupancyMaxActiveBlocksPerMultiprocessor(&per_cu, (const void*)fwd, NTHREADS, LDS_BYTES) != hipSuccess || per_cu < 1) fprintf(stderr, "kernel_launch: occupancy query says %d\n", per_cu);
        (void)hipGetLastError();
        grid = cus > 256 ? 256 : cus;
    }
    if (grid < 0) return;
    if (hipMemsetAsync((char*)d_ws + WS_CTL, 0, CTL_ZERO_BYTES, stream) != hipSuccess) return;
    Args a{};
    for (int i = 0; i < 37; ++i) a.in[i] = (const float*)d_in[i];
    a.out = (float*)d_out; a.ws = (unsigned char*)d_ws;
#if MK_ONE_LAUNCH
    a.ph_lo = 0; a.ph_hi = N_PHASES;
    hipLaunchKernelGGL(fwd, dim3(grid), dim3(NTHREADS), LDS_BYTES, stream, a);
#else
    for (int p = 0; p < N_PHASES; ++p) { a.ph_lo = p; a.ph_hi = p + 1; hipLaunchKernelGGL(fwd, dim3(grid), dim3(NTHREADS), LDS_BYTES, stream, a);
#ifdef PROBE_REPEAT_PHASE
        if (p == PROBE_REPEAT_PHASE) hipLaunchKernelGGL(fwd, dim3(grid), dim3(NTHREADS), LDS_BYTES, stream, a);
#endif
    }
#endif
}
```

```cpp
#include <hip/hip_runtime.h>
#include <cstdio>
#include <cstdint>

#ifndef MK_ONE_LAUNCH
#define MK_ONE_LAUNCH 1
#endif

#define DI __device__ __forceinline__
#define GAS __attribute__((address_space(1)))
#define LAS __attribute__((address_space(3)))
typedef unsigned short bf16;
typedef short bf16x8 __attribute__((ext_vector_type(8)));
typedef float f32x4 __attribute__((ext_vector_type(4)));
typedef float f32x2 __attribute__((ext_vector_type(2)));
typedef unsigned u32x4 __attribute__((ext_vector_type(4)));
typedef unsigned u32x2 __attribute__((ext_vector_type(2)));

constexpr int D = 1024, NB = 4, SEQ = 4096, M = NB * SEQ;
constexpr int MEML = 256, MROWS = NB * MEML;
constexpr int LRU_W = 512, RW = 512, NH = 8, HD = 64;
constexpr int INW = 2816;
constexpr int XH = 4, XHD = 256;
constexpr int NE = 32, TOPK = 4, DFF = 1024;
constexpr int NASSIGN = M * TOPK;
constexpr int MAXTILES = 288, MAXROWS = MAXTILES * 256;
constexpr float EPS = 1e-6f, GN_EPS = 64e-5f;

namespace pg8 {
constexpr int BM = 256, BK = 64, HALF = 128, HTB = HALF * BK * 2, STAGE_BYTES = 8 * HTB, NXCD = 8, WGM = 8;
__host__ __device__ __forceinline__ int lds_byte(int r, int c) { const int st = (r >> 4) * 2 + (c >> 5), rr = r & 15, cc = c & 31, ob = rr * 64 + cc * 2; return st * 1024 + (ob ^ (((ob >> 9) & 1) << 5)); }
__host__ __device__ __forceinline__ void stage_rc(int b, int& R, int& C) { const int st = b / 1024, sb = b % 1024, swz = sb ^ (((sb >> 9) & 1) << 5); R = (st >> 1) * 16 + swz / 64; C = (st & 1) * 32 + (swz % 64) / 2; }
__host__ __device__ __forceinline__ int perm32(int rho) { const int n = rho >> 4, i = rho & 15; return 8 * (i >> 2) + 4 * n + (i & 3); }

struct Unit { int pm, pn, e; };

struct StaticOrder {
    int nM, nN, nwg, G, c;
    __host__ __device__ void init_tiles(int nM_, int nN_, int G_, int c_) { nM = nM_; nN = nN_; nwg = nM * nN; G = G_; c = c_; }
    __host__ __device__ bool next(int i, Unit& u) const {
        const long L = (long)i * G + c; if (L >= nwg) return false;
        int wgid = (int)L; { const int q = nwg / NXCD, r = nwg % NXCD, xcd = wgid % NXCD, off = wgid / NXCD; wgid = (xcd < r ? xcd * (q + 1) : r * (q + 1) + (xcd - r) * q) + off; }
        const int nig = WGM * nN, gid = wgid / nig, fm = gid * WGM, gsz = (nM - fm) < WGM ? (nM - fm) : WGM;
        u.pm = fm + ((wgid % nig) % gsz); u.pn = (wgid % nig) / gsz; u.e = 0; return true;
    }
};
struct DenseSched {
    StaticOrder o; const char* A; const char* B; size_t tstep;
    DI bool next(int i, Unit& u) const { return o.next(i, u); }
    DI const char* a_ptr(const Unit& u) const { return A + (size_t)u.pm * tstep; }
    DI const char* b_ptr(const Unit& u) const { return B + (size_t)u.pn * tstep; }
};
struct MoeSched {
    StaticOrder o; const char* A; const char* B; const int* tile_e; size_t tstep, estep;
    DI bool next(int i, Unit& u) const { if (!o.next(i, u)) return false; u.e = tile_e[u.pm]; return true; }
    DI const char* a_ptr(const Unit& u) const { return A + (size_t)u.pm * tstep; }
    DI const char* b_ptr(const Unit& u) const { return B + (size_t)u.e * estep + (size_t)u.pn * tstep; }
};

DI unsigned cvt_pk_bf16(float lo, float hi) { unsigned r; asm volatile("v_cvt_pk_bf16_f32 %0, %1, %2" : "=v"(r) : "v"(lo), "v"(hi)); return r; }

template <class Epi, class Sched, bool ALIGN_EPI = true, bool SP2 = true>
DI void gemm_phase(LAS unsigned char* lds, const int K, const Sched& S, const Epi& E) {
    const int tid = threadIdx.x, wid = __builtin_amdgcn_readfirstlane(tid >> 6), lane = tid & 63, wr = wid >> 2, wc = wid & 3, fr = lane & 15, fq = lane >> 4;
    const int nt = K / BK;
    unsigned voffA[2], voffB[2];
#pragma unroll
    for (int i = 0; i < 2; ++i) { int R, C; stage_rc(tid * 16 + i * 8192, R, C); const int Rb = Epi::PERM ? ((R & ~31) + perm32(R & 31)) : R;
        voffA[i] = (unsigned)(R * K + C) * 2u; voffB[i] = (unsigned)(Rb * K + C) * 2u; }
    const size_t kstep = (size_t)(BK * 2);
    const size_t hstep = (size_t)HALF * K * 2;
    const unsigned ldsw = (unsigned)wid * 1024u;
    const int aoff = lds_byte(wr * 64 + fr, fq * 8), boff = lds_byte(wc * 32 + fr, fq * 8);
#define PG8_SA(b, h) (((b) * 2 + (h)) * HTB)
#define PG8_SB(b, h) ((4 + (b) * 2 + (h)) * HTB)
#define PG8_STAGE(bufoff, gbase, voff) do { _Pragma("unroll") for (int _i = 0; _i < 2; ++_i) \
        __builtin_amdgcn_global_load_lds((const unsigned*)((const char*)(gbase) + (voff)[_i]), (LAS unsigned*)(lds + (bufoff) + ldsw + _i * 8192), 16, 0, 0); } while (0)
#define PG8_LDA(dst, b, h) do { _Pragma("unroll") for (int m = 0; m < 4; ++m) _Pragma("unroll") for (int k = 0; k < 2; ++k) dst[m][k] = *(const LAS bf16x8*)(lds + PG8_SA(b, h) + aoff + m * 2048 + k * 1024); } while (0)
#define PG8_LDB(dst, b, h) do { _Pragma("unroll") for (int n = 0; n < 2; ++n) _Pragma("unroll") for (int k = 0; k < 2; ++k) dst[n][k] = *(const LAS bf16x8*)(lds + PG8_SB(b, h) + boff + n * 2048 + k * 1024); } while (0)
#define PG8_MMA(ai, bj, At, Bt) do { __builtin_amdgcn_s_setprio(1); _Pragma("unroll") for (int m = 0; m < 4; ++m) _Pragma("unroll") for (int n = 0; n < 2; ++n) _Pragma("unroll") for (int k = 0; k < 2; ++k) \
        acc[ai][bj][m][n] = __builtin_amdgcn_mfma_f32_16x16x32_bf16(Bt[n][k], At[m][k], acc[ai][bj][m][n], 0, 0, 0); __builtin_amdgcn_s_setprio(0); } while (0)
#define PG8_WAIT_V(n) asm volatile("s_waitcnt vmcnt(" #n ")" ::: "memory")
#define PG8_WAIT_L(n) asm volatile("s_waitcnt lgkmcnt(" #n ")" ::: "memory")
#define PG8_BAR __builtin_amdgcn_s_barrier()
#define PG8_SCHED __builtin_amdgcn_sched_barrier(0)
    Unit cur, nxt; int ui = 0;
    if (!S.next(0, cur)) return;
    f32x4 acc[2][2][4][2];
#pragma unroll
    for (int a = 0; a < 2; ++a)
#pragma unroll
        for (int b = 0; b < 2; ++b)
#pragma unroll
            for (int m = 0; m < 4; ++m)
#pragma unroll
                for (int n = 0; n < 2; ++n) acc[a][b][m][n] = (f32x4){0.f, 0.f, 0.f, 0.f};
    bf16x8 At[4][2], B0[2][2], B1[2][2];
    const char* cA = S.a_ptr(cur); const char* cB = S.b_ptr(cur);
    if constexpr (SP2) {
        PG8_STAGE(PG8_SB(0, 0), cB, voffB); PG8_STAGE(PG8_SB(0, 1), cB + hstep, voffB); PG8_STAGE(PG8_SA(0, 0), cA, voffA); PG8_STAGE(PG8_SA(0, 1), cA + hstep, voffA);
        if (wr == 1) PG8_BAR;
        PG8_WAIT_V(2); PG8_BAR;
        PG8_STAGE(PG8_SB(1, 0), cB + kstep, voffB); PG8_STAGE(PG8_SA(1, 0), cA + kstep, voffA); PG8_STAGE(PG8_SB(1, 1), cB + hstep + kstep, voffB);
        PG8_WAIT_V(6); PG8_BAR;
    } else {
        PG8_STAGE(PG8_SB(0, 0), cB, voffB); PG8_STAGE(PG8_SA(0, 0), cA, voffA); PG8_STAGE(PG8_SB(0, 1), cB + hstep, voffB); PG8_STAGE(PG8_SA(0, 1), cA + hstep, voffA);
        if (wr == 1) PG8_BAR;
        PG8_WAIT_V(4); PG8_BAR;
        PG8_STAGE(PG8_SB(1, 0), cB + kstep, voffB); PG8_STAGE(PG8_SA(1, 0), cA + kstep, voffA); PG8_STAGE(PG8_SB(1, 1), cB + hstep + kstep, voffB);
        PG8_WAIT_V(6); PG8_BAR;
    }
    for (;;) {
        const bool has_next = S.next(ui + 1, nxt);
        const char* nA = has_next ? S.a_ptr(nxt) : cA; const char* nB = has_next ? S.b_ptr(nxt) : cB;
        for (int t = 0; t < nt; t += 2) {
            const bool last = (t == nt - 2);
            const char* a1 = cA + (size_t)(t + 1) * kstep;
            const char* a2 = last ? nA : cA + (size_t)(t + 2) * kstep; const char* b2 = last ? nB : cB + (size_t)(t + 2) * kstep;
            const char* a3 = a2 + kstep; const char* b3 = b2 + kstep;
            if constexpr (SP2) {
            PG8_LDB(B0, 0, 0); PG8_LDB(B1, 0, 1); PG8_SCHED; PG8_LDA(At, 0, 0); PG8_STAGE(PG8_SA(1, 1), a1 + hstep, voffA);
            PG8_WAIT_V(8); PG8_WAIT_L(0); PG8_BAR; PG8_MMA(0, 0, At, B0); PG8_MMA(0, 1, At, B1); PG8_BAR; PG8_SCHED;
            PG8_LDA(At, 0, 1); PG8_STAGE(PG8_SB(0, 0), b2, voffB); PG8_STAGE(PG8_SB(0, 1), b2 + hstep, voffB); PG8_STAGE(PG8_SA(0, 0), a2, voffA);
            PG8_WAIT_V(8); PG8_WAIT_L(0); PG8_BAR; PG8_MMA(1, 0, At, B0); PG8_MMA(1, 1, At, B1); PG8_BAR; PG8_SCHED;
            PG8_LDB(B0, 1, 0); PG8_LDB(B1, 1, 1); PG8_SCHED; PG8_LDA(At, 1, 0); PG8_STAGE(PG8_SA(0, 1), a2 + hstep, voffA);
            PG8_WAIT_V(8); PG8_WAIT_L(0); PG8_BAR; PG8_MMA(0, 0, At, B0); PG8_MMA(0, 1, At, B1); PG8_BAR; PG8_SCHED;
            PG8_LDA(At, 1, 1); PG8_STAGE(PG8_SB(1, 0), b3, voffB); PG8_STAGE(PG8_SB(1, 1), b3 + hstep, voffB); PG8_STAGE(PG8_SA(1, 0), a3, voffA);
            PG8_WAIT_V(8); PG8_WAIT_L(0); PG8_BAR; PG8_MMA(1, 0, At, B0); PG8_MMA(1, 1, At, B1); PG8_BAR; PG8_SCHED;
            } else {
            PG8_LDB(B0, 0, 0); PG8_SCHED; PG8_LDA(At, 0, 0); PG8_STAGE(PG8_SA(1, 1), a1 + hstep, voffA);
            PG8_WAIT_L(8); PG8_BAR; PG8_WAIT_L(0); PG8_MMA(0, 0, At, B0); PG8_BAR; PG8_SCHED;
            PG8_LDB(B1, 0, 1); PG8_STAGE(PG8_SB(0, 0), b2, voffB);
            PG8_BAR; PG8_WAIT_L(0); PG8_MMA(0, 1, At, B1); PG8_BAR;
            PG8_LDA(At, 0, 1); PG8_STAGE(PG8_SA(0, 0), a2, voffA);
            PG8_BAR; PG8_WAIT_L(0); PG8_MMA(1, 0, At, B0); PG8_BAR; PG8_SCHED;
            PG8_STAGE(PG8_SB(0, 1), b2 + hstep, voffB);
            PG8_WAIT_V(6); PG8_BAR; PG8_MMA(1, 1, At, B1); PG8_BAR;
            PG8_LDB(B0, 1, 0); PG8_SCHED; PG8_LDA(At, 1, 0); PG8_STAGE(PG8_SA(0, 1), a2 + hstep, voffA);
            PG8_WAIT_L(8); PG8_BAR; PG8_WAIT_L(0); PG8_MMA(0, 0, At, B0); PG8_BAR; PG8_SCHED;
            PG8_LDB(B1, 1, 1); PG8_STAGE(PG8_SB(1, 0), b3, voffB);
            PG8_BAR; PG8_WAIT_L(0); PG8_MMA(0, 1, At, B1); PG8_BAR;
            PG8_LDA(At, 1, 1); PG8_STAGE(PG8_SA(1, 0), a3, voffA);
            PG8_BAR; PG8_WAIT_L(0); PG8_MMA(1, 0, At, B0); PG8_BAR; PG8_SCHED;
            PG8_STAGE(PG8_SB(1, 1), b3 + hstep, voffB);
            PG8_WAIT_V(6); PG8_BAR; PG8_MMA(1, 1, At, B1); PG8_BAR;
            }
        }
        if constexpr (ALIGN_EPI) { if (wr == 0) PG8_BAR; }
        E(acc, cur, wr, wc, fr, fq);
        if (!has_next) break;
#pragma unroll
        for (int a = 0; a < 2; ++a)
#pragma unroll
            for (int b = 0; b < 2; ++b)
#pragma unroll
                for (int m = 0; m < 4; ++m)
#pragma unroll
                    for (int n = 0; n < 2; ++n) acc[a][b][m][n] = (f32x4){0.f, 0.f, 0.f, 0.f};
        cur = nxt; cA = nA; cB = nB; ++ui;
        if constexpr (ALIGN_EPI) { if (wr == 1) PG8_BAR; }
    }
    PG8_WAIT_V(0);
    if constexpr (!ALIGN_EPI) { if (wr == 0) PG8_BAR; }
    PG8_BAR;
#undef PG8_SA
#undef PG8_SB
#undef PG8_STAGE
#undef PG8_LDA
#undef PG8_LDB
#undef PG8_MMA
#undef PG8_WAIT_V
#undef PG8_WAIT_L
#undef PG8_BAR
#undef PG8_SCHED
}
}
using pg8::Unit;
using pg8::cvt_pk_bf16;

DI float bflo(unsigned w) { return __uint_as_float(w << 16); }
DI float bfhi(unsigned w) { return __uint_as_float(w & 0xffff0000u); }
DI float bf2f(bf16 b) { return __uint_as_float(((unsigned)b) << 16); }
DI unsigned f2bf(float f) { unsigned u = __float_as_uint(f); return (u + 0x7fffu + ((u >> 16) & 1u)) >> 16; }
DI unsigned pk2(float lo, float hi) { return f2bf(lo) | (f2bf(hi) << 16); }
DI float sigmoid_f(float x) { return 1.0f / (1.0f + __expf(-x)); }
DI float softplus_f(float x) { return fmaxf(x, 0.f) + log1pf(__expf(-fabsf(x))); }
DI float softplus_fast(float x) { return fmaxf(x, 0.f) + __logf(1.0f + __expf(-fabsf(x))); }
DI float gelu_tanh_f(float x) { const float u = 0.7978845608028654f * (x + 0.044715f * x * x * x); return 0.5f * x * (1.0f + tanhf(u)); }
DI int fresh_tid() { int t = threadIdx.x; asm volatile("" : "+v"(t)); return t; }
DI float wave_sum(float v) {
#pragma unroll
    for (int o = 1; o < 64; o <<= 1) v += __shfl_xor(v, o);
    return v;
}

struct EpiBf16Plain {
    static constexpr bool PERM = true;
    bf16* O; int ldc; float scale;
    DI void operator()(const f32x4 (&acc)[2][2][4][2], const Unit& u, int wr, int wc, int fr, int fq) const {
        const int row0 = u.pm * 256 + wr * 64 + fr, col0 = u.pn * 256 + wc * 32 + 8 * fq;
#pragma unroll
        for (int ai = 0; ai < 2; ++ai)
#pragma unroll
            for (int m = 0; m < 4; ++m) { bf16* rowp = O + (size_t)(row0 + ai * 128 + m * 16) * ldc + col0;
#pragma unroll
                for (int bj = 0; bj < 2; ++bj) { const f32x4 v0 = acc[ai][bj][m][0] * scale, v1 = acc[ai][bj][m][1] * scale;
                    u32x4 w; w.x = cvt_pk_bf16(v0[0], v0[1]); w.y = cvt_pk_bf16(v0[2], v0[3]); w.z = cvt_pk_bf16(v1[0], v1[1]); w.w = cvt_pk_bf16(v1[2], v1[3]);
                    *(u32x4*)(rowp + bj * 128) = w; } }
    }
};
struct EpiF32Res {
    static constexpr bool PERM = false;
    const float* Rz; float* C; int ldc;
    DI void operator()(const f32x4 (&acc)[2][2][4][2], const Unit& u, int wr, int wc, int fr, int fq) const {
        const int row0 = u.pm * 256 + wr * 64 + fr, col0 = u.pn * 256 + wc * 32 + 4 * fq;
#pragma unroll
        for (int ai = 0; ai < 2; ++ai)
#pragma unroll
            for (int m = 0; m < 4; ++m) { const size_t off = (size_t)(row0 + ai * 128 + m * 16) * ldc + col0;
#pragma unroll
                for (int bj = 0; bj < 2; ++bj)
#pragma unroll
                    for (int n = 0; n < 2; ++n) { const f32x4 r = *(const f32x4*)(Rz + off + bj * 128 + n * 16); *(f32x4*)(C + off + bj * 128 + n * 16) = r + acc[ai][bj][m][n]; } }
    }
};
struct EpiLora {
    static constexpr bool PERM = false;
    float* LWp; bf16* AAp; bf16* GGp; const float* w0; const float* a0;
    DI void operator()(const f32x4 (&acc)[2][2][4][2], const Unit& u, int wr, int wc, int fr, int fq) const {
        const int kind = u.pn >> 1;
        const int row0 = u.pm * 256 + wr * 64 + fr, col0 = (u.pn & 1) * 256 + wc * 32 + 4 * fq;
#pragma unroll
        for (int bj = 0; bj < 2; ++bj)
#pragma unroll
            for (int n = 0; n < 2; ++n) {
                const int c = col0 + bj * 128 + n * 16;
                f32x4 bias = (f32x4){0.f, 0.f, 0.f, 0.f};
                if (kind == 0) bias = *(const f32x4*)(w0 + c); else if (kind == 1) bias = *(const f32x4*)(a0 + c);
#pragma unroll
                for (int ai = 0; ai < 2; ++ai)
#pragma unroll
                    for (int m = 0; m < 4; ++m) {
                        f32x4 v = acc[ai][bj][m][n] + bias;
                        if (kind == 0) {
#pragma unroll
                            for (int j = 0; j < 4; ++j) { const float w = -softplus_fast(-v[j]) - 0.5f; v[j] = -__expf(w);     }
                        } else if (kind == 1) {
#pragma unroll
                            for (int j = 0; j < 4; ++j) v[j] = sigmoid_f(v[j]);
                        }
                        const size_t o_ = (size_t)(row0 + ai * 128 + m * 16) * 512 + c;
                        if (kind == 0) *(f32x4*)(LWp + o_) = v;
                        else { u32x2 w_; w_.x = cvt_pk_bf16(v[0], v[1]); w_.y = cvt_pk_bf16(v[2], v[3]); *(u32x2*)((kind == 1 ? AAp : GGp) + o_) = w_; }
                    }
            }
    }
};
struct EpiSwiglu {
    static constexpr bool PERM = true;
    bf16* ACT; const float* b_gu;
    DI void operator()(const f32x4 (&acc)[2][2][4][2], const Unit& u, int wr, int wc, int fr, int fq) const {
        const int row0 = u.pm * 256 + wr * 64 + fr, j0 = u.pn * 128 + wc * 32 + 8 * fq;
        const float* bg = b_gu + (size_t)u.e * 2048 + j0; const float* bu = bg + 1024;
        const f32x4 bg0 = *(const f32x4*)bg, bg1 = *(const f32x4*)(bg + 4), bu0 = *(const f32x4*)bu, bu1 = *(const f32x4*)(bu + 4);
#pragma unroll
        for (int ai = 0; ai < 2; ++ai)
#pragma unroll
            for (int m = 0; m < 4; ++m) {
                float o[8];
#pragma unroll
                for (int n = 0; n < 2; ++n) { const f32x4 g4 = acc[ai][0][m][n] + (n ? bg1 : bg0), u4 = acc[ai][1][m][n] + (n ? bu1 : bu0);
#pragma unroll
                    for (int j = 0; j < 4; ++j) { const float g = fminf(g4[j], 7.0f), up = fminf(fmaxf(u4[j], -7.0f), 7.0f); o[n * 4 + j] = (up + 1.0f) * (g * sigmoid_f(1.702f * g)); } }
                u32x4 w; w.x = cvt_pk_bf16(o[0], o[1]); w.y = cvt_pk_bf16(o[2], o[3]); w.z = cvt_pk_bf16(o[4], o[5]); w.w = cvt_pk_bf16(o[6], o[7]);
                *(u32x4*)(ACT + (size_t)(row0 + ai * 128 + m * 16) * 1024 + j0) = w;
            }
    }
};
struct EpiDown {
    static constexpr bool PERM = true;
    bf16* YS; const float* b_dn; const int* row_slot; const float* row_gate;
    DI void operator()(const f32x4 (&acc)[2][2][4][2], const Unit& u, int wr, int wc, int fr, int fq) const {
        const int row0 = u.pm * 256 + wr * 64 + fr, col0 = u.pn * 256 + wc * 32 + 8 * fq;
        const float* bb = b_dn + (size_t)u.e * 1024 + col0;
        f32x4 bv[2][2];
#pragma unroll
        for (int bj = 0; bj < 2; ++bj)
#pragma unroll
            for (int n = 0; n < 2; ++n) bv[bj][n] = *(const f32x4*)(bb + bj * 128 + 4 * n);
#pragma unroll
        for (int ai = 0; ai < 2; ++ai)
#pragma unroll
            for (int m = 0; m < 4; ++m) {
                const int r = row0 + ai * 128 + m * 16; const int slot = row_slot[r]; const float gt = row_gate[r];
                if (slot >= 0) { bf16* rowp = YS + (size_t)slot * 1024 + col0;
#pragma unroll
                    for (int bj = 0; bj < 2; ++bj) { const f32x4 v0 = (acc[ai][bj][m][0] + bv[bj][0]) * gt, v1 = (acc[ai][bj][m][1] + bv[bj][1]) * gt;
                        u32x4 w; w.x = cvt_pk_bf16(v0[0], v0[1]); w.y = cvt_pk_bf16(v0[2], v0[3]); w.z = cvt_pk_bf16(v1[0], v1[1]); w.w = cvt_pk_bf16(v1[2], v1[3]);
                        *(u32x4*)(rowp + bj * 128) = w; } }
            }
    }
};

constexpr size_t MiB = 1u << 20;
constexpr size_t WS_CTL = 0, CTL_ZERO_BYTES = 1 * MiB;
constexpr size_t WS_WIN = 1 * MiB, WS_WOUT = 7 * MiB, WS_WQ = 9 * MiB, WS_WK = 11 * MiB, WS_WV = 13 * MiB, WS_WO = 15 * MiB, WS_LORAB = 17 * MiB, WS_LRUW = 18 * MiB;
constexpr size_t WS_ROUTE = 19 * MiB;
constexpr size_t WS_WGU = 22 * MiB, WS_WDN = 150 * MiB;
constexpr size_t WS_HN = 214 * MiB, WS_MEMN = 246 * MiB, WS_KM = 248 * MiB, WS_VT = 250 * MiB;
constexpr size_t WS_X1 = 252 * MiB, WS_X2 = 316 * MiB;
constexpr size_t WS_U = 380 * MiB, WS_R = 468 * MiB, WS_KRAW = 500 * MiB, WS_V = 532 * MiB, WS_KKN = 564 * MiB, WS_WD = 596 * MiB, WS_AA = 628 * MiB, WS_G = 660 * MiB;
constexpr size_t WS_LA = 692 * MiB, WS_LB = 724 * MiB, WS_AP = 756 * MiB, WS_CAT = 764 * MiB, WS_Q = 796 * MiB;
constexpr size_t WS_XS = 380 * MiB, WS_ACT = 524 * MiB, WS_YS = 668 * MiB;
constexpr size_t WS_GP = 796 * MiB, WS_HF = 860 * MiB, WS_RP = 924 * MiB, WS_Y1F = 940 * MiB, WS_ADD = 972 * MiB, WS_END = 1004 * MiB;
constexpr size_t WS_GC = 468 * MiB, WS_HC = 484 * MiB, WS_ZS = 500 * MiB;
static_assert(WS_AA == WS_WD + 32 * MiB && WS_G == WS_AA + 32 * MiB, "EpiLora strides");
static_assert(WS_U + (size_t)M * INW * 2 <= WS_R && WS_XS + (size_t)MAXROWS * 2048 <= WS_ACT && WS_ACT + (size_t)MAXROWS * 2048 <= WS_YS && WS_YS + (size_t)NASSIGN * 2048 <= WS_Q, "ws map");
constexpr size_t RT_E = 0, RT_POS = 256 * 1024, RT_G = 512 * 1024, RT_SLOT = 768 * 1024, RT_GATE = 1088 * 1024, RT_TILE = 1408 * 1024;
constexpr int CW_BAR = 4096, CW_CNT = 8192;

constexpr int RING_BYTES = 131072, MISC_OFF = RING_BYTES + 320, LDS_BYTES = 147456;
constexpr int NWAVES = 8, NTHREADS = 512;

#define XB_TMO      128
#define XB_XCNT(j)  (256  + 64 * (j))
#define XB_XSUB(j)  (1280 + 64 * (j))
#define XB_XGEN(j)  (2304 + 64 * (j))
#define XB_TOP      3328
#define XB_TOPGEN   3392
#define XCD_BAR_WORDS 3456
#define XB_SPIN_CAP (1u << 18)
DI unsigned xb_ld(unsigned* p)              { return __hip_atomic_load(p, __ATOMIC_RELAXED, __HIP_MEMORY_SCOPE_AGENT); }
DI unsigned xb_add(unsigned* p, unsigned v) { return __hip_atomic_fetch_add(p, v, __ATOMIC_RELAXED, __HIP_MEMORY_SCOPE_AGENT); }
DI unsigned xb_xcc_id() { return (unsigned)__builtin_amdgcn_s_getreg((3 << 11) | 20) & 0xFu; }
#define XB_SPIN(cond, bar) do { unsigned _sp = 0; while (cond) { __builtin_amdgcn_s_sleep(1); \
    if ((++_sp & 255u) == 0u) { if (xb_ld(&(bar)[XB_TMO])) break; if (_sp > XB_SPIN_CAP) { atomicAdd(&(bar)[XB_TMO], 1u); break; } } } } while (0)
struct XcdBarrier { unsigned* bar; unsigned x; volatile LAS unsigned* st; };
DI XcdBarrier xcd_barrier_post(unsigned* bar, volatile LAS unsigned* st) {
    XcdBarrier b; b.bar = bar; b.x = xb_xcc_id(); b.st = st;
    if (threadIdx.x == 0) (void)xb_add(&bar[XB_XCNT(b.x)], 1u);
    return b;
}
DI void xcd_barrier_complete(unsigned* bar, unsigned x, unsigned& nloc, unsigned& nx) {
    const unsigned G = gridDim.x * gridDim.y * gridDim.z;
    unsigned sum, cnt, mine, sp = 0u;
    for (;;) {
        sum = 0u; cnt = 0u; mine = 0u;
#pragma unroll
        for (unsigned j = 0; j < 16; ++j) { const unsigned c = xb_ld(&bar[XB_XCNT(j)]); sum += c; cnt += (c > 0u) ? 1u : 0u; mine = (j == x) ? c : mine; }
        if (sum == G) break;
        __builtin_amdgcn_s_sleep(1);
        if ((++sp & 255u) == 0u) { if (xb_ld(&bar[XB_TMO])) break; if (sp > XB_SPIN_CAP) { atomicAdd(&bar[XB_TMO], 1u); break; } }
    }
    nloc = mine > 0u ? mine : 1u; nx = cnt > 0u ? cnt : 1u;
}
DI void xcd_barrier(const XcdBarrier& b) {
    asm volatile("s_waitcnt vmcnt(0)" ::: "memory");
    __syncthreads();
    if (threadIdx.x == 0) {
        unsigned* bar = b.bar;
        __builtin_amdgcn_s_waitcnt(0);
        unsigned nloc = b.st[0], nx = b.st[1];
        if (nloc == 0u) { xcd_barrier_complete(bar, b.x, nloc, nx); b.st[0] = nloc; b.st[1] = nx; }
        const unsigned old = xb_add(&bar[XB_XSUB(b.x)], 1u);
        const unsigned gen = old / nloc;
        if (old + 1u == (gen + 1u) * nloc) {
            __builtin_amdgcn_fence(__ATOMIC_RELEASE, "agent");
            asm volatile("s_waitcnt vmcnt(0)" ::: "memory");
            const unsigned og = xb_add(&bar[XB_TOP], 1u);
            const unsigned tg = og / nx;
            if (og + 1u == (tg + 1u) * nx) xb_add(&bar[XB_TOPGEN], 1u);
            else XB_SPIN(xb_ld(&bar[XB_TOPGEN]) == tg, bar);
            __builtin_amdgcn_fence(__ATOMIC_ACQUIRE, "agent");
            xb_add(&bar[XB_XGEN(b.x)], 1u);
            asm volatile("s_waitcnt vmcnt(0)" ::: "memory");
        } else {
            XB_SPIN(xb_ld(&bar[XB_XGEN(b.x)]) == gen, bar);
            __builtin_amdgcn_fence(__ATOMIC_ACQUIRE, "agent");
            asm volatile("s_waitcnt vmcnt(0)" ::: "memory");
        }
    }
    __syncthreads();
}

struct Args { const float* in[37]; float* out; unsigned char* ws; int ph_lo, ph_hi; };
enum { I_X = 0, I_MEM, I_NMIXG, I_WIN, I_CONVW, I_CONVB, I_LWX, I_LBX, I_LWA, I_LBA, I_LAM, I_MU, I_W0, I_WUP, I_A0, I_AUP, I_GUP, I_KK, I_KA, I_RK, I_LNG, I_LNB,
       I_WOUT, I_NXAG, I_NMEMG, I_WQ, I_WK, I_WV, I_WO, I_NFFG, I_WR, I_BR, I_WGU, I_BGU, I_WDN, I_BDN, I_FNG };

DI void transpose_item(const float* W, int ldw, int K, bf16* WT, int k0, int n0, int drow0, LAS float* scr, int lane) {
#pragma unroll 8
    for (int i = 0; i < 32; ++i) { const int kk = 2 * i + (lane >> 5); scr[kk * 33 + (lane & 31)] = W[(size_t)(k0 + kk) * ldw + n0 + (lane & 31)]; }
    asm volatile("s_waitcnt lgkmcnt(0)" ::: "memory");
    const int c = lane & 7;
#pragma unroll
    for (int j = 0; j < 4; ++j) { const int n = (lane >> 3) + 8 * j; const LAS float* s = scr + (8 * c) * 33 + n;
        u32x4 o; o.x = pk2(s[0 * 33], s[1 * 33]); o.y = pk2(s[2 * 33], s[3 * 33]); o.z = pk2(s[4 * 33], s[5 * 33]); o.w = pk2(s[6 * 33], s[7 * 33]);
        *(u32x4*)(WT + (size_t)(drow0 + n) * K + k0 + 8 * c) = o; }
    asm volatile("s_waitcnt lgkmcnt(0)" ::: "memory");
}
DI void rms_row_to_bf16(const float* xrow, const float* g, bf16* orow, int lane) {
    const f32x4* xr = (const f32x4*)xrow + lane; const f32x4* gr = (const f32x4*)g + lane;
    f32x4 v[4]; float s = 0.f;
#pragma unroll
    for (int j = 0; j < 4; ++j) { v[j] = xr[64 * j]; s += (v[j].x * v[j].x + v[j].y * v[j].y) + (v[j].z * v[j].z + v[j].w * v[j].w); }
    const float rstd = 1.0f / sqrtf(wave_sum(s) * (1.f / D) + EPS);
    u32x2* o8 = (u32x2*)orow + lane;
#pragma unroll
    for (int j = 0; j < 4; ++j) { const f32x4 gg = gr[64 * j]; u32x2 w; w.x = pk2(v[j].x * rstd * gg.x, v[j].y * rstd * gg.y); w.y = pk2(v[j].z * rstd * gg.z, v[j].w * rstd * gg.w); o8[64 * j] = w; }
}

__global__ void __launch_bounds__(NTHREADS, 2) fwd(Args args) {
    extern __shared__ __attribute__((aligned(16))) unsigned char lds_raw[];
    LAS unsigned char* lds = (LAS unsigned char*)lds_raw;
    volatile LAS unsigned* MISC = (volatile LAS unsigned*)(lds + MISC_OFF);
    const int G = gridDim.x, bid = blockIdx.x, NGW = G * NWAVES;
#define PHASE_IDS const int tid = fresh_tid(), lane = tid & 63, wave = __builtin_amdgcn_readfirstlane(tid >> 6), gw = bid * NWAVES + wave; (void)tid; (void)lane; (void)wave; (void)gw
    unsigned char* ws = args.ws;
    unsigned* ctl = (unsigned*)(ws + WS_CTL);
    const int lo = args.ph_lo, hi = args.ph_hi;

    for (int u = threadIdx.x; u < (LDS_BYTES - RING_BYTES) / 4; u += NTHREADS) ((LAS unsigned*)(lds + RING_BYTES))[u] = 0u;
    __syncthreads();
    XcdBarrier bar; bar.bar = ctl + CW_BAR; bar.x = 0; bar.st = nullptr;
    if (hi - lo > 1) bar = xcd_barrier_post(ctl + CW_BAR, MISC + 8);
#define IN(k) (lo <= (k) && (k) < hi)
#define SEAM(k) do { if (IN(k) && IN((k) + 1)) xcd_barrier(bar); } while (0)

#define Win_t ((bf16*)(ws + WS_WIN))
#define Wout_t ((bf16*)(ws + WS_WOUT))
#define Wq_t ((bf16*)(ws + WS_WQ))
#define Wk_t ((bf16*)(ws + WS_WK))
#define Wv_t ((bf16*)(ws + WS_WV))
#define Wo_t ((bf16*)(ws + WS_WO))
#define LoraB ((bf16*)(ws + WS_LORAB))
#define LruW ((bf16*)(ws + WS_LRUW))
#define Wgu_t ((bf16*)(ws + WS_WGU))
#define Wdn_t ((bf16*)(ws + WS_WDN))
#define HN ((bf16*)(ws + WS_HN))
#define MEMN ((bf16*)(ws + WS_MEMN))
#define KM ((bf16*)(ws + WS_KM))
#define VT ((bf16*)(ws + WS_VT))
#define X1 ((float*)(ws + WS_X1))
#define X2 ((float*)(ws + WS_X2))
#define U ((bf16*)(ws + WS_U))
#define Rr ((float*)(ws + WS_R))
#define KRAW ((float*)(ws + WS_KRAW))
#define Vv ((float*)(ws + WS_V))
#define KKN ((float*)(ws + WS_KKN))
#define WD ((float*)(ws + WS_WD))
#define AA ((float*)(ws + WS_AA))
#define GG ((float*)(ws + WS_G))
#define LA ((float*)(ws + WS_LA))
#define LB ((float*)(ws + WS_LB))
#define AP ((bf16*)(ws + WS_AP))
#define CAT ((bf16*)(ws + WS_CAT))
#define Qb ((bf16*)(ws + WS_Q))
#define Ob CAT
#define XS ((bf16*)(ws + WS_XS))
#define ACT ((bf16*)(ws + WS_ACT))
#define YS ((bf16*)(ws + WS_YS))
#define route_e ((int*)(ws + WS_ROUTE + RT_E))
#define route_pos ((int*)(ws + WS_ROUTE + RT_POS))
#define route_g ((float*)(ws + WS_ROUTE + RT_G))
#define row_slot ((int*)(ws + WS_ROUTE + RT_SLOT))
#define row_gate ((float*)(ws + WS_ROUTE + RT_GATE))
#define tile_tab ((int*)(ws + WS_ROUTE + RT_TILE))
#define ecnt (ctl + CW_CNT)

    if (IN(0)) { PHASE_IDS;
        LAS float* scr = (LAS float*)(lds + wave * 16384);
        constexpr int I_IN = 16 * (INW / 32), I_SQ = 16 * 32;
        constexpr int N_ITEMS = I_IN + 5 * I_SQ;
        for (int it = gw; it < N_ITEMS; it += NGW) {
            int r = it;
            if (r < I_IN) { const int nblk = INW / 32, kb = r / nblk, nb = r % nblk; transpose_item(args.in[I_WIN], INW, D, Win_t, 64 * kb, 32 * nb, 32 * nb, scr, lane); continue; } r -= I_IN;
            { const int w = r / I_SQ, q = r % I_SQ, kb = q / 32, nb = q % 32;
                const float* src = w == 0 ? args.in[I_WOUT] : w == 1 ? args.in[I_WQ] : w == 2 ? args.in[I_WK] : w == 3 ? args.in[I_WV] : args.in[I_WO];
                bf16* dst = w == 0 ? Wout_t : w == 1 ? Wq_t : w == 2 ? Wk_t : w == 3 ? Wv_t : Wo_t;
                transpose_item(src, D, D, dst, 64 * kb, 32 * nb, 32 * nb, scr, lane); }
        }
        for (int idx = bid * NTHREADS + tid; idx < 1536 * 256; idx += G * NTHREADS) {
            const int n = idx >> 8, k = idx & 255; float v = 0.f;
            if (n < 512) { if (k < 64) v = args.in[I_WUP][k * 512 + n]; }
            else if (n < 1024) { if (k >= 64 && k < 128) v = args.in[I_AUP][(k - 64) * 512 + (n - 512)]; }
            else { if (k >= 128) v = args.in[I_GUP][(k - 128) * 512 + (n - 1024)]; }
            LoraB[idx] = (bf16)f2bf(v);
        }
        for (int idx = bid * NTHREADS + tid; idx < 8 * 128 * 64; idx += G * NTHREADS) {
            const int nb = idx >> 13, col = (idx >> 6) & 127, k = idx & 63;
            const float v = col < 64 ? args.in[I_LWX][nb * 4096 + k * 64 + col] : args.in[I_LWA][nb * 4096 + k * 64 + (col - 64)];
            LruW[idx] = (bf16)f2bf(v);
        }
        for (int m = gw; m < M; m += NGW) rms_row_to_bf16(args.in[I_X] + (size_t)m * D, args.in[I_NMIXG], HN + (size_t)m * D, lane);
        for (int m = gw; m < MROWS; m += NGW) rms_row_to_bf16(args.in[I_MEM] + (size_t)m * D, args.in[I_NMEMG], MEMN + (size_t)m * D, lane);
    }
    SEAM(0);

    if (IN(1)) { PHASE_IDS;
        { pg8::DenseSched S; S.o.init_tiles(M / 256, INW / 256, G, bid); S.A = (const char*)HN; S.B = (const char*)Win_t; S.tstep = (size_t)256 * D * 2;
          EpiBf16Plain E{U, INW, 1.0f}; pg8::gemm_phase(lds, D, S, E); }
        { pg8::DenseSched S; S.o.init_tiles(MROWS / 256, D / 256, G, (bid + 64) & (G - 1)); S.A = (const char*)MEMN; S.B = (const char*)Wk_t; S.tstep = (size_t)256 * D * 2;
          EpiBf16Plain E{KM, D, 1.0f}; pg8::gemm_phase(lds, D, S, E); }
        { pg8::DenseSched S; S.o.init_tiles(D / 256, MROWS / 256, G, (bid + 48) & (G - 1)); S.A = (const char*)Wv_t; S.B = (const char*)MEMN; S.tstep = (size_t)256 * D * 2;
          EpiBf16Plain E{VT, MROWS, 1.0f}; pg8::gemm_phase(lds, D, S, E); }
    }
    SEAM(1);

    if (IN(2)) { PHASE_IDS;
        const float* mu = args.in[I_MU];
        for (int m = gw; m < M; m += NGW) {
            const bool hp = (m & (SEQ - 1)) != 0;
            const bf16* ur = U + (size_t)m * INW + 2560 + 4 * lane;
            const u32x2 cu = *(const u32x2*)ur; u32x2 pu = (u32x2){0u, 0u}; if (hp) pu = *(const u32x2*)(ur - INW);
            const f32x4 m4 = *(const f32x4*)(mu + 1536 + 4 * lane);
            f32x4 uu; { const float a0 = bflo(cu.x), a1 = bfhi(cu.x), a2 = bflo(cu.y), a3 = bfhi(cu.y), p0 = bflo(pu.x), p1 = bfhi(pu.x), p2 = bflo(pu.y), p3 = bfhi(pu.y);
                uu.x = a0 + (p0 - a0) * m4.x; uu.y = a1 + (p1 - a1) * m4.y; uu.z = a2 + (p2 - a2) * m4.z; uu.w = a3 + (p3 - a3) * m4.w; }
            f32x4 o = uu;
            if (lane < 16) { o.x = tanhf(uu.x); o.y = tanhf(uu.y); o.z = tanhf(uu.z); o.w = tanhf(uu.w); }
            else if (lane >= 32) { o.x = sigmoid_f(uu.x); o.y = sigmoid_f(uu.y); o.z = sigmoid_f(uu.z); o.w = sigmoid_f(uu.w); }
            u32x2 w; w.x = pk2(o.x, o.y); w.y = pk2(o.z, o.w); *(u32x2*)(AP + (size_t)m * 256 + 4 * lane) = w;
        }
        {
            const float* conv_w = args.in[I_CONVW]; const float* conv_b = args.in[I_CONVB]; const float* bx = args.in[I_LBX]; const float* ba = args.in[I_LBA]; const float* lam = args.in[I_LAM];
            LAS float* xs = (LAS float*)(lds + wave * 4096);
            const int i = lane & 15, kg = lane >> 4;
            for (int unit = gw; unit < (M / 16) * 2; unit += NGW) {
                const int tile = unit >> 1, nb0 = (unit & 1) * 4, m0 = tile * 16, s0 = m0 & (SEQ - 1);
                for (int nb = nb0; nb < nb0 + 4; ++nb) {
                    bf16x8 af[2];
#pragma unroll
                    for (int ks = 0; ks < 2; ++ks) {
                        const int chb = nb * 64 + 32 * ks + 8 * kg;
                        f32x4 x0 = *(const f32x4*)(conv_b + chb), x1 = *(const f32x4*)(conv_b + chb + 4);
#pragma unroll
                        for (int j = 0; j < 4; ++j) {
                            if (s0 + i - 3 + j >= 0) {
                                const u32x4 uw = *(const u32x4*)(U + (size_t)(m0 + i - 3 + j) * INW + chb);
                                const f32x4 w0 = *(const f32x4*)(conv_w + j * 512 + chb), w1 = *(const f32x4*)(conv_w + j * 512 + chb + 4);
                                x0.x += w0.x * bflo(uw.x); x0.y += w0.y * bfhi(uw.x); x0.z += w0.z * bflo(uw.y); x0.w += w0.w * bfhi(uw.y);
                                x1.x += w1.x * bflo(uw.z); x1.y += w1.y * bfhi(uw.z); x1.z += w1.z * bflo(uw.w); x1.w += w1.w * bfhi(uw.w);
                            }
                        }
                        *(LAS f32x4*)(xs + i * 64 + 32 * ks + 8 * kg) = x0; *(LAS f32x4*)(xs + i * 64 + 32 * ks + 8 * kg + 4) = x1;
                        u32x4 p; p.x = pk2(x0.x, x0.y); p.y = pk2(x0.z, x0.w); p.z = pk2(x1.x, x1.y); p.w = pk2(x1.z, x1.w);
                        af[ks] = __builtin_bit_cast(bf16x8, p);
                    }
                    f32x4 acc[8];
#pragma unroll
                    for (int ct = 0; ct < 8; ++ct) { acc[ct] = (f32x4){0.f, 0.f, 0.f, 0.f};
#pragma unroll
                        for (int ks = 0; ks < 2; ++ks) { const bf16x8 bfr = *(const bf16x8*)(LruW + ((size_t)(nb * 128 + 16 * ct + i) * 64 + 32 * ks + 8 * kg));
                            acc[ct] = __builtin_amdgcn_mfma_f32_16x16x32_bf16(af[ks], bfr, acc[ct], 0, 0, 0); } }
                    asm volatile("s_waitcnt lgkmcnt(0)" ::: "memory");
#pragma unroll
                    for (int ct = 0; ct < 4; ++ct) {
                        const int col = 16 * ct + i, ch = nb * 64 + col;
                        const float bxv = bx[ch], bav = ba[ch], sp = softplus_f(-lam[ch]);
#pragma unroll
                        for (int e = 0; e < 4; ++e) {
                            const int tok = 4 * kg + e;
                            const float gx = sigmoid_f(acc[ct][e] + bxv), ga = sigmoid_f(acc[ct + 4][e] + bav);
                            const float la = -8.0f * ga * sp, a = __expf(la), xcv = xs[tok * 64 + col];
                            const float bt = sqrtf(fmaxf(-expm1f(2.0f * la), 0.f)) * gx * xcv;
                            LA[(size_t)(m0 + tok) * 512 + ch] = a; LB[(size_t)(m0 + tok) * 512 + ch] = bt;
                        }
                    }
                }
            }
        }
    }
    SEAM(2);

    if (IN(3)) { PHASE_IDS;
        pg8::DenseSched S; S.o.init_tiles(M / 256, 1536 / 256, G, bid); S.A = (const char*)AP; S.B = (const char*)LoraB; S.tstep = (size_t)256 * 256 * 2;
        EpiLora E{WD, (bf16*)(ws + WS_AA), (bf16*)(ws + WS_G), args.in[I_W0], args.in[I_A0]}; pg8::gemm_phase(lds, 256, S, E);
    }
    SEAM(3);

    if (IN(4)) { PHASE_IDS;
        LAS unsigned char* wl = lds + wave * 16384;
        LAS bf16* Arm = (LAS bf16*)(wl); LAS bf16* Brm = (LAS bf16*)(wl + 2048); LAS bf16* Krm = (LAS bf16*)(wl + 4096); LAS bf16* Rrm = (LAS bf16*)(wl + 6144);
        LAS bf16* ATt = (LAS bf16*)(wl + 8192); LAS bf16* BTt = (LAS bf16*)(wl + 10240); LAS bf16* KTt = (LAS bf16*)(wl + 12288); LAS bf16* VTt = (LAS bf16*)(wl + 14336);
        LAS float* MabT = (LAS float*)(wl); LAS bf16* Mak = (LAS bf16*)(wl + 1024); LAS bf16* Mrb = (LAS bf16*)(wl + 1536); LAS bf16* Mrk = (LAS bf16*)(wl + 2048); LAS bf16* Tm = (LAS bf16*)(wl + 2560);
        LAS float* PLs = (LAS float*)(wl + 3072); LAS bf16* Q0T = (LAS bf16*)(wl + 4096);
        const int l15 = lane & 15, g = lane >> 4, te = lane >> 2, kq = lane & 3;
        const bf16x8 z8 = (bf16x8){0, 0, 0, 0, 0, 0, 0, 0};
        const f32x4 z4 = (f32x4){0.f, 0.f, 0.f, 0.f};
        for (int un = gw; un < NB * NH * (SEQ / 16); un += NGW) {
            const int bh = un >> 8, c = un & 255, b = bh >> 3, h = bh & 7;
            const size_t mrow = (size_t)b * SEQ + c * 16 + te, off = mrow * 512 + h * 64 + 16 * kq;
            const int hc = h * 64 + 16 * kq;
            float cl[16], eP[16];
            {
                float lwv[16], rl[16], kl[16], vl[16], kn[16], av[16];
                const bool hp = (mrow & (SEQ - 1)) != 0;
                const bf16* ub = U + mrow * INW + 1024 + hc;
#pragma unroll
                for (int hh = 0; hh < 2; ++hh) {
#pragma unroll
                    for (int a3 = 0; a3 < 3; ++a3) {
                        const u32x4 cu = *(const u32x4*)(ub + 512 * a3 + 8 * hh); u32x4 pu = (u32x4){0u, 0u, 0u, 0u}; if (hp) pu = *(const u32x4*)(ub - INW + 512 * a3 + 8 * hh);
                        const f32x4 m0 = *(const f32x4*)(args.in[I_MU] + 512 * a3 + hc + 8 * hh), m1 = *(const f32x4*)(args.in[I_MU] + 512 * a3 + hc + 8 * hh + 4);
                        float o8[8];
#pragma unroll
                        for (int q = 0; q < 4; ++q) { const float c0 = bflo(cu[q]), c1 = bfhi(cu[q]), p0 = bflo(pu[q]), p1 = bfhi(pu[q]); const float mm0 = q < 2 ? m0[2 * q] : m1[2 * q - 4], mm1 = q < 2 ? m0[2 * q + 1] : m1[2 * q - 3];
                            o8[2 * q] = c0 + (p0 - c0) * mm0; o8[2 * q + 1] = c1 + (p1 - c1) * mm1; }
#pragma unroll
                        for (int q = 0; q < 8; ++q) { if (a3 == 0) rl[8 * hh + q] = o8[q]; else if (a3 == 1) kl[8 * hh + q] = o8[q]; else vl[8 * hh + q] = o8[q]; }
                    }
                    const u32x4 aw = *(const u32x4*)((const bf16*)(ws + WS_AA) + off + 8 * hh);
#pragma unroll
                    for (int q = 0; q < 4; ++q) { av[8 * hh + 2 * q] = bflo(aw[q]); av[8 * hh + 2 * q + 1] = bfhi(aw[q]); }
                }
                float ss = 0.f;
#pragma unroll
                for (int j4 = 0; j4 < 4; ++j4) { const f32x4 x = *(const f32x4*)(WD + off + 4 * j4), kk4 = *(const f32x4*)(args.in[I_KK] + hc + 4 * j4); lwv[4 * j4] = x.x; lwv[4 * j4 + 1] = x.y; lwv[4 * j4 + 2] = x.z; lwv[4 * j4 + 3] = x.w;
#pragma unroll
                    for (int q = 0; q < 4; ++q) { kn[4 * j4 + q] = kl[4 * j4 + q] * kk4[q]; ss += kn[4 * j4 + q] * kn[4 * j4 + q]; } }
                ss += __shfl_xor(ss, 1); ss += __shfl_xor(ss, 2);
                const float kinv = 1.0f / fmaxf(sqrtf(ss), 1e-12f);
#pragma unroll
                for (int j = 0; j < 16; ++j) { float x = lwv[j];
#pragma unroll
                    for (int sft = 4; sft < 64; sft <<= 1) { const float y = __shfl_up(x, sft); if (lane >= sft) x += y; }
                    cl[j] = x; }
                float bon = 0.f;
                u32x4 pa[2], pb[2], pk[2], pr[2];
#pragma unroll
                for (int j4 = 0; j4 < 4; ++j4) {
                    const f32x4 ka = *(const f32x4*)(args.in[I_KA] + hc + 4 * j4), rk = *(const f32x4*)(args.in[I_RK] + hc + 4 * j4);
                    float at4[4], bt4[4], kt4[4], rt4[4];
#pragma unroll
                    for (int q = 0; q < 4; ++q) { const int j = 4 * j4 + q;
                        const float p = __expf(cl[j]), pn = __expf(-cl[j]), pm1 = __expf(cl[j] - lwv[j]); eP[j] = p;
                        const float knj = kn[j] * kinv;
                        const float kp = kl[j] * (1.0f + (av[j] - 1.0f) * ka[q]);
                        at4[q] = -knj * pm1; bt4[q] = knj * av[j] * pn; kt4[q] = kp * pn; rt4[q] = rl[j] * p;
                        bon += rl[j] * kp * rk[q];
                        const int kk = 16 * kq + j;
                        ATt[kk * 16 + te] = (bf16)f2bf(at4[q]); BTt[kk * 16 + te] = (bf16)f2bf(bt4[q]); KTt[kk * 16 + te] = (bf16)f2bf(kt4[q]); VTt[kk * 16 + te] = (bf16)f2bf(vl[j]); }
                    const int hh = j4 >> 1, w2 = (j4 & 1) * 2;
                    pa[hh][w2] = pk2(at4[0], at4[1]); pa[hh][w2 + 1] = pk2(at4[2], at4[3]); pb[hh][w2] = pk2(bt4[0], bt4[1]); pb[hh][w2 + 1] = pk2(bt4[2], bt4[3]);
                    pk[hh][w2] = pk2(kt4[0], kt4[1]); pk[hh][w2 + 1] = pk2(kt4[2], kt4[3]); pr[hh][w2] = pk2(rt4[0], rt4[1]); pr[hh][w2 + 1] = pk2(rt4[2], rt4[3]);
                }
#pragma unroll
                for (int hh = 0; hh < 2; ++hh) { const int po = te * 64 + 8 * ((2 * kq + hh) ^ (te & 7));
                    *(LAS u32x4*)(Arm + po) = pa[hh]; *(LAS u32x4*)(Brm + po) = pb[hh]; *(LAS u32x4*)(Krm + po) = pk[hh]; *(LAS u32x4*)(Rrm + po) = pr[hh]; }
                bon += __shfl_xor(bon, 1); bon += __shfl_xor(bon, 2);
#pragma unroll
                for (int hh = 0; hh < 2; ++hh) { const u32x4 gw_ = *(const u32x4*)((const bf16*)(ws + WS_G) + off + 8 * hh);
#pragma unroll
                    for (int q2 = 0; q2 < 2; ++q2) { const f32x4 lb = *(const f32x4*)(args.in[I_LNB] + hc + 8 * hh + 4 * q2); const int j0 = 8 * hh + 4 * q2;
                        f32x4 o; o.x = (lb.x + vl[j0] * bon) * bflo(gw_[2 * q2]); o.y = (lb.y + vl[j0 + 1] * bon) * bfhi(gw_[2 * q2]); o.z = (lb.z + vl[j0 + 2] * bon) * bflo(gw_[2 * q2 + 1]); o.w = (lb.w + vl[j0 + 3] * bon) * bfhi(gw_[2 * q2 + 1]);
                        *(f32x4*)((float*)(ws + WS_ADD) + off + j0) = o; } }
            }
            asm volatile("s_waitcnt lgkmcnt(0)" ::: "memory");
            {
                bf16x8 fa[2], fr[2], fb[2], fk[2];
#pragma unroll
                for (int ks = 0; ks < 2; ++ks) { const int po = l15 * 64 + 8 * ((4 * ks + g) ^ (l15 & 7));
                    fa[ks] = *(const LAS bf16x8*)(Arm + po); fr[ks] = *(const LAS bf16x8*)(Rrm + po); fb[ks] = *(const LAS bf16x8*)(Brm + po); fk[ks] = *(const LAS bf16x8*)(Krm + po); }
                f32x4 mab = z4, mak = z4, mrb = z4, mrk = z4;
#pragma unroll
                for (int ks = 0; ks < 2; ++ks) { mab = __builtin_amdgcn_mfma_f32_16x16x32_bf16(fb[ks], fa[ks], mab, 0, 0, 0); mak = __builtin_amdgcn_mfma_f32_16x16x32_bf16(fk[ks], fa[ks], mak, 0, 0, 0);
                    mrb = __builtin_amdgcn_mfma_f32_16x16x32_bf16(fb[ks], fr[ks], mrb, 0, 0, 0); mrk = __builtin_amdgcn_mfma_f32_16x16x32_bf16(fk[ks], fr[ks], mrk, 0, 0, 0); }
#pragma unroll
                for (int e = 0; e < 4; ++e) { const int i = 4 * g + e; if (!(i < l15)) { mab[e] = 0.f; mak[e] = 0.f; } if (!(i <= l15)) { mrb[e] = 0.f; mrk[e] = 0.f; } }
                asm volatile("s_waitcnt lgkmcnt(0)" ::: "memory");
#pragma unroll
                for (int e = 0; e < 4; ++e) MabT[(4 * g + e) * 16 + l15] = mab[e];
                u32x2 w; w.x = pk2(mak[0], mak[1]); w.y = pk2(mak[2], mak[3]); *(LAS u32x2*)(Mak + l15 * 16 + 4 * g) = w;
                w.x = pk2(mrb[0], mrb[1]); w.y = pk2(mrb[2], mrb[3]); *(LAS u32x2*)(Mrb + l15 * 16 + 4 * g) = w;
                w.x = pk2(mrk[0], mrk[1]); w.y = pk2(mrk[2], mrk[3]); *(LAS u32x2*)(Mrk + l15 * 16 + 4 * g) = w;
                if (te == 15) {
#pragma unroll
                    for (int j = 0; j < 16; ++j) PLs[16 * kq + j] = eP[j]; }
            }
            asm volatile("s_waitcnt lgkmcnt(0)" ::: "memory");
            {
                float y[16];
#pragma unroll
                for (int j = 15; j >= 0; --j) {
                    float acc = (j == l15) ? 1.0f : 0.0f;
                    float row[16];
#pragma unroll
                    for (int q = 0; q < 4; ++q) { const f32x4 x = *(const LAS f32x4*)(MabT + j * 16 + 4 * q); row[4 * q] = x.x; row[4 * q + 1] = x.y; row[4 * q + 2] = x.z; row[4 * q + 3] = x.w; }
#pragma unroll
                    for (int i = j + 1; i < 16; ++i) acc += y[i] * row[i];
                    y[j] = acc;
                }
                if (g == 0) { u32x4 t0, t1; t0.x = pk2(y[0], y[1]); t0.y = pk2(y[2], y[3]); t0.z = pk2(y[4], y[5]); t0.w = pk2(y[6], y[7]); t1.x = pk2(y[8], y[9]); t1.y = pk2(y[10], y[11]); t1.z = pk2(y[12], y[13]); t1.w = pk2(y[14], y[15]);
                    *(LAS u32x4*)(Tm + l15 * 16) = t0; *(LAS u32x4*)(Tm + l15 * 16 + 8) = t1; }
            }
            asm volatile("s_waitcnt lgkmcnt(0)" ::: "memory");
            {
                const bool act = g < 2; const int fo = l15 * 16 + 8 * g;
                const bf16x8 fT = act ? *(const LAS bf16x8*)(Tm + fo) : z8, fMak = act ? *(const LAS bf16x8*)(Mak + fo) : z8, fMrb = act ? *(const LAS bf16x8*)(Mrb + fo) : z8, fMrk = act ? *(const LAS bf16x8*)(Mrk + fo) : z8;
                bf16x8 fV[4], fQ1[4], fAh[4], fBT[4], fKT[4];
#pragma unroll
                for (int vt = 0; vt < 4; ++vt) { fV[vt] = act ? *(const LAS bf16x8*)(VTt + vt * 256 + fo) : z8; fBT[vt] = act ? *(const LAS bf16x8*)(BTt + vt * 256 + fo) : z8; fKT[vt] = act ? *(const LAS bf16x8*)(KTt + vt * 256 + fo) : z8; }
#pragma unroll
                for (int vt = 0; vt < 4; ++vt) { const f32x4 q0 = __builtin_amdgcn_mfma_f32_16x16x32_bf16(fMak, fV[vt], z4, 0, 0, 0);
                    u32x2 w; w.x = pk2(q0[0], q0[1]); w.y = pk2(q0[2], q0[3]); *(LAS u32x2*)(Q0T + vt * 256 + l15 * 16 + 4 * g) = w; }
#pragma unroll
                for (int kt = 0; kt < 4; ++kt) { const bf16x8 fA = act ? *(const LAS bf16x8*)(ATt + kt * 256 + fo) : z8; const f32x4 ah = __builtin_amdgcn_mfma_f32_16x16x32_bf16(fT, fA, z4, 0, 0, 0);
                    u32x2 w; w.x = pk2(ah[0], ah[1]); w.y = pk2(ah[2], ah[3]); *(LAS u32x2*)(ATt + kt * 256 + l15 * 16 + 4 * g) = w; }
                asm volatile("s_waitcnt lgkmcnt(0)" ::: "memory");
#pragma unroll
                for (int vt = 0; vt < 4; ++vt) { const bf16x8 fQ0 = act ? *(const LAS bf16x8*)(Q0T + vt * 256 + fo) : z8; const f32x4 q1 = __builtin_amdgcn_mfma_f32_16x16x32_bf16(fT, fQ0, z4, 0, 0, 0);
                    u32x2 w; w.x = pk2(q1[0], q1[1]); w.y = pk2(q1[2], q1[3]); *(LAS u32x2*)(Q0T + vt * 256 + l15 * 16 + 4 * g) = w; }
                asm volatile("s_waitcnt lgkmcnt(0)" ::: "memory");
#pragma unroll
                for (int vt = 0; vt < 4; ++vt) { fQ1[vt] = act ? *(const LAS bf16x8*)(Q0T + vt * 256 + fo) : z8; fAh[vt] = act ? *(const LAS bf16x8*)(ATt + vt * 256 + fo) : z8; }
                bf16* rp = (bf16*)(ws + WS_RP) + (size_t)un * 1024 + l15 * 64;
#pragma unroll
                for (int kt = 0; kt < 4; ++kt) {
                    const u32x2 rr = *(const LAS u32x2*)(Rrm + l15 * 64 + 8 * ((2 * kt + (g >> 1)) ^ (l15 & 7)) + 4 * (g & 1));
                    f32x4 ini; ini[0] = bflo(rr.x); ini[1] = bfhi(rr.x); ini[2] = bflo(rr.y); ini[3] = bfhi(rr.y);
                    const f32x4 rh = __builtin_amdgcn_mfma_f32_16x16x32_bf16(fAh[kt], fMrb, ini, 0, 0, 0);
                    u32x2 w; w.x = pk2(rh[0], rh[1]); w.y = pk2(rh[2], rh[3]); *(u32x2*)(rp + 32 * (kt >> 1) + 8 * g + 4 * (kt & 1)) = w;
                }
#pragma unroll
                for (int vt = 0; vt < 4; ++vt) { f32x4 y1 = __builtin_amdgcn_mfma_f32_16x16x32_bf16(fMrb, fQ1[vt], z4, 0, 0, 0); y1 = __builtin_amdgcn_mfma_f32_16x16x32_bf16(fMrk, fV[vt], y1, 0, 0, 0);
                    *(f32x4*)((float*)(ws + WS_Y1F) + ((size_t)(un * 4 + vt) * 64 + lane) * 4) = y1; }
                bf16* gp = (bf16*)(ws + WS_GP) + (size_t)un * 4096;
#pragma unroll
                for (int krt = 0; krt < 4; ++krt) { const float pl = PLs[16 * krt + l15];
#pragma unroll
                    for (int kct = 0; kct < 4; ++kct) { f32x4 ga = __builtin_amdgcn_mfma_f32_16x16x32_bf16(fAh[kct], fBT[krt], z4, 0, 0, 0);
                        if (kct == krt) {
#pragma unroll
                            for (int e = 0; e < 4; ++e) if (4 * g + e == l15) ga[e] += 1.0f; }
                        u32x2 w; w.x = pk2(ga[0] * pl, ga[1] * pl); w.y = pk2(ga[2] * pl, ga[3] * pl);
                        *(u32x2*)(gp + (16 * krt + l15) * 64 + 32 * (kct >> 1) + 8 * g + 4 * (kct & 1)) = w; } }
#pragma unroll
                for (int mt = 0; mt < 4; ++mt) { const f32x4 pl4 = *(const LAS f32x4*)(PLs + 16 * mt + 4 * g);
#pragma unroll
                    for (int vt = 0; vt < 4; ++vt) { f32x4 ha = __builtin_amdgcn_mfma_f32_16x16x32_bf16(fBT[mt], fQ1[vt], z4, 0, 0, 0); ha = __builtin_amdgcn_mfma_f32_16x16x32_bf16(fKT[mt], fV[vt], ha, 0, 0, 0);
                        u32x2 w; w.x = pk2(ha[0] * pl4[0], ha[1] * pl4[1]); w.y = pk2(ha[2] * pl4[2], ha[3] * pl4[3]);
                        *(u32x2*)((bf16*)(ws + WS_HF) + ((size_t)((un * 4 + vt) * 4 + mt) * 64 + lane) * 4) = w; } }
            }
            asm volatile("s_waitcnt lgkmcnt(0)" ::: "memory");
        }
    }
    SEAM(4);

#define RW_ZB(zz, zb) do { _Pragma("unroll") for (int ks_ = 0; ks_ < 2; ++ks_) { u32x4 p_; p_.x = pk2(zz[2 * ks_][0], zz[2 * ks_][1]); p_.y = pk2(zz[2 * ks_][2], zz[2 * ks_][3]); \
        p_.z = pk2(zz[2 * ks_ + 1][0], zz[2 * ks_ + 1][1]); p_.w = pk2(zz[2 * ks_ + 1][2], zz[2 * ks_ + 1][3]); zb[ks_] = __builtin_bit_cast(bf16x8, p_); } } while (0)
    if (IN(5)) { PHASE_IDS;
        const int l15 = lane & 15, g = lane >> 4;
        for (int u2 = gw; u2 < 2 * NB * NH * (SEQ / 64); u2 += NGW) {
            const int u64 = u2 >> 1, part = u2 & 1;
            f32x4 z[4][4];
#pragma unroll
            for (int sl = 0; sl < 4; ++sl)
#pragma unroll
                for (int mt = 0; mt < 4; ++mt)
#pragma unroll
                    for (int e = 0; e < 4; ++e) z[sl][mt][e] = (part == 0 && sl == mt && 4 * g + e == l15) ? 1.0f : 0.0f;
#pragma unroll 1
            for (int j = 0; j < 4; ++j) {
                const size_t un = (size_t)u64 * 4 + j;
                const bf16* gp = (const bf16*)(ws + WS_GP) + un * 4096 + l15 * 64 + 8 * g;
                bf16x8 gf[4][2];
#pragma unroll
                for (int mt = 0; mt < 4; ++mt) { gf[mt][0] = *(const bf16x8*)(gp + mt * 1024); gf[mt][1] = *(const bf16x8*)(gp + mt * 1024 + 32); }
#pragma unroll
                for (int sl = 0; sl < 4; ++sl) {
                    bf16x8 zb[2]; RW_ZB(z[sl], zb);
#pragma unroll
                    for (int mt = 0; mt < 4; ++mt) {
                        f32x4 a = (f32x4){0.f, 0.f, 0.f, 0.f};
                        if (part) { const u32x2 hh = *(const u32x2*)((const bf16*)(ws + WS_HF) + ((size_t)((un * 4 + sl) * 4 + mt) * 64 + lane) * 4); a[0] = bflo(hh.x); a[1] = bfhi(hh.x); a[2] = bflo(hh.y); a[3] = bfhi(hh.y); }
                        a = __builtin_amdgcn_mfma_f32_16x16x32_bf16(gf[mt][0], zb[0], a, 0, 0, 0); a = __builtin_amdgcn_mfma_f32_16x16x32_bf16(gf[mt][1], zb[1], a, 0, 0, 0);
                        z[sl][mt] = a;
                    }
                }
            }
            if (part == 0) {
                bf16* gc = (bf16*)(ws + WS_GC) + (size_t)u64 * 4096;
#pragma unroll
                for (int sl = 0; sl < 4; ++sl) { const int pc = 32 * (sl >> 1) + 8 * (l15 >> 2) + 4 * (sl & 1) + (l15 & 3);
#pragma unroll
                    for (int mt = 0; mt < 4; ++mt)
#pragma unroll
                        for (int e = 0; e < 4; ++e) gc[(16 * mt + 4 * g + e) * 64 + pc] = (bf16)f2bf(z[sl][mt][e]); }
            } else {
#pragma unroll
                for (int sl = 0; sl < 4; ++sl)
#pragma unroll
                    for (int mt = 0; mt < 4; ++mt) { u32x2 w; w.x = pk2(z[sl][mt][0], z[sl][mt][1]); w.y = pk2(z[sl][mt][2], z[sl][mt][3]);
                        *(u32x2*)((bf16*)(ws + WS_HC) + ((size_t)((u64 * 4 + sl) * 4 + mt) * 64 + lane) * 4) = w; }
            }
        }
        for (int lu = gw; lu < NB * 8 * 64; lu += NGW) {
            const int bc = lu >> 6, seg = lu & 63, b = bc >> 3, cg = bc & 7, ch = cg * 64 + lane;
            const size_t mb = (size_t)b * SEQ + seg * 64;
            float A = 1.f, B = 0.f;
#pragma unroll 16
            for (int t = 0; t < 64; ++t) { const float a = LA[(mb + t) * 512 + ch], bt = LB[(mb + t) * 512 + ch]; B = a * B + bt; A *= a; }
            f32x2 ab; ab.x = A; ab.y = B; *(f32x2*)((float*)(ws + WS_AP) + ((size_t)lu * 64 + lane) * 2) = ab;
        }
    }
    SEAM(5);

    if (IN(6)) { PHASE_IDS;
        if (!(bid < 128 && wave == 0)) {
            const int wi = bid < 128 ? bid * 7 + (wave - 1) : 896 + (bid - 128) * 8 + wave, NW = 896 + (G - 128) * 8;
            for (int lu = wi; lu < NB * 8 * 64; lu += NW) {
                const int bc = lu >> 6, seg = lu & 63, b = bc >> 3, cg = bc & 7, ch = cg * 64 + lane;
                const size_t mb = (size_t)b * SEQ + seg * 64;
                float hst = 0.f;
                const f32x2* ag = (const f32x2*)((const float*)(ws + WS_AP)) + (size_t)(bc * 64) * 64 + lane;
#pragma unroll 8
                for (int sg = 0; sg < seg; ++sg) { const f32x2 ab = ag[(size_t)sg * 64]; hst = ab.x * hst + ab.y; }
#pragma unroll 16
                for (int t = 0; t < 64; ++t) { const float a = LA[(mb + t) * 512 + ch], bt = LB[(mb + t) * 512 + ch]; hst = a * hst + bt;
                    const float gl = bf2f(U[(mb + t) * INW + 512 + ch]); CAT[(mb + t) * 1024 + ch] = (bf16)f2bf(hst * gelu_tanh_f(gl)); }
            }
            LAS float* scr = (LAS float*)(lds + wave * 16384);
            constexpr int I_GU = 16 * 64, I_DN = 16 * 32;
            for (int it = wi; it < NE * (I_GU + I_DN); it += NW) {
                int r = it;
                if (r < NE * I_GU) { const int e = r / I_GU, q = r % I_GU, kb = q / 64, nb = q % 64; const int n0 = 32 * nb;
                    const int drow = n0 < 1024 ? (256 * (n0 >> 7) + (n0 & 127)) : (256 * ((n0 - 1024) >> 7) + 128 + ((n0 - 1024) & 127));
                    transpose_item(args.in[I_WGU] + (size_t)e * D * 2048, 2048, D, Wgu_t + (size_t)e * 2048 * D, 64 * kb, n0, drow, scr, lane); continue; } r -= NE * I_GU;
                { const int e = r / I_DN, q = r % I_DN, kb = q / 32, nb = q % 32;
                  transpose_item(args.in[I_WDN] + (size_t)e * DFF * D, D, DFF, Wdn_t + (size_t)e * D * DFF, 64 * kb, 32 * nb, 32 * nb, scr, lane); }
            }
        } else {
            const int l15 = lane & 15, g = lane >> 4, bh = bid >> 2, vs = bid & 3;
            f32x4 z[4];
#pragma unroll
            for (int mt = 0; mt < 4; ++mt) z[mt] = (f32x4){0.f, 0.f, 0.f, 0.f};
            bf16x8 gA[4][2], gB[4][2], gC[4][2], gD[4][2]; u32x2 hA[4], hB[4], hC[4], hD[4];
#define SC_LOAD(gf, hf, C) do { const size_t u64_ = (size_t)bh * 64 + (C); const bf16* gp_ = (const bf16*)(ws + WS_GC) + u64_ * 4096 + l15 * 64 + 8 * g; \
                _Pragma("unroll") for (int mt = 0; mt < 4; ++mt) { gf[mt][0] = *(const bf16x8*)(gp_ + mt * 1024); gf[mt][1] = *(const bf16x8*)(gp_ + mt * 1024 + 32); \
                    hf[mt] = *(const u32x2*)((const bf16*)(ws + WS_HC) + ((size_t)((u64_ * 4 + vs) * 4 + mt) * 64 + lane) * 4); } } while (0)
#define SC_STEP(gf, hf, C) do { const size_t u64_ = (size_t)bh * 64 + (C); float* zs_ = (float*)(ws + WS_ZS) + ((size_t)((u64_ * 4 + vs) * 4) * 64 + lane) * 4; \
                _Pragma("unroll") for (int mt = 0; mt < 4; ++mt) *(f32x4*)(zs_ + mt * 256) = z[mt]; \
                bf16x8 zb[2]; RW_ZB(z, zb); \
                _Pragma("unroll") for (int mt = 0; mt < 4; ++mt) { f32x4 a; a[0] = bflo(hf[mt].x); a[1] = bfhi(hf[mt].x); a[2] = bflo(hf[mt].y); a[3] = bfhi(hf[mt].y); \
                    a = __builtin_amdgcn_mfma_f32_16x16x32_bf16(gf[mt][0], zb[0], a, 0, 0, 0); a = __builtin_amdgcn_mfma_f32_16x16x32_bf16(gf[mt][1], zb[1], a, 0, 0, 0); z[mt] = a; } } while (0)
            SC_LOAD(gA, hA, 0); SC_LOAD(gB, hB, 1); SC_LOAD(gC, hC, 2);
#pragma unroll 1
            for (int C = 0; C < 64; C += 4) {
                SC_LOAD(gD, hD, C + 3);
                SC_STEP(gA, hA, C);
                if (C + 4 < 64) SC_LOAD(gA, hA, C + 4);
                SC_STEP(gB, hB, C + 1);
                if (C + 5 < 64) SC_LOAD(gB, hB, C + 5);
                SC_STEP(gC, hC, C + 2);
                if (C + 6 < 64) SC_LOAD(gC, hC, C + 6);
                SC_STEP(gD, hD, C + 3);
            }
#undef SC_LOAD
#undef SC_STEP
        }
    }
    SEAM(6);

    if (IN(7)) { PHASE_IDS;
        const int l15 = lane & 15, g = lane >> 4;
        for (int u64 = gw; u64 < NB * NH * (SEQ / 64); u64 += NGW) {
            const int bh = u64 >> 6, C = u64 & 63, b = bh >> 3, h = bh & 7;
            f32x4 z[4][4];
#pragma unroll
            for (int sl = 0; sl < 4; ++sl)
#pragma unroll
                for (int mt = 0; mt < 4; ++mt) z[sl][mt] = *(const f32x4*)((const float*)(ws + WS_ZS) + ((size_t)((u64 * 4 + sl) * 4 + mt) * 64 + lane) * 4);
            float lg4[4];
#pragma unroll
            for (int sl = 0; sl < 4; ++sl) lg4[sl] = args.in[I_LNG][h * 64 + 16 * sl + l15];
#pragma unroll 1
            for (int j = 0; j < 4; ++j) {
                const size_t un = (size_t)u64 * 4 + j; const size_t m0 = (size_t)b * SEQ + (C * 4 + j) * 16;
                const bf16* rp = (const bf16*)(ws + WS_RP) + un * 1024 + l15 * 64 + 8 * g;
                const bf16x8 rf0 = *(const bf16x8*)rp, rf1 = *(const bf16x8*)(rp + 32);
                f32x4 y[4];
#pragma unroll
                for (int sl = 0; sl < 4; ++sl) { bf16x8 zb[2]; RW_ZB(z[sl], zb);
                    f32x4 a = *(const f32x4*)((const float*)(ws + WS_Y1F) + ((size_t)(un * 4 + sl) * 64 + lane) * 4);
                    a = __builtin_amdgcn_mfma_f32_16x16x32_bf16(rf0, zb[0], a, 0, 0, 0); a = __builtin_amdgcn_mfma_f32_16x16x32_bf16(rf1, zb[1], a, 0, 0, 0); y[sl] = a; }
#pragma unroll
                for (int e = 0; e < 4; ++e) {
                    float s1 = (y[0][e] + y[1][e]) + (y[2][e] + y[3][e]);
                    s1 += __shfl_xor(s1, 1); s1 += __shfl_xor(s1, 2); s1 += __shfl_xor(s1, 4); s1 += __shfl_xor(s1, 8);
                    const float mean = s1 * (1.0f / 64.0f);
                    float d0 = y[0][e] - mean, d1 = y[1][e] - mean, d2 = y[2][e] - mean, d3 = y[3][e] - mean;
                    float s2 = (d0 * d0 + d1 * d1) + (d2 * d2 + d3 * d3);
                    s2 += __shfl_xor(s2, 1); s2 += __shfl_xor(s2, 2); s2 += __shfl_xor(s2, 4); s2 += __shfl_xor(s2, 8);
                    const float rstd = 1.0f / sqrtf(s2 * (1.0f / 64.0f) + GN_EPS);
                    const size_t ro = (m0 + 4 * g + e) * 512 + h * 64 + l15;
                    const float dd[4] = {d0, d1, d2, d3};
#pragma unroll
                    for (int sl = 0; sl < 4; ++sl) { const float gg = bf2f(((const bf16*)(ws + WS_G))[ro + 16 * sl]), ad = ((const float*)(ws + WS_ADD))[ro + 16 * sl];
                        const float o = dd[sl] * rstd * lg4[sl] * gg + ad;
                        CAT[(m0 + 4 * g + e) * 1024 + 512 + h * 64 + 16 * sl + l15] = (bf16)f2bf(o); }
                }
                if (j < 3) {
                    const bf16* gp = (const bf16*)(ws + WS_GP) + un * 4096 + l15 * 64 + 8 * g;
                    bf16x8 gf[4][2];
#pragma unroll
                    for (int mt = 0; mt < 4; ++mt) { gf[mt][0] = *(const bf16x8*)(gp + mt * 1024); gf[mt][1] = *(const bf16x8*)(gp + mt * 1024 + 32); }
#pragma unroll
                    for (int sl = 0; sl < 4; ++sl) { bf16x8 zb[2]; RW_ZB(z[sl], zb);
#pragma unroll
                        for (int mt = 0; mt < 4; ++mt) { const u32x2 hh = *(const u32x2*)((const bf16*)(ws + WS_HF) + ((size_t)((un * 4 + sl) * 4 + mt) * 64 + lane) * 4);
                            f32x4 a; a[0] = bflo(hh.x); a[1] = bfhi(hh.x); a[2] = bflo(hh.y); a[3] = bfhi(hh.y);
                            a = __builtin_amdgcn_mfma_f32_16x16x32_bf16(gf[mt][0], zb[0], a, 0, 0, 0); a = __builtin_amdgcn_mfma_f32_16x16x32_bf16(gf[mt][1], zb[1], a, 0, 0, 0); z[sl][mt] = a; } }
                }
            }
        }
    }
    SEAM(7);
#undef RW_ZB


    if (IN(8)) { PHASE_IDS;
        pg8::DenseSched S; S.o.init_tiles(M / 256, D / 256, G, bid); S.A = (const char*)CAT; S.B = (const char*)Wout_t; S.tstep = (size_t)256 * D * 2;
        EpiF32Res E{args.in[I_X], X1, D}; pg8::gemm_phase(lds, D, S, E);
    }
    SEAM(8);
    if (IN(9)) { PHASE_IDS; for (int m = gw; m < M; m += NGW) rms_row_to_bf16(X1 + (size_t)m * D, args.in[I_NXAG], HN + (size_t)m * D, lane); }
    SEAM(9);
    if (IN(10)) { PHASE_IDS;
        pg8::DenseSched S; S.o.init_tiles(M / 256, D / 256, G, bid); S.A = (const char*)HN; S.B = (const char*)Wq_t; S.tstep = (size_t)256 * D * 2;
        EpiBf16Plain E{Qb, D, 0.0625f}; pg8::gemm_phase(lds, D, S, E);
    }
    SEAM(10);
    if (IN(11)) { PHASE_IDS;
        const int l15 = lane & 15, g4 = lane >> 4;
        for (int unit = gw; unit < NB * XH * (SEQ / 16); unit += NGW) {
            const int qt16 = unit % (SEQ / 16), bh = unit / (SEQ / 16), h = bh & 3, b = bh >> 2;
            const bf16* qbase = Qb + (size_t)(b * SEQ + qt16 * 16 + l15) * D + h * XHD + 8 * g4;
            const bf16* kbase = KM + (size_t)(b * MEML + l15) * D + h * XHD + 8 * g4;
            f32x4 sc[16];
#pragma unroll
            for (int kt = 0; kt < 16; ++kt) sc[kt] = (f32x4){0.f, 0.f, 0.f, 0.f};
#pragma unroll 1
            for (int ks = 0; ks < 8; ++ks) {
                const bf16x8 q0 = *(const bf16x8*)(qbase + 32 * ks);
                const bf16* kp = kbase + 32 * ks;
#pragma unroll
                for (int kt = 0; kt < 16; ++kt) { const bf16x8 kf = *(const bf16x8*)(kp + (size_t)(16 * kt) * D);
                    sc[kt] = __builtin_amdgcn_mfma_f32_16x16x32_bf16(kf, q0, sc[kt], 0, 0, 0); }
            }
            bf16x8 pf[8];
            {
                float mx = -3.0e38f;
#pragma unroll
                for (int kt = 0; kt < 16; ++kt) mx = fmaxf(mx, fmaxf(fmaxf(sc[kt][0], sc[kt][1]), fmaxf(sc[kt][2], sc[kt][3])));
                mx = fmaxf(mx, __shfl_xor(mx, 16)); mx = fmaxf(mx, __shfl_xor(mx, 32));
                float sum = 0.f;
#pragma unroll
                for (int kt = 0; kt < 16; ++kt) {
#pragma unroll
                    for (int e = 0; e < 4; ++e) { const float p = __expf(sc[kt][e] - mx); sc[kt][e] = p; sum += p; } }
                sum += __shfl_xor(sum, 16); sum += __shfl_xor(sum, 32);
                const float inv = 1.0f / sum;
#pragma unroll
                for (int s2 = 0; s2 < 8; ++s2) { const f32x4 a = sc[2 * s2] * inv, c = sc[2 * s2 + 1] * inv;
                    u32x4 p; p.x = pk2(a[0], a[1]); p.y = pk2(a[2], a[3]); p.z = pk2(c[0], c[1]); p.w = pk2(c[2], c[3]); pf[s2] = __builtin_bit_cast(bf16x8, p); }
            }
            const bf16* vbase = VT + (size_t)(h * XHD + l15) * MROWS + b * MEML + 4 * g4;
            bf16* obase = Ob + (size_t)(b * SEQ + qt16 * 16 + l15) * D + h * XHD + 4 * g4;
#pragma unroll 1
            for (int dt = 0; dt < 16; ++dt) {
                const bf16* vp = vbase + (size_t)(16 * dt) * MROWS;
                f32x4 oc = (f32x4){0.f, 0.f, 0.f, 0.f};
#pragma unroll
                for (int s2 = 0; s2 < 8; ++s2) {
                    const u32x2 v0 = *(const u32x2*)(vp + 32 * s2), v1 = *(const u32x2*)(vp + 32 * s2 + 16);
                    u32x4 vv; vv.x = v0.x; vv.y = v0.y; vv.z = v1.x; vv.w = v1.y; const bf16x8 vf = __builtin_bit_cast(bf16x8, vv);
                    oc = __builtin_amdgcn_mfma_f32_16x16x32_bf16(vf, pf[s2], oc, 0, 0, 0);
                }
                u32x2 w; w.x = pk2(oc[0], oc[1]); w.y = pk2(oc[2], oc[3]);
                *(u32x2*)(obase + 16 * dt) = w;
            }
        }
    }
    SEAM(11);
    if (IN(12)) { PHASE_IDS;
        pg8::DenseSched S; S.o.init_tiles(M / 256, D / 256, G, bid); S.A = (const char*)Ob; S.B = (const char*)Wo_t; S.tstep = (size_t)256 * D * 2;
        EpiF32Res E{X1, X2, D}; pg8::gemm_phase(lds, D, S, E);
    }
    SEAM(12);
    if (IN(13)) { PHASE_IDS;
        LAS float* hs = (LAS float*)(lds + wave * 16384);
        const float* gfn = args.in[I_NFFG]; const float* wr_ = args.in[I_WR]; const float* br = args.in[I_BR];
        const int e = lane & 31, half = lane >> 5;
        for (int grp = gw; grp < M / 4; grp += NGW) {
            const int m0 = grp * 4;
#pragma unroll
            for (int rr = 0; rr < 4; ++rr) {
                const f32x4* xr = (const f32x4*)(X2 + (size_t)(m0 + rr) * D) + lane; const f32x4* gr = (const f32x4*)gfn + lane;
                f32x4 v[4]; float s = 0.f;
#pragma unroll
                for (int j = 0; j < 4; ++j) { v[j] = xr[64 * j]; s += (v[j].x * v[j].x + v[j].y * v[j].y) + (v[j].z * v[j].z + v[j].w * v[j].w); }
                const float rstd = 1.0f / sqrtf(wave_sum(s) * (1.f / D) + EPS);
                u32x2* o8 = (u32x2*)(HN + (size_t)(m0 + rr) * D) + lane;
#pragma unroll
                for (int j = 0; j < 4; ++j) { const f32x4 gg = gr[64 * j]; f32x4 hv = v[j] * rstd * gg; *(LAS f32x4*)(hs + rr * 1024 + 256 * j + 4 * lane) = hv;
                    u32x2 w; w.x = pk2(hv.x, hv.y); w.y = pk2(hv.z, hv.w); o8[64 * j] = w; }
            }
            asm volatile("s_waitcnt lgkmcnt(0)" ::: "memory");
            float lg[4] = {0.f, 0.f, 0.f, 0.f};
#pragma unroll 4
            for (int d = half * 512; d < half * 512 + 512; d += 4) {
                const float w0 = wr_[(d + 0) * 32 + e], w1 = wr_[(d + 1) * 32 + e], w2 = wr_[(d + 2) * 32 + e], w3 = wr_[(d + 3) * 32 + e];
#pragma unroll
                for (int rr = 0; rr < 4; ++rr) { const f32x4 h4 = *(const LAS f32x4*)(hs + rr * 1024 + d); lg[rr] += (h4.x * w0 + h4.y * w1) + (h4.z * w2 + h4.w * w3); }
            }
            const float brv = br[e];
#pragma unroll
            for (int rr = 0; rr < 4; ++rr) {
                float v = lg[rr] + __shfl_xor(lg[rr], 32) + brv;
                float selv[4]; int sele[4];
#pragma unroll
                for (int k = 0; k < 4; ++k) {
                    float mv = v; int mi = e;
#pragma unroll
                    for (int o = 1; o < 32; o <<= 1) { const float ov = __shfl_xor(mv, o); const int oi = __shfl_xor(mi, o); if (ov > mv || (ov == mv && oi < mi)) { mv = ov; mi = oi; } }
                    selv[k] = mv; sele[k] = mi; if (e == mi) v = -3.0e38f;
                }
                const float e1 = __expf(selv[1] - selv[0]), e2 = __expf(selv[2] - selv[0]), e3 = __expf(selv[3] - selv[0]);
                const float inv = 1.0f / (1.0f + e1 + e2 + e3);
                if (lane < 4) {
                    const int me = lane == 0 ? sele[0] : lane == 1 ? sele[1] : lane == 2 ? sele[2] : sele[3];
                    const float mg = (lane == 0 ? 1.0f : lane == 1 ? e1 : lane == 2 ? e2 : e3) * inv;
                    const int pos = (int)atomicAdd(ecnt + me, 1u);
                    const int ai = (m0 + rr) * 4 + lane; route_e[ai] = me; route_pos[ai] = pos; route_g[ai] = mg;
                }
            }
        }
    }
    SEAM(13);
    if (IN(14)) { PHASE_IDS;
        LAS int* pst = (LAS int*)lds;
        if (tid == 0) { int acc = 0; for (int e = 0; e < NE; ++e) { const int c = (int)__hip_atomic_load(ecnt + e, __ATOMIC_RELAXED, __HIP_MEMORY_SCOPE_AGENT); pst[e] = acc; pst[64 + e] = c; acc += (c + 255) & ~255; } pst[32] = acc; }
        __syncthreads();
        for (int t = gw; t < M; t += NGW) {
            int row = 0;
            if (lane < 4) { const int ai = t * 4 + lane; const int e = route_e[ai]; row = pst[e] + route_pos[ai]; row_slot[row] = ai; row_gate[row] = route_g[ai]; }
            const u32x4* src = (const u32x4*)(HN + (size_t)t * D);
            const u32x4 a = src[lane], c = src[64 + lane];
#pragma unroll
            for (int k = 0; k < 4; ++k) { const int rk = __shfl(row, k); u32x4* dst = (u32x4*)(XS + (size_t)rk * D); dst[lane] = a; dst[64 + lane] = c; }
        }
        if (bid < NE) { const int e = bid, c = pst[64 + e], pe = (c + 255) & ~255; for (int p = c + tid; p < pe; p += NTHREADS) { row_slot[pst[e] + p] = -1; row_gate[pst[e] + p] = 0.f; } }
        if (bid == 0 && tid == 0) { int nt = 0; for (int e = 0; e < NE; ++e) { const int n = ((pst[64 + e] + 255) & ~255) >> 8; for (int j = 0; j < n; ++j) tile_tab[16 + nt++] = e; } tile_tab[0] = nt; }
        __syncthreads();
    }
    SEAM(14);
    if (IN(15)) { PHASE_IDS;
        const int ntiles = tile_tab[0];
        pg8::MoeSched S; S.o.init_tiles(ntiles, 2048 / 256, G, bid); S.A = (const char*)XS; S.B = (const char*)Wgu_t; S.tile_e = tile_tab + 16; S.tstep = (size_t)256 * D * 2; S.estep = (size_t)2048 * D * 2;
        EpiSwiglu E{ACT, args.in[I_BGU]}; pg8::gemm_phase(lds, D, S, E);
    }
    SEAM(15);
    if (IN(16)) { PHASE_IDS;
        const int ntiles = tile_tab[0];
        pg8::MoeSched S; S.o.init_tiles(ntiles, D / 256, G, bid); S.A = (const char*)ACT; S.B = (const char*)Wdn_t; S.tile_e = tile_tab + 16; S.tstep = (size_t)256 * DFF * 2; S.estep = (size_t)D * DFF * 2;
        EpiDown E{YS, args.in[I_BDN], row_slot, row_gate}; pg8::gemm_phase(lds, DFF, S, E);
    }
    SEAM(16);
    if (IN(17)) { PHASE_IDS;
        const f32x4* gr = (const f32x4*)args.in[I_FNG] + lane;
        for (int m = gw; m < M; m += NGW) {
            const f32x4* xr = (const f32x4*)(X2 + (size_t)m * D) + lane;
            f32x4 v[4]; float s = 0.f;
#pragma unroll
            for (int j = 0; j < 4; ++j) { v[j] = xr[64 * j];
#pragma unroll
                for (int k = 0; k < 4; ++k) { const u32x2 y = *((const u32x2*)(YS + (size_t)(m * 4 + k) * D) + 64 * j + lane); v[j].x += bflo(y.x); v[j].y += bfhi(y.x); v[j].z += bflo(y.y); v[j].w += bfhi(y.y); }
                s += (v[j].x * v[j].x + v[j].y * v[j].y) + (v[j].z * v[j].z + v[j].w * v[j].w); }
            const float rstd = 1.0f / sqrtf(wave_sum(s) * (1.f / D) + EPS);
            f32x4* o = (f32x4*)(args.out + (size_t)m * D) + lane;
#pragma unroll
            for (int j = 0; j < 4; ++j) o[64 * j] = v[j] * rstd * gr[64 * j];
        }
    }
#undef IN
#undef SEAM
}

constexpr int N_PHASES = 18;
extern "C" void kernel_launch(void* const* d_in, const int* in_sizes, int n_in, void* d_out, int out_size, void* d_ws, size_t ws_size, hipStream_t stream) {
    static int grid = 0;
    if (grid == 0) {
        if (n_in != 37 || out_size != M * D || ws_size < WS_END) { fprintf(stderr, "kernel_launch: unexpected shapes (n_in %d, out %d, ws %zu); nothing launched\n", n_in, out_size, ws_size); grid = -1; return; }
        int dev = 0, cus = 0, per_cu = 0;
        if (hipGetDevice(&dev) != hipSuccess || hipDeviceGetAttribute(&cus, hipDeviceAttributeMultiprocessorCount, dev) != hipSuccess) { grid = -1; return; }
        if (hipFuncSetAttribute((const void*)fwd, hipFuncAttributeMaxDynamicSharedMemorySize, LDS_BYTES) != hipSuccess) { fprintf(stderr, "kernel_launch: hipFuncSetAttribute failed\n"); grid = -1; return; }
        if (hipOccupancyMaxActiveBlocksPerMultiprocessor(&per_cu, (const void*)fwd, NTHREADS, LDS_BYTES) != hipSuccess || per_cu < 1) fprintf(stderr, "kernel_launch: occupancy query says %d\n", per_cu);
        (void)hipGetLastError();
        grid = cus > 256 ? 256 : cus;
    }
    if (grid < 0) return;
    if (hipMemsetAsync((char*)d_ws + WS_CTL, 0, CTL_ZERO_BYTES, stream) != hipSuccess) return;
    Args a{};
    for (int i = 0; i < 37; ++i) a.in[i] = (const float*)d_in[i];
    a.out = (float*)d_out; a.ws = (unsigned char*)d_ws;
#if MK_ONE_LAUNCH
    a.ph_lo = 0; a.ph_hi = N_PHASES;
    hipLaunchKernelGGL(fwd, dim3(grid), dim3(NTHREADS), LDS_BYTES, stream, a);
#else
    for (int p = 0; p < N_PHASES; ++p) { a.ph_lo = p; a.ph_hi = p + 1; hipLaunchKernelGGL(fwd, dim3(grid), dim3(NTHREADS), LDS_BYTES, stream, a);
#ifdef PROBE_REPEAT_PHASE
        if (p == PROBE_REPEAT_PHASE) hipLaunchKernelGGL(fwd, dim3(grid), dim3(NTHREADS), LDS_BYTES, stream, a);
#endif
    }
#endif
}
```

```cpp
#include <hip/hip_runtime.h>
#include <cstdio>
#include <cstdint>

#ifndef MK_ONE_LAUNCH
#define MK_ONE_LAUNCH 1
#endif

#define DI __device__ __forceinline__
#define GAS __attribute__((address_space(1)))
#define LAS __attribute__((address_space(3)))
typedef unsigned short bf16;
typedef short bf16x8 __attribute__((ext_vector_type(8)));
typedef float f32x4 __attribute__((ext_vector_type(4)));
typedef float f32x2 __attribute__((ext_vector_type(2)));
typedef unsigned u32x4 __attribute__((ext_vector_type(4)));
typedef unsigned u32x2 __attribute__((ext_vector_type(2)));

constexpr int D = 1024, NB = 4, SEQ = 4096, M = NB * SEQ;
constexpr int MEML = 256, MROWS = NB * MEML;
constexpr int LRU_W = 512, RW = 512, NH = 8, HD = 64;
constexpr int INW = 2816;
constexpr int XH = 4, XHD = 256;
constexpr int NE = 32, TOPK = 4, DFF = 1024;
constexpr int NASSIGN = M * TOPK;
constexpr int MAXTILES = 288, MAXROWS = MAXTILES * 256;
constexpr float EPS = 1e-6f, GN_EPS = 64e-5f;

namespace pg8 {
constexpr int BM = 256, BK = 64, HALF = 128, HTB = HALF * BK * 2, STAGE_BYTES = 8 * HTB, NXCD = 8, WGM = 8;
__host__ __device__ __forceinline__ int lds_byte(int r, int c) { const int st = (r >> 4) * 2 + (c >> 5), rr = r & 15, cc = c & 31, ob = rr * 64 + cc * 2; return st * 1024 + (ob ^ (((ob >> 9) & 1) << 5)); }
__host__ __device__ __forceinline__ void stage_rc(int b, int& R, int& C) { const int st = b / 1024, sb = b % 1024, swz = sb ^ (((sb >> 9) & 1) << 5); R = (st >> 1) * 16 + swz / 64; C = (st & 1) * 32 + (swz % 64) / 2; }
__host__ __device__ __forceinline__ int perm32(int rho) { const int n = rho >> 4, i = rho & 15; return 8 * (i >> 2) + 4 * n + (i & 3); }

struct Unit { int pm, pn, e; };

struct StaticOrder {
    int nM, nN, nwg, G, c;
    __host__ __device__ void init_tiles(int nM_, int nN_, int G_, int c_) { nM = nM_; nN = nN_; nwg = nM * nN; G = G_; c = c_; }
    __host__ __device__ bool next(int i, Unit& u) const {
        const long L = (long)i * G + c; if (L >= nwg) return false;
        int wgid = (int)L; { const int q = nwg / NXCD, r = nwg % NXCD, xcd = wgid % NXCD, off = wgid / NXCD; wgid = (xcd < r ? xcd * (q + 1) : r * (q + 1) + (xcd - r) * q) + off; }
        const int nig = WGM * nN, gid = wgid / nig, fm = gid * WGM, gsz = (nM - fm) < WGM ? (nM - fm) : WGM;
        u.pm = fm + ((wgid % nig) % gsz); u.pn = (wgid % nig) / gsz; u.e = 0; return true;
    }
};
struct DenseSched {
    static constexpr bool GATHER = false;
    StaticOrder o; const char* A; const char* B; size_t tstep;
    DI bool next(int i, Unit& u) const { return o.next(i, u); }
    DI const char* a_ptr(const Unit& u) const { return A + (size_t)u.pm * tstep; }
    DI const char* b_ptr(const Unit& u) const { return B + (size_t)u.pn * tstep; }
    DI void a_voff(const Unit&, int K, const int (&R)[2], const int (&C)[2], unsigned (&vo)[2][2]) const {
#pragma unroll
        for (int h = 0; h < 2; ++h)
#pragma unroll
            for (int i = 0; i < 2; ++i) vo[h][i] = (unsigned)((h * HALF + R[i]) * K + C[i]) * 2u; }
};
struct MoeSched {
    static constexpr bool GATHER = false;
    StaticOrder o; const char* A; const char* B; const int* tile_e; size_t tstep, estep;
    DI bool next(int i, Unit& u) const { if (!o.next(i, u)) return false; u.e = tile_e[u.pm]; return true; }
    DI const char* a_ptr(const Unit& u) const { return A + (size_t)u.pm * tstep; }
    DI const char* b_ptr(const Unit& u) const { return B + (size_t)u.e * estep + (size_t)u.pn * tstep; }
    DI void a_voff(const Unit&, int K, const int (&R)[2], const int (&C)[2], unsigned (&vo)[2][2]) const {
#pragma unroll
        for (int h = 0; h < 2; ++h)
#pragma unroll
            for (int i = 0; i < 2; ++i) vo[h][i] = (unsigned)((h * HALF + R[i]) * K + C[i]) * 2u; }
};
struct MoeGatherSched {
    static constexpr bool GATHER = true;
    StaticOrder o; const char* A; const char* B; const int* tile_e; const int* rtok; size_t tstep, estep;
    DI bool next(int i, Unit& u) const { if (!o.next(i, u)) return false; u.e = tile_e[u.pm]; return true; }
    DI const char* a_ptr(const Unit&) const { return A; }
    DI const char* b_ptr(const Unit& u) const { return B + (size_t)u.e * estep + (size_t)u.pn * tstep; }
    DI void a_voff(const Unit& u, int K, const int (&R)[2], const int (&C)[2], unsigned (&vo)[2][2]) const {
#pragma unroll
        for (int h = 0; h < 2; ++h)
#pragma unroll
            for (int i = 0; i < 2; ++i) vo[h][i] = (unsigned)(rtok[u.pm * BM + h * HALF + R[i]] * K + C[i]) * 2u; }
};

DI unsigned cvt_pk_bf16(float lo, float hi) { unsigned r; asm volatile("v_cvt_pk_bf16_f32 %0, %1, %2" : "=v"(r) : "v"(lo), "v"(hi)); return r; }

template <class Epi, class Sched, bool ALIGN_EPI = true>
DI void gemm_phase(LAS unsigned char* lds, const int K, const Sched& S, const Epi& E) {
    const int tid = threadIdx.x, wid = __builtin_amdgcn_readfirstlane(tid >> 6), lane = tid & 63, wr = wid >> 2, wc = wid & 3, fr = lane & 15, fq = lane >> 4;
    const int nt = K / BK;
    constexpr bool GA = Sched::GATHER;
    unsigned voffA[2][2], voffAn[2][2], voffB[2]; int sR[2], sC[2];
#pragma unroll
    for (int i = 0; i < 2; ++i) { int R, C; stage_rc(tid * 16 + i * 8192, R, C); const int Rb = Epi::PERM ? ((R & ~31) + perm32(R & 31)) : R;
        sR[i] = R; sC[i] = C; voffB[i] = (unsigned)(Rb * K + C) * 2u; }
    const size_t kstep = (size_t)(BK * 2);
    const size_t hstep = (size_t)HALF * K * 2;
    const unsigned ldsw = (unsigned)wid * 1024u;
    const int aoff = lds_byte(wr * 64 + fr, fq * 8), boff = lds_byte(wc * 32 + fr, fq * 8);
#define PG8_SA(b, h) (((b) * 2 + (h)) * HTB)
#define PG8_SB(b, h) ((4 + (b) * 2 + (h)) * HTB)
#define PG8_STAGE(bufoff, gbase, voff) do { _Pragma("unroll") for (int _i = 0; _i < 2; ++_i) \
        __builtin_amdgcn_global_load_lds((const unsigned*)((const char*)(gbase) + (voff)[_i]), (LAS unsigned*)(lds + (bufoff) + ldsw + _i * 8192), 16, 0, 0); } while (0)
#define PG8_LDA(dst, b, h) do { _Pragma("unroll") for (int m = 0; m < 4; ++m) _Pragma("unroll") for (int k = 0; k < 2; ++k) dst[m][k] = *(const LAS bf16x8*)(lds + PG8_SA(b, h) + aoff + m * 2048 + k * 1024); } while (0)
#define PG8_LDB(dst, b, h) do { _Pragma("unroll") for (int n = 0; n < 2; ++n) _Pragma("unroll") for (int k = 0; k < 2; ++k) dst[n][k] = *(const LAS bf16x8*)(lds + PG8_SB(b, h) + boff + n * 2048 + k * 1024); } while (0)
#define PG8_MMA(ai, bj, At, Bt) do { __builtin_amdgcn_s_setprio(1); _Pragma("unroll") for (int m = 0; m < 4; ++m) _Pragma("unroll") for (int n = 0; n < 2; ++n) _Pragma("unroll") for (int k = 0; k < 2; ++k) \
        acc[ai][bj][m][n] = __builtin_amdgcn_mfma_f32_16x16x32_bf16(Bt[n][k], At[m][k], acc[ai][bj][m][n], 0, 0, 0); __builtin_amdgcn_s_setprio(0); } while (0)
#define PG8_WAIT_V(n) asm volatile("s_waitcnt vmcnt(" #n ")" ::: "memory")
#define PG8_WAIT_L(n) asm volatile("s_waitcnt lgkmcnt(" #n ")" ::: "memory")
#define PG8_BAR __builtin_amdgcn_s_barrier()
#define PG8_SCHED __builtin_amdgcn_sched_barrier(0)
    Unit cur, nxt; int ui = 0;
    if (!S.next(0, cur)) return;
    f32x4 acc[2][2][4][2];
#pragma unroll
    for (int a = 0; a < 2; ++a)
#pragma unroll
        for (int b = 0; b < 2; ++b)
#pragma unroll
            for (int m = 0; m < 4; ++m)
#pragma unroll
                for (int n = 0; n < 2; ++n) acc[a][b][m][n] = (f32x4){0.f, 0.f, 0.f, 0.f};
    bf16x8 At[4][2], B0[2][2], B1[2][2];
    const char* cA = S.a_ptr(cur); const char* cB = S.b_ptr(cur);
    S.a_voff(cur, K, sR, sC, voffA);
#define PG8_STAGE_A(bufoff, kbase, h, vo) do { if constexpr (GA) { PG8_STAGE(bufoff, kbase, (vo)[h]); } else { PG8_STAGE(bufoff, (kbase) + (h) * hstep, voffA[0]); } } while (0)
    PG8_STAGE(PG8_SB(0, 0), cB, voffB); PG8_STAGE(PG8_SB(0, 1), cB + hstep, voffB); PG8_STAGE_A(PG8_SA(0, 0), cA, 0, voffA); PG8_STAGE_A(PG8_SA(0, 1), cA, 1, voffA);
    if (wr == 1) PG8_BAR;
    PG8_WAIT_V(2); PG8_BAR;
    PG8_STAGE(PG8_SB(1, 0), cB + kstep, voffB); PG8_STAGE_A(PG8_SA(1, 0), cA + kstep, 0, voffA); PG8_STAGE(PG8_SB(1, 1), cB + hstep + kstep, voffB);
    PG8_WAIT_V(6); PG8_BAR;
    for (;;) {
        const bool has_next = S.next(ui + 1, nxt);
        const char* nA = has_next ? S.a_ptr(nxt) : cA; const char* nB = has_next ? S.b_ptr(nxt) : cB;
        if constexpr (GA) { if (has_next) S.a_voff(nxt, K, sR, sC, voffAn);
            else {
#pragma unroll
                for (int h = 0; h < 2; ++h)
#pragma unroll
                    for (int i = 0; i < 2; ++i) voffAn[h][i] = voffA[h][i]; } }
        for (int t = 0; t < nt; t += 2) {
            const bool last = (t == nt - 2);
            const char* a1 = cA + (size_t)(t + 1) * kstep;
            const char* a2 = last ? nA : cA + (size_t)(t + 2) * kstep; const char* b2 = last ? nB : cB + (size_t)(t + 2) * kstep;
            const char* a3 = a2 + kstep; const char* b3 = b2 + kstep;
            unsigned vs[2][2];
            if constexpr (GA) {
#pragma unroll
                for (int i = 0; i < 2; ++i) { vs[0][i] = last ? voffAn[0][i] : voffA[0][i]; vs[1][i] = last ? voffAn[1][i] : voffA[1][i]; } }
            PG8_LDB(B0, 0, 0); PG8_LDB(B1, 0, 1); PG8_SCHED; PG8_LDA(At, 0, 0); PG8_STAGE_A(PG8_SA(1, 1), a1, 1, voffA);
            PG8_WAIT_V(8); PG8_WAIT_L(0); PG8_BAR; PG8_MMA(0, 0, At, B0); PG8_MMA(0, 1, At, B1); PG8_BAR; PG8_SCHED;
            PG8_LDA(At, 0, 1); PG8_STAGE(PG8_SB(0, 0), b2, voffB); PG8_STAGE(PG8_SB(0, 1), b2 + hstep, voffB); PG8_STAGE_A(PG8_SA(0, 0), a2, 0, vs);
            PG8_WAIT_V(8); PG8_WAIT_L(0); PG8_BAR; PG8_MMA(1, 0, At, B0); PG8_MMA(1, 1, At, B1); PG8_BAR; PG8_SCHED;
            PG8_LDB(B0, 1, 0); PG8_LDB(B1, 1, 1); PG8_SCHED; PG8_LDA(At, 1, 0); PG8_STAGE_A(PG8_SA(0, 1), a2, 1, vs);
            PG8_WAIT_V(8); PG8_WAIT_L(0); PG8_BAR; PG8_MMA(0, 0, At, B0); PG8_MMA(0, 1, At, B1); PG8_BAR; PG8_SCHED;
            PG8_LDA(At, 1, 1); PG8_STAGE(PG8_SB(1, 0), b3, voffB); PG8_STAGE(PG8_SB(1, 1), b3 + hstep, voffB); PG8_STAGE_A(PG8_SA(1, 0), a3, 0, vs);
            PG8_WAIT_V(8); PG8_WAIT_L(0); PG8_BAR; PG8_MMA(1, 0, At, B0); PG8_MMA(1, 1, At, B1); PG8_BAR; PG8_SCHED;
        }
        if constexpr (ALIGN_EPI) { if (wr == 0) PG8_BAR; }
        E(acc, cur, wr, wc, fr, fq);
        if (!has_next) break;
#pragma unroll
        for (int a = 0; a < 2; ++a)
#pragma unroll
            for (int b = 0; b < 2; ++b)
#pragma unroll
                for (int m = 0; m < 4; ++m)
#pragma unroll
                    for (int n = 0; n < 2; ++n) acc[a][b][m][n] = (f32x4){0.f, 0.f, 0.f, 0.f};
        cur = nxt; cA = nA; cB = nB; ++ui;
        if constexpr (GA) {
#pragma unroll
            for (int h = 0; h < 2; ++h)
#pragma unroll
                for (int i = 0; i < 2; ++i) voffA[h][i] = voffAn[h][i]; }
        if constexpr (ALIGN_EPI) { if (wr == 1) PG8_BAR; }
    }
    PG8_WAIT_V(0);
    if constexpr (!ALIGN_EPI) { if (wr == 0) PG8_BAR; }
    PG8_BAR;
#undef PG8_SA
#undef PG8_SB
#undef PG8_STAGE
#undef PG8_STAGE_A
#undef PG8_LDA
#undef PG8_LDB
#undef PG8_MMA
#undef PG8_WAIT_V
#undef PG8_WAIT_L
#undef PG8_BAR
#undef PG8_SCHED
}
}
using pg8::Unit;
using pg8::cvt_pk_bf16;

DI float bflo(unsigned w) { return __uint_as_float(w << 16); }
DI float bfhi(unsigned w) { return __uint_as_float(w & 0xffff0000u); }
DI float bf2f(bf16 b) { return __uint_as_float(((unsigned)b) << 16); }
DI unsigned f2bf(float f) { unsigned u = __float_as_uint(f); return (u + 0x7fffu + ((u >> 16) & 1u)) >> 16; }
DI unsigned pk2(float lo, float hi) { return f2bf(lo) | (f2bf(hi) << 16); }
DI float sigmoid_f(float x) { return 1.0f / (1.0f + __expf(-x)); }
DI float softplus_f(float x) { return fmaxf(x, 0.f) + log1pf(__expf(-fabsf(x))); }
DI float softplus_fast(float x) { return fmaxf(x, 0.f) + __logf(1.0f + __expf(-fabsf(x))); }
DI float gelu_tanh_f(float x) { const float u = 0.7978845608028654f * (x + 0.044715f * x * x * x); return 0.5f * x * (1.0f + tanhf(u)); }
DI int fresh_tid() { int t = threadIdx.x; asm volatile("" : "+v"(t)); return t; }
DI float wave_sum(float v) {
#pragma unroll
    for (int o = 1; o < 64; o <<= 1) v += __shfl_xor(v, o);
    return v;
}

struct EpiBf16Plain {
    static constexpr bool PERM = true;
    bf16* O; int ldc; float scale;
    DI void operator()(const f32x4 (&acc)[2][2][4][2], const Unit& u, int wr, int wc, int fr, int fq) const {
        const int row0 = u.pm * 256 + wr * 64 + fr, col0 = u.pn * 256 + wc * 32 + 8 * fq;
#pragma unroll
        for (int ai = 0; ai < 2; ++ai)
#pragma unroll
            for (int m = 0; m < 4; ++m) { bf16* rowp = O + (size_t)(row0 + ai * 128 + m * 16) * ldc + col0;
#pragma unroll
                for (int bj = 0; bj < 2; ++bj) { const f32x4 v0 = acc[ai][bj][m][0] * scale, v1 = acc[ai][bj][m][1] * scale;
                    u32x4 w; w.x = cvt_pk_bf16(v0[0], v0[1]); w.y = cvt_pk_bf16(v0[2], v0[3]); w.z = cvt_pk_bf16(v1[0], v1[1]); w.w = cvt_pk_bf16(v1[2], v1[3]);
                    *(u32x4*)(rowp + bj * 128) = w; } }
    }
};
struct EpiF32Res {
    static constexpr bool PERM = false;
    const float* Rz; float* C; int ldc;
    DI void operator()(const f32x4 (&acc)[2][2][4][2], const Unit& u, int wr, int wc, int fr, int fq) const {
        const int row0 = u.pm * 256 + wr * 64 + fr, col0 = u.pn * 256 + wc * 32 + 4 * fq;
#pragma unroll
        for (int ai = 0; ai < 2; ++ai)
#pragma unroll
            for (int m = 0; m < 4; ++m) { const size_t off = (size_t)(row0 + ai * 128 + m * 16) * ldc + col0;
#pragma unroll
                for (int bj = 0; bj < 2; ++bj)
#pragma unroll
                    for (int n = 0; n < 2; ++n) { const f32x4 r = *(const f32x4*)(Rz + off + bj * 128 + n * 16); *(f32x4*)(C + off + bj * 128 + n * 16) = r + acc[ai][bj][m][n]; } }
    }
};
struct EpiLora {
    static constexpr bool PERM = false;
    float* LWp; bf16* AAp; bf16* GGp; const float* w0; const float* a0;
    DI void operator()(const f32x4 (&acc)[2][2][4][2], const Unit& u, int wr, int wc, int fr, int fq) const {
        const int kind = u.pn >> 1;
        const int row0 = u.pm * 256 + wr * 64 + fr, col0 = (u.pn & 1) * 256 + wc * 32 + 4 * fq;
#pragma unroll
        for (int bj = 0; bj < 2; ++bj)
#pragma unroll
            for (int n = 0; n < 2; ++n) {
                const int c = col0 + bj * 128 + n * 16;
                f32x4 bias = (f32x4){0.f, 0.f, 0.f, 0.f};
                if (kind == 0) bias = *(const f32x4*)(w0 + c); else if (kind == 1) bias = *(const f32x4*)(a0 + c);
#pragma unroll
                for (int ai = 0; ai < 2; ++ai)
#pragma unroll
                    for (int m = 0; m < 4; ++m) {
                        f32x4 v = acc[ai][bj][m][n] + bias;
                        if (kind == 0) {
#pragma unroll
                            for (int j = 0; j < 4; ++j) { const float w = -softplus_fast(-v[j]) - 0.5f; v[j] = -__expf(w);     }
                        } else if (kind == 1) {
#pragma unroll
                            for (int j = 0; j < 4; ++j) v[j] = sigmoid_f(v[j]);
                        }
                        const size_t o_ = (size_t)(row0 + ai * 128 + m * 16) * 512 + c;
                        if (kind == 0) *(f32x4*)(LWp + o_) = v;
                        else { u32x2 w_; w_.x = cvt_pk_bf16(v[0], v[1]); w_.y = cvt_pk_bf16(v[2], v[3]); *(u32x2*)((kind == 1 ? AAp : GGp) + o_) = w_; }
                    }
            }
    }
};
struct EpiSwiglu {
    static constexpr bool PERM = true;
    bf16* ACT; const float* b_gu;
    DI void operator()(const f32x4 (&acc)[2][2][4][2], const Unit& u, int wr, int wc, int fr, int fq) const {
        const int row0 = u.pm * 256 + wr * 64 + fr, j0 = u.pn * 128 + wc * 32 + 8 * fq;
        const float* bg = b_gu + (size_t)u.e * 2048 + j0; const float* bu = bg + 1024;
        const f32x4 bg0 = *(const f32x4*)bg, bg1 = *(const f32x4*)(bg + 4), bu0 = *(const f32x4*)bu, bu1 = *(const f32x4*)(bu + 4);
#pragma unroll
        for (int ai = 0; ai < 2; ++ai)
#pragma unroll
            for (int m = 0; m < 4; ++m) {
                float o[8];
#pragma unroll
                for (int n = 0; n < 2; ++n) { const f32x4 g4 = acc[ai][0][m][n] + (n ? bg1 : bg0), u4 = acc[ai][1][m][n] + (n ? bu1 : bu0);
#pragma unroll
                    for (int j = 0; j < 4; ++j) { const float g = fminf(g4[j], 7.0f), up = fminf(fmaxf(u4[j], -7.0f), 7.0f); o[n * 4 + j] = (up + 1.0f) * (g * sigmoid_f(1.702f * g)); } }
                u32x4 w; w.x = cvt_pk_bf16(o[0], o[1]); w.y = cvt_pk_bf16(o[2], o[3]); w.z = cvt_pk_bf16(o[4], o[5]); w.w = cvt_pk_bf16(o[6], o[7]);
                *(u32x4*)(ACT + (size_t)(row0 + ai * 128 + m * 16) * 1024 + j0) = w;
            }
    }
};
struct EpiDown {
    static constexpr bool PERM = true;
    bf16* YS; const float* b_dn; const int* row_slot; const float* row_gate;
    DI void operator()(const f32x4 (&acc)[2][2][4][2], const Unit& u, int wr, int wc, int fr, int fq) const {
        const int row0 = u.pm * 256 + wr * 64 + fr, col0 = u.pn * 256 + wc * 32 + 8 * fq;
        const float* bb = b_dn + (size_t)u.e * 1024 + col0;
        f32x4 bv[2][2];
#pragma unroll
        for (int bj = 0; bj < 2; ++bj)
#pragma unroll
            for (int n = 0; n < 2; ++n) bv[bj][n] = *(const f32x4*)(bb + bj * 128 + 4 * n);
#pragma unroll
        for (int ai = 0; ai < 2; ++ai)
#pragma unroll
            for (int m = 0; m < 4; ++m) {
                const int r = row0 + ai * 128 + m * 16; const int slot = row_slot[r]; const float gt = row_gate[r];
                if (slot >= 0) { bf16* rowp = YS + (size_t)slot * 1024 + col0;
#pragma unroll
                    for (int bj = 0; bj < 2; ++bj) { const f32x4 v0 = (acc[ai][bj][m][0] + bv[bj][0]) * gt, v1 = (acc[ai][bj][m][1] + bv[bj][1]) * gt;
                        u32x4 w; w.x = cvt_pk_bf16(v0[0], v0[1]); w.y = cvt_pk_bf16(v0[2], v0[3]); w.z = cvt_pk_bf16(v1[0], v1[1]); w.w = cvt_pk_bf16(v1[2], v1[3]);
                        *(u32x4*)(rowp + bj * 128) = w; } }
            }
    }
};

constexpr size_t MiB = 1u << 20;
constexpr size_t WS_CTL = 0, CTL_ZERO_BYTES = 1 * MiB;
constexpr size_t WS_WIN = 1 * MiB, WS_WOUT = 7 * MiB, WS_WQ = 9 * MiB, WS_WK = 11 * MiB, WS_WV = 13 * MiB, WS_WO = 15 * MiB, WS_LORAB = 17 * MiB, WS_LRUW = 18 * MiB;
constexpr size_t WS_ROUTE = 19 * MiB;
constexpr size_t WS_WGU = 22 * MiB, WS_WDN = 150 * MiB;
constexpr size_t WS_HN = 214 * MiB, WS_MEMN = 246 * MiB, WS_KM = 248 * MiB, WS_VT = 250 * MiB;
constexpr size_t WS_X1 = 252 * MiB, WS_X2 = 316 * MiB;
constexpr size_t WS_U = 380 * MiB, WS_R = 468 * MiB, WS_KRAW = 500 * MiB, WS_V = 532 * MiB, WS_KKN = 564 * MiB, WS_WD = 596 * MiB, WS_AA = 628 * MiB, WS_G = 660 * MiB;
constexpr size_t WS_LA = 692 * MiB, WS_LB = 724 * MiB, WS_AP = 756 * MiB, WS_CAT = 764 * MiB, WS_Q = 796 * MiB;
constexpr size_t WS_XS = 380 * MiB, WS_ACT = 524 * MiB, WS_YS = 668 * MiB;
constexpr size_t WS_GP = 796 * MiB, WS_HF = 860 * MiB, WS_RP = 924 * MiB, WS_Y1F = 940 * MiB, WS_ADD = 972 * MiB, WS_END = 1004 * MiB;
constexpr size_t WS_GC = 468 * MiB, WS_HC = 484 * MiB, WS_ZS = 500 * MiB;
static_assert(WS_AA == WS_WD + 32 * MiB && WS_G == WS_AA + 32 * MiB, "EpiLora strides");
static_assert(WS_U + (size_t)M * INW * 2 <= WS_R && WS_XS + (size_t)MAXROWS * 2048 <= WS_ACT && WS_ACT + (size_t)MAXROWS * 2048 <= WS_YS && WS_YS + (size_t)NASSIGN * 2048 <= WS_Q, "ws map");
constexpr size_t RT_E = 0, RT_POS = 256 * 1024, RT_G = 512 * 1024, RT_SLOT = 768 * 1024, RT_GATE = 1088 * 1024, RT_TILE = 1408 * 1024, RT_TOK = 1472 * 1024;
constexpr int CW_BAR = 4096, CW_CNT = 8192;

constexpr int RING_BYTES = 131072, MISC_OFF = RING_BYTES + 320, LDS_BYTES = 147456;
constexpr int NWAVES = 8, NTHREADS = 512;

#define XB_TMO      128
#define XB_XCNT(j)  (256  + 64 * (j))
#define XB_XSUB(j)  (1280 + 64 * (j))
#define XB_XGEN(j)  (2304 + 64 * (j))
#define XB_TOP      3328
#define XB_TOPGEN   3392
#define XCD_BAR_WORDS 3456
#define XB_SPIN_CAP (1u << 18)
DI unsigned xb_ld(unsigned* p)              { return __hip_atomic_load(p, __ATOMIC_RELAXED, __HIP_MEMORY_SCOPE_AGENT); }
DI unsigned xb_add(unsigned* p, unsigned v) { return __hip_atomic_fetch_add(p, v, __ATOMIC_RELAXED, __HIP_MEMORY_SCOPE_AGENT); }
DI unsigned xb_xcc_id() { return (unsigned)__builtin_amdgcn_s_getreg((3 << 11) | 20) & 0xFu; }
#define XB_SPIN(cond, bar) do { unsigned _sp = 0; while (cond) { __builtin_amdgcn_s_sleep(1); \
    if ((++_sp & 255u) == 0u) { if (xb_ld(&(bar)[XB_TMO])) break; if (_sp > XB_SPIN_CAP) { atomicAdd(&(bar)[XB_TMO], 1u); break; } } } } while (0)
struct XcdBarrier { unsigned* bar; unsigned x; volatile LAS unsigned* st; };
DI XcdBarrier xcd_barrier_post(unsigned* bar, volatile LAS unsigned* st) {
    XcdBarrier b; b.bar = bar; b.x = xb_xcc_id(); b.st = st;
    if (threadIdx.x == 0) (void)xb_add(&bar[XB_XCNT(b.x)], 1u);
    return b;
}
DI void xcd_barrier_complete(unsigned* bar, unsigned x, unsigned& nloc, unsigned& nx) {
    const unsigned G = gridDim.x * gridDim.y * gridDim.z;
    unsigned sum, cnt, mine, sp = 0u;
    for (;;) {
        sum = 0u; cnt = 0u; mine = 0u;
#pragma unroll
        for (unsigned j = 0; j < 16; ++j) { const unsigned c = xb_ld(&bar[XB_XCNT(j)]); sum += c; cnt += (c > 0u) ? 1u : 0u; mine = (j == x) ? c : mine; }
        if (sum == G) break;
        __builtin_amdgcn_s_sleep(1);
        if ((++sp & 255u) == 0u) { if (xb_ld(&bar[XB_TMO])) break; if (sp > XB_SPIN_CAP) { atomicAdd(&bar[XB_TMO], 1u); break; } }
    }
    nloc = mine > 0u ? mine : 1u; nx = cnt > 0u ? cnt : 1u;
}
DI void xcd_barrier(const XcdBarrier& b) {
    asm volatile("s_waitcnt vmcnt(0)" ::: "memory");
    __syncthreads();
    if (threadIdx.x == 0) {
        unsigned* bar = b.bar;
        __builtin_amdgcn_s_waitcnt(0);
        unsigned nloc = b.st[0], nx = b.st[1];
        if (nloc == 0u) { xcd_barrier_complete(bar, b.x, nloc, nx); b.st[0] = nloc; b.st[1] = nx; }
        const unsigned old = xb_add(&bar[XB_XSUB(b.x)], 1u);
        const unsigned gen = old / nloc;
        if (old + 1u == (gen + 1u) * nloc) {
            __builtin_amdgcn_fence(__ATOMIC_RELEASE, "agent");
            asm volatile("s_waitcnt vmcnt(0)" ::: "memory");
            const unsigned og = xb_add(&bar[XB_TOP], 1u);
            const unsigned tg = og / nx;
            if (og + 1u == (tg + 1u) * nx) xb_add(&bar[XB_TOPGEN], 1u);
            else XB_SPIN(xb_ld(&bar[XB_TOPGEN]) == tg, bar);
            __builtin_amdgcn_fence(__ATOMIC_ACQUIRE, "agent");
            xb_add(&bar[XB_XGEN(b.x)], 1u);
            asm volatile("s_waitcnt vmcnt(0)" ::: "memory");
        } else {
            XB_SPIN(xb_ld(&bar[XB_XGEN(b.x)]) == gen, bar);
            __builtin_amdgcn_fence(__ATOMIC_ACQUIRE, "agent");
            asm volatile("s_waitcnt vmcnt(0)" ::: "memory");
        }
    }
    __syncthreads();
}

struct Args { const float* in[37]; float* out; unsigned char* ws; int ph_lo, ph_hi; };
enum { I_X = 0, I_MEM, I_NMIXG, I_WIN, I_CONVW, I_CONVB, I_LWX, I_LBX, I_LWA, I_LBA, I_LAM, I_MU, I_W0, I_WUP, I_A0, I_AUP, I_GUP, I_KK, I_KA, I_RK, I_LNG, I_LNB,
       I_WOUT, I_NXAG, I_NMEMG, I_WQ, I_WK, I_WV, I_WO, I_NFFG, I_WR, I_BR, I_WGU, I_BGU, I_WDN, I_BDN, I_FNG };

DI void transpose_item(const float* W, int ldw, int K, bf16* WT, int k0, int n0, int drow0, LAS float* scr, int lane) {
#pragma unroll 8
    for (int i = 0; i < 32; ++i) { const int kk = 2 * i + (lane >> 5); scr[kk * 33 + (lane & 31)] = W[(size_t)(k0 + kk) * ldw + n0 + (lane & 31)]; }
    asm volatile("s_waitcnt lgkmcnt(0)" ::: "memory");
    const int c = lane & 7;
#pragma unroll
    for (int j = 0; j < 4; ++j) { const int n = (lane >> 3) + 8 * j; const LAS float* s = scr + (8 * c) * 33 + n;
        u32x4 o; o.x = pk2(s[0 * 33], s[1 * 33]); o.y = pk2(s[2 * 33], s[3 * 33]); o.z = pk2(s[4 * 33], s[5 * 33]); o.w = pk2(s[6 * 33], s[7 * 33]);
        *(u32x4*)(WT + (size_t)(drow0 + n) * K + k0 + 8 * c) = o; }
    asm volatile("s_waitcnt lgkmcnt(0)" ::: "memory");
}
DI void rms_row_to_bf16(const float* xrow, const float* g, bf16* orow, int lane) {
    const f32x4* xr = (const f32x4*)xrow + lane; const f32x4* gr = (const f32x4*)g + lane;
    f32x4 v[4]; float s = 0.f;
#pragma unroll
    for (int j = 0; j < 4; ++j) { v[j] = xr[64 * j]; s += (v[j].x * v[j].x + v[j].y * v[j].y) + (v[j].z * v[j].z + v[j].w * v[j].w); }
    const float rstd = 1.0f / sqrtf(wave_sum(s) * (1.f / D) + EPS);
    u32x2* o8 = (u32x2*)orow + lane;
#pragma unroll
    for (int j = 0; j < 4; ++j) { const f32x4 gg = gr[64 * j]; u32x2 w; w.x = pk2(v[j].x * rstd * gg.x, v[j].y * rstd * gg.y); w.y = pk2(v[j].z * rstd * gg.z, v[j].w * rstd * gg.w); o8[64 * j] = w; }
}

__global__ void __launch_bounds__(NTHREADS, 2) fwd(Args args) {
    extern __shared__ __attribute__((aligned(16))) unsigned char lds_raw[];
    LAS unsigned char* lds = (LAS unsigned char*)lds_raw;
    volatile LAS unsigned* MISC = (volatile LAS unsigned*)(lds + MISC_OFF);
    const int G = gridDim.x, bid = blockIdx.x, NGW = G * NWAVES;
#define PHASE_IDS const int tid = fresh_tid(), lane = tid & 63, wave = __builtin_amdgcn_readfirstlane(tid >> 6), gw = bid * NWAVES + wave; (void)tid; (void)lane; (void)wave; (void)gw
    unsigned char* ws = args.ws;
    unsigned* ctl = (unsigned*)(ws + WS_CTL);
    const int lo = args.ph_lo, hi = args.ph_hi;

    for (int u = threadIdx.x; u < (LDS_BYTES - RING_BYTES) / 4; u += NTHREADS) ((LAS unsigned*)(lds + RING_BYTES))[u] = 0u;
    __syncthreads();
    XcdBarrier bar; bar.bar = ctl + CW_BAR; bar.x = 0; bar.st = nullptr;
    if (hi - lo > 1) bar = xcd_barrier_post(ctl + CW_BAR, MISC + 8);
#define IN(k) (lo <= (k) && (k) < hi)
#define SEAM(k) do { if (IN(k) && IN((k) + 1)) xcd_barrier(bar); } while (0)

#define Win_t ((bf16*)(ws + WS_WIN))
#define Wout_t ((bf16*)(ws + WS_WOUT))
#define Wq_t ((bf16*)(ws + WS_WQ))
#define Wk_t ((bf16*)(ws + WS_WK))
#define Wv_t ((bf16*)(ws + WS_WV))
#define Wo_t ((bf16*)(ws + WS_WO))
#define LoraB ((bf16*)(ws + WS_LORAB))
#define LruW ((bf16*)(ws + WS_LRUW))
#define Wgu_t ((bf16*)(ws + WS_WGU))
#define Wdn_t ((bf16*)(ws + WS_WDN))
#define HN ((bf16*)(ws + WS_HN))
#define MEMN ((bf16*)(ws + WS_MEMN))
#define KM ((bf16*)(ws + WS_KM))
#define VT ((bf16*)(ws + WS_VT))
#define X1 ((float*)(ws + WS_X1))
#define X2 ((float*)(ws + WS_X2))
#define U ((bf16*)(ws + WS_U))
#define Rr ((float*)(ws + WS_R))
#define KRAW ((float*)(ws + WS_KRAW))
#define Vv ((float*)(ws + WS_V))
#define KKN ((float*)(ws + WS_KKN))
#define WD ((float*)(ws + WS_WD))
#define AA ((float*)(ws + WS_AA))
#define GG ((float*)(ws + WS_G))
#define LA ((float*)(ws + WS_LA))
#define LB ((float*)(ws + WS_LB))
#define AP ((bf16*)(ws + WS_AP))
#define CAT ((bf16*)(ws + WS_CAT))
#define Qb ((bf16*)(ws + WS_Q))
#define Ob CAT
#define XS ((bf16*)(ws + WS_XS))
#define ACT ((bf16*)(ws + WS_ACT))
#define YS ((bf16*)(ws + WS_YS))
#define route_e ((int*)(ws + WS_ROUTE + RT_E))
#define route_pos ((int*)(ws + WS_ROUTE + RT_POS))
#define route_g ((float*)(ws + WS_ROUTE + RT_G))
#define row_slot ((int*)(ws + WS_ROUTE + RT_SLOT))
#define row_gate ((float*)(ws + WS_ROUTE + RT_GATE))
#define tile_tab ((int*)(ws + WS_ROUTE + RT_TILE))
#define row_tok ((int*)(ws + WS_ROUTE + RT_TOK))
#define ecnt (ctl + CW_CNT)

    if (IN(0)) { PHASE_IDS;
        LAS float* scr = (LAS float*)(lds + wave * 16384);
        constexpr int I_IN = 16 * (INW / 32), I_SQ = 16 * 32;
        constexpr int N_ITEMS = I_IN + 5 * I_SQ;
        for (int it = gw; it < N_ITEMS; it += NGW) {
            int r = it;
            if (r < I_IN) { const int nblk = INW / 32, kb = r / nblk, nb = r % nblk; transpose_item(args.in[I_WIN], INW, D, Win_t, 64 * kb, 32 * nb, 32 * nb, scr, lane); continue; } r -= I_IN;
            { const int w = r / I_SQ, q = r % I_SQ, kb = q / 32, nb = q % 32;
                const float* src = w == 0 ? args.in[I_WOUT] : w == 1 ? args.in[I_WQ] : w == 2 ? args.in[I_WK] : w == 3 ? args.in[I_WV] : args.in[I_WO];
                bf16* dst = w == 0 ? Wout_t : w == 1 ? Wq_t : w == 2 ? Wk_t : w == 3 ? Wv_t : Wo_t;
                transpose_item(src, D, D, dst, 64 * kb, 32 * nb, 32 * nb, scr, lane); }
        }
        for (int idx = bid * NTHREADS + tid; idx < 1536 * 256; idx += G * NTHREADS) {
            const int n = idx >> 8, k = idx & 255; float v = 0.f;
            if (n < 512) { if (k < 64) v = args.in[I_WUP][k * 512 + n]; }
            else if (n < 1024) { if (k >= 64 && k < 128) v = args.in[I_AUP][(k - 64) * 512 + (n - 512)]; }
            else { if (k >= 128) v = args.in[I_GUP][(k - 128) * 512 + (n - 1024)]; }
            LoraB[idx] = (bf16)f2bf(v);
        }
        for (int idx = bid * NTHREADS + tid; idx < 8 * 128 * 64; idx += G * NTHREADS) {
            const int nb = idx >> 13, col = (idx >> 6) & 127, k = idx & 63;
            const float v = col < 64 ? args.in[I_LWX][nb * 4096 + k * 64 + col] : args.in[I_LWA][nb * 4096 + k * 64 + (col - 64)];
            LruW[idx] = (bf16)f2bf(v);
        }
        for (int m = gw; m < M; m += NGW) rms_row_to_bf16(args.in[I_X] + (size_t)m * D, args.in[I_NMIXG], HN + (size_t)m * D, lane);
        for (int m = gw; m < MROWS; m += NGW) rms_row_to_bf16(args.in[I_MEM] + (size_t)m * D, args.in[I_NMEMG], MEMN + (size_t)m * D, lane);
    }
    SEAM(0);

    if (IN(1)) { PHASE_IDS;
        { pg8::DenseSched S; S.o.init_tiles(M / 256, INW / 256, G, bid); S.A = (const char*)HN; S.B = (const char*)Win_t; S.tstep = (size_t)256 * D * 2;
          EpiBf16Plain E{U, INW, 1.0f}; pg8::gemm_phase(lds, D, S, E); }
        { pg8::DenseSched S; S.o.init_tiles(MROWS / 256, D / 256, G, (bid + 64) & (G - 1)); S.A = (const char*)MEMN; S.B = (const char*)Wk_t; S.tstep = (size_t)256 * D * 2;
          EpiBf16Plain E{KM, D, 1.0f}; pg8::gemm_phase(lds, D, S, E); }
        { pg8::DenseSched S; S.o.init_tiles(D / 256, MROWS / 256, G, (bid + 48) & (G - 1)); S.A = (const char*)Wv_t; S.B = (const char*)MEMN; S.tstep = (size_t)256 * D * 2;
          EpiBf16Plain E{VT, MROWS, 1.0f}; pg8::gemm_phase(lds, D, S, E); }
    }
    SEAM(1);

    if (IN(2)) { PHASE_IDS;
        const float* mu = args.in[I_MU];
        for (int m = gw; m < M; m += NGW) {
            const bool hp = (m & (SEQ - 1)) != 0;
            const bf16* ur = U + (size_t)m * INW + 2560 + 4 * lane;
            const u32x2 cu = *(const u32x2*)ur; u32x2 pu = (u32x2){0u, 0u}; if (hp) pu = *(const u32x2*)(ur - INW);
            const f32x4 m4 = *(const f32x4*)(mu + 1536 + 4 * lane);
            f32x4 uu; { const float a0 = bflo(cu.x), a1 = bfhi(cu.x), a2 = bflo(cu.y), a3 = bfhi(cu.y), p0 = bflo(pu.x), p1 = bfhi(pu.x), p2 = bflo(pu.y), p3 = bfhi(pu.y);
                uu.x = a0 + (p0 - a0) * m4.x; uu.y = a1 + (p1 - a1) * m4.y; uu.z = a2 + (p2 - a2) * m4.z; uu.w = a3 + (p3 - a3) * m4.w; }
            f32x4 o = uu;
            if (lane < 16) { o.x = tanhf(uu.x); o.y = tanhf(uu.y); o.z = tanhf(uu.z); o.w = tanhf(uu.w); }
            else if (lane >= 32) { o.x = sigmoid_f(uu.x); o.y = sigmoid_f(uu.y); o.z = sigmoid_f(uu.z); o.w = sigmoid_f(uu.w); }
            u32x2 w; w.x = pk2(o.x, o.y); w.y = pk2(o.z, o.w); *(u32x2*)(AP + (size_t)m * 256 + 4 * lane) = w;
        }
        {
            const float* conv_w = args.in[I_CONVW]; const float* conv_b = args.in[I_CONVB]; const float* bx = args.in[I_LBX]; const float* ba = args.in[I_LBA]; const float* lam = args.in[I_LAM];
            LAS float* xs = (LAS float*)(lds + wave * 4096);
            const int i = lane & 15, kg = lane >> 4;
            for (int unit = gw; unit < (M / 16) * 2; unit += NGW) {
                const int tile = unit >> 1, nb0 = (unit & 1) * 4, m0 = tile * 16, s0 = m0 & (SEQ - 1);
                for (int nb = nb0; nb < nb0 + 4; ++nb) {
                    bf16x8 af[2];
#pragma unroll
                    for (int ks = 0; ks < 2; ++ks) {
                        const int chb = nb * 64 + 32 * ks + 8 * kg;
                        f32x4 x0 = *(const f32x4*)(conv_b + chb), x1 = *(const f32x4*)(conv_b + chb + 4);
#pragma unroll
                        for (int j = 0; j < 4; ++j) {
                            if (s0 + i - 3 + j >= 0) {
                                const u32x4 uw = *(const u32x4*)(U + (size_t)(m0 + i - 3 + j) * INW + chb);
                                const f32x4 w0 = *(const f32x4*)(conv_w + j * 512 + chb), w1 = *(const f32x4*)(conv_w + j * 512 + chb + 4);
                                x0.x += w0.x * bflo(uw.x); x0.y += w0.y * bfhi(uw.x); x0.z += w0.z * bflo(uw.y); x0.w += w0.w * bfhi(uw.y);
                                x1.x += w1.x * bflo(uw.z); x1.y += w1.y * bfhi(uw.z); x1.z += w1.z * bflo(uw.w); x1.w += w1.w * bfhi(uw.w);
                            }
                        }
                        *(LAS f32x4*)(xs + i * 64 + 32 * ks + 8 * kg) = x0; *(LAS f32x4*)(xs + i * 64 + 32 * ks + 8 * kg + 4) = x1;
                        u32x4 p; p.x = pk2(x0.x, x0.y); p.y = pk2(x0.z, x0.w); p.z = pk2(x1.x, x1.y); p.w = pk2(x1.z, x1.w);
                        af[ks] = __builtin_bit_cast(bf16x8, p);
                    }
                    f32x4 acc[8];
#pragma unroll
                    for (int ct = 0; ct < 8; ++ct) { acc[ct] = (f32x4){0.f, 0.f, 0.f, 0.f};
#pragma unroll
                        for (int ks = 0; ks < 2; ++ks) { const bf16x8 bfr = *(const bf16x8*)(LruW + ((size_t)(nb * 128 + 16 * ct + i) * 64 + 32 * ks + 8 * kg));
                            acc[ct] = __builtin_amdgcn_mfma_f32_16x16x32_bf16(af[ks], bfr, acc[ct], 0, 0, 0); } }
                    asm volatile("s_waitcnt lgkmcnt(0)" ::: "memory");
#pragma unroll
                    for (int ct = 0; ct < 4; ++ct) {
                        const int col = 16 * ct + i, ch = nb * 64 + col;
                        const float bxv = bx[ch], bav = ba[ch], sp = softplus_f(-lam[ch]);
#pragma unroll
                        for (int e = 0; e < 4; ++e) {
                            const int tok = 4 * kg + e;
                            const float gx = sigmoid_f(acc[ct][e] + bxv), ga = sigmoid_f(acc[ct + 4][e] + bav);
                            const float la = -8.0f * ga * sp, a = __expf(la), xcv = xs[tok * 64 + col];
                            const float bt = sqrtf(fmaxf(-expm1f(2.0f * la), 0.f)) * gx * xcv;
                            LA[(size_t)(m0 + tok) * 512 + ch] = a; LB[(size_t)(m0 + tok) * 512 + ch] = bt;
                        }
                    }
                }
            }
        }
    }
    SEAM(2);

    if (IN(3)) { PHASE_IDS;
        pg8::DenseSched S; S.o.init_tiles(M / 256, 1536 / 256, G, bid); S.A = (const char*)AP; S.B = (const char*)LoraB; S.tstep = (size_t)256 * 256 * 2;
        EpiLora E{WD, (bf16*)(ws + WS_AA), (bf16*)(ws + WS_G), args.in[I_W0], args.in[I_A0]}; pg8::gemm_phase(lds, 256, S, E);
    }
    SEAM(3);

    if (IN(4)) { PHASE_IDS;
        LAS unsigned char* wl = lds + wave * 16384;
        LAS bf16* Arm = (LAS bf16*)(wl); LAS bf16* Brm = (LAS bf16*)(wl + 2048); LAS bf16* Krm = (LAS bf16*)(wl + 4096); LAS bf16* Rrm = (LAS bf16*)(wl + 6144);
        LAS bf16* ATt = (LAS bf16*)(wl + 8192); LAS bf16* BTt = (LAS bf16*)(wl + 10240); LAS bf16* KTt = (LAS bf16*)(wl + 12288); LAS bf16* VTt = (LAS bf16*)(wl + 14336);
        LAS float* MabT = (LAS float*)(wl); LAS bf16* Mak = (LAS bf16*)(wl + 1024); LAS bf16* Mrb = (LAS bf16*)(wl + 1536); LAS bf16* Mrk = (LAS bf16*)(wl + 2048); LAS bf16* Tm = (LAS bf16*)(wl + 2560);
        LAS float* PLs = (LAS float*)(wl + 3072); LAS bf16* Q0T = (LAS bf16*)(wl + 4096);
        const int l15 = lane & 15, g = lane >> 4, te = lane >> 2, kq = lane & 3;
        const bf16x8 z8 = (bf16x8){0, 0, 0, 0, 0, 0, 0, 0};
        const f32x4 z4 = (f32x4){0.f, 0.f, 0.f, 0.f};
        for (int un = gw; un < NB * NH * (SEQ / 16); un += NGW) {
            const int bh = un >> 8, c = un & 255, b = bh >> 3, h = bh & 7;
            const size_t mrow = (size_t)b * SEQ + c * 16 + te, off = mrow * 512 + h * 64 + 16 * kq;
            const int hc = h * 64 + 16 * kq;
            float cl[16], eP[16];
            {
                float lwv[16], rl[16], kl[16], vl[16], kn[16], av[16];
                const bool hp = (mrow & (SEQ - 1)) != 0;
                const bf16* ub = U + mrow * INW + 1024 + hc;
#pragma unroll
                for (int hh = 0; hh < 2; ++hh) {
#pragma unroll
                    for (int a3 = 0; a3 < 3; ++a3) {
                        const u32x4 cu = *(const u32x4*)(ub + 512 * a3 + 8 * hh); u32x4 pu = (u32x4){0u, 0u, 0u, 0u}; if (hp) pu = *(const u32x4*)(ub - INW + 512 * a3 + 8 * hh);
                        const f32x4 m0 = *(const f32x4*)(args.in[I_MU] + 512 * a3 + hc + 8 * hh), m1 = *(const f32x4*)(args.in[I_MU] + 512 * a3 + hc + 8 * hh + 4);
                        float o8[8];
#pragma unroll
                        for (int q = 0; q < 4; ++q) { const float c0 = bflo(cu[q]), c1 = bfhi(cu[q]), p0 = bflo(pu[q]), p1 = bfhi(pu[q]); const float mm0 = q < 2 ? m0[2 * q] : m1[2 * q - 4], mm1 = q < 2 ? m0[2 * q + 1] : m1[2 * q - 3];
                            o8[2 * q] = c0 + (p0 - c0) * mm0; o8[2 * q + 1] = c1 + (p1 - c1) * mm1; }
#pragma unroll
                        for (int q = 0; q < 8; ++q) { if (a3 == 0) rl[8 * hh + q] = o8[q]; else if (a3 == 1) kl[8 * hh + q] = o8[q]; else vl[8 * hh + q] = o8[q]; }
                    }
                    const u32x4 aw = *(const u32x4*)((const bf16*)(ws + WS_AA) + off + 8 * hh);
#pragma unroll
                    for (int q = 0; q < 4; ++q) { av[8 * hh + 2 * q] = bflo(aw[q]); av[8 * hh + 2 * q + 1] = bfhi(aw[q]); }
                }
                float ss = 0.f;
#pragma unroll
                for (int j4 = 0; j4 < 4; ++j4) { const f32x4 x = *(const f32x4*)(WD + off + 4 * j4), kk4 = *(const f32x4*)(args.in[I_KK] + hc + 4 * j4); lwv[4 * j4] = x.x; lwv[4 * j4 + 1] = x.y; lwv[4 * j4 + 2] = x.z; lwv[4 * j4 + 3] = x.w;
#pragma unroll
                    for (int q = 0; q < 4; ++q) { kn[4 * j4 + q] = kl[4 * j4 + q] * kk4[q]; ss += kn[4 * j4 + q] * kn[4 * j4 + q]; } }
                ss += __shfl_xor(ss, 1); ss += __shfl_xor(ss, 2);
                const float kinv = 1.0f / fmaxf(sqrtf(ss), 1e-12f);
#pragma unroll
                for (int j = 0; j < 16; ++j) { float x = lwv[j];
#pragma unroll
                    for (int sft = 4; sft < 64; sft <<= 1) { const float y = __shfl_up(x, sft); if (lane >= sft) x += y; }
                    cl[j] = x; }
                float bon = 0.f;
                u32x4 pa[2], pb[2], pk[2], pr[2];
#pragma unroll
                for (int j4 = 0; j4 < 4; ++j4) {
                    const f32x4 ka = *(const f32x4*)(args.in[I_KA] + hc + 4 * j4), rk = *(const f32x4*)(args.in[I_RK] + hc + 4 * j4);
                    float at4[4], bt4[4], kt4[4], rt4[4];
#pragma unroll
                    for (int q = 0; q < 4; ++q) { const int j = 4 * j4 + q;
                        const float p = __expf(cl[j]), pn = __expf(-cl[j]), pm1 = __expf(cl[j] - lwv[j]); eP[j] = p;
                        const float knj = kn[j] * kinv;
                        const float kp = kl[j] * (1.0f + (av[j] - 1.0f) * ka[q]);
                        at4[q] = -knj * pm1; bt4[q] = knj * av[j] * pn; kt4[q] = kp * pn; rt4[q] = rl[j] * p;
                        bon += rl[j] * kp * rk[q];
                        const int kk = 16 * kq + j;
                        ATt[kk * 16 + te] = (bf16)f2bf(at4[q]); BTt[kk * 16 + te] = (bf16)f2bf(bt4[q]); KTt[kk * 16 + te] = (bf16)f2bf(kt4[q]); VTt[kk * 16 + te] = (bf16)f2bf(vl[j]); }
                    const int hh = j4 >> 1, w2 = (j4 & 1) * 2;
                    pa[hh][w2] = pk2(at4[0], at4[1]); pa[hh][w2 + 1] = pk2(at4[2], at4[3]); pb[hh][w2] = pk2(bt4[0], bt4[1]); pb[hh][w2 + 1] = pk2(bt4[2], bt4[3]);
                    pk[hh][w2] = pk2(kt4[0], kt4[1]); pk[hh][w2 + 1] = pk2(kt4[2], kt4[3]); pr[hh][w2] = pk2(rt4[0], rt4[1]); pr[hh][w2 + 1] = pk2(rt4[2], rt4[3]);
                }
#pragma unroll
                for (int hh = 0; hh < 2; ++hh) { const int po = te * 64 + 8 * ((2 * kq + hh) ^ (te & 7));
                    *(LAS u32x4*)(Arm + po) = pa[hh]; *(LAS u32x4*)(Brm + po) = pb[hh]; *(LAS u32x4*)(Krm + po) = pk[hh]; *(LAS u32x4*)(Rrm + po) = pr[hh]; }
                bon += __shfl_xor(bon, 1); bon += __shfl_xor(bon, 2);
#pragma unroll
                for (int hh = 0; hh < 2; ++hh) { const u32x4 gw_ = *(const u32x4*)((const bf16*)(ws + WS_G) + off + 8 * hh);
#pragma unroll
                    for (int q2 = 0; q2 < 2; ++q2) { const f32x4 lb = *(const f32x4*)(args.in[I_LNB] + hc + 8 * hh + 4 * q2); const int j0 = 8 * hh + 4 * q2;
                        f32x4 o; o.x = (lb.x + vl[j0] * bon) * bflo(gw_[2 * q2]); o.y = (lb.y + vl[j0 + 1] * bon) * bfhi(gw_[2 * q2]); o.z = (lb.z + vl[j0 + 2] * bon) * bflo(gw_[2 * q2 + 1]); o.w = (lb.w + vl[j0 + 3] * bon) * bfhi(gw_[2 * q2 + 1]);
                        *(f32x4*)((float*)(ws + WS_ADD) + off + j0) = o; } }
            }
            asm volatile("s_waitcnt lgkmcnt(0)" ::: "memory");
            {
                bf16x8 fa[2], fr[2], fb[2], fk[2];
#pragma unroll
                for (int ks = 0; ks < 2; ++ks) { const int po = l15 * 64 + 8 * ((4 * ks + g) ^ (l15 & 7));
                    fa[ks] = *(const LAS bf16x8*)(Arm + po); fr[ks] = *(const LAS bf16x8*)(Rrm + po); fb[ks] = *(const LAS bf16x8*)(Brm + po); fk[ks] = *(const LAS bf16x8*)(Krm + po); }
                f32x4 mab = z4, mak = z4, mrb = z4, mrk = z4;
#pragma unroll
                for (int ks = 0; ks < 2; ++ks) { mab = __builtin_amdgcn_mfma_f32_16x16x32_bf16(fb[ks], fa[ks], mab, 0, 0, 0); mak = __builtin_amdgcn_mfma_f32_16x16x32_bf16(fk[ks], fa[ks], mak, 0, 0, 0);
                    mrb = __builtin_amdgcn_mfma_f32_16x16x32_bf16(fb[ks], fr[ks], mrb, 0, 0, 0); mrk = __builtin_amdgcn_mfma_f32_16x16x32_bf16(fk[ks], fr[ks], mrk, 0, 0, 0); }
#pragma unroll
                for (int e = 0; e < 4; ++e) { const int i = 4 * g + e; if (!(i < l15)) { mab[e] = 0.f; mak[e] = 0.f; } if (!(i <= l15)) { mrb[e] = 0.f; mrk[e] = 0.f; } }
                asm volatile("s_waitcnt lgkmcnt(0)" ::: "memory");
#pragma unroll
                for (int e = 0; e < 4; ++e) MabT[(4 * g + e) * 16 + l15] = mab[e];
                u32x2 w; w.x = pk2(mak[0], mak[1]); w.y = pk2(mak[2], mak[3]); *(LAS u32x2*)(Mak + l15 * 16 + 4 * g) = w;
                w.x = pk2(mrb[0], mrb[1]); w.y = pk2(mrb[2], mrb[3]); *(LAS u32x2*)(Mrb + l15 * 16 + 4 * g) = w;
                w.x = pk2(mrk[0], mrk[1]); w.y = pk2(mrk[2], mrk[3]); *(LAS u32x2*)(Mrk + l15 * 16 + 4 * g) = w;
                if (te == 15) {
#pragma unroll
                    for (int j = 0; j < 16; ++j) PLs[16 * kq + j] = eP[j]; }
            }
            asm volatile("s_waitcnt lgkmcnt(0)" ::: "memory");
            {
                float y[16];
#pragma unroll
                for (int j = 15; j >= 0; --j) {
                    float acc = (j == l15) ? 1.0f : 0.0f;
                    float row[16];
#pragma unroll
                    for (int q = 0; q < 4; ++q) { const f32x4 x = *(const LAS f32x4*)(MabT + j * 16 + 4 * q); row[4 * q] = x.x; row[4 * q + 1] = x.y; row[4 * q + 2] = x.z; row[4 * q + 3] = x.w; }
#pragma unroll
                    for (int i = j + 1; i < 16; ++i) acc += y[i] * row[i];
                    y[j] = acc;
                }
                if (g == 0) { u32x4 t0, t1; t0.x = pk2(y[0], y[1]); t0.y = pk2(y[2], y[3]); t0.z = pk2(y[4], y[5]); t0.w = pk2(y[6], y[7]); t1.x = pk2(y[8], y[9]); t1.y = pk2(y[10], y[11]); t1.z = pk2(y[12], y[13]); t1.w = pk2(y[14], y[15]);
                    *(LAS u32x4*)(Tm + l15 * 16) = t0; *(LAS u32x4*)(Tm + l15 * 16 + 8) = t1; }
            }
            asm volatile("s_waitcnt lgkmcnt(0)" ::: "memory");
            {
                const bool act = g < 2; const int fo = l15 * 16 + 8 * g;
                const bf16x8 fT = act ? *(const LAS bf16x8*)(Tm + fo) : z8, fMak = act ? *(const LAS bf16x8*)(Mak + fo) : z8, fMrb = act ? *(const LAS bf16x8*)(Mrb + fo) : z8, fMrk = act ? *(const LAS bf16x8*)(Mrk + fo) : z8;
                bf16x8 fV[4], fQ1[4], fAh[4], fBT[4], fKT[4];
#pragma unroll
                for (int vt = 0; vt < 4; ++vt) { fV[vt] = act ? *(const LAS bf16x8*)(VTt + vt * 256 + fo) : z8; fBT[vt] = act ? *(const LAS bf16x8*)(BTt + vt * 256 + fo) : z8; fKT[vt] = act ? *(const LAS bf16x8*)(KTt + vt * 256 + fo) : z8; }
#pragma unroll
                for (int vt = 0; vt < 4; ++vt) { const f32x4 q0 = __builtin_amdgcn_mfma_f32_16x16x32_bf16(fMak, fV[vt], z4, 0, 0, 0);
                    u32x2 w; w.x = pk2(q0[0], q0[1]); w.y = pk2(q0[2], q0[3]); *(LAS u32x2*)(Q0T + vt * 256 + l15 * 16 + 4 * g) = w; }
#pragma unroll
                for (int kt = 0; kt < 4; ++kt) { const bf16x8 fA = act ? *(const LAS bf16x8*)(ATt + kt * 256 + fo) : z8; const f32x4 ah = __builtin_amdgcn_mfma_f32_16x16x32_bf16(fT, fA, z4, 0, 0, 0);
                    u32x2 w; w.x = pk2(ah[0], ah[1]); w.y = pk2(ah[2], ah[3]); *(LAS u32x2*)(ATt + kt * 256 + l15 * 16 + 4 * g) = w; }
                asm volatile("s_waitcnt lgkmcnt(0)" ::: "memory");
#pragma unroll
                for (int vt = 0; vt < 4; ++vt) { const bf16x8 fQ0 = act ? *(const LAS bf16x8*)(Q0T + vt * 256 + fo) : z8; const f32x4 q1 = __builtin_amdgcn_mfma_f32_16x16x32_bf16(fT, fQ0, z4, 0, 0, 0);
                    u32x2 w; w.x = pk2(q1[0], q1[1]); w.y = pk2(q1[2], q1[3]); *(LAS u32x2*)(Q0T + vt * 256 + l15 * 16 + 4 * g) = w; }
                asm volatile("s_waitcnt lgkmcnt(0)" ::: "memory");
#pragma unroll
                for (int vt = 0; vt < 4; ++vt) { fQ1[vt] = act ? *(const LAS bf16x8*)(Q0T + vt * 256 + fo) : z8; fAh[vt] = act ? *(const LAS bf16x8*)(ATt + vt * 256 + fo) : z8; }
                bf16* rp = (bf16*)(ws + WS_RP) + (size_t)un * 1024 + l15 * 64;
#pragma unroll
                for (int kt = 0; kt < 4; ++kt) {
                    const u32x2 rr = *(const LAS u32x2*)(Rrm + l15 * 64 + 8 * ((2 * kt + (g >> 1)) ^ (l15 & 7)) + 4 * (g & 1));
                    f32x4 ini; ini[0] = bflo(rr.x); ini[1] = bfhi(rr.x); ini[2] = bflo(rr.y); ini[3] = bfhi(rr.y);
                    const f32x4 rh = __builtin_amdgcn_mfma_f32_16x16x32_bf16(fAh[kt], fMrb, ini, 0, 0, 0);
                    u32x2 w; w.x = pk2(rh[0], rh[1]); w.y = pk2(rh[2], rh[3]); *(u32x2*)(rp + 32 * (kt >> 1) + 8 * g + 4 * (kt & 1)) = w;
                }
#pragma unroll
                for (int vt = 0; vt < 4; ++vt) { f32x4 y1 = __builtin_amdgcn_mfma_f32_16x16x32_bf16(fMrb, fQ1[vt], z4, 0, 0, 0); y1 = __builtin_amdgcn_mfma_f32_16x16x32_bf16(fMrk, fV[vt], y1, 0, 0, 0);
                    *(f32x4*)((float*)(ws + WS_Y1F) + ((size_t)(un * 4 + vt) * 64 + lane) * 4) = y1; }
                bf16* gp = (bf16*)(ws + WS_GP) + (size_t)un * 4096;
#pragma unroll
                for (int krt = 0; krt < 4; ++krt) { const float pl = PLs[16 * krt + l15];
#pragma unroll
                    for (int kct = 0; kct < 4; ++kct) { f32x4 ga = __builtin_amdgcn_mfma_f32_16x16x32_bf16(fAh[kct], fBT[krt], z4, 0, 0, 0);
                        if (kct == krt) {
#pragma unroll
                            for (int e = 0; e < 4; ++e) if (4 * g + e == l15) ga[e] += 1.0f; }
                        u32x2 w; w.x = pk2(ga[0] * pl, ga[1] * pl); w.y = pk2(ga[2] * pl, ga[3] * pl);
                        *(u32x2*)(gp + (16 * krt + l15) * 64 + 32 * (kct >> 1) + 8 * g + 4 * (kct & 1)) = w; } }
#pragma unroll
                for (int mt = 0; mt < 4; ++mt) { const f32x4 pl4 = *(const LAS f32x4*)(PLs + 16 * mt + 4 * g);
#pragma unroll
                    for (int vt = 0; vt < 4; ++vt) { f32x4 ha = __builtin_amdgcn_mfma_f32_16x16x32_bf16(fBT[mt], fQ1[vt], z4, 0, 0, 0); ha = __builtin_amdgcn_mfma_f32_16x16x32_bf16(fKT[mt], fV[vt], ha, 0, 0, 0);
                        u32x2 w; w.x = pk2(ha[0] * pl4[0], ha[1] * pl4[1]); w.y = pk2(ha[2] * pl4[2], ha[3] * pl4[3]);
                        *(u32x2*)((bf16*)(ws + WS_HF) + ((size_t)((un * 4 + vt) * 4 + mt) * 64 + lane) * 4) = w; } }
            }
            asm volatile("s_waitcnt lgkmcnt(0)" ::: "memory");
        }
    }
    SEAM(4);

#define RW_ZB(zz, zb) do { _Pragma("unroll") for (int ks_ = 0; ks_ < 2; ++ks_) { u32x4 p_; p_.x = pk2(zz[2 * ks_][0], zz[2 * ks_][1]); p_.y = pk2(zz[2 * ks_][2], zz[2 * ks_][3]); \
        p_.z = pk2(zz[2 * ks_ + 1][0], zz[2 * ks_ + 1][1]); p_.w = pk2(zz[2 * ks_ + 1][2], zz[2 * ks_ + 1][3]); zb[ks_] = __builtin_bit_cast(bf16x8, p_); } } while (0)
    if (IN(5)) { PHASE_IDS;
        const int l15 = lane & 15, g = lane >> 4;
        for (int u2 = gw; u2 < 2 * NB * NH * (SEQ / 64); u2 += NGW) {
            const int u64 = u2 >> 1, part = u2 & 1;
            f32x4 z[4][4];
#pragma unroll
            for (int sl = 0; sl < 4; ++sl)
#pragma unroll
                for (int mt = 0; mt < 4; ++mt)
#pragma unroll
                    for (int e = 0; e < 4; ++e) z[sl][mt][e] = (part == 0 && sl == mt && 4 * g + e == l15) ? 1.0f : 0.0f;
#pragma unroll 1
            for (int j = 0; j < 4; ++j) {
                const size_t un = (size_t)u64 * 4 + j;
                const bf16* gp = (const bf16*)(ws + WS_GP) + un * 4096 + l15 * 64 + 8 * g;
                bf16x8 gf[4][2];
#pragma unroll
                for (int mt = 0; mt < 4; ++mt) { gf[mt][0] = *(const bf16x8*)(gp + mt * 1024); gf[mt][1] = *(const bf16x8*)(gp + mt * 1024 + 32); }
#pragma unroll
                for (int sl = 0; sl < 4; ++sl) {
                    bf16x8 zb[2]; RW_ZB(z[sl], zb);
#pragma unroll
                    for (int mt = 0; mt < 4; ++mt) {
                        f32x4 a = (f32x4){0.f, 0.f, 0.f, 0.f};
                        if (part) { const u32x2 hh = *(const u32x2*)((const bf16*)(ws + WS_HF) + ((size_t)((un * 4 + sl) * 4 + mt) * 64 + lane) * 4); a[0] = bflo(hh.x); a[1] = bfhi(hh.x); a[2] = bflo(hh.y); a[3] = bfhi(hh.y); }
                        a = __builtin_amdgcn_mfma_f32_16x16x32_bf16(gf[mt][0], zb[0], a, 0, 0, 0); a = __builtin_amdgcn_mfma_f32_16x16x32_bf16(gf[mt][1], zb[1], a, 0, 0, 0);
                        z[sl][mt] = a;
                    }
                }
            }
            if (part == 0) {
                bf16* gc = (bf16*)(ws + WS_GC) + (size_t)u64 * 4096;
#pragma unroll
                for (int sl = 0; sl < 4; ++sl) { const int pc = 32 * (sl >> 1) + 8 * (l15 >> 2) + 4 * (sl & 1) + (l15 & 3);
#pragma unroll
                    for (int mt = 0; mt < 4; ++mt)
#pragma unroll
                        for (int e = 0; e < 4; ++e) gc[(16 * mt + 4 * g + e) * 64 + pc] = (bf16)f2bf(z[sl][mt][e]); }
            } else {
#pragma unroll
                for (int sl = 0; sl < 4; ++sl)
#pragma unroll
                    for (int mt = 0; mt < 4; ++mt) { u32x2 w; w.x = pk2(z[sl][mt][0], z[sl][mt][1]); w.y = pk2(z[sl][mt][2], z[sl][mt][3]);
                        *(u32x2*)((bf16*)(ws + WS_HC) + ((size_t)((u64 * 4 + sl) * 4 + mt) * 64 + lane) * 4) = w; }
            }
        }
        for (int lu = gw; lu < NB * 8 * 64; lu += NGW) {
            const int bc = lu >> 6, seg = lu & 63, b = bc >> 3, cg = bc & 7, ch = cg * 64 + lane;
            const size_t mb = (size_t)b * SEQ + seg * 64;
            float A = 1.f, B = 0.f;
#pragma unroll 16
            for (int t = 0; t < 64; ++t) { const float a = LA[(mb + t) * 512 + ch], bt = LB[(mb + t) * 512 + ch]; B = a * B + bt; A *= a; }
            f32x2 ab; ab.x = A; ab.y = B; *(f32x2*)((float*)(ws + WS_AP) + ((size_t)lu * 64 + lane) * 2) = ab;
        }
    }
    SEAM(5);

    if (IN(6)) { PHASE_IDS;
        if (!(bid < 128 && wave == 0)) {
            const int wi = bid < 128 ? bid * 7 + (wave - 1) : 896 + (bid - 128) * 8 + wave, NW = 896 + (G - 128) * 8;
            for (int lu = wi; lu < NB * 8 * 64; lu += NW) {
                const int bc = lu >> 6, seg = lu & 63, b = bc >> 3, cg = bc & 7, ch = cg * 64 + lane;
                const size_t mb = (size_t)b * SEQ + seg * 64;
                float hst = 0.f;
                const f32x2* ag = (const f32x2*)((const float*)(ws + WS_AP)) + (size_t)(bc * 64) * 64 + lane;
#pragma unroll 8
                for (int sg = 0; sg < seg; ++sg) { const f32x2 ab = ag[(size_t)sg * 64]; hst = ab.x * hst + ab.y; }
#pragma unroll 16
                for (int t = 0; t < 64; ++t) { const float a = LA[(mb + t) * 512 + ch], bt = LB[(mb + t) * 512 + ch]; hst = a * hst + bt;
                    const float gl = bf2f(U[(mb + t) * INW + 512 + ch]); CAT[(mb + t) * 1024 + ch] = (bf16)f2bf(hst * gelu_tanh_f(gl)); }
            }
            LAS float* scr = (LAS float*)(lds + wave * 16384);
            constexpr int I_GU = 16 * 64, I_DN = 16 * 32;
            for (int it = wi; it < NE * (I_GU + I_DN); it += NW) {
                int r = it;
                if (r < NE * I_GU) { const int e = r / I_GU, q = r % I_GU, kb = q / 64, nb = q % 64; const int n0 = 32 * nb;
                    const int drow = n0 < 1024 ? (256 * (n0 >> 7) + (n0 & 127)) : (256 * ((n0 - 1024) >> 7) + 128 + ((n0 - 1024) & 127));
                    transpose_item(args.in[I_WGU] + (size_t)e * D * 2048, 2048, D, Wgu_t + (size_t)e * 2048 * D, 64 * kb, n0, drow, scr, lane); continue; } r -= NE * I_GU;
                { const int e = r / I_DN, q = r % I_DN, kb = q / 32, nb = q % 32;
                  transpose_item(args.in[I_WDN] + (size_t)e * DFF * D, D, DFF, Wdn_t + (size_t)e * D * DFF, 64 * kb, 32 * nb, 32 * nb, scr, lane); }
            }
        } else {
            const int l15 = lane & 15, g = lane >> 4, bh = bid >> 2, vs = bid & 3;
            f32x4 z[4];
#pragma unroll
            for (int mt = 0; mt < 4; ++mt) z[mt] = (f32x4){0.f, 0.f, 0.f, 0.f};
            bf16x8 gA[4][2], gB[4][2], gC[4][2], gD[4][2]; u32x2 hA[4], hB[4], hC[4], hD[4];
#define SC_LOAD(gf, hf, C) do { const size_t u64_ = (size_t)bh * 64 + (C); const bf16* gp_ = (const bf16*)(ws + WS_GC) + u64_ * 4096 + l15 * 64 + 8 * g; \
                _Pragma("unroll") for (int mt = 0; mt < 4; ++mt) { gf[mt][0] = *(const bf16x8*)(gp_ + mt * 1024); gf[mt][1] = *(const bf16x8*)(gp_ + mt * 1024 + 32); \
                    hf[mt] = *(const u32x2*)((const bf16*)(ws + WS_HC) + ((size_t)((u64_ * 4 + vs) * 4 + mt) * 64 + lane) * 4); } } while (0)
#define SC_STEP(gf, hf, C) do { const size_t u64_ = (size_t)bh * 64 + (C); float* zs_ = (float*)(ws + WS_ZS) + ((size_t)((u64_ * 4 + vs) * 4) * 64 + lane) * 4; \
                _Pragma("unroll") for (int mt = 0; mt < 4; ++mt) *(f32x4*)(zs_ + mt * 256) = z[mt]; \
                bf16x8 zb[2]; RW_ZB(z, zb); \
                _Pragma("unroll") for (int mt = 0; mt < 4; ++mt) { f32x4 a; a[0] = bflo(hf[mt].x); a[1] = bfhi(hf[mt].x); a[2] = bflo(hf[mt].y); a[3] = bfhi(hf[mt].y); \
                    a = __builtin_amdgcn_mfma_f32_16x16x32_bf16(gf[mt][0], zb[0], a, 0, 0, 0); a = __builtin_amdgcn_mfma_f32_16x16x32_bf16(gf[mt][1], zb[1], a, 0, 0, 0); z[mt] = a; } } while (0)
            SC_LOAD(gA, hA, 0); SC_LOAD(gB, hB, 1); SC_LOAD(gC, hC, 2);
#pragma unroll 1
            for (int C = 0; C < 64; C += 4) {
                SC_LOAD(gD, hD, C + 3);
                SC_STEP(gA, hA, C);
                if (C + 4 < 64) SC_LOAD(gA, hA, C + 4);
                SC_STEP(gB, hB, C + 1);
                if (C + 5 < 64) SC_LOAD(gB, hB, C + 5);
                SC_STEP(gC, hC, C + 2);
                if (C + 6 < 64) SC_LOAD(gC, hC, C + 6);
                SC_STEP(gD, hD, C + 3);
            }
#undef SC_LOAD
#undef SC_STEP
        }
    }
    SEAM(6);

    if (IN(7)) { PHASE_IDS;
        const int l15 = lane & 15, g = lane >> 4;
        for (int u64 = gw; u64 < NB * NH * (SEQ / 64); u64 += NGW) {
            const int bh = u64 >> 6, C = u64 & 63, b = bh >> 3, h = bh & 7;
            f32x4 z[4][4];
#pragma unroll
            for (int sl = 0; sl < 4; ++sl)
#pragma unroll
                for (int mt = 0; mt < 4; ++mt) z[sl][mt] = *(const f32x4*)((const float*)(ws + WS_ZS) + ((size_t)((u64 * 4 + sl) * 4 + mt) * 64 + lane) * 4);
            float lg4[4];
#pragma unroll
            for (int sl = 0; sl < 4; ++sl) lg4[sl] = args.in[I_LNG][h * 64 + 16 * sl + l15];
#pragma unroll 1
            for (int j = 0; j < 4; ++j) {
                const size_t un = (size_t)u64 * 4 + j; const size_t m0 = (size_t)b * SEQ + (C * 4 + j) * 16;
                const bf16* rp = (const bf16*)(ws + WS_RP) + un * 1024 + l15 * 64 + 8 * g;
                const bf16x8 rf0 = *(const bf16x8*)rp, rf1 = *(const bf16x8*)(rp + 32);
                f32x4 y[4];
#pragma unroll
                for (int sl = 0; sl < 4; ++sl) { bf16x8 zb[2]; RW_ZB(z[sl], zb);
                    f32x4 a = *(const f32x4*)((const float*)(ws + WS_Y1F) + ((size_t)(un * 4 + sl) * 64 + lane) * 4);
                    a = __builtin_amdgcn_mfma_f32_16x16x32_bf16(rf0, zb[0], a, 0, 0, 0); a = __builtin_amdgcn_mfma_f32_16x16x32_bf16(rf1, zb[1], a, 0, 0, 0); y[sl] = a; }
#pragma unroll
                for (int e = 0; e < 4; ++e) {
                    float s1 = (y[0][e] + y[1][e]) + (y[2][e] + y[3][e]);
                    s1 += __shfl_xor(s1, 1); s1 += __shfl_xor(s1, 2); s1 += __shfl_xor(s1, 4); s1 += __shfl_xor(s1, 8);
                    const float mean = s1 * (1.0f / 64.0f);
                    float d0 = y[0][e] - mean, d1 = y[1][e] - mean, d2 = y[2][e] - mean, d3 = y[3][e] - mean;
                    float s2 = (d0 * d0 + d1 * d1) + (d2 * d2 + d3 * d3);
                    s2 += __shfl_xor(s2, 1); s2 += __shfl_xor(s2, 2); s2 += __shfl_xor(s2, 4); s2 += __shfl_xor(s2, 8);
                    const float rstd = 1.0f / sqrtf(s2 * (1.0f / 64.0f) + GN_EPS);
                    const size_t ro = (m0 + 4 * g + e) * 512 + h * 64 + l15;
                    const float dd[4] = {d0, d1, d2, d3};
#pragma unroll
                    for (int sl = 0; sl < 4; ++sl) { const float gg = bf2f(((const bf16*)(ws + WS_G))[ro + 16 * sl]), ad = ((const float*)(ws + WS_ADD))[ro + 16 * sl];
                        const float o = dd[sl] * rstd * lg4[sl] * gg + ad;
                        CAT[(m0 + 4 * g + e) * 1024 + 512 + h * 64 + 16 * sl + l15] = (bf16)f2bf(o); }
                }
                if (j < 3) {
                    const bf16* gp = (const bf16*)(ws + WS_GP) + un * 4096 + l15 * 64 + 8 * g;
                    bf16x8 gf[4][2];
#pragma unroll
                    for (int mt = 0; mt < 4; ++mt) { gf[mt][0] = *(const bf16x8*)(gp + mt * 1024); gf[mt][1] = *(const bf16x8*)(gp + mt * 1024 + 32); }
#pragma unroll
                    for (int sl = 0; sl < 4; ++sl) { bf16x8 zb[2]; RW_ZB(z[sl], zb);
#pragma unroll
                        for (int mt = 0; mt < 4; ++mt) { const u32x2 hh = *(const u32x2*)((const bf16*)(ws + WS_HF) + ((size_t)((un * 4 + sl) * 4 + mt) * 64 + lane) * 4);
                            f32x4 a; a[0] = bflo(hh.x); a[1] = bfhi(hh.x); a[2] = bflo(hh.y); a[3] = bfhi(hh.y);
                            a = __builtin_amdgcn_mfma_f32_16x16x32_bf16(gf[mt][0], zb[0], a, 0, 0, 0); a = __builtin_amdgcn_mfma_f32_16x16x32_bf16(gf[mt][1], zb[1], a, 0, 0, 0); z[sl][mt] = a; } }
                }
            }
        }
    }
    SEAM(7);
#undef RW_ZB


    if (IN(8)) { PHASE_IDS;
        pg8::DenseSched S; S.o.init_tiles(M / 256, D / 256, G, bid); S.A = (const char*)CAT; S.B = (const char*)Wout_t; S.tstep = (size_t)256 * D * 2;
        EpiF32Res E{args.in[I_X], X1, D}; pg8::gemm_phase(lds, D, S, E);
    }
    SEAM(8);
    if (IN(9)) { PHASE_IDS; for (int m = gw; m < M; m += NGW) rms_row_to_bf16(X1 + (size_t)m * D, args.in[I_NXAG], HN + (size_t)m * D, lane); }
    SEAM(9);
    if (IN(10)) { PHASE_IDS;
        pg8::DenseSched S; S.o.init_tiles(M / 256, D / 256, G, bid); S.A = (const char*)HN; S.B = (const char*)Wq_t; S.tstep = (size_t)256 * D * 2;
        EpiBf16Plain E{Qb, D, 0.0625f}; pg8::gemm_phase(lds, D, S, E);
    }
    SEAM(10);
    if (IN(11)) { PHASE_IDS;
        const int l15 = lane & 15, g4 = lane >> 4;
        for (int unit = gw; unit < NB * XH * (SEQ / 16); unit += NGW) {
            const int qt16 = unit % (SEQ / 16), bh = unit / (SEQ / 16), h = bh & 3, b = bh >> 2;
            const bf16* qbase = Qb + (size_t)(b * SEQ + qt16 * 16 + l15) * D + h * XHD + 8 * g4;
            const bf16* kbase = KM + (size_t)(b * MEML + l15) * D + h * XHD + 8 * g4;
            f32x4 sc[16];
#pragma unroll
            for (int kt = 0; kt < 16; ++kt) sc[kt] = (f32x4){0.f, 0.f, 0.f, 0.f};
#pragma unroll 1
            for (int ks = 0; ks < 8; ++ks) {
                const bf16x8 q0 = *(const bf16x8*)(qbase + 32 * ks);
                const bf16* kp = kbase + 32 * ks;
#pragma unroll
                for (int kt = 0; kt < 16; ++kt) { const bf16x8 kf = *(const bf16x8*)(kp + (size_t)(16 * kt) * D);
                    sc[kt] = __builtin_amdgcn_mfma_f32_16x16x32_bf16(kf, q0, sc[kt], 0, 0, 0); }
            }
            bf16x8 pf[8];
            {
                float mx = -3.0e38f;
#pragma unroll
                for (int kt = 0; kt < 16; ++kt) mx = fmaxf(mx, fmaxf(fmaxf(sc[kt][0], sc[kt][1]), fmaxf(sc[kt][2], sc[kt][3])));
                mx = fmaxf(mx, __shfl_xor(mx, 16)); mx = fmaxf(mx, __shfl_xor(mx, 32));
                float sum = 0.f;
#pragma unroll
                for (int kt = 0; kt < 16; ++kt) {
#pragma unroll
                    for (int e = 0; e < 4; ++e) { const float p = __expf(sc[kt][e] - mx); sc[kt][e] = p; sum += p; } }
                sum += __shfl_xor(sum, 16); sum += __shfl_xor(sum, 32);
                const float inv = 1.0f / sum;
#pragma unroll
                for (int s2 = 0; s2 < 8; ++s2) { const f32x4 a = sc[2 * s2] * inv, c = sc[2 * s2 + 1] * inv;
                    u32x4 p; p.x = pk2(a[0], a[1]); p.y = pk2(a[2], a[3]); p.z = pk2(c[0], c[1]); p.w = pk2(c[2], c[3]); pf[s2] = __builtin_bit_cast(bf16x8, p); }
            }
            const bf16* vbase = VT + (size_t)(h * XHD + l15) * MROWS + b * MEML + 4 * g4;
            bf16* obase = Ob + (size_t)(b * SEQ + qt16 * 16 + l15) * D + h * XHD + 4 * g4;
#pragma unroll 1
            for (int dt = 0; dt < 16; ++dt) {
                const bf16* vp = vbase + (size_t)(16 * dt) * MROWS;
                f32x4 oc = (f32x4){0.f, 0.f, 0.f, 0.f};
#pragma unroll
                for (int s2 = 0; s2 < 8; ++s2) {
                    const u32x2 v0 = *(const u32x2*)(vp + 32 * s2), v1 = *(const u32x2*)(vp + 32 * s2 + 16);
                    u32x4 vv; vv.x = v0.x; vv.y = v0.y; vv.z = v1.x; vv.w = v1.y; const bf16x8 vf = __builtin_bit_cast(bf16x8, vv);
                    oc = __builtin_amdgcn_mfma_f32_16x16x32_bf16(vf, pf[s2], oc, 0, 0, 0);
                }
                u32x2 w; w.x = pk2(oc[0], oc[1]); w.y = pk2(oc[2], oc[3]);
                *(u32x2*)(obase + 16 * dt) = w;
            }
        }
    }
    SEAM(11);
    if (IN(12)) { PHASE_IDS;
        pg8::DenseSched S; S.o.init_tiles(M / 256, D / 256, G, bid); S.A = (const char*)Ob; S.B = (const char*)Wo_t; S.tstep = (size_t)256 * D * 2;
        EpiF32Res E{X1, X2, D}; pg8::gemm_phase(lds, D, S, E);
    }
    SEAM(12);
    if (IN(13)) { PHASE_IDS;
        LAS float* hs = (LAS float*)(lds + wave * 16384);
        const float* gfn = args.in[I_NFFG]; const float* wr_ = args.in[I_WR]; const float* br = args.in[I_BR];
        const int e = lane & 31, half = lane >> 5;
        for (int grp = gw; grp < M / 4; grp += NGW) {
            const int m0 = grp * 4;
#pragma unroll
            for (int rr = 0; rr < 4; ++rr) {
                const f32x4* xr = (const f32x4*)(X2 + (size_t)(m0 + rr) * D) + lane; const f32x4* gr = (const f32x4*)gfn + lane;
                f32x4 v[4]; float s = 0.f;
#pragma unroll
                for (int j = 0; j < 4; ++j) { v[j] = xr[64 * j]; s += (v[j].x * v[j].x + v[j].y * v[j].y) + (v[j].z * v[j].z + v[j].w * v[j].w); }
                const float rstd = 1.0f / sqrtf(wave_sum(s) * (1.f / D) + EPS);
                u32x2* o8 = (u32x2*)(HN + (size_t)(m0 + rr) * D) + lane;
#pragma unroll
                for (int j = 0; j < 4; ++j) { const f32x4 gg = gr[64 * j]; f32x4 hv = v[j] * rstd * gg; *(LAS f32x4*)(hs + rr * 1024 + 256 * j + 4 * lane) = hv;
                    u32x2 w; w.x = pk2(hv.x, hv.y); w.y = pk2(hv.z, hv.w); o8[64 * j] = w; }
            }
            asm volatile("s_waitcnt lgkmcnt(0)" ::: "memory");
            float lg[4] = {0.f, 0.f, 0.f, 0.f};
#pragma unroll 4
            for (int d = half * 512; d < half * 512 + 512; d += 4) {
                const float w0 = wr_[(d + 0) * 32 + e], w1 = wr_[(d + 1) * 32 + e], w2 = wr_[(d + 2) * 32 + e], w3 = wr_[(d + 3) * 32 + e];
#pragma unroll
                for (int rr = 0; rr < 4; ++rr) { const f32x4 h4 = *(const LAS f32x4*)(hs + rr * 1024 + d); lg[rr] += (h4.x * w0 + h4.y * w1) + (h4.z * w2 + h4.w * w3); }
            }
            const float brv = br[e];
#pragma unroll
            for (int rr = 0; rr < 4; ++rr) {
                float v = lg[rr] + __shfl_xor(lg[rr], 32) + brv;
                float selv[4]; int sele[4];
#pragma unroll
                for (int k = 0; k < 4; ++k) {
                    float mv = v; int mi = e;
#pragma unroll
                    for (int o = 1; o < 32; o <<= 1) { const float ov = __shfl_xor(mv, o); const int oi = __shfl_xor(mi, o); if (ov > mv || (ov == mv && oi < mi)) { mv = ov; mi = oi; } }
                    selv[k] = mv; sele[k] = mi; if (e == mi) v = -3.0e38f;
                }
                const float e1 = __expf(selv[1] - selv[0]), e2 = __expf(selv[2] - selv[0]), e3 = __expf(selv[3] - selv[0]);
                const float inv = 1.0f / (1.0f + e1 + e2 + e3);
                if (lane < 4) {
                    const int me = lane == 0 ? sele[0] : lane == 1 ? sele[1] : lane == 2 ? sele[2] : sele[3];
                    const float mg = (lane == 0 ? 1.0f : lane == 1 ? e1 : lane == 2 ? e2 : e3) * inv;
                    const int pos = (int)atomicAdd(ecnt + me, 1u);
                    const int ai = (m0 + rr) * 4 + lane; route_e[ai] = me; route_pos[ai] = pos; route_g[ai] = mg;
                }
            }
        }
    }
    SEAM(13);
    if (IN(14)) { PHASE_IDS;
        LAS int* pst = (LAS int*)lds;
        if (tid == 0) { int acc = 0; for (int e = 0; e < NE; ++e) { const int c = (int)__hip_atomic_load(ecnt + e, __ATOMIC_RELAXED, __HIP_MEMORY_SCOPE_AGENT); pst[e] = acc; pst[64 + e] = c; acc += (c + 255) & ~255; } pst[32] = acc; }
        __syncthreads();
        for (int ai = bid * NTHREADS + tid; ai < NASSIGN; ai += G * NTHREADS) {
            const int e = route_e[ai]; const int row = pst[e] + route_pos[ai]; row_slot[row] = ai; row_gate[row] = route_g[ai]; row_tok[row] = ai >> 2; }
        if (bid < NE) { const int e = bid, c = pst[64 + e], pe = (c + 255) & ~255; for (int p = c + tid; p < pe; p += NTHREADS) { row_slot[pst[e] + p] = -1; row_gate[pst[e] + p] = 0.f; row_tok[pst[e] + p] = 0; } }
        if (bid == 0 && tid == 0) { int nt = 0; for (int e = 0; e < NE; ++e) { const int n = ((pst[64 + e] + 255) & ~255) >> 8; for (int j = 0; j < n; ++j) tile_tab[16 + nt++] = e; } tile_tab[0] = nt; }
        __syncthreads();
    }
    SEAM(14);
    if (IN(15)) { PHASE_IDS;
        const int ntiles = tile_tab[0];
        pg8::MoeGatherSched S; S.o.init_tiles(ntiles, 2048 / 256, G, bid); S.A = (const char*)HN; S.B = (const char*)Wgu_t; S.tile_e = tile_tab + 16; S.rtok = row_tok; S.tstep = (size_t)256 * D * 2; S.estep = (size_t)2048 * D * 2;
        EpiSwiglu E{ACT, args.in[I_BGU]}; pg8::gemm_phase(lds, D, S, E);
    }
    SEAM(15);
    if (IN(16)) { PHASE_IDS;
        const int ntiles = tile_tab[0];
        pg8::MoeSched S; S.o.init_tiles(ntiles, D / 256, G, bid); S.A = (const char*)ACT; S.B = (const char*)Wdn_t; S.tile_e = tile_tab + 16; S.tstep = (size_t)256 * DFF * 2; S.estep = (size_t)D * DFF * 2;
        EpiDown E{YS, args.in[I_BDN], row_slot, row_gate}; pg8::gemm_phase(lds, DFF, S, E);
    }
    SEAM(16);
    if (IN(17)) { PHASE_IDS;
        const f32x4* gr = (const f32x4*)args.in[I_FNG] + lane;
        for (int m = gw; m < M; m += NGW) {
            const f32x4* xr = (const f32x4*)(X2 + (size_t)m * D) + lane;
            f32x4 v[4]; float s = 0.f;
#pragma unroll
            for (int j = 0; j < 4; ++j) { v[j] = xr[64 * j];
#pragma unroll
                for (int k = 0; k < 4; ++k) { const u32x2 y = *((const u32x2*)(YS + (size_t)(m * 4 + k) * D) + 64 * j + lane); v[j].x += bflo(y.x); v[j].y += bfhi(y.x); v[j].z += bflo(y.y); v[j].w += bfhi(y.y); }
                s += (v[j].x * v[j].x + v[j].y * v[j].y) + (v[j].z * v[j].z + v[j].w * v[j].w); }
            const float rstd = 1.0f / sqrtf(wave_sum(s) * (1.f / D) + EPS);
            f32x4* o = (f32x4*)(args.out + (size_t)m * D) + lane;
#pragma unroll
            for (int j = 0; j < 4; ++j) o[64 * j] = v[j] * rstd * gr[64 * j];
        }
    }
#undef IN
#undef SEAM
}

constexpr int N_PHASES = 18;
extern "C" void kernel_launch(void* const* d_in, const int* in_sizes, int n_in, void* d_out, int out_size, void* d_ws, size_t ws_size, hipStream_t stream) {
    static int grid = 0;
    if (grid == 0) {
        if (n_in != 37 || out_size != M * D || ws_size < WS_END) { fprintf(stderr, "kernel_launch: unexpected shapes (n_in %d, out %d, ws %zu); nothing launched\n", n_in, out_size, ws_size); grid = -1; return; }
        int dev = 0, cus = 0, per_cu = 0;
        if (hipGetDevice(&dev) != hipSuccess || hipDeviceGetAttribute(&cus, hipDeviceAttributeMultiprocessorCount, dev) != hipSuccess) { grid = -1; return; }
        if (hipFuncSetAttribute((const void*)fwd, hipFuncAttributeMaxDynamicSharedMemorySize, LDS_BYTES) != hipSuccess) { fprintf(stderr, "kernel_launch: hipFuncSetAttribute failed\n"); grid = -1; return; }
        if (hipOccupancyMaxActiveBlocksPerMultiprocessor(&per_cu, (const void*)fwd, NTHREADS, LDS_BYTES) != hipSuccess || per_cu < 1) fprintf(stderr, "kernel_launch: occupancy query says %d\n", per_cu);
        (void)hipGetLastError();
        grid = cus > 256 ? 256 : cus;
    }
    if (grid < 0) return;
    if (hipMemsetAsync((char*)d_ws + WS_CTL, 0, CTL_ZERO_BYTES, stream) != hipSuccess) return;
    Args a{};
    for (int i = 0; i < 37; ++i) a.in[i] = (const float*)d_in[i];
    a.out = (float*)d_out; a.ws = (unsigned char*)d_ws;
#if MK_ONE_LAUNCH
    a.ph_lo = 0; a.ph_hi = N_PHASES;
    hipLaunchKernelGGL(fwd, dim3(grid), dim3(NTHREADS), LDS_BYTES, stream, a);
#else
    for (int p = 0; p < N_PHASES; ++p) { a.ph_lo = p; a.ph_hi = p + 1; hipLaunchKernelGGL(fwd, dim3(grid), dim3(NTHREADS), LDS_BYTES, stream, a);
#ifdef PROBE_REPEAT_PHASE
        if (p == PROBE_REPEAT_PHASE) hipLaunchKernelGGL(fwd, dim3(grid), dim3(NTHREADS), LDS_BYTES, stream, a);
#endif
    }
#endif
}
```

```cpp
#include <hip/hip_runtime.h>
#include <cstdio>
#include <cstdint>

#ifndef MK_ONE_LAUNCH
#define MK_ONE_LAUNCH 1
#endif

#define DI __device__ __forceinline__
#define GAS __attribute__((address_space(1)))
#define LAS __attribute__((address_space(3)))
typedef unsigned short bf16;
typedef short bf16x8 __attribute__((ext_vector_type(8)));
typedef float f32x4 __attribute__((ext_vector_type(4)));
typedef float f32x2 __attribute__((ext_vector_type(2)));
typedef unsigned u32x4 __attribute__((ext_vector_type(4)));
typedef unsigned u32x2 __attribute__((ext_vector_type(2)));

constexpr int D = 1024, NB = 4, SEQ = 4096, M = NB * SEQ;
constexpr int MEML = 256, MROWS = NB * MEML;
constexpr int LRU_W = 512, RW = 512, NH = 8, HD = 64;
constexpr int INW = 2816;
constexpr int XH = 4, XHD = 256;
constexpr int NE = 32, TOPK = 4, DFF = 1024;
constexpr int NASSIGN = M * TOPK;
constexpr int MAXTILES = 288, MAXROWS = MAXTILES * 256;
constexpr float EPS = 1e-6f, GN_EPS = 64e-5f;

DI int fresh_tid() { int t = threadIdx.x; asm volatile("" : "+v"(t)); return t; }
namespace pg8 {
constexpr int BM = 256, BK = 64, HALF = 128, HTB = HALF * BK * 2, STAGE_BYTES = 8 * HTB, NXCD = 8, WGM = 8;
__host__ __device__ __forceinline__ int lds_byte(int r, int c) { const int st = (r >> 4) * 2 + (c >> 5), rr = r & 15, cc = c & 31, ob = rr * 64 + cc * 2; return st * 1024 + (ob ^ (((ob >> 9) & 1) << 5)); }
__host__ __device__ __forceinline__ void stage_rc(int b, int& R, int& C) { const int st = b / 1024, sb = b % 1024, swz = sb ^ (((sb >> 9) & 1) << 5); R = (st >> 1) * 16 + swz / 64; C = (st & 1) * 32 + (swz % 64) / 2; }
__host__ __device__ __forceinline__ int perm32(int rho) { const int n = rho >> 4, i = rho & 15; return 8 * (i >> 2) + 4 * n + (i & 3); }

struct Unit { int pm, pn, e; };

struct StaticOrder {
    int nM, nN, nwg, G, c;
    __host__ __device__ void init_tiles(int nM_, int nN_, int G_, int c_) { nM = nM_; nN = nN_; nwg = nM * nN; G = G_; c = c_; }
    __host__ __device__ bool next(int i, Unit& u) const {
        const long L = (long)i * G + c; if (L >= nwg) return false;
        int wgid = (int)L; { const int q = nwg / NXCD, r = nwg % NXCD, xcd = wgid % NXCD, off = wgid / NXCD; wgid = (xcd < r ? xcd * (q + 1) : r * (q + 1) + (xcd - r) * q) + off; }
        const int nig = WGM * nN, gid = wgid / nig, fm = gid * WGM, gsz = (nM - fm) < WGM ? (nM - fm) : WGM;
        u.pm = fm + ((wgid % nig) % gsz); u.pn = (wgid % nig) / gsz; u.e = 0; return true;
    }
};
struct DenseSched {
    static constexpr bool GATHER = false;
    StaticOrder o; const char* A; const char* B; size_t tstep;
    DI bool next(int i, Unit& u) const { return o.next(i, u); }
    DI const char* a_ptr(const Unit& u) const { return A + (size_t)u.pm * tstep; }
    DI const char* b_ptr(const Unit& u) const { return B + (size_t)u.pn * tstep; }
    DI void a_voff(const Unit&, int K, const int (&R)[2], const int (&C)[2], unsigned (&vo)[2][2]) const {
#pragma unroll
        for (int h = 0; h < 2; ++h)
#pragma unroll
            for (int i = 0; i < 2; ++i) vo[h][i] = (unsigned)((h * HALF + R[i]) * K + C[i]) * 2u; }
};
struct MoeSched {
    static constexpr bool GATHER = false;
    StaticOrder o; const char* A; const char* B; const int* tile_e; size_t tstep, estep;
    DI bool next(int i, Unit& u) const { if (!o.next(i, u)) return false; u.e = tile_e[u.pm]; return true; }
    DI const char* a_ptr(const Unit& u) const { return A + (size_t)u.pm * tstep; }
    DI const char* b_ptr(const Unit& u) const { return B + (size_t)u.e * estep + (size_t)u.pn * tstep; }
    DI void a_voff(const Unit&, int K, const int (&R)[2], const int (&C)[2], unsigned (&vo)[2][2]) const {
#pragma unroll
        for (int h = 0; h < 2; ++h)
#pragma unroll
            for (int i = 0; i < 2; ++i) vo[h][i] = (unsigned)((h * HALF + R[i]) * K + C[i]) * 2u; }
};
struct MoeGatherSched {
    static constexpr bool GATHER = true;
    StaticOrder o; const char* A; const char* B; const int* tile_e; const int* rtok; size_t tstep, estep;
    DI bool next(int i, Unit& u) const { if (!o.next(i, u)) return false; u.e = tile_e[u.pm]; return true; }
    DI const char* a_ptr(const Unit&) const { return A; }
    DI const char* b_ptr(const Unit& u) const { return B + (size_t)u.e * estep + (size_t)u.pn * tstep; }
    DI void a_voff(const Unit& u, int K, const int (&R)[2], const int (&C)[2], unsigned (&vo)[2][2]) const {
#pragma unroll
        for (int h = 0; h < 2; ++h)
#pragma unroll
            for (int i = 0; i < 2; ++i) vo[h][i] = (unsigned)(rtok[u.pm * BM + h * HALF + R[i]] * K + C[i]) * 2u; }
};

DI unsigned cvt_pk_bf16(float lo, float hi) { unsigned r; asm volatile("v_cvt_pk_bf16_f32 %0, %1, %2" : "=v"(r) : "v"(lo), "v"(hi)); return r; }

template <class Epi, class Sched, bool ALIGN_EPI = true>
DI void gemm_phase(LAS unsigned char* lds, const int K, const Sched& S, const Epi& E) {
    const int tid = fresh_tid(), wid = __builtin_amdgcn_readfirstlane(tid >> 6), lane = tid & 63, wr = wid >> 2, wc = wid & 3, fr = lane & 15, fq = lane >> 4;
    const int nt = K / BK;
    constexpr bool GA = Sched::GATHER;
    unsigned voffA[2][2], voffAn[2][2], voffB[2]; int sR[2], sC[2];
#pragma unroll
    for (int i = 0; i < 2; ++i) { int R, C; stage_rc(tid * 16 + i * 8192, R, C); const int Rb = Epi::PERM ? ((R & ~31) + perm32(R & 31)) : R;
        sR[i] = R; sC[i] = C; voffB[i] = (unsigned)(Rb * K + C) * 2u; }
    const size_t kstep = (size_t)(BK * 2);
    const size_t hstep = (size_t)HALF * K * 2;
    const unsigned ldsw = (unsigned)wid * 1024u;
    const int aoff = lds_byte(wr * 64 + fr, fq * 8), boff = lds_byte(wc * 32 + fr, fq * 8);
#define PG8_SA(b, h) (((b) * 2 + (h)) * HTB)
#define PG8_SB(b, h) ((4 + (b) * 2 + (h)) * HTB)
#define PG8_STAGE(bufoff, gbase, voff) do { _Pragma("unroll") for (int _i = 0; _i < 2; ++_i) \
        __builtin_amdgcn_global_load_lds((const unsigned*)((const char*)(gbase) + (voff)[_i]), (LAS unsigned*)(lds + (bufoff) + ldsw + _i * 8192), 16, 0, 0); } while (0)
#define PG8_LDA(dst, b, h) do { _Pragma("unroll") for (int m = 0; m < 4; ++m) _Pragma("unroll") for (int k = 0; k < 2; ++k) dst[m][k] = *(const LAS bf16x8*)(lds + PG8_SA(b, h) + aoff + m * 2048 + k * 1024); } while (0)
#define PG8_LDB(dst, b, h) do { _Pragma("unroll") for (int n = 0; n < 2; ++n) _Pragma("unroll") for (int k = 0; k < 2; ++k) dst[n][k] = *(const LAS bf16x8*)(lds + PG8_SB(b, h) + boff + n * 2048 + k * 1024); } while (0)
#define PG8_MMA(ai, bj, At, Bt) do { __builtin_amdgcn_s_setprio(1); _Pragma("unroll") for (int m = 0; m < 4; ++m) _Pragma("unroll") for (int n = 0; n < 2; ++n) _Pragma("unroll") for (int k = 0; k < 2; ++k) \
        acc[ai][bj][m][n] = __builtin_amdgcn_mfma_f32_16x16x32_bf16(Bt[n][k], At[m][k], acc[ai][bj][m][n], 0, 0, 0); __builtin_amdgcn_s_setprio(0); } while (0)
#define PG8_WAIT_V(n) asm volatile("s_waitcnt vmcnt(" #n ")" ::: "memory")
#define PG8_WAIT_L(n) asm volatile("s_waitcnt lgkmcnt(" #n ")" ::: "memory")
#define PG8_BAR __builtin_amdgcn_s_barrier()
#define PG8_SCHED __builtin_amdgcn_sched_barrier(0)
    Unit cur, nxt; int ui = 0;
    if (!S.next(0, cur)) return;
    f32x4 acc[2][2][4][2];
#pragma unroll
    for (int a = 0; a < 2; ++a)
#pragma unroll
        for (int b = 0; b < 2; ++b)
#pragma unroll
            for (int m = 0; m < 4; ++m)
#pragma unroll
                for (int n = 0; n < 2; ++n) acc[a][b][m][n] = (f32x4){0.f, 0.f, 0.f, 0.f};
    bf16x8 At[4][2], B0[2][2], B1[2][2];
    const char* cA = S.a_ptr(cur); const char* cB = S.b_ptr(cur);
    S.a_voff(cur, K, sR, sC, voffA);
#define PG8_STAGE_A(bufoff, kbase, h, vo) do { if constexpr (GA) { PG8_STAGE(bufoff, kbase, (vo)[h]); } else { PG8_STAGE(bufoff, (kbase) + (h) * hstep, voffA[0]); } } while (0)
    PG8_STAGE(PG8_SB(0, 0), cB, voffB); PG8_STAGE(PG8_SB(0, 1), cB + hstep, voffB); PG8_STAGE_A(PG8_SA(0, 0), cA, 0, voffA); PG8_STAGE_A(PG8_SA(0, 1), cA, 1, voffA);
    if (wr == 1) PG8_BAR;
    PG8_WAIT_V(2); PG8_BAR;
    PG8_STAGE(PG8_SB(1, 0), cB + kstep, voffB); PG8_STAGE_A(PG8_SA(1, 0), cA + kstep, 0, voffA); PG8_STAGE(PG8_SB(1, 1), cB + hstep + kstep, voffB);
    PG8_WAIT_V(6); PG8_BAR;
    for (;;) {
        const bool has_next = S.next(ui + 1, nxt);
        const char* nA = has_next ? S.a_ptr(nxt) : cA; const char* nB = has_next ? S.b_ptr(nxt) : cB;
        if constexpr (GA) { if (has_next) S.a_voff(nxt, K, sR, sC, voffAn);
            else {
#pragma unroll
                for (int h = 0; h < 2; ++h)
#pragma unroll
                    for (int i = 0; i < 2; ++i) voffAn[h][i] = voffA[h][i]; } }
        for (int t = 0; t < nt; t += 2) {
            const bool last = (t == nt - 2);
            const char* a1 = cA + (size_t)(t + 1) * kstep;
            const char* a2 = last ? nA : cA + (size_t)(t + 2) * kstep; const char* b2 = last ? nB : cB + (size_t)(t + 2) * kstep;
            const char* a3 = a2 + kstep; const char* b3 = b2 + kstep;
            unsigned vs[2][2];
            if constexpr (GA) {
#pragma unroll
                for (int i = 0; i < 2; ++i) { vs[0][i] = last ? voffAn[0][i] : voffA[0][i]; vs[1][i] = last ? voffAn[1][i] : voffA[1][i]; } }
            PG8_LDB(B0, 0, 0); PG8_LDB(B1, 0, 1); PG8_SCHED; PG8_LDA(At, 0, 0); PG8_STAGE_A(PG8_SA(1, 1), a1, 1, voffA);
            PG8_WAIT_V(8); PG8_WAIT_L(0); PG8_BAR; PG8_MMA(0, 0, At, B0); PG8_MMA(0, 1, At, B1); PG8_BAR; PG8_SCHED;
            PG8_LDA(At, 0, 1); PG8_STAGE(PG8_SB(0, 0), b2, voffB); PG8_STAGE(PG8_SB(0, 1), b2 + hstep, voffB); PG8_STAGE_A(PG8_SA(0, 0), a2, 0, vs);
            PG8_WAIT_V(8); PG8_WAIT_L(0); PG8_BAR; PG8_MMA(1, 0, At, B0); PG8_MMA(1, 1, At, B1); PG8_BAR; PG8_SCHED;
            PG8_LDB(B0, 1, 0); PG8_LDB(B1, 1, 1); PG8_SCHED; PG8_LDA(At, 1, 0); PG8_STAGE_A(PG8_SA(0, 1), a2, 1, vs);
            PG8_WAIT_V(8); PG8_WAIT_L(0); PG8_BAR; PG8_MMA(0, 0, At, B0); PG8_MMA(0, 1, At, B1); PG8_BAR; PG8_SCHED;
            PG8_LDA(At, 1, 1); PG8_STAGE(PG8_SB(1, 0), b3, voffB); PG8_STAGE(PG8_SB(1, 1), b3 + hstep, voffB); PG8_STAGE_A(PG8_SA(1, 0), a3, 0, vs);
            PG8_WAIT_V(8); PG8_WAIT_L(0); PG8_BAR; PG8_MMA(1, 0, At, B0); PG8_MMA(1, 1, At, B1); PG8_BAR; PG8_SCHED;
        }
        if constexpr (ALIGN_EPI) { if (wr == 0) PG8_BAR; }
        E(acc, cur, wr, wc, fr, fq);
        if (!has_next) break;
#pragma unroll
        for (int a = 0; a < 2; ++a)
#pragma unroll
            for (int b = 0; b < 2; ++b)
#pragma unroll
                for (int m = 0; m < 4; ++m)
#pragma unroll
                    for (int n = 0; n < 2; ++n) acc[a][b][m][n] = (f32x4){0.f, 0.f, 0.f, 0.f};
        cur = nxt; cA = nA; cB = nB; ++ui;
        if constexpr (GA) {
#pragma unroll
            for (int h = 0; h < 2; ++h)
#pragma unroll
                for (int i = 0; i < 2; ++i) voffA[h][i] = voffAn[h][i]; }
        if constexpr (ALIGN_EPI) { if (wr == 1) PG8_BAR; }
    }
    PG8_WAIT_V(0);
    if constexpr (!ALIGN_EPI) { if (wr == 0) PG8_BAR; }
    PG8_BAR;
#undef PG8_SA
#undef PG8_SB
#undef PG8_STAGE
#undef PG8_STAGE_A
#undef PG8_LDA
#undef PG8_LDB
#undef PG8_MMA
#undef PG8_WAIT_V
#undef PG8_WAIT_L
#undef PG8_BAR
#undef PG8_SCHED
}
}
using pg8::Unit;
using pg8::cvt_pk_bf16;

DI float bflo(unsigned w) { return __uint_as_float(w << 16); }
DI float bfhi(unsigned w) { return __uint_as_float(w & 0xffff0000u); }
DI float bf2f(bf16 b) { return __uint_as_float(((unsigned)b) << 16); }
DI unsigned f2bf(float f) { unsigned u = __float_as_uint(f); return (u + 0x7fffu + ((u >> 16) & 1u)) >> 16; }
DI unsigned pk2(float lo, float hi) { return f2bf(lo) | (f2bf(hi) << 16); }
DI float sigmoid_f(float x) { return 1.0f / (1.0f + __expf(-x)); }
DI float softplus_f(float x) { return fmaxf(x, 0.f) + log1pf(__expf(-fabsf(x))); }
DI float softplus_fast(float x) { return fmaxf(x, 0.f) + __logf(1.0f + __expf(-fabsf(x))); }
DI float gelu_tanh_f(float x) { const float u = 0.7978845608028654f * (x + 0.044715f * x * x * x); return 0.5f * x * (1.0f + tanhf(u)); }
DI float wave_sum(float v) {
#pragma unroll
    for (int o = 1; o < 64; o <<= 1) v += __shfl_xor(v, o);
    return v;
}

struct EpiBf16Plain {
    static constexpr bool PERM = true;
    bf16* O; int ldc; float scale;
    DI void operator()(const f32x4 (&acc)[2][2][4][2], const Unit& u, int wr, int wc, int fr, int fq) const {
        const int row0 = u.pm * 256 + wr * 64 + fr, col0 = u.pn * 256 + wc * 32 + 8 * fq;
#pragma unroll
        for (int ai = 0; ai < 2; ++ai)
#pragma unroll
            for (int m = 0; m < 4; ++m) { bf16* rowp = O + (size_t)(row0 + ai * 128 + m * 16) * ldc + col0;
#pragma unroll
                for (int bj = 0; bj < 2; ++bj) { const f32x4 v0 = acc[ai][bj][m][0] * scale, v1 = acc[ai][bj][m][1] * scale;
                    u32x4 w; w.x = cvt_pk_bf16(v0[0], v0[1]); w.y = cvt_pk_bf16(v0[2], v0[3]); w.z = cvt_pk_bf16(v1[0], v1[1]); w.w = cvt_pk_bf16(v1[2], v1[3]);
                    *(u32x4*)(rowp + bj * 128) = w; } }
    }
};
struct EpiF32Res {
    static constexpr bool PERM = false;
    const float* Rz; float* C; int ldc;
    DI void operator()(const f32x4 (&acc)[2][2][4][2], const Unit& u, int wr, int wc, int fr, int fq) const {
        const int row0 = u.pm * 256 + wr * 64 + fr, col0 = u.pn * 256 + wc * 32 + 4 * fq;
#pragma unroll
        for (int ai = 0; ai < 2; ++ai)
#pragma unroll
            for (int m = 0; m < 4; ++m) { const size_t off = (size_t)(row0 + ai * 128 + m * 16) * ldc + col0;
#pragma unroll
                for (int bj = 0; bj < 2; ++bj)
#pragma unroll
                    for (int n = 0; n < 2; ++n) { const f32x4 r = *(const f32x4*)(Rz + off + bj * 128 + n * 16); *(f32x4*)(C + off + bj * 128 + n * 16) = r + acc[ai][bj][m][n]; } }
    }
};
struct EpiLora {
    static constexpr bool PERM = false;
    float* LWp; bf16* AAp; bf16* GGp; const float* w0; const float* a0;
    DI void operator()(const f32x4 (&acc)[2][2][4][2], const Unit& u, int wr, int wc, int fr, int fq) const {
        const int kind = u.pn >> 1;
        const int row0 = u.pm * 256 + wr * 64 + fr, col0 = (u.pn & 1) * 256 + wc * 32 + 4 * fq;
#pragma unroll
        for (int bj = 0; bj < 2; ++bj)
#pragma unroll
            for (int n = 0; n < 2; ++n) {
                const int c = col0 + bj * 128 + n * 16;
                f32x4 bias = (f32x4){0.f, 0.f, 0.f, 0.f};
                if (kind == 0) bias = *(const f32x4*)(w0 + c); else if (kind == 1) bias = *(const f32x4*)(a0 + c);
#pragma unroll
                for (int ai = 0; ai < 2; ++ai)
#pragma unroll
                    for (int m = 0; m < 4; ++m) {
                        f32x4 v = acc[ai][bj][m][n] + bias;
                        if (kind == 0) {
#pragma unroll
                            for (int j = 0; j < 4; ++j) { const float w = -softplus_fast(-v[j]) - 0.5f; v[j] = -__expf(w);     }
                        } else if (kind == 1) {
#pragma unroll
                            for (int j = 0; j < 4; ++j) v[j] = sigmoid_f(v[j]);
                        }
                        const size_t o_ = (size_t)(row0 + ai * 128 + m * 16) * 512 + c;
                        if (kind == 0) *(f32x4*)(LWp + o_) = v;
                        else { u32x2 w_; w_.x = cvt_pk_bf16(v[0], v[1]); w_.y = cvt_pk_bf16(v[2], v[3]); *(u32x2*)((kind == 1 ? AAp : GGp) + o_) = w_; }
                    }
            }
    }
};
struct EpiSwiglu {
    static constexpr bool PERM = true;
    bf16* ACT; const float* b_gu;
    DI void operator()(const f32x4 (&acc)[2][2][4][2], const Unit& u, int wr, int wc, int fr, int fq) const {
        const int row0 = u.pm * 256 + wr * 64 + fr, j0 = u.pn * 128 + wc * 32 + 8 * fq;
        const float* bg = b_gu + (size_t)u.e * 2048 + j0; const float* bu = bg + 1024;
        const f32x4 bg0 = *(const f32x4*)bg, bg1 = *(const f32x4*)(bg + 4), bu0 = *(const f32x4*)bu, bu1 = *(const f32x4*)(bu + 4);
#pragma unroll
        for (int ai = 0; ai < 2; ++ai)
#pragma unroll
            for (int m = 0; m < 4; ++m) {
                float o[8];
#pragma unroll
                for (int n = 0; n < 2; ++n) { const f32x4 g4 = acc[ai][0][m][n] + (n ? bg1 : bg0), u4 = acc[ai][1][m][n] + (n ? bu1 : bu0);
#pragma unroll
                    for (int j = 0; j < 4; ++j) { const float g = fminf(g4[j], 7.0f), up = fminf(fmaxf(u4[j], -7.0f), 7.0f); o[n * 4 + j] = (up + 1.0f) * (g * sigmoid_f(1.702f * g)); } }
                u32x4 w; w.x = cvt_pk_bf16(o[0], o[1]); w.y = cvt_pk_bf16(o[2], o[3]); w.z = cvt_pk_bf16(o[4], o[5]); w.w = cvt_pk_bf16(o[6], o[7]);
                *(u32x4*)(ACT + (size_t)(row0 + ai * 128 + m * 16) * 1024 + j0) = w;
            }
    }
};
struct EpiDown {
    static constexpr bool PERM = true;
    bf16* YS; const float* b_dn; const int* row_slot; const float* row_gate;
    DI void operator()(const f32x4 (&acc)[2][2][4][2], const Unit& u, int wr, int wc, int fr, int fq) const {
        const int row0 = u.pm * 256 + wr * 64 + fr, col0 = u.pn * 256 + wc * 32 + 8 * fq;
        const float* bb = b_dn + (size_t)u.e * 1024 + col0;
        f32x4 bv[2][2];
#pragma unroll
        for (int bj = 0; bj < 2; ++bj)
#pragma unroll
            for (int n = 0; n < 2; ++n) bv[bj][n] = *(const f32x4*)(bb + bj * 128 + 4 * n);
#pragma unroll
        for (int ai = 0; ai < 2; ++ai)
#pragma unroll
            for (int m = 0; m < 4; ++m) {
                const int r = row0 + ai * 128 + m * 16; const int slot = row_slot[r]; const float gt = row_gate[r];
                if (slot >= 0) { bf16* rowp = YS + (size_t)slot * 1024 + col0;
#pragma unroll
                    for (int bj = 0; bj < 2; ++bj) { const f32x4 v0 = (acc[ai][bj][m][0] + bv[bj][0]) * gt, v1 = (acc[ai][bj][m][1] + bv[bj][1]) * gt;
                        u32x4 w; w.x = cvt_pk_bf16(v0[0], v0[1]); w.y = cvt_pk_bf16(v0[2], v0[3]); w.z = cvt_pk_bf16(v1[0], v1[1]); w.w = cvt_pk_bf16(v1[2], v1[3]);
                        *(u32x4*)(rowp + bj * 128) = w; } }
            }
    }
};

constexpr size_t MiB = 1u << 20;
constexpr size_t WS_CTL = 0, CTL_ZERO_BYTES = 1 * MiB;
constexpr size_t WS_WIN = 1 * MiB, WS_WOUT = 7 * MiB, WS_WQ = 9 * MiB, WS_WK = 11 * MiB, WS_WV = 13 * MiB, WS_WO = 15 * MiB, WS_LORAB = 17 * MiB, WS_LRUW = 18 * MiB;
constexpr size_t WS_ROUTE = 19 * MiB;
constexpr size_t WS_WGU = 22 * MiB, WS_WDN = 150 * MiB;
constexpr size_t WS_HN = 214 * MiB, WS_MEMN = 246 * MiB, WS_KM = 248 * MiB, WS_VT = 250 * MiB;
constexpr size_t WS_X1 = 252 * MiB, WS_X2 = 316 * MiB;
constexpr size_t WS_U = 380 * MiB, WS_R = 468 * MiB, WS_KRAW = 500 * MiB, WS_V = 532 * MiB, WS_KKN = 564 * MiB, WS_WD = 596 * MiB, WS_AA = 628 * MiB, WS_G = 660 * MiB;
constexpr size_t WS_LA = 692 * MiB, WS_LB = 724 * MiB, WS_AP = 756 * MiB, WS_CAT = 764 * MiB, WS_Q = 796 * MiB;
constexpr size_t WS_XS = 380 * MiB, WS_ACT = 524 * MiB, WS_YS = 668 * MiB;
constexpr size_t WS_GP = 796 * MiB, WS_HF = 860 * MiB, WS_RP = 924 * MiB, WS_Y1F = 940 * MiB, WS_ADD = 972 * MiB, WS_END = 1004 * MiB;
constexpr size_t WS_GC = 468 * MiB, WS_HC = 484 * MiB, WS_ZS = 500 * MiB;
static_assert(WS_AA == WS_WD + 32 * MiB && WS_G == WS_AA + 32 * MiB, "EpiLora strides");
static_assert(WS_U + (size_t)M * INW * 2 <= WS_R && WS_XS + (size_t)MAXROWS * 2048 <= WS_ACT && WS_ACT + (size_t)MAXROWS * 2048 <= WS_YS && WS_YS + (size_t)NASSIGN * 2048 <= WS_Q, "ws map");
constexpr size_t RT_E = 0, RT_POS = 256 * 1024, RT_G = 512 * 1024, RT_SLOT = 768 * 1024, RT_GATE = 1088 * 1024, RT_TILE = 1408 * 1024, RT_TOK = 1472 * 1024;
constexpr int CW_BAR = 4096, CW_CNT = 8192;

constexpr int RING_BYTES = 131072, MISC_OFF = RING_BYTES + 320, LDS_BYTES = 147456;
constexpr int NWAVES = 8, NTHREADS = 512;

#define XB_TMO      128
#define XB_XCNT(j)  (256  + 64 * (j))
#define XB_XSUB(j)  (1280 + 64 * (j))
#define XB_XGEN(j)  (2304 + 64 * (j))
#define XB_TOP      3328
#define XB_TOPGEN   3392
#define XCD_BAR_WORDS 3456
#define XB_SPIN_CAP (1u << 18)
DI unsigned xb_ld(unsigned* p)              { return __hip_atomic_load(p, __ATOMIC_RELAXED, __HIP_MEMORY_SCOPE_AGENT); }
DI unsigned xb_add(unsigned* p, unsigned v) { return __hip_atomic_fetch_add(p, v, __ATOMIC_RELAXED, __HIP_MEMORY_SCOPE_AGENT); }
DI unsigned xb_xcc_id() { return (unsigned)__builtin_amdgcn_s_getreg((3 << 11) | 20) & 0xFu; }
#define XB_SPIN(cond, bar) do { unsigned _sp = 0; while (cond) { __builtin_amdgcn_s_sleep(1); \
    if ((++_sp & 255u) == 0u) { if (xb_ld(&(bar)[XB_TMO])) break; if (_sp > XB_SPIN_CAP) { atomicAdd(&(bar)[XB_TMO], 1u); break; } } } } while (0)
struct XcdBarrier { unsigned* bar; unsigned x; volatile LAS unsigned* st; };
DI XcdBarrier xcd_barrier_post(unsigned* bar, volatile LAS unsigned* st) {
    XcdBarrier b; b.bar = bar; b.x = xb_xcc_id(); b.st = st;
    if (threadIdx.x == 0) (void)xb_add(&bar[XB_XCNT(b.x)], 1u);
    return b;
}
DI void xcd_barrier_complete(unsigned* bar, unsigned x, unsigned& nloc, unsigned& nx) {
    const unsigned G = gridDim.x * gridDim.y * gridDim.z;
    unsigned sum, cnt, mine, sp = 0u;
    for (;;) {
        sum = 0u; cnt = 0u; mine = 0u;
#pragma unroll
        for (unsigned j = 0; j < 16; ++j) { const unsigned c = xb_ld(&bar[XB_XCNT(j)]); sum += c; cnt += (c > 0u) ? 1u : 0u; mine = (j == x) ? c : mine; }
        if (sum == G) break;
        __builtin_amdgcn_s_sleep(1);
        if ((++sp & 255u) == 0u) { if (xb_ld(&bar[XB_TMO])) break; if (sp > XB_SPIN_CAP) { atomicAdd(&bar[XB_TMO], 1u); break; } }
    }
    nloc = mine > 0u ? mine : 1u; nx = cnt > 0u ? cnt : 1u;
}
DI void xcd_barrier(const XcdBarrier& b) {
    asm volatile("s_waitcnt vmcnt(0)" ::: "memory");
    __syncthreads();
    if (threadIdx.x == 0) {
        unsigned* bar = b.bar;
        __builtin_amdgcn_s_waitcnt(0);
        unsigned nloc = b.st[0], nx = b.st[1];
        if (nloc == 0u) { xcd_barrier_complete(bar, b.x, nloc, nx); b.st[0] = nloc; b.st[1] = nx; }
        const unsigned old = xb_add(&bar[XB_XSUB(b.x)], 1u);
        const unsigned gen = old / nloc;
        if (old + 1u == (gen + 1u) * nloc) {
            __builtin_amdgcn_fence(__ATOMIC_RELEASE, "agent");
            asm volatile("s_waitcnt vmcnt(0)" ::: "memory");
            const unsigned og = xb_add(&bar[XB_TOP], 1u);
            const unsigned tg = og / nx;
            if (og + 1u == (tg + 1u) * nx) xb_add(&bar[XB_TOPGEN], 1u);
            else XB_SPIN(xb_ld(&bar[XB_TOPGEN]) == tg, bar);
            __builtin_amdgcn_fence(__ATOMIC_ACQUIRE, "agent");
            xb_add(&bar[XB_XGEN(b.x)], 1u);
            asm volatile("s_waitcnt vmcnt(0)" ::: "memory");
        } else {
            XB_SPIN(xb_ld(&bar[XB_XGEN(b.x)]) == gen, bar);
            __builtin_amdgcn_fence(__ATOMIC_ACQUIRE, "agent");
            asm volatile("s_waitcnt vmcnt(0)" ::: "memory");
        }
    }
    __syncthreads();
}

struct Args { const float* in[37]; float* out; unsigned char* ws; int ph_lo, ph_hi; };
enum { I_X = 0, I_MEM, I_NMIXG, I_WIN, I_CONVW, I_CONVB, I_LWX, I_LBX, I_LWA, I_LBA, I_LAM, I_MU, I_W0, I_WUP, I_A0, I_AUP, I_GUP, I_KK, I_KA, I_RK, I_LNG, I_LNB,
       I_WOUT, I_NXAG, I_NMEMG, I_WQ, I_WK, I_WV, I_WO, I_NFFG, I_WR, I_BR, I_WGU, I_BGU, I_WDN, I_BDN, I_FNG };

DI void transpose_item(const float* W, int ldw, int K, bf16* WT, int k0, int n0, int drow0, LAS float* scr, int lane) {
#pragma unroll 8
    for (int i = 0; i < 32; ++i) { const int kk = 2 * i + (lane >> 5); scr[kk * 33 + (lane & 31)] = W[(size_t)(k0 + kk) * ldw + n0 + (lane & 31)]; }
    asm volatile("s_waitcnt lgkmcnt(0)" ::: "memory");
    const int c = lane & 7;
#pragma unroll
    for (int j = 0; j < 4; ++j) { const int n = (lane >> 3) + 8 * j; const LAS float* s = scr + (8 * c) * 33 + n;
        u32x4 o; o.x = pk2(s[0 * 33], s[1 * 33]); o.y = pk2(s[2 * 33], s[3 * 33]); o.z = pk2(s[4 * 33], s[5 * 33]); o.w = pk2(s[6 * 33], s[7 * 33]);
        *(u32x4*)(WT + (size_t)(drow0 + n) * K + k0 + 8 * c) = o; }
    asm volatile("s_waitcnt lgkmcnt(0)" ::: "memory");
}
DI void rms_row_to_bf16(const float* xrow, const float* g, bf16* orow, int lane) {
    const f32x4* xr = (const f32x4*)xrow + lane; const f32x4* gr = (const f32x4*)g + lane;
    f32x4 v[4]; float s = 0.f;
#pragma unroll
    for (int j = 0; j < 4; ++j) { v[j] = xr[64 * j]; s += (v[j].x * v[j].x + v[j].y * v[j].y) + (v[j].z * v[j].z + v[j].w * v[j].w); }
    const float rstd = 1.0f / sqrtf(wave_sum(s) * (1.f / D) + EPS);
    u32x2* o8 = (u32x2*)orow + lane;
#pragma unroll
    for (int j = 0; j < 4; ++j) { const f32x4 gg = gr[64 * j]; u32x2 w; w.x = pk2(v[j].x * rstd * gg.x, v[j].y * rstd * gg.y); w.y = pk2(v[j].z * rstd * gg.z, v[j].w * rstd * gg.w); o8[64 * j] = w; }
}

__global__ void __launch_bounds__(NTHREADS, 2) fwd(Args args) {
    extern __shared__ __attribute__((aligned(16))) unsigned char lds_raw[];
    LAS unsigned char* lds = (LAS unsigned char*)lds_raw;
    volatile LAS unsigned* MISC = (volatile LAS unsigned*)(lds + MISC_OFF);
    const int G = gridDim.x, bid = blockIdx.x, NGW = G * NWAVES;
#define PHASE_IDS const int tid = fresh_tid(), lane = tid & 63, wave = __builtin_amdgcn_readfirstlane(tid >> 6), gw = bid * NWAVES + wave; (void)tid; (void)lane; (void)wave; (void)gw
    unsigned char* ws = args.ws;
    unsigned* ctl = (unsigned*)(ws + WS_CTL);
    const int lo = args.ph_lo, hi = args.ph_hi;

    for (int u = threadIdx.x; u < (LDS_BYTES - RING_BYTES) / 4; u += NTHREADS) ((LAS unsigned*)(lds + RING_BYTES))[u] = 0u;
    __syncthreads();
    XcdBarrier bar; bar.bar = ctl + CW_BAR; bar.x = 0; bar.st = nullptr;
    if (hi - lo > 1) bar = xcd_barrier_post(ctl + CW_BAR, MISC + 8);
#define IN(k) (lo <= (k) && (k) < hi)
#define SEAM(k) do { if (IN(k) && IN((k) + 1)) xcd_barrier(bar); } while (0)

#define Win_t ((bf16*)(ws + WS_WIN))
#define Wout_t ((bf16*)(ws + WS_WOUT))
#define Wq_t ((bf16*)(ws + WS_WQ))
#define Wk_t ((bf16*)(ws + WS_WK))
#define Wv_t ((bf16*)(ws + WS_WV))
#define Wo_t ((bf16*)(ws + WS_WO))
#define LoraB ((bf16*)(ws + WS_LORAB))
#define LruW ((bf16*)(ws + WS_LRUW))
#define Wgu_t ((bf16*)(ws + WS_WGU))
#define Wdn_t ((bf16*)(ws + WS_WDN))
#define HN ((bf16*)(ws + WS_HN))
#define MEMN ((bf16*)(ws + WS_MEMN))
#define KM ((bf16*)(ws + WS_KM))
#define VT ((bf16*)(ws + WS_VT))
#define X1 ((float*)(ws + WS_X1))
#define X2 ((float*)(ws + WS_X2))
#define U ((bf16*)(ws + WS_U))
#define Rr ((float*)(ws + WS_R))
#define KRAW ((float*)(ws + WS_KRAW))
#define Vv ((float*)(ws + WS_V))
#define KKN ((float*)(ws + WS_KKN))
#define WD ((float*)(ws + WS_WD))
#define AA ((float*)(ws + WS_AA))
#define GG ((float*)(ws + WS_G))
#define LA ((float*)(ws + WS_LA))
#define LB ((float*)(ws + WS_LB))
#define AP ((bf16*)(ws + WS_AP))
#define CAT ((bf16*)(ws + WS_CAT))
#define Qb ((bf16*)(ws + WS_Q))
#define Ob CAT
#define XS ((bf16*)(ws + WS_XS))
#define ACT ((bf16*)(ws + WS_ACT))
#define YS ((bf16*)(ws + WS_YS))
#define route_e ((int*)(ws + WS_ROUTE + RT_E))
#define route_pos ((int*)(ws + WS_ROUTE + RT_POS))
#define route_g ((float*)(ws + WS_ROUTE + RT_G))
#define row_slot ((int*)(ws + WS_ROUTE + RT_SLOT))
#define row_gate ((float*)(ws + WS_ROUTE + RT_GATE))
#define tile_tab ((int*)(ws + WS_ROUTE + RT_TILE))
#define row_tok ((int*)(ws + WS_ROUTE + RT_TOK))
#define ecnt (ctl + CW_CNT)

    if (IN(0)) { PHASE_IDS;
        LAS float* scr = (LAS float*)(lds + wave * 16384);
        constexpr int I_IN = 16 * (INW / 32), I_SQ = 16 * 32;
        constexpr int N_ITEMS = I_IN + 5 * I_SQ;
        for (int it = gw; it < N_ITEMS; it += NGW) {
            int r = it;
            if (r < I_IN) { const int nblk = INW / 32, kb = r / nblk, nb = r % nblk; transpose_item(args.in[I_WIN], INW, D, Win_t, 64 * kb, 32 * nb, 32 * nb, scr, lane); continue; } r -= I_IN;
            { const int w = r / I_SQ, q = r % I_SQ, kb = q / 32, nb = q % 32;
                const float* src = w == 0 ? args.in[I_WOUT] : w == 1 ? args.in[I_WQ] : w == 2 ? args.in[I_WK] : w == 3 ? args.in[I_WV] : args.in[I_WO];
                bf16* dst = w == 0 ? Wout_t : w == 1 ? Wq_t : w == 2 ? Wk_t : w == 3 ? Wv_t : Wo_t;
                transpose_item(src, D, D, dst, 64 * kb, 32 * nb, 32 * nb, scr, lane); }
        }
        for (int idx = bid * NTHREADS + tid; idx < 1536 * 256; idx += G * NTHREADS) {
            const int n = idx >> 8, k = idx & 255; float v = 0.f;
            if (n < 512) { if (k < 64) v = args.in[I_WUP][k * 512 + n]; }
            else if (n < 1024) { if (k >= 64 && k < 128) v = args.in[I_AUP][(k - 64) * 512 + (n - 512)]; }
            else { if (k >= 128) v = args.in[I_GUP][(k - 128) * 512 + (n - 1024)]; }
            LoraB[idx] = (bf16)f2bf(v);
        }
        for (int idx = bid * NTHREADS + tid; idx < 8 * 128 * 64; idx += G * NTHREADS) {
            const int nb = idx >> 13, col = (idx >> 6) & 127, k = idx & 63;
            const float v = col < 64 ? args.in[I_LWX][nb * 4096 + k * 64 + col] : args.in[I_LWA][nb * 4096 + k * 64 + (col - 64)];
            LruW[idx] = (bf16)f2bf(v);
        }
        for (int m = gw; m < M; m += NGW) rms_row_to_bf16(args.in[I_X] + (size_t)m * D, args.in[I_NMIXG], HN + (size_t)m * D, lane);
        for (int m = gw; m < MROWS; m += NGW) rms_row_to_bf16(args.in[I_MEM] + (size_t)m * D, args.in[I_NMEMG], MEMN + (size_t)m * D, lane);
    }
    SEAM(0);

    if (IN(1)) { PHASE_IDS;
        { pg8::DenseSched S; S.o.init_tiles(M / 256, INW / 256, G, bid); S.A = (const char*)HN; S.B = (const char*)Win_t; S.tstep = (size_t)256 * D * 2;
          EpiBf16Plain E{U, INW, 1.0f}; pg8::gemm_phase(lds, D, S, E); }
        { pg8::DenseSched S; S.o.init_tiles(MROWS / 256, D / 256, G, (bid + 64) & (G - 1)); S.A = (const char*)MEMN; S.B = (const char*)Wk_t; S.tstep = (size_t)256 * D * 2;
          EpiBf16Plain E{KM, D, 1.0f}; pg8::gemm_phase(lds, D, S, E); }
        { pg8::DenseSched S; S.o.init_tiles(D / 256, MROWS / 256, G, (bid + 48) & (G - 1)); S.A = (const char*)Wv_t; S.B = (const char*)MEMN; S.tstep = (size_t)256 * D * 2;
          EpiBf16Plain E{VT, MROWS, 1.0f}; pg8::gemm_phase(lds, D, S, E); }
    }
    SEAM(1);

    if (IN(2)) { PHASE_IDS;
        const float* mu = args.in[I_MU];
        for (int m = gw; m < M; m += NGW) {
            const bool hp = (m & (SEQ - 1)) != 0;
            const bf16* ur = U + (size_t)m * INW + 2560 + 4 * lane;
            const u32x2 cu = *(const u32x2*)ur; u32x2 pu = (u32x2){0u, 0u}; if (hp) pu = *(const u32x2*)(ur - INW);
            const f32x4 m4 = *(const f32x4*)(mu + 1536 + 4 * lane);
            f32x4 uu; { const float a0 = bflo(cu.x), a1 = bfhi(cu.x), a2 = bflo(cu.y), a3 = bfhi(cu.y), p0 = bflo(pu.x), p1 = bfhi(pu.x), p2 = bflo(pu.y), p3 = bfhi(pu.y);
                uu.x = a0 + (p0 - a0) * m4.x; uu.y = a1 + (p1 - a1) * m4.y; uu.z = a2 + (p2 - a2) * m4.z; uu.w = a3 + (p3 - a3) * m4.w; }
            f32x4 o = uu;
            if (lane < 16) { o.x = tanhf(uu.x); o.y = tanhf(uu.y); o.z = tanhf(uu.z); o.w = tanhf(uu.w); }
            else if (lane >= 32) { o.x = sigmoid_f(uu.x); o.y = sigmoid_f(uu.y); o.z = sigmoid_f(uu.z); o.w = sigmoid_f(uu.w); }
            u32x2 w; w.x = pk2(o.x, o.y); w.y = pk2(o.z, o.w); *(u32x2*)(AP + (size_t)m * 256 + 4 * lane) = w;
        }
        {
            const float* conv_w = args.in[I_CONVW]; const float* conv_b = args.in[I_CONVB]; const float* bx = args.in[I_LBX]; const float* ba = args.in[I_LBA]; const float* lam = args.in[I_LAM];
            LAS float* xs = (LAS float*)(lds + wave * 4096);
            const int i = lane & 15, kg = lane >> 4;
            for (int unit = gw; unit < (M / 16) * 2; unit += NGW) {
                const int tile = unit >> 1, nb0 = (unit & 1) * 4, m0 = tile * 16, s0 = m0 & (SEQ - 1);
                for (int nb = nb0; nb < nb0 + 4; ++nb) {
                    bf16x8 af[2];
#pragma unroll
                    for (int ks = 0; ks < 2; ++ks) {
                        const int chb = nb * 64 + 32 * ks + 8 * kg;
                        f32x4 x0 = *(const f32x4*)(conv_b + chb), x1 = *(const f32x4*)(conv_b + chb + 4);
#pragma unroll
                        for (int j = 0; j < 4; ++j) {
                            if (s0 + i - 3 + j >= 0) {
                                const u32x4 uw = *(const u32x4*)(U + (size_t)(m0 + i - 3 + j) * INW + chb);
                                const f32x4 w0 = *(const f32x4*)(conv_w + j * 512 + chb), w1 = *(const f32x4*)(conv_w + j * 512 + chb + 4);
                                x0.x += w0.x * bflo(uw.x); x0.y += w0.y * bfhi(uw.x); x0.z += w0.z * bflo(uw.y); x0.w += w0.w * bfhi(uw.y);
                                x1.x += w1.x * bflo(uw.z); x1.y += w1.y * bfhi(uw.z); x1.z += w1.z * bflo(uw.w); x1.w += w1.w * bfhi(uw.w);
                            }
                        }
                        *(LAS f32x4*)(xs + i * 64 + 32 * ks + 8 * kg) = x0; *(LAS f32x4*)(xs + i * 64 + 32 * ks + 8 * kg + 4) = x1;
                        u32x4 p; p.x = pk2(x0.x, x0.y); p.y = pk2(x0.z, x0.w); p.z = pk2(x1.x, x1.y); p.w = pk2(x1.z, x1.w);
                        af[ks] = __builtin_bit_cast(bf16x8, p);
                    }
                    f32x4 acc[8];
#pragma unroll
                    for (int ct = 0; ct < 8; ++ct) { acc[ct] = (f32x4){0.f, 0.f, 0.f, 0.f};
#pragma unroll
                        for (int ks = 0; ks < 2; ++ks) { const bf16x8 bfr = *(const bf16x8*)(LruW + ((size_t)(nb * 128 + 16 * ct + i) * 64 + 32 * ks + 8 * kg));
                            acc[ct] = __builtin_amdgcn_mfma_f32_16x16x32_bf16(af[ks], bfr, acc[ct], 0, 0, 0); } }
                    asm volatile("s_waitcnt lgkmcnt(0)" ::: "memory");
#pragma unroll
                    for (int ct = 0; ct < 4; ++ct) {
                        const int col = 16 * ct + i, ch = nb * 64 + col;
                        const float bxv = bx[ch], bav = ba[ch], sp = softplus_f(-lam[ch]);
#pragma unroll
                        for (int e = 0; e < 4; ++e) {
                            const int tok = 4 * kg + e;
                            const float gx = sigmoid_f(acc[ct][e] + bxv), ga = sigmoid_f(acc[ct + 4][e] + bav);
                            const float la = -8.0f * ga * sp, a = __expf(la), xcv = xs[tok * 64 + col];
                            const float bt = sqrtf(fmaxf(-expm1f(2.0f * la), 0.f)) * gx * xcv;
                            LA[(size_t)(m0 + tok) * 512 + ch] = a; LB[(size_t)(m0 + tok) * 512 + ch] = bt;
                        }
                    }
                }
            }
        }
    }
    SEAM(2);

    if (IN(3)) { PHASE_IDS;
        pg8::DenseSched S; S.o.init_tiles(M / 256, 1536 / 256, G, bid); S.A = (const char*)AP; S.B = (const char*)LoraB; S.tstep = (size_t)256 * 256 * 2;
        EpiLora E{WD, (bf16*)(ws + WS_AA), (bf16*)(ws + WS_G), args.in[I_W0], args.in[I_A0]}; pg8::gemm_phase(lds, 256, S, E);
    }
    SEAM(3);

#define RW_ZB(zz, zb) do { _Pragma("unroll") for (int ks_ = 0; ks_ < 2; ++ks_) { u32x4 p_; p_.x = pk2(zz[2 * ks_][0], zz[2 * ks_][1]); p_.y = pk2(zz[2 * ks_][2], zz[2 * ks_][3]); \
        p_.z = pk2(zz[2 * ks_ + 1][0], zz[2 * ks_ + 1][1]); p_.w = pk2(zz[2 * ks_ + 1][2], zz[2 * ks_ + 1][3]); zb[ks_] = __builtin_bit_cast(bf16x8, p_); } } while (0)
    if (IN(4)) { PHASE_IDS;
        for (int u64 = gw; u64 < NB * NH * (SEQ / 64); u64 += NGW) {
#pragma unroll 1
        for (int jj = 0; jj < 4; ++jj) {
        LAS unsigned char* wl = lds + wave * 16384;
        LAS bf16* Arm = (LAS bf16*)(wl); LAS bf16* Brm = (LAS bf16*)(wl + 2048); LAS bf16* Krm = (LAS bf16*)(wl + 4096); LAS bf16* Rrm = (LAS bf16*)(wl + 6144);
        LAS bf16* ATt = (LAS bf16*)(wl + 8192); LAS bf16* BTt = (LAS bf16*)(wl + 10240); LAS bf16* KTt = (LAS bf16*)(wl + 12288); LAS bf16* VTt = (LAS bf16*)(wl + 14336);
        LAS float* MabT = (LAS float*)(wl); LAS bf16* Mak = (LAS bf16*)(wl + 1024); LAS bf16* Mrb = (LAS bf16*)(wl + 1536); LAS bf16* Mrk = (LAS bf16*)(wl + 2048); LAS bf16* Tm = (LAS bf16*)(wl + 2560);
        LAS float* PLs = (LAS float*)(wl + 3072); LAS bf16* Q0T = (LAS bf16*)(wl + 4096);
        const int lane = fresh_tid() & 63, l15 = lane & 15, g = lane >> 4, te = lane >> 2, kq = lane & 3;
        const bf16x8 z8 = (bf16x8){0, 0, 0, 0, 0, 0, 0, 0};
        const f32x4 z4 = (f32x4){0.f, 0.f, 0.f, 0.f};
            const int un = u64 * 4 + jj;
            const int bh = un >> 8, c = un & 255, b = bh >> 3, h = bh & 7;
            const size_t mrow = (size_t)b * SEQ + c * 16 + te, off = mrow * 512 + h * 64 + 16 * kq;
            const int hc = h * 64 + 16 * kq;
            float cl[16], eP[16];
            {
                float lwv[16], rl[16], kl[16], vl[16], kn[16], av[16];
                const bool hp = (mrow & (SEQ - 1)) != 0;
                const bf16* ub = U + mrow * INW + 1024 + hc;
#pragma unroll
                for (int hh = 0; hh < 2; ++hh) {
#pragma unroll
                    for (int a3 = 0; a3 < 3; ++a3) {
                        const u32x4 cu = *(const u32x4*)(ub + 512 * a3 + 8 * hh); u32x4 pu = (u32x4){0u, 0u, 0u, 0u}; if (hp) pu = *(const u32x4*)(ub - INW + 512 * a3 + 8 * hh);
                        const f32x4 m0 = *(const f32x4*)(args.in[I_MU] + 512 * a3 + hc + 8 * hh), m1 = *(const f32x4*)(args.in[I_MU] + 512 * a3 + hc + 8 * hh + 4);
                        float o8[8];
#pragma unroll
                        for (int q = 0; q < 4; ++q) { const float c0 = bflo(cu[q]), c1 = bfhi(cu[q]), p0 = bflo(pu[q]), p1 = bfhi(pu[q]); const float mm0 = q < 2 ? m0[2 * q] : m1[2 * q - 4], mm1 = q < 2 ? m0[2 * q + 1] : m1[2 * q - 3];
                            o8[2 * q] = c0 + (p0 - c0) * mm0; o8[2 * q + 1] = c1 + (p1 - c1) * mm1; }
#pragma unroll
                        for (int q = 0; q < 8; ++q) { if (a3 == 0) rl[8 * hh + q] = o8[q]; else if (a3 == 1) kl[8 * hh + q] = o8[q]; else vl[8 * hh + q] = o8[q]; }
                    }
                    const u32x4 aw = *(const u32x4*)((const bf16*)(ws + WS_AA) + off + 8 * hh);
#pragma unroll
                    for (int q = 0; q < 4; ++q) { av[8 * hh + 2 * q] = bflo(aw[q]); av[8 * hh + 2 * q + 1] = bfhi(aw[q]); }
                }
                float ss = 0.f;
#pragma unroll
                for (int j4 = 0; j4 < 4; ++j4) { const f32x4 x = *(const f32x4*)(WD + off + 4 * j4), kk4 = *(const f32x4*)(args.in[I_KK] + hc + 4 * j4); lwv[4 * j4] = x.x; lwv[4 * j4 + 1] = x.y; lwv[4 * j4 + 2] = x.z; lwv[4 * j4 + 3] = x.w;
#pragma unroll
                    for (int q = 0; q < 4; ++q) { kn[4 * j4 + q] = kl[4 * j4 + q] * kk4[q]; ss += kn[4 * j4 + q] * kn[4 * j4 + q]; } }
                ss += __shfl_xor(ss, 1); ss += __shfl_xor(ss, 2);
                const float kinv = 1.0f / fmaxf(sqrtf(ss), 1e-12f);
#pragma unroll
                for (int j = 0; j < 16; ++j) { float x = lwv[j];
#pragma unroll
                    for (int sft = 4; sft < 64; sft <<= 1) { const float y = __shfl_up(x, sft); if (lane >= sft) x += y; }
                    cl[j] = x; }
                float bon = 0.f;
                u32x4 pa[2], pb[2], pk[2], pr[2];
#pragma unroll
                for (int j4 = 0; j4 < 4; ++j4) {
                    const f32x4 ka = *(const f32x4*)(args.in[I_KA] + hc + 4 * j4), rk = *(const f32x4*)(args.in[I_RK] + hc + 4 * j4);
                    float at4[4], bt4[4], kt4[4], rt4[4];
#pragma unroll
                    for (int q = 0; q < 4; ++q) { const int j = 4 * j4 + q;
                        const float p = __expf(cl[j]), pn = __expf(-cl[j]), pm1 = __expf(cl[j] - lwv[j]); eP[j] = p;
                        const float knj = kn[j] * kinv;
                        const float kp = kl[j] * (1.0f + (av[j] - 1.0f) * ka[q]);
                        at4[q] = -knj * pm1; bt4[q] = knj * av[j] * pn; kt4[q] = kp * pn; rt4[q] = rl[j] * p;
                        bon += rl[j] * kp * rk[q];
                        const int kk = 16 * kq + j;
                        ATt[kk * 16 + te] = (bf16)f2bf(at4[q]); BTt[kk * 16 + te] = (bf16)f2bf(bt4[q]); KTt[kk * 16 + te] = (bf16)f2bf(kt4[q]); VTt[kk * 16 + te] = (bf16)f2bf(vl[j]); }
                    const int hh = j4 >> 1, w2 = (j4 & 1) * 2;
                    pa[hh][w2] = pk2(at4[0], at4[1]); pa[hh][w2 + 1] = pk2(at4[2], at4[3]); pb[hh][w2] = pk2(bt4[0], bt4[1]); pb[hh][w2 + 1] = pk2(bt4[2], bt4[3]);
                    pk[hh][w2] = pk2(kt4[0], kt4[1]); pk[hh][w2 + 1] = pk2(kt4[2], kt4[3]); pr[hh][w2] = pk2(rt4[0], rt4[1]); pr[hh][w2 + 1] = pk2(rt4[2], rt4[3]);
                }
#pragma unroll
                for (int hh = 0; hh < 2; ++hh) { const int po = te * 64 + 8 * ((2 * kq + hh) ^ (te & 7));
                    *(LAS u32x4*)(Arm + po) = pa[hh]; *(LAS u32x4*)(Brm + po) = pb[hh]; *(LAS u32x4*)(Krm + po) = pk[hh]; *(LAS u32x4*)(Rrm + po) = pr[hh]; }
                bon += __shfl_xor(bon, 1); bon += __shfl_xor(bon, 2);
#pragma unroll
                for (int hh = 0; hh < 2; ++hh) { const u32x4 gw_ = *(const u32x4*)((const bf16*)(ws + WS_G) + off + 8 * hh);
#pragma unroll
                    for (int q2 = 0; q2 < 2; ++q2) { const f32x4 lb = *(const f32x4*)(args.in[I_LNB] + hc + 8 * hh + 4 * q2); const int j0 = 8 * hh + 4 * q2;
                        f32x4 o; o.x = (lb.x + vl[j0] * bon) * bflo(gw_[2 * q2]); o.y = (lb.y + vl[j0 + 1] * bon) * bfhi(gw_[2 * q2]); o.z = (lb.z + vl[j0 + 2] * bon) * bflo(gw_[2 * q2 + 1]); o.w = (lb.w + vl[j0 + 3] * bon) * bfhi(gw_[2 * q2 + 1]);
                        *(f32x4*)((float*)(ws + WS_ADD) + off + j0) = o; } }
            }
            asm volatile("s_waitcnt lgkmcnt(0)" ::: "memory");
            {
                bf16x8 fa[2], fr[2], fb[2], fk[2];
#pragma unroll
                for (int ks = 0; ks < 2; ++ks) { const int po = l15 * 64 + 8 * ((4 * ks + g) ^ (l15 & 7));
                    fa[ks] = *(const LAS bf16x8*)(Arm + po); fr[ks] = *(const LAS bf16x8*)(Rrm + po); fb[ks] = *(const LAS bf16x8*)(Brm + po); fk[ks] = *(const LAS bf16x8*)(Krm + po); }
                f32x4 mab = z4, mak = z4, mrb = z4, mrk = z4;
#pragma unroll
                for (int ks = 0; ks < 2; ++ks) { mab = __builtin_amdgcn_mfma_f32_16x16x32_bf16(fb[ks], fa[ks], mab, 0, 0, 0); mak = __builtin_amdgcn_mfma_f32_16x16x32_bf16(fk[ks], fa[ks], mak, 0, 0, 0);
                    mrb = __builtin_amdgcn_mfma_f32_16x16x32_bf16(fb[ks], fr[ks], mrb, 0, 0, 0); mrk = __builtin_amdgcn_mfma_f32_16x16x32_bf16(fk[ks], fr[ks], mrk, 0, 0, 0); }
#pragma unroll
                for (int e = 0; e < 4; ++e) { const int i = 4 * g + e; if (!(i < l15)) { mab[e] = 0.f; mak[e] = 0.f; } if (!(i <= l15)) { mrb[e] = 0.f; mrk[e] = 0.f; } }
                asm volatile("s_waitcnt lgkmcnt(0)" ::: "memory");
#pragma unroll
                for (int e = 0; e < 4; ++e) MabT[(4 * g + e) * 16 + l15] = mab[e];
                u32x2 w; w.x = pk2(mak[0], mak[1]); w.y = pk2(mak[2], mak[3]); *(LAS u32x2*)(Mak + l15 * 16 + 4 * g) = w;
                w.x = pk2(mrb[0], mrb[1]); w.y = pk2(mrb[2], mrb[3]); *(LAS u32x2*)(Mrb + l15 * 16 + 4 * g) = w;
                w.x = pk2(mrk[0], mrk[1]); w.y = pk2(mrk[2], mrk[3]); *(LAS u32x2*)(Mrk + l15 * 16 + 4 * g) = w;
                if (te == 15) {
#pragma unroll
                    for (int j = 0; j < 16; ++j) PLs[16 * kq + j] = eP[j]; }
            }
            asm volatile("s_waitcnt lgkmcnt(0)" ::: "memory");
            {
                float y[16];
#pragma unroll
                for (int j = 15; j >= 0; --j) {
                    float acc = (j == l15) ? 1.0f : 0.0f;
                    float row[16];
#pragma unroll
                    for (int q = 0; q < 4; ++q) { const f32x4 x = *(const LAS f32x4*)(MabT + j * 16 + 4 * q); row[4 * q] = x.x; row[4 * q + 1] = x.y; row[4 * q + 2] = x.z; row[4 * q + 3] = x.w; }
#pragma unroll
                    for (int i = j + 1; i < 16; ++i) acc += y[i] * row[i];
                    y[j] = acc;
                }
                if (g == 0) { u32x4 t0, t1; t0.x = pk2(y[0], y[1]); t0.y = pk2(y[2], y[3]); t0.z = pk2(y[4], y[5]); t0.w = pk2(y[6], y[7]); t1.x = pk2(y[8], y[9]); t1.y = pk2(y[10], y[11]); t1.z = pk2(y[12], y[13]); t1.w = pk2(y[14], y[15]);
                    *(LAS u32x4*)(Tm + l15 * 16) = t0; *(LAS u32x4*)(Tm + l15 * 16 + 8) = t1; }
            }
            asm volatile("s_waitcnt lgkmcnt(0)" ::: "memory");
            {
                const bool act = g < 2; const int fo = l15 * 16 + 8 * g;
                const bf16x8 fT = act ? *(const LAS bf16x8*)(Tm + fo) : z8, fMak = act ? *(const LAS bf16x8*)(Mak + fo) : z8, fMrb = act ? *(const LAS bf16x8*)(Mrb + fo) : z8, fMrk = act ? *(const LAS bf16x8*)(Mrk + fo) : z8;
                bf16x8 fV[4], fQ1[4], fAh[4], fBT[4], fKT[4];
#pragma unroll
                for (int vt = 0; vt < 4; ++vt) { fV[vt] = act ? *(const LAS bf16x8*)(VTt + vt * 256 + fo) : z8; fBT[vt] = act ? *(const LAS bf16x8*)(BTt + vt * 256 + fo) : z8; fKT[vt] = act ? *(const LAS bf16x8*)(KTt + vt * 256 + fo) : z8; }
#pragma unroll
                for (int vt = 0; vt < 4; ++vt) { const f32x4 q0 = __builtin_amdgcn_mfma_f32_16x16x32_bf16(fMak, fV[vt], z4, 0, 0, 0);
                    u32x2 w; w.x = pk2(q0[0], q0[1]); w.y = pk2(q0[2], q0[3]); *(LAS u32x2*)(Q0T + vt * 256 + l15 * 16 + 4 * g) = w; }
#pragma unroll
                for (int kt = 0; kt < 4; ++kt) { const bf16x8 fA = act ? *(const LAS bf16x8*)(ATt + kt * 256 + fo) : z8; const f32x4 ah = __builtin_amdgcn_mfma_f32_16x16x32_bf16(fT, fA, z4, 0, 0, 0);
                    u32x2 w; w.x = pk2(ah[0], ah[1]); w.y = pk2(ah[2], ah[3]); *(LAS u32x2*)(ATt + kt * 256 + l15 * 16 + 4 * g) = w; }
                asm volatile("s_waitcnt lgkmcnt(0)" ::: "memory");
#pragma unroll
                for (int vt = 0; vt < 4; ++vt) { const bf16x8 fQ0 = act ? *(const LAS bf16x8*)(Q0T + vt * 256 + fo) : z8; const f32x4 q1 = __builtin_amdgcn_mfma_f32_16x16x32_bf16(fT, fQ0, z4, 0, 0, 0);
                    u32x2 w; w.x = pk2(q1[0], q1[1]); w.y = pk2(q1[2], q1[3]); *(LAS u32x2*)(Q0T + vt * 256 + l15 * 16 + 4 * g) = w; }
                asm volatile("s_waitcnt lgkmcnt(0)" ::: "memory");
#pragma unroll
                for (int vt = 0; vt < 4; ++vt) { fQ1[vt] = act ? *(const LAS bf16x8*)(Q0T + vt * 256 + fo) : z8; fAh[vt] = act ? *(const LAS bf16x8*)(ATt + vt * 256 + fo) : z8; }
                bf16* rp = (bf16*)(ws + WS_RP) + (size_t)un * 1024 + l15 * 64;
#pragma unroll
                for (int kt = 0; kt < 4; ++kt) {
                    const u32x2 rr = *(const LAS u32x2*)(Rrm + l15 * 64 + 8 * ((2 * kt + (g >> 1)) ^ (l15 & 7)) + 4 * (g & 1));
                    f32x4 ini; ini[0] = bflo(rr.x); ini[1] = bfhi(rr.x); ini[2] = bflo(rr.y); ini[3] = bfhi(rr.y);
                    const f32x4 rh = __builtin_amdgcn_mfma_f32_16x16x32_bf16(fAh[kt], fMrb, ini, 0, 0, 0);
                    u32x2 w; w.x = pk2(rh[0], rh[1]); w.y = pk2(rh[2], rh[3]); *(u32x2*)(rp + 32 * (kt >> 1) + 8 * g + 4 * (kt & 1)) = w;
                }
#pragma unroll
                for (int vt = 0; vt < 4; ++vt) { f32x4 y1 = __builtin_amdgcn_mfma_f32_16x16x32_bf16(fMrb, fQ1[vt], z4, 0, 0, 0); y1 = __builtin_amdgcn_mfma_f32_16x16x32_bf16(fMrk, fV[vt], y1, 0, 0, 0);
                    *(f32x4*)((float*)(ws + WS_Y1F) + ((size_t)(un * 4 + vt) * 64 + lane) * 4) = y1; }
                bf16* gp = (bf16*)(ws + WS_GP) + (size_t)un * 4096;
#pragma unroll
                for (int krt = 0; krt < 4; ++krt) { const float pl = PLs[16 * krt + l15];
#pragma unroll
                    for (int kct = 0; kct < 4; ++kct) { f32x4 ga = __builtin_amdgcn_mfma_f32_16x16x32_bf16(fAh[kct], fBT[krt], z4, 0, 0, 0);
                        if (kct == krt) {
#pragma unroll
                            for (int e = 0; e < 4; ++e) if (4 * g + e == l15) ga[e] += 1.0f; }
                        u32x2 w; w.x = pk2(ga[0] * pl, ga[1] * pl); w.y = pk2(ga[2] * pl, ga[3] * pl);
                        *(u32x2*)(gp + (16 * krt + l15) * 64 + 32 * (kct >> 1) + 8 * g + 4 * (kct & 1)) = w; } }
#pragma unroll
                for (int mt = 0; mt < 4; ++mt) { const f32x4 pl4 = *(const LAS f32x4*)(PLs + 16 * mt + 4 * g);
#pragma unroll
                    for (int vt = 0; vt < 4; ++vt) { f32x4 ha = __builtin_amdgcn_mfma_f32_16x16x32_bf16(fBT[mt], fQ1[vt], z4, 0, 0, 0); ha = __builtin_amdgcn_mfma_f32_16x16x32_bf16(fKT[mt], fV[vt], ha, 0, 0, 0);
                        u32x2 w; w.x = pk2(ha[0] * pl4[0], ha[1] * pl4[1]); w.y = pk2(ha[2] * pl4[2], ha[3] * pl4[3]);
                        *(u32x2*)((bf16*)(ws + WS_HF) + ((size_t)((un * 4 + vt) * 4 + mt) * 64 + lane) * 4) = w; } }
            }
            asm volatile("s_waitcnt lgkmcnt(0)" ::: "memory");
        }
        asm volatile("s_waitcnt vmcnt(0)" ::: "memory");
        { const int ltid = fresh_tid() & 63, l15 = ltid & 15, g = ltid >> 4, lane = ltid;
#pragma unroll 1
        for (int part = 0; part < 2; ++part) {
            f32x4 z[4][4];
#pragma unroll
            for (int sl = 0; sl < 4; ++sl)
#pragma unroll
                for (int mt = 0; mt < 4; ++mt)
#pragma unroll
                    for (int e = 0; e < 4; ++e) z[sl][mt][e] = (part == 0 && sl == mt && 4 * g + e == l15) ? 1.0f : 0.0f;
#pragma unroll 1
            for (int j = 0; j < 4; ++j) {
                const size_t un = (size_t)u64 * 4 + j;
                const bf16* gp = (const bf16*)(ws + WS_GP) + un * 4096 + l15 * 64 + 8 * g;
                bf16x8 gf[4][2];
#pragma unroll
                for (int mt = 0; mt < 4; ++mt) { gf[mt][0] = *(const bf16x8*)(gp + mt * 1024); gf[mt][1] = *(const bf16x8*)(gp + mt * 1024 + 32); }
#pragma unroll
                for (int sl = 0; sl < 4; ++sl) {
                    bf16x8 zb[2]; RW_ZB(z[sl], zb);
#pragma unroll
                    for (int mt = 0; mt < 4; ++mt) {
                        f32x4 a = (f32x4){0.f, 0.f, 0.f, 0.f};
                        if (part) { const u32x2 hh = *(const u32x2*)((const bf16*)(ws + WS_HF) + ((size_t)((un * 4 + sl) * 4 + mt) * 64 + lane) * 4); a[0] = bflo(hh.x); a[1] = bfhi(hh.x); a[2] = bflo(hh.y); a[3] = bfhi(hh.y); }
                        a = __builtin_amdgcn_mfma_f32_16x16x32_bf16(gf[mt][0], zb[0], a, 0, 0, 0); a = __builtin_amdgcn_mfma_f32_16x16x32_bf16(gf[mt][1], zb[1], a, 0, 0, 0);
                        z[sl][mt] = a;
                    }
                }
            }
            if (part == 0) {
                bf16* gc = (bf16*)(ws + WS_GC) + (size_t)u64 * 4096;
#pragma unroll
                for (int sl = 0; sl < 4; ++sl) { const int pc = 32 * (sl >> 1) + 8 * (l15 >> 2) + 4 * (sl & 1) + (l15 & 3);
#pragma unroll
                    for (int mt = 0; mt < 4; ++mt)
#pragma unroll
                        for (int e = 0; e < 4; ++e) gc[(16 * mt + 4 * g + e) * 64 + pc] = (bf16)f2bf(z[sl][mt][e]); }
            } else {
#pragma unroll
                for (int sl = 0; sl < 4; ++sl)
#pragma unroll
                    for (int mt = 0; mt < 4; ++mt) { u32x2 w; w.x = pk2(z[sl][mt][0], z[sl][mt][1]); w.y = pk2(z[sl][mt][2], z[sl][mt][3]);
                        *(u32x2*)((bf16*)(ws + WS_HC) + ((size_t)((u64 * 4 + sl) * 4 + mt) * 64 + lane) * 4) = w; }
            }
        }
        }
        }
        for (int lu = gw; lu < NB * 8 * 64; lu += NGW) {
            const int bc = lu >> 6, seg = lu & 63, b = bc >> 3, cg = bc & 7, ch = cg * 64 + lane;
            const size_t mb = (size_t)b * SEQ + seg * 64;
            float A = 1.f, B = 0.f;
#pragma unroll 16
            for (int t = 0; t < 64; ++t) { const float a = LA[(mb + t) * 512 + ch], bt = LB[(mb + t) * 512 + ch]; B = a * B + bt; A *= a; }
            f32x2 ab; ab.x = A; ab.y = B; *(f32x2*)((float*)(ws + WS_AP) + ((size_t)lu * 64 + lane) * 2) = ab;
        }
    }
    SEAM(4);


    if (IN(5)) { PHASE_IDS;
        if (!(bid < 128 && wave == 0)) {
            const int wi = bid < 128 ? bid * 7 + (wave - 1) : 896 + (bid - 128) * 8 + wave, NW = 896 + (G - 128) * 8;
            for (int lu = wi; lu < NB * 8 * 64; lu += NW) {
                const int bc = lu >> 6, seg = lu & 63, b = bc >> 3, cg = bc & 7, ch = cg * 64 + lane;
                const size_t mb = (size_t)b * SEQ + seg * 64;
                float hst = 0.f;
                const f32x2* ag = (const f32x2*)((const float*)(ws + WS_AP)) + (size_t)(bc * 64) * 64 + lane;
#pragma unroll 8
                for (int sg = 0; sg < seg; ++sg) { const f32x2 ab = ag[(size_t)sg * 64]; hst = ab.x * hst + ab.y; }
#pragma unroll 16
                for (int t = 0; t < 64; ++t) { const float a = LA[(mb + t) * 512 + ch], bt = LB[(mb + t) * 512 + ch]; hst = a * hst + bt;
                    const float gl = bf2f(U[(mb + t) * INW + 512 + ch]); CAT[(mb + t) * 1024 + ch] = (bf16)f2bf(hst * gelu_tanh_f(gl)); }
            }
            LAS float* scr = (LAS float*)(lds + wave * 16384);
            constexpr int I_GU = 16 * 64, I_DN = 16 * 32;
            for (int it = wi; it < NE * (I_GU + I_DN); it += NW) {
                int r = it;
                if (r < NE * I_GU) { const int e = r / I_GU, q = r % I_GU, kb = q / 64, nb = q % 64; const int n0 = 32 * nb;
                    const int drow = n0 < 1024 ? (256 * (n0 >> 7) + (n0 & 127)) : (256 * ((n0 - 1024) >> 7) + 128 + ((n0 - 1024) & 127));
                    transpose_item(args.in[I_WGU] + (size_t)e * D * 2048, 2048, D, Wgu_t + (size_t)e * 2048 * D, 64 * kb, n0, drow, scr, lane); continue; } r -= NE * I_GU;
                { const int e = r / I_DN, q = r % I_DN, kb = q / 32, nb = q % 32;
                  transpose_item(args.in[I_WDN] + (size_t)e * DFF * D, D, DFF, Wdn_t + (size_t)e * D * DFF, 64 * kb, 32 * nb, 32 * nb, scr, lane); }
            }
        } else {
            const int l15 = lane & 15, g = lane >> 4, bh = bid >> 2, vs = bid & 3;
            f32x4 z[4];
#pragma unroll
            for (int mt = 0; mt < 4; ++mt) z[mt] = (f32x4){0.f, 0.f, 0.f, 0.f};
            bf16x8 gA[4][2], gB[4][2], gC[4][2], gD[4][2]; u32x2 hA[4], hB[4], hC[4], hD[4];
#define SC_LOAD(gf, hf, C) do { const size_t u64_ = (size_t)bh * 64 + (C); const bf16* gp_ = (const bf16*)(ws + WS_GC) + u64_ * 4096 + l15 * 64 + 8 * g; \
                _Pragma("unroll") for (int mt = 0; mt < 4; ++mt) { gf[mt][0] = *(const bf16x8*)(gp_ + mt * 1024); gf[mt][1] = *(const bf16x8*)(gp_ + mt * 1024 + 32); \
                    hf[mt] = *(const u32x2*)((const bf16*)(ws + WS_HC) + ((size_t)((u64_ * 4 + vs) * 4 + mt) * 64 + lane) * 4); } } while (0)
#define SC_STEP(gf, hf, C) do { const size_t u64_ = (size_t)bh * 64 + (C); float* zs_ = (float*)(ws + WS_ZS) + ((size_t)((u64_ * 4 + vs) * 4) * 64 + lane) * 4; \
                _Pragma("unroll") for (int mt = 0; mt < 4; ++mt) *(f32x4*)(zs_ + mt * 256) = z[mt]; \
                bf16x8 zb[2]; RW_ZB(z, zb); \
                _Pragma("unroll") for (int mt = 0; mt < 4; ++mt) { f32x4 a; a[0] = bflo(hf[mt].x); a[1] = bfhi(hf[mt].x); a[2] = bflo(hf[mt].y); a[3] = bfhi(hf[mt].y); \
                    a = __builtin_amdgcn_mfma_f32_16x16x32_bf16(gf[mt][0], zb[0], a, 0, 0, 0); a = __builtin_amdgcn_mfma_f32_16x16x32_bf16(gf[mt][1], zb[1], a, 0, 0, 0); z[mt] = a; } } while (0)
            SC_LOAD(gA, hA, 0); SC_LOAD(gB, hB, 1); SC_LOAD(gC, hC, 2);
#pragma unroll 1
            for (int C = 0; C < 64; C += 4) {
                SC_LOAD(gD, hD, C + 3);
                SC_STEP(gA, hA, C);
                if (C + 4 < 64) SC_LOAD(gA, hA, C + 4);
                SC_STEP(gB, hB, C + 1);
                if (C + 5 < 64) SC_LOAD(gB, hB, C + 5);
                SC_STEP(gC, hC, C + 2);
                if (C + 6 < 64) SC_LOAD(gC, hC, C + 6);
                SC_STEP(gD, hD, C + 3);
            }
#undef SC_LOAD
#undef SC_STEP
        }
    }
    SEAM(5);

    if (IN(6)) { PHASE_IDS;
        const int l15 = lane & 15, g = lane >> 4;
        for (int u64 = gw; u64 < NB * NH * (SEQ / 64); u64 += NGW) {
            const int bh = u64 >> 6, C = u64 & 63, b = bh >> 3, h = bh & 7;
            f32x4 z[4][4];
#pragma unroll
            for (int sl = 0; sl < 4; ++sl)
#pragma unroll
                for (int mt = 0; mt < 4; ++mt) z[sl][mt] = *(const f32x4*)((const float*)(ws + WS_ZS) + ((size_t)((u64 * 4 + sl) * 4 + mt) * 64 + lane) * 4);
            float lg4[4];
#pragma unroll
            for (int sl = 0; sl < 4; ++sl) lg4[sl] = args.in[I_LNG][h * 64 + 16 * sl + l15];
#pragma unroll 1
            for (int j = 0; j < 4; ++j) {
                const size_t un = (size_t)u64 * 4 + j; const size_t m0 = (size_t)b * SEQ + (C * 4 + j) * 16;
                const bf16* rp = (const bf16*)(ws + WS_RP) + un * 1024 + l15 * 64 + 8 * g;
                const bf16x8 rf0 = *(const bf16x8*)rp, rf1 = *(const bf16x8*)(rp + 32);
                f32x4 y[4];
#pragma unroll
                for (int sl = 0; sl < 4; ++sl) { bf16x8 zb[2]; RW_ZB(z[sl], zb);
                    f32x4 a = *(const f32x4*)((const float*)(ws + WS_Y1F) + ((size_t)(un * 4 + sl) * 64 + lane) * 4);
                    a = __builtin_amdgcn_mfma_f32_16x16x32_bf16(rf0, zb[0], a, 0, 0, 0); a = __builtin_amdgcn_mfma_f32_16x16x32_bf16(rf1, zb[1], a, 0, 0, 0); y[sl] = a; }
#pragma unroll
                for (int e = 0; e < 4; ++e) {
                    float s1 = (y[0][e] + y[1][e]) + (y[2][e] + y[3][e]);
                    s1 += __shfl_xor(s1, 1); s1 += __shfl_xor(s1, 2); s1 += __shfl_xor(s1, 4); s1 += __shfl_xor(s1, 8);
                    const float mean = s1 * (1.0f / 64.0f);
                    float d0 = y[0][e] - mean, d1 = y[1][e] - mean, d2 = y[2][e] - mean, d3 = y[3][e] - mean;
                    float s2 = (d0 * d0 + d1 * d1) + (d2 * d2 + d3 * d3);
                    s2 += __shfl_xor(s2, 1); s2 += __shfl_xor(s2, 2); s2 += __shfl_xor(s2, 4); s2 += __shfl_xor(s2, 8);
                    const float rstd = 1.0f / sqrtf(s2 * (1.0f / 64.0f) + GN_EPS);
                    const size_t ro = (m0 + 4 * g + e) * 512 + h * 64 + l15;
                    const float dd[4] = {d0, d1, d2, d3};
#pragma unroll
                    for (int sl = 0; sl < 4; ++sl) { const float gg = bf2f(((const bf16*)(ws + WS_G))[ro + 16 * sl]), ad = ((const float*)(ws + WS_ADD))[ro + 16 * sl];
                        const float o = dd[sl] * rstd * lg4[sl] * gg + ad;
                        CAT[(m0 + 4 * g + e) * 1024 + 512 + h * 64 + 16 * sl + l15] = (bf16)f2bf(o); }
                }
                if (j < 3) {
                    const bf16* gp = (const bf16*)(ws + WS_GP) + un * 4096 + l15 * 64 + 8 * g;
                    bf16x8 gf[4][2];
#pragma unroll
                    for (int mt = 0; mt < 4; ++mt) { gf[mt][0] = *(const bf16x8*)(gp + mt * 1024); gf[mt][1] = *(const bf16x8*)(gp + mt * 1024 + 32); }
#pragma unroll
                    for (int sl = 0; sl < 4; ++sl) { bf16x8 zb[2]; RW_ZB(z[sl], zb);
#pragma unroll
                        for (int mt = 0; mt < 4; ++mt) { const u32x2 hh = *(const u32x2*)((const bf16*)(ws + WS_HF) + ((size_t)((un * 4 + sl) * 4 + mt) * 64 + lane) * 4);
                            f32x4 a; a[0] = bflo(hh.x); a[1] = bfhi(hh.x); a[2] = bflo(hh.y); a[3] = bfhi(hh.y);
                            a = __builtin_amdgcn_mfma_f32_16x16x32_bf16(gf[mt][0], zb[0], a, 0, 0, 0); a = __builtin_amdgcn_mfma_f32_16x16x32_bf16(gf[mt][1], zb[1], a, 0, 0, 0); z[sl][mt] = a; } }
                }
            }
        }
    }
    SEAM(6);
#undef RW_ZB


    if (IN(7)) { PHASE_IDS;
        pg8::DenseSched S; S.o.init_tiles(M / 256, D / 256, G, bid); S.A = (const char*)CAT; S.B = (const char*)Wout_t; S.tstep = (size_t)256 * D * 2;
        EpiF32Res E{args.in[I_X], X1, D}; pg8::gemm_phase(lds, D, S, E);
    }
    SEAM(7);
    if (IN(8)) { PHASE_IDS; for (int m = gw; m < M; m += NGW) rms_row_to_bf16(X1 + (size_t)m * D, args.in[I_NXAG], HN + (size_t)m * D, lane); }
    SEAM(8);
    if (IN(9)) { PHASE_IDS;
        pg8::DenseSched S; S.o.init_tiles(M / 256, D / 256, G, bid); S.A = (const char*)HN; S.B = (const char*)Wq_t; S.tstep = (size_t)256 * D * 2;
        EpiBf16Plain E{Qb, D, 0.0625f}; pg8::gemm_phase(lds, D, S, E);
    }
    SEAM(9);
    if (IN(10)) { PHASE_IDS;
        const int l15 = lane & 15, g4 = lane >> 4;
        for (int unit = gw; unit < NB * XH * (SEQ / 16); unit += NGW) {
            const int qt16 = unit % (SEQ / 16), bh = unit / (SEQ / 16), h = bh & 3, b = bh >> 2;
            const bf16* qbase = Qb + (size_t)(b * SEQ + qt16 * 16 + l15) * D + h * XHD + 8 * g4;
            const bf16* kbase = KM + (size_t)(b * MEML + l15) * D + h * XHD + 8 * g4;
            f32x4 sc[16];
#pragma unroll
            for (int kt = 0; kt < 16; ++kt) sc[kt] = (f32x4){0.f, 0.f, 0.f, 0.f};
#pragma unroll 1
            for (int ks = 0; ks < 8; ++ks) {
                const bf16x8 q0 = *(const bf16x8*)(qbase + 32 * ks);
                const bf16* kp = kbase + 32 * ks;
#pragma unroll
                for (int kt = 0; kt < 16; ++kt) { const bf16x8 kf = *(const bf16x8*)(kp + (size_t)(16 * kt) * D);
                    sc[kt] = __builtin_amdgcn_mfma_f32_16x16x32_bf16(kf, q0, sc[kt], 0, 0, 0); }
            }
            bf16x8 pf[8];
            {
                float mx = -3.0e38f;
#pragma unroll
                for (int kt = 0; kt < 16; ++kt) mx = fmaxf(mx, fmaxf(fmaxf(sc[kt][0], sc[kt][1]), fmaxf(sc[kt][2], sc[kt][3])));
                mx = fmaxf(mx, __shfl_xor(mx, 16)); mx = fmaxf(mx, __shfl_xor(mx, 32));
                float sum = 0.f;
#pragma unroll
                for (int kt = 0; kt < 16; ++kt) {
#pragma unroll
                    for (int e = 0; e < 4; ++e) { const float p = __expf(sc[kt][e] - mx); sc[kt][e] = p; sum += p; } }
                sum += __shfl_xor(sum, 16); sum += __shfl_xor(sum, 32);
                const float inv = 1.0f / sum;
#pragma unroll
                for (int s2 = 0; s2 < 8; ++s2) { const f32x4 a = sc[2 * s2] * inv, c = sc[2 * s2 + 1] * inv;
                    u32x4 p; p.x = pk2(a[0], a[1]); p.y = pk2(a[2], a[3]); p.z = pk2(c[0], c[1]); p.w = pk2(c[2], c[3]); pf[s2] = __builtin_bit_cast(bf16x8, p); }
            }
            const bf16* vbase = VT + (size_t)(h * XHD + l15) * MROWS + b * MEML + 4 * g4;
            bf16* obase = Ob + (size_t)(b * SEQ + qt16 * 16 + l15) * D + h * XHD + 4 * g4;
#pragma unroll 1
            for (int dt = 0; dt < 16; ++dt) {
                const bf16* vp = vbase + (size_t)(16 * dt) * MROWS;
                f32x4 oc = (f32x4){0.f, 0.f, 0.f, 0.f};
#pragma unroll
                for (int s2 = 0; s2 < 8; ++s2) {
                    const u32x2 v0 = *(const u32x2*)(vp + 32 * s2), v1 = *(const u32x2*)(vp + 32 * s2 + 16);
                    u32x4 vv; vv.x = v0.x; vv.y = v0.y; vv.z = v1.x; vv.w = v1.y; const bf16x8 vf = __builtin_bit_cast(bf16x8, vv);
                    oc = __builtin_amdgcn_mfma_f32_16x16x32_bf16(vf, pf[s2], oc, 0, 0, 0);
                }
                u32x2 w; w.x = pk2(oc[0], oc[1]); w.y = pk2(oc[2], oc[3]);
                *(u32x2*)(obase + 16 * dt) = w;
            }
        }
    }
    SEAM(10);
    if (IN(11)) { PHASE_IDS;
        pg8::DenseSched S; S.o.init_tiles(M / 256, D / 256, G, bid); S.A = (const char*)Ob; S.B = (const char*)Wo_t; S.tstep = (size_t)256 * D * 2;
        EpiF32Res E{X1, X2, D}; pg8::gemm_phase(lds, D, S, E);
    }
    SEAM(11);
    if (IN(12)) { PHASE_IDS;
        LAS float* hs = (LAS float*)(lds + wave * 16384);
        const float* gfn = args.in[I_NFFG]; const float* wr_ = args.in[I_WR]; const float* br = args.in[I_BR];
        const int e = lane & 31, half = lane >> 5;
        for (int grp = gw; grp < M / 4; grp += NGW) {
            const int m0 = grp * 4;
#pragma unroll
            for (int rr = 0; rr < 4; ++rr) {
                const f32x4* xr = (const f32x4*)(X2 + (size_t)(m0 + rr) * D) + lane; const f32x4* gr = (const f32x4*)gfn + lane;
                f32x4 v[4]; float s = 0.f;
#pragma unroll
                for (int j = 0; j < 4; ++j) { v[j] = xr[64 * j]; s += (v[j].x * v[j].x + v[j].y * v[j].y) + (v[j].z * v[j].z + v[j].w * v[j].w); }
                const float rstd = 1.0f / sqrtf(wave_sum(s) * (1.f / D) + EPS);
                u32x2* o8 = (u32x2*)(HN + (size_t)(m0 + rr) * D) + lane;
#pragma unroll
                for (int j = 0; j < 4; ++j) { const f32x4 gg = gr[64 * j]; f32x4 hv = v[j] * rstd * gg; *(LAS f32x4*)(hs + rr * 1024 + 256 * j + 4 * lane) = hv;
                    u32x2 w; w.x = pk2(hv.x, hv.y); w.y = pk2(hv.z, hv.w); o8[64 * j] = w; }
            }
            asm volatile("s_waitcnt lgkmcnt(0)" ::: "memory");
            float lg[4] = {0.f, 0.f, 0.f, 0.f};
#pragma unroll 4
            for (int d = half * 512; d < half * 512 + 512; d += 4) {
                const float w0 = wr_[(d + 0) * 32 + e], w1 = wr_[(d + 1) * 32 + e], w2 = wr_[(d + 2) * 32 + e], w3 = wr_[(d + 3) * 32 + e];
#pragma unroll
                for (int rr = 0; rr < 4; ++rr) { const f32x4 h4 = *(const LAS f32x4*)(hs + rr * 1024 + d); lg[rr] += (h4.x * w0 + h4.y * w1) + (h4.z * w2 + h4.w * w3); }
            }
            const float brv = br[e];
#pragma unroll
            for (int rr = 0; rr < 4; ++rr) {
                float v = lg[rr] + __shfl_xor(lg[rr], 32) + brv;
                float selv[4]; int sele[4];
#pragma unroll
                for (int k = 0; k < 4; ++k) {
                    float mv = v; int mi = e;
#pragma unroll
                    for (int o = 1; o < 32; o <<= 1) { const float ov = __shfl_xor(mv, o); const int oi = __shfl_xor(mi, o); if (ov > mv || (ov == mv && oi < mi)) { mv = ov; mi = oi; } }
                    selv[k] = mv; sele[k] = mi; if (e == mi) v = -3.0e38f;
                }
                const float e1 = __expf(selv[1] - selv[0]), e2 = __expf(selv[2] - selv[0]), e3 = __expf(selv[3] - selv[0]);
                const float inv = 1.0f / (1.0f + e1 + e2 + e3);
                if (lane < 4) {
                    const int me = lane == 0 ? sele[0] : lane == 1 ? sele[1] : lane == 2 ? sele[2] : sele[3];
                    const float mg = (lane == 0 ? 1.0f : lane == 1 ? e1 : lane == 2 ? e2 : e3) * inv;
                    const int pos = (int)atomicAdd(ecnt + me, 1u);
                    const int ai = (m0 + rr) * 4 + lane; route_e[ai] = me; route_pos[ai] = pos; route_g[ai] = mg;
                }
            }
        }
    }
    SEAM(12);
    if (IN(13)) { PHASE_IDS;
        LAS int* pst = (LAS int*)lds;
        if (tid == 0) { int acc = 0; for (int e = 0; e < NE; ++e) { const int c = (int)__hip_atomic_load(ecnt + e, __ATOMIC_RELAXED, __HIP_MEMORY_SCOPE_AGENT); pst[e] = acc; pst[64 + e] = c; acc += (c + 255) & ~255; } pst[32] = acc; }
        __syncthreads();
        for (int ai = bid * NTHREADS + tid; ai < NASSIGN; ai += G * NTHREADS) {
            const int e = route_e[ai]; const int row = pst[e] + route_pos[ai]; row_slot[row] = ai; row_gate[row] = route_g[ai]; row_tok[row] = ai >> 2; }
        if (bid < NE) { const int e = bid, c = pst[64 + e], pe = (c + 255) & ~255; for (int p = c + tid; p < pe; p += NTHREADS) { row_slot[pst[e] + p] = -1; row_gate[pst[e] + p] = 0.f; row_tok[pst[e] + p] = 0; } }
        if (bid == 0 && tid == 0) { int nt = 0; for (int e = 0; e < NE; ++e) { const int n = ((pst[64 + e] + 255) & ~255) >> 8; for (int j = 0; j < n; ++j) tile_tab[16 + nt++] = e; } tile_tab[0] = nt; }
        __syncthreads();
    }
    SEAM(13);
    if (IN(14)) { PHASE_IDS;
        const int ntiles = tile_tab[0];
        pg8::MoeGatherSched S; S.o.init_tiles(ntiles, 2048 / 256, G, bid); S.A = (const char*)HN; S.B = (const char*)Wgu_t; S.tile_e = tile_tab + 16; S.rtok = row_tok; S.tstep = (size_t)256 * D * 2; S.estep = (size_t)2048 * D * 2;
        EpiSwiglu E{ACT, args.in[I_BGU]}; pg8::gemm_phase(lds, D, S, E);
    }
    SEAM(14);
    if (IN(15)) { PHASE_IDS;
        const int ntiles = tile_tab[0];
        pg8::MoeSched S; S.o.init_tiles(ntiles, D / 256, G, bid); S.A = (const char*)ACT; S.B = (const char*)Wdn_t; S.tile_e = tile_tab + 16; S.tstep = (size_t)256 * DFF * 2; S.estep = (size_t)D * DFF * 2;
        EpiDown E{YS, args.in[I_BDN], row_slot, row_gate}; pg8::gemm_phase(lds, DFF, S, E);
    }
    SEAM(15);
    if (IN(16)) { PHASE_IDS;
        const f32x4* gr = (const f32x4*)args.in[I_FNG] + lane;
        for (int m = gw; m < M; m += NGW) {
            const f32x4* xr = (const f32x4*)(X2 + (size_t)m * D) + lane;
            f32x4 v[4]; float s = 0.f;
#pragma unroll
            for (int j = 0; j < 4; ++j) { v[j] = xr[64 * j];
#pragma unroll
                for (int k = 0; k < 4; ++k) { const u32x2 y = *((const u32x2*)(YS + (size_t)(m * 4 + k) * D) + 64 * j + lane); v[j].x += bflo(y.x); v[j].y += bfhi(y.x); v[j].z += bflo(y.y); v[j].w += bfhi(y.y); }
                s += (v[j].x * v[j].x + v[j].y * v[j].y) + (v[j].z * v[j].z + v[j].w * v[j].w); }
            const float rstd = 1.0f / sqrtf(wave_sum(s) * (1.f / D) + EPS);
            f32x4* o = (f32x4*)(args.out + (size_t)m * D) + lane;
#pragma unroll
            for (int j = 0; j < 4; ++j) o[64 * j] = v[j] * rstd * gr[64 * j];
        }
    }
#undef IN
#undef SEAM
}

constexpr int N_PHASES = 17;
extern "C" void kernel_launch(void* const* d_in, const int* in_sizes, int n_in, void* d_out, int out_size, void* d_ws, size_t ws_size, hipStream_t stream) {
    static int grid = 0;
    if (grid == 0) {
        if (n_in != 37 || out_size != M * D || ws_size < WS_END) { fprintf(stderr, "kernel_launch: unexpected shapes (n_in %d, out %d, ws %zu); nothing launched\n", n_in, out_size, ws_size); grid = -1; return; }
        int dev = 0, cus = 0, per_cu = 0;
        if (hipGetDevice(&dev) != hipSuccess || hipDeviceGetAttribute(&cus, hipDeviceAttributeMultiprocessorCount, dev) != hipSuccess) { grid = -1; return; }
        if (hipFuncSetAttribute((const void*)fwd, hipFuncAttributeMaxDynamicSharedMemorySize, LDS_BYTES) != hipSuccess) { fprintf(stderr, "kernel_launch: hipFuncSetAttribute failed\n"); grid = -1; return; }
        if (hipOccupancyMaxActiveBlocksPerMultiprocessor(&per_cu, (const void*)fwd, NTHREADS, LDS_BYTES) != hipSuccess || per_cu < 1) fprintf(stderr, "kernel_launch: occupancy query says %d\n", per_cu);
        (void)hipGetLastError();
        grid = cus > 256 ? 256 : cus;
    }
    if (grid < 0) return;
    if (hipMemsetAsync((char*)d_ws + WS_CTL, 0, CTL_ZERO_BYTES, stream) != hipSuccess) return;
    Args a{};
    for (int i = 0; i < 37; ++i) a.in[i] = (const float*)d_in[i];
    a.out = (float*)d_out; a.ws = (unsigned char*)d_ws;
#if MK_ONE_LAUNCH
    a.ph_lo = 0; a.ph_hi = N_PHASES;
    hipLaunchKernelGGL(fwd, dim3(grid), dim3(NTHREADS), LDS_BYTES, stream, a);
#else
    for (int p = 0; p < N_PHASES; ++p) { a.ph_lo = p; a.ph_hi = p + 1; hipLaunchKernelGGL(fwd, dim3(grid), dim3(NTHREADS), LDS_BYTES, stream, a);
#ifdef PROBE_REPEAT_PHASE
        if (p == PROBE_REPEAT_PHASE) hipLaunchKernelGGL(fwd, dim3(grid), dim3(NTHREADS), LDS_BYTES, stream, a);
#endif
    }
#endif
}
```

```cpp
#include <hip/hip_runtime.h>
#include <cstdio>
#include <cstdint>

#ifndef MK_ONE_LAUNCH
#define MK_ONE_LAUNCH 1
#endif

#define DI __device__ __forceinline__
#define GAS __attribute__((address_space(1)))
#define LAS __attribute__((address_space(3)))
typedef unsigned short bf16;
typedef short bf16x8 __attribute__((ext_vector_type(8)));
typedef float f32x4 __attribute__((ext_vector_type(4)));
typedef float f32x2 __attribute__((ext_vector_type(2)));
typedef unsigned u32x4 __attribute__((ext_vector_type(4)));
typedef unsigned u32x2 __attribute__((ext_vector_type(2)));

constexpr int D = 1024, NB = 4, SEQ = 4096, M = NB * SEQ;
constexpr int MEML = 256, MROWS = NB * MEML;
constexpr int LRU_W = 512, RW = 512, NH = 8, HD = 64;
constexpr int INW = 2816;
constexpr int XH = 4, XHD = 256;
constexpr int NE = 32, TOPK = 4, DFF = 1024;
constexpr int NASSIGN = M * TOPK;
constexpr int MAXTILES = 288, MAXROWS = MAXTILES * 256;
constexpr float EPS = 1e-6f, GN_EPS = 64e-5f;

DI int fresh_tid() { int t = threadIdx.x; asm volatile("" : "+v"(t)); return t; }
namespace pg8 {
constexpr int BM = 256, BK = 64, HALF = 128, HTB = HALF * BK * 2, STAGE_BYTES = 8 * HTB, NXCD = 8, WGM = 8;
__host__ __device__ __forceinline__ int lds_byte(int r, int c) { const int st = (r >> 4) * 2 + (c >> 5), rr = r & 15, cc = c & 31, ob = rr * 64 + cc * 2; return st * 1024 + (ob ^ (((ob >> 9) & 1) << 5)); }
__host__ __device__ __forceinline__ void stage_rc(int b, int& R, int& C) { const int st = b / 1024, sb = b % 1024, swz = sb ^ (((sb >> 9) & 1) << 5); R = (st >> 1) * 16 + swz / 64; C = (st & 1) * 32 + (swz % 64) / 2; }
__host__ __device__ __forceinline__ int perm32(int rho) { const int n = rho >> 4, i = rho & 15; return 8 * (i >> 2) + 4 * n + (i & 3); }

struct Unit { int pm, pn, e; };

struct StaticOrder {
    int nM, nN, nwg, G, c;
    __host__ __device__ void init_tiles(int nM_, int nN_, int G_, int c_) { nM = nM_; nN = nN_; nwg = nM * nN; G = G_; c = c_; }
    __host__ __device__ bool next(int i, Unit& u) const {
        const long L = (long)i * G + c; if (L >= nwg) return false;
        int wgid = (int)L; { const int q = nwg / NXCD, r = nwg % NXCD, xcd = wgid % NXCD, off = wgid / NXCD; wgid = (xcd < r ? xcd * (q + 1) : r * (q + 1) + (xcd - r) * q) + off; }
        const int nig = WGM * nN, gid = wgid / nig, fm = gid * WGM, gsz = (nM - fm) < WGM ? (nM - fm) : WGM;
        u.pm = fm + ((wgid % nig) % gsz); u.pn = (wgid % nig) / gsz; u.e = 0; return true;
    }
};
struct DenseSched {
    static constexpr bool GATHER = false;
    StaticOrder o; const char* A; const char* B; size_t tstep;
    DI bool next(int i, Unit& u) const { return o.next(i, u); }
    DI const char* a_ptr(const Unit& u) const { return A + (size_t)u.pm * tstep; }
    DI const char* b_ptr(const Unit& u) const { return B + (size_t)u.pn * tstep; }
    DI void a_voff(const Unit&, int K, const int (&R)[2], const int (&C)[2], unsigned (&vo)[2][2]) const {
#pragma unroll
        for (int h = 0; h < 2; ++h)
#pragma unroll
            for (int i = 0; i < 2; ++i) vo[h][i] = (unsigned)((h * HALF + R[i]) * K + C[i]) * 2u; }
};
struct MoeSched {
    static constexpr bool GATHER = false;
    StaticOrder o; const char* A; const char* B; const int* tile_e; size_t tstep, estep;
    DI bool next(int i, Unit& u) const { if (!o.next(i, u)) return false; u.e = tile_e[u.pm]; return true; }
    DI const char* a_ptr(const Unit& u) const { return A + (size_t)u.pm * tstep; }
    DI const char* b_ptr(const Unit& u) const { return B + (size_t)u.e * estep + (size_t)u.pn * tstep; }
    DI void a_voff(const Unit&, int K, const int (&R)[2], const int (&C)[2], unsigned (&vo)[2][2]) const {
#pragma unroll
        for (int h = 0; h < 2; ++h)
#pragma unroll
            for (int i = 0; i < 2; ++i) vo[h][i] = (unsigned)((h * HALF + R[i]) * K + C[i]) * 2u; }
};
struct MoeGatherSched {
    static constexpr bool GATHER = true;
    StaticOrder o; const char* A; const char* B; const int* tile_e; const int* rtok; size_t tstep, estep;
    DI bool next(int i, Unit& u) const { if (!o.next(i, u)) return false; u.e = tile_e[u.pm]; return true; }
    DI const char* a_ptr(const Unit&) const { return A; }
    DI const char* b_ptr(const Unit& u) const { return B + (size_t)u.e * estep + (size_t)u.pn * tstep; }
    DI void a_voff(const Unit& u, int K, const int (&R)[2], const int (&C)[2], unsigned (&vo)[2][2]) const {
#pragma unroll
        for (int h = 0; h < 2; ++h)
#pragma unroll
            for (int i = 0; i < 2; ++i) vo[h][i] = (unsigned)(rtok[u.pm * BM + h * HALF + R[i]] * K + C[i]) * 2u; }
};

DI unsigned cvt_pk_bf16(float lo, float hi) { unsigned r; asm volatile("v_cvt_pk_bf16_f32 %0, %1, %2" : "=v"(r) : "v"(lo), "v"(hi)); return r; }

template <class Epi, class Sched, bool ALIGN_EPI = true>
DI void gemm_phase(LAS unsigned char* lds, const int K, const Sched& S, const Epi& E) {
    const int tid = fresh_tid(), wid = __builtin_amdgcn_readfirstlane(tid >> 6), lane = tid & 63, wr = wid >> 2, wc = wid & 3, fr = lane & 15, fq = lane >> 4;
    const int nt = K / BK;
    constexpr bool GA = Sched::GATHER;
    unsigned voffA[2][2], voffAn[2][2], voffB[2]; int sR[2], sC[2];
#pragma unroll
    for (int i = 0; i < 2; ++i) { int R, C; stage_rc(tid * 16 + i * 8192, R, C); const int Rb = Epi::PERM ? ((R & ~31) + perm32(R & 31)) : R;
        sR[i] = R; sC[i] = C; voffB[i] = (unsigned)(Rb * K + C) * 2u; }
    const size_t kstep = (size_t)(BK * 2);
    const size_t hstep = (size_t)HALF * K * 2;
    const unsigned ldsw = (unsigned)wid * 1024u;
    const int aoff = lds_byte(wr * 64 + fr, fq * 8), boff = lds_byte(wc * 32 + fr, fq * 8);
#define PG8_SA(b, h) (((b) * 2 + (h)) * HTB)
#define PG8_SB(b, h) ((4 + (b) * 2 + (h)) * HTB)
#define PG8_STAGE(bufoff, gbase, voff) do { _Pragma("unroll") for (int _i = 0; _i < 2; ++_i) \
        __builtin_amdgcn_global_load_lds((const unsigned*)((const char*)(gbase) + (voff)[_i]), (LAS unsigned*)(lds + (bufoff) + ldsw + _i * 8192), 16, 0, 0); } while (0)
#define PG8_LDA(dst, b, h) do { _Pragma("unroll") for (int m = 0; m < 4; ++m) _Pragma("unroll") for (int k = 0; k < 2; ++k) dst[m][k] = *(const LAS bf16x8*)(lds + PG8_SA(b, h) + aoff + m * 2048 + k * 1024); } while (0)
#define PG8_LDB(dst, b, h) do { _Pragma("unroll") for (int n = 0; n < 2; ++n) _Pragma("unroll") for (int k = 0; k < 2; ++k) dst[n][k] = *(const LAS bf16x8*)(lds + PG8_SB(b, h) + boff + n * 2048 + k * 1024); } while (0)
#define PG8_MMA(ai, bj, At, Bt) do { __builtin_amdgcn_s_setprio(1); _Pragma("unroll") for (int m = 0; m < 4; ++m) _Pragma("unroll") for (int n = 0; n < 2; ++n) _Pragma("unroll") for (int k = 0; k < 2; ++k) \
        acc[ai][bj][m][n] = __builtin_amdgcn_mfma_f32_16x16x32_bf16(Bt[n][k], At[m][k], acc[ai][bj][m][n], 0, 0, 0); __builtin_amdgcn_s_setprio(0); } while (0)
#define PG8_WAIT_V(n) asm volatile("s_waitcnt vmcnt(" #n ")" ::: "memory")
#define PG8_WAIT_L(n) asm volatile("s_waitcnt lgkmcnt(" #n ")" ::: "memory")
#define PG8_BAR __builtin_amdgcn_s_barrier()
#define PG8_SCHED __builtin_amdgcn_sched_barrier(0)
    Unit cur, nxt; int ui = 0;
    if (!S.next(0, cur)) return;
    f32x4 acc[2][2][4][2];
#pragma unroll
    for (int a = 0; a < 2; ++a)
#pragma unroll
        for (int b = 0; b < 2; ++b)
#pragma unroll
            for (int m = 0; m < 4; ++m)
#pragma unroll
                for (int n = 0; n < 2; ++n) acc[a][b][m][n] = (f32x4){0.f, 0.f, 0.f, 0.f};
    bf16x8 At[4][2], B0[2][2], B1[2][2];
    const char* cA = S.a_ptr(cur); const char* cB = S.b_ptr(cur);
    S.a_voff(cur, K, sR, sC, voffA);
#define PG8_STAGE_A(bufoff, kbase, h, vo) do { if constexpr (GA) { PG8_STAGE(bufoff, kbase, (vo)[h]); } else { PG8_STAGE(bufoff, (kbase) + (h) * hstep, voffA[0]); } } while (0)
    PG8_STAGE(PG8_SB(0, 0), cB, voffB); PG8_STAGE(PG8_SB(0, 1), cB + hstep, voffB); PG8_STAGE_A(PG8_SA(0, 0), cA, 0, voffA); PG8_STAGE_A(PG8_SA(0, 1), cA, 1, voffA);
    if (wr == 1) PG8_BAR;
    PG8_WAIT_V(2); PG8_BAR;
    PG8_STAGE(PG8_SB(1, 0), cB + kstep, voffB); PG8_STAGE_A(PG8_SA(1, 0), cA + kstep, 0, voffA); PG8_STAGE(PG8_SB(1, 1), cB + hstep + kstep, voffB);
    PG8_WAIT_V(6); PG8_BAR;
    for (;;) {
        const bool has_next = S.next(ui + 1, nxt);
        const char* nA = has_next ? S.a_ptr(nxt) : cA; const char* nB = has_next ? S.b_ptr(nxt) : cB;
        if constexpr (GA) { if (has_next) S.a_voff(nxt, K, sR, sC, voffAn);
            else {
#pragma unroll
                for (int h = 0; h < 2; ++h)
#pragma unroll
                    for (int i = 0; i < 2; ++i) voffAn[h][i] = voffA[h][i]; } }
        for (int t = 0; t < nt; t += 2) {
            const bool last = (t == nt - 2);
            const char* a1 = cA + (size_t)(t + 1) * kstep;
            const char* a2 = last ? nA : cA + (size_t)(t + 2) * kstep; const char* b2 = last ? nB : cB + (size_t)(t + 2) * kstep;
            const char* a3 = a2 + kstep; const char* b3 = b2 + kstep;
            unsigned vs[2][2];
            if constexpr (GA) {
#pragma unroll
                for (int i = 0; i < 2; ++i) { vs[0][i] = last ? voffAn[0][i] : voffA[0][i]; vs[1][i] = last ? voffAn[1][i] : voffA[1][i]; } }
            PG8_LDB(B0, 0, 0); PG8_LDB(B1, 0, 1); PG8_SCHED; PG8_LDA(At, 0, 0); PG8_STAGE_A(PG8_SA(1, 1), a1, 1, voffA);
            PG8_WAIT_V(8); PG8_WAIT_L(0); PG8_BAR; PG8_MMA(0, 0, At, B0); PG8_MMA(0, 1, At, B1); PG8_BAR; PG8_SCHED;
            PG8_LDA(At, 0, 1); PG8_STAGE(PG8_SB(0, 0), b2, voffB); PG8_STAGE(PG8_SB(0, 1), b2 + hstep, voffB); PG8_STAGE_A(PG8_SA(0, 0), a2, 0, vs);
            PG8_WAIT_V(8); PG8_WAIT_L(0); PG8_BAR; PG8_MMA(1, 0, At, B0); PG8_MMA(1, 1, At, B1); PG8_BAR; PG8_SCHED;
            PG8_LDB(B0, 1, 0); PG8_LDB(B1, 1, 1); PG8_SCHED; PG8_LDA(At, 1, 0); PG8_STAGE_A(PG8_SA(0, 1), a2, 1, vs);
            PG8_WAIT_V(8); PG8_WAIT_L(0); PG8_BAR; PG8_MMA(0, 0, At, B0); PG8_MMA(0, 1, At, B1); PG8_BAR; PG8_SCHED;
            PG8_LDA(At, 1, 1); PG8_STAGE(PG8_SB(1, 0), b3, voffB); PG8_STAGE(PG8_SB(1, 1), b3 + hstep, voffB); PG8_STAGE_A(PG8_SA(1, 0), a3, 0, vs);
            PG8_WAIT_V(8); PG8_WAIT_L(0); PG8_BAR; PG8_MMA(1, 0, At, B0); PG8_MMA(1, 1, At, B1); PG8_BAR; PG8_SCHED;
        }
        if constexpr (ALIGN_EPI) { if (wr == 0) PG8_BAR; }
        E(acc, cur, wr, wc, fr, fq);
        if (!has_next) break;
#pragma unroll
        for (int a = 0; a < 2; ++a)
#pragma unroll
            for (int b = 0; b < 2; ++b)
#pragma unroll
                for (int m = 0; m < 4; ++m)
#pragma unroll
                    for (int n = 0; n < 2; ++n) acc[a][b][m][n] = (f32x4){0.f, 0.f, 0.f, 0.f};
        cur = nxt; cA = nA; cB = nB; ++ui;
        if constexpr (GA) {
#pragma unroll
            for (int h = 0; h < 2; ++h)
#pragma unroll
                for (int i = 0; i < 2; ++i) voffA[h][i] = voffAn[h][i]; }
        if constexpr (ALIGN_EPI) { if (wr == 1) PG8_BAR; }
    }
    PG8_WAIT_V(0);
    if constexpr (!ALIGN_EPI) { if (wr == 0) PG8_BAR; }
    PG8_BAR;
#undef PG8_SA
#undef PG8_SB
#undef PG8_STAGE
#undef PG8_STAGE_A
#undef PG8_LDA
#undef PG8_LDB
#undef PG8_MMA
#undef PG8_WAIT_V
#undef PG8_WAIT_L
#undef PG8_BAR
#undef PG8_SCHED
}
}
using pg8::Unit;
using pg8::cvt_pk_bf16;

DI float bflo(unsigned w) { return __uint_as_float(w << 16); }
DI float bfhi(unsigned w) { return __uint_as_float(w & 0xffff0000u); }
DI float bf2f(bf16 b) { return __uint_as_float(((unsigned)b) << 16); }
DI unsigned f2bf(float f) { unsigned u = __float_as_uint(f); return (u + 0x7fffu + ((u >> 16) & 1u)) >> 16; }
DI unsigned pk2(float lo, float hi) { return f2bf(lo) | (f2bf(hi) << 16); }
DI float sigmoid_f(float x) { return 1.0f / (1.0f + __expf(-x)); }
DI float softplus_f(float x) { return fmaxf(x, 0.f) + log1pf(__expf(-fabsf(x))); }
DI float softplus_fast(float x) { return fmaxf(x, 0.f) + __logf(1.0f + __expf(-fabsf(x))); }
DI float gelu_tanh_f(float x) { const float u = 0.7978845608028654f * (x + 0.044715f * x * x * x); return 0.5f * x * (1.0f + tanhf(u)); }
DI float wave_sum(float v) {
#pragma unroll
    for (int o = 1; o < 64; o <<= 1) v += __shfl_xor(v, o);
    return v;
}

struct EpiBf16Plain {
    static constexpr bool PERM = true;
    bf16* O; int ldc; float scale;
    DI void operator()(const f32x4 (&acc)[2][2][4][2], const Unit& u, int wr, int wc, int fr, int fq) const {
        const int row0 = u.pm * 256 + wr * 64 + fr, col0 = u.pn * 256 + wc * 32 + 8 * fq;
#pragma unroll
        for (int ai = 0; ai < 2; ++ai)
#pragma unroll
            for (int m = 0; m < 4; ++m) { bf16* rowp = O + (size_t)(row0 + ai * 128 + m * 16) * ldc + col0;
#pragma unroll
                for (int bj = 0; bj < 2; ++bj) { const f32x4 v0 = acc[ai][bj][m][0] * scale, v1 = acc[ai][bj][m][1] * scale;
                    u32x4 w; w.x = cvt_pk_bf16(v0[0], v0[1]); w.y = cvt_pk_bf16(v0[2], v0[3]); w.z = cvt_pk_bf16(v1[0], v1[1]); w.w = cvt_pk_bf16(v1[2], v1[3]);
                    *(u32x4*)(rowp + bj * 128) = w; } }
    }
};
template <bool RES_BF16> struct EpiBf16Res {
    static constexpr bool PERM = true;
    const void* Rz; bf16* O; int ldc;
    DI void operator()(const f32x4 (&acc)[2][2][4][2], const Unit& u, int wr, int wc, int fr, int fq) const {
        const int row0 = u.pm * 256 + wr * 64 + fr, col0 = u.pn * 256 + wc * 32 + 8 * fq;
#pragma unroll
        for (int ai = 0; ai < 2; ++ai)
#pragma unroll
            for (int m = 0; m < 4; ++m) { const size_t off = (size_t)(row0 + ai * 128 + m * 16) * ldc + col0;
#pragma unroll
                for (int bj = 0; bj < 2; ++bj) { f32x4 r0, r1;
                    if (RES_BF16) { const u32x4 rw = *(const u32x4*)((const bf16*)Rz + off + bj * 128); r0 = (f32x4){bflo(rw.x), bfhi(rw.x), bflo(rw.y), bfhi(rw.y)}; r1 = (f32x4){bflo(rw.z), bfhi(rw.z), bflo(rw.w), bfhi(rw.w)}; }
                    else { r0 = *(const f32x4*)((const float*)Rz + off + bj * 128); r1 = *(const f32x4*)((const float*)Rz + off + bj * 128 + 4); }
                    const f32x4 v0 = r0 + acc[ai][bj][m][0], v1 = r1 + acc[ai][bj][m][1];
                    u32x4 w; w.x = cvt_pk_bf16(v0[0], v0[1]); w.y = cvt_pk_bf16(v0[2], v0[3]); w.z = cvt_pk_bf16(v1[0], v1[1]); w.w = cvt_pk_bf16(v1[2], v1[3]);
                    *(u32x4*)(O + off + bj * 128) = w; } }
    }
};
struct EpiLora {
    static constexpr bool PERM = false;
    float* LWp; bf16* AAp; bf16* GGp; const float* w0; const float* a0;
    DI void operator()(const f32x4 (&acc)[2][2][4][2], const Unit& u, int wr, int wc, int fr, int fq) const {
        const int kind = u.pn >> 1;
        const int row0 = u.pm * 256 + wr * 64 + fr, col0 = (u.pn & 1) * 256 + wc * 32 + 4 * fq;
#pragma unroll
        for (int bj = 0; bj < 2; ++bj)
#pragma unroll
            for (int n = 0; n < 2; ++n) {
                const int c = col0 + bj * 128 + n * 16;
                f32x4 bias = (f32x4){0.f, 0.f, 0.f, 0.f};
                if (kind == 0) bias = *(const f32x4*)(w0 + c); else if (kind == 1) bias = *(const f32x4*)(a0 + c);
#pragma unroll
                for (int ai = 0; ai < 2; ++ai)
#pragma unroll
                    for (int m = 0; m < 4; ++m) {
                        f32x4 v = acc[ai][bj][m][n] + bias;
                        if (kind == 0) {
#pragma unroll
                            for (int j = 0; j < 4; ++j) { const float w = -softplus_fast(-v[j]) - 0.5f; v[j] = -__expf(w);     }
                        } else if (kind == 1) {
#pragma unroll
                            for (int j = 0; j < 4; ++j) v[j] = sigmoid_f(v[j]);
                        }
                        const size_t o_ = (size_t)(row0 + ai * 128 + m * 16) * 512 + c;
                        if (kind == 0) *(f32x4*)(LWp + o_) = v;
                        else { u32x2 w_; w_.x = cvt_pk_bf16(v[0], v[1]); w_.y = cvt_pk_bf16(v[2], v[3]); *(u32x2*)((kind == 1 ? AAp : GGp) + o_) = w_; }
                    }
            }
    }
};
struct EpiSwiglu {
    static constexpr bool PERM = true;
    bf16* ACT; const float* b_gu;
    DI void operator()(const f32x4 (&acc)[2][2][4][2], const Unit& u, int wr, int wc, int fr, int fq) const {
        const int row0 = u.pm * 256 + wr * 64 + fr, j0 = u.pn * 128 + wc * 32 + 8 * fq;
        const float* bg = b_gu + (size_t)u.e * 2048 + j0; const float* bu = bg + 1024;
        const f32x4 bg0 = *(const f32x4*)bg, bg1 = *(const f32x4*)(bg + 4), bu0 = *(const f32x4*)bu, bu1 = *(const f32x4*)(bu + 4);
#pragma unroll
        for (int ai = 0; ai < 2; ++ai)
#pragma unroll
            for (int m = 0; m < 4; ++m) {
                float o[8];
#pragma unroll
                for (int n = 0; n < 2; ++n) { const f32x4 g4 = acc[ai][0][m][n] + (n ? bg1 : bg0), u4 = acc[ai][1][m][n] + (n ? bu1 : bu0);
#pragma unroll
                    for (int j = 0; j < 4; ++j) { const float g = fminf(g4[j], 7.0f), up = fminf(fmaxf(u4[j], -7.0f), 7.0f); o[n * 4 + j] = (up + 1.0f) * (g * sigmoid_f(1.702f * g)); } }
                u32x4 w; w.x = cvt_pk_bf16(o[0], o[1]); w.y = cvt_pk_bf16(o[2], o[3]); w.z = cvt_pk_bf16(o[4], o[5]); w.w = cvt_pk_bf16(o[6], o[7]);
                *(u32x4*)(ACT + (size_t)(row0 + ai * 128 + m * 16) * 1024 + j0) = w;
            }
    }
};
struct EpiDown {
    static constexpr bool PERM = true;
    bf16* YS; const float* b_dn; const int* row_slot; const float* row_gate;
    DI void operator()(const f32x4 (&acc)[2][2][4][2], const Unit& u, int wr, int wc, int fr, int fq) const {
        const int row0 = u.pm * 256 + wr * 64 + fr, col0 = u.pn * 256 + wc * 32 + 8 * fq;
        const float* bb = b_dn + (size_t)u.e * 1024 + col0;
        f32x4 bv[2][2];
#pragma unroll
        for (int bj = 0; bj < 2; ++bj)
#pragma unroll
            for (int n = 0; n < 2; ++n) bv[bj][n] = *(const f32x4*)(bb + bj * 128 + 4 * n);
#pragma unroll
        for (int ai = 0; ai < 2; ++ai)
#pragma unroll
            for (int m = 0; m < 4; ++m) {
                const int r = row0 + ai * 128 + m * 16; const int slot = row_slot[r]; const float gt = row_gate[r];
                if (slot >= 0) { bf16* rowp = YS + (size_t)slot * 1024 + col0;
#pragma unroll
                    for (int bj = 0; bj < 2; ++bj) { const f32x4 v0 = (acc[ai][bj][m][0] + bv[bj][0]) * gt, v1 = (acc[ai][bj][m][1] + bv[bj][1]) * gt;
                        u32x4 w; w.x = cvt_pk_bf16(v0[0], v0[1]); w.y = cvt_pk_bf16(v0[2], v0[3]); w.z = cvt_pk_bf16(v1[0], v1[1]); w.w = cvt_pk_bf16(v1[2], v1[3]);
                        *(u32x4*)(rowp + bj * 128) = w; } }
            }
    }
};

constexpr size_t MiB = 1u << 20;
constexpr size_t WS_CTL = 0, CTL_ZERO_BYTES = 1 * MiB;
constexpr size_t WS_WIN = 1 * MiB, WS_WOUT = 7 * MiB, WS_WQ = 9 * MiB, WS_WK = 11 * MiB, WS_WV = 13 * MiB, WS_WO = 15 * MiB, WS_LORAB = 17 * MiB, WS_LRUW = 18 * MiB;
constexpr size_t WS_ROUTE = 19 * MiB;
constexpr size_t WS_WGU = 22 * MiB, WS_WDN = 150 * MiB;
constexpr size_t WS_HN = 214 * MiB, WS_MEMN = 246 * MiB, WS_KM = 248 * MiB, WS_VT = 250 * MiB;
constexpr size_t WS_X1 = 252 * MiB, WS_X2 = 316 * MiB;
constexpr size_t WS_U = 380 * MiB, WS_R = 468 * MiB, WS_KRAW = 500 * MiB, WS_V = 532 * MiB, WS_KKN = 564 * MiB, WS_WD = 596 * MiB, WS_AA = 628 * MiB, WS_G = 660 * MiB;
constexpr size_t WS_LA = 692 * MiB, WS_LB = 724 * MiB, WS_AP = 756 * MiB, WS_CAT = 764 * MiB, WS_Q = 796 * MiB;
constexpr size_t WS_XS = 380 * MiB, WS_ACT = 524 * MiB, WS_YS = 668 * MiB;
constexpr size_t WS_GP = 796 * MiB, WS_HF = 860 * MiB, WS_RP = 924 * MiB, WS_Y1F = 940 * MiB, WS_ADD = 972 * MiB, WS_END = 1004 * MiB;
constexpr size_t WS_GC = 468 * MiB, WS_HC = 484 * MiB, WS_ZS = 500 * MiB;
static_assert(WS_AA == WS_WD + 32 * MiB && WS_G == WS_AA + 32 * MiB, "EpiLora strides");
static_assert(WS_U + (size_t)M * INW * 2 <= WS_R && WS_XS + (size_t)MAXROWS * 2048 <= WS_ACT && WS_ACT + (size_t)MAXROWS * 2048 <= WS_YS && WS_YS + (size_t)NASSIGN * 2048 <= WS_Q, "ws map");
constexpr size_t RT_E = 0, RT_POS = 256 * 1024, RT_G = 512 * 1024, RT_SLOT = 768 * 1024, RT_GATE = 1088 * 1024, RT_TILE = 1408 * 1024, RT_TOK = 1472 * 1024;
constexpr int CW_BAR = 4096, CW_CNT = 8192;

constexpr int RING_BYTES = 131072, MISC_OFF = RING_BYTES + 320, LDS_BYTES = 147456;
constexpr int NWAVES = 8, NTHREADS = 512;

#define XB_TMO      128
#define XB_XCNT(j)  (256  + 64 * (j))
#define XB_XSUB(j)  (1280 + 64 * (j))
#define XB_XGEN(j)  (2304 + 64 * (j))
#define XB_TOP      3328
#define XB_TOPGEN   3392
#define XCD_BAR_WORDS 3456
#define XB_SPIN_CAP (1u << 18)
DI unsigned xb_ld(unsigned* p)              { return __hip_atomic_load(p, __ATOMIC_RELAXED, __HIP_MEMORY_SCOPE_AGENT); }
DI unsigned xb_add(unsigned* p, unsigned v) { return __hip_atomic_fetch_add(p, v, __ATOMIC_RELAXED, __HIP_MEMORY_SCOPE_AGENT); }
DI unsigned xb_xcc_id() { return (unsigned)__builtin_amdgcn_s_getreg((3 << 11) | 20) & 0xFu; }
#define XB_SPIN(cond, bar) do { unsigned _sp = 0; while (cond) { __builtin_amdgcn_s_sleep(1); \
    if ((++_sp & 255u) == 0u) { if (xb_ld(&(bar)[XB_TMO])) break; if (_sp > XB_SPIN_CAP) { atomicAdd(&(bar)[XB_TMO], 1u); break; } } } } while (0)
struct XcdBarrier { unsigned* bar; unsigned x; volatile LAS unsigned* st; };
DI XcdBarrier xcd_barrier_post(unsigned* bar, volatile LAS unsigned* st) {
    XcdBarrier b; b.bar = bar; b.x = xb_xcc_id(); b.st = st;
    if (threadIdx.x == 0) (void)xb_add(&bar[XB_XCNT(b.x)], 1u);
    return b;
}
DI void xcd_barrier_complete(unsigned* bar, unsigned x, unsigned& nloc, unsigned& nx) {
    const unsigned G = gridDim.x * gridDim.y * gridDim.z;
    unsigned sum, cnt, mine, sp = 0u;
    for (;;) {
        sum = 0u; cnt = 0u; mine = 0u;
#pragma unroll
        for (unsigned j = 0; j < 16; ++j) { const unsigned c = xb_ld(&bar[XB_XCNT(j)]); sum += c; cnt += (c > 0u) ? 1u : 0u; mine = (j == x) ? c : mine; }
        if (sum == G) break;
        __builtin_amdgcn_s_sleep(1);
        if ((++sp & 255u) == 0u) { if (xb_ld(&bar[XB_TMO])) break; if (sp > XB_SPIN_CAP) { atomicAdd(&bar[XB_TMO], 1u); break; } }
    }
    nloc = mine > 0u ? mine : 1u; nx = cnt > 0u ? cnt : 1u;
}
DI void xcd_barrier(const XcdBarrier& b) {
    asm volatile("s_waitcnt vmcnt(0)" ::: "memory");
    __syncthreads();
    if (threadIdx.x == 0) {
        unsigned* bar = b.bar;
        __builtin_amdgcn_s_waitcnt(0);
        unsigned nloc = b.st[0], nx = b.st[1];
        if (nloc == 0u) { xcd_barrier_complete(bar, b.x, nloc, nx); b.st[0] = nloc; b.st[1] = nx; }
        const unsigned old = xb_add(&bar[XB_XSUB(b.x)], 1u);
        const unsigned gen = old / nloc;
        if (old + 1u == (gen + 1u) * nloc) {
            __builtin_amdgcn_fence(__ATOMIC_RELEASE, "agent");
            asm volatile("s_waitcnt vmcnt(0)" ::: "memory");
            const unsigned og = xb_add(&bar[XB_TOP], 1u);
            const unsigned tg = og / nx;
            if (og + 1u == (tg + 1u) * nx) xb_add(&bar[XB_TOPGEN], 1u);
            else XB_SPIN(xb_ld(&bar[XB_TOPGEN]) == tg, bar);
            __builtin_amdgcn_fence(__ATOMIC_ACQUIRE, "agent");
            xb_add(&bar[XB_XGEN(b.x)], 1u);
            asm volatile("s_waitcnt vmcnt(0)" ::: "memory");
        } else {
            XB_SPIN(xb_ld(&bar[XB_XGEN(b.x)]) == gen, bar);
            __builtin_amdgcn_fence(__ATOMIC_ACQUIRE, "agent");
            asm volatile("s_waitcnt vmcnt(0)" ::: "memory");
        }
    }
    __syncthreads();
}

struct Args { const float* in[37]; float* out; unsigned char* ws; int ph_lo, ph_hi; };
enum { I_X = 0, I_MEM, I_NMIXG, I_WIN, I_CONVW, I_CONVB, I_LWX, I_LBX, I_LWA, I_LBA, I_LAM, I_MU, I_W0, I_WUP, I_A0, I_AUP, I_GUP, I_KK, I_KA, I_RK, I_LNG, I_LNB,
       I_WOUT, I_NXAG, I_NMEMG, I_WQ, I_WK, I_WV, I_WO, I_NFFG, I_WR, I_BR, I_WGU, I_BGU, I_WDN, I_BDN, I_FNG };

DI void transpose_item(const float* W, int ldw, int K, bf16* WT, int k0, int n0, int drow0, LAS float* scr, int lane) {
#pragma unroll 8
    for (int i = 0; i < 32; ++i) { const int kk = 2 * i + (lane >> 5); scr[kk * 33 + (lane & 31)] = W[(size_t)(k0 + kk) * ldw + n0 + (lane & 31)]; }
    asm volatile("s_waitcnt lgkmcnt(0)" ::: "memory");
    const int c = lane & 7;
#pragma unroll
    for (int j = 0; j < 4; ++j) { const int n = (lane >> 3) + 8 * j; const LAS float* s = scr + (8 * c) * 33 + n;
        u32x4 o; o.x = pk2(s[0 * 33], s[1 * 33]); o.y = pk2(s[2 * 33], s[3 * 33]); o.z = pk2(s[4 * 33], s[5 * 33]); o.w = pk2(s[6 * 33], s[7 * 33]);
        *(u32x4*)(WT + (size_t)(drow0 + n) * K + k0 + 8 * c) = o; }
    asm volatile("s_waitcnt lgkmcnt(0)" ::: "memory");
}
DI void rms_row_to_bf16(const float* xrow, const float* g, bf16* orow, int lane) {
    const f32x4* xr = (const f32x4*)xrow + lane; const f32x4* gr = (const f32x4*)g + lane;
    f32x4 v[4]; float s = 0.f;
#pragma unroll
    for (int j = 0; j < 4; ++j) { v[j] = xr[64 * j]; s += (v[j].x * v[j].x + v[j].y * v[j].y) + (v[j].z * v[j].z + v[j].w * v[j].w); }
    const float rstd = 1.0f / sqrtf(wave_sum(s) * (1.f / D) + EPS);
    u32x2* o8 = (u32x2*)orow + lane;
#pragma unroll
    for (int j = 0; j < 4; ++j) { const f32x4 gg = gr[64 * j]; u32x2 w; w.x = pk2(v[j].x * rstd * gg.x, v[j].y * rstd * gg.y); w.y = pk2(v[j].z * rstd * gg.z, v[j].w * rstd * gg.w); o8[64 * j] = w; }
}

DI void rms_rowbf_to_bf16(const bf16* xrow, const float* g, bf16* orow, int lane) {
    float v[16]; float s = 0.f;
#pragma unroll
    for (int hf = 0; hf < 2; ++hf) { const u32x4 w = *(const u32x4*)(xrow + 512 * hf + 8 * lane);
#pragma unroll
        for (int q = 0; q < 4; ++q) { v[8 * hf + 2 * q] = bflo(w[q]); v[8 * hf + 2 * q + 1] = bfhi(w[q]); } }
#pragma unroll
    for (int j = 0; j < 16; ++j) s += v[j] * v[j];
    const float rstd = 1.0f / sqrtf(wave_sum(s) * (1.f / D) + EPS);
#pragma unroll
    for (int hf = 0; hf < 2; ++hf) { const f32x4 g0 = *(const f32x4*)(g + 512 * hf + 8 * lane), g1 = *(const f32x4*)(g + 512 * hf + 8 * lane + 4);
        u32x4 w; w.x = pk2(v[8 * hf] * rstd * g0.x, v[8 * hf + 1] * rstd * g0.y); w.y = pk2(v[8 * hf + 2] * rstd * g0.z, v[8 * hf + 3] * rstd * g0.w);
        w.z = pk2(v[8 * hf + 4] * rstd * g1.x, v[8 * hf + 5] * rstd * g1.y); w.w = pk2(v[8 * hf + 6] * rstd * g1.z, v[8 * hf + 7] * rstd * g1.w);
        *(u32x4*)(orow + 512 * hf + 8 * lane) = w; }
}

__global__ void __launch_bounds__(NTHREADS, 2) fwd(Args args) {
    extern __shared__ __attribute__((aligned(16))) unsigned char lds_raw[];
    LAS unsigned char* lds = (LAS unsigned char*)lds_raw;
    volatile LAS unsigned* MISC = (volatile LAS unsigned*)(lds + MISC_OFF);
    const int G = gridDim.x, bid = blockIdx.x, NGW = G * NWAVES;
#define PHASE_IDS const int tid = fresh_tid(), lane = tid & 63, wave = __builtin_amdgcn_readfirstlane(tid >> 6), gw = bid * NWAVES + wave; (void)tid; (void)lane; (void)wave; (void)gw
    unsigned char* ws = args.ws;
    unsigned* ctl = (unsigned*)(ws + WS_CTL);
    const int lo = args.ph_lo, hi = args.ph_hi;

    for (int u = threadIdx.x; u < (LDS_BYTES - RING_BYTES) / 4; u += NTHREADS) ((LAS unsigned*)(lds + RING_BYTES))[u] = 0u;
    __syncthreads();
    XcdBarrier bar; bar.bar = ctl + CW_BAR; bar.x = 0; bar.st = nullptr;
    if (hi - lo > 1) bar = xcd_barrier_post(ctl + CW_BAR, MISC + 8);
#define IN(k) (lo <= (k) && (k) < hi)
#define SEAM(k) do { if (IN(k) && IN((k) + 1)) xcd_barrier(bar); } while (0)

#define Win_t ((bf16*)(ws + WS_WIN))
#define Wout_t ((bf16*)(ws + WS_WOUT))
#define Wq_t ((bf16*)(ws + WS_WQ))
#define Wk_t ((bf16*)(ws + WS_WK))
#define Wv_t ((bf16*)(ws + WS_WV))
#define Wo_t ((bf16*)(ws + WS_WO))
#define LoraB ((bf16*)(ws + WS_LORAB))
#define LruW ((bf16*)(ws + WS_LRUW))
#define Wgu_t ((bf16*)(ws + WS_WGU))
#define Wdn_t ((bf16*)(ws + WS_WDN))
#define HN ((bf16*)(ws + WS_HN))
#define MEMN ((bf16*)(ws + WS_MEMN))
#define KM ((bf16*)(ws + WS_KM))
#define VT ((bf16*)(ws + WS_VT))
#define X1 ((bf16*)(ws + WS_X1))
#define X2 ((bf16*)(ws + WS_X2))
#define U ((bf16*)(ws + WS_U))
#define Rr ((float*)(ws + WS_R))
#define KRAW ((float*)(ws + WS_KRAW))
#define Vv ((float*)(ws + WS_V))
#define KKN ((float*)(ws + WS_KKN))
#define WD ((float*)(ws + WS_WD))
#define AA ((float*)(ws + WS_AA))
#define GG ((float*)(ws + WS_G))
#define LA ((bf16*)(ws + WS_LA))
#define LB ((bf16*)(ws + WS_LB))
#define AP ((bf16*)(ws + WS_AP))
#define CAT ((bf16*)(ws + WS_CAT))
#define Qb ((bf16*)(ws + WS_Q))
#define Ob CAT
#define XS ((bf16*)(ws + WS_XS))
#define ACT ((bf16*)(ws + WS_ACT))
#define YS ((bf16*)(ws + WS_YS))
#define route_e ((int*)(ws + WS_ROUTE + RT_E))
#define route_pos ((int*)(ws + WS_ROUTE + RT_POS))
#define route_g ((float*)(ws + WS_ROUTE + RT_G))
#define row_slot ((int*)(ws + WS_ROUTE + RT_SLOT))
#define row_gate ((float*)(ws + WS_ROUTE + RT_GATE))
#define tile_tab ((int*)(ws + WS_ROUTE + RT_TILE))
#define row_tok ((int*)(ws + WS_ROUTE + RT_TOK))
#define ecnt (ctl + CW_CNT)

    if (IN(0)) { PHASE_IDS;
        LAS float* scr = (LAS float*)(lds + wave * 16384);
        constexpr int I_IN = 16 * (INW / 32), I_SQ = 16 * 32;
        constexpr int N_ITEMS = I_IN + 5 * I_SQ;
        for (int it = gw; it < N_ITEMS; it += NGW) {
            int r = it;
            if (r < I_IN) { const int nblk = INW / 32, kb = r / nblk, nb = r % nblk; transpose_item(args.in[I_WIN], INW, D, Win_t, 64 * kb, 32 * nb, 32 * nb, scr, lane); continue; } r -= I_IN;
            { const int w = r / I_SQ, q = r % I_SQ, kb = q / 32, nb = q % 32;
                const float* src = w == 0 ? args.in[I_WOUT] : w == 1 ? args.in[I_WQ] : w == 2 ? args.in[I_WK] : w == 3 ? args.in[I_WV] : args.in[I_WO];
                bf16* dst = w == 0 ? Wout_t : w == 1 ? Wq_t : w == 2 ? Wk_t : w == 3 ? Wv_t : Wo_t;
                transpose_item(src, D, D, dst, 64 * kb, 32 * nb, 32 * nb, scr, lane); }
        }
        for (int idx = bid * NTHREADS + tid; idx < 1536 * 256; idx += G * NTHREADS) {
            const int n = idx >> 8, k = idx & 255; float v = 0.f;
            if (n < 512) { if (k < 64) v = args.in[I_WUP][k * 512 + n]; }
            else if (n < 1024) { if (k >= 64 && k < 128) v = args.in[I_AUP][(k - 64) * 512 + (n - 512)]; }
            else { if (k >= 128) v = args.in[I_GUP][(k - 128) * 512 + (n - 1024)]; }
            LoraB[idx] = (bf16)f2bf(v);
        }
        for (int idx = bid * NTHREADS + tid; idx < 8 * 128 * 64; idx += G * NTHREADS) {
            const int nb = idx >> 13, col = (idx >> 6) & 127, k = idx & 63;
            const float v = col < 64 ? args.in[I_LWX][nb * 4096 + k * 64 + col] : args.in[I_LWA][nb * 4096 + k * 64 + (col - 64)];
            LruW[idx] = (bf16)f2bf(v);
        }
        for (int m = gw; m < M; m += NGW) rms_row_to_bf16(args.in[I_X] + (size_t)m * D, args.in[I_NMIXG], HN + (size_t)m * D, lane);
        for (int m = gw; m < MROWS; m += NGW) rms_row_to_bf16(args.in[I_MEM] + (size_t)m * D, args.in[I_NMEMG], MEMN + (size_t)m * D, lane);
    }
    SEAM(0);

    if (IN(1)) { PHASE_IDS;
        { pg8::DenseSched S; S.o.init_tiles(M / 256, INW / 256, G, bid); S.A = (const char*)HN; S.B = (const char*)Win_t; S.tstep = (size_t)256 * D * 2;
          EpiBf16Plain E{U, INW, 1.0f}; pg8::gemm_phase(lds, D, S, E); }
        { pg8::DenseSched S; S.o.init_tiles(MROWS / 256, D / 256, G, (bid + 64) & (G - 1)); S.A = (const char*)MEMN; S.B = (const char*)Wk_t; S.tstep = (size_t)256 * D * 2;
          EpiBf16Plain E{KM, D, 1.0f}; pg8::gemm_phase(lds, D, S, E); }
        { pg8::DenseSched S; S.o.init_tiles(D / 256, MROWS / 256, G, (bid + 48) & (G - 1)); S.A = (const char*)Wv_t; S.B = (const char*)MEMN; S.tstep = (size_t)256 * D * 2;
          EpiBf16Plain E{VT, MROWS, 1.0f}; pg8::gemm_phase(lds, D, S, E); }
    }
    SEAM(1);

    if (IN(2)) { PHASE_IDS;
        const float* mu = args.in[I_MU];
        for (int m = gw; m < M; m += NGW) {
            const bool hp = (m & (SEQ - 1)) != 0;
            const bf16* ur = U + (size_t)m * INW + 2560 + 4 * lane;
            const u32x2 cu = *(const u32x2*)ur; u32x2 pu = (u32x2){0u, 0u}; if (hp) pu = *(const u32x2*)(ur - INW);
            const f32x4 m4 = *(const f32x4*)(mu + 1536 + 4 * lane);
            f32x4 uu; { const float a0 = bflo(cu.x), a1 = bfhi(cu.x), a2 = bflo(cu.y), a3 = bfhi(cu.y), p0 = bflo(pu.x), p1 = bfhi(pu.x), p2 = bflo(pu.y), p3 = bfhi(pu.y);
                uu.x = a0 + (p0 - a0) * m4.x; uu.y = a1 + (p1 - a1) * m4.y; uu.z = a2 + (p2 - a2) * m4.z; uu.w = a3 + (p3 - a3) * m4.w; }
            f32x4 o = uu;
            if (lane < 16) { o.x = tanhf(uu.x); o.y = tanhf(uu.y); o.z = tanhf(uu.z); o.w = tanhf(uu.w); }
            else if (lane >= 32) { o.x = sigmoid_f(uu.x); o.y = sigmoid_f(uu.y); o.z = sigmoid_f(uu.z); o.w = sigmoid_f(uu.w); }
            u32x2 w; w.x = pk2(o.x, o.y); w.y = pk2(o.z, o.w); *(u32x2*)(AP + (size_t)m * 256 + 4 * lane) = w;
        }
        {
            const float* conv_w = args.in[I_CONVW]; const float* conv_b = args.in[I_CONVB]; const float* bx = args.in[I_LBX]; const float* ba = args.in[I_LBA]; const float* lam = args.in[I_LAM];
            LAS float* xs = (LAS float*)(lds + wave * 4096);
            const int i = lane & 15, kg = lane >> 4;
            for (int unit = gw; unit < (M / 16) * 2; unit += NGW) {
                const int tile = unit >> 1, nb0 = (unit & 1) * 4, m0 = tile * 16, s0 = m0 & (SEQ - 1);
                for (int nb = nb0; nb < nb0 + 4; ++nb) {
                    bf16x8 af[2];
#pragma unroll
                    for (int ks = 0; ks < 2; ++ks) {
                        const int chb = nb * 64 + 32 * ks + 8 * kg;
                        f32x4 x0 = *(const f32x4*)(conv_b + chb), x1 = *(const f32x4*)(conv_b + chb + 4);
#pragma unroll
                        for (int j = 0; j < 4; ++j) {
                            if (s0 + i - 3 + j >= 0) {
                                const u32x4 uw = *(const u32x4*)(U + (size_t)(m0 + i - 3 + j) * INW + chb);
                                const f32x4 w0 = *(const f32x4*)(conv_w + j * 512 + chb), w1 = *(const f32x4*)(conv_w + j * 512 + chb + 4);
                                x0.x += w0.x * bflo(uw.x); x0.y += w0.y * bfhi(uw.x); x0.z += w0.z * bflo(uw.y); x0.w += w0.w * bfhi(uw.y);
                                x1.x += w1.x * bflo(uw.z); x1.y += w1.y * bfhi(uw.z); x1.z += w1.z * bflo(uw.w); x1.w += w1.w * bfhi(uw.w);
                            }
                        }
                        *(LAS f32x4*)(xs + i * 64 + 32 * ks + 8 * kg) = x0; *(LAS f32x4*)(xs + i * 64 + 32 * ks + 8 * kg + 4) = x1;
                        u32x4 p; p.x = pk2(x0.x, x0.y); p.y = pk2(x0.z, x0.w); p.z = pk2(x1.x, x1.y); p.w = pk2(x1.z, x1.w);
                        af[ks] = __builtin_bit_cast(bf16x8, p);
                    }
                    f32x4 acc[8];
#pragma unroll
                    for (int ct = 0; ct < 8; ++ct) { acc[ct] = (f32x4){0.f, 0.f, 0.f, 0.f};
#pragma unroll
                        for (int ks = 0; ks < 2; ++ks) { const bf16x8 bfr = *(const bf16x8*)(LruW + ((size_t)(nb * 128 + 16 * ct + i) * 64 + 32 * ks + 8 * kg));
                            acc[ct] = __builtin_amdgcn_mfma_f32_16x16x32_bf16(af[ks], bfr, acc[ct], 0, 0, 0); } }
                    asm volatile("s_waitcnt lgkmcnt(0)" ::: "memory");
#pragma unroll
                    for (int ct = 0; ct < 4; ++ct) {
                        const int col = 16 * ct + i, ch = nb * 64 + col;
                        const float bxv = bx[ch], bav = ba[ch], sp = softplus_f(-lam[ch]);
#pragma unroll
                        for (int e = 0; e < 4; ++e) {
                            const int tok = 4 * kg + e;
                            const float gx = sigmoid_f(acc[ct][e] + bxv), ga = sigmoid_f(acc[ct + 4][e] + bav);
                            const float la = -8.0f * ga * sp, xcv = xs[tok * 64 + col];
                            const float bt = sqrtf(fmaxf(-expm1f(2.0f * la), 0.f)) * gx * xcv;
                            LA[(size_t)(m0 + tok) * 512 + ch] = (bf16)f2bf(la); LB[(size_t)(m0 + tok) * 512 + ch] = (bf16)f2bf(bt);
                        }
                    }
                }
            }
        }
    }
    SEAM(2);

    if (IN(3)) { PHASE_IDS;
        pg8::DenseSched S; S.o.init_tiles(M / 256, 1536 / 256, G, bid); S.A = (const char*)AP; S.B = (const char*)LoraB; S.tstep = (size_t)256 * 256 * 2;
        EpiLora E{WD, (bf16*)(ws + WS_AA), (bf16*)(ws + WS_G), args.in[I_W0], args.in[I_A0]}; pg8::gemm_phase(lds, 256, S, E);
    }
    SEAM(3);

#define RW_ZB(zz, zb) do { _Pragma("unroll") for (int ks_ = 0; ks_ < 2; ++ks_) { u32x4 p_; p_.x = pk2(zz[2 * ks_][0], zz[2 * ks_][1]); p_.y = pk2(zz[2 * ks_][2], zz[2 * ks_][3]); \
        p_.z = pk2(zz[2 * ks_ + 1][0], zz[2 * ks_ + 1][1]); p_.w = pk2(zz[2 * ks_ + 1][2], zz[2 * ks_ + 1][3]); zb[ks_] = __builtin_bit_cast(bf16x8, p_); } } while (0)
    if (IN(4)) { PHASE_IDS;
        for (int u64 = gw; u64 < NB * NH * (SEQ / 64); u64 += NGW) {
#pragma unroll 1
        for (int jj = 0; jj < 4; ++jj) {
        LAS unsigned char* wl = lds + wave * 16384;
        LAS bf16* Arm = (LAS bf16*)(wl); LAS bf16* Brm = (LAS bf16*)(wl + 2048); LAS bf16* Krm = (LAS bf16*)(wl + 4096); LAS bf16* Rrm = (LAS bf16*)(wl + 6144);
        LAS bf16* ATt = (LAS bf16*)(wl + 8192); LAS bf16* BTt = (LAS bf16*)(wl + 10240); LAS bf16* KTt = (LAS bf16*)(wl + 12288); LAS bf16* VTt = (LAS bf16*)(wl + 14336);
        LAS float* MabT = (LAS float*)(wl); LAS bf16* Mak = (LAS bf16*)(wl + 1024); LAS bf16* Mrb = (LAS bf16*)(wl + 1536); LAS bf16* Mrk = (LAS bf16*)(wl + 2048); LAS bf16* Tm = (LAS bf16*)(wl + 2560);
        LAS float* PLs = (LAS float*)(wl + 3072); LAS bf16* Q0T = (LAS bf16*)(wl + 4096);
        const int lane = fresh_tid() & 63, l15 = lane & 15, g = lane >> 4, te = lane >> 2, kq = lane & 3;
        const bf16x8 z8 = (bf16x8){0, 0, 0, 0, 0, 0, 0, 0};
        const f32x4 z4 = (f32x4){0.f, 0.f, 0.f, 0.f};
            const int un = u64 * 4 + jj;
            const int bh = un >> 8, c = un & 255, b = bh >> 3, h = bh & 7;
            const size_t mrow = (size_t)b * SEQ + c * 16 + te, off = mrow * 512 + h * 64 + 16 * kq;
            const int hc = h * 64 + 16 * kq;
            float cl[16], eP[16];
            {
                float lwv[16], rl[16], kl[16], vl[16], kn[16], av[16];
                const bool hp = (mrow & (SEQ - 1)) != 0;
                const bf16* ub = U + mrow * INW + 1024 + hc;
#pragma unroll
                for (int hh = 0; hh < 2; ++hh) {
#pragma unroll
                    for (int a3 = 0; a3 < 3; ++a3) {
                        const u32x4 cu = *(const u32x4*)(ub + 512 * a3 + 8 * hh); u32x4 pu = (u32x4){0u, 0u, 0u, 0u}; if (hp) pu = *(const u32x4*)(ub - INW + 512 * a3 + 8 * hh);
                        const f32x4 m0 = *(const f32x4*)(args.in[I_MU] + 512 * a3 + hc + 8 * hh), m1 = *(const f32x4*)(args.in[I_MU] + 512 * a3 + hc + 8 * hh + 4);
                        float o8[8];
#pragma unroll
                        for (int q = 0; q < 4; ++q) { const float c0 = bflo(cu[q]), c1 = bfhi(cu[q]), p0 = bflo(pu[q]), p1 = bfhi(pu[q]); const float mm0 = q < 2 ? m0[2 * q] : m1[2 * q - 4], mm1 = q < 2 ? m0[2 * q + 1] : m1[2 * q - 3];
                            o8[2 * q] = c0 + (p0 - c0) * mm0; o8[2 * q + 1] = c1 + (p1 - c1) * mm1; }
#pragma unroll
                        for (int q = 0; q < 8; ++q) { if (a3 == 0) rl[8 * hh + q] = o8[q]; else if (a3 == 1) kl[8 * hh + q] = o8[q]; else vl[8 * hh + q] = o8[q]; }
                    }
                    const u32x4 aw = *(const u32x4*)((const bf16*)(ws + WS_AA) + off + 8 * hh);
#pragma unroll
                    for (int q = 0; q < 4; ++q) { av[8 * hh + 2 * q] = bflo(aw[q]); av[8 * hh + 2 * q + 1] = bfhi(aw[q]); }
                }
                float ss = 0.f;
#pragma unroll
                for (int j4 = 0; j4 < 4; ++j4) { const f32x4 x = *(const f32x4*)(WD + off + 4 * j4), kk4 = *(const f32x4*)(args.in[I_KK] + hc + 4 * j4); lwv[4 * j4] = x.x; lwv[4 * j4 + 1] = x.y; lwv[4 * j4 + 2] = x.z; lwv[4 * j4 + 3] = x.w;
#pragma unroll
                    for (int q = 0; q < 4; ++q) { kn[4 * j4 + q] = kl[4 * j4 + q] * kk4[q]; ss += kn[4 * j4 + q] * kn[4 * j4 + q]; } }
                ss += __shfl_xor(ss, 1); ss += __shfl_xor(ss, 2);
                const float kinv = 1.0f / fmaxf(sqrtf(ss), 1e-12f);
#pragma unroll
                for (int j = 0; j < 16; ++j) { float x = lwv[j];
#pragma unroll
                    for (int sft = 4; sft < 64; sft <<= 1) { const float y = __shfl_up(x, sft); if (lane >= sft) x += y; }
                    cl[j] = x; }
                float bon = 0.f;
                u32x4 pa[2], pb[2], pk[2], pr[2];
#pragma unroll
                for (int j4 = 0; j4 < 4; ++j4) {
                    const f32x4 ka = *(const f32x4*)(args.in[I_KA] + hc + 4 * j4), rk = *(const f32x4*)(args.in[I_RK] + hc + 4 * j4);
                    float at4[4], bt4[4], kt4[4], rt4[4];
#pragma unroll
                    for (int q = 0; q < 4; ++q) { const int j = 4 * j4 + q;
                        const float p = __expf(cl[j]), pn = __expf(-cl[j]), pm1 = __expf(cl[j] - lwv[j]); eP[j] = p;
                        const float knj = kn[j] * kinv;
                        const float kp = kl[j] * (1.0f + (av[j] - 1.0f) * ka[q]);
                        at4[q] = -knj * pm1; bt4[q] = knj * av[j] * pn; kt4[q] = kp * pn; rt4[q] = rl[j] * p;
                        bon += rl[j] * kp * rk[q];
                        const int kk = 16 * kq + j;
                        ATt[kk * 16 + te] = (bf16)f2bf(at4[q]); BTt[kk * 16 + te] = (bf16)f2bf(bt4[q]); KTt[kk * 16 + te] = (bf16)f2bf(kt4[q]); VTt[kk * 16 + te] = (bf16)f2bf(vl[j]); }
                    const int hh = j4 >> 1, w2 = (j4 & 1) * 2;
                    pa[hh][w2] = pk2(at4[0], at4[1]); pa[hh][w2 + 1] = pk2(at4[2], at4[3]); pb[hh][w2] = pk2(bt4[0], bt4[1]); pb[hh][w2 + 1] = pk2(bt4[2], bt4[3]);
                    pk[hh][w2] = pk2(kt4[0], kt4[1]); pk[hh][w2 + 1] = pk2(kt4[2], kt4[3]); pr[hh][w2] = pk2(rt4[0], rt4[1]); pr[hh][w2 + 1] = pk2(rt4[2], rt4[3]);
                }
#pragma unroll
                for (int hh = 0; hh < 2; ++hh) { const int po = te * 64 + 8 * ((2 * kq + hh) ^ (te & 7));
                    *(LAS u32x4*)(Arm + po) = pa[hh]; *(LAS u32x4*)(Brm + po) = pb[hh]; *(LAS u32x4*)(Krm + po) = pk[hh]; *(LAS u32x4*)(Rrm + po) = pr[hh]; }
                bon += __shfl_xor(bon, 1); bon += __shfl_xor(bon, 2);
#pragma unroll
                for (int hh = 0; hh < 2; ++hh) { const u32x4 gw_ = *(const u32x4*)((const bf16*)(ws + WS_G) + off + 8 * hh);
#pragma unroll
                    for (int q2 = 0; q2 < 2; ++q2) { const f32x4 lb = *(const f32x4*)(args.in[I_LNB] + hc + 8 * hh + 4 * q2); const int j0 = 8 * hh + 4 * q2;
                        f32x4 o; o.x = (lb.x + vl[j0] * bon) * bflo(gw_[2 * q2]); o.y = (lb.y + vl[j0 + 1] * bon) * bfhi(gw_[2 * q2]); o.z = (lb.z + vl[j0 + 2] * bon) * bflo(gw_[2 * q2 + 1]); o.w = (lb.w + vl[j0 + 3] * bon) * bfhi(gw_[2 * q2 + 1]);
                        u32x2 ow; ow.x = pk2(o.x, o.y); ow.y = pk2(o.z, o.w); *(u32x2*)((bf16*)(ws + WS_ADD) + off + j0) = ow; } }
            }
            asm volatile("s_waitcnt lgkmcnt(0)" ::: "memory");
            {
                bf16x8 fa[2], fr[2], fb[2], fk[2];
#pragma unroll
                for (int ks = 0; ks < 2; ++ks) { const int po = l15 * 64 + 8 * ((4 * ks + g) ^ (l15 & 7));
                    fa[ks] = *(const LAS bf16x8*)(Arm + po); fr[ks] = *(const LAS bf16x8*)(Rrm + po); fb[ks] = *(const LAS bf16x8*)(Brm + po); fk[ks] = *(const LAS bf16x8*)(Krm + po); }
                f32x4 mab = z4, mak = z4, mrb = z4, mrk = z4;
#pragma unroll
                for (int ks = 0; ks < 2; ++ks) { mab = __builtin_amdgcn_mfma_f32_16x16x32_bf16(fb[ks], fa[ks], mab, 0, 0, 0); mak = __builtin_amdgcn_mfma_f32_16x16x32_bf16(fk[ks], fa[ks], mak, 0, 0, 0);
                    mrb = __builtin_amdgcn_mfma_f32_16x16x32_bf16(fb[ks], fr[ks], mrb, 0, 0, 0); mrk = __builtin_amdgcn_mfma_f32_16x16x32_bf16(fk[ks], fr[ks], mrk, 0, 0, 0); }
#pragma unroll
                for (int e = 0; e < 4; ++e) { const int i = 4 * g + e; if (!(i < l15)) { mab[e] = 0.f; mak[e] = 0.f; } if (!(i <= l15)) { mrb[e] = 0.f; mrk[e] = 0.f; } }
                asm volatile("s_waitcnt lgkmcnt(0)" ::: "memory");
#pragma unroll
                for (int e = 0; e < 4; ++e) MabT[(4 * g + e) * 16 + l15] = mab[e];
                u32x2 w; w.x = pk2(mak[0], mak[1]); w.y = pk2(mak[2], mak[3]); *(LAS u32x2*)(Mak + l15 * 16 + 4 * g) = w;
                w.x = pk2(mrb[0], mrb[1]); w.y = pk2(mrb[2], mrb[3]); *(LAS u32x2*)(Mrb + l15 * 16 + 4 * g) = w;
                w.x = pk2(mrk[0], mrk[1]); w.y = pk2(mrk[2], mrk[3]); *(LAS u32x2*)(Mrk + l15 * 16 + 4 * g) = w;
                if (te == 15) {
#pragma unroll
                    for (int j = 0; j < 16; ++j) PLs[16 * kq + j] = eP[j]; }
            }
            asm volatile("s_waitcnt lgkmcnt(0)" ::: "memory");
            {
                float y[16];
#pragma unroll
                for (int j = 15; j >= 0; --j) {
                    float acc = (j == l15) ? 1.0f : 0.0f;
                    float row[16];
#pragma unroll
                    for (int q = 0; q < 4; ++q) { const f32x4 x = *(const LAS f32x4*)(MabT + j * 16 + 4 * q); row[4 * q] = x.x; row[4 * q + 1] = x.y; row[4 * q + 2] = x.z; row[4 * q + 3] = x.w; }
#pragma unroll
                    for (int i = j + 1; i < 16; ++i) acc += y[i] * row[i];
                    y[j] = acc;
                }
                if (g == 0) { u32x4 t0, t1; t0.x = pk2(y[0], y[1]); t0.y = pk2(y[2], y[3]); t0.z = pk2(y[4], y[5]); t0.w = pk2(y[6], y[7]); t1.x = pk2(y[8], y[9]); t1.y = pk2(y[10], y[11]); t1.z = pk2(y[12], y[13]); t1.w = pk2(y[14], y[15]);
                    *(LAS u32x4*)(Tm + l15 * 16) = t0; *(LAS u32x4*)(Tm + l15 * 16 + 8) = t1; }
            }
            asm volatile("s_waitcnt lgkmcnt(0)" ::: "memory");
            {
                const bool act = g < 2; const int fo = l15 * 16 + 8 * g;
                const bf16x8 fT = act ? *(const LAS bf16x8*)(Tm + fo) : z8, fMak = act ? *(const LAS bf16x8*)(Mak + fo) : z8, fMrb = act ? *(const LAS bf16x8*)(Mrb + fo) : z8, fMrk = act ? *(const LAS bf16x8*)(Mrk + fo) : z8;
                bf16x8 fV[4], fQ1[4], fAh[4], fBT[4], fKT[4];
#pragma unroll
                for (int vt = 0; vt < 4; ++vt) { fV[vt] = act ? *(const LAS bf16x8*)(VTt + vt * 256 + fo) : z8; fBT[vt] = act ? *(const LAS bf16x8*)(BTt + vt * 256 + fo) : z8; fKT[vt] = act ? *(const LAS bf16x8*)(KTt + vt * 256 + fo) : z8; }
#pragma unroll
                for (int vt = 0; vt < 4; ++vt) { const f32x4 q0 = __builtin_amdgcn_mfma_f32_16x16x32_bf16(fMak, fV[vt], z4, 0, 0, 0);
                    u32x2 w; w.x = pk2(q0[0], q0[1]); w.y = pk2(q0[2], q0[3]); *(LAS u32x2*)(Q0T + vt * 256 + l15 * 16 + 4 * g) = w; }
#pragma unroll
                for (int kt = 0; kt < 4; ++kt) { const bf16x8 fA = act ? *(const LAS bf16x8*)(ATt + kt * 256 + fo) : z8; const f32x4 ah = __builtin_amdgcn_mfma_f32_16x16x32_bf16(fT, fA, z4, 0, 0, 0);
                    u32x2 w; w.x = pk2(ah[0], ah[1]); w.y = pk2(ah[2], ah[3]); *(LAS u32x2*)(ATt + kt * 256 + l15 * 16 + 4 * g) = w; }
                asm volatile("s_waitcnt lgkmcnt(0)" ::: "memory");
#pragma unroll
                for (int vt = 0; vt < 4; ++vt) { const bf16x8 fQ0 = act ? *(const LAS bf16x8*)(Q0T + vt * 256 + fo) : z8; const f32x4 q1 = __builtin_amdgcn_mfma_f32_16x16x32_bf16(fT, fQ0, z4, 0, 0, 0);
                    u32x2 w; w.x = pk2(q1[0], q1[1]); w.y = pk2(q1[2], q1[3]); *(LAS u32x2*)(Q0T + vt * 256 + l15 * 16 + 4 * g) = w; }
                asm volatile("s_waitcnt lgkmcnt(0)" ::: "memory");
#pragma unroll
                for (int vt = 0; vt < 4; ++vt) { fQ1[vt] = act ? *(const LAS bf16x8*)(Q0T + vt * 256 + fo) : z8; fAh[vt] = act ? *(const LAS bf16x8*)(ATt + vt * 256 + fo) : z8; }
                bf16* rp = (bf16*)(ws + WS_RP) + (size_t)un * 1024 + l15 * 64;
#pragma unroll
                for (int kt = 0; kt < 4; ++kt) {
                    const u32x2 rr = *(const LAS u32x2*)(Rrm + l15 * 64 + 8 * ((2 * kt + (g >> 1)) ^ (l15 & 7)) + 4 * (g & 1));
                    f32x4 ini; ini[0] = bflo(rr.x); ini[1] = bfhi(rr.x); ini[2] = bflo(rr.y); ini[3] = bfhi(rr.y);
                    const f32x4 rh = __builtin_amdgcn_mfma_f32_16x16x32_bf16(fAh[kt], fMrb, ini, 0, 0, 0);
                    u32x2 w; w.x = pk2(rh[0], rh[1]); w.y = pk2(rh[2], rh[3]); *(u32x2*)(rp + 32 * (kt >> 1) + 8 * g + 4 * (kt & 1)) = w;
                }
#pragma unroll
                for (int vt = 0; vt < 4; ++vt) { f32x4 y1 = __builtin_amdgcn_mfma_f32_16x16x32_bf16(fMrb, fQ1[vt], z4, 0, 0, 0); y1 = __builtin_amdgcn_mfma_f32_16x16x32_bf16(fMrk, fV[vt], y1, 0, 0, 0);
                    *(f32x4*)((float*)(ws + WS_Y1F) + ((size_t)(un * 4 + vt) * 64 + lane) * 4) = y1; }
                bf16* gp = (bf16*)(ws + WS_GP) + (size_t)un * 4096;
#pragma unroll
                for (int krt = 0; krt < 4; ++krt) { const float pl = PLs[16 * krt + l15];
#pragma unroll
                    for (int kct = 0; kct < 4; ++kct) { f32x4 ga = __builtin_amdgcn_mfma_f32_16x16x32_bf16(fAh[kct], fBT[krt], z4, 0, 0, 0);
                        if (kct == krt) {
#pragma unroll
                            for (int e = 0; e < 4; ++e) if (4 * g + e == l15) ga[e] += 1.0f; }
                        u32x2 w; w.x = pk2(ga[0] * pl, ga[1] * pl); w.y = pk2(ga[2] * pl, ga[3] * pl);
                        *(u32x2*)(gp + (16 * krt + l15) * 64 + 32 * (kct >> 1) + 8 * g + 4 * (kct & 1)) = w; } }
#pragma unroll
                for (int mt = 0; mt < 4; ++mt) { const f32x4 pl4 = *(const LAS f32x4*)(PLs + 16 * mt + 4 * g);
#pragma unroll
                    for (int vt = 0; vt < 4; ++vt) { f32x4 ha = __builtin_amdgcn_mfma_f32_16x16x32_bf16(fBT[mt], fQ1[vt], z4, 0, 0, 0); ha = __builtin_amdgcn_mfma_f32_16x16x32_bf16(fKT[mt], fV[vt], ha, 0, 0, 0);
                        u32x2 w; w.x = pk2(ha[0] * pl4[0], ha[1] * pl4[1]); w.y = pk2(ha[2] * pl4[2], ha[3] * pl4[3]);
                        *(u32x2*)((bf16*)(ws + WS_HF) + ((size_t)((un * 4 + vt) * 4 + mt) * 64 + lane) * 4) = w; } }
            }
            asm volatile("s_waitcnt lgkmcnt(0)" ::: "memory");
        }
        asm volatile("s_waitcnt vmcnt(0)" ::: "memory");
        { const int ltid = fresh_tid() & 63, l15 = ltid & 15, g = ltid >> 4, lane = ltid;
#pragma unroll 1
        for (int part = 0; part < 2; ++part) {
            f32x4 z[4][4];
#pragma unroll
            for (int sl = 0; sl < 4; ++sl)
#pragma unroll
                for (int mt = 0; mt < 4; ++mt)
#pragma unroll
                    for (int e = 0; e < 4; ++e) z[sl][mt][e] = (part == 0 && sl == mt && 4 * g + e == l15) ? 1.0f : 0.0f;
#pragma unroll 1
            for (int j = 0; j < 4; ++j) {
                const size_t un = (size_t)u64 * 4 + j;
                const bf16* gp = (const bf16*)(ws + WS_GP) + un * 4096 + l15 * 64 + 8 * g;
                bf16x8 gf[4][2];
#pragma unroll
                for (int mt = 0; mt < 4; ++mt) { gf[mt][0] = *(const bf16x8*)(gp + mt * 1024); gf[mt][1] = *(const bf16x8*)(gp + mt * 1024 + 32); }
#pragma unroll
                for (int sl = 0; sl < 4; ++sl) {
                    bf16x8 zb[2]; RW_ZB(z[sl], zb);
#pragma unroll
                    for (int mt = 0; mt < 4; ++mt) {
                        f32x4 a = (f32x4){0.f, 0.f, 0.f, 0.f};
                        if (part) { const u32x2 hh = *(const u32x2*)((const bf16*)(ws + WS_HF) + ((size_t)((un * 4 + sl) * 4 + mt) * 64 + lane) * 4); a[0] = bflo(hh.x); a[1] = bfhi(hh.x); a[2] = bflo(hh.y); a[3] = bfhi(hh.y); }
                        a = __builtin_amdgcn_mfma_f32_16x16x32_bf16(gf[mt][0], zb[0], a, 0, 0, 0); a = __builtin_amdgcn_mfma_f32_16x16x32_bf16(gf[mt][1], zb[1], a, 0, 0, 0);
                        z[sl][mt] = a;
                    }
                }
            }
            if (part == 0) {
                bf16* gc = (bf16*)(ws + WS_GC) + (size_t)u64 * 4096;
#pragma unroll
                for (int sl = 0; sl < 4; ++sl) { const int pc = 32 * (sl >> 1) + 8 * (l15 >> 2) + 4 * (sl & 1) + (l15 & 3);
#pragma unroll
                    for (int mt = 0; mt < 4; ++mt)
#pragma unroll
                        for (int e = 0; e < 4; ++e) gc[(16 * mt + 4 * g + e) * 64 + pc] = (bf16)f2bf(z[sl][mt][e]); }
            } else {
#pragma unroll
                for (int sl = 0; sl < 4; ++sl)
#pragma unroll
                    for (int mt = 0; mt < 4; ++mt) { u32x2 w; w.x = pk2(z[sl][mt][0], z[sl][mt][1]); w.y = pk2(z[sl][mt][2], z[sl][mt][3]);
                        *(u32x2*)((bf16*)(ws + WS_HC) + ((size_t)((u64 * 4 + sl) * 4 + mt) * 64 + lane) * 4) = w; }
            }
        }
        }
        }
        for (int lu = gw; lu < NB * 8 * 64; lu += NGW) {
            const int bc = lu >> 6, seg = lu & 63, b = bc >> 3, cg = bc & 7, ch = cg * 64 + lane;
            const size_t mb = (size_t)b * SEQ + seg * 64;
            float A = 1.f, B = 0.f;
#pragma unroll 16
            for (int t = 0; t < 64; ++t) { const float a = __expf(bf2f(LA[(mb + t) * 512 + ch])), bt = bf2f(LB[(mb + t) * 512 + ch]); B = a * B + bt; A *= a; }
            f32x2 ab; ab.x = A; ab.y = B; *(f32x2*)((float*)(ws + WS_AP) + ((size_t)lu * 64 + lane) * 2) = ab;
        }
    }
    SEAM(4);


    if (IN(5)) { PHASE_IDS;
        if (!(bid < 128 && wave == 0)) {
            const int wi = bid < 128 ? bid * 7 + (wave - 1) : 896 + (bid - 128) * 8 + wave, NW = 896 + (G - 128) * 8;
            for (int lu = wi; lu < NB * 8 * 64; lu += NW) {
                const int bc = lu >> 6, seg = lu & 63, b = bc >> 3, cg = bc & 7, ch = cg * 64 + lane;
                const size_t mb = (size_t)b * SEQ + seg * 64;
                float hst = 0.f;
                const f32x2* ag = (const f32x2*)((const float*)(ws + WS_AP)) + (size_t)(bc * 64) * 64 + lane;
#pragma unroll 8
                for (int sg = 0; sg < seg; ++sg) { const f32x2 ab = ag[(size_t)sg * 64]; hst = ab.x * hst + ab.y; }
#pragma unroll 16
                for (int t = 0; t < 64; ++t) { const float a = __expf(bf2f(LA[(mb + t) * 512 + ch])), bt = bf2f(LB[(mb + t) * 512 + ch]); hst = a * hst + bt;
                    const float gl = bf2f(U[(mb + t) * INW + 512 + ch]); CAT[(mb + t) * 1024 + ch] = (bf16)f2bf(hst * gelu_tanh_f(gl)); }
            }
            LAS float* scr = (LAS float*)(lds + wave * 16384);
            constexpr int I_GU = 16 * 64, I_DN = 16 * 32;
            for (int it = wi; it < NE * (I_GU + I_DN); it += NW) {
                int r = it;
                if (r < NE * I_GU) { const int e = r / I_GU, q = r % I_GU, kb = q / 64, nb = q % 64; const int n0 = 32 * nb;
                    const int drow = n0 < 1024 ? (256 * (n0 >> 7) + (n0 & 127)) : (256 * ((n0 - 1024) >> 7) + 128 + ((n0 - 1024) & 127));
                    transpose_item(args.in[I_WGU] + (size_t)e * D * 2048, 2048, D, Wgu_t + (size_t)e * 2048 * D, 64 * kb, n0, drow, scr, lane); continue; } r -= NE * I_GU;
                { const int e = r / I_DN, q = r % I_DN, kb = q / 32, nb = q % 32;
                  transpose_item(args.in[I_WDN] + (size_t)e * DFF * D, D, DFF, Wdn_t + (size_t)e * D * DFF, 64 * kb, 32 * nb, 32 * nb, scr, lane); }
            }
        } else {
            const int l15 = lane & 15, g = lane >> 4, bh = bid >> 2, vs = bid & 3;
            f32x4 z[4];
#pragma unroll
            for (int mt = 0; mt < 4; ++mt) z[mt] = (f32x4){0.f, 0.f, 0.f, 0.f};
            bf16x8 gA[4][2], gB[4][2], gC[4][2], gD[4][2]; u32x2 hA[4], hB[4], hC[4], hD[4];
#define SC_LOAD(gf, hf, C) do { const size_t u64_ = (size_t)bh * 64 + (C); const bf16* gp_ = (const bf16*)(ws + WS_GC) + u64_ * 4096 + l15 * 64 + 8 * g; \
                _Pragma("unroll") for (int mt = 0; mt < 4; ++mt) { gf[mt][0] = *(const bf16x8*)(gp_ + mt * 1024); gf[mt][1] = *(const bf16x8*)(gp_ + mt * 1024 + 32); \
                    hf[mt] = *(const u32x2*)((const bf16*)(ws + WS_HC) + ((size_t)((u64_ * 4 + vs) * 4 + mt) * 64 + lane) * 4); } } while (0)
#define SC_STEP(gf, hf, C) do { const size_t u64_ = (size_t)bh * 64 + (C); bf16* zs_ = (bf16*)(ws + WS_ZS) + ((size_t)((u64_ * 4 + vs) * 4) * 64 + lane) * 4; \
                _Pragma("unroll") for (int mt = 0; mt < 4; ++mt) { u32x2 zw_; zw_.x = pk2(z[mt][0], z[mt][1]); zw_.y = pk2(z[mt][2], z[mt][3]); *(u32x2*)(zs_ + mt * 256) = zw_; } \
                bf16x8 zb[2]; RW_ZB(z, zb); \
                _Pragma("unroll") for (int mt = 0; mt < 4; ++mt) { f32x4 a; a[0] = bflo(hf[mt].x); a[1] = bfhi(hf[mt].x); a[2] = bflo(hf[mt].y); a[3] = bfhi(hf[mt].y); \
                    a = __builtin_amdgcn_mfma_f32_16x16x32_bf16(gf[mt][0], zb[0], a, 0, 0, 0); a = __builtin_amdgcn_mfma_f32_16x16x32_bf16(gf[mt][1], zb[1], a, 0, 0, 0); z[mt] = a; } } while (0)
            SC_LOAD(gA, hA, 0); SC_LOAD(gB, hB, 1); SC_LOAD(gC, hC, 2);
#pragma unroll 1
            for (int C = 0; C < 64; C += 4) {
                SC_LOAD(gD, hD, C + 3);
                SC_STEP(gA, hA, C);
                if (C + 4 < 64) SC_LOAD(gA, hA, C + 4);
                SC_STEP(gB, hB, C + 1);
                if (C + 5 < 64) SC_LOAD(gB, hB, C + 5);
                SC_STEP(gC, hC, C + 2);
                if (C + 6 < 64) SC_LOAD(gC, hC, C + 6);
                SC_STEP(gD, hD, C + 3);
            }
#undef SC_LOAD
#undef SC_STEP
        }
    }
    SEAM(5);

    if (IN(6)) { PHASE_IDS;
        const int l15 = lane & 15, g = lane >> 4;
        for (int u64 = gw; u64 < NB * NH * (SEQ / 64); u64 += NGW) {
            const int bh = u64 >> 6, C = u64 & 63, b = bh >> 3, h = bh & 7;
            f32x4 z[4][4];
#pragma unroll
            for (int sl = 0; sl < 4; ++sl)
#pragma unroll
                for (int mt = 0; mt < 4; ++mt) { const u32x2 zw = *(const u32x2*)((const bf16*)(ws + WS_ZS) + ((size_t)((u64 * 4 + sl) * 4 + mt) * 64 + lane) * 4); z[sl][mt] = (f32x4){bflo(zw.x), bfhi(zw.x), bflo(zw.y), bfhi(zw.y)}; }
            float lg4[4];
#pragma unroll
            for (int sl = 0; sl < 4; ++sl) lg4[sl] = args.in[I_LNG][h * 64 + 16 * sl + l15];
#pragma unroll 1
            for (int j = 0; j < 4; ++j) {
                const size_t un = (size_t)u64 * 4 + j; const size_t m0 = (size_t)b * SEQ + (C * 4 + j) * 16;
                const bf16* rp = (const bf16*)(ws + WS_RP) + un * 1024 + l15 * 64 + 8 * g;
                const bf16x8 rf0 = *(const bf16x8*)rp, rf1 = *(const bf16x8*)(rp + 32);
                f32x4 y[4];
#pragma unroll
                for (int sl = 0; sl < 4; ++sl) { bf16x8 zb[2]; RW_ZB(z[sl], zb);
                    f32x4 a = *(const f32x4*)((const float*)(ws + WS_Y1F) + ((size_t)(un * 4 + sl) * 64 + lane) * 4);
                    a = __builtin_amdgcn_mfma_f32_16x16x32_bf16(rf0, zb[0], a, 0, 0, 0); a = __builtin_amdgcn_mfma_f32_16x16x32_bf16(rf1, zb[1], a, 0, 0, 0); y[sl] = a; }
#pragma unroll
                for (int e = 0; e < 4; ++e) {
                    float s1 = (y[0][e] + y[1][e]) + (y[2][e] + y[3][e]);
                    s1 += __shfl_xor(s1, 1); s1 += __shfl_xor(s1, 2); s1 += __shfl_xor(s1, 4); s1 += __shfl_xor(s1, 8);
                    const float mean = s1 * (1.0f / 64.0f);
                    float d0 = y[0][e] - mean, d1 = y[1][e] - mean, d2 = y[2][e] - mean, d3 = y[3][e] - mean;
                    float s2 = (d0 * d0 + d1 * d1) + (d2 * d2 + d3 * d3);
                    s2 += __shfl_xor(s2, 1); s2 += __shfl_xor(s2, 2); s2 += __shfl_xor(s2, 4); s2 += __shfl_xor(s2, 8);
                    const float rstd = 1.0f / sqrtf(s2 * (1.0f / 64.0f) + GN_EPS);
                    const size_t ro = (m0 + 4 * g + e) * 512 + h * 64 + l15;
                    const float dd[4] = {d0, d1, d2, d3};
#pragma unroll
                    for (int sl = 0; sl < 4; ++sl) { const float gg = bf2f(((const bf16*)(ws + WS_G))[ro + 16 * sl]), ad = bf2f(((const bf16*)(ws + WS_ADD))[ro + 16 * sl]);
                        const float o = dd[sl] * rstd * lg4[sl] * gg + ad;
                        CAT[(m0 + 4 * g + e) * 1024 + 512 + h * 64 + 16 * sl + l15] = (bf16)f2bf(o); }
                }
                if (j < 3) {
                    const bf16* gp = (const bf16*)(ws + WS_GP) + un * 4096 + l15 * 64 + 8 * g;
                    bf16x8 gf[4][2];
#pragma unroll
                    for (int mt = 0; mt < 4; ++mt) { gf[mt][0] = *(const bf16x8*)(gp + mt * 1024); gf[mt][1] = *(const bf16x8*)(gp + mt * 1024 + 32); }
#pragma unroll
                    for (int sl = 0; sl < 4; ++sl) { bf16x8 zb[2]; RW_ZB(z[sl], zb);
#pragma unroll
                        for (int mt = 0; mt < 4; ++mt) { const u32x2 hh = *(const u32x2*)((const bf16*)(ws + WS_HF) + ((size_t)((un * 4 + sl) * 4 + mt) * 64 + lane) * 4);
                            f32x4 a; a[0] = bflo(hh.x); a[1] = bfhi(hh.x); a[2] = bflo(hh.y); a[3] = bfhi(hh.y);
                            a = __builtin_amdgcn_mfma_f32_16x16x32_bf16(gf[mt][0], zb[0], a, 0, 0, 0); a = __builtin_amdgcn_mfma_f32_16x16x32_bf16(gf[mt][1], zb[1], a, 0, 0, 0); z[sl][mt] = a; } }
                }
            }
        }
    }
    SEAM(6);
#undef RW_ZB


    if (IN(7)) { PHASE_IDS;
        pg8::DenseSched S; S.o.init_tiles(M / 256, D / 256, G, bid); S.A = (const char*)CAT; S.B = (const char*)Wout_t; S.tstep = (size_t)256 * D * 2;
        EpiBf16Res<false> E{args.in[I_X], X1, D}; pg8::gemm_phase(lds, D, S, E);
    }
    SEAM(7);
    if (IN(8)) { PHASE_IDS; for (int m = gw; m < M; m += NGW) rms_rowbf_to_bf16(X1 + (size_t)m * D, args.in[I_NXAG], HN + (size_t)m * D, lane); }
    SEAM(8);
    if (IN(9)) { PHASE_IDS;
        pg8::DenseSched S; S.o.init_tiles(M / 256, D / 256, G, bid); S.A = (const char*)HN; S.B = (const char*)Wq_t; S.tstep = (size_t)256 * D * 2;
        EpiBf16Plain E{Qb, D, 0.0625f}; pg8::gemm_phase(lds, D, S, E);
    }
    SEAM(9);
    if (IN(10)) { PHASE_IDS;
        const int l15 = lane & 15, g4 = lane >> 4;
        for (int unit = gw; unit < NB * XH * (SEQ / 16); unit += NGW) {
            const int qt16 = unit % (SEQ / 16), bh = unit / (SEQ / 16), h = bh & 3, b = bh >> 2;
            const bf16* qbase = Qb + (size_t)(b * SEQ + qt16 * 16 + l15) * D + h * XHD + 8 * g4;
            const bf16* kbase = KM + (size_t)(b * MEML + l15) * D + h * XHD + 8 * g4;
            f32x4 sc[16];
#pragma unroll
            for (int kt = 0; kt < 16; ++kt) sc[kt] = (f32x4){0.f, 0.f, 0.f, 0.f};
#pragma unroll 1
            for (int ks = 0; ks < 8; ++ks) {
                const bf16x8 q0 = *(const bf16x8*)(qbase + 32 * ks);
                const bf16* kp = kbase + 32 * ks;
#pragma unroll
                for (int kt = 0; kt < 16; ++kt) { const bf16x8 kf = *(const bf16x8*)(kp + (size_t)(16 * kt) * D);
                    sc[kt] = __builtin_amdgcn_mfma_f32_16x16x32_bf16(kf, q0, sc[kt], 0, 0, 0); }
            }
            bf16x8 pf[8];
            {
                float mx = -3.0e38f;
#pragma unroll
                for (int kt = 0; kt < 16; ++kt) mx = fmaxf(mx, fmaxf(fmaxf(sc[kt][0], sc[kt][1]), fmaxf(sc[kt][2], sc[kt][3])));
                mx = fmaxf(mx, __shfl_xor(mx, 16)); mx = fmaxf(mx, __shfl_xor(mx, 32));
                float sum = 0.f;
#pragma unroll
                for (int kt = 0; kt < 16; ++kt) {
#pragma unroll
                    for (int e = 0; e < 4; ++e) { const float p = __expf(sc[kt][e] - mx); sc[kt][e] = p; sum += p; } }
                sum += __shfl_xor(sum, 16); sum += __shfl_xor(sum, 32);
                const float inv = 1.0f / sum;
#pragma unroll
                for (int s2 = 0; s2 < 8; ++s2) { const f32x4 a = sc[2 * s2] * inv, c = sc[2 * s2 + 1] * inv;
                    u32x4 p; p.x = pk2(a[0], a[1]); p.y = pk2(a[2], a[3]); p.z = pk2(c[0], c[1]); p.w = pk2(c[2], c[3]); pf[s2] = __builtin_bit_cast(bf16x8, p); }
            }
            const bf16* vbase = VT + (size_t)(h * XHD + l15) * MROWS + b * MEML + 4 * g4;
            bf16* obase = Ob + (size_t)(b * SEQ + qt16 * 16 + l15) * D + h * XHD + 4 * g4;
#pragma unroll 1
            for (int dt = 0; dt < 16; ++dt) {
                const bf16* vp = vbase + (size_t)(16 * dt) * MROWS;
                f32x4 oc = (f32x4){0.f, 0.f, 0.f, 0.f};
#pragma unroll
                for (int s2 = 0; s2 < 8; ++s2) {
                    const u32x2 v0 = *(const u32x2*)(vp + 32 * s2), v1 = *(const u32x2*)(vp + 32 * s2 + 16);
                    u32x4 vv; vv.x = v0.x; vv.y = v0.y; vv.z = v1.x; vv.w = v1.y; const bf16x8 vf = __builtin_bit_cast(bf16x8, vv);
                    oc = __builtin_amdgcn_mfma_f32_16x16x32_bf16(vf, pf[s2], oc, 0, 0, 0);
                }
                u32x2 w; w.x = pk2(oc[0], oc[1]); w.y = pk2(oc[2], oc[3]);
                *(u32x2*)(obase + 16 * dt) = w;
            }
        }
    }
    SEAM(10);
    if (IN(11)) { PHASE_IDS;
        pg8::DenseSched S; S.o.init_tiles(M / 256, D / 256, G, bid); S.A = (const char*)Ob; S.B = (const char*)Wo_t; S.tstep = (size_t)256 * D * 2;
        EpiBf16Res<true> E{X1, X2, D}; pg8::gemm_phase(lds, D, S, E);
    }
    SEAM(11);
    if (IN(12)) { PHASE_IDS;
        LAS float* hs = (LAS float*)(lds + wave * 16384);
        const float* gfn = args.in[I_NFFG]; const float* wr_ = args.in[I_WR]; const float* br = args.in[I_BR];
        const int e = lane & 31, half = lane >> 5;
        for (int grp = gw; grp < M / 4; grp += NGW) {
            const int m0 = grp * 4;
#pragma unroll
            for (int rr = 0; rr < 4; ++rr) {
                const bf16* xrow = X2 + (size_t)(m0 + rr) * D;
                float v[16]; float s = 0.f;
#pragma unroll
                for (int hf = 0; hf < 2; ++hf) { const u32x4 w = *(const u32x4*)(xrow + 512 * hf + 8 * lane);
#pragma unroll
                    for (int q = 0; q < 4; ++q) { v[8 * hf + 2 * q] = bflo(w[q]); v[8 * hf + 2 * q + 1] = bfhi(w[q]); } }
#pragma unroll
                for (int j = 0; j < 16; ++j) s += v[j] * v[j];
                const float rstd = 1.0f / sqrtf(wave_sum(s) * (1.f / D) + EPS);
#pragma unroll
                for (int hf = 0; hf < 2; ++hf) { const f32x4 g0 = *(const f32x4*)(gfn + 512 * hf + 8 * lane), g1 = *(const f32x4*)(gfn + 512 * hf + 8 * lane + 4);
                    const f32x4 h0 = (f32x4){v[8 * hf] * rstd * g0.x, v[8 * hf + 1] * rstd * g0.y, v[8 * hf + 2] * rstd * g0.z, v[8 * hf + 3] * rstd * g0.w};
                    const f32x4 h1 = (f32x4){v[8 * hf + 4] * rstd * g1.x, v[8 * hf + 5] * rstd * g1.y, v[8 * hf + 6] * rstd * g1.z, v[8 * hf + 7] * rstd * g1.w};
                    *(LAS f32x4*)(hs + rr * 1024 + 512 * hf + 8 * lane) = h0; *(LAS f32x4*)(hs + rr * 1024 + 512 * hf + 8 * lane + 4) = h1;
                    u32x4 w; w.x = pk2(h0.x, h0.y); w.y = pk2(h0.z, h0.w); w.z = pk2(h1.x, h1.y); w.w = pk2(h1.z, h1.w);
                    *(u32x4*)(HN + (size_t)(m0 + rr) * D + 512 * hf + 8 * lane) = w; }
            }
            asm volatile("s_waitcnt lgkmcnt(0)" ::: "memory");
            float lg[4] = {0.f, 0.f, 0.f, 0.f};
#pragma unroll 4
            for (int d = half * 512; d < half * 512 + 512; d += 4) {
                const float w0 = wr_[(d + 0) * 32 + e], w1 = wr_[(d + 1) * 32 + e], w2 = wr_[(d + 2) * 32 + e], w3 = wr_[(d + 3) * 32 + e];
#pragma unroll
                for (int rr = 0; rr < 4; ++rr) { const f32x4 h4 = *(const LAS f32x4*)(hs + rr * 1024 + d); lg[rr] += (h4.x * w0 + h4.y * w1) + (h4.z * w2 + h4.w * w3); }
            }
            const float brv = br[e];
#pragma unroll
            for (int rr = 0; rr < 4; ++rr) {
                float v = lg[rr] + __shfl_xor(lg[rr], 32) + brv;
                float selv[4]; int sele[4];
#pragma unroll
                for (int k = 0; k < 4; ++k) {
                    float mv = v; int mi = e;
#pragma unroll
                    for (int o = 1; o < 32; o <<= 1) { const float ov = __shfl_xor(mv, o); const int oi = __shfl_xor(mi, o); if (ov > mv || (ov == mv && oi < mi)) { mv = ov; mi = oi; } }
                    selv[k] = mv; sele[k] = mi; if (e == mi) v = -3.0e38f;
                }
                const float e1 = __expf(selv[1] - selv[0]), e2 = __expf(selv[2] - selv[0]), e3 = __expf(selv[3] - selv[0]);
                const float inv = 1.0f / (1.0f + e1 + e2 + e3);
                if (lane < 4) {
                    const int me = lane == 0 ? sele[0] : lane == 1 ? sele[1] : lane == 2 ? sele[2] : sele[3];
                    const float mg = (lane == 0 ? 1.0f : lane == 1 ? e1 : lane == 2 ? e2 : e3) * inv;
                    const int pos = (int)atomicAdd(ecnt + me, 1u);
                    const int ai = (m0 + rr) * 4 + lane; route_e[ai] = me; route_pos[ai] = pos; route_g[ai] = mg;
                }
            }
        }
    }
    SEAM(12);
    if (IN(13)) { PHASE_IDS;
        LAS int* pst = (LAS int*)lds;
        if (tid == 0) { int acc = 0; for (int e = 0; e < NE; ++e) { const int c = (int)__hip_atomic_load(ecnt + e, __ATOMIC_RELAXED, __HIP_MEMORY_SCOPE_AGENT); pst[e] = acc; pst[64 + e] = c; acc += (c + 255) & ~255; } pst[32] = acc; }
        __syncthreads();
        for (int ai = bid * NTHREADS + tid; ai < NASSIGN; ai += G * NTHREADS) {
            const int e = route_e[ai]; const int row = pst[e] + route_pos[ai]; row_slot[row] = ai; row_gate[row] = route_g[ai]; row_tok[row] = ai >> 2; }
        if (bid < NE) { const int e = bid, c = pst[64 + e], pe = (c + 255) & ~255; for (int p = c + tid; p < pe; p += NTHREADS) { row_slot[pst[e] + p] = -1; row_gate[pst[e] + p] = 0.f; row_tok[pst[e] + p] = 0; } }
        if (bid == 0 && tid == 0) { int nt = 0; for (int e = 0; e < NE; ++e) { const int n = ((pst[64 + e] + 255) & ~255) >> 8; for (int j = 0; j < n; ++j) tile_tab[16 + nt++] = e; } tile_tab[0] = nt; }
        __syncthreads();
    }
    SEAM(13);
    if (IN(14)) { PHASE_IDS;
        const int ntiles = tile_tab[0];
        pg8::MoeGatherSched S; S.o.init_tiles(ntiles, 2048 / 256, G, bid); S.A = (const char*)HN; S.B = (const char*)Wgu_t; S.tile_e = tile_tab + 16; S.rtok = row_tok; S.tstep = (size_t)256 * D * 2; S.estep = (size_t)2048 * D * 2;
        EpiSwiglu E{ACT, args.in[I_BGU]}; pg8::gemm_phase(lds, D, S, E);
    }
    SEAM(14);
    if (IN(15)) { PHASE_IDS;
        const int ntiles = tile_tab[0];
        pg8::MoeSched S; S.o.init_tiles(ntiles, D / 256, G, bid); S.A = (const char*)ACT; S.B = (const char*)Wdn_t; S.tile_e = tile_tab + 16; S.tstep = (size_t)256 * DFF * 2; S.estep = (size_t)D * DFF * 2;
        EpiDown E{YS, args.in[I_BDN], row_slot, row_gate}; pg8::gemm_phase(lds, DFF, S, E);
    }
    SEAM(15);
    if (IN(16)) { PHASE_IDS;
        const float* gfin = args.in[I_FNG];
        for (int m = gw; m < M; m += NGW) {
            float v[16]; float s = 0.f;
#pragma unroll
            for (int hf = 0; hf < 2; ++hf) { const u32x4 w = *(const u32x4*)(X2 + (size_t)m * D + 512 * hf + 8 * lane);
#pragma unroll
                for (int q = 0; q < 4; ++q) { v[8 * hf + 2 * q] = bflo(w[q]); v[8 * hf + 2 * q + 1] = bfhi(w[q]); }
#pragma unroll
                for (int k = 0; k < 4; ++k) { const u32x4 y = *(const u32x4*)(YS + (size_t)(m * 4 + k) * D + 512 * hf + 8 * lane);
#pragma unroll
                    for (int q = 0; q < 4; ++q) { v[8 * hf + 2 * q] += bflo(y[q]); v[8 * hf + 2 * q + 1] += bfhi(y[q]); } } }
#pragma unroll
            for (int j = 0; j < 16; ++j) s += v[j] * v[j];
            const float rstd = 1.0f / sqrtf(wave_sum(s) * (1.f / D) + EPS);
#pragma unroll
            for (int hf = 0; hf < 2; ++hf) { const f32x4 g0 = *(const f32x4*)(gfin + 512 * hf + 8 * lane), g1 = *(const f32x4*)(gfin + 512 * hf + 8 * lane + 4);
                float* o = args.out + (size_t)m * D + 512 * hf + 8 * lane;
                *(f32x4*)o = (f32x4){v[8 * hf] * rstd * g0.x, v[8 * hf + 1] * rstd * g0.y, v[8 * hf + 2] * rstd * g0.z, v[8 * hf + 3] * rstd * g0.w};
                *(f32x4*)(o + 4) = (f32x4){v[8 * hf + 4] * rstd * g1.x, v[8 * hf + 5] * rstd * g1.y, v[8 * hf + 6] * rstd * g1.z, v[8 * hf + 7] * rstd * g1.w}; }
        }
    }
#undef IN
#undef SEAM
}

constexpr int N_PHASES = 17;
extern "C" void kernel_launch(void* const* d_in, const int* in_sizes, int n_in, void* d_out, int out_size, void* d_ws, size_t ws_size, hipStream_t stream) {
    static int grid = 0;
    if (grid == 0) {
        if (n_in != 37 || out_size != M * D || ws_size < WS_END) { fprintf(stderr, "kernel_launch: unexpected shapes (n_in %d, out %d, ws %zu); nothing launched\n", n_in, out_size, ws_size); grid = -1; return; }
        int dev = 0, cus = 0, per_cu = 0;
        if (hipGetDevice(&dev) != hipSuccess || hipDeviceGetAttribute(&cus, hipDeviceAttributeMultiprocessorCount, dev) != hipSuccess) { grid = -1; return; }
        if (hipFuncSetAttribute((const void*)fwd, hipFuncAttributeMaxDynamicSharedMemorySize, LDS_BYTES) != hipSuccess) { fprintf(stderr, "kernel_launch: hipFuncSetAttribute failed\n"); grid = -1; return; }
        if (hipOccupancyMaxActiveBlocksPerMultiprocessor(&per_cu, (const void*)fwd, NTHREADS, LDS_BYTES) != hipSuccess || per_cu < 1) fprintf(stderr, "kernel_launch: occupancy query says %d\n", per_cu);
        (void)hipGetLastError();
        grid = cus > 256 ? 256 : cus;
    }
    if (grid < 0) return;
    if (hipMemsetAsync((char*)d_ws + WS_CTL, 0, CTL_ZERO_BYTES, stream) != hipSuccess) return;
    Args a{};
    for (int i = 0; i < 37; ++i) a.in[i] = (const float*)d_in[i];
    a.out = (float*)d_out; a.ws = (unsigned char*)d_ws;
#if MK_ONE_LAUNCH
    a.ph_lo = 0; a.ph_hi = N_PHASES;
    hipLaunchKernelGGL(fwd, dim3(grid), dim3(NTHREADS), LDS_BYTES, stream, a);
#else
    for (int p = 0; p < N_PHASES; ++p) { a.ph_lo = p; a.ph_hi = p + 1; hipLaunchKernelGGL(fwd, dim3(grid), dim3(NTHREADS), LDS_BYTES, stream, a);
#ifdef PROBE_REPEAT_PHASE
        if (p == PROBE_REPEAT_PHASE) hipLaunchKernelGGL(fwd, dim3(grid), dim3(NTHREADS), LDS_BYTES, stream, a);
#endif
    }
#endif
}
```

```cpp
#include <hip/hip_runtime.h>
#include <cstdio>
#include <cstdint>

#ifndef MK_ONE_LAUNCH
#define MK_ONE_LAUNCH 1
#endif

#define DI __device__ __forceinline__
#define GAS __attribute__((address_space(1)))
#define LAS __attribute__((address_space(3)))
typedef unsigned short bf16;
typedef short bf16x8 __attribute__((ext_vector_type(8)));
typedef float f32x4 __attribute__((ext_vector_type(4)));
typedef float f32x2 __attribute__((ext_vector_type(2)));
typedef unsigned u32x4 __attribute__((ext_vector_type(4)));
typedef unsigned u32x2 __attribute__((ext_vector_type(2)));

constexpr int D = 1024, NB = 4, SEQ = 4096, M = NB * SEQ;
constexpr int MEML = 256, MROWS = NB * MEML;
constexpr int LRU_W = 512, RW = 512, NH = 8, HD = 64;
constexpr int INW = 2816;
constexpr int XH = 4, XHD = 256;
constexpr int NE = 32, TOPK = 4, DFF = 1024;
constexpr int NASSIGN = M * TOPK;
constexpr int MAXTILES = 288, MAXROWS = MAXTILES * 256;
constexpr float EPS = 1e-6f, GN_EPS = 64e-5f;

DI int fresh_tid() { int t = threadIdx.x; asm volatile("" : "+v"(t)); return t; }
namespace pg8 {
constexpr int BM = 256, BK = 64, HALF = 128, HTB = HALF * BK * 2, STAGE_BYTES = 8 * HTB, NXCD = 8, WGM = 8;
__host__ __device__ __forceinline__ int lds_byte(int r, int c) { const int st = (r >> 4) * 2 + (c >> 5), rr = r & 15, cc = c & 31, ob = rr * 64 + cc * 2; return st * 1024 + (ob ^ (((ob >> 9) & 1) << 5)); }
__host__ __device__ __forceinline__ void stage_rc(int b, int& R, int& C) { const int st = b / 1024, sb = b % 1024, swz = sb ^ (((sb >> 9) & 1) << 5); R = (st >> 1) * 16 + swz / 64; C = (st & 1) * 32 + (swz % 64) / 2; }
__host__ __device__ __forceinline__ int perm32(int rho) { const int n = rho >> 4, i = rho & 15; return 8 * (i >> 2) + 4 * n + (i & 3); }

struct Unit { int pm, pn, e; };

struct StaticOrder {
    int nM, nN, nwg, G, c;
    __host__ __device__ void init_tiles(int nM_, int nN_, int G_, int c_) { nM = nM_; nN = nN_; nwg = nM * nN; G = G_; c = c_; }
    __host__ __device__ bool next(int i, Unit& u) const {
        const long L = (long)i * G + c; if (L >= nwg) return false;
        int wgid = (int)L; { const int q = nwg / NXCD, r = nwg % NXCD, xcd = wgid % NXCD, off = wgid / NXCD; wgid = (xcd < r ? xcd * (q + 1) : r * (q + 1) + (xcd - r) * q) + off; }
        const int nig = WGM * nN, gid = wgid / nig, fm = gid * WGM, gsz = (nM - fm) < WGM ? (nM - fm) : WGM;
        u.pm = fm + ((wgid % nig) % gsz); u.pn = (wgid % nig) / gsz; u.e = 0; return true;
    }
};
struct DenseSched {
    static constexpr bool GATHER = false, B_TILED = false;
    StaticOrder o; const char* A; const char* B; size_t tstep;
    DI bool next(int i, Unit& u) const { return o.next(i, u); }
    DI const char* a_ptr(const Unit& u) const { return A + (size_t)u.pm * tstep; }
    DI const char* b_ptr(const Unit& u) const { return B + (size_t)u.pn * tstep; }
    DI void a_voff(const Unit&, int K, const int (&R)[2], const int (&C)[2], unsigned (&vo)[2][2]) const {
#pragma unroll
        for (int h = 0; h < 2; ++h)
#pragma unroll
            for (int i = 0; i < 2; ++i) vo[h][i] = (unsigned)((h * HALF + R[i]) * K + C[i]) * 2u; }
};
struct MoeSched {
    static constexpr bool GATHER = false, B_TILED = true;
    StaticOrder o; const char* A; const char* B; const int* tile_e; size_t tstep, estep;
    DI bool next(int i, Unit& u) const { if (!o.next(i, u)) return false; u.e = tile_e[u.pm]; return true; }
    DI const char* a_ptr(const Unit& u) const { return A + (size_t)u.pm * tstep; }
    DI const char* b_ptr(const Unit& u) const { return B + (size_t)u.e * estep + (size_t)u.pn * tstep; }
    DI void a_voff(const Unit&, int K, const int (&R)[2], const int (&C)[2], unsigned (&vo)[2][2]) const {
#pragma unroll
        for (int h = 0; h < 2; ++h)
#pragma unroll
            for (int i = 0; i < 2; ++i) vo[h][i] = (unsigned)((h * HALF + R[i]) * K + C[i]) * 2u; }
};
struct MoeGatherSched {
    static constexpr bool GATHER = true, B_TILED = true;
    StaticOrder o; const char* A; const char* B; const int* tile_e; const int* rtok; size_t tstep, estep;
    DI bool next(int i, Unit& u) const { if (!o.next(i, u)) return false; u.e = tile_e[u.pm]; return true; }
    DI const char* a_ptr(const Unit&) const { return A; }
    DI const char* b_ptr(const Unit& u) const { return B + (size_t)u.e * estep + (size_t)u.pn * tstep; }
    DI void a_voff(const Unit& u, int K, const int (&R)[2], const int (&C)[2], unsigned (&vo)[2][2]) const {
#pragma unroll
        for (int h = 0; h < 2; ++h)
#pragma unroll
            for (int i = 0; i < 2; ++i) vo[h][i] = (unsigned)(rtok[u.pm * BM + h * HALF + R[i]] * K + C[i]) * 2u; }
};

DI unsigned cvt_pk_bf16(float lo, float hi) { unsigned r; asm volatile("v_cvt_pk_bf16_f32 %0, %1, %2" : "=v"(r) : "v"(lo), "v"(hi)); return r; }

template <class Epi, class Sched, bool ALIGN_EPI = true>
DI void gemm_phase(LAS unsigned char* lds, const int K, const Sched& S, const Epi& E) {
    const int tid = fresh_tid(), wid = __builtin_amdgcn_readfirstlane(tid >> 6), lane = tid & 63, wr = wid >> 2, wc = wid & 3, fr = lane & 15, fq = lane >> 4;
    const int nt = K / BK;
    constexpr bool GA = Sched::GATHER, BT = Sched::B_TILED;
    unsigned voffA[2][2], voffAn[2][2], voffB[2]; int sR[2], sC[2];
#pragma unroll
    for (int i = 0; i < 2; ++i) { int R, C; stage_rc(tid * 16 + i * 8192, R, C); const int Rb = Epi::PERM ? ((R & ~31) + perm32(R & 31)) : R;
        sR[i] = R; sC[i] = C; voffB[i] = BT ? (unsigned)(tid * 16 + i * 8192) : (unsigned)(Rb * K + C) * 2u; }
    const size_t kstep = (size_t)(BK * 2);
    const size_t hstep = (size_t)HALF * K * 2;
    const size_t kstepB = BT ? (size_t)(2 * HTB) : kstep, hstepB = BT ? (size_t)HTB : hstep;
    const unsigned ldsw = (unsigned)wid * 1024u;
    const int aoff = lds_byte(wr * 64 + fr, fq * 8), boff = lds_byte(wc * 32 + fr, fq * 8);
#define PG8_SA(b, h) (((b) * 2 + (h)) * HTB)
#define PG8_SB(b, h) ((4 + (b) * 2 + (h)) * HTB)
#define PG8_STAGE(bufoff, gbase, voff) do { _Pragma("unroll") for (int _i = 0; _i < 2; ++_i) \
        __builtin_amdgcn_global_load_lds((const unsigned*)((const char*)(gbase) + (voff)[_i]), (LAS unsigned*)(lds + (bufoff) + ldsw + _i * 8192), 16, 0, 0); } while (0)
#define PG8_LDA(dst, b, h) do { _Pragma("unroll") for (int m = 0; m < 4; ++m) _Pragma("unroll") for (int k = 0; k < 2; ++k) dst[m][k] = *(const LAS bf16x8*)(lds + PG8_SA(b, h) + aoff + m * 2048 + k * 1024); } while (0)
#define PG8_LDB(dst, b, h) do { _Pragma("unroll") for (int n = 0; n < 2; ++n) _Pragma("unroll") for (int k = 0; k < 2; ++k) dst[n][k] = *(const LAS bf16x8*)(lds + PG8_SB(b, h) + boff + n * 2048 + k * 1024); } while (0)
#define PG8_MMA(ai, bj, At, Bt) do { __builtin_amdgcn_s_setprio(1); _Pragma("unroll") for (int m = 0; m < 4; ++m) _Pragma("unroll") for (int n = 0; n < 2; ++n) _Pragma("unroll") for (int k = 0; k < 2; ++k) \
        acc[ai][bj][m][n] = __builtin_amdgcn_mfma_f32_16x16x32_bf16(Bt[n][k], At[m][k], acc[ai][bj][m][n], 0, 0, 0); __builtin_amdgcn_s_setprio(0); } while (0)
#define PG8_WAIT_V(n) asm volatile("s_waitcnt vmcnt(" #n ")" ::: "memory")
#define PG8_WAIT_L(n) asm volatile("s_waitcnt lgkmcnt(" #n ")" ::: "memory")
#define PG8_BAR __builtin_amdgcn_s_barrier()
#define PG8_SCHED __builtin_amdgcn_sched_barrier(0)
    Unit cur, nxt; int ui = 0;
    if (!S.next(0, cur)) return;
    f32x4 acc[2][2][4][2];
#pragma unroll
    for (int a = 0; a < 2; ++a)
#pragma unroll
        for (int b = 0; b < 2; ++b)
#pragma unroll
            for (int m = 0; m < 4; ++m)
#pragma unroll
                for (int n = 0; n < 2; ++n) acc[a][b][m][n] = (f32x4){0.f, 0.f, 0.f, 0.f};
    bf16x8 At[4][2], B0[2][2], B1[2][2];
    const char* cA = S.a_ptr(cur); const char* cB = S.b_ptr(cur);
    S.a_voff(cur, K, sR, sC, voffA);
#define PG8_STAGE_A(bufoff, kbase, h, vo) do { if constexpr (GA) { PG8_STAGE(bufoff, kbase, (vo)[h]); } else { PG8_STAGE(bufoff, (kbase) + (h) * hstep, voffA[0]); } } while (0)
    PG8_STAGE(PG8_SB(0, 0), cB, voffB); PG8_STAGE(PG8_SB(0, 1), cB + hstepB, voffB); PG8_STAGE_A(PG8_SA(0, 0), cA, 0, voffA); PG8_STAGE_A(PG8_SA(0, 1), cA, 1, voffA);
    if (wr == 1) PG8_BAR;
    PG8_WAIT_V(2); PG8_BAR;
    PG8_STAGE(PG8_SB(1, 0), cB + kstepB, voffB); PG8_STAGE_A(PG8_SA(1, 0), cA + kstep, 0, voffA); PG8_STAGE(PG8_SB(1, 1), cB + hstepB + kstepB, voffB);
    PG8_WAIT_V(6); PG8_BAR;
    for (;;) {
        const bool has_next = S.next(ui + 1, nxt);
        const char* nA = has_next ? S.a_ptr(nxt) : cA; const char* nB = has_next ? S.b_ptr(nxt) : cB;
        if constexpr (GA) { if (has_next) S.a_voff(nxt, K, sR, sC, voffAn);
            else {
#pragma unroll
                for (int h = 0; h < 2; ++h)
#pragma unroll
                    for (int i = 0; i < 2; ++i) voffAn[h][i] = voffA[h][i]; } }
        for (int t = 0; t < nt; t += 2) {
            const bool last = (t == nt - 2);
            const char* a1 = cA + (size_t)(t + 1) * kstep;
            const char* a2 = last ? nA : cA + (size_t)(t + 2) * kstep; const char* b2 = last ? nB : cB + (size_t)(t + 2) * kstepB;
            const char* a3 = a2 + kstep; const char* b3 = b2 + kstepB;
            unsigned vs[2][2];
            if constexpr (GA) {
#pragma unroll
                for (int i = 0; i < 2; ++i) { vs[0][i] = last ? voffAn[0][i] : voffA[0][i]; vs[1][i] = last ? voffAn[1][i] : voffA[1][i]; } }
            PG8_LDB(B0, 0, 0); PG8_LDB(B1, 0, 1); PG8_SCHED; PG8_LDA(At, 0, 0); PG8_STAGE_A(PG8_SA(1, 1), a1, 1, voffA);
            PG8_WAIT_V(8); PG8_WAIT_L(0); PG8_BAR; PG8_MMA(0, 0, At, B0); PG8_MMA(0, 1, At, B1); PG8_BAR; PG8_SCHED;
            PG8_LDA(At, 0, 1); PG8_STAGE(PG8_SB(0, 0), b2, voffB); PG8_STAGE(PG8_SB(0, 1), b2 + hstepB, voffB); PG8_STAGE_A(PG8_SA(0, 0), a2, 0, vs);
            PG8_WAIT_V(8); PG8_WAIT_L(0); PG8_BAR; PG8_MMA(1, 0, At, B0); PG8_MMA(1, 1, At, B1); PG8_BAR; PG8_SCHED;
            PG8_LDB(B0, 1, 0); PG8_LDB(B1, 1, 1); PG8_SCHED; PG8_LDA(At, 1, 0); PG8_STAGE_A(PG8_SA(0, 1), a2, 1, vs);
            PG8_WAIT_V(8); PG8_WAIT_L(0); PG8_BAR; PG8_MMA(0, 0, At, B0); PG8_MMA(0, 1, At, B1); PG8_BAR; PG8_SCHED;
            PG8_LDA(At, 1, 1); PG8_STAGE(PG8_SB(1, 0), b3, voffB); PG8_STAGE(PG8_SB(1, 1), b3 + hstepB, voffB); PG8_STAGE_A(PG8_SA(1, 0), a3, 0, vs);
            PG8_WAIT_V(8); PG8_WAIT_L(0); PG8_BAR; PG8_MMA(1, 0, At, B0); PG8_MMA(1, 1, At, B1); PG8_BAR; PG8_SCHED;
        }
        if constexpr (ALIGN_EPI) { if (wr == 0) PG8_BAR; }
        E(acc, cur, wr, wc, fr, fq);
        if (!has_next) break;
#pragma unroll
        for (int a = 0; a < 2; ++a)
#pragma unroll
            for (int b = 0; b < 2; ++b)
#pragma unroll
                for (int m = 0; m < 4; ++m)
#pragma unroll
                    for (int n = 0; n < 2; ++n) acc[a][b][m][n] = (f32x4){0.f, 0.f, 0.f, 0.f};
        cur = nxt; cA = nA; cB = nB; ++ui;
        if constexpr (GA) {
#pragma unroll
            for (int h = 0; h < 2; ++h)
#pragma unroll
                for (int i = 0; i < 2; ++i) voffA[h][i] = voffAn[h][i]; }
        if constexpr (ALIGN_EPI) { if (wr == 1) PG8_BAR; }
    }
    PG8_WAIT_V(0);
    if constexpr (!ALIGN_EPI) { if (wr == 0) PG8_BAR; }
    PG8_BAR;
#undef PG8_SA
#undef PG8_SB
#undef PG8_STAGE
#undef PG8_STAGE_A
#undef PG8_LDA
#undef PG8_LDB
#undef PG8_MMA
#undef PG8_WAIT_V
#undef PG8_WAIT_L
#undef PG8_BAR
#undef PG8_SCHED
}
}
using pg8::Unit;
using pg8::cvt_pk_bf16;

DI float bflo(unsigned w) { return __uint_as_float(w << 16); }
DI float bfhi(unsigned w) { return __uint_as_float(w & 0xffff0000u); }
DI float bf2f(bf16 b) { return __uint_as_float(((unsigned)b) << 16); }
DI unsigned f2bf(float f) { unsigned u = __float_as_uint(f); return (u + 0x7fffu + ((u >> 16) & 1u)) >> 16; }
DI unsigned pk2(float lo, float hi) { return f2bf(lo) | (f2bf(hi) << 16); }
DI float sigmoid_f(float x) { return 1.0f / (1.0f + __expf(-x)); }
DI float softplus_f(float x) { return fmaxf(x, 0.f) + log1pf(__expf(-fabsf(x))); }
DI float softplus_fast(float x) { return fmaxf(x, 0.f) + __logf(1.0f + __expf(-fabsf(x))); }
DI float gelu_tanh_f(float x) { const float u = 0.7978845608028654f * (x + 0.044715f * x * x * x); return 0.5f * x * (1.0f + tanhf(u)); }
DI float wave_sum(float v) {
#pragma unroll
    for (int o = 1; o < 64; o <<= 1) v += __shfl_xor(v, o);
    return v;
}

struct EpiBf16Plain {
    static constexpr bool PERM = true;
    bf16* O; int ldc; float scale;
    DI void operator()(const f32x4 (&acc)[2][2][4][2], const Unit& u, int wr, int wc, int fr, int fq) const {
        const int row0 = u.pm * 256 + wr * 64 + fr, col0 = u.pn * 256 + wc * 32 + 8 * fq;
#pragma unroll
        for (int ai = 0; ai < 2; ++ai)
#pragma unroll
            for (int m = 0; m < 4; ++m) { bf16* rowp = O + (size_t)(row0 + ai * 128 + m * 16) * ldc + col0;
#pragma unroll
                for (int bj = 0; bj < 2; ++bj) { const f32x4 v0 = acc[ai][bj][m][0] * scale, v1 = acc[ai][bj][m][1] * scale;
                    u32x4 w; w.x = cvt_pk_bf16(v0[0], v0[1]); w.y = cvt_pk_bf16(v0[2], v0[3]); w.z = cvt_pk_bf16(v1[0], v1[1]); w.w = cvt_pk_bf16(v1[2], v1[3]);
                    *(u32x4*)(rowp + bj * 128) = w; } }
    }
};
template <bool RES_BF16> struct EpiBf16Res {
    static constexpr bool PERM = true;
    const void* Rz; bf16* O; int ldc;
    DI void operator()(const f32x4 (&acc)[2][2][4][2], const Unit& u, int wr, int wc, int fr, int fq) const {
        const int row0 = u.pm * 256 + wr * 64 + fr, col0 = u.pn * 256 + wc * 32 + 8 * fq;
#pragma unroll
        for (int ai = 0; ai < 2; ++ai)
#pragma unroll
            for (int m = 0; m < 4; ++m) { const size_t off = (size_t)(row0 + ai * 128 + m * 16) * ldc + col0;
#pragma unroll
                for (int bj = 0; bj < 2; ++bj) { f32x4 r0, r1;
                    if (RES_BF16) { const u32x4 rw = *(const u32x4*)((const bf16*)Rz + off + bj * 128); r0 = (f32x4){bflo(rw.x), bfhi(rw.x), bflo(rw.y), bfhi(rw.y)}; r1 = (f32x4){bflo(rw.z), bfhi(rw.z), bflo(rw.w), bfhi(rw.w)}; }
                    else { r0 = *(const f32x4*)((const float*)Rz + off + bj * 128); r1 = *(const f32x4*)((const float*)Rz + off + bj * 128 + 4); }
                    const f32x4 v0 = r0 + acc[ai][bj][m][0], v1 = r1 + acc[ai][bj][m][1];
                    u32x4 w; w.x = cvt_pk_bf16(v0[0], v0[1]); w.y = cvt_pk_bf16(v0[2], v0[3]); w.z = cvt_pk_bf16(v1[0], v1[1]); w.w = cvt_pk_bf16(v1[2], v1[3]);
                    *(u32x4*)(O + off + bj * 128) = w; } }
    }
};
struct EpiLora {
    static constexpr bool PERM = false;
    float* LWp; bf16* AAp; bf16* GGp; const float* w0; const float* a0;
    DI void operator()(const f32x4 (&acc)[2][2][4][2], const Unit& u, int wr, int wc, int fr, int fq) const {
        const int kind = u.pn >> 1;
        const int row0 = u.pm * 256 + wr * 64 + fr, col0 = (u.pn & 1) * 256 + wc * 32 + 4 * fq;
#pragma unroll
        for (int bj = 0; bj < 2; ++bj)
#pragma unroll
            for (int n = 0; n < 2; ++n) {
                const int c = col0 + bj * 128 + n * 16;
                f32x4 bias = (f32x4){0.f, 0.f, 0.f, 0.f};
                if (kind == 0) bias = *(const f32x4*)(w0 + c); else if (kind == 1) bias = *(const f32x4*)(a0 + c);
#pragma unroll
                for (int ai = 0; ai < 2; ++ai)
#pragma unroll
                    for (int m = 0; m < 4; ++m) {
                        f32x4 v = acc[ai][bj][m][n] + bias;
                        if (kind == 0) {
#pragma unroll
                            for (int j = 0; j < 4; ++j) { const float w = -softplus_fast(-v[j]) - 0.5f; v[j] = -__expf(w);     }
                        } else if (kind == 1) {
#pragma unroll
                            for (int j = 0; j < 4; ++j) v[j] = sigmoid_f(v[j]);
                        }
                        const size_t o_ = (size_t)(row0 + ai * 128 + m * 16) * 512 + c;
                        if (kind == 0) *(f32x4*)(LWp + o_) = v;
                        else { u32x2 w_; w_.x = cvt_pk_bf16(v[0], v[1]); w_.y = cvt_pk_bf16(v[2], v[3]); *(u32x2*)((kind == 1 ? AAp : GGp) + o_) = w_; }
                    }
            }
    }
};
struct EpiSwiglu {
    static constexpr bool PERM = true;
    bf16* ACT; const float* b_gu;
    DI void operator()(const f32x4 (&acc)[2][2][4][2], const Unit& u, int wr, int wc, int fr, int fq) const {
        const int row0 = u.pm * 256 + wr * 64 + fr, j0 = u.pn * 128 + wc * 32 + 8 * fq;
        const float* bg = b_gu + (size_t)u.e * 2048 + j0; const float* bu = bg + 1024;
        const f32x4 bg0 = *(const f32x4*)bg, bg1 = *(const f32x4*)(bg + 4), bu0 = *(const f32x4*)bu, bu1 = *(const f32x4*)(bu + 4);
#pragma unroll
        for (int ai = 0; ai < 2; ++ai)
#pragma unroll
            for (int m = 0; m < 4; ++m) {
                float o[8];
#pragma unroll
                for (int n = 0; n < 2; ++n) { const f32x4 g4 = acc[ai][0][m][n] + (n ? bg1 : bg0), u4 = acc[ai][1][m][n] + (n ? bu1 : bu0);
#pragma unroll
                    for (int j = 0; j < 4; ++j) { const float g = fminf(g4[j], 7.0f), up = fminf(fmaxf(u4[j], -7.0f), 7.0f); o[n * 4 + j] = (up + 1.0f) * (g * sigmoid_f(1.702f * g)); } }
                u32x4 w; w.x = cvt_pk_bf16(o[0], o[1]); w.y = cvt_pk_bf16(o[2], o[3]); w.z = cvt_pk_bf16(o[4], o[5]); w.w = cvt_pk_bf16(o[6], o[7]);
                *(u32x4*)(ACT + (size_t)(row0 + ai * 128 + m * 16) * 1024 + j0) = w;
            }
    }
};
struct EpiDown {
    static constexpr bool PERM = true;
    bf16* YS; const float* b_dn; const int* row_slot; const float* row_gate;
    DI void operator()(const f32x4 (&acc)[2][2][4][2], const Unit& u, int wr, int wc, int fr, int fq) const {
        const int row0 = u.pm * 256 + wr * 64 + fr, col0 = u.pn * 256 + wc * 32 + 8 * fq;
        const float* bb = b_dn + (size_t)u.e * 1024 + col0;
        f32x4 bv[2][2];
#pragma unroll
        for (int bj = 0; bj < 2; ++bj)
#pragma unroll
            for (int n = 0; n < 2; ++n) bv[bj][n] = *(const f32x4*)(bb + bj * 128 + 4 * n);
#pragma unroll
        for (int ai = 0; ai < 2; ++ai)
#pragma unroll
            for (int m = 0; m < 4; ++m) {
                const int r = row0 + ai * 128 + m * 16; const int slot = row_slot[r]; const float gt = row_gate[r];
                if (slot >= 0) { bf16* rowp = YS + (size_t)slot * 1024 + col0;
#pragma unroll
                    for (int bj = 0; bj < 2; ++bj) { const f32x4 v0 = (acc[ai][bj][m][0] + bv[bj][0]) * gt, v1 = (acc[ai][bj][m][1] + bv[bj][1]) * gt;
                        u32x4 w; w.x = cvt_pk_bf16(v0[0], v0[1]); w.y = cvt_pk_bf16(v0[2], v0[3]); w.z = cvt_pk_bf16(v1[0], v1[1]); w.w = cvt_pk_bf16(v1[2], v1[3]);
                        *(u32x4*)(rowp + bj * 128) = w; } }
            }
    }
};

constexpr size_t MiB = 1u << 20;
constexpr size_t WS_CTL = 0, CTL_ZERO_BYTES = 1 * MiB;
constexpr size_t WS_WIN = 1 * MiB, WS_WOUT = 7 * MiB, WS_WQ = 9 * MiB, WS_WK = 11 * MiB, WS_WV = 13 * MiB, WS_WO = 15 * MiB, WS_LORAB = 17 * MiB, WS_LRUW = 18 * MiB;
constexpr size_t WS_ROUTE = 19 * MiB;
constexpr size_t WS_WGU = 22 * MiB, WS_WDN = 150 * MiB;
constexpr size_t WS_HN = 214 * MiB, WS_MEMN = 246 * MiB, WS_KM = 248 * MiB, WS_VT = 250 * MiB;
constexpr size_t WS_X1 = 252 * MiB, WS_X2 = 316 * MiB;
constexpr size_t WS_U = 380 * MiB, WS_R = 468 * MiB, WS_KRAW = 500 * MiB, WS_V = 532 * MiB, WS_KKN = 564 * MiB, WS_WD = 596 * MiB, WS_AA = 628 * MiB, WS_G = 660 * MiB;
constexpr size_t WS_LA = 692 * MiB, WS_LB = 724 * MiB, WS_AP = 756 * MiB, WS_CAT = 764 * MiB, WS_Q = 796 * MiB;
constexpr size_t WS_XS = 380 * MiB, WS_ACT = 524 * MiB, WS_YS = 668 * MiB;
constexpr size_t WS_GP = 796 * MiB, WS_HF = 860 * MiB, WS_RP = 924 * MiB, WS_Y1F = 940 * MiB, WS_ADD = 972 * MiB, WS_END = 1004 * MiB;
constexpr size_t WS_GC = 468 * MiB, WS_HC = 484 * MiB, WS_ZS = 500 * MiB;
static_assert(WS_AA == WS_WD + 32 * MiB && WS_G == WS_AA + 32 * MiB, "EpiLora strides");
static_assert(WS_U + (size_t)M * INW * 2 <= WS_R && WS_XS + (size_t)MAXROWS * 2048 <= WS_ACT && WS_ACT + (size_t)MAXROWS * 2048 <= WS_YS && WS_YS + (size_t)NASSIGN * 2048 <= WS_Q, "ws map");
constexpr size_t RT_E = 0, RT_POS = 256 * 1024, RT_G = 512 * 1024, RT_SLOT = 768 * 1024, RT_GATE = 1088 * 1024, RT_TILE = 1408 * 1024, RT_TOK = 1472 * 1024;
constexpr int CW_BAR = 4096, CW_CNT = 8192;

constexpr int RING_BYTES = 131072, MISC_OFF = RING_BYTES + 320, LDS_BYTES = 147456;
constexpr int NWAVES = 8, NTHREADS = 512;

#define XB_TMO      128
#define XB_XCNT(j)  (256  + 64 * (j))
#define XB_XSUB(j)  (1280 + 64 * (j))
#define XB_XGEN(j)  (2304 + 64 * (j))
#define XB_TOP      3328
#define XB_TOPGEN   3392
#define XCD_BAR_WORDS 3456
#define XB_SPIN_CAP (1u << 18)
DI unsigned xb_ld(unsigned* p)              { return __hip_atomic_load(p, __ATOMIC_RELAXED, __HIP_MEMORY_SCOPE_AGENT); }
DI unsigned xb_add(unsigned* p, unsigned v) { return __hip_atomic_fetch_add(p, v, __ATOMIC_RELAXED, __HIP_MEMORY_SCOPE_AGENT); }
DI unsigned xb_xcc_id() { return (unsigned)__builtin_amdgcn_s_getreg((3 << 11) | 20) & 0xFu; }
#define XB_SPIN(cond, bar) do { unsigned _sp = 0; while (cond) { __builtin_amdgcn_s_sleep(1); \
    if ((++_sp & 255u) == 0u) { if (xb_ld(&(bar)[XB_TMO])) break; if (_sp > XB_SPIN_CAP) { atomicAdd(&(bar)[XB_TMO], 1u); break; } } } } while (0)
struct XcdBarrier { unsigned* bar; unsigned x; volatile LAS unsigned* st; };
DI XcdBarrier xcd_barrier_post(unsigned* bar, volatile LAS unsigned* st) {
    XcdBarrier b; b.bar = bar; b.x = xb_xcc_id(); b.st = st;
    if (threadIdx.x == 0) (void)xb_add(&bar[XB_XCNT(b.x)], 1u);
    return b;
}
DI void xcd_barrier_complete(unsigned* bar, unsigned x, unsigned& nloc, unsigned& nx) {
    const unsigned G = gridDim.x * gridDim.y * gridDim.z;
    unsigned sum, cnt, mine, sp = 0u;
    for (;;) {
        sum = 0u; cnt = 0u; mine = 0u;
#pragma unroll
        for (unsigned j = 0; j < 16; ++j) { const unsigned c = xb_ld(&bar[XB_XCNT(j)]); sum += c; cnt += (c > 0u) ? 1u : 0u; mine = (j == x) ? c : mine; }
        if (sum == G) break;
        __builtin_amdgcn_s_sleep(1);
        if ((++sp & 255u) == 0u) { if (xb_ld(&bar[XB_TMO])) break; if (sp > XB_SPIN_CAP) { atomicAdd(&bar[XB_TMO], 1u); break; } }
    }
    nloc = mine > 0u ? mine : 1u; nx = cnt > 0u ? cnt : 1u;
}
DI void xcd_barrier(const XcdBarrier& b) {
    asm volatile("s_waitcnt vmcnt(0)" ::: "memory");
    __syncthreads();
    if (threadIdx.x == 0) {
        unsigned* bar = b.bar;
        __builtin_amdgcn_s_waitcnt(0);
        unsigned nloc = b.st[0], nx = b.st[1];
        if (nloc == 0u) { xcd_barrier_complete(bar, b.x, nloc, nx); b.st[0] = nloc; b.st[1] = nx; }
        const unsigned old = xb_add(&bar[XB_XSUB(b.x)], 1u);
        const unsigned gen = old / nloc;
        if (old + 1u == (gen + 1u) * nloc) {
            __builtin_amdgcn_fence(__ATOMIC_RELEASE, "agent");
            asm volatile("s_waitcnt vmcnt(0)" ::: "memory");
            const unsigned og = xb_add(&bar[XB_TOP], 1u);
            const unsigned tg = og / nx;
            if (og + 1u == (tg + 1u) * nx) xb_add(&bar[XB_TOPGEN], 1u);
            else XB_SPIN(xb_ld(&bar[XB_TOPGEN]) == tg, bar);
            __builtin_amdgcn_fence(__ATOMIC_ACQUIRE, "agent");
            xb_add(&bar[XB_XGEN(b.x)], 1u);
            asm volatile("s_waitcnt vmcnt(0)" ::: "memory");
        } else {
            XB_SPIN(xb_ld(&bar[XB_XGEN(b.x)]) == gen, bar);
            __builtin_amdgcn_fence(__ATOMIC_ACQUIRE, "agent");
            asm volatile("s_waitcnt vmcnt(0)" ::: "memory");
        }
    }
    __syncthreads();
}

struct Args { const float* in[37]; float* out; unsigned char* ws; int ph_lo, ph_hi; };
enum { I_X = 0, I_MEM, I_NMIXG, I_WIN, I_CONVW, I_CONVB, I_LWX, I_LBX, I_LWA, I_LBA, I_LAM, I_MU, I_W0, I_WUP, I_A0, I_AUP, I_GUP, I_KK, I_KA, I_RK, I_LNG, I_LNB,
       I_WOUT, I_NXAG, I_NMEMG, I_WQ, I_WK, I_WV, I_WO, I_NFFG, I_WR, I_BR, I_WGU, I_BGU, I_WDN, I_BDN, I_FNG };

DI void transpose_item(const float* W, int ldw, int K, bf16* WT, int k0, int n0, int drow0, LAS float* scr, int lane) {
    f32x4 t[8];
    const float* src = W + (size_t)(k0 + (lane >> 3)) * ldw + n0 + 4 * (lane & 7);
#pragma unroll
    for (int i = 0; i < 8; ++i) t[i] = *(const f32x4*)(src + (size_t)(8 * i) * ldw);
#pragma unroll
    for (int i = 0; i < 8; ++i) { LAS float* d = scr + (8 * i + (lane >> 3)) * 33 + 4 * (lane & 7); d[0] = t[i].x; d[1] = t[i].y; d[2] = t[i].z; d[3] = t[i].w; }
    asm volatile("s_waitcnt lgkmcnt(0)" ::: "memory");
    const int c = lane & 7;
#pragma unroll
    for (int j = 0; j < 4; ++j) { const int n = (lane >> 3) + 8 * j; const LAS float* s = scr + (8 * c) * 33 + n;
        u32x4 o; o.x = pk2(s[0 * 33], s[1 * 33]); o.y = pk2(s[2 * 33], s[3 * 33]); o.z = pk2(s[4 * 33], s[5 * 33]); o.w = pk2(s[6 * 33], s[7 * 33]);
        *(u32x4*)(WT + (size_t)(drow0 + n) * K + k0 + 8 * c) = o; }
    asm volatile("s_waitcnt lgkmcnt(0)" ::: "memory");
}
DI void transpose_item_tiled(const float* W, int ldw, int K, bf16* WTe, int k0, int n0, int drow0, LAS float* scr, int lane) {
    f32x4 t[8];
    const float* src = W + (size_t)(k0 + (lane >> 3)) * ldw + n0 + 4 * (lane & 7);
#pragma unroll
    for (int i = 0; i < 8; ++i) t[i] = *(const f32x4*)(src + (size_t)(8 * i) * ldw);
#pragma unroll
    for (int i = 0; i < 8; ++i) { LAS float* d = scr + (8 * i + (lane >> 3)) * 33 + 4 * (lane & 7); d[0] = t[i].x; d[1] = t[i].y; d[2] = t[i].z; d[3] = t[i].w; }
    asm volatile("s_waitcnt lgkmcnt(0)" ::: "memory");
    const int c = lane & 7;
#pragma unroll
    for (int j = 0; j < 4; ++j) { const int n = (lane >> 3) + 8 * j; const LAS float* s = scr + (8 * c) * 33 + n;
        u32x4 o; o.x = pk2(s[0 * 33], s[1 * 33]); o.y = pk2(s[2 * 33], s[3 * 33]); o.z = pk2(s[4 * 33], s[5 * 33]); o.w = pk2(s[6 * 33], s[7 * 33]);
        const int drow = drow0 + n, pn = drow >> 8, half = (drow >> 7) & 1, r = drow & 127, x = r & 31;
        const int rslot = (r & ~31) + 16 * ((x >> 2) & 1) + 4 * (x >> 3) + (x & 3);
        const size_t tb = ((size_t)(pn * (K / 64) + (k0 >> 6)) * 2 + half) * 16384 + pg8::lds_byte(rslot, 8 * c);
        *(u32x4*)((char*)WTe + tb) = o; }
    asm volatile("s_waitcnt lgkmcnt(0)" ::: "memory");
}
DI void rms_row_to_bf16(const float* xrow, const float* g, bf16* orow, int lane) {
    const f32x4* xr = (const f32x4*)xrow + lane; const f32x4* gr = (const f32x4*)g + lane;
    f32x4 v[4]; float s = 0.f;
#pragma unroll
    for (int j = 0; j < 4; ++j) { v[j] = xr[64 * j]; s += (v[j].x * v[j].x + v[j].y * v[j].y) + (v[j].z * v[j].z + v[j].w * v[j].w); }
    const float rstd = 1.0f / sqrtf(wave_sum(s) * (1.f / D) + EPS);
    u32x2* o8 = (u32x2*)orow + lane;
#pragma unroll
    for (int j = 0; j < 4; ++j) { const f32x4 gg = gr[64 * j]; u32x2 w; w.x = pk2(v[j].x * rstd * gg.x, v[j].y * rstd * gg.y); w.y = pk2(v[j].z * rstd * gg.z, v[j].w * rstd * gg.w); o8[64 * j] = w; }
}

DI void rms_rowbf_to_bf16(const bf16* xrow, const float* g, bf16* orow, int lane) {
    float v[16]; float s = 0.f;
#pragma unroll
    for (int hf = 0; hf < 2; ++hf) { const u32x4 w = *(const u32x4*)(xrow + 512 * hf + 8 * lane);
#pragma unroll
        for (int q = 0; q < 4; ++q) { v[8 * hf + 2 * q] = bflo(w[q]); v[8 * hf + 2 * q + 1] = bfhi(w[q]); } }
#pragma unroll
    for (int j = 0; j < 16; ++j) s += v[j] * v[j];
    const float rstd = 1.0f / sqrtf(wave_sum(s) * (1.f / D) + EPS);
#pragma unroll
    for (int hf = 0; hf < 2; ++hf) { const f32x4 g0 = *(const f32x4*)(g + 512 * hf + 8 * lane), g1 = *(const f32x4*)(g + 512 * hf + 8 * lane + 4);
        u32x4 w; w.x = pk2(v[8 * hf] * rstd * g0.x, v[8 * hf + 1] * rstd * g0.y); w.y = pk2(v[8 * hf + 2] * rstd * g0.z, v[8 * hf + 3] * rstd * g0.w);
        w.z = pk2(v[8 * hf + 4] * rstd * g1.x, v[8 * hf + 5] * rstd * g1.y); w.w = pk2(v[8 * hf + 6] * rstd * g1.z, v[8 * hf + 7] * rstd * g1.w);
        *(u32x4*)(orow + 512 * hf + 8 * lane) = w; }
}

__global__ void __launch_bounds__(NTHREADS, 2) fwd(Args args) {
    extern __shared__ __attribute__((aligned(16))) unsigned char lds_raw[];
    LAS unsigned char* lds = (LAS unsigned char*)lds_raw;
    volatile LAS unsigned* MISC = (volatile LAS unsigned*)(lds + MISC_OFF);
    const int G = gridDim.x, bid = blockIdx.x, NGW = G * NWAVES;
#define PHASE_IDS const int tid = fresh_tid(), lane = tid & 63, wave = __builtin_amdgcn_readfirstlane(tid >> 6), gw = bid * NWAVES + wave; (void)tid; (void)lane; (void)wave; (void)gw
    unsigned char* ws = args.ws;
    unsigned* ctl = (unsigned*)(ws + WS_CTL);
    const int lo = args.ph_lo, hi = args.ph_hi;

    for (int u = threadIdx.x; u < (LDS_BYTES - RING_BYTES) / 4; u += NTHREADS) ((LAS unsigned*)(lds + RING_BYTES))[u] = 0u;
    __syncthreads();
    XcdBarrier bar; bar.bar = ctl + CW_BAR; bar.x = 0; bar.st = nullptr;
    if (hi - lo > 1) bar = xcd_barrier_post(ctl + CW_BAR, MISC + 8);
#define IN(k) (lo <= (k) && (k) < hi)
#define SEAM(k) do { if (IN(k) && IN((k) + 1)) xcd_barrier(bar); } while (0)

#define Win_t ((bf16*)(ws + WS_WIN))
#define Wout_t ((bf16*)(ws + WS_WOUT))
#define Wq_t ((bf16*)(ws + WS_WQ))
#define Wk_t ((bf16*)(ws + WS_WK))
#define Wv_t ((bf16*)(ws + WS_WV))
#define Wo_t ((bf16*)(ws + WS_WO))
#define LoraB ((bf16*)(ws + WS_LORAB))
#define LruW ((bf16*)(ws + WS_LRUW))
#define Wgu_t ((bf16*)(ws + WS_WGU))
#define Wdn_t ((bf16*)(ws + WS_WDN))
#define HN ((bf16*)(ws + WS_HN))
#define MEMN ((bf16*)(ws + WS_MEMN))
#define KM ((bf16*)(ws + WS_KM))
#define VT ((bf16*)(ws + WS_VT))
#define X1 ((bf16*)(ws + WS_X1))
#define X2 ((bf16*)(ws + WS_X2))
#define U ((bf16*)(ws + WS_U))
#define Rr ((float*)(ws + WS_R))
#define KRAW ((float*)(ws + WS_KRAW))
#define Vv ((float*)(ws + WS_V))
#define KKN ((float*)(ws + WS_KKN))
#define WD ((float*)(ws + WS_WD))
#define AA ((float*)(ws + WS_AA))
#define GG ((float*)(ws + WS_G))
#define LA ((bf16*)(ws + WS_LA))
#define LB ((bf16*)(ws + WS_LB))
#define AP ((bf16*)(ws + WS_AP))
#define CAT ((bf16*)(ws + WS_CAT))
#define Qb ((bf16*)(ws + WS_Q))
#define Ob CAT
#define XS ((bf16*)(ws + WS_XS))
#define ACT ((bf16*)(ws + WS_ACT))
#define YS ((bf16*)(ws + WS_YS))
#define route_e ((int*)(ws + WS_ROUTE + RT_E))
#define route_pos ((int*)(ws + WS_ROUTE + RT_POS))
#define route_g ((float*)(ws + WS_ROUTE + RT_G))
#define row_slot ((int*)(ws + WS_ROUTE + RT_SLOT))
#define row_gate ((float*)(ws + WS_ROUTE + RT_GATE))
#define tile_tab ((int*)(ws + WS_ROUTE + RT_TILE))
#define row_tok ((int*)(ws + WS_ROUTE + RT_TOK))
#define ecnt (ctl + CW_CNT)

    if (IN(0)) { PHASE_IDS;
        LAS float* scr = (LAS float*)(lds + wave * 16384);
        constexpr int I_IN = 16 * (INW / 32), I_SQ = 16 * 32;
        constexpr int N_ITEMS = I_IN + 5 * I_SQ;
        for (int it = gw; it < N_ITEMS; it += NGW) {
            int r = it;
            if (r < I_IN) { const int nblk = INW / 32, kb = r / nblk, nb = r % nblk; transpose_item(args.in[I_WIN], INW, D, Win_t, 64 * kb, 32 * nb, 32 * nb, scr, lane); continue; } r -= I_IN;
            { const int w = r / I_SQ, q = r % I_SQ, kb = q / 32, nb = q % 32;
                const float* src = w == 0 ? args.in[I_WOUT] : w == 1 ? args.in[I_WQ] : w == 2 ? args.in[I_WK] : w == 3 ? args.in[I_WV] : args.in[I_WO];
                bf16* dst = w == 0 ? Wout_t : w == 1 ? Wq_t : w == 2 ? Wk_t : w == 3 ? Wv_t : Wo_t;
                transpose_item(src, D, D, dst, 64 * kb, 32 * nb, 32 * nb, scr, lane); }
        }
        for (int idx = bid * NTHREADS + tid; idx < 1536 * 256; idx += G * NTHREADS) {
            const int n = idx >> 8, k = idx & 255; float v = 0.f;
            if (n < 512) { if (k < 64) v = args.in[I_WUP][k * 512 + n]; }
            else if (n < 1024) { if (k >= 64 && k < 128) v = args.in[I_AUP][(k - 64) * 512 + (n - 512)]; }
            else { if (k >= 128) v = args.in[I_GUP][(k - 128) * 512 + (n - 1024)]; }
            LoraB[idx] = (bf16)f2bf(v);
        }
        for (int idx = bid * NTHREADS + tid; idx < 8 * 128 * 64; idx += G * NTHREADS) {
            const int nb = idx >> 13, col = (idx >> 6) & 127, k = idx & 63;
            const float v = col < 64 ? args.in[I_LWX][nb * 4096 + k * 64 + col] : args.in[I_LWA][nb * 4096 + k * 64 + (col - 64)];
            LruW[idx] = (bf16)f2bf(v);
        }
        for (int m = gw; m < M; m += NGW) rms_row_to_bf16(args.in[I_X] + (size_t)m * D, args.in[I_NMIXG], HN + (size_t)m * D, lane);
        for (int m = gw; m < MROWS; m += NGW) rms_row_to_bf16(args.in[I_MEM] + (size_t)m * D, args.in[I_NMEMG], MEMN + (size_t)m * D, lane);
    }
    SEAM(0);

    if (IN(1)) { PHASE_IDS;
        { pg8::DenseSched S; S.o.init_tiles(M / 256, INW / 256, G, bid); S.A = (const char*)HN; S.B = (const char*)Win_t; S.tstep = (size_t)256 * D * 2;
          EpiBf16Plain E{U, INW, 1.0f}; pg8::gemm_phase(lds, D, S, E); }
        { pg8::DenseSched S; S.o.init_tiles(MROWS / 256, D / 256, G, (bid + 64) & (G - 1)); S.A = (const char*)MEMN; S.B = (const char*)Wk_t; S.tstep = (size_t)256 * D * 2;
          EpiBf16Plain E{KM, D, 1.0f}; pg8::gemm_phase(lds, D, S, E); }
        { pg8::DenseSched S; S.o.init_tiles(D / 256, MROWS / 256, G, (bid + 48) & (G - 1)); S.A = (const char*)Wv_t; S.B = (const char*)MEMN; S.tstep = (size_t)256 * D * 2;
          EpiBf16Plain E{VT, MROWS, 1.0f}; pg8::gemm_phase(lds, D, S, E); }
    }
    SEAM(1);

    if (IN(2)) { PHASE_IDS;
        const float* mu = args.in[I_MU];
        for (int m = gw; m < M; m += NGW) {
            const bool hp = (m & (SEQ - 1)) != 0;
            const bf16* ur = U + (size_t)m * INW + 2560 + 4 * lane;
            const u32x2 cu = *(const u32x2*)ur; u32x2 pu = (u32x2){0u, 0u}; if (hp) pu = *(const u32x2*)(ur - INW);
            const f32x4 m4 = *(const f32x4*)(mu + 1536 + 4 * lane);
            f32x4 uu; { const float a0 = bflo(cu.x), a1 = bfhi(cu.x), a2 = bflo(cu.y), a3 = bfhi(cu.y), p0 = bflo(pu.x), p1 = bfhi(pu.x), p2 = bflo(pu.y), p3 = bfhi(pu.y);
                uu.x = a0 + (p0 - a0) * m4.x; uu.y = a1 + (p1 - a1) * m4.y; uu.z = a2 + (p2 - a2) * m4.z; uu.w = a3 + (p3 - a3) * m4.w; }
            f32x4 o = uu;
            if (lane < 16) { o.x = tanhf(uu.x); o.y = tanhf(uu.y); o.z = tanhf(uu.z); o.w = tanhf(uu.w); }
            else if (lane >= 32) { o.x = sigmoid_f(uu.x); o.y = sigmoid_f(uu.y); o.z = sigmoid_f(uu.z); o.w = sigmoid_f(uu.w); }
            u32x2 w; w.x = pk2(o.x, o.y); w.y = pk2(o.z, o.w); *(u32x2*)(AP + (size_t)m * 256 + 4 * lane) = w;
        }
        {
            const float* conv_w = args.in[I_CONVW]; const float* conv_b = args.in[I_CONVB]; const float* bx = args.in[I_LBX]; const float* ba = args.in[I_LBA]; const float* lam = args.in[I_LAM];
            LAS float* xs = (LAS float*)(lds + wave * 4096);
            const int i = lane & 15, kg = lane >> 4;
            for (int unit = gw; unit < (M / 16) * 2; unit += NGW) {
                const int tile = unit >> 1, nb0 = (unit & 1) * 4, m0 = tile * 16, s0 = m0 & (SEQ - 1);
                for (int nb = nb0; nb < nb0 + 4; ++nb) {
                    bf16x8 af[2];
#pragma unroll
                    for (int ks = 0; ks < 2; ++ks) {
                        const int chb = nb * 64 + 32 * ks + 8 * kg;
                        f32x4 x0 = *(const f32x4*)(conv_b + chb), x1 = *(const f32x4*)(conv_b + chb + 4);
#pragma unroll
                        for (int j = 0; j < 4; ++j) {
                            if (s0 + i - 3 + j >= 0) {
                                const u32x4 uw = *(const u32x4*)(U + (size_t)(m0 + i - 3 + j) * INW + chb);
                                const f32x4 w0 = *(const f32x4*)(conv_w + j * 512 + chb), w1 = *(const f32x4*)(conv_w + j * 512 + chb + 4);
                                x0.x += w0.x * bflo(uw.x); x0.y += w0.y * bfhi(uw.x); x0.z += w0.z * bflo(uw.y); x0.w += w0.w * bfhi(uw.y);
                                x1.x += w1.x * bflo(uw.z); x1.y += w1.y * bfhi(uw.z); x1.z += w1.z * bflo(uw.w); x1.w += w1.w * bfhi(uw.w);
                            }
                        }
                        *(LAS f32x4*)(xs + i * 64 + 32 * ks + 8 * kg) = x0; *(LAS f32x4*)(xs + i * 64 + 32 * ks + 8 * kg + 4) = x1;
                        u32x4 p; p.x = pk2(x0.x, x0.y); p.y = pk2(x0.z, x0.w); p.z = pk2(x1.x, x1.y); p.w = pk2(x1.z, x1.w);
                        af[ks] = __builtin_bit_cast(bf16x8, p);
                    }
                    f32x4 acc[8];
#pragma unroll
                    for (int ct = 0; ct < 8; ++ct) { acc[ct] = (f32x4){0.f, 0.f, 0.f, 0.f};
#pragma unroll
                        for (int ks = 0; ks < 2; ++ks) { const bf16x8 bfr = *(const bf16x8*)(LruW + ((size_t)(nb * 128 + 16 * ct + i) * 64 + 32 * ks + 8 * kg));
                            acc[ct] = __builtin_amdgcn_mfma_f32_16x16x32_bf16(af[ks], bfr, acc[ct], 0, 0, 0); } }
                    asm volatile("s_waitcnt lgkmcnt(0)" ::: "memory");
#pragma unroll
                    for (int ct = 0; ct < 4; ++ct) {
                        const int col = 16 * ct + i, ch = nb * 64 + col;
                        const float bxv = bx[ch], bav = ba[ch], sp = softplus_f(-lam[ch]);
#pragma unroll
                        for (int e = 0; e < 4; ++e) {
                            const int tok = 4 * kg + e;
                            const float gx = sigmoid_f(acc[ct][e] + bxv), ga = sigmoid_f(acc[ct + 4][e] + bav);
                            const float la = -8.0f * ga * sp, xcv = xs[tok * 64 + col];
                            const float bt = sqrtf(fmaxf(-expm1f(2.0f * la), 0.f)) * gx * xcv;
                            LA[(size_t)(m0 + tok) * 512 + ch] = (bf16)f2bf(la); LB[(size_t)(m0 + tok) * 512 + ch] = (bf16)f2bf(bt);
                        }
                    }
                }
            }
        }
    }
    SEAM(2);

    if (IN(3)) { PHASE_IDS;
        pg8::DenseSched S; S.o.init_tiles(M / 256, 1536 / 256, G, bid); S.A = (const char*)AP; S.B = (const char*)LoraB; S.tstep = (size_t)256 * 256 * 2;
        EpiLora E{WD, (bf16*)(ws + WS_AA), (bf16*)(ws + WS_G), args.in[I_W0], args.in[I_A0]}; pg8::gemm_phase(lds, 256, S, E);
    }
    SEAM(3);

#define RW_ZB(zz, zb) do { _Pragma("unroll") for (int ks_ = 0; ks_ < 2; ++ks_) { u32x4 p_; p_.x = pk2(zz[2 * ks_][0], zz[2 * ks_][1]); p_.y = pk2(zz[2 * ks_][2], zz[2 * ks_][3]); \
        p_.z = pk2(zz[2 * ks_ + 1][0], zz[2 * ks_ + 1][1]); p_.w = pk2(zz[2 * ks_ + 1][2], zz[2 * ks_ + 1][3]); zb[ks_] = __builtin_bit_cast(bf16x8, p_); } } while (0)
    if (IN(4)) { PHASE_IDS;
        for (int u64 = gw; u64 < NB * NH * (SEQ / 64); u64 += NGW) {
#pragma unroll 1
        for (int jj = 0; jj < 4; ++jj) {
        LAS unsigned char* wl = lds + wave * 16384;
        LAS bf16* Arm = (LAS bf16*)(wl); LAS bf16* Brm = (LAS bf16*)(wl + 2048); LAS bf16* Krm = (LAS bf16*)(wl + 4096); LAS bf16* Rrm = (LAS bf16*)(wl + 6144);
        LAS bf16* ATt = (LAS bf16*)(wl + 8192); LAS bf16* BTt = (LAS bf16*)(wl + 10240); LAS bf16* KTt = (LAS bf16*)(wl + 12288); LAS bf16* VTt = (LAS bf16*)(wl + 14336);
        LAS float* MabT = (LAS float*)(wl); LAS bf16* Mak = (LAS bf16*)(wl + 1024); LAS bf16* Mrb = (LAS bf16*)(wl + 1536); LAS bf16* Mrk = (LAS bf16*)(wl + 2048); LAS bf16* Tm = (LAS bf16*)(wl + 2560);
        LAS float* PLs = (LAS float*)(wl + 3072); LAS bf16* Q0T = (LAS bf16*)(wl + 4096);
        const int lane = fresh_tid() & 63, l15 = lane & 15, g = lane >> 4, te = lane >> 2, kq = lane & 3;
        const bf16x8 z8 = (bf16x8){0, 0, 0, 0, 0, 0, 0, 0};
        const f32x4 z4 = (f32x4){0.f, 0.f, 0.f, 0.f};
            const int un = u64 * 4 + jj;
            const int bh = un >> 8, c = un & 255, b = bh >> 3, h = bh & 7;
            const size_t mrow = (size_t)b * SEQ + c * 16 + te, off = mrow * 512 + h * 64 + 16 * kq;
            const int hc = h * 64 + 16 * kq;
            float cl[16], eP[16];
            {
                float lwv[16], rl[16], kl[16], vl[16], kn[16], av[16];
                const bool hp = (mrow & (SEQ - 1)) != 0;
                const bf16* ub = U + mrow * INW + 1024 + hc;
#pragma unroll
                for (int hh = 0; hh < 2; ++hh) {
#pragma unroll
                    for (int a3 = 0; a3 < 3; ++a3) {
                        const u32x4 cu = *(const u32x4*)(ub + 512 * a3 + 8 * hh); u32x4 pu = (u32x4){0u, 0u, 0u, 0u}; if (hp) pu = *(const u32x4*)(ub - INW + 512 * a3 + 8 * hh);
                        const f32x4 m0 = *(const f32x4*)(args.in[I_MU] + 512 * a3 + hc + 8 * hh), m1 = *(const f32x4*)(args.in[I_MU] + 512 * a3 + hc + 8 * hh + 4);
                        float o8[8];
#pragma unroll
                        for (int q = 0; q < 4; ++q) { const float c0 = bflo(cu[q]), c1 = bfhi(cu[q]), p0 = bflo(pu[q]), p1 = bfhi(pu[q]); const float mm0 = q < 2 ? m0[2 * q] : m1[2 * q - 4], mm1 = q < 2 ? m0[2 * q + 1] : m1[2 * q - 3];
                            o8[2 * q] = c0 + (p0 - c0) * mm0; o8[2 * q + 1] = c1 + (p1 - c1) * mm1; }
#pragma unroll
                        for (int q = 0; q < 8; ++q) { if (a3 == 0) rl[8 * hh + q] = o8[q]; else if (a3 == 1) kl[8 * hh + q] = o8[q]; else vl[8 * hh + q] = o8[q]; }
                    }
                    const u32x4 aw = *(const u32x4*)((const bf16*)(ws + WS_AA) + off + 8 * hh);
#pragma unroll
                    for (int q = 0; q < 4; ++q) { av[8 * hh + 2 * q] = bflo(aw[q]); av[8 * hh + 2 * q + 1] = bfhi(aw[q]); }
                }
                float ss = 0.f;
#pragma unroll
                for (int j4 = 0; j4 < 4; ++j4) { const f32x4 x = *(const f32x4*)(WD + off + 4 * j4), kk4 = *(const f32x4*)(args.in[I_KK] + hc + 4 * j4); lwv[4 * j4] = x.x; lwv[4 * j4 + 1] = x.y; lwv[4 * j4 + 2] = x.z; lwv[4 * j4 + 3] = x.w;
#pragma unroll
                    for (int q = 0; q < 4; ++q) { kn[4 * j4 + q] = kl[4 * j4 + q] * kk4[q]; ss += kn[4 * j4 + q] * kn[4 * j4 + q]; } }
                ss += __shfl_xor(ss, 1); ss += __shfl_xor(ss, 2);
                const float kinv = 1.0f / fmaxf(sqrtf(ss), 1e-12f);
#pragma unroll
                for (int j = 0; j < 16; ++j) { float x = lwv[j];
#pragma unroll
                    for (int sft = 4; sft < 64; sft <<= 1) { const float y = __shfl_up(x, sft); if (lane >= sft) x += y; }
                    cl[j] = x; }
                float bon = 0.f;
                u32x4 pa[2], pb[2], pk[2], pr[2];
#pragma unroll
                for (int j4 = 0; j4 < 4; ++j4) {
                    const f32x4 ka = *(const f32x4*)(args.in[I_KA] + hc + 4 * j4), rk = *(const f32x4*)(args.in[I_RK] + hc + 4 * j4);
                    float at4[4], bt4[4], kt4[4], rt4[4];
#pragma unroll
                    for (int q = 0; q < 4; ++q) { const int j = 4 * j4 + q;
                        const float p = __expf(cl[j]), pn = __expf(-cl[j]), pm1 = __expf(cl[j] - lwv[j]); eP[j] = p;
                        const float knj = kn[j] * kinv;
                        const float kp = kl[j] * (1.0f + (av[j] - 1.0f) * ka[q]);
                        at4[q] = -knj * pm1; bt4[q] = knj * av[j] * pn; kt4[q] = kp * pn; rt4[q] = rl[j] * p;
                        bon += rl[j] * kp * rk[q];
                        const int kk = 16 * kq + j;
                        ATt[kk * 16 + te] = (bf16)f2bf(at4[q]); BTt[kk * 16 + te] = (bf16)f2bf(bt4[q]); KTt[kk * 16 + te] = (bf16)f2bf(kt4[q]); VTt[kk * 16 + te] = (bf16)f2bf(vl[j]); }
                    const int hh = j4 >> 1, w2 = (j4 & 1) * 2;
                    pa[hh][w2] = pk2(at4[0], at4[1]); pa[hh][w2 + 1] = pk2(at4[2], at4[3]); pb[hh][w2] = pk2(bt4[0], bt4[1]); pb[hh][w2 + 1] = pk2(bt4[2], bt4[3]);
                    pk[hh][w2] = pk2(kt4[0], kt4[1]); pk[hh][w2 + 1] = pk2(kt4[2], kt4[3]); pr[hh][w2] = pk2(rt4[0], rt4[1]); pr[hh][w2 + 1] = pk2(rt4[2], rt4[3]);
                }
#pragma unroll
                for (int hh = 0; hh < 2; ++hh) { const int po = te * 64 + 8 * ((2 * kq + hh) ^ (te & 7));
                    *(LAS u32x4*)(Arm + po) = pa[hh]; *(LAS u32x4*)(Brm + po) = pb[hh]; *(LAS u32x4*)(Krm + po) = pk[hh]; *(LAS u32x4*)(Rrm + po) = pr[hh]; }
                bon += __shfl_xor(bon, 1); bon += __shfl_xor(bon, 2);
#pragma unroll
                for (int hh = 0; hh < 2; ++hh) { const u32x4 gw_ = *(const u32x4*)((const bf16*)(ws + WS_G) + off + 8 * hh);
#pragma unroll
                    for (int q2 = 0; q2 < 2; ++q2) { const f32x4 lb = *(const f32x4*)(args.in[I_LNB] + hc + 8 * hh + 4 * q2); const int j0 = 8 * hh + 4 * q2;
                        f32x4 o; o.x = (lb.x + vl[j0] * bon) * bflo(gw_[2 * q2]); o.y = (lb.y + vl[j0 + 1] * bon) * bfhi(gw_[2 * q2]); o.z = (lb.z + vl[j0 + 2] * bon) * bflo(gw_[2 * q2 + 1]); o.w = (lb.w + vl[j0 + 3] * bon) * bfhi(gw_[2 * q2 + 1]);
                        u32x2 ow; ow.x = pk2(o.x, o.y); ow.y = pk2(o.z, o.w); *(u32x2*)((bf16*)(ws + WS_ADD) + off + j0) = ow; } }
            }
            asm volatile("s_waitcnt lgkmcnt(0)" ::: "memory");
            {
                bf16x8 fa[2], fr[2], fb[2], fk[2];
#pragma unroll
                for (int ks = 0; ks < 2; ++ks) { const int po = l15 * 64 + 8 * ((4 * ks + g) ^ (l15 & 7));
                    fa[ks] = *(const LAS bf16x8*)(Arm + po); fr[ks] = *(const LAS bf16x8*)(Rrm + po); fb[ks] = *(const LAS bf16x8*)(Brm + po); fk[ks] = *(const LAS bf16x8*)(Krm + po); }
                f32x4 mab = z4, mak = z4, mrb = z4, mrk = z4;
#pragma unroll
                for (int ks = 0; ks < 2; ++ks) { mab = __builtin_amdgcn_mfma_f32_16x16x32_bf16(fb[ks], fa[ks], mab, 0, 0, 0); mak = __builtin_amdgcn_mfma_f32_16x16x32_bf16(fk[ks], fa[ks], mak, 0, 0, 0);
                    mrb = __builtin_amdgcn_mfma_f32_16x16x32_bf16(fb[ks], fr[ks], mrb, 0, 0, 0); mrk = __builtin_amdgcn_mfma_f32_16x16x32_bf16(fk[ks], fr[ks], mrk, 0, 0, 0); }
#pragma unroll
                for (int e = 0; e < 4; ++e) { const int i = 4 * g + e; if (!(i < l15)) { mab[e] = 0.f; mak[e] = 0.f; } if (!(i <= l15)) { mrb[e] = 0.f; mrk[e] = 0.f; } }
                asm volatile("s_waitcnt lgkmcnt(0)" ::: "memory");
#pragma unroll
                for (int e = 0; e < 4; ++e) MabT[(4 * g + e) * 16 + l15] = mab[e];
                u32x2 w; w.x = pk2(mak[0], mak[1]); w.y = pk2(mak[2], mak[3]); *(LAS u32x2*)(Mak + l15 * 16 + 4 * g) = w;
                w.x = pk2(mrb[0], mrb[1]); w.y = pk2(mrb[2], mrb[3]); *(LAS u32x2*)(Mrb + l15 * 16 + 4 * g) = w;
                w.x = pk2(mrk[0], mrk[1]); w.y = pk2(mrk[2], mrk[3]); *(LAS u32x2*)(Mrk + l15 * 16 + 4 * g) = w;
                if (te == 15) {
#pragma unroll
                    for (int j = 0; j < 16; ++j) PLs[16 * kq + j] = eP[j]; }
            }
            asm volatile("s_waitcnt lgkmcnt(0)" ::: "memory");
            {
                float y[16];
#pragma unroll
                for (int j = 15; j >= 0; --j) {
                    float acc = (j == l15) ? 1.0f : 0.0f;
                    float row[16];
#pragma unroll
                    for (int q = 0; q < 4; ++q) { const f32x4 x = *(const LAS f32x4*)(MabT + j * 16 + 4 * q); row[4 * q] = x.x; row[4 * q + 1] = x.y; row[4 * q + 2] = x.z; row[4 * q + 3] = x.w; }
#pragma unroll
                    for (int i = j + 1; i < 16; ++i) acc += y[i] * row[i];
                    y[j] = acc;
                }
                if (g == 0) { u32x4 t0, t1; t0.x = pk2(y[0], y[1]); t0.y = pk2(y[2], y[3]); t0.z = pk2(y[4], y[5]); t0.w = pk2(y[6], y[7]); t1.x = pk2(y[8], y[9]); t1.y = pk2(y[10], y[11]); t1.z = pk2(y[12], y[13]); t1.w = pk2(y[14], y[15]);
                    *(LAS u32x4*)(Tm + l15 * 16) = t0; *(LAS u32x4*)(Tm + l15 * 16 + 8) = t1; }
            }
            asm volatile("s_waitcnt lgkmcnt(0)" ::: "memory");
            {
                const bool act = g < 2; const int fo = l15 * 16 + 8 * g;
                const bf16x8 fT = act ? *(const LAS bf16x8*)(Tm + fo) : z8, fMak = act ? *(const LAS bf16x8*)(Mak + fo) : z8, fMrb = act ? *(const LAS bf16x8*)(Mrb + fo) : z8, fMrk = act ? *(const LAS bf16x8*)(Mrk + fo) : z8;
                bf16x8 fV[4], fQ1[4], fAh[4], fBT[4], fKT[4];
#pragma unroll
                for (int vt = 0; vt < 4; ++vt) { fV[vt] = act ? *(const LAS bf16x8*)(VTt + vt * 256 + fo) : z8; fBT[vt] = act ? *(const LAS bf16x8*)(BTt + vt * 256 + fo) : z8; fKT[vt] = act ? *(const LAS bf16x8*)(KTt + vt * 256 + fo) : z8; }
#pragma unroll
                for (int vt = 0; vt < 4; ++vt) { const f32x4 q0 = __builtin_amdgcn_mfma_f32_16x16x32_bf16(fMak, fV[vt], z4, 0, 0, 0);
                    u32x2 w; w.x = pk2(q0[0], q0[1]); w.y = pk2(q0[2], q0[3]); *(LAS u32x2*)(Q0T + vt * 256 + l15 * 16 + 4 * g) = w; }
#pragma unroll
                for (int kt = 0; kt < 4; ++kt) { const bf16x8 fA = act ? *(const LAS bf16x8*)(ATt + kt * 256 + fo) : z8; const f32x4 ah = __builtin_amdgcn_mfma_f32_16x16x32_bf16(fT, fA, z4, 0, 0, 0);
                    u32x2 w; w.x = pk2(ah[0], ah[1]); w.y = pk2(ah[2], ah[3]); *(LAS u32x2*)(ATt + kt * 256 + l15 * 16 + 4 * g) = w; }
                asm volatile("s_waitcnt lgkmcnt(0)" ::: "memory");
#pragma unroll
                for (int vt = 0; vt < 4; ++vt) { const bf16x8 fQ0 = act ? *(const LAS bf16x8*)(Q0T + vt * 256 + fo) : z8; const f32x4 q1 = __builtin_amdgcn_mfma_f32_16x16x32_bf16(fT, fQ0, z4, 0, 0, 0);
                    u32x2 w; w.x = pk2(q1[0], q1[1]); w.y = pk2(q1[2], q1[3]); *(LAS u32x2*)(Q0T + vt * 256 + l15 * 16 + 4 * g) = w; }
                asm volatile("s_waitcnt lgkmcnt(0)" ::: "memory");
#pragma unroll
                for (int vt = 0; vt < 4; ++vt) { fQ1[vt] = act ? *(const LAS bf16x8*)(Q0T + vt * 256 + fo) : z8; fAh[vt] = act ? *(const LAS bf16x8*)(ATt + vt * 256 + fo) : z8; }
                bf16* rp = (bf16*)(ws + WS_RP) + (size_t)un * 1024 + l15 * 64;
#pragma unroll
                for (int kt = 0; kt < 4; ++kt) {
                    const u32x2 rr = *(const LAS u32x2*)(Rrm + l15 * 64 + 8 * ((2 * kt + (g >> 1)) ^ (l15 & 7)) + 4 * (g & 1));
                    f32x4 ini; ini[0] = bflo(rr.x); ini[1] = bfhi(rr.x); ini[2] = bflo(rr.y); ini[3] = bfhi(rr.y);
                    const f32x4 rh = __builtin_amdgcn_mfma_f32_16x16x32_bf16(fAh[kt], fMrb, ini, 0, 0, 0);
                    u32x2 w; w.x = pk2(rh[0], rh[1]); w.y = pk2(rh[2], rh[3]); *(u32x2*)(rp + 32 * (kt >> 1) + 8 * g + 4 * (kt & 1)) = w;
                }
#pragma unroll
                for (int vt = 0; vt < 4; ++vt) { f32x4 y1 = __builtin_amdgcn_mfma_f32_16x16x32_bf16(fMrb, fQ1[vt], z4, 0, 0, 0); y1 = __builtin_amdgcn_mfma_f32_16x16x32_bf16(fMrk, fV[vt], y1, 0, 0, 0);
                    *(f32x4*)((float*)(ws + WS_Y1F) + ((size_t)(un * 4 + vt) * 64 + lane) * 4) = y1; }
                bf16* gp = (bf16*)(ws + WS_GP) + (size_t)un * 4096;
#pragma unroll
                for (int krt = 0; krt < 4; ++krt) { const float pl = PLs[16 * krt + l15];
#pragma unroll
                    for (int kct = 0; kct < 4; ++kct) { f32x4 ga = __builtin_amdgcn_mfma_f32_16x16x32_bf16(fAh[kct], fBT[krt], z4, 0, 0, 0);
                        if (kct == krt) {
#pragma unroll
                            for (int e = 0; e < 4; ++e) if (4 * g + e == l15) ga[e] += 1.0f; }
                        u32x2 w; w.x = pk2(ga[0] * pl, ga[1] * pl); w.y = pk2(ga[2] * pl, ga[3] * pl);
                        *(u32x2*)(gp + (16 * krt + l15) * 64 + 32 * (kct >> 1) + 8 * g + 4 * (kct & 1)) = w; } }
#pragma unroll
                for (int mt = 0; mt < 4; ++mt) { const f32x4 pl4 = *(const LAS f32x4*)(PLs + 16 * mt + 4 * g);
#pragma unroll
                    for (int vt = 0; vt < 4; ++vt) { f32x4 ha = __builtin_amdgcn_mfma_f32_16x16x32_bf16(fBT[mt], fQ1[vt], z4, 0, 0, 0); ha = __builtin_amdgcn_mfma_f32_16x16x32_bf16(fKT[mt], fV[vt], ha, 0, 0, 0);
                        u32x2 w; w.x = pk2(ha[0] * pl4[0], ha[1] * pl4[1]); w.y = pk2(ha[2] * pl4[2], ha[3] * pl4[3]);
                        *(u32x2*)((bf16*)(ws + WS_HF) + ((size_t)((un * 4 + vt) * 4 + mt) * 64 + lane) * 4) = w; } }
            }
            asm volatile("s_waitcnt lgkmcnt(0)" ::: "memory");
        }
        asm volatile("s_waitcnt vmcnt(0)" ::: "memory");
        { const int ltid = fresh_tid() & 63, l15 = ltid & 15, g = ltid >> 4, lane = ltid;
#pragma unroll 1
        for (int part = 0; part < 2; ++part) {
            f32x4 z[4][4];
#pragma unroll
            for (int sl = 0; sl < 4; ++sl)
#pragma unroll
                for (int mt = 0; mt < 4; ++mt)
#pragma unroll
                    for (int e = 0; e < 4; ++e) z[sl][mt][e] = (part == 0 && sl == mt && 4 * g + e == l15) ? 1.0f : 0.0f;
#pragma unroll 1
            for (int j = 0; j < 4; ++j) {
                const size_t un = (size_t)u64 * 4 + j;
                const bf16* gp = (const bf16*)(ws + WS_GP) + un * 4096 + l15 * 64 + 8 * g;
                bf16x8 gf[4][2];
#pragma unroll
                for (int mt = 0; mt < 4; ++mt) { gf[mt][0] = *(const bf16x8*)(gp + mt * 1024); gf[mt][1] = *(const bf16x8*)(gp + mt * 1024 + 32); }
#pragma unroll
                for (int sl = 0; sl < 4; ++sl) {
                    bf16x8 zb[2]; RW_ZB(z[sl], zb);
#pragma unroll
                    for (int mt = 0; mt < 4; ++mt) {
                        f32x4 a = (f32x4){0.f, 0.f, 0.f, 0.f};
                        if (part) { const u32x2 hh = *(const u32x2*)((const bf16*)(ws + WS_HF) + ((size_t)((un * 4 + sl) * 4 + mt) * 64 + lane) * 4); a[0] = bflo(hh.x); a[1] = bfhi(hh.x); a[2] = bflo(hh.y); a[3] = bfhi(hh.y); }
                        a = __builtin_amdgcn_mfma_f32_16x16x32_bf16(gf[mt][0], zb[0], a, 0, 0, 0); a = __builtin_amdgcn_mfma_f32_16x16x32_bf16(gf[mt][1], zb[1], a, 0, 0, 0);
                        z[sl][mt] = a;
                    }
                }
            }
            if (part == 0) {
                bf16* gc = (bf16*)(ws + WS_GC) + (size_t)u64 * 4096;
#pragma unroll
                for (int sl = 0; sl < 4; ++sl) { const int pc = 32 * (sl >> 1) + 8 * (l15 >> 2) + 4 * (sl & 1) + (l15 & 3);
#pragma unroll
                    for (int mt = 0; mt < 4; ++mt)
#pragma unroll
                        for (int e = 0; e < 4; ++e) gc[(16 * mt + 4 * g + e) * 64 + pc] = (bf16)f2bf(z[sl][mt][e]); }
            } else {
#pragma unroll
                for (int sl = 0; sl < 4; ++sl)
#pragma unroll
                    for (int mt = 0; mt < 4; ++mt) { u32x2 w; w.x = pk2(z[sl][mt][0], z[sl][mt][1]); w.y = pk2(z[sl][mt][2], z[sl][mt][3]);
                        *(u32x2*)((bf16*)(ws + WS_HC) + ((size_t)((u64 * 4 + sl) * 4 + mt) * 64 + lane) * 4) = w; }
            }
        }
        }
        }
        for (int lu = gw; lu < NB * 8 * 64; lu += NGW) {
            const int bc = lu >> 6, seg = lu & 63, b = bc >> 3, cg = bc & 7, ch = cg * 64 + lane;
            const size_t mb = (size_t)b * SEQ + seg * 64;
            float A = 1.f, B = 0.f;
#pragma unroll 16
            for (int t = 0; t < 64; ++t) { const float a = __expf(bf2f(LA[(mb + t) * 512 + ch])), bt = bf2f(LB[(mb + t) * 512 + ch]); B = a * B + bt; A *= a; }
            f32x2 ab; ab.x = A; ab.y = B; *(f32x2*)((float*)(ws + WS_AP) + ((size_t)lu * 64 + lane) * 2) = ab;
        }
    }
    SEAM(4);


    if (IN(5)) { PHASE_IDS;
        if (!(bid < 128 && wave == 0)) {
            const int wi = bid < 128 ? bid * 7 + (wave - 1) : 896 + (bid - 128) * 8 + wave, NW = 896 + (G - 128) * 8;
            for (int lu = wi; lu < NB * 8 * 64; lu += NW) {
                const int bc = lu >> 6, seg = lu & 63, b = bc >> 3, cg = bc & 7, ch = cg * 64 + lane;
                const size_t mb = (size_t)b * SEQ + seg * 64;
                float hst = 0.f;
                const f32x2* ag = (const f32x2*)((const float*)(ws + WS_AP)) + (size_t)(bc * 64) * 64 + lane;
#pragma unroll 8
                for (int sg = 0; sg < seg; ++sg) { const f32x2 ab = ag[(size_t)sg * 64]; hst = ab.x * hst + ab.y; }
#pragma unroll 16
                for (int t = 0; t < 64; ++t) { const float a = __expf(bf2f(LA[(mb + t) * 512 + ch])), bt = bf2f(LB[(mb + t) * 512 + ch]); hst = a * hst + bt;
                    const float gl = bf2f(U[(mb + t) * INW + 512 + ch]); CAT[(mb + t) * 1024 + ch] = (bf16)f2bf(hst * gelu_tanh_f(gl)); }
            }
            LAS float* scr = (LAS float*)(lds + wave * 16384);
            constexpr int I_GU = 16 * 64, I_DN = 16 * 32;
            for (int it = wi; it < NE * (I_GU + I_DN); it += NW) {
                int r = it;
                if (r < NE * I_GU) { const int e = r / I_GU, q = r % I_GU, kb = q / 64, nb = q % 64; const int n0 = 32 * nb;
                    const int drow = n0 < 1024 ? (256 * (n0 >> 7) + (n0 & 127)) : (256 * ((n0 - 1024) >> 7) + 128 + ((n0 - 1024) & 127));
                    transpose_item_tiled(args.in[I_WGU] + (size_t)e * D * 2048, 2048, D, Wgu_t + (size_t)e * 2048 * D, 64 * kb, n0, drow, scr, lane); continue; } r -= NE * I_GU;
                { const int e = r / I_DN, q = r % I_DN, kb = q / 32, nb = q % 32;
                  transpose_item_tiled(args.in[I_WDN] + (size_t)e * DFF * D, D, DFF, Wdn_t + (size_t)e * D * DFF, 64 * kb, 32 * nb, 32 * nb, scr, lane); }
            }
        } else {
            const int l15 = lane & 15, g = lane >> 4, bh = bid >> 2, vs = bid & 3;
            f32x4 z[4];
#pragma unroll
            for (int mt = 0; mt < 4; ++mt) z[mt] = (f32x4){0.f, 0.f, 0.f, 0.f};
            bf16x8 gA[4][2], gB[4][2], gC[4][2], gD[4][2]; u32x2 hA[4], hB[4], hC[4], hD[4];
#define SC_LOAD(gf, hf, C) do { const size_t u64_ = (size_t)bh * 64 + (C); const bf16* gp_ = (const bf16*)(ws + WS_GC) + u64_ * 4096 + l15 * 64 + 8 * g; \
                _Pragma("unroll") for (int mt = 0; mt < 4; ++mt) { gf[mt][0] = *(const bf16x8*)(gp_ + mt * 1024); gf[mt][1] = *(const bf16x8*)(gp_ + mt * 1024 + 32); \
                    hf[mt] = *(const u32x2*)((const bf16*)(ws + WS_HC) + ((size_t)((u64_ * 4 + vs) * 4 + mt) * 64 + lane) * 4); } } while (0)
#define SC_STEP(gf, hf, C) do { const size_t u64_ = (size_t)bh * 64 + (C); bf16* zs_ = (bf16*)(ws + WS_ZS) + ((size_t)((u64_ * 4 + vs) * 4) * 64 + lane) * 4; \
                _Pragma("unroll") for (int mt = 0; mt < 4; ++mt) { u32x2 zw_; zw_.x = pk2(z[mt][0], z[mt][1]); zw_.y = pk2(z[mt][2], z[mt][3]); *(u32x2*)(zs_ + mt * 256) = zw_; } \
                bf16x8 zb[2]; RW_ZB(z, zb); \
                _Pragma("unroll") for (int mt = 0; mt < 4; ++mt) { f32x4 a; a[0] = bflo(hf[mt].x); a[1] = bfhi(hf[mt].x); a[2] = bflo(hf[mt].y); a[3] = bfhi(hf[mt].y); \
                    a = __builtin_amdgcn_mfma_f32_16x16x32_bf16(gf[mt][0], zb[0], a, 0, 0, 0); a = __builtin_amdgcn_mfma_f32_16x16x32_bf16(gf[mt][1], zb[1], a, 0, 0, 0); z[mt] = a; } } while (0)
            SC_LOAD(gA, hA, 0); SC_LOAD(gB, hB, 1); SC_LOAD(gC, hC, 2);
#pragma unroll 1
            for (int C = 0; C < 64; C += 4) {
                SC_LOAD(gD, hD, C + 3);
                SC_STEP(gA, hA, C);
                if (C + 4 < 64) SC_LOAD(gA, hA, C + 4);
                SC_STEP(gB, hB, C + 1);
                if (C + 5 < 64) SC_LOAD(gB, hB, C + 5);
                SC_STEP(gC, hC, C + 2);
                if (C + 6 < 64) SC_LOAD(gC, hC, C + 6);
                SC_STEP(gD, hD, C + 3);
            }
#undef SC_LOAD
#undef SC_STEP
        }
    }
    SEAM(5);

    if (IN(6)) { PHASE_IDS;
        const int l15 = lane & 15, g = lane >> 4;
        for (int u64 = gw; u64 < NB * NH * (SEQ / 64); u64 += NGW) {
            const int bh = u64 >> 6, C = u64 & 63, b = bh >> 3, h = bh & 7;
            f32x4 z[4][4];
#pragma unroll
            for (int sl = 0; sl < 4; ++sl)
#pragma unroll
                for (int mt = 0; mt < 4; ++mt) { const u32x2 zw = *(const u32x2*)((const bf16*)(ws + WS_ZS) + ((size_t)((u64 * 4 + sl) * 4 + mt) * 64 + lane) * 4); z[sl][mt] = (f32x4){bflo(zw.x), bfhi(zw.x), bflo(zw.y), bfhi(zw.y)}; }
            float lg4[4];
#pragma unroll
            for (int sl = 0; sl < 4; ++sl) lg4[sl] = args.in[I_LNG][h * 64 + 16 * sl + l15];
#pragma unroll 1
            for (int j = 0; j < 4; ++j) {
                const size_t un = (size_t)u64 * 4 + j; const size_t m0 = (size_t)b * SEQ + (C * 4 + j) * 16;
                const bf16* rp = (const bf16*)(ws + WS_RP) + un * 1024 + l15 * 64 + 8 * g;
                const bf16x8 rf0 = *(const bf16x8*)rp, rf1 = *(const bf16x8*)(rp + 32);
                f32x4 y[4];
#pragma unroll
                for (int sl = 0; sl < 4; ++sl) { bf16x8 zb[2]; RW_ZB(z[sl], zb);
                    f32x4 a = *(const f32x4*)((const float*)(ws + WS_Y1F) + ((size_t)(un * 4 + sl) * 64 + lane) * 4);
                    a = __builtin_amdgcn_mfma_f32_16x16x32_bf16(rf0, zb[0], a, 0, 0, 0); a = __builtin_amdgcn_mfma_f32_16x16x32_bf16(rf1, zb[1], a, 0, 0, 0); y[sl] = a; }
#pragma unroll
                for (int e = 0; e < 4; ++e) {
                    float s1 = (y[0][e] + y[1][e]) + (y[2][e] + y[3][e]);
                    s1 += __shfl_xor(s1, 1); s1 += __shfl_xor(s1, 2); s1 += __shfl_xor(s1, 4); s1 += __shfl_xor(s1, 8);
                    const float mean = s1 * (1.0f / 64.0f);
                    float d0 = y[0][e] - mean, d1 = y[1][e] - mean, d2 = y[2][e] - mean, d3 = y[3][e] - mean;
                    float s2 = (d0 * d0 + d1 * d1) + (d2 * d2 + d3 * d3);
                    s2 += __shfl_xor(s2, 1); s2 += __shfl_xor(s2, 2); s2 += __shfl_xor(s2, 4); s2 += __shfl_xor(s2, 8);
                    const float rstd = 1.0f / sqrtf(s2 * (1.0f / 64.0f) + GN_EPS);
                    const size_t ro = (m0 + 4 * g + e) * 512 + h * 64 + l15;
                    const float dd[4] = {d0, d1, d2, d3};
#pragma unroll
                    for (int sl = 0; sl < 4; ++sl) { const float gg = bf2f(((const bf16*)(ws + WS_G))[ro + 16 * sl]), ad = bf2f(((const bf16*)(ws + WS_ADD))[ro + 16 * sl]);
                        const float o = dd[sl] * rstd * lg4[sl] * gg + ad;
                        CAT[(m0 + 4 * g + e) * 1024 + 512 + h * 64 + 16 * sl + l15] = (bf16)f2bf(o); }
                }
                if (j < 3) {
                    const bf16* gp = (const bf16*)(ws + WS_GP) + un * 4096 + l15 * 64 + 8 * g;
                    bf16x8 gf[4][2];
#pragma unroll
                    for (int mt = 0; mt < 4; ++mt) { gf[mt][0] = *(const bf16x8*)(gp + mt * 1024); gf[mt][1] = *(const bf16x8*)(gp + mt * 1024 + 32); }
#pragma unroll
                    for (int sl = 0; sl < 4; ++sl) { bf16x8 zb[2]; RW_ZB(z[sl], zb);
#pragma unroll
                        for (int mt = 0; mt < 4; ++mt) { const u32x2 hh = *(const u32x2*)((const bf16*)(ws + WS_HF) + ((size_t)((un * 4 + sl) * 4 + mt) * 64 + lane) * 4);
                            f32x4 a; a[0] = bflo(hh.x); a[1] = bfhi(hh.x); a[2] = bflo(hh.y); a[3] = bfhi(hh.y);
                            a = __builtin_amdgcn_mfma_f32_16x16x32_bf16(gf[mt][0], zb[0], a, 0, 0, 0); a = __builtin_amdgcn_mfma_f32_16x16x32_bf16(gf[mt][1], zb[1], a, 0, 0, 0); z[sl][mt] = a; } }
                }
            }
        }
    }
    SEAM(6);
#undef RW_ZB


    if (IN(7)) { PHASE_IDS;
        pg8::DenseSched S; S.o.init_tiles(M / 256, D / 256, G, bid); S.A = (const char*)CAT; S.B = (const char*)Wout_t; S.tstep = (size_t)256 * D * 2;
        EpiBf16Res<false> E{args.in[I_X], X1, D}; pg8::gemm_phase(lds, D, S, E);
    }
    SEAM(7);
    if (IN(8)) { PHASE_IDS; for (int m = gw; m < M; m += NGW) rms_rowbf_to_bf16(X1 + (size_t)m * D, args.in[I_NXAG], HN + (size_t)m * D, lane); }
    SEAM(8);
    if (IN(9)) { PHASE_IDS;
        pg8::DenseSched S; S.o.init_tiles(M / 256, D / 256, G, bid); S.A = (const char*)HN; S.B = (const char*)Wq_t; S.tstep = (size_t)256 * D * 2;
        EpiBf16Plain E{Qb, D, 0.0625f}; pg8::gemm_phase(lds, D, S, E);
    }
    SEAM(9);
    if (IN(10)) { PHASE_IDS;
        constexpr int KP = 264, VP = 72;
        LAS bf16* Kt = (LAS bf16*)lds;
        LAS bf16* Vt = (LAS bf16*)(lds + 64 * KP * 2);
        const int l15 = lane & 15, g4 = lane >> 4;
        const int bh = bid >> 4, b = bh >> 2, h = bh & 3;
        const int kkey = tid >> 3, kpart = tid & 7, vd = tid >> 1, vhalf = tid & 1;
        const bf16* kg = KM + (size_t)(b * MEML + kkey) * D + h * XHD + 32 * kpart;
        const bf16* vg = VT + (size_t)(h * XHD + vd) * MROWS + b * MEML + 32 * vhalf;
#pragma unroll 1
        for (int u = 0; u < 2; ++u) {
            const int q0 = ((bid & 15) * 2 + u) * 128 + wave * 16;
            const bf16* qbase = Qb + (size_t)(b * SEQ + q0 + l15) * D + h * XHD + 8 * g4;
            bf16x8 qf[8];
#pragma unroll
            for (int ks = 0; ks < 8; ++ks) qf[ks] = *(const bf16x8*)(qbase + 32 * ks);
            f32x4 oc[16];
#pragma unroll
            for (int dt = 0; dt < 16; ++dt) oc[dt] = (f32x4){0.f, 0.f, 0.f, 0.f};
            float mrun = -3.0e38f, lrun = 0.f;
            u32x4 kr[4], vr[4];
#pragma unroll
            for (int i = 0; i < 4; ++i) { kr[i] = *(const u32x4*)(kg + 8 * i); vr[i] = *(const u32x4*)(vg + 8 * i); }
#pragma unroll 1
            for (int kt = 0; kt < 4; ++kt) {
                __syncthreads();
#pragma unroll
                for (int i = 0; i < 4; ++i) { *(LAS u32x4*)(Kt + kkey * KP + 32 * kpart + 8 * i) = kr[i]; *(LAS u32x4*)(Vt + vd * VP + 32 * vhalf + 8 * i) = vr[i]; }
                if (kt < 3) {
#pragma unroll
                    for (int i = 0; i < 4; ++i) { kr[i] = *(const u32x4*)(kg + (size_t)(kt + 1) * 64 * D + 8 * i); vr[i] = *(const u32x4*)(vg + (kt + 1) * 64 + 8 * i); } }
                __syncthreads();
                f32x4 sc[4];
#pragma unroll
                for (int j = 0; j < 4; ++j) sc[j] = (f32x4){0.f, 0.f, 0.f, 0.f};
#pragma unroll
                for (int ks = 0; ks < 8; ++ks)
#pragma unroll
                    for (int j = 0; j < 4; ++j) { const bf16x8 kf = *(const LAS bf16x8*)(Kt + (16 * j + l15) * KP + 32 * ks + 8 * g4);
                        sc[j] = __builtin_amdgcn_mfma_f32_16x16x32_bf16(kf, qf[ks], sc[j], 0, 0, 0); }
                float mx = -3.0e38f;
#pragma unroll
                for (int j = 0; j < 4; ++j) mx = fmaxf(mx, fmaxf(fmaxf(sc[j][0], sc[j][1]), fmaxf(sc[j][2], sc[j][3])));
                mx = fmaxf(mx, __shfl_xor(mx, 16)); mx = fmaxf(mx, __shfl_xor(mx, 32));
                const float mnew = fmaxf(mrun, mx), alpha = __expf(mrun - mnew);
                mrun = mnew; lrun *= alpha;
#pragma unroll
                for (int j = 0; j < 4; ++j)
#pragma unroll
                    for (int e = 0; e < 4; ++e) { const float p = __expf(sc[j][e] - mnew); sc[j][e] = p; lrun += p; }
                bf16x8 pf[2];
#pragma unroll
                for (int s2 = 0; s2 < 2; ++s2) { u32x4 pw; pw.x = pk2(sc[2 * s2][0], sc[2 * s2][1]); pw.y = pk2(sc[2 * s2][2], sc[2 * s2][3]); pw.z = pk2(sc[2 * s2 + 1][0], sc[2 * s2 + 1][1]); pw.w = pk2(sc[2 * s2 + 1][2], sc[2 * s2 + 1][3]);
                    pf[s2] = __builtin_bit_cast(bf16x8, pw); }
#pragma unroll
                for (int dt = 0; dt < 16; ++dt) {
                    f32x4 o = oc[dt] * alpha;
#pragma unroll
                    for (int s2 = 0; s2 < 2; ++s2) { const LAS bf16* vp = Vt + (16 * dt + l15) * VP + 32 * s2 + 4 * g4;
                        const u32x2 v0 = *(const LAS u32x2*)vp, v1 = *(const LAS u32x2*)(vp + 16);
                        u32x4 vv; vv.x = v0.x; vv.y = v0.y; vv.z = v1.x; vv.w = v1.y;
                        o = __builtin_amdgcn_mfma_f32_16x16x32_bf16(__builtin_bit_cast(bf16x8, vv), pf[s2], o, 0, 0, 0); }
                    oc[dt] = o;
                }
            }
            lrun += __shfl_xor(lrun, 16); lrun += __shfl_xor(lrun, 32);
            const float inv = 1.0f / lrun;
            bf16* obase = Ob + (size_t)(b * SEQ + q0 + l15) * D + h * XHD + 4 * g4;
#pragma unroll
            for (int dt = 0; dt < 16; ++dt) { u32x2 w; w.x = pk2(oc[dt][0] * inv, oc[dt][1] * inv); w.y = pk2(oc[dt][2] * inv, oc[dt][3] * inv); *(u32x2*)(obase + 16 * dt) = w; }
        }
        __syncthreads();
    }
    SEAM(10);
    if (IN(11)) { PHASE_IDS;
        pg8::DenseSched S; S.o.init_tiles(M / 256, D / 256, G, bid); S.A = (const char*)Ob; S.B = (const char*)Wo_t; S.tstep = (size_t)256 * D * 2;
        EpiBf16Res<true> E{X1, X2, D}; pg8::gemm_phase(lds, D, S, E);
    }
    SEAM(11);
    if (IN(12)) { PHASE_IDS;
        LAS float* hs = (LAS float*)(lds + wave * 16384);
        const float* gfn = args.in[I_NFFG]; const float* wr_ = args.in[I_WR]; const float* br = args.in[I_BR];
        const int e = lane & 31, half = lane >> 5;
        for (int grp = gw; grp < M / 4; grp += NGW) {
            const int m0 = grp * 4;
#pragma unroll
            for (int rr = 0; rr < 4; ++rr) {
                const bf16* xrow = X2 + (size_t)(m0 + rr) * D;
                float v[16]; float s = 0.f;
#pragma unroll
                for (int hf = 0; hf < 2; ++hf) { const u32x4 w = *(const u32x4*)(xrow + 512 * hf + 8 * lane);
#pragma unroll
                    for (int q = 0; q < 4; ++q) { v[8 * hf + 2 * q] = bflo(w[q]); v[8 * hf + 2 * q + 1] = bfhi(w[q]); } }
#pragma unroll
                for (int j = 0; j < 16; ++j) s += v[j] * v[j];
                const float rstd = 1.0f / sqrtf(wave_sum(s) * (1.f / D) + EPS);
#pragma unroll
                for (int hf = 0; hf < 2; ++hf) { const f32x4 g0 = *(const f32x4*)(gfn + 512 * hf + 8 * lane), g1 = *(const f32x4*)(gfn + 512 * hf + 8 * lane + 4);
                    const f32x4 h0 = (f32x4){v[8 * hf] * rstd * g0.x, v[8 * hf + 1] * rstd * g0.y, v[8 * hf + 2] * rstd * g0.z, v[8 * hf + 3] * rstd * g0.w};
                    const f32x4 h1 = (f32x4){v[8 * hf + 4] * rstd * g1.x, v[8 * hf + 5] * rstd * g1.y, v[8 * hf + 6] * rstd * g1.z, v[8 * hf + 7] * rstd * g1.w};
                    *(LAS f32x4*)(hs + rr * 1024 + 512 * hf + 8 * lane) = h0; *(LAS f32x4*)(hs + rr * 1024 + 512 * hf + 8 * lane + 4) = h1;
                    u32x4 w; w.x = pk2(h0.x, h0.y); w.y = pk2(h0.z, h0.w); w.z = pk2(h1.x, h1.y); w.w = pk2(h1.z, h1.w);
                    *(u32x4*)(HN + (size_t)(m0 + rr) * D + 512 * hf + 8 * lane) = w; }
            }
            asm volatile("s_waitcnt lgkmcnt(0)" ::: "memory");
            float lg[4] = {0.f, 0.f, 0.f, 0.f};
#pragma unroll 4
            for (int d = half * 512; d < half * 512 + 512; d += 4) {
                const float w0 = wr_[(d + 0) * 32 + e], w1 = wr_[(d + 1) * 32 + e], w2 = wr_[(d + 2) * 32 + e], w3 = wr_[(d + 3) * 32 + e];
#pragma unroll
                for (int rr = 0; rr < 4; ++rr) { const f32x4 h4 = *(const LAS f32x4*)(hs + rr * 1024 + d); lg[rr] += (h4.x * w0 + h4.y * w1) + (h4.z * w2 + h4.w * w3); }
            }
            const float brv = br[e];
#pragma unroll
            for (int rr = 0; rr < 4; ++rr) {
                float v = lg[rr] + __shfl_xor(lg[rr], 32) + brv;
                float selv[4]; int sele[4];
#pragma unroll
                for (int k = 0; k < 4; ++k) {
                    float mv = v; int mi = e;
#pragma unroll
                    for (int o = 1; o < 32; o <<= 1) { const float ov = __shfl_xor(mv, o); const int oi = __shfl_xor(mi, o); if (ov > mv || (ov == mv && oi < mi)) { mv = ov; mi = oi; } }
                    selv[k] = mv; sele[k] = mi; if (e == mi) v = -3.0e38f;
                }
                const float e1 = __expf(selv[1] - selv[0]), e2 = __expf(selv[2] - selv[0]), e3 = __expf(selv[3] - selv[0]);
                const float inv = 1.0f / (1.0f + e1 + e2 + e3);
                if (lane < 4) {
                    const int me = lane == 0 ? sele[0] : lane == 1 ? sele[1] : lane == 2 ? sele[2] : sele[3];
                    const float mg = (lane == 0 ? 1.0f : lane == 1 ? e1 : lane == 2 ? e2 : e3) * inv;
                    const int pos = (int)atomicAdd(ecnt + me, 1u);
                    const int ai = (m0 + rr) * 4 + lane; route_e[ai] = me; route_pos[ai] = pos; route_g[ai] = mg;
                }
            }
        }
    }
    SEAM(12);
    if (IN(13)) { PHASE_IDS;
        LAS int* pst = (LAS int*)lds;
        if (tid == 0) { int acc = 0; for (int e = 0; e < NE; ++e) { const int c = (int)__hip_atomic_load(ecnt + e, __ATOMIC_RELAXED, __HIP_MEMORY_SCOPE_AGENT); pst[e] = acc; pst[64 + e] = c; acc += (c + 255) & ~255; } pst[32] = acc; }
        __syncthreads();
        for (int ai = bid * NTHREADS + tid; ai < NASSIGN; ai += G * NTHREADS) {
            const int e = route_e[ai]; const int row = pst[e] + route_pos[ai]; row_slot[row] = ai; row_gate[row] = route_g[ai]; row_tok[row] = ai >> 2; }
        if (bid < NE) { const int e = bid, c = pst[64 + e], pe = (c + 255) & ~255; for (int p = c + tid; p < pe; p += NTHREADS) { row_slot[pst[e] + p] = -1; row_gate[pst[e] + p] = 0.f; row_tok[pst[e] + p] = 0; } }
        if (bid == 0 && tid == 0) { int nt = 0; for (int e = 0; e < NE; ++e) { const int n = ((pst[64 + e] + 255) & ~255) >> 8; for (int j = 0; j < n; ++j) tile_tab[16 + nt++] = e; } tile_tab[0] = nt; }
        __syncthreads();
    }
    SEAM(13);
    if (IN(14)) { PHASE_IDS;
        const int ntiles = tile_tab[0];
        pg8::MoeGatherSched S; S.o.init_tiles(ntiles, 2048 / 256, G, bid); S.A = (const char*)HN; S.B = (const char*)Wgu_t; S.tile_e = tile_tab + 16; S.rtok = row_tok; S.tstep = (size_t)256 * D * 2; S.estep = (size_t)2048 * D * 2;
        EpiSwiglu E{ACT, args.in[I_BGU]}; pg8::gemm_phase(lds, D, S, E);
    }
    SEAM(14);
    if (IN(15)) { PHASE_IDS;
        const int ntiles = tile_tab[0];
        pg8::MoeSched S; S.o.init_tiles(ntiles, D / 256, G, bid); S.A = (const char*)ACT; S.B = (const char*)Wdn_t; S.tile_e = tile_tab + 16; S.tstep = (size_t)256 * DFF * 2; S.estep = (size_t)D * DFF * 2;
        EpiDown E{YS, args.in[I_BDN], row_slot, row_gate}; pg8::gemm_phase(lds, DFF, S, E);
    }
    SEAM(15);
    if (IN(16)) { PHASE_IDS;
        const float* gfin = args.in[I_FNG];
        for (int m = gw; m < M; m += NGW) {
            float v[16]; float s = 0.f;
#pragma unroll
            for (int hf = 0; hf < 2; ++hf) { const u32x4 w = *(const u32x4*)(X2 + (size_t)m * D + 512 * hf + 8 * lane);
#pragma unroll
                for (int q = 0; q < 4; ++q) { v[8 * hf + 2 * q] = bflo(w[q]); v[8 * hf + 2 * q + 1] = bfhi(w[q]); }
#pragma unroll
                for (int k = 0; k < 4; ++k) { const u32x4 y = *(const u32x4*)(YS + (size_t)(m * 4 + k) * D + 512 * hf + 8 * lane);
#pragma unroll
                    for (int q = 0; q < 4; ++q) { v[8 * hf + 2 * q] += bflo(y[q]); v[8 * hf + 2 * q + 1] += bfhi(y[q]); } } }
#pragma unroll
            for (int j = 0; j < 16; ++j) s += v[j] * v[j];
            const float rstd = 1.0f / sqrtf(wave_sum(s) * (1.f / D) + EPS);
#pragma unroll
            for (int hf = 0; hf < 2; ++hf) { const f32x4 g0 = *(const f32x4*)(gfin + 512 * hf + 8 * lane), g1 = *(const f32x4*)(gfin + 512 * hf + 8 * lane + 4);
                float* o = args.out + (size_t)m * D + 512 * hf + 8 * lane;
                *(f32x4*)o = (f32x4){v[8 * hf] * rstd * g0.x, v[8 * hf + 1] * rstd * g0.y, v[8 * hf + 2] * rstd * g0.z, v[8 * hf + 3] * rstd * g0.w};
                *(f32x4*)(o + 4) = (f32x4){v[8 * hf + 4] * rstd * g1.x, v[8 * hf + 5] * rstd * g1.y, v[8 * hf + 6] * rstd * g1.z, v[8 * hf + 7] * rstd * g1.w}; }
        }
    }
#undef IN
#undef SEAM
}

constexpr int N_PHASES = 17;
extern "C" void kernel_launch(void* const* d_in, const int* in_sizes, int n_in, void* d_out, int out_size, void* d_ws, size_t ws_size, hipStream_t stream) {
    static int grid = 0;
    if (grid == 0) {
        if (n_in != 37 || out_size != M * D || ws_size < WS_END) { fprintf(stderr, "kernel_launch: unexpected shapes (n_in %d, out %d, ws %zu); nothing launched\n", n_in, out_size, ws_size); grid = -1; return; }
        int dev = 0, cus = 0, per_cu = 0;
        if (hipGetDevice(&dev) != hipSuccess || hipDeviceGetAttribute(&cus, hipDeviceAttributeMultiprocessorCount, dev) != hipSuccess) { grid = -1; return; }
        if (hipFuncSetAttribute((const void*)fwd, hipFuncAttributeMaxDynamicSharedMemorySize, LDS_BYTES) != hipSuccess) { fprintf(stderr, "kernel_launch: hipFuncSetAttribute failed\n"); grid = -1; return; }
        if (hipOccupancyMaxActiveBlocksPerMultiprocessor(&per_cu, (const void*)fwd, NTHREADS, LDS_BYTES) != hipSuccess || per_cu < 1) fprintf(stderr, "kernel_launch: occupancy query says %d\n", per_cu);
        (void)hipGetLastError();
        grid = cus > 256 ? 256 : cus;
    }
    if (grid < 0) return;
    if (hipMemsetAsync((char*)d_ws + WS_CTL, 0, CTL_ZERO_BYTES, stream) != hipSuccess) return;
    Args a{};
    for (int i = 0; i < 37; ++i) a.in[i] = (const float*)d_in[i];
    a.out = (float*)d_out; a.ws = (unsigned char*)d_ws;
#if MK_ONE_LAUNCH
    a.ph_lo = 0; a.ph_hi = N_PHASES;
    hipLaunchKernelGGL(fwd, dim3(grid), dim3(NTHREADS), LDS_BYTES, stream, a);
#else
    for (int p = 0; p < N_PHASES; ++p) { a.ph_lo = p; a.ph_hi = p + 1; hipLaunchKernelGGL(fwd, dim3(grid), dim3(NTHREADS), LDS_BYTES, stream, a);
#ifdef PROBE_REPEAT_PHASE
        if (p == PROBE_REPEAT_PHASE) hipLaunchKernelGGL(fwd, dim3(grid), dim3(NTHREADS), LDS_BYTES, stream, a);
#endif
    }
#endif
}
```

```cpp
#include <hip/hip_runtime.h>
#include <cstdio>
#include <cstdint>

#ifndef MK_ONE_LAUNCH
#define MK_ONE_LAUNCH 1
#endif

#define DI __device__ __forceinline__
#define GAS __attribute__((address_space(1)))
#define LAS __attribute__((address_space(3)))
typedef unsigned short bf16;
typedef short bf16x8 __attribute__((ext_vector_type(8)));
typedef float f32x4 __attribute__((ext_vector_type(4)));
typedef float f32x2 __attribute__((ext_vector_type(2)));
typedef unsigned u32x4 __attribute__((ext_vector_type(4)));
typedef unsigned u32x2 __attribute__((ext_vector_type(2)));

constexpr int D = 1024, NB = 4, SEQ = 4096, M = NB * SEQ;
constexpr int MEML = 256, MROWS = NB * MEML;
constexpr int LRU_W = 512, RW = 512, NH = 8, HD = 64;
constexpr int INW = 2816;
constexpr int XH = 4, XHD = 256;
constexpr int NE = 32, TOPK = 4, DFF = 1024;
constexpr int NASSIGN = M * TOPK;
constexpr int MAXTILES = 288, MAXROWS = MAXTILES * 256;
constexpr float EPS = 1e-6f, GN_EPS = 64e-5f;

DI int fresh_tid() { int t = threadIdx.x; asm volatile("" : "+v"(t)); return t; }
namespace pg8 {
constexpr int BM = 256, BK = 64, HALF = 128, HTB = HALF * BK * 2, STAGE_BYTES = 8 * HTB, NXCD = 8, WGM = 8;
__host__ __device__ __forceinline__ int lds_byte(int r, int c) { const int st = (r >> 4) * 2 + (c >> 5), rr = r & 15, cc = c & 31, ob = rr * 64 + cc * 2; return st * 1024 + (ob ^ (((ob >> 9) & 1) << 5)); }
__host__ __device__ __forceinline__ void stage_rc(int b, int& R, int& C) { const int st = b / 1024, sb = b % 1024, swz = sb ^ (((sb >> 9) & 1) << 5); R = (st >> 1) * 16 + swz / 64; C = (st & 1) * 32 + (swz % 64) / 2; }
__host__ __device__ __forceinline__ int perm32(int rho) { const int n = rho >> 4, i = rho & 15; return 8 * (i >> 2) + 4 * n + (i & 3); }

struct Unit { int pm, pn, e; };

struct StaticOrder {
    int nM, nN, nwg, G, c;
    __host__ __device__ void init_tiles(int nM_, int nN_, int G_, int c_) { nM = nM_; nN = nN_; nwg = nM * nN; G = G_; c = c_; }
    __host__ __device__ bool next(int i, Unit& u) const {
        const long L = (long)i * G + c; if (L >= nwg) return false;
        int wgid = (int)L; { const int q = nwg / NXCD, r = nwg % NXCD, xcd = wgid % NXCD, off = wgid / NXCD; wgid = (xcd < r ? xcd * (q + 1) : r * (q + 1) + (xcd - r) * q) + off; }
        const int nig = WGM * nN, gid = wgid / nig, fm = gid * WGM, gsz = (nM - fm) < WGM ? (nM - fm) : WGM;
        u.pm = fm + ((wgid % nig) % gsz); u.pn = (wgid % nig) / gsz; u.e = 0; return true;
    }
};
struct DenseSched {
    static constexpr bool GATHER = false, B_TILED = false;
    StaticOrder o; const char* A; const char* B; size_t tstep;
    DI bool next(int i, Unit& u) const { return o.next(i, u); }
    DI const char* a_ptr(const Unit& u) const { return A + (size_t)u.pm * tstep; }
    DI const char* b_ptr(const Unit& u) const { return B + (size_t)u.pn * tstep; }
    DI void a_voff(const Unit&, int K, const int (&R)[2], const int (&C)[2], unsigned (&vo)[2][2]) const {
#pragma unroll
        for (int h = 0; h < 2; ++h)
#pragma unroll
            for (int i = 0; i < 2; ++i) vo[h][i] = (unsigned)((h * HALF + R[i]) * K + C[i]) * 2u; }
};
struct MoeSched {
    static constexpr bool GATHER = false, B_TILED = true;
    StaticOrder o; const char* A; const char* B; const int* tile_e; size_t tstep, estep;
    DI bool next(int i, Unit& u) const { if (!o.next(i, u)) return false; u.e = tile_e[u.pm]; return true; }
    DI const char* a_ptr(const Unit& u) const { return A + (size_t)u.pm * tstep; }
    DI const char* b_ptr(const Unit& u) const { return B + (size_t)u.e * estep + (size_t)u.pn * tstep; }
    DI void a_voff(const Unit&, int K, const int (&R)[2], const int (&C)[2], unsigned (&vo)[2][2]) const {
#pragma unroll
        for (int h = 0; h < 2; ++h)
#pragma unroll
            for (int i = 0; i < 2; ++i) vo[h][i] = (unsigned)((h * HALF + R[i]) * K + C[i]) * 2u; }
};
struct MoeGatherSched {
    static constexpr bool GATHER = true, B_TILED = true;
    StaticOrder o; const char* A; const char* B; const int* tile_e; const int* rtok; size_t tstep, estep;
    DI bool next(int i, Unit& u) const { if (!o.next(i, u)) return false; u.e = tile_e[u.pm]; return true; }
    DI const char* a_ptr(const Unit&) const { return A; }
    DI const char* b_ptr(const Unit& u) const { return B + (size_t)u.e * estep + (size_t)u.pn * tstep; }
    DI void a_voff(const Unit& u, int K, const int (&R)[2], const int (&C)[2], unsigned (&vo)[2][2]) const {
#pragma unroll
        for (int h = 0; h < 2; ++h)
#pragma unroll
            for (int i = 0; i < 2; ++i) vo[h][i] = (unsigned)(rtok[u.pm * BM + h * HALF + R[i]] * K + C[i]) * 2u; }
};

DI unsigned cvt_pk_bf16(float lo, float hi) { unsigned r; asm volatile("v_cvt_pk_bf16_f32 %0, %1, %2" : "=v"(r) : "v"(lo), "v"(hi)); return r; }

template <class Epi, class Sched, bool ALIGN_EPI = true>
DI void gemm_phase(LAS unsigned char* lds, const int K, const Sched& S, const Epi& E) {
    const int tid = fresh_tid(), wid = __builtin_amdgcn_readfirstlane(tid >> 6), lane = tid & 63, wr = wid >> 2, wc = wid & 3, fr = lane & 15, fq = lane >> 4;
    const int nt = K / BK;
    constexpr bool GA = Sched::GATHER, BT = Sched::B_TILED;
    unsigned voffA[2][2], voffAn[2][2], voffB[2]; int sR[2], sC[2];
#pragma unroll
    for (int i = 0; i < 2; ++i) { int R, C; stage_rc(tid * 16 + i * 8192, R, C); const int Rb = Epi::PERM ? ((R & ~31) + perm32(R & 31)) : R;
        sR[i] = R; sC[i] = C; voffB[i] = BT ? (unsigned)(tid * 16 + i * 8192) : (unsigned)(Rb * K + C) * 2u; }
    const size_t kstep = (size_t)(BK * 2);
    const size_t hstep = (size_t)HALF * K * 2;
    const size_t kstepB = BT ? (size_t)(2 * HTB) : kstep, hstepB = BT ? (size_t)HTB : hstep;
    const unsigned ldsw = (unsigned)wid * 1024u;
    const int aoff = lds_byte(wr * 64 + fr, fq * 8), boff = lds_byte(wc * 32 + fr, fq * 8);
#define PG8_SA(b, h) (((b) * 2 + (h)) * HTB)
#define PG8_SB(b, h) ((4 + (b) * 2 + (h)) * HTB)
#define PG8_STAGE(bufoff, gbase, voff) do { _Pragma("unroll") for (int _i = 0; _i < 2; ++_i) \
        __builtin_amdgcn_global_load_lds((const unsigned*)((const char*)(gbase) + (voff)[_i]), (LAS unsigned*)(lds + (bufoff) + ldsw + _i * 8192), 16, 0, 0); } while (0)
#define PG8_LDA(dst, b, h) do { _Pragma("unroll") for (int m = 0; m < 4; ++m) _Pragma("unroll") for (int k = 0; k < 2; ++k) dst[m][k] = *(const LAS bf16x8*)(lds + PG8_SA(b, h) + aoff + m * 2048 + k * 1024); } while (0)
#define PG8_LDB(dst, b, h) do { _Pragma("unroll") for (int n = 0; n < 2; ++n) _Pragma("unroll") for (int k = 0; k < 2; ++k) dst[n][k] = *(const LAS bf16x8*)(lds + PG8_SB(b, h) + boff + n * 2048 + k * 1024); } while (0)
#define PG8_MMA(ai, bj, At, Bt) do { __builtin_amdgcn_s_setprio(1); _Pragma("unroll") for (int m = 0; m < 4; ++m) _Pragma("unroll") for (int n = 0; n < 2; ++n) _Pragma("unroll") for (int k = 0; k < 2; ++k) \
        acc[ai][bj][m][n] = __builtin_amdgcn_mfma_f32_16x16x32_bf16(Bt[n][k], At[m][k], acc[ai][bj][m][n], 0, 0, 0); __builtin_amdgcn_s_setprio(0); } while (0)
#define PG8_WAIT_V(n) asm volatile("s_waitcnt vmcnt(" #n ")" ::: "memory")
#define PG8_WAIT_L(n) asm volatile("s_waitcnt lgkmcnt(" #n ")" ::: "memory")
#define PG8_BAR __builtin_amdgcn_s_barrier()
#define PG8_SCHED __builtin_amdgcn_sched_barrier(0)
    Unit cur, nxt; int ui = 0;
    if (!S.next(0, cur)) return;
    f32x4 acc[2][2][4][2];
#pragma unroll
    for (int a = 0; a < 2; ++a)
#pragma unroll
        for (int b = 0; b < 2; ++b)
#pragma unroll
            for (int m = 0; m < 4; ++m)
#pragma unroll
                for (int n = 0; n < 2; ++n) acc[a][b][m][n] = (f32x4){0.f, 0.f, 0.f, 0.f};
    bf16x8 At[4][2], B0[2][2], B1[2][2];
    const char* cA = S.a_ptr(cur); const char* cB = S.b_ptr(cur);
    S.a_voff(cur, K, sR, sC, voffA);
#define PG8_STAGE_A(bufoff, kbase, h, vo) do { if constexpr (GA) { PG8_STAGE(bufoff, kbase, (vo)[h]); } else { PG8_STAGE(bufoff, (kbase) + (h) * hstep, voffA[0]); } } while (0)
    PG8_STAGE(PG8_SB(0, 0), cB, voffB); PG8_STAGE(PG8_SB(0, 1), cB + hstepB, voffB); PG8_STAGE_A(PG8_SA(0, 0), cA, 0, voffA); PG8_STAGE_A(PG8_SA(0, 1), cA, 1, voffA);
    if (wr == 1) PG8_BAR;
    PG8_WAIT_V(2); PG8_BAR;
    PG8_STAGE(PG8_SB(1, 0), cB + kstepB, voffB); PG8_STAGE_A(PG8_SA(1, 0), cA + kstep, 0, voffA); PG8_STAGE(PG8_SB(1, 1), cB + hstepB + kstepB, voffB);
    PG8_WAIT_V(6); PG8_BAR;
    for (;;) {
        const bool has_next = S.next(ui + 1, nxt);
        const char* nA = has_next ? S.a_ptr(nxt) : cA; const char* nB = has_next ? S.b_ptr(nxt) : cB;
        if constexpr (GA) { if (has_next) S.a_voff(nxt, K, sR, sC, voffAn);
            else {
#pragma unroll
                for (int h = 0; h < 2; ++h)
#pragma unroll
                    for (int i = 0; i < 2; ++i) voffAn[h][i] = voffA[h][i]; } }
        for (int t = 0; t < nt; t += 2) {
            const bool last = (t == nt - 2);
            const char* a1 = cA + (size_t)(t + 1) * kstep;
            const char* a2 = last ? nA : cA + (size_t)(t + 2) * kstep; const char* b2 = last ? nB : cB + (size_t)(t + 2) * kstepB;
            const char* a3 = a2 + kstep; const char* b3 = b2 + kstepB;
            unsigned vs[2][2];
            if constexpr (GA) {
#pragma unroll
                for (int i = 0; i < 2; ++i) { vs[0][i] = last ? voffAn[0][i] : voffA[0][i]; vs[1][i] = last ? voffAn[1][i] : voffA[1][i]; } }
            PG8_LDB(B0, 0, 0); PG8_LDB(B1, 0, 1); PG8_SCHED; PG8_LDA(At, 0, 0); PG8_STAGE_A(PG8_SA(1, 1), a1, 1, voffA);
            PG8_WAIT_V(8); PG8_WAIT_L(0); PG8_BAR; PG8_MMA(0, 0, At, B0); PG8_MMA(0, 1, At, B1); PG8_BAR; PG8_SCHED;
            PG8_LDA(At, 0, 1); PG8_STAGE(PG8_SB(0, 0), b2, voffB); PG8_STAGE(PG8_SB(0, 1), b2 + hstepB, voffB); PG8_STAGE_A(PG8_SA(0, 0), a2, 0, vs);
            PG8_WAIT_V(8); PG8_WAIT_L(0); PG8_BAR; PG8_MMA(1, 0, At, B0); PG8_MMA(1, 1, At, B1); PG8_BAR; PG8_SCHED;
            PG8_LDB(B0, 1, 0); PG8_LDB(B1, 1, 1); PG8_SCHED; PG8_LDA(At, 1, 0); PG8_STAGE_A(PG8_SA(0, 1), a2, 1, vs);
            PG8_WAIT_V(8); PG8_WAIT_L(0); PG8_BAR; PG8_MMA(0, 0, At, B0); PG8_MMA(0, 1, At, B1); PG8_BAR; PG8_SCHED;
            PG8_LDA(At, 1, 1); PG8_STAGE(PG8_SB(1, 0), b3, voffB); PG8_STAGE(PG8_SB(1, 1), b3 + hstepB, voffB); PG8_STAGE_A(PG8_SA(1, 0), a3, 0, vs);
            PG8_WAIT_V(8); PG8_WAIT_L(0); PG8_BAR; PG8_MMA(1, 0, At, B0); PG8_MMA(1, 1, At, B1); PG8_BAR; PG8_SCHED;
        }
        if constexpr (ALIGN_EPI) { if (wr == 0) PG8_BAR; }
        E(acc, cur, wr, wc, fr, fq);
        if (!has_next) break;
#pragma unroll
        for (int a = 0; a < 2; ++a)
#pragma unroll
            for (int b = 0; b < 2; ++b)
#pragma unroll
                for (int m = 0; m < 4; ++m)
#pragma unroll
                    for (int n = 0; n < 2; ++n) acc[a][b][m][n] = (f32x4){0.f, 0.f, 0.f, 0.f};
        cur = nxt; cA = nA; cB = nB; ++ui;
        if constexpr (GA) {
#pragma unroll
            for (int h = 0; h < 2; ++h)
#pragma unroll
                for (int i = 0; i < 2; ++i) voffA[h][i] = voffAn[h][i]; }
        if constexpr (ALIGN_EPI) { if (wr == 1) PG8_BAR; }
    }
    PG8_WAIT_V(0);
    if constexpr (!ALIGN_EPI) { if (wr == 0) PG8_BAR; }
    PG8_BAR;
#undef PG8_SA
#undef PG8_SB
#undef PG8_STAGE
#undef PG8_STAGE_A
#undef PG8_LDA
#undef PG8_LDB
#undef PG8_MMA
#undef PG8_WAIT_V
#undef PG8_WAIT_L
#undef PG8_BAR
#undef PG8_SCHED
}
}
using pg8::Unit;
using pg8::cvt_pk_bf16;

DI float bflo(unsigned w) { return __uint_as_float(w << 16); }
DI float bfhi(unsigned w) { return __uint_as_float(w & 0xffff0000u); }
DI float bf2f(bf16 b) { return __uint_as_float(((unsigned)b) << 16); }
DI unsigned f2bf(float f) { unsigned u = __float_as_uint(f); return (u + 0x7fffu + ((u >> 16) & 1u)) >> 16; }
DI unsigned pk2(float lo, float hi) { return f2bf(lo) | (f2bf(hi) << 16); }
DI float rcp_f(float x) { return __builtin_amdgcn_rcpf(x); }
DI float rsq_f(float x) { return __builtin_amdgcn_rsqf(x); }
DI float sigmoid_f(float x) { return rcp_f(1.0f + __expf(-x)); }
DI float tanh_fast(float x) { return 1.0f - 2.0f * rcp_f(__expf(2.0f * x) + 1.0f); }
DI float softplus_f(float x) { return fmaxf(x, 0.f) + __logf(1.0f + __expf(-fabsf(x))); }
DI float softplus_fast(float x) { return fmaxf(x, 0.f) + __logf(1.0f + __expf(-fabsf(x))); }
DI float gelu_tanh_f(float x) { const float u = 0.7978845608028654f * (x + 0.044715f * x * x * x); return 0.5f * x * (1.0f + tanh_fast(u)); }
DI float wave_sum(float v) {
#pragma unroll
    for (int o = 1; o < 64; o <<= 1) v += __shfl_xor(v, o);
    return v;
}

struct EpiBf16Plain {
    static constexpr bool PERM = true;
    bf16* O; int ldc; float scale;
    DI void operator()(const f32x4 (&acc)[2][2][4][2], const Unit& u, int wr, int wc, int fr, int fq) const {
        const int row0 = u.pm * 256 + wr * 64 + fr, col0 = u.pn * 256 + wc * 32 + 8 * fq;
#pragma unroll
        for (int ai = 0; ai < 2; ++ai)
#pragma unroll
            for (int m = 0; m < 4; ++m) { bf16* rowp = O + (size_t)(row0 + ai * 128 + m * 16) * ldc + col0;
#pragma unroll
                for (int bj = 0; bj < 2; ++bj) { const f32x4 v0 = acc[ai][bj][m][0] * scale, v1 = acc[ai][bj][m][1] * scale;
                    u32x4 w; w.x = cvt_pk_bf16(v0[0], v0[1]); w.y = cvt_pk_bf16(v0[2], v0[3]); w.z = cvt_pk_bf16(v1[0], v1[1]); w.w = cvt_pk_bf16(v1[2], v1[3]);
                    *(u32x4*)(rowp + bj * 128) = w; } }
    }
};
template <bool RES_BF16> struct EpiBf16Res {
    static constexpr bool PERM = true;
    const void* Rz; bf16* O; int ldc;
    DI void operator()(const f32x4 (&acc)[2][2][4][2], const Unit& u, int wr, int wc, int fr, int fq) const {
        const int row0 = u.pm * 256 + wr * 64 + fr, col0 = u.pn * 256 + wc * 32 + 8 * fq;
#pragma unroll
        for (int ai = 0; ai < 2; ++ai)
#pragma unroll
            for (int m = 0; m < 4; ++m) { const size_t off = (size_t)(row0 + ai * 128 + m * 16) * ldc + col0;
#pragma unroll
                for (int bj = 0; bj < 2; ++bj) { f32x4 r0, r1;
                    if (RES_BF16) { const u32x4 rw = *(const u32x4*)((const bf16*)Rz + off + bj * 128); r0 = (f32x4){bflo(rw.x), bfhi(rw.x), bflo(rw.y), bfhi(rw.y)}; r1 = (f32x4){bflo(rw.z), bfhi(rw.z), bflo(rw.w), bfhi(rw.w)}; }
                    else { r0 = *(const f32x4*)((const float*)Rz + off + bj * 128); r1 = *(const f32x4*)((const float*)Rz + off + bj * 128 + 4); }
                    const f32x4 v0 = r0 + acc[ai][bj][m][0], v1 = r1 + acc[ai][bj][m][1];
                    u32x4 w; w.x = cvt_pk_bf16(v0[0], v0[1]); w.y = cvt_pk_bf16(v0[2], v0[3]); w.z = cvt_pk_bf16(v1[0], v1[1]); w.w = cvt_pk_bf16(v1[2], v1[3]);
                    *(u32x4*)(O + off + bj * 128) = w; } }
    }
};
struct EpiLora {
    static constexpr bool PERM = false;
    float* LWp; bf16* AAp; bf16* GGp; const float* w0; const float* a0;
    DI void operator()(const f32x4 (&acc)[2][2][4][2], const Unit& u, int wr, int wc, int fr, int fq) const {
        const int kind = u.pn >> 1;
        const int row0 = u.pm * 256 + wr * 64 + fr, col0 = (u.pn & 1) * 256 + wc * 32 + 4 * fq;
#pragma unroll
        for (int bj = 0; bj < 2; ++bj)
#pragma unroll
            for (int n = 0; n < 2; ++n) {
                const int c = col0 + bj * 128 + n * 16;
                f32x4 bias = (f32x4){0.f, 0.f, 0.f, 0.f};
                if (kind == 0) bias = *(const f32x4*)(w0 + c); else if (kind == 1) bias = *(const f32x4*)(a0 + c);
#pragma unroll
                for (int ai = 0; ai < 2; ++ai)
#pragma unroll
                    for (int m = 0; m < 4; ++m) {
                        f32x4 v = acc[ai][bj][m][n] + bias;
                        if (kind == 0) {
#pragma unroll
                            for (int j = 0; j < 4; ++j) { const float w = -softplus_fast(-v[j]) - 0.5f; v[j] = -__expf(w);     }
                        } else if (kind == 1) {
#pragma unroll
                            for (int j = 0; j < 4; ++j) v[j] = sigmoid_f(v[j]);
                        }
                        const size_t o_ = (size_t)(row0 + ai * 128 + m * 16) * 512 + c;
                        if (kind == 0) *(f32x4*)(LWp + o_) = v;
                        else { u32x2 w_; w_.x = cvt_pk_bf16(v[0], v[1]); w_.y = cvt_pk_bf16(v[2], v[3]); *(u32x2*)((kind == 1 ? AAp : GGp) + o_) = w_; }
                    }
            }
    }
};
struct EpiSwiglu {
    static constexpr bool PERM = true;
    bf16* ACT; const float* b_gu;
    DI void operator()(const f32x4 (&acc)[2][2][4][2], const Unit& u, int wr, int wc, int fr, int fq) const {
        const int row0 = u.pm * 256 + wr * 64 + fr, j0 = u.pn * 128 + wc * 32 + 8 * fq;
        const float* bg = b_gu + (size_t)u.e * 2048 + j0; const float* bu = bg + 1024;
        const f32x4 bg0 = *(const f32x4*)bg, bg1 = *(const f32x4*)(bg + 4), bu0 = *(const f32x4*)bu, bu1 = *(const f32x4*)(bu + 4);
#pragma unroll
        for (int ai = 0; ai < 2; ++ai)
#pragma unroll
            for (int m = 0; m < 4; ++m) {
                float o[8];
#pragma unroll
                for (int n = 0; n < 2; ++n) { const f32x4 g4 = acc[ai][0][m][n] + (n ? bg1 : bg0), u4 = acc[ai][1][m][n] + (n ? bu1 : bu0);
#pragma unroll
                    for (int j = 0; j < 4; ++j) { const float g = fminf(g4[j], 7.0f), up = fminf(fmaxf(u4[j], -7.0f), 7.0f); o[n * 4 + j] = (up + 1.0f) * (g * sigmoid_f(1.702f * g)); } }
                u32x4 w; w.x = cvt_pk_bf16(o[0], o[1]); w.y = cvt_pk_bf16(o[2], o[3]); w.z = cvt_pk_bf16(o[4], o[5]); w.w = cvt_pk_bf16(o[6], o[7]);
                *(u32x4*)(ACT + (size_t)(row0 + ai * 128 + m * 16) * 1024 + j0) = w;
            }
    }
};
struct EpiDown {
    static constexpr bool PERM = true;
    bf16* YS; const float* b_dn; const int* row_slot; const float* row_gate;
    DI void operator()(const f32x4 (&acc)[2][2][4][2], const Unit& u, int wr, int wc, int fr, int fq) const {
        const int row0 = u.pm * 256 + wr * 64 + fr, col0 = u.pn * 256 + wc * 32 + 8 * fq;
        const float* bb = b_dn + (size_t)u.e * 1024 + col0;
        f32x4 bv[2][2];
#pragma unroll
        for (int bj = 0; bj < 2; ++bj)
#pragma unroll
            for (int n = 0; n < 2; ++n) bv[bj][n] = *(const f32x4*)(bb + bj * 128 + 4 * n);
#pragma unroll
        for (int ai = 0; ai < 2; ++ai)
#pragma unroll
            for (int m = 0; m < 4; ++m) {
                const int r = row0 + ai * 128 + m * 16; const int slot = row_slot[r]; const float gt = row_gate[r];
                if (slot >= 0) { bf16* rowp = YS + (size_t)slot * 1024 + col0;
#pragma unroll
                    for (int bj = 0; bj < 2; ++bj) { const f32x4 v0 = (acc[ai][bj][m][0] + bv[bj][0]) * gt, v1 = (acc[ai][bj][m][1] + bv[bj][1]) * gt;
                        u32x4 w; w.x = cvt_pk_bf16(v0[0], v0[1]); w.y = cvt_pk_bf16(v0[2], v0[3]); w.z = cvt_pk_bf16(v1[0], v1[1]); w.w = cvt_pk_bf16(v1[2], v1[3]);
                        *(u32x4*)(rowp + bj * 128) = w; } }
            }
    }
};

constexpr size_t MiB = 1u << 20;
constexpr size_t WS_CTL = 0, CTL_ZERO_BYTES = 1 * MiB;
constexpr size_t WS_WIN = 1 * MiB, WS_WOUT = 7 * MiB, WS_WQ = 9 * MiB, WS_WK = 11 * MiB, WS_WV = 13 * MiB, WS_WO = 15 * MiB, WS_LORAB = 17 * MiB, WS_LRUW = 18 * MiB;
constexpr size_t WS_ROUTE = 19 * MiB;
constexpr size_t WS_WGU = 22 * MiB, WS_WDN = 150 * MiB;
constexpr size_t WS_HN = 214 * MiB, WS_MEMN = 246 * MiB, WS_KM = 248 * MiB, WS_VT = 250 * MiB;
constexpr size_t WS_X1 = 252 * MiB, WS_X2 = 316 * MiB;
constexpr size_t WS_U = 380 * MiB, WS_R = 468 * MiB, WS_KRAW = 500 * MiB, WS_V = 532 * MiB, WS_KKN = 564 * MiB, WS_WD = 596 * MiB, WS_AA = 628 * MiB, WS_G = 660 * MiB;
constexpr size_t WS_LA = 692 * MiB, WS_LB = 724 * MiB, WS_AP = 756 * MiB, WS_CAT = 764 * MiB, WS_Q = 796 * MiB;
constexpr size_t WS_XS = 380 * MiB, WS_ACT = 524 * MiB, WS_YS = 668 * MiB;
constexpr size_t WS_GP = 796 * MiB, WS_HF = 860 * MiB, WS_RP = 924 * MiB, WS_Y1F = 940 * MiB, WS_ADD = 972 * MiB, WS_END = 1004 * MiB;
constexpr size_t WS_GC = 468 * MiB, WS_HC = 484 * MiB, WS_ZS = 500 * MiB;
static_assert(WS_AA == WS_WD + 32 * MiB && WS_G == WS_AA + 32 * MiB, "EpiLora strides");
static_assert(WS_U + (size_t)M * INW * 2 <= WS_R && WS_XS + (size_t)MAXROWS * 2048 <= WS_ACT && WS_ACT + (size_t)MAXROWS * 2048 <= WS_YS && WS_YS + (size_t)NASSIGN * 2048 <= WS_Q, "ws map");
constexpr size_t RT_E = 0, RT_POS = 256 * 1024, RT_G = 512 * 1024, RT_SLOT = 768 * 1024, RT_GATE = 1088 * 1024, RT_TILE = 1408 * 1024, RT_TOK = 1472 * 1024;
constexpr int CW_BAR = 4096, CW_CNT = 8192;

constexpr int RING_BYTES = 131072, MISC_OFF = RING_BYTES + 320, LDS_BYTES = 147456;
constexpr int NWAVES = 8, NTHREADS = 512;

#define XB_TMO      128
#define XB_XCNT(j)  (256  + 64 * (j))
#define XB_XSUB(j)  (1280 + 64 * (j))
#define XB_XGEN(j)  (2304 + 64 * (j))
#define XB_TOP      3328
#define XB_TOPGEN   3392
#define XCD_BAR_WORDS 3456
#define XB_SPIN_CAP (1u << 18)
DI unsigned xb_ld(unsigned* p)              { return __hip_atomic_load(p, __ATOMIC_RELAXED, __HIP_MEMORY_SCOPE_AGENT); }
DI unsigned xb_add(unsigned* p, unsigned v) { return __hip_atomic_fetch_add(p, v, __ATOMIC_RELAXED, __HIP_MEMORY_SCOPE_AGENT); }
DI unsigned xb_xcc_id() { return (unsigned)__builtin_amdgcn_s_getreg((3 << 11) | 20) & 0xFu; }
#define XB_SPIN(cond, bar) do { unsigned _sp = 0; while (cond) { __builtin_amdgcn_s_sleep(1); \
    if ((++_sp & 255u) == 0u) { if (xb_ld(&(bar)[XB_TMO])) break; if (_sp > XB_SPIN_CAP) { atomicAdd(&(bar)[XB_TMO], 1u); break; } } } } while (0)
struct XcdBarrier { unsigned* bar; unsigned x; volatile LAS unsigned* st; };
DI XcdBarrier xcd_barrier_post(unsigned* bar, volatile LAS unsigned* st) {
    XcdBarrier b; b.bar = bar; b.x = xb_xcc_id(); b.st = st;
    if (threadIdx.x == 0) (void)xb_add(&bar[XB_XCNT(b.x)], 1u);
    return b;
}
DI void xcd_barrier_complete(unsigned* bar, unsigned x, unsigned& nloc, unsigned& nx) {
    const unsigned G = gridDim.x * gridDim.y * gridDim.z;
    unsigned sum, cnt, mine, sp = 0u;
    for (;;) {
        sum = 0u; cnt = 0u; mine = 0u;
#pragma unroll
        for (unsigned j = 0; j < 16; ++j) { const unsigned c = xb_ld(&bar[XB_XCNT(j)]); sum += c; cnt += (c > 0u) ? 1u : 0u; mine = (j == x) ? c : mine; }
        if (sum == G) break;
        __builtin_amdgcn_s_sleep(1);
        if ((++sp & 255u) == 0u) { if (xb_ld(&bar[XB_TMO])) break; if (sp > XB_SPIN_CAP) { atomicAdd(&bar[XB_TMO], 1u); break; } }
    }
    nloc = mine > 0u ? mine : 1u; nx = cnt > 0u ? cnt : 1u;
}
DI void xcd_barrier(const XcdBarrier& b) {
    asm volatile("s_waitcnt vmcnt(0)" ::: "memory");
    __syncthreads();
    if (threadIdx.x == 0) {
        unsigned* bar = b.bar;
        __builtin_amdgcn_s_waitcnt(0);
        unsigned nloc = b.st[0], nx = b.st[1];
        if (nloc == 0u) { xcd_barrier_complete(bar, b.x, nloc, nx); b.st[0] = nloc; b.st[1] = nx; }
        const unsigned old = xb_add(&bar[XB_XSUB(b.x)], 1u);
        const unsigned gen = old / nloc;
        if (old + 1u == (gen + 1u) * nloc) {
            __builtin_amdgcn_fence(__ATOMIC_RELEASE, "agent");
            asm volatile("s_waitcnt vmcnt(0)" ::: "memory");
            const unsigned og = xb_add(&bar[XB_TOP], 1u);
            const unsigned tg = og / nx;
            if (og + 1u == (tg + 1u) * nx) xb_add(&bar[XB_TOPGEN], 1u);
            else XB_SPIN(xb_ld(&bar[XB_TOPGEN]) == tg, bar);
            __builtin_amdgcn_fence(__ATOMIC_ACQUIRE, "agent");
            xb_add(&bar[XB_XGEN(b.x)], 1u);
            asm volatile("s_waitcnt vmcnt(0)" ::: "memory");
        } else {
            XB_SPIN(xb_ld(&bar[XB_XGEN(b.x)]) == gen, bar);
            __builtin_amdgcn_fence(__ATOMIC_ACQUIRE, "agent");
            asm volatile("s_waitcnt vmcnt(0)" ::: "memory");
        }
    }
    __syncthreads();
}

struct Args { const float* in[37]; float* out; unsigned char* ws; int ph_lo, ph_hi; };
enum { I_X = 0, I_MEM, I_NMIXG, I_WIN, I_CONVW, I_CONVB, I_LWX, I_LBX, I_LWA, I_LBA, I_LAM, I_MU, I_W0, I_WUP, I_A0, I_AUP, I_GUP, I_KK, I_KA, I_RK, I_LNG, I_LNB,
       I_WOUT, I_NXAG, I_NMEMG, I_WQ, I_WK, I_WV, I_WO, I_NFFG, I_WR, I_BR, I_WGU, I_BGU, I_WDN, I_BDN, I_FNG };

DI void transpose_item(const float* W, int ldw, int K, bf16* WT, int k0, int n0, int drow0, LAS float* scr, int lane) {
    f32x4 t[8];
    const float* src = W + (size_t)(k0 + (lane >> 3)) * ldw + n0 + 4 * (lane & 7);
#pragma unroll
    for (int i = 0; i < 8; ++i) t[i] = *(const f32x4*)(src + (size_t)(8 * i) * ldw);
#pragma unroll
    for (int i = 0; i < 8; ++i) { LAS float* d = scr + (8 * i + (lane >> 3)) * 33 + 4 * (lane & 7); d[0] = t[i].x; d[1] = t[i].y; d[2] = t[i].z; d[3] = t[i].w; }
    asm volatile("s_waitcnt lgkmcnt(0)" ::: "memory");
    const int c = lane & 7;
#pragma unroll
    for (int j = 0; j < 4; ++j) { const int n = (lane >> 3) + 8 * j; const LAS float* s = scr + (8 * c) * 33 + n;
        u32x4 o; o.x = pk2(s[0 * 33], s[1 * 33]); o.y = pk2(s[2 * 33], s[3 * 33]); o.z = pk2(s[4 * 33], s[5 * 33]); o.w = pk2(s[6 * 33], s[7 * 33]);
        *(u32x4*)(WT + (size_t)(drow0 + n) * K + k0 + 8 * c) = o; }
    asm volatile("s_waitcnt lgkmcnt(0)" ::: "memory");
}
DI void transpose_item_tiled(const float* W, int ldw, int K, bf16* WTe, int k0, int n0, int drow0, LAS float* scr, int lane) {
    f32x4 t[8];
    const float* src = W + (size_t)(k0 + (lane >> 3)) * ldw + n0 + 4 * (lane & 7);
#pragma unroll
    for (int i = 0; i < 8; ++i) t[i] = *(const f32x4*)(src + (size_t)(8 * i) * ldw);
#pragma unroll
    for (int i = 0; i < 8; ++i) { LAS float* d = scr + (8 * i + (lane >> 3)) * 33 + 4 * (lane & 7); d[0] = t[i].x; d[1] = t[i].y; d[2] = t[i].z; d[3] = t[i].w; }
    asm volatile("s_waitcnt lgkmcnt(0)" ::: "memory");
    const int c = lane & 7;
#pragma unroll
    for (int j = 0; j < 4; ++j) { const int n = (lane >> 3) + 8 * j; const LAS float* s = scr + (8 * c) * 33 + n;
        u32x4 o; o.x = pk2(s[0 * 33], s[1 * 33]); o.y = pk2(s[2 * 33], s[3 * 33]); o.z = pk2(s[4 * 33], s[5 * 33]); o.w = pk2(s[6 * 33], s[7 * 33]);
        const int drow = drow0 + n, pn = drow >> 8, half = (drow >> 7) & 1, r = drow & 127, x = r & 31;
        const int rslot = (r & ~31) + 16 * ((x >> 2) & 1) + 4 * (x >> 3) + (x & 3);
        const size_t tb = ((size_t)(pn * (K / 64) + (k0 >> 6)) * 2 + half) * 16384 + pg8::lds_byte(rslot, 8 * c);
        *(u32x4*)((char*)WTe + tb) = o; }
    asm volatile("s_waitcnt lgkmcnt(0)" ::: "memory");
}
DI void rms_row_to_bf16(const float* xrow, const float* g, bf16* orow, int lane) {
    const f32x4* xr = (const f32x4*)xrow + lane; const f32x4* gr = (const f32x4*)g + lane;
    f32x4 v[4]; float s = 0.f;
#pragma unroll
    for (int j = 0; j < 4; ++j) { v[j] = xr[64 * j]; s += (v[j].x * v[j].x + v[j].y * v[j].y) + (v[j].z * v[j].z + v[j].w * v[j].w); }
    const float rstd = rsq_f(wave_sum(s) * (1.f / D) + EPS);
    u32x2* o8 = (u32x2*)orow + lane;
#pragma unroll
    for (int j = 0; j < 4; ++j) { const f32x4 gg = gr[64 * j]; u32x2 w; w.x = pk2(v[j].x * rstd * gg.x, v[j].y * rstd * gg.y); w.y = pk2(v[j].z * rstd * gg.z, v[j].w * rstd * gg.w); o8[64 * j] = w; }
}

DI void rms_rowbf_to_bf16(const bf16* xrow, const float* g, bf16* orow, int lane) {
    float v[16]; float s = 0.f;
#pragma unroll
    for (int hf = 0; hf < 2; ++hf) { const u32x4 w = *(const u32x4*)(xrow + 512 * hf + 8 * lane);
#pragma unroll
        for (int q = 0; q < 4; ++q) { v[8 * hf + 2 * q] = bflo(w[q]); v[8 * hf + 2 * q + 1] = bfhi(w[q]); } }
#pragma unroll
    for (int j = 0; j < 16; ++j) s += v[j] * v[j];
    const float rstd = rsq_f(wave_sum(s) * (1.f / D) + EPS);
#pragma unroll
    for (int hf = 0; hf < 2; ++hf) { const f32x4 g0 = *(const f32x4*)(g + 512 * hf + 8 * lane), g1 = *(const f32x4*)(g + 512 * hf + 8 * lane + 4);
        u32x4 w; w.x = pk2(v[8 * hf] * rstd * g0.x, v[8 * hf + 1] * rstd * g0.y); w.y = pk2(v[8 * hf + 2] * rstd * g0.z, v[8 * hf + 3] * rstd * g0.w);
        w.z = pk2(v[8 * hf + 4] * rstd * g1.x, v[8 * hf + 5] * rstd * g1.y); w.w = pk2(v[8 * hf + 6] * rstd * g1.z, v[8 * hf + 7] * rstd * g1.w);
        *(u32x4*)(orow + 512 * hf + 8 * lane) = w; }
}

__global__ void __launch_bounds__(NTHREADS, 2) fwd(Args args) {
    extern __shared__ __attribute__((aligned(16))) unsigned char lds_raw[];
    LAS unsigned char* lds = (LAS unsigned char*)lds_raw;
    volatile LAS unsigned* MISC = (volatile LAS unsigned*)(lds + MISC_OFF);
    const int G = gridDim.x, bid = blockIdx.x, NGW = G * NWAVES;
#define PHASE_IDS const int tid = fresh_tid(), lane = tid & 63, wave = __builtin_amdgcn_readfirstlane(tid >> 6), gw = bid * NWAVES + wave; (void)tid; (void)lane; (void)wave; (void)gw
    unsigned char* ws = args.ws;
    unsigned* ctl = (unsigned*)(ws + WS_CTL);
    const int lo = args.ph_lo, hi = args.ph_hi;

    for (int u = threadIdx.x; u < (LDS_BYTES - RING_BYTES) / 4; u += NTHREADS) ((LAS unsigned*)(lds + RING_BYTES))[u] = 0u;
    __syncthreads();
    XcdBarrier bar; bar.bar = ctl + CW_BAR; bar.x = 0; bar.st = nullptr;
    if (hi - lo > 1) bar = xcd_barrier_post(ctl + CW_BAR, MISC + 8);
#define IN(k) (lo <= (k) && (k) < hi)
#define SEAM(k) do { if (IN(k) && IN((k) + 1)) xcd_barrier(bar); } while (0)

#define Win_t ((bf16*)(ws + WS_WIN))
#define Wout_t ((bf16*)(ws + WS_WOUT))
#define Wq_t ((bf16*)(ws + WS_WQ))
#define Wk_t ((bf16*)(ws + WS_WK))
#define Wv_t ((bf16*)(ws + WS_WV))
#define Wo_t ((bf16*)(ws + WS_WO))
#define LoraB ((bf16*)(ws + WS_LORAB))
#define LruW ((bf16*)(ws + WS_LRUW))
#define Wgu_t ((bf16*)(ws + WS_WGU))
#define Wdn_t ((bf16*)(ws + WS_WDN))
#define HN ((bf16*)(ws + WS_HN))
#define MEMN ((bf16*)(ws + WS_MEMN))
#define KM ((bf16*)(ws + WS_KM))
#define VT ((bf16*)(ws + WS_VT))
#define X1 ((bf16*)(ws + WS_X1))
#define X2 ((bf16*)(ws + WS_X2))
#define U ((bf16*)(ws + WS_U))
#define Rr ((float*)(ws + WS_R))
#define KRAW ((float*)(ws + WS_KRAW))
#define Vv ((float*)(ws + WS_V))
#define KKN ((float*)(ws + WS_KKN))
#define WD ((float*)(ws + WS_WD))
#define AA ((float*)(ws + WS_AA))
#define GG ((float*)(ws + WS_G))
#define LA ((bf16*)(ws + WS_LA))
#define LB ((bf16*)(ws + WS_LB))
#define AP ((bf16*)(ws + WS_AP))
#define CAT ((bf16*)(ws + WS_CAT))
#define Qb ((bf16*)(ws + WS_Q))
#define Ob CAT
#define XS ((bf16*)(ws + WS_XS))
#define ACT ((bf16*)(ws + WS_ACT))
#define YS ((bf16*)(ws + WS_YS))
#define route_e ((int*)(ws + WS_ROUTE + RT_E))
#define route_pos ((int*)(ws + WS_ROUTE + RT_POS))
#define route_g ((float*)(ws + WS_ROUTE + RT_G))
#define row_slot ((int*)(ws + WS_ROUTE + RT_SLOT))
#define row_gate ((float*)(ws + WS_ROUTE + RT_GATE))
#define tile_tab ((int*)(ws + WS_ROUTE + RT_TILE))
#define row_tok ((int*)(ws + WS_ROUTE + RT_TOK))
#define ecnt (ctl + CW_CNT)

    if (IN(0)) { PHASE_IDS;
        LAS float* scr = (LAS float*)(lds + wave * 16384);
        constexpr int I_IN = 16 * (INW / 32), I_SQ = 16 * 32;
        constexpr int N_ITEMS = I_IN + 5 * I_SQ;
        for (int it = gw; it < N_ITEMS; it += NGW) {
            int r = it;
            if (r < I_IN) { const int nblk = INW / 32, kb = r / nblk, nb = r % nblk; transpose_item(args.in[I_WIN], INW, D, Win_t, 64 * kb, 32 * nb, 32 * nb, scr, lane); continue; } r -= I_IN;
            { const int w = r / I_SQ, q = r % I_SQ, kb = q / 32, nb = q % 32;
                const float* src = w == 0 ? args.in[I_WOUT] : w == 1 ? args.in[I_WQ] : w == 2 ? args.in[I_WK] : w == 3 ? args.in[I_WV] : args.in[I_WO];
                bf16* dst = w == 0 ? Wout_t : w == 1 ? Wq_t : w == 2 ? Wk_t : w == 3 ? Wv_t : Wo_t;
                transpose_item(src, D, D, dst, 64 * kb, 32 * nb, 32 * nb, scr, lane); }
        }
        for (int idx = bid * NTHREADS + tid; idx < 1536 * 256; idx += G * NTHREADS) {
            const int n = idx >> 8, k = idx & 255; float v = 0.f;
            if (n < 512) { if (k < 64) v = args.in[I_WUP][k * 512 + n]; }
            else if (n < 1024) { if (k >= 64 && k < 128) v = args.in[I_AUP][(k - 64) * 512 + (n - 512)]; }
            else { if (k >= 128) v = args.in[I_GUP][(k - 128) * 512 + (n - 1024)]; }
            LoraB[idx] = (bf16)f2bf(v);
        }
        for (int idx = bid * NTHREADS + tid; idx < 8 * 128 * 64; idx += G * NTHREADS) {
            const int nb = idx >> 13, col = (idx >> 6) & 127, k = idx & 63;
            const float v = col < 64 ? args.in[I_LWX][nb * 4096 + k * 64 + col] : args.in[I_LWA][nb * 4096 + k * 64 + (col - 64)];
            LruW[idx] = (bf16)f2bf(v);
        }
        for (int m = gw; m < M; m += NGW) rms_row_to_bf16(args.in[I_X] + (size_t)m * D, args.in[I_NMIXG], HN + (size_t)m * D, lane);
        for (int m = gw; m < MROWS; m += NGW) rms_row_to_bf16(args.in[I_MEM] + (size_t)m * D, args.in[I_NMEMG], MEMN + (size_t)m * D, lane);
        {
            LAS float* scr = (LAS float*)(lds + wave * 16384);
            constexpr int I_GU = 16 * 64, I_DN = 16 * 32;
            for (int it = gw; it < NE * (I_GU + I_DN); it += NGW) {
                int r = it;
                if (r < NE * I_GU) { const int e = r / I_GU, q = r % I_GU, kb = q / 64, nb = q % 64; const int n0 = 32 * nb;
                    const int drow = n0 < 1024 ? (256 * (n0 >> 7) + (n0 & 127)) : (256 * ((n0 - 1024) >> 7) + 128 + ((n0 - 1024) & 127));
                    transpose_item_tiled(args.in[I_WGU] + (size_t)e * D * 2048, 2048, D, Wgu_t + (size_t)e * 2048 * D, 64 * kb, n0, drow, scr, lane); continue; } r -= NE * I_GU;
                { const int e = r / I_DN, q = r % I_DN, kb = q / 32, nb = q % 32;
                  transpose_item_tiled(args.in[I_WDN] + (size_t)e * DFF * D, D, DFF, Wdn_t + (size_t)e * D * DFF, 64 * kb, 32 * nb, 32 * nb, scr, lane); }
            }
        }
    }
    SEAM(0);

    if (IN(1)) { PHASE_IDS;
        { pg8::DenseSched S; S.o.init_tiles(M / 256, INW / 256, G, bid); S.A = (const char*)HN; S.B = (const char*)Win_t; S.tstep = (size_t)256 * D * 2;
          EpiBf16Plain E{U, INW, 1.0f}; pg8::gemm_phase(lds, D, S, E); }
        { pg8::DenseSched S; S.o.init_tiles(MROWS / 256, D / 256, G, (bid + 64) & (G - 1)); S.A = (const char*)MEMN; S.B = (const char*)Wk_t; S.tstep = (size_t)256 * D * 2;
          EpiBf16Plain E{KM, D, 1.0f}; pg8::gemm_phase(lds, D, S, E); }
        { pg8::DenseSched S; S.o.init_tiles(D / 256, MROWS / 256, G, (bid + 48) & (G - 1)); S.A = (const char*)Wv_t; S.B = (const char*)MEMN; S.tstep = (size_t)256 * D * 2;
          EpiBf16Plain E{VT, MROWS, 1.0f}; pg8::gemm_phase(lds, D, S, E); }
    }
    SEAM(1);

    if (IN(2)) { PHASE_IDS;
        {
            const float* conv_w = args.in[I_CONVW]; const float* conv_b = args.in[I_CONVB]; const float* bx = args.in[I_LBX]; const float* ba = args.in[I_LBA]; const float* lam = args.in[I_LAM];
            LAS float* xs = (LAS float*)(lds + wave * 4096);
            const int i = lane & 15, kg = lane >> 4;
            for (int unit = gw; unit < (M / 16) * 2; unit += NGW) {
                const int tile = unit >> 1, nb0 = (unit & 1) * 4, m0 = tile * 16, s0 = m0 & (SEQ - 1);
                for (int nb = nb0; nb < nb0 + 4; ++nb) {
                    bf16x8 af[2];
#pragma unroll
                    for (int ks = 0; ks < 2; ++ks) {
                        const int chb = nb * 64 + 32 * ks + 8 * kg;
                        f32x4 x0 = *(const f32x4*)(conv_b + chb), x1 = *(const f32x4*)(conv_b + chb + 4);
#pragma unroll
                        for (int j = 0; j < 4; ++j) {
                            if (s0 + i - 3 + j >= 0) {
                                const u32x4 uw = *(const u32x4*)(U + (size_t)(m0 + i - 3 + j) * INW + chb);
                                const f32x4 w0 = *(const f32x4*)(conv_w + j * 512 + chb), w1 = *(const f32x4*)(conv_w + j * 512 + chb + 4);
                                x0.x += w0.x * bflo(uw.x); x0.y += w0.y * bfhi(uw.x); x0.z += w0.z * bflo(uw.y); x0.w += w0.w * bfhi(uw.y);
                                x1.x += w1.x * bflo(uw.z); x1.y += w1.y * bfhi(uw.z); x1.z += w1.z * bflo(uw.w); x1.w += w1.w * bfhi(uw.w);
                            }
                        }
                        *(LAS f32x4*)(xs + i * 64 + 32 * ks + 8 * kg) = x0; *(LAS f32x4*)(xs + i * 64 + 32 * ks + 8 * kg + 4) = x1;
                        u32x4 p; p.x = pk2(x0.x, x0.y); p.y = pk2(x0.z, x0.w); p.z = pk2(x1.x, x1.y); p.w = pk2(x1.z, x1.w);
                        af[ks] = __builtin_bit_cast(bf16x8, p);
                    }
                    f32x4 acc[8];
#pragma unroll
                    for (int ct = 0; ct < 8; ++ct) { acc[ct] = (f32x4){0.f, 0.f, 0.f, 0.f};
#pragma unroll
                        for (int ks = 0; ks < 2; ++ks) { const bf16x8 bfr = *(const bf16x8*)(LruW + ((size_t)(nb * 128 + 16 * ct + i) * 64 + 32 * ks + 8 * kg));
                            acc[ct] = __builtin_amdgcn_mfma_f32_16x16x32_bf16(af[ks], bfr, acc[ct], 0, 0, 0); } }
                    asm volatile("s_waitcnt lgkmcnt(0)" ::: "memory");
#pragma unroll
                    for (int ct = 0; ct < 4; ++ct) {
                        const int col = 16 * ct + i, ch = nb * 64 + col;
                        const float bxv = bx[ch], bav = ba[ch], sp = softplus_f(-lam[ch]);
#pragma unroll
                        for (int e = 0; e < 4; ++e) {
                            const int tok = 4 * kg + e;
                            const float gx = sigmoid_f(acc[ct][e] + bxv), ga = sigmoid_f(acc[ct + 4][e] + bav);
                            const float la = -8.0f * ga * sp, xcv = xs[tok * 64 + col];
                            const float bt = __builtin_amdgcn_sqrtf(fmaxf(1.0f - __expf(2.0f * la), 0.f)) * gx * xcv;
                            LA[(size_t)(m0 + tok) * 512 + ch] = (bf16)f2bf(la); LB[(size_t)(m0 + tok) * 512 + ch] = (bf16)f2bf(bt);
                        }
                    }
                }
            }
        }
    }
    SEAM(2);


#define RW_ZB(zz, zb) do { _Pragma("unroll") for (int ks_ = 0; ks_ < 2; ++ks_) { u32x4 p_; p_.x = pk2(zz[2 * ks_][0], zz[2 * ks_][1]); p_.y = pk2(zz[2 * ks_][2], zz[2 * ks_][3]); \
        p_.z = pk2(zz[2 * ks_ + 1][0], zz[2 * ks_ + 1][1]); p_.w = pk2(zz[2 * ks_ + 1][2], zz[2 * ks_ + 1][3]); zb[ks_] = __builtin_bit_cast(bf16x8, p_); } } while (0)
    if (IN(3)) { PHASE_IDS;
        for (int u64 = gw; u64 < NB * NH * (SEQ / 64); u64 += NGW) {
#pragma unroll 1
        for (int jj = 0; jj < 4; ++jj) {
        LAS unsigned char* wl = lds + wave * 16384;
        LAS bf16* Arm = (LAS bf16*)(wl); LAS bf16* Brm = (LAS bf16*)(wl + 2048); LAS bf16* Krm = (LAS bf16*)(wl + 4096); LAS bf16* Rrm = (LAS bf16*)(wl + 6144);
        LAS bf16* ATt = (LAS bf16*)(wl + 8192); LAS bf16* BTt = (LAS bf16*)(wl + 10240); LAS bf16* KTt = (LAS bf16*)(wl + 12288); LAS bf16* VTt = (LAS bf16*)(wl + 14336);
        LAS float* MabT = (LAS float*)(wl); LAS bf16* Mak = (LAS bf16*)(wl + 1024); LAS bf16* Mrb = (LAS bf16*)(wl + 1536); LAS bf16* Mrk = (LAS bf16*)(wl + 2048); LAS bf16* Tm = (LAS bf16*)(wl + 2560);
        LAS float* PLs = (LAS float*)(wl + 3072); LAS bf16* Q0T = (LAS bf16*)(wl + 4096);
        const int lane = fresh_tid() & 63, l15 = lane & 15, g = lane >> 4, te = lane >> 2, kq = lane & 3;
        const bf16x8 z8 = (bf16x8){0, 0, 0, 0, 0, 0, 0, 0};
        const f32x4 z4 = (f32x4){0.f, 0.f, 0.f, 0.f};
            const int un = u64 * 4 + jj;
            const int bh = un >> 8, c = un & 255, b = bh >> 3, h = bh & 7;
            const size_t mrow = (size_t)b * SEQ + c * 16 + te, off = mrow * 512 + h * 64 + 16 * kq;
            const int hc = h * 64 + 16 * kq;
            LAS float* tmpL = (LAS float*)wl;
            {
                const size_t mr = (size_t)b * SEQ + c * 16 + l15; const bool hp2 = (mr & (SEQ - 1)) != 0;
                const bf16* ua = U + mr * INW + 2560 + 8 * g;
                bf16x8 af[8];
#pragma unroll
                for (int ks = 0; ks < 8; ++ks) {
                    const u32x4 cu = *(const u32x4*)(ua + 32 * ks); u32x4 pu = (u32x4){0u, 0u, 0u, 0u}; if (hp2) pu = *(const u32x4*)(ua - INW + 32 * ks);
                    const f32x4 m0 = *(const f32x4*)(args.in[I_MU] + 1536 + 32 * ks + 8 * g), m1 = *(const f32x4*)(args.in[I_MU] + 1536 + 32 * ks + 8 * g + 4);
                    float o8[8];
#pragma unroll
                    for (int q = 0; q < 4; ++q) { const float c0 = bflo(cu[q]), c1 = bfhi(cu[q]), p0 = bflo(pu[q]), p1 = bfhi(pu[q]); const float mm0 = q < 2 ? m0[2 * q] : m1[2 * q - 4], mm1 = q < 2 ? m0[2 * q + 1] : m1[2 * q - 3];
                        float x0 = c0 + (p0 - c0) * mm0, x1 = c1 + (p1 - c1) * mm1;
                        if (ks < 2) { x0 = tanh_fast(x0); x1 = tanh_fast(x1); }
                        else if (ks >= 4) { x0 = sigmoid_f(x0); x1 = sigmoid_f(x1); }
                        o8[2 * q] = x0; o8[2 * q + 1] = x1; }
                    u32x4 pw; pw.x = pk2(o8[0], o8[1]); pw.y = pk2(o8[2], o8[3]); pw.z = pk2(o8[4], o8[5]); pw.w = pk2(o8[6], o8[7]); af[ks] = __builtin_bit_cast(bf16x8, pw);
                }
#pragma unroll
                for (int kind = 0; kind < 3; ++kind)
#pragma unroll
                    for (int ct = 0; ct < 4; ++ct) {
                        const bf16* lb = LoraB + (size_t)(kind * 512 + h * 64 + 16 * ct + l15) * 256 + 8 * g;
                        f32x4 a4 = z4;
#pragma unroll
                        for (int ks = (kind == 0 ? 0 : kind == 1 ? 2 : 4); ks < (kind == 0 ? 2 : kind == 1 ? 4 : 8); ++ks) a4 = __builtin_amdgcn_mfma_f32_16x16x32_bf16(af[ks], *(const bf16x8*)(lb + 32 * ks), a4, 0, 0, 0);
#pragma unroll
                        for (int e = 0; e < 4; ++e) tmpL[kind * 1088 + (4 * g + e) * 68 + 16 * ct + l15] = a4[e];
                    }
            }
            asm volatile("s_waitcnt lgkmcnt(0)" ::: "memory");
            float cl[16], eP[16];
            {
                float lwv[16], rl[16], kl[16], vl[16], kn[16], av[16];
                const bool hp = (mrow & (SEQ - 1)) != 0;
                const bf16* ub = U + mrow * INW + 1024 + hc;
#pragma unroll
                for (int hh = 0; hh < 2; ++hh) {
#pragma unroll
                    for (int a3 = 0; a3 < 3; ++a3) {
                        const u32x4 cu = *(const u32x4*)(ub + 512 * a3 + 8 * hh); u32x4 pu = (u32x4){0u, 0u, 0u, 0u}; if (hp) pu = *(const u32x4*)(ub - INW + 512 * a3 + 8 * hh);
                        const f32x4 m0 = *(const f32x4*)(args.in[I_MU] + 512 * a3 + hc + 8 * hh), m1 = *(const f32x4*)(args.in[I_MU] + 512 * a3 + hc + 8 * hh + 4);
                        float o8[8];
#pragma unroll
                        for (int q = 0; q < 4; ++q) { const float c0 = bflo(cu[q]), c1 = bfhi(cu[q]), p0 = bflo(pu[q]), p1 = bfhi(pu[q]); const float mm0 = q < 2 ? m0[2 * q] : m1[2 * q - 4], mm1 = q < 2 ? m0[2 * q + 1] : m1[2 * q - 3];
                            o8[2 * q] = c0 + (p0 - c0) * mm0; o8[2 * q + 1] = c1 + (p1 - c1) * mm1; }
#pragma unroll
                        for (int q = 0; q < 8; ++q) { if (a3 == 0) rl[8 * hh + q] = o8[q]; else if (a3 == 1) kl[8 * hh + q] = o8[q]; else vl[8 * hh + q] = o8[q]; }
                    }
                }
                float gv[16];
#pragma unroll
                for (int j4 = 0; j4 < 4; ++j4) { const f32x4 xl = *(const LAS f32x4*)(tmpL + te * 68 + 16 * kq + 4 * j4), xa = *(const LAS f32x4*)(tmpL + 1088 + te * 68 + 16 * kq + 4 * j4), xg = *(const LAS f32x4*)(tmpL + 2176 + te * 68 + 16 * kq + 4 * j4);
                    const f32x4 w0v = *(const f32x4*)(args.in[I_W0] + hc + 4 * j4), a0v = *(const f32x4*)(args.in[I_A0] + hc + 4 * j4);
#pragma unroll
                    for (int q = 0; q < 4; ++q) { const float wq = -softplus_fast(-(xl[q] + w0v[q])) - 0.5f; lwv[4 * j4 + q] = -__expf(wq); av[4 * j4 + q] = sigmoid_f(xa[q] + a0v[q]); gv[4 * j4 + q] = xg[q]; } }
                asm volatile("s_waitcnt lgkmcnt(0)" ::: "memory");
                float ss = 0.f;
#pragma unroll
                for (int j4 = 0; j4 < 4; ++j4) { const f32x4 kk4 = *(const f32x4*)(args.in[I_KK] + hc + 4 * j4);
#pragma unroll
                    for (int q = 0; q < 4; ++q) { kn[4 * j4 + q] = kl[4 * j4 + q] * kk4[q]; ss += kn[4 * j4 + q] * kn[4 * j4 + q]; } }
                ss += __shfl_xor(ss, 1); ss += __shfl_xor(ss, 2);
                const float kinv = rsq_f(fmaxf(ss, 1e-24f));
#pragma unroll
                for (int j = 0; j < 16; ++j) { float x = lwv[j];
#pragma unroll
                    for (int sft = 4; sft < 64; sft <<= 1) { const float y = __shfl_up(x, sft); if (lane >= sft) x += y; }
                    cl[j] = x; }
                float bon = 0.f;
                u32x4 pa[2], pb[2], pk[2], pr[2];
#pragma unroll
                for (int j4 = 0; j4 < 4; ++j4) {
                    const f32x4 ka = *(const f32x4*)(args.in[I_KA] + hc + 4 * j4), rk = *(const f32x4*)(args.in[I_RK] + hc + 4 * j4);
                    float at4[4], bt4[4], kt4[4], rt4[4];
#pragma unroll
                    for (int q = 0; q < 4; ++q) { const int j = 4 * j4 + q;
                        const float p = __expf(cl[j]), pn = __expf(-cl[j]), pm1 = __expf(cl[j] - lwv[j]); eP[j] = p;
                        const float knj = kn[j] * kinv;
                        const float kp = kl[j] * (1.0f + (av[j] - 1.0f) * ka[q]);
                        at4[q] = -knj * pm1; bt4[q] = knj * av[j] * pn; kt4[q] = kp * pn; rt4[q] = rl[j] * p;
                        bon += rl[j] * kp * rk[q];
                        const int kk = 16 * kq + j;
                        ATt[kk * 16 + te] = (bf16)f2bf(at4[q]); BTt[kk * 16 + te] = (bf16)f2bf(bt4[q]); KTt[kk * 16 + te] = (bf16)f2bf(kt4[q]); VTt[kk * 16 + te] = (bf16)f2bf(vl[j]); }
                    const int hh = j4 >> 1, w2 = (j4 & 1) * 2;
                    pa[hh][w2] = pk2(at4[0], at4[1]); pa[hh][w2 + 1] = pk2(at4[2], at4[3]); pb[hh][w2] = pk2(bt4[0], bt4[1]); pb[hh][w2 + 1] = pk2(bt4[2], bt4[3]);
                    pk[hh][w2] = pk2(kt4[0], kt4[1]); pk[hh][w2 + 1] = pk2(kt4[2], kt4[3]); pr[hh][w2] = pk2(rt4[0], rt4[1]); pr[hh][w2 + 1] = pk2(rt4[2], rt4[3]);
                }
#pragma unroll
                for (int hh = 0; hh < 2; ++hh) { const int po = te * 64 + 8 * ((2 * kq + hh) ^ (te & 7));
                    *(LAS u32x4*)(Arm + po) = pa[hh]; *(LAS u32x4*)(Brm + po) = pb[hh]; *(LAS u32x4*)(Krm + po) = pk[hh]; *(LAS u32x4*)(Rrm + po) = pr[hh]; }
                bon += __shfl_xor(bon, 1); bon += __shfl_xor(bon, 2);
#pragma unroll
                for (int j4 = 0; j4 < 4; ++j4) { const f32x4 lb = *(const f32x4*)(args.in[I_LNB] + hc + 4 * j4), lgn = *(const f32x4*)(args.in[I_LNG] + hc + 4 * j4); const int j0 = 4 * j4;
                    u32x2 ow, gw2; ow.x = pk2((lb.x + vl[j0] * bon) * gv[j0], (lb.y + vl[j0 + 1] * bon) * gv[j0 + 1]); ow.y = pk2((lb.z + vl[j0 + 2] * bon) * gv[j0 + 2], (lb.w + vl[j0 + 3] * bon) * gv[j0 + 3]);
                    gw2.x = pk2(lgn.x * gv[j0], lgn.y * gv[j0 + 1]); gw2.y = pk2(lgn.z * gv[j0 + 2], lgn.w * gv[j0 + 3]);
                    *(u32x2*)((bf16*)(ws + WS_ADD) + off + j0) = ow; *(u32x2*)((bf16*)(ws + WS_G) + off + j0) = gw2; }
            }
            asm volatile("s_waitcnt lgkmcnt(0)" ::: "memory");
            {
                bf16x8 fa[2], fr[2], fb[2], fk[2];
#pragma unroll
                for (int ks = 0; ks < 2; ++ks) { const int po = l15 * 64 + 8 * ((4 * ks + g) ^ (l15 & 7));
                    fa[ks] = *(const LAS bf16x8*)(Arm + po); fr[ks] = *(const LAS bf16x8*)(Rrm + po); fb[ks] = *(const LAS bf16x8*)(Brm + po); fk[ks] = *(const LAS bf16x8*)(Krm + po); }
                f32x4 mab = z4, mak = z4, mrb = z4, mrk = z4;
#pragma unroll
                for (int ks = 0; ks < 2; ++ks) { mab = __builtin_amdgcn_mfma_f32_16x16x32_bf16(fb[ks], fa[ks], mab, 0, 0, 0); mak = __builtin_amdgcn_mfma_f32_16x16x32_bf16(fk[ks], fa[ks], mak, 0, 0, 0);
                    mrb = __builtin_amdgcn_mfma_f32_16x16x32_bf16(fb[ks], fr[ks], mrb, 0, 0, 0); mrk = __builtin_amdgcn_mfma_f32_16x16x32_bf16(fk[ks], fr[ks], mrk, 0, 0, 0); }
#pragma unroll
                for (int e = 0; e < 4; ++e) { const int i = 4 * g + e; if (!(i < l15)) { mab[e] = 0.f; mak[e] = 0.f; } if (!(i <= l15)) { mrb[e] = 0.f; mrk[e] = 0.f; } }
                asm volatile("s_waitcnt lgkmcnt(0)" ::: "memory");
#pragma unroll
                for (int e = 0; e < 4; ++e) MabT[(4 * g + e) * 16 + l15] = mab[e];
                u32x2 w; w.x = pk2(mak[0], mak[1]); w.y = pk2(mak[2], mak[3]); *(LAS u32x2*)(Mak + l15 * 16 + 4 * g) = w;
                w.x = pk2(mrb[0], mrb[1]); w.y = pk2(mrb[2], mrb[3]); *(LAS u32x2*)(Mrb + l15 * 16 + 4 * g) = w;
                w.x = pk2(mrk[0], mrk[1]); w.y = pk2(mrk[2], mrk[3]); *(LAS u32x2*)(Mrk + l15 * 16 + 4 * g) = w;
                if (te == 15) {
#pragma unroll
                    for (int j = 0; j < 16; ++j) PLs[16 * kq + j] = eP[j]; }
            }
            asm volatile("s_waitcnt lgkmcnt(0)" ::: "memory");
            {
                float y[16];
#pragma unroll
                for (int j = 15; j >= 0; --j) {
                    float acc = (j == l15) ? 1.0f : 0.0f;
                    float row[16];
#pragma unroll
                    for (int q = 0; q < 4; ++q) { const f32x4 x = *(const LAS f32x4*)(MabT + j * 16 + 4 * q); row[4 * q] = x.x; row[4 * q + 1] = x.y; row[4 * q + 2] = x.z; row[4 * q + 3] = x.w; }
#pragma unroll
                    for (int i = j + 1; i < 16; ++i) acc += y[i] * row[i];
                    y[j] = acc;
                }
                if (g == 0) { u32x4 t0, t1; t0.x = pk2(y[0], y[1]); t0.y = pk2(y[2], y[3]); t0.z = pk2(y[4], y[5]); t0.w = pk2(y[6], y[7]); t1.x = pk2(y[8], y[9]); t1.y = pk2(y[10], y[11]); t1.z = pk2(y[12], y[13]); t1.w = pk2(y[14], y[15]);
                    *(LAS u32x4*)(Tm + l15 * 16) = t0; *(LAS u32x4*)(Tm + l15 * 16 + 8) = t1; }
            }
            asm volatile("s_waitcnt lgkmcnt(0)" ::: "memory");
            {
                const bool act = g < 2; const int fo = l15 * 16 + 8 * g;
                const bf16x8 fT = act ? *(const LAS bf16x8*)(Tm + fo) : z8, fMak = act ? *(const LAS bf16x8*)(Mak + fo) : z8, fMrb = act ? *(const LAS bf16x8*)(Mrb + fo) : z8, fMrk = act ? *(const LAS bf16x8*)(Mrk + fo) : z8;
                bf16x8 fV[4], fQ1[4], fAh[4], fBT[4], fKT[4];
#pragma unroll
                for (int vt = 0; vt < 4; ++vt) { fV[vt] = act ? *(const LAS bf16x8*)(VTt + vt * 256 + fo) : z8; fBT[vt] = act ? *(const LAS bf16x8*)(BTt + vt * 256 + fo) : z8; fKT[vt] = act ? *(const LAS bf16x8*)(KTt + vt * 256 + fo) : z8; }
#pragma unroll
                for (int vt = 0; vt < 4; ++vt) { const f32x4 q0 = __builtin_amdgcn_mfma_f32_16x16x32_bf16(fMak, fV[vt], z4, 0, 0, 0);
                    u32x2 w; w.x = pk2(q0[0], q0[1]); w.y = pk2(q0[2], q0[3]); *(LAS u32x2*)(Q0T + vt * 256 + l15 * 16 + 4 * g) = w; }
#pragma unroll
                for (int kt = 0; kt < 4; ++kt) { const bf16x8 fA = act ? *(const LAS bf16x8*)(ATt + kt * 256 + fo) : z8; const f32x4 ah = __builtin_amdgcn_mfma_f32_16x16x32_bf16(fT, fA, z4, 0, 0, 0);
                    u32x2 w; w.x = pk2(ah[0], ah[1]); w.y = pk2(ah[2], ah[3]); *(LAS u32x2*)(ATt + kt * 256 + l15 * 16 + 4 * g) = w; }
                asm volatile("s_waitcnt lgkmcnt(0)" ::: "memory");
#pragma unroll
                for (int vt = 0; vt < 4; ++vt) { const bf16x8 fQ0 = act ? *(const LAS bf16x8*)(Q0T + vt * 256 + fo) : z8; const f32x4 q1 = __builtin_amdgcn_mfma_f32_16x16x32_bf16(fT, fQ0, z4, 0, 0, 0);
                    u32x2 w; w.x = pk2(q1[0], q1[1]); w.y = pk2(q1[2], q1[3]); *(LAS u32x2*)(Q0T + vt * 256 + l15 * 16 + 4 * g) = w; }
                asm volatile("s_waitcnt lgkmcnt(0)" ::: "memory");
#pragma unroll
                for (int vt = 0; vt < 4; ++vt) { fQ1[vt] = act ? *(const LAS bf16x8*)(Q0T + vt * 256 + fo) : z8; fAh[vt] = act ? *(const LAS bf16x8*)(ATt + vt * 256 + fo) : z8; }
                bf16* rp = (bf16*)(ws + WS_RP) + (size_t)un * 1024 + l15 * 64;
#pragma unroll
                for (int kt = 0; kt < 4; ++kt) {
                    const u32x2 rr = *(const LAS u32x2*)(Rrm + l15 * 64 + 8 * ((2 * kt + (g >> 1)) ^ (l15 & 7)) + 4 * (g & 1));
                    f32x4 ini; ini[0] = bflo(rr.x); ini[1] = bfhi(rr.x); ini[2] = bflo(rr.y); ini[3] = bfhi(rr.y);
                    const f32x4 rh = __builtin_amdgcn_mfma_f32_16x16x32_bf16(fAh[kt], fMrb, ini, 0, 0, 0);
                    u32x2 w; w.x = pk2(rh[0], rh[1]); w.y = pk2(rh[2], rh[3]); *(u32x2*)(rp + 32 * (kt >> 1) + 8 * g + 4 * (kt & 1)) = w;
                }
#pragma unroll
                for (int vt = 0; vt < 4; ++vt) { f32x4 y1 = __builtin_amdgcn_mfma_f32_16x16x32_bf16(fMrb, fQ1[vt], z4, 0, 0, 0); y1 = __builtin_amdgcn_mfma_f32_16x16x32_bf16(fMrk, fV[vt], y1, 0, 0, 0);
                    *(f32x4*)((float*)(ws + WS_Y1F) + ((size_t)(un * 4 + vt) * 64 + lane) * 4) = y1; }
                bf16* gp = (bf16*)(ws + WS_GP) + (size_t)un * 4096;
#pragma unroll
                for (int krt = 0; krt < 4; ++krt) { const float pl = PLs[16 * krt + l15];
#pragma unroll
                    for (int kct = 0; kct < 4; ++kct) { f32x4 ga = __builtin_amdgcn_mfma_f32_16x16x32_bf16(fAh[kct], fBT[krt], z4, 0, 0, 0);
                        if (kct == krt) {
#pragma unroll
                            for (int e = 0; e < 4; ++e) if (4 * g + e == l15) ga[e] += 1.0f; }
                        u32x2 w; w.x = pk2(ga[0] * pl, ga[1] * pl); w.y = pk2(ga[2] * pl, ga[3] * pl);
                        *(u32x2*)(gp + (16 * krt + l15) * 64 + 32 * (kct >> 1) + 8 * g + 4 * (kct & 1)) = w; } }
#pragma unroll
                for (int mt = 0; mt < 4; ++mt) { const f32x4 pl4 = *(const LAS f32x4*)(PLs + 16 * mt + 4 * g);
#pragma unroll
                    for (int vt = 0; vt < 4; ++vt) { f32x4 ha = __builtin_amdgcn_mfma_f32_16x16x32_bf16(fBT[mt], fQ1[vt], z4, 0, 0, 0); ha = __builtin_amdgcn_mfma_f32_16x16x32_bf16(fKT[mt], fV[vt], ha, 0, 0, 0);
                        u32x2 w; w.x = pk2(ha[0] * pl4[0], ha[1] * pl4[1]); w.y = pk2(ha[2] * pl4[2], ha[3] * pl4[3]);
                        *(u32x2*)((bf16*)(ws + WS_HF) + ((size_t)((un * 4 + vt) * 4 + mt) * 64 + lane) * 4) = w; } }
            }
            asm volatile("s_waitcnt lgkmcnt(0)" ::: "memory");
        }
        asm volatile("s_waitcnt vmcnt(0)" ::: "memory");
        { const int ltid = fresh_tid() & 63, l15 = ltid & 15, g = ltid >> 4, lane = ltid;
#pragma unroll 1
        for (int part = 0; part < 2; ++part) {
            f32x4 z[4][4];
#pragma unroll
            for (int sl = 0; sl < 4; ++sl)
#pragma unroll
                for (int mt = 0; mt < 4; ++mt)
#pragma unroll
                    for (int e = 0; e < 4; ++e) z[sl][mt][e] = (part == 0 && sl == mt && 4 * g + e == l15) ? 1.0f : 0.0f;
#pragma unroll 1
            for (int j = 0; j < 4; ++j) {
                const size_t un = (size_t)u64 * 4 + j;
                const bf16* gp = (const bf16*)(ws + WS_GP) + un * 4096 + l15 * 64 + 8 * g;
                bf16x8 gf[4][2];
#pragma unroll
                for (int mt = 0; mt < 4; ++mt) { gf[mt][0] = *(const bf16x8*)(gp + mt * 1024); gf[mt][1] = *(const bf16x8*)(gp + mt * 1024 + 32); }
#pragma unroll
                for (int sl = 0; sl < 4; ++sl) {
                    bf16x8 zb[2]; RW_ZB(z[sl], zb);
#pragma unroll
                    for (int mt = 0; mt < 4; ++mt) {
                        f32x4 a = (f32x4){0.f, 0.f, 0.f, 0.f};
                        if (part) { const u32x2 hh = *(const u32x2*)((const bf16*)(ws + WS_HF) + ((size_t)((un * 4 + sl) * 4 + mt) * 64 + lane) * 4); a[0] = bflo(hh.x); a[1] = bfhi(hh.x); a[2] = bflo(hh.y); a[3] = bfhi(hh.y); }
                        a = __builtin_amdgcn_mfma_f32_16x16x32_bf16(gf[mt][0], zb[0], a, 0, 0, 0); a = __builtin_amdgcn_mfma_f32_16x16x32_bf16(gf[mt][1], zb[1], a, 0, 0, 0);
                        z[sl][mt] = a;
                    }
                }
            }
            if (part == 0) {
                bf16* gc = (bf16*)(ws + WS_GC) + (size_t)u64 * 4096;
#pragma unroll
                for (int sl = 0; sl < 4; ++sl) { const int pc = 32 * (sl >> 1) + 8 * (l15 >> 2) + 4 * (sl & 1) + (l15 & 3);
#pragma unroll
                    for (int mt = 0; mt < 4; ++mt)
#pragma unroll
                        for (int e = 0; e < 4; ++e) gc[(16 * mt + 4 * g + e) * 64 + pc] = (bf16)f2bf(z[sl][mt][e]); }
            } else {
#pragma unroll
                for (int sl = 0; sl < 4; ++sl)
#pragma unroll
                    for (int mt = 0; mt < 4; ++mt) { u32x2 w; w.x = pk2(z[sl][mt][0], z[sl][mt][1]); w.y = pk2(z[sl][mt][2], z[sl][mt][3]);
                        *(u32x2*)((bf16*)(ws + WS_HC) + ((size_t)((u64 * 4 + sl) * 4 + mt) * 64 + lane) * 4) = w; }
            }
        }
        }
        }
        for (int lu = gw; lu < NB * 8 * 64; lu += NGW) {
            const int bc = lu >> 6, seg = lu & 63, b = bc >> 3, cg = bc & 7, ch = cg * 64 + lane;
            const size_t mb = (size_t)b * SEQ + seg * 64;
            float A = 1.f, B = 0.f;
#pragma unroll 16
            for (int t = 0; t < 64; ++t) { const float a = __expf(bf2f(LA[(mb + t) * 512 + ch])), bt = bf2f(LB[(mb + t) * 512 + ch]); B = a * B + bt; A *= a; }
            f32x2 ab; ab.x = A; ab.y = B; *(f32x2*)((float*)(ws + WS_AP) + ((size_t)lu * 64 + lane) * 2) = ab;
        }
    }
    SEAM(3);


    if (IN(4)) { PHASE_IDS;
        if (!(bid < 128 && wave == 0)) {
            const int wi = bid < 128 ? bid * 7 + (wave - 1) : 896 + (bid - 128) * 8 + wave, NW = 896 + (G - 128) * 8;
        } else {
            const int l15 = lane & 15, g = lane >> 4, bh = bid >> 2, vs = bid & 3;
            f32x4 z[4];
#pragma unroll
            for (int mt = 0; mt < 4; ++mt) z[mt] = (f32x4){0.f, 0.f, 0.f, 0.f};
            bf16x8 gA[4][2], gB[4][2], gC[4][2], gD[4][2]; u32x2 hA[4], hB[4], hC[4], hD[4];
#define SC_LOAD(gf, hf, C) do { const size_t u64_ = (size_t)bh * 64 + (C); const bf16* gp_ = (const bf16*)(ws + WS_GC) + u64_ * 4096 + l15 * 64 + 8 * g; \
                _Pragma("unroll") for (int mt = 0; mt < 4; ++mt) { gf[mt][0] = *(const bf16x8*)(gp_ + mt * 1024); gf[mt][1] = *(const bf16x8*)(gp_ + mt * 1024 + 32); \
                    hf[mt] = *(const u32x2*)((const bf16*)(ws + WS_HC) + ((size_t)((u64_ * 4 + vs) * 4 + mt) * 64 + lane) * 4); } } while (0)
#define SC_STEP(gf, hf, C) do { const size_t u64_ = (size_t)bh * 64 + (C); bf16* zs_ = (bf16*)(ws + WS_ZS) + ((size_t)((u64_ * 4 + vs) * 4) * 64 + lane) * 4; \
                _Pragma("unroll") for (int mt = 0; mt < 4; ++mt) { u32x2 zw_; zw_.x = pk2(z[mt][0], z[mt][1]); zw_.y = pk2(z[mt][2], z[mt][3]); *(u32x2*)(zs_ + mt * 256) = zw_; } \
                bf16x8 zb[2]; RW_ZB(z, zb); \
                _Pragma("unroll") for (int mt = 0; mt < 4; ++mt) { f32x4 a; a[0] = bflo(hf[mt].x); a[1] = bfhi(hf[mt].x); a[2] = bflo(hf[mt].y); a[3] = bfhi(hf[mt].y); \
                    a = __builtin_amdgcn_mfma_f32_16x16x32_bf16(gf[mt][0], zb[0], a, 0, 0, 0); a = __builtin_amdgcn_mfma_f32_16x16x32_bf16(gf[mt][1], zb[1], a, 0, 0, 0); z[mt] = a; } } while (0)
            SC_LOAD(gA, hA, 0); SC_LOAD(gB, hB, 1); SC_LOAD(gC, hC, 2);
#pragma unroll 1
            for (int C = 0; C < 64; C += 4) {
                SC_LOAD(gD, hD, C + 3);
                SC_STEP(gA, hA, C);
                if (C + 4 < 64) SC_LOAD(gA, hA, C + 4);
                SC_STEP(gB, hB, C + 1);
                if (C + 5 < 64) SC_LOAD(gB, hB, C + 5);
                SC_STEP(gC, hC, C + 2);
                if (C + 6 < 64) SC_LOAD(gC, hC, C + 6);
                SC_STEP(gD, hD, C + 3);
            }
#undef SC_LOAD
#undef SC_STEP
        }
    }
    SEAM(4);

    if (IN(5)) { PHASE_IDS;
        {
            for (int lu = gw; lu < NB * 8 * 64; lu += NGW) {
                const int bc = lu >> 6, seg = lu & 63, b = bc >> 3, cg = bc & 7, ch = cg * 64 + lane;
                const size_t mb = (size_t)b * SEQ + seg * 64;
                float hst = 0.f;
                const f32x2* ag = (const f32x2*)((const float*)(ws + WS_AP)) + (size_t)(bc * 64) * 64 + lane;
#pragma unroll 8
                for (int sg = 0; sg < seg; ++sg) { const f32x2 ab = ag[(size_t)sg * 64]; hst = ab.x * hst + ab.y; }
#pragma unroll 16
                for (int t = 0; t < 64; ++t) { const float a = __expf(bf2f(LA[(mb + t) * 512 + ch])), bt = bf2f(LB[(mb + t) * 512 + ch]); hst = a * hst + bt;
                    const float gl = bf2f(U[(mb + t) * INW + 512 + ch]); CAT[(mb + t) * 1024 + ch] = (bf16)f2bf(hst * gelu_tanh_f(gl)); }
            }
        }
        const int l15 = lane & 15, g = lane >> 4;
        for (int u64 = gw; u64 < NB * NH * (SEQ / 64); u64 += NGW) {
            const int bh = u64 >> 6, C = u64 & 63, b = bh >> 3, h = bh & 7;
            f32x4 z[4][4];
#pragma unroll
            for (int sl = 0; sl < 4; ++sl)
#pragma unroll
                for (int mt = 0; mt < 4; ++mt) { const u32x2 zw = *(const u32x2*)((const bf16*)(ws + WS_ZS) + ((size_t)((u64 * 4 + sl) * 4 + mt) * 64 + lane) * 4); z[sl][mt] = (f32x4){bflo(zw.x), bfhi(zw.x), bflo(zw.y), bfhi(zw.y)}; }
#pragma unroll 1
            for (int j = 0; j < 4; ++j) {
                const size_t un = (size_t)u64 * 4 + j; const size_t m0 = (size_t)b * SEQ + (C * 4 + j) * 16;
                const bf16* rp = (const bf16*)(ws + WS_RP) + un * 1024 + l15 * 64 + 8 * g;
                const bf16x8 rf0 = *(const bf16x8*)rp, rf1 = *(const bf16x8*)(rp + 32);
                f32x4 y[4];
#pragma unroll
                for (int sl = 0; sl < 4; ++sl) { bf16x8 zb[2]; RW_ZB(z[sl], zb);
                    f32x4 a = *(const f32x4*)((const float*)(ws + WS_Y1F) + ((size_t)(un * 4 + sl) * 64 + lane) * 4);
                    a = __builtin_amdgcn_mfma_f32_16x16x32_bf16(rf0, zb[0], a, 0, 0, 0); a = __builtin_amdgcn_mfma_f32_16x16x32_bf16(rf1, zb[1], a, 0, 0, 0); y[sl] = a; }
#pragma unroll
                for (int e = 0; e < 4; ++e) {
                    float s1 = (y[0][e] + y[1][e]) + (y[2][e] + y[3][e]);
                    s1 += __shfl_xor(s1, 1); s1 += __shfl_xor(s1, 2); s1 += __shfl_xor(s1, 4); s1 += __shfl_xor(s1, 8);
                    const float mean = s1 * (1.0f / 64.0f);
                    float d0 = y[0][e] - mean, d1 = y[1][e] - mean, d2 = y[2][e] - mean, d3 = y[3][e] - mean;
                    float s2 = (d0 * d0 + d1 * d1) + (d2 * d2 + d3 * d3);
                    s2 += __shfl_xor(s2, 1); s2 += __shfl_xor(s2, 2); s2 += __shfl_xor(s2, 4); s2 += __shfl_xor(s2, 8);
                    const float rstd = rsq_f(s2 * (1.0f / 64.0f) + GN_EPS);
                    const size_t ro = (m0 + 4 * g + e) * 512 + h * 64 + l15;
                    const float dd[4] = {d0, d1, d2, d3};
#pragma unroll
                    for (int sl = 0; sl < 4; ++sl) { const float gg = bf2f(((const bf16*)(ws + WS_G))[ro + 16 * sl]), ad = bf2f(((const bf16*)(ws + WS_ADD))[ro + 16 * sl]);
                        const float o = dd[sl] * rstd * gg + ad;
                        CAT[(m0 + 4 * g + e) * 1024 + 512 + h * 64 + 16 * sl + l15] = (bf16)f2bf(o); }
                }
                if (j < 3) {
                    const bf16* gp = (const bf16*)(ws + WS_GP) + un * 4096 + l15 * 64 + 8 * g;
                    bf16x8 gf[4][2];
#pragma unroll
                    for (int mt = 0; mt < 4; ++mt) { gf[mt][0] = *(const bf16x8*)(gp + mt * 1024); gf[mt][1] = *(const bf16x8*)(gp + mt * 1024 + 32); }
#pragma unroll
                    for (int sl = 0; sl < 4; ++sl) { bf16x8 zb[2]; RW_ZB(z[sl], zb);
#pragma unroll
                        for (int mt = 0; mt < 4; ++mt) { const u32x2 hh = *(const u32x2*)((const bf16*)(ws + WS_HF) + ((size_t)((un * 4 + sl) * 4 + mt) * 64 + lane) * 4);
                            f32x4 a; a[0] = bflo(hh.x); a[1] = bfhi(hh.x); a[2] = bflo(hh.y); a[3] = bfhi(hh.y);
                            a = __builtin_amdgcn_mfma_f32_16x16x32_bf16(gf[mt][0], zb[0], a, 0, 0, 0); a = __builtin_amdgcn_mfma_f32_16x16x32_bf16(gf[mt][1], zb[1], a, 0, 0, 0); z[sl][mt] = a; } }
                }
            }
        }
    }
    SEAM(5);
#undef RW_ZB


    if (IN(6)) { PHASE_IDS;
        pg8::DenseSched S; S.o.init_tiles(M / 256, D / 256, G, bid); S.A = (const char*)CAT; S.B = (const char*)Wout_t; S.tstep = (size_t)256 * D * 2;
        EpiBf16Res<false> E{args.in[I_X], X1, D}; pg8::gemm_phase(lds, D, S, E);
    }
    SEAM(6);
    if (IN(7)) { PHASE_IDS; for (int m = gw; m < M; m += NGW) rms_rowbf_to_bf16(X1 + (size_t)m * D, args.in[I_NXAG], HN + (size_t)m * D, lane); }
    SEAM(7);
    if (IN(8)) { PHASE_IDS;
        pg8::DenseSched S; S.o.init_tiles(M / 256, D / 256, G, bid); S.A = (const char*)HN; S.B = (const char*)Wq_t; S.tstep = (size_t)256 * D * 2;
        EpiBf16Plain E{Qb, D, 0.0625f}; pg8::gemm_phase(lds, D, S, E);
    }
    SEAM(8);
    if (IN(9)) { PHASE_IDS;
        constexpr int KP = 264, VP = 72;
        LAS bf16* Kt = (LAS bf16*)lds;
        LAS bf16* Vt = (LAS bf16*)(lds + 64 * KP * 2);
        const int l15 = lane & 15, g4 = lane >> 4;
        const int bh = bid >> 4, b = bh >> 2, h = bh & 3;
        const int kkey = tid >> 3, kpart = tid & 7, vd = tid >> 1, vhalf = tid & 1;
        const bf16* kg = KM + (size_t)(b * MEML + kkey) * D + h * XHD + 32 * kpart;
        const bf16* vg = VT + (size_t)(h * XHD + vd) * MROWS + b * MEML + 32 * vhalf;
#pragma unroll 1
        for (int u = 0; u < 2; ++u) {
            const int q0 = ((bid & 15) * 2 + u) * 128 + wave * 16;
            const bf16* qbase = Qb + (size_t)(b * SEQ + q0 + l15) * D + h * XHD + 8 * g4;
            bf16x8 qf[8];
#pragma unroll
            for (int ks = 0; ks < 8; ++ks) qf[ks] = *(const bf16x8*)(qbase + 32 * ks);
            f32x4 oc[16];
#pragma unroll
            for (int dt = 0; dt < 16; ++dt) oc[dt] = (f32x4){0.f, 0.f, 0.f, 0.f};
            float mrun = -3.0e38f, lrun = 0.f;
            u32x4 kr[4], vr[4];
#pragma unroll
            for (int i = 0; i < 4; ++i) { kr[i] = *(const u32x4*)(kg + 8 * i); vr[i] = *(const u32x4*)(vg + 8 * i); }
#pragma unroll 1
            for (int kt = 0; kt < 4; ++kt) {
                __syncthreads();
#pragma unroll
                for (int i = 0; i < 4; ++i) { *(LAS u32x4*)(Kt + kkey * KP + 32 * kpart + 8 * i) = kr[i]; *(LAS u32x4*)(Vt + vd * VP + 32 * vhalf + 8 * i) = vr[i]; }
                if (kt < 3) {
#pragma unroll
                    for (int i = 0; i < 4; ++i) { kr[i] = *(const u32x4*)(kg + (size_t)(kt + 1) * 64 * D + 8 * i); vr[i] = *(const u32x4*)(vg + (kt + 1) * 64 + 8 * i); } }
                __syncthreads();
                f32x4 sc[4];
#pragma unroll
                for (int j = 0; j < 4; ++j) sc[j] = (f32x4){0.f, 0.f, 0.f, 0.f};
#pragma unroll
                for (int ks = 0; ks < 8; ++ks)
#pragma unroll
                    for (int j = 0; j < 4; ++j) { const bf16x8 kf = *(const LAS bf16x8*)(Kt + (16 * j + l15) * KP + 32 * ks + 8 * g4);
                        sc[j] = __builtin_amdgcn_mfma_f32_16x16x32_bf16(kf, qf[ks], sc[j], 0, 0, 0); }
                float mx = -3.0e38f;
#pragma unroll
                for (int j = 0; j < 4; ++j) mx = fmaxf(mx, fmaxf(fmaxf(sc[j][0], sc[j][1]), fmaxf(sc[j][2], sc[j][3])));
                mx = fmaxf(mx, __shfl_xor(mx, 16)); mx = fmaxf(mx, __shfl_xor(mx, 32));
                const float mnew = fmaxf(mrun, mx), alpha = __expf(mrun - mnew);
                mrun = mnew; lrun *= alpha;
#pragma unroll
                for (int j = 0; j < 4; ++j)
#pragma unroll
                    for (int e = 0; e < 4; ++e) { const float p = __expf(sc[j][e] - mnew); sc[j][e] = p; lrun += p; }
                bf16x8 pf[2];
#pragma unroll
                for (int s2 = 0; s2 < 2; ++s2) { u32x4 pw; pw.x = pk2(sc[2 * s2][0], sc[2 * s2][1]); pw.y = pk2(sc[2 * s2][2], sc[2 * s2][3]); pw.z = pk2(sc[2 * s2 + 1][0], sc[2 * s2 + 1][1]); pw.w = pk2(sc[2 * s2 + 1][2], sc[2 * s2 + 1][3]);
                    pf[s2] = __builtin_bit_cast(bf16x8, pw); }
#pragma unroll
                for (int dt = 0; dt < 16; ++dt) {
                    f32x4 o = oc[dt] * alpha;
#pragma unroll
                    for (int s2 = 0; s2 < 2; ++s2) { const LAS bf16* vp = Vt + (16 * dt + l15) * VP + 32 * s2 + 4 * g4;
                        const u32x2 v0 = *(const LAS u32x2*)vp, v1 = *(const LAS u32x2*)(vp + 16);
                        u32x4 vv; vv.x = v0.x; vv.y = v0.y; vv.z = v1.x; vv.w = v1.y;
                        o = __builtin_amdgcn_mfma_f32_16x16x32_bf16(__builtin_bit_cast(bf16x8, vv), pf[s2], o, 0, 0, 0); }
                    oc[dt] = o;
                }
            }
            lrun += __shfl_xor(lrun, 16); lrun += __shfl_xor(lrun, 32);
            const float inv = rcp_f(lrun);
            bf16* obase = Ob + (size_t)(b * SEQ + q0 + l15) * D + h * XHD + 4 * g4;
#pragma unroll
            for (int dt = 0; dt < 16; ++dt) { u32x2 w; w.x = pk2(oc[dt][0] * inv, oc[dt][1] * inv); w.y = pk2(oc[dt][2] * inv, oc[dt][3] * inv); *(u32x2*)(obase + 16 * dt) = w; }
        }
        __syncthreads();
    }
    SEAM(9);
    if (IN(10)) { PHASE_IDS;
        pg8::DenseSched S; S.o.init_tiles(M / 256, D / 256, G, bid); S.A = (const char*)Ob; S.B = (const char*)Wo_t; S.tstep = (size_t)256 * D * 2;
        EpiBf16Res<true> E{X1, X2, D}; pg8::gemm_phase(lds, D, S, E);
    }
    SEAM(10);
    if (IN(11)) { PHASE_IDS;
        LAS float* hs = (LAS float*)(lds + wave * 16384);
        const float* gfn = args.in[I_NFFG]; const float* wr_ = args.in[I_WR]; const float* br = args.in[I_BR];
        const int e = lane & 31, half = lane >> 5;
        for (int grp = gw; grp < M / 4; grp += NGW) {
            const int m0 = grp * 4;
#pragma unroll
            for (int rr = 0; rr < 4; ++rr) {
                const bf16* xrow = X2 + (size_t)(m0 + rr) * D;
                float v[16]; float s = 0.f;
#pragma unroll
                for (int hf = 0; hf < 2; ++hf) { const u32x4 w = *(const u32x4*)(xrow + 512 * hf + 8 * lane);
#pragma unroll
                    for (int q = 0; q < 4; ++q) { v[8 * hf + 2 * q] = bflo(w[q]); v[8 * hf + 2 * q + 1] = bfhi(w[q]); } }
#pragma unroll
                for (int j = 0; j < 16; ++j) s += v[j] * v[j];
                const float rstd = rsq_f(wave_sum(s) * (1.f / D) + EPS);
#pragma unroll
                for (int hf = 0; hf < 2; ++hf) { const f32x4 g0 = *(const f32x4*)(gfn + 512 * hf + 8 * lane), g1 = *(const f32x4*)(gfn + 512 * hf + 8 * lane + 4);
                    const f32x4 h0 = (f32x4){v[8 * hf] * rstd * g0.x, v[8 * hf + 1] * rstd * g0.y, v[8 * hf + 2] * rstd * g0.z, v[8 * hf + 3] * rstd * g0.w};
                    const f32x4 h1 = (f32x4){v[8 * hf + 4] * rstd * g1.x, v[8 * hf + 5] * rstd * g1.y, v[8 * hf + 6] * rstd * g1.z, v[8 * hf + 7] * rstd * g1.w};
                    *(LAS f32x4*)(hs + rr * 1024 + 512 * hf + 8 * lane) = h0; *(LAS f32x4*)(hs + rr * 1024 + 512 * hf + 8 * lane + 4) = h1;
                    u32x4 w; w.x = pk2(h0.x, h0.y); w.y = pk2(h0.z, h0.w); w.z = pk2(h1.x, h1.y); w.w = pk2(h1.z, h1.w);
                    *(u32x4*)(HN + (size_t)(m0 + rr) * D + 512 * hf + 8 * lane) = w; }
            }
            asm volatile("s_waitcnt lgkmcnt(0)" ::: "memory");
            float lg[4] = {0.f, 0.f, 0.f, 0.f};
#pragma unroll 4
            for (int d = half * 512; d < half * 512 + 512; d += 4) {
                const float w0 = wr_[(d + 0) * 32 + e], w1 = wr_[(d + 1) * 32 + e], w2 = wr_[(d + 2) * 32 + e], w3 = wr_[(d + 3) * 32 + e];
#pragma unroll
                for (int rr = 0; rr < 4; ++rr) { const f32x4 h4 = *(const LAS f32x4*)(hs + rr * 1024 + d); lg[rr] += (h4.x * w0 + h4.y * w1) + (h4.z * w2 + h4.w * w3); }
            }
            const float brv = br[e];
#pragma unroll
            for (int rr = 0; rr < 4; ++rr) {
                float v = lg[rr] + __shfl_xor(lg[rr], 32) + brv;
                float selv[4]; int sele[4];
#pragma unroll
                for (int k = 0; k < 4; ++k) {
                    float mv = v; int mi = e;
#pragma unroll
                    for (int o = 1; o < 32; o <<= 1) { const float ov = __shfl_xor(mv, o); const int oi = __shfl_xor(mi, o); if (ov > mv || (ov == mv && oi < mi)) { mv = ov; mi = oi; } }
                    selv[k] = mv; sele[k] = mi; if (e == mi) v = -3.0e38f;
                }
                const float e1 = __expf(selv[1] - selv[0]), e2 = __expf(selv[2] - selv[0]), e3 = __expf(selv[3] - selv[0]);
                const float inv = rcp_f(1.0f + e1 + e2 + e3);
                if (lane < 4) {
                    const int me = lane == 0 ? sele[0] : lane == 1 ? sele[1] : lane == 2 ? sele[2] : sele[3];
                    const float mg = (lane == 0 ? 1.0f : lane == 1 ? e1 : lane == 2 ? e2 : e3) * inv;
                    const int pos = (int)atomicAdd(ecnt + me, 1u);
                    const int ai = (m0 + rr) * 4 + lane; route_e[ai] = me; route_pos[ai] = pos; route_g[ai] = mg;
                }
            }
        }
    }
    SEAM(11);
    if (IN(12)) { PHASE_IDS;
        LAS int* pst = (LAS int*)lds;
        if (tid == 0) { int acc = 0; for (int e = 0; e < NE; ++e) { const int c = (int)__hip_atomic_load(ecnt + e, __ATOMIC_RELAXED, __HIP_MEMORY_SCOPE_AGENT); pst[e] = acc; pst[64 + e] = c; acc += (c + 255) & ~255; } pst[32] = acc; }
        __syncthreads();
        for (int ai = bid * NTHREADS + tid; ai < NASSIGN; ai += G * NTHREADS) {
            const int e = route_e[ai]; const int row = pst[e] + route_pos[ai]; row_slot[row] = ai; row_gate[row] = route_g[ai]; row_tok[row] = ai >> 2; }
        if (bid < NE) { const int e = bid, c = pst[64 + e], pe = (c + 255) & ~255; for (int p = c + tid; p < pe; p += NTHREADS) { row_slot[pst[e] + p] = -1; row_gate[pst[e] + p] = 0.f; row_tok[pst[e] + p] = 0; } }
        if (bid == 0 && tid == 0) { int nt = 0; for (int e = 0; e < NE; ++e) { const int n = ((pst[64 + e] + 255) & ~255) >> 8; for (int j = 0; j < n; ++j) tile_tab[16 + nt++] = e; } tile_tab[0] = nt; }
        __syncthreads();
    }
    SEAM(12);
    if (IN(13)) { PHASE_IDS;
        const int ntiles = tile_tab[0];
        pg8::MoeGatherSched S; S.o.init_tiles(ntiles, 2048 / 256, G, bid); S.A = (const char*)HN; S.B = (const char*)Wgu_t; S.tile_e = tile_tab + 16; S.rtok = row_tok; S.tstep = (size_t)256 * D * 2; S.estep = (size_t)2048 * D * 2;
        EpiSwiglu E{ACT, args.in[I_BGU]}; pg8::gemm_phase(lds, D, S, E);
    }
    SEAM(13);
    if (IN(14)) { PHASE_IDS;
        const int ntiles = tile_tab[0];
        pg8::MoeSched S; S.o.init_tiles(ntiles, D / 256, G, bid); S.A = (const char*)ACT; S.B = (const char*)Wdn_t; S.tile_e = tile_tab + 16; S.tstep = (size_t)256 * DFF * 2; S.estep = (size_t)D * DFF * 2;
        EpiDown E{YS, args.in[I_BDN], row_slot, row_gate}; pg8::gemm_phase(lds, DFF, S, E);
    }
    SEAM(14);
    if (IN(15)) { PHASE_IDS;
        const float* gfin = args.in[I_FNG];
        for (int m = gw; m < M; m += NGW) {
            float v[16]; float s = 0.f;
#pragma unroll
            for (int hf = 0; hf < 2; ++hf) { const u32x4 w = *(const u32x4*)(X2 + (size_t)m * D + 512 * hf + 8 * lane);
#pragma unroll
                for (int q = 0; q < 4; ++q) { v[8 * hf + 2 * q] = bflo(w[q]); v[8 * hf + 2 * q + 1] = bfhi(w[q]); }
#pragma unroll
                for (int k = 0; k < 4; ++k) { const u32x4 y = *(const u32x4*)(YS + (size_t)(m * 4 + k) * D + 512 * hf + 8 * lane);
#pragma unroll
                    for (int q = 0; q < 4; ++q) { v[8 * hf + 2 * q] += bflo(y[q]); v[8 * hf + 2 * q + 1] += bfhi(y[q]); } } }
#pragma unroll
            for (int j = 0; j < 16; ++j) s += v[j] * v[j];
            const float rstd = rsq_f(wave_sum(s) * (1.f / D) + EPS);
#pragma unroll
            for (int hf = 0; hf < 2; ++hf) { const f32x4 g0 = *(const f32x4*)(gfin + 512 * hf + 8 * lane), g1 = *(const f32x4*)(gfin + 512 * hf + 8 * lane + 4);
                float* o = args.out + (size_t)m * D + 512 * hf + 8 * lane;
                *(f32x4*)o = (f32x4){v[8 * hf] * rstd * g0.x, v[8 * hf + 1] * rstd * g0.y, v[8 * hf + 2] * rstd * g0.z, v[8 * hf + 3] * rstd * g0.w};
                *(f32x4*)(o + 4) = (f32x4){v[8 * hf + 4] * rstd * g1.x, v[8 * hf + 5] * rstd * g1.y, v[8 * hf + 6] * rstd * g1.z, v[8 * hf + 7] * rstd * g1.w}; }
        }
    }
#undef IN
#undef SEAM
}

constexpr int N_PHASES = 16;
extern "C" void kernel_launch(void* const* d_in, const int* in_sizes, int n_in, void* d_out, int out_size, void* d_ws, size_t ws_size, hipStream_t stream) {
    static int grid = 0;
    if (grid == 0) {
        if (n_in != 37 || out_size != M * D || ws_size < WS_END) { fprintf(stderr, "kernel_launch: unexpected shapes (n_in %d, out %d, ws %zu); nothing launched\n", n_in, out_size, ws_size); grid = -1; return; }
        int dev = 0, cus = 0, per_cu = 0;
        if (hipGetDevice(&dev) != hipSuccess || hipDeviceGetAttribute(&cus, hipDeviceAttributeMultiprocessorCount, dev) != hipSuccess) { grid = -1; return; }
        if (hipFuncSetAttribute((const void*)fwd, hipFuncAttributeMaxDynamicSharedMemorySize, LDS_BYTES) != hipSuccess) { fprintf(stderr, "kernel_launch: hipFuncSetAttribute failed\n"); grid = -1; return; }
        if (hipOccupancyMaxActiveBlocksPerMultiprocessor(&per_cu, (const void*)fwd, NTHREADS, LDS_BYTES) != hipSuccess || per_cu < 1) fprintf(stderr, "kernel_launch: occupancy query says %d\n", per_cu);
        (void)hipGetLastError();
        grid = cus > 256 ? 256 : cus;
    }
    if (grid < 0) return;
    if (hipMemsetAsync((char*)d_ws + WS_CTL, 0, CTL_ZERO_BYTES, stream) != hipSuccess) return;
    Args a{};
    for (int i = 0; i < 37; ++i) a.in[i] = (const float*)d_in[i];
    a.out = (float*)d_out; a.ws = (unsigned char*)d_ws;
#if MK_ONE_LAUNCH
    a.ph_lo = 0; a.ph_hi = N_PHASES;
    hipLaunchKernelGGL(fwd, dim3(grid), dim3(NTHREADS), LDS_BYTES, stream, a);
#else
    for (int p = 0; p < N_PHASES; ++p) { a.ph_lo = p; a.ph_hi = p + 1; hipLaunchKernelGGL(fwd, dim3(grid), dim3(NTHREADS), LDS_BYTES, stream, a);
#ifdef PROBE_REPEAT_PHASE
        if (p == PROBE_REPEAT_PHASE) hipLaunchKernelGGL(fwd, dim3(grid), dim3(NTHREADS), LDS_BYTES, stream, a);
#endif
    }
#endif
}
```

```cpp
#include <hip/hip_runtime.h>
#include <cstdio>
#include <cstdint>

#ifndef MK_ONE_LAUNCH
#define MK_ONE_LAUNCH 1
#endif

#define DI __device__ __forceinline__
#define GAS __attribute__((address_space(1)))
#define LAS __attribute__((address_space(3)))
typedef unsigned short bf16;
typedef short bf16x8 __attribute__((ext_vector_type(8)));
typedef float f32x4 __attribute__((ext_vector_type(4)));
typedef float f32x2 __attribute__((ext_vector_type(2)));
typedef unsigned u32x4 __attribute__((ext_vector_type(4)));
typedef unsigned u32x2 __attribute__((ext_vector_type(2)));

constexpr int D = 1024, NB = 4, SEQ = 4096, M = NB * SEQ;
constexpr int MEML = 256, MROWS = NB * MEML;
constexpr int LRU_W = 512, RW = 512, NH = 8, HD = 64;
constexpr int INW = 2816;
constexpr int XH = 4, XHD = 256;
constexpr int NE = 32, TOPK = 4, DFF = 1024;
constexpr int NASSIGN = M * TOPK;
constexpr int MAXTILES = 288, MAXROWS = MAXTILES * 256;
constexpr float EPS = 1e-6f, GN_EPS = 64e-5f;

DI int fresh_tid() { int t = threadIdx.x; asm volatile("" : "+v"(t)); return t; }
namespace pg8 {
constexpr int BM = 256, BK = 64, HALF = 128, HTB = HALF * BK * 2, STAGE_BYTES = 8 * HTB, NXCD = 8, WGM = 8;
__host__ __device__ __forceinline__ int lds_byte(int r, int c) { const int st = (r >> 4) * 2 + (c >> 5), rr = r & 15, cc = c & 31, ob = rr * 64 + cc * 2; return st * 1024 + (ob ^ (((ob >> 9) & 1) << 5)); }
__host__ __device__ __forceinline__ void stage_rc(int b, int& R, int& C) { const int st = b / 1024, sb = b % 1024, swz = sb ^ (((sb >> 9) & 1) << 5); R = (st >> 1) * 16 + swz / 64; C = (st & 1) * 32 + (swz % 64) / 2; }
__host__ __device__ __forceinline__ int perm32(int rho) { const int n = rho >> 4, i = rho & 15; return 8 * (i >> 2) + 4 * n + (i & 3); }

struct Unit { int pm, pn, e; };

struct StaticOrder {
    int nM, nN, nwg, G, c;
    __host__ __device__ void init_tiles(int nM_, int nN_, int G_, int c_) { nM = nM_; nN = nN_; nwg = nM * nN; G = G_; c = c_; }
    __host__ __device__ bool next(int i, Unit& u) const {
        const long L = (long)i * G + c; if (L >= nwg) return false;
        int wgid = (int)L; { const int q = nwg / NXCD, r = nwg % NXCD, xcd = wgid % NXCD, off = wgid / NXCD; wgid = (xcd < r ? xcd * (q + 1) : r * (q + 1) + (xcd - r) * q) + off; }
        const int nig = WGM * nN, gid = wgid / nig, fm = gid * WGM, gsz = (nM - fm) < WGM ? (nM - fm) : WGM;
        u.pm = fm + ((wgid % nig) % gsz); u.pn = (wgid % nig) / gsz; u.e = 0; return true;
    }
};
struct DenseSched {
    static constexpr bool GATHER = false, B_TILED = false;
    StaticOrder o; const char* A; const char* B; size_t tstep;
    DI bool next(int i, Unit& u) const { return o.next(i, u); }
    DI const char* a_ptr(const Unit& u) const { return A + (size_t)u.pm * tstep; }
    DI const char* b_ptr(const Unit& u) const { return B + (size_t)u.pn * tstep; }
    DI void a_voff(const Unit&, int K, const int (&R)[2], const int (&C)[2], unsigned (&vo)[2][2]) const {
#pragma unroll
        for (int h = 0; h < 2; ++h)
#pragma unroll
            for (int i = 0; i < 2; ++i) vo[h][i] = (unsigned)((h * HALF + R[i]) * K + C[i]) * 2u; }
};
struct MoeSched {
    static constexpr bool GATHER = false, B_TILED = true;
    StaticOrder o; const char* A; const char* B; const int* tile_e; size_t tstep, estep;
    DI bool next(int i, Unit& u) const { if (!o.next(i, u)) return false; u.e = tile_e[u.pm]; return true; }
    DI const char* a_ptr(const Unit& u) const { return A + (size_t)u.pm * tstep; }
    DI const char* b_ptr(const Unit& u) const { return B + (size_t)u.e * estep + (size_t)u.pn * tstep; }
    DI void a_voff(const Unit&, int K, const int (&R)[2], const int (&C)[2], unsigned (&vo)[2][2]) const {
#pragma unroll
        for (int h = 0; h < 2; ++h)
#pragma unroll
            for (int i = 0; i < 2; ++i) vo[h][i] = (unsigned)((h * HALF + R[i]) * K + C[i]) * 2u; }
};
struct MoeGatherSched {
    static constexpr bool GATHER = true, B_TILED = true;
    StaticOrder o; const char* A; const char* B; const int* tile_e; const int* rtok; size_t tstep, estep;
    DI bool next(int i, Unit& u) const { if (!o.next(i, u)) return false; u.e = tile_e[u.pm]; return true; }
    DI const char* a_ptr(const Unit&) const { return A; }
    DI const char* b_ptr(const Unit& u) const { return B + (size_t)u.e * estep + (size_t)u.pn * tstep; }
    DI void a_voff(const Unit& u, int K, const int (&R)[2], const int (&C)[2], unsigned (&vo)[2][2]) const {
#pragma unroll
        for (int h = 0; h < 2; ++h)
#pragma unroll
            for (int i = 0; i < 2; ++i) vo[h][i] = (unsigned)(rtok[u.pm * BM + h * HALF + R[i]] * K + C[i]) * 2u; }
};

DI unsigned cvt_pk_bf16(float lo, float hi) { unsigned r; asm volatile("v_cvt_pk_bf16_f32 %0, %1, %2" : "=v"(r) : "v"(lo), "v"(hi)); return r; }

template <class Epi, class Sched, bool ALIGN_EPI = true>
DI void gemm_phase(LAS unsigned char* lds, const int K, const Sched& S, const Epi& E) {
    const int tid = fresh_tid(), wid = __builtin_amdgcn_readfirstlane(tid >> 6), lane = tid & 63, wr = wid >> 2, wc = wid & 3, fr = lane & 15, fq = lane >> 4;
    const int nt = K / BK;
    constexpr bool GA = Sched::GATHER, BT = Sched::B_TILED;
    unsigned voffA[2][2], voffAn[2][2], voffB[2]; int sR[2], sC[2];
#pragma unroll
    for (int i = 0; i < 2; ++i) { int R, C; stage_rc(tid * 16 + i * 8192, R, C); const int Rb = Epi::PERM ? ((R & ~31) + perm32(R & 31)) : R;
        sR[i] = R; sC[i] = C; voffB[i] = BT ? (unsigned)(tid * 16 + i * 8192) : (unsigned)(Rb * K + C) * 2u; }
    const size_t kstep = (size_t)(BK * 2);
    const size_t hstep = (size_t)HALF * K * 2;
    const size_t kstepB = BT ? (size_t)(2 * HTB) : kstep, hstepB = BT ? (size_t)HTB : hstep;
    const unsigned ldsw = (unsigned)wid * 1024u;
    const int aoff = lds_byte(wr * 64 + fr, fq * 8), boff = lds_byte(wc * 32 + fr, fq * 8);
#define PG8_SA(b, h) (((b) * 2 + (h)) * HTB)
#define PG8_SB(b, h) ((4 + (b) * 2 + (h)) * HTB)
#define PG8_STAGE(bufoff, gbase, voff) do { _Pragma("unroll") for (int _i = 0; _i < 2; ++_i) \
        __builtin_amdgcn_global_load_lds((const unsigned*)((const char*)(gbase) + (voff)[_i]), (LAS unsigned*)(lds + (bufoff) + ldsw + _i * 8192), 16, 0, 0); } while (0)
#define PG8_LDA(dst, b, h) do { _Pragma("unroll") for (int m = 0; m < 4; ++m) _Pragma("unroll") for (int k = 0; k < 2; ++k) dst[m][k] = *(const LAS bf16x8*)(lds + PG8_SA(b, h) + aoff + m * 2048 + k * 1024); } while (0)
#define PG8_LDB(dst, b, h) do { _Pragma("unroll") for (int n = 0; n < 2; ++n) _Pragma("unroll") for (int k = 0; k < 2; ++k) dst[n][k] = *(const LAS bf16x8*)(lds + PG8_SB(b, h) + boff + n * 2048 + k * 1024); } while (0)
#define PG8_MMA(ai, bj, At, Bt) do { __builtin_amdgcn_s_setprio(1); _Pragma("unroll") for (int m = 0; m < 4; ++m) _Pragma("unroll") for (int n = 0; n < 2; ++n) _Pragma("unroll") for (int k = 0; k < 2; ++k) \
        acc[ai][bj][m][n] = __builtin_amdgcn_mfma_f32_16x16x32_bf16(Bt[n][k], At[m][k], acc[ai][bj][m][n], 0, 0, 0); __builtin_amdgcn_s_setprio(0); } while (0)
#define PG8_WAIT_V(n) asm volatile("s_waitcnt vmcnt(" #n ")" ::: "memory")
#define PG8_WAIT_L(n) asm volatile("s_waitcnt lgkmcnt(" #n ")" ::: "memory")
#define PG8_BAR __builtin_amdgcn_s_barrier()
#define PG8_SCHED __builtin_amdgcn_sched_barrier(0)
    Unit cur, nxt; int ui = 0;
    if (!S.next(0, cur)) return;
    f32x4 acc[2][2][4][2];
#pragma unroll
    for (int a = 0; a < 2; ++a)
#pragma unroll
        for (int b = 0; b < 2; ++b)
#pragma unroll
            for (int m = 0; m < 4; ++m)
#pragma unroll
                for (int n = 0; n < 2; ++n) acc[a][b][m][n] = (f32x4){0.f, 0.f, 0.f, 0.f};
    bf16x8 At[4][2], B0[2][2], B1[2][2];
    const char* cA = S.a_ptr(cur); const char* cB = S.b_ptr(cur);
    S.a_voff(cur, K, sR, sC, voffA);
#define PG8_STAGE_A(bufoff, kbase, h, vo) do { if constexpr (GA) { PG8_STAGE(bufoff, kbase, (vo)[h]); } else { PG8_STAGE(bufoff, (kbase) + (h) * hstep, voffA[0]); } } while (0)
    PG8_STAGE(PG8_SB(0, 0), cB, voffB); PG8_STAGE(PG8_SB(0, 1), cB + hstepB, voffB); PG8_STAGE_A(PG8_SA(0, 0), cA, 0, voffA); PG8_STAGE_A(PG8_SA(0, 1), cA, 1, voffA);
    if (wr == 1) PG8_BAR;
    PG8_WAIT_V(2); PG8_BAR;
    PG8_STAGE(PG8_SB(1, 0), cB + kstepB, voffB); PG8_STAGE_A(PG8_SA(1, 0), cA + kstep, 0, voffA); PG8_STAGE(PG8_SB(1, 1), cB + hstepB + kstepB, voffB);
    PG8_WAIT_V(6); PG8_BAR;
    for (;;) {
        const bool has_next = S.next(ui + 1, nxt);
        const char* nA = has_next ? S.a_ptr(nxt) : cA; const char* nB = has_next ? S.b_ptr(nxt) : cB;
        if constexpr (GA) { if (has_next) S.a_voff(nxt, K, sR, sC, voffAn);
            else {
#pragma unroll
                for (int h = 0; h < 2; ++h)
#pragma unroll
                    for (int i = 0; i < 2; ++i) voffAn[h][i] = voffA[h][i]; } }
        for (int t = 0; t < nt; t += 2) {
            const bool last = (t == nt - 2);
            const char* a1 = cA + (size_t)(t + 1) * kstep;
            const char* a2 = last ? nA : cA + (size_t)(t + 2) * kstep; const char* b2 = last ? nB : cB + (size_t)(t + 2) * kstepB;
            const char* a3 = a2 + kstep; const char* b3 = b2 + kstepB;
            unsigned vs[2][2];
            if constexpr (GA) {
#pragma unroll
                for (int i = 0; i < 2; ++i) { vs[0][i] = last ? voffAn[0][i] : voffA[0][i]; vs[1][i] = last ? voffAn[1][i] : voffA[1][i]; } }
            PG8_LDB(B0, 0, 0); PG8_LDB(B1, 0, 1); PG8_SCHED; PG8_LDA(At, 0, 0); PG8_STAGE_A(PG8_SA(1, 1), a1, 1, voffA);
            PG8_WAIT_V(8); PG8_WAIT_L(0); PG8_BAR; PG8_MMA(0, 0, At, B0); PG8_MMA(0, 1, At, B1); PG8_BAR; PG8_SCHED;
            PG8_LDA(At, 0, 1); PG8_STAGE(PG8_SB(0, 0), b2, voffB); PG8_STAGE(PG8_SB(0, 1), b2 + hstepB, voffB); PG8_STAGE_A(PG8_SA(0, 0), a2, 0, vs);
            PG8_WAIT_V(8); PG8_WAIT_L(0); PG8_BAR; PG8_MMA(1, 0, At, B0); PG8_MMA(1, 1, At, B1); PG8_BAR; PG8_SCHED;
            PG8_LDB(B0, 1, 0); PG8_LDB(B1, 1, 1); PG8_SCHED; PG8_LDA(At, 1, 0); PG8_STAGE_A(PG8_SA(0, 1), a2, 1, vs);
            PG8_WAIT_V(8); PG8_WAIT_L(0); PG8_BAR; PG8_MMA(0, 0, At, B0); PG8_MMA(0, 1, At, B1); PG8_BAR; PG8_SCHED;
            PG8_LDA(At, 1, 1); PG8_STAGE(PG8_SB(1, 0), b3, voffB); PG8_STAGE(PG8_SB(1, 1), b3 + hstepB, voffB); PG8_STAGE_A(PG8_SA(1, 0), a3, 0, vs);
            PG8_WAIT_V(8); PG8_WAIT_L(0); PG8_BAR; PG8_MMA(1, 0, At, B0); PG8_MMA(1, 1, At, B1); PG8_BAR; PG8_SCHED;
        }
        if constexpr (ALIGN_EPI) { if (wr == 0) PG8_BAR; }
        E(acc, cur, wr, wc, fr, fq);
        if (!has_next) break;
#pragma unroll
        for (int a = 0; a < 2; ++a)
#pragma unroll
            for (int b = 0; b < 2; ++b)
#pragma unroll
                for (int m = 0; m < 4; ++m)
#pragma unroll
                    for (int n = 0; n < 2; ++n) acc[a][b][m][n] = (f32x4){0.f, 0.f, 0.f, 0.f};
        cur = nxt; cA = nA; cB = nB; ++ui;
        if constexpr (GA) {
#pragma unroll
            for (int h = 0; h < 2; ++h)
#pragma unroll
                for (int i = 0; i < 2; ++i) voffA[h][i] = voffAn[h][i]; }
        if constexpr (ALIGN_EPI) { if (wr == 1) PG8_BAR; }
    }
    PG8_WAIT_V(0);
    if constexpr (!ALIGN_EPI) { if (wr == 0) PG8_BAR; }
    PG8_BAR;
#undef PG8_SA
#undef PG8_SB
#undef PG8_STAGE
#undef PG8_STAGE_A
#undef PG8_LDA
#undef PG8_LDB
#undef PG8_MMA
#undef PG8_WAIT_V
#undef PG8_WAIT_L
#undef PG8_BAR
#undef PG8_SCHED
}
}
using pg8::Unit;
using pg8::cvt_pk_bf16;

DI float bflo(unsigned w) { return __uint_as_float(w << 16); }
DI float bfhi(unsigned w) { return __uint_as_float(w & 0xffff0000u); }
DI float bf2f(bf16 b) { return __uint_as_float(((unsigned)b) << 16); }
typedef __bf16 hwbf2 __attribute__((ext_vector_type(2)));
DI unsigned pk2(float lo, float hi) { const f32x2 v = {lo, hi}; return __builtin_bit_cast(unsigned, __builtin_convertvector(v, hwbf2)); }
DI unsigned f2bf(float f) { return pk2(f, 0.f) & 0xffffu; }
DI float rcp_f(float x) { return __builtin_amdgcn_rcpf(x); }
DI float rsq_f(float x) { return __builtin_amdgcn_rsqf(x); }
DI float sigmoid_f(float x) { return rcp_f(1.0f + __expf(-x)); }
DI float tanh_fast(float x) { return 1.0f - 2.0f * rcp_f(__expf(2.0f * x) + 1.0f); }
DI float softplus_f(float x) { return fmaxf(x, 0.f) + __logf(1.0f + __expf(-fabsf(x))); }
DI float softplus_fast(float x) { return fmaxf(x, 0.f) + __logf(1.0f + __expf(-fabsf(x))); }
DI float gelu_tanh_f(float x) { const float u = 0.7978845608028654f * (x + 0.044715f * x * x * x); return 0.5f * x * (1.0f + tanh_fast(u)); }
DI float wave_sum(float v) {
#pragma unroll
    for (int o = 1; o < 64; o <<= 1) v += __shfl_xor(v, o);
    return v;
}

struct EpiBf16Plain {
    static constexpr bool PERM = true;
    bf16* O; int ldc; float scale;
    DI void operator()(const f32x4 (&acc)[2][2][4][2], const Unit& u, int wr, int wc, int fr, int fq) const {
        const int row0 = u.pm * 256 + wr * 64 + fr, col0 = u.pn * 256 + wc * 32 + 8 * fq;
#pragma unroll
        for (int ai = 0; ai < 2; ++ai)
#pragma unroll
            for (int m = 0; m < 4; ++m) { bf16* rowp = O + (size_t)(row0 + ai * 128 + m * 16) * ldc + col0;
#pragma unroll
                for (int bj = 0; bj < 2; ++bj) { const f32x4 v0 = acc[ai][bj][m][0] * scale, v1 = acc[ai][bj][m][1] * scale;
                    u32x4 w; w.x = cvt_pk_bf16(v0[0], v0[1]); w.y = cvt_pk_bf16(v0[2], v0[3]); w.z = cvt_pk_bf16(v1[0], v1[1]); w.w = cvt_pk_bf16(v1[2], v1[3]);
                    *(u32x4*)(rowp + bj * 128) = w; } }
    }
};
template <bool RES_BF16> struct EpiBf16Res {
    static constexpr bool PERM = true;
    const void* Rz; bf16* O; int ldc;
    DI void operator()(const f32x4 (&acc)[2][2][4][2], const Unit& u, int wr, int wc, int fr, int fq) const {
        const int row0 = u.pm * 256 + wr * 64 + fr, col0 = u.pn * 256 + wc * 32 + 8 * fq;
#pragma unroll
        for (int ai = 0; ai < 2; ++ai)
#pragma unroll
            for (int m = 0; m < 4; ++m) { const size_t off = (size_t)(row0 + ai * 128 + m * 16) * ldc + col0;
#pragma unroll
                for (int bj = 0; bj < 2; ++bj) { f32x4 r0, r1;
                    if (RES_BF16) { const u32x4 rw = *(const u32x4*)((const bf16*)Rz + off + bj * 128); r0 = (f32x4){bflo(rw.x), bfhi(rw.x), bflo(rw.y), bfhi(rw.y)}; r1 = (f32x4){bflo(rw.z), bfhi(rw.z), bflo(rw.w), bfhi(rw.w)}; }
                    else { r0 = *(const f32x4*)((const float*)Rz + off + bj * 128); r1 = *(const f32x4*)((const float*)Rz + off + bj * 128 + 4); }
                    const f32x4 v0 = r0 + acc[ai][bj][m][0], v1 = r1 + acc[ai][bj][m][1];
                    u32x4 w; w.x = cvt_pk_bf16(v0[0], v0[1]); w.y = cvt_pk_bf16(v0[2], v0[3]); w.z = cvt_pk_bf16(v1[0], v1[1]); w.w = cvt_pk_bf16(v1[2], v1[3]);
                    *(u32x4*)(O + off + bj * 128) = w; } }
    }
};
struct EpiLora {
    static constexpr bool PERM = false;
    float* LWp; bf16* AAp; bf16* GGp; const float* w0; const float* a0;
    DI void operator()(const f32x4 (&acc)[2][2][4][2], const Unit& u, int wr, int wc, int fr, int fq) const {
        const int kind = u.pn >> 1;
        const int row0 = u.pm * 256 + wr * 64 + fr, col0 = (u.pn & 1) * 256 + wc * 32 + 4 * fq;
#pragma unroll
        for (int bj = 0; bj < 2; ++bj)
#pragma unroll
            for (int n = 0; n < 2; ++n) {
                const int c = col0 + bj * 128 + n * 16;
                f32x4 bias = (f32x4){0.f, 0.f, 0.f, 0.f};
                if (kind == 0) bias = *(const f32x4*)(w0 + c); else if (kind == 1) bias = *(const f32x4*)(a0 + c);
#pragma unroll
                for (int ai = 0; ai < 2; ++ai)
#pragma unroll
                    for (int m = 0; m < 4; ++m) {
                        f32x4 v = acc[ai][bj][m][n] + bias;
                        if (kind == 0) {
#pragma unroll
                            for (int j = 0; j < 4; ++j) { const float w = -softplus_fast(-v[j]) - 0.5f; v[j] = -__expf(w);     }
                        } else if (kind == 1) {
#pragma unroll
                            for (int j = 0; j < 4; ++j) v[j] = sigmoid_f(v[j]);
                        }
                        const size_t o_ = (size_t)(row0 + ai * 128 + m * 16) * 512 + c;
                        if (kind == 0) *(f32x4*)(LWp + o_) = v;
                        else { u32x2 w_; w_.x = cvt_pk_bf16(v[0], v[1]); w_.y = cvt_pk_bf16(v[2], v[3]); *(u32x2*)((kind == 1 ? AAp : GGp) + o_) = w_; }
                    }
            }
    }
};
struct EpiSwiglu {
    static constexpr bool PERM = true;
    bf16* ACT; const float* b_gu;
    DI void operator()(const f32x4 (&acc)[2][2][4][2], const Unit& u, int wr, int wc, int fr, int fq) const {
        const int row0 = u.pm * 256 + wr * 64 + fr, j0 = u.pn * 128 + wc * 32 + 8 * fq;
        const float* bg = b_gu + (size_t)u.e * 2048 + j0; const float* bu = bg + 1024;
        const f32x4 bg0 = *(const f32x4*)bg, bg1 = *(const f32x4*)(bg + 4), bu0 = *(const f32x4*)bu, bu1 = *(const f32x4*)(bu + 4);
#pragma unroll
        for (int ai = 0; ai < 2; ++ai)
#pragma unroll
            for (int m = 0; m < 4; ++m) {
                float o[8];
#pragma unroll
                for (int n = 0; n < 2; ++n) { const f32x4 g4 = acc[ai][0][m][n] + (n ? bg1 : bg0), u4 = acc[ai][1][m][n] + (n ? bu1 : bu0);
#pragma unroll
                    for (int j = 0; j < 4; ++j) { const float g = fminf(g4[j], 7.0f), up = fminf(fmaxf(u4[j], -7.0f), 7.0f); o[n * 4 + j] = (up + 1.0f) * (g * sigmoid_f(1.702f * g)); } }
                u32x4 w; w.x = cvt_pk_bf16(o[0], o[1]); w.y = cvt_pk_bf16(o[2], o[3]); w.z = cvt_pk_bf16(o[4], o[5]); w.w = cvt_pk_bf16(o[6], o[7]);
                *(u32x4*)(ACT + (size_t)(row0 + ai * 128 + m * 16) * 1024 + j0) = w;
            }
    }
};
struct EpiDown {
    static constexpr bool PERM = true;
    bf16* YS; const float* b_dn; const int* row_slot; const float* row_gate;
    DI void operator()(const f32x4 (&acc)[2][2][4][2], const Unit& u, int wr, int wc, int fr, int fq) const {
        const int row0 = u.pm * 256 + wr * 64 + fr, col0 = u.pn * 256 + wc * 32 + 8 * fq;
        const float* bb = b_dn + (size_t)u.e * 1024 + col0;
        f32x4 bv[2][2];
#pragma unroll
        for (int bj = 0; bj < 2; ++bj)
#pragma unroll
            for (int n = 0; n < 2; ++n) bv[bj][n] = *(const f32x4*)(bb + bj * 128 + 4 * n);
#pragma unroll
        for (int ai = 0; ai < 2; ++ai)
#pragma unroll
            for (int m = 0; m < 4; ++m) {
                const int r = row0 + ai * 128 + m * 16; const int slot = row_slot[r]; const float gt = row_gate[r];
                if (slot >= 0) { bf16* rowp = YS + (size_t)slot * 1024 + col0;
#pragma unroll
                    for (int bj = 0; bj < 2; ++bj) { const f32x4 v0 = (acc[ai][bj][m][0] + bv[bj][0]) * gt, v1 = (acc[ai][bj][m][1] + bv[bj][1]) * gt;
                        u32x4 w; w.x = cvt_pk_bf16(v0[0], v0[1]); w.y = cvt_pk_bf16(v0[2], v0[3]); w.z = cvt_pk_bf16(v1[0], v1[1]); w.w = cvt_pk_bf16(v1[2], v1[3]);
                        *(u32x4*)(rowp + bj * 128) = w; } }
            }
    }
};

constexpr size_t MiB = 1u << 20;
constexpr size_t WS_CTL = 0, CTL_ZERO_BYTES = 1 * MiB;
constexpr size_t WS_WIN = 1 * MiB, WS_WOUT = 7 * MiB, WS_WQ = 9 * MiB, WS_WK = 11 * MiB, WS_WV = 13 * MiB, WS_WO = 15 * MiB, WS_LORAB = 17 * MiB, WS_LRUW = 18 * MiB;
constexpr size_t WS_ROUTE = 19 * MiB;
constexpr size_t WS_WGU = 22 * MiB, WS_WDN = 150 * MiB;
constexpr size_t WS_HN = 214 * MiB, WS_MEMN = 246 * MiB, WS_KM = 248 * MiB, WS_VT = 250 * MiB;
constexpr size_t WS_X1 = 252 * MiB, WS_X2 = 316 * MiB;
constexpr size_t WS_U = 380 * MiB, WS_R = 468 * MiB, WS_KRAW = 500 * MiB, WS_V = 532 * MiB, WS_KKN = 564 * MiB, WS_WD = 596 * MiB, WS_AA = 628 * MiB, WS_G = 660 * MiB;
constexpr size_t WS_LA = 692 * MiB, WS_LB = 724 * MiB, WS_AP = 756 * MiB, WS_CAT = 764 * MiB, WS_Q = 796 * MiB;
constexpr size_t WS_XS = 380 * MiB, WS_ACT = 524 * MiB, WS_YS = 668 * MiB;
constexpr size_t WS_GP = 796 * MiB, WS_HF = 860 * MiB, WS_RP = 924 * MiB, WS_Y1F = 940 * MiB, WS_ADD = 972 * MiB, WS_END = 1004 * MiB;
constexpr size_t WS_GC = 468 * MiB, WS_HC = 484 * MiB, WS_ZS = 500 * MiB;
static_assert(WS_AA == WS_WD + 32 * MiB && WS_G == WS_AA + 32 * MiB, "EpiLora strides");
static_assert(WS_U + (size_t)M * INW * 2 <= WS_R && WS_XS + (size_t)MAXROWS * 2048 <= WS_ACT && WS_ACT + (size_t)MAXROWS * 2048 <= WS_YS && WS_YS + (size_t)NASSIGN * 2048 <= WS_Q, "ws map");
constexpr size_t RT_E = 0, RT_POS = 256 * 1024, RT_G = 512 * 1024, RT_SLOT = 768 * 1024, RT_GATE = 1088 * 1024, RT_TILE = 1408 * 1024, RT_TOK = 1472 * 1024;
constexpr int CW_BAR = 4096, CW_CNT = 8192;

constexpr int RING_BYTES = 131072, MISC_OFF = RING_BYTES + 320, LDS_BYTES = 147456;
constexpr int NWAVES = 8, NTHREADS = 512;

#define XB_TMO      128
#define XB_XCNT(j)  (256  + 64 * (j))
#define XB_XSUB(j)  (1280 + 64 * (j))
#define XB_XGEN(j)  (2304 + 64 * (j))
#define XB_TOP      3328
#define XB_TOPGEN   3392
#define XCD_BAR_WORDS 3456
#define XB_SPIN_CAP (1u << 18)
DI unsigned xb_ld(unsigned* p)              { return __hip_atomic_load(p, __ATOMIC_RELAXED, __HIP_MEMORY_SCOPE_AGENT); }
DI unsigned xb_add(unsigned* p, unsigned v) { return __hip_atomic_fetch_add(p, v, __ATOMIC_RELAXED, __HIP_MEMORY_SCOPE_AGENT); }
DI unsigned xb_xcc_id() { return (unsigned)__builtin_amdgcn_s_getreg((3 << 11) | 20) & 0xFu; }
#define XB_SPIN(cond, bar) do { unsigned _sp = 0; while (cond) { __builtin_amdgcn_s_sleep(1); \
    if ((++_sp & 255u) == 0u) { if (xb_ld(&(bar)[XB_TMO])) break; if (_sp > XB_SPIN_CAP) { atomicAdd(&(bar)[XB_TMO], 1u); break; } } } } while (0)
struct XcdBarrier { unsigned* bar; unsigned x; volatile LAS unsigned* st; };
DI XcdBarrier xcd_barrier_post(unsigned* bar, volatile LAS unsigned* st) {
    XcdBarrier b; b.bar = bar; b.x = xb_xcc_id(); b.st = st;
    if (threadIdx.x == 0) (void)xb_add(&bar[XB_XCNT(b.x)], 1u);
    return b;
}
DI void xcd_barrier_complete(unsigned* bar, unsigned x, unsigned& nloc, unsigned& nx) {
    const unsigned G = gridDim.x * gridDim.y * gridDim.z;
    unsigned sum, cnt, mine, sp = 0u;
    for (;;) {
        sum = 0u; cnt = 0u; mine = 0u;
#pragma unroll
        for (unsigned j = 0; j < 16; ++j) { const unsigned c = xb_ld(&bar[XB_XCNT(j)]); sum += c; cnt += (c > 0u) ? 1u : 0u; mine = (j == x) ? c : mine; }
        if (sum == G) break;
        __builtin_amdgcn_s_sleep(1);
        if ((++sp & 255u) == 0u) { if (xb_ld(&bar[XB_TMO])) break; if (sp > XB_SPIN_CAP) { atomicAdd(&bar[XB_TMO], 1u); break; } }
    }
    nloc = mine > 0u ? mine : 1u; nx = cnt > 0u ? cnt : 1u;
}
DI void xcd_barrier(const XcdBarrier& b) {
    asm volatile("s_waitcnt vmcnt(0)" ::: "memory");
    __syncthreads();
    if (threadIdx.x == 0) {
        unsigned* bar = b.bar;
        __builtin_amdgcn_s_waitcnt(0);
        unsigned nloc = b.st[0], nx = b.st[1];
        if (nloc == 0u) { xcd_barrier_complete(bar, b.x, nloc, nx); b.st[0] = nloc; b.st[1] = nx; }
        const unsigned old = xb_add(&bar[XB_XSUB(b.x)], 1u);
        const unsigned gen = old / nloc;
        if (old + 1u == (gen + 1u) * nloc) {
            __builtin_amdgcn_fence(__ATOMIC_RELEASE, "agent");
            asm volatile("s_waitcnt vmcnt(0)" ::: "memory");
            const unsigned og = xb_add(&bar[XB_TOP], 1u);
            const unsigned tg = og / nx;
            if (og + 1u == (tg + 1u) * nx) xb_add(&bar[XB_TOPGEN], 1u);
            else XB_SPIN(xb_ld(&bar[XB_TOPGEN]) == tg, bar);
            __builtin_amdgcn_fence(__ATOMIC_ACQUIRE, "agent");
            xb_add(&bar[XB_XGEN(b.x)], 1u);
            asm volatile("s_waitcnt vmcnt(0)" ::: "memory");
        } else {
            XB_SPIN(xb_ld(&bar[XB_XGEN(b.x)]) == gen, bar);
            __builtin_amdgcn_fence(__ATOMIC_ACQUIRE, "agent");
            asm volatile("s_waitcnt vmcnt(0)" ::: "memory");
        }
    }
    __syncthreads();
}

struct Args { const float* in[37]; float* out; unsigned char* ws; int ph_lo, ph_hi; };
enum { I_X = 0, I_MEM, I_NMIXG, I_WIN, I_CONVW, I_CONVB, I_LWX, I_LBX, I_LWA, I_LBA, I_LAM, I_MU, I_W0, I_WUP, I_A0, I_AUP, I_GUP, I_KK, I_KA, I_RK, I_LNG, I_LNB,
       I_WOUT, I_NXAG, I_NMEMG, I_WQ, I_WK, I_WV, I_WO, I_NFFG, I_WR, I_BR, I_WGU, I_BGU, I_WDN, I_BDN, I_FNG };

DI void transpose_item(const float* W, int ldw, int K, bf16* WT, int k0, int n0, int drow0, LAS float* scr, int lane) {
    f32x4 t[8];
    const float* src = W + (size_t)(k0 + (lane >> 3)) * ldw + n0 + 4 * (lane & 7);
#pragma unroll
    for (int i = 0; i < 8; ++i) t[i] = *(const f32x4*)(src + (size_t)(8 * i) * ldw);
#pragma unroll
    for (int i = 0; i < 8; ++i) { LAS float* d = scr + (8 * i + (lane >> 3)) * 33 + 4 * (lane & 7); d[0] = t[i].x; d[1] = t[i].y; d[2] = t[i].z; d[3] = t[i].w; }
    asm volatile("s_waitcnt lgkmcnt(0)" ::: "memory");
    const int c = lane & 7;
#pragma unroll
    for (int j = 0; j < 4; ++j) { const int n = (lane >> 3) + 8 * j; const LAS float* s = scr + (8 * c) * 33 + n;
        u32x4 o; o.x = pk2(s[0 * 33], s[1 * 33]); o.y = pk2(s[2 * 33], s[3 * 33]); o.z = pk2(s[4 * 33], s[5 * 33]); o.w = pk2(s[6 * 33], s[7 * 33]);
        *(u32x4*)(WT + (size_t)(drow0 + n) * K + k0 + 8 * c) = o; }
    asm volatile("s_waitcnt lgkmcnt(0)" ::: "memory");
}
DI void transpose_item_tiled(const float* W, int ldw, int K, bf16* WTe, int k0, int n0, int drow0, LAS float* scr, int lane) {
    f32x4 t[8];
    const float* src = W + (size_t)(k0 + (lane >> 3)) * ldw + n0 + 4 * (lane & 7);
#pragma unroll
    for (int i = 0; i < 8; ++i) t[i] = *(const f32x4*)(src + (size_t)(8 * i) * ldw);
#pragma unroll
    for (int i = 0; i < 8; ++i) { LAS float* d = scr + (8 * i + (lane >> 3)) * 33 + 4 * (lane & 7); d[0] = t[i].x; d[1] = t[i].y; d[2] = t[i].z; d[3] = t[i].w; }
    asm volatile("s_waitcnt lgkmcnt(0)" ::: "memory");
    const int c = lane & 7;
#pragma unroll
    for (int j = 0; j < 4; ++j) { const int n = (lane >> 3) + 8 * j; const LAS float* s = scr + (8 * c) * 33 + n;
        u32x4 o; o.x = pk2(s[0 * 33], s[1 * 33]); o.y = pk2(s[2 * 33], s[3 * 33]); o.z = pk2(s[4 * 33], s[5 * 33]); o.w = pk2(s[6 * 33], s[7 * 33]);
        const int drow = drow0 + n, pn = drow >> 8, half = (drow >> 7) & 1, r = drow & 127, x = r & 31;
        const int rslot = (r & ~31) + 16 * ((x >> 2) & 1) + 4 * (x >> 3) + (x & 3);
        const size_t tb = ((size_t)(pn * (K / 64) + (k0 >> 6)) * 2 + half) * 16384 + pg8::lds_byte(rslot, 8 * c);
        *(u32x4*)((char*)WTe + tb) = o; }
    asm volatile("s_waitcnt lgkmcnt(0)" ::: "memory");
}
DI void rms_row_to_bf16(const float* xrow, const float* g, bf16* orow, int lane) {
    const f32x4* xr = (const f32x4*)xrow + lane; const f32x4* gr = (const f32x4*)g + lane;
    f32x4 v[4]; float s = 0.f;
#pragma unroll
    for (int j = 0; j < 4; ++j) { v[j] = xr[64 * j]; s += (v[j].x * v[j].x + v[j].y * v[j].y) + (v[j].z * v[j].z + v[j].w * v[j].w); }
    const float rstd = rsq_f(wave_sum(s) * (1.f / D) + EPS);
    u32x2* o8 = (u32x2*)orow + lane;
#pragma unroll
    for (int j = 0; j < 4; ++j) { const f32x4 gg = gr[64 * j]; u32x2 w; w.x = pk2(v[j].x * rstd * gg.x, v[j].y * rstd * gg.y); w.y = pk2(v[j].z * rstd * gg.z, v[j].w * rstd * gg.w); o8[64 * j] = w; }
}

DI void rms_rowbf_to_bf16(const bf16* xrow, const float* g, bf16* orow, int lane) {
    float v[16]; float s = 0.f;
#pragma unroll
    for (int hf = 0; hf < 2; ++hf) { const u32x4 w = *(const u32x4*)(xrow + 512 * hf + 8 * lane);
#pragma unroll
        for (int q = 0; q < 4; ++q) { v[8 * hf + 2 * q] = bflo(w[q]); v[8 * hf + 2 * q + 1] = bfhi(w[q]); } }
#pragma unroll
    for (int j = 0; j < 16; ++j) s += v[j] * v[j];
    const float rstd = rsq_f(wave_sum(s) * (1.f / D) + EPS);
#pragma unroll
    for (int hf = 0; hf < 2; ++hf) { const f32x4 g0 = *(const f32x4*)(g + 512 * hf + 8 * lane), g1 = *(const f32x4*)(g + 512 * hf + 8 * lane + 4);
        u32x4 w; w.x = pk2(v[8 * hf] * rstd * g0.x, v[8 * hf + 1] * rstd * g0.y); w.y = pk2(v[8 * hf + 2] * rstd * g0.z, v[8 * hf + 3] * rstd * g0.w);
        w.z = pk2(v[8 * hf + 4] * rstd * g1.x, v[8 * hf + 5] * rstd * g1.y); w.w = pk2(v[8 * hf + 6] * rstd * g1.z, v[8 * hf + 7] * rstd * g1.w);
        *(u32x4*)(orow + 512 * hf + 8 * lane) = w; }
}

__global__ void __launch_bounds__(NTHREADS, 2) fwd(Args args) {
    extern __shared__ __attribute__((aligned(16))) unsigned char lds_raw[];
    LAS unsigned char* lds = (LAS unsigned char*)lds_raw;
    volatile LAS unsigned* MISC = (volatile LAS unsigned*)(lds + MISC_OFF);
    const int G = gridDim.x, bid = blockIdx.x, NGW = G * NWAVES;
#define PHASE_IDS const int tid = fresh_tid(), lane = tid & 63, wave = __builtin_amdgcn_readfirstlane(tid >> 6), gw = bid * NWAVES + wave; (void)tid; (void)lane; (void)wave; (void)gw
    unsigned char* ws = args.ws;
    unsigned* ctl = (unsigned*)(ws + WS_CTL);
    const int lo = args.ph_lo, hi = args.ph_hi;

    for (int u = threadIdx.x; u < (LDS_BYTES - RING_BYTES) / 4; u += NTHREADS) ((LAS unsigned*)(lds + RING_BYTES))[u] = 0u;
    __syncthreads();
    XcdBarrier bar; bar.bar = ctl + CW_BAR; bar.x = 0; bar.st = nullptr;
    if (hi - lo > 1) bar = xcd_barrier_post(ctl + CW_BAR, MISC + 8);
#define IN(k) (lo <= (k) && (k) < hi)
#define SEAM(k) do { if (IN(k) && IN((k) + 1)) xcd_barrier(bar); } while (0)

#define Win_t ((bf16*)(ws + WS_WIN))
#define Wout_t ((bf16*)(ws + WS_WOUT))
#define Wq_t ((bf16*)(ws + WS_WQ))
#define Wk_t ((bf16*)(ws + WS_WK))
#define Wv_t ((bf16*)(ws + WS_WV))
#define Wo_t ((bf16*)(ws + WS_WO))
#define LoraB ((bf16*)(ws + WS_LORAB))
#define LruW ((bf16*)(ws + WS_LRUW))
#define WrT ((bf16*)(ws + WS_LRUW + 512 * 1024))
#define Wgu_t ((bf16*)(ws + WS_WGU))
#define Wdn_t ((bf16*)(ws + WS_WDN))
#define HN ((bf16*)(ws + WS_HN))
#define MEMN ((bf16*)(ws + WS_MEMN))
#define KM ((bf16*)(ws + WS_KM))
#define VT ((bf16*)(ws + WS_VT))
#define X1 ((bf16*)(ws + WS_X1))
#define X2 ((bf16*)(ws + WS_X2))
#define U ((bf16*)(ws + WS_U))
#define Rr ((float*)(ws + WS_R))
#define KRAW ((float*)(ws + WS_KRAW))
#define Vv ((float*)(ws + WS_V))
#define KKN ((float*)(ws + WS_KKN))
#define WD ((float*)(ws + WS_WD))
#define AA ((float*)(ws + WS_AA))
#define GG ((float*)(ws + WS_G))
#define LA ((bf16*)(ws + WS_LA))
#define LB ((bf16*)(ws + WS_LB))
#define AP ((bf16*)(ws + WS_AP))
#define CAT ((bf16*)(ws + WS_CAT))
#define Qb ((bf16*)(ws + WS_Q))
#define Ob CAT
#define XS ((bf16*)(ws + WS_XS))
#define ACT ((bf16*)(ws + WS_ACT))
#define YS ((bf16*)(ws + WS_YS))
#define route_e ((int*)(ws + WS_ROUTE + RT_E))
#define route_pos ((int*)(ws + WS_ROUTE + RT_POS))
#define route_g ((float*)(ws + WS_ROUTE + RT_G))
#define row_slot ((int*)(ws + WS_ROUTE + RT_SLOT))
#define row_gate ((float*)(ws + WS_ROUTE + RT_GATE))
#define tile_tab ((int*)(ws + WS_ROUTE + RT_TILE))
#define row_tok ((int*)(ws + WS_ROUTE + RT_TOK))
#define ecnt (ctl + CW_CNT)

    if (IN(0)) { PHASE_IDS;
        LAS float* scr = (LAS float*)(lds + wave * 16384);
        constexpr int I_IN = 16 * (INW / 32), I_SQ = 16 * 32;
        constexpr int N_ITEMS = I_IN + 5 * I_SQ;
        for (int it = gw; it < N_ITEMS; it += NGW) {
            int r = it;
            if (r < I_IN) { const int nblk = INW / 32, kb = r / nblk, nb = r % nblk; transpose_item(args.in[I_WIN], INW, D, Win_t, 64 * kb, 32 * nb, 32 * nb, scr, lane); continue; } r -= I_IN;
            { const int w = r / I_SQ, q = r % I_SQ, kb = q / 32, nb = q % 32;
                const float* src = w == 0 ? args.in[I_WOUT] : w == 1 ? args.in[I_WQ] : w == 2 ? args.in[I_WK] : w == 3 ? args.in[I_WV] : args.in[I_WO];
                bf16* dst = w == 0 ? Wout_t : w == 1 ? Wq_t : w == 2 ? Wk_t : w == 3 ? Wv_t : Wo_t;
                transpose_item(src, D, D, dst, 64 * kb, 32 * nb, 32 * nb, scr, lane); }
        }
        for (int idx = bid * NTHREADS + tid; idx < 1536 * 256; idx += G * NTHREADS) {
            const int n = idx >> 8, k = idx & 255; float v = 0.f;
            if (n < 512) { if (k < 64) v = args.in[I_WUP][k * 512 + n]; }
            else if (n < 1024) { if (k >= 64 && k < 128) v = args.in[I_AUP][(k - 64) * 512 + (n - 512)]; }
            else { if (k >= 128) v = args.in[I_GUP][(k - 128) * 512 + (n - 1024)]; }
            LoraB[idx] = (bf16)f2bf(v);
        }
        for (int idx = bid * NTHREADS + tid; idx < 8 * 128 * 64; idx += G * NTHREADS) {
            const int nb = idx >> 13, col = (idx >> 6) & 127, k = idx & 63;
            const float v = col < 64 ? args.in[I_LWX][nb * 4096 + k * 64 + col] : args.in[I_LWA][nb * 4096 + k * 64 + (col - 64)];
            LruW[idx] = (bf16)f2bf(v);
        }
        for (int idx = bid * NTHREADS + tid; idx < NE * D; idx += G * NTHREADS) {
            const int e = idx >> 10, k = idx & 1023; const float v = args.in[I_WR][k * NE + e];
            const unsigned hi = f2bf(v); const float lo = v - __uint_as_float(hi << 16);
            WrT[idx] = (bf16)hi; WrT[NE * D + idx] = (bf16)f2bf(lo);
        }
        for (int m = gw; m < M; m += NGW) rms_row_to_bf16(args.in[I_X] + (size_t)m * D, args.in[I_NMIXG], HN + (size_t)m * D, lane);
        for (int m = gw; m < MROWS; m += NGW) rms_row_to_bf16(args.in[I_MEM] + (size_t)m * D, args.in[I_NMEMG], MEMN + (size_t)m * D, lane);
        {
            LAS float* scr = (LAS float*)(lds + wave * 16384);
            constexpr int I_GU = 16 * 64, I_DN = 16 * 32;
            for (int it = gw; it < NE * (I_GU + I_DN); it += NGW) {
                int r = it;
                if (r < NE * I_GU) { const int e = r / I_GU, q = r % I_GU, kb = q / 64, nb = q % 64; const int n0 = 32 * nb;
                    const int drow = n0 < 1024 ? (256 * (n0 >> 7) + (n0 & 127)) : (256 * ((n0 - 1024) >> 7) + 128 + ((n0 - 1024) & 127));
                    transpose_item_tiled(args.in[I_WGU] + (size_t)e * D * 2048, 2048, D, Wgu_t + (size_t)e * 2048 * D, 64 * kb, n0, drow, scr, lane); continue; } r -= NE * I_GU;
                { const int e = r / I_DN, q = r % I_DN, kb = q / 32, nb = q % 32;
                  transpose_item_tiled(args.in[I_WDN] + (size_t)e * DFF * D, D, DFF, Wdn_t + (size_t)e * D * DFF, 64 * kb, 32 * nb, 32 * nb, scr, lane); }
            }
        }
    }
    SEAM(0);

    if (IN(1)) { PHASE_IDS;
        { pg8::DenseSched S; S.o.init_tiles(M / 256, INW / 256, G, bid); S.A = (const char*)HN; S.B = (const char*)Win_t; S.tstep = (size_t)256 * D * 2;
          EpiBf16Plain E{U, INW, 1.0f}; pg8::gemm_phase(lds, D, S, E); }
        { pg8::DenseSched S; S.o.init_tiles(MROWS / 256, D / 256, G, (bid + 64) & (G - 1)); S.A = (const char*)MEMN; S.B = (const char*)Wk_t; S.tstep = (size_t)256 * D * 2;
          EpiBf16Plain E{KM, D, 1.0f}; pg8::gemm_phase(lds, D, S, E); }
        { pg8::DenseSched S; S.o.init_tiles(D / 256, MROWS / 256, G, (bid + 48) & (G - 1)); S.A = (const char*)Wv_t; S.B = (const char*)MEMN; S.tstep = (size_t)256 * D * 2;
          EpiBf16Plain E{VT, MROWS, 1.0f}; pg8::gemm_phase(lds, D, S, E); }
    }
    SEAM(1);

    if (IN(2)) { PHASE_IDS;
        {
            const float* conv_w = args.in[I_CONVW]; const float* conv_b = args.in[I_CONVB]; const float* bx = args.in[I_LBX]; const float* ba = args.in[I_LBA]; const float* lam = args.in[I_LAM];
            LAS float* xs = (LAS float*)(lds + wave * 4096);
            const int i = lane & 15, kg = lane >> 4;
            for (int unit = gw; unit < (M / 16) * 2; unit += NGW) {
                const int tile = unit >> 1, nb0 = (unit & 1) * 4, m0 = tile * 16, s0 = m0 & (SEQ - 1);
                for (int nb = nb0; nb < nb0 + 4; ++nb) {
                    bf16x8 af[2];
#pragma unroll
                    for (int ks = 0; ks < 2; ++ks) {
                        const int chb = nb * 64 + 32 * ks + 8 * kg;
                        f32x4 x0 = *(const f32x4*)(conv_b + chb), x1 = *(const f32x4*)(conv_b + chb + 4);
#pragma unroll
                        for (int j = 0; j < 4; ++j) {
                            if (s0 + i - 3 + j >= 0) {
                                const u32x4 uw = *(const u32x4*)(U + (size_t)(m0 + i - 3 + j) * INW + chb);
                                const f32x4 w0 = *(const f32x4*)(conv_w + j * 512 + chb), w1 = *(const f32x4*)(conv_w + j * 512 + chb + 4);
                                x0.x += w0.x * bflo(uw.x); x0.y += w0.y * bfhi(uw.x); x0.z += w0.z * bflo(uw.y); x0.w += w0.w * bfhi(uw.y);
                                x1.x += w1.x * bflo(uw.z); x1.y += w1.y * bfhi(uw.z); x1.z += w1.z * bflo(uw.w); x1.w += w1.w * bfhi(uw.w);
                            }
                        }
                        *(LAS f32x4*)(xs + i * 64 + 32 * ks + 8 * kg) = x0; *(LAS f32x4*)(xs + i * 64 + 32 * ks + 8 * kg + 4) = x1;
                        u32x4 p; p.x = pk2(x0.x, x0.y); p.y = pk2(x0.z, x0.w); p.z = pk2(x1.x, x1.y); p.w = pk2(x1.z, x1.w);
                        af[ks] = __builtin_bit_cast(bf16x8, p);
                    }
                    f32x4 acc[8];
#pragma unroll
                    for (int ct = 0; ct < 8; ++ct) { acc[ct] = (f32x4){0.f, 0.f, 0.f, 0.f};
#pragma unroll
                        for (int ks = 0; ks < 2; ++ks) { const bf16x8 bfr = *(const bf16x8*)(LruW + ((size_t)(nb * 128 + 16 * ct + i) * 64 + 32 * ks + 8 * kg));
                            acc[ct] = __builtin_amdgcn_mfma_f32_16x16x32_bf16(af[ks], bfr, acc[ct], 0, 0, 0); } }
                    asm volatile("s_waitcnt lgkmcnt(0)" ::: "memory");
#pragma unroll
                    for (int ct = 0; ct < 4; ++ct) {
                        const int col = 16 * ct + i, ch = nb * 64 + col;
                        const float bxv = bx[ch], bav = ba[ch], sp = softplus_f(-lam[ch]);
#pragma unroll
                        for (int e = 0; e < 4; ++e) {
                            const int tok = 4 * kg + e;
                            const float gx = sigmoid_f(acc[ct][e] + bxv), ga = sigmoid_f(acc[ct + 4][e] + bav);
                            const float la = -8.0f * ga * sp, xcv = xs[tok * 64 + col];
                            const float bt = __builtin_amdgcn_sqrtf(fmaxf(1.0f - __expf(2.0f * la), 0.f)) * gx * xcv;
                            LA[(size_t)(m0 + tok) * 512 + ch] = (bf16)f2bf(la); LB[(size_t)(m0 + tok) * 512 + ch] = (bf16)f2bf(bt);
                        }
                    }
                }
            }
        }
    }
    SEAM(2);


#define RW_ZB(zz, zb) do { _Pragma("unroll") for (int ks_ = 0; ks_ < 2; ++ks_) { u32x4 p_; p_.x = pk2(zz[2 * ks_][0], zz[2 * ks_][1]); p_.y = pk2(zz[2 * ks_][2], zz[2 * ks_][3]); \
        p_.z = pk2(zz[2 * ks_ + 1][0], zz[2 * ks_ + 1][1]); p_.w = pk2(zz[2 * ks_ + 1][2], zz[2 * ks_ + 1][3]); zb[ks_] = __builtin_bit_cast(bf16x8, p_); } } while (0)
    if (IN(3)) { PHASE_IDS;
        for (int u64 = gw; u64 < NB * NH * (SEQ / 64); u64 += NGW) {
#pragma unroll 1
        for (int jj = 0; jj < 4; ++jj) {
        LAS unsigned char* wl = lds + wave * 16384;
        LAS bf16* Arm = (LAS bf16*)(wl); LAS bf16* Brm = (LAS bf16*)(wl + 2048); LAS bf16* Krm = (LAS bf16*)(wl + 4096); LAS bf16* Rrm = (LAS bf16*)(wl + 6144);
        LAS bf16* ATt = (LAS bf16*)(wl + 8192); LAS bf16* BTt = (LAS bf16*)(wl + 10240); LAS bf16* KTt = (LAS bf16*)(wl + 12288); LAS bf16* VTt = (LAS bf16*)(wl + 14336);
        LAS float* MabT = (LAS float*)(wl); LAS bf16* Mak = (LAS bf16*)(wl + 1024); LAS bf16* Mrb = (LAS bf16*)(wl + 1536); LAS bf16* Mrk = (LAS bf16*)(wl + 2048); LAS bf16* Tm = (LAS bf16*)(wl + 2560);
        LAS float* PLs = (LAS float*)(wl + 3072); LAS bf16* Q0T = (LAS bf16*)(wl + 4096);
        const int lane = fresh_tid() & 63, l15 = lane & 15, g = lane >> 4, te = lane >> 2, kq = lane & 3;
        const bf16x8 z8 = (bf16x8){0, 0, 0, 0, 0, 0, 0, 0};
        const f32x4 z4 = (f32x4){0.f, 0.f, 0.f, 0.f};
            const int un = u64 * 4 + jj;
            const int bh = un >> 8, c = un & 255, b = bh >> 3, h = bh & 7;
            const size_t mrow = (size_t)b * SEQ + c * 16 + te, off = mrow * 512 + h * 64 + 16 * kq;
            const int hc = h * 64 + 16 * kq;
            LAS float* tmpL = (LAS float*)wl;
            {
                const size_t mr = (size_t)b * SEQ + c * 16 + l15; const bool hp2 = (mr & (SEQ - 1)) != 0;
                const bf16* ua = U + mr * INW + 2560 + 8 * g;
                bf16x8 af[8];
#pragma unroll
                for (int ks = 0; ks < 8; ++ks) {
                    const u32x4 cu = *(const u32x4*)(ua + 32 * ks); u32x4 pu = (u32x4){0u, 0u, 0u, 0u}; if (hp2) pu = *(const u32x4*)(ua - INW + 32 * ks);
                    const f32x4 m0 = *(const f32x4*)(args.in[I_MU] + 1536 + 32 * ks + 8 * g), m1 = *(const f32x4*)(args.in[I_MU] + 1536 + 32 * ks + 8 * g + 4);
                    float o8[8];
#pragma unroll
                    for (int q = 0; q < 4; ++q) { const float c0 = bflo(cu[q]), c1 = bfhi(cu[q]), p0 = bflo(pu[q]), p1 = bfhi(pu[q]); const float mm0 = q < 2 ? m0[2 * q] : m1[2 * q - 4], mm1 = q < 2 ? m0[2 * q + 1] : m1[2 * q - 3];
                        float x0 = c0 + (p0 - c0) * mm0, x1 = c1 + (p1 - c1) * mm1;
                        if (ks < 2) { x0 = tanh_fast(x0); x1 = tanh_fast(x1); }
                        else if (ks >= 4) { x0 = sigmoid_f(x0); x1 = sigmoid_f(x1); }
                        o8[2 * q] = x0; o8[2 * q + 1] = x1; }
                    u32x4 pw; pw.x = pk2(o8[0], o8[1]); pw.y = pk2(o8[2], o8[3]); pw.z = pk2(o8[4], o8[5]); pw.w = pk2(o8[6], o8[7]); af[ks] = __builtin_bit_cast(bf16x8, pw);
                }
#pragma unroll
                for (int kind = 0; kind < 3; ++kind)
#pragma unroll
                    for (int ct = 0; ct < 4; ++ct) {
                        const bf16* lb = LoraB + (size_t)(kind * 512 + h * 64 + 16 * ct + l15) * 256 + 8 * g;
                        f32x4 a4 = z4;
#pragma unroll
                        for (int ks = (kind == 0 ? 0 : kind == 1 ? 2 : 4); ks < (kind == 0 ? 2 : kind == 1 ? 4 : 8); ++ks) a4 = __builtin_amdgcn_mfma_f32_16x16x32_bf16(af[ks], *(const bf16x8*)(lb + 32 * ks), a4, 0, 0, 0);
#pragma unroll
                        for (int e = 0; e < 4; ++e) tmpL[kind * 1088 + (4 * g + e) * 68 + 16 * ct + l15] = a4[e];
                    }
            }
            asm volatile("s_waitcnt lgkmcnt(0)" ::: "memory");
            float cl[16], eP[16];
            {
                float lwv[16], rl[16], kl[16], vl[16], kn[16], av[16];
                const bool hp = (mrow & (SEQ - 1)) != 0;
                const bf16* ub = U + mrow * INW + 1024 + hc;
#pragma unroll
                for (int hh = 0; hh < 2; ++hh) {
#pragma unroll
                    for (int a3 = 0; a3 < 3; ++a3) {
                        const u32x4 cu = *(const u32x4*)(ub + 512 * a3 + 8 * hh); u32x4 pu = (u32x4){0u, 0u, 0u, 0u}; if (hp) pu = *(const u32x4*)(ub - INW + 512 * a3 + 8 * hh);
                        const f32x4 m0 = *(const f32x4*)(args.in[I_MU] + 512 * a3 + hc + 8 * hh), m1 = *(const f32x4*)(args.in[I_MU] + 512 * a3 + hc + 8 * hh + 4);
                        float o8[8];
#pragma unroll
                        for (int q = 0; q < 4; ++q) { const float c0 = bflo(cu[q]), c1 = bfhi(cu[q]), p0 = bflo(pu[q]), p1 = bfhi(pu[q]); const float mm0 = q < 2 ? m0[2 * q] : m1[2 * q - 4], mm1 = q < 2 ? m0[2 * q + 1] : m1[2 * q - 3];
                            o8[2 * q] = c0 + (p0 - c0) * mm0; o8[2 * q + 1] = c1 + (p1 - c1) * mm1; }
#pragma unroll
                        for (int q = 0; q < 8; ++q) { if (a3 == 0) rl[8 * hh + q] = o8[q]; else if (a3 == 1) kl[8 * hh + q] = o8[q]; else vl[8 * hh + q] = o8[q]; }
                    }
                }
                float gv[16];
#pragma unroll
                for (int j4 = 0; j4 < 4; ++j4) { const f32x4 xl = *(const LAS f32x4*)(tmpL + te * 68 + 16 * kq + 4 * j4), xa = *(const LAS f32x4*)(tmpL + 1088 + te * 68 + 16 * kq + 4 * j4), xg = *(const LAS f32x4*)(tmpL + 2176 + te * 68 + 16 * kq + 4 * j4);
                    const f32x4 w0v = *(const f32x4*)(args.in[I_W0] + hc + 4 * j4), a0v = *(const f32x4*)(args.in[I_A0] + hc + 4 * j4);
#pragma unroll
                    for (int q = 0; q < 4; ++q) { const float wq = -softplus_fast(-(xl[q] + w0v[q])) - 0.5f; lwv[4 * j4 + q] = -__expf(wq); av[4 * j4 + q] = sigmoid_f(xa[q] + a0v[q]); gv[4 * j4 + q] = xg[q]; } }
                asm volatile("s_waitcnt lgkmcnt(0)" ::: "memory");
                float ss = 0.f;
#pragma unroll
                for (int j4 = 0; j4 < 4; ++j4) { const f32x4 kk4 = *(const f32x4*)(args.in[I_KK] + hc + 4 * j4);
#pragma unroll
                    for (int q = 0; q < 4; ++q) { kn[4 * j4 + q] = kl[4 * j4 + q] * kk4[q]; ss += kn[4 * j4 + q] * kn[4 * j4 + q]; } }
                ss += __shfl_xor(ss, 1); ss += __shfl_xor(ss, 2);
                const float kinv = rsq_f(fmaxf(ss, 1e-24f));
#pragma unroll
                for (int j = 0; j < 16; ++j) { float x = lwv[j];
#pragma unroll
                    for (int sft = 4; sft < 64; sft <<= 1) { const float y = __shfl_up(x, sft); if (lane >= sft) x += y; }
                    cl[j] = x; }
                float bon = 0.f;
                u32x4 pa[2], pb[2], pk[2], pr[2];
#pragma unroll
                for (int j4 = 0; j4 < 4; ++j4) {
                    const f32x4 ka = *(const f32x4*)(args.in[I_KA] + hc + 4 * j4), rk = *(const f32x4*)(args.in[I_RK] + hc + 4 * j4);
                    float at4[4], bt4[4], kt4[4], rt4[4];
#pragma unroll
                    for (int q = 0; q < 4; ++q) { const int j = 4 * j4 + q;
                        const float p = __expf(cl[j]), pn = __expf(-cl[j]), pm1 = __expf(cl[j] - lwv[j]); eP[j] = p;
                        const float knj = kn[j] * kinv;
                        const float kp = kl[j] * (1.0f + (av[j] - 1.0f) * ka[q]);
                        at4[q] = -knj * pm1; bt4[q] = knj * av[j] * pn; kt4[q] = kp * pn; rt4[q] = rl[j] * p;
                        bon += rl[j] * kp * rk[q];
                        const int kk = 16 * kq + j;
                        ATt[kk * 16 + te] = (bf16)f2bf(at4[q]); BTt[kk * 16 + te] = (bf16)f2bf(bt4[q]); KTt[kk * 16 + te] = (bf16)f2bf(kt4[q]); VTt[kk * 16 + te] = (bf16)f2bf(vl[j]); }
                    const int hh = j4 >> 1, w2 = (j4 & 1) * 2;
                    pa[hh][w2] = pk2(at4[0], at4[1]); pa[hh][w2 + 1] = pk2(at4[2], at4[3]); pb[hh][w2] = pk2(bt4[0], bt4[1]); pb[hh][w2 + 1] = pk2(bt4[2], bt4[3]);
                    pk[hh][w2] = pk2(kt4[0], kt4[1]); pk[hh][w2 + 1] = pk2(kt4[2], kt4[3]); pr[hh][w2] = pk2(rt4[0], rt4[1]); pr[hh][w2 + 1] = pk2(rt4[2], rt4[3]);
                }
#pragma unroll
                for (int hh = 0; hh < 2; ++hh) { const int po = te * 64 + 8 * ((2 * kq + hh) ^ (te & 7));
                    *(LAS u32x4*)(Arm + po) = pa[hh]; *(LAS u32x4*)(Brm + po) = pb[hh]; *(LAS u32x4*)(Krm + po) = pk[hh]; *(LAS u32x4*)(Rrm + po) = pr[hh]; }
                bon += __shfl_xor(bon, 1); bon += __shfl_xor(bon, 2);
#pragma unroll
                for (int j4 = 0; j4 < 4; ++j4) { const f32x4 lb = *(const f32x4*)(args.in[I_LNB] + hc + 4 * j4), lgn = *(const f32x4*)(args.in[I_LNG] + hc + 4 * j4); const int j0 = 4 * j4;
                    u32x2 ow, gw2; ow.x = pk2((lb.x + vl[j0] * bon) * gv[j0], (lb.y + vl[j0 + 1] * bon) * gv[j0 + 1]); ow.y = pk2((lb.z + vl[j0 + 2] * bon) * gv[j0 + 2], (lb.w + vl[j0 + 3] * bon) * gv[j0 + 3]);
                    gw2.x = pk2(lgn.x * gv[j0], lgn.y * gv[j0 + 1]); gw2.y = pk2(lgn.z * gv[j0 + 2], lgn.w * gv[j0 + 3]);
                    *(u32x2*)((bf16*)(ws + WS_ADD) + off + j0) = ow; *(u32x2*)((bf16*)(ws + WS_G) + off + j0) = gw2; }
            }
            asm volatile("s_waitcnt lgkmcnt(0)" ::: "memory");
            {
                bf16x8 fa[2], fr[2], fb[2], fk[2];
#pragma unroll
                for (int ks = 0; ks < 2; ++ks) { const int po = l15 * 64 + 8 * ((4 * ks + g) ^ (l15 & 7));
                    fa[ks] = *(const LAS bf16x8*)(Arm + po); fr[ks] = *(const LAS bf16x8*)(Rrm + po); fb[ks] = *(const LAS bf16x8*)(Brm + po); fk[ks] = *(const LAS bf16x8*)(Krm + po); }
                f32x4 mab = z4, mak = z4, mrb = z4, mrk = z4;
#pragma unroll
                for (int ks = 0; ks < 2; ++ks) { mab = __builtin_amdgcn_mfma_f32_16x16x32_bf16(fb[ks], fa[ks], mab, 0, 0, 0); mak = __builtin_amdgcn_mfma_f32_16x16x32_bf16(fk[ks], fa[ks], mak, 0, 0, 0);
                    mrb = __builtin_amdgcn_mfma_f32_16x16x32_bf16(fb[ks], fr[ks], mrb, 0, 0, 0); mrk = __builtin_amdgcn_mfma_f32_16x16x32_bf16(fk[ks], fr[ks], mrk, 0, 0, 0); }
#pragma unroll
                for (int e = 0; e < 4; ++e) { const int i = 4 * g + e; if (!(i < l15)) { mab[e] = 0.f; mak[e] = 0.f; } if (!(i <= l15)) { mrb[e] = 0.f; mrk[e] = 0.f; } }
                asm volatile("s_waitcnt lgkmcnt(0)" ::: "memory");
#pragma unroll
                for (int e = 0; e < 4; ++e) MabT[(4 * g + e) * 16 + l15] = mab[e];
                u32x2 w; w.x = pk2(mak[0], mak[1]); w.y = pk2(mak[2], mak[3]); *(LAS u32x2*)(Mak + l15 * 16 + 4 * g) = w;
                w.x = pk2(mrb[0], mrb[1]); w.y = pk2(mrb[2], mrb[3]); *(LAS u32x2*)(Mrb + l15 * 16 + 4 * g) = w;
                w.x = pk2(mrk[0], mrk[1]); w.y = pk2(mrk[2], mrk[3]); *(LAS u32x2*)(Mrk + l15 * 16 + 4 * g) = w;
                if (te == 15) {
#pragma unroll
                    for (int j = 0; j < 16; ++j) PLs[16 * kq + j] = eP[j]; }
            }
            asm volatile("s_waitcnt lgkmcnt(0)" ::: "memory");
            {
                float y[16];
#pragma unroll
                for (int j = 15; j >= 0; --j) {
                    float acc = (j == l15) ? 1.0f : 0.0f;
                    float row[16];
#pragma unroll
                    for (int q = 0; q < 4; ++q) { const f32x4 x = *(const LAS f32x4*)(MabT + j * 16 + 4 * q); row[4 * q] = x.x; row[4 * q + 1] = x.y; row[4 * q + 2] = x.z; row[4 * q + 3] = x.w; }
#pragma unroll
                    for (int i = j + 1; i < 16; ++i) acc += y[i] * row[i];
                    y[j] = acc;
                }
                if (g == 0) { u32x4 t0, t1; t0.x = pk2(y[0], y[1]); t0.y = pk2(y[2], y[3]); t0.z = pk2(y[4], y[5]); t0.w = pk2(y[6], y[7]); t1.x = pk2(y[8], y[9]); t1.y = pk2(y[10], y[11]); t1.z = pk2(y[12], y[13]); t1.w = pk2(y[14], y[15]);
                    *(LAS u32x4*)(Tm + l15 * 16) = t0; *(LAS u32x4*)(Tm + l15 * 16 + 8) = t1; }
            }
            asm volatile("s_waitcnt lgkmcnt(0)" ::: "memory");
            {
                const bool act = g < 2; const int fo = l15 * 16 + 8 * g;
                const bf16x8 fT = act ? *(const LAS bf16x8*)(Tm + fo) : z8, fMak = act ? *(const LAS bf16x8*)(Mak + fo) : z8, fMrb = act ? *(const LAS bf16x8*)(Mrb + fo) : z8, fMrk = act ? *(const LAS bf16x8*)(Mrk + fo) : z8;
                bf16x8 fV[4], fQ1[4], fAh[4], fBT[4], fKT[4];
#pragma unroll
                for (int vt = 0; vt < 4; ++vt) { fV[vt] = act ? *(const LAS bf16x8*)(VTt + vt * 256 + fo) : z8; fBT[vt] = act ? *(const LAS bf16x8*)(BTt + vt * 256 + fo) : z8; fKT[vt] = act ? *(const LAS bf16x8*)(KTt + vt * 256 + fo) : z8; }
#pragma unroll
                for (int vt = 0; vt < 4; ++vt) { const f32x4 q0 = __builtin_amdgcn_mfma_f32_16x16x32_bf16(fMak, fV[vt], z4, 0, 0, 0);
                    u32x2 w; w.x = pk2(q0[0], q0[1]); w.y = pk2(q0[2], q0[3]); *(LAS u32x2*)(Q0T + vt * 256 + l15 * 16 + 4 * g) = w; }
#pragma unroll
                for (int kt = 0; kt < 4; ++kt) { const bf16x8 fA = act ? *(const LAS bf16x8*)(ATt + kt * 256 + fo) : z8; const f32x4 ah = __builtin_amdgcn_mfma_f32_16x16x32_bf16(fT, fA, z4, 0, 0, 0);
                    u32x2 w; w.x = pk2(ah[0], ah[1]); w.y = pk2(ah[2], ah[3]); *(LAS u32x2*)(ATt + kt * 256 + l15 * 16 + 4 * g) = w; }
                asm volatile("s_waitcnt lgkmcnt(0)" ::: "memory");
#pragma unroll
                for (int vt = 0; vt < 4; ++vt) { const bf16x8 fQ0 = act ? *(const LAS bf16x8*)(Q0T + vt * 256 + fo) : z8; const f32x4 q1 = __builtin_amdgcn_mfma_f32_16x16x32_bf16(fT, fQ0, z4, 0, 0, 0);
                    u32x2 w; w.x = pk2(q1[0], q1[1]); w.y = pk2(q1[2], q1[3]); *(LAS u32x2*)(Q0T + vt * 256 + l15 * 16 + 4 * g) = w; }
                asm volatile("s_waitcnt lgkmcnt(0)" ::: "memory");
#pragma unroll
                for (int vt = 0; vt < 4; ++vt) { fQ1[vt] = act ? *(const LAS bf16x8*)(Q0T + vt * 256 + fo) : z8; fAh[vt] = act ? *(const LAS bf16x8*)(ATt + vt * 256 + fo) : z8; }
                bf16* rp = (bf16*)(ws + WS_RP) + (size_t)un * 1024 + l15 * 64;
#pragma unroll
                for (int kt = 0; kt < 4; ++kt) {
                    const u32x2 rr = *(const LAS u32x2*)(Rrm + l15 * 64 + 8 * ((2 * kt + (g >> 1)) ^ (l15 & 7)) + 4 * (g & 1));
                    f32x4 ini; ini[0] = bflo(rr.x); ini[1] = bfhi(rr.x); ini[2] = bflo(rr.y); ini[3] = bfhi(rr.y);
                    const f32x4 rh = __builtin_amdgcn_mfma_f32_16x16x32_bf16(fAh[kt], fMrb, ini, 0, 0, 0);
                    u32x2 w; w.x = pk2(rh[0], rh[1]); w.y = pk2(rh[2], rh[3]); *(u32x2*)(rp + 32 * (kt >> 1) + 8 * g + 4 * (kt & 1)) = w;
                }
#pragma unroll
                for (int vt = 0; vt < 4; ++vt) { f32x4 y1 = __builtin_amdgcn_mfma_f32_16x16x32_bf16(fMrb, fQ1[vt], z4, 0, 0, 0); y1 = __builtin_amdgcn_mfma_f32_16x16x32_bf16(fMrk, fV[vt], y1, 0, 0, 0);
                    *(f32x4*)((float*)(ws + WS_Y1F) + ((size_t)(un * 4 + vt) * 64 + lane) * 4) = y1; }
                bf16* gp = (bf16*)(ws + WS_GP) + (size_t)un * 4096;
#pragma unroll
                for (int krt = 0; krt < 4; ++krt) { const float pl = PLs[16 * krt + l15];
#pragma unroll
                    for (int kct = 0; kct < 4; ++kct) { f32x4 ga = __builtin_amdgcn_mfma_f32_16x16x32_bf16(fAh[kct], fBT[krt], z4, 0, 0, 0);
                        if (kct == krt) {
#pragma unroll
                            for (int e = 0; e < 4; ++e) if (4 * g + e == l15) ga[e] += 1.0f; }
                        u32x2 w; w.x = pk2(ga[0] * pl, ga[1] * pl); w.y = pk2(ga[2] * pl, ga[3] * pl);
                        *(u32x2*)(gp + (16 * krt + l15) * 64 + 32 * (kct >> 1) + 8 * g + 4 * (kct & 1)) = w; } }
#pragma unroll
                for (int mt = 0; mt < 4; ++mt) { const f32x4 pl4 = *(const LAS f32x4*)(PLs + 16 * mt + 4 * g);
#pragma unroll
                    for (int vt = 0; vt < 4; ++vt) { f32x4 ha = __builtin_amdgcn_mfma_f32_16x16x32_bf16(fBT[mt], fQ1[vt], z4, 0, 0, 0); ha = __builtin_amdgcn_mfma_f32_16x16x32_bf16(fKT[mt], fV[vt], ha, 0, 0, 0);
                        u32x2 w; w.x = pk2(ha[0] * pl4[0], ha[1] * pl4[1]); w.y = pk2(ha[2] * pl4[2], ha[3] * pl4[3]);
                        *(u32x2*)((bf16*)(ws + WS_HF) + ((size_t)((un * 4 + vt) * 4 + mt) * 64 + lane) * 4) = w; } }
            }
            asm volatile("s_waitcnt lgkmcnt(0)" ::: "memory");
        }
        asm volatile("s_waitcnt vmcnt(0)" ::: "memory");
        { const int ltid = fresh_tid() & 63, l15 = ltid & 15, g = ltid >> 4, lane = ltid;
#pragma unroll 1
        for (int part = 0; part < 2; ++part) {
            f32x4 z[4][4];
#pragma unroll
            for (int sl = 0; sl < 4; ++sl)
#pragma unroll
                for (int mt = 0; mt < 4; ++mt)
#pragma unroll
                    for (int e = 0; e < 4; ++e) z[sl][mt][e] = (part == 0 && sl == mt && 4 * g + e == l15) ? 1.0f : 0.0f;
#pragma unroll 1
            for (int j = 0; j < 4; ++j) {
                const size_t un = (size_t)u64 * 4 + j;
                const bf16* gp = (const bf16*)(ws + WS_GP) + un * 4096 + l15 * 64 + 8 * g;
                bf16x8 gf[4][2];
#pragma unroll
                for (int mt = 0; mt < 4; ++mt) { gf[mt][0] = *(const bf16x8*)(gp + mt * 1024); gf[mt][1] = *(const bf16x8*)(gp + mt * 1024 + 32); }
#pragma unroll
                for (int sl = 0; sl < 4; ++sl) {
                    bf16x8 zb[2]; RW_ZB(z[sl], zb);
#pragma unroll
                    for (int mt = 0; mt < 4; ++mt) {
                        f32x4 a = (f32x4){0.f, 0.f, 0.f, 0.f};
                        if (part) { const u32x2 hh = *(const u32x2*)((const bf16*)(ws + WS_HF) + ((size_t)((un * 4 + sl) * 4 + mt) * 64 + lane) * 4); a[0] = bflo(hh.x); a[1] = bfhi(hh.x); a[2] = bflo(hh.y); a[3] = bfhi(hh.y); }
                        a = __builtin_amdgcn_mfma_f32_16x16x32_bf16(gf[mt][0], zb[0], a, 0, 0, 0); a = __builtin_amdgcn_mfma_f32_16x16x32_bf16(gf[mt][1], zb[1], a, 0, 0, 0);
                        z[sl][mt] = a;
                    }
                }
            }
            if (part == 0) {
                bf16* gc = (bf16*)(ws + WS_GC) + (size_t)u64 * 4096;
#pragma unroll
                for (int sl = 0; sl < 4; ++sl) { const int pc = 32 * (sl >> 1) + 8 * (l15 >> 2) + 4 * (sl & 1) + (l15 & 3);
#pragma unroll
                    for (int mt = 0; mt < 4; ++mt)
#pragma unroll
                        for (int e = 0; e < 4; ++e) gc[(16 * mt + 4 * g + e) * 64 + pc] = (bf16)f2bf(z[sl][mt][e]); }
            } else {
#pragma unroll
                for (int sl = 0; sl < 4; ++sl)
#pragma unroll
                    for (int mt = 0; mt < 4; ++mt) { u32x2 w; w.x = pk2(z[sl][mt][0], z[sl][mt][1]); w.y = pk2(z[sl][mt][2], z[sl][mt][3]);
                        *(u32x2*)((bf16*)(ws + WS_HC) + ((size_t)((u64 * 4 + sl) * 4 + mt) * 64 + lane) * 4) = w; }
            }
        }
        }
        }
        for (int lu = gw; lu < NB * 8 * 64; lu += NGW) {
            const int bc = lu >> 6, seg = lu & 63, b = bc >> 3, cg = bc & 7, ch = cg * 64 + lane;
            const size_t mb = (size_t)b * SEQ + seg * 64;
            float A = 1.f, B = 0.f;
#pragma unroll 16
            for (int t = 0; t < 64; ++t) { const float a = __expf(bf2f(LA[(mb + t) * 512 + ch])), bt = bf2f(LB[(mb + t) * 512 + ch]); B = a * B + bt; A *= a; }
            f32x2 ab; ab.x = A; ab.y = B; *(f32x2*)((float*)(ws + WS_AP) + ((size_t)lu * 64 + lane) * 2) = ab;
        }
    }
    SEAM(3);


    if (IN(4)) { PHASE_IDS;
        if (!(bid < 128 && wave == 0)) {
            const int wi = bid < 128 ? bid * 7 + (wave - 1) : 896 + (bid - 128) * 8 + wave, NW = 896 + (G - 128) * 8;
        } else {
            const int l15 = lane & 15, g = lane >> 4, bh = bid >> 2, vs = bid & 3;
            f32x4 z[4];
#pragma unroll
            for (int mt = 0; mt < 4; ++mt) z[mt] = (f32x4){0.f, 0.f, 0.f, 0.f};
            bf16x8 gA[4][2], gB[4][2], gC[4][2], gD[4][2]; u32x2 hA[4], hB[4], hC[4], hD[4];
#define SC_LOAD(gf, hf, C) do { const size_t u64_ = (size_t)bh * 64 + (C); const bf16* gp_ = (const bf16*)(ws + WS_GC) + u64_ * 4096 + l15 * 64 + 8 * g; \
                _Pragma("unroll") for (int mt = 0; mt < 4; ++mt) { gf[mt][0] = *(const bf16x8*)(gp_ + mt * 1024); gf[mt][1] = *(const bf16x8*)(gp_ + mt * 1024 + 32); \
                    hf[mt] = *(const u32x2*)((const bf16*)(ws + WS_HC) + ((size_t)((u64_ * 4 + vs) * 4 + mt) * 64 + lane) * 4); } } while (0)
#define SC_STEP(gf, hf, C) do { const size_t u64_ = (size_t)bh * 64 + (C); bf16* zs_ = (bf16*)(ws + WS_ZS) + ((size_t)((u64_ * 4 + vs) * 4) * 64 + lane) * 4; \
                _Pragma("unroll") for (int mt = 0; mt < 4; ++mt) { u32x2 zw_; zw_.x = pk2(z[mt][0], z[mt][1]); zw_.y = pk2(z[mt][2], z[mt][3]); *(u32x2*)(zs_ + mt * 256) = zw_; } \
                bf16x8 zb[2]; RW_ZB(z, zb); \
                _Pragma("unroll") for (int mt = 0; mt < 4; ++mt) { f32x4 a; a[0] = bflo(hf[mt].x); a[1] = bfhi(hf[mt].x); a[2] = bflo(hf[mt].y); a[3] = bfhi(hf[mt].y); \
                    a = __builtin_amdgcn_mfma_f32_16x16x32_bf16(gf[mt][0], zb[0], a, 0, 0, 0); a = __builtin_amdgcn_mfma_f32_16x16x32_bf16(gf[mt][1], zb[1], a, 0, 0, 0); z[mt] = a; } } while (0)
            SC_LOAD(gA, hA, 0); SC_LOAD(gB, hB, 1); SC_LOAD(gC, hC, 2);
#pragma unroll 1
            for (int C = 0; C < 64; C += 4) {
                SC_LOAD(gD, hD, C + 3);
                SC_STEP(gA, hA, C);
                if (C + 4 < 64) SC_LOAD(gA, hA, C + 4);
                SC_STEP(gB, hB, C + 1);
                if (C + 5 < 64) SC_LOAD(gB, hB, C + 5);
                SC_STEP(gC, hC, C + 2);
                if (C + 6 < 64) SC_LOAD(gC, hC, C + 6);
                SC_STEP(gD, hD, C + 3);
            }
#undef SC_LOAD
#undef SC_STEP
        }
    }
    SEAM(4);

    if (IN(5)) { PHASE_IDS;
        {
            for (int lu = gw; lu < NB * 8 * 64; lu += NGW) {
                const int bc = lu >> 6, seg = lu & 63, b = bc >> 3, cg = bc & 7, ch = cg * 64 + lane;
                const size_t mb = (size_t)b * SEQ + seg * 64;
                float hst = 0.f;
                const f32x2* ag = (const f32x2*)((const float*)(ws + WS_AP)) + (size_t)(bc * 64) * 64 + lane;
#pragma unroll 8
                for (int sg = 0; sg < seg; ++sg) { const f32x2 ab = ag[(size_t)sg * 64]; hst = ab.x * hst + ab.y; }
#pragma unroll 16
                for (int t = 0; t < 64; ++t) { const float a = __expf(bf2f(LA[(mb + t) * 512 + ch])), bt = bf2f(LB[(mb + t) * 512 + ch]); hst = a * hst + bt;
                    const float gl = bf2f(U[(mb + t) * INW + 512 + ch]); CAT[(mb + t) * 1024 + ch] = (bf16)f2bf(hst * gelu_tanh_f(gl)); }
            }
        }
        const int l15 = lane & 15, g = lane >> 4;
        for (int u64 = gw; u64 < NB * NH * (SEQ / 64); u64 += NGW) {
            const int bh = u64 >> 6, C = u64 & 63, b = bh >> 3, h = bh & 7;
            f32x4 z[4][4];
#pragma unroll
            for (int sl = 0; sl < 4; ++sl)
#pragma unroll
                for (int mt = 0; mt < 4; ++mt) { const u32x2 zw = *(const u32x2*)((const bf16*)(ws + WS_ZS) + ((size_t)((u64 * 4 + sl) * 4 + mt) * 64 + lane) * 4); z[sl][mt] = (f32x4){bflo(zw.x), bfhi(zw.x), bflo(zw.y), bfhi(zw.y)}; }
#pragma unroll 1
            for (int j = 0; j < 4; ++j) {
                const size_t un = (size_t)u64 * 4 + j; const size_t m0 = (size_t)b * SEQ + (C * 4 + j) * 16;
                const bf16* rp = (const bf16*)(ws + WS_RP) + un * 1024 + l15 * 64 + 8 * g;
                const bf16x8 rf0 = *(const bf16x8*)rp, rf1 = *(const bf16x8*)(rp + 32);
                f32x4 y[4];
#pragma unroll
                for (int sl = 0; sl < 4; ++sl) { bf16x8 zb[2]; RW_ZB(z[sl], zb);
                    f32x4 a = *(const f32x4*)((const float*)(ws + WS_Y1F) + ((size_t)(un * 4 + sl) * 64 + lane) * 4);
                    a = __builtin_amdgcn_mfma_f32_16x16x32_bf16(rf0, zb[0], a, 0, 0, 0); a = __builtin_amdgcn_mfma_f32_16x16x32_bf16(rf1, zb[1], a, 0, 0, 0); y[sl] = a; }
#pragma unroll
                for (int e = 0; e < 4; ++e) {
                    float s1 = (y[0][e] + y[1][e]) + (y[2][e] + y[3][e]);
                    s1 += __shfl_xor(s1, 1); s1 += __shfl_xor(s1, 2); s1 += __shfl_xor(s1, 4); s1 += __shfl_xor(s1, 8);
                    const float mean = s1 * (1.0f / 64.0f);
                    float d0 = y[0][e] - mean, d1 = y[1][e] - mean, d2 = y[2][e] - mean, d3 = y[3][e] - mean;
                    float s2 = (d0 * d0 + d1 * d1) + (d2 * d2 + d3 * d3);
                    s2 += __shfl_xor(s2, 1); s2 += __shfl_xor(s2, 2); s2 += __shfl_xor(s2, 4); s2 += __shfl_xor(s2, 8);
                    const float rstd = rsq_f(s2 * (1.0f / 64.0f) + GN_EPS);
                    const size_t ro = (m0 + 4 * g + e) * 512 + h * 64 + l15;
                    const float dd[4] = {d0, d1, d2, d3};
#pragma unroll
                    for (int sl = 0; sl < 4; ++sl) { const float gg = bf2f(((const bf16*)(ws + WS_G))[ro + 16 * sl]), ad = bf2f(((const bf16*)(ws + WS_ADD))[ro + 16 * sl]);
                        const float o = dd[sl] * rstd * gg + ad;
                        CAT[(m0 + 4 * g + e) * 1024 + 512 + h * 64 + 16 * sl + l15] = (bf16)f2bf(o); }
                }
                if (j < 3) {
                    const bf16* gp = (const bf16*)(ws + WS_GP) + un * 4096 + l15 * 64 + 8 * g;
                    bf16x8 gf[4][2];
#pragma unroll
                    for (int mt = 0; mt < 4; ++mt) { gf[mt][0] = *(const bf16x8*)(gp + mt * 1024); gf[mt][1] = *(const bf16x8*)(gp + mt * 1024 + 32); }
#pragma unroll
                    for (int sl = 0; sl < 4; ++sl) { bf16x8 zb[2]; RW_ZB(z[sl], zb);
#pragma unroll
                        for (int mt = 0; mt < 4; ++mt) { const u32x2 hh = *(const u32x2*)((const bf16*)(ws + WS_HF) + ((size_t)((un * 4 + sl) * 4 + mt) * 64 + lane) * 4);
                            f32x4 a; a[0] = bflo(hh.x); a[1] = bfhi(hh.x); a[2] = bflo(hh.y); a[3] = bfhi(hh.y);
                            a = __builtin_amdgcn_mfma_f32_16x16x32_bf16(gf[mt][0], zb[0], a, 0, 0, 0); a = __builtin_amdgcn_mfma_f32_16x16x32_bf16(gf[mt][1], zb[1], a, 0, 0, 0); z[sl][mt] = a; } }
                }
            }
        }
    }
    SEAM(5);
#undef RW_ZB


    if (IN(6)) { PHASE_IDS;
        pg8::DenseSched S; S.o.init_tiles(M / 256, D / 256, G, bid); S.A = (const char*)CAT; S.B = (const char*)Wout_t; S.tstep = (size_t)256 * D * 2;
        EpiBf16Res<false> E{args.in[I_X], X1, D}; pg8::gemm_phase(lds, D, S, E);
    }
    SEAM(6);
    if (IN(7)) { PHASE_IDS; for (int m = gw; m < M; m += NGW) rms_rowbf_to_bf16(X1 + (size_t)m * D, args.in[I_NXAG], HN + (size_t)m * D, lane); }
    SEAM(7);
    if (IN(8)) { PHASE_IDS;
        pg8::DenseSched S; S.o.init_tiles(M / 256, D / 256, G, bid); S.A = (const char*)HN; S.B = (const char*)Wq_t; S.tstep = (size_t)256 * D * 2;
        EpiBf16Plain E{Qb, D, 0.0625f}; pg8::gemm_phase(lds, D, S, E);
    }
    SEAM(8);
    if (IN(9)) { PHASE_IDS;
        constexpr int KP = 264, VP = 72;
        LAS bf16* Kt = (LAS bf16*)lds;
        LAS bf16* Vt = (LAS bf16*)(lds + 64 * KP * 2);
        const int l15 = lane & 15, g4 = lane >> 4;
        const int bh = bid >> 4, b = bh >> 2, h = bh & 3;
        const int kkey = tid >> 3, kpart = tid & 7, vd = tid >> 1, vhalf = tid & 1;
        const bf16* kg = KM + (size_t)(b * MEML + kkey) * D + h * XHD + 32 * kpart;
        const bf16* vg = VT + (size_t)(h * XHD + vd) * MROWS + b * MEML + 32 * vhalf;
#pragma unroll 1
        for (int u = 0; u < 2; ++u) {
            const int q0 = ((bid & 15) * 2 + u) * 128 + wave * 16;
            const bf16* qbase = Qb + (size_t)(b * SEQ + q0 + l15) * D + h * XHD + 8 * g4;
            bf16x8 qf[8];
#pragma unroll
            for (int ks = 0; ks < 8; ++ks) qf[ks] = *(const bf16x8*)(qbase + 32 * ks);
            f32x4 oc[16];
#pragma unroll
            for (int dt = 0; dt < 16; ++dt) oc[dt] = (f32x4){0.f, 0.f, 0.f, 0.f};
            float mrun = -3.0e38f, lrun = 0.f;
            u32x4 kr[4], vr[4];
#pragma unroll
            for (int i = 0; i < 4; ++i) { kr[i] = *(const u32x4*)(kg + 8 * i); vr[i] = *(const u32x4*)(vg + 8 * i); }
#pragma unroll 1
            for (int kt = 0; kt < 4; ++kt) {
                __syncthreads();
#pragma unroll
                for (int i = 0; i < 4; ++i) { *(LAS u32x4*)(Kt + kkey * KP + 32 * kpart + 8 * i) = kr[i]; *(LAS u32x4*)(Vt + vd * VP + 32 * vhalf + 8 * i) = vr[i]; }
                if (kt < 3) {
#pragma unroll
                    for (int i = 0; i < 4; ++i) { kr[i] = *(const u32x4*)(kg + (size_t)(kt + 1) * 64 * D + 8 * i); vr[i] = *(const u32x4*)(vg + (kt + 1) * 64 + 8 * i); } }
                __syncthreads();
                f32x4 sc[4];
#pragma unroll
                for (int j = 0; j < 4; ++j) sc[j] = (f32x4){0.f, 0.f, 0.f, 0.f};
#pragma unroll
                for (int ks = 0; ks < 8; ++ks)
#pragma unroll
                    for (int j = 0; j < 4; ++j) { const bf16x8 kf = *(const LAS bf16x8*)(Kt + (16 * j + l15) * KP + 32 * ks + 8 * g4);
                        sc[j] = __builtin_amdgcn_mfma_f32_16x16x32_bf16(kf, qf[ks], sc[j], 0, 0, 0); }
                float mx = -3.0e38f;
#pragma unroll
                for (int j = 0; j < 4; ++j) mx = fmaxf(mx, fmaxf(fmaxf(sc[j][0], sc[j][1]), fmaxf(sc[j][2], sc[j][3])));
                mx = fmaxf(mx, __shfl_xor(mx, 16)); mx = fmaxf(mx, __shfl_xor(mx, 32));
                const float mnew = fmaxf(mrun, mx), alpha = __expf(mrun - mnew);
                mrun = mnew; lrun *= alpha;
#pragma unroll
                for (int j = 0; j < 4; ++j)
#pragma unroll
                    for (int e = 0; e < 4; ++e) { const float p = __expf(sc[j][e] - mnew); sc[j][e] = p; lrun += p; }
                bf16x8 pf[2];
#pragma unroll
                for (int s2 = 0; s2 < 2; ++s2) { u32x4 pw; pw.x = pk2(sc[2 * s2][0], sc[2 * s2][1]); pw.y = pk2(sc[2 * s2][2], sc[2 * s2][3]); pw.z = pk2(sc[2 * s2 + 1][0], sc[2 * s2 + 1][1]); pw.w = pk2(sc[2 * s2 + 1][2], sc[2 * s2 + 1][3]);
                    pf[s2] = __builtin_bit_cast(bf16x8, pw); }
#pragma unroll
                for (int dt = 0; dt < 16; ++dt) {
                    f32x4 o = oc[dt] * alpha;
#pragma unroll
                    for (int s2 = 0; s2 < 2; ++s2) { const LAS bf16* vp = Vt + (16 * dt + l15) * VP + 32 * s2 + 4 * g4;
                        const u32x2 v0 = *(const LAS u32x2*)vp, v1 = *(const LAS u32x2*)(vp + 16);
                        u32x4 vv; vv.x = v0.x; vv.y = v0.y; vv.z = v1.x; vv.w = v1.y;
                        o = __builtin_amdgcn_mfma_f32_16x16x32_bf16(__builtin_bit_cast(bf16x8, vv), pf[s2], o, 0, 0, 0); }
                    oc[dt] = o;
                }
            }
            lrun += __shfl_xor(lrun, 16); lrun += __shfl_xor(lrun, 32);
            const float inv = rcp_f(lrun);
            bf16* obase = Ob + (size_t)(b * SEQ + q0 + l15) * D + h * XHD + 4 * g4;
#pragma unroll
            for (int dt = 0; dt < 16; ++dt) { u32x2 w; w.x = pk2(oc[dt][0] * inv, oc[dt][1] * inv); w.y = pk2(oc[dt][2] * inv, oc[dt][3] * inv); *(u32x2*)(obase + 16 * dt) = w; }
        }
        __syncthreads();
    }
    SEAM(9);
    if (IN(10)) { PHASE_IDS;
        pg8::DenseSched S; S.o.init_tiles(M / 256, D / 256, G, bid); S.A = (const char*)Ob; S.B = (const char*)Wo_t; S.tstep = (size_t)256 * D * 2;
        EpiBf16Res<true> E{X1, X2, D}; pg8::gemm_phase(lds, D, S, E);
    }
    SEAM(10);
    if (IN(11)) { PHASE_IDS;
        for (int cid = tid; cid < 2 * NE * 128; cid += NTHREADS) { const int t = cid >> 12, row = (cid >> 7) & 31, c = cid & 127;
            *(LAS u32x4*)(lds + t * 65536 + row * 2048 + ((c ^ (row & 7)) << 4)) = *(const u32x4*)(WrT + (size_t)t * NE * D + row * D + 8 * c); }
        __syncthreads();
        const int l15 = lane & 15, g = lane >> 4;
        LAS float* LG = (LAS float*)(lds + RING_BYTES + 1024 + wave * 2304);
        const float* gfn = args.in[I_NFFG];
        if (wave < 4)
        for (int tile = bid * 4 + wave; tile < M / 16; tile += G * 4) {
            const int m0 = tile * 16;
            const bf16* xrow = X2 + (size_t)(m0 + l15) * D + 8 * g;
            float ss = 0.f;
#pragma unroll 8
            for (int ks = 0; ks < 32; ++ks) { const u32x4 xw = *(const u32x4*)(xrow + 32 * ks);
#pragma unroll
                for (int q = 0; q < 4; ++q) { const float a = bflo(xw[q]), c = bfhi(xw[q]); ss += a * a + c * c; } }
            ss += __shfl_xor(ss, 16); ss += __shfl_xor(ss, 32);
            const float rstd = rsq_f(ss * (1.f / D) + EPS);
            f32x4 acc0 = (f32x4){0.f, 0.f, 0.f, 0.f}, acc1 = acc0;
            bf16* hrow = HN + (size_t)(m0 + l15) * D + 8 * g;
#pragma unroll 2
            for (int ks = 0; ks < 32; ++ks) {
                const f32x4 g0 = *(const f32x4*)(gfn + 32 * ks + 8 * g), g1 = *(const f32x4*)(gfn + 32 * ks + 8 * g + 4);
                const u32x4 xw = *(const u32x4*)(xrow + 32 * ks);
                float hf[8];
#pragma unroll
                for (int q = 0; q < 4; ++q) { hf[2 * q] = bflo(xw[q]) * rstd * (q < 2 ? g0[2 * q] : g1[2 * q - 4]); hf[2 * q + 1] = bfhi(xw[q]) * rstd * (q < 2 ? g0[2 * q + 1] : g1[2 * q - 3]); }
                u32x4 hi, lo;
#pragma unroll
                for (int q = 0; q < 4; ++q) { hi[q] = pk2(hf[2 * q], hf[2 * q + 1]); lo[q] = pk2(hf[2 * q] - bflo(hi[q]), hf[2 * q + 1] - bfhi(hi[q])); }
                *(u32x4*)(hrow + 32 * ks) = hi;
                const bf16x8 ah = __builtin_bit_cast(bf16x8, hi), al = __builtin_bit_cast(bf16x8, lo);
                const int c = 4 * ks + g;
#pragma unroll
                for (int nt = 0; nt < 2; ++nt) { const int row = 16 * nt + l15; const int off = row * 2048 + ((c ^ (row & 7)) << 4);
                    const bf16x8 bh = *(const LAS bf16x8*)(lds + off), bl = *(const LAS bf16x8*)(lds + 65536 + off);
                    f32x4 a = nt ? acc1 : acc0;
                    a = __builtin_amdgcn_mfma_f32_16x16x32_bf16(ah, bh, a, 0, 0, 0); a = __builtin_amdgcn_mfma_f32_16x16x32_bf16(ah, bl, a, 0, 0, 0); a = __builtin_amdgcn_mfma_f32_16x16x32_bf16(al, bh, a, 0, 0, 0);
                    if (nt) acc1 = a; else acc0 = a; }
            }
            { const float b0 = args.in[I_BR][l15], b1 = args.in[I_BR][16 + l15];
#pragma unroll
              for (int j = 0; j < 4; ++j) { LG[(4 * g + j) * 33 + l15] = acc0[j] + b0; LG[(4 * g + j) * 33 + 16 + l15] = acc1[j] + b1; } }
            const int rrow = lane >> 2, qq = lane & 3;
            float tv[4] = {-3.0e38f, -3.0e38f, -3.0e38f, -3.0e38f}; int ti[4] = {64, 65, 66, 67};
#define TOP_INS(xv_, xi_) do { float x_ = (xv_); int i_ = (xi_); _Pragma("unroll") for (int p_ = 0; p_ < 4; ++p_) { const bool b_ = x_ > tv[p_] || (x_ == tv[p_] && i_ < ti[p_]); \
                const float ov_ = tv[p_]; const int oi_ = ti[p_]; tv[p_] = b_ ? x_ : ov_; ti[p_] = b_ ? i_ : oi_; x_ = b_ ? ov_ : x_; i_ = b_ ? oi_ : i_; } } while (0)
#pragma unroll
            for (int j = 0; j < 8; ++j) TOP_INS(LG[rrow * 33 + 8 * qq + j], 8 * qq + j);
#pragma unroll
            for (int st = 1; st < 4; st <<= 1) { float pv[4]; int pi[4];
#pragma unroll
                for (int p = 0; p < 4; ++p) { pv[p] = __shfl_xor(tv[p], st); pi[p] = __shfl_xor(ti[p], st); }
#pragma unroll
                for (int p = 0; p < 4; ++p) TOP_INS(pv[p], pi[p]); }
#undef TOP_INS
            const float e1 = __expf(tv[1] - tv[0]), e2 = __expf(tv[2] - tv[0]), e3 = __expf(tv[3] - tv[0]);
            const float inv = rcp_f(1.0f + e1 + e2 + e3);
            const int me = qq == 0 ? ti[0] : qq == 1 ? ti[1] : qq == 2 ? ti[2] : ti[3];
            const float mg = (qq == 0 ? 1.0f : qq == 1 ? e1 : qq == 2 ? e2 : e3) * inv;
            const int pos = (int)atomicAdd(ecnt + me, 1u);
            const int ai = (m0 + rrow) * 4 + qq; route_e[ai] = me; route_pos[ai] = pos; route_g[ai] = mg;
        }
        __syncthreads();
    }
    SEAM(11);
    if (IN(12)) { PHASE_IDS;
        LAS int* pst = (LAS int*)lds;
        if (tid == 0) { int acc = 0; for (int e = 0; e < NE; ++e) { const int c = (int)__hip_atomic_load(ecnt + e, __ATOMIC_RELAXED, __HIP_MEMORY_SCOPE_AGENT); pst[e] = acc; pst[64 + e] = c; acc += (c + 255) & ~255; } pst[32] = acc; }
        __syncthreads();
        for (int ai = bid * NTHREADS + tid; ai < NASSIGN; ai += G * NTHREADS) {
            const int e = route_e[ai]; const int row = pst[e] + route_pos[ai]; row_slot[row] = ai; row_gate[row] = route_g[ai]; row_tok[row] = ai >> 2; }
        if (bid < NE) { const int e = bid, c = pst[64 + e], pe = (c + 255) & ~255; for (int p = c + tid; p < pe; p += NTHREADS) { row_slot[pst[e] + p] = -1; row_gate[pst[e] + p] = 0.f; row_tok[pst[e] + p] = 0; } }
        if (bid == 0 && tid == 0) { int nt = 0; for (int e = 0; e < NE; ++e) { const int n = ((pst[64 + e] + 255) & ~255) >> 8; for (int j = 0; j < n; ++j) tile_tab[16 + nt++] = e; } tile_tab[0] = nt; }
        __syncthreads();
    }
    SEAM(12);
    if (IN(13)) { PHASE_IDS;
        const int ntiles = tile_tab[0];
        pg8::MoeGatherSched S; S.o.init_tiles(ntiles, 2048 / 256, G, bid); S.A = (const char*)HN; S.B = (const char*)Wgu_t; S.tile_e = tile_tab + 16; S.rtok = row_tok; S.tstep = (size_t)256 * D * 2; S.estep = (size_t)2048 * D * 2;
        EpiSwiglu E{ACT, args.in[I_BGU]}; pg8::gemm_phase(lds, D, S, E);
    }
    SEAM(13);
    if (IN(14)) { PHASE_IDS;
        const int ntiles = tile_tab[0];
        pg8::MoeSched S; S.o.init_tiles(ntiles, D / 256, G, bid); S.A = (const char*)ACT; S.B = (const char*)Wdn_t; S.tile_e = tile_tab + 16; S.tstep = (size_t)256 * DFF * 2; S.estep = (size_t)D * DFF * 2;
        EpiDown E{YS, args.in[I_BDN], row_slot, row_gate}; pg8::gemm_phase(lds, DFF, S, E);
    }
    SEAM(14);
    if (IN(15)) { PHASE_IDS;
        const float* gfin = args.in[I_FNG];
        for (int m = gw; m < M; m += NGW) {
            float v[16]; float s = 0.f;
#pragma unroll
            for (int hf = 0; hf < 2; ++hf) { const u32x4 w = *(const u32x4*)(X2 + (size_t)m * D + 512 * hf + 8 * lane);
#pragma unroll
                for (int q = 0; q < 4; ++q) { v[8 * hf + 2 * q] = bflo(w[q]); v[8 * hf + 2 * q + 1] = bfhi(w[q]); }
#pragma unroll
                for (int k = 0; k < 4; ++k) { const u32x4 y = *(const u32x4*)(YS + (size_t)(m * 4 + k) * D + 512 * hf + 8 * lane);
#pragma unroll
                    for (int q = 0; q < 4; ++q) { v[8 * hf + 2 * q] += bflo(y[q]); v[8 * hf + 2 * q + 1] += bfhi(y[q]); } } }
#pragma unroll
            for (int j = 0; j < 16; ++j) s += v[j] * v[j];
            const float rstd = rsq_f(wave_sum(s) * (1.f / D) + EPS);
#pragma unroll
            for (int hf = 0; hf < 2; ++hf) { const f32x4 g0 = *(const f32x4*)(gfin + 512 * hf + 8 * lane), g1 = *(const f32x4*)(gfin + 512 * hf + 8 * lane + 4);
                float* o = args.out + (size_t)m * D + 512 * hf + 8 * lane;
                *(f32x4*)o = (f32x4){v[8 * hf] * rstd * g0.x, v[8 * hf + 1] * rstd * g0.y, v[8 * hf + 2] * rstd * g0.z, v[8 * hf + 3] * rstd * g0.w};
                *(f32x4*)(o + 4) = (f32x4){v[8 * hf + 4] * rstd * g1.x, v[8 * hf + 5] * rstd * g1.y, v[8 * hf + 6] * rstd * g1.z, v[8 * hf + 7] * rstd * g1.w}; }
        }
    }
#undef IN
#undef SEAM
}

constexpr int N_PHASES = 16;
extern "C" void kernel_launch(void* const* d_in, const int* in_sizes, int n_in, void* d_out, int out_size, void* d_ws, size_t ws_size, hipStream_t stream) {
    static int grid = 0;
    if (grid == 0) {
        if (n_in != 37 || out_size != M * D || ws_size < WS_END) { fprintf(stderr, "kernel_launch: unexpected shapes (n_in %d, out %d, ws %zu); nothing launched\n", n_in, out_size, ws_size); grid = -1; return; }
        int dev = 0, cus = 0, per_cu = 0;
        if (hipGetDevice(&dev) != hipSuccess || hipDeviceGetAttribute(&cus, hipDeviceAttributeMultiprocessorCount, dev) != hipSuccess) { grid = -1; return; }
        if (hipFuncSetAttribute((const void*)fwd, hipFuncAttributeMaxDynamicSharedMemorySize, LDS_BYTES) != hipSuccess) { fprintf(stderr, "kernel_launch: hipFuncSetAttribute failed\n"); grid = -1; return; }
        if (hipOccupancyMaxActiveBlocksPerMultiprocessor(&per_cu, (const void*)fwd, NTHREADS, LDS_BYTES) != hipSuccess || per_cu < 1) fprintf(stderr, "kernel_launch: occupancy query says %d\n", per_cu);
        (void)hipGetLastError();
        grid = cus > 256 ? 256 : cus;
    }
    if (grid < 0) return;
    if (hipMemsetAsync((char*)d_ws + WS_CTL, 0, CTL_ZERO_BYTES, stream) != hipSuccess) return;
    Args a{};
    for (int i = 0; i < 37; ++i) a.in[i] = (const float*)d_in[i];
    a.out = (float*)d_out; a.ws = (unsigned char*)d_ws;
#if MK_ONE_LAUNCH
    a.ph_lo = 0; a.ph_hi = N_PHASES;
    hipLaunchKernelGGL(fwd, dim3(grid), dim3(NTHREADS), LDS_BYTES, stream, a);
#else
    for (int p = 0; p < N_PHASES; ++p) { a.ph_lo = p; a.ph_hi = p + 1; hipLaunchKernelGGL(fwd, dim3(grid), dim3(NTHREADS), LDS_BYTES, stream, a);
#ifdef PROBE_REPEAT_PHASE
        if (p == PROBE_REPEAT_PHASE) hipLaunchKernelGGL(fwd, dim3(grid), dim3(NTHREADS), LDS_BYTES, stream, a);
#endif
    }
#endif
}
```

```cpp
#include <hip/hip_runtime.h>
#include <cstdio>
#include <cstdint>

#ifndef MK_ONE_LAUNCH
#define MK_ONE_LAUNCH 1
#endif

#define DI __device__ __forceinline__
#define GAS __attribute__((address_space(1)))
#define LAS __attribute__((address_space(3)))
typedef unsigned short bf16;
typedef short bf16x8 __attribute__((ext_vector_type(8)));
typedef float f32x4 __attribute__((ext_vector_type(4)));
typedef float f32x2 __attribute__((ext_vector_type(2)));
typedef unsigned u32x4 __attribute__((ext_vector_type(4)));
typedef unsigned u32x2 __attribute__((ext_vector_type(2)));

constexpr int D = 1024, NB = 4, SEQ = 4096, M = NB * SEQ;
constexpr int MEML = 256, MROWS = NB * MEML;
constexpr int LRU_W = 512, RW = 512, NH = 8, HD = 64;
constexpr int INW = 2816;
constexpr int XH = 4, XHD = 256;
constexpr int NE = 32, TOPK = 4, DFF = 1024;
constexpr int NASSIGN = M * TOPK;
constexpr int MAXTILES = 288, MAXROWS = MAXTILES * 256;
constexpr float EPS = 1e-6f, GN_EPS = 64e-5f;

DI int fresh_tid() { int t = threadIdx.x; asm volatile("" : "+v"(t)); return t; }
namespace pg8 {
constexpr int BM = 256, BK = 64, HALF = 128, HTB = HALF * BK * 2, STAGE_BYTES = 8 * HTB, NXCD = 8, WGM = 8;
__host__ __device__ __forceinline__ int lds_byte(int r, int c) { const int st = (r >> 4) * 2 + (c >> 5), rr = r & 15, cc = c & 31, ob = rr * 64 + cc * 2; return st * 1024 + (ob ^ (((ob >> 9) & 1) << 5)); }
__host__ __device__ __forceinline__ void stage_rc(int b, int& R, int& C) { const int st = b / 1024, sb = b % 1024, swz = sb ^ (((sb >> 9) & 1) << 5); R = (st >> 1) * 16 + swz / 64; C = (st & 1) * 32 + (swz % 64) / 2; }
__host__ __device__ __forceinline__ int perm32(int rho) { const int n = rho >> 4, i = rho & 15; return 8 * (i >> 2) + 4 * n + (i & 3); }

struct Unit { int pm, pn, e; };

struct StaticOrder {
    int nM, nN, nwg, G, c;
    __host__ __device__ void init_tiles(int nM_, int nN_, int G_, int c_) { nM = nM_; nN = nN_; nwg = nM * nN; G = G_; c = c_; }
    __host__ __device__ bool next(int i, Unit& u) const {
        const long L = (long)i * G + c; if (L >= nwg) return false;
        int wgid = (int)L; { const int q = nwg / NXCD, r = nwg % NXCD, xcd = wgid % NXCD, off = wgid / NXCD; wgid = (xcd < r ? xcd * (q + 1) : r * (q + 1) + (xcd - r) * q) + off; }
        const int nig = WGM * nN, gid = wgid / nig, fm = gid * WGM, gsz = (nM - fm) < WGM ? (nM - fm) : WGM;
        u.pm = fm + ((wgid % nig) % gsz); u.pn = (wgid % nig) / gsz; u.e = 0; return true;
    }
};
struct DenseSched {
    static constexpr bool GATHER = false, B_TILED = false;
    StaticOrder o; const char* A; const char* B; size_t tstep;
    DI bool next(int i, Unit& u) const { return o.next(i, u); }
    DI const char* a_ptr(const Unit& u) const { return A + (size_t)u.pm * tstep; }
    DI const char* b_ptr(const Unit& u) const { return B + (size_t)u.pn * tstep; }
    DI void a_voff(const Unit&, int K, const int (&R)[2], const int (&C)[2], unsigned (&vo)[2][2]) const {
#pragma unroll
        for (int h = 0; h < 2; ++h)
#pragma unroll
            for (int i = 0; i < 2; ++i) vo[h][i] = (unsigned)((h * HALF + R[i]) * K + C[i]) * 2u; }
};
struct MoeSched {
    static constexpr bool GATHER = false, B_TILED = true;
    StaticOrder o; const char* A; const char* B; const int* tile_e; size_t tstep, estep;
    DI bool next(int i, Unit& u) const { if (!o.next(i, u)) return false; u.e = tile_e[u.pm]; return true; }
    DI const char* a_ptr(const Unit& u) const { return A + (size_t)u.pm * tstep; }
    DI const char* b_ptr(const Unit& u) const { return B + (size_t)u.e * estep + (size_t)u.pn * tstep; }
    DI void a_voff(const Unit&, int K, const int (&R)[2], const int (&C)[2], unsigned (&vo)[2][2]) const {
#pragma unroll
        for (int h = 0; h < 2; ++h)
#pragma unroll
            for (int i = 0; i < 2; ++i) vo[h][i] = (unsigned)((h * HALF + R[i]) * K + C[i]) * 2u; }
};
struct MoeGatherSched {
    static constexpr bool GATHER = true, B_TILED = true;
    StaticOrder o; const char* A; const char* B; const int* tile_e; const int* rtok; size_t tstep, estep;
    DI bool next(int i, Unit& u) const { if (!o.next(i, u)) return false; u.e = tile_e[u.pm]; return true; }
    DI const char* a_ptr(const Unit&) const { return A; }
    DI const char* b_ptr(const Unit& u) const { return B + (size_t)u.e * estep + (size_t)u.pn * tstep; }
    DI void a_voff(const Unit& u, int K, const int (&R)[2], const int (&C)[2], unsigned (&vo)[2][2]) const {
#pragma unroll
        for (int h = 0; h < 2; ++h)
#pragma unroll
            for (int i = 0; i < 2; ++i) vo[h][i] = (unsigned)(rtok[u.pm * BM + h * HALF + R[i]] * K + C[i]) * 2u; }
};

DI unsigned cvt_pk_bf16(float lo, float hi) { unsigned r; asm volatile("v_cvt_pk_bf16_f32 %0, %1, %2" : "=v"(r) : "v"(lo), "v"(hi)); return r; }

template <class Epi, class Sched, bool ALIGN_EPI = true>
DI void gemm_phase(LAS unsigned char* lds, const int K, const Sched& S, const Epi& E) {
    const int tid = fresh_tid(), wid = __builtin_amdgcn_readfirstlane(tid >> 6), lane = tid & 63, wr = wid >> 2, wc = wid & 3, fr = lane & 15, fq = lane >> 4;
    const int nt = K / BK;
    constexpr bool GA = Sched::GATHER, BT = Sched::B_TILED;
    unsigned voffA[2][2], voffAn[2][2], voffB[2]; int sR[2], sC[2];
#pragma unroll
    for (int i = 0; i < 2; ++i) { int R, C; stage_rc(tid * 16 + i * 8192, R, C); const int Rb = Epi::PERM ? ((R & ~31) + perm32(R & 31)) : R;
        sR[i] = R; sC[i] = C; voffB[i] = BT ? (unsigned)(tid * 16 + i * 8192) : (unsigned)(Rb * K + C) * 2u; }
    const size_t kstep = (size_t)(BK * 2);
    const size_t hstep = (size_t)HALF * K * 2;
    const size_t kstepB = BT ? (size_t)(2 * HTB) : kstep, hstepB = BT ? (size_t)HTB : hstep;
    const unsigned ldsw = (unsigned)wid * 1024u;
    const int aoff = lds_byte(wr * 64 + fr, fq * 8), boff = lds_byte(wc * 32 + fr, fq * 8);
#define PG8_SA(b, h) (((b) * 2 + (h)) * HTB)
#define PG8_SB(b, h) ((4 + (b) * 2 + (h)) * HTB)
#define PG8_STAGE(bufoff, gbase, voff) do { _Pragma("unroll") for (int _i = 0; _i < 2; ++_i) \
        __builtin_amdgcn_global_load_lds((const unsigned*)((const char*)(gbase) + (voff)[_i]), (LAS unsigned*)(lds + (bufoff) + ldsw + _i * 8192), 16, 0, 0); } while (0)
#define PG8_LDA(dst, b, h) do { _Pragma("unroll") for (int m = 0; m < 4; ++m) _Pragma("unroll") for (int k = 0; k < 2; ++k) dst[m][k] = *(const LAS bf16x8*)(lds + PG8_SA(b, h) + aoff + m * 2048 + k * 1024); } while (0)
#define PG8_LDB(dst, b, h) do { _Pragma("unroll") for (int n = 0; n < 2; ++n) _Pragma("unroll") for (int k = 0; k < 2; ++k) dst[n][k] = *(const LAS bf16x8*)(lds + PG8_SB(b, h) + boff + n * 2048 + k * 1024); } while (0)
#define PG8_MMA(ai, bj, At, Bt) do { __builtin_amdgcn_s_setprio(1); _Pragma("unroll") for (int m = 0; m < 4; ++m) _Pragma("unroll") for (int n = 0; n < 2; ++n) _Pragma("unroll") for (int k = 0; k < 2; ++k) \
        acc[ai][bj][m][n] = __builtin_amdgcn_mfma_f32_16x16x32_bf16(Bt[n][k], At[m][k], acc[ai][bj][m][n], 0, 0, 0); __builtin_amdgcn_s_setprio(0); } while (0)
#define PG8_WAIT_V(n) asm volatile("s_waitcnt vmcnt(" #n ")" ::: "memory")
#define PG8_WAIT_L(n) asm volatile("s_waitcnt lgkmcnt(" #n ")" ::: "memory")
#define PG8_BAR __builtin_amdgcn_s_barrier()
#define PG8_SCHED __builtin_amdgcn_sched_barrier(0)
    Unit cur, nxt; int ui = 0;
    if (!S.next(0, cur)) return;
    f32x4 acc[2][2][4][2];
#pragma unroll
    for (int a = 0; a < 2; ++a)
#pragma unroll
        for (int b = 0; b < 2; ++b)
#pragma unroll
            for (int m = 0; m < 4; ++m)
#pragma unroll
                for (int n = 0; n < 2; ++n) acc[a][b][m][n] = (f32x4){0.f, 0.f, 0.f, 0.f};
    bf16x8 At[4][2], B0[2][2], B1[2][2];
    const char* cA = S.a_ptr(cur); const char* cB = S.b_ptr(cur);
    S.a_voff(cur, K, sR, sC, voffA);
#define PG8_STAGE_A(bufoff, kbase, h, vo) do { if constexpr (GA) { PG8_STAGE(bufoff, kbase, (vo)[h]); } else { PG8_STAGE(bufoff, (kbase) + (h) * hstep, voffA[0]); } } while (0)
    PG8_STAGE(PG8_SB(0, 0), cB, voffB); PG8_STAGE(PG8_SB(0, 1), cB + hstepB, voffB); PG8_STAGE_A(PG8_SA(0, 0), cA, 0, voffA); PG8_STAGE_A(PG8_SA(0, 1), cA, 1, voffA);
    if (wr == 1) PG8_BAR;
    PG8_WAIT_V(2); PG8_BAR;
    PG8_STAGE(PG8_SB(1, 0), cB + kstepB, voffB); PG8_STAGE_A(PG8_SA(1, 0), cA + kstep, 0, voffA); PG8_STAGE(PG8_SB(1, 1), cB + hstepB + kstepB, voffB);
    PG8_WAIT_V(6); PG8_BAR;
    for (;;) {
        const bool has_next = S.next(ui + 1, nxt);
        const char* nA = has_next ? S.a_ptr(nxt) : cA; const char* nB = has_next ? S.b_ptr(nxt) : cB;
        if constexpr (GA) { if (has_next) S.a_voff(nxt, K, sR, sC, voffAn);
            else {
#pragma unroll
                for (int h = 0; h < 2; ++h)
#pragma unroll
                    for (int i = 0; i < 2; ++i) voffAn[h][i] = voffA[h][i]; } }
        for (int t = 0; t < nt; t += 2) {
            const bool last = (t == nt - 2);
            const char* a1 = cA + (size_t)(t + 1) * kstep;
            const char* a2 = last ? nA : cA + (size_t)(t + 2) * kstep; const char* b2 = last ? nB : cB + (size_t)(t + 2) * kstepB;
            const char* a3 = a2 + kstep; const char* b3 = b2 + kstepB;
            unsigned vs[2][2];
            if constexpr (GA) {
#pragma unroll
                for (int i = 0; i < 2; ++i) { vs[0][i] = last ? voffAn[0][i] : voffA[0][i]; vs[1][i] = last ? voffAn[1][i] : voffA[1][i]; } }
            PG8_LDB(B0, 0, 0); PG8_LDB(B1, 0, 1); PG8_SCHED; PG8_LDA(At, 0, 0); PG8_STAGE_A(PG8_SA(1, 1), a1, 1, voffA);
            PG8_WAIT_V(8); PG8_WAIT_L(0); PG8_BAR; PG8_MMA(0, 0, At, B0); PG8_MMA(0, 1, At, B1); PG8_BAR; PG8_SCHED;
            PG8_LDA(At, 0, 1); PG8_STAGE(PG8_SB(0, 0), b2, voffB); PG8_STAGE(PG8_SB(0, 1), b2 + hstepB, voffB); PG8_STAGE_A(PG8_SA(0, 0), a2, 0, vs);
            PG8_WAIT_V(8); PG8_WAIT_L(0); PG8_BAR; PG8_MMA(1, 0, At, B0); PG8_MMA(1, 1, At, B1); PG8_BAR; PG8_SCHED;
            PG8_LDB(B0, 1, 0); PG8_LDB(B1, 1, 1); PG8_SCHED; PG8_LDA(At, 1, 0); PG8_STAGE_A(PG8_SA(0, 1), a2, 1, vs);
            PG8_WAIT_V(8); PG8_WAIT_L(0); PG8_BAR; PG8_MMA(0, 0, At, B0); PG8_MMA(0, 1, At, B1); PG8_BAR; PG8_SCHED;
            PG8_LDA(At, 1, 1); PG8_STAGE(PG8_SB(1, 0), b3, voffB); PG8_STAGE(PG8_SB(1, 1), b3 + hstepB, voffB); PG8_STAGE_A(PG8_SA(1, 0), a3, 0, vs);
            PG8_WAIT_V(8); PG8_WAIT_L(0); PG8_BAR; PG8_MMA(1, 0, At, B0); PG8_MMA(1, 1, At, B1); PG8_BAR; PG8_SCHED;
        }
        if constexpr (ALIGN_EPI) { if (wr == 0) PG8_BAR; }
        E(acc, cur, wr, wc, fr, fq);
        if (!has_next) break;
#pragma unroll
        for (int a = 0; a < 2; ++a)
#pragma unroll
            for (int b = 0; b < 2; ++b)
#pragma unroll
                for (int m = 0; m < 4; ++m)
#pragma unroll
                    for (int n = 0; n < 2; ++n) acc[a][b][m][n] = (f32x4){0.f, 0.f, 0.f, 0.f};
        cur = nxt; cA = nA; cB = nB; ++ui;
        if constexpr (GA) {
#pragma unroll
            for (int h = 0; h < 2; ++h)
#pragma unroll
                for (int i = 0; i < 2; ++i) voffA[h][i] = voffAn[h][i]; }
        if constexpr (ALIGN_EPI) { if (wr == 1) PG8_BAR; }
    }
    PG8_WAIT_V(0);
    if constexpr (!ALIGN_EPI) { if (wr == 0) PG8_BAR; }
    PG8_BAR;
#undef PG8_SA
#undef PG8_SB
#undef PG8_STAGE
#undef PG8_STAGE_A
#undef PG8_LDA
#undef PG8_LDB
#undef PG8_MMA
#undef PG8_WAIT_V
#undef PG8_WAIT_L
#undef PG8_BAR
#undef PG8_SCHED
}
}
using pg8::Unit;
using pg8::cvt_pk_bf16;

DI float bflo(unsigned w) { return __uint_as_float(w << 16); }
DI float bfhi(unsigned w) { return __uint_as_float(w & 0xffff0000u); }
DI float bf2f(bf16 b) { return __uint_as_float(((unsigned)b) << 16); }
typedef __bf16 hwbf2 __attribute__((ext_vector_type(2)));
DI unsigned pk2(float lo, float hi) { const f32x2 v = {lo, hi}; return __builtin_bit_cast(unsigned, __builtin_convertvector(v, hwbf2)); }
DI unsigned f2bf(float f) { return pk2(f, 0.f) & 0xffffu; }
DI float rcp_f(float x) { return __builtin_amdgcn_rcpf(x); }
DI float rsq_f(float x) { return __builtin_amdgcn_rsqf(x); }
DI float sigmoid_f(float x) { return rcp_f(1.0f + __expf(-x)); }
DI float tanh_fast(float x) { return 1.0f - 2.0f * rcp_f(__expf(2.0f * x) + 1.0f); }
DI float softplus_f(float x) { return fmaxf(x, 0.f) + __logf(1.0f + __expf(-fabsf(x))); }
DI float softplus_fast(float x) { return fmaxf(x, 0.f) + __logf(1.0f + __expf(-fabsf(x))); }
DI float gelu_tanh_f(float x) { const float u = 0.7978845608028654f * (x + 0.044715f * x * x * x); return 0.5f * x * (1.0f + tanh_fast(u)); }
DI float wave_sum(float v) {
#pragma unroll
    for (int o = 1; o < 64; o <<= 1) v += __shfl_xor(v, o);
    return v;
}

struct EpiBf16Plain {
    static constexpr bool PERM = true;
    bf16* O; int ldc; float scale;
    DI void operator()(const f32x4 (&acc)[2][2][4][2], const Unit& u, int wr, int wc, int fr, int fq) const {
        const int row0 = u.pm * 256 + wr * 64 + fr, col0 = u.pn * 256 + wc * 32 + 8 * fq;
#pragma unroll
        for (int ai = 0; ai < 2; ++ai)
#pragma unroll
            for (int m = 0; m < 4; ++m) { bf16* rowp = O + (size_t)(row0 + ai * 128 + m * 16) * ldc + col0;
#pragma unroll
                for (int bj = 0; bj < 2; ++bj) { const f32x4 v0 = acc[ai][bj][m][0] * scale, v1 = acc[ai][bj][m][1] * scale;
                    u32x4 w; w.x = cvt_pk_bf16(v0[0], v0[1]); w.y = cvt_pk_bf16(v0[2], v0[3]); w.z = cvt_pk_bf16(v1[0], v1[1]); w.w = cvt_pk_bf16(v1[2], v1[3]);
                    *(u32x4*)(rowp + bj * 128) = w; } }
    }
};
template <bool RES_BF16> struct EpiBf16Res {
    static constexpr bool PERM = true;
    const void* Rz; bf16* O; int ldc;
    DI void operator()(const f32x4 (&acc)[2][2][4][2], const Unit& u, int wr, int wc, int fr, int fq) const {
        const int row0 = u.pm * 256 + wr * 64 + fr, col0 = u.pn * 256 + wc * 32 + 8 * fq;
#pragma unroll
        for (int ai = 0; ai < 2; ++ai)
#pragma unroll
            for (int m = 0; m < 4; ++m) { const size_t off = (size_t)(row0 + ai * 128 + m * 16) * ldc + col0;
#pragma unroll
                for (int bj = 0; bj < 2; ++bj) { f32x4 r0, r1;
                    if (RES_BF16) { const u32x4 rw = *(const u32x4*)((const bf16*)Rz + off + bj * 128); r0 = (f32x4){bflo(rw.x), bfhi(rw.x), bflo(rw.y), bfhi(rw.y)}; r1 = (f32x4){bflo(rw.z), bfhi(rw.z), bflo(rw.w), bfhi(rw.w)}; }
                    else { r0 = *(const f32x4*)((const float*)Rz + off + bj * 128); r1 = *(const f32x4*)((const float*)Rz + off + bj * 128 + 4); }
                    const f32x4 v0 = r0 + acc[ai][bj][m][0], v1 = r1 + acc[ai][bj][m][1];
                    u32x4 w; w.x = cvt_pk_bf16(v0[0], v0[1]); w.y = cvt_pk_bf16(v0[2], v0[3]); w.z = cvt_pk_bf16(v1[0], v1[1]); w.w = cvt_pk_bf16(v1[2], v1[3]);
                    *(u32x4*)(O + off + bj * 128) = w; } }
    }
};
struct EpiLora {
    static constexpr bool PERM = false;
    float* LWp; bf16* AAp; bf16* GGp; const float* w0; const float* a0;
    DI void operator()(const f32x4 (&acc)[2][2][4][2], const Unit& u, int wr, int wc, int fr, int fq) const {
        const int kind = u.pn >> 1;
        const int row0 = u.pm * 256 + wr * 64 + fr, col0 = (u.pn & 1) * 256 + wc * 32 + 4 * fq;
#pragma unroll
        for (int bj = 0; bj < 2; ++bj)
#pragma unroll
            for (int n = 0; n < 2; ++n) {
                const int c = col0 + bj * 128 + n * 16;
                f32x4 bias = (f32x4){0.f, 0.f, 0.f, 0.f};
                if (kind == 0) bias = *(const f32x4*)(w0 + c); else if (kind == 1) bias = *(const f32x4*)(a0 + c);
#pragma unroll
                for (int ai = 0; ai < 2; ++ai)
#pragma unroll
                    for (int m = 0; m < 4; ++m) {
                        f32x4 v = acc[ai][bj][m][n] + bias;
                        if (kind == 0) {
#pragma unroll
                            for (int j = 0; j < 4; ++j) { const float w = -softplus_fast(-v[j]) - 0.5f; v[j] = -__expf(w);     }
                        } else if (kind == 1) {
#pragma unroll
                            for (int j = 0; j < 4; ++j) v[j] = sigmoid_f(v[j]);
                        }
                        const size_t o_ = (size_t)(row0 + ai * 128 + m * 16) * 512 + c;
                        if (kind == 0) *(f32x4*)(LWp + o_) = v;
                        else { u32x2 w_; w_.x = cvt_pk_bf16(v[0], v[1]); w_.y = cvt_pk_bf16(v[2], v[3]); *(u32x2*)((kind == 1 ? AAp : GGp) + o_) = w_; }
                    }
            }
    }
};
struct EpiSwiglu {
    static constexpr bool PERM = true;
    bf16* ACT; const float* b_gu;
    DI void operator()(const f32x4 (&acc)[2][2][4][2], const Unit& u, int wr, int wc, int fr, int fq) const {
        const int row0 = u.pm * 256 + wr * 64 + fr, j0 = u.pn * 128 + wc * 32 + 8 * fq;
        const float* bg = b_gu + (size_t)u.e * 2048 + j0; const float* bu = bg + 1024;
        const f32x4 bg0 = *(const f32x4*)bg, bg1 = *(const f32x4*)(bg + 4), bu0 = *(const f32x4*)bu, bu1 = *(const f32x4*)(bu + 4);
#pragma unroll
        for (int ai = 0; ai < 2; ++ai)
#pragma unroll
            for (int m = 0; m < 4; ++m) {
                float o[8];
#pragma unroll
                for (int n = 0; n < 2; ++n) { const f32x4 g4 = acc[ai][0][m][n] + (n ? bg1 : bg0), u4 = acc[ai][1][m][n] + (n ? bu1 : bu0);
#pragma unroll
                    for (int j = 0; j < 4; ++j) { const float g = fminf(g4[j], 7.0f), up = fminf(fmaxf(u4[j], -7.0f), 7.0f); o[n * 4 + j] = (up + 1.0f) * (g * sigmoid_f(1.702f * g)); } }
                u32x4 w; w.x = cvt_pk_bf16(o[0], o[1]); w.y = cvt_pk_bf16(o[2], o[3]); w.z = cvt_pk_bf16(o[4], o[5]); w.w = cvt_pk_bf16(o[6], o[7]);
                *(u32x4*)(ACT + (size_t)(row0 + ai * 128 + m * 16) * 1024 + j0) = w;
            }
    }
};
struct EpiDown {
    static constexpr bool PERM = true;
    bf16* YS; const float* b_dn; const int* row_slot; const float* row_gate;
    DI void operator()(const f32x4 (&acc)[2][2][4][2], const Unit& u, int wr, int wc, int fr, int fq) const {
        const int row0 = u.pm * 256 + wr * 64 + fr, col0 = u.pn * 256 + wc * 32 + 8 * fq;
        const float* bb = b_dn + (size_t)u.e * 1024 + col0;
        f32x4 bv[2][2];
#pragma unroll
        for (int bj = 0; bj < 2; ++bj)
#pragma unroll
            for (int n = 0; n < 2; ++n) bv[bj][n] = *(const f32x4*)(bb + bj * 128 + 4 * n);
#pragma unroll
        for (int ai = 0; ai < 2; ++ai)
#pragma unroll
            for (int m = 0; m < 4; ++m) {
                const int r = row0 + ai * 128 + m * 16; const int slot = row_slot[r]; const float gt = row_gate[r];
                if (slot >= 0) { bf16* rowp = YS + (size_t)slot * 1024 + col0;
#pragma unroll
                    for (int bj = 0; bj < 2; ++bj) { const f32x4 v0 = (acc[ai][bj][m][0] + bv[bj][0]) * gt, v1 = (acc[ai][bj][m][1] + bv[bj][1]) * gt;
                        u32x4 w; w.x = cvt_pk_bf16(v0[0], v0[1]); w.y = cvt_pk_bf16(v0[2], v0[3]); w.z = cvt_pk_bf16(v1[0], v1[1]); w.w = cvt_pk_bf16(v1[2], v1[3]);
                        *(u32x4*)(rowp + bj * 128) = w; } }
            }
    }
};

constexpr size_t MiB = 1u << 20;
constexpr size_t WS_CTL = 0, CTL_ZERO_BYTES = 1 * MiB;
constexpr size_t WS_WIN = 1 * MiB, WS_WOUT = 7 * MiB, WS_WQ = 9 * MiB, WS_WK = 11 * MiB, WS_WV = 13 * MiB, WS_WO = 15 * MiB, WS_LORAB = 17 * MiB, WS_LRUW = 18 * MiB;
constexpr size_t WS_ROUTE = 19 * MiB;
constexpr size_t WS_WGU = 22 * MiB, WS_WDN = 150 * MiB;
constexpr size_t WS_HN = 214 * MiB, WS_MEMN = 246 * MiB, WS_KM = 248 * MiB, WS_VT = 250 * MiB;
constexpr size_t WS_X1 = 252 * MiB, WS_X2 = 316 * MiB;
constexpr size_t WS_U = 380 * MiB, WS_R = 468 * MiB, WS_KRAW = 500 * MiB, WS_V = 532 * MiB, WS_KKN = 564 * MiB, WS_WD = 596 * MiB, WS_AA = 628 * MiB, WS_G = 660 * MiB;
constexpr size_t WS_LA = 692 * MiB, WS_LB = 724 * MiB, WS_AP = 756 * MiB, WS_CAT = 764 * MiB, WS_Q = 796 * MiB;
constexpr size_t WS_XS = 380 * MiB, WS_ACT = 524 * MiB, WS_YS = 668 * MiB;
constexpr size_t WS_GP = 796 * MiB, WS_HF = 860 * MiB, WS_RP = 924 * MiB, WS_Y1F = 940 * MiB, WS_ADD = 972 * MiB, WS_END = 1004 * MiB;
constexpr size_t WS_GC = 468 * MiB, WS_HC = 484 * MiB, WS_ZS = 500 * MiB;
static_assert(WS_AA == WS_WD + 32 * MiB && WS_G == WS_AA + 32 * MiB, "EpiLora strides");
static_assert(WS_U + (size_t)M * INW * 2 <= WS_R && WS_XS + (size_t)MAXROWS * 2048 <= WS_ACT && WS_ACT + (size_t)MAXROWS * 2048 <= WS_YS && WS_YS + (size_t)NASSIGN * 2048 <= WS_Q, "ws map");
constexpr size_t RT_E = 0, RT_POS = 256 * 1024, RT_G = 512 * 1024, RT_SLOT = 768 * 1024, RT_GATE = 1088 * 1024, RT_TILE = 1408 * 1024, RT_TOK = 1472 * 1024;
constexpr int CW_BAR = 4096, CW_CNT = 8192;

constexpr int RING_BYTES = 131072, MISC_OFF = RING_BYTES + 320, LDS_BYTES = 147456;
constexpr int NWAVES = 8, NTHREADS = 512;

#define XB_TMO      128
#define XB_XCNT(j)  (256  + 64 * (j))
#define XB_XSUB(j)  (1280 + 64 * (j))
#define XB_XGEN(j)  (2304 + 64 * (j))
#define XB_TOP      3328
#define XB_TOPGEN   3392
#define XCD_BAR_WORDS 3456
#define XB_SPIN_CAP (1u << 18)
DI unsigned xb_ld(unsigned* p)              { return __hip_atomic_load(p, __ATOMIC_RELAXED, __HIP_MEMORY_SCOPE_AGENT); }
DI unsigned xb_add(unsigned* p, unsigned v) { return __hip_atomic_fetch_add(p, v, __ATOMIC_RELAXED, __HIP_MEMORY_SCOPE_AGENT); }
DI unsigned xb_xcc_id() { return (unsigned)__builtin_amdgcn_s_getreg((3 << 11) | 20) & 0xFu; }
#define XB_SPIN(cond, bar) do { unsigned _sp = 0; while (cond) { __builtin_amdgcn_s_sleep(1); \
    if ((++_sp & 255u) == 0u) { if (xb_ld(&(bar)[XB_TMO])) break; if (_sp > XB_SPIN_CAP) { atomicAdd(&(bar)[XB_TMO], 1u); break; } } } } while (0)
struct XcdBarrier { unsigned* bar; unsigned x; volatile LAS unsigned* st; };
DI XcdBarrier xcd_barrier_post(unsigned* bar, volatile LAS unsigned* st) {
    XcdBarrier b; b.bar = bar; b.x = xb_xcc_id(); b.st = st;
    if (threadIdx.x == 0) (void)xb_add(&bar[XB_XCNT(b.x)], 1u);
    return b;
}
DI void xcd_barrier_complete(unsigned* bar, unsigned x, unsigned& nloc, unsigned& nx) {
    const unsigned G = gridDim.x * gridDim.y * gridDim.z;
    unsigned sum, cnt, mine, sp = 0u;
    for (;;) {
        sum = 0u; cnt = 0u; mine = 0u;
#pragma unroll
        for (unsigned j = 0; j < 16; ++j) { const unsigned c = xb_ld(&bar[XB_XCNT(j)]); sum += c; cnt += (c > 0u) ? 1u : 0u; mine = (j == x) ? c : mine; }
        if (sum == G) break;
        __builtin_amdgcn_s_sleep(1);
        if ((++sp & 255u) == 0u) { if (xb_ld(&bar[XB_TMO])) break; if (sp > XB_SPIN_CAP) { atomicAdd(&bar[XB_TMO], 1u); break; } }
    }
    nloc = mine > 0u ? mine : 1u; nx = cnt > 0u ? cnt : 1u;
}
DI void xcd_barrier(const XcdBarrier& b) {
    asm volatile("s_waitcnt vmcnt(0)" ::: "memory");
    __syncthreads();
    if (threadIdx.x == 0) {
        unsigned* bar = b.bar;
        __builtin_amdgcn_s_waitcnt(0);
        unsigned nloc = b.st[0], nx = b.st[1];
        if (nloc == 0u) { xcd_barrier_complete(bar, b.x, nloc, nx); b.st[0] = nloc; b.st[1] = nx; }
        const unsigned old = xb_add(&bar[XB_XSUB(b.x)], 1u);
        const unsigned gen = old / nloc;
        if (old + 1u == (gen + 1u) * nloc) {
            __builtin_amdgcn_fence(__ATOMIC_RELEASE, "agent");
            asm volatile("s_waitcnt vmcnt(0)" ::: "memory");
            const unsigned og = xb_add(&bar[XB_TOP], 1u);
            const unsigned tg = og / nx;
            if (og + 1u == (tg + 1u) * nx) xb_add(&bar[XB_TOPGEN], 1u);
            else XB_SPIN(xb_ld(&bar[XB_TOPGEN]) == tg, bar);
            __builtin_amdgcn_fence(__ATOMIC_ACQUIRE, "agent");
            xb_add(&bar[XB_XGEN(b.x)], 1u);
            asm volatile("s_waitcnt vmcnt(0)" ::: "memory");
        } else {
            XB_SPIN(xb_ld(&bar[XB_XGEN(b.x)]) == gen, bar);
            __builtin_amdgcn_fence(__ATOMIC_ACQUIRE, "agent");
            asm volatile("s_waitcnt vmcnt(0)" ::: "memory");
        }
    }
    __syncthreads();
}

struct Args { const float* in[37]; float* out; unsigned char* ws; int ph_lo, ph_hi; };
enum { I_X = 0, I_MEM, I_NMIXG, I_WIN, I_CONVW, I_CONVB, I_LWX, I_LBX, I_LWA, I_LBA, I_LAM, I_MU, I_W0, I_WUP, I_A0, I_AUP, I_GUP, I_KK, I_KA, I_RK, I_LNG, I_LNB,
       I_WOUT, I_NXAG, I_NMEMG, I_WQ, I_WK, I_WV, I_WO, I_NFFG, I_WR, I_BR, I_WGU, I_BGU, I_WDN, I_BDN, I_FNG };

DI void transpose_item(const float* W, int ldw, int K, bf16* WT, int k0, int n0, int drow0, LAS float* scr, int lane) {
    f32x4 t[8];
    const float* src = W + (size_t)(k0 + (lane >> 3)) * ldw + n0 + 4 * (lane & 7);
#pragma unroll
    for (int i = 0; i < 8; ++i) t[i] = *(const f32x4*)(src + (size_t)(8 * i) * ldw);
#pragma unroll
    for (int i = 0; i < 8; ++i) { LAS float* d = scr + (8 * i + (lane >> 3)) * 33 + 4 * (lane & 7); d[0] = t[i].x; d[1] = t[i].y; d[2] = t[i].z; d[3] = t[i].w; }
    asm volatile("s_waitcnt lgkmcnt(0)" ::: "memory");
    const int c = lane & 7;
#pragma unroll
    for (int j = 0; j < 4; ++j) { const int n = (lane >> 3) + 8 * j; const LAS float* s = scr + (8 * c) * 33 + n;
        u32x4 o; o.x = pk2(s[0 * 33], s[1 * 33]); o.y = pk2(s[2 * 33], s[3 * 33]); o.z = pk2(s[4 * 33], s[5 * 33]); o.w = pk2(s[6 * 33], s[7 * 33]);
        *(u32x4*)(WT + (size_t)(drow0 + n) * K + k0 + 8 * c) = o; }
    asm volatile("s_waitcnt lgkmcnt(0)" ::: "memory");
}
DI void transpose_item_tiled(const float* W, int ldw, int K, bf16* WTe, int k0, int n0, int drow0, LAS float* scr, int lane) {
    f32x4 t[8];
    const float* src = W + (size_t)(k0 + (lane >> 3)) * ldw + n0 + 4 * (lane & 7);
#pragma unroll
    for (int i = 0; i < 8; ++i) t[i] = *(const f32x4*)(src + (size_t)(8 * i) * ldw);
#pragma unroll
    for (int i = 0; i < 8; ++i) { LAS float* d = scr + (8 * i + (lane >> 3)) * 33 + 4 * (lane & 7); d[0] = t[i].x; d[1] = t[i].y; d[2] = t[i].z; d[3] = t[i].w; }
    asm volatile("s_waitcnt lgkmcnt(0)" ::: "memory");
    const int c = lane & 7;
#pragma unroll
    for (int j = 0; j < 4; ++j) { const int n = (lane >> 3) + 8 * j; const LAS float* s = scr + (8 * c) * 33 + n;
        u32x4 o; o.x = pk2(s[0 * 33], s[1 * 33]); o.y = pk2(s[2 * 33], s[3 * 33]); o.z = pk2(s[4 * 33], s[5 * 33]); o.w = pk2(s[6 * 33], s[7 * 33]);
        const int drow = drow0 + n, pn = drow >> 8, half = (drow >> 7) & 1, r = drow & 127, x = r & 31;
        const int rslot = (r & ~31) + 16 * ((x >> 2) & 1) + 4 * (x >> 3) + (x & 3);
        const size_t tb = ((size_t)(pn * (K / 64) + (k0 >> 6)) * 2 + half) * 16384 + pg8::lds_byte(rslot, 8 * c);
        *(u32x4*)((char*)WTe + tb) = o; }
    asm volatile("s_waitcnt lgkmcnt(0)" ::: "memory");
}
DI void rms_row_to_bf16(const float* xrow, const float* g, bf16* orow, int lane) {
    const f32x4* xr = (const f32x4*)xrow + lane; const f32x4* gr = (const f32x4*)g + lane;
    f32x4 v[4]; float s = 0.f;
#pragma unroll
    for (int j = 0; j < 4; ++j) { v[j] = xr[64 * j]; s += (v[j].x * v[j].x + v[j].y * v[j].y) + (v[j].z * v[j].z + v[j].w * v[j].w); }
    const float rstd = rsq_f(wave_sum(s) * (1.f / D) + EPS);
    u32x2* o8 = (u32x2*)orow + lane;
#pragma unroll
    for (int j = 0; j < 4; ++j) { const f32x4 gg = gr[64 * j]; u32x2 w; w.x = pk2(v[j].x * rstd * gg.x, v[j].y * rstd * gg.y); w.y = pk2(v[j].z * rstd * gg.z, v[j].w * rstd * gg.w); o8[64 * j] = w; }
}

DI void rms_rowbf_to_bf16(const bf16* xrow, const float* g, bf16* orow, int lane) {
    float v[16]; float s = 0.f;
#pragma unroll
    for (int hf = 0; hf < 2; ++hf) { const u32x4 w = *(const u32x4*)(xrow + 512 * hf + 8 * lane);
#pragma unroll
        for (int q = 0; q < 4; ++q) { v[8 * hf + 2 * q] = bflo(w[q]); v[8 * hf + 2 * q + 1] = bfhi(w[q]); } }
#pragma unroll
    for (int j = 0; j < 16; ++j) s += v[j] * v[j];
    const float rstd = rsq_f(wave_sum(s) * (1.f / D) + EPS);
#pragma unroll
    for (int hf = 0; hf < 2; ++hf) { const f32x4 g0 = *(const f32x4*)(g + 512 * hf + 8 * lane), g1 = *(const f32x4*)(g + 512 * hf + 8 * lane + 4);
        u32x4 w; w.x = pk2(v[8 * hf] * rstd * g0.x, v[8 * hf + 1] * rstd * g0.y); w.y = pk2(v[8 * hf + 2] * rstd * g0.z, v[8 * hf + 3] * rstd * g0.w);
        w.z = pk2(v[8 * hf + 4] * rstd * g1.x, v[8 * hf + 5] * rstd * g1.y); w.w = pk2(v[8 * hf + 6] * rstd * g1.z, v[8 * hf + 7] * rstd * g1.w);
        *(u32x4*)(orow + 512 * hf + 8 * lane) = w; }
}

__global__ void __launch_bounds__(NTHREADS, 2) fwd(Args args) {
    extern __shared__ __attribute__((aligned(16))) unsigned char lds_raw[];
    LAS unsigned char* lds = (LAS unsigned char*)lds_raw;
    volatile LAS unsigned* MISC = (volatile LAS unsigned*)(lds + MISC_OFF);
    const int G = gridDim.x, bid = blockIdx.x, NGW = G * NWAVES;
#define PHASE_IDS const int tid = fresh_tid(), lane = tid & 63, wave = __builtin_amdgcn_readfirstlane(tid >> 6), gw = bid * NWAVES + wave; (void)tid; (void)lane; (void)wave; (void)gw
    unsigned char* ws = args.ws;
    unsigned* ctl = (unsigned*)(ws + WS_CTL);
    const int lo = args.ph_lo, hi = args.ph_hi;

    for (int u = threadIdx.x; u < (LDS_BYTES - RING_BYTES) / 4; u += NTHREADS) ((LAS unsigned*)(lds + RING_BYTES))[u] = 0u;
    __syncthreads();
    XcdBarrier bar; bar.bar = ctl + CW_BAR; bar.x = 0; bar.st = nullptr;
    if (hi - lo > 1) bar = xcd_barrier_post(ctl + CW_BAR, MISC + 8);
#define IN(k) (lo <= (k) && (k) < hi)
#define SEAM(k) do { if (IN(k) && IN((k) + 1)) xcd_barrier(bar); } while (0)

#define Win_t ((bf16*)(ws + WS_WIN))
#define Wout_t ((bf16*)(ws + WS_WOUT))
#define Wq_t ((bf16*)(ws + WS_WQ))
#define Wk_t ((bf16*)(ws + WS_WK))
#define Wv_t ((bf16*)(ws + WS_WV))
#define Wo_t ((bf16*)(ws + WS_WO))
#define LoraB ((bf16*)(ws + WS_LORAB))
#define LruW ((bf16*)(ws + WS_LRUW))
#define WrT ((bf16*)(ws + WS_LRUW + 512 * 1024))
#define Wgu_t ((bf16*)(ws + WS_WGU))
#define Wdn_t ((bf16*)(ws + WS_WDN))
#define HN ((bf16*)(ws + WS_HN))
#define MEMN ((bf16*)(ws + WS_MEMN))
#define KM ((bf16*)(ws + WS_KM))
#define VT ((bf16*)(ws + WS_VT))
#define X1 ((bf16*)(ws + WS_X1))
#define X2 ((bf16*)(ws + WS_X2))
#define U ((bf16*)(ws + WS_U))
#define Rr ((float*)(ws + WS_R))
#define KRAW ((float*)(ws + WS_KRAW))
#define Vv ((float*)(ws + WS_V))
#define KKN ((float*)(ws + WS_KKN))
#define WD ((float*)(ws + WS_WD))
#define AA ((float*)(ws + WS_AA))
#define GG ((float*)(ws + WS_G))
#define LA ((bf16*)(ws + WS_LA))
#define LB ((bf16*)(ws + WS_LB))
#define AP ((bf16*)(ws + WS_AP))
#define CAT ((bf16*)(ws + WS_CAT))
#define Qb ((bf16*)(ws + WS_Q))
#define Ob CAT
#define XS ((bf16*)(ws + WS_XS))
#define ACT ((bf16*)(ws + WS_ACT))
#define YS ((bf16*)(ws + WS_YS))
#define route_e ((int*)(ws + WS_ROUTE + RT_E))
#define route_pos ((int*)(ws + WS_ROUTE + RT_POS))
#define route_g ((float*)(ws + WS_ROUTE + RT_G))
#define row_slot ((int*)(ws + WS_ROUTE + RT_SLOT))
#define row_gate ((float*)(ws + WS_ROUTE + RT_GATE))
#define tile_tab ((int*)(ws + WS_ROUTE + RT_TILE))
#define row_tok ((int*)(ws + WS_ROUTE + RT_TOK))
#define ecnt (ctl + CW_CNT)

    if (IN(0)) { PHASE_IDS;
        LAS float* scr = (LAS float*)(lds + wave * 16384);
        constexpr int I_IN = 16 * (INW / 32), I_SQ = 16 * 32;
        constexpr int N_ITEMS = I_IN + 5 * I_SQ;
        for (int it = gw; it < N_ITEMS; it += NGW) {
            int r = it;
            if (r < I_IN) { const int nblk = INW / 32, kb = r / nblk, nb = r % nblk; transpose_item(args.in[I_WIN], INW, D, Win_t, 64 * kb, 32 * nb, 32 * nb, scr, lane); continue; } r -= I_IN;
            { const int w = r / I_SQ, q = r % I_SQ, kb = q / 32, nb = q % 32;
                const float* src = w == 0 ? args.in[I_WOUT] : w == 1 ? args.in[I_WQ] : w == 2 ? args.in[I_WK] : w == 3 ? args.in[I_WV] : args.in[I_WO];
                bf16* dst = w == 0 ? Wout_t : w == 1 ? Wq_t : w == 2 ? Wk_t : w == 3 ? Wv_t : Wo_t;
                transpose_item(src, D, D, dst, 64 * kb, 32 * nb, 32 * nb, scr, lane); }
        }
        for (int idx = bid * NTHREADS + tid; idx < 1536 * 256; idx += G * NTHREADS) {
            const int n = idx >> 8, k = idx & 255; float v = 0.f;
            if (n < 512) { if (k < 64) v = args.in[I_WUP][k * 512 + n]; }
            else if (n < 1024) { if (k >= 64 && k < 128) v = args.in[I_AUP][(k - 64) * 512 + (n - 512)]; }
            else { if (k >= 128) v = args.in[I_GUP][(k - 128) * 512 + (n - 1024)]; }
            LoraB[idx] = (bf16)f2bf(v);
        }
        for (int idx = bid * NTHREADS + tid; idx < 8 * 128 * 64; idx += G * NTHREADS) {
            const int nb = idx >> 13, col = (idx >> 6) & 127, k = idx & 63;
            const float v = col < 64 ? args.in[I_LWX][nb * 4096 + k * 64 + col] : args.in[I_LWA][nb * 4096 + k * 64 + (col - 64)];
            LruW[idx] = (bf16)f2bf(v);
        }
        for (int idx = bid * NTHREADS + tid; idx < NE * D; idx += G * NTHREADS) {
            const int e = idx >> 10, k = idx & 1023; const float v = args.in[I_WR][k * NE + e];
            const unsigned hi = f2bf(v); const float lo = v - __uint_as_float(hi << 16);
            WrT[idx] = (bf16)hi; WrT[NE * D + idx] = (bf16)f2bf(lo);
        }
        for (int m = gw; m < M; m += NGW) rms_row_to_bf16(args.in[I_X] + (size_t)m * D, args.in[I_NMIXG], HN + (size_t)m * D, lane);
        for (int m = gw; m < MROWS; m += NGW) rms_row_to_bf16(args.in[I_MEM] + (size_t)m * D, args.in[I_NMEMG], MEMN + (size_t)m * D, lane);
        {
            LAS float* scr = (LAS float*)(lds + wave * 16384);
            constexpr int I_GU = 16 * 64, I_DN = 16 * 32;
            for (int it = gw; it < NE * (I_GU + I_DN); it += NGW) {
                int r = it;
                if (r < NE * I_GU) { const int e = r / I_GU, q = r % I_GU, kb = q / 64, nb = q % 64; const int n0 = 32 * nb;
                    const int drow = n0 < 1024 ? (256 * (n0 >> 7) + (n0 & 127)) : (256 * ((n0 - 1024) >> 7) + 128 + ((n0 - 1024) & 127));
                    transpose_item_tiled(args.in[I_WGU] + (size_t)e * D * 2048, 2048, D, Wgu_t + (size_t)e * 2048 * D, 64 * kb, n0, drow, scr, lane); continue; } r -= NE * I_GU;
                { const int e = r / I_DN, q = r % I_DN, kb = q / 32, nb = q % 32;
                  transpose_item_tiled(args.in[I_WDN] + (size_t)e * DFF * D, D, DFF, Wdn_t + (size_t)e * D * DFF, 64 * kb, 32 * nb, 32 * nb, scr, lane); }
            }
        }
    }
    SEAM(0);

    if (IN(1)) { PHASE_IDS;
        { pg8::DenseSched S; S.o.init_tiles(M / 256, INW / 256, G, bid); S.A = (const char*)HN; S.B = (const char*)Win_t; S.tstep = (size_t)256 * D * 2;
          EpiBf16Plain E{U, INW, 1.0f}; pg8::gemm_phase(lds, D, S, E); }
        { pg8::DenseSched S; S.o.init_tiles(MROWS / 256, D / 256, G, (bid + 64) & (G - 1)); S.A = (const char*)MEMN; S.B = (const char*)Wk_t; S.tstep = (size_t)256 * D * 2;
          EpiBf16Plain E{KM, D, 1.0f}; pg8::gemm_phase(lds, D, S, E); }
        { pg8::DenseSched S; S.o.init_tiles(D / 256, MROWS / 256, G, (bid + 48) & (G - 1)); S.A = (const char*)Wv_t; S.B = (const char*)MEMN; S.tstep = (size_t)256 * D * 2;
          EpiBf16Plain E{VT, MROWS, 1.0f}; pg8::gemm_phase(lds, D, S, E); }
    }
    SEAM(1);

    if (IN(2)) { PHASE_IDS;
        {
            const float* conv_w = args.in[I_CONVW]; const float* conv_b = args.in[I_CONVB]; const float* bx = args.in[I_LBX]; const float* ba = args.in[I_LBA]; const float* lam = args.in[I_LAM];
            LAS float* xs = (LAS float*)(lds + wave * 4096);
            const int i = lane & 15, kg = lane >> 4;
            for (int unit = gw; unit < (M / 16) * 2; unit += NGW) {
                const int tile = unit >> 1, nb0 = (unit & 1) * 4, m0 = tile * 16, s0 = m0 & (SEQ - 1);
                for (int nb = nb0; nb < nb0 + 4; ++nb) {
                    bf16x8 af[2];
#pragma unroll
                    for (int ks = 0; ks < 2; ++ks) {
                        const int chb = nb * 64 + 32 * ks + 8 * kg;
                        f32x4 x0 = *(const f32x4*)(conv_b + chb), x1 = *(const f32x4*)(conv_b + chb + 4);
#pragma unroll
                        for (int j = 0; j < 4; ++j) {
                            if (s0 + i - 3 + j >= 0) {
                                const u32x4 uw = *(const u32x4*)(U + (size_t)(m0 + i - 3 + j) * INW + chb);
                                const f32x4 w0 = *(const f32x4*)(conv_w + j * 512 + chb), w1 = *(const f32x4*)(conv_w + j * 512 + chb + 4);
                                x0.x += w0.x * bflo(uw.x); x0.y += w0.y * bfhi(uw.x); x0.z += w0.z * bflo(uw.y); x0.w += w0.w * bfhi(uw.y);
                                x1.x += w1.x * bflo(uw.z); x1.y += w1.y * bfhi(uw.z); x1.z += w1.z * bflo(uw.w); x1.w += w1.w * bfhi(uw.w);
                            }
                        }
                        *(LAS f32x4*)(xs + i * 64 + 32 * ks + 8 * kg) = x0; *(LAS f32x4*)(xs + i * 64 + 32 * ks + 8 * kg + 4) = x1;
                        u32x4 p; p.x = pk2(x0.x, x0.y); p.y = pk2(x0.z, x0.w); p.z = pk2(x1.x, x1.y); p.w = pk2(x1.z, x1.w);
                        af[ks] = __builtin_bit_cast(bf16x8, p);
                    }
                    f32x4 acc[8];
#pragma unroll
                    for (int ct = 0; ct < 8; ++ct) { acc[ct] = (f32x4){0.f, 0.f, 0.f, 0.f};
#pragma unroll
                        for (int ks = 0; ks < 2; ++ks) { const bf16x8 bfr = *(const bf16x8*)(LruW + ((size_t)(nb * 128 + 16 * ct + i) * 64 + 32 * ks + 8 * kg));
                            acc[ct] = __builtin_amdgcn_mfma_f32_16x16x32_bf16(af[ks], bfr, acc[ct], 0, 0, 0); } }
                    asm volatile("s_waitcnt lgkmcnt(0)" ::: "memory");
#pragma unroll
                    for (int ct = 0; ct < 4; ++ct) {
                        const int col = 16 * ct + i, ch = nb * 64 + col;
                        const float bxv = bx[ch], bav = ba[ch], sp = softplus_f(-lam[ch]);
#pragma unroll
                        for (int e = 0; e < 4; ++e) {
                            const int tok = 4 * kg + e;
                            const float gx = sigmoid_f(acc[ct][e] + bxv), ga = sigmoid_f(acc[ct + 4][e] + bav);
                            const float la = -8.0f * ga * sp, xcv = xs[tok * 64 + col];
                            const float bt = __builtin_amdgcn_sqrtf(fmaxf(1.0f - __expf(2.0f * la), 0.f)) * gx * xcv;
                            LA[(size_t)(m0 + tok) * 512 + ch] = (bf16)f2bf(la); LB[(size_t)(m0 + tok) * 512 + ch] = (bf16)f2bf(bt);
                        }
                    }
                }
            }
        }
    }
    SEAM(2);


#define RW_ZB(zz, zb) do { _Pragma("unroll") for (int ks_ = 0; ks_ < 2; ++ks_) { u32x4 p_; p_.x = pk2(zz[2 * ks_][0], zz[2 * ks_][1]); p_.y = pk2(zz[2 * ks_][2], zz[2 * ks_][3]); \
        p_.z = pk2(zz[2 * ks_ + 1][0], zz[2 * ks_ + 1][1]); p_.w = pk2(zz[2 * ks_ + 1][2], zz[2 * ks_ + 1][3]); zb[ks_] = __builtin_bit_cast(bf16x8, p_); } } while (0)
    if (IN(3)) { PHASE_IDS;
        for (int u64 = gw; u64 < NB * NH * (SEQ / 64); u64 += NGW) {
#pragma unroll 1
        for (int jj = 0; jj < 4; ++jj) {
        LAS unsigned char* wl = lds + wave * 16384;
        LAS bf16* Arm = (LAS bf16*)(wl); LAS bf16* Brm = (LAS bf16*)(wl + 2048); LAS bf16* Krm = (LAS bf16*)(wl + 4096); LAS bf16* Rrm = (LAS bf16*)(wl + 6144);
        LAS bf16* ATt = (LAS bf16*)(wl + 8192); LAS bf16* BTt = (LAS bf16*)(wl + 10240); LAS bf16* KTt = (LAS bf16*)(wl + 12288); LAS bf16* VTt = (LAS bf16*)(wl + 14336);
        LAS float* MabT = (LAS float*)(wl); LAS bf16* Mak = (LAS bf16*)(wl + 1024); LAS bf16* Mrb = (LAS bf16*)(wl + 1536); LAS bf16* Mrk = (LAS bf16*)(wl + 2048); LAS bf16* Tm = (LAS bf16*)(wl + 2560);
        LAS float* PLs = (LAS float*)(wl + 3072); LAS bf16* Q0T = (LAS bf16*)(wl + 4096);
        const int lane = fresh_tid() & 63, l15 = lane & 15, g = lane >> 4, te = lane >> 2, kq = lane & 3;
        const bf16x8 z8 = (bf16x8){0, 0, 0, 0, 0, 0, 0, 0};
        const f32x4 z4 = (f32x4){0.f, 0.f, 0.f, 0.f};
            const int un = u64 * 4 + jj;
            const int bh = un >> 8, c = un & 255, b = bh >> 3, h = bh & 7;
            const size_t mrow = (size_t)b * SEQ + c * 16 + te, off = mrow * 512 + h * 64 + 16 * kq;
            const int hc = h * 64 + 16 * kq;
            LAS float* tmpL = (LAS float*)wl;
            {
                const size_t mr = (size_t)b * SEQ + c * 16 + l15; const bool hp2 = (mr & (SEQ - 1)) != 0;
                const bf16* ua = U + mr * INW + 2560 + 8 * g;
                bf16x8 af[8];
#pragma unroll
                for (int ks = 0; ks < 8; ++ks) {
                    const u32x4 cu = *(const u32x4*)(ua + 32 * ks); u32x4 pu = (u32x4){0u, 0u, 0u, 0u}; if (hp2) pu = *(const u32x4*)(ua - INW + 32 * ks);
                    const f32x4 m0 = *(const f32x4*)(args.in[I_MU] + 1536 + 32 * ks + 8 * g), m1 = *(const f32x4*)(args.in[I_MU] + 1536 + 32 * ks + 8 * g + 4);
                    float o8[8];
#pragma unroll
                    for (int q = 0; q < 4; ++q) { const float c0 = bflo(cu[q]), c1 = bfhi(cu[q]), p0 = bflo(pu[q]), p1 = bfhi(pu[q]); const float mm0 = q < 2 ? m0[2 * q] : m1[2 * q - 4], mm1 = q < 2 ? m0[2 * q + 1] : m1[2 * q - 3];
                        float x0 = c0 + (p0 - c0) * mm0, x1 = c1 + (p1 - c1) * mm1;
                        if (ks < 2) { x0 = tanh_fast(x0); x1 = tanh_fast(x1); }
                        else if (ks >= 4) { x0 = sigmoid_f(x0); x1 = sigmoid_f(x1); }
                        o8[2 * q] = x0; o8[2 * q + 1] = x1; }
                    u32x4 pw; pw.x = pk2(o8[0], o8[1]); pw.y = pk2(o8[2], o8[3]); pw.z = pk2(o8[4], o8[5]); pw.w = pk2(o8[6], o8[7]); af[ks] = __builtin_bit_cast(bf16x8, pw);
                }
#pragma unroll
                for (int kind = 0; kind < 3; ++kind)
#pragma unroll
                    for (int ct = 0; ct < 4; ++ct) {
                        const bf16* lb = LoraB + (size_t)(kind * 512 + h * 64 + 16 * ct + l15) * 256 + 8 * g;
                        f32x4 a4 = z4;
#pragma unroll
                        for (int ks = (kind == 0 ? 0 : kind == 1 ? 2 : 4); ks < (kind == 0 ? 2 : kind == 1 ? 4 : 8); ++ks) a4 = __builtin_amdgcn_mfma_f32_16x16x32_bf16(af[ks], *(const bf16x8*)(lb + 32 * ks), a4, 0, 0, 0);
#pragma unroll
                        for (int e = 0; e < 4; ++e) tmpL[kind * 1088 + (4 * g + e) * 68 + 16 * ct + l15] = a4[e];
                    }
            }
            asm volatile("s_waitcnt lgkmcnt(0)" ::: "memory");
            float cl[16], eP[16];
            {
                float lwv[16], rl[16], kl[16], vl[16], kn[16], av[16];
                const bool hp = (mrow & (SEQ - 1)) != 0;
                const bf16* ub = U + mrow * INW + 1024 + hc;
#pragma unroll
                for (int hh = 0; hh < 2; ++hh) {
#pragma unroll
                    for (int a3 = 0; a3 < 3; ++a3) {
                        const u32x4 cu = *(const u32x4*)(ub + 512 * a3 + 8 * hh); u32x4 pu = (u32x4){0u, 0u, 0u, 0u}; if (hp) pu = *(const u32x4*)(ub - INW + 512 * a3 + 8 * hh);
                        const f32x4 m0 = *(const f32x4*)(args.in[I_MU] + 512 * a3 + hc + 8 * hh), m1 = *(const f32x4*)(args.in[I_MU] + 512 * a3 + hc + 8 * hh + 4);
                        float o8[8];
#pragma unroll
                        for (int q = 0; q < 4; ++q) { const float c0 = bflo(cu[q]), c1 = bfhi(cu[q]), p0 = bflo(pu[q]), p1 = bfhi(pu[q]); const float mm0 = q < 2 ? m0[2 * q] : m1[2 * q - 4], mm1 = q < 2 ? m0[2 * q + 1] : m1[2 * q - 3];
                            o8[2 * q] = c0 + (p0 - c0) * mm0; o8[2 * q + 1] = c1 + (p1 - c1) * mm1; }
#pragma unroll
                        for (int q = 0; q < 8; ++q) { if (a3 == 0) rl[8 * hh + q] = o8[q]; else if (a3 == 1) kl[8 * hh + q] = o8[q]; else vl[8 * hh + q] = o8[q]; }
                    }
                }
                float gv[16];
#pragma unroll
                for (int j4 = 0; j4 < 4; ++j4) { const f32x4 xl = *(const LAS f32x4*)(tmpL + te * 68 + 16 * kq + 4 * j4), xa = *(const LAS f32x4*)(tmpL + 1088 + te * 68 + 16 * kq + 4 * j4), xg = *(const LAS f32x4*)(tmpL + 2176 + te * 68 + 16 * kq + 4 * j4);
                    const f32x4 w0v = *(const f32x4*)(args.in[I_W0] + hc + 4 * j4), a0v = *(const f32x4*)(args.in[I_A0] + hc + 4 * j4);
#pragma unroll
                    for (int q = 0; q < 4; ++q) { const float wq = -softplus_fast(-(xl[q] + w0v[q])) - 0.5f; lwv[4 * j4 + q] = -__expf(wq); av[4 * j4 + q] = sigmoid_f(xa[q] + a0v[q]); gv[4 * j4 + q] = xg[q]; } }
                asm volatile("s_waitcnt lgkmcnt(0)" ::: "memory");
                float ss = 0.f;
#pragma unroll
                for (int j4 = 0; j4 < 4; ++j4) { const f32x4 kk4 = *(const f32x4*)(args.in[I_KK] + hc + 4 * j4);
#pragma unroll
                    for (int q = 0; q < 4; ++q) { kn[4 * j4 + q] = kl[4 * j4 + q] * kk4[q]; ss += kn[4 * j4 + q] * kn[4 * j4 + q]; } }
                ss += __shfl_xor(ss, 1); ss += __shfl_xor(ss, 2);
                const float kinv = rsq_f(fmaxf(ss, 1e-24f));
#pragma unroll
                for (int j = 0; j < 16; ++j) { float x = lwv[j];
#pragma unroll
                    for (int sft = 4; sft < 64; sft <<= 1) { const float y = __shfl_up(x, sft); if (lane >= sft) x += y; }
                    cl[j] = x; }
                float bon = 0.f;
                u32x4 pa[2], pb[2], pk[2], pr[2];
#pragma unroll
                for (int j4 = 0; j4 < 4; ++j4) {
                    const f32x4 ka = *(const f32x4*)(args.in[I_KA] + hc + 4 * j4), rk = *(const f32x4*)(args.in[I_RK] + hc + 4 * j4);
                    float at4[4], bt4[4], kt4[4], rt4[4];
#pragma unroll
                    for (int q = 0; q < 4; ++q) { const int j = 4 * j4 + q;
                        const float p = __expf(cl[j]), pn = __expf(-cl[j]), pm1 = __expf(cl[j] - lwv[j]); eP[j] = p;
                        const float knj = kn[j] * kinv;
                        const float kp = kl[j] * (1.0f + (av[j] - 1.0f) * ka[q]);
                        at4[q] = -knj * pm1; bt4[q] = knj * av[j] * pn; kt4[q] = kp * pn; rt4[q] = rl[j] * p;
                        bon += rl[j] * kp * rk[q];
                        const int kk = 16 * kq + j;
                        ATt[kk * 16 + te] = (bf16)f2bf(at4[q]); BTt[kk * 16 + te] = (bf16)f2bf(bt4[q]); KTt[kk * 16 + te] = (bf16)f2bf(kt4[q]); VTt[kk * 16 + te] = (bf16)f2bf(vl[j]); }
                    const int hh = j4 >> 1, w2 = (j4 & 1) * 2;
                    pa[hh][w2] = pk2(at4[0], at4[1]); pa[hh][w2 + 1] = pk2(at4[2], at4[3]); pb[hh][w2] = pk2(bt4[0], bt4[1]); pb[hh][w2 + 1] = pk2(bt4[2], bt4[3]);
                    pk[hh][w2] = pk2(kt4[0], kt4[1]); pk[hh][w2 + 1] = pk2(kt4[2], kt4[3]); pr[hh][w2] = pk2(rt4[0], rt4[1]); pr[hh][w2 + 1] = pk2(rt4[2], rt4[3]);
                }
#pragma unroll
                for (int hh = 0; hh < 2; ++hh) { const int po = te * 64 + 8 * ((2 * kq + hh) ^ (te & 7));
                    *(LAS u32x4*)(Arm + po) = pa[hh]; *(LAS u32x4*)(Brm + po) = pb[hh]; *(LAS u32x4*)(Krm + po) = pk[hh]; *(LAS u32x4*)(Rrm + po) = pr[hh]; }
                bon += __shfl_xor(bon, 1); bon += __shfl_xor(bon, 2);
#pragma unroll
                for (int j4 = 0; j4 < 4; ++j4) { const f32x4 lb = *(const f32x4*)(args.in[I_LNB] + hc + 4 * j4), lgn = *(const f32x4*)(args.in[I_LNG] + hc + 4 * j4); const int j0 = 4 * j4;
                    u32x2 ow, gw2; ow.x = pk2((lb.x + vl[j0] * bon) * gv[j0], (lb.y + vl[j0 + 1] * bon) * gv[j0 + 1]); ow.y = pk2((lb.z + vl[j0 + 2] * bon) * gv[j0 + 2], (lb.w + vl[j0 + 3] * bon) * gv[j0 + 3]);
                    gw2.x = pk2(lgn.x * gv[j0], lgn.y * gv[j0 + 1]); gw2.y = pk2(lgn.z * gv[j0 + 2], lgn.w * gv[j0 + 3]);
                    *(u32x2*)((bf16*)(ws + WS_ADD) + off + j0) = ow; *(u32x2*)((bf16*)(ws + WS_G) + off + j0) = gw2; }
            }
            asm volatile("s_waitcnt lgkmcnt(0)" ::: "memory");
            {
                bf16x8 fa[2], fr[2], fb[2], fk[2];
#pragma unroll
                for (int ks = 0; ks < 2; ++ks) { const int po = l15 * 64 + 8 * ((4 * ks + g) ^ (l15 & 7));
                    fa[ks] = *(const LAS bf16x8*)(Arm + po); fr[ks] = *(const LAS bf16x8*)(Rrm + po); fb[ks] = *(const LAS bf16x8*)(Brm + po); fk[ks] = *(const LAS bf16x8*)(Krm + po); }
                f32x4 mab = z4, mak = z4, mrb = z4, mrk = z4;
#pragma unroll
                for (int ks = 0; ks < 2; ++ks) { mab = __builtin_amdgcn_mfma_f32_16x16x32_bf16(fb[ks], fa[ks], mab, 0, 0, 0); mak = __builtin_amdgcn_mfma_f32_16x16x32_bf16(fk[ks], fa[ks], mak, 0, 0, 0);
                    mrb = __builtin_amdgcn_mfma_f32_16x16x32_bf16(fb[ks], fr[ks], mrb, 0, 0, 0); mrk = __builtin_amdgcn_mfma_f32_16x16x32_bf16(fk[ks], fr[ks], mrk, 0, 0, 0); }
#pragma unroll
                for (int e = 0; e < 4; ++e) { const int i = 4 * g + e; if (!(i < l15)) { mab[e] = 0.f; mak[e] = 0.f; } if (!(i <= l15)) { mrb[e] = 0.f; mrk[e] = 0.f; } }
                asm volatile("s_waitcnt lgkmcnt(0)" ::: "memory");
#pragma unroll
                for (int e = 0; e < 4; ++e) MabT[(4 * g + e) * 16 + l15] = mab[e];
                u32x2 w; w.x = pk2(mak[0], mak[1]); w.y = pk2(mak[2], mak[3]); *(LAS u32x2*)(Mak + l15 * 16 + 4 * g) = w;
                w.x = pk2(mrb[0], mrb[1]); w.y = pk2(mrb[2], mrb[3]); *(LAS u32x2*)(Mrb + l15 * 16 + 4 * g) = w;
                w.x = pk2(mrk[0], mrk[1]); w.y = pk2(mrk[2], mrk[3]); *(LAS u32x2*)(Mrk + l15 * 16 + 4 * g) = w;
                if (te == 15) {
#pragma unroll
                    for (int j = 0; j < 16; ++j) PLs[16 * kq + j] = eP[j]; }
            }
            asm volatile("s_waitcnt lgkmcnt(0)" ::: "memory");
            {
                float y[16];
#pragma unroll
                for (int j = 15; j >= 0; --j) {
                    float acc = (j == l15) ? 1.0f : 0.0f;
                    float row[16];
#pragma unroll
                    for (int q = 0; q < 4; ++q) { const f32x4 x = *(const LAS f32x4*)(MabT + j * 16 + 4 * q); row[4 * q] = x.x; row[4 * q + 1] = x.y; row[4 * q + 2] = x.z; row[4 * q + 3] = x.w; }
#pragma unroll
                    for (int i = j + 1; i < 16; ++i) acc += y[i] * row[i];
                    y[j] = acc;
                }
                if (g == 0) { u32x4 t0, t1; t0.x = pk2(y[0], y[1]); t0.y = pk2(y[2], y[3]); t0.z = pk2(y[4], y[5]); t0.w = pk2(y[6], y[7]); t1.x = pk2(y[8], y[9]); t1.y = pk2(y[10], y[11]); t1.z = pk2(y[12], y[13]); t1.w = pk2(y[14], y[15]);
                    *(LAS u32x4*)(Tm + l15 * 16) = t0; *(LAS u32x4*)(Tm + l15 * 16 + 8) = t1; }
            }
            asm volatile("s_waitcnt lgkmcnt(0)" ::: "memory");
            {
                const bool act = g < 2; const int fo = l15 * 16 + 8 * g;
                const bf16x8 fT = act ? *(const LAS bf16x8*)(Tm + fo) : z8, fMak = act ? *(const LAS bf16x8*)(Mak + fo) : z8, fMrb = act ? *(const LAS bf16x8*)(Mrb + fo) : z8, fMrk = act ? *(const LAS bf16x8*)(Mrk + fo) : z8;
                bf16x8 fV[4], fQ1[4], fAh[4], fBT[4], fKT[4];
#pragma unroll
                for (int vt = 0; vt < 4; ++vt) { fV[vt] = act ? *(const LAS bf16x8*)(VTt + vt * 256 + fo) : z8; fBT[vt] = act ? *(const LAS bf16x8*)(BTt + vt * 256 + fo) : z8; fKT[vt] = act ? *(const LAS bf16x8*)(KTt + vt * 256 + fo) : z8; }
#pragma unroll
                for (int vt = 0; vt < 4; ++vt) { const f32x4 q0 = __builtin_amdgcn_mfma_f32_16x16x32_bf16(fMak, fV[vt], z4, 0, 0, 0);
                    u32x2 w; w.x = pk2(q0[0], q0[1]); w.y = pk2(q0[2], q0[3]); *(LAS u32x2*)(Q0T + vt * 256 + l15 * 16 + 4 * g) = w; }
#pragma unroll
                for (int kt = 0; kt < 4; ++kt) { const bf16x8 fA = act ? *(const LAS bf16x8*)(ATt + kt * 256 + fo) : z8; const f32x4 ah = __builtin_amdgcn_mfma_f32_16x16x32_bf16(fT, fA, z4, 0, 0, 0);
                    u32x2 w; w.x = pk2(ah[0], ah[1]); w.y = pk2(ah[2], ah[3]); *(LAS u32x2*)(ATt + kt * 256 + l15 * 16 + 4 * g) = w; }
                asm volatile("s_waitcnt lgkmcnt(0)" ::: "memory");
#pragma unroll
                for (int vt = 0; vt < 4; ++vt) { const bf16x8 fQ0 = act ? *(const LAS bf16x8*)(Q0T + vt * 256 + fo) : z8; const f32x4 q1 = __builtin_amdgcn_mfma_f32_16x16x32_bf16(fT, fQ0, z4, 0, 0, 0);
                    u32x2 w; w.x = pk2(q1[0], q1[1]); w.y = pk2(q1[2], q1[3]); *(LAS u32x2*)(Q0T + vt * 256 + l15 * 16 + 4 * g) = w; }
                asm volatile("s_waitcnt lgkmcnt(0)" ::: "memory");
#pragma unroll
                for (int vt = 0; vt < 4; ++vt) { fQ1[vt] = act ? *(const LAS bf16x8*)(Q0T + vt * 256 + fo) : z8; fAh[vt] = act ? *(const LAS bf16x8*)(ATt + vt * 256 + fo) : z8; }
                bf16* rp = (bf16*)(ws + WS_RP) + (size_t)un * 1024 + l15 * 64;
#pragma unroll
                for (int kt = 0; kt < 4; ++kt) {
                    const u32x2 rr = *(const LAS u32x2*)(Rrm + l15 * 64 + 8 * ((2 * kt + (g >> 1)) ^ (l15 & 7)) + 4 * (g & 1));
                    f32x4 ini; ini[0] = bflo(rr.x); ini[1] = bfhi(rr.x); ini[2] = bflo(rr.y); ini[3] = bfhi(rr.y);
                    const f32x4 rh = __builtin_amdgcn_mfma_f32_16x16x32_bf16(fAh[kt], fMrb, ini, 0, 0, 0);
                    u32x2 w; w.x = pk2(rh[0], rh[1]); w.y = pk2(rh[2], rh[3]); *(u32x2*)(rp + 32 * (kt >> 1) + 8 * g + 4 * (kt & 1)) = w;
                }
#pragma unroll
                for (int vt = 0; vt < 4; ++vt) { f32x4 y1 = __builtin_amdgcn_mfma_f32_16x16x32_bf16(fMrb, fQ1[vt], z4, 0, 0, 0); y1 = __builtin_amdgcn_mfma_f32_16x16x32_bf16(fMrk, fV[vt], y1, 0, 0, 0);
                    *(f32x4*)((float*)(ws + WS_Y1F) + ((size_t)(un * 4 + vt) * 64 + lane) * 4) = y1; }
                bf16* gp = (bf16*)(ws + WS_GP) + (size_t)un * 4096;
#pragma unroll
                for (int krt = 0; krt < 4; ++krt) { const float pl = PLs[16 * krt + l15];
#pragma unroll
                    for (int kct = 0; kct < 4; ++kct) { f32x4 ga = __builtin_amdgcn_mfma_f32_16x16x32_bf16(fAh[kct], fBT[krt], z4, 0, 0, 0);
                        if (kct == krt) {
#pragma unroll
                            for (int e = 0; e < 4; ++e) if (4 * g + e == l15) ga[e] += 1.0f; }
                        u32x2 w; w.x = pk2(ga[0] * pl, ga[1] * pl); w.y = pk2(ga[2] * pl, ga[3] * pl);
                        *(u32x2*)(gp + (16 * krt + l15) * 64 + 32 * (kct >> 1) + 8 * g + 4 * (kct & 1)) = w; } }
#pragma unroll
                for (int mt = 0; mt < 4; ++mt) { const f32x4 pl4 = *(const LAS f32x4*)(PLs + 16 * mt + 4 * g);
#pragma unroll
                    for (int vt = 0; vt < 4; ++vt) { f32x4 ha = __builtin_amdgcn_mfma_f32_16x16x32_bf16(fBT[mt], fQ1[vt], z4, 0, 0, 0); ha = __builtin_amdgcn_mfma_f32_16x16x32_bf16(fKT[mt], fV[vt], ha, 0, 0, 0);
                        u32x2 w; w.x = pk2(ha[0] * pl4[0], ha[1] * pl4[1]); w.y = pk2(ha[2] * pl4[2], ha[3] * pl4[3]);
                        *(u32x2*)((bf16*)(ws + WS_HF) + ((size_t)((un * 4 + vt) * 4 + mt) * 64 + lane) * 4) = w; } }
            }
            asm volatile("s_waitcnt lgkmcnt(0)" ::: "memory");
        }
        asm volatile("s_waitcnt vmcnt(0)" ::: "memory");
        { const int ltid = fresh_tid() & 63, l15 = ltid & 15, g = ltid >> 4, lane = ltid;
#pragma unroll 1
        for (int part = 0; part < 2; ++part) {
            f32x4 z[4][4];
#pragma unroll
            for (int sl = 0; sl < 4; ++sl)
#pragma unroll
                for (int mt = 0; mt < 4; ++mt)
#pragma unroll
                    for (int e = 0; e < 4; ++e) z[sl][mt][e] = (part == 0 && sl == mt && 4 * g + e == l15) ? 1.0f : 0.0f;
#pragma unroll 1
            for (int j = 0; j < 4; ++j) {
                const size_t un = (size_t)u64 * 4 + j;
                const bf16* gp = (const bf16*)(ws + WS_GP) + un * 4096 + l15 * 64 + 8 * g;
                bf16x8 gf[4][2];
#pragma unroll
                for (int mt = 0; mt < 4; ++mt) { gf[mt][0] = *(const bf16x8*)(gp + mt * 1024); gf[mt][1] = *(const bf16x8*)(gp + mt * 1024 + 32); }
#pragma unroll
                for (int sl = 0; sl < 4; ++sl) {
                    bf16x8 zb[2]; RW_ZB(z[sl], zb);
#pragma unroll
                    for (int mt = 0; mt < 4; ++mt) {
                        f32x4 a = (f32x4){0.f, 0.f, 0.f, 0.f};
                        if (part) { const u32x2 hh = *(const u32x2*)((const bf16*)(ws + WS_HF) + ((size_t)((un * 4 + sl) * 4 + mt) * 64 + lane) * 4); a[0] = bflo(hh.x); a[1] = bfhi(hh.x); a[2] = bflo(hh.y); a[3] = bfhi(hh.y); }
                        a = __builtin_amdgcn_mfma_f32_16x16x32_bf16(gf[mt][0], zb[0], a, 0, 0, 0); a = __builtin_amdgcn_mfma_f32_16x16x32_bf16(gf[mt][1], zb[1], a, 0, 0, 0);
                        z[sl][mt] = a;
                    }
                }
            }
            if (part == 0) {
                bf16* gc = (bf16*)(ws + WS_GC) + (size_t)u64 * 4096;
#pragma unroll
                for (int sl = 0; sl < 4; ++sl) { const int pc = 32 * (sl >> 1) + 8 * (l15 >> 2) + 4 * (sl & 1) + (l15 & 3);
#pragma unroll
                    for (int mt = 0; mt < 4; ++mt)
#pragma unroll
                        for (int e = 0; e < 4; ++e) gc[(16 * mt + 4 * g + e) * 64 + pc] = (bf16)f2bf(z[sl][mt][e]); }
            } else {
#pragma unroll
                for (int sl = 0; sl < 4; ++sl)
#pragma unroll
                    for (int mt = 0; mt < 4; ++mt) { u32x2 w; w.x = pk2(z[sl][mt][0], z[sl][mt][1]); w.y = pk2(z[sl][mt][2], z[sl][mt][3]);
                        *(u32x2*)((bf16*)(ws + WS_HC) + ((size_t)((u64 * 4 + sl) * 4 + mt) * 64 + lane) * 4) = w; }
            }
        }
        }
        }
        for (int lu = gw; lu < NB * 8 * 64; lu += NGW) {
            const int bc = lu >> 6, seg = lu & 63, b = bc >> 3, cg = bc & 7, ch = cg * 64 + lane;
            const size_t mb = (size_t)b * SEQ + seg * 64;
            float A = 1.f, B = 0.f;
#pragma unroll 16
            for (int t = 0; t < 64; ++t) { const float a = __expf(bf2f(LA[(mb + t) * 512 + ch])), bt = bf2f(LB[(mb + t) * 512 + ch]); B = a * B + bt; A *= a; }
            f32x2 ab; ab.x = A; ab.y = B; *(f32x2*)((float*)(ws + WS_AP) + ((size_t)lu * 64 + lane) * 2) = ab;
        }
    }
    SEAM(3);


    if (IN(4)) { PHASE_IDS;
        if (!(bid < 128 && wave == 0)) {
            const int wi = bid < 128 ? bid * 7 + (wave - 1) : 896 + (bid - 128) * 8 + wave, NW = 896 + (G - 128) * 8;
        } else {
            const int l15 = lane & 15, g = lane >> 4, bh = bid >> 2, vs = bid & 3;
            f32x4 z[4];
#pragma unroll
            for (int mt = 0; mt < 4; ++mt) z[mt] = (f32x4){0.f, 0.f, 0.f, 0.f};
            bf16x8 gA[4][2], gB[4][2], gC[4][2], gD[4][2]; u32x2 hA[4], hB[4], hC[4], hD[4];
#define SC_LOAD(gf, hf, C) do { const size_t u64_ = (size_t)bh * 64 + (C); const bf16* gp_ = (const bf16*)(ws + WS_GC) + u64_ * 4096 + l15 * 64 + 8 * g; \
                _Pragma("unroll") for (int mt = 0; mt < 4; ++mt) { gf[mt][0] = *(const bf16x8*)(gp_ + mt * 1024); gf[mt][1] = *(const bf16x8*)(gp_ + mt * 1024 + 32); \
                    hf[mt] = *(const u32x2*)((const bf16*)(ws + WS_HC) + ((size_t)((u64_ * 4 + vs) * 4 + mt) * 64 + lane) * 4); } } while (0)
#define SC_STEP(gf, hf, C) do { const size_t u64_ = (size_t)bh * 64 + (C); bf16* zs_ = (bf16*)(ws + WS_ZS) + ((size_t)((u64_ * 4 + vs) * 4) * 64 + lane) * 4; \
                _Pragma("unroll") for (int mt = 0; mt < 4; ++mt) { u32x2 zw_; zw_.x = pk2(z[mt][0], z[mt][1]); zw_.y = pk2(z[mt][2], z[mt][3]); *(u32x2*)(zs_ + mt * 256) = zw_; } \
                bf16x8 zb[2]; RW_ZB(z, zb); \
                _Pragma("unroll") for (int mt = 0; mt < 4; ++mt) { f32x4 a; a[0] = bflo(hf[mt].x); a[1] = bfhi(hf[mt].x); a[2] = bflo(hf[mt].y); a[3] = bfhi(hf[mt].y); \
                    a = __builtin_amdgcn_mfma_f32_16x16x32_bf16(gf[mt][0], zb[0], a, 0, 0, 0); a = __builtin_amdgcn_mfma_f32_16x16x32_bf16(gf[mt][1], zb[1], a, 0, 0, 0); z[mt] = a; } } while (0)
            SC_LOAD(gA, hA, 0); SC_LOAD(gB, hB, 1); SC_LOAD(gC, hC, 2);
#pragma unroll 1
            for (int C = 0; C < 64; C += 4) {
                SC_LOAD(gD, hD, C + 3);
                SC_STEP(gA, hA, C);
                if (C + 4 < 64) SC_LOAD(gA, hA, C + 4);
                SC_STEP(gB, hB, C + 1);
                if (C + 5 < 64) SC_LOAD(gB, hB, C + 5);
                SC_STEP(gC, hC, C + 2);
                if (C + 6 < 64) SC_LOAD(gC, hC, C + 6);
                SC_STEP(gD, hD, C + 3);
            }
#undef SC_LOAD
#undef SC_STEP
        }
    }
    SEAM(4);

    if (IN(5)) { PHASE_IDS;
        {
            for (int lu = gw; lu < NB * 8 * 64; lu += NGW) {
                const int bc = lu >> 6, seg = lu & 63, b = bc >> 3, cg = bc & 7, ch = cg * 64 + lane;
                const size_t mb = (size_t)b * SEQ + seg * 64;
                float hst = 0.f;
                const f32x2* ag = (const f32x2*)((const float*)(ws + WS_AP)) + (size_t)(bc * 64) * 64 + lane;
#pragma unroll 8
                for (int sg = 0; sg < seg; ++sg) { const f32x2 ab = ag[(size_t)sg * 64]; hst = ab.x * hst + ab.y; }
#pragma unroll 16
                for (int t = 0; t < 64; ++t) { const float a = __expf(bf2f(LA[(mb + t) * 512 + ch])), bt = bf2f(LB[(mb + t) * 512 + ch]); hst = a * hst + bt;
                    const float gl = bf2f(U[(mb + t) * INW + 512 + ch]); CAT[(mb + t) * 1024 + ch] = (bf16)f2bf(hst * gelu_tanh_f(gl)); }
            }
        }
        const int l15 = lane & 15, g = lane >> 4;
        for (int u64 = gw; u64 < NB * NH * (SEQ / 64); u64 += NGW) {
            const int bh = u64 >> 6, C = u64 & 63, b = bh >> 3, h = bh & 7;
            f32x4 z[4][4];
#pragma unroll
            for (int sl = 0; sl < 4; ++sl)
#pragma unroll
                for (int mt = 0; mt < 4; ++mt) { const u32x2 zw = *(const u32x2*)((const bf16*)(ws + WS_ZS) + ((size_t)((u64 * 4 + sl) * 4 + mt) * 64 + lane) * 4); z[sl][mt] = (f32x4){bflo(zw.x), bfhi(zw.x), bflo(zw.y), bfhi(zw.y)}; }
#pragma unroll 1
            for (int j = 0; j < 4; ++j) {
                const size_t un = (size_t)u64 * 4 + j; const size_t m0 = (size_t)b * SEQ + (C * 4 + j) * 16;
                const bf16* rp = (const bf16*)(ws + WS_RP) + un * 1024 + l15 * 64 + 8 * g;
                const bf16x8 rf0 = *(const bf16x8*)rp, rf1 = *(const bf16x8*)(rp + 32);
                f32x4 y[4];
#pragma unroll
                for (int sl = 0; sl < 4; ++sl) { bf16x8 zb[2]; RW_ZB(z[sl], zb);
                    f32x4 a = *(const f32x4*)((const float*)(ws + WS_Y1F) + ((size_t)(un * 4 + sl) * 64 + lane) * 4);
                    a = __builtin_amdgcn_mfma_f32_16x16x32_bf16(rf0, zb[0], a, 0, 0, 0); a = __builtin_amdgcn_mfma_f32_16x16x32_bf16(rf1, zb[1], a, 0, 0, 0); y[sl] = a; }
#pragma unroll
                for (int e = 0; e < 4; ++e) {
                    float s1 = (y[0][e] + y[1][e]) + (y[2][e] + y[3][e]);
                    s1 += __shfl_xor(s1, 1); s1 += __shfl_xor(s1, 2); s1 += __shfl_xor(s1, 4); s1 += __shfl_xor(s1, 8);
                    const float mean = s1 * (1.0f / 64.0f);
                    float d0 = y[0][e] - mean, d1 = y[1][e] - mean, d2 = y[2][e] - mean, d3 = y[3][e] - mean;
                    float s2 = (d0 * d0 + d1 * d1) + (d2 * d2 + d3 * d3);
                    s2 += __shfl_xor(s2, 1); s2 += __shfl_xor(s2, 2); s2 += __shfl_xor(s2, 4); s2 += __shfl_xor(s2, 8);
                    const float rstd = rsq_f(s2 * (1.0f / 64.0f) + GN_EPS);
                    const size_t ro = (m0 + 4 * g + e) * 512 + h * 64 + l15;
                    const float dd[4] = {d0, d1, d2, d3};
#pragma unroll
                    for (int sl = 0; sl < 4; ++sl) { const float gg = bf2f(((const bf16*)(ws + WS_G))[ro + 16 * sl]), ad = bf2f(((const bf16*)(ws + WS_ADD))[ro + 16 * sl]);
                        const float o = dd[sl] * rstd * gg + ad;
                        CAT[(m0 + 4 * g + e) * 1024 + 512 + h * 64 + 16 * sl + l15] = (bf16)f2bf(o); }
                }
                if (j < 3) {
                    const bf16* gp = (const bf16*)(ws + WS_GP) + un * 4096 + l15 * 64 + 8 * g;
                    bf16x8 gf[4][2];
#pragma unroll
                    for (int mt = 0; mt < 4; ++mt) { gf[mt][0] = *(const bf16x8*)(gp + mt * 1024); gf[mt][1] = *(const bf16x8*)(gp + mt * 1024 + 32); }
#pragma unroll
                    for (int sl = 0; sl < 4; ++sl) { bf16x8 zb[2]; RW_ZB(z[sl], zb);
#pragma unroll
                        for (int mt = 0; mt < 4; ++mt) { const u32x2 hh = *(const u32x2*)((const bf16*)(ws + WS_HF) + ((size_t)((un * 4 + sl) * 4 + mt) * 64 + lane) * 4);
                            f32x4 a; a[0] = bflo(hh.x); a[1] = bfhi(hh.x); a[2] = bflo(hh.y); a[3] = bfhi(hh.y);
                            a = __builtin_amdgcn_mfma_f32_16x16x32_bf16(gf[mt][0], zb[0], a, 0, 0, 0); a = __builtin_amdgcn_mfma_f32_16x16x32_bf16(gf[mt][1], zb[1], a, 0, 0, 0); z[sl][mt] = a; } }
                }
            }
        }
    }
    SEAM(5);
#undef RW_ZB


    if (IN(6)) { PHASE_IDS;
        pg8::DenseSched S; S.o.init_tiles(M / 256, D / 256, G, bid); S.A = (const char*)CAT; S.B = (const char*)Wout_t; S.tstep = (size_t)256 * D * 2;
        EpiBf16Res<false> E{args.in[I_X], X1, D}; pg8::gemm_phase(lds, D, S, E);
    }
    SEAM(6);
    if (IN(7)) { PHASE_IDS; for (int m = gw; m < M; m += NGW) rms_rowbf_to_bf16(X1 + (size_t)m * D, args.in[I_NXAG], HN + (size_t)m * D, lane); }
    SEAM(7);
    if (IN(8)) { PHASE_IDS;
        pg8::DenseSched S; S.o.init_tiles(M / 256, D / 256, G, bid); S.A = (const char*)HN; S.B = (const char*)Wq_t; S.tstep = (size_t)256 * D * 2;
        EpiBf16Plain E{Qb, D, 0.0625f}; pg8::gemm_phase(lds, D, S, E);
    }
    SEAM(8);
    if (IN(9)) { PHASE_IDS;
        constexpr int KP = 264, VP = 72;
        LAS bf16* Kt = (LAS bf16*)lds;
        LAS bf16* Vt = (LAS bf16*)(lds + 64 * KP * 2);
        const int l15 = lane & 15, g4 = lane >> 4;
        const int bh = bid >> 4, b = bh >> 2, h = bh & 3;
        const int kkey = tid >> 3, kpart = tid & 7, vd = tid >> 1, vhalf = tid & 1;
        const bf16* kg = KM + (size_t)(b * MEML + kkey) * D + h * XHD + 32 * kpart;
        const bf16* vg = VT + (size_t)(h * XHD + vd) * MROWS + b * MEML + 32 * vhalf;
#pragma unroll 1
        for (int u = 0; u < 2; ++u) {
            const int q0 = ((bid & 15) * 2 + u) * 128 + wave * 16;
            const bf16* qbase = Qb + (size_t)(b * SEQ + q0 + l15) * D + h * XHD + 8 * g4;
            bf16x8 qf[8];
#pragma unroll
            for (int ks = 0; ks < 8; ++ks) qf[ks] = *(const bf16x8*)(qbase + 32 * ks);
            f32x4 oc[16];
#pragma unroll
            for (int dt = 0; dt < 16; ++dt) oc[dt] = (f32x4){0.f, 0.f, 0.f, 0.f};
            float mrun = -3.0e38f, lrun = 0.f;
            u32x4 kr[4], vr[4];
#pragma unroll
            for (int i = 0; i < 4; ++i) { kr[i] = *(const u32x4*)(kg + 8 * i); vr[i] = *(const u32x4*)(vg + 8 * i); }
#pragma unroll 1
            for (int kt = 0; kt < 4; ++kt) {
                __syncthreads();
#pragma unroll
                for (int i = 0; i < 4; ++i) { *(LAS u32x4*)(Kt + kkey * KP + 32 * kpart + 8 * i) = kr[i]; *(LAS u32x4*)(Vt + vd * VP + 32 * vhalf + 8 * i) = vr[i]; }
                if (kt < 3) {
#pragma unroll
                    for (int i = 0; i < 4; ++i) { kr[i] = *(const u32x4*)(kg + (size_t)(kt + 1) * 64 * D + 8 * i); vr[i] = *(const u32x4*)(vg + (kt + 1) * 64 + 8 * i); } }
                __syncthreads();
                f32x4 sc[4];
#pragma unroll
                for (int j = 0; j < 4; ++j) sc[j] = (f32x4){0.f, 0.f, 0.f, 0.f};
#pragma unroll
                for (int ks = 0; ks < 8; ++ks)
#pragma unroll
                    for (int j = 0; j < 4; ++j) { const bf16x8 kf = *(const LAS bf16x8*)(Kt + (16 * j + l15) * KP + 32 * ks + 8 * g4);
                        sc[j] = __builtin_amdgcn_mfma_f32_16x16x32_bf16(kf, qf[ks], sc[j], 0, 0, 0); }
                float mx = -3.0e38f;
#pragma unroll
                for (int j = 0; j < 4; ++j) mx = fmaxf(mx, fmaxf(fmaxf(sc[j][0], sc[j][1]), fmaxf(sc[j][2], sc[j][3])));
                mx = fmaxf(mx, __shfl_xor(mx, 16)); mx = fmaxf(mx, __shfl_xor(mx, 32));
                const float mnew = fmaxf(mrun, mx), alpha = __expf(mrun - mnew);
                mrun = mnew; lrun *= alpha;
#pragma unroll
                for (int j = 0; j < 4; ++j)
#pragma unroll
                    for (int e = 0; e < 4; ++e) { const float p = __expf(sc[j][e] - mnew); sc[j][e] = p; lrun += p; }
                bf16x8 pf[2];
#pragma unroll
                for (int s2 = 0; s2 < 2; ++s2) { u32x4 pw; pw.x = pk2(sc[2 * s2][0], sc[2 * s2][1]); pw.y = pk2(sc[2 * s2][2], sc[2 * s2][3]); pw.z = pk2(sc[2 * s2 + 1][0], sc[2 * s2 + 1][1]); pw.w = pk2(sc[2 * s2 + 1][2], sc[2 * s2 + 1][3]);
                    pf[s2] = __builtin_bit_cast(bf16x8, pw); }
#pragma unroll
                for (int dt = 0; dt < 16; ++dt) {
                    f32x4 o = oc[dt] * alpha;
#pragma unroll
                    for (int s2 = 0; s2 < 2; ++s2) { const LAS bf16* vp = Vt + (16 * dt + l15) * VP + 32 * s2 + 4 * g4;
                        const u32x2 v0 = *(const LAS u32x2*)vp, v1 = *(const LAS u32x2*)(vp + 16);
                        u32x4 vv; vv.x = v0.x; vv.y = v0.y; vv.z = v1.x; vv.w = v1.y;
                        o = __builtin_amdgcn_mfma_f32_16x16x32_bf16(__builtin_bit_cast(bf16x8, vv), pf[s2], o, 0, 0, 0); }
                    oc[dt] = o;
                }
            }
            lrun += __shfl_xor(lrun, 16); lrun += __shfl_xor(lrun, 32);
            const float inv = rcp_f(lrun);
            bf16* obase = Ob + (size_t)(b * SEQ + q0 + l15) * D + h * XHD + 4 * g4;
#pragma unroll
            for (int dt = 0; dt < 16; ++dt) { u32x2 w; w.x = pk2(oc[dt][0] * inv, oc[dt][1] * inv); w.y = pk2(oc[dt][2] * inv, oc[dt][3] * inv); *(u32x2*)(obase + 16 * dt) = w; }
        }
        __syncthreads();
    }
    SEAM(9);
    if (IN(10)) { PHASE_IDS;
        pg8::DenseSched S; S.o.init_tiles(M / 256, D / 256, G, bid); S.A = (const char*)Ob; S.B = (const char*)Wo_t; S.tstep = (size_t)256 * D * 2;
        EpiBf16Res<true> E{X1, X2, D}; pg8::gemm_phase(lds, D, S, E);
    }
    SEAM(10);
    if (IN(11)) { PHASE_IDS;
        for (int cid = tid; cid < 2 * NE * 128; cid += NTHREADS) { const int t = cid >> 12, row = (cid >> 7) & 31, c = cid & 127;
            *(LAS u32x4*)(lds + t * 65536 + row * 2048 + ((c ^ (row & 7)) << 4)) = *(const u32x4*)(WrT + (size_t)t * NE * D + row * D + 8 * c); }
        __syncthreads();
        const int l15 = lane & 15, g = lane >> 4;
        LAS float* LG = (LAS float*)(lds + RING_BYTES + 1024 + wave * 2304);
        const float* gfn = args.in[I_NFFG];
        LAS unsigned* cntl = (LAS unsigned*)(lds + RING_BYTES + 640);
        for (int t0 = 0; t0 < M / 16; t0 += G * 4) {
        if (tid < 64) cntl[tid] = 0u;
        __syncthreads();
        const int tile = t0 + bid * 4 + wave; const bool active = wave < 4 && tile < M / 16;
        int me = 0, lpos = 0, ai = 0; float mg = 0.f;
        if (active) {
            const int m0 = tile * 16;
            const bf16* xrow = X2 + (size_t)(m0 + l15) * D + 8 * g;
            float ss = 0.f;
#pragma unroll 8
            for (int ks = 0; ks < 32; ++ks) { const u32x4 xw = *(const u32x4*)(xrow + 32 * ks);
#pragma unroll
                for (int q = 0; q < 4; ++q) { const float a = bflo(xw[q]), c = bfhi(xw[q]); ss += a * a + c * c; } }
            ss += __shfl_xor(ss, 16); ss += __shfl_xor(ss, 32);
            const float rstd = rsq_f(ss * (1.f / D) + EPS);
            f32x4 acc0 = (f32x4){0.f, 0.f, 0.f, 0.f}, acc1 = acc0;
            bf16* hrow = HN + (size_t)(m0 + l15) * D + 8 * g;
#pragma unroll 2
            for (int ks = 0; ks < 32; ++ks) {
                const f32x4 g0 = *(const f32x4*)(gfn + 32 * ks + 8 * g), g1 = *(const f32x4*)(gfn + 32 * ks + 8 * g + 4);
                const u32x4 xw = *(const u32x4*)(xrow + 32 * ks);
                float hf[8];
#pragma unroll
                for (int q = 0; q < 4; ++q) { hf[2 * q] = bflo(xw[q]) * rstd * (q < 2 ? g0[2 * q] : g1[2 * q - 4]); hf[2 * q + 1] = bfhi(xw[q]) * rstd * (q < 2 ? g0[2 * q + 1] : g1[2 * q - 3]); }
                u32x4 hi, lo;
#pragma unroll
                for (int q = 0; q < 4; ++q) { hi[q] = pk2(hf[2 * q], hf[2 * q + 1]); lo[q] = pk2(hf[2 * q] - bflo(hi[q]), hf[2 * q + 1] - bfhi(hi[q])); }
                *(u32x4*)(hrow + 32 * ks) = hi;
                const bf16x8 ah = __builtin_bit_cast(bf16x8, hi), al = __builtin_bit_cast(bf16x8, lo);
                const int c = 4 * ks + g;
#pragma unroll
                for (int nt = 0; nt < 2; ++nt) { const int row = 16 * nt + l15; const int off = row * 2048 + ((c ^ (row & 7)) << 4);
                    const bf16x8 bh = *(const LAS bf16x8*)(lds + off), bl = *(const LAS bf16x8*)(lds + 65536 + off);
                    f32x4 a = nt ? acc1 : acc0;
                    a = __builtin_amdgcn_mfma_f32_16x16x32_bf16(ah, bh, a, 0, 0, 0); a = __builtin_amdgcn_mfma_f32_16x16x32_bf16(ah, bl, a, 0, 0, 0); a = __builtin_amdgcn_mfma_f32_16x16x32_bf16(al, bh, a, 0, 0, 0);
                    if (nt) acc1 = a; else acc0 = a; }
            }
            { const float b0 = args.in[I_BR][l15], b1 = args.in[I_BR][16 + l15];
#pragma unroll
              for (int j = 0; j < 4; ++j) { LG[(4 * g + j) * 33 + l15] = acc0[j] + b0; LG[(4 * g + j) * 33 + 16 + l15] = acc1[j] + b1; } }
            const int rrow = lane >> 2, qq = lane & 3;
            float tv[4] = {-3.0e38f, -3.0e38f, -3.0e38f, -3.0e38f}; int ti[4] = {64, 65, 66, 67};
#define TOP_INS(xv_, xi_) do { float x_ = (xv_); int i_ = (xi_); _Pragma("unroll") for (int p_ = 0; p_ < 4; ++p_) { const bool b_ = x_ > tv[p_] || (x_ == tv[p_] && i_ < ti[p_]); \
                const float ov_ = tv[p_]; const int oi_ = ti[p_]; tv[p_] = b_ ? x_ : ov_; ti[p_] = b_ ? i_ : oi_; x_ = b_ ? ov_ : x_; i_ = b_ ? oi_ : i_; } } while (0)
#pragma unroll
            for (int j = 0; j < 8; ++j) TOP_INS(LG[rrow * 33 + 8 * qq + j], 8 * qq + j);
#pragma unroll
            for (int st = 1; st < 4; st <<= 1) { float pv[4]; int pi[4];
#pragma unroll
                for (int p = 0; p < 4; ++p) { pv[p] = __shfl_xor(tv[p], st); pi[p] = __shfl_xor(ti[p], st); }
#pragma unroll
                for (int p = 0; p < 4; ++p) TOP_INS(pv[p], pi[p]); }
#undef TOP_INS
            const float e1 = __expf(tv[1] - tv[0]), e2 = __expf(tv[2] - tv[0]), e3 = __expf(tv[3] - tv[0]);
            const float inv = rcp_f(1.0f + e1 + e2 + e3);
            me = qq == 0 ? ti[0] : qq == 1 ? ti[1] : qq == 2 ? ti[2] : ti[3];
            mg = (qq == 0 ? 1.0f : qq == 1 ? e1 : qq == 2 ? e2 : e3) * inv;
            lpos = (int)__hip_atomic_fetch_add(cntl + me, 1u, __ATOMIC_RELAXED, __HIP_MEMORY_SCOPE_WORKGROUP);
            ai = (m0 + rrow) * 4 + qq;
        }
        __syncthreads();
        if (tid < NE) { const unsigned c = cntl[tid]; cntl[32 + tid] = c ? atomicAdd(ecnt + 64 * tid, c) : 0u; }
        __syncthreads();
        if (active) { route_e[ai] = me; route_pos[ai] = (int)cntl[32 + me] + lpos; route_g[ai] = mg; }
        __syncthreads();
        }
    }
    SEAM(11);
    if (IN(12)) { PHASE_IDS;
        LAS int* pst = (LAS int*)lds;
        if (tid == 0) { int acc = 0; for (int e = 0; e < NE; ++e) { const int c = (int)__hip_atomic_load(ecnt + 64 * e, __ATOMIC_RELAXED, __HIP_MEMORY_SCOPE_AGENT); pst[e] = acc; pst[64 + e] = c; acc += (c + 255) & ~255; } pst[32] = acc; }
        __syncthreads();
        for (int ai = bid * NTHREADS + tid; ai < NASSIGN; ai += G * NTHREADS) {
            const int e = route_e[ai]; const int row = pst[e] + route_pos[ai]; row_slot[row] = ai; row_gate[row] = route_g[ai]; row_tok[row] = ai >> 2; }
        if (bid < NE) { const int e = bid, c = pst[64 + e], pe = (c + 255) & ~255; for (int p = c + tid; p < pe; p += NTHREADS) { row_slot[pst[e] + p] = -1; row_gate[pst[e] + p] = 0.f; row_tok[pst[e] + p] = 0; } }
        if (bid == 0 && tid == 0) { int nt = 0; for (int e = 0; e < NE; ++e) { const int n = ((pst[64 + e] + 255) & ~255) >> 8; for (int j = 0; j < n; ++j) tile_tab[16 + nt++] = e; } tile_tab[0] = nt; }
        __syncthreads();
    }
    SEAM(12);
    if (IN(13)) { PHASE_IDS;
        const int ntiles = tile_tab[0];
        pg8::MoeGatherSched S; S.o.init_tiles(ntiles, 2048 / 256, G, bid); S.A = (const char*)HN; S.B = (const char*)Wgu_t; S.tile_e = tile_tab + 16; S.rtok = row_tok; S.tstep = (size_t)256 * D * 2; S.estep = (size_t)2048 * D * 2;
        EpiSwiglu E{ACT, args.in[I_BGU]}; pg8::gemm_phase(lds, D, S, E);
    }
    SEAM(13);
    if (IN(14)) { PHASE_IDS;
        const int ntiles = tile_tab[0];
        pg8::MoeSched S; S.o.init_tiles(ntiles, D / 256, G, bid); S.A = (const char*)ACT; S.B = (const char*)Wdn_t; S.tile_e = tile_tab + 16; S.tstep = (size_t)256 * DFF * 2; S.estep = (size_t)D * DFF * 2;
        EpiDown E{YS, args.in[I_BDN], row_slot, row_gate}; pg8::gemm_phase(lds, DFF, S, E);
    }
    SEAM(14);
    if (IN(15)) { PHASE_IDS;
        const float* gfin = args.in[I_FNG];
        for (int m = gw; m < M; m += NGW) {
            float v[16]; float s = 0.f;
#pragma unroll
            for (int hf = 0; hf < 2; ++hf) { const u32x4 w = *(const u32x4*)(X2 + (size_t)m * D + 512 * hf + 8 * lane);
#pragma unroll
                for (int q = 0; q < 4; ++q) { v[8 * hf + 2 * q] = bflo(w[q]); v[8 * hf + 2 * q + 1] = bfhi(w[q]); }
#pragma unroll
                for (int k = 0; k < 4; ++k) { const u32x4 y = *(const u32x4*)(YS + (size_t)(m * 4 + k) * D + 512 * hf + 8 * lane);
#pragma unroll
                    for (int q = 0; q < 4; ++q) { v[8 * hf + 2 * q] += bflo(y[q]); v[8 * hf + 2 * q + 1] += bfhi(y[q]); } } }
#pragma unroll
            for (int j = 0; j < 16; ++j) s += v[j] * v[j];
            const float rstd = rsq_f(wave_sum(s) * (1.f / D) + EPS);
#pragma unroll
            for (int hf = 0; hf < 2; ++hf) { const f32x4 g0 = *(const f32x4*)(gfin + 512 * hf + 8 * lane), g1 = *(const f32x4*)(gfin + 512 * hf + 8 * lane + 4);
                float* o = args.out + (size_t)m * D + 512 * hf + 8 * lane;
                *(f32x4*)o = (f32x4){v[8 * hf] * rstd * g0.x, v[8 * hf + 1] * rstd * g0.y, v[8 * hf + 2] * rstd * g0.z, v[8 * hf + 3] * rstd * g0.w};
                *(f32x4*)(o + 4) = (f32x4){v[8 * hf + 4] * rstd * g1.x, v[8 * hf + 5] * rstd * g1.y, v[8 * hf + 6] * rstd * g1.z, v[8 * hf + 7] * rstd * g1.w}; }
        }
    }
#undef IN
#undef SEAM
}

constexpr int N_PHASES = 16;
extern "C" void kernel_launch(void* const* d_in, const int* in_sizes, int n_in, void* d_out, int out_size, void* d_ws, size_t ws_size, hipStream_t stream) {
    static int grid = 0;
    if (grid == 0) {
        if (n_in != 37 || out_size != M * D || ws_size < WS_END) { fprintf(stderr, "kernel_launch: unexpected shapes (n_in %d, out %d, ws %zu); nothing launched\n", n_in, out_size, ws_size); grid = -1; return; }
        int dev = 0, cus = 0, per_cu = 0;
        if (hipGetDevice(&dev) != hipSuccess || hipDeviceGetAttribute(&cus, hipDeviceAttributeMultiprocessorCount, dev) != hipSuccess) { grid = -1; return; }
        if (hipFuncSetAttribute((const void*)fwd, hipFuncAttributeMaxDynamicSharedMemorySize, LDS_BYTES) != hipSuccess) { fprintf(stderr, "kernel_launch: hipFuncSetAttribute failed\n"); grid = -1; return; }
        if (hipOccupancyMaxActiveBlocksPerMultiprocessor(&per_cu, (const void*)fwd, NTHREADS, LDS_BYTES) != hipSuccess || per_cu < 1) fprintf(stderr, "kernel_launch: occupancy query says %d\n", per_cu);
        (void)hipGetLastError();
        grid = cus > 256 ? 256 : cus;
    }
    if (grid < 0) return;
    if (hipMemsetAsync((char*)d_ws + WS_CTL, 0, CTL_ZERO_BYTES, stream) != hipSuccess) return;
    Args a{};
    for (int i = 0; i < 37; ++i) a.in[i] = (const float*)d_in[i];
    a.out = (float*)d_out; a.ws = (unsigned char*)d_ws;
#if MK_ONE_LAUNCH
    a.ph_lo = 0; a.ph_hi = N_PHASES;
    hipLaunchKernelGGL(fwd, dim3(grid), dim3(NTHREADS), LDS_BYTES, stream, a);
#else
    for (int p = 0; p < N_PHASES; ++p) { a.ph_lo = p; a.ph_hi = p + 1; hipLaunchKernelGGL(fwd, dim3(grid), dim3(NTHREADS), LDS_BYTES, stream, a);
#ifdef PROBE_REPEAT_PHASE
        if (p == PROBE_REPEAT_PHASE) hipLaunchKernelGGL(fwd, dim3(grid), dim3(NTHREADS), LDS_BYTES, stream, a);
#endif
    }
#endif
}
```

```cpp
#include <hip/hip_runtime.h>
#include <cstdio>
#include <cstdint>

#ifndef MK_ONE_LAUNCH
#define MK_ONE_LAUNCH 1
#endif

#define DI __device__ __forceinline__
#define GAS __attribute__((address_space(1)))
#define LAS __attribute__((address_space(3)))
typedef unsigned short bf16;
typedef short bf16x8 __attribute__((ext_vector_type(8)));
typedef float f32x4 __attribute__((ext_vector_type(4)));
typedef float f32x2 __attribute__((ext_vector_type(2)));
typedef unsigned u32x4 __attribute__((ext_vector_type(4)));
typedef unsigned u32x2 __attribute__((ext_vector_type(2)));

constexpr int D = 1024, NB = 4, SEQ = 4096, M = NB * SEQ;
constexpr int MEML = 256, MROWS = NB * MEML;
constexpr int LRU_W = 512, RW = 512, NH = 8, HD = 64;
constexpr int INW = 2816;
constexpr int XH = 4, XHD = 256;
constexpr int NE = 32, TOPK = 4, DFF = 1024;
constexpr int NASSIGN = M * TOPK;
constexpr int MAXTILES = 288, MAXROWS = MAXTILES * 256;
constexpr float EPS = 1e-6f, GN_EPS = 64e-5f;

DI int fresh_tid() { int t = threadIdx.x; asm volatile("" : "+v"(t)); return t; }
namespace pg8 {
constexpr int BM = 256, BK = 64, HALF = 128, HTB = HALF * BK * 2, STAGE_BYTES = 8 * HTB, NXCD = 8, WGM = 8;
__host__ __device__ __forceinline__ int lds_byte(int r, int c) { const int st = (r >> 4) * 2 + (c >> 5), rr = r & 15, cc = c & 31, ob = rr * 64 + cc * 2; return st * 1024 + (ob ^ (((ob >> 9) & 1) << 5)); }
__host__ __device__ __forceinline__ void stage_rc(int b, int& R, int& C) { const int st = b / 1024, sb = b % 1024, swz = sb ^ (((sb >> 9) & 1) << 5); R = (st >> 1) * 16 + swz / 64; C = (st & 1) * 32 + (swz % 64) / 2; }
__host__ __device__ __forceinline__ int perm32(int rho) { const int n = rho >> 4, i = rho & 15; return 8 * (i >> 2) + 4 * n + (i & 3); }

struct Unit { int pm, pn, e; };

struct StaticOrder {
    int nM, nN, nwg, G, c;
    __host__ __device__ void init_tiles(int nM_, int nN_, int G_, int c_) { nM = nM_; nN = nN_; nwg = nM * nN; G = G_; c = c_; }
    __host__ __device__ bool next(int i, Unit& u) const {
        const long L = (long)i * G + c; if (L >= nwg) return false;
        int wgid = (int)L; { const int q = nwg / NXCD, r = nwg % NXCD, xcd = wgid % NXCD, off = wgid / NXCD; wgid = (xcd < r ? xcd * (q + 1) : r * (q + 1) + (xcd - r) * q) + off; }
        const int nig = WGM * nN, gid = wgid / nig, fm = gid * WGM, gsz = (nM - fm) < WGM ? (nM - fm) : WGM;
        u.pm = fm + ((wgid % nig) % gsz); u.pn = (wgid % nig) / gsz; u.e = 0; return true;
    }
};
struct DenseSched {
    static constexpr bool GATHER = false, B_TILED = false;
    StaticOrder o; const char* A; const char* B; size_t tstep;
    DI bool next(int i, Unit& u) const { return o.next(i, u); }
    DI const char* a_ptr(const Unit& u) const { return A + (size_t)u.pm * tstep; }
    DI const char* b_ptr(const Unit& u) const { return B + (size_t)u.pn * tstep; }
    DI void a_voff(const Unit&, int K, const int (&R)[2], const int (&C)[2], unsigned (&vo)[2][2]) const {
#pragma unroll
        for (int h = 0; h < 2; ++h)
#pragma unroll
            for (int i = 0; i < 2; ++i) vo[h][i] = (unsigned)((h * HALF + R[i]) * K + C[i]) * 2u; }
};
struct MoeSched {
    static constexpr bool GATHER = false, B_TILED = true;
    StaticOrder o; const char* A; const char* B; const int* tile_e; size_t tstep, estep;
    DI bool next(int i, Unit& u) const { if (!o.next(i, u)) return false; u.e = tile_e[u.pm]; return true; }
    DI const char* a_ptr(const Unit& u) const { return A + (size_t)u.pm * tstep; }
    DI const char* b_ptr(const Unit& u) const { return B + (size_t)u.e * estep + (size_t)u.pn * tstep; }
    DI void a_voff(const Unit&, int K, const int (&R)[2], const int (&C)[2], unsigned (&vo)[2][2]) const {
#pragma unroll
        for (int h = 0; h < 2; ++h)
#pragma unroll
            for (int i = 0; i < 2; ++i) vo[h][i] = (unsigned)((h * HALF + R[i]) * K + C[i]) * 2u; }
};
struct MoeGatherSched {
    static constexpr bool GATHER = true, B_TILED = true;
    StaticOrder o; const char* A; const char* B; const int* tile_e; const int* rtok; size_t tstep, estep;
    DI bool next(int i, Unit& u) const { if (!o.next(i, u)) return false; u.e = tile_e[u.pm]; return true; }
    DI const char* a_ptr(const Unit&) const { return A; }
    DI const char* b_ptr(const Unit& u) const { return B + (size_t)u.e * estep + (size_t)u.pn * tstep; }
    DI void a_voff(const Unit& u, int K, const int (&R)[2], const int (&C)[2], unsigned (&vo)[2][2]) const {
#pragma unroll
        for (int h = 0; h < 2; ++h)
#pragma unroll
            for (int i = 0; i < 2; ++i) vo[h][i] = (unsigned)(rtok[u.pm * BM + h * HALF + R[i]] * K + C[i]) * 2u; }
};

DI unsigned cvt_pk_bf16(float lo, float hi) { unsigned r; asm volatile("v_cvt_pk_bf16_f32 %0, %1, %2" : "=v"(r) : "v"(lo), "v"(hi)); return r; }

template <class Epi, class Sched, bool ALIGN_EPI = true>
DI void gemm_phase(LAS unsigned char* lds, const int K, const Sched& S, const Epi& E) {
    const int tid = fresh_tid(), wid = __builtin_amdgcn_readfirstlane(tid >> 6), lane = tid & 63, wr = wid >> 2, wc = wid & 3, fr = lane & 15, fq = lane >> 4;
    const int nt = K / BK;
    constexpr bool GA = Sched::GATHER, BT = Sched::B_TILED;
    unsigned voffA[2][2], voffAn[2][2], voffB[2]; int sR[2], sC[2];
#pragma unroll
    for (int i = 0; i < 2; ++i) { int R, C; stage_rc(tid * 16 + i * 8192, R, C); const int Rb = Epi::PERM ? ((R & ~31) + perm32(R & 31)) : R;
        sR[i] = R; sC[i] = C; voffB[i] = BT ? (unsigned)(tid * 16 + i * 8192) : (unsigned)(Rb * K + C) * 2u; }
    const size_t kstep = (size_t)(BK * 2);
    const size_t hstep = (size_t)HALF * K * 2;
    const size_t kstepB = BT ? (size_t)(2 * HTB) : kstep, hstepB = BT ? (size_t)HTB : hstep;
    const unsigned ldsw = (unsigned)wid * 1024u;
    const int aoff = lds_byte(wr * 64 + fr, fq * 8), boff = lds_byte(wc * 32 + fr, fq * 8);
#define PG8_SA(b, h) (((b) * 2 + (h)) * HTB)
#define PG8_SB(b, h) ((4 + (b) * 2 + (h)) * HTB)
#define PG8_STAGE(bufoff, gbase, voff) do { _Pragma("unroll") for (int _i = 0; _i < 2; ++_i) \
        __builtin_amdgcn_global_load_lds((const unsigned*)((const char*)(gbase) + (voff)[_i]), (LAS unsigned*)(lds + (bufoff) + ldsw + _i * 8192), 16, 0, 0); } while (0)
#define PG8_LDA(dst, b, h) do { _Pragma("unroll") for (int m = 0; m < 4; ++m) _Pragma("unroll") for (int k = 0; k < 2; ++k) dst[m][k] = *(const LAS bf16x8*)(lds + PG8_SA(b, h) + aoff + m * 2048 + k * 1024); } while (0)
#define PG8_LDB(dst, b, h) do { _Pragma("unroll") for (int n = 0; n < 2; ++n) _Pragma("unroll") for (int k = 0; k < 2; ++k) dst[n][k] = *(const LAS bf16x8*)(lds + PG8_SB(b, h) + boff + n * 2048 + k * 1024); } while (0)
#define PG8_MMA(ai, bj, At, Bt) do { __builtin_amdgcn_s_setprio(1); _Pragma("unroll") for (int m = 0; m < 4; ++m) _Pragma("unroll") for (int n = 0; n < 2; ++n) _Pragma("unroll") for (int k = 0; k < 2; ++k) \
        acc[ai][bj][m][n] = __builtin_amdgcn_mfma_f32_16x16x32_bf16(Bt[n][k], At[m][k], acc[ai][bj][m][n], 0, 0, 0); __builtin_amdgcn_s_setprio(0); } while (0)
#define PG8_WAIT_V(n) asm volatile("s_waitcnt vmcnt(" #n ")" ::: "memory")
#define PG8_WAIT_L(n) asm volatile("s_waitcnt lgkmcnt(" #n ")" ::: "memory")
#define PG8_BAR __builtin_amdgcn_s_barrier()
#define PG8_SCHED __builtin_amdgcn_sched_barrier(0)
    Unit cur, nxt; int ui = 0;
    if (!S.next(0, cur)) return;
    f32x4 acc[2][2][4][2];
#pragma unroll
    for (int a = 0; a < 2; ++a)
#pragma unroll
        for (int b = 0; b < 2; ++b)
#pragma unroll
            for (int m = 0; m < 4; ++m)
#pragma unroll
                for (int n = 0; n < 2; ++n) acc[a][b][m][n] = (f32x4){0.f, 0.f, 0.f, 0.f};
    bf16x8 At[4][2], B0[2][2], B1[2][2];
    const char* cA = S.a_ptr(cur); const char* cB = S.b_ptr(cur);
    S.a_voff(cur, K, sR, sC, voffA);
#define PG8_STAGE_A(bufoff, kbase, h, vo) do { if constexpr (GA) { PG8_STAGE(bufoff, kbase, (vo)[h]); } else { PG8_STAGE(bufoff, (kbase) + (h) * hstep, voffA[0]); } } while (0)
    PG8_STAGE(PG8_SB(0, 0), cB, voffB); PG8_STAGE(PG8_SB(0, 1), cB + hstepB, voffB); PG8_STAGE_A(PG8_SA(0, 0), cA, 0, voffA); PG8_STAGE_A(PG8_SA(0, 1), cA, 1, voffA);
    if (wr == 1) PG8_BAR;
    PG8_WAIT_V(2); PG8_BAR;
    PG8_STAGE(PG8_SB(1, 0), cB + kstepB, voffB); PG8_STAGE_A(PG8_SA(1, 0), cA + kstep, 0, voffA); PG8_STAGE(PG8_SB(1, 1), cB + hstepB + kstepB, voffB);
    PG8_WAIT_V(6); PG8_BAR;
    for (;;) {
        const bool has_next = S.next(ui + 1, nxt);
        const char* nA = has_next ? S.a_ptr(nxt) : cA; const char* nB = has_next ? S.b_ptr(nxt) : cB;
        if constexpr (GA) { if (has_next) S.a_voff(nxt, K, sR, sC, voffAn);
            else {
#pragma unroll
                for (int h = 0; h < 2; ++h)
#pragma unroll
                    for (int i = 0; i < 2; ++i) voffAn[h][i] = voffA[h][i]; } }
        for (int t = 0; t < nt; t += 2) {
            const bool last = (t == nt - 2);
            const char* a1 = cA + (size_t)(t + 1) * kstep;
            const char* a2 = last ? nA : cA + (size_t)(t + 2) * kstep; const char* b2 = last ? nB : cB + (size_t)(t + 2) * kstepB;
            const char* a3 = a2 + kstep; const char* b3 = b2 + kstepB;
            unsigned vs[2][2];
            if constexpr (GA) {
#pragma unroll
                for (int i = 0; i < 2; ++i) { vs[0][i] = last ? voffAn[0][i] : voffA[0][i]; vs[1][i] = last ? voffAn[1][i] : voffA[1][i]; } }
            PG8_LDB(B0, 0, 0); PG8_LDB(B1, 0, 1); PG8_SCHED; PG8_LDA(At, 0, 0); PG8_STAGE_A(PG8_SA(1, 1), a1, 1, voffA);
            PG8_WAIT_V(8); PG8_WAIT_L(0); PG8_BAR; PG8_MMA(0, 0, At, B0); PG8_MMA(0, 1, At, B1); PG8_BAR; PG8_SCHED;
            PG8_LDA(At, 0, 1); PG8_STAGE(PG8_SB(0, 0), b2, voffB); PG8_STAGE(PG8_SB(0, 1), b2 + hstepB, voffB); PG8_STAGE_A(PG8_SA(0, 0), a2, 0, vs);
            PG8_WAIT_V(8); PG8_WAIT_L(0); PG8_BAR; PG8_MMA(1, 0, At, B0); PG8_MMA(1, 1, At, B1); PG8_BAR; PG8_SCHED;
            PG8_LDB(B0, 1, 0); PG8_LDB(B1, 1, 1); PG8_SCHED; PG8_LDA(At, 1, 0); PG8_STAGE_A(PG8_SA(0, 1), a2, 1, vs);
            PG8_WAIT_V(8); PG8_WAIT_L(0); PG8_BAR; PG8_MMA(0, 0, At, B0); PG8_MMA(0, 1, At, B1); PG8_BAR; PG8_SCHED;
            PG8_LDA(At, 1, 1); PG8_STAGE(PG8_SB(1, 0), b3, voffB); PG8_STAGE(PG8_SB(1, 1), b3 + hstepB, voffB); PG8_STAGE_A(PG8_SA(1, 0), a3, 0, vs);
            PG8_WAIT_V(8); PG8_WAIT_L(0); PG8_BAR; PG8_MMA(1, 0, At, B0); PG8_MMA(1, 1, At, B1); PG8_BAR; PG8_SCHED;
        }
        if constexpr (ALIGN_EPI) { if (wr == 0) PG8_BAR; }
        E(acc, cur, wr, wc, fr, fq);
        if (!has_next) break;
#pragma unroll
        for (int a = 0; a < 2; ++a)
#pragma unroll
            for (int b = 0; b < 2; ++b)
#pragma unroll
                for (int m = 0; m < 4; ++m)
#pragma unroll
                    for (int n = 0; n < 2; ++n) acc[a][b][m][n] = (f32x4){0.f, 0.f, 0.f, 0.f};
        cur = nxt; cA = nA; cB = nB; ++ui;
        if constexpr (GA) {
#pragma unroll
            for (int h = 0; h < 2; ++h)
#pragma unroll
                for (int i = 0; i < 2; ++i) voffA[h][i] = voffAn[h][i]; }
        if constexpr (ALIGN_EPI) { if (wr == 1) PG8_BAR; }
    }
    PG8_WAIT_V(0);
    if constexpr (!ALIGN_EPI) { if (wr == 0) PG8_BAR; }
    PG8_BAR;
#undef PG8_SA
#undef PG8_SB
#undef PG8_STAGE
#undef PG8_STAGE_A
#undef PG8_LDA
#undef PG8_LDB
#undef PG8_MMA
#undef PG8_WAIT_V
#undef PG8_WAIT_L
#undef PG8_BAR
#undef PG8_SCHED
}
}
using pg8::Unit;
using pg8::cvt_pk_bf16;

DI float bflo(unsigned w) { return __uint_as_float(w << 16); }
DI float bfhi(unsigned w) { return __uint_as_float(w & 0xffff0000u); }
DI float bf2f(bf16 b) { return __uint_as_float(((unsigned)b) << 16); }
typedef __bf16 hwbf2 __attribute__((ext_vector_type(2)));
DI unsigned pk2(float lo, float hi) { const f32x2 v = {lo, hi}; return __builtin_bit_cast(unsigned, __builtin_convertvector(v, hwbf2)); }
DI unsigned f2bf(float f) { return pk2(f, 0.f) & 0xffffu; }
DI float rcp_f(float x) { return __builtin_amdgcn_rcpf(x); }
DI float rsq_f(float x) { return __builtin_amdgcn_rsqf(x); }
DI float sigmoid_f(float x) { return rcp_f(1.0f + __expf(-x)); }
DI float tanh_fast(float x) { return 1.0f - 2.0f * rcp_f(__expf(2.0f * x) + 1.0f); }
DI float softplus_f(float x) { return fmaxf(x, 0.f) + __logf(1.0f + __expf(-fabsf(x))); }
DI float softplus_fast(float x) { return fmaxf(x, 0.f) + __logf(1.0f + __expf(-fabsf(x))); }
DI float gelu_tanh_f(float x) { const float u = 0.7978845608028654f * (x + 0.044715f * x * x * x); return 0.5f * x * (1.0f + tanh_fast(u)); }
DI float wave_sum(float v) {
#pragma unroll
    for (int o = 1; o < 64; o <<= 1) v += __shfl_xor(v, o);
    return v;
}

struct EpiBf16Plain {
    static constexpr bool PERM = true;
    bf16* O; int ldc; float scale;
    DI void operator()(const f32x4 (&acc)[2][2][4][2], const Unit& u, int wr, int wc, int fr, int fq) const {
        const int row0 = u.pm * 256 + wr * 64 + fr, col0 = u.pn * 256 + wc * 32 + 8 * fq;
#pragma unroll
        for (int ai = 0; ai < 2; ++ai)
#pragma unroll
            for (int m = 0; m < 4; ++m) { bf16* rowp = O + (size_t)(row0 + ai * 128 + m * 16) * ldc + col0;
#pragma unroll
                for (int bj = 0; bj < 2; ++bj) { const f32x4 v0 = acc[ai][bj][m][0] * scale, v1 = acc[ai][bj][m][1] * scale;
                    u32x4 w; w.x = cvt_pk_bf16(v0[0], v0[1]); w.y = cvt_pk_bf16(v0[2], v0[3]); w.z = cvt_pk_bf16(v1[0], v1[1]); w.w = cvt_pk_bf16(v1[2], v1[3]);
                    *(u32x4*)(rowp + bj * 128) = w; } }
    }
};
struct EpiBf16RowNorm {
    static constexpr bool PERM = true;
    bf16* O; int ldc; float scale; const float* RS;
    DI void operator()(const f32x4 (&acc)[2][2][4][2], const Unit& u, int wr, int wc, int fr, int fq) const {
        const int row0 = u.pm * 256 + wr * 64 + fr, col0 = u.pn * 256 + wc * 32 + 8 * fq;
#pragma unroll
        for (int ai = 0; ai < 2; ++ai)
#pragma unroll
            for (int m = 0; m < 4; ++m) { const int r = row0 + ai * 128 + m * 16; const f32x4* rp = (const f32x4*)(RS + (size_t)r * 16);
                const f32x4 p0 = rp[0], p1 = rp[1], p2 = rp[2], p3 = rp[3];
                const float ss = ((p0[0] + p0[1]) + (p0[2] + p0[3])) + ((p1[0] + p1[1]) + (p1[2] + p1[3])) + ((p2[0] + p2[1]) + (p2[2] + p2[3])) + ((p3[0] + p3[1]) + (p3[2] + p3[3]));
                const float sc = scale * __builtin_amdgcn_rsqf(ss * (1.0f / 1024.0f) + 1e-6f);
                bf16* rowp = O + (size_t)r * ldc + col0;
#pragma unroll
                for (int bj = 0; bj < 2; ++bj) { const f32x4 v0 = acc[ai][bj][m][0] * sc, v1 = acc[ai][bj][m][1] * sc;
                    u32x4 w; w.x = cvt_pk_bf16(v0[0], v0[1]); w.y = cvt_pk_bf16(v0[2], v0[3]); w.z = cvt_pk_bf16(v1[0], v1[1]); w.w = cvt_pk_bf16(v1[2], v1[3]);
                    *(u32x4*)(rowp + bj * 128) = w; } }
    }
};
template <bool RES_BF16> struct EpiBf16Res {
    static constexpr bool PERM = true;
    const void* Rz; bf16* O; int ldc; float* RS;
    DI void operator()(const f32x4 (&acc)[2][2][4][2], const Unit& u, int wr, int wc, int fr, int fq) const {
        const int row0 = u.pm * 256 + wr * 64 + fr, col0 = u.pn * 256 + wc * 32 + 8 * fq;
#pragma unroll
        for (int ai = 0; ai < 2; ++ai)
#pragma unroll
            for (int m = 0; m < 4; ++m) { const size_t off = (size_t)(row0 + ai * 128 + m * 16) * ldc + col0; float ssq = 0.f;
#pragma unroll
                for (int bj = 0; bj < 2; ++bj) { f32x4 r0, r1;
                    if (RES_BF16) { const u32x4 rw = *(const u32x4*)((const bf16*)Rz + off + bj * 128); r0 = (f32x4){bflo(rw.x), bfhi(rw.x), bflo(rw.y), bfhi(rw.y)}; r1 = (f32x4){bflo(rw.z), bfhi(rw.z), bflo(rw.w), bfhi(rw.w)}; }
                    else { r0 = *(const f32x4*)((const float*)Rz + off + bj * 128); r1 = *(const f32x4*)((const float*)Rz + off + bj * 128 + 4); }
                    const f32x4 v0 = r0 + acc[ai][bj][m][0], v1 = r1 + acc[ai][bj][m][1];
                    ssq += (v0[0] * v0[0] + v0[1] * v0[1]) + (v0[2] * v0[2] + v0[3] * v0[3]) + (v1[0] * v1[0] + v1[1] * v1[1]) + (v1[2] * v1[2] + v1[3] * v1[3]);
                    u32x4 w; w.x = cvt_pk_bf16(v0[0], v0[1]); w.y = cvt_pk_bf16(v0[2], v0[3]); w.z = cvt_pk_bf16(v1[0], v1[1]); w.w = cvt_pk_bf16(v1[2], v1[3]);
                    *(u32x4*)(O + off + bj * 128) = w; }
                if (RS) { ssq += __shfl_xor(ssq, 16); ssq += __shfl_xor(ssq, 32); if (fq == 0) RS[(size_t)(row0 + ai * 128 + m * 16) * 16 + u.pn * 4 + wc] = ssq; } }
    }
};
struct EpiLora {
    static constexpr bool PERM = false;
    float* LWp; bf16* AAp; bf16* GGp; const float* w0; const float* a0;
    DI void operator()(const f32x4 (&acc)[2][2][4][2], const Unit& u, int wr, int wc, int fr, int fq) const {
        const int kind = u.pn >> 1;
        const int row0 = u.pm * 256 + wr * 64 + fr, col0 = (u.pn & 1) * 256 + wc * 32 + 4 * fq;
#pragma unroll
        for (int bj = 0; bj < 2; ++bj)
#pragma unroll
            for (int n = 0; n < 2; ++n) {
                const int c = col0 + bj * 128 + n * 16;
                f32x4 bias = (f32x4){0.f, 0.f, 0.f, 0.f};
                if (kind == 0) bias = *(const f32x4*)(w0 + c); else if (kind == 1) bias = *(const f32x4*)(a0 + c);
#pragma unroll
                for (int ai = 0; ai < 2; ++ai)
#pragma unroll
                    for (int m = 0; m < 4; ++m) {
                        f32x4 v = acc[ai][bj][m][n] + bias;
                        if (kind == 0) {
#pragma unroll
                            for (int j = 0; j < 4; ++j) { const float w = -softplus_fast(-v[j]) - 0.5f; v[j] = -__expf(w);     }
                        } else if (kind == 1) {
#pragma unroll
                            for (int j = 0; j < 4; ++j) v[j] = sigmoid_f(v[j]);
                        }
                        const size_t o_ = (size_t)(row0 + ai * 128 + m * 16) * 512 + c;
                        if (kind == 0) *(f32x4*)(LWp + o_) = v;
                        else { u32x2 w_; w_.x = cvt_pk_bf16(v[0], v[1]); w_.y = cvt_pk_bf16(v[2], v[3]); *(u32x2*)((kind == 1 ? AAp : GGp) + o_) = w_; }
                    }
            }
    }
};
struct EpiSwiglu {
    static constexpr bool PERM = true;
    bf16* ACT; const float* b_gu;
    DI void operator()(const f32x4 (&acc)[2][2][4][2], const Unit& u, int wr, int wc, int fr, int fq) const {
        const int row0 = u.pm * 256 + wr * 64 + fr, j0 = u.pn * 128 + wc * 32 + 8 * fq;
        const float* bg = b_gu + (size_t)u.e * 2048 + j0; const float* bu = bg + 1024;
        const f32x4 bg0 = *(const f32x4*)bg, bg1 = *(const f32x4*)(bg + 4), bu0 = *(const f32x4*)bu, bu1 = *(const f32x4*)(bu + 4);
#pragma unroll
        for (int ai = 0; ai < 2; ++ai)
#pragma unroll
            for (int m = 0; m < 4; ++m) {
                float o[8];
#pragma unroll
                for (int n = 0; n < 2; ++n) { const f32x4 g4 = acc[ai][0][m][n] + (n ? bg1 : bg0), u4 = acc[ai][1][m][n] + (n ? bu1 : bu0);
#pragma unroll
                    for (int j = 0; j < 4; ++j) { const float g = fminf(g4[j], 7.0f), up = fminf(fmaxf(u4[j], -7.0f), 7.0f); o[n * 4 + j] = (up + 1.0f) * (g * sigmoid_f(1.702f * g)); } }
                u32x4 w; w.x = cvt_pk_bf16(o[0], o[1]); w.y = cvt_pk_bf16(o[2], o[3]); w.z = cvt_pk_bf16(o[4], o[5]); w.w = cvt_pk_bf16(o[6], o[7]);
                *(u32x4*)(ACT + (size_t)(row0 + ai * 128 + m * 16) * 1024 + j0) = w;
            }
    }
};
struct EpiDown {
    static constexpr bool PERM = true;
    bf16* YS; const float* b_dn; const int* row_slot; const float* row_gate;
    DI void operator()(const f32x4 (&acc)[2][2][4][2], const Unit& u, int wr, int wc, int fr, int fq) const {
        const int row0 = u.pm * 256 + wr * 64 + fr, col0 = u.pn * 256 + wc * 32 + 8 * fq;
        const float* bb = b_dn + (size_t)u.e * 1024 + col0;
        f32x4 bv[2][2];
#pragma unroll
        for (int bj = 0; bj < 2; ++bj)
#pragma unroll
            for (int n = 0; n < 2; ++n) bv[bj][n] = *(const f32x4*)(bb + bj * 128 + 4 * n);
#pragma unroll
        for (int ai = 0; ai < 2; ++ai)
#pragma unroll
            for (int m = 0; m < 4; ++m) {
                const int r = row0 + ai * 128 + m * 16; const int slot = row_slot[r]; const float gt = row_gate[r];
                if (slot >= 0) { bf16* rowp = YS + (size_t)slot * 1024 + col0;
#pragma unroll
                    for (int bj = 0; bj < 2; ++bj) { const f32x4 v0 = (acc[ai][bj][m][0] + bv[bj][0]) * gt, v1 = (acc[ai][bj][m][1] + bv[bj][1]) * gt;
                        u32x4 w; w.x = cvt_pk_bf16(v0[0], v0[1]); w.y = cvt_pk_bf16(v0[2], v0[3]); w.z = cvt_pk_bf16(v1[0], v1[1]); w.w = cvt_pk_bf16(v1[2], v1[3]);
                        *(u32x4*)(rowp + bj * 128) = w; } }
            }
    }
};

constexpr size_t MiB = 1u << 20;
constexpr size_t WS_CTL = 0, CTL_ZERO_BYTES = 1 * MiB;
constexpr size_t WS_WIN = 1 * MiB, WS_WOUT = 7 * MiB, WS_WQ = 9 * MiB, WS_WK = 11 * MiB, WS_WV = 13 * MiB, WS_WO = 15 * MiB, WS_LORAB = 17 * MiB, WS_LRUW = 18 * MiB;
constexpr size_t WS_ROUTE = 19 * MiB;
constexpr size_t WS_WGU = 22 * MiB, WS_WDN = 150 * MiB;
constexpr size_t WS_HN = 214 * MiB, WS_MEMN = 246 * MiB, WS_KM = 248 * MiB, WS_VT = 250 * MiB;
constexpr size_t WS_X1 = 252 * MiB, WS_X2 = 316 * MiB;
constexpr size_t WS_U = 380 * MiB, WS_R = 468 * MiB, WS_KRAW = 500 * MiB, WS_V = 532 * MiB, WS_KKN = 564 * MiB, WS_WD = 596 * MiB, WS_AA = 628 * MiB, WS_G = 660 * MiB;
constexpr size_t WS_LA = 692 * MiB, WS_LB = 724 * MiB, WS_AP = 756 * MiB, WS_CAT = 764 * MiB, WS_Q = 796 * MiB;
constexpr size_t WS_XS = 380 * MiB, WS_ACT = 524 * MiB, WS_YS = 668 * MiB;
constexpr size_t WS_GP = 796 * MiB, WS_HF = 860 * MiB, WS_RP = 924 * MiB, WS_Y1F = 940 * MiB, WS_ADD = 972 * MiB, WS_END = 1004 * MiB;
constexpr size_t WS_GC = 468 * MiB, WS_HC = 484 * MiB, WS_ZS = 500 * MiB;
static_assert(WS_AA == WS_WD + 32 * MiB && WS_G == WS_AA + 32 * MiB, "EpiLora strides");
static_assert(WS_U + (size_t)M * INW * 2 <= WS_R && WS_XS + (size_t)MAXROWS * 2048 <= WS_ACT && WS_ACT + (size_t)MAXROWS * 2048 <= WS_YS && WS_YS + (size_t)NASSIGN * 2048 <= WS_Q, "ws map");
constexpr size_t RT_E = 0, RT_POS = 256 * 1024, RT_G = 512 * 1024, RT_SLOT = 768 * 1024, RT_GATE = 1088 * 1024, RT_TILE = 1408 * 1024, RT_TOK = 1472 * 1024;
constexpr int CW_BAR = 4096, CW_CNT = 8192;

constexpr int RING_BYTES = 131072, MISC_OFF = RING_BYTES + 320, LDS_BYTES = 147456;
constexpr int NWAVES = 8, NTHREADS = 512;

#define XB_TMO      128
#define XB_XCNT(j)  (256  + 64 * (j))
#define XB_XSUB(j)  (1280 + 64 * (j))
#define XB_XGEN(j)  (2304 + 64 * (j))
#define XB_TOP      3328
#define XB_TOPGEN   3392
#define XCD_BAR_WORDS 3456
#define XB_SPIN_CAP (1u << 18)
DI unsigned xb_ld(unsigned* p)              { return __hip_atomic_load(p, __ATOMIC_RELAXED, __HIP_MEMORY_SCOPE_AGENT); }
DI unsigned xb_add(unsigned* p, unsigned v) { return __hip_atomic_fetch_add(p, v, __ATOMIC_RELAXED, __HIP_MEMORY_SCOPE_AGENT); }
DI unsigned xb_xcc_id() { return (unsigned)__builtin_amdgcn_s_getreg((3 << 11) | 20) & 0xFu; }
#define XB_SPIN(cond, bar) do { unsigned _sp = 0; while (cond) { __builtin_amdgcn_s_sleep(1); \
    if ((++_sp & 255u) == 0u) { if (xb_ld(&(bar)[XB_TMO])) break; if (_sp > XB_SPIN_CAP) { atomicAdd(&(bar)[XB_TMO], 1u); break; } } } } while (0)
struct XcdBarrier { unsigned* bar; unsigned x; volatile LAS unsigned* st; };
DI XcdBarrier xcd_barrier_post(unsigned* bar, volatile LAS unsigned* st) {
    XcdBarrier b; b.bar = bar; b.x = xb_xcc_id(); b.st = st;
    if (threadIdx.x == 0) (void)xb_add(&bar[XB_XCNT(b.x)], 1u);
    return b;
}
DI void xcd_barrier_complete(unsigned* bar, unsigned x, unsigned& nloc, unsigned& nx) {
    const unsigned G = gridDim.x * gridDim.y * gridDim.z;
    unsigned sum, cnt, mine, sp = 0u;
    for (;;) {
        sum = 0u; cnt = 0u; mine = 0u;
#pragma unroll
        for (unsigned j = 0; j < 16; ++j) { const unsigned c = xb_ld(&bar[XB_XCNT(j)]); sum += c; cnt += (c > 0u) ? 1u : 0u; mine = (j == x) ? c : mine; }
        if (sum == G) break;
        __builtin_amdgcn_s_sleep(1);
        if ((++sp & 255u) == 0u) { if (xb_ld(&bar[XB_TMO])) break; if (sp > XB_SPIN_CAP) { atomicAdd(&bar[XB_TMO], 1u); break; } }
    }
    nloc = mine > 0u ? mine : 1u; nx = cnt > 0u ? cnt : 1u;
}
DI void xcd_barrier(const XcdBarrier& b) {
    asm volatile("s_waitcnt vmcnt(0)" ::: "memory");
    __syncthreads();
    if (threadIdx.x == 0) {
        unsigned* bar = b.bar;
        __builtin_amdgcn_s_waitcnt(0);
        unsigned nloc = b.st[0], nx = b.st[1];
        if (nloc == 0u) { xcd_barrier_complete(bar, b.x, nloc, nx); b.st[0] = nloc; b.st[1] = nx; }
        const unsigned old = xb_add(&bar[XB_XSUB(b.x)], 1u);
        const unsigned gen = old / nloc;
        if (old + 1u == (gen + 1u) * nloc) {
            __builtin_amdgcn_fence(__ATOMIC_RELEASE, "agent");
            asm volatile("s_waitcnt vmcnt(0)" ::: "memory");
            const unsigned og = xb_add(&bar[XB_TOP], 1u);
            const unsigned tg = og / nx;
            if (og + 1u == (tg + 1u) * nx) xb_add(&bar[XB_TOPGEN], 1u);
            else XB_SPIN(xb_ld(&bar[XB_TOPGEN]) == tg, bar);
            __builtin_amdgcn_fence(__ATOMIC_ACQUIRE, "agent");
            xb_add(&bar[XB_XGEN(b.x)], 1u);
            asm volatile("s_waitcnt vmcnt(0)" ::: "memory");
        } else {
            XB_SPIN(xb_ld(&bar[XB_XGEN(b.x)]) == gen, bar);
            __builtin_amdgcn_fence(__ATOMIC_ACQUIRE, "agent");
            asm volatile("s_waitcnt vmcnt(0)" ::: "memory");
        }
    }
    __syncthreads();
}

struct Args { const float* in[37]; float* out; unsigned char* ws; int ph_lo, ph_hi; };
enum { I_X = 0, I_MEM, I_NMIXG, I_WIN, I_CONVW, I_CONVB, I_LWX, I_LBX, I_LWA, I_LBA, I_LAM, I_MU, I_W0, I_WUP, I_A0, I_AUP, I_GUP, I_KK, I_KA, I_RK, I_LNG, I_LNB,
       I_WOUT, I_NXAG, I_NMEMG, I_WQ, I_WK, I_WV, I_WO, I_NFFG, I_WR, I_BR, I_WGU, I_BGU, I_WDN, I_BDN, I_FNG };

DI void transpose_item(const float* W, int ldw, int K, bf16* WT, int k0, int n0, int drow0, LAS float* scr, int lane, const float* rs = nullptr) {
    f32x4 t[8];
    const float* src = W + (size_t)(k0 + (lane >> 3)) * ldw + n0 + 4 * (lane & 7);
#pragma unroll
    for (int i = 0; i < 8; ++i) t[i] = *(const f32x4*)(src + (size_t)(8 * i) * ldw);
#pragma unroll
    for (int i = 0; i < 8; ++i) { const float sc_ = rs ? rs[k0 + 8 * i + (lane >> 3)] : 1.0f; LAS float* d = scr + (8 * i + (lane >> 3)) * 33 + 4 * (lane & 7); d[0] = t[i].x * sc_; d[1] = t[i].y * sc_; d[2] = t[i].z * sc_; d[3] = t[i].w * sc_; }
    asm volatile("s_waitcnt lgkmcnt(0)" ::: "memory");
    const int c = lane & 7;
#pragma unroll
    for (int j = 0; j < 4; ++j) { const int n = (lane >> 3) + 8 * j; const LAS float* s = scr + (8 * c) * 33 + n;
        u32x4 o; o.x = pk2(s[0 * 33], s[1 * 33]); o.y = pk2(s[2 * 33], s[3 * 33]); o.z = pk2(s[4 * 33], s[5 * 33]); o.w = pk2(s[6 * 33], s[7 * 33]);
        *(u32x4*)(WT + (size_t)(drow0 + n) * K + k0 + 8 * c) = o; }
    asm volatile("s_waitcnt lgkmcnt(0)" ::: "memory");
}
DI void transpose_item_tiled(const float* W, int ldw, int K, bf16* WTe, int k0, int n0, int drow0, LAS float* scr, int lane) {
    f32x4 t[8];
    const float* src = W + (size_t)(k0 + (lane >> 3)) * ldw + n0 + 4 * (lane & 7);
#pragma unroll
    for (int i = 0; i < 8; ++i) t[i] = *(const f32x4*)(src + (size_t)(8 * i) * ldw);
#pragma unroll
    for (int i = 0; i < 8; ++i) { LAS float* d = scr + (8 * i + (lane >> 3)) * 33 + 4 * (lane & 7); d[0] = t[i].x; d[1] = t[i].y; d[2] = t[i].z; d[3] = t[i].w; }
    asm volatile("s_waitcnt lgkmcnt(0)" ::: "memory");
    const int c = lane & 7;
#pragma unroll
    for (int j = 0; j < 4; ++j) { const int n = (lane >> 3) + 8 * j; const LAS float* s = scr + (8 * c) * 33 + n;
        u32x4 o; o.x = pk2(s[0 * 33], s[1 * 33]); o.y = pk2(s[2 * 33], s[3 * 33]); o.z = pk2(s[4 * 33], s[5 * 33]); o.w = pk2(s[6 * 33], s[7 * 33]);
        const int drow = drow0 + n, pn = drow >> 8, half = (drow >> 7) & 1, r = drow & 127, x = r & 31;
        const int rslot = (r & ~31) + 16 * ((x >> 2) & 1) + 4 * (x >> 3) + (x & 3);
        const size_t tb = ((size_t)(pn * (K / 64) + (k0 >> 6)) * 2 + half) * 16384 + pg8::lds_byte(rslot, 8 * c);
        *(u32x4*)((char*)WTe + tb) = o; }
    asm volatile("s_waitcnt lgkmcnt(0)" ::: "memory");
}
DI void rms_row_to_bf16(const float* xrow, const float* g, bf16* orow, int lane) {
    const f32x4* xr = (const f32x4*)xrow + lane; const f32x4* gr = (const f32x4*)g + lane;
    f32x4 v[4]; float s = 0.f;
#pragma unroll
    for (int j = 0; j < 4; ++j) { v[j] = xr[64 * j]; s += (v[j].x * v[j].x + v[j].y * v[j].y) + (v[j].z * v[j].z + v[j].w * v[j].w); }
    const float rstd = rsq_f(wave_sum(s) * (1.f / D) + EPS);
    u32x2* o8 = (u32x2*)orow + lane;
#pragma unroll
    for (int j = 0; j < 4; ++j) { const f32x4 gg = gr[64 * j]; u32x2 w; w.x = pk2(v[j].x * rstd * gg.x, v[j].y * rstd * gg.y); w.y = pk2(v[j].z * rstd * gg.z, v[j].w * rstd * gg.w); o8[64 * j] = w; }
}

DI void rms_rowbf_to_bf16(const bf16* xrow, const float* g, bf16* orow, int lane) {
    float v[16]; float s = 0.f;
#pragma unroll
    for (int hf = 0; hf < 2; ++hf) { const u32x4 w = *(const u32x4*)(xrow + 512 * hf + 8 * lane);
#pragma unroll
        for (int q = 0; q < 4; ++q) { v[8 * hf + 2 * q] = bflo(w[q]); v[8 * hf + 2 * q + 1] = bfhi(w[q]); } }
#pragma unroll
    for (int j = 0; j < 16; ++j) s += v[j] * v[j];
    const float rstd = rsq_f(wave_sum(s) * (1.f / D) + EPS);
#pragma unroll
    for (int hf = 0; hf < 2; ++hf) { const f32x4 g0 = *(const f32x4*)(g + 512 * hf + 8 * lane), g1 = *(const f32x4*)(g + 512 * hf + 8 * lane + 4);
        u32x4 w; w.x = pk2(v[8 * hf] * rstd * g0.x, v[8 * hf + 1] * rstd * g0.y); w.y = pk2(v[8 * hf + 2] * rstd * g0.z, v[8 * hf + 3] * rstd * g0.w);
        w.z = pk2(v[8 * hf + 4] * rstd * g1.x, v[8 * hf + 5] * rstd * g1.y); w.w = pk2(v[8 * hf + 6] * rstd * g1.z, v[8 * hf + 7] * rstd * g1.w);
        *(u32x4*)(orow + 512 * hf + 8 * lane) = w; }
}

__global__ void __launch_bounds__(NTHREADS, 2) fwd(Args args) {
    extern __shared__ __attribute__((aligned(16))) unsigned char lds_raw[];
    LAS unsigned char* lds = (LAS unsigned char*)lds_raw;
    volatile LAS unsigned* MISC = (volatile LAS unsigned*)(lds + MISC_OFF);
    const int G = gridDim.x, bid = blockIdx.x, NGW = G * NWAVES;
#define PHASE_IDS const int tid = fresh_tid(), lane = tid & 63, wave = __builtin_amdgcn_readfirstlane(tid >> 6), gw = bid * NWAVES + wave; (void)tid; (void)lane; (void)wave; (void)gw
    unsigned char* ws = args.ws;
    unsigned* ctl = (unsigned*)(ws + WS_CTL);
    const int lo = args.ph_lo, hi = args.ph_hi;

    for (int u = threadIdx.x; u < (LDS_BYTES - RING_BYTES) / 4; u += NTHREADS) ((LAS unsigned*)(lds + RING_BYTES))[u] = 0u;
    __syncthreads();
    XcdBarrier bar; bar.bar = ctl + CW_BAR; bar.x = 0; bar.st = nullptr;
    if (hi - lo > 1) bar = xcd_barrier_post(ctl + CW_BAR, MISC + 8);
#define IN(k) (lo <= (k) && (k) < hi)
#define SEAM(k) do { if (IN(k) && IN((k) + 1)) xcd_barrier(bar); } while (0)

#define Win_t ((bf16*)(ws + WS_WIN))
#define Wout_t ((bf16*)(ws + WS_WOUT))
#define Wq_t ((bf16*)(ws + WS_WQ))
#define Wk_t ((bf16*)(ws + WS_WK))
#define Wv_t ((bf16*)(ws + WS_WV))
#define Wo_t ((bf16*)(ws + WS_WO))
#define LoraB ((bf16*)(ws + WS_LORAB))
#define LruW ((bf16*)(ws + WS_LRUW))
#define WrT ((bf16*)(ws + WS_LRUW + 512 * 1024))
#define Wgu_t ((bf16*)(ws + WS_WGU))
#define Wdn_t ((bf16*)(ws + WS_WDN))
#define HN ((bf16*)(ws + WS_HN))
#define MEMN ((bf16*)(ws + WS_MEMN))
#define KM ((bf16*)(ws + WS_KM))
#define VT ((bf16*)(ws + WS_VT))
#define X1 ((bf16*)(ws + WS_X1))
#define X2 ((bf16*)(ws + WS_X2))
#define U ((bf16*)(ws + WS_U))
#define Rr ((float*)(ws + WS_R))
#define KRAW ((float*)(ws + WS_KRAW))
#define Vv ((float*)(ws + WS_V))
#define KKN ((float*)(ws + WS_KKN))
#define WD ((float*)(ws + WS_WD))
#define AA ((float*)(ws + WS_AA))
#define GG ((float*)(ws + WS_G))
#define LA ((bf16*)(ws + WS_LA))
#define LB ((bf16*)(ws + WS_LB))
#define AP ((bf16*)(ws + WS_AP))
#define CAT ((bf16*)(ws + WS_CAT))
#define Qb ((bf16*)(ws + WS_Q))
#define Ob CAT
#define XS ((bf16*)(ws + WS_XS))
#define ACT ((bf16*)(ws + WS_ACT))
#define YS ((bf16*)(ws + WS_YS))
#define route_e ((int*)(ws + WS_ROUTE + RT_E))
#define route_pos ((int*)(ws + WS_ROUTE + RT_POS))
#define route_g ((float*)(ws + WS_ROUTE + RT_G))
#define row_slot ((int*)(ws + WS_ROUTE + RT_SLOT))
#define row_gate ((float*)(ws + WS_ROUTE + RT_GATE))
#define tile_tab ((int*)(ws + WS_ROUTE + RT_TILE))
#define row_tok ((int*)(ws + WS_ROUTE + RT_TOK))
#define ecnt (ctl + CW_CNT)

    if (IN(0)) { PHASE_IDS;
        LAS float* scr = (LAS float*)(lds + wave * 16384);
        constexpr int I_IN = 16 * (INW / 32), I_SQ = 16 * 32;
        constexpr int N_ITEMS = I_IN + 5 * I_SQ;
        for (int it = gw; it < N_ITEMS; it += NGW) {
            int r = it;
            if (r < I_IN) { const int nblk = INW / 32, kb = r / nblk, nb = r % nblk; transpose_item(args.in[I_WIN], INW, D, Win_t, 64 * kb, 32 * nb, 32 * nb, scr, lane); continue; } r -= I_IN;
            { const int w = r / I_SQ, q = r % I_SQ, kb = q / 32, nb = q % 32;
                const float* src = w == 0 ? args.in[I_WOUT] : w == 1 ? args.in[I_WQ] : w == 2 ? args.in[I_WK] : w == 3 ? args.in[I_WV] : args.in[I_WO];
                bf16* dst = w == 0 ? Wout_t : w == 1 ? Wq_t : w == 2 ? Wk_t : w == 3 ? Wv_t : Wo_t;
                transpose_item(src, D, D, dst, 64 * kb, 32 * nb, 32 * nb, scr, lane, w == 1 ? args.in[I_NXAG] : nullptr); }
        }
        for (int idx = bid * NTHREADS + tid; idx < 1536 * 256; idx += G * NTHREADS) {
            const int n = idx >> 8, k = idx & 255; float v = 0.f;
            if (n < 512) { if (k < 64) v = args.in[I_WUP][k * 512 + n]; }
            else if (n < 1024) { if (k >= 64 && k < 128) v = args.in[I_AUP][(k - 64) * 512 + (n - 512)]; }
            else { if (k >= 128) v = args.in[I_GUP][(k - 128) * 512 + (n - 1024)]; }
            LoraB[idx] = (bf16)f2bf(v);
        }
        for (int idx = bid * NTHREADS + tid; idx < 8 * 128 * 64; idx += G * NTHREADS) {
            const int nb = idx >> 13, col = (idx >> 6) & 127, k = idx & 63;
            const float v = col < 64 ? args.in[I_LWX][nb * 4096 + k * 64 + col] : args.in[I_LWA][nb * 4096 + k * 64 + (col - 64)];
            LruW[idx] = (bf16)f2bf(v);
        }
        for (int idx = bid * NTHREADS + tid; idx < NE * D; idx += G * NTHREADS) {
            const int e = idx >> 10, k = idx & 1023; const float v = args.in[I_WR][k * NE + e];
            const unsigned hi = f2bf(v); const float lo = v - __uint_as_float(hi << 16);
            WrT[idx] = (bf16)hi; WrT[NE * D + idx] = (bf16)f2bf(lo);
        }
        for (int m = gw; m < M; m += NGW) rms_row_to_bf16(args.in[I_X] + (size_t)m * D, args.in[I_NMIXG], HN + (size_t)m * D, lane);
        for (int m = gw; m < MROWS; m += NGW) rms_row_to_bf16(args.in[I_MEM] + (size_t)m * D, args.in[I_NMEMG], MEMN + (size_t)m * D, lane);
        {
            LAS float* scr = (LAS float*)(lds + wave * 16384);
            constexpr int I_GU = 16 * 64, I_DN = 16 * 32;
            for (int it = gw; it < NE * (I_GU + I_DN); it += NGW) {
                int r = it;
                if (r < NE * I_GU) { const int e = r / I_GU, q = r % I_GU, kb = q / 64, nb = q % 64; const int n0 = 32 * nb;
                    const int drow = n0 < 1024 ? (256 * (n0 >> 7) + (n0 & 127)) : (256 * ((n0 - 1024) >> 7) + 128 + ((n0 - 1024) & 127));
                    transpose_item_tiled(args.in[I_WGU] + (size_t)e * D * 2048, 2048, D, Wgu_t + (size_t)e * 2048 * D, 64 * kb, n0, drow, scr, lane); continue; } r -= NE * I_GU;
                { const int e = r / I_DN, q = r % I_DN, kb = q / 32, nb = q % 32;
                  transpose_item_tiled(args.in[I_WDN] + (size_t)e * DFF * D, D, DFF, Wdn_t + (size_t)e * D * DFF, 64 * kb, 32 * nb, 32 * nb, scr, lane); }
            }
        }
    }
    SEAM(0);

    if (IN(1)) { PHASE_IDS;
        { pg8::DenseSched S; S.o.init_tiles(M / 256, INW / 256, G, bid); S.A = (const char*)HN; S.B = (const char*)Win_t; S.tstep = (size_t)256 * D * 2;
          EpiBf16Plain E{U, INW, 1.0f}; pg8::gemm_phase(lds, D, S, E); }
        { pg8::DenseSched S; S.o.init_tiles(MROWS / 256, D / 256, G, (bid + 64) & (G - 1)); S.A = (const char*)MEMN; S.B = (const char*)Wk_t; S.tstep = (size_t)256 * D * 2;
          EpiBf16Plain E{KM, D, 1.0f}; pg8::gemm_phase(lds, D, S, E); }
        { pg8::DenseSched S; S.o.init_tiles(D / 256, MROWS / 256, G, (bid + 48) & (G - 1)); S.A = (const char*)Wv_t; S.B = (const char*)MEMN; S.tstep = (size_t)256 * D * 2;
          EpiBf16Plain E{VT, MROWS, 1.0f}; pg8::gemm_phase(lds, D, S, E); }
    }
    SEAM(1);

    if (IN(2)) { PHASE_IDS;
        {
            const float* conv_w = args.in[I_CONVW]; const float* conv_b = args.in[I_CONVB]; const float* bx = args.in[I_LBX]; const float* ba = args.in[I_LBA]; const float* lam = args.in[I_LAM];
            LAS float* xs = (LAS float*)(lds + wave * 4096);
            const int i = lane & 15, kg = lane >> 4;
            for (int unit = gw; unit < (M / 16) * 2; unit += NGW) {
                const int tile = unit >> 1, nb0 = (unit & 1) * 4, m0 = tile * 16, s0 = m0 & (SEQ - 1);
                for (int nb = nb0; nb < nb0 + 4; ++nb) {
                    bf16x8 af[2];
#pragma unroll
                    for (int ks = 0; ks < 2; ++ks) {
                        const int chb = nb * 64 + 32 * ks + 8 * kg;
                        f32x4 x0 = *(const f32x4*)(conv_b + chb), x1 = *(const f32x4*)(conv_b + chb + 4);
#pragma unroll
                        for (int j = 0; j < 4; ++j) {
                            {
                                const bool ok = s0 + i - 3 + j >= 0;
                                u32x4 uw = *(const u32x4*)(U + (size_t)(ok ? m0 + i - 3 + j : m0) * INW + chb); if (!ok) uw = (u32x4){0u, 0u, 0u, 0u};
                                const f32x4 w0 = *(const f32x4*)(conv_w + j * 512 + chb), w1 = *(const f32x4*)(conv_w + j * 512 + chb + 4);
                                x0.x += w0.x * bflo(uw.x); x0.y += w0.y * bfhi(uw.x); x0.z += w0.z * bflo(uw.y); x0.w += w0.w * bfhi(uw.y);
                                x1.x += w1.x * bflo(uw.z); x1.y += w1.y * bfhi(uw.z); x1.z += w1.z * bflo(uw.w); x1.w += w1.w * bfhi(uw.w);
                            }
                        }
                        *(LAS f32x4*)(xs + i * 64 + 32 * ks + 8 * kg) = x0; *(LAS f32x4*)(xs + i * 64 + 32 * ks + 8 * kg + 4) = x1;
                        u32x4 p; p.x = pk2(x0.x, x0.y); p.y = pk2(x0.z, x0.w); p.z = pk2(x1.x, x1.y); p.w = pk2(x1.z, x1.w);
                        af[ks] = __builtin_bit_cast(bf16x8, p);
                    }
                    f32x4 acc[8];
#pragma unroll
                    for (int ct = 0; ct < 8; ++ct) { acc[ct] = (f32x4){0.f, 0.f, 0.f, 0.f};
#pragma unroll
                        for (int ks = 0; ks < 2; ++ks) { const bf16x8 bfr = *(const bf16x8*)(LruW + ((size_t)(nb * 128 + 16 * ct + i) * 64 + 32 * ks + 8 * kg));
                            acc[ct] = __builtin_amdgcn_mfma_f32_16x16x32_bf16(af[ks], bfr, acc[ct], 0, 0, 0); } }
                    asm volatile("s_waitcnt lgkmcnt(0)" ::: "memory");
#pragma unroll
                    for (int ct = 0; ct < 4; ++ct) {
                        const int col = 16 * ct + i, ch = nb * 64 + col;
                        const float bxv = bx[ch], bav = ba[ch], sp = softplus_f(-lam[ch]);
#pragma unroll
                        for (int e = 0; e < 4; ++e) {
                            const int tok = 4 * kg + e;
                            const float gx = sigmoid_f(acc[ct][e] + bxv), ga = sigmoid_f(acc[ct + 4][e] + bav);
                            const float la = -8.0f * ga * sp, xcv = xs[tok * 64 + col];
                            const float bt = __builtin_amdgcn_sqrtf(fmaxf(1.0f - __expf(2.0f * la), 0.f)) * gx * xcv;
                            LA[(size_t)(m0 + tok) * 512 + ch] = (bf16)f2bf(la); LB[(size_t)(m0 + tok) * 512 + ch] = (bf16)f2bf(bt);
                        }
                    }
                }
            }
        }
    }
    SEAM(2);


#define RW_ZB(zz, zb) do { _Pragma("unroll") for (int ks_ = 0; ks_ < 2; ++ks_) { u32x4 p_; p_.x = pk2(zz[2 * ks_][0], zz[2 * ks_][1]); p_.y = pk2(zz[2 * ks_][2], zz[2 * ks_][3]); \
        p_.z = pk2(zz[2 * ks_ + 1][0], zz[2 * ks_ + 1][1]); p_.w = pk2(zz[2 * ks_ + 1][2], zz[2 * ks_ + 1][3]); zb[ks_] = __builtin_bit_cast(bf16x8, p_); } } while (0)
    if (IN(3)) { PHASE_IDS;
        for (int u64 = gw; u64 < NB * NH * (SEQ / 64); u64 += NGW) {
#pragma unroll 1
        for (int jj = 0; jj < 4; ++jj) {
        LAS unsigned char* wl = lds + wave * 16384;
        LAS bf16* Arm = (LAS bf16*)(wl); LAS bf16* Brm = (LAS bf16*)(wl + 2048); LAS bf16* Krm = (LAS bf16*)(wl + 4096); LAS bf16* Rrm = (LAS bf16*)(wl + 6144);
        LAS bf16* ATt = (LAS bf16*)(wl + 8192); LAS bf16* BTt = (LAS bf16*)(wl + 10240); LAS bf16* KTt = (LAS bf16*)(wl + 12288); LAS bf16* VTt = (LAS bf16*)(wl + 14336);
        LAS float* MabT = (LAS float*)(wl); LAS bf16* Mak = (LAS bf16*)(wl + 1024); LAS bf16* Mrb = (LAS bf16*)(wl + 1536); LAS bf16* Mrk = (LAS bf16*)(wl + 2048); LAS bf16* Tm = (LAS bf16*)(wl + 2560);
        LAS float* PLs = (LAS float*)(wl + 3072); LAS bf16* Q0T = (LAS bf16*)(wl + 4096);
        const int lane = fresh_tid() & 63, l15 = lane & 15, g = lane >> 4, te = lane >> 2, kq = lane & 3;
        const bf16x8 z8 = (bf16x8){0, 0, 0, 0, 0, 0, 0, 0};
        const f32x4 z4 = (f32x4){0.f, 0.f, 0.f, 0.f};
            const int un = u64 * 4 + jj;
            const int bh = un >> 8, c = un & 255, b = bh >> 3, h = bh & 7;
            const size_t mrow = (size_t)b * SEQ + c * 16 + te, off = mrow * 512 + h * 64 + 16 * kq;
            const int hc = h * 64 + 16 * kq;
            LAS float* tmpL = (LAS float*)wl;
            {
                const size_t mr = (size_t)b * SEQ + c * 16 + l15; const bool hp2 = (mr & (SEQ - 1)) != 0;
                const bf16* ua = U + mr * INW + 2560 + 8 * g;
                bf16x8 af[8];
#pragma unroll
                for (int ks = 0; ks < 8; ++ks) {
                    const u32x4 cu = *(const u32x4*)(ua + 32 * ks); u32x4 pu = *(const u32x4*)(ua - (hp2 ? INW : 0) + 32 * ks); if (!hp2) pu = (u32x4){0u, 0u, 0u, 0u};
                    const f32x4 m0 = *(const f32x4*)(args.in[I_MU] + 1536 + 32 * ks + 8 * g), m1 = *(const f32x4*)(args.in[I_MU] + 1536 + 32 * ks + 8 * g + 4);
                    float o8[8];
#pragma unroll
                    for (int q = 0; q < 4; ++q) { const float c0 = bflo(cu[q]), c1 = bfhi(cu[q]), p0 = bflo(pu[q]), p1 = bfhi(pu[q]); const float mm0 = q < 2 ? m0[2 * q] : m1[2 * q - 4], mm1 = q < 2 ? m0[2 * q + 1] : m1[2 * q - 3];
                        float x0 = c0 + (p0 - c0) * mm0, x1 = c1 + (p1 - c1) * mm1;
                        if (ks < 2) { x0 = tanh_fast(x0); x1 = tanh_fast(x1); }
                        else if (ks >= 4) { x0 = sigmoid_f(x0); x1 = sigmoid_f(x1); }
                        o8[2 * q] = x0; o8[2 * q + 1] = x1; }
                    u32x4 pw; pw.x = pk2(o8[0], o8[1]); pw.y = pk2(o8[2], o8[3]); pw.z = pk2(o8[4], o8[5]); pw.w = pk2(o8[6], o8[7]); af[ks] = __builtin_bit_cast(bf16x8, pw);
                }
#pragma unroll
                for (int kind = 0; kind < 3; ++kind)
#pragma unroll
                    for (int ct = 0; ct < 4; ++ct) {
                        const bf16* lb = LoraB + (size_t)(kind * 512 + h * 64 + 16 * ct + l15) * 256 + 8 * g;
                        f32x4 a4 = z4;
#pragma unroll
                        for (int ks = (kind == 0 ? 0 : kind == 1 ? 2 : 4); ks < (kind == 0 ? 2 : kind == 1 ? 4 : 8); ++ks) a4 = __builtin_amdgcn_mfma_f32_16x16x32_bf16(af[ks], *(const bf16x8*)(lb + 32 * ks), a4, 0, 0, 0);
#pragma unroll
                        for (int e = 0; e < 4; ++e) tmpL[kind * 1088 + (4 * g + e) * 68 + 16 * ct + l15] = a4[e];
                    }
            }
            asm volatile("s_waitcnt lgkmcnt(0)" ::: "memory");
            float cl[16], eP[16];
            {
                float lwv[16], rl[16], kl[16], vl[16], kn[16], av[16];
                const bool hp = (mrow & (SEQ - 1)) != 0;
                const bf16* ub = U + mrow * INW + 1024 + hc;
#pragma unroll
                for (int hh = 0; hh < 2; ++hh) {
#pragma unroll
                    for (int a3 = 0; a3 < 3; ++a3) {
                        const u32x4 cu = *(const u32x4*)(ub + 512 * a3 + 8 * hh); u32x4 pu = *(const u32x4*)(ub - (hp ? INW : 0) + 512 * a3 + 8 * hh); if (!hp) pu = (u32x4){0u, 0u, 0u, 0u};
                        const f32x4 m0 = *(const f32x4*)(args.in[I_MU] + 512 * a3 + hc + 8 * hh), m1 = *(const f32x4*)(args.in[I_MU] + 512 * a3 + hc + 8 * hh + 4);
                        float o8[8];
#pragma unroll
                        for (int q = 0; q < 4; ++q) { const float c0 = bflo(cu[q]), c1 = bfhi(cu[q]), p0 = bflo(pu[q]), p1 = bfhi(pu[q]); const float mm0 = q < 2 ? m0[2 * q] : m1[2 * q - 4], mm1 = q < 2 ? m0[2 * q + 1] : m1[2 * q - 3];
                            o8[2 * q] = c0 + (p0 - c0) * mm0; o8[2 * q + 1] = c1 + (p1 - c1) * mm1; }
#pragma unroll
                        for (int q = 0; q < 8; ++q) { if (a3 == 0) rl[8 * hh + q] = o8[q]; else if (a3 == 1) kl[8 * hh + q] = o8[q]; else vl[8 * hh + q] = o8[q]; }
                    }
                }
                float gv[16];
#pragma unroll
                for (int j4 = 0; j4 < 4; ++j4) { const f32x4 xl = *(const LAS f32x4*)(tmpL + te * 68 + 16 * kq + 4 * j4), xa = *(const LAS f32x4*)(tmpL + 1088 + te * 68 + 16 * kq + 4 * j4), xg = *(const LAS f32x4*)(tmpL + 2176 + te * 68 + 16 * kq + 4 * j4);
                    const f32x4 w0v = *(const f32x4*)(args.in[I_W0] + hc + 4 * j4), a0v = *(const f32x4*)(args.in[I_A0] + hc + 4 * j4);
#pragma unroll
                    for (int q = 0; q < 4; ++q) { const float wq = -softplus_fast(-(xl[q] + w0v[q])) - 0.5f; lwv[4 * j4 + q] = -__expf(wq); av[4 * j4 + q] = sigmoid_f(xa[q] + a0v[q]); gv[4 * j4 + q] = xg[q]; } }
                asm volatile("s_waitcnt lgkmcnt(0)" ::: "memory");
                float ss = 0.f;
#pragma unroll
                for (int j4 = 0; j4 < 4; ++j4) { const f32x4 kk4 = *(const f32x4*)(args.in[I_KK] + hc + 4 * j4);
#pragma unroll
                    for (int q = 0; q < 4; ++q) { kn[4 * j4 + q] = kl[4 * j4 + q] * kk4[q]; ss += kn[4 * j4 + q] * kn[4 * j4 + q]; } }
                ss += __shfl_xor(ss, 1); ss += __shfl_xor(ss, 2);
                const float kinv = rsq_f(fmaxf(ss, 1e-24f));
#pragma unroll
                for (int j = 0; j < 16; ++j) { float x = lwv[j];
#pragma unroll
                    for (int sft = 4; sft < 64; sft <<= 1) { const float y = __shfl_up(x, sft); if (lane >= sft) x += y; }
                    cl[j] = x; }
                float bon = 0.f;
                u32x4 pa[2], pb[2], pk[2], pr[2];
#pragma unroll
                for (int j4 = 0; j4 < 4; ++j4) {
                    const f32x4 ka = *(const f32x4*)(args.in[I_KA] + hc + 4 * j4), rk = *(const f32x4*)(args.in[I_RK] + hc + 4 * j4);
                    float at4[4], bt4[4], kt4[4], rt4[4];
#pragma unroll
                    for (int q = 0; q < 4; ++q) { const int j = 4 * j4 + q;
                        const float p = __expf(cl[j]), pn = __expf(-cl[j]), pm1 = __expf(cl[j] - lwv[j]); eP[j] = p;
                        const float knj = kn[j] * kinv;
                        const float kp = kl[j] * (1.0f + (av[j] - 1.0f) * ka[q]);
                        at4[q] = -knj * pm1; bt4[q] = knj * av[j] * pn; kt4[q] = kp * pn; rt4[q] = rl[j] * p;
                        bon += rl[j] * kp * rk[q];
                        const int kk = 16 * kq + j;
                        ATt[kk * 16 + te] = (bf16)f2bf(at4[q]); BTt[kk * 16 + te] = (bf16)f2bf(bt4[q]); KTt[kk * 16 + te] = (bf16)f2bf(kt4[q]); VTt[kk * 16 + te] = (bf16)f2bf(vl[j]); }
                    const int hh = j4 >> 1, w2 = (j4 & 1) * 2;
                    pa[hh][w2] = pk2(at4[0], at4[1]); pa[hh][w2 + 1] = pk2(at4[2], at4[3]); pb[hh][w2] = pk2(bt4[0], bt4[1]); pb[hh][w2 + 1] = pk2(bt4[2], bt4[3]);
                    pk[hh][w2] = pk2(kt4[0], kt4[1]); pk[hh][w2 + 1] = pk2(kt4[2], kt4[3]); pr[hh][w2] = pk2(rt4[0], rt4[1]); pr[hh][w2 + 1] = pk2(rt4[2], rt4[3]);
                }
#pragma unroll
                for (int hh = 0; hh < 2; ++hh) { const int po = te * 64 + 8 * ((2 * kq + hh) ^ (te & 7));
                    *(LAS u32x4*)(Arm + po) = pa[hh]; *(LAS u32x4*)(Brm + po) = pb[hh]; *(LAS u32x4*)(Krm + po) = pk[hh]; *(LAS u32x4*)(Rrm + po) = pr[hh]; }
                bon += __shfl_xor(bon, 1); bon += __shfl_xor(bon, 2);
                f32x4 lbv[4], lgv[4];
#pragma unroll
                for (int j4 = 0; j4 < 4; ++j4) { lbv[j4] = *(const f32x4*)(args.in[I_LNB] + hc + 4 * j4); lgv[j4] = *(const f32x4*)(args.in[I_LNG] + hc + 4 * j4); }
#pragma unroll
                for (int j4 = 0; j4 < 4; ++j4) { const f32x4 lb = lbv[j4], lgn = lgv[j4]; const int j0 = 4 * j4;
                    u32x2 ow, gw2; ow.x = pk2((lb.x + vl[j0] * bon) * gv[j0], (lb.y + vl[j0 + 1] * bon) * gv[j0 + 1]); ow.y = pk2((lb.z + vl[j0 + 2] * bon) * gv[j0 + 2], (lb.w + vl[j0 + 3] * bon) * gv[j0 + 3]);
                    gw2.x = pk2(lgn.x * gv[j0], lgn.y * gv[j0 + 1]); gw2.y = pk2(lgn.z * gv[j0 + 2], lgn.w * gv[j0 + 3]);
                    *(u32x2*)((bf16*)(ws + WS_ADD) + off + j0) = ow; *(u32x2*)((bf16*)(ws + WS_G) + off + j0) = gw2; }
            }
            asm volatile("s_waitcnt lgkmcnt(0)" ::: "memory");
            {
                bf16x8 fa[2], fr[2], fb[2], fk[2];
#pragma unroll
                for (int ks = 0; ks < 2; ++ks) { const int po = l15 * 64 + 8 * ((4 * ks + g) ^ (l15 & 7));
                    fa[ks] = *(const LAS bf16x8*)(Arm + po); fr[ks] = *(const LAS bf16x8*)(Rrm + po); fb[ks] = *(const LAS bf16x8*)(Brm + po); fk[ks] = *(const LAS bf16x8*)(Krm + po); }
                f32x4 mab = z4, mak = z4, mrb = z4, mrk = z4;
#pragma unroll
                for (int ks = 0; ks < 2; ++ks) { mab = __builtin_amdgcn_mfma_f32_16x16x32_bf16(fb[ks], fa[ks], mab, 0, 0, 0); mak = __builtin_amdgcn_mfma_f32_16x16x32_bf16(fk[ks], fa[ks], mak, 0, 0, 0);
                    mrb = __builtin_amdgcn_mfma_f32_16x16x32_bf16(fb[ks], fr[ks], mrb, 0, 0, 0); mrk = __builtin_amdgcn_mfma_f32_16x16x32_bf16(fk[ks], fr[ks], mrk, 0, 0, 0); }
#pragma unroll
                for (int e = 0; e < 4; ++e) { const int i = 4 * g + e; if (!(i < l15)) { mab[e] = 0.f; mak[e] = 0.f; } if (!(i <= l15)) { mrb[e] = 0.f; mrk[e] = 0.f; } }
                asm volatile("s_waitcnt lgkmcnt(0)" ::: "memory");
#pragma unroll
                for (int e = 0; e < 4; ++e) MabT[(4 * g + e) * 16 + l15] = mab[e];
                u32x2 w; w.x = pk2(mak[0], mak[1]); w.y = pk2(mak[2], mak[3]); *(LAS u32x2*)(Mak + l15 * 16 + 4 * g) = w;
                w.x = pk2(mrb[0], mrb[1]); w.y = pk2(mrb[2], mrb[3]); *(LAS u32x2*)(Mrb + l15 * 16 + 4 * g) = w;
                w.x = pk2(mrk[0], mrk[1]); w.y = pk2(mrk[2], mrk[3]); *(LAS u32x2*)(Mrk + l15 * 16 + 4 * g) = w;
                if (te == 15) {
#pragma unroll
                    for (int j = 0; j < 16; ++j) PLs[16 * kq + j] = eP[j]; }
            }
            asm volatile("s_waitcnt lgkmcnt(0)" ::: "memory");
            {
                float y[16];
#pragma unroll
                for (int j = 15; j >= 0; --j) {
                    float acc = (j == l15) ? 1.0f : 0.0f;
                    float row[16];
#pragma unroll
                    for (int q = 0; q < 4; ++q) { const f32x4 x = *(const LAS f32x4*)(MabT + j * 16 + 4 * q); row[4 * q] = x.x; row[4 * q + 1] = x.y; row[4 * q + 2] = x.z; row[4 * q + 3] = x.w; }
#pragma unroll
                    for (int i = j + 1; i < 16; ++i) acc += y[i] * row[i];
                    y[j] = acc;
                }
                if (g == 0) { u32x4 t0, t1; t0.x = pk2(y[0], y[1]); t0.y = pk2(y[2], y[3]); t0.z = pk2(y[4], y[5]); t0.w = pk2(y[6], y[7]); t1.x = pk2(y[8], y[9]); t1.y = pk2(y[10], y[11]); t1.z = pk2(y[12], y[13]); t1.w = pk2(y[14], y[15]);
                    *(LAS u32x4*)(Tm + l15 * 16) = t0; *(LAS u32x4*)(Tm + l15 * 16 + 8) = t1; }
            }
            asm volatile("s_waitcnt lgkmcnt(0)" ::: "memory");
            {
                const bool act = g < 2; const int fo = l15 * 16 + 8 * g;
                const bf16x8 fT = act ? *(const LAS bf16x8*)(Tm + fo) : z8, fMak = act ? *(const LAS bf16x8*)(Mak + fo) : z8, fMrb = act ? *(const LAS bf16x8*)(Mrb + fo) : z8, fMrk = act ? *(const LAS bf16x8*)(Mrk + fo) : z8;
                bf16x8 fV[4], fQ1[4], fAh[4], fBT[4], fKT[4];
#pragma unroll
                for (int vt = 0; vt < 4; ++vt) { fV[vt] = act ? *(const LAS bf16x8*)(VTt + vt * 256 + fo) : z8; fBT[vt] = act ? *(const LAS bf16x8*)(BTt + vt * 256 + fo) : z8; fKT[vt] = act ? *(const LAS bf16x8*)(KTt + vt * 256 + fo) : z8; }
#pragma unroll
                for (int vt = 0; vt < 4; ++vt) { const f32x4 q0 = __builtin_amdgcn_mfma_f32_16x16x32_bf16(fMak, fV[vt], z4, 0, 0, 0);
                    u32x2 w; w.x = pk2(q0[0], q0[1]); w.y = pk2(q0[2], q0[3]); *(LAS u32x2*)(Q0T + vt * 256 + l15 * 16 + 4 * g) = w; }
#pragma unroll
                for (int kt = 0; kt < 4; ++kt) { const bf16x8 fA = act ? *(const LAS bf16x8*)(ATt + kt * 256 + fo) : z8; const f32x4 ah = __builtin_amdgcn_mfma_f32_16x16x32_bf16(fT, fA, z4, 0, 0, 0);
                    u32x2 w; w.x = pk2(ah[0], ah[1]); w.y = pk2(ah[2], ah[3]); *(LAS u32x2*)(ATt + kt * 256 + l15 * 16 + 4 * g) = w; }
                asm volatile("s_waitcnt lgkmcnt(0)" ::: "memory");
#pragma unroll
                for (int vt = 0; vt < 4; ++vt) { const bf16x8 fQ0 = act ? *(const LAS bf16x8*)(Q0T + vt * 256 + fo) : z8; const f32x4 q1 = __builtin_amdgcn_mfma_f32_16x16x32_bf16(fT, fQ0, z4, 0, 0, 0);
                    u32x2 w; w.x = pk2(q1[0], q1[1]); w.y = pk2(q1[2], q1[3]); *(LAS u32x2*)(Q0T + vt * 256 + l15 * 16 + 4 * g) = w; }
                asm volatile("s_waitcnt lgkmcnt(0)" ::: "memory");
#pragma unroll
                for (int vt = 0; vt < 4; ++vt) { fQ1[vt] = act ? *(const LAS bf16x8*)(Q0T + vt * 256 + fo) : z8; fAh[vt] = act ? *(const LAS bf16x8*)(ATt + vt * 256 + fo) : z8; }
                bf16* rp = (bf16*)(ws + WS_RP) + (size_t)un * 1024 + l15 * 64;
#pragma unroll
                for (int kt = 0; kt < 4; ++kt) {
                    const u32x2 rr = *(const LAS u32x2*)(Rrm + l15 * 64 + 8 * ((2 * kt + (g >> 1)) ^ (l15 & 7)) + 4 * (g & 1));
                    f32x4 ini; ini[0] = bflo(rr.x); ini[1] = bfhi(rr.x); ini[2] = bflo(rr.y); ini[3] = bfhi(rr.y);
                    const f32x4 rh = __builtin_amdgcn_mfma_f32_16x16x32_bf16(fAh[kt], fMrb, ini, 0, 0, 0);
                    u32x2 w; w.x = pk2(rh[0], rh[1]); w.y = pk2(rh[2], rh[3]); *(u32x2*)(rp + 32 * (kt >> 1) + 8 * g + 4 * (kt & 1)) = w;
                }
#pragma unroll
                for (int vt = 0; vt < 4; ++vt) { f32x4 y1 = __builtin_amdgcn_mfma_f32_16x16x32_bf16(fMrb, fQ1[vt], z4, 0, 0, 0); y1 = __builtin_amdgcn_mfma_f32_16x16x32_bf16(fMrk, fV[vt], y1, 0, 0, 0);
                    *(f32x4*)((float*)(ws + WS_Y1F) + ((size_t)(un * 4 + vt) * 64 + lane) * 4) = y1; }
                bf16* gp = (bf16*)(ws + WS_GP) + (size_t)un * 4096;
#pragma unroll
                for (int krt = 0; krt < 4; ++krt) { const float pl = PLs[16 * krt + l15];
#pragma unroll
                    for (int kct = 0; kct < 4; ++kct) { f32x4 ga = __builtin_amdgcn_mfma_f32_16x16x32_bf16(fAh[kct], fBT[krt], z4, 0, 0, 0);
                        if (kct == krt) {
#pragma unroll
                            for (int e = 0; e < 4; ++e) if (4 * g + e == l15) ga[e] += 1.0f; }
                        u32x2 w; w.x = pk2(ga[0] * pl, ga[1] * pl); w.y = pk2(ga[2] * pl, ga[3] * pl);
                        *(u32x2*)(gp + (16 * krt + l15) * 64 + 32 * (kct >> 1) + 8 * g + 4 * (kct & 1)) = w; } }
#pragma unroll
                for (int mt = 0; mt < 4; ++mt) { const f32x4 pl4 = *(const LAS f32x4*)(PLs + 16 * mt + 4 * g);
#pragma unroll
                    for (int vt = 0; vt < 4; ++vt) { f32x4 ha = __builtin_amdgcn_mfma_f32_16x16x32_bf16(fBT[mt], fQ1[vt], z4, 0, 0, 0); ha = __builtin_amdgcn_mfma_f32_16x16x32_bf16(fKT[mt], fV[vt], ha, 0, 0, 0);
                        u32x2 w; w.x = pk2(ha[0] * pl4[0], ha[1] * pl4[1]); w.y = pk2(ha[2] * pl4[2], ha[3] * pl4[3]);
                        *(u32x2*)((bf16*)(ws + WS_HF) + ((size_t)((un * 4 + vt) * 4 + mt) * 64 + lane) * 4) = w; } }
            }
            asm volatile("s_waitcnt lgkmcnt(0)" ::: "memory");
        }
        asm volatile("s_waitcnt vmcnt(0)" ::: "memory");
        { const int ltid = fresh_tid() & 63, l15 = ltid & 15, g = ltid >> 4, lane = ltid;
#define CP_LOADG(gf_, j_) do { const bf16* gp_ = (const bf16*)(ws + WS_GP) + ((size_t)u64 * 4 + (j_)) * 4096 + l15 * 64 + 8 * g; \
            _Pragma("unroll") for (int mt = 0; mt < 4; ++mt) { gf_[mt][0] = *(const bf16x8*)(gp_ + mt * 1024); gf_[mt][1] = *(const bf16x8*)(gp_ + mt * 1024 + 32); } } while (0)
#define CP_LOADH(hf_, j_) do { _Pragma("unroll") for (int sl = 0; sl < 4; ++sl) _Pragma("unroll") for (int mt = 0; mt < 4; ++mt) \
            hf_[sl][mt] = *(const u32x2*)((const bf16*)(ws + WS_HF) + ((size_t)((((size_t)u64 * 4 + (j_)) * 4 + sl) * 4 + mt) * 64 + lane) * 4); } while (0)
#define CP_STEP(gf_, hf_, useh_) do { _Pragma("unroll") for (int sl = 0; sl < 4; ++sl) { bf16x8 zb[2]; RW_ZB(z[sl], zb); \
            _Pragma("unroll") for (int mt = 0; mt < 4; ++mt) { f32x4 a_ = (f32x4){0.f, 0.f, 0.f, 0.f}; \
                if (useh_) { a_[0] = bflo(hf_[sl][mt].x); a_[1] = bfhi(hf_[sl][mt].x); a_[2] = bflo(hf_[sl][mt].y); a_[3] = bfhi(hf_[sl][mt].y); } \
                a_ = __builtin_amdgcn_mfma_f32_16x16x32_bf16(gf_[mt][0], zb[0], a_, 0, 0, 0); a_ = __builtin_amdgcn_mfma_f32_16x16x32_bf16(gf_[mt][1], zb[1], a_, 0, 0, 0); z[sl][mt] = a_; } } } while (0)
        {
            f32x4 z[4][4];
#pragma unroll
            for (int sl = 0; sl < 4; ++sl)
#pragma unroll
                for (int mt = 0; mt < 4; ++mt)
#pragma unroll
                    for (int e = 0; e < 4; ++e) z[sl][mt][e] = (sl == mt && 4 * g + e == l15) ? 1.0f : 0.0f;
            bf16x8 gA[4][2], gB[4][2]; u32x2 hdum[4][4];
            CP_LOADG(gA, 0); CP_LOADG(gB, 1);
            CP_STEP(gA, hdum, false); CP_LOADG(gA, 2);
            CP_STEP(gB, hdum, false); CP_LOADG(gB, 3);
            CP_STEP(gA, hdum, false);
            CP_STEP(gB, hdum, false);
            LAS bf16* tg = (LAS bf16*)(lds + wave * 16384);
#pragma unroll
            for (int sl = 0; sl < 4; ++sl) { const int pc = 32 * (sl >> 1) + 8 * (l15 >> 2) + 4 * (sl & 1) + (l15 & 3);
#pragma unroll
                for (int mt = 0; mt < 4; ++mt)
#pragma unroll
                    for (int e = 0; e < 4; ++e) tg[(16 * mt + 4 * g + e) * 64 + pc] = (bf16)f2bf(z[sl][mt][e]); }
            u32x4* gc = (u32x4*)((bf16*)(ws + WS_GC) + (size_t)u64 * 4096);
#pragma unroll
            for (int i = 0; i < 8; ++i) gc[i * 64 + lane] = *(const LAS u32x4*)(tg + (i * 64 + lane) * 8);
        }
        {
            f32x4 z[4][4];
#pragma unroll
            for (int sl = 0; sl < 4; ++sl)
#pragma unroll
                for (int mt = 0; mt < 4; ++mt) z[sl][mt] = (f32x4){0.f, 0.f, 0.f, 0.f};
            bf16x8 gA[4][2], gB[4][2]; u32x2 hA[4][4], hB[4][4];
            CP_LOADG(gA, 0); CP_LOADH(hA, 0); CP_LOADG(gB, 1); CP_LOADH(hB, 1);
            CP_STEP(gA, hA, true); CP_LOADG(gA, 2); CP_LOADH(hA, 2);
            CP_STEP(gB, hB, true); CP_LOADG(gB, 3); CP_LOADH(hB, 3);
            CP_STEP(gA, hA, true);
            CP_STEP(gB, hB, true);
#pragma unroll
            for (int sl = 0; sl < 4; ++sl)
#pragma unroll
                for (int mt = 0; mt < 4; ++mt) { u32x2 w; w.x = pk2(z[sl][mt][0], z[sl][mt][1]); w.y = pk2(z[sl][mt][2], z[sl][mt][3]);
                    *(u32x2*)((bf16*)(ws + WS_HC) + ((size_t)((u64 * 4 + sl) * 4 + mt) * 64 + lane) * 4) = w; }
        }
#undef CP_LOADG
#undef CP_LOADH
#undef CP_STEP
        }
        }
        for (int lu = gw; lu < NB * 8 * 64; lu += NGW) {
            const int bc = lu >> 6, seg = lu & 63, b = bc >> 3, cg = bc & 7, ch = cg * 64 + lane;
            const size_t mb = (size_t)b * SEQ + seg * 64;
            float A = 1.f, B = 0.f;
#pragma unroll 16
            for (int t = 0; t < 64; ++t) { const float a = __expf(bf2f(LA[(mb + t) * 512 + ch])), bt = bf2f(LB[(mb + t) * 512 + ch]); B = a * B + bt; A *= a; }
            f32x2 ab; ab.x = A; ab.y = B; *(f32x2*)((float*)(ws + WS_AP) + ((size_t)lu * 64 + lane) * 2) = ab;
        }
    }
    SEAM(3);


    if (IN(4)) { PHASE_IDS;
        if (!(bid < 128 && wave == 0)) {
            const int wi = bid < 128 ? bid * 7 + (wave - 1) : 896 + (bid - 128) * 8 + wave, NW = 896 + (G - 128) * 8;
        } else {
            const int l15 = lane & 15, g = lane >> 4, bh = bid >> 2, vs = bid & 3;
            f32x4 z[4];
#pragma unroll
            for (int mt = 0; mt < 4; ++mt) z[mt] = (f32x4){0.f, 0.f, 0.f, 0.f};
            bf16x8 gA[4][2], gB[4][2], gC[4][2], gD[4][2]; u32x2 hA[4], hB[4], hC[4], hD[4];
#define SC_LOAD(gf, hf, C) do { const size_t u64_ = (size_t)bh * 64 + (C); const bf16* gp_ = (const bf16*)(ws + WS_GC) + u64_ * 4096 + l15 * 64 + 8 * g; \
                _Pragma("unroll") for (int mt = 0; mt < 4; ++mt) { gf[mt][0] = *(const bf16x8*)(gp_ + mt * 1024); gf[mt][1] = *(const bf16x8*)(gp_ + mt * 1024 + 32); \
                    hf[mt] = *(const u32x2*)((const bf16*)(ws + WS_HC) + ((size_t)((u64_ * 4 + vs) * 4 + mt) * 64 + lane) * 4); } } while (0)
#define SC_STEP(gf, hf, C) do { const size_t u64_ = (size_t)bh * 64 + (C); bf16* zs_ = (bf16*)(ws + WS_ZS) + ((size_t)((u64_ * 4 + vs) * 4) * 64 + lane) * 4; \
                _Pragma("unroll") for (int mt = 0; mt < 4; ++mt) { u32x2 zw_; zw_.x = pk2(z[mt][0], z[mt][1]); zw_.y = pk2(z[mt][2], z[mt][3]); *(u32x2*)(zs_ + mt * 256) = zw_; } \
                bf16x8 zb[2]; RW_ZB(z, zb); \
                _Pragma("unroll") for (int mt = 0; mt < 4; ++mt) { f32x4 a; a[0] = bflo(hf[mt].x); a[1] = bfhi(hf[mt].x); a[2] = bflo(hf[mt].y); a[3] = bfhi(hf[mt].y); \
                    a = __builtin_amdgcn_mfma_f32_16x16x32_bf16(gf[mt][0], zb[0], a, 0, 0, 0); a = __builtin_amdgcn_mfma_f32_16x16x32_bf16(gf[mt][1], zb[1], a, 0, 0, 0); z[mt] = a; } } while (0)
            SC_LOAD(gA, hA, 0); SC_LOAD(gB, hB, 1); SC_LOAD(gC, hC, 2);
#pragma unroll 1
            for (int C = 0; C < 64; C += 4) {
                SC_LOAD(gD, hD, C + 3);
                SC_STEP(gA, hA, C);
                if (C + 4 < 64) SC_LOAD(gA, hA, C + 4);
                SC_STEP(gB, hB, C + 1);
                if (C + 5 < 64) SC_LOAD(gB, hB, C + 5);
                SC_STEP(gC, hC, C + 2);
                if (C + 6 < 64) SC_LOAD(gC, hC, C + 6);
                SC_STEP(gD, hD, C + 3);
            }
#undef SC_LOAD
#undef SC_STEP
        }
    }
    SEAM(4);

    if (IN(5)) { PHASE_IDS;
        {
            for (int lu = gw; lu < NB * 8 * 64; lu += NGW) {
                const int bc = lu >> 6, seg = lu & 63, b = bc >> 3, cg = bc & 7, ch = cg * 64 + lane;
                const size_t mb = (size_t)b * SEQ + seg * 64;
                float hst = 0.f;
                const f32x2* ag = (const f32x2*)((const float*)(ws + WS_AP)) + (size_t)(bc * 64) * 64 + lane;
#pragma unroll 8
                for (int sg = 0; sg < seg; ++sg) { const f32x2 ab = ag[(size_t)sg * 64]; hst = ab.x * hst + ab.y; }
#pragma unroll 16
                for (int t = 0; t < 64; ++t) { const float a = __expf(bf2f(LA[(mb + t) * 512 + ch])), bt = bf2f(LB[(mb + t) * 512 + ch]); hst = a * hst + bt;
                    const float gl = bf2f(U[(mb + t) * INW + 512 + ch]); CAT[(mb + t) * 1024 + ch] = (bf16)f2bf(hst * gelu_tanh_f(gl)); }
            }
        }
        const int l15 = lane & 15, g = lane >> 4;
        LAS bf16* tGL = (LAS bf16*)(lds + wave * 16384); LAS bf16* tAD = tGL + 1024; LAS bf16* tOUT = tGL + 2048;
        const int ct = lane >> 3, cc = lane & 7;
        for (int u64 = gw; u64 < NB * NH * (SEQ / 64); u64 += NGW) {
            const int bh = u64 >> 6, C = u64 & 63, b = bh >> 3, h = bh & 7;
            f32x4 z[4][4];
#pragma unroll
            for (int sl = 0; sl < 4; ++sl)
#pragma unroll
                for (int mt = 0; mt < 4; ++mt) { const u32x2 zw = *(const u32x2*)((const bf16*)(ws + WS_ZS) + ((size_t)((u64 * 4 + sl) * 4 + mt) * 64 + lane) * 4); z[sl][mt] = (f32x4){bflo(zw.x), bfhi(zw.x), bflo(zw.y), bfhi(zw.y)}; }
#pragma unroll 1
            for (int j = 0; j < 4; ++j) {
                const size_t un = (size_t)u64 * 4 + j; const size_t m0 = (size_t)b * SEQ + (C * 4 + j) * 16;
                const bf16* rp = (const bf16*)(ws + WS_RP) + un * 1024 + l15 * 64 + 8 * g;
                const bf16x8 rf0 = *(const bf16x8*)rp, rf1 = *(const bf16x8*)(rp + 32);
                f32x4 y[4];
#pragma unroll
                for (int sl = 0; sl < 4; ++sl) y[sl] = *(const f32x4*)((const float*)(ws + WS_Y1F) + ((size_t)(un * 4 + sl) * 64 + lane) * 4);
                const size_t rg = (m0 + ct) * 512 + h * 64 + 8 * cc;
                const u32x4 gl0 = *(const u32x4*)((const bf16*)(ws + WS_G) + rg), gl1 = *(const u32x4*)((const bf16*)(ws + WS_G) + rg + 8 * 512);
                const u32x4 ad0 = *(const u32x4*)((const bf16*)(ws + WS_ADD) + rg), ad1 = *(const u32x4*)((const bf16*)(ws + WS_ADD) + rg + 8 * 512);
                bf16x8 gf[4][2]; u32x2 hfr[4][4];
                if (j < 3) {
                    const bf16* gp = (const bf16*)(ws + WS_GP) + un * 4096 + l15 * 64 + 8 * g;
#pragma unroll
                    for (int mt = 0; mt < 4; ++mt) { gf[mt][0] = *(const bf16x8*)(gp + mt * 1024); gf[mt][1] = *(const bf16x8*)(gp + mt * 1024 + 32); }
#pragma unroll
                    for (int sl = 0; sl < 4; ++sl)
#pragma unroll
                        for (int mt = 0; mt < 4; ++mt) hfr[sl][mt] = *(const u32x2*)((const bf16*)(ws + WS_HF) + ((size_t)((un * 4 + sl) * 4 + mt) * 64 + lane) * 4);
                }
                *(LAS u32x4*)(tGL + ct * 64 + 8 * cc) = gl0; *(LAS u32x4*)(tGL + (ct + 8) * 64 + 8 * cc) = gl1;
                *(LAS u32x4*)(tAD + ct * 64 + 8 * cc) = ad0; *(LAS u32x4*)(tAD + (ct + 8) * 64 + 8 * cc) = ad1;
                bf16x8 zb[4][2];
#pragma unroll
                for (int sl = 0; sl < 4; ++sl) { RW_ZB(z[sl], zb[sl]);
                    y[sl] = __builtin_amdgcn_mfma_f32_16x16x32_bf16(rf0, zb[sl][0], y[sl], 0, 0, 0); y[sl] = __builtin_amdgcn_mfma_f32_16x16x32_bf16(rf1, zb[sl][1], y[sl], 0, 0, 0); }
#pragma unroll
                for (int e = 0; e < 4; ++e) {
                    float s1 = (y[0][e] + y[1][e]) + (y[2][e] + y[3][e]);
                    s1 += __shfl_xor(s1, 1); s1 += __shfl_xor(s1, 2); s1 += __shfl_xor(s1, 4); s1 += __shfl_xor(s1, 8);
                    const float mean = s1 * (1.0f / 64.0f);
                    float d0 = y[0][e] - mean, d1 = y[1][e] - mean, d2 = y[2][e] - mean, d3 = y[3][e] - mean;
                    float s2 = (d0 * d0 + d1 * d1) + (d2 * d2 + d3 * d3);
                    s2 += __shfl_xor(s2, 1); s2 += __shfl_xor(s2, 2); s2 += __shfl_xor(s2, 4); s2 += __shfl_xor(s2, 8);
                    const float rstd = rsq_f(s2 * (1.0f / 64.0f) + GN_EPS);
                    const float dd[4] = {d0, d1, d2, d3};
#pragma unroll
                    for (int sl = 0; sl < 4; ++sl) { const int ti_ = (4 * g + e) * 64 + 16 * sl + l15;
                        const float o = dd[sl] * rstd * bf2f(tGL[ti_]) + bf2f(tAD[ti_]); tOUT[ti_] = (bf16)f2bf(o); }
                }
                { bf16* cp = CAT + (m0 + ct) * 1024 + 512 + h * 64 + 8 * cc;
                  *(u32x4*)cp = *(const LAS u32x4*)(tOUT + ct * 64 + 8 * cc); *(u32x4*)(cp + 8 * 1024) = *(const LAS u32x4*)(tOUT + (ct + 8) * 64 + 8 * cc); }
                if (j < 3) {
#pragma unroll
                    for (int sl = 0; sl < 4; ++sl)
#pragma unroll
                        for (int mt = 0; mt < 4; ++mt) { const u32x2 hh = hfr[sl][mt];
                            f32x4 a; a[0] = bflo(hh.x); a[1] = bfhi(hh.x); a[2] = bflo(hh.y); a[3] = bfhi(hh.y);
                            a = __builtin_amdgcn_mfma_f32_16x16x32_bf16(gf[mt][0], zb[sl][0], a, 0, 0, 0); a = __builtin_amdgcn_mfma_f32_16x16x32_bf16(gf[mt][1], zb[sl][1], a, 0, 0, 0); z[sl][mt] = a; }
                }
            }
        }
    }
    SEAM(5);
#undef RW_ZB


    if (IN(6)) { PHASE_IDS;
        pg8::DenseSched S; S.o.init_tiles(M / 256, D / 256, G, bid); S.A = (const char*)CAT; S.B = (const char*)Wout_t; S.tstep = (size_t)256 * D * 2;
        EpiBf16Res<false> E{args.in[I_X], X1, D, (float*)(ws + WS_AP + 2 * MiB)}; pg8::gemm_phase(lds, D, S, E);
    }
    SEAM(6);
    if (IN(7)) { PHASE_IDS;
        pg8::DenseSched S; S.o.init_tiles(M / 256, D / 256, G, bid); S.A = (const char*)X1; S.B = (const char*)Wq_t; S.tstep = (size_t)256 * D * 2;
        EpiBf16RowNorm E{Qb, D, 0.0625f, (const float*)(ws + WS_AP + 2 * MiB)}; pg8::gemm_phase(lds, D, S, E);
    }
    SEAM(7);
    if (IN(8)) { PHASE_IDS;
        constexpr int KP = 264, VP = 72;
        LAS bf16* Kt = (LAS bf16*)lds;
        LAS bf16* Vt = (LAS bf16*)(lds + 64 * KP * 2);
        const int l15 = lane & 15, g4 = lane >> 4;
        const int bh = bid >> 4, b = bh >> 2, h = bh & 3;
        const int kkey = tid >> 3, kpart = tid & 7, vd = tid >> 1, vhalf = tid & 1;
        const bf16* kg = KM + (size_t)(b * MEML + kkey) * D + h * XHD + 32 * kpart;
        const bf16* vg = VT + (size_t)(h * XHD + vd) * MROWS + b * MEML + 32 * vhalf;
#pragma unroll 1
        for (int u = 0; u < 2; ++u) {
            const int q0 = ((bid & 15) * 2 + u) * 128 + wave * 16;
            const bf16* qbase = Qb + (size_t)(b * SEQ + q0 + l15) * D + h * XHD + 8 * g4;
            bf16x8 qf[8];
#pragma unroll
            for (int ks = 0; ks < 8; ++ks) qf[ks] = *(const bf16x8*)(qbase + 32 * ks);
            f32x4 oc[16];
#pragma unroll
            for (int dt = 0; dt < 16; ++dt) oc[dt] = (f32x4){0.f, 0.f, 0.f, 0.f};
            float mrun = -3.0e38f, lrun = 0.f;
            u32x4 kr[4], vr[4];
#pragma unroll
            for (int i = 0; i < 4; ++i) { kr[i] = *(const u32x4*)(kg + 8 * i); vr[i] = *(const u32x4*)(vg + 8 * i); }
#pragma unroll 1
            for (int kt = 0; kt < 4; ++kt) {
                __syncthreads();
#pragma unroll
                for (int i = 0; i < 4; ++i) { *(LAS u32x4*)(Kt + kkey * KP + 32 * kpart + 8 * i) = kr[i]; *(LAS u32x4*)(Vt + vd * VP + 32 * vhalf + 8 * i) = vr[i]; }
                if (kt < 3) {
#pragma unroll
                    for (int i = 0; i < 4; ++i) { kr[i] = *(const u32x4*)(kg + (size_t)(kt + 1) * 64 * D + 8 * i); vr[i] = *(const u32x4*)(vg + (kt + 1) * 64 + 8 * i); } }
                __syncthreads();
                f32x4 sc[4];
#pragma unroll
                for (int j = 0; j < 4; ++j) sc[j] = (f32x4){0.f, 0.f, 0.f, 0.f};
#pragma unroll
                for (int ks = 0; ks < 8; ++ks)
#pragma unroll
                    for (int j = 0; j < 4; ++j) { const bf16x8 kf = *(const LAS bf16x8*)(Kt + (16 * j + l15) * KP + 32 * ks + 8 * g4);
                        sc[j] = __builtin_amdgcn_mfma_f32_16x16x32_bf16(kf, qf[ks], sc[j], 0, 0, 0); }
                float mx = -3.0e38f;
#pragma unroll
                for (int j = 0; j < 4; ++j) mx = fmaxf(mx, fmaxf(fmaxf(sc[j][0], sc[j][1]), fmaxf(sc[j][2], sc[j][3])));
                mx = fmaxf(mx, __shfl_xor(mx, 16)); mx = fmaxf(mx, __shfl_xor(mx, 32));
                const float mnew = fmaxf(mrun, mx), alpha = __expf(mrun - mnew);
                mrun = mnew; lrun *= alpha;
#pragma unroll
                for (int j = 0; j < 4; ++j)
#pragma unroll
                    for (int e = 0; e < 4; ++e) { const float p = __expf(sc[j][e] - mnew); sc[j][e] = p; lrun += p; }
                bf16x8 pf[2];
#pragma unroll
                for (int s2 = 0; s2 < 2; ++s2) { u32x4 pw; pw.x = pk2(sc[2 * s2][0], sc[2 * s2][1]); pw.y = pk2(sc[2 * s2][2], sc[2 * s2][3]); pw.z = pk2(sc[2 * s2 + 1][0], sc[2 * s2 + 1][1]); pw.w = pk2(sc[2 * s2 + 1][2], sc[2 * s2 + 1][3]);
                    pf[s2] = __builtin_bit_cast(bf16x8, pw); }
#pragma unroll
                for (int dt = 0; dt < 16; ++dt) {
                    f32x4 o = oc[dt] * alpha;
#pragma unroll
                    for (int s2 = 0; s2 < 2; ++s2) { const LAS bf16* vp = Vt + (16 * dt + l15) * VP + 32 * s2 + 4 * g4;
                        const u32x2 v0 = *(const LAS u32x2*)vp, v1 = *(const LAS u32x2*)(vp + 16);
                        u32x4 vv; vv.x = v0.x; vv.y = v0.y; vv.z = v1.x; vv.w = v1.y;
                        o = __builtin_amdgcn_mfma_f32_16x16x32_bf16(__builtin_bit_cast(bf16x8, vv), pf[s2], o, 0, 0, 0); }
                    oc[dt] = o;
                }
            }
            lrun += __shfl_xor(lrun, 16); lrun += __shfl_xor(lrun, 32);
            const float inv = rcp_f(lrun);
            bf16* obase = Ob + (size_t)(b * SEQ + q0 + l15) * D + h * XHD + 4 * g4;
#pragma unroll
            for (int dt = 0; dt < 16; ++dt) { u32x2 w; w.x = pk2(oc[dt][0] * inv, oc[dt][1] * inv); w.y = pk2(oc[dt][2] * inv, oc[dt][3] * inv); *(u32x2*)(obase + 16 * dt) = w; }
        }
        __syncthreads();
    }
    SEAM(8);
    if (IN(9)) { PHASE_IDS;
        pg8::DenseSched S; S.o.init_tiles(M / 256, D / 256, G, bid); S.A = (const char*)Ob; S.B = (const char*)Wo_t; S.tstep = (size_t)256 * D * 2;
        EpiBf16Res<true> E{X1, X2, D, nullptr}; pg8::gemm_phase(lds, D, S, E);
    }
    SEAM(9);
    if (IN(10)) { PHASE_IDS;
        for (int cid = tid; cid < 2 * NE * 128; cid += NTHREADS) { const int t = cid >> 12, row = (cid >> 7) & 31, c = cid & 127;
            *(LAS u32x4*)(lds + t * 65536 + row * 2048 + ((c ^ (row & 7)) << 4)) = *(const u32x4*)(WrT + (size_t)t * NE * D + row * D + 8 * c); }
        __syncthreads();
        const int l15 = lane & 15, g = lane >> 4;
        LAS float* LG = (LAS float*)(lds + RING_BYTES + 1024 + wave * 2304);
        const float* gfn = args.in[I_NFFG];
        LAS unsigned* cntl = (LAS unsigned*)(lds + RING_BYTES + 640);
        for (int t0 = 0; t0 < M / 16; t0 += G * 4) {
        if (tid < 64) cntl[tid] = 0u;
        __syncthreads();
        const int tile = t0 + bid * 4 + wave; const bool active = wave < 4 && tile < M / 16;
        int me = 0, lpos = 0, ai = 0; float mg = 0.f;
        if (active) {
            const int m0 = tile * 16;
            const bf16* xrow = X2 + (size_t)(m0 + l15) * D + 8 * g;
            float ss = 0.f;
#pragma unroll 8
            for (int ks = 0; ks < 32; ++ks) { const u32x4 xw = *(const u32x4*)(xrow + 32 * ks);
#pragma unroll
                for (int q = 0; q < 4; ++q) { const float a = bflo(xw[q]), c = bfhi(xw[q]); ss += a * a + c * c; } }
            ss += __shfl_xor(ss, 16); ss += __shfl_xor(ss, 32);
            const float rstd = rsq_f(ss * (1.f / D) + EPS);
            f32x4 acc0 = (f32x4){0.f, 0.f, 0.f, 0.f}, acc1 = acc0;
            bf16* hrow = HN + (size_t)(m0 + l15) * D + 8 * g;
#pragma unroll 2
            for (int ks = 0; ks < 32; ++ks) {
                const f32x4 g0 = *(const f32x4*)(gfn + 32 * ks + 8 * g), g1 = *(const f32x4*)(gfn + 32 * ks + 8 * g + 4);
                const u32x4 xw = *(const u32x4*)(xrow + 32 * ks);
                float hf[8];
#pragma unroll
                for (int q = 0; q < 4; ++q) { hf[2 * q] = bflo(xw[q]) * rstd * (q < 2 ? g0[2 * q] : g1[2 * q - 4]); hf[2 * q + 1] = bfhi(xw[q]) * rstd * (q < 2 ? g0[2 * q + 1] : g1[2 * q - 3]); }
                u32x4 hi, lo;
#pragma unroll
                for (int q = 0; q < 4; ++q) { hi[q] = pk2(hf[2 * q], hf[2 * q + 1]); lo[q] = pk2(hf[2 * q] - bflo(hi[q]), hf[2 * q + 1] - bfhi(hi[q])); }
                *(u32x4*)(hrow + 32 * ks) = hi;
                const bf16x8 ah = __builtin_bit_cast(bf16x8, hi), al = __builtin_bit_cast(bf16x8, lo);
                const int c = 4 * ks + g;
#pragma unroll
                for (int nt = 0; nt < 2; ++nt) { const int row = 16 * nt + l15; const int off = row * 2048 + ((c ^ (row & 7)) << 4);
                    const bf16x8 bh = *(const LAS bf16x8*)(lds + off), bl = *(const LAS bf16x8*)(lds + 65536 + off);
                    f32x4 a = nt ? acc1 : acc0;
                    a = __builtin_amdgcn_mfma_f32_16x16x32_bf16(ah, bh, a, 0, 0, 0); a = __builtin_amdgcn_mfma_f32_16x16x32_bf16(ah, bl, a, 0, 0, 0); a = __builtin_amdgcn_mfma_f32_16x16x32_bf16(al, bh, a, 0, 0, 0);
                    if (nt) acc1 = a; else acc0 = a; }
            }
            { const float b0 = args.in[I_BR][l15], b1 = args.in[I_BR][16 + l15];
#pragma unroll
              for (int j = 0; j < 4; ++j) { LG[(4 * g + j) * 33 + l15] = acc0[j] + b0; LG[(4 * g + j) * 33 + 16 + l15] = acc1[j] + b1; } }
            const int rrow = lane >> 2, qq = lane & 3;
            float tv[4] = {-3.0e38f, -3.0e38f, -3.0e38f, -3.0e38f}; int ti[4] = {64, 65, 66, 67};
#define TOP_INS(xv_, xi_) do { float x_ = (xv_); int i_ = (xi_); _Pragma("unroll") for (int p_ = 0; p_ < 4; ++p_) { const bool b_ = x_ > tv[p_] || (x_ == tv[p_] && i_ < ti[p_]); \
                const float ov_ = tv[p_]; const int oi_ = ti[p_]; tv[p_] = b_ ? x_ : ov_; ti[p_] = b_ ? i_ : oi_; x_ = b_ ? ov_ : x_; i_ = b_ ? oi_ : i_; } } while (0)
#pragma unroll
            for (int j = 0; j < 8; ++j) TOP_INS(LG[rrow * 33 + 8 * qq + j], 8 * qq + j);
#pragma unroll
            for (int st = 1; st < 4; st <<= 1) { float pv[4]; int pi[4];
#pragma unroll
                for (int p = 0; p < 4; ++p) { pv[p] = __shfl_xor(tv[p], st); pi[p] = __shfl_xor(ti[p], st); }
#pragma unroll
                for (int p = 0; p < 4; ++p) TOP_INS(pv[p], pi[p]); }
#undef TOP_INS
            const float e1 = __expf(tv[1] - tv[0]), e2 = __expf(tv[2] - tv[0]), e3 = __expf(tv[3] - tv[0]);
            const float inv = rcp_f(1.0f + e1 + e2 + e3);
            me = qq == 0 ? ti[0] : qq == 1 ? ti[1] : qq == 2 ? ti[2] : ti[3];
            mg = (qq == 0 ? 1.0f : qq == 1 ? e1 : qq == 2 ? e2 : e3) * inv;
            lpos = (int)__hip_atomic_fetch_add(cntl + me, 1u, __ATOMIC_RELAXED, __HIP_MEMORY_SCOPE_WORKGROUP);
            ai = (m0 + rrow) * 4 + qq;
        }
        __syncthreads();
        if (tid < NE) { const unsigned c = cntl[tid]; cntl[32 + tid] = c ? atomicAdd(ecnt + 64 * tid, c) : 0u; }
        __syncthreads();
        if (active) { route_e[ai] = me; route_pos[ai] = (int)cntl[32 + me] + lpos; route_g[ai] = mg; }
        __syncthreads();
        }
    }
    SEAM(10);
    if (IN(11)) { PHASE_IDS;
        LAS int* pst = (LAS int*)lds;
        if (tid == 0) { int acc = 0; for (int e = 0; e < NE; ++e) { const int c = (int)__hip_atomic_load(ecnt + 64 * e, __ATOMIC_RELAXED, __HIP_MEMORY_SCOPE_AGENT); pst[e] = acc; pst[64 + e] = c; acc += (c + 255) & ~255; } pst[32] = acc; }
        __syncthreads();
        for (int ai = bid * NTHREADS + tid; ai < NASSIGN; ai += G * NTHREADS) {
            const int e = route_e[ai]; const int row = pst[e] + route_pos[ai]; row_slot[row] = ai; row_gate[row] = route_g[ai]; row_tok[row] = ai >> 2; }
        if (bid < NE) { const int e = bid, c = pst[64 + e], pe = (c + 255) & ~255; for (int p = c + tid; p < pe; p += NTHREADS) { row_slot[pst[e] + p] = -1; row_gate[pst[e] + p] = 0.f; row_tok[pst[e] + p] = 0; } }
        if (bid == 0 && tid == 0) { int nt = 0; for (int e = 0; e < NE; ++e) { const int n = ((pst[64 + e] + 255) & ~255) >> 8; for (int j = 0; j < n; ++j) tile_tab[16 + nt++] = e; } tile_tab[0] = nt; }
        __syncthreads();
    }
    SEAM(11);
    if (IN(12)) { PHASE_IDS;
        const int ntiles = tile_tab[0];
        pg8::MoeGatherSched S; S.o.init_tiles(ntiles, 2048 / 256, G, bid); S.A = (const char*)HN; S.B = (const char*)Wgu_t; S.tile_e = tile_tab + 16; S.rtok = row_tok; S.tstep = (size_t)256 * D * 2; S.estep = (size_t)2048 * D * 2;
        EpiSwiglu E{ACT, args.in[I_BGU]}; pg8::gemm_phase(lds, D, S, E);
    }
    SEAM(12);
    if (IN(13)) { PHASE_IDS;
        const int ntiles = tile_tab[0];
        pg8::MoeSched S; S.o.init_tiles(ntiles, D / 256, G, bid); S.A = (const char*)ACT; S.B = (const char*)Wdn_t; S.tile_e = tile_tab + 16; S.tstep = (size_t)256 * DFF * 2; S.estep = (size_t)D * DFF * 2;
        EpiDown E{YS, args.in[I_BDN], row_slot, row_gate}; pg8::gemm_phase(lds, DFF, S, E);
    }
    SEAM(13);
    if (IN(14)) { PHASE_IDS;
        const float* gfin = args.in[I_FNG];
        for (int m = gw; m < M; m += NGW) {
            float v[16]; float s = 0.f;
#pragma unroll
            for (int hf = 0; hf < 2; ++hf) { const u32x4 w = *(const u32x4*)(X2 + (size_t)m * D + 512 * hf + 8 * lane);
#pragma unroll
                for (int q = 0; q < 4; ++q) { v[8 * hf + 2 * q] = bflo(w[q]); v[8 * hf + 2 * q + 1] = bfhi(w[q]); }
#pragma unroll
                for (int k = 0; k < 4; ++k) { const u32x4 y = *(const u32x4*)(YS + (size_t)(m * 4 + k) * D + 512 * hf + 8 * lane);
#pragma unroll
                    for (int q = 0; q < 4; ++q) { v[8 * hf + 2 * q] += bflo(y[q]); v[8 * hf + 2 * q + 1] += bfhi(y[q]); } } }
#pragma unroll
            for (int j = 0; j < 16; ++j) s += v[j] * v[j];
            const float rstd = rsq_f(wave_sum(s) * (1.f / D) + EPS);
#pragma unroll
            for (int hf = 0; hf < 2; ++hf) { const f32x4 g0 = *(const f32x4*)(gfin + 512 * hf + 8 * lane), g1 = *(const f32x4*)(gfin + 512 * hf + 8 * lane + 4);
                float* o = args.out + (size_t)m * D + 512 * hf + 8 * lane;
                *(f32x4*)o = (f32x4){v[8 * hf] * rstd * g0.x, v[8 * hf + 1] * rstd * g0.y, v[8 * hf + 2] * rstd * g0.z, v[8 * hf + 3] * rstd * g0.w};
                *(f32x4*)(o + 4) = (f32x4){v[8 * hf + 4] * rstd * g1.x, v[8 * hf + 5] * rstd * g1.y, v[8 * hf + 6] * rstd * g1.z, v[8 * hf + 7] * rstd * g1.w}; }
        }
    }
#undef IN
#undef SEAM
}

constexpr int N_PHASES = 15;
extern "C" void kernel_launch(void* const* d_in, const int* in_sizes, int n_in, void* d_out, int out_size, void* d_ws, size_t ws_size, hipStream_t stream) {
    static int grid = 0;
    if (grid == 0) {
        if (n_in != 37 || out_size != M * D || ws_size < WS_END) { fprintf(stderr, "kernel_launch: unexpected shapes (n_in %d, out %d, ws %zu); nothing launched\n", n_in, out_size, ws_size); grid = -1; return; }
        int dev = 0, cus = 0, per_cu = 0;
        if (hipGetDevice(&dev) != hipSuccess || hipDeviceGetAttribute(&cus, hipDeviceAttributeMultiprocessorCount, dev) != hipSuccess) { grid = -1; return; }
        if (hipFuncSetAttribute((const void*)fwd, hipFuncAttributeMaxDynamicSharedMemorySize, LDS_BYTES) != hipSuccess) { fprintf(stderr, "kernel_launch: hipFuncSetAttribute failed\n"); grid = -1; return; }
        if (hipOccupancyMaxActiveBlocksPerMultiprocessor(&per_cu, (const void*)fwd, NTHREADS, LDS_BYTES) != hipSuccess || per_cu < 1) fprintf(stderr, "kernel_launch: occupancy query says %d\n", per_cu);
        (void)hipGetLastError();
        grid = cus > 256 ? 256 : cus;
    }
    if (grid < 0) return;
    if (hipMemsetAsync((char*)d_ws + WS_CTL, 0, CTL_ZERO_BYTES, stream) != hipSuccess) return;
    Args a{};
    for (int i = 0; i < 37; ++i) a.in[i] = (const float*)d_in[i];
    a.out = (float*)d_out; a.ws = (unsigned char*)d_ws;
#if MK_ONE_LAUNCH
    a.ph_lo = 0; a.ph_hi = N_PHASES;
    hipLaunchKernelGGL(fwd, dim3(grid), dim3(NTHREADS), LDS_BYTES, stream, a);
#else
    for (int p = 0; p < N_PHASES; ++p) { a.ph_lo = p; a.ph_hi = p + 1; hipLaunchKernelGGL(fwd, dim3(grid), dim3(NTHREADS), LDS_BYTES, stream, a);
#ifdef PROBE_REPEAT_PHASE
        if (p == PROBE_REPEAT_PHASE) hipLaunchKernelGGL(fwd, dim3(grid), dim3(NTHREADS), LDS_BYTES, stream, a);
#endif
    }
#endif
}
```

```cpp
#include <hip/hip_runtime.h>
#include <cstdio>
#include <cstdint>

#ifndef MK_ONE_LAUNCH
#define MK_ONE_LAUNCH 1
#endif

#define DI __device__ __forceinline__
#define GAS __attribute__((address_space(1)))
#define LAS __attribute__((address_space(3)))
typedef unsigned short bf16;
typedef short bf16x8 __attribute__((ext_vector_type(8)));
typedef float f32x4 __attribute__((ext_vector_type(4)));
typedef float f32x2 __attribute__((ext_vector_type(2)));
typedef unsigned u32x4 __attribute__((ext_vector_type(4)));
typedef unsigned u32x2 __attribute__((ext_vector_type(2)));

constexpr int D = 1024, NB = 4, SEQ = 4096, M = NB * SEQ;
constexpr int MEML = 256, MROWS = NB * MEML;
constexpr int LRU_W = 512, RW = 512, NH = 8, HD = 64;
constexpr int INW = 2816;
constexpr int XH = 4, XHD = 256;
constexpr int NE = 32, TOPK = 4, DFF = 1024;
constexpr int NASSIGN = M * TOPK;
constexpr int MAXTILES = 288, MAXROWS = MAXTILES * 256;
constexpr float EPS = 1e-6f, GN_EPS = 64e-5f;

DI int fresh_tid() { int t = threadIdx.x; asm volatile("" : "+v"(t)); return t; }
namespace pg8 {
constexpr int BM = 256, BK = 64, HALF = 128, HTB = HALF * BK * 2, STAGE_BYTES = 8 * HTB, NXCD = 8, WGM = 8;
__host__ __device__ __forceinline__ int lds_byte(int r, int c) { const int st = (r >> 4) * 2 + (c >> 5), rr = r & 15, cc = c & 31, ob = rr * 64 + cc * 2; return st * 1024 + (ob ^ (((ob >> 9) & 1) << 5)); }
__host__ __device__ __forceinline__ void stage_rc(int b, int& R, int& C) { const int st = b / 1024, sb = b % 1024, swz = sb ^ (((sb >> 9) & 1) << 5); R = (st >> 1) * 16 + swz / 64; C = (st & 1) * 32 + (swz % 64) / 2; }
__host__ __device__ __forceinline__ int perm32(int rho) { const int n = rho >> 4, i = rho & 15; return 8 * (i >> 2) + 4 * n + (i & 3); }

struct Unit { int pm, pn, e; };

struct StaticOrder {
    int nM, nN, nwg, G, c;
    __host__ __device__ void init_tiles(int nM_, int nN_, int G_, int c_) { nM = nM_; nN = nN_; nwg = nM * nN; G = G_; c = c_; }
    __host__ __device__ bool next(int i, Unit& u) const {
        const long L = (long)i * G + c; if (L >= nwg) return false;
        int wgid = (int)L; { const int q = nwg / NXCD, r = nwg % NXCD, xcd = wgid % NXCD, off = wgid / NXCD; wgid = (xcd < r ? xcd * (q + 1) : r * (q + 1) + (xcd - r) * q) + off; }
        const int nig = WGM * nN, gid = wgid / nig, fm = gid * WGM, gsz = (nM - fm) < WGM ? (nM - fm) : WGM;
        u.pm = fm + ((wgid % nig) % gsz); u.pn = (wgid % nig) / gsz; u.e = 0; return true;
    }
};
struct DenseSched {
    static constexpr bool GATHER = false, B_TILED = false;
    StaticOrder o; const char* A; const char* B; size_t tstep;
    DI bool next(int i, Unit& u) const { return o.next(i, u); }
    DI const char* a_ptr(const Unit& u) const { return A + (size_t)u.pm * tstep; }
    DI const char* b_ptr(const Unit& u) const { return B + (size_t)u.pn * tstep; }
    DI void a_voff(const Unit&, int K, const int (&R)[2], const int (&C)[2], unsigned (&vo)[2][2]) const {
#pragma unroll
        for (int h = 0; h < 2; ++h)
#pragma unroll
            for (int i = 0; i < 2; ++i) vo[h][i] = (unsigned)((h * HALF + R[i]) * K + C[i]) * 2u; }
};
struct MoeSched {
    static constexpr bool GATHER = false, B_TILED = true;
    StaticOrder o; const char* A; const char* B; const int* tile_e; size_t tstep, estep;
    DI bool next(int i, Unit& u) const { if (!o.next(i, u)) return false; u.e = tile_e[u.pm]; return true; }
    DI const char* a_ptr(const Unit& u) const { return A + (size_t)u.pm * tstep; }
    DI const char* b_ptr(const Unit& u) const { return B + (size_t)u.e * estep + (size_t)u.pn * tstep; }
    DI void a_voff(const Unit&, int K, const int (&R)[2], const int (&C)[2], unsigned (&vo)[2][2]) const {
#pragma unroll
        for (int h = 0; h < 2; ++h)
#pragma unroll
            for (int i = 0; i < 2; ++i) vo[h][i] = (unsigned)((h * HALF + R[i]) * K + C[i]) * 2u; }
};
struct MoeGatherSched {
    static constexpr bool GATHER = true, B_TILED = true;
    StaticOrder o; const char* A; const char* B; const int* tile_e; const int* rtok; size_t tstep, estep;
    DI bool next(int i, Unit& u) const { if (!o.next(i, u)) return false; u.e = tile_e[u.pm]; return true; }
    DI const char* a_ptr(const Unit&) const { return A; }
    DI const char* b_ptr(const Unit& u) const { return B + (size_t)u.e * estep + (size_t)u.pn * tstep; }
    DI void a_voff(const Unit& u, int K, const int (&R)[2], const int (&C)[2], unsigned (&vo)[2][2]) const {
#pragma unroll
        for (int h = 0; h < 2; ++h)
#pragma unroll
            for (int i = 0; i < 2; ++i) vo[h][i] = (unsigned)(rtok[u.pm * BM + h * HALF + R[i]] * K + C[i]) * 2u; }
};

struct BatchBSched {
    static constexpr bool GATHER = false, B_TILED = false;
    StaticOrder o; const char* A; const char* B; size_t tstep, bstep;
    DI bool next(int i, Unit& u) const { return o.next(i, u); }
    DI const char* a_ptr(const Unit& u) const { return A + (size_t)u.pm * tstep; }
    DI const char* b_ptr(const Unit& u) const { return B + (size_t)(u.pm >> 4) * bstep + (size_t)u.pn * tstep; }
    DI void a_voff(const Unit&, int K, const int (&R)[2], const int (&C)[2], unsigned (&vo)[2][2]) const {
#pragma unroll
        for (int h = 0; h < 2; ++h)
#pragma unroll
            for (int i = 0; i < 2; ++i) vo[h][i] = (unsigned)((h * HALF + R[i]) * K + C[i]) * 2u; }
};
template <int MODE> struct FoldSched {
    static constexpr bool GATHER = false, B_TILED = false;
    const char* A; const char* B; int G, c;
    DI bool next(int i, Unit& u) const { const int L = i * G + c; if (L >= 64) return false; u.pm = L >> 2; u.pn = L & 3; u.e = 0; return true; }
    DI const char* a_ptr(const Unit& u) const { const int b = u.pm >> 2, h = u.pm & 3; return A + ((size_t)(MODE == 0 ? b * 256 : u.pn * 256) * 1024 + h * 256) * 2; }
    DI const char* b_ptr(const Unit& u) const { const int b = u.pm >> 2, h = u.pm & 3; return B + ((size_t)(MODE == 0 ? u.pn * 256 : b * 256) * 1024 + h * 256) * 2; }
    DI void a_voff(const Unit&, int K, const int (&R)[2], const int (&C)[2], unsigned (&vo)[2][2]) const {
#pragma unroll
        for (int h = 0; h < 2; ++h)
#pragma unroll
            for (int i = 0; i < 2; ++i) vo[h][i] = (unsigned)((h * HALF + R[i]) * K + C[i]) * 2u; }
};

DI unsigned cvt_pk_bf16(float lo, float hi) { unsigned r; asm volatile("v_cvt_pk_bf16_f32 %0, %1, %2" : "=v"(r) : "v"(lo), "v"(hi)); return r; }

template <class Epi, class Sched, bool ALIGN_EPI = true>
DI void gemm_phase(LAS unsigned char* lds, const int K, const Sched& S, const Epi& E, const int ldp = 0) {
    const int ld = ldp ? ldp : K;
    const int tid = fresh_tid(), wid = __builtin_amdgcn_readfirstlane(tid >> 6), lane = tid & 63, wr = wid >> 2, wc = wid & 3, fr = lane & 15, fq = lane >> 4;
    const int nt = K / BK;
    constexpr bool GA = Sched::GATHER, BT = Sched::B_TILED;
    unsigned voffA[2][2], voffAn[2][2], voffB[2]; int sR[2], sC[2];
#pragma unroll
    for (int i = 0; i < 2; ++i) { int R, C; stage_rc(tid * 16 + i * 8192, R, C); const int Rb = Epi::PERM ? ((R & ~31) + perm32(R & 31)) : R;
        sR[i] = R; sC[i] = C; voffB[i] = BT ? (unsigned)(tid * 16 + i * 8192) : (unsigned)(Rb * ld + C) * 2u; }
    const size_t kstep = (size_t)(BK * 2);
    const size_t hstep = (size_t)HALF * ld * 2;
    const size_t kstepB = BT ? (size_t)(2 * HTB) : kstep, hstepB = BT ? (size_t)HTB : hstep;
    const unsigned ldsw = (unsigned)wid * 1024u;
    const int aoff = lds_byte(wr * 64 + fr, fq * 8), boff = lds_byte(wc * 32 + fr, fq * 8);
#define PG8_SA(b, h) (((b) * 2 + (h)) * HTB)
#define PG8_SB(b, h) ((4 + (b) * 2 + (h)) * HTB)
#define PG8_STAGE(bufoff, gbase, voff) do { _Pragma("unroll") for (int _i = 0; _i < 2; ++_i) \
        __builtin_amdgcn_global_load_lds((const unsigned*)((const char*)(gbase) + (voff)[_i]), (LAS unsigned*)(lds + (bufoff) + ldsw + _i * 8192), 16, 0, 0); } while (0)
#define PG8_LDA(dst, b, h) do { _Pragma("unroll") for (int m = 0; m < 4; ++m) _Pragma("unroll") for (int k = 0; k < 2; ++k) dst[m][k] = *(const LAS bf16x8*)(lds + PG8_SA(b, h) + aoff + m * 2048 + k * 1024); } while (0)
#define PG8_LDB(dst, b, h) do { _Pragma("unroll") for (int n = 0; n < 2; ++n) _Pragma("unroll") for (int k = 0; k < 2; ++k) dst[n][k] = *(const LAS bf16x8*)(lds + PG8_SB(b, h) + boff + n * 2048 + k * 1024); } while (0)
#define PG8_MMA(ai, bj, At, Bt) do { __builtin_amdgcn_s_setprio(1); _Pragma("unroll") for (int m = 0; m < 4; ++m) _Pragma("unroll") for (int n = 0; n < 2; ++n) _Pragma("unroll") for (int k = 0; k < 2; ++k) \
        acc[ai][bj][m][n] = __builtin_amdgcn_mfma_f32_16x16x32_bf16(Bt[n][k], At[m][k], acc[ai][bj][m][n], 0, 0, 0); __builtin_amdgcn_s_setprio(0); } while (0)
#define PG8_WAIT_V(n) asm volatile("s_waitcnt vmcnt(" #n ")" ::: "memory")
#define PG8_WAIT_L(n) asm volatile("s_waitcnt lgkmcnt(" #n ")" ::: "memory")
#define PG8_BAR __builtin_amdgcn_s_barrier()
#define PG8_SCHED __builtin_amdgcn_sched_barrier(0)
    Unit cur, nxt; int ui = 0;
    if (!S.next(0, cur)) return;
    f32x4 acc[2][2][4][2];
#pragma unroll
    for (int a = 0; a < 2; ++a)
#pragma unroll
        for (int b = 0; b < 2; ++b)
#pragma unroll
            for (int m = 0; m < 4; ++m)
#pragma unroll
                for (int n = 0; n < 2; ++n) acc[a][b][m][n] = (f32x4){0.f, 0.f, 0.f, 0.f};
    bf16x8 At[4][2], B0[2][2], B1[2][2];
    const char* cA = S.a_ptr(cur); const char* cB = S.b_ptr(cur);
    S.a_voff(cur, ld, sR, sC, voffA);
#define PG8_STAGE_A(bufoff, kbase, h, vo) do { if constexpr (GA) { PG8_STAGE(bufoff, kbase, (vo)[h]); } else { PG8_STAGE(bufoff, (kbase) + (h) * hstep, voffA[0]); } } while (0)
    PG8_STAGE(PG8_SB(0, 0), cB, voffB); PG8_STAGE(PG8_SB(0, 1), cB + hstepB, voffB); PG8_STAGE_A(PG8_SA(0, 0), cA, 0, voffA); PG8_STAGE_A(PG8_SA(0, 1), cA, 1, voffA);
    if (wr == 1) PG8_BAR;
    PG8_WAIT_V(2); PG8_BAR;
    PG8_STAGE(PG8_SB(1, 0), cB + kstepB, voffB); PG8_STAGE_A(PG8_SA(1, 0), cA + kstep, 0, voffA); PG8_STAGE(PG8_SB(1, 1), cB + hstepB + kstepB, voffB);
    PG8_WAIT_V(6); PG8_BAR;
    for (;;) {
        const bool has_next = S.next(ui + 1, nxt);
        const char* nA = has_next ? S.a_ptr(nxt) : cA; const char* nB = has_next ? S.b_ptr(nxt) : cB;
        if constexpr (GA) { if (has_next) S.a_voff(nxt, ld, sR, sC, voffAn);
            else {
#pragma unroll
                for (int h = 0; h < 2; ++h)
#pragma unroll
                    for (int i = 0; i < 2; ++i) voffAn[h][i] = voffA[h][i]; } }
#pragma unroll 1
        for (int t = 0; t < nt; t += 2) {
            const bool last = (t == nt - 2);
            const char* a1 = cA + (size_t)(t + 1) * kstep;
            const char* a2 = last ? nA : cA + (size_t)(t + 2) * kstep; const char* b2 = last ? nB : cB + (size_t)(t + 2) * kstepB;
            const char* a3 = a2 + kstep; const char* b3 = b2 + kstepB;
            unsigned vs[2][2];
            if constexpr (GA) {
#pragma unroll
                for (int i = 0; i < 2; ++i) { vs[0][i] = last ? voffAn[0][i] : voffA[0][i]; vs[1][i] = last ? voffAn[1][i] : voffA[1][i]; } }
            PG8_LDB(B0, 0, 0); PG8_LDB(B1, 0, 1); PG8_SCHED; PG8_LDA(At, 0, 0); PG8_STAGE_A(PG8_SA(1, 1), a1, 1, voffA);
            PG8_WAIT_V(8); PG8_WAIT_L(0); PG8_BAR; PG8_MMA(0, 0, At, B0); PG8_MMA(0, 1, At, B1); PG8_BAR; PG8_SCHED;
            PG8_LDA(At, 0, 1); PG8_STAGE(PG8_SB(0, 0), b2, voffB); PG8_STAGE(PG8_SB(0, 1), b2 + hstepB, voffB); PG8_STAGE_A(PG8_SA(0, 0), a2, 0, vs);
            PG8_WAIT_V(8); PG8_WAIT_L(0); PG8_BAR; PG8_MMA(1, 0, At, B0); PG8_MMA(1, 1, At, B1); PG8_BAR; PG8_SCHED;
            PG8_LDB(B0, 1, 0); PG8_LDB(B1, 1, 1); PG8_SCHED; PG8_LDA(At, 1, 0); PG8_STAGE_A(PG8_SA(0, 1), a2, 1, vs);
            PG8_WAIT_V(8); PG8_WAIT_L(0); PG8_BAR; PG8_MMA(0, 0, At, B0); PG8_MMA(0, 1, At, B1); PG8_BAR; PG8_SCHED;
            PG8_LDA(At, 1, 1); PG8_STAGE(PG8_SB(1, 0), b3, voffB); PG8_STAGE(PG8_SB(1, 1), b3 + hstepB, voffB); PG8_STAGE_A(PG8_SA(1, 0), a3, 0, vs);
            PG8_WAIT_V(8); PG8_WAIT_L(0); PG8_BAR; PG8_MMA(1, 0, At, B0); PG8_MMA(1, 1, At, B1); PG8_BAR; PG8_SCHED;
        }
        if constexpr (ALIGN_EPI) { if (wr == 0) PG8_BAR; }
        E(acc, cur, wr, wc, fr, fq);
        if (!has_next) break;
#pragma unroll
        for (int a = 0; a < 2; ++a)
#pragma unroll
            for (int b = 0; b < 2; ++b)
#pragma unroll
                for (int m = 0; m < 4; ++m)
#pragma unroll
                    for (int n = 0; n < 2; ++n) acc[a][b][m][n] = (f32x4){0.f, 0.f, 0.f, 0.f};
        cur = nxt; cA = nA; cB = nB; ++ui;
        if constexpr (GA) {
#pragma unroll
            for (int h = 0; h < 2; ++h)
#pragma unroll
                for (int i = 0; i < 2; ++i) voffA[h][i] = voffAn[h][i]; }
        if constexpr (ALIGN_EPI) { if (wr == 1) PG8_BAR; }
    }
    PG8_WAIT_V(0);
    if constexpr (!ALIGN_EPI) { if (wr == 0) PG8_BAR; }
    PG8_BAR;
#undef PG8_SA
#undef PG8_SB
#undef PG8_STAGE
#undef PG8_STAGE_A
#undef PG8_LDA
#undef PG8_LDB
#undef PG8_MMA
#undef PG8_WAIT_V
#undef PG8_WAIT_L
#undef PG8_BAR
#undef PG8_SCHED
}
}
using pg8::Unit;
using pg8::cvt_pk_bf16;

DI float bflo(unsigned w) { return __uint_as_float(w << 16); }
DI float bfhi(unsigned w) { return __uint_as_float(w & 0xffff0000u); }
DI float bf2f(bf16 b) { return __uint_as_float(((unsigned)b) << 16); }
typedef __bf16 hwbf2 __attribute__((ext_vector_type(2)));
DI unsigned pk2(float lo, float hi) { const f32x2 v = {lo, hi}; return __builtin_bit_cast(unsigned, __builtin_convertvector(v, hwbf2)); }
DI unsigned f2bf(float f) { return pk2(f, 0.f) & 0xffffu; }
DI float rcp_f(float x) { return __builtin_amdgcn_rcpf(x); }
DI float rsq_f(float x) { return __builtin_amdgcn_rsqf(x); }
DI float sigmoid_f(float x) { return rcp_f(1.0f + __expf(-x)); }
DI float tanh_fast(float x) { return 1.0f - 2.0f * rcp_f(__expf(2.0f * x) + 1.0f); }
DI float softplus_f(float x) { return fmaxf(x, 0.f) + __logf(1.0f + __expf(-fabsf(x))); }
DI float softplus_fast(float x) { return fmaxf(x, 0.f) + __logf(1.0f + __expf(-fabsf(x))); }
DI float gelu_tanh_f(float x) { const float u = 0.7978845608028654f * (x + 0.044715f * x * x * x); return 0.5f * x * (1.0f + tanh_fast(u)); }
DI float wave_sum(float v) {
#pragma unroll
    for (int o = 1; o < 64; o <<= 1) v += __shfl_xor(v, o);
    return v;
}

struct EpiBf16Plain {
    static constexpr bool PERM = true;
    bf16* O; int ldc; float scale;
    DI void operator()(const f32x4 (&acc)[2][2][4][2], const Unit& u, int wr, int wc, int fr, int fq) const {
        const int row0 = u.pm * 256 + wr * 64 + fr, col0 = u.pn * 256 + wc * 32 + 8 * fq;
#pragma unroll
        for (int ai = 0; ai < 2; ++ai)
#pragma unroll
            for (int m = 0; m < 4; ++m) { bf16* rowp = O + (size_t)(row0 + ai * 128 + m * 16) * ldc + col0;
#pragma unroll
                for (int bj = 0; bj < 2; ++bj) { const f32x4 v0 = acc[ai][bj][m][0] * scale, v1 = acc[ai][bj][m][1] * scale;
                    u32x4 w; w.x = cvt_pk_bf16(v0[0], v0[1]); w.y = cvt_pk_bf16(v0[2], v0[3]); w.z = cvt_pk_bf16(v1[0], v1[1]); w.w = cvt_pk_bf16(v1[2], v1[3]);
                    *(u32x4*)(rowp + bj * 128) = w; } }
    }
};
template <int MODE> struct EpiFold {
    static constexpr bool PERM = true;
    bf16* O;
    DI void operator()(const f32x4 (&acc)[2][2][4][2], const Unit& u, int wr, int wc, int fr, int fq) const {
        const int b = u.pm >> 2, h = u.pm & 3;
        const int rbase = MODE == 0 ? h * 256 : u.pn * 256, cbase = MODE == 0 ? u.pn * 256 : h * 256;
        const unsigned boff = (unsigned)b * 1024u * 1024u + (unsigned)(rbase + wr * 64 + fr) * 1024u + (unsigned)(cbase + wc * 32 + 8 * fq);
#pragma unroll
        for (int ai = 0; ai < 2; ++ai)
#pragma unroll
            for (int m = 0; m < 4; ++m) { bf16* rowp = O + (boff + (unsigned)(ai * 128 + m * 16) * 1024u);
#pragma unroll
                for (int bj = 0; bj < 2; ++bj) { const f32x4 v0 = acc[ai][bj][m][0], v1 = acc[ai][bj][m][1];
                    u32x4 w; w.x = cvt_pk_bf16(v0[0], v0[1]); w.y = cvt_pk_bf16(v0[2], v0[3]); w.z = cvt_pk_bf16(v1[0], v1[1]); w.w = cvt_pk_bf16(v1[2], v1[3]);
                    *(u32x4*)(rowp + bj * 128) = w; } }
    }
};
struct EpiSoftmax {
    static constexpr bool PERM = true;
    bf16* O; float scale; const float* RS; LAS float* XM; LAS float* XS;
    DI void operator()(const f32x4 (&acc)[2][2][4][2], const Unit& u, int wr, int wc, int fr, int fq) const {
        const int row0 = u.pm * 256 + wr * 64 + fr, col0 = u.pn * 256 + wc * 32 + 8 * fq;
        float sc[2][4];
#pragma unroll
        for (int ai = 0; ai < 2; ++ai)
#pragma unroll
            for (int m = 0; m < 4; ++m) { const int r = row0 + ai * 128 + m * 16; const f32x4* rp = (const f32x4*)(RS + (size_t)r * 16);
                const f32x4 p0 = rp[0], p1 = rp[1], p2 = rp[2], p3 = rp[3];
                const float ss = ((p0[0] + p0[1]) + (p0[2] + p0[3])) + ((p1[0] + p1[1]) + (p1[2] + p1[3])) + ((p2[0] + p2[1]) + (p2[2] + p2[3])) + ((p3[0] + p3[1]) + (p3[2] + p3[3]));
                sc[ai][m] = scale * __builtin_amdgcn_rsqf(ss * (1.0f / 1024.0f) + 1e-6f);
                float mm = -3.0e38f;
#pragma unroll
                for (int bj = 0; bj < 2; ++bj)
#pragma unroll
                    for (int n = 0; n < 2; ++n) { const f32x4 v = acc[ai][bj][m][n]; mm = fmaxf(mm, fmaxf(fmaxf(v[0], v[1]), fmaxf(v[2], v[3]))); }
                mm *= sc[ai][m];
                mm = fmaxf(mm, __shfl_xor(mm, 16)); mm = fmaxf(mm, __shfl_xor(mm, 32));
                if (fq == 0) XM[(ai * 128 + wr * 64 + m * 16 + fr) * 4 + wc] = mm; }
        asm volatile("s_waitcnt lgkmcnt(0)" ::: "memory"); __builtin_amdgcn_s_barrier(); asm volatile("" ::: "memory");
        f32x4 (&pa)[2][2][4][2] = const_cast<f32x4 (&)[2][2][4][2]>(acc);
#pragma unroll
        for (int ai = 0; ai < 2; ++ai)
#pragma unroll
            for (int m = 0; m < 4; ++m) { const int lr = ai * 128 + wr * 64 + m * 16 + fr; const f32x4 q = *(const LAS f32x4*)(XM + lr * 4);
                const float mxr = fmaxf(fmaxf(q[0], q[1]), fmaxf(q[2], q[3])); float sm = 0.f;
#pragma unroll
                for (int bj = 0; bj < 2; ++bj)
#pragma unroll
                    for (int n = 0; n < 2; ++n)
#pragma unroll
                        for (int j = 0; j < 4; ++j) { const float p = __expf(acc[ai][bj][m][n][j] * sc[ai][m] - mxr); pa[ai][bj][m][n][j] = p; sm += p; }
                sm += __shfl_xor(sm, 16); sm += __shfl_xor(sm, 32);
                if (fq == 0) XS[lr * 4 + wc] = sm; }
        asm volatile("s_waitcnt lgkmcnt(0)" ::: "memory"); __builtin_amdgcn_s_barrier(); asm volatile("" ::: "memory");
#pragma unroll
        for (int ai = 0; ai < 2; ++ai)
#pragma unroll
            for (int m = 0; m < 4; ++m) { const int lr = ai * 128 + wr * 64 + m * 16 + fr; const f32x4 q = *(const LAS f32x4*)(XS + lr * 4);
                const float inv = __builtin_amdgcn_rcpf((q[0] + q[1]) + (q[2] + q[3]));
                bf16* rowp = O + (size_t)(row0 + ai * 128 + m * 16) * 1024 + col0;
#pragma unroll
                for (int bj = 0; bj < 2; ++bj) { const f32x4 v0 = pa[ai][bj][m][0] * inv, v1 = pa[ai][bj][m][1] * inv;
                    u32x4 w; w.x = cvt_pk_bf16(v0[0], v0[1]); w.y = cvt_pk_bf16(v0[2], v0[3]); w.z = cvt_pk_bf16(v1[0], v1[1]); w.w = cvt_pk_bf16(v1[2], v1[3]);
                    *(u32x4*)(rowp + bj * 128) = w; } }
        asm volatile("s_waitcnt lgkmcnt(0)" ::: "memory"); __builtin_amdgcn_s_barrier(); asm volatile("" ::: "memory");
    }
};
struct EpiBf16RowNorm {
    static constexpr bool PERM = true;
    bf16* O; int ldc; float scale; const float* RS;
    DI void operator()(const f32x4 (&acc)[2][2][4][2], const Unit& u, int wr, int wc, int fr, int fq) const {
        const int row0 = u.pm * 256 + wr * 64 + fr, col0 = u.pn * 256 + wc * 32 + 8 * fq;
#pragma unroll
        for (int ai = 0; ai < 2; ++ai)
#pragma unroll
            for (int m = 0; m < 4; ++m) { const int r = row0 + ai * 128 + m * 16; const f32x4* rp = (const f32x4*)(RS + (size_t)r * 16);
                const f32x4 p0 = rp[0], p1 = rp[1], p2 = rp[2], p3 = rp[3];
                const float ss = ((p0[0] + p0[1]) + (p0[2] + p0[3])) + ((p1[0] + p1[1]) + (p1[2] + p1[3])) + ((p2[0] + p2[1]) + (p2[2] + p2[3])) + ((p3[0] + p3[1]) + (p3[2] + p3[3]));
                const float sc = scale * __builtin_amdgcn_rsqf(ss * (1.0f / 1024.0f) + 1e-6f);
                bf16* rowp = O + (size_t)r * ldc + col0;
#pragma unroll
                for (int bj = 0; bj < 2; ++bj) { const f32x4 v0 = acc[ai][bj][m][0] * sc, v1 = acc[ai][bj][m][1] * sc;
                    u32x4 w; w.x = cvt_pk_bf16(v0[0], v0[1]); w.y = cvt_pk_bf16(v0[2], v0[3]); w.z = cvt_pk_bf16(v1[0], v1[1]); w.w = cvt_pk_bf16(v1[2], v1[3]);
                    *(u32x4*)(rowp + bj * 128) = w; } }
    }
};
template <bool RES_BF16> struct EpiBf16Res {
    static constexpr bool PERM = true;
    const void* Rz; bf16* O; int ldc; float* RS;
    DI void operator()(const f32x4 (&acc)[2][2][4][2], const Unit& u, int wr, int wc, int fr, int fq) const {
        const int row0 = u.pm * 256 + wr * 64 + fr, col0 = u.pn * 256 + wc * 32 + 8 * fq;
#pragma unroll
        for (int ai = 0; ai < 2; ++ai)
#pragma unroll
            for (int m = 0; m < 4; ++m) { const size_t off = (size_t)(row0 + ai * 128 + m * 16) * ldc + col0; float ssq = 0.f;
#pragma unroll
                for (int bj = 0; bj < 2; ++bj) { f32x4 r0, r1;
                    if (RES_BF16) { const u32x4 rw = *(const u32x4*)((const bf16*)Rz + off + bj * 128); r0 = (f32x4){bflo(rw.x), bfhi(rw.x), bflo(rw.y), bfhi(rw.y)}; r1 = (f32x4){bflo(rw.z), bfhi(rw.z), bflo(rw.w), bfhi(rw.w)}; }
                    else { r0 = *(const f32x4*)((const float*)Rz + off + bj * 128); r1 = *(const f32x4*)((const float*)Rz + off + bj * 128 + 4); }
                    const f32x4 v0 = r0 + acc[ai][bj][m][0], v1 = r1 + acc[ai][bj][m][1];
                    ssq += (v0[0] * v0[0] + v0[1] * v0[1]) + (v0[2] * v0[2] + v0[3] * v0[3]) + (v1[0] * v1[0] + v1[1] * v1[1]) + (v1[2] * v1[2] + v1[3] * v1[3]);
                    u32x4 w; w.x = cvt_pk_bf16(v0[0], v0[1]); w.y = cvt_pk_bf16(v0[2], v0[3]); w.z = cvt_pk_bf16(v1[0], v1[1]); w.w = cvt_pk_bf16(v1[2], v1[3]);
                    *(u32x4*)(O + off + bj * 128) = w; }
                if (RS) { ssq += __shfl_xor(ssq, 16); ssq += __shfl_xor(ssq, 32); if (fq == 0) RS[(size_t)(row0 + ai * 128 + m * 16) * 16 + u.pn * 4 + wc] = ssq; } }
    }
};
struct EpiLora {
    static constexpr bool PERM = false;
    float* LWp; bf16* AAp; bf16* GGp; const float* w0; const float* a0;
    DI void operator()(const f32x4 (&acc)[2][2][4][2], const Unit& u, int wr, int wc, int fr, int fq) const {
        const int kind = u.pn >> 1;
        const int row0 = u.pm * 256 + wr * 64 + fr, col0 = (u.pn & 1) * 256 + wc * 32 + 4 * fq;
#pragma unroll
        for (int bj = 0; bj < 2; ++bj)
#pragma unroll
            for (int n = 0; n < 2; ++n) {
                const int c = col0 + bj * 128 + n * 16;
                f32x4 bias = (f32x4){0.f, 0.f, 0.f, 0.f};
                if (kind == 0) bias = *(const f32x4*)(w0 + c); else if (kind == 1) bias = *(const f32x4*)(a0 + c);
#pragma unroll
                for (int ai = 0; ai < 2; ++ai)
#pragma unroll
                    for (int m = 0; m < 4; ++m) {
                        f32x4 v = acc[ai][bj][m][n] + bias;
                        if (kind == 0) {
#pragma unroll
                            for (int j = 0; j < 4; ++j) { const float w = -softplus_fast(-v[j]) - 0.5f; v[j] = -__expf(w);     }
                        } else if (kind == 1) {
#pragma unroll
                            for (int j = 0; j < 4; ++j) v[j] = sigmoid_f(v[j]);
                        }
                        const size_t o_ = (size_t)(row0 + ai * 128 + m * 16) * 512 + c;
                        if (kind == 0) *(f32x4*)(LWp + o_) = v;
                        else { u32x2 w_; w_.x = cvt_pk_bf16(v[0], v[1]); w_.y = cvt_pk_bf16(v[2], v[3]); *(u32x2*)((kind == 1 ? AAp : GGp) + o_) = w_; }
                    }
            }
    }
};
struct EpiSwiglu {
    static constexpr bool PERM = true;
    bf16* ACT; const float* b_gu;
    DI void operator()(const f32x4 (&acc)[2][2][4][2], const Unit& u, int wr, int wc, int fr, int fq) const {
        const int row0 = u.pm * 256 + wr * 64 + fr, j0 = u.pn * 128 + wc * 32 + 8 * fq;
        const float* bg = b_gu + (size_t)u.e * 2048 + j0; const float* bu = bg + 1024;
        const f32x4 bg0 = *(const f32x4*)bg, bg1 = *(const f32x4*)(bg + 4), bu0 = *(const f32x4*)bu, bu1 = *(const f32x4*)(bu + 4);
#pragma unroll
        for (int ai = 0; ai < 2; ++ai)
#pragma unroll
            for (int m = 0; m < 4; ++m) {
                float o[8];
#pragma unroll
                for (int n = 0; n < 2; ++n) { const f32x4 g4 = acc[ai][0][m][n] + (n ? bg1 : bg0), u4 = acc[ai][1][m][n] + (n ? bu1 : bu0);
#pragma unroll
                    for (int j = 0; j < 4; ++j) { const float g = fminf(g4[j], 7.0f), up = fminf(fmaxf(u4[j], -7.0f), 7.0f); o[n * 4 + j] = (up + 1.0f) * (g * sigmoid_f(1.702f * g)); } }
                u32x4 w; w.x = cvt_pk_bf16(o[0], o[1]); w.y = cvt_pk_bf16(o[2], o[3]); w.z = cvt_pk_bf16(o[4], o[5]); w.w = cvt_pk_bf16(o[6], o[7]);
                *(u32x4*)(ACT + (size_t)(row0 + ai * 128 + m * 16) * 1024 + j0) = w;
            }
    }
};
struct EpiDown {
    static constexpr bool PERM = true;
    bf16* YS; const float* b_dn; const int* row_slot; const float* row_gate;
    DI void operator()(const f32x4 (&acc)[2][2][4][2], const Unit& u, int wr, int wc, int fr, int fq) const {
        const int row0 = u.pm * 256 + wr * 64 + fr, col0 = u.pn * 256 + wc * 32 + 8 * fq;
        const float* bb = b_dn + (size_t)u.e * 1024 + col0;
        f32x4 bv[2][2];
#pragma unroll
        for (int bj = 0; bj < 2; ++bj)
#pragma unroll
            for (int n = 0; n < 2; ++n) bv[bj][n] = *(const f32x4*)(bb + bj * 128 + 4 * n);
#pragma unroll
        for (int ai = 0; ai < 2; ++ai)
#pragma unroll
            for (int m = 0; m < 4; ++m) {
                const int r = row0 + ai * 128 + m * 16; const int slot = row_slot[r]; const float gt = row_gate[r];
                if (slot >= 0) { bf16* rowp = YS + (size_t)slot * 1024 + col0;
#pragma unroll
                    for (int bj = 0; bj < 2; ++bj) { const f32x4 v0 = (acc[ai][bj][m][0] + bv[bj][0]) * gt, v1 = (acc[ai][bj][m][1] + bv[bj][1]) * gt;
                        u32x4 w; w.x = cvt_pk_bf16(v0[0], v0[1]); w.y = cvt_pk_bf16(v0[2], v0[3]); w.z = cvt_pk_bf16(v1[0], v1[1]); w.w = cvt_pk_bf16(v1[2], v1[3]);
                        *(u32x4*)(rowp + bj * 128) = w; } }
            }
    }
};

constexpr size_t MiB = 1u << 20;
constexpr size_t WS_CTL = 0, CTL_ZERO_BYTES = 1 * MiB;
constexpr size_t WS_WIN = 1 * MiB, WS_WOUT = 7 * MiB, WS_WQ = 9 * MiB, WS_WK = 11 * MiB, WS_WV = 13 * MiB, WS_WO = 15 * MiB, WS_LORAB = 17 * MiB, WS_LRUW = 18 * MiB;
constexpr size_t WS_ROUTE = 19 * MiB;
constexpr size_t WS_WGU = 22 * MiB, WS_WDN = 150 * MiB;
constexpr size_t WS_HN = 214 * MiB, WS_MEMN = 246 * MiB, WS_KM = 248 * MiB, WS_VT = 250 * MiB;
constexpr size_t WS_X1 = 252 * MiB, WS_X2 = 316 * MiB;
constexpr size_t WS_U = 380 * MiB, WS_R = 468 * MiB, WS_KRAW = 500 * MiB, WS_V = 532 * MiB, WS_KKN = 564 * MiB, WS_WD = 596 * MiB, WS_AA = 628 * MiB, WS_G = 660 * MiB;
constexpr size_t WS_LA = 692 * MiB, WS_LB = 724 * MiB, WS_AP = 756 * MiB, WS_CAT = 764 * MiB, WS_Q = 796 * MiB;
constexpr size_t WS_XS = 380 * MiB, WS_ACT = 524 * MiB, WS_YS = 668 * MiB;
constexpr size_t WS_GP = 796 * MiB, WS_HF = 860 * MiB, WS_RP = 924 * MiB, WS_Y1F = 940 * MiB, WS_ADD = 972 * MiB, WS_END = 1004 * MiB;
constexpr size_t WS_GC = 468 * MiB, WS_HC = 484 * MiB, WS_ZS = 500 * MiB;
static_assert(WS_AA == WS_WD + 32 * MiB && WS_G == WS_AA + 32 * MiB, "EpiLora strides");
static_assert(WS_U + (size_t)M * INW * 2 <= WS_R && WS_XS + (size_t)MAXROWS * 2048 <= WS_ACT && WS_ACT + (size_t)MAXROWS * 2048 <= WS_YS && WS_YS + (size_t)NASSIGN * 2048 <= WS_Q, "ws map");
constexpr size_t RT_E = 0, RT_POS = 256 * 1024, RT_G = 512 * 1024, RT_SLOT = 768 * 1024, RT_GATE = 1088 * 1024, RT_TILE = 1408 * 1024, RT_TOK = 1472 * 1024;
constexpr int CW_BAR = 4096, CW_CNT = 8192;

constexpr int RING_BYTES = 131072, MISC_OFF = RING_BYTES + 320, LDS_BYTES = 147456;
constexpr int NWAVES = 8, NTHREADS = 512;

#define XB_TMO      128
#define XB_XCNT(j)  (256  + 64 * (j))
#define XB_XSUB(j)  (1280 + 64 * (j))
#define XB_XGEN(j)  (2304 + 64 * (j))
#define XB_TOP      3328
#define XB_TOPGEN   3392
#define XCD_BAR_WORDS 3456
#define XB_SPIN_CAP (1u << 18)
DI unsigned xb_ld(unsigned* p)              { return __hip_atomic_load(p, __ATOMIC_RELAXED, __HIP_MEMORY_SCOPE_AGENT); }
DI unsigned xb_add(unsigned* p, unsigned v) { return __hip_atomic_fetch_add(p, v, __ATOMIC_RELAXED, __HIP_MEMORY_SCOPE_AGENT); }
DI unsigned xb_xcc_id() { return (unsigned)__builtin_amdgcn_s_getreg((3 << 11) | 20) & 0xFu; }
#define XB_SPIN(cond, bar) do { unsigned _sp = 0; while (cond) { __builtin_amdgcn_s_sleep(1); \
    if ((++_sp & 255u) == 0u) { if (xb_ld(&(bar)[XB_TMO])) break; if (_sp > XB_SPIN_CAP) { atomicAdd(&(bar)[XB_TMO], 1u); break; } } } } while (0)
struct XcdBarrier { unsigned* bar; unsigned x; volatile LAS unsigned* st; };
DI XcdBarrier xcd_barrier_post(unsigned* bar, volatile LAS unsigned* st) {
    XcdBarrier b; b.bar = bar; b.x = xb_xcc_id(); b.st = st;
    if (threadIdx.x == 0) (void)xb_add(&bar[XB_XCNT(b.x)], 1u);
    return b;
}
DI void xcd_barrier_complete(unsigned* bar, unsigned x, unsigned& nloc, unsigned& nx) {
    const unsigned G = gridDim.x * gridDim.y * gridDim.z;
    unsigned sum, cnt, mine, sp = 0u;
    for (;;) {
        sum = 0u; cnt = 0u; mine = 0u;
#pragma unroll
        for (unsigned j = 0; j < 16; ++j) { const unsigned c = xb_ld(&bar[XB_XCNT(j)]); sum += c; cnt += (c > 0u) ? 1u : 0u; mine = (j == x) ? c : mine; }
        if (sum == G) break;
        __builtin_amdgcn_s_sleep(1);
        if ((++sp & 255u) == 0u) { if (xb_ld(&bar[XB_TMO])) break; if (sp > XB_SPIN_CAP) { atomicAdd(&bar[XB_TMO], 1u); break; } }
    }
    nloc = mine > 0u ? mine : 1u; nx = cnt > 0u ? cnt : 1u;
}
DI void xcd_barrier(const XcdBarrier& b) {
    asm volatile("s_waitcnt vmcnt(0)" ::: "memory");
    __syncthreads();
    if (threadIdx.x == 0) {
        unsigned* bar = b.bar;
        __builtin_amdgcn_s_waitcnt(0);
        unsigned nloc = b.st[0], nx = b.st[1];
        if (nloc == 0u) { xcd_barrier_complete(bar, b.x, nloc, nx); b.st[0] = nloc; b.st[1] = nx; }
        const unsigned old = xb_add(&bar[XB_XSUB(b.x)], 1u);
        const unsigned gen = old / nloc;
        if (old + 1u == (gen + 1u) * nloc) {
            __builtin_amdgcn_fence(__ATOMIC_RELEASE, "agent");
            asm volatile("s_waitcnt vmcnt(0)" ::: "memory");
            const unsigned og = xb_add(&bar[XB_TOP], 1u);
            const unsigned tg = og / nx;
            if (og + 1u == (tg + 1u) * nx) xb_add(&bar[XB_TOPGEN], 1u);
            else XB_SPIN(xb_ld(&bar[XB_TOPGEN]) == tg, bar);
            __builtin_amdgcn_fence(__ATOMIC_ACQUIRE, "agent");
            xb_add(&bar[XB_XGEN(b.x)], 1u);
            asm volatile("s_waitcnt vmcnt(0)" ::: "memory");
        } else {
            XB_SPIN(xb_ld(&bar[XB_XGEN(b.x)]) == gen, bar);
            __builtin_amdgcn_fence(__ATOMIC_ACQUIRE, "agent");
            asm volatile("s_waitcnt vmcnt(0)" ::: "memory");
        }
    }
    __syncthreads();
}

struct Args { const float* in[37]; float* out; unsigned char* ws; int ph_lo, ph_hi; };
enum { I_X = 0, I_MEM, I_NMIXG, I_WIN, I_CONVW, I_CONVB, I_LWX, I_LBX, I_LWA, I_LBA, I_LAM, I_MU, I_W0, I_WUP, I_A0, I_AUP, I_GUP, I_KK, I_KA, I_RK, I_LNG, I_LNB,
       I_WOUT, I_NXAG, I_NMEMG, I_WQ, I_WK, I_WV, I_WO, I_NFFG, I_WR, I_BR, I_WGU, I_BGU, I_WDN, I_BDN, I_FNG };

DI void transpose_item(const float* W, int ldw, int K, bf16* WT, int k0, int n0, int drow0, LAS float* scr, int lane, const float* rs = nullptr) {
    f32x4 t[8];
    const float* src = W + (size_t)(k0 + (lane >> 3)) * ldw + n0 + 4 * (lane & 7);
#pragma unroll
    for (int i = 0; i < 8; ++i) t[i] = *(const f32x4*)(src + (size_t)(8 * i) * ldw);
#pragma unroll
    for (int i = 0; i < 8; ++i) { const float sc_ = rs ? rs[k0 + 8 * i + (lane >> 3)] : 1.0f; LAS float* d = scr + (8 * i + (lane >> 3)) * 33 + 4 * (lane & 7); d[0] = t[i].x * sc_; d[1] = t[i].y * sc_; d[2] = t[i].z * sc_; d[3] = t[i].w * sc_; }
    asm volatile("s_waitcnt lgkmcnt(0)" ::: "memory");
    const int c = lane & 7;
#pragma unroll
    for (int j = 0; j < 4; ++j) { const int n = (lane >> 3) + 8 * j; const LAS float* s = scr + (8 * c) * 33 + n;
        u32x4 o; o.x = pk2(s[0 * 33], s[1 * 33]); o.y = pk2(s[2 * 33], s[3 * 33]); o.z = pk2(s[4 * 33], s[5 * 33]); o.w = pk2(s[6 * 33], s[7 * 33]);
        *(u32x4*)(WT + (size_t)(drow0 + n) * K + k0 + 8 * c) = o; }
    asm volatile("s_waitcnt lgkmcnt(0)" ::: "memory");
}
DI void transpose_item_tiled(const float* W, int ldw, int K, bf16* WTe, int k0, int n0, int drow0, LAS float* scr, int lane) {
    f32x4 t[8];
    const float* src = W + (size_t)(k0 + (lane >> 3)) * ldw + n0 + 4 * (lane & 7);
#pragma unroll
    for (int i = 0; i < 8; ++i) t[i] = *(const f32x4*)(src + (size_t)(8 * i) * ldw);
#pragma unroll
    for (int i = 0; i < 8; ++i) { LAS float* d = scr + (8 * i + (lane >> 3)) * 33 + 4 * (lane & 7); d[0] = t[i].x; d[1] = t[i].y; d[2] = t[i].z; d[3] = t[i].w; }
    asm volatile("s_waitcnt lgkmcnt(0)" ::: "memory");
    const int c = lane & 7;
#pragma unroll
    for (int j = 0; j < 4; ++j) { const int n = (lane >> 3) + 8 * j; const LAS float* s = scr + (8 * c) * 33 + n;
        u32x4 o; o.x = pk2(s[0 * 33], s[1 * 33]); o.y = pk2(s[2 * 33], s[3 * 33]); o.z = pk2(s[4 * 33], s[5 * 33]); o.w = pk2(s[6 * 33], s[7 * 33]);
        const int drow = drow0 + n, pn = drow >> 8, half = (drow >> 7) & 1, r = drow & 127, x = r & 31;
        const int rslot = (r & ~31) + 16 * ((x >> 2) & 1) + 4 * (x >> 3) + (x & 3);
        const size_t tb = ((size_t)(pn * (K / 64) + (k0 >> 6)) * 2 + half) * 16384 + pg8::lds_byte(rslot, 8 * c);
        *(u32x4*)((char*)WTe + tb) = o; }
    asm volatile("s_waitcnt lgkmcnt(0)" ::: "memory");
}
DI void rms_row_to_bf16(const float* xrow, const float* g, bf16* orow, int lane) {
    const f32x4* xr = (const f32x4*)xrow + lane; const f32x4* gr = (const f32x4*)g + lane;
    f32x4 v[4]; float s = 0.f;
#pragma unroll
    for (int j = 0; j < 4; ++j) { v[j] = xr[64 * j]; s += (v[j].x * v[j].x + v[j].y * v[j].y) + (v[j].z * v[j].z + v[j].w * v[j].w); }
    const float rstd = rsq_f(wave_sum(s) * (1.f / D) + EPS);
    u32x2* o8 = (u32x2*)orow + lane;
#pragma unroll
    for (int j = 0; j < 4; ++j) { const f32x4 gg = gr[64 * j]; u32x2 w; w.x = pk2(v[j].x * rstd * gg.x, v[j].y * rstd * gg.y); w.y = pk2(v[j].z * rstd * gg.z, v[j].w * rstd * gg.w); o8[64 * j] = w; }
}

DI void rms_rowbf_to_bf16(const bf16* xrow, const float* g, bf16* orow, int lane) {
    float v[16]; float s = 0.f;
#pragma unroll
    for (int hf = 0; hf < 2; ++hf) { const u32x4 w = *(const u32x4*)(xrow + 512 * hf + 8 * lane);
#pragma unroll
        for (int q = 0; q < 4; ++q) { v[8 * hf + 2 * q] = bflo(w[q]); v[8 * hf + 2 * q + 1] = bfhi(w[q]); } }
#pragma unroll
    for (int j = 0; j < 16; ++j) s += v[j] * v[j];
    const float rstd = rsq_f(wave_sum(s) * (1.f / D) + EPS);
#pragma unroll
    for (int hf = 0; hf < 2; ++hf) { const f32x4 g0 = *(const f32x4*)(g + 512 * hf + 8 * lane), g1 = *(const f32x4*)(g + 512 * hf + 8 * lane + 4);
        u32x4 w; w.x = pk2(v[8 * hf] * rstd * g0.x, v[8 * hf + 1] * rstd * g0.y); w.y = pk2(v[8 * hf + 2] * rstd * g0.z, v[8 * hf + 3] * rstd * g0.w);
        w.z = pk2(v[8 * hf + 4] * rstd * g1.x, v[8 * hf + 5] * rstd * g1.y); w.w = pk2(v[8 * hf + 6] * rstd * g1.z, v[8 * hf + 7] * rstd * g1.w);
        *(u32x4*)(orow + 512 * hf + 8 * lane) = w; }
}

__global__ void __launch_bounds__(NTHREADS, 2) fwd(Args args) {
    extern __shared__ __attribute__((aligned(16))) unsigned char lds_raw[];
    LAS unsigned char* lds = (LAS unsigned char*)lds_raw;
    volatile LAS unsigned* MISC = (volatile LAS unsigned*)(lds + MISC_OFF);
    const int G = gridDim.x, bid = blockIdx.x, NGW = G * NWAVES;
#define PHASE_IDS const int tid = fresh_tid(), lane = tid & 63, wave = __builtin_amdgcn_readfirstlane(tid >> 6), gw = bid * NWAVES + wave; (void)tid; (void)lane; (void)wave; (void)gw
    unsigned char* ws = args.ws;
    unsigned* ctl = (unsigned*)(ws + WS_CTL);
    const int lo = args.ph_lo, hi = args.ph_hi;

    for (int u = threadIdx.x; u < (LDS_BYTES - RING_BYTES) / 4; u += NTHREADS) ((LAS unsigned*)(lds + RING_BYTES))[u] = 0u;
    __syncthreads();
    XcdBarrier bar; bar.bar = ctl + CW_BAR; bar.x = 0; bar.st = nullptr;
    if (hi - lo > 1) bar = xcd_barrier_post(ctl + CW_BAR, MISC + 8);
#define IN(k) (lo <= (k) && (k) < hi)
#define SEAM(k) do { if (IN(k) && IN((k) + 1)) xcd_barrier(bar); } while (0)

#define Win_t ((bf16*)(ws + WS_WIN))
#define Wout_t ((bf16*)(ws + WS_WOUT))
#define Wq_t ((bf16*)(ws + WS_WQ))
#define Wk_t ((bf16*)(ws + WS_WK))
#define Wv_t ((bf16*)(ws + WS_WV))
#define Wo_t ((bf16*)(ws + WS_WO))
#define LoraB ((bf16*)(ws + WS_LORAB))
#define LruW ((bf16*)(ws + WS_LRUW))
#define WrT ((bf16*)(ws + WS_LRUW + 512 * 1024))
#define Wgu_t ((bf16*)(ws + WS_WGU))
#define Wdn_t ((bf16*)(ws + WS_WDN))
#define HN ((bf16*)(ws + WS_HN))
#define MEMN ((bf16*)(ws + WS_MEMN))
#define KM ((bf16*)(ws + WS_KM))
#define VT ((bf16*)(ws + WS_VT))
#define X1 ((bf16*)(ws + WS_X1))
#define X2 ((bf16*)(ws + WS_X2))
#define U ((bf16*)(ws + WS_U))
#define Rr ((float*)(ws + WS_R))
#define KRAW ((float*)(ws + WS_KRAW))
#define Vv ((float*)(ws + WS_V))
#define KKN ((float*)(ws + WS_KKN))
#define WD ((float*)(ws + WS_WD))
#define AA ((float*)(ws + WS_AA))
#define GG ((float*)(ws + WS_G))
#define LA ((bf16*)(ws + WS_LA))
#define LB ((bf16*)(ws + WS_LB))
#define AP ((bf16*)(ws + WS_AP))
#define CAT ((bf16*)(ws + WS_CAT))
#define Qb ((bf16*)(ws + WS_Q))
#define Ob CAT
#define XS ((bf16*)(ws + WS_XS))
#define ACT ((bf16*)(ws + WS_ACT))
#define YS ((bf16*)(ws + WS_YS))
#define route_e ((int*)(ws + WS_ROUTE + RT_E))
#define route_pos ((int*)(ws + WS_ROUTE + RT_POS))
#define route_g ((float*)(ws + WS_ROUTE + RT_G))
#define row_slot ((int*)(ws + WS_ROUTE + RT_SLOT))
#define row_gate ((float*)(ws + WS_ROUTE + RT_GATE))
#define tile_tab ((int*)(ws + WS_ROUTE + RT_TILE))
#define row_tok ((int*)(ws + WS_ROUTE + RT_TOK))
#define ecnt (ctl + CW_CNT)

    if (IN(0)) { PHASE_IDS;
        LAS float* scr = (LAS float*)(lds + wave * 16384);
        constexpr int I_IN = 16 * (INW / 32), I_SQ = 16 * 32;
        constexpr int N_ITEMS = I_IN + 5 * I_SQ;
        for (int it = gw; it < N_ITEMS; it += NGW) {
            int r = it;
            if (r < I_IN) { const int nblk = INW / 32, kb = r / nblk, nb = r % nblk; transpose_item(args.in[I_WIN], INW, D, Win_t, 64 * kb, 32 * nb, 32 * nb, scr, lane); continue; } r -= I_IN;
            { const int w = r / I_SQ, q = r % I_SQ, kb = q / 32, nb = q % 32;
                if (w == 1) continue;
                const float* src = w == 0 ? args.in[I_WOUT] : w == 2 ? args.in[I_WK] : w == 3 ? args.in[I_WV] : args.in[I_WO];
                bf16* dst = w == 0 ? Wout_t : w == 2 ? Wk_t : w == 3 ? Wv_t : Wo_t;
                transpose_item(src, D, D, dst, 64 * kb, 32 * nb, 32 * nb, scr, lane); }
        }
        for (int idx = bid * NTHREADS + tid; idx < D * D / 4; idx += G * NTHREADS) { const f32x4 v = ((const f32x4*)args.in[I_WQ])[idx]; const float gk = args.in[I_NXAG][idx >> 8];
            u32x2 w; w.x = pk2(v.x * gk, v.y * gk); w.y = pk2(v.z * gk, v.w * gk); ((u32x2*)Wq_t)[idx] = w; }
        for (int idx = bid * NTHREADS + tid; idx < 1536 * 256; idx += G * NTHREADS) {
            const int e = idx & 7, ln = (idx >> 3) & 63, ks = (idx >> 9) & 7, ct = (idx >> 12) & 3, hk = idx >> 14, hh = hk / 3, kind = hk - 3 * hh;
            const int k = 32 * ks + 8 * (ln >> 4) + e, n = hh * 64 + 16 * ct + (ln & 15); float v = 0.f;
            if (kind == 0) { if (k < 64) v = args.in[I_WUP][k * 512 + n]; }
            else if (kind == 1) { if (k >= 64 && k < 128) v = args.in[I_AUP][(k - 64) * 512 + n]; }
            else { if (k >= 128) v = args.in[I_GUP][(k - 128) * 512 + n]; }
            LoraB[idx] = (bf16)f2bf(v);
        }
        for (int idx = bid * NTHREADS + tid; idx < 8 * 128 * 64; idx += G * NTHREADS) {
            const int nb = idx >> 13, col = (idx >> 6) & 127, k = idx & 63;
            const float v = col < 64 ? args.in[I_LWX][nb * 4096 + k * 64 + col] : args.in[I_LWA][nb * 4096 + k * 64 + (col - 64)];
            LruW[idx] = (bf16)f2bf(v);
        }
        for (int idx = bid * NTHREADS + tid; idx < NE * D; idx += G * NTHREADS) {
            const int e = idx >> 10, k = idx & 1023; const float v = args.in[I_WR][k * NE + e];
            const unsigned hi = f2bf(v); const float lo = v - __uint_as_float(hi << 16);
            WrT[idx] = (bf16)hi; WrT[NE * D + idx] = (bf16)f2bf(lo);
        }
        for (int m = gw; m < M; m += NGW) rms_row_to_bf16(args.in[I_X] + (size_t)m * D, args.in[I_NMIXG], HN + (size_t)m * D, lane);
        for (int m = gw; m < MROWS; m += NGW) rms_row_to_bf16(args.in[I_MEM] + (size_t)m * D, args.in[I_NMEMG], MEMN + (size_t)m * D, lane);
        {
            LAS float* scr = (LAS float*)(lds + wave * 16384);
            constexpr int I_GU = 16 * 64, I_DN = 16 * 32;
            for (int it = gw; it < NE * (I_GU + I_DN); it += NGW) {
                int r = it;
                if (r < NE * I_GU) { const int e = r / I_GU, q = r % I_GU, kb = q / 64, nb = q % 64; const int n0 = 32 * nb;
                    const int drow = n0 < 1024 ? (256 * (n0 >> 7) + (n0 & 127)) : (256 * ((n0 - 1024) >> 7) + 128 + ((n0 - 1024) & 127));
                    transpose_item_tiled(args.in[I_WGU] + (size_t)e * D * 2048, 2048, D, Wgu_t + (size_t)e * 2048 * D, 64 * kb, n0, drow, scr, lane); continue; } r -= NE * I_GU;
                { const int e = r / I_DN, q = r % I_DN, kb = q / 32, nb = q % 32;
                  transpose_item_tiled(args.in[I_WDN] + (size_t)e * DFF * D, D, DFF, Wdn_t + (size_t)e * D * DFF, 64 * kb, 32 * nb, 32 * nb, scr, lane); }
            }
        }
    }
    SEAM(0);

    if (IN(1)) { PHASE_IDS;
        { pg8::DenseSched S; S.o.init_tiles(M / 256, INW / 256, G, bid); S.A = (const char*)HN; S.B = (const char*)Win_t; S.tstep = (size_t)256 * D * 2;
          EpiBf16Plain E{U, INW, 1.0f}; pg8::gemm_phase(lds, D, S, E); }
        { pg8::DenseSched S; S.o.init_tiles(MROWS / 256, D / 256, G, (bid + 64) & (G - 1)); S.A = (const char*)MEMN; S.B = (const char*)Wk_t; S.tstep = (size_t)256 * D * 2;
          EpiBf16Plain E{KM, D, 1.0f}; pg8::gemm_phase(lds, D, S, E); }
        { pg8::DenseSched S; S.o.init_tiles(MROWS / 256, D / 256, G, (bid + 48) & (G - 1)); S.A = (const char*)MEMN; S.B = (const char*)Wv_t; S.tstep = (size_t)256 * D * 2;
          EpiBf16Plain E{VT, D, 1.0f}; pg8::gemm_phase(lds, D, S, E); }
    }
    SEAM(1);

    if (IN(2)) { PHASE_IDS;
        {
            const float* conv_w = args.in[I_CONVW]; const float* conv_b = args.in[I_CONVB]; const float* bx = args.in[I_LBX]; const float* ba = args.in[I_LBA]; const float* lam = args.in[I_LAM];
            LAS float* xs = (LAS float*)(lds + wave * 4096);
            const int i = lane & 15, kg = lane >> 4;
            for (int unit = gw; unit < (M / 16) * 2; unit += NGW) {
                const int tile = unit >> 1, nb0 = (unit & 1) * 4, m0 = tile * 16, s0 = m0 & (SEQ - 1);
                for (int nb = nb0; nb < nb0 + 4; ++nb) {
                    bf16x8 af[2];
#pragma unroll
                    for (int ks = 0; ks < 2; ++ks) {
                        const int chb = nb * 64 + 32 * ks + 8 * kg;
                        f32x4 x0 = *(const f32x4*)(conv_b + chb), x1 = *(const f32x4*)(conv_b + chb + 4);
#pragma unroll
                        for (int j = 0; j < 4; ++j) {
                            {
                                const bool ok = s0 + i - 3 + j >= 0;
                                u32x4 uw = *(const u32x4*)(U + (size_t)(ok ? m0 + i - 3 + j : m0) * INW + chb); if (!ok) uw = (u32x4){0u, 0u, 0u, 0u};
                                const f32x4 w0 = *(const f32x4*)(conv_w + j * 512 + chb), w1 = *(const f32x4*)(conv_w + j * 512 + chb + 4);
                                x0.x += w0.x * bflo(uw.x); x0.y += w0.y * bfhi(uw.x); x0.z += w0.z * bflo(uw.y); x0.w += w0.w * bfhi(uw.y);
                                x1.x += w1.x * bflo(uw.z); x1.y += w1.y * bfhi(uw.z); x1.z += w1.z * bflo(uw.w); x1.w += w1.w * bfhi(uw.w);
                            }
                        }
                        *(LAS f32x4*)(xs + i * 64 + 32 * ks + 8 * kg) = x0; *(LAS f32x4*)(xs + i * 64 + 32 * ks + 8 * kg + 4) = x1;
                        u32x4 p; p.x = pk2(x0.x, x0.y); p.y = pk2(x0.z, x0.w); p.z = pk2(x1.x, x1.y); p.w = pk2(x1.z, x1.w);
                        af[ks] = __builtin_bit_cast(bf16x8, p);
                    }
                    f32x4 acc[8];
#pragma unroll
                    for (int ct = 0; ct < 8; ++ct) { acc[ct] = (f32x4){0.f, 0.f, 0.f, 0.f};
#pragma unroll
                        for (int ks = 0; ks < 2; ++ks) { const bf16x8 bfr = *(const bf16x8*)(LruW + ((size_t)(nb * 128 + 16 * ct + i) * 64 + 32 * ks + 8 * kg));
                            acc[ct] = __builtin_amdgcn_mfma_f32_16x16x32_bf16(af[ks], bfr, acc[ct], 0, 0, 0); } }
                    asm volatile("s_waitcnt lgkmcnt(0)" ::: "memory");
#pragma unroll
                    for (int ct = 0; ct < 4; ++ct) {
                        const int col = 16 * ct + i, ch = nb * 64 + col;
                        const float bxv = bx[ch], bav = ba[ch], sp = softplus_f(-lam[ch]);
#pragma unroll
                        for (int e = 0; e < 4; ++e) {
                            const int tok = 4 * kg + e;
                            const float gx = sigmoid_f(acc[ct][e] + bxv), ga = sigmoid_f(acc[ct + 4][e] + bav);
                            const float la = -8.0f * ga * sp, xcv = xs[tok * 64 + col];
                            const float bt = __builtin_amdgcn_sqrtf(fmaxf(1.0f - __expf(2.0f * la), 0.f)) * gx * xcv;
                            LA[(size_t)(m0 + tok) * 512 + ch] = (bf16)f2bf(la); LB[(size_t)(m0 + tok) * 512 + ch] = (bf16)f2bf(bt);
                        }
                    }
                }
            }
        }
    }
    if (IN(2)) { PHASE_IDS;
        bf16* WKt = HN; bf16* VWt = HN + (size_t)4 * 1024 * 1024;
        __syncthreads();
        if (bid < 64) { pg8::FoldSched<0> S; S.A = (const char*)KM; S.B = (const char*)Wq_t; S.G = 64; S.c = bid; EpiFold<0> E{WKt}; pg8::gemm_phase(lds, 256, S, E, 1024); }
        else if (bid < 128) { pg8::FoldSched<1> S; S.A = (const char*)Wo_t; S.B = (const char*)VT; S.G = 64; S.c = bid - 64; EpiFold<1> E{VWt}; pg8::gemm_phase(lds, 256, S, E, 1024); }
    }
    SEAM(2);


#define RW_ZB(zz, zb) do { _Pragma("unroll") for (int ks_ = 0; ks_ < 2; ++ks_) { u32x4 p_; p_.x = pk2(zz[2 * ks_][0], zz[2 * ks_][1]); p_.y = pk2(zz[2 * ks_][2], zz[2 * ks_][3]); \
        p_.z = pk2(zz[2 * ks_ + 1][0], zz[2 * ks_ + 1][1]); p_.w = pk2(zz[2 * ks_ + 1][2], zz[2 * ks_ + 1][3]); zb[ks_] = __builtin_bit_cast(bf16x8, p_); } } while (0)
    if (IN(3)) { PHASE_IDS;
        for (int u64 = gw; u64 < NB * NH * (SEQ / 64); u64 += NGW) {
#pragma unroll 1
        for (int jj = 0; jj < 4; ++jj) {
        LAS unsigned char* wl = lds + wave * 16384;
        LAS bf16* Arm = (LAS bf16*)(wl); LAS bf16* Brm = (LAS bf16*)(wl + 2048); LAS bf16* Krm = (LAS bf16*)(wl + 4096); LAS bf16* Rrm = (LAS bf16*)(wl + 6144);
        LAS bf16* ATt = (LAS bf16*)(wl + 8192); LAS bf16* BTt = (LAS bf16*)(wl + 10240); LAS bf16* KTt = (LAS bf16*)(wl + 12288); LAS bf16* VTt = (LAS bf16*)(wl + 14336);
        LAS float* MabT = (LAS float*)(wl); LAS bf16* Mak = (LAS bf16*)(wl + 1024); LAS bf16* Mrb = (LAS bf16*)(wl + 1536); LAS bf16* Mrk = (LAS bf16*)(wl + 2048); LAS bf16* Tm = (LAS bf16*)(wl + 2560);
        LAS float* PLs = (LAS float*)(wl + 3072); LAS bf16* Q0T = (LAS bf16*)(wl + 4096);
        const int lane = fresh_tid() & 63, l15 = lane & 15, g = lane >> 4, te = lane >> 2, kq = lane & 3;
        const bf16x8 z8 = (bf16x8){0, 0, 0, 0, 0, 0, 0, 0};
        const f32x4 z4 = (f32x4){0.f, 0.f, 0.f, 0.f};
            const int un = u64 * 4 + jj;
            const int bh = un >> 8, c = un & 255, b = bh >> 3, h = bh & 7;
            const size_t mrow = (size_t)b * SEQ + c * 16 + te, off = mrow * 512 + h * 64 + 16 * kq;
            const int hc = h * 64 + 16 * kq;
            LAS float* tmpL = (LAS float*)wl;
            {
                const int rsub = lane >> 5, chunk = lane & 31; const size_t mt0 = (size_t)b * SEQ + c * 16;
                const f32x4 m0 = *(const f32x4*)(args.in[I_MU] + 1536 + 8 * chunk), m1 = *(const f32x4*)(args.in[I_MU] + 1536 + 8 * chunk + 4);
                u32x4 cu[8], pu[8];
#pragma unroll
                for (int i = 0; i < 8; ++i) { const size_t mr = mt0 + 2 * i + rsub; const bool hp2 = (mr & (SEQ - 1)) != 0; const bf16* ua = U + mr * INW + 2560 + 8 * chunk;
                    cu[i] = *(const u32x4*)ua; pu[i] = *(const u32x4*)(ua - (hp2 ? INW : 0)); if (!hp2) pu[i] = (u32x4){0u, 0u, 0u, 0u}; }
#pragma unroll
                for (int i = 0; i < 8; ++i) { float o8[8];
#pragma unroll
                    for (int q = 0; q < 4; ++q) { const float c0 = bflo(cu[i][q]), c1 = bfhi(cu[i][q]), p0 = bflo(pu[i][q]), p1 = bfhi(pu[i][q]); const float mm0 = q < 2 ? m0[2 * q] : m1[2 * q - 4], mm1 = q < 2 ? m0[2 * q + 1] : m1[2 * q - 3];
                        float x0 = c0 + (p0 - c0) * mm0, x1 = c1 + (p1 - c1) * mm1;
                        if (chunk < 8) { x0 = tanh_fast(x0); x1 = tanh_fast(x1); }
                        else if (chunk >= 16) { x0 = sigmoid_f(x0); x1 = sigmoid_f(x1); }
                        o8[2 * q] = x0; o8[2 * q + 1] = x1; }
                    u32x4 pw; pw.x = pk2(o8[0], o8[1]); pw.y = pk2(o8[2], o8[3]); pw.z = pk2(o8[4], o8[5]); pw.w = pk2(o8[6], o8[7]);
                    const int row = 2 * i + rsub; *(LAS u32x4*)(wl + row * 512 + ((chunk ^ (row & 7)) << 4)) = pw; }
                bf16x8 af[8];
#pragma unroll
                for (int ks = 0; ks < 8; ++ks) af[ks] = *(const LAS bf16x8*)(wl + l15 * 512 + (((4 * ks + g) ^ (l15 & 7)) << 4));
                asm volatile("s_waitcnt lgkmcnt(0)" ::: "memory");
#pragma unroll
                for (int kind = 0; kind < 3; ++kind)
#pragma unroll
                    for (int ct = 0; ct < 4; ++ct) {
                        const bf16* lb = LoraB + ((size_t)((h * 3 + kind) * 4 + ct) * 8 * 64 + lane) * 8;
                        f32x4 a4 = z4;
#pragma unroll
                        for (int ks = (kind == 0 ? 0 : kind == 1 ? 2 : 4); ks < (kind == 0 ? 2 : kind == 1 ? 4 : 8); ++ks) a4 = __builtin_amdgcn_mfma_f32_16x16x32_bf16(af[ks], *(const bf16x8*)(lb + ks * 512), a4, 0, 0, 0);
#pragma unroll
                        for (int e = 0; e < 4; ++e) tmpL[kind * 1088 + (4 * g + e) * 68 + 16 * ct + l15] = a4[e];
                    }
            }
            asm volatile("s_waitcnt lgkmcnt(0)" ::: "memory");
            float cl[16], eP[16];
            {
                float lwv[16], rl[16], kl[16], vl[16], kn[16], av[16];
                const bool hp = (mrow & (SEQ - 1)) != 0;
                const bf16* ub = U + mrow * INW + 1024 + hc;
#pragma unroll
                for (int hh = 0; hh < 2; ++hh) {
#pragma unroll
                    for (int a3 = 0; a3 < 3; ++a3) {
                        const u32x4 cu = *(const u32x4*)(ub + 512 * a3 + 8 * hh); u32x4 pu = *(const u32x4*)(ub - (hp ? INW : 0) + 512 * a3 + 8 * hh); if (!hp) pu = (u32x4){0u, 0u, 0u, 0u};
                        const f32x4 m0 = *(const f32x4*)(args.in[I_MU] + 512 * a3 + hc + 8 * hh), m1 = *(const f32x4*)(args.in[I_MU] + 512 * a3 + hc + 8 * hh + 4);
                        float o8[8];
#pragma unroll
                        for (int q = 0; q < 4; ++q) { const float c0 = bflo(cu[q]), c1 = bfhi(cu[q]), p0 = bflo(pu[q]), p1 = bfhi(pu[q]); const float mm0 = q < 2 ? m0[2 * q] : m1[2 * q - 4], mm1 = q < 2 ? m0[2 * q + 1] : m1[2 * q - 3];
                            o8[2 * q] = c0 + (p0 - c0) * mm0; o8[2 * q + 1] = c1 + (p1 - c1) * mm1; }
#pragma unroll
                        for (int q = 0; q < 8; ++q) { if (a3 == 0) rl[8 * hh + q] = o8[q]; else if (a3 == 1) kl[8 * hh + q] = o8[q]; else vl[8 * hh + q] = o8[q]; }
                    }
                }
                float gv[16];
#pragma unroll
                for (int j4 = 0; j4 < 4; ++j4) { const f32x4 xl = *(const LAS f32x4*)(tmpL + te * 68 + 16 * kq + 4 * j4), xa = *(const LAS f32x4*)(tmpL + 1088 + te * 68 + 16 * kq + 4 * j4), xg = *(const LAS f32x4*)(tmpL + 2176 + te * 68 + 16 * kq + 4 * j4);
                    const f32x4 w0v = *(const f32x4*)(args.in[I_W0] + hc + 4 * j4), a0v = *(const f32x4*)(args.in[I_A0] + hc + 4 * j4);
#pragma unroll
                    for (int q = 0; q < 4; ++q) { const float wq = -softplus_fast(-(xl[q] + w0v[q])) - 0.5f; lwv[4 * j4 + q] = -__expf(wq); av[4 * j4 + q] = sigmoid_f(xa[q] + a0v[q]); gv[4 * j4 + q] = xg[q]; } }
                asm volatile("s_waitcnt lgkmcnt(0)" ::: "memory");
                float ss = 0.f;
#pragma unroll
                for (int j4 = 0; j4 < 4; ++j4) { const f32x4 kk4 = *(const f32x4*)(args.in[I_KK] + hc + 4 * j4);
#pragma unroll
                    for (int q = 0; q < 4; ++q) { kn[4 * j4 + q] = kl[4 * j4 + q] * kk4[q]; ss += kn[4 * j4 + q] * kn[4 * j4 + q]; } }
                ss += __shfl_xor(ss, 1); ss += __shfl_xor(ss, 2);
                const float kinv = rsq_f(fmaxf(ss, 1e-24f));
#pragma unroll
                for (int j = 0; j < 16; ++j) { float x = lwv[j];
#pragma unroll
                    for (int sft = 4; sft < 64; sft <<= 1) { const float y = __shfl_up(x, sft); if (lane >= sft) x += y; }
                    cl[j] = x; }
                float bon = 0.f;
                u32x4 pa[2], pb[2], pk[2], pr[2];
#pragma unroll
                for (int j4 = 0; j4 < 4; ++j4) {
                    const f32x4 ka = *(const f32x4*)(args.in[I_KA] + hc + 4 * j4), rk = *(const f32x4*)(args.in[I_RK] + hc + 4 * j4);
                    float at4[4], bt4[4], kt4[4], rt4[4];
#pragma unroll
                    for (int q = 0; q < 4; ++q) { const int j = 4 * j4 + q;
                        const float p = __expf(cl[j]), pn = __expf(-cl[j]), pm1 = __expf(cl[j] - lwv[j]); eP[j] = p;
                        const float knj = kn[j] * kinv;
                        const float kp = kl[j] * (1.0f + (av[j] - 1.0f) * ka[q]);
                        at4[q] = -knj * pm1; bt4[q] = knj * av[j] * pn; kt4[q] = kp * pn; rt4[q] = rl[j] * p;
                        bon += rl[j] * kp * rk[q];
                        const int kk = 16 * kq + j;
                        ATt[kk * 16 + te] = (bf16)f2bf(at4[q]); BTt[kk * 16 + te] = (bf16)f2bf(bt4[q]); KTt[kk * 16 + te] = (bf16)f2bf(kt4[q]); VTt[kk * 16 + te] = (bf16)f2bf(vl[j]); }
                    const int hh = j4 >> 1, w2 = (j4 & 1) * 2;
                    pa[hh][w2] = pk2(at4[0], at4[1]); pa[hh][w2 + 1] = pk2(at4[2], at4[3]); pb[hh][w2] = pk2(bt4[0], bt4[1]); pb[hh][w2 + 1] = pk2(bt4[2], bt4[3]);
                    pk[hh][w2] = pk2(kt4[0], kt4[1]); pk[hh][w2 + 1] = pk2(kt4[2], kt4[3]); pr[hh][w2] = pk2(rt4[0], rt4[1]); pr[hh][w2 + 1] = pk2(rt4[2], rt4[3]);
                }
#pragma unroll
                for (int hh = 0; hh < 2; ++hh) { const int po = te * 64 + 8 * ((2 * kq + hh) ^ (te & 7));
                    *(LAS u32x4*)(Arm + po) = pa[hh]; *(LAS u32x4*)(Brm + po) = pb[hh]; *(LAS u32x4*)(Krm + po) = pk[hh]; *(LAS u32x4*)(Rrm + po) = pr[hh]; }
                bon += __shfl_xor(bon, 1); bon += __shfl_xor(bon, 2);
                f32x4 lbv[4], lgv[4];
#pragma unroll
                for (int j4 = 0; j4 < 4; ++j4) { lbv[j4] = *(const f32x4*)(args.in[I_LNB] + hc + 4 * j4); lgv[j4] = *(const f32x4*)(args.in[I_LNG] + hc + 4 * j4); }
#pragma unroll
                for (int j4 = 0; j4 < 4; ++j4) { const f32x4 lb = lbv[j4], lgn = lgv[j4]; const int j0 = 4 * j4;
                    u32x2 ow, gw2; ow.x = pk2((lb.x + vl[j0] * bon) * gv[j0], (lb.y + vl[j0 + 1] * bon) * gv[j0 + 1]); ow.y = pk2((lb.z + vl[j0 + 2] * bon) * gv[j0 + 2], (lb.w + vl[j0 + 3] * bon) * gv[j0 + 3]);
                    gw2.x = pk2(lgn.x * gv[j0], lgn.y * gv[j0 + 1]); gw2.y = pk2(lgn.z * gv[j0 + 2], lgn.w * gv[j0 + 3]);
                    *(u32x2*)((bf16*)(ws + WS_ADD) + off + j0) = ow; *(u32x2*)((bf16*)(ws + WS_G) + off + j0) = gw2; }
            }
            asm volatile("s_waitcnt lgkmcnt(0)" ::: "memory");
            {
                bf16x8 fa[2], fr[2], fb[2], fk[2];
#pragma unroll
                for (int ks = 0; ks < 2; ++ks) { const int po = l15 * 64 + 8 * ((4 * ks + g) ^ (l15 & 7));
                    fa[ks] = *(const LAS bf16x8*)(Arm + po); fr[ks] = *(const LAS bf16x8*)(Rrm + po); fb[ks] = *(const LAS bf16x8*)(Brm + po); fk[ks] = *(const LAS bf16x8*)(Krm + po); }
                f32x4 mab = z4, mak = z4, mrb = z4, mrk = z4;
#pragma unroll
                for (int ks = 0; ks < 2; ++ks) { mab = __builtin_amdgcn_mfma_f32_16x16x32_bf16(fb[ks], fa[ks], mab, 0, 0, 0); mak = __builtin_amdgcn_mfma_f32_16x16x32_bf16(fk[ks], fa[ks], mak, 0, 0, 0);
                    mrb = __builtin_amdgcn_mfma_f32_16x16x32_bf16(fb[ks], fr[ks], mrb, 0, 0, 0); mrk = __builtin_amdgcn_mfma_f32_16x16x32_bf16(fk[ks], fr[ks], mrk, 0, 0, 0); }
#pragma unroll
                for (int e = 0; e < 4; ++e) { const int i = 4 * g + e; if (!(i < l15)) { mab[e] = 0.f; mak[e] = 0.f; } if (!(i <= l15)) { mrb[e] = 0.f; mrk[e] = 0.f; } }
                asm volatile("s_waitcnt lgkmcnt(0)" ::: "memory");
#pragma unroll
                for (int e = 0; e < 4; ++e) MabT[(4 * g + e) * 16 + l15] = mab[e];
                u32x2 w; w.x = pk2(mak[0], mak[1]); w.y = pk2(mak[2], mak[3]); *(LAS u32x2*)(Mak + l15 * 16 + 4 * g) = w;
                w.x = pk2(mrb[0], mrb[1]); w.y = pk2(mrb[2], mrb[3]); *(LAS u32x2*)(Mrb + l15 * 16 + 4 * g) = w;
                w.x = pk2(mrk[0], mrk[1]); w.y = pk2(mrk[2], mrk[3]); *(LAS u32x2*)(Mrk + l15 * 16 + 4 * g) = w;
                if (te == 15) {
#pragma unroll
                    for (int j = 0; j < 16; ++j) PLs[16 * kq + j] = eP[j]; }
            }
            asm volatile("s_waitcnt lgkmcnt(0)" ::: "memory");
            {
                f32x4 mq[15][4];
#pragma unroll
                for (int j = 0; j < 15; ++j)
#pragma unroll
                    for (int q = 0; q < 4; ++q) if (4 * q + 3 > j) mq[j][q] = *(const LAS f32x4*)(MabT + j * 16 + 4 * q);
                float y[16];
#pragma unroll
                for (int j = 15; j >= 0; --j) {
                    float acc = (j == l15) ? 1.0f : 0.0f;
#pragma unroll
                    for (int i = j + 1; i < 16; ++i) acc += y[i] * mq[j < 15 ? j : 0][i >> 2][i & 3];
                    y[j] = acc;
                }
                if (g == 0) { u32x4 t0, t1; t0.x = pk2(y[0], y[1]); t0.y = pk2(y[2], y[3]); t0.z = pk2(y[4], y[5]); t0.w = pk2(y[6], y[7]); t1.x = pk2(y[8], y[9]); t1.y = pk2(y[10], y[11]); t1.z = pk2(y[12], y[13]); t1.w = pk2(y[14], y[15]);
                    *(LAS u32x4*)(Tm + l15 * 16) = t0; *(LAS u32x4*)(Tm + l15 * 16 + 8) = t1; }
            }
            asm volatile("s_waitcnt lgkmcnt(0)" ::: "memory");
            {
                const bool act = g < 2; const int fo = l15 * 16 + 8 * g;
                const bf16x8 fT = act ? *(const LAS bf16x8*)(Tm + fo) : z8, fMak = act ? *(const LAS bf16x8*)(Mak + fo) : z8, fMrb = act ? *(const LAS bf16x8*)(Mrb + fo) : z8, fMrk = act ? *(const LAS bf16x8*)(Mrk + fo) : z8;
                bf16x8 fV[4], fQ1[4], fAh[4], fBT[4], fKT[4];
#pragma unroll
                for (int vt = 0; vt < 4; ++vt) { fV[vt] = act ? *(const LAS bf16x8*)(VTt + vt * 256 + fo) : z8; fBT[vt] = act ? *(const LAS bf16x8*)(BTt + vt * 256 + fo) : z8; fKT[vt] = act ? *(const LAS bf16x8*)(KTt + vt * 256 + fo) : z8; }
#pragma unroll
                for (int vt = 0; vt < 4; ++vt) { const f32x4 q0 = __builtin_amdgcn_mfma_f32_16x16x32_bf16(fMak, fV[vt], z4, 0, 0, 0);
                    u32x2 w; w.x = pk2(q0[0], q0[1]); w.y = pk2(q0[2], q0[3]); *(LAS u32x2*)(Q0T + vt * 256 + l15 * 16 + 4 * g) = w; }
#pragma unroll
                for (int kt = 0; kt < 4; ++kt) { const bf16x8 fA = act ? *(const LAS bf16x8*)(ATt + kt * 256 + fo) : z8; const f32x4 ah = __builtin_amdgcn_mfma_f32_16x16x32_bf16(fT, fA, z4, 0, 0, 0);
                    u32x2 w; w.x = pk2(ah[0], ah[1]); w.y = pk2(ah[2], ah[3]); *(LAS u32x2*)(ATt + kt * 256 + l15 * 16 + 4 * g) = w; }
                asm volatile("s_waitcnt lgkmcnt(0)" ::: "memory");
#pragma unroll
                for (int vt = 0; vt < 4; ++vt) { const bf16x8 fQ0 = act ? *(const LAS bf16x8*)(Q0T + vt * 256 + fo) : z8; const f32x4 q1 = __builtin_amdgcn_mfma_f32_16x16x32_bf16(fT, fQ0, z4, 0, 0, 0);
                    u32x2 w; w.x = pk2(q1[0], q1[1]); w.y = pk2(q1[2], q1[3]); *(LAS u32x2*)(Q0T + vt * 256 + l15 * 16 + 4 * g) = w; }
                asm volatile("s_waitcnt lgkmcnt(0)" ::: "memory");
#pragma unroll
                for (int vt = 0; vt < 4; ++vt) { fQ1[vt] = act ? *(const LAS bf16x8*)(Q0T + vt * 256 + fo) : z8; fAh[vt] = act ? *(const LAS bf16x8*)(ATt + vt * 256 + fo) : z8; }
                bf16* rp = (bf16*)(ws + WS_RP) + (size_t)un * 1024 + l15 * 64;
#pragma unroll
                for (int kt = 0; kt < 4; ++kt) {
                    const u32x2 rr = *(const LAS u32x2*)(Rrm + l15 * 64 + 8 * ((2 * kt + (g >> 1)) ^ (l15 & 7)) + 4 * (g & 1));
                    f32x4 ini; ini[0] = bflo(rr.x); ini[1] = bfhi(rr.x); ini[2] = bflo(rr.y); ini[3] = bfhi(rr.y);
                    const f32x4 rh = __builtin_amdgcn_mfma_f32_16x16x32_bf16(fAh[kt], fMrb, ini, 0, 0, 0);
                    u32x2 w; w.x = pk2(rh[0], rh[1]); w.y = pk2(rh[2], rh[3]); *(u32x2*)(rp + 32 * (kt >> 1) + 8 * g + 4 * (kt & 1)) = w;
                }
#pragma unroll
                for (int vt = 0; vt < 4; ++vt) { f32x4 y1 = __builtin_amdgcn_mfma_f32_16x16x32_bf16(fMrb, fQ1[vt], z4, 0, 0, 0); y1 = __builtin_amdgcn_mfma_f32_16x16x32_bf16(fMrk, fV[vt], y1, 0, 0, 0);
                    *(f32x4*)((float*)(ws + WS_Y1F) + ((size_t)(un * 4 + vt) * 64 + lane) * 4) = y1; }
                LAS bf16* tgs = (LAS bf16*)(wl + 8192);
#pragma unroll
                for (int krt = 0; krt < 4; ++krt) { const float pl = PLs[16 * krt + l15];
#pragma unroll
                    for (int kct = 0; kct < 4; ++kct) { f32x4 ga = __builtin_amdgcn_mfma_f32_16x16x32_bf16(fAh[kct], fBT[krt], z4, 0, 0, 0);
                        if (kct == krt) {
#pragma unroll
                            for (int e = 0; e < 4; ++e) if (4 * g + e == l15) ga[e] += 1.0f; }
                        u32x2 w; w.x = pk2(ga[0] * pl, ga[1] * pl); w.y = pk2(ga[2] * pl, ga[3] * pl);
                        *(LAS u32x2*)(tgs + (16 * krt + l15) * 64 + 32 * (kct >> 1) + 8 * g + 4 * (kct & 1)) = w; } }
                { u32x4* gp16 = (u32x4*)((bf16*)(ws + WS_GP) + (size_t)un * 4096);
#pragma unroll
                  for (int i = 0; i < 8; ++i) gp16[i * 64 + lane] = *(const LAS u32x4*)(tgs + (i * 64 + lane) * 8); }
#pragma unroll
                for (int mt = 0; mt < 4; ++mt) { const f32x4 pl4 = *(const LAS f32x4*)(PLs + 16 * mt + 4 * g);
#pragma unroll
                    for (int vt = 0; vt < 4; ++vt) { f32x4 ha = __builtin_amdgcn_mfma_f32_16x16x32_bf16(fBT[mt], fQ1[vt], z4, 0, 0, 0); ha = __builtin_amdgcn_mfma_f32_16x16x32_bf16(fKT[mt], fV[vt], ha, 0, 0, 0);
                        u32x2 w; w.x = pk2(ha[0] * pl4[0], ha[1] * pl4[1]); w.y = pk2(ha[2] * pl4[2], ha[3] * pl4[3]);
                        *(u32x2*)((bf16*)(ws + WS_HF) + ((size_t)((un * 4 + vt) * 4 + mt) * 64 + lane) * 4) = w; } }
            }
            asm volatile("s_waitcnt lgkmcnt(0)" ::: "memory");
        }
        asm volatile("s_waitcnt vmcnt(0)" ::: "memory");
        { const int ltid = fresh_tid() & 63, l15 = ltid & 15, g = ltid >> 4, lane = ltid;
#define CP_LOADG(gf_, j_) do { const bf16* gp_ = (const bf16*)(ws + WS_GP) + ((size_t)u64 * 4 + (j_)) * 4096 + l15 * 64 + 8 * g; \
            _Pragma("unroll") for (int mt = 0; mt < 4; ++mt) { gf_[mt][0] = *(const bf16x8*)(gp_ + mt * 1024); gf_[mt][1] = *(const bf16x8*)(gp_ + mt * 1024 + 32); } } while (0)
#define CP_LOADH(hf_, j_) do { _Pragma("unroll") for (int sl = 0; sl < 4; ++sl) _Pragma("unroll") for (int mt = 0; mt < 4; ++mt) \
            hf_[sl][mt] = *(const u32x2*)((const bf16*)(ws + WS_HF) + ((size_t)((((size_t)u64 * 4 + (j_)) * 4 + sl) * 4 + mt) * 64 + lane) * 4); } while (0)
#define CP_STEP(gf_, hf_, useh_) do { _Pragma("unroll") for (int sl = 0; sl < 4; ++sl) { bf16x8 zb[2]; RW_ZB(z[sl], zb); \
            _Pragma("unroll") for (int mt = 0; mt < 4; ++mt) { f32x4 a_ = (f32x4){0.f, 0.f, 0.f, 0.f}; \
                if (useh_) { a_[0] = bflo(hf_[sl][mt].x); a_[1] = bfhi(hf_[sl][mt].x); a_[2] = bflo(hf_[sl][mt].y); a_[3] = bfhi(hf_[sl][mt].y); } \
                a_ = __builtin_amdgcn_mfma_f32_16x16x32_bf16(gf_[mt][0], zb[0], a_, 0, 0, 0); a_ = __builtin_amdgcn_mfma_f32_16x16x32_bf16(gf_[mt][1], zb[1], a_, 0, 0, 0); z[sl][mt] = a_; } } } while (0)
        {
            f32x4 z[4][4];
#pragma unroll
            for (int sl = 0; sl < 4; ++sl)
#pragma unroll
                for (int mt = 0; mt < 4; ++mt)
#pragma unroll
                    for (int e = 0; e < 4; ++e) z[sl][mt][e] = (sl == mt && 4 * g + e == l15) ? 1.0f : 0.0f;
            bf16x8 gA[4][2], gB[4][2]; u32x2 hdum[4][4];
            CP_LOADG(gA, 0); CP_LOADG(gB, 1);
            CP_STEP(gA, hdum, false); CP_LOADG(gA, 2);
            CP_STEP(gB, hdum, false); CP_LOADG(gB, 3);
            CP_STEP(gA, hdum, false);
            CP_STEP(gB, hdum, false);
            LAS bf16* tg = (LAS bf16*)(lds + wave * 16384);
#pragma unroll
            for (int sl = 0; sl < 4; ++sl) { const int pc = 32 * (sl >> 1) + 8 * (l15 >> 2) + 4 * (sl & 1) + (l15 & 3);
#pragma unroll
                for (int mt = 0; mt < 4; ++mt)
#pragma unroll
                    for (int e = 0; e < 4; ++e) tg[(16 * mt + 4 * g + e) * 64 + pc] = (bf16)f2bf(z[sl][mt][e]); }
            u32x4* gc = (u32x4*)((bf16*)(ws + WS_GC) + (size_t)u64 * 4096);
#pragma unroll
            for (int i = 0; i < 8; ++i) gc[i * 64 + lane] = *(const LAS u32x4*)(tg + (i * 64 + lane) * 8);
        }
        {
            f32x4 z[4][4];
#pragma unroll
            for (int sl = 0; sl < 4; ++sl)
#pragma unroll
                for (int mt = 0; mt < 4; ++mt) z[sl][mt] = (f32x4){0.f, 0.f, 0.f, 0.f};
            bf16x8 gA[4][2], gB[4][2]; u32x2 hA[4][4], hB[4][4];
            CP_LOADG(gA, 0); CP_LOADH(hA, 0); CP_LOADG(gB, 1); CP_LOADH(hB, 1);
            CP_STEP(gA, hA, true); CP_LOADG(gA, 2); CP_LOADH(hA, 2);
            CP_STEP(gB, hB, true); CP_LOADG(gB, 3); CP_LOADH(hB, 3);
            CP_STEP(gA, hA, true);
            CP_STEP(gB, hB, true);
#pragma unroll
            for (int sl = 0; sl < 4; ++sl)
#pragma unroll
                for (int mt = 0; mt < 4; ++mt) { u32x2 w; w.x = pk2(z[sl][mt][0], z[sl][mt][1]); w.y = pk2(z[sl][mt][2], z[sl][mt][3]);
                    *(u32x2*)((bf16*)(ws + WS_HC) + ((size_t)((u64 * 4 + sl) * 4 + mt) * 64 + lane) * 4) = w; }
        }
#undef CP_LOADG
#undef CP_LOADH
#undef CP_STEP
        }
        }
        for (int lu = gw; lu < NB * 8 * 64; lu += NGW) {
            const int bc = lu >> 6, seg = lu & 63, b = bc >> 3, cg = bc & 7, ch = cg * 64 + lane;
            const size_t mb = (size_t)b * SEQ + seg * 64;
            float A = 1.f, B = 0.f;
#pragma unroll 16
            for (int t = 0; t < 64; ++t) { const float a = __expf(bf2f(LA[(mb + t) * 512 + ch])), bt = bf2f(LB[(mb + t) * 512 + ch]); B = a * B + bt; A *= a; }
            f32x2 ab; ab.x = A; ab.y = B; *(f32x2*)((float*)(ws + WS_AP) + ((size_t)lu * 64 + lane) * 2) = ab;
        }
    }
    SEAM(3);


    if (IN(4)) { PHASE_IDS;
        if (!(bid < 128 && wave == 0)) {
            const int wi = bid < 128 ? bid * 7 + (wave - 1) : 896 + (bid - 128) * 8 + wave, NW = 896 + (G - 128) * 8;
        } else {
            const int l15 = lane & 15, g = lane >> 4, bh = bid >> 2, vs = bid & 3;
            f32x4 z[4];
#pragma unroll
            for (int mt = 0; mt < 4; ++mt) z[mt] = (f32x4){0.f, 0.f, 0.f, 0.f};
            bf16x8 gA[4][2], gB[4][2], gC[4][2], gD[4][2]; u32x2 hA[4], hB[4], hC[4], hD[4];
#define SC_LOAD(gf, hf, C) do { const size_t u64_ = (size_t)bh * 64 + (C); const bf16* gp_ = (const bf16*)(ws + WS_GC) + u64_ * 4096 + l15 * 64 + 8 * g; \
                _Pragma("unroll") for (int mt = 0; mt < 4; ++mt) { gf[mt][0] = *(const bf16x8*)(gp_ + mt * 1024); gf[mt][1] = *(const bf16x8*)(gp_ + mt * 1024 + 32); \
                    hf[mt] = *(const u32x2*)((const bf16*)(ws + WS_HC) + ((size_t)((u64_ * 4 + vs) * 4 + mt) * 64 + lane) * 4); } } while (0)
#define SC_STEP(gf, hf, C) do { const size_t u64_ = (size_t)bh * 64 + (C); bf16* zs_ = (bf16*)(ws + WS_ZS) + ((size_t)((u64_ * 4 + vs) * 4) * 64 + lane) * 4; \
                _Pragma("unroll") for (int mt = 0; mt < 4; ++mt) { u32x2 zw_; zw_.x = pk2(z[mt][0], z[mt][1]); zw_.y = pk2(z[mt][2], z[mt][3]); *(u32x2*)(zs_ + mt * 256) = zw_; } \
                bf16x8 zb[2]; RW_ZB(z, zb); \
                _Pragma("unroll") for (int mt = 0; mt < 4; ++mt) { f32x4 a; a[0] = bflo(hf[mt].x); a[1] = bfhi(hf[mt].x); a[2] = bflo(hf[mt].y); a[3] = bfhi(hf[mt].y); \
                    a = __builtin_amdgcn_mfma_f32_16x16x32_bf16(gf[mt][0], zb[0], a, 0, 0, 0); a = __builtin_amdgcn_mfma_f32_16x16x32_bf16(gf[mt][1], zb[1], a, 0, 0, 0); z[mt] = a; } } while (0)
            SC_LOAD(gA, hA, 0); SC_LOAD(gB, hB, 1); SC_LOAD(gC, hC, 2);
#pragma unroll 1
            for (int C = 0; C < 64; C += 4) {
                SC_LOAD(gD, hD, C + 3);
                SC_STEP(gA, hA, C);
                if (C + 4 < 64) SC_LOAD(gA, hA, C + 4);
                SC_STEP(gB, hB, C + 1);
                if (C + 5 < 64) SC_LOAD(gB, hB, C + 5);
                SC_STEP(gC, hC, C + 2);
                if (C + 6 < 64) SC_LOAD(gC, hC, C + 6);
                SC_STEP(gD, hD, C + 3);
            }
#undef SC_LOAD
#undef SC_STEP
        }
    }
    SEAM(4);

    if (IN(5)) { PHASE_IDS;
        {
            for (int lu = gw; lu < NB * 8 * 64; lu += NGW) {
                const int bc = lu >> 6, seg = lu & 63, b = bc >> 3, cg = bc & 7, ch = cg * 64 + lane;
                const size_t mb = (size_t)b * SEQ + seg * 64;
                float hst = 0.f;
                const f32x2* ag = (const f32x2*)((const float*)(ws + WS_AP)) + (size_t)(bc * 64) * 64 + lane;
#pragma unroll 8
                for (int sg = 0; sg < seg; ++sg) { const f32x2 ab = ag[(size_t)sg * 64]; hst = ab.x * hst + ab.y; }
#pragma unroll 16
                for (int t = 0; t < 64; ++t) { const float a = __expf(bf2f(LA[(mb + t) * 512 + ch])), bt = bf2f(LB[(mb + t) * 512 + ch]); hst = a * hst + bt;
                    const float gl = bf2f(U[(mb + t) * INW + 512 + ch]); CAT[(mb + t) * 1024 + ch] = (bf16)f2bf(hst * gelu_tanh_f(gl)); }
            }
        }
        const int l15 = lane & 15, g = lane >> 4;
        LAS bf16* tGL = (LAS bf16*)(lds + wave * 16384); LAS bf16* tAD = tGL + 1024; LAS bf16* tOUT = tGL + 2048;
        const int ct = lane >> 3, cc = lane & 7;
        for (int u64 = gw; u64 < NB * NH * (SEQ / 64); u64 += NGW) {
            const int bh = u64 >> 6, C = u64 & 63, b = bh >> 3, h = bh & 7;
            f32x4 z[4][4];
#pragma unroll
            for (int sl = 0; sl < 4; ++sl)
#pragma unroll
                for (int mt = 0; mt < 4; ++mt) { const u32x2 zw = *(const u32x2*)((const bf16*)(ws + WS_ZS) + ((size_t)((u64 * 4 + sl) * 4 + mt) * 64 + lane) * 4); z[sl][mt] = (f32x4){bflo(zw.x), bfhi(zw.x), bflo(zw.y), bfhi(zw.y)}; }
#pragma unroll 1
            for (int j = 0; j < 4; ++j) {
                const size_t un = (size_t)u64 * 4 + j; const size_t m0 = (size_t)b * SEQ + (C * 4 + j) * 16;
                const bf16* rp = (const bf16*)(ws + WS_RP) + un * 1024 + l15 * 64 + 8 * g;
                const bf16x8 rf0 = *(const bf16x8*)rp, rf1 = *(const bf16x8*)(rp + 32);
                f32x4 y[4];
#pragma unroll
                for (int sl = 0; sl < 4; ++sl) y[sl] = *(const f32x4*)((const float*)(ws + WS_Y1F) + ((size_t)(un * 4 + sl) * 64 + lane) * 4);
                const size_t rg = (m0 + ct) * 512 + h * 64 + 8 * cc;
                const u32x4 gl0 = *(const u32x4*)((const bf16*)(ws + WS_G) + rg), gl1 = *(const u32x4*)((const bf16*)(ws + WS_G) + rg + 8 * 512);
                const u32x4 ad0 = *(const u32x4*)((const bf16*)(ws + WS_ADD) + rg), ad1 = *(const u32x4*)((const bf16*)(ws + WS_ADD) + rg + 8 * 512);
                bf16x8 gf[4][2]; u32x2 hfr[4][4];
                if (j < 3) {
                    const bf16* gp = (const bf16*)(ws + WS_GP) + un * 4096 + l15 * 64 + 8 * g;
#pragma unroll
                    for (int mt = 0; mt < 4; ++mt) { gf[mt][0] = *(const bf16x8*)(gp + mt * 1024); gf[mt][1] = *(const bf16x8*)(gp + mt * 1024 + 32); }
#pragma unroll
                    for (int sl = 0; sl < 4; ++sl)
#pragma unroll
                        for (int mt = 0; mt < 4; ++mt) hfr[sl][mt] = *(const u32x2*)((const bf16*)(ws + WS_HF) + ((size_t)((un * 4 + sl) * 4 + mt) * 64 + lane) * 4);
                }
                *(LAS u32x4*)(tGL + ct * 64 + 8 * cc) = gl0; *(LAS u32x4*)(tGL + (ct + 8) * 64 + 8 * cc) = gl1;
                *(LAS u32x4*)(tAD + ct * 64 + 8 * cc) = ad0; *(LAS u32x4*)(tAD + (ct + 8) * 64 + 8 * cc) = ad1;
                bf16x8 zb[4][2];
#pragma unroll
                for (int sl = 0; sl < 4; ++sl) { RW_ZB(z[sl], zb[sl]);
                    y[sl] = __builtin_amdgcn_mfma_f32_16x16x32_bf16(rf0, zb[sl][0], y[sl], 0, 0, 0); y[sl] = __builtin_amdgcn_mfma_f32_16x16x32_bf16(rf1, zb[sl][1], y[sl], 0, 0, 0); }
#pragma unroll
                for (int e = 0; e < 4; ++e) {
                    float s1 = (y[0][e] + y[1][e]) + (y[2][e] + y[3][e]);
                    s1 += __shfl_xor(s1, 1); s1 += __shfl_xor(s1, 2); s1 += __shfl_xor(s1, 4); s1 += __shfl_xor(s1, 8);
                    const float mean = s1 * (1.0f / 64.0f);
                    float d0 = y[0][e] - mean, d1 = y[1][e] - mean, d2 = y[2][e] - mean, d3 = y[3][e] - mean;
                    float s2 = (d0 * d0 + d1 * d1) + (d2 * d2 + d3 * d3);
                    s2 += __shfl_xor(s2, 1); s2 += __shfl_xor(s2, 2); s2 += __shfl_xor(s2, 4); s2 += __shfl_xor(s2, 8);
                    const float rstd = rsq_f(s2 * (1.0f / 64.0f) + GN_EPS);
                    const float dd[4] = {d0, d1, d2, d3};
#pragma unroll
                    for (int sl = 0; sl < 4; ++sl) { const int ti_ = (4 * g + e) * 64 + 16 * sl + l15;
                        const float o = dd[sl] * rstd * bf2f(tGL[ti_]) + bf2f(tAD[ti_]); tOUT[ti_] = (bf16)f2bf(o); }
                }
                { bf16* cp = CAT + (m0 + ct) * 1024 + 512 + h * 64 + 8 * cc;
                  *(u32x4*)cp = *(const LAS u32x4*)(tOUT + ct * 64 + 8 * cc); *(u32x4*)(cp + 8 * 1024) = *(const LAS u32x4*)(tOUT + (ct + 8) * 64 + 8 * cc); }
                if (j < 3) {
#pragma unroll
                    for (int sl = 0; sl < 4; ++sl)
#pragma unroll
                        for (int mt = 0; mt < 4; ++mt) { const u32x2 hh = hfr[sl][mt];
                            f32x4 a; a[0] = bflo(hh.x); a[1] = bfhi(hh.x); a[2] = bflo(hh.y); a[3] = bfhi(hh.y);
                            a = __builtin_amdgcn_mfma_f32_16x16x32_bf16(gf[mt][0], zb[sl][0], a, 0, 0, 0); a = __builtin_amdgcn_mfma_f32_16x16x32_bf16(gf[mt][1], zb[sl][1], a, 0, 0, 0); z[sl][mt] = a; }
                }
            }
        }
    }
    SEAM(5);
#undef RW_ZB


    if (IN(6)) { PHASE_IDS;
        pg8::DenseSched S; S.o.init_tiles(M / 256, D / 256, G, bid); S.A = (const char*)CAT; S.B = (const char*)Wout_t; S.tstep = (size_t)256 * D * 2;
        EpiBf16Res<false> E{args.in[I_X], X1, D, (float*)(ws + WS_AP + 2 * MiB)}; pg8::gemm_phase(lds, D, S, E);
    }
    SEAM(6);
    if (IN(7)) { PHASE_IDS;
        pg8::BatchBSched S; S.o.init_tiles(M / 256, D / 256, G, bid); S.A = (const char*)X1; S.B = (const char*)HN; S.tstep = (size_t)256 * D * 2; S.bstep = (size_t)1024 * 1024 * 2;
        EpiSoftmax E{Qb, 0.0625f, (const float*)(ws + WS_AP + 2 * MiB), (LAS float*)(lds + RING_BYTES + 1024), (LAS float*)(lds + RING_BYTES + 1024 + 4096)};
        pg8::gemm_phase(lds, D, S, E);
    }
    SEAM(7);
    if (IN(8)) { PHASE_IDS;
        pg8::BatchBSched S; S.o.init_tiles(M / 256, D / 256, G, bid); S.A = (const char*)Qb; S.B = (const char*)(HN + (size_t)4 * 1024 * 1024); S.tstep = (size_t)256 * D * 2; S.bstep = (size_t)1024 * 1024 * 2;
        EpiBf16Res<true> E{X1, X2, D, nullptr}; pg8::gemm_phase(lds, D, S, E);
    }
    SEAM(8);
    if (IN(9)) { PHASE_IDS;
        for (int cid = tid; cid < 2 * NE * 128; cid += NTHREADS) { const int t = cid >> 12, row = (cid >> 7) & 31, c = cid & 127;
            *(LAS u32x4*)(lds + t * 65536 + row * 2048 + ((c ^ (row & 7)) << 4)) = *(const u32x4*)(WrT + (size_t)t * NE * D + row * D + 8 * c); }
        __syncthreads();
        const int l15 = lane & 15, g = lane >> 4;
        LAS float* LG = (LAS float*)(lds + RING_BYTES + 1024 + wave * 2304);
        const float* gfn = args.in[I_NFFG];
        LAS unsigned* cntl = (LAS unsigned*)(lds + RING_BYTES + 640);
        for (int t0 = 0; t0 < M / 16; t0 += G * 4) {
        if (tid < 64) cntl[tid] = 0u;
        __syncthreads();
        const int tile = t0 + bid * 4 + wave; const bool active = wave < 4 && tile < M / 16;
        int me = 0, lpos = 0, ai = 0; float mg = 0.f;
        if (active) {
            const int m0 = tile * 16;
            const bf16* xrow = X2 + (size_t)(m0 + l15) * D + 8 * g;
            float ss = 0.f;
#pragma unroll 8
            for (int ks = 0; ks < 32; ++ks) { const u32x4 xw = *(const u32x4*)(xrow + 32 * ks);
#pragma unroll
                for (int q = 0; q < 4; ++q) { const float a = bflo(xw[q]), c = bfhi(xw[q]); ss += a * a + c * c; } }
            ss += __shfl_xor(ss, 16); ss += __shfl_xor(ss, 32);
            const float rstd = rsq_f(ss * (1.f / D) + EPS);
            f32x4 acc0 = (f32x4){0.f, 0.f, 0.f, 0.f}, acc1 = acc0;
            bf16* hrow = HN + (size_t)(m0 + l15) * D + 8 * g;
#pragma unroll 2
            for (int ks = 0; ks < 32; ++ks) {
                const f32x4 g0 = *(const f32x4*)(gfn + 32 * ks + 8 * g), g1 = *(const f32x4*)(gfn + 32 * ks + 8 * g + 4);
                const u32x4 xw = *(const u32x4*)(xrow + 32 * ks);
                float hf[8];
#pragma unroll
                for (int q = 0; q < 4; ++q) { hf[2 * q] = bflo(xw[q]) * rstd * (q < 2 ? g0[2 * q] : g1[2 * q - 4]); hf[2 * q + 1] = bfhi(xw[q]) * rstd * (q < 2 ? g0[2 * q + 1] : g1[2 * q - 3]); }
                u32x4 hi, lo;
#pragma unroll
                for (int q = 0; q < 4; ++q) { hi[q] = pk2(hf[2 * q], hf[2 * q + 1]); lo[q] = pk2(hf[2 * q] - bflo(hi[q]), hf[2 * q + 1] - bfhi(hi[q])); }
                *(u32x4*)(hrow + 32 * ks) = hi;
                const bf16x8 ah = __builtin_bit_cast(bf16x8, hi), al = __builtin_bit_cast(bf16x8, lo);
                const int c = 4 * ks + g;
#pragma unroll
                for (int nt = 0; nt < 2; ++nt) { const int row = 16 * nt + l15; const int off = row * 2048 + ((c ^ (row & 7)) << 4);
                    const bf16x8 bh = *(const LAS bf16x8*)(lds + off), bl = *(const LAS bf16x8*)(lds + 65536 + off);
                    f32x4 a = nt ? acc1 : acc0;
                    a = __builtin_amdgcn_mfma_f32_16x16x32_bf16(ah, bh, a, 0, 0, 0); a = __builtin_amdgcn_mfma_f32_16x16x32_bf16(ah, bl, a, 0, 0, 0); a = __builtin_amdgcn_mfma_f32_16x16x32_bf16(al, bh, a, 0, 0, 0);
                    if (nt) acc1 = a; else acc0 = a; }
            }
            { const float b0 = args.in[I_BR][l15], b1 = args.in[I_BR][16 + l15];
#pragma unroll
              for (int j = 0; j < 4; ++j) { LG[(4 * g + j) * 33 + l15] = acc0[j] + b0; LG[(4 * g + j) * 33 + 16 + l15] = acc1[j] + b1; } }
            const int rrow = lane >> 2, qq = lane & 3;
            float tv[4] = {-3.0e38f, -3.0e38f, -3.0e38f, -3.0e38f}; int ti[4] = {64, 65, 66, 67};
#define TOP_INS(xv_, xi_) do { float x_ = (xv_); int i_ = (xi_); _Pragma("unroll") for (int p_ = 0; p_ < 4; ++p_) { const bool b_ = x_ > tv[p_] || (x_ == tv[p_] && i_ < ti[p_]); \
                const float ov_ = tv[p_]; const int oi_ = ti[p_]; tv[p_] = b_ ? x_ : ov_; ti[p_] = b_ ? i_ : oi_; x_ = b_ ? ov_ : x_; i_ = b_ ? oi_ : i_; } } while (0)
#pragma unroll
            for (int j = 0; j < 8; ++j) TOP_INS(LG[rrow * 33 + 8 * qq + j], 8 * qq + j);
#pragma unroll
            for (int st = 1; st < 4; st <<= 1) { float pv[4]; int pi[4];
#pragma unroll
                for (int p = 0; p < 4; ++p) { pv[p] = __shfl_xor(tv[p], st); pi[p] = __shfl_xor(ti[p], st); }
#pragma unroll
                for (int p = 0; p < 4; ++p) TOP_INS(pv[p], pi[p]); }
#undef TOP_INS
            const float e1 = __expf(tv[1] - tv[0]), e2 = __expf(tv[2] - tv[0]), e3 = __expf(tv[3] - tv[0]);
            const float inv = rcp_f(1.0f + e1 + e2 + e3);
            me = qq == 0 ? ti[0] : qq == 1 ? ti[1] : qq == 2 ? ti[2] : ti[3];
            mg = (qq == 0 ? 1.0f : qq == 1 ? e1 : qq == 2 ? e2 : e3) * inv;
            lpos = (int)__hip_atomic_fetch_add(cntl + me, 1u, __ATOMIC_RELAXED, __HIP_MEMORY_SCOPE_WORKGROUP);
            ai = (m0 + rrow) * 4 + qq;
        }
        __syncthreads();
        if (tid < NE) { const unsigned c = cntl[tid]; cntl[32 + tid] = c ? atomicAdd(ecnt + 64 * tid, c) : 0u; }
        __syncthreads();
        if (active) { route_e[ai] = me; route_pos[ai] = (int)cntl[32 + me] + lpos; route_g[ai] = mg; }
        __syncthreads();
        }
    }
    SEAM(9);
    if (IN(10)) { PHASE_IDS;
        LAS int* pst = (LAS int*)lds;
        if (tid == 0) { int acc = 0; for (int e = 0; e < NE; ++e) { const int c = (int)__hip_atomic_load(ecnt + 64 * e, __ATOMIC_RELAXED, __HIP_MEMORY_SCOPE_AGENT); pst[e] = acc; pst[64 + e] = c; acc += (c + 255) & ~255; } pst[32] = acc; }
        __syncthreads();
        for (int ai = bid * NTHREADS + tid; ai < NASSIGN; ai += G * NTHREADS) {
            const int e = route_e[ai]; const int row = pst[e] + route_pos[ai]; row_slot[row] = ai; row_gate[row] = route_g[ai]; row_tok[row] = ai >> 2; }
        if (bid < NE) { const int e = bid, c = pst[64 + e], pe = (c + 255) & ~255; for (int p = c + tid; p < pe; p += NTHREADS) { row_slot[pst[e] + p] = -1; row_gate[pst[e] + p] = 0.f; row_tok[pst[e] + p] = 0; } }
        if (bid == 0 && tid == 0) { int nt = 0; for (int e = 0; e < NE; ++e) { const int n = ((pst[64 + e] + 255) & ~255) >> 8; for (int j = 0; j < n; ++j) tile_tab[16 + nt++] = e; } tile_tab[0] = nt; }
        __syncthreads();
    }
    SEAM(10);
    if (IN(11)) { PHASE_IDS;
        const int ntiles = tile_tab[0];
        pg8::MoeGatherSched S; S.o.init_tiles(ntiles, 2048 / 256, G, bid); S.A = (const char*)HN; S.B = (const char*)Wgu_t; S.tile_e = tile_tab + 16; S.rtok = row_tok; S.tstep = (size_t)256 * D * 2; S.estep = (size_t)2048 * D * 2;
        EpiSwiglu E{ACT, args.in[I_BGU]}; pg8::gemm_phase(lds, D, S, E);
    }
    SEAM(11);
    if (IN(12)) { PHASE_IDS;
        const int ntiles = tile_tab[0];
        pg8::MoeSched S; S.o.init_tiles(ntiles, D / 256, G, bid); S.A = (const char*)ACT; S.B = (const char*)Wdn_t; S.tile_e = tile_tab + 16; S.tstep = (size_t)256 * DFF * 2; S.estep = (size_t)D * DFF * 2;
        EpiDown E{YS, args.in[I_BDN], row_slot, row_gate}; pg8::gemm_phase(lds, DFF, S, E);
    }
    SEAM(12);
    if (IN(13)) { PHASE_IDS;
        const float* gfin = args.in[I_FNG];
        for (int m = gw; m < M; m += NGW) {
            float v[16]; float s = 0.f;
#pragma unroll
            for (int hf = 0; hf < 2; ++hf) { const u32x4 w = *(const u32x4*)(X2 + (size_t)m * D + 512 * hf + 8 * lane);
#pragma unroll
                for (int q = 0; q < 4; ++q) { v[8 * hf + 2 * q] = bflo(w[q]); v[8 * hf + 2 * q + 1] = bfhi(w[q]); }
#pragma unroll
                for (int k = 0; k < 4; ++k) { const u32x4 y = *(const u32x4*)(YS + (size_t)(m * 4 + k) * D + 512 * hf + 8 * lane);
#pragma unroll
                    for (int q = 0; q < 4; ++q) { v[8 * hf + 2 * q] += bflo(y[q]); v[8 * hf + 2 * q + 1] += bfhi(y[q]); } } }
#pragma unroll
            for (int j = 0; j < 16; ++j) s += v[j] * v[j];
            const float rstd = rsq_f(wave_sum(s) * (1.f / D) + EPS);
#pragma unroll
            for (int hf = 0; hf < 2; ++hf) { const f32x4 g0 = *(const f32x4*)(gfin + 512 * hf + 8 * lane), g1 = *(const f32x4*)(gfin + 512 * hf + 8 * lane + 4);
                float* o = args.out + (size_t)m * D + 512 * hf + 8 * lane;
                *(f32x4*)o = (f32x4){v[8 * hf] * rstd * g0.x, v[8 * hf + 1] * rstd * g0.y, v[8 * hf + 2] * rstd * g0.z, v[8 * hf + 3] * rstd * g0.w};
                *(f32x4*)(o + 4) = (f32x4){v[8 * hf + 4] * rstd * g1.x, v[8 * hf + 5] * rstd * g1.y, v[8 * hf + 6] * rstd * g1.z, v[8 * hf + 7] * rstd * g1.w}; }
        }
    }
#undef IN
#undef SEAM
}

constexpr int N_PHASES = 14;
extern "C" void kernel_launch(void* const* d_in, const int* in_sizes, int n_in, void* d_out, int out_size, void* d_ws, size_t ws_size, hipStream_t stream) {
    static int grid = 0;
    if (grid == 0) {
        if (n_in != 37 || out_size != M * D || ws_size < WS_END) { fprintf(stderr, "kernel_launch: unexpected shapes (n_in %d, out %d, ws %zu); nothing launched\n", n_in, out_size, ws_size); grid = -1; return; }
        int dev = 0, cus = 0, per_cu = 0;
        if (hipGetDevice(&dev) != hipSuccess || hipDeviceGetAttribute(&cus, hipDeviceAttributeMultiprocessorCount, dev) != hipSuccess) { grid = -1; return; }
        if (hipFuncSetAttribute((const void*)fwd, hipFuncAttributeMaxDynamicSharedMemorySize, LDS_BYTES) != hipSuccess) { fprintf(stderr, "kernel_launch: hipFuncSetAttribute failed\n"); grid = -1; return; }
        if (hipOccupancyMaxActiveBlocksPerMultiprocessor(&per_cu, (const void*)fwd, NTHREADS, LDS_BYTES) != hipSuccess || per_cu < 1) fprintf(stderr, "kernel_launch: occupancy query says %d\n", per_cu);
        (void)hipGetLastError();
        grid = cus > 256 ? 256 : cus;
    }
    if (grid < 0) return;
    if (hipMemsetAsync((char*)d_ws + WS_CTL, 0, CTL_ZERO_BYTES, stream) != hipSuccess) return;
    Args a{};
    for (int i = 0; i < 37; ++i) a.in[i] = (const float*)d_in[i];
    a.out = (float*)d_out; a.ws = (unsigned char*)d_ws;
#if MK_ONE_LAUNCH
    a.ph_lo = 0; a.ph_hi = N_PHASES;
    hipLaunchKernelGGL(fwd, dim3(grid), dim3(NTHREADS), LDS_BYTES, stream, a);
#else
    for (int p = 0; p < N_PHASES; ++p) { a.ph_lo = p; a.ph_hi = p + 1; hipLaunchKernelGGL(fwd, dim3(grid), dim3(NTHREADS), LDS_BYTES, stream, a);
#ifdef PROBE_REPEAT_PHASE
        if (p == PROBE_REPEAT_PHASE) hipLaunchKernelGGL(fwd, dim3(grid), dim3(NTHREADS), LDS_BYTES, stream, a);
#endif
    }
#endif
}
```

```cpp
#include <hip/hip_runtime.h>
#include <cstdio>
#include <cstdint>

#ifndef MK_ONE_LAUNCH
#define MK_ONE_LAUNCH 1
#endif

#define DI __device__ __forceinline__
#define GAS __attribute__((address_space(1)))
#define LAS __attribute__((address_space(3)))
typedef unsigned short bf16;
typedef short bf16x8 __attribute__((ext_vector_type(8)));
typedef float f32x4 __attribute__((ext_vector_type(4)));
typedef float f32x2 __attribute__((ext_vector_type(2)));
typedef unsigned u32x4 __attribute__((ext_vector_type(4)));
typedef unsigned u32x2 __attribute__((ext_vector_type(2)));

constexpr int D = 1024, NB = 4, SEQ = 4096, M = NB * SEQ;
constexpr int MEML = 256, MROWS = NB * MEML;
constexpr int LRU_W = 512, RW = 512, NH = 8, HD = 64;
constexpr int INW = 2816;
constexpr int XH = 4, XHD = 256;
constexpr int NE = 32, TOPK = 4, DFF = 1024;
constexpr int NASSIGN = M * TOPK;
constexpr int MAXTILES = 288, MAXROWS = MAXTILES * 256;
constexpr float EPS = 1e-6f, GN_EPS = 64e-5f;

DI int fresh_tid() { int t = threadIdx.x; asm volatile("" : "+v"(t)); return t; }
namespace pg8 {
constexpr int BM = 256, BK = 64, HALF = 128, HTB = HALF * BK * 2, STAGE_BYTES = 8 * HTB, NXCD = 8, WGM = 8;
__host__ __device__ __forceinline__ int lds_byte(int r, int c) { const int st = (r >> 4) * 2 + (c >> 5), rr = r & 15, cc = c & 31, ob = rr * 64 + cc * 2; return st * 1024 + (ob ^ (((ob >> 9) & 1) << 5)); }
__host__ __device__ __forceinline__ void stage_rc(int b, int& R, int& C) { const int st = b / 1024, sb = b % 1024, swz = sb ^ (((sb >> 9) & 1) << 5); R = (st >> 1) * 16 + swz / 64; C = (st & 1) * 32 + (swz % 64) / 2; }
__host__ __device__ __forceinline__ int perm32(int rho) { const int n = rho >> 4, i = rho & 15; return 8 * (i >> 2) + 4 * n + (i & 3); }

struct Unit { int pm, pn, e; };

struct StaticOrder {
    int nM, nN, nwg, G, c;
    __host__ __device__ void init_tiles(int nM_, int nN_, int G_, int c_) { nM = nM_; nN = nN_; nwg = nM * nN; G = G_; c = c_; }
    __host__ __device__ bool next(int i, Unit& u) const {
        const long L = (long)i * G + c; if (L >= nwg) return false;
        int wgid = (int)L; { const int q = nwg / NXCD, r = nwg % NXCD, xcd = wgid % NXCD, off = wgid / NXCD; wgid = (xcd < r ? xcd * (q + 1) : r * (q + 1) + (xcd - r) * q) + off; }
        const int nig = WGM * nN, gid = wgid / nig, fm = gid * WGM, gsz = (nM - fm) < WGM ? (nM - fm) : WGM;
        u.pm = fm + ((wgid % nig) % gsz); u.pn = (wgid % nig) / gsz; u.e = 0; return true;
    }
};
struct DenseSched {
    static constexpr bool GATHER = false, B_TILED = false;
    StaticOrder o; const char* A; const char* B; size_t tstep;
    DI bool next(int i, Unit& u) const { return o.next(i, u); }
    DI const char* a_ptr(const Unit& u) const { return A + (size_t)u.pm * tstep; }
    DI const char* b_ptr(const Unit& u) const { return B + (size_t)u.pn * tstep; }
    DI void a_voff(const Unit&, int K, const int (&R)[2], const int (&C)[2], unsigned (&vo)[2][2]) const {
#pragma unroll
        for (int h = 0; h < 2; ++h)
#pragma unroll
            for (int i = 0; i < 2; ++i) vo[h][i] = (unsigned)((h * HALF + R[i]) * K + C[i]) * 2u; }
};
struct MoeSched {
    static constexpr bool GATHER = false, B_TILED = true;
    StaticOrder o; const char* A; const char* B; const int* tile_e; size_t tstep, estep;
    DI bool next(int i, Unit& u) const { if (!o.next(i, u)) return false; u.e = tile_e[u.pm]; return true; }
    DI const char* a_ptr(const Unit& u) const { return A + (size_t)u.pm * tstep; }
    DI const char* b_ptr(const Unit& u) const { return B + (size_t)u.e * estep + (size_t)u.pn * tstep; }
    DI void a_voff(const Unit&, int K, const int (&R)[2], const int (&C)[2], unsigned (&vo)[2][2]) const {
#pragma unroll
        for (int h = 0; h < 2; ++h)
#pragma unroll
            for (int i = 0; i < 2; ++i) vo[h][i] = (unsigned)((h * HALF + R[i]) * K + C[i]) * 2u; }
};
struct MoeGatherSched {
    static constexpr bool GATHER = true, B_TILED = true;
    StaticOrder o; const char* A; const char* B; const int* tile_e; const int* rtok; size_t tstep, estep;
    DI bool next(int i, Unit& u) const { if (!o.next(i, u)) return false; u.e = tile_e[u.pm]; return true; }
    DI const char* a_ptr(const Unit&) const { return A; }
    DI const char* b_ptr(const Unit& u) const { return B + (size_t)u.e * estep + (size_t)u.pn * tstep; }
    DI void a_voff(const Unit& u, int K, const int (&R)[2], const int (&C)[2], unsigned (&vo)[2][2]) const {
#pragma unroll
        for (int h = 0; h < 2; ++h)
#pragma unroll
            for (int i = 0; i < 2; ++i) vo[h][i] = (unsigned)(rtok[u.pm * BM + h * HALF + R[i]] * K + C[i]) * 2u; }
};

struct BatchBSched {
    static constexpr bool GATHER = false, B_TILED = false;
    StaticOrder o; const char* A; const char* B; size_t tstep, bstep;
    DI bool next(int i, Unit& u) const { return o.next(i, u); }
    DI const char* a_ptr(const Unit& u) const { return A + (size_t)u.pm * tstep; }
    DI const char* b_ptr(const Unit& u) const { return B + (size_t)(u.pm >> 4) * bstep + (size_t)u.pn * tstep; }
    DI void a_voff(const Unit&, int K, const int (&R)[2], const int (&C)[2], unsigned (&vo)[2][2]) const {
#pragma unroll
        for (int h = 0; h < 2; ++h)
#pragma unroll
            for (int i = 0; i < 2; ++i) vo[h][i] = (unsigned)((h * HALF + R[i]) * K + C[i]) * 2u; }
};
template <int MODE> struct FoldSched {
    static constexpr bool GATHER = false, B_TILED = false;
    const char* A; const char* B; int G, c;
    DI bool next(int i, Unit& u) const { const int L = i * G + c; if (L >= 64) return false; u.pm = L >> 2; u.pn = L & 3; u.e = 0; return true; }
    DI const char* a_ptr(const Unit& u) const { const int b = u.pm >> 2, h = u.pm & 3; return A + ((size_t)(MODE == 0 ? b * 256 : u.pn * 256) * 1024 + h * 256) * 2; }
    DI const char* b_ptr(const Unit& u) const { const int b = u.pm >> 2, h = u.pm & 3; return B + ((size_t)(MODE == 0 ? u.pn * 256 : b * 256) * 1024 + h * 256) * 2; }
    DI void a_voff(const Unit&, int K, const int (&R)[2], const int (&C)[2], unsigned (&vo)[2][2]) const {
#pragma unroll
        for (int h = 0; h < 2; ++h)
#pragma unroll
            for (int i = 0; i < 2; ++i) vo[h][i] = (unsigned)((h * HALF + R[i]) * K + C[i]) * 2u; }
};

DI unsigned cvt_pk_bf16(float lo, float hi) { unsigned r; asm volatile("v_cvt_pk_bf16_f32 %0, %1, %2" : "=v"(r) : "v"(lo), "v"(hi)); return r; }

template <class Epi, class Sched, bool ALIGN_EPI = true>
DI void gemm_phase(LAS unsigned char* lds, const int K, const Sched& S, const Epi& E, const int ldp = 0) {
    const int ld = ldp ? ldp : K;
    const int tid = fresh_tid(), wid = __builtin_amdgcn_readfirstlane(tid >> 6), lane = tid & 63, wr = wid >> 2, wc = wid & 3, fr = lane & 15, fq = lane >> 4;
    const int nt = K / BK;
    constexpr bool GA = Sched::GATHER, BT = Sched::B_TILED;
    unsigned voffA[2][2], voffAn[2][2], voffB[2]; int sR[2], sC[2];
#pragma unroll
    for (int i = 0; i < 2; ++i) { int R, C; stage_rc(tid * 16 + i * 8192, R, C); const int Rb = Epi::PERM ? ((R & ~31) + perm32(R & 31)) : R;
        sR[i] = R; sC[i] = C; voffB[i] = BT ? (unsigned)(tid * 16 + i * 8192) : (unsigned)(Rb * ld + C) * 2u; }
    const size_t kstep = (size_t)(BK * 2);
    const size_t hstep = (size_t)HALF * ld * 2;
    const size_t kstepB = BT ? (size_t)(2 * HTB) : kstep, hstepB = BT ? (size_t)HTB : hstep;
    const unsigned ldsw = (unsigned)wid * 1024u;
    const int aoff = lds_byte(wr * 64 + fr, fq * 8), boff = lds_byte(wc * 32 + fr, fq * 8);
#define PG8_SA(b, h) (((b) * 2 + (h)) * HTB)
#define PG8_SB(b, h) ((4 + (b) * 2 + (h)) * HTB)
#define PG8_STAGE(bufoff, gbase, voff) do { _Pragma("unroll") for (int _i = 0; _i < 2; ++_i) \
        __builtin_amdgcn_global_load_lds((const unsigned*)((const char*)(gbase) + (voff)[_i]), (LAS unsigned*)(lds + (bufoff) + ldsw + _i * 8192), 16, 0, 0); } while (0)
#define PG8_LDA(dst, b, h) do { _Pragma("unroll") for (int m = 0; m < 4; ++m) _Pragma("unroll") for (int k = 0; k < 2; ++k) dst[m][k] = *(const LAS bf16x8*)(lds + PG8_SA(b, h) + aoff + m * 2048 + k * 1024); } while (0)
#define PG8_LDB(dst, b, h) do { _Pragma("unroll") for (int n = 0; n < 2; ++n) _Pragma("unroll") for (int k = 0; k < 2; ++k) dst[n][k] = *(const LAS bf16x8*)(lds + PG8_SB(b, h) + boff + n * 2048 + k * 1024); } while (0)
#define PG8_MMA(ai, bj, At, Bt) do { __builtin_amdgcn_s_setprio(1); _Pragma("unroll") for (int m = 0; m < 4; ++m) _Pragma("unroll") for (int n = 0; n < 2; ++n) _Pragma("unroll") for (int k = 0; k < 2; ++k) \
        acc[ai][bj][m][n] = __builtin_amdgcn_mfma_f32_16x16x32_bf16(Bt[n][k], At[m][k], acc[ai][bj][m][n], 0, 0, 0); __builtin_amdgcn_s_setprio(0); } while (0)
#define PG8_WAIT_V(n) asm volatile("s_waitcnt vmcnt(" #n ")" ::: "memory")
#define PG8_WAIT_L(n) asm volatile("s_waitcnt lgkmcnt(" #n ")" ::: "memory")
#define PG8_BAR __builtin_amdgcn_s_barrier()
#define PG8_SCHED __builtin_amdgcn_sched_barrier(0)
    Unit cur, nxt; int ui = 0;
    if (!S.next(0, cur)) return;
    f32x4 acc[2][2][4][2];
#pragma unroll
    for (int a = 0; a < 2; ++a)
#pragma unroll
        for (int b = 0; b < 2; ++b)
#pragma unroll
            for (int m = 0; m < 4; ++m)
#pragma unroll
                for (int n = 0; n < 2; ++n) acc[a][b][m][n] = (f32x4){0.f, 0.f, 0.f, 0.f};
    bf16x8 At[4][2], B0[2][2], B1[2][2];
    const char* cA = S.a_ptr(cur); const char* cB = S.b_ptr(cur);
    S.a_voff(cur, ld, sR, sC, voffA);
#define PG8_STAGE_A(bufoff, kbase, h, vo) do { if constexpr (GA) { PG8_STAGE(bufoff, kbase, (vo)[h]); } else { PG8_STAGE(bufoff, (kbase) + (h) * hstep, voffA[0]); } } while (0)
    PG8_STAGE(PG8_SB(0, 0), cB, voffB); PG8_STAGE(PG8_SB(0, 1), cB + hstepB, voffB); PG8_STAGE_A(PG8_SA(0, 0), cA, 0, voffA); PG8_STAGE_A(PG8_SA(0, 1), cA, 1, voffA);
    if (wr == 1) PG8_BAR;
    PG8_WAIT_V(2); PG8_BAR;
    PG8_STAGE(PG8_SB(1, 0), cB + kstepB, voffB); PG8_STAGE_A(PG8_SA(1, 0), cA + kstep, 0, voffA); PG8_STAGE(PG8_SB(1, 1), cB + hstepB + kstepB, voffB);
    PG8_WAIT_V(6); PG8_BAR;
    for (;;) {
        const bool has_next = S.next(ui + 1, nxt);
        const char* nA = has_next ? S.a_ptr(nxt) : cA; const char* nB = has_next ? S.b_ptr(nxt) : cB;
        if constexpr (GA) { if (has_next) S.a_voff(nxt, ld, sR, sC, voffAn);
            else {
#pragma unroll
                for (int h = 0; h < 2; ++h)
#pragma unroll
                    for (int i = 0; i < 2; ++i) voffAn[h][i] = voffA[h][i]; } }
#pragma unroll 1
        for (int t = 0; t < nt; t += 2) {
            const bool last = (t == nt - 2);
            const char* a1 = cA + (size_t)(t + 1) * kstep;
            const char* a2 = last ? nA : cA + (size_t)(t + 2) * kstep; const char* b2 = last ? nB : cB + (size_t)(t + 2) * kstepB;
            const char* a3 = a2 + kstep; const char* b3 = b2 + kstepB;
            unsigned vs[2][2];
            if constexpr (GA) {
#pragma unroll
                for (int i = 0; i < 2; ++i) { vs[0][i] = last ? voffAn[0][i] : voffA[0][i]; vs[1][i] = last ? voffAn[1][i] : voffA[1][i]; } }
            PG8_LDB(B0, 0, 0); PG8_LDB(B1, 0, 1); PG8_SCHED; PG8_LDA(At, 0, 0); PG8_STAGE_A(PG8_SA(1, 1), a1, 1, voffA);
            PG8_WAIT_V(8); PG8_WAIT_L(0); PG8_BAR; PG8_MMA(0, 0, At, B0); PG8_MMA(0, 1, At, B1); PG8_BAR; PG8_SCHED;
            PG8_LDA(At, 0, 1); PG8_STAGE(PG8_SB(0, 0), b2, voffB); PG8_STAGE(PG8_SB(0, 1), b2 + hstepB, voffB); PG8_STAGE_A(PG8_SA(0, 0), a2, 0, vs);
            PG8_WAIT_V(8); PG8_WAIT_L(0); PG8_BAR; PG8_MMA(1, 0, At, B0); PG8_MMA(1, 1, At, B1); PG8_BAR; PG8_SCHED;
            PG8_LDB(B0, 1, 0); PG8_LDB(B1, 1, 1); PG8_SCHED; PG8_LDA(At, 1, 0); PG8_STAGE_A(PG8_SA(0, 1), a2, 1, vs);
            PG8_WAIT_V(8); PG8_WAIT_L(0); PG8_BAR; PG8_MMA(0, 0, At, B0); PG8_MMA(0, 1, At, B1); PG8_BAR; PG8_SCHED;
            PG8_LDA(At, 1, 1); PG8_STAGE(PG8_SB(1, 0), b3, voffB); PG8_STAGE(PG8_SB(1, 1), b3 + hstepB, voffB); PG8_STAGE_A(PG8_SA(1, 0), a3, 0, vs);
            PG8_WAIT_V(8); PG8_WAIT_L(0); PG8_BAR; PG8_MMA(1, 0, At, B0); PG8_MMA(1, 1, At, B1); PG8_BAR; PG8_SCHED;
        }
        if constexpr (ALIGN_EPI) { if (wr == 0) PG8_BAR; }
        E(acc, cur, wr, wc, fr, fq);
        if (!has_next) break;
#pragma unroll
        for (int a = 0; a < 2; ++a)
#pragma unroll
            for (int b = 0; b < 2; ++b)
#pragma unroll
                for (int m = 0; m < 4; ++m)
#pragma unroll
                    for (int n = 0; n < 2; ++n) acc[a][b][m][n] = (f32x4){0.f, 0.f, 0.f, 0.f};
        cur = nxt; cA = nA; cB = nB; ++ui;
        if constexpr (GA) {
#pragma unroll
            for (int h = 0; h < 2; ++h)
#pragma unroll
                for (int i = 0; i < 2; ++i) voffA[h][i] = voffAn[h][i]; }
        if constexpr (ALIGN_EPI) { if (wr == 1) PG8_BAR; }
    }
    PG8_WAIT_V(0);
    if constexpr (!ALIGN_EPI) { if (wr == 0) PG8_BAR; }
    PG8_BAR;
#undef PG8_SA
#undef PG8_SB
#undef PG8_STAGE
#undef PG8_STAGE_A
#undef PG8_LDA
#undef PG8_LDB
#undef PG8_MMA
#undef PG8_WAIT_V
#undef PG8_WAIT_L
#undef PG8_BAR
#undef PG8_SCHED
}
}
using pg8::Unit;
using pg8::cvt_pk_bf16;

DI float bflo(unsigned w) { return __uint_as_float(w << 16); }
DI float bfhi(unsigned w) { return __uint_as_float(w & 0xffff0000u); }
DI float bf2f(bf16 b) { return __uint_as_float(((unsigned)b) << 16); }
typedef __bf16 hwbf2 __attribute__((ext_vector_type(2)));
DI unsigned pk2(float lo, float hi) { const f32x2 v = {lo, hi}; return __builtin_bit_cast(unsigned, __builtin_convertvector(v, hwbf2)); }
DI unsigned f2bf(float f) { return pk2(f, 0.f) & 0xffffu; }
DI float rcp_f(float x) { return __builtin_amdgcn_rcpf(x); }
DI float rsq_f(float x) { return __builtin_amdgcn_rsqf(x); }
DI float sigmoid_f(float x) { return rcp_f(1.0f + __expf(-x)); }
DI float tanh_fast(float x) { return 1.0f - 2.0f * rcp_f(__expf(2.0f * x) + 1.0f); }
DI float softplus_f(float x) { return fmaxf(x, 0.f) + __logf(1.0f + __expf(-fabsf(x))); }
DI float softplus_fast(float x) { return fmaxf(x, 0.f) + __logf(1.0f + __expf(-fabsf(x))); }
DI float gelu_tanh_f(float x) { const float u = 0.7978845608028654f * (x + 0.044715f * x * x * x); return 0.5f * x * (1.0f + tanh_fast(u)); }
DI float wave_sum(float v) {
#pragma unroll
    for (int o = 1; o < 64; o <<= 1) v += __shfl_xor(v, o);
    return v;
}

struct EpiBf16Plain {
    static constexpr bool PERM = true;
    bf16* O; int ldc; float scale;
    DI void operator()(const f32x4 (&acc)[2][2][4][2], const Unit& u, int wr, int wc, int fr, int fq) const {
        const int row0 = u.pm * 256 + wr * 64 + fr, col0 = u.pn * 256 + wc * 32 + 8 * fq;
#pragma unroll
        for (int ai = 0; ai < 2; ++ai)
#pragma unroll
            for (int m = 0; m < 4; ++m) { bf16* rowp = O + (size_t)(row0 + ai * 128 + m * 16) * ldc + col0;
#pragma unroll
                for (int bj = 0; bj < 2; ++bj) { const f32x4 v0 = acc[ai][bj][m][0] * scale, v1 = acc[ai][bj][m][1] * scale;
                    u32x4 w; w.x = cvt_pk_bf16(v0[0], v0[1]); w.y = cvt_pk_bf16(v0[2], v0[3]); w.z = cvt_pk_bf16(v1[0], v1[1]); w.w = cvt_pk_bf16(v1[2], v1[3]);
                    *(u32x4*)(rowp + bj * 128) = w; } }
    }
};
template <int MODE> struct EpiFold {
    static constexpr bool PERM = true;
    bf16* O;
    DI void operator()(const f32x4 (&acc)[2][2][4][2], const Unit& u, int wr, int wc, int fr, int fq) const {
        const int b = u.pm >> 2, h = u.pm & 3;
        const int rbase = MODE == 0 ? h * 256 : u.pn * 256, cbase = MODE == 0 ? u.pn * 256 : h * 256;
        const unsigned boff = (unsigned)b * 1024u * 1024u + (unsigned)(rbase + wr * 64 + fr) * 1024u + (unsigned)(cbase + wc * 32 + 8 * fq);
#pragma unroll
        for (int ai = 0; ai < 2; ++ai)
#pragma unroll
            for (int m = 0; m < 4; ++m) { bf16* rowp = O + (boff + (unsigned)(ai * 128 + m * 16) * 1024u);
#pragma unroll
                for (int bj = 0; bj < 2; ++bj) { const f32x4 v0 = acc[ai][bj][m][0], v1 = acc[ai][bj][m][1];
                    u32x4 w; w.x = cvt_pk_bf16(v0[0], v0[1]); w.y = cvt_pk_bf16(v0[2], v0[3]); w.z = cvt_pk_bf16(v1[0], v1[1]); w.w = cvt_pk_bf16(v1[2], v1[3]);
                    *(u32x4*)(rowp + bj * 128) = w; } }
    }
};
struct EpiSoftmax {
    static constexpr bool PERM = true;
    bf16* O; float scale; const float* RS; LAS float* XM; LAS float* XS;
    DI void operator()(const f32x4 (&acc)[2][2][4][2], const Unit& u, int wr, int wc, int fr, int fq) const {
        const int row0 = u.pm * 256 + wr * 64 + fr, col0 = u.pn * 256 + wc * 32 + 8 * fq;
        float sc[2][4];
#pragma unroll
        for (int ai = 0; ai < 2; ++ai)
#pragma unroll
            for (int m = 0; m < 4; ++m) { const int r = row0 + ai * 128 + m * 16; const f32x4* rp = (const f32x4*)(RS + (size_t)r * 16);
                const f32x4 p0 = rp[0], p1 = rp[1], p2 = rp[2], p3 = rp[3];
                const float ss = ((p0[0] + p0[1]) + (p0[2] + p0[3])) + ((p1[0] + p1[1]) + (p1[2] + p1[3])) + ((p2[0] + p2[1]) + (p2[2] + p2[3])) + ((p3[0] + p3[1]) + (p3[2] + p3[3]));
                sc[ai][m] = scale * __builtin_amdgcn_rsqf(ss * (1.0f / 1024.0f) + 1e-6f);
                float mm = -3.0e38f;
#pragma unroll
                for (int bj = 0; bj < 2; ++bj)
#pragma unroll
                    for (int n = 0; n < 2; ++n) { const f32x4 v = acc[ai][bj][m][n]; mm = fmaxf(mm, fmaxf(fmaxf(v[0], v[1]), fmaxf(v[2], v[3]))); }
                mm *= sc[ai][m];
                mm = fmaxf(mm, __shfl_xor(mm, 16)); mm = fmaxf(mm, __shfl_xor(mm, 32));
                if (fq == 0) XM[(ai * 128 + wr * 64 + m * 16 + fr) * 4 + wc] = mm; }
        asm volatile("s_waitcnt lgkmcnt(0)" ::: "memory"); __builtin_amdgcn_s_barrier(); asm volatile("" ::: "memory");
        f32x4 (&pa)[2][2][4][2] = const_cast<f32x4 (&)[2][2][4][2]>(acc);
#pragma unroll
        for (int ai = 0; ai < 2; ++ai)
#pragma unroll
            for (int m = 0; m < 4; ++m) { const int lr = ai * 128 + wr * 64 + m * 16 + fr; const f32x4 q = *(const LAS f32x4*)(XM + lr * 4);
                const float mxr = fmaxf(fmaxf(q[0], q[1]), fmaxf(q[2], q[3])); float sm = 0.f;
#pragma unroll
                for (int bj = 0; bj < 2; ++bj)
#pragma unroll
                    for (int n = 0; n < 2; ++n)
#pragma unroll
                        for (int j = 0; j < 4; ++j) { const float p = __expf(acc[ai][bj][m][n][j] * sc[ai][m] - mxr); pa[ai][bj][m][n][j] = p; sm += p; }
                sm += __shfl_xor(sm, 16); sm += __shfl_xor(sm, 32);
                if (fq == 0) XS[lr * 4 + wc] = sm; }
        asm volatile("s_waitcnt lgkmcnt(0)" ::: "memory"); __builtin_amdgcn_s_barrier(); asm volatile("" ::: "memory");
#pragma unroll
        for (int ai = 0; ai < 2; ++ai)
#pragma unroll
            for (int m = 0; m < 4; ++m) { const int lr = ai * 128 + wr * 64 + m * 16 + fr; const f32x4 q = *(const LAS f32x4*)(XS + lr * 4);
                const float inv = __builtin_amdgcn_rcpf((q[0] + q[1]) + (q[2] + q[3]));
                bf16* rowp = O + (size_t)(row0 + ai * 128 + m * 16) * 1024 + col0;
#pragma unroll
                for (int bj = 0; bj < 2; ++bj) { const f32x4 v0 = pa[ai][bj][m][0] * inv, v1 = pa[ai][bj][m][1] * inv;
                    u32x4 w; w.x = cvt_pk_bf16(v0[0], v0[1]); w.y = cvt_pk_bf16(v0[2], v0[3]); w.z = cvt_pk_bf16(v1[0], v1[1]); w.w = cvt_pk_bf16(v1[2], v1[3]);
                    *(u32x4*)(rowp + bj * 128) = w; } }
        asm volatile("s_waitcnt lgkmcnt(0)" ::: "memory"); __builtin_amdgcn_s_barrier(); asm volatile("" ::: "memory");
    }
};
struct EpiBf16RowNorm {
    static constexpr bool PERM = true;
    bf16* O; int ldc; float scale; const float* RS;
    DI void operator()(const f32x4 (&acc)[2][2][4][2], const Unit& u, int wr, int wc, int fr, int fq) const {
        const int row0 = u.pm * 256 + wr * 64 + fr, col0 = u.pn * 256 + wc * 32 + 8 * fq;
#pragma unroll
        for (int ai = 0; ai < 2; ++ai)
#pragma unroll
            for (int m = 0; m < 4; ++m) { const int r = row0 + ai * 128 + m * 16; const f32x4* rp = (const f32x4*)(RS + (size_t)r * 16);
                const f32x4 p0 = rp[0], p1 = rp[1], p2 = rp[2], p3 = rp[3];
                const float ss = ((p0[0] + p0[1]) + (p0[2] + p0[3])) + ((p1[0] + p1[1]) + (p1[2] + p1[3])) + ((p2[0] + p2[1]) + (p2[2] + p2[3])) + ((p3[0] + p3[1]) + (p3[2] + p3[3]));
                const float sc = scale * __builtin_amdgcn_rsqf(ss * (1.0f / 1024.0f) + 1e-6f);
                bf16* rowp = O + (size_t)r * ldc + col0;
#pragma unroll
                for (int bj = 0; bj < 2; ++bj) { const f32x4 v0 = acc[ai][bj][m][0] * sc, v1 = acc[ai][bj][m][1] * sc;
                    u32x4 w; w.x = cvt_pk_bf16(v0[0], v0[1]); w.y = cvt_pk_bf16(v0[2], v0[3]); w.z = cvt_pk_bf16(v1[0], v1[1]); w.w = cvt_pk_bf16(v1[2], v1[3]);
                    *(u32x4*)(rowp + bj * 128) = w; } }
    }
};
template <bool RES_BF16> struct EpiBf16Res {
    static constexpr bool PERM = true;
    const void* Rz; bf16* O; int ldc; float* RS;
    DI void operator()(const f32x4 (&acc)[2][2][4][2], const Unit& u, int wr, int wc, int fr, int fq) const {
        const int row0 = u.pm * 256 + wr * 64 + fr, col0 = u.pn * 256 + wc * 32 + 8 * fq;
#pragma unroll
        for (int ai = 0; ai < 2; ++ai)
#pragma unroll
            for (int m = 0; m < 4; ++m) { const size_t off = (size_t)(row0 + ai * 128 + m * 16) * ldc + col0; float ssq = 0.f;
#pragma unroll
                for (int bj = 0; bj < 2; ++bj) { f32x4 r0, r1;
                    if (RES_BF16) { const u32x4 rw = *(const u32x4*)((const bf16*)Rz + off + bj * 128); r0 = (f32x4){bflo(rw.x), bfhi(rw.x), bflo(rw.y), bfhi(rw.y)}; r1 = (f32x4){bflo(rw.z), bfhi(rw.z), bflo(rw.w), bfhi(rw.w)}; }
                    else { r0 = *(const f32x4*)((const float*)Rz + off + bj * 128); r1 = *(const f32x4*)((const float*)Rz + off + bj * 128 + 4); }
                    const f32x4 v0 = r0 + acc[ai][bj][m][0], v1 = r1 + acc[ai][bj][m][1];
                    ssq += (v0[0] * v0[0] + v0[1] * v0[1]) + (v0[2] * v0[2] + v0[3] * v0[3]) + (v1[0] * v1[0] + v1[1] * v1[1]) + (v1[2] * v1[2] + v1[3] * v1[3]);
                    u32x4 w; w.x = cvt_pk_bf16(v0[0], v0[1]); w.y = cvt_pk_bf16(v0[2], v0[3]); w.z = cvt_pk_bf16(v1[0], v1[1]); w.w = cvt_pk_bf16(v1[2], v1[3]);
                    *(u32x4*)(O + off + bj * 128) = w; }
                if (RS) { ssq += __shfl_xor(ssq, 16); ssq += __shfl_xor(ssq, 32); if (fq == 0) RS[(size_t)(row0 + ai * 128 + m * 16) * 16 + u.pn * 4 + wc] = ssq; } }
    }
};
struct EpiLora {
    static constexpr bool PERM = false;
    float* LWp; bf16* AAp; bf16* GGp; const float* w0; const float* a0;
    DI void operator()(const f32x4 (&acc)[2][2][4][2], const Unit& u, int wr, int wc, int fr, int fq) const {
        const int kind = u.pn >> 1;
        const int row0 = u.pm * 256 + wr * 64 + fr, col0 = (u.pn & 1) * 256 + wc * 32 + 4 * fq;
#pragma unroll
        for (int bj = 0; bj < 2; ++bj)
#pragma unroll
            for (int n = 0; n < 2; ++n) {
                const int c = col0 + bj * 128 + n * 16;
                f32x4 bias = (f32x4){0.f, 0.f, 0.f, 0.f};
                if (kind == 0) bias = *(const f32x4*)(w0 + c); else if (kind == 1) bias = *(const f32x4*)(a0 + c);
#pragma unroll
                for (int ai = 0; ai < 2; ++ai)
#pragma unroll
                    for (int m = 0; m < 4; ++m) {
                        f32x4 v = acc[ai][bj][m][n] + bias;
                        if (kind == 0) {
#pragma unroll
                            for (int j = 0; j < 4; ++j) { const float w = -softplus_fast(-v[j]) - 0.5f; v[j] = -__expf(w);     }
                        } else if (kind == 1) {
#pragma unroll
                            for (int j = 0; j < 4; ++j) v[j] = sigmoid_f(v[j]);
                        }
                        const size_t o_ = (size_t)(row0 + ai * 128 + m * 16) * 512 + c;
                        if (kind == 0) *(f32x4*)(LWp + o_) = v;
                        else { u32x2 w_; w_.x = cvt_pk_bf16(v[0], v[1]); w_.y = cvt_pk_bf16(v[2], v[3]); *(u32x2*)((kind == 1 ? AAp : GGp) + o_) = w_; }
                    }
            }
    }
};
struct EpiSwiglu {
    static constexpr bool PERM = true;
    bf16* ACT; const float* b_gu;
    DI void operator()(const f32x4 (&acc)[2][2][4][2], const Unit& u, int wr, int wc, int fr, int fq) const {
        const int row0 = u.pm * 256 + wr * 64 + fr, j0 = u.pn * 128 + wc * 32 + 8 * fq;
        const float* bg = b_gu + (size_t)u.e * 2048 + j0; const float* bu = bg + 1024;
        const f32x4 bg0 = *(const f32x4*)bg, bg1 = *(const f32x4*)(bg + 4), bu0 = *(const f32x4*)bu, bu1 = *(const f32x4*)(bu + 4);
#pragma unroll
        for (int ai = 0; ai < 2; ++ai)
#pragma unroll
            for (int m = 0; m < 4; ++m) {
                float o[8];
#pragma unroll
                for (int n = 0; n < 2; ++n) { const f32x4 g4 = acc[ai][0][m][n] + (n ? bg1 : bg0), u4 = acc[ai][1][m][n] + (n ? bu1 : bu0);
#pragma unroll
                    for (int j = 0; j < 4; ++j) { const float g = fminf(g4[j], 7.0f), up = fminf(fmaxf(u4[j], -7.0f), 7.0f); o[n * 4 + j] = (up + 1.0f) * (g * sigmoid_f(1.702f * g)); } }
                u32x4 w; w.x = cvt_pk_bf16(o[0], o[1]); w.y = cvt_pk_bf16(o[2], o[3]); w.z = cvt_pk_bf16(o[4], o[5]); w.w = cvt_pk_bf16(o[6], o[7]);
                *(u32x4*)(ACT + (size_t)(row0 + ai * 128 + m * 16) * 1024 + j0) = w;
            }
    }
};
struct EpiDown {
    static constexpr bool PERM = true;
    bf16* YS; const float* b_dn; const int* row_slot; const float* row_gate;
    DI void operator()(const f32x4 (&acc)[2][2][4][2], const Unit& u, int wr, int wc, int fr, int fq) const {
        const int row0 = u.pm * 256 + wr * 64 + fr, col0 = u.pn * 256 + wc * 32 + 8 * fq;
        const float* bb = b_dn + (size_t)u.e * 1024 + col0;
        f32x4 bv[2][2];
#pragma unroll
        for (int bj = 0; bj < 2; ++bj)
#pragma unroll
            for (int n = 0; n < 2; ++n) bv[bj][n] = *(const f32x4*)(bb + bj * 128 + 4 * n);
#pragma unroll
        for (int ai = 0; ai < 2; ++ai)
#pragma unroll
            for (int m = 0; m < 4; ++m) {
                const int r = row0 + ai * 128 + m * 16; const int slot = row_slot[r]; const float gt = row_gate[r];
                if (slot >= 0) { bf16* rowp = YS + (size_t)slot * 1024 + col0;
#pragma unroll
                    for (int bj = 0; bj < 2; ++bj) { const f32x4 v0 = (acc[ai][bj][m][0] + bv[bj][0]) * gt, v1 = (acc[ai][bj][m][1] + bv[bj][1]) * gt;
                        u32x4 w; w.x = cvt_pk_bf16(v0[0], v0[1]); w.y = cvt_pk_bf16(v0[2], v0[3]); w.z = cvt_pk_bf16(v1[0], v1[1]); w.w = cvt_pk_bf16(v1[2], v1[3]);
                        *(u32x4*)(rowp + bj * 128) = w; } }
            }
    }
};

constexpr size_t MiB = 1u << 20;
constexpr size_t WS_CTL = 0, CTL_ZERO_BYTES = 1 * MiB;
constexpr size_t WS_WIN = 1 * MiB, WS_WOUT = 7 * MiB, WS_WQ = 9 * MiB, WS_WK = 11 * MiB, WS_WV = 13 * MiB, WS_WO = 15 * MiB, WS_LORAB = 17 * MiB, WS_LRUW = 18 * MiB;
constexpr size_t WS_ROUTE = 19 * MiB;
constexpr size_t WS_WGU = 22 * MiB, WS_WDN = 150 * MiB;
constexpr size_t WS_HN = 214 * MiB, WS_MEMN = 246 * MiB, WS_KM = 248 * MiB, WS_VT = 250 * MiB;
constexpr size_t WS_X1 = 252 * MiB, WS_X2 = 316 * MiB;
constexpr size_t WS_U = 380 * MiB, WS_R = 468 * MiB, WS_KRAW = 500 * MiB, WS_V = 532 * MiB, WS_KKN = 564 * MiB, WS_WD = 596 * MiB, WS_AA = 628 * MiB, WS_G = 660 * MiB;
constexpr size_t WS_LA = 692 * MiB, WS_LB = 724 * MiB, WS_AP = 756 * MiB, WS_CAT = 764 * MiB, WS_Q = 796 * MiB;
constexpr size_t WS_XS = 380 * MiB, WS_ACT = 524 * MiB, WS_YS = 668 * MiB;
constexpr size_t WS_GP = 796 * MiB, WS_HF = 860 * MiB, WS_RP = 924 * MiB, WS_Y1F = 940 * MiB, WS_ADD = 972 * MiB, WS_END = 1004 * MiB;
constexpr size_t WS_GC = 468 * MiB, WS_HC = 484 * MiB, WS_ZS = 500 * MiB;
static_assert(WS_AA == WS_WD + 32 * MiB && WS_G == WS_AA + 32 * MiB, "EpiLora strides");
static_assert(WS_U + (size_t)M * INW * 2 <= WS_R && WS_XS + (size_t)MAXROWS * 2048 <= WS_ACT && WS_ACT + (size_t)MAXROWS * 2048 <= WS_YS && WS_YS + (size_t)NASSIGN * 2048 <= WS_Q, "ws map");
constexpr size_t RT_E = 0, RT_POS = 256 * 1024, RT_G = 512 * 1024, RT_SLOT = 768 * 1024, RT_GATE = 1088 * 1024, RT_TILE = 1408 * 1024, RT_TOK = 1472 * 1024;
constexpr int CW_BAR = 4096, CW_CNT = 8192, CW_CONV = 12288;

constexpr int RING_BYTES = 131072, MISC_OFF = RING_BYTES + 320, LDS_BYTES = 147456;
constexpr int NWAVES = 8, NTHREADS = 512;
constexpr int CONV_P9 = 10240;

#define XB_TMO      128
#define XB_XCNT(j)  (256  + 64 * (j))
#define XB_XSUB(j)  (1280 + 64 * (j))
#define XB_XGEN(j)  (2304 + 64 * (j))
#define XB_TOP      3328
#define XB_TOPGEN   3392
#define XCD_BAR_WORDS 3456
#define XB_SPIN_CAP (1u << 18)
DI unsigned xb_ld(unsigned* p)              { return __hip_atomic_load(p, __ATOMIC_RELAXED, __HIP_MEMORY_SCOPE_AGENT); }
DI unsigned xb_add(unsigned* p, unsigned v) { return __hip_atomic_fetch_add(p, v, __ATOMIC_RELAXED, __HIP_MEMORY_SCOPE_AGENT); }
DI unsigned xb_xcc_id() { return (unsigned)__builtin_amdgcn_s_getreg((3 << 11) | 20) & 0xFu; }
#define XB_SPIN(cond, bar) do { unsigned _sp = 0; while (cond) { __builtin_amdgcn_s_sleep(1); \
    if ((++_sp & 255u) == 0u) { if (xb_ld(&(bar)[XB_TMO])) break; if (_sp > XB_SPIN_CAP) { atomicAdd(&(bar)[XB_TMO], 1u); break; } } } } while (0)
struct XcdBarrier { unsigned* bar; unsigned x; volatile LAS unsigned* st; };
DI XcdBarrier xcd_barrier_post(unsigned* bar, volatile LAS unsigned* st) {
    XcdBarrier b; b.bar = bar; b.x = xb_xcc_id(); b.st = st;
    if (threadIdx.x == 0) (void)xb_add(&bar[XB_XCNT(b.x)], 1u);
    return b;
}
DI void xcd_barrier_complete(unsigned* bar, unsigned x, unsigned& nloc, unsigned& nx) {
    const unsigned G = gridDim.x * gridDim.y * gridDim.z;
    unsigned sum, cnt, mine, sp = 0u;
    for (;;) {
        sum = 0u; cnt = 0u; mine = 0u;
#pragma unroll
        for (unsigned j = 0; j < 16; ++j) { const unsigned c = xb_ld(&bar[XB_XCNT(j)]); sum += c; cnt += (c > 0u) ? 1u : 0u; mine = (j == x) ? c : mine; }
        if (sum == G) break;
        __builtin_amdgcn_s_sleep(1);
        if ((++sp & 255u) == 0u) { if (xb_ld(&bar[XB_TMO])) break; if (sp > XB_SPIN_CAP) { atomicAdd(&bar[XB_TMO], 1u); break; } }
    }
    nloc = mine > 0u ? mine : 1u; nx = cnt > 0u ? cnt : 1u;
}
DI void xcd_barrier(const XcdBarrier& b) {
    asm volatile("s_waitcnt vmcnt(0)" ::: "memory");
    __syncthreads();
    if (threadIdx.x == 0) {
        unsigned* bar = b.bar;
        __builtin_amdgcn_s_waitcnt(0);
        unsigned nloc = b.st[0], nx = b.st[1];
        if (nloc == 0u) { xcd_barrier_complete(bar, b.x, nloc, nx); b.st[0] = nloc; b.st[1] = nx; }
        const unsigned old = xb_add(&bar[XB_XSUB(b.x)], 1u);
        const unsigned gen = old / nloc;
        if (old + 1u == (gen + 1u) * nloc) {
            __builtin_amdgcn_fence(__ATOMIC_RELEASE, "agent");
            asm volatile("s_waitcnt vmcnt(0)" ::: "memory");
            const unsigned og = xb_add(&bar[XB_TOP], 1u);
            const unsigned tg = og / nx;
            if (og + 1u == (tg + 1u) * nx) xb_add(&bar[XB_TOPGEN], 1u);
            else XB_SPIN(xb_ld(&bar[XB_TOPGEN]) == tg, bar);
            __builtin_amdgcn_fence(__ATOMIC_ACQUIRE, "agent");
            xb_add(&bar[XB_XGEN(b.x)], 1u);
            asm volatile("s_waitcnt vmcnt(0)" ::: "memory");
        } else {
            XB_SPIN(xb_ld(&bar[XB_XGEN(b.x)]) == gen, bar);
            __builtin_amdgcn_fence(__ATOMIC_ACQUIRE, "agent");
            asm volatile("s_waitcnt vmcnt(0)" ::: "memory");
        }
    }
    __syncthreads();
}

struct Args { const float* in[37]; float* out; unsigned char* ws; int ph_lo, ph_hi; };
enum { I_X = 0, I_MEM, I_NMIXG, I_WIN, I_CONVW, I_CONVB, I_LWX, I_LBX, I_LWA, I_LBA, I_LAM, I_MU, I_W0, I_WUP, I_A0, I_AUP, I_GUP, I_KK, I_KA, I_RK, I_LNG, I_LNB,
       I_WOUT, I_NXAG, I_NMEMG, I_WQ, I_WK, I_WV, I_WO, I_NFFG, I_WR, I_BR, I_WGU, I_BGU, I_WDN, I_BDN, I_FNG };

DI void transpose_item(const float* W, int ldw, int K, bf16* WT, int k0, int n0, int drow0, LAS float* scr, int lane, const float* rs = nullptr) {
    f32x4 t[8];
    const float* src = W + (size_t)(k0 + (lane >> 3)) * ldw + n0 + 4 * (lane & 7);
#pragma unroll
    for (int i = 0; i < 8; ++i) t[i] = *(const f32x4*)(src + (size_t)(8 * i) * ldw);
#pragma unroll
    for (int i = 0; i < 8; ++i) { const float sc_ = rs ? rs[k0 + 8 * i + (lane >> 3)] : 1.0f; LAS float* d = scr + (8 * i + (lane >> 3)) * 33 + 4 * (lane & 7); d[0] = t[i].x * sc_; d[1] = t[i].y * sc_; d[2] = t[i].z * sc_; d[3] = t[i].w * sc_; }
    asm volatile("s_waitcnt lgkmcnt(0)" ::: "memory");
    const int c = lane & 7;
#pragma unroll
    for (int j = 0; j < 4; ++j) { const int n = (lane >> 3) + 8 * j; const LAS float* s = scr + (8 * c) * 33 + n;
        u32x4 o; o.x = pk2(s[0 * 33], s[1 * 33]); o.y = pk2(s[2 * 33], s[3 * 33]); o.z = pk2(s[4 * 33], s[5 * 33]); o.w = pk2(s[6 * 33], s[7 * 33]);
        *(u32x4*)(WT + (size_t)(drow0 + n) * K + k0 + 8 * c) = o; }
    asm volatile("s_waitcnt lgkmcnt(0)" ::: "memory");
}
DI void transpose_item_tiled(const float* W, int ldw, int K, bf16* WTe, int k0, int n0, int drow0, LAS float* scr, int lane) {
    f32x4 t[8];
    const float* src = W + (size_t)(k0 + (lane >> 3)) * ldw + n0 + 4 * (lane & 7);
#pragma unroll
    for (int i = 0; i < 8; ++i) t[i] = *(const f32x4*)(src + (size_t)(8 * i) * ldw);
#pragma unroll
    for (int i = 0; i < 8; ++i) { LAS float* d = scr + (8 * i + (lane >> 3)) * 33 + 4 * (lane & 7); d[0] = t[i].x; d[1] = t[i].y; d[2] = t[i].z; d[3] = t[i].w; }
    asm volatile("s_waitcnt lgkmcnt(0)" ::: "memory");
    const int c = lane & 7;
#pragma unroll
    for (int j = 0; j < 4; ++j) { const int n = (lane >> 3) + 8 * j; const LAS float* s = scr + (8 * c) * 33 + n;
        u32x4 o; o.x = pk2(s[0 * 33], s[1 * 33]); o.y = pk2(s[2 * 33], s[3 * 33]); o.z = pk2(s[4 * 33], s[5 * 33]); o.w = pk2(s[6 * 33], s[7 * 33]);
        const int drow = drow0 + n, pn = drow >> 8, half = (drow >> 7) & 1, r = drow & 127, x = r & 31;
        const int rslot = (r & ~31) + 16 * ((x >> 2) & 1) + 4 * (x >> 3) + (x & 3);
        const size_t tb = ((size_t)(pn * (K / 64) + (k0 >> 6)) * 2 + half) * 16384 + pg8::lds_byte(rslot, 8 * c);
        *(u32x4*)((char*)WTe + tb) = o; }
    asm volatile("s_waitcnt lgkmcnt(0)" ::: "memory");
}
DI void transpose_item_tiled_nolds(const float* W, int ldw, int K, bf16* WTe, int k0, int n0, int drow0, int lane) {
    const int n = lane & 31, kh = lane >> 5;
    const float* src = W + (size_t)(k0 + 32 * kh) * ldw + n0 + n;
    float t[32];
#pragma unroll
    for (int i = 0; i < 32; ++i) t[i] = src[(size_t)i * ldw];
    const int drow = drow0 + n, pn = drow >> 8, half = (drow >> 7) & 1, r = drow & 127, x = r & 31;
    const int rslot = (r & ~31) + 16 * ((x >> 2) & 1) + 4 * (x >> 3) + (x & 3);
    const size_t tb0 = ((size_t)(pn * (K / 64) + (k0 >> 6)) * 2 + half) * 16384;
#pragma unroll
    for (int c = 0; c < 4; ++c) { u32x4 o; o.x = pk2(t[8 * c], t[8 * c + 1]); o.y = pk2(t[8 * c + 2], t[8 * c + 3]); o.z = pk2(t[8 * c + 4], t[8 * c + 5]); o.w = pk2(t[8 * c + 6], t[8 * c + 7]);
        *(u32x4*)((char*)WTe + tb0 + pg8::lds_byte(rslot, 32 * kh + 8 * c)) = o; }
}
DI void rms_row_to_bf16(const float* xrow, const float* g, bf16* orow, int lane) {
    const f32x4* xr = (const f32x4*)xrow + lane; const f32x4* gr = (const f32x4*)g + lane;
    f32x4 v[4]; float s = 0.f;
#pragma unroll
    for (int j = 0; j < 4; ++j) { v[j] = xr[64 * j]; s += (v[j].x * v[j].x + v[j].y * v[j].y) + (v[j].z * v[j].z + v[j].w * v[j].w); }
    const float rstd = rsq_f(wave_sum(s) * (1.f / D) + EPS);
    u32x2* o8 = (u32x2*)orow + lane;
#pragma unroll
    for (int j = 0; j < 4; ++j) { const f32x4 gg = gr[64 * j]; u32x2 w; w.x = pk2(v[j].x * rstd * gg.x, v[j].y * rstd * gg.y); w.y = pk2(v[j].z * rstd * gg.z, v[j].w * rstd * gg.w); o8[64 * j] = w; }
}

DI void rms_rowbf_to_bf16(const bf16* xrow, const float* g, bf16* orow, int lane) {
    float v[16]; float s = 0.f;
#pragma unroll
    for (int hf = 0; hf < 2; ++hf) { const u32x4 w = *(const u32x4*)(xrow + 512 * hf + 8 * lane);
#pragma unroll
        for (int q = 0; q < 4; ++q) { v[8 * hf + 2 * q] = bflo(w[q]); v[8 * hf + 2 * q + 1] = bfhi(w[q]); } }
#pragma unroll
    for (int j = 0; j < 16; ++j) s += v[j] * v[j];
    const float rstd = rsq_f(wave_sum(s) * (1.f / D) + EPS);
#pragma unroll
    for (int hf = 0; hf < 2; ++hf) { const f32x4 g0 = *(const f32x4*)(g + 512 * hf + 8 * lane), g1 = *(const f32x4*)(g + 512 * hf + 8 * lane + 4);
        u32x4 w; w.x = pk2(v[8 * hf] * rstd * g0.x, v[8 * hf + 1] * rstd * g0.y); w.y = pk2(v[8 * hf + 2] * rstd * g0.z, v[8 * hf + 3] * rstd * g0.w);
        w.z = pk2(v[8 * hf + 4] * rstd * g1.x, v[8 * hf + 5] * rstd * g1.y); w.w = pk2(v[8 * hf + 6] * rstd * g1.z, v[8 * hf + 7] * rstd * g1.w);
        *(u32x4*)(orow + 512 * hf + 8 * lane) = w; }
}

__global__ void __launch_bounds__(NTHREADS, 2) fwd(Args args) {
    extern __shared__ __attribute__((aligned(16))) unsigned char lds_raw[];
    LAS unsigned char* lds = (LAS unsigned char*)lds_raw;
    volatile LAS unsigned* MISC = (volatile LAS unsigned*)(lds + MISC_OFF);
    const int G = gridDim.x, bid = blockIdx.x, NGW = G * NWAVES;
#define PHASE_IDS const int tid = fresh_tid(), lane = tid & 63, wave = __builtin_amdgcn_readfirstlane(tid >> 6), gw = bid * NWAVES + wave; (void)tid; (void)lane; (void)wave; (void)gw
    unsigned char* ws = args.ws;
    unsigned* ctl = (unsigned*)(ws + WS_CTL);
    const int lo = args.ph_lo, hi = args.ph_hi;

    for (int u = threadIdx.x; u < (LDS_BYTES - RING_BYTES) / 4; u += NTHREADS) ((LAS unsigned*)(lds + RING_BYTES))[u] = 0u;
    __syncthreads();
    XcdBarrier bar; bar.bar = ctl + CW_BAR; bar.x = 0; bar.st = nullptr;
    if (hi - lo > 1) bar = xcd_barrier_post(ctl + CW_BAR, MISC + 8);
#define IN(k) (lo <= (k) && (k) < hi)
#define SEAM(k) do { if (IN(k) && IN((k) + 1)) xcd_barrier(bar); } while (0)

#define Win_t ((bf16*)(ws + WS_WIN))
#define Wout_t ((bf16*)(ws + WS_WOUT))
#define Wq_t ((bf16*)(ws + WS_WQ))
#define Wk_t ((bf16*)(ws + WS_WK))
#define Wv_t ((bf16*)(ws + WS_WV))
#define Wo_t ((bf16*)(ws + WS_WO))
#define LoraB ((bf16*)(ws + WS_LORAB))
#define LruW ((bf16*)(ws + WS_LRUW))
#define WrT ((bf16*)(ws + WS_LRUW + 512 * 1024))
#define Wgu_t ((bf16*)(ws + WS_WGU))
#define Wdn_t ((bf16*)(ws + WS_WDN))
#define HN ((bf16*)(ws + WS_HN))
#define MEMN ((bf16*)(ws + WS_MEMN))
#define KM ((bf16*)(ws + WS_KM))
#define VT ((bf16*)(ws + WS_VT))
#define X1 ((bf16*)(ws + WS_X1))
#define X2 ((bf16*)(ws + WS_X2))
#define U ((bf16*)(ws + WS_U))
#define Rr ((float*)(ws + WS_R))
#define KRAW ((float*)(ws + WS_KRAW))
#define Vv ((float*)(ws + WS_V))
#define KKN ((float*)(ws + WS_KKN))
#define WD ((float*)(ws + WS_WD))
#define AA ((float*)(ws + WS_AA))
#define GG ((float*)(ws + WS_G))
#define LA ((bf16*)(ws + WS_LA))
#define LB ((bf16*)(ws + WS_LB))
#define AP ((bf16*)(ws + WS_AP))
#define CAT ((bf16*)(ws + WS_CAT))
#define Qb ((bf16*)(ws + WS_Q))
#define Ob CAT
#define XS ((bf16*)(ws + WS_XS))
#define ACT ((bf16*)(ws + WS_ACT))
#define YS ((bf16*)(ws + WS_YS))
#define route_e ((int*)(ws + WS_ROUTE + RT_E))
#define route_pos ((int*)(ws + WS_ROUTE + RT_POS))
#define route_g ((float*)(ws + WS_ROUTE + RT_G))
#define row_slot ((int*)(ws + WS_ROUTE + RT_SLOT))
#define row_gate ((float*)(ws + WS_ROUTE + RT_GATE))
#define tile_tab ((int*)(ws + WS_ROUTE + RT_TILE))
#define row_tok ((int*)(ws + WS_ROUTE + RT_TOK))
#define ecnt (ctl + CW_CNT)

    if (IN(0)) { PHASE_IDS;
        LAS float* scr = (LAS float*)(lds + wave * 16384);
        constexpr int I_IN = 16 * (INW / 32), I_SQ = 16 * 32;
        constexpr int N_ITEMS = I_IN + 5 * I_SQ;
        for (int it = gw; it < N_ITEMS; it += NGW) {
            int r = it;
            if (r < I_IN) { const int nblk = INW / 32, kb = r / nblk, nb = r % nblk; transpose_item(args.in[I_WIN], INW, D, Win_t, 64 * kb, 32 * nb, 32 * nb, scr, lane); continue; } r -= I_IN;
            { const int w = r / I_SQ, q = r % I_SQ, kb = q / 32, nb = q % 32;
                if (w == 1) continue;
                const float* src = w == 0 ? args.in[I_WOUT] : w == 2 ? args.in[I_WK] : w == 3 ? args.in[I_WV] : args.in[I_WO];
                bf16* dst = w == 0 ? Wout_t : w == 2 ? Wk_t : w == 3 ? Wv_t : Wo_t;
                transpose_item(src, D, D, dst, 64 * kb, 32 * nb, 32 * nb, scr, lane); }
        }
        for (int idx = bid * NTHREADS + tid; idx < D * D / 4; idx += G * NTHREADS) { const f32x4 v = ((const f32x4*)args.in[I_WQ])[idx]; const float gk = args.in[I_NXAG][idx >> 8];
            u32x2 w; w.x = pk2(v.x * gk, v.y * gk); w.y = pk2(v.z * gk, v.w * gk); ((u32x2*)Wq_t)[idx] = w; }
        for (int idx = bid * NTHREADS + tid; idx < 1536 * 256; idx += G * NTHREADS) {
            const int e = idx & 7, ln = (idx >> 3) & 63, ks = (idx >> 9) & 7, ct = (idx >> 12) & 3, hk = idx >> 14, hh = hk / 3, kind = hk - 3 * hh;
            const int k = 32 * ks + 8 * (ln >> 4) + e, n = hh * 64 + 16 * ct + (ln & 15); float v = 0.f;
            if (kind == 0) { if (k < 64) v = args.in[I_WUP][k * 512 + n]; }
            else if (kind == 1) { if (k >= 64 && k < 128) v = args.in[I_AUP][(k - 64) * 512 + n]; }
            else { if (k >= 128) v = args.in[I_GUP][(k - 128) * 512 + n]; }
            LoraB[idx] = (bf16)f2bf(v);
        }
        for (int idx = bid * NTHREADS + tid; idx < 8 * 128 * 64; idx += G * NTHREADS) {
            const int nb = idx >> 13, col = (idx >> 6) & 127, k = idx & 63;
            const float v = col < 64 ? args.in[I_LWX][nb * 4096 + k * 64 + col] : args.in[I_LWA][nb * 4096 + k * 64 + (col - 64)];
            LruW[idx] = (bf16)f2bf(v);
        }
        for (int idx = bid * NTHREADS + tid; idx < NE * D; idx += G * NTHREADS) {
            const int e = idx >> 10, k = idx & 1023; const float v = args.in[I_WR][k * NE + e];
            const unsigned hi = f2bf(v); const float lo = v - __uint_as_float(hi << 16);
            WrT[idx] = (bf16)hi; WrT[NE * D + idx] = (bf16)f2bf(lo);
        }
        for (int m = gw; m < M; m += NGW) rms_row_to_bf16(args.in[I_X] + (size_t)m * D, args.in[I_NMIXG], HN + (size_t)m * D, lane);
        for (int m = gw; m < MROWS; m += NGW) rms_row_to_bf16(args.in[I_MEM] + (size_t)m * D, args.in[I_NMEMG], MEMN + (size_t)m * D, lane);
        {
            LAS float* scr = (LAS float*)(lds + wave * 16384);
            constexpr int I_GU = 16 * 64, I_DN = 16 * 32;
            for (int it = CONV_P9 + gw; it < NE * I_GU; it += NGW) {
                int r = it;
                if (r < NE * I_GU) { const int e = r / I_GU, q = r % I_GU, kb = q / 64, nb = q % 64; const int n0 = 32 * nb;
                    const int drow = n0 < 1024 ? (256 * (n0 >> 7) + (n0 & 127)) : (256 * ((n0 - 1024) >> 7) + 128 + ((n0 - 1024) & 127));
                    transpose_item_tiled(args.in[I_WGU] + (size_t)e * D * 2048, 2048, D, Wgu_t + (size_t)e * 2048 * D, 64 * kb, n0, drow, scr, lane); continue; } r -= NE * I_GU;
                { const int e = r / I_DN, q = r % I_DN, kb = q / 32, nb = q % 32;
                  transpose_item_tiled(args.in[I_WDN] + (size_t)e * DFF * D, D, DFF, Wdn_t + (size_t)e * D * DFF, 64 * kb, 32 * nb, 32 * nb, scr, lane); }
            }
        }
    }
    SEAM(0);

    if (IN(1)) { PHASE_IDS;
        { pg8::DenseSched S; S.o.init_tiles(M / 256, INW / 256, G, bid); S.A = (const char*)HN; S.B = (const char*)Win_t; S.tstep = (size_t)256 * D * 2;
          EpiBf16Plain E{U, INW, 1.0f}; pg8::gemm_phase(lds, D, S, E); }
        { pg8::DenseSched S; S.o.init_tiles(MROWS / 256, D / 256, G, (bid + 64) & (G - 1)); S.A = (const char*)MEMN; S.B = (const char*)Wk_t; S.tstep = (size_t)256 * D * 2;
          EpiBf16Plain E{KM, D, 1.0f}; pg8::gemm_phase(lds, D, S, E); }
        { pg8::DenseSched S; S.o.init_tiles(MROWS / 256, D / 256, G, (bid + 48) & (G - 1)); S.A = (const char*)MEMN; S.B = (const char*)Wv_t; S.tstep = (size_t)256 * D * 2;
          EpiBf16Plain E{VT, D, 1.0f}; pg8::gemm_phase(lds, D, S, E); }
    }
    SEAM(1);

    if (IN(2)) { PHASE_IDS;
        {
            const float* conv_w = args.in[I_CONVW]; const float* conv_b = args.in[I_CONVB]; const float* bx = args.in[I_LBX]; const float* ba = args.in[I_LBA]; const float* lam = args.in[I_LAM];
            LAS float* xs = (LAS float*)(lds + wave * 4096);
            const int i = lane & 15, kg = lane >> 4;
            for (int unit = gw; unit < (M / 16) * 2; unit += NGW) {
                const int tile = unit >> 1, nb0 = (unit & 1) * 4, m0 = tile * 16, s0 = m0 & (SEQ - 1);
                for (int nb = nb0; nb < nb0 + 4; ++nb) {
                    bf16x8 af[2];
#pragma unroll
                    for (int ks = 0; ks < 2; ++ks) {
                        const int chb = nb * 64 + 32 * ks + 8 * kg;
                        f32x4 x0 = *(const f32x4*)(conv_b + chb), x1 = *(const f32x4*)(conv_b + chb + 4);
#pragma unroll
                        for (int j = 0; j < 4; ++j) {
                            {
                                const bool ok = s0 + i - 3 + j >= 0;
                                u32x4 uw = *(const u32x4*)(U + (size_t)(ok ? m0 + i - 3 + j : m0) * INW + chb); if (!ok) uw = (u32x4){0u, 0u, 0u, 0u};
                                const f32x4 w0 = *(const f32x4*)(conv_w + j * 512 + chb), w1 = *(const f32x4*)(conv_w + j * 512 + chb + 4);
                                x0.x += w0.x * bflo(uw.x); x0.y += w0.y * bfhi(uw.x); x0.z += w0.z * bflo(uw.y); x0.w += w0.w * bfhi(uw.y);
                                x1.x += w1.x * bflo(uw.z); x1.y += w1.y * bfhi(uw.z); x1.z += w1.z * bflo(uw.w); x1.w += w1.w * bfhi(uw.w);
                            }
                        }
                        *(LAS f32x4*)(xs + i * 64 + 32 * ks + 8 * kg) = x0; *(LAS f32x4*)(xs + i * 64 + 32 * ks + 8 * kg + 4) = x1;
                        u32x4 p; p.x = pk2(x0.x, x0.y); p.y = pk2(x0.z, x0.w); p.z = pk2(x1.x, x1.y); p.w = pk2(x1.z, x1.w);
                        af[ks] = __builtin_bit_cast(bf16x8, p);
                    }
                    f32x4 acc[8];
#pragma unroll
                    for (int ct = 0; ct < 8; ++ct) { acc[ct] = (f32x4){0.f, 0.f, 0.f, 0.f};
#pragma unroll
                        for (int ks = 0; ks < 2; ++ks) { const bf16x8 bfr = *(const bf16x8*)(LruW + ((size_t)(nb * 128 + 16 * ct + i) * 64 + 32 * ks + 8 * kg));
                            acc[ct] = __builtin_amdgcn_mfma_f32_16x16x32_bf16(af[ks], bfr, acc[ct], 0, 0, 0); } }
                    asm volatile("s_waitcnt lgkmcnt(0)" ::: "memory");
#pragma unroll
                    for (int ct = 0; ct < 4; ++ct) {
                        const int col = 16 * ct + i, ch = nb * 64 + col;
                        const float bxv = bx[ch], bav = ba[ch], sp = softplus_f(-lam[ch]);
#pragma unroll
                        for (int e = 0; e < 4; ++e) {
                            const int tok = 4 * kg + e;
                            const float gx = sigmoid_f(acc[ct][e] + bxv), ga = sigmoid_f(acc[ct + 4][e] + bav);
                            const float la = -8.0f * ga * sp, xcv = xs[tok * 64 + col];
                            const float bt = __builtin_amdgcn_sqrtf(fmaxf(1.0f - __expf(2.0f * la), 0.f)) * gx * xcv;
                            LA[(size_t)(m0 + tok) * 512 + ch] = (bf16)f2bf(la); LB[(size_t)(m0 + tok) * 512 + ch] = (bf16)f2bf(bt);
                        }
                    }
                }
            }
        }
    }
    SEAM(2);


#define RW_ZB(zz, zb) do { _Pragma("unroll") for (int ks_ = 0; ks_ < 2; ++ks_) { u32x4 p_; p_.x = pk2(zz[2 * ks_][0], zz[2 * ks_][1]); p_.y = pk2(zz[2 * ks_][2], zz[2 * ks_][3]); \
        p_.z = pk2(zz[2 * ks_ + 1][0], zz[2 * ks_ + 1][1]); p_.w = pk2(zz[2 * ks_ + 1][2], zz[2 * ks_ + 1][3]); zb[ks_] = __builtin_bit_cast(bf16x8, p_); } } while (0)
    if (IN(3)) { PHASE_IDS;
        for (int u64 = gw; u64 < NB * NH * (SEQ / 64); u64 += NGW) {
#pragma unroll 1
        for (int jj = 0; jj < 4; ++jj) {
        LAS unsigned char* wl = lds + wave * 16384;
        LAS bf16* Arm = (LAS bf16*)(wl); LAS bf16* Brm = (LAS bf16*)(wl + 2048); LAS bf16* Krm = (LAS bf16*)(wl + 4096); LAS bf16* Rrm = (LAS bf16*)(wl + 6144);
        LAS bf16* ATt = (LAS bf16*)(wl + 8192); LAS bf16* BTt = (LAS bf16*)(wl + 10240); LAS bf16* KTt = (LAS bf16*)(wl + 12288); LAS bf16* VTt = (LAS bf16*)(wl + 14336);
        LAS float* MabT = (LAS float*)(wl); LAS bf16* Mak = (LAS bf16*)(wl + 1024); LAS bf16* Mrb = (LAS bf16*)(wl + 1536); LAS bf16* Mrk = (LAS bf16*)(wl + 2048); LAS bf16* Tm = (LAS bf16*)(wl + 2560);
        LAS float* PLs = (LAS float*)(wl + 3072); LAS bf16* Q0T = (LAS bf16*)(wl + 4096);
        const int lane = fresh_tid() & 63, l15 = lane & 15, g = lane >> 4, te = lane >> 2, kq = lane & 3;
        const bf16x8 z8 = (bf16x8){0, 0, 0, 0, 0, 0, 0, 0};
        const f32x4 z4 = (f32x4){0.f, 0.f, 0.f, 0.f};
            const int un = u64 * 4 + jj;
            const int bh = un >> 8, c = un & 255, b = bh >> 3, h = bh & 7;
            const size_t mrow = (size_t)b * SEQ + c * 16 + te, off = mrow * 512 + h * 64 + 16 * kq;
            const int hc = h * 64 + 16 * kq;
            LAS float* tmpL = (LAS float*)wl;
            {
                const int rsub = lane >> 5, chunk = lane & 31; const size_t mt0 = (size_t)b * SEQ + c * 16;
                const f32x4 m0 = *(const f32x4*)(args.in[I_MU] + 1536 + 8 * chunk), m1 = *(const f32x4*)(args.in[I_MU] + 1536 + 8 * chunk + 4);
                u32x4 cu[8], pu[8];
#pragma unroll
                for (int i = 0; i < 8; ++i) { const size_t mr = mt0 + 2 * i + rsub; const bool hp2 = (mr & (SEQ - 1)) != 0; const bf16* ua = U + mr * INW + 2560 + 8 * chunk;
                    cu[i] = *(const u32x4*)ua; pu[i] = *(const u32x4*)(ua - (hp2 ? INW : 0)); if (!hp2) pu[i] = (u32x4){0u, 0u, 0u, 0u}; }
#pragma unroll
                for (int i = 0; i < 8; ++i) { float o8[8];
#pragma unroll
                    for (int q = 0; q < 4; ++q) { const float c0 = bflo(cu[i][q]), c1 = bfhi(cu[i][q]), p0 = bflo(pu[i][q]), p1 = bfhi(pu[i][q]); const float mm0 = q < 2 ? m0[2 * q] : m1[2 * q - 4], mm1 = q < 2 ? m0[2 * q + 1] : m1[2 * q - 3];
                        float x0 = c0 + (p0 - c0) * mm0, x1 = c1 + (p1 - c1) * mm1;
                        if (chunk < 8) { x0 = tanh_fast(x0); x1 = tanh_fast(x1); }
                        else if (chunk >= 16) { x0 = sigmoid_f(x0); x1 = sigmoid_f(x1); }
                        o8[2 * q] = x0; o8[2 * q + 1] = x1; }
                    u32x4 pw; pw.x = pk2(o8[0], o8[1]); pw.y = pk2(o8[2], o8[3]); pw.z = pk2(o8[4], o8[5]); pw.w = pk2(o8[6], o8[7]);
                    const int row = 2 * i + rsub; *(LAS u32x4*)(wl + row * 512 + ((chunk ^ (row & 7)) << 4)) = pw; }
                bf16x8 af[8];
#pragma unroll
                for (int ks = 0; ks < 8; ++ks) af[ks] = *(const LAS bf16x8*)(wl + l15 * 512 + (((4 * ks + g) ^ (l15 & 7)) << 4));
                asm volatile("s_waitcnt lgkmcnt(0)" ::: "memory");
#pragma unroll
                for (int kind = 0; kind < 3; ++kind)
#pragma unroll
                    for (int ct = 0; ct < 4; ++ct) {
                        const bf16* lb = LoraB + ((size_t)((h * 3 + kind) * 4 + ct) * 8 * 64 + lane) * 8;
                        f32x4 a4 = z4;
#pragma unroll
                        for (int ks = (kind == 0 ? 0 : kind == 1 ? 2 : 4); ks < (kind == 0 ? 2 : kind == 1 ? 4 : 8); ++ks) a4 = __builtin_amdgcn_mfma_f32_16x16x32_bf16(af[ks], *(const bf16x8*)(lb + ks * 512), a4, 0, 0, 0);
#pragma unroll
                        for (int e = 0; e < 4; ++e) tmpL[kind * 1088 + (4 * g + e) * 68 + 16 * ct + l15] = a4[e];
                    }
            }
            asm volatile("s_waitcnt lgkmcnt(0)" ::: "memory");
            float cl[16], eP[16];
            {
                float lwv[16], rl[16], kl[16], vl[16], kn[16], av[16];
                const bool hp = (mrow & (SEQ - 1)) != 0;
                const bf16* ub = U + mrow * INW + 1024 + hc;
#pragma unroll
                for (int hh = 0; hh < 2; ++hh) {
#pragma unroll
                    for (int a3 = 0; a3 < 3; ++a3) {
                        const u32x4 cu = *(const u32x4*)(ub + 512 * a3 + 8 * hh); u32x4 pu = *(const u32x4*)(ub - (hp ? INW : 0) + 512 * a3 + 8 * hh); if (!hp) pu = (u32x4){0u, 0u, 0u, 0u};
                        const f32x4 m0 = *(const f32x4*)(args.in[I_MU] + 512 * a3 + hc + 8 * hh), m1 = *(const f32x4*)(args.in[I_MU] + 512 * a3 + hc + 8 * hh + 4);
                        float o8[8];
#pragma unroll
                        for (int q = 0; q < 4; ++q) { const float c0 = bflo(cu[q]), c1 = bfhi(cu[q]), p0 = bflo(pu[q]), p1 = bfhi(pu[q]); const float mm0 = q < 2 ? m0[2 * q] : m1[2 * q - 4], mm1 = q < 2 ? m0[2 * q + 1] : m1[2 * q - 3];
                            o8[2 * q] = c0 + (p0 - c0) * mm0; o8[2 * q + 1] = c1 + (p1 - c1) * mm1; }
#pragma unroll
                        for (int q = 0; q < 8; ++q) { if (a3 == 0) rl[8 * hh + q] = o8[q]; else if (a3 == 1) kl[8 * hh + q] = o8[q]; else vl[8 * hh + q] = o8[q]; }
                    }
                }
                float gv[16];
#pragma unroll
                for (int j4 = 0; j4 < 4; ++j4) { const f32x4 xl = *(const LAS f32x4*)(tmpL + te * 68 + 16 * kq + 4 * j4), xa = *(const LAS f32x4*)(tmpL + 1088 + te * 68 + 16 * kq + 4 * j4), xg = *(const LAS f32x4*)(tmpL + 2176 + te * 68 + 16 * kq + 4 * j4);
                    const f32x4 w0v = *(const f32x4*)(args.in[I_W0] + hc + 4 * j4), a0v = *(const f32x4*)(args.in[I_A0] + hc + 4 * j4);
#pragma unroll
                    for (int q = 0; q < 4; ++q) { const float wq = -softplus_fast(-(xl[q] + w0v[q])) - 0.5f; lwv[4 * j4 + q] = -__expf(wq); av[4 * j4 + q] = sigmoid_f(xa[q] + a0v[q]); gv[4 * j4 + q] = xg[q]; } }
                asm volatile("s_waitcnt lgkmcnt(0)" ::: "memory");
                float ss = 0.f;
#pragma unroll
                for (int j4 = 0; j4 < 4; ++j4) { const f32x4 kk4 = *(const f32x4*)(args.in[I_KK] + hc + 4 * j4);
#pragma unroll
                    for (int q = 0; q < 4; ++q) { kn[4 * j4 + q] = kl[4 * j4 + q] * kk4[q]; ss += kn[4 * j4 + q] * kn[4 * j4 + q]; } }
                ss += __shfl_xor(ss, 1); ss += __shfl_xor(ss, 2);
                const float kinv = rsq_f(fmaxf(ss, 1e-24f));
#pragma unroll
                for (int j = 0; j < 16; ++j) { float x = lwv[j];
#pragma unroll
                    for (int sft = 4; sft < 64; sft <<= 1) { const float y = __shfl_up(x, sft); if (lane >= sft) x += y; }
                    cl[j] = x; }
                float bon = 0.f;
                u32x4 pa[2], pb[2], pk[2], pr[2];
#pragma unroll
                for (int j4 = 0; j4 < 4; ++j4) {
                    const f32x4 ka = *(const f32x4*)(args.in[I_KA] + hc + 4 * j4), rk = *(const f32x4*)(args.in[I_RK] + hc + 4 * j4);
                    float at4[4], bt4[4], kt4[4], rt4[4];
#pragma unroll
                    for (int q = 0; q < 4; ++q) { const int j = 4 * j4 + q;
                        const float p = __expf(cl[j]), pn = __expf(-cl[j]), pm1 = __expf(cl[j] - lwv[j]); eP[j] = p;
                        const float knj = kn[j] * kinv;
                        const float kp = kl[j] * (1.0f + (av[j] - 1.0f) * ka[q]);
                        at4[q] = -knj * pm1; bt4[q] = knj * av[j] * pn; kt4[q] = kp * pn; rt4[q] = rl[j] * p;
                        bon += rl[j] * kp * rk[q];
                        const int kk = 16 * kq + j;
                        ATt[kk * 16 + te] = (bf16)f2bf(at4[q]); BTt[kk * 16 + te] = (bf16)f2bf(bt4[q]); KTt[kk * 16 + te] = (bf16)f2bf(kt4[q]); VTt[kk * 16 + te] = (bf16)f2bf(vl[j]); }
                    const int hh = j4 >> 1, w2 = (j4 & 1) * 2;
                    pa[hh][w2] = pk2(at4[0], at4[1]); pa[hh][w2 + 1] = pk2(at4[2], at4[3]); pb[hh][w2] = pk2(bt4[0], bt4[1]); pb[hh][w2 + 1] = pk2(bt4[2], bt4[3]);
                    pk[hh][w2] = pk2(kt4[0], kt4[1]); pk[hh][w2 + 1] = pk2(kt4[2], kt4[3]); pr[hh][w2] = pk2(rt4[0], rt4[1]); pr[hh][w2 + 1] = pk2(rt4[2], rt4[3]);
                }
#pragma unroll
                for (int hh = 0; hh < 2; ++hh) { const int po = te * 64 + 8 * ((2 * kq + hh) ^ (te & 7));
                    *(LAS u32x4*)(Arm + po) = pa[hh]; *(LAS u32x4*)(Brm + po) = pb[hh]; *(LAS u32x4*)(Krm + po) = pk[hh]; *(LAS u32x4*)(Rrm + po) = pr[hh]; }
                bon += __shfl_xor(bon, 1); bon += __shfl_xor(bon, 2);
                f32x4 lbv[4], lgv[4];
#pragma unroll
                for (int j4 = 0; j4 < 4; ++j4) { lbv[j4] = *(const f32x4*)(args.in[I_LNB] + hc + 4 * j4); lgv[j4] = *(const f32x4*)(args.in[I_LNG] + hc + 4 * j4); }
#pragma unroll
                for (int j4 = 0; j4 < 4; ++j4) { const f32x4 lb = lbv[j4], lgn = lgv[j4]; const int j0 = 4 * j4;
                    u32x2 ow, gw2; ow.x = pk2((lb.x + vl[j0] * bon) * gv[j0], (lb.y + vl[j0 + 1] * bon) * gv[j0 + 1]); ow.y = pk2((lb.z + vl[j0 + 2] * bon) * gv[j0 + 2], (lb.w + vl[j0 + 3] * bon) * gv[j0 + 3]);
                    gw2.x = pk2(lgn.x * gv[j0], lgn.y * gv[j0 + 1]); gw2.y = pk2(lgn.z * gv[j0 + 2], lgn.w * gv[j0 + 3]);
                    *(u32x2*)((bf16*)(ws + WS_ADD) + off + j0) = ow; *(u32x2*)((bf16*)(ws + WS_G) + off + j0) = gw2; }
            }
            asm volatile("s_waitcnt lgkmcnt(0)" ::: "memory");
            {
                bf16x8 fa[2], fr[2], fb[2], fk[2];
#pragma unroll
                for (int ks = 0; ks < 2; ++ks) { const int po = l15 * 64 + 8 * ((4 * ks + g) ^ (l15 & 7));
                    fa[ks] = *(const LAS bf16x8*)(Arm + po); fr[ks] = *(const LAS bf16x8*)(Rrm + po); fb[ks] = *(const LAS bf16x8*)(Brm + po); fk[ks] = *(const LAS bf16x8*)(Krm + po); }
                f32x4 mab = z4, mak = z4, mrb = z4, mrk = z4;
#pragma unroll
                for (int ks = 0; ks < 2; ++ks) { mab = __builtin_amdgcn_mfma_f32_16x16x32_bf16(fb[ks], fa[ks], mab, 0, 0, 0); mak = __builtin_amdgcn_mfma_f32_16x16x32_bf16(fk[ks], fa[ks], mak, 0, 0, 0);
                    mrb = __builtin_amdgcn_mfma_f32_16x16x32_bf16(fb[ks], fr[ks], mrb, 0, 0, 0); mrk = __builtin_amdgcn_mfma_f32_16x16x32_bf16(fk[ks], fr[ks], mrk, 0, 0, 0); }
#pragma unroll
                for (int e = 0; e < 4; ++e) { const int i = 4 * g + e; if (!(i < l15)) { mab[e] = 0.f; mak[e] = 0.f; } if (!(i <= l15)) { mrb[e] = 0.f; mrk[e] = 0.f; } }
                asm volatile("s_waitcnt lgkmcnt(0)" ::: "memory");
#pragma unroll
                for (int e = 0; e < 4; ++e) MabT[(4 * g + e) * 16 + l15] = mab[e];
                u32x2 w; w.x = pk2(mak[0], mak[1]); w.y = pk2(mak[2], mak[3]); *(LAS u32x2*)(Mak + l15 * 16 + 4 * g) = w;
                w.x = pk2(mrb[0], mrb[1]); w.y = pk2(mrb[2], mrb[3]); *(LAS u32x2*)(Mrb + l15 * 16 + 4 * g) = w;
                w.x = pk2(mrk[0], mrk[1]); w.y = pk2(mrk[2], mrk[3]); *(LAS u32x2*)(Mrk + l15 * 16 + 4 * g) = w;
                if (te == 15) {
#pragma unroll
                    for (int j = 0; j < 16; ++j) PLs[16 * kq + j] = eP[j]; }
            }
            asm volatile("s_waitcnt lgkmcnt(0)" ::: "memory");
            {
                f32x4 mq[15][4];
#pragma unroll
                for (int j = 0; j < 15; ++j)
#pragma unroll
                    for (int q = 0; q < 4; ++q) if (4 * q + 3 > j) mq[j][q] = *(const LAS f32x4*)(MabT + j * 16 + 4 * q);
                float y[16];
#pragma unroll
                for (int j = 15; j >= 0; --j) {
                    float acc = (j == l15) ? 1.0f : 0.0f;
#pragma unroll
                    for (int i = j + 1; i < 16; ++i) acc += y[i] * mq[j < 15 ? j : 0][i >> 2][i & 3];
                    y[j] = acc;
                }
                if (g == 0) { u32x4 t0, t1; t0.x = pk2(y[0], y[1]); t0.y = pk2(y[2], y[3]); t0.z = pk2(y[4], y[5]); t0.w = pk2(y[6], y[7]); t1.x = pk2(y[8], y[9]); t1.y = pk2(y[10], y[11]); t1.z = pk2(y[12], y[13]); t1.w = pk2(y[14], y[15]);
                    *(LAS u32x4*)(Tm + l15 * 16) = t0; *(LAS u32x4*)(Tm + l15 * 16 + 8) = t1; }
            }
            asm volatile("s_waitcnt lgkmcnt(0)" ::: "memory");
            {
                const bool act = g < 2; const int fo = l15 * 16 + 8 * g;
                const bf16x8 fT = act ? *(const LAS bf16x8*)(Tm + fo) : z8, fMak = act ? *(const LAS bf16x8*)(Mak + fo) : z8, fMrb = act ? *(const LAS bf16x8*)(Mrb + fo) : z8, fMrk = act ? *(const LAS bf16x8*)(Mrk + fo) : z8;
                bf16x8 fV[4], fQ1[4], fAh[4], fBT[4], fKT[4];
#pragma unroll
                for (int vt = 0; vt < 4; ++vt) { fV[vt] = act ? *(const LAS bf16x8*)(VTt + vt * 256 + fo) : z8; fBT[vt] = act ? *(const LAS bf16x8*)(BTt + vt * 256 + fo) : z8; fKT[vt] = act ? *(const LAS bf16x8*)(KTt + vt * 256 + fo) : z8; }
#pragma unroll
                for (int vt = 0; vt < 4; ++vt) { const f32x4 q0 = __builtin_amdgcn_mfma_f32_16x16x32_bf16(fMak, fV[vt], z4, 0, 0, 0);
                    u32x2 w; w.x = pk2(q0[0], q0[1]); w.y = pk2(q0[2], q0[3]); *(LAS u32x2*)(Q0T + vt * 256 + l15 * 16 + 4 * g) = w; }
#pragma unroll
                for (int kt = 0; kt < 4; ++kt) { const bf16x8 fA = act ? *(const LAS bf16x8*)(ATt + kt * 256 + fo) : z8; const f32x4 ah = __builtin_amdgcn_mfma_f32_16x16x32_bf16(fT, fA, z4, 0, 0, 0);
                    u32x2 w; w.x = pk2(ah[0], ah[1]); w.y = pk2(ah[2], ah[3]); *(LAS u32x2*)(ATt + kt * 256 + l15 * 16 + 4 * g) = w; }
                asm volatile("s_waitcnt lgkmcnt(0)" ::: "memory");
#pragma unroll
                for (int vt = 0; vt < 4; ++vt) { const bf16x8 fQ0 = act ? *(const LAS bf16x8*)(Q0T + vt * 256 + fo) : z8; const f32x4 q1 = __builtin_amdgcn_mfma_f32_16x16x32_bf16(fT, fQ0, z4, 0, 0, 0);
                    u32x2 w; w.x = pk2(q1[0], q1[1]); w.y = pk2(q1[2], q1[3]); *(LAS u32x2*)(Q0T + vt * 256 + l15 * 16 + 4 * g) = w; }
                asm volatile("s_waitcnt lgkmcnt(0)" ::: "memory");
#pragma unroll
                for (int vt = 0; vt < 4; ++vt) { fQ1[vt] = act ? *(const LAS bf16x8*)(Q0T + vt * 256 + fo) : z8; fAh[vt] = act ? *(const LAS bf16x8*)(ATt + vt * 256 + fo) : z8; }
                bf16* rp = (bf16*)(ws + WS_RP) + (size_t)un * 1024 + l15 * 64;
#pragma unroll
                for (int kt = 0; kt < 4; ++kt) {
                    const u32x2 rr = *(const LAS u32x2*)(Rrm + l15 * 64 + 8 * ((2 * kt + (g >> 1)) ^ (l15 & 7)) + 4 * (g & 1));
                    f32x4 ini; ini[0] = bflo(rr.x); ini[1] = bfhi(rr.x); ini[2] = bflo(rr.y); ini[3] = bfhi(rr.y);
                    const f32x4 rh = __builtin_amdgcn_mfma_f32_16x16x32_bf16(fAh[kt], fMrb, ini, 0, 0, 0);
                    u32x2 w; w.x = pk2(rh[0], rh[1]); w.y = pk2(rh[2], rh[3]); *(u32x2*)(rp + 32 * (kt >> 1) + 8 * g + 4 * (kt & 1)) = w;
                }
#pragma unroll
                for (int vt = 0; vt < 4; ++vt) { f32x4 y1 = __builtin_amdgcn_mfma_f32_16x16x32_bf16(fMrb, fQ1[vt], z4, 0, 0, 0); y1 = __builtin_amdgcn_mfma_f32_16x16x32_bf16(fMrk, fV[vt], y1, 0, 0, 0);
                    *(f32x4*)((float*)(ws + WS_Y1F) + ((size_t)(un * 4 + vt) * 64 + lane) * 4) = y1; }
                LAS bf16* tgs = (LAS bf16*)(wl + 8192);
#pragma unroll
                for (int krt = 0; krt < 4; ++krt) { const float pl = PLs[16 * krt + l15];
#pragma unroll
                    for (int kct = 0; kct < 4; ++kct) { f32x4 ga = __builtin_amdgcn_mfma_f32_16x16x32_bf16(fAh[kct], fBT[krt], z4, 0, 0, 0);
                        if (kct == krt) {
#pragma unroll
                            for (int e = 0; e < 4; ++e) if (4 * g + e == l15) ga[e] += 1.0f; }
                        u32x2 w; w.x = pk2(ga[0] * pl, ga[1] * pl); w.y = pk2(ga[2] * pl, ga[3] * pl);
                        *(LAS u32x2*)(tgs + (16 * krt + l15) * 64 + 32 * (kct >> 1) + 8 * g + 4 * (kct & 1)) = w; } }
                { u32x4* gp16 = (u32x4*)((bf16*)(ws + WS_GP) + (size_t)un * 4096);
#pragma unroll
                  for (int i = 0; i < 8; ++i) gp16[i * 64 + lane] = *(const LAS u32x4*)(tgs + (i * 64 + lane) * 8); }
#pragma unroll
                for (int mt = 0; mt < 4; ++mt) { const f32x4 pl4 = *(const LAS f32x4*)(PLs + 16 * mt + 4 * g);
#pragma unroll
                    for (int vt = 0; vt < 4; ++vt) { f32x4 ha = __builtin_amdgcn_mfma_f32_16x16x32_bf16(fBT[mt], fQ1[vt], z4, 0, 0, 0); ha = __builtin_amdgcn_mfma_f32_16x16x32_bf16(fKT[mt], fV[vt], ha, 0, 0, 0);
                        u32x2 w; w.x = pk2(ha[0] * pl4[0], ha[1] * pl4[1]); w.y = pk2(ha[2] * pl4[2], ha[3] * pl4[3]);
                        *(u32x2*)((bf16*)(ws + WS_HF) + ((size_t)((un * 4 + vt) * 4 + mt) * 64 + lane) * 4) = w; } }
            }
            asm volatile("s_waitcnt lgkmcnt(0)" ::: "memory");
        }
        asm volatile("s_waitcnt vmcnt(0)" ::: "memory");
        { const int ltid = fresh_tid() & 63, l15 = ltid & 15, g = ltid >> 4, lane = ltid;
#define CP_LOADG(gf_, j_) do { const bf16* gp_ = (const bf16*)(ws + WS_GP) + ((size_t)u64 * 4 + (j_)) * 4096 + l15 * 64 + 8 * g; \
            _Pragma("unroll") for (int mt = 0; mt < 4; ++mt) { gf_[mt][0] = *(const bf16x8*)(gp_ + mt * 1024); gf_[mt][1] = *(const bf16x8*)(gp_ + mt * 1024 + 32); } } while (0)
#define CP_LOADH(hf_, j_) do { _Pragma("unroll") for (int sl = 0; sl < 4; ++sl) _Pragma("unroll") for (int mt = 0; mt < 4; ++mt) \
            hf_[sl][mt] = *(const u32x2*)((const bf16*)(ws + WS_HF) + ((size_t)((((size_t)u64 * 4 + (j_)) * 4 + sl) * 4 + mt) * 64 + lane) * 4); } while (0)
#define CP_STEP(gf_, hf_, useh_) do { _Pragma("unroll") for (int sl = 0; sl < 4; ++sl) { bf16x8 zb[2]; RW_ZB(z[sl], zb); \
            _Pragma("unroll") for (int mt = 0; mt < 4; ++mt) { f32x4 a_ = (f32x4){0.f, 0.f, 0.f, 0.f}; \
                if (useh_) { a_[0] = bflo(hf_[sl][mt].x); a_[1] = bfhi(hf_[sl][mt].x); a_[2] = bflo(hf_[sl][mt].y); a_[3] = bfhi(hf_[sl][mt].y); } \
                a_ = __builtin_amdgcn_mfma_f32_16x16x32_bf16(gf_[mt][0], zb[0], a_, 0, 0, 0); a_ = __builtin_amdgcn_mfma_f32_16x16x32_bf16(gf_[mt][1], zb[1], a_, 0, 0, 0); z[sl][mt] = a_; } } } while (0)
        {
            f32x4 z[4][4];
#pragma unroll
            for (int sl = 0; sl < 4; ++sl)
#pragma unroll
                for (int mt = 0; mt < 4; ++mt)
#pragma unroll
                    for (int e = 0; e < 4; ++e) z[sl][mt][e] = (sl == mt && 4 * g + e == l15) ? 1.0f : 0.0f;
            bf16x8 gA[4][2], gB[4][2]; u32x2 hdum[4][4];
            CP_LOADG(gA, 0); CP_LOADG(gB, 1);
            CP_STEP(gA, hdum, false); CP_LOADG(gA, 2);
            CP_STEP(gB, hdum, false); CP_LOADG(gB, 3);
            CP_STEP(gA, hdum, false);
            CP_STEP(gB, hdum, false);
            LAS bf16* tg = (LAS bf16*)(lds + wave * 16384);
#pragma unroll
            for (int sl = 0; sl < 4; ++sl) { const int pc = 32 * (sl >> 1) + 8 * (l15 >> 2) + 4 * (sl & 1) + (l15 & 3);
#pragma unroll
                for (int mt = 0; mt < 4; ++mt)
#pragma unroll
                    for (int e = 0; e < 4; ++e) tg[(16 * mt + 4 * g + e) * 64 + pc] = (bf16)f2bf(z[sl][mt][e]); }
            u32x4* gc = (u32x4*)((bf16*)(ws + WS_GC) + (size_t)u64 * 4096);
#pragma unroll
            for (int i = 0; i < 8; ++i) gc[i * 64 + lane] = *(const LAS u32x4*)(tg + (i * 64 + lane) * 8);
        }
        {
            f32x4 z[4][4];
#pragma unroll
            for (int sl = 0; sl < 4; ++sl)
#pragma unroll
                for (int mt = 0; mt < 4; ++mt) z[sl][mt] = (f32x4){0.f, 0.f, 0.f, 0.f};
            bf16x8 gA[4][2], gB[4][2]; u32x2 hA[4][4], hB[4][4];
            CP_LOADG(gA, 0); CP_LOADH(hA, 0); CP_LOADG(gB, 1); CP_LOADH(hB, 1);
            CP_STEP(gA, hA, true); CP_LOADG(gA, 2); CP_LOADH(hA, 2);
            CP_STEP(gB, hB, true); CP_LOADG(gB, 3); CP_LOADH(hB, 3);
            CP_STEP(gA, hA, true);
            CP_STEP(gB, hB, true);
#pragma unroll
            for (int sl = 0; sl < 4; ++sl)
#pragma unroll
                for (int mt = 0; mt < 4; ++mt) { u32x2 w; w.x = pk2(z[sl][mt][0], z[sl][mt][1]); w.y = pk2(z[sl][mt][2], z[sl][mt][3]);
                    *(u32x2*)((bf16*)(ws + WS_HC) + ((size_t)((u64 * 4 + sl) * 4 + mt) * 64 + lane) * 4) = w; }
        }
#undef CP_LOADG
#undef CP_LOADH
#undef CP_STEP
        }
        }
        for (int lu = gw; lu < NB * 8 * 64; lu += NGW) {
            const int bc = lu >> 6, seg = lu & 63, b = bc >> 3, cg = bc & 7, ch = cg * 64 + lane;
            const size_t mb = (size_t)b * SEQ + seg * 64;
            float A = 1.f, B = 0.f;
#pragma unroll 16
            for (int t = 0; t < 64; ++t) { const float a = __expf(bf2f(LA[(mb + t) * 512 + ch])), bt = bf2f(LB[(mb + t) * 512 + ch]); B = a * B + bt; A *= a; }
            f32x2 ab; ab.x = A; ab.y = B; *(f32x2*)((float*)(ws + WS_AP) + ((size_t)lu * 64 + lane) * 2) = ab;
        }
    }
    SEAM(3);


    if (IN(4)) { PHASE_IDS;
        if (!(bid < 128 && wave == 0)) {
            const int wi = bid < 128 ? bid * 7 + (wave - 1) : 896 + (bid - 128) * 8 + wave, NW = 896 + (G - 128) * 8;
        } else {
            const int l15 = lane & 15, g = lane >> 4, bh = bid >> 2, vs = bid & 3;
            f32x4 z[4];
#pragma unroll
            for (int mt = 0; mt < 4; ++mt) z[mt] = (f32x4){0.f, 0.f, 0.f, 0.f};
            bf16x8 gA[4][2], gB[4][2], gC[4][2], gD[4][2]; u32x2 hA[4], hB[4], hC[4], hD[4];
#define SC_LOAD(gf, hf, C) do { const size_t u64_ = (size_t)bh * 64 + (C); const bf16* gp_ = (const bf16*)(ws + WS_GC) + u64_ * 4096 + l15 * 64 + 8 * g; \
                _Pragma("unroll") for (int mt = 0; mt < 4; ++mt) { gf[mt][0] = *(const bf16x8*)(gp_ + mt * 1024); gf[mt][1] = *(const bf16x8*)(gp_ + mt * 1024 + 32); \
                    hf[mt] = *(const u32x2*)((const bf16*)(ws + WS_HC) + ((size_t)((u64_ * 4 + vs) * 4 + mt) * 64 + lane) * 4); } } while (0)
#define SC_STEP(gf, hf, C) do { const size_t u64_ = (size_t)bh * 64 + (C); bf16* zs_ = (bf16*)(ws + WS_ZS) + ((size_t)((u64_ * 4 + vs) * 4) * 64 + lane) * 4; \
                _Pragma("unroll") for (int mt = 0; mt < 4; ++mt) { u32x2 zw_; zw_.x = pk2(z[mt][0], z[mt][1]); zw_.y = pk2(z[mt][2], z[mt][3]); *(u32x2*)(zs_ + mt * 256) = zw_; } \
                bf16x8 zb[2]; RW_ZB(z, zb); \
                _Pragma("unroll") for (int mt = 0; mt < 4; ++mt) { f32x4 a; a[0] = bflo(hf[mt].x); a[1] = bfhi(hf[mt].x); a[2] = bflo(hf[mt].y); a[3] = bfhi(hf[mt].y); \
                    a = __builtin_amdgcn_mfma_f32_16x16x32_bf16(gf[mt][0], zb[0], a, 0, 0, 0); a = __builtin_amdgcn_mfma_f32_16x16x32_bf16(gf[mt][1], zb[1], a, 0, 0, 0); z[mt] = a; } } while (0)
            SC_LOAD(gA, hA, 0); SC_LOAD(gB, hB, 1); SC_LOAD(gC, hC, 2);
#pragma unroll 1
            for (int C = 0; C < 64; C += 4) {
                SC_LOAD(gD, hD, C + 3);
                SC_STEP(gA, hA, C);
                if (C + 4 < 64) SC_LOAD(gA, hA, C + 4);
                SC_STEP(gB, hB, C + 1);
                if (C + 5 < 64) SC_LOAD(gB, hB, C + 5);
                SC_STEP(gC, hC, C + 2);
                if (C + 6 < 64) SC_LOAD(gC, hC, C + 6);
                SC_STEP(gD, hD, C + 3);
            }
#undef SC_LOAD
#undef SC_STEP
        }
    }
    if (IN(4)) { PHASE_IDS;
        bf16* WKt = HN; bf16* VWt = HN + (size_t)4 * 1024 * 1024;
        __syncthreads();
        if (bid >= 128 && bid < 192) { pg8::FoldSched<0> S; S.A = (const char*)KM; S.B = (const char*)Wq_t; S.G = 64; S.c = bid - 128; EpiFold<0> E{WKt}; pg8::gemm_phase(lds, 256, S, E, 1024); }
        else if (bid >= 192) { pg8::FoldSched<1> S; S.A = (const char*)Wo_t; S.B = (const char*)VT; S.G = 64; S.c = bid - 192; EpiFold<1> E{VWt}; pg8::gemm_phase(lds, 256, S, E, 1024); }
    }
    SEAM(4);

    if (IN(5)) { PHASE_IDS;
        {
            for (int lu = gw; lu < NB * 8 * 64; lu += NGW) {
                const int bc = lu >> 6, seg = lu & 63, b = bc >> 3, cg = bc & 7, ch = cg * 64 + lane;
                const size_t mb = (size_t)b * SEQ + seg * 64;
                float hst = 0.f;
                const f32x2* ag = (const f32x2*)((const float*)(ws + WS_AP)) + (size_t)(bc * 64) * 64 + lane;
#pragma unroll 8
                for (int sg = 0; sg < seg; ++sg) { const f32x2 ab = ag[(size_t)sg * 64]; hst = ab.x * hst + ab.y; }
#pragma unroll 16
                for (int t = 0; t < 64; ++t) { const float a = __expf(bf2f(LA[(mb + t) * 512 + ch])), bt = bf2f(LB[(mb + t) * 512 + ch]); hst = a * hst + bt;
                    const float gl = bf2f(U[(mb + t) * INW + 512 + ch]); CAT[(mb + t) * 1024 + ch] = (bf16)f2bf(hst * gelu_tanh_f(gl)); }
            }
        }
        const int l15 = lane & 15, g = lane >> 4;
        LAS bf16* tGL = (LAS bf16*)(lds + wave * 16384); LAS bf16* tAD = tGL + 1024; LAS bf16* tOUT = tGL + 2048;
        const int ct = lane >> 3, cc = lane & 7;
        for (int u64 = gw; u64 < NB * NH * (SEQ / 64); u64 += NGW) {
            const int bh = u64 >> 6, C = u64 & 63, b = bh >> 3, h = bh & 7;
            f32x4 z[4][4];
#pragma unroll
            for (int sl = 0; sl < 4; ++sl)
#pragma unroll
                for (int mt = 0; mt < 4; ++mt) { const u32x2 zw = *(const u32x2*)((const bf16*)(ws + WS_ZS) + ((size_t)((u64 * 4 + sl) * 4 + mt) * 64 + lane) * 4); z[sl][mt] = (f32x4){bflo(zw.x), bfhi(zw.x), bflo(zw.y), bfhi(zw.y)}; }
#pragma unroll 1
            for (int j = 0; j < 4; ++j) {
                const size_t un = (size_t)u64 * 4 + j; const size_t m0 = (size_t)b * SEQ + (C * 4 + j) * 16;
                const bf16* rp = (const bf16*)(ws + WS_RP) + un * 1024 + l15 * 64 + 8 * g;
                const bf16x8 rf0 = *(const bf16x8*)rp, rf1 = *(const bf16x8*)(rp + 32);
                f32x4 y[4];
#pragma unroll
                for (int sl = 0; sl < 4; ++sl) y[sl] = *(const f32x4*)((const float*)(ws + WS_Y1F) + ((size_t)(un * 4 + sl) * 64 + lane) * 4);
                const size_t rg = (m0 + ct) * 512 + h * 64 + 8 * cc;
                const u32x4 gl0 = *(const u32x4*)((const bf16*)(ws + WS_G) + rg), gl1 = *(const u32x4*)((const bf16*)(ws + WS_G) + rg + 8 * 512);
                const u32x4 ad0 = *(const u32x4*)((const bf16*)(ws + WS_ADD) + rg), ad1 = *(const u32x4*)((const bf16*)(ws + WS_ADD) + rg + 8 * 512);
                bf16x8 gf[4][2]; u32x2 hfr[4][4];
                if (j < 3) {
                    const bf16* gp = (const bf16*)(ws + WS_GP) + un * 4096 + l15 * 64 + 8 * g;
#pragma unroll
                    for (int mt = 0; mt < 4; ++mt) { gf[mt][0] = *(const bf16x8*)(gp + mt * 1024); gf[mt][1] = *(const bf16x8*)(gp + mt * 1024 + 32); }
#pragma unroll
                    for (int sl = 0; sl < 4; ++sl)
#pragma unroll
                        for (int mt = 0; mt < 4; ++mt) hfr[sl][mt] = *(const u32x2*)((const bf16*)(ws + WS_HF) + ((size_t)((un * 4 + sl) * 4 + mt) * 64 + lane) * 4);
                }
                *(LAS u32x4*)(tGL + ct * 64 + 8 * cc) = gl0; *(LAS u32x4*)(tGL + (ct + 8) * 64 + 8 * cc) = gl1;
                *(LAS u32x4*)(tAD + ct * 64 + 8 * cc) = ad0; *(LAS u32x4*)(tAD + (ct + 8) * 64 + 8 * cc) = ad1;
                bf16x8 zb[4][2];
#pragma unroll
                for (int sl = 0; sl < 4; ++sl) { RW_ZB(z[sl], zb[sl]);
                    y[sl] = __builtin_amdgcn_mfma_f32_16x16x32_bf16(rf0, zb[sl][0], y[sl], 0, 0, 0); y[sl] = __builtin_amdgcn_mfma_f32_16x16x32_bf16(rf1, zb[sl][1], y[sl], 0, 0, 0); }
#pragma unroll
                for (int e = 0; e < 4; ++e) {
                    float s1 = (y[0][e] + y[1][e]) + (y[2][e] + y[3][e]);
                    s1 += __shfl_xor(s1, 1); s1 += __shfl_xor(s1, 2); s1 += __shfl_xor(s1, 4); s1 += __shfl_xor(s1, 8);
                    const float mean = s1 * (1.0f / 64.0f);
                    float d0 = y[0][e] - mean, d1 = y[1][e] - mean, d2 = y[2][e] - mean, d3 = y[3][e] - mean;
                    float s2 = (d0 * d0 + d1 * d1) + (d2 * d2 + d3 * d3);
                    s2 += __shfl_xor(s2, 1); s2 += __shfl_xor(s2, 2); s2 += __shfl_xor(s2, 4); s2 += __shfl_xor(s2, 8);
                    const float rstd = rsq_f(s2 * (1.0f / 64.0f) + GN_EPS);
                    const float dd[4] = {d0, d1, d2, d3};
#pragma unroll
                    for (int sl = 0; sl < 4; ++sl) { const int ti_ = (4 * g + e) * 64 + 16 * sl + l15;
                        const float o = dd[sl] * rstd * bf2f(tGL[ti_]) + bf2f(tAD[ti_]); tOUT[ti_] = (bf16)f2bf(o); }
                }
                { bf16* cp = CAT + (m0 + ct) * 1024 + 512 + h * 64 + 8 * cc;
                  *(u32x4*)cp = *(const LAS u32x4*)(tOUT + ct * 64 + 8 * cc); *(u32x4*)(cp + 8 * 1024) = *(const LAS u32x4*)(tOUT + (ct + 8) * 64 + 8 * cc); }
                if (j < 3) {
#pragma unroll
                    for (int sl = 0; sl < 4; ++sl)
#pragma unroll
                        for (int mt = 0; mt < 4; ++mt) { const u32x2 hh = hfr[sl][mt];
                            f32x4 a; a[0] = bflo(hh.x); a[1] = bfhi(hh.x); a[2] = bflo(hh.y); a[3] = bfhi(hh.y);
                            a = __builtin_amdgcn_mfma_f32_16x16x32_bf16(gf[mt][0], zb[sl][0], a, 0, 0, 0); a = __builtin_amdgcn_mfma_f32_16x16x32_bf16(gf[mt][1], zb[sl][1], a, 0, 0, 0); z[sl][mt] = a; }
                }
            }
        }
    }
    SEAM(5);
#undef RW_ZB


    if (IN(6)) { PHASE_IDS;
        pg8::DenseSched S; S.o.init_tiles(M / 256, D / 256, G, bid); S.A = (const char*)CAT; S.B = (const char*)Wout_t; S.tstep = (size_t)256 * D * 2;
        EpiBf16Res<false> E{args.in[I_X], X1, D, (float*)(ws + WS_AP + 2 * MiB)}; pg8::gemm_phase(lds, D, S, E);
    }
    SEAM(6);
    if (IN(7)) { PHASE_IDS;
        pg8::BatchBSched S; S.o.init_tiles(M / 256, D / 256, G, bid); S.A = (const char*)X1; S.B = (const char*)HN; S.tstep = (size_t)256 * D * 2; S.bstep = (size_t)1024 * 1024 * 2;
        EpiSoftmax E{Qb, 0.0625f, (const float*)(ws + WS_AP + 2 * MiB), (LAS float*)(lds + RING_BYTES + 1024), (LAS float*)(lds + RING_BYTES + 1024 + 4096)};
        pg8::gemm_phase(lds, D, S, E);
    }
    SEAM(7);
    if (IN(8)) { PHASE_IDS;
        pg8::BatchBSched S; S.o.init_tiles(M / 256, D / 256, G, bid); S.A = (const char*)Qb; S.B = (const char*)(HN + (size_t)4 * 1024 * 1024); S.tstep = (size_t)256 * D * 2; S.bstep = (size_t)1024 * 1024 * 2;
        EpiBf16Res<true> E{X1, X2, D, nullptr}; pg8::gemm_phase(lds, D, S, E);
    }
    SEAM(8);
    if (IN(9)) { PHASE_IDS;
        for (int cid = tid; cid < 2 * NE * 128; cid += NTHREADS) { const int t = cid >> 12, row = (cid >> 7) & 31, c = cid & 127;
            *(LAS u32x4*)(lds + t * 65536 + row * 2048 + ((c ^ (row & 7)) << 4)) = *(const u32x4*)(WrT + (size_t)t * NE * D + row * D + 8 * c); }
        __syncthreads();
        const int l15 = lane & 15, g = lane >> 4;
        LAS float* LG = (LAS float*)(lds + RING_BYTES + 1024 + wave * 2304);
        const float* gfn = args.in[I_NFFG];
        LAS unsigned* cntl = (LAS unsigned*)(lds + RING_BYTES + 640);
        for (int t0 = 0; t0 < M / 16; t0 += G * 4) {
        if (tid < 64) cntl[tid] = 0u;
        __syncthreads();
        if (t0 == 0 && wave >= 4) {
            constexpr int I_GU = 16 * 64;
            for (int r = bid * 4 + (wave - 4); r < CONV_P9; r += G * 4) { const int e = r / I_GU, q = r % I_GU, kb = q / 64, nb = q % 64; const int n0 = 32 * nb;
                const int drow = n0 < 1024 ? (256 * (n0 >> 7) + (n0 & 127)) : (256 * ((n0 - 1024) >> 7) + 128 + ((n0 - 1024) & 127));
                transpose_item_tiled_nolds(args.in[I_WGU] + (size_t)e * D * 2048, 2048, D, Wgu_t + (size_t)e * 2048 * D, 64 * kb, n0, drow, lane); }
        }
        const int tile = t0 + bid * 4 + wave; const bool active = wave < 4 && tile < M / 16;
        int me = 0, lpos = 0, ai = 0; float mg = 0.f;
        if (active) {
            const int m0 = tile * 16;
            const bf16* xrow = X2 + (size_t)(m0 + l15) * D + 8 * g;
            float ss = 0.f;
#pragma unroll 8
            for (int ks = 0; ks < 32; ++ks) { const u32x4 xw = *(const u32x4*)(xrow + 32 * ks);
#pragma unroll
                for (int q = 0; q < 4; ++q) { const float a = bflo(xw[q]), c = bfhi(xw[q]); ss += a * a + c * c; } }
            ss += __shfl_xor(ss, 16); ss += __shfl_xor(ss, 32);
            const float rstd = rsq_f(ss * (1.f / D) + EPS);
            f32x4 acc0 = (f32x4){0.f, 0.f, 0.f, 0.f}, acc1 = acc0;
            bf16* hrow = HN + (size_t)(m0 + l15) * D + 8 * g;
#pragma unroll 2
            for (int ks = 0; ks < 32; ++ks) {
                const f32x4 g0 = *(const f32x4*)(gfn + 32 * ks + 8 * g), g1 = *(const f32x4*)(gfn + 32 * ks + 8 * g + 4);
                const u32x4 xw = *(const u32x4*)(xrow + 32 * ks);
                float hf[8];
#pragma unroll
                for (int q = 0; q < 4; ++q) { hf[2 * q] = bflo(xw[q]) * rstd * (q < 2 ? g0[2 * q] : g1[2 * q - 4]); hf[2 * q + 1] = bfhi(xw[q]) * rstd * (q < 2 ? g0[2 * q + 1] : g1[2 * q - 3]); }
                u32x4 hi, lo;
#pragma unroll
                for (int q = 0; q < 4; ++q) { hi[q] = pk2(hf[2 * q], hf[2 * q + 1]); lo[q] = pk2(hf[2 * q] - bflo(hi[q]), hf[2 * q + 1] - bfhi(hi[q])); }
                *(u32x4*)(hrow + 32 * ks) = hi;
                const bf16x8 ah = __builtin_bit_cast(bf16x8, hi), al = __builtin_bit_cast(bf16x8, lo);
                const int c = 4 * ks + g;
#pragma unroll
                for (int nt = 0; nt < 2; ++nt) { const int row = 16 * nt + l15; const int off = row * 2048 + ((c ^ (row & 7)) << 4);
                    const bf16x8 bh = *(const LAS bf16x8*)(lds + off), bl = *(const LAS bf16x8*)(lds + 65536 + off);
                    f32x4 a = nt ? acc1 : acc0;
                    a = __builtin_amdgcn_mfma_f32_16x16x32_bf16(ah, bh, a, 0, 0, 0); a = __builtin_amdgcn_mfma_f32_16x16x32_bf16(ah, bl, a, 0, 0, 0); a = __builtin_amdgcn_mfma_f32_16x16x32_bf16(al, bh, a, 0, 0, 0);
                    if (nt) acc1 = a; else acc0 = a; }
            }
            { const float b0 = args.in[I_BR][l15], b1 = args.in[I_BR][16 + l15];
#pragma unroll
              for (int j = 0; j < 4; ++j) { LG[(4 * g + j) * 33 + l15] = acc0[j] + b0; LG[(4 * g + j) * 33 + 16 + l15] = acc1[j] + b1; } }
            const int rrow = lane >> 2, qq = lane & 3;
            float tv[4] = {-3.0e38f, -3.0e38f, -3.0e38f, -3.0e38f}; int ti[4] = {64, 65, 66, 67};
#define TOP_INS(xv_, xi_) do { float x_ = (xv_); int i_ = (xi_); _Pragma("unroll") for (int p_ = 0; p_ < 4; ++p_) { const bool b_ = x_ > tv[p_] || (x_ == tv[p_] && i_ < ti[p_]); \
                const float ov_ = tv[p_]; const int oi_ = ti[p_]; tv[p_] = b_ ? x_ : ov_; ti[p_] = b_ ? i_ : oi_; x_ = b_ ? ov_ : x_; i_ = b_ ? oi_ : i_; } } while (0)
#pragma unroll
            for (int j = 0; j < 8; ++j) TOP_INS(LG[rrow * 33 + 8 * qq + j], 8 * qq + j);
#pragma unroll
            for (int st = 1; st < 4; st <<= 1) { float pv[4]; int pi[4];
#pragma unroll
                for (int p = 0; p < 4; ++p) { pv[p] = __shfl_xor(tv[p], st); pi[p] = __shfl_xor(ti[p], st); }
#pragma unroll
                for (int p = 0; p < 4; ++p) TOP_INS(pv[p], pi[p]); }
#undef TOP_INS
            const float e1 = __expf(tv[1] - tv[0]), e2 = __expf(tv[2] - tv[0]), e3 = __expf(tv[3] - tv[0]);
            const float inv = rcp_f(1.0f + e1 + e2 + e3);
            me = qq == 0 ? ti[0] : qq == 1 ? ti[1] : qq == 2 ? ti[2] : ti[3];
            mg = (qq == 0 ? 1.0f : qq == 1 ? e1 : qq == 2 ? e2 : e3) * inv;
            lpos = (int)__hip_atomic_fetch_add(cntl + me, 1u, __ATOMIC_RELAXED, __HIP_MEMORY_SCOPE_WORKGROUP);
            ai = (m0 + rrow) * 4 + qq;
        }
        __syncthreads();
        if (tid < NE) { const unsigned c = cntl[tid]; cntl[32 + tid] = c ? atomicAdd(ecnt + 64 * tid, c) : 0u; }
        __syncthreads();
        if (active) { route_e[ai] = me; route_pos[ai] = (int)cntl[32 + me] + lpos; route_g[ai] = mg; }
        __syncthreads();
        }
    }
    SEAM(9);
    if (IN(10)) { PHASE_IDS;
        LAS int* pst = (LAS int*)lds;
        if (tid == 0) { int acc = 0; for (int e = 0; e < NE; ++e) { const int c = (int)__hip_atomic_load(ecnt + 64 * e, __ATOMIC_RELAXED, __HIP_MEMORY_SCOPE_AGENT); pst[e] = acc; pst[64 + e] = c; acc += (c + 255) & ~255; } pst[32] = acc; }
        __syncthreads();
        for (int ai = bid * NTHREADS + tid; ai < NASSIGN; ai += G * NTHREADS) {
            const int e = route_e[ai]; const int row = pst[e] + route_pos[ai]; row_slot[row] = ai; row_gate[row] = route_g[ai]; row_tok[row] = ai >> 2; }
        if (bid < NE) { const int e = bid, c = pst[64 + e], pe = (c + 255) & ~255; for (int p = c + tid; p < pe; p += NTHREADS) { row_slot[pst[e] + p] = -1; row_gate[pst[e] + p] = 0.f; row_tok[pst[e] + p] = 0; } }
        if (bid == 0 && tid == 0) { int nt = 0; for (int e = 0; e < NE; ++e) { const int n = ((pst[64 + e] + 255) & ~255) >> 8; for (int j = 0; j < n; ++j) tile_tab[16 + nt++] = e; } tile_tab[0] = nt; }
        __syncthreads();
    }
    SEAM(10);
    if (IN(11)) { PHASE_IDS;
        const int ntiles = tile_tab[0];
        pg8::MoeGatherSched S; S.o.init_tiles(ntiles, 2048 / 256, G, bid); S.A = (const char*)HN; S.B = (const char*)Wgu_t; S.tile_e = tile_tab + 16; S.rtok = row_tok; S.tstep = (size_t)256 * D * 2; S.estep = (size_t)2048 * D * 2;
        EpiSwiglu E{ACT, args.in[I_BGU]}; pg8::gemm_phase(lds, D, S, E);
        { LAS float* scr = (LAS float*)(lds + wave * 16384); constexpr int I_DN = 16 * 32;
          for (;;) { int c0 = 0; if (lane == 0) c0 = (int)atomicAdd(ctl + CW_CONV, 8u); c0 = __builtin_amdgcn_readfirstlane(c0);
              if (c0 >= NE * I_DN) break;
              for (int r = c0; r < c0 + 8; ++r) { const int e = r / I_DN, q = r % I_DN, kb = q / 32, nb = q % 32;
                  transpose_item_tiled(args.in[I_WDN] + (size_t)e * DFF * D, D, DFF, Wdn_t + (size_t)e * D * DFF, 64 * kb, 32 * nb, 32 * nb, scr, lane); } } }
    }
    SEAM(11);
    if (IN(12)) { PHASE_IDS;
        const int ntiles = tile_tab[0];
        pg8::MoeSched S; S.o.init_tiles(ntiles, D / 256, G, bid); S.A = (const char*)ACT; S.B = (const char*)Wdn_t; S.tile_e = tile_tab + 16; S.tstep = (size_t)256 * DFF * 2; S.estep = (size_t)D * DFF * 2;
        EpiDown E{YS, args.in[I_BDN], row_slot, row_gate}; pg8::gemm_phase(lds, DFF, S, E);
    }
    SEAM(12);
    if (IN(13)) { PHASE_IDS;
        const float* gfin = args.in[I_FNG];
        for (int m = gw; m < M; m += NGW) {
            float v[16]; float s = 0.f;
#pragma unroll
            for (int hf = 0; hf < 2; ++hf) { const u32x4 w = *(const u32x4*)(X2 + (size_t)m * D + 512 * hf + 8 * lane);
#pragma unroll
                for (int q = 0; q < 4; ++q) { v[8 * hf + 2 * q] = bflo(w[q]); v[8 * hf + 2 * q + 1] = bfhi(w[q]); }
#pragma unroll
                for (int k = 0; k < 4; ++k) { const u32x4 y = *(const u32x4*)(YS + (size_t)(m * 4 + k) * D + 512 * hf + 8 * lane);
#pragma unroll
                    for (int q = 0; q < 4; ++q) { v[8 * hf + 2 * q] += bflo(y[q]); v[8 * hf + 2 * q + 1] += bfhi(y[q]); } } }
#pragma unroll
            for (int j = 0; j < 16; ++j) s += v[j] * v[j];
            const float rstd = rsq_f(wave_sum(s) * (1.f / D) + EPS);
#pragma unroll
            for (int hf = 0; hf < 2; ++hf) { const f32x4 g0 = *(const f32x4*)(gfin + 512 * hf + 8 * lane), g1 = *(const f32x4*)(gfin + 512 * hf + 8 * lane + 4);
                float* o = args.out + (size_t)m * D + 512 * hf + 8 * lane;
                *(f32x4*)o = (f32x4){v[8 * hf] * rstd * g0.x, v[8 * hf + 1] * rstd * g0.y, v[8 * hf + 2] * rstd * g0.z, v[8 * hf + 3] * rstd * g0.w};
                *(f32x4*)(o + 4) = (f32x4){v[8 * hf + 4] * rstd * g1.x, v[8 * hf + 5] * rstd * g1.y, v[8 * hf + 6] * rstd * g1.z, v[8 * hf + 7] * rstd * g1.w}; }
        }
    }
#undef IN
#undef SEAM
}

constexpr int N_PHASES = 14;
extern "C" void kernel_launch(void* const* d_in, const int* in_sizes, int n_in, void* d_out, int out_size, void* d_ws, size_t ws_size, hipStream_t stream) {
    static int grid = 0;
    if (grid == 0) {
        if (n_in != 37 || out_size != M * D || ws_size < WS_END) { fprintf(stderr, "kernel_launch: unexpected shapes (n_in %d, out %d, ws %zu); nothing launched\n", n_in, out_size, ws_size); grid = -1; return; }
        int dev = 0, cus = 0, per_cu = 0;
        if (hipGetDevice(&dev) != hipSuccess || hipDeviceGetAttribute(&cus, hipDeviceAttributeMultiprocessorCount, dev) != hipSuccess) { grid = -1; return; }
        if (hipFuncSetAttribute((const void*)fwd, hipFuncAttributeMaxDynamicSharedMemorySize, LDS_BYTES) != hipSuccess) { fprintf(stderr, "kernel_launch: hipFuncSetAttribute failed\n"); grid = -1; return; }
        if (hipOccupancyMaxActiveBlocksPerMultiprocessor(&per_cu, (const void*)fwd, NTHREADS, LDS_BYTES) != hipSuccess || per_cu < 1) fprintf(stderr, "kernel_launch: occupancy query says %d\n", per_cu);
        (void)hipGetLastError();
        grid = cus > 256 ? 256 : cus;
    }
    if (grid < 0) return;
    if (hipMemsetAsync((char*)d_ws + WS_CTL, 0, CTL_ZERO_BYTES, stream) != hipSuccess) return;
    Args a{};
    for (int i = 0; i < 37; ++i) a.in[i] = (const float*)d_in[i];
    a.out = (float*)d_out; a.ws = (unsigned char*)d_ws;
#if MK_ONE_LAUNCH
    a.ph_lo = 0; a.ph_hi = N_PHASES;
    hipLaunchKernelGGL(fwd, dim3(grid), dim3(NTHREADS), LDS_BYTES, stream, a);
#else
    for (int p = 0; p < N_PHASES; ++p) { a.ph_lo = p; a.ph_hi = p + 1; hipLaunchKernelGGL(fwd, dim3(grid), dim3(NTHREADS), LDS_BYTES, stream, a);
#ifdef PROBE_REPEAT_PHASE
        if (p == PROBE_REPEAT_PHASE) hipLaunchKernelGGL(fwd, dim3(grid), dim3(NTHREADS), LDS_BYTES, stream, a);
#endif
    }
#endif
}
```

```cpp
#include <hip/hip_runtime.h>
#include <cstdio>
#include <cstdint>

#ifndef MK_ONE_LAUNCH
#define MK_ONE_LAUNCH 1
#endif

#define DI __device__ __forceinline__
#define GAS __attribute__((address_space(1)))
#define LAS __attribute__((address_space(3)))
typedef unsigned short bf16;
typedef short bf16x8 __attribute__((ext_vector_type(8)));
typedef float f32x4 __attribute__((ext_vector_type(4)));
typedef float f32x2 __attribute__((ext_vector_type(2)));
typedef unsigned u32x4 __attribute__((ext_vector_type(4)));
typedef unsigned u32x2 __attribute__((ext_vector_type(2)));

constexpr int D = 1024, NB = 4, SEQ = 4096, M = NB * SEQ;
constexpr int MEML = 256, MROWS = NB * MEML;
constexpr int LRU_W = 512, RW = 512, NH = 8, HD = 64;
constexpr int INW = 2816;
constexpr int XH = 4, XHD = 256;
constexpr int NE = 32, TOPK = 4, DFF = 1024;
constexpr int NASSIGN = M * TOPK;
constexpr int MAXTILES = 288, MAXROWS = MAXTILES * 256;
constexpr float EPS = 1e-6f, GN_EPS = 64e-5f;

DI int fresh_tid() { int t = threadIdx.x; asm volatile("" : "+v"(t)); return t; }
namespace pg8 {
constexpr int BM = 256, BK = 64, HALF = 128, HTB = HALF * BK * 2, STAGE_BYTES = 8 * HTB, NXCD = 8, WGM = 8;
__host__ __device__ __forceinline__ int lds_byte(int r, int c) { const int st = (r >> 4) * 2 + (c >> 5), rr = r & 15, cc = c & 31, ob = rr * 64 + cc * 2; return st * 1024 + (ob ^ (((ob >> 9) & 1) << 5)); }
__host__ __device__ __forceinline__ void stage_rc(int b, int& R, int& C) { const int st = b / 1024, sb = b % 1024, swz = sb ^ (((sb >> 9) & 1) << 5); R = (st >> 1) * 16 + swz / 64; C = (st & 1) * 32 + (swz % 64) / 2; }
__host__ __device__ __forceinline__ int perm32(int rho) { const int n = rho >> 4, i = rho & 15; return 8 * (i >> 2) + 4 * n + (i & 3); }

struct Unit { int pm, pn, e; };

struct StaticOrder {
    int nM, nN, nwg, G, c;
    __host__ __device__ void init_tiles(int nM_, int nN_, int G_, int c_) { nM = nM_; nN = nN_; nwg = nM * nN; G = G_; c = c_; }
    __host__ __device__ bool next(int i, Unit& u) const {
        const long L = (long)i * G + c; if (L >= nwg) return false;
        int wgid = (int)L; { const int q = nwg / NXCD, r = nwg % NXCD, xcd = wgid % NXCD, off = wgid / NXCD; wgid = (xcd < r ? xcd * (q + 1) : r * (q + 1) + (xcd - r) * q) + off; }
        const int nig = WGM * nN, gid = wgid / nig, fm = gid * WGM, gsz = (nM - fm) < WGM ? (nM - fm) : WGM;
        u.pm = fm + ((wgid % nig) % gsz); u.pn = (wgid % nig) / gsz; u.e = 0; return true;
    }
};
struct DenseSched {
    static constexpr bool GATHER = false, B_TILED = false;
    StaticOrder o; const char* A; const char* B; size_t tstep;
    DI bool next(int i, Unit& u) const { return o.next(i, u); }
    DI const char* a_ptr(const Unit& u) const { return A + (size_t)u.pm * tstep; }
    DI const char* b_ptr(const Unit& u) const { return B + (size_t)u.pn * tstep; }
    DI void a_voff(const Unit&, int K, const int (&R)[2], const int (&C)[2], unsigned (&vo)[2][2]) const {
#pragma unroll
        for (int h = 0; h < 2; ++h)
#pragma unroll
            for (int i = 0; i < 2; ++i) vo[h][i] = (unsigned)((h * HALF + R[i]) * K + C[i]) * 2u; }
};
struct MoeSched {
    static constexpr bool GATHER = false, B_TILED = true;
    StaticOrder o; const char* A; const char* B; const int* tile_e; size_t tstep, estep;
    DI bool next(int i, Unit& u) const { if (!o.next(i, u)) return false; u.e = tile_e[u.pm]; return true; }
    DI const char* a_ptr(const Unit& u) const { return A + (size_t)u.pm * tstep; }
    DI const char* b_ptr(const Unit& u) const { return B + (size_t)u.e * estep + (size_t)u.pn * tstep; }
    DI void a_voff(const Unit&, int K, const int (&R)[2], const int (&C)[2], unsigned (&vo)[2][2]) const {
#pragma unroll
        for (int h = 0; h < 2; ++h)
#pragma unroll
            for (int i = 0; i < 2; ++i) vo[h][i] = (unsigned)((h * HALF + R[i]) * K + C[i]) * 2u; }
};
struct MoeGatherSched {
    static constexpr bool GATHER = true, B_TILED = true;
    StaticOrder o; const char* A; const char* B; const int* tile_e; const int* rtok; size_t tstep, estep;
    DI bool next(int i, Unit& u) const { if (!o.next(i, u)) return false; u.e = tile_e[u.pm]; return true; }
    DI const char* a_ptr(const Unit&) const { return A; }
    DI const char* b_ptr(const Unit& u) const { return B + (size_t)u.e * estep + (size_t)u.pn * tstep; }
    DI void a_voff(const Unit& u, int K, const int (&R)[2], const int (&C)[2], unsigned (&vo)[2][2]) const {
#pragma unroll
        for (int h = 0; h < 2; ++h)
#pragma unroll
            for (int i = 0; i < 2; ++i) vo[h][i] = (unsigned)(rtok[u.pm * BM + h * HALF + R[i]] * K + C[i]) * 2u; }
};

struct BatchBSched {
    static constexpr bool GATHER = false, B_TILED = false;
    StaticOrder o; const char* A; const char* B; size_t tstep, bstep;
    DI bool next(int i, Unit& u) const { return o.next(i, u); }
    DI const char* a_ptr(const Unit& u) const { return A + (size_t)u.pm * tstep; }
    DI const char* b_ptr(const Unit& u) const { return B + (size_t)(u.pm >> 4) * bstep + (size_t)u.pn * tstep; }
    DI void a_voff(const Unit&, int K, const int (&R)[2], const int (&C)[2], unsigned (&vo)[2][2]) const {
#pragma unroll
        for (int h = 0; h < 2; ++h)
#pragma unroll
            for (int i = 0; i < 2; ++i) vo[h][i] = (unsigned)((h * HALF + R[i]) * K + C[i]) * 2u; }
};
template <int MODE> struct FoldSched {
    static constexpr bool GATHER = false, B_TILED = false;
    const char* A; const char* B; int G, c;
    DI bool next(int i, Unit& u) const { const int L = i * G + c; if (L >= 64) return false; u.pm = L >> 2; u.pn = L & 3; u.e = 0; return true; }
    DI const char* a_ptr(const Unit& u) const { const int b = u.pm >> 2, h = u.pm & 3; return A + ((size_t)(MODE == 0 ? b * 256 : u.pn * 256) * 1024 + h * 256) * 2; }
    DI const char* b_ptr(const Unit& u) const { const int b = u.pm >> 2, h = u.pm & 3; return B + ((size_t)(MODE == 0 ? u.pn * 256 : b * 256) * 1024 + h * 256) * 2; }
    DI void a_voff(const Unit&, int K, const int (&R)[2], const int (&C)[2], unsigned (&vo)[2][2]) const {
#pragma unroll
        for (int h = 0; h < 2; ++h)
#pragma unroll
            for (int i = 0; i < 2; ++i) vo[h][i] = (unsigned)((h * HALF + R[i]) * K + C[i]) * 2u; }
};

DI unsigned cvt_pk_bf16(float lo, float hi) { unsigned r; asm volatile("v_cvt_pk_bf16_f32 %0, %1, %2" : "=v"(r) : "v"(lo), "v"(hi)); return r; }

template <class Epi, class Sched, bool ALIGN_EPI = true>
DI void gemm_phase(LAS unsigned char* lds, const int K, const Sched& S, const Epi& E, const int ldp = 0) {
    const int ld = ldp ? ldp : K;
    const int tid = fresh_tid(), wid = __builtin_amdgcn_readfirstlane(tid >> 6), lane = tid & 63, wr = wid >> 2, wc = wid & 3, fr = lane & 15, fq = lane >> 4;
    const int nt = K / BK;
    constexpr bool GA = Sched::GATHER, BT = Sched::B_TILED;
    unsigned voffA[2][2], voffAn[2][2], voffB[2]; int sR[2], sC[2];
#pragma unroll
    for (int i = 0; i < 2; ++i) { int R, C; stage_rc(tid * 16 + i * 8192, R, C); const int Rb = Epi::PERM ? ((R & ~31) + perm32(R & 31)) : R;
        sR[i] = R; sC[i] = C; voffB[i] = BT ? (unsigned)(tid * 16 + i * 8192) : (unsigned)(Rb * ld + C) * 2u; }
    const size_t kstep = (size_t)(BK * 2);
    const size_t hstep = (size_t)HALF * ld * 2;
    const size_t kstepB = BT ? (size_t)(2 * HTB) : kstep, hstepB = BT ? (size_t)HTB : hstep;
    const unsigned ldsw = (unsigned)wid * 1024u;
    const int aoff = lds_byte(wr * 64 + fr, fq * 8), boff = lds_byte(wc * 32 + fr, fq * 8);
#define PG8_SA(b, h) (((b) * 2 + (h)) * HTB)
#define PG8_SB(b, h) ((4 + (b) * 2 + (h)) * HTB)
#define PG8_STAGE(bufoff, gbase, voff) do { _Pragma("unroll") for (int _i = 0; _i < 2; ++_i) \
        __builtin_amdgcn_global_load_lds((const unsigned*)((const char*)(gbase) + (voff)[_i]), (LAS unsigned*)(lds + (bufoff) + ldsw + _i * 8192), 16, 0, 0); } while (0)
#define PG8_LDA(dst, b, h) do { _Pragma("unroll") for (int m = 0; m < 4; ++m) _Pragma("unroll") for (int k = 0; k < 2; ++k) dst[m][k] = *(const LAS bf16x8*)(lds + PG8_SA(b, h) + aoff + m * 2048 + k * 1024); } while (0)
#define PG8_LDB(dst, b, h) do { _Pragma("unroll") for (int n = 0; n < 2; ++n) _Pragma("unroll") for (int k = 0; k < 2; ++k) dst[n][k] = *(const LAS bf16x8*)(lds + PG8_SB(b, h) + boff + n * 2048 + k * 1024); } while (0)
#define PG8_MMA(ai, bj, At, Bt) do { __builtin_amdgcn_s_setprio(1); _Pragma("unroll") for (int m = 0; m < 4; ++m) _Pragma("unroll") for (int n = 0; n < 2; ++n) _Pragma("unroll") for (int k = 0; k < 2; ++k) \
        acc[ai][bj][m][n] = __builtin_amdgcn_mfma_f32_16x16x32_bf16(Bt[n][k], At[m][k], acc[ai][bj][m][n], 0, 0, 0); __builtin_amdgcn_s_setprio(0); } while (0)
#define PG8_WAIT_V(n) asm volatile("s_waitcnt vmcnt(" #n ")" ::: "memory")
#define PG8_WAIT_L(n) asm volatile("s_waitcnt lgkmcnt(" #n ")" ::: "memory")
#define PG8_BAR __builtin_amdgcn_s_barrier()
#define PG8_SCHED __builtin_amdgcn_sched_barrier(0)
    Unit cur, nxt; int ui = 0;
    if (!S.next(0, cur)) return;
    f32x4 acc[2][2][4][2];
#pragma unroll
    for (int a = 0; a < 2; ++a)
#pragma unroll
        for (int b = 0; b < 2; ++b)
#pragma unroll
            for (int m = 0; m < 4; ++m)
#pragma unroll
                for (int n = 0; n < 2; ++n) acc[a][b][m][n] = (f32x4){0.f, 0.f, 0.f, 0.f};
    bf16x8 At[4][2], B0[2][2], B1[2][2];
    const char* cA = S.a_ptr(cur); const char* cB = S.b_ptr(cur);
    S.a_voff(cur, ld, sR, sC, voffA);
#define PG8_STAGE_A(bufoff, kbase, h, vo) do { if constexpr (GA) { PG8_STAGE(bufoff, kbase, (vo)[h]); } else { PG8_STAGE(bufoff, (kbase) + (h) * hstep, voffA[0]); } } while (0)
    PG8_STAGE(PG8_SB(0, 0), cB, voffB); PG8_STAGE(PG8_SB(0, 1), cB + hstepB, voffB); PG8_STAGE_A(PG8_SA(0, 0), cA, 0, voffA); PG8_STAGE_A(PG8_SA(0, 1), cA, 1, voffA);
    if (wr == 1) PG8_BAR;
    PG8_WAIT_V(2); PG8_BAR;
    PG8_STAGE(PG8_SB(1, 0), cB + kstepB, voffB); PG8_STAGE_A(PG8_SA(1, 0), cA + kstep, 0, voffA); PG8_STAGE(PG8_SB(1, 1), cB + hstepB + kstepB, voffB);
    PG8_WAIT_V(6); PG8_BAR;
    for (;;) {
        const bool has_next = S.next(ui + 1, nxt);
        const char* nA = has_next ? S.a_ptr(nxt) : cA; const char* nB = has_next ? S.b_ptr(nxt) : cB;
        if constexpr (GA) { if (has_next) S.a_voff(nxt, ld, sR, sC, voffAn);
            else {
#pragma unroll
                for (int h = 0; h < 2; ++h)
#pragma unroll
                    for (int i = 0; i < 2; ++i) voffAn[h][i] = voffA[h][i]; } }
#pragma unroll 1
        for (int t = 0; t < nt; t += 2) {
            const bool last = (t == nt - 2);
            const char* a1 = cA + (size_t)(t + 1) * kstep;
            const char* a2 = last ? nA : cA + (size_t)(t + 2) * kstep; const char* b2 = last ? nB : cB + (size_t)(t + 2) * kstepB;
            const char* a3 = a2 + kstep; const char* b3 = b2 + kstepB;
            unsigned vs[2][2];
            if constexpr (GA) {
#pragma unroll
                for (int i = 0; i < 2; ++i) { vs[0][i] = last ? voffAn[0][i] : voffA[0][i]; vs[1][i] = last ? voffAn[1][i] : voffA[1][i]; } }
            PG8_LDB(B0, 0, 0); PG8_LDB(B1, 0, 1); PG8_SCHED; PG8_LDA(At, 0, 0); PG8_STAGE_A(PG8_SA(1, 1), a1, 1, voffA);
            PG8_WAIT_V(8); PG8_WAIT_L(0); PG8_BAR; PG8_MMA(0, 0, At, B0); PG8_MMA(0, 1, At, B1); PG8_BAR; PG8_SCHED;
            PG8_LDA(At, 0, 1); PG8_STAGE(PG8_SB(0, 0), b2, voffB); PG8_STAGE(PG8_SB(0, 1), b2 + hstepB, voffB); PG8_STAGE_A(PG8_SA(0, 0), a2, 0, vs);
            PG8_WAIT_V(8); PG8_WAIT_L(0); PG8_BAR; PG8_MMA(1, 0, At, B0); PG8_MMA(1, 1, At, B1); PG8_BAR; PG8_SCHED;
            PG8_LDB(B0, 1, 0); PG8_LDB(B1, 1, 1); PG8_SCHED; PG8_LDA(At, 1, 0); PG8_STAGE_A(PG8_SA(0, 1), a2, 1, vs);
            PG8_WAIT_V(8); PG8_WAIT_L(0); PG8_BAR; PG8_MMA(0, 0, At, B0); PG8_MMA(0, 1, At, B1); PG8_BAR; PG8_SCHED;
            PG8_LDA(At, 1, 1); PG8_STAGE(PG8_SB(1, 0), b3, voffB); PG8_STAGE(PG8_SB(1, 1), b3 + hstepB, voffB); PG8_STAGE_A(PG8_SA(1, 0), a3, 0, vs);
            PG8_WAIT_V(8); PG8_WAIT_L(0); PG8_BAR; PG8_MMA(1, 0, At, B0); PG8_MMA(1, 1, At, B1); PG8_BAR; PG8_SCHED;
        }
        if constexpr (ALIGN_EPI) { if (wr == 0) PG8_BAR; }
        E(acc, cur, wr, wc, fr, fq);
        if (!has_next) break;
#pragma unroll
        for (int a = 0; a < 2; ++a)
#pragma unroll
            for (int b = 0; b < 2; ++b)
#pragma unroll
                for (int m = 0; m < 4; ++m)
#pragma unroll
                    for (int n = 0; n < 2; ++n) acc[a][b][m][n] = (f32x4){0.f, 0.f, 0.f, 0.f};
        cur = nxt; cA = nA; cB = nB; ++ui;
        if constexpr (GA) {
#pragma unroll
            for (int h = 0; h < 2; ++h)
#pragma unroll
                for (int i = 0; i < 2; ++i) voffA[h][i] = voffAn[h][i]; }
        if constexpr (ALIGN_EPI) { if (wr == 1) PG8_BAR; }
    }
    PG8_WAIT_V(0);
    if constexpr (!ALIGN_EPI) { if (wr == 0) PG8_BAR; }
    PG8_BAR;
#undef PG8_SA
#undef PG8_SB
#undef PG8_STAGE
#undef PG8_STAGE_A
#undef PG8_LDA
#undef PG8_LDB
#undef PG8_MMA
#undef PG8_WAIT_V
#undef PG8_WAIT_L
#undef PG8_BAR
#undef PG8_SCHED
}
}
using pg8::Unit;
using pg8::cvt_pk_bf16;

DI float bflo(unsigned w) { return __uint_as_float(w << 16); }
DI float bfhi(unsigned w) { return __uint_as_float(w & 0xffff0000u); }
DI float bf2f(bf16 b) { return __uint_as_float(((unsigned)b) << 16); }
typedef __bf16 hwbf2 __attribute__((ext_vector_type(2)));
DI unsigned pk2(float lo, float hi) { const f32x2 v = {lo, hi}; return __builtin_bit_cast(unsigned, __builtin_convertvector(v, hwbf2)); }
DI unsigned f2bf(float f) { return pk2(f, 0.f) & 0xffffu; }
DI float rcp_f(float x) { return __builtin_amdgcn_rcpf(x); }
DI float rsq_f(float x) { return __builtin_amdgcn_rsqf(x); }
DI float sigmoid_f(float x) { return rcp_f(1.0f + __expf(-x)); }
DI float tanh_fast(float x) { return 1.0f - 2.0f * rcp_f(__expf(2.0f * x) + 1.0f); }
DI float softplus_f(float x) { return fmaxf(x, 0.f) + __logf(1.0f + __expf(-fabsf(x))); }
DI float softplus_fast(float x) { return fmaxf(x, 0.f) + __logf(1.0f + __expf(-fabsf(x))); }
DI float gelu_tanh_f(float x) { const float u = 0.7978845608028654f * (x + 0.044715f * x * x * x); return 0.5f * x * (1.0f + tanh_fast(u)); }
DI float wave_sum(float v) {
#pragma unroll
    for (int o = 1; o < 64; o <<= 1) v += __shfl_xor(v, o);
    return v;
}

struct EpiBf16Plain {
    static constexpr bool PERM = true;
    bf16* O; int ldc; float scale;
    DI void operator()(const f32x4 (&acc)[2][2][4][2], const Unit& u, int wr, int wc, int fr, int fq) const {
        const int row0 = u.pm * 256 + wr * 64 + fr, col0 = u.pn * 256 + wc * 32 + 8 * fq;
#pragma unroll
        for (int ai = 0; ai < 2; ++ai)
#pragma unroll
            for (int m = 0; m < 4; ++m) { bf16* rowp = O + (size_t)(row0 + ai * 128 + m * 16) * ldc + col0;
#pragma unroll
                for (int bj = 0; bj < 2; ++bj) { const f32x4 v0 = acc[ai][bj][m][0] * scale, v1 = acc[ai][bj][m][1] * scale;
                    u32x4 w; w.x = cvt_pk_bf16(v0[0], v0[1]); w.y = cvt_pk_bf16(v0[2], v0[3]); w.z = cvt_pk_bf16(v1[0], v1[1]); w.w = cvt_pk_bf16(v1[2], v1[3]);
                    *(u32x4*)(rowp + bj * 128) = w; } }
    }
};
template <int MODE> struct EpiFold {
    static constexpr bool PERM = true;
    bf16* O;
    DI void operator()(const f32x4 (&acc)[2][2][4][2], const Unit& u, int wr, int wc, int fr, int fq) const {
        const int b = u.pm >> 2, h = u.pm & 3;
        const int rbase = MODE == 0 ? h * 256 : u.pn * 256, cbase = MODE == 0 ? u.pn * 256 : h * 256;
        const unsigned boff = (unsigned)b * 1024u * 1024u + (unsigned)(rbase + wr * 64 + fr) * 1024u + (unsigned)(cbase + wc * 32 + 8 * fq);
#pragma unroll
        for (int ai = 0; ai < 2; ++ai)
#pragma unroll
            for (int m = 0; m < 4; ++m) { bf16* rowp = O + (boff + (unsigned)(ai * 128 + m * 16) * 1024u);
#pragma unroll
                for (int bj = 0; bj < 2; ++bj) { const f32x4 v0 = acc[ai][bj][m][0], v1 = acc[ai][bj][m][1];
                    u32x4 w; w.x = cvt_pk_bf16(v0[0], v0[1]); w.y = cvt_pk_bf16(v0[2], v0[3]); w.z = cvt_pk_bf16(v1[0], v1[1]); w.w = cvt_pk_bf16(v1[2], v1[3]);
                    *(u32x4*)(rowp + bj * 128) = w; } }
    }
};
struct EpiSoftmax {
    static constexpr bool PERM = true;
    bf16* O; float scale; const float* RS; LAS float* XM; LAS float* XS;
    DI void operator()(const f32x4 (&acc)[2][2][4][2], const Unit& u, int wr, int wc, int fr, int fq) const {
        const int row0 = u.pm * 256 + wr * 64 + fr, col0 = u.pn * 256 + wc * 32 + 8 * fq;
        float sc[2][4];
#pragma unroll
        for (int ai = 0; ai < 2; ++ai)
#pragma unroll
            for (int m = 0; m < 4; ++m) { const int r = row0 + ai * 128 + m * 16; const f32x4* rp = (const f32x4*)(RS + (size_t)r * 16);
                const f32x4 p0 = rp[0], p1 = rp[1], p2 = rp[2], p3 = rp[3];
                const float ss = ((p0[0] + p0[1]) + (p0[2] + p0[3])) + ((p1[0] + p1[1]) + (p1[2] + p1[3])) + ((p2[0] + p2[1]) + (p2[2] + p2[3])) + ((p3[0] + p3[1]) + (p3[2] + p3[3]));
                sc[ai][m] = scale * __builtin_amdgcn_rsqf(ss * (1.0f / 1024.0f) + 1e-6f);
                float mm = -3.0e38f;
#pragma unroll
                for (int bj = 0; bj < 2; ++bj)
#pragma unroll
                    for (int n = 0; n < 2; ++n) { const f32x4 v = acc[ai][bj][m][n]; mm = fmaxf(mm, fmaxf(fmaxf(v[0], v[1]), fmaxf(v[2], v[3]))); }
                mm *= sc[ai][m];
                mm = fmaxf(mm, __shfl_xor(mm, 16)); mm = fmaxf(mm, __shfl_xor(mm, 32));
                if (fq == 0) XM[(ai * 128 + wr * 64 + m * 16 + fr) * 4 + wc] = mm; }
        asm volatile("s_waitcnt lgkmcnt(0)" ::: "memory"); __builtin_amdgcn_s_barrier(); asm volatile("" ::: "memory");
        f32x4 (&pa)[2][2][4][2] = const_cast<f32x4 (&)[2][2][4][2]>(acc);
#pragma unroll
        for (int ai = 0; ai < 2; ++ai)
#pragma unroll
            for (int m = 0; m < 4; ++m) { const int lr = ai * 128 + wr * 64 + m * 16 + fr; const f32x4 q = *(const LAS f32x4*)(XM + lr * 4);
                const float mxr = fmaxf(fmaxf(q[0], q[1]), fmaxf(q[2], q[3])); float sm = 0.f;
#pragma unroll
                for (int bj = 0; bj < 2; ++bj)
#pragma unroll
                    for (int n = 0; n < 2; ++n)
#pragma unroll
                        for (int j = 0; j < 4; ++j) { const float p = __expf(acc[ai][bj][m][n][j] * sc[ai][m] - mxr); pa[ai][bj][m][n][j] = p; sm += p; }
                sm += __shfl_xor(sm, 16); sm += __shfl_xor(sm, 32);
                if (fq == 0) XS[lr * 4 + wc] = sm; }
        asm volatile("s_waitcnt lgkmcnt(0)" ::: "memory"); __builtin_amdgcn_s_barrier(); asm volatile("" ::: "memory");
#pragma unroll
        for (int ai = 0; ai < 2; ++ai)
#pragma unroll
            for (int m = 0; m < 4; ++m) { const int lr = ai * 128 + wr * 64 + m * 16 + fr; const f32x4 q = *(const LAS f32x4*)(XS + lr * 4);
                const float inv = __builtin_amdgcn_rcpf((q[0] + q[1]) + (q[2] + q[3]));
                bf16* rowp = O + (size_t)(row0 + ai * 128 + m * 16) * 1024 + col0;
#pragma unroll
                for (int bj = 0; bj < 2; ++bj) { const f32x4 v0 = pa[ai][bj][m][0] * inv, v1 = pa[ai][bj][m][1] * inv;
                    u32x4 w; w.x = cvt_pk_bf16(v0[0], v0[1]); w.y = cvt_pk_bf16(v0[2], v0[3]); w.z = cvt_pk_bf16(v1[0], v1[1]); w.w = cvt_pk_bf16(v1[2], v1[3]);
                    *(u32x4*)(rowp + bj * 128) = w; } }
        asm volatile("s_waitcnt lgkmcnt(0)" ::: "memory"); __builtin_amdgcn_s_barrier(); asm volatile("" ::: "memory");
    }
};
struct EpiBf16RowNorm {
    static constexpr bool PERM = true;
    bf16* O; int ldc; float scale; const float* RS;
    DI void operator()(const f32x4 (&acc)[2][2][4][2], const Unit& u, int wr, int wc, int fr, int fq) const {
        const int row0 = u.pm * 256 + wr * 64 + fr, col0 = u.pn * 256 + wc * 32 + 8 * fq;
#pragma unroll
        for (int ai = 0; ai < 2; ++ai)
#pragma unroll
            for (int m = 0; m < 4; ++m) { const int r = row0 + ai * 128 + m * 16; const f32x4* rp = (const f32x4*)(RS + (size_t)r * 16);
                const f32x4 p0 = rp[0], p1 = rp[1], p2 = rp[2], p3 = rp[3];
                const float ss = ((p0[0] + p0[1]) + (p0[2] + p0[3])) + ((p1[0] + p1[1]) + (p1[2] + p1[3])) + ((p2[0] + p2[1]) + (p2[2] + p2[3])) + ((p3[0] + p3[1]) + (p3[2] + p3[3]));
                const float sc = scale * __builtin_amdgcn_rsqf(ss * (1.0f / 1024.0f) + 1e-6f);
                bf16* rowp = O + (size_t)r * ldc + col0;
#pragma unroll
                for (int bj = 0; bj < 2; ++bj) { const f32x4 v0 = acc[ai][bj][m][0] * sc, v1 = acc[ai][bj][m][1] * sc;
                    u32x4 w; w.x = cvt_pk_bf16(v0[0], v0[1]); w.y = cvt_pk_bf16(v0[2], v0[3]); w.z = cvt_pk_bf16(v1[0], v1[1]); w.w = cvt_pk_bf16(v1[2], v1[3]);
                    *(u32x4*)(rowp + bj * 128) = w; } }
    }
};
template <bool RES_BF16> struct EpiBf16Res {
    static constexpr bool PERM = true;
    const void* Rz; bf16* O; int ldc; float* RS;
    DI void operator()(const f32x4 (&acc)[2][2][4][2], const Unit& u, int wr, int wc, int fr, int fq) const {
        const int row0 = u.pm * 256 + wr * 64 + fr, col0 = u.pn * 256 + wc * 32 + 8 * fq;
#pragma unroll
        for (int ai = 0; ai < 2; ++ai)
#pragma unroll
            for (int m = 0; m < 4; ++m) { const size_t off = (size_t)(row0 + ai * 128 + m * 16) * ldc + col0; float ssq = 0.f;
#pragma unroll
                for (int bj = 0; bj < 2; ++bj) { f32x4 r0, r1;
                    if (RES_BF16) { const u32x4 rw = *(const u32x4*)((const bf16*)Rz + off + bj * 128); r0 = (f32x4){bflo(rw.x), bfhi(rw.x), bflo(rw.y), bfhi(rw.y)}; r1 = (f32x4){bflo(rw.z), bfhi(rw.z), bflo(rw.w), bfhi(rw.w)}; }
                    else { r0 = *(const f32x4*)((const float*)Rz + off + bj * 128); r1 = *(const f32x4*)((const float*)Rz + off + bj * 128 + 4); }
                    const f32x4 v0 = r0 + acc[ai][bj][m][0], v1 = r1 + acc[ai][bj][m][1];
                    ssq += (v0[0] * v0[0] + v0[1] * v0[1]) + (v0[2] * v0[2] + v0[3] * v0[3]) + (v1[0] * v1[0] + v1[1] * v1[1]) + (v1[2] * v1[2] + v1[3] * v1[3]);
                    u32x4 w; w.x = cvt_pk_bf16(v0[0], v0[1]); w.y = cvt_pk_bf16(v0[2], v0[3]); w.z = cvt_pk_bf16(v1[0], v1[1]); w.w = cvt_pk_bf16(v1[2], v1[3]);
                    *(u32x4*)(O + off + bj * 128) = w; }
                if (RS) { ssq += __shfl_xor(ssq, 16); ssq += __shfl_xor(ssq, 32); if (fq == 0) RS[(size_t)(row0 + ai * 128 + m * 16) * 16 + u.pn * 4 + wc] = ssq; } }
    }
};
struct EpiLora {
    static constexpr bool PERM = false;
    float* LWp; bf16* AAp; bf16* GGp; const float* w0; const float* a0;
    DI void operator()(const f32x4 (&acc)[2][2][4][2], const Unit& u, int wr, int wc, int fr, int fq) const {
        const int kind = u.pn >> 1;
        const int row0 = u.pm * 256 + wr * 64 + fr, col0 = (u.pn & 1) * 256 + wc * 32 + 4 * fq;
#pragma unroll
        for (int bj = 0; bj < 2; ++bj)
#pragma unroll
            for (int n = 0; n < 2; ++n) {
                const int c = col0 + bj * 128 + n * 16;
                f32x4 bias = (f32x4){0.f, 0.f, 0.f, 0.f};
                if (kind == 0) bias = *(const f32x4*)(w0 + c); else if (kind == 1) bias = *(const f32x4*)(a0 + c);
#pragma unroll
                for (int ai = 0; ai < 2; ++ai)
#pragma unroll
                    for (int m = 0; m < 4; ++m) {
                        f32x4 v = acc[ai][bj][m][n] + bias;
                        if (kind == 0) {
#pragma unroll
                            for (int j = 0; j < 4; ++j) { const float w = -softplus_fast(-v[j]) - 0.5f; v[j] = -__expf(w);     }
                        } else if (kind == 1) {
#pragma unroll
                            for (int j = 0; j < 4; ++j) v[j] = sigmoid_f(v[j]);
                        }
                        const size_t o_ = (size_t)(row0 + ai * 128 + m * 16) * 512 + c;
                        if (kind == 0) *(f32x4*)(LWp + o_) = v;
                        else { u32x2 w_; w_.x = cvt_pk_bf16(v[0], v[1]); w_.y = cvt_pk_bf16(v[2], v[3]); *(u32x2*)((kind == 1 ? AAp : GGp) + o_) = w_; }
                    }
            }
    }
};
struct EpiSwiglu {
    static constexpr bool PERM = true;
    bf16* ACT; const float* b_gu;
    DI void operator()(const f32x4 (&acc)[2][2][4][2], const Unit& u, int wr, int wc, int fr, int fq) const {
        const int row0 = u.pm * 256 + wr * 64 + fr, j0 = u.pn * 128 + wc * 32 + 8 * fq;
        const float* bg = b_gu + (size_t)u.e * 2048 + j0; const float* bu = bg + 1024;
        const f32x4 bg0 = *(const f32x4*)bg, bg1 = *(const f32x4*)(bg + 4), bu0 = *(const f32x4*)bu, bu1 = *(const f32x4*)(bu + 4);
#pragma unroll
        for (int ai = 0; ai < 2; ++ai)
#pragma unroll
            for (int m = 0; m < 4; ++m) {
                float o[8];
#pragma unroll
                for (int n = 0; n < 2; ++n) { const f32x4 g4 = acc[ai][0][m][n] + (n ? bg1 : bg0), u4 = acc[ai][1][m][n] + (n ? bu1 : bu0);
#pragma unroll
                    for (int j = 0; j < 4; ++j) { const float g = fminf(g4[j], 7.0f), up = fminf(fmaxf(u4[j], -7.0f), 7.0f); o[n * 4 + j] = (up + 1.0f) * (g * sigmoid_f(1.702f * g)); } }
                u32x4 w; w.x = cvt_pk_bf16(o[0], o[1]); w.y = cvt_pk_bf16(o[2], o[3]); w.z = cvt_pk_bf16(o[4], o[5]); w.w = cvt_pk_bf16(o[6], o[7]);
                *(u32x4*)(ACT + (size_t)(row0 + ai * 128 + m * 16) * 1024 + j0) = w;
            }
    }
};
struct EpiDown {
    static constexpr bool PERM = true;
    bf16* YS; const float* b_dn; const int* row_slot; const float* row_gate;
    DI void operator()(const f32x4 (&acc)[2][2][4][2], const Unit& u, int wr, int wc, int fr, int fq) const {
        const int row0 = u.pm * 256 + wr * 64 + fr, col0 = u.pn * 256 + wc * 32 + 8 * fq;
        const float* bb = b_dn + (size_t)u.e * 1024 + col0;
        f32x4 bv[2][2];
#pragma unroll
        for (int bj = 0; bj < 2; ++bj)
#pragma unroll
            for (int n = 0; n < 2; ++n) bv[bj][n] = *(const f32x4*)(bb + bj * 128 + 4 * n);
#pragma unroll
        for (int ai = 0; ai < 2; ++ai)
#pragma unroll
            for (int m = 0; m < 4; ++m) {
                const int r = row0 + ai * 128 + m * 16; const int slot = row_slot[r]; const float gt = row_gate[r];
                if (slot >= 0) { bf16* rowp = YS + (size_t)slot * 1024 + col0;
#pragma unroll
                    for (int bj = 0; bj < 2; ++bj) { const f32x4 v0 = (acc[ai][bj][m][0] + bv[bj][0]) * gt, v1 = (acc[ai][bj][m][1] + bv[bj][1]) * gt;
                        u32x4 w; w.x = cvt_pk_bf16(v0[0], v0[1]); w.y = cvt_pk_bf16(v0[2], v0[3]); w.z = cvt_pk_bf16(v1[0], v1[1]); w.w = cvt_pk_bf16(v1[2], v1[3]);
                        *(u32x4*)(rowp + bj * 128) = w; } }
            }
    }
};

constexpr size_t MiB = 1u << 20;
constexpr size_t WS_CTL = 0, CTL_ZERO_BYTES = 1 * MiB;
constexpr size_t WS_WIN = 1 * MiB, WS_WOUT = 7 * MiB, WS_WQ = 9 * MiB, WS_WK = 11 * MiB, WS_WV = 13 * MiB, WS_WO = 15 * MiB, WS_LORAB = 17 * MiB, WS_LRUW = 18 * MiB;
constexpr size_t WS_ROUTE = 19 * MiB;
constexpr size_t WS_WGU = 22 * MiB, WS_WDN = 150 * MiB;
constexpr size_t WS_HN = 214 * MiB, WS_MEMN = 246 * MiB, WS_KM = 248 * MiB, WS_VT = 250 * MiB;
constexpr size_t WS_X1 = 252 * MiB, WS_X2 = 316 * MiB;
constexpr size_t WS_U = 380 * MiB, WS_R = 468 * MiB, WS_KRAW = 500 * MiB, WS_V = 532 * MiB, WS_KKN = 564 * MiB, WS_WD = 596 * MiB, WS_AA = 628 * MiB, WS_G = 660 * MiB;
constexpr size_t WS_LA = 692 * MiB, WS_LB = 724 * MiB, WS_AP = 756 * MiB, WS_CAT = 764 * MiB, WS_Q = 796 * MiB;
constexpr size_t WS_XS = 380 * MiB, WS_ACT = 524 * MiB, WS_YS = 668 * MiB;
constexpr size_t WS_GP = 796 * MiB, WS_HF = 860 * MiB, WS_RP = 924 * MiB, WS_Y1F = 940 * MiB, WS_ADD = 972 * MiB, WS_END = 1004 * MiB;
constexpr size_t WS_GC = 468 * MiB, WS_HC = 484 * MiB, WS_ZS = 500 * MiB;
static_assert(WS_AA == WS_WD + 32 * MiB && WS_G == WS_AA + 32 * MiB, "EpiLora strides");
static_assert(WS_U + (size_t)M * INW * 2 <= WS_R && WS_XS + (size_t)MAXROWS * 2048 <= WS_ACT && WS_ACT + (size_t)MAXROWS * 2048 <= WS_YS && WS_YS + (size_t)NASSIGN * 2048 <= WS_Q, "ws map");
constexpr size_t RT_E = 0, RT_POS = 256 * 1024, RT_G = 512 * 1024, RT_SLOT = 768 * 1024, RT_GATE = 1088 * 1024, RT_TILE = 1408 * 1024, RT_TOK = 1472 * 1024;
constexpr int CW_BAR = 4096, CW_CNT = 8192, CW_CONV = 12288;

constexpr int RING_BYTES = 131072, MISC_OFF = RING_BYTES + 320, LDS_BYTES = 147456;
constexpr int NWAVES = 8, NTHREADS = 512;
constexpr int CONV_P9 = 10240;

#define XB_TMO      128
#define XB_XCNT(j)  (256  + 64 * (j))
#define XB_XSUB(j)  (1280 + 64 * (j))
#define XB_XGEN(j)  (2304 + 64 * (j))
#define XB_TOP      3328
#define XB_TOPGEN   3392
#define XCD_BAR_WORDS 3456
#define XB_SPIN_CAP (1u << 18)
DI unsigned xb_ld(unsigned* p)              { return __hip_atomic_load(p, __ATOMIC_RELAXED, __HIP_MEMORY_SCOPE_AGENT); }
DI unsigned xb_add(unsigned* p, unsigned v) { return __hip_atomic_fetch_add(p, v, __ATOMIC_RELAXED, __HIP_MEMORY_SCOPE_AGENT); }
DI unsigned xb_xcc_id() { return (unsigned)__builtin_amdgcn_s_getreg((3 << 11) | 20) & 0xFu; }
#define XB_SPIN(cond, bar) do { unsigned _sp = 0; while (cond) { __builtin_amdgcn_s_sleep(1); \
    if ((++_sp & 255u) == 0u) { if (xb_ld(&(bar)[XB_TMO])) break; if (_sp > XB_SPIN_CAP) { atomicAdd(&(bar)[XB_TMO], 1u); break; } } } } while (0)
struct XcdBarrier { unsigned* bar; unsigned x; volatile LAS unsigned* st; };
DI XcdBarrier xcd_barrier_post(unsigned* bar, volatile LAS unsigned* st) {
    XcdBarrier b; b.bar = bar; b.x = xb_xcc_id(); b.st = st;
    if (threadIdx.x == 0) (void)xb_add(&bar[XB_XCNT(b.x)], 1u);
    return b;
}
DI void xcd_barrier_complete(unsigned* bar, unsigned x, unsigned& nloc, unsigned& nx) {
    const unsigned G = gridDim.x * gridDim.y * gridDim.z;
    unsigned sum, cnt, mine, sp = 0u;
    for (;;) {
        sum = 0u; cnt = 0u; mine = 0u;
#pragma unroll
        for (unsigned j = 0; j < 16; ++j) { const unsigned c = xb_ld(&bar[XB_XCNT(j)]); sum += c; cnt += (c > 0u) ? 1u : 0u; mine = (j == x) ? c : mine; }
        if (sum == G) break;
        __builtin_amdgcn_s_sleep(1);
        if ((++sp & 255u) == 0u) { if (xb_ld(&bar[XB_TMO])) break; if (sp > XB_SPIN_CAP) { atomicAdd(&bar[XB_TMO], 1u); break; } }
    }
    nloc = mine > 0u ? mine : 1u; nx = cnt > 0u ? cnt : 1u;
}
DI void xcd_barrier(const XcdBarrier& b) {
    asm volatile("s_waitcnt vmcnt(0)" ::: "memory");
    __syncthreads();
    if (threadIdx.x == 0) {
        unsigned* bar = b.bar;
        __builtin_amdgcn_s_waitcnt(0);
        unsigned nloc = b.st[0], nx = b.st[1];
        if (nloc == 0u) { xcd_barrier_complete(bar, b.x, nloc, nx); b.st[0] = nloc; b.st[1] = nx; }
        const unsigned old = xb_add(&bar[XB_XSUB(b.x)], 1u);
        const unsigned gen = old / nloc;
        if (old + 1u == (gen + 1u) * nloc) {
            __builtin_amdgcn_fence(__ATOMIC_RELEASE, "agent");
            asm volatile("s_waitcnt vmcnt(0)" ::: "memory");
            const unsigned og = xb_add(&bar[XB_TOP], 1u);
            const unsigned tg = og / nx;
            if (og + 1u == (tg + 1u) * nx) xb_add(&bar[XB_TOPGEN], 1u);
            else XB_SPIN(xb_ld(&bar[XB_TOPGEN]) == tg, bar);
            __builtin_amdgcn_fence(__ATOMIC_ACQUIRE, "agent");
            xb_add(&bar[XB_XGEN(b.x)], 1u);
            asm volatile("s_waitcnt vmcnt(0)" ::: "memory");
        } else {
            XB_SPIN(xb_ld(&bar[XB_XGEN(b.x)]) == gen, bar);
            __builtin_amdgcn_fence(__ATOMIC_ACQUIRE, "agent");
            asm volatile("s_waitcnt vmcnt(0)" ::: "memory");
        }
    }
    __syncthreads();
}

struct Args { const float* in[37]; float* out; unsigned char* ws; int ph_lo, ph_hi; };
enum { I_X = 0, I_MEM, I_NMIXG, I_WIN, I_CONVW, I_CONVB, I_LWX, I_LBX, I_LWA, I_LBA, I_LAM, I_MU, I_W0, I_WUP, I_A0, I_AUP, I_GUP, I_KK, I_KA, I_RK, I_LNG, I_LNB,
       I_WOUT, I_NXAG, I_NMEMG, I_WQ, I_WK, I_WV, I_WO, I_NFFG, I_WR, I_BR, I_WGU, I_BGU, I_WDN, I_BDN, I_FNG };

DI void transpose_item(const float* W, int ldw, int K, bf16* WT, int k0, int n0, int drow0, LAS float* scr, int lane, const float* rs = nullptr) {
    f32x4 t[8];
    const float* src = W + (size_t)(k0 + (lane >> 3)) * ldw + n0 + 4 * (lane & 7);
#pragma unroll
    for (int i = 0; i < 8; ++i) t[i] = *(const f32x4*)(src + (size_t)(8 * i) * ldw);
#pragma unroll
    for (int i = 0; i < 8; ++i) { const float sc_ = rs ? rs[k0 + 8 * i + (lane >> 3)] : 1.0f; LAS float* d = scr + (8 * i + (lane >> 3)) * 33 + 4 * (lane & 7); d[0] = t[i].x * sc_; d[1] = t[i].y * sc_; d[2] = t[i].z * sc_; d[3] = t[i].w * sc_; }
    asm volatile("s_waitcnt lgkmcnt(0)" ::: "memory");
    const int c = lane & 7;
#pragma unroll
    for (int j = 0; j < 4; ++j) { const int n = (lane >> 3) + 8 * j; const LAS float* s = scr + (8 * c) * 33 + n;
        u32x4 o; o.x = pk2(s[0 * 33], s[1 * 33]); o.y = pk2(s[2 * 33], s[3 * 33]); o.z = pk2(s[4 * 33], s[5 * 33]); o.w = pk2(s[6 * 33], s[7 * 33]);
        *(u32x4*)(WT + (size_t)(drow0 + n) * K + k0 + 8 * c) = o; }
    asm volatile("s_waitcnt lgkmcnt(0)" ::: "memory");
}
DI void transpose_item_tiled(const float* W, int ldw, int K, bf16* WTe, int k0, int n0, int drow0, LAS float* scr, int lane) {
    f32x4 t[8];
    const float* src = W + (size_t)(k0 + (lane >> 3)) * ldw + n0 + 4 * (lane & 7);
#pragma unroll
    for (int i = 0; i < 8; ++i) t[i] = *(const f32x4*)(src + (size_t)(8 * i) * ldw);
#pragma unroll
    for (int i = 0; i < 8; ++i) { LAS float* d = scr + (8 * i + (lane >> 3)) * 33 + 4 * (lane & 7); d[0] = t[i].x; d[1] = t[i].y; d[2] = t[i].z; d[3] = t[i].w; }
    asm volatile("s_waitcnt lgkmcnt(0)" ::: "memory");
    const int c = lane & 7;
#pragma unroll
    for (int j = 0; j < 4; ++j) { const int n = (lane >> 3) + 8 * j; const LAS float* s = scr + (8 * c) * 33 + n;
        u32x4 o; o.x = pk2(s[0 * 33], s[1 * 33]); o.y = pk2(s[2 * 33], s[3 * 33]); o.z = pk2(s[4 * 33], s[5 * 33]); o.w = pk2(s[6 * 33], s[7 * 33]);
        const int drow = drow0 + n, pn = drow >> 8, half = (drow >> 7) & 1, r = drow & 127, x = r & 31;
        const int rslot = (r & ~31) + 16 * ((x >> 2) & 1) + 4 * (x >> 3) + (x & 3);
        const size_t tb = ((size_t)(pn * (K / 64) + (k0 >> 6)) * 2 + half) * 16384 + pg8::lds_byte(rslot, 8 * c);
        *(u32x4*)((char*)WTe + tb) = o; }
    asm volatile("s_waitcnt lgkmcnt(0)" ::: "memory");
}
DI void transpose_item_tiled_nolds(const float* W, int ldw, int K, bf16* WTe, int k0, int n0, int drow0, int lane) {
    const int n = lane & 31, kh = lane >> 5;
    const float* src = W + (size_t)(k0 + 32 * kh) * ldw + n0 + n;
    float t[32];
#pragma unroll
    for (int i = 0; i < 32; ++i) t[i] = src[(size_t)i * ldw];
    const int drow = drow0 + n, pn = drow >> 8, half = (drow >> 7) & 1, r = drow & 127, x = r & 31;
    const int rslot = (r & ~31) + 16 * ((x >> 2) & 1) + 4 * (x >> 3) + (x & 3);
    const size_t tb0 = ((size_t)(pn * (K / 64) + (k0 >> 6)) * 2 + half) * 16384;
#pragma unroll
    for (int c = 0; c < 4; ++c) { u32x4 o; o.x = pk2(t[8 * c], t[8 * c + 1]); o.y = pk2(t[8 * c + 2], t[8 * c + 3]); o.z = pk2(t[8 * c + 4], t[8 * c + 5]); o.w = pk2(t[8 * c + 6], t[8 * c + 7]);
        *(u32x4*)((char*)WTe + tb0 + pg8::lds_byte(rslot, 32 * kh + 8 * c)) = o; }
}
DI void rms_row_to_bf16(const float* xrow, const float* g, bf16* orow, int lane) {
    const f32x4* xr = (const f32x4*)xrow + lane; const f32x4* gr = (const f32x4*)g + lane;
    f32x4 v[4]; float s = 0.f;
#pragma unroll
    for (int j = 0; j < 4; ++j) { v[j] = xr[64 * j]; s += (v[j].x * v[j].x + v[j].y * v[j].y) + (v[j].z * v[j].z + v[j].w * v[j].w); }
    const float rstd = rsq_f(wave_sum(s) * (1.f / D) + EPS);
    u32x2* o8 = (u32x2*)orow + lane;
#pragma unroll
    for (int j = 0; j < 4; ++j) { const f32x4 gg = gr[64 * j]; u32x2 w; w.x = pk2(v[j].x * rstd * gg.x, v[j].y * rstd * gg.y); w.y = pk2(v[j].z * rstd * gg.z, v[j].w * rstd * gg.w); o8[64 * j] = w; }
}

DI void rms_rowbf_to_bf16(const bf16* xrow, const float* g, bf16* orow, int lane) {
    float v[16]; float s = 0.f;
#pragma unroll
    for (int hf = 0; hf < 2; ++hf) { const u32x4 w = *(const u32x4*)(xrow + 512 * hf + 8 * lane);
#pragma unroll
        for (int q = 0; q < 4; ++q) { v[8 * hf + 2 * q] = bflo(w[q]); v[8 * hf + 2 * q + 1] = bfhi(w[q]); } }
#pragma unroll
    for (int j = 0; j < 16; ++j) s += v[j] * v[j];
    const float rstd = rsq_f(wave_sum(s) * (1.f / D) + EPS);
#pragma unroll
    for (int hf = 0; hf < 2; ++hf) { const f32x4 g0 = *(const f32x4*)(g + 512 * hf + 8 * lane), g1 = *(const f32x4*)(g + 512 * hf + 8 * lane + 4);
        u32x4 w; w.x = pk2(v[8 * hf] * rstd * g0.x, v[8 * hf + 1] * rstd * g0.y); w.y = pk2(v[8 * hf + 2] * rstd * g0.z, v[8 * hf + 3] * rstd * g0.w);
        w.z = pk2(v[8 * hf + 4] * rstd * g1.x, v[8 * hf + 5] * rstd * g1.y); w.w = pk2(v[8 * hf + 6] * rstd * g1.z, v[8 * hf + 7] * rstd * g1.w);
        *(u32x4*)(orow + 512 * hf + 8 * lane) = w; }
}

__global__ void __launch_bounds__(NTHREADS, 2) fwd(Args args) {
    extern __shared__ __attribute__((aligned(16))) unsigned char lds_raw[];
    LAS unsigned char* lds = (LAS unsigned char*)lds_raw;
    volatile LAS unsigned* MISC = (volatile LAS unsigned*)(lds + MISC_OFF);
    const int G = gridDim.x, bid = blockIdx.x, NGW = G * NWAVES;
#define PHASE_IDS const int tid = fresh_tid(), lane = tid & 63, wave = __builtin_amdgcn_readfirstlane(tid >> 6), gw = bid * NWAVES + wave; (void)tid; (void)lane; (void)wave; (void)gw
    unsigned char* ws = args.ws;
    unsigned* ctl = (unsigned*)(ws + WS_CTL);
    const int lo = args.ph_lo, hi = args.ph_hi;

    for (int u = threadIdx.x; u < (LDS_BYTES - RING_BYTES) / 4; u += NTHREADS) ((LAS unsigned*)(lds + RING_BYTES))[u] = 0u;
    __syncthreads();
    XcdBarrier bar; bar.bar = ctl + CW_BAR; bar.x = 0; bar.st = nullptr;
    if (hi - lo > 1) bar = xcd_barrier_post(ctl + CW_BAR, MISC + 8);
#define IN(k) (lo <= (k) && (k) < hi)
#define SEAM(k) do { if (IN(k) && IN((k) + 1)) xcd_barrier(bar); } while (0)

#define Win_t ((bf16*)(ws + WS_WIN))
#define Wout_t ((bf16*)(ws + WS_WOUT))
#define Wq_t ((bf16*)(ws + WS_WQ))
#define Wk_t ((bf16*)(ws + WS_WK))
#define Wv_t ((bf16*)(ws + WS_WV))
#define Wo_t ((bf16*)(ws + WS_WO))
#define LoraB ((bf16*)(ws + WS_LORAB))
#define LruW ((bf16*)(ws + WS_LRUW))
#define WrT ((bf16*)(ws + WS_LRUW + 512 * 1024))
#define Wgu_t ((bf16*)(ws + WS_WGU))
#define Wdn_t ((bf16*)(ws + WS_WDN))
#define HN ((bf16*)(ws + WS_HN))
#define MEMN ((bf16*)(ws + WS_MEMN))
#define KM ((bf16*)(ws + WS_KM))
#define VT ((bf16*)(ws + WS_VT))
#define X1 ((bf16*)(ws + WS_X1))
#define X2 ((bf16*)(ws + WS_X2))
#define U ((bf16*)(ws + WS_U))
#define Rr ((float*)(ws + WS_R))
#define KRAW ((float*)(ws + WS_KRAW))
#define Vv ((float*)(ws + WS_V))
#define KKN ((float*)(ws + WS_KKN))
#define WD ((float*)(ws + WS_WD))
#define AA ((float*)(ws + WS_AA))
#define GG ((float*)(ws + WS_G))
#define LA ((bf16*)(ws + WS_LA))
#define LB ((bf16*)(ws + WS_LB))
#define AP ((bf16*)(ws + WS_AP))
#define CAT ((bf16*)(ws + WS_CAT))
#define Qb ((bf16*)(ws + WS_Q))
#define Ob CAT
#define XS ((bf16*)(ws + WS_XS))
#define ACT ((bf16*)(ws + WS_ACT))
#define YS ((bf16*)(ws + WS_YS))
#define route_e ((int*)(ws + WS_ROUTE + RT_E))
#define route_pos ((int*)(ws + WS_ROUTE + RT_POS))
#define route_g ((float*)(ws + WS_ROUTE + RT_G))
#define row_slot ((int*)(ws + WS_ROUTE + RT_SLOT))
#define row_gate ((float*)(ws + WS_ROUTE + RT_GATE))
#define tile_tab ((int*)(ws + WS_ROUTE + RT_TILE))
#define row_tok ((int*)(ws + WS_ROUTE + RT_TOK))
#define ecnt (ctl + CW_CNT)

    if (IN(0)) { PHASE_IDS;
        LAS float* scr = (LAS float*)(lds + wave * 16384);
        constexpr int I_IN = 16 * (INW / 32), I_SQ = 16 * 32;
        constexpr int N_ITEMS = I_IN + 5 * I_SQ;
        for (int it = gw; it < N_ITEMS; it += NGW) {
            int r = it;
            if (r < I_IN) { const int nblk = INW / 32, kb = r / nblk, nb = r % nblk; transpose_item(args.in[I_WIN], INW, D, Win_t, 64 * kb, 32 * nb, 32 * nb, scr, lane); continue; } r -= I_IN;
            { const int w = r / I_SQ, q = r % I_SQ, kb = q / 32, nb = q % 32;
                if (w == 1) continue;
                const float* src = w == 0 ? args.in[I_WOUT] : w == 2 ? args.in[I_WK] : w == 3 ? args.in[I_WV] : args.in[I_WO];
                bf16* dst = w == 0 ? Wout_t : w == 2 ? Wk_t : w == 3 ? Wv_t : Wo_t;
                transpose_item(src, D, D, dst, 64 * kb, 32 * nb, 32 * nb, scr, lane); }
        }
        for (int idx = bid * NTHREADS + tid; idx < D * D / 4; idx += G * NTHREADS) { const f32x4 v = ((const f32x4*)args.in[I_WQ])[idx]; const float gk = args.in[I_NXAG][idx >> 8];
            u32x2 w; w.x = pk2(v.x * gk, v.y * gk); w.y = pk2(v.z * gk, v.w * gk); ((u32x2*)Wq_t)[idx] = w; }
        for (int idx = bid * NTHREADS + tid; idx < 1536 * 256; idx += G * NTHREADS) {
            const int e = idx & 7, ln = (idx >> 3) & 63, ks = (idx >> 9) & 7, ct = (idx >> 12) & 3, hk = idx >> 14, hh = hk / 3, kind = hk - 3 * hh;
            const int k = 32 * ks + 8 * (ln >> 4) + e, n = hh * 64 + 16 * ct + (ln & 15); float v = 0.f;
            if (kind == 0) { if (k < 64) v = args.in[I_WUP][k * 512 + n]; }
            else if (kind == 1) { if (k >= 64 && k < 128) v = args.in[I_AUP][(k - 64) * 512 + n]; }
            else { if (k >= 128) v = args.in[I_GUP][(k - 128) * 512 + n]; }
            LoraB[idx] = (bf16)f2bf(v);
        }
        for (int idx = bid * NTHREADS + tid; idx < 8 * 128 * 64; idx += G * NTHREADS) {
            const int nb = idx >> 13, col = (idx >> 6) & 127, k = idx & 63;
            const float v = col < 64 ? args.in[I_LWX][nb * 4096 + k * 64 + col] : args.in[I_LWA][nb * 4096 + k * 64 + (col - 64)];
            LruW[idx] = (bf16)f2bf(v);
        }
        for (int idx = bid * NTHREADS + tid; idx < NE * D; idx += G * NTHREADS) {
            const int e = idx >> 10, k = idx & 1023; const float v = args.in[I_WR][k * NE + e];
            const unsigned hi = f2bf(v); const float lo = v - __uint_as_float(hi << 16);
            WrT[idx] = (bf16)hi; WrT[NE * D + idx] = (bf16)f2bf(lo);
        }
        for (int m = gw; m < M; m += NGW) rms_row_to_bf16(args.in[I_X] + (size_t)m * D, args.in[I_NMIXG], HN + (size_t)m * D, lane);
        for (int m = gw; m < MROWS; m += NGW) rms_row_to_bf16(args.in[I_MEM] + (size_t)m * D, args.in[I_NMEMG], MEMN + (size_t)m * D, lane);
        {
            LAS float* scr = (LAS float*)(lds + wave * 16384);
            constexpr int I_GU = 16 * 64, I_DN = 16 * 32;
            for (int it = CONV_P9 + gw; it < NE * I_GU; it += NGW) {
                int r = it;
                if (r < NE * I_GU) { const int e = r / I_GU, q = r % I_GU, kb = q / 64, nb = q % 64; const int n0 = 32 * nb;
                    const int drow = n0 < 1024 ? (256 * (n0 >> 7) + (n0 & 127)) : (256 * ((n0 - 1024) >> 7) + 128 + ((n0 - 1024) & 127));
                    transpose_item_tiled(args.in[I_WGU] + (size_t)e * D * 2048, 2048, D, Wgu_t + (size_t)e * 2048 * D, 64 * kb, n0, drow, scr, lane); continue; } r -= NE * I_GU;
                { const int e = r / I_DN, q = r % I_DN, kb = q / 32, nb = q % 32;
                  transpose_item_tiled(args.in[I_WDN] + (size_t)e * DFF * D, D, DFF, Wdn_t + (size_t)e * D * DFF, 64 * kb, 32 * nb, 32 * nb, scr, lane); }
            }
        }
    }
    SEAM(0);

    if (IN(1)) { PHASE_IDS;
        { pg8::DenseSched S; S.o.init_tiles(M / 256, INW / 256, G, bid); S.A = (const char*)HN; S.B = (const char*)Win_t; S.tstep = (size_t)256 * D * 2;
          EpiBf16Plain E{U, INW, 1.0f}; pg8::gemm_phase(lds, D, S, E); }
        { pg8::DenseSched S; S.o.init_tiles(MROWS / 256, D / 256, G, (bid + 64) & (G - 1)); S.A = (const char*)MEMN; S.B = (const char*)Wk_t; S.tstep = (size_t)256 * D * 2;
          EpiBf16Plain E{KM, D, 1.0f}; pg8::gemm_phase(lds, D, S, E); }
        { pg8::DenseSched S; S.o.init_tiles(MROWS / 256, D / 256, G, (bid + 48) & (G - 1)); S.A = (const char*)MEMN; S.B = (const char*)Wv_t; S.tstep = (size_t)256 * D * 2;
          EpiBf16Plain E{VT, D, 1.0f}; pg8::gemm_phase(lds, D, S, E); }
    }
    SEAM(1);

    if (IN(2)) { PHASE_IDS;
        const float* conv_w = args.in[I_CONVW]; const float* conv_b = args.in[I_CONVB];
        LAS float* xs = (LAS float*)(lds + wave * 16384);
        LAS bf16* tP = (LAS bf16*)(lds + wave * 16384 + 4096); LAS bf16* tH = tP + 1024;
        const int i = lane & 15, kg = lane >> 4;
        for (int unit = gw; unit < (M / 64) * 8; unit += NGW) {
            const int seg = unit >> 3, nb = unit & 7, m0s = seg * 64, s0s = m0s & (SEQ - 1);
            bf16x8 wf[8][2];
#pragma unroll
            for (int ct = 0; ct < 8; ++ct)
#pragma unroll
                for (int ks = 0; ks < 2; ++ks) wf[ct][ks] = *(const bf16x8*)(LruW + ((size_t)(nb * 128 + 16 * ct + i) * 64 + 32 * ks + 8 * kg));
            float bxv[4], bav[4], spv[4], Arun[4], Brun[4];
#pragma unroll
            for (int ct = 0; ct < 4; ++ct) { const int ch = nb * 64 + 16 * ct + i; bxv[ct] = args.in[I_LBX][ch]; bav[ct] = args.in[I_LBA][ch]; spv[ct] = softplus_f(-args.in[I_LAM][ch]); Arun[ct] = 1.f; Brun[ct] = 0.f; }
#pragma unroll 1
            for (int jt = 0; jt < 4; ++jt) {
                const int m0 = m0s + 16 * jt, s0 = s0s + 16 * jt;
                bf16x8 af[2];
#pragma unroll
                for (int ks = 0; ks < 2; ++ks) {
                    const int chb = nb * 64 + 32 * ks + 8 * kg;
                    f32x4 x0 = *(const f32x4*)(conv_b + chb), x1 = *(const f32x4*)(conv_b + chb + 4);
#pragma unroll
                    for (int j = 0; j < 4; ++j) {
                        const bool ok = s0 + i - 3 + j >= 0;
                        u32x4 uw = *(const u32x4*)(U + (size_t)(ok ? m0 + i - 3 + j : m0) * INW + chb); if (!ok) uw = (u32x4){0u, 0u, 0u, 0u};
                        const f32x4 w0 = *(const f32x4*)(conv_w + j * 512 + chb), w1 = *(const f32x4*)(conv_w + j * 512 + chb + 4);
                        x0.x += w0.x * bflo(uw.x); x0.y += w0.y * bfhi(uw.x); x0.z += w0.z * bflo(uw.y); x0.w += w0.w * bfhi(uw.y);
                        x1.x += w1.x * bflo(uw.z); x1.y += w1.y * bfhi(uw.z); x1.z += w1.z * bflo(uw.w); x1.w += w1.w * bfhi(uw.w);
                    }
                    *(LAS f32x4*)(xs + i * 64 + 32 * ks + 8 * kg) = x0; *(LAS f32x4*)(xs + i * 64 + 32 * ks + 8 * kg + 4) = x1;
                    u32x4 p; p.x = pk2(x0.x, x0.y); p.y = pk2(x0.z, x0.w); p.z = pk2(x1.x, x1.y); p.w = pk2(x1.z, x1.w);
                    af[ks] = __builtin_bit_cast(bf16x8, p);
                }
                f32x4 acc[8];
#pragma unroll
                for (int ct = 0; ct < 8; ++ct) { acc[ct] = (f32x4){0.f, 0.f, 0.f, 0.f};
#pragma unroll
                    for (int ks = 0; ks < 2; ++ks) acc[ct] = __builtin_amdgcn_mfma_f32_16x16x32_bf16(af[ks], wf[ct][ks], acc[ct], 0, 0, 0); }
#pragma unroll
                for (int ct = 0; ct < 4; ++ct) {
                    const int col = 16 * ct + i;
                    float hl[4], pl[4]; float hprev = 0.f, pprev = 1.f;
#pragma unroll
                    for (int e = 0; e < 4; ++e) {
                        const float gx = sigmoid_f(acc[ct][e] + bxv[ct]), ga = sigmoid_f(acc[ct + 4][e] + bav[ct]);
                        const float la = -8.0f * ga * spv[ct], av = __expf(la), xcv = xs[(4 * kg + e) * 64 + col];
                        const float bt = __builtin_amdgcn_sqrtf(fmaxf(1.0f - av * av, 0.f)) * gx * xcv;
                        hprev = av * hprev + bt; pprev *= av; hl[e] = hprev; pl[e] = pprev;
                    }
                    float Ag[4], Bg[4];
#pragma unroll
                    for (int gq = 0; gq < 4; ++gq) { Ag[gq] = __shfl(pl[3], i + 16 * gq); Bg[gq] = __shfl(hl[3], i + 16 * gq); }
                    float Ain = Arun[ct], Bin = Brun[ct];
#pragma unroll
                    for (int gq = 0; gq < 3; ++gq) if (gq < kg) { Bin = Ag[gq] * Bin + Bg[gq]; Ain *= Ag[gq]; }
                    float At = 1.f, Bt = 0.f;
#pragma unroll
                    for (int gq = 0; gq < 4; ++gq) { Bt = Ag[gq] * Bt + Bg[gq]; At *= Ag[gq]; }
                    Brun[ct] = At * Brun[ct] + Bt; Arun[ct] *= At;
#pragma unroll
                    for (int e = 0; e < 4; ++e) { const int ti_ = (4 * kg + e) * 64 + col; tP[ti_] = (bf16)f2bf(pl[e] * Ain); tH[ti_] = (bf16)f2bf(hl[e] + pl[e] * Bin); }
                }
                { const int rr = lane >> 2, cq = lane & 3;
                  bf16* pp = LA + (size_t)(m0 + rr) * 512 + nb * 64 + 16 * cq; bf16* hp = LB + (size_t)(m0 + rr) * 512 + nb * 64 + 16 * cq;
                  *(u32x4*)pp = *(const LAS u32x4*)(tP + rr * 64 + 16 * cq); *(u32x4*)(pp + 8) = *(const LAS u32x4*)(tP + rr * 64 + 16 * cq + 8);
                  *(u32x4*)hp = *(const LAS u32x4*)(tH + rr * 64 + 16 * cq); *(u32x4*)(hp + 8) = *(const LAS u32x4*)(tH + rr * 64 + 16 * cq + 8); }
            }
            if (kg == 0) {
#pragma unroll
                for (int ct = 0; ct < 4; ++ct) { f32x2 ab; ab.x = Arun[ct]; ab.y = Brun[ct];
                    *(f32x2*)((float*)(ws + WS_AP) + ((size_t)(((seg >> 6) * 8 + nb) * 64 + (seg & 63)) * 64 + 16 * ct + i) * 2) = ab; }
            }
        }
    }
    SEAM(2);


#define RW_ZB(zz, zb) do { _Pragma("unroll") for (int ks_ = 0; ks_ < 2; ++ks_) { u32x4 p_; p_.x = pk2(zz[2 * ks_][0], zz[2 * ks_][1]); p_.y = pk2(zz[2 * ks_][2], zz[2 * ks_][3]); \
        p_.z = pk2(zz[2 * ks_ + 1][0], zz[2 * ks_ + 1][1]); p_.w = pk2(zz[2 * ks_ + 1][2], zz[2 * ks_ + 1][3]); zb[ks_] = __builtin_bit_cast(bf16x8, p_); } } while (0)
    if (IN(3)) { PHASE_IDS;
        for (int u64 = gw; u64 < NB * NH * (SEQ / 64); u64 += NGW) {
#pragma unroll 1
        for (int jj = 0; jj < 4; ++jj) {
        LAS unsigned char* wl = lds + wave * 16384;
        LAS bf16* Arm = (LAS bf16*)(wl); LAS bf16* Brm = (LAS bf16*)(wl + 2048); LAS bf16* Krm = (LAS bf16*)(wl + 4096); LAS bf16* Rrm = (LAS bf16*)(wl + 6144);
        LAS bf16* ATt = (LAS bf16*)(wl + 8192); LAS bf16* BTt = (LAS bf16*)(wl + 10240); LAS bf16* KTt = (LAS bf16*)(wl + 12288); LAS bf16* VTt = (LAS bf16*)(wl + 14336);
        LAS float* MabT = (LAS float*)(wl); LAS bf16* Mak = (LAS bf16*)(wl + 1024); LAS bf16* Mrb = (LAS bf16*)(wl + 1536); LAS bf16* Mrk = (LAS bf16*)(wl + 2048); LAS bf16* Tm = (LAS bf16*)(wl + 2560);
        LAS float* PLs = (LAS float*)(wl + 3072); LAS bf16* Q0T = (LAS bf16*)(wl + 4096);
        const int lane = fresh_tid() & 63, l15 = lane & 15, g = lane >> 4, te = lane >> 2, kq = lane & 3;
        const bf16x8 z8 = (bf16x8){0, 0, 0, 0, 0, 0, 0, 0};
        const f32x4 z4 = (f32x4){0.f, 0.f, 0.f, 0.f};
            const int un = u64 * 4 + jj;
            const int bh = un >> 8, c = un & 255, b = bh >> 3, h = bh & 7;
            const size_t mrow = (size_t)b * SEQ + c * 16 + te, off = mrow * 512 + h * 64 + 16 * kq;
            const int hc = h * 64 + 16 * kq;
            LAS float* tmpL = (LAS float*)wl;
            {
                const int rsub = lane >> 5, chunk = lane & 31; const size_t mt0 = (size_t)b * SEQ + c * 16;
                const f32x4 m0 = *(const f32x4*)(args.in[I_MU] + 1536 + 8 * chunk), m1 = *(const f32x4*)(args.in[I_MU] + 1536 + 8 * chunk + 4);
                u32x4 cu[8], pu[8];
#pragma unroll
                for (int i = 0; i < 8; ++i) { const size_t mr = mt0 + 2 * i + rsub; const bool hp2 = (mr & (SEQ - 1)) != 0; const bf16* ua = U + mr * INW + 2560 + 8 * chunk;
                    cu[i] = *(const u32x4*)ua; pu[i] = *(const u32x4*)(ua - (hp2 ? INW : 0)); if (!hp2) pu[i] = (u32x4){0u, 0u, 0u, 0u}; }
#pragma unroll
                for (int i = 0; i < 8; ++i) { float o8[8];
#pragma unroll
                    for (int q = 0; q < 4; ++q) { const float c0 = bflo(cu[i][q]), c1 = bfhi(cu[i][q]), p0 = bflo(pu[i][q]), p1 = bfhi(pu[i][q]); const float mm0 = q < 2 ? m0[2 * q] : m1[2 * q - 4], mm1 = q < 2 ? m0[2 * q + 1] : m1[2 * q - 3];
                        float x0 = c0 + (p0 - c0) * mm0, x1 = c1 + (p1 - c1) * mm1;
                        if (chunk < 8) { x0 = tanh_fast(x0); x1 = tanh_fast(x1); }
                        else if (chunk >= 16) { x0 = sigmoid_f(x0); x1 = sigmoid_f(x1); }
                        o8[2 * q] = x0; o8[2 * q + 1] = x1; }
                    u32x4 pw; pw.x = pk2(o8[0], o8[1]); pw.y = pk2(o8[2], o8[3]); pw.z = pk2(o8[4], o8[5]); pw.w = pk2(o8[6], o8[7]);
                    const int row = 2 * i + rsub; *(LAS u32x4*)(wl + row * 512 + ((chunk ^ (row & 7)) << 4)) = pw; }
                bf16x8 af[8];
#pragma unroll
                for (int ks = 0; ks < 8; ++ks) af[ks] = *(const LAS bf16x8*)(wl + l15 * 512 + (((4 * ks + g) ^ (l15 & 7)) << 4));
                asm volatile("s_waitcnt lgkmcnt(0)" ::: "memory");
#pragma unroll
                for (int kind = 0; kind < 3; ++kind)
#pragma unroll
                    for (int ct = 0; ct < 4; ++ct) {
                        const bf16* lb = LoraB + ((size_t)((h * 3 + kind) * 4 + ct) * 8 * 64 + lane) * 8;
                        f32x4 a4 = z4;
#pragma unroll
                        for (int ks = (kind == 0 ? 0 : kind == 1 ? 2 : 4); ks < (kind == 0 ? 2 : kind == 1 ? 4 : 8); ++ks) a4 = __builtin_amdgcn_mfma_f32_16x16x32_bf16(af[ks], *(const bf16x8*)(lb + ks * 512), a4, 0, 0, 0);
#pragma unroll
                        for (int e = 0; e < 4; ++e) tmpL[kind * 1088 + (4 * g + e) * 68 + 16 * ct + l15] = a4[e];
                    }
            }
            asm volatile("s_waitcnt lgkmcnt(0)" ::: "memory");
            float cl[16], eP[16];
            {
                float lwv[16], rl[16], kl[16], vl[16], kn[16], av[16];
                const bool hp = (mrow & (SEQ - 1)) != 0;
                const bf16* ub = U + mrow * INW + 1024 + hc;
#pragma unroll
                for (int hh = 0; hh < 2; ++hh) {
#pragma unroll
                    for (int a3 = 0; a3 < 3; ++a3) {
                        const u32x4 cu = *(const u32x4*)(ub + 512 * a3 + 8 * hh); u32x4 pu = *(const u32x4*)(ub - (hp ? INW : 0) + 512 * a3 + 8 * hh); if (!hp) pu = (u32x4){0u, 0u, 0u, 0u};
                        const f32x4 m0 = *(const f32x4*)(args.in[I_MU] + 512 * a3 + hc + 8 * hh), m1 = *(const f32x4*)(args.in[I_MU] + 512 * a3 + hc + 8 * hh + 4);
                        float o8[8];
#pragma unroll
                        for (int q = 0; q < 4; ++q) { const float c0 = bflo(cu[q]), c1 = bfhi(cu[q]), p0 = bflo(pu[q]), p1 = bfhi(pu[q]); const float mm0 = q < 2 ? m0[2 * q] : m1[2 * q - 4], mm1 = q < 2 ? m0[2 * q + 1] : m1[2 * q - 3];
                            o8[2 * q] = c0 + (p0 - c0) * mm0; o8[2 * q + 1] = c1 + (p1 - c1) * mm1; }
#pragma unroll
                        for (int q = 0; q < 8; ++q) { if (a3 == 0) rl[8 * hh + q] = o8[q]; else if (a3 == 1) kl[8 * hh + q] = o8[q]; else vl[8 * hh + q] = o8[q]; }
                    }
                }
                float gv[16];
#pragma unroll
                for (int j4 = 0; j4 < 4; ++j4) { const f32x4 xl = *(const LAS f32x4*)(tmpL + te * 68 + 16 * kq + 4 * j4), xa = *(const LAS f32x4*)(tmpL + 1088 + te * 68 + 16 * kq + 4 * j4), xg = *(const LAS f32x4*)(tmpL + 2176 + te * 68 + 16 * kq + 4 * j4);
                    const f32x4 w0v = *(const f32x4*)(args.in[I_W0] + hc + 4 * j4), a0v = *(const f32x4*)(args.in[I_A0] + hc + 4 * j4);
#pragma unroll
                    for (int q = 0; q < 4; ++q) { const float wq = -softplus_fast(-(xl[q] + w0v[q])) - 0.5f; lwv[4 * j4 + q] = -__expf(wq); av[4 * j4 + q] = sigmoid_f(xa[q] + a0v[q]); gv[4 * j4 + q] = xg[q]; } }
                asm volatile("s_waitcnt lgkmcnt(0)" ::: "memory");
                float ss = 0.f;
#pragma unroll
                for (int j4 = 0; j4 < 4; ++j4) { const f32x4 kk4 = *(const f32x4*)(args.in[I_KK] + hc + 4 * j4);
#pragma unroll
                    for (int q = 0; q < 4; ++q) { kn[4 * j4 + q] = kl[4 * j4 + q] * kk4[q]; ss += kn[4 * j4 + q] * kn[4 * j4 + q]; } }
                ss += __shfl_xor(ss, 1); ss += __shfl_xor(ss, 2);
                const float kinv = rsq_f(fmaxf(ss, 1e-24f));
#pragma unroll
                for (int j = 0; j < 16; ++j) { float x = lwv[j];
#pragma unroll
                    for (int sft = 4; sft < 64; sft <<= 1) { const float y = __shfl_up(x, sft); if (lane >= sft) x += y; }
                    cl[j] = x; }
                float bon = 0.f;
                u32x4 pa[2], pb[2], pk[2], pr[2];
#pragma unroll
                for (int j4 = 0; j4 < 4; ++j4) {
                    const f32x4 ka = *(const f32x4*)(args.in[I_KA] + hc + 4 * j4), rk = *(const f32x4*)(args.in[I_RK] + hc + 4 * j4);
                    float at4[4], bt4[4], kt4[4], rt4[4];
#pragma unroll
                    for (int q = 0; q < 4; ++q) { const int j = 4 * j4 + q;
                        const float p = __expf(cl[j]), pn = __expf(-cl[j]), pm1 = __expf(cl[j] - lwv[j]); eP[j] = p;
                        const float knj = kn[j] * kinv;
                        const float kp = kl[j] * (1.0f + (av[j] - 1.0f) * ka[q]);
                        at4[q] = -knj * pm1; bt4[q] = knj * av[j] * pn; kt4[q] = kp * pn; rt4[q] = rl[j] * p;
                        bon += rl[j] * kp * rk[q];
                        const int kk = 16 * kq + j;
                        ATt[kk * 16 + te] = (bf16)f2bf(at4[q]); BTt[kk * 16 + te] = (bf16)f2bf(bt4[q]); KTt[kk * 16 + te] = (bf16)f2bf(kt4[q]); VTt[kk * 16 + te] = (bf16)f2bf(vl[j]); }
                    const int hh = j4 >> 1, w2 = (j4 & 1) * 2;
                    pa[hh][w2] = pk2(at4[0], at4[1]); pa[hh][w2 + 1] = pk2(at4[2], at4[3]); pb[hh][w2] = pk2(bt4[0], bt4[1]); pb[hh][w2 + 1] = pk2(bt4[2], bt4[3]);
                    pk[hh][w2] = pk2(kt4[0], kt4[1]); pk[hh][w2 + 1] = pk2(kt4[2], kt4[3]); pr[hh][w2] = pk2(rt4[0], rt4[1]); pr[hh][w2 + 1] = pk2(rt4[2], rt4[3]);
                }
#pragma unroll
                for (int hh = 0; hh < 2; ++hh) { const int po = te * 64 + 8 * ((2 * kq + hh) ^ (te & 7));
                    *(LAS u32x4*)(Arm + po) = pa[hh]; *(LAS u32x4*)(Brm + po) = pb[hh]; *(LAS u32x4*)(Krm + po) = pk[hh]; *(LAS u32x4*)(Rrm + po) = pr[hh]; }
                bon += __shfl_xor(bon, 1); bon += __shfl_xor(bon, 2);
                f32x4 lbv[4], lgv[4];
#pragma unroll
                for (int j4 = 0; j4 < 4; ++j4) { lbv[j4] = *(const f32x4*)(args.in[I_LNB] + hc + 4 * j4); lgv[j4] = *(const f32x4*)(args.in[I_LNG] + hc + 4 * j4); }
#pragma unroll
                for (int j4 = 0; j4 < 4; ++j4) { const f32x4 lb = lbv[j4], lgn = lgv[j4]; const int j0 = 4 * j4;
                    u32x2 ow, gw2; ow.x = pk2((lb.x + vl[j0] * bon) * gv[j0], (lb.y + vl[j0 + 1] * bon) * gv[j0 + 1]); ow.y = pk2((lb.z + vl[j0 + 2] * bon) * gv[j0 + 2], (lb.w + vl[j0 + 3] * bon) * gv[j0 + 3]);
                    gw2.x = pk2(lgn.x * gv[j0], lgn.y * gv[j0 + 1]); gw2.y = pk2(lgn.z * gv[j0 + 2], lgn.w * gv[j0 + 3]);
                    *(u32x2*)((bf16*)(ws + WS_ADD) + off + j0) = ow; *(u32x2*)((bf16*)(ws + WS_G) + off + j0) = gw2; }
            }
            asm volatile("s_waitcnt lgkmcnt(0)" ::: "memory");
            {
                bf16x8 fa[2], fr[2], fb[2], fk[2];
#pragma unroll
                for (int ks = 0; ks < 2; ++ks) { const int po = l15 * 64 + 8 * ((4 * ks + g) ^ (l15 & 7));
                    fa[ks] = *(const LAS bf16x8*)(Arm + po); fr[ks] = *(const LAS bf16x8*)(Rrm + po); fb[ks] = *(const LAS bf16x8*)(Brm + po); fk[ks] = *(const LAS bf16x8*)(Krm + po); }
                f32x4 mab = z4, mak = z4, mrb = z4, mrk = z4;
#pragma unroll
                for (int ks = 0; ks < 2; ++ks) { mab = __builtin_amdgcn_mfma_f32_16x16x32_bf16(fb[ks], fa[ks], mab, 0, 0, 0); mak = __builtin_amdgcn_mfma_f32_16x16x32_bf16(fk[ks], fa[ks], mak, 0, 0, 0);
                    mrb = __builtin_amdgcn_mfma_f32_16x16x32_bf16(fb[ks], fr[ks], mrb, 0, 0, 0); mrk = __builtin_amdgcn_mfma_f32_16x16x32_bf16(fk[ks], fr[ks], mrk, 0, 0, 0); }
#pragma unroll
                for (int e = 0; e < 4; ++e) { const int i = 4 * g + e; if (!(i < l15)) { mab[e] = 0.f; mak[e] = 0.f; } if (!(i <= l15)) { mrb[e] = 0.f; mrk[e] = 0.f; } }
                asm volatile("s_waitcnt lgkmcnt(0)" ::: "memory");
#pragma unroll
                for (int e = 0; e < 4; ++e) MabT[(4 * g + e) * 16 + l15] = mab[e];
                u32x2 w; w.x = pk2(mak[0], mak[1]); w.y = pk2(mak[2], mak[3]); *(LAS u32x2*)(Mak + l15 * 16 + 4 * g) = w;
                w.x = pk2(mrb[0], mrb[1]); w.y = pk2(mrb[2], mrb[3]); *(LAS u32x2*)(Mrb + l15 * 16 + 4 * g) = w;
                w.x = pk2(mrk[0], mrk[1]); w.y = pk2(mrk[2], mrk[3]); *(LAS u32x2*)(Mrk + l15 * 16 + 4 * g) = w;
                if (te == 15) {
#pragma unroll
                    for (int j = 0; j < 16; ++j) PLs[16 * kq + j] = eP[j]; }
            }
            asm volatile("s_waitcnt lgkmcnt(0)" ::: "memory");
            {
                f32x4 mq[15][4];
#pragma unroll
                for (int j = 0; j < 15; ++j)
#pragma unroll
                    for (int q = 0; q < 4; ++q) if (4 * q + 3 > j) mq[j][q] = *(const LAS f32x4*)(MabT + j * 16 + 4 * q);
                float y[16];
#pragma unroll
                for (int j = 15; j >= 0; --j) {
                    float acc = (j == l15) ? 1.0f : 0.0f;
#pragma unroll
                    for (int i = j + 1; i < 16; ++i) acc += y[i] * mq[j < 15 ? j : 0][i >> 2][i & 3];
                    y[j] = acc;
                }
                if (g == 0) { u32x4 t0, t1; t0.x = pk2(y[0], y[1]); t0.y = pk2(y[2], y[3]); t0.z = pk2(y[4], y[5]); t0.w = pk2(y[6], y[7]); t1.x = pk2(y[8], y[9]); t1.y = pk2(y[10], y[11]); t1.z = pk2(y[12], y[13]); t1.w = pk2(y[14], y[15]);
                    *(LAS u32x4*)(Tm + l15 * 16) = t0; *(LAS u32x4*)(Tm + l15 * 16 + 8) = t1; }
            }
            asm volatile("s_waitcnt lgkmcnt(0)" ::: "memory");
            {
                const bool act = g < 2; const int fo = l15 * 16 + 8 * g;
                const bf16x8 fT = act ? *(const LAS bf16x8*)(Tm + fo) : z8, fMak = act ? *(const LAS bf16x8*)(Mak + fo) : z8, fMrb = act ? *(const LAS bf16x8*)(Mrb + fo) : z8, fMrk = act ? *(const LAS bf16x8*)(Mrk + fo) : z8;
                bf16x8 fV[4], fQ1[4], fAh[4], fBT[4], fKT[4];
#pragma unroll
                for (int vt = 0; vt < 4; ++vt) { fV[vt] = act ? *(const LAS bf16x8*)(VTt + vt * 256 + fo) : z8; fBT[vt] = act ? *(const LAS bf16x8*)(BTt + vt * 256 + fo) : z8; fKT[vt] = act ? *(const LAS bf16x8*)(KTt + vt * 256 + fo) : z8; }
#pragma unroll
                for (int vt = 0; vt < 4; ++vt) { const f32x4 q0 = __builtin_amdgcn_mfma_f32_16x16x32_bf16(fMak, fV[vt], z4, 0, 0, 0);
                    u32x2 w; w.x = pk2(q0[0], q0[1]); w.y = pk2(q0[2], q0[3]); *(LAS u32x2*)(Q0T + vt * 256 + l15 * 16 + 4 * g) = w; }
#pragma unroll
                for (int kt = 0; kt < 4; ++kt) { const bf16x8 fA = act ? *(const LAS bf16x8*)(ATt + kt * 256 + fo) : z8; const f32x4 ah = __builtin_amdgcn_mfma_f32_16x16x32_bf16(fT, fA, z4, 0, 0, 0);
                    u32x2 w; w.x = pk2(ah[0], ah[1]); w.y = pk2(ah[2], ah[3]); *(LAS u32x2*)(ATt + kt * 256 + l15 * 16 + 4 * g) = w; }
                asm volatile("s_waitcnt lgkmcnt(0)" ::: "memory");
#pragma unroll
                for (int vt = 0; vt < 4; ++vt) { const bf16x8 fQ0 = act ? *(const LAS bf16x8*)(Q0T + vt * 256 + fo) : z8; const f32x4 q1 = __builtin_amdgcn_mfma_f32_16x16x32_bf16(fT, fQ0, z4, 0, 0, 0);
                    u32x2 w; w.x = pk2(q1[0], q1[1]); w.y = pk2(q1[2], q1[3]); *(LAS u32x2*)(Q0T + vt * 256 + l15 * 16 + 4 * g) = w; }
                asm volatile("s_waitcnt lgkmcnt(0)" ::: "memory");
#pragma unroll
                for (int vt = 0; vt < 4; ++vt) { fQ1[vt] = act ? *(const LAS bf16x8*)(Q0T + vt * 256 + fo) : z8; fAh[vt] = act ? *(const LAS bf16x8*)(ATt + vt * 256 + fo) : z8; }
                bf16* rp = (bf16*)(ws + WS_RP) + (size_t)un * 1024 + l15 * 64;
#pragma unroll
                for (int kt = 0; kt < 4; ++kt) {
                    const u32x2 rr = *(const LAS u32x2*)(Rrm + l15 * 64 + 8 * ((2 * kt + (g >> 1)) ^ (l15 & 7)) + 4 * (g & 1));
                    f32x4 ini; ini[0] = bflo(rr.x); ini[1] = bfhi(rr.x); ini[2] = bflo(rr.y); ini[3] = bfhi(rr.y);
                    const f32x4 rh = __builtin_amdgcn_mfma_f32_16x16x32_bf16(fAh[kt], fMrb, ini, 0, 0, 0);
                    u32x2 w; w.x = pk2(rh[0], rh[1]); w.y = pk2(rh[2], rh[3]); *(u32x2*)(rp + 32 * (kt >> 1) + 8 * g + 4 * (kt & 1)) = w;
                }
#pragma unroll
                for (int vt = 0; vt < 4; ++vt) { f32x4 y1 = __builtin_amdgcn_mfma_f32_16x16x32_bf16(fMrb, fQ1[vt], z4, 0, 0, 0); y1 = __builtin_amdgcn_mfma_f32_16x16x32_bf16(fMrk, fV[vt], y1, 0, 0, 0);
                    *(f32x4*)((float*)(ws + WS_Y1F) + ((size_t)(un * 4 + vt) * 64 + lane) * 4) = y1; }
                LAS bf16* tgs = (LAS bf16*)(wl + 8192);
#pragma unroll
                for (int krt = 0; krt < 4; ++krt) { const float pl = PLs[16 * krt + l15];
#pragma unroll
                    for (int kct = 0; kct < 4; ++kct) { f32x4 ga = __builtin_amdgcn_mfma_f32_16x16x32_bf16(fAh[kct], fBT[krt], z4, 0, 0, 0);
                        if (kct == krt) {
#pragma unroll
                            for (int e = 0; e < 4; ++e) if (4 * g + e == l15) ga[e] += 1.0f; }
                        u32x2 w; w.x = pk2(ga[0] * pl, ga[1] * pl); w.y = pk2(ga[2] * pl, ga[3] * pl);
                        *(LAS u32x2*)(tgs + (16 * krt + l15) * 64 + 32 * (kct >> 1) + 8 * g + 4 * (kct & 1)) = w; } }
                { u32x4* gp16 = (u32x4*)((bf16*)(ws + WS_GP) + (size_t)un * 4096);
#pragma unroll
                  for (int i = 0; i < 8; ++i) gp16[i * 64 + lane] = *(const LAS u32x4*)(tgs + (i * 64 + lane) * 8); }
#pragma unroll
                for (int mt = 0; mt < 4; ++mt) { const f32x4 pl4 = *(const LAS f32x4*)(PLs + 16 * mt + 4 * g);
#pragma unroll
                    for (int vt = 0; vt < 4; ++vt) { f32x4 ha = __builtin_amdgcn_mfma_f32_16x16x32_bf16(fBT[mt], fQ1[vt], z4, 0, 0, 0); ha = __builtin_amdgcn_mfma_f32_16x16x32_bf16(fKT[mt], fV[vt], ha, 0, 0, 0);
                        u32x2 w; w.x = pk2(ha[0] * pl4[0], ha[1] * pl4[1]); w.y = pk2(ha[2] * pl4[2], ha[3] * pl4[3]);
                        *(u32x2*)((bf16*)(ws + WS_HF) + ((size_t)((un * 4 + vt) * 4 + mt) * 64 + lane) * 4) = w; } }
            }
            asm volatile("s_waitcnt lgkmcnt(0)" ::: "memory");
        }
        asm volatile("s_waitcnt vmcnt(0)" ::: "memory");
        { const int ltid = fresh_tid() & 63, l15 = ltid & 15, g = ltid >> 4, lane = ltid;
#define CP_LOADG(gf_, j_) do { const bf16* gp_ = (const bf16*)(ws + WS_GP) + ((size_t)u64 * 4 + (j_)) * 4096 + l15 * 64 + 8 * g; \
            _Pragma("unroll") for (int mt = 0; mt < 4; ++mt) { gf_[mt][0] = *(const bf16x8*)(gp_ + mt * 1024); gf_[mt][1] = *(const bf16x8*)(gp_ + mt * 1024 + 32); } } while (0)
#define CP_LOADH(hf_, j_) do { _Pragma("unroll") for (int sl = 0; sl < 4; ++sl) _Pragma("unroll") for (int mt = 0; mt < 4; ++mt) \
            hf_[sl][mt] = *(const u32x2*)((const bf16*)(ws + WS_HF) + ((size_t)((((size_t)u64 * 4 + (j_)) * 4 + sl) * 4 + mt) * 64 + lane) * 4); } while (0)
#define CP_STEP(gf_, hf_, useh_) do { _Pragma("unroll") for (int sl = 0; sl < 4; ++sl) { bf16x8 zb[2]; RW_ZB(z[sl], zb); \
            _Pragma("unroll") for (int mt = 0; mt < 4; ++mt) { f32x4 a_ = (f32x4){0.f, 0.f, 0.f, 0.f}; \
                if (useh_) { a_[0] = bflo(hf_[sl][mt].x); a_[1] = bfhi(hf_[sl][mt].x); a_[2] = bflo(hf_[sl][mt].y); a_[3] = bfhi(hf_[sl][mt].y); } \
                a_ = __builtin_amdgcn_mfma_f32_16x16x32_bf16(gf_[mt][0], zb[0], a_, 0, 0, 0); a_ = __builtin_amdgcn_mfma_f32_16x16x32_bf16(gf_[mt][1], zb[1], a_, 0, 0, 0); z[sl][mt] = a_; } } } while (0)
        {
            f32x4 z[4][4];
#pragma unroll
            for (int sl = 0; sl < 4; ++sl)
#pragma unroll
                for (int mt = 0; mt < 4; ++mt)
#pragma unroll
                    for (int e = 0; e < 4; ++e) z[sl][mt][e] = (sl == mt && 4 * g + e == l15) ? 1.0f : 0.0f;
            bf16x8 gA[4][2], gB[4][2]; u32x2 hdum[4][4];
            CP_LOADG(gA, 0); CP_LOADG(gB, 1);
            CP_STEP(gA, hdum, false); CP_LOADG(gA, 2);
            CP_STEP(gB, hdum, false); CP_LOADG(gB, 3);
            CP_STEP(gA, hdum, false);
            CP_STEP(gB, hdum, false);
            LAS bf16* tg = (LAS bf16*)(lds + wave * 16384);
#pragma unroll
            for (int sl = 0; sl < 4; ++sl) { const int pc = 32 * (sl >> 1) + 8 * (l15 >> 2) + 4 * (sl & 1) + (l15 & 3);
#pragma unroll
                for (int mt = 0; mt < 4; ++mt)
#pragma unroll
                    for (int e = 0; e < 4; ++e) tg[(16 * mt + 4 * g + e) * 64 + pc] = (bf16)f2bf(z[sl][mt][e]); }
            u32x4* gc = (u32x4*)((bf16*)(ws + WS_GC) + (size_t)u64 * 4096);
#pragma unroll
            for (int i = 0; i < 8; ++i) gc[i * 64 + lane] = *(const LAS u32x4*)(tg + (i * 64 + lane) * 8);
        }
        {
            f32x4 z[4][4];
#pragma unroll
            for (int sl = 0; sl < 4; ++sl)
#pragma unroll
                for (int mt = 0; mt < 4; ++mt) z[sl][mt] = (f32x4){0.f, 0.f, 0.f, 0.f};
            bf16x8 gA[4][2], gB[4][2]; u32x2 hA[4][4], hB[4][4];
            CP_LOADG(gA, 0); CP_LOADH(hA, 0); CP_LOADG(gB, 1); CP_LOADH(hB, 1);
            CP_STEP(gA, hA, true); CP_LOADG(gA, 2); CP_LOADH(hA, 2);
            CP_STEP(gB, hB, true); CP_LOADG(gB, 3); CP_LOADH(hB, 3);
            CP_STEP(gA, hA, true);
            CP_STEP(gB, hB, true);
#pragma unroll
            for (int sl = 0; sl < 4; ++sl)
#pragma unroll
                for (int mt = 0; mt < 4; ++mt) { u32x2 w; w.x = pk2(z[sl][mt][0], z[sl][mt][1]); w.y = pk2(z[sl][mt][2], z[sl][mt][3]);
                    *(u32x2*)((bf16*)(ws + WS_HC) + ((size_t)((u64 * 4 + sl) * 4 + mt) * 64 + lane) * 4) = w; }
        }
#undef CP_LOADG
#undef CP_LOADH
#undef CP_STEP
        }
        }
    }
    SEAM(3);


    if (IN(4)) { PHASE_IDS;
        if (!(bid < 128 && wave == 0)) {
            const int wi = bid < 128 ? bid * 7 + (wave - 1) : 896 + (bid - 128) * 8 + wave, NW = 896 + (G - 128) * 8;
        } else {
            const int l15 = lane & 15, g = lane >> 4, bh = bid >> 2, vs = bid & 3;
            f32x4 z[4];
#pragma unroll
            for (int mt = 0; mt < 4; ++mt) z[mt] = (f32x4){0.f, 0.f, 0.f, 0.f};
            bf16x8 gA[4][2], gB[4][2], gC[4][2], gD[4][2]; u32x2 hA[4], hB[4], hC[4], hD[4];
#define SC_LOAD(gf, hf, C) do { const size_t u64_ = (size_t)bh * 64 + (C); const bf16* gp_ = (const bf16*)(ws + WS_GC) + u64_ * 4096 + l15 * 64 + 8 * g; \
                _Pragma("unroll") for (int mt = 0; mt < 4; ++mt) { gf[mt][0] = *(const bf16x8*)(gp_ + mt * 1024); gf[mt][1] = *(const bf16x8*)(gp_ + mt * 1024 + 32); \
                    hf[mt] = *(const u32x2*)((const bf16*)(ws + WS_HC) + ((size_t)((u64_ * 4 + vs) * 4 + mt) * 64 + lane) * 4); } } while (0)
#define SC_STEP(gf, hf, C) do { const size_t u64_ = (size_t)bh * 64 + (C); bf16* zs_ = (bf16*)(ws + WS_ZS) + ((size_t)((u64_ * 4 + vs) * 4) * 64 + lane) * 4; \
                _Pragma("unroll") for (int mt = 0; mt < 4; ++mt) { u32x2 zw_; zw_.x = pk2(z[mt][0], z[mt][1]); zw_.y = pk2(z[mt][2], z[mt][3]); *(u32x2*)(zs_ + mt * 256) = zw_; } \
                bf16x8 zb[2]; RW_ZB(z, zb); \
                _Pragma("unroll") for (int mt = 0; mt < 4; ++mt) { f32x4 a; a[0] = bflo(hf[mt].x); a[1] = bfhi(hf[mt].x); a[2] = bflo(hf[mt].y); a[3] = bfhi(hf[mt].y); \
                    a = __builtin_amdgcn_mfma_f32_16x16x32_bf16(gf[mt][0], zb[0], a, 0, 0, 0); a = __builtin_amdgcn_mfma_f32_16x16x32_bf16(gf[mt][1], zb[1], a, 0, 0, 0); z[mt] = a; } } while (0)
            SC_LOAD(gA, hA, 0); SC_LOAD(gB, hB, 1); SC_LOAD(gC, hC, 2);
#pragma unroll 1
            for (int C = 0; C < 64; C += 4) {
                SC_LOAD(gD, hD, C + 3);
                SC_STEP(gA, hA, C);
                if (C + 4 < 64) SC_LOAD(gA, hA, C + 4);
                SC_STEP(gB, hB, C + 1);
                if (C + 5 < 64) SC_LOAD(gB, hB, C + 5);
                SC_STEP(gC, hC, C + 2);
                if (C + 6 < 64) SC_LOAD(gC, hC, C + 6);
                SC_STEP(gD, hD, C + 3);
            }
#undef SC_LOAD
#undef SC_STEP
        }
    }
    if (IN(4)) { PHASE_IDS;
        if (bid < 32 && wave == 1) { const int bc = bid; const f32x2* ag = (const f32x2*)((const float*)(ws + WS_AP)) + (size_t)(bc * 64) * 64 + lane;
            float* car = (float*)(ws + WS_AP + 4 * MiB) + (size_t)(bc * 64) * 64 + lane; float hst = 0.f;
#pragma unroll 16
            for (int sg = 0; sg < 64; ++sg) { const f32x2 ab = ag[(size_t)sg * 64]; car[(size_t)sg * 64] = hst; hst = ab.x * hst + ab.y; } }
    }
    if (IN(4)) { PHASE_IDS;
        bf16* WKt = HN; bf16* VWt = HN + (size_t)4 * 1024 * 1024;
        __syncthreads();
        if (bid >= 128 && bid < 192) { pg8::FoldSched<0> S; S.A = (const char*)KM; S.B = (const char*)Wq_t; S.G = 64; S.c = bid - 128; EpiFold<0> E{WKt}; pg8::gemm_phase(lds, 256, S, E, 1024); }
        else if (bid >= 192) { pg8::FoldSched<1> S; S.A = (const char*)Wo_t; S.B = (const char*)VT; S.G = 64; S.c = bid - 192; EpiFold<1> E{VWt}; pg8::gemm_phase(lds, 256, S, E, 1024); }
    }
    SEAM(4);

    if (IN(5)) { PHASE_IDS;
        {
            for (int lu = gw; lu < (M / 64) * 8; lu += NGW) {
                const int seg = lu >> 3, nb = lu & 7, rr = lane >> 3, cq = lane & 7;
                const float* cp = (const float*)(ws + WS_AP + 4 * MiB) + ((size_t)(((seg >> 6) * 8 + nb) * 64 + (seg & 63)) * 64 + 8 * cq);
                const f32x4 c0 = *(const f32x4*)cp, c1 = *(const f32x4*)(cp + 4);
#pragma unroll
                for (int it = 0; it < 8; ++it) { const size_t m = (size_t)seg * 64 + 8 * it + rr; const size_t o = m * 512 + nb * 64 + 8 * cq;
                    const u32x4 pw = *(const u32x4*)(LA + o), hw = *(const u32x4*)(LB + o), gw_ = *(const u32x4*)(U + m * INW + 512 + nb * 64 + 8 * cq);
                    float y[8];
#pragma unroll
                    for (int q = 0; q < 4; ++q) { const float ca = q < 2 ? c0[2 * q] : c1[2 * q - 4], cb = q < 2 ? c0[2 * q + 1] : c1[2 * q - 3];
                        y[2 * q] = (bflo(hw[q]) + bflo(pw[q]) * ca) * gelu_tanh_f(bflo(gw_[q])); y[2 * q + 1] = (bfhi(hw[q]) + bfhi(pw[q]) * cb) * gelu_tanh_f(bfhi(gw_[q])); }
                    u32x4 w; w.x = pk2(y[0], y[1]); w.y = pk2(y[2], y[3]); w.z = pk2(y[4], y[5]); w.w = pk2(y[6], y[7]);
                    *(u32x4*)(CAT + m * 1024 + nb * 64 + 8 * cq) = w; }
            }
        }
        const int l15 = lane & 15, g = lane >> 4;
        LAS bf16* tGL = (LAS bf16*)(lds + wave * 16384); LAS bf16* tAD = tGL + 1024; LAS bf16* tOUT = tGL + 2048;
        const int ct = lane >> 3, cc = lane & 7;
        for (int u64 = gw; u64 < NB * NH * (SEQ / 64); u64 += NGW) {
            const int bh = u64 >> 6, C = u64 & 63, b = bh >> 3, h = bh & 7;
            f32x4 z[4][4];
#pragma unroll
            for (int sl = 0; sl < 4; ++sl)
#pragma unroll
                for (int mt = 0; mt < 4; ++mt) { const u32x2 zw = *(const u32x2*)((const bf16*)(ws + WS_ZS) + ((size_t)((u64 * 4 + sl) * 4 + mt) * 64 + lane) * 4); z[sl][mt] = (f32x4){bflo(zw.x), bfhi(zw.x), bflo(zw.y), bfhi(zw.y)}; }
#pragma unroll 1
            for (int j = 0; j < 4; ++j) {
                const size_t un = (size_t)u64 * 4 + j; const size_t m0 = (size_t)b * SEQ + (C * 4 + j) * 16;
                const bf16* rp = (const bf16*)(ws + WS_RP) + un * 1024 + l15 * 64 + 8 * g;
                const bf16x8 rf0 = *(const bf16x8*)rp, rf1 = *(const bf16x8*)(rp + 32);
                f32x4 y[4];
#pragma unroll
                for (int sl = 0; sl < 4; ++sl) y[sl] = *(const f32x4*)((const float*)(ws + WS_Y1F) + ((size_t)(un * 4 + sl) * 64 + lane) * 4);
                const size_t rg = (m0 + ct) * 512 + h * 64 + 8 * cc;
                const u32x4 gl0 = *(const u32x4*)((const bf16*)(ws + WS_G) + rg), gl1 = *(const u32x4*)((const bf16*)(ws + WS_G) + rg + 8 * 512);
                const u32x4 ad0 = *(const u32x4*)((const bf16*)(ws + WS_ADD) + rg), ad1 = *(const u32x4*)((const bf16*)(ws + WS_ADD) + rg + 8 * 512);
                bf16x8 gf[4][2]; u32x2 hfr[4][4];
                if (j < 3) {
                    const bf16* gp = (const bf16*)(ws + WS_GP) + un * 4096 + l15 * 64 + 8 * g;
#pragma unroll
                    for (int mt = 0; mt < 4; ++mt) { gf[mt][0] = *(const bf16x8*)(gp + mt * 1024); gf[mt][1] = *(const bf16x8*)(gp + mt * 1024 + 32); }
#pragma unroll
                    for (int sl = 0; sl < 4; ++sl)
#pragma unroll
                        for (int mt = 0; mt < 4; ++mt) hfr[sl][mt] = *(const u32x2*)((const bf16*)(ws + WS_HF) + ((size_t)((un * 4 + sl) * 4 + mt) * 64 + lane) * 4);
                }
                *(LAS u32x4*)(tGL + ct * 64 + 8 * cc) = gl0; *(LAS u32x4*)(tGL + (ct + 8) * 64 + 8 * cc) = gl1;
                *(LAS u32x4*)(tAD + ct * 64 + 8 * cc) = ad0; *(LAS u32x4*)(tAD + (ct + 8) * 64 + 8 * cc) = ad1;
                bf16x8 zb[4][2];
#pragma unroll
                for (int sl = 0; sl < 4; ++sl) { RW_ZB(z[sl], zb[sl]);
                    y[sl] = __builtin_amdgcn_mfma_f32_16x16x32_bf16(rf0, zb[sl][0], y[sl], 0, 0, 0); y[sl] = __builtin_amdgcn_mfma_f32_16x16x32_bf16(rf1, zb[sl][1], y[sl], 0, 0, 0); }
#pragma unroll
                for (int e = 0; e < 4; ++e) {
                    float s1 = (y[0][e] + y[1][e]) + (y[2][e] + y[3][e]);
                    s1 += __shfl_xor(s1, 1); s1 += __shfl_xor(s1, 2); s1 += __shfl_xor(s1, 4); s1 += __shfl_xor(s1, 8);
                    const float mean = s1 * (1.0f / 64.0f);
                    float d0 = y[0][e] - mean, d1 = y[1][e] - mean, d2 = y[2][e] - mean, d3 = y[3][e] - mean;
                    float s2 = (d0 * d0 + d1 * d1) + (d2 * d2 + d3 * d3);
                    s2 += __shfl_xor(s2, 1); s2 += __shfl_xor(s2, 2); s2 += __shfl_xor(s2, 4); s2 += __shfl_xor(s2, 8);
                    const float rstd = rsq_f(s2 * (1.0f / 64.0f) + GN_EPS);
                    const float dd[4] = {d0, d1, d2, d3};
#pragma unroll
                    for (int sl = 0; sl < 4; ++sl) { const int ti_ = (4 * g + e) * 64 + 16 * sl + l15;
                        const float o = dd[sl] * rstd * bf2f(tGL[ti_]) + bf2f(tAD[ti_]); tOUT[ti_] = (bf16)f2bf(o); }
                }
                { bf16* cp = CAT + (m0 + ct) * 1024 + 512 + h * 64 + 8 * cc;
                  *(u32x4*)cp = *(const LAS u32x4*)(tOUT + ct * 64 + 8 * cc); *(u32x4*)(cp + 8 * 1024) = *(const LAS u32x4*)(tOUT + (ct + 8) * 64 + 8 * cc); }
                if (j < 3) {
#pragma unroll
                    for (int sl = 0; sl < 4; ++sl)
#pragma unroll
                        for (int mt = 0; mt < 4; ++mt) { const u32x2 hh = hfr[sl][mt];
                            f32x4 a; a[0] = bflo(hh.x); a[1] = bfhi(hh.x); a[2] = bflo(hh.y); a[3] = bfhi(hh.y);
                            a = __builtin_amdgcn_mfma_f32_16x16x32_bf16(gf[mt][0], zb[sl][0], a, 0, 0, 0); a = __builtin_amdgcn_mfma_f32_16x16x32_bf16(gf[mt][1], zb[sl][1], a, 0, 0, 0); z[sl][mt] = a; }
                }
            }
        }
    }
    SEAM(5);
#undef RW_ZB


    if (IN(6)) { PHASE_IDS;
        pg8::DenseSched S; S.o.init_tiles(M / 256, D / 256, G, bid); S.A = (const char*)CAT; S.B = (const char*)Wout_t; S.tstep = (size_t)256 * D * 2;
        EpiBf16Res<false> E{args.in[I_X], X1, D, (float*)(ws + WS_AP + 2 * MiB)}; pg8::gemm_phase(lds, D, S, E);
    }
    SEAM(6);
    if (IN(7)) { PHASE_IDS;
        pg8::BatchBSched S; S.o.init_tiles(M / 256, D / 256, G, bid); S.A = (const char*)X1; S.B = (const char*)HN; S.tstep = (size_t)256 * D * 2; S.bstep = (size_t)1024 * 1024 * 2;
        EpiSoftmax E{Qb, 0.0625f, (const float*)(ws + WS_AP + 2 * MiB), (LAS float*)(lds + RING_BYTES + 1024), (LAS float*)(lds + RING_BYTES + 1024 + 4096)};
        pg8::gemm_phase(lds, D, S, E);
    }
    SEAM(7);
    if (IN(8)) { PHASE_IDS;
        pg8::BatchBSched S; S.o.init_tiles(M / 256, D / 256, G, bid); S.A = (const char*)Qb; S.B = (const char*)(HN + (size_t)4 * 1024 * 1024); S.tstep = (size_t)256 * D * 2; S.bstep = (size_t)1024 * 1024 * 2;
        EpiBf16Res<true> E{X1, X2, D, nullptr}; pg8::gemm_phase(lds, D, S, E);
    }
    SEAM(8);
    if (IN(9)) { PHASE_IDS;
        for (int cid = tid; cid < 2 * NE * 128; cid += NTHREADS) { const int t = cid >> 12, row = (cid >> 7) & 31, c = cid & 127;
            *(LAS u32x4*)(lds + t * 65536 + row * 2048 + ((c ^ (row & 7)) << 4)) = *(const u32x4*)(WrT + (size_t)t * NE * D + row * D + 8 * c); }
        __syncthreads();
        const int l15 = lane & 15, g = lane >> 4;
        LAS float* LG = (LAS float*)(lds + RING_BYTES + 1024 + wave * 2304);
        const float* gfn = args.in[I_NFFG];
        LAS unsigned* cntl = (LAS unsigned*)(lds + RING_BYTES + 640);
        for (int t0 = 0; t0 < M / 16; t0 += G * 4) {
        if (tid < 64) cntl[tid] = 0u;
        __syncthreads();
        if (t0 == 0 && wave >= 4) {
            constexpr int I_GU = 16 * 64;
            for (int r = bid * 4 + (wave - 4); r < CONV_P9; r += G * 4) { const int e = r / I_GU, q = r % I_GU, kb = q / 64, nb = q % 64; const int n0 = 32 * nb;
                const int drow = n0 < 1024 ? (256 * (n0 >> 7) + (n0 & 127)) : (256 * ((n0 - 1024) >> 7) + 128 + ((n0 - 1024) & 127));
                transpose_item_tiled_nolds(args.in[I_WGU] + (size_t)e * D * 2048, 2048, D, Wgu_t + (size_t)e * 2048 * D, 64 * kb, n0, drow, lane); }
        }
        const int tile = t0 + bid * 4 + wave; const bool active = wave < 4 && tile < M / 16;
        int me = 0, lpos = 0, ai = 0; float mg = 0.f;
        if (active) {
            const int m0 = tile * 16;
            const bf16* xrow = X2 + (size_t)(m0 + l15) * D + 8 * g;
            float ss = 0.f;
#pragma unroll 8
            for (int ks = 0; ks < 32; ++ks) { const u32x4 xw = *(const u32x4*)(xrow + 32 * ks);
#pragma unroll
                for (int q = 0; q < 4; ++q) { const float a = bflo(xw[q]), c = bfhi(xw[q]); ss += a * a + c * c; } }
            ss += __shfl_xor(ss, 16); ss += __shfl_xor(ss, 32);
            const float rstd = rsq_f(ss * (1.f / D) + EPS);
            f32x4 acc0 = (f32x4){0.f, 0.f, 0.f, 0.f}, acc1 = acc0;
            bf16* hrow = HN + (size_t)(m0 + l15) * D + 8 * g;
#pragma unroll 2
            for (int ks = 0; ks < 32; ++ks) {
                const f32x4 g0 = *(const f32x4*)(gfn + 32 * ks + 8 * g), g1 = *(const f32x4*)(gfn + 32 * ks + 8 * g + 4);
                const u32x4 xw = *(const u32x4*)(xrow + 32 * ks);
                float hf[8];
#pragma unroll
                for (int q = 0; q < 4; ++q) { hf[2 * q] = bflo(xw[q]) * rstd * (q < 2 ? g0[2 * q] : g1[2 * q - 4]); hf[2 * q + 1] = bfhi(xw[q]) * rstd * (q < 2 ? g0[2 * q + 1] : g1[2 * q - 3]); }
                u32x4 hi, lo;
#pragma unroll
                for (int q = 0; q < 4; ++q) { hi[q] = pk2(hf[2 * q], hf[2 * q + 1]); lo[q] = pk2(hf[2 * q] - bflo(hi[q]), hf[2 * q + 1] - bfhi(hi[q])); }
                *(u32x4*)(hrow + 32 * ks) = hi;
                const bf16x8 ah = __builtin_bit_cast(bf16x8, hi), al = __builtin_bit_cast(bf16x8, lo);
                const int c = 4 * ks + g;
#pragma unroll
                for (int nt = 0; nt < 2; ++nt) { const int row = 16 * nt + l15; const int off = row * 2048 + ((c ^ (row & 7)) << 4);
                    const bf16x8 bh = *(const LAS bf16x8*)(lds + off), bl = *(const LAS bf16x8*)(lds + 65536 + off);
                    f32x4 a = nt ? acc1 : acc0;
                    a = __builtin_amdgcn_mfma_f32_16x16x32_bf16(ah, bh, a, 0, 0, 0); a = __builtin_amdgcn_mfma_f32_16x16x32_bf16(ah, bl, a, 0, 0, 0); a = __builtin_amdgcn_mfma_f32_16x16x32_bf16(al, bh, a, 0, 0, 0);
                    if (nt) acc1 = a; else acc0 = a; }
            }
            { const float b0 = args.in[I_BR][l15], b1 = args.in[I_BR][16 + l15];
#pragma unroll
              for (int j = 0; j < 4; ++j) { LG[(4 * g + j) * 33 + l15] = acc0[j] + b0; LG[(4 * g + j) * 33 + 16 + l15] = acc1[j] + b1; } }
            const int rrow = lane >> 2, qq = lane & 3;
            float tv[4] = {-3.0e38f, -3.0e38f, -3.0e38f, -3.0e38f}; int ti[4] = {64, 65, 66, 67};
#define TOP_INS(xv_, xi_) do { float x_ = (xv_); int i_ = (xi_); _Pragma("unroll") for (int p_ = 0; p_ < 4; ++p_) { const bool b_ = x_ > tv[p_] || (x_ == tv[p_] && i_ < ti[p_]); \
                const float ov_ = tv[p_]; const int oi_ = ti[p_]; tv[p_] = b_ ? x_ : ov_; ti[p_] = b_ ? i_ : oi_; x_ = b_ ? ov_ : x_; i_ = b_ ? oi_ : i_; } } while (0)
#pragma unroll
            for (int j = 0; j < 8; ++j) TOP_INS(LG[rrow * 33 + 8 * qq + j], 8 * qq + j);
#pragma unroll
            for (int st = 1; st < 4; st <<= 1) { float pv[4]; int pi[4];
#pragma unroll
                for (int p = 0; p < 4; ++p) { pv[p] = __shfl_xor(tv[p], st); pi[p] = __shfl_xor(ti[p], st); }
#pragma unroll
                for (int p = 0; p < 4; ++p) TOP_INS(pv[p], pi[p]); }
#undef TOP_INS
            const float e1 = __expf(tv[1] - tv[0]), e2 = __expf(tv[2] - tv[0]), e3 = __expf(tv[3] - tv[0]);
            const float inv = rcp_f(1.0f + e1 + e2 + e3);
            me = qq == 0 ? ti[0] : qq == 1 ? ti[1] : qq == 2 ? ti[2] : ti[3];
            mg = (qq == 0 ? 1.0f : qq == 1 ? e1 : qq == 2 ? e2 : e3) * inv;
            lpos = (int)__hip_atomic_fetch_add(cntl + me, 1u, __ATOMIC_RELAXED, __HIP_MEMORY_SCOPE_WORKGROUP);
            ai = (m0 + rrow) * 4 + qq;
        }
        __syncthreads();
        if (tid < NE) { const unsigned c = cntl[tid]; cntl[32 + tid] = c ? atomicAdd(ecnt + 64 * tid, c) : 0u; }
        __syncthreads();
        if (active) { route_e[ai] = me; route_pos[ai] = (int)cntl[32 + me] + lpos; route_g[ai] = mg; }
        __syncthreads();
        }
    }
    SEAM(9);
    if (IN(10)) { PHASE_IDS;
        LAS int* pst = (LAS int*)lds;
        if (tid == 0) { int acc = 0; for (int e = 0; e < NE; ++e) { const int c = (int)__hip_atomic_load(ecnt + 64 * e, __ATOMIC_RELAXED, __HIP_MEMORY_SCOPE_AGENT); pst[e] = acc; pst[64 + e] = c; acc += (c + 255) & ~255; } pst[32] = acc; }
        __syncthreads();
        for (int ai = bid * NTHREADS + tid; ai < NASSIGN; ai += G * NTHREADS) {
            const int e = route_e[ai]; const int row = pst[e] + route_pos[ai]; row_slot[row] = ai; row_gate[row] = route_g[ai]; row_tok[row] = ai >> 2; }
        if (bid < NE) { const int e = bid, c = pst[64 + e], pe = (c + 255) & ~255; for (int p = c + tid; p < pe; p += NTHREADS) { row_slot[pst[e] + p] = -1; row_gate[pst[e] + p] = 0.f; row_tok[pst[e] + p] = 0; } }
        if (bid == 0 && tid == 0) { int nt = 0; for (int e = 0; e < NE; ++e) { const int n = ((pst[64 + e] + 255) & ~255) >> 8; for (int j = 0; j < n; ++j) tile_tab[16 + nt++] = e; } tile_tab[0] = nt; }
        __syncthreads();
    }
    SEAM(10);
    if (IN(11)) { PHASE_IDS;
        const int ntiles = tile_tab[0];
        pg8::MoeGatherSched S; S.o.init_tiles(ntiles, 2048 / 256, G, bid); S.A = (const char*)HN; S.B = (const char*)Wgu_t; S.tile_e = tile_tab + 16; S.rtok = row_tok; S.tstep = (size_t)256 * D * 2; S.estep = (size_t)2048 * D * 2;
        EpiSwiglu E{ACT, args.in[I_BGU]}; pg8::gemm_phase(lds, D, S, E);
        { LAS float* scr = (LAS float*)(lds + wave * 16384); constexpr int I_DN = 16 * 32;
          for (;;) { int c0 = 0; if (lane == 0) c0 = (int)atomicAdd(ctl + CW_CONV, 8u); c0 = __builtin_amdgcn_readfirstlane(c0);
              if (c0 >= NE * I_DN) break;
              for (int r = c0; r < c0 + 8; ++r) { const int e = r / I_DN, q = r % I_DN, kb = q / 32, nb = q % 32;
                  transpose_item_tiled(args.in[I_WDN] + (size_t)e * DFF * D, D, DFF, Wdn_t + (size_t)e * D * DFF, 64 * kb, 32 * nb, 32 * nb, scr, lane); } } }
    }
    SEAM(11);
    if (IN(12)) { PHASE_IDS;
        const int ntiles = tile_tab[0];
        pg8::MoeSched S; S.o.init_tiles(ntiles, D / 256, G, bid); S.A = (const char*)ACT; S.B = (const char*)Wdn_t; S.tile_e = tile_tab + 16; S.tstep = (size_t)256 * DFF * 2; S.estep = (size_t)D * DFF * 2;
        EpiDown E{YS, args.in[I_BDN], row_slot, row_gate}; pg8::gemm_phase(lds, DFF, S, E);
    }
    SEAM(12);
    if (IN(13)) { PHASE_IDS;
        const float* gfin = args.in[I_FNG];
        for (int m = gw; m < M; m += NGW) {
            float v[16]; float s = 0.f;
#pragma unroll
            for (int hf = 0; hf < 2; ++hf) { const u32x4 w = *(const u32x4*)(X2 + (size_t)m * D + 512 * hf + 8 * lane);
#pragma unroll
                for (int q = 0; q < 4; ++q) { v[8 * hf + 2 * q] = bflo(w[q]); v[8 * hf + 2 * q + 1] = bfhi(w[q]); }
#pragma unroll
                for (int k = 0; k < 4; ++k) { const u32x4 y = *(const u32x4*)(YS + (size_t)(m * 4 + k) * D + 512 * hf + 8 * lane);
#pragma unroll
                    for (int q = 0; q < 4; ++q) { v[8 * hf + 2 * q] += bflo(y[q]); v[8 * hf + 2 * q + 1] += bfhi(y[q]); } } }
#pragma unroll
            for (int j = 0; j < 16; ++j) s += v[j] * v[j];
            const float rstd = rsq_f(wave_sum(s) * (1.f / D) + EPS);
#pragma unroll
            for (int hf = 0; hf < 2; ++hf) { const f32x4 g0 = *(const f32x4*)(gfin + 512 * hf + 8 * lane), g1 = *(const f32x4*)(gfin + 512 * hf + 8 * lane + 4);
                float* o = args.out + (size_t)m * D + 512 * hf + 8 * lane;
                *(f32x4*)o = (f32x4){v[8 * hf] * rstd * g0.x, v[8 * hf + 1] * rstd * g0.y, v[8 * hf + 2] * rstd * g0.z, v[8 * hf + 3] * rstd * g0.w};
                *(f32x4*)(o + 4) = (f32x4){v[8 * hf + 4] * rstd * g1.x, v[8 * hf + 5] * rstd * g1.y, v[8 * hf + 6] * rstd * g1.z, v[8 * hf + 7] * rstd * g1.w}; }
        }
    }
#undef IN
#undef SEAM
}

constexpr int N_PHASES = 14;
extern "C" void kernel_launch(void* const* d_in, const int* in_sizes, int n_in, void* d_out, int out_size, void* d_ws, size_t ws_size, hipStream_t stream) {
    static int grid = 0;
    if (grid == 0) {
        if (n_in != 37 || out_size != M * D || ws_size < WS_END) { fprintf(stderr, "kernel_launch: unexpected shapes (n_in %d, out %d, ws %zu); nothing launched\n", n_in, out_size, ws_size); grid = -1; return; }
        int dev = 0, cus = 0, per_cu = 0;
        if (hipGetDevice(&dev) != hipSuccess || hipDeviceGetAttribute(&cus, hipDeviceAttributeMultiprocessorCount, dev) != hipSuccess) { grid = -1; return; }
        if (hipFuncSetAttribute((const void*)fwd, hipFuncAttributeMaxDynamicSharedMemorySize, LDS_BYTES) != hipSuccess) { fprintf(stderr, "kernel_launch: hipFuncSetAttribute failed\n"); grid = -1; return; }
        if (hipOccupancyMaxActiveBlocksPerMultiprocessor(&per_cu, (const void*)fwd, NTHREADS, LDS_BYTES) != hipSuccess || per_cu < 1) fprintf(stderr, "kernel_launch: occupancy query says %d\n", per_cu);
        (void)hipGetLastError();
        grid = cus > 256 ? 256 : cus;
    }
    if (grid < 0) return;
    if (hipMemsetAsync((char*)d_ws + WS_CTL, 0, CTL_ZERO_BYTES, stream) != hipSuccess) return;
    Args a{};
    for (int i = 0; i < 37; ++i) a.in[i] = (const float*)d_in[i];
    a.out = (float*)d_out; a.ws = (unsigned char*)d_ws;
#if MK_ONE_LAUNCH
    a.ph_lo = 0; a.ph_hi = N_PHASES;
    hipLaunchKernelGGL(fwd, dim3(grid), dim3(NTHREADS), LDS_BYTES, stream, a);
#else
    for (int p = 0; p < N_PHASES; ++p) { a.ph_lo = p; a.ph_hi = p + 1; hipLaunchKernelGGL(fwd, dim3(grid), dim3(NTHREADS), LDS_BYTES, stream, a);
#ifdef PROBE_REPEAT_PHASE
        if (p == PROBE_REPEAT_PHASE) hipLaunchKernelGGL(fwd, dim3(grid), dim3(NTHREADS), LDS_BYTES, stream, a);
#endif
    }
#endif
}
```

```cpp
#include <hip/hip_runtime.h>
#include <cstdio>
#include <cstdint>

#ifndef MK_ONE_LAUNCH
#define MK_ONE_LAUNCH 1
#endif

#define DI __device__ __forceinline__
#define GAS __attribute__((address_space(1)))
#define LAS __attribute__((address_space(3)))
typedef unsigned short bf16;
typedef short bf16x8 __attribute__((ext_vector_type(8)));
typedef int v4i __attribute__((ext_vector_type(4)));
typedef int v8i __attribute__((ext_vector_type(8)));
typedef float f32x4 __attribute__((ext_vector_type(4)));
typedef float f32x2 __attribute__((ext_vector_type(2)));
typedef unsigned u32x4 __attribute__((ext_vector_type(4)));
typedef unsigned u32x2 __attribute__((ext_vector_type(2)));

constexpr int D = 1024, NB = 4, SEQ = 4096, M = NB * SEQ;
constexpr int MEML = 256, MROWS = NB * MEML;
constexpr int LRU_W = 512, RW = 512, NH = 8, HD = 64;
constexpr int INW = 2816;
constexpr int XH = 4, XHD = 256;
constexpr int NE = 32, TOPK = 4, DFF = 1024;
constexpr int NASSIGN = M * TOPK;
constexpr int MAXTILES = 288, MAXROWS = MAXTILES * 256;
constexpr float EPS = 1e-6f, GN_EPS = 64e-5f;

DI int fresh_tid_(int wv) { int w = wv; asm volatile("" : "+s"(w)); int l; asm volatile("v_mbcnt_lo_u32_b32 %0, -1, 0\n\tv_mbcnt_hi_u32_b32 %0, -1, %0" : "=v"(l)); return (w << 6) | (l & 63); }
#define fresh_tid() fresh_tid_(wv0)
namespace pg8 {
constexpr int BM = 256, BK = 64, HALF = 128, HTB = HALF * BK * 2, STAGE_BYTES = 8 * HTB, NXCD = 8, WGM = 8;
__host__ __device__ __forceinline__ int lds_byte(int r, int c) { const int st = (r >> 4) * 2 + (c >> 5), rr = r & 15, cc = c & 31, ob = rr * 64 + cc * 2; return st * 1024 + (ob ^ (((ob >> 9) & 1) << 5)); }
__host__ __device__ __forceinline__ void stage_rc(int b, int& R, int& C) { const int st = b / 1024, sb = b % 1024, swz = sb ^ (((sb >> 9) & 1) << 5); R = (st >> 1) * 16 + swz / 64; C = (st & 1) * 32 + (swz % 64) / 2; }
__host__ __device__ __forceinline__ int perm32(int rho) { const int n = rho >> 4, i = rho & 15; return 8 * (i >> 2) + 4 * n + (i & 3); }

struct Unit { int pm, pn, e; };

struct StaticOrder {
    int nM, nN, nwg, G, c;
    __host__ __device__ void init_tiles(int nM_, int nN_, int G_, int c_) { nM = nM_; nN = nN_; nwg = nM * nN; G = G_; c = c_; }
    __host__ __device__ bool next(int i, Unit& u) const {
        const long L = (long)i * G + c; if (L >= nwg) return false;
        int wgid = (int)L; { const int q = nwg / NXCD, r = nwg % NXCD, xcd = wgid % NXCD, off = wgid / NXCD; wgid = (xcd < r ? xcd * (q + 1) : r * (q + 1) + (xcd - r) * q) + off; }
        const int nig = WGM * nN, gid = wgid / nig, fm = gid * WGM, gsz = (nM - fm) < WGM ? (nM - fm) : WGM;
        u.pm = fm + ((wgid % nig) % gsz); u.pn = (wgid % nig) / gsz; u.e = 0; return true;
    }
};
struct DenseSched {
    static constexpr bool GATHER = false, B_TILED = false;
    StaticOrder o; const char* A; const char* B; size_t tstep;
    DI bool next(int i, Unit& u) const { return o.next(i, u); }
    DI const char* a_ptr(const Unit& u) const { return A + (size_t)u.pm * tstep; }
    DI const char* b_ptr(const Unit& u) const { return B + (size_t)u.pn * tstep; }
    DI void a_voff(const Unit&, int K, const int (&R)[2], const int (&C)[2], unsigned (&vo)[2][2]) const {
#pragma unroll
        for (int h = 0; h < 2; ++h)
#pragma unroll
            for (int i = 0; i < 2; ++i) vo[h][i] = (unsigned)((h * HALF + R[i]) * K + C[i]) * 2u; }
};
struct MoeSched {
    static constexpr bool GATHER = false, B_TILED = true;
    StaticOrder o; const char* A; const char* B; const int* tile_e; const int* utab; size_t tstep, estep;
    DI bool next(int i, Unit& u) const { const int L = i * o.G + o.c; if (L >= o.nwg) return false; const int en = __builtin_amdgcn_readfirstlane(utab[L]); u.pm = en & 0xfff; u.pn = (en >> 12) & 15; u.e = en >> 16; return true; }
    DI const char* a_ptr(const Unit& u) const { return A + (size_t)u.pm * tstep; }
    DI const char* b_ptr(const Unit& u) const { return B + (size_t)u.e * estep + (size_t)u.pn * tstep; }
    DI void a_voff(const Unit&, int K, const int (&R)[2], const int (&C)[2], unsigned (&vo)[2][2]) const {
#pragma unroll
        for (int h = 0; h < 2; ++h)
#pragma unroll
            for (int i = 0; i < 2; ++i) vo[h][i] = (unsigned)((h * HALF + R[i]) * K + C[i]) * 2u; }
};
struct MoeGatherSched {
    static constexpr bool GATHER = true, B_TILED = true;
    StaticOrder o; const char* A; const char* B; const int* tile_e; const int* utab; const int* rtok; size_t tstep, estep;
    DI bool next(int i, Unit& u) const { const int L = i * o.G + o.c; if (L >= o.nwg) return false; const int en = __builtin_amdgcn_readfirstlane(utab[L]); u.pm = en & 0xfff; u.pn = (en >> 12) & 15; u.e = en >> 16; return true; }
    DI const char* a_ptr(const Unit&) const { return A; }
    DI const char* b_ptr(const Unit& u) const { return B + (size_t)u.e * estep + (size_t)u.pn * tstep; }
    DI void a_voff(const Unit& u, int K, const int (&R)[2], const int (&C)[2], unsigned (&vo)[2][2]) const {
#pragma unroll
        for (int h = 0; h < 2; ++h)
#pragma unroll
            for (int i = 0; i < 2; ++i) vo[h][i] = (unsigned)(rtok[u.pm * BM + h * HALF + R[i]] * K + C[i]) * 2u; }
};

struct BatchBSched {
    static constexpr bool GATHER = false, B_TILED = false;
    StaticOrder o; const char* A; const char* B; size_t tstep, bstep;
    DI bool next(int i, Unit& u) const { return o.next(i, u); }
    DI const char* a_ptr(const Unit& u) const { return A + (size_t)u.pm * tstep; }
    DI const char* b_ptr(const Unit& u) const { return B + (size_t)(u.pm >> 4) * bstep + (size_t)u.pn * tstep; }
    DI void a_voff(const Unit&, int K, const int (&R)[2], const int (&C)[2], unsigned (&vo)[2][2]) const {
#pragma unroll
        for (int h = 0; h < 2; ++h)
#pragma unroll
            for (int i = 0; i < 2; ++i) vo[h][i] = (unsigned)((h * HALF + R[i]) * K + C[i]) * 2u; }
};
template <int MODE> struct FoldSched {
    static constexpr bool GATHER = false, B_TILED = false;
    const char* A; const char* B; int G, c;
    DI bool next(int i, Unit& u) const { const int L = i * G + c; if (L >= 64) return false; u.pm = L >> 2; u.pn = L & 3; u.e = 0; return true; }
    DI const char* a_ptr(const Unit& u) const { const int b = u.pm >> 2, h = u.pm & 3; return A + ((size_t)(MODE == 0 ? b * 256 : u.pn * 256) * 1024 + h * 256) * 2; }
    DI const char* b_ptr(const Unit& u) const { const int b = u.pm >> 2, h = u.pm & 3; return B + ((size_t)(MODE == 0 ? u.pn * 256 : b * 256) * 1024 + h * 256) * 2; }
    DI void a_voff(const Unit&, int K, const int (&R)[2], const int (&C)[2], unsigned (&vo)[2][2]) const {
#pragma unroll
        for (int h = 0; h < 2; ++h)
#pragma unroll
            for (int i = 0; i < 2; ++i) vo[h][i] = (unsigned)((h * HALF + R[i]) * K + C[i]) * 2u; }
};

DI unsigned cvt_pk_bf16(float lo, float hi) { unsigned r; asm volatile("v_cvt_pk_bf16_f32 %0, %1, %2" : "=v"(r) : "v"(lo), "v"(hi)); return r; }

template <class Epi, class Sched, bool ALIGN_EPI = true, bool FP8 = false>
DI void gemm_phase(LAS unsigned char* lds, const int K, const Sched& S, const Epi& E, const int wv0, const int ldp = 0) {
    const int ld = ldp ? ldp : K;
    const int tid = fresh_tid(), wid = __builtin_amdgcn_readfirstlane(tid >> 6), lane = tid & 63, wr = wid >> 2, wc = wid & 3, fr = lane & 15, fq = lane >> 4;
    const int nt = K / BK;
    constexpr bool GA = Sched::GATHER, BT = Sched::B_TILED;
    unsigned voffA[2][2], voffAn[2][2], voffB[2];
#pragma unroll
    for (int i = 0; i < 2; ++i) { int R, C; stage_rc(tid * 16 + i * 8192, R, C); const int Rb = Epi::PERM ? ((R & ~31) + perm32(R & 31)) : R;
        voffB[i] = BT ? (unsigned)(tid * 16 + i * 8192) : (unsigned)(Rb * ld + C) * 2u; }
#define PG8_AVOFF(unit, dst) do { int sR[2], sC[2]; const int t2_ = fresh_tid(); stage_rc(t2_ * 16, sR[0], sC[0]); stage_rc(t2_ * 16 + 8192, sR[1], sC[1]); S.a_voff(unit, ld, sR, sC, dst); } while (0)
    const size_t kstep = (size_t)(BK * 2);
    const size_t hstep = (size_t)HALF * ld * 2;
    const size_t kstepB = BT ? (size_t)(2 * HTB) : kstep, hstepB = BT ? (size_t)HTB : hstep;
    const unsigned ldsw = (unsigned)wid * 1024u;
    unsigned aoffv = (unsigned)(size_t)lds + (unsigned)lds_byte(wr * 64 + fr, fq * 8), boffv = (unsigned)(size_t)lds + (unsigned)(4 * HTB) + (unsigned)lds_byte(wc * 32 + fr, fq * 8);
    asm volatile("" : "+v"(aoffv), "+v"(boffv));
    const size_t dB = BT ? (size_t)8192 : (size_t)64 * ld * 2, dA = (size_t)64 * ld * 2;
#define PG8_SA(b, h) (((b) * 2 + (h)) * HTB)
#define PG8_SB(b, h) ((4 + (b) * 2 + (h)) * HTB)
    const unsigned ldsbase = (unsigned)__builtin_amdgcn_readfirstlane((int)((unsigned)(size_t)lds + ldsw));
#define PG8_STAGE1(bufoff, gptr, vo, i_) do { const unsigned m0v_ = ldsbase + (unsigned)(bufoff) + (unsigned)(i_) * 8192u; \
        asm volatile("s_mov_b32 m0, %2\n\ts_nop 0\n\tglobal_load_lds_dwordx4 %0, %1" :: "v"(vo), "s"((const char*)(gptr)), "s"(m0v_) : "memory", "m0"); } while (0)
#define PG8_STAGE(bufoff, gbase, voff) do { PG8_STAGE1(bufoff, gbase, (voff)[0], 0); PG8_STAGE1(bufoff, gbase, (voff)[1], 1); } while (0)
#define PG8_STAGE_D(bufoff, gbase, vo, delta) do { PG8_STAGE1(bufoff, gbase, vo, 0); PG8_STAGE1(bufoff, (const char*)(gbase) + (delta), vo, 1); } while (0)
#define PG8_LDA(dst, b, h) do { if constexpr (FP8) { _Pragma("unroll") for (int m = 0; m < 4; ++m) { const LAS v4i* p_ = (const LAS v4i*)((LAS unsigned char*)(size_t)aoffv + PG8_SA(b, h) + m * 2048); dst##8[m] = __builtin_shufflevector(p_[0], p_[64], 0, 1, 2, 3, 4, 5, 6, 7); } } \
        else { _Pragma("unroll") for (int m = 0; m < 4; ++m) _Pragma("unroll") for (int k = 0; k < 2; ++k) dst[m][k] = *(const LAS bf16x8*)((LAS unsigned char*)(size_t)aoffv + PG8_SA(b, h) + m * 2048 + k * 1024); } } while (0)
#define PG8_LDB(dst, b, h) do { if constexpr (FP8) { _Pragma("unroll") for (int n = 0; n < 2; ++n) { const LAS v4i* p_ = (const LAS v4i*)((LAS unsigned char*)(size_t)boffv + (PG8_SB(b, h) - 4 * HTB) + n * 2048); dst##8[n] = __builtin_shufflevector(p_[0], p_[64], 0, 1, 2, 3, 4, 5, 6, 7); } } \
        else { _Pragma("unroll") for (int n = 0; n < 2; ++n) _Pragma("unroll") for (int k = 0; k < 2; ++k) dst[n][k] = *(const LAS bf16x8*)((LAS unsigned char*)(size_t)boffv + (PG8_SB(b, h) - 4 * HTB) + n * 2048 + k * 1024); } } while (0)
#define PG8_MMA(ai, bj, At, Bt) do { __builtin_amdgcn_s_setprio(1); \
        if constexpr (FP8) {   \
            _Pragma("unroll") for (int m = 0; m < 4; ++m) _Pragma("unroll") for (int n = 0; n < 2; ++n) \
                acc[ai][bj][m][n] = __builtin_amdgcn_mfma_scale_f32_16x16x128_f8f6f4(Bt##8[n], At##8[m], acc[ai][bj][m][n], 0, 0, 0, 0, 0, 0); } \
        else { _Pragma("unroll") for (int m = 0; m < 4; ++m) _Pragma("unroll") for (int n = 0; n < 2; ++n) _Pragma("unroll") for (int k = 0; k < 2; ++k) \
            acc[ai][bj][m][n] = __builtin_amdgcn_mfma_f32_16x16x32_bf16(Bt[n][k], At[m][k], acc[ai][bj][m][n], 0, 0, 0); } \
        __builtin_amdgcn_s_setprio(0); } while (0)
#define PG8_WAIT_V(n) asm volatile("s_waitcnt vmcnt(" #n ")" ::: "memory")
#define PG8_WAIT_L(n) asm volatile("s_waitcnt lgkmcnt(" #n ")" ::: "memory")
#define PG8_BAR __builtin_amdgcn_s_barrier()
#define PG8_SCHED __builtin_amdgcn_sched_barrier(0)
    Unit cur, nxt; int ui = 0;
    if (!S.next(0, cur)) return;
    f32x4 acc[2][2][4][2];
#pragma unroll
    for (int a = 0; a < 2; ++a)
#pragma unroll
        for (int b = 0; b < 2; ++b)
#pragma unroll
            for (int m = 0; m < 4; ++m)
#pragma unroll
                for (int n = 0; n < 2; ++n) acc[a][b][m][n] = (f32x4){0.f, 0.f, 0.f, 0.f};
    bf16x8 At[4][2], B0[2][2], B1[2][2]; v8i At8[4], B08[2], B18[2];
    const char* cA = S.a_ptr(cur); const char* cB = S.b_ptr(cur);
    PG8_AVOFF(cur, voffA);
#define PG8_STAGE_A(bufoff, kbase, h, vo) do { if constexpr (GA) { PG8_STAGE(bufoff, kbase, (vo)[h]); } else { PG8_STAGE_D(bufoff, (kbase) + (h) * hstep, voffA[0][0], dA); } } while (0)
    PG8_STAGE_D(PG8_SB(0, 0), cB, voffB[0], dB); PG8_STAGE_D(PG8_SB(0, 1), cB + hstepB, voffB[0], dB); PG8_STAGE_A(PG8_SA(0, 0), cA, 0, voffA); PG8_STAGE_A(PG8_SA(0, 1), cA, 1, voffA);
    if (wr == 1) PG8_BAR;
    PG8_WAIT_V(2); PG8_BAR;
    PG8_STAGE_D(PG8_SB(1, 0), cB + kstepB, voffB[0], dB); PG8_STAGE_A(PG8_SA(1, 0), cA + kstep, 0, voffA); PG8_STAGE_D(PG8_SB(1, 1), cB + hstepB + kstepB, voffB[0], dB);
    PG8_WAIT_V(6); PG8_BAR;
    for (;;) {
        const bool has_next = S.next(ui + 1, nxt);
        const char* nA = has_next ? S.a_ptr(nxt) : cA; const char* nB = has_next ? S.b_ptr(nxt) : cB;
        if constexpr (GA) { if (has_next) PG8_AVOFF(nxt, voffAn);
            else {
#pragma unroll
                for (int h = 0; h < 2; ++h)
#pragma unroll
                    for (int i = 0; i < 2; ++i) voffAn[h][i] = voffA[h][i]; } }
#pragma unroll 1
        for (int t = 0; t < nt; t += 2) {
            const bool last = (t == nt - 2);
            const char* a1 = cA + (size_t)(t + 1) * kstep;
            const char* a2 = last ? nA : cA + (size_t)(t + 2) * kstep; const char* b2 = last ? nB : cB + (size_t)(t + 2) * kstepB;
            const char* a3 = a2 + kstep; const char* b3 = b2 + kstepB;
            PG8_LDB(B0, 0, 0); PG8_LDB(B1, 0, 1); PG8_SCHED; PG8_LDA(At, 0, 0); PG8_STAGE_A(PG8_SA(1, 1), a1, 1, voffA);
            if constexpr (GA) { if (last) {
#pragma unroll
                for (int h = 0; h < 2; ++h)
#pragma unroll
                    for (int i = 0; i < 2; ++i) voffA[h][i] = voffAn[h][i]; } }
            PG8_WAIT_V(8); PG8_WAIT_L(0); PG8_BAR; PG8_MMA(0, 0, At, B0); PG8_MMA(0, 1, At, B1); PG8_BAR; PG8_SCHED;
            PG8_LDA(At, 0, 1); PG8_STAGE_D(PG8_SB(0, 0), b2, voffB[0], dB); PG8_STAGE_D(PG8_SB(0, 1), b2 + hstepB, voffB[0], dB); PG8_STAGE_A(PG8_SA(0, 0), a2, 0, voffA);
            PG8_WAIT_V(8); PG8_WAIT_L(0); PG8_BAR; PG8_MMA(1, 0, At, B0); PG8_MMA(1, 1, At, B1); PG8_BAR; PG8_SCHED;
            PG8_LDB(B0, 1, 0); PG8_LDB(B1, 1, 1); PG8_SCHED; PG8_LDA(At, 1, 0); PG8_STAGE_A(PG8_SA(0, 1), a2, 1, voffA);
            PG8_WAIT_V(8); PG8_WAIT_L(0); PG8_BAR; PG8_MMA(0, 0, At, B0); PG8_MMA(0, 1, At, B1); PG8_BAR; PG8_SCHED;
            PG8_LDA(At, 1, 1); PG8_STAGE_D(PG8_SB(1, 0), b3, voffB[0], dB); PG8_STAGE_D(PG8_SB(1, 1), b3 + hstepB, voffB[0], dB); PG8_STAGE_A(PG8_SA(1, 0), a3, 0, voffA);
            PG8_WAIT_V(8); PG8_WAIT_L(0); PG8_BAR; PG8_MMA(1, 0, At, B0); PG8_MMA(1, 1, At, B1); PG8_BAR; PG8_SCHED;
        }
        if constexpr (ALIGN_EPI) { if (wr == 0) PG8_BAR; }
        { Unit ue = cur; ue.pm = __builtin_amdgcn_readfirstlane(ue.pm); ue.pn = __builtin_amdgcn_readfirstlane(ue.pn); ue.e = __builtin_amdgcn_readfirstlane(ue.e); asm volatile("" : "+s"(ue.pm), "+s"(ue.pn), "+s"(ue.e));
          const int t3_ = fresh_tid(); const int fr_ = t3_ & 15, fq_ = (t3_ & 63) >> 4;
          E(acc, ue, wr, wc, fr_, fq_); }
        if (!has_next) break;
#pragma unroll
        for (int a = 0; a < 2; ++a)
#pragma unroll
            for (int b = 0; b < 2; ++b)
#pragma unroll
                for (int m = 0; m < 4; ++m)
#pragma unroll
                    for (int n = 0; n < 2; ++n) acc[a][b][m][n] = (f32x4){0.f, 0.f, 0.f, 0.f};
        cur = nxt; cA = nA; cB = nB; ++ui;
        if constexpr (ALIGN_EPI) { if (wr == 1) PG8_BAR; }
    }
    PG8_WAIT_V(0);
    if constexpr (!ALIGN_EPI) { if (wr == 0) PG8_BAR; }
    PG8_BAR;
#undef PG8_SA
#undef PG8_SB
#undef PG8_STAGE
#undef PG8_STAGE1
#undef PG8_STAGE_D
#undef PG8_STAGE_A
#undef PG8_AVOFF
#undef PG8_LDA
#undef PG8_LDB
#undef PG8_MMA
#undef PG8_WAIT_V
#undef PG8_WAIT_L
#undef PG8_BAR
#undef PG8_SCHED
}
}
using pg8::Unit;
using pg8::cvt_pk_bf16;

DI float bflo(unsigned w) { return __uint_as_float(w << 16); }
DI float bfhi(unsigned w) { return __uint_as_float(w & 0xffff0000u); }
DI float bf2f(bf16 b) { return __uint_as_float(((unsigned)b) << 16); }
typedef __bf16 hwbf2 __attribute__((ext_vector_type(2)));
DI unsigned pk2(float lo, float hi) { const f32x2 v = {lo, hi}; return __builtin_bit_cast(unsigned, __builtin_convertvector(v, hwbf2)); }
DI unsigned f2bf(float f) { return pk2(f, 0.f) & 0xffffu; }
DI float rcp_f(float x) { return __builtin_amdgcn_rcpf(x); }
DI float rsq_f(float x) { return __builtin_amdgcn_rsqf(x); }
DI float sigmoid_f(float x) { return rcp_f(1.0f + __expf(-x)); }
DI float tanh_fast(float x) { return 1.0f - 2.0f * rcp_f(__expf(2.0f * x) + 1.0f); }
DI float softplus_f(float x) { return fmaxf(x, 0.f) + __logf(1.0f + __expf(-fabsf(x))); }
DI float softplus_fast(float x) { return fmaxf(x, 0.f) + __logf(1.0f + __expf(-fabsf(x))); }
DI float gelu_tanh_f(float x) { const float u = 0.7978845608028654f * (x + 0.044715f * x * x * x); return 0.5f * x * (1.0f + tanh_fast(u)); }
DI float wave_sum(float v) {
#pragma unroll
    for (int o = 1; o < 64; o <<= 1) v += __shfl_xor(v, o);
    return v;
}

DI unsigned pk4_fp8(float a, float b, float c, float d) { int w = 0; w = __builtin_amdgcn_cvt_pk_fp8_f32(a, b, w, false); w = __builtin_amdgcn_cvt_pk_fp8_f32(c, d, w, true); return (unsigned)w; }
struct EpiBf16Plain {
    static constexpr bool PERM = true;
    bf16* O; int ldc; float scale;
    DI void operator()(const f32x4 (&acc)[2][2][4][2], const Unit& u, int wr, int wc, int fr, int fq) const {
        const int row0 = u.pm * 256 + wr * 64 + fr, col0 = u.pn * 256 + wc * 32 + 8 * fq;
#pragma unroll
        for (int ai = 0; ai < 2; ++ai)
#pragma unroll
            for (int m = 0; m < 4; ++m) { bf16* rowp = O + (size_t)(row0 + ai * 128 + m * 16) * ldc + col0;
#pragma unroll
                for (int bj = 0; bj < 2; ++bj) { const f32x4 v0 = acc[ai][bj][m][0] * scale, v1 = acc[ai][bj][m][1] * scale;
                    u32x4 w; w.x = cvt_pk_bf16(v0[0], v0[1]); w.y = cvt_pk_bf16(v0[2], v0[3]); w.z = cvt_pk_bf16(v1[0], v1[1]); w.w = cvt_pk_bf16(v1[2], v1[3]);
                    *(u32x4*)(rowp + bj * 128) = w; } }
    }
};
template <int MODE> struct EpiFold {
    static constexpr bool PERM = true;
    bf16* O;
    DI void operator()(const f32x4 (&acc)[2][2][4][2], const Unit& u, int wr, int wc, int fr, int fq) const {
        const int b = u.pm >> 2, h = u.pm & 3;
        const int rbase = MODE == 0 ? h * 256 : u.pn * 256, cbase = MODE == 0 ? u.pn * 256 : h * 256;
        const unsigned boff = (unsigned)b * 1024u * 1024u + (unsigned)(rbase + wr * 64 + fr) * 1024u + (unsigned)(cbase + wc * 32 + 8 * fq);
#pragma unroll
        for (int ai = 0; ai < 2; ++ai)
#pragma unroll
            for (int m = 0; m < 4; ++m) { bf16* rowp = O + (boff + (unsigned)(ai * 128 + m * 16) * 1024u);
#pragma unroll
                for (int bj = 0; bj < 2; ++bj) { const f32x4 v0 = acc[ai][bj][m][0], v1 = acc[ai][bj][m][1];
                    u32x4 w; w.x = cvt_pk_bf16(v0[0], v0[1]); w.y = cvt_pk_bf16(v0[2], v0[3]); w.z = cvt_pk_bf16(v1[0], v1[1]); w.w = cvt_pk_bf16(v1[2], v1[3]);
                    *(u32x4*)(rowp + bj * 128) = w; } }
    }
};
struct EpiSoftmax {
    static constexpr bool PERM = true;
    bf16* O; float scale; const float* RS; LAS float* XM; LAS float* XS;
    DI void operator()(const f32x4 (&acc)[2][2][4][2], const Unit& u, int wr, int wc, int fr, int fq) const {
        const int row0 = u.pm * 256 + wr * 64 + fr, col0 = u.pn * 256 + wc * 32 + 8 * fq;
        float sc[2][4];
#pragma unroll
        for (int ai = 0; ai < 2; ++ai)
#pragma unroll
            for (int m = 0; m < 4; ++m) { const int r = row0 + ai * 128 + m * 16; const f32x4* rp = (const f32x4*)(RS + (size_t)r * 16);
                const f32x4 p0 = rp[0], p1 = rp[1], p2 = rp[2], p3 = rp[3];
                const float ss = ((p0[0] + p0[1]) + (p0[2] + p0[3])) + ((p1[0] + p1[1]) + (p1[2] + p1[3])) + ((p2[0] + p2[1]) + (p2[2] + p2[3])) + ((p3[0] + p3[1]) + (p3[2] + p3[3]));
                sc[ai][m] = scale * __builtin_amdgcn_rsqf(ss * (1.0f / 1024.0f) + 1e-6f);
                float mm = -3.0e38f;
#pragma unroll
                for (int bj = 0; bj < 2; ++bj)
#pragma unroll
                    for (int n = 0; n < 2; ++n) { const f32x4 v = acc[ai][bj][m][n]; mm = fmaxf(mm, fmaxf(fmaxf(v[0], v[1]), fmaxf(v[2], v[3]))); }
                mm *= sc[ai][m];
                mm = fmaxf(mm, __shfl_xor(mm, 16)); mm = fmaxf(mm, __shfl_xor(mm, 32));
                if (fq == 0) XM[(ai * 128 + wr * 64 + m * 16 + fr) * 4 + wc] = mm; }
        asm volatile("s_waitcnt lgkmcnt(0)" ::: "memory"); __builtin_amdgcn_s_barrier(); asm volatile("" ::: "memory");
        f32x4 (&pa)[2][2][4][2] = const_cast<f32x4 (&)[2][2][4][2]>(acc);
#pragma unroll
        for (int ai = 0; ai < 2; ++ai)
#pragma unroll
            for (int m = 0; m < 4; ++m) { const int lr = ai * 128 + wr * 64 + m * 16 + fr; const f32x4 q = *(const LAS f32x4*)(XM + lr * 4);
                const float mxr = fmaxf(fmaxf(q[0], q[1]), fmaxf(q[2], q[3])); float sm = 0.f;
#pragma unroll
                for (int bj = 0; bj < 2; ++bj)
#pragma unroll
                    for (int n = 0; n < 2; ++n)
#pragma unroll
                        for (int j = 0; j < 4; ++j) { const float p = __expf(acc[ai][bj][m][n][j] * sc[ai][m] - mxr); pa[ai][bj][m][n][j] = p; sm += p; }
                sm += __shfl_xor(sm, 16); sm += __shfl_xor(sm, 32);
                if (fq == 0) XS[lr * 4 + wc] = sm; }
        asm volatile("s_waitcnt lgkmcnt(0)" ::: "memory"); __builtin_amdgcn_s_barrier(); asm volatile("" ::: "memory");
#pragma unroll
        for (int ai = 0; ai < 2; ++ai)
#pragma unroll
            for (int m = 0; m < 4; ++m) { const int lr = ai * 128 + wr * 64 + m * 16 + fr; const f32x4 q = *(const LAS f32x4*)(XS + lr * 4);
                const float inv = __builtin_amdgcn_rcpf((q[0] + q[1]) + (q[2] + q[3]));
                bf16* rowp = O + (size_t)(row0 + ai * 128 + m * 16) * 1024 + col0;
#pragma unroll
                for (int bj = 0; bj < 2; ++bj) { const f32x4 v0 = pa[ai][bj][m][0] * inv, v1 = pa[ai][bj][m][1] * inv;
                    u32x4 w; w.x = cvt_pk_bf16(v0[0], v0[1]); w.y = cvt_pk_bf16(v0[2], v0[3]); w.z = cvt_pk_bf16(v1[0], v1[1]); w.w = cvt_pk_bf16(v1[2], v1[3]);
                    *(u32x4*)(rowp + bj * 128) = w; } }
        asm volatile("s_waitcnt lgkmcnt(0)" ::: "memory"); __builtin_amdgcn_s_barrier(); asm volatile("" ::: "memory");
    }
};
struct EpiBf16RowNorm {
    static constexpr bool PERM = true;
    bf16* O; int ldc; float scale; const float* RS;
    DI void operator()(const f32x4 (&acc)[2][2][4][2], const Unit& u, int wr, int wc, int fr, int fq) const {
        const int row0 = u.pm * 256 + wr * 64 + fr, col0 = u.pn * 256 + wc * 32 + 8 * fq;
#pragma unroll
        for (int ai = 0; ai < 2; ++ai)
#pragma unroll
            for (int m = 0; m < 4; ++m) { const int r = row0 + ai * 128 + m * 16; const f32x4* rp = (const f32x4*)(RS + (size_t)r * 16);
                const f32x4 p0 = rp[0], p1 = rp[1], p2 = rp[2], p3 = rp[3];
                const float ss = ((p0[0] + p0[1]) + (p0[2] + p0[3])) + ((p1[0] + p1[1]) + (p1[2] + p1[3])) + ((p2[0] + p2[1]) + (p2[2] + p2[3])) + ((p3[0] + p3[1]) + (p3[2] + p3[3]));
                const float sc = scale * __builtin_amdgcn_rsqf(ss * (1.0f / 1024.0f) + 1e-6f);
                bf16* rowp = O + (size_t)r * ldc + col0;
#pragma unroll
                for (int bj = 0; bj < 2; ++bj) { const f32x4 v0 = acc[ai][bj][m][0] * sc, v1 = acc[ai][bj][m][1] * sc;
                    u32x4 w; w.x = cvt_pk_bf16(v0[0], v0[1]); w.y = cvt_pk_bf16(v0[2], v0[3]); w.z = cvt_pk_bf16(v1[0], v1[1]); w.w = cvt_pk_bf16(v1[2], v1[3]);
                    *(u32x4*)(rowp + bj * 128) = w; } }
    }
};
template <bool RES_BF16> struct EpiBf16Res {
    static constexpr bool PERM = true;
    const void* Rz; bf16* O; int ldc; float* RS;
    DI void operator()(const f32x4 (&acc)[2][2][4][2], const Unit& u, int wr, int wc, int fr, int fq) const {
        const int row0 = u.pm * 256 + wr * 64 + fr, col0 = u.pn * 256 + wc * 32 + 8 * fq;
#pragma unroll
        for (int ai = 0; ai < 2; ++ai)
#pragma unroll
            for (int m = 0; m < 4; ++m) { const size_t off = (size_t)(row0 + ai * 128 + m * 16) * ldc + col0; float ssq = 0.f;
#pragma unroll
                for (int bj = 0; bj < 2; ++bj) { f32x4 r0, r1;
                    if (RES_BF16) { const u32x4 rw = *(const u32x4*)((const bf16*)Rz + off + bj * 128); r0 = (f32x4){bflo(rw.x), bfhi(rw.x), bflo(rw.y), bfhi(rw.y)}; r1 = (f32x4){bflo(rw.z), bfhi(rw.z), bflo(rw.w), bfhi(rw.w)}; }
                    else { r0 = *(const f32x4*)((const float*)Rz + off + bj * 128); r1 = *(const f32x4*)((const float*)Rz + off + bj * 128 + 4); }
                    const f32x4 v0 = r0 + acc[ai][bj][m][0], v1 = r1 + acc[ai][bj][m][1];
                    ssq += (v0[0] * v0[0] + v0[1] * v0[1]) + (v0[2] * v0[2] + v0[3] * v0[3]) + (v1[0] * v1[0] + v1[1] * v1[1]) + (v1[2] * v1[2] + v1[3] * v1[3]);
                    u32x4 w; w.x = cvt_pk_bf16(v0[0], v0[1]); w.y = cvt_pk_bf16(v0[2], v0[3]); w.z = cvt_pk_bf16(v1[0], v1[1]); w.w = cvt_pk_bf16(v1[2], v1[3]);
                    *(u32x4*)(O + off + bj * 128) = w; }
                if (RS) { ssq += __shfl_xor(ssq, 16); ssq += __shfl_xor(ssq, 32); if (fq == 0) RS[(size_t)(row0 + ai * 128 + m * 16) * 16 + u.pn * 4 + wc] = ssq; } }
    }
};
struct EpiLora {
    static constexpr bool PERM = false;
    float* LWp; bf16* AAp; bf16* GGp; const float* w0; const float* a0;
    DI void operator()(const f32x4 (&acc)[2][2][4][2], const Unit& u, int wr, int wc, int fr, int fq) const {
        const int kind = u.pn >> 1;
        const int row0 = u.pm * 256 + wr * 64 + fr, col0 = (u.pn & 1) * 256 + wc * 32 + 4 * fq;
#pragma unroll
        for (int bj = 0; bj < 2; ++bj)
#pragma unroll
            for (int n = 0; n < 2; ++n) {
                const int c = col0 + bj * 128 + n * 16;
                f32x4 bias = (f32x4){0.f, 0.f, 0.f, 0.f};
                if (kind == 0) bias = *(const f32x4*)(w0 + c); else if (kind == 1) bias = *(const f32x4*)(a0 + c);
#pragma unroll
                for (int ai = 0; ai < 2; ++ai)
#pragma unroll
                    for (int m = 0; m < 4; ++m) {
                        f32x4 v = acc[ai][bj][m][n] + bias;
                        if (kind == 0) {
#pragma unroll
                            for (int j = 0; j < 4; ++j) { const float w = -softplus_fast(-v[j]) - 0.5f; v[j] = -__expf(w);     }
                        } else if (kind == 1) {
#pragma unroll
                            for (int j = 0; j < 4; ++j) v[j] = sigmoid_f(v[j]);
                        }
                        const size_t o_ = (size_t)(row0 + ai * 128 + m * 16) * 512 + c;
                        if (kind == 0) *(f32x4*)(LWp + o_) = v;
                        else { u32x2 w_; w_.x = cvt_pk_bf16(v[0], v[1]); w_.y = cvt_pk_bf16(v[2], v[3]); *(u32x2*)((kind == 1 ? AAp : GGp) + o_) = w_; }
                    }
            }
    }
};
struct EpiSwiglu {
    static constexpr bool PERM = true;
    bf16* ACT; const float* b_gu;
    DI void operator()(const f32x4 (&acc)[2][2][4][2], const Unit& u, int wr, int wc, int fr, int fq) const {
        const int row0 = u.pm * 256 + wr * 64 + fr, j0 = u.pn * 128 + wc * 32 + 8 * fq;
        const float* bg = b_gu + (size_t)u.e * 2048 + j0; const float* bu = bg + 1024;
        const f32x4 bg0 = *(const f32x4*)bg, bg1 = *(const f32x4*)(bg + 4), bu0 = *(const f32x4*)bu, bu1 = *(const f32x4*)(bu + 4);
#pragma unroll
        for (int ai = 0; ai < 2; ++ai)
#pragma unroll
            for (int m = 0; m < 4; ++m) {
                float o[8];
#pragma unroll
                for (int n = 0; n < 2; ++n) { const f32x4 g4 = acc[ai][0][m][n] * 0.015625f + (n ? bg1 : bg0), u4 = acc[ai][1][m][n] * 0.015625f + (n ? bu1 : bu0);
#pragma unroll
                    for (int j = 0; j < 4; ++j) { const float g = fminf(g4[j], 7.0f), up = fminf(fmaxf(u4[j], -7.0f), 7.0f); o[n * 4 + j] = (up + 1.0f) * (g * sigmoid_f(1.702f * g)); } }
                u32x2 w; w.x = pk4_fp8(o[0], o[1], o[2], o[3]); w.y = pk4_fp8(o[4], o[5], o[6], o[7]);
                *(u32x2*)((unsigned char*)ACT + (size_t)(row0 + ai * 128 + m * 16) * 1024 + j0) = w;
            }
    }
};
struct EpiDown {
    static constexpr bool PERM = true;
    bf16* YS; const float* b_dn; const int* row_slot; const float* row_gate;
    DI void operator()(const f32x4 (&acc)[2][2][4][2], const Unit& u, int wr, int wc, int fr, int fq) const {
        const int row0 = u.pm * 256 + wr * 64 + fr, col0 = u.pn * 256 + wc * 32 + 8 * fq;
        const float* bb = b_dn + (size_t)u.e * 1024 + col0;
        f32x4 bv[2][2];
#pragma unroll
        for (int bj = 0; bj < 2; ++bj)
#pragma unroll
            for (int n = 0; n < 2; ++n) bv[bj][n] = *(const f32x4*)(bb + bj * 128 + 4 * n);
#pragma unroll
        for (int ai = 0; ai < 2; ++ai)
#pragma unroll
            for (int m = 0; m < 4; ++m) {
                const int r = row0 + ai * 128 + m * 16; const int slot = row_slot[r]; const float gt = row_gate[r];
                if (slot >= 0) { bf16* rowp = YS + (size_t)slot * 1024 + col0;
#pragma unroll
                    for (int bj = 0; bj < 2; ++bj) { const f32x4 v0 = (acc[ai][bj][m][0] * 0.015625f + bv[bj][0]) * gt, v1 = (acc[ai][bj][m][1] * 0.015625f + bv[bj][1]) * gt;
                        u32x4 w; w.x = cvt_pk_bf16(v0[0], v0[1]); w.y = cvt_pk_bf16(v0[2], v0[3]); w.z = cvt_pk_bf16(v1[0], v1[1]); w.w = cvt_pk_bf16(v1[2], v1[3]);
                        *(u32x4*)(rowp + bj * 128) = w; } }
            }
    }
};

constexpr size_t MiB = 1u << 20;
constexpr size_t WS_CTL = 0, CTL_ZERO_BYTES = 1 * MiB;
constexpr size_t WS_WIN = 1 * MiB, WS_WOUT = 7 * MiB, WS_WQ = 9 * MiB, WS_WK = 11 * MiB, WS_WV = 13 * MiB, WS_WO = 15 * MiB, WS_LORAB = 17 * MiB, WS_LRUW = 18 * MiB;
constexpr size_t WS_ROUTE = 19 * MiB;
constexpr size_t WS_WGU = 22 * MiB, WS_WDN = 150 * MiB;
constexpr size_t WS_HN = 214 * MiB, WS_MEMN = 246 * MiB, WS_KM = 248 * MiB, WS_VT = 250 * MiB;
constexpr size_t WS_X1 = 252 * MiB, WS_X2 = 316 * MiB;
constexpr size_t WS_U = 380 * MiB, WS_R = 468 * MiB, WS_KRAW = 500 * MiB, WS_V = 532 * MiB, WS_KKN = 564 * MiB, WS_WD = 596 * MiB, WS_AA = 628 * MiB, WS_G = 660 * MiB;
constexpr size_t WS_LA = 692 * MiB, WS_LB = 724 * MiB, WS_AP = 756 * MiB, WS_CAT = 764 * MiB, WS_Q = 796 * MiB;
constexpr size_t WS_XS = 380 * MiB, WS_ACT = 524 * MiB, WS_YS = 668 * MiB;
constexpr size_t WS_GP = 796 * MiB, WS_HF = 860 * MiB, WS_RP = 924 * MiB, WS_Y1F = 940 * MiB, WS_ADD = 972 * MiB, WS_END = 1004 * MiB;
constexpr size_t WS_GC = 468 * MiB, WS_HC = 484 * MiB, WS_ZS = 500 * MiB;
static_assert(WS_AA == WS_WD + 32 * MiB && WS_G == WS_AA + 32 * MiB, "EpiLora strides");
static_assert(WS_U + (size_t)M * INW * 2 <= WS_R && WS_XS + (size_t)MAXROWS * 2048 <= WS_ACT && WS_ACT + (size_t)MAXROWS * 2048 <= WS_YS && WS_YS + (size_t)NASSIGN * 2048 <= WS_Q, "ws map");
constexpr size_t RT_E = 0, RT_POS = 256 * 1024, RT_G = 512 * 1024, RT_SLOT = 768 * 1024, RT_GATE = 1088 * 1024, RT_TILE = 1408 * 1024, RT_TOK = 1472 * 1024, RT_UGU = 1792 * 1024, RT_UDN = 1808 * 1024;
constexpr int CW_BAR = 4096, CW_CNT = 8192, CW_CONV = 12288;

constexpr int RING_BYTES = 131072, MISC_OFF = RING_BYTES + 320, LDS_BYTES = 147456;
constexpr int NWAVES = 8, NTHREADS = 512;
constexpr int CONV_P9 = 0;

#define XB_TMO      128
#define XB_XCNT(j)  (256  + 64 * (j))
#define XB_XSUB(j)  (1280 + 64 * (j))
#define XB_XGEN(j)  (2304 + 64 * (j))
#define XB_TOP      3328
#define XB_TOPGEN   3392
#define XCD_BAR_WORDS 3456
#define XB_SPIN_CAP (1u << 18)
DI unsigned xb_ld(unsigned* p)              { return __hip_atomic_load(p, __ATOMIC_RELAXED, __HIP_MEMORY_SCOPE_AGENT); }
DI unsigned xb_add(unsigned* p, unsigned v) { return __hip_atomic_fetch_add(p, v, __ATOMIC_RELAXED, __HIP_MEMORY_SCOPE_AGENT); }
DI unsigned xb_xcc_id() { return (unsigned)__builtin_amdgcn_s_getreg((3 << 11) | 20) & 0xFu; }
#define XB_SPIN(cond, bar) do { unsigned _sp = 0; while (cond) { __builtin_amdgcn_s_sleep(1); \
    if ((++_sp & 255u) == 0u) { if (xb_ld(&(bar)[XB_TMO])) break; if (_sp > XB_SPIN_CAP) { atomicAdd(&(bar)[XB_TMO], 1u); break; } } } } while (0)
struct XcdBarrier { unsigned* bar; unsigned x; volatile LAS unsigned* st; int w0; };
DI XcdBarrier xcd_barrier_post(unsigned* bar, volatile LAS unsigned* st, int w0) {
    XcdBarrier b; b.bar = bar; b.x = xb_xcc_id(); b.st = st; b.w0 = w0;
    if (fresh_tid_(w0) == 0) (void)xb_add(&bar[XB_XCNT(b.x)], 1u);
    return b;
}
DI void xcd_barrier_complete(unsigned* bar, unsigned x, unsigned& nloc, unsigned& nx) {
    const unsigned G = gridDim.x * gridDim.y * gridDim.z;
    unsigned sum, cnt, mine, sp = 0u;
    for (;;) {
        sum = 0u; cnt = 0u; mine = 0u;
#pragma unroll
        for (unsigned j = 0; j < 16; ++j) { const unsigned c = xb_ld(&bar[XB_XCNT(j)]); sum += c; cnt += (c > 0u) ? 1u : 0u; mine = (j == x) ? c : mine; }
        if (sum == G) break;
        __builtin_amdgcn_s_sleep(1);
        if ((++sp & 255u) == 0u) { if (xb_ld(&bar[XB_TMO])) break; if (sp > XB_SPIN_CAP) { atomicAdd(&bar[XB_TMO], 1u); break; } }
    }
    nloc = mine > 0u ? mine : 1u; nx = cnt > 0u ? cnt : 1u;
}
DI void xcd_barrier(const XcdBarrier& b) {
    asm volatile("s_waitcnt vmcnt(0)" ::: "memory");
    __syncthreads();
    if (fresh_tid_(b.w0) == 0) {
        unsigned* bar = b.bar;
        __builtin_amdgcn_s_waitcnt(0);
        unsigned nloc = b.st[0], nx = b.st[1];
        if (nloc == 0u) { xcd_barrier_complete(bar, b.x, nloc, nx); b.st[0] = nloc; b.st[1] = nx; }
        const unsigned old = xb_add(&bar[XB_XSUB(b.x)], 1u);
        const unsigned gen = old / nloc;
        if (old + 1u == (gen + 1u) * nloc) {
            __builtin_amdgcn_fence(__ATOMIC_RELEASE, "agent");
            asm volatile("s_waitcnt vmcnt(0)" ::: "memory");
            const unsigned og = xb_add(&bar[XB_TOP], 1u);
            const unsigned tg = og / nx;
            if (og + 1u == (tg + 1u) * nx) xb_add(&bar[XB_TOPGEN], 1u);
            else XB_SPIN(xb_ld(&bar[XB_TOPGEN]) == tg, bar);
            __builtin_amdgcn_fence(__ATOMIC_ACQUIRE, "agent");
            xb_add(&bar[XB_XGEN(b.x)], 1u);
            asm volatile("s_waitcnt vmcnt(0)" ::: "memory");
        } else {
            XB_SPIN(xb_ld(&bar[XB_XGEN(b.x)]) == gen, bar);
            __builtin_amdgcn_fence(__ATOMIC_ACQUIRE, "agent");
            asm volatile("s_waitcnt vmcnt(0)" ::: "memory");
        }
    }
    __syncthreads();
}

struct Args { const float* in[37]; float* out; unsigned char* ws; int ph_lo, ph_hi; };
enum { I_X = 0, I_MEM, I_NMIXG, I_WIN, I_CONVW, I_CONVB, I_LWX, I_LBX, I_LWA, I_LBA, I_LAM, I_MU, I_W0, I_WUP, I_A0, I_AUP, I_GUP, I_KK, I_KA, I_RK, I_LNG, I_LNB,
       I_WOUT, I_NXAG, I_NMEMG, I_WQ, I_WK, I_WV, I_WO, I_NFFG, I_WR, I_BR, I_WGU, I_BGU, I_WDN, I_BDN, I_FNG };

DI void transpose_item(const float* W, int ldw, int K, bf16* WT, int k0, int n0, int drow0, LAS float* scr, int lane, const float* rs = nullptr) {
    f32x4 t[8];
    const float* src = W + (size_t)(k0 + (lane >> 3)) * ldw + n0 + 4 * (lane & 7);
#pragma unroll
    for (int i = 0; i < 8; ++i) t[i] = *(const f32x4*)(src + (size_t)(8 * i) * ldw);
#pragma unroll
    for (int i = 0; i < 8; ++i) { const float sc_ = rs ? rs[k0 + 8 * i + (lane >> 3)] : 1.0f; LAS float* d = scr + (8 * i + (lane >> 3)) * 33 + 4 * (lane & 7); d[0] = t[i].x * sc_; d[1] = t[i].y * sc_; d[2] = t[i].z * sc_; d[3] = t[i].w * sc_; }
    asm volatile("s_waitcnt lgkmcnt(0)" ::: "memory");
    const int c = lane & 7;
#pragma unroll
    for (int j = 0; j < 4; ++j) { const int n = (lane >> 3) + 8 * j; const LAS float* s = scr + (8 * c) * 33 + n;
        u32x4 o; o.x = pk2(s[0 * 33], s[1 * 33]); o.y = pk2(s[2 * 33], s[3 * 33]); o.z = pk2(s[4 * 33], s[5 * 33]); o.w = pk2(s[6 * 33], s[7 * 33]);
        *(u32x4*)(WT + (size_t)(drow0 + n) * K + k0 + 8 * c) = o; }
    asm volatile("s_waitcnt lgkmcnt(0)" ::: "memory");
}
DI void transpose_item_tiled(const float* W, int ldw, int K, bf16* WTe, int k0, int n0, int drow0, LAS float* scr, int lane) {
    f32x4 t[8];
    const float* src = W + (size_t)(k0 + (lane >> 3)) * ldw + n0 + 4 * (lane & 7);
#pragma unroll
    for (int i = 0; i < 8; ++i) t[i] = *(const f32x4*)(src + (size_t)(8 * i) * ldw);
#pragma unroll
    for (int i = 0; i < 8; ++i) { LAS float* d = scr + (8 * i + (lane >> 3)) * 33 + 4 * (lane & 7); d[0] = t[i].x; d[1] = t[i].y; d[2] = t[i].z; d[3] = t[i].w; }
    asm volatile("s_waitcnt lgkmcnt(0)" ::: "memory");
    const int c = lane & 7;
#pragma unroll
    for (int j = 0; j < 4; ++j) { const int n = (lane >> 3) + 8 * j; const LAS float* s = scr + (8 * c) * 33 + n;
        u32x4 o; o.x = pk2(s[0 * 33], s[1 * 33]); o.y = pk2(s[2 * 33], s[3 * 33]); o.z = pk2(s[4 * 33], s[5 * 33]); o.w = pk2(s[6 * 33], s[7 * 33]);
        const int drow = drow0 + n, pn = drow >> 8, half = (drow >> 7) & 1, r = drow & 127, x = r & 31;
        const int rslot = (r & ~31) + 16 * ((x >> 2) & 1) + 4 * (x >> 3) + (x & 3);
        const size_t tb = ((size_t)(pn * (K / 64) + (k0 >> 6)) * 2 + half) * 16384 + pg8::lds_byte(rslot, 8 * c);
        *(u32x4*)((char*)WTe + tb) = o; }
    asm volatile("s_waitcnt lgkmcnt(0)" ::: "memory");
}
DI void transpose_item_tiled_nolds(const float* W, int ldw, int K, bf16* WTe, int k0, int n0, int drow0, int lane) {
    const int n = lane & 31, kh = lane >> 5;
    const float* src = W + (size_t)(k0 + 32 * kh) * ldw + n0 + n;
    float t[32];
#pragma unroll
    for (int i = 0; i < 32; ++i) t[i] = src[(size_t)i * ldw];
    const int drow = drow0 + n, pn = drow >> 8, half = (drow >> 7) & 1, r = drow & 127, x = r & 31;
    const int rslot = (r & ~31) + 16 * ((x >> 2) & 1) + 4 * (x >> 3) + (x & 3);
    const size_t tb0 = ((size_t)(pn * (K / 64) + (k0 >> 6)) * 2 + half) * 16384;
#pragma unroll
    for (int c = 0; c < 4; ++c) { u32x4 o; o.x = pk2(t[8 * c], t[8 * c + 1]); o.y = pk2(t[8 * c + 2], t[8 * c + 3]); o.z = pk2(t[8 * c + 4], t[8 * c + 5]); o.w = pk2(t[8 * c + 6], t[8 * c + 7]);
        *(u32x4*)((char*)WTe + tb0 + pg8::lds_byte(rslot, 32 * kh + 8 * c)) = o; }
}
DI void transpose_item_tiled_fp8(const float* W, int ldw, int K, unsigned char* WTe, int k0, int n0, int drow0, LAS float* scr, int lane) {
    f32x4 t[8];
    const float* src = W + (size_t)(k0 + (lane >> 3)) * ldw + n0 + 4 * (lane & 7);
#pragma unroll
    for (int i = 0; i < 8; ++i) t[i] = *(const f32x4*)(src + (size_t)(8 * i) * ldw);
#pragma unroll
    for (int i = 0; i < 8; ++i) { LAS float* d = scr + (8 * i + (lane >> 3)) * 33 + 4 * (lane & 7); d[0] = t[i].x * 64.f; d[1] = t[i].y * 64.f; d[2] = t[i].z * 64.f; d[3] = t[i].w * 64.f; }
    asm volatile("s_waitcnt lgkmcnt(0)" ::: "memory");
    const int c = lane & 3;
#pragma unroll
    for (int j = 0; j < 2; ++j) { const int n = (lane >> 2) + 16 * j; const LAS float* sp = scr + (16 * c) * 33 + n;
        u32x4 o; o.x = pk4_fp8(sp[0 * 33], sp[1 * 33], sp[2 * 33], sp[3 * 33]); o.y = pk4_fp8(sp[4 * 33], sp[5 * 33], sp[6 * 33], sp[7 * 33]);
        o.z = pk4_fp8(sp[8 * 33], sp[9 * 33], sp[10 * 33], sp[11 * 33]); o.w = pk4_fp8(sp[12 * 33], sp[13 * 33], sp[14 * 33], sp[15 * 33]);
        const int drow = drow0 + n, pn = drow >> 8, half = (drow >> 7) & 1, r = drow & 127, x = r & 31;
        const int rslot = (r & ~31) + 16 * ((x >> 2) & 1) + 4 * (x >> 3) + (x & 3);
        const int bc = (k0 & 64) + 16 * c;
        const size_t tb = ((size_t)(pn * (K / 128) + (k0 >> 7)) * 2 + half) * 16384 + pg8::lds_byte(rslot, bc >> 1);
        *(u32x4*)(WTe + tb) = o; }
    asm volatile("s_waitcnt lgkmcnt(0)" ::: "memory");
}
DI void rms_row_to_bf16(const float* xrow, const float* g, bf16* orow, int lane) {
    const f32x4* xr = (const f32x4*)xrow + lane; const f32x4* gr = (const f32x4*)g + lane;
    f32x4 v[4]; float s = 0.f;
#pragma unroll
    for (int j = 0; j < 4; ++j) { v[j] = xr[64 * j]; s += (v[j].x * v[j].x + v[j].y * v[j].y) + (v[j].z * v[j].z + v[j].w * v[j].w); }
    const float rstd = rsq_f(wave_sum(s) * (1.f / D) + EPS);
    u32x2* o8 = (u32x2*)orow + lane;
#pragma unroll
    for (int j = 0; j < 4; ++j) { const f32x4 gg = gr[64 * j]; u32x2 w; w.x = pk2(v[j].x * rstd * gg.x, v[j].y * rstd * gg.y); w.y = pk2(v[j].z * rstd * gg.z, v[j].w * rstd * gg.w); o8[64 * j] = w; }
}

DI void rms_rowbf_to_bf16(const bf16* xrow, const float* g, bf16* orow, int lane) {
    float v[16]; float s = 0.f;
#pragma unroll
    for (int hf = 0; hf < 2; ++hf) { const u32x4 w = *(const u32x4*)(xrow + 512 * hf + 8 * lane);
#pragma unroll
        for (int q = 0; q < 4; ++q) { v[8 * hf + 2 * q] = bflo(w[q]); v[8 * hf + 2 * q + 1] = bfhi(w[q]); } }
#pragma unroll
    for (int j = 0; j < 16; ++j) s += v[j] * v[j];
    const float rstd = rsq_f(wave_sum(s) * (1.f / D) + EPS);
#pragma unroll
    for (int hf = 0; hf < 2; ++hf) { const f32x4 g0 = *(const f32x4*)(g + 512 * hf + 8 * lane), g1 = *(const f32x4*)(g + 512 * hf + 8 * lane + 4);
        u32x4 w; w.x = pk2(v[8 * hf] * rstd * g0.x, v[8 * hf + 1] * rstd * g0.y); w.y = pk2(v[8 * hf + 2] * rstd * g0.z, v[8 * hf + 3] * rstd * g0.w);
        w.z = pk2(v[8 * hf + 4] * rstd * g1.x, v[8 * hf + 5] * rstd * g1.y); w.w = pk2(v[8 * hf + 6] * rstd * g1.z, v[8 * hf + 7] * rstd * g1.w);
        *(u32x4*)(orow + 512 * hf + 8 * lane) = w; }
}

__global__ void __launch_bounds__(NTHREADS, 2) fwd(Args args) {
    extern __shared__ __attribute__((aligned(16))) unsigned char lds_raw[];
    LAS unsigned char* lds = (LAS unsigned char*)lds_raw;
    volatile LAS unsigned* MISC = (volatile LAS unsigned*)(lds + MISC_OFF);
    const int G = gridDim.x, bid = blockIdx.x, NGW = G * NWAVES;
    const int wv0 = __builtin_amdgcn_readfirstlane((int)(threadIdx.x >> 6));
#define PHASE_IDS const int tid = fresh_tid(), lane = tid & 63, wave = __builtin_amdgcn_readfirstlane(tid >> 6), gw = bid * NWAVES + wave; (void)tid; (void)lane; (void)wave; (void)gw
    unsigned char* ws = args.ws;
    unsigned* ctl = (unsigned*)(ws + WS_CTL);
    const int lo = args.ph_lo, hi = args.ph_hi;

    for (int u = fresh_tid(); u < (LDS_BYTES - RING_BYTES) / 4; u += NTHREADS) ((LAS unsigned*)(lds + RING_BYTES))[u] = 0u;
    __syncthreads();
    XcdBarrier bar; bar.bar = ctl + CW_BAR; bar.x = 0; bar.st = nullptr; bar.w0 = wv0;
    if (hi - lo > 1) bar = xcd_barrier_post(ctl + CW_BAR, MISC + 8, wv0);
#define IN(k) (lo <= (k) && (k) < hi)
#define SEAM(k) do { if (IN(k) && IN((k) + 1)) xcd_barrier(bar); } while (0)

#define Win_t ((bf16*)(ws + WS_WIN))
#define Wout_t ((bf16*)(ws + WS_WOUT))
#define Wq_t ((bf16*)(ws + WS_WQ))
#define Wk_t ((bf16*)(ws + WS_WK))
#define Wv_t ((bf16*)(ws + WS_WV))
#define Wo_t ((bf16*)(ws + WS_WO))
#define LoraB ((bf16*)(ws + WS_LORAB))
#define LruW ((bf16*)(ws + WS_LRUW))
#define WrT ((bf16*)(ws + WS_LRUW + 512 * 1024))
#define Wgu_t ((bf16*)(ws + WS_WGU))
#define Wdn_t ((bf16*)(ws + WS_WDN))
#define HN ((bf16*)(ws + WS_HN))
#define MEMN ((bf16*)(ws + WS_MEMN))
#define KM ((bf16*)(ws + WS_KM))
#define VT ((bf16*)(ws + WS_VT))
#define X1 ((bf16*)(ws + WS_X1))
#define X2 ((bf16*)(ws + WS_X2))
#define U ((bf16*)(ws + WS_U))
#define Rr ((float*)(ws + WS_R))
#define KRAW ((float*)(ws + WS_KRAW))
#define Vv ((float*)(ws + WS_V))
#define KKN ((float*)(ws + WS_KKN))
#define WD ((float*)(ws + WS_WD))
#define AA ((float*)(ws + WS_AA))
#define GG ((float*)(ws + WS_G))
#define LA ((bf16*)(ws + WS_LA))
#define LB ((bf16*)(ws + WS_LB))
#define AP ((bf16*)(ws + WS_AP))
#define CAT ((bf16*)(ws + WS_CAT))
#define Qb ((bf16*)(ws + WS_Q))
#define Ob CAT
#define XS ((bf16*)(ws + WS_XS))
#define ACT ((bf16*)(ws + WS_ACT))
#define YS ((bf16*)(ws + WS_YS))
#define route_e ((int*)(ws + WS_ROUTE + RT_E))
#define route_pos ((int*)(ws + WS_ROUTE + RT_POS))
#define route_g ((float*)(ws + WS_ROUTE + RT_G))
#define row_slot ((int*)(ws + WS_ROUTE + RT_SLOT))
#define row_gate ((float*)(ws + WS_ROUTE + RT_GATE))
#define tile_tab ((int*)(ws + WS_ROUTE + RT_TILE))
#define row_tok ((int*)(ws + WS_ROUTE + RT_TOK))
#define ecnt (ctl + CW_CNT)

    if (IN(0)) { PHASE_IDS;
        LAS float* scr = (LAS float*)(lds + wave * 16384);
        constexpr int I_IN = 16 * (INW / 32), I_SQ = 16 * 32;
        constexpr int N_ITEMS = I_IN + 5 * I_SQ;
        for (int it = gw; it < N_ITEMS; it += NGW) {
            int r = it;
            if (r < I_IN) { const int nblk = INW / 32, kb = r / nblk, nb = r % nblk; transpose_item(args.in[I_WIN], INW, D, Win_t, 64 * kb, 32 * nb, 32 * nb, scr, lane); continue; } r -= I_IN;
            { const int w = r / I_SQ, q = r % I_SQ, kb = q / 32, nb = q % 32;
                if (w == 1) continue;
                const float* src = w == 0 ? args.in[I_WOUT] : w == 2 ? args.in[I_WK] : w == 3 ? args.in[I_WV] : args.in[I_WO];
                bf16* dst = w == 0 ? Wout_t : w == 2 ? Wk_t : w == 3 ? Wv_t : Wo_t;
                transpose_item(src, D, D, dst, 64 * kb, 32 * nb, 32 * nb, scr, lane); }
        }
        for (int idx = bid * NTHREADS + tid; idx < D * D / 4; idx += G * NTHREADS) { const f32x4 v = ((const f32x4*)args.in[I_WQ])[idx]; const float gk = args.in[I_NXAG][idx >> 8];
            u32x2 w; w.x = pk2(v.x * gk, v.y * gk); w.y = pk2(v.z * gk, v.w * gk); ((u32x2*)Wq_t)[idx] = w; }
        for (int idx = bid * NTHREADS + tid; idx < 1536 * 256; idx += G * NTHREADS) {
            const int e = idx & 7, ln = (idx >> 3) & 63, ks = (idx >> 9) & 7, ct = (idx >> 12) & 3, hk = idx >> 14, hh = hk / 3, kind = hk - 3 * hh;
            const int k = 32 * ks + 8 * (ln >> 4) + e, n = hh * 64 + 16 * ct + (ln & 15); float v = 0.f;
            if (kind == 0) { if (k < 64) v = args.in[I_WUP][k * 512 + n]; }
            else if (kind == 1) { if (k >= 64 && k < 128) v = args.in[I_AUP][(k - 64) * 512 + n]; }
            else { if (k >= 128) v = args.in[I_GUP][(k - 128) * 512 + n]; }
            LoraB[idx] = (bf16)f2bf(v);
        }
        for (int idx = bid * NTHREADS + tid; idx < 8 * 128 * 64; idx += G * NTHREADS) {
            const int nb = idx >> 13, col = (idx >> 6) & 127, k = idx & 63;
            const float v = col < 64 ? args.in[I_LWX][nb * 4096 + k * 64 + col] : args.in[I_LWA][nb * 4096 + k * 64 + (col - 64)];
            LruW[idx] = (bf16)f2bf(v);
        }
        for (int idx = bid * NTHREADS + tid; idx < NE * D; idx += G * NTHREADS) {
            const int e = idx >> 10, k = idx & 1023; const float v = args.in[I_WR][k * NE + e];
            const unsigned hi = f2bf(v); const float lo = v - __uint_as_float(hi << 16);
            WrT[idx] = (bf16)hi; WrT[NE * D + idx] = (bf16)f2bf(lo);
        }
        for (int m = gw; m < M; m += NGW) rms_row_to_bf16(args.in[I_X] + (size_t)m * D, args.in[I_NMIXG], HN + (size_t)m * D, lane);
        for (int m = gw; m < MROWS; m += NGW) rms_row_to_bf16(args.in[I_MEM] + (size_t)m * D, args.in[I_NMEMG], MEMN + (size_t)m * D, lane);
        {
            LAS float* scr = (LAS float*)(lds + wave * 16384);
            constexpr int I_GU = 16 * 64, I_DN = 16 * 32;
            for (int it = CONV_P9 + gw; it < NE * I_GU; it += NGW) {
                int r = it;
                if (r < NE * I_GU) { const int e = r / I_GU, q = r % I_GU, kb = q / 64, nb = q % 64; const int n0 = 32 * nb;
                    const int drow = n0 < 1024 ? (256 * (n0 >> 7) + (n0 & 127)) : (256 * ((n0 - 1024) >> 7) + 128 + ((n0 - 1024) & 127));
                    transpose_item_tiled_fp8(args.in[I_WGU] + (size_t)e * D * 2048, 2048, D, (unsigned char*)Wgu_t + (size_t)e * 2048 * D, 64 * kb, n0, drow, scr, lane); continue; } r -= NE * I_GU;
                { const int e = r / I_DN, q = r % I_DN, kb = q / 32, nb = q % 32;
                  transpose_item_tiled(args.in[I_WDN] + (size_t)e * DFF * D, D, DFF, Wdn_t + (size_t)e * D * DFF, 64 * kb, 32 * nb, 32 * nb, scr, lane); }
            }
        }
    }
    SEAM(0);

    if (IN(1)) { PHASE_IDS;
        { pg8::DenseSched S; S.o.init_tiles(M / 256, INW / 256, G, bid); S.A = (const char*)HN; S.B = (const char*)Win_t; S.tstep = (size_t)256 * D * 2;
          EpiBf16Plain E{U, INW, 1.0f}; pg8::gemm_phase(lds, D, S, E, wv0); }
        { pg8::DenseSched S; S.o.init_tiles(MROWS / 256, D / 256, G, (bid + 64) & (G - 1)); S.A = (const char*)MEMN; S.B = (const char*)Wk_t; S.tstep = (size_t)256 * D * 2;
          EpiBf16Plain E{KM, D, 1.0f}; pg8::gemm_phase(lds, D, S, E, wv0); }
        { pg8::DenseSched S; S.o.init_tiles(MROWS / 256, D / 256, G, (bid + 48) & (G - 1)); S.A = (const char*)MEMN; S.B = (const char*)Wv_t; S.tstep = (size_t)256 * D * 2;
          EpiBf16Plain E{VT, D, 1.0f}; pg8::gemm_phase(lds, D, S, E, wv0); }
    }
    SEAM(1);

    if (IN(2)) { PHASE_IDS;
        const float* conv_w = args.in[I_CONVW]; const float* conv_b = args.in[I_CONVB];
        LAS float* xs = (LAS float*)(lds + wave * 16384);
        LAS bf16* tP = (LAS bf16*)(lds + wave * 16384 + 4096); LAS bf16* tH = tP + 1024;
        const int i = lane & 15, kg = lane >> 4;
        for (int unit = gw; unit < (M / 64) * 8; unit += NGW) {
            const int seg = unit >> 3, nb = unit & 7, m0s = seg * 64, s0s = m0s & (SEQ - 1);
            bf16x8 wf[8][2];
#pragma unroll
            for (int ct = 0; ct < 8; ++ct)
#pragma unroll
                for (int ks = 0; ks < 2; ++ks) wf[ct][ks] = *(const bf16x8*)(LruW + ((size_t)(nb * 128 + 16 * ct + i) * 64 + 32 * ks + 8 * kg));
            float bxv[4], bav[4], spv[4], Arun[4], Brun[4];
#pragma unroll
            for (int ct = 0; ct < 4; ++ct) { const int ch = nb * 64 + 16 * ct + i; bxv[ct] = args.in[I_LBX][ch]; bav[ct] = args.in[I_LBA][ch]; spv[ct] = softplus_f(-args.in[I_LAM][ch]); Arun[ct] = 1.f; Brun[ct] = 0.f; }
#pragma unroll 1
            for (int jt = 0; jt < 4; ++jt) {
                const int m0 = m0s + 16 * jt, s0 = s0s + 16 * jt;
                bf16x8 af[2];
#pragma unroll
                for (int ks = 0; ks < 2; ++ks) {
                    const int chb = nb * 64 + 32 * ks + 8 * kg;
                    f32x4 x0 = *(const f32x4*)(conv_b + chb), x1 = *(const f32x4*)(conv_b + chb + 4);
#pragma unroll
                    for (int j = 0; j < 4; ++j) {
                        const bool ok = s0 + i - 3 + j >= 0;
                        u32x4 uw = *(const u32x4*)(U + (size_t)(ok ? m0 + i - 3 + j : m0) * INW + chb); if (!ok) uw = (u32x4){0u, 0u, 0u, 0u};
                        const f32x4 w0 = *(const f32x4*)(conv_w + j * 512 + chb), w1 = *(const f32x4*)(conv_w + j * 512 + chb + 4);
                        x0.x += w0.x * bflo(uw.x); x0.y += w0.y * bfhi(uw.x); x0.z += w0.z * bflo(uw.y); x0.w += w0.w * bfhi(uw.y);
                        x1.x += w1.x * bflo(uw.z); x1.y += w1.y * bfhi(uw.z); x1.z += w1.z * bflo(uw.w); x1.w += w1.w * bfhi(uw.w);
                    }
                    *(LAS f32x4*)(xs + i * 64 + 32 * ks + 8 * kg) = x0; *(LAS f32x4*)(xs + i * 64 + 32 * ks + 8 * kg + 4) = x1;
                    u32x4 p; p.x = pk2(x0.x, x0.y); p.y = pk2(x0.z, x0.w); p.z = pk2(x1.x, x1.y); p.w = pk2(x1.z, x1.w);
                    af[ks] = __builtin_bit_cast(bf16x8, p);
                }
                f32x4 acc[8];
#pragma unroll
                for (int ct = 0; ct < 8; ++ct) { acc[ct] = (f32x4){0.f, 0.f, 0.f, 0.f};
#pragma unroll
                    for (int ks = 0; ks < 2; ++ks) acc[ct] = __builtin_amdgcn_mfma_f32_16x16x32_bf16(af[ks], wf[ct][ks], acc[ct], 0, 0, 0); }
#pragma unroll
                for (int ct = 0; ct < 4; ++ct) {
                    const int col = 16 * ct + i;
                    float hl[4], pl[4]; float hprev = 0.f, pprev = 1.f;
#pragma unroll
                    for (int e = 0; e < 4; ++e) {
                        const float gx = sigmoid_f(acc[ct][e] + bxv[ct]), ga = sigmoid_f(acc[ct + 4][e] + bav[ct]);
                        const float la = -8.0f * ga * spv[ct], av = __expf(la), xcv = xs[(4 * kg + e) * 64 + col];
                        const float bt = __builtin_amdgcn_sqrtf(fmaxf(1.0f - av * av, 0.f)) * gx * xcv;
                        hprev = av * hprev + bt; pprev *= av; hl[e] = hprev; pl[e] = pprev;
                    }
                    float Ag[4], Bg[4];
#pragma unroll
                    for (int gq = 0; gq < 4; ++gq) { Ag[gq] = __shfl(pl[3], i + 16 * gq); Bg[gq] = __shfl(hl[3], i + 16 * gq); }
                    float Ain = Arun[ct], Bin = Brun[ct];
#pragma unroll
                    for (int gq = 0; gq < 3; ++gq) if (gq < kg) { Bin = Ag[gq] * Bin + Bg[gq]; Ain *= Ag[gq]; }
                    float At = 1.f, Bt = 0.f;
#pragma unroll
                    for (int gq = 0; gq < 4; ++gq) { Bt = Ag[gq] * Bt + Bg[gq]; At *= Ag[gq]; }
                    Brun[ct] = At * Brun[ct] + Bt; Arun[ct] *= At;
#pragma unroll
                    for (int e = 0; e < 4; ++e) { const int ti_ = (4 * kg + e) * 64 + col; tP[ti_] = (bf16)f2bf(pl[e] * Ain); tH[ti_] = (bf16)f2bf(hl[e] + pl[e] * Bin); }
                }
                { const int rr = lane >> 2, cq = lane & 3;
                  bf16* pp = LA + (size_t)(m0 + rr) * 512 + nb * 64 + 16 * cq; bf16* hp = LB + (size_t)(m0 + rr) * 512 + nb * 64 + 16 * cq;
                  *(u32x4*)pp = *(const LAS u32x4*)(tP + rr * 64 + 16 * cq); *(u32x4*)(pp + 8) = *(const LAS u32x4*)(tP + rr * 64 + 16 * cq + 8);
                  *(u32x4*)hp = *(const LAS u32x4*)(tH + rr * 64 + 16 * cq); *(u32x4*)(hp + 8) = *(const LAS u32x4*)(tH + rr * 64 + 16 * cq + 8); }
            }
            if (kg == 0) {
#pragma unroll
                for (int ct = 0; ct < 4; ++ct) { f32x2 ab; ab.x = Arun[ct]; ab.y = Brun[ct];
                    *(f32x2*)((float*)(ws + WS_AP) + ((size_t)(((seg >> 6) * 8 + nb) * 64 + (seg & 63)) * 64 + 16 * ct + i) * 2) = ab; }
            }
        }
    }
    SEAM(2);


#define RW_ZB(zz, zb) do { _Pragma("unroll") for (int ks_ = 0; ks_ < 2; ++ks_) { u32x4 p_; p_.x = pk2(zz[2 * ks_][0], zz[2 * ks_][1]); p_.y = pk2(zz[2 * ks_][2], zz[2 * ks_][3]); \
        p_.z = pk2(zz[2 * ks_ + 1][0], zz[2 * ks_ + 1][1]); p_.w = pk2(zz[2 * ks_ + 1][2], zz[2 * ks_ + 1][3]); zb[ks_] = __builtin_bit_cast(bf16x8, p_); } } while (0)
    if (IN(3)) { PHASE_IDS;
        for (int u64 = gw; u64 < NB * NH * (SEQ / 64); u64 += NGW) {
#pragma unroll 1
        for (int jj = 0; jj < 4; ++jj) {
        LAS unsigned char* wl = lds + wave * 16384;
        LAS bf16* Arm = (LAS bf16*)(wl); LAS bf16* Brm = (LAS bf16*)(wl + 2048); LAS bf16* Krm = (LAS bf16*)(wl + 4096); LAS bf16* Rrm = (LAS bf16*)(wl + 6144);
        LAS bf16* ATt = (LAS bf16*)(wl + 8192); LAS bf16* BTt = (LAS bf16*)(wl + 10240); LAS bf16* KTt = (LAS bf16*)(wl + 12288); LAS bf16* VTt = (LAS bf16*)(wl + 14336);
        LAS float* MabT = (LAS float*)(wl); LAS bf16* Mak = (LAS bf16*)(wl + 1024); LAS bf16* Mrb = (LAS bf16*)(wl + 1536); LAS bf16* Mrk = (LAS bf16*)(wl + 2048); LAS bf16* Tm = (LAS bf16*)(wl + 2560);
        LAS float* PLs = (LAS float*)(wl + 3072); LAS bf16* Q0T = (LAS bf16*)(wl + 4096);
        const int lane = fresh_tid() & 63, l15 = lane & 15, g = lane >> 4, te = lane >> 2, kq = lane & 3;
        const bf16x8 z8 = (bf16x8){0, 0, 0, 0, 0, 0, 0, 0};
        const f32x4 z4 = (f32x4){0.f, 0.f, 0.f, 0.f};
            const int un = u64 * 4 + jj;
            const int bh = un >> 8, c = un & 255, b = bh >> 3, h = bh & 7;
            const size_t mrow = (size_t)b * SEQ + c * 16 + te, off = mrow * 512 + h * 64 + 16 * kq;
            const int hc = h * 64 + 16 * kq;
            LAS float* tmpL = (LAS float*)wl;
            {
                const int rsub = lane >> 5, chunk = lane & 31; const size_t mt0 = (size_t)b * SEQ + c * 16;
                const f32x4 m0 = *(const f32x4*)(args.in[I_MU] + 1536 + 8 * chunk), m1 = *(const f32x4*)(args.in[I_MU] + 1536 + 8 * chunk + 4);
                u32x4 cu[8], pu[8];
#pragma unroll
                for (int i = 0; i < 8; ++i) { const size_t mr = mt0 + 2 * i + rsub; const bool hp2 = (mr & (SEQ - 1)) != 0; const bf16* ua = U + mr * INW + 2560 + 8 * chunk;
                    cu[i] = *(const u32x4*)ua; pu[i] = *(const u32x4*)(ua - (hp2 ? INW : 0)); if (!hp2) pu[i] = (u32x4){0u, 0u, 0u, 0u}; }
#pragma unroll
                for (int i = 0; i < 8; ++i) { float o8[8];
#pragma unroll
                    for (int q = 0; q < 4; ++q) { const float c0 = bflo(cu[i][q]), c1 = bfhi(cu[i][q]), p0 = bflo(pu[i][q]), p1 = bfhi(pu[i][q]); const float mm0 = q < 2 ? m0[2 * q] : m1[2 * q - 4], mm1 = q < 2 ? m0[2 * q + 1] : m1[2 * q - 3];
                        float x0 = c0 + (p0 - c0) * mm0, x1 = c1 + (p1 - c1) * mm1;
                        if (chunk < 8) { x0 = tanh_fast(x0); x1 = tanh_fast(x1); }
                        else if (chunk >= 16) { x0 = sigmoid_f(x0); x1 = sigmoid_f(x1); }
                        o8[2 * q] = x0; o8[2 * q + 1] = x1; }
                    u32x4 pw; pw.x = pk2(o8[0], o8[1]); pw.y = pk2(o8[2], o8[3]); pw.z = pk2(o8[4], o8[5]); pw.w = pk2(o8[6], o8[7]);
                    const int row = 2 * i + rsub; *(LAS u32x4*)(wl + row * 512 + ((chunk ^ (row & 7)) << 4)) = pw; }
                bf16x8 af[8];
#pragma unroll
                for (int ks = 0; ks < 8; ++ks) af[ks] = *(const LAS bf16x8*)(wl + l15 * 512 + (((4 * ks + g) ^ (l15 & 7)) << 4));
                asm volatile("s_waitcnt lgkmcnt(0)" ::: "memory");
#pragma unroll
                for (int kind = 0; kind < 3; ++kind)
#pragma unroll
                    for (int ct = 0; ct < 4; ++ct) {
                        const bf16* lb = LoraB + ((size_t)((h * 3 + kind) * 4 + ct) * 8 * 64 + lane) * 8;
                        f32x4 a4 = z4;
#pragma unroll
                        for (int ks = (kind == 0 ? 0 : kind == 1 ? 2 : 4); ks < (kind == 0 ? 2 : kind == 1 ? 4 : 8); ++ks) a4 = __builtin_amdgcn_mfma_f32_16x16x32_bf16(af[ks], *(const bf16x8*)(lb + ks * 512), a4, 0, 0, 0);
#pragma unroll
                        for (int e = 0; e < 4; ++e) tmpL[kind * 1088 + (4 * g + e) * 68 + 16 * ct + l15] = a4[e];
                    }
            }
            asm volatile("s_waitcnt lgkmcnt(0)" ::: "memory");
            float cl[16], eP[16];
            {
                float lwv[16], rl[16], kl[16], vl[16], kn[16], av[16];
                const bool hp = (mrow & (SEQ - 1)) != 0;
                const bf16* ub = U + mrow * INW + 1024 + hc;
#pragma unroll
                for (int hh = 0; hh < 2; ++hh) {
#pragma unroll
                    for (int a3 = 0; a3 < 3; ++a3) {
                        const u32x4 cu = *(const u32x4*)(ub + 512 * a3 + 8 * hh); u32x4 pu = *(const u32x4*)(ub - (hp ? INW : 0) + 512 * a3 + 8 * hh); if (!hp) pu = (u32x4){0u, 0u, 0u, 0u};
                        const f32x4 m0 = *(const f32x4*)(args.in[I_MU] + 512 * a3 + hc + 8 * hh), m1 = *(const f32x4*)(args.in[I_MU] + 512 * a3 + hc + 8 * hh + 4);
                        float o8[8];
#pragma unroll
                        for (int q = 0; q < 4; ++q) { const float c0 = bflo(cu[q]), c1 = bfhi(cu[q]), p0 = bflo(pu[q]), p1 = bfhi(pu[q]); const float mm0 = q < 2 ? m0[2 * q] : m1[2 * q - 4], mm1 = q < 2 ? m0[2 * q + 1] : m1[2 * q - 3];
                            o8[2 * q] = c0 + (p0 - c0) * mm0; o8[2 * q + 1] = c1 + (p1 - c1) * mm1; }
#pragma unroll
                        for (int q = 0; q < 8; ++q) { if (a3 == 0) rl[8 * hh + q] = o8[q]; else if (a3 == 1) kl[8 * hh + q] = o8[q]; else vl[8 * hh + q] = o8[q]; }
                    }
                }
                float gv[16];
#pragma unroll
                for (int j4 = 0; j4 < 4; ++j4) { const f32x4 xl = *(const LAS f32x4*)(tmpL + te * 68 + 16 * kq + 4 * j4), xa = *(const LAS f32x4*)(tmpL + 1088 + te * 68 + 16 * kq + 4 * j4), xg = *(const LAS f32x4*)(tmpL + 2176 + te * 68 + 16 * kq + 4 * j4);
                    const f32x4 w0v = *(const f32x4*)(args.in[I_W0] + hc + 4 * j4), a0v = *(const f32x4*)(args.in[I_A0] + hc + 4 * j4);
#pragma unroll
                    for (int q = 0; q < 4; ++q) { const float wq = -softplus_fast(-(xl[q] + w0v[q])) - 0.5f; lwv[4 * j4 + q] = -__expf(wq); av[4 * j4 + q] = sigmoid_f(xa[q] + a0v[q]); gv[4 * j4 + q] = xg[q]; } }
                asm volatile("s_waitcnt lgkmcnt(0)" ::: "memory");
                float ss = 0.f;
#pragma unroll
                for (int j4 = 0; j4 < 4; ++j4) { const f32x4 kk4 = *(const f32x4*)(args.in[I_KK] + hc + 4 * j4);
#pragma unroll
                    for (int q = 0; q < 4; ++q) { kn[4 * j4 + q] = kl[4 * j4 + q] * kk4[q]; ss += kn[4 * j4 + q] * kn[4 * j4 + q]; } }
                ss += __shfl_xor(ss, 1); ss += __shfl_xor(ss, 2);
                const float kinv = rsq_f(fmaxf(ss, 1e-24f));
#pragma unroll
                for (int j = 0; j < 16; ++j) { float x = lwv[j];
#pragma unroll
                    for (int sft = 4; sft < 64; sft <<= 1) { const float y = __shfl_up(x, sft); if (lane >= sft) x += y; }
                    cl[j] = x; }
                float bon = 0.f;
                u32x4 pa[2], pb[2], pk[2], pr[2];
#pragma unroll
                for (int j4 = 0; j4 < 4; ++j4) {
                    const f32x4 ka = *(const f32x4*)(args.in[I_KA] + hc + 4 * j4), rk = *(const f32x4*)(args.in[I_RK] + hc + 4 * j4);
                    float at4[4], bt4[4], kt4[4], rt4[4];
#pragma unroll
                    for (int q = 0; q < 4; ++q) { const int j = 4 * j4 + q;
                        const float p = __expf(cl[j]), pn = __expf(-cl[j]), pm1 = __expf(cl[j] - lwv[j]); eP[j] = p;
                        const float knj = kn[j] * kinv;
                        const float kp = kl[j] * (1.0f + (av[j] - 1.0f) * ka[q]);
                        at4[q] = -knj * pm1; bt4[q] = knj * av[j] * pn; kt4[q] = kp * pn; rt4[q] = rl[j] * p;
                        bon += rl[j] * kp * rk[q];
                        const int kk = 16 * kq + j;
                        ATt[kk * 16 + te] = (bf16)f2bf(at4[q]); BTt[kk * 16 + te] = (bf16)f2bf(bt4[q]); KTt[kk * 16 + te] = (bf16)f2bf(kt4[q]); VTt[kk * 16 + te] = (bf16)f2bf(vl[j]); }
                    const int hh = j4 >> 1, w2 = (j4 & 1) * 2;
                    pa[hh][w2] = pk2(at4[0], at4[1]); pa[hh][w2 + 1] = pk2(at4[2], at4[3]); pb[hh][w2] = pk2(bt4[0], bt4[1]); pb[hh][w2 + 1] = pk2(bt4[2], bt4[3]);
                    pk[hh][w2] = pk2(kt4[0], kt4[1]); pk[hh][w2 + 1] = pk2(kt4[2], kt4[3]); pr[hh][w2] = pk2(rt4[0], rt4[1]); pr[hh][w2 + 1] = pk2(rt4[2], rt4[3]);
                }
#pragma unroll
                for (int hh = 0; hh < 2; ++hh) { const int po = te * 64 + 8 * ((2 * kq + hh) ^ (te & 7));
                    *(LAS u32x4*)(Arm + po) = pa[hh]; *(LAS u32x4*)(Brm + po) = pb[hh]; *(LAS u32x4*)(Krm + po) = pk[hh]; *(LAS u32x4*)(Rrm + po) = pr[hh]; }
                bon += __shfl_xor(bon, 1); bon += __shfl_xor(bon, 2);
                f32x4 lbv[4], lgv[4];
#pragma unroll
                for (int j4 = 0; j4 < 4; ++j4) { lbv[j4] = *(const f32x4*)(args.in[I_LNB] + hc + 4 * j4); lgv[j4] = *(const f32x4*)(args.in[I_LNG] + hc + 4 * j4); }
#pragma unroll
                for (int j4 = 0; j4 < 4; ++j4) { const f32x4 lb = lbv[j4], lgn = lgv[j4]; const int j0 = 4 * j4;
                    u32x2 ow, gw2; ow.x = pk2((lb.x + vl[j0] * bon) * gv[j0], (lb.y + vl[j0 + 1] * bon) * gv[j0 + 1]); ow.y = pk2((lb.z + vl[j0 + 2] * bon) * gv[j0 + 2], (lb.w + vl[j0 + 3] * bon) * gv[j0 + 3]);
                    gw2.x = pk2(lgn.x * gv[j0], lgn.y * gv[j0 + 1]); gw2.y = pk2(lgn.z * gv[j0 + 2], lgn.w * gv[j0 + 3]);
                    *(u32x2*)((bf16*)(ws + WS_ADD) + off + j0) = ow; *(u32x2*)((bf16*)(ws + WS_G) + off + j0) = gw2; }
            }
            asm volatile("s_waitcnt lgkmcnt(0)" ::: "memory");
            {
                bf16x8 fa[2], fr[2], fb[2], fk[2];
#pragma unroll
                for (int ks = 0; ks < 2; ++ks) { const int po = l15 * 64 + 8 * ((4 * ks + g) ^ (l15 & 7));
                    fa[ks] = *(const LAS bf16x8*)(Arm + po); fr[ks] = *(const LAS bf16x8*)(Rrm + po); fb[ks] = *(const LAS bf16x8*)(Brm + po); fk[ks] = *(const LAS bf16x8*)(Krm + po); }
                f32x4 mab = z4, mak = z4, mrb = z4, mrk = z4;
#pragma unroll
                for (int ks = 0; ks < 2; ++ks) { mab = __builtin_amdgcn_mfma_f32_16x16x32_bf16(fb[ks], fa[ks], mab, 0, 0, 0); mak = __builtin_amdgcn_mfma_f32_16x16x32_bf16(fk[ks], fa[ks], mak, 0, 0, 0);
                    mrb = __builtin_amdgcn_mfma_f32_16x16x32_bf16(fb[ks], fr[ks], mrb, 0, 0, 0); mrk = __builtin_amdgcn_mfma_f32_16x16x32_bf16(fk[ks], fr[ks], mrk, 0, 0, 0); }
#pragma unroll
                for (int e = 0; e < 4; ++e) { const int i = 4 * g + e; if (!(i < l15)) { mab[e] = 0.f; mak[e] = 0.f; } if (!(i <= l15)) { mrb[e] = 0.f; mrk[e] = 0.f; } }
                asm volatile("s_waitcnt lgkmcnt(0)" ::: "memory");
#pragma unroll
                for (int e = 0; e < 4; ++e) MabT[(4 * g + e) * 16 + l15] = mab[e];
                u32x2 w; w.x = pk2(mak[0], mak[1]); w.y = pk2(mak[2], mak[3]); *(LAS u32x2*)(Mak + l15 * 16 + 4 * g) = w;
                w.x = pk2(mrb[0], mrb[1]); w.y = pk2(mrb[2], mrb[3]); *(LAS u32x2*)(Mrb + l15 * 16 + 4 * g) = w;
                w.x = pk2(mrk[0], mrk[1]); w.y = pk2(mrk[2], mrk[3]); *(LAS u32x2*)(Mrk + l15 * 16 + 4 * g) = w;
                if (te == 15) {
#pragma unroll
                    for (int j = 0; j < 16; ++j) PLs[16 * kq + j] = eP[j]; }
            }
            asm volatile("s_waitcnt lgkmcnt(0)" ::: "memory");
            {
                f32x4 mq[15][4];
#pragma unroll
                for (int j = 0; j < 15; ++j)
#pragma unroll
                    for (int q = 0; q < 4; ++q) if (4 * q + 3 > j) mq[j][q] = *(const LAS f32x4*)(MabT + j * 16 + 4 * q);
                float y[16];
#pragma unroll
                for (int j = 15; j >= 0; --j) {
                    float acc = (j == l15) ? 1.0f : 0.0f;
#pragma unroll
                    for (int i = j + 1; i < 16; ++i) acc += y[i] * mq[j < 15 ? j : 0][i >> 2][i & 3];
                    y[j] = acc;
                }
                if (g == 0) { u32x4 t0, t1; t0.x = pk2(y[0], y[1]); t0.y = pk2(y[2], y[3]); t0.z = pk2(y[4], y[5]); t0.w = pk2(y[6], y[7]); t1.x = pk2(y[8], y[9]); t1.y = pk2(y[10], y[11]); t1.z = pk2(y[12], y[13]); t1.w = pk2(y[14], y[15]);
                    *(LAS u32x4*)(Tm + l15 * 16) = t0; *(LAS u32x4*)(Tm + l15 * 16 + 8) = t1; }
            }
            asm volatile("s_waitcnt lgkmcnt(0)" ::: "memory");
            {
                const bool act = g < 2; const int fo = l15 * 16 + 8 * g;
                const bf16x8 fT = act ? *(const LAS bf16x8*)(Tm + fo) : z8, fMak = act ? *(const LAS bf16x8*)(Mak + fo) : z8, fMrb = act ? *(const LAS bf16x8*)(Mrb + fo) : z8, fMrk = act ? *(const LAS bf16x8*)(Mrk + fo) : z8;
                bf16x8 fV[4], fQ1[4], fAh[4], fBT[4], fKT[4];
#pragma unroll
                for (int vt = 0; vt < 4; ++vt) { fV[vt] = act ? *(const LAS bf16x8*)(VTt + vt * 256 + fo) : z8; fBT[vt] = act ? *(const LAS bf16x8*)(BTt + vt * 256 + fo) : z8; fKT[vt] = act ? *(const LAS bf16x8*)(KTt + vt * 256 + fo) : z8; }
#pragma unroll
                for (int vt = 0; vt < 4; ++vt) { const f32x4 q0 = __builtin_amdgcn_mfma_f32_16x16x32_bf16(fMak, fV[vt], z4, 0, 0, 0);
                    u32x2 w; w.x = pk2(q0[0], q0[1]); w.y = pk2(q0[2], q0[3]); *(LAS u32x2*)(Q0T + vt * 256 + l15 * 16 + 4 * g) = w; }
#pragma unroll
                for (int kt = 0; kt < 4; ++kt) { const bf16x8 fA = act ? *(const LAS bf16x8*)(ATt + kt * 256 + fo) : z8; const f32x4 ah = __builtin_amdgcn_mfma_f32_16x16x32_bf16(fT, fA, z4, 0, 0, 0);
                    u32x2 w; w.x = pk2(ah[0], ah[1]); w.y = pk2(ah[2], ah[3]); *(LAS u32x2*)(ATt + kt * 256 + l15 * 16 + 4 * g) = w; }
                asm volatile("s_waitcnt lgkmcnt(0)" ::: "memory");
#pragma unroll
                for (int vt = 0; vt < 4; ++vt) { const bf16x8 fQ0 = act ? *(const LAS bf16x8*)(Q0T + vt * 256 + fo) : z8; const f32x4 q1 = __builtin_amdgcn_mfma_f32_16x16x32_bf16(fT, fQ0, z4, 0, 0, 0);
                    u32x2 w; w.x = pk2(q1[0], q1[1]); w.y = pk2(q1[2], q1[3]); *(LAS u32x2*)(Q0T + vt * 256 + l15 * 16 + 4 * g) = w; }
                asm volatile("s_waitcnt lgkmcnt(0)" ::: "memory");
#pragma unroll
                for (int vt = 0; vt < 4; ++vt) { fQ1[vt] = act ? *(const LAS bf16x8*)(Q0T + vt * 256 + fo) : z8; fAh[vt] = act ? *(const LAS bf16x8*)(ATt + vt * 256 + fo) : z8; }
                bf16* rp = (bf16*)(ws + WS_RP) + (size_t)un * 1024 + l15 * 64;
#pragma unroll
                for (int kt = 0; kt < 4; ++kt) {
                    const u32x2 rr = *(const LAS u32x2*)(Rrm + l15 * 64 + 8 * ((2 * kt + (g >> 1)) ^ (l15 & 7)) + 4 * (g & 1));
                    f32x4 ini; ini[0] = bflo(rr.x); ini[1] = bfhi(rr.x); ini[2] = bflo(rr.y); ini[3] = bfhi(rr.y);
                    const f32x4 rh = __builtin_amdgcn_mfma_f32_16x16x32_bf16(fAh[kt], fMrb, ini, 0, 0, 0);
                    u32x2 w; w.x = pk2(rh[0], rh[1]); w.y = pk2(rh[2], rh[3]); *(u32x2*)(rp + 32 * (kt >> 1) + 8 * g + 4 * (kt & 1)) = w;
                }
#pragma unroll
                for (int vt = 0; vt < 4; ++vt) { f32x4 y1 = __builtin_amdgcn_mfma_f32_16x16x32_bf16(fMrb, fQ1[vt], z4, 0, 0, 0); y1 = __builtin_amdgcn_mfma_f32_16x16x32_bf16(fMrk, fV[vt], y1, 0, 0, 0);
                    *(f32x4*)((float*)(ws + WS_Y1F) + ((size_t)(un * 4 + vt) * 64 + lane) * 4) = y1; }
                LAS bf16* tgs = (LAS bf16*)(wl + 8192);
#pragma unroll
                for (int krt = 0; krt < 4; ++krt) { const float pl = PLs[16 * krt + l15];
#pragma unroll
                    for (int kct = 0; kct < 4; ++kct) { f32x4 ga = __builtin_amdgcn_mfma_f32_16x16x32_bf16(fAh[kct], fBT[krt], z4, 0, 0, 0);
                        if (kct == krt) {
#pragma unroll
                            for (int e = 0; e < 4; ++e) if (4 * g + e == l15) ga[e] += 1.0f; }
                        u32x2 w; w.x = pk2(ga[0] * pl, ga[1] * pl); w.y = pk2(ga[2] * pl, ga[3] * pl);
                        *(LAS u32x2*)(tgs + (16 * krt + l15) * 64 + 32 * (kct >> 1) + 8 * g + 4 * (kct & 1)) = w; } }
                { u32x4* gp16 = (u32x4*)((bf16*)(ws + WS_GP) + (size_t)un * 4096);
#pragma unroll
                  for (int i = 0; i < 8; ++i) gp16[i * 64 + lane] = *(const LAS u32x4*)(tgs + (i * 64 + lane) * 8); }
#pragma unroll
                for (int mt = 0; mt < 4; ++mt) { const f32x4 pl4 = *(const LAS f32x4*)(PLs + 16 * mt + 4 * g);
#pragma unroll
                    for (int vt = 0; vt < 4; ++vt) { f32x4 ha = __builtin_amdgcn_mfma_f32_16x16x32_bf16(fBT[mt], fQ1[vt], z4, 0, 0, 0); ha = __builtin_amdgcn_mfma_f32_16x16x32_bf16(fKT[mt], fV[vt], ha, 0, 0, 0);
                        u32x2 w; w.x = pk2(ha[0] * pl4[0], ha[1] * pl4[1]); w.y = pk2(ha[2] * pl4[2], ha[3] * pl4[3]);
                        *(u32x2*)((bf16*)(ws + WS_HF) + ((size_t)((un * 4 + vt) * 4 + mt) * 64 + lane) * 4) = w; } }
            }
            asm volatile("s_waitcnt lgkmcnt(0)" ::: "memory");
        }
        asm volatile("s_waitcnt vmcnt(0)" ::: "memory");
        { const int ltid = fresh_tid() & 63, l15 = ltid & 15, g = ltid >> 4, lane = ltid;
#define CP_LOADG(gf_, j_) do { const bf16* gp_ = (const bf16*)(ws + WS_GP) + ((size_t)u64 * 4 + (j_)) * 4096 + l15 * 64 + 8 * g; \
            _Pragma("unroll") for (int mt = 0; mt < 4; ++mt) { gf_[mt][0] = *(const bf16x8*)(gp_ + mt * 1024); gf_[mt][1] = *(const bf16x8*)(gp_ + mt * 1024 + 32); } } while (0)
#define CP_LOADH(hf_, j_) do { _Pragma("unroll") for (int sl = 0; sl < 4; ++sl) _Pragma("unroll") for (int mt = 0; mt < 4; ++mt) \
            hf_[sl][mt] = *(const u32x2*)((const bf16*)(ws + WS_HF) + ((size_t)((((size_t)u64 * 4 + (j_)) * 4 + sl) * 4 + mt) * 64 + lane) * 4); } while (0)
#define CP_STEP(gf_, hf_, useh_) do { _Pragma("unroll") for (int sl = 0; sl < 4; ++sl) { bf16x8 zb[2]; RW_ZB(z[sl], zb); \
            _Pragma("unroll") for (int mt = 0; mt < 4; ++mt) { f32x4 a_ = (f32x4){0.f, 0.f, 0.f, 0.f}; \
                if (useh_) { a_[0] = bflo(hf_[sl][mt].x); a_[1] = bfhi(hf_[sl][mt].x); a_[2] = bflo(hf_[sl][mt].y); a_[3] = bfhi(hf_[sl][mt].y); } \
                a_ = __builtin_amdgcn_mfma_f32_16x16x32_bf16(gf_[mt][0], zb[0], a_, 0, 0, 0); a_ = __builtin_amdgcn_mfma_f32_16x16x32_bf16(gf_[mt][1], zb[1], a_, 0, 0, 0); z[sl][mt] = a_; } } } while (0)
        {
            f32x4 z[4][4];
#pragma unroll
            for (int sl = 0; sl < 4; ++sl)
#pragma unroll
                for (int mt = 0; mt < 4; ++mt)
#pragma unroll
                    for (int e = 0; e < 4; ++e) z[sl][mt][e] = (sl == mt && 4 * g + e == l15) ? 1.0f : 0.0f;
            bf16x8 gA[4][2], gB[4][2]; u32x2 hdum[4][4];
            CP_LOADG(gA, 0); CP_LOADG(gB, 1);
            CP_STEP(gA, hdum, false); CP_LOADG(gA, 2);
            CP_STEP(gB, hdum, false); CP_LOADG(gB, 3);
            CP_STEP(gA, hdum, false);
            CP_STEP(gB, hdum, false);
            LAS bf16* tg = (LAS bf16*)(lds + wave * 16384);
#pragma unroll
            for (int sl = 0; sl < 4; ++sl) { const int pc = 32 * (sl >> 1) + 8 * (l15 >> 2) + 4 * (sl & 1) + (l15 & 3);
#pragma unroll
                for (int mt = 0; mt < 4; ++mt)
#pragma unroll
                    for (int e = 0; e < 4; ++e) tg[(16 * mt + 4 * g + e) * 64 + pc] = (bf16)f2bf(z[sl][mt][e]); }
            u32x4* gc = (u32x4*)((bf16*)(ws + WS_GC) + (size_t)u64 * 4096);
#pragma unroll
            for (int i = 0; i < 8; ++i) gc[i * 64 + lane] = *(const LAS u32x4*)(tg + (i * 64 + lane) * 8);
        }
        {
            f32x4 z[4][4];
#pragma unroll
            for (int sl = 0; sl < 4; ++sl)
#pragma unroll
                for (int mt = 0; mt < 4; ++mt) z[sl][mt] = (f32x4){0.f, 0.f, 0.f, 0.f};
            bf16x8 gA[4][2], gB[4][2]; u32x2 hA[4][4], hB[4][4];
            CP_LOADG(gA, 0); CP_LOADH(hA, 0); CP_LOADG(gB, 1); CP_LOADH(hB, 1);
            CP_STEP(gA, hA, true); CP_LOADG(gA, 2); CP_LOADH(hA, 2);
            CP_STEP(gB, hB, true); CP_LOADG(gB, 3); CP_LOADH(hB, 3);
            CP_STEP(gA, hA, true);
            CP_STEP(gB, hB, true);
#pragma unroll
            for (int sl = 0; sl < 4; ++sl)
#pragma unroll
                for (int mt = 0; mt < 4; ++mt) { u32x2 w; w.x = pk2(z[sl][mt][0], z[sl][mt][1]); w.y = pk2(z[sl][mt][2], z[sl][mt][3]);
                    *(u32x2*)((bf16*)(ws + WS_HC) + ((size_t)((u64 * 4 + sl) * 4 + mt) * 64 + lane) * 4) = w; }
        }
#undef CP_LOADG
#undef CP_LOADH
#undef CP_STEP
        }
        }
    }
    SEAM(3);


    if (IN(4)) { PHASE_IDS;
        if (!(bid < 128 && wave == 0)) {
            const int wi = bid < 128 ? bid * 7 + (wave - 1) : 896 + (bid - 128) * 8 + wave, NW = 896 + (G - 128) * 8;
        } else {
            const int l15 = lane & 15, g = lane >> 4, bh = bid >> 2, vs = bid & 3;
            f32x4 z[4];
#pragma unroll
            for (int mt = 0; mt < 4; ++mt) z[mt] = (f32x4){0.f, 0.f, 0.f, 0.f};
            bf16x8 gA[4][2], gB[4][2], gC[4][2], gD[4][2]; u32x2 hA[4], hB[4], hC[4], hD[4];
#define SC_LOAD(gf, hf, C) do { const size_t u64_ = (size_t)bh * 64 + (C); const bf16* gp_ = (const bf16*)(ws + WS_GC) + u64_ * 4096 + l15 * 64 + 8 * g; \
                _Pragma("unroll") for (int mt = 0; mt < 4; ++mt) { gf[mt][0] = *(const bf16x8*)(gp_ + mt * 1024); gf[mt][1] = *(const bf16x8*)(gp_ + mt * 1024 + 32); \
                    hf[mt] = *(const u32x2*)((const bf16*)(ws + WS_HC) + ((size_t)((u64_ * 4 + vs) * 4 + mt) * 64 + lane) * 4); } } while (0)
#define SC_STEP(gf, hf, C) do { const size_t u64_ = (size_t)bh * 64 + (C); bf16* zs_ = (bf16*)(ws + WS_ZS) + ((size_t)((u64_ * 4 + vs) * 4) * 64 + lane) * 4; \
                _Pragma("unroll") for (int mt = 0; mt < 4; ++mt) { u32x2 zw_; zw_.x = pk2(z[mt][0], z[mt][1]); zw_.y = pk2(z[mt][2], z[mt][3]); *(u32x2*)(zs_ + mt * 256) = zw_; } \
                bf16x8 zb[2]; RW_ZB(z, zb); \
                _Pragma("unroll") for (int mt = 0; mt < 4; ++mt) { f32x4 a; a[0] = bflo(hf[mt].x); a[1] = bfhi(hf[mt].x); a[2] = bflo(hf[mt].y); a[3] = bfhi(hf[mt].y); \
                    a = __builtin_amdgcn_mfma_f32_16x16x32_bf16(gf[mt][0], zb[0], a, 0, 0, 0); a = __builtin_amdgcn_mfma_f32_16x16x32_bf16(gf[mt][1], zb[1], a, 0, 0, 0); z[mt] = a; } } while (0)
            SC_LOAD(gA, hA, 0); SC_LOAD(gB, hB, 1); SC_LOAD(gC, hC, 2);
#pragma unroll 1
            for (int C = 0; C < 64; C += 4) {
                SC_LOAD(gD, hD, C + 3);
                SC_STEP(gA, hA, C);
                if (C + 4 < 64) SC_LOAD(gA, hA, C + 4);
                SC_STEP(gB, hB, C + 1);
                if (C + 5 < 64) SC_LOAD(gB, hB, C + 5);
                SC_STEP(gC, hC, C + 2);
                if (C + 6 < 64) SC_LOAD(gC, hC, C + 6);
                SC_STEP(gD, hD, C + 3);
            }
#undef SC_LOAD
#undef SC_STEP
        }
    }
    if (IN(4)) { PHASE_IDS;
        if (bid < 32 && wave == 1) { const int bc = bid; const f32x2* ag = (const f32x2*)((const float*)(ws + WS_AP)) + (size_t)(bc * 64) * 64 + lane;
            float* car = (float*)(ws + WS_AP + 4 * MiB) + (size_t)(bc * 64) * 64 + lane; float hst = 0.f;
#pragma unroll 16
            for (int sg = 0; sg < 64; ++sg) { const f32x2 ab = ag[(size_t)sg * 64]; car[(size_t)sg * 64] = hst; hst = ab.x * hst + ab.y; } }
    }
    if (IN(4)) { PHASE_IDS;
        bf16* WKt = HN; bf16* VWt = HN + (size_t)4 * 1024 * 1024;
        __syncthreads();
        if (bid >= 128 && bid < 192) { pg8::FoldSched<0> S; S.A = (const char*)KM; S.B = (const char*)Wq_t; S.G = 64; S.c = bid - 128; EpiFold<0> E{WKt}; pg8::gemm_phase(lds, 256, S, E, wv0, 1024); }
        else if (bid >= 192) { pg8::FoldSched<1> S; S.A = (const char*)Wo_t; S.B = (const char*)VT; S.G = 64; S.c = bid - 192; EpiFold<1> E{VWt}; pg8::gemm_phase(lds, 256, S, E, wv0, 1024); }
    }
    SEAM(4);

    if (IN(5)) { PHASE_IDS;
        {
            for (int lu = gw; lu < (M / 64) * 8; lu += NGW) {
                const int seg = lu >> 3, nb = lu & 7, rr = lane >> 3, cq = lane & 7;
                const float* cp = (const float*)(ws + WS_AP + 4 * MiB) + ((size_t)(((seg >> 6) * 8 + nb) * 64 + (seg & 63)) * 64 + 8 * cq);
                const f32x4 c0 = *(const f32x4*)cp, c1 = *(const f32x4*)(cp + 4);
#pragma unroll
                for (int it = 0; it < 8; ++it) { const size_t m = (size_t)seg * 64 + 8 * it + rr; const size_t o = m * 512 + nb * 64 + 8 * cq;
                    const u32x4 pw = *(const u32x4*)(LA + o), hw = *(const u32x4*)(LB + o), gw_ = *(const u32x4*)(U + m * INW + 512 + nb * 64 + 8 * cq);
                    float y[8];
#pragma unroll
                    for (int q = 0; q < 4; ++q) { const float ca = q < 2 ? c0[2 * q] : c1[2 * q - 4], cb = q < 2 ? c0[2 * q + 1] : c1[2 * q - 3];
                        y[2 * q] = (bflo(hw[q]) + bflo(pw[q]) * ca) * gelu_tanh_f(bflo(gw_[q])); y[2 * q + 1] = (bfhi(hw[q]) + bfhi(pw[q]) * cb) * gelu_tanh_f(bfhi(gw_[q])); }
                    u32x4 w; w.x = pk2(y[0], y[1]); w.y = pk2(y[2], y[3]); w.z = pk2(y[4], y[5]); w.w = pk2(y[6], y[7]);
                    *(u32x4*)(CAT + m * 1024 + nb * 64 + 8 * cq) = w; }
            }
        }
        const int l15 = lane & 15, g = lane >> 4;
        LAS bf16* tGL = (LAS bf16*)(lds + wave * 16384); LAS bf16* tAD = tGL + 1024; LAS bf16* tOUT = tGL + 2048;
        const int ct = lane >> 3, cc = lane & 7;
        for (int u64 = gw; u64 < NB * NH * (SEQ / 64); u64 += NGW) {
            const int bh = u64 >> 6, C = u64 & 63, b = bh >> 3, h = bh & 7;
            f32x4 z[4][4];
#pragma unroll
            for (int sl = 0; sl < 4; ++sl)
#pragma unroll
                for (int mt = 0; mt < 4; ++mt) { const u32x2 zw = *(const u32x2*)((const bf16*)(ws + WS_ZS) + ((size_t)((u64 * 4 + sl) * 4 + mt) * 64 + lane) * 4); z[sl][mt] = (f32x4){bflo(zw.x), bfhi(zw.x), bflo(zw.y), bfhi(zw.y)}; }
#pragma unroll 1
            for (int j = 0; j < 4; ++j) {
                const size_t un = (size_t)u64 * 4 + j; const size_t m0 = (size_t)b * SEQ + (C * 4 + j) * 16;
                const bf16* rp = (const bf16*)(ws + WS_RP) + un * 1024 + l15 * 64 + 8 * g;
                const bf16x8 rf0 = *(const bf16x8*)rp, rf1 = *(const bf16x8*)(rp + 32);
                f32x4 y[4];
#pragma unroll
                for (int sl = 0; sl < 4; ++sl) y[sl] = *(const f32x4*)((const float*)(ws + WS_Y1F) + ((size_t)(un * 4 + sl) * 64 + lane) * 4);
                const size_t rg = (m0 + ct) * 512 + h * 64 + 8 * cc;
                const u32x4 gl0 = *(const u32x4*)((const bf16*)(ws + WS_G) + rg), gl1 = *(const u32x4*)((const bf16*)(ws + WS_G) + rg + 8 * 512);
                const u32x4 ad0 = *(const u32x4*)((const bf16*)(ws + WS_ADD) + rg), ad1 = *(const u32x4*)((const bf16*)(ws + WS_ADD) + rg + 8 * 512);
                bf16x8 gf[4][2]; u32x2 hfr[4][4];
                if (j < 3) {
                    const bf16* gp = (const bf16*)(ws + WS_GP) + un * 4096 + l15 * 64 + 8 * g;
#pragma unroll
                    for (int mt = 0; mt < 4; ++mt) { gf[mt][0] = *(const bf16x8*)(gp + mt * 1024); gf[mt][1] = *(const bf16x8*)(gp + mt * 1024 + 32); }
#pragma unroll
                    for (int sl = 0; sl < 4; ++sl)
#pragma unroll
                        for (int mt = 0; mt < 4; ++mt) hfr[sl][mt] = *(const u32x2*)((const bf16*)(ws + WS_HF) + ((size_t)((un * 4 + sl) * 4 + mt) * 64 + lane) * 4);
                }
                *(LAS u32x4*)(tGL + ct * 64 + 8 * cc) = gl0; *(LAS u32x4*)(tGL + (ct + 8) * 64 + 8 * cc) = gl1;
                *(LAS u32x4*)(tAD + ct * 64 + 8 * cc) = ad0; *(LAS u32x4*)(tAD + (ct + 8) * 64 + 8 * cc) = ad1;
                bf16x8 zb[4][2];
#pragma unroll
                for (int sl = 0; sl < 4; ++sl) { RW_ZB(z[sl], zb[sl]);
                    y[sl] = __builtin_amdgcn_mfma_f32_16x16x32_bf16(rf0, zb[sl][0], y[sl], 0, 0, 0); y[sl] = __builtin_amdgcn_mfma_f32_16x16x32_bf16(rf1, zb[sl][1], y[sl], 0, 0, 0); }
#pragma unroll
                for (int e = 0; e < 4; ++e) {
                    float s1 = (y[0][e] + y[1][e]) + (y[2][e] + y[3][e]);
                    s1 += __shfl_xor(s1, 1); s1 += __shfl_xor(s1, 2); s1 += __shfl_xor(s1, 4); s1 += __shfl_xor(s1, 8);
                    const float mean = s1 * (1.0f / 64.0f);
                    float d0 = y[0][e] - mean, d1 = y[1][e] - mean, d2 = y[2][e] - mean, d3 = y[3][e] - mean;
                    float s2 = (d0 * d0 + d1 * d1) + (d2 * d2 + d3 * d3);
                    s2 += __shfl_xor(s2, 1); s2 += __shfl_xor(s2, 2); s2 += __shfl_xor(s2, 4); s2 += __shfl_xor(s2, 8);
                    const float rstd = rsq_f(s2 * (1.0f / 64.0f) + GN_EPS);
                    const float dd[4] = {d0, d1, d2, d3};
#pragma unroll
                    for (int sl = 0; sl < 4; ++sl) { const int ti_ = (4 * g + e) * 64 + 16 * sl + l15;
                        const float o = dd[sl] * rstd * bf2f(tGL[ti_]) + bf2f(tAD[ti_]); tOUT[ti_] = (bf16)f2bf(o); }
                }
                { bf16* cp = CAT + (m0 + ct) * 1024 + 512 + h * 64 + 8 * cc;
                  *(u32x4*)cp = *(const LAS u32x4*)(tOUT + ct * 64 + 8 * cc); *(u32x4*)(cp + 8 * 1024) = *(const LAS u32x4*)(tOUT + (ct + 8) * 64 + 8 * cc); }
                if (j < 3) {
#pragma unroll
                    for (int sl = 0; sl < 4; ++sl)
#pragma unroll
                        for (int mt = 0; mt < 4; ++mt) { const u32x2 hh = hfr[sl][mt];
                            f32x4 a; a[0] = bflo(hh.x); a[1] = bfhi(hh.x); a[2] = bflo(hh.y); a[3] = bfhi(hh.y);
                            a = __builtin_amdgcn_mfma_f32_16x16x32_bf16(gf[mt][0], zb[sl][0], a, 0, 0, 0); a = __builtin_amdgcn_mfma_f32_16x16x32_bf16(gf[mt][1], zb[sl][1], a, 0, 0, 0); z[sl][mt] = a; }
                }
            }
        }
    }
    SEAM(5);
#undef RW_ZB


    if (IN(6)) { PHASE_IDS;
        pg8::DenseSched S; S.o.init_tiles(M / 256, D / 256, G, bid); S.A = (const char*)CAT; S.B = (const char*)Wout_t; S.tstep = (size_t)256 * D * 2;
        EpiBf16Res<false> E{args.in[I_X], X1, D, (float*)(ws + WS_AP + 2 * MiB)}; pg8::gemm_phase(lds, D, S, E, wv0);
    }
    SEAM(6);
    if (IN(7)) { PHASE_IDS;
        pg8::BatchBSched S; S.o.init_tiles(M / 256, D / 256, G, bid); S.A = (const char*)X1; S.B = (const char*)HN; S.tstep = (size_t)256 * D * 2; S.bstep = (size_t)1024 * 1024 * 2;
        EpiSoftmax E{Qb, 0.0625f, (const float*)(ws + WS_AP + 2 * MiB), (LAS float*)(lds + RING_BYTES + 1024), (LAS float*)(lds + RING_BYTES + 1024 + 4096)};
        pg8::gemm_phase(lds, D, S, E, wv0);
    }
    SEAM(7);
    if (IN(8)) { PHASE_IDS;
        pg8::BatchBSched S; S.o.init_tiles(M / 256, D / 256, G, bid); S.A = (const char*)Qb; S.B = (const char*)(HN + (size_t)4 * 1024 * 1024); S.tstep = (size_t)256 * D * 2; S.bstep = (size_t)1024 * 1024 * 2;
        EpiBf16Res<true> E{X1, X2, D, nullptr}; pg8::gemm_phase(lds, D, S, E, wv0);
    }
    SEAM(8);
    if (IN(9)) { PHASE_IDS;
        for (int cid = tid; cid < 2 * NE * 128; cid += NTHREADS) { const int t = cid >> 12, row = (cid >> 7) & 31, c = cid & 127;
            *(LAS u32x4*)(lds + t * 65536 + row * 2048 + ((c ^ (row & 7)) << 4)) = *(const u32x4*)(WrT + (size_t)t * NE * D + row * D + 8 * c); }
        __syncthreads();
        const int l15 = lane & 15, g = lane >> 4;
        LAS float* LG = (LAS float*)(lds + RING_BYTES + 1024 + wave * 2304);
        const float* gfn = args.in[I_NFFG];
        LAS unsigned* cntl = (LAS unsigned*)(lds + RING_BYTES + 640);
        for (int t0 = 0; t0 < M / 16; t0 += G * 4) {
        if (tid < 64) cntl[tid] = 0u;
        __syncthreads();
        if (t0 == 0 && wave >= 4) {
            constexpr int I_GU = 16 * 64;
            for (int r = bid * 4 + (wave - 4); r < CONV_P9; r += G * 4) { const int e = r / I_GU, q = r % I_GU, kb = q / 64, nb = q % 64; const int n0 = 32 * nb;
                const int drow = n0 < 1024 ? (256 * (n0 >> 7) + (n0 & 127)) : (256 * ((n0 - 1024) >> 7) + 128 + ((n0 - 1024) & 127));
                transpose_item_tiled_nolds(args.in[I_WGU] + (size_t)e * D * 2048, 2048, D, Wgu_t + (size_t)e * 2048 * D, 64 * kb, n0, drow, lane); }
        }
        const int tile = t0 + bid * 4 + wave; const bool active = wave < 4 && tile < M / 16;
        int me = 0, lpos = 0, ai = 0; float mg = 0.f;
        if (active) {
            const int m0 = tile * 16;
            const bf16* xrow = X2 + (size_t)(m0 + l15) * D + 8 * g;
            float ss = 0.f;
#pragma unroll 8
            for (int ks = 0; ks < 32; ++ks) { const u32x4 xw = *(const u32x4*)(xrow + 32 * ks);
#pragma unroll
                for (int q = 0; q < 4; ++q) { const float a = bflo(xw[q]), c = bfhi(xw[q]); ss += a * a + c * c; } }
            ss += __shfl_xor(ss, 16); ss += __shfl_xor(ss, 32);
            const float rstd = rsq_f(ss * (1.f / D) + EPS);
            f32x4 acc0 = (f32x4){0.f, 0.f, 0.f, 0.f}, acc1 = acc0;
            unsigned char* hrow = (unsigned char*)HN + (size_t)(m0 + l15) * D + 8 * g;
#pragma unroll 2
            for (int ks = 0; ks < 32; ++ks) {
                const f32x4 g0 = *(const f32x4*)(gfn + 32 * ks + 8 * g), g1 = *(const f32x4*)(gfn + 32 * ks + 8 * g + 4);
                const u32x4 xw = *(const u32x4*)(xrow + 32 * ks);
                float hf[8];
#pragma unroll
                for (int q = 0; q < 4; ++q) { hf[2 * q] = bflo(xw[q]) * rstd * (q < 2 ? g0[2 * q] : g1[2 * q - 4]); hf[2 * q + 1] = bfhi(xw[q]) * rstd * (q < 2 ? g0[2 * q + 1] : g1[2 * q - 3]); }
                u32x4 hi, lo;
#pragma unroll
                for (int q = 0; q < 4; ++q) { hi[q] = pk2(hf[2 * q], hf[2 * q + 1]); lo[q] = pk2(hf[2 * q] - bflo(hi[q]), hf[2 * q + 1] - bfhi(hi[q])); }
                { u32x2 h8; h8.x = pk4_fp8(hf[0], hf[1], hf[2], hf[3]); h8.y = pk4_fp8(hf[4], hf[5], hf[6], hf[7]); *(u32x2*)(hrow + 32 * ks) = h8; }
                const bf16x8 ah = __builtin_bit_cast(bf16x8, hi), al = __builtin_bit_cast(bf16x8, lo);
                const int c = 4 * ks + g;
#pragma unroll
                for (int nt = 0; nt < 2; ++nt) { const int row = 16 * nt + l15; const int off = row * 2048 + ((c ^ (row & 7)) << 4);
                    const bf16x8 bh = *(const LAS bf16x8*)(lds + off), bl = *(const LAS bf16x8*)(lds + 65536 + off);
                    f32x4 a = nt ? acc1 : acc0;
                    a = __builtin_amdgcn_mfma_f32_16x16x32_bf16(ah, bh, a, 0, 0, 0); a = __builtin_amdgcn_mfma_f32_16x16x32_bf16(ah, bl, a, 0, 0, 0); a = __builtin_amdgcn_mfma_f32_16x16x32_bf16(al, bh, a, 0, 0, 0);
                    if (nt) acc1 = a; else acc0 = a; }
            }
            { const float b0 = args.in[I_BR][l15], b1 = args.in[I_BR][16 + l15];
#pragma unroll
              for (int j = 0; j < 4; ++j) { LG[(4 * g + j) * 33 + l15] = acc0[j] + b0; LG[(4 * g + j) * 33 + 16 + l15] = acc1[j] + b1; } }
            const int rrow = lane >> 2, qq = lane & 3;
            float tv[4] = {-3.0e38f, -3.0e38f, -3.0e38f, -3.0e38f}; int ti[4] = {64, 65, 66, 67};
#define TOP_INS(xv_, xi_) do { float x_ = (xv_); int i_ = (xi_); _Pragma("unroll") for (int p_ = 0; p_ < 4; ++p_) { const bool b_ = x_ > tv[p_] || (x_ == tv[p_] && i_ < ti[p_]); \
                const float ov_ = tv[p_]; const int oi_ = ti[p_]; tv[p_] = b_ ? x_ : ov_; ti[p_] = b_ ? i_ : oi_; x_ = b_ ? ov_ : x_; i_ = b_ ? oi_ : i_; } } while (0)
#pragma unroll
            for (int j = 0; j < 8; ++j) TOP_INS(LG[rrow * 33 + 8 * qq + j], 8 * qq + j);
#pragma unroll
            for (int st = 1; st < 4; st <<= 1) { float pv[4]; int pi[4];
#pragma unroll
                for (int p = 0; p < 4; ++p) { pv[p] = __shfl_xor(tv[p], st); pi[p] = __shfl_xor(ti[p], st); }
#pragma unroll
                for (int p = 0; p < 4; ++p) TOP_INS(pv[p], pi[p]); }
#undef TOP_INS
            const float e1 = __expf(tv[1] - tv[0]), e2 = __expf(tv[2] - tv[0]), e3 = __expf(tv[3] - tv[0]);
            const float inv = rcp_f(1.0f + e1 + e2 + e3);
            me = qq == 0 ? ti[0] : qq == 1 ? ti[1] : qq == 2 ? ti[2] : ti[3];
            mg = (qq == 0 ? 1.0f : qq == 1 ? e1 : qq == 2 ? e2 : e3) * inv;
            lpos = (int)__hip_atomic_fetch_add(cntl + me, 1u, __ATOMIC_RELAXED, __HIP_MEMORY_SCOPE_WORKGROUP);
            ai = (m0 + rrow) * 4 + qq;
        }
        __syncthreads();
        if (tid < NE) { const unsigned c = cntl[tid]; cntl[32 + tid] = c ? atomicAdd(ecnt + 64 * tid, c) : 0u; }
        __syncthreads();
        if (active) { route_e[ai] = me; route_pos[ai] = (int)cntl[32 + me] + lpos; route_g[ai] = mg; }
        __syncthreads();
        }
    }
    SEAM(9);
    if (IN(10)) { PHASE_IDS;
        LAS int* pst = (LAS int*)lds;
        if (tid == 0) { int acc = 0; for (int e = 0; e < NE; ++e) { const int c = (int)__hip_atomic_load(ecnt + 64 * e, __ATOMIC_RELAXED, __HIP_MEMORY_SCOPE_AGENT); pst[e] = acc; pst[64 + e] = c; acc += (c + 255) & ~255; } pst[32] = acc; }
        __syncthreads();
        for (int ai = bid * NTHREADS + tid; ai < NASSIGN; ai += G * NTHREADS) {
            const int e = route_e[ai]; const int row = pst[e] + route_pos[ai]; row_slot[row] = ai; row_gate[row] = route_g[ai]; row_tok[row] = ai >> 2; }
        if (bid < NE) { const int e = bid, c = pst[64 + e], pe = (c + 255) & ~255; for (int p = c + tid; p < pe; p += NTHREADS) { row_slot[pst[e] + p] = -1; row_gate[pst[e] + p] = 0.f; row_tok[pst[e] + p] = 0; } }
        if (bid == 0 && tid == 0) { int nt = 0; for (int e = 0; e < NE; ++e) { const int n = ((pst[64 + e] + 255) & ~255) >> 8; for (int j = 0; j < n; ++j) tile_tab[16 + nt++] = e; } tile_tab[0] = nt; }
        if (bid == 1 || bid == 2) { const int nt = pst[32] >> 8, nN = bid == 1 ? 8 : 4; int* tab = (int*)(ws + WS_ROUTE + (bid == 1 ? RT_UGU : RT_UDN));
            for (int L = tid; L < nt * nN; L += NTHREADS) { Unit uu; { const int nwg = nt * nN; int wgid = L; { const int q = nwg / 8, r = nwg % 8, xcd = wgid % 8, off = wgid / 8; wgid = (xcd < r ? xcd * (q + 1) : r * (q + 1) + (xcd - r) * q) + off; }
                    const int nig = 8 * nN, gid = wgid / nig, fm = gid * 8, gsz = (nt - fm) < 8 ? (nt - fm) : 8; uu.pm = fm + ((wgid % nig) % gsz); uu.pn = (wgid % nig) / gsz; uu.e = 0; }
                int e = 0; while (e < NE - 1 && (pst[e + 1] >> 8) <= uu.pm) ++e;
                tab[L] = uu.pm | (uu.pn << 12) | (e << 16); } }
        __syncthreads();
    }
    SEAM(10);
    if (IN(11)) {
        const int ntiles = tile_tab[0];
        pg8::MoeGatherSched S; S.o.init_tiles(ntiles, 2048 / 256, G, bid); S.A = (const char*)HN; S.B = (const char*)Wgu_t; S.tile_e = tile_tab + 16; S.utab = (const int*)(ws + WS_ROUTE + RT_UGU); S.rtok = row_tok; S.tstep = (size_t)256 * 1024; S.estep = (size_t)2048 * 1024;
        EpiSwiglu E{ACT, args.in[I_BGU]}; pg8::gemm_phase<EpiSwiglu, pg8::MoeGatherSched, true, true>(lds, 512, S, E, wv0);
        { PHASE_IDS; LAS float* scr = (LAS float*)(lds + wave * 16384); constexpr int I_DN = 16 * 32;
          for (;;) { int c0 = 0; if (lane == 0) c0 = (int)atomicAdd(ctl + CW_CONV, 8u); c0 = __builtin_amdgcn_readfirstlane(c0);
              if (c0 >= NE * I_DN) break;
              for (int r = c0; r < c0 + 8; ++r) { const int e = r / I_DN, q = r % I_DN, kb = q / 32, nb = q % 32;
                  transpose_item_tiled_fp8(args.in[I_WDN] + (size_t)e * DFF * D, D, DFF, (unsigned char*)Wdn_t + (size_t)e * D * DFF, 64 * kb, 32 * nb, 32 * nb, scr, lane); } } }
    }
    SEAM(11);
    if (IN(12)) {
        const int ntiles = tile_tab[0];
        pg8::MoeSched S; S.o.init_tiles(ntiles, D / 256, G, bid); S.A = (const char*)ACT; S.B = (const char*)Wdn_t; S.tile_e = tile_tab + 16; S.utab = (const int*)(ws + WS_ROUTE + RT_UDN); S.tstep = (size_t)256 * 1024; S.estep = (size_t)1024 * 1024;
        EpiDown E{YS, args.in[I_BDN], row_slot, row_gate}; pg8::gemm_phase<EpiDown, pg8::MoeSched, true, true>(lds, 512, S, E, wv0);
    }
    SEAM(12);
    if (IN(13)) { PHASE_IDS;
        const float* gfin = args.in[I_FNG];
        for (int m = gw; m < M; m += NGW) {
            float v[16]; float s = 0.f;
#pragma unroll
            for (int hf = 0; hf < 2; ++hf) { const u32x4 w = *(const u32x4*)(X2 + (size_t)m * D + 512 * hf + 8 * lane);
#pragma unroll
                for (int q = 0; q < 4; ++q) { v[8 * hf + 2 * q] = bflo(w[q]); v[8 * hf + 2 * q + 1] = bfhi(w[q]); }
#pragma unroll
                for (int k = 0; k < 4; ++k) { const u32x4 y = *(const u32x4*)(YS + (size_t)(m * 4 + k) * D + 512 * hf + 8 * lane);
#pragma unroll
                    for (int q = 0; q < 4; ++q) { v[8 * hf + 2 * q] += bflo(y[q]); v[8 * hf + 2 * q + 1] += bfhi(y[q]); } } }
#pragma unroll
            for (int j = 0; j < 16; ++j) s += v[j] * v[j];
            const float rstd = rsq_f(wave_sum(s) * (1.f / D) + EPS);
#pragma unroll
            for (int hf = 0; hf < 2; ++hf) { const f32x4 g0 = *(const f32x4*)(gfin + 512 * hf + 8 * lane), g1 = *(const f32x4*)(gfin + 512 * hf + 8 * lane + 4);
                float* o = args.out + (size_t)m * D + 512 * hf + 8 * lane;
                *(f32x4*)o = (f32x4){v[8 * hf] * rstd * g0.x, v[8 * hf + 1] * rstd * g0.y, v[8 * hf + 2] * rstd * g0.z, v[8 * hf + 3] * rstd * g0.w};
                *(f32x4*)(o + 4) = (f32x4){v[8 * hf + 4] * rstd * g1.x, v[8 * hf + 5] * rstd * g1.y, v[8 * hf + 6] * rstd * g1.z, v[8 * hf + 7] * rstd * g1.w}; }
        }
    }
#undef IN
#undef SEAM
}

constexpr int N_PHASES = 14;
extern "C" void kernel_launch(void* const* d_in, const int* in_sizes, int n_in, void* d_out, int out_size, void* d_ws, size_t ws_size, hipStream_t stream) {
    static int grid = 0;
    if (grid == 0) {
        if (n_in != 37 || out_size != M * D || ws_size < WS_END) { fprintf(stderr, "kernel_launch: unexpected shapes (n_in %d, out %d, ws %zu); nothing launched\n", n_in, out_size, ws_size); grid = -1; return; }
        int dev = 0, cus = 0, per_cu = 0;
        if (hipGetDevice(&dev) != hipSuccess || hipDeviceGetAttribute(&cus, hipDeviceAttributeMultiprocessorCount, dev) != hipSuccess) { grid = -1; return; }
        if (hipFuncSetAttribute((const void*)fwd, hipFuncAttributeMaxDynamicSharedMemorySize, LDS_BYTES) != hipSuccess) { fprintf(stderr, "kernel_launch: hipFuncSetAttribute failed\n"); grid = -1; return; }
        if (hipOccupancyMaxActiveBlocksPerMultiprocessor(&per_cu, (const void*)fwd, NTHREADS, LDS_BYTES) != hipSuccess || per_cu < 1) fprintf(stderr, "kernel_launch: occupancy query says %d\n", per_cu);
        (void)hipGetLastError();
        grid = cus > 256 ? 256 : cus;
    }
    if (grid < 0) return;
    if (hipMemsetAsync((char*)d_ws + WS_CTL, 0, CTL_ZERO_BYTES, stream) != hipSuccess) return;
    Args a{};
    for (int i = 0; i < 37; ++i) a.in[i] = (const float*)d_in[i];
    a.out = (float*)d_out; a.ws = (unsigned char*)d_ws;
#if MK_ONE_LAUNCH
    a.ph_lo = 0; a.ph_hi = N_PHASES;
    hipLaunchKernelGGL(fwd, dim3(grid), dim3(NTHREADS), LDS_BYTES, stream, a);
#else
    for (int p = 0; p < N_PHASES; ++p) { a.ph_lo = p; a.ph_hi = p + 1; hipLaunchKernelGGL(fwd, dim3(grid), dim3(NTHREADS), LDS_BYTES, stream, a);
#ifdef PROBE_REPEAT_PHASE
        if (p == PROBE_REPEAT_PHASE) hipLaunchKernelGGL(fwd, dim3(grid), dim3(NTHREADS), LDS_BYTES, stream, a);
#endif
    }
#endif
}
```

```cpp
#include <hip/hip_runtime.h>
#include <cstdio>
#include <cstdint>

#ifndef MK_ONE_LAUNCH
#define MK_ONE_LAUNCH 1
#endif

#define DI __device__ __forceinline__
#define GAS __attribute__((address_space(1)))
#define LAS __attribute__((address_space(3)))
typedef unsigned short bf16;
typedef short bf16x8 __attribute__((ext_vector_type(8)));
typedef int v4i __attribute__((ext_vector_type(4)));
typedef int v8i __attribute__((ext_vector_type(8)));
typedef float f32x4 __attribute__((ext_vector_type(4)));
typedef float f32x2 __attribute__((ext_vector_type(2)));
typedef unsigned u32x4 __attribute__((ext_vector_type(4)));
typedef unsigned u32x2 __attribute__((ext_vector_type(2)));

constexpr int D = 1024, NB = 4, SEQ = 4096, M = NB * SEQ;
constexpr int MEML = 256, MROWS = NB * MEML;
constexpr int LRU_W = 512, RW = 512, NH = 8, HD = 64;
constexpr int INW = 2816;
constexpr int XH = 4, XHD = 256;
constexpr int NE = 32, TOPK = 4, DFF = 1024;
constexpr int NASSIGN = M * TOPK;
constexpr int MAXTILES = 288, MAXROWS = MAXTILES * 256;
constexpr float EPS = 1e-6f, GN_EPS = 64e-5f;

DI int fresh_tid_(int wv) { int w = wv; asm volatile("" : "+s"(w)); int l; asm volatile("v_mbcnt_lo_u32_b32 %0, -1, 0\n\tv_mbcnt_hi_u32_b32 %0, -1, %0" : "=v"(l)); return (w << 6) | (l & 63); }
#define fresh_tid() fresh_tid_(wv0)
namespace pg8 {
constexpr int BM = 256, BK = 64, HALF = 128, HTB = HALF * BK * 2, STAGE_BYTES = 8 * HTB, NXCD = 8, WGM = 8;
__host__ __device__ __forceinline__ int lds_byte(int r, int c) { const int st = (r >> 4) * 2 + (c >> 5), rr = r & 15, cc = c & 31, ob = rr * 64 + cc * 2; return st * 1024 + (ob ^ (((ob >> 9) & 1) << 5)); }
__host__ __device__ __forceinline__ void stage_rc(int b, int& R, int& C) { const int st = b / 1024, sb = b % 1024, swz = sb ^ (((sb >> 9) & 1) << 5); R = (st >> 1) * 16 + swz / 64; C = (st & 1) * 32 + (swz % 64) / 2; }
__host__ __device__ __forceinline__ int perm32(int rho) { const int n = rho >> 4, i = rho & 15; return 8 * (i >> 2) + 4 * n + (i & 3); }

struct Unit { int pm, pn, e; };

struct StaticOrder {
    int nM, nN, nwg, G, c;
    __host__ __device__ void init_tiles(int nM_, int nN_, int G_, int c_) { nM = nM_; nN = nN_; nwg = nM * nN; G = G_; c = c_; }
    __host__ __device__ bool next(int i, Unit& u) const {
        const long L = (long)i * G + c; if (L >= nwg) return false;
        int wgid = (int)L; { const int q = nwg / NXCD, r = nwg % NXCD, xcd = wgid % NXCD, off = wgid / NXCD; wgid = (xcd < r ? xcd * (q + 1) : r * (q + 1) + (xcd - r) * q) + off; }
        const int nig = WGM * nN, gid = wgid / nig, fm = gid * WGM, gsz = (nM - fm) < WGM ? (nM - fm) : WGM;
        u.pm = fm + ((wgid % nig) % gsz); u.pn = (wgid % nig) / gsz; u.e = 0; return true;
    }
};
struct DenseSched {
    static constexpr bool GATHER = false, B_TILED = false;
    StaticOrder o; const char* A; const char* B; size_t tstep;
    DI bool next(int i, Unit& u) const { return o.next(i, u); }
    DI const char* a_ptr(const Unit& u) const { return A + (size_t)u.pm * tstep; }
    DI const char* b_ptr(const Unit& u) const { return B + (size_t)u.pn * tstep; }
    DI void a_voff(const Unit&, int K, const int (&R)[2], const int (&C)[2], unsigned (&vo)[2][2]) const {
#pragma unroll
        for (int h = 0; h < 2; ++h)
#pragma unroll
            for (int i = 0; i < 2; ++i) vo[h][i] = (unsigned)((h * HALF + R[i]) * K + C[i]) * 2u; }
};
struct MoeSched {
    static constexpr bool GATHER = false, B_TILED = true;
    StaticOrder o; const char* A; const char* B; const int* tile_e; const int* utab; size_t tstep, estep;
    DI bool next(int i, Unit& u) const { const int L = i * o.G + o.c; if (L >= o.nwg) return false; int en; asm volatile("s_load_dword %0, %1, 0x0\n\ts_waitcnt lgkmcnt(0)" : "=s"(en) : "s"(utab + L) : "memory");     u.pm = en & 0xfff; u.pn = (en >> 12) & 15; u.e = en >> 16; return true; }
    DI const char* a_ptr(const Unit& u) const { return A + (size_t)u.pm * tstep; }
    DI const char* b_ptr(const Unit& u) const { return B + (size_t)u.e * estep + (size_t)u.pn * tstep; }
    DI void a_voff(const Unit&, int K, const int (&R)[2], const int (&C)[2], unsigned (&vo)[2][2]) const {
#pragma unroll
        for (int h = 0; h < 2; ++h)
#pragma unroll
            for (int i = 0; i < 2; ++i) vo[h][i] = (unsigned)((h * HALF + R[i]) * K + C[i]) * 2u; }
};
struct MoeGatherSched {
    static constexpr bool GATHER = true, B_TILED = true;
    StaticOrder o; const char* A; const char* B; const int* tile_e; const int* utab; const int* rtok; size_t tstep, estep;
    DI bool next(int i, Unit& u) const { const int L = i * o.G + o.c; if (L >= o.nwg) return false; int en; asm volatile("s_load_dword %0, %1, 0x0\n\ts_waitcnt lgkmcnt(0)" : "=s"(en) : "s"(utab + L) : "memory");     u.pm = en & 0xfff; u.pn = (en >> 12) & 15; u.e = en >> 16; return true; }
    DI const char* a_ptr(const Unit&) const { return A; }
    DI const char* b_ptr(const Unit& u) const { return B + (size_t)u.e * estep + (size_t)u.pn * tstep; }
    DI void a_voff(const Unit& u, int K, const int (&R)[2], const int (&C)[2], unsigned (&vo)[2][2]) const {
#pragma unroll
        for (int h = 0; h < 2; ++h)
#pragma unroll
            for (int i = 0; i < 2; ++i) vo[h][i] = (unsigned)(rtok[u.pm * BM + h * HALF + R[i]] * K + C[i]) * 2u; }
};

struct BatchBSched {
    static constexpr bool GATHER = false, B_TILED = false;
    StaticOrder o; const char* A; const char* B; size_t tstep, bstep;
    DI bool next(int i, Unit& u) const { return o.next(i, u); }
    DI const char* a_ptr(const Unit& u) const { return A + (size_t)u.pm * tstep; }
    DI const char* b_ptr(const Unit& u) const { return B + (size_t)(u.pm >> 4) * bstep + (size_t)u.pn * tstep; }
    DI void a_voff(const Unit&, int K, const int (&R)[2], const int (&C)[2], unsigned (&vo)[2][2]) const {
#pragma unroll
        for (int h = 0; h < 2; ++h)
#pragma unroll
            for (int i = 0; i < 2; ++i) vo[h][i] = (unsigned)((h * HALF + R[i]) * K + C[i]) * 2u; }
};
template <int MODE> struct FoldSched {
    static constexpr bool GATHER = false, B_TILED = false;
    const char* A; const char* B; int G, c;
    DI bool next(int i, Unit& u) const { const int L = i * G + c; if (L >= 64) return false; u.pm = L >> 2; u.pn = L & 3; u.e = 0; return true; }
    DI const char* a_ptr(const Unit& u) const { const int b = u.pm >> 2, h = u.pm & 3; return A + ((size_t)(MODE == 0 ? b * 256 : u.pn * 256) * 1024 + h * 256) * 2; }
    DI const char* b_ptr(const Unit& u) const { const int b = u.pm >> 2, h = u.pm & 3; return B + ((size_t)(MODE == 0 ? u.pn * 256 : b * 256) * 1024 + h * 256) * 2; }
    DI void a_voff(const Unit&, int K, const int (&R)[2], const int (&C)[2], unsigned (&vo)[2][2]) const {
#pragma unroll
        for (int h = 0; h < 2; ++h)
#pragma unroll
            for (int i = 0; i < 2; ++i) vo[h][i] = (unsigned)((h * HALF + R[i]) * K + C[i]) * 2u; }
};

DI unsigned cvt_pk_bf16(float lo, float hi) { unsigned r; asm volatile("v_cvt_pk_bf16_f32 %0, %1, %2" : "=v"(r) : "v"(lo), "v"(hi)); return r; }

template <class Epi, class Sched, bool ALIGN_EPI = true, bool FP8 = false>
DI void gemm_phase(LAS unsigned char* lds, const int K, const Sched& S, const Epi& E, const int wv0, const int ldp = 0) {
    const int ld = ldp ? ldp : K;
    const int tid = fresh_tid(), wid = __builtin_amdgcn_readfirstlane(tid >> 6), lane = tid & 63, wr = wid >> 2, wc = wid & 3, fr = lane & 15, fq = lane >> 4;
    const int nt = K / BK;
    constexpr bool GA = Sched::GATHER, BT = Sched::B_TILED;
    unsigned voffA[2][2], voffAn[2][2], voffB[2];
#pragma unroll
    for (int i = 0; i < 2; ++i) { int R, C; stage_rc(tid * 16 + i * 8192, R, C); const int Rb = Epi::PERM ? ((R & ~31) + perm32(R & 31)) : R;
        voffB[i] = BT ? (unsigned)(tid * 16 + i * 8192) : (unsigned)(Rb * ld + C) * 2u; }
#define PG8_AVOFF(unit, dst) do { int sR[2], sC[2]; const int t2_ = fresh_tid(); stage_rc(t2_ * 16, sR[0], sC[0]); stage_rc(t2_ * 16 + 8192, sR[1], sC[1]); S.a_voff(unit, ld, sR, sC, dst); } while (0)
    const size_t kstep = (size_t)(BK * 2);
    const size_t hstep = (size_t)HALF * ld * 2;
    const size_t kstepB = BT ? (size_t)(2 * HTB) : kstep, hstepB = BT ? (size_t)HTB : hstep;
    const unsigned ldsw = (unsigned)wid * 1024u;
    unsigned aoffv = (unsigned)(size_t)lds + (unsigned)lds_byte(wr * 64 + fr, fq * 8), boffv = (unsigned)(size_t)lds + (unsigned)(4 * HTB) + (unsigned)lds_byte(wc * 32 + fr, fq * 8);
    asm volatile("" : "+v"(aoffv), "+v"(boffv));
    const size_t dB = BT ? (size_t)8192 : (size_t)64 * ld * 2, dA = (size_t)64 * ld * 2;
#define PG8_SA(b, h) (((b) * 2 + (h)) * HTB)
#define PG8_SB(b, h) ((4 + (b) * 2 + (h)) * HTB)
    const unsigned ldsbase = (unsigned)__builtin_amdgcn_readfirstlane((int)((unsigned)(size_t)lds + ldsw));
#define PG8_STAGE1(bufoff, gptr, vo, i_) do { const unsigned m0v_ = ldsbase + (unsigned)(bufoff) + (unsigned)(i_) * 8192u; \
        asm volatile("s_mov_b32 m0, %2\n\ts_nop 0\n\tglobal_load_lds_dwordx4 %0, %1" :: "v"(vo), "s"((const char*)(gptr)), "s"(m0v_) : "memory", "m0"); } while (0)
#define PG8_STAGE(bufoff, gbase, voff) do { PG8_STAGE1(bufoff, gbase, (voff)[0], 0); PG8_STAGE1(bufoff, gbase, (voff)[1], 1); } while (0)
#define PG8_STAGE_D(bufoff, gbase, vo, delta) do { PG8_STAGE1(bufoff, gbase, vo, 0); PG8_STAGE1(bufoff, (const char*)(gbase) + (delta), vo, 1); } while (0)
#define PG8_LDA(dst, b, h) do { if constexpr (FP8) { _Pragma("unroll") for (int m = 0; m < 4; ++m) { const LAS v4i* p_ = (const LAS v4i*)((LAS unsigned char*)(size_t)aoffv + PG8_SA(b, h) + m * 2048); dst##8[m] = __builtin_shufflevector(p_[0], p_[64], 0, 1, 2, 3, 4, 5, 6, 7); } } \
        else { _Pragma("unroll") for (int m = 0; m < 4; ++m) _Pragma("unroll") for (int k = 0; k < 2; ++k) dst[m][k] = *(const LAS bf16x8*)((LAS unsigned char*)(size_t)aoffv + PG8_SA(b, h) + m * 2048 + k * 1024); } } while (0)
#define PG8_LDB(dst, b, h) do { if constexpr (FP8) { _Pragma("unroll") for (int n = 0; n < 2; ++n) { const LAS v4i* p_ = (const LAS v4i*)((LAS unsigned char*)(size_t)boffv + (PG8_SB(b, h) - 4 * HTB) + n * 2048); dst##8[n] = __builtin_shufflevector(p_[0], p_[64], 0, 1, 2, 3, 4, 5, 6, 7); } } \
        else { _Pragma("unroll") for (int n = 0; n < 2; ++n) _Pragma("unroll") for (int k = 0; k < 2; ++k) dst[n][k] = *(const LAS bf16x8*)((LAS unsigned char*)(size_t)boffv + (PG8_SB(b, h) - 4 * HTB) + n * 2048 + k * 1024); } } while (0)
#define PG8_MMA(ai, bj, At, Bt) do { __builtin_amdgcn_s_setprio(1); \
        if constexpr (FP8) {   \
            _Pragma("unroll") for (int m = 0; m < 4; ++m) _Pragma("unroll") for (int n = 0; n < 2; ++n) \
                acc[ai][bj][m][n] = __builtin_amdgcn_mfma_scale_f32_16x16x128_f8f6f4(Bt##8[n], At##8[m], acc[ai][bj][m][n], 0, 0, 0, 0, 0, 0); } \
        else { _Pragma("unroll") for (int m = 0; m < 4; ++m) _Pragma("unroll") for (int n = 0; n < 2; ++n) _Pragma("unroll") for (int k = 0; k < 2; ++k) \
            acc[ai][bj][m][n] = __builtin_amdgcn_mfma_f32_16x16x32_bf16(Bt[n][k], At[m][k], acc[ai][bj][m][n], 0, 0, 0); } \
        __builtin_amdgcn_s_setprio(0); } while (0)
#define PG8_WAIT_V(n) asm volatile("s_waitcnt vmcnt(" #n ")" ::: "memory")
#define PG8_WAIT_L(n) asm volatile("s_waitcnt lgkmcnt(" #n ")" ::: "memory")
#define PG8_BAR __builtin_amdgcn_s_barrier()
#define PG8_SCHED __builtin_amdgcn_sched_barrier(0)
    Unit cur, nxt; int ui = 0;
    if (!S.next(0, cur)) return;
    f32x4 acc[2][2][4][2];
#pragma unroll
    for (int a = 0; a < 2; ++a)
#pragma unroll
        for (int b = 0; b < 2; ++b)
#pragma unroll
            for (int m = 0; m < 4; ++m)
#pragma unroll
                for (int n = 0; n < 2; ++n) acc[a][b][m][n] = (f32x4){0.f, 0.f, 0.f, 0.f};
    bf16x8 At[4][2], B0[2][2], B1[2][2]; v8i At8[4], B08[2], B18[2];
    const char* cA = S.a_ptr(cur); const char* cB = S.b_ptr(cur);
    PG8_AVOFF(cur, voffA);
#define PG8_STAGE_A(bufoff, kbase, h, vo) do { if constexpr (GA) { PG8_STAGE(bufoff, kbase, (vo)[h]); } else { PG8_STAGE_D(bufoff, (kbase) + (h) * hstep, voffA[0][0], dA); } } while (0)
    PG8_STAGE_D(PG8_SB(0, 0), cB, voffB[0], dB); PG8_STAGE_D(PG8_SB(0, 1), cB + hstepB, voffB[0], dB); PG8_STAGE_A(PG8_SA(0, 0), cA, 0, voffA); PG8_STAGE_A(PG8_SA(0, 1), cA, 1, voffA);
    if (wr == 1) PG8_BAR;
    PG8_WAIT_V(2); PG8_BAR;
    PG8_STAGE_D(PG8_SB(1, 0), cB + kstepB, voffB[0], dB); PG8_STAGE_A(PG8_SA(1, 0), cA + kstep, 0, voffA); PG8_STAGE_D(PG8_SB(1, 1), cB + hstepB + kstepB, voffB[0], dB);
    PG8_WAIT_V(6); PG8_BAR;
    for (;;) {
        const bool has_next = S.next(ui + 1, nxt);
        const char* nA = has_next ? S.a_ptr(nxt) : cA; const char* nB = has_next ? S.b_ptr(nxt) : cB;
        if constexpr (GA) { if (has_next) PG8_AVOFF(nxt, voffAn);
            else {
#pragma unroll
                for (int h = 0; h < 2; ++h)
#pragma unroll
                    for (int i = 0; i < 2; ++i) voffAn[h][i] = voffA[h][i]; } }
#pragma unroll 1
        for (int t = 0; t < nt; t += 2) {
            const bool last = (t == nt - 2);
            const char* a1 = cA + (size_t)(t + 1) * kstep;
            const char* a2 = last ? nA : cA + (size_t)(t + 2) * kstep; const char* b2 = last ? nB : cB + (size_t)(t + 2) * kstepB;
            const char* a3 = a2 + kstep; const char* b3 = b2 + kstepB;
            PG8_LDB(B0, 0, 0); PG8_LDB(B1, 0, 1); PG8_SCHED; PG8_LDA(At, 0, 0); PG8_STAGE_A(PG8_SA(1, 1), a1, 1, voffA);
            if constexpr (GA) { if (last) {
#pragma unroll
                for (int h = 0; h < 2; ++h)
#pragma unroll
                    for (int i = 0; i < 2; ++i) voffA[h][i] = voffAn[h][i]; } }
            PG8_WAIT_V(8); PG8_WAIT_L(0); PG8_BAR; PG8_MMA(0, 0, At, B0); PG8_MMA(0, 1, At, B1); PG8_BAR; PG8_SCHED;
            PG8_LDA(At, 0, 1); PG8_STAGE_D(PG8_SB(0, 0), b2, voffB[0], dB); PG8_STAGE_D(PG8_SB(0, 1), b2 + hstepB, voffB[0], dB); PG8_STAGE_A(PG8_SA(0, 0), a2, 0, voffA);
            PG8_WAIT_V(8); PG8_WAIT_L(0); PG8_BAR; PG8_MMA(1, 0, At, B0); PG8_MMA(1, 1, At, B1); PG8_BAR; PG8_SCHED;
            PG8_LDB(B0, 1, 0); PG8_LDB(B1, 1, 1); PG8_SCHED; PG8_LDA(At, 1, 0); PG8_STAGE_A(PG8_SA(0, 1), a2, 1, voffA);
            PG8_WAIT_V(8); PG8_WAIT_L(0); PG8_BAR; PG8_MMA(0, 0, At, B0); PG8_MMA(0, 1, At, B1); PG8_BAR; PG8_SCHED;
            PG8_LDA(At, 1, 1); PG8_STAGE_D(PG8_SB(1, 0), b3, voffB[0], dB); PG8_STAGE_D(PG8_SB(1, 1), b3 + hstepB, voffB[0], dB); PG8_STAGE_A(PG8_SA(1, 0), a3, 0, voffA);
            PG8_WAIT_V(8); PG8_WAIT_L(0); PG8_BAR; PG8_MMA(1, 0, At, B0); PG8_MMA(1, 1, At, B1); PG8_BAR; PG8_SCHED;
        }
        if constexpr (ALIGN_EPI) { if (wr == 0) PG8_BAR; }
        { Unit ue = cur; ue.pm = __builtin_amdgcn_readfirstlane(ue.pm); ue.pn = __builtin_amdgcn_readfirstlane(ue.pn); ue.e = __builtin_amdgcn_readfirstlane(ue.e); asm volatile("" : "+s"(ue.pm), "+s"(ue.pn), "+s"(ue.e));
          const int t3_ = fresh_tid(); const int fr_ = t3_ & 15, fq_ = (t3_ & 63) >> 4;
          E(acc, ue, wr, wc, fr_, fq_); }
        if (!has_next) break;
#pragma unroll
        for (int a = 0; a < 2; ++a)
#pragma unroll
            for (int b = 0; b < 2; ++b)
#pragma unroll
                for (int m = 0; m < 4; ++m)
#pragma unroll
                    for (int n = 0; n < 2; ++n) acc[a][b][m][n] = (f32x4){0.f, 0.f, 0.f, 0.f};
        cur = nxt; cA = nA; cB = nB; ++ui;
        if constexpr (ALIGN_EPI) { if (wr == 1) PG8_BAR; }
    }
    PG8_WAIT_V(0);
    if constexpr (!ALIGN_EPI) { if (wr == 0) PG8_BAR; }
    PG8_BAR;
#undef PG8_SA
#undef PG8_SB
#undef PG8_STAGE
#undef PG8_STAGE1
#undef PG8_STAGE_D
#undef PG8_STAGE_A
#undef PG8_AVOFF
#undef PG8_LDA
#undef PG8_LDB
#undef PG8_MMA
#undef PG8_WAIT_V
#undef PG8_WAIT_L
#undef PG8_BAR
#undef PG8_SCHED
}
}
using pg8::Unit;
using pg8::cvt_pk_bf16;

DI float bflo(unsigned w) { return __uint_as_float(w << 16); }
DI float bfhi(unsigned w) { return __uint_as_float(w & 0xffff0000u); }
DI float bf2f(bf16 b) { return __uint_as_float(((unsigned)b) << 16); }
typedef __bf16 hwbf2 __attribute__((ext_vector_type(2)));
DI unsigned pk2(float lo, float hi) { const f32x2 v = {lo, hi}; return __builtin_bit_cast(unsigned, __builtin_convertvector(v, hwbf2)); }
DI unsigned f2bf(float f) { return pk2(f, 0.f) & 0xffffu; }
DI float rcp_f(float x) { return __builtin_amdgcn_rcpf(x); }
DI float rsq_f(float x) { return __builtin_amdgcn_rsqf(x); }
DI float sigmoid_f(float x) { return rcp_f(1.0f + __expf(-x)); }
DI float tanh_fast(float x) { return 1.0f - 2.0f * rcp_f(__expf(2.0f * x) + 1.0f); }
DI float softplus_f(float x) { return fmaxf(x, 0.f) + __logf(1.0f + __expf(-fabsf(x))); }
DI float softplus_fast(float x) { return fmaxf(x, 0.f) + __logf(1.0f + __expf(-fabsf(x))); }
DI float gelu_tanh_f(float x) { const float u = 0.7978845608028654f * (x + 0.044715f * x * x * x); return 0.5f * x * (1.0f + tanh_fast(u)); }
DI float wave_sum(float v) {
#pragma unroll
    for (int o = 1; o < 64; o <<= 1) v += __shfl_xor(v, o);
    return v;
}

DI unsigned pk4_fp8(float a, float b, float c, float d) { int w = 0; w = __builtin_amdgcn_cvt_pk_fp8_f32(a, b, w, false); w = __builtin_amdgcn_cvt_pk_fp8_f32(c, d, w, true); return (unsigned)w; }
struct EpiBf16Plain {
    static constexpr bool PERM = true;
    bf16* O; int ldc; float scale;
    DI void operator()(const f32x4 (&acc)[2][2][4][2], const Unit& u, int wr, int wc, int fr, int fq) const {
        const int row0 = u.pm * 256 + wr * 64 + fr, col0 = u.pn * 256 + wc * 32 + 8 * fq;
#pragma unroll
        for (int ai = 0; ai < 2; ++ai)
#pragma unroll
            for (int m = 0; m < 4; ++m) { bf16* rowp = O + (size_t)(row0 + ai * 128 + m * 16) * ldc + col0;
#pragma unroll
                for (int bj = 0; bj < 2; ++bj) { const f32x4 v0 = acc[ai][bj][m][0] * scale, v1 = acc[ai][bj][m][1] * scale;
                    u32x4 w; w.x = cvt_pk_bf16(v0[0], v0[1]); w.y = cvt_pk_bf16(v0[2], v0[3]); w.z = cvt_pk_bf16(v1[0], v1[1]); w.w = cvt_pk_bf16(v1[2], v1[3]);
                    *(u32x4*)(rowp + bj * 128) = w; } }
    }
};
template <int MODE> struct EpiFold {
    static constexpr bool PERM = true;
    bf16* O;
    DI void operator()(const f32x4 (&acc)[2][2][4][2], const Unit& u, int wr, int wc, int fr, int fq) const {
        const int b = u.pm >> 2, h = u.pm & 3;
        const int rbase = MODE == 0 ? h * 256 : u.pn * 256, cbase = MODE == 0 ? u.pn * 256 : h * 256;
        const unsigned boff = (unsigned)b * 1024u * 1024u + (unsigned)(rbase + wr * 64 + fr) * 1024u + (unsigned)(cbase + wc * 32 + 8 * fq);
#pragma unroll
        for (int ai = 0; ai < 2; ++ai)
#pragma unroll
            for (int m = 0; m < 4; ++m) { bf16* rowp = O + (boff + (unsigned)(ai * 128 + m * 16) * 1024u);
#pragma unroll
                for (int bj = 0; bj < 2; ++bj) { const f32x4 v0 = acc[ai][bj][m][0], v1 = acc[ai][bj][m][1];
                    u32x4 w; w.x = cvt_pk_bf16(v0[0], v0[1]); w.y = cvt_pk_bf16(v0[2], v0[3]); w.z = cvt_pk_bf16(v1[0], v1[1]); w.w = cvt_pk_bf16(v1[2], v1[3]);
                    *(u32x4*)(rowp + bj * 128) = w; } }
    }
};
struct EpiSoftmax {
    static constexpr bool PERM = true;
    bf16* O; float scale; const float* RS; LAS float* XM; LAS float* XS;
    DI void operator()(const f32x4 (&acc)[2][2][4][2], const Unit& u, int wr, int wc, int fr, int fq) const {
        const int row0 = u.pm * 256 + wr * 64 + fr, col0 = u.pn * 256 + wc * 32 + 8 * fq;
        float sc[2][4];
#pragma unroll
        for (int ai = 0; ai < 2; ++ai)
#pragma unroll
            for (int m = 0; m < 4; ++m) { const int r = row0 + ai * 128 + m * 16; const f32x4* rp = (const f32x4*)(RS + (size_t)r * 16);
                const f32x4 p0 = rp[0], p1 = rp[1], p2 = rp[2], p3 = rp[3];
                const float ss = ((p0[0] + p0[1]) + (p0[2] + p0[3])) + ((p1[0] + p1[1]) + (p1[2] + p1[3])) + ((p2[0] + p2[1]) + (p2[2] + p2[3])) + ((p3[0] + p3[1]) + (p3[2] + p3[3]));
                sc[ai][m] = scale * __builtin_amdgcn_rsqf(ss * (1.0f / 1024.0f) + 1e-6f);
                float mm = -3.0e38f;
#pragma unroll
                for (int bj = 0; bj < 2; ++bj)
#pragma unroll
                    for (int n = 0; n < 2; ++n) { const f32x4 v = acc[ai][bj][m][n]; mm = fmaxf(mm, fmaxf(fmaxf(v[0], v[1]), fmaxf(v[2], v[3]))); }
                mm *= sc[ai][m];
                mm = fmaxf(mm, __shfl_xor(mm, 16)); mm = fmaxf(mm, __shfl_xor(mm, 32));
                if (fq == 0) XM[(ai * 128 + wr * 64 + m * 16 + fr) * 4 + wc] = mm; }
        asm volatile("s_waitcnt lgkmcnt(0)" ::: "memory"); __builtin_amdgcn_s_barrier(); asm volatile("" ::: "memory");
        f32x4 (&pa)[2][2][4][2] = const_cast<f32x4 (&)[2][2][4][2]>(acc);
#pragma unroll
        for (int ai = 0; ai < 2; ++ai)
#pragma unroll
            for (int m = 0; m < 4; ++m) { const int lr = ai * 128 + wr * 64 + m * 16 + fr; const f32x4 q = *(const LAS f32x4*)(XM + lr * 4);
                const float mxr = fmaxf(fmaxf(q[0], q[1]), fmaxf(q[2], q[3])); float sm = 0.f;
#pragma unroll
                for (int bj = 0; bj < 2; ++bj)
#pragma unroll
                    for (int n = 0; n < 2; ++n)
#pragma unroll
                        for (int j = 0; j < 4; ++j) { const float p = __expf(acc[ai][bj][m][n][j] * sc[ai][m] - mxr); pa[ai][bj][m][n][j] = p; sm += p; }
                sm += __shfl_xor(sm, 16); sm += __shfl_xor(sm, 32);
                if (fq == 0) XS[lr * 4 + wc] = sm; }
        asm volatile("s_waitcnt lgkmcnt(0)" ::: "memory"); __builtin_amdgcn_s_barrier(); asm volatile("" ::: "memory");
#pragma unroll
        for (int ai = 0; ai < 2; ++ai)
#pragma unroll
            for (int m = 0; m < 4; ++m) { const int lr = ai * 128 + wr * 64 + m * 16 + fr; const f32x4 q = *(const LAS f32x4*)(XS + lr * 4);
                const float inv = __builtin_amdgcn_rcpf((q[0] + q[1]) + (q[2] + q[3]));
                bf16* rowp = O + (size_t)(row0 + ai * 128 + m * 16) * 1024 + col0;
#pragma unroll
                for (int bj = 0; bj < 2; ++bj) { const f32x4 v0 = pa[ai][bj][m][0] * inv, v1 = pa[ai][bj][m][1] * inv;
                    u32x4 w; w.x = cvt_pk_bf16(v0[0], v0[1]); w.y = cvt_pk_bf16(v0[2], v0[3]); w.z = cvt_pk_bf16(v1[0], v1[1]); w.w = cvt_pk_bf16(v1[2], v1[3]);
                    *(u32x4*)(rowp + bj * 128) = w; } }
        asm volatile("s_waitcnt lgkmcnt(0)" ::: "memory"); __builtin_amdgcn_s_barrier(); asm volatile("" ::: "memory");
    }
};
struct EpiBf16RowNorm {
    static constexpr bool PERM = true;
    bf16* O; int ldc; float scale; const float* RS;
    DI void operator()(const f32x4 (&acc)[2][2][4][2], const Unit& u, int wr, int wc, int fr, int fq) const {
        const int row0 = u.pm * 256 + wr * 64 + fr, col0 = u.pn * 256 + wc * 32 + 8 * fq;
#pragma unroll
        for (int ai = 0; ai < 2; ++ai)
#pragma unroll
            for (int m = 0; m < 4; ++m) { const int r = row0 + ai * 128 + m * 16; const f32x4* rp = (const f32x4*)(RS + (size_t)r * 16);
                const f32x4 p0 = rp[0], p1 = rp[1], p2 = rp[2], p3 = rp[3];
                const float ss = ((p0[0] + p0[1]) + (p0[2] + p0[3])) + ((p1[0] + p1[1]) + (p1[2] + p1[3])) + ((p2[0] + p2[1]) + (p2[2] + p2[3])) + ((p3[0] + p3[1]) + (p3[2] + p3[3]));
                const float sc = scale * __builtin_amdgcn_rsqf(ss * (1.0f / 1024.0f) + 1e-6f);
                bf16* rowp = O + (size_t)r * ldc + col0;
#pragma unroll
                for (int bj = 0; bj < 2; ++bj) { const f32x4 v0 = acc[ai][bj][m][0] * sc, v1 = acc[ai][bj][m][1] * sc;
                    u32x4 w; w.x = cvt_pk_bf16(v0[0], v0[1]); w.y = cvt_pk_bf16(v0[2], v0[3]); w.z = cvt_pk_bf16(v1[0], v1[1]); w.w = cvt_pk_bf16(v1[2], v1[3]);
                    *(u32x4*)(rowp + bj * 128) = w; } }
    }
};
template <bool RES_BF16> struct EpiBf16Res {
    static constexpr bool PERM = true;
    const void* Rz; bf16* O; int ldc; float* RS;
    DI void operator()(const f32x4 (&acc)[2][2][4][2], const Unit& u, int wr, int wc, int fr, int fq) const {
        const int row0 = u.pm * 256 + wr * 64 + fr, col0 = u.pn * 256 + wc * 32 + 8 * fq;
#pragma unroll
        for (int ai = 0; ai < 2; ++ai) {
            u32x4 rwb[4][2]; f32x4 rf0[4][2], rf1[4][2];
#pragma unroll
            for (int m = 0; m < 4; ++m) { const size_t off = (size_t)(row0 + ai * 128 + m * 16) * ldc + col0;
#pragma unroll
                for (int bj = 0; bj < 2; ++bj) {
                    if (RES_BF16) rwb[m][bj] = *(const u32x4*)((const bf16*)Rz + off + bj * 128);
                    else { rf0[m][bj] = *(const f32x4*)((const float*)Rz + off + bj * 128); rf1[m][bj] = *(const f32x4*)((const float*)Rz + off + bj * 128 + 4); } } }
#pragma unroll
            for (int m = 0; m < 4; ++m) { const size_t off = (size_t)(row0 + ai * 128 + m * 16) * ldc + col0; float ssq = 0.f;
#pragma unroll
                for (int bj = 0; bj < 2; ++bj) { f32x4 r0, r1;
                    if (RES_BF16) { const u32x4 rw = rwb[m][bj]; r0 = (f32x4){bflo(rw.x), bfhi(rw.x), bflo(rw.y), bfhi(rw.y)}; r1 = (f32x4){bflo(rw.z), bfhi(rw.z), bflo(rw.w), bfhi(rw.w)}; }
                    else { r0 = rf0[m][bj]; r1 = rf1[m][bj]; }
                    const f32x4 v0 = r0 + acc[ai][bj][m][0], v1 = r1 + acc[ai][bj][m][1];
                    ssq += (v0[0] * v0[0] + v0[1] * v0[1]) + (v0[2] * v0[2] + v0[3] * v0[3]) + (v1[0] * v1[0] + v1[1] * v1[1]) + (v1[2] * v1[2] + v1[3] * v1[3]);
                    u32x4 w; w.x = cvt_pk_bf16(v0[0], v0[1]); w.y = cvt_pk_bf16(v0[2], v0[3]); w.z = cvt_pk_bf16(v1[0], v1[1]); w.w = cvt_pk_bf16(v1[2], v1[3]);
                    *(u32x4*)(O + off + bj * 128) = w; }
                if (RS) { ssq += __shfl_xor(ssq, 16); ssq += __shfl_xor(ssq, 32); if (fq == 0) RS[(size_t)(row0 + ai * 128 + m * 16) * 16 + u.pn * 4 + wc] = ssq; } } }
    }
};
struct EpiLora {
    static constexpr bool PERM = false;
    float* LWp; bf16* AAp; bf16* GGp; const float* w0; const float* a0;
    DI void operator()(const f32x4 (&acc)[2][2][4][2], const Unit& u, int wr, int wc, int fr, int fq) const {
        const int kind = u.pn >> 1;
        const int row0 = u.pm * 256 + wr * 64 + fr, col0 = (u.pn & 1) * 256 + wc * 32 + 4 * fq;
#pragma unroll
        for (int bj = 0; bj < 2; ++bj)
#pragma unroll
            for (int n = 0; n < 2; ++n) {
                const int c = col0 + bj * 128 + n * 16;
                f32x4 bias = (f32x4){0.f, 0.f, 0.f, 0.f};
                if (kind == 0) bias = *(const f32x4*)(w0 + c); else if (kind == 1) bias = *(const f32x4*)(a0 + c);
#pragma unroll
                for (int ai = 0; ai < 2; ++ai)
#pragma unroll
                    for (int m = 0; m < 4; ++m) {
                        f32x4 v = acc[ai][bj][m][n] + bias;
                        if (kind == 0) {
#pragma unroll
                            for (int j = 0; j < 4; ++j) { const float w = -softplus_fast(-v[j]) - 0.5f; v[j] = -__expf(w);     }
                        } else if (kind == 1) {
#pragma unroll
                            for (int j = 0; j < 4; ++j) v[j] = sigmoid_f(v[j]);
                        }
                        const size_t o_ = (size_t)(row0 + ai * 128 + m * 16) * 512 + c;
                        if (kind == 0) *(f32x4*)(LWp + o_) = v;
                        else { u32x2 w_; w_.x = cvt_pk_bf16(v[0], v[1]); w_.y = cvt_pk_bf16(v[2], v[3]); *(u32x2*)((kind == 1 ? AAp : GGp) + o_) = w_; }
                    }
            }
    }
};
struct EpiSwiglu {
    static constexpr bool PERM = true;
    bf16* ACT; const float* b_gu;
    DI void operator()(const f32x4 (&acc)[2][2][4][2], const Unit& u, int wr, int wc, int fr, int fq) const {
        const int row0 = u.pm * 256 + wr * 64 + fr, j0 = u.pn * 128 + wc * 32 + 8 * fq;
        const float* bg = b_gu + (size_t)u.e * 2048 + j0; const float* bu = bg + 1024;
        const f32x4 bg0 = *(const f32x4*)bg, bg1 = *(const f32x4*)(bg + 4), bu0 = *(const f32x4*)bu, bu1 = *(const f32x4*)(bu + 4);
#pragma unroll
        for (int ai = 0; ai < 2; ++ai)
#pragma unroll
            for (int m = 0; m < 4; ++m) {
                float o[8];
#pragma unroll
                for (int n = 0; n < 2; ++n) { const f32x4 g4 = acc[ai][0][m][n] * 0.015625f + (n ? bg1 : bg0), u4 = acc[ai][1][m][n] * 0.015625f + (n ? bu1 : bu0);
#pragma unroll
                    for (int j = 0; j < 4; ++j) { const float g = fminf(g4[j], 7.0f), up = fminf(fmaxf(u4[j], -7.0f), 7.0f); o[n * 4 + j] = (up + 1.0f) * (g * sigmoid_f(1.702f * g)); } }
                u32x2 w; w.x = pk4_fp8(o[0], o[1], o[2], o[3]); w.y = pk4_fp8(o[4], o[5], o[6], o[7]);
                *(u32x2*)((unsigned char*)ACT + (size_t)(row0 + ai * 128 + m * 16) * 1024 + j0) = w;
            }
    }
};
struct EpiDown {
    static constexpr bool PERM = true;
    bf16* YS; const float* b_dn; const u32x2* row_sg;
    DI void operator()(const f32x4 (&acc)[2][2][4][2], const Unit& u, int wr, int wc, int fr, int fq) const {
        const int row0 = u.pm * 256 + wr * 64 + fr, col0 = u.pn * 256 + wc * 32 + 8 * fq;
        const float* bb = b_dn + (size_t)u.e * 1024 + col0;
        f32x4 bv[2][2];
#pragma unroll
        for (int bj = 0; bj < 2; ++bj)
#pragma unroll
            for (int n = 0; n < 2; ++n) bv[bj][n] = *(const f32x4*)(bb + bj * 128 + 4 * n);
        int slots[8]; float gts[8];
        { const u32x2* sgp = row_sg + row0;
#pragma unroll
        for (int q = 0; q < 8; ++q) { const u32x2 sg = sgp[(q >> 2) * 128 + (q & 3) * 16]; slots[q] = (int)sg.x; gts[q] = __uint_as_float(sg.y); } }
#pragma unroll
        for (int ai = 0; ai < 2; ++ai)
#pragma unroll
            for (int m = 0; m < 4; ++m) {
                const int slot = slots[ai * 4 + m]; const float gt = gts[ai * 4 + m];
                if (slot >= 0) { bf16* rowp = YS + (size_t)slot * 1024 + col0;
#pragma unroll
                    for (int bj = 0; bj < 2; ++bj) { const f32x4 v0 = (acc[ai][bj][m][0] * 0.015625f + bv[bj][0]) * gt, v1 = (acc[ai][bj][m][1] * 0.015625f + bv[bj][1]) * gt;
                        u32x4 w; w.x = cvt_pk_bf16(v0[0], v0[1]); w.y = cvt_pk_bf16(v0[2], v0[3]); w.z = cvt_pk_bf16(v1[0], v1[1]); w.w = cvt_pk_bf16(v1[2], v1[3]);
                        *(u32x4*)(rowp + bj * 128) = w; } }
            }
    }
};

constexpr size_t MiB = 1u << 20;
constexpr size_t WS_CTL = 0, CTL_ZERO_BYTES = 1 * MiB;
constexpr size_t WS_WIN = 1 * MiB, WS_WOUT = 7 * MiB, WS_WQ = 9 * MiB, WS_WK = 11 * MiB, WS_WV = 13 * MiB, WS_WO = 15 * MiB, WS_LORAB = 17 * MiB, WS_LRUW = 18 * MiB;
constexpr size_t WS_ROUTE = 19 * MiB;
constexpr size_t WS_WGU = 22 * MiB, WS_WDN = 150 * MiB;
constexpr size_t WS_HN = 214 * MiB, WS_MEMN = 246 * MiB, WS_KM = 248 * MiB, WS_VT = 250 * MiB;
constexpr size_t WS_X1 = 252 * MiB, WS_X2 = 316 * MiB;
constexpr size_t WS_U = 380 * MiB, WS_R = 468 * MiB, WS_KRAW = 500 * MiB, WS_V = 532 * MiB, WS_KKN = 564 * MiB, WS_WD = 596 * MiB, WS_AA = 628 * MiB, WS_G = 660 * MiB;
constexpr size_t WS_LA = 692 * MiB, WS_LB = 724 * MiB, WS_AP = 756 * MiB, WS_CAT = 764 * MiB, WS_Q = 796 * MiB;
constexpr size_t WS_XS = 380 * MiB, WS_ACT = 524 * MiB, WS_YS = 668 * MiB;
constexpr size_t WS_GP = 796 * MiB, WS_HF = 860 * MiB, WS_RP = 924 * MiB, WS_Y1F = 940 * MiB, WS_ADD = 972 * MiB, WS_END = 1004 * MiB;
constexpr size_t WS_GC = 468 * MiB, WS_HC = 484 * MiB, WS_ZS = 500 * MiB;
static_assert(WS_AA == WS_WD + 32 * MiB && WS_G == WS_AA + 32 * MiB, "EpiLora strides");
static_assert(WS_U + (size_t)M * INW * 2 <= WS_R && WS_XS + (size_t)MAXROWS * 2048 <= WS_ACT && WS_ACT + (size_t)MAXROWS * 2048 <= WS_YS && WS_YS + (size_t)NASSIGN * 2048 <= WS_Q, "ws map");
constexpr size_t RT_E = 0, RT_POS = 256 * 1024, RT_G = 512 * 1024, RT_SLOT = 768 * 1024, RT_GATE = 1088 * 1024, RT_TILE = 1408 * 1024, RT_TOK = 1472 * 1024, RT_UGU = 1792 * 1024, RT_UDN = 1808 * 1024;
constexpr int CW_BAR = 4096, CW_CNT = 8192, CW_CONV = 12288;

constexpr int RING_BYTES = 131072, MISC_OFF = RING_BYTES + 320, LDS_BYTES = 147456;
constexpr int NWAVES = 8, NTHREADS = 512;
constexpr int CONV_P9 = 0;

#define XB_TMO      128
#define XB_XCNT(j)  (256  + 64 * (j))
#define XB_XSUB(j)  (1280 + 64 * (j))
#define XB_XGEN(j)  (2304 + 64 * (j))
#define XB_TOP      3328
#define XB_TOPGEN   3392
#define XCD_BAR_WORDS 3456
#define XB_SPIN_CAP (1u << 18)
DI unsigned xb_ld(unsigned* p)              { return __hip_atomic_load(p, __ATOMIC_RELAXED, __HIP_MEMORY_SCOPE_AGENT); }
DI unsigned xb_add(unsigned* p, unsigned v) { return __hip_atomic_fetch_add(p, v, __ATOMIC_RELAXED, __HIP_MEMORY_SCOPE_AGENT); }
DI unsigned xb_xcc_id() { return (unsigned)__builtin_amdgcn_s_getreg((3 << 11) | 20) & 0xFu; }
#define XB_SPIN(cond, bar) do { unsigned _sp = 0; while (cond) { __builtin_amdgcn_s_sleep(1); \
    if ((++_sp & 255u) == 0u) { if (xb_ld(&(bar)[XB_TMO])) break; if (_sp > XB_SPIN_CAP) { atomicAdd(&(bar)[XB_TMO], 1u); break; } } } } while (0)
struct XcdBarrier { unsigned* bar; unsigned x; volatile LAS unsigned* st; int w0; };
DI XcdBarrier xcd_barrier_post(unsigned* bar, volatile LAS unsigned* st, int w0) {
    XcdBarrier b; b.bar = bar; b.x = xb_xcc_id(); b.st = st; b.w0 = w0;
    if (fresh_tid_(w0) == 0) (void)xb_add(&bar[XB_XCNT(b.x)], 1u);
    return b;
}
DI void xcd_barrier_complete(unsigned* bar, unsigned x, unsigned& nloc, unsigned& nx) {
    const unsigned G = gridDim.x * gridDim.y * gridDim.z;
    unsigned sum, cnt, mine, sp = 0u;
    for (;;) {
        sum = 0u; cnt = 0u; mine = 0u;
#pragma unroll
        for (unsigned j = 0; j < 16; ++j) { const unsigned c = xb_ld(&bar[XB_XCNT(j)]); sum += c; cnt += (c > 0u) ? 1u : 0u; mine = (j == x) ? c : mine; }
        if (sum == G) break;
        __builtin_amdgcn_s_sleep(1);
        if ((++sp & 255u) == 0u) { if (xb_ld(&bar[XB_TMO])) break; if (sp > XB_SPIN_CAP) { atomicAdd(&bar[XB_TMO], 1u); break; } }
    }
    nloc = mine > 0u ? mine : 1u; nx = cnt > 0u ? cnt : 1u;
}
DI void xcd_barrier(const XcdBarrier& b) {
    asm volatile("s_waitcnt vmcnt(0)" ::: "memory");
    __syncthreads();
    if (fresh_tid_(b.w0) == 0) {
        unsigned* bar = b.bar;
        __builtin_amdgcn_s_waitcnt(0);
        unsigned nloc = b.st[0], nx = b.st[1];
        if (nloc == 0u) { xcd_barrier_complete(bar, b.x, nloc, nx); b.st[0] = nloc; b.st[1] = nx; }
        const unsigned old = xb_add(&bar[XB_XSUB(b.x)], 1u);
        const unsigned gen = old / nloc;
        if (old + 1u == (gen + 1u) * nloc) {
            __builtin_amdgcn_fence(__ATOMIC_RELEASE, "agent");
            asm volatile("s_waitcnt vmcnt(0)" ::: "memory");
            const unsigned og = xb_add(&bar[XB_TOP], 1u);
            const unsigned tg = og / nx;
            if (og + 1u == (tg + 1u) * nx) xb_add(&bar[XB_TOPGEN], 1u);
            else XB_SPIN(xb_ld(&bar[XB_TOPGEN]) == tg, bar);
            __builtin_amdgcn_fence(__ATOMIC_ACQUIRE, "agent");
            xb_add(&bar[XB_XGEN(b.x)], 1u);
            asm volatile("s_waitcnt vmcnt(0)" ::: "memory");
        } else {
            XB_SPIN(xb_ld(&bar[XB_XGEN(b.x)]) == gen, bar);
            __builtin_amdgcn_fence(__ATOMIC_ACQUIRE, "agent");
            asm volatile("s_waitcnt vmcnt(0)" ::: "memory");
        }
    }
    __syncthreads();
}

struct Args { const float* in[37]; float* out; unsigned char* ws; int ph_lo, ph_hi; };
enum { I_X = 0, I_MEM, I_NMIXG, I_WIN, I_CONVW, I_CONVB, I_LWX, I_LBX, I_LWA, I_LBA, I_LAM, I_MU, I_W0, I_WUP, I_A0, I_AUP, I_GUP, I_KK, I_KA, I_RK, I_LNG, I_LNB,
       I_WOUT, I_NXAG, I_NMEMG, I_WQ, I_WK, I_WV, I_WO, I_NFFG, I_WR, I_BR, I_WGU, I_BGU, I_WDN, I_BDN, I_FNG };

DI void transpose_item(const float* W, int ldw, int K, bf16* WT, int k0, int n0, int drow0, LAS float* scr, int lane, const float* rs = nullptr) {
    f32x4 t[8];
    const float* src = W + (size_t)(k0 + (lane >> 3)) * ldw + n0 + 4 * (lane & 7);
#pragma unroll
    for (int i = 0; i < 8; ++i) t[i] = *(const f32x4*)(src + (size_t)(8 * i) * ldw);
#pragma unroll
    for (int i = 0; i < 8; ++i) { const float sc_ = rs ? rs[k0 + 8 * i + (lane >> 3)] : 1.0f; LAS float* d = scr + (8 * i + (lane >> 3)) * 33 + 4 * (lane & 7); d[0] = t[i].x * sc_; d[1] = t[i].y * sc_; d[2] = t[i].z * sc_; d[3] = t[i].w * sc_; }
    asm volatile("s_waitcnt lgkmcnt(0)" ::: "memory");
    const int c = lane & 7;
#pragma unroll
    for (int j = 0; j < 4; ++j) { const int n = (lane >> 3) + 8 * j; const LAS float* s = scr + (8 * c) * 33 + n;
        u32x4 o; o.x = pk2(s[0 * 33], s[1 * 33]); o.y = pk2(s[2 * 33], s[3 * 33]); o.z = pk2(s[4 * 33], s[5 * 33]); o.w = pk2(s[6 * 33], s[7 * 33]);
        *(u32x4*)(WT + (size_t)(drow0 + n) * K + k0 + 8 * c) = o; }
    asm volatile("s_waitcnt lgkmcnt(0)" ::: "memory");
}
DI void transpose_item_tiled(const float* W, int ldw, int K, bf16* WTe, int k0, int n0, int drow0, LAS float* scr, int lane) {
    f32x4 t[8];
    const float* src = W + (size_t)(k0 + (lane >> 3)) * ldw + n0 + 4 * (lane & 7);
#pragma unroll
    for (int i = 0; i < 8; ++i) t[i] = *(const f32x4*)(src + (size_t)(8 * i) * ldw);
#pragma unroll
    for (int i = 0; i < 8; ++i) { LAS float* d = scr + (8 * i + (lane >> 3)) * 33 + 4 * (lane & 7); d[0] = t[i].x; d[1] = t[i].y; d[2] = t[i].z; d[3] = t[i].w; }
    asm volatile("s_waitcnt lgkmcnt(0)" ::: "memory");
    const int c = lane & 7;
#pragma unroll
    for (int j = 0; j < 4; ++j) { const int n = (lane >> 3) + 8 * j; const LAS float* s = scr + (8 * c) * 33 + n;
        u32x4 o; o.x = pk2(s[0 * 33], s[1 * 33]); o.y = pk2(s[2 * 33], s[3 * 33]); o.z = pk2(s[4 * 33], s[5 * 33]); o.w = pk2(s[6 * 33], s[7 * 33]);
        const int drow = drow0 + n, pn = drow >> 8, half = (drow >> 7) & 1, r = drow & 127, x = r & 31;
        const int rslot = (r & ~31) + 16 * ((x >> 2) & 1) + 4 * (x >> 3) + (x & 3);
        const size_t tb = ((size_t)(pn * (K / 64) + (k0 >> 6)) * 2 + half) * 16384 + pg8::lds_byte(rslot, 8 * c);
        *(u32x4*)((char*)WTe + tb) = o; }
    asm volatile("s_waitcnt lgkmcnt(0)" ::: "memory");
}
DI void transpose_item_tiled_nolds(const float* W, int ldw, int K, bf16* WTe, int k0, int n0, int drow0, int lane) {
    const int n = lane & 31, kh = lane >> 5;
    const float* src = W + (size_t)(k0 + 32 * kh) * ldw + n0 + n;
    float t[32];
#pragma unroll
    for (int i = 0; i < 32; ++i) t[i] = src[(size_t)i * ldw];
    const int drow = drow0 + n, pn = drow >> 8, half = (drow >> 7) & 1, r = drow & 127, x = r & 31;
    const int rslot = (r & ~31) + 16 * ((x >> 2) & 1) + 4 * (x >> 3) + (x & 3);
    const size_t tb0 = ((size_t)(pn * (K / 64) + (k0 >> 6)) * 2 + half) * 16384;
#pragma unroll
    for (int c = 0; c < 4; ++c) { u32x4 o; o.x = pk2(t[8 * c], t[8 * c + 1]); o.y = pk2(t[8 * c + 2], t[8 * c + 3]); o.z = pk2(t[8 * c + 4], t[8 * c + 5]); o.w = pk2(t[8 * c + 6], t[8 * c + 7]);
        *(u32x4*)((char*)WTe + tb0 + pg8::lds_byte(rslot, 32 * kh + 8 * c)) = o; }
}
DI void transpose_item_tiled_fp8(const float* W, int ldw, int K, unsigned char* WTe, int k0, int n0, int drow0, LAS float* scr, int lane) {
    f32x4 t[8];
    const float* src = W + (size_t)(k0 + (lane >> 3)) * ldw + n0 + 4 * (lane & 7);
#pragma unroll
    for (int i = 0; i < 8; ++i) t[i] = *(const f32x4*)(src + (size_t)(8 * i) * ldw);
#pragma unroll
    for (int i = 0; i < 8; ++i) { LAS float* d = scr + (8 * i + (lane >> 3)) * 33 + 4 * (lane & 7); d[0] = t[i].x * 64.f; d[1] = t[i].y * 64.f; d[2] = t[i].z * 64.f; d[3] = t[i].w * 64.f; }
    asm volatile("s_waitcnt lgkmcnt(0)" ::: "memory");
    const int c = lane & 3;
#pragma unroll
    for (int j = 0; j < 2; ++j) { const int n = (lane >> 2) + 16 * j; const LAS float* sp = scr + (16 * c) * 33 + n;
        u32x4 o; o.x = pk4_fp8(sp[0 * 33], sp[1 * 33], sp[2 * 33], sp[3 * 33]); o.y = pk4_fp8(sp[4 * 33], sp[5 * 33], sp[6 * 33], sp[7 * 33]);
        o.z = pk4_fp8(sp[8 * 33], sp[9 * 33], sp[10 * 33], sp[11 * 33]); o.w = pk4_fp8(sp[12 * 33], sp[13 * 33], sp[14 * 33], sp[15 * 33]);
        const int drow = drow0 + n, pn = drow >> 8, half = (drow >> 7) & 1, r = drow & 127, x = r & 31;
        const int rslot = (r & ~31) + 16 * ((x >> 2) & 1) + 4 * (x >> 3) + (x & 3);
        const int bc = (k0 & 64) + 16 * c;
        const size_t tb = ((size_t)(pn * (K / 128) + (k0 >> 7)) * 2 + half) * 16384 + pg8::lds_byte(rslot, bc >> 1);
        *(u32x4*)(WTe + tb) = o; }
    asm volatile("s_waitcnt lgkmcnt(0)" ::: "memory");
}
DI void rms_row_to_bf16(const float* xrow, const float* g, bf16* orow, int lane) {
    const f32x4* xr = (const f32x4*)xrow + lane; const f32x4* gr = (const f32x4*)g + lane;
    f32x4 v[4]; float s = 0.f;
#pragma unroll
    for (int j = 0; j < 4; ++j) { v[j] = xr[64 * j]; s += (v[j].x * v[j].x + v[j].y * v[j].y) + (v[j].z * v[j].z + v[j].w * v[j].w); }
    const float rstd = rsq_f(wave_sum(s) * (1.f / D) + EPS);
    u32x2* o8 = (u32x2*)orow + lane;
#pragma unroll
    for (int j = 0; j < 4; ++j) { const f32x4 gg = gr[64 * j]; u32x2 w; w.x = pk2(v[j].x * rstd * gg.x, v[j].y * rstd * gg.y); w.y = pk2(v[j].z * rstd * gg.z, v[j].w * rstd * gg.w); o8[64 * j] = w; }
}

DI void rms_rowbf_to_bf16(const bf16* xrow, const float* g, bf16* orow, int lane) {
    float v[16]; float s = 0.f;
#pragma unroll
    for (int hf = 0; hf < 2; ++hf) { const u32x4 w = *(const u32x4*)(xrow + 512 * hf + 8 * lane);
#pragma unroll
        for (int q = 0; q < 4; ++q) { v[8 * hf + 2 * q] = bflo(w[q]); v[8 * hf + 2 * q + 1] = bfhi(w[q]); } }
#pragma unroll
    for (int j = 0; j < 16; ++j) s += v[j] * v[j];
    const float rstd = rsq_f(wave_sum(s) * (1.f / D) + EPS);
#pragma unroll
    for (int hf = 0; hf < 2; ++hf) { const f32x4 g0 = *(const f32x4*)(g + 512 * hf + 8 * lane), g1 = *(const f32x4*)(g + 512 * hf + 8 * lane + 4);
        u32x4 w; w.x = pk2(v[8 * hf] * rstd * g0.x, v[8 * hf + 1] * rstd * g0.y); w.y = pk2(v[8 * hf + 2] * rstd * g0.z, v[8 * hf + 3] * rstd * g0.w);
        w.z = pk2(v[8 * hf + 4] * rstd * g1.x, v[8 * hf + 5] * rstd * g1.y); w.w = pk2(v[8 * hf + 6] * rstd * g1.z, v[8 * hf + 7] * rstd * g1.w);
        *(u32x4*)(orow + 512 * hf + 8 * lane) = w; }
}

__global__ void __launch_bounds__(NTHREADS, 2) fwd(Args args) {
    extern __shared__ __attribute__((aligned(16))) unsigned char lds_raw[];
    LAS unsigned char* lds = (LAS unsigned char*)lds_raw;
    volatile LAS unsigned* MISC = (volatile LAS unsigned*)(lds + MISC_OFF);
    const int G = gridDim.x, bid = blockIdx.x, NGW = G * NWAVES;
    const int wv0 = __builtin_amdgcn_readfirstlane((int)(threadIdx.x >> 6));
#define PHASE_IDS const int tid = fresh_tid(), lane = tid & 63, wave = __builtin_amdgcn_readfirstlane(tid >> 6), gw = bid * NWAVES + wave; (void)tid; (void)lane; (void)wave; (void)gw
    unsigned char* ws = args.ws;
    unsigned* ctl = (unsigned*)(ws + WS_CTL);
    const int lo = args.ph_lo, hi = args.ph_hi;

    for (int u = fresh_tid(); u < (LDS_BYTES - RING_BYTES) / 4; u += NTHREADS) ((LAS unsigned*)(lds + RING_BYTES))[u] = 0u;
    __syncthreads();
    XcdBarrier bar; bar.bar = ctl + CW_BAR; bar.x = 0; bar.st = nullptr; bar.w0 = wv0;
    if (hi - lo > 1) bar = xcd_barrier_post(ctl + CW_BAR, MISC + 8, wv0);
#define IN(k) (lo <= (k) && (k) < hi)
#define SEAM(k) do { if (IN(k) && IN((k) + 1)) xcd_barrier(bar); } while (0)

#define Win_t ((bf16*)(ws + WS_WIN))
#define Wout_t ((bf16*)(ws + WS_WOUT))
#define Wq_t ((bf16*)(ws + WS_WQ))
#define Wk_t ((bf16*)(ws + WS_WK))
#define Wv_t ((bf16*)(ws + WS_WV))
#define Wo_t ((bf16*)(ws + WS_WO))
#define LoraB ((bf16*)(ws + WS_LORAB))
#define LruW ((bf16*)(ws + WS_LRUW))
#define WrT ((bf16*)(ws + WS_LRUW + 512 * 1024))
#define Wgu_t ((bf16*)(ws + WS_WGU))
#define Wdn_t ((bf16*)(ws + WS_WDN))
#define HN ((bf16*)(ws + WS_HN))
#define MEMN ((bf16*)(ws + WS_MEMN))
#define KM ((bf16*)(ws + WS_KM))
#define VT ((bf16*)(ws + WS_VT))
#define X1 ((bf16*)(ws + WS_X1))
#define X2 ((bf16*)(ws + WS_X2))
#define U ((bf16*)(ws + WS_U))
#define Rr ((float*)(ws + WS_R))
#define KRAW ((float*)(ws + WS_KRAW))
#define Vv ((float*)(ws + WS_V))
#define KKN ((float*)(ws + WS_KKN))
#define WD ((float*)(ws + WS_WD))
#define AA ((float*)(ws + WS_AA))
#define GG ((float*)(ws + WS_G))
#define LA ((bf16*)(ws + WS_LA))
#define LB ((bf16*)(ws + WS_LB))
#define AP ((bf16*)(ws + WS_AP))
#define CAT ((bf16*)(ws + WS_CAT))
#define Qb ((bf16*)(ws + WS_Q))
#define Ob CAT
#define XS ((bf16*)(ws + WS_XS))
#define ACT ((bf16*)(ws + WS_ACT))
#define YS ((bf16*)(ws + WS_YS))
#define route_e ((int*)(ws + WS_ROUTE + RT_E))
#define route_pos ((int*)(ws + WS_ROUTE + RT_POS))
#define route_g ((float*)(ws + WS_ROUTE + RT_G))
#define row_sg ((u32x2*)(ws + WS_ROUTE + RT_SLOT))
#define tile_tab ((int*)(ws + WS_ROUTE + RT_TILE))
#define row_tok ((int*)(ws + WS_ROUTE + RT_TOK))
#define ecnt (ctl + CW_CNT)

    if (IN(0)) { PHASE_IDS;
        LAS float* scr = (LAS float*)(lds + wave * 16384);
        constexpr int I_IN = 16 * (INW / 32), I_SQ = 16 * 32;
        constexpr int N_ITEMS = I_IN + 5 * I_SQ;
        for (int it = gw; it < N_ITEMS; it += NGW) {
            int r = it;
            if (r < I_IN) { const int nblk = INW / 32, kb = r / nblk, nb = r % nblk; transpose_item(args.in[I_WIN], INW, D, Win_t, 64 * kb, 32 * nb, 32 * nb, scr, lane); continue; } r -= I_IN;
            { const int w = r / I_SQ, q = r % I_SQ, kb = q / 32, nb = q % 32;
                if (w == 1) continue;
                const float* src = w == 0 ? args.in[I_WOUT] : w == 2 ? args.in[I_WK] : w == 3 ? args.in[I_WV] : args.in[I_WO];
                bf16* dst = w == 0 ? Wout_t : w == 2 ? Wk_t : w == 3 ? Wv_t : Wo_t;
                transpose_item(src, D, D, dst, 64 * kb, 32 * nb, 32 * nb, scr, lane); }
        }
        for (int idx = bid * NTHREADS + tid; idx < D * D / 4; idx += G * NTHREADS) { const f32x4 v = ((const f32x4*)args.in[I_WQ])[idx]; const float gk = args.in[I_NXAG][idx >> 8];
            u32x2 w; w.x = pk2(v.x * gk, v.y * gk); w.y = pk2(v.z * gk, v.w * gk); ((u32x2*)Wq_t)[idx] = w; }
        for (int idx = bid * NTHREADS + tid; idx < 1536 * 256; idx += G * NTHREADS) {
            const int e = idx & 7, ln = (idx >> 3) & 63, ks = (idx >> 9) & 7, ct = (idx >> 12) & 3, hk = idx >> 14, hh = hk / 3, kind = hk - 3 * hh;
            const int k = 32 * ks + 8 * (ln >> 4) + e, n = hh * 64 + 16 * ct + (ln & 15); float v = 0.f;
            if (kind == 0) { if (k < 64) v = args.in[I_WUP][k * 512 + n]; }
            else if (kind == 1) { if (k >= 64 && k < 128) v = args.in[I_AUP][(k - 64) * 512 + n]; }
            else { if (k >= 128) v = args.in[I_GUP][(k - 128) * 512 + n]; }
            LoraB[idx] = (bf16)f2bf(v);
        }
        for (int idx = bid * NTHREADS + tid; idx < 8 * 128 * 64; idx += G * NTHREADS) {
            const int nb = idx >> 13, col = (idx >> 6) & 127, k = idx & 63;
            const float v = col < 64 ? args.in[I_LWX][nb * 4096 + k * 64 + col] : args.in[I_LWA][nb * 4096 + k * 64 + (col - 64)];
            LruW[idx] = (bf16)f2bf(v);
        }
        for (int idx = bid * NTHREADS + tid; idx < NE * D; idx += G * NTHREADS) {
            const int e = idx >> 10, k = idx & 1023; const float v = args.in[I_WR][k * NE + e];
            const unsigned hi = f2bf(v); const float lo = v - __uint_as_float(hi << 16);
            WrT[idx] = (bf16)hi; WrT[NE * D + idx] = (bf16)f2bf(lo);
        }
        for (int m = gw; m < M; m += NGW) rms_row_to_bf16(args.in[I_X] + (size_t)m * D, args.in[I_NMIXG], HN + (size_t)m * D, lane);
        for (int m = gw; m < MROWS; m += NGW) rms_row_to_bf16(args.in[I_MEM] + (size_t)m * D, args.in[I_NMEMG], MEMN + (size_t)m * D, lane);
        {
            LAS float* scr = (LAS float*)(lds + wave * 16384);
            constexpr int I_GU = 16 * 64, I_DN = 16 * 32;
            for (int it = CONV_P9 + gw; it < NE * I_GU; it += NGW) {
                int r = it;
                if (r < NE * I_GU) { const int e = r / I_GU, q = r % I_GU, kb = q / 64, nb = q % 64; const int n0 = 32 * nb;
                    const int drow = n0 < 1024 ? (256 * (n0 >> 7) + (n0 & 127)) : (256 * ((n0 - 1024) >> 7) + 128 + ((n0 - 1024) & 127));
                    transpose_item_tiled_fp8(args.in[I_WGU] + (size_t)e * D * 2048, 2048, D, (unsigned char*)Wgu_t + (size_t)e * 2048 * D, 64 * kb, n0, drow, scr, lane); continue; } r -= NE * I_GU;
                { const int e = r / I_DN, q = r % I_DN, kb = q / 32, nb = q % 32;
                  transpose_item_tiled(args.in[I_WDN] + (size_t)e * DFF * D, D, DFF, Wdn_t + (size_t)e * D * DFF, 64 * kb, 32 * nb, 32 * nb, scr, lane); }
            }
        }
    }
    SEAM(0);

    if (IN(1)) { PHASE_IDS;
        { pg8::DenseSched S; S.o.init_tiles(M / 256, INW / 256, G, bid); S.A = (const char*)HN; S.B = (const char*)Win_t; S.tstep = (size_t)256 * D * 2;
          EpiBf16Plain E{U, INW, 1.0f}; pg8::gemm_phase(lds, D, S, E, wv0); }
        { pg8::DenseSched S; S.o.init_tiles(MROWS / 256, D / 256, G, (bid + 64) & (G - 1)); S.A = (const char*)MEMN; S.B = (const char*)Wk_t; S.tstep = (size_t)256 * D * 2;
          EpiBf16Plain E{KM, D, 1.0f}; pg8::gemm_phase(lds, D, S, E, wv0); }
        { pg8::DenseSched S; S.o.init_tiles(MROWS / 256, D / 256, G, (bid + 48) & (G - 1)); S.A = (const char*)MEMN; S.B = (const char*)Wv_t; S.tstep = (size_t)256 * D * 2;
          EpiBf16Plain E{VT, D, 1.0f}; pg8::gemm_phase(lds, D, S, E, wv0); }
    }
    SEAM(1);

    if (IN(2)) { PHASE_IDS;
        const float* conv_w = args.in[I_CONVW]; const float* conv_b = args.in[I_CONVB];
        LAS float* xs = (LAS float*)(lds + wave * 16384);
        LAS bf16* tP = (LAS bf16*)(lds + wave * 16384 + 4096); LAS bf16* tH = tP + 1024;
        const int i = lane & 15, kg = lane >> 4;
        for (int unit = gw; unit < (M / 64) * 8; unit += NGW) {
            const int seg = unit >> 3, nb = unit & 7, m0s = seg * 64, s0s = m0s & (SEQ - 1);
            bf16x8 wf[8][2];
#pragma unroll
            for (int ct = 0; ct < 8; ++ct)
#pragma unroll
                for (int ks = 0; ks < 2; ++ks) wf[ct][ks] = *(const bf16x8*)(LruW + ((size_t)(nb * 128 + 16 * ct + i) * 64 + 32 * ks + 8 * kg));
            float bxv[4], bav[4], spv[4], Arun[4], Brun[4];
#pragma unroll
            for (int ct = 0; ct < 4; ++ct) { const int ch = nb * 64 + 16 * ct + i; bxv[ct] = args.in[I_LBX][ch]; bav[ct] = args.in[I_LBA][ch]; spv[ct] = softplus_f(-args.in[I_LAM][ch]); Arun[ct] = 1.f; Brun[ct] = 0.f; }
#pragma unroll 1
            for (int jt = 0; jt < 4; ++jt) {
                const int m0 = m0s + 16 * jt, s0 = s0s + 16 * jt;
                bf16x8 af[2];
#pragma unroll
                for (int ks = 0; ks < 2; ++ks) {
                    const int chb = nb * 64 + 32 * ks + 8 * kg;
                    f32x4 x0 = *(const f32x4*)(conv_b + chb), x1 = *(const f32x4*)(conv_b + chb + 4);
#pragma unroll
                    for (int j = 0; j < 4; ++j) {
                        const bool ok = s0 + i - 3 + j >= 0;
                        u32x4 uw = *(const u32x4*)(U + (size_t)(ok ? m0 + i - 3 + j : m0) * INW + chb); if (!ok) uw = (u32x4){0u, 0u, 0u, 0u};
                        const f32x4 w0 = *(const f32x4*)(conv_w + j * 512 + chb), w1 = *(const f32x4*)(conv_w + j * 512 + chb + 4);
                        x0.x += w0.x * bflo(uw.x); x0.y += w0.y * bfhi(uw.x); x0.z += w0.z * bflo(uw.y); x0.w += w0.w * bfhi(uw.y);
                        x1.x += w1.x * bflo(uw.z); x1.y += w1.y * bfhi(uw.z); x1.z += w1.z * bflo(uw.w); x1.w += w1.w * bfhi(uw.w);
                    }
                    *(LAS f32x4*)(xs + i * 64 + 32 * ks + 8 * kg) = x0; *(LAS f32x4*)(xs + i * 64 + 32 * ks + 8 * kg + 4) = x1;
                    u32x4 p; p.x = pk2(x0.x, x0.y); p.y = pk2(x0.z, x0.w); p.z = pk2(x1.x, x1.y); p.w = pk2(x1.z, x1.w);
                    af[ks] = __builtin_bit_cast(bf16x8, p);
                }
                f32x4 acc[8];
#pragma unroll
                for (int ct = 0; ct < 8; ++ct) { acc[ct] = (f32x4){0.f, 0.f, 0.f, 0.f};
#pragma unroll
                    for (int ks = 0; ks < 2; ++ks) acc[ct] = __builtin_amdgcn_mfma_f32_16x16x32_bf16(af[ks], wf[ct][ks], acc[ct], 0, 0, 0); }
#pragma unroll
                for (int ct = 0; ct < 4; ++ct) {
                    const int col = 16 * ct + i;
                    float hl[4], pl[4]; float hprev = 0.f, pprev = 1.f;
#pragma unroll
                    for (int e = 0; e < 4; ++e) {
                        const float gx = sigmoid_f(acc[ct][e] + bxv[ct]), ga = sigmoid_f(acc[ct + 4][e] + bav[ct]);
                        const float la = -8.0f * ga * spv[ct], av = __expf(la), xcv = xs[(4 * kg + e) * 64 + col];
                        const float bt = __builtin_amdgcn_sqrtf(fmaxf(1.0f - av * av, 0.f)) * gx * xcv;
                        hprev = av * hprev + bt; pprev *= av; hl[e] = hprev; pl[e] = pprev;
                    }
                    float Ag[4], Bg[4];
#pragma unroll
                    for (int gq = 0; gq < 4; ++gq) { Ag[gq] = __shfl(pl[3], i + 16 * gq); Bg[gq] = __shfl(hl[3], i + 16 * gq); }
                    float Ain = Arun[ct], Bin = Brun[ct];
#pragma unroll
                    for (int gq = 0; gq < 3; ++gq) if (gq < kg) { Bin = Ag[gq] * Bin + Bg[gq]; Ain *= Ag[gq]; }
                    float At = 1.f, Bt = 0.f;
#pragma unroll
                    for (int gq = 0; gq < 4; ++gq) { Bt = Ag[gq] * Bt + Bg[gq]; At *= Ag[gq]; }
                    Brun[ct] = At * Brun[ct] + Bt; Arun[ct] *= At;
#pragma unroll
                    for (int e = 0; e < 4; ++e) { const int ti_ = (4 * kg + e) * 64 + col; tP[ti_] = (bf16)f2bf(pl[e] * Ain); tH[ti_] = (bf16)f2bf(hl[e] + pl[e] * Bin); }
                }
                { const int rr = lane >> 2, cq = lane & 3;
                  bf16* pp = LA + (size_t)(m0 + rr) * 512 + nb * 64 + 16 * cq; bf16* hp = LB + (size_t)(m0 + rr) * 512 + nb * 64 + 16 * cq;
                  *(u32x4*)pp = *(const LAS u32x4*)(tP + rr * 64 + 16 * cq); *(u32x4*)(pp + 8) = *(const LAS u32x4*)(tP + rr * 64 + 16 * cq + 8);
                  *(u32x4*)hp = *(const LAS u32x4*)(tH + rr * 64 + 16 * cq); *(u32x4*)(hp + 8) = *(const LAS u32x4*)(tH + rr * 64 + 16 * cq + 8); }
            }
            if (kg == 0) {
#pragma unroll
                for (int ct = 0; ct < 4; ++ct) { f32x2 ab; ab.x = Arun[ct]; ab.y = Brun[ct];
                    *(f32x2*)((float*)(ws + WS_AP) + ((size_t)(((seg >> 6) * 8 + nb) * 64 + (seg & 63)) * 64 + 16 * ct + i) * 2) = ab; }
            }
        }
    }
    SEAM(2);


#define RW_ZB(zz, zb) do { _Pragma("unroll") for (int ks_ = 0; ks_ < 2; ++ks_) { u32x4 p_; p_.x = pk2(zz[2 * ks_][0], zz[2 * ks_][1]); p_.y = pk2(zz[2 * ks_][2], zz[2 * ks_][3]); \
        p_.z = pk2(zz[2 * ks_ + 1][0], zz[2 * ks_ + 1][1]); p_.w = pk2(zz[2 * ks_ + 1][2], zz[2 * ks_ + 1][3]); zb[ks_] = __builtin_bit_cast(bf16x8, p_); } } while (0)
    if (IN(3)) { PHASE_IDS;
        for (int u64 = gw; u64 < NB * NH * (SEQ / 64); u64 += NGW) {
#pragma unroll 1
        for (int jj = 0; jj < 4; ++jj) {
        LAS unsigned char* wl = lds + wave * 16384;
        LAS bf16* Arm = (LAS bf16*)(wl); LAS bf16* Brm = (LAS bf16*)(wl + 2048); LAS bf16* Krm = (LAS bf16*)(wl + 4096); LAS bf16* Rrm = (LAS bf16*)(wl + 6144);
        LAS bf16* ATt = (LAS bf16*)(wl + 8192); LAS bf16* BTt = (LAS bf16*)(wl + 10240); LAS bf16* KTt = (LAS bf16*)(wl + 12288); LAS bf16* VTt = (LAS bf16*)(wl + 14336);
        LAS float* MabT = (LAS float*)(wl); LAS bf16* Mak = (LAS bf16*)(wl + 1024); LAS bf16* Mrb = (LAS bf16*)(wl + 1536); LAS bf16* Mrk = (LAS bf16*)(wl + 2048); LAS bf16* Tm = (LAS bf16*)(wl + 2560);
        LAS float* PLs = (LAS float*)(wl + 3072); LAS bf16* Q0T = (LAS bf16*)(wl + 4096);
        const int lane = fresh_tid() & 63, l15 = lane & 15, g = lane >> 4, te = lane >> 2, kq = lane & 3;
        const bf16x8 z8 = (bf16x8){0, 0, 0, 0, 0, 0, 0, 0};
        const f32x4 z4 = (f32x4){0.f, 0.f, 0.f, 0.f};
            const int un = u64 * 4 + jj;
            const int bh = un >> 8, c = un & 255, b = bh >> 3, h = bh & 7;
            const size_t mrow = (size_t)b * SEQ + c * 16 + te, off = mrow * 512 + h * 64 + 16 * kq;
            const int hc = h * 64 + 16 * kq;
            LAS float* tmpL = (LAS float*)wl;
            {
                const int rsub = lane >> 5, chunk = lane & 31; const size_t mt0 = (size_t)b * SEQ + c * 16;
                const f32x4 m0 = *(const f32x4*)(args.in[I_MU] + 1536 + 8 * chunk), m1 = *(const f32x4*)(args.in[I_MU] + 1536 + 8 * chunk + 4);
                u32x4 cu[8], pu[8];
#pragma unroll
                for (int i = 0; i < 8; ++i) { const size_t mr = mt0 + 2 * i + rsub; const bool hp2 = (mr & (SEQ - 1)) != 0; const bf16* ua = U + mr * INW + 2560 + 8 * chunk;
                    cu[i] = *(const u32x4*)ua; pu[i] = *(const u32x4*)(ua - (hp2 ? INW : 0)); if (!hp2) pu[i] = (u32x4){0u, 0u, 0u, 0u}; }
#pragma unroll
                for (int i = 0; i < 8; ++i) { float o8[8];
#pragma unroll
                    for (int q = 0; q < 4; ++q) { const float c0 = bflo(cu[i][q]), c1 = bfhi(cu[i][q]), p0 = bflo(pu[i][q]), p1 = bfhi(pu[i][q]); const float mm0 = q < 2 ? m0[2 * q] : m1[2 * q - 4], mm1 = q < 2 ? m0[2 * q + 1] : m1[2 * q - 3];
                        float x0 = c0 + (p0 - c0) * mm0, x1 = c1 + (p1 - c1) * mm1;
                        if (chunk < 8) { x0 = tanh_fast(x0); x1 = tanh_fast(x1); }
                        else if (chunk >= 16) { x0 = sigmoid_f(x0); x1 = sigmoid_f(x1); }
                        o8[2 * q] = x0; o8[2 * q + 1] = x1; }
                    u32x4 pw; pw.x = pk2(o8[0], o8[1]); pw.y = pk2(o8[2], o8[3]); pw.z = pk2(o8[4], o8[5]); pw.w = pk2(o8[6], o8[7]);
                    const int row = 2 * i + rsub; *(LAS u32x4*)(wl + row * 512 + ((chunk ^ (row & 7)) << 4)) = pw; }
                bf16x8 af[8];
#pragma unroll
                for (int ks = 0; ks < 8; ++ks) af[ks] = *(const LAS bf16x8*)(wl + l15 * 512 + (((4 * ks + g) ^ (l15 & 7)) << 4));
                asm volatile("s_waitcnt lgkmcnt(0)" ::: "memory");
#pragma unroll
                for (int kind = 0; kind < 3; ++kind)
#pragma unroll
                    for (int ct = 0; ct < 4; ++ct) {
                        const bf16* lb = LoraB + ((size_t)((h * 3 + kind) * 4 + ct) * 8 * 64 + lane) * 8;
                        f32x4 a4 = z4;
#pragma unroll
                        for (int ks = (kind == 0 ? 0 : kind == 1 ? 2 : 4); ks < (kind == 0 ? 2 : kind == 1 ? 4 : 8); ++ks) a4 = __builtin_amdgcn_mfma_f32_16x16x32_bf16(af[ks], *(const bf16x8*)(lb + ks * 512), a4, 0, 0, 0);
#pragma unroll
                        for (int e = 0; e < 4; ++e) tmpL[kind * 1088 + (4 * g + e) * 68 + 16 * ct + l15] = a4[e];
                    }
            }
            asm volatile("s_waitcnt lgkmcnt(0)" ::: "memory");
            float cl[16], eP[16];
            {
                float lwv[16], rl[16], kl[16], vl[16], kn[16], av[16];
                const bool hp = (mrow & (SEQ - 1)) != 0;
                const bf16* ub = U + mrow * INW + 1024 + hc;
#pragma unroll
                for (int hh = 0; hh < 2; ++hh) {
#pragma unroll
                    for (int a3 = 0; a3 < 3; ++a3) {
                        const u32x4 cu = *(const u32x4*)(ub + 512 * a3 + 8 * hh); u32x4 pu = *(const u32x4*)(ub - (hp ? INW : 0) + 512 * a3 + 8 * hh); if (!hp) pu = (u32x4){0u, 0u, 0u, 0u};
                        const f32x4 m0 = *(const f32x4*)(args.in[I_MU] + 512 * a3 + hc + 8 * hh), m1 = *(const f32x4*)(args.in[I_MU] + 512 * a3 + hc + 8 * hh + 4);
                        float o8[8];
#pragma unroll
                        for (int q = 0; q < 4; ++q) { const float c0 = bflo(cu[q]), c1 = bfhi(cu[q]), p0 = bflo(pu[q]), p1 = bfhi(pu[q]); const float mm0 = q < 2 ? m0[2 * q] : m1[2 * q - 4], mm1 = q < 2 ? m0[2 * q + 1] : m1[2 * q - 3];
                            o8[2 * q] = c0 + (p0 - c0) * mm0; o8[2 * q + 1] = c1 + (p1 - c1) * mm1; }
#pragma unroll
                        for (int q = 0; q < 8; ++q) { if (a3 == 0) rl[8 * hh + q] = o8[q]; else if (a3 == 1) kl[8 * hh + q] = o8[q]; else vl[8 * hh + q] = o8[q]; }
                    }
                }
                float gv[16];
#pragma unroll
                for (int j4 = 0; j4 < 4; ++j4) { const f32x4 xl = *(const LAS f32x4*)(tmpL + te * 68 + 16 * kq + 4 * j4), xa = *(const LAS f32x4*)(tmpL + 1088 + te * 68 + 16 * kq + 4 * j4), xg = *(const LAS f32x4*)(tmpL + 2176 + te * 68 + 16 * kq + 4 * j4);
                    const f32x4 w0v = *(const f32x4*)(args.in[I_W0] + hc + 4 * j4), a0v = *(const f32x4*)(args.in[I_A0] + hc + 4 * j4);
#pragma unroll
                    for (int q = 0; q < 4; ++q) { const float wq = -softplus_fast(-(xl[q] + w0v[q])) - 0.5f; lwv[4 * j4 + q] = -__expf(wq); av[4 * j4 + q] = sigmoid_f(xa[q] + a0v[q]); gv[4 * j4 + q] = xg[q]; } }
                asm volatile("s_waitcnt lgkmcnt(0)" ::: "memory");
                float ss = 0.f;
#pragma unroll
                for (int j4 = 0; j4 < 4; ++j4) { const f32x4 kk4 = *(const f32x4*)(args.in[I_KK] + hc + 4 * j4);
#pragma unroll
                    for (int q = 0; q < 4; ++q) { kn[4 * j4 + q] = kl[4 * j4 + q] * kk4[q]; ss += kn[4 * j4 + q] * kn[4 * j4 + q]; } }
                ss += __shfl_xor(ss, 1); ss += __shfl_xor(ss, 2);
                const float kinv = rsq_f(fmaxf(ss, 1e-24f));
#pragma unroll
                for (int j = 0; j < 16; ++j) { float x = lwv[j];
#pragma unroll
                    for (int sft = 4; sft < 64; sft <<= 1) { const float y = __shfl_up(x, sft); if (lane >= sft) x += y; }
                    cl[j] = x; }
                float bon = 0.f;
                u32x4 pa[2], pb[2], pk[2], pr[2];
#pragma unroll
                for (int j4 = 0; j4 < 4; ++j4) {
                    const f32x4 ka = *(const f32x4*)(args.in[I_KA] + hc + 4 * j4), rk = *(const f32x4*)(args.in[I_RK] + hc + 4 * j4);
                    float at4[4], bt4[4], kt4[4], rt4[4];
#pragma unroll
                    for (int q = 0; q < 4; ++q) { const int j = 4 * j4 + q;
                        const float p = __expf(cl[j]), pn = __expf(-cl[j]), pm1 = __expf(cl[j] - lwv[j]); eP[j] = p;
                        const float knj = kn[j] * kinv;
                        const float kp = kl[j] * (1.0f + (av[j] - 1.0f) * ka[q]);
                        at4[q] = -knj * pm1; bt4[q] = knj * av[j] * pn; kt4[q] = kp * pn; rt4[q] = rl[j] * p;
                        bon += rl[j] * kp * rk[q];
                        const int kk = 16 * kq + j;
                        ATt[kk * 16 + te] = (bf16)f2bf(at4[q]); BTt[kk * 16 + te] = (bf16)f2bf(bt4[q]); KTt[kk * 16 + te] = (bf16)f2bf(kt4[q]); VTt[kk * 16 + te] = (bf16)f2bf(vl[j]); }
                    const int hh = j4 >> 1, w2 = (j4 & 1) * 2;
                    pa[hh][w2] = pk2(at4[0], at4[1]); pa[hh][w2 + 1] = pk2(at4[2], at4[3]); pb[hh][w2] = pk2(bt4[0], bt4[1]); pb[hh][w2 + 1] = pk2(bt4[2], bt4[3]);
                    pk[hh][w2] = pk2(kt4[0], kt4[1]); pk[hh][w2 + 1] = pk2(kt4[2], kt4[3]); pr[hh][w2] = pk2(rt4[0], rt4[1]); pr[hh][w2 + 1] = pk2(rt4[2], rt4[3]);
                }
#pragma unroll
                for (int hh = 0; hh < 2; ++hh) { const int po = te * 64 + 8 * ((2 * kq + hh) ^ (te & 7));
                    *(LAS u32x4*)(Arm + po) = pa[hh]; *(LAS u32x4*)(Brm + po) = pb[hh]; *(LAS u32x4*)(Krm + po) = pk[hh]; *(LAS u32x4*)(Rrm + po) = pr[hh]; }
                bon += __shfl_xor(bon, 1); bon += __shfl_xor(bon, 2);
                f32x4 lbv[4], lgv[4];
#pragma unroll
                for (int j4 = 0; j4 < 4; ++j4) { lbv[j4] = *(const f32x4*)(args.in[I_LNB] + hc + 4 * j4); lgv[j4] = *(const f32x4*)(args.in[I_LNG] + hc + 4 * j4); }
#pragma unroll
                for (int j4 = 0; j4 < 4; ++j4) { const f32x4 lb = lbv[j4], lgn = lgv[j4]; const int j0 = 4 * j4;
                    u32x2 ow, gw2; ow.x = pk2((lb.x + vl[j0] * bon) * gv[j0], (lb.y + vl[j0 + 1] * bon) * gv[j0 + 1]); ow.y = pk2((lb.z + vl[j0 + 2] * bon) * gv[j0 + 2], (lb.w + vl[j0 + 3] * bon) * gv[j0 + 3]);
                    gw2.x = pk2(lgn.x * gv[j0], lgn.y * gv[j0 + 1]); gw2.y = pk2(lgn.z * gv[j0 + 2], lgn.w * gv[j0 + 3]);
                    *(u32x2*)((bf16*)(ws + WS_ADD) + off + j0) = ow; *(u32x2*)((bf16*)(ws + WS_G) + off + j0) = gw2; }
            }
            asm volatile("s_waitcnt lgkmcnt(0)" ::: "memory");
            {
                bf16x8 fa[2], fr[2], fb[2], fk[2];
#pragma unroll
                for (int ks = 0; ks < 2; ++ks) { const int po = l15 * 64 + 8 * ((4 * ks + g) ^ (l15 & 7));
                    fa[ks] = *(const LAS bf16x8*)(Arm + po); fr[ks] = *(const LAS bf16x8*)(Rrm + po); fb[ks] = *(const LAS bf16x8*)(Brm + po); fk[ks] = *(const LAS bf16x8*)(Krm + po); }
                f32x4 mab = z4, mak = z4, mrb = z4, mrk = z4;
#pragma unroll
                for (int ks = 0; ks < 2; ++ks) { mab = __builtin_amdgcn_mfma_f32_16x16x32_bf16(fb[ks], fa[ks], mab, 0, 0, 0); mak = __builtin_amdgcn_mfma_f32_16x16x32_bf16(fk[ks], fa[ks], mak, 0, 0, 0);
                    mrb = __builtin_amdgcn_mfma_f32_16x16x32_bf16(fb[ks], fr[ks], mrb, 0, 0, 0); mrk = __builtin_amdgcn_mfma_f32_16x16x32_bf16(fk[ks], fr[ks], mrk, 0, 0, 0); }
#pragma unroll
                for (int e = 0; e < 4; ++e) { const int i = 4 * g + e; if (!(i < l15)) { mab[e] = 0.f; mak[e] = 0.f; } if (!(i <= l15)) { mrb[e] = 0.f; mrk[e] = 0.f; } }
                asm volatile("s_waitcnt lgkmcnt(0)" ::: "memory");
#pragma unroll
                for (int e = 0; e < 4; ++e) MabT[(4 * g + e) * 16 + l15] = mab[e];
                u32x2 w; w.x = pk2(mak[0], mak[1]); w.y = pk2(mak[2], mak[3]); *(LAS u32x2*)(Mak + l15 * 16 + 4 * g) = w;
                w.x = pk2(mrb[0], mrb[1]); w.y = pk2(mrb[2], mrb[3]); *(LAS u32x2*)(Mrb + l15 * 16 + 4 * g) = w;
                w.x = pk2(mrk[0], mrk[1]); w.y = pk2(mrk[2], mrk[3]); *(LAS u32x2*)(Mrk + l15 * 16 + 4 * g) = w;
                if (te == 15) {
#pragma unroll
                    for (int j = 0; j < 16; ++j) PLs[16 * kq + j] = eP[j]; }
            }
            asm volatile("s_waitcnt lgkmcnt(0)" ::: "memory");
            {
                f32x4 mq[15][4];
#pragma unroll
                for (int j = 0; j < 15; ++j)
#pragma unroll
                    for (int q = 0; q < 4; ++q) if (4 * q + 3 > j) mq[j][q] = *(const LAS f32x4*)(MabT + j * 16 + 4 * q);
                float y[16];
#pragma unroll
                for (int j = 15; j >= 0; --j) {
                    float acc = (j == l15) ? 1.0f : 0.0f;
#pragma unroll
                    for (int i = j + 1; i < 16; ++i) acc += y[i] * mq[j < 15 ? j : 0][i >> 2][i & 3];
                    y[j] = acc;
                }
                if (g == 0) { u32x4 t0, t1; t0.x = pk2(y[0], y[1]); t0.y = pk2(y[2], y[3]); t0.z = pk2(y[4], y[5]); t0.w = pk2(y[6], y[7]); t1.x = pk2(y[8], y[9]); t1.y = pk2(y[10], y[11]); t1.z = pk2(y[12], y[13]); t1.w = pk2(y[14], y[15]);
                    *(LAS u32x4*)(Tm + l15 * 16) = t0; *(LAS u32x4*)(Tm + l15 * 16 + 8) = t1; }
            }
            asm volatile("s_waitcnt lgkmcnt(0)" ::: "memory");
            {
                const bool act = g < 2; const int fo = l15 * 16 + 8 * g;
                const bf16x8 fT = act ? *(const LAS bf16x8*)(Tm + fo) : z8, fMak = act ? *(const LAS bf16x8*)(Mak + fo) : z8, fMrb = act ? *(const LAS bf16x8*)(Mrb + fo) : z8, fMrk = act ? *(const LAS bf16x8*)(Mrk + fo) : z8;
                bf16x8 fV[4], fQ1[4], fAh[4], fBT[4], fKT[4];
#pragma unroll
                for (int vt = 0; vt < 4; ++vt) { fV[vt] = act ? *(const LAS bf16x8*)(VTt + vt * 256 + fo) : z8; fBT[vt] = act ? *(const LAS bf16x8*)(BTt + vt * 256 + fo) : z8; fKT[vt] = act ? *(const LAS bf16x8*)(KTt + vt * 256 + fo) : z8; }
#pragma unroll
                for (int vt = 0; vt < 4; ++vt) { const f32x4 q0 = __builtin_amdgcn_mfma_f32_16x16x32_bf16(fMak, fV[vt], z4, 0, 0, 0);
                    u32x2 w; w.x = pk2(q0[0], q0[1]); w.y = pk2(q0[2], q0[3]); *(LAS u32x2*)(Q0T + vt * 256 + l15 * 16 + 4 * g) = w; }
#pragma unroll
                for (int kt = 0; kt < 4; ++kt) { const bf16x8 fA = act ? *(const LAS bf16x8*)(ATt + kt * 256 + fo) : z8; const f32x4 ah = __builtin_amdgcn_mfma_f32_16x16x32_bf16(fT, fA, z4, 0, 0, 0);
                    u32x2 w; w.x = pk2(ah[0], ah[1]); w.y = pk2(ah[2], ah[3]); *(LAS u32x2*)(ATt + kt * 256 + l15 * 16 + 4 * g) = w; }
                asm volatile("s_waitcnt lgkmcnt(0)" ::: "memory");
#pragma unroll
                for (int vt = 0; vt < 4; ++vt) { const bf16x8 fQ0 = act ? *(const LAS bf16x8*)(Q0T + vt * 256 + fo) : z8; const f32x4 q1 = __builtin_amdgcn_mfma_f32_16x16x32_bf16(fT, fQ0, z4, 0, 0, 0);
                    u32x2 w; w.x = pk2(q1[0], q1[1]); w.y = pk2(q1[2], q1[3]); *(LAS u32x2*)(Q0T + vt * 256 + l15 * 16 + 4 * g) = w; }
                asm volatile("s_waitcnt lgkmcnt(0)" ::: "memory");
#pragma unroll
                for (int vt = 0; vt < 4; ++vt) { fQ1[vt] = act ? *(const LAS bf16x8*)(Q0T + vt * 256 + fo) : z8; fAh[vt] = act ? *(const LAS bf16x8*)(ATt + vt * 256 + fo) : z8; }
                bf16* rp = (bf16*)(ws + WS_RP) + (size_t)un * 1024 + l15 * 64;
#pragma unroll
                for (int kt = 0; kt < 4; ++kt) {
                    const u32x2 rr = *(const LAS u32x2*)(Rrm + l15 * 64 + 8 * ((2 * kt + (g >> 1)) ^ (l15 & 7)) + 4 * (g & 1));
                    f32x4 ini; ini[0] = bflo(rr.x); ini[1] = bfhi(rr.x); ini[2] = bflo(rr.y); ini[3] = bfhi(rr.y);
                    const f32x4 rh = __builtin_amdgcn_mfma_f32_16x16x32_bf16(fAh[kt], fMrb, ini, 0, 0, 0);
                    u32x2 w; w.x = pk2(rh[0], rh[1]); w.y = pk2(rh[2], rh[3]); *(u32x2*)(rp + 32 * (kt >> 1) + 8 * g + 4 * (kt & 1)) = w;
                }
#pragma unroll
                for (int vt = 0; vt < 4; ++vt) { f32x4 y1 = __builtin_amdgcn_mfma_f32_16x16x32_bf16(fMrb, fQ1[vt], z4, 0, 0, 0); y1 = __builtin_amdgcn_mfma_f32_16x16x32_bf16(fMrk, fV[vt], y1, 0, 0, 0);
                    *(f32x4*)((float*)(ws + WS_Y1F) + ((size_t)(un * 4 + vt) * 64 + lane) * 4) = y1; }
                LAS bf16* tgs = (LAS bf16*)(wl + 8192);
#pragma unroll
                for (int krt = 0; krt < 4; ++krt) { const float pl = PLs[16 * krt + l15];
#pragma unroll
                    for (int kct = 0; kct < 4; ++kct) { f32x4 ga = __builtin_amdgcn_mfma_f32_16x16x32_bf16(fAh[kct], fBT[krt], z4, 0, 0, 0);
                        if (kct == krt) {
#pragma unroll
                            for (int e = 0; e < 4; ++e) if (4 * g + e == l15) ga[e] += 1.0f; }
                        u32x2 w; w.x = pk2(ga[0] * pl, ga[1] * pl); w.y = pk2(ga[2] * pl, ga[3] * pl);
                        *(LAS u32x2*)(tgs + (16 * krt + l15) * 64 + 32 * (kct >> 1) + 8 * g + 4 * (kct & 1)) = w; } }
                { u32x4* gp16 = (u32x4*)((bf16*)(ws + WS_GP) + (size_t)un * 4096);
#pragma unroll
                  for (int i = 0; i < 8; ++i) gp16[i * 64 + lane] = *(const LAS u32x4*)(tgs + (i * 64 + lane) * 8); }
#pragma unroll
                for (int mt = 0; mt < 4; ++mt) { const f32x4 pl4 = *(const LAS f32x4*)(PLs + 16 * mt + 4 * g);
#pragma unroll
                    for (int vt = 0; vt < 4; ++vt) { f32x4 ha = __builtin_amdgcn_mfma_f32_16x16x32_bf16(fBT[mt], fQ1[vt], z4, 0, 0, 0); ha = __builtin_amdgcn_mfma_f32_16x16x32_bf16(fKT[mt], fV[vt], ha, 0, 0, 0);
                        u32x2 w; w.x = pk2(ha[0] * pl4[0], ha[1] * pl4[1]); w.y = pk2(ha[2] * pl4[2], ha[3] * pl4[3]);
                        *(u32x2*)((bf16*)(ws + WS_HF) + ((size_t)((un * 4 + vt) * 4 + mt) * 64 + lane) * 4) = w; } }
            }
            asm volatile("s_waitcnt lgkmcnt(0)" ::: "memory");
        }
        asm volatile("s_waitcnt vmcnt(0)" ::: "memory");
        { const int ltid = fresh_tid() & 63, l15 = ltid & 15, g = ltid >> 4, lane = ltid;
#define CP_LOADG(gf_, j_) do { const bf16* gp_ = (const bf16*)(ws + WS_GP) + ((size_t)u64 * 4 + (j_)) * 4096 + l15 * 64 + 8 * g; \
            _Pragma("unroll") for (int mt = 0; mt < 4; ++mt) { gf_[mt][0] = *(const bf16x8*)(gp_ + mt * 1024); gf_[mt][1] = *(const bf16x8*)(gp_ + mt * 1024 + 32); } } while (0)
#define CP_LOADH(hf_, j_) do { _Pragma("unroll") for (int sl = 0; sl < 4; ++sl) _Pragma("unroll") for (int mt = 0; mt < 4; ++mt) \
            hf_[sl][mt] = *(const u32x2*)((const bf16*)(ws + WS_HF) + ((size_t)((((size_t)u64 * 4 + (j_)) * 4 + sl) * 4 + mt) * 64 + lane) * 4); } while (0)
#define CP_STEP(gf_, hf_, useh_) do { _Pragma("unroll") for (int sl = 0; sl < 4; ++sl) { bf16x8 zb[2]; RW_ZB(z[sl], zb); \
            _Pragma("unroll") for (int mt = 0; mt < 4; ++mt) { f32x4 a_ = (f32x4){0.f, 0.f, 0.f, 0.f}; \
                if (useh_) { a_[0] = bflo(hf_[sl][mt].x); a_[1] = bfhi(hf_[sl][mt].x); a_[2] = bflo(hf_[sl][mt].y); a_[3] = bfhi(hf_[sl][mt].y); } \
                a_ = __builtin_amdgcn_mfma_f32_16x16x32_bf16(gf_[mt][0], zb[0], a_, 0, 0, 0); a_ = __builtin_amdgcn_mfma_f32_16x16x32_bf16(gf_[mt][1], zb[1], a_, 0, 0, 0); z[sl][mt] = a_; } } } while (0)
        {
            f32x4 z[4][4];
#pragma unroll
            for (int sl = 0; sl < 4; ++sl)
#pragma unroll
                for (int mt = 0; mt < 4; ++mt)
#pragma unroll
                    for (int e = 0; e < 4; ++e) z[sl][mt][e] = (sl == mt && 4 * g + e == l15) ? 1.0f : 0.0f;
            bf16x8 gA[4][2], gB[4][2]; u32x2 hdum[4][4];
            CP_LOADG(gA, 0); CP_LOADG(gB, 1);
            CP_STEP(gA, hdum, false); CP_LOADG(gA, 2);
            CP_STEP(gB, hdum, false); CP_LOADG(gB, 3);
            CP_STEP(gA, hdum, false);
            CP_STEP(gB, hdum, false);
            LAS bf16* tg = (LAS bf16*)(lds + wave * 16384);
#pragma unroll
            for (int sl = 0; sl < 4; ++sl) { const int pc = 32 * (sl >> 1) + 8 * (l15 >> 2) + 4 * (sl & 1) + (l15 & 3);
#pragma unroll
                for (int mt = 0; mt < 4; ++mt)
#pragma unroll
                    for (int e = 0; e < 4; ++e) tg[(16 * mt + 4 * g + e) * 64 + pc] = (bf16)f2bf(z[sl][mt][e]); }
            u32x4* gc = (u32x4*)((bf16*)(ws + WS_GC) + (size_t)u64 * 4096);
#pragma unroll
            for (int i = 0; i < 8; ++i) gc[i * 64 + lane] = *(const LAS u32x4*)(tg + (i * 64 + lane) * 8);
        }
        {
            f32x4 z[4][4];
#pragma unroll
            for (int sl = 0; sl < 4; ++sl)
#pragma unroll
                for (int mt = 0; mt < 4; ++mt) z[sl][mt] = (f32x4){0.f, 0.f, 0.f, 0.f};
            bf16x8 gA[4][2], gB[4][2]; u32x2 hA[4][4], hB[4][4];
            CP_LOADG(gA, 0); CP_LOADH(hA, 0); CP_LOADG(gB, 1); CP_LOADH(hB, 1);
            CP_STEP(gA, hA, true); CP_LOADG(gA, 2); CP_LOADH(hA, 2);
            CP_STEP(gB, hB, true); CP_LOADG(gB, 3); CP_LOADH(hB, 3);
            CP_STEP(gA, hA, true);
            CP_STEP(gB, hB, true);
#pragma unroll
            for (int sl = 0; sl < 4; ++sl)
#pragma unroll
                for (int mt = 0; mt < 4; ++mt) { u32x2 w; w.x = pk2(z[sl][mt][0], z[sl][mt][1]); w.y = pk2(z[sl][mt][2], z[sl][mt][3]);
                    *(u32x2*)((bf16*)(ws + WS_HC) + ((size_t)((u64 * 4 + sl) * 4 + mt) * 64 + lane) * 4) = w; }
        }
#undef CP_LOADG
#undef CP_LOADH
#undef CP_STEP
        }
        }
    }
    SEAM(3);


    if (IN(4)) { PHASE_IDS;
        if (!(bid < 128 && wave == 0)) {
            const int wi = bid < 128 ? bid * 7 + (wave - 1) : 896 + (bid - 128) * 8 + wave, NW = 896 + (G - 128) * 8;
        } else {
            const int l15 = lane & 15, g = lane >> 4, bh = bid >> 2, vs = bid & 3;
            f32x4 z[4];
#pragma unroll
            for (int mt = 0; mt < 4; ++mt) z[mt] = (f32x4){0.f, 0.f, 0.f, 0.f};
            bf16x8 gA[4][2], gB[4][2], gC[4][2], gD[4][2]; u32x2 hA[4], hB[4], hC[4], hD[4];
#define SC_LOAD(gf, hf, C) do { const size_t u64_ = (size_t)bh * 64 + (C); const bf16* gp_ = (const bf16*)(ws + WS_GC) + u64_ * 4096 + l15 * 64 + 8 * g; \
                _Pragma("unroll") for (int mt = 0; mt < 4; ++mt) { gf[mt][0] = *(const bf16x8*)(gp_ + mt * 1024); gf[mt][1] = *(const bf16x8*)(gp_ + mt * 1024 + 32); \
                    hf[mt] = *(const u32x2*)((const bf16*)(ws + WS_HC) + ((size_t)((u64_ * 4 + vs) * 4 + mt) * 64 + lane) * 4); } } while (0)
#define SC_STEP(gf, hf, C) do { const size_t u64_ = (size_t)bh * 64 + (C); bf16* zs_ = (bf16*)(ws + WS_ZS) + ((size_t)((u64_ * 4 + vs) * 4) * 64 + lane) * 4; \
                _Pragma("unroll") for (int mt = 0; mt < 4; ++mt) { u32x2 zw_; zw_.x = pk2(z[mt][0], z[mt][1]); zw_.y = pk2(z[mt][2], z[mt][3]); *(u32x2*)(zs_ + mt * 256) = zw_; } \
                bf16x8 zb[2]; RW_ZB(z, zb); \
                _Pragma("unroll") for (int mt = 0; mt < 4; ++mt) { f32x4 a; a[0] = bflo(hf[mt].x); a[1] = bfhi(hf[mt].x); a[2] = bflo(hf[mt].y); a[3] = bfhi(hf[mt].y); \
                    a = __builtin_amdgcn_mfma_f32_16x16x32_bf16(gf[mt][0], zb[0], a, 0, 0, 0); a = __builtin_amdgcn_mfma_f32_16x16x32_bf16(gf[mt][1], zb[1], a, 0, 0, 0); z[mt] = a; } } while (0)
            SC_LOAD(gA, hA, 0); SC_LOAD(gB, hB, 1); SC_LOAD(gC, hC, 2);
#pragma unroll 1
            for (int C = 0; C < 64; C += 4) {
                SC_LOAD(gD, hD, C + 3);
                SC_STEP(gA, hA, C);
                if (C + 4 < 64) SC_LOAD(gA, hA, C + 4);
                SC_STEP(gB, hB, C + 1);
                if (C + 5 < 64) SC_LOAD(gB, hB, C + 5);
                SC_STEP(gC, hC, C + 2);
                if (C + 6 < 64) SC_LOAD(gC, hC, C + 6);
                SC_STEP(gD, hD, C + 3);
            }
#undef SC_LOAD
#undef SC_STEP
        }
    }
    if (IN(4)) { PHASE_IDS;
        if (bid < 32 && wave == 1) { const int bc = bid; const f32x2* ag = (const f32x2*)((const float*)(ws + WS_AP)) + (size_t)(bc * 64) * 64 + lane;
            float* car = (float*)(ws + WS_AP + 4 * MiB) + (size_t)(bc * 64) * 64 + lane; float hst = 0.f;
#pragma unroll 16
            for (int sg = 0; sg < 64; ++sg) { const f32x2 ab = ag[(size_t)sg * 64]; car[(size_t)sg * 64] = hst; hst = ab.x * hst + ab.y; } }
    }
    if (IN(4)) { PHASE_IDS;
        bf16* WKt = HN; bf16* VWt = HN + (size_t)4 * 1024 * 1024;
        __syncthreads();
        if (bid >= 128 && bid < 192) { pg8::FoldSched<0> S; S.A = (const char*)KM; S.B = (const char*)Wq_t; S.G = 64; S.c = bid - 128; EpiFold<0> E{WKt}; pg8::gemm_phase(lds, 256, S, E, wv0, 1024); }
        else if (bid >= 192) { pg8::FoldSched<1> S; S.A = (const char*)Wo_t; S.B = (const char*)VT; S.G = 64; S.c = bid - 192; EpiFold<1> E{VWt}; pg8::gemm_phase(lds, 256, S, E, wv0, 1024); }
    }
    SEAM(4);

    if (IN(5)) { PHASE_IDS;
        {
            for (int lu = gw; lu < (M / 64) * 8; lu += NGW) {
                const int seg = lu >> 3, nb = lu & 7, rr = lane >> 3, cq = lane & 7;
                const float* cp = (const float*)(ws + WS_AP + 4 * MiB) + ((size_t)(((seg >> 6) * 8 + nb) * 64 + (seg & 63)) * 64 + 8 * cq);
                const f32x4 c0 = *(const f32x4*)cp, c1 = *(const f32x4*)(cp + 4);
#pragma unroll
                for (int it = 0; it < 8; ++it) { const size_t m = (size_t)seg * 64 + 8 * it + rr; const size_t o = m * 512 + nb * 64 + 8 * cq;
                    const u32x4 pw = *(const u32x4*)(LA + o), hw = *(const u32x4*)(LB + o), gw_ = *(const u32x4*)(U + m * INW + 512 + nb * 64 + 8 * cq);
                    float y[8];
#pragma unroll
                    for (int q = 0; q < 4; ++q) { const float ca = q < 2 ? c0[2 * q] : c1[2 * q - 4], cb = q < 2 ? c0[2 * q + 1] : c1[2 * q - 3];
                        y[2 * q] = (bflo(hw[q]) + bflo(pw[q]) * ca) * gelu_tanh_f(bflo(gw_[q])); y[2 * q + 1] = (bfhi(hw[q]) + bfhi(pw[q]) * cb) * gelu_tanh_f(bfhi(gw_[q])); }
                    u32x4 w; w.x = pk2(y[0], y[1]); w.y = pk2(y[2], y[3]); w.z = pk2(y[4], y[5]); w.w = pk2(y[6], y[7]);
                    *(u32x4*)(CAT + m * 1024 + nb * 64 + 8 * cq) = w; }
            }
        }
        const int l15 = lane & 15, g = lane >> 4;
        LAS bf16* tGL = (LAS bf16*)(lds + wave * 16384); LAS bf16* tAD = tGL + 1024; LAS bf16* tOUT = tGL + 2048;
        const int ct = lane >> 3, cc = lane & 7;
        for (int u64 = gw; u64 < NB * NH * (SEQ / 64); u64 += NGW) {
            const int bh = u64 >> 6, C = u64 & 63, b = bh >> 3, h = bh & 7;
            f32x4 z[4][4];
#pragma unroll
            for (int sl = 0; sl < 4; ++sl)
#pragma unroll
                for (int mt = 0; mt < 4; ++mt) { const u32x2 zw = *(const u32x2*)((const bf16*)(ws + WS_ZS) + ((size_t)((u64 * 4 + sl) * 4 + mt) * 64 + lane) * 4); z[sl][mt] = (f32x4){bflo(zw.x), bfhi(zw.x), bflo(zw.y), bfhi(zw.y)}; }
#pragma unroll 1
            for (int j = 0; j < 4; ++j) {
                const size_t un = (size_t)u64 * 4 + j; const size_t m0 = (size_t)b * SEQ + (C * 4 + j) * 16;
                const bf16* rp = (const bf16*)(ws + WS_RP) + un * 1024 + l15 * 64 + 8 * g;
                const bf16x8 rf0 = *(const bf16x8*)rp, rf1 = *(const bf16x8*)(rp + 32);
                f32x4 y[4];
#pragma unroll
                for (int sl = 0; sl < 4; ++sl) y[sl] = *(const f32x4*)((const float*)(ws + WS_Y1F) + ((size_t)(un * 4 + sl) * 64 + lane) * 4);
                const size_t rg = (m0 + ct) * 512 + h * 64 + 8 * cc;
                const u32x4 gl0 = *(const u32x4*)((const bf16*)(ws + WS_G) + rg), gl1 = *(const u32x4*)((const bf16*)(ws + WS_G) + rg + 8 * 512);
                const u32x4 ad0 = *(const u32x4*)((const bf16*)(ws + WS_ADD) + rg), ad1 = *(const u32x4*)((const bf16*)(ws + WS_ADD) + rg + 8 * 512);
                bf16x8 gf[4][2]; u32x2 hfr[4][4];
                if (j < 3) {
                    const bf16* gp = (const bf16*)(ws + WS_GP) + un * 4096 + l15 * 64 + 8 * g;
#pragma unroll
                    for (int mt = 0; mt < 4; ++mt) { gf[mt][0] = *(const bf16x8*)(gp + mt * 1024); gf[mt][1] = *(const bf16x8*)(gp + mt * 1024 + 32); }
#pragma unroll
                    for (int sl = 0; sl < 4; ++sl)
#pragma unroll
                        for (int mt = 0; mt < 4; ++mt) hfr[sl][mt] = *(const u32x2*)((const bf16*)(ws + WS_HF) + ((size_t)((un * 4 + sl) * 4 + mt) * 64 + lane) * 4);
                }
                *(LAS u32x4*)(tGL + ct * 64 + 8 * cc) = gl0; *(LAS u32x4*)(tGL + (ct + 8) * 64 + 8 * cc) = gl1;
                *(LAS u32x4*)(tAD + ct * 64 + 8 * cc) = ad0; *(LAS u32x4*)(tAD + (ct + 8) * 64 + 8 * cc) = ad1;
                bf16x8 zb[4][2];
#pragma unroll
                for (int sl = 0; sl < 4; ++sl) { RW_ZB(z[sl], zb[sl]);
                    y[sl] = __builtin_amdgcn_mfma_f32_16x16x32_bf16(rf0, zb[sl][0], y[sl], 0, 0, 0); y[sl] = __builtin_amdgcn_mfma_f32_16x16x32_bf16(rf1, zb[sl][1], y[sl], 0, 0, 0); }
#pragma unroll
                for (int e = 0; e < 4; ++e) {
                    float s1 = (y[0][e] + y[1][e]) + (y[2][e] + y[3][e]);
                    s1 += __shfl_xor(s1, 1); s1 += __shfl_xor(s1, 2); s1 += __shfl_xor(s1, 4); s1 += __shfl_xor(s1, 8);
                    const float mean = s1 * (1.0f / 64.0f);
                    float d0 = y[0][e] - mean, d1 = y[1][e] - mean, d2 = y[2][e] - mean, d3 = y[3][e] - mean;
                    float s2 = (d0 * d0 + d1 * d1) + (d2 * d2 + d3 * d3);
                    s2 += __shfl_xor(s2, 1); s2 += __shfl_xor(s2, 2); s2 += __shfl_xor(s2, 4); s2 += __shfl_xor(s2, 8);
                    const float rstd = rsq_f(s2 * (1.0f / 64.0f) + GN_EPS);
                    const float dd[4] = {d0, d1, d2, d3};
#pragma unroll
                    for (int sl = 0; sl < 4; ++sl) { const int ti_ = (4 * g + e) * 64 + 16 * sl + l15;
                        const float o = dd[sl] * rstd * bf2f(tGL[ti_]) + bf2f(tAD[ti_]); tOUT[ti_] = (bf16)f2bf(o); }
                }
                { bf16* cp = CAT + (m0 + ct) * 1024 + 512 + h * 64 + 8 * cc;
                  *(u32x4*)cp = *(const LAS u32x4*)(tOUT + ct * 64 + 8 * cc); *(u32x4*)(cp + 8 * 1024) = *(const LAS u32x4*)(tOUT + (ct + 8) * 64 + 8 * cc); }
                if (j < 3) {
#pragma unroll
                    for (int sl = 0; sl < 4; ++sl)
#pragma unroll
                        for (int mt = 0; mt < 4; ++mt) { const u32x2 hh = hfr[sl][mt];
                            f32x4 a; a[0] = bflo(hh.x); a[1] = bfhi(hh.x); a[2] = bflo(hh.y); a[3] = bfhi(hh.y);
                            a = __builtin_amdgcn_mfma_f32_16x16x32_bf16(gf[mt][0], zb[sl][0], a, 0, 0, 0); a = __builtin_amdgcn_mfma_f32_16x16x32_bf16(gf[mt][1], zb[sl][1], a, 0, 0, 0); z[sl][mt] = a; }
                }
            }
        }
    }
    SEAM(5);
#undef RW_ZB


    if (IN(6)) { PHASE_IDS;
        pg8::DenseSched S; S.o.init_tiles(M / 256, D / 256, G, bid); S.A = (const char*)CAT; S.B = (const char*)Wout_t; S.tstep = (size_t)256 * D * 2;
        EpiBf16Res<false> E{args.in[I_X], X1, D, (float*)(ws + WS_AP + 2 * MiB)}; pg8::gemm_phase(lds, D, S, E, wv0);
    }
    SEAM(6);
    if (IN(7)) { PHASE_IDS;
        pg8::BatchBSched S; S.o.init_tiles(M / 256, D / 256, G, bid); S.A = (const char*)X1; S.B = (const char*)HN; S.tstep = (size_t)256 * D * 2; S.bstep = (size_t)1024 * 1024 * 2;
        EpiSoftmax E{Qb, 0.0625f, (const float*)(ws + WS_AP + 2 * MiB), (LAS float*)(lds + RING_BYTES + 1024), (LAS float*)(lds + RING_BYTES + 1024 + 4096)};
        pg8::gemm_phase(lds, D, S, E, wv0);
    }
    SEAM(7);
    if (IN(8)) { PHASE_IDS;
        pg8::BatchBSched S; S.o.init_tiles(M / 256, D / 256, G, bid); S.A = (const char*)Qb; S.B = (const char*)(HN + (size_t)4 * 1024 * 1024); S.tstep = (size_t)256 * D * 2; S.bstep = (size_t)1024 * 1024 * 2;
        EpiBf16Res<true> E{X1, X2, D, nullptr}; pg8::gemm_phase(lds, D, S, E, wv0);
    }
    SEAM(8);
    if (IN(9)) { PHASE_IDS;
        for (int cid = tid; cid < 2 * NE * 128; cid += NTHREADS) { const int t = cid >> 12, row = (cid >> 7) & 31, c = cid & 127;
            *(LAS u32x4*)(lds + t * 65536 + row * 2048 + ((c ^ (row & 7)) << 4)) = *(const u32x4*)(WrT + (size_t)t * NE * D + row * D + 8 * c); }
        __syncthreads();
        const int l15 = lane & 15, g = lane >> 4;
        LAS float* LG = (LAS float*)(lds + RING_BYTES + 1024 + wave * 2304);
        const float* gfn = args.in[I_NFFG];
        LAS unsigned* cntl = (LAS unsigned*)(lds + RING_BYTES + 640);
        for (int t0 = 0; t0 < M / 16; t0 += G * 4) {
        if (tid < 64) cntl[tid] = 0u;
        __syncthreads();
        if (t0 == 0 && wave >= 4) {
            constexpr int I_GU = 16 * 64;
            for (int r = bid * 4 + (wave - 4); r < CONV_P9; r += G * 4) { const int e = r / I_GU, q = r % I_GU, kb = q / 64, nb = q % 64; const int n0 = 32 * nb;
                const int drow = n0 < 1024 ? (256 * (n0 >> 7) + (n0 & 127)) : (256 * ((n0 - 1024) >> 7) + 128 + ((n0 - 1024) & 127));
                transpose_item_tiled_nolds(args.in[I_WGU] + (size_t)e * D * 2048, 2048, D, Wgu_t + (size_t)e * 2048 * D, 64 * kb, n0, drow, lane); }
        }
        const int tile = t0 + bid * 4 + wave; const bool active = wave < 4 && tile < M / 16;
        int me = 0, lpos = 0, ai = 0; float mg = 0.f;
        if (active) {
            const int m0 = tile * 16;
            const bf16* xrow = X2 + (size_t)(m0 + l15) * D + 8 * g;
            float ss = 0.f;
#pragma unroll 8
            for (int ks = 0; ks < 32; ++ks) { const u32x4 xw = *(const u32x4*)(xrow + 32 * ks);
#pragma unroll
                for (int q = 0; q < 4; ++q) { const float a = bflo(xw[q]), c = bfhi(xw[q]); ss += a * a + c * c; } }
            ss += __shfl_xor(ss, 16); ss += __shfl_xor(ss, 32);
            const float rstd = rsq_f(ss * (1.f / D) + EPS);
            f32x4 acc0 = (f32x4){0.f, 0.f, 0.f, 0.f}, acc1 = acc0;
            unsigned char* hrow = (unsigned char*)HN + (size_t)(m0 + l15) * D + 8 * g;
#pragma unroll 2
            for (int ks = 0; ks < 32; ++ks) {
                const f32x4 g0 = *(const f32x4*)(gfn + 32 * ks + 8 * g), g1 = *(const f32x4*)(gfn + 32 * ks + 8 * g + 4);
                const u32x4 xw = *(const u32x4*)(xrow + 32 * ks);
                float hf[8];
#pragma unroll
                for (int q = 0; q < 4; ++q) { hf[2 * q] = bflo(xw[q]) * rstd * (q < 2 ? g0[2 * q] : g1[2 * q - 4]); hf[2 * q + 1] = bfhi(xw[q]) * rstd * (q < 2 ? g0[2 * q + 1] : g1[2 * q - 3]); }
                u32x4 hi, lo;
#pragma unroll
                for (int q = 0; q < 4; ++q) { hi[q] = pk2(hf[2 * q], hf[2 * q + 1]); lo[q] = pk2(hf[2 * q] - bflo(hi[q]), hf[2 * q + 1] - bfhi(hi[q])); }
                { u32x2 h8; h8.x = pk4_fp8(hf[0], hf[1], hf[2], hf[3]); h8.y = pk4_fp8(hf[4], hf[5], hf[6], hf[7]); *(u32x2*)(hrow + 32 * ks) = h8; }
                const bf16x8 ah = __builtin_bit_cast(bf16x8, hi), al = __builtin_bit_cast(bf16x8, lo);
                const int c = 4 * ks + g;
#pragma unroll
                for (int nt = 0; nt < 2; ++nt) { const int row = 16 * nt + l15; const int off = row * 2048 + ((c ^ (row & 7)) << 4);
                    const bf16x8 bh = *(const LAS bf16x8*)(lds + off), bl = *(const LAS bf16x8*)(lds + 65536 + off);
                    f32x4 a = nt ? acc1 : acc0;
                    a = __builtin_amdgcn_mfma_f32_16x16x32_bf16(ah, bh, a, 0, 0, 0); a = __builtin_amdgcn_mfma_f32_16x16x32_bf16(ah, bl, a, 0, 0, 0); a = __builtin_amdgcn_mfma_f32_16x16x32_bf16(al, bh, a, 0, 0, 0);
                    if (nt) acc1 = a; else acc0 = a; }
            }
            { const float b0 = args.in[I_BR][l15], b1 = args.in[I_BR][16 + l15];
#pragma unroll
              for (int j = 0; j < 4; ++j) { LG[(4 * g + j) * 33 + l15] = acc0[j] + b0; LG[(4 * g + j) * 33 + 16 + l15] = acc1[j] + b1; } }
            const int rrow = lane >> 2, qq = lane & 3;
            float tv[4] = {-3.0e38f, -3.0e38f, -3.0e38f, -3.0e38f}; int ti[4] = {64, 65, 66, 67};
#define TOP_INS(xv_, xi_) do { float x_ = (xv_); int i_ = (xi_); _Pragma("unroll") for (int p_ = 0; p_ < 4; ++p_) { const bool b_ = x_ > tv[p_] || (x_ == tv[p_] && i_ < ti[p_]); \
                const float ov_ = tv[p_]; const int oi_ = ti[p_]; tv[p_] = b_ ? x_ : ov_; ti[p_] = b_ ? i_ : oi_; x_ = b_ ? ov_ : x_; i_ = b_ ? oi_ : i_; } } while (0)
#pragma unroll
            for (int j = 0; j < 8; ++j) TOP_INS(LG[rrow * 33 + 8 * qq + j], 8 * qq + j);
#pragma unroll
            for (int st = 1; st < 4; st <<= 1) { float pv[4]; int pi[4];
#pragma unroll
                for (int p = 0; p < 4; ++p) { pv[p] = __shfl_xor(tv[p], st); pi[p] = __shfl_xor(ti[p], st); }
#pragma unroll
                for (int p = 0; p < 4; ++p) TOP_INS(pv[p], pi[p]); }
#undef TOP_INS
            const float e1 = __expf(tv[1] - tv[0]), e2 = __expf(tv[2] - tv[0]), e3 = __expf(tv[3] - tv[0]);
            const float inv = rcp_f(1.0f + e1 + e2 + e3);
            me = qq == 0 ? ti[0] : qq == 1 ? ti[1] : qq == 2 ? ti[2] : ti[3];
            mg = (qq == 0 ? 1.0f : qq == 1 ? e1 : qq == 2 ? e2 : e3) * inv;
            lpos = (int)__hip_atomic_fetch_add(cntl + me, 1u, __ATOMIC_RELAXED, __HIP_MEMORY_SCOPE_WORKGROUP);
            ai = (m0 + rrow) * 4 + qq;
        }
        __syncthreads();
        if (tid < NE) { const unsigned c = cntl[tid]; cntl[32 + tid] = c ? atomicAdd(ecnt + 64 * tid, c) : 0u; }
        __syncthreads();
        if (active) { route_e[ai] = me; route_pos[ai] = (int)cntl[32 + me] + lpos; route_g[ai] = mg; }
        __syncthreads();
        }
    }
    SEAM(9);
    if (IN(10)) { PHASE_IDS;
        LAS int* pst = (LAS int*)lds;
        if (tid == 0) { int acc = 0; for (int e = 0; e < NE; ++e) { const int c = (int)__hip_atomic_load(ecnt + 64 * e, __ATOMIC_RELAXED, __HIP_MEMORY_SCOPE_AGENT); pst[e] = acc; pst[64 + e] = c; acc += (c + 255) & ~255; } pst[32] = acc; }
        __syncthreads();
        for (int ai = bid * NTHREADS + tid; ai < NASSIGN; ai += G * NTHREADS) {
            const int e = route_e[ai]; const int row = pst[e] + route_pos[ai]; { u32x2 sg_; sg_.x = (unsigned)ai; sg_.y = __float_as_uint(route_g[ai]); row_sg[row] = sg_; } row_tok[row] = ai >> 2; }
        if (bid < NE) { const int e = bid, c = pst[64 + e], pe = (c + 255) & ~255; for (int p = c + tid; p < pe; p += NTHREADS) { u32x2 sg_; sg_.x = 0xffffffffu; sg_.y = 0u; row_sg[pst[e] + p] = sg_; row_tok[pst[e] + p] = 0; } }
        if (bid == 0 && tid == 0) { int nt = 0; for (int e = 0; e < NE; ++e) { const int n = ((pst[64 + e] + 255) & ~255) >> 8; for (int j = 0; j < n; ++j) tile_tab[16 + nt++] = e; } tile_tab[0] = nt; }
        if (bid == 1 || bid == 2) { const int nt = pst[32] >> 8, nN = bid == 1 ? 8 : 4; int* tab = (int*)(ws + WS_ROUTE + (bid == 1 ? RT_UGU : RT_UDN));
            for (int L = tid; L < nt * nN; L += NTHREADS) { Unit uu; { const int nwg = nt * nN; int wgid = L; { const int q = nwg / 8, r = nwg % 8, xcd = wgid % 8, off = wgid / 8; wgid = (xcd < r ? xcd * (q + 1) : r * (q + 1) + (xcd - r) * q) + off; }
                    const int nig = 8 * nN, gid = wgid / nig, fm = gid * 8, gsz = (nt - fm) < 8 ? (nt - fm) : 8; uu.pm = fm + ((wgid % nig) % gsz); uu.pn = (wgid % nig) / gsz; uu.e = 0; }
                int e = 0; while (e < NE - 1 && (pst[e + 1] >> 8) <= uu.pm) ++e;
                tab[L] = uu.pm | (uu.pn << 12) | (e << 16); } }
        __syncthreads();
    }
    SEAM(10);
    if (IN(11)) {
        const int ntiles = tile_tab[0];
        pg8::MoeGatherSched S; S.o.init_tiles(ntiles, 2048 / 256, G, bid); S.A = (const char*)HN; S.B = (const char*)Wgu_t; S.tile_e = tile_tab + 16; S.utab = (const int*)(ws + WS_ROUTE + RT_UGU); S.rtok = row_tok; S.tstep = (size_t)256 * 1024; S.estep = (size_t)2048 * 1024;
        EpiSwiglu E{ACT, args.in[I_BGU]}; pg8::gemm_phase<EpiSwiglu, pg8::MoeGatherSched, true, true>(lds, 512, S, E, wv0);
        { PHASE_IDS; LAS float* scr = (LAS float*)(lds + wave * 16384); constexpr int I_DN = 16 * 32;
          for (;;) { int c0 = 0; if (lane == 0) c0 = (int)atomicAdd(ctl + CW_CONV, 8u); c0 = __builtin_amdgcn_readfirstlane(c0);
              if (c0 >= NE * I_DN) break;
              for (int r = c0; r < c0 + 8; ++r) { const int e = r / I_DN, q = r % I_DN, kb = q / 32, nb = q % 32;
                  transpose_item_tiled_fp8(args.in[I_WDN] + (size_t)e * DFF * D, D, DFF, (unsigned char*)Wdn_t + (size_t)e * D * DFF, 64 * kb, 32 * nb, 32 * nb, scr, lane); } } }
    }
    SEAM(11);
    if (IN(12)) {
        const int ntiles = tile_tab[0];
        pg8::MoeSched S; S.o.init_tiles(ntiles, D / 256, G, bid); S.A = (const char*)ACT; S.B = (const char*)Wdn_t; S.tile_e = tile_tab + 16; S.utab = (const int*)(ws + WS_ROUTE + RT_UDN); S.tstep = (size_t)256 * 1024; S.estep = (size_t)1024 * 1024;
        EpiDown E{YS, args.in[I_BDN], row_sg}; pg8::gemm_phase<EpiDown, pg8::MoeSched, true, true>(lds, 512, S, E, wv0);
    }
    SEAM(12);
    if (IN(13)) { PHASE_IDS;
        const float* gfin = args.in[I_FNG];
        for (int m = gw; m < M; m += NGW) {
            float v[16]; float s = 0.f;
#pragma unroll
            for (int hf = 0; hf < 2; ++hf) { const u32x4 w = *(const u32x4*)(X2 + (size_t)m * D + 512 * hf + 8 * lane);
#pragma unroll
                for (int q = 0; q < 4; ++q) { v[8 * hf + 2 * q] = bflo(w[q]); v[8 * hf + 2 * q + 1] = bfhi(w[q]); }
#pragma unroll
                for (int k = 0; k < 4; ++k) { const u32x4 y = *(const u32x4*)(YS + (size_t)(m * 4 + k) * D + 512 * hf + 8 * lane);
#pragma unroll
                    for (int q = 0; q < 4; ++q) { v[8 * hf + 2 * q] += bflo(y[q]); v[8 * hf + 2 * q + 1] += bfhi(y[q]); } } }
#pragma unroll
            for (int j = 0; j < 16; ++j) s += v[j] * v[j];
            const float rstd = rsq_f(wave_sum(s) * (1.f / D) + EPS);
#pragma unroll
            for (int hf = 0; hf < 2; ++hf) { const f32x4 g0 = *(const f32x4*)(gfin + 512 * hf + 8 * lane), g1 = *(const f32x4*)(gfin + 512 * hf + 8 * lane + 4);
                float* o = args.out + (size_t)m * D + 512 * hf + 8 * lane;
                *(f32x4*)o = (f32x4){v[8 * hf] * rstd * g0.x, v[8 * hf + 1] * rstd * g0.y, v[8 * hf + 2] * rstd * g0.z, v[8 * hf + 3] * rstd * g0.w};
                *(f32x4*)(o + 4) = (f32x4){v[8 * hf + 4] * rstd * g1.x, v[8 * hf + 5] * rstd * g1.y, v[8 * hf + 6] * rstd * g1.z, v[8 * hf + 7] * rstd * g1.w}; }
        }
    }
#undef IN
#undef SEAM
}

constexpr int N_PHASES = 14;
extern "C" void kernel_launch(void* const* d_in, const int* in_sizes, int n_in, void* d_out, int out_size, void* d_ws, size_t ws_size, hipStream_t stream) {
    static int grid = 0;
    if (grid == 0) {
        if (n_in != 37 || out_size != M * D || ws_size < WS_END) { fprintf(stderr, "kernel_launch: unexpected shapes (n_in %d, out %d, ws %zu); nothing launched\n", n_in, out_size, ws_size); grid = -1; return; }
        int dev = 0, cus = 0, per_cu = 0;
        if (hipGetDevice(&dev) != hipSuccess || hipDeviceGetAttribute(&cus, hipDeviceAttributeMultiprocessorCount, dev) != hipSuccess) { grid = -1; return; }
        if (hipFuncSetAttribute((const void*)fwd, hipFuncAttributeMaxDynamicSharedMemorySize, LDS_BYTES) != hipSuccess) { fprintf(stderr, "kernel_launch: hipFuncSetAttribute failed\n"); grid = -1; return; }
        if (hipOccupancyMaxActiveBlocksPerMultiprocessor(&per_cu, (const void*)fwd, NTHREADS, LDS_BYTES) != hipSuccess || per_cu < 1) fprintf(stderr, "kernel_launch: occupancy query says %d\n", per_cu);
        (void)hipGetLastError();
        grid = cus > 256 ? 256 : cus;
    }
    if (grid < 0) return;
    if (hipMemsetAsync((char*)d_ws + WS_CTL, 0, CTL_ZERO_BYTES, stream) != hipSuccess) return;
    Args a{};
    for (int i = 0; i < 37; ++i) a.in[i] = (const float*)d_in[i];
    a.out = (float*)d_out; a.ws = (unsigned char*)d_ws;
#if MK_ONE_LAUNCH
    a.ph_lo = 0; a.ph_hi = N_PHASES;
    hipLaunchKernelGGL(fwd, dim3(grid), dim3(NTHREADS), LDS_BYTES, stream, a);
#else
    for (int p = 0; p < N_PHASES; ++p) { a.ph_lo = p; a.ph_hi = p + 1; hipLaunchKernelGGL(fwd, dim3(grid), dim3(NTHREADS), LDS_BYTES, stream, a);
#ifdef PROBE_REPEAT_PHASE
        if (p == PROBE_REPEAT_PHASE) hipLaunchKernelGGL(fwd, dim3(grid), dim3(NTHREADS), LDS_BYTES, stream, a);
#endif
    }
#endif
}
```

```cpp
#include <hip/hip_runtime.h>
#include <cstdio>
#include <cstdint>

#ifndef MK_ONE_LAUNCH
#define MK_ONE_LAUNCH 1
#endif

#define DI __device__ __forceinline__
#define GAS __attribute__((address_space(1)))
#define LAS __attribute__((address_space(3)))
typedef unsigned short bf16;
typedef short bf16x8 __attribute__((ext_vector_type(8)));
typedef int v4i __attribute__((ext_vector_type(4)));
typedef int v8i __attribute__((ext_vector_type(8)));
typedef float f32x4 __attribute__((ext_vector_type(4)));
typedef float f32x2 __attribute__((ext_vector_type(2)));
typedef unsigned u32x4 __attribute__((ext_vector_type(4)));
typedef unsigned u32x2 __attribute__((ext_vector_type(2)));

constexpr int D = 1024, NB = 4, SEQ = 4096, M = NB * SEQ;
constexpr int MEML = 256, MROWS = NB * MEML;
constexpr int LRU_W = 512, RW = 512, NH = 8, HD = 64;
constexpr int INW = 2816;
constexpr int XH = 4, XHD = 256;
constexpr int NE = 32, TOPK = 4, DFF = 1024;
constexpr int NASSIGN = M * TOPK;
constexpr int MAXTILES = 288, MAXROWS = MAXTILES * 256;
constexpr float EPS = 1e-6f, GN_EPS = 64e-5f;

DI int fresh_tid_(int wv) { int w = wv; asm volatile("" : "+s"(w)); int l; asm volatile("v_mbcnt_lo_u32_b32 %0, -1, 0\n\tv_mbcnt_hi_u32_b32 %0, -1, %0" : "=v"(l)); return (w << 6) | (l & 63); }
#define fresh_tid() fresh_tid_(wv0)
namespace pg8 {
constexpr int BM = 256, BK = 64, HALF = 128, HTB = HALF * BK * 2, STAGE_BYTES = 8 * HTB, NXCD = 8, WGM = 8;
__host__ __device__ __forceinline__ int lds_byte(int r, int c) { const int st = (r >> 4) * 2 + (c >> 5), rr = r & 15, cc = c & 31, ob = rr * 64 + cc * 2; return st * 1024 + (ob ^ (((ob >> 9) & 1) << 5)); }
__host__ __device__ __forceinline__ void stage_rc(int b, int& R, int& C) { const int st = b / 1024, sb = b % 1024, swz = sb ^ (((sb >> 9) & 1) << 5); R = (st >> 1) * 16 + swz / 64; C = (st & 1) * 32 + (swz % 64) / 2; }
__host__ __device__ __forceinline__ int perm32(int rho) { const int n = rho >> 4, i = rho & 15; return 8 * (i >> 2) + 4 * n + (i & 3); }

struct Unit { int pm, pn, e; };

struct StaticOrder {
    int nM, nN, nwg, G, c;
    __host__ __device__ void init_tiles(int nM_, int nN_, int G_, int c_) { nM = nM_; nN = nN_; nwg = nM * nN; G = G_; c = c_; }
    __host__ __device__ bool next(int i, Unit& u) const {
        const long L = (long)i * G + c; if (L >= nwg) return false;
        int wgid = (int)L; { const int q = nwg / NXCD, r = nwg % NXCD, xcd = wgid % NXCD, off = wgid / NXCD; wgid = (xcd < r ? xcd * (q + 1) : r * (q + 1) + (xcd - r) * q) + off; }
        const int nig = WGM * nN, gid = wgid / nig, fm = gid * WGM, gsz = (nM - fm) < WGM ? (nM - fm) : WGM;
        u.pm = fm + ((wgid % nig) % gsz); u.pn = (wgid % nig) / gsz; u.e = 0; return true;
    }
};
struct DenseSched {
    static constexpr bool GATHER = false, B_TILED = false;
    StaticOrder o; const char* A; const char* B; size_t tstep;
    DI bool next(int i, Unit& u) const { return o.next(i, u); }
    DI const char* a_ptr(const Unit& u) const { return A + (size_t)u.pm * tstep; }
    DI const char* b_ptr(const Unit& u) const { return B + (size_t)u.pn * tstep; }
    DI void a_voff(const Unit&, int K, const int (&R)[2], const int (&C)[2], unsigned (&vo)[2][2]) const {
#pragma unroll
        for (int h = 0; h < 2; ++h)
#pragma unroll
            for (int i = 0; i < 2; ++i) vo[h][i] = (unsigned)((h * HALF + R[i]) * K + C[i]) * 2u; }
};
struct MoeSched {
    static constexpr bool GATHER = false, B_TILED = true;
    StaticOrder o; const char* A; const char* B; const int* tile_e; const int* utab; size_t tstep, estep;
    DI bool next(int i, Unit& u) const { const int L = i * o.G + o.c; if (L >= o.nwg) return false; int en; asm volatile("s_load_dword %0, %1, 0x0\n\ts_waitcnt lgkmcnt(0)" : "=s"(en) : "s"(utab + L) : "memory");     u.pm = en & 0xfff; u.pn = (en >> 12) & 15; u.e = en >> 16; return true; }
    DI const char* a_ptr(const Unit& u) const { return A + (size_t)u.pm * tstep; }
    DI const char* b_ptr(const Unit& u) const { return B + (size_t)u.e * estep + (size_t)u.pn * tstep; }
    DI void a_voff(const Unit&, int K, const int (&R)[2], const int (&C)[2], unsigned (&vo)[2][2]) const {
#pragma unroll
        for (int h = 0; h < 2; ++h)
#pragma unroll
            for (int i = 0; i < 2; ++i) vo[h][i] = (unsigned)((h * HALF + R[i]) * K + C[i]) * 2u; }
};
struct MoeGatherSched {
    static constexpr bool GATHER = true, B_TILED = true;
    StaticOrder o; const char* A; const char* B; const int* tile_e; const int* utab; const int* rtok; size_t tstep, estep;
    DI bool next(int i, Unit& u) const { const int L = i * o.G + o.c; if (L >= o.nwg) return false; int en; asm volatile("s_load_dword %0, %1, 0x0\n\ts_waitcnt lgkmcnt(0)" : "=s"(en) : "s"(utab + L) : "memory");     u.pm = en & 0xfff; u.pn = (en >> 12) & 15; u.e = en >> 16; return true; }
    DI const char* a_ptr(const Unit&) const { return A; }
    DI const char* b_ptr(const Unit& u) const { return B + (size_t)u.e * estep + (size_t)u.pn * tstep; }
    DI void a_voff(const Unit& u, int K, const int (&R)[2], const int (&C)[2], unsigned (&vo)[2][2]) const {
#pragma unroll
        for (int h = 0; h < 2; ++h)
#pragma unroll
            for (int i = 0; i < 2; ++i) vo[h][i] = (unsigned)(rtok[u.pm * BM + h * HALF + R[i]] * K + C[i]) * 2u; }
};

struct BatchBSched {
    static constexpr bool GATHER = false, B_TILED = false;
    StaticOrder o; const char* A; const char* B; size_t tstep, bstep;
    DI bool next(int i, Unit& u) const { return o.next(i, u); }
    DI const char* a_ptr(const Unit& u) const { return A + (size_t)u.pm * tstep; }
    DI const char* b_ptr(const Unit& u) const { return B + (size_t)(u.pm >> 4) * bstep + (size_t)u.pn * tstep; }
    DI void a_voff(const Unit&, int K, const int (&R)[2], const int (&C)[2], unsigned (&vo)[2][2]) const {
#pragma unroll
        for (int h = 0; h < 2; ++h)
#pragma unroll
            for (int i = 0; i < 2; ++i) vo[h][i] = (unsigned)((h * HALF + R[i]) * K + C[i]) * 2u; }
};
template <int MODE> struct FoldSched {
    static constexpr bool GATHER = false, B_TILED = false;
    const char* A; const char* B; int G, c;
    DI bool next(int i, Unit& u) const { const int L = i * G + c; if (L >= 64) return false; u.pm = L >> 2; u.pn = L & 3; u.e = 0; return true; }
    DI const char* a_ptr(const Unit& u) const { const int b = u.pm >> 2, h = u.pm & 3; return A + ((size_t)(MODE == 0 ? b * 256 : u.pn * 256) * 1024 + h * 256) * 2; }
    DI const char* b_ptr(const Unit& u) const { const int b = u.pm >> 2, h = u.pm & 3; return B + ((size_t)(MODE == 0 ? u.pn * 256 : b * 256) * 1024 + h * 256) * 2; }
    DI void a_voff(const Unit&, int K, const int (&R)[2], const int (&C)[2], unsigned (&vo)[2][2]) const {
#pragma unroll
        for (int h = 0; h < 2; ++h)
#pragma unroll
            for (int i = 0; i < 2; ++i) vo[h][i] = (unsigned)((h * HALF + R[i]) * K + C[i]) * 2u; }
};

DI unsigned cvt_pk_bf16(float lo, float hi) { unsigned r; asm volatile("v_cvt_pk_bf16_f32 %0, %1, %2" : "=v"(r) : "v"(lo), "v"(hi)); return r; }

template <class Epi, class Sched, bool ALIGN_EPI = true, bool FP8 = false>
DI void gemm_phase(LAS unsigned char* lds, const int K, const Sched& S, const Epi& E, const int wv0, const int ldp = 0) {
    const int ld = ldp ? ldp : K;
    const int tid = fresh_tid(), wid = __builtin_amdgcn_readfirstlane(tid >> 6), lane = tid & 63, wr = wid >> 2, wc = wid & 3, fr = lane & 15, fq = lane >> 4;
    const int nt = K / BK;
    constexpr bool GA = Sched::GATHER, BT = Sched::B_TILED;
    unsigned voffA[2][2], voffAn[2][2], voffB[2];
#pragma unroll
    for (int i = 0; i < 2; ++i) { int R, C; stage_rc(tid * 16 + i * 8192, R, C); const int Rb = Epi::PERM ? ((R & ~31) + perm32(R & 31)) : R;
        voffB[i] = BT ? (unsigned)(tid * 16 + i * 8192) : (unsigned)(Rb * ld + C) * 2u; }
#define PG8_AVOFF(unit, dst) do { int sR[2], sC[2]; const int t2_ = fresh_tid(); stage_rc(t2_ * 16, sR[0], sC[0]); stage_rc(t2_ * 16 + 8192, sR[1], sC[1]); S.a_voff(unit, ld, sR, sC, dst); } while (0)
    const size_t kstep = (size_t)(BK * 2);
    const size_t hstep = (size_t)HALF * ld * 2;
    const size_t kstepB = BT ? (size_t)(2 * HTB) : kstep, hstepB = BT ? (size_t)HTB : hstep;
    const unsigned ldsw = (unsigned)wid * 1024u;
    unsigned aoffv = (unsigned)(size_t)lds + (unsigned)lds_byte(wr * 64 + fr, fq * 8), boffv = (unsigned)(size_t)lds + (unsigned)(4 * HTB) + (unsigned)lds_byte(wc * 32 + fr, fq * 8);
    asm volatile("" : "+v"(aoffv), "+v"(boffv));
    const size_t dB = BT ? (size_t)8192 : (size_t)64 * ld * 2, dA = (size_t)64 * ld * 2;
#define PG8_SA(b, h) (((b) * 2 + (h)) * HTB)
#define PG8_SB(b, h) ((4 + (b) * 2 + (h)) * HTB)
    const unsigned ldsbase = (unsigned)__builtin_amdgcn_readfirstlane((int)((unsigned)(size_t)lds + ldsw));
#define PG8_STAGE1(bufoff, gptr, vo, i_) do { const unsigned m0v_ = ldsbase + (unsigned)(bufoff) + (unsigned)(i_) * 8192u; \
        asm volatile("s_mov_b32 m0, %2\n\ts_nop 0\n\tglobal_load_lds_dwordx4 %0, %1" :: "v"(vo), "s"((const char*)(gptr)), "s"(m0v_) : "memory", "m0"); } while (0)
#define PG8_STAGE(bufoff, gbase, voff) do { PG8_STAGE1(bufoff, gbase, (voff)[0], 0); PG8_STAGE1(bufoff, gbase, (voff)[1], 1); } while (0)
#define PG8_STAGE_D(bufoff, gbase, vo, delta) do { PG8_STAGE1(bufoff, gbase, vo, 0); PG8_STAGE1(bufoff, (const char*)(gbase) + (delta), vo, 1); } while (0)
#define PG8_LDA(dst, b, h) do { if constexpr (FP8) { _Pragma("unroll") for (int m = 0; m < 4; ++m) { const LAS v4i* p_ = (const LAS v4i*)((LAS unsigned char*)(size_t)aoffv + PG8_SA(b, h) + m * 2048); dst##8[m] = __builtin_shufflevector(p_[0], p_[64], 0, 1, 2, 3, 4, 5, 6, 7); } } \
        else { _Pragma("unroll") for (int m = 0; m < 4; ++m) _Pragma("unroll") for (int k = 0; k < 2; ++k) dst[m][k] = *(const LAS bf16x8*)((LAS unsigned char*)(size_t)aoffv + PG8_SA(b, h) + m * 2048 + k * 1024); } } while (0)
#define PG8_LDB(dst, b, h) do { if constexpr (FP8) { _Pragma("unroll") for (int n = 0; n < 2; ++n) { const LAS v4i* p_ = (const LAS v4i*)((LAS unsigned char*)(size_t)boffv + (PG8_SB(b, h) - 4 * HTB) + n * 2048); dst##8[n] = __builtin_shufflevector(p_[0], p_[64], 0, 1, 2, 3, 4, 5, 6, 7); } } \
        else { _Pragma("unroll") for (int n = 0; n < 2; ++n) _Pragma("unroll") for (int k = 0; k < 2; ++k) dst[n][k] = *(const LAS bf16x8*)((LAS unsigned char*)(size_t)boffv + (PG8_SB(b, h) - 4 * HTB) + n * 2048 + k * 1024); } } while (0)
#define PG8_MMA(ai, bj, At, Bt) do { __builtin_amdgcn_s_setprio(1); \
        if constexpr (FP8) {   \
            _Pragma("unroll") for (int m = 0; m < 4; ++m) _Pragma("unroll") for (int n = 0; n < 2; ++n) \
                acc[ai][bj][m][n] = __builtin_amdgcn_mfma_scale_f32_16x16x128_f8f6f4(Bt##8[n], At##8[m], acc[ai][bj][m][n], 0, 0, 0, 0, 0, 0); } \
        else { _Pragma("unroll") for (int m = 0; m < 4; ++m) _Pragma("unroll") for (int n = 0; n < 2; ++n) _Pragma("unroll") for (int k = 0; k < 2; ++k) \
            acc[ai][bj][m][n] = __builtin_amdgcn_mfma_f32_16x16x32_bf16(Bt[n][k], At[m][k], acc[ai][bj][m][n], 0, 0, 0); } \
        __builtin_amdgcn_s_setprio(0); } while (0)
#define PG8_WAIT_V(n) asm volatile("s_waitcnt vmcnt(" #n ")" ::: "memory")
#define PG8_WAIT_L(n) asm volatile("s_waitcnt lgkmcnt(" #n ")" ::: "memory")
#define PG8_BAR __builtin_amdgcn_s_barrier()
#define PG8_SCHED __builtin_amdgcn_sched_barrier(0)
    Unit cur, nxt; int ui = 0;
    if (!S.next(0, cur)) return;
    f32x4 acc[2][2][4][2];
#pragma unroll
    for (int a = 0; a < 2; ++a)
#pragma unroll
        for (int b = 0; b < 2; ++b)
#pragma unroll
            for (int m = 0; m < 4; ++m)
#pragma unroll
                for (int n = 0; n < 2; ++n) acc[a][b][m][n] = (f32x4){0.f, 0.f, 0.f, 0.f};
    bf16x8 At[4][2], B0[2][2], B1[2][2]; v8i At8[4], B08[2], B18[2];
    const char* cA = S.a_ptr(cur); const char* cB = S.b_ptr(cur);
    PG8_AVOFF(cur, voffA);
#define PG8_STAGE_A(bufoff, kbase, h, vo) do { if constexpr (GA) { PG8_STAGE(bufoff, kbase, (vo)[h]); } else { PG8_STAGE_D(bufoff, (kbase) + (h) * hstep, voffA[0][0], dA); } } while (0)
    PG8_STAGE_D(PG8_SB(0, 0), cB, voffB[0], dB); PG8_STAGE_D(PG8_SB(0, 1), cB + hstepB, voffB[0], dB); PG8_STAGE_A(PG8_SA(0, 0), cA, 0, voffA); PG8_STAGE_A(PG8_SA(0, 1), cA, 1, voffA);
    if (wr == 1) PG8_BAR;
    PG8_WAIT_V(2); PG8_BAR;
    PG8_STAGE_D(PG8_SB(1, 0), cB + kstepB, voffB[0], dB); PG8_STAGE_A(PG8_SA(1, 0), cA + kstep, 0, voffA); PG8_STAGE_D(PG8_SB(1, 1), cB + hstepB + kstepB, voffB[0], dB);
    PG8_WAIT_V(6); PG8_BAR;
    for (;;) {
        const bool has_next = S.next(ui + 1, nxt);
        const char* nA = has_next ? S.a_ptr(nxt) : cA; const char* nB = has_next ? S.b_ptr(nxt) : cB;
        if constexpr (GA) { if (has_next) PG8_AVOFF(nxt, voffAn);
            else {
#pragma unroll
                for (int h = 0; h < 2; ++h)
#pragma unroll
                    for (int i = 0; i < 2; ++i) voffAn[h][i] = voffA[h][i]; } }
#pragma unroll 1
        for (int t = 0; t < nt; t += 2) {
            const bool last = (t == nt - 2);
            const char* a1 = cA + (size_t)(t + 1) * kstep;
            const char* a2 = last ? nA : cA + (size_t)(t + 2) * kstep; const char* b2 = last ? nB : cB + (size_t)(t + 2) * kstepB;
            const char* a3 = a2 + kstep; const char* b3 = b2 + kstepB;
            PG8_LDB(B0, 0, 0); PG8_LDB(B1, 0, 1); PG8_SCHED; PG8_LDA(At, 0, 0); PG8_STAGE_A(PG8_SA(1, 1), a1, 1, voffA);
            if constexpr (GA) { if (last) {
#pragma unroll
                for (int h = 0; h < 2; ++h)
#pragma unroll
                    for (int i = 0; i < 2; ++i) voffA[h][i] = voffAn[h][i]; } }
            PG8_WAIT_V(8); PG8_WAIT_L(0); PG8_BAR; PG8_MMA(0, 0, At, B0); PG8_MMA(0, 1, At, B1); PG8_BAR; PG8_SCHED;
            PG8_LDA(At, 0, 1); PG8_STAGE_D(PG8_SB(0, 0), b2, voffB[0], dB); PG8_STAGE_D(PG8_SB(0, 1), b2 + hstepB, voffB[0], dB); PG8_STAGE_A(PG8_SA(0, 0), a2, 0, voffA);
            PG8_WAIT_V(8); PG8_WAIT_L(0); PG8_BAR; PG8_MMA(1, 0, At, B0); PG8_MMA(1, 1, At, B1); PG8_BAR; PG8_SCHED;
            PG8_LDB(B0, 1, 0); PG8_LDB(B1, 1, 1); PG8_SCHED; PG8_LDA(At, 1, 0); PG8_STAGE_A(PG8_SA(0, 1), a2, 1, voffA);
            PG8_WAIT_V(8); PG8_WAIT_L(0); PG8_BAR; PG8_MMA(0, 0, At, B0); PG8_MMA(0, 1, At, B1); PG8_BAR; PG8_SCHED;
            PG8_LDA(At, 1, 1); PG8_STAGE_D(PG8_SB(1, 0), b3, voffB[0], dB); PG8_STAGE_D(PG8_SB(1, 1), b3 + hstepB, voffB[0], dB); PG8_STAGE_A(PG8_SA(1, 0), a3, 0, voffA);
            PG8_WAIT_V(8); PG8_WAIT_L(0); PG8_BAR; PG8_MMA(1, 0, At, B0); PG8_MMA(1, 1, At, B1); PG8_BAR; PG8_SCHED;
        }
        if constexpr (ALIGN_EPI) { if (wr == 0) PG8_BAR; }
        { Unit ue = cur; ue.pm = __builtin_amdgcn_readfirstlane(ue.pm); ue.pn = __builtin_amdgcn_readfirstlane(ue.pn); ue.e = __builtin_amdgcn_readfirstlane(ue.e); asm volatile("" : "+s"(ue.pm), "+s"(ue.pn), "+s"(ue.e));
          const int t3_ = fresh_tid(); const int fr_ = t3_ & 15, fq_ = (t3_ & 63) >> 4;
          E(acc, ue, wr, wc, fr_, fq_); }
        if (!has_next) break;
#pragma unroll
        for (int a = 0; a < 2; ++a)
#pragma unroll
            for (int b = 0; b < 2; ++b)
#pragma unroll
                for (int m = 0; m < 4; ++m)
#pragma unroll
                    for (int n = 0; n < 2; ++n) acc[a][b][m][n] = (f32x4){0.f, 0.f, 0.f, 0.f};
        cur = nxt; cA = nA; cB = nB; ++ui;
        if constexpr (ALIGN_EPI) { if (wr == 1) PG8_BAR; }
    }
    PG8_WAIT_V(0);
    if constexpr (!ALIGN_EPI) { if (wr == 0) PG8_BAR; }
    PG8_BAR;
#undef PG8_SA
#undef PG8_SB
#undef PG8_STAGE
#undef PG8_STAGE1
#undef PG8_STAGE_D
#undef PG8_STAGE_A
#undef PG8_AVOFF
#undef PG8_LDA
#undef PG8_LDB
#undef PG8_MMA
#undef PG8_WAIT_V
#undef PG8_WAIT_L
#undef PG8_BAR
#undef PG8_SCHED
}
}
using pg8::Unit;
using pg8::cvt_pk_bf16;

DI float bflo(unsigned w) { return __uint_as_float(w << 16); }
DI float bfhi(unsigned w) { return __uint_as_float(w & 0xffff0000u); }
DI float bf2f(bf16 b) { return __uint_as_float(((unsigned)b) << 16); }
typedef __bf16 hwbf2 __attribute__((ext_vector_type(2)));
DI unsigned pk2(float lo, float hi) { const f32x2 v = {lo, hi}; return __builtin_bit_cast(unsigned, __builtin_convertvector(v, hwbf2)); }
DI unsigned f2bf(float f) { return pk2(f, 0.f) & 0xffffu; }
DI float rcp_f(float x) { return __builtin_amdgcn_rcpf(x); }
DI float rsq_f(float x) { return __builtin_amdgcn_rsqf(x); }
DI float sigmoid_f(float x) { return rcp_f(1.0f + __expf(-x)); }
DI float tanh_fast(float x) { return 1.0f - 2.0f * rcp_f(__expf(2.0f * x) + 1.0f); }
DI float softplus_f(float x) { return fmaxf(x, 0.f) + __logf(1.0f + __expf(-fabsf(x))); }
DI float softplus_fast(float x) { return fmaxf(x, 0.f) + __logf(1.0f + __expf(-fabsf(x))); }
DI float gelu_tanh_f(float x) { const float u = 0.7978845608028654f * (x + 0.044715f * x * x * x); return 0.5f * x * (1.0f + tanh_fast(u)); }
DI float wave_sum(float v) {
#pragma unroll
    for (int o = 1; o < 64; o <<= 1) v += __shfl_xor(v, o);
    return v;
}

DI unsigned pk4_fp8(float a, float b, float c, float d) { int w = 0; w = __builtin_amdgcn_cvt_pk_fp8_f32(a, b, w, false); w = __builtin_amdgcn_cvt_pk_fp8_f32(c, d, w, true); return (unsigned)w; }
struct EpiBf16Plain {
    static constexpr bool PERM = true;
    bf16* O; int ldc; float scale;
    DI void operator()(const f32x4 (&acc)[2][2][4][2], const Unit& u, int wr, int wc, int fr, int fq) const {
        const int row0 = u.pm * 256 + wr * 64 + fr, col0 = u.pn * 256 + wc * 32 + 8 * fq;
#pragma unroll
        for (int ai = 0; ai < 2; ++ai)
#pragma unroll
            for (int m = 0; m < 4; ++m) { bf16* rowp = O + (size_t)(row0 + ai * 128 + m * 16) * ldc + col0;
#pragma unroll
                for (int bj = 0; bj < 2; ++bj) { const f32x4 v0 = acc[ai][bj][m][0] * scale, v1 = acc[ai][bj][m][1] * scale;
                    u32x4 w; w.x = cvt_pk_bf16(v0[0], v0[1]); w.y = cvt_pk_bf16(v0[2], v0[3]); w.z = cvt_pk_bf16(v1[0], v1[1]); w.w = cvt_pk_bf16(v1[2], v1[3]);
                    *(u32x4*)(rowp + bj * 128) = w; } }
    }
};
template <int MODE> struct EpiFold {
    static constexpr bool PERM = true;
    bf16* O;
    DI void operator()(const f32x4 (&acc)[2][2][4][2], const Unit& u, int wr, int wc, int fr, int fq) const {
        const int b = u.pm >> 2, h = u.pm & 3;
        const int rbase = MODE == 0 ? h * 256 : u.pn * 256, cbase = MODE == 0 ? u.pn * 256 : h * 256;
        const unsigned boff = (unsigned)b * 1024u * 1024u + (unsigned)(rbase + wr * 64 + fr) * 1024u + (unsigned)(cbase + wc * 32 + 8 * fq);
#pragma unroll
        for (int ai = 0; ai < 2; ++ai)
#pragma unroll
            for (int m = 0; m < 4; ++m) { bf16* rowp = O + (boff + (unsigned)(ai * 128 + m * 16) * 1024u);
#pragma unroll
                for (int bj = 0; bj < 2; ++bj) { const f32x4 v0 = acc[ai][bj][m][0], v1 = acc[ai][bj][m][1];
                    u32x4 w; w.x = cvt_pk_bf16(v0[0], v0[1]); w.y = cvt_pk_bf16(v0[2], v0[3]); w.z = cvt_pk_bf16(v1[0], v1[1]); w.w = cvt_pk_bf16(v1[2], v1[3]);
                    *(u32x4*)(rowp + bj * 128) = w; } }
    }
};
struct EpiSoftmax {
    static constexpr bool PERM = true;
    bf16* O; float scale; const float* RS; LAS float* XM; LAS float* XS;
    DI void operator()(const f32x4 (&acc)[2][2][4][2], const Unit& u, int wr, int wc, int fr, int fq) const {
        const int row0 = u.pm * 256 + wr * 64 + fr, col0 = u.pn * 256 + wc * 32 + 8 * fq;
        float sc[2][4];
#pragma unroll
        for (int ai = 0; ai < 2; ++ai)
#pragma unroll
            for (int m = 0; m < 4; ++m) { const int r = row0 + ai * 128 + m * 16; const f32x4* rp = (const f32x4*)(RS + (size_t)r * 16);
                const f32x4 p0 = rp[0], p1 = rp[1], p2 = rp[2], p3 = rp[3];
                const float ss = ((p0[0] + p0[1]) + (p0[2] + p0[3])) + ((p1[0] + p1[1]) + (p1[2] + p1[3])) + ((p2[0] + p2[1]) + (p2[2] + p2[3])) + ((p3[0] + p3[1]) + (p3[2] + p3[3]));
                sc[ai][m] = scale * __builtin_amdgcn_rsqf(ss * (1.0f / 1024.0f) + 1e-6f);
                float mm = -3.0e38f;
#pragma unroll
                for (int bj = 0; bj < 2; ++bj)
#pragma unroll
                    for (int n = 0; n < 2; ++n) { const f32x4 v = acc[ai][bj][m][n]; mm = fmaxf(mm, fmaxf(fmaxf(v[0], v[1]), fmaxf(v[2], v[3]))); }
                mm *= sc[ai][m];
                mm = fmaxf(mm, __shfl_xor(mm, 16)); mm = fmaxf(mm, __shfl_xor(mm, 32));
                if (fq == 0) XM[(ai * 128 + wr * 64 + m * 16 + fr) * 4 + wc] = mm; }
        asm volatile("s_waitcnt lgkmcnt(0)" ::: "memory"); __builtin_amdgcn_s_barrier(); asm volatile("" ::: "memory");
        f32x4 (&pa)[2][2][4][2] = const_cast<f32x4 (&)[2][2][4][2]>(acc);
#pragma unroll
        for (int ai = 0; ai < 2; ++ai)
#pragma unroll
            for (int m = 0; m < 4; ++m) { const int lr = ai * 128 + wr * 64 + m * 16 + fr; const f32x4 q = *(const LAS f32x4*)(XM + lr * 4);
                const float mxr = fmaxf(fmaxf(q[0], q[1]), fmaxf(q[2], q[3])); float sm = 0.f;
#pragma unroll
                for (int bj = 0; bj < 2; ++bj)
#pragma unroll
                    for (int n = 0; n < 2; ++n)
#pragma unroll
                        for (int j = 0; j < 4; ++j) { const float p = __expf(acc[ai][bj][m][n][j] * sc[ai][m] - mxr); pa[ai][bj][m][n][j] = p; sm += p; }
                sm += __shfl_xor(sm, 16); sm += __shfl_xor(sm, 32);
                if (fq == 0) XS[lr * 4 + wc] = sm; }
        asm volatile("s_waitcnt lgkmcnt(0)" ::: "memory"); __builtin_amdgcn_s_barrier(); asm volatile("" ::: "memory");
#pragma unroll
        for (int ai = 0; ai < 2; ++ai)
#pragma unroll
            for (int m = 0; m < 4; ++m) { const int lr = ai * 128 + wr * 64 + m * 16 + fr; const f32x4 q = *(const LAS f32x4*)(XS + lr * 4);
                const float inv = __builtin_amdgcn_rcpf((q[0] + q[1]) + (q[2] + q[3]));
                bf16* rowp = O + (size_t)(row0 + ai * 128 + m * 16) * 1024 + col0;
#pragma unroll
                for (int bj = 0; bj < 2; ++bj) { const f32x4 v0 = pa[ai][bj][m][0] * inv, v1 = pa[ai][bj][m][1] * inv;
                    u32x4 w; w.x = cvt_pk_bf16(v0[0], v0[1]); w.y = cvt_pk_bf16(v0[2], v0[3]); w.z = cvt_pk_bf16(v1[0], v1[1]); w.w = cvt_pk_bf16(v1[2], v1[3]);
                    *(u32x4*)(rowp + bj * 128) = w; } }
        asm volatile("s_waitcnt lgkmcnt(0)" ::: "memory"); __builtin_amdgcn_s_barrier(); asm volatile("" ::: "memory");
    }
};
struct EpiBf16RowNorm {
    static constexpr bool PERM = true;
    bf16* O; int ldc; float scale; const float* RS;
    DI void operator()(const f32x4 (&acc)[2][2][4][2], const Unit& u, int wr, int wc, int fr, int fq) const {
        const int row0 = u.pm * 256 + wr * 64 + fr, col0 = u.pn * 256 + wc * 32 + 8 * fq;
#pragma unroll
        for (int ai = 0; ai < 2; ++ai)
#pragma unroll
            for (int m = 0; m < 4; ++m) { const int r = row0 + ai * 128 + m * 16; const f32x4* rp = (const f32x4*)(RS + (size_t)r * 16);
                const f32x4 p0 = rp[0], p1 = rp[1], p2 = rp[2], p3 = rp[3];
                const float ss = ((p0[0] + p0[1]) + (p0[2] + p0[3])) + ((p1[0] + p1[1]) + (p1[2] + p1[3])) + ((p2[0] + p2[1]) + (p2[2] + p2[3])) + ((p3[0] + p3[1]) + (p3[2] + p3[3]));
                const float sc = scale * __builtin_amdgcn_rsqf(ss * (1.0f / 1024.0f) + 1e-6f);
                bf16* rowp = O + (size_t)r * ldc + col0;
#pragma unroll
                for (int bj = 0; bj < 2; ++bj) { const f32x4 v0 = acc[ai][bj][m][0] * sc, v1 = acc[ai][bj][m][1] * sc;
                    u32x4 w; w.x = cvt_pk_bf16(v0[0], v0[1]); w.y = cvt_pk_bf16(v0[2], v0[3]); w.z = cvt_pk_bf16(v1[0], v1[1]); w.w = cvt_pk_bf16(v1[2], v1[3]);
                    *(u32x4*)(rowp + bj * 128) = w; } }
    }
};
template <bool RES_BF16> struct EpiBf16Res {
    static constexpr bool PERM = true;
    const void* Rz; bf16* O; int ldc; float* RS;
    DI void operator()(const f32x4 (&acc)[2][2][4][2], const Unit& u, int wr, int wc, int fr, int fq) const {
        const int row0 = u.pm * 256 + wr * 64 + fr, col0 = u.pn * 256 + wc * 32 + 8 * fq;
#pragma unroll
        for (int ai = 0; ai < 2; ++ai) {
            u32x4 rwb[4][2]; f32x4 rf0[4][2], rf1[4][2];
#pragma unroll
            for (int m = 0; m < 4; ++m) { const size_t off = (size_t)(row0 + ai * 128 + m * 16) * ldc + col0;
#pragma unroll
                for (int bj = 0; bj < 2; ++bj) {
                    if (RES_BF16) rwb[m][bj] = *(const u32x4*)((const bf16*)Rz + off + bj * 128);
                    else { rf0[m][bj] = *(const f32x4*)((const float*)Rz + off + bj * 128); rf1[m][bj] = *(const f32x4*)((const float*)Rz + off + bj * 128 + 4); } } }
#pragma unroll
            for (int m = 0; m < 4; ++m) { const size_t off = (size_t)(row0 + ai * 128 + m * 16) * ldc + col0; float ssq = 0.f;
#pragma unroll
                for (int bj = 0; bj < 2; ++bj) { f32x4 r0, r1;
                    if (RES_BF16) { const u32x4 rw = rwb[m][bj]; r0 = (f32x4){bflo(rw.x), bfhi(rw.x), bflo(rw.y), bfhi(rw.y)}; r1 = (f32x4){bflo(rw.z), bfhi(rw.z), bflo(rw.w), bfhi(rw.w)}; }
                    else { r0 = rf0[m][bj]; r1 = rf1[m][bj]; }
                    const f32x4 v0 = r0 + acc[ai][bj][m][0], v1 = r1 + acc[ai][bj][m][1];
                    ssq += (v0[0] * v0[0] + v0[1] * v0[1]) + (v0[2] * v0[2] + v0[3] * v0[3]) + (v1[0] * v1[0] + v1[1] * v1[1]) + (v1[2] * v1[2] + v1[3] * v1[3]);
                    u32x4 w; w.x = cvt_pk_bf16(v0[0], v0[1]); w.y = cvt_pk_bf16(v0[2], v0[3]); w.z = cvt_pk_bf16(v1[0], v1[1]); w.w = cvt_pk_bf16(v1[2], v1[3]);
                    *(u32x4*)(O + off + bj * 128) = w; }
                if (RS) { ssq += __shfl_xor(ssq, 16); ssq += __shfl_xor(ssq, 32); if (fq == 0) RS[(size_t)(row0 + ai * 128 + m * 16) * 16 + u.pn * 4 + wc] = ssq; } } }
    }
};
struct EpiLora {
    static constexpr bool PERM = false;
    float* LWp; bf16* AAp; bf16* GGp; const float* w0; const float* a0;
    DI void operator()(const f32x4 (&acc)[2][2][4][2], const Unit& u, int wr, int wc, int fr, int fq) const {
        const int kind = u.pn >> 1;
        const int row0 = u.pm * 256 + wr * 64 + fr, col0 = (u.pn & 1) * 256 + wc * 32 + 4 * fq;
#pragma unroll
        for (int bj = 0; bj < 2; ++bj)
#pragma unroll
            for (int n = 0; n < 2; ++n) {
                const int c = col0 + bj * 128 + n * 16;
                f32x4 bias = (f32x4){0.f, 0.f, 0.f, 0.f};
                if (kind == 0) bias = *(const f32x4*)(w0 + c); else if (kind == 1) bias = *(const f32x4*)(a0 + c);
#pragma unroll
                for (int ai = 0; ai < 2; ++ai)
#pragma unroll
                    for (int m = 0; m < 4; ++m) {
                        f32x4 v = acc[ai][bj][m][n] + bias;
                        if (kind == 0) {
#pragma unroll
                            for (int j = 0; j < 4; ++j) { const float w = -softplus_fast(-v[j]) - 0.5f; v[j] = -__expf(w);     }
                        } else if (kind == 1) {
#pragma unroll
                            for (int j = 0; j < 4; ++j) v[j] = sigmoid_f(v[j]);
                        }
                        const size_t o_ = (size_t)(row0 + ai * 128 + m * 16) * 512 + c;
                        if (kind == 0) *(f32x4*)(LWp + o_) = v;
                        else { u32x2 w_; w_.x = cvt_pk_bf16(v[0], v[1]); w_.y = cvt_pk_bf16(v[2], v[3]); *(u32x2*)((kind == 1 ? AAp : GGp) + o_) = w_; }
                    }
            }
    }
};
struct EpiSwiglu {
    static constexpr bool PERM = true;
    bf16* ACT; const float* b_gu;
    DI void operator()(const f32x4 (&acc)[2][2][4][2], const Unit& u, int wr, int wc, int fr, int fq) const {
        const int row0 = u.pm * 256 + wr * 64 + fr, j0 = u.pn * 128 + wc * 32 + 8 * fq;
        const float* bg = b_gu + (size_t)u.e * 2048 + j0; const float* bu = bg + 1024;
        const f32x4 bg0 = *(const f32x4*)bg, bg1 = *(const f32x4*)(bg + 4), bu0 = *(const f32x4*)bu, bu1 = *(const f32x4*)(bu + 4);
#pragma unroll
        for (int ai = 0; ai < 2; ++ai)
#pragma unroll
            for (int m = 0; m < 4; ++m) {
                float o[8];
#pragma unroll
                for (int n = 0; n < 2; ++n) { const f32x4 g4 = acc[ai][0][m][n] * 0.015625f + (n ? bg1 : bg0), u4 = acc[ai][1][m][n] * 0.015625f + (n ? bu1 : bu0);
#pragma unroll
                    for (int j = 0; j < 4; ++j) { const float g = fminf(g4[j], 7.0f), up = fminf(fmaxf(u4[j], -7.0f), 7.0f); o[n * 4 + j] = (up + 1.0f) * (g * sigmoid_f(1.702f * g)); } }
                u32x2 w; w.x = pk4_fp8(o[0], o[1], o[2], o[3]); w.y = pk4_fp8(o[4], o[5], o[6], o[7]);
                *(u32x2*)((unsigned char*)ACT + (size_t)(row0 + ai * 128 + m * 16) * 1024 + j0) = w;
            }
    }
};
struct EpiDown {
    static constexpr bool PERM = true;
    bf16* YS; const float* b_dn; const u32x2* row_sg;
    DI void operator()(const f32x4 (&acc)[2][2][4][2], const Unit& u, int wr, int wc, int fr, int fq) const {
        const int row0 = u.pm * 256 + wr * 64 + fr, col0 = u.pn * 256 + wc * 32 + 8 * fq;
        const float* bb = b_dn + (size_t)u.e * 1024 + col0;
        f32x4 bv[2][2];
#pragma unroll
        for (int bj = 0; bj < 2; ++bj)
#pragma unroll
            for (int n = 0; n < 2; ++n) bv[bj][n] = *(const f32x4*)(bb + bj * 128 + 4 * n);
        int slots[8]; float gts[8];
        { const u32x2* sgp = row_sg + row0;
#pragma unroll
        for (int q = 0; q < 8; ++q) { const u32x2 sg = sgp[(q >> 2) * 128 + (q & 3) * 16]; slots[q] = (int)sg.x; gts[q] = __uint_as_float(sg.y); } }
#pragma unroll
        for (int ai = 0; ai < 2; ++ai)
#pragma unroll
            for (int m = 0; m < 4; ++m) {
                const int slot = slots[ai * 4 + m]; const float gt = gts[ai * 4 + m];
                if (slot >= 0) { bf16* rowp = YS + (size_t)slot * 1024 + col0;
#pragma unroll
                    for (int bj = 0; bj < 2; ++bj) { const f32x4 v0 = (acc[ai][bj][m][0] * 0.015625f + bv[bj][0]) * gt, v1 = (acc[ai][bj][m][1] * 0.015625f + bv[bj][1]) * gt;
                        u32x4 w; w.x = cvt_pk_bf16(v0[0], v0[1]); w.y = cvt_pk_bf16(v0[2], v0[3]); w.z = cvt_pk_bf16(v1[0], v1[1]); w.w = cvt_pk_bf16(v1[2], v1[3]);
                        *(u32x4*)(rowp + bj * 128) = w; } }
            }
    }
};

constexpr size_t MiB = 1u << 20;
constexpr size_t WS_CTL = 0, CTL_ZERO_BYTES = 1 * MiB;
constexpr size_t WS_WIN = 1 * MiB, WS_WOUT = 7 * MiB, WS_WQ = 9 * MiB, WS_WK = 11 * MiB, WS_WV = 13 * MiB, WS_WO = 15 * MiB, WS_LORAB = 17 * MiB, WS_LRUW = 18 * MiB;
constexpr size_t WS_ROUTE = 19 * MiB;
constexpr size_t WS_WGU = 22 * MiB, WS_WDN = 150 * MiB;
constexpr size_t WS_HN = 214 * MiB, WS_MEMN = 246 * MiB, WS_KM = 248 * MiB, WS_VT = 250 * MiB;
constexpr size_t WS_X1 = 252 * MiB, WS_X2 = 316 * MiB;
constexpr size_t WS_U = 380 * MiB, WS_R = 468 * MiB, WS_KRAW = 500 * MiB, WS_V = 532 * MiB, WS_KKN = 564 * MiB, WS_WD = 596 * MiB, WS_AA = 628 * MiB, WS_G = 660 * MiB;
constexpr size_t WS_LA = 692 * MiB, WS_LB = 724 * MiB, WS_AP = 756 * MiB, WS_CAT = 764 * MiB, WS_Q = 796 * MiB;
constexpr size_t WS_XS = 380 * MiB, WS_ACT = 524 * MiB, WS_YS = 668 * MiB;
constexpr size_t WS_GP = 796 * MiB, WS_HF = 860 * MiB, WS_RP = 924 * MiB, WS_Y1F = 940 * MiB, WS_ADD = 972 * MiB, WS_END = 1004 * MiB;
constexpr size_t WS_GC = 468 * MiB, WS_HC = 484 * MiB, WS_ZS = 500 * MiB;
static_assert(WS_AA == WS_WD + 32 * MiB && WS_G == WS_AA + 32 * MiB, "EpiLora strides");
static_assert(WS_U + (size_t)M * INW * 2 <= WS_R && WS_XS + (size_t)MAXROWS * 2048 <= WS_ACT && WS_ACT + (size_t)MAXROWS * 2048 <= WS_YS && WS_YS + (size_t)NASSIGN * 2048 <= WS_Q, "ws map");
constexpr size_t RT_E = 0, RT_POS = 256 * 1024, RT_G = 512 * 1024, RT_SLOT = 768 * 1024, RT_GATE = 1088 * 1024, RT_TILE = 1408 * 1024, RT_TOK = 1472 * 1024, RT_UGU = 1792 * 1024, RT_UDN = 1808 * 1024;
constexpr int CW_BAR = 4096, CW_CNT = 8192, CW_CONV = 12288;

constexpr int RING_BYTES = 131072, MISC_OFF = RING_BYTES + 320, LDS_BYTES = 147456;
constexpr int NWAVES = 8, NTHREADS = 512;
constexpr int CONV_P9 = 0;
constexpr int CONV_P9D = 16384;

#define XB_TMO      128
#define XB_XCNT(j)  (256  + 64 * (j))
#define XB_XSUB(j)  (1280 + 64 * (j))
#define XB_XGEN(j)  (2304 + 64 * (j))
#define XB_TOP      3328
#define XB_TOPGEN   3392
#define XCD_BAR_WORDS 3456
#define XB_SPIN_CAP (1u << 18)
DI unsigned xb_ld(unsigned* p)              { return __hip_atomic_load(p, __ATOMIC_RELAXED, __HIP_MEMORY_SCOPE_AGENT); }
DI unsigned xb_add(unsigned* p, unsigned v) { return __hip_atomic_fetch_add(p, v, __ATOMIC_RELAXED, __HIP_MEMORY_SCOPE_AGENT); }
DI unsigned xb_xcc_id() { return (unsigned)__builtin_amdgcn_s_getreg((3 << 11) | 20) & 0xFu; }
#define XB_SPIN(cond, bar) do { unsigned _sp = 0; while (cond) { __builtin_amdgcn_s_sleep(1); \
    if ((++_sp & 255u) == 0u) { if (xb_ld(&(bar)[XB_TMO])) break; if (_sp > XB_SPIN_CAP) { atomicAdd(&(bar)[XB_TMO], 1u); break; } } } } while (0)
struct XcdBarrier { unsigned* bar; unsigned x; volatile LAS unsigned* st; int w0; };
DI XcdBarrier xcd_barrier_post(unsigned* bar, volatile LAS unsigned* st, int w0) {
    XcdBarrier b; b.bar = bar; b.x = xb_xcc_id(); b.st = st; b.w0 = w0;
    if (fresh_tid_(w0) == 0) (void)xb_add(&bar[XB_XCNT(b.x)], 1u);
    return b;
}
DI void xcd_barrier_complete(unsigned* bar, unsigned x, unsigned& nloc, unsigned& nx) {
    const unsigned G = gridDim.x * gridDim.y * gridDim.z;
    unsigned sum, cnt, mine, sp = 0u;
    for (;;) {
        sum = 0u; cnt = 0u; mine = 0u;
#pragma unroll
        for (unsigned j = 0; j < 16; ++j) { const unsigned c = xb_ld(&bar[XB_XCNT(j)]); sum += c; cnt += (c > 0u) ? 1u : 0u; mine = (j == x) ? c : mine; }
        if (sum == G) break;
        __builtin_amdgcn_s_sleep(1);
        if ((++sp & 255u) == 0u) { if (xb_ld(&bar[XB_TMO])) break; if (sp > XB_SPIN_CAP) { atomicAdd(&bar[XB_TMO], 1u); break; } }
    }
    nloc = mine > 0u ? mine : 1u; nx = cnt > 0u ? cnt : 1u;
}
DI void xcd_barrier(const XcdBarrier& b) {
    asm volatile("s_waitcnt vmcnt(0)" ::: "memory");
    __syncthreads();
    if (fresh_tid_(b.w0) == 0) {
        unsigned* bar = b.bar;
        __builtin_amdgcn_s_waitcnt(0);
        unsigned nloc = b.st[0], nx = b.st[1];
        if (nloc == 0u) { xcd_barrier_complete(bar, b.x, nloc, nx); b.st[0] = nloc; b.st[1] = nx; }
        const unsigned old = xb_add(&bar[XB_XSUB(b.x)], 1u);
        const unsigned gen = old / nloc;
        if (old + 1u == (gen + 1u) * nloc) {
            __builtin_amdgcn_fence(__ATOMIC_RELEASE, "agent");
            asm volatile("s_waitcnt vmcnt(0)" ::: "memory");
            const unsigned og = xb_add(&bar[XB_TOP], 1u);
            const unsigned tg = og / nx;
            if (og + 1u == (tg + 1u) * nx) xb_add(&bar[XB_TOPGEN], 1u);
            else XB_SPIN(xb_ld(&bar[XB_TOPGEN]) == tg, bar);
            __builtin_amdgcn_fence(__ATOMIC_ACQUIRE, "agent");
            xb_add(&bar[XB_XGEN(b.x)], 1u);
            asm volatile("s_waitcnt vmcnt(0)" ::: "memory");
        } else {
            XB_SPIN(xb_ld(&bar[XB_XGEN(b.x)]) == gen, bar);
            __builtin_amdgcn_fence(__ATOMIC_ACQUIRE, "agent");
            asm volatile("s_waitcnt vmcnt(0)" ::: "memory");
        }
    }
    __syncthreads();
}

struct Args { const float* in[37]; float* out; unsigned char* ws; int ph_lo, ph_hi; };
enum { I_X = 0, I_MEM, I_NMIXG, I_WIN, I_CONVW, I_CONVB, I_LWX, I_LBX, I_LWA, I_LBA, I_LAM, I_MU, I_W0, I_WUP, I_A0, I_AUP, I_GUP, I_KK, I_KA, I_RK, I_LNG, I_LNB,
       I_WOUT, I_NXAG, I_NMEMG, I_WQ, I_WK, I_WV, I_WO, I_NFFG, I_WR, I_BR, I_WGU, I_BGU, I_WDN, I_BDN, I_FNG };

DI void transpose_item(const float* W, int ldw, int K, bf16* WT, int k0, int n0, int drow0, LAS float* scr, int lane, const float* rs = nullptr) {
    f32x4 t[8];
    const float* src = W + (size_t)(k0 + (lane >> 3)) * ldw + n0 + 4 * (lane & 7);
#pragma unroll
    for (int i = 0; i < 8; ++i) t[i] = *(const f32x4*)(src + (size_t)(8 * i) * ldw);
#pragma unroll
    for (int i = 0; i < 8; ++i) { const float sc_ = rs ? rs[k0 + 8 * i + (lane >> 3)] : 1.0f; LAS float* d = scr + (8 * i + (lane >> 3)) * 33 + 4 * (lane & 7); d[0] = t[i].x * sc_; d[1] = t[i].y * sc_; d[2] = t[i].z * sc_; d[3] = t[i].w * sc_; }
    asm volatile("s_waitcnt lgkmcnt(0)" ::: "memory");
    const int c = lane & 7;
#pragma unroll
    for (int j = 0; j < 4; ++j) { const int n = (lane >> 3) + 8 * j; const LAS float* s = scr + (8 * c) * 33 + n;
        u32x4 o; o.x = pk2(s[0 * 33], s[1 * 33]); o.y = pk2(s[2 * 33], s[3 * 33]); o.z = pk2(s[4 * 33], s[5 * 33]); o.w = pk2(s[6 * 33], s[7 * 33]);
        *(u32x4*)(WT + (size_t)(drow0 + n) * K + k0 + 8 * c) = o; }
    asm volatile("s_waitcnt lgkmcnt(0)" ::: "memory");
}
DI void transpose_item_tiled(const float* W, int ldw, int K, bf16* WTe, int k0, int n0, int drow0, LAS float* scr, int lane) {
    f32x4 t[8];
    const float* src = W + (size_t)(k0 + (lane >> 3)) * ldw + n0 + 4 * (lane & 7);
#pragma unroll
    for (int i = 0; i < 8; ++i) t[i] = *(const f32x4*)(src + (size_t)(8 * i) * ldw);
#pragma unroll
    for (int i = 0; i < 8; ++i) { LAS float* d = scr + (8 * i + (lane >> 3)) * 33 + 4 * (lane & 7); d[0] = t[i].x; d[1] = t[i].y; d[2] = t[i].z; d[3] = t[i].w; }
    asm volatile("s_waitcnt lgkmcnt(0)" ::: "memory");
    const int c = lane & 7;
#pragma unroll
    for (int j = 0; j < 4; ++j) { const int n = (lane >> 3) + 8 * j; const LAS float* s = scr + (8 * c) * 33 + n;
        u32x4 o; o.x = pk2(s[0 * 33], s[1 * 33]); o.y = pk2(s[2 * 33], s[3 * 33]); o.z = pk2(s[4 * 33], s[5 * 33]); o.w = pk2(s[6 * 33], s[7 * 33]);
        const int drow = drow0 + n, pn = drow >> 8, half = (drow >> 7) & 1, r = drow & 127, x = r & 31;
        const int rslot = (r & ~31) + 16 * ((x >> 2) & 1) + 4 * (x >> 3) + (x & 3);
        const size_t tb = ((size_t)(pn * (K / 64) + (k0 >> 6)) * 2 + half) * 16384 + pg8::lds_byte(rslot, 8 * c);
        *(u32x4*)((char*)WTe + tb) = o; }
    asm volatile("s_waitcnt lgkmcnt(0)" ::: "memory");
}
DI void transpose_item_tiled_nolds(const float* W, int ldw, int K, bf16* WTe, int k0, int n0, int drow0, int lane) {
    const int n = lane & 31, kh = lane >> 5;
    const float* src = W + (size_t)(k0 + 32 * kh) * ldw + n0 + n;
    float t[32];
#pragma unroll
    for (int i = 0; i < 32; ++i) t[i] = src[(size_t)i * ldw];
    const int drow = drow0 + n, pn = drow >> 8, half = (drow >> 7) & 1, r = drow & 127, x = r & 31;
    const int rslot = (r & ~31) + 16 * ((x >> 2) & 1) + 4 * (x >> 3) + (x & 3);
    const size_t tb0 = ((size_t)(pn * (K / 64) + (k0 >> 6)) * 2 + half) * 16384;
#pragma unroll
    for (int c = 0; c < 4; ++c) { u32x4 o; o.x = pk2(t[8 * c], t[8 * c + 1]); o.y = pk2(t[8 * c + 2], t[8 * c + 3]); o.z = pk2(t[8 * c + 4], t[8 * c + 5]); o.w = pk2(t[8 * c + 6], t[8 * c + 7]);
        *(u32x4*)((char*)WTe + tb0 + pg8::lds_byte(rslot, 32 * kh + 8 * c)) = o; }
}
DI void transpose_item_tiled_fp8_nolds(const float* W, int ldw, int K, unsigned char* WTe, int k0, int n0, int drow0, int lane) {
    const int n = lane & 31, kh = lane >> 5;
    const float* src = W + (size_t)(k0 + 32 * kh) * ldw + n0 + n;
    float t[32];
#pragma unroll
    for (int i = 0; i < 32; ++i) t[i] = src[(size_t)i * ldw] * 64.f;
    const int drow = drow0 + n, pn = drow >> 8, half = (drow >> 7) & 1, r = drow & 127, x = r & 31;
    const int rslot = (r & ~31) + 16 * ((x >> 2) & 1) + 4 * (x >> 3) + (x & 3);
    const size_t tb0 = ((size_t)(pn * (K / 128) + (k0 >> 7)) * 2 + half) * 16384;
#pragma unroll
    for (int c = 0; c < 2; ++c) { u32x4 o; o.x = pk4_fp8(t[16 * c], t[16 * c + 1], t[16 * c + 2], t[16 * c + 3]); o.y = pk4_fp8(t[16 * c + 4], t[16 * c + 5], t[16 * c + 6], t[16 * c + 7]);
        o.z = pk4_fp8(t[16 * c + 8], t[16 * c + 9], t[16 * c + 10], t[16 * c + 11]); o.w = pk4_fp8(t[16 * c + 12], t[16 * c + 13], t[16 * c + 14], t[16 * c + 15]);
        const int bc = (k0 & 64) + 32 * kh + 16 * c;
        *(u32x4*)(WTe + tb0 + pg8::lds_byte(rslot, bc >> 1)) = o; }
}
DI void transpose_item_tiled_fp8(const float* W, int ldw, int K, unsigned char* WTe, int k0, int n0, int drow0, LAS float* scr, int lane) {
    f32x4 t[8];
    const float* src = W + (size_t)(k0 + (lane >> 3)) * ldw + n0 + 4 * (lane & 7);
#pragma unroll
    for (int i = 0; i < 8; ++i) t[i] = *(const f32x4*)(src + (size_t)(8 * i) * ldw);
#pragma unroll
    for (int i = 0; i < 8; ++i) { LAS float* d = scr + (8 * i + (lane >> 3)) * 33 + 4 * (lane & 7); d[0] = t[i].x * 64.f; d[1] = t[i].y * 64.f; d[2] = t[i].z * 64.f; d[3] = t[i].w * 64.f; }
    asm volatile("s_waitcnt lgkmcnt(0)" ::: "memory");
    const int c = lane & 3;
#pragma unroll
    for (int j = 0; j < 2; ++j) { const int n = (lane >> 2) + 16 * j; const LAS float* sp = scr + (16 * c) * 33 + n;
        u32x4 o; o.x = pk4_fp8(sp[0 * 33], sp[1 * 33], sp[2 * 33], sp[3 * 33]); o.y = pk4_fp8(sp[4 * 33], sp[5 * 33], sp[6 * 33], sp[7 * 33]);
        o.z = pk4_fp8(sp[8 * 33], sp[9 * 33], sp[10 * 33], sp[11 * 33]); o.w = pk4_fp8(sp[12 * 33], sp[13 * 33], sp[14 * 33], sp[15 * 33]);
        const int drow = drow0 + n, pn = drow >> 8, half = (drow >> 7) & 1, r = drow & 127, x = r & 31;
        const int rslot = (r & ~31) + 16 * ((x >> 2) & 1) + 4 * (x >> 3) + (x & 3);
        const int bc = (k0 & 64) + 16 * c;
        const size_t tb = ((size_t)(pn * (K / 128) + (k0 >> 7)) * 2 + half) * 16384 + pg8::lds_byte(rslot, bc >> 1);
        *(u32x4*)(WTe + tb) = o; }
    asm volatile("s_waitcnt lgkmcnt(0)" ::: "memory");
}
DI void rms_row_to_bf16(const float* xrow, const float* g, bf16* orow, int lane) {
    const f32x4* xr = (const f32x4*)xrow + lane; const f32x4* gr = (const f32x4*)g + lane;
    f32x4 v[4]; float s = 0.f;
#pragma unroll
    for (int j = 0; j < 4; ++j) { v[j] = xr[64 * j]; s += (v[j].x * v[j].x + v[j].y * v[j].y) + (v[j].z * v[j].z + v[j].w * v[j].w); }
    const float rstd = rsq_f(wave_sum(s) * (1.f / D) + EPS);
    u32x2* o8 = (u32x2*)orow + lane;
#pragma unroll
    for (int j = 0; j < 4; ++j) { const f32x4 gg = gr[64 * j]; u32x2 w; w.x = pk2(v[j].x * rstd * gg.x, v[j].y * rstd * gg.y); w.y = pk2(v[j].z * rstd * gg.z, v[j].w * rstd * gg.w); o8[64 * j] = w; }
}

DI void rms_rowbf_to_bf16(const bf16* xrow, const float* g, bf16* orow, int lane) {
    float v[16]; float s = 0.f;
#pragma unroll
    for (int hf = 0; hf < 2; ++hf) { const u32x4 w = *(const u32x4*)(xrow + 512 * hf + 8 * lane);
#pragma unroll
        for (int q = 0; q < 4; ++q) { v[8 * hf + 2 * q] = bflo(w[q]); v[8 * hf + 2 * q + 1] = bfhi(w[q]); } }
#pragma unroll
    for (int j = 0; j < 16; ++j) s += v[j] * v[j];
    const float rstd = rsq_f(wave_sum(s) * (1.f / D) + EPS);
#pragma unroll
    for (int hf = 0; hf < 2; ++hf) { const f32x4 g0 = *(const f32x4*)(g + 512 * hf + 8 * lane), g1 = *(const f32x4*)(g + 512 * hf + 8 * lane + 4);
        u32x4 w; w.x = pk2(v[8 * hf] * rstd * g0.x, v[8 * hf + 1] * rstd * g0.y); w.y = pk2(v[8 * hf + 2] * rstd * g0.z, v[8 * hf + 3] * rstd * g0.w);
        w.z = pk2(v[8 * hf + 4] * rstd * g1.x, v[8 * hf + 5] * rstd * g1.y); w.w = pk2(v[8 * hf + 6] * rstd * g1.z, v[8 * hf + 7] * rstd * g1.w);
        *(u32x4*)(orow + 512 * hf + 8 * lane) = w; }
}

__global__ void __launch_bounds__(NTHREADS, 2) fwd(Args args) {
    extern __shared__ __attribute__((aligned(16))) unsigned char lds_raw[];
    LAS unsigned char* lds = (LAS unsigned char*)lds_raw;
    volatile LAS unsigned* MISC = (volatile LAS unsigned*)(lds + MISC_OFF);
    const int G = gridDim.x, bid = blockIdx.x, NGW = G * NWAVES;
    const int wv0 = __builtin_amdgcn_readfirstlane((int)(threadIdx.x >> 6));
#define PHASE_IDS const int tid = fresh_tid(), lane = tid & 63, wave = __builtin_amdgcn_readfirstlane(tid >> 6), gw = bid * NWAVES + wave; (void)tid; (void)lane; (void)wave; (void)gw
    unsigned char* ws = args.ws;
    unsigned* ctl = (unsigned*)(ws + WS_CTL);
    const int lo = args.ph_lo, hi = args.ph_hi;

    for (int u = fresh_tid(); u < (LDS_BYTES - RING_BYTES) / 4; u += NTHREADS) ((LAS unsigned*)(lds + RING_BYTES))[u] = 0u;
    __syncthreads();
    XcdBarrier bar; bar.bar = ctl + CW_BAR; bar.x = 0; bar.st = nullptr; bar.w0 = wv0;
    if (hi - lo > 1) bar = xcd_barrier_post(ctl + CW_BAR, MISC + 8, wv0);
#define IN(k) (lo <= (k) && (k) < hi)
#define SEAM(k) do { if (IN(k) && IN((k) + 1)) xcd_barrier(bar); } while (0)

#define Win_t ((bf16*)(ws + WS_WIN))
#define Wout_t ((bf16*)(ws + WS_WOUT))
#define Wq_t ((bf16*)(ws + WS_WQ))
#define Wk_t ((bf16*)(ws + WS_WK))
#define Wv_t ((bf16*)(ws + WS_WV))
#define Wo_t ((bf16*)(ws + WS_WO))
#define LoraB ((bf16*)(ws + WS_LORAB))
#define LruW ((bf16*)(ws + WS_LRUW))
#define WrT ((bf16*)(ws + WS_LRUW + 512 * 1024))
#define Wgu_t ((bf16*)(ws + WS_WGU))
#define Wdn_t ((bf16*)(ws + WS_WDN))
#define HN ((bf16*)(ws + WS_HN))
#define MEMN ((bf16*)(ws + WS_MEMN))
#define KM ((bf16*)(ws + WS_KM))
#define VT ((bf16*)(ws + WS_VT))
#define X1 ((bf16*)(ws + WS_X1))
#define X2 ((bf16*)(ws + WS_X2))
#define U ((bf16*)(ws + WS_U))
#define Rr ((float*)(ws + WS_R))
#define KRAW ((float*)(ws + WS_KRAW))
#define Vv ((float*)(ws + WS_V))
#define KKN ((float*)(ws + WS_KKN))
#define WD ((float*)(ws + WS_WD))
#define AA ((float*)(ws + WS_AA))
#define GG ((float*)(ws + WS_G))
#define LA ((bf16*)(ws + WS_LA))
#define LB ((bf16*)(ws + WS_LB))
#define AP ((bf16*)(ws + WS_AP))
#define CAT ((bf16*)(ws + WS_CAT))
#define Qb ((bf16*)(ws + WS_Q))
#define Ob CAT
#define XS ((bf16*)(ws + WS_XS))
#define ACT ((bf16*)(ws + WS_ACT))
#define YS ((bf16*)(ws + WS_YS))
#define route_e ((int*)(ws + WS_ROUTE + RT_E))
#define route_pos ((int*)(ws + WS_ROUTE + RT_POS))
#define route_g ((float*)(ws + WS_ROUTE + RT_G))
#define row_sg ((u32x2*)(ws + WS_ROUTE + RT_SLOT))
#define tile_tab ((int*)(ws + WS_ROUTE + RT_TILE))
#define row_tok ((int*)(ws + WS_ROUTE + RT_TOK))
#define ecnt (ctl + CW_CNT)

    if (IN(0)) { PHASE_IDS;
        LAS float* scr = (LAS float*)(lds + wave * 16384);
        constexpr int I_IN = 16 * (INW / 32), I_SQ = 16 * 32;
        constexpr int N_ITEMS = I_IN + 5 * I_SQ;
        for (int it = gw; it < N_ITEMS; it += NGW) {
            int r = it;
            if (r < I_IN) { const int nblk = INW / 32, kb = r / nblk, nb = r % nblk; transpose_item(args.in[I_WIN], INW, D, Win_t, 64 * kb, 32 * nb, 32 * nb, scr, lane); continue; } r -= I_IN;
            { const int w = r / I_SQ, q = r % I_SQ, kb = q / 32, nb = q % 32;
                if (w == 1) continue;
                const float* src = w == 0 ? args.in[I_WOUT] : w == 2 ? args.in[I_WK] : w == 3 ? args.in[I_WV] : args.in[I_WO];
                bf16* dst = w == 0 ? Wout_t : w == 2 ? Wk_t : w == 3 ? Wv_t : Wo_t;
                transpose_item(src, D, D, dst, 64 * kb, 32 * nb, 32 * nb, scr, lane); }
        }
        for (int idx = bid * NTHREADS + tid; idx < D * D / 4; idx += G * NTHREADS) { const f32x4 v = ((const f32x4*)args.in[I_WQ])[idx]; const float gk = args.in[I_NXAG][idx >> 8];
            u32x2 w; w.x = pk2(v.x * gk, v.y * gk); w.y = pk2(v.z * gk, v.w * gk); ((u32x2*)Wq_t)[idx] = w; }
        for (int idx = bid * NTHREADS + tid; idx < 1536 * 256; idx += G * NTHREADS) {
            const int e = idx & 7, ln = (idx >> 3) & 63, ks = (idx >> 9) & 7, ct = (idx >> 12) & 3, hk = idx >> 14, hh = hk / 3, kind = hk - 3 * hh;
            const int k = 32 * ks + 8 * (ln >> 4) + e, n = hh * 64 + 16 * ct + (ln & 15); float v = 0.f;
            if (kind == 0) { if (k < 64) v = args.in[I_WUP][k * 512 + n]; }
            else if (kind == 1) { if (k >= 64 && k < 128) v = args.in[I_AUP][(k - 64) * 512 + n]; }
            else { if (k >= 128) v = args.in[I_GUP][(k - 128) * 512 + n]; }
            LoraB[idx] = (bf16)f2bf(v);
        }
        for (int idx = bid * NTHREADS + tid; idx < 8 * 128 * 64; idx += G * NTHREADS) {
            const int nb = idx >> 13, col = (idx >> 6) & 127, k = idx & 63;
            const float v = col < 64 ? args.in[I_LWX][nb * 4096 + k * 64 + col] : args.in[I_LWA][nb * 4096 + k * 64 + (col - 64)];
            LruW[idx] = (bf16)f2bf(v);
        }
        for (int idx = bid * NTHREADS + tid; idx < NE * D; idx += G * NTHREADS) {
            const int e = idx >> 10, k = idx & 1023; const float v = args.in[I_WR][k * NE + e];
            const unsigned hi = f2bf(v); const float lo = v - __uint_as_float(hi << 16);
            WrT[idx] = (bf16)hi; WrT[NE * D + idx] = (bf16)f2bf(lo);
        }
        for (int m = gw; m < M; m += NGW) rms_row_to_bf16(args.in[I_X] + (size_t)m * D, args.in[I_NMIXG], HN + (size_t)m * D, lane);
        for (int m = gw; m < MROWS; m += NGW) rms_row_to_bf16(args.in[I_MEM] + (size_t)m * D, args.in[I_NMEMG], MEMN + (size_t)m * D, lane);
        {
            LAS float* scr = (LAS float*)(lds + wave * 16384);
            constexpr int I_GU = 16 * 64, I_DN = 16 * 32;
            for (int it = CONV_P9 + gw; it < NE * I_GU; it += NGW) {
                int r = it;
                if (r < NE * I_GU) { const int e = r / I_GU, q = r % I_GU, kb = q / 64, nb = q % 64; const int n0 = 32 * nb;
                    const int drow = n0 < 1024 ? (256 * (n0 >> 7) + (n0 & 127)) : (256 * ((n0 - 1024) >> 7) + 128 + ((n0 - 1024) & 127));
                    transpose_item_tiled_fp8(args.in[I_WGU] + (size_t)e * D * 2048, 2048, D, (unsigned char*)Wgu_t + (size_t)e * 2048 * D, 64 * kb, n0, drow, scr, lane); continue; } r -= NE * I_GU;
                { const int e = r / I_DN, q = r % I_DN, kb = q / 32, nb = q % 32;
                  transpose_item_tiled(args.in[I_WDN] + (size_t)e * DFF * D, D, DFF, Wdn_t + (size_t)e * D * DFF, 64 * kb, 32 * nb, 32 * nb, scr, lane); }
            }
        }
    }
    SEAM(0);

    if (IN(1)) { PHASE_IDS;
        { pg8::DenseSched S; S.o.init_tiles(M / 256, INW / 256, G, bid); S.A = (const char*)HN; S.B = (const char*)Win_t; S.tstep = (size_t)256 * D * 2;
          EpiBf16Plain E{U, INW, 1.0f}; pg8::gemm_phase(lds, D, S, E, wv0); }
        { pg8::DenseSched S; S.o.init_tiles(MROWS / 256, D / 256, G, (bid + 64) & (G - 1)); S.A = (const char*)MEMN; S.B = (const char*)Wk_t; S.tstep = (size_t)256 * D * 2;
          EpiBf16Plain E{KM, D, 1.0f}; pg8::gemm_phase(lds, D, S, E, wv0); }
        { pg8::DenseSched S; S.o.init_tiles(MROWS / 256, D / 256, G, (bid + 48) & (G - 1)); S.A = (const char*)MEMN; S.B = (const char*)Wv_t; S.tstep = (size_t)256 * D * 2;
          EpiBf16Plain E{VT, D, 1.0f}; pg8::gemm_phase(lds, D, S, E, wv0); }
    }
    SEAM(1);

    if (IN(2)) { PHASE_IDS;
        const float* conv_w = args.in[I_CONVW]; const float* conv_b = args.in[I_CONVB];
        LAS float* xs = (LAS float*)(lds + wave * 16384);
        LAS bf16* tP = (LAS bf16*)(lds + wave * 16384 + 4096); LAS bf16* tH = tP + 1024;
        const int i = lane & 15, kg = lane >> 4;
        for (int unit = gw; unit < (M / 64) * 8; unit += NGW) {
            const int seg = unit >> 3, nb = unit & 7, m0s = seg * 64, s0s = m0s & (SEQ - 1);
            bf16x8 wf[8][2];
#pragma unroll
            for (int ct = 0; ct < 8; ++ct)
#pragma unroll
                for (int ks = 0; ks < 2; ++ks) wf[ct][ks] = *(const bf16x8*)(LruW + ((size_t)(nb * 128 + 16 * ct + i) * 64 + 32 * ks + 8 * kg));
            float bxv[4], bav[4], spv[4], Arun[4], Brun[4];
#pragma unroll
            for (int ct = 0; ct < 4; ++ct) { const int ch = nb * 64 + 16 * ct + i; bxv[ct] = args.in[I_LBX][ch]; bav[ct] = args.in[I_LBA][ch]; spv[ct] = softplus_f(-args.in[I_LAM][ch]); Arun[ct] = 1.f; Brun[ct] = 0.f; }
#pragma unroll 1
            for (int jt = 0; jt < 4; ++jt) {
                const int m0 = m0s + 16 * jt, s0 = s0s + 16 * jt;
                bf16x8 af[2];
#pragma unroll
                for (int ks = 0; ks < 2; ++ks) {
                    const int chb = nb * 64 + 32 * ks + 8 * kg;
                    f32x4 x0 = *(const f32x4*)(conv_b + chb), x1 = *(const f32x4*)(conv_b + chb + 4);
#pragma unroll
                    for (int j = 0; j < 4; ++j) {
                        const bool ok = s0 + i - 3 + j >= 0;
                        u32x4 uw = *(const u32x4*)(U + (size_t)(ok ? m0 + i - 3 + j : m0) * INW + chb); if (!ok) uw = (u32x4){0u, 0u, 0u, 0u};
                        const f32x4 w0 = *(const f32x4*)(conv_w + j * 512 + chb), w1 = *(const f32x4*)(conv_w + j * 512 + chb + 4);
                        x0.x += w0.x * bflo(uw.x); x0.y += w0.y * bfhi(uw.x); x0.z += w0.z * bflo(uw.y); x0.w += w0.w * bfhi(uw.y);
                        x1.x += w1.x * bflo(uw.z); x1.y += w1.y * bfhi(uw.z); x1.z += w1.z * bflo(uw.w); x1.w += w1.w * bfhi(uw.w);
                    }
                    *(LAS f32x4*)(xs + i * 64 + 32 * ks + 8 * kg) = x0; *(LAS f32x4*)(xs + i * 64 + 32 * ks + 8 * kg + 4) = x1;
                    u32x4 p; p.x = pk2(x0.x, x0.y); p.y = pk2(x0.z, x0.w); p.z = pk2(x1.x, x1.y); p.w = pk2(x1.z, x1.w);
                    af[ks] = __builtin_bit_cast(bf16x8, p);
                }
                f32x4 acc[8];
#pragma unroll
                for (int ct = 0; ct < 8; ++ct) { acc[ct] = (f32x4){0.f, 0.f, 0.f, 0.f};
#pragma unroll
                    for (int ks = 0; ks < 2; ++ks) acc[ct] = __builtin_amdgcn_mfma_f32_16x16x32_bf16(af[ks], wf[ct][ks], acc[ct], 0, 0, 0); }
#pragma unroll
                for (int ct = 0; ct < 4; ++ct) {
                    const int col = 16 * ct + i;
                    float hl[4], pl[4]; float hprev = 0.f, pprev = 1.f;
#pragma unroll
                    for (int e = 0; e < 4; ++e) {
                        const float gx = sigmoid_f(acc[ct][e] + bxv[ct]), ga = sigmoid_f(acc[ct + 4][e] + bav[ct]);
                        const float la = -8.0f * ga * spv[ct], av = __expf(la), xcv = xs[(4 * kg + e) * 64 + col];
                        const float bt = __builtin_amdgcn_sqrtf(fmaxf(1.0f - av * av, 0.f)) * gx * xcv;
                        hprev = av * hprev + bt; pprev *= av; hl[e] = hprev; pl[e] = pprev;
                    }
                    float Ag[4], Bg[4];
#pragma unroll
                    for (int gq = 0; gq < 4; ++gq) { Ag[gq] = __shfl(pl[3], i + 16 * gq); Bg[gq] = __shfl(hl[3], i + 16 * gq); }
                    float Ain = Arun[ct], Bin = Brun[ct];
#pragma unroll
                    for (int gq = 0; gq < 3; ++gq) if (gq < kg) { Bin = Ag[gq] * Bin + Bg[gq]; Ain *= Ag[gq]; }
                    float At = 1.f, Bt = 0.f;
#pragma unroll
                    for (int gq = 0; gq < 4; ++gq) { Bt = Ag[gq] * Bt + Bg[gq]; At *= Ag[gq]; }
                    Brun[ct] = At * Brun[ct] + Bt; Arun[ct] *= At;
#pragma unroll
                    for (int e = 0; e < 4; ++e) { const int ti_ = (4 * kg + e) * 64 + col; tP[ti_] = (bf16)f2bf(pl[e] * Ain); tH[ti_] = (bf16)f2bf(hl[e] + pl[e] * Bin); }
                }
                { const int rr = lane >> 2, cq = lane & 3;
                  bf16* pp = LA + (size_t)(m0 + rr) * 512 + nb * 64 + 16 * cq; bf16* hp = LB + (size_t)(m0 + rr) * 512 + nb * 64 + 16 * cq;
                  *(u32x4*)pp = *(const LAS u32x4*)(tP + rr * 64 + 16 * cq); *(u32x4*)(pp + 8) = *(const LAS u32x4*)(tP + rr * 64 + 16 * cq + 8);
                  *(u32x4*)hp = *(const LAS u32x4*)(tH + rr * 64 + 16 * cq); *(u32x4*)(hp + 8) = *(const LAS u32x4*)(tH + rr * 64 + 16 * cq + 8); }
            }
            if (kg == 0) {
#pragma unroll
                for (int ct = 0; ct < 4; ++ct) { f32x2 ab; ab.x = Arun[ct]; ab.y = Brun[ct];
                    *(f32x2*)((float*)(ws + WS_AP) + ((size_t)(((seg >> 6) * 8 + nb) * 64 + (seg & 63)) * 64 + 16 * ct + i) * 2) = ab; }
            }
        }
    }
    SEAM(2);


#define RW_ZB(zz, zb) do { _Pragma("unroll") for (int ks_ = 0; ks_ < 2; ++ks_) { u32x4 p_; p_.x = pk2(zz[2 * ks_][0], zz[2 * ks_][1]); p_.y = pk2(zz[2 * ks_][2], zz[2 * ks_][3]); \
        p_.z = pk2(zz[2 * ks_ + 1][0], zz[2 * ks_ + 1][1]); p_.w = pk2(zz[2 * ks_ + 1][2], zz[2 * ks_ + 1][3]); zb[ks_] = __builtin_bit_cast(bf16x8, p_); } } while (0)
    if (IN(3)) { PHASE_IDS;
        for (int u64 = gw; u64 < NB * NH * (SEQ / 64); u64 += NGW) {
#pragma unroll 1
        for (int jj = 0; jj < 4; ++jj) {
        LAS unsigned char* wl = lds + wave * 16384;
        LAS bf16* Arm = (LAS bf16*)(wl); LAS bf16* Brm = (LAS bf16*)(wl + 2048); LAS bf16* Krm = (LAS bf16*)(wl + 4096); LAS bf16* Rrm = (LAS bf16*)(wl + 6144);
        LAS bf16* ATt = (LAS bf16*)(wl + 8192); LAS bf16* BTt = (LAS bf16*)(wl + 10240); LAS bf16* KTt = (LAS bf16*)(wl + 12288); LAS bf16* VTt = (LAS bf16*)(wl + 14336);
        LAS float* MabT = (LAS float*)(wl); LAS bf16* Mak = (LAS bf16*)(wl + 1024); LAS bf16* Mrb = (LAS bf16*)(wl + 1536); LAS bf16* Mrk = (LAS bf16*)(wl + 2048); LAS bf16* Tm = (LAS bf16*)(wl + 2560);
        LAS float* PLs = (LAS float*)(wl + 3072); LAS bf16* Q0T = (LAS bf16*)(wl + 4096);
        const int lane = fresh_tid() & 63, l15 = lane & 15, g = lane >> 4, te = lane >> 2, kq = lane & 3;
        const bf16x8 z8 = (bf16x8){0, 0, 0, 0, 0, 0, 0, 0};
        const f32x4 z4 = (f32x4){0.f, 0.f, 0.f, 0.f};
            const int un = u64 * 4 + jj;
            const int bh = un >> 8, c = un & 255, b = bh >> 3, h = bh & 7;
            const size_t mrow = (size_t)b * SEQ + c * 16 + te, off = mrow * 512 + h * 64 + 16 * kq;
            const int hc = h * 64 + 16 * kq;
            LAS float* tmpL = (LAS float*)wl;
            {
                const int rsub = lane >> 5, chunk = lane & 31; const size_t mt0 = (size_t)b * SEQ + c * 16;
                const f32x4 m0 = *(const f32x4*)(args.in[I_MU] + 1536 + 8 * chunk), m1 = *(const f32x4*)(args.in[I_MU] + 1536 + 8 * chunk + 4);
                u32x4 cu[8], pu[8];
#pragma unroll
                for (int i = 0; i < 8; ++i) { const size_t mr = mt0 + 2 * i + rsub; const bool hp2 = (mr & (SEQ - 1)) != 0; const bf16* ua = U + mr * INW + 2560 + 8 * chunk;
                    cu[i] = *(const u32x4*)ua; pu[i] = *(const u32x4*)(ua - (hp2 ? INW : 0)); if (!hp2) pu[i] = (u32x4){0u, 0u, 0u, 0u}; }
#pragma unroll
                for (int i = 0; i < 8; ++i) { float o8[8];
#pragma unroll
                    for (int q = 0; q < 4; ++q) { const float c0 = bflo(cu[i][q]), c1 = bfhi(cu[i][q]), p0 = bflo(pu[i][q]), p1 = bfhi(pu[i][q]); const float mm0 = q < 2 ? m0[2 * q] : m1[2 * q - 4], mm1 = q < 2 ? m0[2 * q + 1] : m1[2 * q - 3];
                        float x0 = c0 + (p0 - c0) * mm0, x1 = c1 + (p1 - c1) * mm1;
                        if (chunk < 8) { x0 = tanh_fast(x0); x1 = tanh_fast(x1); }
                        else if (chunk >= 16) { x0 = sigmoid_f(x0); x1 = sigmoid_f(x1); }
                        o8[2 * q] = x0; o8[2 * q + 1] = x1; }
                    u32x4 pw; pw.x = pk2(o8[0], o8[1]); pw.y = pk2(o8[2], o8[3]); pw.z = pk2(o8[4], o8[5]); pw.w = pk2(o8[6], o8[7]);
                    const int row = 2 * i + rsub; *(LAS u32x4*)(wl + row * 512 + ((chunk ^ (row & 7)) << 4)) = pw; }
                bf16x8 af[8];
#pragma unroll
                for (int ks = 0; ks < 8; ++ks) af[ks] = *(const LAS bf16x8*)(wl + l15 * 512 + (((4 * ks + g) ^ (l15 & 7)) << 4));
                asm volatile("s_waitcnt lgkmcnt(0)" ::: "memory");
#pragma unroll
                for (int kind = 0; kind < 3; ++kind)
#pragma unroll
                    for (int ct = 0; ct < 4; ++ct) {
                        const bf16* lb = LoraB + ((size_t)((h * 3 + kind) * 4 + ct) * 8 * 64 + lane) * 8;
                        f32x4 a4 = z4;
#pragma unroll
                        for (int ks = (kind == 0 ? 0 : kind == 1 ? 2 : 4); ks < (kind == 0 ? 2 : kind == 1 ? 4 : 8); ++ks) a4 = __builtin_amdgcn_mfma_f32_16x16x32_bf16(af[ks], *(const bf16x8*)(lb + ks * 512), a4, 0, 0, 0);
#pragma unroll
                        for (int e = 0; e < 4; ++e) tmpL[kind * 1088 + (4 * g + e) * 68 + 16 * ct + l15] = a4[e];
                    }
            }
            asm volatile("s_waitcnt lgkmcnt(0)" ::: "memory");
            float cl[16], eP[16];
            {
                float lwv[16], rl[16], kl[16], vl[16], kn[16], av[16];
                const bool hp = (mrow & (SEQ - 1)) != 0;
                const bf16* ub = U + mrow * INW + 1024 + hc;
#pragma unroll
                for (int hh = 0; hh < 2; ++hh) {
#pragma unroll
                    for (int a3 = 0; a3 < 3; ++a3) {
                        const u32x4 cu = *(const u32x4*)(ub + 512 * a3 + 8 * hh); u32x4 pu = *(const u32x4*)(ub - (hp ? INW : 0) + 512 * a3 + 8 * hh); if (!hp) pu = (u32x4){0u, 0u, 0u, 0u};
                        const f32x4 m0 = *(const f32x4*)(args.in[I_MU] + 512 * a3 + hc + 8 * hh), m1 = *(const f32x4*)(args.in[I_MU] + 512 * a3 + hc + 8 * hh + 4);
                        float o8[8];
#pragma unroll
                        for (int q = 0; q < 4; ++q) { const float c0 = bflo(cu[q]), c1 = bfhi(cu[q]), p0 = bflo(pu[q]), p1 = bfhi(pu[q]); const float mm0 = q < 2 ? m0[2 * q] : m1[2 * q - 4], mm1 = q < 2 ? m0[2 * q + 1] : m1[2 * q - 3];
                            o8[2 * q] = c0 + (p0 - c0) * mm0; o8[2 * q + 1] = c1 + (p1 - c1) * mm1; }
#pragma unroll
                        for (int q = 0; q < 8; ++q) { if (a3 == 0) rl[8 * hh + q] = o8[q]; else if (a3 == 1) kl[8 * hh + q] = o8[q]; else vl[8 * hh + q] = o8[q]; }
                    }
                }
                float gv[16];
#pragma unroll
                for (int j4 = 0; j4 < 4; ++j4) { const f32x4 xl = *(const LAS f32x4*)(tmpL + te * 68 + 16 * kq + 4 * j4), xa = *(const LAS f32x4*)(tmpL + 1088 + te * 68 + 16 * kq + 4 * j4), xg = *(const LAS f32x4*)(tmpL + 2176 + te * 68 + 16 * kq + 4 * j4);
                    const f32x4 w0v = *(const f32x4*)(args.in[I_W0] + hc + 4 * j4), a0v = *(const f32x4*)(args.in[I_A0] + hc + 4 * j4);
#pragma unroll
                    for (int q = 0; q < 4; ++q) { const float wq = -softplus_fast(-(xl[q] + w0v[q])) - 0.5f; lwv[4 * j4 + q] = -__expf(wq); av[4 * j4 + q] = sigmoid_f(xa[q] + a0v[q]); gv[4 * j4 + q] = xg[q]; } }
                asm volatile("s_waitcnt lgkmcnt(0)" ::: "memory");
                float ss = 0.f;
#pragma unroll
                for (int j4 = 0; j4 < 4; ++j4) { const f32x4 kk4 = *(const f32x4*)(args.in[I_KK] + hc + 4 * j4);
#pragma unroll
                    for (int q = 0; q < 4; ++q) { kn[4 * j4 + q] = kl[4 * j4 + q] * kk4[q]; ss += kn[4 * j4 + q] * kn[4 * j4 + q]; } }
                ss += __shfl_xor(ss, 1); ss += __shfl_xor(ss, 2);
                const float kinv = rsq_f(fmaxf(ss, 1e-24f));
#pragma unroll
                for (int j = 0; j < 16; ++j) { float x = lwv[j];
#pragma unroll
                    for (int sft = 4; sft < 64; sft <<= 1) { const float y = __shfl_up(x, sft); if (lane >= sft) x += y; }
                    cl[j] = x; }
                float bon = 0.f;
                u32x4 pa[2], pb[2], pk[2], pr[2];
#pragma unroll
                for (int j4 = 0; j4 < 4; ++j4) {
                    const f32x4 ka = *(const f32x4*)(args.in[I_KA] + hc + 4 * j4), rk = *(const f32x4*)(args.in[I_RK] + hc + 4 * j4);
                    float at4[4], bt4[4], kt4[4], rt4[4];
#pragma unroll
                    for (int q = 0; q < 4; ++q) { const int j = 4 * j4 + q;
                        const float p = __expf(cl[j]), pn = __expf(-cl[j]), pm1 = __expf(cl[j] - lwv[j]); eP[j] = p;
                        const float knj = kn[j] * kinv;
                        const float kp = kl[j] * (1.0f + (av[j] - 1.0f) * ka[q]);
                        at4[q] = -knj * pm1; bt4[q] = knj * av[j] * pn; kt4[q] = kp * pn; rt4[q] = rl[j] * p;
                        bon += rl[j] * kp * rk[q];
                        const int kk = 16 * kq + j;
                        ATt[kk * 16 + te] = (bf16)f2bf(at4[q]); BTt[kk * 16 + te] = (bf16)f2bf(bt4[q]); KTt[kk * 16 + te] = (bf16)f2bf(kt4[q]); VTt[kk * 16 + te] = (bf16)f2bf(vl[j]); }
                    const int hh = j4 >> 1, w2 = (j4 & 1) * 2;
                    pa[hh][w2] = pk2(at4[0], at4[1]); pa[hh][w2 + 1] = pk2(at4[2], at4[3]); pb[hh][w2] = pk2(bt4[0], bt4[1]); pb[hh][w2 + 1] = pk2(bt4[2], bt4[3]);
                    pk[hh][w2] = pk2(kt4[0], kt4[1]); pk[hh][w2 + 1] = pk2(kt4[2], kt4[3]); pr[hh][w2] = pk2(rt4[0], rt4[1]); pr[hh][w2 + 1] = pk2(rt4[2], rt4[3]);
                }
#pragma unroll
                for (int hh = 0; hh < 2; ++hh) { const int po = te * 64 + 8 * ((2 * kq + hh) ^ (te & 7));
                    *(LAS u32x4*)(Arm + po) = pa[hh]; *(LAS u32x4*)(Brm + po) = pb[hh]; *(LAS u32x4*)(Krm + po) = pk[hh]; *(LAS u32x4*)(Rrm + po) = pr[hh]; }
                bon += __shfl_xor(bon, 1); bon += __shfl_xor(bon, 2);
                f32x4 lbv[4], lgv[4];
#pragma unroll
                for (int j4 = 0; j4 < 4; ++j4) { lbv[j4] = *(const f32x4*)(args.in[I_LNB] + hc + 4 * j4); lgv[j4] = *(const f32x4*)(args.in[I_LNG] + hc + 4 * j4); }
#pragma unroll
                for (int j4 = 0; j4 < 4; ++j4) { const f32x4 lb = lbv[j4], lgn = lgv[j4]; const int j0 = 4 * j4;
                    u32x2 ow, gw2; ow.x = pk2((lb.x + vl[j0] * bon) * gv[j0], (lb.y + vl[j0 + 1] * bon) * gv[j0 + 1]); ow.y = pk2((lb.z + vl[j0 + 2] * bon) * gv[j0 + 2], (lb.w + vl[j0 + 3] * bon) * gv[j0 + 3]);
                    gw2.x = pk2(lgn.x * gv[j0], lgn.y * gv[j0 + 1]); gw2.y = pk2(lgn.z * gv[j0 + 2], lgn.w * gv[j0 + 3]);
                    *(u32x2*)((bf16*)(ws + WS_ADD) + off + j0) = ow; *(u32x2*)((bf16*)(ws + WS_G) + off + j0) = gw2; }
            }
            asm volatile("s_waitcnt lgkmcnt(0)" ::: "memory");
            {
                bf16x8 fa[2], fr[2], fb[2], fk[2];
#pragma unroll
                for (int ks = 0; ks < 2; ++ks) { const int po = l15 * 64 + 8 * ((4 * ks + g) ^ (l15 & 7));
                    fa[ks] = *(const LAS bf16x8*)(Arm + po); fr[ks] = *(const LAS bf16x8*)(Rrm + po); fb[ks] = *(const LAS bf16x8*)(Brm + po); fk[ks] = *(const LAS bf16x8*)(Krm + po); }
                f32x4 mab = z4, mak = z4, mrb = z4, mrk = z4;
#pragma unroll
                for (int ks = 0; ks < 2; ++ks) { mab = __builtin_amdgcn_mfma_f32_16x16x32_bf16(fb[ks], fa[ks], mab, 0, 0, 0); mak = __builtin_amdgcn_mfma_f32_16x16x32_bf16(fk[ks], fa[ks], mak, 0, 0, 0);
                    mrb = __builtin_amdgcn_mfma_f32_16x16x32_bf16(fb[ks], fr[ks], mrb, 0, 0, 0); mrk = __builtin_amdgcn_mfma_f32_16x16x32_bf16(fk[ks], fr[ks], mrk, 0, 0, 0); }
#pragma unroll
                for (int e = 0; e < 4; ++e) { const int i = 4 * g + e; if (!(i < l15)) { mab[e] = 0.f; mak[e] = 0.f; } if (!(i <= l15)) { mrb[e] = 0.f; mrk[e] = 0.f; } }
                asm volatile("s_waitcnt lgkmcnt(0)" ::: "memory");
#pragma unroll
                for (int e = 0; e < 4; ++e) MabT[(4 * g + e) * 16 + l15] = mab[e];
                u32x2 w; w.x = pk2(mak[0], mak[1]); w.y = pk2(mak[2], mak[3]); *(LAS u32x2*)(Mak + l15 * 16 + 4 * g) = w;
                w.x = pk2(mrb[0], mrb[1]); w.y = pk2(mrb[2], mrb[3]); *(LAS u32x2*)(Mrb + l15 * 16 + 4 * g) = w;
                w.x = pk2(mrk[0], mrk[1]); w.y = pk2(mrk[2], mrk[3]); *(LAS u32x2*)(Mrk + l15 * 16 + 4 * g) = w;
                if (te == 15) {
#pragma unroll
                    for (int j = 0; j < 16; ++j) PLs[16 * kq + j] = eP[j]; }
            }
            asm volatile("s_waitcnt lgkmcnt(0)" ::: "memory");
            {
                f32x4 mq[15][4];
#pragma unroll
                for (int j = 0; j < 15; ++j)
#pragma unroll
                    for (int q = 0; q < 4; ++q) if (4 * q + 3 > j) mq[j][q] = *(const LAS f32x4*)(MabT + j * 16 + 4 * q);
                float y[16];
#pragma unroll
                for (int j = 15; j >= 0; --j) {
                    float acc = (j == l15) ? 1.0f : 0.0f;
#pragma unroll
                    for (int i = j + 1; i < 16; ++i) acc += y[i] * mq[j < 15 ? j : 0][i >> 2][i & 3];
                    y[j] = acc;
                }
                if (g == 0) { u32x4 t0, t1; t0.x = pk2(y[0], y[1]); t0.y = pk2(y[2], y[3]); t0.z = pk2(y[4], y[5]); t0.w = pk2(y[6], y[7]); t1.x = pk2(y[8], y[9]); t1.y = pk2(y[10], y[11]); t1.z = pk2(y[12], y[13]); t1.w = pk2(y[14], y[15]);
                    *(LAS u32x4*)(Tm + l15 * 16) = t0; *(LAS u32x4*)(Tm + l15 * 16 + 8) = t1; }
            }
            asm volatile("s_waitcnt lgkmcnt(0)" ::: "memory");
            {
                const bool act = g < 2; const int fo = l15 * 16 + 8 * g;
                const bf16x8 fT = act ? *(const LAS bf16x8*)(Tm + fo) : z8, fMak = act ? *(const LAS bf16x8*)(Mak + fo) : z8, fMrb = act ? *(const LAS bf16x8*)(Mrb + fo) : z8, fMrk = act ? *(const LAS bf16x8*)(Mrk + fo) : z8;
                bf16x8 fV[4], fQ1[4], fAh[4], fBT[4], fKT[4];
#pragma unroll
                for (int vt = 0; vt < 4; ++vt) { fV[vt] = act ? *(const LAS bf16x8*)(VTt + vt * 256 + fo) : z8; fBT[vt] = act ? *(const LAS bf16x8*)(BTt + vt * 256 + fo) : z8; fKT[vt] = act ? *(const LAS bf16x8*)(KTt + vt * 256 + fo) : z8; }
#pragma unroll
                for (int vt = 0; vt < 4; ++vt) { const f32x4 q0 = __builtin_amdgcn_mfma_f32_16x16x32_bf16(fMak, fV[vt], z4, 0, 0, 0);
                    u32x2 w; w.x = pk2(q0[0], q0[1]); w.y = pk2(q0[2], q0[3]); *(LAS u32x2*)(Q0T + vt * 256 + l15 * 16 + 4 * g) = w; }
#pragma unroll
                for (int kt = 0; kt < 4; ++kt) { const bf16x8 fA = act ? *(const LAS bf16x8*)(ATt + kt * 256 + fo) : z8; const f32x4 ah = __builtin_amdgcn_mfma_f32_16x16x32_bf16(fT, fA, z4, 0, 0, 0);
                    u32x2 w; w.x = pk2(ah[0], ah[1]); w.y = pk2(ah[2], ah[3]); *(LAS u32x2*)(ATt + kt * 256 + l15 * 16 + 4 * g) = w; }
                asm volatile("s_waitcnt lgkmcnt(0)" ::: "memory");
#pragma unroll
                for (int vt = 0; vt < 4; ++vt) { const bf16x8 fQ0 = act ? *(const LAS bf16x8*)(Q0T + vt * 256 + fo) : z8; const f32x4 q1 = __builtin_amdgcn_mfma_f32_16x16x32_bf16(fT, fQ0, z4, 0, 0, 0);
                    u32x2 w; w.x = pk2(q1[0], q1[1]); w.y = pk2(q1[2], q1[3]); *(LAS u32x2*)(Q0T + vt * 256 + l15 * 16 + 4 * g) = w; }
                asm volatile("s_waitcnt lgkmcnt(0)" ::: "memory");
#pragma unroll
                for (int vt = 0; vt < 4; ++vt) { fQ1[vt] = act ? *(const LAS bf16x8*)(Q0T + vt * 256 + fo) : z8; fAh[vt] = act ? *(const LAS bf16x8*)(ATt + vt * 256 + fo) : z8; }
                bf16* rp = (bf16*)(ws + WS_RP) + (size_t)un * 1024 + l15 * 64;
#pragma unroll
                for (int kt = 0; kt < 4; ++kt) {
                    const u32x2 rr = *(const LAS u32x2*)(Rrm + l15 * 64 + 8 * ((2 * kt + (g >> 1)) ^ (l15 & 7)) + 4 * (g & 1));
                    f32x4 ini; ini[0] = bflo(rr.x); ini[1] = bfhi(rr.x); ini[2] = bflo(rr.y); ini[3] = bfhi(rr.y);
                    const f32x4 rh = __builtin_amdgcn_mfma_f32_16x16x32_bf16(fAh[kt], fMrb, ini, 0, 0, 0);
                    u32x2 w; w.x = pk2(rh[0], rh[1]); w.y = pk2(rh[2], rh[3]); *(u32x2*)(rp + 32 * (kt >> 1) + 8 * g + 4 * (kt & 1)) = w;
                }
#pragma unroll
                for (int vt = 0; vt < 4; ++vt) { f32x4 y1 = __builtin_amdgcn_mfma_f32_16x16x32_bf16(fMrb, fQ1[vt], z4, 0, 0, 0); y1 = __builtin_amdgcn_mfma_f32_16x16x32_bf16(fMrk, fV[vt], y1, 0, 0, 0);
                    *(f32x4*)((float*)(ws + WS_Y1F) + ((size_t)(un * 4 + vt) * 64 + lane) * 4) = y1; }
                LAS bf16* tgs = (LAS bf16*)(wl + 8192);
#pragma unroll
                for (int krt = 0; krt < 4; ++krt) { const float pl = PLs[16 * krt + l15];
#pragma unroll
                    for (int kct = 0; kct < 4; ++kct) { f32x4 ga = __builtin_amdgcn_mfma_f32_16x16x32_bf16(fAh[kct], fBT[krt], z4, 0, 0, 0);
                        if (kct == krt) {
#pragma unroll
                            for (int e = 0; e < 4; ++e) if (4 * g + e == l15) ga[e] += 1.0f; }
                        u32x2 w; w.x = pk2(ga[0] * pl, ga[1] * pl); w.y = pk2(ga[2] * pl, ga[3] * pl);
                        *(LAS u32x2*)(tgs + (16 * krt + l15) * 64 + 32 * (kct >> 1) + 8 * g + 4 * (kct & 1)) = w; } }
                { u32x4* gp16 = (u32x4*)((bf16*)(ws + WS_GP) + (size_t)un * 4096);
#pragma unroll
                  for (int i = 0; i < 8; ++i) gp16[i * 64 + lane] = *(const LAS u32x4*)(tgs + (i * 64 + lane) * 8); }
#pragma unroll
                for (int mt = 0; mt < 4; ++mt) { const f32x4 pl4 = *(const LAS f32x4*)(PLs + 16 * mt + 4 * g);
#pragma unroll
                    for (int vt = 0; vt < 4; ++vt) { f32x4 ha = __builtin_amdgcn_mfma_f32_16x16x32_bf16(fBT[mt], fQ1[vt], z4, 0, 0, 0); ha = __builtin_amdgcn_mfma_f32_16x16x32_bf16(fKT[mt], fV[vt], ha, 0, 0, 0);
                        u32x2 w; w.x = pk2(ha[0] * pl4[0], ha[1] * pl4[1]); w.y = pk2(ha[2] * pl4[2], ha[3] * pl4[3]);
                        *(u32x2*)((bf16*)(ws + WS_HF) + ((size_t)((un * 4 + vt) * 4 + mt) * 64 + lane) * 4) = w; } }
            }
            asm volatile("s_waitcnt lgkmcnt(0)" ::: "memory");
        }
        asm volatile("s_waitcnt vmcnt(0)" ::: "memory");
        { const int ltid = fresh_tid() & 63, l15 = ltid & 15, g = ltid >> 4, lane = ltid;
#define CP_LOADG(gf_, j_) do { const bf16* gp_ = (const bf16*)(ws + WS_GP) + ((size_t)u64 * 4 + (j_)) * 4096 + l15 * 64 + 8 * g; \
            _Pragma("unroll") for (int mt = 0; mt < 4; ++mt) { gf_[mt][0] = *(const bf16x8*)(gp_ + mt * 1024); gf_[mt][1] = *(const bf16x8*)(gp_ + mt * 1024 + 32); } } while (0)
#define CP_LOADH(hf_, j_) do { _Pragma("unroll") for (int sl = 0; sl < 4; ++sl) _Pragma("unroll") for (int mt = 0; mt < 4; ++mt) \
            hf_[sl][mt] = *(const u32x2*)((const bf16*)(ws + WS_HF) + ((size_t)((((size_t)u64 * 4 + (j_)) * 4 + sl) * 4 + mt) * 64 + lane) * 4); } while (0)
#define CP_STEP(gf_, hf_, useh_) do { _Pragma("unroll") for (int sl = 0; sl < 4; ++sl) { bf16x8 zb[2]; RW_ZB(z[sl], zb); \
            _Pragma("unroll") for (int mt = 0; mt < 4; ++mt) { f32x4 a_ = (f32x4){0.f, 0.f, 0.f, 0.f}; \
                if (useh_) { a_[0] = bflo(hf_[sl][mt].x); a_[1] = bfhi(hf_[sl][mt].x); a_[2] = bflo(hf_[sl][mt].y); a_[3] = bfhi(hf_[sl][mt].y); } \
                a_ = __builtin_amdgcn_mfma_f32_16x16x32_bf16(gf_[mt][0], zb[0], a_, 0, 0, 0); a_ = __builtin_amdgcn_mfma_f32_16x16x32_bf16(gf_[mt][1], zb[1], a_, 0, 0, 0); z[sl][mt] = a_; } } } while (0)
        {
            f32x4 z[4][4];
#pragma unroll
            for (int sl = 0; sl < 4; ++sl)
#pragma unroll
                for (int mt = 0; mt < 4; ++mt)
#pragma unroll
                    for (int e = 0; e < 4; ++e) z[sl][mt][e] = (sl == mt && 4 * g + e == l15) ? 1.0f : 0.0f;
            bf16x8 gA[4][2], gB[4][2]; u32x2 hdum[4][4];
            CP_LOADG(gA, 0); CP_LOADG(gB, 1);
            CP_STEP(gA, hdum, false); CP_LOADG(gA, 2);
            CP_STEP(gB, hdum, false); CP_LOADG(gB, 3);
            CP_STEP(gA, hdum, false);
            CP_STEP(gB, hdum, false);
            LAS bf16* tg = (LAS bf16*)(lds + wave * 16384);
#pragma unroll
            for (int sl = 0; sl < 4; ++sl) { const int pc = 32 * (sl >> 1) + 8 * (l15 >> 2) + 4 * (sl & 1) + (l15 & 3);
#pragma unroll
                for (int mt = 0; mt < 4; ++mt)
#pragma unroll
                    for (int e = 0; e < 4; ++e) tg[(16 * mt + 4 * g + e) * 64 + pc] = (bf16)f2bf(z[sl][mt][e]); }
            u32x4* gc = (u32x4*)((bf16*)(ws + WS_GC) + (size_t)u64 * 4096);
#pragma unroll
            for (int i = 0; i < 8; ++i) gc[i * 64 + lane] = *(const LAS u32x4*)(tg + (i * 64 + lane) * 8);
        }
        {
            f32x4 z[4][4];
#pragma unroll
            for (int sl = 0; sl < 4; ++sl)
#pragma unroll
                for (int mt = 0; mt < 4; ++mt) z[sl][mt] = (f32x4){0.f, 0.f, 0.f, 0.f};
            bf16x8 gA[4][2], gB[4][2]; u32x2 hA[4][4], hB[4][4];
            CP_LOADG(gA, 0); CP_LOADH(hA, 0); CP_LOADG(gB, 1); CP_LOADH(hB, 1);
            CP_STEP(gA, hA, true); CP_LOADG(gA, 2); CP_LOADH(hA, 2);
            CP_STEP(gB, hB, true); CP_LOADG(gB, 3); CP_LOADH(hB, 3);
            CP_STEP(gA, hA, true);
            CP_STEP(gB, hB, true);
#pragma unroll
            for (int sl = 0; sl < 4; ++sl)
#pragma unroll
                for (int mt = 0; mt < 4; ++mt) { u32x2 w; w.x = pk2(z[sl][mt][0], z[sl][mt][1]); w.y = pk2(z[sl][mt][2], z[sl][mt][3]);
                    *(u32x2*)((bf16*)(ws + WS_HC) + ((size_t)((u64 * 4 + sl) * 4 + mt) * 64 + lane) * 4) = w; }
        }
#undef CP_LOADG
#undef CP_LOADH
#undef CP_STEP
        }
        }
    }
    SEAM(3);


    if (IN(4)) { PHASE_IDS;
        if (!(bid < 128 && wave == 0)) {
            const int wi = bid < 128 ? bid * 7 + (wave - 1) : 896 + (bid - 128) * 8 + wave, NW = 896 + (G - 128) * 8;
        } else {
            const int l15 = lane & 15, g = lane >> 4, bh = bid >> 2, vs = bid & 3;
            f32x4 z[4];
#pragma unroll
            for (int mt = 0; mt < 4; ++mt) z[mt] = (f32x4){0.f, 0.f, 0.f, 0.f};
            bf16x8 gA[4][2], gB[4][2], gC[4][2], gD[4][2]; u32x2 hA[4], hB[4], hC[4], hD[4];
#define SC_LOAD(gf, hf, C) do { const size_t u64_ = (size_t)bh * 64 + (C); const bf16* gp_ = (const bf16*)(ws + WS_GC) + u64_ * 4096 + l15 * 64 + 8 * g; \
                _Pragma("unroll") for (int mt = 0; mt < 4; ++mt) { gf[mt][0] = *(const bf16x8*)(gp_ + mt * 1024); gf[mt][1] = *(const bf16x8*)(gp_ + mt * 1024 + 32); \
                    hf[mt] = *(const u32x2*)((const bf16*)(ws + WS_HC) + ((size_t)((u64_ * 4 + vs) * 4 + mt) * 64 + lane) * 4); } } while (0)
#define SC_STEP(gf, hf, C) do { const size_t u64_ = (size_t)bh * 64 + (C); bf16* zs_ = (bf16*)(ws + WS_ZS) + ((size_t)((u64_ * 4 + vs) * 4) * 64 + lane) * 4; \
                _Pragma("unroll") for (int mt = 0; mt < 4; ++mt) { u32x2 zw_; zw_.x = pk2(z[mt][0], z[mt][1]); zw_.y = pk2(z[mt][2], z[mt][3]); *(u32x2*)(zs_ + mt * 256) = zw_; } \
                bf16x8 zb[2]; RW_ZB(z, zb); \
                _Pragma("unroll") for (int mt = 0; mt < 4; ++mt) { f32x4 a; a[0] = bflo(hf[mt].x); a[1] = bfhi(hf[mt].x); a[2] = bflo(hf[mt].y); a[3] = bfhi(hf[mt].y); \
                    a = __builtin_amdgcn_mfma_f32_16x16x32_bf16(gf[mt][0], zb[0], a, 0, 0, 0); a = __builtin_amdgcn_mfma_f32_16x16x32_bf16(gf[mt][1], zb[1], a, 0, 0, 0); z[mt] = a; } } while (0)
            SC_LOAD(gA, hA, 0); SC_LOAD(gB, hB, 1); SC_LOAD(gC, hC, 2);
#pragma unroll 1
            for (int C = 0; C < 64; C += 4) {
                SC_LOAD(gD, hD, C + 3);
                SC_STEP(gA, hA, C);
                if (C + 4 < 64) SC_LOAD(gA, hA, C + 4);
                SC_STEP(gB, hB, C + 1);
                if (C + 5 < 64) SC_LOAD(gB, hB, C + 5);
                SC_STEP(gC, hC, C + 2);
                if (C + 6 < 64) SC_LOAD(gC, hC, C + 6);
                SC_STEP(gD, hD, C + 3);
            }
#undef SC_LOAD
#undef SC_STEP
        }
    }
    if (IN(4)) { PHASE_IDS;
        if (bid < 32 && wave == 1) { const int bc = bid; const f32x2* ag = (const f32x2*)((const float*)(ws + WS_AP)) + (size_t)(bc * 64) * 64 + lane;
            float* car = (float*)(ws + WS_AP + 4 * MiB) + (size_t)(bc * 64) * 64 + lane; float hst = 0.f;
#pragma unroll 16
            for (int sg = 0; sg < 64; ++sg) { const f32x2 ab = ag[(size_t)sg * 64]; car[(size_t)sg * 64] = hst; hst = ab.x * hst + ab.y; } }
    }
    if (IN(4)) { PHASE_IDS;
        bf16* WKt = HN; bf16* VWt = HN + (size_t)4 * 1024 * 1024;
        __syncthreads();
        if (bid >= 128 && bid < 192) { pg8::FoldSched<0> S; S.A = (const char*)KM; S.B = (const char*)Wq_t; S.G = 64; S.c = bid - 128; EpiFold<0> E{WKt}; pg8::gemm_phase(lds, 256, S, E, wv0, 1024); }
        else if (bid >= 192) { pg8::FoldSched<1> S; S.A = (const char*)Wo_t; S.B = (const char*)VT; S.G = 64; S.c = bid - 192; EpiFold<1> E{VWt}; pg8::gemm_phase(lds, 256, S, E, wv0, 1024); }
    }
    SEAM(4);

    if (IN(5)) { PHASE_IDS;
        {
            for (int lu = gw; lu < (M / 64) * 8; lu += NGW) {
                const int seg = lu >> 3, nb = lu & 7, rr = lane >> 3, cq = lane & 7;
                const float* cp = (const float*)(ws + WS_AP + 4 * MiB) + ((size_t)(((seg >> 6) * 8 + nb) * 64 + (seg & 63)) * 64 + 8 * cq);
                const f32x4 c0 = *(const f32x4*)cp, c1 = *(const f32x4*)(cp + 4);
#pragma unroll
                for (int it = 0; it < 8; ++it) { const size_t m = (size_t)seg * 64 + 8 * it + rr; const size_t o = m * 512 + nb * 64 + 8 * cq;
                    const u32x4 pw = *(const u32x4*)(LA + o), hw = *(const u32x4*)(LB + o), gw_ = *(const u32x4*)(U + m * INW + 512 + nb * 64 + 8 * cq);
                    float y[8];
#pragma unroll
                    for (int q = 0; q < 4; ++q) { const float ca = q < 2 ? c0[2 * q] : c1[2 * q - 4], cb = q < 2 ? c0[2 * q + 1] : c1[2 * q - 3];
                        y[2 * q] = (bflo(hw[q]) + bflo(pw[q]) * ca) * gelu_tanh_f(bflo(gw_[q])); y[2 * q + 1] = (bfhi(hw[q]) + bfhi(pw[q]) * cb) * gelu_tanh_f(bfhi(gw_[q])); }
                    u32x4 w; w.x = pk2(y[0], y[1]); w.y = pk2(y[2], y[3]); w.z = pk2(y[4], y[5]); w.w = pk2(y[6], y[7]);
                    *(u32x4*)(CAT + m * 1024 + nb * 64 + 8 * cq) = w; }
            }
        }
        const int l15 = lane & 15, g = lane >> 4;
        LAS bf16* tGL = (LAS bf16*)(lds + wave * 16384); LAS bf16* tAD = tGL + 1024; LAS bf16* tOUT = tGL + 2048;
        const int ct = lane >> 3, cc = lane & 7;
        for (int u64 = gw; u64 < NB * NH * (SEQ / 64); u64 += NGW) {
            const int bh = u64 >> 6, C = u64 & 63, b = bh >> 3, h = bh & 7;
            f32x4 z[4][4];
#pragma unroll
            for (int sl = 0; sl < 4; ++sl)
#pragma unroll
                for (int mt = 0; mt < 4; ++mt) { const u32x2 zw = *(const u32x2*)((const bf16*)(ws + WS_ZS) + ((size_t)((u64 * 4 + sl) * 4 + mt) * 64 + lane) * 4); z[sl][mt] = (f32x4){bflo(zw.x), bfhi(zw.x), bflo(zw.y), bfhi(zw.y)}; }
#pragma unroll 1
            for (int j = 0; j < 4; ++j) {
                const size_t un = (size_t)u64 * 4 + j; const size_t m0 = (size_t)b * SEQ + (C * 4 + j) * 16;
                const bf16* rp = (const bf16*)(ws + WS_RP) + un * 1024 + l15 * 64 + 8 * g;
                const bf16x8 rf0 = *(const bf16x8*)rp, rf1 = *(const bf16x8*)(rp + 32);
                f32x4 y[4];
#pragma unroll
                for (int sl = 0; sl < 4; ++sl) y[sl] = *(const f32x4*)((const float*)(ws + WS_Y1F) + ((size_t)(un * 4 + sl) * 64 + lane) * 4);
                const size_t rg = (m0 + ct) * 512 + h * 64 + 8 * cc;
                const u32x4 gl0 = *(const u32x4*)((const bf16*)(ws + WS_G) + rg), gl1 = *(const u32x4*)((const bf16*)(ws + WS_G) + rg + 8 * 512);
                const u32x4 ad0 = *(const u32x4*)((const bf16*)(ws + WS_ADD) + rg), ad1 = *(const u32x4*)((const bf16*)(ws + WS_ADD) + rg + 8 * 512);
                bf16x8 gf[4][2]; u32x2 hfr[4][4];
                if (j < 3) {
                    const bf16* gp = (const bf16*)(ws + WS_GP) + un * 4096 + l15 * 64 + 8 * g;
#pragma unroll
                    for (int mt = 0; mt < 4; ++mt) { gf[mt][0] = *(const bf16x8*)(gp + mt * 1024); gf[mt][1] = *(const bf16x8*)(gp + mt * 1024 + 32); }
#pragma unroll
                    for (int sl = 0; sl < 4; ++sl)
#pragma unroll
                        for (int mt = 0; mt < 4; ++mt) hfr[sl][mt] = *(const u32x2*)((const bf16*)(ws + WS_HF) + ((size_t)((un * 4 + sl) * 4 + mt) * 64 + lane) * 4);
                }
                *(LAS u32x4*)(tGL + ct * 64 + 8 * cc) = gl0; *(LAS u32x4*)(tGL + (ct + 8) * 64 + 8 * cc) = gl1;
                *(LAS u32x4*)(tAD + ct * 64 + 8 * cc) = ad0; *(LAS u32x4*)(tAD + (ct + 8) * 64 + 8 * cc) = ad1;
                bf16x8 zb[4][2];
#pragma unroll
                for (int sl = 0; sl < 4; ++sl) { RW_ZB(z[sl], zb[sl]);
                    y[sl] = __builtin_amdgcn_mfma_f32_16x16x32_bf16(rf0, zb[sl][0], y[sl], 0, 0, 0); y[sl] = __builtin_amdgcn_mfma_f32_16x16x32_bf16(rf1, zb[sl][1], y[sl], 0, 0, 0); }
#pragma unroll
                for (int e = 0; e < 4; ++e) {
                    float s1 = (y[0][e] + y[1][e]) + (y[2][e] + y[3][e]);
                    s1 += __shfl_xor(s1, 1); s1 += __shfl_xor(s1, 2); s1 += __shfl_xor(s1, 4); s1 += __shfl_xor(s1, 8);
                    const float mean = s1 * (1.0f / 64.0f);
                    float d0 = y[0][e] - mean, d1 = y[1][e] - mean, d2 = y[2][e] - mean, d3 = y[3][e] - mean;
                    float s2 = (d0 * d0 + d1 * d1) + (d2 * d2 + d3 * d3);
                    s2 += __shfl_xor(s2, 1); s2 += __shfl_xor(s2, 2); s2 += __shfl_xor(s2, 4); s2 += __shfl_xor(s2, 8);
                    const float rstd = rsq_f(s2 * (1.0f / 64.0f) + GN_EPS);
                    const float dd[4] = {d0, d1, d2, d3};
#pragma unroll
                    for (int sl = 0; sl < 4; ++sl) { const int ti_ = (4 * g + e) * 64 + 16 * sl + l15;
                        const float o = dd[sl] * rstd * bf2f(tGL[ti_]) + bf2f(tAD[ti_]); tOUT[ti_] = (bf16)f2bf(o); }
                }
                { bf16* cp = CAT + (m0 + ct) * 1024 + 512 + h * 64 + 8 * cc;
                  *(u32x4*)cp = *(const LAS u32x4*)(tOUT + ct * 64 + 8 * cc); *(u32x4*)(cp + 8 * 1024) = *(const LAS u32x4*)(tOUT + (ct + 8) * 64 + 8 * cc); }
                if (j < 3) {
#pragma unroll
                    for (int sl = 0; sl < 4; ++sl)
#pragma unroll
                        for (int mt = 0; mt < 4; ++mt) { const u32x2 hh = hfr[sl][mt];
                            f32x4 a; a[0] = bflo(hh.x); a[1] = bfhi(hh.x); a[2] = bflo(hh.y); a[3] = bfhi(hh.y);
                            a = __builtin_amdgcn_mfma_f32_16x16x32_bf16(gf[mt][0], zb[sl][0], a, 0, 0, 0); a = __builtin_amdgcn_mfma_f32_16x16x32_bf16(gf[mt][1], zb[sl][1], a, 0, 0, 0); z[sl][mt] = a; }
                }
            }
        }
    }
    SEAM(5);
#undef RW_ZB


    if (IN(6)) { PHASE_IDS;
        pg8::DenseSched S; S.o.init_tiles(M / 256, D / 256, G, bid); S.A = (const char*)CAT; S.B = (const char*)Wout_t; S.tstep = (size_t)256 * D * 2;
        EpiBf16Res<false> E{args.in[I_X], X1, D, (float*)(ws + WS_AP + 2 * MiB)}; pg8::gemm_phase(lds, D, S, E, wv0);
    }
    SEAM(6);
    if (IN(7)) { PHASE_IDS;
        pg8::BatchBSched S; S.o.init_tiles(M / 256, D / 256, G, bid); S.A = (const char*)X1; S.B = (const char*)HN; S.tstep = (size_t)256 * D * 2; S.bstep = (size_t)1024 * 1024 * 2;
        EpiSoftmax E{Qb, 0.0625f, (const float*)(ws + WS_AP + 2 * MiB), (LAS float*)(lds + RING_BYTES + 1024), (LAS float*)(lds + RING_BYTES + 1024 + 4096)};
        pg8::gemm_phase(lds, D, S, E, wv0);
    }
    SEAM(7);
    if (IN(8)) { PHASE_IDS;
        pg8::BatchBSched S; S.o.init_tiles(M / 256, D / 256, G, bid); S.A = (const char*)Qb; S.B = (const char*)(HN + (size_t)4 * 1024 * 1024); S.tstep = (size_t)256 * D * 2; S.bstep = (size_t)1024 * 1024 * 2;
        EpiBf16Res<true> E{X1, X2, D, nullptr}; pg8::gemm_phase(lds, D, S, E, wv0);
    }
    SEAM(8);
    if (IN(9)) { PHASE_IDS;
        for (int cid = tid; cid < 2 * NE * 128; cid += NTHREADS) { const int t = cid >> 12, row = (cid >> 7) & 31, c = cid & 127;
            *(LAS u32x4*)(lds + t * 65536 + row * 2048 + ((c ^ (row & 7)) << 4)) = *(const u32x4*)(WrT + (size_t)t * NE * D + row * D + 8 * c); }
        __syncthreads();
        const int l15 = lane & 15, g = lane >> 4;
        LAS float* LG = (LAS float*)(lds + RING_BYTES + 1024 + wave * 2304);
        const float* gfn = args.in[I_NFFG];
        LAS unsigned* cntl = (LAS unsigned*)(lds + RING_BYTES + 640);
        for (int t0 = 0; t0 < M / 16; t0 += G * 4) {
        if (tid < 64) cntl[tid] = 0u;
        __syncthreads();
        if (t0 == 0 && wave >= 4) {
            constexpr int I_DN = 16 * 32;
            for (int r = bid * 4 + (wave - 4); r < CONV_P9D; r += G * 4) { const int e = r / I_DN, q = r % I_DN, kb = q / 32, nb = q % 32;
                transpose_item_tiled_fp8_nolds(args.in[I_WDN] + (size_t)e * DFF * D, D, DFF, (unsigned char*)Wdn_t + (size_t)e * D * DFF, 64 * kb, 32 * nb, 32 * nb, lane); }
        }
        const int tile = t0 + bid * 4 + wave; const bool active = wave < 4 && tile < M / 16;
        int me = 0, lpos = 0, ai = 0; float mg = 0.f;
        if (active) {
            const int m0 = tile * 16;
            const bf16* xrow = X2 + (size_t)(m0 + l15) * D + 8 * g;
            float ss = 0.f;
#pragma unroll 8
            for (int ks = 0; ks < 32; ++ks) { const u32x4 xw = *(const u32x4*)(xrow + 32 * ks);
#pragma unroll
                for (int q = 0; q < 4; ++q) { const float a = bflo(xw[q]), c = bfhi(xw[q]); ss += a * a + c * c; } }
            ss += __shfl_xor(ss, 16); ss += __shfl_xor(ss, 32);
            const float rstd = rsq_f(ss * (1.f / D) + EPS);
            f32x4 acc0 = (f32x4){0.f, 0.f, 0.f, 0.f}, acc1 = acc0;
            unsigned char* hrow = (unsigned char*)HN + (size_t)(m0 + l15) * D + 8 * g;
#pragma unroll 2
            for (int ks = 0; ks < 32; ++ks) {
                const f32x4 g0 = *(const f32x4*)(gfn + 32 * ks + 8 * g), g1 = *(const f32x4*)(gfn + 32 * ks + 8 * g + 4);
                const u32x4 xw = *(const u32x4*)(xrow + 32 * ks);
                float hf[8];
#pragma unroll
                for (int q = 0; q < 4; ++q) { hf[2 * q] = bflo(xw[q]) * rstd * (q < 2 ? g0[2 * q] : g1[2 * q - 4]); hf[2 * q + 1] = bfhi(xw[q]) * rstd * (q < 2 ? g0[2 * q + 1] : g1[2 * q - 3]); }
                u32x4 hi, lo;
#pragma unroll
                for (int q = 0; q < 4; ++q) { hi[q] = pk2(hf[2 * q], hf[2 * q + 1]); lo[q] = pk2(hf[2 * q] - bflo(hi[q]), hf[2 * q + 1] - bfhi(hi[q])); }
                { u32x2 h8; h8.x = pk4_fp8(hf[0], hf[1], hf[2], hf[3]); h8.y = pk4_fp8(hf[4], hf[5], hf[6], hf[7]); *(u32x2*)(hrow + 32 * ks) = h8; }
                const bf16x8 ah = __builtin_bit_cast(bf16x8, hi), al = __builtin_bit_cast(bf16x8, lo);
                const int c = 4 * ks + g;
#pragma unroll
                for (int nt = 0; nt < 2; ++nt) { const int row = 16 * nt + l15; const int off = row * 2048 + ((c ^ (row & 7)) << 4);
                    const bf16x8 bh = *(const LAS bf16x8*)(lds + off), bl = *(const LAS bf16x8*)(lds + 65536 + off);
                    f32x4 a = nt ? acc1 : acc0;
                    a = __builtin_amdgcn_mfma_f32_16x16x32_bf16(ah, bh, a, 0, 0, 0); a = __builtin_amdgcn_mfma_f32_16x16x32_bf16(ah, bl, a, 0, 0, 0); a = __builtin_amdgcn_mfma_f32_16x16x32_bf16(al, bh, a, 0, 0, 0);
                    if (nt) acc1 = a; else acc0 = a; }
            }
            { const float b0 = args.in[I_BR][l15], b1 = args.in[I_BR][16 + l15];
#pragma unroll
              for (int j = 0; j < 4; ++j) { LG[(4 * g + j) * 33 + l15] = acc0[j] + b0; LG[(4 * g + j) * 33 + 16 + l15] = acc1[j] + b1; } }
            const int rrow = lane >> 2, qq = lane & 3;
            float tv[4] = {-3.0e38f, -3.0e38f, -3.0e38f, -3.0e38f}; int ti[4] = {64, 65, 66, 67};
#define TOP_INS(xv_, xi_) do { float x_ = (xv_); int i_ = (xi_); _Pragma("unroll") for (int p_ = 0; p_ < 4; ++p_) { const bool b_ = x_ > tv[p_] || (x_ == tv[p_] && i_ < ti[p_]); \
                const float ov_ = tv[p_]; const int oi_ = ti[p_]; tv[p_] = b_ ? x_ : ov_; ti[p_] = b_ ? i_ : oi_; x_ = b_ ? ov_ : x_; i_ = b_ ? oi_ : i_; } } while (0)
#pragma unroll
            for (int j = 0; j < 8; ++j) TOP_INS(LG[rrow * 33 + 8 * qq + j], 8 * qq + j);
#pragma unroll
            for (int st = 1; st < 4; st <<= 1) { float pv[4]; int pi[4];
#pragma unroll
                for (int p = 0; p < 4; ++p) { pv[p] = __shfl_xor(tv[p], st); pi[p] = __shfl_xor(ti[p], st); }
#pragma unroll
                for (int p = 0; p < 4; ++p) TOP_INS(pv[p], pi[p]); }
#undef TOP_INS
            const float e1 = __expf(tv[1] - tv[0]), e2 = __expf(tv[2] - tv[0]), e3 = __expf(tv[3] - tv[0]);
            const float inv = rcp_f(1.0f + e1 + e2 + e3);
            me = qq == 0 ? ti[0] : qq == 1 ? ti[1] : qq == 2 ? ti[2] : ti[3];
            mg = (qq == 0 ? 1.0f : qq == 1 ? e1 : qq == 2 ? e2 : e3) * inv;
            lpos = (int)__hip_atomic_fetch_add(cntl + me, 1u, __ATOMIC_RELAXED, __HIP_MEMORY_SCOPE_WORKGROUP);
            ai = (m0 + rrow) * 4 + qq;
        }
        __syncthreads();
        if (tid < NE) { const unsigned c = cntl[tid]; cntl[32 + tid] = c ? atomicAdd(ecnt + 64 * tid, c) : 0u; }
        __syncthreads();
        if (active) { route_e[ai] = me; route_pos[ai] = (int)cntl[32 + me] + lpos; route_g[ai] = mg; }
        __syncthreads();
        }
    }
    SEAM(9);
    if (IN(10)) { PHASE_IDS;
        LAS int* pst = (LAS int*)lds;
        if (tid == 0) { int acc = 0; for (int e = 0; e < NE; ++e) { const int c = (int)__hip_atomic_load(ecnt + 64 * e, __ATOMIC_RELAXED, __HIP_MEMORY_SCOPE_AGENT); pst[e] = acc; pst[64 + e] = c; acc += (c + 255) & ~255; } pst[32] = acc; }
        __syncthreads();
        for (int ai = bid * NTHREADS + tid; ai < NASSIGN; ai += G * NTHREADS) {
            const int e = route_e[ai]; const int row = pst[e] + route_pos[ai]; { u32x2 sg_; sg_.x = (unsigned)ai; sg_.y = __float_as_uint(route_g[ai]); row_sg[row] = sg_; } row_tok[row] = ai >> 2; }
        if (bid < NE) { const int e = bid, c = pst[64 + e], pe = (c + 255) & ~255; for (int p = c + tid; p < pe; p += NTHREADS) { u32x2 sg_; sg_.x = 0xffffffffu; sg_.y = 0u; row_sg[pst[e] + p] = sg_; row_tok[pst[e] + p] = 0; } }
        if (bid == 0 && tid == 0) { int nt = 0; for (int e = 0; e < NE; ++e) { const int n = ((pst[64 + e] + 255) & ~255) >> 8; for (int j = 0; j < n; ++j) tile_tab[16 + nt++] = e; } tile_tab[0] = nt; }
        if (bid == 1 || bid == 2) { const int nt = pst[32] >> 8, nN = bid == 1 ? 8 : 4; int* tab = (int*)(ws + WS_ROUTE + (bid == 1 ? RT_UGU : RT_UDN));
            for (int L = tid; L < nt * nN; L += NTHREADS) { Unit uu; { const int nwg = nt * nN; int wgid = L; { const int q = nwg / 8, r = nwg % 8, xcd = wgid % 8, off = wgid / 8; wgid = (xcd < r ? xcd * (q + 1) : r * (q + 1) + (xcd - r) * q) + off; }
                    const int nig = 8 * nN, gid = wgid / nig, fm = gid * 8, gsz = (nt - fm) < 8 ? (nt - fm) : 8; uu.pm = fm + ((wgid % nig) % gsz); uu.pn = (wgid % nig) / gsz; uu.e = 0; }
                int e = 0; while (e < NE - 1 && (pst[e + 1] >> 8) <= uu.pm) ++e;
                tab[L] = uu.pm | (uu.pn << 12) | (e << 16); } }
        __syncthreads();
    }
    SEAM(10);
    if (IN(11)) {
        const int ntiles = tile_tab[0];
        pg8::MoeGatherSched S; S.o.init_tiles(ntiles, 2048 / 256, G, bid); S.A = (const char*)HN; S.B = (const char*)Wgu_t; S.tile_e = tile_tab + 16; S.utab = (const int*)(ws + WS_ROUTE + RT_UGU); S.rtok = row_tok; S.tstep = (size_t)256 * 1024; S.estep = (size_t)2048 * 1024;
        EpiSwiglu E{ACT, args.in[I_BGU]}; pg8::gemm_phase<EpiSwiglu, pg8::MoeGatherSched, true, true>(lds, 512, S, E, wv0);
        { PHASE_IDS; LAS float* scr = (LAS float*)(lds + wave * 16384); constexpr int I_DN = 16 * 32;
          for (;;) { int c0 = 0; if (lane == 0) c0 = (int)atomicAdd(ctl + CW_CONV, 8u); c0 = __builtin_amdgcn_readfirstlane(c0);
              c0 += CONV_P9D; if (c0 >= NE * I_DN) break;
              for (int r = c0; r < c0 + 8; ++r) { const int e = r / I_DN, q = r % I_DN, kb = q / 32, nb = q % 32;
                  transpose_item_tiled_fp8(args.in[I_WDN] + (size_t)e * DFF * D, D, DFF, (unsigned char*)Wdn_t + (size_t)e * D * DFF, 64 * kb, 32 * nb, 32 * nb, scr, lane); } } }
    }
    SEAM(11);
    if (IN(12)) {
        const int ntiles = tile_tab[0];
        pg8::MoeSched S; S.o.init_tiles(ntiles, D / 256, G, bid); S.A = (const char*)ACT; S.B = (const char*)Wdn_t; S.tile_e = tile_tab + 16; S.utab = (const int*)(ws + WS_ROUTE + RT_UDN); S.tstep = (size_t)256 * 1024; S.estep = (size_t)1024 * 1024;
        EpiDown E{YS, args.in[I_BDN], row_sg}; pg8::gemm_phase<EpiDown, pg8::MoeSched, true, true>(lds, 512, S, E, wv0);
    }
    SEAM(12);
    if (IN(13)) { PHASE_IDS;
        const float* gfin = args.in[I_FNG];
        for (int m = gw; m < M; m += NGW) {
            float v[16]; float s = 0.f;
#pragma unroll
            for (int hf = 0; hf < 2; ++hf) { const u32x4 w = *(const u32x4*)(X2 + (size_t)m * D + 512 * hf + 8 * lane);
#pragma unroll
                for (int q = 0; q < 4; ++q) { v[8 * hf + 2 * q] = bflo(w[q]); v[8 * hf + 2 * q + 1] = bfhi(w[q]); }
#pragma unroll
                for (int k = 0; k < 4; ++k) { const u32x4 y = *(const u32x4*)(YS + (size_t)(m * 4 + k) * D + 512 * hf + 8 * lane);
#pragma unroll
                    for (int q = 0; q < 4; ++q) { v[8 * hf + 2 * q] += bflo(y[q]); v[8 * hf + 2 * q + 1] += bfhi(y[q]); } } }
#pragma unroll
            for (int j = 0; j < 16; ++j) s += v[j] * v[j];
            const float rstd = rsq_f(wave_sum(s) * (1.f / D) + EPS);
#pragma unroll
            for (int hf = 0; hf < 2; ++hf) { const f32x4 g0 = *(const f32x4*)(gfin + 512 * hf + 8 * lane), g1 = *(const f32x4*)(gfin + 512 * hf + 8 * lane + 4);
                float* o = args.out + (size_t)m * D + 512 * hf + 8 * lane;
                *(f32x4*)o = (f32x4){v[8 * hf] * rstd * g0.x, v[8 * hf + 1] * rstd * g0.y, v[8 * hf + 2] * rstd * g0.z, v[8 * hf + 3] * rstd * g0.w};
                *(f32x4*)(o + 4) = (f32x4){v[8 * hf + 4] * rstd * g1.x, v[8 * hf + 5] * rstd * g1.y, v[8 * hf + 6] * rstd * g1.z, v[8 * hf + 7] * rstd * g1.w}; }
        }
    }
#undef IN
#undef SEAM
}

constexpr int N_PHASES = 14;
extern "C" void kernel_launch(void* const* d_in, const int* in_sizes, int n_in, void* d_out, int out_size, void* d_ws, size_t ws_size, hipStream_t stream) {
    static int grid = 0;
    if (grid == 0) {
        if (n_in != 37 || out_size != M * D || ws_size < WS_END) { fprintf(stderr, "kernel_launch: unexpected shapes (n_in %d, out %d, ws %zu); nothing launched\n", n_in, out_size, ws_size); grid = -1; return; }
        int dev = 0, cus = 0, per_cu = 0;
        if (hipGetDevice(&dev) != hipSuccess || hipDeviceGetAttribute(&cus, hipDeviceAttributeMultiprocessorCount, dev) != hipSuccess) { grid = -1; return; }
        if (hipFuncSetAttribute((const void*)fwd, hipFuncAttributeMaxDynamicSharedMemorySize, LDS_BYTES) != hipSuccess) { fprintf(stderr, "kernel_launch: hipFuncSetAttribute failed\n"); grid = -1; return; }
        if (hipOccupancyMaxActiveBlocksPerMultiprocessor(&per_cu, (const void*)fwd, NTHREADS, LDS_BYTES) != hipSuccess || per_cu < 1) fprintf(stderr, "kernel_launch: occupancy query says %d\n", per_cu);
        (void)hipGetLastError();
        grid = cus > 256 ? 256 : cus;
    }
    if (grid < 0) return;
    if (hipMemsetAsync((char*)d_ws + WS_CTL, 0, CTL_ZERO_BYTES, stream) != hipSuccess) return;
    Args a{};
    for (int i = 0; i < 37; ++i) a.in[i] = (const float*)d_in[i];
    a.out = (float*)d_out; a.ws = (unsigned char*)d_ws;
#if MK_ONE_LAUNCH
    a.ph_lo = 0; a.ph_hi = N_PHASES;
    hipLaunchKernelGGL(fwd, dim3(grid), dim3(NTHREADS), LDS_BYTES, stream, a);
#else
    for (int p = 0; p < N_PHASES; ++p) { a.ph_lo = p; a.ph_hi = p + 1; hipLaunchKernelGGL(fwd, dim3(grid), dim3(NTHREADS), LDS_BYTES, stream, a);
#ifdef PROBE_REPEAT_PHASE
        if (p == PROBE_REPEAT_PHASE) hipLaunchKernelGGL(fwd, dim3(grid), dim3(NTHREADS), LDS_BYTES, stream, a);
#endif
    }
#endif
}
```

```cpp
#include <hip/hip_runtime.h>
#include <cstdio>
#include <cstdint>

#ifndef MK_ONE_LAUNCH
#define MK_ONE_LAUNCH 1
#endif

#define DI __device__ __forceinline__
#define GAS __attribute__((address_space(1)))
#define LAS __attribute__((address_space(3)))
typedef unsigned short bf16;
typedef short bf16x8 __attribute__((ext_vector_type(8)));
typedef int v4i __attribute__((ext_vector_type(4)));
typedef int v8i __attribute__((ext_vector_type(8)));
typedef float f32x4 __attribute__((ext_vector_type(4)));
typedef float f32x2 __attribute__((ext_vector_type(2)));
typedef unsigned u32x4 __attribute__((ext_vector_type(4)));
typedef unsigned u32x2 __attribute__((ext_vector_type(2)));

constexpr int D = 1024, NB = 4, SEQ = 4096, M = NB * SEQ;
constexpr int MEML = 256, MROWS = NB * MEML;
constexpr int LRU_W = 512, RW = 512, NH = 8, HD = 64;
constexpr int INW = 2816;
constexpr int XH = 4, XHD = 256;
constexpr int NE = 32, TOPK = 4, DFF = 1024;
constexpr int NASSIGN = M * TOPK;
constexpr int MAXTILES = 288, MAXROWS = MAXTILES * 256;
constexpr float EPS = 1e-6f, GN_EPS = 64e-5f;

DI int fresh_tid_(int wv) { int w = wv; asm volatile("" : "+s"(w)); int l; asm volatile("v_mbcnt_lo_u32_b32 %0, -1, 0\n\tv_mbcnt_hi_u32_b32 %0, -1, %0" : "=v"(l)); return (w << 6) | (l & 63); }
#define fresh_tid() fresh_tid_(wv0)
namespace pg8 {
constexpr int BM = 256, BK = 64, HALF = 128, HTB = HALF * BK * 2, STAGE_BYTES = 8 * HTB, NXCD = 8, WGM = 8;
__host__ __device__ __forceinline__ int lds_byte(int r, int c) { const int st = (r >> 4) * 2 + (c >> 5), rr = r & 15, cc = c & 31, ob = rr * 64 + cc * 2; return st * 1024 + (ob ^ (((ob >> 9) & 1) << 5)); }
__host__ __device__ __forceinline__ void stage_rc(int b, int& R, int& C) { const int st = b / 1024, sb = b % 1024, swz = sb ^ (((sb >> 9) & 1) << 5); R = (st >> 1) * 16 + swz / 64; C = (st & 1) * 32 + (swz % 64) / 2; }
__host__ __device__ __forceinline__ int perm32(int rho) { const int n = rho >> 4, i = rho & 15; return 8 * (i >> 2) + 4 * n + (i & 3); }

struct Unit { int pm, pn, e; };

struct StaticOrder {
    int nM, nN, nwg, G, c;
    __host__ __device__ void init_tiles(int nM_, int nN_, int G_, int c_) { nM = nM_; nN = nN_; nwg = nM * nN; G = G_; c = c_; }
    __host__ __device__ bool next(int i, Unit& u) const {
        const long L = (long)i * G + c; if (L >= nwg) return false;
        int wgid = (int)L; { const int q = nwg / NXCD, r = nwg % NXCD, xcd = wgid % NXCD, off = wgid / NXCD; wgid = (xcd < r ? xcd * (q + 1) : r * (q + 1) + (xcd - r) * q) + off; }
        const int nig = WGM * nN, gid = wgid / nig, fm = gid * WGM, gsz = (nM - fm) < WGM ? (nM - fm) : WGM;
        u.pm = fm + ((wgid % nig) % gsz); u.pn = (wgid % nig) / gsz; u.e = 0; return true;
    }
};
struct DenseSched {
    static constexpr bool GATHER = false, B_TILED = false;
    StaticOrder o; const char* A; const char* B; size_t tstep;
    DI bool next(int i, Unit& u) const { return o.next(i, u); }
    DI const char* a_ptr(const Unit& u) const { return A + (size_t)u.pm * tstep; }
    DI const char* b_ptr(const Unit& u) const { return B + (size_t)u.pn * tstep; }
    DI void a_voff(const Unit&, int K, const int (&R)[2], const int (&C)[2], unsigned (&vo)[2][2]) const {
#pragma unroll
        for (int h = 0; h < 2; ++h)
#pragma unroll
            for (int i = 0; i < 2; ++i) vo[h][i] = (unsigned)((h * HALF + R[i]) * K + C[i]) * 2u; }
};
struct MoeSched {
    static constexpr bool GATHER = false, B_TILED = true;
    StaticOrder o; const char* A; const char* B; const int* tile_e; const int* utab; size_t tstep, estep;
    DI bool next(int i, Unit& u) const { const int L = i * o.G + o.c; if (L >= o.nwg) return false; int en; asm volatile("s_load_dword %0, %1, 0x0\n\ts_waitcnt lgkmcnt(0)" : "=s"(en) : "s"(utab + L) : "memory");     u.pm = en & 0xfff; u.pn = (en >> 12) & 15; u.e = en >> 16; return true; }
    DI const char* a_ptr(const Unit& u) const { return A + (size_t)u.pm * tstep; }
    DI const char* b_ptr(const Unit& u) const { return B + (size_t)u.e * estep + (size_t)u.pn * tstep; }
    DI void a_voff(const Unit&, int K, const int (&R)[2], const int (&C)[2], unsigned (&vo)[2][2]) const {
#pragma unroll
        for (int h = 0; h < 2; ++h)
#pragma unroll
            for (int i = 0; i < 2; ++i) vo[h][i] = (unsigned)((h * HALF + R[i]) * K + C[i]) * 2u; }
};
struct MoeGatherSched {
    static constexpr bool GATHER = true, B_TILED = true;
    StaticOrder o; const char* A; const char* B; const int* tile_e; const int* utab; const int* rtok; size_t tstep, estep;
    DI bool next(int i, Unit& u) const { const int L = i * o.G + o.c; if (L >= o.nwg) return false; int en; asm volatile("s_load_dword %0, %1, 0x0\n\ts_waitcnt lgkmcnt(0)" : "=s"(en) : "s"(utab + L) : "memory");     u.pm = en & 0xfff; u.pn = (en >> 12) & 15; u.e = en >> 16; return true; }
    DI const char* a_ptr(const Unit&) const { return A; }
    DI const char* b_ptr(const Unit& u) const { return B + (size_t)u.e * estep + (size_t)u.pn * tstep; }
    DI void a_voff(const Unit& u, int K, const int (&R)[2], const int (&C)[2], unsigned (&vo)[2][2]) const {
#pragma unroll
        for (int h = 0; h < 2; ++h)
#pragma unroll
            for (int i = 0; i < 2; ++i) vo[h][i] = (unsigned)(rtok[u.pm * BM + h * HALF + R[i]] * K + C[i]) * 2u; }
};

struct BatchBSched {
    static constexpr bool GATHER = false, B_TILED = false;
    StaticOrder o; const char* A; const char* B; size_t tstep, bstep;
    DI bool next(int i, Unit& u) const { return o.next(i, u); }
    DI const char* a_ptr(const Unit& u) const { return A + (size_t)u.pm * tstep; }
    DI const char* b_ptr(const Unit& u) const { return B + (size_t)(u.pm >> 4) * bstep + (size_t)u.pn * tstep; }
    DI void a_voff(const Unit&, int K, const int (&R)[2], const int (&C)[2], unsigned (&vo)[2][2]) const {
#pragma unroll
        for (int h = 0; h < 2; ++h)
#pragma unroll
            for (int i = 0; i < 2; ++i) vo[h][i] = (unsigned)((h * HALF + R[i]) * K + C[i]) * 2u; }
};
template <int MODE> struct FoldSched {
    static constexpr bool GATHER = false, B_TILED = false;
    const char* A; const char* B; int G, c;
    DI bool next(int i, Unit& u) const { const int L = i * G + c; if (L >= 64) return false; u.pm = L >> 2; u.pn = L & 3; u.e = 0; return true; }
    DI const char* a_ptr(const Unit& u) const { const int b = u.pm >> 2, h = u.pm & 3; return A + ((size_t)(MODE == 0 ? b * 256 : u.pn * 256) * 1024 + h * 256) * 2; }
    DI const char* b_ptr(const Unit& u) const { const int b = u.pm >> 2, h = u.pm & 3; return B + ((size_t)(MODE == 0 ? u.pn * 256 : b * 256) * 1024 + h * 256) * 2; }
    DI void a_voff(const Unit&, int K, const int (&R)[2], const int (&C)[2], unsigned (&vo)[2][2]) const {
#pragma unroll
        for (int h = 0; h < 2; ++h)
#pragma unroll
            for (int i = 0; i < 2; ++i) vo[h][i] = (unsigned)((h * HALF + R[i]) * K + C[i]) * 2u; }
};

DI unsigned cvt_pk_bf16(float lo, float hi) { unsigned r; asm volatile("v_cvt_pk_bf16_f32 %0, %1, %2" : "=v"(r) : "v"(lo), "v"(hi)); return r; }

template <class Epi, class Sched, bool ALIGN_EPI = true, bool FP8 = false>
DI void gemm_phase(LAS unsigned char* lds, const int K, const Sched& S, const Epi& E, const int wv0, const int ldp = 0) {
    const int ld = ldp ? ldp : K;
    const int tid = fresh_tid(), wid = __builtin_amdgcn_readfirstlane(tid >> 6), lane = tid & 63, wr = wid >> 2, wc = wid & 3, fr = lane & 15, fq = lane >> 4;
    const int nt = K / BK;
    constexpr bool GA = Sched::GATHER, BT = Sched::B_TILED;
    unsigned voffA[2][2], voffAn[2][2], voffB[2];
#pragma unroll
    for (int i = 0; i < 2; ++i) { int R, C; stage_rc(tid * 16 + i * 8192, R, C); const int Rb = Epi::PERM ? ((R & ~31) + perm32(R & 31)) : R;
        voffB[i] = BT ? (unsigned)(tid * 16 + i * 8192) : (unsigned)(Rb * ld + C) * 2u; }
#define PG8_AVOFF(unit, dst) do { int sR[2], sC[2]; const int t2_ = fresh_tid(); stage_rc(t2_ * 16, sR[0], sC[0]); stage_rc(t2_ * 16 + 8192, sR[1], sC[1]); S.a_voff(unit, ld, sR, sC, dst); } while (0)
    const size_t kstep = (size_t)(BK * 2);
    const size_t hstep = (size_t)HALF * ld * 2;
    const size_t kstepB = BT ? (size_t)(2 * HTB) : kstep, hstepB = BT ? (size_t)HTB : hstep;
    const unsigned ldsw = (unsigned)wid * 1024u;
    unsigned aoffv = (unsigned)(size_t)lds + (unsigned)lds_byte(wr * 64 + fr, fq * 8), boffv = (unsigned)(size_t)lds + (unsigned)(4 * HTB) + (unsigned)lds_byte(wc * 32 + fr, fq * 8);
    asm volatile("" : "+v"(aoffv), "+v"(boffv));
    const size_t dB = BT ? (size_t)8192 : (size_t)64 * ld * 2, dA = (size_t)64 * ld * 2;
#define PG8_SA(b, h) (((b) * 2 + (h)) * HTB)
#define PG8_SB(b, h) ((4 + (b) * 2 + (h)) * HTB)
    const unsigned ldsbase = (unsigned)__builtin_amdgcn_readfirstlane((int)((unsigned)(size_t)lds + ldsw));
#define PG8_STAGE1(bufoff, gptr, vo, i_) do { const unsigned m0v_ = ldsbase + (unsigned)(bufoff) + (unsigned)(i_) * 8192u; \
        asm volatile("s_mov_b32 m0, %2\n\ts_nop 0\n\tglobal_load_lds_dwordx4 %0, %1" :: "v"(vo), "s"((const char*)(gptr)), "s"(m0v_) : "memory", "m0"); } while (0)
#define PG8_STAGE(bufoff, gbase, voff) do { PG8_STAGE1(bufoff, gbase, (voff)[0], 0); PG8_STAGE1(bufoff, gbase, (voff)[1], 1); } while (0)
#define PG8_STAGE_D(bufoff, gbase, vo, delta) do { PG8_STAGE1(bufoff, gbase, vo, 0); PG8_STAGE1(bufoff, (const char*)(gbase) + (delta), vo, 1); } while (0)
#define PG8_LDA(dst, b, h) do { if constexpr (FP8) { _Pragma("unroll") for (int m = 0; m < 4; ++m) { const LAS v4i* p_ = (const LAS v4i*)((LAS unsigned char*)(size_t)aoffv + PG8_SA(b, h) + m * 2048); dst##8[m] = __builtin_shufflevector(p_[0], p_[64], 0, 1, 2, 3, 4, 5, 6, 7); } } \
        else { _Pragma("unroll") for (int m = 0; m < 4; ++m) _Pragma("unroll") for (int k = 0; k < 2; ++k) dst[m][k] = *(const LAS bf16x8*)((LAS unsigned char*)(size_t)aoffv + PG8_SA(b, h) + m * 2048 + k * 1024); } } while (0)
#define PG8_LDB(dst, b, h) do { if constexpr (FP8) { _Pragma("unroll") for (int n = 0; n < 2; ++n) { const LAS v4i* p_ = (const LAS v4i*)((LAS unsigned char*)(size_t)boffv + (PG8_SB(b, h) - 4 * HTB) + n * 2048); dst##8[n] = __builtin_shufflevector(p_[0], p_[64], 0, 1, 2, 3, 4, 5, 6, 7); } } \
        else { _Pragma("unroll") for (int n = 0; n < 2; ++n) _Pragma("unroll") for (int k = 0; k < 2; ++k) dst[n][k] = *(const LAS bf16x8*)((LAS unsigned char*)(size_t)boffv + (PG8_SB(b, h) - 4 * HTB) + n * 2048 + k * 1024); } } while (0)
#define PG8_MMA(ai, bj, At, Bt) do { __builtin_amdgcn_s_setprio(1); \
        if constexpr (FP8) {   \
            _Pragma("unroll") for (int m = 0; m < 4; ++m) _Pragma("unroll") for (int n = 0; n < 2; ++n) \
                acc[ai][bj][m][n] = __builtin_amdgcn_mfma_scale_f32_16x16x128_f8f6f4(Bt##8[n], At##8[m], acc[ai][bj][m][n], 0, 0, 0, 0, 0, 0); } \
        else { _Pragma("unroll") for (int m = 0; m < 4; ++m) _Pragma("unroll") for (int n = 0; n < 2; ++n) _Pragma("unroll") for (int k = 0; k < 2; ++k) \
            acc[ai][bj][m][n] = __builtin_amdgcn_mfma_f32_16x16x32_bf16(Bt[n][k], At[m][k], acc[ai][bj][m][n], 0, 0, 0); } \
        __builtin_amdgcn_s_setprio(0); } while (0)
#define PG8_WAIT_V(n) asm volatile("s_waitcnt vmcnt(" #n ")" ::: "memory")
#define PG8_WAIT_L(n) asm volatile("s_waitcnt lgkmcnt(" #n ")" ::: "memory")
#define PG8_BAR __builtin_amdgcn_s_barrier()
#define PG8_SCHED __builtin_amdgcn_sched_barrier(0)
    Unit cur, nxt; int ui = 0;
    if (!S.next(0, cur)) return;
    f32x4 acc[2][2][4][2];
#pragma unroll
    for (int a = 0; a < 2; ++a)
#pragma unroll
        for (int b = 0; b < 2; ++b)
#pragma unroll
            for (int m = 0; m < 4; ++m)
#pragma unroll
                for (int n = 0; n < 2; ++n) acc[a][b][m][n] = (f32x4){0.f, 0.f, 0.f, 0.f};
    bf16x8 At[4][2], B0[2][2], B1[2][2]; v8i At8[4], B08[2], B18[2];
    const char* cA = S.a_ptr(cur); const char* cB = S.b_ptr(cur);
    PG8_AVOFF(cur, voffA);
#define PG8_STAGE_A(bufoff, kbase, h, vo) do { if constexpr (GA) { PG8_STAGE(bufoff, kbase, (vo)[h]); } else { PG8_STAGE_D(bufoff, (kbase) + (h) * hstep, voffA[0][0], dA); } } while (0)
    PG8_STAGE_D(PG8_SB(0, 0), cB, voffB[0], dB); PG8_STAGE_D(PG8_SB(0, 1), cB + hstepB, voffB[0], dB); PG8_STAGE_A(PG8_SA(0, 0), cA, 0, voffA); PG8_STAGE_A(PG8_SA(0, 1), cA, 1, voffA);
    if (wr == 1) PG8_BAR;
    PG8_WAIT_V(2); PG8_BAR;
    PG8_STAGE_D(PG8_SB(1, 0), cB + kstepB, voffB[0], dB); PG8_STAGE_A(PG8_SA(1, 0), cA + kstep, 0, voffA); PG8_STAGE_D(PG8_SB(1, 1), cB + hstepB + kstepB, voffB[0], dB);
    PG8_WAIT_V(6); PG8_BAR;
    for (;;) {
        const bool has_next = S.next(ui + 1, nxt);
        const char* nA = has_next ? S.a_ptr(nxt) : cA; const char* nB = has_next ? S.b_ptr(nxt) : cB;
        if constexpr (GA) { if (has_next) PG8_AVOFF(nxt, voffAn);
            else {
#pragma unroll
                for (int h = 0; h < 2; ++h)
#pragma unroll
                    for (int i = 0; i < 2; ++i) voffAn[h][i] = voffA[h][i]; } }
#pragma unroll 1
        for (int t = 0; t < nt; t += 2) {
            const bool last = (t == nt - 2);
            const char* a1 = cA + (size_t)(t + 1) * kstep;
            const char* a2 = last ? nA : cA + (size_t)(t + 2) * kstep; const char* b2 = last ? nB : cB + (size_t)(t + 2) * kstepB;
            const char* a3 = a2 + kstep; const char* b3 = b2 + kstepB;
            PG8_LDB(B0, 0, 0); PG8_LDB(B1, 0, 1); PG8_SCHED; PG8_LDA(At, 0, 0); PG8_STAGE_A(PG8_SA(1, 1), a1, 1, voffA);
            if constexpr (GA) { if (last) {
#pragma unroll
                for (int h = 0; h < 2; ++h)
#pragma unroll
                    for (int i = 0; i < 2; ++i) voffA[h][i] = voffAn[h][i]; } }
            PG8_WAIT_V(8); PG8_WAIT_L(0); PG8_BAR; PG8_MMA(0, 0, At, B0); PG8_MMA(0, 1, At, B1); PG8_BAR; PG8_SCHED;
            PG8_LDA(At, 0, 1); PG8_STAGE_D(PG8_SB(0, 0), b2, voffB[0], dB); PG8_STAGE_D(PG8_SB(0, 1), b2 + hstepB, voffB[0], dB); PG8_STAGE_A(PG8_SA(0, 0), a2, 0, voffA);
            PG8_WAIT_V(8); PG8_WAIT_L(0); PG8_BAR; PG8_MMA(1, 0, At, B0); PG8_MMA(1, 1, At, B1); PG8_BAR; PG8_SCHED;
            PG8_LDB(B0, 1, 0); PG8_LDB(B1, 1, 1); PG8_SCHED; PG8_LDA(At, 1, 0); PG8_STAGE_A(PG8_SA(0, 1), a2, 1, voffA);
            PG8_WAIT_V(8); PG8_WAIT_L(0); PG8_BAR; PG8_MMA(0, 0, At, B0); PG8_MMA(0, 1, At, B1); PG8_BAR; PG8_SCHED;
            PG8_LDA(At, 1, 1); PG8_STAGE_D(PG8_SB(1, 0), b3, voffB[0], dB); PG8_STAGE_D(PG8_SB(1, 1), b3 + hstepB, voffB[0], dB); PG8_STAGE_A(PG8_SA(1, 0), a3, 0, voffA);
            PG8_WAIT_V(8); PG8_WAIT_L(0); PG8_BAR; PG8_MMA(1, 0, At, B0); PG8_MMA(1, 1, At, B1); PG8_BAR; PG8_SCHED;
        }
        if constexpr (ALIGN_EPI) { if (wr == 0) PG8_BAR; }
        { Unit ue = cur; ue.pm = __builtin_amdgcn_readfirstlane(ue.pm); ue.pn = __builtin_amdgcn_readfirstlane(ue.pn); ue.e = __builtin_amdgcn_readfirstlane(ue.e); asm volatile("" : "+s"(ue.pm), "+s"(ue.pn), "+s"(ue.e));
          const int t3_ = fresh_tid(); const int fr_ = t3_ & 15, fq_ = (t3_ & 63) >> 4;
          E(acc, ue, wr, wc, fr_, fq_); }
        if (!has_next) break;
#pragma unroll
        for (int a = 0; a < 2; ++a)
#pragma unroll
            for (int b = 0; b < 2; ++b)
#pragma unroll
                for (int m = 0; m < 4; ++m)
#pragma unroll
                    for (int n = 0; n < 2; ++n) acc[a][b][m][n] = (f32x4){0.f, 0.f, 0.f, 0.f};
        cur = nxt; cA = nA; cB = nB; ++ui;
        if constexpr (ALIGN_EPI) { if (wr == 1) PG8_BAR; }
    }
    PG8_WAIT_V(0);
    if constexpr (!ALIGN_EPI) { if (wr == 0) PG8_BAR; }
    PG8_BAR;
#undef PG8_SA
#undef PG8_SB
#undef PG8_STAGE
#undef PG8_STAGE1
#undef PG8_STAGE_D
#undef PG8_STAGE_A
#undef PG8_AVOFF
#undef PG8_LDA
#undef PG8_LDB
#undef PG8_MMA
#undef PG8_WAIT_V
#undef PG8_WAIT_L
#undef PG8_BAR
#undef PG8_SCHED
}
}
using pg8::Unit;
using pg8::cvt_pk_bf16;

DI float bflo(unsigned w) { return __uint_as_float(w << 16); }
DI float bfhi(unsigned w) { return __uint_as_float(w & 0xffff0000u); }
DI float bf2f(bf16 b) { return __uint_as_float(((unsigned)b) << 16); }
typedef __bf16 hwbf2 __attribute__((ext_vector_type(2)));
DI unsigned pk2(float lo, float hi) { const f32x2 v = {lo, hi}; return __builtin_bit_cast(unsigned, __builtin_convertvector(v, hwbf2)); }
DI unsigned f2bf(float f) { return pk2(f, 0.f) & 0xffffu; }
DI float rcp_f(float x) { return __builtin_amdgcn_rcpf(x); }
DI float rsq_f(float x) { return __builtin_amdgcn_rsqf(x); }
DI float sigmoid_f(float x) { return rcp_f(1.0f + __expf(-x)); }
DI float tanh_fast(float x) { return 1.0f - 2.0f * rcp_f(__expf(2.0f * x) + 1.0f); }
DI float softplus_f(float x) { return fmaxf(x, 0.f) + __logf(1.0f + __expf(-fabsf(x))); }
DI float softplus_fast(float x) { return fmaxf(x, 0.f) + __logf(1.0f + __expf(-fabsf(x))); }
DI float gelu_tanh_f(float x) { const float u = 0.7978845608028654f * (x + 0.044715f * x * x * x); return 0.5f * x * (1.0f + tanh_fast(u)); }
DI float wave_sum(float v) {
#pragma unroll
    for (int o = 1; o < 64; o <<= 1) v += __shfl_xor(v, o);
    return v;
}

DI unsigned pk4_fp8(float a, float b, float c, float d) { int w = 0; w = __builtin_amdgcn_cvt_pk_fp8_f32(a, b, w, false); w = __builtin_amdgcn_cvt_pk_fp8_f32(c, d, w, true); return (unsigned)w; }
struct EpiBf16Plain {
    static constexpr bool PERM = true;
    bf16* O; int ldc; float scale;
    DI void operator()(const f32x4 (&acc)[2][2][4][2], const Unit& u, int wr, int wc, int fr, int fq) const {
        const int row0 = u.pm * 256 + wr * 64 + fr, col0 = u.pn * 256 + wc * 32 + 8 * fq;
#pragma unroll
        for (int ai = 0; ai < 2; ++ai)
#pragma unroll
            for (int m = 0; m < 4; ++m) { bf16* rowp = O + (size_t)(row0 + ai * 128 + m * 16) * ldc + col0;
#pragma unroll
                for (int bj = 0; bj < 2; ++bj) { const f32x4 v0 = acc[ai][bj][m][0] * scale, v1 = acc[ai][bj][m][1] * scale;
                    u32x4 w; w.x = cvt_pk_bf16(v0[0], v0[1]); w.y = cvt_pk_bf16(v0[2], v0[3]); w.z = cvt_pk_bf16(v1[0], v1[1]); w.w = cvt_pk_bf16(v1[2], v1[3]);
                    *(u32x4*)(rowp + bj * 128) = w; } }
    }
};
template <int MODE> struct EpiFold {
    static constexpr bool PERM = true;
    unsigned char* O;
    DI void operator()(const f32x4 (&acc)[2][2][4][2], const Unit& u, int wr, int wc, int fr, int fq) const {
        const int b = u.pm >> 2, h = u.pm & 3;
        const int rbase = MODE == 0 ? h * 256 : u.pn * 256, cbase = MODE == 0 ? u.pn * 256 : h * 256;
        const unsigned boff = (unsigned)b * 1024u * 1024u + (unsigned)(rbase + wr * 64 + fr) * 1024u + (unsigned)(cbase + wc * 32 + 8 * fq);
#pragma unroll
        for (int ai = 0; ai < 2; ++ai)
#pragma unroll
            for (int m = 0; m < 4; ++m) { unsigned char* rowp = O + (boff + (unsigned)(ai * 128 + m * 16) * 1024u);
#pragma unroll
                for (int bj = 0; bj < 2; ++bj) { const f32x4 v0 = acc[ai][bj][m][0] * 4.0f, v1 = acc[ai][bj][m][1] * 4.0f;
                    u32x2 w; w.x = pk4_fp8(v0[0], v0[1], v0[2], v0[3]); w.y = pk4_fp8(v1[0], v1[1], v1[2], v1[3]);
                    *(u32x2*)(rowp + bj * 128) = w; } }
    }
};
struct EpiSoftmax {
    static constexpr bool PERM = true;
    unsigned char* O; float scale; const float* RS; LAS float* XM; LAS float* XS;
    DI void operator()(const f32x4 (&acc)[2][2][4][2], const Unit& u, int wr, int wc, int fr, int fq) const {
        const int row0 = u.pm * 256 + wr * 64 + fr, col0 = u.pn * 256 + wc * 32 + 8 * fq;
        float sc[2][4];
#pragma unroll
        for (int ai = 0; ai < 2; ++ai)
#pragma unroll
            for (int m = 0; m < 4; ++m) { const int r = row0 + ai * 128 + m * 16; const f32x4* rp = (const f32x4*)(RS + (size_t)r * 16);
                const f32x4 p0 = rp[0], p1 = rp[1], p2 = rp[2], p3 = rp[3];
                const float ss = ((p0[0] + p0[1]) + (p0[2] + p0[3])) + ((p1[0] + p1[1]) + (p1[2] + p1[3])) + ((p2[0] + p2[1]) + (p2[2] + p2[3])) + ((p3[0] + p3[1]) + (p3[2] + p3[3]));
                sc[ai][m] = scale * __builtin_amdgcn_rsqf(ss * (1.0f / 1024.0f) + 1e-6f);
                float mm = -3.0e38f;
#pragma unroll
                for (int bj = 0; bj < 2; ++bj)
#pragma unroll
                    for (int n = 0; n < 2; ++n) { const f32x4 v = acc[ai][bj][m][n]; mm = fmaxf(mm, fmaxf(fmaxf(v[0], v[1]), fmaxf(v[2], v[3]))); }
                mm *= sc[ai][m];
                mm = fmaxf(mm, __shfl_xor(mm, 16)); mm = fmaxf(mm, __shfl_xor(mm, 32));
                if (fq == 0) XM[(ai * 128 + wr * 64 + m * 16 + fr) * 4 + wc] = mm; }
        asm volatile("s_waitcnt lgkmcnt(0)" ::: "memory"); __builtin_amdgcn_s_barrier(); asm volatile("" ::: "memory");
        f32x4 (&pa)[2][2][4][2] = const_cast<f32x4 (&)[2][2][4][2]>(acc);
#pragma unroll
        for (int ai = 0; ai < 2; ++ai)
#pragma unroll
            for (int m = 0; m < 4; ++m) { const int lr = ai * 128 + wr * 64 + m * 16 + fr; const f32x4 q = *(const LAS f32x4*)(XM + lr * 4);
                const float mxr = fmaxf(fmaxf(q[0], q[1]), fmaxf(q[2], q[3])); float sm = 0.f;
#pragma unroll
                for (int bj = 0; bj < 2; ++bj)
#pragma unroll
                    for (int n = 0; n < 2; ++n)
#pragma unroll
                        for (int j = 0; j < 4; ++j) { const float p = __expf(acc[ai][bj][m][n][j] * sc[ai][m] - mxr); pa[ai][bj][m][n][j] = p; sm += p; }
                sm += __shfl_xor(sm, 16); sm += __shfl_xor(sm, 32);
                if (fq == 0) XS[lr * 4 + wc] = sm; }
        asm volatile("s_waitcnt lgkmcnt(0)" ::: "memory"); __builtin_amdgcn_s_barrier(); asm volatile("" ::: "memory");
#pragma unroll
        for (int ai = 0; ai < 2; ++ai)
#pragma unroll
            for (int m = 0; m < 4; ++m) { const int lr = ai * 128 + wr * 64 + m * 16 + fr; const f32x4 q = *(const LAS f32x4*)(XS + lr * 4);
                const float inv = 256.0f * __builtin_amdgcn_rcpf((q[0] + q[1]) + (q[2] + q[3]));
                unsigned char* rowp = O + (size_t)(row0 + ai * 128 + m * 16) * 1024 + col0;
#pragma unroll
                for (int bj = 0; bj < 2; ++bj) { const f32x4 v0 = pa[ai][bj][m][0] * inv, v1 = pa[ai][bj][m][1] * inv;
                    u32x2 w; w.x = pk4_fp8(v0[0], v0[1], v0[2], v0[3]); w.y = pk4_fp8(v1[0], v1[1], v1[2], v1[3]);
                    *(u32x2*)(rowp + bj * 128) = w; } }
        asm volatile("s_waitcnt lgkmcnt(0)" ::: "memory"); __builtin_amdgcn_s_barrier(); asm volatile("" ::: "memory");
    }
};
struct EpiBf16RowNorm {
    static constexpr bool PERM = true;
    bf16* O; int ldc; float scale; const float* RS;
    DI void operator()(const f32x4 (&acc)[2][2][4][2], const Unit& u, int wr, int wc, int fr, int fq) const {
        const int row0 = u.pm * 256 + wr * 64 + fr, col0 = u.pn * 256 + wc * 32 + 8 * fq;
#pragma unroll
        for (int ai = 0; ai < 2; ++ai)
#pragma unroll
            for (int m = 0; m < 4; ++m) { const int r = row0 + ai * 128 + m * 16; const f32x4* rp = (const f32x4*)(RS + (size_t)r * 16);
                const f32x4 p0 = rp[0], p1 = rp[1], p2 = rp[2], p3 = rp[3];
                const float ss = ((p0[0] + p0[1]) + (p0[2] + p0[3])) + ((p1[0] + p1[1]) + (p1[2] + p1[3])) + ((p2[0] + p2[1]) + (p2[2] + p2[3])) + ((p3[0] + p3[1]) + (p3[2] + p3[3]));
                const float sc = scale * __builtin_amdgcn_rsqf(ss * (1.0f / 1024.0f) + 1e-6f);
                bf16* rowp = O + (size_t)r * ldc + col0;
#pragma unroll
                for (int bj = 0; bj < 2; ++bj) { const f32x4 v0 = acc[ai][bj][m][0] * sc, v1 = acc[ai][bj][m][1] * sc;
                    u32x4 w; w.x = cvt_pk_bf16(v0[0], v0[1]); w.y = cvt_pk_bf16(v0[2], v0[3]); w.z = cvt_pk_bf16(v1[0], v1[1]); w.w = cvt_pk_bf16(v1[2], v1[3]);
                    *(u32x4*)(rowp + bj * 128) = w; } }
    }
};
template <bool RES_BF16> struct EpiBf16Res {
    static constexpr bool PERM = true;
    const void* Rz; bf16* O; int ldc; float* RS; float ascale; unsigned char* O8;
    DI void operator()(const f32x4 (&acc)[2][2][4][2], const Unit& u, int wr, int wc, int fr, int fq) const {
        const int row0 = u.pm * 256 + wr * 64 + fr, col0 = u.pn * 256 + wc * 32 + 8 * fq;
#pragma unroll
        for (int ai = 0; ai < 2; ++ai) {
            u32x4 rwb[4][2]; f32x4 rf0[4][2], rf1[4][2];
#pragma unroll
            for (int m = 0; m < 4; ++m) { const size_t off = (size_t)(row0 + ai * 128 + m * 16) * ldc + col0;
#pragma unroll
                for (int bj = 0; bj < 2; ++bj) {
                    if (RES_BF16) rwb[m][bj] = *(const u32x4*)((const bf16*)Rz + off + bj * 128);
                    else { rf0[m][bj] = *(const f32x4*)((const float*)Rz + off + bj * 128); rf1[m][bj] = *(const f32x4*)((const float*)Rz + off + bj * 128 + 4); } } }
#pragma unroll
            for (int m = 0; m < 4; ++m) { const size_t off = (size_t)(row0 + ai * 128 + m * 16) * ldc + col0; float ssq = 0.f;
#pragma unroll
                for (int bj = 0; bj < 2; ++bj) { f32x4 r0, r1;
                    if (RES_BF16) { const u32x4 rw = rwb[m][bj]; r0 = (f32x4){bflo(rw.x), bfhi(rw.x), bflo(rw.y), bfhi(rw.y)}; r1 = (f32x4){bflo(rw.z), bfhi(rw.z), bflo(rw.w), bfhi(rw.w)}; }
                    else { r0 = rf0[m][bj]; r1 = rf1[m][bj]; }
                    const f32x4 v0 = r0 + acc[ai][bj][m][0] * ascale, v1 = r1 + acc[ai][bj][m][1] * ascale;
                    if (O8) { u32x2 w8; w8.x = pk4_fp8(v0[0], v0[1], v0[2], v0[3]); w8.y = pk4_fp8(v1[0], v1[1], v1[2], v1[3]); *(u32x2*)(O8 + off + bj * 128) = w8; }
                    ssq += (v0[0] * v0[0] + v0[1] * v0[1]) + (v0[2] * v0[2] + v0[3] * v0[3]) + (v1[0] * v1[0] + v1[1] * v1[1]) + (v1[2] * v1[2] + v1[3] * v1[3]);
                    u32x4 w; w.x = cvt_pk_bf16(v0[0], v0[1]); w.y = cvt_pk_bf16(v0[2], v0[3]); w.z = cvt_pk_bf16(v1[0], v1[1]); w.w = cvt_pk_bf16(v1[2], v1[3]);
                    *(u32x4*)(O + off + bj * 128) = w; }
                if (RS) { ssq += __shfl_xor(ssq, 16); ssq += __shfl_xor(ssq, 32); if (fq == 0) RS[(size_t)(row0 + ai * 128 + m * 16) * 16 + u.pn * 4 + wc] = ssq; } } }
    }
};
struct EpiLora {
    static constexpr bool PERM = false;
    float* LWp; bf16* AAp; bf16* GGp; const float* w0; const float* a0;
    DI void operator()(const f32x4 (&acc)[2][2][4][2], const Unit& u, int wr, int wc, int fr, int fq) const {
        const int kind = u.pn >> 1;
        const int row0 = u.pm * 256 + wr * 64 + fr, col0 = (u.pn & 1) * 256 + wc * 32 + 4 * fq;
#pragma unroll
        for (int bj = 0; bj < 2; ++bj)
#pragma unroll
            for (int n = 0; n < 2; ++n) {
                const int c = col0 + bj * 128 + n * 16;
                f32x4 bias = (f32x4){0.f, 0.f, 0.f, 0.f};
                if (kind == 0) bias = *(const f32x4*)(w0 + c); else if (kind == 1) bias = *(const f32x4*)(a0 + c);
#pragma unroll
                for (int ai = 0; ai < 2; ++ai)
#pragma unroll
                    for (int m = 0; m < 4; ++m) {
                        f32x4 v = acc[ai][bj][m][n] + bias;
                        if (kind == 0) {
#pragma unroll
                            for (int j = 0; j < 4; ++j) { const float w = -softplus_fast(-v[j]) - 0.5f; v[j] = -__expf(w);     }
                        } else if (kind == 1) {
#pragma unroll
                            for (int j = 0; j < 4; ++j) v[j] = sigmoid_f(v[j]);
                        }
                        const size_t o_ = (size_t)(row0 + ai * 128 + m * 16) * 512 + c;
                        if (kind == 0) *(f32x4*)(LWp + o_) = v;
                        else { u32x2 w_; w_.x = cvt_pk_bf16(v[0], v[1]); w_.y = cvt_pk_bf16(v[2], v[3]); *(u32x2*)((kind == 1 ? AAp : GGp) + o_) = w_; }
                    }
            }
    }
};
struct EpiSwiglu {
    static constexpr bool PERM = true;
    bf16* ACT; const float* b_gu;
    DI void operator()(const f32x4 (&acc)[2][2][4][2], const Unit& u, int wr, int wc, int fr, int fq) const {
        const int row0 = u.pm * 256 + wr * 64 + fr, j0 = u.pn * 128 + wc * 32 + 8 * fq;
        const float* bg = b_gu + (size_t)u.e * 2048 + j0; const float* bu = bg + 1024;
        const f32x4 bg0 = *(const f32x4*)bg, bg1 = *(const f32x4*)(bg + 4), bu0 = *(const f32x4*)bu, bu1 = *(const f32x4*)(bu + 4);
#pragma unroll
        for (int ai = 0; ai < 2; ++ai)
#pragma unroll
            for (int m = 0; m < 4; ++m) {
                float o[8];
#pragma unroll
                for (int n = 0; n < 2; ++n) { const f32x4 g4 = acc[ai][0][m][n] * 0.015625f + (n ? bg1 : bg0), u4 = acc[ai][1][m][n] * 0.015625f + (n ? bu1 : bu0);
#pragma unroll
                    for (int j = 0; j < 4; ++j) { const float g = fminf(g4[j], 7.0f), up = fminf(fmaxf(u4[j], -7.0f), 7.0f); o[n * 4 + j] = (up + 1.0f) * (g * sigmoid_f(1.702f * g)); } }
                u32x2 w; w.x = pk4_fp8(o[0], o[1], o[2], o[3]); w.y = pk4_fp8(o[4], o[5], o[6], o[7]);
                *(u32x2*)((unsigned char*)ACT + (size_t)(row0 + ai * 128 + m * 16) * 1024 + j0) = w;
            }
    }
};
struct EpiDown {
    static constexpr bool PERM = true;
    bf16* YS; const float* b_dn; const u32x2* row_sg;
    DI void operator()(const f32x4 (&acc)[2][2][4][2], const Unit& u, int wr, int wc, int fr, int fq) const {
        const int row0 = u.pm * 256 + wr * 64 + fr, col0 = u.pn * 256 + wc * 32 + 8 * fq;
        const float* bb = b_dn + (size_t)u.e * 1024 + col0;
        f32x4 bv[2][2];
#pragma unroll
        for (int bj = 0; bj < 2; ++bj)
#pragma unroll
            for (int n = 0; n < 2; ++n) bv[bj][n] = *(const f32x4*)(bb + bj * 128 + 4 * n);
        int slots[8]; float gts[8];
        { const u32x2* sgp = row_sg + row0;
#pragma unroll
        for (int q = 0; q < 8; ++q) { const u32x2 sg = sgp[(q >> 2) * 128 + (q & 3) * 16]; slots[q] = (int)sg.x; gts[q] = __uint_as_float(sg.y); } }
#pragma unroll
        for (int ai = 0; ai < 2; ++ai)
#pragma unroll
            for (int m = 0; m < 4; ++m) {
                const int slot = slots[ai * 4 + m]; const float gt = gts[ai * 4 + m];
                if (slot >= 0) { bf16* rowp = YS + (size_t)slot * 1024 + col0;
#pragma unroll
                    for (int bj = 0; bj < 2; ++bj) { const f32x4 v0 = (acc[ai][bj][m][0] * 0.015625f + bv[bj][0]) * gt, v1 = (acc[ai][bj][m][1] * 0.015625f + bv[bj][1]) * gt;
                        u32x4 w; w.x = cvt_pk_bf16(v0[0], v0[1]); w.y = cvt_pk_bf16(v0[2], v0[3]); w.z = cvt_pk_bf16(v1[0], v1[1]); w.w = cvt_pk_bf16(v1[2], v1[3]);
                        *(u32x4*)(rowp + bj * 128) = w; } }
            }
    }
};

constexpr size_t MiB = 1u << 20;
constexpr size_t WS_CTL = 0, CTL_ZERO_BYTES = 1 * MiB;
constexpr size_t WS_WIN = 1 * MiB, WS_WOUT = 7 * MiB, WS_WQ = 9 * MiB, WS_WK = 11 * MiB, WS_WV = 13 * MiB, WS_WO = 15 * MiB, WS_LORAB = 17 * MiB, WS_LRUW = 18 * MiB;
constexpr size_t WS_ROUTE = 19 * MiB;
constexpr size_t WS_WGU = 22 * MiB, WS_WDN = 150 * MiB;
constexpr size_t WS_HN = 214 * MiB, WS_MEMN = 246 * MiB, WS_KM = 248 * MiB, WS_VT = 250 * MiB;
constexpr size_t WS_X1 = 252 * MiB, WS_X2 = 316 * MiB;
constexpr size_t WS_U = 380 * MiB, WS_R = 468 * MiB, WS_KRAW = 500 * MiB, WS_V = 532 * MiB, WS_KKN = 564 * MiB, WS_WD = 596 * MiB, WS_AA = 628 * MiB, WS_G = 660 * MiB;
constexpr size_t WS_LA = 692 * MiB, WS_LB = 724 * MiB, WS_AP = 756 * MiB, WS_CAT = 764 * MiB, WS_Q = 796 * MiB;
constexpr size_t WS_XS = 380 * MiB, WS_ACT = 524 * MiB, WS_YS = 668 * MiB;
constexpr size_t WS_GP = 796 * MiB, WS_HF = 860 * MiB, WS_RP = 924 * MiB, WS_Y1F = 940 * MiB, WS_ADD = 972 * MiB, WS_END = 1004 * MiB;
constexpr size_t WS_GC = 468 * MiB, WS_HC = 484 * MiB, WS_ZS = 500 * MiB;
static_assert(WS_AA == WS_WD + 32 * MiB && WS_G == WS_AA + 32 * MiB, "EpiLora strides");
static_assert(WS_U + (size_t)M * INW * 2 <= WS_R && WS_XS + (size_t)MAXROWS * 2048 <= WS_ACT && WS_ACT + (size_t)MAXROWS * 2048 <= WS_YS && WS_YS + (size_t)NASSIGN * 2048 <= WS_Q, "ws map");
constexpr size_t RT_E = 0, RT_POS = 256 * 1024, RT_G = 512 * 1024, RT_SLOT = 768 * 1024, RT_GATE = 1088 * 1024, RT_TILE = 1408 * 1024, RT_TOK = 1472 * 1024, RT_UGU = 1792 * 1024, RT_UDN = 1808 * 1024;
constexpr int CW_BAR = 4096, CW_CNT = 8192, CW_CONV = 12288;

constexpr int RING_BYTES = 131072, MISC_OFF = RING_BYTES + 320, LDS_BYTES = 147456;
constexpr int NWAVES = 8, NTHREADS = 512;
constexpr int CONV_P9 = 6144;
constexpr int CONV_P9D = 16384;

#define XB_TMO      128
#define XB_XCNT(j)  (256  + 64 * (j))
#define XB_XSUB(j)  (1280 + 64 * (j))
#define XB_XGEN(j)  (2304 + 64 * (j))
#define XB_TOP      3328
#define XB_TOPGEN   3392
#define XCD_BAR_WORDS 3456
#define XB_SPIN_CAP (1u << 18)
DI unsigned xb_ld(unsigned* p)              { return __hip_atomic_load(p, __ATOMIC_RELAXED, __HIP_MEMORY_SCOPE_AGENT); }
DI unsigned xb_add(unsigned* p, unsigned v) { return __hip_atomic_fetch_add(p, v, __ATOMIC_RELAXED, __HIP_MEMORY_SCOPE_AGENT); }
DI unsigned xb_xcc_id() { return (unsigned)__builtin_amdgcn_s_getreg((3 << 11) | 20) & 0xFu; }
#define XB_SPIN(cond, bar) do { unsigned _sp = 0; while (cond) { __builtin_amdgcn_s_sleep(1); \
    if ((++_sp & 255u) == 0u) { if (xb_ld(&(bar)[XB_TMO])) break; if (_sp > XB_SPIN_CAP) { atomicAdd(&(bar)[XB_TMO], 1u); break; } } } } while (0)
struct XcdBarrier { unsigned* bar; unsigned x; volatile LAS unsigned* st; int w0; };
DI XcdBarrier xcd_barrier_post(unsigned* bar, volatile LAS unsigned* st, int w0) {
    XcdBarrier b; b.bar = bar; b.x = xb_xcc_id(); b.st = st; b.w0 = w0;
    if (fresh_tid_(w0) == 0) (void)xb_add(&bar[XB_XCNT(b.x)], 1u);
    return b;
}
DI void xcd_barrier_complete(unsigned* bar, unsigned x, unsigned& nloc, unsigned& nx) {
    const unsigned G = gridDim.x * gridDim.y * gridDim.z;
    unsigned sum, cnt, mine, sp = 0u;
    for (;;) {
        sum = 0u; cnt = 0u; mine = 0u;
#pragma unroll
        for (unsigned j = 0; j < 16; ++j) { const unsigned c = xb_ld(&bar[XB_XCNT(j)]); sum += c; cnt += (c > 0u) ? 1u : 0u; mine = (j == x) ? c : mine; }
        if (sum == G) break;
        __builtin_amdgcn_s_sleep(1);
        if ((++sp & 255u) == 0u) { if (xb_ld(&bar[XB_TMO])) break; if (sp > XB_SPIN_CAP) { atomicAdd(&bar[XB_TMO], 1u); break; } }
    }
    nloc = mine > 0u ? mine : 1u; nx = cnt > 0u ? cnt : 1u;
}
DI void xcd_barrier(const XcdBarrier& b) {
    asm volatile("s_waitcnt vmcnt(0)" ::: "memory");
    __syncthreads();
    if (fresh_tid_(b.w0) == 0) {
        unsigned* bar = b.bar;
        __builtin_amdgcn_s_waitcnt(0);
        unsigned nloc = b.st[0], nx = b.st[1];
        if (nloc == 0u) { xcd_barrier_complete(bar, b.x, nloc, nx); b.st[0] = nloc; b.st[1] = nx; }
        const unsigned old = xb_add(&bar[XB_XSUB(b.x)], 1u);
        const unsigned gen = old / nloc;
        if (old + 1u == (gen + 1u) * nloc) {
            __builtin_amdgcn_fence(__ATOMIC_RELEASE, "agent");
            asm volatile("s_waitcnt vmcnt(0)" ::: "memory");
            const unsigned og = xb_add(&bar[XB_TOP], 1u);
            const unsigned tg = og / nx;
            if (og + 1u == (tg + 1u) * nx) xb_add(&bar[XB_TOPGEN], 1u);
            else XB_SPIN(xb_ld(&bar[XB_TOPGEN]) == tg, bar);
            __builtin_amdgcn_fence(__ATOMIC_ACQUIRE, "agent");
            xb_add(&bar[XB_XGEN(b.x)], 1u);
            asm volatile("s_waitcnt vmcnt(0)" ::: "memory");
        } else {
            XB_SPIN(xb_ld(&bar[XB_XGEN(b.x)]) == gen, bar);
            __builtin_amdgcn_fence(__ATOMIC_ACQUIRE, "agent");
            asm volatile("s_waitcnt vmcnt(0)" ::: "memory");
        }
    }
    __syncthreads();
}

struct Args { const float* in[37]; float* out; unsigned char* ws; int ph_lo, ph_hi; };
enum { I_X = 0, I_MEM, I_NMIXG, I_WIN, I_CONVW, I_CONVB, I_LWX, I_LBX, I_LWA, I_LBA, I_LAM, I_MU, I_W0, I_WUP, I_A0, I_AUP, I_GUP, I_KK, I_KA, I_RK, I_LNG, I_LNB,
       I_WOUT, I_NXAG, I_NMEMG, I_WQ, I_WK, I_WV, I_WO, I_NFFG, I_WR, I_BR, I_WGU, I_BGU, I_WDN, I_BDN, I_FNG };

DI void transpose_item(const float* W, int ldw, int K, bf16* WT, int k0, int n0, int drow0, LAS float* scr, int lane, const float* rs = nullptr) {
    f32x4 t[8];
    const float* src = W + (size_t)(k0 + (lane >> 3)) * ldw + n0 + 4 * (lane & 7);
#pragma unroll
    for (int i = 0; i < 8; ++i) t[i] = *(const f32x4*)(src + (size_t)(8 * i) * ldw);
#pragma unroll
    for (int i = 0; i < 8; ++i) { const float sc_ = rs ? rs[k0 + 8 * i + (lane >> 3)] : 1.0f; LAS float* d = scr + (8 * i + (lane >> 3)) * 33 + 4 * (lane & 7); d[0] = t[i].x * sc_; d[1] = t[i].y * sc_; d[2] = t[i].z * sc_; d[3] = t[i].w * sc_; }
    asm volatile("s_waitcnt lgkmcnt(0)" ::: "memory");
    const int c = lane & 7;
#pragma unroll
    for (int j = 0; j < 4; ++j) { const int n = (lane >> 3) + 8 * j; const LAS float* s = scr + (8 * c) * 33 + n;
        u32x4 o; o.x = pk2(s[0 * 33], s[1 * 33]); o.y = pk2(s[2 * 33], s[3 * 33]); o.z = pk2(s[4 * 33], s[5 * 33]); o.w = pk2(s[6 * 33], s[7 * 33]);
        *(u32x4*)(WT + (size_t)(drow0 + n) * K + k0 + 8 * c) = o; }
    asm volatile("s_waitcnt lgkmcnt(0)" ::: "memory");
}
DI void transpose_item_tiled(const float* W, int ldw, int K, bf16* WTe, int k0, int n0, int drow0, LAS float* scr, int lane) {
    f32x4 t[8];
    const float* src = W + (size_t)(k0 + (lane >> 3)) * ldw + n0 + 4 * (lane & 7);
#pragma unroll
    for (int i = 0; i < 8; ++i) t[i] = *(const f32x4*)(src + (size_t)(8 * i) * ldw);
#pragma unroll
    for (int i = 0; i < 8; ++i) { LAS float* d = scr + (8 * i + (lane >> 3)) * 33 + 4 * (lane & 7); d[0] = t[i].x; d[1] = t[i].y; d[2] = t[i].z; d[3] = t[i].w; }
    asm volatile("s_waitcnt lgkmcnt(0)" ::: "memory");
    const int c = lane & 7;
#pragma unroll
    for (int j = 0; j < 4; ++j) { const int n = (lane >> 3) + 8 * j; const LAS float* s = scr + (8 * c) * 33 + n;
        u32x4 o; o.x = pk2(s[0 * 33], s[1 * 33]); o.y = pk2(s[2 * 33], s[3 * 33]); o.z = pk2(s[4 * 33], s[5 * 33]); o.w = pk2(s[6 * 33], s[7 * 33]);
        const int drow = drow0 + n, pn = drow >> 8, half = (drow >> 7) & 1, r = drow & 127, x = r & 31;
        const int rslot = (r & ~31) + 16 * ((x >> 2) & 1) + 4 * (x >> 3) + (x & 3);
        const size_t tb = ((size_t)(pn * (K / 64) + (k0 >> 6)) * 2 + half) * 16384 + pg8::lds_byte(rslot, 8 * c);
        *(u32x4*)((char*)WTe + tb) = o; }
    asm volatile("s_waitcnt lgkmcnt(0)" ::: "memory");
}
DI void transpose_item_tiled_nolds(const float* W, int ldw, int K, bf16* WTe, int k0, int n0, int drow0, int lane) {
    const int n = lane & 31, kh = lane >> 5;
    const float* src = W + (size_t)(k0 + 32 * kh) * ldw + n0 + n;
    float t[32];
#pragma unroll
    for (int i = 0; i < 32; ++i) t[i] = src[(size_t)i * ldw];
    const int drow = drow0 + n, pn = drow >> 8, half = (drow >> 7) & 1, r = drow & 127, x = r & 31;
    const int rslot = (r & ~31) + 16 * ((x >> 2) & 1) + 4 * (x >> 3) + (x & 3);
    const size_t tb0 = ((size_t)(pn * (K / 64) + (k0 >> 6)) * 2 + half) * 16384;
#pragma unroll
    for (int c = 0; c < 4; ++c) { u32x4 o; o.x = pk2(t[8 * c], t[8 * c + 1]); o.y = pk2(t[8 * c + 2], t[8 * c + 3]); o.z = pk2(t[8 * c + 4], t[8 * c + 5]); o.w = pk2(t[8 * c + 6], t[8 * c + 7]);
        *(u32x4*)((char*)WTe + tb0 + pg8::lds_byte(rslot, 32 * kh + 8 * c)) = o; }
}
DI void transpose_item_tiled_fp8_nolds(const float* W, int ldw, int K, unsigned char* WTe, int k0, int n0, int drow0, int lane) {
    const int n = lane & 31, kh = lane >> 5;
    const float* src = W + (size_t)(k0 + 32 * kh) * ldw + n0 + n;
    float t[32];
#pragma unroll
    for (int i = 0; i < 32; ++i) t[i] = src[(size_t)i * ldw] * 64.f;
    const int drow = drow0 + n, pn = drow >> 8, half = (drow >> 7) & 1, r = drow & 127, x = r & 31;
    const int rslot = (r & ~31) + 16 * ((x >> 2) & 1) + 4 * (x >> 3) + (x & 3);
    const size_t tb0 = ((size_t)(pn * (K / 128) + (k0 >> 7)) * 2 + half) * 16384;
#pragma unroll
    for (int c = 0; c < 2; ++c) { u32x4 o; o.x = pk4_fp8(t[16 * c], t[16 * c + 1], t[16 * c + 2], t[16 * c + 3]); o.y = pk4_fp8(t[16 * c + 4], t[16 * c + 5], t[16 * c + 6], t[16 * c + 7]);
        o.z = pk4_fp8(t[16 * c + 8], t[16 * c + 9], t[16 * c + 10], t[16 * c + 11]); o.w = pk4_fp8(t[16 * c + 12], t[16 * c + 13], t[16 * c + 14], t[16 * c + 15]);
        const int bc = (k0 & 64) + 32 * kh + 16 * c;
        *(u32x4*)(WTe + tb0 + pg8::lds_byte(rslot, bc >> 1)) = o; }
}
DI void transpose_item_tiled_fp8(const float* W, int ldw, int K, unsigned char* WTe, int k0, int n0, int drow0, LAS float* scr, int lane) {
    f32x4 t[8];
    const float* src = W + (size_t)(k0 + (lane >> 3)) * ldw + n0 + 4 * (lane & 7);
#pragma unroll
    for (int i = 0; i < 8; ++i) t[i] = *(const f32x4*)(src + (size_t)(8 * i) * ldw);
#pragma unroll
    for (int i = 0; i < 8; ++i) { LAS float* d = scr + (8 * i + (lane >> 3)) * 33 + 4 * (lane & 7); d[0] = t[i].x * 64.f; d[1] = t[i].y * 64.f; d[2] = t[i].z * 64.f; d[3] = t[i].w * 64.f; }
    asm volatile("s_waitcnt lgkmcnt(0)" ::: "memory");
    const int c = lane & 3;
#pragma unroll
    for (int j = 0; j < 2; ++j) { const int n = (lane >> 2) + 16 * j; const LAS float* sp = scr + (16 * c) * 33 + n;
        u32x4 o; o.x = pk4_fp8(sp[0 * 33], sp[1 * 33], sp[2 * 33], sp[3 * 33]); o.y = pk4_fp8(sp[4 * 33], sp[5 * 33], sp[6 * 33], sp[7 * 33]);
        o.z = pk4_fp8(sp[8 * 33], sp[9 * 33], sp[10 * 33], sp[11 * 33]); o.w = pk4_fp8(sp[12 * 33], sp[13 * 33], sp[14 * 33], sp[15 * 33]);
        const int drow = drow0 + n, pn = drow >> 8, half = (drow >> 7) & 1, r = drow & 127, x = r & 31;
        const int rslot = (r & ~31) + 16 * ((x >> 2) & 1) + 4 * (x >> 3) + (x & 3);
        const int bc = (k0 & 64) + 16 * c;
        const size_t tb = ((size_t)(pn * (K / 128) + (k0 >> 7)) * 2 + half) * 16384 + pg8::lds_byte(rslot, bc >> 1);
        *(u32x4*)(WTe + tb) = o; }
    asm volatile("s_waitcnt lgkmcnt(0)" ::: "memory");
}
DI void rms_row_to_bf16(const float* xrow, const float* g, bf16* orow, int lane) {
    const f32x4* xr = (const f32x4*)xrow + lane; const f32x4* gr = (const f32x4*)g + lane;
    f32x4 v[4]; float s = 0.f;
#pragma unroll
    for (int j = 0; j < 4; ++j) { v[j] = xr[64 * j]; s += (v[j].x * v[j].x + v[j].y * v[j].y) + (v[j].z * v[j].z + v[j].w * v[j].w); }
    const float rstd = rsq_f(wave_sum(s) * (1.f / D) + EPS);
    u32x2* o8 = (u32x2*)orow + lane;
#pragma unroll
    for (int j = 0; j < 4; ++j) { const f32x4 gg = gr[64 * j]; u32x2 w; w.x = pk2(v[j].x * rstd * gg.x, v[j].y * rstd * gg.y); w.y = pk2(v[j].z * rstd * gg.z, v[j].w * rstd * gg.w); o8[64 * j] = w; }
}

DI void rms_rowbf_to_bf16(const bf16* xrow, const float* g, bf16* orow, int lane) {
    float v[16]; float s = 0.f;
#pragma unroll
    for (int hf = 0; hf < 2; ++hf) { const u32x4 w = *(const u32x4*)(xrow + 512 * hf + 8 * lane);
#pragma unroll
        for (int q = 0; q < 4; ++q) { v[8 * hf + 2 * q] = bflo(w[q]); v[8 * hf + 2 * q + 1] = bfhi(w[q]); } }
#pragma unroll
    for (int j = 0; j < 16; ++j) s += v[j] * v[j];
    const float rstd = rsq_f(wave_sum(s) * (1.f / D) + EPS);
#pragma unroll
    for (int hf = 0; hf < 2; ++hf) { const f32x4 g0 = *(const f32x4*)(g + 512 * hf + 8 * lane), g1 = *(const f32x4*)(g + 512 * hf + 8 * lane + 4);
        u32x4 w; w.x = pk2(v[8 * hf] * rstd * g0.x, v[8 * hf + 1] * rstd * g0.y); w.y = pk2(v[8 * hf + 2] * rstd * g0.z, v[8 * hf + 3] * rstd * g0.w);
        w.z = pk2(v[8 * hf + 4] * rstd * g1.x, v[8 * hf + 5] * rstd * g1.y); w.w = pk2(v[8 * hf + 6] * rstd * g1.z, v[8 * hf + 7] * rstd * g1.w);
        *(u32x4*)(orow + 512 * hf + 8 * lane) = w; }
}

__global__ void __launch_bounds__(NTHREADS, 2) fwd(Args args) {
    extern __shared__ __attribute__((aligned(16))) unsigned char lds_raw[];
    LAS unsigned char* lds = (LAS unsigned char*)lds_raw;
    volatile LAS unsigned* MISC = (volatile LAS unsigned*)(lds + MISC_OFF);
    const int G = gridDim.x, bid = blockIdx.x, NGW = G * NWAVES;
    const int wv0 = __builtin_amdgcn_readfirstlane((int)(threadIdx.x >> 6));
#define PHASE_IDS const int tid = fresh_tid(), lane = tid & 63, wave = __builtin_amdgcn_readfirstlane(tid >> 6), gw = bid * NWAVES + wave; (void)tid; (void)lane; (void)wave; (void)gw
    unsigned char* ws = args.ws;
    unsigned* ctl = (unsigned*)(ws + WS_CTL);
    const int lo = args.ph_lo, hi = args.ph_hi;

    for (int u = fresh_tid(); u < (LDS_BYTES - RING_BYTES) / 4; u += NTHREADS) ((LAS unsigned*)(lds + RING_BYTES))[u] = 0u;
    __syncthreads();
    XcdBarrier bar; bar.bar = ctl + CW_BAR; bar.x = 0; bar.st = nullptr; bar.w0 = wv0;
    if (hi - lo > 1) bar = xcd_barrier_post(ctl + CW_BAR, MISC + 8, wv0);
#define IN(k) (lo <= (k) && (k) < hi)
#define SEAM(k) do { if (IN(k) && IN((k) + 1)) xcd_barrier(bar); } while (0)

#define Win_t ((bf16*)(ws + WS_WIN))
#define Wout_t ((bf16*)(ws + WS_WOUT))
#define Wq_t ((bf16*)(ws + WS_WQ))
#define Wk_t ((bf16*)(ws + WS_WK))
#define Wv_t ((bf16*)(ws + WS_WV))
#define Wo_t ((bf16*)(ws + WS_WO))
#define LoraB ((bf16*)(ws + WS_LORAB))
#define LruW ((bf16*)(ws + WS_LRUW))
#define WrT ((bf16*)(ws + WS_LRUW + 512 * 1024))
#define Wgu_t ((bf16*)(ws + WS_WGU))
#define Wdn_t ((bf16*)(ws + WS_WDN))
#define HN ((bf16*)(ws + WS_HN))
#define MEMN ((bf16*)(ws + WS_MEMN))
#define KM ((bf16*)(ws + WS_KM))
#define VT ((bf16*)(ws + WS_VT))
#define X1 ((bf16*)(ws + WS_X1))
#define X2 ((bf16*)(ws + WS_X2))
#define U ((bf16*)(ws + WS_U))
#define Rr ((float*)(ws + WS_R))
#define KRAW ((float*)(ws + WS_KRAW))
#define Vv ((float*)(ws + WS_V))
#define KKN ((float*)(ws + WS_KKN))
#define WD ((float*)(ws + WS_WD))
#define AA ((float*)(ws + WS_AA))
#define GG ((float*)(ws + WS_G))
#define LA ((bf16*)(ws + WS_LA))
#define LB ((bf16*)(ws + WS_LB))
#define AP ((bf16*)(ws + WS_AP))
#define CAT ((bf16*)(ws + WS_CAT))
#define Qb ((bf16*)(ws + WS_Q))
#define Ob CAT
#define X1F8 ((unsigned char*)(ws + WS_XS))
#define XS ((bf16*)(ws + WS_XS))
#define ACT ((bf16*)(ws + WS_ACT))
#define YS ((bf16*)(ws + WS_YS))
#define route_e ((int*)(ws + WS_ROUTE + RT_E))
#define route_pos ((int*)(ws + WS_ROUTE + RT_POS))
#define route_g ((float*)(ws + WS_ROUTE + RT_G))
#define row_sg ((u32x2*)(ws + WS_ROUTE + RT_SLOT))
#define tile_tab ((int*)(ws + WS_ROUTE + RT_TILE))
#define row_tok ((int*)(ws + WS_ROUTE + RT_TOK))
#define ecnt (ctl + CW_CNT)

    if (IN(0)) { PHASE_IDS;
        LAS float* scr = (LAS float*)(lds + wave * 16384);
        constexpr int I_IN = 16 * (INW / 32), I_SQ = 16 * 32;
        constexpr int N_ITEMS = I_IN + 5 * I_SQ;
        for (int it = gw; it < N_ITEMS; it += NGW) {
            int r = it;
            if (r < I_IN) { const int nblk = INW / 32, kb = r / nblk, nb = r % nblk; transpose_item(args.in[I_WIN], INW, D, Win_t, 64 * kb, 32 * nb, 32 * nb, scr, lane); continue; } r -= I_IN;
            { const int w = r / I_SQ, q = r % I_SQ, kb = q / 32, nb = q % 32;
                if (w == 1) continue;
                const float* src = w == 0 ? args.in[I_WOUT] : w == 2 ? args.in[I_WK] : w == 3 ? args.in[I_WV] : args.in[I_WO];
                bf16* dst = w == 0 ? Wout_t : w == 2 ? Wk_t : w == 3 ? Wv_t : Wo_t;
                transpose_item(src, D, D, dst, 64 * kb, 32 * nb, 32 * nb, scr, lane); }
        }
        for (int idx = bid * NTHREADS + tid; idx < D * D / 4; idx += G * NTHREADS) { const f32x4 v = ((const f32x4*)args.in[I_WQ])[idx]; const float gk = args.in[I_NXAG][idx >> 8];
            u32x2 w; w.x = pk2(v.x * gk, v.y * gk); w.y = pk2(v.z * gk, v.w * gk); ((u32x2*)Wq_t)[idx] = w; }
        for (int idx = bid * NTHREADS + tid; idx < 1536 * 256; idx += G * NTHREADS) {
            const int e = idx & 7, ln = (idx >> 3) & 63, ks = (idx >> 9) & 7, ct = (idx >> 12) & 3, hk = idx >> 14, hh = hk / 3, kind = hk - 3 * hh;
            const int k = 32 * ks + 8 * (ln >> 4) + e, n = hh * 64 + 16 * ct + (ln & 15); float v = 0.f;
            if (kind == 0) { if (k < 64) v = args.in[I_WUP][k * 512 + n]; }
            else if (kind == 1) { if (k >= 64 && k < 128) v = args.in[I_AUP][(k - 64) * 512 + n]; }
            else { if (k >= 128) v = args.in[I_GUP][(k - 128) * 512 + n]; }
            LoraB[idx] = (bf16)f2bf(v);
        }
        for (int idx = bid * NTHREADS + tid; idx < 8 * 128 * 64; idx += G * NTHREADS) {
            const int nb = idx >> 13, col = (idx >> 6) & 127, k = idx & 63;
            const float v = col < 64 ? args.in[I_LWX][nb * 4096 + k * 64 + col] : args.in[I_LWA][nb * 4096 + k * 64 + (col - 64)];
            LruW[idx] = (bf16)f2bf(v);
        }
        for (int idx = bid * NTHREADS + tid; idx < NE * D; idx += G * NTHREADS) {
            const int e = idx >> 10, k = idx & 1023; const float v = args.in[I_WR][k * NE + e];
            const unsigned hi = f2bf(v); const float lo = v - __uint_as_float(hi << 16);
            WrT[idx] = (bf16)hi; WrT[NE * D + idx] = (bf16)f2bf(lo);
        }
        for (int m = gw; m < M; m += NGW) rms_row_to_bf16(args.in[I_X] + (size_t)m * D, args.in[I_NMIXG], HN + (size_t)m * D, lane);
        for (int m = gw; m < MROWS; m += NGW) rms_row_to_bf16(args.in[I_MEM] + (size_t)m * D, args.in[I_NMEMG], MEMN + (size_t)m * D, lane);
        {
            LAS float* scr = (LAS float*)(lds + wave * 16384);
            constexpr int I_GU = 16 * 64, I_DN = 16 * 32;
            for (int it = CONV_P9 + gw; it < NE * I_GU; it += NGW) {
                int r = it;
                if (r < NE * I_GU) { const int e = r / I_GU, q = r % I_GU, kb = q / 64, nb = q % 64; const int n0 = 32 * nb;
                    const int drow = n0 < 1024 ? (256 * (n0 >> 7) + (n0 & 127)) : (256 * ((n0 - 1024) >> 7) + 128 + ((n0 - 1024) & 127));
                    transpose_item_tiled_fp8(args.in[I_WGU] + (size_t)e * D * 2048, 2048, D, (unsigned char*)Wgu_t + (size_t)e * 2048 * D, 64 * kb, n0, drow, scr, lane); continue; } r -= NE * I_GU;
                { const int e = r / I_DN, q = r % I_DN, kb = q / 32, nb = q % 32;
                  transpose_item_tiled(args.in[I_WDN] + (size_t)e * DFF * D, D, DFF, Wdn_t + (size_t)e * D * DFF, 64 * kb, 32 * nb, 32 * nb, scr, lane); }
            }
        }
    }
    SEAM(0);

    if (IN(1)) { PHASE_IDS;
        { pg8::DenseSched S; S.o.init_tiles(M / 256, INW / 256, G, bid); S.A = (const char*)HN; S.B = (const char*)Win_t; S.tstep = (size_t)256 * D * 2;
          EpiBf16Plain E{U, INW, 1.0f}; pg8::gemm_phase(lds, D, S, E, wv0); }
        { pg8::DenseSched S; S.o.init_tiles(MROWS / 256, D / 256, G, (bid + 64) & (G - 1)); S.A = (const char*)MEMN; S.B = (const char*)Wk_t; S.tstep = (size_t)256 * D * 2;
          EpiBf16Plain E{KM, D, 1.0f}; pg8::gemm_phase(lds, D, S, E, wv0); }
        { pg8::DenseSched S; S.o.init_tiles(MROWS / 256, D / 256, G, (bid + 48) & (G - 1)); S.A = (const char*)MEMN; S.B = (const char*)Wv_t; S.tstep = (size_t)256 * D * 2;
          EpiBf16Plain E{VT, D, 1.0f}; pg8::gemm_phase(lds, D, S, E, wv0); }
    }
    SEAM(1);

    if (IN(2)) { PHASE_IDS;
        const float* conv_w = args.in[I_CONVW]; const float* conv_b = args.in[I_CONVB];
        LAS float* xs = (LAS float*)(lds + wave * 16384);
        LAS bf16* tP = (LAS bf16*)(lds + wave * 16384 + 4096); LAS bf16* tH = tP + 1024;
        const int i = lane & 15, kg = lane >> 4;
        for (int unit = gw; unit < (M / 64) * 8; unit += NGW) {
            const int seg = unit >> 3, nb = unit & 7, m0s = seg * 64, s0s = m0s & (SEQ - 1);
            bf16x8 wf[8][2];
#pragma unroll
            for (int ct = 0; ct < 8; ++ct)
#pragma unroll
                for (int ks = 0; ks < 2; ++ks) wf[ct][ks] = *(const bf16x8*)(LruW + ((size_t)(nb * 128 + 16 * ct + i) * 64 + 32 * ks + 8 * kg));
            float bxv[4], bav[4], spv[4], Arun[4], Brun[4];
#pragma unroll
            for (int ct = 0; ct < 4; ++ct) { const int ch = nb * 64 + 16 * ct + i; bxv[ct] = args.in[I_LBX][ch]; bav[ct] = args.in[I_LBA][ch]; spv[ct] = softplus_f(-args.in[I_LAM][ch]); Arun[ct] = 1.f; Brun[ct] = 0.f; }
#pragma unroll 1
            for (int jt = 0; jt < 4; ++jt) {
                const int m0 = m0s + 16 * jt, s0 = s0s + 16 * jt;
                bf16x8 af[2];
#pragma unroll
                for (int ks = 0; ks < 2; ++ks) {
                    const int chb = nb * 64 + 32 * ks + 8 * kg;
                    f32x4 x0 = *(const f32x4*)(conv_b + chb), x1 = *(const f32x4*)(conv_b + chb + 4);
#pragma unroll
                    for (int j = 0; j < 4; ++j) {
                        const bool ok = s0 + i - 3 + j >= 0;
                        u32x4 uw = *(const u32x4*)(U + (size_t)(ok ? m0 + i - 3 + j : m0) * INW + chb); if (!ok) uw = (u32x4){0u, 0u, 0u, 0u};
                        const f32x4 w0 = *(const f32x4*)(conv_w + j * 512 + chb), w1 = *(const f32x4*)(conv_w + j * 512 + chb + 4);
                        x0.x += w0.x * bflo(uw.x); x0.y += w0.y * bfhi(uw.x); x0.z += w0.z * bflo(uw.y); x0.w += w0.w * bfhi(uw.y);
                        x1.x += w1.x * bflo(uw.z); x1.y += w1.y * bfhi(uw.z); x1.z += w1.z * bflo(uw.w); x1.w += w1.w * bfhi(uw.w);
                    }
                    *(LAS f32x4*)(xs + i * 64 + 32 * ks + 8 * kg) = x0; *(LAS f32x4*)(xs + i * 64 + 32 * ks + 8 * kg + 4) = x1;
                    u32x4 p; p.x = pk2(x0.x, x0.y); p.y = pk2(x0.z, x0.w); p.z = pk2(x1.x, x1.y); p.w = pk2(x1.z, x1.w);
                    af[ks] = __builtin_bit_cast(bf16x8, p);
                }
                f32x4 acc[8];
#pragma unroll
                for (int ct = 0; ct < 8; ++ct) { acc[ct] = (f32x4){0.f, 0.f, 0.f, 0.f};
#pragma unroll
                    for (int ks = 0; ks < 2; ++ks) acc[ct] = __builtin_amdgcn_mfma_f32_16x16x32_bf16(af[ks], wf[ct][ks], acc[ct], 0, 0, 0); }
#pragma unroll
                for (int ct = 0; ct < 4; ++ct) {
                    const int col = 16 * ct + i;
                    float hl[4], pl[4]; float hprev = 0.f, pprev = 1.f;
#pragma unroll
                    for (int e = 0; e < 4; ++e) {
                        const float gx = sigmoid_f(acc[ct][e] + bxv[ct]), ga = sigmoid_f(acc[ct + 4][e] + bav[ct]);
                        const float la = -8.0f * ga * spv[ct], av = __expf(la), xcv = xs[(4 * kg + e) * 64 + col];
                        const float bt = __builtin_amdgcn_sqrtf(fmaxf(1.0f - av * av, 0.f)) * gx * xcv;
                        hprev = av * hprev + bt; pprev *= av; hl[e] = hprev; pl[e] = pprev;
                    }
                    float Ag[4], Bg[4];
#pragma unroll
                    for (int gq = 0; gq < 4; ++gq) { Ag[gq] = __shfl(pl[3], i + 16 * gq); Bg[gq] = __shfl(hl[3], i + 16 * gq); }
                    float Ain = Arun[ct], Bin = Brun[ct];
#pragma unroll
                    for (int gq = 0; gq < 3; ++gq) if (gq < kg) { Bin = Ag[gq] * Bin + Bg[gq]; Ain *= Ag[gq]; }
                    float At = 1.f, Bt = 0.f;
#pragma unroll
                    for (int gq = 0; gq < 4; ++gq) { Bt = Ag[gq] * Bt + Bg[gq]; At *= Ag[gq]; }
                    Brun[ct] = At * Brun[ct] + Bt; Arun[ct] *= At;
#pragma unroll
                    for (int e = 0; e < 4; ++e) { const int ti_ = (4 * kg + e) * 64 + col; tP[ti_] = (bf16)f2bf(pl[e] * Ain); tH[ti_] = (bf16)f2bf(hl[e] + pl[e] * Bin); }
                }
                { const int rr = lane >> 2, cq = lane & 3;
                  bf16* pp = LA + (size_t)(m0 + rr) * 512 + nb * 64 + 16 * cq; bf16* hp = LB + (size_t)(m0 + rr) * 512 + nb * 64 + 16 * cq;
                  *(u32x4*)pp = *(const LAS u32x4*)(tP + rr * 64 + 16 * cq); *(u32x4*)(pp + 8) = *(const LAS u32x4*)(tP + rr * 64 + 16 * cq + 8);
                  *(u32x4*)hp = *(const LAS u32x4*)(tH + rr * 64 + 16 * cq); *(u32x4*)(hp + 8) = *(const LAS u32x4*)(tH + rr * 64 + 16 * cq + 8); }
            }
            if (kg == 0) {
#pragma unroll
                for (int ct = 0; ct < 4; ++ct) { f32x2 ab; ab.x = Arun[ct]; ab.y = Brun[ct];
                    *(f32x2*)((float*)(ws + WS_AP) + ((size_t)(((seg >> 6) * 8 + nb) * 64 + (seg & 63)) * 64 + 16 * ct + i) * 2) = ab; }
            }
        }
    }
    SEAM(2);


#define RW_ZB(zz, zb) do { _Pragma("unroll") for (int ks_ = 0; ks_ < 2; ++ks_) { u32x4 p_; p_.x = pk2(zz[2 * ks_][0], zz[2 * ks_][1]); p_.y = pk2(zz[2 * ks_][2], zz[2 * ks_][3]); \
        p_.z = pk2(zz[2 * ks_ + 1][0], zz[2 * ks_ + 1][1]); p_.w = pk2(zz[2 * ks_ + 1][2], zz[2 * ks_ + 1][3]); zb[ks_] = __builtin_bit_cast(bf16x8, p_); } } while (0)
    if (IN(3)) { PHASE_IDS;
        for (int u64 = gw; u64 < NB * NH * (SEQ / 64); u64 += NGW) {
#pragma unroll 1
        for (int jj = 0; jj < 4; ++jj) {
        LAS unsigned char* wl = lds + wave * 16384;
        LAS bf16* Arm = (LAS bf16*)(wl); LAS bf16* Brm = (LAS bf16*)(wl + 2048); LAS bf16* Krm = (LAS bf16*)(wl + 4096); LAS bf16* Rrm = (LAS bf16*)(wl + 6144);
        LAS bf16* ATt = (LAS bf16*)(wl + 8192); LAS bf16* BTt = (LAS bf16*)(wl + 10240); LAS bf16* KTt = (LAS bf16*)(wl + 12288); LAS bf16* VTt = (LAS bf16*)(wl + 14336);
        LAS float* MabT = (LAS float*)(wl); LAS bf16* Mak = (LAS bf16*)(wl + 1024); LAS bf16* Mrb = (LAS bf16*)(wl + 1536); LAS bf16* Mrk = (LAS bf16*)(wl + 2048); LAS bf16* Tm = (LAS bf16*)(wl + 2560);
        LAS float* PLs = (LAS float*)(wl + 3072); LAS bf16* Q0T = (LAS bf16*)(wl + 4096);
        const int lane = fresh_tid() & 63, l15 = lane & 15, g = lane >> 4, te = lane >> 2, kq = lane & 3;
        const bf16x8 z8 = (bf16x8){0, 0, 0, 0, 0, 0, 0, 0};
        const f32x4 z4 = (f32x4){0.f, 0.f, 0.f, 0.f};
            const int un = u64 * 4 + jj;
            const int bh = un >> 8, c = un & 255, b = bh >> 3, h = bh & 7;
            const size_t mrow = (size_t)b * SEQ + c * 16 + te, off = mrow * 512 + h * 64 + 16 * kq;
            const int hc = h * 64 + 16 * kq;
            LAS float* tmpL = (LAS float*)wl;
            {
                const int rsub = lane >> 5, chunk = lane & 31; const size_t mt0 = (size_t)b * SEQ + c * 16;
                const f32x4 m0 = *(const f32x4*)(args.in[I_MU] + 1536 + 8 * chunk), m1 = *(const f32x4*)(args.in[I_MU] + 1536 + 8 * chunk + 4);
                u32x4 cu[8], pu[8];
#pragma unroll
                for (int i = 0; i < 8; ++i) { const size_t mr = mt0 + 2 * i + rsub; const bool hp2 = (mr & (SEQ - 1)) != 0; const bf16* ua = U + mr * INW + 2560 + 8 * chunk;
                    cu[i] = *(const u32x4*)ua; pu[i] = *(const u32x4*)(ua - (hp2 ? INW : 0)); if (!hp2) pu[i] = (u32x4){0u, 0u, 0u, 0u}; }
#pragma unroll
                for (int i = 0; i < 8; ++i) { float o8[8];
#pragma unroll
                    for (int q = 0; q < 4; ++q) { const float c0 = bflo(cu[i][q]), c1 = bfhi(cu[i][q]), p0 = bflo(pu[i][q]), p1 = bfhi(pu[i][q]); const float mm0 = q < 2 ? m0[2 * q] : m1[2 * q - 4], mm1 = q < 2 ? m0[2 * q + 1] : m1[2 * q - 3];
                        float x0 = c0 + (p0 - c0) * mm0, x1 = c1 + (p1 - c1) * mm1;
                        if (chunk < 8) { x0 = tanh_fast(x0); x1 = tanh_fast(x1); }
                        else if (chunk >= 16) { x0 = sigmoid_f(x0); x1 = sigmoid_f(x1); }
                        o8[2 * q] = x0; o8[2 * q + 1] = x1; }
                    u32x4 pw; pw.x = pk2(o8[0], o8[1]); pw.y = pk2(o8[2], o8[3]); pw.z = pk2(o8[4], o8[5]); pw.w = pk2(o8[6], o8[7]);
                    const int row = 2 * i + rsub; *(LAS u32x4*)(wl + row * 512 + ((chunk ^ (row & 7)) << 4)) = pw; }
                bf16x8 af[8];
#pragma unroll
                for (int ks = 0; ks < 8; ++ks) af[ks] = *(const LAS bf16x8*)(wl + l15 * 512 + (((4 * ks + g) ^ (l15 & 7)) << 4));
                asm volatile("s_waitcnt lgkmcnt(0)" ::: "memory");
#pragma unroll
                for (int kind = 0; kind < 3; ++kind)
#pragma unroll
                    for (int ct = 0; ct < 4; ++ct) {
                        const bf16* lb = LoraB + ((size_t)((h * 3 + kind) * 4 + ct) * 8 * 64 + lane) * 8;
                        f32x4 a4 = z4;
#pragma unroll
                        for (int ks = (kind == 0 ? 0 : kind == 1 ? 2 : 4); ks < (kind == 0 ? 2 : kind == 1 ? 4 : 8); ++ks) a4 = __builtin_amdgcn_mfma_f32_16x16x32_bf16(af[ks], *(const bf16x8*)(lb + ks * 512), a4, 0, 0, 0);
#pragma unroll
                        for (int e = 0; e < 4; ++e) tmpL[kind * 1088 + (4 * g + e) * 68 + 16 * ct + l15] = a4[e];
                    }
            }
            asm volatile("s_waitcnt lgkmcnt(0)" ::: "memory");
            float cl[16], eP[16];
            {
                float lwv[16], rl[16], kl[16], vl[16], kn[16], av[16];
                const bool hp = (mrow & (SEQ - 1)) != 0;
                const bf16* ub = U + mrow * INW + 1024 + hc;
#pragma unroll
                for (int hh = 0; hh < 2; ++hh) {
#pragma unroll
                    for (int a3 = 0; a3 < 3; ++a3) {
                        const u32x4 cu = *(const u32x4*)(ub + 512 * a3 + 8 * hh); u32x4 pu = *(const u32x4*)(ub - (hp ? INW : 0) + 512 * a3 + 8 * hh); if (!hp) pu = (u32x4){0u, 0u, 0u, 0u};
                        const f32x4 m0 = *(const f32x4*)(args.in[I_MU] + 512 * a3 + hc + 8 * hh), m1 = *(const f32x4*)(args.in[I_MU] + 512 * a3 + hc + 8 * hh + 4);
                        float o8[8];
#pragma unroll
                        for (int q = 0; q < 4; ++q) { const float c0 = bflo(cu[q]), c1 = bfhi(cu[q]), p0 = bflo(pu[q]), p1 = bfhi(pu[q]); const float mm0 = q < 2 ? m0[2 * q] : m1[2 * q - 4], mm1 = q < 2 ? m0[2 * q + 1] : m1[2 * q - 3];
                            o8[2 * q] = c0 + (p0 - c0) * mm0; o8[2 * q + 1] = c1 + (p1 - c1) * mm1; }
#pragma unroll
                        for (int q = 0; q < 8; ++q) { if (a3 == 0) rl[8 * hh + q] = o8[q]; else if (a3 == 1) kl[8 * hh + q] = o8[q]; else vl[8 * hh + q] = o8[q]; }
                    }
                }
                float gv[16];
#pragma unroll
                for (int j4 = 0; j4 < 4; ++j4) { const f32x4 xl = *(const LAS f32x4*)(tmpL + te * 68 + 16 * kq + 4 * j4), xa = *(const LAS f32x4*)(tmpL + 1088 + te * 68 + 16 * kq + 4 * j4), xg = *(const LAS f32x4*)(tmpL + 2176 + te * 68 + 16 * kq + 4 * j4);
                    const f32x4 w0v = *(const f32x4*)(args.in[I_W0] + hc + 4 * j4), a0v = *(const f32x4*)(args.in[I_A0] + hc + 4 * j4);
#pragma unroll
                    for (int q = 0; q < 4; ++q) { const float wq = -softplus_fast(-(xl[q] + w0v[q])) - 0.5f; lwv[4 * j4 + q] = -__expf(wq); av[4 * j4 + q] = sigmoid_f(xa[q] + a0v[q]); gv[4 * j4 + q] = xg[q]; } }
                asm volatile("s_waitcnt lgkmcnt(0)" ::: "memory");
                float ss = 0.f;
#pragma unroll
                for (int j4 = 0; j4 < 4; ++j4) { const f32x4 kk4 = *(const f32x4*)(args.in[I_KK] + hc + 4 * j4);
#pragma unroll
                    for (int q = 0; q < 4; ++q) { kn[4 * j4 + q] = kl[4 * j4 + q] * kk4[q]; ss += kn[4 * j4 + q] * kn[4 * j4 + q]; } }
                ss += __shfl_xor(ss, 1); ss += __shfl_xor(ss, 2);
                const float kinv = rsq_f(fmaxf(ss, 1e-24f));
#pragma unroll
                for (int j = 0; j < 16; ++j) { float x = lwv[j];
#pragma unroll
                    for (int sft = 4; sft < 64; sft <<= 1) { const float y = __shfl_up(x, sft); if (lane >= sft) x += y; }
                    cl[j] = x; }
                float bon = 0.f;
                u32x4 pa[2], pb[2], pk[2], pr[2];
#pragma unroll
                for (int j4 = 0; j4 < 4; ++j4) {
                    const f32x4 ka = *(const f32x4*)(args.in[I_KA] + hc + 4 * j4), rk = *(const f32x4*)(args.in[I_RK] + hc + 4 * j4);
                    float at4[4], bt4[4], kt4[4], rt4[4];
#pragma unroll
                    for (int q = 0; q < 4; ++q) { const int j = 4 * j4 + q;
                        const float p = __expf(cl[j]), pn = __expf(-cl[j]), pm1 = __expf(cl[j] - lwv[j]); eP[j] = p;
                        const float knj = kn[j] * kinv;
                        const float kp = kl[j] * (1.0f + (av[j] - 1.0f) * ka[q]);
                        at4[q] = -knj * pm1; bt4[q] = knj * av[j] * pn; kt4[q] = kp * pn; rt4[q] = rl[j] * p;
                        bon += rl[j] * kp * rk[q];
                        const int kk = 16 * kq + j;
                        ATt[kk * 16 + te] = (bf16)f2bf(at4[q]); BTt[kk * 16 + te] = (bf16)f2bf(bt4[q]); KTt[kk * 16 + te] = (bf16)f2bf(kt4[q]); VTt[kk * 16 + te] = (bf16)f2bf(vl[j]); }
                    const int hh = j4 >> 1, w2 = (j4 & 1) * 2;
                    pa[hh][w2] = pk2(at4[0], at4[1]); pa[hh][w2 + 1] = pk2(at4[2], at4[3]); pb[hh][w2] = pk2(bt4[0], bt4[1]); pb[hh][w2 + 1] = pk2(bt4[2], bt4[3]);
                    pk[hh][w2] = pk2(kt4[0], kt4[1]); pk[hh][w2 + 1] = pk2(kt4[2], kt4[3]); pr[hh][w2] = pk2(rt4[0], rt4[1]); pr[hh][w2 + 1] = pk2(rt4[2], rt4[3]);
                }
#pragma unroll
                for (int hh = 0; hh < 2; ++hh) { const int po = te * 64 + 8 * ((2 * kq + hh) ^ (te & 7));
                    *(LAS u32x4*)(Arm + po) = pa[hh]; *(LAS u32x4*)(Brm + po) = pb[hh]; *(LAS u32x4*)(Krm + po) = pk[hh]; *(LAS u32x4*)(Rrm + po) = pr[hh]; }
                bon += __shfl_xor(bon, 1); bon += __shfl_xor(bon, 2);
                f32x4 lbv[4], lgv[4];
#pragma unroll
                for (int j4 = 0; j4 < 4; ++j4) { lbv[j4] = *(const f32x4*)(args.in[I_LNB] + hc + 4 * j4); lgv[j4] = *(const f32x4*)(args.in[I_LNG] + hc + 4 * j4); }
#pragma unroll
                for (int j4 = 0; j4 < 4; ++j4) { const f32x4 lb = lbv[j4], lgn = lgv[j4]; const int j0 = 4 * j4;
                    u32x2 ow, gw2; ow.x = pk2((lb.x + vl[j0] * bon) * gv[j0], (lb.y + vl[j0 + 1] * bon) * gv[j0 + 1]); ow.y = pk2((lb.z + vl[j0 + 2] * bon) * gv[j0 + 2], (lb.w + vl[j0 + 3] * bon) * gv[j0 + 3]);
                    gw2.x = pk2(lgn.x * gv[j0], lgn.y * gv[j0 + 1]); gw2.y = pk2(lgn.z * gv[j0 + 2], lgn.w * gv[j0 + 3]);
                    *(u32x2*)((bf16*)(ws + WS_ADD) + off + j0) = ow; *(u32x2*)((bf16*)(ws + WS_G) + off + j0) = gw2; }
            }
            asm volatile("s_waitcnt lgkmcnt(0)" ::: "memory");
            {
                bf16x8 fa[2], fr[2], fb[2], fk[2];
#pragma unroll
                for (int ks = 0; ks < 2; ++ks) { const int po = l15 * 64 + 8 * ((4 * ks + g) ^ (l15 & 7));
                    fa[ks] = *(const LAS bf16x8*)(Arm + po); fr[ks] = *(const LAS bf16x8*)(Rrm + po); fb[ks] = *(const LAS bf16x8*)(Brm + po); fk[ks] = *(const LAS bf16x8*)(Krm + po); }
                f32x4 mab = z4, mak = z4, mrb = z4, mrk = z4;
#pragma unroll
                for (int ks = 0; ks < 2; ++ks) { mab = __builtin_amdgcn_mfma_f32_16x16x32_bf16(fb[ks], fa[ks], mab, 0, 0, 0); mak = __builtin_amdgcn_mfma_f32_16x16x32_bf16(fk[ks], fa[ks], mak, 0, 0, 0);
                    mrb = __builtin_amdgcn_mfma_f32_16x16x32_bf16(fb[ks], fr[ks], mrb, 0, 0, 0); mrk = __builtin_amdgcn_mfma_f32_16x16x32_bf16(fk[ks], fr[ks], mrk, 0, 0, 0); }
#pragma unroll
                for (int e = 0; e < 4; ++e) { const int i = 4 * g + e; if (!(i < l15)) { mab[e] = 0.f; mak[e] = 0.f; } if (!(i <= l15)) { mrb[e] = 0.f; mrk[e] = 0.f; } }
                asm volatile("s_waitcnt lgkmcnt(0)" ::: "memory");
#pragma unroll
                for (int e = 0; e < 4; ++e) MabT[(4 * g + e) * 16 + l15] = mab[e];
                u32x2 w; w.x = pk2(mak[0], mak[1]); w.y = pk2(mak[2], mak[3]); *(LAS u32x2*)(Mak + l15 * 16 + 4 * g) = w;
                w.x = pk2(mrb[0], mrb[1]); w.y = pk2(mrb[2], mrb[3]); *(LAS u32x2*)(Mrb + l15 * 16 + 4 * g) = w;
                w.x = pk2(mrk[0], mrk[1]); w.y = pk2(mrk[2], mrk[3]); *(LAS u32x2*)(Mrk + l15 * 16 + 4 * g) = w;
                if (te == 15) {
#pragma unroll
                    for (int j = 0; j < 16; ++j) PLs[16 * kq + j] = eP[j]; }
            }
            asm volatile("s_waitcnt lgkmcnt(0)" ::: "memory");
            {
                f32x4 mq[15][4];
#pragma unroll
                for (int j = 0; j < 15; ++j)
#pragma unroll
                    for (int q = 0; q < 4; ++q) if (4 * q + 3 > j) mq[j][q] = *(const LAS f32x4*)(MabT + j * 16 + 4 * q);
                float y[16];
#pragma unroll
                for (int j = 15; j >= 0; --j) {
                    float acc = (j == l15) ? 1.0f : 0.0f;
#pragma unroll
                    for (int i = j + 1; i < 16; ++i) acc += y[i] * mq[j < 15 ? j : 0][i >> 2][i & 3];
                    y[j] = acc;
                }
                if (g == 0) { u32x4 t0, t1; t0.x = pk2(y[0], y[1]); t0.y = pk2(y[2], y[3]); t0.z = pk2(y[4], y[5]); t0.w = pk2(y[6], y[7]); t1.x = pk2(y[8], y[9]); t1.y = pk2(y[10], y[11]); t1.z = pk2(y[12], y[13]); t1.w = pk2(y[14], y[15]);
                    *(LAS u32x4*)(Tm + l15 * 16) = t0; *(LAS u32x4*)(Tm + l15 * 16 + 8) = t1; }
            }
            asm volatile("s_waitcnt lgkmcnt(0)" ::: "memory");
            {
                const bool act = g < 2; const int fo = l15 * 16 + 8 * g;
                const bf16x8 fT = act ? *(const LAS bf16x8*)(Tm + fo) : z8, fMak = act ? *(const LAS bf16x8*)(Mak + fo) : z8, fMrb = act ? *(const LAS bf16x8*)(Mrb + fo) : z8, fMrk = act ? *(const LAS bf16x8*)(Mrk + fo) : z8;
                bf16x8 fV[4], fQ1[4], fAh[4], fBT[4], fKT[4];
#pragma unroll
                for (int vt = 0; vt < 4; ++vt) { fV[vt] = act ? *(const LAS bf16x8*)(VTt + vt * 256 + fo) : z8; fBT[vt] = act ? *(const LAS bf16x8*)(BTt + vt * 256 + fo) : z8; fKT[vt] = act ? *(const LAS bf16x8*)(KTt + vt * 256 + fo) : z8; }
#pragma unroll
                for (int vt = 0; vt < 4; ++vt) { const f32x4 q0 = __builtin_amdgcn_mfma_f32_16x16x32_bf16(fMak, fV[vt], z4, 0, 0, 0);
                    u32x2 w; w.x = pk2(q0[0], q0[1]); w.y = pk2(q0[2], q0[3]); *(LAS u32x2*)(Q0T + vt * 256 + l15 * 16 + 4 * g) = w; }
#pragma unroll
                for (int kt = 0; kt < 4; ++kt) { const bf16x8 fA = act ? *(const LAS bf16x8*)(ATt + kt * 256 + fo) : z8; const f32x4 ah = __builtin_amdgcn_mfma_f32_16x16x32_bf16(fT, fA, z4, 0, 0, 0);
                    u32x2 w; w.x = pk2(ah[0], ah[1]); w.y = pk2(ah[2], ah[3]); *(LAS u32x2*)(ATt + kt * 256 + l15 * 16 + 4 * g) = w; }
                asm volatile("s_waitcnt lgkmcnt(0)" ::: "memory");
#pragma unroll
                for (int vt = 0; vt < 4; ++vt) { const bf16x8 fQ0 = act ? *(const LAS bf16x8*)(Q0T + vt * 256 + fo) : z8; const f32x4 q1 = __builtin_amdgcn_mfma_f32_16x16x32_bf16(fT, fQ0, z4, 0, 0, 0);
                    u32x2 w; w.x = pk2(q1[0], q1[1]); w.y = pk2(q1[2], q1[3]); *(LAS u32x2*)(Q0T + vt * 256 + l15 * 16 + 4 * g) = w; }
                asm volatile("s_waitcnt lgkmcnt(0)" ::: "memory");
#pragma unroll
                for (int vt = 0; vt < 4; ++vt) { fQ1[vt] = act ? *(const LAS bf16x8*)(Q0T + vt * 256 + fo) : z8; fAh[vt] = act ? *(const LAS bf16x8*)(ATt + vt * 256 + fo) : z8; }
                bf16* rp = (bf16*)(ws + WS_RP) + (size_t)un * 1024 + l15 * 64;
#pragma unroll
                for (int kt = 0; kt < 4; ++kt) {
                    const u32x2 rr = *(const LAS u32x2*)(Rrm + l15 * 64 + 8 * ((2 * kt + (g >> 1)) ^ (l15 & 7)) + 4 * (g & 1));
                    f32x4 ini; ini[0] = bflo(rr.x); ini[1] = bfhi(rr.x); ini[2] = bflo(rr.y); ini[3] = bfhi(rr.y);
                    const f32x4 rh = __builtin_amdgcn_mfma_f32_16x16x32_bf16(fAh[kt], fMrb, ini, 0, 0, 0);
                    u32x2 w; w.x = pk2(rh[0], rh[1]); w.y = pk2(rh[2], rh[3]); *(u32x2*)(rp + 32 * (kt >> 1) + 8 * g + 4 * (kt & 1)) = w;
                }
#pragma unroll
                for (int vt = 0; vt < 4; ++vt) { f32x4 y1 = __builtin_amdgcn_mfma_f32_16x16x32_bf16(fMrb, fQ1[vt], z4, 0, 0, 0); y1 = __builtin_amdgcn_mfma_f32_16x16x32_bf16(fMrk, fV[vt], y1, 0, 0, 0);
                    *(f32x4*)((float*)(ws + WS_Y1F) + ((size_t)(un * 4 + vt) * 64 + lane) * 4) = y1; }
                LAS bf16* tgs = (LAS bf16*)(wl + 8192);
#pragma unroll
                for (int krt = 0; krt < 4; ++krt) { const float pl = PLs[16 * krt + l15];
#pragma unroll
                    for (int kct = 0; kct < 4; ++kct) { f32x4 ga = __builtin_amdgcn_mfma_f32_16x16x32_bf16(fAh[kct], fBT[krt], z4, 0, 0, 0);
                        if (kct == krt) {
#pragma unroll
                            for (int e = 0; e < 4; ++e) if (4 * g + e == l15) ga[e] += 1.0f; }
                        u32x2 w; w.x = pk2(ga[0] * pl, ga[1] * pl); w.y = pk2(ga[2] * pl, ga[3] * pl);
                        *(LAS u32x2*)(tgs + (16 * krt + l15) * 64 + 32 * (kct >> 1) + 8 * g + 4 * (kct & 1)) = w; } }
                { u32x4* gp16 = (u32x4*)((bf16*)(ws + WS_GP) + (size_t)un * 4096);
#pragma unroll
                  for (int i = 0; i < 8; ++i) gp16[i * 64 + lane] = *(const LAS u32x4*)(tgs + (i * 64 + lane) * 8); }
#pragma unroll
                for (int mt = 0; mt < 4; ++mt) { const f32x4 pl4 = *(const LAS f32x4*)(PLs + 16 * mt + 4 * g);
#pragma unroll
                    for (int vt = 0; vt < 4; ++vt) { f32x4 ha = __builtin_amdgcn_mfma_f32_16x16x32_bf16(fBT[mt], fQ1[vt], z4, 0, 0, 0); ha = __builtin_amdgcn_mfma_f32_16x16x32_bf16(fKT[mt], fV[vt], ha, 0, 0, 0);
                        u32x2 w; w.x = pk2(ha[0] * pl4[0], ha[1] * pl4[1]); w.y = pk2(ha[2] * pl4[2], ha[3] * pl4[3]);
                        *(u32x2*)((bf16*)(ws + WS_HF) + ((size_t)((un * 4 + vt) * 4 + mt) * 64 + lane) * 4) = w; } }
            }
            asm volatile("s_waitcnt lgkmcnt(0)" ::: "memory");
        }
        asm volatile("s_waitcnt vmcnt(0)" ::: "memory");
        { const int ltid = fresh_tid() & 63, l15 = ltid & 15, g = ltid >> 4, lane = ltid;
#define CP_LOADG(gf_, j_) do { const bf16* gp_ = (const bf16*)(ws + WS_GP) + ((size_t)u64 * 4 + (j_)) * 4096 + l15 * 64 + 8 * g; \
            _Pragma("unroll") for (int mt = 0; mt < 4; ++mt) { gf_[mt][0] = *(const bf16x8*)(gp_ + mt * 1024); gf_[mt][1] = *(const bf16x8*)(gp_ + mt * 1024 + 32); } } while (0)
#define CP_LOADH(hf_, j_) do { _Pragma("unroll") for (int sl = 0; sl < 4; ++sl) _Pragma("unroll") for (int mt = 0; mt < 4; ++mt) \
            hf_[sl][mt] = *(const u32x2*)((const bf16*)(ws + WS_HF) + ((size_t)((((size_t)u64 * 4 + (j_)) * 4 + sl) * 4 + mt) * 64 + lane) * 4); } while (0)
#define CP_STEP(gf_, hf_, useh_) do { _Pragma("unroll") for (int sl = 0; sl < 4; ++sl) { bf16x8 zb[2]; RW_ZB(z[sl], zb); \
            _Pragma("unroll") for (int mt = 0; mt < 4; ++mt) { f32x4 a_ = (f32x4){0.f, 0.f, 0.f, 0.f}; \
                if (useh_) { a_[0] = bflo(hf_[sl][mt].x); a_[1] = bfhi(hf_[sl][mt].x); a_[2] = bflo(hf_[sl][mt].y); a_[3] = bfhi(hf_[sl][mt].y); } \
                a_ = __builtin_amdgcn_mfma_f32_16x16x32_bf16(gf_[mt][0], zb[0], a_, 0, 0, 0); a_ = __builtin_amdgcn_mfma_f32_16x16x32_bf16(gf_[mt][1], zb[1], a_, 0, 0, 0); z[sl][mt] = a_; } } } while (0)
        {
            f32x4 z[4][4];
#pragma unroll
            for (int sl = 0; sl < 4; ++sl)
#pragma unroll
                for (int mt = 0; mt < 4; ++mt)
#pragma unroll
                    for (int e = 0; e < 4; ++e) z[sl][mt][e] = (sl == mt && 4 * g + e == l15) ? 1.0f : 0.0f;
            bf16x8 gA[4][2], gB[4][2]; u32x2 hdum[4][4];
            CP_LOADG(gA, 0); CP_LOADG(gB, 1);
            CP_STEP(gA, hdum, false); CP_LOADG(gA, 2);
            CP_STEP(gB, hdum, false); CP_LOADG(gB, 3);
            CP_STEP(gA, hdum, false);
            CP_STEP(gB, hdum, false);
            LAS bf16* tg = (LAS bf16*)(lds + wave * 16384);
#pragma unroll
            for (int sl = 0; sl < 4; ++sl) { const int pc = 32 * (sl >> 1) + 8 * (l15 >> 2) + 4 * (sl & 1) + (l15 & 3);
#pragma unroll
                for (int mt = 0; mt < 4; ++mt)
#pragma unroll
                    for (int e = 0; e < 4; ++e) tg[(16 * mt + 4 * g + e) * 64 + pc] = (bf16)f2bf(z[sl][mt][e]); }
            u32x4* gc = (u32x4*)((bf16*)(ws + WS_GC) + (size_t)u64 * 4096);
#pragma unroll
            for (int i = 0; i < 8; ++i) gc[i * 64 + lane] = *(const LAS u32x4*)(tg + (i * 64 + lane) * 8);
        }
        {
            f32x4 z[4][4];
#pragma unroll
            for (int sl = 0; sl < 4; ++sl)
#pragma unroll
                for (int mt = 0; mt < 4; ++mt) z[sl][mt] = (f32x4){0.f, 0.f, 0.f, 0.f};
            bf16x8 gA[4][2], gB[4][2]; u32x2 hA[4][4], hB[4][4];
            CP_LOADG(gA, 0); CP_LOADH(hA, 0); CP_LOADG(gB, 1); CP_LOADH(hB, 1);
            CP_STEP(gA, hA, true); CP_LOADG(gA, 2); CP_LOADH(hA, 2);
            CP_STEP(gB, hB, true); CP_LOADG(gB, 3); CP_LOADH(hB, 3);
            CP_STEP(gA, hA, true);
            CP_STEP(gB, hB, true);
#pragma unroll
            for (int sl = 0; sl < 4; ++sl)
#pragma unroll
                for (int mt = 0; mt < 4; ++mt) { u32x2 w; w.x = pk2(z[sl][mt][0], z[sl][mt][1]); w.y = pk2(z[sl][mt][2], z[sl][mt][3]);
                    *(u32x2*)((bf16*)(ws + WS_HC) + ((size_t)((u64 * 4 + sl) * 4 + mt) * 64 + lane) * 4) = w; }
        }
#undef CP_LOADG
#undef CP_LOADH
#undef CP_STEP
        }
        }
    }
    SEAM(3);


    if (IN(4)) { PHASE_IDS;
        if (!(bid < 128 && wave == 0)) {
            const int wi = bid < 128 ? bid * 7 + (wave - 1) : 896 + (bid - 128) * 8 + wave, NW = 896 + (G - 128) * 8;
        } else {
            const int l15 = lane & 15, g = lane >> 4, bh = bid >> 2, vs = bid & 3;
            f32x4 z[4];
#pragma unroll
            for (int mt = 0; mt < 4; ++mt) z[mt] = (f32x4){0.f, 0.f, 0.f, 0.f};
            bf16x8 gA[4][2], gB[4][2], gC[4][2], gD[4][2]; u32x2 hA[4], hB[4], hC[4], hD[4];
#define SC_LOAD(gf, hf, C) do { const size_t u64_ = (size_t)bh * 64 + (C); const bf16* gp_ = (const bf16*)(ws + WS_GC) + u64_ * 4096 + l15 * 64 + 8 * g; \
                _Pragma("unroll") for (int mt = 0; mt < 4; ++mt) { gf[mt][0] = *(const bf16x8*)(gp_ + mt * 1024); gf[mt][1] = *(const bf16x8*)(gp_ + mt * 1024 + 32); \
                    hf[mt] = *(const u32x2*)((const bf16*)(ws + WS_HC) + ((size_t)((u64_ * 4 + vs) * 4 + mt) * 64 + lane) * 4); } } while (0)
#define SC_STEP(gf, hf, C) do { const size_t u64_ = (size_t)bh * 64 + (C); bf16* zs_ = (bf16*)(ws + WS_ZS) + ((size_t)((u64_ * 4 + vs) * 4) * 64 + lane) * 4; \
                _Pragma("unroll") for (int mt = 0; mt < 4; ++mt) { u32x2 zw_; zw_.x = pk2(z[mt][0], z[mt][1]); zw_.y = pk2(z[mt][2], z[mt][3]); *(u32x2*)(zs_ + mt * 256) = zw_; } \
                bf16x8 zb[2]; RW_ZB(z, zb); \
                _Pragma("unroll") for (int mt = 0; mt < 4; ++mt) { f32x4 a; a[0] = bflo(hf[mt].x); a[1] = bfhi(hf[mt].x); a[2] = bflo(hf[mt].y); a[3] = bfhi(hf[mt].y); \
                    a = __builtin_amdgcn_mfma_f32_16x16x32_bf16(gf[mt][0], zb[0], a, 0, 0, 0); a = __builtin_amdgcn_mfma_f32_16x16x32_bf16(gf[mt][1], zb[1], a, 0, 0, 0); z[mt] = a; } } while (0)
            SC_LOAD(gA, hA, 0); SC_LOAD(gB, hB, 1); SC_LOAD(gC, hC, 2);
#pragma unroll 1
            for (int C = 0; C < 64; C += 4) {
                SC_LOAD(gD, hD, C + 3);
                SC_STEP(gA, hA, C);
                if (C + 4 < 64) SC_LOAD(gA, hA, C + 4);
                SC_STEP(gB, hB, C + 1);
                if (C + 5 < 64) SC_LOAD(gB, hB, C + 5);
                SC_STEP(gC, hC, C + 2);
                if (C + 6 < 64) SC_LOAD(gC, hC, C + 6);
                SC_STEP(gD, hD, C + 3);
            }
#undef SC_LOAD
#undef SC_STEP
        }
    }
    if (IN(4)) { PHASE_IDS;
        if (bid < 32 && wave == 1) { const int bc = bid; const f32x2* ag = (const f32x2*)((const float*)(ws + WS_AP)) + (size_t)(bc * 64) * 64 + lane;
            float* car = (float*)(ws + WS_AP + 4 * MiB) + (size_t)(bc * 64) * 64 + lane; float hst = 0.f;
#pragma unroll 16
            for (int sg = 0; sg < 64; ++sg) { const f32x2 ab = ag[(size_t)sg * 64]; car[(size_t)sg * 64] = hst; hst = ab.x * hst + ab.y; } }
    }
    if (IN(4)) { PHASE_IDS;
        bf16* WKt = HN; bf16* VWt = HN + (size_t)4 * 1024 * 1024;
        __syncthreads();
        if (bid >= 128 && bid < 192) { pg8::FoldSched<0> S; S.A = (const char*)KM; S.B = (const char*)Wq_t; S.G = 64; S.c = bid - 128; EpiFold<0> E{(unsigned char*)WKt}; pg8::gemm_phase(lds, 256, S, E, wv0, 1024); }
        else if (bid >= 192) { pg8::FoldSched<1> S; S.A = (const char*)Wo_t; S.B = (const char*)VT; S.G = 64; S.c = bid - 192; EpiFold<1> E{(unsigned char*)VWt}; pg8::gemm_phase(lds, 256, S, E, wv0, 1024); }
    }
    SEAM(4);

    if (IN(5)) { PHASE_IDS;
        {
            for (int lu = gw; lu < (M / 64) * 8; lu += NGW) {
                const int seg = lu >> 3, nb = lu & 7, rr = lane >> 3, cq = lane & 7;
                const float* cp = (const float*)(ws + WS_AP + 4 * MiB) + ((size_t)(((seg >> 6) * 8 + nb) * 64 + (seg & 63)) * 64 + 8 * cq);
                const f32x4 c0 = *(const f32x4*)cp, c1 = *(const f32x4*)(cp + 4);
#pragma unroll
                for (int it = 0; it < 8; ++it) { const size_t m = (size_t)seg * 64 + 8 * it + rr; const size_t o = m * 512 + nb * 64 + 8 * cq;
                    const u32x4 pw = *(const u32x4*)(LA + o), hw = *(const u32x4*)(LB + o), gw_ = *(const u32x4*)(U + m * INW + 512 + nb * 64 + 8 * cq);
                    float y[8];
#pragma unroll
                    for (int q = 0; q < 4; ++q) { const float ca = q < 2 ? c0[2 * q] : c1[2 * q - 4], cb = q < 2 ? c0[2 * q + 1] : c1[2 * q - 3];
                        y[2 * q] = (bflo(hw[q]) + bflo(pw[q]) * ca) * gelu_tanh_f(bflo(gw_[q])); y[2 * q + 1] = (bfhi(hw[q]) + bfhi(pw[q]) * cb) * gelu_tanh_f(bfhi(gw_[q])); }
                    u32x4 w; w.x = pk2(y[0], y[1]); w.y = pk2(y[2], y[3]); w.z = pk2(y[4], y[5]); w.w = pk2(y[6], y[7]);
                    *(u32x4*)(CAT + m * 1024 + nb * 64 + 8 * cq) = w; }
            }
        }
        const int l15 = lane & 15, g = lane >> 4;
        LAS bf16* tGL = (LAS bf16*)(lds + wave * 16384); LAS bf16* tAD = tGL + 1024; LAS bf16* tOUT = tGL + 2048;
        const int ct = lane >> 3, cc = lane & 7;
        for (int u64 = gw; u64 < NB * NH * (SEQ / 64); u64 += NGW) {
            const int bh = u64 >> 6, C = u64 & 63, b = bh >> 3, h = bh & 7;
            f32x4 z[4][4];
#pragma unroll
            for (int sl = 0; sl < 4; ++sl)
#pragma unroll
                for (int mt = 0; mt < 4; ++mt) { const u32x2 zw = *(const u32x2*)((const bf16*)(ws + WS_ZS) + ((size_t)((u64 * 4 + sl) * 4 + mt) * 64 + lane) * 4); z[sl][mt] = (f32x4){bflo(zw.x), bfhi(zw.x), bflo(zw.y), bfhi(zw.y)}; }
#pragma unroll 1
            for (int j = 0; j < 4; ++j) {
                const size_t un = (size_t)u64 * 4 + j; const size_t m0 = (size_t)b * SEQ + (C * 4 + j) * 16;
                const bf16* rp = (const bf16*)(ws + WS_RP) + un * 1024 + l15 * 64 + 8 * g;
                const bf16x8 rf0 = *(const bf16x8*)rp, rf1 = *(const bf16x8*)(rp + 32);
                f32x4 y[4];
#pragma unroll
                for (int sl = 0; sl < 4; ++sl) y[sl] = *(const f32x4*)((const float*)(ws + WS_Y1F) + ((size_t)(un * 4 + sl) * 64 + lane) * 4);
                const size_t rg = (m0 + ct) * 512 + h * 64 + 8 * cc;
                const u32x4 gl0 = *(const u32x4*)((const bf16*)(ws + WS_G) + rg), gl1 = *(const u32x4*)((const bf16*)(ws + WS_G) + rg + 8 * 512);
                const u32x4 ad0 = *(const u32x4*)((const bf16*)(ws + WS_ADD) + rg), ad1 = *(const u32x4*)((const bf16*)(ws + WS_ADD) + rg + 8 * 512);
                bf16x8 gf[4][2]; u32x2 hfr[4][4];
                if (j < 3) {
                    const bf16* gp = (const bf16*)(ws + WS_GP) + un * 4096 + l15 * 64 + 8 * g;
#pragma unroll
                    for (int mt = 0; mt < 4; ++mt) { gf[mt][0] = *(const bf16x8*)(gp + mt * 1024); gf[mt][1] = *(const bf16x8*)(gp + mt * 1024 + 32); }
#pragma unroll
                    for (int sl = 0; sl < 4; ++sl)
#pragma unroll
                        for (int mt = 0; mt < 4; ++mt) hfr[sl][mt] = *(const u32x2*)((const bf16*)(ws + WS_HF) + ((size_t)((un * 4 + sl) * 4 + mt) * 64 + lane) * 4);
                }
                *(LAS u32x4*)(tGL + ct * 64 + 8 * cc) = gl0; *(LAS u32x4*)(tGL + (ct + 8) * 64 + 8 * cc) = gl1;
                *(LAS u32x4*)(tAD + ct * 64 + 8 * cc) = ad0; *(LAS u32x4*)(tAD + (ct + 8) * 64 + 8 * cc) = ad1;
                bf16x8 zb[4][2];
#pragma unroll
                for (int sl = 0; sl < 4; ++sl) { RW_ZB(z[sl], zb[sl]);
                    y[sl] = __builtin_amdgcn_mfma_f32_16x16x32_bf16(rf0, zb[sl][0], y[sl], 0, 0, 0); y[sl] = __builtin_amdgcn_mfma_f32_16x16x32_bf16(rf1, zb[sl][1], y[sl], 0, 0, 0); }
#pragma unroll
                for (int e = 0; e < 4; ++e) {
                    float s1 = (y[0][e] + y[1][e]) + (y[2][e] + y[3][e]);
                    s1 += __shfl_xor(s1, 1); s1 += __shfl_xor(s1, 2); s1 += __shfl_xor(s1, 4); s1 += __shfl_xor(s1, 8);
                    const float mean = s1 * (1.0f / 64.0f);
                    float d0 = y[0][e] - mean, d1 = y[1][e] - mean, d2 = y[2][e] - mean, d3 = y[3][e] - mean;
                    float s2 = (d0 * d0 + d1 * d1) + (d2 * d2 + d3 * d3);
                    s2 += __shfl_xor(s2, 1); s2 += __shfl_xor(s2, 2); s2 += __shfl_xor(s2, 4); s2 += __shfl_xor(s2, 8);
                    const float rstd = rsq_f(s2 * (1.0f / 64.0f) + GN_EPS);
                    const float dd[4] = {d0, d1, d2, d3};
#pragma unroll
                    for (int sl = 0; sl < 4; ++sl) { const int ti_ = (4 * g + e) * 64 + 16 * sl + l15;
                        const float o = dd[sl] * rstd * bf2f(tGL[ti_]) + bf2f(tAD[ti_]); tOUT[ti_] = (bf16)f2bf(o); }
                }
                { bf16* cp = CAT + (m0 + ct) * 1024 + 512 + h * 64 + 8 * cc;
                  *(u32x4*)cp = *(const LAS u32x4*)(tOUT + ct * 64 + 8 * cc); *(u32x4*)(cp + 8 * 1024) = *(const LAS u32x4*)(tOUT + (ct + 8) * 64 + 8 * cc); }
                if (j < 3) {
#pragma unroll
                    for (int sl = 0; sl < 4; ++sl)
#pragma unroll
                        for (int mt = 0; mt < 4; ++mt) { const u32x2 hh = hfr[sl][mt];
                            f32x4 a; a[0] = bflo(hh.x); a[1] = bfhi(hh.x); a[2] = bflo(hh.y); a[3] = bfhi(hh.y);
                            a = __builtin_amdgcn_mfma_f32_16x16x32_bf16(gf[mt][0], zb[sl][0], a, 0, 0, 0); a = __builtin_amdgcn_mfma_f32_16x16x32_bf16(gf[mt][1], zb[sl][1], a, 0, 0, 0); z[sl][mt] = a; }
                }
            }
        }
    }
    SEAM(5);
#undef RW_ZB


    if (IN(6)) { PHASE_IDS;
        pg8::DenseSched S; S.o.init_tiles(M / 256, D / 256, G, bid); S.A = (const char*)CAT; S.B = (const char*)Wout_t; S.tstep = (size_t)256 * D * 2;
        EpiBf16Res<false> E{args.in[I_X], X1, D, (float*)(ws + WS_AP + 2 * MiB), 1.0f, X1F8}; pg8::gemm_phase(lds, D, S, E, wv0);
    }
    SEAM(6);
    if (IN(7)) { PHASE_IDS;
        pg8::BatchBSched S; S.o.init_tiles(M / 256, D / 256, G, bid); S.A = (const char*)X1F8; S.B = (const char*)HN; S.tstep = (size_t)256 * 1024; S.bstep = (size_t)1024 * 1024;
        EpiSoftmax E{(unsigned char*)Qb, 0.0625f * 0.25f, (const float*)(ws + WS_AP + 2 * MiB), (LAS float*)(lds + RING_BYTES + 1024), (LAS float*)(lds + RING_BYTES + 1024 + 4096)};
        pg8::gemm_phase<EpiSoftmax, pg8::BatchBSched, true, true>(lds, 512, S, E, wv0);
    }
    SEAM(7);
    if (IN(8)) { PHASE_IDS;
        pg8::BatchBSched S; S.o.init_tiles(M / 256, D / 256, G, bid); S.A = (const char*)Qb; S.B = (const char*)(HN + (size_t)4 * 1024 * 1024); S.tstep = (size_t)256 * 1024; S.bstep = (size_t)1024 * 1024;
        EpiBf16Res<true> E{X1, X2, D, nullptr, 1.0f / 1024.0f, nullptr}; pg8::gemm_phase<EpiBf16Res<true>, pg8::BatchBSched, true, true>(lds, 512, S, E, wv0);
    }
    SEAM(8);
    if (IN(9)) { PHASE_IDS;
        for (int cid = tid; cid < 2 * NE * 128; cid += NTHREADS) { const int t = cid >> 12, row = (cid >> 7) & 31, c = cid & 127;
            *(LAS u32x4*)(lds + t * 65536 + row * 2048 + ((c ^ (row & 7)) << 4)) = *(const u32x4*)(WrT + (size_t)t * NE * D + row * D + 8 * c); }
        __syncthreads();
        const int l15 = lane & 15, g = lane >> 4;
        LAS float* LG = (LAS float*)(lds + RING_BYTES + 1024 + wave * 2304);
        const float* gfn = args.in[I_NFFG];
        LAS unsigned* cntl = (LAS unsigned*)(lds + RING_BYTES + 640);
        for (int t0 = 0; t0 < M / 16; t0 += G * 4) {
        if (tid < 64) cntl[tid] = 0u;
        __syncthreads();
        if (t0 == 0 && wave >= 4) {
            constexpr int I_DN = 16 * 32, I_GU = 16 * 64;
            for (int r = bid * 4 + (wave - 4); r < CONV_P9; r += G * 4) { const int e = r / I_GU, q = r % I_GU, kb = q / 64, nb = q % 64; const int n0 = 32 * nb;
                const int drow = n0 < 1024 ? (256 * (n0 >> 7) + (n0 & 127)) : (256 * ((n0 - 1024) >> 7) + 128 + ((n0 - 1024) & 127));
                transpose_item_tiled_fp8_nolds(args.in[I_WGU] + (size_t)e * D * 2048, 2048, D, (unsigned char*)Wgu_t + (size_t)e * 2048 * D, 64 * kb, n0, drow, lane); }
            for (int r = bid * 4 + (wave - 4); r < CONV_P9D; r += G * 4) { const int e = r / I_DN, q = r % I_DN, kb = q / 32, nb = q % 32;
                transpose_item_tiled_fp8_nolds(args.in[I_WDN] + (size_t)e * DFF * D, D, DFF, (unsigned char*)Wdn_t + (size_t)e * D * DFF, 64 * kb, 32 * nb, 32 * nb, lane); }
        }
        const int tile = t0 + bid * 4 + wave; const bool active = wave < 4 && tile < M / 16;
        int me = 0, lpos = 0, ai = 0; float mg = 0.f;
        if (active) {
            const int m0 = tile * 16;
            const bf16* xrow = X2 + (size_t)(m0 + l15) * D + 8 * g;
            float ss = 0.f;
#pragma unroll 8
            for (int ks = 0; ks < 32; ++ks) { const u32x4 xw = *(const u32x4*)(xrow + 32 * ks);
#pragma unroll
                for (int q = 0; q < 4; ++q) { const float a = bflo(xw[q]), c = bfhi(xw[q]); ss += a * a + c * c; } }
            ss += __shfl_xor(ss, 16); ss += __shfl_xor(ss, 32);
            const float rstd = rsq_f(ss * (1.f / D) + EPS);
            f32x4 acc0 = (f32x4){0.f, 0.f, 0.f, 0.f}, acc1 = acc0;
            unsigned char* hrow = (unsigned char*)HN + (size_t)(m0 + l15) * D + 8 * g;
#pragma unroll 2
            for (int ks = 0; ks < 32; ++ks) {
                const f32x4 g0 = *(const f32x4*)(gfn + 32 * ks + 8 * g), g1 = *(const f32x4*)(gfn + 32 * ks + 8 * g + 4);
                const u32x4 xw = *(const u32x4*)(xrow + 32 * ks);
                float hf[8];
#pragma unroll
                for (int q = 0; q < 4; ++q) { hf[2 * q] = bflo(xw[q]) * rstd * (q < 2 ? g0[2 * q] : g1[2 * q - 4]); hf[2 * q + 1] = bfhi(xw[q]) * rstd * (q < 2 ? g0[2 * q + 1] : g1[2 * q - 3]); }
                u32x4 hi, lo;
#pragma unroll
                for (int q = 0; q < 4; ++q) { hi[q] = pk2(hf[2 * q], hf[2 * q + 1]); lo[q] = pk2(hf[2 * q] - bflo(hi[q]), hf[2 * q + 1] - bfhi(hi[q])); }
                { u32x2 h8; h8.x = pk4_fp8(hf[0], hf[1], hf[2], hf[3]); h8.y = pk4_fp8(hf[4], hf[5], hf[6], hf[7]); *(u32x2*)(hrow + 32 * ks) = h8; }
                const bf16x8 ah = __builtin_bit_cast(bf16x8, hi), al = __builtin_bit_cast(bf16x8, lo);
                const int c = 4 * ks + g;
#pragma unroll
                for (int nt = 0; nt < 2; ++nt) { const int row = 16 * nt + l15; const int off = row * 2048 + ((c ^ (row & 7)) << 4);
                    const bf16x8 bh = *(const LAS bf16x8*)(lds + off), bl = *(const LAS bf16x8*)(lds + 65536 + off);
                    f32x4 a = nt ? acc1 : acc0;
                    a = __builtin_amdgcn_mfma_f32_16x16x32_bf16(ah, bh, a, 0, 0, 0); a = __builtin_amdgcn_mfma_f32_16x16x32_bf16(ah, bl, a, 0, 0, 0); a = __builtin_amdgcn_mfma_f32_16x16x32_bf16(al, bh, a, 0, 0, 0);
                    if (nt) acc1 = a; else acc0 = a; }
            }
            { const float b0 = args.in[I_BR][l15], b1 = args.in[I_BR][16 + l15];
#pragma unroll
              for (int j = 0; j < 4; ++j) { LG[(4 * g + j) * 33 + l15] = acc0[j] + b0; LG[(4 * g + j) * 33 + 16 + l15] = acc1[j] + b1; } }
            const int rrow = lane >> 2, qq = lane & 3;
            float tv[4] = {-3.0e38f, -3.0e38f, -3.0e38f, -3.0e38f}; int ti[4] = {64, 65, 66, 67};
#define TOP_INS(xv_, xi_) do { float x_ = (xv_); int i_ = (xi_); _Pragma("unroll") for (int p_ = 0; p_ < 4; ++p_) { const bool b_ = x_ > tv[p_] || (x_ == tv[p_] && i_ < ti[p_]); \
                const float ov_ = tv[p_]; const int oi_ = ti[p_]; tv[p_] = b_ ? x_ : ov_; ti[p_] = b_ ? i_ : oi_; x_ = b_ ? ov_ : x_; i_ = b_ ? oi_ : i_; } } while (0)
#pragma unroll
            for (int j = 0; j < 8; ++j) TOP_INS(LG[rrow * 33 + 8 * qq + j], 8 * qq + j);
#pragma unroll
            for (int st = 1; st < 4; st <<= 1) { float pv[4]; int pi[4];
#pragma unroll
                for (int p = 0; p < 4; ++p) { pv[p] = __shfl_xor(tv[p], st); pi[p] = __shfl_xor(ti[p], st); }
#pragma unroll
                for (int p = 0; p < 4; ++p) TOP_INS(pv[p], pi[p]); }
#undef TOP_INS
            const float e1 = __expf(tv[1] - tv[0]), e2 = __expf(tv[2] - tv[0]), e3 = __expf(tv[3] - tv[0]);
            const float inv = rcp_f(1.0f + e1 + e2 + e3);
            me = qq == 0 ? ti[0] : qq == 1 ? ti[1] : qq == 2 ? ti[2] : ti[3];
            mg = (qq == 0 ? 1.0f : qq == 1 ? e1 : qq == 2 ? e2 : e3) * inv;
            lpos = (int)__hip_atomic_fetch_add(cntl + me, 1u, __ATOMIC_RELAXED, __HIP_MEMORY_SCOPE_WORKGROUP);
            ai = (m0 + rrow) * 4 + qq;
        }
        __syncthreads();
        if (tid < NE) { const unsigned c = cntl[tid]; cntl[32 + tid] = c ? atomicAdd(ecnt + 64 * tid, c) : 0u; }
        __syncthreads();
        if (active) { route_e[ai] = me; route_pos[ai] = (int)cntl[32 + me] + lpos; route_g[ai] = mg; }
        __syncthreads();
        }
    }
    SEAM(9);
    if (IN(10)) { PHASE_IDS;
        LAS int* pst = (LAS int*)lds;
        if (tid == 0) { int acc = 0; for (int e = 0; e < NE; ++e) { const int c = (int)__hip_atomic_load(ecnt + 64 * e, __ATOMIC_RELAXED, __HIP_MEMORY_SCOPE_AGENT); pst[e] = acc; pst[64 + e] = c; acc += (c + 255) & ~255; } pst[32] = acc; }
        __syncthreads();
        for (int ai = bid * NTHREADS + tid; ai < NASSIGN; ai += G * NTHREADS) {
            const int e = route_e[ai]; const int row = pst[e] + route_pos[ai]; { u32x2 sg_; sg_.x = (unsigned)ai; sg_.y = __float_as_uint(route_g[ai]); row_sg[row] = sg_; } row_tok[row] = ai >> 2; }
        if (bid < NE) { const int e = bid, c = pst[64 + e], pe = (c + 255) & ~255; for (int p = c + tid; p < pe; p += NTHREADS) { u32x2 sg_; sg_.x = 0xffffffffu; sg_.y = 0u; row_sg[pst[e] + p] = sg_; row_tok[pst[e] + p] = 0; } }
        if (bid == 0 && tid == 0) { int nt = 0; for (int e = 0; e < NE; ++e) { const int n = ((pst[64 + e] + 255) & ~255) >> 8; for (int j = 0; j < n; ++j) tile_tab[16 + nt++] = e; } tile_tab[0] = nt; }
        if (bid == 1 || bid == 2) { const int nt = pst[32] >> 8, nN = bid == 1 ? 8 : 4; int* tab = (int*)(ws + WS_ROUTE + (bid == 1 ? RT_UGU : RT_UDN));
            for (int L = tid; L < nt * nN; L += NTHREADS) { Unit uu; { const int nwg = nt * nN; int wgid = L; { const int q = nwg / 8, r = nwg % 8, xcd = wgid % 8, off = wgid / 8; wgid = (xcd < r ? xcd * (q + 1) : r * (q + 1) + (xcd - r) * q) + off; }
                    const int nig = 8 * nN, gid = wgid / nig, fm = gid * 8, gsz = (nt - fm) < 8 ? (nt - fm) : 8; uu.pm = fm + ((wgid % nig) % gsz); uu.pn = (wgid % nig) / gsz; uu.e = 0; }
                int e = 0; while (e < NE - 1 && (pst[e + 1] >> 8) <= uu.pm) ++e;
                tab[L] = uu.pm | (uu.pn << 12) | (e << 16); } }
        __syncthreads();
    }
    SEAM(10);
    if (IN(11)) {
        const int ntiles = tile_tab[0];
        pg8::MoeGatherSched S; S.o.init_tiles(ntiles, 2048 / 256, G, bid); S.A = (const char*)HN; S.B = (const char*)Wgu_t; S.tile_e = tile_tab + 16; S.utab = (const int*)(ws + WS_ROUTE + RT_UGU); S.rtok = row_tok; S.tstep = (size_t)256 * 1024; S.estep = (size_t)2048 * 1024;
        EpiSwiglu E{ACT, args.in[I_BGU]}; pg8::gemm_phase<EpiSwiglu, pg8::MoeGatherSched, true, true>(lds, 512, S, E, wv0);
        { PHASE_IDS; LAS float* scr = (LAS float*)(lds + wave * 16384); constexpr int I_DN = 16 * 32;
          for (;;) { int c0 = 0; if (lane == 0) c0 = (int)atomicAdd(ctl + CW_CONV, 8u); c0 = __builtin_amdgcn_readfirstlane(c0);
              c0 += CONV_P9D; if (c0 >= NE * I_DN) break;
              for (int r = c0; r < c0 + 8; ++r) { const int e = r / I_DN, q = r % I_DN, kb = q / 32, nb = q % 32;
                  transpose_item_tiled_fp8(args.in[I_WDN] + (size_t)e * DFF * D, D, DFF, (unsigned char*)Wdn_t + (size_t)e * D * DFF, 64 * kb, 32 * nb, 32 * nb, scr, lane); } } }
    }
    SEAM(11);
    if (IN(12)) {
        const int ntiles = tile_tab[0];
        pg8::MoeSched S; S.o.init_tiles(ntiles, D / 256, G, bid); S.A = (const char*)ACT; S.B = (const char*)Wdn_t; S.tile_e = tile_tab + 16; S.utab = (const int*)(ws + WS_ROUTE + RT_UDN); S.tstep = (size_t)256 * 1024; S.estep = (size_t)1024 * 1024;
        EpiDown E{YS, args.in[I_BDN], row_sg}; pg8::gemm_phase<EpiDown, pg8::MoeSched, true, true>(lds, 512, S, E, wv0);
    }
    SEAM(12);
    if (IN(13)) { PHASE_IDS;
        const float* gfin = args.in[I_FNG];
        for (int m = gw; m < M; m += NGW) {
            float v[16]; float s = 0.f;
#pragma unroll
            for (int hf = 0; hf < 2; ++hf) { const u32x4 w = *(const u32x4*)(X2 + (size_t)m * D + 512 * hf + 8 * lane);
#pragma unroll
                for (int q = 0; q < 4; ++q) { v[8 * hf + 2 * q] = bflo(w[q]); v[8 * hf + 2 * q + 1] = bfhi(w[q]); }
#pragma unroll
                for (int k = 0; k < 4; ++k) { const u32x4 y = *(const u32x4*)(YS + (size_t)(m * 4 + k) * D + 512 * hf + 8 * lane);
#pragma unroll
                    for (int q = 0; q < 4; ++q) { v[8 * hf + 2 * q] += bflo(y[q]); v[8 * hf + 2 * q + 1] += bfhi(y[q]); } } }
#pragma unroll
            for (int j = 0; j < 16; ++j) s += v[j] * v[j];
            const float rstd = rsq_f(wave_sum(s) * (1.f / D) + EPS);
#pragma unroll
            for (int hf = 0; hf < 2; ++hf) { const f32x4 g0 = *(const f32x4*)(gfin + 512 * hf + 8 * lane), g1 = *(const f32x4*)(gfin + 512 * hf + 8 * lane + 4);
                float* o = args.out + (size_t)m * D + 512 * hf + 8 * lane;
                *(f32x4*)o = (f32x4){v[8 * hf] * rstd * g0.x, v[8 * hf + 1] * rstd * g0.y, v[8 * hf + 2] * rstd * g0.z, v[8 * hf + 3] * rstd * g0.w};
                *(f32x4*)(o + 4) = (f32x4){v[8 * hf + 4] * rstd * g1.x, v[8 * hf + 5] * rstd * g1.y, v[8 * hf + 6] * rstd * g1.z, v[8 * hf + 7] * rstd * g1.w}; }
        }
    }
#undef IN
#undef SEAM
}

constexpr int N_PHASES = 14;
extern "C" void kernel_launch(void* const* d_in, const int* in_sizes, int n_in, void* d_out, int out_size, void* d_ws, size_t ws_size, hipStream_t stream) {
    static int grid = 0;
    if (grid == 0) {
        if (n_in != 37 || out_size != M * D || ws_size < WS_END) { fprintf(stderr, "kernel_launch: unexpected shapes (n_in %d, out %d, ws %zu); nothing launched\n", n_in, out_size, ws_size); grid = -1; return; }
        int dev = 0, cus = 0, per_cu = 0;
        if (hipGetDevice(&dev) != hipSuccess || hipDeviceGetAttribute(&cus, hipDeviceAttributeMultiprocessorCount, dev) != hipSuccess) { grid = -1; return; }
        if (hipFuncSetAttribute((const void*)fwd, hipFuncAttributeMaxDynamicSharedMemorySize, LDS_BYTES) != hipSuccess) { fprintf(stderr, "kernel_launch: hipFuncSetAttribute failed\n"); grid = -1; return; }
        if (hipOccupancyMaxActiveBlocksPerMultiprocessor(&per_cu, (const void*)fwd, NTHREADS, LDS_BYTES) != hipSuccess || per_cu < 1) fprintf(stderr, "kernel_launch: occupancy query says %d\n", per_cu);
        (void)hipGetLastError();
        grid = cus > 256 ? 256 : cus;
    }
    if (grid < 0) return;
    if (hipMemsetAsync((char*)d_ws + WS_CTL, 0, CTL_ZERO_BYTES, stream) != hipSuccess) return;
    Args a{};
    for (int i = 0; i < 37; ++i) a.in[i] = (const float*)d_in[i];
    a.out = (float*)d_out; a.ws = (unsigned char*)d_ws;
#if MK_ONE_LAUNCH
    a.ph_lo = 0; a.ph_hi = N_PHASES;
    hipLaunchKernelGGL(fwd, dim3(grid), dim3(NTHREADS), LDS_BYTES, stream, a);
#else
    for (int p = 0; p < N_PHASES; ++p) { a.ph_lo = p; a.ph_hi = p + 1; hipLaunchKernelGGL(fwd, dim3(grid), dim3(NTHREADS), LDS_BYTES, stream, a);
#ifdef PROBE_REPEAT_PHASE
        if (p == PROBE_REPEAT_PHASE) hipLaunchKernelGGL(fwd, dim3(grid), dim3(NTHREADS), LDS_BYTES, stream, a);
#endif
    }
#endif
}
```

```cpp
#include <hip/hip_runtime.h>
#include <cstdio>
#include <cstdint>

#ifndef MK_ONE_LAUNCH
#define MK_ONE_LAUNCH 1
#endif

#define DI __device__ __forceinline__
#define GAS __attribute__((address_space(1)))
#define LAS __attribute__((address_space(3)))
typedef unsigned short bf16;
typedef short bf16x8 __attribute__((ext_vector_type(8)));
typedef int v4i __attribute__((ext_vector_type(4)));
typedef int v8i __attribute__((ext_vector_type(8)));
typedef float f32x4 __attribute__((ext_vector_type(4)));
typedef float f32x2 __attribute__((ext_vector_type(2)));
typedef unsigned u32x4 __attribute__((ext_vector_type(4)));
typedef unsigned u32x2 __attribute__((ext_vector_type(2)));

constexpr int D = 1024, NB = 4, SEQ = 4096, M = NB * SEQ;
constexpr int MEML = 256, MROWS = NB * MEML;
constexpr int LRU_W = 512, RW = 512, NH = 8, HD = 64;
constexpr int INW = 2816;
constexpr int XH = 4, XHD = 256;
constexpr int NE = 32, TOPK = 4, DFF = 1024;
constexpr int NASSIGN = M * TOPK;
constexpr int MAXTILES = 288, MAXROWS = MAXTILES * 256;
constexpr float EPS = 1e-6f, GN_EPS = 64e-5f;

DI int fresh_tid_(int wv) { int w = wv; asm volatile("" : "+s"(w)); int l; asm volatile("v_mbcnt_lo_u32_b32 %0, -1, 0\n\tv_mbcnt_hi_u32_b32 %0, -1, %0" : "=v"(l)); return (w << 6) | (l & 63); }
#define fresh_tid() fresh_tid_(wv0)
namespace pg8 {
constexpr int BM = 256, BK = 64, HALF = 128, HTB = HALF * BK * 2, STAGE_BYTES = 8 * HTB, NXCD = 8, WGM = 8;
__host__ __device__ __forceinline__ int lds_byte(int r, int c) { const int st = (r >> 4) * 2 + (c >> 5), rr = r & 15, cc = c & 31, ob = rr * 64 + cc * 2; return st * 1024 + (ob ^ (((ob >> 9) & 1) << 5)); }
__host__ __device__ __forceinline__ void stage_rc(int b, int& R, int& C) { const int st = b / 1024, sb = b % 1024, swz = sb ^ (((sb >> 9) & 1) << 5); R = (st >> 1) * 16 + swz / 64; C = (st & 1) * 32 + (swz % 64) / 2; }
__host__ __device__ __forceinline__ int perm32(int rho) { const int n = rho >> 4, i = rho & 15; return 8 * (i >> 2) + 4 * n + (i & 3); }

struct Unit { int pm, pn, e; };

struct StaticOrder {
    int nM, nN, nwg, G, c;
    __host__ __device__ void init_tiles(int nM_, int nN_, int G_, int c_) { nM = nM_; nN = nN_; nwg = nM * nN; G = G_; c = c_; }
    __host__ __device__ bool next(int i, Unit& u) const {
        const long L = (long)i * G + c; if (L >= nwg) return false;
        int wgid = (int)L; { const int q = nwg / NXCD, r = nwg % NXCD, xcd = wgid % NXCD, off = wgid / NXCD; wgid = (xcd < r ? xcd * (q + 1) : r * (q + 1) + (xcd - r) * q) + off; }
        const int nig = WGM * nN, gid = wgid / nig, fm = gid * WGM, gsz = (nM - fm) < WGM ? (nM - fm) : WGM;
        u.pm = fm + ((wgid % nig) % gsz); u.pn = (wgid % nig) / gsz; u.e = 0; return true;
    }
};
struct DenseSched {
    static constexpr bool GATHER = false, B_TILED = false;
    StaticOrder o; const char* A; const char* B; size_t tstep;
    DI bool next(int i, Unit& u) const { return o.next(i, u); }
    DI const char* a_ptr(const Unit& u) const { return A + (size_t)u.pm * tstep; }
    DI const char* b_ptr(const Unit& u) const { return B + (size_t)u.pn * tstep; }
    DI void a_voff(const Unit&, int K, const int (&R)[2], const int (&C)[2], unsigned (&vo)[2][2]) const {
#pragma unroll
        for (int h = 0; h < 2; ++h)
#pragma unroll
            for (int i = 0; i < 2; ++i) vo[h][i] = (unsigned)((h * HALF + R[i]) * K + C[i]) * 2u; }
};
struct MoeSched {
    static constexpr bool GATHER = false, B_TILED = true;
    StaticOrder o; const char* A; const char* B; const int* tile_e; const int* utab; size_t tstep, estep;
    DI bool next(int i, Unit& u) const { const int L = i * o.G + o.c; if (L >= o.nwg) return false; int en; asm volatile("s_load_dword %0, %1, 0x0\n\ts_waitcnt lgkmcnt(0)" : "=s"(en) : "s"(utab + L) : "memory");     u.pm = en & 0xfff; u.pn = (en >> 12) & 15; u.e = en >> 16; return true; }
    DI const char* a_ptr(const Unit& u) const { return A + (size_t)u.pm * tstep; }
    DI const char* b_ptr(const Unit& u) const { return B + (size_t)u.e * estep + (size_t)u.pn * tstep; }
    DI void a_voff(const Unit&, int K, const int (&R)[2], const int (&C)[2], unsigned (&vo)[2][2]) const {
#pragma unroll
        for (int h = 0; h < 2; ++h)
#pragma unroll
            for (int i = 0; i < 2; ++i) vo[h][i] = (unsigned)((h * HALF + R[i]) * K + C[i]) * 2u; }
};
struct MoeGatherSched {
    static constexpr bool GATHER = true, B_TILED = true;
    StaticOrder o; const char* A; const char* B; const int* tile_e; const int* utab; const int* rtok; size_t tstep, estep;
    DI bool next(int i, Unit& u) const { const int L = i * o.G + o.c; if (L >= o.nwg) return false; int en; asm volatile("s_load_dword %0, %1, 0x0\n\ts_waitcnt lgkmcnt(0)" : "=s"(en) : "s"(utab + L) : "memory");     u.pm = en & 0xfff; u.pn = (en >> 12) & 15; u.e = en >> 16; return true; }
    DI const char* a_ptr(const Unit&) const { return A; }
    DI const char* b_ptr(const Unit& u) const { return B + (size_t)u.e * estep + (size_t)u.pn * tstep; }
    DI void a_voff(const Unit& u, int K, const int (&R)[2], const int (&C)[2], unsigned (&vo)[2][2]) const {
#pragma unroll
        for (int h = 0; h < 2; ++h)
#pragma unroll
            for (int i = 0; i < 2; ++i) vo[h][i] = (unsigned)(rtok[u.pm * BM + h * HALF + R[i]] * K + C[i]) * 2u; }
};

struct BatchBSched {
    static constexpr bool GATHER = false, B_TILED = false;
    StaticOrder o; const char* A; const char* B; size_t tstep, bstep;
    DI bool next(int i, Unit& u) const { return o.next(i, u); }
    DI const char* a_ptr(const Unit& u) const { return A + (size_t)u.pm * tstep; }
    DI const char* b_ptr(const Unit& u) const { return B + (size_t)(u.pm >> 4) * bstep + (size_t)u.pn * tstep; }
    DI void a_voff(const Unit&, int K, const int (&R)[2], const int (&C)[2], unsigned (&vo)[2][2]) const {
#pragma unroll
        for (int h = 0; h < 2; ++h)
#pragma unroll
            for (int i = 0; i < 2; ++i) vo[h][i] = (unsigned)((h * HALF + R[i]) * K + C[i]) * 2u; }
};
template <int MODE> struct FoldSched {
    static constexpr bool GATHER = false, B_TILED = false;
    const char* A; const char* B; int G, c;
    DI bool next(int i, Unit& u) const { const int L = i * G + c; if (L >= 64) return false; u.pm = L >> 2; u.pn = L & 3; u.e = 0; return true; }
    DI const char* a_ptr(const Unit& u) const { const int b = u.pm >> 2, h = u.pm & 3; return A + ((size_t)(MODE == 0 ? b * 256 : u.pn * 256) * 1024 + h * 256) * 2; }
    DI const char* b_ptr(const Unit& u) const { const int b = u.pm >> 2, h = u.pm & 3; return B + ((size_t)(MODE == 0 ? u.pn * 256 : b * 256) * 1024 + h * 256) * 2; }
    DI void a_voff(const Unit&, int K, const int (&R)[2], const int (&C)[2], unsigned (&vo)[2][2]) const {
#pragma unroll
        for (int h = 0; h < 2; ++h)
#pragma unroll
            for (int i = 0; i < 2; ++i) vo[h][i] = (unsigned)((h * HALF + R[i]) * K + C[i]) * 2u; }
};

DI unsigned cvt_pk_bf16(float lo, float hi) { unsigned r; asm volatile("v_cvt_pk_bf16_f32 %0, %1, %2" : "=v"(r) : "v"(lo), "v"(hi)); return r; }

template <class Epi, class Sched, bool ALIGN_EPI = true, bool FP8 = false>
DI void gemm_phase(LAS unsigned char* lds, const int K, const Sched& S, const Epi& E, const int wv0, const int ldp = 0) {
    const int ld = ldp ? ldp : K;
    const int tid = fresh_tid(), wid = __builtin_amdgcn_readfirstlane(tid >> 6), lane = tid & 63, wr = wid >> 2, wc = wid & 3, fr = lane & 15, fq = lane >> 4;
    const int nt = K / BK;
    constexpr bool GA = Sched::GATHER, BT = Sched::B_TILED;
    unsigned voffA[2][2], voffAn[2][2], voffB[2];
#pragma unroll
    for (int i = 0; i < 2; ++i) { int R, C; stage_rc(tid * 16 + i * 8192, R, C); const int Rb = Epi::PERM ? ((R & ~31) + perm32(R & 31)) : R;
        voffB[i] = BT ? (unsigned)(tid * 16 + i * 8192) : (unsigned)(Rb * ld + C) * 2u; }
#define PG8_AVOFF(unit, dst) do { int sR[2], sC[2]; const int t2_ = fresh_tid(); stage_rc(t2_ * 16, sR[0], sC[0]); stage_rc(t2_ * 16 + 8192, sR[1], sC[1]); S.a_voff(unit, ld, sR, sC, dst); } while (0)
    const size_t kstep = (size_t)(BK * 2);
    const size_t hstep = (size_t)HALF * ld * 2;
    const size_t kstepB = BT ? (size_t)(2 * HTB) : kstep, hstepB = BT ? (size_t)HTB : hstep;
    const unsigned ldsw = (unsigned)wid * 1024u;
    unsigned aoffv = (unsigned)(size_t)lds + (unsigned)lds_byte(wr * 64 + fr, fq * 8), boffv = (unsigned)(size_t)lds + (unsigned)(4 * HTB) + (unsigned)lds_byte(wc * 32 + fr, fq * 8);
    asm volatile("" : "+v"(aoffv), "+v"(boffv));
    const size_t dB = BT ? (size_t)8192 : (size_t)64 * ld * 2, dA = (size_t)64 * ld * 2;
#define PG8_SA(b, h) (((b) * 2 + (h)) * HTB)
#define PG8_SB(b, h) ((4 + (b) * 2 + (h)) * HTB)
    const unsigned ldsbase = (unsigned)__builtin_amdgcn_readfirstlane((int)((unsigned)(size_t)lds + ldsw));
#define PG8_STAGE1(bufoff, gptr, vo, i_) do { const unsigned m0v_ = ldsbase + (unsigned)(bufoff) + (unsigned)(i_) * 8192u; \
        asm volatile("s_mov_b32 m0, %2\n\ts_nop 0\n\tglobal_load_lds_dwordx4 %0, %1" :: "v"(vo), "s"((const char*)(gptr)), "s"(m0v_) : "memory", "m0"); } while (0)
#define PG8_STAGE(bufoff, gbase, voff) do { PG8_STAGE1(bufoff, gbase, (voff)[0], 0); PG8_STAGE1(bufoff, gbase, (voff)[1], 1); } while (0)
#define PG8_STAGE_D(bufoff, gbase, vo, delta) do { PG8_STAGE1(bufoff, gbase, vo, 0); PG8_STAGE1(bufoff, (const char*)(gbase) + (delta), vo, 1); } while (0)
#define PG8_LDA(dst, b, h) do { if constexpr (FP8) { _Pragma("unroll") for (int m = 0; m < 4; ++m) { const LAS v4i* p_ = (const LAS v4i*)((LAS unsigned char*)(size_t)aoffv + PG8_SA(b, h) + m * 2048); dst##8[m] = __builtin_shufflevector(p_[0], p_[64], 0, 1, 2, 3, 4, 5, 6, 7); } } \
        else { _Pragma("unroll") for (int m = 0; m < 4; ++m) _Pragma("unroll") for (int k = 0; k < 2; ++k) dst[m][k] = *(const LAS bf16x8*)((LAS unsigned char*)(size_t)aoffv + PG8_SA(b, h) + m * 2048 + k * 1024); } } while (0)
#define PG8_LDB(dst, b, h) do { if constexpr (FP8) { _Pragma("unroll") for (int n = 0; n < 2; ++n) { const LAS v4i* p_ = (const LAS v4i*)((LAS unsigned char*)(size_t)boffv + (PG8_SB(b, h) - 4 * HTB) + n * 2048); dst##8[n] = __builtin_shufflevector(p_[0], p_[64], 0, 1, 2, 3, 4, 5, 6, 7); } } \
        else { _Pragma("unroll") for (int n = 0; n < 2; ++n) _Pragma("unroll") for (int k = 0; k < 2; ++k) dst[n][k] = *(const LAS bf16x8*)((LAS unsigned char*)(size_t)boffv + (PG8_SB(b, h) - 4 * HTB) + n * 2048 + k * 1024); } } while (0)
#define PG8_MMA(ai, bj, At, Bt) do { __builtin_amdgcn_s_setprio(1); \
        if constexpr (FP8) {   \
            _Pragma("unroll") for (int m = 0; m < 4; ++m) _Pragma("unroll") for (int n = 0; n < 2; ++n) \
                acc[ai][bj][m][n] = __builtin_amdgcn_mfma_scale_f32_16x16x128_f8f6f4(Bt##8[n], At##8[m], acc[ai][bj][m][n], 0, 0, 0, 0, 0, 0); } \
        else { _Pragma("unroll") for (int m = 0; m < 4; ++m) _Pragma("unroll") for (int n = 0; n < 2; ++n) _Pragma("unroll") for (int k = 0; k < 2; ++k) \
            acc[ai][bj][m][n] = __builtin_amdgcn_mfma_f32_16x16x32_bf16(Bt[n][k], At[m][k], acc[ai][bj][m][n], 0, 0, 0); } \
        __builtin_amdgcn_s_setprio(0); } while (0)
#define PG8_WAIT_V(n) asm volatile("s_waitcnt vmcnt(" #n ")" ::: "memory")
#define PG8_WAIT_L(n) asm volatile("s_waitcnt lgkmcnt(" #n ")" ::: "memory")
#define PG8_BAR __builtin_amdgcn_s_barrier()
#define PG8_SCHED __builtin_amdgcn_sched_barrier(0)
    Unit cur, nxt; int ui = 0;
    if (!S.next(0, cur)) return;
    f32x4 acc[2][2][4][2];
#pragma unroll
    for (int a = 0; a < 2; ++a)
#pragma unroll
        for (int b = 0; b < 2; ++b)
#pragma unroll
            for (int m = 0; m < 4; ++m)
#pragma unroll
                for (int n = 0; n < 2; ++n) acc[a][b][m][n] = (f32x4){0.f, 0.f, 0.f, 0.f};
    bf16x8 At[4][2], B0[2][2], B1[2][2]; v8i At8[4], B08[2], B18[2];
    const char* cA = S.a_ptr(cur); const char* cB = S.b_ptr(cur);
    PG8_AVOFF(cur, voffA);
#define PG8_STAGE_A(bufoff, kbase, h, vo) do { if constexpr (GA) { PG8_STAGE(bufoff, kbase, (vo)[h]); } else { PG8_STAGE_D(bufoff, (kbase) + (h) * hstep, voffA[0][0], dA); } } while (0)
    PG8_STAGE_D(PG8_SB(0, 0), cB, voffB[0], dB); PG8_STAGE_D(PG8_SB(0, 1), cB + hstepB, voffB[0], dB); PG8_STAGE_A(PG8_SA(0, 0), cA, 0, voffA); PG8_STAGE_A(PG8_SA(0, 1), cA, 1, voffA);
    if (wr == 1) PG8_BAR;
    PG8_WAIT_V(2); PG8_BAR;
    PG8_STAGE_D(PG8_SB(1, 0), cB + kstepB, voffB[0], dB); PG8_STAGE_A(PG8_SA(1, 0), cA + kstep, 0, voffA); PG8_STAGE_D(PG8_SB(1, 1), cB + hstepB + kstepB, voffB[0], dB);
    PG8_WAIT_V(6); PG8_BAR;
    for (;;) {
        const bool has_next = S.next(ui + 1, nxt);
        const char* nA = has_next ? S.a_ptr(nxt) : cA; const char* nB = has_next ? S.b_ptr(nxt) : cB;
        if constexpr (GA) { if (has_next) PG8_AVOFF(nxt, voffAn);
            else {
#pragma unroll
                for (int h = 0; h < 2; ++h)
#pragma unroll
                    for (int i = 0; i < 2; ++i) voffAn[h][i] = voffA[h][i]; } }
#pragma unroll 1
        for (int t = 0; t < nt; t += 2) {
            const bool last = (t == nt - 2);
            const char* a1 = cA + (size_t)(t + 1) * kstep;
            const char* a2 = last ? nA : cA + (size_t)(t + 2) * kstep; const char* b2 = last ? nB : cB + (size_t)(t + 2) * kstepB;
            const char* a3 = a2 + kstep; const char* b3 = b2 + kstepB;
            PG8_LDB(B0, 0, 0); PG8_LDB(B1, 0, 1); PG8_SCHED; PG8_LDA(At, 0, 0); PG8_STAGE_A(PG8_SA(1, 1), a1, 1, voffA);
            if constexpr (GA) { if (last) {
#pragma unroll
                for (int h = 0; h < 2; ++h)
#pragma unroll
                    for (int i = 0; i < 2; ++i) voffA[h][i] = voffAn[h][i]; } }
            PG8_WAIT_V(8); PG8_WAIT_L(0); PG8_BAR; PG8_MMA(0, 0, At, B0); PG8_MMA(0, 1, At, B1); PG8_BAR; PG8_SCHED;
            PG8_LDA(At, 0, 1); PG8_STAGE_D(PG8_SB(0, 0), b2, voffB[0], dB); PG8_STAGE_D(PG8_SB(0, 1), b2 + hstepB, voffB[0], dB); PG8_STAGE_A(PG8_SA(0, 0), a2, 0, voffA);
            PG8_WAIT_V(8); PG8_WAIT_L(0); PG8_BAR; PG8_MMA(1, 0, At, B0); PG8_MMA(1, 1, At, B1); PG8_BAR; PG8_SCHED;
            PG8_LDB(B0, 1, 0); PG8_LDB(B1, 1, 1); PG8_SCHED; PG8_LDA(At, 1, 0); PG8_STAGE_A(PG8_SA(0, 1), a2, 1, voffA);
            PG8_WAIT_V(8); PG8_WAIT_L(0); PG8_BAR; PG8_MMA(0, 0, At, B0); PG8_MMA(0, 1, At, B1); PG8_BAR; PG8_SCHED;
            PG8_LDA(At, 1, 1); PG8_STAGE_D(PG8_SB(1, 0), b3, voffB[0], dB); PG8_STAGE_D(PG8_SB(1, 1), b3 + hstepB, voffB[0], dB); PG8_STAGE_A(PG8_SA(1, 0), a3, 0, voffA);
            PG8_WAIT_V(8); PG8_WAIT_L(0); PG8_BAR; PG8_MMA(1, 0, At, B0); PG8_MMA(1, 1, At, B1); PG8_BAR; PG8_SCHED;
        }
        if constexpr (ALIGN_EPI) { if (wr == 0) PG8_BAR; }
        { Unit ue = cur; ue.pm = __builtin_amdgcn_readfirstlane(ue.pm); ue.pn = __builtin_amdgcn_readfirstlane(ue.pn); ue.e = __builtin_amdgcn_readfirstlane(ue.e); asm volatile("" : "+s"(ue.pm), "+s"(ue.pn), "+s"(ue.e));
          const int t3_ = fresh_tid(); const int fr_ = t3_ & 15, fq_ = (t3_ & 63) >> 4;
          E(acc, ue, wr, wc, fr_, fq_); }
        if (!has_next) break;
#pragma unroll
        for (int a = 0; a < 2; ++a)
#pragma unroll
            for (int b = 0; b < 2; ++b)
#pragma unroll
                for (int m = 0; m < 4; ++m)
#pragma unroll
                    for (int n = 0; n < 2; ++n) acc[a][b][m][n] = (f32x4){0.f, 0.f, 0.f, 0.f};
        cur = nxt; cA = nA; cB = nB; ++ui;
        if constexpr (ALIGN_EPI) { if (wr == 1) PG8_BAR; }
    }
    PG8_WAIT_V(0);
    if constexpr (!ALIGN_EPI) { if (wr == 0) PG8_BAR; }
    PG8_BAR;
#undef PG8_SA
#undef PG8_SB
#undef PG8_STAGE
#undef PG8_STAGE1
#undef PG8_STAGE_D
#undef PG8_STAGE_A
#undef PG8_AVOFF
#undef PG8_LDA
#undef PG8_LDB
#undef PG8_MMA
#undef PG8_WAIT_V
#undef PG8_WAIT_L
#undef PG8_BAR
#undef PG8_SCHED
}
}
using pg8::Unit;
using pg8::cvt_pk_bf16;

DI float bflo(unsigned w) { return __uint_as_float(w << 16); }
DI float bfhi(unsigned w) { return __uint_as_float(w & 0xffff0000u); }
DI float bf2f(bf16 b) { return __uint_as_float(((unsigned)b) << 16); }
typedef __bf16 hwbf2 __attribute__((ext_vector_type(2)));
DI unsigned pk2(float lo, float hi) { const f32x2 v = {lo, hi}; return __builtin_bit_cast(unsigned, __builtin_convertvector(v, hwbf2)); }
DI unsigned f2bf(float f) { return pk2(f, 0.f) & 0xffffu; }
DI float rcp_f(float x) { return __builtin_amdgcn_rcpf(x); }
DI float rsq_f(float x) { return __builtin_amdgcn_rsqf(x); }
DI float sigmoid_f(float x) { return rcp_f(1.0f + __expf(-x)); }
DI float tanh_fast(float x) { return 1.0f - 2.0f * rcp_f(__expf(2.0f * x) + 1.0f); }
DI float softplus_f(float x) { return fmaxf(x, 0.f) + __logf(1.0f + __expf(-fabsf(x))); }
DI float softplus_fast(float x) { return fmaxf(x, 0.f) + __logf(1.0f + __expf(-fabsf(x))); }
DI float gelu_tanh_f(float x) { const float u = 0.7978845608028654f * (x + 0.044715f * x * x * x); return 0.5f * x * (1.0f + tanh_fast(u)); }
DI float wave_sum(float v) {
#pragma unroll
    for (int o = 1; o < 64; o <<= 1) v += __shfl_xor(v, o);
    return v;
}

DI unsigned pk4_fp8(float a, float b, float c, float d) { int w = 0; w = __builtin_amdgcn_cvt_pk_fp8_f32(a, b, w, false); w = __builtin_amdgcn_cvt_pk_fp8_f32(c, d, w, true); return (unsigned)w; }
struct EpiBf16Plain {
    static constexpr bool PERM = true;
    bf16* O; int ldc; float scale;
    DI void operator()(const f32x4 (&acc)[2][2][4][2], const Unit& u, int wr, int wc, int fr, int fq) const {
        const int row0 = u.pm * 256 + wr * 64 + fr, col0 = u.pn * 256 + wc * 32 + 8 * fq;
#pragma unroll
        for (int ai = 0; ai < 2; ++ai)
#pragma unroll
            for (int m = 0; m < 4; ++m) { bf16* rowp = O + (size_t)(row0 + ai * 128 + m * 16) * ldc + col0;
#pragma unroll
                for (int bj = 0; bj < 2; ++bj) { const f32x4 v0 = acc[ai][bj][m][0] * scale, v1 = acc[ai][bj][m][1] * scale;
                    u32x4 w; w.x = cvt_pk_bf16(v0[0], v0[1]); w.y = cvt_pk_bf16(v0[2], v0[3]); w.z = cvt_pk_bf16(v1[0], v1[1]); w.w = cvt_pk_bf16(v1[2], v1[3]);
                    *(u32x4*)(rowp + bj * 128) = w; } }
    }
};
template <int MODE> struct EpiFold {
    static constexpr bool PERM = true;
    unsigned char* O;
    DI void operator()(const f32x4 (&acc)[2][2][4][2], const Unit& u, int wr, int wc, int fr, int fq) const {
        const int b = u.pm >> 2, h = u.pm & 3;
        const int rbase = MODE == 0 ? h * 256 : u.pn * 256, cbase = MODE == 0 ? u.pn * 256 : h * 256;
        const unsigned boff = (unsigned)b * 1024u * 1024u + (unsigned)(rbase + wr * 64 + fr) * 1024u + (unsigned)(cbase + wc * 32 + 8 * fq);
#pragma unroll
        for (int ai = 0; ai < 2; ++ai)
#pragma unroll
            for (int m = 0; m < 4; ++m) { unsigned char* rowp = O + (boff + (unsigned)(ai * 128 + m * 16) * 1024u);
#pragma unroll
                for (int bj = 0; bj < 2; ++bj) { const f32x4 v0 = acc[ai][bj][m][0] * 4.0f, v1 = acc[ai][bj][m][1] * 4.0f;
                    u32x2 w; w.x = pk4_fp8(v0[0], v0[1], v0[2], v0[3]); w.y = pk4_fp8(v1[0], v1[1], v1[2], v1[3]);
                    *(u32x2*)(rowp + bj * 128) = w; } }
    }
};
struct EpiSoftmax {
    static constexpr bool PERM = true;
    unsigned char* O; float scale; const float* RS; LAS float* XM; LAS float* XS;
    DI void operator()(const f32x4 (&acc)[2][2][4][2], const Unit& u, int wr, int wc, int fr, int fq) const {
        const int row0 = u.pm * 256 + wr * 64 + fr, col0 = u.pn * 256 + wc * 32 + 8 * fq;
        float sc[2][4];
#pragma unroll
        for (int ai = 0; ai < 2; ++ai)
#pragma unroll
            for (int m = 0; m < 4; ++m) { const int r = row0 + ai * 128 + m * 16; const f32x4* rp = (const f32x4*)(RS + (size_t)r * 16);
                const f32x4 p0 = rp[0], p1 = rp[1], p2 = rp[2], p3 = rp[3];
                const float ss = ((p0[0] + p0[1]) + (p0[2] + p0[3])) + ((p1[0] + p1[1]) + (p1[2] + p1[3])) + ((p2[0] + p2[1]) + (p2[2] + p2[3])) + ((p3[0] + p3[1]) + (p3[2] + p3[3]));
                sc[ai][m] = scale * __builtin_amdgcn_rsqf(ss * (1.0f / 1024.0f) + 1e-6f);
                float mm = -3.0e38f;
#pragma unroll
                for (int bj = 0; bj < 2; ++bj)
#pragma unroll
                    for (int n = 0; n < 2; ++n) { const f32x4 v = acc[ai][bj][m][n]; mm = fmaxf(mm, fmaxf(fmaxf(v[0], v[1]), fmaxf(v[2], v[3]))); }
                mm *= sc[ai][m];
                mm = fmaxf(mm, __shfl_xor(mm, 16)); mm = fmaxf(mm, __shfl_xor(mm, 32));
                if (fq == 0) XM[(ai * 128 + wr * 64 + m * 16 + fr) * 4 + wc] = mm; }
        asm volatile("s_waitcnt lgkmcnt(0)" ::: "memory"); __builtin_amdgcn_s_barrier(); asm volatile("" ::: "memory");
        f32x4 (&pa)[2][2][4][2] = const_cast<f32x4 (&)[2][2][4][2]>(acc);
#pragma unroll
        for (int ai = 0; ai < 2; ++ai)
#pragma unroll
            for (int m = 0; m < 4; ++m) { const int lr = ai * 128 + wr * 64 + m * 16 + fr; const f32x4 q = *(const LAS f32x4*)(XM + lr * 4);
                const float mxr = fmaxf(fmaxf(q[0], q[1]), fmaxf(q[2], q[3])); float sm = 0.f;
#pragma unroll
                for (int bj = 0; bj < 2; ++bj)
#pragma unroll
                    for (int n = 0; n < 2; ++n)
#pragma unroll
                        for (int j = 0; j < 4; ++j) { const float p = __expf(acc[ai][bj][m][n][j] * sc[ai][m] - mxr); pa[ai][bj][m][n][j] = p; sm += p; }
                sm += __shfl_xor(sm, 16); sm += __shfl_xor(sm, 32);
                if (fq == 0) XS[lr * 4 + wc] = sm; }
        asm volatile("s_waitcnt lgkmcnt(0)" ::: "memory"); __builtin_amdgcn_s_barrier(); asm volatile("" ::: "memory");
#pragma unroll
        for (int ai = 0; ai < 2; ++ai)
#pragma unroll
            for (int m = 0; m < 4; ++m) { const int lr = ai * 128 + wr * 64 + m * 16 + fr; const f32x4 q = *(const LAS f32x4*)(XS + lr * 4);
                const float inv = 256.0f * __builtin_amdgcn_rcpf((q[0] + q[1]) + (q[2] + q[3]));
                unsigned char* rowp = O + (size_t)(row0 + ai * 128 + m * 16) * 1024 + col0;
#pragma unroll
                for (int bj = 0; bj < 2; ++bj) { const f32x4 v0 = pa[ai][bj][m][0] * inv, v1 = pa[ai][bj][m][1] * inv;
                    u32x2 w; w.x = pk4_fp8(v0[0], v0[1], v0[2], v0[3]); w.y = pk4_fp8(v1[0], v1[1], v1[2], v1[3]);
                    *(u32x2*)(rowp + bj * 128) = w; } }
        asm volatile("s_waitcnt lgkmcnt(0)" ::: "memory"); __builtin_amdgcn_s_barrier(); asm volatile("" ::: "memory");
    }
};
struct EpiBf16RowNorm {
    static constexpr bool PERM = true;
    bf16* O; int ldc; float scale; const float* RS;
    DI void operator()(const f32x4 (&acc)[2][2][4][2], const Unit& u, int wr, int wc, int fr, int fq) const {
        const int row0 = u.pm * 256 + wr * 64 + fr, col0 = u.pn * 256 + wc * 32 + 8 * fq;
#pragma unroll
        for (int ai = 0; ai < 2; ++ai)
#pragma unroll
            for (int m = 0; m < 4; ++m) { const int r = row0 + ai * 128 + m * 16; const f32x4* rp = (const f32x4*)(RS + (size_t)r * 16);
                const f32x4 p0 = rp[0], p1 = rp[1], p2 = rp[2], p3 = rp[3];
                const float ss = ((p0[0] + p0[1]) + (p0[2] + p0[3])) + ((p1[0] + p1[1]) + (p1[2] + p1[3])) + ((p2[0] + p2[1]) + (p2[2] + p2[3])) + ((p3[0] + p3[1]) + (p3[2] + p3[3]));
                const float sc = scale * __builtin_amdgcn_rsqf(ss * (1.0f / 1024.0f) + 1e-6f);
                bf16* rowp = O + (size_t)r * ldc + col0;
#pragma unroll
                for (int bj = 0; bj < 2; ++bj) { const f32x4 v0 = acc[ai][bj][m][0] * sc, v1 = acc[ai][bj][m][1] * sc;
                    u32x4 w; w.x = cvt_pk_bf16(v0[0], v0[1]); w.y = cvt_pk_bf16(v0[2], v0[3]); w.z = cvt_pk_bf16(v1[0], v1[1]); w.w = cvt_pk_bf16(v1[2], v1[3]);
                    *(u32x4*)(rowp + bj * 128) = w; } }
    }
};
template <bool RES_BF16> struct EpiBf16Res {
    static constexpr bool PERM = true;
    const void* Rz; bf16* O; int ldc; float* RS; float ascale; unsigned char* O8;
    DI void operator()(const f32x4 (&acc)[2][2][4][2], const Unit& u, int wr, int wc, int fr, int fq) const {
        const int row0 = u.pm * 256 + wr * 64 + fr, col0 = u.pn * 256 + wc * 32 + 8 * fq;
#pragma unroll
        for (int ai = 0; ai < 2; ++ai) {
            u32x4 rwb[4][2]; f32x4 rf0[4][2], rf1[4][2];
#pragma unroll
            for (int m = 0; m < 4; ++m) { const size_t off = (size_t)(row0 + ai * 128 + m * 16) * ldc + col0;
#pragma unroll
                for (int bj = 0; bj < 2; ++bj) {
                    if (RES_BF16) rwb[m][bj] = *(const u32x4*)((const bf16*)Rz + off + bj * 128);
                    else { rf0[m][bj] = *(const f32x4*)((const float*)Rz + off + bj * 128); rf1[m][bj] = *(const f32x4*)((const float*)Rz + off + bj * 128 + 4); } } }
#pragma unroll
            for (int m = 0; m < 4; ++m) { const size_t off = (size_t)(row0 + ai * 128 + m * 16) * ldc + col0; float ssq = 0.f;
#pragma unroll
                for (int bj = 0; bj < 2; ++bj) { f32x4 r0, r1;
                    if (RES_BF16) { const u32x4 rw = rwb[m][bj]; r0 = (f32x4){bflo(rw.x), bfhi(rw.x), bflo(rw.y), bfhi(rw.y)}; r1 = (f32x4){bflo(rw.z), bfhi(rw.z), bflo(rw.w), bfhi(rw.w)}; }
                    else { r0 = rf0[m][bj]; r1 = rf1[m][bj]; }
                    const f32x4 v0 = r0 + acc[ai][bj][m][0] * ascale, v1 = r1 + acc[ai][bj][m][1] * ascale;
                    if (O8) { u32x2 w8; w8.x = pk4_fp8(v0[0], v0[1], v0[2], v0[3]); w8.y = pk4_fp8(v1[0], v1[1], v1[2], v1[3]); *(u32x2*)(O8 + off + bj * 128) = w8; }
                    ssq += (v0[0] * v0[0] + v0[1] * v0[1]) + (v0[2] * v0[2] + v0[3] * v0[3]) + (v1[0] * v1[0] + v1[1] * v1[1]) + (v1[2] * v1[2] + v1[3] * v1[3]);
                    u32x4 w; w.x = cvt_pk_bf16(v0[0], v0[1]); w.y = cvt_pk_bf16(v0[2], v0[3]); w.z = cvt_pk_bf16(v1[0], v1[1]); w.w = cvt_pk_bf16(v1[2], v1[3]);
                    *(u32x4*)(O + off + bj * 128) = w; }
                if (RS) { ssq += __shfl_xor(ssq, 16); ssq += __shfl_xor(ssq, 32); if (fq == 0) RS[(size_t)(row0 + ai * 128 + m * 16) * 16 + u.pn * 4 + wc] = ssq; } } }
    }
};
struct EpiLora {
    static constexpr bool PERM = false;
    float* LWp; bf16* AAp; bf16* GGp; const float* w0; const float* a0;
    DI void operator()(const f32x4 (&acc)[2][2][4][2], const Unit& u, int wr, int wc, int fr, int fq) const {
        const int kind = u.pn >> 1;
        const int row0 = u.pm * 256 + wr * 64 + fr, col0 = (u.pn & 1) * 256 + wc * 32 + 4 * fq;
#pragma unroll
        for (int bj = 0; bj < 2; ++bj)
#pragma unroll
            for (int n = 0; n < 2; ++n) {
                const int c = col0 + bj * 128 + n * 16;
                f32x4 bias = (f32x4){0.f, 0.f, 0.f, 0.f};
                if (kind == 0) bias = *(const f32x4*)(w0 + c); else if (kind == 1) bias = *(const f32x4*)(a0 + c);
#pragma unroll
                for (int ai = 0; ai < 2; ++ai)
#pragma unroll
                    for (int m = 0; m < 4; ++m) {
                        f32x4 v = acc[ai][bj][m][n] + bias;
                        if (kind == 0) {
#pragma unroll
                            for (int j = 0; j < 4; ++j) { const float w = -softplus_fast(-v[j]) - 0.5f; v[j] = -__expf(w);     }
                        } else if (kind == 1) {
#pragma unroll
                            for (int j = 0; j < 4; ++j) v[j] = sigmoid_f(v[j]);
                        }
                        const size_t o_ = (size_t)(row0 + ai * 128 + m * 16) * 512 + c;
                        if (kind == 0) *(f32x4*)(LWp + o_) = v;
                        else { u32x2 w_; w_.x = cvt_pk_bf16(v[0], v[1]); w_.y = cvt_pk_bf16(v[2], v[3]); *(u32x2*)((kind == 1 ? AAp : GGp) + o_) = w_; }
                    }
            }
    }
};
struct EpiSwiglu {
    static constexpr bool PERM = true;
    bf16* ACT; const float* b_gu;
    DI void operator()(const f32x4 (&acc)[2][2][4][2], const Unit& u, int wr, int wc, int fr, int fq) const {
        const int row0 = u.pm * 256 + wr * 64 + fr, j0 = u.pn * 128 + wc * 32 + 8 * fq;
        const float* bg = b_gu + (size_t)u.e * 2048 + j0; const float* bu = bg + 1024;
        const f32x4 bg0 = *(const f32x4*)bg, bg1 = *(const f32x4*)(bg + 4), bu0 = *(const f32x4*)bu, bu1 = *(const f32x4*)(bu + 4);
#pragma unroll
        for (int ai = 0; ai < 2; ++ai)
#pragma unroll
            for (int m = 0; m < 4; ++m) {
                float o[8];
#pragma unroll
                for (int n = 0; n < 2; ++n) { const f32x4 g4 = acc[ai][0][m][n] * 0.015625f + (n ? bg1 : bg0), u4 = acc[ai][1][m][n] * 0.015625f + (n ? bu1 : bu0);
#pragma unroll
                    for (int j = 0; j < 4; ++j) { const float g = fminf(g4[j], 7.0f), up = fminf(fmaxf(u4[j], -7.0f), 7.0f); o[n * 4 + j] = (up + 1.0f) * (g * sigmoid_f(1.702f * g)); } }
                u32x2 w; w.x = pk4_fp8(o[0], o[1], o[2], o[3]); w.y = pk4_fp8(o[4], o[5], o[6], o[7]);
                *(u32x2*)((unsigned char*)ACT + (size_t)(row0 + ai * 128 + m * 16) * 1024 + j0) = w;
            }
    }
};
struct EpiDown {
    static constexpr bool PERM = true;
    bf16* YS; const float* b_dn; const u32x2* row_sg;
    DI void operator()(const f32x4 (&acc)[2][2][4][2], const Unit& u, int wr, int wc, int fr, int fq) const {
        const int row0 = u.pm * 256 + wr * 64 + fr, col0 = u.pn * 256 + wc * 32 + 8 * fq;
        const float* bb = b_dn + (size_t)u.e * 1024 + col0;
        f32x4 bv[2][2];
#pragma unroll
        for (int bj = 0; bj < 2; ++bj)
#pragma unroll
            for (int n = 0; n < 2; ++n) bv[bj][n] = *(const f32x4*)(bb + bj * 128 + 4 * n);
        int slots[8]; float gts[8];
        { const u32x2* sgp = row_sg + row0;
#pragma unroll
        for (int q = 0; q < 8; ++q) { const u32x2 sg = sgp[(q >> 2) * 128 + (q & 3) * 16]; slots[q] = (int)sg.x; gts[q] = __uint_as_float(sg.y); } }
#pragma unroll
        for (int ai = 0; ai < 2; ++ai)
#pragma unroll
            for (int m = 0; m < 4; ++m) {
                const int slot = slots[ai * 4 + m]; const float gt = gts[ai * 4 + m];
                if (slot >= 0) { unsigned char* rowp = (unsigned char*)YS + (size_t)slot * 1024 + col0; const float g16 = gt * 16.0f;
#pragma unroll
                    for (int bj = 0; bj < 2; ++bj) { const f32x4 v0 = (acc[ai][bj][m][0] * 0.015625f + bv[bj][0]) * g16, v1 = (acc[ai][bj][m][1] * 0.015625f + bv[bj][1]) * g16;
                        u32x2 w; w.x = pk4_fp8(v0[0], v0[1], v0[2], v0[3]); w.y = pk4_fp8(v1[0], v1[1], v1[2], v1[3]);
                        *(u32x2*)(rowp + bj * 128) = w; } }
            }
    }
};

constexpr size_t MiB = 1u << 20;
constexpr size_t WS_CTL = 0, CTL_ZERO_BYTES = 1 * MiB;
constexpr size_t WS_WIN = 1 * MiB, WS_WOUT = 7 * MiB, WS_WQ = 9 * MiB, WS_WK = 11 * MiB, WS_WV = 13 * MiB, WS_WO = 15 * MiB, WS_LORAB = 17 * MiB, WS_LRUW = 18 * MiB;
constexpr size_t WS_ROUTE = 19 * MiB;
constexpr size_t WS_WGU = 22 * MiB, WS_WDN = 150 * MiB;
constexpr size_t WS_HN = 214 * MiB, WS_MEMN = 246 * MiB, WS_KM = 248 * MiB, WS_VT = 250 * MiB;
constexpr size_t WS_X1 = 252 * MiB, WS_X2 = 316 * MiB;
constexpr size_t WS_U = 380 * MiB, WS_R = 468 * MiB, WS_KRAW = 500 * MiB, WS_V = 532 * MiB, WS_KKN = 564 * MiB, WS_WD = 596 * MiB, WS_AA = 628 * MiB, WS_G = 660 * MiB;
constexpr size_t WS_LA = 692 * MiB, WS_LB = 724 * MiB, WS_AP = 756 * MiB, WS_CAT = 764 * MiB, WS_Q = 796 * MiB;
constexpr size_t WS_XS = 380 * MiB, WS_ACT = 524 * MiB, WS_YS = 668 * MiB;
constexpr size_t WS_GP = 796 * MiB, WS_HF = 860 * MiB, WS_RP = 924 * MiB, WS_Y1F = 940 * MiB, WS_ADD = 972 * MiB, WS_END = 1004 * MiB;
constexpr size_t WS_GC = 468 * MiB, WS_HC = 484 * MiB, WS_ZS = 500 * MiB;
static_assert(WS_AA == WS_WD + 32 * MiB && WS_G == WS_AA + 32 * MiB, "EpiLora strides");
static_assert(WS_U + (size_t)M * INW * 2 <= WS_R && WS_XS + (size_t)MAXROWS * 2048 <= WS_ACT && WS_ACT + (size_t)MAXROWS * 2048 <= WS_YS && WS_YS + (size_t)NASSIGN * 2048 <= WS_Q, "ws map");
constexpr size_t RT_E = 0, RT_POS = 256 * 1024, RT_G = 512 * 1024, RT_SLOT = 768 * 1024, RT_GATE = 1088 * 1024, RT_TILE = 1408 * 1024, RT_TOK = 1472 * 1024, RT_UGU = 1792 * 1024, RT_UDN = 1808 * 1024;
constexpr int CW_BAR = 4096, CW_CNT = 8192, CW_CONV = 12288;

constexpr int RING_BYTES = 131072, MISC_OFF = RING_BYTES + 320, LDS_BYTES = 147456;
constexpr int NWAVES = 8, NTHREADS = 512;
constexpr int CONV_P9 = 6144;
constexpr int CONV_P9D = 16384;

#define XB_TMO      128
#define XB_XCNT(j)  (256  + 64 * (j))
#define XB_XSUB(j)  (1280 + 64 * (j))
#define XB_XGEN(j)  (2304 + 64 * (j))
#define XB_TOP      3328
#define XB_TOPGEN   3392
#define XCD_BAR_WORDS 3456
#define XB_SPIN_CAP (1u << 18)
DI unsigned xb_ld(unsigned* p)              { return __hip_atomic_load(p, __ATOMIC_RELAXED, __HIP_MEMORY_SCOPE_AGENT); }
DI unsigned xb_add(unsigned* p, unsigned v) { return __hip_atomic_fetch_add(p, v, __ATOMIC_RELAXED, __HIP_MEMORY_SCOPE_AGENT); }
DI unsigned xb_xcc_id() { return (unsigned)__builtin_amdgcn_s_getreg((3 << 11) | 20) & 0xFu; }
#define XB_SPIN(cond, bar) do { unsigned _sp = 0; while (cond) { __builtin_amdgcn_s_sleep(1); \
    if ((++_sp & 255u) == 0u) { if (xb_ld(&(bar)[XB_TMO])) break; if (_sp > XB_SPIN_CAP) { atomicAdd(&(bar)[XB_TMO], 1u); break; } } } } while (0)
struct XcdBarrier { unsigned* bar; unsigned x; volatile LAS unsigned* st; int w0; };
DI XcdBarrier xcd_barrier_post(unsigned* bar, volatile LAS unsigned* st, int w0) {
    XcdBarrier b; b.bar = bar; b.x = xb_xcc_id(); b.st = st; b.w0 = w0;
    if (fresh_tid_(w0) == 0) (void)xb_add(&bar[XB_XCNT(b.x)], 1u);
    return b;
}
DI void xcd_barrier_complete(unsigned* bar, unsigned x, unsigned& nloc, unsigned& nx) {
    const unsigned G = gridDim.x * gridDim.y * gridDim.z;
    unsigned sum, cnt, mine, sp = 0u;
    for (;;) {
        sum = 0u; cnt = 0u; mine = 0u;
#pragma unroll
        for (unsigned j = 0; j < 16; ++j) { const unsigned c = xb_ld(&bar[XB_XCNT(j)]); sum += c; cnt += (c > 0u) ? 1u : 0u; mine = (j == x) ? c : mine; }
        if (sum == G) break;
        __builtin_amdgcn_s_sleep(1);
        if ((++sp & 255u) == 0u) { if (xb_ld(&bar[XB_TMO])) break; if (sp > XB_SPIN_CAP) { atomicAdd(&bar[XB_TMO], 1u); break; } }
    }
    nloc = mine > 0u ? mine : 1u; nx = cnt > 0u ? cnt : 1u;
}
DI void xcd_barrier(const XcdBarrier& b) {
    asm volatile("s_waitcnt vmcnt(0)" ::: "memory");
    __syncthreads();
    if (fresh_tid_(b.w0) == 0) {
        unsigned* bar = b.bar;
        __builtin_amdgcn_s_waitcnt(0);
        unsigned nloc = b.st[0], nx = b.st[1];
        if (nloc == 0u) { xcd_barrier_complete(bar, b.x, nloc, nx); b.st[0] = nloc; b.st[1] = nx; }
        const unsigned old = xb_add(&bar[XB_XSUB(b.x)], 1u);
        const unsigned gen = old / nloc;
        if (old + 1u == (gen + 1u) * nloc) {
            __builtin_amdgcn_fence(__ATOMIC_RELEASE, "agent");
            asm volatile("s_waitcnt vmcnt(0)" ::: "memory");
            const unsigned og = xb_add(&bar[XB_TOP], 1u);
            const unsigned tg = og / nx;
            if (og + 1u == (tg + 1u) * nx) xb_add(&bar[XB_TOPGEN], 1u);
            else XB_SPIN(xb_ld(&bar[XB_TOPGEN]) == tg, bar);
            __builtin_amdgcn_fence(__ATOMIC_ACQUIRE, "agent");
            xb_add(&bar[XB_XGEN(b.x)], 1u);
            asm volatile("s_waitcnt vmcnt(0)" ::: "memory");
        } else {
            XB_SPIN(xb_ld(&bar[XB_XGEN(b.x)]) == gen, bar);
            __builtin_amdgcn_fence(__ATOMIC_ACQUIRE, "agent");
            asm volatile("s_waitcnt vmcnt(0)" ::: "memory");
        }
    }
    __syncthreads();
}

struct Args { const float* in[37]; float* out; unsigned char* ws; int ph_lo, ph_hi; };
enum { I_X = 0, I_MEM, I_NMIXG, I_WIN, I_CONVW, I_CONVB, I_LWX, I_LBX, I_LWA, I_LBA, I_LAM, I_MU, I_W0, I_WUP, I_A0, I_AUP, I_GUP, I_KK, I_KA, I_RK, I_LNG, I_LNB,
       I_WOUT, I_NXAG, I_NMEMG, I_WQ, I_WK, I_WV, I_WO, I_NFFG, I_WR, I_BR, I_WGU, I_BGU, I_WDN, I_BDN, I_FNG };

DI void transpose_item(const float* W, int ldw, int K, bf16* WT, int k0, int n0, int drow0, LAS float* scr, int lane, const float* rs = nullptr) {
    f32x4 t[8];
    const float* src = W + (size_t)(k0 + (lane >> 3)) * ldw + n0 + 4 * (lane & 7);
#pragma unroll
    for (int i = 0; i < 8; ++i) t[i] = *(const f32x4*)(src + (size_t)(8 * i) * ldw);
#pragma unroll
    for (int i = 0; i < 8; ++i) { const float sc_ = rs ? rs[k0 + 8 * i + (lane >> 3)] : 1.0f; LAS float* d = scr + (8 * i + (lane >> 3)) * 33 + 4 * (lane & 7); d[0] = t[i].x * sc_; d[1] = t[i].y * sc_; d[2] = t[i].z * sc_; d[3] = t[i].w * sc_; }
    asm volatile("s_waitcnt lgkmcnt(0)" ::: "memory");
    const int c = lane & 7;
#pragma unroll
    for (int j = 0; j < 4; ++j) { const int n = (lane >> 3) + 8 * j; const LAS float* s = scr + (8 * c) * 33 + n;
        u32x4 o; o.x = pk2(s[0 * 33], s[1 * 33]); o.y = pk2(s[2 * 33], s[3 * 33]); o.z = pk2(s[4 * 33], s[5 * 33]); o.w = pk2(s[6 * 33], s[7 * 33]);
        *(u32x4*)(WT + (size_t)(drow0 + n) * K + k0 + 8 * c) = o; }
    asm volatile("s_waitcnt lgkmcnt(0)" ::: "memory");
}
DI void transpose_item_tiled(const float* W, int ldw, int K, bf16* WTe, int k0, int n0, int drow0, LAS float* scr, int lane) {
    f32x4 t[8];
    const float* src = W + (size_t)(k0 + (lane >> 3)) * ldw + n0 + 4 * (lane & 7);
#pragma unroll
    for (int i = 0; i < 8; ++i) t[i] = *(const f32x4*)(src + (size_t)(8 * i) * ldw);
#pragma unroll
    for (int i = 0; i < 8; ++i) { LAS float* d = scr + (8 * i + (lane >> 3)) * 33 + 4 * (lane & 7); d[0] = t[i].x; d[1] = t[i].y; d[2] = t[i].z; d[3] = t[i].w; }
    asm volatile("s_waitcnt lgkmcnt(0)" ::: "memory");
    const int c = lane & 7;
#pragma unroll
    for (int j = 0; j < 4; ++j) { const int n = (lane >> 3) + 8 * j; const LAS float* s = scr + (8 * c) * 33 + n;
        u32x4 o; o.x = pk2(s[0 * 33], s[1 * 33]); o.y = pk2(s[2 * 33], s[3 * 33]); o.z = pk2(s[4 * 33], s[5 * 33]); o.w = pk2(s[6 * 33], s[7 * 33]);
        const int drow = drow0 + n, pn = drow >> 8, half = (drow >> 7) & 1, r = drow & 127, x = r & 31;
        const int rslot = (r & ~31) + 16 * ((x >> 2) & 1) + 4 * (x >> 3) + (x & 3);
        const size_t tb = ((size_t)(pn * (K / 64) + (k0 >> 6)) * 2 + half) * 16384 + pg8::lds_byte(rslot, 8 * c);
        *(u32x4*)((char*)WTe + tb) = o; }
    asm volatile("s_waitcnt lgkmcnt(0)" ::: "memory");
}
DI void transpose_item_tiled_nolds(const float* W, int ldw, int K, bf16* WTe, int k0, int n0, int drow0, int lane) {
    const int n = lane & 31, kh = lane >> 5;
    const float* src = W + (size_t)(k0 + 32 * kh) * ldw + n0 + n;
    float t[32];
#pragma unroll
    for (int i = 0; i < 32; ++i) t[i] = src[(size_t)i * ldw];
    const int drow = drow0 + n, pn = drow >> 8, half = (drow >> 7) & 1, r = drow & 127, x = r & 31;
    const int rslot = (r & ~31) + 16 * ((x >> 2) & 1) + 4 * (x >> 3) + (x & 3);
    const size_t tb0 = ((size_t)(pn * (K / 64) + (k0 >> 6)) * 2 + half) * 16384;
#pragma unroll
    for (int c = 0; c < 4; ++c) { u32x4 o; o.x = pk2(t[8 * c], t[8 * c + 1]); o.y = pk2(t[8 * c + 2], t[8 * c + 3]); o.z = pk2(t[8 * c + 4], t[8 * c + 5]); o.w = pk2(t[8 * c + 6], t[8 * c + 7]);
        *(u32x4*)((char*)WTe + tb0 + pg8::lds_byte(rslot, 32 * kh + 8 * c)) = o; }
}
DI void transpose_item_tiled_fp8_nolds(const float* W, int ldw, int K, unsigned char* WTe, int k0, int n0, int drow0, int lane) {
    const int n = lane & 31, kh = lane >> 5;
    const float* src = W + (size_t)(k0 + 32 * kh) * ldw + n0 + n;
    float t[32];
#pragma unroll
    for (int i = 0; i < 32; ++i) t[i] = src[(size_t)i * ldw] * 64.f;
    const int drow = drow0 + n, pn = drow >> 8, half = (drow >> 7) & 1, r = drow & 127, x = r & 31;
    const int rslot = (r & ~31) + 16 * ((x >> 2) & 1) + 4 * (x >> 3) + (x & 3);
    const size_t tb0 = ((size_t)(pn * (K / 128) + (k0 >> 7)) * 2 + half) * 16384;
#pragma unroll
    for (int c = 0; c < 2; ++c) { u32x4 o; o.x = pk4_fp8(t[16 * c], t[16 * c + 1], t[16 * c + 2], t[16 * c + 3]); o.y = pk4_fp8(t[16 * c + 4], t[16 * c + 5], t[16 * c + 6], t[16 * c + 7]);
        o.z = pk4_fp8(t[16 * c + 8], t[16 * c + 9], t[16 * c + 10], t[16 * c + 11]); o.w = pk4_fp8(t[16 * c + 12], t[16 * c + 13], t[16 * c + 14], t[16 * c + 15]);
        const int bc = (k0 & 64) + 32 * kh + 16 * c;
        *(u32x4*)(WTe + tb0 + pg8::lds_byte(rslot, bc >> 1)) = o; }
}
DI void transpose_item_tiled_fp8(const float* W, int ldw, int K, unsigned char* WTe, int k0, int n0, int drow0, LAS float* scr, int lane) {
    f32x4 t[8];
    const float* src = W + (size_t)(k0 + (lane >> 3)) * ldw + n0 + 4 * (lane & 7);
#pragma unroll
    for (int i = 0; i < 8; ++i) t[i] = *(const f32x4*)(src + (size_t)(8 * i) * ldw);
#pragma unroll
    for (int i = 0; i < 8; ++i) { LAS float* d = scr + (8 * i + (lane >> 3)) * 33 + 4 * (lane & 7); d[0] = t[i].x * 64.f; d[1] = t[i].y * 64.f; d[2] = t[i].z * 64.f; d[3] = t[i].w * 64.f; }
    asm volatile("s_waitcnt lgkmcnt(0)" ::: "memory");
    const int c = lane & 3;
#pragma unroll
    for (int j = 0; j < 2; ++j) { const int n = (lane >> 2) + 16 * j; const LAS float* sp = scr + (16 * c) * 33 + n;
        u32x4 o; o.x = pk4_fp8(sp[0 * 33], sp[1 * 33], sp[2 * 33], sp[3 * 33]); o.y = pk4_fp8(sp[4 * 33], sp[5 * 33], sp[6 * 33], sp[7 * 33]);
        o.z = pk4_fp8(sp[8 * 33], sp[9 * 33], sp[10 * 33], sp[11 * 33]); o.w = pk4_fp8(sp[12 * 33], sp[13 * 33], sp[14 * 33], sp[15 * 33]);
        const int drow = drow0 + n, pn = drow >> 8, half = (drow >> 7) & 1, r = drow & 127, x = r & 31;
        const int rslot = (r & ~31) + 16 * ((x >> 2) & 1) + 4 * (x >> 3) + (x & 3);
        const int bc = (k0 & 64) + 16 * c;
        const size_t tb = ((size_t)(pn * (K / 128) + (k0 >> 7)) * 2 + half) * 16384 + pg8::lds_byte(rslot, bc >> 1);
        *(u32x4*)(WTe + tb) = o; }
    asm volatile("s_waitcnt lgkmcnt(0)" ::: "memory");
}
DI void rms_row_to_bf16(const float* xrow, const float* g, bf16* orow, int lane) {
    const f32x4* xr = (const f32x4*)xrow + lane; const f32x4* gr = (const f32x4*)g + lane;
    f32x4 v[4]; float s = 0.f;
#pragma unroll
    for (int j = 0; j < 4; ++j) { v[j] = xr[64 * j]; s += (v[j].x * v[j].x + v[j].y * v[j].y) + (v[j].z * v[j].z + v[j].w * v[j].w); }
    const float rstd = rsq_f(wave_sum(s) * (1.f / D) + EPS);
    u32x2* o8 = (u32x2*)orow + lane;
#pragma unroll
    for (int j = 0; j < 4; ++j) { const f32x4 gg = gr[64 * j]; u32x2 w; w.x = pk2(v[j].x * rstd * gg.x, v[j].y * rstd * gg.y); w.y = pk2(v[j].z * rstd * gg.z, v[j].w * rstd * gg.w); o8[64 * j] = w; }
}

DI void rms_rowbf_to_bf16(const bf16* xrow, const float* g, bf16* orow, int lane) {
    float v[16]; float s = 0.f;
#pragma unroll
    for (int hf = 0; hf < 2; ++hf) { const u32x4 w = *(const u32x4*)(xrow + 512 * hf + 8 * lane);
#pragma unroll
        for (int q = 0; q < 4; ++q) { v[8 * hf + 2 * q] = bflo(w[q]); v[8 * hf + 2 * q + 1] = bfhi(w[q]); } }
#pragma unroll
    for (int j = 0; j < 16; ++j) s += v[j] * v[j];
    const float rstd = rsq_f(wave_sum(s) * (1.f / D) + EPS);
#pragma unroll
    for (int hf = 0; hf < 2; ++hf) { const f32x4 g0 = *(const f32x4*)(g + 512 * hf + 8 * lane), g1 = *(const f32x4*)(g + 512 * hf + 8 * lane + 4);
        u32x4 w; w.x = pk2(v[8 * hf] * rstd * g0.x, v[8 * hf + 1] * rstd * g0.y); w.y = pk2(v[8 * hf + 2] * rstd * g0.z, v[8 * hf + 3] * rstd * g0.w);
        w.z = pk2(v[8 * hf + 4] * rstd * g1.x, v[8 * hf + 5] * rstd * g1.y); w.w = pk2(v[8 * hf + 6] * rstd * g1.z, v[8 * hf + 7] * rstd * g1.w);
        *(u32x4*)(orow + 512 * hf + 8 * lane) = w; }
}

__global__ void __launch_bounds__(NTHREADS, 2) fwd(Args args) {
    extern __shared__ __attribute__((aligned(16))) unsigned char lds_raw[];
    LAS unsigned char* lds = (LAS unsigned char*)lds_raw;
    volatile LAS unsigned* MISC = (volatile LAS unsigned*)(lds + MISC_OFF);
    const int G = gridDim.x, bid = blockIdx.x, NGW = G * NWAVES;
    const int wv0 = __builtin_amdgcn_readfirstlane((int)(threadIdx.x >> 6));
#define PHASE_IDS const int tid = fresh_tid(), lane = tid & 63, wave = __builtin_amdgcn_readfirstlane(tid >> 6), gw = bid * NWAVES + wave; (void)tid; (void)lane; (void)wave; (void)gw
    unsigned char* ws = args.ws;
    unsigned* ctl = (unsigned*)(ws + WS_CTL);
    const int lo = args.ph_lo, hi = args.ph_hi;

    for (int u = fresh_tid(); u < (LDS_BYTES - RING_BYTES) / 4; u += NTHREADS) ((LAS unsigned*)(lds + RING_BYTES))[u] = 0u;
    __syncthreads();
    XcdBarrier bar; bar.bar = ctl + CW_BAR; bar.x = 0; bar.st = nullptr; bar.w0 = wv0;
    if (hi - lo > 1) bar = xcd_barrier_post(ctl + CW_BAR, MISC + 8, wv0);
#define IN(k) (lo <= (k) && (k) < hi)
#define SEAM(k) do { if (IN(k) && IN((k) + 1)) xcd_barrier(bar); } while (0)

#define Win_t ((bf16*)(ws + WS_WIN))
#define Wout_t ((bf16*)(ws + WS_WOUT))
#define Wq_t ((bf16*)(ws + WS_WQ))
#define Wk_t ((bf16*)(ws + WS_WK))
#define Wv_t ((bf16*)(ws + WS_WV))
#define Wo_t ((bf16*)(ws + WS_WO))
#define LoraB ((bf16*)(ws + WS_LORAB))
#define LruW ((bf16*)(ws + WS_LRUW))
#define WrT ((bf16*)(ws + WS_LRUW + 512 * 1024))
#define Wgu_t ((bf16*)(ws + WS_WGU))
#define Wdn_t ((bf16*)(ws + WS_WDN))
#define HN ((bf16*)(ws + WS_HN))
#define MEMN ((bf16*)(ws + WS_MEMN))
#define KM ((bf16*)(ws + WS_KM))
#define VT ((bf16*)(ws + WS_VT))
#define X1 ((bf16*)(ws + WS_X1))
#define X2 ((bf16*)(ws + WS_X2))
#define U ((bf16*)(ws + WS_U))
#define Rr ((float*)(ws + WS_R))
#define KRAW ((float*)(ws + WS_KRAW))
#define Vv ((float*)(ws + WS_V))
#define KKN ((float*)(ws + WS_KKN))
#define WD ((float*)(ws + WS_WD))
#define AA ((float*)(ws + WS_AA))
#define GG ((float*)(ws + WS_G))
#define LA ((bf16*)(ws + WS_LA))
#define LB ((bf16*)(ws + WS_LB))
#define AP ((bf16*)(ws + WS_AP))
#define CAT ((bf16*)(ws + WS_CAT))
#define Qb ((bf16*)(ws + WS_Q))
#define Ob CAT
#define X1F8 ((unsigned char*)(ws + WS_XS))
#define XS ((bf16*)(ws + WS_XS))
#define ACT ((bf16*)(ws + WS_ACT))
#define YS ((bf16*)(ws + WS_YS))
#define route_e ((int*)(ws + WS_ROUTE + RT_E))
#define route_pos ((int*)(ws + WS_ROUTE + RT_POS))
#define route_g ((float*)(ws + WS_ROUTE + RT_G))
#define row_sg ((u32x2*)(ws + WS_ROUTE + RT_SLOT))
#define tile_tab ((int*)(ws + WS_ROUTE + RT_TILE))
#define row_tok ((int*)(ws + WS_ROUTE + RT_TOK))
#define ecnt (ctl + CW_CNT)

    if (IN(0)) { PHASE_IDS;
        LAS float* scr = (LAS float*)(lds + wave * 16384);
        constexpr int I_IN = 16 * (INW / 32), I_SQ = 16 * 32;
        constexpr int N_ITEMS = I_IN + 5 * I_SQ;
        for (int it = gw; it < N_ITEMS; it += NGW) {
            int r = it;
            if (r < I_IN) { const int nblk = INW / 32, kb = r / nblk, nb = r % nblk; transpose_item(args.in[I_WIN], INW, D, Win_t, 64 * kb, 32 * nb, 32 * nb, scr, lane); continue; } r -= I_IN;
            { const int w = r / I_SQ, q = r % I_SQ, kb = q / 32, nb = q % 32;
                if (w == 1) continue;
                const float* src = w == 0 ? args.in[I_WOUT] : w == 2 ? args.in[I_WK] : w == 3 ? args.in[I_WV] : args.in[I_WO];
                bf16* dst = w == 0 ? Wout_t : w == 2 ? Wk_t : w == 3 ? Wv_t : Wo_t;
                transpose_item(src, D, D, dst, 64 * kb, 32 * nb, 32 * nb, scr, lane); }
        }
        for (int idx = bid * NTHREADS + tid; idx < D * D / 4; idx += G * NTHREADS) { const f32x4 v = ((const f32x4*)args.in[I_WQ])[idx]; const float gk = args.in[I_NXAG][idx >> 8];
            u32x2 w; w.x = pk2(v.x * gk, v.y * gk); w.y = pk2(v.z * gk, v.w * gk); ((u32x2*)Wq_t)[idx] = w; }
        for (int idx = bid * NTHREADS + tid; idx < 1536 * 256; idx += G * NTHREADS) {
            const int e = idx & 7, ln = (idx >> 3) & 63, ks = (idx >> 9) & 7, ct = (idx >> 12) & 3, hk = idx >> 14, hh = hk / 3, kind = hk - 3 * hh;
            const int k = 32 * ks + 8 * (ln >> 4) + e, n = hh * 64 + 16 * ct + (ln & 15); float v = 0.f;
            if (kind == 0) { if (k < 64) v = args.in[I_WUP][k * 512 + n]; }
            else if (kind == 1) { if (k >= 64 && k < 128) v = args.in[I_AUP][(k - 64) * 512 + n]; }
            else { if (k >= 128) v = args.in[I_GUP][(k - 128) * 512 + n]; }
            LoraB[idx] = (bf16)f2bf(v);
        }
        for (int idx = bid * NTHREADS + tid; idx < 8 * 128 * 64; idx += G * NTHREADS) {
            const int nb = idx >> 13, col = (idx >> 6) & 127, k = idx & 63;
            const float v = col < 64 ? args.in[I_LWX][nb * 4096 + k * 64 + col] : args.in[I_LWA][nb * 4096 + k * 64 + (col - 64)];
            LruW[idx] = (bf16)f2bf(v);
        }
        for (int idx = bid * NTHREADS + tid; idx < NE * D; idx += G * NTHREADS) {
            const int e = idx >> 10, k = idx & 1023; const float v = args.in[I_WR][k * NE + e];
            const unsigned hi = f2bf(v); const float lo = v - __uint_as_float(hi << 16);
            WrT[idx] = (bf16)hi; WrT[NE * D + idx] = (bf16)f2bf(lo);
        }
        for (int m = gw; m < M; m += NGW) rms_row_to_bf16(args.in[I_X] + (size_t)m * D, args.in[I_NMIXG], HN + (size_t)m * D, lane);
        for (int m = gw; m < MROWS; m += NGW) rms_row_to_bf16(args.in[I_MEM] + (size_t)m * D, args.in[I_NMEMG], MEMN + (size_t)m * D, lane);
        {
            LAS float* scr = (LAS float*)(lds + wave * 16384);
            constexpr int I_GU = 16 * 64, I_DN = 16 * 32;
            for (int it = CONV_P9 + gw; it < NE * I_GU; it += NGW) {
                int r = it;
                if (r < NE * I_GU) { const int e = r / I_GU, q = r % I_GU, kb = q / 64, nb = q % 64; const int n0 = 32 * nb;
                    const int drow = n0 < 1024 ? (256 * (n0 >> 7) + (n0 & 127)) : (256 * ((n0 - 1024) >> 7) + 128 + ((n0 - 1024) & 127));
                    transpose_item_tiled_fp8(args.in[I_WGU] + (size_t)e * D * 2048, 2048, D, (unsigned char*)Wgu_t + (size_t)e * 2048 * D, 64 * kb, n0, drow, scr, lane); continue; } r -= NE * I_GU;
                { const int e = r / I_DN, q = r % I_DN, kb = q / 32, nb = q % 32;
                  transpose_item_tiled(args.in[I_WDN] + (size_t)e * DFF * D, D, DFF, Wdn_t + (size_t)e * D * DFF, 64 * kb, 32 * nb, 32 * nb, scr, lane); }
            }
        }
    }
    SEAM(0);

    if (IN(1)) { PHASE_IDS;
        { pg8::DenseSched S; S.o.init_tiles(M / 256, INW / 256, G, bid); S.A = (const char*)HN; S.B = (const char*)Win_t; S.tstep = (size_t)256 * D * 2;
          EpiBf16Plain E{U, INW, 1.0f}; pg8::gemm_phase(lds, D, S, E, wv0); }
        { pg8::DenseSched S; S.o.init_tiles(MROWS / 256, D / 256, G, (bid + 64) & (G - 1)); S.A = (const char*)MEMN; S.B = (const char*)Wk_t; S.tstep = (size_t)256 * D * 2;
          EpiBf16Plain E{KM, D, 1.0f}; pg8::gemm_phase(lds, D, S, E, wv0); }
        { pg8::DenseSched S; S.o.init_tiles(MROWS / 256, D / 256, G, (bid + 48) & (G - 1)); S.A = (const char*)MEMN; S.B = (const char*)Wv_t; S.tstep = (size_t)256 * D * 2;
          EpiBf16Plain E{VT, D, 1.0f}; pg8::gemm_phase(lds, D, S, E, wv0); }
    }
    SEAM(1);

    if (IN(2)) { PHASE_IDS;
        const float* conv_w = args.in[I_CONVW]; const float* conv_b = args.in[I_CONVB];
        LAS float* xs = (LAS float*)(lds + wave * 16384);
        LAS bf16* tP = (LAS bf16*)(lds + wave * 16384 + 4096); LAS bf16* tH = tP + 1024;
        const int i = lane & 15, kg = lane >> 4;
        for (int unit = gw; unit < (M / 64) * 8; unit += NGW) {
            const int seg = unit >> 3, nb = unit & 7, m0s = seg * 64, s0s = m0s & (SEQ - 1);
            bf16x8 wf[8][2];
#pragma unroll
            for (int ct = 0; ct < 8; ++ct)
#pragma unroll
                for (int ks = 0; ks < 2; ++ks) wf[ct][ks] = *(const bf16x8*)(LruW + ((size_t)(nb * 128 + 16 * ct + i) * 64 + 32 * ks + 8 * kg));
            float bxv[4], bav[4], spv[4], Arun[4], Brun[4];
#pragma unroll
            for (int ct = 0; ct < 4; ++ct) { const int ch = nb * 64 + 16 * ct + i; bxv[ct] = args.in[I_LBX][ch]; bav[ct] = args.in[I_LBA][ch]; spv[ct] = softplus_f(-args.in[I_LAM][ch]); Arun[ct] = 1.f; Brun[ct] = 0.f; }
#pragma unroll 1
            for (int jt = 0; jt < 4; ++jt) {
                const int m0 = m0s + 16 * jt, s0 = s0s + 16 * jt;
                bf16x8 af[2];
#pragma unroll
                for (int ks = 0; ks < 2; ++ks) {
                    const int chb = nb * 64 + 32 * ks + 8 * kg;
                    f32x4 x0 = *(const f32x4*)(conv_b + chb), x1 = *(const f32x4*)(conv_b + chb + 4);
#pragma unroll
                    for (int j = 0; j < 4; ++j) {
                        const bool ok = s0 + i - 3 + j >= 0;
                        u32x4 uw = *(const u32x4*)(U + (size_t)(ok ? m0 + i - 3 + j : m0) * INW + chb); if (!ok) uw = (u32x4){0u, 0u, 0u, 0u};
                        const f32x4 w0 = *(const f32x4*)(conv_w + j * 512 + chb), w1 = *(const f32x4*)(conv_w + j * 512 + chb + 4);
                        x0.x += w0.x * bflo(uw.x); x0.y += w0.y * bfhi(uw.x); x0.z += w0.z * bflo(uw.y); x0.w += w0.w * bfhi(uw.y);
                        x1.x += w1.x * bflo(uw.z); x1.y += w1.y * bfhi(uw.z); x1.z += w1.z * bflo(uw.w); x1.w += w1.w * bfhi(uw.w);
                    }
                    *(LAS f32x4*)(xs + i * 64 + 32 * ks + 8 * kg) = x0; *(LAS f32x4*)(xs + i * 64 + 32 * ks + 8 * kg + 4) = x1;
                    u32x4 p; p.x = pk2(x0.x, x0.y); p.y = pk2(x0.z, x0.w); p.z = pk2(x1.x, x1.y); p.w = pk2(x1.z, x1.w);
                    af[ks] = __builtin_bit_cast(bf16x8, p);
                }
                f32x4 acc[8];
#pragma unroll
                for (int ct = 0; ct < 8; ++ct) { acc[ct] = (f32x4){0.f, 0.f, 0.f, 0.f};
#pragma unroll
                    for (int ks = 0; ks < 2; ++ks) acc[ct] = __builtin_amdgcn_mfma_f32_16x16x32_bf16(af[ks], wf[ct][ks], acc[ct], 0, 0, 0); }
#pragma unroll
                for (int ct = 0; ct < 4; ++ct) {
                    const int col = 16 * ct + i;
                    float hl[4], pl[4]; float hprev = 0.f, pprev = 1.f;
#pragma unroll
                    for (int e = 0; e < 4; ++e) {
                        const float gx = sigmoid_f(acc[ct][e] + bxv[ct]), ga = sigmoid_f(acc[ct + 4][e] + bav[ct]);
                        const float la = -8.0f * ga * spv[ct], av = __expf(la), xcv = xs[(4 * kg + e) * 64 + col];
                        const float bt = __builtin_amdgcn_sqrtf(fmaxf(1.0f - av * av, 0.f)) * gx * xcv;
                        hprev = av * hprev + bt; pprev *= av; hl[e] = hprev; pl[e] = pprev;
                    }
                    float Ag[4], Bg[4];
#pragma unroll
                    for (int gq = 0; gq < 4; ++gq) { Ag[gq] = __shfl(pl[3], i + 16 * gq); Bg[gq] = __shfl(hl[3], i + 16 * gq); }
                    float Ain = Arun[ct], Bin = Brun[ct];
#pragma unroll
                    for (int gq = 0; gq < 3; ++gq) if (gq < kg) { Bin = Ag[gq] * Bin + Bg[gq]; Ain *= Ag[gq]; }
                    float At = 1.f, Bt = 0.f;
#pragma unroll
                    for (int gq = 0; gq < 4; ++gq) { Bt = Ag[gq] * Bt + Bg[gq]; At *= Ag[gq]; }
                    Brun[ct] = At * Brun[ct] + Bt; Arun[ct] *= At;
#pragma unroll
                    for (int e = 0; e < 4; ++e) { const int ti_ = (4 * kg + e) * 64 + col; tP[ti_] = (bf16)f2bf(pl[e] * Ain); tH[ti_] = (bf16)f2bf(hl[e] + pl[e] * Bin); }
                }
                { const int rr = lane >> 2, cq = lane & 3;
                  bf16* pp = LA + (size_t)(m0 + rr) * 512 + nb * 64 + 16 * cq; bf16* hp = LB + (size_t)(m0 + rr) * 512 + nb * 64 + 16 * cq;
                  *(u32x4*)pp = *(const LAS u32x4*)(tP + rr * 64 + 16 * cq); *(u32x4*)(pp + 8) = *(const LAS u32x4*)(tP + rr * 64 + 16 * cq + 8);
                  *(u32x4*)hp = *(const LAS u32x4*)(tH + rr * 64 + 16 * cq); *(u32x4*)(hp + 8) = *(const LAS u32x4*)(tH + rr * 64 + 16 * cq + 8); }
            }
            if (kg == 0) {
#pragma unroll
                for (int ct = 0; ct < 4; ++ct) { f32x2 ab; ab.x = Arun[ct]; ab.y = Brun[ct];
                    *(f32x2*)((float*)(ws + WS_AP) + ((size_t)(((seg >> 6) * 8 + nb) * 64 + (seg & 63)) * 64 + 16 * ct + i) * 2) = ab; }
            }
        }
    }
    SEAM(2);


#define RW_ZB(zz, zb) do { _Pragma("unroll") for (int ks_ = 0; ks_ < 2; ++ks_) { u32x4 p_; p_.x = pk2(zz[2 * ks_][0], zz[2 * ks_][1]); p_.y = pk2(zz[2 * ks_][2], zz[2 * ks_][3]); \
        p_.z = pk2(zz[2 * ks_ + 1][0], zz[2 * ks_ + 1][1]); p_.w = pk2(zz[2 * ks_ + 1][2], zz[2 * ks_ + 1][3]); zb[ks_] = __builtin_bit_cast(bf16x8, p_); } } while (0)
    if (IN(3)) { PHASE_IDS;
        for (int u64 = gw; u64 < NB * NH * (SEQ / 64); u64 += NGW) {
#pragma unroll 1
        for (int jj = 0; jj < 4; ++jj) {
        LAS unsigned char* wl = lds + wave * 16384;
        LAS bf16* Arm = (LAS bf16*)(wl); LAS bf16* Brm = (LAS bf16*)(wl + 2048); LAS bf16* Krm = (LAS bf16*)(wl + 4096); LAS bf16* Rrm = (LAS bf16*)(wl + 6144);
        LAS bf16* ATt = (LAS bf16*)(wl + 8192); LAS bf16* BTt = (LAS bf16*)(wl + 10240); LAS bf16* KTt = (LAS bf16*)(wl + 12288); LAS bf16* VTt = (LAS bf16*)(wl + 14336);
        LAS float* MabT = (LAS float*)(wl); LAS bf16* Mak = (LAS bf16*)(wl + 1024); LAS bf16* Mrb = (LAS bf16*)(wl + 1536); LAS bf16* Mrk = (LAS bf16*)(wl + 2048); LAS bf16* Tm = (LAS bf16*)(wl + 2560);
        LAS float* PLs = (LAS float*)(wl + 3072); LAS bf16* Q0T = (LAS bf16*)(wl + 4096);
        const int lane = fresh_tid() & 63, l15 = lane & 15, g = lane >> 4, te = lane >> 2, kq = lane & 3;
        const bf16x8 z8 = (bf16x8){0, 0, 0, 0, 0, 0, 0, 0};
        const f32x4 z4 = (f32x4){0.f, 0.f, 0.f, 0.f};
            const int un = u64 * 4 + jj;
            const int bh = un >> 8, c = un & 255, b = bh >> 3, h = bh & 7;
            const size_t mrow = (size_t)b * SEQ + c * 16 + te, off = mrow * 512 + h * 64 + 16 * kq;
            const int hc = h * 64 + 16 * kq;
            LAS float* tmpL = (LAS float*)wl;
            {
                const int rsub = lane >> 5, chunk = lane & 31; const size_t mt0 = (size_t)b * SEQ + c * 16;
                const f32x4 m0 = *(const f32x4*)(args.in[I_MU] + 1536 + 8 * chunk), m1 = *(const f32x4*)(args.in[I_MU] + 1536 + 8 * chunk + 4);
                u32x4 cu[8], pu[8];
#pragma unroll
                for (int i = 0; i < 8; ++i) { const size_t mr = mt0 + 2 * i + rsub; const bool hp2 = (mr & (SEQ - 1)) != 0; const bf16* ua = U + mr * INW + 2560 + 8 * chunk;
                    cu[i] = *(const u32x4*)ua; pu[i] = *(const u32x4*)(ua - (hp2 ? INW : 0)); if (!hp2) pu[i] = (u32x4){0u, 0u, 0u, 0u}; }
#pragma unroll
                for (int i = 0; i < 8; ++i) { float o8[8];
#pragma unroll
                    for (int q = 0; q < 4; ++q) { const float c0 = bflo(cu[i][q]), c1 = bfhi(cu[i][q]), p0 = bflo(pu[i][q]), p1 = bfhi(pu[i][q]); const float mm0 = q < 2 ? m0[2 * q] : m1[2 * q - 4], mm1 = q < 2 ? m0[2 * q + 1] : m1[2 * q - 3];
                        float x0 = c0 + (p0 - c0) * mm0, x1 = c1 + (p1 - c1) * mm1;
                        if (chunk < 8) { x0 = tanh_fast(x0); x1 = tanh_fast(x1); }
                        else if (chunk >= 16) { x0 = sigmoid_f(x0); x1 = sigmoid_f(x1); }
                        o8[2 * q] = x0; o8[2 * q + 1] = x1; }
                    u32x4 pw; pw.x = pk2(o8[0], o8[1]); pw.y = pk2(o8[2], o8[3]); pw.z = pk2(o8[4], o8[5]); pw.w = pk2(o8[6], o8[7]);
                    const int row = 2 * i + rsub; *(LAS u32x4*)(wl + row * 512 + ((chunk ^ (row & 7)) << 4)) = pw; }
                bf16x8 af[8];
#pragma unroll
                for (int ks = 0; ks < 8; ++ks) af[ks] = *(const LAS bf16x8*)(wl + l15 * 512 + (((4 * ks + g) ^ (l15 & 7)) << 4));
                asm volatile("s_waitcnt lgkmcnt(0)" ::: "memory");
#pragma unroll
                for (int kind = 0; kind < 3; ++kind)
#pragma unroll
                    for (int ct = 0; ct < 4; ++ct) {
                        const bf16* lb = LoraB + ((size_t)((h * 3 + kind) * 4 + ct) * 8 * 64 + lane) * 8;
                        f32x4 a4 = z4;
#pragma unroll
                        for (int ks = (kind == 0 ? 0 : kind == 1 ? 2 : 4); ks < (kind == 0 ? 2 : kind == 1 ? 4 : 8); ++ks) a4 = __builtin_amdgcn_mfma_f32_16x16x32_bf16(af[ks], *(const bf16x8*)(lb + ks * 512), a4, 0, 0, 0);
#pragma unroll
                        for (int e = 0; e < 4; ++e) tmpL[kind * 1088 + (4 * g + e) * 68 + 16 * ct + l15] = a4[e];
                    }
            }
            asm volatile("s_waitcnt lgkmcnt(0)" ::: "memory");
            float cl[16], eP[16];
            {
                float lwv[16], rl[16], kl[16], vl[16], kn[16], av[16];
                const bool hp = (mrow & (SEQ - 1)) != 0;
                const bf16* ub = U + mrow * INW + 1024 + hc;
#pragma unroll
                for (int hh = 0; hh < 2; ++hh) {
#pragma unroll
                    for (int a3 = 0; a3 < 3; ++a3) {
                        const u32x4 cu = *(const u32x4*)(ub + 512 * a3 + 8 * hh); u32x4 pu = *(const u32x4*)(ub - (hp ? INW : 0) + 512 * a3 + 8 * hh); if (!hp) pu = (u32x4){0u, 0u, 0u, 0u};
                        const f32x4 m0 = *(const f32x4*)(args.in[I_MU] + 512 * a3 + hc + 8 * hh), m1 = *(const f32x4*)(args.in[I_MU] + 512 * a3 + hc + 8 * hh + 4);
                        float o8[8];
#pragma unroll
                        for (int q = 0; q < 4; ++q) { const float c0 = bflo(cu[q]), c1 = bfhi(cu[q]), p0 = bflo(pu[q]), p1 = bfhi(pu[q]); const float mm0 = q < 2 ? m0[2 * q] : m1[2 * q - 4], mm1 = q < 2 ? m0[2 * q + 1] : m1[2 * q - 3];
                            o8[2 * q] = c0 + (p0 - c0) * mm0; o8[2 * q + 1] = c1 + (p1 - c1) * mm1; }
#pragma unroll
                        for (int q = 0; q < 8; ++q) { if (a3 == 0) rl[8 * hh + q] = o8[q]; else if (a3 == 1) kl[8 * hh + q] = o8[q]; else vl[8 * hh + q] = o8[q]; }
                    }
                }
                float gv[16];
#pragma unroll
                for (int j4 = 0; j4 < 4; ++j4) { const f32x4 xl = *(const LAS f32x4*)(tmpL + te * 68 + 16 * kq + 4 * j4), xa = *(const LAS f32x4*)(tmpL + 1088 + te * 68 + 16 * kq + 4 * j4), xg = *(const LAS f32x4*)(tmpL + 2176 + te * 68 + 16 * kq + 4 * j4);
                    const f32x4 w0v = *(const f32x4*)(args.in[I_W0] + hc + 4 * j4), a0v = *(const f32x4*)(args.in[I_A0] + hc + 4 * j4);
#pragma unroll
                    for (int q = 0; q < 4; ++q) { const float wq = -softplus_fast(-(xl[q] + w0v[q])) - 0.5f; lwv[4 * j4 + q] = -__expf(wq); av[4 * j4 + q] = sigmoid_f(xa[q] + a0v[q]); gv[4 * j4 + q] = xg[q]; } }
                asm volatile("s_waitcnt lgkmcnt(0)" ::: "memory");
                float ss = 0.f;
#pragma unroll
                for (int j4 = 0; j4 < 4; ++j4) { const f32x4 kk4 = *(const f32x4*)(args.in[I_KK] + hc + 4 * j4);
#pragma unroll
                    for (int q = 0; q < 4; ++q) { kn[4 * j4 + q] = kl[4 * j4 + q] * kk4[q]; ss += kn[4 * j4 + q] * kn[4 * j4 + q]; } }
                ss += __shfl_xor(ss, 1); ss += __shfl_xor(ss, 2);
                const float kinv = rsq_f(fmaxf(ss, 1e-24f));
#pragma unroll
                for (int j = 0; j < 16; ++j) { float x = lwv[j];
#pragma unroll
                    for (int sft = 4; sft < 64; sft <<= 1) { const float y = __shfl_up(x, sft); if (lane >= sft) x += y; }
                    cl[j] = x; }
                float bon = 0.f;
                u32x4 pa[2], pb[2], pk[2], pr[2];
#pragma unroll
                for (int j4 = 0; j4 < 4; ++j4) {
                    const f32x4 ka = *(const f32x4*)(args.in[I_KA] + hc + 4 * j4), rk = *(const f32x4*)(args.in[I_RK] + hc + 4 * j4);
                    float at4[4], bt4[4], kt4[4], rt4[4];
#pragma unroll
                    for (int q = 0; q < 4; ++q) { const int j = 4 * j4 + q;
                        const float p = __expf(cl[j]), pn = __expf(-cl[j]), pm1 = __expf(cl[j] - lwv[j]); eP[j] = p;
                        const float knj = kn[j] * kinv;
                        const float kp = kl[j] * (1.0f + (av[j] - 1.0f) * ka[q]);
                        at4[q] = -knj * pm1; bt4[q] = knj * av[j] * pn; kt4[q] = kp * pn; rt4[q] = rl[j] * p;
                        bon += rl[j] * kp * rk[q];
                        const int kk = 16 * kq + j;
                        ATt[kk * 16 + te] = (bf16)f2bf(at4[q]); BTt[kk * 16 + te] = (bf16)f2bf(bt4[q]); KTt[kk * 16 + te] = (bf16)f2bf(kt4[q]); VTt[kk * 16 + te] = (bf16)f2bf(vl[j]); }
                    const int hh = j4 >> 1, w2 = (j4 & 1) * 2;
                    pa[hh][w2] = pk2(at4[0], at4[1]); pa[hh][w2 + 1] = pk2(at4[2], at4[3]); pb[hh][w2] = pk2(bt4[0], bt4[1]); pb[hh][w2 + 1] = pk2(bt4[2], bt4[3]);
                    pk[hh][w2] = pk2(kt4[0], kt4[1]); pk[hh][w2 + 1] = pk2(kt4[2], kt4[3]); pr[hh][w2] = pk2(rt4[0], rt4[1]); pr[hh][w2 + 1] = pk2(rt4[2], rt4[3]);
                }
#pragma unroll
                for (int hh = 0; hh < 2; ++hh) { const int po = te * 64 + 8 * ((2 * kq + hh) ^ (te & 7));
                    *(LAS u32x4*)(Arm + po) = pa[hh]; *(LAS u32x4*)(Brm + po) = pb[hh]; *(LAS u32x4*)(Krm + po) = pk[hh]; *(LAS u32x4*)(Rrm + po) = pr[hh]; }
                bon += __shfl_xor(bon, 1); bon += __shfl_xor(bon, 2);
                f32x4 lbv[4], lgv[4];
#pragma unroll
                for (int j4 = 0; j4 < 4; ++j4) { lbv[j4] = *(const f32x4*)(args.in[I_LNB] + hc + 4 * j4); lgv[j4] = *(const f32x4*)(args.in[I_LNG] + hc + 4 * j4); }
#pragma unroll
                for (int j4 = 0; j4 < 4; ++j4) { const f32x4 lb = lbv[j4], lgn = lgv[j4]; const int j0 = 4 * j4;
                    u32x2 ow, gw2; ow.x = pk2((lb.x + vl[j0] * bon) * gv[j0], (lb.y + vl[j0 + 1] * bon) * gv[j0 + 1]); ow.y = pk2((lb.z + vl[j0 + 2] * bon) * gv[j0 + 2], (lb.w + vl[j0 + 3] * bon) * gv[j0 + 3]);
                    gw2.x = pk2(lgn.x * gv[j0], lgn.y * gv[j0 + 1]); gw2.y = pk2(lgn.z * gv[j0 + 2], lgn.w * gv[j0 + 3]);
                    *(u32x2*)((bf16*)(ws + WS_ADD) + off + j0) = ow; *(u32x2*)((bf16*)(ws + WS_G) + off + j0) = gw2; }
            }
            asm volatile("s_waitcnt lgkmcnt(0)" ::: "memory");
            {
                bf16x8 fa[2], fr[2], fb[2], fk[2];
#pragma unroll
                for (int ks = 0; ks < 2; ++ks) { const int po = l15 * 64 + 8 * ((4 * ks + g) ^ (l15 & 7));
                    fa[ks] = *(const LAS bf16x8*)(Arm + po); fr[ks] = *(const LAS bf16x8*)(Rrm + po); fb[ks] = *(const LAS bf16x8*)(Brm + po); fk[ks] = *(const LAS bf16x8*)(Krm + po); }
                f32x4 mab = z4, mak = z4, mrb = z4, mrk = z4;
#pragma unroll
                for (int ks = 0; ks < 2; ++ks) { mab = __builtin_amdgcn_mfma_f32_16x16x32_bf16(fb[ks], fa[ks], mab, 0, 0, 0); mak = __builtin_amdgcn_mfma_f32_16x16x32_bf16(fk[ks], fa[ks], mak, 0, 0, 0);
                    mrb = __builtin_amdgcn_mfma_f32_16x16x32_bf16(fb[ks], fr[ks], mrb, 0, 0, 0); mrk = __builtin_amdgcn_mfma_f32_16x16x32_bf16(fk[ks], fr[ks], mrk, 0, 0, 0); }
#pragma unroll
                for (int e = 0; e < 4; ++e) { const int i = 4 * g + e; if (!(i < l15)) { mab[e] = 0.f; mak[e] = 0.f; } if (!(i <= l15)) { mrb[e] = 0.f; mrk[e] = 0.f; } }
                asm volatile("s_waitcnt lgkmcnt(0)" ::: "memory");
#pragma unroll
                for (int e = 0; e < 4; ++e) MabT[(4 * g + e) * 16 + l15] = mab[e];
                u32x2 w; w.x = pk2(mak[0], mak[1]); w.y = pk2(mak[2], mak[3]); *(LAS u32x2*)(Mak + l15 * 16 + 4 * g) = w;
                w.x = pk2(mrb[0], mrb[1]); w.y = pk2(mrb[2], mrb[3]); *(LAS u32x2*)(Mrb + l15 * 16 + 4 * g) = w;
                w.x = pk2(mrk[0], mrk[1]); w.y = pk2(mrk[2], mrk[3]); *(LAS u32x2*)(Mrk + l15 * 16 + 4 * g) = w;
                if (te == 15) {
#pragma unroll
                    for (int j = 0; j < 16; ++j) PLs[16 * kq + j] = eP[j]; }
            }
            asm volatile("s_waitcnt lgkmcnt(0)" ::: "memory");
            {
                f32x4 mq[15][4];
#pragma unroll
                for (int j = 0; j < 15; ++j)
#pragma unroll
                    for (int q = 0; q < 4; ++q) if (4 * q + 3 > j) mq[j][q] = *(const LAS f32x4*)(MabT + j * 16 + 4 * q);
                float y[16];
#pragma unroll
                for (int j = 15; j >= 0; --j) {
                    float acc = (j == l15) ? 1.0f : 0.0f;
#pragma unroll
                    for (int i = j + 1; i < 16; ++i) acc += y[i] * mq[j < 15 ? j : 0][i >> 2][i & 3];
                    y[j] = acc;
                }
                if (g == 0) { u32x4 t0, t1; t0.x = pk2(y[0], y[1]); t0.y = pk2(y[2], y[3]); t0.z = pk2(y[4], y[5]); t0.w = pk2(y[6], y[7]); t1.x = pk2(y[8], y[9]); t1.y = pk2(y[10], y[11]); t1.z = pk2(y[12], y[13]); t1.w = pk2(y[14], y[15]);
                    *(LAS u32x4*)(Tm + l15 * 16) = t0; *(LAS u32x4*)(Tm + l15 * 16 + 8) = t1; }
            }
            asm volatile("s_waitcnt lgkmcnt(0)" ::: "memory");
            {
                const bool act = g < 2; const int fo = l15 * 16 + 8 * g;
                const bf16x8 fT = act ? *(const LAS bf16x8*)(Tm + fo) : z8, fMak = act ? *(const LAS bf16x8*)(Mak + fo) : z8, fMrb = act ? *(const LAS bf16x8*)(Mrb + fo) : z8, fMrk = act ? *(const LAS bf16x8*)(Mrk + fo) : z8;
                bf16x8 fV[4], fQ1[4], fAh[4], fBT[4], fKT[4];
#pragma unroll
                for (int vt = 0; vt < 4; ++vt) { fV[vt] = act ? *(const LAS bf16x8*)(VTt + vt * 256 + fo) : z8; fBT[vt] = act ? *(const LAS bf16x8*)(BTt + vt * 256 + fo) : z8; fKT[vt] = act ? *(const LAS bf16x8*)(KTt + vt * 256 + fo) : z8; }
#pragma unroll
                for (int vt = 0; vt < 4; ++vt) { const f32x4 q0 = __builtin_amdgcn_mfma_f32_16x16x32_bf16(fMak, fV[vt], z4, 0, 0, 0);
                    u32x2 w; w.x = pk2(q0[0], q0[1]); w.y = pk2(q0[2], q0[3]); *(LAS u32x2*)(Q0T + vt * 256 + l15 * 16 + 4 * g) = w; }
#pragma unroll
                for (int kt = 0; kt < 4; ++kt) { const bf16x8 fA = act ? *(const LAS bf16x8*)(ATt + kt * 256 + fo) : z8; const f32x4 ah = __builtin_amdgcn_mfma_f32_16x16x32_bf16(fT, fA, z4, 0, 0, 0);
                    u32x2 w; w.x = pk2(ah[0], ah[1]); w.y = pk2(ah[2], ah[3]); *(LAS u32x2*)(ATt + kt * 256 + l15 * 16 + 4 * g) = w; }
                asm volatile("s_waitcnt lgkmcnt(0)" ::: "memory");
#pragma unroll
                for (int vt = 0; vt < 4; ++vt) { const bf16x8 fQ0 = act ? *(const LAS bf16x8*)(Q0T + vt * 256 + fo) : z8; const f32x4 q1 = __builtin_amdgcn_mfma_f32_16x16x32_bf16(fT, fQ0, z4, 0, 0, 0);
                    u32x2 w; w.x = pk2(q1[0], q1[1]); w.y = pk2(q1[2], q1[3]); *(LAS u32x2*)(Q0T + vt * 256 + l15 * 16 + 4 * g) = w; }
                asm volatile("s_waitcnt lgkmcnt(0)" ::: "memory");
#pragma unroll
                for (int vt = 0; vt < 4; ++vt) { fQ1[vt] = act ? *(const LAS bf16x8*)(Q0T + vt * 256 + fo) : z8; fAh[vt] = act ? *(const LAS bf16x8*)(ATt + vt * 256 + fo) : z8; }
                bf16* rp = (bf16*)(ws + WS_RP) + (size_t)un * 1024 + l15 * 64;
#pragma unroll
                for (int kt = 0; kt < 4; ++kt) {
                    const u32x2 rr = *(const LAS u32x2*)(Rrm + l15 * 64 + 8 * ((2 * kt + (g >> 1)) ^ (l15 & 7)) + 4 * (g & 1));
                    f32x4 ini; ini[0] = bflo(rr.x); ini[1] = bfhi(rr.x); ini[2] = bflo(rr.y); ini[3] = bfhi(rr.y);
                    const f32x4 rh = __builtin_amdgcn_mfma_f32_16x16x32_bf16(fAh[kt], fMrb, ini, 0, 0, 0);
                    u32x2 w; w.x = pk2(rh[0], rh[1]); w.y = pk2(rh[2], rh[3]); *(u32x2*)(rp + 32 * (kt >> 1) + 8 * g + 4 * (kt & 1)) = w;
                }
#pragma unroll
                for (int vt = 0; vt < 4; ++vt) { f32x4 y1 = __builtin_amdgcn_mfma_f32_16x16x32_bf16(fMrb, fQ1[vt], z4, 0, 0, 0); y1 = __builtin_amdgcn_mfma_f32_16x16x32_bf16(fMrk, fV[vt], y1, 0, 0, 0);
                    *(f32x4*)((float*)(ws + WS_Y1F) + ((size_t)(un * 4 + vt) * 64 + lane) * 4) = y1; }
                LAS bf16* tgs = (LAS bf16*)(wl + 8192);
#pragma unroll
                for (int krt = 0; krt < 4; ++krt) { const float pl = PLs[16 * krt + l15];
#pragma unroll
                    for (int kct = 0; kct < 4; ++kct) { f32x4 ga = __builtin_amdgcn_mfma_f32_16x16x32_bf16(fAh[kct], fBT[krt], z4, 0, 0, 0);
                        if (kct == krt) {
#pragma unroll
                            for (int e = 0; e < 4; ++e) if (4 * g + e == l15) ga[e] += 1.0f; }
                        u32x2 w; w.x = pk2(ga[0] * pl, ga[1] * pl); w.y = pk2(ga[2] * pl, ga[3] * pl);
                        *(LAS u32x2*)(tgs + (16 * krt + l15) * 64 + 32 * (kct >> 1) + 8 * g + 4 * (kct & 1)) = w; } }
                { u32x4* gp16 = (u32x4*)((bf16*)(ws + WS_GP) + (size_t)un * 4096);
#pragma unroll
                  for (int i = 0; i < 8; ++i) gp16[i * 64 + lane] = *(const LAS u32x4*)(tgs + (i * 64 + lane) * 8); }
#pragma unroll
                for (int mt = 0; mt < 4; ++mt) { const f32x4 pl4 = *(const LAS f32x4*)(PLs + 16 * mt + 4 * g);
#pragma unroll
                    for (int vt = 0; vt < 4; ++vt) { f32x4 ha = __builtin_amdgcn_mfma_f32_16x16x32_bf16(fBT[mt], fQ1[vt], z4, 0, 0, 0); ha = __builtin_amdgcn_mfma_f32_16x16x32_bf16(fKT[mt], fV[vt], ha, 0, 0, 0);
                        u32x2 w; w.x = pk2(ha[0] * pl4[0], ha[1] * pl4[1]); w.y = pk2(ha[2] * pl4[2], ha[3] * pl4[3]);
                        *(u32x2*)((bf16*)(ws + WS_HF) + ((size_t)((un * 4 + vt) * 4 + mt) * 64 + lane) * 4) = w; } }
            }
            asm volatile("s_waitcnt lgkmcnt(0)" ::: "memory");
        }
        asm volatile("s_waitcnt vmcnt(0)" ::: "memory");
        { const int ltid = fresh_tid() & 63, l15 = ltid & 15, g = ltid >> 4, lane = ltid;
#define CP_LOADG(gf_, j_) do { const bf16* gp_ = (const bf16*)(ws + WS_GP) + ((size_t)u64 * 4 + (j_)) * 4096 + l15 * 64 + 8 * g; \
            _Pragma("unroll") for (int mt = 0; mt < 4; ++mt) { gf_[mt][0] = *(const bf16x8*)(gp_ + mt * 1024); gf_[mt][1] = *(const bf16x8*)(gp_ + mt * 1024 + 32); } } while (0)
#define CP_LOADH(hf_, j_) do { _Pragma("unroll") for (int sl = 0; sl < 4; ++sl) _Pragma("unroll") for (int mt = 0; mt < 4; ++mt) \
            hf_[sl][mt] = *(const u32x2*)((const bf16*)(ws + WS_HF) + ((size_t)((((size_t)u64 * 4 + (j_)) * 4 + sl) * 4 + mt) * 64 + lane) * 4); } while (0)
#define CP_STEP(gf_, hf_, useh_) do { _Pragma("unroll") for (int sl = 0; sl < 4; ++sl) { bf16x8 zb[2]; RW_ZB(z[sl], zb); \
            _Pragma("unroll") for (int mt = 0; mt < 4; ++mt) { f32x4 a_ = (f32x4){0.f, 0.f, 0.f, 0.f}; \
                if (useh_) { a_[0] = bflo(hf_[sl][mt].x); a_[1] = bfhi(hf_[sl][mt].x); a_[2] = bflo(hf_[sl][mt].y); a_[3] = bfhi(hf_[sl][mt].y); } \
                a_ = __builtin_amdgcn_mfma_f32_16x16x32_bf16(gf_[mt][0], zb[0], a_, 0, 0, 0); a_ = __builtin_amdgcn_mfma_f32_16x16x32_bf16(gf_[mt][1], zb[1], a_, 0, 0, 0); z[sl][mt] = a_; } } } while (0)
        {
            f32x4 z[4][4];
#pragma unroll
            for (int sl = 0; sl < 4; ++sl)
#pragma unroll
                for (int mt = 0; mt < 4; ++mt)
#pragma unroll
                    for (int e = 0; e < 4; ++e) z[sl][mt][e] = (sl == mt && 4 * g + e == l15) ? 1.0f : 0.0f;
            bf16x8 gA[4][2], gB[4][2]; u32x2 hdum[4][4];
            CP_LOADG(gA, 0); CP_LOADG(gB, 1);
            CP_STEP(gA, hdum, false); CP_LOADG(gA, 2);
            CP_STEP(gB, hdum, false); CP_LOADG(gB, 3);
            CP_STEP(gA, hdum, false);
            CP_STEP(gB, hdum, false);
            LAS bf16* tg = (LAS bf16*)(lds + wave * 16384);
#pragma unroll
            for (int sl = 0; sl < 4; ++sl) { const int pc = 32 * (sl >> 1) + 8 * (l15 >> 2) + 4 * (sl & 1) + (l15 & 3);
#pragma unroll
                for (int mt = 0; mt < 4; ++mt)
#pragma unroll
                    for (int e = 0; e < 4; ++e) tg[(16 * mt + 4 * g + e) * 64 + pc] = (bf16)f2bf(z[sl][mt][e]); }
            u32x4* gc = (u32x4*)((bf16*)(ws + WS_GC) + (size_t)u64 * 4096);
#pragma unroll
            for (int i = 0; i < 8; ++i) gc[i * 64 + lane] = *(const LAS u32x4*)(tg + (i * 64 + lane) * 8);
        }
        {
            f32x4 z[4][4];
#pragma unroll
            for (int sl = 0; sl < 4; ++sl)
#pragma unroll
                for (int mt = 0; mt < 4; ++mt) z[sl][mt] = (f32x4){0.f, 0.f, 0.f, 0.f};
            bf16x8 gA[4][2], gB[4][2]; u32x2 hA[4][4], hB[4][4];
            CP_LOADG(gA, 0); CP_LOADH(hA, 0); CP_LOADG(gB, 1); CP_LOADH(hB, 1);
            CP_STEP(gA, hA, true); CP_LOADG(gA, 2); CP_LOADH(hA, 2);
            CP_STEP(gB, hB, true); CP_LOADG(gB, 3); CP_LOADH(hB, 3);
            CP_STEP(gA, hA, true);
            CP_STEP(gB, hB, true);
#pragma unroll
            for (int sl = 0; sl < 4; ++sl)
#pragma unroll
                for (int mt = 0; mt < 4; ++mt) { u32x2 w; w.x = pk2(z[sl][mt][0], z[sl][mt][1]); w.y = pk2(z[sl][mt][2], z[sl][mt][3]);
                    *(u32x2*)((bf16*)(ws + WS_HC) + ((size_t)((u64 * 4 + sl) * 4 + mt) * 64 + lane) * 4) = w; }
        }
#undef CP_LOADG
#undef CP_LOADH
#undef CP_STEP
        }
        }
    }
    SEAM(3);


    if (IN(4)) { PHASE_IDS;
        if (!(bid < 128 && wave == 0)) {
            const int wi = bid < 128 ? bid * 7 + (wave - 1) : 896 + (bid - 128) * 8 + wave, NW = 896 + (G - 128) * 8;
        } else {
            const int l15 = lane & 15, g = lane >> 4, bh = bid >> 2, vs = bid & 3;
            f32x4 z[4];
#pragma unroll
            for (int mt = 0; mt < 4; ++mt) z[mt] = (f32x4){0.f, 0.f, 0.f, 0.f};
            bf16x8 gA[4][2], gB[4][2], gC[4][2], gD[4][2]; u32x2 hA[4], hB[4], hC[4], hD[4];
#define SC_LOAD(gf, hf, C) do { const size_t u64_ = (size_t)bh * 64 + (C); const bf16* gp_ = (const bf16*)(ws + WS_GC) + u64_ * 4096 + l15 * 64 + 8 * g; \
                _Pragma("unroll") for (int mt = 0; mt < 4; ++mt) { gf[mt][0] = *(const bf16x8*)(gp_ + mt * 1024); gf[mt][1] = *(const bf16x8*)(gp_ + mt * 1024 + 32); \
                    hf[mt] = *(const u32x2*)((const bf16*)(ws + WS_HC) + ((size_t)((u64_ * 4 + vs) * 4 + mt) * 64 + lane) * 4); } } while (0)
#define SC_STEP(gf, hf, C) do { const size_t u64_ = (size_t)bh * 64 + (C); bf16* zs_ = (bf16*)(ws + WS_ZS) + ((size_t)((u64_ * 4 + vs) * 4) * 64 + lane) * 4; \
                _Pragma("unroll") for (int mt = 0; mt < 4; ++mt) { u32x2 zw_; zw_.x = pk2(z[mt][0], z[mt][1]); zw_.y = pk2(z[mt][2], z[mt][3]); *(u32x2*)(zs_ + mt * 256) = zw_; } \
                bf16x8 zb[2]; RW_ZB(z, zb); \
                _Pragma("unroll") for (int mt = 0; mt < 4; ++mt) { f32x4 a; a[0] = bflo(hf[mt].x); a[1] = bfhi(hf[mt].x); a[2] = bflo(hf[mt].y); a[3] = bfhi(hf[mt].y); \
                    a = __builtin_amdgcn_mfma_f32_16x16x32_bf16(gf[mt][0], zb[0], a, 0, 0, 0); a = __builtin_amdgcn_mfma_f32_16x16x32_bf16(gf[mt][1], zb[1], a, 0, 0, 0); z[mt] = a; } } while (0)
            SC_LOAD(gA, hA, 0); SC_LOAD(gB, hB, 1); SC_LOAD(gC, hC, 2);
#pragma unroll 1
            for (int C = 0; C < 64; C += 4) {
                SC_LOAD(gD, hD, C + 3);
                SC_STEP(gA, hA, C);
                if (C + 4 < 64) SC_LOAD(gA, hA, C + 4);
                SC_STEP(gB, hB, C + 1);
                if (C + 5 < 64) SC_LOAD(gB, hB, C + 5);
                SC_STEP(gC, hC, C + 2);
                if (C + 6 < 64) SC_LOAD(gC, hC, C + 6);
                SC_STEP(gD, hD, C + 3);
            }
#undef SC_LOAD
#undef SC_STEP
        }
    }
    if (IN(4)) { PHASE_IDS;
        if (bid < 32 && wave == 1) { const int bc = bid; const f32x2* ag = (const f32x2*)((const float*)(ws + WS_AP)) + (size_t)(bc * 64) * 64 + lane;
            float* car = (float*)(ws + WS_AP + 4 * MiB) + (size_t)(bc * 64) * 64 + lane; float hst = 0.f;
#pragma unroll 16
            for (int sg = 0; sg < 64; ++sg) { const f32x2 ab = ag[(size_t)sg * 64]; car[(size_t)sg * 64] = hst; hst = ab.x * hst + ab.y; } }
    }
    if (IN(4)) { PHASE_IDS;
        bf16* WKt = HN; bf16* VWt = HN + (size_t)4 * 1024 * 1024;
        __syncthreads();
        if (bid >= 128 && bid < 192) { pg8::FoldSched<0> S; S.A = (const char*)KM; S.B = (const char*)Wq_t; S.G = 64; S.c = bid - 128; EpiFold<0> E{(unsigned char*)WKt}; pg8::gemm_phase(lds, 256, S, E, wv0, 1024); }
        else if (bid >= 192) { pg8::FoldSched<1> S; S.A = (const char*)Wo_t; S.B = (const char*)VT; S.G = 64; S.c = bid - 192; EpiFold<1> E{(unsigned char*)VWt}; pg8::gemm_phase(lds, 256, S, E, wv0, 1024); }
    }
    SEAM(4);

    if (IN(5)) { PHASE_IDS;
        {
            for (int lu = gw; lu < (M / 64) * 8; lu += NGW) {
                const int seg = lu >> 3, nb = lu & 7, rr = lane >> 3, cq = lane & 7;
                const float* cp = (const float*)(ws + WS_AP + 4 * MiB) + ((size_t)(((seg >> 6) * 8 + nb) * 64 + (seg & 63)) * 64 + 8 * cq);
                const f32x4 c0 = *(const f32x4*)cp, c1 = *(const f32x4*)(cp + 4);
#pragma unroll
                for (int it = 0; it < 8; ++it) { const size_t m = (size_t)seg * 64 + 8 * it + rr; const size_t o = m * 512 + nb * 64 + 8 * cq;
                    const u32x4 pw = *(const u32x4*)(LA + o), hw = *(const u32x4*)(LB + o), gw_ = *(const u32x4*)(U + m * INW + 512 + nb * 64 + 8 * cq);
                    float y[8];
#pragma unroll
                    for (int q = 0; q < 4; ++q) { const float ca = q < 2 ? c0[2 * q] : c1[2 * q - 4], cb = q < 2 ? c0[2 * q + 1] : c1[2 * q - 3];
                        y[2 * q] = (bflo(hw[q]) + bflo(pw[q]) * ca) * gelu_tanh_f(bflo(gw_[q])); y[2 * q + 1] = (bfhi(hw[q]) + bfhi(pw[q]) * cb) * gelu_tanh_f(bfhi(gw_[q])); }
                    u32x4 w; w.x = pk2(y[0], y[1]); w.y = pk2(y[2], y[3]); w.z = pk2(y[4], y[5]); w.w = pk2(y[6], y[7]);
                    *(u32x4*)(CAT + m * 1024 + nb * 64 + 8 * cq) = w; }
            }
        }
        const int l15 = lane & 15, g = lane >> 4;
        LAS bf16* tGL = (LAS bf16*)(lds + wave * 16384); LAS bf16* tAD = tGL + 1024; LAS bf16* tOUT = tGL + 2048;
        const int ct = lane >> 3, cc = lane & 7;
        for (int u64 = gw; u64 < NB * NH * (SEQ / 64); u64 += NGW) {
            const int bh = u64 >> 6, C = u64 & 63, b = bh >> 3, h = bh & 7;
            f32x4 z[4][4];
#pragma unroll
            for (int sl = 0; sl < 4; ++sl)
#pragma unroll
                for (int mt = 0; mt < 4; ++mt) { const u32x2 zw = *(const u32x2*)((const bf16*)(ws + WS_ZS) + ((size_t)((u64 * 4 + sl) * 4 + mt) * 64 + lane) * 4); z[sl][mt] = (f32x4){bflo(zw.x), bfhi(zw.x), bflo(zw.y), bfhi(zw.y)}; }
#pragma unroll 1
            for (int j = 0; j < 4; ++j) {
                const size_t un = (size_t)u64 * 4 + j; const size_t m0 = (size_t)b * SEQ + (C * 4 + j) * 16;
                const bf16* rp = (const bf16*)(ws + WS_RP) + un * 1024 + l15 * 64 + 8 * g;
                const bf16x8 rf0 = *(const bf16x8*)rp, rf1 = *(const bf16x8*)(rp + 32);
                f32x4 y[4];
#pragma unroll
                for (int sl = 0; sl < 4; ++sl) y[sl] = *(const f32x4*)((const float*)(ws + WS_Y1F) + ((size_t)(un * 4 + sl) * 64 + lane) * 4);
                const size_t rg = (m0 + ct) * 512 + h * 64 + 8 * cc;
                const u32x4 gl0 = *(const u32x4*)((const bf16*)(ws + WS_G) + rg), gl1 = *(const u32x4*)((const bf16*)(ws + WS_G) + rg + 8 * 512);
                const u32x4 ad0 = *(const u32x4*)((const bf16*)(ws + WS_ADD) + rg), ad1 = *(const u32x4*)((const bf16*)(ws + WS_ADD) + rg + 8 * 512);
                bf16x8 gf[4][2]; u32x2 hfr[4][4];
                if (j < 3) {
                    const bf16* gp = (const bf16*)(ws + WS_GP) + un * 4096 + l15 * 64 + 8 * g;
#pragma unroll
                    for (int mt = 0; mt < 4; ++mt) { gf[mt][0] = *(const bf16x8*)(gp + mt * 1024); gf[mt][1] = *(const bf16x8*)(gp + mt * 1024 + 32); }
#pragma unroll
                    for (int sl = 0; sl < 4; ++sl)
#pragma unroll
                        for (int mt = 0; mt < 4; ++mt) hfr[sl][mt] = *(const u32x2*)((const bf16*)(ws + WS_HF) + ((size_t)((un * 4 + sl) * 4 + mt) * 64 + lane) * 4);
                }
                *(LAS u32x4*)(tGL + ct * 64 + 8 * cc) = gl0; *(LAS u32x4*)(tGL + (ct + 8) * 64 + 8 * cc) = gl1;
                *(LAS u32x4*)(tAD + ct * 64 + 8 * cc) = ad0; *(LAS u32x4*)(tAD + (ct + 8) * 64 + 8 * cc) = ad1;
                bf16x8 zb[4][2];
#pragma unroll
                for (int sl = 0; sl < 4; ++sl) { RW_ZB(z[sl], zb[sl]);
                    y[sl] = __builtin_amdgcn_mfma_f32_16x16x32_bf16(rf0, zb[sl][0], y[sl], 0, 0, 0); y[sl] = __builtin_amdgcn_mfma_f32_16x16x32_bf16(rf1, zb[sl][1], y[sl], 0, 0, 0); }
#pragma unroll
                for (int e = 0; e < 4; ++e) {
                    float s1 = (y[0][e] + y[1][e]) + (y[2][e] + y[3][e]);
                    s1 += __shfl_xor(s1, 1); s1 += __shfl_xor(s1, 2); s1 += __shfl_xor(s1, 4); s1 += __shfl_xor(s1, 8);
                    const float mean = s1 * (1.0f / 64.0f);
                    float d0 = y[0][e] - mean, d1 = y[1][e] - mean, d2 = y[2][e] - mean, d3 = y[3][e] - mean;
                    float s2 = (d0 * d0 + d1 * d1) + (d2 * d2 + d3 * d3);
                    s2 += __shfl_xor(s2, 1); s2 += __shfl_xor(s2, 2); s2 += __shfl_xor(s2, 4); s2 += __shfl_xor(s2, 8);
                    const float rstd = rsq_f(s2 * (1.0f / 64.0f) + GN_EPS);
                    const float dd[4] = {d0, d1, d2, d3};
#pragma unroll
                    for (int sl = 0; sl < 4; ++sl) { const int ti_ = (4 * g + e) * 64 + 16 * sl + l15;
                        const float o = dd[sl] * rstd * bf2f(tGL[ti_]) + bf2f(tAD[ti_]); tOUT[ti_] = (bf16)f2bf(o); }
                }
                { bf16* cp = CAT + (m0 + ct) * 1024 + 512 + h * 64 + 8 * cc;
                  *(u32x4*)cp = *(const LAS u32x4*)(tOUT + ct * 64 + 8 * cc); *(u32x4*)(cp + 8 * 1024) = *(const LAS u32x4*)(tOUT + (ct + 8) * 64 + 8 * cc); }
                if (j < 3) {
#pragma unroll
                    for (int sl = 0; sl < 4; ++sl)
#pragma unroll
                        for (int mt = 0; mt < 4; ++mt) { const u32x2 hh = hfr[sl][mt];
                            f32x4 a; a[0] = bflo(hh.x); a[1] = bfhi(hh.x); a[2] = bflo(hh.y); a[3] = bfhi(hh.y);
                            a = __builtin_amdgcn_mfma_f32_16x16x32_bf16(gf[mt][0], zb[sl][0], a, 0, 0, 0); a = __builtin_amdgcn_mfma_f32_16x16x32_bf16(gf[mt][1], zb[sl][1], a, 0, 0, 0); z[sl][mt] = a; }
                }
            }
        }
    }
    SEAM(5);
#undef RW_ZB


    if (IN(6)) { PHASE_IDS;
        pg8::DenseSched S; S.o.init_tiles(M / 256, D / 256, G, bid); S.A = (const char*)CAT; S.B = (const char*)Wout_t; S.tstep = (size_t)256 * D * 2;
        EpiBf16Res<false> E{args.in[I_X], X1, D, (float*)(ws + WS_AP + 2 * MiB), 1.0f, X1F8}; pg8::gemm_phase(lds, D, S, E, wv0);
    }
    SEAM(6);
    if (IN(7)) { PHASE_IDS;
        pg8::BatchBSched S; S.o.init_tiles(M / 256, D / 256, G, bid); S.A = (const char*)X1F8; S.B = (const char*)HN; S.tstep = (size_t)256 * 1024; S.bstep = (size_t)1024 * 1024;
        EpiSoftmax E{(unsigned char*)Qb, 0.0625f * 0.25f, (const float*)(ws + WS_AP + 2 * MiB), (LAS float*)(lds + RING_BYTES + 1024), (LAS float*)(lds + RING_BYTES + 1024 + 4096)};
        pg8::gemm_phase<EpiSoftmax, pg8::BatchBSched, true, true>(lds, 512, S, E, wv0);
    }
    SEAM(7);
    if (IN(8)) { PHASE_IDS;
        pg8::BatchBSched S; S.o.init_tiles(M / 256, D / 256, G, bid); S.A = (const char*)Qb; S.B = (const char*)(HN + (size_t)4 * 1024 * 1024); S.tstep = (size_t)256 * 1024; S.bstep = (size_t)1024 * 1024;
        EpiBf16Res<true> E{X1, X2, D, nullptr, 1.0f / 1024.0f, nullptr}; pg8::gemm_phase<EpiBf16Res<true>, pg8::BatchBSched, true, true>(lds, 512, S, E, wv0);
    }
    SEAM(8);
    if (IN(9)) { PHASE_IDS;
        for (int cid = tid; cid < 2 * NE * 128; cid += NTHREADS) { const int t = cid >> 12, row = (cid >> 7) & 31, c = cid & 127;
            *(LAS u32x4*)(lds + t * 65536 + row * 2048 + ((c ^ (row & 7)) << 4)) = *(const u32x4*)(WrT + (size_t)t * NE * D + row * D + 8 * c); }
        __syncthreads();
        const int l15 = lane & 15, g = lane >> 4;
        LAS float* LG = (LAS float*)(lds + RING_BYTES + 1024 + wave * 2304);
        const float* gfn = args.in[I_NFFG];
        LAS unsigned* cntl = (LAS unsigned*)(lds + RING_BYTES + 640);
        for (int t0 = 0; t0 < M / 16; t0 += G * 4) {
        if (tid < 64) cntl[tid] = 0u;
        __syncthreads();
        if (t0 == 0 && wave >= 4) {
            constexpr int I_DN = 16 * 32, I_GU = 16 * 64;
            for (int r = bid * 4 + (wave - 4); r < CONV_P9; r += G * 4) { const int e = r / I_GU, q = r % I_GU, kb = q / 64, nb = q % 64; const int n0 = 32 * nb;
                const int drow = n0 < 1024 ? (256 * (n0 >> 7) + (n0 & 127)) : (256 * ((n0 - 1024) >> 7) + 128 + ((n0 - 1024) & 127));
                transpose_item_tiled_fp8_nolds(args.in[I_WGU] + (size_t)e * D * 2048, 2048, D, (unsigned char*)Wgu_t + (size_t)e * 2048 * D, 64 * kb, n0, drow, lane); }
            for (int r = bid * 4 + (wave - 4); r < CONV_P9D; r += G * 4) { const int e = r / I_DN, q = r % I_DN, kb = q / 32, nb = q % 32;
                transpose_item_tiled_fp8_nolds(args.in[I_WDN] + (size_t)e * DFF * D, D, DFF, (unsigned char*)Wdn_t + (size_t)e * D * DFF, 64 * kb, 32 * nb, 32 * nb, lane); }
        }
        const int tile = t0 + bid * 4 + wave; const bool active = wave < 4 && tile < M / 16;
        int me = 0, lpos = 0, ai = 0; float mg = 0.f;
        if (active) {
            const int m0 = tile * 16;
            const bf16* xrow = X2 + (size_t)(m0 + l15) * D + 8 * g;
            float ss = 0.f;
#pragma unroll 8
            for (int ks = 0; ks < 32; ++ks) { const u32x4 xw = *(const u32x4*)(xrow + 32 * ks);
#pragma unroll
                for (int q = 0; q < 4; ++q) { const float a = bflo(xw[q]), c = bfhi(xw[q]); ss += a * a + c * c; } }
            ss += __shfl_xor(ss, 16); ss += __shfl_xor(ss, 32);
            const float rstd = rsq_f(ss * (1.f / D) + EPS);
            f32x4 acc0 = (f32x4){0.f, 0.f, 0.f, 0.f}, acc1 = acc0;
            unsigned char* hrow = (unsigned char*)HN + (size_t)(m0 + l15) * D + 8 * g;
#pragma unroll 2
            for (int ks = 0; ks < 32; ++ks) {
                const f32x4 g0 = *(const f32x4*)(gfn + 32 * ks + 8 * g), g1 = *(const f32x4*)(gfn + 32 * ks + 8 * g + 4);
                const u32x4 xw = *(const u32x4*)(xrow + 32 * ks);
                float hf[8];
#pragma unroll
                for (int q = 0; q < 4; ++q) { hf[2 * q] = bflo(xw[q]) * rstd * (q < 2 ? g0[2 * q] : g1[2 * q - 4]); hf[2 * q + 1] = bfhi(xw[q]) * rstd * (q < 2 ? g0[2 * q + 1] : g1[2 * q - 3]); }
                u32x4 hi, lo;
#pragma unroll
                for (int q = 0; q < 4; ++q) { hi[q] = pk2(hf[2 * q], hf[2 * q + 1]); lo[q] = pk2(hf[2 * q] - bflo(hi[q]), hf[2 * q + 1] - bfhi(hi[q])); }
                { u32x2 h8; h8.x = pk4_fp8(hf[0], hf[1], hf[2], hf[3]); h8.y = pk4_fp8(hf[4], hf[5], hf[6], hf[7]); *(u32x2*)(hrow + 32 * ks) = h8; }
                const bf16x8 ah = __builtin_bit_cast(bf16x8, hi), al = __builtin_bit_cast(bf16x8, lo);
                const int c = 4 * ks + g;
#pragma unroll
                for (int nt = 0; nt < 2; ++nt) { const int row = 16 * nt + l15; const int off = row * 2048 + ((c ^ (row & 7)) << 4);
                    const bf16x8 bh = *(const LAS bf16x8*)(lds + off), bl = *(const LAS bf16x8*)(lds + 65536 + off);
                    f32x4 a = nt ? acc1 : acc0;
                    a = __builtin_amdgcn_mfma_f32_16x16x32_bf16(ah, bh, a, 0, 0, 0); a = __builtin_amdgcn_mfma_f32_16x16x32_bf16(ah, bl, a, 0, 0, 0); a = __builtin_amdgcn_mfma_f32_16x16x32_bf16(al, bh, a, 0, 0, 0);
                    if (nt) acc1 = a; else acc0 = a; }
            }
            { const float b0 = args.in[I_BR][l15], b1 = args.in[I_BR][16 + l15];
#pragma unroll
              for (int j = 0; j < 4; ++j) { LG[(4 * g + j) * 33 + l15] = acc0[j] + b0; LG[(4 * g + j) * 33 + 16 + l15] = acc1[j] + b1; } }
            const int rrow = lane >> 2, qq = lane & 3;
            float tv[4] = {-3.0e38f, -3.0e38f, -3.0e38f, -3.0e38f}; int ti[4] = {64, 65, 66, 67};
#define TOP_INS(xv_, xi_) do { float x_ = (xv_); int i_ = (xi_); _Pragma("unroll") for (int p_ = 0; p_ < 4; ++p_) { const bool b_ = x_ > tv[p_] || (x_ == tv[p_] && i_ < ti[p_]); \
                const float ov_ = tv[p_]; const int oi_ = ti[p_]; tv[p_] = b_ ? x_ : ov_; ti[p_] = b_ ? i_ : oi_; x_ = b_ ? ov_ : x_; i_ = b_ ? oi_ : i_; } } while (0)
#pragma unroll
            for (int j = 0; j < 8; ++j) TOP_INS(LG[rrow * 33 + 8 * qq + j], 8 * qq + j);
#pragma unroll
            for (int st = 1; st < 4; st <<= 1) { float pv[4]; int pi[4];
#pragma unroll
                for (int p = 0; p < 4; ++p) { pv[p] = __shfl_xor(tv[p], st); pi[p] = __shfl_xor(ti[p], st); }
#pragma unroll
                for (int p = 0; p < 4; ++p) TOP_INS(pv[p], pi[p]); }
#undef TOP_INS
            const float e1 = __expf(tv[1] - tv[0]), e2 = __expf(tv[2] - tv[0]), e3 = __expf(tv[3] - tv[0]);
            const float inv = rcp_f(1.0f + e1 + e2 + e3);
            me = qq == 0 ? ti[0] : qq == 1 ? ti[1] : qq == 2 ? ti[2] : ti[3];
            mg = (qq == 0 ? 1.0f : qq == 1 ? e1 : qq == 2 ? e2 : e3) * inv;
            lpos = (int)__hip_atomic_fetch_add(cntl + me, 1u, __ATOMIC_RELAXED, __HIP_MEMORY_SCOPE_WORKGROUP);
            ai = (m0 + rrow) * 4 + qq;
        }
        __syncthreads();
        if (tid < NE) { const unsigned c = cntl[tid]; cntl[32 + tid] = c ? atomicAdd(ecnt + 64 * tid, c) : 0u; }
        __syncthreads();
        if (active) { route_e[ai] = me; route_pos[ai] = (int)cntl[32 + me] + lpos; route_g[ai] = mg; }
        __syncthreads();
        }
    }
    SEAM(9);
    if (IN(10)) { PHASE_IDS;
        LAS int* pst = (LAS int*)lds;
        if (tid == 0) { int acc = 0; for (int e = 0; e < NE; ++e) { const int c = (int)__hip_atomic_load(ecnt + 64 * e, __ATOMIC_RELAXED, __HIP_MEMORY_SCOPE_AGENT); pst[e] = acc; pst[64 + e] = c; acc += (c + 255) & ~255; } pst[32] = acc; }
        __syncthreads();
        for (int ai = bid * NTHREADS + tid; ai < NASSIGN; ai += G * NTHREADS) {
            const int e = route_e[ai]; const int row = pst[e] + route_pos[ai]; { u32x2 sg_; sg_.x = (unsigned)ai; sg_.y = __float_as_uint(route_g[ai]); row_sg[row] = sg_; } row_tok[row] = ai >> 2; }
        if (bid < NE) { const int e = bid, c = pst[64 + e], pe = (c + 255) & ~255; for (int p = c + tid; p < pe; p += NTHREADS) { u32x2 sg_; sg_.x = 0xffffffffu; sg_.y = 0u; row_sg[pst[e] + p] = sg_; row_tok[pst[e] + p] = 0; } }
        if (bid == 0 && tid == 0) { int nt = 0; for (int e = 0; e < NE; ++e) { const int n = ((pst[64 + e] + 255) & ~255) >> 8; for (int j = 0; j < n; ++j) tile_tab[16 + nt++] = e; } tile_tab[0] = nt; }
        if (bid == 1 || bid == 2) { const int nt = pst[32] >> 8, nN = bid == 1 ? 8 : 4; int* tab = (int*)(ws + WS_ROUTE + (bid == 1 ? RT_UGU : RT_UDN));
            for (int L = tid; L < nt * nN; L += NTHREADS) { Unit uu; { const int nwg = nt * nN; int wgid = L; { const int q = nwg / 8, r = nwg % 8, xcd = wgid % 8, off = wgid / 8; wgid = (xcd < r ? xcd * (q + 1) : r * (q + 1) + (xcd - r) * q) + off; }
                    const int nig = 8 * nN, gid = wgid / nig, fm = gid * 8, gsz = (nt - fm) < 8 ? (nt - fm) : 8; uu.pm = fm + ((wgid % nig) % gsz); uu.pn = (wgid % nig) / gsz; uu.e = 0; }
                int e = 0; while (e < NE - 1 && (pst[e + 1] >> 8) <= uu.pm) ++e;
                tab[L] = uu.pm | (uu.pn << 12) | (e << 16); } }
        __syncthreads();
    }
    SEAM(10);
    if (IN(11)) {
        const int ntiles = tile_tab[0];
        pg8::MoeGatherSched S; S.o.init_tiles(ntiles, 2048 / 256, G, bid); S.A = (const char*)HN; S.B = (const char*)Wgu_t; S.tile_e = tile_tab + 16; S.utab = (const int*)(ws + WS_ROUTE + RT_UGU); S.rtok = row_tok; S.tstep = (size_t)256 * 1024; S.estep = (size_t)2048 * 1024;
        EpiSwiglu E{ACT, args.in[I_BGU]}; pg8::gemm_phase<EpiSwiglu, pg8::MoeGatherSched, true, true>(lds, 512, S, E, wv0);
        { PHASE_IDS; LAS float* scr = (LAS float*)(lds + wave * 16384); constexpr int I_DN = 16 * 32;
          for (;;) { int c0 = 0; if (lane == 0) c0 = (int)atomicAdd(ctl + CW_CONV, 8u); c0 = __builtin_amdgcn_readfirstlane(c0);
              c0 += CONV_P9D; if (c0 >= NE * I_DN) break;
              for (int r = c0; r < c0 + 8; ++r) { const int e = r / I_DN, q = r % I_DN, kb = q / 32, nb = q % 32;
                  transpose_item_tiled_fp8(args.in[I_WDN] + (size_t)e * DFF * D, D, DFF, (unsigned char*)Wdn_t + (size_t)e * D * DFF, 64 * kb, 32 * nb, 32 * nb, scr, lane); } } }
    }
    SEAM(11);
    if (IN(12)) {
        const int ntiles = tile_tab[0];
        pg8::MoeSched S; S.o.init_tiles(ntiles, D / 256, G, bid); S.A = (const char*)ACT; S.B = (const char*)Wdn_t; S.tile_e = tile_tab + 16; S.utab = (const int*)(ws + WS_ROUTE + RT_UDN); S.tstep = (size_t)256 * 1024; S.estep = (size_t)1024 * 1024;
        EpiDown E{YS, args.in[I_BDN], row_sg}; pg8::gemm_phase<EpiDown, pg8::MoeSched, true, true>(lds, 512, S, E, wv0);
    }
    SEAM(12);
    if (IN(13)) { PHASE_IDS;
        const float* gfin = args.in[I_FNG];
        for (int m = gw; m < M; m += NGW) {
            float v[16]; float s = 0.f;
#pragma unroll
            for (int hf = 0; hf < 2; ++hf) { const u32x4 w = *(const u32x4*)(X2 + (size_t)m * D + 512 * hf + 8 * lane);
#pragma unroll
                for (int q = 0; q < 4; ++q) { v[8 * hf + 2 * q] = bflo(w[q]); v[8 * hf + 2 * q + 1] = bfhi(w[q]); }
#pragma unroll
                for (int k = 0; k < 4; ++k) { const u32x2 y = *(const u32x2*)((const unsigned char*)YS + (size_t)(m * 4 + k) * D + 512 * hf + 8 * lane);
#pragma unroll
                    for (int q = 0; q < 2; ++q) { const auto lo2 = __builtin_amdgcn_cvt_pk_f32_fp8((int)y[q], false), hi2 = __builtin_amdgcn_cvt_pk_f32_fp8((int)y[q], true);
                        v[8 * hf + 4 * q] += lo2[0] * 0.0625f; v[8 * hf + 4 * q + 1] += lo2[1] * 0.0625f; v[8 * hf + 4 * q + 2] += hi2[0] * 0.0625f; v[8 * hf + 4 * q + 3] += hi2[1] * 0.0625f; } } }
#pragma unroll
            for (int j = 0; j < 16; ++j) s += v[j] * v[j];
            const float rstd = rsq_f(wave_sum(s) * (1.f / D) + EPS);
#pragma unroll
            for (int hf = 0; hf < 2; ++hf) { const f32x4 g0 = *(const f32x4*)(gfin + 512 * hf + 8 * lane), g1 = *(const f32x4*)(gfin + 512 * hf + 8 * lane + 4);
                float* o = args.out + (size_t)m * D + 512 * hf + 8 * lane;
                *(f32x4*)o = (f32x4){v[8 * hf] * rstd * g0.x, v[8 * hf + 1] * rstd * g0.y, v[8 * hf + 2] * rstd * g0.z, v[8 * hf + 3] * rstd * g0.w};
                *(f32x4*)(o + 4) = (f32x4){v[8 * hf + 4] * rstd * g1.x, v[8 * hf + 5] * rstd * g1.y, v[8 * hf + 6] * rstd * g1.z, v[8 * hf + 7] * rstd * g1.w}; }
        }
    }
#undef IN
#undef SEAM
}

constexpr int N_PHASES = 14;
extern "C" void kernel_launch(void* const* d_in, const int* in_sizes, int n_in, void* d_out, int out_size, void* d_ws, size_t ws_size, hipStream_t stream) {
    static int grid = 0;
    if (grid == 0) {
        if (n_in != 37 || out_size != M * D || ws_size < WS_END) { fprintf(stderr, "kernel_launch: unexpected shapes (n_in %d, out %d, ws %zu); nothing launched\n", n_in, out_size, ws_size); grid = -1; return; }
        int dev = 0, cus = 0, per_cu = 0;
        if (hipGetDevice(&dev) != hipSuccess || hipDeviceGetAttribute(&cus, hipDeviceAttributeMultiprocessorCount, dev) != hipSuccess) { grid = -1; return; }
        if (hipFuncSetAttribute((const void*)fwd, hipFuncAttributeMaxDynamicSharedMemorySize, LDS_BYTES) != hipSuccess) { fprintf(stderr, "kernel_launch: hipFuncSetAttribute failed\n"); grid = -1; return; }
        if (hipOccupancyMaxActiveBlocksPerMultiprocessor(&per_cu, (const void*)fwd, NTHREADS, LDS_BYTES) != hipSuccess || per_cu < 1) fprintf(stderr, "kernel_launch: occupancy query says %d\n", per_cu);
        (void)hipGetLastError();
        grid = cus > 256 ? 256 : cus;
    }
    if (grid < 0) return;
    if (hipMemsetAsync((char*)d_ws + WS_CTL, 0, CTL_ZERO_BYTES, stream) != hipSuccess) return;
    Args a{};
    for (int i = 0; i < 37; ++i) a.in[i] = (const float*)d_in[i];
    a.out = (float*)d_out; a.ws = (unsigned char*)d_ws;
#if MK_ONE_LAUNCH
    a.ph_lo = 0; a.ph_hi = N_PHASES;
    hipLaunchKernelGGL(fwd, dim3(grid), dim3(NTHREADS), LDS_BYTES, stream, a);
#else
    for (int p = 0; p < N_PHASES; ++p) { a.ph_lo = p; a.ph_hi = p + 1; hipLaunchKernelGGL(fwd, dim3(grid), dim3(NTHREADS), LDS_BYTES, stream, a);
#ifdef PROBE_REPEAT_PHASE
        if (p == PROBE_REPEAT_PHASE) hipLaunchKernelGGL(fwd, dim3(grid), dim3(NTHREADS), LDS_BYTES, stream, a);
#endif
    }
#endif
}
```

```cpp
#include <hip/hip_runtime.h>
#include <cstdio>
#include <cstdint>

#ifndef MK_ONE_LAUNCH
#define MK_ONE_LAUNCH 1
#endif

#define DI __device__ __forceinline__
#define GAS __attribute__((address_space(1)))
#define LAS __attribute__((address_space(3)))
typedef unsigned short bf16;
typedef short bf16x8 __attribute__((ext_vector_type(8)));
typedef int v4i __attribute__((ext_vector_type(4)));
typedef int v8i __attribute__((ext_vector_type(8)));
typedef float f32x4 __attribute__((ext_vector_type(4)));
typedef float f32x2 __attribute__((ext_vector_type(2)));
typedef unsigned u32x4 __attribute__((ext_vector_type(4)));
typedef unsigned u32x2 __attribute__((ext_vector_type(2)));

constexpr int D = 1024, NB = 4, SEQ = 4096, M = NB * SEQ;
constexpr int MEML = 256, MROWS = NB * MEML;
constexpr int LRU_W = 512, RW = 512, NH = 8, HD = 64;
constexpr int INW = 2816;
constexpr int XH = 4, XHD = 256;
constexpr int NE = 32, TOPK = 4, DFF = 1024;
constexpr int NASSIGN = M * TOPK;
constexpr int MAXTILES = 288, MAXROWS = MAXTILES * 256;
constexpr float EPS = 1e-6f, GN_EPS = 64e-5f;

DI int fresh_tid_(int wv) { int w = wv; asm volatile("" : "+s"(w)); int l; asm volatile("v_mbcnt_lo_u32_b32 %0, -1, 0\n\tv_mbcnt_hi_u32_b32 %0, -1, %0" : "=v"(l)); return (w << 6) | (l & 63); }
#define fresh_tid() fresh_tid_(wv0)
namespace pg8 {
constexpr int BM = 256, BK = 64, HALF = 128, HTB = HALF * BK * 2, STAGE_BYTES = 8 * HTB, NXCD = 8, WGM = 8;
__host__ __device__ __forceinline__ int lds_byte(int r, int c) { const int st = (r >> 4) * 2 + (c >> 5), rr = r & 15, cc = c & 31, ob = rr * 64 + cc * 2; return st * 1024 + (ob ^ (((ob >> 9) & 1) << 5)); }
__host__ __device__ __forceinline__ void stage_rc(int b, int& R, int& C) { const int st = b / 1024, sb = b % 1024, swz = sb ^ (((sb >> 9) & 1) << 5); R = (st >> 1) * 16 + swz / 64; C = (st & 1) * 32 + (swz % 64) / 2; }
__host__ __device__ __forceinline__ int perm32(int rho) { const int n = rho >> 4, i = rho & 15; return 8 * (i >> 2) + 4 * n + (i & 3); }

struct Unit { int pm, pn, e; };

struct StaticOrder {
    int nM, nN, nwg, G, c;
    __host__ __device__ void init_tiles(int nM_, int nN_, int G_, int c_) { nM = nM_; nN = nN_; nwg = nM * nN; G = G_; c = c_; }
    __host__ __device__ bool next(int i, Unit& u) const {
        const long L = (long)i * G + c; if (L >= nwg) return false;
        int wgid = (int)L; { const int q = nwg / NXCD, r = nwg % NXCD, xcd = wgid % NXCD, off = wgid / NXCD; wgid = (xcd < r ? xcd * (q + 1) : r * (q + 1) + (xcd - r) * q) + off; }
        const int nig = WGM * nN, gid = wgid / nig, fm = gid * WGM, gsz = (nM - fm) < WGM ? (nM - fm) : WGM;
        u.pm = fm + ((wgid % nig) % gsz); u.pn = (wgid % nig) / gsz; u.e = 0; return true;
    }
};
struct DenseSched {
    static constexpr bool GATHER = false, B_TILED = false;
    StaticOrder o; const char* A; const char* B; size_t tstep;
    DI bool next(int i, Unit& u) const { return o.next(i, u); }
    DI const char* a_ptr(const Unit& u) const { return A + (size_t)u.pm * tstep; }
    DI const char* b_ptr(const Unit& u) const { return B + (size_t)u.pn * tstep; }
    DI void a_voff(const Unit&, int K, const int (&R)[2], const int (&C)[2], unsigned (&vo)[2][2]) const {
#pragma unroll
        for (int h = 0; h < 2; ++h)
#pragma unroll
            for (int i = 0; i < 2; ++i) vo[h][i] = (unsigned)((h * HALF + R[i]) * K + C[i]) * 2u; }
};
struct MoeSched {
    static constexpr bool GATHER = false, B_TILED = true;
    StaticOrder o; const char* A; const char* B; const int* tile_e; const int* utab; size_t tstep, estep;
    DI bool next(int i, Unit& u) const { const int L = i * o.G + o.c; if (L >= o.nwg) return false; int en; asm volatile("s_load_dword %0, %1, 0x0\n\ts_waitcnt lgkmcnt(0)" : "=s"(en) : "s"(utab + L) : "memory");     u.pm = en & 0xfff; u.pn = (en >> 12) & 15; u.e = en >> 16; return true; }
    DI const char* a_ptr(const Unit& u) const { return A + (size_t)u.pm * tstep; }
    DI const char* b_ptr(const Unit& u) const { return B + (size_t)u.e * estep + (size_t)u.pn * tstep; }
    DI void a_voff(const Unit&, int K, const int (&R)[2], const int (&C)[2], unsigned (&vo)[2][2]) const {
#pragma unroll
        for (int h = 0; h < 2; ++h)
#pragma unroll
            for (int i = 0; i < 2; ++i) vo[h][i] = (unsigned)((h * HALF + R[i]) * K + C[i]) * 2u; }
};
struct MoeGatherSched {
    static constexpr bool GATHER = true, B_TILED = true;
    StaticOrder o; const char* A; const char* B; const int* tile_e; const int* utab; const int* rtok; size_t tstep, estep;
    DI bool next(int i, Unit& u) const { const int L = i * o.G + o.c; if (L >= o.nwg) return false; int en; asm volatile("s_load_dword %0, %1, 0x0\n\ts_waitcnt lgkmcnt(0)" : "=s"(en) : "s"(utab + L) : "memory");     u.pm = en & 0xfff; u.pn = (en >> 12) & 15; u.e = en >> 16; return true; }
    DI const char* a_ptr(const Unit&) const { return A; }
    DI const char* b_ptr(const Unit& u) const { return B + (size_t)u.e * estep + (size_t)u.pn * tstep; }
    DI void a_voff(const Unit& u, int K, const int (&R)[2], const int (&C)[2], unsigned (&vo)[2][2]) const {
#pragma unroll
        for (int h = 0; h < 2; ++h)
#pragma unroll
            for (int i = 0; i < 2; ++i) vo[h][i] = (unsigned)(rtok[u.pm * BM + h * HALF + R[i]] * K + C[i]) * 2u; }
};

struct BatchBSched {
    static constexpr bool GATHER = false, B_TILED = false;
    StaticOrder o; const char* A; const char* B; size_t tstep, bstep;
    DI bool next(int i, Unit& u) const { return o.next(i, u); }
    DI const char* a_ptr(const Unit& u) const { return A + (size_t)u.pm * tstep; }
    DI const char* b_ptr(const Unit& u) const { return B + (size_t)(u.pm >> 4) * bstep + (size_t)u.pn * tstep; }
    DI void a_voff(const Unit&, int K, const int (&R)[2], const int (&C)[2], unsigned (&vo)[2][2]) const {
#pragma unroll
        for (int h = 0; h < 2; ++h)
#pragma unroll
            for (int i = 0; i < 2; ++i) vo[h][i] = (unsigned)((h * HALF + R[i]) * K + C[i]) * 2u; }
};
template <int MODE> struct FoldSched {
    static constexpr bool GATHER = false, B_TILED = false;
    const char* A; const char* B; int G, c;
    DI bool next(int i, Unit& u) const { const int L = i * G + c; if (L >= 64) return false; u.pm = L >> 2; u.pn = L & 3; u.e = 0; return true; }
    DI const char* a_ptr(const Unit& u) const { const int b = u.pm >> 2, h = u.pm & 3; return A + ((size_t)(MODE == 0 ? b * 256 : u.pn * 256) * 1024 + h * 256) * 2; }
    DI const char* b_ptr(const Unit& u) const { const int b = u.pm >> 2, h = u.pm & 3; return B + ((size_t)(MODE == 0 ? u.pn * 256 : b * 256) * 1024 + h * 256) * 2; }
    DI void a_voff(const Unit&, int K, const int (&R)[2], const int (&C)[2], unsigned (&vo)[2][2]) const {
#pragma unroll
        for (int h = 0; h < 2; ++h)
#pragma unroll
            for (int i = 0; i < 2; ++i) vo[h][i] = (unsigned)((h * HALF + R[i]) * K + C[i]) * 2u; }
};

DI unsigned cvt_pk_bf16(float lo, float hi) { unsigned r; asm volatile("v_cvt_pk_bf16_f32 %0, %1, %2" : "=v"(r) : "v"(lo), "v"(hi)); return r; }

template <class Epi, class Sched, bool ALIGN_EPI = true, bool FP8 = false>
DI void gemm_phase(LAS unsigned char* lds, const int K, const Sched& S, const Epi& E, const int wv0, const int ldp = 0) {
    const int ld = ldp ? ldp : K;
    const int tid = fresh_tid(), wid = __builtin_amdgcn_readfirstlane(tid >> 6), lane = tid & 63, wr = wid >> 2, wc = wid & 3, fr = lane & 15, fq = lane >> 4;
    const int nt = K / BK;
    constexpr bool GA = Sched::GATHER, BT = Sched::B_TILED;
    unsigned voffA[2][2], voffAn[2][2], voffB[2];
#pragma unroll
    for (int i = 0; i < 2; ++i) { int R, C; stage_rc(tid * 16 + i * 8192, R, C); const int Rb = Epi::PERM ? ((R & ~31) + perm32(R & 31)) : R;
        voffB[i] = BT ? (unsigned)(tid * 16 + i * 8192) : (unsigned)(Rb * ld + C) * 2u; }
#define PG8_AVOFF(unit, dst) do { int sR[2], sC[2]; const int t2_ = fresh_tid(); stage_rc(t2_ * 16, sR[0], sC[0]); stage_rc(t2_ * 16 + 8192, sR[1], sC[1]); S.a_voff(unit, ld, sR, sC, dst); } while (0)
    const size_t kstep = (size_t)(BK * 2);
    const size_t hstep = (size_t)HALF * ld * 2;
    const size_t kstepB = BT ? (size_t)(2 * HTB) : kstep, hstepB = BT ? (size_t)HTB : hstep;
    const unsigned ldsw = (unsigned)wid * 1024u;
    unsigned aoffv = (unsigned)(size_t)lds + (unsigned)lds_byte(wr * 64 + fr, fq * 8), boffv = (unsigned)(size_t)lds + (unsigned)(4 * HTB) + (unsigned)lds_byte(wc * 32 + fr, fq * 8);
    asm volatile("" : "+v"(aoffv), "+v"(boffv));
    const size_t dB = BT ? (size_t)8192 : (size_t)64 * ld * 2, dA = (size_t)64 * ld * 2;
#define PG8_SA(b, h) (((b) * 2 + (h)) * HTB)
#define PG8_SB(b, h) ((4 + (b) * 2 + (h)) * HTB)
    const unsigned ldsbase = (unsigned)__builtin_amdgcn_readfirstlane((int)((unsigned)(size_t)lds + ldsw));
#define PG8_STAGE1(bufoff, gptr, vo, i_) do { const unsigned m0v_ = ldsbase + (unsigned)(bufoff) + (unsigned)(i_) * 8192u; \
        asm volatile("s_mov_b32 m0, %2\n\ts_nop 0\n\tglobal_load_lds_dwordx4 %0, %1" :: "v"(vo), "s"((const char*)(gptr)), "s"(m0v_) : "memory", "m0"); } while (0)
#define PG8_STAGE(bufoff, gbase, voff) do { PG8_STAGE1(bufoff, gbase, (voff)[0], 0); PG8_STAGE1(bufoff, gbase, (voff)[1], 1); } while (0)
#define PG8_STAGE_D(bufoff, gbase, vo, delta) do { PG8_STAGE1(bufoff, gbase, vo, 0); PG8_STAGE1(bufoff, (const char*)(gbase) + (delta), vo, 1); } while (0)
#define PG8_LDA(dst, b, h) do { if constexpr (FP8) { _Pragma("unroll") for (int m = 0; m < 4; ++m) { const LAS v4i* p_ = (const LAS v4i*)((LAS unsigned char*)(size_t)aoffv + PG8_SA(b, h) + m * 2048); dst##8[m] = __builtin_shufflevector(p_[0], p_[64], 0, 1, 2, 3, 4, 5, 6, 7); } } \
        else { _Pragma("unroll") for (int m = 0; m < 4; ++m) _Pragma("unroll") for (int k = 0; k < 2; ++k) dst[m][k] = *(const LAS bf16x8*)((LAS unsigned char*)(size_t)aoffv + PG8_SA(b, h) + m * 2048 + k * 1024); } } while (0)
#define PG8_LDB(dst, b, h) do { if constexpr (FP8) { _Pragma("unroll") for (int n = 0; n < 2; ++n) { const LAS v4i* p_ = (const LAS v4i*)((LAS unsigned char*)(size_t)boffv + (PG8_SB(b, h) - 4 * HTB) + n * 2048); dst##8[n] = __builtin_shufflevector(p_[0], p_[64], 0, 1, 2, 3, 4, 5, 6, 7); } } \
        else { _Pragma("unroll") for (int n = 0; n < 2; ++n) _Pragma("unroll") for (int k = 0; k < 2; ++k) dst[n][k] = *(const LAS bf16x8*)((LAS unsigned char*)(size_t)boffv + (PG8_SB(b, h) - 4 * HTB) + n * 2048 + k * 1024); } } while (0)
#define PG8_MMA(ai, bj, At, Bt) do { __builtin_amdgcn_s_setprio(1); \
        if constexpr (FP8) {   \
            _Pragma("unroll") for (int m = 0; m < 4; ++m) _Pragma("unroll") for (int n = 0; n < 2; ++n) \
                acc[ai][bj][m][n] = __builtin_amdgcn_mfma_scale_f32_16x16x128_f8f6f4(Bt##8[n], At##8[m], acc[ai][bj][m][n], 0, 0, 0, 0, 0, 0); } \
        else { _Pragma("unroll") for (int m = 0; m < 4; ++m) _Pragma("unroll") for (int n = 0; n < 2; ++n) _Pragma("unroll") for (int k = 0; k < 2; ++k) \
            acc[ai][bj][m][n] = __builtin_amdgcn_mfma_f32_16x16x32_bf16(Bt[n][k], At[m][k], acc[ai][bj][m][n], 0, 0, 0); } \
        __builtin_amdgcn_s_setprio(0); } while (0)
#define PG8_WAIT_V(n) asm volatile("s_waitcnt vmcnt(" #n ")" ::: "memory")
#define PG8_WAIT_L(n) asm volatile("s_waitcnt lgkmcnt(" #n ")" ::: "memory")
#define PG8_BAR __builtin_amdgcn_s_barrier()
#define PG8_SCHED __builtin_amdgcn_sched_barrier(0)
    Unit cur, nxt; int ui = 0;
    if (!S.next(0, cur)) return;
    f32x4 acc[2][2][4][2];
#pragma unroll
    for (int a = 0; a < 2; ++a)
#pragma unroll
        for (int b = 0; b < 2; ++b)
#pragma unroll
            for (int m = 0; m < 4; ++m)
#pragma unroll
                for (int n = 0; n < 2; ++n) acc[a][b][m][n] = (f32x4){0.f, 0.f, 0.f, 0.f};
    bf16x8 At[4][2], B0[2][2], B1[2][2]; v8i At8[4], B08[2], B18[2];
    const char* cA = S.a_ptr(cur); const char* cB = S.b_ptr(cur);
    PG8_AVOFF(cur, voffA);
#define PG8_STAGE_A(bufoff, kbase, h, vo) do { if constexpr (GA) { PG8_STAGE(bufoff, kbase, (vo)[h]); } else { PG8_STAGE_D(bufoff, (kbase) + (h) * hstep, voffA[0][0], dA); } } while (0)
    PG8_STAGE_D(PG8_SB(0, 0), cB, voffB[0], dB); PG8_STAGE_D(PG8_SB(0, 1), cB + hstepB, voffB[0], dB); PG8_STAGE_A(PG8_SA(0, 0), cA, 0, voffA); PG8_STAGE_A(PG8_SA(0, 1), cA, 1, voffA);
    if (wr == 1) PG8_BAR;
    PG8_WAIT_V(2); PG8_BAR;
    PG8_STAGE_D(PG8_SB(1, 0), cB + kstepB, voffB[0], dB); PG8_STAGE_A(PG8_SA(1, 0), cA + kstep, 0, voffA); PG8_STAGE_D(PG8_SB(1, 1), cB + hstepB + kstepB, voffB[0], dB);
    PG8_WAIT_V(6); PG8_BAR;
    for (;;) {
        const bool has_next = S.next(ui + 1, nxt);
        const char* nA = has_next ? S.a_ptr(nxt) : cA; const char* nB = has_next ? S.b_ptr(nxt) : cB;
        if constexpr (GA) { if (has_next) PG8_AVOFF(nxt, voffAn);
            else {
#pragma unroll
                for (int h = 0; h < 2; ++h)
#pragma unroll
                    for (int i = 0; i < 2; ++i) voffAn[h][i] = voffA[h][i]; } }
#pragma unroll 1
        for (int t = 0; t < nt; t += 2) {
            const bool last = (t == nt - 2);
            const char* a1 = cA + (size_t)(t + 1) * kstep;
            const char* a2 = last ? nA : cA + (size_t)(t + 2) * kstep; const char* b2 = last ? nB : cB + (size_t)(t + 2) * kstepB;
            const char* a3 = a2 + kstep; const char* b3 = b2 + kstepB;
            PG8_LDB(B0, 0, 0); PG8_LDB(B1, 0, 1); PG8_SCHED; PG8_LDA(At, 0, 0); PG8_STAGE_A(PG8_SA(1, 1), a1, 1, voffA);
            if constexpr (GA) { if (last) {
#pragma unroll
                for (int h = 0; h < 2; ++h)
#pragma unroll
                    for (int i = 0; i < 2; ++i) voffA[h][i] = voffAn[h][i]; } }
            PG8_WAIT_V(8); PG8_WAIT_L(0); PG8_BAR; PG8_MMA(0, 0, At, B0); PG8_MMA(0, 1, At, B1); PG8_BAR; PG8_SCHED;
            PG8_LDA(At, 0, 1); PG8_STAGE_D(PG8_SB(0, 0), b2, voffB[0], dB); PG8_STAGE_D(PG8_SB(0, 1), b2 + hstepB, voffB[0], dB); PG8_STAGE_A(PG8_SA(0, 0), a2, 0, voffA);
            PG8_WAIT_V(8); PG8_WAIT_L(0); PG8_BAR; PG8_MMA(1, 0, At, B0); PG8_MMA(1, 1, At, B1); PG8_BAR; PG8_SCHED;
            PG8_LDB(B0, 1, 0); PG8_LDB(B1, 1, 1); PG8_SCHED; PG8_LDA(At, 1, 0); PG8_STAGE_A(PG8_SA(0, 1), a2, 1, voffA);
            PG8_WAIT_V(8); PG8_WAIT_L(0); PG8_BAR; PG8_MMA(0, 0, At, B0); PG8_MMA(0, 1, At, B1); PG8_BAR; PG8_SCHED;
            PG8_LDA(At, 1, 1); PG8_STAGE_D(PG8_SB(1, 0), b3, voffB[0], dB); PG8_STAGE_D(PG8_SB(1, 1), b3 + hstepB, voffB[0], dB); PG8_STAGE_A(PG8_SA(1, 0), a3, 0, voffA);
            PG8_WAIT_V(8); PG8_WAIT_L(0); PG8_BAR; PG8_MMA(1, 0, At, B0); PG8_MMA(1, 1, At, B1); PG8_BAR; PG8_SCHED;
        }
        if constexpr (ALIGN_EPI) { if (wr == 0) PG8_BAR; }
        { Unit ue = cur; ue.pm = __builtin_amdgcn_readfirstlane(ue.pm); ue.pn = __builtin_amdgcn_readfirstlane(ue.pn); ue.e = __builtin_amdgcn_readfirstlane(ue.e); asm volatile("" : "+s"(ue.pm), "+s"(ue.pn), "+s"(ue.e));
          const int t3_ = fresh_tid(); const int fr_ = t3_ & 15, fq_ = (t3_ & 63) >> 4;
          E(acc, ue, wr, wc, fr_, fq_); }
        if (!has_next) break;
#pragma unroll
        for (int a = 0; a < 2; ++a)
#pragma unroll
            for (int b = 0; b < 2; ++b)
#pragma unroll
                for (int m = 0; m < 4; ++m)
#pragma unroll
                    for (int n = 0; n < 2; ++n) acc[a][b][m][n] = (f32x4){0.f, 0.f, 0.f, 0.f};
        cur = nxt; cA = nA; cB = nB; ++ui;
        if constexpr (ALIGN_EPI) { if (wr == 1) PG8_BAR; }
    }
    PG8_WAIT_V(0);
    if constexpr (!ALIGN_EPI) { if (wr == 0) PG8_BAR; }
    PG8_BAR;
#undef PG8_SA
#undef PG8_SB
#undef PG8_STAGE
#undef PG8_STAGE1
#undef PG8_STAGE_D
#undef PG8_STAGE_A
#undef PG8_AVOFF
#undef PG8_LDA
#undef PG8_LDB
#undef PG8_MMA
#undef PG8_WAIT_V
#undef PG8_WAIT_L
#undef PG8_BAR
#undef PG8_SCHED
}
}
using pg8::Unit;
using pg8::cvt_pk_bf16;

DI float bflo(unsigned w) { return __uint_as_float(w << 16); }
DI float bfhi(unsigned w) { return __uint_as_float(w & 0xffff0000u); }
DI float bf2f(bf16 b) { return __uint_as_float(((unsigned)b) << 16); }
typedef __bf16 hwbf2 __attribute__((ext_vector_type(2)));
DI unsigned pk2(float lo, float hi) { const f32x2 v = {lo, hi}; return __builtin_bit_cast(unsigned, __builtin_convertvector(v, hwbf2)); }
DI unsigned f2bf(float f) { return pk2(f, 0.f) & 0xffffu; }
DI float rcp_f(float x) { return __builtin_amdgcn_rcpf(x); }
DI float rsq_f(float x) { return __builtin_amdgcn_rsqf(x); }
DI float sigmoid_f(float x) { return rcp_f(1.0f + __expf(-x)); }
DI float tanh_fast(float x) { return 1.0f - 2.0f * rcp_f(__expf(2.0f * x) + 1.0f); }
DI float softplus_f(float x) { return fmaxf(x, 0.f) + __logf(1.0f + __expf(-fabsf(x))); }
DI float softplus_fast(float x) { return fmaxf(x, 0.f) + __logf(1.0f + __expf(-fabsf(x))); }
DI float gelu_tanh_f(float x) { const float u = 0.7978845608028654f * (x + 0.044715f * x * x * x); return 0.5f * x * (1.0f + tanh_fast(u)); }
DI float wave_sum(float v) {
#pragma unroll
    for (int o = 1; o < 64; o <<= 1) v += __shfl_xor(v, o);
    return v;
}

DI unsigned pk4_fp8(float a, float b, float c, float d) { int w = 0; w = __builtin_amdgcn_cvt_pk_fp8_f32(a, b, w, false); w = __builtin_amdgcn_cvt_pk_fp8_f32(c, d, w, true); return (unsigned)w; }
struct EpiBf16Plain {
    static constexpr bool PERM = true;
    bf16* O; int ldc; float scale;
    DI void operator()(const f32x4 (&acc)[2][2][4][2], const Unit& u, int wr, int wc, int fr, int fq) const {
        const int row0 = u.pm * 256 + wr * 64 + fr, col0 = u.pn * 256 + wc * 32 + 8 * fq;
#pragma unroll
        for (int ai = 0; ai < 2; ++ai)
#pragma unroll
            for (int m = 0; m < 4; ++m) { bf16* rowp = O + (size_t)(row0 + ai * 128 + m * 16) * ldc + col0;
#pragma unroll
                for (int bj = 0; bj < 2; ++bj) { const f32x4 v0 = acc[ai][bj][m][0] * scale, v1 = acc[ai][bj][m][1] * scale;
                    u32x4 w; w.x = cvt_pk_bf16(v0[0], v0[1]); w.y = cvt_pk_bf16(v0[2], v0[3]); w.z = cvt_pk_bf16(v1[0], v1[1]); w.w = cvt_pk_bf16(v1[2], v1[3]);
                    *(u32x4*)(rowp + bj * 128) = w; } }
    }
};
template <int MODE> struct EpiFold {
    static constexpr bool PERM = true;
    unsigned char* O;
    DI void operator()(const f32x4 (&acc)[2][2][4][2], const Unit& u, int wr, int wc, int fr, int fq) const {
        const int b = u.pm >> 2, h = u.pm & 3;
        const int rbase = MODE == 0 ? h * 256 : u.pn * 256, cbase = MODE == 0 ? u.pn * 256 : h * 256;
        const unsigned boff = (unsigned)b * 1024u * 1024u + (unsigned)(rbase + wr * 64 + fr) * 1024u + (unsigned)(cbase + wc * 32 + 8 * fq);
#pragma unroll
        for (int ai = 0; ai < 2; ++ai)
#pragma unroll
            for (int m = 0; m < 4; ++m) { unsigned char* rowp = O + (boff + (unsigned)(ai * 128 + m * 16) * 1024u);
#pragma unroll
                for (int bj = 0; bj < 2; ++bj) { const f32x4 v0 = acc[ai][bj][m][0] * 4.0f, v1 = acc[ai][bj][m][1] * 4.0f;
                    u32x2 w; w.x = pk4_fp8(v0[0], v0[1], v0[2], v0[3]); w.y = pk4_fp8(v1[0], v1[1], v1[2], v1[3]);
                    *(u32x2*)(rowp + bj * 128) = w; } }
    }
};
struct EpiSoftmax {
    static constexpr bool PERM = true;
    unsigned char* O; float scale; const float* RS; LAS float* XM; LAS float* XS;
    DI void operator()(const f32x4 (&acc)[2][2][4][2], const Unit& u, int wr, int wc, int fr, int fq) const {
        const int row0 = u.pm * 256 + wr * 64 + fr, col0 = u.pn * 256 + wc * 32 + 8 * fq;
        float sc[2][4];
#pragma unroll
        for (int ai = 0; ai < 2; ++ai)
#pragma unroll
            for (int m = 0; m < 4; ++m) { const int r = row0 + ai * 128 + m * 16; const f32x4* rp = (const f32x4*)(RS + (size_t)r * 16);
                const f32x4 p0 = rp[0], p1 = rp[1], p2 = rp[2], p3 = rp[3];
                const float ss = ((p0[0] + p0[1]) + (p0[2] + p0[3])) + ((p1[0] + p1[1]) + (p1[2] + p1[3])) + ((p2[0] + p2[1]) + (p2[2] + p2[3])) + ((p3[0] + p3[1]) + (p3[2] + p3[3]));
                sc[ai][m] = scale * __builtin_amdgcn_rsqf(ss * (1.0f / 1024.0f) + 1e-6f);
                float mm = -3.0e38f;
#pragma unroll
                for (int bj = 0; bj < 2; ++bj)
#pragma unroll
                    for (int n = 0; n < 2; ++n) { const f32x4 v = acc[ai][bj][m][n]; mm = fmaxf(mm, fmaxf(fmaxf(v[0], v[1]), fmaxf(v[2], v[3]))); }
                mm *= sc[ai][m];
                mm = fmaxf(mm, __shfl_xor(mm, 16)); mm = fmaxf(mm, __shfl_xor(mm, 32));
                if (fq == 0) XM[(ai * 128 + wr * 64 + m * 16 + fr) * 4 + wc] = mm; }
        asm volatile("s_waitcnt lgkmcnt(0)" ::: "memory"); __builtin_amdgcn_s_barrier(); asm volatile("" ::: "memory");
        f32x4 (&pa)[2][2][4][2] = const_cast<f32x4 (&)[2][2][4][2]>(acc);
#pragma unroll
        for (int ai = 0; ai < 2; ++ai)
#pragma unroll
            for (int m = 0; m < 4; ++m) { const int lr = ai * 128 + wr * 64 + m * 16 + fr; const f32x4 q = *(const LAS f32x4*)(XM + lr * 4);
                const float mxr = fmaxf(fmaxf(q[0], q[1]), fmaxf(q[2], q[3])); float sm = 0.f;
#pragma unroll
                for (int bj = 0; bj < 2; ++bj)
#pragma unroll
                    for (int n = 0; n < 2; ++n)
#pragma unroll
                        for (int j = 0; j < 4; ++j) { const float p = __expf(acc[ai][bj][m][n][j] * sc[ai][m] - mxr); pa[ai][bj][m][n][j] = p; sm += p; }
                sm += __shfl_xor(sm, 16); sm += __shfl_xor(sm, 32);
                if (fq == 0) XS[lr * 4 + wc] = sm; }
        asm volatile("s_waitcnt lgkmcnt(0)" ::: "memory"); __builtin_amdgcn_s_barrier(); asm volatile("" ::: "memory");
#pragma unroll
        for (int ai = 0; ai < 2; ++ai)
#pragma unroll
            for (int m = 0; m < 4; ++m) { const int lr = ai * 128 + wr * 64 + m * 16 + fr; const f32x4 q = *(const LAS f32x4*)(XS + lr * 4);
                const float inv = 256.0f * __builtin_amdgcn_rcpf((q[0] + q[1]) + (q[2] + q[3]));
                unsigned char* rowp = O + (size_t)(row0 + ai * 128 + m * 16) * 1024 + col0;
#pragma unroll
                for (int bj = 0; bj < 2; ++bj) { const f32x4 v0 = pa[ai][bj][m][0] * inv, v1 = pa[ai][bj][m][1] * inv;
                    u32x2 w; w.x = pk4_fp8(v0[0], v0[1], v0[2], v0[3]); w.y = pk4_fp8(v1[0], v1[1], v1[2], v1[3]);
                    *(u32x2*)(rowp + bj * 128) = w; } }
        asm volatile("s_waitcnt lgkmcnt(0)" ::: "memory"); __builtin_amdgcn_s_barrier(); asm volatile("" ::: "memory");
    }
};
struct EpiBf16RowNorm {
    static constexpr bool PERM = true;
    bf16* O; int ldc; float scale; const float* RS;
    DI void operator()(const f32x4 (&acc)[2][2][4][2], const Unit& u, int wr, int wc, int fr, int fq) const {
        const int row0 = u.pm * 256 + wr * 64 + fr, col0 = u.pn * 256 + wc * 32 + 8 * fq;
#pragma unroll
        for (int ai = 0; ai < 2; ++ai)
#pragma unroll
            for (int m = 0; m < 4; ++m) { const int r = row0 + ai * 128 + m * 16; const f32x4* rp = (const f32x4*)(RS + (size_t)r * 16);
                const f32x4 p0 = rp[0], p1 = rp[1], p2 = rp[2], p3 = rp[3];
                const float ss = ((p0[0] + p0[1]) + (p0[2] + p0[3])) + ((p1[0] + p1[1]) + (p1[2] + p1[3])) + ((p2[0] + p2[1]) + (p2[2] + p2[3])) + ((p3[0] + p3[1]) + (p3[2] + p3[3]));
                const float sc = scale * __builtin_amdgcn_rsqf(ss * (1.0f / 1024.0f) + 1e-6f);
                bf16* rowp = O + (size_t)r * ldc + col0;
#pragma unroll
                for (int bj = 0; bj < 2; ++bj) { const f32x4 v0 = acc[ai][bj][m][0] * sc, v1 = acc[ai][bj][m][1] * sc;
                    u32x4 w; w.x = cvt_pk_bf16(v0[0], v0[1]); w.y = cvt_pk_bf16(v0[2], v0[3]); w.z = cvt_pk_bf16(v1[0], v1[1]); w.w = cvt_pk_bf16(v1[2], v1[3]);
                    *(u32x4*)(rowp + bj * 128) = w; } }
    }
};
template <bool RES_BF16> struct EpiBf16Res {
    static constexpr bool PERM = true;
    const void* Rz; bf16* O; int ldc; float* RS; float ascale; unsigned char* O8;
    DI void operator()(const f32x4 (&acc)[2][2][4][2], const Unit& u, int wr, int wc, int fr, int fq) const {
        const int row0 = u.pm * 256 + wr * 64 + fr, col0 = u.pn * 256 + wc * 32 + 8 * fq;
#pragma unroll
        for (int ai = 0; ai < 2; ++ai) {
            u32x4 rwb[4][2]; f32x4 rf0[4][2], rf1[4][2];
#pragma unroll
            for (int m = 0; m < 4; ++m) { const size_t off = (size_t)(row0 + ai * 128 + m * 16) * ldc + col0;
#pragma unroll
                for (int bj = 0; bj < 2; ++bj) {
                    if (RES_BF16) rwb[m][bj] = *(const u32x4*)((const bf16*)Rz + off + bj * 128);
                    else { rf0[m][bj] = *(const f32x4*)((const float*)Rz + off + bj * 128); rf1[m][bj] = *(const f32x4*)((const float*)Rz + off + bj * 128 + 4); } } }
#pragma unroll
            for (int m = 0; m < 4; ++m) { const size_t off = (size_t)(row0 + ai * 128 + m * 16) * ldc + col0; float ssq = 0.f;
#pragma unroll
                for (int bj = 0; bj < 2; ++bj) { f32x4 r0, r1;
                    if (RES_BF16) { const u32x4 rw = rwb[m][bj]; r0 = (f32x4){bflo(rw.x), bfhi(rw.x), bflo(rw.y), bfhi(rw.y)}; r1 = (f32x4){bflo(rw.z), bfhi(rw.z), bflo(rw.w), bfhi(rw.w)}; }
                    else { r0 = rf0[m][bj]; r1 = rf1[m][bj]; }
                    const f32x4 v0 = r0 + acc[ai][bj][m][0] * ascale, v1 = r1 + acc[ai][bj][m][1] * ascale;
                    if (O8) { u32x2 w8; w8.x = pk4_fp8(v0[0], v0[1], v0[2], v0[3]); w8.y = pk4_fp8(v1[0], v1[1], v1[2], v1[3]); *(u32x2*)(O8 + off + bj * 128) = w8; }
                    ssq += (v0[0] * v0[0] + v0[1] * v0[1]) + (v0[2] * v0[2] + v0[3] * v0[3]) + (v1[0] * v1[0] + v1[1] * v1[1]) + (v1[2] * v1[2] + v1[3] * v1[3]);
                    u32x4 w; w.x = cvt_pk_bf16(v0[0], v0[1]); w.y = cvt_pk_bf16(v0[2], v0[3]); w.z = cvt_pk_bf16(v1[0], v1[1]); w.w = cvt_pk_bf16(v1[2], v1[3]);
                    *(u32x4*)(O + off + bj * 128) = w; }
                if (RS) { ssq += __shfl_xor(ssq, 16); ssq += __shfl_xor(ssq, 32); if (fq == 0) RS[(size_t)(row0 + ai * 128 + m * 16) * 16 + u.pn * 4 + wc] = ssq; } } }
    }
};
struct EpiLora {
    static constexpr bool PERM = false;
    float* LWp; bf16* AAp; bf16* GGp; const float* w0; const float* a0;
    DI void operator()(const f32x4 (&acc)[2][2][4][2], const Unit& u, int wr, int wc, int fr, int fq) const {
        const int kind = u.pn >> 1;
        const int row0 = u.pm * 256 + wr * 64 + fr, col0 = (u.pn & 1) * 256 + wc * 32 + 4 * fq;
#pragma unroll
        for (int bj = 0; bj < 2; ++bj)
#pragma unroll
            for (int n = 0; n < 2; ++n) {
                const int c = col0 + bj * 128 + n * 16;
                f32x4 bias = (f32x4){0.f, 0.f, 0.f, 0.f};
                if (kind == 0) bias = *(const f32x4*)(w0 + c); else if (kind == 1) bias = *(const f32x4*)(a0 + c);
#pragma unroll
                for (int ai = 0; ai < 2; ++ai)
#pragma unroll
                    for (int m = 0; m < 4; ++m) {
                        f32x4 v = acc[ai][bj][m][n] + bias;
                        if (kind == 0) {
#pragma unroll
                            for (int j = 0; j < 4; ++j) { const float w = -softplus_fast(-v[j]) - 0.5f; v[j] = -__expf(w);     }
                        } else if (kind == 1) {
#pragma unroll
                            for (int j = 0; j < 4; ++j) v[j] = sigmoid_f(v[j]);
                        }
                        const size_t o_ = (size_t)(row0 + ai * 128 + m * 16) * 512 + c;
                        if (kind == 0) *(f32x4*)(LWp + o_) = v;
                        else { u32x2 w_; w_.x = cvt_pk_bf16(v[0], v[1]); w_.y = cvt_pk_bf16(v[2], v[3]); *(u32x2*)((kind == 1 ? AAp : GGp) + o_) = w_; }
                    }
            }
    }
};
struct EpiSwiglu {
    static constexpr bool PERM = true;
    bf16* ACT; const float* b_gu;
    DI void operator()(const f32x4 (&acc)[2][2][4][2], const Unit& u, int wr, int wc, int fr, int fq) const {
        const int row0 = u.pm * 256 + wr * 64 + fr, j0 = u.pn * 128 + wc * 32 + 8 * fq;
        const float* bg = b_gu + (size_t)u.e * 2048 + j0; const float* bu = bg + 1024;
        const f32x4 bg0 = *(const f32x4*)bg, bg1 = *(const f32x4*)(bg + 4), bu0 = *(const f32x4*)bu, bu1 = *(const f32x4*)(bu + 4);
#pragma unroll
        for (int ai = 0; ai < 2; ++ai)
#pragma unroll
            for (int m = 0; m < 4; ++m) {
                float o[8];
#pragma unroll
                for (int n = 0; n < 2; ++n) { const f32x4 g4 = acc[ai][0][m][n] * 0.015625f + (n ? bg1 : bg0), u4 = acc[ai][1][m][n] * 0.015625f + (n ? bu1 : bu0);
#pragma unroll
                    for (int j = 0; j < 4; ++j) { const float g = fminf(g4[j], 7.0f), up = fminf(fmaxf(u4[j], -7.0f), 7.0f); o[n * 4 + j] = (up + 1.0f) * (g * sigmoid_f(1.702f * g)); } }
                u32x2 w; w.x = pk4_fp8(o[0], o[1], o[2], o[3]); w.y = pk4_fp8(o[4], o[5], o[6], o[7]);
                *(u32x2*)((unsigned char*)ACT + (size_t)(row0 + ai * 128 + m * 16) * 1024 + j0) = w;
            }
    }
};
struct EpiDown {
    static constexpr bool PERM = true;
    bf16* YS; const float* b_dn; const u32x2* row_sg;
    DI void operator()(const f32x4 (&acc)[2][2][4][2], const Unit& u, int wr, int wc, int fr, int fq) const {
        const int row0 = u.pm * 256 + wr * 64 + fr, col0 = u.pn * 256 + wc * 32 + 8 * fq;
        const float* bb = b_dn + (size_t)u.e * 1024 + col0;
        f32x4 bv[2][2];
#pragma unroll
        for (int bj = 0; bj < 2; ++bj)
#pragma unroll
            for (int n = 0; n < 2; ++n) bv[bj][n] = *(const f32x4*)(bb + bj * 128 + 4 * n);
        int slots[8]; float gts[8];
        { const u32x2* sgp = row_sg + row0;
#pragma unroll
        for (int q = 0; q < 8; ++q) { const u32x2 sg = sgp[(q >> 2) * 128 + (q & 3) * 16]; slots[q] = (int)sg.x; gts[q] = __uint_as_float(sg.y); } }
#pragma unroll
        for (int ai = 0; ai < 2; ++ai)
#pragma unroll
            for (int m = 0; m < 4; ++m) {
                const int slot = slots[ai * 4 + m]; const float gt = gts[ai * 4 + m];
                if (slot >= 0) { unsigned char* rowp = (unsigned char*)YS + (size_t)slot * 1024 + col0; const float g16 = gt * 16.0f;
#pragma unroll
                    for (int bj = 0; bj < 2; ++bj) { const f32x4 v0 = (acc[ai][bj][m][0] * 0.015625f + bv[bj][0]) * g16, v1 = (acc[ai][bj][m][1] * 0.015625f + bv[bj][1]) * g16;
                        u32x2 w; w.x = pk4_fp8(v0[0], v0[1], v0[2], v0[3]); w.y = pk4_fp8(v1[0], v1[1], v1[2], v1[3]);
                        *(u32x2*)(rowp + bj * 128) = w; } }
            }
    }
};

constexpr size_t MiB = 1u << 20;
constexpr size_t WS_CTL = 0, CTL_ZERO_BYTES = 1 * MiB;
constexpr size_t WS_WIN = 1 * MiB, WS_WOUT = 7 * MiB, WS_WQ = 9 * MiB, WS_WK = 11 * MiB, WS_WV = 13 * MiB, WS_WO = 15 * MiB, WS_LORAB = 17 * MiB, WS_LRUW = 18 * MiB;
constexpr size_t WS_ROUTE = 19 * MiB;
constexpr size_t WS_WGU = 22 * MiB, WS_WDN = 150 * MiB;
constexpr size_t WS_HN = 214 * MiB, WS_MEMN = 246 * MiB, WS_KM = 248 * MiB, WS_VT = 250 * MiB;
constexpr size_t WS_X1 = 252 * MiB, WS_X2 = 316 * MiB;
constexpr size_t WS_U = 380 * MiB, WS_R = 468 * MiB, WS_KRAW = 500 * MiB, WS_V = 532 * MiB, WS_KKN = 564 * MiB, WS_WD = 596 * MiB, WS_AA = 628 * MiB, WS_G = 660 * MiB;
constexpr size_t WS_LA = 692 * MiB, WS_LB = 724 * MiB, WS_AP = 756 * MiB, WS_CAT = 764 * MiB, WS_Q = 796 * MiB;
constexpr size_t WS_XS = 380 * MiB, WS_ACT = 524 * MiB, WS_YS = 668 * MiB;
constexpr size_t WS_GP = 796 * MiB, WS_HF = 860 * MiB, WS_RP = 924 * MiB, WS_Y1F = 940 * MiB, WS_ADD = 972 * MiB, WS_END = 1004 * MiB;
constexpr size_t WS_GC = 468 * MiB, WS_HC = 484 * MiB, WS_ZS = 500 * MiB;
static_assert(WS_AA == WS_WD + 32 * MiB && WS_G == WS_AA + 32 * MiB, "EpiLora strides");
static_assert(WS_U + (size_t)M * INW * 2 <= WS_R && WS_XS + (size_t)MAXROWS * 2048 <= WS_ACT && WS_ACT + (size_t)MAXROWS * 2048 <= WS_YS && WS_YS + (size_t)NASSIGN * 2048 <= WS_Q, "ws map");
constexpr size_t RT_E = 0, RT_POS = 256 * 1024, RT_G = 512 * 1024, RT_SLOT = 768 * 1024, RT_GATE = 1088 * 1024, RT_TILE = 1408 * 1024, RT_TOK = 1472 * 1024, RT_UGU = 1792 * 1024, RT_UDN = 1808 * 1024;
constexpr int CW_BAR = 4096, CW_CNT = 8192, CW_CONV = 12288;

constexpr int RING_BYTES = 131072, MISC_OFF = RING_BYTES + 320, LDS_BYTES = 147456;
constexpr int NWAVES = 8, NTHREADS = 512;
constexpr int CONV_P9 = 6144;
constexpr int CONV_P9D = 16384;

#define XB_TMO      128
#define XB_XCNT(j)  (256  + 64 * (j))
#define XB_XSUB(j)  (1280 + 64 * (j))
#define XB_XGEN(j)  (2304 + 64 * (j))
#define XB_TOP      3328
#define XB_TOPGEN   3392
#define XCD_BAR_WORDS 3456
#define XB_SPIN_CAP (1u << 18)
DI unsigned xb_ld(unsigned* p)              { return __hip_atomic_load(p, __ATOMIC_RELAXED, __HIP_MEMORY_SCOPE_AGENT); }
DI unsigned xb_add(unsigned* p, unsigned v) { return __hip_atomic_fetch_add(p, v, __ATOMIC_RELAXED, __HIP_MEMORY_SCOPE_AGENT); }
DI unsigned xb_xcc_id() { return (unsigned)__builtin_amdgcn_s_getreg((3 << 11) | 20) & 0xFu; }
#define XB_SPIN(cond, bar) do { unsigned _sp = 0; while (cond) { __builtin_amdgcn_s_sleep(1); \
    if ((++_sp & 255u) == 0u) { if (xb_ld(&(bar)[XB_TMO])) break; if (_sp > XB_SPIN_CAP) { atomicAdd(&(bar)[XB_TMO], 1u); break; } } } } while (0)
struct XcdBarrier { unsigned* bar; unsigned x; volatile LAS unsigned* st; int w0; };
DI XcdBarrier xcd_barrier_post(unsigned* bar, volatile LAS unsigned* st, int w0) {
    XcdBarrier b; b.bar = bar; b.x = xb_xcc_id(); b.st = st; b.w0 = w0;
    if (fresh_tid_(w0) == 0) (void)xb_add(&bar[XB_XCNT(b.x)], 1u);
    return b;
}
DI void xcd_barrier_complete(unsigned* bar, unsigned x, unsigned& nloc, unsigned& nx) {
    const unsigned G = gridDim.x * gridDim.y * gridDim.z;
    unsigned sum, cnt, mine, sp = 0u;
    for (;;) {
        sum = 0u; cnt = 0u; mine = 0u;
#pragma unroll
        for (unsigned j = 0; j < 16; ++j) { const unsigned c = xb_ld(&bar[XB_XCNT(j)]); sum += c; cnt += (c > 0u) ? 1u : 0u; mine = (j == x) ? c : mine; }
        if (sum == G) break;
        __builtin_amdgcn_s_sleep(1);
        if ((++sp & 255u) == 0u) { if (xb_ld(&bar[XB_TMO])) break; if (sp > XB_SPIN_CAP) { atomicAdd(&bar[XB_TMO], 1u); break; } }
    }
    nloc = mine > 0u ? mine : 1u; nx = cnt > 0u ? cnt : 1u;
}
DI void xcd_barrier(const XcdBarrier& b) {
    asm volatile("s_waitcnt vmcnt(0)" ::: "memory");
    __syncthreads();
    if (fresh_tid_(b.w0) == 0) {
        unsigned* bar = b.bar;
        __builtin_amdgcn_s_waitcnt(0);
        unsigned nloc = b.st[0], nx = b.st[1];
        if (nloc == 0u) { xcd_barrier_complete(bar, b.x, nloc, nx); b.st[0] = nloc; b.st[1] = nx; }
        const unsigned old = xb_add(&bar[XB_XSUB(b.x)], 1u);
        const unsigned gen = old / nloc;
        if (old + 1u == (gen + 1u) * nloc) {
            __builtin_amdgcn_fence(__ATOMIC_RELEASE, "agent");
            asm volatile("s_waitcnt vmcnt(0)" ::: "memory");
            const unsigned og = xb_add(&bar[XB_TOP], 1u);
            const unsigned tg = og / nx;
            if (og + 1u == (tg + 1u) * nx) xb_add(&bar[XB_TOPGEN], 1u);
            else XB_SPIN(xb_ld(&bar[XB_TOPGEN]) == tg, bar);
            __builtin_amdgcn_fence(__ATOMIC_ACQUIRE, "agent");
            xb_add(&bar[XB_XGEN(b.x)], 1u);
            asm volatile("s_waitcnt vmcnt(0)" ::: "memory");
        } else {
            XB_SPIN(xb_ld(&bar[XB_XGEN(b.x)]) == gen, bar);
            __builtin_amdgcn_fence(__ATOMIC_ACQUIRE, "agent");
            asm volatile("s_waitcnt vmcnt(0)" ::: "memory");
        }
    }
    __syncthreads();
}

struct Args { const float* in[37]; float* out; unsigned char* ws; int ph_lo, ph_hi; };
enum { I_X = 0, I_MEM, I_NMIXG, I_WIN, I_CONVW, I_CONVB, I_LWX, I_LBX, I_LWA, I_LBA, I_LAM, I_MU, I_W0, I_WUP, I_A0, I_AUP, I_GUP, I_KK, I_KA, I_RK, I_LNG, I_LNB,
       I_WOUT, I_NXAG, I_NMEMG, I_WQ, I_WK, I_WV, I_WO, I_NFFG, I_WR, I_BR, I_WGU, I_BGU, I_WDN, I_BDN, I_FNG };

DI void transpose_item(const float* W, int ldw, int K, bf16* WT, int k0, int n0, int drow0, LAS float* scr, int lane, const float* rs = nullptr) {
    f32x4 t[8];
    const float* src = W + (size_t)(k0 + (lane >> 3)) * ldw + n0 + 4 * (lane & 7);
#pragma unroll
    for (int i = 0; i < 8; ++i) t[i] = *(const f32x4*)(src + (size_t)(8 * i) * ldw);
#pragma unroll
    for (int i = 0; i < 8; ++i) { const float sc_ = rs ? rs[k0 + 8 * i + (lane >> 3)] : 1.0f; LAS float* d = scr + (8 * i + (lane >> 3)) * 33 + 4 * (lane & 7); d[0] = t[i].x * sc_; d[1] = t[i].y * sc_; d[2] = t[i].z * sc_; d[3] = t[i].w * sc_; }
    asm volatile("s_waitcnt lgkmcnt(0)" ::: "memory");
    const int c = lane & 7;
#pragma unroll
    for (int j = 0; j < 4; ++j) { const int n = (lane >> 3) + 8 * j; const LAS float* s = scr + (8 * c) * 33 + n;
        u32x4 o; o.x = pk2(s[0 * 33], s[1 * 33]); o.y = pk2(s[2 * 33], s[3 * 33]); o.z = pk2(s[4 * 33], s[5 * 33]); o.w = pk2(s[6 * 33], s[7 * 33]);
        *(u32x4*)(WT + (size_t)(drow0 + n) * K + k0 + 8 * c) = o; }
    asm volatile("s_waitcnt lgkmcnt(0)" ::: "memory");
}
DI void transpose_item_tiled(const float* W, int ldw, int K, bf16* WTe, int k0, int n0, int drow0, LAS float* scr, int lane) {
    f32x4 t[8];
    const float* src = W + (size_t)(k0 + (lane >> 3)) * ldw + n0 + 4 * (lane & 7);
#pragma unroll
    for (int i = 0; i < 8; ++i) t[i] = *(const f32x4*)(src + (size_t)(8 * i) * ldw);
#pragma unroll
    for (int i = 0; i < 8; ++i) { LAS float* d = scr + (8 * i + (lane >> 3)) * 33 + 4 * (lane & 7); d[0] = t[i].x; d[1] = t[i].y; d[2] = t[i].z; d[3] = t[i].w; }
    asm volatile("s_waitcnt lgkmcnt(0)" ::: "memory");
    const int c = lane & 7;
#pragma unroll
    for (int j = 0; j < 4; ++j) { const int n = (lane >> 3) + 8 * j; const LAS float* s = scr + (8 * c) * 33 + n;
        u32x4 o; o.x = pk2(s[0 * 33], s[1 * 33]); o.y = pk2(s[2 * 33], s[3 * 33]); o.z = pk2(s[4 * 33], s[5 * 33]); o.w = pk2(s[6 * 33], s[7 * 33]);
        const int drow = drow0 + n, pn = drow >> 8, half = (drow >> 7) & 1, r = drow & 127, x = r & 31;
        const int rslot = (r & ~31) + 16 * ((x >> 2) & 1) + 4 * (x >> 3) + (x & 3);
        const size_t tb = ((size_t)(pn * (K / 64) + (k0 >> 6)) * 2 + half) * 16384 + pg8::lds_byte(rslot, 8 * c);
        *(u32x4*)((char*)WTe + tb) = o; }
    asm volatile("s_waitcnt lgkmcnt(0)" ::: "memory");
}
DI void transpose_item_tiled_nolds(const float* W, int ldw, int K, bf16* WTe, int k0, int n0, int drow0, int lane) {
    const int n = lane & 31, kh = lane >> 5;
    const float* src = W + (size_t)(k0 + 32 * kh) * ldw + n0 + n;
    float t[32];
#pragma unroll
    for (int i = 0; i < 32; ++i) t[i] = src[(size_t)i * ldw];
    const int drow = drow0 + n, pn = drow >> 8, half = (drow >> 7) & 1, r = drow & 127, x = r & 31;
    const int rslot = (r & ~31) + 16 * ((x >> 2) & 1) + 4 * (x >> 3) + (x & 3);
    const size_t tb0 = ((size_t)(pn * (K / 64) + (k0 >> 6)) * 2 + half) * 16384;
#pragma unroll
    for (int c = 0; c < 4; ++c) { u32x4 o; o.x = pk2(t[8 * c], t[8 * c + 1]); o.y = pk2(t[8 * c + 2], t[8 * c + 3]); o.z = pk2(t[8 * c + 4], t[8 * c + 5]); o.w = pk2(t[8 * c + 6], t[8 * c + 7]);
        *(u32x4*)((char*)WTe + tb0 + pg8::lds_byte(rslot, 32 * kh + 8 * c)) = o; }
}
DI void transpose_item_tiled_fp8_nolds(const float* W, int ldw, int K, unsigned char* WTe, int k0, int n0, int drow0, int lane) {
    const int n = lane & 31, kh = lane >> 5;
    const float* src = W + (size_t)(k0 + 32 * kh) * ldw + n0 + n;
    float t[32];
#pragma unroll
    for (int i = 0; i < 32; ++i) t[i] = src[(size_t)i * ldw] * 64.f;
    const int drow = drow0 + n, pn = drow >> 8, half = (drow >> 7) & 1, r = drow & 127, x = r & 31;
    const int rslot = (r & ~31) + 16 * ((x >> 2) & 1) + 4 * (x >> 3) + (x & 3);
    const size_t tb0 = ((size_t)(pn * (K / 128) + (k0 >> 7)) * 2 + half) * 16384;
#pragma unroll
    for (int c = 0; c < 2; ++c) { u32x4 o; o.x = pk4_fp8(t[16 * c], t[16 * c + 1], t[16 * c + 2], t[16 * c + 3]); o.y = pk4_fp8(t[16 * c + 4], t[16 * c + 5], t[16 * c + 6], t[16 * c + 7]);
        o.z = pk4_fp8(t[16 * c + 8], t[16 * c + 9], t[16 * c + 10], t[16 * c + 11]); o.w = pk4_fp8(t[16 * c + 12], t[16 * c + 13], t[16 * c + 14], t[16 * c + 15]);
        const int bc = (k0 & 64) + 32 * kh + 16 * c;
        *(u32x4*)(WTe + tb0 + pg8::lds_byte(rslot, bc >> 1)) = o; }
}
DI void transpose_item_tiled_fp8(const float* W, int ldw, int K, unsigned char* WTe, int k0, int n0, int drow0, LAS float* scr, int lane) {
    f32x4 t[8];
    const float* src = W + (size_t)(k0 + (lane >> 3)) * ldw + n0 + 4 * (lane & 7);
#pragma unroll
    for (int i = 0; i < 8; ++i) t[i] = *(const f32x4*)(src + (size_t)(8 * i) * ldw);
#pragma unroll
    for (int i = 0; i < 8; ++i) { LAS float* d = scr + (8 * i + (lane >> 3)) * 33 + 4 * (lane & 7); d[0] = t[i].x * 64.f; d[1] = t[i].y * 64.f; d[2] = t[i].z * 64.f; d[3] = t[i].w * 64.f; }
    asm volatile("s_waitcnt lgkmcnt(0)" ::: "memory");
    const int c = lane & 3;
#pragma unroll
    for (int j = 0; j < 2; ++j) { const int n = (lane >> 2) + 16 * j; const LAS float* sp = scr + (16 * c) * 33 + n;
        u32x4 o; o.x = pk4_fp8(sp[0 * 33], sp[1 * 33], sp[2 * 33], sp[3 * 33]); o.y = pk4_fp8(sp[4 * 33], sp[5 * 33], sp[6 * 33], sp[7 * 33]);
        o.z = pk4_fp8(sp[8 * 33], sp[9 * 33], sp[10 * 33], sp[11 * 33]); o.w = pk4_fp8(sp[12 * 33], sp[13 * 33], sp[14 * 33], sp[15 * 33]);
        const int drow = drow0 + n, pn = drow >> 8, half = (drow >> 7) & 1, r = drow & 127, x = r & 31;
        const int rslot = (r & ~31) + 16 * ((x >> 2) & 1) + 4 * (x >> 3) + (x & 3);
        const int bc = (k0 & 64) + 16 * c;
        const size_t tb = ((size_t)(pn * (K / 128) + (k0 >> 7)) * 2 + half) * 16384 + pg8::lds_byte(rslot, bc >> 1);
        *(u32x4*)(WTe + tb) = o; }
    asm volatile("s_waitcnt lgkmcnt(0)" ::: "memory");
}
DI void rms_row_to_bf16(const float* xrow, const float* g, bf16* orow, int lane) {
    const f32x4* xr = (const f32x4*)xrow + lane; const f32x4* gr = (const f32x4*)g + lane;
    f32x4 v[4]; float s = 0.f;
#pragma unroll
    for (int j = 0; j < 4; ++j) { v[j] = xr[64 * j]; s += (v[j].x * v[j].x + v[j].y * v[j].y) + (v[j].z * v[j].z + v[j].w * v[j].w); }
    const float rstd = rsq_f(wave_sum(s) * (1.f / D) + EPS);
    u32x2* o8 = (u32x2*)orow + lane;
#pragma unroll
    for (int j = 0; j < 4; ++j) { const f32x4 gg = gr[64 * j]; u32x2 w; w.x = pk2(v[j].x * rstd * gg.x, v[j].y * rstd * gg.y); w.y = pk2(v[j].z * rstd * gg.z, v[j].w * rstd * gg.w); o8[64 * j] = w; }
}

DI void rms_rowbf_to_bf16(const bf16* xrow, const float* g, bf16* orow, int lane) {
    float v[16]; float s = 0.f;
#pragma unroll
    for (int hf = 0; hf < 2; ++hf) { const u32x4 w = *(const u32x4*)(xrow + 512 * hf + 8 * lane);
#pragma unroll
        for (int q = 0; q < 4; ++q) { v[8 * hf + 2 * q] = bflo(w[q]); v[8 * hf + 2 * q + 1] = bfhi(w[q]); } }
#pragma unroll
    for (int j = 0; j < 16; ++j) s += v[j] * v[j];
    const float rstd = rsq_f(wave_sum(s) * (1.f / D) + EPS);
#pragma unroll
    for (int hf = 0; hf < 2; ++hf) { const f32x4 g0 = *(const f32x4*)(g + 512 * hf + 8 * lane), g1 = *(const f32x4*)(g + 512 * hf + 8 * lane + 4);
        u32x4 w; w.x = pk2(v[8 * hf] * rstd * g0.x, v[8 * hf + 1] * rstd * g0.y); w.y = pk2(v[8 * hf + 2] * rstd * g0.z, v[8 * hf + 3] * rstd * g0.w);
        w.z = pk2(v[8 * hf + 4] * rstd * g1.x, v[8 * hf + 5] * rstd * g1.y); w.w = pk2(v[8 * hf + 6] * rstd * g1.z, v[8 * hf + 7] * rstd * g1.w);
        *(u32x4*)(orow + 512 * hf + 8 * lane) = w; }
}

__global__ void __launch_bounds__(NTHREADS, 2) fwd(Args args) {
    extern __shared__ __attribute__((aligned(16))) unsigned char lds_raw[];
    LAS unsigned char* lds = (LAS unsigned char*)lds_raw;
    volatile LAS unsigned* MISC = (volatile LAS unsigned*)(lds + MISC_OFF);
    const int G = gridDim.x, bid = blockIdx.x, NGW = G * NWAVES;
    const int wv0 = __builtin_amdgcn_readfirstlane((int)(threadIdx.x >> 6));
#define PHASE_IDS const int tid = fresh_tid(), lane = tid & 63, wave = __builtin_amdgcn_readfirstlane(tid >> 6), gw = bid * NWAVES + wave; (void)tid; (void)lane; (void)wave; (void)gw
    unsigned char* ws = args.ws;
    unsigned* ctl = (unsigned*)(ws + WS_CTL);
    const int lo = args.ph_lo, hi = args.ph_hi;

    for (int u = fresh_tid(); u < (LDS_BYTES - RING_BYTES) / 4; u += NTHREADS) ((LAS unsigned*)(lds + RING_BYTES))[u] = 0u;
    __syncthreads();
    XcdBarrier bar; bar.bar = ctl + CW_BAR; bar.x = 0; bar.st = nullptr; bar.w0 = wv0;
    if (hi - lo > 1) bar = xcd_barrier_post(ctl + CW_BAR, MISC + 8, wv0);
#define IN(k) (lo <= (k) && (k) < hi)
#define SEAM(k) do { if (IN(k) && IN((k) + 1)) xcd_barrier(bar); } while (0)

#define Win_t ((bf16*)(ws + WS_WIN))
#define Wout_t ((bf16*)(ws + WS_WOUT))
#define Wq_t ((bf16*)(ws + WS_WQ))
#define Wk_t ((bf16*)(ws + WS_WK))
#define Wv_t ((bf16*)(ws + WS_WV))
#define Wo_t ((bf16*)(ws + WS_WO))
#define LoraB ((bf16*)(ws + WS_LORAB))
#define LruW ((bf16*)(ws + WS_LRUW))
#define WrT ((bf16*)(ws + WS_LRUW + 512 * 1024))
#define Wgu_t ((bf16*)(ws + WS_WGU))
#define Wdn_t ((bf16*)(ws + WS_WDN))
#define HN ((bf16*)(ws + WS_HN))
#define MEMN ((bf16*)(ws + WS_MEMN))
#define KM ((bf16*)(ws + WS_KM))
#define VT ((bf16*)(ws + WS_VT))
#define X1 ((bf16*)(ws + WS_X1))
#define X2 ((bf16*)(ws + WS_X2))
#define U ((bf16*)(ws + WS_U))
#define Rr ((float*)(ws + WS_R))
#define KRAW ((float*)(ws + WS_KRAW))
#define Vv ((float*)(ws + WS_V))
#define KKN ((float*)(ws + WS_KKN))
#define WD ((float*)(ws + WS_WD))
#define AA ((float*)(ws + WS_AA))
#define GG ((float*)(ws + WS_G))
#define LA ((bf16*)(ws + WS_LA))
#define LB ((bf16*)(ws + WS_LB))
#define AP ((bf16*)(ws + WS_AP))
#define CAT ((bf16*)(ws + WS_CAT))
#define Qb ((bf16*)(ws + WS_Q))
#define Ob CAT
#define X1F8 ((unsigned char*)(ws + WS_XS))
#define XS ((bf16*)(ws + WS_XS))
#define ACT ((bf16*)(ws + WS_ACT))
#define YS ((bf16*)(ws + WS_YS))
#define route_e ((int*)(ws + WS_ROUTE + RT_E))
#define route_pos ((int*)(ws + WS_ROUTE + RT_POS))
#define route_g ((float*)(ws + WS_ROUTE + RT_G))
#define row_sg ((u32x2*)(ws + WS_ROUTE + RT_SLOT))
#define tile_tab ((int*)(ws + WS_ROUTE + RT_TILE))
#define row_tok ((int*)(ws + WS_ROUTE + RT_TOK))
#define ecnt (ctl + CW_CNT)

    if (IN(0)) { PHASE_IDS;
        LAS float* scr = (LAS float*)(lds + wave * 16384);
        constexpr int I_IN = 16 * (INW / 32), I_SQ = 16 * 32;
        constexpr int N_ITEMS = I_IN + 5 * I_SQ;
        for (int it = gw; it < N_ITEMS; it += NGW) {
            int r = it;
            if (r < I_IN) { const int nblk = INW / 32, kb = r / nblk, nb = r % nblk; transpose_item(args.in[I_WIN], INW, D, Win_t, 64 * kb, 32 * nb, 32 * nb, scr, lane); continue; } r -= I_IN;
            { const int w = r / I_SQ, q = r % I_SQ, kb = q / 32, nb = q % 32;
                if (w == 1) continue;
                const float* src = w == 0 ? args.in[I_WOUT] : w == 2 ? args.in[I_WK] : w == 3 ? args.in[I_WV] : args.in[I_WO];
                bf16* dst = w == 0 ? Wout_t : w == 2 ? Wk_t : w == 3 ? Wv_t : Wo_t;
                transpose_item(src, D, D, dst, 64 * kb, 32 * nb, 32 * nb, scr, lane); }
        }
        for (int idx = bid * NTHREADS + tid; idx < D * D / 4; idx += G * NTHREADS) { const f32x4 v = ((const f32x4*)args.in[I_WQ])[idx]; const float gk = args.in[I_NXAG][idx >> 8];
            u32x2 w; w.x = pk2(v.x * gk, v.y * gk); w.y = pk2(v.z * gk, v.w * gk); ((u32x2*)Wq_t)[idx] = w; }
        for (int idx = bid * NTHREADS + tid; idx < 1536 * 256; idx += G * NTHREADS) {
            const int e = idx & 7, ln = (idx >> 3) & 63, ks = (idx >> 9) & 7, ct = (idx >> 12) & 3, hk = idx >> 14, hh = hk / 3, kind = hk - 3 * hh;
            const int k = 32 * ks + 8 * (ln >> 4) + e, n = hh * 64 + 16 * ct + (ln & 15); float v = 0.f;
            if (kind == 0) { if (k < 64) v = args.in[I_WUP][k * 512 + n]; }
            else if (kind == 1) { if (k >= 64 && k < 128) v = args.in[I_AUP][(k - 64) * 512 + n]; }
            else { if (k >= 128) v = args.in[I_GUP][(k - 128) * 512 + n]; }
            LoraB[idx] = (bf16)f2bf(v);
        }
        for (int idx = bid * NTHREADS + tid; idx < 8 * 128 * 64; idx += G * NTHREADS) {
            const int nb = idx >> 13, col = (idx >> 6) & 127, k = idx & 63;
            const float v = col < 64 ? args.in[I_LWX][nb * 4096 + k * 64 + col] : args.in[I_LWA][nb * 4096 + k * 64 + (col - 64)];
            LruW[idx] = (bf16)f2bf(v);
        }
        for (int idx = bid * NTHREADS + tid; idx < NE * D; idx += G * NTHREADS) {
            const int e = idx >> 10, k = idx & 1023; const float v = args.in[I_WR][k * NE + e];
            const unsigned hi = f2bf(v); const float lo = v - __uint_as_float(hi << 16);
            WrT[idx] = (bf16)hi; WrT[NE * D + idx] = (bf16)f2bf(lo);
        }
        for (int m = gw; m < M; m += NGW) rms_row_to_bf16(args.in[I_X] + (size_t)m * D, args.in[I_NMIXG], HN + (size_t)m * D, lane);
        for (int m = gw; m < MROWS; m += NGW) rms_row_to_bf16(args.in[I_MEM] + (size_t)m * D, args.in[I_NMEMG], MEMN + (size_t)m * D, lane);
        {
            LAS float* scr = (LAS float*)(lds + wave * 16384);
            constexpr int I_GU = 16 * 64, I_DN = 16 * 32;
            for (int it = CONV_P9 + gw; it < NE * I_GU; it += NGW) {
                int r = it;
                if (r < NE * I_GU) { const int e = r / I_GU, q = r % I_GU, kb = q / 64, nb = q % 64; const int n0 = 32 * nb;
                    const int drow = n0 < 1024 ? (256 * (n0 >> 7) + (n0 & 127)) : (256 * ((n0 - 1024) >> 7) + 128 + ((n0 - 1024) & 127));
                    transpose_item_tiled_fp8(args.in[I_WGU] + (size_t)e * D * 2048, 2048, D, (unsigned char*)Wgu_t + (size_t)e * 2048 * D, 64 * kb, n0, drow, scr, lane); continue; } r -= NE * I_GU;
                { const int e = r / I_DN, q = r % I_DN, kb = q / 32, nb = q % 32;
                  transpose_item_tiled(args.in[I_WDN] + (size_t)e * DFF * D, D, DFF, Wdn_t + (size_t)e * D * DFF, 64 * kb, 32 * nb, 32 * nb, scr, lane); }
            }
        }
    }
    SEAM(0);

    if (IN(1)) { PHASE_IDS;
        { pg8::DenseSched S; S.o.init_tiles(M / 256, INW / 256, G, bid); S.A = (const char*)HN; S.B = (const char*)Win_t; S.tstep = (size_t)256 * D * 2;
          EpiBf16Plain E{U, INW, 1.0f}; pg8::gemm_phase(lds, D, S, E, wv0); }
        { pg8::DenseSched S; S.o.init_tiles(MROWS / 256, D / 256, G, (bid + 64) & (G - 1)); S.A = (const char*)MEMN; S.B = (const char*)Wk_t; S.tstep = (size_t)256 * D * 2;
          EpiBf16Plain E{KM, D, 1.0f}; pg8::gemm_phase(lds, D, S, E, wv0); }
        { pg8::DenseSched S; S.o.init_tiles(MROWS / 256, D / 256, G, (bid + 48) & (G - 1)); S.A = (const char*)MEMN; S.B = (const char*)Wv_t; S.tstep = (size_t)256 * D * 2;
          EpiBf16Plain E{VT, D, 1.0f}; pg8::gemm_phase(lds, D, S, E, wv0); }
    }
    SEAM(1);

    if (IN(2)) { PHASE_IDS;
        const float* conv_w = args.in[I_CONVW]; const float* conv_b = args.in[I_CONVB];
        LAS float* xs = (LAS float*)(lds + wave * 16384);
        LAS bf16* tP = (LAS bf16*)(lds + wave * 16384 + 4096); LAS bf16* tH = tP + 1024;
        const int i = lane & 15, kg = lane >> 4;
        for (int unit = gw; unit < (M / 64) * 8; unit += NGW) {
            const int seg = unit >> 3, nb = unit & 7, m0s = seg * 64, s0s = m0s & (SEQ - 1);
            bf16x8 wf[8][2];
#pragma unroll
            for (int ct = 0; ct < 8; ++ct)
#pragma unroll
                for (int ks = 0; ks < 2; ++ks) wf[ct][ks] = *(const bf16x8*)(LruW + ((size_t)(nb * 128 + 16 * ct + i) * 64 + 32 * ks + 8 * kg));
            float bxv[4], bav[4], spv[4], Arun[4], Brun[4];
#pragma unroll
            for (int ct = 0; ct < 4; ++ct) { const int ch = nb * 64 + 16 * ct + i; bxv[ct] = args.in[I_LBX][ch]; bav[ct] = args.in[I_LBA][ch]; spv[ct] = softplus_f(-args.in[I_LAM][ch]); Arun[ct] = 1.f; Brun[ct] = 0.f; }
#pragma unroll 1
            for (int jt = 0; jt < 4; ++jt) {
                const int m0 = m0s + 16 * jt, s0 = s0s + 16 * jt;
                bf16x8 af[2];
#pragma unroll
                for (int ks = 0; ks < 2; ++ks) {
                    const int chb = nb * 64 + 32 * ks + 8 * kg;
                    f32x4 x0 = *(const f32x4*)(conv_b + chb), x1 = *(const f32x4*)(conv_b + chb + 4);
#pragma unroll
                    for (int j = 0; j < 4; ++j) {
                        const bool ok = s0 + i - 3 + j >= 0;
                        u32x4 uw = *(const u32x4*)(U + (size_t)(ok ? m0 + i - 3 + j : m0) * INW + chb); if (!ok) uw = (u32x4){0u, 0u, 0u, 0u};
                        const f32x4 w0 = *(const f32x4*)(conv_w + j * 512 + chb), w1 = *(const f32x4*)(conv_w + j * 512 + chb + 4);
                        x0.x += w0.x * bflo(uw.x); x0.y += w0.y * bfhi(uw.x); x0.z += w0.z * bflo(uw.y); x0.w += w0.w * bfhi(uw.y);
                        x1.x += w1.x * bflo(uw.z); x1.y += w1.y * bfhi(uw.z); x1.z += w1.z * bflo(uw.w); x1.w += w1.w * bfhi(uw.w);
                    }
                    *(LAS f32x4*)(xs + i * 64 + 32 * ks + 8 * kg) = x0; *(LAS f32x4*)(xs + i * 64 + 32 * ks + 8 * kg + 4) = x1;
                    u32x4 p; p.x = pk2(x0.x, x0.y); p.y = pk2(x0.z, x0.w); p.z = pk2(x1.x, x1.y); p.w = pk2(x1.z, x1.w);
                    af[ks] = __builtin_bit_cast(bf16x8, p);
                }
                f32x4 acc[8];
#pragma unroll
                for (int ct = 0; ct < 8; ++ct) { acc[ct] = (f32x4){0.f, 0.f, 0.f, 0.f};
#pragma unroll
                    for (int ks = 0; ks < 2; ++ks) acc[ct] = __builtin_amdgcn_mfma_f32_16x16x32_bf16(af[ks], wf[ct][ks], acc[ct], 0, 0, 0); }
#pragma unroll
                for (int ct = 0; ct < 4; ++ct) {
                    const int col = 16 * ct + i;
                    float hl[4], pl[4]; float hprev = 0.f, pprev = 1.f;
#pragma unroll
                    for (int e = 0; e < 4; ++e) {
                        const float gx = sigmoid_f(acc[ct][e] + bxv[ct]), ga = sigmoid_f(acc[ct + 4][e] + bav[ct]);
                        const float la = -8.0f * ga * spv[ct], av = __expf(la), xcv = xs[(4 * kg + e) * 64 + col];
                        const float bt = __builtin_amdgcn_sqrtf(fmaxf(1.0f - av * av, 0.f)) * gx * xcv;
                        hprev = av * hprev + bt; pprev *= av; hl[e] = hprev; pl[e] = pprev;
                    }
                    float Ag[4], Bg[4];
#pragma unroll
                    for (int gq = 0; gq < 4; ++gq) { Ag[gq] = __shfl(pl[3], i + 16 * gq); Bg[gq] = __shfl(hl[3], i + 16 * gq); }
                    float Ain = Arun[ct], Bin = Brun[ct];
#pragma unroll
                    for (int gq = 0; gq < 3; ++gq) if (gq < kg) { Bin = Ag[gq] * Bin + Bg[gq]; Ain *= Ag[gq]; }
                    float At = 1.f, Bt = 0.f;
#pragma unroll
                    for (int gq = 0; gq < 4; ++gq) { Bt = Ag[gq] * Bt + Bg[gq]; At *= Ag[gq]; }
                    Brun[ct] = At * Brun[ct] + Bt; Arun[ct] *= At;
#pragma unroll
                    for (int e = 0; e < 4; ++e) { const int ti_ = (4 * kg + e) * 64 + col; tP[ti_] = (bf16)f2bf(pl[e] * Ain); tH[ti_] = (bf16)f2bf(hl[e] + pl[e] * Bin); }
                }
                { const int rr = lane >> 2, cq = lane & 3;
                  bf16* pp = LA + (size_t)(m0 + rr) * 512 + nb * 64 + 16 * cq; bf16* hp = LB + (size_t)(m0 + rr) * 512 + nb * 64 + 16 * cq;
                  *(u32x4*)pp = *(const LAS u32x4*)(tP + rr * 64 + 16 * cq); *(u32x4*)(pp + 8) = *(const LAS u32x4*)(tP + rr * 64 + 16 * cq + 8);
                  *(u32x4*)hp = *(const LAS u32x4*)(tH + rr * 64 + 16 * cq); *(u32x4*)(hp + 8) = *(const LAS u32x4*)(tH + rr * 64 + 16 * cq + 8); }
            }
            if (kg == 0) {
#pragma unroll
                for (int ct = 0; ct < 4; ++ct) { f32x2 ab; ab.x = Arun[ct]; ab.y = Brun[ct];
                    *(f32x2*)((float*)(ws + WS_AP) + ((size_t)(((seg >> 6) * 8 + nb) * 64 + (seg & 63)) * 64 + 16 * ct + i) * 2) = ab; }
            }
        }
    }
    SEAM(2);


#define RW_ZB(zz, zb) do { _Pragma("unroll") for (int ks_ = 0; ks_ < 2; ++ks_) { u32x4 p_; p_.x = pk2(zz[2 * ks_][0], zz[2 * ks_][1]); p_.y = pk2(zz[2 * ks_][2], zz[2 * ks_][3]); \
        p_.z = pk2(zz[2 * ks_ + 1][0], zz[2 * ks_ + 1][1]); p_.w = pk2(zz[2 * ks_ + 1][2], zz[2 * ks_ + 1][3]); zb[ks_] = __builtin_bit_cast(bf16x8, p_); } } while (0)
    if (IN(3)) { PHASE_IDS;
        for (int u64 = gw; u64 < NB * NH * (SEQ / 64); u64 += NGW) {
#pragma unroll 1
        for (int jj = 0; jj < 4; ++jj) {
        LAS unsigned char* wl = lds + wave * 16384;
        LAS bf16* Arm = (LAS bf16*)(wl); LAS bf16* Brm = (LAS bf16*)(wl + 2048); LAS bf16* Krm = (LAS bf16*)(wl + 4096); LAS bf16* Rrm = (LAS bf16*)(wl + 6144);
        LAS bf16* ATt = (LAS bf16*)(wl + 8192); LAS bf16* BTt = (LAS bf16*)(wl + 10240); LAS bf16* KTt = (LAS bf16*)(wl + 12288); LAS bf16* VTt = (LAS bf16*)(wl + 14336);
        LAS float* MabT = (LAS float*)(wl); LAS bf16* Mak = (LAS bf16*)(wl + 1024); LAS bf16* Mrb = (LAS bf16*)(wl + 1536); LAS bf16* Mrk = (LAS bf16*)(wl + 2048); LAS bf16* Tm = (LAS bf16*)(wl + 2560);
        LAS float* PLs = (LAS float*)(wl + 3072); LAS bf16* Q0T = (LAS bf16*)(wl + 4096);
        const int lane = fresh_tid() & 63, l15 = lane & 15, g = lane >> 4, te = lane >> 2, kq = lane & 3;
        const bf16x8 z8 = (bf16x8){0, 0, 0, 0, 0, 0, 0, 0};
        const f32x4 z4 = (f32x4){0.f, 0.f, 0.f, 0.f};
            const int un = u64 * 4 + jj;
            const int bh = un >> 8, c = un & 255, b = bh >> 3, h = bh & 7;
            const size_t mrow = (size_t)b * SEQ + c * 16 + te, off = mrow * 512 + h * 64 + 16 * kq;
            const int hc = h * 64 + 16 * kq;
            LAS float* tmpL = (LAS float*)wl;
            {
                const int rsub = lane >> 5, chunk = lane & 31; const size_t mt0 = (size_t)b * SEQ + c * 16;
                const f32x4 m0 = *(const f32x4*)(args.in[I_MU] + 1536 + 8 * chunk), m1 = *(const f32x4*)(args.in[I_MU] + 1536 + 8 * chunk + 4);
                u32x4 cu[8], pu[8];
#pragma unroll
                for (int i = 0; i < 8; ++i) { const size_t mr = mt0 + 2 * i + rsub; const bool hp2 = (mr & (SEQ - 1)) != 0; const bf16* ua = U + mr * INW + 2560 + 8 * chunk;
                    cu[i] = *(const u32x4*)ua; pu[i] = *(const u32x4*)(ua - (hp2 ? INW : 0)); if (!hp2) pu[i] = (u32x4){0u, 0u, 0u, 0u}; }
#pragma unroll
                for (int i = 0; i < 8; ++i) { float o8[8];
#pragma unroll
                    for (int q = 0; q < 4; ++q) { const float c0 = bflo(cu[i][q]), c1 = bfhi(cu[i][q]), p0 = bflo(pu[i][q]), p1 = bfhi(pu[i][q]); const float mm0 = q < 2 ? m0[2 * q] : m1[2 * q - 4], mm1 = q < 2 ? m0[2 * q + 1] : m1[2 * q - 3];
                        float x0 = c0 + (p0 - c0) * mm0, x1 = c1 + (p1 - c1) * mm1;
                        if (chunk < 8) { x0 = tanh_fast(x0); x1 = tanh_fast(x1); }
                        else if (chunk >= 16) { x0 = sigmoid_f(x0); x1 = sigmoid_f(x1); }
                        o8[2 * q] = x0; o8[2 * q + 1] = x1; }
                    u32x4 pw; pw.x = pk2(o8[0], o8[1]); pw.y = pk2(o8[2], o8[3]); pw.z = pk2(o8[4], o8[5]); pw.w = pk2(o8[6], o8[7]);
                    const int row = 2 * i + rsub; *(LAS u32x4*)(wl + row * 512 + ((chunk ^ (row & 7)) << 4)) = pw; }
                bf16x8 af[8];
#pragma unroll
                for (int ks = 0; ks < 8; ++ks) af[ks] = *(const LAS bf16x8*)(wl + l15 * 512 + (((4 * ks + g) ^ (l15 & 7)) << 4));
                asm volatile("s_waitcnt lgkmcnt(0)" ::: "memory");
#pragma unroll
                for (int kind = 0; kind < 3; ++kind)
#pragma unroll
                    for (int ct = 0; ct < 4; ++ct) {
                        const bf16* lb = LoraB + ((size_t)((h * 3 + kind) * 4 + ct) * 8 * 64 + lane) * 8;
                        f32x4 a4 = z4;
#pragma unroll
                        for (int ks = (kind == 0 ? 0 : kind == 1 ? 2 : 4); ks < (kind == 0 ? 2 : kind == 1 ? 4 : 8); ++ks) a4 = __builtin_amdgcn_mfma_f32_16x16x32_bf16(af[ks], *(const bf16x8*)(lb + ks * 512), a4, 0, 0, 0);
#pragma unroll
                        for (int e = 0; e < 4; ++e) tmpL[kind * 1088 + (4 * g + e) * 68 + 16 * ct + l15] = a4[e];
                    }
            }
            asm volatile("s_waitcnt lgkmcnt(0)" ::: "memory");
            float cl[16], eP[16];
            {
                float lwv[16], rl[16], kl[16], vl[16], kn[16], av[16];
                const bool hp = (mrow & (SEQ - 1)) != 0;
                const bf16* ub = U + mrow * INW + 1024 + hc;
#pragma unroll
                for (int hh = 0; hh < 2; ++hh) {
#pragma unroll
                    for (int a3 = 0; a3 < 3; ++a3) {
                        const u32x4 cu = *(const u32x4*)(ub + 512 * a3 + 8 * hh); u32x4 pu = *(const u32x4*)(ub - (hp ? INW : 0) + 512 * a3 + 8 * hh); if (!hp) pu = (u32x4){0u, 0u, 0u, 0u};
                        const f32x4 m0 = *(const f32x4*)(args.in[I_MU] + 512 * a3 + hc + 8 * hh), m1 = *(const f32x4*)(args.in[I_MU] + 512 * a3 + hc + 8 * hh + 4);
                        float o8[8];
#pragma unroll
                        for (int q = 0; q < 4; ++q) { const float c0 = bflo(cu[q]), c1 = bfhi(cu[q]), p0 = bflo(pu[q]), p1 = bfhi(pu[q]); const float mm0 = q < 2 ? m0[2 * q] : m1[2 * q - 4], mm1 = q < 2 ? m0[2 * q + 1] : m1[2 * q - 3];
                            o8[2 * q] = c0 + (p0 - c0) * mm0; o8[2 * q + 1] = c1 + (p1 - c1) * mm1; }
#pragma unroll
                        for (int q = 0; q < 8; ++q) { if (a3 == 0) rl[8 * hh + q] = o8[q]; else if (a3 == 1) kl[8 * hh + q] = o8[q]; else vl[8 * hh + q] = o8[q]; }
                    }
                }
                float gv[16];
#pragma unroll
                for (int j4 = 0; j4 < 4; ++j4) { const f32x4 xl = *(const LAS f32x4*)(tmpL + te * 68 + 16 * kq + 4 * j4), xa = *(const LAS f32x4*)(tmpL + 1088 + te * 68 + 16 * kq + 4 * j4), xg = *(const LAS f32x4*)(tmpL + 2176 + te * 68 + 16 * kq + 4 * j4);
                    const f32x4 w0v = *(const f32x4*)(args.in[I_W0] + hc + 4 * j4), a0v = *(const f32x4*)(args.in[I_A0] + hc + 4 * j4);
#pragma unroll
                    for (int q = 0; q < 4; ++q) { const float wq = -softplus_fast(-(xl[q] + w0v[q])) - 0.5f; lwv[4 * j4 + q] = -__expf(wq); av[4 * j4 + q] = sigmoid_f(xa[q] + a0v[q]); gv[4 * j4 + q] = xg[q]; } }
                asm volatile("s_waitcnt lgkmcnt(0)" ::: "memory");
                float ss = 0.f;
#pragma unroll
                for (int j4 = 0; j4 < 4; ++j4) { const f32x4 kk4 = *(const f32x4*)(args.in[I_KK] + hc + 4 * j4);
#pragma unroll
                    for (int q = 0; q < 4; ++q) { kn[4 * j4 + q] = kl[4 * j4 + q] * kk4[q]; ss += kn[4 * j4 + q] * kn[4 * j4 + q]; } }
                ss += __shfl_xor(ss, 1); ss += __shfl_xor(ss, 2);
                const float kinv = rsq_f(fmaxf(ss, 1e-24f));
#pragma unroll
                for (int j = 0; j < 16; ++j) { float x = lwv[j];
#pragma unroll
                    for (int sft = 4; sft < 64; sft <<= 1) { const float y = __shfl_up(x, sft); if (lane >= sft) x += y; }
                    cl[j] = x; }
                float bon = 0.f;
                u32x4 pa[2], pb[2], pk[2], pr[2];
#pragma unroll
                for (int j4 = 0; j4 < 4; ++j4) {
                    const f32x4 ka = *(const f32x4*)(args.in[I_KA] + hc + 4 * j4), rk = *(const f32x4*)(args.in[I_RK] + hc + 4 * j4);
                    float at4[4], bt4[4], kt4[4], rt4[4];
#pragma unroll
                    for (int q = 0; q < 4; ++q) { const int j = 4 * j4 + q;
                        const float p = __expf(cl[j]), pn = __expf(-cl[j]), pm1 = __expf(cl[j] - lwv[j]); eP[j] = p;
                        const float knj = kn[j] * kinv;
                        const float kp = kl[j] * (1.0f + (av[j] - 1.0f) * ka[q]);
                        at4[q] = -knj * pm1; bt4[q] = knj * av[j] * pn; kt4[q] = kp * pn; rt4[q] = rl[j] * p;
                        bon += rl[j] * kp * rk[q];
                        const int kk = 16 * kq + j;
                        ATt[kk * 16 + te] = (bf16)f2bf(at4[q]); BTt[kk * 16 + te] = (bf16)f2bf(bt4[q]); KTt[kk * 16 + te] = (bf16)f2bf(kt4[q]); VTt[kk * 16 + te] = (bf16)f2bf(vl[j]); }
                    const int hh = j4 >> 1, w2 = (j4 & 1) * 2;
                    pa[hh][w2] = pk2(at4[0], at4[1]); pa[hh][w2 + 1] = pk2(at4[2], at4[3]); pb[hh][w2] = pk2(bt4[0], bt4[1]); pb[hh][w2 + 1] = pk2(bt4[2], bt4[3]);
                    pk[hh][w2] = pk2(kt4[0], kt4[1]); pk[hh][w2 + 1] = pk2(kt4[2], kt4[3]); pr[hh][w2] = pk2(rt4[0], rt4[1]); pr[hh][w2 + 1] = pk2(rt4[2], rt4[3]);
                }
#pragma unroll
                for (int hh = 0; hh < 2; ++hh) { const int po = te * 64 + 8 * ((2 * kq + hh) ^ (te & 7));
                    *(LAS u32x4*)(Arm + po) = pa[hh]; *(LAS u32x4*)(Brm + po) = pb[hh]; *(LAS u32x4*)(Krm + po) = pk[hh]; *(LAS u32x4*)(Rrm + po) = pr[hh]; }
                bon += __shfl_xor(bon, 1); bon += __shfl_xor(bon, 2);
                f32x4 lbv[4], lgv[4];
#pragma unroll
                for (int j4 = 0; j4 < 4; ++j4) { lbv[j4] = *(const f32x4*)(args.in[I_LNB] + hc + 4 * j4); lgv[j4] = *(const f32x4*)(args.in[I_LNG] + hc + 4 * j4); }
#pragma unroll
                for (int j4 = 0; j4 < 4; ++j4) { const f32x4 lb = lbv[j4], lgn = lgv[j4]; const int j0 = 4 * j4;
                    u32x2 ow, gw2; ow.x = pk2((lb.x + vl[j0] * bon) * gv[j0], (lb.y + vl[j0 + 1] * bon) * gv[j0 + 1]); ow.y = pk2((lb.z + vl[j0 + 2] * bon) * gv[j0 + 2], (lb.w + vl[j0 + 3] * bon) * gv[j0 + 3]);
                    gw2.x = pk2(lgn.x * gv[j0], lgn.y * gv[j0 + 1]); gw2.y = pk2(lgn.z * gv[j0 + 2], lgn.w * gv[j0 + 3]);
                    *(u32x2*)((bf16*)(ws + WS_ADD) + off + j0) = ow; *(u32x2*)((bf16*)(ws + WS_G) + off + j0) = gw2; }
            }
            asm volatile("s_waitcnt lgkmcnt(0)" ::: "memory");
            {
                bf16x8 fa[2], fr[2], fb[2], fk[2];
#pragma unroll
                for (int ks = 0; ks < 2; ++ks) { const int po = l15 * 64 + 8 * ((4 * ks + g) ^ (l15 & 7));
                    fa[ks] = *(const LAS bf16x8*)(Arm + po); fr[ks] = *(const LAS bf16x8*)(Rrm + po); fb[ks] = *(const LAS bf16x8*)(Brm + po); fk[ks] = *(const LAS bf16x8*)(Krm + po); }
                f32x4 mab = z4, mak = z4, mrb = z4, mrk = z4;
#pragma unroll
                for (int ks = 0; ks < 2; ++ks) { mab = __builtin_amdgcn_mfma_f32_16x16x32_bf16(fb[ks], fa[ks], mab, 0, 0, 0); mak = __builtin_amdgcn_mfma_f32_16x16x32_bf16(fk[ks], fa[ks], mak, 0, 0, 0);
                    mrb = __builtin_amdgcn_mfma_f32_16x16x32_bf16(fb[ks], fr[ks], mrb, 0, 0, 0); mrk = __builtin_amdgcn_mfma_f32_16x16x32_bf16(fk[ks], fr[ks], mrk, 0, 0, 0); }
#pragma unroll
                for (int e = 0; e < 4; ++e) { const int i = 4 * g + e; if (!(i < l15)) { mab[e] = 0.f; mak[e] = 0.f; } if (!(i <= l15)) { mrb[e] = 0.f; mrk[e] = 0.f; } }
                asm volatile("s_waitcnt lgkmcnt(0)" ::: "memory");
#pragma unroll
                for (int e = 0; e < 4; ++e) MabT[(4 * g + e) * 16 + l15] = mab[e];
                u32x2 w; w.x = pk2(mak[0], mak[1]); w.y = pk2(mak[2], mak[3]); *(LAS u32x2*)(Mak + l15 * 16 + 4 * g) = w;
                w.x = pk2(mrb[0], mrb[1]); w.y = pk2(mrb[2], mrb[3]); *(LAS u32x2*)(Mrb + l15 * 16 + 4 * g) = w;
                w.x = pk2(mrk[0], mrk[1]); w.y = pk2(mrk[2], mrk[3]); *(LAS u32x2*)(Mrk + l15 * 16 + 4 * g) = w;
                if (te == 15) {
#pragma unroll
                    for (int j = 0; j < 16; ++j) PLs[16 * kq + j] = eP[j]; }
            }
            asm volatile("s_waitcnt lgkmcnt(0)" ::: "memory");
            {
                f32x4 mq[15][4];
#pragma unroll
                for (int j = 0; j < 15; ++j)
#pragma unroll
                    for (int q = 0; q < 4; ++q) if (4 * q + 3 > j) mq[j][q] = *(const LAS f32x4*)(MabT + j * 16 + 4 * q);
                float y[16];
#pragma unroll
                for (int j = 15; j >= 0; --j) {
                    float acc = (j == l15) ? 1.0f : 0.0f;
#pragma unroll
                    for (int i = j + 1; i < 16; ++i) acc += y[i] * mq[j < 15 ? j : 0][i >> 2][i & 3];
                    y[j] = acc;
                }
                if (g == 0) { u32x4 t0, t1; t0.x = pk2(y[0], y[1]); t0.y = pk2(y[2], y[3]); t0.z = pk2(y[4], y[5]); t0.w = pk2(y[6], y[7]); t1.x = pk2(y[8], y[9]); t1.y = pk2(y[10], y[11]); t1.z = pk2(y[12], y[13]); t1.w = pk2(y[14], y[15]);
                    *(LAS u32x4*)(Tm + l15 * 16) = t0; *(LAS u32x4*)(Tm + l15 * 16 + 8) = t1; }
            }
            asm volatile("s_waitcnt lgkmcnt(0)" ::: "memory");
            {
                const bool act = g < 2; const int fo = l15 * 16 + 8 * g;
                const bf16x8 fT = act ? *(const LAS bf16x8*)(Tm + fo) : z8, fMak = act ? *(const LAS bf16x8*)(Mak + fo) : z8, fMrb = act ? *(const LAS bf16x8*)(Mrb + fo) : z8, fMrk = act ? *(const LAS bf16x8*)(Mrk + fo) : z8;
                bf16x8 fV[4], fQ1[4], fAh[4], fBT[4], fKT[4];
#pragma unroll
                for (int vt = 0; vt < 4; ++vt) { fV[vt] = act ? *(const LAS bf16x8*)(VTt + vt * 256 + fo) : z8; fBT[vt] = act ? *(const LAS bf16x8*)(BTt + vt * 256 + fo) : z8; fKT[vt] = act ? *(const LAS bf16x8*)(KTt + vt * 256 + fo) : z8; }
#pragma unroll
                for (int vt = 0; vt < 4; ++vt) { const f32x4 q0 = __builtin_amdgcn_mfma_f32_16x16x32_bf16(fMak, fV[vt], z4, 0, 0, 0);
                    u32x2 w; w.x = pk2(q0[0], q0[1]); w.y = pk2(q0[2], q0[3]); *(LAS u32x2*)(Q0T + vt * 256 + l15 * 16 + 4 * g) = w; }
#pragma unroll
                for (int kt = 0; kt < 4; ++kt) { const bf16x8 fA = act ? *(const LAS bf16x8*)(ATt + kt * 256 + fo) : z8; const f32x4 ah = __builtin_amdgcn_mfma_f32_16x16x32_bf16(fT, fA, z4, 0, 0, 0);
                    u32x2 w; w.x = pk2(ah[0], ah[1]); w.y = pk2(ah[2], ah[3]); *(LAS u32x2*)(ATt + kt * 256 + l15 * 16 + 4 * g) = w; }
                asm volatile("s_waitcnt lgkmcnt(0)" ::: "memory");
#pragma unroll
                for (int vt = 0; vt < 4; ++vt) { const bf16x8 fQ0 = act ? *(const LAS bf16x8*)(Q0T + vt * 256 + fo) : z8; const f32x4 q1 = __builtin_amdgcn_mfma_f32_16x16x32_bf16(fT, fQ0, z4, 0, 0, 0);
                    u32x2 w; w.x = pk2(q1[0], q1[1]); w.y = pk2(q1[2], q1[3]); *(LAS u32x2*)(Q0T + vt * 256 + l15 * 16 + 4 * g) = w; }
                asm volatile("s_waitcnt lgkmcnt(0)" ::: "memory");
#pragma unroll
                for (int vt = 0; vt < 4; ++vt) { fQ1[vt] = act ? *(const LAS bf16x8*)(Q0T + vt * 256 + fo) : z8; fAh[vt] = act ? *(const LAS bf16x8*)(ATt + vt * 256 + fo) : z8; }
                bf16* rp = (bf16*)(ws + WS_RP) + (size_t)un * 1024 + l15 * 64;
#pragma unroll
                for (int kt = 0; kt < 4; ++kt) {
                    const u32x2 rr = *(const LAS u32x2*)(Rrm + l15 * 64 + 8 * ((2 * kt + (g >> 1)) ^ (l15 & 7)) + 4 * (g & 1));
                    f32x4 ini; ini[0] = bflo(rr.x); ini[1] = bfhi(rr.x); ini[2] = bflo(rr.y); ini[3] = bfhi(rr.y);
                    const f32x4 rh = __builtin_amdgcn_mfma_f32_16x16x32_bf16(fAh[kt], fMrb, ini, 0, 0, 0);
                    u32x2 w; w.x = pk2(rh[0], rh[1]); w.y = pk2(rh[2], rh[3]); *(u32x2*)(rp + 32 * (kt >> 1) + 8 * g + 4 * (kt & 1)) = w;
                }
#pragma unroll
                for (int vt = 0; vt < 4; ++vt) { f32x4 y1 = __builtin_amdgcn_mfma_f32_16x16x32_bf16(fMrb, fQ1[vt], z4, 0, 0, 0); y1 = __builtin_amdgcn_mfma_f32_16x16x32_bf16(fMrk, fV[vt], y1, 0, 0, 0);
                    *(f32x4*)((float*)(ws + WS_Y1F) + ((size_t)(un * 4 + vt) * 64 + lane) * 4) = y1; }
                LAS bf16* tgs = (LAS bf16*)(wl + 8192);
#pragma unroll
                for (int krt = 0; krt < 4; ++krt) { const float pl = PLs[16 * krt + l15];
#pragma unroll
                    for (int kct = 0; kct < 4; ++kct) { f32x4 ga = __builtin_amdgcn_mfma_f32_16x16x32_bf16(fAh[kct], fBT[krt], z4, 0, 0, 0);
                        if (kct == krt) {
#pragma unroll
                            for (int e = 0; e < 4; ++e) if (4 * g + e == l15) ga[e] += 1.0f; }
                        u32x2 w; w.x = pk2(ga[0] * pl, ga[1] * pl); w.y = pk2(ga[2] * pl, ga[3] * pl);
                        *(LAS u32x2*)(tgs + (16 * krt + l15) * 64 + 32 * (kct >> 1) + 8 * g + 4 * (kct & 1)) = w; } }
                { u32x4* gp16 = (u32x4*)((bf16*)(ws + WS_GP) + (size_t)un * 4096);
#pragma unroll
                  for (int i = 0; i < 8; ++i) gp16[i * 64 + lane] = *(const LAS u32x4*)(tgs + (i * 64 + lane) * 8); }
#pragma unroll
                for (int mt = 0; mt < 4; ++mt) { const f32x4 pl4 = *(const LAS f32x4*)(PLs + 16 * mt + 4 * g);
#pragma unroll
                    for (int vt = 0; vt < 4; ++vt) { f32x4 ha = __builtin_amdgcn_mfma_f32_16x16x32_bf16(fBT[mt], fQ1[vt], z4, 0, 0, 0); ha = __builtin_amdgcn_mfma_f32_16x16x32_bf16(fKT[mt], fV[vt], ha, 0, 0, 0);
                        u32x2 w; w.x = pk2(ha[0] * pl4[0], ha[1] * pl4[1]); w.y = pk2(ha[2] * pl4[2], ha[3] * pl4[3]);
                        *(u32x2*)((bf16*)(ws + WS_HF) + ((size_t)((un * 4 + vt) * 4 + mt) * 64 + lane) * 4) = w; } }
            }
            asm volatile("s_waitcnt lgkmcnt(0)" ::: "memory");
        }
        asm volatile("s_waitcnt vmcnt(0)" ::: "memory");
        { const int ltid = fresh_tid() & 63, l15 = ltid & 15, g = ltid >> 4, lane = ltid;
#define CP_LOADG(gf_, j_) do { const bf16* gp_ = (const bf16*)(ws + WS_GP) + ((size_t)u64 * 4 + (j_)) * 4096 + l15 * 64 + 8 * g; \
            _Pragma("unroll") for (int mt = 0; mt < 4; ++mt) { gf_[mt][0] = *(const bf16x8*)(gp_ + mt * 1024); gf_[mt][1] = *(const bf16x8*)(gp_ + mt * 1024 + 32); } } while (0)
#define CP_LOADH(hf_, j_) do { _Pragma("unroll") for (int sl = 0; sl < 4; ++sl) _Pragma("unroll") for (int mt = 0; mt < 4; ++mt) \
            hf_[sl][mt] = *(const u32x2*)((const bf16*)(ws + WS_HF) + ((size_t)((((size_t)u64 * 4 + (j_)) * 4 + sl) * 4 + mt) * 64 + lane) * 4); } while (0)
#define CP_STEP(gf_, hf_, useh_) do { _Pragma("unroll") for (int sl = 0; sl < 4; ++sl) { bf16x8 zb[2]; RW_ZB(z[sl], zb); \
            _Pragma("unroll") for (int mt = 0; mt < 4; ++mt) { f32x4 a_ = (f32x4){0.f, 0.f, 0.f, 0.f}; \
                if (useh_) { a_[0] = bflo(hf_[sl][mt].x); a_[1] = bfhi(hf_[sl][mt].x); a_[2] = bflo(hf_[sl][mt].y); a_[3] = bfhi(hf_[sl][mt].y); } \
                a_ = __builtin_amdgcn_mfma_f32_16x16x32_bf16(gf_[mt][0], zb[0], a_, 0, 0, 0); a_ = __builtin_amdgcn_mfma_f32_16x16x32_bf16(gf_[mt][1], zb[1], a_, 0, 0, 0); z[sl][mt] = a_; } } } while (0)
        {
            f32x4 z[4][4];
#pragma unroll
            for (int sl = 0; sl < 4; ++sl)
#pragma unroll
                for (int mt = 0; mt < 4; ++mt)
#pragma unroll
                    for (int e = 0; e < 4; ++e) z[sl][mt][e] = (sl == mt && 4 * g + e == l15) ? 1.0f : 0.0f;
            bf16x8 gA[4][2], gB[4][2]; u32x2 hdum[4][4];
            CP_LOADG(gA, 0); CP_LOADG(gB, 1);
            CP_STEP(gA, hdum, false); CP_LOADG(gA, 2);
            CP_STEP(gB, hdum, false); CP_LOADG(gB, 3);
            CP_STEP(gA, hdum, false);
            CP_STEP(gB, hdum, false);
            LAS bf16* tg = (LAS bf16*)(lds + wave * 16384);
#pragma unroll
            for (int sl = 0; sl < 4; ++sl) { const int pc = 32 * (sl >> 1) + 8 * (l15 >> 2) + 4 * (sl & 1) + (l15 & 3);
#pragma unroll
                for (int mt = 0; mt < 4; ++mt)
#pragma unroll
                    for (int e = 0; e < 4; ++e) tg[(16 * mt + 4 * g + e) * 64 + pc] = (bf16)f2bf(z[sl][mt][e]); }
            u32x4* gc = (u32x4*)((bf16*)(ws + WS_GC) + (size_t)u64 * 4096);
#pragma unroll
            for (int i = 0; i < 8; ++i) gc[i * 64 + lane] = *(const LAS u32x4*)(tg + (i * 64 + lane) * 8);
        }
        {
            f32x4 z[4][4];
#pragma unroll
            for (int sl = 0; sl < 4; ++sl)
#pragma unroll
                for (int mt = 0; mt < 4; ++mt) z[sl][mt] = (f32x4){0.f, 0.f, 0.f, 0.f};
            bf16x8 gA[4][2], gB[4][2]; u32x2 hA[4][4], hB[4][4];
            CP_LOADG(gA, 0); CP_LOADH(hA, 0); CP_LOADG(gB, 1); CP_LOADH(hB, 1);
            CP_STEP(gA, hA, true); CP_LOADG(gA, 2); CP_LOADH(hA, 2);
            CP_STEP(gB, hB, true); CP_LOADG(gB, 3); CP_LOADH(hB, 3);
            CP_STEP(gA, hA, true);
            CP_STEP(gB, hB, true);
#pragma unroll
            for (int sl = 0; sl < 4; ++sl)
#pragma unroll
                for (int mt = 0; mt < 4; ++mt) { u32x2 w; w.x = pk2(z[sl][mt][0], z[sl][mt][1]); w.y = pk2(z[sl][mt][2], z[sl][mt][3]);
                    *(u32x2*)((bf16*)(ws + WS_HC) + ((size_t)((u64 * 4 + sl) * 4 + mt) * 64 + lane) * 4) = w; }
        }
#undef CP_LOADG
#undef CP_LOADH
#undef CP_STEP
        }
        }
    }
    SEAM(3);


    if (IN(4)) { PHASE_IDS;
        if (!(bid < 128 && wave == 0)) {
            const int wi = bid < 128 ? bid * 7 + (wave - 1) : 896 + (bid - 128) * 8 + wave, NW = 896 + (G - 128) * 8;
        } else {
            const int l15 = lane & 15, g = lane >> 4, bh = bid >> 2, vs = bid & 3;
            f32x4 z[4];
#pragma unroll
            for (int mt = 0; mt < 4; ++mt) z[mt] = (f32x4){0.f, 0.f, 0.f, 0.f};
            bf16x8 gA[4][2], gB[4][2], gC[4][2], gD[4][2]; u32x2 hA[4], hB[4], hC[4], hD[4];
#define SC_LOAD(gf, hf, C) do { const size_t u64_ = (size_t)bh * 64 + (C); const bf16* gp_ = (const bf16*)(ws + WS_GC) + u64_ * 4096 + l15 * 64 + 8 * g; \
                _Pragma("unroll") for (int mt = 0; mt < 4; ++mt) { gf[mt][0] = *(const bf16x8*)(gp_ + mt * 1024); gf[mt][1] = *(const bf16x8*)(gp_ + mt * 1024 + 32); \
                    hf[mt] = *(const u32x2*)((const bf16*)(ws + WS_HC) + ((size_t)((u64_ * 4 + vs) * 4 + mt) * 64 + lane) * 4); } } while (0)
#define SC_STEP(gf, hf, C) do { const size_t u64_ = (size_t)bh * 64 + (C); bf16* zs_ = (bf16*)(ws + WS_ZS) + ((size_t)((u64_ * 4 + vs) * 4) * 64 + lane) * 4; \
                _Pragma("unroll") for (int mt = 0; mt < 4; ++mt) { u32x2 zw_; zw_.x = pk2(z[mt][0], z[mt][1]); zw_.y = pk2(z[mt][2], z[mt][3]); *(u32x2*)(zs_ + mt * 256) = zw_; } \
                bf16x8 zb[2]; RW_ZB(z, zb); \
                _Pragma("unroll") for (int mt = 0; mt < 4; ++mt) { f32x4 a; a[0] = bflo(hf[mt].x); a[1] = bfhi(hf[mt].x); a[2] = bflo(hf[mt].y); a[3] = bfhi(hf[mt].y); \
                    a = __builtin_amdgcn_mfma_f32_16x16x32_bf16(gf[mt][0], zb[0], a, 0, 0, 0); a = __builtin_amdgcn_mfma_f32_16x16x32_bf16(gf[mt][1], zb[1], a, 0, 0, 0); z[mt] = a; } } while (0)
            SC_LOAD(gA, hA, 0); SC_LOAD(gB, hB, 1); SC_LOAD(gC, hC, 2);
#pragma unroll 1
            for (int C = 0; C < 64; C += 4) {
                SC_LOAD(gD, hD, C + 3);
                SC_STEP(gA, hA, C);
                if (C + 4 < 64) SC_LOAD(gA, hA, C + 4);
                SC_STEP(gB, hB, C + 1);
                if (C + 5 < 64) SC_LOAD(gB, hB, C + 5);
                SC_STEP(gC, hC, C + 2);
                if (C + 6 < 64) SC_LOAD(gC, hC, C + 6);
                SC_STEP(gD, hD, C + 3);
            }
#undef SC_LOAD
#undef SC_STEP
        }
    }
    if (IN(4)) { PHASE_IDS;
        if (bid < 32 && wave == 1) { const int bc = bid; const f32x2* ag = (const f32x2*)((const float*)(ws + WS_AP)) + (size_t)(bc * 64) * 64 + lane;
            float* car = (float*)(ws + WS_AP + 4 * MiB) + (size_t)(bc * 64) * 64 + lane; float hst = 0.f;
#pragma unroll 16
            for (int sg = 0; sg < 64; ++sg) { const f32x2 ab = ag[(size_t)sg * 64]; car[(size_t)sg * 64] = hst; hst = ab.x * hst + ab.y; } }
    }
    if (IN(4)) { PHASE_IDS;
        bf16* WKt = HN; bf16* VWt = HN + (size_t)4 * 1024 * 1024;
        __syncthreads();
        if (bid >= 128 && bid < 192) { pg8::FoldSched<0> S; S.A = (const char*)KM; S.B = (const char*)Wq_t; S.G = 64; S.c = bid - 128; EpiFold<0> E{(unsigned char*)WKt}; pg8::gemm_phase(lds, 256, S, E, wv0, 1024); }
        else if (bid >= 192) { pg8::FoldSched<1> S; S.A = (const char*)Wo_t; S.B = (const char*)VT; S.G = 64; S.c = bid - 192; EpiFold<1> E{(unsigned char*)VWt}; pg8::gemm_phase(lds, 256, S, E, wv0, 1024); }
    }
    SEAM(4);

    if (IN(5)) { PHASE_IDS;
        {
            for (int lu = gw; lu < (M / 64) * 8; lu += NGW) {
                const int seg = lu >> 3, nb = lu & 7, rr = lane >> 3, cq = lane & 7;
                const float* cp = (const float*)(ws + WS_AP + 4 * MiB) + ((size_t)(((seg >> 6) * 8 + nb) * 64 + (seg & 63)) * 64 + 8 * cq);
                const f32x4 c0 = *(const f32x4*)cp, c1 = *(const f32x4*)(cp + 4);
#pragma unroll
                for (int it = 0; it < 8; ++it) { const size_t m = (size_t)seg * 64 + 8 * it + rr; const size_t o = m * 512 + nb * 64 + 8 * cq;
                    const u32x4 pw = *(const u32x4*)(LA + o), hw = *(const u32x4*)(LB + o), gw_ = *(const u32x4*)(U + m * INW + 512 + nb * 64 + 8 * cq);
                    float y[8];
#pragma unroll
                    for (int q = 0; q < 4; ++q) { const float ca = q < 2 ? c0[2 * q] : c1[2 * q - 4], cb = q < 2 ? c0[2 * q + 1] : c1[2 * q - 3];
                        y[2 * q] = (bflo(hw[q]) + bflo(pw[q]) * ca) * gelu_tanh_f(bflo(gw_[q])); y[2 * q + 1] = (bfhi(hw[q]) + bfhi(pw[q]) * cb) * gelu_tanh_f(bfhi(gw_[q])); }
                    u32x4 w; w.x = pk2(y[0], y[1]); w.y = pk2(y[2], y[3]); w.z = pk2(y[4], y[5]); w.w = pk2(y[6], y[7]);
                    *(u32x4*)(CAT + m * 1024 + nb * 64 + 8 * cq) = w; }
            }
        }
        const int l15 = lane & 15, g = lane >> 4;
        LAS bf16* tGL = (LAS bf16*)(lds + wave * 16384); LAS bf16* tAD = tGL + 1024; LAS bf16* tOUT = tGL + 2048;
        const int ct = lane >> 3, cc = lane & 7;
        for (int u64 = gw; u64 < NB * NH * (SEQ / 64); u64 += NGW) {
            const int bh = u64 >> 6, C = u64 & 63, b = bh >> 3, h = bh & 7;
            f32x4 z[4][4];
#pragma unroll
            for (int sl = 0; sl < 4; ++sl)
#pragma unroll
                for (int mt = 0; mt < 4; ++mt) { const u32x2 zw = *(const u32x2*)((const bf16*)(ws + WS_ZS) + ((size_t)((u64 * 4 + sl) * 4 + mt) * 64 + lane) * 4); z[sl][mt] = (f32x4){bflo(zw.x), bfhi(zw.x), bflo(zw.y), bfhi(zw.y)}; }
#pragma unroll 1
            for (int j = 0; j < 4; ++j) {
                const size_t un = (size_t)u64 * 4 + j; const size_t m0 = (size_t)b * SEQ + (C * 4 + j) * 16;
                const bf16* rp = (const bf16*)(ws + WS_RP) + un * 1024 + l15 * 64 + 8 * g;
                const bf16x8 rf0 = *(const bf16x8*)rp, rf1 = *(const bf16x8*)(rp + 32);
                f32x4 y[4];
#pragma unroll
                for (int sl = 0; sl < 4; ++sl) y[sl] = *(const f32x4*)((const float*)(ws + WS_Y1F) + ((size_t)(un * 4 + sl) * 64 + lane) * 4);
                const size_t rg = (m0 + ct) * 512 + h * 64 + 8 * cc;
                const u32x4 gl0 = *(const u32x4*)((const bf16*)(ws + WS_G) + rg), gl1 = *(const u32x4*)((const bf16*)(ws + WS_G) + rg + 8 * 512);
                const u32x4 ad0 = *(const u32x4*)((const bf16*)(ws + WS_ADD) + rg), ad1 = *(const u32x4*)((const bf16*)(ws + WS_ADD) + rg + 8 * 512);
                bf16x8 gf[4][2]; u32x2 hfr[4][4];
                if (j < 3) {
                    const bf16* gp = (const bf16*)(ws + WS_GP) + un * 4096 + l15 * 64 + 8 * g;
#pragma unroll
                    for (int mt = 0; mt < 4; ++mt) { gf[mt][0] = *(const bf16x8*)(gp + mt * 1024); gf[mt][1] = *(const bf16x8*)(gp + mt * 1024 + 32); }
#pragma unroll
                    for (int sl = 0; sl < 4; ++sl)
#pragma unroll
                        for (int mt = 0; mt < 4; ++mt) hfr[sl][mt] = *(const u32x2*)((const bf16*)(ws + WS_HF) + ((size_t)((un * 4 + sl) * 4 + mt) * 64 + lane) * 4);
                }
                *(LAS u32x4*)(tGL + ct * 64 + 8 * cc) = gl0; *(LAS u32x4*)(tGL + (ct + 8) * 64 + 8 * cc) = gl1;
                *(LAS u32x4*)(tAD + ct * 64 + 8 * cc) = ad0; *(LAS u32x4*)(tAD + (ct + 8) * 64 + 8 * cc) = ad1;
                bf16x8 zb[4][2];
#pragma unroll
                for (int sl = 0; sl < 4; ++sl) { RW_ZB(z[sl], zb[sl]);
                    y[sl] = __builtin_amdgcn_mfma_f32_16x16x32_bf16(rf0, zb[sl][0], y[sl], 0, 0, 0); y[sl] = __builtin_amdgcn_mfma_f32_16x16x32_bf16(rf1, zb[sl][1], y[sl], 0, 0, 0); }
#pragma unroll
                for (int e = 0; e < 4; ++e) {
                    float s1 = (y[0][e] + y[1][e]) + (y[2][e] + y[3][e]);
                    s1 += __shfl_xor(s1, 1); s1 += __shfl_xor(s1, 2); s1 += __shfl_xor(s1, 4); s1 += __shfl_xor(s1, 8);
                    const float mean = s1 * (1.0f / 64.0f);
                    float d0 = y[0][e] - mean, d1 = y[1][e] - mean, d2 = y[2][e] - mean, d3 = y[3][e] - mean;
                    float s2 = (d0 * d0 + d1 * d1) + (d2 * d2 + d3 * d3);
                    s2 += __shfl_xor(s2, 1); s2 += __shfl_xor(s2, 2); s2 += __shfl_xor(s2, 4); s2 += __shfl_xor(s2, 8);
                    const float rstd = rsq_f(s2 * (1.0f / 64.0f) + GN_EPS);
                    const float dd[4] = {d0, d1, d2, d3};
#pragma unroll
                    for (int sl = 0; sl < 4; ++sl) { const int ti_ = (4 * g + e) * 64 + 16 * sl + l15;
                        const float o = dd[sl] * rstd * bf2f(tGL[ti_]) + bf2f(tAD[ti_]); tOUT[ti_] = (bf16)f2bf(o); }
                }
                { bf16* cp = CAT + (m0 + ct) * 1024 + 512 + h * 64 + 8 * cc;
                  *(u32x4*)cp = *(const LAS u32x4*)(tOUT + ct * 64 + 8 * cc); *(u32x4*)(cp + 8 * 1024) = *(const LAS u32x4*)(tOUT + (ct + 8) * 64 + 8 * cc); }
                if (j < 3) {
#pragma unroll
                    for (int sl = 0; sl < 4; ++sl)
#pragma unroll
                        for (int mt = 0; mt < 4; ++mt) { const u32x2 hh = hfr[sl][mt];
                            f32x4 a; a[0] = bflo(hh.x); a[1] = bfhi(hh.x); a[2] = bflo(hh.y); a[3] = bfhi(hh.y);
                            a = __builtin_amdgcn_mfma_f32_16x16x32_bf16(gf[mt][0], zb[sl][0], a, 0, 0, 0); a = __builtin_amdgcn_mfma_f32_16x16x32_bf16(gf[mt][1], zb[sl][1], a, 0, 0, 0); z[sl][mt] = a; }
                }
            }
        }
    }
    SEAM(5);
#undef RW_ZB


    if (IN(6)) { PHASE_IDS;
        pg8::DenseSched S; S.o.init_tiles(M / 256, D / 256, G, bid); S.A = (const char*)CAT; S.B = (const char*)Wout_t; S.tstep = (size_t)256 * D * 2;
        EpiBf16Res<false> E{args.in[I_X], X1, D, (float*)(ws + WS_AP + 2 * MiB), 1.0f, X1F8}; pg8::gemm_phase(lds, D, S, E, wv0);
    }
    SEAM(6);
    if (IN(7)) { PHASE_IDS;
        pg8::BatchBSched S; S.o.init_tiles(M / 256, D / 256, G, bid); S.A = (const char*)X1F8; S.B = (const char*)HN; S.tstep = (size_t)256 * 1024; S.bstep = (size_t)1024 * 1024;
        EpiSoftmax E{(unsigned char*)Qb, 0.0625f * 0.25f, (const float*)(ws + WS_AP + 2 * MiB), (LAS float*)(lds + RING_BYTES + 1024), (LAS float*)(lds + RING_BYTES + 1024 + 4096)};
        pg8::gemm_phase<EpiSoftmax, pg8::BatchBSched, true, true>(lds, 512, S, E, wv0);
    }
    SEAM(7);
    if (IN(8)) { PHASE_IDS;
        pg8::BatchBSched S; S.o.init_tiles(M / 256, D / 256, G, bid); S.A = (const char*)Qb; S.B = (const char*)(HN + (size_t)4 * 1024 * 1024); S.tstep = (size_t)256 * 1024; S.bstep = (size_t)1024 * 1024;
        EpiBf16Res<true> E{X1, X2, D, nullptr, 1.0f / 1024.0f, nullptr}; pg8::gemm_phase<EpiBf16Res<true>, pg8::BatchBSched, true, true>(lds, 512, S, E, wv0);
    }
    SEAM(8);
    if (IN(9)) { PHASE_IDS;
        for (int cid = tid; cid < 2 * NE * 128; cid += NTHREADS) { const int t = cid >> 12, row = (cid >> 7) & 31, c = cid & 127;
            *(LAS u32x4*)(lds + t * 65536 + row * 2048 + ((c ^ (row & 7)) << 4)) = *(const u32x4*)(WrT + (size_t)t * NE * D + row * D + 8 * c); }
        __syncthreads();
        const int l15 = lane & 15, g = lane >> 4;
        LAS float* LG = (LAS float*)(lds + RING_BYTES + 1024 + wave * 2304);
        const float* gfn = args.in[I_NFFG];
        LAS unsigned* cntl = (LAS unsigned*)(lds + RING_BYTES + 640);
        for (int t0 = 0; t0 < M / 16; t0 += G * 4) {
        if (tid < 64) cntl[tid] = 0u;
        __syncthreads();
        if (t0 == 0 && wave >= 4) {
            constexpr int I_DN = 16 * 32, I_GU = 16 * 64;
            for (int r = bid * 4 + (wave - 4); r < CONV_P9; r += G * 4) { const int e = r / I_GU, q = r % I_GU, kb = q / 64, nb = q % 64; const int n0 = 32 * nb;
                const int drow = n0 < 1024 ? (256 * (n0 >> 7) + (n0 & 127)) : (256 * ((n0 - 1024) >> 7) + 128 + ((n0 - 1024) & 127));
                transpose_item_tiled_fp8_nolds(args.in[I_WGU] + (size_t)e * D * 2048, 2048, D, (unsigned char*)Wgu_t + (size_t)e * 2048 * D, 64 * kb, n0, drow, lane); }
            for (int r = bid * 4 + (wave - 4); r < CONV_P9D; r += G * 4) { const int e = r / I_DN, q = r % I_DN, kb = q / 32, nb = q % 32;
                transpose_item_tiled_fp8_nolds(args.in[I_WDN] + (size_t)e * DFF * D, D, DFF, (unsigned char*)Wdn_t + (size_t)e * D * DFF, 64 * kb, 32 * nb, 32 * nb, lane); }
        }
        const int tile = t0 + bid * 4 + wave; const bool active = wave < 4 && tile < M / 16;
        int me = 0, lpos = 0, ai = 0; float mg = 0.f;
        if (active) {
            const int m0 = tile * 16;
            const bf16* xrow = X2 + (size_t)(m0 + l15) * D + 8 * g;
            float ss = 0.f;
#pragma unroll 8
            for (int ks = 0; ks < 32; ++ks) { const u32x4 xw = *(const u32x4*)(xrow + 32 * ks);
#pragma unroll
                for (int q = 0; q < 4; ++q) { const float a = bflo(xw[q]), c = bfhi(xw[q]); ss += a * a + c * c; } }
            ss += __shfl_xor(ss, 16); ss += __shfl_xor(ss, 32);
            const float rstd = rsq_f(ss * (1.f / D) + EPS);
            f32x4 acc0 = (f32x4){0.f, 0.f, 0.f, 0.f}, acc1 = acc0;
            unsigned char* hrow = (unsigned char*)HN + (size_t)(m0 + l15) * D + 8 * g;
#pragma unroll 2
            for (int ks = 0; ks < 32; ++ks) {
                const f32x4 g0 = *(const f32x4*)(gfn + 32 * ks + 8 * g), g1 = *(const f32x4*)(gfn + 32 * ks + 8 * g + 4);
                const u32x4 xw = *(const u32x4*)(xrow + 32 * ks);
                float hf[8];
#pragma unroll
                for (int q = 0; q < 4; ++q) { hf[2 * q] = bflo(xw[q]) * rstd * (q < 2 ? g0[2 * q] : g1[2 * q - 4]); hf[2 * q + 1] = bfhi(xw[q]) * rstd * (q < 2 ? g0[2 * q + 1] : g1[2 * q - 3]); }
                u32x4 hi, lo;
#pragma unroll
                for (int q = 0; q < 4; ++q) { hi[q] = pk2(hf[2 * q], hf[2 * q + 1]); lo[q] = pk2(hf[2 * q] - bflo(hi[q]), hf[2 * q + 1] - bfhi(hi[q])); }
                { u32x2 h8; h8.x = pk4_fp8(hf[0], hf[1], hf[2], hf[3]); h8.y = pk4_fp8(hf[4], hf[5], hf[6], hf[7]); *(u32x2*)(hrow + 32 * ks) = h8; }
                const bf16x8 ah = __builtin_bit_cast(bf16x8, hi), al = __builtin_bit_cast(bf16x8, lo);
                const int c = 4 * ks + g;
#pragma unroll
                for (int nt = 0; nt < 2; ++nt) { const int row = 16 * nt + l15; const int off = row * 2048 + ((c ^ (row & 7)) << 4);
                    const bf16x8 bh = *(const LAS bf16x8*)(lds + off), bl = *(const LAS bf16x8*)(lds + 65536 + off);
                    f32x4 a = nt ? acc1 : acc0;
                    a = __builtin_amdgcn_mfma_f32_16x16x32_bf16(ah, bh, a, 0, 0, 0); a = __builtin_amdgcn_mfma_f32_16x16x32_bf16(ah, bl, a, 0, 0, 0); a = __builtin_amdgcn_mfma_f32_16x16x32_bf16(al, bh, a, 0, 0, 0);
                    if (nt) acc1 = a; else acc0 = a; }
            }
            { const float b0 = args.in[I_BR][l15], b1 = args.in[I_BR][16 + l15];
#pragma unroll
              for (int j = 0; j < 4; ++j) { LG[(4 * g + j) * 33 + l15] = acc0[j] + b0; LG[(4 * g + j) * 33 + 16 + l15] = acc1[j] + b1; } }
            const int rrow = lane >> 2, qq = lane & 3;
            float tv[4] = {-3.0e38f, -3.0e38f, -3.0e38f, -3.0e38f}; int ti[4] = {64, 65, 66, 67};
#define TOP_INS(xv_, xi_) do { float x_ = (xv_); int i_ = (xi_); _Pragma("unroll") for (int p_ = 0; p_ < 4; ++p_) { const bool b_ = x_ > tv[p_] || (x_ == tv[p_] && i_ < ti[p_]); \
                const float ov_ = tv[p_]; const int oi_ = ti[p_]; tv[p_] = b_ ? x_ : ov_; ti[p_] = b_ ? i_ : oi_; x_ = b_ ? ov_ : x_; i_ = b_ ? oi_ : i_; } } while (0)
#pragma unroll
            for (int j = 0; j < 8; ++j) TOP_INS(LG[rrow * 33 + 8 * qq + j], 8 * qq + j);
#pragma unroll
            for (int st = 1; st < 4; st <<= 1) { float pv[4]; int pi[4];
#pragma unroll
                for (int p = 0; p < 4; ++p) { pv[p] = __shfl_xor(tv[p], st); pi[p] = __shfl_xor(ti[p], st); }
#pragma unroll
                for (int p = 0; p < 4; ++p) TOP_INS(pv[p], pi[p]); }
#undef TOP_INS
            const float e1 = __expf(tv[1] - tv[0]), e2 = __expf(tv[2] - tv[0]), e3 = __expf(tv[3] - tv[0]);
            const float inv = rcp_f(1.0f + e1 + e2 + e3);
            me = qq == 0 ? ti[0] : qq == 1 ? ti[1] : qq == 2 ? ti[2] : ti[3];
            mg = (qq == 0 ? 1.0f : qq == 1 ? e1 : qq == 2 ? e2 : e3) * inv;
            lpos = (int)__hip_atomic_fetch_add(cntl + me, 1u, __ATOMIC_RELAXED, __HIP_MEMORY_SCOPE_WORKGROUP);
            ai = (m0 + rrow) * 4 + qq;
        }
        __syncthreads();
        if (tid < NE) { const unsigned c = cntl[tid]; cntl[32 + tid] = c ? atomicAdd(ecnt + 64 * tid, c) : 0u; }
        __syncthreads();
        if (active) { route_e[ai] = me; route_pos[ai] = (int)cntl[32 + me] + lpos; route_g[ai] = mg; }
        __syncthreads();
        }
    }
    SEAM(9);
    if (IN(10)) { PHASE_IDS;
        LAS int* pst = (LAS int*)lds;
        if (wave == 0) {
            const int c = lane < NE ? (int)__hip_atomic_load(ecnt + 64 * lane, __ATOMIC_RELAXED, __HIP_MEMORY_SCOPE_AGENT) : 0; const int pc = (c + 255) & ~255;
            int x = pc;
#pragma unroll
            for (int d = 1; d < 32; d <<= 1) { const int y = __shfl_up(x, d); if (lane >= d) x += y; }
            if (lane < NE) { pst[lane] = x - pc; pst[64 + lane] = c; } if (lane == NE - 1) pst[32] = x; }
        __syncthreads();
        for (int ai = bid * NTHREADS + tid; ai < NASSIGN; ai += G * NTHREADS) {
            const int e = route_e[ai]; const int row = pst[e] + route_pos[ai]; { u32x2 sg_; sg_.x = (unsigned)ai; sg_.y = __float_as_uint(route_g[ai]); row_sg[row] = sg_; } row_tok[row] = ai >> 2; }
        if (bid < NE) { const int e = bid, c = pst[64 + e], pe = (c + 255) & ~255; for (int p = c + tid; p < pe; p += NTHREADS) { u32x2 sg_; sg_.x = 0xffffffffu; sg_.y = 0u; row_sg[pst[e] + p] = sg_; row_tok[pst[e] + p] = 0; } }
        if (bid == 0 && tid == 0) tile_tab[0] = pst[32] >> 8;
        if (bid >= 128 && bid < 136) { const int nt = pst[32] >> 8, nN = bid < 132 ? 8 : 4; int* tab = (int*)(ws + WS_ROUTE + (bid < 132 ? RT_UGU : RT_UDN));
            for (int L = (bid & 3) * NTHREADS + tid; L < nt * nN; L += 4 * NTHREADS) { Unit uu; { const int nwg = nt * nN; int wgid = L; { const int q = nwg / 8, r = nwg % 8, xcd = wgid % 8, off = wgid / 8; wgid = (xcd < r ? xcd * (q + 1) : r * (q + 1) + (xcd - r) * q) + off; }
                    const int nig = 8 * nN, gid = wgid / nig, fm = gid * 8, gsz = (nt - fm) < 8 ? (nt - fm) : 8; uu.pm = fm + ((wgid % nig) % gsz); uu.pn = (wgid % nig) / gsz; uu.e = 0; }
                int e = 0;
#pragma unroll
                for (int st = 16; st >= 1; st >>= 1) { if ((pst[e + st] >> 8) <= uu.pm) e += st; }
                tab[L] = uu.pm | (uu.pn << 12) | (e << 16); } }
        __syncthreads();
    }
    SEAM(10);
    if (IN(11)) {
        const int ntiles = tile_tab[0];
        pg8::MoeGatherSched S; S.o.init_tiles(ntiles, 2048 / 256, G, bid); S.A = (const char*)HN; S.B = (const char*)Wgu_t; S.tile_e = tile_tab + 16; S.utab = (const int*)(ws + WS_ROUTE + RT_UGU); S.rtok = row_tok; S.tstep = (size_t)256 * 1024; S.estep = (size_t)2048 * 1024;
        EpiSwiglu E{ACT, args.in[I_BGU]}; pg8::gemm_phase<EpiSwiglu, pg8::MoeGatherSched, true, true>(lds, 512, S, E, wv0);
        { PHASE_IDS; LAS float* scr = (LAS float*)(lds + wave * 16384); constexpr int I_DN = 16 * 32;
          for (;;) { int c0 = 0; if (lane == 0) c0 = (int)atomicAdd(ctl + CW_CONV, 8u); c0 = __builtin_amdgcn_readfirstlane(c0);
              c0 += CONV_P9D; if (c0 >= NE * I_DN) break;
              for (int r = c0; r < c0 + 8; ++r) { const int e = r / I_DN, q = r % I_DN, kb = q / 32, nb = q % 32;
                  transpose_item_tiled_fp8(args.in[I_WDN] + (size_t)e * DFF * D, D, DFF, (unsigned char*)Wdn_t + (size_t)e * D * DFF, 64 * kb, 32 * nb, 32 * nb, scr, lane); } } }
    }
    SEAM(11);
    if (IN(12)) {
        const int ntiles = tile_tab[0];
        pg8::MoeSched S; S.o.init_tiles(ntiles, D / 256, G, bid); S.A = (const char*)ACT; S.B = (const char*)Wdn_t; S.tile_e = tile_tab + 16; S.utab = (const int*)(ws + WS_ROUTE + RT_UDN); S.tstep = (size_t)256 * 1024; S.estep = (size_t)1024 * 1024;
        EpiDown E{YS, args.in[I_BDN], row_sg}; pg8::gemm_phase<EpiDown, pg8::MoeSched, true, true>(lds, 512, S, E, wv0);
    }
    SEAM(12);
    if (IN(13)) { PHASE_IDS;
        const float* gfin = args.in[I_FNG];
        for (int m = gw; m < M; m += NGW) {
            float v[16]; float s = 0.f;
#pragma unroll
            for (int hf = 0; hf < 2; ++hf) { const u32x4 w = *(const u32x4*)(X2 + (size_t)m * D + 512 * hf + 8 * lane);
#pragma unroll
                for (int q = 0; q < 4; ++q) { v[8 * hf + 2 * q] = bflo(w[q]); v[8 * hf + 2 * q + 1] = bfhi(w[q]); }
#pragma unroll
                for (int k = 0; k < 4; ++k) { const u32x2 y = *(const u32x2*)((const unsigned char*)YS + (size_t)(m * 4 + k) * D + 512 * hf + 8 * lane);
#pragma unroll
                    for (int q = 0; q < 2; ++q) { const auto lo2 = __builtin_amdgcn_cvt_pk_f32_fp8((int)y[q], false), hi2 = __builtin_amdgcn_cvt_pk_f32_fp8((int)y[q], true);
                        v[8 * hf + 4 * q] += lo2[0] * 0.0625f; v[8 * hf + 4 * q + 1] += lo2[1] * 0.0625f; v[8 * hf + 4 * q + 2] += hi2[0] * 0.0625f; v[8 * hf + 4 * q + 3] += hi2[1] * 0.0625f; } } }
#pragma unroll
            for (int j = 0; j < 16; ++j) s += v[j] * v[j];
            const float rstd = rsq_f(wave_sum(s) * (1.f / D) + EPS);
#pragma unroll
            for (int hf = 0; hf < 2; ++hf) { const f32x4 g0 = *(const f32x4*)(gfin + 512 * hf + 8 * lane), g1 = *(const f32x4*)(gfin + 512 * hf + 8 * lane + 4);
                float* o = args.out + (size_t)m * D + 512 * hf + 8 * lane;
                *(f32x4*)o = (f32x4){v[8 * hf] * rstd * g0.x, v[8 * hf + 1] * rstd * g0.y, v[8 * hf + 2] * rstd * g0.z, v[8 * hf + 3] * rstd * g0.w};
                *(f32x4*)(o + 4) = (f32x4){v[8 * hf + 4] * rstd * g1.x, v[8 * hf + 5] * rstd * g1.y, v[8 * hf + 6] * rstd * g1.z, v[8 * hf + 7] * rstd * g1.w}; }
        }
    }
#undef IN
#undef SEAM
}

constexpr int N_PHASES = 14;
extern "C" void kernel_launch(void* const* d_in, const int* in_sizes, int n_in, void* d_out, int out_size, void* d_ws, size_t ws_size, hipStream_t stream) {
    static int grid = 0;
    if (grid == 0) {
        if (n_in != 37 || out_size != M * D || ws_size < WS_END) { fprintf(stderr, "kernel_launch: unexpected shapes (n_in %d, out %d, ws %zu); nothing launched\n", n_in, out_size, ws_size); grid = -1; return; }
        int dev = 0, cus = 0, per_cu = 0;
        if (hipGetDevice(&dev) != hipSuccess || hipDeviceGetAttribute(&cus, hipDeviceAttributeMultiprocessorCount, dev) != hipSuccess) { grid = -1; return; }
        if (hipFuncSetAttribute((const void*)fwd, hipFuncAttributeMaxDynamicSharedMemorySize, LDS_BYTES) != hipSuccess) { fprintf(stderr, "kernel_launch: hipFuncSetAttribute failed\n"); grid = -1; return; }
        if (hipOccupancyMaxActiveBlocksPerMultiprocessor(&per_cu, (const void*)fwd, NTHREADS, LDS_BYTES) != hipSuccess || per_cu < 1) fprintf(stderr, "kernel_launch: occupancy query says %d\n", per_cu);
        (void)hipGetLastError();
        grid = cus > 256 ? 256 : cus;
    }
    if (grid < 0) return;
    if (hipMemsetAsync((char*)d_ws + WS_CTL, 0, CTL_ZERO_BYTES, stream) != hipSuccess) return;
    Args a{};
    for (int i = 0; i < 37; ++i) a.in[i] = (const float*)d_in[i];
    a.out = (float*)d_out; a.ws = (unsigned char*)d_ws;
#if MK_ONE_LAUNCH
    a.ph_lo = 0; a.ph_hi = N_PHASES;
    hipLaunchKernelGGL(fwd, dim3(grid), dim3(NTHREADS), LDS_BYTES, stream, a);
#else
    for (int p = 0; p < N_PHASES; ++p) { a.ph_lo = p; a.ph_hi = p + 1; hipLaunchKernelGGL(fwd, dim3(grid), dim3(NTHREADS), LDS_BYTES, stream, a);
#ifdef PROBE_REPEAT_PHASE
        if (p == PROBE_REPEAT_PHASE) hipLaunchKernelGGL(fwd, dim3(grid), dim3(NTHREADS), LDS_BYTES, stream, a);
#endif
    }
#endif
}
```

```cpp
#include <hip/hip_runtime.h>
#include <cstdio>
#include <cstdint>

#ifndef MK_ONE_LAUNCH
#define MK_ONE_LAUNCH 1
#endif

#define DI __device__ __forceinline__
#define GAS __attribute__((address_space(1)))
#define LAS __attribute__((address_space(3)))
typedef unsigned short bf16;
typedef short bf16x8 __attribute__((ext_vector_type(8)));
typedef int v4i __attribute__((ext_vector_type(4)));
typedef int v8i __attribute__((ext_vector_type(8)));
typedef float f32x4 __attribute__((ext_vector_type(4)));
typedef float f32x2 __attribute__((ext_vector_type(2)));
typedef unsigned u32x4 __attribute__((ext_vector_type(4)));
typedef unsigned u32x2 __attribute__((ext_vector_type(2)));

constexpr int D = 1024, NB = 4, SEQ = 4096, M = NB * SEQ;
constexpr int MEML = 256, MROWS = NB * MEML;
constexpr int LRU_W = 512, RW = 512, NH = 8, HD = 64;
constexpr int INW = 2816;
constexpr int XH = 4, XHD = 256;
constexpr int NE = 32, TOPK = 4, DFF = 1024;
constexpr int NASSIGN = M * TOPK;
constexpr int MAXTILES = 288, MAXROWS = MAXTILES * 256;
constexpr float EPS = 1e-6f, GN_EPS = 64e-5f;

DI int fresh_tid_(int wv) { int w = wv; asm volatile("" : "+s"(w)); int l; asm volatile("v_mbcnt_lo_u32_b32 %0, -1, 0\n\tv_mbcnt_hi_u32_b32 %0, -1, %0" : "=v"(l)); return (w << 6) | (l & 63); }
#define fresh_tid() fresh_tid_(wv0)
namespace pg8 {
constexpr int BM = 256, BK = 64, HALF = 128, HTB = HALF * BK * 2, STAGE_BYTES = 8 * HTB, NXCD = 8, WGM = 8;
__host__ __device__ __forceinline__ int lds_byte(int r, int c) { const int st = (r >> 4) * 2 + (c >> 5), rr = r & 15, cc = c & 31, ob = rr * 64 + cc * 2; return st * 1024 + (ob ^ (((ob >> 9) & 1) << 5)); }
__host__ __device__ __forceinline__ void stage_rc(int b, int& R, int& C) { const int st = b / 1024, sb = b % 1024, swz = sb ^ (((sb >> 9) & 1) << 5); R = (st >> 1) * 16 + swz / 64; C = (st & 1) * 32 + (swz % 64) / 2; }
__host__ __device__ __forceinline__ int perm32(int rho) { const int n = rho >> 4, i = rho & 15; return 8 * (i >> 2) + 4 * n + (i & 3); }

struct Unit { int pm, pn, e; };

struct StaticOrder {
    int nM, nN, nwg, G, c;
    __host__ __device__ void init_tiles(int nM_, int nN_, int G_, int c_) { nM = nM_; nN = nN_; nwg = nM * nN; G = G_; c = c_; }
    __host__ __device__ bool next(int i, Unit& u) const {
        const long L = (long)i * G + c; if (L >= nwg) return false;
        int wgid = (int)L; { const int q = nwg / NXCD, r = nwg % NXCD, xcd = wgid % NXCD, off = wgid / NXCD; wgid = (xcd < r ? xcd * (q + 1) : r * (q + 1) + (xcd - r) * q) + off; }
        const int nig = WGM * nN, gid = wgid / nig, fm = gid * WGM, gsz = (nM - fm) < WGM ? (nM - fm) : WGM;
        u.pm = fm + ((wgid % nig) % gsz); u.pn = (wgid % nig) / gsz; u.e = 0; return true;
    }
};
struct DenseSched {
    static constexpr bool GATHER = false, B_TILED = false;
    StaticOrder o; const char* A; const char* B; size_t tstep;
    DI bool next(int i, Unit& u) const { return o.next(i, u); }
    DI const char* a_ptr(const Unit& u) const { return A + (size_t)u.pm * tstep; }
    DI const char* b_ptr(const Unit& u) const { return B + (size_t)u.pn * tstep; }
    DI void a_voff(const Unit&, int K, const int (&R)[2], const int (&C)[2], unsigned (&vo)[2][2]) const {
#pragma unroll
        for (int h = 0; h < 2; ++h)
#pragma unroll
            for (int i = 0; i < 2; ++i) vo[h][i] = (unsigned)((h * HALF + R[i]) * K + C[i]) * 2u; }
};
struct MoeSched {
    static constexpr bool GATHER = false, B_TILED = true;
    StaticOrder o; const char* A; const char* B; const int* tile_e; const int* utab; size_t tstep, estep;
    DI bool next(int i, Unit& u) const { const int L = i * o.G + o.c; if (L >= o.nwg) return false; int en; asm volatile("s_load_dword %0, %1, 0x0\n\ts_waitcnt lgkmcnt(0)" : "=s"(en) : "s"(utab + L) : "memory");     u.pm = en & 0xfff; u.pn = (en >> 12) & 15; u.e = en >> 16; return true; }
    DI const char* a_ptr(const Unit& u) const { return A + (size_t)u.pm * tstep; }
    DI const char* b_ptr(const Unit& u) const { return B + (size_t)u.e * estep + (size_t)u.pn * tstep; }
    DI void a_voff(const Unit&, int K, const int (&R)[2], const int (&C)[2], unsigned (&vo)[2][2]) const {
#pragma unroll
        for (int h = 0; h < 2; ++h)
#pragma unroll
            for (int i = 0; i < 2; ++i) vo[h][i] = (unsigned)((h * HALF + R[i]) * K + C[i]) * 2u; }
};
struct MoeGatherSched {
    static constexpr bool GATHER = true, B_TILED = true;
    StaticOrder o; const char* A; const char* B; const int* tile_e; const int* utab; const int* rtok; size_t tstep, estep;
    DI bool next(int i, Unit& u) const { const int L = i * o.G + o.c; if (L >= o.nwg) return false; int en; asm volatile("s_load_dword %0, %1, 0x0\n\ts_waitcnt lgkmcnt(0)" : "=s"(en) : "s"(utab + L) : "memory");     u.pm = en & 0xfff; u.pn = (en >> 12) & 15; u.e = en >> 16; return true; }
    DI const char* a_ptr(const Unit&) const { return A; }
    DI const char* b_ptr(const Unit& u) const { return B + (size_t)u.e * estep + (size_t)u.pn * tstep; }
    DI void a_voff(const Unit& u, int K, const int (&R)[2], const int (&C)[2], unsigned (&vo)[2][2]) const {
#pragma unroll
        for (int h = 0; h < 2; ++h)
#pragma unroll
            for (int i = 0; i < 2; ++i) vo[h][i] = (unsigned)(rtok[u.pm * BM + h * HALF + R[i]] * K + C[i]) * 2u; }
};

struct BatchBSched {
    static constexpr bool GATHER = false, B_TILED = false;
    StaticOrder o; const char* A; const char* B; size_t tstep, bstep;
    DI bool next(int i, Unit& u) const { return o.next(i, u); }
    DI const char* a_ptr(const Unit& u) const { return A + (size_t)u.pm * tstep; }
    DI const char* b_ptr(const Unit& u) const { return B + (size_t)(u.pm >> 4) * bstep + (size_t)u.pn * tstep; }
    DI void a_voff(const Unit&, int K, const int (&R)[2], const int (&C)[2], unsigned (&vo)[2][2]) const {
#pragma unroll
        for (int h = 0; h < 2; ++h)
#pragma unroll
            for (int i = 0; i < 2; ++i) vo[h][i] = (unsigned)((h * HALF + R[i]) * K + C[i]) * 2u; }
};
template <int MODE> struct FoldSched {
    static constexpr bool GATHER = false, B_TILED = false;
    const char* A; const char* B; int G, c;
    DI bool next(int i, Unit& u) const { const int L = i * G + c; if (L >= 64) return false; u.pm = L >> 2; u.pn = L & 3; u.e = 0; return true; }
    DI const char* a_ptr(const Unit& u) const { const int b = u.pm >> 2, h = u.pm & 3; return A + ((size_t)(MODE == 0 ? b * 256 : u.pn * 256) * 1024 + h * 256) * 2; }
    DI const char* b_ptr(const Unit& u) const { const int b = u.pm >> 2, h = u.pm & 3; return B + ((size_t)(MODE == 0 ? u.pn * 256 : b * 256) * 1024 + h * 256) * 2; }
    DI void a_voff(const Unit&, int K, const int (&R)[2], const int (&C)[2], unsigned (&vo)[2][2]) const {
#pragma unroll
        for (int h = 0; h < 2; ++h)
#pragma unroll
            for (int i = 0; i < 2; ++i) vo[h][i] = (unsigned)((h * HALF + R[i]) * K + C[i]) * 2u; }
};

DI unsigned cvt_pk_bf16(float lo, float hi) { unsigned r; asm volatile("v_cvt_pk_bf16_f32 %0, %1, %2" : "=v"(r) : "v"(lo), "v"(hi)); return r; }

template <class Epi, class Sched, bool ALIGN_EPI = true, bool FP8 = false>
DI void gemm_phase(LAS unsigned char* lds, const int K, const Sched& S, const Epi& E, const int wv0, const int ldp = 0) {
    const int ld = ldp ? ldp : K;
    const int tid = fresh_tid(), wid = __builtin_amdgcn_readfirstlane(tid >> 6), lane = tid & 63, wr = wid >> 2, wc = wid & 3, fr = lane & 15, fq = lane >> 4;
    const int nt = K / BK;
    constexpr bool GA = Sched::GATHER, BT = Sched::B_TILED;
    unsigned voffA[2][2], voffAn[2][2], voffB[2];
#pragma unroll
    for (int i = 0; i < 2; ++i) { int R, C; stage_rc(tid * 16 + i * 8192, R, C); const int Rb = Epi::PERM ? ((R & ~31) + perm32(R & 31)) : R;
        voffB[i] = BT ? (unsigned)(tid * 16 + i * 8192) : (unsigned)(Rb * ld + C) * 2u; }
#define PG8_AVOFF(unit, dst) do { int sR[2], sC[2]; const int t2_ = fresh_tid(); stage_rc(t2_ * 16, sR[0], sC[0]); stage_rc(t2_ * 16 + 8192, sR[1], sC[1]); S.a_voff(unit, ld, sR, sC, dst); } while (0)
    const size_t kstep = (size_t)(BK * 2);
    const size_t hstep = (size_t)HALF * ld * 2;
    const size_t kstepB = BT ? (size_t)(2 * HTB) : kstep, hstepB = BT ? (size_t)HTB : hstep;
    const unsigned ldsw = (unsigned)wid * 1024u;
    unsigned aoffv = (unsigned)(size_t)lds + (unsigned)lds_byte(wr * 64 + fr, fq * 8), boffv = (unsigned)(size_t)lds + (unsigned)(4 * HTB) + (unsigned)lds_byte(wc * 32 + fr, fq * 8);
    asm volatile("" : "+v"(aoffv), "+v"(boffv));
    const size_t dB = BT ? (size_t)8192 : (size_t)64 * ld * 2, dA = (size_t)64 * ld * 2;
#define PG8_SA(b, h) (((b) * 2 + (h)) * HTB)
#define PG8_SB(b, h) ((4 + (b) * 2 + (h)) * HTB)
    const unsigned ldsbase = (unsigned)__builtin_amdgcn_readfirstlane((int)((unsigned)(size_t)lds + ldsw));
#define PG8_STAGE1(bufoff, gptr, vo, i_) do { const unsigned m0v_ = ldsbase + (unsigned)(bufoff) + (unsigned)(i_) * 8192u; \
        asm volatile("s_mov_b32 m0, %2\n\ts_nop 0\n\tglobal_load_lds_dwordx4 %0, %1" :: "v"(vo), "s"((const char*)(gptr)), "s"(m0v_) : "memory", "m0"); } while (0)
#define PG8_STAGE(bufoff, gbase, voff) do { PG8_STAGE1(bufoff, gbase, (voff)[0], 0); PG8_STAGE1(bufoff, gbase, (voff)[1], 1); } while (0)
#define PG8_STAGE_D(bufoff, gbase, vo, delta) do { PG8_STAGE1(bufoff, gbase, vo, 0); PG8_STAGE1(bufoff, (const char*)(gbase) + (delta), vo, 1); } while (0)
#define PG8_LDA(dst, b, h) do { if constexpr (FP8) { _Pragma("unroll") for (int m = 0; m < 4; ++m) { const LAS v4i* p_ = (const LAS v4i*)((LAS unsigned char*)(size_t)aoffv + PG8_SA(b, h) + m * 2048); dst##8[m] = __builtin_shufflevector(p_[0], p_[64], 0, 1, 2, 3, 4, 5, 6, 7); } } \
        else { _Pragma("unroll") for (int m = 0; m < 4; ++m) _Pragma("unroll") for (int k = 0; k < 2; ++k) dst[m][k] = *(const LAS bf16x8*)((LAS unsigned char*)(size_t)aoffv + PG8_SA(b, h) + m * 2048 + k * 1024); } } while (0)
#define PG8_LDB(dst, b, h) do { if constexpr (FP8) { _Pragma("unroll") for (int n = 0; n < 2; ++n) { const LAS v4i* p_ = (const LAS v4i*)((LAS unsigned char*)(size_t)boffv + (PG8_SB(b, h) - 4 * HTB) + n * 2048); dst##8[n] = __builtin_shufflevector(p_[0], p_[64], 0, 1, 2, 3, 4, 5, 6, 7); } } \
        else { _Pragma("unroll") for (int n = 0; n < 2; ++n) _Pragma("unroll") for (int k = 0; k < 2; ++k) dst[n][k] = *(const LAS bf16x8*)((LAS unsigned char*)(size_t)boffv + (PG8_SB(b, h) - 4 * HTB) + n * 2048 + k * 1024); } } while (0)
#define PG8_MMA(ai, bj, At, Bt) do { __builtin_amdgcn_s_setprio(1); \
        if constexpr (FP8) {   \
            _Pragma("unroll") for (int m = 0; m < 4; ++m) _Pragma("unroll") for (int n = 0; n < 2; ++n) \
                acc[ai][bj][m][n] = __builtin_amdgcn_mfma_scale_f32_16x16x128_f8f6f4(Bt##8[n], At##8[m], acc[ai][bj][m][n], 0, 0, 0, 0, 0, 0); } \
        else { _Pragma("unroll") for (int m = 0; m < 4; ++m) _Pragma("unroll") for (int n = 0; n < 2; ++n) _Pragma("unroll") for (int k = 0; k < 2; ++k) \
            acc[ai][bj][m][n] = __builtin_amdgcn_mfma_f32_16x16x32_bf16(Bt[n][k], At[m][k], acc[ai][bj][m][n], 0, 0, 0); } \
        __builtin_amdgcn_s_setprio(0); } while (0)
#define PG8_WAIT_V(n) asm volatile("s_waitcnt vmcnt(" #n ")" ::: "memory")
#define PG8_WAIT_L(n) asm volatile("s_waitcnt lgkmcnt(" #n ")" ::: "memory")
#define PG8_BAR __builtin_amdgcn_s_barrier()
#define PG8_SCHED __builtin_amdgcn_sched_barrier(0)
    Unit cur, nxt; int ui = 0;
    if (!S.next(0, cur)) return;
    f32x4 acc[2][2][4][2];
#pragma unroll
    for (int a = 0; a < 2; ++a)
#pragma unroll
        for (int b = 0; b < 2; ++b)
#pragma unroll
            for (int m = 0; m < 4; ++m)
#pragma unroll
                for (int n = 0; n < 2; ++n) acc[a][b][m][n] = (f32x4){0.f, 0.f, 0.f, 0.f};
    bf16x8 At[4][2], B0[2][2], B1[2][2]; v8i At8[4], B08[2], B18[2];
    const char* cA = S.a_ptr(cur); const char* cB = S.b_ptr(cur);
    PG8_AVOFF(cur, voffA);
#define PG8_STAGE_A(bufoff, kbase, h, vo) do { if constexpr (GA) { PG8_STAGE(bufoff, kbase, (vo)[h]); } else { PG8_STAGE_D(bufoff, (kbase) + (h) * hstep, voffA[0][0], dA); } } while (0)
    PG8_STAGE_D(PG8_SB(0, 0), cB, voffB[0], dB); PG8_STAGE_D(PG8_SB(0, 1), cB + hstepB, voffB[0], dB); PG8_STAGE_A(PG8_SA(0, 0), cA, 0, voffA); PG8_STAGE_A(PG8_SA(0, 1), cA, 1, voffA);
    if (wr == 1) PG8_BAR;
    PG8_WAIT_V(2); PG8_BAR;
    PG8_STAGE_D(PG8_SB(1, 0), cB + kstepB, voffB[0], dB); PG8_STAGE_A(PG8_SA(1, 0), cA + kstep, 0, voffA); PG8_STAGE_D(PG8_SB(1, 1), cB + hstepB + kstepB, voffB[0], dB);
    PG8_WAIT_V(6); PG8_BAR;
    for (;;) {
        const bool has_next = S.next(ui + 1, nxt);
        const char* nA = has_next ? S.a_ptr(nxt) : cA; const char* nB = has_next ? S.b_ptr(nxt) : cB;
        if constexpr (GA) { if (has_next) PG8_AVOFF(nxt, voffAn);
            else {
#pragma unroll
                for (int h = 0; h < 2; ++h)
#pragma unroll
                    for (int i = 0; i < 2; ++i) voffAn[h][i] = voffA[h][i]; } }
#pragma unroll 1
        for (int t = 0; t < nt; t += 2) {
            const bool last = (t == nt - 2);
            const char* a1 = cA + (size_t)(t + 1) * kstep;
            const char* a2 = last ? nA : cA + (size_t)(t + 2) * kstep; const char* b2 = last ? nB : cB + (size_t)(t + 2) * kstepB;
            const char* a3 = a2 + kstep; const char* b3 = b2 + kstepB;
            PG8_LDB(B0, 0, 0); PG8_LDB(B1, 0, 1); PG8_SCHED; PG8_LDA(At, 0, 0); PG8_STAGE_A(PG8_SA(1, 1), a1, 1, voffA);
            if constexpr (GA) { if (last) {
#pragma unroll
                for (int h = 0; h < 2; ++h)
#pragma unroll
                    for (int i = 0; i < 2; ++i) voffA[h][i] = voffAn[h][i]; } }
            PG8_WAIT_V(8); PG8_WAIT_L(0); PG8_BAR; PG8_MMA(0, 0, At, B0); PG8_MMA(0, 1, At, B1); PG8_BAR; PG8_SCHED;
            PG8_LDA(At, 0, 1); PG8_STAGE_D(PG8_SB(0, 0), b2, voffB[0], dB); PG8_STAGE_D(PG8_SB(0, 1), b2 + hstepB, voffB[0], dB); PG8_STAGE_A(PG8_SA(0, 0), a2, 0, voffA);
            PG8_WAIT_V(8); PG8_WAIT_L(0); PG8_BAR; PG8_MMA(1, 0, At, B0); PG8_MMA(1, 1, At, B1); PG8_BAR; PG8_SCHED;
            PG8_LDB(B0, 1, 0); PG8_LDB(B1, 1, 1); PG8_SCHED; PG8_LDA(At, 1, 0); PG8_STAGE_A(PG8_SA(0, 1), a2, 1, voffA);
            PG8_WAIT_V(8); PG8_WAIT_L(0); PG8_BAR; PG8_MMA(0, 0, At, B0); PG8_MMA(0, 1, At, B1); PG8_BAR; PG8_SCHED;
            PG8_LDA(At, 1, 1); PG8_STAGE_D(PG8_SB(1, 0), b3, voffB[0], dB); PG8_STAGE_D(PG8_SB(1, 1), b3 + hstepB, voffB[0], dB); PG8_STAGE_A(PG8_SA(1, 0), a3, 0, voffA);
            PG8_WAIT_V(8); PG8_WAIT_L(0); PG8_BAR; PG8_MMA(1, 0, At, B0); PG8_MMA(1, 1, At, B1); PG8_BAR; PG8_SCHED;
        }
        if constexpr (ALIGN_EPI) { if (wr == 0) PG8_BAR; }
        { Unit ue = cur; ue.pm = __builtin_amdgcn_readfirstlane(ue.pm); ue.pn = __builtin_amdgcn_readfirstlane(ue.pn); ue.e = __builtin_amdgcn_readfirstlane(ue.e); asm volatile("" : "+s"(ue.pm), "+s"(ue.pn), "+s"(ue.e));
          const int t3_ = fresh_tid(); const int fr_ = t3_ & 15, fq_ = (t3_ & 63) >> 4;
          E(acc, ue, wr, wc, fr_, fq_); }
        if (!has_next) break;
#pragma unroll
        for (int a = 0; a < 2; ++a)
#pragma unroll
            for (int b = 0; b < 2; ++b)
#pragma unroll
                for (int m = 0; m < 4; ++m)
#pragma unroll
                    for (int n = 0; n < 2; ++n) acc[a][b][m][n] = (f32x4){0.f, 0.f, 0.f, 0.f};
        cur = nxt; cA = nA; cB = nB; ++ui;
        if constexpr (ALIGN_EPI) { if (wr == 1) PG8_BAR; }
    }
    PG8_WAIT_V(0);
    if constexpr (!ALIGN_EPI) { if (wr == 0) PG8_BAR; }
    PG8_BAR;
#undef PG8_SA
#undef PG8_SB
#undef PG8_STAGE
#undef PG8_STAGE1
#undef PG8_STAGE_D
#undef PG8_STAGE_A
#undef PG8_AVOFF
#undef PG8_LDA
#undef PG8_LDB
#undef PG8_MMA
#undef PG8_WAIT_V
#undef PG8_WAIT_L
#undef PG8_BAR
#undef PG8_SCHED
}
}
using pg8::Unit;
using pg8::cvt_pk_bf16;

DI float bflo(unsigned w) { return __uint_as_float(w << 16); }
DI float bfhi(unsigned w) { return __uint_as_float(w & 0xffff0000u); }
DI float bf2f(bf16 b) { return __uint_as_float(((unsigned)b) << 16); }
typedef __bf16 hwbf2 __attribute__((ext_vector_type(2)));
DI unsigned pk2(float lo, float hi) { const f32x2 v = {lo, hi}; return __builtin_bit_cast(unsigned, __builtin_convertvector(v, hwbf2)); }
DI unsigned f2bf(float f) { return pk2(f, 0.f) & 0xffffu; }
DI float rcp_f(float x) { return __builtin_amdgcn_rcpf(x); }
DI float rsq_f(float x) { return __builtin_amdgcn_rsqf(x); }
DI float sigmoid_f(float x) { return rcp_f(1.0f + __expf(-x)); }
DI float tanh_fast(float x) { return 1.0f - 2.0f * rcp_f(__expf(2.0f * x) + 1.0f); }
DI float softplus_f(float x) { return fmaxf(x, 0.f) + __logf(1.0f + __expf(-fabsf(x))); }
DI float softplus_fast(float x) { return fmaxf(x, 0.f) + __logf(1.0f + __expf(-fabsf(x))); }
DI float gelu_tanh_f(float x) { const float u = 0.7978845608028654f * (x + 0.044715f * x * x * x); return 0.5f * x * (1.0f + tanh_fast(u)); }
DI float wave_sum(float v) {
#pragma unroll
    for (int o = 1; o < 64; o <<= 1) v += __shfl_xor(v, o);
    return v;
}

DI unsigned pk4_fp8(float a, float b, float c, float d) { int w = 0; w = __builtin_amdgcn_cvt_pk_fp8_f32(a, b, w, false); w = __builtin_amdgcn_cvt_pk_fp8_f32(c, d, w, true); return (unsigned)w; }
struct EpiBf16Plain {
    static constexpr bool PERM = true;
    bf16* O; int ldc; float scale;
    DI void operator()(const f32x4 (&acc)[2][2][4][2], const Unit& u, int wr, int wc, int fr, int fq) const {
        const int row0 = u.pm * 256 + wr * 64 + fr, col0 = u.pn * 256 + wc * 32 + 8 * fq;
#pragma unroll
        for (int ai = 0; ai < 2; ++ai)
#pragma unroll
            for (int m = 0; m < 4; ++m) { bf16* rowp = O + (size_t)(row0 + ai * 128 + m * 16) * ldc + col0;
#pragma unroll
                for (int bj = 0; bj < 2; ++bj) { const f32x4 v0 = acc[ai][bj][m][0] * scale, v1 = acc[ai][bj][m][1] * scale;
                    u32x4 w; w.x = cvt_pk_bf16(v0[0], v0[1]); w.y = cvt_pk_bf16(v0[2], v0[3]); w.z = cvt_pk_bf16(v1[0], v1[1]); w.w = cvt_pk_bf16(v1[2], v1[3]);
                    *(u32x4*)(rowp + bj * 128) = w; } }
    }
};
template <int MODE> struct EpiFold {
    static constexpr bool PERM = true;
    unsigned char* O;
    DI void operator()(const f32x4 (&acc)[2][2][4][2], const Unit& u, int wr, int wc, int fr, int fq) const {
        const int b = u.pm >> 2, h = u.pm & 3;
        const int rbase = MODE == 0 ? h * 256 : u.pn * 256, cbase = MODE == 0 ? u.pn * 256 : h * 256;
        const unsigned boff = (unsigned)b * 1024u * 1024u + (unsigned)(rbase + wr * 64 + fr) * 1024u + (unsigned)(cbase + wc * 32 + 8 * fq);
#pragma unroll
        for (int ai = 0; ai < 2; ++ai)
#pragma unroll
            for (int m = 0; m < 4; ++m) { unsigned char* rowp = O + (boff + (unsigned)(ai * 128 + m * 16) * 1024u);
#pragma unroll
                for (int bj = 0; bj < 2; ++bj) { const f32x4 v0 = acc[ai][bj][m][0] * 4.0f, v1 = acc[ai][bj][m][1] * 4.0f;
                    u32x2 w; w.x = pk4_fp8(v0[0], v0[1], v0[2], v0[3]); w.y = pk4_fp8(v1[0], v1[1], v1[2], v1[3]);
                    *(u32x2*)(rowp + bj * 128) = w; } }
    }
};
struct EpiSoftmax {
    static constexpr bool PERM = true;
    unsigned char* O; float scale; const float* RS; LAS float* XM; LAS float* XS;
    DI void operator()(const f32x4 (&acc)[2][2][4][2], const Unit& u, int wr, int wc, int fr, int fq) const {
        const int row0 = u.pm * 256 + wr * 64 + fr, col0 = u.pn * 256 + wc * 32 + 8 * fq;
        float sc[2][4];
#pragma unroll
        for (int ai = 0; ai < 2; ++ai)
#pragma unroll
            for (int m = 0; m < 4; ++m) { const int r = row0 + ai * 128 + m * 16; const f32x4* rp = (const f32x4*)(RS + (size_t)r * 16);
                const f32x4 p0 = rp[0], p1 = rp[1], p2 = rp[2], p3 = rp[3];
                const float ss = ((p0[0] + p0[1]) + (p0[2] + p0[3])) + ((p1[0] + p1[1]) + (p1[2] + p1[3])) + ((p2[0] + p2[1]) + (p2[2] + p2[3])) + ((p3[0] + p3[1]) + (p3[2] + p3[3]));
                sc[ai][m] = scale * __builtin_amdgcn_rsqf(ss * (1.0f / 1024.0f) + 1e-6f);
                float mm = -3.0e38f;
#pragma unroll
                for (int bj = 0; bj < 2; ++bj)
#pragma unroll
                    for (int n = 0; n < 2; ++n) { const f32x4 v = acc[ai][bj][m][n]; mm = fmaxf(mm, fmaxf(fmaxf(v[0], v[1]), fmaxf(v[2], v[3]))); }
                mm *= sc[ai][m];
                mm = fmaxf(mm, __shfl_xor(mm, 16)); mm = fmaxf(mm, __shfl_xor(mm, 32));
                if (fq == 0) XM[(ai * 128 + wr * 64 + m * 16 + fr) * 4 + wc] = mm; }
        asm volatile("s_waitcnt lgkmcnt(0)" ::: "memory"); __builtin_amdgcn_s_barrier(); asm volatile("" ::: "memory");
        f32x4 (&pa)[2][2][4][2] = const_cast<f32x4 (&)[2][2][4][2]>(acc);
#pragma unroll
        for (int ai = 0; ai < 2; ++ai)
#pragma unroll
            for (int m = 0; m < 4; ++m) { const int lr = ai * 128 + wr * 64 + m * 16 + fr; const f32x4 q = *(const LAS f32x4*)(XM + lr * 4);
                const float mxr = fmaxf(fmaxf(q[0], q[1]), fmaxf(q[2], q[3])); float sm = 0.f;
#pragma unroll
                for (int bj = 0; bj < 2; ++bj)
#pragma unroll
                    for (int n = 0; n < 2; ++n)
#pragma unroll
                        for (int j = 0; j < 4; ++j) { const float p = __expf(acc[ai][bj][m][n][j] * sc[ai][m] - mxr); pa[ai][bj][m][n][j] = p; sm += p; }
                sm += __shfl_xor(sm, 16); sm += __shfl_xor(sm, 32);
                if (fq == 0) XS[lr * 4 + wc] = sm; }
        asm volatile("s_waitcnt lgkmcnt(0)" ::: "memory"); __builtin_amdgcn_s_barrier(); asm volatile("" ::: "memory");
#pragma unroll
        for (int ai = 0; ai < 2; ++ai)
#pragma unroll
            for (int m = 0; m < 4; ++m) { const int lr = ai * 128 + wr * 64 + m * 16 + fr; const f32x4 q = *(const LAS f32x4*)(XS + lr * 4);
                const float inv = 256.0f * __builtin_amdgcn_rcpf((q[0] + q[1]) + (q[2] + q[3]));
                unsigned char* rowp = O + (size_t)(row0 + ai * 128 + m * 16) * 1024 + col0;
#pragma unroll
                for (int bj = 0; bj < 2; ++bj) { const f32x4 v0 = pa[ai][bj][m][0] * inv, v1 = pa[ai][bj][m][1] * inv;
                    u32x2 w; w.x = pk4_fp8(v0[0], v0[1], v0[2], v0[3]); w.y = pk4_fp8(v1[0], v1[1], v1[2], v1[3]);
                    *(u32x2*)(rowp + bj * 128) = w; } }
        asm volatile("s_waitcnt lgkmcnt(0)" ::: "memory"); __builtin_amdgcn_s_barrier(); asm volatile("" ::: "memory");
    }
};
struct EpiBf16RowNorm {
    static constexpr bool PERM = true;
    bf16* O; int ldc; float scale; const float* RS;
    DI void operator()(const f32x4 (&acc)[2][2][4][2], const Unit& u, int wr, int wc, int fr, int fq) const {
        const int row0 = u.pm * 256 + wr * 64 + fr, col0 = u.pn * 256 + wc * 32 + 8 * fq;
#pragma unroll
        for (int ai = 0; ai < 2; ++ai)
#pragma unroll
            for (int m = 0; m < 4; ++m) { const int r = row0 + ai * 128 + m * 16; const f32x4* rp = (const f32x4*)(RS + (size_t)r * 16);
                const f32x4 p0 = rp[0], p1 = rp[1], p2 = rp[2], p3 = rp[3];
                const float ss = ((p0[0] + p0[1]) + (p0[2] + p0[3])) + ((p1[0] + p1[1]) + (p1[2] + p1[3])) + ((p2[0] + p2[1]) + (p2[2] + p2[3])) + ((p3[0] + p3[1]) + (p3[2] + p3[3]));
                const float sc = scale * __builtin_amdgcn_rsqf(ss * (1.0f / 1024.0f) + 1e-6f);
                bf16* rowp = O + (size_t)r * ldc + col0;
#pragma unroll
                for (int bj = 0; bj < 2; ++bj) { const f32x4 v0 = acc[ai][bj][m][0] * sc, v1 = acc[ai][bj][m][1] * sc;
                    u32x4 w; w.x = cvt_pk_bf16(v0[0], v0[1]); w.y = cvt_pk_bf16(v0[2], v0[3]); w.z = cvt_pk_bf16(v1[0], v1[1]); w.w = cvt_pk_bf16(v1[2], v1[3]);
                    *(u32x4*)(rowp + bj * 128) = w; } }
    }
};
template <bool RES_BF16> struct EpiBf16Res {
    static constexpr bool PERM = true;
    const void* Rz; bf16* O; int ldc; float* RS; float ascale; unsigned char* O8;
    DI void operator()(const f32x4 (&acc)[2][2][4][2], const Unit& u, int wr, int wc, int fr, int fq) const {
        const int row0 = u.pm * 256 + wr * 64 + fr, col0 = u.pn * 256 + wc * 32 + 8 * fq;
#pragma unroll
        for (int ai = 0; ai < 2; ++ai) {
            u32x4 rwb[4][2]; f32x4 rf0[4][2], rf1[4][2];
#pragma unroll
            for (int m = 0; m < 4; ++m) { const size_t off = (size_t)(row0 + ai * 128 + m * 16) * ldc + col0;
#pragma unroll
                for (int bj = 0; bj < 2; ++bj) {
                    if (RES_BF16) rwb[m][bj] = *(const u32x4*)((const bf16*)Rz + off + bj * 128);
                    else { rf0[m][bj] = *(const f32x4*)((const float*)Rz + off + bj * 128); rf1[m][bj] = *(const f32x4*)((const float*)Rz + off + bj * 128 + 4); } } }
#pragma unroll
            for (int m = 0; m < 4; ++m) { const size_t off = (size_t)(row0 + ai * 128 + m * 16) * ldc + col0; float ssq = 0.f;
#pragma unroll
                for (int bj = 0; bj < 2; ++bj) { f32x4 r0, r1;
                    if (RES_BF16) { const u32x4 rw = rwb[m][bj]; r0 = (f32x4){bflo(rw.x), bfhi(rw.x), bflo(rw.y), bfhi(rw.y)}; r1 = (f32x4){bflo(rw.z), bfhi(rw.z), bflo(rw.w), bfhi(rw.w)}; }
                    else { r0 = rf0[m][bj]; r1 = rf1[m][bj]; }
                    const f32x4 v0 = r0 + acc[ai][bj][m][0] * ascale, v1 = r1 + acc[ai][bj][m][1] * ascale;
                    if (O8) { u32x2 w8; w8.x = pk4_fp8(v0[0], v0[1], v0[2], v0[3]); w8.y = pk4_fp8(v1[0], v1[1], v1[2], v1[3]); *(u32x2*)(O8 + off + bj * 128) = w8; }
                    ssq += (v0[0] * v0[0] + v0[1] * v0[1]) + (v0[2] * v0[2] + v0[3] * v0[3]) + (v1[0] * v1[0] + v1[1] * v1[1]) + (v1[2] * v1[2] + v1[3] * v1[3]);
                    u32x4 w; w.x = cvt_pk_bf16(v0[0], v0[1]); w.y = cvt_pk_bf16(v0[2], v0[3]); w.z = cvt_pk_bf16(v1[0], v1[1]); w.w = cvt_pk_bf16(v1[2], v1[3]);
                    *(u32x4*)(O + off + bj * 128) = w; }
                if (RS) { ssq += __shfl_xor(ssq, 16); ssq += __shfl_xor(ssq, 32); if (fq == 0) RS[(size_t)(row0 + ai * 128 + m * 16) * 16 + u.pn * 4 + wc] = ssq; } } }
    }
};
struct EpiLora {
    static constexpr bool PERM = false;
    float* LWp; bf16* AAp; bf16* GGp; const float* w0; const float* a0;
    DI void operator()(const f32x4 (&acc)[2][2][4][2], const Unit& u, int wr, int wc, int fr, int fq) const {
        const int kind = u.pn >> 1;
        const int row0 = u.pm * 256 + wr * 64 + fr, col0 = (u.pn & 1) * 256 + wc * 32 + 4 * fq;
#pragma unroll
        for (int bj = 0; bj < 2; ++bj)
#pragma unroll
            for (int n = 0; n < 2; ++n) {
                const int c = col0 + bj * 128 + n * 16;
                f32x4 bias = (f32x4){0.f, 0.f, 0.f, 0.f};
                if (kind == 0) bias = *(const f32x4*)(w0 + c); else if (kind == 1) bias = *(const f32x4*)(a0 + c);
#pragma unroll
                for (int ai = 0; ai < 2; ++ai)
#pragma unroll
                    for (int m = 0; m < 4; ++m) {
                        f32x4 v = acc[ai][bj][m][n] + bias;
                        if (kind == 0) {
#pragma unroll
                            for (int j = 0; j < 4; ++j) { const float w = -softplus_fast(-v[j]) - 0.5f; v[j] = -__expf(w);     }
                        } else if (kind == 1) {
#pragma unroll
                            for (int j = 0; j < 4; ++j) v[j] = sigmoid_f(v[j]);
                        }
                        const size_t o_ = (size_t)(row0 + ai * 128 + m * 16) * 512 + c;
                        if (kind == 0) *(f32x4*)(LWp + o_) = v;
                        else { u32x2 w_; w_.x = cvt_pk_bf16(v[0], v[1]); w_.y = cvt_pk_bf16(v[2], v[3]); *(u32x2*)((kind == 1 ? AAp : GGp) + o_) = w_; }
                    }
            }
    }
};
typedef float f32x2_t __attribute__((ext_vector_type(2)));
struct EpiSwiglu {
    static constexpr bool PERM = true;
    bf16* ACT; const float* b_gu;
    DI void operator()(const f32x4 (&acc)[2][2][4][2], const Unit& u, int wr, int wc, int fr, int fq) const {
        const int row0 = u.pm * 256 + wr * 64 + fr, j0 = u.pn * 128 + wc * 32 + 8 * fq;
        const float* bg = b_gu + (size_t)u.e * 2048 + j0; const float* bu = bg + 1024;
        const f32x4 bg0 = *(const f32x4*)bg, bg1 = *(const f32x4*)(bg + 4), bu0 = *(const f32x4*)bu, bu1 = *(const f32x4*)(bu + 4);
#pragma unroll
        for (int ai = 0; ai < 2; ++ai)
#pragma unroll
            for (int m = 0; m < 4; ++m) {
                float o[8];
#pragma unroll
                for (int n = 0; n < 2; ++n) { const f32x4 g4 = acc[ai][0][m][n] * 0.015625f + (n ? bg1 : bg0), u4 = acc[ai][1][m][n] * 0.015625f + (n ? bu1 : bu0);
#pragma unroll
                    for (int p = 0; p < 2; ++p) {
                        f32x2_t g, up; g.x = fminf(g4[2 * p], 7.0f); g.y = fminf(g4[2 * p + 1], 7.0f); up.x = fminf(fmaxf(u4[2 * p], -7.0f), 7.0f); up.y = fminf(fmaxf(u4[2 * p + 1], -7.0f), 7.0f);
                        const f32x2_t ex = g * (-1.702f * 1.44269504089f); f32x2_t d; d.x = __builtin_amdgcn_exp2f(ex.x); d.y = __builtin_amdgcn_exp2f(ex.y); d = d + 1.0f;
                        f32x2_t r; r.x = __builtin_amdgcn_rcpf(d.x); r.y = __builtin_amdgcn_rcpf(d.y);
                        const f32x2_t ov = (up + 1.0f) * (g * r); o[n * 4 + 2 * p] = ov.x; o[n * 4 + 2 * p + 1] = ov.y; } }
                u32x2 w; w.x = pk4_fp8(o[0], o[1], o[2], o[3]); w.y = pk4_fp8(o[4], o[5], o[6], o[7]);
                *(u32x2*)((unsigned char*)ACT + (size_t)(row0 + ai * 128 + m * 16) * 1024 + j0) = w;
            }
    }
};
struct EpiDown {
    static constexpr bool PERM = true;
    bf16* YS; const float* b_dn; const u32x2* row_sg;
    DI void operator()(const f32x4 (&acc)[2][2][4][2], const Unit& u, int wr, int wc, int fr, int fq) const {
        const int row0 = u.pm * 256 + wr * 64 + fr, col0 = u.pn * 256 + wc * 32 + 8 * fq;
        const float* bb = b_dn + (size_t)u.e * 1024 + col0;
        f32x4 bv[2][2];
#pragma unroll
        for (int bj = 0; bj < 2; ++bj)
#pragma unroll
            for (int n = 0; n < 2; ++n) bv[bj][n] = *(const f32x4*)(bb + bj * 128 + 4 * n);
        int slots[8]; float gts[8];
        { const u32x2* sgp = row_sg + row0;
#pragma unroll
        for (int q = 0; q < 8; ++q) { const u32x2 sg = sgp[(q >> 2) * 128 + (q & 3) * 16]; slots[q] = (int)sg.x; gts[q] = __uint_as_float(sg.y); } }
#pragma unroll
        for (int ai = 0; ai < 2; ++ai)
#pragma unroll
            for (int m = 0; m < 4; ++m) {
                const int slot = slots[ai * 4 + m]; const float gt = gts[ai * 4 + m];
                if (slot >= 0) { unsigned char* rowp = (unsigned char*)YS + (size_t)slot * 1024 + col0; const float g16 = gt * 16.0f;
#pragma unroll
                    for (int bj = 0; bj < 2; ++bj) { const f32x4 v0 = (acc[ai][bj][m][0] * 0.015625f + bv[bj][0]) * g16, v1 = (acc[ai][bj][m][1] * 0.015625f + bv[bj][1]) * g16;
                        u32x2 w; w.x = pk4_fp8(v0[0], v0[1], v0[2], v0[3]); w.y = pk4_fp8(v1[0], v1[1], v1[2], v1[3]);
                        *(u32x2*)(rowp + bj * 128) = w; } }
            }
    }
};

constexpr size_t MiB = 1u << 20;
constexpr size_t WS_CTL = 0, CTL_ZERO_BYTES = 1 * MiB;
constexpr size_t WS_WIN = 1 * MiB, WS_WOUT = 7 * MiB, WS_WQ = 9 * MiB, WS_WK = 11 * MiB, WS_WV = 13 * MiB, WS_WO = 15 * MiB, WS_LORAB = 17 * MiB, WS_LRUW = 18 * MiB;
constexpr size_t WS_ROUTE = 19 * MiB;
constexpr size_t WS_WGU = 22 * MiB, WS_WDN = 150 * MiB;
constexpr size_t WS_HN = 214 * MiB, WS_MEMN = 246 * MiB, WS_KM = 248 * MiB, WS_VT = 250 * MiB;
constexpr size_t WS_X1 = 252 * MiB, WS_X2 = 316 * MiB;
constexpr size_t WS_U = 380 * MiB, WS_R = 468 * MiB, WS_KRAW = 500 * MiB, WS_V = 532 * MiB, WS_KKN = 564 * MiB, WS_WD = 596 * MiB, WS_AA = 628 * MiB, WS_G = 660 * MiB;
constexpr size_t WS_LA = 692 * MiB, WS_LB = 724 * MiB, WS_AP = 756 * MiB, WS_CAT = 764 * MiB, WS_Q = 796 * MiB;
constexpr size_t WS_XS = 380 * MiB, WS_ACT = 524 * MiB, WS_YS = 668 * MiB;
constexpr size_t WS_GP = 796 * MiB, WS_HF = 860 * MiB, WS_RP = 924 * MiB, WS_Y1F = 940 * MiB, WS_ADD = 972 * MiB, WS_END = 1004 * MiB;
constexpr size_t WS_GC = 468 * MiB, WS_HC = 484 * MiB, WS_ZS = 500 * MiB;
static_assert(WS_AA == WS_WD + 32 * MiB && WS_G == WS_AA + 32 * MiB, "EpiLora strides");
static_assert(WS_U + (size_t)M * INW * 2 <= WS_R && WS_XS + (size_t)MAXROWS * 2048 <= WS_ACT && WS_ACT + (size_t)MAXROWS * 2048 <= WS_YS && WS_YS + (size_t)NASSIGN * 2048 <= WS_Q, "ws map");
constexpr size_t RT_E = 0, RT_POS = 256 * 1024, RT_G = 512 * 1024, RT_SLOT = 768 * 1024, RT_GATE = 1088 * 1024, RT_TILE = 1408 * 1024, RT_TOK = 1472 * 1024, RT_UGU = 1792 * 1024, RT_UDN = 1808 * 1024;
constexpr int CW_BAR = 4096, CW_CNT = 8192, CW_CONV = 12288;

constexpr int RING_BYTES = 131072, MISC_OFF = RING_BYTES + 320, LDS_BYTES = 147456;
constexpr int NWAVES = 8, NTHREADS = 512;
constexpr int CONV_P9 = 6144;
constexpr int CONV_P9D = 16384;

#define XB_TMO      128
#define XB_XCNT(j)  (256  + 64 * (j))
#define XB_XSUB(j)  (1280 + 64 * (j))
#define XB_XGEN(j)  (2304 + 64 * (j))
#define XB_TOP      3328
#define XB_TOPGEN   3392
#define XCD_BAR_WORDS 3456
#define XB_SPIN_CAP (1u << 18)
DI unsigned xb_ld(unsigned* p)              { return __hip_atomic_load(p, __ATOMIC_RELAXED, __HIP_MEMORY_SCOPE_AGENT); }
DI unsigned xb_add(unsigned* p, unsigned v) { return __hip_atomic_fetch_add(p, v, __ATOMIC_RELAXED, __HIP_MEMORY_SCOPE_AGENT); }
DI unsigned xb_xcc_id() { return (unsigned)__builtin_amdgcn_s_getreg((3 << 11) | 20) & 0xFu; }
#define XB_SPIN(cond, bar) do { unsigned _sp = 0; while (cond) { __builtin_amdgcn_s_sleep(1); \
    if ((++_sp & 255u) == 0u) { if (xb_ld(&(bar)[XB_TMO])) break; if (_sp > XB_SPIN_CAP) { atomicAdd(&(bar)[XB_TMO], 1u); break; } } } } while (0)
struct XcdBarrier { unsigned* bar; unsigned x; volatile LAS unsigned* st; int w0; };
DI XcdBarrier xcd_barrier_post(unsigned* bar, volatile LAS unsigned* st, int w0) {
    XcdBarrier b; b.bar = bar; b.x = xb_xcc_id(); b.st = st; b.w0 = w0;
    if (fresh_tid_(w0) == 0) (void)xb_add(&bar[XB_XCNT(b.x)], 1u);
    return b;
}
DI void xcd_barrier_complete(unsigned* bar, unsigned x, unsigned& nloc, unsigned& nx) {
    const unsigned G = gridDim.x * gridDim.y * gridDim.z;
    unsigned sum, cnt, mine, sp = 0u;
    for (;;) {
        sum = 0u; cnt = 0u; mine = 0u;
#pragma unroll
        for (unsigned j = 0; j < 16; ++j) { const unsigned c = xb_ld(&bar[XB_XCNT(j)]); sum += c; cnt += (c > 0u) ? 1u : 0u; mine = (j == x) ? c : mine; }
        if (sum == G) break;
        __builtin_amdgcn_s_sleep(1);
        if ((++sp & 255u) == 0u) { if (xb_ld(&bar[XB_TMO])) break; if (sp > XB_SPIN_CAP) { atomicAdd(&bar[XB_TMO], 1u); break; } }
    }
    nloc = mine > 0u ? mine : 1u; nx = cnt > 0u ? cnt : 1u;
}
DI void xcd_barrier(const XcdBarrier& b) {
    asm volatile("s_waitcnt vmcnt(0)" ::: "memory");
    __syncthreads();
    if (fresh_tid_(b.w0) == 0) {
        unsigned* bar = b.bar;
        __builtin_amdgcn_s_waitcnt(0);
        unsigned nloc = b.st[0], nx = b.st[1];
        if (nloc == 0u) { xcd_barrier_complete(bar, b.x, nloc, nx); b.st[0] = nloc; b.st[1] = nx; }
        const unsigned old = xb_add(&bar[XB_XSUB(b.x)], 1u);
        const unsigned gen = old / nloc;
        if (old + 1u == (gen + 1u) * nloc) {
            __builtin_amdgcn_fence(__ATOMIC_RELEASE, "agent");
            asm volatile("s_waitcnt vmcnt(0)" ::: "memory");
            const unsigned og = xb_add(&bar[XB_TOP], 1u);
            const unsigned tg = og / nx;
            if (og + 1u == (tg + 1u) * nx) xb_add(&bar[XB_TOPGEN], 1u);
            else XB_SPIN(xb_ld(&bar[XB_TOPGEN]) == tg, bar);
            __builtin_amdgcn_fence(__ATOMIC_ACQUIRE, "agent");
            xb_add(&bar[XB_XGEN(b.x)], 1u);
            asm volatile("s_waitcnt vmcnt(0)" ::: "memory");
        } else {
            XB_SPIN(xb_ld(&bar[XB_XGEN(b.x)]) == gen, bar);
            __builtin_amdgcn_fence(__ATOMIC_ACQUIRE, "agent");
            asm volatile("s_waitcnt vmcnt(0)" ::: "memory");
        }
    }
    __syncthreads();
}

struct Args { const float* in[37]; float* out; unsigned char* ws; int ph_lo, ph_hi; };
enum { I_X = 0, I_MEM, I_NMIXG, I_WIN, I_CONVW, I_CONVB, I_LWX, I_LBX, I_LWA, I_LBA, I_LAM, I_MU, I_W0, I_WUP, I_A0, I_AUP, I_GUP, I_KK, I_KA, I_RK, I_LNG, I_LNB,
       I_WOUT, I_NXAG, I_NMEMG, I_WQ, I_WK, I_WV, I_WO, I_NFFG, I_WR, I_BR, I_WGU, I_BGU, I_WDN, I_BDN, I_FNG };

DI void transpose_item(const float* W, int ldw, int K, bf16* WT, int k0, int n0, int drow0, LAS float* scr, int lane, const float* rs = nullptr) {
    f32x4 t[8];
    const float* src = W + (size_t)(k0 + (lane >> 3)) * ldw + n0 + 4 * (lane & 7);
#pragma unroll
    for (int i = 0; i < 8; ++i) t[i] = *(const f32x4*)(src + (size_t)(8 * i) * ldw);
#pragma unroll
    for (int i = 0; i < 8; ++i) { const float sc_ = rs ? rs[k0 + 8 * i + (lane >> 3)] : 1.0f; LAS float* d = scr + (8 * i + (lane >> 3)) * 33 + 4 * (lane & 7); d[0] = t[i].x * sc_; d[1] = t[i].y * sc_; d[2] = t[i].z * sc_; d[3] = t[i].w * sc_; }
    asm volatile("s_waitcnt lgkmcnt(0)" ::: "memory");
    const int c = lane & 7;
#pragma unroll
    for (int j = 0; j < 4; ++j) { const int n = (lane >> 3) + 8 * j; const LAS float* s = scr + (8 * c) * 33 + n;
        u32x4 o; o.x = pk2(s[0 * 33], s[1 * 33]); o.y = pk2(s[2 * 33], s[3 * 33]); o.z = pk2(s[4 * 33], s[5 * 33]); o.w = pk2(s[6 * 33], s[7 * 33]);
        *(u32x4*)(WT + (size_t)(drow0 + n) * K + k0 + 8 * c) = o; }
    asm volatile("s_waitcnt lgkmcnt(0)" ::: "memory");
}
DI void transpose_item_tiled(const float* W, int ldw, int K, bf16* WTe, int k0, int n0, int drow0, LAS float* scr, int lane) {
    f32x4 t[8];
    const float* src = W + (size_t)(k0 + (lane >> 3)) * ldw + n0 + 4 * (lane & 7);
#pragma unroll
    for (int i = 0; i < 8; ++i) t[i] = *(const f32x4*)(src + (size_t)(8 * i) * ldw);
#pragma unroll
    for (int i = 0; i < 8; ++i) { LAS float* d = scr + (8 * i + (lane >> 3)) * 33 + 4 * (lane & 7); d[0] = t[i].x; d[1] = t[i].y; d[2] = t[i].z; d[3] = t[i].w; }
    asm volatile("s_waitcnt lgkmcnt(0)" ::: "memory");
    const int c = lane & 7;
#pragma unroll
    for (int j = 0; j < 4; ++j) { const int n = (lane >> 3) + 8 * j; const LAS float* s = scr + (8 * c) * 33 + n;
        u32x4 o; o.x = pk2(s[0 * 33], s[1 * 33]); o.y = pk2(s[2 * 33], s[3 * 33]); o.z = pk2(s[4 * 33], s[5 * 33]); o.w = pk2(s[6 * 33], s[7 * 33]);
        const int drow = drow0 + n, pn = drow >> 8, half = (drow >> 7) & 1, r = drow & 127, x = r & 31;
        const int rslot = (r & ~31) + 16 * ((x >> 2) & 1) + 4 * (x >> 3) + (x & 3);
        const size_t tb = ((size_t)(pn * (K / 64) + (k0 >> 6)) * 2 + half) * 16384 + pg8::lds_byte(rslot, 8 * c);
        *(u32x4*)((char*)WTe + tb) = o; }
    asm volatile("s_waitcnt lgkmcnt(0)" ::: "memory");
}
DI void transpose_item_tiled_nolds(const float* W, int ldw, int K, bf16* WTe, int k0, int n0, int drow0, int lane) {
    const int n = lane & 31, kh = lane >> 5;
    const float* src = W + (size_t)(k0 + 32 * kh) * ldw + n0 + n;
    float t[32];
#pragma unroll
    for (int i = 0; i < 32; ++i) t[i] = src[(size_t)i * ldw];
    const int drow = drow0 + n, pn = drow >> 8, half = (drow >> 7) & 1, r = drow & 127, x = r & 31;
    const int rslot = (r & ~31) + 16 * ((x >> 2) & 1) + 4 * (x >> 3) + (x & 3);
    const size_t tb0 = ((size_t)(pn * (K / 64) + (k0 >> 6)) * 2 + half) * 16384;
#pragma unroll
    for (int c = 0; c < 4; ++c) { u32x4 o; o.x = pk2(t[8 * c], t[8 * c + 1]); o.y = pk2(t[8 * c + 2], t[8 * c + 3]); o.z = pk2(t[8 * c + 4], t[8 * c + 5]); o.w = pk2(t[8 * c + 6], t[8 * c + 7]);
        *(u32x4*)((char*)WTe + tb0 + pg8::lds_byte(rslot, 32 * kh + 8 * c)) = o; }
}
DI void transpose_item_tiled_fp8_nolds(const float* W, int ldw, int K, unsigned char* WTe, int k0, int n0, int drow0, int lane) {
    const int n = lane & 31, kh = lane >> 5;
    const float* src = W + (size_t)(k0 + 32 * kh) * ldw + n0 + n;
    float t[32];
#pragma unroll
    for (int i = 0; i < 32; ++i) t[i] = src[(size_t)i * ldw] * 64.f;
    const int drow = drow0 + n, pn = drow >> 8, half = (drow >> 7) & 1, r = drow & 127, x = r & 31;
    const int rslot = (r & ~31) + 16 * ((x >> 2) & 1) + 4 * (x >> 3) + (x & 3);
    const size_t tb0 = ((size_t)(pn * (K / 128) + (k0 >> 7)) * 2 + half) * 16384;
#pragma unroll
    for (int c = 0; c < 2; ++c) { u32x4 o; o.x = pk4_fp8(t[16 * c], t[16 * c + 1], t[16 * c + 2], t[16 * c + 3]); o.y = pk4_fp8(t[16 * c + 4], t[16 * c + 5], t[16 * c + 6], t[16 * c + 7]);
        o.z = pk4_fp8(t[16 * c + 8], t[16 * c + 9], t[16 * c + 10], t[16 * c + 11]); o.w = pk4_fp8(t[16 * c + 12], t[16 * c + 13], t[16 * c + 14], t[16 * c + 15]);
        const int bc = (k0 & 64) + 32 * kh + 16 * c;
        *(u32x4*)(WTe + tb0 + pg8::lds_byte(rslot, bc >> 1)) = o; }
}
DI void transpose_item_tiled_fp8(const float* W, int ldw, int K, unsigned char* WTe, int k0, int n0, int drow0, LAS float* scr, int lane) {
    f32x4 t[8];
    const float* src = W + (size_t)(k0 + (lane >> 3)) * ldw + n0 + 4 * (lane & 7);
#pragma unroll
    for (int i = 0; i < 8; ++i) t[i] = *(const f32x4*)(src + (size_t)(8 * i) * ldw);
#pragma unroll
    for (int i = 0; i < 8; ++i) { LAS float* d = scr + (8 * i + (lane >> 3)) * 33 + 4 * (lane & 7); d[0] = t[i].x * 64.f; d[1] = t[i].y * 64.f; d[2] = t[i].z * 64.f; d[3] = t[i].w * 64.f; }
    asm volatile("s_waitcnt lgkmcnt(0)" ::: "memory");
    const int c = lane & 3;
#pragma unroll
    for (int j = 0; j < 2; ++j) { const int n = (lane >> 2) + 16 * j; const LAS float* sp = scr + (16 * c) * 33 + n;
        u32x4 o; o.x = pk4_fp8(sp[0 * 33], sp[1 * 33], sp[2 * 33], sp[3 * 33]); o.y = pk4_fp8(sp[4 * 33], sp[5 * 33], sp[6 * 33], sp[7 * 33]);
        o.z = pk4_fp8(sp[8 * 33], sp[9 * 33], sp[10 * 33], sp[11 * 33]); o.w = pk4_fp8(sp[12 * 33], sp[13 * 33], sp[14 * 33], sp[15 * 33]);
        const int drow = drow0 + n, pn = drow >> 8, half = (drow >> 7) & 1, r = drow & 127, x = r & 31;
        const int rslot = (r & ~31) + 16 * ((x >> 2) & 1) + 4 * (x >> 3) + (x & 3);
        const int bc = (k0 & 64) + 16 * c;
        const size_t tb = ((size_t)(pn * (K / 128) + (k0 >> 7)) * 2 + half) * 16384 + pg8::lds_byte(rslot, bc >> 1);
        *(u32x4*)(WTe + tb) = o; }
    asm volatile("s_waitcnt lgkmcnt(0)" ::: "memory");
}
DI void rms_row_to_bf16(const float* xrow, const float* g, bf16* orow, int lane) {
    const f32x4* xr = (const f32x4*)xrow + lane; const f32x4* gr = (const f32x4*)g + lane;
    f32x4 v[4]; float s = 0.f;
#pragma unroll
    for (int j = 0; j < 4; ++j) { v[j] = xr[64 * j]; s += (v[j].x * v[j].x + v[j].y * v[j].y) + (v[j].z * v[j].z + v[j].w * v[j].w); }
    const float rstd = rsq_f(wave_sum(s) * (1.f / D) + EPS);
    u32x2* o8 = (u32x2*)orow + lane;
#pragma unroll
    for (int j = 0; j < 4; ++j) { const f32x4 gg = gr[64 * j]; u32x2 w; w.x = pk2(v[j].x * rstd * gg.x, v[j].y * rstd * gg.y); w.y = pk2(v[j].z * rstd * gg.z, v[j].w * rstd * gg.w); o8[64 * j] = w; }
}

DI void rms_rowbf_to_bf16(const bf16* xrow, const float* g, bf16* orow, int lane) {
    float v[16]; float s = 0.f;
#pragma unroll
    for (int hf = 0; hf < 2; ++hf) { const u32x4 w = *(const u32x4*)(xrow + 512 * hf + 8 * lane);
#pragma unroll
        for (int q = 0; q < 4; ++q) { v[8 * hf + 2 * q] = bflo(w[q]); v[8 * hf + 2 * q + 1] = bfhi(w[q]); } }
#pragma unroll
    for (int j = 0; j < 16; ++j) s += v[j] * v[j];
    const float rstd = rsq_f(wave_sum(s) * (1.f / D) + EPS);
#pragma unroll
    for (int hf = 0; hf < 2; ++hf) { const f32x4 g0 = *(const f32x4*)(g + 512 * hf + 8 * lane), g1 = *(const f32x4*)(g + 512 * hf + 8 * lane + 4);
        u32x4 w; w.x = pk2(v[8 * hf] * rstd * g0.x, v[8 * hf + 1] * rstd * g0.y); w.y = pk2(v[8 * hf + 2] * rstd * g0.z, v[8 * hf + 3] * rstd * g0.w);
        w.z = pk2(v[8 * hf + 4] * rstd * g1.x, v[8 * hf + 5] * rstd * g1.y); w.w = pk2(v[8 * hf + 6] * rstd * g1.z, v[8 * hf + 7] * rstd * g1.w);
        *(u32x4*)(orow + 512 * hf + 8 * lane) = w; }
}

__global__ void __launch_bounds__(NTHREADS, 2) fwd(Args args) {
    extern __shared__ __attribute__((aligned(16))) unsigned char lds_raw[];
    LAS unsigned char* lds = (LAS unsigned char*)lds_raw;
    volatile LAS unsigned* MISC = (volatile LAS unsigned*)(lds + MISC_OFF);
    const int G = gridDim.x, bid = blockIdx.x, NGW = G * NWAVES;
    const int wv0 = __builtin_amdgcn_readfirstlane((int)(threadIdx.x >> 6));
#define PHASE_IDS const int tid = fresh_tid(), lane = tid & 63, wave = __builtin_amdgcn_readfirstlane(tid >> 6), gw = bid * NWAVES + wave; (void)tid; (void)lane; (void)wave; (void)gw
    unsigned char* ws = args.ws;
    unsigned* ctl = (unsigned*)(ws + WS_CTL);
    const int lo = args.ph_lo, hi = args.ph_hi;

    for (int u = fresh_tid(); u < (LDS_BYTES - RING_BYTES) / 4; u += NTHREADS) ((LAS unsigned*)(lds + RING_BYTES))[u] = 0u;
    __syncthreads();
    XcdBarrier bar; bar.bar = ctl + CW_BAR; bar.x = 0; bar.st = nullptr; bar.w0 = wv0;
    if (hi - lo > 1) bar = xcd_barrier_post(ctl + CW_BAR, MISC + 8, wv0);
#define IN(k) (lo <= (k) && (k) < hi)
#define SEAM(k) do { if (IN(k) && IN((k) + 1)) xcd_barrier(bar); } while (0)

#define Win_t ((bf16*)(ws + WS_WIN))
#define Wout_t ((bf16*)(ws + WS_WOUT))
#define Wq_t ((bf16*)(ws + WS_WQ))
#define Wk_t ((bf16*)(ws + WS_WK))
#define Wv_t ((bf16*)(ws + WS_WV))
#define Wo_t ((bf16*)(ws + WS_WO))
#define LoraB ((bf16*)(ws + WS_LORAB))
#define LruW ((bf16*)(ws + WS_LRUW))
#define WrT ((bf16*)(ws + WS_LRUW + 512 * 1024))
#define Wgu_t ((bf16*)(ws + WS_WGU))
#define Wdn_t ((bf16*)(ws + WS_WDN))
#define HN ((bf16*)(ws + WS_HN))
#define MEMN ((bf16*)(ws + WS_MEMN))
#define KM ((bf16*)(ws + WS_KM))
#define VT ((bf16*)(ws + WS_VT))
#define X1 ((bf16*)(ws + WS_X1))
#define X2 ((bf16*)(ws + WS_X2))
#define U ((bf16*)(ws + WS_U))
#define Rr ((float*)(ws + WS_R))
#define KRAW ((float*)(ws + WS_KRAW))
#define Vv ((float*)(ws + WS_V))
#define KKN ((float*)(ws + WS_KKN))
#define WD ((float*)(ws + WS_WD))
#define AA ((float*)(ws + WS_AA))
#define GG ((float*)(ws + WS_G))
#define LA ((bf16*)(ws + WS_LA))
#define LB ((bf16*)(ws + WS_LB))
#define AP ((bf16*)(ws + WS_AP))
#define CAT ((bf16*)(ws + WS_CAT))
#define Qb ((bf16*)(ws + WS_Q))
#define Ob CAT
#define X1F8 ((unsigned char*)(ws + WS_XS))
#define XS ((bf16*)(ws + WS_XS))
#define ACT ((bf16*)(ws + WS_ACT))
#define YS ((bf16*)(ws + WS_YS))
#define route_e ((int*)(ws + WS_ROUTE + RT_E))
#define route_pos ((int*)(ws + WS_ROUTE + RT_POS))
#define route_g ((float*)(ws + WS_ROUTE + RT_G))
#define row_sg ((u32x2*)(ws + WS_ROUTE + RT_SLOT))
#define tile_tab ((int*)(ws + WS_ROUTE + RT_TILE))
#define row_tok ((int*)(ws + WS_ROUTE + RT_TOK))
#define ecnt (ctl + CW_CNT)

    if (IN(0)) { PHASE_IDS;
        LAS float* scr = (LAS float*)(lds + wave * 16384);
        constexpr int I_IN = 16 * (INW / 32), I_SQ = 16 * 32;
        constexpr int N_ITEMS = I_IN + 5 * I_SQ;
        for (int it = gw; it < N_ITEMS; it += NGW) {
            int r = it;
            if (r < I_IN) { const int nblk = INW / 32, kb = r / nblk, nb = r % nblk; transpose_item(args.in[I_WIN], INW, D, Win_t, 64 * kb, 32 * nb, 32 * nb, scr, lane); continue; } r -= I_IN;
            { const int w = r / I_SQ, q = r % I_SQ, kb = q / 32, nb = q % 32;
                if (w == 1) continue;
                const float* src = w == 0 ? args.in[I_WOUT] : w == 2 ? args.in[I_WK] : w == 3 ? args.in[I_WV] : args.in[I_WO];
                bf16* dst = w == 0 ? Wout_t : w == 2 ? Wk_t : w == 3 ? Wv_t : Wo_t;
                transpose_item(src, D, D, dst, 64 * kb, 32 * nb, 32 * nb, scr, lane); }
        }
        for (int idx = bid * NTHREADS + tid; idx < D * D / 4; idx += G * NTHREADS) { const f32x4 v = ((const f32x4*)args.in[I_WQ])[idx]; const float gk = args.in[I_NXAG][idx >> 8];
            u32x2 w; w.x = pk2(v.x * gk, v.y * gk); w.y = pk2(v.z * gk, v.w * gk); ((u32x2*)Wq_t)[idx] = w; }
        for (int idx = bid * NTHREADS + tid; idx < 1536 * 256; idx += G * NTHREADS) {
            const int e = idx & 7, ln = (idx >> 3) & 63, ks = (idx >> 9) & 7, ct = (idx >> 12) & 3, hk = idx >> 14, hh = hk / 3, kind = hk - 3 * hh;
            const int k = 32 * ks + 8 * (ln >> 4) + e, n = hh * 64 + 16 * ct + (ln & 15); float v = 0.f;
            if (kind == 0) { if (k < 64) v = args.in[I_WUP][k * 512 + n]; }
            else if (kind == 1) { if (k >= 64 && k < 128) v = args.in[I_AUP][(k - 64) * 512 + n]; }
            else { if (k >= 128) v = args.in[I_GUP][(k - 128) * 512 + n]; }
            LoraB[idx] = (bf16)f2bf(v);
        }
        for (int idx = bid * NTHREADS + tid; idx < 8 * 128 * 64; idx += G * NTHREADS) {
            const int nb = idx >> 13, col = (idx >> 6) & 127, k = idx & 63;
            const float v = col < 64 ? args.in[I_LWX][nb * 4096 + k * 64 + col] : args.in[I_LWA][nb * 4096 + k * 64 + (col - 64)];
            LruW[idx] = (bf16)f2bf(v);
        }
        for (int idx = bid * NTHREADS + tid; idx < NE * D; idx += G * NTHREADS) {
            const int e = idx >> 10, k = idx & 1023; const float v = args.in[I_WR][k * NE + e];
            const unsigned hi = f2bf(v); const float lo = v - __uint_as_float(hi << 16);
            WrT[idx] = (bf16)hi; WrT[NE * D + idx] = (bf16)f2bf(lo);
        }
        for (int m = gw; m < M; m += NGW) rms_row_to_bf16(args.in[I_X] + (size_t)m * D, args.in[I_NMIXG], HN + (size_t)m * D, lane);
        for (int m = gw; m < MROWS; m += NGW) rms_row_to_bf16(args.in[I_MEM] + (size_t)m * D, args.in[I_NMEMG], MEMN + (size_t)m * D, lane);
        {
            LAS float* scr = (LAS float*)(lds + wave * 16384);
            constexpr int I_GU = 16 * 64, I_DN = 16 * 32;
            for (int it = CONV_P9 + gw; it < NE * I_GU; it += NGW) {
                int r = it;
                if (r < NE * I_GU) { const int e = r / I_GU, q = r % I_GU, kb = q / 64, nb = q % 64; const int n0 = 32 * nb;
                    const int drow = n0 < 1024 ? (256 * (n0 >> 7) + (n0 & 127)) : (256 * ((n0 - 1024) >> 7) + 128 + ((n0 - 1024) & 127));
                    transpose_item_tiled_fp8(args.in[I_WGU] + (size_t)e * D * 2048, 2048, D, (unsigned char*)Wgu_t + (size_t)e * 2048 * D, 64 * kb, n0, drow, scr, lane); continue; } r -= NE * I_GU;
                { const int e = r / I_DN, q = r % I_DN, kb = q / 32, nb = q % 32;
                  transpose_item_tiled(args.in[I_WDN] + (size_t)e * DFF * D, D, DFF, Wdn_t + (size_t)e * D * DFF, 64 * kb, 32 * nb, 32 * nb, scr, lane); }
            }
        }
    }
    SEAM(0);

    if (IN(1)) { PHASE_IDS;
        { pg8::DenseSched S; S.o.init_tiles(M / 256, INW / 256, G, bid); S.A = (const char*)HN; S.B = (const char*)Win_t; S.tstep = (size_t)256 * D * 2;
          EpiBf16Plain E{U, INW, 1.0f}; pg8::gemm_phase(lds, D, S, E, wv0); }
        { pg8::DenseSched S; S.o.init_tiles(MROWS / 256, D / 256, G, (bid + 64) & (G - 1)); S.A = (const char*)MEMN; S.B = (const char*)Wk_t; S.tstep = (size_t)256 * D * 2;
          EpiBf16Plain E{KM, D, 1.0f}; pg8::gemm_phase(lds, D, S, E, wv0); }
        { pg8::DenseSched S; S.o.init_tiles(MROWS / 256, D / 256, G, (bid + 48) & (G - 1)); S.A = (const char*)MEMN; S.B = (const char*)Wv_t; S.tstep = (size_t)256 * D * 2;
          EpiBf16Plain E{VT, D, 1.0f}; pg8::gemm_phase(lds, D, S, E, wv0); }
    }
    SEAM(1);

    if (IN(2)) { PHASE_IDS;
        const float* conv_w = args.in[I_CONVW]; const float* conv_b = args.in[I_CONVB];
        LAS float* xs = (LAS float*)(lds + wave * 16384);
        LAS bf16* tP = (LAS bf16*)(lds + wave * 16384 + 4096); LAS bf16* tH = tP + 1024;
        const int i = lane & 15, kg = lane >> 4;
        for (int unit = gw; unit < (M / 64) * 8; unit += NGW) {
            const int seg = unit >> 3, nb = unit & 7, m0s = seg * 64, s0s = m0s & (SEQ - 1);
            bf16x8 wf[8][2];
#pragma unroll
            for (int ct = 0; ct < 8; ++ct)
#pragma unroll
                for (int ks = 0; ks < 2; ++ks) wf[ct][ks] = *(const bf16x8*)(LruW + ((size_t)(nb * 128 + 16 * ct + i) * 64 + 32 * ks + 8 * kg));
            float bxv[4], bav[4], spv[4], Arun[4], Brun[4];
#pragma unroll
            for (int ct = 0; ct < 4; ++ct) { const int ch = nb * 64 + 16 * ct + i; bxv[ct] = args.in[I_LBX][ch]; bav[ct] = args.in[I_LBA][ch]; spv[ct] = softplus_f(-args.in[I_LAM][ch]); Arun[ct] = 1.f; Brun[ct] = 0.f; }
#pragma unroll 1
            for (int jt = 0; jt < 4; ++jt) {
                const int m0 = m0s + 16 * jt, s0 = s0s + 16 * jt;
                bf16x8 af[2];
#pragma unroll
                for (int ks = 0; ks < 2; ++ks) {
                    const int chb = nb * 64 + 32 * ks + 8 * kg;
                    f32x4 x0 = *(const f32x4*)(conv_b + chb), x1 = *(const f32x4*)(conv_b + chb + 4);
#pragma unroll
                    for (int j = 0; j < 4; ++j) {
                        const bool ok = s0 + i - 3 + j >= 0;
                        u32x4 uw = *(const u32x4*)(U + (size_t)(ok ? m0 + i - 3 + j : m0) * INW + chb); if (!ok) uw = (u32x4){0u, 0u, 0u, 0u};
                        const f32x4 w0 = *(const f32x4*)(conv_w + j * 512 + chb), w1 = *(const f32x4*)(conv_w + j * 512 + chb + 4);
                        x0.x += w0.x * bflo(uw.x); x0.y += w0.y * bfhi(uw.x); x0.z += w0.z * bflo(uw.y); x0.w += w0.w * bfhi(uw.y);
                        x1.x += w1.x * bflo(uw.z); x1.y += w1.y * bfhi(uw.z); x1.z += w1.z * bflo(uw.w); x1.w += w1.w * bfhi(uw.w);
                    }
                    *(LAS f32x4*)(xs + i * 64 + 32 * ks + 8 * kg) = x0; *(LAS f32x4*)(xs + i * 64 + 32 * ks + 8 * kg + 4) = x1;
                    u32x4 p; p.x = pk2(x0.x, x0.y); p.y = pk2(x0.z, x0.w); p.z = pk2(x1.x, x1.y); p.w = pk2(x1.z, x1.w);
                    af[ks] = __builtin_bit_cast(bf16x8, p);
                }
                f32x4 acc[8];
#pragma unroll
                for (int ct = 0; ct < 8; ++ct) { acc[ct] = (f32x4){0.f, 0.f, 0.f, 0.f};
#pragma unroll
                    for (int ks = 0; ks < 2; ++ks) acc[ct] = __builtin_amdgcn_mfma_f32_16x16x32_bf16(af[ks], wf[ct][ks], acc[ct], 0, 0, 0); }
#pragma unroll
                for (int ct = 0; ct < 4; ++ct) {
                    const int col = 16 * ct + i;
                    float hl[4], pl[4]; float hprev = 0.f, pprev = 1.f;
#pragma unroll
                    for (int e = 0; e < 4; ++e) {
                        const float gx = sigmoid_f(acc[ct][e] + bxv[ct]), ga = sigmoid_f(acc[ct + 4][e] + bav[ct]);
                        const float la = -8.0f * ga * spv[ct], av = __expf(la), xcv = xs[(4 * kg + e) * 64 + col];
                        const float bt = __builtin_amdgcn_sqrtf(fmaxf(1.0f - av * av, 0.f)) * gx * xcv;
                        hprev = av * hprev + bt; pprev *= av; hl[e] = hprev; pl[e] = pprev;
                    }
                    float Ag[4], Bg[4];
#pragma unroll
                    for (int gq = 0; gq < 4; ++gq) { Ag[gq] = __shfl(pl[3], i + 16 * gq); Bg[gq] = __shfl(hl[3], i + 16 * gq); }
                    float Ain = Arun[ct], Bin = Brun[ct];
#pragma unroll
                    for (int gq = 0; gq < 3; ++gq) if (gq < kg) { Bin = Ag[gq] * Bin + Bg[gq]; Ain *= Ag[gq]; }
                    float At = 1.f, Bt = 0.f;
#pragma unroll
                    for (int gq = 0; gq < 4; ++gq) { Bt = Ag[gq] * Bt + Bg[gq]; At *= Ag[gq]; }
                    Brun[ct] = At * Brun[ct] + Bt; Arun[ct] *= At;
#pragma unroll
                    for (int e = 0; e < 4; ++e) { const int ti_ = (4 * kg + e) * 64 + col; tP[ti_] = (bf16)f2bf(pl[e] * Ain); tH[ti_] = (bf16)f2bf(hl[e] + pl[e] * Bin); }
                }
                { const int rr = lane >> 2, cq = lane & 3;
                  bf16* pp = LA + (size_t)(m0 + rr) * 512 + nb * 64 + 16 * cq; bf16* hp = LB + (size_t)(m0 + rr) * 512 + nb * 64 + 16 * cq;
                  *(u32x4*)pp = *(const LAS u32x4*)(tP + rr * 64 + 16 * cq); *(u32x4*)(pp + 8) = *(const LAS u32x4*)(tP + rr * 64 + 16 * cq + 8);
                  *(u32x4*)hp = *(const LAS u32x4*)(tH + rr * 64 + 16 * cq); *(u32x4*)(hp + 8) = *(const LAS u32x4*)(tH + rr * 64 + 16 * cq + 8); }
            }
            if (kg == 0) {
#pragma unroll
                for (int ct = 0; ct < 4; ++ct) { f32x2 ab; ab.x = Arun[ct]; ab.y = Brun[ct];
                    *(f32x2*)((float*)(ws + WS_AP) + ((size_t)(((seg >> 6) * 8 + nb) * 64 + (seg & 63)) * 64 + 16 * ct + i) * 2) = ab; }
            }
        }
    }
    SEAM(2);


#define RW_ZB(zz, zb) do { _Pragma("unroll") for (int ks_ = 0; ks_ < 2; ++ks_) { u32x4 p_; p_.x = pk2(zz[2 * ks_][0], zz[2 * ks_][1]); p_.y = pk2(zz[2 * ks_][2], zz[2 * ks_][3]); \
        p_.z = pk2(zz[2 * ks_ + 1][0], zz[2 * ks_ + 1][1]); p_.w = pk2(zz[2 * ks_ + 1][2], zz[2 * ks_ + 1][3]); zb[ks_] = __builtin_bit_cast(bf16x8, p_); } } while (0)
    if (IN(3)) { PHASE_IDS;
        for (int u64 = gw; u64 < NB * NH * (SEQ / 64); u64 += NGW) {
#pragma unroll 1
        for (int jj = 0; jj < 4; ++jj) {
        LAS unsigned char* wl = lds + wave * 16384;
        LAS bf16* Arm = (LAS bf16*)(wl); LAS bf16* Brm = (LAS bf16*)(wl + 2048); LAS bf16* Krm = (LAS bf16*)(wl + 4096); LAS bf16* Rrm = (LAS bf16*)(wl + 6144);
        LAS bf16* ATt = (LAS bf16*)(wl + 8192); LAS bf16* BTt = (LAS bf16*)(wl + 10240); LAS bf16* KTt = (LAS bf16*)(wl + 12288); LAS bf16* VTt = (LAS bf16*)(wl + 14336);
        LAS float* MabT = (LAS float*)(wl); LAS bf16* Mak = (LAS bf16*)(wl + 1024); LAS bf16* Mrb = (LAS bf16*)(wl + 1536); LAS bf16* Mrk = (LAS bf16*)(wl + 2048); LAS bf16* Tm = (LAS bf16*)(wl + 2560);
        LAS float* PLs = (LAS float*)(wl + 3072); LAS bf16* Q0T = (LAS bf16*)(wl + 4096);
        const int lane = fresh_tid() & 63, l15 = lane & 15, g = lane >> 4, te = lane >> 2, kq = lane & 3;
        const bf16x8 z8 = (bf16x8){0, 0, 0, 0, 0, 0, 0, 0};
        const f32x4 z4 = (f32x4){0.f, 0.f, 0.f, 0.f};
            const int un = u64 * 4 + jj;
            const int bh = un >> 8, c = un & 255, b = bh >> 3, h = bh & 7;
            const size_t mrow = (size_t)b * SEQ + c * 16 + te, off = mrow * 512 + h * 64 + 16 * kq;
            const int hc = h * 64 + 16 * kq;
            LAS float* tmpL = (LAS float*)wl;
            {
                const int rsub = lane >> 5, chunk = lane & 31; const size_t mt0 = (size_t)b * SEQ + c * 16;
                const f32x4 m0 = *(const f32x4*)(args.in[I_MU] + 1536 + 8 * chunk), m1 = *(const f32x4*)(args.in[I_MU] + 1536 + 8 * chunk + 4);
                u32x4 cu[8], pu[8];
#pragma unroll
                for (int i = 0; i < 8; ++i) { const size_t mr = mt0 + 2 * i + rsub; const bool hp2 = (mr & (SEQ - 1)) != 0; const bf16* ua = U + mr * INW + 2560 + 8 * chunk;
                    cu[i] = *(const u32x4*)ua; pu[i] = *(const u32x4*)(ua - (hp2 ? INW : 0)); if (!hp2) pu[i] = (u32x4){0u, 0u, 0u, 0u}; }
#pragma unroll
                for (int i = 0; i < 8; ++i) { float o8[8];
#pragma unroll
                    for (int q = 0; q < 4; ++q) { const float c0 = bflo(cu[i][q]), c1 = bfhi(cu[i][q]), p0 = bflo(pu[i][q]), p1 = bfhi(pu[i][q]); const float mm0 = q < 2 ? m0[2 * q] : m1[2 * q - 4], mm1 = q < 2 ? m0[2 * q + 1] : m1[2 * q - 3];
                        float x0 = c0 + (p0 - c0) * mm0, x1 = c1 + (p1 - c1) * mm1;
                        if (chunk < 8) { x0 = tanh_fast(x0); x1 = tanh_fast(x1); }
                        else if (chunk >= 16) { x0 = sigmoid_f(x0); x1 = sigmoid_f(x1); }
                        o8[2 * q] = x0; o8[2 * q + 1] = x1; }
                    u32x4 pw; pw.x = pk2(o8[0], o8[1]); pw.y = pk2(o8[2], o8[3]); pw.z = pk2(o8[4], o8[5]); pw.w = pk2(o8[6], o8[7]);
                    const int row = 2 * i + rsub; *(LAS u32x4*)(wl + row * 512 + ((chunk ^ (row & 7)) << 4)) = pw; }
                bf16x8 af[8];
#pragma unroll
                for (int ks = 0; ks < 8; ++ks) af[ks] = *(const LAS bf16x8*)(wl + l15 * 512 + (((4 * ks + g) ^ (l15 & 7)) << 4));
                asm volatile("s_waitcnt lgkmcnt(0)" ::: "memory");
#pragma unroll
                for (int kind = 0; kind < 3; ++kind)
#pragma unroll
                    for (int ct = 0; ct < 4; ++ct) {
                        const bf16* lb = LoraB + ((size_t)((h * 3 + kind) * 4 + ct) * 8 * 64 + lane) * 8;
                        f32x4 a4 = z4;
#pragma unroll
                        for (int ks = (kind == 0 ? 0 : kind == 1 ? 2 : 4); ks < (kind == 0 ? 2 : kind == 1 ? 4 : 8); ++ks) a4 = __builtin_amdgcn_mfma_f32_16x16x32_bf16(af[ks], *(const bf16x8*)(lb + ks * 512), a4, 0, 0, 0);
#pragma unroll
                        for (int e = 0; e < 4; ++e) tmpL[kind * 1088 + (4 * g + e) * 68 + 16 * ct + l15] = a4[e];
                    }
            }
            asm volatile("s_waitcnt lgkmcnt(0)" ::: "memory");
            float cl[16], eP[16];
            {
                float lwv[16], rl[16], kl[16], vl[16], kn[16], av[16];
                const bool hp = (mrow & (SEQ - 1)) != 0;
                const bf16* ub = U + mrow * INW + 1024 + hc;
#pragma unroll
                for (int hh = 0; hh < 2; ++hh) {
#pragma unroll
                    for (int a3 = 0; a3 < 3; ++a3) {
                        const u32x4 cu = *(const u32x4*)(ub + 512 * a3 + 8 * hh); u32x4 pu = *(const u32x4*)(ub - (hp ? INW : 0) + 512 * a3 + 8 * hh); if (!hp) pu = (u32x4){0u, 0u, 0u, 0u};
                        const f32x4 m0 = *(const f32x4*)(args.in[I_MU] + 512 * a3 + hc + 8 * hh), m1 = *(const f32x4*)(args.in[I_MU] + 512 * a3 + hc + 8 * hh + 4);
                        float o8[8];
#pragma unroll
                        for (int q = 0; q < 4; ++q) { const float c0 = bflo(cu[q]), c1 = bfhi(cu[q]), p0 = bflo(pu[q]), p1 = bfhi(pu[q]); const float mm0 = q < 2 ? m0[2 * q] : m1[2 * q - 4], mm1 = q < 2 ? m0[2 * q + 1] : m1[2 * q - 3];
                            o8[2 * q] = c0 + (p0 - c0) * mm0; o8[2 * q + 1] = c1 + (p1 - c1) * mm1; }
#pragma unroll
                        for (int q = 0; q < 8; ++q) { if (a3 == 0) rl[8 * hh + q] = o8[q]; else if (a3 == 1) kl[8 * hh + q] = o8[q]; else vl[8 * hh + q] = o8[q]; }
                    }
                }
                float gv[16];
#pragma unroll
                for (int j4 = 0; j4 < 4; ++j4) { const f32x4 xl = *(const LAS f32x4*)(tmpL + te * 68 + 16 * kq + 4 * j4), xa = *(const LAS f32x4*)(tmpL + 1088 + te * 68 + 16 * kq + 4 * j4), xg = *(const LAS f32x4*)(tmpL + 2176 + te * 68 + 16 * kq + 4 * j4);
                    const f32x4 w0v = *(const f32x4*)(args.in[I_W0] + hc + 4 * j4), a0v = *(const f32x4*)(args.in[I_A0] + hc + 4 * j4);
#pragma unroll
                    for (int q = 0; q < 4; ++q) { const float wq = -softplus_fast(-(xl[q] + w0v[q])) - 0.5f; lwv[4 * j4 + q] = -__expf(wq); av[4 * j4 + q] = sigmoid_f(xa[q] + a0v[q]); gv[4 * j4 + q] = xg[q]; } }
                asm volatile("s_waitcnt lgkmcnt(0)" ::: "memory");
                float ss = 0.f;
#pragma unroll
                for (int j4 = 0; j4 < 4; ++j4) { const f32x4 kk4 = *(const f32x4*)(args.in[I_KK] + hc + 4 * j4);
#pragma unroll
                    for (int q = 0; q < 4; ++q) { kn[4 * j4 + q] = kl[4 * j4 + q] * kk4[q]; ss += kn[4 * j4 + q] * kn[4 * j4 + q]; } }
                ss += __shfl_xor(ss, 1); ss += __shfl_xor(ss, 2);
                const float kinv = rsq_f(fmaxf(ss, 1e-24f));
#pragma unroll
                for (int j = 0; j < 16; ++j) { float x = lwv[j];
#pragma unroll
                    for (int sft = 4; sft < 64; sft <<= 1) { const float y = __shfl_up(x, sft); if (lane >= sft) x += y; }
                    cl[j] = x; }
                float bon = 0.f;
                u32x4 pa[2], pb[2], pk[2], pr[2];
#pragma unroll
                for (int j4 = 0; j4 < 4; ++j4) {
                    const f32x4 ka = *(const f32x4*)(args.in[I_KA] + hc + 4 * j4), rk = *(const f32x4*)(args.in[I_RK] + hc + 4 * j4);
                    float at4[4], bt4[4], kt4[4], rt4[4];
#pragma unroll
                    for (int q = 0; q < 4; ++q) { const int j = 4 * j4 + q;
                        const float p = __expf(cl[j]), pn = __expf(-cl[j]), pm1 = __expf(cl[j] - lwv[j]); eP[j] = p;
                        const float knj = kn[j] * kinv;
                        const float kp = kl[j] * (1.0f + (av[j] - 1.0f) * ka[q]);
                        at4[q] = -knj * pm1; bt4[q] = knj * av[j] * pn; kt4[q] = kp * pn; rt4[q] = rl[j] * p;
                        bon += rl[j] * kp * rk[q];
                        const int kk = 16 * kq + j;
                        ATt[kk * 16 + te] = (bf16)f2bf(at4[q]); BTt[kk * 16 + te] = (bf16)f2bf(bt4[q]); KTt[kk * 16 + te] = (bf16)f2bf(kt4[q]); VTt[kk * 16 + te] = (bf16)f2bf(vl[j]); }
                    const int hh = j4 >> 1, w2 = (j4 & 1) * 2;
                    pa[hh][w2] = pk2(at4[0], at4[1]); pa[hh][w2 + 1] = pk2(at4[2], at4[3]); pb[hh][w2] = pk2(bt4[0], bt4[1]); pb[hh][w2 + 1] = pk2(bt4[2], bt4[3]);
                    pk[hh][w2] = pk2(kt4[0], kt4[1]); pk[hh][w2 + 1] = pk2(kt4[2], kt4[3]); pr[hh][w2] = pk2(rt4[0], rt4[1]); pr[hh][w2 + 1] = pk2(rt4[2], rt4[3]);
                }
#pragma unroll
                for (int hh = 0; hh < 2; ++hh) { const int po = te * 64 + 8 * ((2 * kq + hh) ^ (te & 7));
                    *(LAS u32x4*)(Arm + po) = pa[hh]; *(LAS u32x4*)(Brm + po) = pb[hh]; *(LAS u32x4*)(Krm + po) = pk[hh]; *(LAS u32x4*)(Rrm + po) = pr[hh]; }
                bon += __shfl_xor(bon, 1); bon += __shfl_xor(bon, 2);
                f32x4 lbv[4], lgv[4];
#pragma unroll
                for (int j4 = 0; j4 < 4; ++j4) { lbv[j4] = *(const f32x4*)(args.in[I_LNB] + hc + 4 * j4); lgv[j4] = *(const f32x4*)(args.in[I_LNG] + hc + 4 * j4); }
#pragma unroll
                for (int j4 = 0; j4 < 4; ++j4) { const f32x4 lb = lbv[j4], lgn = lgv[j4]; const int j0 = 4 * j4;
                    u32x2 ow, gw2; ow.x = pk2((lb.x + vl[j0] * bon) * gv[j0], (lb.y + vl[j0 + 1] * bon) * gv[j0 + 1]); ow.y = pk2((lb.z + vl[j0 + 2] * bon) * gv[j0 + 2], (lb.w + vl[j0 + 3] * bon) * gv[j0 + 3]);
                    gw2.x = pk2(lgn.x * gv[j0], lgn.y * gv[j0 + 1]); gw2.y = pk2(lgn.z * gv[j0 + 2], lgn.w * gv[j0 + 3]);
                    *(u32x2*)((bf16*)(ws + WS_ADD) + off + j0) = ow; *(u32x2*)((bf16*)(ws + WS_G) + off + j0) = gw2; }
            }
            asm volatile("s_waitcnt lgkmcnt(0)" ::: "memory");
            {
                bf16x8 fa[2], fr[2], fb[2], fk[2];
#pragma unroll
                for (int ks = 0; ks < 2; ++ks) { const int po = l15 * 64 + 8 * ((4 * ks + g) ^ (l15 & 7));
                    fa[ks] = *(const LAS bf16x8*)(Arm + po); fr[ks] = *(const LAS bf16x8*)(Rrm + po); fb[ks] = *(const LAS bf16x8*)(Brm + po); fk[ks] = *(const LAS bf16x8*)(Krm + po); }
                f32x4 mab = z4, mak = z4, mrb = z4, mrk = z4;
#pragma unroll
                for (int ks = 0; ks < 2; ++ks) { mab = __builtin_amdgcn_mfma_f32_16x16x32_bf16(fb[ks], fa[ks], mab, 0, 0, 0); mak = __builtin_amdgcn_mfma_f32_16x16x32_bf16(fk[ks], fa[ks], mak, 0, 0, 0);
                    mrb = __builtin_amdgcn_mfma_f32_16x16x32_bf16(fb[ks], fr[ks], mrb, 0, 0, 0); mrk = __builtin_amdgcn_mfma_f32_16x16x32_bf16(fk[ks], fr[ks], mrk, 0, 0, 0); }
#pragma unroll
                for (int e = 0; e < 4; ++e) { const int i = 4 * g + e; if (!(i < l15)) { mab[e] = 0.f; mak[e] = 0.f; } if (!(i <= l15)) { mrb[e] = 0.f; mrk[e] = 0.f; } }
                asm volatile("s_waitcnt lgkmcnt(0)" ::: "memory");
#pragma unroll
                for (int e = 0; e < 4; ++e) MabT[(4 * g + e) * 16 + l15] = mab[e];
                u32x2 w; w.x = pk2(mak[0], mak[1]); w.y = pk2(mak[2], mak[3]); *(LAS u32x2*)(Mak + l15 * 16 + 4 * g) = w;
                w.x = pk2(mrb[0], mrb[1]); w.y = pk2(mrb[2], mrb[3]); *(LAS u32x2*)(Mrb + l15 * 16 + 4 * g) = w;
                w.x = pk2(mrk[0], mrk[1]); w.y = pk2(mrk[2], mrk[3]); *(LAS u32x2*)(Mrk + l15 * 16 + 4 * g) = w;
                if (te == 15) {
#pragma unroll
                    for (int j = 0; j < 16; ++j) PLs[16 * kq + j] = eP[j]; }
            }
            asm volatile("s_waitcnt lgkmcnt(0)" ::: "memory");
            {
                f32x4 mq[15][4];
#pragma unroll
                for (int j = 0; j < 15; ++j)
#pragma unroll
                    for (int q = 0; q < 4; ++q) if (4 * q + 3 > j) mq[j][q] = *(const LAS f32x4*)(MabT + j * 16 + 4 * q);
                float y[16];
#pragma unroll
                for (int j = 15; j >= 0; --j) {
                    float acc = (j == l15) ? 1.0f : 0.0f;
#pragma unroll
                    for (int i = j + 1; i < 16; ++i) acc += y[i] * mq[j < 15 ? j : 0][i >> 2][i & 3];
                    y[j] = acc;
                }
                if (g == 0) { u32x4 t0, t1; t0.x = pk2(y[0], y[1]); t0.y = pk2(y[2], y[3]); t0.z = pk2(y[4], y[5]); t0.w = pk2(y[6], y[7]); t1.x = pk2(y[8], y[9]); t1.y = pk2(y[10], y[11]); t1.z = pk2(y[12], y[13]); t1.w = pk2(y[14], y[15]);
                    *(LAS u32x4*)(Tm + l15 * 16) = t0; *(LAS u32x4*)(Tm + l15 * 16 + 8) = t1; }
            }
            asm volatile("s_waitcnt lgkmcnt(0)" ::: "memory");
            {
                const bool act = g < 2; const int fo = l15 * 16 + 8 * g;
                const bf16x8 fT = act ? *(const LAS bf16x8*)(Tm + fo) : z8, fMak = act ? *(const LAS bf16x8*)(Mak + fo) : z8, fMrb = act ? *(const LAS bf16x8*)(Mrb + fo) : z8, fMrk = act ? *(const LAS bf16x8*)(Mrk + fo) : z8;
                bf16x8 fV[4], fQ1[4], fAh[4], fBT[4], fKT[4];
#pragma unroll
                for (int vt = 0; vt < 4; ++vt) { fV[vt] = act ? *(const LAS bf16x8*)(VTt + vt * 256 + fo) : z8; fBT[vt] = act ? *(const LAS bf16x8*)(BTt + vt * 256 + fo) : z8; fKT[vt] = act ? *(const LAS bf16x8*)(KTt + vt * 256 + fo) : z8; }
#pragma unroll
                for (int vt = 0; vt < 4; ++vt) { const f32x4 q0 = __builtin_amdgcn_mfma_f32_16x16x32_bf16(fMak, fV[vt], z4, 0, 0, 0);
                    u32x2 w; w.x = pk2(q0[0], q0[1]); w.y = pk2(q0[2], q0[3]); *(LAS u32x2*)(Q0T + vt * 256 + l15 * 16 + 4 * g) = w; }
#pragma unroll
                for (int kt = 0; kt < 4; ++kt) { const bf16x8 fA = act ? *(const LAS bf16x8*)(ATt + kt * 256 + fo) : z8; const f32x4 ah = __builtin_amdgcn_mfma_f32_16x16x32_bf16(fT, fA, z4, 0, 0, 0);
                    u32x2 w; w.x = pk2(ah[0], ah[1]); w.y = pk2(ah[2], ah[3]); *(LAS u32x2*)(ATt + kt * 256 + l15 * 16 + 4 * g) = w; }
                asm volatile("s_waitcnt lgkmcnt(0)" ::: "memory");
#pragma unroll
                for (int vt = 0; vt < 4; ++vt) { const bf16x8 fQ0 = act ? *(const LAS bf16x8*)(Q0T + vt * 256 + fo) : z8; const f32x4 q1 = __builtin_amdgcn_mfma_f32_16x16x32_bf16(fT, fQ0, z4, 0, 0, 0);
                    u32x2 w; w.x = pk2(q1[0], q1[1]); w.y = pk2(q1[2], q1[3]); *(LAS u32x2*)(Q0T + vt * 256 + l15 * 16 + 4 * g) = w; }
                asm volatile("s_waitcnt lgkmcnt(0)" ::: "memory");
#pragma unroll
                for (int vt = 0; vt < 4; ++vt) { fQ1[vt] = act ? *(const LAS bf16x8*)(Q0T + vt * 256 + fo) : z8; fAh[vt] = act ? *(const LAS bf16x8*)(ATt + vt * 256 + fo) : z8; }
                bf16* rp = (bf16*)(ws + WS_RP) + (size_t)un * 1024 + l15 * 64;
#pragma unroll
                for (int kt = 0; kt < 4; ++kt) {
                    const u32x2 rr = *(const LAS u32x2*)(Rrm + l15 * 64 + 8 * ((2 * kt + (g >> 1)) ^ (l15 & 7)) + 4 * (g & 1));
                    f32x4 ini; ini[0] = bflo(rr.x); ini[1] = bfhi(rr.x); ini[2] = bflo(rr.y); ini[3] = bfhi(rr.y);
                    const f32x4 rh = __builtin_amdgcn_mfma_f32_16x16x32_bf16(fAh[kt], fMrb, ini, 0, 0, 0);
                    u32x2 w; w.x = pk2(rh[0], rh[1]); w.y = pk2(rh[2], rh[3]); *(u32x2*)(rp + 32 * (kt >> 1) + 8 * g + 4 * (kt & 1)) = w;
                }
#pragma unroll
                for (int vt = 0; vt < 4; ++vt) { f32x4 y1 = __builtin_amdgcn_mfma_f32_16x16x32_bf16(fMrb, fQ1[vt], z4, 0, 0, 0); y1 = __builtin_amdgcn_mfma_f32_16x16x32_bf16(fMrk, fV[vt], y1, 0, 0, 0);
                    *(f32x4*)((float*)(ws + WS_Y1F) + ((size_t)(un * 4 + vt) * 64 + lane) * 4) = y1; }
                LAS bf16* tgs = (LAS bf16*)(wl + 8192);
#pragma unroll
                for (int krt = 0; krt < 4; ++krt) { const float pl = PLs[16 * krt + l15];
#pragma unroll
                    for (int kct = 0; kct < 4; ++kct) { f32x4 ga = __builtin_amdgcn_mfma_f32_16x16x32_bf16(fAh[kct], fBT[krt], z4, 0, 0, 0);
                        if (kct == krt) {
#pragma unroll
                            for (int e = 0; e < 4; ++e) if (4 * g + e == l15) ga[e] += 1.0f; }
                        u32x2 w; w.x = pk2(ga[0] * pl, ga[1] * pl); w.y = pk2(ga[2] * pl, ga[3] * pl);
                        *(LAS u32x2*)(tgs + (16 * krt + l15) * 64 + 32 * (kct >> 1) + 8 * g + 4 * (kct & 1)) = w; } }
                { u32x4* gp16 = (u32x4*)((bf16*)(ws + WS_GP) + (size_t)un * 4096);
#pragma unroll
                  for (int i = 0; i < 8; ++i) gp16[i * 64 + lane] = *(const LAS u32x4*)(tgs + (i * 64 + lane) * 8); }
#pragma unroll
                for (int mt = 0; mt < 4; ++mt) { const f32x4 pl4 = *(const LAS f32x4*)(PLs + 16 * mt + 4 * g);
#pragma unroll
                    for (int vt = 0; vt < 4; ++vt) { f32x4 ha = __builtin_amdgcn_mfma_f32_16x16x32_bf16(fBT[mt], fQ1[vt], z4, 0, 0, 0); ha = __builtin_amdgcn_mfma_f32_16x16x32_bf16(fKT[mt], fV[vt], ha, 0, 0, 0);
                        u32x2 w; w.x = pk2(ha[0] * pl4[0], ha[1] * pl4[1]); w.y = pk2(ha[2] * pl4[2], ha[3] * pl4[3]);
                        *(u32x2*)((bf16*)(ws + WS_HF) + ((size_t)((un * 4 + vt) * 4 + mt) * 64 + lane) * 4) = w; } }
            }
            asm volatile("s_waitcnt lgkmcnt(0)" ::: "memory");
        }
        asm volatile("s_waitcnt vmcnt(0)" ::: "memory");
        { const int ltid = fresh_tid() & 63, l15 = ltid & 15, g = ltid >> 4, lane = ltid;
#define CP_LOADG(gf_, j_) do { const bf16* gp_ = (const bf16*)(ws + WS_GP) + ((size_t)u64 * 4 + (j_)) * 4096 + l15 * 64 + 8 * g; \
            _Pragma("unroll") for (int mt = 0; mt < 4; ++mt) { gf_[mt][0] = *(const bf16x8*)(gp_ + mt * 1024); gf_[mt][1] = *(const bf16x8*)(gp_ + mt * 1024 + 32); } } while (0)
#define CP_LOADH(hf_, j_) do { _Pragma("unroll") for (int sl = 0; sl < 4; ++sl) _Pragma("unroll") for (int mt = 0; mt < 4; ++mt) \
            hf_[sl][mt] = *(const u32x2*)((const bf16*)(ws + WS_HF) + ((size_t)((((size_t)u64 * 4 + (j_)) * 4 + sl) * 4 + mt) * 64 + lane) * 4); } while (0)
#define CP_STEP(gf_, hf_, useh_) do { _Pragma("unroll") for (int sl = 0; sl < 4; ++sl) { bf16x8 zb[2]; RW_ZB(z[sl], zb); \
            _Pragma("unroll") for (int mt = 0; mt < 4; ++mt) { f32x4 a_ = (f32x4){0.f, 0.f, 0.f, 0.f}; \
                if (useh_) { a_[0] = bflo(hf_[sl][mt].x); a_[1] = bfhi(hf_[sl][mt].x); a_[2] = bflo(hf_[sl][mt].y); a_[3] = bfhi(hf_[sl][mt].y); } \
                a_ = __builtin_amdgcn_mfma_f32_16x16x32_bf16(gf_[mt][0], zb[0], a_, 0, 0, 0); a_ = __builtin_amdgcn_mfma_f32_16x16x32_bf16(gf_[mt][1], zb[1], a_, 0, 0, 0); z[sl][mt] = a_; } } } while (0)
        {
            f32x4 z[4][4];
#pragma unroll
            for (int sl = 0; sl < 4; ++sl)
#pragma unroll
                for (int mt = 0; mt < 4; ++mt)
#pragma unroll
                    for (int e = 0; e < 4; ++e) z[sl][mt][e] = (sl == mt && 4 * g + e == l15) ? 1.0f : 0.0f;
            bf16x8 gA[4][2], gB[4][2]; u32x2 hdum[4][4];
            CP_LOADG(gA, 0); CP_LOADG(gB, 1);
            CP_STEP(gA, hdum, false); CP_LOADG(gA, 2);
            CP_STEP(gB, hdum, false); CP_LOADG(gB, 3);
            CP_STEP(gA, hdum, false);
            CP_STEP(gB, hdum, false);
            LAS bf16* tg = (LAS bf16*)(lds + wave * 16384);
#pragma unroll
            for (int sl = 0; sl < 4; ++sl) { const int pc = 32 * (sl >> 1) + 8 * (l15 >> 2) + 4 * (sl & 1) + (l15 & 3);
#pragma unroll
                for (int mt = 0; mt < 4; ++mt)
#pragma unroll
                    for (int e = 0; e < 4; ++e) tg[(16 * mt + 4 * g + e) * 64 + pc] = (bf16)f2bf(z[sl][mt][e]); }
            u32x4* gc = (u32x4*)((bf16*)(ws + WS_GC) + (size_t)u64 * 4096);
#pragma unroll
            for (int i = 0; i < 8; ++i) gc[i * 64 + lane] = *(const LAS u32x4*)(tg + (i * 64 + lane) * 8);
        }
        {
            f32x4 z[4][4];
#pragma unroll
            for (int sl = 0; sl < 4; ++sl)
#pragma unroll
                for (int mt = 0; mt < 4; ++mt) z[sl][mt] = (f32x4){0.f, 0.f, 0.f, 0.f};
            bf16x8 gA[4][2], gB[4][2]; u32x2 hA[4][4], hB[4][4];
            CP_LOADG(gA, 0); CP_LOADH(hA, 0); CP_LOADG(gB, 1); CP_LOADH(hB, 1);
            CP_STEP(gA, hA, true); CP_LOADG(gA, 2); CP_LOADH(hA, 2);
            CP_STEP(gB, hB, true); CP_LOADG(gB, 3); CP_LOADH(hB, 3);
            CP_STEP(gA, hA, true);
            CP_STEP(gB, hB, true);
#pragma unroll
            for (int sl = 0; sl < 4; ++sl)
#pragma unroll
                for (int mt = 0; mt < 4; ++mt) { u32x2 w; w.x = pk2(z[sl][mt][0], z[sl][mt][1]); w.y = pk2(z[sl][mt][2], z[sl][mt][3]);
                    *(u32x2*)((bf16*)(ws + WS_HC) + ((size_t)((u64 * 4 + sl) * 4 + mt) * 64 + lane) * 4) = w; }
        }
#undef CP_LOADG
#undef CP_LOADH
#undef CP_STEP
        }
        }
    }
    SEAM(3);


    if (IN(4)) { PHASE_IDS;
        if (!(bid < 128 && wave == 0)) {
            const int wi = bid < 128 ? bid * 7 + (wave - 1) : 896 + (bid - 128) * 8 + wave, NW = 896 + (G - 128) * 8;
        } else {
            const int l15 = lane & 15, g = lane >> 4, bh = bid >> 2, vs = bid & 3;
            f32x4 z[4];
#pragma unroll
            for (int mt = 0; mt < 4; ++mt) z[mt] = (f32x4){0.f, 0.f, 0.f, 0.f};
            bf16x8 gA[4][2], gB[4][2], gC[4][2], gD[4][2]; u32x2 hA[4], hB[4], hC[4], hD[4];
#define SC_LOAD(gf, hf, C) do { const size_t u64_ = (size_t)bh * 64 + (C); const bf16* gp_ = (const bf16*)(ws + WS_GC) + u64_ * 4096 + l15 * 64 + 8 * g; \
                _Pragma("unroll") for (int mt = 0; mt < 4; ++mt) { gf[mt][0] = *(const bf16x8*)(gp_ + mt * 1024); gf[mt][1] = *(const bf16x8*)(gp_ + mt * 1024 + 32); \
                    hf[mt] = *(const u32x2*)((const bf16*)(ws + WS_HC) + ((size_t)((u64_ * 4 + vs) * 4 + mt) * 64 + lane) * 4); } } while (0)
#define SC_STEP(gf, hf, C) do { const size_t u64_ = (size_t)bh * 64 + (C); bf16* zs_ = (bf16*)(ws + WS_ZS) + ((size_t)((u64_ * 4 + vs) * 4) * 64 + lane) * 4; \
                _Pragma("unroll") for (int mt = 0; mt < 4; ++mt) { u32x2 zw_; zw_.x = pk2(z[mt][0], z[mt][1]); zw_.y = pk2(z[mt][2], z[mt][3]); *(u32x2*)(zs_ + mt * 256) = zw_; } \
                bf16x8 zb[2]; RW_ZB(z, zb); \
                _Pragma("unroll") for (int mt = 0; mt < 4; ++mt) { f32x4 a; a[0] = bflo(hf[mt].x); a[1] = bfhi(hf[mt].x); a[2] = bflo(hf[mt].y); a[3] = bfhi(hf[mt].y); \
                    a = __builtin_amdgcn_mfma_f32_16x16x32_bf16(gf[mt][0], zb[0], a, 0, 0, 0); a = __builtin_amdgcn_mfma_f32_16x16x32_bf16(gf[mt][1], zb[1], a, 0, 0, 0); z[mt] = a; } } while (0)
            SC_LOAD(gA, hA, 0); SC_LOAD(gB, hB, 1); SC_LOAD(gC, hC, 2);
#pragma unroll 1
            for (int C = 0; C < 64; C += 4) {
                SC_LOAD(gD, hD, C + 3);
                SC_STEP(gA, hA, C);
                if (C + 4 < 64) SC_LOAD(gA, hA, C + 4);
                SC_STEP(gB, hB, C + 1);
                if (C + 5 < 64) SC_LOAD(gB, hB, C + 5);
                SC_STEP(gC, hC, C + 2);
                if (C + 6 < 64) SC_LOAD(gC, hC, C + 6);
                SC_STEP(gD, hD, C + 3);
            }
#undef SC_LOAD
#undef SC_STEP
        }
    }
    if (IN(4)) { PHASE_IDS;
        if (bid < 32 && wave == 1) { const int bc = bid; const f32x2* ag = (const f32x2*)((const float*)(ws + WS_AP)) + (size_t)(bc * 64) * 64 + lane;
            float* car = (float*)(ws + WS_AP + 4 * MiB) + (size_t)(bc * 64) * 64 + lane; float hst = 0.f;
#pragma unroll 16
            for (int sg = 0; sg < 64; ++sg) { const f32x2 ab = ag[(size_t)sg * 64]; car[(size_t)sg * 64] = hst; hst = ab.x * hst + ab.y; } }
    }
    if (IN(4)) { PHASE_IDS;
        bf16* WKt = HN; bf16* VWt = HN + (size_t)4 * 1024 * 1024;
        __syncthreads();
        if (bid >= 128 && bid < 192) { pg8::FoldSched<0> S; S.A = (const char*)KM; S.B = (const char*)Wq_t; S.G = 64; S.c = bid - 128; EpiFold<0> E{(unsigned char*)WKt}; pg8::gemm_phase(lds, 256, S, E, wv0, 1024); }
        else if (bid >= 192) { pg8::FoldSched<1> S; S.A = (const char*)Wo_t; S.B = (const char*)VT; S.G = 64; S.c = bid - 192; EpiFold<1> E{(unsigned char*)VWt}; pg8::gemm_phase(lds, 256, S, E, wv0, 1024); }
    }
    SEAM(4);

    if (IN(5)) { PHASE_IDS;
        {
            for (int lu = gw; lu < (M / 64) * 8; lu += NGW) {
                const int seg = lu >> 3, nb = lu & 7, rr = lane >> 3, cq = lane & 7;
                const float* cp = (const float*)(ws + WS_AP + 4 * MiB) + ((size_t)(((seg >> 6) * 8 + nb) * 64 + (seg & 63)) * 64 + 8 * cq);
                const f32x4 c0 = *(const f32x4*)cp, c1 = *(const f32x4*)(cp + 4);
#pragma unroll
                for (int it = 0; it < 8; ++it) { const size_t m = (size_t)seg * 64 + 8 * it + rr; const size_t o = m * 512 + nb * 64 + 8 * cq;
                    const u32x4 pw = *(const u32x4*)(LA + o), hw = *(const u32x4*)(LB + o), gw_ = *(const u32x4*)(U + m * INW + 512 + nb * 64 + 8 * cq);
                    float y[8];
#pragma unroll
                    for (int q = 0; q < 4; ++q) { const float ca = q < 2 ? c0[2 * q] : c1[2 * q - 4], cb = q < 2 ? c0[2 * q + 1] : c1[2 * q - 3];
                        y[2 * q] = (bflo(hw[q]) + bflo(pw[q]) * ca) * gelu_tanh_f(bflo(gw_[q])); y[2 * q + 1] = (bfhi(hw[q]) + bfhi(pw[q]) * cb) * gelu_tanh_f(bfhi(gw_[q])); }
                    u32x4 w; w.x = pk2(y[0], y[1]); w.y = pk2(y[2], y[3]); w.z = pk2(y[4], y[5]); w.w = pk2(y[6], y[7]);
                    *(u32x4*)(CAT + m * 1024 + nb * 64 + 8 * cq) = w; }
            }
        }
        const int l15 = lane & 15, g = lane >> 4;
        LAS bf16* tGL = (LAS bf16*)(lds + wave * 16384); LAS bf16* tAD = tGL + 1024; LAS bf16* tOUT = tGL + 2048;
        const int ct = lane >> 3, cc = lane & 7;
        for (int u64 = gw; u64 < NB * NH * (SEQ / 64); u64 += NGW) {
            const int bh = u64 >> 6, C = u64 & 63, b = bh >> 3, h = bh & 7;
            f32x4 z[4][4];
#pragma unroll
            for (int sl = 0; sl < 4; ++sl)
#pragma unroll
                for (int mt = 0; mt < 4; ++mt) { const u32x2 zw = *(const u32x2*)((const bf16*)(ws + WS_ZS) + ((size_t)((u64 * 4 + sl) * 4 + mt) * 64 + lane) * 4); z[sl][mt] = (f32x4){bflo(zw.x), bfhi(zw.x), bflo(zw.y), bfhi(zw.y)}; }
#pragma unroll 1
            for (int j = 0; j < 4; ++j) {
                const size_t un = (size_t)u64 * 4 + j; const size_t m0 = (size_t)b * SEQ + (C * 4 + j) * 16;
                const bf16* rp = (const bf16*)(ws + WS_RP) + un * 1024 + l15 * 64 + 8 * g;
                const bf16x8 rf0 = *(const bf16x8*)rp, rf1 = *(const bf16x8*)(rp + 32);
                f32x4 y[4];
#pragma unroll
                for (int sl = 0; sl < 4; ++sl) y[sl] = *(const f32x4*)((const float*)(ws + WS_Y1F) + ((size_t)(un * 4 + sl) * 64 + lane) * 4);
                const size_t rg = (m0 + ct) * 512 + h * 64 + 8 * cc;
                const u32x4 gl0 = *(const u32x4*)((const bf16*)(ws + WS_G) + rg), gl1 = *(const u32x4*)((const bf16*)(ws + WS_G) + rg + 8 * 512);
                const u32x4 ad0 = *(const u32x4*)((const bf16*)(ws + WS_ADD) + rg), ad1 = *(const u32x4*)((const bf16*)(ws + WS_ADD) + rg + 8 * 512);
                bf16x8 gf[4][2]; u32x2 hfr[4][4];
                if (j < 3) {
                    const bf16* gp = (const bf16*)(ws + WS_GP) + un * 4096 + l15 * 64 + 8 * g;
#pragma unroll
                    for (int mt = 0; mt < 4; ++mt) { gf[mt][0] = *(const bf16x8*)(gp + mt * 1024); gf[mt][1] = *(const bf16x8*)(gp + mt * 1024 + 32); }
#pragma unroll
                    for (int sl = 0; sl < 4; ++sl)
#pragma unroll
                        for (int mt = 0; mt < 4; ++mt) hfr[sl][mt] = *(const u32x2*)((const bf16*)(ws + WS_HF) + ((size_t)((un * 4 + sl) * 4 + mt) * 64 + lane) * 4);
                }
                *(LAS u32x4*)(tGL + ct * 64 + 8 * cc) = gl0; *(LAS u32x4*)(tGL + (ct + 8) * 64 + 8 * cc) = gl1;
                *(LAS u32x4*)(tAD + ct * 64 + 8 * cc) = ad0; *(LAS u32x4*)(tAD + (ct + 8) * 64 + 8 * cc) = ad1;
                bf16x8 zb[4][2];
#pragma unroll
                for (int sl = 0; sl < 4; ++sl) { RW_ZB(z[sl], zb[sl]);
                    y[sl] = __builtin_amdgcn_mfma_f32_16x16x32_bf16(rf0, zb[sl][0], y[sl], 0, 0, 0); y[sl] = __builtin_amdgcn_mfma_f32_16x16x32_bf16(rf1, zb[sl][1], y[sl], 0, 0, 0); }
#pragma unroll
                for (int e = 0; e < 4; ++e) {
                    float s1 = (y[0][e] + y[1][e]) + (y[2][e] + y[3][e]);
                    s1 += __shfl_xor(s1, 1); s1 += __shfl_xor(s1, 2); s1 += __shfl_xor(s1, 4); s1 += __shfl_xor(s1, 8);
                    const float mean = s1 * (1.0f / 64.0f);
                    float d0 = y[0][e] - mean, d1 = y[1][e] - mean, d2 = y[2][e] - mean, d3 = y[3][e] - mean;
                    float s2 = (d0 * d0 + d1 * d1) + (d2 * d2 + d3 * d3);
                    s2 += __shfl_xor(s2, 1); s2 += __shfl_xor(s2, 2); s2 += __shfl_xor(s2, 4); s2 += __shfl_xor(s2, 8);
                    const float rstd = rsq_f(s2 * (1.0f / 64.0f) + GN_EPS);
                    const float dd[4] = {d0, d1, d2, d3};
#pragma unroll
                    for (int sl = 0; sl < 4; ++sl) { const int ti_ = (4 * g + e) * 64 + 16 * sl + l15;
                        const float o = dd[sl] * rstd * bf2f(tGL[ti_]) + bf2f(tAD[ti_]); tOUT[ti_] = (bf16)f2bf(o); }
                }
                { bf16* cp = CAT + (m0 + ct) * 1024 + 512 + h * 64 + 8 * cc;
                  *(u32x4*)cp = *(const LAS u32x4*)(tOUT + ct * 64 + 8 * cc); *(u32x4*)(cp + 8 * 1024) = *(const LAS u32x4*)(tOUT + (ct + 8) * 64 + 8 * cc); }
                if (j < 3) {
#pragma unroll
                    for (int sl = 0; sl < 4; ++sl)
#pragma unroll
                        for (int mt = 0; mt < 4; ++mt) { const u32x2 hh = hfr[sl][mt];
                            f32x4 a; a[0] = bflo(hh.x); a[1] = bfhi(hh.x); a[2] = bflo(hh.y); a[3] = bfhi(hh.y);
                            a = __builtin_amdgcn_mfma_f32_16x16x32_bf16(gf[mt][0], zb[sl][0], a, 0, 0, 0); a = __builtin_amdgcn_mfma_f32_16x16x32_bf16(gf[mt][1], zb[sl][1], a, 0, 0, 0); z[sl][mt] = a; }
                }
            }
        }
    }
    SEAM(5);
#undef RW_ZB


    if (IN(6)) { PHASE_IDS;
        pg8::DenseSched S; S.o.init_tiles(M / 256, D / 256, G, bid); S.A = (const char*)CAT; S.B = (const char*)Wout_t; S.tstep = (size_t)256 * D * 2;
        EpiBf16Res<false> E{args.in[I_X], X1, D, (float*)(ws + WS_AP + 2 * MiB), 1.0f, X1F8}; pg8::gemm_phase(lds, D, S, E, wv0);
    }
    SEAM(6);
    if (IN(7)) { PHASE_IDS;
        pg8::BatchBSched S; S.o.init_tiles(M / 256, D / 256, G, bid); S.A = (const char*)X1F8; S.B = (const char*)HN; S.tstep = (size_t)256 * 1024; S.bstep = (size_t)1024 * 1024;
        EpiSoftmax E{(unsigned char*)Qb, 0.0625f * 0.25f, (const float*)(ws + WS_AP + 2 * MiB), (LAS float*)(lds + RING_BYTES + 1024), (LAS float*)(lds + RING_BYTES + 1024 + 4096)};
        pg8::gemm_phase<EpiSoftmax, pg8::BatchBSched, true, true>(lds, 512, S, E, wv0);
    }
    SEAM(7);
    if (IN(8)) { PHASE_IDS;
        pg8::BatchBSched S; S.o.init_tiles(M / 256, D / 256, G, bid); S.A = (const char*)Qb; S.B = (const char*)(HN + (size_t)4 * 1024 * 1024); S.tstep = (size_t)256 * 1024; S.bstep = (size_t)1024 * 1024;
        EpiBf16Res<true> E{X1, X2, D, nullptr, 1.0f / 1024.0f, nullptr}; pg8::gemm_phase<EpiBf16Res<true>, pg8::BatchBSched, true, true>(lds, 512, S, E, wv0);
    }
    SEAM(8);
    if (IN(9)) { PHASE_IDS;
        for (int cid = tid; cid < 2 * NE * 128; cid += NTHREADS) { const int t = cid >> 12, row = (cid >> 7) & 31, c = cid & 127;
            *(LAS u32x4*)(lds + t * 65536 + row * 2048 + ((c ^ (row & 7)) << 4)) = *(const u32x4*)(WrT + (size_t)t * NE * D + row * D + 8 * c); }
        __syncthreads();
        const int l15 = lane & 15, g = lane >> 4;
        LAS float* LG = (LAS float*)(lds + RING_BYTES + 1024 + wave * 2304);
        const float* gfn = args.in[I_NFFG];
        LAS unsigned* cntl = (LAS unsigned*)(lds + RING_BYTES + 640);
        for (int t0 = 0; t0 < M / 16; t0 += G * 4) {
        if (tid < 64) cntl[tid] = 0u;
        __syncthreads();
        if (t0 == 0 && wave >= 4) {
            constexpr int I_DN = 16 * 32, I_GU = 16 * 64;
            for (int r = bid * 4 + (wave - 4); r < CONV_P9; r += G * 4) { const int e = r / I_GU, q = r % I_GU, kb = q / 64, nb = q % 64; const int n0 = 32 * nb;
                const int drow = n0 < 1024 ? (256 * (n0 >> 7) + (n0 & 127)) : (256 * ((n0 - 1024) >> 7) + 128 + ((n0 - 1024) & 127));
                transpose_item_tiled_fp8_nolds(args.in[I_WGU] + (size_t)e * D * 2048, 2048, D, (unsigned char*)Wgu_t + (size_t)e * 2048 * D, 64 * kb, n0, drow, lane); }
            for (int r = bid * 4 + (wave - 4); r < CONV_P9D; r += G * 4) { const int e = r / I_DN, q = r % I_DN, kb = q / 32, nb = q % 32;
                transpose_item_tiled_fp8_nolds(args.in[I_WDN] + (size_t)e * DFF * D, D, DFF, (unsigned char*)Wdn_t + (size_t)e * D * DFF, 64 * kb, 32 * nb, 32 * nb, lane); }
        }
        const int tile = t0 + bid * 4 + wave; const bool active = wave < 4 && tile < M / 16;
        int me = 0, lpos = 0, ai = 0; float mg = 0.f;
        if (active) {
            const int m0 = tile * 16;
            const bf16* xrow = X2 + (size_t)(m0 + l15) * D + 8 * g;
            float ss = 0.f;
#pragma unroll 8
            for (int ks = 0; ks < 32; ++ks) { const u32x4 xw = *(const u32x4*)(xrow + 32 * ks);
#pragma unroll
                for (int q = 0; q < 4; ++q) { const float a = bflo(xw[q]), c = bfhi(xw[q]); ss += a * a + c * c; } }
            ss += __shfl_xor(ss, 16); ss += __shfl_xor(ss, 32);
            const float rstd = rsq_f(ss * (1.f / D) + EPS);
            f32x4 acc0 = (f32x4){0.f, 0.f, 0.f, 0.f}, acc1 = acc0;
            unsigned char* hrow = (unsigned char*)HN + (size_t)(m0 + l15) * D + 8 * g;
#pragma unroll 2
            for (int ks = 0; ks < 32; ++ks) {
                const f32x4 g0 = *(const f32x4*)(gfn + 32 * ks + 8 * g), g1 = *(const f32x4*)(gfn + 32 * ks + 8 * g + 4);
                const u32x4 xw = *(const u32x4*)(xrow + 32 * ks);
                float hf[8];
#pragma unroll
                for (int q = 0; q < 4; ++q) { hf[2 * q] = bflo(xw[q]) * rstd * (q < 2 ? g0[2 * q] : g1[2 * q - 4]); hf[2 * q + 1] = bfhi(xw[q]) * rstd * (q < 2 ? g0[2 * q + 1] : g1[2 * q - 3]); }
                u32x4 hi, lo;
#pragma unroll
                for (int q = 0; q < 4; ++q) { hi[q] = pk2(hf[2 * q], hf[2 * q + 1]); lo[q] = pk2(hf[2 * q] - bflo(hi[q]), hf[2 * q + 1] - bfhi(hi[q])); }
                { u32x2 h8; h8.x = pk4_fp8(hf[0], hf[1], hf[2], hf[3]); h8.y = pk4_fp8(hf[4], hf[5], hf[6], hf[7]); *(u32x2*)(hrow + 32 * ks) = h8; }
                const bf16x8 ah = __builtin_bit_cast(bf16x8, hi), al = __builtin_bit_cast(bf16x8, lo);
                const int c = 4 * ks + g;
#pragma unroll
                for (int nt = 0; nt < 2; ++nt) { const int row = 16 * nt + l15; const int off = row * 2048 + ((c ^ (row & 7)) << 4);
                    const bf16x8 bh = *(const LAS bf16x8*)(lds + off), bl = *(const LAS bf16x8*)(lds + 65536 + off);
                    f32x4 a = nt ? acc1 : acc0;
                    a = __builtin_amdgcn_mfma_f32_16x16x32_bf16(ah, bh, a, 0, 0, 0); a = __builtin_amdgcn_mfma_f32_16x16x32_bf16(ah, bl, a, 0, 0, 0); a = __builtin_amdgcn_mfma_f32_16x16x32_bf16(al, bh, a, 0, 0, 0);
                    if (nt) acc1 = a; else acc0 = a; }
            }
            { const float b0 = args.in[I_BR][l15], b1 = args.in[I_BR][16 + l15];
#pragma unroll
              for (int j = 0; j < 4; ++j) { LG[(4 * g + j) * 33 + l15] = acc0[j] + b0; LG[(4 * g + j) * 33 + 16 + l15] = acc1[j] + b1; } }
            const int rrow = lane >> 2, qq = lane & 3;
            float tv[4] = {-3.0e38f, -3.0e38f, -3.0e38f, -3.0e38f}; int ti[4] = {64, 65, 66, 67};
#define TOP_INS(xv_, xi_) do { float x_ = (xv_); int i_ = (xi_); _Pragma("unroll") for (int p_ = 0; p_ < 4; ++p_) { const bool b_ = x_ > tv[p_] || (x_ == tv[p_] && i_ < ti[p_]); \
                const float ov_ = tv[p_]; const int oi_ = ti[p_]; tv[p_] = b_ ? x_ : ov_; ti[p_] = b_ ? i_ : oi_; x_ = b_ ? ov_ : x_; i_ = b_ ? oi_ : i_; } } while (0)
#pragma unroll
            for (int j = 0; j < 8; ++j) TOP_INS(LG[rrow * 33 + 8 * qq + j], 8 * qq + j);
#pragma unroll
            for (int st = 1; st < 4; st <<= 1) { float pv[4]; int pi[4];
#pragma unroll
                for (int p = 0; p < 4; ++p) { pv[p] = __shfl_xor(tv[p], st); pi[p] = __shfl_xor(ti[p], st); }
#pragma unroll
                for (int p = 0; p < 4; ++p) TOP_INS(pv[p], pi[p]); }
#undef TOP_INS
            const float e1 = __expf(tv[1] - tv[0]), e2 = __expf(tv[2] - tv[0]), e3 = __expf(tv[3] - tv[0]);
            const float inv = rcp_f(1.0f + e1 + e2 + e3);
            me = qq == 0 ? ti[0] : qq == 1 ? ti[1] : qq == 2 ? ti[2] : ti[3];
            mg = (qq == 0 ? 1.0f : qq == 1 ? e1 : qq == 2 ? e2 : e3) * inv;
            lpos = (int)__hip_atomic_fetch_add(cntl + me, 1u, __ATOMIC_RELAXED, __HIP_MEMORY_SCOPE_WORKGROUP);
            ai = (m0 + rrow) * 4 + qq;
        }
        __syncthreads();
        if (tid < NE) { const unsigned c = cntl[tid]; cntl[32 + tid] = c ? atomicAdd(ecnt + 64 * tid, c) : 0u; }
        __syncthreads();
        if (active) { route_e[ai] = me; route_pos[ai] = (int)cntl[32 + me] + lpos; route_g[ai] = mg; }
        __syncthreads();
        }
    }
    SEAM(9);
    if (IN(10)) { PHASE_IDS;
        LAS int* pst = (LAS int*)lds;
        if (wave == 0) {
            const int c = lane < NE ? (int)__hip_atomic_load(ecnt + 64 * lane, __ATOMIC_RELAXED, __HIP_MEMORY_SCOPE_AGENT) : 0; const int pc = (c + 255) & ~255;
            int x = pc;
#pragma unroll
            for (int d = 1; d < 32; d <<= 1) { const int y = __shfl_up(x, d); if (lane >= d) x += y; }
            if (lane < NE) { pst[lane] = x - pc; pst[64 + lane] = c; } if (lane == NE - 1) pst[32] = x; }
        __syncthreads();
        for (int ai = bid * NTHREADS + tid; ai < NASSIGN; ai += G * NTHREADS) {
            const int e = route_e[ai]; const int row = pst[e] + route_pos[ai]; { u32x2 sg_; sg_.x = (unsigned)ai; sg_.y = __float_as_uint(route_g[ai]); row_sg[row] = sg_; } row_tok[row] = ai >> 2; }
        if (bid < NE) { const int e = bid, c = pst[64 + e], pe = (c + 255) & ~255; for (int p = c + tid; p < pe; p += NTHREADS) { u32x2 sg_; sg_.x = 0xffffffffu; sg_.y = 0u; row_sg[pst[e] + p] = sg_; row_tok[pst[e] + p] = 0; } }
        if (bid == 0 && tid == 0) tile_tab[0] = pst[32] >> 8;
        if (bid >= 128 && bid < 136) { const int nt = pst[32] >> 8, nN = bid < 132 ? 8 : 4; int* tab = (int*)(ws + WS_ROUTE + (bid < 132 ? RT_UGU : RT_UDN));
            for (int L = (bid & 3) * NTHREADS + tid; L < nt * nN; L += 4 * NTHREADS) { Unit uu; { const int nwg = nt * nN; int wgid = L; { const int q = nwg / 8, r = nwg % 8, xcd = wgid % 8, off = wgid / 8; wgid = (xcd < r ? xcd * (q + 1) : r * (q + 1) + (xcd - r) * q) + off; }
                    const int nig = 8 * nN, gid = wgid / nig, fm = gid * 8, gsz = (nt - fm) < 8 ? (nt - fm) : 8; uu.pm = fm + ((wgid % nig) % gsz); uu.pn = (wgid % nig) / gsz; uu.e = 0; }
                int e = 0;
#pragma unroll
                for (int st = 16; st >= 1; st >>= 1) { if ((pst[e + st] >> 8) <= uu.pm) e += st; }
                tab[L] = uu.pm | (uu.pn << 12) | (e << 16); } }
        __syncthreads();
    }
    SEAM(10);
    if (IN(11)) {
        const int ntiles = tile_tab[0];
        pg8::MoeGatherSched S; S.o.init_tiles(ntiles, 2048 / 256, G, bid); S.A = (const char*)HN; S.B = (const char*)Wgu_t; S.tile_e = tile_tab + 16; S.utab = (const int*)(ws + WS_ROUTE + RT_UGU); S.rtok = row_tok; S.tstep = (size_t)256 * 1024; S.estep = (size_t)2048 * 1024;
        EpiSwiglu E{ACT, args.in[I_BGU]}; pg8::gemm_phase<EpiSwiglu, pg8::MoeGatherSched, true, true>(lds, 512, S, E, wv0);
        { PHASE_IDS; LAS float* scr = (LAS float*)(lds + wave * 16384); constexpr int I_DN = 16 * 32;
          for (;;) { int c0 = 0; if (lane == 0) c0 = (int)atomicAdd(ctl + CW_CONV, 8u); c0 = __builtin_amdgcn_readfirstlane(c0);
              c0 += CONV_P9D; if (c0 >= NE * I_DN) break;
              for (int r = c0; r < c0 + 8; ++r) { const int e = r / I_DN, q = r % I_DN, kb = q / 32, nb = q % 32;
                  transpose_item_tiled_fp8(args.in[I_WDN] + (size_t)e * DFF * D, D, DFF, (unsigned char*)Wdn_t + (size_t)e * D * DFF, 64 * kb, 32 * nb, 32 * nb, scr, lane); } } }
    }
    SEAM(11);
    if (IN(12)) {
        const int ntiles = tile_tab[0];
        pg8::MoeSched S; S.o.init_tiles(ntiles, D / 256, G, bid); S.A = (const char*)ACT; S.B = (const char*)Wdn_t; S.tile_e = tile_tab + 16; S.utab = (const int*)(ws + WS_ROUTE + RT_UDN); S.tstep = (size_t)256 * 1024; S.estep = (size_t)1024 * 1024;
        EpiDown E{YS, args.in[I_BDN], row_sg}; pg8::gemm_phase<EpiDown, pg8::MoeSched, true, true>(lds, 512, S, E, wv0);
    }
    SEAM(12);
    if (IN(13)) { PHASE_IDS;
        const float* gfin = args.in[I_FNG];
        for (int m = gw; m < M; m += NGW) {
            float v[16]; float s = 0.f;
#pragma unroll
            for (int hf = 0; hf < 2; ++hf) { const u32x4 w = *(const u32x4*)(X2 + (size_t)m * D + 512 * hf + 8 * lane);
#pragma unroll
                for (int q = 0; q < 4; ++q) { v[8 * hf + 2 * q] = bflo(w[q]); v[8 * hf + 2 * q + 1] = bfhi(w[q]); }
#pragma unroll
                for (int k = 0; k < 4; ++k) { const u32x2 y = *(const u32x2*)((const unsigned char*)YS + (size_t)(m * 4 + k) * D + 512 * hf + 8 * lane);
#pragma unroll
                    for (int q = 0; q < 2; ++q) { const auto lo2 = __builtin_amdgcn_cvt_pk_f32_fp8((int)y[q], false), hi2 = __builtin_amdgcn_cvt_pk_f32_fp8((int)y[q], true);
                        v[8 * hf + 4 * q] += lo2[0] * 0.0625f; v[8 * hf + 4 * q + 1] += lo2[1] * 0.0625f; v[8 * hf + 4 * q + 2] += hi2[0] * 0.0625f; v[8 * hf + 4 * q + 3] += hi2[1] * 0.0625f; } } }
#pragma unroll
            for (int j = 0; j < 16; ++j) s += v[j] * v[j];
            const float rstd = rsq_f(wave_sum(s) * (1.f / D) + EPS);
#pragma unroll
            for (int hf = 0; hf < 2; ++hf) { const f32x4 g0 = *(const f32x4*)(gfin + 512 * hf + 8 * lane), g1 = *(const f32x4*)(gfin + 512 * hf + 8 * lane + 4);
                float* o = args.out + (size_t)m * D + 512 * hf + 8 * lane;
                *(f32x4*)o = (f32x4){v[8 * hf] * rstd * g0.x, v[8 * hf + 1] * rstd * g0.y, v[8 * hf + 2] * rstd * g0.z, v[8 * hf + 3] * rstd * g0.w};
                *(f32x4*)(o + 4) = (f32x4){v[8 * hf + 4] * rstd * g1.x, v[8 * hf + 5] * rstd * g1.y, v[8 * hf + 6] * rstd * g1.z, v[8 * hf + 7] * rstd * g1.w}; }
        }
    }
#undef IN
#undef SEAM
}

constexpr int N_PHASES = 14;
extern "C" void kernel_launch(void* const* d_in, const int* in_sizes, int n_in, void* d_out, int out_size, void* d_ws, size_t ws_size, hipStream_t stream) {
    static int grid = 0;
    if (grid == 0) {
        if (n_in != 37 || out_size != M * D || ws_size < WS_END) { fprintf(stderr, "kernel_launch: unexpected shapes (n_in %d, out %d, ws %zu); nothing launched\n", n_in, out_size, ws_size); grid = -1; return; }
        int dev = 0, cus = 0, per_cu = 0;
        if (hipGetDevice(&dev) != hipSuccess || hipDeviceGetAttribute(&cus, hipDeviceAttributeMultiprocessorCount, dev) != hipSuccess) { grid = -1; return; }
        if (hipFuncSetAttribute((const void*)fwd, hipFuncAttributeMaxDynamicSharedMemorySize, LDS_BYTES) != hipSuccess) { fprintf(stderr, "kernel_launch: hipFuncSetAttribute failed\n"); grid = -1; return; }
        if (hipOccupancyMaxActiveBlocksPerMultiprocessor(&per_cu, (const void*)fwd, NTHREADS, LDS_BYTES) != hipSuccess || per_cu < 1) fprintf(stderr, "kernel_launch: occupancy query says %d\n", per_cu);
        (void)hipGetLastError();
        grid = cus > 256 ? 256 : cus;
    }
    if (grid < 0) return;
    if (hipMemsetAsync((char*)d_ws + WS_CTL, 0, CTL_ZERO_BYTES, stream) != hipSuccess) return;
    Args a{};
    for (int i = 0; i < 37; ++i) a.in[i] = (const float*)d_in[i];
    a.out = (float*)d_out; a.ws = (unsigned char*)d_ws;
#if MK_ONE_LAUNCH
    a.ph_lo = 0; a.ph_hi = N_PHASES;
    hipLaunchKernelGGL(fwd, dim3(grid), dim3(NTHREADS), LDS_BYTES, stream, a);
#else
    for (int p = 0; p < N_PHASES; ++p) { a.ph_lo = p; a.ph_hi = p + 1; hipLaunchKernelGGL(fwd, dim3(grid), dim3(NTHREADS), LDS_BYTES, stream, a);
#ifdef PROBE_REPEAT_PHASE
        if (p == PROBE_REPEAT_PHASE) hipLaunchKernelGGL(fwd, dim3(grid), dim3(NTHREADS), LDS_BYTES, stream, a);
#endif
    }
#endif
}
```

```cpp
#include <hip/hip_runtime.h>
#include <cstdio>
#include <cstdint>

#ifndef MK_ONE_LAUNCH
#define MK_ONE_LAUNCH 1
#endif

#define DI __device__ __forceinline__
#define GAS __attribute__((address_space(1)))
#define LAS __attribute__((address_space(3)))
typedef unsigned short bf16;
typedef short bf16x8 __attribute__((ext_vector_type(8)));
typedef int v4i __attribute__((ext_vector_type(4)));
typedef int v8i __attribute__((ext_vector_type(8)));
typedef float f32x4 __attribute__((ext_vector_type(4)));
typedef float f32x2 __attribute__((ext_vector_type(2)));
typedef unsigned u32x4 __attribute__((ext_vector_type(4)));
typedef unsigned u32x2 __attribute__((ext_vector_type(2)));

constexpr int D = 1024, NB = 4, SEQ = 4096, M = NB * SEQ;
constexpr int MEML = 256, MROWS = NB * MEML;
constexpr int LRU_W = 512, RW = 512, NH = 8, HD = 64;
constexpr int INW = 2816;
constexpr int XH = 4, XHD = 256;
constexpr int NE = 32, TOPK = 4, DFF = 1024;
constexpr int NASSIGN = M * TOPK;
constexpr int MAXTILES = 288, MAXROWS = MAXTILES * 256;
constexpr float EPS = 1e-6f, GN_EPS = 64e-5f;

DI int fresh_tid_(int wv) { int w = wv; asm volatile("" : "+s"(w)); int l; asm volatile("v_mbcnt_lo_u32_b32 %0, -1, 0\n\tv_mbcnt_hi_u32_b32 %0, -1, %0" : "=v"(l)); return (w << 6) | (l & 63); }
#define fresh_tid() fresh_tid_(wv0)
namespace pg8 {
constexpr int BM = 256, BK = 64, HALF = 128, HTB = HALF * BK * 2, STAGE_BYTES = 8 * HTB, NXCD = 8, WGM = 8;
__host__ __device__ __forceinline__ int lds_byte(int r, int c) { const int st = (r >> 4) * 2 + (c >> 5), rr = r & 15, cc = c & 31, ob = rr * 64 + cc * 2; return st * 1024 + (ob ^ (((ob >> 9) & 1) << 5)); }
__host__ __device__ __forceinline__ void stage_rc(int b, int& R, int& C) { const int st = b / 1024, sb = b % 1024, swz = sb ^ (((sb >> 9) & 1) << 5); R = (st >> 1) * 16 + swz / 64; C = (st & 1) * 32 + (swz % 64) / 2; }
__host__ __device__ __forceinline__ int perm32(int rho) { const int n = rho >> 4, i = rho & 15; return 8 * (i >> 2) + 4 * n + (i & 3); }

struct Unit { int pm, pn, e; };

struct StaticOrder {
    int nM, nN, nwg, G, c;
    __host__ __device__ void init_tiles(int nM_, int nN_, int G_, int c_) { nM = nM_; nN = nN_; nwg = nM * nN; G = G_; c = c_; }
    __host__ __device__ bool next(int i, Unit& u) const {
        const long L = (long)i * G + c; if (L >= nwg) return false;
        int wgid = (int)L; { const int q = nwg / NXCD, r = nwg % NXCD, xcd = wgid % NXCD, off = wgid / NXCD; wgid = (xcd < r ? xcd * (q + 1) : r * (q + 1) + (xcd - r) * q) + off; }
        const int nig = WGM * nN, gid = wgid / nig, fm = gid * WGM, gsz = (nM - fm) < WGM ? (nM - fm) : WGM;
        u.pm = fm + ((wgid % nig) % gsz); u.pn = (wgid % nig) / gsz; u.e = 0; return true;
    }
};
struct DenseSched {
    static constexpr bool GATHER = false, B_TILED = false;
    StaticOrder o; const char* A; const char* B; size_t tstep;
    DI bool next(int i, Unit& u) const { return o.next(i, u); }
    DI const char* a_ptr(const Unit& u) const { return A + (size_t)u.pm * tstep; }
    DI const char* b_ptr(const Unit& u) const { return B + (size_t)u.pn * tstep; }
    DI void a_voff(const Unit&, int K, const int (&R)[2], const int (&C)[2], unsigned (&vo)[2][2]) const {
#pragma unroll
        for (int h = 0; h < 2; ++h)
#pragma unroll
            for (int i = 0; i < 2; ++i) vo[h][i] = (unsigned)((h * HALF + R[i]) * K + C[i]) * 2u; }
};
struct MoeSched {
    static constexpr bool GATHER = false, B_TILED = true;
    StaticOrder o; const char* A; const char* B; const int* tile_e; const int* utab; size_t tstep, estep;
    DI bool next(int i, Unit& u) const { const int L = i * o.G + o.c; if (L >= o.nwg) return false; int en; asm volatile("s_load_dword %0, %1, 0x0\n\ts_waitcnt lgkmcnt(0)" : "=s"(en) : "s"(utab + L) : "memory");     u.pm = en & 0xfff; u.pn = (en >> 12) & 15; u.e = en >> 16; return true; }
    DI const char* a_ptr(const Unit& u) const { return A + (size_t)u.pm * tstep; }
    DI const char* b_ptr(const Unit& u) const { return B + (size_t)u.e * estep + (size_t)u.pn * tstep; }
    DI void a_voff(const Unit&, int K, const int (&R)[2], const int (&C)[2], unsigned (&vo)[2][2]) const {
#pragma unroll
        for (int h = 0; h < 2; ++h)
#pragma unroll
            for (int i = 0; i < 2; ++i) vo[h][i] = (unsigned)((h * HALF + R[i]) * K + C[i]) * 2u; }
};
struct MoeGatherSched {
    static constexpr bool GATHER = true, B_TILED = true;
    StaticOrder o; const char* A; const char* B; const int* tile_e; const int* utab; const int* rtok; size_t tstep, estep;
    DI bool next(int i, Unit& u) const { const int L = i * o.G + o.c; if (L >= o.nwg) return false; int en; asm volatile("s_load_dword %0, %1, 0x0\n\ts_waitcnt lgkmcnt(0)" : "=s"(en) : "s"(utab + L) : "memory");     u.pm = en & 0xfff; u.pn = (en >> 12) & 15; u.e = en >> 16; return true; }
    DI const char* a_ptr(const Unit&) const { return A; }
    DI const char* b_ptr(const Unit& u) const { return B + (size_t)u.e * estep + (size_t)u.pn * tstep; }
    DI void a_voff(const Unit& u, int K, const int (&R)[2], const int (&C)[2], unsigned (&vo)[2][2]) const {
#pragma unroll
        for (int h = 0; h < 2; ++h)
#pragma unroll
            for (int i = 0; i < 2; ++i) vo[h][i] = (unsigned)(rtok[u.pm * BM + h * HALF + R[i]] * K + C[i]) * 2u; }
};

struct BatchBSched {
    static constexpr bool GATHER = false, B_TILED = false;
    StaticOrder o; const char* A; const char* B; size_t tstep, bstep;
    DI bool next(int i, Unit& u) const { return o.next(i, u); }
    DI const char* a_ptr(const Unit& u) const { return A + (size_t)u.pm * tstep; }
    DI const char* b_ptr(const Unit& u) const { return B + (size_t)(u.pm >> 4) * bstep + (size_t)u.pn * tstep; }
    DI void a_voff(const Unit&, int K, const int (&R)[2], const int (&C)[2], unsigned (&vo)[2][2]) const {
#pragma unroll
        for (int h = 0; h < 2; ++h)
#pragma unroll
            for (int i = 0; i < 2; ++i) vo[h][i] = (unsigned)((h * HALF + R[i]) * K + C[i]) * 2u; }
};
template <int MODE> struct FoldSched {
    static constexpr bool GATHER = false, B_TILED = false;
    const char* A; const char* B; int G, c;
    DI bool next(int i, Unit& u) const { const int L = i * G + c; if (L >= 64) return false; u.pm = L >> 2; u.pn = L & 3; u.e = 0; return true; }
    DI const char* a_ptr(const Unit& u) const { const int b = u.pm >> 2, h = u.pm & 3; return A + ((size_t)(MODE == 0 ? b * 256 : u.pn * 256) * 1024 + h * 256) * 2; }
    DI const char* b_ptr(const Unit& u) const { const int b = u.pm >> 2, h = u.pm & 3; return B + ((size_t)(MODE == 0 ? u.pn * 256 : b * 256) * 1024 + h * 256) * 2; }
    DI void a_voff(const Unit&, int K, const int (&R)[2], const int (&C)[2], unsigned (&vo)[2][2]) const {
#pragma unroll
        for (int h = 0; h < 2; ++h)
#pragma unroll
            for (int i = 0; i < 2; ++i) vo[h][i] = (unsigned)((h * HALF + R[i]) * K + C[i]) * 2u; }
};

DI unsigned cvt_pk_bf16(float lo, float hi) { unsigned r; asm volatile("v_cvt_pk_bf16_f32 %0, %1, %2" : "=v"(r) : "v"(lo), "v"(hi)); return r; }

template <class Epi, class Sched, bool ALIGN_EPI = true, bool FP8 = false>
DI void gemm_phase(LAS unsigned char* lds, const int K, const Sched& S, const Epi& E, const int wv0, const int ldp = 0) {
    const int ld = ldp ? ldp : K;
    const int tid = fresh_tid(), wid = __builtin_amdgcn_readfirstlane(tid >> 6), lane = tid & 63, wr = wid >> 2, wc = wid & 3, fr = lane & 15, fq = lane >> 4;
    const int nt = K / BK;
    constexpr bool GA = Sched::GATHER, BT = Sched::B_TILED;
    unsigned voffA[2][2], voffAn[2][2], voffB[2];
#pragma unroll
    for (int i = 0; i < 2; ++i) { int R, C; stage_rc(tid * 16 + i * 8192, R, C); const int Rb = Epi::PERM ? ((R & ~31) + perm32(R & 31)) : R;
        voffB[i] = BT ? (unsigned)(tid * 16 + i * 8192) : (unsigned)(Rb * ld + C) * 2u; }
#define PG8_AVOFF(unit, dst) do { int sR[2], sC[2]; const int t2_ = fresh_tid(); stage_rc(t2_ * 16, sR[0], sC[0]); stage_rc(t2_ * 16 + 8192, sR[1], sC[1]); S.a_voff(unit, ld, sR, sC, dst); } while (0)
    const size_t kstep = (size_t)(BK * 2);
    const size_t hstep = (size_t)HALF * ld * 2;
    const size_t kstepB = BT ? (size_t)(2 * HTB) : kstep, hstepB = BT ? (size_t)HTB : hstep;
    const unsigned ldsw = (unsigned)wid * 1024u;
    unsigned aoffv = (unsigned)(size_t)lds + (unsigned)lds_byte(wr * 64 + fr, fq * 8), boffv = (unsigned)(size_t)lds + (unsigned)(4 * HTB) + (unsigned)lds_byte(wc * 32 + fr, fq * 8);
    asm volatile("" : "+v"(aoffv), "+v"(boffv));
    const size_t dB = BT ? (size_t)8192 : (size_t)64 * ld * 2, dA = (size_t)64 * ld * 2;
#define PG8_SA(b, h) (((b) * 2 + (h)) * HTB)
#define PG8_SB(b, h) ((4 + (b) * 2 + (h)) * HTB)
    const unsigned ldsbase = (unsigned)__builtin_amdgcn_readfirstlane((int)((unsigned)(size_t)lds + ldsw));
#define PG8_STAGE1(bufoff, gptr, vo, i_) do { const unsigned m0v_ = ldsbase + (unsigned)(bufoff) + (unsigned)(i_) * 8192u; \
        asm volatile("s_mov_b32 m0, %2\n\ts_nop 0\n\tglobal_load_lds_dwordx4 %0, %1" :: "v"(vo), "s"((const char*)(gptr)), "s"(m0v_) : "memory", "m0"); } while (0)
#define PG8_STAGE(bufoff, gbase, voff) do { PG8_STAGE1(bufoff, gbase, (voff)[0], 0); PG8_STAGE1(bufoff, gbase, (voff)[1], 1); } while (0)
#define PG8_STAGE_D(bufoff, gbase, vo, delta) do { PG8_STAGE1(bufoff, gbase, vo, 0); PG8_STAGE1(bufoff, (const char*)(gbase) + (delta), vo, 1); } while (0)
#define PG8_LDA(dst, b, h) do { if constexpr (FP8) { _Pragma("unroll") for (int m = 0; m < 4; ++m) { const LAS v4i* p_ = (const LAS v4i*)((LAS unsigned char*)(size_t)aoffv + PG8_SA(b, h) + m * 2048); dst##8[m] = __builtin_shufflevector(p_[0], p_[64], 0, 1, 2, 3, 4, 5, 6, 7); } } \
        else { _Pragma("unroll") for (int m = 0; m < 4; ++m) _Pragma("unroll") for (int k = 0; k < 2; ++k) dst[m][k] = *(const LAS bf16x8*)((LAS unsigned char*)(size_t)aoffv + PG8_SA(b, h) + m * 2048 + k * 1024); } } while (0)
#define PG8_LDB(dst, b, h) do { if constexpr (FP8) { _Pragma("unroll") for (int n = 0; n < 2; ++n) { const LAS v4i* p_ = (const LAS v4i*)((LAS unsigned char*)(size_t)boffv + (PG8_SB(b, h) - 4 * HTB) + n * 2048); dst##8[n] = __builtin_shufflevector(p_[0], p_[64], 0, 1, 2, 3, 4, 5, 6, 7); } } \
        else { _Pragma("unroll") for (int n = 0; n < 2; ++n) _Pragma("unroll") for (int k = 0; k < 2; ++k) dst[n][k] = *(const LAS bf16x8*)((LAS unsigned char*)(size_t)boffv + (PG8_SB(b, h) - 4 * HTB) + n * 2048 + k * 1024); } } while (0)
#define PG8_MMA(ai, bj, At, Bt) do { __builtin_amdgcn_s_setprio(1); \
        if constexpr (FP8) {   \
            _Pragma("unroll") for (int m = 0; m < 4; ++m) _Pragma("unroll") for (int n = 0; n < 2; ++n) \
                acc[ai][bj][m][n] = __builtin_amdgcn_mfma_scale_f32_16x16x128_f8f6f4(Bt##8[n], At##8[m], acc[ai][bj][m][n], 0, 0, 0, 0, 0, 0); } \
        else { _Pragma("unroll") for (int m = 0; m < 4; ++m) _Pragma("unroll") for (int n = 0; n < 2; ++n) _Pragma("unroll") for (int k = 0; k < 2; ++k) \
            acc[ai][bj][m][n] = __builtin_amdgcn_mfma_f32_16x16x32_bf16(Bt[n][k], At[m][k], acc[ai][bj][m][n], 0, 0, 0); } \
        __builtin_amdgcn_s_setprio(0); } while (0)
#define PG8_WAIT_V(n) asm volatile("s_waitcnt vmcnt(" #n ")" ::: "memory")
#define PG8_WAIT_L(n) asm volatile("s_waitcnt lgkmcnt(" #n ")" ::: "memory")
#define PG8_BAR __builtin_amdgcn_s_barrier()
#define PG8_SCHED __builtin_amdgcn_sched_barrier(0)
    Unit cur, nxt; int ui = 0;
    if (!S.next(0, cur)) return;
    f32x4 acc[2][2][4][2];
#pragma unroll
    for (int a = 0; a < 2; ++a)
#pragma unroll
        for (int b = 0; b < 2; ++b)
#pragma unroll
            for (int m = 0; m < 4; ++m)
#pragma unroll
                for (int n = 0; n < 2; ++n) acc[a][b][m][n] = (f32x4){0.f, 0.f, 0.f, 0.f};
    bf16x8 At[4][2], B0[2][2], B1[2][2]; v8i At8[4], B08[2], B18[2];
    const char* cA = S.a_ptr(cur); const char* cB = S.b_ptr(cur);
    PG8_AVOFF(cur, voffA);
#define PG8_STAGE_A(bufoff, kbase, h, vo) do { if constexpr (GA) { PG8_STAGE(bufoff, kbase, (vo)[h]); } else { PG8_STAGE_D(bufoff, (kbase) + (h) * hstep, voffA[0][0], dA); } } while (0)
    PG8_STAGE_D(PG8_SB(0, 0), cB, voffB[0], dB); PG8_STAGE_D(PG8_SB(0, 1), cB + hstepB, voffB[0], dB); PG8_STAGE_A(PG8_SA(0, 0), cA, 0, voffA); PG8_STAGE_A(PG8_SA(0, 1), cA, 1, voffA);
    if (wr == 1) PG8_BAR;
    PG8_WAIT_V(2); PG8_BAR;
    PG8_STAGE_D(PG8_SB(1, 0), cB + kstepB, voffB[0], dB); PG8_STAGE_A(PG8_SA(1, 0), cA + kstep, 0, voffA); PG8_STAGE_D(PG8_SB(1, 1), cB + hstepB + kstepB, voffB[0], dB);
    PG8_WAIT_V(6); PG8_BAR;
    for (;;) {
        const bool has_next = S.next(ui + 1, nxt);
        const char* nA = has_next ? S.a_ptr(nxt) : cA; const char* nB = has_next ? S.b_ptr(nxt) : cB;
        if constexpr (GA) { if (has_next) PG8_AVOFF(nxt, voffAn);
            else {
#pragma unroll
                for (int h = 0; h < 2; ++h)
#pragma unroll
                    for (int i = 0; i < 2; ++i) voffAn[h][i] = voffA[h][i]; } }
#pragma unroll 1
        for (int t = 0; t < nt; t += 2) {
            const bool last = (t == nt - 2);
            const char* a1 = cA + (size_t)(t + 1) * kstep;
            const char* a2 = last ? nA : cA + (size_t)(t + 2) * kstep; const char* b2 = last ? nB : cB + (size_t)(t + 2) * kstepB;
            const char* a3 = a2 + kstep; const char* b3 = b2 + kstepB;
            PG8_LDB(B0, 0, 0); PG8_LDB(B1, 0, 1); PG8_SCHED; PG8_LDA(At, 0, 0); PG8_STAGE_A(PG8_SA(1, 1), a1, 1, voffA);
            if constexpr (GA) { if (last) {
#pragma unroll
                for (int h = 0; h < 2; ++h)
#pragma unroll
                    for (int i = 0; i < 2; ++i) voffA[h][i] = voffAn[h][i]; } }
            PG8_WAIT_V(8); PG8_WAIT_L(0); PG8_BAR; PG8_MMA(0, 0, At, B0); PG8_MMA(0, 1, At, B1); PG8_BAR; PG8_SCHED;
            PG8_LDA(At, 0, 1); PG8_STAGE_D(PG8_SB(0, 0), b2, voffB[0], dB); PG8_STAGE_D(PG8_SB(0, 1), b2 + hstepB, voffB[0], dB); PG8_STAGE_A(PG8_SA(0, 0), a2, 0, voffA);
            PG8_WAIT_V(8); PG8_WAIT_L(0); PG8_BAR; PG8_MMA(1, 0, At, B0); PG8_MMA(1, 1, At, B1); PG8_BAR; PG8_SCHED;
            PG8_LDB(B0, 1, 0); PG8_LDB(B1, 1, 1); PG8_SCHED; PG8_LDA(At, 1, 0); PG8_STAGE_A(PG8_SA(0, 1), a2, 1, voffA);
            PG8_WAIT_V(8); PG8_WAIT_L(0); PG8_BAR; PG8_MMA(0, 0, At, B0); PG8_MMA(0, 1, At, B1); PG8_BAR; PG8_SCHED;
            PG8_LDA(At, 1, 1); PG8_STAGE_D(PG8_SB(1, 0), b3, voffB[0], dB); PG8_STAGE_D(PG8_SB(1, 1), b3 + hstepB, voffB[0], dB); PG8_STAGE_A(PG8_SA(1, 0), a3, 0, voffA);
            PG8_WAIT_V(8); PG8_WAIT_L(0); PG8_BAR; PG8_MMA(1, 0, At, B0); PG8_MMA(1, 1, At, B1); PG8_BAR; PG8_SCHED;
        }
        if constexpr (ALIGN_EPI) { if (wr == 0) PG8_BAR; }
        { Unit ue = cur; ue.pm = __builtin_amdgcn_readfirstlane(ue.pm); ue.pn = __builtin_amdgcn_readfirstlane(ue.pn); ue.e = __builtin_amdgcn_readfirstlane(ue.e); asm volatile("" : "+s"(ue.pm), "+s"(ue.pn), "+s"(ue.e));
          const int t3_ = fresh_tid(); const int fr_ = t3_ & 15, fq_ = (t3_ & 63) >> 4;
          E(acc, ue, wr, wc, fr_, fq_); }
        if (!has_next) break;
#pragma unroll
        for (int a = 0; a < 2; ++a)
#pragma unroll
            for (int b = 0; b < 2; ++b)
#pragma unroll
                for (int m = 0; m < 4; ++m)
#pragma unroll
                    for (int n = 0; n < 2; ++n) acc[a][b][m][n] = (f32x4){0.f, 0.f, 0.f, 0.f};
        cur = nxt; cA = nA; cB = nB; ++ui;
        if constexpr (ALIGN_EPI) { if (wr == 1) PG8_BAR; }
    }
    PG8_WAIT_V(0);
    if constexpr (!ALIGN_EPI) { if (wr == 0) PG8_BAR; }
    PG8_BAR;
#undef PG8_SA
#undef PG8_SB
#undef PG8_STAGE
#undef PG8_STAGE1
#undef PG8_STAGE_D
#undef PG8_STAGE_A
#undef PG8_AVOFF
#undef PG8_LDA
#undef PG8_LDB
#undef PG8_MMA
#undef PG8_WAIT_V
#undef PG8_WAIT_L
#undef PG8_BAR
#undef PG8_SCHED
}
}
using pg8::Unit;
using pg8::cvt_pk_bf16;

DI float bflo(unsigned w) { return __uint_as_float(w << 16); }
DI float bfhi(unsigned w) { return __uint_as_float(w & 0xffff0000u); }
DI float bf2f(bf16 b) { return __uint_as_float(((unsigned)b) << 16); }
typedef __bf16 hwbf2 __attribute__((ext_vector_type(2)));
DI unsigned pk2(float lo, float hi) { const f32x2 v = {lo, hi}; return __builtin_bit_cast(unsigned, __builtin_convertvector(v, hwbf2)); }
DI unsigned f2bf(float f) { return pk2(f, 0.f) & 0xffffu; }
DI float rcp_f(float x) { return __builtin_amdgcn_rcpf(x); }
DI float rsq_f(float x) { return __builtin_amdgcn_rsqf(x); }
DI float sigmoid_f(float x) { return rcp_f(1.0f + __expf(-x)); }
DI float tanh_fast(float x) { return 1.0f - 2.0f * rcp_f(__expf(2.0f * x) + 1.0f); }
DI float softplus_f(float x) { return fmaxf(x, 0.f) + __logf(1.0f + __expf(-fabsf(x))); }
DI float softplus_fast(float x) { return fmaxf(x, 0.f) + __logf(1.0f + __expf(-fabsf(x))); }
DI float gelu_tanh_f(float x) { const float u = 0.7978845608028654f * (x + 0.044715f * x * x * x); return 0.5f * x * (1.0f + tanh_fast(u)); }
DI float wave_sum(float v) {
#pragma unroll
    for (int o = 1; o < 64; o <<= 1) v += __shfl_xor(v, o);
    return v;
}

DI unsigned pk4_fp8(float a, float b, float c, float d) { int w = 0; w = __builtin_amdgcn_cvt_pk_fp8_f32(a, b, w, false); w = __builtin_amdgcn_cvt_pk_fp8_f32(c, d, w, true); return (unsigned)w; }
struct EpiBf16Plain {
    static constexpr bool PERM = true;
    bf16* O; int ldc; float scale;
    DI void operator()(const f32x4 (&acc)[2][2][4][2], const Unit& u, int wr, int wc, int fr, int fq) const {
        const int row0 = u.pm * 256 + wr * 64 + fr, col0 = u.pn * 256 + wc * 32 + 8 * fq;
#pragma unroll
        for (int ai = 0; ai < 2; ++ai)
#pragma unroll
            for (int m = 0; m < 4; ++m) { bf16* rowp = O + (size_t)(row0 + ai * 128 + m * 16) * ldc + col0;
#pragma unroll
                for (int bj = 0; bj < 2; ++bj) { const f32x4 v0 = acc[ai][bj][m][0] * scale, v1 = acc[ai][bj][m][1] * scale;
                    u32x4 w; w.x = cvt_pk_bf16(v0[0], v0[1]); w.y = cvt_pk_bf16(v0[2], v0[3]); w.z = cvt_pk_bf16(v1[0], v1[1]); w.w = cvt_pk_bf16(v1[2], v1[3]);
                    *(u32x4*)(rowp + bj * 128) = w; } }
    }
};
template <int MODE> struct EpiFold {
    static constexpr bool PERM = true;
    unsigned char* O;
    DI void operator()(const f32x4 (&acc)[2][2][4][2], const Unit& u, int wr, int wc, int fr, int fq) const {
        const int b = u.pm >> 2, h = u.pm & 3;
        const int rbase = MODE == 0 ? h * 256 : u.pn * 256, cbase = MODE == 0 ? u.pn * 256 : h * 256;
        const unsigned boff = (unsigned)b * 1024u * 1024u + (unsigned)(rbase + wr * 64 + fr) * 1024u + (unsigned)(cbase + wc * 32 + 8 * fq);
#pragma unroll
        for (int ai = 0; ai < 2; ++ai)
#pragma unroll
            for (int m = 0; m < 4; ++m) { unsigned char* rowp = O + (boff + (unsigned)(ai * 128 + m * 16) * 1024u);
#pragma unroll
                for (int bj = 0; bj < 2; ++bj) { const f32x4 v0 = acc[ai][bj][m][0] * 4.0f, v1 = acc[ai][bj][m][1] * 4.0f;
                    u32x2 w; w.x = pk4_fp8(v0[0], v0[1], v0[2], v0[3]); w.y = pk4_fp8(v1[0], v1[1], v1[2], v1[3]);
                    *(u32x2*)(rowp + bj * 128) = w; } }
    }
};
struct EpiSoftmax {
    static constexpr bool PERM = true;
    unsigned char* O; float scale; const float* RS; LAS float* XM; LAS float* XS;
    DI void operator()(const f32x4 (&acc)[2][2][4][2], const Unit& u, int wr, int wc, int fr, int fq) const {
        const int row0 = u.pm * 256 + wr * 64 + fr, col0 = u.pn * 256 + wc * 32 + 8 * fq;
        float sc[2][4];
#pragma unroll
        for (int ai = 0; ai < 2; ++ai)
#pragma unroll
            for (int m = 0; m < 4; ++m) { const int r = row0 + ai * 128 + m * 16; const f32x4* rp = (const f32x4*)(RS + (size_t)r * 16);
                const f32x4 p0 = rp[0], p1 = rp[1], p2 = rp[2], p3 = rp[3];
                const float ss = ((p0[0] + p0[1]) + (p0[2] + p0[3])) + ((p1[0] + p1[1]) + (p1[2] + p1[3])) + ((p2[0] + p2[1]) + (p2[2] + p2[3])) + ((p3[0] + p3[1]) + (p3[2] + p3[3]));
                sc[ai][m] = scale * __builtin_amdgcn_rsqf(ss * (1.0f / 1024.0f) + 1e-6f);
                float mm = -3.0e38f;
#pragma unroll
                for (int bj = 0; bj < 2; ++bj)
#pragma unroll
                    for (int n = 0; n < 2; ++n) { const f32x4 v = acc[ai][bj][m][n]; mm = fmaxf(mm, fmaxf(fmaxf(v[0], v[1]), fmaxf(v[2], v[3]))); }
                mm *= sc[ai][m];
                mm = fmaxf(mm, __shfl_xor(mm, 16)); mm = fmaxf(mm, __shfl_xor(mm, 32));
                if (fq == 0) XM[(ai * 128 + wr * 64 + m * 16 + fr) * 4 + wc] = mm; }
        asm volatile("s_waitcnt lgkmcnt(0)" ::: "memory"); __builtin_amdgcn_s_barrier(); asm volatile("" ::: "memory");
        f32x4 (&pa)[2][2][4][2] = const_cast<f32x4 (&)[2][2][4][2]>(acc);
#pragma unroll
        for (int ai = 0; ai < 2; ++ai)
#pragma unroll
            for (int m = 0; m < 4; ++m) { const int lr = ai * 128 + wr * 64 + m * 16 + fr; const f32x4 q = *(const LAS f32x4*)(XM + lr * 4);
                const float mxr = fmaxf(fmaxf(q[0], q[1]), fmaxf(q[2], q[3])); float sm = 0.f;
#pragma unroll
                for (int bj = 0; bj < 2; ++bj)
#pragma unroll
                    for (int n = 0; n < 2; ++n)
#pragma unroll
                        for (int j = 0; j < 4; ++j) { const float p = __expf(acc[ai][bj][m][n][j] * sc[ai][m] - mxr); pa[ai][bj][m][n][j] = p; sm += p; }
                sm += __shfl_xor(sm, 16); sm += __shfl_xor(sm, 32);
                if (fq == 0) XS[lr * 4 + wc] = sm; }
        asm volatile("s_waitcnt lgkmcnt(0)" ::: "memory"); __builtin_amdgcn_s_barrier(); asm volatile("" ::: "memory");
#pragma unroll
        for (int ai = 0; ai < 2; ++ai)
#pragma unroll
            for (int m = 0; m < 4; ++m) { const int lr = ai * 128 + wr * 64 + m * 16 + fr; const f32x4 q = *(const LAS f32x4*)(XS + lr * 4);
                const float inv = 256.0f * __builtin_amdgcn_rcpf((q[0] + q[1]) + (q[2] + q[3]));
                unsigned char* rowp = O + (size_t)(row0 + ai * 128 + m * 16) * 1024 + col0;
#pragma unroll
                for (int bj = 0; bj < 2; ++bj) { const f32x4 v0 = pa[ai][bj][m][0] * inv, v1 = pa[ai][bj][m][1] * inv;
                    u32x2 w; w.x = pk4_fp8(v0[0], v0[1], v0[2], v0[3]); w.y = pk4_fp8(v1[0], v1[1], v1[2], v1[3]);
                    *(u32x2*)(rowp + bj * 128) = w; } }
        asm volatile("s_waitcnt lgkmcnt(0)" ::: "memory"); __builtin_amdgcn_s_barrier(); asm volatile("" ::: "memory");
    }
};
struct EpiBf16RowNorm {
    static constexpr bool PERM = true;
    bf16* O; int ldc; float scale; const float* RS;
    DI void operator()(const f32x4 (&acc)[2][2][4][2], const Unit& u, int wr, int wc, int fr, int fq) const {
        const int row0 = u.pm * 256 + wr * 64 + fr, col0 = u.pn * 256 + wc * 32 + 8 * fq;
#pragma unroll
        for (int ai = 0; ai < 2; ++ai)
#pragma unroll
            for (int m = 0; m < 4; ++m) { const int r = row0 + ai * 128 + m * 16; const f32x4* rp = (const f32x4*)(RS + (size_t)r * 16);
                const f32x4 p0 = rp[0], p1 = rp[1], p2 = rp[2], p3 = rp[3];
                const float ss = ((p0[0] + p0[1]) + (p0[2] + p0[3])) + ((p1[0] + p1[1]) + (p1[2] + p1[3])) + ((p2[0] + p2[1]) + (p2[2] + p2[3])) + ((p3[0] + p3[1]) + (p3[2] + p3[3]));
                const float sc = scale * __builtin_amdgcn_rsqf(ss * (1.0f / 1024.0f) + 1e-6f);
                bf16* rowp = O + (size_t)r * ldc + col0;
#pragma unroll
                for (int bj = 0; bj < 2; ++bj) { const f32x4 v0 = acc[ai][bj][m][0] * sc, v1 = acc[ai][bj][m][1] * sc;
                    u32x4 w; w.x = cvt_pk_bf16(v0[0], v0[1]); w.y = cvt_pk_bf16(v0[2], v0[3]); w.z = cvt_pk_bf16(v1[0], v1[1]); w.w = cvt_pk_bf16(v1[2], v1[3]);
                    *(u32x4*)(rowp + bj * 128) = w; } }
    }
};
template <bool RES_BF16> struct EpiBf16Res {
    static constexpr bool PERM = true;
    const void* Rz; bf16* O; int ldc; float* RS; float ascale; unsigned char* O8;
    DI void operator()(const f32x4 (&acc)[2][2][4][2], const Unit& u, int wr, int wc, int fr, int fq) const {
        const int row0 = u.pm * 256 + wr * 64 + fr, col0 = u.pn * 256 + wc * 32 + 8 * fq;
#pragma unroll
        for (int ai = 0; ai < 2; ++ai) {
            u32x4 rwb[4][2]; f32x4 rf0[4][2], rf1[4][2];
#pragma unroll
            for (int m = 0; m < 4; ++m) { const size_t off = (size_t)(row0 + ai * 128 + m * 16) * ldc + col0;
#pragma unroll
                for (int bj = 0; bj < 2; ++bj) {
                    if (RES_BF16) rwb[m][bj] = *(const u32x4*)((const bf16*)Rz + off + bj * 128);
                    else { rf0[m][bj] = *(const f32x4*)((const float*)Rz + off + bj * 128); rf1[m][bj] = *(const f32x4*)((const float*)Rz + off + bj * 128 + 4); } } }
#pragma unroll
            for (int m = 0; m < 4; ++m) { const size_t off = (size_t)(row0 + ai * 128 + m * 16) * ldc + col0; float ssq = 0.f;
#pragma unroll
                for (int bj = 0; bj < 2; ++bj) { f32x4 r0, r1;
                    if (RES_BF16) { const u32x4 rw = rwb[m][bj]; r0 = (f32x4){bflo(rw.x), bfhi(rw.x), bflo(rw.y), bfhi(rw.y)}; r1 = (f32x4){bflo(rw.z), bfhi(rw.z), bflo(rw.w), bfhi(rw.w)}; }
                    else { r0 = rf0[m][bj]; r1 = rf1[m][bj]; }
                    const f32x4 v0 = r0 + acc[ai][bj][m][0] * ascale, v1 = r1 + acc[ai][bj][m][1] * ascale;
                    if (O8) { u32x2 w8; w8.x = pk4_fp8(v0[0], v0[1], v0[2], v0[3]); w8.y = pk4_fp8(v1[0], v1[1], v1[2], v1[3]); *(u32x2*)(O8 + off + bj * 128) = w8; }
                    ssq += (v0[0] * v0[0] + v0[1] * v0[1]) + (v0[2] * v0[2] + v0[3] * v0[3]) + (v1[0] * v1[0] + v1[1] * v1[1]) + (v1[2] * v1[2] + v1[3] * v1[3]);
                    u32x4 w; w.x = cvt_pk_bf16(v0[0], v0[1]); w.y = cvt_pk_bf16(v0[2], v0[3]); w.z = cvt_pk_bf16(v1[0], v1[1]); w.w = cvt_pk_bf16(v1[2], v1[3]);
                    *(u32x4*)(O + off + bj * 128) = w; }
                if (RS) { ssq += __shfl_xor(ssq, 16); ssq += __shfl_xor(ssq, 32); if (fq == 0) RS[(size_t)(row0 + ai * 128 + m * 16) * 16 + u.pn * 4 + wc] = ssq; } } }
    }
};
struct EpiLora {
    static constexpr bool PERM = false;
    float* LWp; bf16* AAp; bf16* GGp; const float* w0; const float* a0;
    DI void operator()(const f32x4 (&acc)[2][2][4][2], const Unit& u, int wr, int wc, int fr, int fq) const {
        const int kind = u.pn >> 1;
        const int row0 = u.pm * 256 + wr * 64 + fr, col0 = (u.pn & 1) * 256 + wc * 32 + 4 * fq;
#pragma unroll
        for (int bj = 0; bj < 2; ++bj)
#pragma unroll
            for (int n = 0; n < 2; ++n) {
                const int c = col0 + bj * 128 + n * 16;
                f32x4 bias = (f32x4){0.f, 0.f, 0.f, 0.f};
                if (kind == 0) bias = *(const f32x4*)(w0 + c); else if (kind == 1) bias = *(const f32x4*)(a0 + c);
#pragma unroll
                for (int ai = 0; ai < 2; ++ai)
#pragma unroll
                    for (int m = 0; m < 4; ++m) {
                        f32x4 v = acc[ai][bj][m][n] + bias;
                        if (kind == 0) {
#pragma unroll
                            for (int j = 0; j < 4; ++j) { const float w = -softplus_fast(-v[j]) - 0.5f; v[j] = -__expf(w);     }
                        } else if (kind == 1) {
#pragma unroll
                            for (int j = 0; j < 4; ++j) v[j] = sigmoid_f(v[j]);
                        }
                        const size_t o_ = (size_t)(row0 + ai * 128 + m * 16) * 512 + c;
                        if (kind == 0) *(f32x4*)(LWp + o_) = v;
                        else { u32x2 w_; w_.x = cvt_pk_bf16(v[0], v[1]); w_.y = cvt_pk_bf16(v[2], v[3]); *(u32x2*)((kind == 1 ? AAp : GGp) + o_) = w_; }
                    }
            }
    }
};
typedef float f32x2_t __attribute__((ext_vector_type(2)));
struct EpiSwiglu {
    static constexpr bool PERM = true;
    bf16* ACT; const float* b_gu;
    DI void operator()(const f32x4 (&acc)[2][2][4][2], const Unit& u, int wr, int wc, int fr, int fq) const {
        const int row0 = u.pm * 256 + wr * 64 + fr, j0 = u.pn * 128 + wc * 32 + 8 * fq;
        const float* bg = b_gu + (size_t)u.e * 2048 + j0; const float* bu = bg + 1024;
        const f32x4 bg0 = *(const f32x4*)bg, bg1 = *(const f32x4*)(bg + 4), bu0 = *(const f32x4*)bu, bu1 = *(const f32x4*)(bu + 4);
#pragma unroll
        for (int ai = 0; ai < 2; ++ai)
#pragma unroll
            for (int m = 0; m < 4; ++m) {
                float o[8];
#pragma unroll
                for (int n = 0; n < 2; ++n) { const f32x4 g4 = acc[ai][0][m][n] * 0.015625f + (n ? bg1 : bg0), u4 = acc[ai][1][m][n] * 0.015625f + (n ? bu1 : bu0);
#pragma unroll
                    for (int p = 0; p < 2; ++p) {
                        f32x2_t g, up; g.x = fminf(g4[2 * p], 7.0f); g.y = fminf(g4[2 * p + 1], 7.0f); up.x = fminf(fmaxf(u4[2 * p], -7.0f), 7.0f); up.y = fminf(fmaxf(u4[2 * p + 1], -7.0f), 7.0f);
                        const f32x2_t ex = g * (-1.702f * 1.44269504089f); f32x2_t d; d.x = __builtin_amdgcn_exp2f(ex.x); d.y = __builtin_amdgcn_exp2f(ex.y); d = d + 1.0f;
                        f32x2_t r; r.x = __builtin_amdgcn_rcpf(d.x); r.y = __builtin_amdgcn_rcpf(d.y);
                        const f32x2_t ov = (up + 1.0f) * (g * r); o[n * 4 + 2 * p] = ov.x; o[n * 4 + 2 * p + 1] = ov.y; } }
                u32x2 w; w.x = pk4_fp8(o[0], o[1], o[2], o[3]); w.y = pk4_fp8(o[4], o[5], o[6], o[7]);
                *(u32x2*)((unsigned char*)ACT + (size_t)(row0 + ai * 128 + m * 16) * 1024 + j0) = w;
            }
    }
};
struct EpiDown {
    static constexpr bool PERM = true;
    bf16* YS; const float* b_dn; const u32x2* row_sg;
    DI void operator()(const f32x4 (&acc)[2][2][4][2], const Unit& u, int wr, int wc, int fr, int fq) const {
        const int row0 = u.pm * 256 + wr * 64 + fr, col0 = u.pn * 256 + wc * 32 + 8 * fq;
        const float* bb = b_dn + (size_t)u.e * 1024 + col0;
        f32x4 bv[2][2];
#pragma unroll
        for (int bj = 0; bj < 2; ++bj)
#pragma unroll
            for (int n = 0; n < 2; ++n) bv[bj][n] = *(const f32x4*)(bb + bj * 128 + 4 * n);
        int slots[8]; float gts[8];
        { const u32x2* sgp = row_sg + row0;
#pragma unroll
        for (int q = 0; q < 8; ++q) { const u32x2 sg = sgp[(q >> 2) * 128 + (q & 3) * 16]; slots[q] = (int)sg.x; gts[q] = __uint_as_float(sg.y); } }
#pragma unroll
        for (int ai = 0; ai < 2; ++ai)
#pragma unroll
            for (int m = 0; m < 4; ++m) {
                const int slot = slots[ai * 4 + m]; const float gt = gts[ai * 4 + m];
                if (slot >= 0) { unsigned char* rowp = (unsigned char*)YS + (size_t)slot * 1024 + col0; const float g16 = gt * 16.0f;
#pragma unroll
                    for (int bj = 0; bj < 2; ++bj) { const f32x4 v0 = (acc[ai][bj][m][0] * 0.015625f + bv[bj][0]) * g16, v1 = (acc[ai][bj][m][1] * 0.015625f + bv[bj][1]) * g16;
                        u32x2 w; w.x = pk4_fp8(v0[0], v0[1], v0[2], v0[3]); w.y = pk4_fp8(v1[0], v1[1], v1[2], v1[3]);
                        *(u32x2*)(rowp + bj * 128) = w; } }
            }
    }
};

constexpr size_t MiB = 1u << 20;
constexpr size_t WS_CTL = 0, CTL_ZERO_BYTES = 1 * MiB;
constexpr size_t WS_WIN = 1 * MiB, WS_WOUT = 7 * MiB, WS_WQ = 9 * MiB, WS_WK = 11 * MiB, WS_WV = 13 * MiB, WS_WO = 15 * MiB, WS_LORAB = 17 * MiB, WS_LRUW = 18 * MiB;
constexpr size_t WS_ROUTE = 19 * MiB;
constexpr size_t WS_WGU = 22 * MiB, WS_WDN = 150 * MiB;
constexpr size_t WS_HN = 214 * MiB, WS_MEMN = 246 * MiB, WS_KM = 248 * MiB, WS_VT = 250 * MiB;
constexpr size_t WS_X1 = 252 * MiB, WS_X2 = 316 * MiB;
constexpr size_t WS_U = 380 * MiB, WS_R = 468 * MiB, WS_KRAW = 500 * MiB, WS_V = 532 * MiB, WS_KKN = 564 * MiB, WS_WD = 596 * MiB, WS_AA = 628 * MiB, WS_G = 660 * MiB;
constexpr size_t WS_LA = 692 * MiB, WS_LB = 724 * MiB, WS_AP = 756 * MiB, WS_CAT = 764 * MiB, WS_Q = 796 * MiB;
constexpr size_t WS_XS = 380 * MiB, WS_ACT = 524 * MiB, WS_YS = 668 * MiB;
constexpr size_t WS_GP = 796 * MiB, WS_HF = 860 * MiB, WS_RP = 924 * MiB, WS_Y1F = 940 * MiB, WS_ADD = 972 * MiB, WS_END = 1004 * MiB;
constexpr size_t WS_GC = 468 * MiB, WS_HC = 484 * MiB, WS_ZS = 500 * MiB;
static_assert(WS_AA == WS_WD + 32 * MiB && WS_G == WS_AA + 32 * MiB, "EpiLora strides");
static_assert(WS_U + (size_t)M * INW * 2 <= WS_R && WS_XS + (size_t)MAXROWS * 2048 <= WS_ACT && WS_ACT + (size_t)MAXROWS * 2048 <= WS_YS && WS_YS + (size_t)NASSIGN * 2048 <= WS_Q, "ws map");
constexpr size_t RT_E = 0, RT_POS = 256 * 1024, RT_G = 512 * 1024, RT_SLOT = 768 * 1024, RT_GATE = 1088 * 1024, RT_TILE = 1408 * 1024, RT_TOK = 1472 * 1024, RT_UGU = 1792 * 1024, RT_UDN = 1808 * 1024;
constexpr int CW_BAR = 4096, CW_CNT = 8192, CW_CONV = 12288;

constexpr int RING_BYTES = 131072, MISC_OFF = RING_BYTES + 320, LDS_BYTES = 147456;
constexpr int NWAVES = 8, NTHREADS = 512;
constexpr int CONV_P9 = 6144;
constexpr int CONV_P9D = 16384;

#define XB_TMO      128
#define XB_XCNT(j)  (256  + 64 * (j))
#define XB_XSUB(j)  (1280 + 64 * (j))
#define XB_XGEN(j)  (2304 + 64 * (j))
#define XB_TOP      3328
#define XB_TOPGEN   3392
#define XCD_BAR_WORDS 3456
#define XB_SPIN_CAP (1u << 18)
DI unsigned xb_ld(unsigned* p)              { return __hip_atomic_load(p, __ATOMIC_RELAXED, __HIP_MEMORY_SCOPE_AGENT); }
DI unsigned xb_add(unsigned* p, unsigned v) { return __hip_atomic_fetch_add(p, v, __ATOMIC_RELAXED, __HIP_MEMORY_SCOPE_AGENT); }
DI unsigned xb_xcc_id() { return (unsigned)__builtin_amdgcn_s_getreg((3 << 11) | 20) & 0xFu; }
#define XB_SPIN(cond, bar) do { unsigned _sp = 0; while (cond) { __builtin_amdgcn_s_sleep(1); \
    if ((++_sp & 255u) == 0u) { if (xb_ld(&(bar)[XB_TMO])) break; if (_sp > XB_SPIN_CAP) { atomicAdd(&(bar)[XB_TMO], 1u); break; } } } } while (0)
struct XcdBarrier { unsigned* bar; unsigned x; volatile LAS unsigned* st; int w0; };
DI XcdBarrier xcd_barrier_post(unsigned* bar, volatile LAS unsigned* st, int w0) {
    XcdBarrier b; b.bar = bar; b.x = xb_xcc_id(); b.st = st; b.w0 = w0;
    if (fresh_tid_(w0) == 0) (void)xb_add(&bar[XB_XCNT(b.x)], 1u);
    return b;
}
DI void xcd_barrier_complete(unsigned* bar, unsigned x, unsigned& nloc, unsigned& nx) {
    const unsigned G = gridDim.x * gridDim.y * gridDim.z;
    unsigned sum, cnt, mine, sp = 0u;
    for (;;) {
        sum = 0u; cnt = 0u; mine = 0u;
#pragma unroll
        for (unsigned j = 0; j < 16; ++j) { const unsigned c = xb_ld(&bar[XB_XCNT(j)]); sum += c; cnt += (c > 0u) ? 1u : 0u; mine = (j == x) ? c : mine; }
        if (sum == G) break;
        __builtin_amdgcn_s_sleep(1);
        if ((++sp & 255u) == 0u) { if (xb_ld(&bar[XB_TMO])) break; if (sp > XB_SPIN_CAP) { atomicAdd(&bar[XB_TMO], 1u); break; } }
    }
    nloc = mine > 0u ? mine : 1u; nx = cnt > 0u ? cnt : 1u;
}
DI void xcd_barrier(const XcdBarrier& b) {
    asm volatile("s_waitcnt vmcnt(0)" ::: "memory");
    __syncthreads();
    if (fresh_tid_(b.w0) == 0) {
        unsigned* bar = b.bar;
        __builtin_amdgcn_s_waitcnt(0);
        unsigned nloc = b.st[0], nx = b.st[1];
        if (nloc == 0u) { xcd_barrier_complete(bar, b.x, nloc, nx); b.st[0] = nloc; b.st[1] = nx; }
        const unsigned old = xb_add(&bar[XB_XSUB(b.x)], 1u);
        const unsigned gen = old / nloc;
        if (old + 1u == (gen + 1u) * nloc) {
            __builtin_amdgcn_fence(__ATOMIC_RELEASE, "agent");
            asm volatile("s_waitcnt vmcnt(0)" ::: "memory");
            const unsigned og = xb_add(&bar[XB_TOP], 1u);
            const unsigned tg = og / nx;
            if (og + 1u == (tg + 1u) * nx) xb_add(&bar[XB_TOPGEN], 1u);
            else XB_SPIN(xb_ld(&bar[XB_TOPGEN]) == tg, bar);
            __builtin_amdgcn_fence(__ATOMIC_ACQUIRE, "agent");
            xb_add(&bar[XB_XGEN(b.x)], 1u);
            asm volatile("s_waitcnt vmcnt(0)" ::: "memory");
        } else {
            XB_SPIN(xb_ld(&bar[XB_XGEN(b.x)]) == gen, bar);
            __builtin_amdgcn_fence(__ATOMIC_ACQUIRE, "agent");
            asm volatile("s_waitcnt vmcnt(0)" ::: "memory");
        }
    }
    __syncthreads();
}

struct Args { const float* in[37]; float* out; unsigned char* ws; int ph_lo, ph_hi; };
enum { I_X = 0, I_MEM, I_NMIXG, I_WIN, I_CONVW, I_CONVB, I_LWX, I_LBX, I_LWA, I_LBA, I_LAM, I_MU, I_W0, I_WUP, I_A0, I_AUP, I_GUP, I_KK, I_KA, I_RK, I_LNG, I_LNB,
       I_WOUT, I_NXAG, I_NMEMG, I_WQ, I_WK, I_WV, I_WO, I_NFFG, I_WR, I_BR, I_WGU, I_BGU, I_WDN, I_BDN, I_FNG };

DI void transpose_item(const float* W, int ldw, int K, bf16* WT, int k0, int n0, int drow0, LAS float* scr, int lane, const float* rs = nullptr) {
    f32x4 t[8];
    const float* src = W + (size_t)(k0 + (lane >> 3)) * ldw + n0 + 4 * (lane & 7);
#pragma unroll
    for (int i = 0; i < 8; ++i) t[i] = *(const f32x4*)(src + (size_t)(8 * i) * ldw);
#pragma unroll
    for (int i = 0; i < 8; ++i) { const float sc_ = rs ? rs[k0 + 8 * i + (lane >> 3)] : 1.0f; LAS float* d = scr + (8 * i + (lane >> 3)) * 33 + 4 * (lane & 7); d[0] = t[i].x * sc_; d[1] = t[i].y * sc_; d[2] = t[i].z * sc_; d[3] = t[i].w * sc_; }
    asm volatile("s_waitcnt lgkmcnt(0)" ::: "memory");
    const int c = lane & 7;
#pragma unroll
    for (int j = 0; j < 4; ++j) { const int n = (lane >> 3) + 8 * j; const LAS float* s = scr + (8 * c) * 33 + n;
        u32x4 o; o.x = pk2(s[0 * 33], s[1 * 33]); o.y = pk2(s[2 * 33], s[3 * 33]); o.z = pk2(s[4 * 33], s[5 * 33]); o.w = pk2(s[6 * 33], s[7 * 33]);
        *(u32x4*)(WT + (size_t)(drow0 + n) * K + k0 + 8 * c) = o; }
    asm volatile("s_waitcnt lgkmcnt(0)" ::: "memory");
}
DI void transpose_item_tiled(const float* W, int ldw, int K, bf16* WTe, int k0, int n0, int drow0, LAS float* scr, int lane) {
    f32x4 t[8];
    const float* src = W + (size_t)(k0 + (lane >> 3)) * ldw + n0 + 4 * (lane & 7);
#pragma unroll
    for (int i = 0; i < 8; ++i) t[i] = *(const f32x4*)(src + (size_t)(8 * i) * ldw);
#pragma unroll
    for (int i = 0; i < 8; ++i) { LAS float* d = scr + (8 * i + (lane >> 3)) * 33 + 4 * (lane & 7); d[0] = t[i].x; d[1] = t[i].y; d[2] = t[i].z; d[3] = t[i].w; }
    asm volatile("s_waitcnt lgkmcnt(0)" ::: "memory");
    const int c = lane & 7;
#pragma unroll
    for (int j = 0; j < 4; ++j) { const int n = (lane >> 3) + 8 * j; const LAS float* s = scr + (8 * c) * 33 + n;
        u32x4 o; o.x = pk2(s[0 * 33], s[1 * 33]); o.y = pk2(s[2 * 33], s[3 * 33]); o.z = pk2(s[4 * 33], s[5 * 33]); o.w = pk2(s[6 * 33], s[7 * 33]);
        const int drow = drow0 + n, pn = drow >> 8, half = (drow >> 7) & 1, r = drow & 127, x = r & 31;
        const int rslot = (r & ~31) + 16 * ((x >> 2) & 1) + 4 * (x >> 3) + (x & 3);
        const size_t tb = ((size_t)(pn * (K / 64) + (k0 >> 6)) * 2 + half) * 16384 + pg8::lds_byte(rslot, 8 * c);
        *(u32x4*)((char*)WTe + tb) = o; }
    asm volatile("s_waitcnt lgkmcnt(0)" ::: "memory");
}
DI void transpose_item_tiled_nolds(const float* W, int ldw, int K, bf16* WTe, int k0, int n0, int drow0, int lane) {
    const int n = lane & 31, kh = lane >> 5;
    const float* src = W + (size_t)(k0 + 32 * kh) * ldw + n0 + n;
    float t[32];
#pragma unroll
    for (int i = 0; i < 32; ++i) t[i] = src[(size_t)i * ldw];
    const int drow = drow0 + n, pn = drow >> 8, half = (drow >> 7) & 1, r = drow & 127, x = r & 31;
    const int rslot = (r & ~31) + 16 * ((x >> 2) & 1) + 4 * (x >> 3) + (x & 3);
    const size_t tb0 = ((size_t)(pn * (K / 64) + (k0 >> 6)) * 2 + half) * 16384;
#pragma unroll
    for (int c = 0; c < 4; ++c) { u32x4 o; o.x = pk2(t[8 * c], t[8 * c + 1]); o.y = pk2(t[8 * c + 2], t[8 * c + 3]); o.z = pk2(t[8 * c + 4], t[8 * c + 5]); o.w = pk2(t[8 * c + 6], t[8 * c + 7]);
        *(u32x4*)((char*)WTe + tb0 + pg8::lds_byte(rslot, 32 * kh + 8 * c)) = o; }
}
DI void transpose_item_tiled_fp8_nolds(const float* W, int ldw, int K, unsigned char* WTe, int k0, int n0, int drow0, int lane) {
    const int n = lane & 31, kh = lane >> 5;
    const float* src = W + (size_t)(k0 + 32 * kh) * ldw + n0 + n;
    float t[32];
#pragma unroll
    for (int i = 0; i < 32; ++i) t[i] = __builtin_nontemporal_load(src + (size_t)i * ldw) * 64.f;
    const int drow = drow0 + n, pn = drow >> 8, half = (drow >> 7) & 1, r = drow & 127, x = r & 31;
    const int rslot = (r & ~31) + 16 * ((x >> 2) & 1) + 4 * (x >> 3) + (x & 3);
    const size_t tb0 = ((size_t)(pn * (K / 128) + (k0 >> 7)) * 2 + half) * 16384;
#pragma unroll
    for (int c = 0; c < 2; ++c) { u32x4 o; o.x = pk4_fp8(t[16 * c], t[16 * c + 1], t[16 * c + 2], t[16 * c + 3]); o.y = pk4_fp8(t[16 * c + 4], t[16 * c + 5], t[16 * c + 6], t[16 * c + 7]);
        o.z = pk4_fp8(t[16 * c + 8], t[16 * c + 9], t[16 * c + 10], t[16 * c + 11]); o.w = pk4_fp8(t[16 * c + 12], t[16 * c + 13], t[16 * c + 14], t[16 * c + 15]);
        const int bc = (k0 & 64) + 32 * kh + 16 * c;
        *(u32x4*)(WTe + tb0 + pg8::lds_byte(rslot, bc >> 1)) = o; }
}
DI void transpose_item_tiled_fp8(const float* W, int ldw, int K, unsigned char* WTe, int k0, int n0, int drow0, LAS float* scr, int lane) {
    f32x4 t[8];
    const float* src = W + (size_t)(k0 + (lane >> 3)) * ldw + n0 + 4 * (lane & 7);
#pragma unroll
    for (int i = 0; i < 8; ++i) t[i] = __builtin_nontemporal_load((const f32x4*)(src + (size_t)(8 * i) * ldw));
#pragma unroll
    for (int i = 0; i < 8; ++i) { LAS float* d = scr + (8 * i + (lane >> 3)) * 33 + 4 * (lane & 7); d[0] = t[i].x * 64.f; d[1] = t[i].y * 64.f; d[2] = t[i].z * 64.f; d[3] = t[i].w * 64.f; }
    asm volatile("s_waitcnt lgkmcnt(0)" ::: "memory");
    const int c = lane & 3;
#pragma unroll
    for (int j = 0; j < 2; ++j) { const int n = (lane >> 2) + 16 * j; const LAS float* sp = scr + (16 * c) * 33 + n;
        u32x4 o; o.x = pk4_fp8(sp[0 * 33], sp[1 * 33], sp[2 * 33], sp[3 * 33]); o.y = pk4_fp8(sp[4 * 33], sp[5 * 33], sp[6 * 33], sp[7 * 33]);
        o.z = pk4_fp8(sp[8 * 33], sp[9 * 33], sp[10 * 33], sp[11 * 33]); o.w = pk4_fp8(sp[12 * 33], sp[13 * 33], sp[14 * 33], sp[15 * 33]);
        const int drow = drow0 + n, pn = drow >> 8, half = (drow >> 7) & 1, r = drow & 127, x = r & 31;
        const int rslot = (r & ~31) + 16 * ((x >> 2) & 1) + 4 * (x >> 3) + (x & 3);
        const int bc = (k0 & 64) + 16 * c;
        const size_t tb = ((size_t)(pn * (K / 128) + (k0 >> 7)) * 2 + half) * 16384 + pg8::lds_byte(rslot, bc >> 1);
        *(u32x4*)(WTe + tb) = o; }
    asm volatile("s_waitcnt lgkmcnt(0)" ::: "memory");
}
DI void rms_row_to_bf16(const float* xrow, const float* g, bf16* orow, int lane) {
    const f32x4* xr = (const f32x4*)xrow + lane; const f32x4* gr = (const f32x4*)g + lane;
    f32x4 v[4]; float s = 0.f;
#pragma unroll
    for (int j = 0; j < 4; ++j) { v[j] = xr[64 * j]; s += (v[j].x * v[j].x + v[j].y * v[j].y) + (v[j].z * v[j].z + v[j].w * v[j].w); }
    const float rstd = rsq_f(wave_sum(s) * (1.f / D) + EPS);
    u32x2* o8 = (u32x2*)orow + lane;
#pragma unroll
    for (int j = 0; j < 4; ++j) { const f32x4 gg = gr[64 * j]; u32x2 w; w.x = pk2(v[j].x * rstd * gg.x, v[j].y * rstd * gg.y); w.y = pk2(v[j].z * rstd * gg.z, v[j].w * rstd * gg.w); o8[64 * j] = w; }
}

DI void rms_rowbf_to_bf16(const bf16* xrow, const float* g, bf16* orow, int lane) {
    float v[16]; float s = 0.f;
#pragma unroll
    for (int hf = 0; hf < 2; ++hf) { const u32x4 w = *(const u32x4*)(xrow + 512 * hf + 8 * lane);
#pragma unroll
        for (int q = 0; q < 4; ++q) { v[8 * hf + 2 * q] = bflo(w[q]); v[8 * hf + 2 * q + 1] = bfhi(w[q]); } }
#pragma unroll
    for (int j = 0; j < 16; ++j) s += v[j] * v[j];
    const float rstd = rsq_f(wave_sum(s) * (1.f / D) + EPS);
#pragma unroll
    for (int hf = 0; hf < 2; ++hf) { const f32x4 g0 = *(const f32x4*)(g + 512 * hf + 8 * lane), g1 = *(const f32x4*)(g + 512 * hf + 8 * lane + 4);
        u32x4 w; w.x = pk2(v[8 * hf] * rstd * g0.x, v[8 * hf + 1] * rstd * g0.y); w.y = pk2(v[8 * hf + 2] * rstd * g0.z, v[8 * hf + 3] * rstd * g0.w);
        w.z = pk2(v[8 * hf + 4] * rstd * g1.x, v[8 * hf + 5] * rstd * g1.y); w.w = pk2(v[8 * hf + 6] * rstd * g1.z, v[8 * hf + 7] * rstd * g1.w);
        *(u32x4*)(orow + 512 * hf + 8 * lane) = w; }
}

__global__ void __launch_bounds__(NTHREADS, 2) fwd(Args args) {
    extern __shared__ __attribute__((aligned(16))) unsigned char lds_raw[];
    LAS unsigned char* lds = (LAS unsigned char*)lds_raw;
    volatile LAS unsigned* MISC = (volatile LAS unsigned*)(lds + MISC_OFF);
    const int G = gridDim.x, bid = blockIdx.x, NGW = G * NWAVES;
    const int wv0 = __builtin_amdgcn_readfirstlane((int)(threadIdx.x >> 6));
#define PHASE_IDS const int tid = fresh_tid(), lane = tid & 63, wave = __builtin_amdgcn_readfirstlane(tid >> 6), gw = bid * NWAVES + wave; (void)tid; (void)lane; (void)wave; (void)gw
    unsigned char* ws = args.ws;
    unsigned* ctl = (unsigned*)(ws + WS_CTL);
    const int lo = args.ph_lo, hi = args.ph_hi;

    for (int u = fresh_tid(); u < (LDS_BYTES - RING_BYTES) / 4; u += NTHREADS) ((LAS unsigned*)(lds + RING_BYTES))[u] = 0u;
    __syncthreads();
    XcdBarrier bar; bar.bar = ctl + CW_BAR; bar.x = 0; bar.st = nullptr; bar.w0 = wv0;
    if (hi - lo > 1) bar = xcd_barrier_post(ctl + CW_BAR, MISC + 8, wv0);
#define IN(k) (lo <= (k) && (k) < hi)
#define SEAM(k) do { if (IN(k) && IN((k) + 1)) xcd_barrier(bar); } while (0)

#define Win_t ((bf16*)(ws + WS_WIN))
#define Wout_t ((bf16*)(ws + WS_WOUT))
#define Wq_t ((bf16*)(ws + WS_WQ))
#define Wk_t ((bf16*)(ws + WS_WK))
#define Wv_t ((bf16*)(ws + WS_WV))
#define Wo_t ((bf16*)(ws + WS_WO))
#define LoraB ((bf16*)(ws + WS_LORAB))
#define LruW ((bf16*)(ws + WS_LRUW))
#define WrT ((bf16*)(ws + WS_LRUW + 512 * 1024))
#define Wgu_t ((bf16*)(ws + WS_WGU))
#define Wdn_t ((bf16*)(ws + WS_WDN))
#define HN ((bf16*)(ws + WS_HN))
#define MEMN ((bf16*)(ws + WS_MEMN))
#define KM ((bf16*)(ws + WS_KM))
#define VT ((bf16*)(ws + WS_VT))
#define X1 ((bf16*)(ws + WS_X1))
#define X2 ((bf16*)(ws + WS_X2))
#define U ((bf16*)(ws + WS_U))
#define Rr ((float*)(ws + WS_R))
#define KRAW ((float*)(ws + WS_KRAW))
#define Vv ((float*)(ws + WS_V))
#define KKN ((float*)(ws + WS_KKN))
#define WD ((float*)(ws + WS_WD))
#define AA ((float*)(ws + WS_AA))
#define GG ((float*)(ws + WS_G))
#define LA ((bf16*)(ws + WS_LA))
#define LB ((bf16*)(ws + WS_LB))
#define AP ((bf16*)(ws + WS_AP))
#define CAT ((bf16*)(ws + WS_CAT))
#define Qb ((bf16*)(ws + WS_Q))
#define Ob CAT
#define X1F8 ((unsigned char*)(ws + WS_XS))
#define XS ((bf16*)(ws + WS_XS))
#define ACT ((bf16*)(ws + WS_ACT))
#define YS ((bf16*)(ws + WS_YS))
#define route_e ((int*)(ws + WS_ROUTE + RT_E))
#define route_pos ((int*)(ws + WS_ROUTE + RT_POS))
#define route_g ((float*)(ws + WS_ROUTE + RT_G))
#define row_sg ((u32x2*)(ws + WS_ROUTE + RT_SLOT))
#define tile_tab ((int*)(ws + WS_ROUTE + RT_TILE))
#define row_tok ((int*)(ws + WS_ROUTE + RT_TOK))
#define ecnt (ctl + CW_CNT)

    if (IN(0)) { PHASE_IDS;
        LAS float* scr = (LAS float*)(lds + wave * 16384);
        constexpr int I_IN = 16 * (INW / 32), I_SQ = 16 * 32;
        constexpr int N_ITEMS = I_IN + 5 * I_SQ;
        for (int it = gw; it < N_ITEMS; it += NGW) {
            int r = it;
            if (r < I_IN) { const int nblk = INW / 32, kb = r / nblk, nb = r % nblk; transpose_item(args.in[I_WIN], INW, D, Win_t, 64 * kb, 32 * nb, 32 * nb, scr, lane); continue; } r -= I_IN;
            { const int w = r / I_SQ, q = r % I_SQ, kb = q / 32, nb = q % 32;
                if (w == 1) continue;
                const float* src = w == 0 ? args.in[I_WOUT] : w == 2 ? args.in[I_WK] : w == 3 ? args.in[I_WV] : args.in[I_WO];
                bf16* dst = w == 0 ? Wout_t : w == 2 ? Wk_t : w == 3 ? Wv_t : Wo_t;
                transpose_item(src, D, D, dst, 64 * kb, 32 * nb, 32 * nb, scr, lane); }
        }
        for (int idx = bid * NTHREADS + tid; idx < D * D / 4; idx += G * NTHREADS) { const f32x4 v = ((const f32x4*)args.in[I_WQ])[idx]; const float gk = args.in[I_NXAG][idx >> 8];
            u32x2 w; w.x = pk2(v.x * gk, v.y * gk); w.y = pk2(v.z * gk, v.w * gk); ((u32x2*)Wq_t)[idx] = w; }
        for (int idx = bid * NTHREADS + tid; idx < 1536 * 256; idx += G * NTHREADS) {
            const int e = idx & 7, ln = (idx >> 3) & 63, ks = (idx >> 9) & 7, ct = (idx >> 12) & 3, hk = idx >> 14, hh = hk / 3, kind = hk - 3 * hh;
            const int k = 32 * ks + 8 * (ln >> 4) + e, n = hh * 64 + 16 * ct + (ln & 15); float v = 0.f;
            if (kind == 0) { if (k < 64) v = args.in[I_WUP][k * 512 + n]; }
            else if (kind == 1) { if (k >= 64 && k < 128) v = args.in[I_AUP][(k - 64) * 512 + n]; }
            else { if (k >= 128) v = args.in[I_GUP][(k - 128) * 512 + n]; }
            LoraB[idx] = (bf16)f2bf(v);
        }
        for (int idx = bid * NTHREADS + tid; idx < 8 * 128 * 64; idx += G * NTHREADS) {
            const int nb = idx >> 13, col = (idx >> 6) & 127, k = idx & 63;
            const float v = col < 64 ? args.in[I_LWX][nb * 4096 + k * 64 + col] : args.in[I_LWA][nb * 4096 + k * 64 + (col - 64)];
            LruW[idx] = (bf16)f2bf(v);
        }
        for (int idx = bid * NTHREADS + tid; idx < NE * D; idx += G * NTHREADS) {
            const int e = idx >> 10, k = idx & 1023; const float v = args.in[I_WR][k * NE + e];
            const unsigned hi = f2bf(v); const float lo = v - __uint_as_float(hi << 16);
            WrT[idx] = (bf16)hi; WrT[NE * D + idx] = (bf16)f2bf(lo);
        }
        for (int m = gw; m < M; m += NGW) rms_row_to_bf16(args.in[I_X] + (size_t)m * D, args.in[I_NMIXG], HN + (size_t)m * D, lane);
        for (int m = gw; m < MROWS; m += NGW) rms_row_to_bf16(args.in[I_MEM] + (size_t)m * D, args.in[I_NMEMG], MEMN + (size_t)m * D, lane);
        {
            LAS float* scr = (LAS float*)(lds + wave * 16384);
            constexpr int I_GU = 16 * 64, I_DN = 16 * 32;
            for (int it = CONV_P9 + gw; it < NE * I_GU; it += NGW) {
                int r = it;
                if (r < NE * I_GU) { const int e = r / I_GU, q = r % I_GU, kb = q / 64, nb = q % 64; const int n0 = 32 * nb;
                    const int drow = n0 < 1024 ? (256 * (n0 >> 7) + (n0 & 127)) : (256 * ((n0 - 1024) >> 7) + 128 + ((n0 - 1024) & 127));
                    transpose_item_tiled_fp8(args.in[I_WGU] + (size_t)e * D * 2048, 2048, D, (unsigned char*)Wgu_t + (size_t)e * 2048 * D, 64 * kb, n0, drow, scr, lane); continue; } r -= NE * I_GU;
                { const int e = r / I_DN, q = r % I_DN, kb = q / 32, nb = q % 32;
                  transpose_item_tiled(args.in[I_WDN] + (size_t)e * DFF * D, D, DFF, Wdn_t + (size_t)e * D * DFF, 64 * kb, 32 * nb, 32 * nb, scr, lane); }
            }
        }
    }
    SEAM(0);

    if (IN(1)) { PHASE_IDS;
        { pg8::DenseSched S; S.o.init_tiles(M / 256, INW / 256, G, bid); S.A = (const char*)HN; S.B = (const char*)Win_t; S.tstep = (size_t)256 * D * 2;
          EpiBf16Plain E{U, INW, 1.0f}; pg8::gemm_phase(lds, D, S, E, wv0); }
        { pg8::DenseSched S; S.o.init_tiles(MROWS / 256, D / 256, G, (bid + 64) & (G - 1)); S.A = (const char*)MEMN; S.B = (const char*)Wk_t; S.tstep = (size_t)256 * D * 2;
          EpiBf16Plain E{KM, D, 1.0f}; pg8::gemm_phase(lds, D, S, E, wv0); }
        { pg8::DenseSched S; S.o.init_tiles(MROWS / 256, D / 256, G, (bid + 48) & (G - 1)); S.A = (const char*)MEMN; S.B = (const char*)Wv_t; S.tstep = (size_t)256 * D * 2;
          EpiBf16Plain E{VT, D, 1.0f}; pg8::gemm_phase(lds, D, S, E, wv0); }
    }
    SEAM(1);

    if (IN(2)) { PHASE_IDS;
        const float* conv_w = args.in[I_CONVW]; const float* conv_b = args.in[I_CONVB];
        LAS float* xs = (LAS float*)(lds + wave * 16384);
        LAS bf16* tP = (LAS bf16*)(lds + wave * 16384 + 4096); LAS bf16* tH = tP + 1024;
        const int i = lane & 15, kg = lane >> 4;
        for (int unit = gw; unit < (M / 64) * 8; unit += NGW) {
            const int seg = unit >> 3, nb = unit & 7, m0s = seg * 64, s0s = m0s & (SEQ - 1);
            bf16x8 wf[8][2];
#pragma unroll
            for (int ct = 0; ct < 8; ++ct)
#pragma unroll
                for (int ks = 0; ks < 2; ++ks) wf[ct][ks] = *(const bf16x8*)(LruW + ((size_t)(nb * 128 + 16 * ct + i) * 64 + 32 * ks + 8 * kg));
            float bxv[4], bav[4], spv[4], Arun[4], Brun[4];
#pragma unroll
            for (int ct = 0; ct < 4; ++ct) { const int ch = nb * 64 + 16 * ct + i; bxv[ct] = args.in[I_LBX][ch]; bav[ct] = args.in[I_LBA][ch]; spv[ct] = softplus_f(-args.in[I_LAM][ch]); Arun[ct] = 1.f; Brun[ct] = 0.f; }
#pragma unroll 1
            for (int jt = 0; jt < 4; ++jt) {
                const int m0 = m0s + 16 * jt, s0 = s0s + 16 * jt;
                bf16x8 af[2];
#pragma unroll
                for (int ks = 0; ks < 2; ++ks) {
                    const int chb = nb * 64 + 32 * ks + 8 * kg;
                    f32x4 x0 = *(const f32x4*)(conv_b + chb), x1 = *(const f32x4*)(conv_b + chb + 4);
#pragma unroll
                    for (int j = 0; j < 4; ++j) {
                        const bool ok = s0 + i - 3 + j >= 0;
                        u32x4 uw = *(const u32x4*)(U + (size_t)(ok ? m0 + i - 3 + j : m0) * INW + chb); if (!ok) uw = (u32x4){0u, 0u, 0u, 0u};
                        const f32x4 w0 = *(const f32x4*)(conv_w + j * 512 + chb), w1 = *(const f32x4*)(conv_w + j * 512 + chb + 4);
                        x0.x += w0.x * bflo(uw.x); x0.y += w0.y * bfhi(uw.x); x0.z += w0.z * bflo(uw.y); x0.w += w0.w * bfhi(uw.y);
                        x1.x += w1.x * bflo(uw.z); x1.y += w1.y * bfhi(uw.z); x1.z += w1.z * bflo(uw.w); x1.w += w1.w * bfhi(uw.w);
                    }
                    *(LAS f32x4*)(xs + i * 64 + 32 * ks + 8 * kg) = x0; *(LAS f32x4*)(xs + i * 64 + 32 * ks + 8 * kg + 4) = x1;
                    u32x4 p; p.x = pk2(x0.x, x0.y); p.y = pk2(x0.z, x0.w); p.z = pk2(x1.x, x1.y); p.w = pk2(x1.z, x1.w);
                    af[ks] = __builtin_bit_cast(bf16x8, p);
                }
                f32x4 acc[8];
#pragma unroll
                for (int ct = 0; ct < 8; ++ct) { acc[ct] = (f32x4){0.f, 0.f, 0.f, 0.f};
#pragma unroll
                    for (int ks = 0; ks < 2; ++ks) acc[ct] = __builtin_amdgcn_mfma_f32_16x16x32_bf16(af[ks], wf[ct][ks], acc[ct], 0, 0, 0); }
#pragma unroll
                for (int ct = 0; ct < 4; ++ct) {
                    const int col = 16 * ct + i;
                    float hl[4], pl[4]; float hprev = 0.f, pprev = 1.f;
#pragma unroll
                    for (int e = 0; e < 4; ++e) {
                        const float gx = sigmoid_f(acc[ct][e] + bxv[ct]), ga = sigmoid_f(acc[ct + 4][e] + bav[ct]);
                        const float la = -8.0f * ga * spv[ct], av = __expf(la), xcv = xs[(4 * kg + e) * 64 + col];
                        const float bt = __builtin_amdgcn_sqrtf(fmaxf(1.0f - av * av, 0.f)) * gx * xcv;
                        hprev = av * hprev + bt; pprev *= av; hl[e] = hprev; pl[e] = pprev;
                    }
                    float Ag[4], Bg[4];
#pragma unroll
                    for (int gq = 0; gq < 4; ++gq) { Ag[gq] = __shfl(pl[3], i + 16 * gq); Bg[gq] = __shfl(hl[3], i + 16 * gq); }
                    float Ain = Arun[ct], Bin = Brun[ct];
#pragma unroll
                    for (int gq = 0; gq < 3; ++gq) if (gq < kg) { Bin = Ag[gq] * Bin + Bg[gq]; Ain *= Ag[gq]; }
                    float At = 1.f, Bt = 0.f;
#pragma unroll
                    for (int gq = 0; gq < 4; ++gq) { Bt = Ag[gq] * Bt + Bg[gq]; At *= Ag[gq]; }
                    Brun[ct] = At * Brun[ct] + Bt; Arun[ct] *= At;
#pragma unroll
                    for (int e = 0; e < 4; ++e) { const int ti_ = (4 * kg + e) * 64 + col; tP[ti_] = (bf16)f2bf(pl[e] * Ain); tH[ti_] = (bf16)f2bf(hl[e] + pl[e] * Bin); }
                }
                { const int rr = lane >> 2, cq = lane & 3;
                  bf16* pp = LA + (size_t)(m0 + rr) * 512 + nb * 64 + 16 * cq; bf16* hp = LB + (size_t)(m0 + rr) * 512 + nb * 64 + 16 * cq;
                  *(u32x4*)pp = *(const LAS u32x4*)(tP + rr * 64 + 16 * cq); *(u32x4*)(pp + 8) = *(const LAS u32x4*)(tP + rr * 64 + 16 * cq + 8);
                  *(u32x4*)hp = *(const LAS u32x4*)(tH + rr * 64 + 16 * cq); *(u32x4*)(hp + 8) = *(const LAS u32x4*)(tH + rr * 64 + 16 * cq + 8); }
            }
            if (kg == 0) {
#pragma unroll
                for (int ct = 0; ct < 4; ++ct) { f32x2 ab; ab.x = Arun[ct]; ab.y = Brun[ct];
                    *(f32x2*)((float*)(ws + WS_AP) + ((size_t)(((seg >> 6) * 8 + nb) * 64 + (seg & 63)) * 64 + 16 * ct + i) * 2) = ab; }
            }
        }
    }
    SEAM(2);


#define RW_ZB(zz, zb) do { _Pragma("unroll") for (int ks_ = 0; ks_ < 2; ++ks_) { u32x4 p_; p_.x = pk2(zz[2 * ks_][0], zz[2 * ks_][1]); p_.y = pk2(zz[2 * ks_][2], zz[2 * ks_][3]); \
        p_.z = pk2(zz[2 * ks_ + 1][0], zz[2 * ks_ + 1][1]); p_.w = pk2(zz[2 * ks_ + 1][2], zz[2 * ks_ + 1][3]); zb[ks_] = __builtin_bit_cast(bf16x8, p_); } } while (0)
    if (IN(3)) { PHASE_IDS;
        for (int u64 = gw; u64 < NB * NH * (SEQ / 64); u64 += NGW) {
#pragma unroll 1
        for (int jj = 0; jj < 4; ++jj) {
        LAS unsigned char* wl = lds + wave * 16384;
        LAS bf16* Arm = (LAS bf16*)(wl); LAS bf16* Brm = (LAS bf16*)(wl + 2048); LAS bf16* Krm = (LAS bf16*)(wl + 4096); LAS bf16* Rrm = (LAS bf16*)(wl + 6144);
        LAS bf16* ATt = (LAS bf16*)(wl + 8192); LAS bf16* BTt = (LAS bf16*)(wl + 10240); LAS bf16* KTt = (LAS bf16*)(wl + 12288); LAS bf16* VTt = (LAS bf16*)(wl + 14336);
        LAS float* MabT = (LAS float*)(wl); LAS bf16* Mak = (LAS bf16*)(wl + 1024); LAS bf16* Mrb = (LAS bf16*)(wl + 1536); LAS bf16* Mrk = (LAS bf16*)(wl + 2048); LAS bf16* Tm = (LAS bf16*)(wl + 2560);
        LAS float* PLs = (LAS float*)(wl + 3072); LAS bf16* Q0T = (LAS bf16*)(wl + 4096);
        const int lane = fresh_tid() & 63, l15 = lane & 15, g = lane >> 4, te = lane >> 2, kq = lane & 3;
        const bf16x8 z8 = (bf16x8){0, 0, 0, 0, 0, 0, 0, 0};
        const f32x4 z4 = (f32x4){0.f, 0.f, 0.f, 0.f};
            const int un = u64 * 4 + jj;
            const int bh = un >> 8, c = un & 255, b = bh >> 3, h = bh & 7;
            const size_t mrow = (size_t)b * SEQ + c * 16 + te, off = mrow * 512 + h * 64 + 16 * kq;
            const int hc = h * 64 + 16 * kq;
            LAS float* tmpL = (LAS float*)wl;
            {
                const int rsub = lane >> 5, chunk = lane & 31; const size_t mt0 = (size_t)b * SEQ + c * 16;
                const f32x4 m0 = *(const f32x4*)(args.in[I_MU] + 1536 + 8 * chunk), m1 = *(const f32x4*)(args.in[I_MU] + 1536 + 8 * chunk + 4);
                u32x4 cu[8], pu[8];
#pragma unroll
                for (int i = 0; i < 8; ++i) { const size_t mr = mt0 + 2 * i + rsub; const bool hp2 = (mr & (SEQ - 1)) != 0; const bf16* ua = U + mr * INW + 2560 + 8 * chunk;
                    cu[i] = *(const u32x4*)ua; pu[i] = *(const u32x4*)(ua - (hp2 ? INW : 0)); if (!hp2) pu[i] = (u32x4){0u, 0u, 0u, 0u}; }
#pragma unroll
                for (int i = 0; i < 8; ++i) { float o8[8];
#pragma unroll
                    for (int q = 0; q < 4; ++q) { const float c0 = bflo(cu[i][q]), c1 = bfhi(cu[i][q]), p0 = bflo(pu[i][q]), p1 = bfhi(pu[i][q]); const float mm0 = q < 2 ? m0[2 * q] : m1[2 * q - 4], mm1 = q < 2 ? m0[2 * q + 1] : m1[2 * q - 3];
                        float x0 = c0 + (p0 - c0) * mm0, x1 = c1 + (p1 - c1) * mm1;
                        if (chunk < 8) { x0 = tanh_fast(x0); x1 = tanh_fast(x1); }
                        else if (chunk >= 16) { x0 = sigmoid_f(x0); x1 = sigmoid_f(x1); }
                        o8[2 * q] = x0; o8[2 * q + 1] = x1; }
                    u32x4 pw; pw.x = pk2(o8[0], o8[1]); pw.y = pk2(o8[2], o8[3]); pw.z = pk2(o8[4], o8[5]); pw.w = pk2(o8[6], o8[7]);
                    const int row = 2 * i + rsub; *(LAS u32x4*)(wl + row * 512 + ((chunk ^ (row & 7)) << 4)) = pw; }
                bf16x8 af[8];
#pragma unroll
                for (int ks = 0; ks < 8; ++ks) af[ks] = *(const LAS bf16x8*)(wl + l15 * 512 + (((4 * ks + g) ^ (l15 & 7)) << 4));
                asm volatile("s_waitcnt lgkmcnt(0)" ::: "memory");
#pragma unroll
                for (int kind = 0; kind < 3; ++kind)
#pragma unroll
                    for (int ct = 0; ct < 4; ++ct) {
                        const bf16* lb = LoraB + ((size_t)((h * 3 + kind) * 4 + ct) * 8 * 64 + lane) * 8;
                        f32x4 a4 = z4;
#pragma unroll
                        for (int ks = (kind == 0 ? 0 : kind == 1 ? 2 : 4); ks < (kind == 0 ? 2 : kind == 1 ? 4 : 8); ++ks) a4 = __builtin_amdgcn_mfma_f32_16x16x32_bf16(af[ks], *(const bf16x8*)(lb + ks * 512), a4, 0, 0, 0);
#pragma unroll
                        for (int e = 0; e < 4; ++e) tmpL[kind * 1088 + (4 * g + e) * 68 + 16 * ct + l15] = a4[e];
                    }
            }
            asm volatile("s_waitcnt lgkmcnt(0)" ::: "memory");
            float cl[16], eP[16];
            {
                float lwv[16], rl[16], kl[16], vl[16], kn[16], av[16];
                const bool hp = (mrow & (SEQ - 1)) != 0;
                const bf16* ub = U + mrow * INW + 1024 + hc;
#pragma unroll
                for (int hh = 0; hh < 2; ++hh) {
#pragma unroll
                    for (int a3 = 0; a3 < 3; ++a3) {
                        const u32x4 cu = *(const u32x4*)(ub + 512 * a3 + 8 * hh); u32x4 pu = *(const u32x4*)(ub - (hp ? INW : 0) + 512 * a3 + 8 * hh); if (!hp) pu = (u32x4){0u, 0u, 0u, 0u};
                        const f32x4 m0 = *(const f32x4*)(args.in[I_MU] + 512 * a3 + hc + 8 * hh), m1 = *(const f32x4*)(args.in[I_MU] + 512 * a3 + hc + 8 * hh + 4);
                        float o8[8];
#pragma unroll
                        for (int q = 0; q < 4; ++q) { const float c0 = bflo(cu[q]), c1 = bfhi(cu[q]), p0 = bflo(pu[q]), p1 = bfhi(pu[q]); const float mm0 = q < 2 ? m0[2 * q] : m1[2 * q - 4], mm1 = q < 2 ? m0[2 * q + 1] : m1[2 * q - 3];
                            o8[2 * q] = c0 + (p0 - c0) * mm0; o8[2 * q + 1] = c1 + (p1 - c1) * mm1; }
#pragma unroll
                        for (int q = 0; q < 8; ++q) { if (a3 == 0) rl[8 * hh + q] = o8[q]; else if (a3 == 1) kl[8 * hh + q] = o8[q]; else vl[8 * hh + q] = o8[q]; }
                    }
                }
                float gv[16];
#pragma unroll
                for (int j4 = 0; j4 < 4; ++j4) { const f32x4 xl = *(const LAS f32x4*)(tmpL + te * 68 + 16 * kq + 4 * j4), xa = *(const LAS f32x4*)(tmpL + 1088 + te * 68 + 16 * kq + 4 * j4), xg = *(const LAS f32x4*)(tmpL + 2176 + te * 68 + 16 * kq + 4 * j4);
                    const f32x4 w0v = *(const f32x4*)(args.in[I_W0] + hc + 4 * j4), a0v = *(const f32x4*)(args.in[I_A0] + hc + 4 * j4);
#pragma unroll
                    for (int q = 0; q < 4; ++q) { const float wq = -softplus_fast(-(xl[q] + w0v[q])) - 0.5f; lwv[4 * j4 + q] = -__expf(wq); av[4 * j4 + q] = sigmoid_f(xa[q] + a0v[q]); gv[4 * j4 + q] = xg[q]; } }
                asm volatile("s_waitcnt lgkmcnt(0)" ::: "memory");
                float ss = 0.f;
#pragma unroll
                for (int j4 = 0; j4 < 4; ++j4) { const f32x4 kk4 = *(const f32x4*)(args.in[I_KK] + hc + 4 * j4);
#pragma unroll
                    for (int q = 0; q < 4; ++q) { kn[4 * j4 + q] = kl[4 * j4 + q] * kk4[q]; ss += kn[4 * j4 + q] * kn[4 * j4 + q]; } }
                ss += __shfl_xor(ss, 1); ss += __shfl_xor(ss, 2);
                const float kinv = rsq_f(fmaxf(ss, 1e-24f));
#pragma unroll
                for (int j = 0; j < 16; ++j) { float x = lwv[j];
#pragma unroll
                    for (int sft = 4; sft < 64; sft <<= 1) { const float y = __shfl_up(x, sft); if (lane >= sft) x += y; }
                    cl[j] = x; }
                float bon = 0.f;
                u32x4 pa[2], pb[2], pk[2], pr[2];
#pragma unroll
                for (int j4 = 0; j4 < 4; ++j4) {
                    const f32x4 ka = *(const f32x4*)(args.in[I_KA] + hc + 4 * j4), rk = *(const f32x4*)(args.in[I_RK] + hc + 4 * j4);
                    float at4[4], bt4[4], kt4[4], rt4[4];
#pragma unroll
                    for (int q = 0; q < 4; ++q) { const int j = 4 * j4 + q;
                        const float p = __expf(cl[j]), pn = __expf(-cl[j]), pm1 = __expf(cl[j] - lwv[j]); eP[j] = p;
                        const float knj = kn[j] * kinv;
                        const float kp = kl[j] * (1.0f + (av[j] - 1.0f) * ka[q]);
                        at4[q] = -knj * pm1; bt4[q] = knj * av[j] * pn; kt4[q] = kp * pn; rt4[q] = rl[j] * p;
                        bon += rl[j] * kp * rk[q];
                        const int kk = 16 * kq + j;
                        ATt[kk * 16 + te] = (bf16)f2bf(at4[q]); BTt[kk * 16 + te] = (bf16)f2bf(bt4[q]); KTt[kk * 16 + te] = (bf16)f2bf(kt4[q]); VTt[kk * 16 + te] = (bf16)f2bf(vl[j]); }
                    const int hh = j4 >> 1, w2 = (j4 & 1) * 2;
                    pa[hh][w2] = pk2(at4[0], at4[1]); pa[hh][w2 + 1] = pk2(at4[2], at4[3]); pb[hh][w2] = pk2(bt4[0], bt4[1]); pb[hh][w2 + 1] = pk2(bt4[2], bt4[3]);
                    pk[hh][w2] = pk2(kt4[0], kt4[1]); pk[hh][w2 + 1] = pk2(kt4[2], kt4[3]); pr[hh][w2] = pk2(rt4[0], rt4[1]); pr[hh][w2 + 1] = pk2(rt4[2], rt4[3]);
                }
#pragma unroll
                for (int hh = 0; hh < 2; ++hh) { const int po = te * 64 + 8 * ((2 * kq + hh) ^ (te & 7));
                    *(LAS u32x4*)(Arm + po) = pa[hh]; *(LAS u32x4*)(Brm + po) = pb[hh]; *(LAS u32x4*)(Krm + po) = pk[hh]; *(LAS u32x4*)(Rrm + po) = pr[hh]; }
                bon += __shfl_xor(bon, 1); bon += __shfl_xor(bon, 2);
                f32x4 lbv[4], lgv[4];
#pragma unroll
                for (int j4 = 0; j4 < 4; ++j4) { lbv[j4] = *(const f32x4*)(args.in[I_LNB] + hc + 4 * j4); lgv[j4] = *(const f32x4*)(args.in[I_LNG] + hc + 4 * j4); }
#pragma unroll
                for (int j4 = 0; j4 < 4; ++j4) { const f32x4 lb = lbv[j4], lgn = lgv[j4]; const int j0 = 4 * j4;
                    u32x2 ow, gw2; ow.x = pk2((lb.x + vl[j0] * bon) * gv[j0], (lb.y + vl[j0 + 1] * bon) * gv[j0 + 1]); ow.y = pk2((lb.z + vl[j0 + 2] * bon) * gv[j0 + 2], (lb.w + vl[j0 + 3] * bon) * gv[j0 + 3]);
                    gw2.x = pk2(lgn.x * gv[j0], lgn.y * gv[j0 + 1]); gw2.y = pk2(lgn.z * gv[j0 + 2], lgn.w * gv[j0 + 3]);
                    *(u32x2*)((bf16*)(ws + WS_ADD) + off + j0) = ow; *(u32x2*)((bf16*)(ws + WS_G) + off + j0) = gw2; }
            }
            asm volatile("s_waitcnt lgkmcnt(0)" ::: "memory");
            {
                bf16x8 fa[2], fr[2], fb[2], fk[2];
#pragma unroll
                for (int ks = 0; ks < 2; ++ks) { const int po = l15 * 64 + 8 * ((4 * ks + g) ^ (l15 & 7));
                    fa[ks] = *(const LAS bf16x8*)(Arm + po); fr[ks] = *(const LAS bf16x8*)(Rrm + po); fb[ks] = *(const LAS bf16x8*)(Brm + po); fk[ks] = *(const LAS bf16x8*)(Krm + po); }
                f32x4 mab = z4, mak = z4, mrb = z4, mrk = z4;
#pragma unroll
                for (int ks = 0; ks < 2; ++ks) { mab = __builtin_amdgcn_mfma_f32_16x16x32_bf16(fb[ks], fa[ks], mab, 0, 0, 0); mak = __builtin_amdgcn_mfma_f32_16x16x32_bf16(fk[ks], fa[ks], mak, 0, 0, 0);
                    mrb = __builtin_amdgcn_mfma_f32_16x16x32_bf16(fb[ks], fr[ks], mrb, 0, 0, 0); mrk = __builtin_amdgcn_mfma_f32_16x16x32_bf16(fk[ks], fr[ks], mrk, 0, 0, 0); }
#pragma unroll
                for (int e = 0; e < 4; ++e) { const int i = 4 * g + e; if (!(i < l15)) { mab[e] = 0.f; mak[e] = 0.f; } if (!(i <= l15)) { mrb[e] = 0.f; mrk[e] = 0.f; } }
                asm volatile("s_waitcnt lgkmcnt(0)" ::: "memory");
#pragma unroll
                for (int e = 0; e < 4; ++e) MabT[(4 * g + e) * 16 + l15] = mab[e];
                u32x2 w; w.x = pk2(mak[0], mak[1]); w.y = pk2(mak[2], mak[3]); *(LAS u32x2*)(Mak + l15 * 16 + 4 * g) = w;
                w.x = pk2(mrb[0], mrb[1]); w.y = pk2(mrb[2], mrb[3]); *(LAS u32x2*)(Mrb + l15 * 16 + 4 * g) = w;
                w.x = pk2(mrk[0], mrk[1]); w.y = pk2(mrk[2], mrk[3]); *(LAS u32x2*)(Mrk + l15 * 16 + 4 * g) = w;
                if (te == 15) {
#pragma unroll
                    for (int j = 0; j < 16; ++j) PLs[16 * kq + j] = eP[j]; }
            }
            asm volatile("s_waitcnt lgkmcnt(0)" ::: "memory");
            {
                f32x4 mq[15][4];
#pragma unroll
                for (int j = 0; j < 15; ++j)
#pragma unroll
                    for (int q = 0; q < 4; ++q) if (4 * q + 3 > j) mq[j][q] = *(const LAS f32x4*)(MabT + j * 16 + 4 * q);
                float y[16];
#pragma unroll
                for (int j = 15; j >= 0; --j) {
                    float acc = (j == l15) ? 1.0f : 0.0f;
#pragma unroll
                    for (int i = j + 1; i < 16; ++i) acc += y[i] * mq[j < 15 ? j : 0][i >> 2][i & 3];
                    y[j] = acc;
                }
                if (g == 0) { u32x4 t0, t1; t0.x = pk2(y[0], y[1]); t0.y = pk2(y[2], y[3]); t0.z = pk2(y[4], y[5]); t0.w = pk2(y[6], y[7]); t1.x = pk2(y[8], y[9]); t1.y = pk2(y[10], y[11]); t1.z = pk2(y[12], y[13]); t1.w = pk2(y[14], y[15]);
                    *(LAS u32x4*)(Tm + l15 * 16) = t0; *(LAS u32x4*)(Tm + l15 * 16 + 8) = t1; }
            }
            asm volatile("s_waitcnt lgkmcnt(0)" ::: "memory");
            {
                const bool act = g < 2; const int fo = l15 * 16 + 8 * g;
                const bf16x8 fT = act ? *(const LAS bf16x8*)(Tm + fo) : z8, fMak = act ? *(const LAS bf16x8*)(Mak + fo) : z8, fMrb = act ? *(const LAS bf16x8*)(Mrb + fo) : z8, fMrk = act ? *(const LAS bf16x8*)(Mrk + fo) : z8;
                bf16x8 fV[4], fQ1[4], fAh[4], fBT[4], fKT[4];
#pragma unroll
                for (int vt = 0; vt < 4; ++vt) { fV[vt] = act ? *(const LAS bf16x8*)(VTt + vt * 256 + fo) : z8; fBT[vt] = act ? *(const LAS bf16x8*)(BTt + vt * 256 + fo) : z8; fKT[vt] = act ? *(const LAS bf16x8*)(KTt + vt * 256 + fo) : z8; }
#pragma unroll
                for (int vt = 0; vt < 4; ++vt) { const f32x4 q0 = __builtin_amdgcn_mfma_f32_16x16x32_bf16(fMak, fV[vt], z4, 0, 0, 0);
                    u32x2 w; w.x = pk2(q0[0], q0[1]); w.y = pk2(q0[2], q0[3]); *(LAS u32x2*)(Q0T + vt * 256 + l15 * 16 + 4 * g) = w; }
#pragma unroll
                for (int kt = 0; kt < 4; ++kt) { const bf16x8 fA = act ? *(const LAS bf16x8*)(ATt + kt * 256 + fo) : z8; const f32x4 ah = __builtin_amdgcn_mfma_f32_16x16x32_bf16(fT, fA, z4, 0, 0, 0);
                    u32x2 w; w.x = pk2(ah[0], ah[1]); w.y = pk2(ah[2], ah[3]); *(LAS u32x2*)(ATt + kt * 256 + l15 * 16 + 4 * g) = w; }
                asm volatile("s_waitcnt lgkmcnt(0)" ::: "memory");
#pragma unroll
                for (int vt = 0; vt < 4; ++vt) { const bf16x8 fQ0 = act ? *(const LAS bf16x8*)(Q0T + vt * 256 + fo) : z8; const f32x4 q1 = __builtin_amdgcn_mfma_f32_16x16x32_bf16(fT, fQ0, z4, 0, 0, 0);
                    u32x2 w; w.x = pk2(q1[0], q1[1]); w.y = pk2(q1[2], q1[3]); *(LAS u32x2*)(Q0T + vt * 256 + l15 * 16 + 4 * g) = w; }
                asm volatile("s_waitcnt lgkmcnt(0)" ::: "memory");
#pragma unroll
                for (int vt = 0; vt < 4; ++vt) { fQ1[vt] = act ? *(const LAS bf16x8*)(Q0T + vt * 256 + fo) : z8; fAh[vt] = act ? *(const LAS bf16x8*)(ATt + vt * 256 + fo) : z8; }
                bf16* rp = (bf16*)(ws + WS_RP) + (size_t)un * 1024 + l15 * 64;
#pragma unroll
                for (int kt = 0; kt < 4; ++kt) {
                    const u32x2 rr = *(const LAS u32x2*)(Rrm + l15 * 64 + 8 * ((2 * kt + (g >> 1)) ^ (l15 & 7)) + 4 * (g & 1));
                    f32x4 ini; ini[0] = bflo(rr.x); ini[1] = bfhi(rr.x); ini[2] = bflo(rr.y); ini[3] = bfhi(rr.y);
                    const f32x4 rh = __builtin_amdgcn_mfma_f32_16x16x32_bf16(fAh[kt], fMrb, ini, 0, 0, 0);
                    u32x2 w; w.x = pk2(rh[0], rh[1]); w.y = pk2(rh[2], rh[3]); *(u32x2*)(rp + 32 * (kt >> 1) + 8 * g + 4 * (kt & 1)) = w;
                }
#pragma unroll
                for (int vt = 0; vt < 4; ++vt) { f32x4 y1 = __builtin_amdgcn_mfma_f32_16x16x32_bf16(fMrb, fQ1[vt], z4, 0, 0, 0); y1 = __builtin_amdgcn_mfma_f32_16x16x32_bf16(fMrk, fV[vt], y1, 0, 0, 0);
                    *(f32x4*)((float*)(ws + WS_Y1F) + ((size_t)(un * 4 + vt) * 64 + lane) * 4) = y1; }
                LAS bf16* tgs = (LAS bf16*)(wl + 8192);
#pragma unroll
                for (int krt = 0; krt < 4; ++krt) { const float pl = PLs[16 * krt + l15];
#pragma unroll
                    for (int kct = 0; kct < 4; ++kct) { f32x4 ga = __builtin_amdgcn_mfma_f32_16x16x32_bf16(fAh[kct], fBT[krt], z4, 0, 0, 0);
                        if (kct == krt) {
#pragma unroll
                            for (int e = 0; e < 4; ++e) if (4 * g + e == l15) ga[e] += 1.0f; }
                        u32x2 w; w.x = pk2(ga[0] * pl, ga[1] * pl); w.y = pk2(ga[2] * pl, ga[3] * pl);
                        *(LAS u32x2*)(tgs + (16 * krt + l15) * 64 + 32 * (kct >> 1) + 8 * g + 4 * (kct & 1)) = w; } }
                { u32x4* gp16 = (u32x4*)((bf16*)(ws + WS_GP) + (size_t)un * 4096);
#pragma unroll
                  for (int i = 0; i < 8; ++i) gp16[i * 64 + lane] = *(const LAS u32x4*)(tgs + (i * 64 + lane) * 8); }
#pragma unroll
                for (int mt = 0; mt < 4; ++mt) { const f32x4 pl4 = *(const LAS f32x4*)(PLs + 16 * mt + 4 * g);
#pragma unroll
                    for (int vt = 0; vt < 4; ++vt) { f32x4 ha = __builtin_amdgcn_mfma_f32_16x16x32_bf16(fBT[mt], fQ1[vt], z4, 0, 0, 0); ha = __builtin_amdgcn_mfma_f32_16x16x32_bf16(fKT[mt], fV[vt], ha, 0, 0, 0);
                        u32x2 w; w.x = pk2(ha[0] * pl4[0], ha[1] * pl4[1]); w.y = pk2(ha[2] * pl4[2], ha[3] * pl4[3]);
                        *(u32x2*)((bf16*)(ws + WS_HF) + ((size_t)((un * 4 + vt) * 4 + mt) * 64 + lane) * 4) = w; } }
            }
            asm volatile("s_waitcnt lgkmcnt(0)" ::: "memory");
        }
        asm volatile("s_waitcnt vmcnt(0)" ::: "memory");
        { const int ltid = fresh_tid() & 63, l15 = ltid & 15, g = ltid >> 4, lane = ltid;
#define CP_LOADG(gf_, j_) do { const bf16* gp_ = (const bf16*)(ws + WS_GP) + ((size_t)u64 * 4 + (j_)) * 4096 + l15 * 64 + 8 * g; \
            _Pragma("unroll") for (int mt = 0; mt < 4; ++mt) { gf_[mt][0] = *(const bf16x8*)(gp_ + mt * 1024); gf_[mt][1] = *(const bf16x8*)(gp_ + mt * 1024 + 32); } } while (0)
#define CP_LOADH(hf_, j_) do { _Pragma("unroll") for (int sl = 0; sl < 4; ++sl) _Pragma("unroll") for (int mt = 0; mt < 4; ++mt) \
            hf_[sl][mt] = *(const u32x2*)((const bf16*)(ws + WS_HF) + ((size_t)((((size_t)u64 * 4 + (j_)) * 4 + sl) * 4 + mt) * 64 + lane) * 4); } while (0)
#define CP_STEP(gf_, hf_, useh_) do { _Pragma("unroll") for (int sl = 0; sl < 4; ++sl) { bf16x8 zb[2]; RW_ZB(z[sl], zb); \
            _Pragma("unroll") for (int mt = 0; mt < 4; ++mt) { f32x4 a_ = (f32x4){0.f, 0.f, 0.f, 0.f}; \
                if (useh_) { a_[0] = bflo(hf_[sl][mt].x); a_[1] = bfhi(hf_[sl][mt].x); a_[2] = bflo(hf_[sl][mt].y); a_[3] = bfhi(hf_[sl][mt].y); } \
                a_ = __builtin_amdgcn_mfma_f32_16x16x32_bf16(gf_[mt][0], zb[0], a_, 0, 0, 0); a_ = __builtin_amdgcn_mfma_f32_16x16x32_bf16(gf_[mt][1], zb[1], a_, 0, 0, 0); z[sl][mt] = a_; } } } while (0)
        {
            f32x4 z[4][4];
#pragma unroll
            for (int sl = 0; sl < 4; ++sl)
#pragma unroll
                for (int mt = 0; mt < 4; ++mt)
#pragma unroll
                    for (int e = 0; e < 4; ++e) z[sl][mt][e] = (sl == mt && 4 * g + e == l15) ? 1.0f : 0.0f;
            bf16x8 gA[4][2], gB[4][2]; u32x2 hdum[4][4];
            CP_LOADG(gA, 0); CP_LOADG(gB, 1);
            CP_STEP(gA, hdum, false); CP_LOADG(gA, 2);
            CP_STEP(gB, hdum, false); CP_LOADG(gB, 3);
            CP_STEP(gA, hdum, false);
            CP_STEP(gB, hdum, false);
            LAS bf16* tg = (LAS bf16*)(lds + wave * 16384);
#pragma unroll
            for (int sl = 0; sl < 4; ++sl) { const int pc = 32 * (sl >> 1) + 8 * (l15 >> 2) + 4 * (sl & 1) + (l15 & 3);
#pragma unroll
                for (int mt = 0; mt < 4; ++mt)
#pragma unroll
                    for (int e = 0; e < 4; ++e) tg[(16 * mt + 4 * g + e) * 64 + pc] = (bf16)f2bf(z[sl][mt][e]); }
            u32x4* gc = (u32x4*)((bf16*)(ws + WS_GC) + (size_t)u64 * 4096);
#pragma unroll
            for (int i = 0; i < 8; ++i) gc[i * 64 + lane] = *(const LAS u32x4*)(tg + (i * 64 + lane) * 8);
        }
        {
            f32x4 z[4][4];
#pragma unroll
            for (int sl = 0; sl < 4; ++sl)
#pragma unroll
                for (int mt = 0; mt < 4; ++mt) z[sl][mt] = (f32x4){0.f, 0.f, 0.f, 0.f};
            bf16x8 gA[4][2], gB[4][2]; u32x2 hA[4][4], hB[4][4];
            CP_LOADG(gA, 0); CP_LOADH(hA, 0); CP_LOADG(gB, 1); CP_LOADH(hB, 1);
            CP_STEP(gA, hA, true); CP_LOADG(gA, 2); CP_LOADH(hA, 2);
            CP_STEP(gB, hB, true); CP_LOADG(gB, 3); CP_LOADH(hB, 3);
            CP_STEP(gA, hA, true);
            CP_STEP(gB, hB, true);
#pragma unroll
            for (int sl = 0; sl < 4; ++sl)
#pragma unroll
                for (int mt = 0; mt < 4; ++mt) { u32x2 w; w.x = pk2(z[sl][mt][0], z[sl][mt][1]); w.y = pk2(z[sl][mt][2], z[sl][mt][3]);
                    *(u32x2*)((bf16*)(ws + WS_HC) + ((size_t)((u64 * 4 + sl) * 4 + mt) * 64 + lane) * 4) = w; }
        }
#undef CP_LOADG
#undef CP_LOADH
#undef CP_STEP
        }
        }
    }
    SEAM(3);


    if (IN(4)) { PHASE_IDS;
        if (!(bid < 128 && wave == 0)) {
            const int wi = bid < 128 ? bid * 7 + (wave - 1) : 896 + (bid - 128) * 8 + wave, NW = 896 + (G - 128) * 8;
        } else {
            const int l15 = lane & 15, g = lane >> 4, bh = bid >> 2, vs = bid & 3;
            f32x4 z[4];
#pragma unroll
            for (int mt = 0; mt < 4; ++mt) z[mt] = (f32x4){0.f, 0.f, 0.f, 0.f};
            bf16x8 gA[4][2], gB[4][2], gC[4][2], gD[4][2]; u32x2 hA[4], hB[4], hC[4], hD[4];
#define SC_LOAD(gf, hf, C) do { const size_t u64_ = (size_t)bh * 64 + (C); const bf16* gp_ = (const bf16*)(ws + WS_GC) + u64_ * 4096 + l15 * 64 + 8 * g; \
                _Pragma("unroll") for (int mt = 0; mt < 4; ++mt) { gf[mt][0] = *(const bf16x8*)(gp_ + mt * 1024); gf[mt][1] = *(const bf16x8*)(gp_ + mt * 1024 + 32); \
                    hf[mt] = *(const u32x2*)((const bf16*)(ws + WS_HC) + ((size_t)((u64_ * 4 + vs) * 4 + mt) * 64 + lane) * 4); } } while (0)
#define SC_STEP(gf, hf, C) do { const size_t u64_ = (size_t)bh * 64 + (C); bf16* zs_ = (bf16*)(ws + WS_ZS) + ((size_t)((u64_ * 4 + vs) * 4) * 64 + lane) * 4; \
                _Pragma("unroll") for (int mt = 0; mt < 4; ++mt) { u32x2 zw_; zw_.x = pk2(z[mt][0], z[mt][1]); zw_.y = pk2(z[mt][2], z[mt][3]); *(u32x2*)(zs_ + mt * 256) = zw_; } \
                bf16x8 zb[2]; RW_ZB(z, zb); \
                _Pragma("unroll") for (int mt = 0; mt < 4; ++mt) { f32x4 a; a[0] = bflo(hf[mt].x); a[1] = bfhi(hf[mt].x); a[2] = bflo(hf[mt].y); a[3] = bfhi(hf[mt].y); \
                    a = __builtin_amdgcn_mfma_f32_16x16x32_bf16(gf[mt][0], zb[0], a, 0, 0, 0); a = __builtin_amdgcn_mfma_f32_16x16x32_bf16(gf[mt][1], zb[1], a, 0, 0, 0); z[mt] = a; } } while (0)
            SC_LOAD(gA, hA, 0); SC_LOAD(gB, hB, 1); SC_LOAD(gC, hC, 2);
#pragma unroll 1
            for (int C = 0; C < 64; C += 4) {
                SC_LOAD(gD, hD, C + 3);
                SC_STEP(gA, hA, C);
                if (C + 4 < 64) SC_LOAD(gA, hA, C + 4);
                SC_STEP(gB, hB, C + 1);
                if (C + 5 < 64) SC_LOAD(gB, hB, C + 5);
                SC_STEP(gC, hC, C + 2);
                if (C + 6 < 64) SC_LOAD(gC, hC, C + 6);
                SC_STEP(gD, hD, C + 3);
            }
#undef SC_LOAD
#undef SC_STEP
        }
    }
    if (IN(4)) { PHASE_IDS;
        if (bid < 32 && wave == 1) { const int bc = bid; const f32x2* ag = (const f32x2*)((const float*)(ws + WS_AP)) + (size_t)(bc * 64) * 64 + lane;
            float* car = (float*)(ws + WS_AP + 4 * MiB) + (size_t)(bc * 64) * 64 + lane; float hst = 0.f;
#pragma unroll 16
            for (int sg = 0; sg < 64; ++sg) { const f32x2 ab = ag[(size_t)sg * 64]; car[(size_t)sg * 64] = hst; hst = ab.x * hst + ab.y; } }
    }
    if (IN(4)) { PHASE_IDS;
        bf16* WKt = HN; bf16* VWt = HN + (size_t)4 * 1024 * 1024;
        __syncthreads();
        if (bid >= 128 && bid < 192) { pg8::FoldSched<0> S; S.A = (const char*)KM; S.B = (const char*)Wq_t; S.G = 64; S.c = bid - 128; EpiFold<0> E{(unsigned char*)WKt}; pg8::gemm_phase(lds, 256, S, E, wv0, 1024); }
        else if (bid >= 192) { pg8::FoldSched<1> S; S.A = (const char*)Wo_t; S.B = (const char*)VT; S.G = 64; S.c = bid - 192; EpiFold<1> E{(unsigned char*)VWt}; pg8::gemm_phase(lds, 256, S, E, wv0, 1024); }
    }
    SEAM(4);

    if (IN(5)) { PHASE_IDS;
        {
            for (int lu = gw; lu < (M / 64) * 8; lu += NGW) {
                const int seg = lu >> 3, nb = lu & 7, rr = lane >> 3, cq = lane & 7;
                const float* cp = (const float*)(ws + WS_AP + 4 * MiB) + ((size_t)(((seg >> 6) * 8 + nb) * 64 + (seg & 63)) * 64 + 8 * cq);
                const f32x4 c0 = *(const f32x4*)cp, c1 = *(const f32x4*)(cp + 4);
#pragma unroll
                for (int it = 0; it < 8; ++it) { const size_t m = (size_t)seg * 64 + 8 * it + rr; const size_t o = m * 512 + nb * 64 + 8 * cq;
                    const u32x4 pw = *(const u32x4*)(LA + o), hw = *(const u32x4*)(LB + o), gw_ = *(const u32x4*)(U + m * INW + 512 + nb * 64 + 8 * cq);
                    float y[8];
#pragma unroll
                    for (int q = 0; q < 4; ++q) { const float ca = q < 2 ? c0[2 * q] : c1[2 * q - 4], cb = q < 2 ? c0[2 * q + 1] : c1[2 * q - 3];
                        y[2 * q] = (bflo(hw[q]) + bflo(pw[q]) * ca) * gelu_tanh_f(bflo(gw_[q])); y[2 * q + 1] = (bfhi(hw[q]) + bfhi(pw[q]) * cb) * gelu_tanh_f(bfhi(gw_[q])); }
                    u32x4 w; w.x = pk2(y[0], y[1]); w.y = pk2(y[2], y[3]); w.z = pk2(y[4], y[5]); w.w = pk2(y[6], y[7]);
                    *(u32x4*)(CAT + m * 1024 + nb * 64 + 8 * cq) = w; }
            }
        }
        const int l15 = lane & 15, g = lane >> 4;
        LAS bf16* tGL = (LAS bf16*)(lds + wave * 16384); LAS bf16* tAD = tGL + 1024; LAS bf16* tOUT = tGL + 2048;
        const int ct = lane >> 3, cc = lane & 7;
        for (int u64 = gw; u64 < NB * NH * (SEQ / 64); u64 += NGW) {
            const int bh = u64 >> 6, C = u64 & 63, b = bh >> 3, h = bh & 7;
            f32x4 z[4][4];
#pragma unroll
            for (int sl = 0; sl < 4; ++sl)
#pragma unroll
                for (int mt = 0; mt < 4; ++mt) { const u32x2 zw = *(const u32x2*)((const bf16*)(ws + WS_ZS) + ((size_t)((u64 * 4 + sl) * 4 + mt) * 64 + lane) * 4); z[sl][mt] = (f32x4){bflo(zw.x), bfhi(zw.x), bflo(zw.y), bfhi(zw.y)}; }
#pragma unroll 1
            for (int j = 0; j < 4; ++j) {
                const size_t un = (size_t)u64 * 4 + j; const size_t m0 = (size_t)b * SEQ + (C * 4 + j) * 16;
                const bf16* rp = (const bf16*)(ws + WS_RP) + un * 1024 + l15 * 64 + 8 * g;
                const bf16x8 rf0 = *(const bf16x8*)rp, rf1 = *(const bf16x8*)(rp + 32);
                f32x4 y[4];
#pragma unroll
                for (int sl = 0; sl < 4; ++sl) y[sl] = *(const f32x4*)((const float*)(ws + WS_Y1F) + ((size_t)(un * 4 + sl) * 64 + lane) * 4);
                const size_t rg = (m0 + ct) * 512 + h * 64 + 8 * cc;
                const u32x4 gl0 = *(const u32x4*)((const bf16*)(ws + WS_G) + rg), gl1 = *(const u32x4*)((const bf16*)(ws + WS_G) + rg + 8 * 512);
                const u32x4 ad0 = *(const u32x4*)((const bf16*)(ws + WS_ADD) + rg), ad1 = *(const u32x4*)((const bf16*)(ws + WS_ADD) + rg + 8 * 512);
                bf16x8 gf[4][2]; u32x2 hfr[4][4];
                if (j < 3) {
                    const bf16* gp = (const bf16*)(ws + WS_GP) + un * 4096 + l15 * 64 + 8 * g;
#pragma unroll
                    for (int mt = 0; mt < 4; ++mt) { gf[mt][0] = *(const bf16x8*)(gp + mt * 1024); gf[mt][1] = *(const bf16x8*)(gp + mt * 1024 + 32); }
#pragma unroll
                    for (int sl = 0; sl < 4; ++sl)
#pragma unroll
                        for (int mt = 0; mt < 4; ++mt) hfr[sl][mt] = *(const u32x2*)((const bf16*)(ws + WS_HF) + ((size_t)((un * 4 + sl) * 4 + mt) * 64 + lane) * 4);
                }
                *(LAS u32x4*)(tGL + ct * 64 + 8 * cc) = gl0; *(LAS u32x4*)(tGL + (ct + 8) * 64 + 8 * cc) = gl1;
                *(LAS u32x4*)(tAD + ct * 64 + 8 * cc) = ad0; *(LAS u32x4*)(tAD + (ct + 8) * 64 + 8 * cc) = ad1;
                bf16x8 zb[4][2];
#pragma unroll
                for (int sl = 0; sl < 4; ++sl) { RW_ZB(z[sl], zb[sl]);
                    y[sl] = __builtin_amdgcn_mfma_f32_16x16x32_bf16(rf0, zb[sl][0], y[sl], 0, 0, 0); y[sl] = __builtin_amdgcn_mfma_f32_16x16x32_bf16(rf1, zb[sl][1], y[sl], 0, 0, 0); }
#pragma unroll
                for (int e = 0; e < 4; ++e) {
                    float s1 = (y[0][e] + y[1][e]) + (y[2][e] + y[3][e]);
                    s1 += __shfl_xor(s1, 1); s1 += __shfl_xor(s1, 2); s1 += __shfl_xor(s1, 4); s1 += __shfl_xor(s1, 8);
                    const float mean = s1 * (1.0f / 64.0f);
                    float d0 = y[0][e] - mean, d1 = y[1][e] - mean, d2 = y[2][e] - mean, d3 = y[3][e] - mean;
                    float s2 = (d0 * d0 + d1 * d1) + (d2 * d2 + d3 * d3);
                    s2 += __shfl_xor(s2, 1); s2 += __shfl_xor(s2, 2); s2 += __shfl_xor(s2, 4); s2 += __shfl_xor(s2, 8);
                    const float rstd = rsq_f(s2 * (1.0f / 64.0f) + GN_EPS);
                    const float dd[4] = {d0, d1, d2, d3};
#pragma unroll
                    for (int sl = 0; sl < 4; ++sl) { const int ti_ = (4 * g + e) * 64 + 16 * sl + l15;
                        const float o = dd[sl] * rstd * bf2f(tGL[ti_]) + bf2f(tAD[ti_]); tOUT[ti_] = (bf16)f2bf(o); }
                }
                { bf16* cp = CAT + (m0 + ct) * 1024 + 512 + h * 64 + 8 * cc;
                  *(u32x4*)cp = *(const LAS u32x4*)(tOUT + ct * 64 + 8 * cc); *(u32x4*)(cp + 8 * 1024) = *(const LAS u32x4*)(tOUT + (ct + 8) * 64 + 8 * cc); }
                if (j < 3) {
#pragma unroll
                    for (int sl = 0; sl < 4; ++sl)
#pragma unroll
                        for (int mt = 0; mt < 4; ++mt) { const u32x2 hh = hfr[sl][mt];
                            f32x4 a; a[0] = bflo(hh.x); a[1] = bfhi(hh.x); a[2] = bflo(hh.y); a[3] = bfhi(hh.y);
                            a = __builtin_amdgcn_mfma_f32_16x16x32_bf16(gf[mt][0], zb[sl][0], a, 0, 0, 0); a = __builtin_amdgcn_mfma_f32_16x16x32_bf16(gf[mt][1], zb[sl][1], a, 0, 0, 0); z[sl][mt] = a; }
                }
            }
        }
    }
    SEAM(5);
#undef RW_ZB


    if (IN(6)) { PHASE_IDS;
        pg8::DenseSched S; S.o.init_tiles(M / 256, D / 256, G, bid); S.A = (const char*)CAT; S.B = (const char*)Wout_t; S.tstep = (size_t)256 * D * 2;
        EpiBf16Res<false> E{args.in[I_X], X1, D, (float*)(ws + WS_AP + 2 * MiB), 1.0f, X1F8}; pg8::gemm_phase(lds, D, S, E, wv0);
    }
    SEAM(6);
    if (IN(7)) { PHASE_IDS;
        pg8::BatchBSched S; S.o.init_tiles(M / 256, D / 256, G, bid); S.A = (const char*)X1F8; S.B = (const char*)HN; S.tstep = (size_t)256 * 1024; S.bstep = (size_t)1024 * 1024;
        EpiSoftmax E{(unsigned char*)Qb, 0.0625f * 0.25f, (const float*)(ws + WS_AP + 2 * MiB), (LAS float*)(lds + RING_BYTES + 1024), (LAS float*)(lds + RING_BYTES + 1024 + 4096)};
        pg8::gemm_phase<EpiSoftmax, pg8::BatchBSched, true, true>(lds, 512, S, E, wv0);
    }
    SEAM(7);
    if (IN(8)) { PHASE_IDS;
        pg8::BatchBSched S; S.o.init_tiles(M / 256, D / 256, G, bid); S.A = (const char*)Qb; S.B = (const char*)(HN + (size_t)4 * 1024 * 1024); S.tstep = (size_t)256 * 1024; S.bstep = (size_t)1024 * 1024;
        EpiBf16Res<true> E{X1, X2, D, nullptr, 1.0f / 1024.0f, nullptr}; pg8::gemm_phase<EpiBf16Res<true>, pg8::BatchBSched, true, true>(lds, 512, S, E, wv0);
    }
    SEAM(8);
    if (IN(9)) { PHASE_IDS;
        for (int cid = tid; cid < 2 * NE * 128; cid += NTHREADS) { const int t = cid >> 12, row = (cid >> 7) & 31, c = cid & 127;
            *(LAS u32x4*)(lds + t * 65536 + row * 2048 + ((c ^ (row & 7)) << 4)) = *(const u32x4*)(WrT + (size_t)t * NE * D + row * D + 8 * c); }
        __syncthreads();
        const int l15 = lane & 15, g = lane >> 4;
        LAS float* LG = (LAS float*)(lds + RING_BYTES + 1024 + wave * 2304);
        const float* gfn = args.in[I_NFFG];
        LAS unsigned* cntl = (LAS unsigned*)(lds + RING_BYTES + 640);
        for (int t0 = 0; t0 < M / 16; t0 += G * 4) {
        if (tid < 64) cntl[tid] = 0u;
        __syncthreads();
        if (t0 == 0 && wave >= 4) {
            constexpr int I_DN = 16 * 32, I_GU = 16 * 64;
            for (int r = bid * 4 + (wave - 4); r < CONV_P9; r += G * 4) { const int e = r / I_GU, q = r % I_GU, kb = q / 64, nb = q % 64; const int n0 = 32 * nb;
                const int drow = n0 < 1024 ? (256 * (n0 >> 7) + (n0 & 127)) : (256 * ((n0 - 1024) >> 7) + 128 + ((n0 - 1024) & 127));
                transpose_item_tiled_fp8_nolds(args.in[I_WGU] + (size_t)e * D * 2048, 2048, D, (unsigned char*)Wgu_t + (size_t)e * 2048 * D, 64 * kb, n0, drow, lane); }
            for (int r = bid * 4 + (wave - 4); r < CONV_P9D; r += G * 4) { const int e = r / I_DN, q = r % I_DN, kb = q / 32, nb = q % 32;
                transpose_item_tiled_fp8_nolds(args.in[I_WDN] + (size_t)e * DFF * D, D, DFF, (unsigned char*)Wdn_t + (size_t)e * D * DFF, 64 * kb, 32 * nb, 32 * nb, lane); }
        }
        const int tile = t0 + bid * 4 + wave; const bool active = wave < 4 && tile < M / 16;
        int me = 0, lpos = 0, ai = 0; float mg = 0.f;
        if (active) {
            const int m0 = tile * 16;
            const bf16* xrow = X2 + (size_t)(m0 + l15) * D + 8 * g;
            float ss = 0.f;
#pragma unroll 8
            for (int ks = 0; ks < 32; ++ks) { const u32x4 xw = *(const u32x4*)(xrow + 32 * ks);
#pragma unroll
                for (int q = 0; q < 4; ++q) { const float a = bflo(xw[q]), c = bfhi(xw[q]); ss += a * a + c * c; } }
            ss += __shfl_xor(ss, 16); ss += __shfl_xor(ss, 32);
            const float rstd = rsq_f(ss * (1.f / D) + EPS);
            f32x4 acc0 = (f32x4){0.f, 0.f, 0.f, 0.f}, acc1 = acc0;
            unsigned char* hrow = (unsigned char*)HN + (size_t)(m0 + l15) * D + 8 * g;
#pragma unroll 2
            for (int ks = 0; ks < 32; ++ks) {
                const f32x4 g0 = *(const f32x4*)(gfn + 32 * ks + 8 * g), g1 = *(const f32x4*)(gfn + 32 * ks + 8 * g + 4);
                const u32x4 xw = *(const u32x4*)(xrow + 32 * ks);
                float hf[8];
#pragma unroll
                for (int q = 0; q < 4; ++q) { hf[2 * q] = bflo(xw[q]) * rstd * (q < 2 ? g0[2 * q] : g1[2 * q - 4]); hf[2 * q + 1] = bfhi(xw[q]) * rstd * (q < 2 ? g0[2 * q + 1] : g1[2 * q - 3]); }
                u32x4 hi, lo;
#pragma unroll
                for (int q = 0; q < 4; ++q) { hi[q] = pk2(hf[2 * q], hf[2 * q + 1]); lo[q] = pk2(hf[2 * q] - bflo(hi[q]), hf[2 * q + 1] - bfhi(hi[q])); }
                { u32x2 h8; h8.x = pk4_fp8(hf[0], hf[1], hf[2], hf[3]); h8.y = pk4_fp8(hf[4], hf[5], hf[6], hf[7]); *(u32x2*)(hrow + 32 * ks) = h8; }
                const bf16x8 ah = __builtin_bit_cast(bf16x8, hi), al = __builtin_bit_cast(bf16x8, lo);
                const int c = 4 * ks + g;
#pragma unroll
                for (int nt = 0; nt < 2; ++nt) { const int row = 16 * nt + l15; const int off = row * 2048 + ((c ^ (row & 7)) << 4);
                    const bf16x8 bh = *(const LAS bf16x8*)(lds + off), bl = *(const LAS bf16x8*)(lds + 65536 + off);
                    f32x4 a = nt ? acc1 : acc0;
                    a = __builtin_amdgcn_mfma_f32_16x16x32_bf16(ah, bh, a, 0, 0, 0); a = __builtin_amdgcn_mfma_f32_16x16x32_bf16(ah, bl, a, 0, 0, 0); a = __builtin_amdgcn_mfma_f32_16x16x32_bf16(al, bh, a, 0, 0, 0);
                    if (nt) acc1 = a; else acc0 = a; }
            }
            { const float b0 = args.in[I_BR][l15], b1 = args.in[I_BR][16 + l15];
#pragma unroll
              for (int j = 0; j < 4; ++j) { LG[(4 * g + j) * 33 + l15] = acc0[j] + b0; LG[(4 * g + j) * 33 + 16 + l15] = acc1[j] + b1; } }
            const int rrow = lane >> 2, qq = lane & 3;
            float tv[4] = {-3.0e38f, -3.0e38f, -3.0e38f, -3.0e38f}; int ti[4] = {64, 65, 66, 67};
#define TOP_INS(xv_, xi_) do { float x_ = (xv_); int i_ = (xi_); _Pragma("unroll") for (int p_ = 0; p_ < 4; ++p_) { const bool b_ = x_ > tv[p_] || (x_ == tv[p_] && i_ < ti[p_]); \
                const float ov_ = tv[p_]; const int oi_ = ti[p_]; tv[p_] = b_ ? x_ : ov_; ti[p_] = b_ ? i_ : oi_; x_ = b_ ? ov_ : x_; i_ = b_ ? oi_ : i_; } } while (0)
#pragma unroll
            for (int j = 0; j < 8; ++j) TOP_INS(LG[rrow * 33 + 8 * qq + j], 8 * qq + j);
#pragma unroll
            for (int st = 1; st < 4; st <<= 1) { float pv[4]; int pi[4];
#pragma unroll
                for (int p = 0; p < 4; ++p) { pv[p] = __shfl_xor(tv[p], st); pi[p] = __shfl_xor(ti[p], st); }
#pragma unroll
                for (int p = 0; p < 4; ++p) TOP_INS(pv[p], pi[p]); }
#undef TOP_INS
            const float e1 = __expf(tv[1] - tv[0]), e2 = __expf(tv[2] - tv[0]), e3 = __expf(tv[3] - tv[0]);
            const float inv = rcp_f(1.0f + e1 + e2 + e3);
            me = qq == 0 ? ti[0] : qq == 1 ? ti[1] : qq == 2 ? ti[2] : ti[3];
            mg = (qq == 0 ? 1.0f : qq == 1 ? e1 : qq == 2 ? e2 : e3) * inv;
            lpos = (int)__hip_atomic_fetch_add(cntl + me, 1u, __ATOMIC_RELAXED, __HIP_MEMORY_SCOPE_WORKGROUP);
            ai = (m0 + rrow) * 4 + qq;
        }
        __syncthreads();
        if (tid < NE) { const unsigned c = cntl[tid]; cntl[32 + tid] = c ? atomicAdd(ecnt + 64 * tid, c) : 0u; }
        __syncthreads();
        if (active) { route_e[ai] = me; route_pos[ai] = (int)cntl[32 + me] + lpos; route_g[ai] = mg; }
        __syncthreads();
        }
    }
    SEAM(9);
    if (IN(10)) { PHASE_IDS;
        LAS int* pst = (LAS int*)lds;
        if (wave == 0) {
            const int c = lane < NE ? (int)__hip_atomic_load(ecnt + 64 * lane, __ATOMIC_RELAXED, __HIP_MEMORY_SCOPE_AGENT) : 0; const int pc = (c + 255) & ~255;
            int x = pc;
#pragma unroll
            for (int d = 1; d < 32; d <<= 1) { const int y = __shfl_up(x, d); if (lane >= d) x += y; }
            if (lane < NE) { pst[lane] = x - pc; pst[64 + lane] = c; } if (lane == NE - 1) pst[32] = x; }
        __syncthreads();
        for (int ai = bid * NTHREADS + tid; ai < NASSIGN; ai += G * NTHREADS) {
            const int e = route_e[ai]; const int row = pst[e] + route_pos[ai]; { u32x2 sg_; sg_.x = (unsigned)ai; sg_.y = __float_as_uint(route_g[ai]); row_sg[row] = sg_; } row_tok[row] = ai >> 2; }
        if (bid < NE) { const int e = bid, c = pst[64 + e], pe = (c + 255) & ~255; for (int p = c + tid; p < pe; p += NTHREADS) { u32x2 sg_; sg_.x = 0xffffffffu; sg_.y = 0u; row_sg[pst[e] + p] = sg_; row_tok[pst[e] + p] = 0; } }
        if (bid == 0 && tid == 0) tile_tab[0] = pst[32] >> 8;
        if (bid >= 128 && bid < 136) { const int nt = pst[32] >> 8, nN = bid < 132 ? 8 : 4; int* tab = (int*)(ws + WS_ROUTE + (bid < 132 ? RT_UGU : RT_UDN));
            for (int L = (bid & 3) * NTHREADS + tid; L < nt * nN; L += 4 * NTHREADS) { Unit uu; { const int nwg = nt * nN; int wgid = L; { const int q = nwg / 8, r = nwg % 8, xcd = wgid % 8, off = wgid / 8; wgid = (xcd < r ? xcd * (q + 1) : r * (q + 1) + (xcd - r) * q) + off; }
                    const int nig = 8 * nN, gid = wgid / nig, fm = gid * 8, gsz = (nt - fm) < 8 ? (nt - fm) : 8; uu.pm = fm + ((wgid % nig) % gsz); uu.pn = (wgid % nig) / gsz; uu.e = 0; }
                int e = 0;
#pragma unroll
                for (int st = 16; st >= 1; st >>= 1) { if ((pst[e + st] >> 8) <= uu.pm) e += st; }
                tab[L] = uu.pm | (uu.pn << 12) | (e << 16); } }
        __syncthreads();
    }
    SEAM(10);
    if (IN(11)) {
        const int ntiles = tile_tab[0];
        pg8::MoeGatherSched S; S.o.init_tiles(ntiles, 2048 / 256, G, bid); S.A = (const char*)HN; S.B = (const char*)Wgu_t; S.tile_e = tile_tab + 16; S.utab = (const int*)(ws + WS_ROUTE + RT_UGU); S.rtok = row_tok; S.tstep = (size_t)256 * 1024; S.estep = (size_t)2048 * 1024;
        EpiSwiglu E{ACT, args.in[I_BGU]}; pg8::gemm_phase<EpiSwiglu, pg8::MoeGatherSched, true, true>(lds, 512, S, E, wv0);
        { PHASE_IDS; LAS float* scr = (LAS float*)(lds + wave * 16384); constexpr int I_DN = 16 * 32;
          for (;;) { int c0 = 0; if (lane == 0) c0 = (int)atomicAdd(ctl + CW_CONV, 8u); c0 = __builtin_amdgcn_readfirstlane(c0);
              c0 += CONV_P9D; if (c0 >= NE * I_DN) break;
              for (int r = c0; r < c0 + 8; ++r) { const int e = r / I_DN, q = r % I_DN, kb = q / 32, nb = q % 32;
                  transpose_item_tiled_fp8(args.in[I_WDN] + (size_t)e * DFF * D, D, DFF, (unsigned char*)Wdn_t + (size_t)e * D * DFF, 64 * kb, 32 * nb, 32 * nb, scr, lane); } } }
    }
    SEAM(11);
    if (IN(12)) {
        const int ntiles = tile_tab[0];
        pg8::MoeSched S; S.o.init_tiles(ntiles, D / 256, G, bid); S.A = (const char*)ACT; S.B = (const char*)Wdn_t; S.tile_e = tile_tab + 16; S.utab = (const int*)(ws + WS_ROUTE + RT_UDN); S.tstep = (size_t)256 * 1024; S.estep = (size_t)1024 * 1024;
        EpiDown E{YS, args.in[I_BDN], row_sg}; pg8::gemm_phase<EpiDown, pg8::MoeSched, true, true>(lds, 512, S, E, wv0);
    }
    SEAM(12);
    if (IN(13)) { PHASE_IDS;
        const float* gfin = args.in[I_FNG];
        for (int m = gw; m < M; m += NGW) {
            float v[16]; float s = 0.f;
#pragma unroll
            for (int hf = 0; hf < 2; ++hf) { const u32x4 w = *(const u32x4*)(X2 + (size_t)m * D + 512 * hf + 8 * lane);
#pragma unroll
                for (int q = 0; q < 4; ++q) { v[8 * hf + 2 * q] = bflo(w[q]); v[8 * hf + 2 * q + 1] = bfhi(w[q]); }
#pragma unroll
                for (int k = 0; k < 4; ++k) { const u32x2 y = *(const u32x2*)((const unsigned char*)YS + (size_t)(m * 4 + k) * D + 512 * hf + 8 * lane);
#pragma unroll
                    for (int q = 0; q < 2; ++q) { const auto lo2 = __builtin_amdgcn_cvt_pk_f32_fp8((int)y[q], false), hi2 = __builtin_amdgcn_cvt_pk_f32_fp8((int)y[q], true);
                        v[8 * hf + 4 * q] += lo2[0] * 0.0625f; v[8 * hf + 4 * q + 1] += lo2[1] * 0.0625f; v[8 * hf + 4 * q + 2] += hi2[0] * 0.0625f; v[8 * hf + 4 * q + 3] += hi2[1] * 0.0625f; } } }
#pragma unroll
            for (int j = 0; j < 16; ++j) s += v[j] * v[j];
            const float rstd = rsq_f(wave_sum(s) * (1.f / D) + EPS);
#pragma unroll
            for (int hf = 0; hf < 2; ++hf) { const f32x4 g0 = *(const f32x4*)(gfin + 512 * hf + 8 * lane), g1 = *(const f32x4*)(gfin + 512 * hf + 8 * lane + 4);
                float* o = args.out + (size_t)m * D + 512 * hf + 8 * lane;
                *(f32x4*)o = (f32x4){v[8 * hf] * rstd * g0.x, v[8 * hf + 1] * rstd * g0.y, v[8 * hf + 2] * rstd * g0.z, v[8 * hf + 3] * rstd * g0.w};
                *(f32x4*)(o + 4) = (f32x4){v[8 * hf + 4] * rstd * g1.x, v[8 * hf + 5] * rstd * g1.y, v[8 * hf + 6] * rstd * g1.z, v[8 * hf + 7] * rstd * g1.w}; }
        }
    }
#undef IN
#undef SEAM
}

constexpr int N_PHASES = 14;
extern "C" void kernel_launch(void* const* d_in, const int* in_sizes, int n_in, void* d_out, int out_size, void* d_ws, size_t ws_size, hipStream_t stream) {
    static int grid = 0;
    if (grid == 0) {
        if (n_in != 37 || out_size != M * D || ws_size < WS_END) { fprintf(stderr, "kernel_launch: unexpected shapes (n_in %d, out %d, ws %zu); nothing launched\n", n_in, out_size, ws_size); grid = -1; return; }
        int dev = 0, cus = 0, per_cu = 0;
        if (hipGetDevice(&dev) != hipSuccess || hipDeviceGetAttribute(&cus, hipDeviceAttributeMultiprocessorCount, dev) != hipSuccess) { grid = -1; return; }
        if (hipFuncSetAttribute((const void*)fwd, hipFuncAttributeMaxDynamicSharedMemorySize, LDS_BYTES) != hipSuccess) { fprintf(stderr, "kernel_launch: hipFuncSetAttribute failed\n"); grid = -1; return; }
        if (hipOccupancyMaxActiveBlocksPerMultiprocessor(&per_cu, (const void*)fwd, NTHREADS, LDS_BYTES) != hipSuccess || per_cu < 1) fprintf(stderr, "kernel_launch: occupancy query says %d\n", per_cu);
        (void)hipGetLastError();
        grid = cus > 256 ? 256 : cus;
    }
    if (grid < 0) return;
    if (hipMemsetAsync((char*)d_ws + WS_CTL, 0, CTL_ZERO_BYTES, stream) != hipSuccess) return;
    Args a{};
    for (int i = 0; i < 37; ++i) a.in[i] = (const float*)d_in[i];
    a.out = (float*)d_out; a.ws = (unsigned char*)d_ws;
#if MK_ONE_LAUNCH
    a.ph_lo = 0; a.ph_hi = N_PHASES;
    hipLaunchKernelGGL(fwd, dim3(grid), dim3(NTHREADS), LDS_BYTES, stream, a);
#else
    for (int p = 0; p < N_PHASES; ++p) { a.ph_lo = p; a.ph_hi = p + 1; hipLaunchKernelGGL(fwd, dim3(grid), dim3(NTHREADS), LDS_BYTES, stream, a);
#ifdef PROBE_REPEAT_PHASE
        if (p == PROBE_REPEAT_PHASE) hipLaunchKernelGGL(fwd, dim3(grid), dim3(NTHREADS), LDS_BYTES, stream, a);
#endif
    }
#endif
}
```

```cpp
#include <hip/hip_runtime.h>
#include <cstdio>
#include <cstdint>

#ifndef MK_ONE_LAUNCH
#define MK_ONE_LAUNCH 1
#endif

#define DI __device__ __forceinline__
#define GAS __attribute__((address_space(1)))
#define LAS __attribute__((address_space(3)))
typedef unsigned short bf16;
typedef short bf16x8 __attribute__((ext_vector_type(8)));
typedef int v4i __attribute__((ext_vector_type(4)));
typedef int v8i __attribute__((ext_vector_type(8)));
typedef float f32x4 __attribute__((ext_vector_type(4)));
typedef float f32x2 __attribute__((ext_vector_type(2)));
typedef unsigned u32x4 __attribute__((ext_vector_type(4)));
typedef unsigned u32x2 __attribute__((ext_vector_type(2)));

constexpr int D = 1024, NB = 4, SEQ = 4096, M = NB * SEQ;
constexpr int MEML = 256, MROWS = NB * MEML;
constexpr int LRU_W = 512, RW = 512, NH = 8, HD = 64;
constexpr int INW = 2816;
constexpr int XH = 4, XHD = 256;
constexpr int NE = 32, TOPK = 4, DFF = 1024;
constexpr int NASSIGN = M * TOPK;
constexpr int MAXTILES = 288, MAXROWS = MAXTILES * 256;
constexpr float EPS = 1e-6f, GN_EPS = 64e-5f;

DI int fresh_tid_(int wv) { int w = wv; asm volatile("" : "+s"(w)); int l; asm volatile("v_mbcnt_lo_u32_b32 %0, -1, 0\n\tv_mbcnt_hi_u32_b32 %0, -1, %0" : "=v"(l)); return (w << 6) | (l & 63); }
#define fresh_tid() fresh_tid_(wv0)
namespace pg8 {
constexpr int BM = 256, BK = 64, HALF = 128, HTB = HALF * BK * 2, STAGE_BYTES = 8 * HTB, NXCD = 8, WGM = 8;
__host__ __device__ __forceinline__ int lds_byte(int r, int c) { const int st = (r >> 4) * 2 + (c >> 5), rr = r & 15, cc = c & 31, ob = rr * 64 + cc * 2; return st * 1024 + (ob ^ (((ob >> 9) & 1) << 5)); }
__host__ __device__ __forceinline__ void stage_rc(int b, int& R, int& C) { const int st = b / 1024, sb = b % 1024, swz = sb ^ (((sb >> 9) & 1) << 5); R = (st >> 1) * 16 + swz / 64; C = (st & 1) * 32 + (swz % 64) / 2; }
__host__ __device__ __forceinline__ int perm32(int rho) { const int n = rho >> 4, i = rho & 15; return 8 * (i >> 2) + 4 * n + (i & 3); }

struct Unit { int pm, pn, e; };

struct StaticOrder {
    int nM, nN, nwg, G, c;
    __host__ __device__ void init_tiles(int nM_, int nN_, int G_, int c_) { nM = nM_; nN = nN_; nwg = nM * nN; G = G_; c = c_; }
    __host__ __device__ bool next(int i, Unit& u) const {
        const long L = (long)i * G + c; if (L >= nwg) return false;
        int wgid = (int)L; { const int q = nwg / NXCD, r = nwg % NXCD, xcd = wgid % NXCD, off = wgid / NXCD; wgid = (xcd < r ? xcd * (q + 1) : r * (q + 1) + (xcd - r) * q) + off; }
        const int nig = WGM * nN, gid = wgid / nig, fm = gid * WGM, gsz = (nM - fm) < WGM ? (nM - fm) : WGM;
        u.pm = fm + ((wgid % nig) % gsz); u.pn = (wgid % nig) / gsz; u.e = 0; return true;
    }
};
struct DenseSched {
    static constexpr bool GATHER = false, B_TILED = false;
    StaticOrder o; const char* A; const char* B; size_t tstep;
    DI bool next(int i, Unit& u) const { return o.next(i, u); }
    DI const char* a_ptr(const Unit& u) const { return A + (size_t)u.pm * tstep; }
    DI const char* b_ptr(const Unit& u) const { return B + (size_t)u.pn * tstep; }
    DI void a_voff(const Unit&, int K, const int (&R)[2], const int (&C)[2], unsigned (&vo)[2][2]) const {
#pragma unroll
        for (int h = 0; h < 2; ++h)
#pragma unroll
            for (int i = 0; i < 2; ++i) vo[h][i] = (unsigned)((h * HALF + R[i]) * K + C[i]) * 2u; }
};
struct MoeSched {
    static constexpr bool GATHER = false, B_TILED = true;
    StaticOrder o; const char* A; const char* B; const int* tile_e; const int* utab; size_t tstep, estep;
    DI bool next(int i, Unit& u) const { const int L = i * o.G + o.c; if (L >= o.nwg) return false; int en; asm volatile("s_load_dword %0, %1, 0x0\n\ts_waitcnt lgkmcnt(0)" : "=s"(en) : "s"(utab + L) : "memory");     u.pm = en & 0xfff; u.pn = (en >> 12) & 15; u.e = en >> 16; return true; }
    DI const char* a_ptr(const Unit& u) const { return A + (size_t)u.pm * tstep; }
    DI const char* b_ptr(const Unit& u) const { return B + (size_t)u.e * estep + (size_t)u.pn * tstep; }
    DI void a_voff(const Unit&, int K, const int (&R)[2], const int (&C)[2], unsigned (&vo)[2][2]) const {
#pragma unroll
        for (int h = 0; h < 2; ++h)
#pragma unroll
            for (int i = 0; i < 2; ++i) vo[h][i] = (unsigned)((h * HALF + R[i]) * K + C[i]) * 2u; }
};
struct MoeGatherSched {
    static constexpr bool GATHER = true, B_TILED = true;
    StaticOrder o; const char* A; const char* B; const int* tile_e; const int* utab; const int* rtok; size_t tstep, estep;
    DI bool next(int i, Unit& u) const { const int L = i * o.G + o.c; if (L >= o.nwg) return false; int en; asm volatile("s_load_dword %0, %1, 0x0\n\ts_waitcnt lgkmcnt(0)" : "=s"(en) : "s"(utab + L) : "memory");     u.pm = en & 0xfff; u.pn = (en >> 12) & 15; u.e = en >> 16; return true; }
    DI const char* a_ptr(const Unit&) const { return A; }
    DI const char* b_ptr(const Unit& u) const { return B + (size_t)u.e * estep + (size_t)u.pn * tstep; }
    DI void a_voff(const Unit& u, int K, const int (&R)[2], const int (&C)[2], unsigned (&vo)[2][2]) const {
#pragma unroll
        for (int h = 0; h < 2; ++h)
#pragma unroll
            for (int i = 0; i < 2; ++i) vo[h][i] = (unsigned)(rtok[u.pm * BM + h * HALF + R[i]] * K + C[i]) * 2u; }
};

struct BatchBSched {
    static constexpr bool GATHER = false, B_TILED = false;
    StaticOrder o; const char* A; const char* B; size_t tstep, bstep;
    DI bool next(int i, Unit& u) const { return o.next(i, u); }
    DI const char* a_ptr(const Unit& u) const { return A + (size_t)u.pm * tstep; }
    DI const char* b_ptr(const Unit& u) const { return B + (size_t)(u.pm >> 4) * bstep + (size_t)u.pn * tstep; }
    DI void a_voff(const Unit&, int K, const int (&R)[2], const int (&C)[2], unsigned (&vo)[2][2]) const {
#pragma unroll
        for (int h = 0; h < 2; ++h)
#pragma unroll
            for (int i = 0; i < 2; ++i) vo[h][i] = (unsigned)((h * HALF + R[i]) * K + C[i]) * 2u; }
};
template <int MODE> struct FoldSched {
    static constexpr bool GATHER = false, B_TILED = false;
    const char* A; const char* B; int G, c;
    DI bool next(int i, Unit& u) const { const int L = i * G + c; if (L >= 64) return false; u.pm = L >> 2; u.pn = L & 3; u.e = 0; return true; }
    DI const char* a_ptr(const Unit& u) const { const int b = u.pm >> 2, h = u.pm & 3; return A + ((size_t)(MODE == 0 ? b * 256 : u.pn * 256) * 1024 + h * 256) * 2; }
    DI const char* b_ptr(const Unit& u) const { const int b = u.pm >> 2, h = u.pm & 3; return B + ((size_t)(MODE == 0 ? u.pn * 256 : b * 256) * 1024 + h * 256) * 2; }
    DI void a_voff(const Unit&, int K, const int (&R)[2], const int (&C)[2], unsigned (&vo)[2][2]) const {
#pragma unroll
        for (int h = 0; h < 2; ++h)
#pragma unroll
            for (int i = 0; i < 2; ++i) vo[h][i] = (unsigned)((h * HALF + R[i]) * K + C[i]) * 2u; }
};

DI unsigned cvt_pk_bf16(float lo, float hi) { unsigned r; asm volatile("v_cvt_pk_bf16_f32 %0, %1, %2" : "=v"(r) : "v"(lo), "v"(hi)); return r; }

template <class Epi, class Sched, bool ALIGN_EPI = true, bool FP8 = false>
DI void gemm_phase(LAS unsigned char* lds, const int K, const Sched& S, const Epi& E, const int wv0, const int ldp = 0) {
    const int ld = ldp ? ldp : K;
    const int tid = fresh_tid(), wid = __builtin_amdgcn_readfirstlane(tid >> 6), lane = tid & 63, wr = wid >> 2, wc = wid & 3, fr = lane & 15, fq = lane >> 4;
    const int nt = K / BK;
    constexpr bool GA = Sched::GATHER, BT = Sched::B_TILED;
    unsigned voffA[2][2], voffAn[2][2], voffB[2];
#pragma unroll
    for (int i = 0; i < 2; ++i) { int R, C; stage_rc(tid * 16 + i * 8192, R, C); const int Rb = Epi::PERM ? ((R & ~31) + perm32(R & 31)) : R;
        voffB[i] = BT ? (unsigned)(tid * 16 + i * 8192) : (unsigned)(Rb * ld + C) * 2u; }
#define PG8_AVOFF(unit, dst) do { int sR[2], sC[2]; const int t2_ = fresh_tid(); stage_rc(t2_ * 16, sR[0], sC[0]); stage_rc(t2_ * 16 + 8192, sR[1], sC[1]); S.a_voff(unit, ld, sR, sC, dst); } while (0)
    const size_t kstep = (size_t)(BK * 2);
    const size_t hstep = (size_t)HALF * ld * 2;
    const size_t kstepB = BT ? (size_t)(2 * HTB) : kstep, hstepB = BT ? (size_t)HTB : hstep;
    const unsigned ldsw = (unsigned)wid * 1024u;
    unsigned aoffv = (unsigned)(size_t)lds + (unsigned)lds_byte(wr * 64 + fr, fq * 8), boffv = (unsigned)(size_t)lds + (unsigned)(4 * HTB) + (unsigned)lds_byte(wc * 32 + fr, fq * 8);
    asm volatile("" : "+v"(aoffv), "+v"(boffv));
    const size_t dB = BT ? (size_t)8192 : (size_t)64 * ld * 2, dA = (size_t)64 * ld * 2;
#define PG8_SA(b, h) (((b) * 2 + (h)) * HTB)
#define PG8_SB(b, h) ((4 + (b) * 2 + (h)) * HTB)
    const unsigned ldsbase = (unsigned)__builtin_amdgcn_readfirstlane((int)((unsigned)(size_t)lds + ldsw));
#define PG8_STAGE1(bufoff, gptr, vo, i_) do { const unsigned m0v_ = ldsbase + (unsigned)(bufoff) + (unsigned)(i_) * 8192u; \
        asm volatile("s_mov_b32 m0, %2\n\ts_nop 0\n\tglobal_load_lds_dwordx4 %0, %1" :: "v"(vo), "s"((const char*)(gptr)), "s"(m0v_) : "memory", "m0"); } while (0)
#define PG8_STAGE(bufoff, gbase, voff) do { PG8_STAGE1(bufoff, gbase, (voff)[0], 0); PG8_STAGE1(bufoff, gbase, (voff)[1], 1); } while (0)
#define PG8_STAGE_D(bufoff, gbase, vo, delta) do { PG8_STAGE1(bufoff, gbase, vo, 0); PG8_STAGE1(bufoff, (const char*)(gbase) + (delta), vo, 1); } while (0)
#define PG8_LDA(dst, b, h) do { if constexpr (FP8) { _Pragma("unroll") for (int m = 0; m < 4; ++m) { const LAS v4i* p_ = (const LAS v4i*)((LAS unsigned char*)(size_t)aoffv + PG8_SA(b, h) + m * 2048); dst##8[m] = __builtin_shufflevector(p_[0], p_[64], 0, 1, 2, 3, 4, 5, 6, 7); } } \
        else { _Pragma("unroll") for (int m = 0; m < 4; ++m) _Pragma("unroll") for (int k = 0; k < 2; ++k) dst[m][k] = *(const LAS bf16x8*)((LAS unsigned char*)(size_t)aoffv + PG8_SA(b, h) + m * 2048 + k * 1024); } } while (0)
#define PG8_LDB(dst, b, h) do { if constexpr (FP8) { _Pragma("unroll") for (int n = 0; n < 2; ++n) { const LAS v4i* p_ = (const LAS v4i*)((LAS unsigned char*)(size_t)boffv + (PG8_SB(b, h) - 4 * HTB) + n * 2048); dst##8[n] = __builtin_shufflevector(p_[0], p_[64], 0, 1, 2, 3, 4, 5, 6, 7); } } \
        else { _Pragma("unroll") for (int n = 0; n < 2; ++n) _Pragma("unroll") for (int k = 0; k < 2; ++k) dst[n][k] = *(const LAS bf16x8*)((LAS unsigned char*)(size_t)boffv + (PG8_SB(b, h) - 4 * HTB) + n * 2048 + k * 1024); } } while (0)
#define PG8_MMA(ai, bj, At, Bt) do { __builtin_amdgcn_s_setprio(1); \
        if constexpr (FP8) {   \
            _Pragma("unroll") for (int m = 0; m < 4; ++m) _Pragma("unroll") for (int n = 0; n < 2; ++n) \
                acc[ai][bj][m][n] = __builtin_amdgcn_mfma_scale_f32_16x16x128_f8f6f4(Bt##8[n], At##8[m], acc[ai][bj][m][n], 0, 0, 0, 0, 0, 0); } \
        else { _Pragma("unroll") for (int m = 0; m < 4; ++m) _Pragma("unroll") for (int n = 0; n < 2; ++n) _Pragma("unroll") for (int k = 0; k < 2; ++k) \
            acc[ai][bj][m][n] = __builtin_amdgcn_mfma_f32_16x16x32_bf16(Bt[n][k], At[m][k], acc[ai][bj][m][n], 0, 0, 0); } \
        __builtin_amdgcn_s_setprio(0); } while (0)
#define PG8_WAIT_V(n) asm volatile("s_waitcnt vmcnt(" #n ")" ::: "memory")
#define PG8_WAIT_L(n) asm volatile("s_waitcnt lgkmcnt(" #n ")" ::: "memory")
#define PG8_BAR __builtin_amdgcn_s_barrier()
#define PG8_SCHED __builtin_amdgcn_sched_barrier(0)
    Unit cur, nxt; int ui = 0;
    if (!S.next(0, cur)) return;
    f32x4 acc[2][2][4][2];
#pragma unroll
    for (int a = 0; a < 2; ++a)
#pragma unroll
        for (int b = 0; b < 2; ++b)
#pragma unroll
            for (int m = 0; m < 4; ++m)
#pragma unroll
                for (int n = 0; n < 2; ++n) acc[a][b][m][n] = (f32x4){0.f, 0.f, 0.f, 0.f};
    bf16x8 At[4][2], B0[2][2], B1[2][2]; v8i At8[4], B08[2], B18[2];
    const char* cA = S.a_ptr(cur); const char* cB = S.b_ptr(cur);
    PG8_AVOFF(cur, voffA);
#define PG8_STAGE_A(bufoff, kbase, h, vo) do { if constexpr (GA) { PG8_STAGE(bufoff, kbase, (vo)[h]); } else { PG8_STAGE_D(bufoff, (kbase) + (h) * hstep, voffA[0][0], dA); } } while (0)
    PG8_STAGE_D(PG8_SB(0, 0), cB, voffB[0], dB); PG8_STAGE_D(PG8_SB(0, 1), cB + hstepB, voffB[0], dB); PG8_STAGE_A(PG8_SA(0, 0), cA, 0, voffA); PG8_STAGE_A(PG8_SA(0, 1), cA, 1, voffA);
    if (wr == 1) PG8_BAR;
    PG8_WAIT_V(2); PG8_BAR;
    PG8_STAGE_D(PG8_SB(1, 0), cB + kstepB, voffB[0], dB); PG8_STAGE_A(PG8_SA(1, 0), cA + kstep, 0, voffA); PG8_STAGE_D(PG8_SB(1, 1), cB + hstepB + kstepB, voffB[0], dB);
    PG8_WAIT_V(6); PG8_BAR;
    for (;;) {
        const bool has_next = S.next(ui + 1, nxt);
        const char* nA = has_next ? S.a_ptr(nxt) : cA; const char* nB = has_next ? S.b_ptr(nxt) : cB;
        if constexpr (GA) { if (has_next) PG8_AVOFF(nxt, voffAn);
            else {
#pragma unroll
                for (int h = 0; h < 2; ++h)
#pragma unroll
                    for (int i = 0; i < 2; ++i) voffAn[h][i] = voffA[h][i]; } }
#pragma unroll 1
        for (int t = 0; t < nt; t += 2) {
            const bool last = (t == nt - 2);
            const char* a1 = cA + (size_t)(t + 1) * kstep;
            const char* a2 = last ? nA : cA + (size_t)(t + 2) * kstep; const char* b2 = last ? nB : cB + (size_t)(t + 2) * kstepB;
            const char* a3 = a2 + kstep; const char* b3 = b2 + kstepB;
            PG8_LDB(B0, 0, 0); PG8_LDB(B1, 0, 1); PG8_SCHED; PG8_LDA(At, 0, 0); PG8_STAGE_A(PG8_SA(1, 1), a1, 1, voffA);
            if constexpr (GA) { if (last) {
#pragma unroll
                for (int h = 0; h < 2; ++h)
#pragma unroll
                    for (int i = 0; i < 2; ++i) voffA[h][i] = voffAn[h][i]; } }
            PG8_WAIT_V(8); PG8_WAIT_L(0); PG8_BAR; PG8_MMA(0, 0, At, B0); PG8_MMA(0, 1, At, B1); PG8_BAR; PG8_SCHED;
            PG8_LDA(At, 0, 1); PG8_STAGE_D(PG8_SB(0, 0), b2, voffB[0], dB); PG8_STAGE_D(PG8_SB(0, 1), b2 + hstepB, voffB[0], dB); PG8_STAGE_A(PG8_SA(0, 0), a2, 0, voffA);
            PG8_WAIT_V(8); PG8_WAIT_L(0); PG8_BAR; PG8_MMA(1, 0, At, B0); PG8_MMA(1, 1, At, B1); PG8_BAR; PG8_SCHED;
            PG8_LDB(B0, 1, 0); PG8_LDB(B1, 1, 1); PG8_SCHED; PG8_LDA(At, 1, 0); PG8_STAGE_A(PG8_SA(0, 1), a2, 1, voffA);
            PG8_WAIT_V(8); PG8_WAIT_L(0); PG8_BAR; PG8_MMA(0, 0, At, B0); PG8_MMA(0, 1, At, B1); PG8_BAR; PG8_SCHED;
            PG8_LDA(At, 1, 1); PG8_STAGE_D(PG8_SB(1, 0), b3, voffB[0], dB); PG8_STAGE_D(PG8_SB(1, 1), b3 + hstepB, voffB[0], dB); PG8_STAGE_A(PG8_SA(1, 0), a3, 0, voffA);
            PG8_WAIT_V(8); PG8_WAIT_L(0); PG8_BAR; PG8_MMA(1, 0, At, B0); PG8_MMA(1, 1, At, B1); PG8_BAR; PG8_SCHED;
        }
        if constexpr (ALIGN_EPI) { if (wr == 0) PG8_BAR; }
        { Unit ue = cur; ue.pm = __builtin_amdgcn_readfirstlane(ue.pm); ue.pn = __builtin_amdgcn_readfirstlane(ue.pn); ue.e = __builtin_amdgcn_readfirstlane(ue.e); asm volatile("" : "+s"(ue.pm), "+s"(ue.pn), "+s"(ue.e));
          const int t3_ = fresh_tid(); const int fr_ = t3_ & 15, fq_ = (t3_ & 63) >> 4;
          E(acc, ue, wr, wc, fr_, fq_); }
        if (!has_next) break;
#pragma unroll
        for (int a = 0; a < 2; ++a)
#pragma unroll
            for (int b = 0; b < 2; ++b)
#pragma unroll
                for (int m = 0; m < 4; ++m)
#pragma unroll
                    for (int n = 0; n < 2; ++n) acc[a][b][m][n] = (f32x4){0.f, 0.f, 0.f, 0.f};
        cur = nxt; cA = nA; cB = nB; ++ui;
        if constexpr (ALIGN_EPI) { if (wr == 1) PG8_BAR; }
    }
    PG8_WAIT_V(0);
    if constexpr (!ALIGN_EPI) { if (wr == 0) PG8_BAR; }
    PG8_BAR;
#undef PG8_SA
#undef PG8_SB
#undef PG8_STAGE
#undef PG8_STAGE1
#undef PG8_STAGE_D
#undef PG8_STAGE_A
#undef PG8_AVOFF
#undef PG8_LDA
#undef PG8_LDB
#undef PG8_MMA
#undef PG8_WAIT_V
#undef PG8_WAIT_L
#undef PG8_BAR
#undef PG8_SCHED
}
}
using pg8::Unit;
using pg8::cvt_pk_bf16;

DI float bflo(unsigned w) { return __uint_as_float(w << 16); }
DI float bfhi(unsigned w) { return __uint_as_float(w & 0xffff0000u); }
DI float bf2f(bf16 b) { return __uint_as_float(((unsigned)b) << 16); }
typedef __bf16 hwbf2 __attribute__((ext_vector_type(2)));
DI unsigned pk2(float lo, float hi) { const f32x2 v = {lo, hi}; return __builtin_bit_cast(unsigned, __builtin_convertvector(v, hwbf2)); }
DI unsigned f2bf(float f) { return pk2(f, 0.f) & 0xffffu; }
DI float rcp_f(float x) { return __builtin_amdgcn_rcpf(x); }
DI float rsq_f(float x) { return __builtin_amdgcn_rsqf(x); }
DI float sigmoid_f(float x) { return rcp_f(1.0f + __expf(-x)); }
DI float tanh_fast(float x) { return 1.0f - 2.0f * rcp_f(__expf(2.0f * x) + 1.0f); }
DI float softplus_f(float x) { return fmaxf(x, 0.f) + __logf(1.0f + __expf(-fabsf(x))); }
DI float softplus_fast(float x) { return fmaxf(x, 0.f) + __logf(1.0f + __expf(-fabsf(x))); }
DI float gelu_tanh_f(float x) { const float u = 0.7978845608028654f * (x + 0.044715f * x * x * x); return 0.5f * x * (1.0f + tanh_fast(u)); }
DI float wave_sum(float v) {
#pragma unroll
    for (int o = 1; o < 64; o <<= 1) v += __shfl_xor(v, o);
    return v;
}

DI unsigned pk4_fp8(float a, float b, float c, float d) { int w = 0; w = __builtin_amdgcn_cvt_pk_fp8_f32(a, b, w, false); w = __builtin_amdgcn_cvt_pk_fp8_f32(c, d, w, true); return (unsigned)w; }
struct EpiBf16Plain {
    static constexpr bool PERM = true;
    bf16* O; int ldc; float scale;
    DI void operator()(const f32x4 (&acc)[2][2][4][2], const Unit& u, int wr, int wc, int fr, int fq) const {
        const int row0 = u.pm * 256 + wr * 64 + fr, col0 = u.pn * 256 + wc * 32 + 8 * fq;
#pragma unroll
        for (int ai = 0; ai < 2; ++ai)
#pragma unroll
            for (int m = 0; m < 4; ++m) { bf16* rowp = O + (size_t)(row0 + ai * 128 + m * 16) * ldc + col0;
#pragma unroll
                for (int bj = 0; bj < 2; ++bj) { const f32x4 v0 = acc[ai][bj][m][0] * scale, v1 = acc[ai][bj][m][1] * scale;
                    u32x4 w; w.x = cvt_pk_bf16(v0[0], v0[1]); w.y = cvt_pk_bf16(v0[2], v0[3]); w.z = cvt_pk_bf16(v1[0], v1[1]); w.w = cvt_pk_bf16(v1[2], v1[3]);
                    *(u32x4*)(rowp + bj * 128) = w; } }
    }
};
template <int MODE> struct EpiFold {
    static constexpr bool PERM = true;
    unsigned char* O;
    DI void operator()(const f32x4 (&acc)[2][2][4][2], const Unit& u, int wr, int wc, int fr, int fq) const {
        const int b = u.pm >> 2, h = u.pm & 3;
        const int rbase = MODE == 0 ? h * 256 : u.pn * 256, cbase = MODE == 0 ? u.pn * 256 : h * 256;
        const unsigned boff = (unsigned)b * 1024u * 1024u + (unsigned)(rbase + wr * 64 + fr) * 1024u + (unsigned)(cbase + wc * 32 + 8 * fq);
#pragma unroll
        for (int ai = 0; ai < 2; ++ai)
#pragma unroll
            for (int m = 0; m < 4; ++m) { unsigned char* rowp = O + (boff + (unsigned)(ai * 128 + m * 16) * 1024u);
#pragma unroll
                for (int bj = 0; bj < 2; ++bj) { const f32x4 v0 = acc[ai][bj][m][0] * 4.0f, v1 = acc[ai][bj][m][1] * 4.0f;
                    u32x2 w; w.x = pk4_fp8(v0[0], v0[1], v0[2], v0[3]); w.y = pk4_fp8(v1[0], v1[1], v1[2], v1[3]);
                    *(u32x2*)(rowp + bj * 128) = w; } }
    }
};
struct EpiSoftmax {
    static constexpr bool PERM = true;
    unsigned char* O; float scale; const float* RS; LAS float* XM; LAS float* XS;
    DI void operator()(const f32x4 (&acc)[2][2][4][2], const Unit& u, int wr, int wc, int fr, int fq) const {
        const int row0 = u.pm * 256 + wr * 64 + fr, col0 = u.pn * 256 + wc * 32 + 8 * fq;
        float sc[2][4];
#pragma unroll
        for (int ai = 0; ai < 2; ++ai)
#pragma unroll
            for (int m = 0; m < 4; ++m) { const int r = row0 + ai * 128 + m * 16; const f32x4* rp = (const f32x4*)(RS + (size_t)r * 16);
                const f32x4 p0 = rp[0], p1 = rp[1], p2 = rp[2], p3 = rp[3];
                const float ss = ((p0[0] + p0[1]) + (p0[2] + p0[3])) + ((p1[0] + p1[1]) + (p1[2] + p1[3])) + ((p2[0] + p2[1]) + (p2[2] + p2[3])) + ((p3[0] + p3[1]) + (p3[2] + p3[3]));
                sc[ai][m] = scale * __builtin_amdgcn_rsqf(ss * (1.0f / 1024.0f) + 1e-6f);
                float mm = -3.0e38f;
#pragma unroll
                for (int bj = 0; bj < 2; ++bj)
#pragma unroll
                    for (int n = 0; n < 2; ++n) { const f32x4 v = acc[ai][bj][m][n]; mm = fmaxf(mm, fmaxf(fmaxf(v[0], v[1]), fmaxf(v[2], v[3]))); }
                mm *= sc[ai][m];
                mm = fmaxf(mm, __shfl_xor(mm, 16)); mm = fmaxf(mm, __shfl_xor(mm, 32));
                if (fq == 0) XM[(ai * 128 + wr * 64 + m * 16 + fr) * 4 + wc] = mm; }
        asm volatile("s_waitcnt lgkmcnt(0)" ::: "memory"); __builtin_amdgcn_s_barrier(); asm volatile("" ::: "memory");
        f32x4 (&pa)[2][2][4][2] = const_cast<f32x4 (&)[2][2][4][2]>(acc);
#pragma unroll
        for (int ai = 0; ai < 2; ++ai)
#pragma unroll
            for (int m = 0; m < 4; ++m) { const int lr = ai * 128 + wr * 64 + m * 16 + fr; const f32x4 q = *(const LAS f32x4*)(XM + lr * 4);
                const float mxr = fmaxf(fmaxf(q[0], q[1]), fmaxf(q[2], q[3])); float sm = 0.f;
#pragma unroll
                for (int bj = 0; bj < 2; ++bj)
#pragma unroll
                    for (int n = 0; n < 2; ++n)
#pragma unroll
                        for (int j = 0; j < 4; ++j) { const float p = __expf(acc[ai][bj][m][n][j] * sc[ai][m] - mxr); pa[ai][bj][m][n][j] = p; sm += p; }
                sm += __shfl_xor(sm, 16); sm += __shfl_xor(sm, 32);
                if (fq == 0) XS[lr * 4 + wc] = sm; }
        asm volatile("s_waitcnt lgkmcnt(0)" ::: "memory"); __builtin_amdgcn_s_barrier(); asm volatile("" ::: "memory");
#pragma unroll
        for (int ai = 0; ai < 2; ++ai)
#pragma unroll
            for (int m = 0; m < 4; ++m) { const int lr = ai * 128 + wr * 64 + m * 16 + fr; const f32x4 q = *(const LAS f32x4*)(XS + lr * 4);
                const float inv = 256.0f * __builtin_amdgcn_rcpf((q[0] + q[1]) + (q[2] + q[3]));
                unsigned char* rowp = O + (size_t)(row0 + ai * 128 + m * 16) * 1024 + col0;
#pragma unroll
                for (int bj = 0; bj < 2; ++bj) { const f32x4 v0 = pa[ai][bj][m][0] * inv, v1 = pa[ai][bj][m][1] * inv;
                    u32x2 w; w.x = pk4_fp8(v0[0], v0[1], v0[2], v0[3]); w.y = pk4_fp8(v1[0], v1[1], v1[2], v1[3]);
                    *(u32x2*)(rowp + bj * 128) = w; } }
        asm volatile("s_waitcnt lgkmcnt(0)" ::: "memory"); __builtin_amdgcn_s_barrier(); asm volatile("" ::: "memory");
    }
};
struct EpiBf16RowNorm {
    static constexpr bool PERM = true;
    bf16* O; int ldc; float scale; const float* RS;
    DI void operator()(const f32x4 (&acc)[2][2][4][2], const Unit& u, int wr, int wc, int fr, int fq) const {
        const int row0 = u.pm * 256 + wr * 64 + fr, col0 = u.pn * 256 + wc * 32 + 8 * fq;
#pragma unroll
        for (int ai = 0; ai < 2; ++ai)
#pragma unroll
            for (int m = 0; m < 4; ++m) { const int r = row0 + ai * 128 + m * 16; const f32x4* rp = (const f32x4*)(RS + (size_t)r * 16);
                const f32x4 p0 = rp[0], p1 = rp[1], p2 = rp[2], p3 = rp[3];
                const float ss = ((p0[0] + p0[1]) + (p0[2] + p0[3])) + ((p1[0] + p1[1]) + (p1[2] + p1[3])) + ((p2[0] + p2[1]) + (p2[2] + p2[3])) + ((p3[0] + p3[1]) + (p3[2] + p3[3]));
                const float sc = scale * __builtin_amdgcn_rsqf(ss * (1.0f / 1024.0f) + 1e-6f);
                bf16* rowp = O + (size_t)r * ldc + col0;
#pragma unroll
                for (int bj = 0; bj < 2; ++bj) { const f32x4 v0 = acc[ai][bj][m][0] * sc, v1 = acc[ai][bj][m][1] * sc;
                    u32x4 w; w.x = cvt_pk_bf16(v0[0], v0[1]); w.y = cvt_pk_bf16(v0[2], v0[3]); w.z = cvt_pk_bf16(v1[0], v1[1]); w.w = cvt_pk_bf16(v1[2], v1[3]);
                    *(u32x4*)(rowp + bj * 128) = w; } }
    }
};
template <bool RES_BF16> struct EpiBf16Res {
    static constexpr bool PERM = true;
    const void* Rz; bf16* O; int ldc; float* RS; float ascale; unsigned char* O8;
    DI void operator()(const f32x4 (&acc)[2][2][4][2], const Unit& u, int wr, int wc, int fr, int fq) const {
        const int row0 = u.pm * 256 + wr * 64 + fr, col0 = u.pn * 256 + wc * 32 + 8 * fq;
#pragma unroll
        for (int ai = 0; ai < 2; ++ai) {
            u32x4 rwb[4][2]; f32x4 rf0[4][2], rf1[4][2];
#pragma unroll
            for (int m = 0; m < 4; ++m) { const size_t off = (size_t)(row0 + ai * 128 + m * 16) * ldc + col0;
#pragma unroll
                for (int bj = 0; bj < 2; ++bj) {
                    if (RES_BF16) rwb[m][bj] = __builtin_nontemporal_load((const u32x4*)((const bf16*)Rz + off + bj * 128));
                    else { rf0[m][bj] = __builtin_nontemporal_load((const f32x4*)((const float*)Rz + off + bj * 128)); rf1[m][bj] = __builtin_nontemporal_load((const f32x4*)((const float*)Rz + off + bj * 128 + 4)); } } }
#pragma unroll
            for (int m = 0; m < 4; ++m) { const size_t off = (size_t)(row0 + ai * 128 + m * 16) * ldc + col0; float ssq = 0.f;
#pragma unroll
                for (int bj = 0; bj < 2; ++bj) { f32x4 r0, r1;
                    if (RES_BF16) { const u32x4 rw = rwb[m][bj]; r0 = (f32x4){bflo(rw.x), bfhi(rw.x), bflo(rw.y), bfhi(rw.y)}; r1 = (f32x4){bflo(rw.z), bfhi(rw.z), bflo(rw.w), bfhi(rw.w)}; }
                    else { r0 = rf0[m][bj]; r1 = rf1[m][bj]; }
                    const f32x4 v0 = r0 + acc[ai][bj][m][0] * ascale, v1 = r1 + acc[ai][bj][m][1] * ascale;
                    if (O8) { u32x2 w8; w8.x = pk4_fp8(v0[0], v0[1], v0[2], v0[3]); w8.y = pk4_fp8(v1[0], v1[1], v1[2], v1[3]); *(u32x2*)(O8 + off + bj * 128) = w8; }
                    ssq += (v0[0] * v0[0] + v0[1] * v0[1]) + (v0[2] * v0[2] + v0[3] * v0[3]) + (v1[0] * v1[0] + v1[1] * v1[1]) + (v1[2] * v1[2] + v1[3] * v1[3]);
                    u32x4 w; w.x = cvt_pk_bf16(v0[0], v0[1]); w.y = cvt_pk_bf16(v0[2], v0[3]); w.z = cvt_pk_bf16(v1[0], v1[1]); w.w = cvt_pk_bf16(v1[2], v1[3]);
                    *(u32x4*)(O + off + bj * 128) = w; }
                if (RS) { ssq += __shfl_xor(ssq, 16); ssq += __shfl_xor(ssq, 32); if (fq == 0) RS[(size_t)(row0 + ai * 128 + m * 16) * 16 + u.pn * 4 + wc] = ssq; } } }
    }
};
struct EpiLora {
    static constexpr bool PERM = false;
    float* LWp; bf16* AAp; bf16* GGp; const float* w0; const float* a0;
    DI void operator()(const f32x4 (&acc)[2][2][4][2], const Unit& u, int wr, int wc, int fr, int fq) const {
        const int kind = u.pn >> 1;
        const int row0 = u.pm * 256 + wr * 64 + fr, col0 = (u.pn & 1) * 256 + wc * 32 + 4 * fq;
#pragma unroll
        for (int bj = 0; bj < 2; ++bj)
#pragma unroll
            for (int n = 0; n < 2; ++n) {
                const int c = col0 + bj * 128 + n * 16;
                f32x4 bias = (f32x4){0.f, 0.f, 0.f, 0.f};
                if (kind == 0) bias = *(const f32x4*)(w0 + c); else if (kind == 1) bias = *(const f32x4*)(a0 + c);
#pragma unroll
                for (int ai = 0; ai < 2; ++ai)
#pragma unroll
                    for (int m = 0; m < 4; ++m) {
                        f32x4 v = acc[ai][bj][m][n] + bias;
                        if (kind == 0) {
#pragma unroll
                            for (int j = 0; j < 4; ++j) { const float w = -softplus_fast(-v[j]) - 0.5f; v[j] = -__expf(w);     }
                        } else if (kind == 1) {
#pragma unroll
                            for (int j = 0; j < 4; ++j) v[j] = sigmoid_f(v[j]);
                        }
                        const size_t o_ = (size_t)(row0 + ai * 128 + m * 16) * 512 + c;
                        if (kind == 0) *(f32x4*)(LWp + o_) = v;
                        else { u32x2 w_; w_.x = cvt_pk_bf16(v[0], v[1]); w_.y = cvt_pk_bf16(v[2], v[3]); *(u32x2*)((kind == 1 ? AAp : GGp) + o_) = w_; }
                    }
            }
    }
};
typedef float f32x2_t __attribute__((ext_vector_type(2)));
struct EpiSwiglu {
    static constexpr bool PERM = true;
    bf16* ACT; const float* b_gu;
    DI void operator()(const f32x4 (&acc)[2][2][4][2], const Unit& u, int wr, int wc, int fr, int fq) const {
        const int row0 = u.pm * 256 + wr * 64 + fr, j0 = u.pn * 128 + wc * 32 + 8 * fq;
        const float* bg = b_gu + (size_t)u.e * 2048 + j0; const float* bu = bg + 1024;
        const f32x4 bg0 = *(const f32x4*)bg, bg1 = *(const f32x4*)(bg + 4), bu0 = *(const f32x4*)bu, bu1 = *(const f32x4*)(bu + 4);
#pragma unroll
        for (int ai = 0; ai < 2; ++ai)
#pragma unroll
            for (int m = 0; m < 4; ++m) {
                float o[8];
#pragma unroll
                for (int n = 0; n < 2; ++n) { const f32x4 g4 = acc[ai][0][m][n] * 0.015625f + (n ? bg1 : bg0), u4 = acc[ai][1][m][n] * 0.015625f + (n ? bu1 : bu0);
#pragma unroll
                    for (int p = 0; p < 2; ++p) {
                        f32x2_t g, up; g.x = fminf(g4[2 * p], 7.0f); g.y = fminf(g4[2 * p + 1], 7.0f); up.x = fminf(fmaxf(u4[2 * p], -7.0f), 7.0f); up.y = fminf(fmaxf(u4[2 * p + 1], -7.0f), 7.0f);
                        const f32x2_t ex = g * (-1.702f * 1.44269504089f); f32x2_t d; d.x = __builtin_amdgcn_exp2f(ex.x); d.y = __builtin_amdgcn_exp2f(ex.y); d = d + 1.0f;
                        f32x2_t r; r.x = __builtin_amdgcn_rcpf(d.x); r.y = __builtin_amdgcn_rcpf(d.y);
                        const f32x2_t ov = (up + 1.0f) * (g * r); o[n * 4 + 2 * p] = ov.x; o[n * 4 + 2 * p + 1] = ov.y; } }
                u32x2 w; w.x = pk4_fp8(o[0], o[1], o[2], o[3]); w.y = pk4_fp8(o[4], o[5], o[6], o[7]);
                *(u32x2*)((unsigned char*)ACT + (size_t)(row0 + ai * 128 + m * 16) * 1024 + j0) = w;
            }
    }
};
struct EpiDown {
    static constexpr bool PERM = true;
    bf16* YS; const float* b_dn; const u32x2* row_sg;
    DI void operator()(const f32x4 (&acc)[2][2][4][2], const Unit& u, int wr, int wc, int fr, int fq) const {
        const int row0 = u.pm * 256 + wr * 64 + fr, col0 = u.pn * 256 + wc * 32 + 8 * fq;
        const float* bb = b_dn + (size_t)u.e * 1024 + col0;
        f32x4 bv[2][2];
#pragma unroll
        for (int bj = 0; bj < 2; ++bj)
#pragma unroll
            for (int n = 0; n < 2; ++n) bv[bj][n] = *(const f32x4*)(bb + bj * 128 + 4 * n);
        int slots[8]; float gts[8];
        { const u32x2* sgp = row_sg + row0;
#pragma unroll
        for (int q = 0; q < 8; ++q) { const u32x2 sg = sgp[(q >> 2) * 128 + (q & 3) * 16]; slots[q] = (int)sg.x; gts[q] = __uint_as_float(sg.y); } }
#pragma unroll
        for (int ai = 0; ai < 2; ++ai)
#pragma unroll
            for (int m = 0; m < 4; ++m) {
                const int slot = slots[ai * 4 + m]; const float gt = gts[ai * 4 + m];
                if (slot >= 0) { unsigned char* rowp = (unsigned char*)YS + (size_t)slot * 1024 + col0; const float g16 = gt * 16.0f;
#pragma unroll
                    for (int bj = 0; bj < 2; ++bj) { const f32x4 v0 = (acc[ai][bj][m][0] * 0.015625f + bv[bj][0]) * g16, v1 = (acc[ai][bj][m][1] * 0.015625f + bv[bj][1]) * g16;
                        u32x2 w; w.x = pk4_fp8(v0[0], v0[1], v0[2], v0[3]); w.y = pk4_fp8(v1[0], v1[1], v1[2], v1[3]);
                        *(u32x2*)(rowp + bj * 128) = w; } }
            }
    }
};

constexpr size_t MiB = 1u << 20;
constexpr size_t WS_CTL = 0, CTL_ZERO_BYTES = 1 * MiB;
constexpr size_t WS_WIN = 1 * MiB, WS_WOUT = 7 * MiB, WS_WQ = 9 * MiB, WS_WK = 11 * MiB, WS_WV = 13 * MiB, WS_WO = 15 * MiB, WS_LORAB = 17 * MiB, WS_LRUW = 18 * MiB;
constexpr size_t WS_ROUTE = 19 * MiB;
constexpr size_t WS_WGU = 22 * MiB, WS_WDN = 150 * MiB;
constexpr size_t WS_HN = 214 * MiB, WS_MEMN = 246 * MiB, WS_KM = 248 * MiB, WS_VT = 250 * MiB;
constexpr size_t WS_X1 = 252 * MiB, WS_X2 = 316 * MiB;
constexpr size_t WS_U = 380 * MiB, WS_R = 468 * MiB, WS_KRAW = 500 * MiB, WS_V = 532 * MiB, WS_KKN = 564 * MiB, WS_WD = 596 * MiB, WS_AA = 628 * MiB, WS_G = 660 * MiB;
constexpr size_t WS_LA = 692 * MiB, WS_LB = 724 * MiB, WS_AP = 756 * MiB, WS_CAT = 764 * MiB, WS_Q = 796 * MiB;
constexpr size_t WS_XS = 380 * MiB, WS_ACT = 524 * MiB, WS_YS = 668 * MiB;
constexpr size_t WS_GP = 796 * MiB, WS_HF = 860 * MiB, WS_RP = 924 * MiB, WS_Y1F = 940 * MiB, WS_ADD = 972 * MiB, WS_END = 1004 * MiB;
constexpr size_t WS_GC = 468 * MiB, WS_HC = 484 * MiB, WS_ZS = 500 * MiB;
static_assert(WS_AA == WS_WD + 32 * MiB && WS_G == WS_AA + 32 * MiB, "EpiLora strides");
static_assert(WS_U + (size_t)M * INW * 2 <= WS_R && WS_XS + (size_t)MAXROWS * 2048 <= WS_ACT && WS_ACT + (size_t)MAXROWS * 2048 <= WS_YS && WS_YS + (size_t)NASSIGN * 2048 <= WS_Q, "ws map");
constexpr size_t RT_E = 0, RT_POS = 256 * 1024, RT_G = 512 * 1024, RT_SLOT = 768 * 1024, RT_GATE = 1088 * 1024, RT_TILE = 1408 * 1024, RT_TOK = 1472 * 1024, RT_UGU = 1792 * 1024, RT_UDN = 1808 * 1024;
constexpr int CW_BAR = 4096, CW_CNT = 8192, CW_CONV = 12288;

constexpr int RING_BYTES = 131072, MISC_OFF = RING_BYTES + 320, LDS_BYTES = 147456;
constexpr int NWAVES = 8, NTHREADS = 512;
constexpr int CONV_P9 = 6144;
constexpr int CONV_P9D = 16384;

#define XB_TMO      128
#define XB_XCNT(j)  (256  + 64 * (j))
#define XB_XSUB(j)  (1280 + 64 * (j))
#define XB_XGEN(j)  (2304 + 64 * (j))
#define XB_TOP      3328
#define XB_TOPGEN   3392
#define XCD_BAR_WORDS 3456
#define XB_SPIN_CAP (1u << 18)
DI unsigned xb_ld(unsigned* p)              { return __hip_atomic_load(p, __ATOMIC_RELAXED, __HIP_MEMORY_SCOPE_AGENT); }
DI unsigned xb_add(unsigned* p, unsigned v) { return __hip_atomic_fetch_add(p, v, __ATOMIC_RELAXED, __HIP_MEMORY_SCOPE_AGENT); }
DI unsigned xb_xcc_id() { return (unsigned)__builtin_amdgcn_s_getreg((3 << 11) | 20) & 0xFu; }
#define XB_SPIN(cond, bar) do { unsigned _sp = 0; while (cond) { __builtin_amdgcn_s_sleep(1); \
    if ((++_sp & 255u) == 0u) { if (xb_ld(&(bar)[XB_TMO])) break; if (_sp > XB_SPIN_CAP) { atomicAdd(&(bar)[XB_TMO], 1u); break; } } } } while (0)
struct XcdBarrier { unsigned* bar; unsigned x; volatile LAS unsigned* st; int w0; };
DI XcdBarrier xcd_barrier_post(unsigned* bar, volatile LAS unsigned* st, int w0) {
    XcdBarrier b; b.bar = bar; b.x = xb_xcc_id(); b.st = st; b.w0 = w0;
    if (fresh_tid_(w0) == 0) (void)xb_add(&bar[XB_XCNT(b.x)], 1u);
    return b;
}
DI void xcd_barrier_complete(unsigned* bar, unsigned x, unsigned& nloc, unsigned& nx) {
    const unsigned G = gridDim.x * gridDim.y * gridDim.z;
    unsigned sum, cnt, mine, sp = 0u;
    for (;;) {
        sum = 0u; cnt = 0u; mine = 0u;
#pragma unroll
        for (unsigned j = 0; j < 16; ++j) { const unsigned c = xb_ld(&bar[XB_XCNT(j)]); sum += c; cnt += (c > 0u) ? 1u : 0u; mine = (j == x) ? c : mine; }
        if (sum == G) break;
        __builtin_amdgcn_s_sleep(1);
        if ((++sp & 255u) == 0u) { if (xb_ld(&bar[XB_TMO])) break; if (sp > XB_SPIN_CAP) { atomicAdd(&bar[XB_TMO], 1u); break; } }
    }
    nloc = mine > 0u ? mine : 1u; nx = cnt > 0u ? cnt : 1u;
}
DI void xcd_barrier(const XcdBarrier& b) {
    asm volatile("s_waitcnt vmcnt(0)" ::: "memory");
    __syncthreads();
    if (fresh_tid_(b.w0) == 0) {
        unsigned* bar = b.bar;
        __builtin_amdgcn_s_waitcnt(0);
        unsigned nloc = b.st[0], nx = b.st[1];
        if (nloc == 0u) { xcd_barrier_complete(bar, b.x, nloc, nx); b.st[0] = nloc; b.st[1] = nx; }
        const unsigned old = xb_add(&bar[XB_XSUB(b.x)], 1u);
        const unsigned gen = old / nloc;
        if (old + 1u == (gen + 1u) * nloc) {
            __builtin_amdgcn_fence(__ATOMIC_RELEASE, "agent");
            asm volatile("s_waitcnt vmcnt(0)" ::: "memory");
            const unsigned og = xb_add(&bar[XB_TOP], 1u);
            const unsigned tg = og / nx;
            if (og + 1u == (tg + 1u) * nx) xb_add(&bar[XB_TOPGEN], 1u);
            else XB_SPIN(xb_ld(&bar[XB_TOPGEN]) == tg, bar);
            __builtin_amdgcn_fence(__ATOMIC_ACQUIRE, "agent");
            xb_add(&bar[XB_XGEN(b.x)], 1u);
            asm volatile("s_waitcnt vmcnt(0)" ::: "memory");
        } else {
            XB_SPIN(xb_ld(&bar[XB_XGEN(b.x)]) == gen, bar);
            __builtin_amdgcn_fence(__ATOMIC_ACQUIRE, "agent");
            asm volatile("s_waitcnt vmcnt(0)" ::: "memory");
        }
    }
    __syncthreads();
}

struct Args { const float* in[37]; float* out; unsigned char* ws; int ph_lo, ph_hi; };
enum { I_X = 0, I_MEM, I_NMIXG, I_WIN, I_CONVW, I_CONVB, I_LWX, I_LBX, I_LWA, I_LBA, I_LAM, I_MU, I_W0, I_WUP, I_A0, I_AUP, I_GUP, I_KK, I_KA, I_RK, I_LNG, I_LNB,
       I_WOUT, I_NXAG, I_NMEMG, I_WQ, I_WK, I_WV, I_WO, I_NFFG, I_WR, I_BR, I_WGU, I_BGU, I_WDN, I_BDN, I_FNG };

DI void transpose_item(const float* W, int ldw, int K, bf16* WT, int k0, int n0, int drow0, LAS float* scr, int lane, const float* rs = nullptr) {
    f32x4 t[8];
    const float* src = W + (size_t)(k0 + (lane >> 3)) * ldw + n0 + 4 * (lane & 7);
#pragma unroll
    for (int i = 0; i < 8; ++i) t[i] = *(const f32x4*)(src + (size_t)(8 * i) * ldw);
#pragma unroll
    for (int i = 0; i < 8; ++i) { const float sc_ = rs ? rs[k0 + 8 * i + (lane >> 3)] : 1.0f; LAS float* d = scr + (8 * i + (lane >> 3)) * 33 + 4 * (lane & 7); d[0] = t[i].x * sc_; d[1] = t[i].y * sc_; d[2] = t[i].z * sc_; d[3] = t[i].w * sc_; }
    asm volatile("s_waitcnt lgkmcnt(0)" ::: "memory");
    const int c = lane & 7;
#pragma unroll
    for (int j = 0; j < 4; ++j) { const int n = (lane >> 3) + 8 * j; const LAS float* s = scr + (8 * c) * 33 + n;
        u32x4 o; o.x = pk2(s[0 * 33], s[1 * 33]); o.y = pk2(s[2 * 33], s[3 * 33]); o.z = pk2(s[4 * 33], s[5 * 33]); o.w = pk2(s[6 * 33], s[7 * 33]);
        *(u32x4*)(WT + (size_t)(drow0 + n) * K + k0 + 8 * c) = o; }
    asm volatile("s_waitcnt lgkmcnt(0)" ::: "memory");
}
DI void transpose_item_tiled(const float* W, int ldw, int K, bf16* WTe, int k0, int n0, int drow0, LAS float* scr, int lane) {
    f32x4 t[8];
    const float* src = W + (size_t)(k0 + (lane >> 3)) * ldw + n0 + 4 * (lane & 7);
#pragma unroll
    for (int i = 0; i < 8; ++i) t[i] = *(const f32x4*)(src + (size_t)(8 * i) * ldw);
#pragma unroll
    for (int i = 0; i < 8; ++i) { LAS float* d = scr + (8 * i + (lane >> 3)) * 33 + 4 * (lane & 7); d[0] = t[i].x; d[1] = t[i].y; d[2] = t[i].z; d[3] = t[i].w; }
    asm volatile("s_waitcnt lgkmcnt(0)" ::: "memory");
    const int c = lane & 7;
#pragma unroll
    for (int j = 0; j < 4; ++j) { const int n = (lane >> 3) + 8 * j; const LAS float* s = scr + (8 * c) * 33 + n;
        u32x4 o; o.x = pk2(s[0 * 33], s[1 * 33]); o.y = pk2(s[2 * 33], s[3 * 33]); o.z = pk2(s[4 * 33], s[5 * 33]); o.w = pk2(s[6 * 33], s[7 * 33]);
        const int drow = drow0 + n, pn = drow >> 8, half = (drow >> 7) & 1, r = drow & 127, x = r & 31;
        const int rslot = (r & ~31) + 16 * ((x >> 2) & 1) + 4 * (x >> 3) + (x & 3);
        const size_t tb = ((size_t)(pn * (K / 64) + (k0 >> 6)) * 2 + half) * 16384 + pg8::lds_byte(rslot, 8 * c);
        *(u32x4*)((char*)WTe + tb) = o; }
    asm volatile("s_waitcnt lgkmcnt(0)" ::: "memory");
}
DI void transpose_item_tiled_nolds(const float* W, int ldw, int K, bf16* WTe, int k0, int n0, int drow0, int lane) {
    const int n = lane & 31, kh = lane >> 5;
    const float* src = W + (size_t)(k0 + 32 * kh) * ldw + n0 + n;
    float t[32];
#pragma unroll
    for (int i = 0; i < 32; ++i) t[i] = src[(size_t)i * ldw];
    const int drow = drow0 + n, pn = drow >> 8, half = (drow >> 7) & 1, r = drow & 127, x = r & 31;
    const int rslot = (r & ~31) + 16 * ((x >> 2) & 1) + 4 * (x >> 3) + (x & 3);
    const size_t tb0 = ((size_t)(pn * (K / 64) + (k0 >> 6)) * 2 + half) * 16384;
#pragma unroll
    for (int c = 0; c < 4; ++c) { u32x4 o; o.x = pk2(t[8 * c], t[8 * c + 1]); o.y = pk2(t[8 * c + 2], t[8 * c + 3]); o.z = pk2(t[8 * c + 4], t[8 * c + 5]); o.w = pk2(t[8 * c + 6], t[8 * c + 7]);
        *(u32x4*)((char*)WTe + tb0 + pg8::lds_byte(rslot, 32 * kh + 8 * c)) = o; }
}
DI void transpose_item_tiled_fp8_nolds(const float* W, int ldw, int K, unsigned char* WTe, int k0, int n0, int drow0, int lane) {
    const int n = lane & 31, kh = lane >> 5;
    const float* src = W + (size_t)(k0 + 32 * kh) * ldw + n0 + n;
    float t[32];
#pragma unroll
    for (int i = 0; i < 32; ++i) t[i] = __builtin_nontemporal_load(src + (size_t)i * ldw) * 64.f;
    const int drow = drow0 + n, pn = drow >> 8, half = (drow >> 7) & 1, r = drow & 127, x = r & 31;
    const int rslot = (r & ~31) + 16 * ((x >> 2) & 1) + 4 * (x >> 3) + (x & 3);
    const size_t tb0 = ((size_t)(pn * (K / 128) + (k0 >> 7)) * 2 + half) * 16384;
#pragma unroll
    for (int c = 0; c < 2; ++c) { u32x4 o; o.x = pk4_fp8(t[16 * c], t[16 * c + 1], t[16 * c + 2], t[16 * c + 3]); o.y = pk4_fp8(t[16 * c + 4], t[16 * c + 5], t[16 * c + 6], t[16 * c + 7]);
        o.z = pk4_fp8(t[16 * c + 8], t[16 * c + 9], t[16 * c + 10], t[16 * c + 11]); o.w = pk4_fp8(t[16 * c + 12], t[16 * c + 13], t[16 * c + 14], t[16 * c + 15]);
        const int bc = (k0 & 64) + 32 * kh + 16 * c;
        *(u32x4*)(WTe + tb0 + pg8::lds_byte(rslot, bc >> 1)) = o; }
}
DI void transpose_item_tiled_fp8(const float* W, int ldw, int K, unsigned char* WTe, int k0, int n0, int drow0, LAS float* scr, int lane) {
    f32x4 t[8];
    const float* src = W + (size_t)(k0 + (lane >> 3)) * ldw + n0 + 4 * (lane & 7);
#pragma unroll
    for (int i = 0; i < 8; ++i) t[i] = __builtin_nontemporal_load((const f32x4*)(src + (size_t)(8 * i) * ldw));
#pragma unroll
    for (int i = 0; i < 8; ++i) { LAS float* d = scr + (8 * i + (lane >> 3)) * 33 + 4 * (lane & 7); d[0] = t[i].x * 64.f; d[1] = t[i].y * 64.f; d[2] = t[i].z * 64.f; d[3] = t[i].w * 64.f; }
    asm volatile("s_waitcnt lgkmcnt(0)" ::: "memory");
    const int c = lane & 3;
#pragma unroll
    for (int j = 0; j < 2; ++j) { const int n = (lane >> 2) + 16 * j; const LAS float* sp = scr + (16 * c) * 33 + n;
        u32x4 o; o.x = pk4_fp8(sp[0 * 33], sp[1 * 33], sp[2 * 33], sp[3 * 33]); o.y = pk4_fp8(sp[4 * 33], sp[5 * 33], sp[6 * 33], sp[7 * 33]);
        o.z = pk4_fp8(sp[8 * 33], sp[9 * 33], sp[10 * 33], sp[11 * 33]); o.w = pk4_fp8(sp[12 * 33], sp[13 * 33], sp[14 * 33], sp[15 * 33]);
        const int drow = drow0 + n, pn = drow >> 8, half = (drow >> 7) & 1, r = drow & 127, x = r & 31;
        const int rslot = (r & ~31) + 16 * ((x >> 2) & 1) + 4 * (x >> 3) + (x & 3);
        const int bc = (k0 & 64) + 16 * c;
        const size_t tb = ((size_t)(pn * (K / 128) + (k0 >> 7)) * 2 + half) * 16384 + pg8::lds_byte(rslot, bc >> 1);
        *(u32x4*)(WTe + tb) = o; }
    asm volatile("s_waitcnt lgkmcnt(0)" ::: "memory");
}
DI void rms_row_to_bf16(const float* xrow, const float* g, bf16* orow, int lane) {
    const f32x4* xr = (const f32x4*)xrow + lane; const f32x4* gr = (const f32x4*)g + lane;
    f32x4 v[4]; float s = 0.f;
#pragma unroll
    for (int j = 0; j < 4; ++j) { v[j] = __builtin_nontemporal_load(xr + 64 * j); s += (v[j].x * v[j].x + v[j].y * v[j].y) + (v[j].z * v[j].z + v[j].w * v[j].w); }
    const float rstd = rsq_f(wave_sum(s) * (1.f / D) + EPS);
    u32x2* o8 = (u32x2*)orow + lane;
#pragma unroll
    for (int j = 0; j < 4; ++j) { const f32x4 gg = gr[64 * j]; u32x2 w; w.x = pk2(v[j].x * rstd * gg.x, v[j].y * rstd * gg.y); w.y = pk2(v[j].z * rstd * gg.z, v[j].w * rstd * gg.w); o8[64 * j] = w; }
}

DI void rms_rowbf_to_bf16(const bf16* xrow, const float* g, bf16* orow, int lane) {
    float v[16]; float s = 0.f;
#pragma unroll
    for (int hf = 0; hf < 2; ++hf) { const u32x4 w = *(const u32x4*)(xrow + 512 * hf + 8 * lane);
#pragma unroll
        for (int q = 0; q < 4; ++q) { v[8 * hf + 2 * q] = bflo(w[q]); v[8 * hf + 2 * q + 1] = bfhi(w[q]); } }
#pragma unroll
    for (int j = 0; j < 16; ++j) s += v[j] * v[j];
    const float rstd = rsq_f(wave_sum(s) * (1.f / D) + EPS);
#pragma unroll
    for (int hf = 0; hf < 2; ++hf) { const f32x4 g0 = *(const f32x4*)(g + 512 * hf + 8 * lane), g1 = *(const f32x4*)(g + 512 * hf + 8 * lane + 4);
        u32x4 w; w.x = pk2(v[8 * hf] * rstd * g0.x, v[8 * hf + 1] * rstd * g0.y); w.y = pk2(v[8 * hf + 2] * rstd * g0.z, v[8 * hf + 3] * rstd * g0.w);
        w.z = pk2(v[8 * hf + 4] * rstd * g1.x, v[8 * hf + 5] * rstd * g1.y); w.w = pk2(v[8 * hf + 6] * rstd * g1.z, v[8 * hf + 7] * rstd * g1.w);
        *(u32x4*)(orow + 512 * hf + 8 * lane) = w; }
}

__global__ void __launch_bounds__(NTHREADS, 2) fwd(Args args) {
    extern __shared__ __attribute__((aligned(16))) unsigned char lds_raw[];
    LAS unsigned char* lds = (LAS unsigned char*)lds_raw;
    volatile LAS unsigned* MISC = (volatile LAS unsigned*)(lds + MISC_OFF);
    const int G = gridDim.x, bid = blockIdx.x, NGW = G * NWAVES;
    const int wv0 = __builtin_amdgcn_readfirstlane((int)(threadIdx.x >> 6));
#define PHASE_IDS const int tid = fresh_tid(), lane = tid & 63, wave = __builtin_amdgcn_readfirstlane(tid >> 6), gw = bid * NWAVES + wave; (void)tid; (void)lane; (void)wave; (void)gw
    unsigned char* ws = args.ws;
    unsigned* ctl = (unsigned*)(ws + WS_CTL);
    const int lo = args.ph_lo, hi = args.ph_hi;

    for (int u = fresh_tid(); u < (LDS_BYTES - RING_BYTES) / 4; u += NTHREADS) ((LAS unsigned*)(lds + RING_BYTES))[u] = 0u;
    __syncthreads();
    XcdBarrier bar; bar.bar = ctl + CW_BAR; bar.x = 0; bar.st = nullptr; bar.w0 = wv0;
    if (hi - lo > 1) bar = xcd_barrier_post(ctl + CW_BAR, MISC + 8, wv0);
#define IN(k) (lo <= (k) && (k) < hi)
#define SEAM(k) do { if (IN(k) && IN((k) + 1)) xcd_barrier(bar); } while (0)

#define Win_t ((bf16*)(ws + WS_WIN))
#define Wout_t ((bf16*)(ws + WS_WOUT))
#define Wq_t ((bf16*)(ws + WS_WQ))
#define Wk_t ((bf16*)(ws + WS_WK))
#define Wv_t ((bf16*)(ws + WS_WV))
#define Wo_t ((bf16*)(ws + WS_WO))
#define LoraB ((bf16*)(ws + WS_LORAB))
#define LruW ((bf16*)(ws + WS_LRUW))
#define WrT ((bf16*)(ws + WS_LRUW + 512 * 1024))
#define Wgu_t ((bf16*)(ws + WS_WGU))
#define Wdn_t ((bf16*)(ws + WS_WDN))
#define HN ((bf16*)(ws + WS_HN))
#define MEMN ((bf16*)(ws + WS_MEMN))
#define KM ((bf16*)(ws + WS_KM))
#define VT ((bf16*)(ws + WS_VT))
#define X1 ((bf16*)(ws + WS_X1))
#define X2 ((bf16*)(ws + WS_X2))
#define U ((bf16*)(ws + WS_U))
#define Rr ((float*)(ws + WS_R))
#define KRAW ((float*)(ws + WS_KRAW))
#define Vv ((float*)(ws + WS_V))
#define KKN ((float*)(ws + WS_KKN))
#define WD ((float*)(ws + WS_WD))
#define AA ((float*)(ws + WS_AA))
#define GG ((float*)(ws + WS_G))
#define LA ((bf16*)(ws + WS_LA))
#define LB ((bf16*)(ws + WS_LB))
#define AP ((bf16*)(ws + WS_AP))
#define CAT ((bf16*)(ws + WS_CAT))
#define Qb ((bf16*)(ws + WS_Q))
#define Ob CAT
#define X1F8 ((unsigned char*)(ws + WS_XS))
#define XS ((bf16*)(ws + WS_XS))
#define ACT ((bf16*)(ws + WS_ACT))
#define YS ((bf16*)(ws + WS_YS))
#define route_e ((int*)(ws + WS_ROUTE + RT_E))
#define route_pos ((int*)(ws + WS_ROUTE + RT_POS))
#define route_g ((float*)(ws + WS_ROUTE + RT_G))
#define row_sg ((u32x2*)(ws + WS_ROUTE + RT_SLOT))
#define tile_tab ((int*)(ws + WS_ROUTE + RT_TILE))
#define row_tok ((int*)(ws + WS_ROUTE + RT_TOK))
#define ecnt (ctl + CW_CNT)

    if (IN(0)) { PHASE_IDS;
        LAS float* scr = (LAS float*)(lds + wave * 16384);
        constexpr int I_IN = 16 * (INW / 32), I_SQ = 16 * 32;
        constexpr int N_ITEMS = I_IN + 5 * I_SQ;
        for (int it = gw; it < N_ITEMS; it += NGW) {
            int r = it;
            if (r < I_IN) { const int nblk = INW / 32, kb = r / nblk, nb = r % nblk; transpose_item(args.in[I_WIN], INW, D, Win_t, 64 * kb, 32 * nb, 32 * nb, scr, lane); continue; } r -= I_IN;
            { const int w = r / I_SQ, q = r % I_SQ, kb = q / 32, nb = q % 32;
                if (w == 1) continue;
                const float* src = w == 0 ? args.in[I_WOUT] : w == 2 ? args.in[I_WK] : w == 3 ? args.in[I_WV] : args.in[I_WO];
                bf16* dst = w == 0 ? Wout_t : w == 2 ? Wk_t : w == 3 ? Wv_t : Wo_t;
                transpose_item(src, D, D, dst, 64 * kb, 32 * nb, 32 * nb, scr, lane); }
        }
        for (int idx = bid * NTHREADS + tid; idx < D * D / 4; idx += G * NTHREADS) { const f32x4 v = ((const f32x4*)args.in[I_WQ])[idx]; const float gk = args.in[I_NXAG][idx >> 8];
            u32x2 w; w.x = pk2(v.x * gk, v.y * gk); w.y = pk2(v.z * gk, v.w * gk); ((u32x2*)Wq_t)[idx] = w; }
        for (int idx = bid * NTHREADS + tid; idx < 1536 * 256; idx += G * NTHREADS) {
            const int e = idx & 7, ln = (idx >> 3) & 63, ks = (idx >> 9) & 7, ct = (idx >> 12) & 3, hk = idx >> 14, hh = hk / 3, kind = hk - 3 * hh;
            const int k = 32 * ks + 8 * (ln >> 4) + e, n = hh * 64 + 16 * ct + (ln & 15); float v = 0.f;
            if (kind == 0) { if (k < 64) v = args.in[I_WUP][k * 512 + n]; }
            else if (kind == 1) { if (k >= 64 && k < 128) v = args.in[I_AUP][(k - 64) * 512 + n]; }
            else { if (k >= 128) v = args.in[I_GUP][(k - 128) * 512 + n]; }
            LoraB[idx] = (bf16)f2bf(v);
        }
        for (int idx = bid * NTHREADS + tid; idx < 8 * 128 * 64; idx += G * NTHREADS) {
            const int nb = idx >> 13, col = (idx >> 6) & 127, k = idx & 63;
            const float v = col < 64 ? args.in[I_LWX][nb * 4096 + k * 64 + col] : args.in[I_LWA][nb * 4096 + k * 64 + (col - 64)];
            LruW[idx] = (bf16)f2bf(v);
        }
        for (int idx = bid * NTHREADS + tid; idx < NE * D; idx += G * NTHREADS) {
            const int e = idx >> 10, k = idx & 1023; const float v = args.in[I_WR][k * NE + e];
            const unsigned hi = f2bf(v); const float lo = v - __uint_as_float(hi << 16);
            WrT[idx] = (bf16)hi; WrT[NE * D + idx] = (bf16)f2bf(lo);
        }
        for (int m = gw; m < M; m += NGW) rms_row_to_bf16(args.in[I_X] + (size_t)m * D, args.in[I_NMIXG], HN + (size_t)m * D, lane);
        for (int m = gw; m < MROWS; m += NGW) rms_row_to_bf16(args.in[I_MEM] + (size_t)m * D, args.in[I_NMEMG], MEMN + (size_t)m * D, lane);
        {
            LAS float* scr = (LAS float*)(lds + wave * 16384);
            constexpr int I_GU = 16 * 64, I_DN = 16 * 32;
            for (int it = CONV_P9 + gw; it < NE * I_GU; it += NGW) {
                int r = it;
                if (r < NE * I_GU) { const int e = r / I_GU, q = r % I_GU, kb = q / 64, nb = q % 64; const int n0 = 32 * nb;
                    const int drow = n0 < 1024 ? (256 * (n0 >> 7) + (n0 & 127)) : (256 * ((n0 - 1024) >> 7) + 128 + ((n0 - 1024) & 127));
                    transpose_item_tiled_fp8(args.in[I_WGU] + (size_t)e * D * 2048, 2048, D, (unsigned char*)Wgu_t + (size_t)e * 2048 * D, 64 * kb, n0, drow, scr, lane); continue; } r -= NE * I_GU;
                { const int e = r / I_DN, q = r % I_DN, kb = q / 32, nb = q % 32;
                  transpose_item_tiled(args.in[I_WDN] + (size_t)e * DFF * D, D, DFF, Wdn_t + (size_t)e * D * DFF, 64 * kb, 32 * nb, 32 * nb, scr, lane); }
            }
        }
    }
    SEAM(0);

    if (IN(1)) { PHASE_IDS;
        { pg8::DenseSched S; S.o.init_tiles(M / 256, INW / 256, G, bid); S.A = (const char*)HN; S.B = (const char*)Win_t; S.tstep = (size_t)256 * D * 2;
          EpiBf16Plain E{U, INW, 1.0f}; pg8::gemm_phase(lds, D, S, E, wv0); }
        { pg8::DenseSched S; S.o.init_tiles(MROWS / 256, D / 256, G, (bid + 64) & (G - 1)); S.A = (const char*)MEMN; S.B = (const char*)Wk_t; S.tstep = (size_t)256 * D * 2;
          EpiBf16Plain E{KM, D, 1.0f}; pg8::gemm_phase(lds, D, S, E, wv0); }
        { pg8::DenseSched S; S.o.init_tiles(MROWS / 256, D / 256, G, (bid + 48) & (G - 1)); S.A = (const char*)MEMN; S.B = (const char*)Wv_t; S.tstep = (size_t)256 * D * 2;
          EpiBf16Plain E{VT, D, 1.0f}; pg8::gemm_phase(lds, D, S, E, wv0); }
    }
    SEAM(1);

    if (IN(2)) { PHASE_IDS;
        const float* conv_w = args.in[I_CONVW]; const float* conv_b = args.in[I_CONVB];
        LAS float* xs = (LAS float*)(lds + wave * 16384);
        LAS bf16* tP = (LAS bf16*)(lds + wave * 16384 + 4096); LAS bf16* tH = tP + 1024;
        const int i = lane & 15, kg = lane >> 4;
        for (int unit = gw; unit < (M / 64) * 8; unit += NGW) {
            const int seg = unit >> 3, nb = unit & 7, m0s = seg * 64, s0s = m0s & (SEQ - 1);
            bf16x8 wf[8][2];
#pragma unroll
            for (int ct = 0; ct < 8; ++ct)
#pragma unroll
                for (int ks = 0; ks < 2; ++ks) wf[ct][ks] = *(const bf16x8*)(LruW + ((size_t)(nb * 128 + 16 * ct + i) * 64 + 32 * ks + 8 * kg));
            float bxv[4], bav[4], spv[4], Arun[4], Brun[4];
#pragma unroll
            for (int ct = 0; ct < 4; ++ct) { const int ch = nb * 64 + 16 * ct + i; bxv[ct] = args.in[I_LBX][ch]; bav[ct] = args.in[I_LBA][ch]; spv[ct] = softplus_f(-args.in[I_LAM][ch]); Arun[ct] = 1.f; Brun[ct] = 0.f; }
#pragma unroll 1
            for (int jt = 0; jt < 4; ++jt) {
                const int m0 = m0s + 16 * jt, s0 = s0s + 16 * jt;
                bf16x8 af[2];
#pragma unroll
                for (int ks = 0; ks < 2; ++ks) {
                    const int chb = nb * 64 + 32 * ks + 8 * kg;
                    f32x4 x0 = *(const f32x4*)(conv_b + chb), x1 = *(const f32x4*)(conv_b + chb + 4);
#pragma unroll
                    for (int j = 0; j < 4; ++j) {
                        const bool ok = s0 + i - 3 + j >= 0;
                        u32x4 uw = *(const u32x4*)(U + (size_t)(ok ? m0 + i - 3 + j : m0) * INW + chb); if (!ok) uw = (u32x4){0u, 0u, 0u, 0u};
                        const f32x4 w0 = *(const f32x4*)(conv_w + j * 512 + chb), w1 = *(const f32x4*)(conv_w + j * 512 + chb + 4);
                        x0.x += w0.x * bflo(uw.x); x0.y += w0.y * bfhi(uw.x); x0.z += w0.z * bflo(uw.y); x0.w += w0.w * bfhi(uw.y);
                        x1.x += w1.x * bflo(uw.z); x1.y += w1.y * bfhi(uw.z); x1.z += w1.z * bflo(uw.w); x1.w += w1.w * bfhi(uw.w);
                    }
                    *(LAS f32x4*)(xs + i * 64 + 32 * ks + 8 * kg) = x0; *(LAS f32x4*)(xs + i * 64 + 32 * ks + 8 * kg + 4) = x1;
                    u32x4 p; p.x = pk2(x0.x, x0.y); p.y = pk2(x0.z, x0.w); p.z = pk2(x1.x, x1.y); p.w = pk2(x1.z, x1.w);
                    af[ks] = __builtin_bit_cast(bf16x8, p);
                }
                f32x4 acc[8];
#pragma unroll
                for (int ct = 0; ct < 8; ++ct) { acc[ct] = (f32x4){0.f, 0.f, 0.f, 0.f};
#pragma unroll
                    for (int ks = 0; ks < 2; ++ks) acc[ct] = __builtin_amdgcn_mfma_f32_16x16x32_bf16(af[ks], wf[ct][ks], acc[ct], 0, 0, 0); }
#pragma unroll
                for (int ct = 0; ct < 4; ++ct) {
                    const int col = 16 * ct + i;
                    float hl[4], pl[4]; float hprev = 0.f, pprev = 1.f;
#pragma unroll
                    for (int e = 0; e < 4; ++e) {
                        const float gx = sigmoid_f(acc[ct][e] + bxv[ct]), ga = sigmoid_f(acc[ct + 4][e] + bav[ct]);
                        const float la = -8.0f * ga * spv[ct], av = __expf(la), xcv = xs[(4 * kg + e) * 64 + col];
                        const float bt = __builtin_amdgcn_sqrtf(fmaxf(1.0f - av * av, 0.f)) * gx * xcv;
                        hprev = av * hprev + bt; pprev *= av; hl[e] = hprev; pl[e] = pprev;
                    }
                    float Ag[4], Bg[4];
#pragma unroll
                    for (int gq = 0; gq < 4; ++gq) { Ag[gq] = __shfl(pl[3], i + 16 * gq); Bg[gq] = __shfl(hl[3], i + 16 * gq); }
                    float Ain = Arun[ct], Bin = Brun[ct];
#pragma unroll
                    for (int gq = 0; gq < 3; ++gq) if (gq < kg) { Bin = Ag[gq] * Bin + Bg[gq]; Ain *= Ag[gq]; }
                    float At = 1.f, Bt = 0.f;
#pragma unroll
                    for (int gq = 0; gq < 4; ++gq) { Bt = Ag[gq] * Bt + Bg[gq]; At *= Ag[gq]; }
                    Brun[ct] = At * Brun[ct] + Bt; Arun[ct] *= At;
#pragma unroll
                    for (int e = 0; e < 4; ++e) { const int ti_ = (4 * kg + e) * 64 + col; tP[ti_] = (bf16)f2bf(pl[e] * Ain); tH[ti_] = (bf16)f2bf(hl[e] + pl[e] * Bin); }
                }
                { const int rr = lane >> 2, cq = lane & 3;
                  bf16* pp = LA + (size_t)(m0 + rr) * 512 + nb * 64 + 16 * cq; bf16* hp = LB + (size_t)(m0 + rr) * 512 + nb * 64 + 16 * cq;
                  *(u32x4*)pp = *(const LAS u32x4*)(tP + rr * 64 + 16 * cq); *(u32x4*)(pp + 8) = *(const LAS u32x4*)(tP + rr * 64 + 16 * cq + 8);
                  *(u32x4*)hp = *(const LAS u32x4*)(tH + rr * 64 + 16 * cq); *(u32x4*)(hp + 8) = *(const LAS u32x4*)(tH + rr * 64 + 16 * cq + 8); }
            }
            if (kg == 0) {
#pragma unroll
                for (int ct = 0; ct < 4; ++ct) { f32x2 ab; ab.x = Arun[ct]; ab.y = Brun[ct];
                    *(f32x2*)((float*)(ws + WS_AP) + ((size_t)(((seg >> 6) * 8 + nb) * 64 + (seg & 63)) * 64 + 16 * ct + i) * 2) = ab; }
            }
        }
    }
    SEAM(2);


#define RW_ZB(zz, zb) do { _Pragma("unroll") for (int ks_ = 0; ks_ < 2; ++ks_) { u32x4 p_; p_.x = pk2(zz[2 * ks_][0], zz[2 * ks_][1]); p_.y = pk2(zz[2 * ks_][2], zz[2 * ks_][3]); \
        p_.z = pk2(zz[2 * ks_ + 1][0], zz[2 * ks_ + 1][1]); p_.w = pk2(zz[2 * ks_ + 1][2], zz[2 * ks_ + 1][3]); zb[ks_] = __builtin_bit_cast(bf16x8, p_); } } while (0)
    if (IN(3)) { PHASE_IDS;
        for (int u64 = gw; u64 < NB * NH * (SEQ / 64); u64 += NGW) {
#pragma unroll 1
        for (int jj = 0; jj < 4; ++jj) {
        LAS unsigned char* wl = lds + wave * 16384;
        LAS bf16* Arm = (LAS bf16*)(wl); LAS bf16* Brm = (LAS bf16*)(wl + 2048); LAS bf16* Krm = (LAS bf16*)(wl + 4096); LAS bf16* Rrm = (LAS bf16*)(wl + 6144);
        LAS bf16* ATt = (LAS bf16*)(wl + 8192); LAS bf16* BTt = (LAS bf16*)(wl + 10240); LAS bf16* KTt = (LAS bf16*)(wl + 12288); LAS bf16* VTt = (LAS bf16*)(wl + 14336);
        LAS float* MabT = (LAS float*)(wl); LAS bf16* Mak = (LAS bf16*)(wl + 1024); LAS bf16* Mrb = (LAS bf16*)(wl + 1536); LAS bf16* Mrk = (LAS bf16*)(wl + 2048); LAS bf16* Tm = (LAS bf16*)(wl + 2560);
        LAS float* PLs = (LAS float*)(wl + 3072); LAS bf16* Q0T = (LAS bf16*)(wl + 4096);
        const int lane = fresh_tid() & 63, l15 = lane & 15, g = lane >> 4, te = lane >> 2, kq = lane & 3;
        const bf16x8 z8 = (bf16x8){0, 0, 0, 0, 0, 0, 0, 0};
        const f32x4 z4 = (f32x4){0.f, 0.f, 0.f, 0.f};
            const int un = u64 * 4 + jj;
            const int bh = un >> 8, c = un & 255, b = bh >> 3, h = bh & 7;
            const size_t mrow = (size_t)b * SEQ + c * 16 + te, off = mrow * 512 + h * 64 + 16 * kq;
            const int hc = h * 64 + 16 * kq;
            LAS float* tmpL = (LAS float*)wl;
            {
                const int rsub = lane >> 5, chunk = lane & 31; const size_t mt0 = (size_t)b * SEQ + c * 16;
                const f32x4 m0 = *(const f32x4*)(args.in[I_MU] + 1536 + 8 * chunk), m1 = *(const f32x4*)(args.in[I_MU] + 1536 + 8 * chunk + 4);
                u32x4 cu[8], pu[8];
#pragma unroll
                for (int i = 0; i < 8; ++i) { const size_t mr = mt0 + 2 * i + rsub; const bool hp2 = (mr & (SEQ - 1)) != 0; const bf16* ua = U + mr * INW + 2560 + 8 * chunk;
                    cu[i] = *(const u32x4*)ua; pu[i] = *(const u32x4*)(ua - (hp2 ? INW : 0)); if (!hp2) pu[i] = (u32x4){0u, 0u, 0u, 0u}; }
#pragma unroll
                for (int i = 0; i < 8; ++i) { float o8[8];
#pragma unroll
                    for (int q = 0; q < 4; ++q) { const float c0 = bflo(cu[i][q]), c1 = bfhi(cu[i][q]), p0 = bflo(pu[i][q]), p1 = bfhi(pu[i][q]); const float mm0 = q < 2 ? m0[2 * q] : m1[2 * q - 4], mm1 = q < 2 ? m0[2 * q + 1] : m1[2 * q - 3];
                        float x0 = c0 + (p0 - c0) * mm0, x1 = c1 + (p1 - c1) * mm1;
                        if (chunk < 8) { x0 = tanh_fast(x0); x1 = tanh_fast(x1); }
                        else if (chunk >= 16) { x0 = sigmoid_f(x0); x1 = sigmoid_f(x1); }
                        o8[2 * q] = x0; o8[2 * q + 1] = x1; }
                    u32x4 pw; pw.x = pk2(o8[0], o8[1]); pw.y = pk2(o8[2], o8[3]); pw.z = pk2(o8[4], o8[5]); pw.w = pk2(o8[6], o8[7]);
                    const int row = 2 * i + rsub; *(LAS u32x4*)(wl + row * 512 + ((chunk ^ (row & 7)) << 4)) = pw; }
                bf16x8 af[8];
#pragma unroll
                for (int ks = 0; ks < 8; ++ks) af[ks] = *(const LAS bf16x8*)(wl + l15 * 512 + (((4 * ks + g) ^ (l15 & 7)) << 4));
                asm volatile("s_waitcnt lgkmcnt(0)" ::: "memory");
#pragma unroll
                for (int kind = 0; kind < 3; ++kind)
#pragma unroll
                    for (int ct = 0; ct < 4; ++ct) {
                        const bf16* lb = LoraB + ((size_t)((h * 3 + kind) * 4 + ct) * 8 * 64 + lane) * 8;
                        f32x4 a4 = z4;
#pragma unroll
                        for (int ks = (kind == 0 ? 0 : kind == 1 ? 2 : 4); ks < (kind == 0 ? 2 : kind == 1 ? 4 : 8); ++ks) a4 = __builtin_amdgcn_mfma_f32_16x16x32_bf16(af[ks], *(const bf16x8*)(lb + ks * 512), a4, 0, 0, 0);
#pragma unroll
                        for (int e = 0; e < 4; ++e) tmpL[kind * 1088 + (4 * g + e) * 68 + 16 * ct + l15] = a4[e];
                    }
            }
            asm volatile("s_waitcnt lgkmcnt(0)" ::: "memory");
            float cl[16], eP[16];
            {
                float lwv[16], rl[16], kl[16], vl[16], kn[16], av[16];
                const bool hp = (mrow & (SEQ - 1)) != 0;
                const bf16* ub = U + mrow * INW + 1024 + hc;
#pragma unroll
                for (int hh = 0; hh < 2; ++hh) {
#pragma unroll
                    for (int a3 = 0; a3 < 3; ++a3) {
                        const u32x4 cu = *(const u32x4*)(ub + 512 * a3 + 8 * hh); u32x4 pu = *(const u32x4*)(ub - (hp ? INW : 0) + 512 * a3 + 8 * hh); if (!hp) pu = (u32x4){0u, 0u, 0u, 0u};
                        const f32x4 m0 = *(const f32x4*)(args.in[I_MU] + 512 * a3 + hc + 8 * hh), m1 = *(const f32x4*)(args.in[I_MU] + 512 * a3 + hc + 8 * hh + 4);
                        float o8[8];
#pragma unroll
                        for (int q = 0; q < 4; ++q) { const float c0 = bflo(cu[q]), c1 = bfhi(cu[q]), p0 = bflo(pu[q]), p1 = bfhi(pu[q]); const float mm0 = q < 2 ? m0[2 * q] : m1[2 * q - 4], mm1 = q < 2 ? m0[2 * q + 1] : m1[2 * q - 3];
                            o8[2 * q] = c0 + (p0 - c0) * mm0; o8[2 * q + 1] = c1 + (p1 - c1) * mm1; }
#pragma unroll
                        for (int q = 0; q < 8; ++q) { if (a3 == 0) rl[8 * hh + q] = o8[q]; else if (a3 == 1) kl[8 * hh + q] = o8[q]; else vl[8 * hh + q] = o8[q]; }
                    }
                }
                float gv[16];
#pragma unroll
                for (int j4 = 0; j4 < 4; ++j4) { const f32x4 xl = *(const LAS f32x4*)(tmpL + te * 68 + 16 * kq + 4 * j4), xa = *(const LAS f32x4*)(tmpL + 1088 + te * 68 + 16 * kq + 4 * j4), xg = *(const LAS f32x4*)(tmpL + 2176 + te * 68 + 16 * kq + 4 * j4);
                    const f32x4 w0v = *(const f32x4*)(args.in[I_W0] + hc + 4 * j4), a0v = *(const f32x4*)(args.in[I_A0] + hc + 4 * j4);
#pragma unroll
                    for (int q = 0; q < 4; ++q) { const float wq = -softplus_fast(-(xl[q] + w0v[q])) - 0.5f; lwv[4 * j4 + q] = -__expf(wq); av[4 * j4 + q] = sigmoid_f(xa[q] + a0v[q]); gv[4 * j4 + q] = xg[q]; } }
                asm volatile("s_waitcnt lgkmcnt(0)" ::: "memory");
                float ss = 0.f;
#pragma unroll
                for (int j4 = 0; j4 < 4; ++j4) { const f32x4 kk4 = *(const f32x4*)(args.in[I_KK] + hc + 4 * j4);
#pragma unroll
                    for (int q = 0; q < 4; ++q) { kn[4 * j4 + q] = kl[4 * j4 + q] * kk4[q]; ss += kn[4 * j4 + q] * kn[4 * j4 + q]; } }
                ss += __shfl_xor(ss, 1); ss += __shfl_xor(ss, 2);
                const float kinv = rsq_f(fmaxf(ss, 1e-24f));
#pragma unroll
                for (int j = 0; j < 16; ++j) { float x = lwv[j];
#pragma unroll
                    for (int sft = 4; sft < 64; sft <<= 1) { const float y = __shfl_up(x, sft); if (lane >= sft) x += y; }
                    cl[j] = x; }
                float bon = 0.f;
                u32x4 pa[2], pb[2], pk[2], pr[2];
#pragma unroll
                for (int j4 = 0; j4 < 4; ++j4) {
                    const f32x4 ka = *(const f32x4*)(args.in[I_KA] + hc + 4 * j4), rk = *(const f32x4*)(args.in[I_RK] + hc + 4 * j4);
                    float at4[4], bt4[4], kt4[4], rt4[4];
#pragma unroll
                    for (int q = 0; q < 4; ++q) { const int j = 4 * j4 + q;
                        const float p = __expf(cl[j]), pn = __expf(-cl[j]), pm1 = __expf(cl[j] - lwv[j]); eP[j] = p;
                        const float knj = kn[j] * kinv;
                        const float kp = kl[j] * (1.0f + (av[j] - 1.0f) * ka[q]);
                        at4[q] = -knj * pm1; bt4[q] = knj * av[j] * pn; kt4[q] = kp * pn; rt4[q] = rl[j] * p;
                        bon += rl[j] * kp * rk[q];
                        const int kk = 16 * kq + j;
                        ATt[kk * 16 + te] = (bf16)f2bf(at4[q]); BTt[kk * 16 + te] = (bf16)f2bf(bt4[q]); KTt[kk * 16 + te] = (bf16)f2bf(kt4[q]); VTt[kk * 16 + te] = (bf16)f2bf(vl[j]); }
                    const int hh = j4 >> 1, w2 = (j4 & 1) * 2;
                    pa[hh][w2] = pk2(at4[0], at4[1]); pa[hh][w2 + 1] = pk2(at4[2], at4[3]); pb[hh][w2] = pk2(bt4[0], bt4[1]); pb[hh][w2 + 1] = pk2(bt4[2], bt4[3]);
                    pk[hh][w2] = pk2(kt4[0], kt4[1]); pk[hh][w2 + 1] = pk2(kt4[2], kt4[3]); pr[hh][w2] = pk2(rt4[0], rt4[1]); pr[hh][w2 + 1] = pk2(rt4[2], rt4[3]);
                }
#pragma unroll
                for (int hh = 0; hh < 2; ++hh) { const int po = te * 64 + 8 * ((2 * kq + hh) ^ (te & 7));
                    *(LAS u32x4*)(Arm + po) = pa[hh]; *(LAS u32x4*)(Brm + po) = pb[hh]; *(LAS u32x4*)(Krm + po) = pk[hh]; *(LAS u32x4*)(Rrm + po) = pr[hh]; }
                bon += __shfl_xor(bon, 1); bon += __shfl_xor(bon, 2);
                f32x4 lbv[4], lgv[4];
#pragma unroll
                for (int j4 = 0; j4 < 4; ++j4) { lbv[j4] = *(const f32x4*)(args.in[I_LNB] + hc + 4 * j4); lgv[j4] = *(const f32x4*)(args.in[I_LNG] + hc + 4 * j4); }
#pragma unroll
                for (int j4 = 0; j4 < 4; ++j4) { const f32x4 lb = lbv[j4], lgn = lgv[j4]; const int j0 = 4 * j4;
                    u32x2 ow, gw2; ow.x = pk2((lb.x + vl[j0] * bon) * gv[j0], (lb.y + vl[j0 + 1] * bon) * gv[j0 + 1]); ow.y = pk2((lb.z + vl[j0 + 2] * bon) * gv[j0 + 2], (lb.w + vl[j0 + 3] * bon) * gv[j0 + 3]);
                    gw2.x = pk2(lgn.x * gv[j0], lgn.y * gv[j0 + 1]); gw2.y = pk2(lgn.z * gv[j0 + 2], lgn.w * gv[j0 + 3]);
                    *(u32x2*)((bf16*)(ws + WS_ADD) + off + j0) = ow; *(u32x2*)((bf16*)(ws + WS_G) + off + j0) = gw2; }
            }
            asm volatile("s_waitcnt lgkmcnt(0)" ::: "memory");
            {
                bf16x8 fa[2], fr[2], fb[2], fk[2];
#pragma unroll
                for (int ks = 0; ks < 2; ++ks) { const int po = l15 * 64 + 8 * ((4 * ks + g) ^ (l15 & 7));
                    fa[ks] = *(const LAS bf16x8*)(Arm + po); fr[ks] = *(const LAS bf16x8*)(Rrm + po); fb[ks] = *(const LAS bf16x8*)(Brm + po); fk[ks] = *(const LAS bf16x8*)(Krm + po); }
                f32x4 mab = z4, mak = z4, mrb = z4, mrk = z4;
#pragma unroll
                for (int ks = 0; ks < 2; ++ks) { mab = __builtin_amdgcn_mfma_f32_16x16x32_bf16(fb[ks], fa[ks], mab, 0, 0, 0); mak = __builtin_amdgcn_mfma_f32_16x16x32_bf16(fk[ks], fa[ks], mak, 0, 0, 0);
                    mrb = __builtin_amdgcn_mfma_f32_16x16x32_bf16(fb[ks], fr[ks], mrb, 0, 0, 0); mrk = __builtin_amdgcn_mfma_f32_16x16x32_bf16(fk[ks], fr[ks], mrk, 0, 0, 0); }
#pragma unroll
                for (int e = 0; e < 4; ++e) { const int i = 4 * g + e; if (!(i < l15)) { mab[e] = 0.f; mak[e] = 0.f; } if (!(i <= l15)) { mrb[e] = 0.f; mrk[e] = 0.f; } }
                asm volatile("s_waitcnt lgkmcnt(0)" ::: "memory");
#pragma unroll
                for (int e = 0; e < 4; ++e) MabT[(4 * g + e) * 16 + l15] = mab[e];
                u32x2 w; w.x = pk2(mak[0], mak[1]); w.y = pk2(mak[2], mak[3]); *(LAS u32x2*)(Mak + l15 * 16 + 4 * g) = w;
                w.x = pk2(mrb[0], mrb[1]); w.y = pk2(mrb[2], mrb[3]); *(LAS u32x2*)(Mrb + l15 * 16 + 4 * g) = w;
                w.x = pk2(mrk[0], mrk[1]); w.y = pk2(mrk[2], mrk[3]); *(LAS u32x2*)(Mrk + l15 * 16 + 4 * g) = w;
                if (te == 15) {
#pragma unroll
                    for (int j = 0; j < 16; ++j) PLs[16 * kq + j] = eP[j]; }
            }
            asm volatile("s_waitcnt lgkmcnt(0)" ::: "memory");
            {
                f32x4 mq[15][4];
#pragma unroll
                for (int j = 0; j < 15; ++j)
#pragma unroll
                    for (int q = 0; q < 4; ++q) if (4 * q + 3 > j) mq[j][q] = *(const LAS f32x4*)(MabT + j * 16 + 4 * q);
                float y[16];
#pragma unroll
                for (int j = 15; j >= 0; --j) {
                    float acc = (j == l15) ? 1.0f : 0.0f;
#pragma unroll
                    for (int i = j + 1; i < 16; ++i) acc += y[i] * mq[j < 15 ? j : 0][i >> 2][i & 3];
                    y[j] = acc;
                }
                if (g == 0) { u32x4 t0, t1; t0.x = pk2(y[0], y[1]); t0.y = pk2(y[2], y[3]); t0.z = pk2(y[4], y[5]); t0.w = pk2(y[6], y[7]); t1.x = pk2(y[8], y[9]); t1.y = pk2(y[10], y[11]); t1.z = pk2(y[12], y[13]); t1.w = pk2(y[14], y[15]);
                    *(LAS u32x4*)(Tm + l15 * 16) = t0; *(LAS u32x4*)(Tm + l15 * 16 + 8) = t1; }
            }
            asm volatile("s_waitcnt lgkmcnt(0)" ::: "memory");
            {
                const bool act = g < 2; const int fo = l15 * 16 + 8 * g;
                const bf16x8 fT = act ? *(const LAS bf16x8*)(Tm + fo) : z8, fMak = act ? *(const LAS bf16x8*)(Mak + fo) : z8, fMrb = act ? *(const LAS bf16x8*)(Mrb + fo) : z8, fMrk = act ? *(const LAS bf16x8*)(Mrk + fo) : z8;
                bf16x8 fV[4], fQ1[4], fAh[4], fBT[4], fKT[4];
#pragma unroll
                for (int vt = 0; vt < 4; ++vt) { fV[vt] = act ? *(const LAS bf16x8*)(VTt + vt * 256 + fo) : z8; fBT[vt] = act ? *(const LAS bf16x8*)(BTt + vt * 256 + fo) : z8; fKT[vt] = act ? *(const LAS bf16x8*)(KTt + vt * 256 + fo) : z8; }
#pragma unroll
                for (int vt = 0; vt < 4; ++vt) { const f32x4 q0 = __builtin_amdgcn_mfma_f32_16x16x32_bf16(fMak, fV[vt], z4, 0, 0, 0);
                    u32x2 w; w.x = pk2(q0[0], q0[1]); w.y = pk2(q0[2], q0[3]); *(LAS u32x2*)(Q0T + vt * 256 + l15 * 16 + 4 * g) = w; }
#pragma unroll
                for (int kt = 0; kt < 4; ++kt) { const bf16x8 fA = act ? *(const LAS bf16x8*)(ATt + kt * 256 + fo) : z8; const f32x4 ah = __builtin_amdgcn_mfma_f32_16x16x32_bf16(fT, fA, z4, 0, 0, 0);
                    u32x2 w; w.x = pk2(ah[0], ah[1]); w.y = pk2(ah[2], ah[3]); *(LAS u32x2*)(ATt + kt * 256 + l15 * 16 + 4 * g) = w; }
                asm volatile("s_waitcnt lgkmcnt(0)" ::: "memory");
#pragma unroll
                for (int vt = 0; vt < 4; ++vt) { const bf16x8 fQ0 = act ? *(const LAS bf16x8*)(Q0T + vt * 256 + fo) : z8; const f32x4 q1 = __builtin_amdgcn_mfma_f32_16x16x32_bf16(fT, fQ0, z4, 0, 0, 0);
                    u32x2 w; w.x = pk2(q1[0], q1[1]); w.y = pk2(q1[2], q1[3]); *(LAS u32x2*)(Q0T + vt * 256 + l15 * 16 + 4 * g) = w; }
                asm volatile("s_waitcnt lgkmcnt(0)" ::: "memory");
#pragma unroll
                for (int vt = 0; vt < 4; ++vt) { fQ1[vt] = act ? *(const LAS bf16x8*)(Q0T + vt * 256 + fo) : z8; fAh[vt] = act ? *(const LAS bf16x8*)(ATt + vt * 256 + fo) : z8; }
                bf16* rp = (bf16*)(ws + WS_RP) + (size_t)un * 1024 + l15 * 64;
#pragma unroll
                for (int kt = 0; kt < 4; ++kt) {
                    const u32x2 rr = *(const LAS u32x2*)(Rrm + l15 * 64 + 8 * ((2 * kt + (g >> 1)) ^ (l15 & 7)) + 4 * (g & 1));
                    f32x4 ini; ini[0] = bflo(rr.x); ini[1] = bfhi(rr.x); ini[2] = bflo(rr.y); ini[3] = bfhi(rr.y);
                    const f32x4 rh = __builtin_amdgcn_mfma_f32_16x16x32_bf16(fAh[kt], fMrb, ini, 0, 0, 0);
                    u32x2 w; w.x = pk2(rh[0], rh[1]); w.y = pk2(rh[2], rh[3]); *(u32x2*)(rp + 32 * (kt >> 1) + 8 * g + 4 * (kt & 1)) = w;
                }
#pragma unroll
                for (int vt = 0; vt < 4; ++vt) { f32x4 y1 = __builtin_amdgcn_mfma_f32_16x16x32_bf16(fMrb, fQ1[vt], z4, 0, 0, 0); y1 = __builtin_amdgcn_mfma_f32_16x16x32_bf16(fMrk, fV[vt], y1, 0, 0, 0);
                    *(f32x4*)((float*)(ws + WS_Y1F) + ((size_t)(un * 4 + vt) * 64 + lane) * 4) = y1; }
                LAS bf16* tgs = (LAS bf16*)(wl + 8192);
#pragma unroll
                for (int krt = 0; krt < 4; ++krt) { const float pl = PLs[16 * krt + l15];
#pragma unroll
                    for (int kct = 0; kct < 4; ++kct) { f32x4 ga = __builtin_amdgcn_mfma_f32_16x16x32_bf16(fAh[kct], fBT[krt], z4, 0, 0, 0);
                        if (kct == krt) {
#pragma unroll
                            for (int e = 0; e < 4; ++e) if (4 * g + e == l15) ga[e] += 1.0f; }
                        u32x2 w; w.x = pk2(ga[0] * pl, ga[1] * pl); w.y = pk2(ga[2] * pl, ga[3] * pl);
                        *(LAS u32x2*)(tgs + (16 * krt + l15) * 64 + 32 * (kct >> 1) + 8 * g + 4 * (kct & 1)) = w; } }
                { u32x4* gp16 = (u32x4*)((bf16*)(ws + WS_GP) + (size_t)un * 4096);
#pragma unroll
                  for (int i = 0; i < 8; ++i) gp16[i * 64 + lane] = *(const LAS u32x4*)(tgs + (i * 64 + lane) * 8); }
#pragma unroll
                for (int mt = 0; mt < 4; ++mt) { const f32x4 pl4 = *(const LAS f32x4*)(PLs + 16 * mt + 4 * g);
#pragma unroll
                    for (int vt = 0; vt < 4; ++vt) { f32x4 ha = __builtin_amdgcn_mfma_f32_16x16x32_bf16(fBT[mt], fQ1[vt], z4, 0, 0, 0); ha = __builtin_amdgcn_mfma_f32_16x16x32_bf16(fKT[mt], fV[vt], ha, 0, 0, 0);
                        u32x2 w; w.x = pk2(ha[0] * pl4[0], ha[1] * pl4[1]); w.y = pk2(ha[2] * pl4[2], ha[3] * pl4[3]);
                        *(u32x2*)((bf16*)(ws + WS_HF) + ((size_t)((un * 4 + vt) * 4 + mt) * 64 + lane) * 4) = w; } }
            }
            asm volatile("s_waitcnt lgkmcnt(0)" ::: "memory");
        }
        asm volatile("s_waitcnt vmcnt(0)" ::: "memory");
        { const int ltid = fresh_tid() & 63, l15 = ltid & 15, g = ltid >> 4, lane = ltid;
#define CP_LOADG(gf_, j_) do { const bf16* gp_ = (const bf16*)(ws + WS_GP) + ((size_t)u64 * 4 + (j_)) * 4096 + l15 * 64 + 8 * g; \
            _Pragma("unroll") for (int mt = 0; mt < 4; ++mt) { gf_[mt][0] = *(const bf16x8*)(gp_ + mt * 1024); gf_[mt][1] = *(const bf16x8*)(gp_ + mt * 1024 + 32); } } while (0)
#define CP_LOADH(hf_, j_) do { _Pragma("unroll") for (int sl = 0; sl < 4; ++sl) _Pragma("unroll") for (int mt = 0; mt < 4; ++mt) \
            hf_[sl][mt] = *(const u32x2*)((const bf16*)(ws + WS_HF) + ((size_t)((((size_t)u64 * 4 + (j_)) * 4 + sl) * 4 + mt) * 64 + lane) * 4); } while (0)
#define CP_STEP(gf_, hf_, useh_) do { _Pragma("unroll") for (int sl = 0; sl < 4; ++sl) { bf16x8 zb[2]; RW_ZB(z[sl], zb); \
            _Pragma("unroll") for (int mt = 0; mt < 4; ++mt) { f32x4 a_ = (f32x4){0.f, 0.f, 0.f, 0.f}; \
                if (useh_) { a_[0] = bflo(hf_[sl][mt].x); a_[1] = bfhi(hf_[sl][mt].x); a_[2] = bflo(hf_[sl][mt].y); a_[3] = bfhi(hf_[sl][mt].y); } \
                a_ = __builtin_amdgcn_mfma_f32_16x16x32_bf16(gf_[mt][0], zb[0], a_, 0, 0, 0); a_ = __builtin_amdgcn_mfma_f32_16x16x32_bf16(gf_[mt][1], zb[1], a_, 0, 0, 0); z[sl][mt] = a_; } } } while (0)
        {
            f32x4 z[4][4];
#pragma unroll
            for (int sl = 0; sl < 4; ++sl)
#pragma unroll
                for (int mt = 0; mt < 4; ++mt)
#pragma unroll
                    for (int e = 0; e < 4; ++e) z[sl][mt][e] = (sl == mt && 4 * g + e == l15) ? 1.0f : 0.0f;
            bf16x8 gA[4][2], gB[4][2]; u32x2 hdum[4][4];
            CP_LOADG(gA, 0); CP_LOADG(gB, 1);
            CP_STEP(gA, hdum, false); CP_LOADG(gA, 2);
            CP_STEP(gB, hdum, false); CP_LOADG(gB, 3);
            CP_STEP(gA, hdum, false);
            CP_STEP(gB, hdum, false);
            LAS bf16* tg = (LAS bf16*)(lds + wave * 16384);
#pragma unroll
            for (int sl = 0; sl < 4; ++sl) { const int pc = 32 * (sl >> 1) + 8 * (l15 >> 2) + 4 * (sl & 1) + (l15 & 3);
#pragma unroll
                for (int mt = 0; mt < 4; ++mt)
#pragma unroll
                    for (int e = 0; e < 4; ++e) tg[(16 * mt + 4 * g + e) * 64 + pc] = (bf16)f2bf(z[sl][mt][e]); }
            u32x4* gc = (u32x4*)((bf16*)(ws + WS_GC) + (size_t)u64 * 4096);
#pragma unroll
            for (int i = 0; i < 8; ++i) gc[i * 64 + lane] = *(const LAS u32x4*)(tg + (i * 64 + lane) * 8);
        }
        {
            f32x4 z[4][4];
#pragma unroll
            for (int sl = 0; sl < 4; ++sl)
#pragma unroll
                for (int mt = 0; mt < 4; ++mt) z[sl][mt] = (f32x4){0.f, 0.f, 0.f, 0.f};
            bf16x8 gA[4][2], gB[4][2]; u32x2 hA[4][4], hB[4][4];
            CP_LOADG(gA, 0); CP_LOADH(hA, 0); CP_LOADG(gB, 1); CP_LOADH(hB, 1);
            CP_STEP(gA, hA, true); CP_LOADG(gA, 2); CP_LOADH(hA, 2);
            CP_STEP(gB, hB, true); CP_LOADG(gB, 3); CP_LOADH(hB, 3);
            CP_STEP(gA, hA, true);
            CP_STEP(gB, hB, true);
#pragma unroll
            for (int sl = 0; sl < 4; ++sl)
#pragma unroll
                for (int mt = 0; mt < 4; ++mt) { u32x2 w; w.x = pk2(z[sl][mt][0], z[sl][mt][1]); w.y = pk2(z[sl][mt][2], z[sl][mt][3]);
                    *(u32x2*)((bf16*)(ws + WS_HC) + ((size_t)((u64 * 4 + sl) * 4 + mt) * 64 + lane) * 4) = w; }
        }
#undef CP_LOADG
#undef CP_LOADH
#undef CP_STEP
        }
        }
    }
    SEAM(3);


    if (IN(4)) { PHASE_IDS;
        if (!(bid < 128 && wave == 0)) {
            const int wi = bid < 128 ? bid * 7 + (wave - 1) : 896 + (bid - 128) * 8 + wave, NW = 896 + (G - 128) * 8;
        } else {
            const int l15 = lane & 15, g = lane >> 4, bh = bid >> 2, vs = bid & 3;
            f32x4 z[4];
#pragma unroll
            for (int mt = 0; mt < 4; ++mt) z[mt] = (f32x4){0.f, 0.f, 0.f, 0.f};
            bf16x8 gA[4][2], gB[4][2], gC[4][2], gD[4][2]; u32x2 hA[4], hB[4], hC[4], hD[4];
#define SC_LOAD(gf, hf, C) do { const size_t u64_ = (size_t)bh * 64 + (C); const bf16* gp_ = (const bf16*)(ws + WS_GC) + u64_ * 4096 + l15 * 64 + 8 * g; \
                _Pragma("unroll") for (int mt = 0; mt < 4; ++mt) { gf[mt][0] = *(const bf16x8*)(gp_ + mt * 1024); gf[mt][1] = *(const bf16x8*)(gp_ + mt * 1024 + 32); \
                    hf[mt] = *(const u32x2*)((const bf16*)(ws + WS_HC) + ((size_t)((u64_ * 4 + vs) * 4 + mt) * 64 + lane) * 4); } } while (0)
#define SC_STEP(gf, hf, C) do { const size_t u64_ = (size_t)bh * 64 + (C); bf16* zs_ = (bf16*)(ws + WS_ZS) + ((size_t)((u64_ * 4 + vs) * 4) * 64 + lane) * 4; \
                _Pragma("unroll") for (int mt = 0; mt < 4; ++mt) { u32x2 zw_; zw_.x = pk2(z[mt][0], z[mt][1]); zw_.y = pk2(z[mt][2], z[mt][3]); *(u32x2*)(zs_ + mt * 256) = zw_; } \
                bf16x8 zb[2]; RW_ZB(z, zb); \
                _Pragma("unroll") for (int mt = 0; mt < 4; ++mt) { f32x4 a; a[0] = bflo(hf[mt].x); a[1] = bfhi(hf[mt].x); a[2] = bflo(hf[mt].y); a[3] = bfhi(hf[mt].y); \
                    a = __builtin_amdgcn_mfma_f32_16x16x32_bf16(gf[mt][0], zb[0], a, 0, 0, 0); a = __builtin_amdgcn_mfma_f32_16x16x32_bf16(gf[mt][1], zb[1], a, 0, 0, 0); z[mt] = a; } } while (0)
            SC_LOAD(gA, hA, 0); SC_LOAD(gB, hB, 1); SC_LOAD(gC, hC, 2);
#pragma unroll 1
            for (int C = 0; C < 64; C += 4) {
                SC_LOAD(gD, hD, C + 3);
                SC_STEP(gA, hA, C);
                if (C + 4 < 64) SC_LOAD(gA, hA, C + 4);
                SC_STEP(gB, hB, C + 1);
                if (C + 5 < 64) SC_LOAD(gB, hB, C + 5);
                SC_STEP(gC, hC, C + 2);
                if (C + 6 < 64) SC_LOAD(gC, hC, C + 6);
                SC_STEP(gD, hD, C + 3);
            }
#undef SC_LOAD
#undef SC_STEP
        }
    }
    if (IN(4)) { PHASE_IDS;
        if (bid < 32 && wave == 1) { const int bc = bid; const f32x2* ag = (const f32x2*)((const float*)(ws + WS_AP)) + (size_t)(bc * 64) * 64 + lane;
            float* car = (float*)(ws + WS_AP + 4 * MiB) + (size_t)(bc * 64) * 64 + lane; float hst = 0.f;
#pragma unroll 16
            for (int sg = 0; sg < 64; ++sg) { const f32x2 ab = ag[(size_t)sg * 64]; car[(size_t)sg * 64] = hst; hst = ab.x * hst + ab.y; } }
    }
    if (IN(4)) { PHASE_IDS;
        bf16* WKt = HN; bf16* VWt = HN + (size_t)4 * 1024 * 1024;
        __syncthreads();
        if (bid >= 128 && bid < 192) { pg8::FoldSched<0> S; S.A = (const char*)KM; S.B = (const char*)Wq_t; S.G = 64; S.c = bid - 128; EpiFold<0> E{(unsigned char*)WKt}; pg8::gemm_phase(lds, 256, S, E, wv0, 1024); }
        else if (bid >= 192) { pg8::FoldSched<1> S; S.A = (const char*)Wo_t; S.B = (const char*)VT; S.G = 64; S.c = bid - 192; EpiFold<1> E{(unsigned char*)VWt}; pg8::gemm_phase(lds, 256, S, E, wv0, 1024); }
    }
    SEAM(4);

    if (IN(5)) { PHASE_IDS;
        {
            for (int lu = gw; lu < (M / 64) * 8; lu += NGW) {
                const int seg = lu >> 3, nb = lu & 7, rr = lane >> 3, cq = lane & 7;
                const float* cp = (const float*)(ws + WS_AP + 4 * MiB) + ((size_t)(((seg >> 6) * 8 + nb) * 64 + (seg & 63)) * 64 + 8 * cq);
                const f32x4 c0 = *(const f32x4*)cp, c1 = *(const f32x4*)(cp + 4);
#pragma unroll
                for (int it = 0; it < 8; ++it) { const size_t m = (size_t)seg * 64 + 8 * it + rr; const size_t o = m * 512 + nb * 64 + 8 * cq;
                    const u32x4 pw = __builtin_nontemporal_load((const u32x4*)(LA + o)), hw = __builtin_nontemporal_load((const u32x4*)(LB + o)), gw_ = __builtin_nontemporal_load((const u32x4*)(U + m * INW + 512 + nb * 64 + 8 * cq));
                    float y[8];
#pragma unroll
                    for (int q = 0; q < 4; ++q) { const float ca = q < 2 ? c0[2 * q] : c1[2 * q - 4], cb = q < 2 ? c0[2 * q + 1] : c1[2 * q - 3];
                        y[2 * q] = (bflo(hw[q]) + bflo(pw[q]) * ca) * gelu_tanh_f(bflo(gw_[q])); y[2 * q + 1] = (bfhi(hw[q]) + bfhi(pw[q]) * cb) * gelu_tanh_f(bfhi(gw_[q])); }
                    u32x4 w; w.x = pk2(y[0], y[1]); w.y = pk2(y[2], y[3]); w.z = pk2(y[4], y[5]); w.w = pk2(y[6], y[7]);
                    *(u32x4*)(CAT + m * 1024 + nb * 64 + 8 * cq) = w; }
            }
        }
        const int l15 = lane & 15, g = lane >> 4;
        LAS bf16* tGL = (LAS bf16*)(lds + wave * 16384); LAS bf16* tAD = tGL + 1024; LAS bf16* tOUT = tGL + 2048;
        const int ct = lane >> 3, cc = lane & 7;
        for (int u64 = gw; u64 < NB * NH * (SEQ / 64); u64 += NGW) {
            const int bh = u64 >> 6, C = u64 & 63, b = bh >> 3, h = bh & 7;
            f32x4 z[4][4];
#pragma unroll
            for (int sl = 0; sl < 4; ++sl)
#pragma unroll
                for (int mt = 0; mt < 4; ++mt) { const u32x2 zw = *(const u32x2*)((const bf16*)(ws + WS_ZS) + ((size_t)((u64 * 4 + sl) * 4 + mt) * 64 + lane) * 4); z[sl][mt] = (f32x4){bflo(zw.x), bfhi(zw.x), bflo(zw.y), bfhi(zw.y)}; }
#pragma unroll 1
            for (int j = 0; j < 4; ++j) {
                const size_t un = (size_t)u64 * 4 + j; const size_t m0 = (size_t)b * SEQ + (C * 4 + j) * 16;
                const bf16* rp = (const bf16*)(ws + WS_RP) + un * 1024 + l15 * 64 + 8 * g;
                const bf16x8 rf0 = __builtin_nontemporal_load((const bf16x8*)rp), rf1 = __builtin_nontemporal_load((const bf16x8*)(rp + 32));
                f32x4 y[4];
#pragma unroll
                for (int sl = 0; sl < 4; ++sl) y[sl] = __builtin_nontemporal_load((const f32x4*)((const float*)(ws + WS_Y1F) + ((size_t)(un * 4 + sl) * 64 + lane) * 4));
                const size_t rg = (m0 + ct) * 512 + h * 64 + 8 * cc;
                const u32x4 gl0 = __builtin_nontemporal_load((const u32x4*)((const bf16*)(ws + WS_G) + rg)), gl1 = __builtin_nontemporal_load((const u32x4*)((const bf16*)(ws + WS_G) + rg + 8 * 512));
                const u32x4 ad0 = __builtin_nontemporal_load((const u32x4*)((const bf16*)(ws + WS_ADD) + rg)), ad1 = __builtin_nontemporal_load((const u32x4*)((const bf16*)(ws + WS_ADD) + rg + 8 * 512));
                bf16x8 gf[4][2]; u32x2 hfr[4][4];
                if (j < 3) {
                    const bf16* gp = (const bf16*)(ws + WS_GP) + un * 4096 + l15 * 64 + 8 * g;
#pragma unroll
                    for (int mt = 0; mt < 4; ++mt) { gf[mt][0] = __builtin_nontemporal_load((const bf16x8*)(gp + mt * 1024)); gf[mt][1] = __builtin_nontemporal_load((const bf16x8*)(gp + mt * 1024 + 32)); }
#pragma unroll
                    for (int sl = 0; sl < 4; ++sl)
#pragma unroll
                        for (int mt = 0; mt < 4; ++mt) hfr[sl][mt] = __builtin_nontemporal_load((const u32x2*)((const bf16*)(ws + WS_HF) + ((size_t)((un * 4 + sl) * 4 + mt) * 64 + lane) * 4));
                }
                *(LAS u32x4*)(tGL + ct * 64 + 8 * cc) = gl0; *(LAS u32x4*)(tGL + (ct + 8) * 64 + 8 * cc) = gl1;
                *(LAS u32x4*)(tAD + ct * 64 + 8 * cc) = ad0; *(LAS u32x4*)(tAD + (ct + 8) * 64 + 8 * cc) = ad1;
                bf16x8 zb[4][2];
#pragma unroll
                for (int sl = 0; sl < 4; ++sl) { RW_ZB(z[sl], zb[sl]);
                    y[sl] = __builtin_amdgcn_mfma_f32_16x16x32_bf16(rf0, zb[sl][0], y[sl], 0, 0, 0); y[sl] = __builtin_amdgcn_mfma_f32_16x16x32_bf16(rf1, zb[sl][1], y[sl], 0, 0, 0); }
#pragma unroll
                for (int e = 0; e < 4; ++e) {
                    float s1 = (y[0][e] + y[1][e]) + (y[2][e] + y[3][e]);
                    s1 += __shfl_xor(s1, 1); s1 += __shfl_xor(s1, 2); s1 += __shfl_xor(s1, 4); s1 += __shfl_xor(s1, 8);
                    const float mean = s1 * (1.0f / 64.0f);
                    float d0 = y[0][e] - mean, d1 = y[1][e] - mean, d2 = y[2][e] - mean, d3 = y[3][e] - mean;
                    float s2 = (d0 * d0 + d1 * d1) + (d2 * d2 + d3 * d3);
                    s2 += __shfl_xor(s2, 1); s2 += __shfl_xor(s2, 2); s2 += __shfl_xor(s2, 4); s2 += __shfl_xor(s2, 8);
                    const float rstd = rsq_f(s2 * (1.0f / 64.0f) + GN_EPS);
                    const float dd[4] = {d0, d1, d2, d3};
#pragma unroll
                    for (int sl = 0; sl < 4; ++sl) { const int ti_ = (4 * g + e) * 64 + 16 * sl + l15;
                        const float o = dd[sl] * rstd * bf2f(tGL[ti_]) + bf2f(tAD[ti_]); tOUT[ti_] = (bf16)f2bf(o); }
                }
                { bf16* cp = CAT + (m0 + ct) * 1024 + 512 + h * 64 + 8 * cc;
                  *(u32x4*)cp = *(const LAS u32x4*)(tOUT + ct * 64 + 8 * cc); *(u32x4*)(cp + 8 * 1024) = *(const LAS u32x4*)(tOUT + (ct + 8) * 64 + 8 * cc); }
                if (j < 3) {
#pragma unroll
                    for (int sl = 0; sl < 4; ++sl)
#pragma unroll
                        for (int mt = 0; mt < 4; ++mt) { const u32x2 hh = hfr[sl][mt];
                            f32x4 a; a[0] = bflo(hh.x); a[1] = bfhi(hh.x); a[2] = bflo(hh.y); a[3] = bfhi(hh.y);
                            a = __builtin_amdgcn_mfma_f32_16x16x32_bf16(gf[mt][0], zb[sl][0], a, 0, 0, 0); a = __builtin_amdgcn_mfma_f32_16x16x32_bf16(gf[mt][1], zb[sl][1], a, 0, 0, 0); z[sl][mt] = a; }
                }
            }
        }
    }
    SEAM(5);
#undef RW_ZB


    if (IN(6)) { PHASE_IDS;
        pg8::DenseSched S; S.o.init_tiles(M / 256, D / 256, G, bid); S.A = (const char*)CAT; S.B = (const char*)Wout_t; S.tstep = (size_t)256 * D * 2;
        EpiBf16Res<false> E{args.in[I_X], X1, D, (float*)(ws + WS_AP + 2 * MiB), 1.0f, X1F8}; pg8::gemm_phase(lds, D, S, E, wv0);
    }
    SEAM(6);
    if (IN(7)) { PHASE_IDS;
        pg8::BatchBSched S; S.o.init_tiles(M / 256, D / 256, G, bid); S.A = (const char*)X1F8; S.B = (const char*)HN; S.tstep = (size_t)256 * 1024; S.bstep = (size_t)1024 * 1024;
        EpiSoftmax E{(unsigned char*)Qb, 0.0625f * 0.25f, (const float*)(ws + WS_AP + 2 * MiB), (LAS float*)(lds + RING_BYTES + 1024), (LAS float*)(lds + RING_BYTES + 1024 + 4096)};
        pg8::gemm_phase<EpiSoftmax, pg8::BatchBSched, true, true>(lds, 512, S, E, wv0);
    }
    SEAM(7);
    if (IN(8)) { PHASE_IDS;
        pg8::BatchBSched S; S.o.init_tiles(M / 256, D / 256, G, bid); S.A = (const char*)Qb; S.B = (const char*)(HN + (size_t)4 * 1024 * 1024); S.tstep = (size_t)256 * 1024; S.bstep = (size_t)1024 * 1024;
        EpiBf16Res<true> E{X1, X2, D, nullptr, 1.0f / 1024.0f, nullptr}; pg8::gemm_phase<EpiBf16Res<true>, pg8::BatchBSched, true, true>(lds, 512, S, E, wv0);
    }
    SEAM(8);
    if (IN(9)) { PHASE_IDS;
        for (int cid = tid; cid < 2 * NE * 128; cid += NTHREADS) { const int t = cid >> 12, row = (cid >> 7) & 31, c = cid & 127;
            *(LAS u32x4*)(lds + t * 65536 + row * 2048 + ((c ^ (row & 7)) << 4)) = *(const u32x4*)(WrT + (size_t)t * NE * D + row * D + 8 * c); }
        __syncthreads();
        const int l15 = lane & 15, g = lane >> 4;
        LAS float* LG = (LAS float*)(lds + RING_BYTES + 1024 + wave * 2304);
        const float* gfn = args.in[I_NFFG];
        LAS unsigned* cntl = (LAS unsigned*)(lds + RING_BYTES + 640);
        for (int t0 = 0; t0 < M / 16; t0 += G * 4) {
        if (tid < 64) cntl[tid] = 0u;
        __syncthreads();
        if (t0 == 0 && wave >= 4) {
            constexpr int I_DN = 16 * 32, I_GU = 16 * 64;
            for (int r = bid * 4 + (wave - 4); r < CONV_P9; r += G * 4) { const int e = r / I_GU, q = r % I_GU, kb = q / 64, nb = q % 64; const int n0 = 32 * nb;
                const int drow = n0 < 1024 ? (256 * (n0 >> 7) + (n0 & 127)) : (256 * ((n0 - 1024) >> 7) + 128 + ((n0 - 1024) & 127));
                transpose_item_tiled_fp8_nolds(args.in[I_WGU] + (size_t)e * D * 2048, 2048, D, (unsigned char*)Wgu_t + (size_t)e * 2048 * D, 64 * kb, n0, drow, lane); }
            for (int r = bid * 4 + (wave - 4); r < CONV_P9D; r += G * 4) { const int e = r / I_DN, q = r % I_DN, kb = q / 32, nb = q % 32;
                transpose_item_tiled_fp8_nolds(args.in[I_WDN] + (size_t)e * DFF * D, D, DFF, (unsigned char*)Wdn_t + (size_t)e * D * DFF, 64 * kb, 32 * nb, 32 * nb, lane); }
        }
        const int tile = t0 + bid * 4 + wave; const bool active = wave < 4 && tile < M / 16;
        int me = 0, lpos = 0, ai = 0; float mg = 0.f;
        if (active) {
            const int m0 = tile * 16;
            const bf16* xrow = X2 + (size_t)(m0 + l15) * D + 8 * g;
            float ss = 0.f;
#pragma unroll 8
            for (int ks = 0; ks < 32; ++ks) { const u32x4 xw = *(const u32x4*)(xrow + 32 * ks);
#pragma unroll
                for (int q = 0; q < 4; ++q) { const float a = bflo(xw[q]), c = bfhi(xw[q]); ss += a * a + c * c; } }
            ss += __shfl_xor(ss, 16); ss += __shfl_xor(ss, 32);
            const float rstd = rsq_f(ss * (1.f / D) + EPS);
            f32x4 acc0 = (f32x4){0.f, 0.f, 0.f, 0.f}, acc1 = acc0;
            unsigned char* hrow = (unsigned char*)HN + (size_t)(m0 + l15) * D + 8 * g;
#pragma unroll 2
            for (int ks = 0; ks < 32; ++ks) {
                const f32x4 g0 = *(const f32x4*)(gfn + 32 * ks + 8 * g), g1 = *(const f32x4*)(gfn + 32 * ks + 8 * g + 4);
                const u32x4 xw = *(const u32x4*)(xrow + 32 * ks);
                float hf[8];
#pragma unroll
                for (int q = 0; q < 4; ++q) { hf[2 * q] = bflo(xw[q]) * rstd * (q < 2 ? g0[2 * q] : g1[2 * q - 4]); hf[2 * q + 1] = bfhi(xw[q]) * rstd * (q < 2 ? g0[2 * q + 1] : g1[2 * q - 3]); }
                u32x4 hi, lo;
#pragma unroll
                for (int q = 0; q < 4; ++q) { hi[q] = pk2(hf[2 * q], hf[2 * q + 1]); lo[q] = pk2(hf[2 * q] - bflo(hi[q]), hf[2 * q + 1] - bfhi(hi[q])); }
                { u32x2 h8; h8.x = pk4_fp8(hf[0], hf[1], hf[2], hf[3]); h8.y = pk4_fp8(hf[4], hf[5], hf[6], hf[7]); *(u32x2*)(hrow + 32 * ks) = h8; }
                const bf16x8 ah = __builtin_bit_cast(bf16x8, hi), al = __builtin_bit_cast(bf16x8, lo);
                const int c = 4 * ks + g;
#pragma unroll
                for (int nt = 0; nt < 2; ++nt) { const int row = 16 * nt + l15; const int off = row * 2048 + ((c ^ (row & 7)) << 4);
                    const bf16x8 bh = *(const LAS bf16x8*)(lds + off), bl = *(const LAS bf16x8*)(lds + 65536 + off);
                    f32x4 a = nt ? acc1 : acc0;
                    a = __builtin_amdgcn_mfma_f32_16x16x32_bf16(ah, bh, a, 0, 0, 0); a = __builtin_amdgcn_mfma_f32_16x16x32_bf16(ah, bl, a, 0, 0, 0); a = __builtin_amdgcn_mfma_f32_16x16x32_bf16(al, bh, a, 0, 0, 0);
                    if (nt) acc1 = a; else acc0 = a; }
            }
            { const float b0 = args.in[I_BR][l15], b1 = args.in[I_BR][16 + l15];
#pragma unroll
              for (int j = 0; j < 4; ++j) { LG[(4 * g + j) * 33 + l15] = acc0[j] + b0; LG[(4 * g + j) * 33 + 16 + l15] = acc1[j] + b1; } }
            const int rrow = lane >> 2, qq = lane & 3;
            float tv[4] = {-3.0e38f, -3.0e38f, -3.0e38f, -3.0e38f}; int ti[4] = {64, 65, 66, 67};
#define TOP_INS(xv_, xi_) do { float x_ = (xv_); int i_ = (xi_); _Pragma("unroll") for (int p_ = 0; p_ < 4; ++p_) { const bool b_ = x_ > tv[p_] || (x_ == tv[p_] && i_ < ti[p_]); \
                const float ov_ = tv[p_]; const int oi_ = ti[p_]; tv[p_] = b_ ? x_ : ov_; ti[p_] = b_ ? i_ : oi_; x_ = b_ ? ov_ : x_; i_ = b_ ? oi_ : i_; } } while (0)
#pragma unroll
            for (int j = 0; j < 8; ++j) TOP_INS(LG[rrow * 33 + 8 * qq + j], 8 * qq + j);
#pragma unroll
            for (int st = 1; st < 4; st <<= 1) { float pv[4]; int pi[4];
#pragma unroll
                for (int p = 0; p < 4; ++p) { pv[p] = __shfl_xor(tv[p], st); pi[p] = __shfl_xor(ti[p], st); }
#pragma unroll
                for (int p = 0; p < 4; ++p) TOP_INS(pv[p], pi[p]); }
#undef TOP_INS
            const float e1 = __expf(tv[1] - tv[0]), e2 = __expf(tv[2] - tv[0]), e3 = __expf(tv[3] - tv[0]);
            const float inv = rcp_f(1.0f + e1 + e2 + e3);
            me = qq == 0 ? ti[0] : qq == 1 ? ti[1] : qq == 2 ? ti[2] : ti[3];
            mg = (qq == 0 ? 1.0f : qq == 1 ? e1 : qq == 2 ? e2 : e3) * inv;
            lpos = (int)__hip_atomic_fetch_add(cntl + me, 1u, __ATOMIC_RELAXED, __HIP_MEMORY_SCOPE_WORKGROUP);
            ai = (m0 + rrow) * 4 + qq;
        }
        __syncthreads();
        if (tid < NE) { const unsigned c = cntl[tid]; cntl[32 + tid] = c ? atomicAdd(ecnt + 64 * tid, c) : 0u; }
        __syncthreads();
        if (active) { route_e[ai] = me; route_pos[ai] = (int)cntl[32 + me] + lpos; route_g[ai] = mg; }
        __syncthreads();
        }
    }
    SEAM(9);
    if (IN(10)) { PHASE_IDS;
        LAS int* pst = (LAS int*)lds;
        if (wave == 0) {
            const int c = lane < NE ? (int)__hip_atomic_load(ecnt + 64 * lane, __ATOMIC_RELAXED, __HIP_MEMORY_SCOPE_AGENT) : 0; const int pc = (c + 255) & ~255;
            int x = pc;
#pragma unroll
            for (int d = 1; d < 32; d <<= 1) { const int y = __shfl_up(x, d); if (lane >= d) x += y; }
            if (lane < NE) { pst[lane] = x - pc; pst[64 + lane] = c; } if (lane == NE - 1) pst[32] = x; }
        __syncthreads();
        for (int ai = bid * NTHREADS + tid; ai < NASSIGN; ai += G * NTHREADS) {
            const int e = route_e[ai]; const int row = pst[e] + route_pos[ai]; { u32x2 sg_; sg_.x = (unsigned)ai; sg_.y = __float_as_uint(route_g[ai]); row_sg[row] = sg_; } row_tok[row] = ai >> 2; }
        if (bid < NE) { const int e = bid, c = pst[64 + e], pe = (c + 255) & ~255; for (int p = c + tid; p < pe; p += NTHREADS) { u32x2 sg_; sg_.x = 0xffffffffu; sg_.y = 0u; row_sg[pst[e] + p] = sg_; row_tok[pst[e] + p] = 0; } }
        if (bid == 0 && tid == 0) tile_tab[0] = pst[32] >> 8;
        if (bid >= 128 && bid < 136) { const int nt = pst[32] >> 8, nN = bid < 132 ? 8 : 4; int* tab = (int*)(ws + WS_ROUTE + (bid < 132 ? RT_UGU : RT_UDN));
            for (int L = (bid & 3) * NTHREADS + tid; L < nt * nN; L += 4 * NTHREADS) { Unit uu; { const int nwg = nt * nN; int wgid = L; { const int q = nwg / 8, r = nwg % 8, xcd = wgid % 8, off = wgid / 8; wgid = (xcd < r ? xcd * (q + 1) : r * (q + 1) + (xcd - r) * q) + off; }
                    const int nig = 8 * nN, gid = wgid / nig, fm = gid * 8, gsz = (nt - fm) < 8 ? (nt - fm) : 8; uu.pm = fm + ((wgid % nig) % gsz); uu.pn = (wgid % nig) / gsz; uu.e = 0; }
                int e = 0;
#pragma unroll
                for (int st = 16; st >= 1; st >>= 1) { if ((pst[e + st] >> 8) <= uu.pm) e += st; }
                tab[L] = uu.pm | (uu.pn << 12) | (e << 16); } }
        __syncthreads();
    }
    SEAM(10);
    if (IN(11)) {
        const int ntiles = tile_tab[0];
        pg8::MoeGatherSched S; S.o.init_tiles(ntiles, 2048 / 256, G, bid); S.A = (const char*)HN; S.B = (const char*)Wgu_t; S.tile_e = tile_tab + 16; S.utab = (const int*)(ws + WS_ROUTE + RT_UGU); S.rtok = row_tok; S.tstep = (size_t)256 * 1024; S.estep = (size_t)2048 * 1024;
        EpiSwiglu E{ACT, args.in[I_BGU]}; pg8::gemm_phase<EpiSwiglu, pg8::MoeGatherSched, true, true>(lds, 512, S, E, wv0);
        { PHASE_IDS; LAS float* scr = (LAS float*)(lds + wave * 16384); constexpr int I_DN = 16 * 32;
          for (;;) { int c0 = 0; if (lane == 0) c0 = (int)atomicAdd(ctl + CW_CONV, 8u); c0 = __builtin_amdgcn_readfirstlane(c0);
              c0 += CONV_P9D; if (c0 >= NE * I_DN) break;
              for (int r = c0; r < c0 + 8; ++r) { const int e = r / I_DN, q = r % I_DN, kb = q / 32, nb = q % 32;
                  transpose_item_tiled_fp8(args.in[I_WDN] + (size_t)e * DFF * D, D, DFF, (unsigned char*)Wdn_t + (size_t)e * D * DFF, 64 * kb, 32 * nb, 32 * nb, scr, lane); } } }
    }
    SEAM(11);
    if (IN(12)) {
        const int ntiles = tile_tab[0];
        pg8::MoeSched S; S.o.init_tiles(ntiles, D / 256, G, bid); S.A = (const char*)ACT; S.B = (const char*)Wdn_t; S.tile_e = tile_tab + 16; S.utab = (const int*)(ws + WS_ROUTE + RT_UDN); S.tstep = (size_t)256 * 1024; S.estep = (size_t)1024 * 1024;
        EpiDown E{YS, args.in[I_BDN], row_sg}; pg8::gemm_phase<EpiDown, pg8::MoeSched, true, true>(lds, 512, S, E, wv0);
    }
    SEAM(12);
    if (IN(13)) { PHASE_IDS;
        const float* gfin = args.in[I_FNG];
        for (int m = gw; m < M; m += NGW) {
            float v[16]; float s = 0.f;
#pragma unroll
            for (int hf = 0; hf < 2; ++hf) { const u32x4 w = __builtin_nontemporal_load((const u32x4*)(X2 + (size_t)m * D + 512 * hf + 8 * lane));
#pragma unroll
                for (int q = 0; q < 4; ++q) { v[8 * hf + 2 * q] = bflo(w[q]); v[8 * hf + 2 * q + 1] = bfhi(w[q]); }
#pragma unroll
                for (int k = 0; k < 4; ++k) { const u32x2 y = __builtin_nontemporal_load((const u32x2*)((const unsigned char*)YS + (size_t)(m * 4 + k) * D + 512 * hf + 8 * lane));
#pragma unroll
                    for (int q = 0; q < 2; ++q) { const auto lo2 = __builtin_amdgcn_cvt_pk_f32_fp8((int)y[q], false), hi2 = __builtin_amdgcn_cvt_pk_f32_fp8((int)y[q], true);
                        v[8 * hf + 4 * q] += lo2[0] * 0.0625f; v[8 * hf + 4 * q + 1] += lo2[1] * 0.0625f; v[8 * hf + 4 * q + 2] += hi2[0] * 0.0625f; v[8 * hf + 4 * q + 3] += hi2[1] * 0.0625f; } } }
#pragma unroll
            for (int j = 0; j < 16; ++j) s += v[j] * v[j];
            const float rstd = rsq_f(wave_sum(s) * (1.f / D) + EPS);
#pragma unroll
            for (int hf = 0; hf < 2; ++hf) { const f32x4 g0 = *(const f32x4*)(gfin + 512 * hf + 8 * lane), g1 = *(const f32x4*)(gfin + 512 * hf + 8 * lane + 4);
                float* o = args.out + (size_t)m * D + 512 * hf + 8 * lane;
                __builtin_nontemporal_store((f32x4){v[8 * hf] * rstd * g0.x, v[8 * hf + 1] * rstd * g0.y, v[8 * hf + 2] * rstd * g0.z, v[8 * hf + 3] * rstd * g0.w}, (f32x4*)o);
                __builtin_nontemporal_store((f32x4){v[8 * hf + 4] * rstd * g1.x, v[8 * hf + 5] * rstd * g1.y, v[8 * hf + 6] * rstd * g1.z, v[8 * hf + 7] * rstd * g1.w}, (f32x4*)(o + 4)); }
        }
    }
#undef IN
#undef SEAM
}

constexpr int N_PHASES = 14;
extern "C" void kernel_launch(void* const* d_in, const int* in_sizes, int n_in, void* d_out, int out_size, void* d_ws, size_t ws_size, hipStream_t stream) {
    static int grid = 0;
    if (grid == 0) {
        if (n_in != 37 || out_size != M * D || ws_size < WS_END) { fprintf(stderr, "kernel_launch: unexpected shapes (n_in %d, out %d, ws %zu); nothing launched\n", n_in, out_size, ws_size); grid = -1; return; }
        int dev = 0, cus = 0, per_cu = 0;
        if (hipGetDevice(&dev) != hipSuccess || hipDeviceGetAttribute(&cus, hipDeviceAttributeMultiprocessorCount, dev) != hipSuccess) { grid = -1; return; }
        if (hipFuncSetAttribute((const void*)fwd, hipFuncAttributeMaxDynamicSharedMemorySize, LDS_BYTES) != hipSuccess) { fprintf(stderr, "kernel_launch: hipFuncSetAttribute failed\n"); grid = -1; return; }
        if (hipOccupancyMaxActiveBlocksPerMultiprocessor(&per_cu, (const void*)fwd, NTHREADS, LDS_BYTES) != hipSuccess || per_cu < 1) fprintf(stderr, "kernel_launch: occupancy query says %d\n", per_cu);
        (void)hipGetLastError();
        grid = cus > 256 ? 256 : cus;
    }
    if (grid < 0) return;
    if (hipMemsetAsync((char*)d_ws + WS_CTL, 0, CTL_ZERO_BYTES, stream) != hipSuccess) return;
    Args a{};
    for (int i = 0; i < 37; ++i) a.in[i] = (const float*)d_in[i];
    a.out = (float*)d_out; a.ws = (unsigned char*)d_ws;
#if MK_ONE_LAUNCH
    a.ph_lo = 0; a.ph_hi = N_PHASES;
    hipLaunchKernelGGL(fwd, dim3(grid), dim3(NTHREADS), LDS_BYTES, stream, a);
#else
    for (int p = 0; p < N_PHASES; ++p) { a.ph_lo = p; a.ph_hi = p + 1; hipLaunchKernelGGL(fwd, dim3(grid), dim3(NTHREADS), LDS_BYTES, stream, a);
#ifdef PROBE_REPEAT_PHASE
        if (p == PROBE_REPEAT_PHASE) hipLaunchKernelGGL(fwd, dim3(grid), dim3(NTHREADS), LDS_BYTES, stream, a);
#endif
    }
#endif
}
```

```cpp
#include <hip/hip_runtime.h>
#include <cstdio>
#include <cstdint>

#ifndef MK_ONE_LAUNCH
#define MK_ONE_LAUNCH 1
#endif

#define DI __device__ __forceinline__
#define GAS __attribute__((address_space(1)))
#define LAS __attribute__((address_space(3)))
typedef unsigned short bf16;
typedef short bf16x8 __attribute__((ext_vector_type(8)));
typedef int v4i __attribute__((ext_vector_type(4)));
typedef int v8i __attribute__((ext_vector_type(8)));
typedef float f32x4 __attribute__((ext_vector_type(4)));
typedef float f32x2 __attribute__((ext_vector_type(2)));
typedef unsigned u32x4 __attribute__((ext_vector_type(4)));
typedef unsigned u32x2 __attribute__((ext_vector_type(2)));

constexpr int D = 1024, NB = 4, SEQ = 4096, M = NB * SEQ;
constexpr int MEML = 256, MROWS = NB * MEML;
constexpr int LRU_W = 512, RW = 512, NH = 8, HD = 64;
constexpr int INW = 2816;
constexpr int XH = 4, XHD = 256;
constexpr int NE = 32, TOPK = 4, DFF = 1024;
constexpr int NASSIGN = M * TOPK;
constexpr int MAXTILES = 288, MAXROWS = MAXTILES * 256;
constexpr float EPS = 1e-6f, GN_EPS = 64e-5f;

DI int fresh_tid_(int wv) { int w = wv; asm volatile("" : "+s"(w)); int l; asm volatile("v_mbcnt_lo_u32_b32 %0, -1, 0\n\tv_mbcnt_hi_u32_b32 %0, -1, %0" : "=v"(l)); return (w << 6) | (l & 63); }
#define fresh_tid() fresh_tid_(wv0)
namespace pg8 {
constexpr int BM = 256, BK = 64, HALF = 128, HTB = HALF * BK * 2, STAGE_BYTES = 8 * HTB, NXCD = 8, WGM = 8;
__host__ __device__ __forceinline__ int lds_byte(int r, int c) { const int st = (r >> 4) * 2 + (c >> 5), rr = r & 15, cc = c & 31, ob = rr * 64 + cc * 2; return st * 1024 + (ob ^ (((ob >> 9) & 1) << 5)); }
__host__ __device__ __forceinline__ void stage_rc(int b, int& R, int& C) { const int st = b / 1024, sb = b % 1024, swz = sb ^ (((sb >> 9) & 1) << 5); R = (st >> 1) * 16 + swz / 64; C = (st & 1) * 32 + (swz % 64) / 2; }
__host__ __device__ __forceinline__ int perm32(int rho) { const int n = rho >> 4, i = rho & 15; return 8 * (i >> 2) + 4 * n + (i & 3); }

struct Unit { int pm, pn, e; };

struct StaticOrder {
    int nM, nN, nwg, G, c;
    __host__ __device__ void init_tiles(int nM_, int nN_, int G_, int c_) { nM = nM_; nN = nN_; nwg = nM * nN; G = G_; c = c_; }
    __host__ __device__ bool next(int i, Unit& u) const {
        const long L = (long)i * G + c; if (L >= nwg) return false;
        int wgid = (int)L; { const int q = nwg / NXCD, r = nwg % NXCD, xcd = wgid % NXCD, off = wgid / NXCD; wgid = (xcd < r ? xcd * (q + 1) : r * (q + 1) + (xcd - r) * q) + off; }
        const int nig = WGM * nN, gid = wgid / nig, fm = gid * WGM, gsz = (nM - fm) < WGM ? (nM - fm) : WGM;
        u.pm = fm + ((wgid % nig) % gsz); u.pn = (wgid % nig) / gsz; u.e = 0; return true;
    }
};
struct DenseSched {
    static constexpr bool GATHER = false, B_TILED = false;
    StaticOrder o; const char* A; const char* B; size_t tstep;
    DI bool next(int i, Unit& u) const { return o.next(i, u); }
    DI const char* a_ptr(const Unit& u) const { return A + (size_t)u.pm * tstep; }
    DI const char* b_ptr(const Unit& u) const { return B + (size_t)u.pn * tstep; }
    DI void a_voff(const Unit&, int K, const int (&R)[2], const int (&C)[2], unsigned (&vo)[2][2]) const {
#pragma unroll
        for (int h = 0; h < 2; ++h)
#pragma unroll
            for (int i = 0; i < 2; ++i) vo[h][i] = (unsigned)((h * HALF + R[i]) * K + C[i]) * 2u; }
};
struct MoeSched {
    static constexpr bool GATHER = false, B_TILED = true;
    StaticOrder o; const char* A; const char* B; const int* tile_e; const int* utab; size_t tstep, estep;
    DI bool next(int i, Unit& u) const { const int L = i * o.G + o.c; if (L >= o.nwg) return false; int en; asm volatile("s_load_dword %0, %1, 0x0\n\ts_waitcnt lgkmcnt(0)" : "=s"(en) : "s"(utab + L) : "memory");     u.pm = en & 0xfff; u.pn = (en >> 12) & 15; u.e = en >> 16; return true; }
    DI const char* a_ptr(const Unit& u) const { return A + (size_t)u.pm * tstep; }
    DI const char* b_ptr(const Unit& u) const { return B + (size_t)u.e * estep + (size_t)u.pn * tstep; }
    DI void a_voff(const Unit&, int K, const int (&R)[2], const int (&C)[2], unsigned (&vo)[2][2]) const {
#pragma unroll
        for (int h = 0; h < 2; ++h)
#pragma unroll
            for (int i = 0; i < 2; ++i) vo[h][i] = (unsigned)((h * HALF + R[i]) * K + C[i]) * 2u; }
};
struct MoeGatherSched {
    static constexpr bool GATHER = true, B_TILED = true;
    StaticOrder o; const char* A; const char* B; const int* tile_e; const int* utab; const int* rtok; size_t tstep, estep;
    DI bool next(int i, Unit& u) const { const int L = i * o.G + o.c; if (L >= o.nwg) return false; int en; asm volatile("s_load_dword %0, %1, 0x0\n\ts_waitcnt lgkmcnt(0)" : "=s"(en) : "s"(utab + L) : "memory");     u.pm = en & 0xfff; u.pn = (en >> 12) & 15; u.e = en >> 16; return true; }
    DI const char* a_ptr(const Unit&) const { return A; }
    DI const char* b_ptr(const Unit& u) const { return B + (size_t)u.e * estep + (size_t)u.pn * tstep; }
    DI void a_voff(const Unit& u, int K, const int (&R)[2], const int (&C)[2], unsigned (&vo)[2][2]) const {
#pragma unroll
        for (int h = 0; h < 2; ++h)
#pragma unroll
            for (int i = 0; i < 2; ++i) vo[h][i] = (unsigned)(rtok[u.pm * BM + h * HALF + R[i]] * K + C[i]) * 2u; }
};

struct BatchBSched {
    static constexpr bool GATHER = false, B_TILED = false;
    StaticOrder o; const char* A; const char* B; size_t tstep, bstep;
    DI bool next(int i, Unit& u) const { return o.next(i, u); }
    DI const char* a_ptr(const Unit& u) const { return A + (size_t)u.pm * tstep; }
    DI const char* b_ptr(const Unit& u) const { return B + (size_t)(u.pm >> 4) * bstep + (size_t)u.pn * tstep; }
    DI void a_voff(const Unit&, int K, const int (&R)[2], const int (&C)[2], unsigned (&vo)[2][2]) const {
#pragma unroll
        for (int h = 0; h < 2; ++h)
#pragma unroll
            for (int i = 0; i < 2; ++i) vo[h][i] = (unsigned)((h * HALF + R[i]) * K + C[i]) * 2u; }
};
template <int MODE> struct FoldSched {
    static constexpr bool GATHER = false, B_TILED = false;
    const char* A; const char* B; int G, c;
    DI bool next(int i, Unit& u) const { const int L = i * G + c; if (L >= 64) return false; u.pm = L >> 2; u.pn = L & 3; u.e = 0; return true; }
    DI const char* a_ptr(const Unit& u) const { const int b = u.pm >> 2, h = u.pm & 3; return A + ((size_t)(MODE == 0 ? b * 256 : u.pn * 256) * 1024 + h * 256) * 2; }
    DI const char* b_ptr(const Unit& u) const { const int b = u.pm >> 2, h = u.pm & 3; return B + ((size_t)(MODE == 0 ? u.pn * 256 : b * 256) * 1024 + h * 256) * 2; }
    DI void a_voff(const Unit&, int K, const int (&R)[2], const int (&C)[2], unsigned (&vo)[2][2]) const {
#pragma unroll
        for (int h = 0; h < 2; ++h)
#pragma unroll
            for (int i = 0; i < 2; ++i) vo[h][i] = (unsigned)((h * HALF + R[i]) * K + C[i]) * 2u; }
};

DI unsigned cvt_pk_bf16(float lo, float hi) { unsigned r; asm volatile("v_cvt_pk_bf16_f32 %0, %1, %2" : "=v"(r) : "v"(lo), "v"(hi)); return r; }

template <class Epi, class Sched, bool ALIGN_EPI = true, bool FP8 = false>
DI void gemm_phase(LAS unsigned char* lds, const int K, const Sched& S, const Epi& E, const int wv0, const int ldp = 0) {
    const int ld = ldp ? ldp : K;
    const int tid = fresh_tid(), wid = __builtin_amdgcn_readfirstlane(tid >> 6), lane = tid & 63, wr = wid >> 2, wc = wid & 3, fr = lane & 15, fq = lane >> 4;
    const int nt = K / BK;
    constexpr bool GA = Sched::GATHER, BT = Sched::B_TILED;
    unsigned voffA[2][2], voffAn[2][2], voffB[2];
#pragma unroll
    for (int i = 0; i < 2; ++i) { int R, C; stage_rc(tid * 16 + i * 8192, R, C); const int Rb = Epi::PERM ? ((R & ~31) + perm32(R & 31)) : R;
        voffB[i] = BT ? (unsigned)(tid * 16 + i * 8192) : (unsigned)(Rb * ld + C) * 2u; }
#define PG8_AVOFF(unit, dst) do { int sR[2], sC[2]; const int t2_ = fresh_tid(); stage_rc(t2_ * 16, sR[0], sC[0]); stage_rc(t2_ * 16 + 8192, sR[1], sC[1]); S.a_voff(unit, ld, sR, sC, dst); } while (0)
    const size_t kstep = (size_t)(BK * 2);
    const size_t hstep = (size_t)HALF * ld * 2;
    const size_t kstepB = BT ? (size_t)(2 * HTB) : kstep, hstepB = BT ? (size_t)HTB : hstep;
    const unsigned ldsw = (unsigned)wid * 1024u;
    unsigned aoffv = (unsigned)(size_t)lds + (unsigned)lds_byte(wr * 64 + fr, fq * 8), boffv = (unsigned)(size_t)lds + (unsigned)(4 * HTB) + (unsigned)lds_byte(wc * 32 + fr, fq * 8);
    asm volatile("" : "+v"(aoffv), "+v"(boffv));
    const size_t dB = BT ? (size_t)8192 : (size_t)64 * ld * 2, dA = (size_t)64 * ld * 2;
#define PG8_SA(b, h) (((b) * 2 + (h)) * HTB)
#define PG8_SB(b, h) ((4 + (b) * 2 + (h)) * HTB)
    const unsigned ldsbase = (unsigned)__builtin_amdgcn_readfirstlane((int)((unsigned)(size_t)lds + ldsw));
#define PG8_STAGE1(bufoff, gptr, vo, i_) do { const unsigned m0v_ = ldsbase + (unsigned)(bufoff) + (unsigned)(i_) * 8192u; \
        asm volatile("s_mov_b32 m0, %2\n\ts_nop 0\n\tglobal_load_lds_dwordx4 %0, %1" :: "v"(vo), "s"((const char*)(gptr)), "s"(m0v_) : "memory", "m0"); } while (0)
#define PG8_STAGE(bufoff, gbase, voff) do { PG8_STAGE1(bufoff, gbase, (voff)[0], 0); PG8_STAGE1(bufoff, gbase, (voff)[1], 1); } while (0)
#define PG8_STAGE_D(bufoff, gbase, vo, delta) do { PG8_STAGE1(bufoff, gbase, vo, 0); PG8_STAGE1(bufoff, (const char*)(gbase) + (delta), vo, 1); } while (0)
#define PG8_LDA(dst, b, h) do { if constexpr (FP8) { _Pragma("unroll") for (int m = 0; m < 4; ++m) { const LAS v4i* p_ = (const LAS v4i*)((LAS unsigned char*)(size_t)aoffv + PG8_SA(b, h) + m * 2048); dst##8[m] = __builtin_shufflevector(p_[0], p_[64], 0, 1, 2, 3, 4, 5, 6, 7); } } \
        else { _Pragma("unroll") for (int m = 0; m < 4; ++m) _Pragma("unroll") for (int k = 0; k < 2; ++k) dst[m][k] = *(const LAS bf16x8*)((LAS unsigned char*)(size_t)aoffv + PG8_SA(b, h) + m * 2048 + k * 1024); } } while (0)
#define PG8_LDB(dst, b, h) do { if constexpr (FP8) { _Pragma("unroll") for (int n = 0; n < 2; ++n) { const LAS v4i* p_ = (const LAS v4i*)((LAS unsigned char*)(size_t)boffv + (PG8_SB(b, h) - 4 * HTB) + n * 2048); dst##8[n] = __builtin_shufflevector(p_[0], p_[64], 0, 1, 2, 3, 4, 5, 6, 7); } } \
        else { _Pragma("unroll") for (int n = 0; n < 2; ++n) _Pragma("unroll") for (int k = 0; k < 2; ++k) dst[n][k] = *(const LAS bf16x8*)((LAS unsigned char*)(size_t)boffv + (PG8_SB(b, h) - 4 * HTB) + n * 2048 + k * 1024); } } while (0)
#define PG8_MMA(ai, bj, At, Bt) do { __builtin_amdgcn_s_setprio(1); \
        if constexpr (FP8) {   \
            _Pragma("unroll") for (int m = 0; m < 4; ++m) _Pragma("unroll") for (int n = 0; n < 2; ++n) \
                acc[ai][bj][m][n] = __builtin_amdgcn_mfma_scale_f32_16x16x128_f8f6f4(Bt##8[n], At##8[m], acc[ai][bj][m][n], 0, 0, 0, 0, 0, 0); } \
        else { _Pragma("unroll") for (int m = 0; m < 4; ++m) _Pragma("unroll") for (int n = 0; n < 2; ++n) _Pragma("unroll") for (int k = 0; k < 2; ++k) \
            acc[ai][bj][m][n] = __builtin_amdgcn_mfma_f32_16x16x32_bf16(Bt[n][k], At[m][k], acc[ai][bj][m][n], 0, 0, 0); } \
        __builtin_amdgcn_s_setprio(0); } while (0)
#define PG8_WAIT_V(n) asm volatile("s_waitcnt vmcnt(" #n ")" ::: "memory")
#define PG8_WAIT_L(n) asm volatile("s_waitcnt lgkmcnt(" #n ")" ::: "memory")
#define PG8_BAR __builtin_amdgcn_s_barrier()
#define PG8_SCHED __builtin_amdgcn_sched_barrier(0)
    Unit cur, nxt; int ui = 0;
    if (!S.next(0, cur)) return;
    f32x4 acc[2][2][4][2];
#pragma unroll
    for (int a = 0; a < 2; ++a)
#pragma unroll
        for (int b = 0; b < 2; ++b)
#pragma unroll
            for (int m = 0; m < 4; ++m)
#pragma unroll
                for (int n = 0; n < 2; ++n) acc[a][b][m][n] = (f32x4){0.f, 0.f, 0.f, 0.f};
    bf16x8 At[4][2], B0[2][2], B1[2][2]; v8i At8[4], B08[2], B18[2];
    const char* cA = S.a_ptr(cur); const char* cB = S.b_ptr(cur);
    PG8_AVOFF(cur, voffA);
#define PG8_STAGE_A(bufoff, kbase, h, vo) do { if constexpr (GA) { PG8_STAGE(bufoff, kbase, (vo)[h]); } else { PG8_STAGE_D(bufoff, (kbase) + (h) * hstep, voffA[0][0], dA); } } while (0)
    PG8_STAGE_D(PG8_SB(0, 0), cB, voffB[0], dB); PG8_STAGE_D(PG8_SB(0, 1), cB + hstepB, voffB[0], dB); PG8_STAGE_A(PG8_SA(0, 0), cA, 0, voffA); PG8_STAGE_A(PG8_SA(0, 1), cA, 1, voffA);
    if (wr == 1) PG8_BAR;
    PG8_WAIT_V(2); PG8_BAR;
    PG8_STAGE_D(PG8_SB(1, 0), cB + kstepB, voffB[0], dB); PG8_STAGE_A(PG8_SA(1, 0), cA + kstep, 0, voffA); PG8_STAGE_D(PG8_SB(1, 1), cB + hstepB + kstepB, voffB[0], dB);
    PG8_WAIT_V(6); PG8_BAR;
    for (;;) {
        const bool has_next = S.next(ui + 1, nxt);
        const char* nA = has_next ? S.a_ptr(nxt) : cA; const char* nB = has_next ? S.b_ptr(nxt) : cB;
        if constexpr (GA) { if (has_next) PG8_AVOFF(nxt, voffAn);
            else {
#pragma unroll
                for (int h = 0; h < 2; ++h)
#pragma unroll
                    for (int i = 0; i < 2; ++i) voffAn[h][i] = voffA[h][i]; } }
#pragma unroll 1
        for (int t = 0; t < nt; t += 2) {
            const bool last = (t == nt - 2);
            const char* a1 = cA + (size_t)(t + 1) * kstep;
            const char* a2 = last ? nA : cA + (size_t)(t + 2) * kstep; const char* b2 = last ? nB : cB + (size_t)(t + 2) * kstepB;
            const char* a3 = a2 + kstep; const char* b3 = b2 + kstepB;
            PG8_LDB(B0, 0, 0); PG8_LDB(B1, 0, 1); PG8_SCHED; PG8_LDA(At, 0, 0); PG8_STAGE_A(PG8_SA(1, 1), a1, 1, voffA);
            if constexpr (GA) { if (last) {
#pragma unroll
                for (int h = 0; h < 2; ++h)
#pragma unroll
                    for (int i = 0; i < 2; ++i) voffA[h][i] = voffAn[h][i]; } }
            PG8_WAIT_V(8); PG8_WAIT_L(0); PG8_BAR; PG8_MMA(0, 0, At, B0); PG8_MMA(0, 1, At, B1); PG8_BAR; PG8_SCHED;
            PG8_LDA(At, 0, 1); PG8_STAGE_D(PG8_SB(0, 0), b2, voffB[0], dB); PG8_STAGE_D(PG8_SB(0, 1), b2 + hstepB, voffB[0], dB); PG8_STAGE_A(PG8_SA(0, 0), a2, 0, voffA);
            PG8_WAIT_V(8); PG8_WAIT_L(0); PG8_BAR; PG8_MMA(1, 0, At, B0); PG8_MMA(1, 1, At, B1); PG8_BAR; PG8_SCHED;
            PG8_LDB(B0, 1, 0); PG8_LDB(B1, 1, 1); PG8_SCHED; PG8_LDA(At, 1, 0); PG8_STAGE_A(PG8_SA(0, 1), a2, 1, voffA);
            PG8_WAIT_V(8); PG8_WAIT_L(0); PG8_BAR; PG8_MMA(0, 0, At, B0); PG8_MMA(0, 1, At, B1); PG8_BAR; PG8_SCHED;
            PG8_LDA(At, 1, 1); PG8_STAGE_D(PG8_SB(1, 0), b3, voffB[0], dB); PG8_STAGE_D(PG8_SB(1, 1), b3 + hstepB, voffB[0], dB); PG8_STAGE_A(PG8_SA(1, 0), a3, 0, voffA);
            PG8_WAIT_V(8); PG8_WAIT_L(0); PG8_BAR; PG8_MMA(1, 0, At, B0); PG8_MMA(1, 1, At, B1); PG8_BAR; PG8_SCHED;
        }
        if constexpr (ALIGN_EPI) { if (wr == 0) PG8_BAR; }
        { Unit ue = cur; ue.pm = __builtin_amdgcn_readfirstlane(ue.pm); ue.pn = __builtin_amdgcn_readfirstlane(ue.pn); ue.e = __builtin_amdgcn_readfirstlane(ue.e); asm volatile("" : "+s"(ue.pm), "+s"(ue.pn), "+s"(ue.e));
          const int t3_ = fresh_tid(); const int fr_ = t3_ & 15, fq_ = (t3_ & 63) >> 4;
          E(acc, ue, wr, wc, fr_, fq_); }
        if (!has_next) break;
#pragma unroll
        for (int a = 0; a < 2; ++a)
#pragma unroll
            for (int b = 0; b < 2; ++b)
#pragma unroll
                for (int m = 0; m < 4; ++m)
#pragma unroll
                    for (int n = 0; n < 2; ++n) acc[a][b][m][n] = (f32x4){0.f, 0.f, 0.f, 0.f};
        cur = nxt; cA = nA; cB = nB; ++ui;
        if constexpr (ALIGN_EPI) { if (wr == 1) PG8_BAR; }
    }
    PG8_WAIT_V(0);
    if constexpr (!ALIGN_EPI) { if (wr == 0) PG8_BAR; }
    PG8_BAR;
#undef PG8_SA
#undef PG8_SB
#undef PG8_STAGE
#undef PG8_STAGE1
#undef PG8_STAGE_D
#undef PG8_STAGE_A
#undef PG8_AVOFF
#undef PG8_LDA
#undef PG8_LDB
#undef PG8_MMA
#undef PG8_WAIT_V
#undef PG8_WAIT_L
#undef PG8_BAR
#undef PG8_SCHED
}
}
using pg8::Unit;
using pg8::cvt_pk_bf16;

DI float bflo(unsigned w) { return __uint_as_float(w << 16); }
DI float bfhi(unsigned w) { return __uint_as_float(w & 0xffff0000u); }
DI float bf2f(bf16 b) { return __uint_as_float(((unsigned)b) << 16); }
typedef __bf16 hwbf2 __attribute__((ext_vector_type(2)));
DI unsigned pk2(float lo, float hi) { const f32x2 v = {lo, hi}; return __builtin_bit_cast(unsigned, __builtin_convertvector(v, hwbf2)); }
DI unsigned f2bf(float f) { return pk2(f, 0.f) & 0xffffu; }
DI float rcp_f(float x) { return __builtin_amdgcn_rcpf(x); }
DI float rsq_f(float x) { return __builtin_amdgcn_rsqf(x); }
DI float sigmoid_f(float x) { return rcp_f(1.0f + __expf(-x)); }
DI float tanh_fast(float x) { return 1.0f - 2.0f * rcp_f(__expf(2.0f * x) + 1.0f); }
DI float softplus_f(float x) { return fmaxf(x, 0.f) + __logf(1.0f + __expf(-fabsf(x))); }
DI float softplus_fast(float x) { return fmaxf(x, 0.f) + __logf(1.0f + __expf(-fabsf(x))); }
DI float gelu_tanh_f(float x) { const float u = 0.7978845608028654f * (x + 0.044715f * x * x * x); return 0.5f * x * (1.0f + tanh_fast(u)); }
DI float wave_sum(float v) {
#pragma unroll
    for (int o = 1; o < 64; o <<= 1) v += __shfl_xor(v, o);
    return v;
}

DI unsigned pk4_fp8(float a, float b, float c, float d) { int w = 0; w = __builtin_amdgcn_cvt_pk_fp8_f32(a, b, w, false); w = __builtin_amdgcn_cvt_pk_fp8_f32(c, d, w, true); return (unsigned)w; }
struct EpiBf16Plain {
    static constexpr bool PERM = true;
    bf16* O; int ldc; float scale;
    DI void operator()(const f32x4 (&acc)[2][2][4][2], const Unit& u, int wr, int wc, int fr, int fq) const {
        const int row0 = u.pm * 256 + wr * 64 + fr, col0 = u.pn * 256 + wc * 32 + 8 * fq;
#pragma unroll
        for (int ai = 0; ai < 2; ++ai)
#pragma unroll
            for (int m = 0; m < 4; ++m) { bf16* rowp = O + (size_t)(row0 + ai * 128 + m * 16) * ldc + col0;
#pragma unroll
                for (int bj = 0; bj < 2; ++bj) { const f32x4 v0 = acc[ai][bj][m][0] * scale, v1 = acc[ai][bj][m][1] * scale;
                    u32x4 w; w.x = cvt_pk_bf16(v0[0], v0[1]); w.y = cvt_pk_bf16(v0[2], v0[3]); w.z = cvt_pk_bf16(v1[0], v1[1]); w.w = cvt_pk_bf16(v1[2], v1[3]);
                    *(u32x4*)(rowp + bj * 128) = w; } }
    }
};
template <int MODE> struct EpiFold {
    static constexpr bool PERM = true;
    unsigned char* O;
    DI void operator()(const f32x4 (&acc)[2][2][4][2], const Unit& u, int wr, int wc, int fr, int fq) const {
        const int b = u.pm >> 2, h = u.pm & 3;
        const int rbase = MODE == 0 ? h * 256 : u.pn * 256, cbase = MODE == 0 ? u.pn * 256 : h * 256;
        const unsigned boff = (unsigned)b * 1024u * 1024u + (unsigned)(rbase + wr * 64 + fr) * 1024u + (unsigned)(cbase + wc * 32 + 8 * fq);
#pragma unroll
        for (int ai = 0; ai < 2; ++ai)
#pragma unroll
            for (int m = 0; m < 4; ++m) { unsigned char* rowp = O + (boff + (unsigned)(ai * 128 + m * 16) * 1024u);
#pragma unroll
                for (int bj = 0; bj < 2; ++bj) { const f32x4 v0 = acc[ai][bj][m][0] * 4.0f, v1 = acc[ai][bj][m][1] * 4.0f;
                    u32x2 w; w.x = pk4_fp8(v0[0], v0[1], v0[2], v0[3]); w.y = pk4_fp8(v1[0], v1[1], v1[2], v1[3]);
                    *(u32x2*)(rowp + bj * 128) = w; } }
    }
};
struct EpiSoftmax {
    static constexpr bool PERM = true;
    unsigned char* O; float scale; const float* RS; LAS float* XM; LAS float* XS;
    DI void operator()(const f32x4 (&acc)[2][2][4][2], const Unit& u, int wr, int wc, int fr, int fq) const {
        const int row0 = u.pm * 256 + wr * 64 + fr, col0 = u.pn * 256 + wc * 32 + 8 * fq;
        float sc[2][4];
#pragma unroll
        for (int ai = 0; ai < 2; ++ai)
#pragma unroll
            for (int m = 0; m < 4; ++m) { const int r = row0 + ai * 128 + m * 16; const f32x4* rp = (const f32x4*)(RS + (size_t)r * 16);
                const f32x4 p0 = rp[0], p1 = rp[1], p2 = rp[2], p3 = rp[3];
                const float ss = ((p0[0] + p0[1]) + (p0[2] + p0[3])) + ((p1[0] + p1[1]) + (p1[2] + p1[3])) + ((p2[0] + p2[1]) + (p2[2] + p2[3])) + ((p3[0] + p3[1]) + (p3[2] + p3[3]));
                sc[ai][m] = scale * __builtin_amdgcn_rsqf(ss * (1.0f / 1024.0f) + 1e-6f);
                float mm = -3.0e38f;
#pragma unroll
                for (int bj = 0; bj < 2; ++bj)
#pragma unroll
                    for (int n = 0; n < 2; ++n) { const f32x4 v = acc[ai][bj][m][n]; mm = fmaxf(mm, fmaxf(fmaxf(v[0], v[1]), fmaxf(v[2], v[3]))); }
                mm *= sc[ai][m];
                mm = fmaxf(mm, __shfl_xor(mm, 16)); mm = fmaxf(mm, __shfl_xor(mm, 32));
                if (fq == 0) XM[(ai * 128 + wr * 64 + m * 16 + fr) * 4 + wc] = mm; }
        asm volatile("s_waitcnt lgkmcnt(0)" ::: "memory"); __builtin_amdgcn_s_barrier(); asm volatile("" ::: "memory");
        f32x4 (&pa)[2][2][4][2] = const_cast<f32x4 (&)[2][2][4][2]>(acc);
#pragma unroll
        for (int ai = 0; ai < 2; ++ai)
#pragma unroll
            for (int m = 0; m < 4; ++m) { const int lr = ai * 128 + wr * 64 + m * 16 + fr; const f32x4 q = *(const LAS f32x4*)(XM + lr * 4);
                const float mxr = fmaxf(fmaxf(q[0], q[1]), fmaxf(q[2], q[3])); float sm = 0.f;
#pragma unroll
                for (int bj = 0; bj < 2; ++bj)
#pragma unroll
                    for (int n = 0; n < 2; ++n)
#pragma unroll
                        for (int j = 0; j < 4; ++j) { const float p = __expf(acc[ai][bj][m][n][j] * sc[ai][m] - mxr); pa[ai][bj][m][n][j] = p; sm += p; }
                sm += __shfl_xor(sm, 16); sm += __shfl_xor(sm, 32);
                if (fq == 0) XS[lr * 4 + wc] = sm; }
        asm volatile("s_waitcnt lgkmcnt(0)" ::: "memory"); __builtin_amdgcn_s_barrier(); asm volatile("" ::: "memory");
#pragma unroll
        for (int ai = 0; ai < 2; ++ai)
#pragma unroll
            for (int m = 0; m < 4; ++m) { const int lr = ai * 128 + wr * 64 + m * 16 + fr; const f32x4 q = *(const LAS f32x4*)(XS + lr * 4);
                const float inv = 256.0f * __builtin_amdgcn_rcpf((q[0] + q[1]) + (q[2] + q[3]));
                unsigned char* rowp = O + (size_t)(row0 + ai * 128 + m * 16) * 1024 + col0;
#pragma unroll
                for (int bj = 0; bj < 2; ++bj) { const f32x4 v0 = pa[ai][bj][m][0] * inv, v1 = pa[ai][bj][m][1] * inv;
                    u32x2 w; w.x = pk4_fp8(v0[0], v0[1], v0[2], v0[3]); w.y = pk4_fp8(v1[0], v1[1], v1[2], v1[3]);
                    *(u32x2*)(rowp + bj * 128) = w; } }
        asm volatile("s_waitcnt lgkmcnt(0)" ::: "memory"); __builtin_amdgcn_s_barrier(); asm volatile("" ::: "memory");
    }
};
struct EpiBf16RowNorm {
    static constexpr bool PERM = true;
    bf16* O; int ldc; float scale; const float* RS;
    DI void operator()(const f32x4 (&acc)[2][2][4][2], const Unit& u, int wr, int wc, int fr, int fq) const {
        const int row0 = u.pm * 256 + wr * 64 + fr, col0 = u.pn * 256 + wc * 32 + 8 * fq;
#pragma unroll
        for (int ai = 0; ai < 2; ++ai)
#pragma unroll
            for (int m = 0; m < 4; ++m) { const int r = row0 + ai * 128 + m * 16; const f32x4* rp = (const f32x4*)(RS + (size_t)r * 16);
                const f32x4 p0 = rp[0], p1 = rp[1], p2 = rp[2], p3 = rp[3];
                const float ss = ((p0[0] + p0[1]) + (p0[2] + p0[3])) + ((p1[0] + p1[1]) + (p1[2] + p1[3])) + ((p2[0] + p2[1]) + (p2[2] + p2[3])) + ((p3[0] + p3[1]) + (p3[2] + p3[3]));
                const float sc = scale * __builtin_amdgcn_rsqf(ss * (1.0f / 1024.0f) + 1e-6f);
                bf16* rowp = O + (size_t)r * ldc + col0;
#pragma unroll
                for (int bj = 0; bj < 2; ++bj) { const f32x4 v0 = acc[ai][bj][m][0] * sc, v1 = acc[ai][bj][m][1] * sc;
                    u32x4 w; w.x = cvt_pk_bf16(v0[0], v0[1]); w.y = cvt_pk_bf16(v0[2], v0[3]); w.z = cvt_pk_bf16(v1[0], v1[1]); w.w = cvt_pk_bf16(v1[2], v1[3]);
                    *(u32x4*)(rowp + bj * 128) = w; } }
    }
};
template <bool RES_BF16> struct EpiBf16Res {
    static constexpr bool PERM = true;
    const void* Rz; bf16* O; int ldc; float* RS; float ascale; unsigned char* O8;
    DI void operator()(const f32x4 (&acc)[2][2][4][2], const Unit& u, int wr, int wc, int fr, int fq) const {
        const int row0 = u.pm * 256 + wr * 64 + fr, col0 = u.pn * 256 + wc * 32 + 8 * fq;
#pragma unroll
        for (int ai = 0; ai < 2; ++ai) {
            u32x4 rwb[4][2]; f32x4 rf0[4][2], rf1[4][2];
#pragma unroll
            for (int m = 0; m < 4; ++m) { const size_t off = (size_t)(row0 + ai * 128 + m * 16) * ldc + col0;
#pragma unroll
                for (int bj = 0; bj < 2; ++bj) {
                    if (RES_BF16) rwb[m][bj] = __builtin_nontemporal_load((const u32x4*)((const bf16*)Rz + off + bj * 128));
                    else { rf0[m][bj] = __builtin_nontemporal_load((const f32x4*)((const float*)Rz + off + bj * 128)); rf1[m][bj] = __builtin_nontemporal_load((const f32x4*)((const float*)Rz + off + bj * 128 + 4)); } } }
#pragma unroll
            for (int m = 0; m < 4; ++m) { const size_t off = (size_t)(row0 + ai * 128 + m * 16) * ldc + col0; float ssq = 0.f;
#pragma unroll
                for (int bj = 0; bj < 2; ++bj) { f32x4 r0, r1;
                    if (RES_BF16) { const u32x4 rw = rwb[m][bj]; r0 = (f32x4){bflo(rw.x), bfhi(rw.x), bflo(rw.y), bfhi(rw.y)}; r1 = (f32x4){bflo(rw.z), bfhi(rw.z), bflo(rw.w), bfhi(rw.w)}; }
                    else { r0 = rf0[m][bj]; r1 = rf1[m][bj]; }
                    const f32x4 v0 = r0 + acc[ai][bj][m][0] * ascale, v1 = r1 + acc[ai][bj][m][1] * ascale;
                    if (O8) { u32x2 w8; w8.x = pk4_fp8(v0[0], v0[1], v0[2], v0[3]); w8.y = pk4_fp8(v1[0], v1[1], v1[2], v1[3]); *(u32x2*)(O8 + off + bj * 128) = w8; }
                    ssq += (v0[0] * v0[0] + v0[1] * v0[1]) + (v0[2] * v0[2] + v0[3] * v0[3]) + (v1[0] * v1[0] + v1[1] * v1[1]) + (v1[2] * v1[2] + v1[3] * v1[3]);
                    u32x4 w; w.x = cvt_pk_bf16(v0[0], v0[1]); w.y = cvt_pk_bf16(v0[2], v0[3]); w.z = cvt_pk_bf16(v1[0], v1[1]); w.w = cvt_pk_bf16(v1[2], v1[3]);
                    *(u32x4*)(O + off + bj * 128) = w; }
                if (RS) { ssq += __shfl_xor(ssq, 16); ssq += __shfl_xor(ssq, 32); if (fq == 0) RS[(size_t)(row0 + ai * 128 + m * 16) * 16 + u.pn * 4 + wc] = ssq; } } }
    }
};
struct EpiLora {
    static constexpr bool PERM = false;
    float* LWp; bf16* AAp; bf16* GGp; const float* w0; const float* a0;
    DI void operator()(const f32x4 (&acc)[2][2][4][2], const Unit& u, int wr, int wc, int fr, int fq) const {
        const int kind = u.pn >> 1;
        const int row0 = u.pm * 256 + wr * 64 + fr, col0 = (u.pn & 1) * 256 + wc * 32 + 4 * fq;
#pragma unroll
        for (int bj = 0; bj < 2; ++bj)
#pragma unroll
            for (int n = 0; n < 2; ++n) {
                const int c = col0 + bj * 128 + n * 16;
                f32x4 bias = (f32x4){0.f, 0.f, 0.f, 0.f};
                if (kind == 0) bias = *(const f32x4*)(w0 + c); else if (kind == 1) bias = *(const f32x4*)(a0 + c);
#pragma unroll
                for (int ai = 0; ai < 2; ++ai)
#pragma unroll
                    for (int m = 0; m < 4; ++m) {
                        f32x4 v = acc[ai][bj][m][n] + bias;
                        if (kind == 0) {
#pragma unroll
                            for (int j = 0; j < 4; ++j) { const float w = -softplus_fast(-v[j]) - 0.5f; v[j] = -__expf(w);     }
                        } else if (kind == 1) {
#pragma unroll
                            for (int j = 0; j < 4; ++j) v[j] = sigmoid_f(v[j]);
                        }
                        const size_t o_ = (size_t)(row0 + ai * 128 + m * 16) * 512 + c;
                        if (kind == 0) *(f32x4*)(LWp + o_) = v;
                        else { u32x2 w_; w_.x = cvt_pk_bf16(v[0], v[1]); w_.y = cvt_pk_bf16(v[2], v[3]); *(u32x2*)((kind == 1 ? AAp : GGp) + o_) = w_; }
                    }
            }
    }
};
typedef float f32x2_t __attribute__((ext_vector_type(2)));
struct EpiSwiglu {
    static constexpr bool PERM = true;
    bf16* ACT; const float* b_gu;
    DI void operator()(const f32x4 (&acc)[2][2][4][2], const Unit& u, int wr, int wc, int fr, int fq) const {
        const int row0 = u.pm * 256 + wr * 64 + fr, j0 = u.pn * 128 + wc * 32 + 8 * fq;
        const float* bg = b_gu + (size_t)u.e * 2048 + j0; const float* bu = bg + 1024;
        const f32x4 bg0 = *(const f32x4*)bg, bg1 = *(const f32x4*)(bg + 4), bu0 = *(const f32x4*)bu, bu1 = *(const f32x4*)(bu + 4);
#pragma unroll
        for (int ai = 0; ai < 2; ++ai)
#pragma unroll
            for (int m = 0; m < 4; ++m) {
                float o[8];
#pragma unroll
                for (int n = 0; n < 2; ++n) { const f32x4 g4 = acc[ai][0][m][n] * 0.015625f + (n ? bg1 : bg0), u4 = acc[ai][1][m][n] * 0.015625f + (n ? bu1 : bu0);
#pragma unroll
                    for (int p = 0; p < 2; ++p) {
                        f32x2_t g, up; g.x = fminf(g4[2 * p], 7.0f); g.y = fminf(g4[2 * p + 1], 7.0f); up.x = fminf(fmaxf(u4[2 * p], -7.0f), 7.0f); up.y = fminf(fmaxf(u4[2 * p + 1], -7.0f), 7.0f);
                        const f32x2_t ex = g * (-1.702f * 1.44269504089f); f32x2_t d; d.x = __builtin_amdgcn_exp2f(ex.x); d.y = __builtin_amdgcn_exp2f(ex.y); d = d + 1.0f;
                        f32x2_t r; r.x = __builtin_amdgcn_rcpf(d.x); r.y = __builtin_amdgcn_rcpf(d.y);
                        const f32x2_t ov = (up + 1.0f) * (g * r); o[n * 4 + 2 * p] = ov.x; o[n * 4 + 2 * p + 1] = ov.y; } }
                u32x2 w; w.x = pk4_fp8(o[0], o[1], o[2], o[3]); w.y = pk4_fp8(o[4], o[5], o[6], o[7]);
                *(u32x2*)((unsigned char*)ACT + (size_t)(row0 + ai * 128 + m * 16) * 1024 + j0) = w;
            }
    }
};
struct EpiDown {
    static constexpr bool PERM = true;
    bf16* YS; const float* b_dn; const u32x2* row_sg;
    DI void operator()(const f32x4 (&acc)[2][2][4][2], const Unit& u, int wr, int wc, int fr, int fq) const {
        const int row0 = u.pm * 256 + wr * 64 + fr, col0 = u.pn * 256 + wc * 32 + 8 * fq;
        const float* bb = b_dn + (size_t)u.e * 1024 + col0;
        f32x4 bv[2][2];
#pragma unroll
        for (int bj = 0; bj < 2; ++bj)
#pragma unroll
            for (int n = 0; n < 2; ++n) bv[bj][n] = *(const f32x4*)(bb + bj * 128 + 4 * n);
        int slots[8]; float gts[8];
        { const u32x2* sgp = row_sg + row0;
#pragma unroll
        for (int q = 0; q < 8; ++q) { const u32x2 sg = sgp[(q >> 2) * 128 + (q & 3) * 16]; slots[q] = (int)sg.x; gts[q] = __uint_as_float(sg.y); } }
#pragma unroll
        for (int ai = 0; ai < 2; ++ai)
#pragma unroll
            for (int m = 0; m < 4; ++m) {
                const int slot = slots[ai * 4 + m]; const float gt = gts[ai * 4 + m];
                if (slot >= 0) { unsigned char* rowp = (unsigned char*)YS + (size_t)slot * 1024 + col0; const float g16 = gt * 16.0f;
#pragma unroll
                    for (int bj = 0; bj < 2; ++bj) { const f32x4 v0 = (acc[ai][bj][m][0] * 0.015625f + bv[bj][0]) * g16, v1 = (acc[ai][bj][m][1] * 0.015625f + bv[bj][1]) * g16;
                        u32x2 w; w.x = pk4_fp8(v0[0], v0[1], v0[2], v0[3]); w.y = pk4_fp8(v1[0], v1[1], v1[2], v1[3]);
                        *(u32x2*)(rowp + bj * 128) = w; } }
            }
    }
};

constexpr size_t MiB = 1u << 20;
constexpr size_t WS_CTL = 0, CTL_ZERO_BYTES = 1 * MiB;
constexpr size_t WS_WIN = 1 * MiB, WS_WOUT = 7 * MiB, WS_WQ = 9 * MiB, WS_WK = 11 * MiB, WS_WV = 13 * MiB, WS_WO = 15 * MiB, WS_LORAB = 17 * MiB, WS_LRUW = 18 * MiB;
constexpr size_t WS_ROUTE = 19 * MiB;
constexpr size_t WS_WGU = 22 * MiB, WS_WDN = 150 * MiB;
constexpr size_t WS_HN = 214 * MiB, WS_MEMN = 246 * MiB, WS_KM = 248 * MiB, WS_VT = 250 * MiB;
constexpr size_t WS_X1 = 252 * MiB, WS_X2 = 316 * MiB;
constexpr size_t WS_U = 380 * MiB, WS_R = 468 * MiB, WS_KRAW = 500 * MiB, WS_V = 532 * MiB, WS_KKN = 564 * MiB, WS_WD = 596 * MiB, WS_AA = 628 * MiB, WS_G = 660 * MiB;
constexpr size_t WS_LA = 692 * MiB, WS_LB = 724 * MiB, WS_AP = 756 * MiB, WS_CAT = 764 * MiB, WS_Q = 796 * MiB;
constexpr size_t WS_XS = 380 * MiB, WS_ACT = 524 * MiB, WS_YS = 668 * MiB;
constexpr size_t WS_GP = 796 * MiB, WS_HF = 860 * MiB, WS_RP = 924 * MiB, WS_Y1F = 940 * MiB, WS_ADD = 972 * MiB, WS_END = 1004 * MiB;
constexpr size_t WS_GC = 468 * MiB, WS_HC = 484 * MiB, WS_ZS = 500 * MiB;
static_assert(WS_AA == WS_WD + 32 * MiB && WS_G == WS_AA + 32 * MiB, "EpiLora strides");
static_assert(WS_U + (size_t)M * INW * 2 <= WS_R && WS_XS + (size_t)MAXROWS * 2048 <= WS_ACT && WS_ACT + (size_t)MAXROWS * 2048 <= WS_YS && WS_YS + (size_t)NASSIGN * 2048 <= WS_Q, "ws map");
constexpr size_t RT_E = 0, RT_POS = 256 * 1024, RT_G = 512 * 1024, RT_SLOT = 768 * 1024, RT_GATE = 1088 * 1024, RT_TILE = 1408 * 1024, RT_TOK = 1472 * 1024, RT_UGU = 1792 * 1024, RT_UDN = 1808 * 1024;
constexpr int CW_BAR = 4096, CW_CNT = 8192, CW_CONV = 12288;

constexpr int RING_BYTES = 131072, MISC_OFF = RING_BYTES + 320, LDS_BYTES = 147456;
constexpr int NWAVES = 8, NTHREADS = 512;
constexpr int CONV_P9 = 6144;
constexpr int CONV_P9D = 16384;

#define XB_TMO      128
#define XB_XCNT(j)  (256  + 64 * (j))
#define XB_XSUB(j)  (1280 + 64 * (j))
#define XB_XGEN(j)  (2304 + 64 * (j))
#define XB_TOP      3328
#define XB_TOPGEN   3392
#define XCD_BAR_WORDS 3456
#define XB_SPIN_CAP (1u << 18)
DI unsigned xb_ld(unsigned* p)              { return __hip_atomic_load(p, __ATOMIC_RELAXED, __HIP_MEMORY_SCOPE_AGENT); }
DI unsigned xb_add(unsigned* p, unsigned v) { return __hip_atomic_fetch_add(p, v, __ATOMIC_RELAXED, __HIP_MEMORY_SCOPE_AGENT); }
DI unsigned xb_xcc_id() { return (unsigned)__builtin_amdgcn_s_getreg((3 << 11) | 20) & 0xFu; }
#define XB_SPIN(cond, bar) do { unsigned _sp = 0; while (cond) { __builtin_amdgcn_s_sleep(1); \
    if ((++_sp & 255u) == 0u) { if (xb_ld(&(bar)[XB_TMO])) break; if (_sp > XB_SPIN_CAP) { atomicAdd(&(bar)[XB_TMO], 1u); break; } } } } while (0)
struct XcdBarrier { unsigned* bar; unsigned x; volatile LAS unsigned* st; int w0; };
DI XcdBarrier xcd_barrier_post(unsigned* bar, volatile LAS unsigned* st, int w0) {
    XcdBarrier b; b.bar = bar; b.x = xb_xcc_id(); b.st = st; b.w0 = w0;
    if (fresh_tid_(w0) == 0) (void)xb_add(&bar[XB_XCNT(b.x)], 1u);
    return b;
}
DI void xcd_barrier_complete(unsigned* bar, unsigned x, unsigned& nloc, unsigned& nx) {
    const unsigned G = gridDim.x * gridDim.y * gridDim.z;
    unsigned sum, cnt, mine, sp = 0u;
    for (;;) {
        sum = 0u; cnt = 0u; mine = 0u;
#pragma unroll
        for (unsigned j = 0; j < 16; ++j) { const unsigned c = xb_ld(&bar[XB_XCNT(j)]); sum += c; cnt += (c > 0u) ? 1u : 0u; mine = (j == x) ? c : mine; }
        if (sum == G) break;
        __builtin_amdgcn_s_sleep(1);
        if ((++sp & 255u) == 0u) { if (xb_ld(&bar[XB_TMO])) break; if (sp > XB_SPIN_CAP) { atomicAdd(&bar[XB_TMO], 1u); break; } }
    }
    nloc = mine > 0u ? mine : 1u; nx = cnt > 0u ? cnt : 1u;
}
DI void xcd_barrier(const XcdBarrier& b) {
    asm volatile("s_waitcnt vmcnt(0)" ::: "memory");
    __syncthreads();
    if (fresh_tid_(b.w0) == 0) {
        unsigned* bar = b.bar;
        __builtin_amdgcn_s_waitcnt(0);
        unsigned nloc = b.st[0], nx = b.st[1];
        if (nloc == 0u) { xcd_barrier_complete(bar, b.x, nloc, nx); b.st[0] = nloc; b.st[1] = nx; }
        const unsigned old = xb_add(&bar[XB_XSUB(b.x)], 1u);
        const unsigned gen = old / nloc;
        if (old + 1u == (gen + 1u) * nloc) {
            __builtin_amdgcn_fence(__ATOMIC_RELEASE, "agent");
            asm volatile("s_waitcnt vmcnt(0)" ::: "memory");
            const unsigned og = xb_add(&bar[XB_TOP], 1u);
            const unsigned tg = og / nx;
            if (og + 1u == (tg + 1u) * nx) xb_add(&bar[XB_TOPGEN], 1u);
            else XB_SPIN(xb_ld(&bar[XB_TOPGEN]) == tg, bar);
            __builtin_amdgcn_fence(__ATOMIC_ACQUIRE, "agent");
            xb_add(&bar[XB_XGEN(b.x)], 1u);
            asm volatile("s_waitcnt vmcnt(0)" ::: "memory");
        } else {
            XB_SPIN(xb_ld(&bar[XB_XGEN(b.x)]) == gen, bar);
            __builtin_amdgcn_fence(__ATOMIC_ACQUIRE, "agent");
            asm volatile("s_waitcnt vmcnt(0)" ::: "memory");
        }
    }
    __syncthreads();
}

struct Args { const float* in[37]; float* out; unsigned char* ws; int ph_lo, ph_hi; };
enum { I_X = 0, I_MEM, I_NMIXG, I_WIN, I_CONVW, I_CONVB, I_LWX, I_LBX, I_LWA, I_LBA, I_LAM, I_MU, I_W0, I_WUP, I_A0, I_AUP, I_GUP, I_KK, I_KA, I_RK, I_LNG, I_LNB,
       I_WOUT, I_NXAG, I_NMEMG, I_WQ, I_WK, I_WV, I_WO, I_NFFG, I_WR, I_BR, I_WGU, I_BGU, I_WDN, I_BDN, I_FNG };

DI void transpose_item(const float* W, int ldw, int K, bf16* WT, int k0, int n0, int drow0, LAS float* scr, int lane, const float* rs = nullptr) {
    f32x4 t[8];
    const float* src = W + (size_t)(k0 + (lane >> 3)) * ldw + n0 + 4 * (lane & 7);
#pragma unroll
    for (int i = 0; i < 8; ++i) t[i] = *(const f32x4*)(src + (size_t)(8 * i) * ldw);
#pragma unroll
    for (int i = 0; i < 8; ++i) { const float sc_ = rs ? rs[k0 + 8 * i + (lane >> 3)] : 1.0f; LAS float* d = scr + (8 * i + (lane >> 3)) * 33 + 4 * (lane & 7); d[0] = t[i].x * sc_; d[1] = t[i].y * sc_; d[2] = t[i].z * sc_; d[3] = t[i].w * sc_; }
    asm volatile("s_waitcnt lgkmcnt(0)" ::: "memory");
    const int c = lane & 7;
#pragma unroll
    for (int j = 0; j < 4; ++j) { const int n = (lane >> 3) + 8 * j; const LAS float* s = scr + (8 * c) * 33 + n;
        u32x4 o; o.x = pk2(s[0 * 33], s[1 * 33]); o.y = pk2(s[2 * 33], s[3 * 33]); o.z = pk2(s[4 * 33], s[5 * 33]); o.w = pk2(s[6 * 33], s[7 * 33]);
        *(u32x4*)(WT + (size_t)(drow0 + n) * K + k0 + 8 * c) = o; }
    asm volatile("s_waitcnt lgkmcnt(0)" ::: "memory");
}
DI void transpose_item_tiled(const float* W, int ldw, int K, bf16* WTe, int k0, int n0, int drow0, LAS float* scr, int lane) {
    f32x4 t[8];
    const float* src = W + (size_t)(k0 + (lane >> 3)) * ldw + n0 + 4 * (lane & 7);
#pragma unroll
    for (int i = 0; i < 8; ++i) t[i] = *(const f32x4*)(src + (size_t)(8 * i) * ldw);
#pragma unroll
    for (int i = 0; i < 8; ++i) { LAS float* d = scr + (8 * i + (lane >> 3)) * 33 + 4 * (lane & 7); d[0] = t[i].x; d[1] = t[i].y; d[2] = t[i].z; d[3] = t[i].w; }
    asm volatile("s_waitcnt lgkmcnt(0)" ::: "memory");
    const int c = lane & 7;
#pragma unroll
    for (int j = 0; j < 4; ++j) { const int n = (lane >> 3) + 8 * j; const LAS float* s = scr + (8 * c) * 33 + n;
        u32x4 o; o.x = pk2(s[0 * 33], s[1 * 33]); o.y = pk2(s[2 * 33], s[3 * 33]); o.z = pk2(s[4 * 33], s[5 * 33]); o.w = pk2(s[6 * 33], s[7 * 33]);
        const int drow = drow0 + n, pn = drow >> 8, half = (drow >> 7) & 1, r = drow & 127, x = r & 31;
        const int rslot = (r & ~31) + 16 * ((x >> 2) & 1) + 4 * (x >> 3) + (x & 3);
        const size_t tb = ((size_t)(pn * (K / 64) + (k0 >> 6)) * 2 + half) * 16384 + pg8::lds_byte(rslot, 8 * c);
        *(u32x4*)((char*)WTe + tb) = o; }
    asm volatile("s_waitcnt lgkmcnt(0)" ::: "memory");
}
DI void transpose_item_tiled_nolds(const float* W, int ldw, int K, bf16* WTe, int k0, int n0, int drow0, int lane) {
    const int n = lane & 31, kh = lane >> 5;
    const float* src = W + (size_t)(k0 + 32 * kh) * ldw + n0 + n;
    float t[32];
#pragma unroll
    for (int i = 0; i < 32; ++i) t[i] = src[(size_t)i * ldw];
    const int drow = drow0 + n, pn = drow >> 8, half = (drow >> 7) & 1, r = drow & 127, x = r & 31;
    const int rslot = (r & ~31) + 16 * ((x >> 2) & 1) + 4 * (x >> 3) + (x & 3);
    const size_t tb0 = ((size_t)(pn * (K / 64) + (k0 >> 6)) * 2 + half) * 16384;
#pragma unroll
    for (int c = 0; c < 4; ++c) { u32x4 o; o.x = pk2(t[8 * c], t[8 * c + 1]); o.y = pk2(t[8 * c + 2], t[8 * c + 3]); o.z = pk2(t[8 * c + 4], t[8 * c + 5]); o.w = pk2(t[8 * c + 6], t[8 * c + 7]);
        *(u32x4*)((char*)WTe + tb0 + pg8::lds_byte(rslot, 32 * kh + 8 * c)) = o; }
}
DI void transpose_item_tiled_fp8_nolds(const float* W, int ldw, int K, unsigned char* WTe, int k0, int n0, int drow0, int lane) {
    const int n = lane & 31, kh = lane >> 5;
    const float* src = W + (size_t)(k0 + 32 * kh) * ldw + n0 + n;
    float t[32];
#pragma unroll
    for (int i = 0; i < 32; ++i) t[i] = __builtin_nontemporal_load(src + (size_t)i * ldw) * 64.f;
    const int drow = drow0 + n, pn = drow >> 8, half = (drow >> 7) & 1, r = drow & 127, x = r & 31;
    const int rslot = (r & ~31) + 16 * ((x >> 2) & 1) + 4 * (x >> 3) + (x & 3);
    const size_t tb0 = ((size_t)(pn * (K / 128) + (k0 >> 7)) * 2 + half) * 16384;
#pragma unroll
    for (int c = 0; c < 2; ++c) { u32x4 o; o.x = pk4_fp8(t[16 * c], t[16 * c + 1], t[16 * c + 2], t[16 * c + 3]); o.y = pk4_fp8(t[16 * c + 4], t[16 * c + 5], t[16 * c + 6], t[16 * c + 7]);
        o.z = pk4_fp8(t[16 * c + 8], t[16 * c + 9], t[16 * c + 10], t[16 * c + 11]); o.w = pk4_fp8(t[16 * c + 12], t[16 * c + 13], t[16 * c + 14], t[16 * c + 15]);
        const int bc = (k0 & 64) + 32 * kh + 16 * c;
        *(u32x4*)(WTe + tb0 + pg8::lds_byte(rslot, bc >> 1)) = o; }
}
DI void transpose_item_tiled_fp8(const float* W, int ldw, int K, unsigned char* WTe, int k0, int n0, int drow0, LAS float* scr, int lane) {
    f32x4 t[8];
    const float* src = W + (size_t)(k0 + (lane >> 3)) * ldw + n0 + 4 * (lane & 7);
#pragma unroll
    for (int i = 0; i < 8; ++i) t[i] = __builtin_nontemporal_load((const f32x4*)(src + (size_t)(8 * i) * ldw));
#pragma unroll
    for (int i = 0; i < 8; ++i) { LAS float* d = scr + (8 * i + (lane >> 3)) * 33 + 4 * (lane & 7); d[0] = t[i].x * 64.f; d[1] = t[i].y * 64.f; d[2] = t[i].z * 64.f; d[3] = t[i].w * 64.f; }
    asm volatile("s_waitcnt lgkmcnt(0)" ::: "memory");
    const int c = lane & 3;
#pragma unroll
    for (int j = 0; j < 2; ++j) { const int n = (lane >> 2) + 16 * j; const LAS float* sp = scr + (16 * c) * 33 + n;
        u32x4 o; o.x = pk4_fp8(sp[0 * 33], sp[1 * 33], sp[2 * 33], sp[3 * 33]); o.y = pk4_fp8(sp[4 * 33], sp[5 * 33], sp[6 * 33], sp[7 * 33]);
        o.z = pk4_fp8(sp[8 * 33], sp[9 * 33], sp[10 * 33], sp[11 * 33]); o.w = pk4_fp8(sp[12 * 33], sp[13 * 33], sp[14 * 33], sp[15 * 33]);
        const int drow = drow0 + n, pn = drow >> 8, half = (drow >> 7) & 1, r = drow & 127, x = r & 31;
        const int rslot = (r & ~31) + 16 * ((x >> 2) & 1) + 4 * (x >> 3) + (x & 3);
        const int bc = (k0 & 64) + 16 * c;
        const size_t tb = ((size_t)(pn * (K / 128) + (k0 >> 7)) * 2 + half) * 16384 + pg8::lds_byte(rslot, bc >> 1);
        *(u32x4*)(WTe + tb) = o; }
    asm volatile("s_waitcnt lgkmcnt(0)" ::: "memory");
}
DI void rms_row_to_bf16(const float* xrow, const float* g, bf16* orow, int lane) {
    const f32x4* xr = (const f32x4*)xrow + lane; const f32x4* gr = (const f32x4*)g + lane;
    f32x4 v[4]; float s = 0.f;
#pragma unroll
    for (int j = 0; j < 4; ++j) { v[j] = __builtin_nontemporal_load(xr + 64 * j); s += (v[j].x * v[j].x + v[j].y * v[j].y) + (v[j].z * v[j].z + v[j].w * v[j].w); }
    const float rstd = rsq_f(wave_sum(s) * (1.f / D) + EPS);
    u32x2* o8 = (u32x2*)orow + lane;
#pragma unroll
    for (int j = 0; j < 4; ++j) { const f32x4 gg = gr[64 * j]; u32x2 w; w.x = pk2(v[j].x * rstd * gg.x, v[j].y * rstd * gg.y); w.y = pk2(v[j].z * rstd * gg.z, v[j].w * rstd * gg.w); o8[64 * j] = w; }
}

DI void rms_rowbf_to_bf16(const bf16* xrow, const float* g, bf16* orow, int lane) {
    float v[16]; float s = 0.f;
#pragma unroll
    for (int hf = 0; hf < 2; ++hf) { const u32x4 w = *(const u32x4*)(xrow + 512 * hf + 8 * lane);
#pragma unroll
        for (int q = 0; q < 4; ++q) { v[8 * hf + 2 * q] = bflo(w[q]); v[8 * hf + 2 * q + 1] = bfhi(w[q]); } }
#pragma unroll
    for (int j = 0; j < 16; ++j) s += v[j] * v[j];
    const float rstd = rsq_f(wave_sum(s) * (1.f / D) + EPS);
#pragma unroll
    for (int hf = 0; hf < 2; ++hf) { const f32x4 g0 = *(const f32x4*)(g + 512 * hf + 8 * lane), g1 = *(const f32x4*)(g + 512 * hf + 8 * lane + 4);
        u32x4 w; w.x = pk2(v[8 * hf] * rstd * g0.x, v[8 * hf + 1] * rstd * g0.y); w.y = pk2(v[8 * hf + 2] * rstd * g0.z, v[8 * hf + 3] * rstd * g0.w);
        w.z = pk2(v[8 * hf + 4] * rstd * g1.x, v[8 * hf + 5] * rstd * g1.y); w.w = pk2(v[8 * hf + 6] * rstd * g1.z, v[8 * hf + 7] * rstd * g1.w);
        *(u32x4*)(orow + 512 * hf + 8 * lane) = w; }
}

__global__ void __launch_bounds__(NTHREADS, 2) fwd(Args args) {
    extern __shared__ __attribute__((aligned(16))) unsigned char lds_raw[];
    LAS unsigned char* lds = (LAS unsigned char*)lds_raw;
    volatile LAS unsigned* MISC = (volatile LAS unsigned*)(lds + MISC_OFF);
    const int G = gridDim.x, bid = blockIdx.x, NGW = G * NWAVES;
    const int wv0 = __builtin_amdgcn_readfirstlane((int)(threadIdx.x >> 6));
#define PHASE_IDS const int tid = fresh_tid(), lane = tid & 63, wave = __builtin_amdgcn_readfirstlane(tid >> 6), gw = bid * NWAVES + wave; (void)tid; (void)lane; (void)wave; (void)gw
    unsigned char* ws = args.ws;
    unsigned* ctl = (unsigned*)(ws + WS_CTL);
    const int lo = args.ph_lo, hi = args.ph_hi;

    for (int u = fresh_tid(); u < (LDS_BYTES - RING_BYTES) / 4; u += NTHREADS) ((LAS unsigned*)(lds + RING_BYTES))[u] = 0u;
    __syncthreads();
    XcdBarrier bar; bar.bar = ctl + CW_BAR; bar.x = 0; bar.st = nullptr; bar.w0 = wv0;
    if (hi - lo > 1) bar = xcd_barrier_post(ctl + CW_BAR, MISC + 8, wv0);
#define IN(k) (lo <= (k) && (k) < hi)
#define SEAM(k) do { if (IN(k) && IN((k) + 1)) xcd_barrier(bar); } while (0)

#define Win_t ((bf16*)(ws + WS_WIN))
#define Wout_t ((bf16*)(ws + WS_WOUT))
#define Wq_t ((bf16*)(ws + WS_WQ))
#define Wk_t ((bf16*)(ws + WS_WK))
#define Wv_t ((bf16*)(ws + WS_WV))
#define Wo_t ((bf16*)(ws + WS_WO))
#define LoraB ((bf16*)(ws + WS_LORAB))
#define LruW ((bf16*)(ws + WS_LRUW))
#define WrT ((bf16*)(ws + WS_LRUW + 512 * 1024))
#define Wgu_t ((bf16*)(ws + WS_WGU))
#define Wdn_t ((bf16*)(ws + WS_WDN))
#define HN ((bf16*)(ws + WS_HN))
#define MEMN ((bf16*)(ws + WS_MEMN))
#define KM ((bf16*)(ws + WS_KM))
#define VT ((bf16*)(ws + WS_VT))
#define X1 ((bf16*)(ws + WS_X1))
#define X2 ((bf16*)(ws + WS_X2))
#define U ((bf16*)(ws + WS_U))
#define Rr ((float*)(ws + WS_R))
#define KRAW ((float*)(ws + WS_KRAW))
#define Vv ((float*)(ws + WS_V))
#define KKN ((float*)(ws + WS_KKN))
#define WD ((float*)(ws + WS_WD))
#define AA ((float*)(ws + WS_AA))
#define GG ((float*)(ws + WS_G))
#define LA ((bf16*)(ws + WS_LA))
#define LB ((bf16*)(ws + WS_LB))
#define AP ((bf16*)(ws + WS_AP))
#define CAT ((bf16*)(ws + WS_CAT))
#define Qb ((bf16*)(ws + WS_Q))
#define Ob CAT
#define X1F8 ((unsigned char*)(ws + WS_XS))
#define XS ((bf16*)(ws + WS_XS))
#define ACT ((bf16*)(ws + WS_ACT))
#define YS ((bf16*)(ws + WS_YS))
#define route_e ((int*)(ws + WS_ROUTE + RT_E))
#define route_pos ((int*)(ws + WS_ROUTE + RT_POS))
#define route_g ((float*)(ws + WS_ROUTE + RT_G))
#define row_sg ((u32x2*)(ws + WS_ROUTE + RT_SLOT))
#define tile_tab ((int*)(ws + WS_ROUTE + RT_TILE))
#define row_tok ((int*)(ws + WS_ROUTE + RT_TOK))
#define ecnt (ctl + CW_CNT)

    if (IN(0)) { PHASE_IDS;
        LAS float* scr = (LAS float*)(lds + wave * 16384);
        constexpr int I_IN = 16 * (INW / 32), I_SQ = 16 * 32;
        constexpr int N_ITEMS = I_IN + 5 * I_SQ;
        for (int it = gw; it < N_ITEMS; it += NGW) {
            int r = it;
            if (r < I_IN) { const int nblk = INW / 32, kb = r / nblk, nb = r % nblk; transpose_item(args.in[I_WIN], INW, D, Win_t, 64 * kb, 32 * nb, 32 * nb, scr, lane); continue; } r -= I_IN;
            { const int w = r / I_SQ, q = r % I_SQ, kb = q / 32, nb = q % 32;
                if (w == 1) continue;
                const float* src = w == 0 ? args.in[I_WOUT] : w == 2 ? args.in[I_WK] : w == 3 ? args.in[I_WV] : args.in[I_WO];
                bf16* dst = w == 0 ? Wout_t : w == 2 ? Wk_t : w == 3 ? Wv_t : Wo_t;
                transpose_item(src, D, D, dst, 64 * kb, 32 * nb, 32 * nb, scr, lane); }
        }
        for (int idx = bid * NTHREADS + tid; idx < D * D / 4; idx += G * NTHREADS) { const f32x4 v = ((const f32x4*)args.in[I_WQ])[idx]; const float gk = args.in[I_NXAG][idx >> 8];
            u32x2 w; w.x = pk2(v.x * gk, v.y * gk); w.y = pk2(v.z * gk, v.w * gk); ((u32x2*)Wq_t)[idx] = w; }
        for (int idx = bid * NTHREADS + tid; idx < 1536 * 256; idx += G * NTHREADS) {
            const int e = idx & 7, ln = (idx >> 3) & 63, ks = (idx >> 9) & 7, ct = (idx >> 12) & 3, hk = idx >> 14, hh = hk / 3, kind = hk - 3 * hh;
            const int k = 32 * ks + 8 * (ln >> 4) + e, n = hh * 64 + 16 * ct + (ln & 15); float v = 0.f;
            if (kind == 0) { if (k < 64) v = args.in[I_WUP][k * 512 + n]; }
            else if (kind == 1) { if (k >= 64 && k < 128) v = args.in[I_AUP][(k - 64) * 512 + n]; }
            else { if (k >= 128) v = args.in[I_GUP][(k - 128) * 512 + n]; }
            LoraB[idx] = (bf16)f2bf(v);
        }
        for (int idx = bid * NTHREADS + tid; idx < 8 * 128 * 64; idx += G * NTHREADS) {
            const int nb = idx >> 13, col = (idx >> 6) & 127, k = idx & 63;
            const float v = col < 64 ? args.in[I_LWX][nb * 4096 + k * 64 + col] : args.in[I_LWA][nb * 4096 + k * 64 + (col - 64)];
            LruW[idx] = (bf16)f2bf(v);
        }
        for (int idx = bid * NTHREADS + tid; idx < NE * D; idx += G * NTHREADS) {
            const int e = idx >> 10, k = idx & 1023; const float v = args.in[I_WR][k * NE + e];
            const unsigned hi = f2bf(v); const float lo = v - __uint_as_float(hi << 16);
            WrT[idx] = (bf16)hi; WrT[NE * D + idx] = (bf16)f2bf(lo);
        }
        for (int m = gw; m < M; m += NGW) rms_row_to_bf16(args.in[I_X] + (size_t)m * D, args.in[I_NMIXG], HN + (size_t)m * D, lane);
        for (int m = gw; m < MROWS; m += NGW) rms_row_to_bf16(args.in[I_MEM] + (size_t)m * D, args.in[I_NMEMG], MEMN + (size_t)m * D, lane);
        {
            LAS float* scr = (LAS float*)(lds + wave * 16384);
            constexpr int I_GU = 16 * 64, I_DN = 16 * 32;
            for (int it = CONV_P9 + gw; it < NE * I_GU; it += NGW) {
                int r = it;
                if (r < NE * I_GU) { const int e = r / I_GU, q = r % I_GU, kb = q / 64, nb = q % 64; const int n0 = 32 * nb;
                    const int drow = n0 < 1024 ? (256 * (n0 >> 7) + (n0 & 127)) : (256 * ((n0 - 1024) >> 7) + 128 + ((n0 - 1024) & 127));
                    transpose_item_tiled_fp8(args.in[I_WGU] + (size_t)e * D * 2048, 2048, D, (unsigned char*)Wgu_t + (size_t)e * 2048 * D, 64 * kb, n0, drow, scr, lane); continue; } r -= NE * I_GU;
                { const int e = r / I_DN, q = r % I_DN, kb = q / 32, nb = q % 32;
                  transpose_item_tiled(args.in[I_WDN] + (size_t)e * DFF * D, D, DFF, Wdn_t + (size_t)e * D * DFF, 64 * kb, 32 * nb, 32 * nb, scr, lane); }
            }
        }
    }
    SEAM(0);

    if (IN(1)) { PHASE_IDS;
        { pg8::DenseSched S; S.o.init_tiles(M / 256, INW / 256, G, bid); S.A = (const char*)HN; S.B = (const char*)Win_t; S.tstep = (size_t)256 * D * 2;
          EpiBf16Plain E{U, INW, 1.0f}; pg8::gemm_phase(lds, D, S, E, wv0); }
        { pg8::DenseSched S; S.o.init_tiles(MROWS / 256, D / 256, G, (bid + 64) & (G - 1)); S.A = (const char*)MEMN; S.B = (const char*)Wk_t; S.tstep = (size_t)256 * D * 2;
          EpiBf16Plain E{KM, D, 1.0f}; pg8::gemm_phase(lds, D, S, E, wv0); }
        { pg8::DenseSched S; S.o.init_tiles(MROWS / 256, D / 256, G, (bid + 48) & (G - 1)); S.A = (const char*)MEMN; S.B = (const char*)Wv_t; S.tstep = (size_t)256 * D * 2;
          EpiBf16Plain E{VT, D, 1.0f}; pg8::gemm_phase(lds, D, S, E, wv0); }
    }
    SEAM(1);

    if (IN(2)) { PHASE_IDS;
        const float* conv_w = args.in[I_CONVW]; const float* conv_b = args.in[I_CONVB];
        LAS float* xs = (LAS float*)(lds + wave * 16384);
        LAS bf16* tP = (LAS bf16*)(lds + wave * 16384 + 4096); LAS bf16* tH = tP + 1024;
        const int i = lane & 15, kg = lane >> 4;
        for (int unit = gw; unit < (M / 64) * 8; unit += NGW) {
            const int seg = unit >> 3, nb = unit & 7, m0s = seg * 64, s0s = m0s & (SEQ - 1);
            bf16x8 wf[8][2];
#pragma unroll
            for (int ct = 0; ct < 8; ++ct)
#pragma unroll
                for (int ks = 0; ks < 2; ++ks) wf[ct][ks] = *(const bf16x8*)(LruW + ((size_t)(nb * 128 + 16 * ct + i) * 64 + 32 * ks + 8 * kg));
            float bxv[4], bav[4], spv[4], Arun[4], Brun[4];
#pragma unroll
            for (int ct = 0; ct < 4; ++ct) { const int ch = nb * 64 + 16 * ct + i; bxv[ct] = args.in[I_LBX][ch]; bav[ct] = args.in[I_LBA][ch]; spv[ct] = softplus_f(-args.in[I_LAM][ch]); Arun[ct] = 1.f; Brun[ct] = 0.f; }
#pragma unroll 1
            for (int jt = 0; jt < 4; ++jt) {
                const int m0 = m0s + 16 * jt, s0 = s0s + 16 * jt;
                bf16x8 af[2];
#pragma unroll
                for (int ks = 0; ks < 2; ++ks) {
                    const int chb = nb * 64 + 32 * ks + 8 * kg;
                    f32x4 x0 = *(const f32x4*)(conv_b + chb), x1 = *(const f32x4*)(conv_b + chb + 4);
#pragma unroll
                    for (int j = 0; j < 4; ++j) {
                        const bool ok = s0 + i - 3 + j >= 0;
                        u32x4 uw = *(const u32x4*)(U + (size_t)(ok ? m0 + i - 3 + j : m0) * INW + chb); if (!ok) uw = (u32x4){0u, 0u, 0u, 0u};
                        const f32x4 w0 = *(const f32x4*)(conv_w + j * 512 + chb), w1 = *(const f32x4*)(conv_w + j * 512 + chb + 4);
                        x0.x += w0.x * bflo(uw.x); x0.y += w0.y * bfhi(uw.x); x0.z += w0.z * bflo(uw.y); x0.w += w0.w * bfhi(uw.y);
                        x1.x += w1.x * bflo(uw.z); x1.y += w1.y * bfhi(uw.z); x1.z += w1.z * bflo(uw.w); x1.w += w1.w * bfhi(uw.w);
                    }
                    *(LAS f32x4*)(xs + i * 64 + 32 * ks + 8 * kg) = x0; *(LAS f32x4*)(xs + i * 64 + 32 * ks + 8 * kg + 4) = x1;
                    u32x4 p; p.x = pk2(x0.x, x0.y); p.y = pk2(x0.z, x0.w); p.z = pk2(x1.x, x1.y); p.w = pk2(x1.z, x1.w);
                    af[ks] = __builtin_bit_cast(bf16x8, p);
                }
                f32x4 acc[8];
#pragma unroll
                for (int ct = 0; ct < 8; ++ct) { acc[ct] = (f32x4){0.f, 0.f, 0.f, 0.f};
#pragma unroll
                    for (int ks = 0; ks < 2; ++ks) acc[ct] = __builtin_amdgcn_mfma_f32_16x16x32_bf16(af[ks], wf[ct][ks], acc[ct], 0, 0, 0); }
#pragma unroll
                for (int ct = 0; ct < 4; ++ct) {
                    const int col = 16 * ct + i;
                    float hl[4], pl[4]; float hprev = 0.f, pprev = 1.f;
#pragma unroll
                    for (int e = 0; e < 4; ++e) {
                        const float gx = sigmoid_f(acc[ct][e] + bxv[ct]), ga = sigmoid_f(acc[ct + 4][e] + bav[ct]);
                        const float la = -8.0f * ga * spv[ct], av = __expf(la), xcv = xs[(4 * kg + e) * 64 + col];
                        const float bt = __builtin_amdgcn_sqrtf(fmaxf(1.0f - av * av, 0.f)) * gx * xcv;
                        hprev = av * hprev + bt; pprev *= av; hl[e] = hprev; pl[e] = pprev;
                    }
                    float Ag[4], Bg[4];
#pragma unroll
                    for (int gq = 0; gq < 4; ++gq) { Ag[gq] = __shfl(pl[3], i + 16 * gq); Bg[gq] = __shfl(hl[3], i + 16 * gq); }
                    float Ain = Arun[ct], Bin = Brun[ct];
#pragma unroll
                    for (int gq = 0; gq < 3; ++gq) if (gq < kg) { Bin = Ag[gq] * Bin + Bg[gq]; Ain *= Ag[gq]; }
                    float At = 1.f, Bt = 0.f;
#pragma unroll
                    for (int gq = 0; gq < 4; ++gq) { Bt = Ag[gq] * Bt + Bg[gq]; At *= Ag[gq]; }
                    Brun[ct] = At * Brun[ct] + Bt; Arun[ct] *= At;
#pragma unroll
                    for (int e = 0; e < 4; ++e) { const int ti_ = (4 * kg + e) * 64 + col; tP[ti_] = (bf16)f2bf(pl[e] * Ain); tH[ti_] = (bf16)f2bf(hl[e] + pl[e] * Bin); }
                }
                { const int rr = lane >> 2, cq = lane & 3;
                  bf16* pp = LA + (size_t)(m0 + rr) * 512 + nb * 64 + 16 * cq; bf16* hp = LB + (size_t)(m0 + rr) * 512 + nb * 64 + 16 * cq;
                  *(u32x4*)pp = *(const LAS u32x4*)(tP + rr * 64 + 16 * cq); *(u32x4*)(pp + 8) = *(const LAS u32x4*)(tP + rr * 64 + 16 * cq + 8);
                  *(u32x4*)hp = *(const LAS u32x4*)(tH + rr * 64 + 16 * cq); *(u32x4*)(hp + 8) = *(const LAS u32x4*)(tH + rr * 64 + 16 * cq + 8); }
            }
            if (kg == 0) {
#pragma unroll
                for (int ct = 0; ct < 4; ++ct) { f32x2 ab; ab.x = Arun[ct]; ab.y = Brun[ct];
                    *(f32x2*)((float*)(ws + WS_AP) + ((size_t)(((seg >> 6) * 8 + nb) * 64 + (seg & 63)) * 64 + 16 * ct + i) * 2) = ab; }
            }
        }
    }
    SEAM(2);


#define RW_ZB(zz, zb) do { _Pragma("unroll") for (int ks_ = 0; ks_ < 2; ++ks_) { u32x4 p_; p_.x = pk2(zz[2 * ks_][0], zz[2 * ks_][1]); p_.y = pk2(zz[2 * ks_][2], zz[2 * ks_][3]); \
        p_.z = pk2(zz[2 * ks_ + 1][0], zz[2 * ks_ + 1][1]); p_.w = pk2(zz[2 * ks_ + 1][2], zz[2 * ks_ + 1][3]); zb[ks_] = __builtin_bit_cast(bf16x8, p_); } } while (0)
    if (IN(3)) { PHASE_IDS;
        for (int u64 = gw; u64 < NB * NH * (SEQ / 64); u64 += NGW) {
#pragma unroll 1
        for (int jj = 0; jj < 4; ++jj) {
        LAS unsigned char* wl = lds + wave * 16384;
        LAS bf16* Arm = (LAS bf16*)(wl); LAS bf16* Brm = (LAS bf16*)(wl + 2048); LAS bf16* Krm = (LAS bf16*)(wl + 4096); LAS bf16* Rrm = (LAS bf16*)(wl + 6144);
        LAS bf16* ATt = (LAS bf16*)(wl + 8192); LAS bf16* BTt = (LAS bf16*)(wl + 10240); LAS bf16* KTt = (LAS bf16*)(wl + 12288); LAS bf16* VTt = (LAS bf16*)(wl + 14336);
        LAS float* MabT = (LAS float*)(wl); LAS bf16* Mak = (LAS bf16*)(wl + 1024); LAS bf16* Mrb = (LAS bf16*)(wl + 1536); LAS bf16* Mrk = (LAS bf16*)(wl + 2048); LAS bf16* Tm = (LAS bf16*)(wl + 2560);
        LAS float* PLs = (LAS float*)(wl + 3072); LAS bf16* Q0T = (LAS bf16*)(wl + 4096);
        const int lane = fresh_tid() & 63, l15 = lane & 15, g = lane >> 4, te = lane >> 2, kq = lane & 3;
        const bf16x8 z8 = (bf16x8){0, 0, 0, 0, 0, 0, 0, 0};
        const f32x4 z4 = (f32x4){0.f, 0.f, 0.f, 0.f};
            const int un = u64 * 4 + jj;
            const int bh = un >> 8, c = un & 255, b = bh >> 3, h = bh & 7;
            const size_t mrow = (size_t)b * SEQ + c * 16 + te, off = mrow * 512 + h * 64 + 16 * kq;
            const int hc = h * 64 + 16 * kq;
            LAS float* tmpL = (LAS float*)wl;
            {
                const int rsub = lane >> 5, chunk = lane & 31; const size_t mt0 = (size_t)b * SEQ + c * 16;
                const f32x4 m0 = *(const f32x4*)(args.in[I_MU] + 1536 + 8 * chunk), m1 = *(const f32x4*)(args.in[I_MU] + 1536 + 8 * chunk + 4);
                const bool actid = chunk >= 8 && chunk < 16; const float actc = chunk < 8 ? 2.8853900818f : -1.4426950409f, actp = chunk < 8 ? 1.0f : 0.0f, actq = chunk < 8 ? -2.0f : 1.0f;
                u32x4 cu[8], pu[8];
#pragma unroll
                for (int i = 0; i < 8; ++i) { const size_t mr = mt0 + 2 * i + rsub; const bool hp2 = (mr & (SEQ - 1)) != 0; const bf16* ua = U + mr * INW + 2560 + 8 * chunk;
                    cu[i] = *(const u32x4*)ua; pu[i] = *(const u32x4*)(ua - (hp2 ? INW : 0)); if (!hp2) pu[i] = (u32x4){0u, 0u, 0u, 0u}; }
#pragma unroll
                for (int i = 0; i < 8; ++i) { float o8[8];
#pragma unroll
                    for (int q = 0; q < 4; ++q) { const float c0 = bflo(cu[i][q]), c1 = bfhi(cu[i][q]), p0 = bflo(pu[i][q]), p1 = bfhi(pu[i][q]); const float mm0 = q < 2 ? m0[2 * q] : m1[2 * q - 4], mm1 = q < 2 ? m0[2 * q + 1] : m1[2 * q - 3];
                        float x0 = c0 + (p0 - c0) * mm0, x1 = c1 + (p1 - c1) * mm1;
                        { const float r0 = __builtin_amdgcn_rcpf(__builtin_amdgcn_exp2f(actc * x0) + 1.0f), r1 = __builtin_amdgcn_rcpf(__builtin_amdgcn_exp2f(actc * x1) + 1.0f);
                          x0 = actid ? x0 : actp + actq * r0; x1 = actid ? x1 : actp + actq * r1; }
                        o8[2 * q] = x0; o8[2 * q + 1] = x1; }
                    u32x4 pw; pw.x = pk2(o8[0], o8[1]); pw.y = pk2(o8[2], o8[3]); pw.z = pk2(o8[4], o8[5]); pw.w = pk2(o8[6], o8[7]);
                    const int row = 2 * i + rsub; *(LAS u32x4*)(wl + row * 512 + ((chunk ^ (row & 7)) << 4)) = pw; }
                bf16x8 af[8];
#pragma unroll
                for (int ks = 0; ks < 8; ++ks) af[ks] = *(const LAS bf16x8*)(wl + l15 * 512 + (((4 * ks + g) ^ (l15 & 7)) << 4));
                asm volatile("s_waitcnt lgkmcnt(0)" ::: "memory");
#pragma unroll
                for (int kind = 0; kind < 3; ++kind)
#pragma unroll
                    for (int ct = 0; ct < 4; ++ct) {
                        const bf16* lb = LoraB + ((size_t)((h * 3 + kind) * 4 + ct) * 8 * 64 + lane) * 8;
                        f32x4 a4 = z4;
#pragma unroll
                        for (int ks = (kind == 0 ? 0 : kind == 1 ? 2 : 4); ks < (kind == 0 ? 2 : kind == 1 ? 4 : 8); ++ks) a4 = __builtin_amdgcn_mfma_f32_16x16x32_bf16(af[ks], *(const bf16x8*)(lb + ks * 512), a4, 0, 0, 0);
#pragma unroll
                        for (int e = 0; e < 4; ++e) tmpL[kind * 1088 + (4 * g + e) * 68 + 16 * ct + l15] = a4[e];
                    }
            }
            asm volatile("s_waitcnt lgkmcnt(0)" ::: "memory");
            float cl[16], eP[16];
            {
                float lwv[16], rl[16], kl[16], vl[16], kn[16], av[16];
                const bool hp = (mrow & (SEQ - 1)) != 0;
                const bf16* ub = U + mrow * INW + 1024 + hc;
#pragma unroll
                for (int hh = 0; hh < 2; ++hh) {
#pragma unroll
                    for (int a3 = 0; a3 < 3; ++a3) {
                        const u32x4 cu = *(const u32x4*)(ub + 512 * a3 + 8 * hh); u32x4 pu = *(const u32x4*)(ub - (hp ? INW : 0) + 512 * a3 + 8 * hh); if (!hp) pu = (u32x4){0u, 0u, 0u, 0u};
                        const f32x4 m0 = *(const f32x4*)(args.in[I_MU] + 512 * a3 + hc + 8 * hh), m1 = *(const f32x4*)(args.in[I_MU] + 512 * a3 + hc + 8 * hh + 4);
                        float o8[8];
#pragma unroll
                        for (int q = 0; q < 4; ++q) { const float c0 = bflo(cu[q]), c1 = bfhi(cu[q]), p0 = bflo(pu[q]), p1 = bfhi(pu[q]); const float mm0 = q < 2 ? m0[2 * q] : m1[2 * q - 4], mm1 = q < 2 ? m0[2 * q + 1] : m1[2 * q - 3];
                            o8[2 * q] = c0 + (p0 - c0) * mm0; o8[2 * q + 1] = c1 + (p1 - c1) * mm1; }
#pragma unroll
                        for (int q = 0; q < 8; ++q) { if (a3 == 0) rl[8 * hh + q] = o8[q]; else if (a3 == 1) kl[8 * hh + q] = o8[q]; else vl[8 * hh + q] = o8[q]; }
                    }
                }
                float gv[16];
#pragma unroll
                for (int j4 = 0; j4 < 4; ++j4) { const f32x4 xl = *(const LAS f32x4*)(tmpL + te * 68 + 16 * kq + 4 * j4), xa = *(const LAS f32x4*)(tmpL + 1088 + te * 68 + 16 * kq + 4 * j4), xg = *(const LAS f32x4*)(tmpL + 2176 + te * 68 + 16 * kq + 4 * j4);
                    const f32x4 w0v = *(const f32x4*)(args.in[I_W0] + hc + 4 * j4), a0v = *(const f32x4*)(args.in[I_A0] + hc + 4 * j4);
#pragma unroll
                    for (int q = 0; q < 4; ++q) { lwv[4 * j4 + q] = -0.6065306597f * sigmoid_f(xl[q] + w0v[q]);        av[4 * j4 + q] = sigmoid_f(xa[q] + a0v[q]); gv[4 * j4 + q] = xg[q]; } }
                asm volatile("s_waitcnt lgkmcnt(0)" ::: "memory");
                float ss = 0.f;
#pragma unroll
                for (int j4 = 0; j4 < 4; ++j4) { const f32x4 kk4 = *(const f32x4*)(args.in[I_KK] + hc + 4 * j4);
#pragma unroll
                    for (int q = 0; q < 4; ++q) { kn[4 * j4 + q] = kl[4 * j4 + q] * kk4[q]; ss += kn[4 * j4 + q] * kn[4 * j4 + q]; } }
                ss += __shfl_xor(ss, 1); ss += __shfl_xor(ss, 2);
                const float kinv = rsq_f(fmaxf(ss, 1e-24f));
#pragma unroll
                for (int j = 0; j < 16; ++j) { float x = lwv[j];
#pragma unroll
                    for (int sft = 4; sft < 64; sft <<= 1) { const float y = __shfl_up(x, sft); if (lane >= sft) x += y; }
                    cl[j] = x; }
                float bon = 0.f;
                u32x4 pa[2], pb[2], pk[2], pr[2];
#pragma unroll
                for (int j4 = 0; j4 < 4; ++j4) {
                    const f32x4 ka = *(const f32x4*)(args.in[I_KA] + hc + 4 * j4), rk = *(const f32x4*)(args.in[I_RK] + hc + 4 * j4);
                    float at4[4], bt4[4], kt4[4], rt4[4];
#pragma unroll
                    for (int q = 0; q < 4; ++q) { const int j = 4 * j4 + q;
                        const float p = __expf(cl[j]), pn = __expf(-cl[j]), pm1 = __expf(cl[j] - lwv[j]); eP[j] = p;
                        const float knj = kn[j] * kinv;
                        const float kp = kl[j] * (1.0f + (av[j] - 1.0f) * ka[q]);
                        at4[q] = -knj * pm1; bt4[q] = knj * av[j] * pn; kt4[q] = kp * pn; rt4[q] = rl[j] * p;
                        bon += rl[j] * kp * rk[q];
                        const int kk = 16 * kq + j;
                        ATt[kk * 16 + te] = (bf16)f2bf(at4[q]); BTt[kk * 16 + te] = (bf16)f2bf(bt4[q]); KTt[kk * 16 + te] = (bf16)f2bf(kt4[q]); VTt[kk * 16 + te] = (bf16)f2bf(vl[j]); }
                    const int hh = j4 >> 1, w2 = (j4 & 1) * 2;
                    pa[hh][w2] = pk2(at4[0], at4[1]); pa[hh][w2 + 1] = pk2(at4[2], at4[3]); pb[hh][w2] = pk2(bt4[0], bt4[1]); pb[hh][w2 + 1] = pk2(bt4[2], bt4[3]);
                    pk[hh][w2] = pk2(kt4[0], kt4[1]); pk[hh][w2 + 1] = pk2(kt4[2], kt4[3]); pr[hh][w2] = pk2(rt4[0], rt4[1]); pr[hh][w2 + 1] = pk2(rt4[2], rt4[3]);
                }
#pragma unroll
                for (int hh = 0; hh < 2; ++hh) { const int po = te * 64 + 8 * ((2 * kq + hh) ^ (te & 7));
                    *(LAS u32x4*)(Arm + po) = pa[hh]; *(LAS u32x4*)(Brm + po) = pb[hh]; *(LAS u32x4*)(Krm + po) = pk[hh]; *(LAS u32x4*)(Rrm + po) = pr[hh]; }
                bon += __shfl_xor(bon, 1); bon += __shfl_xor(bon, 2);
                f32x4 lbv[4], lgv[4];
#pragma unroll
                for (int j4 = 0; j4 < 4; ++j4) { lbv[j4] = *(const f32x4*)(args.in[I_LNB] + hc + 4 * j4); lgv[j4] = *(const f32x4*)(args.in[I_LNG] + hc + 4 * j4); }
#pragma unroll
                for (int j4 = 0; j4 < 4; ++j4) { const f32x4 lb = lbv[j4], lgn = lgv[j4]; const int j0 = 4 * j4;
                    u32x2 ow, gw2; ow.x = pk2((lb.x + vl[j0] * bon) * gv[j0], (lb.y + vl[j0 + 1] * bon) * gv[j0 + 1]); ow.y = pk2((lb.z + vl[j0 + 2] * bon) * gv[j0 + 2], (lb.w + vl[j0 + 3] * bon) * gv[j0 + 3]);
                    gw2.x = pk2(lgn.x * gv[j0], lgn.y * gv[j0 + 1]); gw2.y = pk2(lgn.z * gv[j0 + 2], lgn.w * gv[j0 + 3]);
                    *(u32x2*)((bf16*)(ws + WS_ADD) + off + j0) = ow; *(u32x2*)((bf16*)(ws + WS_G) + off + j0) = gw2; }
            }
            asm volatile("s_waitcnt lgkmcnt(0)" ::: "memory");
            {
                bf16x8 fa[2], fr[2], fb[2], fk[2];
#pragma unroll
                for (int ks = 0; ks < 2; ++ks) { const int po = l15 * 64 + 8 * ((4 * ks + g) ^ (l15 & 7));
                    fa[ks] = *(const LAS bf16x8*)(Arm + po); fr[ks] = *(const LAS bf16x8*)(Rrm + po); fb[ks] = *(const LAS bf16x8*)(Brm + po); fk[ks] = *(const LAS bf16x8*)(Krm + po); }
                f32x4 mab = z4, mak = z4, mrb = z4, mrk = z4;
#pragma unroll
                for (int ks = 0; ks < 2; ++ks) { mab = __builtin_amdgcn_mfma_f32_16x16x32_bf16(fb[ks], fa[ks], mab, 0, 0, 0); mak = __builtin_amdgcn_mfma_f32_16x16x32_bf16(fk[ks], fa[ks], mak, 0, 0, 0);
                    mrb = __builtin_amdgcn_mfma_f32_16x16x32_bf16(fb[ks], fr[ks], mrb, 0, 0, 0); mrk = __builtin_amdgcn_mfma_f32_16x16x32_bf16(fk[ks], fr[ks], mrk, 0, 0, 0); }
#pragma unroll
                for (int e = 0; e < 4; ++e) { const int i = 4 * g + e; if (!(i < l15)) { mab[e] = 0.f; mak[e] = 0.f; } if (!(i <= l15)) { mrb[e] = 0.f; mrk[e] = 0.f; } }
                asm volatile("s_waitcnt lgkmcnt(0)" ::: "memory");
#pragma unroll
                for (int e = 0; e < 4; ++e) MabT[(4 * g + e) * 16 + l15] = mab[e];
                u32x2 w; w.x = pk2(mak[0], mak[1]); w.y = pk2(mak[2], mak[3]); *(LAS u32x2*)(Mak + l15 * 16 + 4 * g) = w;
                w.x = pk2(mrb[0], mrb[1]); w.y = pk2(mrb[2], mrb[3]); *(LAS u32x2*)(Mrb + l15 * 16 + 4 * g) = w;
                w.x = pk2(mrk[0], mrk[1]); w.y = pk2(mrk[2], mrk[3]); *(LAS u32x2*)(Mrk + l15 * 16 + 4 * g) = w;
                if (te == 15) {
#pragma unroll
                    for (int j = 0; j < 16; ++j) PLs[16 * kq + j] = eP[j]; }
            }
            asm volatile("s_waitcnt lgkmcnt(0)" ::: "memory");
            {
                f32x4 mq[15][4];
#pragma unroll
                for (int j = 0; j < 15; ++j)
#pragma unroll
                    for (int q = 0; q < 4; ++q) if (4 * q + 3 > j) mq[j][q] = *(const LAS f32x4*)(MabT + j * 16 + 4 * q);
                float y[16];
#pragma unroll
                for (int j = 15; j >= 0; --j) {
                    float acc = (j == l15) ? 1.0f : 0.0f;
#pragma unroll
                    for (int i = j + 1; i < 16; ++i) acc += y[i] * mq[j < 15 ? j : 0][i >> 2][i & 3];
                    y[j] = acc;
                }
                if (g == 0) { u32x4 t0, t1; t0.x = pk2(y[0], y[1]); t0.y = pk2(y[2], y[3]); t0.z = pk2(y[4], y[5]); t0.w = pk2(y[6], y[7]); t1.x = pk2(y[8], y[9]); t1.y = pk2(y[10], y[11]); t1.z = pk2(y[12], y[13]); t1.w = pk2(y[14], y[15]);
                    *(LAS u32x4*)(Tm + l15 * 16) = t0; *(LAS u32x4*)(Tm + l15 * 16 + 8) = t1; }
            }
            asm volatile("s_waitcnt lgkmcnt(0)" ::: "memory");
            {
                const bool act = g < 2; const int fo = l15 * 16 + 8 * g;
                const bf16x8 fT = act ? *(const LAS bf16x8*)(Tm + fo) : z8, fMak = act ? *(const LAS bf16x8*)(Mak + fo) : z8, fMrb = act ? *(const LAS bf16x8*)(Mrb + fo) : z8, fMrk = act ? *(const LAS bf16x8*)(Mrk + fo) : z8;
                bf16x8 fV[4], fQ1[4], fAh[4], fBT[4], fKT[4];
#pragma unroll
                for (int vt = 0; vt < 4; ++vt) { fV[vt] = act ? *(const LAS bf16x8*)(VTt + vt * 256 + fo) : z8; fBT[vt] = act ? *(const LAS bf16x8*)(BTt + vt * 256 + fo) : z8; fKT[vt] = act ? *(const LAS bf16x8*)(KTt + vt * 256 + fo) : z8; }
#pragma unroll
                for (int vt = 0; vt < 4; ++vt) { const f32x4 q0 = __builtin_amdgcn_mfma_f32_16x16x32_bf16(fMak, fV[vt], z4, 0, 0, 0);
                    u32x2 w; w.x = pk2(q0[0], q0[1]); w.y = pk2(q0[2], q0[3]); *(LAS u32x2*)(Q0T + vt * 256 + l15 * 16 + 4 * g) = w; }
#pragma unroll
                for (int kt = 0; kt < 4; ++kt) { const bf16x8 fA = act ? *(const LAS bf16x8*)(ATt + kt * 256 + fo) : z8; const f32x4 ah = __builtin_amdgcn_mfma_f32_16x16x32_bf16(fT, fA, z4, 0, 0, 0);
                    u32x2 w; w.x = pk2(ah[0], ah[1]); w.y = pk2(ah[2], ah[3]); *(LAS u32x2*)(ATt + kt * 256 + l15 * 16 + 4 * g) = w; }
                asm volatile("s_waitcnt lgkmcnt(0)" ::: "memory");
#pragma unroll
                for (int vt = 0; vt < 4; ++vt) { const bf16x8 fQ0 = act ? *(const LAS bf16x8*)(Q0T + vt * 256 + fo) : z8; const f32x4 q1 = __builtin_amdgcn_mfma_f32_16x16x32_bf16(fT, fQ0, z4, 0, 0, 0);
                    u32x2 w; w.x = pk2(q1[0], q1[1]); w.y = pk2(q1[2], q1[3]); *(LAS u32x2*)(Q0T + vt * 256 + l15 * 16 + 4 * g) = w; }
                asm volatile("s_waitcnt lgkmcnt(0)" ::: "memory");
#pragma unroll
                for (int vt = 0; vt < 4; ++vt) { fQ1[vt] = act ? *(const LAS bf16x8*)(Q0T + vt * 256 + fo) : z8; fAh[vt] = act ? *(const LAS bf16x8*)(ATt + vt * 256 + fo) : z8; }
                bf16* rp = (bf16*)(ws + WS_RP) + (size_t)un * 1024 + l15 * 64;
#pragma unroll
                for (int kt = 0; kt < 4; ++kt) {
                    const u32x2 rr = *(const LAS u32x2*)(Rrm + l15 * 64 + 8 * ((2 * kt + (g >> 1)) ^ (l15 & 7)) + 4 * (g & 1));
                    f32x4 ini; ini[0] = bflo(rr.x); ini[1] = bfhi(rr.x); ini[2] = bflo(rr.y); ini[3] = bfhi(rr.y);
                    const f32x4 rh = __builtin_amdgcn_mfma_f32_16x16x32_bf16(fAh[kt], fMrb, ini, 0, 0, 0);
                    u32x2 w; w.x = pk2(rh[0], rh[1]); w.y = pk2(rh[2], rh[3]); *(u32x2*)(rp + 32 * (kt >> 1) + 8 * g + 4 * (kt & 1)) = w;
                }
#pragma unroll
                for (int vt = 0; vt < 4; ++vt) { f32x4 y1 = __builtin_amdgcn_mfma_f32_16x16x32_bf16(fMrb, fQ1[vt], z4, 0, 0, 0); y1 = __builtin_amdgcn_mfma_f32_16x16x32_bf16(fMrk, fV[vt], y1, 0, 0, 0);
                    *(f32x4*)((float*)(ws + WS_Y1F) + ((size_t)(un * 4 + vt) * 64 + lane) * 4) = y1; }
                LAS bf16* tgs = (LAS bf16*)(wl + 8192);
#pragma unroll
                for (int krt = 0; krt < 4; ++krt) { const float pl = PLs[16 * krt + l15];
#pragma unroll
                    for (int kct = 0; kct < 4; ++kct) { f32x4 ga = __builtin_amdgcn_mfma_f32_16x16x32_bf16(fAh[kct], fBT[krt], z4, 0, 0, 0);
                        if (kct == krt) {
#pragma unroll
                            for (int e = 0; e < 4; ++e) if (4 * g + e == l15) ga[e] += 1.0f; }
                        u32x2 w; w.x = pk2(ga[0] * pl, ga[1] * pl); w.y = pk2(ga[2] * pl, ga[3] * pl);
                        *(LAS u32x2*)(tgs + (16 * krt + l15) * 64 + 32 * (kct >> 1) + 8 * g + 4 * (kct & 1)) = w; } }
                { u32x4* gp16 = (u32x4*)((bf16*)(ws + WS_GP) + (size_t)un * 4096);
#pragma unroll
                  for (int i = 0; i < 8; ++i) gp16[i * 64 + lane] = *(const LAS u32x4*)(tgs + (i * 64 + lane) * 8); }
#pragma unroll
                for (int mt = 0; mt < 4; ++mt) { const f32x4 pl4 = *(const LAS f32x4*)(PLs + 16 * mt + 4 * g);
#pragma unroll
                    for (int vt = 0; vt < 4; ++vt) { f32x4 ha = __builtin_amdgcn_mfma_f32_16x16x32_bf16(fBT[mt], fQ1[vt], z4, 0, 0, 0); ha = __builtin_amdgcn_mfma_f32_16x16x32_bf16(fKT[mt], fV[vt], ha, 0, 0, 0);
                        u32x2 w; w.x = pk2(ha[0] * pl4[0], ha[1] * pl4[1]); w.y = pk2(ha[2] * pl4[2], ha[3] * pl4[3]);
                        *(u32x2*)((bf16*)(ws + WS_HF) + ((size_t)((un * 4 + vt) * 4 + mt) * 64 + lane) * 4) = w; } }
            }
            asm volatile("s_waitcnt lgkmcnt(0)" ::: "memory");
        }
        asm volatile("s_waitcnt vmcnt(0)" ::: "memory");
        { const int ltid = fresh_tid() & 63, l15 = ltid & 15, g = ltid >> 4, lane = ltid;
#define CP_LOADG(gf_, j_) do { const bf16* gp_ = (const bf16*)(ws + WS_GP) + ((size_t)u64 * 4 + (j_)) * 4096 + l15 * 64 + 8 * g; \
            _Pragma("unroll") for (int mt = 0; mt < 4; ++mt) { gf_[mt][0] = *(const bf16x8*)(gp_ + mt * 1024); gf_[mt][1] = *(const bf16x8*)(gp_ + mt * 1024 + 32); } } while (0)
#define CP_LOADH(hf_, j_) do { _Pragma("unroll") for (int sl = 0; sl < 4; ++sl) _Pragma("unroll") for (int mt = 0; mt < 4; ++mt) \
            hf_[sl][mt] = *(const u32x2*)((const bf16*)(ws + WS_HF) + ((size_t)((((size_t)u64 * 4 + (j_)) * 4 + sl) * 4 + mt) * 64 + lane) * 4); } while (0)
#define CP_STEP(gf_, hf_, useh_) do { _Pragma("unroll") for (int sl = 0; sl < 4; ++sl) { bf16x8 zb[2]; RW_ZB(z[sl], zb); \
            _Pragma("unroll") for (int mt = 0; mt < 4; ++mt) { f32x4 a_ = (f32x4){0.f, 0.f, 0.f, 0.f}; \
                if (useh_) { a_[0] = bflo(hf_[sl][mt].x); a_[1] = bfhi(hf_[sl][mt].x); a_[2] = bflo(hf_[sl][mt].y); a_[3] = bfhi(hf_[sl][mt].y); } \
                a_ = __builtin_amdgcn_mfma_f32_16x16x32_bf16(gf_[mt][0], zb[0], a_, 0, 0, 0); a_ = __builtin_amdgcn_mfma_f32_16x16x32_bf16(gf_[mt][1], zb[1], a_, 0, 0, 0); z[sl][mt] = a_; } } } while (0)
        {
            f32x4 z[4][4];
#pragma unroll
            for (int sl = 0; sl < 4; ++sl)
#pragma unroll
                for (int mt = 0; mt < 4; ++mt)
#pragma unroll
                    for (int e = 0; e < 4; ++e) z[sl][mt][e] = (sl == mt && 4 * g + e == l15) ? 1.0f : 0.0f;
            bf16x8 gA[4][2], gB[4][2]; u32x2 hdum[4][4];
            CP_LOADG(gA, 0); CP_LOADG(gB, 1);
            CP_STEP(gA, hdum, false); CP_LOADG(gA, 2);
            CP_STEP(gB, hdum, false); CP_LOADG(gB, 3);
            CP_STEP(gA, hdum, false);
            CP_STEP(gB, hdum, false);
            LAS bf16* tg = (LAS bf16*)(lds + wave * 16384);
#pragma unroll
            for (int sl = 0; sl < 4; ++sl) { const int pc = 32 * (sl >> 1) + 8 * (l15 >> 2) + 4 * (sl & 1) + (l15 & 3);
#pragma unroll
                for (int mt = 0; mt < 4; ++mt)
#pragma unroll
                    for (int e = 0; e < 4; ++e) tg[(16 * mt + 4 * g + e) * 64 + pc] = (bf16)f2bf(z[sl][mt][e]); }
            u32x4* gc = (u32x4*)((bf16*)(ws + WS_GC) + (size_t)u64 * 4096);
#pragma unroll
            for (int i = 0; i < 8; ++i) gc[i * 64 + lane] = *(const LAS u32x4*)(tg + (i * 64 + lane) * 8);
        }
        {
            f32x4 z[4][4];
#pragma unroll
            for (int sl = 0; sl < 4; ++sl)
#pragma unroll
                for (int mt = 0; mt < 4; ++mt) z[sl][mt] = (f32x4){0.f, 0.f, 0.f, 0.f};
            bf16x8 gA[4][2], gB[4][2]; u32x2 hA[4][4], hB[4][4];
            CP_LOADG(gA, 0); CP_LOADH(hA, 0); CP_LOADG(gB, 1); CP_LOADH(hB, 1);
            CP_STEP(gA, hA, true); CP_LOADG(gA, 2); CP_LOADH(hA, 2);
            CP_STEP(gB, hB, true); CP_LOADG(gB, 3); CP_LOADH(hB, 3);
            CP_STEP(gA, hA, true);
            CP_STEP(gB, hB, true);
#pragma unroll
            for (int sl = 0; sl < 4; ++sl)
#pragma unroll
                for (int mt = 0; mt < 4; ++mt) { u32x2 w; w.x = pk2(z[sl][mt][0], z[sl][mt][1]); w.y = pk2(z[sl][mt][2], z[sl][mt][3]);
                    *(u32x2*)((bf16*)(ws + WS_HC) + ((size_t)((u64 * 4 + sl) * 4 + mt) * 64 + lane) * 4) = w; }
        }
#undef CP_LOADG
#undef CP_LOADH
#undef CP_STEP
        }
        }
    }
    SEAM(3);


    if (IN(4)) { PHASE_IDS;
        if (!(bid < 128 && wave == 0)) {
            const int wi = bid < 128 ? bid * 7 + (wave - 1) : 896 + (bid - 128) * 8 + wave, NW = 896 + (G - 128) * 8;
        } else {
            const int l15 = lane & 15, g = lane >> 4, bh = bid >> 2, vs = bid & 3;
            f32x4 z[4];
#pragma unroll
            for (int mt = 0; mt < 4; ++mt) z[mt] = (f32x4){0.f, 0.f, 0.f, 0.f};
            bf16x8 gA[4][2], gB[4][2], gC[4][2], gD[4][2]; u32x2 hA[4], hB[4], hC[4], hD[4];
#define SC_LOAD(gf, hf, C) do { const size_t u64_ = (size_t)bh * 64 + (C); const bf16* gp_ = (const bf16*)(ws + WS_GC) + u64_ * 4096 + l15 * 64 + 8 * g; \
                _Pragma("unroll") for (int mt = 0; mt < 4; ++mt) { gf[mt][0] = *(const bf16x8*)(gp_ + mt * 1024); gf[mt][1] = *(const bf16x8*)(gp_ + mt * 1024 + 32); \
                    hf[mt] = *(const u32x2*)((const bf16*)(ws + WS_HC) + ((size_t)((u64_ * 4 + vs) * 4 + mt) * 64 + lane) * 4); } } while (0)
#define SC_STEP(gf, hf, C) do { const size_t u64_ = (size_t)bh * 64 + (C); bf16* zs_ = (bf16*)(ws + WS_ZS) + ((size_t)((u64_ * 4 + vs) * 4) * 64 + lane) * 4; \
                _Pragma("unroll") for (int mt = 0; mt < 4; ++mt) { u32x2 zw_; zw_.x = pk2(z[mt][0], z[mt][1]); zw_.y = pk2(z[mt][2], z[mt][3]); *(u32x2*)(zs_ + mt * 256) = zw_; } \
                bf16x8 zb[2]; RW_ZB(z, zb); \
                _Pragma("unroll") for (int mt = 0; mt < 4; ++mt) { f32x4 a; a[0] = bflo(hf[mt].x); a[1] = bfhi(hf[mt].x); a[2] = bflo(hf[mt].y); a[3] = bfhi(hf[mt].y); \
                    a = __builtin_amdgcn_mfma_f32_16x16x32_bf16(gf[mt][0], zb[0], a, 0, 0, 0); a = __builtin_amdgcn_mfma_f32_16x16x32_bf16(gf[mt][1], zb[1], a, 0, 0, 0); z[mt] = a; } } while (0)
            SC_LOAD(gA, hA, 0); SC_LOAD(gB, hB, 1); SC_LOAD(gC, hC, 2);
#pragma unroll 1
            for (int C = 0; C < 64; C += 4) {
                SC_LOAD(gD, hD, C + 3);
                SC_STEP(gA, hA, C);
                if (C + 4 < 64) SC_LOAD(gA, hA, C + 4);
                SC_STEP(gB, hB, C + 1);
                if (C + 5 < 64) SC_LOAD(gB, hB, C + 5);
                SC_STEP(gC, hC, C + 2);
                if (C + 6 < 64) SC_LOAD(gC, hC, C + 6);
                SC_STEP(gD, hD, C + 3);
            }
#undef SC_LOAD
#undef SC_STEP
        }
    }
    if (IN(4)) { PHASE_IDS;
        if (bid < 32 && wave == 1) { const int bc = bid; const f32x2* ag = (const f32x2*)((const float*)(ws + WS_AP)) + (size_t)(bc * 64) * 64 + lane;
            float* car = (float*)(ws + WS_AP + 4 * MiB) + (size_t)(bc * 64) * 64 + lane; float hst = 0.f;
#pragma unroll 16
            for (int sg = 0; sg < 64; ++sg) { const f32x2 ab = ag[(size_t)sg * 64]; car[(size_t)sg * 64] = hst; hst = ab.x * hst + ab.y; } }
    }
    if (IN(4)) { PHASE_IDS;
        bf16* WKt = HN; bf16* VWt = HN + (size_t)4 * 1024 * 1024;
        __syncthreads();
        if (bid >= 128 && bid < 192) { pg8::FoldSched<0> S; S.A = (const char*)KM; S.B = (const char*)Wq_t; S.G = 64; S.c = bid - 128; EpiFold<0> E{(unsigned char*)WKt}; pg8::gemm_phase(lds, 256, S, E, wv0, 1024); }
        else if (bid >= 192) { pg8::FoldSched<1> S; S.A = (const char*)Wo_t; S.B = (const char*)VT; S.G = 64; S.c = bid - 192; EpiFold<1> E{(unsigned char*)VWt}; pg8::gemm_phase(lds, 256, S, E, wv0, 1024); }
    }
    SEAM(4);

    if (IN(5)) { PHASE_IDS;
        {
            for (int lu = gw; lu < (M / 64) * 8; lu += NGW) {
                const int seg = lu >> 3, nb = lu & 7, rr = lane >> 3, cq = lane & 7;
                const float* cp = (const float*)(ws + WS_AP + 4 * MiB) + ((size_t)(((seg >> 6) * 8 + nb) * 64 + (seg & 63)) * 64 + 8 * cq);
                const f32x4 c0 = *(const f32x4*)cp, c1 = *(const f32x4*)(cp + 4);
#pragma unroll
                for (int it = 0; it < 8; ++it) { const size_t m = (size_t)seg * 64 + 8 * it + rr; const size_t o = m * 512 + nb * 64 + 8 * cq;
                    const u32x4 pw = __builtin_nontemporal_load((const u32x4*)(LA + o)), hw = __builtin_nontemporal_load((const u32x4*)(LB + o)), gw_ = __builtin_nontemporal_load((const u32x4*)(U + m * INW + 512 + nb * 64 + 8 * cq));
                    float y[8];
#pragma unroll
                    for (int q = 0; q < 4; ++q) { const float ca = q < 2 ? c0[2 * q] : c1[2 * q - 4], cb = q < 2 ? c0[2 * q + 1] : c1[2 * q - 3];
                        y[2 * q] = (bflo(hw[q]) + bflo(pw[q]) * ca) * gelu_tanh_f(bflo(gw_[q])); y[2 * q + 1] = (bfhi(hw[q]) + bfhi(pw[q]) * cb) * gelu_tanh_f(bfhi(gw_[q])); }
                    u32x4 w; w.x = pk2(y[0], y[1]); w.y = pk2(y[2], y[3]); w.z = pk2(y[4], y[5]); w.w = pk2(y[6], y[7]);
                    *(u32x4*)(CAT + m * 1024 + nb * 64 + 8 * cq) = w; }
            }
        }
        const int l15 = lane & 15, g = lane >> 4;
        LAS bf16* tGL = (LAS bf16*)(lds + wave * 16384); LAS bf16* tAD = tGL + 1024; LAS bf16* tOUT = tGL + 2048;
        const int ct = lane >> 3, cc = lane & 7;
        for (int u64 = gw; u64 < NB * NH * (SEQ / 64); u64 += NGW) {
            const int bh = u64 >> 6, C = u64 & 63, b = bh >> 3, h = bh & 7;
            f32x4 z[4][4];
#pragma unroll
            for (int sl = 0; sl < 4; ++sl)
#pragma unroll
                for (int mt = 0; mt < 4; ++mt) { const u32x2 zw = *(const u32x2*)((const bf16*)(ws + WS_ZS) + ((size_t)((u64 * 4 + sl) * 4 + mt) * 64 + lane) * 4); z[sl][mt] = (f32x4){bflo(zw.x), bfhi(zw.x), bflo(zw.y), bfhi(zw.y)}; }
#pragma unroll 1
            for (int j = 0; j < 4; ++j) {
                const size_t un = (size_t)u64 * 4 + j; const size_t m0 = (size_t)b * SEQ + (C * 4 + j) * 16;
                const bf16* rp = (const bf16*)(ws + WS_RP) + un * 1024 + l15 * 64 + 8 * g;
                const bf16x8 rf0 = __builtin_nontemporal_load((const bf16x8*)rp), rf1 = __builtin_nontemporal_load((const bf16x8*)(rp + 32));
                f32x4 y[4];
#pragma unroll
                for (int sl = 0; sl < 4; ++sl) y[sl] = __builtin_nontemporal_load((const f32x4*)((const float*)(ws + WS_Y1F) + ((size_t)(un * 4 + sl) * 64 + lane) * 4));
                const size_t rg = (m0 + ct) * 512 + h * 64 + 8 * cc;
                const u32x4 gl0 = __builtin_nontemporal_load((const u32x4*)((const bf16*)(ws + WS_G) + rg)), gl1 = __builtin_nontemporal_load((const u32x4*)((const bf16*)(ws + WS_G) + rg + 8 * 512));
                const u32x4 ad0 = __builtin_nontemporal_load((const u32x4*)((const bf16*)(ws + WS_ADD) + rg)), ad1 = __builtin_nontemporal_load((const u32x4*)((const bf16*)(ws + WS_ADD) + rg + 8 * 512));
                bf16x8 gf[4][2]; u32x2 hfr[4][4];
                if (j < 3) {
                    const bf16* gp = (const bf16*)(ws + WS_GP) + un * 4096 + l15 * 64 + 8 * g;
#pragma unroll
                    for (int mt = 0; mt < 4; ++mt) { gf[mt][0] = __builtin_nontemporal_load((const bf16x8*)(gp + mt * 1024)); gf[mt][1] = __builtin_nontemporal_load((const bf16x8*)(gp + mt * 1024 + 32)); }
#pragma unroll
                    for (int sl = 0; sl < 4; ++sl)
#pragma unroll
                        for (int mt = 0; mt < 4; ++mt) hfr[sl][mt] = __builtin_nontemporal_load((const u32x2*)((const bf16*)(ws + WS_HF) + ((size_t)((un * 4 + sl) * 4 + mt) * 64 + lane) * 4));
                }
                *(LAS u32x4*)(tGL + ct * 64 + 8 * cc) = gl0; *(LAS u32x4*)(tGL + (ct + 8) * 64 + 8 * cc) = gl1;
                *(LAS u32x4*)(tAD + ct * 64 + 8 * cc) = ad0; *(LAS u32x4*)(tAD + (ct + 8) * 64 + 8 * cc) = ad1;
                bf16x8 zb[4][2];
#pragma unroll
                for (int sl = 0; sl < 4; ++sl) { RW_ZB(z[sl], zb[sl]);
                    y[sl] = __builtin_amdgcn_mfma_f32_16x16x32_bf16(rf0, zb[sl][0], y[sl], 0, 0, 0); y[sl] = __builtin_amdgcn_mfma_f32_16x16x32_bf16(rf1, zb[sl][1], y[sl], 0, 0, 0); }
#pragma unroll
                for (int e = 0; e < 4; ++e) {
                    float s1 = (y[0][e] + y[1][e]) + (y[2][e] + y[3][e]);
                    s1 += __shfl_xor(s1, 1); s1 += __shfl_xor(s1, 2); s1 += __shfl_xor(s1, 4); s1 += __shfl_xor(s1, 8);
                    const float mean = s1 * (1.0f / 64.0f);
                    float d0 = y[0][e] - mean, d1 = y[1][e] - mean, d2 = y[2][e] - mean, d3 = y[3][e] - mean;
                    float s2 = (d0 * d0 + d1 * d1) + (d2 * d2 + d3 * d3);
                    s2 += __shfl_xor(s2, 1); s2 += __shfl_xor(s2, 2); s2 += __shfl_xor(s2, 4); s2 += __shfl_xor(s2, 8);
                    const float rstd = rsq_f(s2 * (1.0f / 64.0f) + GN_EPS);
                    const float dd[4] = {d0, d1, d2, d3};
#pragma unroll
                    for (int sl = 0; sl < 4; ++sl) { const int ti_ = (4 * g + e) * 64 + 16 * sl + l15;
                        const float o = dd[sl] * rstd * bf2f(tGL[ti_]) + bf2f(tAD[ti_]); tOUT[ti_] = (bf16)f2bf(o); }
                }
                { bf16* cp = CAT + (m0 + ct) * 1024 + 512 + h * 64 + 8 * cc;
                  *(u32x4*)cp = *(const LAS u32x4*)(tOUT + ct * 64 + 8 * cc); *(u32x4*)(cp + 8 * 1024) = *(const LAS u32x4*)(tOUT + (ct + 8) * 64 + 8 * cc); }
                if (j < 3) {
#pragma unroll
                    for (int sl = 0; sl < 4; ++sl)
#pragma unroll
                        for (int mt = 0; mt < 4; ++mt) { const u32x2 hh = hfr[sl][mt];
                            f32x4 a; a[0] = bflo(hh.x); a[1] = bfhi(hh.x); a[2] = bflo(hh.y); a[3] = bfhi(hh.y);
                            a = __builtin_amdgcn_mfma_f32_16x16x32_bf16(gf[mt][0], zb[sl][0], a, 0, 0, 0); a = __builtin_amdgcn_mfma_f32_16x16x32_bf16(gf[mt][1], zb[sl][1], a, 0, 0, 0); z[sl][mt] = a; }
                }
            }
        }
    }
    SEAM(5);
#undef RW_ZB


    if (IN(6)) { PHASE_IDS;
        pg8::DenseSched S; S.o.init_tiles(M / 256, D / 256, G, bid); S.A = (const char*)CAT; S.B = (const char*)Wout_t; S.tstep = (size_t)256 * D * 2;
        EpiBf16Res<false> E{args.in[I_X], X1, D, (float*)(ws + WS_AP + 2 * MiB), 1.0f, X1F8}; pg8::gemm_phase(lds, D, S, E, wv0);
    }
    SEAM(6);
    if (IN(7)) { PHASE_IDS;
        pg8::BatchBSched S; S.o.init_tiles(M / 256, D / 256, G, bid); S.A = (const char*)X1F8; S.B = (const char*)HN; S.tstep = (size_t)256 * 1024; S.bstep = (size_t)1024 * 1024;
        EpiSoftmax E{(unsigned char*)Qb, 0.0625f * 0.25f, (const float*)(ws + WS_AP + 2 * MiB), (LAS float*)(lds + RING_BYTES + 1024), (LAS float*)(lds + RING_BYTES + 1024 + 4096)};
        pg8::gemm_phase<EpiSoftmax, pg8::BatchBSched, true, true>(lds, 512, S, E, wv0);
    }
    SEAM(7);
    if (IN(8)) { PHASE_IDS;
        pg8::BatchBSched S; S.o.init_tiles(M / 256, D / 256, G, bid); S.A = (const char*)Qb; S.B = (const char*)(HN + (size_t)4 * 1024 * 1024); S.tstep = (size_t)256 * 1024; S.bstep = (size_t)1024 * 1024;
        EpiBf16Res<true> E{X1, X2, D, nullptr, 1.0f / 1024.0f, nullptr}; pg8::gemm_phase<EpiBf16Res<true>, pg8::BatchBSched, true, true>(lds, 512, S, E, wv0);
    }
    SEAM(8);
    if (IN(9)) { PHASE_IDS;
        for (int cid = tid; cid < 2 * NE * 128; cid += NTHREADS) { const int t = cid >> 12, row = (cid >> 7) & 31, c = cid & 127;
            *(LAS u32x4*)(lds + t * 65536 + row * 2048 + ((c ^ (row & 7)) << 4)) = *(const u32x4*)(WrT + (size_t)t * NE * D + row * D + 8 * c); }
        __syncthreads();
        const int l15 = lane & 15, g = lane >> 4;
        LAS float* LG = (LAS float*)(lds + RING_BYTES + 1024 + wave * 2304);
        const float* gfn = args.in[I_NFFG];
        LAS unsigned* cntl = (LAS unsigned*)(lds + RING_BYTES + 640);
        for (int t0 = 0; t0 < M / 16; t0 += G * 4) {
        if (tid < 64) cntl[tid] = 0u;
        __syncthreads();
        if (t0 == 0 && wave >= 4) {
            constexpr int I_DN = 16 * 32, I_GU = 16 * 64;
            for (int r = bid * 4 + (wave - 4); r < CONV_P9; r += G * 4) { const int e = r / I_GU, q = r % I_GU, kb = q / 64, nb = q % 64; const int n0 = 32 * nb;
                const int drow = n0 < 1024 ? (256 * (n0 >> 7) + (n0 & 127)) : (256 * ((n0 - 1024) >> 7) + 128 + ((n0 - 1024) & 127));
                transpose_item_tiled_fp8_nolds(args.in[I_WGU] + (size_t)e * D * 2048, 2048, D, (unsigned char*)Wgu_t + (size_t)e * 2048 * D, 64 * kb, n0, drow, lane); }
            for (int r = bid * 4 + (wave - 4); r < CONV_P9D; r += G * 4) { const int e = r / I_DN, q = r % I_DN, kb = q / 32, nb = q % 32;
                transpose_item_tiled_fp8_nolds(args.in[I_WDN] + (size_t)e * DFF * D, D, DFF, (unsigned char*)Wdn_t + (size_t)e * D * DFF, 64 * kb, 32 * nb, 32 * nb, lane); }
        }
        const int tile = t0 + bid * 4 + wave; const bool active = wave < 4 && tile < M / 16;
        int me = 0, lpos = 0, ai = 0; float mg = 0.f;
        if (active) {
            const int m0 = tile * 16;
            const bf16* xrow = X2 + (size_t)(m0 + l15) * D + 8 * g;
            float ss = 0.f;
#pragma unroll 8
            for (int ks = 0; ks < 32; ++ks) { const u32x4 xw = *(const u32x4*)(xrow + 32 * ks);
#pragma unroll
                for (int q = 0; q < 4; ++q) { const float a = bflo(xw[q]), c = bfhi(xw[q]); ss += a * a + c * c; } }
            ss += __shfl_xor(ss, 16); ss += __shfl_xor(ss, 32);
            const float rstd = rsq_f(ss * (1.f / D) + EPS);
            f32x4 acc0 = (f32x4){0.f, 0.f, 0.f, 0.f}, acc1 = acc0;
            unsigned char* hrow = (unsigned char*)HN + (size_t)(m0 + l15) * D + 8 * g;
#pragma unroll 2
            for (int ks = 0; ks < 32; ++ks) {
                const f32x4 g0 = *(const f32x4*)(gfn + 32 * ks + 8 * g), g1 = *(const f32x4*)(gfn + 32 * ks + 8 * g + 4);
                const u32x4 xw = *(const u32x4*)(xrow + 32 * ks);
                float hf[8];
#pragma unroll
                for (int q = 0; q < 4; ++q) { hf[2 * q] = bflo(xw[q]) * rstd * (q < 2 ? g0[2 * q] : g1[2 * q - 4]); hf[2 * q + 1] = bfhi(xw[q]) * rstd * (q < 2 ? g0[2 * q + 1] : g1[2 * q - 3]); }
                u32x4 hi, lo;
#pragma unroll
                for (int q = 0; q < 4; ++q) { hi[q] = pk2(hf[2 * q], hf[2 * q + 1]); lo[q] = pk2(hf[2 * q] - bflo(hi[q]), hf[2 * q + 1] - bfhi(hi[q])); }
                { u32x2 h8; h8.x = pk4_fp8(hf[0], hf[1], hf[2], hf[3]); h8.y = pk4_fp8(hf[4], hf[5], hf[6], hf[7]); *(u32x2*)(hrow + 32 * ks) = h8; }
                const bf16x8 ah = __builtin_bit_cast(bf16x8, hi), al = __builtin_bit_cast(bf16x8, lo);
                const int c = 4 * ks + g;
#pragma unroll
                for (int nt = 0; nt < 2; ++nt) { const int row = 16 * nt + l15; const int off = row * 2048 + ((c ^ (row & 7)) << 4);
                    const bf16x8 bh = *(const LAS bf16x8*)(lds + off), bl = *(const LAS bf16x8*)(lds + 65536 + off);
                    f32x4 a = nt ? acc1 : acc0;
                    a = __builtin_amdgcn_mfma_f32_16x16x32_bf16(ah, bh, a, 0, 0, 0); a = __builtin_amdgcn_mfma_f32_16x16x32_bf16(ah, bl, a, 0, 0, 0); a = __builtin_amdgcn_mfma_f32_16x16x32_bf16(al, bh, a, 0, 0, 0);
                    if (nt) acc1 = a; else acc0 = a; }
            }
            { const float b0 = args.in[I_BR][l15], b1 = args.in[I_BR][16 + l15];
#pragma unroll
              for (int j = 0; j < 4; ++j) { LG[(4 * g + j) * 33 + l15] = acc0[j] + b0; LG[(4 * g + j) * 33 + 16 + l15] = acc1[j] + b1; } }
            const int rrow = lane >> 2, qq = lane & 3;
            float tv[4] = {-3.0e38f, -3.0e38f, -3.0e38f, -3.0e38f}; int ti[4] = {64, 65, 66, 67};
#define TOP_INS(xv_, xi_) do { float x_ = (xv_); int i_ = (xi_); _Pragma("unroll") for (int p_ = 0; p_ < 4; ++p_) { const bool b_ = x_ > tv[p_] || (x_ == tv[p_] && i_ < ti[p_]); \
                const float ov_ = tv[p_]; const int oi_ = ti[p_]; tv[p_] = b_ ? x_ : ov_; ti[p_] = b_ ? i_ : oi_; x_ = b_ ? ov_ : x_; i_ = b_ ? oi_ : i_; } } while (0)
#pragma unroll
            for (int j = 0; j < 8; ++j) TOP_INS(LG[rrow * 33 + 8 * qq + j], 8 * qq + j);
#pragma unroll
            for (int st = 1; st < 4; st <<= 1) { float pv[4]; int pi[4];
#pragma unroll
                for (int p = 0; p < 4; ++p) { pv[p] = __shfl_xor(tv[p], st); pi[p] = __shfl_xor(ti[p], st); }
#pragma unroll
                for (int p = 0; p < 4; ++p) TOP_INS(pv[p], pi[p]); }
#undef TOP_INS
            const float e1 = __expf(tv[1] - tv[0]), e2 = __expf(tv[2] - tv[0]), e3 = __expf(tv[3] - tv[0]);
            const float inv = rcp_f(1.0f + e1 + e2 + e3);
            me = qq == 0 ? ti[0] : qq == 1 ? ti[1] : qq == 2 ? ti[2] : ti[3];
            mg = (qq == 0 ? 1.0f : qq == 1 ? e1 : qq == 2 ? e2 : e3) * inv;
            lpos = (int)__hip_atomic_fetch_add(cntl + me, 1u, __ATOMIC_RELAXED, __HIP_MEMORY_SCOPE_WORKGROUP);
            ai = (m0 + rrow) * 4 + qq;
        }
        __syncthreads();
        if (tid < NE) { const unsigned c = cntl[tid]; cntl[32 + tid] = c ? atomicAdd(ecnt + 64 * tid, c) : 0u; }
        __syncthreads();
        if (active) { route_e[ai] = me; route_pos[ai] = (int)cntl[32 + me] + lpos; route_g[ai] = mg; }
        __syncthreads();
        }
    }
    SEAM(9);
    if (IN(10)) { PHASE_IDS;
        LAS int* pst = (LAS int*)lds;
        if (wave == 0) {
            const int c = lane < NE ? (int)__hip_atomic_load(ecnt + 64 * lane, __ATOMIC_RELAXED, __HIP_MEMORY_SCOPE_AGENT) : 0; const int pc = (c + 255) & ~255;
            int x = pc;
#pragma unroll
            for (int d = 1; d < 32; d <<= 1) { const int y = __shfl_up(x, d); if (lane >= d) x += y; }
            if (lane < NE) { pst[lane] = x - pc; pst[64 + lane] = c; } if (lane == NE - 1) pst[32] = x; }
        __syncthreads();
        for (int ai = bid * NTHREADS + tid; ai < NASSIGN; ai += G * NTHREADS) {
            const int e = route_e[ai]; const int row = pst[e] + route_pos[ai]; { u32x2 sg_; sg_.x = (unsigned)ai; sg_.y = __float_as_uint(route_g[ai]); row_sg[row] = sg_; } row_tok[row] = ai >> 2; }
        if (bid < NE) { const int e = bid, c = pst[64 + e], pe = (c + 255) & ~255; for (int p = c + tid; p < pe; p += NTHREADS) { u32x2 sg_; sg_.x = 0xffffffffu; sg_.y = 0u; row_sg[pst[e] + p] = sg_; row_tok[pst[e] + p] = 0; } }
        if (bid == 0 && tid == 0) tile_tab[0] = pst[32] >> 8;
        if (bid >= 128 && bid < 136) { const int nt = pst[32] >> 8, nN = bid < 132 ? 8 : 4; int* tab = (int*)(ws + WS_ROUTE + (bid < 132 ? RT_UGU : RT_UDN));
            for (int L = (bid & 3) * NTHREADS + tid; L < nt * nN; L += 4 * NTHREADS) { Unit uu; { const int nwg = nt * nN; int wgid = L; { const int q = nwg / 8, r = nwg % 8, xcd = wgid % 8, off = wgid / 8; wgid = (xcd < r ? xcd * (q + 1) : r * (q + 1) + (xcd - r) * q) + off; }
                    const int nig = 8 * nN, gid = wgid / nig, fm = gid * 8, gsz = (nt - fm) < 8 ? (nt - fm) : 8; uu.pm = fm + ((wgid % nig) % gsz); uu.pn = (wgid % nig) / gsz; uu.e = 0; }
                int e = 0;
#pragma unroll
                for (int st = 16; st >= 1; st >>= 1) { if ((pst[e + st] >> 8) <= uu.pm) e += st; }
                tab[L] = uu.pm | (uu.pn << 12) | (e << 16); } }
        __syncthreads();
    }
    SEAM(10);
    if (IN(11)) {
        const int ntiles = tile_tab[0];
        pg8::MoeGatherSched S; S.o.init_tiles(ntiles, 2048 / 256, G, bid); S.A = (const char*)HN; S.B = (const char*)Wgu_t; S.tile_e = tile_tab + 16; S.utab = (const int*)(ws + WS_ROUTE + RT_UGU); S.rtok = row_tok; S.tstep = (size_t)256 * 1024; S.estep = (size_t)2048 * 1024;
        EpiSwiglu E{ACT, args.in[I_BGU]}; pg8::gemm_phase<EpiSwiglu, pg8::MoeGatherSched, true, true>(lds, 512, S, E, wv0);
        { PHASE_IDS; LAS float* scr = (LAS float*)(lds + wave * 16384); constexpr int I_DN = 16 * 32;
          for (;;) { int c0 = 0; if (lane == 0) c0 = (int)atomicAdd(ctl + CW_CONV, 8u); c0 = __builtin_amdgcn_readfirstlane(c0);
              c0 += CONV_P9D; if (c0 >= NE * I_DN) break;
              for (int r = c0; r < c0 + 8; ++r) { const int e = r / I_DN, q = r % I_DN, kb = q / 32, nb = q % 32;
                  transpose_item_tiled_fp8(args.in[I_WDN] + (size_t)e * DFF * D, D, DFF, (unsigned char*)Wdn_t + (size_t)e * D * DFF, 64 * kb, 32 * nb, 32 * nb, scr, lane); } } }
    }
    SEAM(11);
    if (IN(12)) {
        const int ntiles = tile_tab[0];
        pg8::MoeSched S; S.o.init_tiles(ntiles, D / 256, G, bid); S.A = (const char*)ACT; S.B = (const char*)Wdn_t; S.tile_e = tile_tab + 16; S.utab = (const int*)(ws + WS_ROUTE + RT_UDN); S.tstep = (size_t)256 * 1024; S.estep = (size_t)1024 * 1024;
        EpiDown E{YS, args.in[I_BDN], row_sg}; pg8::gemm_phase<EpiDown, pg8::MoeSched, true, true>(lds, 512, S, E, wv0);
    }
    SEAM(12);
    if (IN(13)) { PHASE_IDS;
        const float* gfin = args.in[I_FNG];
        for (int m = gw; m < M; m += NGW) {
            float v[16]; float s = 0.f;
#pragma unroll
            for (int hf = 0; hf < 2; ++hf) { const u32x4 w = __builtin_nontemporal_load((const u32x4*)(X2 + (size_t)m * D + 512 * hf + 8 * lane));
#pragma unroll
                for (int q = 0; q < 4; ++q) { v[8 * hf + 2 * q] = bflo(w[q]); v[8 * hf + 2 * q + 1] = bfhi(w[q]); }
#pragma unroll
                for (int k = 0; k < 4; ++k) { const u32x2 y = __builtin_nontemporal_load((const u32x2*)((const unsigned char*)YS + (size_t)(m * 4 + k) * D + 512 * hf + 8 * lane));
#pragma unroll
                    for (int q = 0; q < 2; ++q) { const auto lo2 = __builtin_amdgcn_cvt_pk_f32_fp8((int)y[q], false), hi2 = __builtin_amdgcn_cvt_pk_f32_fp8((int)y[q], true);
                        v[8 * hf + 4 * q] += lo2[0] * 0.0625f; v[8 * hf + 4 * q + 1] += lo2[1] * 0.0625f; v[8 * hf + 4 * q + 2] += hi2[0] * 0.0625f; v[8 * hf + 4 * q + 3] += hi2[1] * 0.0625f; } } }
#pragma unroll
            for (int j = 0; j < 16; ++j) s += v[j] * v[j];
            const float rstd = rsq_f(wave_sum(s) * (1.f / D) + EPS);
#pragma unroll
            for (int hf = 0; hf < 2; ++hf) { const f32x4 g0 = *(const f32x4*)(gfin + 512 * hf + 8 * lane), g1 = *(const f32x4*)(gfin + 512 * hf + 8 * lane + 4);
                float* o = args.out + (size_t)m * D + 512 * hf + 8 * lane;
                __builtin_nontemporal_store((f32x4){v[8 * hf] * rstd * g0.x, v[8 * hf + 1] * rstd * g0.y, v[8 * hf + 2] * rstd * g0.z, v[8 * hf + 3] * rstd * g0.w}, (f32x4*)o);
                __builtin_nontemporal_store((f32x4){v[8 * hf + 4] * rstd * g1.x, v[8 * hf + 5] * rstd * g1.y, v[8 * hf + 6] * rstd * g1.z, v[8 * hf + 7] * rstd * g1.w}, (f32x4*)(o + 4)); }
        }
    }
#undef IN
#undef SEAM
}

constexpr int N_PHASES = 14;
extern "C" void kernel_launch(void* const* d_in, const int* in_sizes, int n_in, void* d_out, int out_size, void* d_ws, size_t ws_size, hipStream_t stream) {
    static int grid = 0;
    if (grid == 0) {
        if (n_in != 37 || out_size != M * D || ws_size < WS_END) { fprintf(stderr, "kernel_launch: unexpected shapes (n_in %d, out %d, ws %zu); nothing launched\n", n_in, out_size, ws_size); grid = -1; return; }
        int dev = 0, cus = 0, per_cu = 0;
        if (hipGetDevice(&dev) != hipSuccess || hipDeviceGetAttribute(&cus, hipDeviceAttributeMultiprocessorCount, dev) != hipSuccess) { grid = -1; return; }
        if (hipFuncSetAttribute((const void*)fwd, hipFuncAttributeMaxDynamicSharedMemorySize, LDS_BYTES) != hipSuccess) { fprintf(stderr, "kernel_launch: hipFuncSetAttribute failed\n"); grid = -1; return; }
        if (hipOccupancyMaxActiveBlocksPerMultiprocessor(&per_cu, (const void*)fwd, NTHREADS, LDS_BYTES) != hipSuccess || per_cu < 1) fprintf(stderr, "kernel_launch: occupancy query says %d\n", per_cu);
        (void)hipGetLastError();
        grid = cus > 256 ? 256 : cus;
    }
    if (grid < 0) return;
    if (hipMemsetAsync((char*)d_ws + WS_CTL, 0, CTL_ZERO_BYTES, stream) != hipSuccess) return;
    Args a{};
    for (int i = 0; i < 37; ++i) a.in[i] = (const float*)d_in[i];
    a.out = (float*)d_out; a.ws = (unsigned char*)d_ws;
#if MK_ONE_LAUNCH
    a.ph_lo = 0; a.ph_hi = N_PHASES;
    hipLaunchKernelGGL(fwd, dim3(grid), dim3(NTHREADS), LDS_BYTES, stream, a);
#else
    for (int p = 0; p < N_PHASES; ++p) { a.ph_lo = p; a.ph_hi = p + 1; hipLaunchKernelGGL(fwd, dim3(grid), dim3(NTHREADS), LDS_BYTES, stream, a);
#ifdef PROBE_REPEAT_PHASE
        if (p == PROBE_REPEAT_PHASE) hipLaunchKernelGGL(fwd, dim3(grid), dim3(NTHREADS), LDS_BYTES, stream, a);
#endif
    }
#endif
}
```

```cpp
#include <hip/hip_runtime.h>
#include <cstdio>
#include <cstdint>

#ifndef MK_ONE_LAUNCH
#define MK_ONE_LAUNCH 1
#endif

#define DI __device__ __forceinline__
#define GAS __attribute__((address_space(1)))
#define LAS __attribute__((address_space(3)))
typedef unsigned short bf16;
typedef short bf16x8 __attribute__((ext_vector_type(8)));
typedef int v4i __attribute__((ext_vector_type(4)));
typedef int v8i __attribute__((ext_vector_type(8)));
typedef float f32x4 __attribute__((ext_vector_type(4)));
typedef float f32x2 __attribute__((ext_vector_type(2)));
typedef unsigned u32x4 __attribute__((ext_vector_type(4)));
typedef unsigned u32x2 __attribute__((ext_vector_type(2)));

constexpr int D = 1024, NB = 4, SEQ = 4096, M = NB * SEQ;
constexpr int MEML = 256, MROWS = NB * MEML;
constexpr int LRU_W = 512, RW = 512, NH = 8, HD = 64;
constexpr int INW = 2816;
constexpr int XH = 4, XHD = 256;
constexpr int NE = 32, TOPK = 4, DFF = 1024;
constexpr int NASSIGN = M * TOPK;
constexpr int MAXTILES = 288, MAXROWS = MAXTILES * 256;
constexpr float EPS = 1e-6f, GN_EPS = 64e-5f;

DI int fresh_tid_(int wv) { int w = wv; asm volatile("" : "+s"(w)); int l; asm volatile("v_mbcnt_lo_u32_b32 %0, -1, 0\n\tv_mbcnt_hi_u32_b32 %0, -1, %0" : "=v"(l)); return (w << 6) | (l & 63); }
#define fresh_tid() fresh_tid_(wv0)
namespace pg8 {
constexpr int BM = 256, BK = 64, HALF = 128, HTB = HALF * BK * 2, STAGE_BYTES = 8 * HTB, NXCD = 8, WGM = 8;
__host__ __device__ __forceinline__ int lds_byte(int r, int c) { const int st = (r >> 4) * 2 + (c >> 5), rr = r & 15, cc = c & 31, ob = rr * 64 + cc * 2; return st * 1024 + (ob ^ (((ob >> 9) & 1) << 5)); }
__host__ __device__ __forceinline__ void stage_rc(int b, int& R, int& C) { const int st = b / 1024, sb = b % 1024, swz = sb ^ (((sb >> 9) & 1) << 5); R = (st >> 1) * 16 + swz / 64; C = (st & 1) * 32 + (swz % 64) / 2; }
__host__ __device__ __forceinline__ int perm32(int rho) { const int n = rho >> 4, i = rho & 15; return 8 * (i >> 2) + 4 * n + (i & 3); }

struct Unit { int pm, pn, e; };

struct StaticOrder {
    int nM, nN, nwg, G, c;
    __host__ __device__ void init_tiles(int nM_, int nN_, int G_, int c_) { nM = nM_; nN = nN_; nwg = nM * nN; G = G_; c = c_; }
    __host__ __device__ bool next(int i, Unit& u) const {
        const long L = (long)i * G + c; if (L >= nwg) return false;
        int wgid = (int)L; { const int q = nwg / NXCD, r = nwg % NXCD, xcd = wgid % NXCD, off = wgid / NXCD; wgid = (xcd < r ? xcd * (q + 1) : r * (q + 1) + (xcd - r) * q) + off; }
        const int nig = WGM * nN, gid = wgid / nig, fm = gid * WGM, gsz = (nM - fm) < WGM ? (nM - fm) : WGM;
        u.pm = fm + ((wgid % nig) % gsz); u.pn = (wgid % nig) / gsz; u.e = 0; return true;
    }
};
struct DenseSched {
    static constexpr bool GATHER = false, B_TILED = false;
    StaticOrder o; const char* A; const char* B; size_t tstep;
    DI bool next(int i, Unit& u) const { return o.next(i, u); }
    DI const char* a_ptr(const Unit& u) const { return A + (size_t)u.pm * tstep; }
    DI const char* b_ptr(const Unit& u) const { return B + (size_t)u.pn * tstep; }
    DI void a_voff(const Unit&, int K, const int (&R)[2], const int (&C)[2], unsigned (&vo)[2][2]) const {
#pragma unroll
        for (int h = 0; h < 2; ++h)
#pragma unroll
            for (int i = 0; i < 2; ++i) vo[h][i] = (unsigned)((h * HALF + R[i]) * K + C[i]) * 2u; }
};
struct MoeSched {
    static constexpr bool GATHER = false, B_TILED = true;
    StaticOrder o; const char* A; const char* B; const int* tile_e; const int* utab; size_t tstep, estep;
    DI bool next(int i, Unit& u) const { const int L = i * o.G + o.c; if (L >= o.nwg) return false; int en; asm volatile("s_load_dword %0, %1, 0x0\n\ts_waitcnt lgkmcnt(0)" : "=s"(en) : "s"(utab + L) : "memory");     u.pm = en & 0xfff; u.pn = (en >> 12) & 15; u.e = en >> 16; return true; }
    DI const char* a_ptr(const Unit& u) const { return A + (size_t)u.pm * tstep; }
    DI const char* b_ptr(const Unit& u) const { return B + (size_t)u.e * estep + (size_t)u.pn * tstep; }
    DI void a_voff(const Unit&, int K, const int (&R)[2], const int (&C)[2], unsigned (&vo)[2][2]) const {
#pragma unroll
        for (int h = 0; h < 2; ++h)
#pragma unroll
            for (int i = 0; i < 2; ++i) vo[h][i] = (unsigned)((h * HALF + R[i]) * K + C[i]) * 2u; }
};
struct MoeGatherSched {
    static constexpr bool GATHER = true, B_TILED = true;
    StaticOrder o; const char* A; const char* B; const int* tile_e; const int* utab; const int* rtok; size_t tstep, estep;
    DI bool next(int i, Unit& u) const { const int L = i * o.G + o.c; if (L >= o.nwg) return false; int en; asm volatile("s_load_dword %0, %1, 0x0\n\ts_waitcnt lgkmcnt(0)" : "=s"(en) : "s"(utab + L) : "memory");     u.pm = en & 0xfff; u.pn = (en >> 12) & 15; u.e = en >> 16; return true; }
    DI const char* a_ptr(const Unit&) const { return A; }
    DI const char* b_ptr(const Unit& u) const { return B + (size_t)u.e * estep + (size_t)u.pn * tstep; }
    DI void a_voff(const Unit& u, int K, const int (&R)[2], const int (&C)[2], unsigned (&vo)[2][2]) const {
#pragma unroll
        for (int h = 0; h < 2; ++h)
#pragma unroll
            for (int i = 0; i < 2; ++i) vo[h][i] = (unsigned)(rtok[u.pm * BM + h * HALF + R[i]] * K + C[i]) * 2u; }
};

struct BatchBSched {
    static constexpr bool GATHER = false, B_TILED = false;
    StaticOrder o; const char* A; const char* B; size_t tstep, bstep;
    DI bool next(int i, Unit& u) const { return o.next(i, u); }
    DI const char* a_ptr(const Unit& u) const { return A + (size_t)u.pm * tstep; }
    DI const char* b_ptr(const Unit& u) const { return B + (size_t)(u.pm >> 4) * bstep + (size_t)u.pn * tstep; }
    DI void a_voff(const Unit&, int K, const int (&R)[2], const int (&C)[2], unsigned (&vo)[2][2]) const {
#pragma unroll
        for (int h = 0; h < 2; ++h)
#pragma unroll
            for (int i = 0; i < 2; ++i) vo[h][i] = (unsigned)((h * HALF + R[i]) * K + C[i]) * 2u; }
};
template <int MODE> struct FoldSched {
    static constexpr bool GATHER = false, B_TILED = false;
    const char* A; const char* B; int G, c;
    DI bool next(int i, Unit& u) const { const int L = i * G + c; if (L >= 64) return false; u.pm = L >> 2; u.pn = L & 3; u.e = 0; return true; }
    DI const char* a_ptr(const Unit& u) const { const int b = u.pm >> 2, h = u.pm & 3; return A + ((size_t)(MODE == 0 ? b * 256 : u.pn * 256) * 1024 + h * 256) * 2; }
    DI const char* b_ptr(const Unit& u) const { const int b = u.pm >> 2, h = u.pm & 3; return B + ((size_t)(MODE == 0 ? u.pn * 256 : b * 256) * 1024 + h * 256) * 2; }
    DI void a_voff(const Unit&, int K, const int (&R)[2], const int (&C)[2], unsigned (&vo)[2][2]) const {
#pragma unroll
        for (int h = 0; h < 2; ++h)
#pragma unroll
            for (int i = 0; i < 2; ++i) vo[h][i] = (unsigned)((h * HALF + R[i]) * K + C[i]) * 2u; }
};

DI unsigned cvt_pk_bf16(float lo, float hi) { unsigned r; asm volatile("v_cvt_pk_bf16_f32 %0, %1, %2" : "=v"(r) : "v"(lo), "v"(hi)); return r; }

template <class Epi, class Sched, bool ALIGN_EPI = true, bool FP8 = false>
DI void gemm_phase(LAS unsigned char* lds, const int K, const Sched& S, const Epi& E, const int wv0, const int ldp = 0) {
    const int ld = ldp ? ldp : K;
    const int tid = fresh_tid(), wid = __builtin_amdgcn_readfirstlane(tid >> 6), lane = tid & 63, wr = wid >> 2, wc = wid & 3, fr = lane & 15, fq = lane >> 4;
    const int nt = K / BK;
    constexpr bool GA = Sched::GATHER, BT = Sched::B_TILED;
    unsigned voffA[2][2], voffAn[2][2], voffB[2];
#pragma unroll
    for (int i = 0; i < 2; ++i) { int R, C; stage_rc(tid * 16 + i * 8192, R, C); const int Rb = Epi::PERM ? ((R & ~31) + perm32(R & 31)) : R;
        voffB[i] = BT ? (unsigned)(tid * 16 + i * 8192) : (unsigned)(Rb * ld + C) * 2u; }
#define PG8_AVOFF(unit, dst) do { int sR[2], sC[2]; const int t2_ = fresh_tid(); stage_rc(t2_ * 16, sR[0], sC[0]); stage_rc(t2_ * 16 + 8192, sR[1], sC[1]); S.a_voff(unit, ld, sR, sC, dst); } while (0)
    const size_t kstep = (size_t)(BK * 2);
    const size_t hstep = (size_t)HALF * ld * 2;
    const size_t kstepB = BT ? (size_t)(2 * HTB) : kstep, hstepB = BT ? (size_t)HTB : hstep;
    const unsigned ldsw = (unsigned)wid * 1024u;
    unsigned aoffv = (unsigned)(size_t)lds + (unsigned)lds_byte(wr * 64 + fr, fq * 8), boffv = (unsigned)(size_t)lds + (unsigned)(4 * HTB) + (unsigned)lds_byte(wc * 32 + fr, fq * 8);
    asm volatile("" : "+v"(aoffv), "+v"(boffv));
    const size_t dB = BT ? (size_t)8192 : (size_t)64 * ld * 2, dA = (size_t)64 * ld * 2;
#define PG8_SA(b, h) (((b) * 2 + (h)) * HTB)
#define PG8_SB(b, h) ((4 + (b) * 2 + (h)) * HTB)
    const unsigned ldsbase = (unsigned)__builtin_amdgcn_readfirstlane((int)((unsigned)(size_t)lds + ldsw));
#define PG8_STAGE1(bufoff, gptr, vo, i_) do { const unsigned m0v_ = ldsbase + (unsigned)(bufoff) + (unsigned)(i_) * 8192u; \
        asm volatile("s_mov_b32 m0, %2\n\ts_nop 0\n\tglobal_load_lds_dwordx4 %0, %1" :: "v"(vo), "s"((const char*)(gptr)), "s"(m0v_) : "memory", "m0"); } while (0)
#define PG8_STAGE(bufoff, gbase, voff) do { PG8_STAGE1(bufoff, gbase, (voff)[0], 0); PG8_STAGE1(bufoff, gbase, (voff)[1], 1); } while (0)
#define PG8_STAGE_D(bufoff, gbase, vo, delta) do { PG8_STAGE1(bufoff, gbase, vo, 0); PG8_STAGE1(bufoff, (const char*)(gbase) + (delta), vo, 1); } while (0)
#define PG8_LDA(dst, b, h) do { if constexpr (FP8) { _Pragma("unroll") for (int m = 0; m < 4; ++m) { const LAS v4i* p_ = (const LAS v4i*)((LAS unsigned char*)(size_t)aoffv + PG8_SA(b, h) + m * 2048); dst##8[m] = __builtin_shufflevector(p_[0], p_[64], 0, 1, 2, 3, 4, 5, 6, 7); } } \
        else { _Pragma("unroll") for (int m = 0; m < 4; ++m) _Pragma("unroll") for (int k = 0; k < 2; ++k) dst[m][k] = *(const LAS bf16x8*)((LAS unsigned char*)(size_t)aoffv + PG8_SA(b, h) + m * 2048 + k * 1024); } } while (0)
#define PG8_LDB(dst, b, h) do { if constexpr (FP8) { _Pragma("unroll") for (int n = 0; n < 2; ++n) { const LAS v4i* p_ = (const LAS v4i*)((LAS unsigned char*)(size_t)boffv + (PG8_SB(b, h) - 4 * HTB) + n * 2048); dst##8[n] = __builtin_shufflevector(p_[0], p_[64], 0, 1, 2, 3, 4, 5, 6, 7); } } \
        else { _Pragma("unroll") for (int n = 0; n < 2; ++n) _Pragma("unroll") for (int k = 0; k < 2; ++k) dst[n][k] = *(const LAS bf16x8*)((LAS unsigned char*)(size_t)boffv + (PG8_SB(b, h) - 4 * HTB) + n * 2048 + k * 1024); } } while (0)
#define PG8_MMA(ai, bj, At, Bt) do { __builtin_amdgcn_s_setprio(1); \
        if constexpr (FP8) {   \
            _Pragma("unroll") for (int m = 0; m < 4; ++m) _Pragma("unroll") for (int n = 0; n < 2; ++n) \
                acc[ai][bj][m][n] = __builtin_amdgcn_mfma_scale_f32_16x16x128_f8f6f4(Bt##8[n], At##8[m], acc[ai][bj][m][n], 0, 0, 0, 0, 0, 0); } \
        else { _Pragma("unroll") for (int m = 0; m < 4; ++m) _Pragma("unroll") for (int n = 0; n < 2; ++n) _Pragma("unroll") for (int k = 0; k < 2; ++k) \
            acc[ai][bj][m][n] = __builtin_amdgcn_mfma_f32_16x16x32_bf16(Bt[n][k], At[m][k], acc[ai][bj][m][n], 0, 0, 0); } \
        __builtin_amdgcn_s_setprio(0); } while (0)
#define PG8_WAIT_V(n) asm volatile("s_waitcnt vmcnt(" #n ")" ::: "memory")
#define PG8_WAIT_L(n) asm volatile("s_waitcnt lgkmcnt(" #n ")" ::: "memory")
#define PG8_BAR __builtin_amdgcn_s_barrier()
#define PG8_SCHED __builtin_amdgcn_sched_barrier(0)
    Unit cur, nxt; int ui = 0;
    if (!S.next(0, cur)) return;
    f32x4 acc[2][2][4][2];
#pragma unroll
    for (int a = 0; a < 2; ++a)
#pragma unroll
        for (int b = 0; b < 2; ++b)
#pragma unroll
            for (int m = 0; m < 4; ++m)
#pragma unroll
                for (int n = 0; n < 2; ++n) acc[a][b][m][n] = (f32x4){0.f, 0.f, 0.f, 0.f};
    bf16x8 At[4][2], B0[2][2], B1[2][2]; v8i At8[4], B08[2], B18[2];
    const char* cA = S.a_ptr(cur); const char* cB = S.b_ptr(cur);
    PG8_AVOFF(cur, voffA);
#define PG8_STAGE_A(bufoff, kbase, h, vo) do { if constexpr (GA) { PG8_STAGE(bufoff, kbase, (vo)[h]); } else { PG8_STAGE_D(bufoff, (kbase) + (h) * hstep, voffA[0][0], dA); } } while (0)
    PG8_STAGE_D(PG8_SB(0, 0), cB, voffB[0], dB); PG8_STAGE_D(PG8_SB(0, 1), cB + hstepB, voffB[0], dB); PG8_STAGE_A(PG8_SA(0, 0), cA, 0, voffA); PG8_STAGE_A(PG8_SA(0, 1), cA, 1, voffA);
    if (wr == 1) PG8_BAR;
    PG8_WAIT_V(2); PG8_BAR;
    PG8_STAGE_D(PG8_SB(1, 0), cB + kstepB, voffB[0], dB); PG8_STAGE_A(PG8_SA(1, 0), cA + kstep, 0, voffA); PG8_STAGE_D(PG8_SB(1, 1), cB + hstepB + kstepB, voffB[0], dB);
    PG8_WAIT_V(6); PG8_BAR;
    for (;;) {
        const bool has_next = S.next(ui + 1, nxt);
        const char* nA = has_next ? S.a_ptr(nxt) : cA; const char* nB = has_next ? S.b_ptr(nxt) : cB;
        if constexpr (GA) { if (has_next) PG8_AVOFF(nxt, voffAn);
            else {
#pragma unroll
                for (int h = 0; h < 2; ++h)
#pragma unroll
                    for (int i = 0; i < 2; ++i) voffAn[h][i] = voffA[h][i]; } }
#pragma unroll 1
        for (int t = 0; t < nt; t += 2) {
            const bool last = (t == nt - 2);
            const char* a1 = cA + (size_t)(t + 1) * kstep;
            const char* a2 = last ? nA : cA + (size_t)(t + 2) * kstep; const char* b2 = last ? nB : cB + (size_t)(t + 2) * kstepB;
            const char* a3 = a2 + kstep; const char* b3 = b2 + kstepB;
            PG8_LDB(B0, 0, 0); PG8_LDB(B1, 0, 1); PG8_SCHED; PG8_LDA(At, 0, 0); PG8_STAGE_A(PG8_SA(1, 1), a1, 1, voffA);
            if constexpr (GA) { if (last) {
#pragma unroll
                for (int h = 0; h < 2; ++h)
#pragma unroll
                    for (int i = 0; i < 2; ++i) voffA[h][i] = voffAn[h][i]; } }
            PG8_WAIT_V(8); PG8_WAIT_L(0); PG8_BAR; PG8_MMA(0, 0, At, B0); PG8_MMA(0, 1, At, B1); PG8_BAR; PG8_SCHED;
            PG8_LDA(At, 0, 1); PG8_STAGE_D(PG8_SB(0, 0), b2, voffB[0], dB); PG8_STAGE_D(PG8_SB(0, 1), b2 + hstepB, voffB[0], dB); PG8_STAGE_A(PG8_SA(0, 0), a2, 0, voffA);
            PG8_WAIT_V(8); PG8_WAIT_L(0); PG8_BAR; PG8_MMA(1, 0, At, B0); PG8_MMA(1, 1, At, B1); PG8_BAR; PG8_SCHED;
            PG8_LDB(B0, 1, 0); PG8_LDB(B1, 1, 1); PG8_SCHED; PG8_LDA(At, 1, 0); PG8_STAGE_A(PG8_SA(0, 1), a2, 1, voffA);
            PG8_WAIT_V(8); PG8_WAIT_L(0); PG8_BAR; PG8_MMA(0, 0, At, B0); PG8_MMA(0, 1, At, B1); PG8_BAR; PG8_SCHED;
            PG8_LDA(At, 1, 1); PG8_STAGE_D(PG8_SB(1, 0), b3, voffB[0], dB); PG8_STAGE_D(PG8_SB(1, 1), b3 + hstepB, voffB[0], dB); PG8_STAGE_A(PG8_SA(1, 0), a3, 0, voffA);
            PG8_WAIT_V(8); PG8_WAIT_L(0); PG8_BAR; PG8_MMA(1, 0, At, B0); PG8_MMA(1, 1, At, B1); PG8_BAR; PG8_SCHED;
        }
        if constexpr (ALIGN_EPI) { if (wr == 0) PG8_BAR; }
        { Unit ue = cur; ue.pm = __builtin_amdgcn_readfirstlane(ue.pm); ue.pn = __builtin_amdgcn_readfirstlane(ue.pn); ue.e = __builtin_amdgcn_readfirstlane(ue.e); asm volatile("" : "+s"(ue.pm), "+s"(ue.pn), "+s"(ue.e));
          const int t3_ = fresh_tid(); const int fr_ = t3_ & 15, fq_ = (t3_ & 63) >> 4;
          E(acc, ue, wr, wc, fr_, fq_); }
        if (!has_next) break;
#pragma unroll
        for (int a = 0; a < 2; ++a)
#pragma unroll
            for (int b = 0; b < 2; ++b)
#pragma unroll
                for (int m = 0; m < 4; ++m)
#pragma unroll
                    for (int n = 0; n < 2; ++n) acc[a][b][m][n] = (f32x4){0.f, 0.f, 0.f, 0.f};
        cur = nxt; cA = nA; cB = nB; ++ui;
        if constexpr (ALIGN_EPI) { if (wr == 1) PG8_BAR; }
    }
    PG8_WAIT_V(0);
    if constexpr (!ALIGN_EPI) { if (wr == 0) PG8_BAR; }
    PG8_BAR;
#undef PG8_SA
#undef PG8_SB
#undef PG8_STAGE
#undef PG8_STAGE1
#undef PG8_STAGE_D
#undef PG8_STAGE_A
#undef PG8_AVOFF
#undef PG8_LDA
#undef PG8_LDB
#undef PG8_MMA
#undef PG8_WAIT_V
#undef PG8_WAIT_L
#undef PG8_BAR
#undef PG8_SCHED
}
}
using pg8::Unit;
using pg8::cvt_pk_bf16;

DI float bflo(unsigned w) { return __uint_as_float(w << 16); }
DI float bfhi(unsigned w) { return __uint_as_float(w & 0xffff0000u); }
DI float bf2f(bf16 b) { return __uint_as_float(((unsigned)b) << 16); }
typedef __bf16 hwbf2 __attribute__((ext_vector_type(2)));
DI unsigned pk2(float lo, float hi) { const f32x2 v = {lo, hi}; return __builtin_bit_cast(unsigned, __builtin_convertvector(v, hwbf2)); }
DI unsigned f2bf(float f) { return pk2(f, 0.f) & 0xffffu; }
DI float rcp_f(float x) { return __builtin_amdgcn_rcpf(x); }
DI float rsq_f(float x) { return __builtin_amdgcn_rsqf(x); }
DI float sigmoid_f(float x) { return rcp_f(1.0f + __expf(-x)); }
DI float tanh_fast(float x) { return 1.0f - 2.0f * rcp_f(__expf(2.0f * x) + 1.0f); }
DI float softplus_f(float x) { return fmaxf(x, 0.f) + __logf(1.0f + __expf(-fabsf(x))); }
DI float softplus_fast(float x) { return fmaxf(x, 0.f) + __logf(1.0f + __expf(-fabsf(x))); }
DI float gelu_tanh_f(float x) { const float u = 0.7978845608028654f * (x + 0.044715f * x * x * x); return 0.5f * x * (1.0f + tanh_fast(u)); }
DI float wave_sum(float v) {
#pragma unroll
    for (int o = 1; o < 64; o <<= 1) v += __shfl_xor(v, o);
    return v;
}

DI unsigned pk4_fp8(float a, float b, float c, float d) { int w = 0; w = __builtin_amdgcn_cvt_pk_fp8_f32(a, b, w, false); w = __builtin_amdgcn_cvt_pk_fp8_f32(c, d, w, true); return (unsigned)w; }
struct EpiBf16Plain {
    static constexpr bool PERM = true;
    bf16* O; int ldc; float scale;
    DI void operator()(const f32x4 (&acc)[2][2][4][2], const Unit& u, int wr, int wc, int fr, int fq) const {
        const int row0 = u.pm * 256 + wr * 64 + fr, col0 = u.pn * 256 + wc * 32 + 8 * fq;
#pragma unroll
        for (int ai = 0; ai < 2; ++ai)
#pragma unroll
            for (int m = 0; m < 4; ++m) { bf16* rowp = O + (size_t)(row0 + ai * 128 + m * 16) * ldc + col0;
#pragma unroll
                for (int bj = 0; bj < 2; ++bj) { const f32x4 v0 = acc[ai][bj][m][0] * scale, v1 = acc[ai][bj][m][1] * scale;
                    u32x4 w; w.x = cvt_pk_bf16(v0[0], v0[1]); w.y = cvt_pk_bf16(v0[2], v0[3]); w.z = cvt_pk_bf16(v1[0], v1[1]); w.w = cvt_pk_bf16(v1[2], v1[3]);
                    *(u32x4*)(rowp + bj * 128) = w; } }
    }
};
template <int MODE> struct EpiFold {
    static constexpr bool PERM = true;
    unsigned char* O;
    DI void operator()(const f32x4 (&acc)[2][2][4][2], const Unit& u, int wr, int wc, int fr, int fq) const {
        const int b = u.pm >> 2, h = u.pm & 3;
        const int rbase = MODE == 0 ? h * 256 : u.pn * 256, cbase = MODE == 0 ? u.pn * 256 : h * 256;
        const unsigned boff = (unsigned)b * 1024u * 1024u + (unsigned)(rbase + wr * 64 + fr) * 1024u + (unsigned)(cbase + wc * 32 + 8 * fq);
#pragma unroll
        for (int ai = 0; ai < 2; ++ai)
#pragma unroll
            for (int m = 0; m < 4; ++m) { unsigned char* rowp = O + (boff + (unsigned)(ai * 128 + m * 16) * 1024u);
#pragma unroll
                for (int bj = 0; bj < 2; ++bj) { const f32x4 v0 = acc[ai][bj][m][0] * 4.0f, v1 = acc[ai][bj][m][1] * 4.0f;
                    u32x2 w; w.x = pk4_fp8(v0[0], v0[1], v0[2], v0[3]); w.y = pk4_fp8(v1[0], v1[1], v1[2], v1[3]);
                    *(u32x2*)(rowp + bj * 128) = w; } }
    }
};
struct EpiSoftmax {
    static constexpr bool PERM = true;
    unsigned char* O; float scale; const float* RS; LAS float* XM; LAS float* XS;
    DI void operator()(const f32x4 (&acc)[2][2][4][2], const Unit& u, int wr, int wc, int fr, int fq) const {
        const int row0 = u.pm * 256 + wr * 64 + fr, col0 = u.pn * 256 + wc * 32 + 8 * fq;
        float sc[2][4];
#pragma unroll
        for (int ai = 0; ai < 2; ++ai)
#pragma unroll
            for (int m = 0; m < 4; ++m) { const int r = row0 + ai * 128 + m * 16; const f32x4* rp = (const f32x4*)(RS + (size_t)r * 16);
                const f32x4 p0 = rp[0], p1 = rp[1], p2 = rp[2], p3 = rp[3];
                const float ss = ((p0[0] + p0[1]) + (p0[2] + p0[3])) + ((p1[0] + p1[1]) + (p1[2] + p1[3])) + ((p2[0] + p2[1]) + (p2[2] + p2[3])) + ((p3[0] + p3[1]) + (p3[2] + p3[3]));
                sc[ai][m] = scale * __builtin_amdgcn_rsqf(ss * (1.0f / 1024.0f) + 1e-6f);
                float mm = -3.0e38f;
#pragma unroll
                for (int bj = 0; bj < 2; ++bj)
#pragma unroll
                    for (int n = 0; n < 2; ++n) { const f32x4 v = acc[ai][bj][m][n]; mm = fmaxf(mm, fmaxf(fmaxf(v[0], v[1]), fmaxf(v[2], v[3]))); }
                mm *= sc[ai][m];
                mm = fmaxf(mm, __shfl_xor(mm, 16)); mm = fmaxf(mm, __shfl_xor(mm, 32));
                if (fq == 0) XM[(ai * 128 + wr * 64 + m * 16 + fr) * 4 + wc] = mm; }
        asm volatile("s_waitcnt lgkmcnt(0)" ::: "memory"); __builtin_amdgcn_s_barrier(); asm volatile("" ::: "memory");
        f32x4 (&pa)[2][2][4][2] = const_cast<f32x4 (&)[2][2][4][2]>(acc);
#pragma unroll
        for (int ai = 0; ai < 2; ++ai)
#pragma unroll
            for (int m = 0; m < 4; ++m) { const int lr = ai * 128 + wr * 64 + m * 16 + fr; const f32x4 q = *(const LAS f32x4*)(XM + lr * 4);
                const float mxr = fmaxf(fmaxf(q[0], q[1]), fmaxf(q[2], q[3])); float sm = 0.f;
#pragma unroll
                for (int bj = 0; bj < 2; ++bj)
#pragma unroll
                    for (int n = 0; n < 2; ++n)
#pragma unroll
                        for (int j = 0; j < 4; ++j) { const float p = __expf(acc[ai][bj][m][n][j] * sc[ai][m] - mxr); pa[ai][bj][m][n][j] = p; sm += p; }
                sm += __shfl_xor(sm, 16); sm += __shfl_xor(sm, 32);
                if (fq == 0) XS[lr * 4 + wc] = sm; }
        asm volatile("s_waitcnt lgkmcnt(0)" ::: "memory"); __builtin_amdgcn_s_barrier(); asm volatile("" ::: "memory");
#pragma unroll
        for (int ai = 0; ai < 2; ++ai)
#pragma unroll
            for (int m = 0; m < 4; ++m) { const int lr = ai * 128 + wr * 64 + m * 16 + fr; const f32x4 q = *(const LAS f32x4*)(XS + lr * 4);
                const float inv = 256.0f * __builtin_amdgcn_rcpf((q[0] + q[1]) + (q[2] + q[3]));
                unsigned char* rowp = O + (size_t)(row0 + ai * 128 + m * 16) * 1024 + col0;
#pragma unroll
                for (int bj = 0; bj < 2; ++bj) { const f32x4 v0 = pa[ai][bj][m][0] * inv, v1 = pa[ai][bj][m][1] * inv;
                    u32x2 w; w.x = pk4_fp8(v0[0], v0[1], v0[2], v0[3]); w.y = pk4_fp8(v1[0], v1[1], v1[2], v1[3]);
                    *(u32x2*)(rowp + bj * 128) = w; } }
        asm volatile("s_waitcnt lgkmcnt(0)" ::: "memory"); __builtin_amdgcn_s_barrier(); asm volatile("" ::: "memory");
    }
};
struct EpiBf16RowNorm {
    static constexpr bool PERM = true;
    bf16* O; int ldc; float scale; const float* RS;
    DI void operator()(const f32x4 (&acc)[2][2][4][2], const Unit& u, int wr, int wc, int fr, int fq) const {
        const int row0 = u.pm * 256 + wr * 64 + fr, col0 = u.pn * 256 + wc * 32 + 8 * fq;
#pragma unroll
        for (int ai = 0; ai < 2; ++ai)
#pragma unroll
            for (int m = 0; m < 4; ++m) { const int r = row0 + ai * 128 + m * 16; const f32x4* rp = (const f32x4*)(RS + (size_t)r * 16);
                const f32x4 p0 = rp[0], p1 = rp[1], p2 = rp[2], p3 = rp[3];
                const float ss = ((p0[0] + p0[1]) + (p0[2] + p0[3])) + ((p1[0] + p1[1]) + (p1[2] + p1[3])) + ((p2[0] + p2[1]) + (p2[2] + p2[3])) + ((p3[0] + p3[1]) + (p3[2] + p3[3]));
                const float sc = scale * __builtin_amdgcn_rsqf(ss * (1.0f / 1024.0f) + 1e-6f);
                bf16* rowp = O + (size_t)r * ldc + col0;
#pragma unroll
                for (int bj = 0; bj < 2; ++bj) { const f32x4 v0 = acc[ai][bj][m][0] * sc, v1 = acc[ai][bj][m][1] * sc;
                    u32x4 w; w.x = cvt_pk_bf16(v0[0], v0[1]); w.y = cvt_pk_bf16(v0[2], v0[3]); w.z = cvt_pk_bf16(v1[0], v1[1]); w.w = cvt_pk_bf16(v1[2], v1[3]);
                    *(u32x4*)(rowp + bj * 128) = w; } }
    }
};
template <bool RES_BF16> struct EpiBf16Res {
    static constexpr bool PERM = true;
    const void* Rz; bf16* O; int ldc; float* RS; float ascale; unsigned char* O8;
    DI void operator()(const f32x4 (&acc)[2][2][4][2], const Unit& u, int wr, int wc, int fr, int fq) const {
        const int row0 = u.pm * 256 + wr * 64 + fr, col0 = u.pn * 256 + wc * 32 + 8 * fq;
#pragma unroll
        for (int ai = 0; ai < 2; ++ai) {
            u32x4 rwb[4][2]; f32x4 rf0[4][2], rf1[4][2];
#pragma unroll
            for (int m = 0; m < 4; ++m) { const size_t off = (size_t)(row0 + ai * 128 + m * 16) * ldc + col0;
#pragma unroll
                for (int bj = 0; bj < 2; ++bj) {
                    if (RES_BF16) rwb[m][bj] = __builtin_nontemporal_load((const u32x4*)((const bf16*)Rz + off + bj * 128));
                    else { rf0[m][bj] = __builtin_nontemporal_load((const f32x4*)((const float*)Rz + off + bj * 128)); rf1[m][bj] = __builtin_nontemporal_load((const f32x4*)((const float*)Rz + off + bj * 128 + 4)); } } }
#pragma unroll
            for (int m = 0; m < 4; ++m) { const size_t off = (size_t)(row0 + ai * 128 + m * 16) * ldc + col0; float ssq = 0.f;
#pragma unroll
                for (int bj = 0; bj < 2; ++bj) { f32x4 r0, r1;
                    if (RES_BF16) { const u32x4 rw = rwb[m][bj]; r0 = (f32x4){bflo(rw.x), bfhi(rw.x), bflo(rw.y), bfhi(rw.y)}; r1 = (f32x4){bflo(rw.z), bfhi(rw.z), bflo(rw.w), bfhi(rw.w)}; }
                    else { r0 = rf0[m][bj]; r1 = rf1[m][bj]; }
                    const f32x4 v0 = r0 + acc[ai][bj][m][0] * ascale, v1 = r1 + acc[ai][bj][m][1] * ascale;
                    if (O8) { u32x2 w8; w8.x = pk4_fp8(v0[0], v0[1], v0[2], v0[3]); w8.y = pk4_fp8(v1[0], v1[1], v1[2], v1[3]); *(u32x2*)(O8 + off + bj * 128) = w8; }
                    ssq += (v0[0] * v0[0] + v0[1] * v0[1]) + (v0[2] * v0[2] + v0[3] * v0[3]) + (v1[0] * v1[0] + v1[1] * v1[1]) + (v1[2] * v1[2] + v1[3] * v1[3]);
                    u32x4 w; w.x = cvt_pk_bf16(v0[0], v0[1]); w.y = cvt_pk_bf16(v0[2], v0[3]); w.z = cvt_pk_bf16(v1[0], v1[1]); w.w = cvt_pk_bf16(v1[2], v1[3]);
                    *(u32x4*)(O + off + bj * 128) = w; }
                if (RS) { ssq += __shfl_xor(ssq, 16); ssq += __shfl_xor(ssq, 32); if (fq == 0) RS[(size_t)(row0 + ai * 128 + m * 16) * 16 + u.pn * 4 + wc] = ssq; } } }
    }
};
struct EpiLora {
    static constexpr bool PERM = false;
    float* LWp; bf16* AAp; bf16* GGp; const float* w0; const float* a0;
    DI void operator()(const f32x4 (&acc)[2][2][4][2], const Unit& u, int wr, int wc, int fr, int fq) const {
        const int kind = u.pn >> 1;
        const int row0 = u.pm * 256 + wr * 64 + fr, col0 = (u.pn & 1) * 256 + wc * 32 + 4 * fq;
#pragma unroll
        for (int bj = 0; bj < 2; ++bj)
#pragma unroll
            for (int n = 0; n < 2; ++n) {
                const int c = col0 + bj * 128 + n * 16;
                f32x4 bias = (f32x4){0.f, 0.f, 0.f, 0.f};
                if (kind == 0) bias = *(const f32x4*)(w0 + c); else if (kind == 1) bias = *(const f32x4*)(a0 + c);
#pragma unroll
                for (int ai = 0; ai < 2; ++ai)
#pragma unroll
                    for (int m = 0; m < 4; ++m) {
                        f32x4 v = acc[ai][bj][m][n] + bias;
                        if (kind == 0) {
#pragma unroll
                            for (int j = 0; j < 4; ++j) { const float w = -softplus_fast(-v[j]) - 0.5f; v[j] = -__expf(w);     }
                        } else if (kind == 1) {
#pragma unroll
                            for (int j = 0; j < 4; ++j) v[j] = sigmoid_f(v[j]);
                        }
                        const size_t o_ = (size_t)(row0 + ai * 128 + m * 16) * 512 + c;
                        if (kind == 0) *(f32x4*)(LWp + o_) = v;
                        else { u32x2 w_; w_.x = cvt_pk_bf16(v[0], v[1]); w_.y = cvt_pk_bf16(v[2], v[3]); *(u32x2*)((kind == 1 ? AAp : GGp) + o_) = w_; }
                    }
            }
    }
};
typedef float f32x2_t __attribute__((ext_vector_type(2)));
struct EpiSwiglu {
    static constexpr bool PERM = true;
    bf16* ACT; const float* b_gu;
    DI void operator()(const f32x4 (&acc)[2][2][4][2], const Unit& u, int wr, int wc, int fr, int fq) const {
        const int row0 = u.pm * 256 + wr * 64 + fr, j0 = u.pn * 128 + wc * 32 + 8 * fq;
        const float* bg = b_gu + (size_t)u.e * 2048 + j0; const float* bu = bg + 1024;
        const f32x4 bg0 = *(const f32x4*)bg, bg1 = *(const f32x4*)(bg + 4), bu0 = *(const f32x4*)bu, bu1 = *(const f32x4*)(bu + 4);
#pragma unroll
        for (int ai = 0; ai < 2; ++ai)
#pragma unroll
            for (int m = 0; m < 4; ++m) {
                float o[8];
#pragma unroll
                for (int n = 0; n < 2; ++n) { const f32x4 g4 = acc[ai][0][m][n] * 0.015625f + (n ? bg1 : bg0), u4 = acc[ai][1][m][n] * 0.015625f + (n ? bu1 : bu0);
#pragma unroll
                    for (int p = 0; p < 2; ++p) {
                        f32x2_t g, up; g.x = fminf(g4[2 * p], 7.0f); g.y = fminf(g4[2 * p + 1], 7.0f); up.x = fminf(fmaxf(u4[2 * p], -7.0f), 7.0f); up.y = fminf(fmaxf(u4[2 * p + 1], -7.0f), 7.0f);
                        const f32x2_t ex = g * (-1.702f * 1.44269504089f); f32x2_t d; d.x = __builtin_amdgcn_exp2f(ex.x); d.y = __builtin_amdgcn_exp2f(ex.y); d = d + 1.0f;
                        f32x2_t r; r.x = __builtin_amdgcn_rcpf(d.x); r.y = __builtin_amdgcn_rcpf(d.y);
                        const f32x2_t ov = (up + 1.0f) * (g * r); o[n * 4 + 2 * p] = ov.x; o[n * 4 + 2 * p + 1] = ov.y; } }
                u32x2 w; w.x = pk4_fp8(o[0], o[1], o[2], o[3]); w.y = pk4_fp8(o[4], o[5], o[6], o[7]);
                *(u32x2*)((unsigned char*)ACT + (size_t)(row0 + ai * 128 + m * 16) * 1024 + j0) = w;
            }
    }
};
struct EpiDown {
    static constexpr bool PERM = true;
    bf16* YS; const float* b_dn; const u32x2* row_sg;
    DI void operator()(const f32x4 (&acc)[2][2][4][2], const Unit& u, int wr, int wc, int fr, int fq) const {
        const int row0 = u.pm * 256 + wr * 64 + fr, col0 = u.pn * 256 + wc * 32 + 8 * fq;
        const float* bb = b_dn + (size_t)u.e * 1024 + col0;
        f32x4 bv[2][2];
#pragma unroll
        for (int bj = 0; bj < 2; ++bj)
#pragma unroll
            for (int n = 0; n < 2; ++n) bv[bj][n] = *(const f32x4*)(bb + bj * 128 + 4 * n);
        int slots[8]; float gts[8];
        { const u32x2* sgp = row_sg + row0;
#pragma unroll
        for (int q = 0; q < 8; ++q) { const u32x2 sg = sgp[(q >> 2) * 128 + (q & 3) * 16]; slots[q] = (int)sg.x; gts[q] = __uint_as_float(sg.y); } }
#pragma unroll
        for (int ai = 0; ai < 2; ++ai)
#pragma unroll
            for (int m = 0; m < 4; ++m) {
                const int slot = slots[ai * 4 + m]; const float gt = gts[ai * 4 + m];
                if (slot >= 0) { unsigned char* rowp = (unsigned char*)YS + (size_t)slot * 1024 + col0; const float g16 = gt * 16.0f;
#pragma unroll
                    for (int bj = 0; bj < 2; ++bj) { const f32x4 v0 = (acc[ai][bj][m][0] * 0.015625f + bv[bj][0]) * g16, v1 = (acc[ai][bj][m][1] * 0.015625f + bv[bj][1]) * g16;
                        u32x2 w; w.x = pk4_fp8(v0[0], v0[1], v0[2], v0[3]); w.y = pk4_fp8(v1[0], v1[1], v1[2], v1[3]);
                        *(u32x2*)(rowp + bj * 128) = w; } }
            }
    }
};

constexpr size_t MiB = 1u << 20;
constexpr size_t WS_CTL = 0, CTL_ZERO_BYTES = 1 * MiB;
constexpr size_t WS_WIN = 1 * MiB, WS_WOUT = 7 * MiB, WS_WQ = 9 * MiB, WS_WK = 11 * MiB, WS_WV = 13 * MiB, WS_WO = 15 * MiB, WS_LORAB = 17 * MiB, WS_LRUW = 18 * MiB;
constexpr size_t WS_ROUTE = 19 * MiB;
constexpr size_t WS_WGU = 22 * MiB, WS_WDN = 150 * MiB;
constexpr size_t WS_HN = 214 * MiB, WS_MEMN = 246 * MiB, WS_KM = 248 * MiB, WS_VT = 250 * MiB;
constexpr size_t WS_X1 = 252 * MiB, WS_X2 = 316 * MiB;
constexpr size_t WS_U = 380 * MiB, WS_R = 468 * MiB, WS_KRAW = 500 * MiB, WS_V = 532 * MiB, WS_KKN = 564 * MiB, WS_WD = 596 * MiB, WS_AA = 628 * MiB, WS_G = 660 * MiB;
constexpr size_t WS_LA = 692 * MiB, WS_LB = 724 * MiB, WS_AP = 756 * MiB, WS_CAT = 764 * MiB, WS_Q = 796 * MiB;
constexpr size_t WS_XS = 380 * MiB, WS_ACT = 524 * MiB, WS_YS = 668 * MiB;
constexpr size_t WS_GP = 796 * MiB, WS_HF = 860 * MiB, WS_RP = 924 * MiB, WS_Y1F = 940 * MiB, WS_ADD = 972 * MiB, WS_END = 1004 * MiB;
constexpr size_t WS_GC = 468 * MiB, WS_HC = 484 * MiB, WS_ZS = 500 * MiB;
static_assert(WS_AA == WS_WD + 32 * MiB && WS_G == WS_AA + 32 * MiB, "EpiLora strides");
static_assert(WS_U + (size_t)M * INW * 2 <= WS_R && WS_XS + (size_t)MAXROWS * 2048 <= WS_ACT && WS_ACT + (size_t)MAXROWS * 2048 <= WS_YS && WS_YS + (size_t)NASSIGN * 2048 <= WS_Q, "ws map");
constexpr size_t RT_E = 0, RT_POS = 256 * 1024, RT_G = 512 * 1024, RT_SLOT = 768 * 1024, RT_GATE = 1088 * 1024, RT_TILE = 1408 * 1024, RT_TOK = 1472 * 1024, RT_UGU = 1792 * 1024, RT_UDN = 1808 * 1024;
constexpr int CW_BAR = 4096, CW_CNT = 8192, CW_CONV = 12288;

constexpr int RING_BYTES = 131072, MISC_OFF = RING_BYTES + 320, LDS_BYTES = 147456;
constexpr int NWAVES = 8, NTHREADS = 512;
constexpr int CONV_P9 = 6144;
constexpr int CONV_P9D = 16384;

#define XB_TMO      128
#define XB_XCNT(j)  (256  + 64 * (j))
#define XB_XSUB(j)  (1280 + 64 * (j))
#define XB_XGEN(j)  (2304 + 64 * (j))
#define XB_TOP      3328
#define XB_TOPGEN   3392
#define XCD_BAR_WORDS 3456
#define XB_SPIN_CAP (1u << 18)
DI unsigned xb_ld(unsigned* p)              { return __hip_atomic_load(p, __ATOMIC_RELAXED, __HIP_MEMORY_SCOPE_AGENT); }
DI unsigned xb_add(unsigned* p, unsigned v) { return __hip_atomic_fetch_add(p, v, __ATOMIC_RELAXED, __HIP_MEMORY_SCOPE_AGENT); }
DI unsigned xb_xcc_id() { return (unsigned)__builtin_amdgcn_s_getreg((3 << 11) | 20) & 0xFu; }
#define XB_SPIN(cond, bar) do { unsigned _sp = 0; while (cond) { __builtin_amdgcn_s_sleep(1); \
    if ((++_sp & 255u) == 0u) { if (xb_ld(&(bar)[XB_TMO])) break; if (_sp > XB_SPIN_CAP) { atomicAdd(&(bar)[XB_TMO], 1u); break; } } } } while (0)
struct XcdBarrier { unsigned* bar; unsigned x; volatile LAS unsigned* st; int w0; };
DI XcdBarrier xcd_barrier_post(unsigned* bar, volatile LAS unsigned* st, int w0) {
    XcdBarrier b; b.bar = bar; b.x = xb_xcc_id(); b.st = st; b.w0 = w0;
    if (fresh_tid_(w0) == 0) (void)xb_add(&bar[XB_XCNT(b.x)], 1u);
    return b;
}
DI void xcd_barrier_complete(unsigned* bar, unsigned x, unsigned& nloc, unsigned& nx) {
    const unsigned G = gridDim.x * gridDim.y * gridDim.z;
    unsigned sum, cnt, mine, sp = 0u;
    for (;;) {
        sum = 0u; cnt = 0u; mine = 0u;
#pragma unroll
        for (unsigned j = 0; j < 16; ++j) { const unsigned c = xb_ld(&bar[XB_XCNT(j)]); sum += c; cnt += (c > 0u) ? 1u : 0u; mine = (j == x) ? c : mine; }
        if (sum == G) break;
        __builtin_amdgcn_s_sleep(1);
        if ((++sp & 255u) == 0u) { if (xb_ld(&bar[XB_TMO])) break; if (sp > XB_SPIN_CAP) { atomicAdd(&bar[XB_TMO], 1u); break; } }
    }
    nloc = mine > 0u ? mine : 1u; nx = cnt > 0u ? cnt : 1u;
}
DI void xcd_barrier(const XcdBarrier& b) {
    asm volatile("s_waitcnt vmcnt(0)" ::: "memory");
    __syncthreads();
    if (fresh_tid_(b.w0) == 0) {
        unsigned* bar = b.bar;
        __builtin_amdgcn_s_waitcnt(0);
        unsigned nloc = b.st[0], nx = b.st[1];
        if (nloc == 0u) { xcd_barrier_complete(bar, b.x, nloc, nx); b.st[0] = nloc; b.st[1] = nx; }
        const unsigned old = xb_add(&bar[XB_XSUB(b.x)], 1u);
        const unsigned gen = old / nloc;
        if (old + 1u == (gen + 1u) * nloc) {
            __builtin_amdgcn_fence(__ATOMIC_RELEASE, "agent");
            asm volatile("s_waitcnt vmcnt(0)" ::: "memory");
            const unsigned og = xb_add(&bar[XB_TOP], 1u);
            const unsigned tg = og / nx;
            if (og + 1u == (tg + 1u) * nx) xb_add(&bar[XB_TOPGEN], 1u);
            else XB_SPIN(xb_ld(&bar[XB_TOPGEN]) == tg, bar);
            __builtin_amdgcn_fence(__ATOMIC_ACQUIRE, "agent");
            xb_add(&bar[XB_XGEN(b.x)], 1u);
            asm volatile("s_waitcnt vmcnt(0)" ::: "memory");
        } else {
            XB_SPIN(xb_ld(&bar[XB_XGEN(b.x)]) == gen, bar);
            __builtin_amdgcn_fence(__ATOMIC_ACQUIRE, "agent");
            asm volatile("s_waitcnt vmcnt(0)" ::: "memory");
        }
    }
    __syncthreads();
}

struct Args { const float* in[37]; float* out; unsigned char* ws; int ph_lo, ph_hi; };
enum { I_X = 0, I_MEM, I_NMIXG, I_WIN, I_CONVW, I_CONVB, I_LWX, I_LBX, I_LWA, I_LBA, I_LAM, I_MU, I_W0, I_WUP, I_A0, I_AUP, I_GUP, I_KK, I_KA, I_RK, I_LNG, I_LNB,
       I_WOUT, I_NXAG, I_NMEMG, I_WQ, I_WK, I_WV, I_WO, I_NFFG, I_WR, I_BR, I_WGU, I_BGU, I_WDN, I_BDN, I_FNG };

DI void transpose_item(const float* W, int ldw, int K, bf16* WT, int k0, int n0, int drow0, LAS float* scr, int lane, const float* rs = nullptr) {
    f32x4 t[8];
    const float* src = W + (size_t)(k0 + (lane >> 3)) * ldw + n0 + 4 * (lane & 7);
#pragma unroll
    for (int i = 0; i < 8; ++i) t[i] = *(const f32x4*)(src + (size_t)(8 * i) * ldw);
#pragma unroll
    for (int i = 0; i < 8; ++i) { const float sc_ = rs ? rs[k0 + 8 * i + (lane >> 3)] : 1.0f; LAS float* d = scr + (8 * i + (lane >> 3)) * 33 + 4 * (lane & 7); d[0] = t[i].x * sc_; d[1] = t[i].y * sc_; d[2] = t[i].z * sc_; d[3] = t[i].w * sc_; }
    asm volatile("s_waitcnt lgkmcnt(0)" ::: "memory");
    const int c = lane & 7;
#pragma unroll
    for (int j = 0; j < 4; ++j) { const int n = (lane >> 3) + 8 * j; const LAS float* s = scr + (8 * c) * 33 + n;
        u32x4 o; o.x = pk2(s[0 * 33], s[1 * 33]); o.y = pk2(s[2 * 33], s[3 * 33]); o.z = pk2(s[4 * 33], s[5 * 33]); o.w = pk2(s[6 * 33], s[7 * 33]);
        *(u32x4*)(WT + (size_t)(drow0 + n) * K + k0 + 8 * c) = o; }
    asm volatile("s_waitcnt lgkmcnt(0)" ::: "memory");
}
DI void transpose_item_tiled(const float* W, int ldw, int K, bf16* WTe, int k0, int n0, int drow0, LAS float* scr, int lane) {
    f32x4 t[8];
    const float* src = W + (size_t)(k0 + (lane >> 3)) * ldw + n0 + 4 * (lane & 7);
#pragma unroll
    for (int i = 0; i < 8; ++i) t[i] = *(const f32x4*)(src + (size_t)(8 * i) * ldw);
#pragma unroll
    for (int i = 0; i < 8; ++i) { LAS float* d = scr + (8 * i + (lane >> 3)) * 33 + 4 * (lane & 7); d[0] = t[i].x; d[1] = t[i].y; d[2] = t[i].z; d[3] = t[i].w; }
    asm volatile("s_waitcnt lgkmcnt(0)" ::: "memory");
    const int c = lane & 7;
#pragma unroll
    for (int j = 0; j < 4; ++j) { const int n = (lane >> 3) + 8 * j; const LAS float* s = scr + (8 * c) * 33 + n;
        u32x4 o; o.x = pk2(s[0 * 33], s[1 * 33]); o.y = pk2(s[2 * 33], s[3 * 33]); o.z = pk2(s[4 * 33], s[5 * 33]); o.w = pk2(s[6 * 33], s[7 * 33]);
        const int drow = drow0 + n, pn = drow >> 8, half = (drow >> 7) & 1, r = drow & 127, x = r & 31;
        const int rslot = (r & ~31) + 16 * ((x >> 2) & 1) + 4 * (x >> 3) + (x & 3);
        const size_t tb = ((size_t)(pn * (K / 64) + (k0 >> 6)) * 2 + half) * 16384 + pg8::lds_byte(rslot, 8 * c);
        *(u32x4*)((char*)WTe + tb) = o; }
    asm volatile("s_waitcnt lgkmcnt(0)" ::: "memory");
}
DI void transpose_item_tiled_nolds(const float* W, int ldw, int K, bf16* WTe, int k0, int n0, int drow0, int lane) {
    const int n = lane & 31, kh = lane >> 5;
    const float* src = W + (size_t)(k0 + 32 * kh) * ldw + n0 + n;
    float t[32];
#pragma unroll
    for (int i = 0; i < 32; ++i) t[i] = src[(size_t)i * ldw];
    const int drow = drow0 + n, pn = drow >> 8, half = (drow >> 7) & 1, r = drow & 127, x = r & 31;
    const int rslot = (r & ~31) + 16 * ((x >> 2) & 1) + 4 * (x >> 3) + (x & 3);
    const size_t tb0 = ((size_t)(pn * (K / 64) + (k0 >> 6)) * 2 + half) * 16384;
#pragma unroll
    for (int c = 0; c < 4; ++c) { u32x4 o; o.x = pk2(t[8 * c], t[8 * c + 1]); o.y = pk2(t[8 * c + 2], t[8 * c + 3]); o.z = pk2(t[8 * c + 4], t[8 * c + 5]); o.w = pk2(t[8 * c + 6], t[8 * c + 7]);
        *(u32x4*)((char*)WTe + tb0 + pg8::lds_byte(rslot, 32 * kh + 8 * c)) = o; }
}
DI void transpose_item_tiled_fp8_nolds(const float* W, int ldw, int K, unsigned char* WTe, int k0, int n0, int drow0, int lane) {
    const int n = lane & 31, kh = lane >> 5;
    const float* src = W + (size_t)(k0 + 32 * kh) * ldw + n0 + n;
    float t[32];
#pragma unroll
    for (int i = 0; i < 32; ++i) t[i] = __builtin_nontemporal_load(src + (size_t)i * ldw) * 64.f;
    const int drow = drow0 + n, pn = drow >> 8, half = (drow >> 7) & 1, r = drow & 127, x = r & 31;
    const int rslot = (r & ~31) + 16 * ((x >> 2) & 1) + 4 * (x >> 3) + (x & 3);
    const size_t tb0 = ((size_t)(pn * (K / 128) + (k0 >> 7)) * 2 + half) * 16384;
#pragma unroll
    for (int c = 0; c < 2; ++c) { u32x4 o; o.x = pk4_fp8(t[16 * c], t[16 * c + 1], t[16 * c + 2], t[16 * c + 3]); o.y = pk4_fp8(t[16 * c + 4], t[16 * c + 5], t[16 * c + 6], t[16 * c + 7]);
        o.z = pk4_fp8(t[16 * c + 8], t[16 * c + 9], t[16 * c + 10], t[16 * c + 11]); o.w = pk4_fp8(t[16 * c + 12], t[16 * c + 13], t[16 * c + 14], t[16 * c + 15]);
        const int bc = (k0 & 64) + 32 * kh + 16 * c;
        *(u32x4*)(WTe + tb0 + pg8::lds_byte(rslot, bc >> 1)) = o; }
}
DI void transpose_item_tiled_fp8(const float* W, int ldw, int K, unsigned char* WTe, int k0, int n0, int drow0, LAS float* scr, int lane) {
    f32x4 t[8];
    const float* src = W + (size_t)(k0 + (lane >> 3)) * ldw + n0 + 4 * (lane & 7);
#pragma unroll
    for (int i = 0; i < 8; ++i) t[i] = __builtin_nontemporal_load((const f32x4*)(src + (size_t)(8 * i) * ldw));
#pragma unroll
    for (int i = 0; i < 8; ++i) { LAS float* d = scr + (8 * i + (lane >> 3)) * 33 + 4 * (lane & 7); d[0] = t[i].x * 64.f; d[1] = t[i].y * 64.f; d[2] = t[i].z * 64.f; d[3] = t[i].w * 64.f; }
    asm volatile("s_waitcnt lgkmcnt(0)" ::: "memory");
    const int c = lane & 3;
#pragma unroll
    for (int j = 0; j < 2; ++j) { const int n = (lane >> 2) + 16 * j; const LAS float* sp = scr + (16 * c) * 33 + n;
        u32x4 o; o.x = pk4_fp8(sp[0 * 33], sp[1 * 33], sp[2 * 33], sp[3 * 33]); o.y = pk4_fp8(sp[4 * 33], sp[5 * 33], sp[6 * 33], sp[7 * 33]);
        o.z = pk4_fp8(sp[8 * 33], sp[9 * 33], sp[10 * 33], sp[11 * 33]); o.w = pk4_fp8(sp[12 * 33], sp[13 * 33], sp[14 * 33], sp[15 * 33]);
        const int drow = drow0 + n, pn = drow >> 8, half = (drow >> 7) & 1, r = drow & 127, x = r & 31;
        const int rslot = (r & ~31) + 16 * ((x >> 2) & 1) + 4 * (x >> 3) + (x & 3);
        const int bc = (k0 & 64) + 16 * c;
        const size_t tb = ((size_t)(pn * (K / 128) + (k0 >> 7)) * 2 + half) * 16384 + pg8::lds_byte(rslot, bc >> 1);
        *(u32x4*)(WTe + tb) = o; }
    asm volatile("s_waitcnt lgkmcnt(0)" ::: "memory");
}
DI void rms_row_to_bf16(const float* xrow, const float* g, bf16* orow, int lane) {
    const f32x4* xr = (const f32x4*)xrow + lane; const f32x4* gr = (const f32x4*)g + lane;
    f32x4 v[4]; float s = 0.f;
#pragma unroll
    for (int j = 0; j < 4; ++j) { v[j] = __builtin_nontemporal_load(xr + 64 * j); s += (v[j].x * v[j].x + v[j].y * v[j].y) + (v[j].z * v[j].z + v[j].w * v[j].w); }
    const float rstd = rsq_f(wave_sum(s) * (1.f / D) + EPS);
    u32x2* o8 = (u32x2*)orow + lane;
#pragma unroll
    for (int j = 0; j < 4; ++j) { const f32x4 gg = gr[64 * j]; u32x2 w; w.x = pk2(v[j].x * rstd * gg.x, v[j].y * rstd * gg.y); w.y = pk2(v[j].z * rstd * gg.z, v[j].w * rstd * gg.w); o8[64 * j] = w; }
}

DI void rms_rowbf_to_bf16(const bf16* xrow, const float* g, bf16* orow, int lane) {
    float v[16]; float s = 0.f;
#pragma unroll
    for (int hf = 0; hf < 2; ++hf) { const u32x4 w = *(const u32x4*)(xrow + 512 * hf + 8 * lane);
#pragma unroll
        for (int q = 0; q < 4; ++q) { v[8 * hf + 2 * q] = bflo(w[q]); v[8 * hf + 2 * q + 1] = bfhi(w[q]); } }
#pragma unroll
    for (int j = 0; j < 16; ++j) s += v[j] * v[j];
    const float rstd = rsq_f(wave_sum(s) * (1.f / D) + EPS);
#pragma unroll
    for (int hf = 0; hf < 2; ++hf) { const f32x4 g0 = *(const f32x4*)(g + 512 * hf + 8 * lane), g1 = *(const f32x4*)(g + 512 * hf + 8 * lane + 4);
        u32x4 w; w.x = pk2(v[8 * hf] * rstd * g0.x, v[8 * hf + 1] * rstd * g0.y); w.y = pk2(v[8 * hf + 2] * rstd * g0.z, v[8 * hf + 3] * rstd * g0.w);
        w.z = pk2(v[8 * hf + 4] * rstd * g1.x, v[8 * hf + 5] * rstd * g1.y); w.w = pk2(v[8 * hf + 6] * rstd * g1.z, v[8 * hf + 7] * rstd * g1.w);
        *(u32x4*)(orow + 512 * hf + 8 * lane) = w; }
}

__global__ void __launch_bounds__(NTHREADS, 2) fwd(Args args) {
    extern __shared__ __attribute__((aligned(16))) unsigned char lds_raw[];
    LAS unsigned char* lds = (LAS unsigned char*)lds_raw;
    volatile LAS unsigned* MISC = (volatile LAS unsigned*)(lds + MISC_OFF);
    const int G = gridDim.x, bid = blockIdx.x, NGW = G * NWAVES;
    const int wv0 = __builtin_amdgcn_readfirstlane((int)(threadIdx.x >> 6));
#define PHASE_IDS const int tid = fresh_tid(), lane = tid & 63, wave = __builtin_amdgcn_readfirstlane(tid >> 6), gw = bid * NWAVES + wave; (void)tid; (void)lane; (void)wave; (void)gw
    unsigned char* ws = args.ws;
    unsigned* ctl = (unsigned*)(ws + WS_CTL);
    const int lo = args.ph_lo, hi = args.ph_hi;

    for (int u = fresh_tid(); u < (LDS_BYTES - RING_BYTES) / 4; u += NTHREADS) ((LAS unsigned*)(lds + RING_BYTES))[u] = 0u;
    __syncthreads();
    XcdBarrier bar; bar.bar = ctl + CW_BAR; bar.x = 0; bar.st = nullptr; bar.w0 = wv0;
    if (hi - lo > 1) bar = xcd_barrier_post(ctl + CW_BAR, MISC + 8, wv0);
#define IN(k) (lo <= (k) && (k) < hi)
#define SEAM(k) do { if (IN(k) && IN((k) + 1)) xcd_barrier(bar); } while (0)

#define Win_t ((bf16*)(ws + WS_WIN))
#define Wout_t ((bf16*)(ws + WS_WOUT))
#define Wq_t ((bf16*)(ws + WS_WQ))
#define Wk_t ((bf16*)(ws + WS_WK))
#define Wv_t ((bf16*)(ws + WS_WV))
#define Wo_t ((bf16*)(ws + WS_WO))
#define LoraB ((bf16*)(ws + WS_LORAB))
#define LruW ((bf16*)(ws + WS_LRUW))
#define WrT ((bf16*)(ws + WS_LRUW + 512 * 1024))
#define Wgu_t ((bf16*)(ws + WS_WGU))
#define Wdn_t ((bf16*)(ws + WS_WDN))
#define HN ((bf16*)(ws + WS_HN))
#define MEMN ((bf16*)(ws + WS_MEMN))
#define KM ((bf16*)(ws + WS_KM))
#define VT ((bf16*)(ws + WS_VT))
#define X1 ((bf16*)(ws + WS_X1))
#define X2 ((bf16*)(ws + WS_X2))
#define U ((bf16*)(ws + WS_U))
#define Rr ((float*)(ws + WS_R))
#define KRAW ((float*)(ws + WS_KRAW))
#define Vv ((float*)(ws + WS_V))
#define KKN ((float*)(ws + WS_KKN))
#define WD ((float*)(ws + WS_WD))
#define AA ((float*)(ws + WS_AA))
#define GG ((float*)(ws + WS_G))
#define LA ((bf16*)(ws + WS_LA))
#define LB ((bf16*)(ws + WS_LB))
#define AP ((bf16*)(ws + WS_AP))
#define CAT ((bf16*)(ws + WS_CAT))
#define Qb ((bf16*)(ws + WS_Q))
#define Ob CAT
#define LACT ((bf16*)(ws + WS_CAT))
#define X1F8 ((unsigned char*)(ws + WS_XS))
#define XS ((bf16*)(ws + WS_XS))
#define ACT ((bf16*)(ws + WS_ACT))
#define YS ((bf16*)(ws + WS_YS))
#define route_e ((int*)(ws + WS_ROUTE + RT_E))
#define route_pos ((int*)(ws + WS_ROUTE + RT_POS))
#define route_g ((float*)(ws + WS_ROUTE + RT_G))
#define row_sg ((u32x2*)(ws + WS_ROUTE + RT_SLOT))
#define tile_tab ((int*)(ws + WS_ROUTE + RT_TILE))
#define row_tok ((int*)(ws + WS_ROUTE + RT_TOK))
#define ecnt (ctl + CW_CNT)

    if (IN(0)) { PHASE_IDS;
        LAS float* scr = (LAS float*)(lds + wave * 16384);
        constexpr int I_IN = 16 * (INW / 32), I_SQ = 16 * 32;
        constexpr int N_ITEMS = I_IN + 5 * I_SQ;
        for (int it = gw; it < N_ITEMS; it += NGW) {
            int r = it;
            if (r < I_IN) { const int nblk = INW / 32, kb = r / nblk, nb = r % nblk; transpose_item(args.in[I_WIN], INW, D, Win_t, 64 * kb, 32 * nb, 32 * nb, scr, lane); continue; } r -= I_IN;
            { const int w = r / I_SQ, q = r % I_SQ, kb = q / 32, nb = q % 32;
                if (w == 1) continue;
                const float* src = w == 0 ? args.in[I_WOUT] : w == 2 ? args.in[I_WK] : w == 3 ? args.in[I_WV] : args.in[I_WO];
                bf16* dst = w == 0 ? Wout_t : w == 2 ? Wk_t : w == 3 ? Wv_t : Wo_t;
                transpose_item(src, D, D, dst, 64 * kb, 32 * nb, 32 * nb, scr, lane); }
        }
        for (int idx = bid * NTHREADS + tid; idx < D * D / 4; idx += G * NTHREADS) { const f32x4 v = ((const f32x4*)args.in[I_WQ])[idx]; const float gk = args.in[I_NXAG][idx >> 8];
            u32x2 w; w.x = pk2(v.x * gk, v.y * gk); w.y = pk2(v.z * gk, v.w * gk); ((u32x2*)Wq_t)[idx] = w; }
        for (int idx = bid * NTHREADS + tid; idx < 1536 * 256; idx += G * NTHREADS) {
            const int e = idx & 7, ln = (idx >> 3) & 63, ks = (idx >> 9) & 7, ct = (idx >> 12) & 3, hk = idx >> 14, hh = hk / 3, kind = hk - 3 * hh;
            const int k = 32 * ks + 8 * (ln >> 4) + e, n = hh * 64 + 16 * ct + (ln & 15); float v = 0.f;
            if (kind == 0) { if (k < 64) v = args.in[I_WUP][k * 512 + n]; }
            else if (kind == 1) { if (k >= 64 && k < 128) v = args.in[I_AUP][(k - 64) * 512 + n]; }
            else { if (k >= 128) v = args.in[I_GUP][(k - 128) * 512 + n]; }
            LoraB[idx] = (bf16)f2bf(v);
        }
        for (int idx = bid * NTHREADS + tid; idx < 8 * 128 * 64; idx += G * NTHREADS) {
            const int nb = idx >> 13, col = (idx >> 6) & 127, k = idx & 63;
            const float v = col < 64 ? args.in[I_LWX][nb * 4096 + k * 64 + col] : args.in[I_LWA][nb * 4096 + k * 64 + (col - 64)];
            LruW[idx] = (bf16)f2bf(v);
        }
        for (int idx = bid * NTHREADS + tid; idx < NE * D; idx += G * NTHREADS) {
            const int e = idx >> 10, k = idx & 1023; const float v = args.in[I_WR][k * NE + e];
            const unsigned hi = f2bf(v); const float lo = v - __uint_as_float(hi << 16);
            WrT[idx] = (bf16)hi; WrT[NE * D + idx] = (bf16)f2bf(lo);
        }
        for (int m = gw; m < M; m += NGW) rms_row_to_bf16(args.in[I_X] + (size_t)m * D, args.in[I_NMIXG], HN + (size_t)m * D, lane);
        for (int m = gw; m < MROWS; m += NGW) rms_row_to_bf16(args.in[I_MEM] + (size_t)m * D, args.in[I_NMEMG], MEMN + (size_t)m * D, lane);
        {
            LAS float* scr = (LAS float*)(lds + wave * 16384);
            constexpr int I_GU = 16 * 64, I_DN = 16 * 32;
            for (int it = CONV_P9 + gw; it < NE * I_GU; it += NGW) {
                int r = it;
                if (r < NE * I_GU) { const int e = r / I_GU, q = r % I_GU, kb = q / 64, nb = q % 64; const int n0 = 32 * nb;
                    const int drow = n0 < 1024 ? (256 * (n0 >> 7) + (n0 & 127)) : (256 * ((n0 - 1024) >> 7) + 128 + ((n0 - 1024) & 127));
                    transpose_item_tiled_fp8(args.in[I_WGU] + (size_t)e * D * 2048, 2048, D, (unsigned char*)Wgu_t + (size_t)e * 2048 * D, 64 * kb, n0, drow, scr, lane); continue; } r -= NE * I_GU;
                { const int e = r / I_DN, q = r % I_DN, kb = q / 32, nb = q % 32;
                  transpose_item_tiled(args.in[I_WDN] + (size_t)e * DFF * D, D, DFF, Wdn_t + (size_t)e * D * DFF, 64 * kb, 32 * nb, 32 * nb, scr, lane); }
            }
        }
    }
    SEAM(0);

    if (IN(1)) { PHASE_IDS;
        { pg8::DenseSched S; S.o.init_tiles(M / 256, INW / 256, G, bid); S.A = (const char*)HN; S.B = (const char*)Win_t; S.tstep = (size_t)256 * D * 2;
          EpiBf16Plain E{U, INW, 1.0f}; pg8::gemm_phase(lds, D, S, E, wv0); }
        { pg8::DenseSched S; S.o.init_tiles(MROWS / 256, D / 256, G, (bid + 64) & (G - 1)); S.A = (const char*)MEMN; S.B = (const char*)Wk_t; S.tstep = (size_t)256 * D * 2;
          EpiBf16Plain E{KM, D, 1.0f}; pg8::gemm_phase(lds, D, S, E, wv0); }
        { pg8::DenseSched S; S.o.init_tiles(MROWS / 256, D / 256, G, (bid + 48) & (G - 1)); S.A = (const char*)MEMN; S.B = (const char*)Wv_t; S.tstep = (size_t)256 * D * 2;
          EpiBf16Plain E{VT, D, 1.0f}; pg8::gemm_phase(lds, D, S, E, wv0); }
    }
    SEAM(1);

    if (IN(2)) { PHASE_IDS;
        const float* conv_w = args.in[I_CONVW]; const float* conv_b = args.in[I_CONVB];
        LAS float* xs = (LAS float*)(lds + wave * 16384);
        LAS bf16* tP = (LAS bf16*)(lds + wave * 16384 + 4096); LAS bf16* tH = tP + 1024;
        const int i = lane & 15, kg = lane >> 4;
        for (int unit = gw; unit < (M / 64) * 8; unit += NGW) {
            const int seg = unit >> 3, nb = unit & 7, m0s = seg * 64, s0s = m0s & (SEQ - 1);
            bf16x8 wf[8][2];
#pragma unroll
            for (int ct = 0; ct < 8; ++ct)
#pragma unroll
                for (int ks = 0; ks < 2; ++ks) wf[ct][ks] = *(const bf16x8*)(LruW + ((size_t)(nb * 128 + 16 * ct + i) * 64 + 32 * ks + 8 * kg));
            float bxv[4], bav[4], spv[4], Arun[4], Brun[4];
#pragma unroll
            for (int ct = 0; ct < 4; ++ct) { const int ch = nb * 64 + 16 * ct + i; bxv[ct] = args.in[I_LBX][ch]; bav[ct] = args.in[I_LBA][ch]; spv[ct] = softplus_f(-args.in[I_LAM][ch]); Arun[ct] = 1.f; Brun[ct] = 0.f; }
#pragma unroll 1
            for (int jt = 0; jt < 4; ++jt) {
                const int m0 = m0s + 16 * jt, s0 = s0s + 16 * jt;
                bf16x8 af[2];
#pragma unroll
                for (int ks = 0; ks < 2; ++ks) {
                    const int chb = nb * 64 + 32 * ks + 8 * kg;
                    f32x4 x0 = *(const f32x4*)(conv_b + chb), x1 = *(const f32x4*)(conv_b + chb + 4);
#pragma unroll
                    for (int j = 0; j < 4; ++j) {
                        const bool ok = s0 + i - 3 + j >= 0;
                        u32x4 uw = *(const u32x4*)(U + (size_t)(ok ? m0 + i - 3 + j : m0) * INW + chb); if (!ok) uw = (u32x4){0u, 0u, 0u, 0u};
                        const f32x4 w0 = *(const f32x4*)(conv_w + j * 512 + chb), w1 = *(const f32x4*)(conv_w + j * 512 + chb + 4);
                        x0.x += w0.x * bflo(uw.x); x0.y += w0.y * bfhi(uw.x); x0.z += w0.z * bflo(uw.y); x0.w += w0.w * bfhi(uw.y);
                        x1.x += w1.x * bflo(uw.z); x1.y += w1.y * bfhi(uw.z); x1.z += w1.z * bflo(uw.w); x1.w += w1.w * bfhi(uw.w);
                    }
                    *(LAS f32x4*)(xs + i * 64 + 32 * ks + 8 * kg) = x0; *(LAS f32x4*)(xs + i * 64 + 32 * ks + 8 * kg + 4) = x1;
                    u32x4 p; p.x = pk2(x0.x, x0.y); p.y = pk2(x0.z, x0.w); p.z = pk2(x1.x, x1.y); p.w = pk2(x1.z, x1.w);
                    af[ks] = __builtin_bit_cast(bf16x8, p);
                }
                f32x4 acc[8];
#pragma unroll
                for (int ct = 0; ct < 8; ++ct) { acc[ct] = (f32x4){0.f, 0.f, 0.f, 0.f};
#pragma unroll
                    for (int ks = 0; ks < 2; ++ks) acc[ct] = __builtin_amdgcn_mfma_f32_16x16x32_bf16(af[ks], wf[ct][ks], acc[ct], 0, 0, 0); }
#pragma unroll
                for (int ct = 0; ct < 4; ++ct) {
                    const int col = 16 * ct + i;
                    float hl[4], pl[4]; float hprev = 0.f, pprev = 1.f;
#pragma unroll
                    for (int e = 0; e < 4; ++e) {
                        const float gx = sigmoid_f(acc[ct][e] + bxv[ct]), ga = sigmoid_f(acc[ct + 4][e] + bav[ct]);
                        const float la = -8.0f * ga * spv[ct], av = __expf(la), xcv = xs[(4 * kg + e) * 64 + col];
                        const float bt = __builtin_amdgcn_sqrtf(fmaxf(1.0f - av * av, 0.f)) * gx * xcv;
                        hprev = av * hprev + bt; pprev *= av; hl[e] = hprev; pl[e] = pprev;
                    }
                    float Ag[4], Bg[4];
#pragma unroll
                    for (int gq = 0; gq < 4; ++gq) { Ag[gq] = __shfl(pl[3], i + 16 * gq); Bg[gq] = __shfl(hl[3], i + 16 * gq); }
                    float Ain = Arun[ct], Bin = Brun[ct];
#pragma unroll
                    for (int gq = 0; gq < 3; ++gq) if (gq < kg) { Bin = Ag[gq] * Bin + Bg[gq]; Ain *= Ag[gq]; }
                    float At = 1.f, Bt = 0.f;
#pragma unroll
                    for (int gq = 0; gq < 4; ++gq) { Bt = Ag[gq] * Bt + Bg[gq]; At *= Ag[gq]; }
                    Brun[ct] = At * Brun[ct] + Bt; Arun[ct] *= At;
#pragma unroll
                    for (int e = 0; e < 4; ++e) { const int ti_ = (4 * kg + e) * 64 + col; tP[ti_] = (bf16)f2bf(pl[e] * Ain); tH[ti_] = (bf16)f2bf(hl[e] + pl[e] * Bin); }
                }
                { const int rr = lane >> 2, cq = lane & 3;
                  bf16* pp = LA + (size_t)(m0 + rr) * 512 + nb * 64 + 16 * cq; bf16* hp = LB + (size_t)(m0 + rr) * 512 + nb * 64 + 16 * cq;
                  *(u32x4*)pp = *(const LAS u32x4*)(tP + rr * 64 + 16 * cq); *(u32x4*)(pp + 8) = *(const LAS u32x4*)(tP + rr * 64 + 16 * cq + 8);
                  *(u32x4*)hp = *(const LAS u32x4*)(tH + rr * 64 + 16 * cq); *(u32x4*)(hp + 8) = *(const LAS u32x4*)(tH + rr * 64 + 16 * cq + 8); }
            }
            if (kg == 0) {
#pragma unroll
                for (int ct = 0; ct < 4; ++ct) { f32x2 ab; ab.x = Arun[ct]; ab.y = Brun[ct];
                    *(f32x2*)((float*)(ws + WS_AP) + ((size_t)(((seg >> 6) * 8 + nb) * 64 + (seg & 63)) * 64 + 16 * ct + i) * 2) = ab; }
            }
        }
        { const int rsub = lane >> 5, chunk = lane & 31;
          const f32x4 m0 = *(const f32x4*)(args.in[I_MU] + 1536 + 8 * chunk), m1 = *(const f32x4*)(args.in[I_MU] + 1536 + 8 * chunk + 4);
          const bool actid = chunk >= 8 && chunk < 16; const float actc = chunk < 8 ? 2.8853900818f : -1.4426950409f, actp = chunk < 8 ? 1.0f : 0.0f, actq = chunk < 8 ? -2.0f : 1.0f;
          for (int rp = gw; rp < M / 2; rp += NGW) { const size_t mr = (size_t)2 * rp + rsub; const bool hp2 = (mr & (SEQ - 1)) != 0; const bf16* ua = U + mr * INW + 2560 + 8 * chunk;
              const u32x4 cu = *(const u32x4*)ua; u32x4 pu = *(const u32x4*)(ua - (hp2 ? INW : 0)); if (!hp2) pu = (u32x4){0u, 0u, 0u, 0u};
              float o8[8];
#pragma unroll
              for (int q = 0; q < 4; ++q) { const float c0 = bflo(cu[q]), c1 = bfhi(cu[q]), p0 = bflo(pu[q]), p1 = bfhi(pu[q]); const float mm0 = q < 2 ? m0[2 * q] : m1[2 * q - 4], mm1 = q < 2 ? m0[2 * q + 1] : m1[2 * q - 3];
                  float x0 = c0 + (p0 - c0) * mm0, x1 = c1 + (p1 - c1) * mm1;
                  const float r0 = __builtin_amdgcn_rcpf(__builtin_amdgcn_exp2f(actc * x0) + 1.0f), r1 = __builtin_amdgcn_rcpf(__builtin_amdgcn_exp2f(actc * x1) + 1.0f);
                  o8[2 * q] = actid ? x0 : actp + actq * r0; o8[2 * q + 1] = actid ? x1 : actp + actq * r1; }
              u32x4 pw; pw.x = pk2(o8[0], o8[1]); pw.y = pk2(o8[2], o8[3]); pw.z = pk2(o8[4], o8[5]); pw.w = pk2(o8[6], o8[7]);
              *(u32x4*)(LACT + mr * 256 + 8 * chunk) = pw; } }
    }
    SEAM(2);


#define RW_ZB(zz, zb) do { _Pragma("unroll") for (int ks_ = 0; ks_ < 2; ++ks_) { u32x4 p_; p_.x = pk2(zz[2 * ks_][0], zz[2 * ks_][1]); p_.y = pk2(zz[2 * ks_][2], zz[2 * ks_][3]); \
        p_.z = pk2(zz[2 * ks_ + 1][0], zz[2 * ks_ + 1][1]); p_.w = pk2(zz[2 * ks_ + 1][2], zz[2 * ks_ + 1][3]); zb[ks_] = __builtin_bit_cast(bf16x8, p_); } } while (0)
    if (IN(3)) { PHASE_IDS;
        for (int u64 = gw; u64 < NB * NH * (SEQ / 64); u64 += NGW) {
#pragma unroll 1
        for (int jj = 0; jj < 4; ++jj) {
        LAS unsigned char* wl = lds + wave * 16384;
        LAS bf16* Arm = (LAS bf16*)(wl); LAS bf16* Brm = (LAS bf16*)(wl + 2048); LAS bf16* Krm = (LAS bf16*)(wl + 4096); LAS bf16* Rrm = (LAS bf16*)(wl + 6144);
        LAS bf16* ATt = (LAS bf16*)(wl + 8192); LAS bf16* BTt = (LAS bf16*)(wl + 10240); LAS bf16* KTt = (LAS bf16*)(wl + 12288); LAS bf16* VTt = (LAS bf16*)(wl + 14336);
        LAS float* MabT = (LAS float*)(wl); LAS bf16* Mak = (LAS bf16*)(wl + 1024); LAS bf16* Mrb = (LAS bf16*)(wl + 1536); LAS bf16* Mrk = (LAS bf16*)(wl + 2048); LAS bf16* Tm = (LAS bf16*)(wl + 2560);
        LAS float* PLs = (LAS float*)(wl + 3072); LAS bf16* Q0T = (LAS bf16*)(wl + 4096);
        const int lane = fresh_tid() & 63, l15 = lane & 15, g = lane >> 4, te = lane >> 2, kq = lane & 3;
        const bf16x8 z8 = (bf16x8){0, 0, 0, 0, 0, 0, 0, 0};
        const f32x4 z4 = (f32x4){0.f, 0.f, 0.f, 0.f};
            const int un = u64 * 4 + jj;
            const int bh = un >> 8, c = un & 255, b = bh >> 3, h = bh & 7;
            const size_t mrow = (size_t)b * SEQ + c * 16 + te, off = mrow * 512 + h * 64 + 16 * kq;
            const int hc = h * 64 + 16 * kq;
            LAS float* tmpL = (LAS float*)wl;
            {
                const int rsub = lane >> 5, chunk = lane & 31; const size_t mt0 = (size_t)b * SEQ + c * 16;
                u32x4 cu[8];
#pragma unroll
                for (int i = 0; i < 8; ++i) cu[i] = *(const u32x4*)(LACT + (mt0 + 2 * i + rsub) * 256 + 8 * chunk);
#pragma unroll
                for (int i = 0; i < 8; ++i) { const int row = 2 * i + rsub; *(LAS u32x4*)(wl + row * 512 + ((chunk ^ (row & 7)) << 4)) = cu[i]; }
                bf16x8 af[8];
#pragma unroll
                for (int ks = 0; ks < 8; ++ks) af[ks] = *(const LAS bf16x8*)(wl + l15 * 512 + (((4 * ks + g) ^ (l15 & 7)) << 4));
                asm volatile("s_waitcnt lgkmcnt(0)" ::: "memory");
#pragma unroll
                for (int kind = 0; kind < 3; ++kind)
#pragma unroll
                    for (int ct = 0; ct < 4; ++ct) {
                        const bf16* lb = LoraB + ((size_t)((h * 3 + kind) * 4 + ct) * 8 * 64 + lane) * 8;
                        f32x4 a4 = z4;
#pragma unroll
                        for (int ks = (kind == 0 ? 0 : kind == 1 ? 2 : 4); ks < (kind == 0 ? 2 : kind == 1 ? 4 : 8); ++ks) a4 = __builtin_amdgcn_mfma_f32_16x16x32_bf16(af[ks], *(const bf16x8*)(lb + ks * 512), a4, 0, 0, 0);
#pragma unroll
                        for (int e = 0; e < 4; ++e) tmpL[kind * 1088 + (4 * g + e) * 68 + 16 * ct + l15] = a4[e];
                    }
            }
            asm volatile("s_waitcnt lgkmcnt(0)" ::: "memory");
            float cl[16], eP[16];
            {
                float lwv[16], rl[16], kl[16], vl[16], kn[16], av[16];
                const bool hp = (mrow & (SEQ - 1)) != 0;
                const bf16* ub = U + mrow * INW + 1024 + hc;
#pragma unroll
                for (int hh = 0; hh < 2; ++hh) {
#pragma unroll
                    for (int a3 = 0; a3 < 3; ++a3) {
                        const u32x4 cu = *(const u32x4*)(ub + 512 * a3 + 8 * hh); u32x4 pu = *(const u32x4*)(ub - (hp ? INW : 0) + 512 * a3 + 8 * hh); if (!hp) pu = (u32x4){0u, 0u, 0u, 0u};
                        const f32x4 m0 = *(const f32x4*)(args.in[I_MU] + 512 * a3 + hc + 8 * hh), m1 = *(const f32x4*)(args.in[I_MU] + 512 * a3 + hc + 8 * hh + 4);
                        float o8[8];
#pragma unroll
                        for (int q = 0; q < 4; ++q) { const float c0 = bflo(cu[q]), c1 = bfhi(cu[q]), p0 = bflo(pu[q]), p1 = bfhi(pu[q]); const float mm0 = q < 2 ? m0[2 * q] : m1[2 * q - 4], mm1 = q < 2 ? m0[2 * q + 1] : m1[2 * q - 3];
                            o8[2 * q] = c0 + (p0 - c0) * mm0; o8[2 * q + 1] = c1 + (p1 - c1) * mm1; }
#pragma unroll
                        for (int q = 0; q < 8; ++q) { if (a3 == 0) rl[8 * hh + q] = o8[q]; else if (a3 == 1) kl[8 * hh + q] = o8[q]; else vl[8 * hh + q] = o8[q]; }
                    }
                }
                float gv[16];
#pragma unroll
                for (int j4 = 0; j4 < 4; ++j4) { const f32x4 xl = *(const LAS f32x4*)(tmpL + te * 68 + 16 * kq + 4 * j4), xa = *(const LAS f32x4*)(tmpL + 1088 + te * 68 + 16 * kq + 4 * j4), xg = *(const LAS f32x4*)(tmpL + 2176 + te * 68 + 16 * kq + 4 * j4);
                    const f32x4 w0v = *(const f32x4*)(args.in[I_W0] + hc + 4 * j4), a0v = *(const f32x4*)(args.in[I_A0] + hc + 4 * j4);
#pragma unroll
                    for (int q = 0; q < 4; ++q) { lwv[4 * j4 + q] = -0.6065306597f * sigmoid_f(xl[q] + w0v[q]);        av[4 * j4 + q] = sigmoid_f(xa[q] + a0v[q]); gv[4 * j4 + q] = xg[q]; } }
                asm volatile("s_waitcnt lgkmcnt(0)" ::: "memory");
                float ss = 0.f;
#pragma unroll
                for (int j4 = 0; j4 < 4; ++j4) { const f32x4 kk4 = *(const f32x4*)(args.in[I_KK] + hc + 4 * j4);
#pragma unroll
                    for (int q = 0; q < 4; ++q) { kn[4 * j4 + q] = kl[4 * j4 + q] * kk4[q]; ss += kn[4 * j4 + q] * kn[4 * j4 + q]; } }
                ss += __shfl_xor(ss, 1); ss += __shfl_xor(ss, 2);
                const float kinv = rsq_f(fmaxf(ss, 1e-24f));
#pragma unroll
                for (int j = 0; j < 16; ++j) { float x = lwv[j];
#pragma unroll
                    for (int sft = 4; sft < 64; sft <<= 1) { const float y = __shfl_up(x, sft); if (lane >= sft) x += y; }
                    cl[j] = x; }
                float bon = 0.f;
                u32x4 pa[2], pb[2], pk[2], pr[2];
#pragma unroll
                for (int j4 = 0; j4 < 4; ++j4) {
                    const f32x4 ka = *(const f32x4*)(args.in[I_KA] + hc + 4 * j4), rk = *(const f32x4*)(args.in[I_RK] + hc + 4 * j4);
                    float at4[4], bt4[4], kt4[4], rt4[4];
#pragma unroll
                    for (int q = 0; q < 4; ++q) { const int j = 4 * j4 + q;
                        const float p = __expf(cl[j]), pn = __expf(-cl[j]), pm1 = __expf(cl[j] - lwv[j]); eP[j] = p;
                        const float knj = kn[j] * kinv;
                        const float kp = kl[j] * (1.0f + (av[j] - 1.0f) * ka[q]);
                        at4[q] = -knj * pm1; bt4[q] = knj * av[j] * pn; kt4[q] = kp * pn; rt4[q] = rl[j] * p;
                        bon += rl[j] * kp * rk[q];
                        const int kk = 16 * kq + j;
                        ATt[kk * 16 + te] = (bf16)f2bf(at4[q]); BTt[kk * 16 + te] = (bf16)f2bf(bt4[q]); KTt[kk * 16 + te] = (bf16)f2bf(kt4[q]); VTt[kk * 16 + te] = (bf16)f2bf(vl[j]); }
                    const int hh = j4 >> 1, w2 = (j4 & 1) * 2;
                    pa[hh][w2] = pk2(at4[0], at4[1]); pa[hh][w2 + 1] = pk2(at4[2], at4[3]); pb[hh][w2] = pk2(bt4[0], bt4[1]); pb[hh][w2 + 1] = pk2(bt4[2], bt4[3]);
                    pk[hh][w2] = pk2(kt4[0], kt4[1]); pk[hh][w2 + 1] = pk2(kt4[2], kt4[3]); pr[hh][w2] = pk2(rt4[0], rt4[1]); pr[hh][w2 + 1] = pk2(rt4[2], rt4[3]);
                }
#pragma unroll
                for (int hh = 0; hh < 2; ++hh) { const int po = te * 64 + 8 * ((2 * kq + hh) ^ (te & 7));
                    *(LAS u32x4*)(Arm + po) = pa[hh]; *(LAS u32x4*)(Brm + po) = pb[hh]; *(LAS u32x4*)(Krm + po) = pk[hh]; *(LAS u32x4*)(Rrm + po) = pr[hh]; }
                bon += __shfl_xor(bon, 1); bon += __shfl_xor(bon, 2);
                f32x4 lbv[4], lgv[4];
#pragma unroll
                for (int j4 = 0; j4 < 4; ++j4) { lbv[j4] = *(const f32x4*)(args.in[I_LNB] + hc + 4 * j4); lgv[j4] = *(const f32x4*)(args.in[I_LNG] + hc + 4 * j4); }
#pragma unroll
                for (int j4 = 0; j4 < 4; ++j4) { const f32x4 lb = lbv[j4], lgn = lgv[j4]; const int j0 = 4 * j4;
                    u32x2 ow, gw2; ow.x = pk2((lb.x + vl[j0] * bon) * gv[j0], (lb.y + vl[j0 + 1] * bon) * gv[j0 + 1]); ow.y = pk2((lb.z + vl[j0 + 2] * bon) * gv[j0 + 2], (lb.w + vl[j0 + 3] * bon) * gv[j0 + 3]);
                    gw2.x = pk2(lgn.x * gv[j0], lgn.y * gv[j0 + 1]); gw2.y = pk2(lgn.z * gv[j0 + 2], lgn.w * gv[j0 + 3]);
                    *(u32x2*)((bf16*)(ws + WS_ADD) + off + j0) = ow; *(u32x2*)((bf16*)(ws + WS_G) + off + j0) = gw2; }
            }
            asm volatile("s_waitcnt lgkmcnt(0)" ::: "memory");
            {
                bf16x8 fa[2], fr[2], fb[2], fk[2];
#pragma unroll
                for (int ks = 0; ks < 2; ++ks) { const int po = l15 * 64 + 8 * ((4 * ks + g) ^ (l15 & 7));
                    fa[ks] = *(const LAS bf16x8*)(Arm + po); fr[ks] = *(const LAS bf16x8*)(Rrm + po); fb[ks] = *(const LAS bf16x8*)(Brm + po); fk[ks] = *(const LAS bf16x8*)(Krm + po); }
                f32x4 mab = z4, mak = z4, mrb = z4, mrk = z4;
#pragma unroll
                for (int ks = 0; ks < 2; ++ks) { mab = __builtin_amdgcn_mfma_f32_16x16x32_bf16(fb[ks], fa[ks], mab, 0, 0, 0); mak = __builtin_amdgcn_mfma_f32_16x16x32_bf16(fk[ks], fa[ks], mak, 0, 0, 0);
                    mrb = __builtin_amdgcn_mfma_f32_16x16x32_bf16(fb[ks], fr[ks], mrb, 0, 0, 0); mrk = __builtin_amdgcn_mfma_f32_16x16x32_bf16(fk[ks], fr[ks], mrk, 0, 0, 0); }
#pragma unroll
                for (int e = 0; e < 4; ++e) { const int i = 4 * g + e; if (!(i < l15)) { mab[e] = 0.f; mak[e] = 0.f; } if (!(i <= l15)) { mrb[e] = 0.f; mrk[e] = 0.f; } }
                asm volatile("s_waitcnt lgkmcnt(0)" ::: "memory");
#pragma unroll
                for (int e = 0; e < 4; ++e) MabT[(4 * g + e) * 16 + l15] = mab[e];
                u32x2 w; w.x = pk2(mak[0], mak[1]); w.y = pk2(mak[2], mak[3]); *(LAS u32x2*)(Mak + l15 * 16 + 4 * g) = w;
                w.x = pk2(mrb[0], mrb[1]); w.y = pk2(mrb[2], mrb[3]); *(LAS u32x2*)(Mrb + l15 * 16 + 4 * g) = w;
                w.x = pk2(mrk[0], mrk[1]); w.y = pk2(mrk[2], mrk[3]); *(LAS u32x2*)(Mrk + l15 * 16 + 4 * g) = w;
                if (te == 15) {
#pragma unroll
                    for (int j = 0; j < 16; ++j) PLs[16 * kq + j] = eP[j]; }
            }
            asm volatile("s_waitcnt lgkmcnt(0)" ::: "memory");
            {
                f32x4 mq[15][4];
#pragma unroll
                for (int j = 0; j < 15; ++j)
#pragma unroll
                    for (int q = 0; q < 4; ++q) if (4 * q + 3 > j) mq[j][q] = *(const LAS f32x4*)(MabT + j * 16 + 4 * q);
                float y[16];
#pragma unroll
                for (int j = 15; j >= 0; --j) {
                    float acc = (j == l15) ? 1.0f : 0.0f;
#pragma unroll
                    for (int i = j + 1; i < 16; ++i) acc += y[i] * mq[j < 15 ? j : 0][i >> 2][i & 3];
                    y[j] = acc;
                }
                if (g == 0) { u32x4 t0, t1; t0.x = pk2(y[0], y[1]); t0.y = pk2(y[2], y[3]); t0.z = pk2(y[4], y[5]); t0.w = pk2(y[6], y[7]); t1.x = pk2(y[8], y[9]); t1.y = pk2(y[10], y[11]); t1.z = pk2(y[12], y[13]); t1.w = pk2(y[14], y[15]);
                    *(LAS u32x4*)(Tm + l15 * 16) = t0; *(LAS u32x4*)(Tm + l15 * 16 + 8) = t1; }
            }
            asm volatile("s_waitcnt lgkmcnt(0)" ::: "memory");
            {
                const bool act = g < 2; const int fo = l15 * 16 + 8 * g;
                const bf16x8 fT = act ? *(const LAS bf16x8*)(Tm + fo) : z8, fMak = act ? *(const LAS bf16x8*)(Mak + fo) : z8, fMrb = act ? *(const LAS bf16x8*)(Mrb + fo) : z8, fMrk = act ? *(const LAS bf16x8*)(Mrk + fo) : z8;
                bf16x8 fV[4], fQ1[4], fAh[4], fBT[4], fKT[4];
#pragma unroll
                for (int vt = 0; vt < 4; ++vt) { fV[vt] = act ? *(const LAS bf16x8*)(VTt + vt * 256 + fo) : z8; fBT[vt] = act ? *(const LAS bf16x8*)(BTt + vt * 256 + fo) : z8; fKT[vt] = act ? *(const LAS bf16x8*)(KTt + vt * 256 + fo) : z8; }
#pragma unroll
                for (int vt = 0; vt < 4; ++vt) { const f32x4 q0 = __builtin_amdgcn_mfma_f32_16x16x32_bf16(fMak, fV[vt], z4, 0, 0, 0);
                    u32x2 w; w.x = pk2(q0[0], q0[1]); w.y = pk2(q0[2], q0[3]); *(LAS u32x2*)(Q0T + vt * 256 + l15 * 16 + 4 * g) = w; }
#pragma unroll
                for (int kt = 0; kt < 4; ++kt) { const bf16x8 fA = act ? *(const LAS bf16x8*)(ATt + kt * 256 + fo) : z8; const f32x4 ah = __builtin_amdgcn_mfma_f32_16x16x32_bf16(fT, fA, z4, 0, 0, 0);
                    u32x2 w; w.x = pk2(ah[0], ah[1]); w.y = pk2(ah[2], ah[3]); *(LAS u32x2*)(ATt + kt * 256 + l15 * 16 + 4 * g) = w; }
                asm volatile("s_waitcnt lgkmcnt(0)" ::: "memory");
#pragma unroll
                for (int vt = 0; vt < 4; ++vt) { const bf16x8 fQ0 = act ? *(const LAS bf16x8*)(Q0T + vt * 256 + fo) : z8; const f32x4 q1 = __builtin_amdgcn_mfma_f32_16x16x32_bf16(fT, fQ0, z4, 0, 0, 0);
                    u32x2 w; w.x = pk2(q1[0], q1[1]); w.y = pk2(q1[2], q1[3]); *(LAS u32x2*)(Q0T + vt * 256 + l15 * 16 + 4 * g) = w; }
                asm volatile("s_waitcnt lgkmcnt(0)" ::: "memory");
#pragma unroll
                for (int vt = 0; vt < 4; ++vt) { fQ1[vt] = act ? *(const LAS bf16x8*)(Q0T + vt * 256 + fo) : z8; fAh[vt] = act ? *(const LAS bf16x8*)(ATt + vt * 256 + fo) : z8; }
                bf16* rp = (bf16*)(ws + WS_RP) + (size_t)un * 1024 + l15 * 64;
#pragma unroll
                for (int kt = 0; kt < 4; ++kt) {
                    const u32x2 rr = *(const LAS u32x2*)(Rrm + l15 * 64 + 8 * ((2 * kt + (g >> 1)) ^ (l15 & 7)) + 4 * (g & 1));
                    f32x4 ini; ini[0] = bflo(rr.x); ini[1] = bfhi(rr.x); ini[2] = bflo(rr.y); ini[3] = bfhi(rr.y);
                    const f32x4 rh = __builtin_amdgcn_mfma_f32_16x16x32_bf16(fAh[kt], fMrb, ini, 0, 0, 0);
                    u32x2 w; w.x = pk2(rh[0], rh[1]); w.y = pk2(rh[2], rh[3]); *(u32x2*)(rp + 32 * (kt >> 1) + 8 * g + 4 * (kt & 1)) = w;
                }
#pragma unroll
                for (int vt = 0; vt < 4; ++vt) { f32x4 y1 = __builtin_amdgcn_mfma_f32_16x16x32_bf16(fMrb, fQ1[vt], z4, 0, 0, 0); y1 = __builtin_amdgcn_mfma_f32_16x16x32_bf16(fMrk, fV[vt], y1, 0, 0, 0);
                    *(f32x4*)((float*)(ws + WS_Y1F) + ((size_t)(un * 4 + vt) * 64 + lane) * 4) = y1; }
                LAS bf16* tgs = (LAS bf16*)(wl + 8192);
#pragma unroll
                for (int krt = 0; krt < 4; ++krt) { const float pl = PLs[16 * krt + l15];
#pragma unroll
                    for (int kct = 0; kct < 4; ++kct) { f32x4 ga = __builtin_amdgcn_mfma_f32_16x16x32_bf16(fAh[kct], fBT[krt], z4, 0, 0, 0);
                        if (kct == krt) {
#pragma unroll
                            for (int e = 0; e < 4; ++e) if (4 * g + e == l15) ga[e] += 1.0f; }
                        u32x2 w; w.x = pk2(ga[0] * pl, ga[1] * pl); w.y = pk2(ga[2] * pl, ga[3] * pl);
                        *(LAS u32x2*)(tgs + (16 * krt + l15) * 64 + 32 * (kct >> 1) + 8 * g + 4 * (kct & 1)) = w; } }
                { u32x4* gp16 = (u32x4*)((bf16*)(ws + WS_GP) + (size_t)un * 4096);
#pragma unroll
                  for (int i = 0; i < 8; ++i) gp16[i * 64 + lane] = *(const LAS u32x4*)(tgs + (i * 64 + lane) * 8); }
#pragma unroll
                for (int mt = 0; mt < 4; ++mt) { const f32x4 pl4 = *(const LAS f32x4*)(PLs + 16 * mt + 4 * g);
#pragma unroll
                    for (int vt = 0; vt < 4; ++vt) { f32x4 ha = __builtin_amdgcn_mfma_f32_16x16x32_bf16(fBT[mt], fQ1[vt], z4, 0, 0, 0); ha = __builtin_amdgcn_mfma_f32_16x16x32_bf16(fKT[mt], fV[vt], ha, 0, 0, 0);
                        u32x2 w; w.x = pk2(ha[0] * pl4[0], ha[1] * pl4[1]); w.y = pk2(ha[2] * pl4[2], ha[3] * pl4[3]);
                        *(u32x2*)((bf16*)(ws + WS_HF) + ((size_t)((un * 4 + vt) * 4 + mt) * 64 + lane) * 4) = w; } }
            }
            asm volatile("s_waitcnt lgkmcnt(0)" ::: "memory");
        }
        asm volatile("s_waitcnt vmcnt(0)" ::: "memory");
        { const int ltid = fresh_tid() & 63, l15 = ltid & 15, g = ltid >> 4, lane = ltid;
#define CP_LOADG(gf_, j_) do { const bf16* gp_ = (const bf16*)(ws + WS_GP) + ((size_t)u64 * 4 + (j_)) * 4096 + l15 * 64 + 8 * g; \
            _Pragma("unroll") for (int mt = 0; mt < 4; ++mt) { gf_[mt][0] = *(const bf16x8*)(gp_ + mt * 1024); gf_[mt][1] = *(const bf16x8*)(gp_ + mt * 1024 + 32); } } while (0)
#define CP_LOADH(hf_, j_) do { _Pragma("unroll") for (int sl = 0; sl < 4; ++sl) _Pragma("unroll") for (int mt = 0; mt < 4; ++mt) \
            hf_[sl][mt] = *(const u32x2*)((const bf16*)(ws + WS_HF) + ((size_t)((((size_t)u64 * 4 + (j_)) * 4 + sl) * 4 + mt) * 64 + lane) * 4); } while (0)
#define CP_STEP(gf_, hf_, useh_) do { _Pragma("unroll") for (int sl = 0; sl < 4; ++sl) { bf16x8 zb[2]; RW_ZB(z[sl], zb); \
            _Pragma("unroll") for (int mt = 0; mt < 4; ++mt) { f32x4 a_ = (f32x4){0.f, 0.f, 0.f, 0.f}; \
                if (useh_) { a_[0] = bflo(hf_[sl][mt].x); a_[1] = bfhi(hf_[sl][mt].x); a_[2] = bflo(hf_[sl][mt].y); a_[3] = bfhi(hf_[sl][mt].y); } \
                a_ = __builtin_amdgcn_mfma_f32_16x16x32_bf16(gf_[mt][0], zb[0], a_, 0, 0, 0); a_ = __builtin_amdgcn_mfma_f32_16x16x32_bf16(gf_[mt][1], zb[1], a_, 0, 0, 0); z[sl][mt] = a_; } } } while (0)
        {
            f32x4 z[4][4];
#pragma unroll
            for (int sl = 0; sl < 4; ++sl)
#pragma unroll
                for (int mt = 0; mt < 4; ++mt)
#pragma unroll
                    for (int e = 0; e < 4; ++e) z[sl][mt][e] = (sl == mt && 4 * g + e == l15) ? 1.0f : 0.0f;
            bf16x8 gA[4][2], gB[4][2]; u32x2 hdum[4][4];
            CP_LOADG(gA, 0); CP_LOADG(gB, 1);
            CP_STEP(gA, hdum, false); CP_LOADG(gA, 2);
            CP_STEP(gB, hdum, false); CP_LOADG(gB, 3);
            CP_STEP(gA, hdum, false);
            CP_STEP(gB, hdum, false);
            LAS bf16* tg = (LAS bf16*)(lds + wave * 16384);
#pragma unroll
            for (int sl = 0; sl < 4; ++sl) { const int pc = 32 * (sl >> 1) + 8 * (l15 >> 2) + 4 * (sl & 1) + (l15 & 3);
#pragma unroll
                for (int mt = 0; mt < 4; ++mt)
#pragma unroll
                    for (int e = 0; e < 4; ++e) tg[(16 * mt + 4 * g + e) * 64 + pc] = (bf16)f2bf(z[sl][mt][e]); }
            u32x4* gc = (u32x4*)((bf16*)(ws + WS_GC) + (size_t)u64 * 4096);
#pragma unroll
            for (int i = 0; i < 8; ++i) gc[i * 64 + lane] = *(const LAS u32x4*)(tg + (i * 64 + lane) * 8);
        }
        {
            f32x4 z[4][4];
#pragma unroll
            for (int sl = 0; sl < 4; ++sl)
#pragma unroll
                for (int mt = 0; mt < 4; ++mt) z[sl][mt] = (f32x4){0.f, 0.f, 0.f, 0.f};
            bf16x8 gA[4][2], gB[4][2]; u32x2 hA[4][4], hB[4][4];
            CP_LOADG(gA, 0); CP_LOADH(hA, 0); CP_LOADG(gB, 1); CP_LOADH(hB, 1);
            CP_STEP(gA, hA, true); CP_LOADG(gA, 2); CP_LOADH(hA, 2);
            CP_STEP(gB, hB, true); CP_LOADG(gB, 3); CP_LOADH(hB, 3);
            CP_STEP(gA, hA, true);
            CP_STEP(gB, hB, true);
#pragma unroll
            for (int sl = 0; sl < 4; ++sl)
#pragma unroll
                for (int mt = 0; mt < 4; ++mt) { u32x2 w; w.x = pk2(z[sl][mt][0], z[sl][mt][1]); w.y = pk2(z[sl][mt][2], z[sl][mt][3]);
                    *(u32x2*)((bf16*)(ws + WS_HC) + ((size_t)((u64 * 4 + sl) * 4 + mt) * 64 + lane) * 4) = w; }
        }
#undef CP_LOADG
#undef CP_LOADH
#undef CP_STEP
        }
        }
    }
    SEAM(3);


    if (IN(4)) { PHASE_IDS;
        if (!(bid < 128 && wave == 0)) {
            const int wi = bid < 128 ? bid * 7 + (wave - 1) : 896 + (bid - 128) * 8 + wave, NW = 896 + (G - 128) * 8;
        } else {
            const int l15 = lane & 15, g = lane >> 4, bh = bid >> 2, vs = bid & 3;
            f32x4 z[4];
#pragma unroll
            for (int mt = 0; mt < 4; ++mt) z[mt] = (f32x4){0.f, 0.f, 0.f, 0.f};
            bf16x8 gA[4][2], gB[4][2], gC[4][2], gD[4][2]; u32x2 hA[4], hB[4], hC[4], hD[4];
#define SC_LOAD(gf, hf, C) do { const size_t u64_ = (size_t)bh * 64 + (C); const bf16* gp_ = (const bf16*)(ws + WS_GC) + u64_ * 4096 + l15 * 64 + 8 * g; \
                _Pragma("unroll") for (int mt = 0; mt < 4; ++mt) { gf[mt][0] = *(const bf16x8*)(gp_ + mt * 1024); gf[mt][1] = *(const bf16x8*)(gp_ + mt * 1024 + 32); \
                    hf[mt] = *(const u32x2*)((const bf16*)(ws + WS_HC) + ((size_t)((u64_ * 4 + vs) * 4 + mt) * 64 + lane) * 4); } } while (0)
#define SC_STEP(gf, hf, C) do { const size_t u64_ = (size_t)bh * 64 + (C); bf16* zs_ = (bf16*)(ws + WS_ZS) + ((size_t)((u64_ * 4 + vs) * 4) * 64 + lane) * 4; \
                _Pragma("unroll") for (int mt = 0; mt < 4; ++mt) { u32x2 zw_; zw_.x = pk2(z[mt][0], z[mt][1]); zw_.y = pk2(z[mt][2], z[mt][3]); *(u32x2*)(zs_ + mt * 256) = zw_; } \
                bf16x8 zb[2]; RW_ZB(z, zb); \
                _Pragma("unroll") for (int mt = 0; mt < 4; ++mt) { f32x4 a; a[0] = bflo(hf[mt].x); a[1] = bfhi(hf[mt].x); a[2] = bflo(hf[mt].y); a[3] = bfhi(hf[mt].y); \
                    a = __builtin_amdgcn_mfma_f32_16x16x32_bf16(gf[mt][0], zb[0], a, 0, 0, 0); a = __builtin_amdgcn_mfma_f32_16x16x32_bf16(gf[mt][1], zb[1], a, 0, 0, 0); z[mt] = a; } } while (0)
            SC_LOAD(gA, hA, 0); SC_LOAD(gB, hB, 1); SC_LOAD(gC, hC, 2);
#pragma unroll 1
            for (int C = 0; C < 64; C += 4) {
                SC_LOAD(gD, hD, C + 3);
                SC_STEP(gA, hA, C);
                if (C + 4 < 64) SC_LOAD(gA, hA, C + 4);
                SC_STEP(gB, hB, C + 1);
                if (C + 5 < 64) SC_LOAD(gB, hB, C + 5);
                SC_STEP(gC, hC, C + 2);
                if (C + 6 < 64) SC_LOAD(gC, hC, C + 6);
                SC_STEP(gD, hD, C + 3);
            }
#undef SC_LOAD
#undef SC_STEP
        }
    }
    if (IN(4)) { PHASE_IDS;
        if (bid < 32 && wave == 1) { const int bc = bid; const f32x2* ag = (const f32x2*)((const float*)(ws + WS_AP)) + (size_t)(bc * 64) * 64 + lane;
            float* car = (float*)(ws + WS_AP + 4 * MiB) + (size_t)(bc * 64) * 64 + lane; float hst = 0.f;
#pragma unroll 16
            for (int sg = 0; sg < 64; ++sg) { const f32x2 ab = ag[(size_t)sg * 64]; car[(size_t)sg * 64] = hst; hst = ab.x * hst + ab.y; } }
    }
    if (IN(4)) { PHASE_IDS;
        bf16* WKt = HN; bf16* VWt = HN + (size_t)4 * 1024 * 1024;
        __syncthreads();
        if (bid >= 128 && bid < 192) { pg8::FoldSched<0> S; S.A = (const char*)KM; S.B = (const char*)Wq_t; S.G = 64; S.c = bid - 128; EpiFold<0> E{(unsigned char*)WKt}; pg8::gemm_phase(lds, 256, S, E, wv0, 1024); }
        else if (bid >= 192) { pg8::FoldSched<1> S; S.A = (const char*)Wo_t; S.B = (const char*)VT; S.G = 64; S.c = bid - 192; EpiFold<1> E{(unsigned char*)VWt}; pg8::gemm_phase(lds, 256, S, E, wv0, 1024); }
    }
    SEAM(4);

    if (IN(5)) { PHASE_IDS;
        {
            for (int lu = gw; lu < (M / 64) * 8; lu += NGW) {
                const int seg = lu >> 3, nb = lu & 7, rr = lane >> 3, cq = lane & 7;
                const float* cp = (const float*)(ws + WS_AP + 4 * MiB) + ((size_t)(((seg >> 6) * 8 + nb) * 64 + (seg & 63)) * 64 + 8 * cq);
                const f32x4 c0 = *(const f32x4*)cp, c1 = *(const f32x4*)(cp + 4);
#pragma unroll
                for (int it = 0; it < 8; ++it) { const size_t m = (size_t)seg * 64 + 8 * it + rr; const size_t o = m * 512 + nb * 64 + 8 * cq;
                    const u32x4 pw = __builtin_nontemporal_load((const u32x4*)(LA + o)), hw = __builtin_nontemporal_load((const u32x4*)(LB + o)), gw_ = __builtin_nontemporal_load((const u32x4*)(U + m * INW + 512 + nb * 64 + 8 * cq));
                    float y[8];
#pragma unroll
                    for (int q = 0; q < 4; ++q) { const float ca = q < 2 ? c0[2 * q] : c1[2 * q - 4], cb = q < 2 ? c0[2 * q + 1] : c1[2 * q - 3];
                        y[2 * q] = (bflo(hw[q]) + bflo(pw[q]) * ca) * gelu_tanh_f(bflo(gw_[q])); y[2 * q + 1] = (bfhi(hw[q]) + bfhi(pw[q]) * cb) * gelu_tanh_f(bfhi(gw_[q])); }
                    u32x4 w; w.x = pk2(y[0], y[1]); w.y = pk2(y[2], y[3]); w.z = pk2(y[4], y[5]); w.w = pk2(y[6], y[7]);
                    *(u32x4*)(CAT + m * 1024 + nb * 64 + 8 * cq) = w; }
            }
        }
        const int l15 = lane & 15, g = lane >> 4;
        LAS bf16* tGL = (LAS bf16*)(lds + wave * 16384); LAS bf16* tAD = tGL + 1024; LAS bf16* tOUT = tGL + 2048;
        const int ct = lane >> 3, cc = lane & 7;
        for (int u64 = gw; u64 < NB * NH * (SEQ / 64); u64 += NGW) {
            const int bh = u64 >> 6, C = u64 & 63, b = bh >> 3, h = bh & 7;
            f32x4 z[4][4];
#pragma unroll
            for (int sl = 0; sl < 4; ++sl)
#pragma unroll
                for (int mt = 0; mt < 4; ++mt) { const u32x2 zw = *(const u32x2*)((const bf16*)(ws + WS_ZS) + ((size_t)((u64 * 4 + sl) * 4 + mt) * 64 + lane) * 4); z[sl][mt] = (f32x4){bflo(zw.x), bfhi(zw.x), bflo(zw.y), bfhi(zw.y)}; }
#pragma unroll 1
            for (int j = 0; j < 4; ++j) {
                const size_t un = (size_t)u64 * 4 + j; const size_t m0 = (size_t)b * SEQ + (C * 4 + j) * 16;
                const bf16* rp = (const bf16*)(ws + WS_RP) + un * 1024 + l15 * 64 + 8 * g;
                const bf16x8 rf0 = __builtin_nontemporal_load((const bf16x8*)rp), rf1 = __builtin_nontemporal_load((const bf16x8*)(rp + 32));
                f32x4 y[4];
#pragma unroll
                for (int sl = 0; sl < 4; ++sl) y[sl] = __builtin_nontemporal_load((const f32x4*)((const float*)(ws + WS_Y1F) + ((size_t)(un * 4 + sl) * 64 + lane) * 4));
                const size_t rg = (m0 + ct) * 512 + h * 64 + 8 * cc;
                const u32x4 gl0 = __builtin_nontemporal_load((const u32x4*)((const bf16*)(ws + WS_G) + rg)), gl1 = __builtin_nontemporal_load((const u32x4*)((const bf16*)(ws + WS_G) + rg + 8 * 512));
                const u32x4 ad0 = __builtin_nontemporal_load((const u32x4*)((const bf16*)(ws + WS_ADD) + rg)), ad1 = __builtin_nontemporal_load((const u32x4*)((const bf16*)(ws + WS_ADD) + rg + 8 * 512));
                bf16x8 gf[4][2]; u32x2 hfr[4][4];
                if (j < 3) {
                    const bf16* gp = (const bf16*)(ws + WS_GP) + un * 4096 + l15 * 64 + 8 * g;
#pragma unroll
                    for (int mt = 0; mt < 4; ++mt) { gf[mt][0] = __builtin_nontemporal_load((const bf16x8*)(gp + mt * 1024)); gf[mt][1] = __builtin_nontemporal_load((const bf16x8*)(gp + mt * 1024 + 32)); }
#pragma unroll
                    for (int sl = 0; sl < 4; ++sl)
#pragma unroll
                        for (int mt = 0; mt < 4; ++mt) hfr[sl][mt] = __builtin_nontemporal_load((const u32x2*)((const bf16*)(ws + WS_HF) + ((size_t)((un * 4 + sl) * 4 + mt) * 64 + lane) * 4));
                }
                *(LAS u32x4*)(tGL + ct * 64 + 8 * cc) = gl0; *(LAS u32x4*)(tGL + (ct + 8) * 64 + 8 * cc) = gl1;
                *(LAS u32x4*)(tAD + ct * 64 + 8 * cc) = ad0; *(LAS u32x4*)(tAD + (ct + 8) * 64 + 8 * cc) = ad1;
                bf16x8 zb[4][2];
#pragma unroll
                for (int sl = 0; sl < 4; ++sl) { RW_ZB(z[sl], zb[sl]);
                    y[sl] = __builtin_amdgcn_mfma_f32_16x16x32_bf16(rf0, zb[sl][0], y[sl], 0, 0, 0); y[sl] = __builtin_amdgcn_mfma_f32_16x16x32_bf16(rf1, zb[sl][1], y[sl], 0, 0, 0); }
#pragma unroll
                for (int e = 0; e < 4; ++e) {
                    float s1 = (y[0][e] + y[1][e]) + (y[2][e] + y[3][e]);
                    s1 += __shfl_xor(s1, 1); s1 += __shfl_xor(s1, 2); s1 += __shfl_xor(s1, 4); s1 += __shfl_xor(s1, 8);
                    const float mean = s1 * (1.0f / 64.0f);
                    float d0 = y[0][e] - mean, d1 = y[1][e] - mean, d2 = y[2][e] - mean, d3 = y[3][e] - mean;
                    float s2 = (d0 * d0 + d1 * d1) + (d2 * d2 + d3 * d3);
                    s2 += __shfl_xor(s2, 1); s2 += __shfl_xor(s2, 2); s2 += __shfl_xor(s2, 4); s2 += __shfl_xor(s2, 8);
                    const float rstd = rsq_f(s2 * (1.0f / 64.0f) + GN_EPS);
                    const float dd[4] = {d0, d1, d2, d3};
#pragma unroll
                    for (int sl = 0; sl < 4; ++sl) { const int ti_ = (4 * g + e) * 64 + 16 * sl + l15;
                        const float o = dd[sl] * rstd * bf2f(tGL[ti_]) + bf2f(tAD[ti_]); tOUT[ti_] = (bf16)f2bf(o); }
                }
                { bf16* cp = CAT + (m0 + ct) * 1024 + 512 + h * 64 + 8 * cc;
                  *(u32x4*)cp = *(const LAS u32x4*)(tOUT + ct * 64 + 8 * cc); *(u32x4*)(cp + 8 * 1024) = *(const LAS u32x4*)(tOUT + (ct + 8) * 64 + 8 * cc); }
                if (j < 3) {
#pragma unroll
                    for (int sl = 0; sl < 4; ++sl)
#pragma unroll
                        for (int mt = 0; mt < 4; ++mt) { const u32x2 hh = hfr[sl][mt];
                            f32x4 a; a[0] = bflo(hh.x); a[1] = bfhi(hh.x); a[2] = bflo(hh.y); a[3] = bfhi(hh.y);
                            a = __builtin_amdgcn_mfma_f32_16x16x32_bf16(gf[mt][0], zb[sl][0], a, 0, 0, 0); a = __builtin_amdgcn_mfma_f32_16x16x32_bf16(gf[mt][1], zb[sl][1], a, 0, 0, 0); z[sl][mt] = a; }
                }
            }
        }
    }
    SEAM(5);
#undef RW_ZB


    if (IN(6)) { PHASE_IDS;
        pg8::DenseSched S; S.o.init_tiles(M / 256, D / 256, G, bid); S.A = (const char*)CAT; S.B = (const char*)Wout_t; S.tstep = (size_t)256 * D * 2;
        EpiBf16Res<false> E{args.in[I_X], X1, D, (float*)(ws + WS_AP + 2 * MiB), 1.0f, X1F8}; pg8::gemm_phase(lds, D, S, E, wv0);
    }
    SEAM(6);
    if (IN(7)) { PHASE_IDS;
        pg8::BatchBSched S; S.o.init_tiles(M / 256, D / 256, G, bid); S.A = (const char*)X1F8; S.B = (const char*)HN; S.tstep = (size_t)256 * 1024; S.bstep = (size_t)1024 * 1024;
        EpiSoftmax E{(unsigned char*)Qb, 0.0625f * 0.25f, (const float*)(ws + WS_AP + 2 * MiB), (LAS float*)(lds + RING_BYTES + 1024), (LAS float*)(lds + RING_BYTES + 1024 + 4096)};
        pg8::gemm_phase<EpiSoftmax, pg8::BatchBSched, true, true>(lds, 512, S, E, wv0);
    }
    SEAM(7);
    if (IN(8)) { PHASE_IDS;
        pg8::BatchBSched S; S.o.init_tiles(M / 256, D / 256, G, bid); S.A = (const char*)Qb; S.B = (const char*)(HN + (size_t)4 * 1024 * 1024); S.tstep = (size_t)256 * 1024; S.bstep = (size_t)1024 * 1024;
        EpiBf16Res<true> E{X1, X2, D, nullptr, 1.0f / 1024.0f, nullptr}; pg8::gemm_phase<EpiBf16Res<true>, pg8::BatchBSched, true, true>(lds, 512, S, E, wv0);
    }
    SEAM(8);
    if (IN(9)) { PHASE_IDS;
        for (int cid = tid; cid < 2 * NE * 128; cid += NTHREADS) { const int t = cid >> 12, row = (cid >> 7) & 31, c = cid & 127;
            *(LAS u32x4*)(lds + t * 65536 + row * 2048 + ((c ^ (row & 7)) << 4)) = *(const u32x4*)(WrT + (size_t)t * NE * D + row * D + 8 * c); }
        __syncthreads();
        const int l15 = lane & 15, g = lane >> 4;
        LAS float* LG = (LAS float*)(lds + RING_BYTES + 1024 + wave * 2304);
        const float* gfn = args.in[I_NFFG];
        LAS unsigned* cntl = (LAS unsigned*)(lds + RING_BYTES + 640);
        for (int t0 = 0; t0 < M / 16; t0 += G * 4) {
        if (tid < 64) cntl[tid] = 0u;
        __syncthreads();
        if (t0 == 0 && wave >= 4) {
            constexpr int I_DN = 16 * 32, I_GU = 16 * 64;
            for (int r = bid * 4 + (wave - 4); r < CONV_P9; r += G * 4) { const int e = r / I_GU, q = r % I_GU, kb = q / 64, nb = q % 64; const int n0 = 32 * nb;
                const int drow = n0 < 1024 ? (256 * (n0 >> 7) + (n0 & 127)) : (256 * ((n0 - 1024) >> 7) + 128 + ((n0 - 1024) & 127));
                transpose_item_tiled_fp8_nolds(args.in[I_WGU] + (size_t)e * D * 2048, 2048, D, (unsigned char*)Wgu_t + (size_t)e * 2048 * D, 64 * kb, n0, drow, lane); }
            for (int r = bid * 4 + (wave - 4); r < CONV_P9D; r += G * 4) { const int e = r / I_DN, q = r % I_DN, kb = q / 32, nb = q % 32;
                transpose_item_tiled_fp8_nolds(args.in[I_WDN] + (size_t)e * DFF * D, D, DFF, (unsigned char*)Wdn_t + (size_t)e * D * DFF, 64 * kb, 32 * nb, 32 * nb, lane); }
        }
        const int tile = t0 + bid * 4 + wave; const bool active = wave < 4 && tile < M / 16;
        int me = 0, lpos = 0, ai = 0; float mg = 0.f;
        if (active) {
            const int m0 = tile * 16;
            const bf16* xrow = X2 + (size_t)(m0 + l15) * D + 8 * g;
            float ss = 0.f;
#pragma unroll 8
            for (int ks = 0; ks < 32; ++ks) { const u32x4 xw = *(const u32x4*)(xrow + 32 * ks);
#pragma unroll
                for (int q = 0; q < 4; ++q) { const float a = bflo(xw[q]), c = bfhi(xw[q]); ss += a * a + c * c; } }
            ss += __shfl_xor(ss, 16); ss += __shfl_xor(ss, 32);
            const float rstd = rsq_f(ss * (1.f / D) + EPS);
            f32x4 acc0 = (f32x4){0.f, 0.f, 0.f, 0.f}, acc1 = acc0;
            unsigned char* hrow = (unsigned char*)HN + (size_t)(m0 + l15) * D + 8 * g;
#pragma unroll 2
            for (int ks = 0; ks < 32; ++ks) {
                const f32x4 g0 = *(const f32x4*)(gfn + 32 * ks + 8 * g), g1 = *(const f32x4*)(gfn + 32 * ks + 8 * g + 4);
                const u32x4 xw = *(const u32x4*)(xrow + 32 * ks);
                float hf[8];
#pragma unroll
                for (int q = 0; q < 4; ++q) { hf[2 * q] = bflo(xw[q]) * rstd * (q < 2 ? g0[2 * q] : g1[2 * q - 4]); hf[2 * q + 1] = bfhi(xw[q]) * rstd * (q < 2 ? g0[2 * q + 1] : g1[2 * q - 3]); }
                u32x4 hi, lo;
#pragma unroll
                for (int q = 0; q < 4; ++q) { hi[q] = pk2(hf[2 * q], hf[2 * q + 1]); lo[q] = pk2(hf[2 * q] - bflo(hi[q]), hf[2 * q + 1] - bfhi(hi[q])); }
                { u32x2 h8; h8.x = pk4_fp8(hf[0], hf[1], hf[2], hf[3]); h8.y = pk4_fp8(hf[4], hf[5], hf[6], hf[7]); *(u32x2*)(hrow + 32 * ks) = h8; }
                const bf16x8 ah = __builtin_bit_cast(bf16x8, hi), al = __builtin_bit_cast(bf16x8, lo);
                const int c = 4 * ks + g;
#pragma unroll
                for (int nt = 0; nt < 2; ++nt) { const int row = 16 * nt + l15; const int off = row * 2048 + ((c ^ (row & 7)) << 4);
                    const bf16x8 bh = *(const LAS bf16x8*)(lds + off), bl = *(const LAS bf16x8*)(lds + 65536 + off);
                    f32x4 a = nt ? acc1 : acc0;
                    a = __builtin_amdgcn_mfma_f32_16x16x32_bf16(ah, bh, a, 0, 0, 0); a = __builtin_amdgcn_mfma_f32_16x16x32_bf16(ah, bl, a, 0, 0, 0); a = __builtin_amdgcn_mfma_f32_16x16x32_bf16(al, bh, a, 0, 0, 0);
                    if (nt) acc1 = a; else acc0 = a; }
            }
            { const float b0 = args.in[I_BR][l15], b1 = args.in[I_BR][16 + l15];
#pragma unroll
              for (int j = 0; j < 4; ++j) { LG[(4 * g + j) * 33 + l15] = acc0[j] + b0; LG[(4 * g + j) * 33 + 16 + l15] = acc1[j] + b1; } }
            const int rrow = lane >> 2, qq = lane & 3;
            float tv[4] = {-3.0e38f, -3.0e38f, -3.0e38f, -3.0e38f}; int ti[4] = {64, 65, 66, 67};
#define TOP_INS(xv_, xi_) do { float x_ = (xv_); int i_ = (xi_); _Pragma("unroll") for (int p_ = 0; p_ < 4; ++p_) { const bool b_ = x_ > tv[p_] || (x_ == tv[p_] && i_ < ti[p_]); \
                const float ov_ = tv[p_]; const int oi_ = ti[p_]; tv[p_] = b_ ? x_ : ov_; ti[p_] = b_ ? i_ : oi_; x_ = b_ ? ov_ : x_; i_ = b_ ? oi_ : i_; } } while (0)
#pragma unroll
            for (int j = 0; j < 8; ++j) TOP_INS(LG[rrow * 33 + 8 * qq + j], 8 * qq + j);
#pragma unroll
            for (int st = 1; st < 4; st <<= 1) { float pv[4]; int pi[4];
#pragma unroll
                for (int p = 0; p < 4; ++p) { pv[p] = __shfl_xor(tv[p], st); pi[p] = __shfl_xor(ti[p], st); }
#pragma unroll
                for (int p = 0; p < 4; ++p) TOP_INS(pv[p], pi[p]); }
#undef TOP_INS
            const float e1 = __expf(tv[1] - tv[0]), e2 = __expf(tv[2] - tv[0]), e3 = __expf(tv[3] - tv[0]);
            const float inv = rcp_f(1.0f + e1 + e2 + e3);
            me = qq == 0 ? ti[0] : qq == 1 ? ti[1] : qq == 2 ? ti[2] : ti[3];
            mg = (qq == 0 ? 1.0f : qq == 1 ? e1 : qq == 2 ? e2 : e3) * inv;
            lpos = (int)__hip_atomic_fetch_add(cntl + me, 1u, __ATOMIC_RELAXED, __HIP_MEMORY_SCOPE_WORKGROUP);
            ai = (m0 + rrow) * 4 + qq;
        }
        __syncthreads();
        if (tid < NE) { const unsigned c = cntl[tid]; cntl[32 + tid] = c ? atomicAdd(ecnt + 64 * tid, c) : 0u; }
        __syncthreads();
        if (active) { route_e[ai] = me; route_pos[ai] = (int)cntl[32 + me] + lpos; route_g[ai] = mg; }
        __syncthreads();
        }
    }
    SEAM(9);
    if (IN(10)) { PHASE_IDS;
        LAS int* pst = (LAS int*)lds;
        if (wave == 0) {
            const int c = lane < NE ? (int)__hip_atomic_load(ecnt + 64 * lane, __ATOMIC_RELAXED, __HIP_MEMORY_SCOPE_AGENT) : 0; const int pc = (c + 255) & ~255;
            int x = pc;
#pragma unroll
            for (int d = 1; d < 32; d <<= 1) { const int y = __shfl_up(x, d); if (lane >= d) x += y; }
            if (lane < NE) { pst[lane] = x - pc; pst[64 + lane] = c; } if (lane == NE - 1) pst[32] = x; }
        __syncthreads();
        for (int ai = bid * NTHREADS + tid; ai < NASSIGN; ai += G * NTHREADS) {
            const int e = route_e[ai]; const int row = pst[e] + route_pos[ai]; { u32x2 sg_; sg_.x = (unsigned)ai; sg_.y = __float_as_uint(route_g[ai]); row_sg[row] = sg_; } row_tok[row] = ai >> 2; }
        if (bid < NE) { const int e = bid, c = pst[64 + e], pe = (c + 255) & ~255; for (int p = c + tid; p < pe; p += NTHREADS) { u32x2 sg_; sg_.x = 0xffffffffu; sg_.y = 0u; row_sg[pst[e] + p] = sg_; row_tok[pst[e] + p] = 0; } }
        if (bid == 0 && tid == 0) tile_tab[0] = pst[32] >> 8;
        if (bid >= 128 && bid < 136) { const int nt = pst[32] >> 8, nN = bid < 132 ? 8 : 4; int* tab = (int*)(ws + WS_ROUTE + (bid < 132 ? RT_UGU : RT_UDN));
            for (int L = (bid & 3) * NTHREADS + tid; L < nt * nN; L += 4 * NTHREADS) { Unit uu; { const int nwg = nt * nN; int wgid = L; { const int q = nwg / 8, r = nwg % 8, xcd = wgid % 8, off = wgid / 8; wgid = (xcd < r ? xcd * (q + 1) : r * (q + 1) + (xcd - r) * q) + off; }
                    const int nig = 8 * nN, gid = wgid / nig, fm = gid * 8, gsz = (nt - fm) < 8 ? (nt - fm) : 8; uu.pm = fm + ((wgid % nig) % gsz); uu.pn = (wgid % nig) / gsz; uu.e = 0; }
                int e = 0;
#pragma unroll
                for (int st = 16; st >= 1; st >>= 1) { if ((pst[e + st] >> 8) <= uu.pm) e += st; }
                tab[L] = uu.pm | (uu.pn << 12) | (e << 16); } }
        __syncthreads();
    }
    SEAM(10);
    if (IN(11)) {
        const int ntiles = tile_tab[0];
        pg8::MoeGatherSched S; S.o.init_tiles(ntiles, 2048 / 256, G, bid); S.A = (const char*)HN; S.B = (const char*)Wgu_t; S.tile_e = tile_tab + 16; S.utab = (const int*)(ws + WS_ROUTE + RT_UGU); S.rtok = row_tok; S.tstep = (size_t)256 * 1024; S.estep = (size_t)2048 * 1024;
        EpiSwiglu E{ACT, args.in[I_BGU]}; pg8::gemm_phase<EpiSwiglu, pg8::MoeGatherSched, true, true>(lds, 512, S, E, wv0);
        { PHASE_IDS; LAS float* scr = (LAS float*)(lds + wave * 16384); constexpr int I_DN = 16 * 32;
          for (;;) { int c0 = 0; if (lane == 0) c0 = (int)atomicAdd(ctl + CW_CONV, 8u); c0 = __builtin_amdgcn_readfirstlane(c0);
              c0 += CONV_P9D; if (c0 >= NE * I_DN) break;
              for (int r = c0; r < c0 + 8; ++r) { const int e = r / I_DN, q = r % I_DN, kb = q / 32, nb = q % 32;
                  transpose_item_tiled_fp8(args.in[I_WDN] + (size_t)e * DFF * D, D, DFF, (unsigned char*)Wdn_t + (size_t)e * D * DFF, 64 * kb, 32 * nb, 32 * nb, scr, lane); } } }
    }
    SEAM(11);
    if (IN(12)) {
        const int ntiles = tile_tab[0];
        pg8::MoeSched S; S.o.init_tiles(ntiles, D / 256, G, bid); S.A = (const char*)ACT; S.B = (const char*)Wdn_t; S.tile_e = tile_tab + 16; S.utab = (const int*)(ws + WS_ROUTE + RT_UDN); S.tstep = (size_t)256 * 1024; S.estep = (size_t)1024 * 1024;
        EpiDown E{YS, args.in[I_BDN], row_sg}; pg8::gemm_phase<EpiDown, pg8::MoeSched, true, true>(lds, 512, S, E, wv0);
    }
    SEAM(12);
    if (IN(13)) { PHASE_IDS;
        const float* gfin = args.in[I_FNG];
        for (int m = gw; m < M; m += NGW) {
            float v[16]; float s = 0.f;
#pragma unroll
            for (int hf = 0; hf < 2; ++hf) { const u32x4 w = __builtin_nontemporal_load((const u32x4*)(X2 + (size_t)m * D + 512 * hf + 8 * lane));
#pragma unroll
                for (int q = 0; q < 4; ++q) { v[8 * hf + 2 * q] = bflo(w[q]); v[8 * hf + 2 * q + 1] = bfhi(w[q]); }
#pragma unroll
                for (int k = 0; k < 4; ++k) { const u32x2 y = __builtin_nontemporal_load((const u32x2*)((const unsigned char*)YS + (size_t)(m * 4 + k) * D + 512 * hf + 8 * lane));
#pragma unroll
                    for (int q = 0; q < 2; ++q) { const auto lo2 = __builtin_amdgcn_cvt_pk_f32_fp8((int)y[q], false), hi2 = __builtin_amdgcn_cvt_pk_f32_fp8((int)y[q], true);
                        v[8 * hf + 4 * q] += lo2[0] * 0.0625f; v[8 * hf + 4 * q + 1] += lo2[1] * 0.0625f; v[8 * hf + 4 * q + 2] += hi2[0] * 0.0625f; v[8 * hf + 4 * q + 3] += hi2[1] * 0.0625f; } } }
#pragma unroll
            for (int j = 0; j < 16; ++j) s += v[j] * v[j];
            const float rstd = rsq_f(wave_sum(s) * (1.f / D) + EPS);
#pragma unroll
            for (int hf = 0; hf < 2; ++hf) { const f32x4 g0 = *(const f32x4*)(gfin + 512 * hf + 8 * lane), g1 = *(const f32x4*)(gfin + 512 * hf + 8 * lane + 4);
                float* o = args.out + (size_t)m * D + 512 * hf + 8 * lane;
                __builtin_nontemporal_store((f32x4){v[8 * hf] * rstd * g0.x, v[8 * hf + 1] * rstd * g0.y, v[8 * hf + 2] * rstd * g0.z, v[8 * hf + 3] * rstd * g0.w}, (f32x4*)o);
                __builtin_nontemporal_store((f32x4){v[8 * hf + 4] * rstd * g1.x, v[8 * hf + 5] * rstd * g1.y, v[8 * hf + 6] * rstd * g1.z, v[8 * hf + 7] * rstd * g1.w}, (f32x4*)(o + 4)); }
        }
    }
#undef IN
#undef SEAM
}

constexpr int N_PHASES = 14;
extern "C" void kernel_launch(void* const* d_in, const int* in_sizes, int n_in, void* d_out, int out_size, void* d_ws, size_t ws_size, hipStream_t stream) {
    static int grid = 0;
    if (grid == 0) {
        if (n_in != 37 || out_size != M * D || ws_size < WS_END) { fprintf(stderr, "kernel_launch: unexpected shapes (n_in %d, out %d, ws %zu); nothing launched\n", n_in, out_size, ws_size); grid = -1; return; }
        int dev = 0, cus = 0, per_cu = 0;
        if (hipGetDevice(&dev) != hipSuccess || hipDeviceGetAttribute(&cus, hipDeviceAttributeMultiprocessorCount, dev) != hipSuccess) { grid = -1; return; }
        if (hipFuncSetAttribute((const void*)fwd, hipFuncAttributeMaxDynamicSharedMemorySize, LDS_BYTES) != hipSuccess) { fprintf(stderr, "kernel_launch: hipFuncSetAttribute failed\n"); grid = -1; return; }
        if (hipOccupancyMaxActiveBlocksPerMultiprocessor(&per_cu, (const void*)fwd, NTHREADS, LDS_BYTES) != hipSuccess || per_cu < 1) fprintf(stderr, "kernel_launch: occupancy query says %d\n", per_cu);
        (void)hipGetLastError();
        grid = cus > 256 ? 256 : cus;
    }
    if (grid < 0) return;
    if (hipMemsetAsync((char*)d_ws + WS_CTL, 0, CTL_ZERO_BYTES, stream) != hipSuccess) return;
    Args a{};
    for (int i = 0; i < 37; ++i) a.in[i] = (const float*)d_in[i];
    a.out = (float*)d_out; a.ws = (unsigned char*)d_ws;
#if MK_ONE_LAUNCH
    a.ph_lo = 0; a.ph_hi = N_PHASES;
    hipLaunchKernelGGL(fwd, dim3(grid), dim3(NTHREADS), LDS_BYTES, stream, a);
#else
    for (int p = 0; p < N_PHASES; ++p) { a.ph_lo = p; a.ph_hi = p + 1; hipLaunchKernelGGL(fwd, dim3(grid), dim3(NTHREADS), LDS_BYTES, stream, a);
#ifdef PROBE_REPEAT_PHASE
        if (p == PROBE_REPEAT_PHASE) hipLaunchKernelGGL(fwd, dim3(grid), dim3(NTHREADS), LDS_BYTES, stream, a);
#endif
    }
#endif
}
```

```cpp
#include <hip/hip_runtime.h>
#include <cstdio>
#include <cstdint>

#ifndef MK_ONE_LAUNCH
#define MK_ONE_LAUNCH 1
#endif

#define DI __device__ __forceinline__
#define GAS __attribute__((address_space(1)))
#define LAS __attribute__((address_space(3)))
typedef unsigned short bf16;
typedef short bf16x8 __attribute__((ext_vector_type(8)));
typedef int v4i __attribute__((ext_vector_type(4)));
typedef int v8i __attribute__((ext_vector_type(8)));
typedef float f32x4 __attribute__((ext_vector_type(4)));
typedef float f32x2 __attribute__((ext_vector_type(2)));
typedef unsigned u32x4 __attribute__((ext_vector_type(4)));
typedef unsigned u32x2 __attribute__((ext_vector_type(2)));

constexpr int D = 1024, NB = 4, SEQ = 4096, M = NB * SEQ;
constexpr int MEML = 256, MROWS = NB * MEML;
constexpr int LRU_W = 512, RW = 512, NH = 8, HD = 64;
constexpr int INW = 2816;
constexpr int XH = 4, XHD = 256;
constexpr int NE = 32, TOPK = 4, DFF = 1024;
constexpr int NASSIGN = M * TOPK;
constexpr int MAXTILES = 288, MAXROWS = MAXTILES * 256;
constexpr float EPS = 1e-6f, GN_EPS = 64e-5f;

DI int fresh_tid_(int wv) { int w = wv; asm volatile("" : "+s"(w)); int l; asm volatile("v_mbcnt_lo_u32_b32 %0, -1, 0\n\tv_mbcnt_hi_u32_b32 %0, -1, %0" : "=v"(l)); return (w << 6) | (l & 63); }
#define fresh_tid() fresh_tid_(wv0)
namespace pg8 {
constexpr int BM = 256, BK = 64, HALF = 128, HTB = HALF * BK * 2, STAGE_BYTES = 8 * HTB, NXCD = 8, WGM = 8;
__host__ __device__ __forceinline__ int lds_byte(int r, int c) { const int st = (r >> 4) * 2 + (c >> 5), rr = r & 15, cc = c & 31, ob = rr * 64 + cc * 2; return st * 1024 + (ob ^ (((ob >> 9) & 1) << 5)); }
__host__ __device__ __forceinline__ void stage_rc(int b, int& R, int& C) { const int st = b / 1024, sb = b % 1024, swz = sb ^ (((sb >> 9) & 1) << 5); R = (st >> 1) * 16 + swz / 64; C = (st & 1) * 32 + (swz % 64) / 2; }
__host__ __device__ __forceinline__ int perm32(int rho) { const int n = rho >> 4, i = rho & 15; return 8 * (i >> 2) + 4 * n + (i & 3); }

struct Unit { int pm, pn, e; };

struct StaticOrder {
    int nM, nN, nwg, G, c;
    __host__ __device__ void init_tiles(int nM_, int nN_, int G_, int c_) { nM = nM_; nN = nN_; nwg = nM * nN; G = G_; c = c_; }
    __host__ __device__ bool next(int i, Unit& u) const {
        const long L = (long)i * G + c; if (L >= nwg) return false;
        int wgid = (int)L; { const int q = nwg / NXCD, r = nwg % NXCD, xcd = wgid % NXCD, off = wgid / NXCD; wgid = (xcd < r ? xcd * (q + 1) : r * (q + 1) + (xcd - r) * q) + off; }
        const int nig = WGM * nN, gid = wgid / nig, fm = gid * WGM, gsz = (nM - fm) < WGM ? (nM - fm) : WGM;
        u.pm = fm + ((wgid % nig) % gsz); u.pn = (wgid % nig) / gsz; u.e = 0; return true;
    }
};
struct DenseSched {
    static constexpr bool GATHER = false, B_TILED = false;
    StaticOrder o; const char* A; const char* B; size_t tstep;
    DI bool next(int i, Unit& u) const { return o.next(i, u); }
    DI const char* a_ptr(const Unit& u) const { return A + (size_t)u.pm * tstep; }
    DI const char* b_ptr(const Unit& u) const { return B + (size_t)u.pn * tstep; }
    DI void a_voff(const Unit&, int K, const int (&R)[2], const int (&C)[2], unsigned (&vo)[2][2]) const {
#pragma unroll
        for (int h = 0; h < 2; ++h)
#pragma unroll
            for (int i = 0; i < 2; ++i) vo[h][i] = (unsigned)((h * HALF + R[i]) * K + C[i]) * 2u; }
};
struct MoeSched {
    static constexpr bool GATHER = false, B_TILED = true;
    StaticOrder o; const char* A; const char* B; const int* tile_e; const int* utab; size_t tstep, estep;
    DI bool next(int i, Unit& u) const { const int L = i * o.G + o.c; if (L >= o.nwg) return false; int en; asm volatile("s_load_dword %0, %1, 0x0\n\ts_waitcnt lgkmcnt(0)" : "=s"(en) : "s"(utab + L) : "memory");     u.pm = en & 0xfff; u.pn = (en >> 12) & 15; u.e = en >> 16; return true; }
    DI const char* a_ptr(const Unit& u) const { return A + (size_t)u.pm * tstep; }
    DI const char* b_ptr(const Unit& u) const { return B + (size_t)u.e * estep + (size_t)u.pn * tstep; }
    DI void a_voff(const Unit&, int K, const int (&R)[2], const int (&C)[2], unsigned (&vo)[2][2]) const {
#pragma unroll
        for (int h = 0; h < 2; ++h)
#pragma unroll
            for (int i = 0; i < 2; ++i) vo[h][i] = (unsigned)((h * HALF + R[i]) * K + C[i]) * 2u; }
};
struct MoeGatherSched {
    static constexpr bool GATHER = true, B_TILED = true;
    StaticOrder o; const char* A; const char* B; const int* tile_e; const int* utab; const int* rtok; size_t tstep, estep;
    DI bool next(int i, Unit& u) const { const int L = i * o.G + o.c; if (L >= o.nwg) return false; int en; asm volatile("s_load_dword %0, %1, 0x0\n\ts_waitcnt lgkmcnt(0)" : "=s"(en) : "s"(utab + L) : "memory");     u.pm = en & 0xfff; u.pn = (en >> 12) & 15; u.e = en >> 16; return true; }
    DI const char* a_ptr(const Unit&) const { return A; }
    DI const char* b_ptr(const Unit& u) const { return B + (size_t)u.e * estep + (size_t)u.pn * tstep; }
    DI void a_voff(const Unit& u, int K, const int (&R)[2], const int (&C)[2], unsigned (&vo)[2][2]) const {
#pragma unroll
        for (int h = 0; h < 2; ++h)
#pragma unroll
            for (int i = 0; i < 2; ++i) vo[h][i] = (unsigned)(rtok[u.pm * BM + h * HALF + R[i]] * K + C[i]) * 2u; }
};

struct BatchBSched {
    static constexpr bool GATHER = false, B_TILED = false;
    StaticOrder o; const char* A; const char* B; size_t tstep, bstep;
    DI bool next(int i, Unit& u) const { return o.next(i, u); }
    DI const char* a_ptr(const Unit& u) const { return A + (size_t)u.pm * tstep; }
    DI const char* b_ptr(const Unit& u) const { return B + (size_t)(u.pm >> 4) * bstep + (size_t)u.pn * tstep; }
    DI void a_voff(const Unit&, int K, const int (&R)[2], const int (&C)[2], unsigned (&vo)[2][2]) const {
#pragma unroll
        for (int h = 0; h < 2; ++h)
#pragma unroll
            for (int i = 0; i < 2; ++i) vo[h][i] = (unsigned)((h * HALF + R[i]) * K + C[i]) * 2u; }
};
template <int MODE> struct FoldSched {
    static constexpr bool GATHER = false, B_TILED = false;
    const char* A; const char* B; int G, c;
    DI bool next(int i, Unit& u) const { const int L = i * G + c; if (L >= 64) return false; u.pm = L >> 2; u.pn = L & 3; u.e = 0; return true; }
    DI const char* a_ptr(const Unit& u) const { const int b = u.pm >> 2, h = u.pm & 3; return A + ((size_t)(MODE == 0 ? b * 256 : u.pn * 256) * 1024 + h * 256) * 2; }
    DI const char* b_ptr(const Unit& u) const { const int b = u.pm >> 2, h = u.pm & 3; return B + ((size_t)(MODE == 0 ? u.pn * 256 : b * 256) * 1024 + h * 256) * 2; }
    DI void a_voff(const Unit&, int K, const int (&R)[2], const int (&C)[2], unsigned (&vo)[2][2]) const {
#pragma unroll
        for (int h = 0; h < 2; ++h)
#pragma unroll
            for (int i = 0; i < 2; ++i) vo[h][i] = (unsigned)((h * HALF + R[i]) * K + C[i]) * 2u; }
};

DI unsigned cvt_pk_bf16(float lo, float hi) { unsigned r; asm volatile("v_cvt_pk_bf16_f32 %0, %1, %2" : "=v"(r) : "v"(lo), "v"(hi)); return r; }

template <class Epi, class Sched, bool ALIGN_EPI = true, bool FP8 = false>
DI void gemm_phase(LAS unsigned char* lds, const int K, const Sched& S, const Epi& E, const int wv0, const int ldp = 0) {
    const int ld = ldp ? ldp : K;
    const int tid = fresh_tid(), wid = __builtin_amdgcn_readfirstlane(tid >> 6), lane = tid & 63, wr = wid >> 2, wc = wid & 3, fr = lane & 15, fq = lane >> 4;
    const int nt = K / BK;
    constexpr bool GA = Sched::GATHER, BT = Sched::B_TILED;
    unsigned voffA[2][2], voffAn[2][2], voffB[2];
#pragma unroll
    for (int i = 0; i < 2; ++i) { int R, C; stage_rc(tid * 16 + i * 8192, R, C); const int Rb = Epi::PERM ? ((R & ~31) + perm32(R & 31)) : R;
        voffB[i] = BT ? (unsigned)(tid * 16 + i * 8192) : (unsigned)(Rb * ld + C) * 2u; }
#define PG8_AVOFF(unit, dst) do { int sR[2], sC[2]; const int t2_ = fresh_tid(); stage_rc(t2_ * 16, sR[0], sC[0]); stage_rc(t2_ * 16 + 8192, sR[1], sC[1]); S.a_voff(unit, ld, sR, sC, dst); } while (0)
    const size_t kstep = (size_t)(BK * 2);
    const size_t hstep = (size_t)HALF * ld * 2;
    const size_t kstepB = BT ? (size_t)(2 * HTB) : kstep, hstepB = BT ? (size_t)HTB : hstep;
    const unsigned ldsw = (unsigned)wid * 1024u;
    unsigned aoffv = (unsigned)(size_t)lds + (unsigned)lds_byte(wr * 64 + fr, fq * 8), boffv = (unsigned)(size_t)lds + (unsigned)(4 * HTB) + (unsigned)lds_byte(wc * 32 + fr, fq * 8);
    asm volatile("" : "+v"(aoffv), "+v"(boffv));
    const size_t dB = BT ? (size_t)8192 : (size_t)64 * ld * 2, dA = (size_t)64 * ld * 2;
#define PG8_SA(b, h) (((b) * 2 + (h)) * HTB)
#define PG8_SB(b, h) ((4 + (b) * 2 + (h)) * HTB)
    const unsigned ldsbase = (unsigned)__builtin_amdgcn_readfirstlane((int)((unsigned)(size_t)lds + ldsw));
#define PG8_STAGE1(bufoff, gptr, vo, i_) do { const unsigned m0v_ = ldsbase + (unsigned)(bufoff) + (unsigned)(i_) * 8192u; \
        asm volatile("s_mov_b32 m0, %2\n\ts_nop 0\n\tglobal_load_lds_dwordx4 %0, %1" :: "v"(vo), "s"((const char*)(gptr)), "s"(m0v_) : "memory", "m0"); } while (0)
#define PG8_STAGE(bufoff, gbase, voff) do { PG8_STAGE1(bufoff, gbase, (voff)[0], 0); PG8_STAGE1(bufoff, gbase, (voff)[1], 1); } while (0)
#define PG8_STAGE_D(bufoff, gbase, vo, delta) do { PG8_STAGE1(bufoff, gbase, vo, 0); PG8_STAGE1(bufoff, (const char*)(gbase) + (delta), vo, 1); } while (0)
#define PG8_LDA(dst, b, h) do { if constexpr (FP8) { _Pragma("unroll") for (int m = 0; m < 4; ++m) { const LAS v4i* p_ = (const LAS v4i*)((LAS unsigned char*)(size_t)aoffv + PG8_SA(b, h) + m * 2048); dst##8[m] = __builtin_shufflevector(p_[0], p_[64], 0, 1, 2, 3, 4, 5, 6, 7); } } \
        else { _Pragma("unroll") for (int m = 0; m < 4; ++m) _Pragma("unroll") for (int k = 0; k < 2; ++k) dst[m][k] = *(const LAS bf16x8*)((LAS unsigned char*)(size_t)aoffv + PG8_SA(b, h) + m * 2048 + k * 1024); } } while (0)
#define PG8_LDB(dst, b, h) do { if constexpr (FP8) { _Pragma("unroll") for (int n = 0; n < 2; ++n) { const LAS v4i* p_ = (const LAS v4i*)((LAS unsigned char*)(size_t)boffv + (PG8_SB(b, h) - 4 * HTB) + n * 2048); dst##8[n] = __builtin_shufflevector(p_[0], p_[64], 0, 1, 2, 3, 4, 5, 6, 7); } } \
        else { _Pragma("unroll") for (int n = 0; n < 2; ++n) _Pragma("unroll") for (int k = 0; k < 2; ++k) dst[n][k] = *(const LAS bf16x8*)((LAS unsigned char*)(size_t)boffv + (PG8_SB(b, h) - 4 * HTB) + n * 2048 + k * 1024); } } while (0)
#define PG8_MMA(ai, bj, At, Bt) do { __builtin_amdgcn_s_setprio(1); \
        if constexpr (FP8) {   \
            _Pragma("unroll") for (int m = 0; m < 4; ++m) _Pragma("unroll") for (int n = 0; n < 2; ++n) \
                acc[ai][bj][m][n] = __builtin_amdgcn_mfma_scale_f32_16x16x128_f8f6f4(Bt##8[n], At##8[m], acc[ai][bj][m][n], 0, 0, 0, 0, 0, 0); } \
        else { _Pragma("unroll") for (int m = 0; m < 4; ++m) _Pragma("unroll") for (int n = 0; n < 2; ++n) _Pragma("unroll") for (int k = 0; k < 2; ++k) \
            acc[ai][bj][m][n] = __builtin_amdgcn_mfma_f32_16x16x32_bf16(Bt[n][k], At[m][k], acc[ai][bj][m][n], 0, 0, 0); } \
        __builtin_amdgcn_s_setprio(0); } while (0)
#define PG8_WAIT_V(n) asm volatile("s_waitcnt vmcnt(" #n ")" ::: "memory")
#define PG8_WAIT_L(n) asm volatile("s_waitcnt lgkmcnt(" #n ")" ::: "memory")
#define PG8_BAR __builtin_amdgcn_s_barrier()
#define PG8_SCHED __builtin_amdgcn_sched_barrier(0)
    Unit cur, nxt; int ui = 0;
    if (!S.next(0, cur)) return;
    f32x4 acc[2][2][4][2];
#pragma unroll
    for (int a = 0; a < 2; ++a)
#pragma unroll
        for (int b = 0; b < 2; ++b)
#pragma unroll
            for (int m = 0; m < 4; ++m)
#pragma unroll
                for (int n = 0; n < 2; ++n) acc[a][b][m][n] = (f32x4){0.f, 0.f, 0.f, 0.f};
    bf16x8 At[4][2], B0[2][2], B1[2][2]; v8i At8[4], B08[2], B18[2];
    const char* cA = S.a_ptr(cur); const char* cB = S.b_ptr(cur);
    PG8_AVOFF(cur, voffA);
#define PG8_STAGE_A(bufoff, kbase, h, vo) do { if constexpr (GA) { PG8_STAGE(bufoff, kbase, (vo)[h]); } else { PG8_STAGE_D(bufoff, (kbase) + (h) * hstep, voffA[0][0], dA); } } while (0)
    PG8_STAGE_D(PG8_SB(0, 0), cB, voffB[0], dB); PG8_STAGE_D(PG8_SB(0, 1), cB + hstepB, voffB[0], dB); PG8_STAGE_A(PG8_SA(0, 0), cA, 0, voffA); PG8_STAGE_A(PG8_SA(0, 1), cA, 1, voffA);
    if (wr == 1) PG8_BAR;
    PG8_WAIT_V(2); PG8_BAR;
    PG8_STAGE_D(PG8_SB(1, 0), cB + kstepB, voffB[0], dB); PG8_STAGE_A(PG8_SA(1, 0), cA + kstep, 0, voffA); PG8_STAGE_D(PG8_SB(1, 1), cB + hstepB + kstepB, voffB[0], dB);
    PG8_WAIT_V(6); PG8_BAR;
    for (;;) {
        const bool has_next = S.next(ui + 1, nxt);
        const char* nA = has_next ? S.a_ptr(nxt) : cA; const char* nB = has_next ? S.b_ptr(nxt) : cB;
        if constexpr (GA) { if (has_next) PG8_AVOFF(nxt, voffAn);
            else {
#pragma unroll
                for (int h = 0; h < 2; ++h)
#pragma unroll
                    for (int i = 0; i < 2; ++i) voffAn[h][i] = voffA[h][i]; } }
#pragma unroll 1
        for (int t = 0; t < nt; t += 2) {
            const bool last = (t == nt - 2);
            const char* a1 = cA + (size_t)(t + 1) * kstep;
            const char* a2 = last ? nA : cA + (size_t)(t + 2) * kstep; const char* b2 = last ? nB : cB + (size_t)(t + 2) * kstepB;
            const char* a3 = a2 + kstep; const char* b3 = b2 + kstepB;
            PG8_LDB(B0, 0, 0); PG8_LDB(B1, 0, 1); PG8_SCHED; PG8_LDA(At, 0, 0); PG8_STAGE_A(PG8_SA(1, 1), a1, 1, voffA);
            if constexpr (GA) { if (last) {
#pragma unroll
                for (int h = 0; h < 2; ++h)
#pragma unroll
                    for (int i = 0; i < 2; ++i) voffA[h][i] = voffAn[h][i]; } }
            PG8_WAIT_V(8); PG8_WAIT_L(0); PG8_BAR; PG8_MMA(0, 0, At, B0); PG8_MMA(0, 1, At, B1); PG8_BAR; PG8_SCHED;
            PG8_LDA(At, 0, 1); PG8_STAGE_D(PG8_SB(0, 0), b2, voffB[0], dB); PG8_STAGE_D(PG8_SB(0, 1), b2 + hstepB, voffB[0], dB); PG8_STAGE_A(PG8_SA(0, 0), a2, 0, voffA);
            PG8_WAIT_V(8); PG8_WAIT_L(0); PG8_BAR; PG8_MMA(1, 0, At, B0); PG8_MMA(1, 1, At, B1); PG8_BAR; PG8_SCHED;
            PG8_LDB(B0, 1, 0); PG8_LDB(B1, 1, 1); PG8_SCHED; PG8_LDA(At, 1, 0); PG8_STAGE_A(PG8_SA(0, 1), a2, 1, voffA);
            PG8_WAIT_V(8); PG8_WAIT_L(0); PG8_BAR; PG8_MMA(0, 0, At, B0); PG8_MMA(0, 1, At, B1); PG8_BAR; PG8_SCHED;
            PG8_LDA(At, 1, 1); PG8_STAGE_D(PG8_SB(1, 0), b3, voffB[0], dB); PG8_STAGE_D(PG8_SB(1, 1), b3 + hstepB, voffB[0], dB); PG8_STAGE_A(PG8_SA(1, 0), a3, 0, voffA);
            PG8_WAIT_V(8); PG8_WAIT_L(0); PG8_BAR; PG8_MMA(1, 0, At, B0); PG8_MMA(1, 1, At, B1); PG8_BAR; PG8_SCHED;
        }
        if constexpr (ALIGN_EPI) { if (wr == 0) PG8_BAR; }
        { Unit ue = cur; ue.pm = __builtin_amdgcn_readfirstlane(ue.pm); ue.pn = __builtin_amdgcn_readfirstlane(ue.pn); ue.e = __builtin_amdgcn_readfirstlane(ue.e); asm volatile("" : "+s"(ue.pm), "+s"(ue.pn), "+s"(ue.e));
          const int t3_ = fresh_tid(); const int fr_ = t3_ & 15, fq_ = (t3_ & 63) >> 4;
          E(acc, ue, wr, wc, fr_, fq_); }
        if (!has_next) break;
#pragma unroll
        for (int a = 0; a < 2; ++a)
#pragma unroll
            for (int b = 0; b < 2; ++b)
#pragma unroll
                for (int m = 0; m < 4; ++m)
#pragma unroll
                    for (int n = 0; n < 2; ++n) acc[a][b][m][n] = (f32x4){0.f, 0.f, 0.f, 0.f};
        cur = nxt; cA = nA; cB = nB; ++ui;
        if constexpr (ALIGN_EPI) { if (wr == 1) PG8_BAR; }
    }
    PG8_WAIT_V(0);
    if constexpr (!ALIGN_EPI) { if (wr == 0) PG8_BAR; }
    PG8_BAR;
#undef PG8_SA
#undef PG8_SB
#undef PG8_STAGE
#undef PG8_STAGE1
#undef PG8_STAGE_D
#undef PG8_STAGE_A
#undef PG8_AVOFF
#undef PG8_LDA
#undef PG8_LDB
#undef PG8_MMA
#undef PG8_WAIT_V
#undef PG8_WAIT_L
#undef PG8_BAR
#undef PG8_SCHED
}
}
using pg8::Unit;
using pg8::cvt_pk_bf16;

DI float bflo(unsigned w) { return __uint_as_float(w << 16); }
DI float bfhi(unsigned w) { return __uint_as_float(w & 0xffff0000u); }
DI float bf2f(bf16 b) { return __uint_as_float(((unsigned)b) << 16); }
typedef __bf16 hwbf2 __attribute__((ext_vector_type(2)));
DI unsigned pk2(float lo, float hi) { const f32x2 v = {lo, hi}; return __builtin_bit_cast(unsigned, __builtin_convertvector(v, hwbf2)); }
DI unsigned f2bf(float f) { return pk2(f, 0.f) & 0xffffu; }
DI float rcp_f(float x) { return __builtin_amdgcn_rcpf(x); }
DI float rsq_f(float x) { return __builtin_amdgcn_rsqf(x); }
DI float sigmoid_f(float x) { return rcp_f(1.0f + __expf(-x)); }
DI float tanh_fast(float x) { return 1.0f - 2.0f * rcp_f(__expf(2.0f * x) + 1.0f); }
DI float softplus_f(float x) { return fmaxf(x, 0.f) + __logf(1.0f + __expf(-fabsf(x))); }
DI float softplus_fast(float x) { return fmaxf(x, 0.f) + __logf(1.0f + __expf(-fabsf(x))); }
DI float gelu_tanh_f(float x) { const float u = 0.7978845608028654f * (x + 0.044715f * x * x * x); return 0.5f * x * (1.0f + tanh_fast(u)); }
DI float wave_sum(float v) {
#pragma unroll
    for (int o = 1; o < 64; o <<= 1) v += __shfl_xor(v, o);
    return v;
}

DI unsigned pk4_fp8(float a, float b, float c, float d) { int w = 0; w = __builtin_amdgcn_cvt_pk_fp8_f32(a, b, w, false); w = __builtin_amdgcn_cvt_pk_fp8_f32(c, d, w, true); return (unsigned)w; }
struct EpiBf16Plain {
    static constexpr bool PERM = true;
    bf16* O; int ldc; float scale;
    DI void operator()(const f32x4 (&acc)[2][2][4][2], const Unit& u, int wr, int wc, int fr, int fq) const {
        const int row0 = u.pm * 256 + wr * 64 + fr, col0 = u.pn * 256 + wc * 32 + 8 * fq;
#pragma unroll
        for (int ai = 0; ai < 2; ++ai)
#pragma unroll
            for (int m = 0; m < 4; ++m) { bf16* rowp = O + (size_t)(row0 + ai * 128 + m * 16) * ldc + col0;
#pragma unroll
                for (int bj = 0; bj < 2; ++bj) { const f32x4 v0 = acc[ai][bj][m][0] * scale, v1 = acc[ai][bj][m][1] * scale;
                    u32x4 w; w.x = cvt_pk_bf16(v0[0], v0[1]); w.y = cvt_pk_bf16(v0[2], v0[3]); w.z = cvt_pk_bf16(v1[0], v1[1]); w.w = cvt_pk_bf16(v1[2], v1[3]);
                    *(u32x4*)(rowp + bj * 128) = w; } }
    }
};
template <int MODE> struct EpiFold {
    static constexpr bool PERM = true;
    unsigned char* O;
    DI void operator()(const f32x4 (&acc)[2][2][4][2], const Unit& u, int wr, int wc, int fr, int fq) const {
        const int b = u.pm >> 2, h = u.pm & 3;
        const int rbase = MODE == 0 ? h * 256 : u.pn * 256, cbase = MODE == 0 ? u.pn * 256 : h * 256;
        const unsigned boff = (unsigned)b * 1024u * 1024u + (unsigned)(rbase + wr * 64 + fr) * 1024u + (unsigned)(cbase + wc * 32 + 8 * fq);
#pragma unroll
        for (int ai = 0; ai < 2; ++ai)
#pragma unroll
            for (int m = 0; m < 4; ++m) { unsigned char* rowp = O + (boff + (unsigned)(ai * 128 + m * 16) * 1024u);
#pragma unroll
                for (int bj = 0; bj < 2; ++bj) { const f32x4 v0 = acc[ai][bj][m][0] * 4.0f, v1 = acc[ai][bj][m][1] * 4.0f;
                    u32x2 w; w.x = pk4_fp8(v0[0], v0[1], v0[2], v0[3]); w.y = pk4_fp8(v1[0], v1[1], v1[2], v1[3]);
                    *(u32x2*)(rowp + bj * 128) = w; } }
    }
};
struct EpiSoftmax {
    static constexpr bool PERM = true;
    unsigned char* O; float scale; const float* RS; LAS float* XM; LAS float* XS;
    DI void operator()(const f32x4 (&acc)[2][2][4][2], const Unit& u, int wr, int wc, int fr, int fq) const {
        const int row0 = u.pm * 256 + wr * 64 + fr, col0 = u.pn * 256 + wc * 32 + 8 * fq;
        float sc[2][4];
#pragma unroll
        for (int ai = 0; ai < 2; ++ai)
#pragma unroll
            for (int m = 0; m < 4; ++m) { const int r = row0 + ai * 128 + m * 16; const f32x4* rp = (const f32x4*)(RS + (size_t)r * 16);
                const f32x4 p0 = rp[0], p1 = rp[1], p2 = rp[2], p3 = rp[3];
                const float ss = ((p0[0] + p0[1]) + (p0[2] + p0[3])) + ((p1[0] + p1[1]) + (p1[2] + p1[3])) + ((p2[0] + p2[1]) + (p2[2] + p2[3])) + ((p3[0] + p3[1]) + (p3[2] + p3[3]));
                sc[ai][m] = scale * __builtin_amdgcn_rsqf(ss * (1.0f / 1024.0f) + 1e-6f);
                float mm = -3.0e38f;
#pragma unroll
                for (int bj = 0; bj < 2; ++bj)
#pragma unroll
                    for (int n = 0; n < 2; ++n) { const f32x4 v = acc[ai][bj][m][n]; mm = fmaxf(mm, fmaxf(fmaxf(v[0], v[1]), fmaxf(v[2], v[3]))); }
                mm *= sc[ai][m];
                mm = fmaxf(mm, __shfl_xor(mm, 16)); mm = fmaxf(mm, __shfl_xor(mm, 32));
                if (fq == 0) XM[(ai * 128 + wr * 64 + m * 16 + fr) * 4 + wc] = mm; }
        asm volatile("s_waitcnt lgkmcnt(0)" ::: "memory"); __builtin_amdgcn_s_barrier(); asm volatile("" ::: "memory");
        f32x4 (&pa)[2][2][4][2] = const_cast<f32x4 (&)[2][2][4][2]>(acc);
#pragma unroll
        for (int ai = 0; ai < 2; ++ai)
#pragma unroll
            for (int m = 0; m < 4; ++m) { const int lr = ai * 128 + wr * 64 + m * 16 + fr; const f32x4 q = *(const LAS f32x4*)(XM + lr * 4);
                const float mxr = fmaxf(fmaxf(q[0], q[1]), fmaxf(q[2], q[3])); float sm = 0.f;
#pragma unroll
                for (int bj = 0; bj < 2; ++bj)
#pragma unroll
                    for (int n = 0; n < 2; ++n)
#pragma unroll
                        for (int j = 0; j < 4; ++j) { const float p = __expf(acc[ai][bj][m][n][j] * sc[ai][m] - mxr); pa[ai][bj][m][n][j] = p; sm += p; }
                sm += __shfl_xor(sm, 16); sm += __shfl_xor(sm, 32);
                if (fq == 0) XS[lr * 4 + wc] = sm; }
        asm volatile("s_waitcnt lgkmcnt(0)" ::: "memory"); __builtin_amdgcn_s_barrier(); asm volatile("" ::: "memory");
#pragma unroll
        for (int ai = 0; ai < 2; ++ai)
#pragma unroll
            for (int m = 0; m < 4; ++m) { const int lr = ai * 128 + wr * 64 + m * 16 + fr; const f32x4 q = *(const LAS f32x4*)(XS + lr * 4);
                const float inv = 256.0f * __builtin_amdgcn_rcpf((q[0] + q[1]) + (q[2] + q[3]));
                unsigned char* rowp = O + (size_t)(row0 + ai * 128 + m * 16) * 1024 + col0;
#pragma unroll
                for (int bj = 0; bj < 2; ++bj) { const f32x4 v0 = pa[ai][bj][m][0] * inv, v1 = pa[ai][bj][m][1] * inv;
                    u32x2 w; w.x = pk4_fp8(v0[0], v0[1], v0[2], v0[3]); w.y = pk4_fp8(v1[0], v1[1], v1[2], v1[3]);
                    *(u32x2*)(rowp + bj * 128) = w; } }
        asm volatile("s_waitcnt lgkmcnt(0)" ::: "memory"); __builtin_amdgcn_s_barrier(); asm volatile("" ::: "memory");
    }
};
struct EpiBf16RowNorm {
    static constexpr bool PERM = true;
    bf16* O; int ldc; float scale; const float* RS;
    DI void operator()(const f32x4 (&acc)[2][2][4][2], const Unit& u, int wr, int wc, int fr, int fq) const {
        const int row0 = u.pm * 256 + wr * 64 + fr, col0 = u.pn * 256 + wc * 32 + 8 * fq;
#pragma unroll
        for (int ai = 0; ai < 2; ++ai)
#pragma unroll
            for (int m = 0; m < 4; ++m) { const int r = row0 + ai * 128 + m * 16; const f32x4* rp = (const f32x4*)(RS + (size_t)r * 16);
                const f32x4 p0 = rp[0], p1 = rp[1], p2 = rp[2], p3 = rp[3];
                const float ss = ((p0[0] + p0[1]) + (p0[2] + p0[3])) + ((p1[0] + p1[1]) + (p1[2] + p1[3])) + ((p2[0] + p2[1]) + (p2[2] + p2[3])) + ((p3[0] + p3[1]) + (p3[2] + p3[3]));
                const float sc = scale * __builtin_amdgcn_rsqf(ss * (1.0f / 1024.0f) + 1e-6f);
                bf16* rowp = O + (size_t)r * ldc + col0;
#pragma unroll
                for (int bj = 0; bj < 2; ++bj) { const f32x4 v0 = acc[ai][bj][m][0] * sc, v1 = acc[ai][bj][m][1] * sc;
                    u32x4 w; w.x = cvt_pk_bf16(v0[0], v0[1]); w.y = cvt_pk_bf16(v0[2], v0[3]); w.z = cvt_pk_bf16(v1[0], v1[1]); w.w = cvt_pk_bf16(v1[2], v1[3]);
                    *(u32x4*)(rowp + bj * 128) = w; } }
    }
};
template <bool RES_BF16> struct EpiBf16Res {
    static constexpr bool PERM = true;
    const void* Rz; bf16* O; int ldc; float* RS; float ascale; unsigned char* O8;
    DI void operator()(const f32x4 (&acc)[2][2][4][2], const Unit& u, int wr, int wc, int fr, int fq) const {
        const int row0 = u.pm * 256 + wr * 64 + fr, col0 = u.pn * 256 + wc * 32 + 8 * fq;
#pragma unroll
        for (int ai = 0; ai < 2; ++ai) {
            u32x4 rwb[4][2]; f32x4 rf0[4][2], rf1[4][2];
#pragma unroll
            for (int m = 0; m < 4; ++m) { const size_t off = (size_t)(row0 + ai * 128 + m * 16) * ldc + col0;
#pragma unroll
                for (int bj = 0; bj < 2; ++bj) {
                    if (RES_BF16) rwb[m][bj] = __builtin_nontemporal_load((const u32x4*)((const bf16*)Rz + off + bj * 128));
                    else { rf0[m][bj] = __builtin_nontemporal_load((const f32x4*)((const float*)Rz + off + bj * 128)); rf1[m][bj] = __builtin_nontemporal_load((const f32x4*)((const float*)Rz + off + bj * 128 + 4)); } } }
#pragma unroll
            for (int m = 0; m < 4; ++m) { const size_t off = (size_t)(row0 + ai * 128 + m * 16) * ldc + col0; float ssq = 0.f;
#pragma unroll
                for (int bj = 0; bj < 2; ++bj) { f32x4 r0, r1;
                    if (RES_BF16) { const u32x4 rw = rwb[m][bj]; r0 = (f32x4){bflo(rw.x), bfhi(rw.x), bflo(rw.y), bfhi(rw.y)}; r1 = (f32x4){bflo(rw.z), bfhi(rw.z), bflo(rw.w), bfhi(rw.w)}; }
                    else { r0 = rf0[m][bj]; r1 = rf1[m][bj]; }
                    const f32x4 v0 = r0 + acc[ai][bj][m][0] * ascale, v1 = r1 + acc[ai][bj][m][1] * ascale;
                    if (O8) { u32x2 w8; w8.x = pk4_fp8(v0[0], v0[1], v0[2], v0[3]); w8.y = pk4_fp8(v1[0], v1[1], v1[2], v1[3]); *(u32x2*)(O8 + off + bj * 128) = w8; }
                    ssq += (v0[0] * v0[0] + v0[1] * v0[1]) + (v0[2] * v0[2] + v0[3] * v0[3]) + (v1[0] * v1[0] + v1[1] * v1[1]) + (v1[2] * v1[2] + v1[3] * v1[3]);
                    u32x4 w; w.x = cvt_pk_bf16(v0[0], v0[1]); w.y = cvt_pk_bf16(v0[2], v0[3]); w.z = cvt_pk_bf16(v1[0], v1[1]); w.w = cvt_pk_bf16(v1[2], v1[3]);
                    *(u32x4*)(O + off + bj * 128) = w; }
                if (RS) { ssq += __shfl_xor(ssq, 16); ssq += __shfl_xor(ssq, 32); if (fq == 0) RS[(size_t)(row0 + ai * 128 + m * 16) * 16 + u.pn * 4 + wc] = ssq; } } }
    }
};
struct EpiLora {
    static constexpr bool PERM = false;
    float* LWp; bf16* AAp; bf16* GGp; const float* w0; const float* a0;
    DI void operator()(const f32x4 (&acc)[2][2][4][2], const Unit& u, int wr, int wc, int fr, int fq) const {
        const int kind = u.pn >> 1;
        const int row0 = u.pm * 256 + wr * 64 + fr, col0 = (u.pn & 1) * 256 + wc * 32 + 4 * fq;
#pragma unroll
        for (int bj = 0; bj < 2; ++bj)
#pragma unroll
            for (int n = 0; n < 2; ++n) {
                const int c = col0 + bj * 128 + n * 16;
                f32x4 bias = (f32x4){0.f, 0.f, 0.f, 0.f};
                if (kind == 0) bias = *(const f32x4*)(w0 + c); else if (kind == 1) bias = *(const f32x4*)(a0 + c);
#pragma unroll
                for (int ai = 0; ai < 2; ++ai)
#pragma unroll
                    for (int m = 0; m < 4; ++m) {
                        f32x4 v = acc[ai][bj][m][n] + bias;
                        if (kind == 0) {
#pragma unroll
                            for (int j = 0; j < 4; ++j) { const float w = -softplus_fast(-v[j]) - 0.5f; v[j] = -__expf(w);     }
                        } else if (kind == 1) {
#pragma unroll
                            for (int j = 0; j < 4; ++j) v[j] = sigmoid_f(v[j]);
                        }
                        const size_t o_ = (size_t)(row0 + ai * 128 + m * 16) * 512 + c;
                        if (kind == 0) *(f32x4*)(LWp + o_) = v;
                        else { u32x2 w_; w_.x = cvt_pk_bf16(v[0], v[1]); w_.y = cvt_pk_bf16(v[2], v[3]); *(u32x2*)((kind == 1 ? AAp : GGp) + o_) = w_; }
                    }
            }
    }
};
typedef float f32x2_t __attribute__((ext_vector_type(2)));
struct EpiSwiglu {
    static constexpr bool PERM = true;
    bf16* ACT; const float* b_gu;
    DI void operator()(const f32x4 (&acc)[2][2][4][2], const Unit& u, int wr, int wc, int fr, int fq) const {
        const int row0 = u.pm * 256 + wr * 64 + fr, j0 = u.pn * 128 + wc * 32 + 8 * fq;
        const float* bg = b_gu + (size_t)u.e * 2048 + j0; const float* bu = bg + 1024;
        const f32x4 bg0 = *(const f32x4*)bg, bg1 = *(const f32x4*)(bg + 4), bu0 = *(const f32x4*)bu, bu1 = *(const f32x4*)(bu + 4);
#pragma unroll
        for (int ai = 0; ai < 2; ++ai)
#pragma unroll
            for (int m = 0; m < 4; ++m) {
                float o[8];
#pragma unroll
                for (int n = 0; n < 2; ++n) { const f32x4 g4 = acc[ai][0][m][n] * 0.015625f + (n ? bg1 : bg0), u4 = acc[ai][1][m][n] * 0.015625f + (n ? bu1 : bu0);
#pragma unroll
                    for (int p = 0; p < 2; ++p) {
                        f32x2_t g, up; g.x = fminf(g4[2 * p], 7.0f); g.y = fminf(g4[2 * p + 1], 7.0f); up.x = fminf(fmaxf(u4[2 * p], -7.0f), 7.0f); up.y = fminf(fmaxf(u4[2 * p + 1], -7.0f), 7.0f);
                        const f32x2_t ex = g * (-1.702f * 1.44269504089f); f32x2_t d; d.x = __builtin_amdgcn_exp2f(ex.x); d.y = __builtin_amdgcn_exp2f(ex.y); d = d + 1.0f;
                        f32x2_t r; r.x = __builtin_amdgcn_rcpf(d.x); r.y = __builtin_amdgcn_rcpf(d.y);
                        const f32x2_t ov = (up + 1.0f) * (g * r); o[n * 4 + 2 * p] = ov.x; o[n * 4 + 2 * p + 1] = ov.y; } }
                u32x2 w; w.x = pk4_fp8(o[0], o[1], o[2], o[3]); w.y = pk4_fp8(o[4], o[5], o[6], o[7]);
                *(u32x2*)((unsigned char*)ACT + (size_t)(row0 + ai * 128 + m * 16) * 1024 + j0) = w;
            }
    }
};
struct EpiDown {
    static constexpr bool PERM = true;
    bf16* YS; const float* b_dn; const u32x2* row_sg;
    DI void operator()(const f32x4 (&acc)[2][2][4][2], const Unit& u, int wr, int wc, int fr, int fq) const {
        const int row0 = u.pm * 256 + wr * 64 + fr, col0 = u.pn * 256 + wc * 32 + 8 * fq;
        const float* bb = b_dn + (size_t)u.e * 1024 + col0;
        f32x4 bv[2][2];
#pragma unroll
        for (int bj = 0; bj < 2; ++bj)
#pragma unroll
            for (int n = 0; n < 2; ++n) bv[bj][n] = *(const f32x4*)(bb + bj * 128 + 4 * n);
        int slots[8]; float gts[8];
        { const u32x2* sgp = row_sg + row0;
#pragma unroll
        for (int q = 0; q < 8; ++q) { const u32x2 sg = sgp[(q >> 2) * 128 + (q & 3) * 16]; slots[q] = (int)sg.x; gts[q] = __uint_as_float(sg.y); } }
#pragma unroll
        for (int ai = 0; ai < 2; ++ai)
#pragma unroll
            for (int m = 0; m < 4; ++m) {
                const int slot = slots[ai * 4 + m]; const float gt = gts[ai * 4 + m];
                if (slot >= 0) { unsigned char* rowp = (unsigned char*)YS + (size_t)slot * 1024 + col0; const float g16 = gt * 16.0f;
#pragma unroll
                    for (int bj = 0; bj < 2; ++bj) { const f32x4 v0 = (acc[ai][bj][m][0] * 0.015625f + bv[bj][0]) * g16, v1 = (acc[ai][bj][m][1] * 0.015625f + bv[bj][1]) * g16;
                        u32x2 w; w.x = pk4_fp8(v0[0], v0[1], v0[2], v0[3]); w.y = pk4_fp8(v1[0], v1[1], v1[2], v1[3]);
                        *(u32x2*)(rowp + bj * 128) = w; } }
            }
    }
};

constexpr size_t MiB = 1u << 20;
constexpr size_t WS_CTL = 0, CTL_ZERO_BYTES = 1 * MiB;
constexpr size_t WS_WIN = 1 * MiB, WS_WOUT = 7 * MiB, WS_WQ = 9 * MiB, WS_WK = 11 * MiB, WS_WV = 13 * MiB, WS_WO = 15 * MiB, WS_LORAB = 17 * MiB, WS_LRUW = 18 * MiB;
constexpr size_t WS_ROUTE = 19 * MiB;
constexpr size_t WS_WGU = 22 * MiB, WS_WDN = 150 * MiB;
constexpr size_t WS_HN = 214 * MiB, WS_MEMN = 246 * MiB, WS_KM = 248 * MiB, WS_VT = 250 * MiB;
constexpr size_t WS_X1 = 252 * MiB, WS_X2 = 316 * MiB;
constexpr size_t WS_U = 380 * MiB, WS_R = 468 * MiB, WS_KRAW = 500 * MiB, WS_V = 532 * MiB, WS_KKN = 564 * MiB, WS_WD = 596 * MiB, WS_AA = 628 * MiB, WS_G = 660 * MiB;
constexpr size_t WS_LA = 692 * MiB, WS_LB = 724 * MiB, WS_AP = 756 * MiB, WS_CAT = 764 * MiB, WS_Q = 796 * MiB;
constexpr size_t WS_XS = 380 * MiB, WS_ACT = 524 * MiB, WS_YS = 668 * MiB;
constexpr size_t WS_GP = 796 * MiB, WS_HF = 860 * MiB, WS_RP = 924 * MiB, WS_Y1F = 940 * MiB, WS_ADD = 972 * MiB, WS_END = 1004 * MiB;
constexpr size_t WS_GC = 468 * MiB, WS_HC = 484 * MiB, WS_ZS = 500 * MiB;
static_assert(WS_AA == WS_WD + 32 * MiB && WS_G == WS_AA + 32 * MiB, "EpiLora strides");
static_assert(WS_U + (size_t)M * INW * 2 <= WS_R && WS_XS + (size_t)MAXROWS * 2048 <= WS_ACT && WS_ACT + (size_t)MAXROWS * 2048 <= WS_YS && WS_YS + (size_t)NASSIGN * 2048 <= WS_Q, "ws map");
constexpr size_t RT_E = 0, RT_POS = 256 * 1024, RT_G = 512 * 1024, RT_SLOT = 768 * 1024, RT_GATE = 1088 * 1024, RT_TILE = 1408 * 1024, RT_TOK = 1472 * 1024, RT_UGU = 1792 * 1024, RT_UDN = 1808 * 1024;
constexpr int CW_BAR = 4096, CW_CNT = 8192, CW_CONV = 12288;

constexpr int RING_BYTES = 131072, MISC_OFF = RING_BYTES + 320, LDS_BYTES = 147456;
constexpr int NWAVES = 8, NTHREADS = 512;
constexpr int CONV_P9 = 6144;
constexpr int CONV_P9D = 16384;

#define XB_TMO      128
#define XB_XCNT(j)  (256  + 64 * (j))
#define XB_XSUB(j)  (1280 + 64 * (j))
#define XB_XGEN(j)  (2304 + 64 * (j))
#define XB_TOP      3328
#define XB_TOPGEN   3392
#define XCD_BAR_WORDS 3456
#define XB_SPIN_CAP (1u << 18)
DI unsigned xb_ld(unsigned* p)              { return __hip_atomic_load(p, __ATOMIC_RELAXED, __HIP_MEMORY_SCOPE_AGENT); }
DI unsigned xb_add(unsigned* p, unsigned v) { return __hip_atomic_fetch_add(p, v, __ATOMIC_RELAXED, __HIP_MEMORY_SCOPE_AGENT); }
DI unsigned xb_xcc_id() { return (unsigned)__builtin_amdgcn_s_getreg((3 << 11) | 20) & 0xFu; }
#define XB_SPIN(cond, bar) do { unsigned _sp = 0; while (cond) { __builtin_amdgcn_s_sleep(1); \
    if ((++_sp & 255u) == 0u) { if (xb_ld(&(bar)[XB_TMO])) break; if (_sp > XB_SPIN_CAP) { atomicAdd(&(bar)[XB_TMO], 1u); break; } } } } while (0)
struct XcdBarrier { unsigned* bar; unsigned x; volatile LAS unsigned* st; int w0; };
DI XcdBarrier xcd_barrier_post(unsigned* bar, volatile LAS unsigned* st, int w0) {
    XcdBarrier b; b.bar = bar; b.x = xb_xcc_id(); b.st = st; b.w0 = w0;
    if (fresh_tid_(w0) == 0) (void)xb_add(&bar[XB_XCNT(b.x)], 1u);
    return b;
}
DI void xcd_barrier_complete(unsigned* bar, unsigned x, unsigned& nloc, unsigned& nx) {
    const unsigned G = gridDim.x * gridDim.y * gridDim.z;
    unsigned sum, cnt, mine, sp = 0u;
    for (;;) {
        sum = 0u; cnt = 0u; mine = 0u;
#pragma unroll
        for (unsigned j = 0; j < 16; ++j) { const unsigned c = xb_ld(&bar[XB_XCNT(j)]); sum += c; cnt += (c > 0u) ? 1u : 0u; mine = (j == x) ? c : mine; }
        if (sum == G) break;
        __builtin_amdgcn_s_sleep(1);
        if ((++sp & 255u) == 0u) { if (xb_ld(&bar[XB_TMO])) break; if (sp > XB_SPIN_CAP) { atomicAdd(&bar[XB_TMO], 1u); break; } }
    }
    nloc = mine > 0u ? mine : 1u; nx = cnt > 0u ? cnt : 1u;
}
DI void xcd_barrier(const XcdBarrier& b) {
    asm volatile("s_waitcnt vmcnt(0)" ::: "memory");
    __syncthreads();
    if (fresh_tid_(b.w0) == 0) {
        unsigned* bar = b.bar;
        __builtin_amdgcn_s_waitcnt(0);
        unsigned nloc = b.st[0], nx = b.st[1];
        if (nloc == 0u) { xcd_barrier_complete(bar, b.x, nloc, nx); b.st[0] = nloc; b.st[1] = nx; }
        const unsigned old = xb_add(&bar[XB_XSUB(b.x)], 1u);
        const unsigned gen = old / nloc;
        if (old + 1u == (gen + 1u) * nloc) {
            __builtin_amdgcn_fence(__ATOMIC_RELEASE, "agent");
            asm volatile("s_waitcnt vmcnt(0)" ::: "memory");
            const unsigned og = xb_add(&bar[XB_TOP], 1u);
            const unsigned tg = og / nx;
            if (og + 1u == (tg + 1u) * nx) xb_add(&bar[XB_TOPGEN], 1u);
            else XB_SPIN(xb_ld(&bar[XB_TOPGEN]) == tg, bar);
            __builtin_amdgcn_fence(__ATOMIC_ACQUIRE, "agent");
            xb_add(&bar[XB_XGEN(b.x)], 1u);
            asm volatile("s_waitcnt vmcnt(0)" ::: "memory");
        } else {
            XB_SPIN(xb_ld(&bar[XB_XGEN(b.x)]) == gen, bar);
            __builtin_amdgcn_fence(__ATOMIC_ACQUIRE, "agent");
            asm volatile("s_waitcnt vmcnt(0)" ::: "memory");
        }
    }
    __syncthreads();
}

struct Args { const float* in[37]; float* out; unsigned char* ws; int ph_lo, ph_hi; };
enum { I_X = 0, I_MEM, I_NMIXG, I_WIN, I_CONVW, I_CONVB, I_LWX, I_LBX, I_LWA, I_LBA, I_LAM, I_MU, I_W0, I_WUP, I_A0, I_AUP, I_GUP, I_KK, I_KA, I_RK, I_LNG, I_LNB,
       I_WOUT, I_NXAG, I_NMEMG, I_WQ, I_WK, I_WV, I_WO, I_NFFG, I_WR, I_BR, I_WGU, I_BGU, I_WDN, I_BDN, I_FNG };

DI void transpose_item(const float* W, int ldw, int K, bf16* WT, int k0, int n0, int drow0, LAS float* scr, int lane, const float* rs = nullptr) {
    f32x4 t[8];
    const float* src = W + (size_t)(k0 + (lane >> 3)) * ldw + n0 + 4 * (lane & 7);
#pragma unroll
    for (int i = 0; i < 8; ++i) t[i] = *(const f32x4*)(src + (size_t)(8 * i) * ldw);
#pragma unroll
    for (int i = 0; i < 8; ++i) { const float sc_ = rs ? rs[k0 + 8 * i + (lane >> 3)] : 1.0f; LAS float* d = scr + (8 * i + (lane >> 3)) * 33 + 4 * (lane & 7); d[0] = t[i].x * sc_; d[1] = t[i].y * sc_; d[2] = t[i].z * sc_; d[3] = t[i].w * sc_; }
    asm volatile("s_waitcnt lgkmcnt(0)" ::: "memory");
    const int c = lane & 7;
#pragma unroll
    for (int j = 0; j < 4; ++j) { const int n = (lane >> 3) + 8 * j; const LAS float* s = scr + (8 * c) * 33 + n;
        u32x4 o; o.x = pk2(s[0 * 33], s[1 * 33]); o.y = pk2(s[2 * 33], s[3 * 33]); o.z = pk2(s[4 * 33], s[5 * 33]); o.w = pk2(s[6 * 33], s[7 * 33]);
        *(u32x4*)(WT + (size_t)(drow0 + n) * K + k0 + 8 * c) = o; }
    asm volatile("s_waitcnt lgkmcnt(0)" ::: "memory");
}
DI void transpose_item_tiled(const float* W, int ldw, int K, bf16* WTe, int k0, int n0, int drow0, LAS float* scr, int lane) {
    f32x4 t[8];
    const float* src = W + (size_t)(k0 + (lane >> 3)) * ldw + n0 + 4 * (lane & 7);
#pragma unroll
    for (int i = 0; i < 8; ++i) t[i] = *(const f32x4*)(src + (size_t)(8 * i) * ldw);
#pragma unroll
    for (int i = 0; i < 8; ++i) { LAS float* d = scr + (8 * i + (lane >> 3)) * 33 + 4 * (lane & 7); d[0] = t[i].x; d[1] = t[i].y; d[2] = t[i].z; d[3] = t[i].w; }
    asm volatile("s_waitcnt lgkmcnt(0)" ::: "memory");
    const int c = lane & 7;
#pragma unroll
    for (int j = 0; j < 4; ++j) { const int n = (lane >> 3) + 8 * j; const LAS float* s = scr + (8 * c) * 33 + n;
        u32x4 o; o.x = pk2(s[0 * 33], s[1 * 33]); o.y = pk2(s[2 * 33], s[3 * 33]); o.z = pk2(s[4 * 33], s[5 * 33]); o.w = pk2(s[6 * 33], s[7 * 33]);
        const int drow = drow0 + n, pn = drow >> 8, half = (drow >> 7) & 1, r = drow & 127, x = r & 31;
        const int rslot = (r & ~31) + 16 * ((x >> 2) & 1) + 4 * (x >> 3) + (x & 3);
        const size_t tb = ((size_t)(pn * (K / 64) + (k0 >> 6)) * 2 + half) * 16384 + pg8::lds_byte(rslot, 8 * c);
        *(u32x4*)((char*)WTe + tb) = o; }
    asm volatile("s_waitcnt lgkmcnt(0)" ::: "memory");
}
DI void transpose_item_tiled_nolds(const float* W, int ldw, int K, bf16* WTe, int k0, int n0, int drow0, int lane) {
    const int n = lane & 31, kh = lane >> 5;
    const float* src = W + (size_t)(k0 + 32 * kh) * ldw + n0 + n;
    float t[32];
#pragma unroll
    for (int i = 0; i < 32; ++i) t[i] = src[(size_t)i * ldw];
    const int drow = drow0 + n, pn = drow >> 8, half = (drow >> 7) & 1, r = drow & 127, x = r & 31;
    const int rslot = (r & ~31) + 16 * ((x >> 2) & 1) + 4 * (x >> 3) + (x & 3);
    const size_t tb0 = ((size_t)(pn * (K / 64) + (k0 >> 6)) * 2 + half) * 16384;
#pragma unroll
    for (int c = 0; c < 4; ++c) { u32x4 o; o.x = pk2(t[8 * c], t[8 * c + 1]); o.y = pk2(t[8 * c + 2], t[8 * c + 3]); o.z = pk2(t[8 * c + 4], t[8 * c + 5]); o.w = pk2(t[8 * c + 6], t[8 * c + 7]);
        *(u32x4*)((char*)WTe + tb0 + pg8::lds_byte(rslot, 32 * kh + 8 * c)) = o; }
}
DI void transpose_item_tiled_fp8_nolds(const float* W, int ldw, int K, unsigned char* WTe, int k0, int n0, int drow0, int lane) {
    const int n = lane & 31, kh = lane >> 5;
    const float* src = W + (size_t)(k0 + 32 * kh) * ldw + n0 + n;
    float t[32];
#pragma unroll
    for (int i = 0; i < 32; ++i) t[i] = __builtin_nontemporal_load(src + (size_t)i * ldw) * 64.f;
    const int drow = drow0 + n, pn = drow >> 8, half = (drow >> 7) & 1, r = drow & 127, x = r & 31;
    const int rslot = (r & ~31) + 16 * ((x >> 2) & 1) + 4 * (x >> 3) + (x & 3);
    const size_t tb0 = ((size_t)(pn * (K / 128) + (k0 >> 7)) * 2 + half) * 16384;
#pragma unroll
    for (int c = 0; c < 2; ++c) { u32x4 o; o.x = pk4_fp8(t[16 * c], t[16 * c + 1], t[16 * c + 2], t[16 * c + 3]); o.y = pk4_fp8(t[16 * c + 4], t[16 * c + 5], t[16 * c + 6], t[16 * c + 7]);
        o.z = pk4_fp8(t[16 * c + 8], t[16 * c + 9], t[16 * c + 10], t[16 * c + 11]); o.w = pk4_fp8(t[16 * c + 12], t[16 * c + 13], t[16 * c + 14], t[16 * c + 15]);
        const int bc = (k0 & 64) + 32 * kh + 16 * c;
        *(u32x4*)(WTe + tb0 + pg8::lds_byte(rslot, bc >> 1)) = o; }
}
DI void transpose_item_tiled_fp8(const float* W, int ldw, int K, unsigned char* WTe, int k0, int n0, int drow0, LAS float* scr, int lane) {
    f32x4 t[8];
    const float* src = W + (size_t)(k0 + (lane >> 3)) * ldw + n0 + 4 * (lane & 7);
#pragma unroll
    for (int i = 0; i < 8; ++i) t[i] = __builtin_nontemporal_load((const f32x4*)(src + (size_t)(8 * i) * ldw));
#pragma unroll
    for (int i = 0; i < 8; ++i) { LAS float* d = scr + (8 * i + (lane >> 3)) * 33 + 4 * (lane & 7); d[0] = t[i].x * 64.f; d[1] = t[i].y * 64.f; d[2] = t[i].z * 64.f; d[3] = t[i].w * 64.f; }
    asm volatile("s_waitcnt lgkmcnt(0)" ::: "memory");
    const int c = lane & 3;
#pragma unroll
    for (int j = 0; j < 2; ++j) { const int n = (lane >> 2) + 16 * j; const LAS float* sp = scr + (16 * c) * 33 + n;
        u32x4 o; o.x = pk4_fp8(sp[0 * 33], sp[1 * 33], sp[2 * 33], sp[3 * 33]); o.y = pk4_fp8(sp[4 * 33], sp[5 * 33], sp[6 * 33], sp[7 * 33]);
        o.z = pk4_fp8(sp[8 * 33], sp[9 * 33], sp[10 * 33], sp[11 * 33]); o.w = pk4_fp8(sp[12 * 33], sp[13 * 33], sp[14 * 33], sp[15 * 33]);
        const int drow = drow0 + n, pn = drow >> 8, half = (drow >> 7) & 1, r = drow & 127, x = r & 31;
        const int rslot = (r & ~31) + 16 * ((x >> 2) & 1) + 4 * (x >> 3) + (x & 3);
        const int bc = (k0 & 64) + 16 * c;
        const size_t tb = ((size_t)(pn * (K / 128) + (k0 >> 7)) * 2 + half) * 16384 + pg8::lds_byte(rslot, bc >> 1);
        *(u32x4*)(WTe + tb) = o; }
    asm volatile("s_waitcnt lgkmcnt(0)" ::: "memory");
}
DI void rms_row_to_bf16(const float* xrow, const float* g, bf16* orow, int lane) {
    const f32x4* xr = (const f32x4*)xrow + lane; const f32x4* gr = (const f32x4*)g + lane;
    f32x4 v[4]; float s = 0.f;
#pragma unroll
    for (int j = 0; j < 4; ++j) { v[j] = __builtin_nontemporal_load(xr + 64 * j); s += (v[j].x * v[j].x + v[j].y * v[j].y) + (v[j].z * v[j].z + v[j].w * v[j].w); }
    const float rstd = rsq_f(wave_sum(s) * (1.f / D) + EPS);
    u32x2* o8 = (u32x2*)orow + lane;
#pragma unroll
    for (int j = 0; j < 4; ++j) { const f32x4 gg = gr[64 * j]; u32x2 w; w.x = pk2(v[j].x * rstd * gg.x, v[j].y * rstd * gg.y); w.y = pk2(v[j].z * rstd * gg.z, v[j].w * rstd * gg.w); o8[64 * j] = w; }
}

DI void rms_rowbf_to_bf16(const bf16* xrow, const float* g, bf16* orow, int lane) {
    float v[16]; float s = 0.f;
#pragma unroll
    for (int hf = 0; hf < 2; ++hf) { const u32x4 w = *(const u32x4*)(xrow + 512 * hf + 8 * lane);
#pragma unroll
        for (int q = 0; q < 4; ++q) { v[8 * hf + 2 * q] = bflo(w[q]); v[8 * hf + 2 * q + 1] = bfhi(w[q]); } }
#pragma unroll
    for (int j = 0; j < 16; ++j) s += v[j] * v[j];
    const float rstd = rsq_f(wave_sum(s) * (1.f / D) + EPS);
#pragma unroll
    for (int hf = 0; hf < 2; ++hf) { const f32x4 g0 = *(const f32x4*)(g + 512 * hf + 8 * lane), g1 = *(const f32x4*)(g + 512 * hf + 8 * lane + 4);
        u32x4 w; w.x = pk2(v[8 * hf] * rstd * g0.x, v[8 * hf + 1] * rstd * g0.y); w.y = pk2(v[8 * hf + 2] * rstd * g0.z, v[8 * hf + 3] * rstd * g0.w);
        w.z = pk2(v[8 * hf + 4] * rstd * g1.x, v[8 * hf + 5] * rstd * g1.y); w.w = pk2(v[8 * hf + 6] * rstd * g1.z, v[8 * hf + 7] * rstd * g1.w);
        *(u32x4*)(orow + 512 * hf + 8 * lane) = w; }
}

__global__ void __launch_bounds__(NTHREADS, 2) fwd(Args args) {
    extern __shared__ __attribute__((aligned(16))) unsigned char lds_raw[];
    LAS unsigned char* lds = (LAS unsigned char*)lds_raw;
    volatile LAS unsigned* MISC = (volatile LAS unsigned*)(lds + MISC_OFF);
    const int G = gridDim.x, bid = blockIdx.x, NGW = G * NWAVES;
    const int wv0 = __builtin_amdgcn_readfirstlane((int)(threadIdx.x >> 6));
#define PHASE_IDS const int tid = fresh_tid(), lane = tid & 63, wave = __builtin_amdgcn_readfirstlane(tid >> 6), gw = bid * NWAVES + wave; (void)tid; (void)lane; (void)wave; (void)gw
    unsigned char* ws = args.ws;
    unsigned* ctl = (unsigned*)(ws + WS_CTL);
    const int lo = args.ph_lo, hi = args.ph_hi;

    for (int u = fresh_tid(); u < (LDS_BYTES - RING_BYTES) / 4; u += NTHREADS) ((LAS unsigned*)(lds + RING_BYTES))[u] = 0u;
    __syncthreads();
    XcdBarrier bar; bar.bar = ctl + CW_BAR; bar.x = 0; bar.st = nullptr; bar.w0 = wv0;
    if (hi - lo > 1) bar = xcd_barrier_post(ctl + CW_BAR, MISC + 8, wv0);
#define IN(k) (lo <= (k) && (k) < hi)
#define SEAM(k) do { if (IN(k) && IN((k) + 1)) xcd_barrier(bar); } while (0)

#define Win_t ((bf16*)(ws + WS_WIN))
#define Wout_t ((bf16*)(ws + WS_WOUT))
#define Wq_t ((bf16*)(ws + WS_WQ))
#define Wk_t ((bf16*)(ws + WS_WK))
#define Wv_t ((bf16*)(ws + WS_WV))
#define Wo_t ((bf16*)(ws + WS_WO))
#define LoraB ((bf16*)(ws + WS_LORAB))
#define LruW ((bf16*)(ws + WS_LRUW))
#define WrT ((bf16*)(ws + WS_LRUW + 512 * 1024))
#define Wgu_t ((bf16*)(ws + WS_WGU))
#define Wdn_t ((bf16*)(ws + WS_WDN))
#define HN ((bf16*)(ws + WS_HN))
#define MEMN ((bf16*)(ws + WS_MEMN))
#define KM ((bf16*)(ws + WS_KM))
#define VT ((bf16*)(ws + WS_VT))
#define X1 ((bf16*)(ws + WS_X1))
#define X2 ((bf16*)(ws + WS_X2))
#define U ((bf16*)(ws + WS_U))
#define Rr ((float*)(ws + WS_R))
#define KRAW ((float*)(ws + WS_KRAW))
#define Vv ((float*)(ws + WS_V))
#define KKN ((float*)(ws + WS_KKN))
#define WD ((float*)(ws + WS_WD))
#define AA ((float*)(ws + WS_AA))
#define GG ((float*)(ws + WS_G))
#define LA ((bf16*)(ws + WS_LA))
#define LB ((bf16*)(ws + WS_LB))
#define AP ((bf16*)(ws + WS_AP))
#define CAT ((bf16*)(ws + WS_CAT))
#define Qb ((bf16*)(ws + WS_Q))
#define Ob CAT
#define LACT ((bf16*)(ws + WS_CAT))
#define X1F8 ((unsigned char*)(ws + WS_XS))
#define XS ((bf16*)(ws + WS_XS))
#define ACT ((bf16*)(ws + WS_ACT))
#define YS ((bf16*)(ws + WS_YS))
#define route_e ((int*)(ws + WS_ROUTE + RT_E))
#define route_pos ((int*)(ws + WS_ROUTE + RT_POS))
#define route_g ((float*)(ws + WS_ROUTE + RT_G))
#define row_sg ((u32x2*)(ws + WS_ROUTE + RT_SLOT))
#define tile_tab ((int*)(ws + WS_ROUTE + RT_TILE))
#define row_tok ((int*)(ws + WS_ROUTE + RT_TOK))
#define ecnt (ctl + CW_CNT)

    if (IN(0)) { PHASE_IDS;
        LAS float* scr = (LAS float*)(lds + wave * 16384);
        constexpr int I_IN = 16 * (INW / 32), I_SQ = 16 * 32;
        constexpr int N_ITEMS = I_IN + 5 * I_SQ;
        for (int it = gw; it < N_ITEMS; it += NGW) {
            int r = it;
            if (r < I_IN) { const int nblk = INW / 32, kb = r / nblk, nb = r % nblk; transpose_item(args.in[I_WIN], INW, D, Win_t, 64 * kb, 32 * nb, 32 * nb, scr, lane); continue; } r -= I_IN;
            { const int w = r / I_SQ, q = r % I_SQ, kb = q / 32, nb = q % 32;
                if (w == 1) continue;
                const float* src = w == 0 ? args.in[I_WOUT] : w == 2 ? args.in[I_WK] : w == 3 ? args.in[I_WV] : args.in[I_WO];
                bf16* dst = w == 0 ? Wout_t : w == 2 ? Wk_t : w == 3 ? Wv_t : Wo_t;
                transpose_item(src, D, D, dst, 64 * kb, 32 * nb, 32 * nb, scr, lane); }
        }
        for (int idx = bid * NTHREADS + tid; idx < D * D / 4; idx += G * NTHREADS) { const f32x4 v = ((const f32x4*)args.in[I_WQ])[idx]; const float gk = args.in[I_NXAG][idx >> 8];
            u32x2 w; w.x = pk2(v.x * gk, v.y * gk); w.y = pk2(v.z * gk, v.w * gk); ((u32x2*)Wq_t)[idx] = w; }
        for (int idx = bid * NTHREADS + tid; idx < 1536 * 256; idx += G * NTHREADS) {
            const int e = idx & 7, ln = (idx >> 3) & 63, ks = (idx >> 9) & 7, ct = (idx >> 12) & 3, hk = idx >> 14, hh = hk / 3, kind = hk - 3 * hh;
            const int k = 32 * ks + 8 * (ln >> 4) + e, n = hh * 64 + 16 * ct + (ln & 15); float v = 0.f;
            if (kind == 0) { if (k < 64) v = args.in[I_WUP][k * 512 + n]; }
            else if (kind == 1) { if (k >= 64 && k < 128) v = args.in[I_AUP][(k - 64) * 512 + n]; }
            else { if (k >= 128) v = args.in[I_GUP][(k - 128) * 512 + n]; }
            LoraB[idx] = (bf16)f2bf(v);
        }
        for (int idx = bid * NTHREADS + tid; idx < 8 * 128 * 64; idx += G * NTHREADS) {
            const int nb = idx >> 13, col = (idx >> 6) & 127, k = idx & 63;
            const float v = col < 64 ? args.in[I_LWX][nb * 4096 + k * 64 + col] : args.in[I_LWA][nb * 4096 + k * 64 + (col - 64)];
            LruW[idx] = (bf16)f2bf(v);
        }
        for (int idx = bid * NTHREADS + tid; idx < NE * D; idx += G * NTHREADS) {
            const int e = idx >> 10, k = idx & 1023; const float v = args.in[I_WR][k * NE + e];
            const unsigned hi = f2bf(v); const float lo = v - __uint_as_float(hi << 16);
            WrT[idx] = (bf16)hi; WrT[NE * D + idx] = (bf16)f2bf(lo);
        }
        for (int m = gw; m < M; m += NGW) rms_row_to_bf16(args.in[I_X] + (size_t)m * D, args.in[I_NMIXG], HN + (size_t)m * D, lane);
        for (int m = gw; m < MROWS; m += NGW) rms_row_to_bf16(args.in[I_MEM] + (size_t)m * D, args.in[I_NMEMG], MEMN + (size_t)m * D, lane);
        {
            LAS float* scr = (LAS float*)(lds + wave * 16384);
            constexpr int I_GU = 16 * 64, I_DN = 16 * 32;
            for (int it = CONV_P9 + gw; it < NE * I_GU; it += NGW) {
                int r = it;
                if (r < NE * I_GU) { const int e = r / I_GU, q = r % I_GU, kb = q / 64, nb = q % 64; const int n0 = 32 * nb;
                    const int drow = n0 < 1024 ? (256 * (n0 >> 7) + (n0 & 127)) : (256 * ((n0 - 1024) >> 7) + 128 + ((n0 - 1024) & 127));
                    transpose_item_tiled_fp8(args.in[I_WGU] + (size_t)e * D * 2048, 2048, D, (unsigned char*)Wgu_t + (size_t)e * 2048 * D, 64 * kb, n0, drow, scr, lane); continue; } r -= NE * I_GU;
                { const int e = r / I_DN, q = r % I_DN, kb = q / 32, nb = q % 32;
                  transpose_item_tiled(args.in[I_WDN] + (size_t)e * DFF * D, D, DFF, Wdn_t + (size_t)e * D * DFF, 64 * kb, 32 * nb, 32 * nb, scr, lane); }
            }
        }
    }
    SEAM(0);

    if (IN(1)) { PHASE_IDS;
        { pg8::DenseSched S; S.o.init_tiles(M / 256, INW / 256, G, bid); S.A = (const char*)HN; S.B = (const char*)Win_t; S.tstep = (size_t)256 * D * 2;
          EpiBf16Plain E{U, INW, 1.0f}; pg8::gemm_phase(lds, D, S, E, wv0); }
        { pg8::DenseSched S; S.o.init_tiles(MROWS / 256, D / 256, G, (bid + 64) & (G - 1)); S.A = (const char*)MEMN; S.B = (const char*)Wk_t; S.tstep = (size_t)256 * D * 2;
          EpiBf16Plain E{KM, D, 1.0f}; pg8::gemm_phase(lds, D, S, E, wv0); }
        { pg8::DenseSched S; S.o.init_tiles(MROWS / 256, D / 256, G, (bid + 48) & (G - 1)); S.A = (const char*)MEMN; S.B = (const char*)Wv_t; S.tstep = (size_t)256 * D * 2;
          EpiBf16Plain E{VT, D, 1.0f}; pg8::gemm_phase(lds, D, S, E, wv0); }
    }
    SEAM(1);

    if (IN(2)) { PHASE_IDS;
        const float* conv_w = args.in[I_CONVW]; const float* conv_b = args.in[I_CONVB];
        LAS float* xs = (LAS float*)(lds + wave * 16384);
        LAS bf16* tP = (LAS bf16*)(lds + wave * 16384 + 4096); LAS bf16* tH = tP + 1024;
        const int i = lane & 15, kg = lane >> 4;
        for (int unit = gw; unit < (M / 64) * 8; unit += NGW) {
            const int seg = unit >> 3, nb = unit & 7, m0s = seg * 64, s0s = m0s & (SEQ - 1);
            bf16x8 wf[8][2];
#pragma unroll
            for (int ct = 0; ct < 8; ++ct)
#pragma unroll
                for (int ks = 0; ks < 2; ++ks) wf[ct][ks] = *(const bf16x8*)(LruW + ((size_t)(nb * 128 + 16 * ct + i) * 64 + 32 * ks + 8 * kg));
            float bxv[4], bav[4], spv[4], Arun[4], Brun[4];
#pragma unroll
            for (int ct = 0; ct < 4; ++ct) { const int ch = nb * 64 + 16 * ct + i; bxv[ct] = args.in[I_LBX][ch]; bav[ct] = args.in[I_LBA][ch]; spv[ct] = softplus_f(-args.in[I_LAM][ch]); Arun[ct] = 1.f; Brun[ct] = 0.f; }
#pragma unroll 1
            for (int jt = 0; jt < 4; ++jt) {
                const int m0 = m0s + 16 * jt, s0 = s0s + 16 * jt;
                bf16x8 af[2];
#pragma unroll
                for (int ks = 0; ks < 2; ++ks) {
                    const int chb = nb * 64 + 32 * ks + 8 * kg;
                    f32x4 x0 = *(const f32x4*)(conv_b + chb), x1 = *(const f32x4*)(conv_b + chb + 4);
#pragma unroll
                    for (int j = 0; j < 4; ++j) {
                        const bool ok = s0 + i - 3 + j >= 0;
                        u32x4 uw = *(const u32x4*)(U + (size_t)(ok ? m0 + i - 3 + j : m0) * INW + chb); if (!ok) uw = (u32x4){0u, 0u, 0u, 0u};
                        const f32x4 w0 = *(const f32x4*)(conv_w + j * 512 + chb), w1 = *(const f32x4*)(conv_w + j * 512 + chb + 4);
                        x0.x += w0.x * bflo(uw.x); x0.y += w0.y * bfhi(uw.x); x0.z += w0.z * bflo(uw.y); x0.w += w0.w * bfhi(uw.y);
                        x1.x += w1.x * bflo(uw.z); x1.y += w1.y * bfhi(uw.z); x1.z += w1.z * bflo(uw.w); x1.w += w1.w * bfhi(uw.w);
                    }
                    *(LAS f32x4*)(xs + i * 64 + 32 * ks + 8 * kg) = x0; *(LAS f32x4*)(xs + i * 64 + 32 * ks + 8 * kg + 4) = x1;
                    u32x4 p; p.x = pk2(x0.x, x0.y); p.y = pk2(x0.z, x0.w); p.z = pk2(x1.x, x1.y); p.w = pk2(x1.z, x1.w);
                    af[ks] = __builtin_bit_cast(bf16x8, p);
                }
                f32x4 acc[8];
#pragma unroll
                for (int ct = 0; ct < 8; ++ct) { acc[ct] = (f32x4){0.f, 0.f, 0.f, 0.f};
#pragma unroll
                    for (int ks = 0; ks < 2; ++ks) acc[ct] = __builtin_amdgcn_mfma_f32_16x16x32_bf16(af[ks], wf[ct][ks], acc[ct], 0, 0, 0); }
#pragma unroll
                for (int ct = 0; ct < 4; ++ct) {
                    const int col = 16 * ct + i;
                    float hl[4], pl[4]; float hprev = 0.f, pprev = 1.f;
#pragma unroll
                    for (int e = 0; e < 4; ++e) {
                        const float gx = sigmoid_f(acc[ct][e] + bxv[ct]), ga = sigmoid_f(acc[ct + 4][e] + bav[ct]);
                        const float la = -8.0f * ga * spv[ct], av = __expf(la), xcv = xs[(4 * kg + e) * 64 + col];
                        const float bt = __builtin_amdgcn_sqrtf(fmaxf(1.0f - av * av, 0.f)) * gx * xcv;
                        hprev = av * hprev + bt; pprev *= av; hl[e] = hprev; pl[e] = pprev;
                    }
                    float Ag[4], Bg[4];
#pragma unroll
                    for (int gq = 0; gq < 4; ++gq) { Ag[gq] = __shfl(pl[3], i + 16 * gq); Bg[gq] = __shfl(hl[3], i + 16 * gq); }
                    float Ain = Arun[ct], Bin = Brun[ct];
#pragma unroll
                    for (int gq = 0; gq < 3; ++gq) if (gq < kg) { Bin = Ag[gq] * Bin + Bg[gq]; Ain *= Ag[gq]; }
                    float At = 1.f, Bt = 0.f;
#pragma unroll
                    for (int gq = 0; gq < 4; ++gq) { Bt = Ag[gq] * Bt + Bg[gq]; At *= Ag[gq]; }
                    Brun[ct] = At * Brun[ct] + Bt; Arun[ct] *= At;
#pragma unroll
                    for (int e = 0; e < 4; ++e) { const int ti_ = (4 * kg + e) * 64 + col; tP[ti_] = (bf16)f2bf(pl[e] * Ain); tH[ti_] = (bf16)f2bf(hl[e] + pl[e] * Bin); }
                }
                { const int rr = lane >> 2, cq = lane & 3;
                  bf16* pp = LA + (size_t)(m0 + rr) * 512 + nb * 64 + 16 * cq; bf16* hp = LB + (size_t)(m0 + rr) * 512 + nb * 64 + 16 * cq;
                  *(u32x4*)pp = *(const LAS u32x4*)(tP + rr * 64 + 16 * cq); *(u32x4*)(pp + 8) = *(const LAS u32x4*)(tP + rr * 64 + 16 * cq + 8);
                  *(u32x4*)hp = *(const LAS u32x4*)(tH + rr * 64 + 16 * cq); *(u32x4*)(hp + 8) = *(const LAS u32x4*)(tH + rr * 64 + 16 * cq + 8); }
            }
            if (kg == 0) {
#pragma unroll
                for (int ct = 0; ct < 4; ++ct) { f32x2 ab; ab.x = Arun[ct]; ab.y = Brun[ct];
                    *(f32x2*)((float*)(ws + WS_AP) + ((size_t)(((seg >> 6) * 8 + nb) * 64 + (seg & 63)) * 64 + 16 * ct + i) * 2) = ab; }
            }
        }
        { const int rsub = lane >> 5, chunk = lane & 31;
          const f32x4 m0 = *(const f32x4*)(args.in[I_MU] + 1536 + 8 * chunk), m1 = *(const f32x4*)(args.in[I_MU] + 1536 + 8 * chunk + 4);
          const bool actid = chunk >= 8 && chunk < 16; const float actc = chunk < 8 ? 2.8853900818f : -1.4426950409f, actp = chunk < 8 ? 1.0f : 0.0f, actq = chunk < 8 ? -2.0f : 1.0f;
          for (int rp = gw; rp < M / 2; rp += NGW) { const size_t mr = (size_t)2 * rp + rsub; const bool hp2 = (mr & (SEQ - 1)) != 0; const bf16* ua = U + mr * INW + 2560 + 8 * chunk;
              const u32x4 cu = *(const u32x4*)ua; u32x4 pu = *(const u32x4*)(ua - (hp2 ? INW : 0)); if (!hp2) pu = (u32x4){0u, 0u, 0u, 0u};
              float o8[8];
#pragma unroll
              for (int q = 0; q < 4; ++q) { const float c0 = bflo(cu[q]), c1 = bfhi(cu[q]), p0 = bflo(pu[q]), p1 = bfhi(pu[q]); const float mm0 = q < 2 ? m0[2 * q] : m1[2 * q - 4], mm1 = q < 2 ? m0[2 * q + 1] : m1[2 * q - 3];
                  float x0 = c0 + (p0 - c0) * mm0, x1 = c1 + (p1 - c1) * mm1;
                  const float r0 = __builtin_amdgcn_rcpf(__builtin_amdgcn_exp2f(actc * x0) + 1.0f), r1 = __builtin_amdgcn_rcpf(__builtin_amdgcn_exp2f(actc * x1) + 1.0f);
                  o8[2 * q] = actid ? x0 : actp + actq * r0; o8[2 * q + 1] = actid ? x1 : actp + actq * r1; }
              u32x4 pw; pw.x = pk2(o8[0], o8[1]); pw.y = pk2(o8[2], o8[3]); pw.z = pk2(o8[4], o8[5]); pw.w = pk2(o8[6], o8[7]);
              *(u32x4*)(LACT + mr * 256 + 8 * chunk) = pw; } }
    }
    SEAM(2);


#define RW_ZB(zz, zb) do { _Pragma("unroll") for (int ks_ = 0; ks_ < 2; ++ks_) { u32x4 p_; p_.x = pk2(zz[2 * ks_][0], zz[2 * ks_][1]); p_.y = pk2(zz[2 * ks_][2], zz[2 * ks_][3]); \
        p_.z = pk2(zz[2 * ks_ + 1][0], zz[2 * ks_ + 1][1]); p_.w = pk2(zz[2 * ks_ + 1][2], zz[2 * ks_ + 1][3]); zb[ks_] = __builtin_bit_cast(bf16x8, p_); } } while (0)
    if (IN(3)) { PHASE_IDS;
        for (int u64 = gw; u64 < NB * NH * (SEQ / 64); u64 += NGW) {
#pragma unroll 1
        for (int jj = 0; jj < 4; ++jj) {
        LAS unsigned char* wl = lds + wave * 16384;
        LAS bf16* Arm = (LAS bf16*)(wl); LAS bf16* Brm = (LAS bf16*)(wl + 2048); LAS bf16* Krm = (LAS bf16*)(wl + 4096); LAS bf16* Rrm = (LAS bf16*)(wl + 6144);
        LAS bf16* ATt = (LAS bf16*)(wl + 8192); LAS bf16* BTt = (LAS bf16*)(wl + 10240); LAS bf16* KTt = (LAS bf16*)(wl + 12288); LAS bf16* VTt = (LAS bf16*)(wl + 14336);
        LAS float* MabT = (LAS float*)(wl); LAS bf16* Mak = (LAS bf16*)(wl + 1024); LAS bf16* Mrb = (LAS bf16*)(wl + 1536); LAS bf16* Mrk = (LAS bf16*)(wl + 2048); LAS bf16* Tm = (LAS bf16*)(wl + 2560);
        LAS float* PLs = (LAS float*)(wl + 3072); LAS bf16* Q0T = (LAS bf16*)(wl + 4096);
        const int lane = fresh_tid() & 63, l15 = lane & 15, g = lane >> 4, te = lane >> 2, kq = lane & 3;
        const bf16x8 z8 = (bf16x8){0, 0, 0, 0, 0, 0, 0, 0};
        const f32x4 z4 = (f32x4){0.f, 0.f, 0.f, 0.f};
            const int un = u64 * 4 + jj;
            const int bh = un >> 8, c = un & 255, b = bh >> 3, h = bh & 7;
            const size_t mrow = (size_t)b * SEQ + c * 16 + te, off = mrow * 512 + h * 64 + 16 * kq;
            const int hc = h * 64 + 16 * kq;
            LAS float* tmpL = (LAS float*)wl;
            {
                const int rsub = lane >> 5, chunk = lane & 31; const size_t mt0 = (size_t)b * SEQ + c * 16;
                u32x4 cu[8];
#pragma unroll
                for (int i = 0; i < 8; ++i) cu[i] = *(const u32x4*)(LACT + (mt0 + 2 * i + rsub) * 256 + 8 * chunk);
#pragma unroll
                for (int i = 0; i < 8; ++i) { const int row = 2 * i + rsub; *(LAS u32x4*)(wl + row * 512 + ((chunk ^ (row & 7)) << 4)) = cu[i]; }
                bf16x8 af[8];
#pragma unroll
                for (int ks = 0; ks < 8; ++ks) af[ks] = *(const LAS bf16x8*)(wl + l15 * 512 + (((4 * ks + g) ^ (l15 & 7)) << 4));
                asm volatile("s_waitcnt lgkmcnt(0)" ::: "memory");
#pragma unroll
                for (int kind = 0; kind < 3; ++kind)
#pragma unroll
                    for (int ct = 0; ct < 4; ++ct) {
                        const bf16* lb = LoraB + ((size_t)((h * 3 + kind) * 4 + ct) * 8 * 64 + lane) * 8;
                        f32x4 a4 = z4;
#pragma unroll
                        for (int ks = (kind == 0 ? 0 : kind == 1 ? 2 : 4); ks < (kind == 0 ? 2 : kind == 1 ? 4 : 8); ++ks) a4 = __builtin_amdgcn_mfma_f32_16x16x32_bf16(af[ks], *(const bf16x8*)(lb + ks * 512), a4, 0, 0, 0);
#pragma unroll
                        for (int e = 0; e < 4; ++e) tmpL[kind * 1088 + (4 * g + e) * 68 + 16 * ct + l15] = a4[e];
                    }
            }
            asm volatile("s_waitcnt lgkmcnt(0)" ::: "memory");
            float cl[16], eP[16];
            {
                float lwv[16], rl[16], kl[16], vl[16], kn[16], av[16];
                const bool hp = (mrow & (SEQ - 1)) != 0;
                const bf16* ub = U + mrow * INW + 1024 + hc;
#pragma unroll
                for (int hh = 0; hh < 2; ++hh) {
#pragma unroll
                    for (int a3 = 0; a3 < 3; ++a3) {
                        const u32x4 cu = *(const u32x4*)(ub + 512 * a3 + 8 * hh); u32x4 pu = *(const u32x4*)(ub - (hp ? INW : 0) + 512 * a3 + 8 * hh); if (!hp) pu = (u32x4){0u, 0u, 0u, 0u};
                        const f32x4 m0 = *(const f32x4*)(args.in[I_MU] + 512 * a3 + hc + 8 * hh), m1 = *(const f32x4*)(args.in[I_MU] + 512 * a3 + hc + 8 * hh + 4);
                        float o8[8];
#pragma unroll
                        for (int q = 0; q < 4; ++q) { const float c0 = bflo(cu[q]), c1 = bfhi(cu[q]), p0 = bflo(pu[q]), p1 = bfhi(pu[q]); const float mm0 = q < 2 ? m0[2 * q] : m1[2 * q - 4], mm1 = q < 2 ? m0[2 * q + 1] : m1[2 * q - 3];
                            o8[2 * q] = c0 + (p0 - c0) * mm0; o8[2 * q + 1] = c1 + (p1 - c1) * mm1; }
#pragma unroll
                        for (int q = 0; q < 8; ++q) { if (a3 == 0) rl[8 * hh + q] = o8[q]; else if (a3 == 1) kl[8 * hh + q] = o8[q]; else vl[8 * hh + q] = o8[q]; }
                    }
                }
                float gv[16];
#pragma unroll
                for (int j4 = 0; j4 < 4; ++j4) { const f32x4 xl = *(const LAS f32x4*)(tmpL + te * 68 + 16 * kq + 4 * j4), xa = *(const LAS f32x4*)(tmpL + 1088 + te * 68 + 16 * kq + 4 * j4), xg = *(const LAS f32x4*)(tmpL + 2176 + te * 68 + 16 * kq + 4 * j4);
                    const f32x4 w0v = *(const f32x4*)(args.in[I_W0] + hc + 4 * j4), a0v = *(const f32x4*)(args.in[I_A0] + hc + 4 * j4);
#pragma unroll
                    for (int q = 0; q < 4; ++q) { lwv[4 * j4 + q] = -0.6065306597f * sigmoid_f(xl[q] + w0v[q]);        av[4 * j4 + q] = sigmoid_f(xa[q] + a0v[q]); gv[4 * j4 + q] = xg[q]; } }
                asm volatile("s_waitcnt lgkmcnt(0)" ::: "memory");
                float ss = 0.f;
#pragma unroll
                for (int j4 = 0; j4 < 4; ++j4) { const f32x4 kk4 = *(const f32x4*)(args.in[I_KK] + hc + 4 * j4);
#pragma unroll
                    for (int q = 0; q < 4; ++q) { kn[4 * j4 + q] = kl[4 * j4 + q] * kk4[q]; ss += kn[4 * j4 + q] * kn[4 * j4 + q]; } }
                ss += __shfl_xor(ss, 1); ss += __shfl_xor(ss, 2);
                const float kinv = rsq_f(fmaxf(ss, 1e-24f));
#pragma unroll
                for (int j = 0; j < 16; ++j) { float x = lwv[j];
#pragma unroll
                    for (int sft = 4; sft < 64; sft <<= 1) { const float y = __shfl_up(x, sft); if (lane >= sft) x += y; }
                    cl[j] = x; }
                float bon = 0.f;
                u32x4 pa[2], pb[2], pk[2], pr[2];
#pragma unroll
                for (int j4 = 0; j4 < 4; ++j4) {
                    const f32x4 ka = *(const f32x4*)(args.in[I_KA] + hc + 4 * j4), rk = *(const f32x4*)(args.in[I_RK] + hc + 4 * j4);
                    float at4[4], bt4[4], kt4[4], rt4[4];
#pragma unroll
                    for (int q = 0; q < 4; ++q) { const int j = 4 * j4 + q;
                        const float p = __expf(cl[j]), pn = __expf(-cl[j]), pm1 = __expf(cl[j] - lwv[j]); eP[j] = p;
                        const float knj = kn[j] * kinv;
                        const float kp = kl[j] * (1.0f + (av[j] - 1.0f) * ka[q]);
                        at4[q] = -knj * pm1; bt4[q] = knj * av[j] * pn; kt4[q] = kp * pn; rt4[q] = rl[j] * p;
                        bon += rl[j] * kp * rk[q];
                        const int kk = 16 * kq + j;
                        ATt[kk * 16 + te] = (bf16)f2bf(at4[q]); BTt[kk * 16 + te] = (bf16)f2bf(bt4[q]); KTt[kk * 16 + te] = (bf16)f2bf(kt4[q]); VTt[kk * 16 + te] = (bf16)f2bf(vl[j]); }
                    const int hh = j4 >> 1, w2 = (j4 & 1) * 2;
                    pa[hh][w2] = pk2(at4[0], at4[1]); pa[hh][w2 + 1] = pk2(at4[2], at4[3]); pb[hh][w2] = pk2(bt4[0], bt4[1]); pb[hh][w2 + 1] = pk2(bt4[2], bt4[3]);
                    pk[hh][w2] = pk2(kt4[0], kt4[1]); pk[hh][w2 + 1] = pk2(kt4[2], kt4[3]); pr[hh][w2] = pk2(rt4[0], rt4[1]); pr[hh][w2 + 1] = pk2(rt4[2], rt4[3]);
                }
#pragma unroll
                for (int hh = 0; hh < 2; ++hh) { const int po = te * 64 + 8 * ((2 * kq + hh) ^ (te & 7));
                    *(LAS u32x4*)(Arm + po) = pa[hh]; *(LAS u32x4*)(Brm + po) = pb[hh]; *(LAS u32x4*)(Krm + po) = pk[hh]; *(LAS u32x4*)(Rrm + po) = pr[hh]; }
                bon += __shfl_xor(bon, 1); bon += __shfl_xor(bon, 2);
                f32x4 lbv[4], lgv[4];
#pragma unroll
                for (int j4 = 0; j4 < 4; ++j4) { lbv[j4] = *(const f32x4*)(args.in[I_LNB] + hc + 4 * j4); lgv[j4] = *(const f32x4*)(args.in[I_LNG] + hc + 4 * j4); }
#pragma unroll
                for (int j4 = 0; j4 < 4; ++j4) { const f32x4 lb = lbv[j4], lgn = lgv[j4]; const int j0 = 4 * j4;
                    u32x2 ow, gw2; ow.x = pk2((lb.x + vl[j0] * bon) * gv[j0], (lb.y + vl[j0 + 1] * bon) * gv[j0 + 1]); ow.y = pk2((lb.z + vl[j0 + 2] * bon) * gv[j0 + 2], (lb.w + vl[j0 + 3] * bon) * gv[j0 + 3]);
                    gw2.x = pk2(lgn.x * gv[j0], lgn.y * gv[j0 + 1]); gw2.y = pk2(lgn.z * gv[j0 + 2], lgn.w * gv[j0 + 3]);
                    *(u32x2*)((bf16*)(ws + WS_ADD) + off + j0) = ow; *(u32x2*)((bf16*)(ws + WS_G) + off + j0) = gw2; }
            }
            asm volatile("s_waitcnt lgkmcnt(0)" ::: "memory");
            {
                bf16x8 fa[2], fr[2], fb[2], fk[2];
#pragma unroll
                for (int ks = 0; ks < 2; ++ks) { const int po = l15 * 64 + 8 * ((4 * ks + g) ^ (l15 & 7));
                    fa[ks] = *(const LAS bf16x8*)(Arm + po); fr[ks] = *(const LAS bf16x8*)(Rrm + po); fb[ks] = *(const LAS bf16x8*)(Brm + po); fk[ks] = *(const LAS bf16x8*)(Krm + po); }
                f32x4 mab = z4, mak = z4, mrb = z4, mrk = z4;
#pragma unroll
                for (int ks = 0; ks < 2; ++ks) { mab = __builtin_amdgcn_mfma_f32_16x16x32_bf16(fb[ks], fa[ks], mab, 0, 0, 0); mak = __builtin_amdgcn_mfma_f32_16x16x32_bf16(fk[ks], fa[ks], mak, 0, 0, 0);
                    mrb = __builtin_amdgcn_mfma_f32_16x16x32_bf16(fb[ks], fr[ks], mrb, 0, 0, 0); mrk = __builtin_amdgcn_mfma_f32_16x16x32_bf16(fk[ks], fr[ks], mrk, 0, 0, 0); }
#pragma unroll
                for (int e = 0; e < 4; ++e) { const int i = 4 * g + e; if (!(i < l15)) { mab[e] = 0.f; mak[e] = 0.f; } if (!(i <= l15)) { mrb[e] = 0.f; mrk[e] = 0.f; } }
                asm volatile("s_waitcnt lgkmcnt(0)" ::: "memory");
#pragma unroll
                for (int e = 0; e < 4; ++e) MabT[(4 * g + e) * 16 + l15] = mab[e];
                u32x2 w; w.x = pk2(mak[0], mak[1]); w.y = pk2(mak[2], mak[3]); *(LAS u32x2*)(Mak + l15 * 16 + 4 * g) = w;
                w.x = pk2(mrb[0], mrb[1]); w.y = pk2(mrb[2], mrb[3]); *(LAS u32x2*)(Mrb + l15 * 16 + 4 * g) = w;
                w.x = pk2(mrk[0], mrk[1]); w.y = pk2(mrk[2], mrk[3]); *(LAS u32x2*)(Mrk + l15 * 16 + 4 * g) = w;
                if (te == 15) {
#pragma unroll
                    for (int j = 0; j < 16; ++j) PLs[16 * kq + j] = eP[j]; }
            }
            asm volatile("s_waitcnt lgkmcnt(0)" ::: "memory");
            {
                f32x4 mq[15][4];
#pragma unroll
                for (int j = 0; j < 15; ++j)
#pragma unroll
                    for (int q = 0; q < 4; ++q) if (4 * q + 3 > j) mq[j][q] = *(const LAS f32x4*)(MabT + j * 16 + 4 * q);
                float y[16];
#pragma unroll
                for (int j = 15; j >= 0; --j) {
                    float acc = (j == l15) ? 1.0f : 0.0f;
#pragma unroll
                    for (int i = j + 1; i < 16; ++i) acc += y[i] * mq[j < 15 ? j : 0][i >> 2][i & 3];
                    y[j] = acc;
                }
                if (g == 0) { u32x4 t0, t1; t0.x = pk2(y[0], y[1]); t0.y = pk2(y[2], y[3]); t0.z = pk2(y[4], y[5]); t0.w = pk2(y[6], y[7]); t1.x = pk2(y[8], y[9]); t1.y = pk2(y[10], y[11]); t1.z = pk2(y[12], y[13]); t1.w = pk2(y[14], y[15]);
                    *(LAS u32x4*)(Tm + l15 * 16) = t0; *(LAS u32x4*)(Tm + l15 * 16 + 8) = t1; }
            }
            asm volatile("s_waitcnt lgkmcnt(0)" ::: "memory");
            {
                const bool act = g < 2; const int fo = l15 * 16 + 8 * g;
                const bf16x8 fT = act ? *(const LAS bf16x8*)(Tm + fo) : z8, fMak = act ? *(const LAS bf16x8*)(Mak + fo) : z8, fMrb = act ? *(const LAS bf16x8*)(Mrb + fo) : z8, fMrk = act ? *(const LAS bf16x8*)(Mrk + fo) : z8;
                bf16x8 fV[4], fQ1[4], fAh[4], fBT[4], fKT[4];
#pragma unroll
                for (int vt = 0; vt < 4; ++vt) { fV[vt] = act ? *(const LAS bf16x8*)(VTt + vt * 256 + fo) : z8; fBT[vt] = act ? *(const LAS bf16x8*)(BTt + vt * 256 + fo) : z8; fKT[vt] = act ? *(const LAS bf16x8*)(KTt + vt * 256 + fo) : z8; }
#pragma unroll
                for (int vt = 0; vt < 4; ++vt) { const f32x4 q0 = __builtin_amdgcn_mfma_f32_16x16x32_bf16(fMak, fV[vt], z4, 0, 0, 0);
                    u32x2 w; w.x = pk2(q0[0], q0[1]); w.y = pk2(q0[2], q0[3]); *(LAS u32x2*)(Q0T + vt * 256 + l15 * 16 + 4 * g) = w; }
#pragma unroll
                for (int kt = 0; kt < 4; ++kt) { const bf16x8 fA = act ? *(const LAS bf16x8*)(ATt + kt * 256 + fo) : z8; const f32x4 ah = __builtin_amdgcn_mfma_f32_16x16x32_bf16(fT, fA, z4, 0, 0, 0);
                    u32x2 w; w.x = pk2(ah[0], ah[1]); w.y = pk2(ah[2], ah[3]); *(LAS u32x2*)(ATt + kt * 256 + l15 * 16 + 4 * g) = w; }
                asm volatile("s_waitcnt lgkmcnt(0)" ::: "memory");
#pragma unroll
                for (int vt = 0; vt < 4; ++vt) { const bf16x8 fQ0 = act ? *(const LAS bf16x8*)(Q0T + vt * 256 + fo) : z8; const f32x4 q1 = __builtin_amdgcn_mfma_f32_16x16x32_bf16(fT, fQ0, z4, 0, 0, 0);
                    u32x2 w; w.x = pk2(q1[0], q1[1]); w.y = pk2(q1[2], q1[3]); *(LAS u32x2*)(Q0T + vt * 256 + l15 * 16 + 4 * g) = w; }
                asm volatile("s_waitcnt lgkmcnt(0)" ::: "memory");
#pragma unroll
                for (int vt = 0; vt < 4; ++vt) { fQ1[vt] = act ? *(const LAS bf16x8*)(Q0T + vt * 256 + fo) : z8; fAh[vt] = act ? *(const LAS bf16x8*)(ATt + vt * 256 + fo) : z8; }
                bf16* rp = (bf16*)(ws + WS_RP) + (size_t)un * 1024 + l15 * 64;
#pragma unroll
                for (int kt = 0; kt < 4; ++kt) {
                    const u32x2 rr = *(const LAS u32x2*)(Rrm + l15 * 64 + 8 * ((2 * kt + (g >> 1)) ^ (l15 & 7)) + 4 * (g & 1));
                    f32x4 ini; ini[0] = bflo(rr.x); ini[1] = bfhi(rr.x); ini[2] = bflo(rr.y); ini[3] = bfhi(rr.y);
                    const f32x4 rh = __builtin_amdgcn_mfma_f32_16x16x32_bf16(fAh[kt], fMrb, ini, 0, 0, 0);
                    u32x2 w; w.x = pk2(rh[0], rh[1]); w.y = pk2(rh[2], rh[3]); *(u32x2*)(rp + 32 * (kt >> 1) + 8 * g + 4 * (kt & 1)) = w;
                }
#pragma unroll
                for (int vt = 0; vt < 4; ++vt) { f32x4 y1 = __builtin_amdgcn_mfma_f32_16x16x32_bf16(fMrb, fQ1[vt], z4, 0, 0, 0); y1 = __builtin_amdgcn_mfma_f32_16x16x32_bf16(fMrk, fV[vt], y1, 0, 0, 0);
                    *(f32x4*)((float*)(ws + WS_Y1F) + ((size_t)(un * 4 + vt) * 64 + lane) * 4) = y1; }
                LAS bf16* tgs = (LAS bf16*)(wl + 8192);
#pragma unroll
                for (int krt = 0; krt < 4; ++krt) { const float pl = PLs[16 * krt + l15];
#pragma unroll
                    for (int kct = 0; kct < 4; ++kct) { f32x4 ga = __builtin_amdgcn_mfma_f32_16x16x32_bf16(fAh[kct], fBT[krt], z4, 0, 0, 0);
                        if (kct == krt) {
#pragma unroll
                            for (int e = 0; e < 4; ++e) if (4 * g + e == l15) ga[e] += 1.0f; }
                        u32x2 w; w.x = pk2(ga[0] * pl, ga[1] * pl); w.y = pk2(ga[2] * pl, ga[3] * pl);
                        *(LAS u32x2*)(tgs + (16 * krt + l15) * 64 + 32 * (kct >> 1) + 8 * g + 4 * (kct & 1)) = w; } }
                { u32x4* gp16 = (u32x4*)((bf16*)(ws + WS_GP) + (size_t)un * 4096);
#pragma unroll
                  for (int i = 0; i < 8; ++i) gp16[i * 64 + lane] = *(const LAS u32x4*)(tgs + (i * 64 + lane) * 8); }
#pragma unroll
                for (int mt = 0; mt < 4; ++mt) { const f32x4 pl4 = *(const LAS f32x4*)(PLs + 16 * mt + 4 * g);
#pragma unroll
                    for (int vt = 0; vt < 4; ++vt) { f32x4 ha = __builtin_amdgcn_mfma_f32_16x16x32_bf16(fBT[mt], fQ1[vt], z4, 0, 0, 0); ha = __builtin_amdgcn_mfma_f32_16x16x32_bf16(fKT[mt], fV[vt], ha, 0, 0, 0);
                        u32x2 w; w.x = pk2(ha[0] * pl4[0], ha[1] * pl4[1]); w.y = pk2(ha[2] * pl4[2], ha[3] * pl4[3]);
                        *(u32x2*)((bf16*)(ws + WS_HF) + ((size_t)((un * 4 + vt) * 4 + mt) * 64 + lane) * 4) = w; } }
            }
            asm volatile("s_waitcnt lgkmcnt(0)" ::: "memory");
        }
        asm volatile("s_waitcnt vmcnt(0)" ::: "memory");
        { const int ltid = fresh_tid() & 63, l15 = ltid & 15, g = ltid >> 4, lane = ltid;
#define CP_LOADG(gf_, j_) do { const bf16* gp_ = (const bf16*)(ws + WS_GP) + ((size_t)u64 * 4 + (j_)) * 4096 + l15 * 64 + 8 * g; \
            _Pragma("unroll") for (int mt = 0; mt < 4; ++mt) { gf_[mt][0] = *(const bf16x8*)(gp_ + mt * 1024); gf_[mt][1] = *(const bf16x8*)(gp_ + mt * 1024 + 32); } } while (0)
#define CP_LOADH(hf_, j_) do { _Pragma("unroll") for (int sl = 0; sl < 4; ++sl) _Pragma("unroll") for (int mt = 0; mt < 4; ++mt) \
            hf_[sl][mt] = *(const u32x2*)((const bf16*)(ws + WS_HF) + ((size_t)((((size_t)u64 * 4 + (j_)) * 4 + sl) * 4 + mt) * 64 + lane) * 4); } while (0)
#define CP_STEP(gf_, hf_, useh_) do { _Pragma("unroll") for (int sl = 0; sl < 4; ++sl) { bf16x8 zb[2]; RW_ZB(z[sl], zb); \
            _Pragma("unroll") for (int mt = 0; mt < 4; ++mt) { f32x4 a_ = (f32x4){0.f, 0.f, 0.f, 0.f}; \
                if (useh_) { a_[0] = bflo(hf_[sl][mt].x); a_[1] = bfhi(hf_[sl][mt].x); a_[2] = bflo(hf_[sl][mt].y); a_[3] = bfhi(hf_[sl][mt].y); } \
                a_ = __builtin_amdgcn_mfma_f32_16x16x32_bf16(gf_[mt][0], zb[0], a_, 0, 0, 0); a_ = __builtin_amdgcn_mfma_f32_16x16x32_bf16(gf_[mt][1], zb[1], a_, 0, 0, 0); z[sl][mt] = a_; } } } while (0)
        {
            f32x4 z[4][4];
#pragma unroll
            for (int sl = 0; sl < 4; ++sl)
#pragma unroll
                for (int mt = 0; mt < 4; ++mt)
#pragma unroll
                    for (int e = 0; e < 4; ++e) z[sl][mt][e] = (sl == mt && 4 * g + e == l15) ? 1.0f : 0.0f;
            bf16x8 gA[4][2], gB[4][2]; u32x2 hdum[4][4];
            CP_LOADG(gA, 0); CP_LOADG(gB, 1);
            CP_STEP(gA, hdum, false); CP_LOADG(gA, 2);
            CP_STEP(gB, hdum, false); CP_LOADG(gB, 3);
            CP_STEP(gA, hdum, false);
            CP_STEP(gB, hdum, false);
            LAS bf16* tg = (LAS bf16*)(lds + wave * 16384);
#pragma unroll
            for (int sl = 0; sl < 4; ++sl) { const int pc = 32 * (sl >> 1) + 8 * (l15 >> 2) + 4 * (sl & 1) + (l15 & 3);
#pragma unroll
                for (int mt = 0; mt < 4; ++mt)
#pragma unroll
                    for (int e = 0; e < 4; ++e) tg[(16 * mt + 4 * g + e) * 64 + pc] = (bf16)f2bf(z[sl][mt][e]); }
            u32x4* gc = (u32x4*)((bf16*)(ws + WS_GC) + (size_t)u64 * 4096);
#pragma unroll
            for (int i = 0; i < 8; ++i) gc[i * 64 + lane] = *(const LAS u32x4*)(tg + (i * 64 + lane) * 8);
        }
        {
            f32x4 z[4][4];
#pragma unroll
            for (int sl = 0; sl < 4; ++sl)
#pragma unroll
                for (int mt = 0; mt < 4; ++mt) z[sl][mt] = (f32x4){0.f, 0.f, 0.f, 0.f};
            bf16x8 gA[4][2], gB[4][2]; u32x2 hA[4][4], hB[4][4];
            CP_LOADG(gA, 0); CP_LOADH(hA, 0); CP_LOADG(gB, 1); CP_LOADH(hB, 1);
            CP_STEP(gA, hA, true); CP_LOADG(gA, 2); CP_LOADH(hA, 2);
            CP_STEP(gB, hB, true); CP_LOADG(gB, 3); CP_LOADH(hB, 3);
            CP_STEP(gA, hA, true);
            CP_STEP(gB, hB, true);
#pragma unroll
            for (int sl = 0; sl < 4; ++sl)
#pragma unroll
                for (int mt = 0; mt < 4; ++mt) { u32x2 w; w.x = pk2(z[sl][mt][0], z[sl][mt][1]); w.y = pk2(z[sl][mt][2], z[sl][mt][3]);
                    *(u32x2*)((bf16*)(ws + WS_HC) + ((size_t)((u64 * 4 + sl) * 4 + mt) * 64 + lane) * 4) = w; }
        }
#undef CP_LOADG
#undef CP_LOADH
#undef CP_STEP
        }
        }
    }
    SEAM(3);


    if (IN(4)) { PHASE_IDS;
        if (!(bid < 128 && wave == 0)) {
            const int wi = bid < 128 ? bid * 7 + (wave - 1) : 896 + (bid - 128) * 8 + wave, NW = 896 + (G - 128) * 8;
        } else {
            const int l15 = lane & 15, g = lane >> 4, bh = bid >> 2, vs = bid & 3;
            f32x4 z[4];
#pragma unroll
            for (int mt = 0; mt < 4; ++mt) z[mt] = (f32x4){0.f, 0.f, 0.f, 0.f};
            bf16x8 gA[4][2], gB[4][2], gC[4][2], gD[4][2]; u32x2 hA[4], hB[4], hC[4], hD[4];
#define SC_LOAD(gf, hf, C) do { const size_t u64_ = (size_t)bh * 64 + (C); const bf16* gp_ = (const bf16*)(ws + WS_GC) + u64_ * 4096 + l15 * 64 + 8 * g; \
                _Pragma("unroll") for (int mt = 0; mt < 4; ++mt) { gf[mt][0] = *(const bf16x8*)(gp_ + mt * 1024); gf[mt][1] = *(const bf16x8*)(gp_ + mt * 1024 + 32); \
                    hf[mt] = *(const u32x2*)((const bf16*)(ws + WS_HC) + ((size_t)((u64_ * 4 + vs) * 4 + mt) * 64 + lane) * 4); } } while (0)
#define SC_STEP(gf, hf, C) do { const size_t u64_ = (size_t)bh * 64 + (C); bf16* zs_ = (bf16*)(ws + WS_ZS) + ((size_t)((u64_ * 4 + vs) * 4) * 64 + lane) * 4; \
                _Pragma("unroll") for (int mt = 0; mt < 4; ++mt) { u32x2 zw_; zw_.x = pk2(z[mt][0], z[mt][1]); zw_.y = pk2(z[mt][2], z[mt][3]); *(u32x2*)(zs_ + mt * 256) = zw_; } \
                bf16x8 zb[2]; RW_ZB(z, zb); \
                _Pragma("unroll") for (int mt = 0; mt < 4; ++mt) { f32x4 a; a[0] = bflo(hf[mt].x); a[1] = bfhi(hf[mt].x); a[2] = bflo(hf[mt].y); a[3] = bfhi(hf[mt].y); \
                    a = __builtin_amdgcn_mfma_f32_16x16x32_bf16(gf[mt][0], zb[0], a, 0, 0, 0); a = __builtin_amdgcn_mfma_f32_16x16x32_bf16(gf[mt][1], zb[1], a, 0, 0, 0); z[mt] = a; } } while (0)
            bf16x8 gE[4][2]; u32x2 hE[4];
            SC_LOAD(gA, hA, 0); SC_LOAD(gB, hB, 1); SC_LOAD(gC, hC, 2); SC_LOAD(gD, hD, 3);
#pragma unroll 1
            for (int C = 0; C < 60; C += 5) {
                SC_LOAD(gE, hE, C + 4);
                SC_STEP(gA, hA, C);     SC_LOAD(gA, hA, C + 5);
                SC_STEP(gB, hB, C + 1); SC_LOAD(gB, hB, C + 6);
                SC_STEP(gC, hC, C + 2); SC_LOAD(gC, hC, C + 7);
                SC_STEP(gD, hD, C + 3); SC_LOAD(gD, hD, C + 8);
                SC_STEP(gE, hE, C + 4);
            }
            SC_STEP(gA, hA, 60); SC_STEP(gB, hB, 61); SC_STEP(gC, hC, 62); SC_STEP(gD, hD, 63);
#undef SC_LOAD
#undef SC_STEP
        }
    }
    if (IN(4)) { PHASE_IDS;
        if (bid < 32 && wave == 1) { const int bc = bid; const f32x2* ag = (const f32x2*)((const float*)(ws + WS_AP)) + (size_t)(bc * 64) * 64 + lane;
            float* car = (float*)(ws + WS_AP + 4 * MiB) + (size_t)(bc * 64) * 64 + lane; float hst = 0.f;
            f32x2 abv[64];
#pragma unroll
            for (int sg = 0; sg < 64; ++sg) abv[sg] = ag[(size_t)sg * 64];
#pragma unroll
            for (int sg = 0; sg < 64; ++sg) { car[(size_t)sg * 64] = hst; hst = abv[sg].x * hst + abv[sg].y; } }
    }
    if (IN(4)) { PHASE_IDS;
        bf16* WKt = HN; bf16* VWt = HN + (size_t)4 * 1024 * 1024;
        __syncthreads();
        if (bid >= 128 && bid < 192) { pg8::FoldSched<0> S; S.A = (const char*)KM; S.B = (const char*)Wq_t; S.G = 64; S.c = bid - 128; EpiFold<0> E{(unsigned char*)WKt}; pg8::gemm_phase(lds, 256, S, E, wv0, 1024); }
        else if (bid >= 192) { pg8::FoldSched<1> S; S.A = (const char*)Wo_t; S.B = (const char*)VT; S.G = 64; S.c = bid - 192; EpiFold<1> E{(unsigned char*)VWt}; pg8::gemm_phase(lds, 256, S, E, wv0, 1024); }
    }
    SEAM(4);

    if (IN(5)) { PHASE_IDS;
        {
            for (int lu = gw; lu < (M / 64) * 8; lu += NGW) {
                const int seg = lu >> 3, nb = lu & 7, rr = lane >> 3, cq = lane & 7;
                const float* cp = (const float*)(ws + WS_AP + 4 * MiB) + ((size_t)(((seg >> 6) * 8 + nb) * 64 + (seg & 63)) * 64 + 8 * cq);
                const f32x4 c0 = *(const f32x4*)cp, c1 = *(const f32x4*)(cp + 4);
#pragma unroll
                for (int it = 0; it < 8; ++it) { const size_t m = (size_t)seg * 64 + 8 * it + rr; const size_t o = m * 512 + nb * 64 + 8 * cq;
                    const u32x4 pw = __builtin_nontemporal_load((const u32x4*)(LA + o)), hw = __builtin_nontemporal_load((const u32x4*)(LB + o)), gw_ = __builtin_nontemporal_load((const u32x4*)(U + m * INW + 512 + nb * 64 + 8 * cq));
                    float y[8];
#pragma unroll
                    for (int q = 0; q < 4; ++q) { const float ca = q < 2 ? c0[2 * q] : c1[2 * q - 4], cb = q < 2 ? c0[2 * q + 1] : c1[2 * q - 3];
                        y[2 * q] = (bflo(hw[q]) + bflo(pw[q]) * ca) * gelu_tanh_f(bflo(gw_[q])); y[2 * q + 1] = (bfhi(hw[q]) + bfhi(pw[q]) * cb) * gelu_tanh_f(bfhi(gw_[q])); }
                    u32x4 w; w.x = pk2(y[0], y[1]); w.y = pk2(y[2], y[3]); w.z = pk2(y[4], y[5]); w.w = pk2(y[6], y[7]);
                    *(u32x4*)(CAT + m * 1024 + nb * 64 + 8 * cq) = w; }
            }
        }
        const int l15 = lane & 15, g = lane >> 4;
        LAS bf16* tGL = (LAS bf16*)(lds + wave * 16384); LAS bf16* tAD = tGL + 1024; LAS bf16* tOUT = tGL + 2048;
        const int ct = lane >> 3, cc = lane & 7;
        for (int u64 = gw; u64 < NB * NH * (SEQ / 64); u64 += NGW) {
            const int bh = u64 >> 6, C = u64 & 63, b = bh >> 3, h = bh & 7;
            f32x4 z[4][4];
#pragma unroll
            for (int sl = 0; sl < 4; ++sl)
#pragma unroll
                for (int mt = 0; mt < 4; ++mt) { const u32x2 zw = *(const u32x2*)((const bf16*)(ws + WS_ZS) + ((size_t)((u64 * 4 + sl) * 4 + mt) * 64 + lane) * 4); z[sl][mt] = (f32x4){bflo(zw.x), bfhi(zw.x), bflo(zw.y), bfhi(zw.y)}; }
#pragma unroll 1
            for (int j = 0; j < 4; ++j) {
                const size_t un = (size_t)u64 * 4 + j; const size_t m0 = (size_t)b * SEQ + (C * 4 + j) * 16;
                const bf16* rp = (const bf16*)(ws + WS_RP) + un * 1024 + l15 * 64 + 8 * g;
                const bf16x8 rf0 = __builtin_nontemporal_load((const bf16x8*)rp), rf1 = __builtin_nontemporal_load((const bf16x8*)(rp + 32));
                f32x4 y[4];
#pragma unroll
                for (int sl = 0; sl < 4; ++sl) y[sl] = __builtin_nontemporal_load((const f32x4*)((const float*)(ws + WS_Y1F) + ((size_t)(un * 4 + sl) * 64 + lane) * 4));
                const size_t rg = (m0 + ct) * 512 + h * 64 + 8 * cc;
                const u32x4 gl0 = __builtin_nontemporal_load((const u32x4*)((const bf16*)(ws + WS_G) + rg)), gl1 = __builtin_nontemporal_load((const u32x4*)((const bf16*)(ws + WS_G) + rg + 8 * 512));
                const u32x4 ad0 = __builtin_nontemporal_load((const u32x4*)((const bf16*)(ws + WS_ADD) + rg)), ad1 = __builtin_nontemporal_load((const u32x4*)((const bf16*)(ws + WS_ADD) + rg + 8 * 512));
                bf16x8 gf[4][2]; u32x2 hfr[4][4];
                if (j < 3) {
                    const bf16* gp = (const bf16*)(ws + WS_GP) + un * 4096 + l15 * 64 + 8 * g;
#pragma unroll
                    for (int mt = 0; mt < 4; ++mt) { gf[mt][0] = __builtin_nontemporal_load((const bf16x8*)(gp + mt * 1024)); gf[mt][1] = __builtin_nontemporal_load((const bf16x8*)(gp + mt * 1024 + 32)); }
#pragma unroll
                    for (int sl = 0; sl < 4; ++sl)
#pragma unroll
                        for (int mt = 0; mt < 4; ++mt) hfr[sl][mt] = __builtin_nontemporal_load((const u32x2*)((const bf16*)(ws + WS_HF) + ((size_t)((un * 4 + sl) * 4 + mt) * 64 + lane) * 4));
                }
                *(LAS u32x4*)(tGL + ct * 64 + 8 * cc) = gl0; *(LAS u32x4*)(tGL + (ct + 8) * 64 + 8 * cc) = gl1;
                *(LAS u32x4*)(tAD + ct * 64 + 8 * cc) = ad0; *(LAS u32x4*)(tAD + (ct + 8) * 64 + 8 * cc) = ad1;
                bf16x8 zb[4][2];
#pragma unroll
                for (int sl = 0; sl < 4; ++sl) { RW_ZB(z[sl], zb[sl]);
                    y[sl] = __builtin_amdgcn_mfma_f32_16x16x32_bf16(rf0, zb[sl][0], y[sl], 0, 0, 0); y[sl] = __builtin_amdgcn_mfma_f32_16x16x32_bf16(rf1, zb[sl][1], y[sl], 0, 0, 0); }
#pragma unroll
                for (int e = 0; e < 4; ++e) {
                    float s1 = (y[0][e] + y[1][e]) + (y[2][e] + y[3][e]);
                    s1 += __shfl_xor(s1, 1); s1 += __shfl_xor(s1, 2); s1 += __shfl_xor(s1, 4); s1 += __shfl_xor(s1, 8);
                    const float mean = s1 * (1.0f / 64.0f);
                    float d0 = y[0][e] - mean, d1 = y[1][e] - mean, d2 = y[2][e] - mean, d3 = y[3][e] - mean;
                    float s2 = (d0 * d0 + d1 * d1) + (d2 * d2 + d3 * d3);
                    s2 += __shfl_xor(s2, 1); s2 += __shfl_xor(s2, 2); s2 += __shfl_xor(s2, 4); s2 += __shfl_xor(s2, 8);
                    const float rstd = rsq_f(s2 * (1.0f / 64.0f) + GN_EPS);
                    const float dd[4] = {d0, d1, d2, d3};
#pragma unroll
                    for (int sl = 0; sl < 4; ++sl) { const int ti_ = (4 * g + e) * 64 + 16 * sl + l15;
                        const float o = dd[sl] * rstd * bf2f(tGL[ti_]) + bf2f(tAD[ti_]); tOUT[ti_] = (bf16)f2bf(o); }
                }
                { bf16* cp = CAT + (m0 + ct) * 1024 + 512 + h * 64 + 8 * cc;
                  *(u32x4*)cp = *(const LAS u32x4*)(tOUT + ct * 64 + 8 * cc); *(u32x4*)(cp + 8 * 1024) = *(const LAS u32x4*)(tOUT + (ct + 8) * 64 + 8 * cc); }
                if (j < 3) {
#pragma unroll
                    for (int sl = 0; sl < 4; ++sl)
#pragma unroll
                        for (int mt = 0; mt < 4; ++mt) { const u32x2 hh = hfr[sl][mt];
                            f32x4 a; a[0] = bflo(hh.x); a[1] = bfhi(hh.x); a[2] = bflo(hh.y); a[3] = bfhi(hh.y);
                            a = __builtin_amdgcn_mfma_f32_16x16x32_bf16(gf[mt][0], zb[sl][0], a, 0, 0, 0); a = __builtin_amdgcn_mfma_f32_16x16x32_bf16(gf[mt][1], zb[sl][1], a, 0, 0, 0); z[sl][mt] = a; }
                }
            }
        }
    }
    SEAM(5);
#undef RW_ZB


    if (IN(6)) { PHASE_IDS;
        pg8::DenseSched S; S.o.init_tiles(M / 256, D / 256, G, bid); S.A = (const char*)CAT; S.B = (const char*)Wout_t; S.tstep = (size_t)256 * D * 2;
        EpiBf16Res<false> E{args.in[I_X], X1, D, (float*)(ws + WS_AP + 2 * MiB), 1.0f, X1F8}; pg8::gemm_phase(lds, D, S, E, wv0);
    }
    SEAM(6);
    if (IN(7)) { PHASE_IDS;
        pg8::BatchBSched S; S.o.init_tiles(M / 256, D / 256, G, bid); S.A = (const char*)X1F8; S.B = (const char*)HN; S.tstep = (size_t)256 * 1024; S.bstep = (size_t)1024 * 1024;
        EpiSoftmax E{(unsigned char*)Qb, 0.0625f * 0.25f, (const float*)(ws + WS_AP + 2 * MiB), (LAS float*)(lds + RING_BYTES + 1024), (LAS float*)(lds + RING_BYTES + 1024 + 4096)};
        pg8::gemm_phase<EpiSoftmax, pg8::BatchBSched, true, true>(lds, 512, S, E, wv0);
    }
    SEAM(7);
    if (IN(8)) { PHASE_IDS;
        pg8::BatchBSched S; S.o.init_tiles(M / 256, D / 256, G, bid); S.A = (const char*)Qb; S.B = (const char*)(HN + (size_t)4 * 1024 * 1024); S.tstep = (size_t)256 * 1024; S.bstep = (size_t)1024 * 1024;
        EpiBf16Res<true> E{X1, X2, D, nullptr, 1.0f / 1024.0f, nullptr}; pg8::gemm_phase<EpiBf16Res<true>, pg8::BatchBSched, true, true>(lds, 512, S, E, wv0);
    }
    SEAM(8);
    if (IN(9)) { PHASE_IDS;
        for (int cid = tid; cid < 2 * NE * 128; cid += NTHREADS) { const int t = cid >> 12, row = (cid >> 7) & 31, c = cid & 127;
            *(LAS u32x4*)(lds + t * 65536 + row * 2048 + ((c ^ (row & 7)) << 4)) = *(const u32x4*)(WrT + (size_t)t * NE * D + row * D + 8 * c); }
        __syncthreads();
        const int l15 = lane & 15, g = lane >> 4;
        LAS float* LG = (LAS float*)(lds + RING_BYTES + 1024 + wave * 2304);
        const float* gfn = args.in[I_NFFG];
        LAS unsigned* cntl = (LAS unsigned*)(lds + RING_BYTES + 640);
        for (int t0 = 0; t0 < M / 16; t0 += G * 4) {
        if (tid < 64) cntl[tid] = 0u;
        __syncthreads();
        if (t0 == 0 && wave >= 4) {
            constexpr int I_DN = 16 * 32, I_GU = 16 * 64;
            for (int r = bid * 4 + (wave - 4); r < CONV_P9; r += G * 4) { const int e = r / I_GU, q = r % I_GU, kb = q / 64, nb = q % 64; const int n0 = 32 * nb;
                const int drow = n0 < 1024 ? (256 * (n0 >> 7) + (n0 & 127)) : (256 * ((n0 - 1024) >> 7) + 128 + ((n0 - 1024) & 127));
                transpose_item_tiled_fp8_nolds(args.in[I_WGU] + (size_t)e * D * 2048, 2048, D, (unsigned char*)Wgu_t + (size_t)e * 2048 * D, 64 * kb, n0, drow, lane); }
            for (int r = bid * 4 + (wave - 4); r < CONV_P9D; r += G * 4) { const int e = r / I_DN, q = r % I_DN, kb = q / 32, nb = q % 32;
                transpose_item_tiled_fp8_nolds(args.in[I_WDN] + (size_t)e * DFF * D, D, DFF, (unsigned char*)Wdn_t + (size_t)e * D * DFF, 64 * kb, 32 * nb, 32 * nb, lane); }
        }
        const int tile = t0 + bid * 4 + wave; const bool active = wave < 4 && tile < M / 16;
        int me = 0, lpos = 0, ai = 0; float mg = 0.f;
        if (active) {
            const int m0 = tile * 16;
            const bf16* xrow = X2 + (size_t)(m0 + l15) * D + 8 * g;
            float ss = 0.f;
#pragma unroll 8
            for (int ks = 0; ks < 32; ++ks) { const u32x4 xw = *(const u32x4*)(xrow + 32 * ks);
#pragma unroll
                for (int q = 0; q < 4; ++q) { const float a = bflo(xw[q]), c = bfhi(xw[q]); ss += a * a + c * c; } }
            ss += __shfl_xor(ss, 16); ss += __shfl_xor(ss, 32);
            const float rstd = rsq_f(ss * (1.f / D) + EPS);
            f32x4 acc0 = (f32x4){0.f, 0.f, 0.f, 0.f}, acc1 = acc0;
            unsigned char* hrow = (unsigned char*)HN + (size_t)(m0 + l15) * D + 8 * g;
#pragma unroll 2
            for (int ks = 0; ks < 32; ++ks) {
                const f32x4 g0 = *(const f32x4*)(gfn + 32 * ks + 8 * g), g1 = *(const f32x4*)(gfn + 32 * ks + 8 * g + 4);
                const u32x4 xw = *(const u32x4*)(xrow + 32 * ks);
                float hf[8];
#pragma unroll
                for (int q = 0; q < 4; ++q) { hf[2 * q] = bflo(xw[q]) * rstd * (q < 2 ? g0[2 * q] : g1[2 * q - 4]); hf[2 * q + 1] = bfhi(xw[q]) * rstd * (q < 2 ? g0[2 * q + 1] : g1[2 * q - 3]); }
                u32x4 hi, lo;
#pragma unroll
                for (int q = 0; q < 4; ++q) { hi[q] = pk2(hf[2 * q], hf[2 * q + 1]); lo[q] = pk2(hf[2 * q] - bflo(hi[q]), hf[2 * q + 1] - bfhi(hi[q])); }
                { u32x2 h8; h8.x = pk4_fp8(hf[0], hf[1], hf[2], hf[3]); h8.y = pk4_fp8(hf[4], hf[5], hf[6], hf[7]); *(u32x2*)(hrow + 32 * ks) = h8; }
                const bf16x8 ah = __builtin_bit_cast(bf16x8, hi), al = __builtin_bit_cast(bf16x8, lo);
                const int c = 4 * ks + g;
#pragma unroll
                for (int nt = 0; nt < 2; ++nt) { const int row = 16 * nt + l15; const int off = row * 2048 + ((c ^ (row & 7)) << 4);
                    const bf16x8 bh = *(const LAS bf16x8*)(lds + off), bl = *(const LAS bf16x8*)(lds + 65536 + off);
                    f32x4 a = nt ? acc1 : acc0;
                    a = __builtin_amdgcn_mfma_f32_16x16x32_bf16(ah, bh, a, 0, 0, 0); a = __builtin_amdgcn_mfma_f32_16x16x32_bf16(ah, bl, a, 0, 0, 0); a = __builtin_amdgcn_mfma_f32_16x16x32_bf16(al, bh, a, 0, 0, 0);
                    if (nt) acc1 = a; else acc0 = a; }
            }
            { const float b0 = args.in[I_BR][l15], b1 = args.in[I_BR][16 + l15];
#pragma unroll
              for (int j = 0; j < 4; ++j) { LG[(4 * g + j) * 33 + l15] = acc0[j] + b0; LG[(4 * g + j) * 33 + 16 + l15] = acc1[j] + b1; } }
            const int rrow = lane >> 2, qq = lane & 3;
            float tv[4] = {-3.0e38f, -3.0e38f, -3.0e38f, -3.0e38f}; int ti[4] = {64, 65, 66, 67};
#define TOP_INS(xv_, xi_) do { float x_ = (xv_); int i_ = (xi_); _Pragma("unroll") for (int p_ = 0; p_ < 4; ++p_) { const bool b_ = x_ > tv[p_] || (x_ == tv[p_] && i_ < ti[p_]); \
                const float ov_ = tv[p_]; const int oi_ = ti[p_]; tv[p_] = b_ ? x_ : ov_; ti[p_] = b_ ? i_ : oi_; x_ = b_ ? ov_ : x_; i_ = b_ ? oi_ : i_; } } while (0)
#pragma unroll
            for (int j = 0; j < 8; ++j) TOP_INS(LG[rrow * 33 + 8 * qq + j], 8 * qq + j);
#pragma unroll
            for (int st = 1; st < 4; st <<= 1) { float pv[4]; int pi[4];
#pragma unroll
                for (int p = 0; p < 4; ++p) { pv[p] = __shfl_xor(tv[p], st); pi[p] = __shfl_xor(ti[p], st); }
#pragma unroll
                for (int p = 0; p < 4; ++p) TOP_INS(pv[p], pi[p]); }
#undef TOP_INS
            const float e1 = __expf(tv[1] - tv[0]), e2 = __expf(tv[2] - tv[0]), e3 = __expf(tv[3] - tv[0]);
            const float inv = rcp_f(1.0f + e1 + e2 + e3);
            me = qq == 0 ? ti[0] : qq == 1 ? ti[1] : qq == 2 ? ti[2] : ti[3];
            mg = (qq == 0 ? 1.0f : qq == 1 ? e1 : qq == 2 ? e2 : e3) * inv;
            lpos = (int)__hip_atomic_fetch_add(cntl + me, 1u, __ATOMIC_RELAXED, __HIP_MEMORY_SCOPE_WORKGROUP);
            ai = (m0 + rrow) * 4 + qq;
        }
        __syncthreads();
        if (tid < NE) { const unsigned c = cntl[tid]; cntl[32 + tid] = c ? atomicAdd(ecnt + 64 * tid, c) : 0u; }
        __syncthreads();
        if (active) { route_e[ai] = me; route_pos[ai] = (int)cntl[32 + me] + lpos; route_g[ai] = mg; }
        __syncthreads();
        }
    }
    SEAM(9);
    if (IN(10)) { PHASE_IDS;
        LAS int* pst = (LAS int*)lds;
        if (wave == 0) {
            const int c = lane < NE ? (int)__hip_atomic_load(ecnt + 64 * lane, __ATOMIC_RELAXED, __HIP_MEMORY_SCOPE_AGENT) : 0; const int pc = (c + 255) & ~255;
            int x = pc;
#pragma unroll
            for (int d = 1; d < 32; d <<= 1) { const int y = __shfl_up(x, d); if (lane >= d) x += y; }
            if (lane < NE) { pst[lane] = x - pc; pst[64 + lane] = c; } if (lane == NE - 1) pst[32] = x; }
        __syncthreads();
        for (int ai = bid * NTHREADS + tid; ai < NASSIGN; ai += G * NTHREADS) {
            const int e = route_e[ai]; const int row = pst[e] + route_pos[ai]; { u32x2 sg_; sg_.x = (unsigned)ai; sg_.y = __float_as_uint(route_g[ai]); row_sg[row] = sg_; } row_tok[row] = ai >> 2; }
        if (bid < NE) { const int e = bid, c = pst[64 + e], pe = (c + 255) & ~255; for (int p = c + tid; p < pe; p += NTHREADS) { u32x2 sg_; sg_.x = 0xffffffffu; sg_.y = 0u; row_sg[pst[e] + p] = sg_; row_tok[pst[e] + p] = 0; } }
        if (bid == 0 && tid == 0) tile_tab[0] = pst[32] >> 8;
        if (bid >= 128 && bid < 136) { const int nt = pst[32] >> 8, nN = bid < 132 ? 8 : 4; int* tab = (int*)(ws + WS_ROUTE + (bid < 132 ? RT_UGU : RT_UDN));
            for (int L = (bid & 3) * NTHREADS + tid; L < nt * nN; L += 4 * NTHREADS) { Unit uu; { const int nwg = nt * nN; int wgid = L; { const int q = nwg / 8, r = nwg % 8, xcd = wgid % 8, off = wgid / 8; wgid = (xcd < r ? xcd * (q + 1) : r * (q + 1) + (xcd - r) * q) + off; }
                    const int nig = 8 * nN, gid = wgid / nig, fm = gid * 8, gsz = (nt - fm) < 8 ? (nt - fm) : 8; uu.pm = fm + ((wgid % nig) % gsz); uu.pn = (wgid % nig) / gsz; uu.e = 0; }
                int e = 0;
#pragma unroll
                for (int st = 16; st >= 1; st >>= 1) { if ((pst[e + st] >> 8) <= uu.pm) e += st; }
                tab[L] = uu.pm | (uu.pn << 12) | (e << 16); } }
        __syncthreads();
    }
    SEAM(10);
    if (IN(11)) {
        const int ntiles = tile_tab[0];
        pg8::MoeGatherSched S; S.o.init_tiles(ntiles, 2048 / 256, G, bid); S.A = (const char*)HN; S.B = (const char*)Wgu_t; S.tile_e = tile_tab + 16; S.utab = (const int*)(ws + WS_ROUTE + RT_UGU); S.rtok = row_tok; S.tstep = (size_t)256 * 1024; S.estep = (size_t)2048 * 1024;
        EpiSwiglu E{ACT, args.in[I_BGU]}; pg8::gemm_phase<EpiSwiglu, pg8::MoeGatherSched, true, true>(lds, 512, S, E, wv0);
        { PHASE_IDS; LAS float* scr = (LAS float*)(lds + wave * 16384); constexpr int I_DN = 16 * 32;
          for (;;) { int c0 = 0; if (lane == 0) c0 = (int)atomicAdd(ctl + CW_CONV, 8u); c0 = __builtin_amdgcn_readfirstlane(c0);
              c0 += CONV_P9D; if (c0 >= NE * I_DN) break;
              for (int r = c0; r < c0 + 8; ++r) { const int e = r / I_DN, q = r % I_DN, kb = q / 32, nb = q % 32;
                  transpose_item_tiled_fp8(args.in[I_WDN] + (size_t)e * DFF * D, D, DFF, (unsigned char*)Wdn_t + (size_t)e * D * DFF, 64 * kb, 32 * nb, 32 * nb, scr, lane); } } }
    }
    SEAM(11);
    if (IN(12)) {
        const int ntiles = tile_tab[0];
        pg8::MoeSched S; S.o.init_tiles(ntiles, D / 256, G, bid); S.A = (const char*)ACT; S.B = (const char*)Wdn_t; S.tile_e = tile_tab + 16; S.utab = (const int*)(ws + WS_ROUTE + RT_UDN); S.tstep = (size_t)256 * 1024; S.estep = (size_t)1024 * 1024;
        EpiDown E{YS, args.in[I_BDN], row_sg}; pg8::gemm_phase<EpiDown, pg8::MoeSched, true, true>(lds, 512, S, E, wv0);
    }
    SEAM(12);
    if (IN(13)) { PHASE_IDS;
        const float* gfin = args.in[I_FNG];
        for (int m = gw; m < M; m += NGW) {
            float v[16]; float s = 0.f;
#pragma unroll
            for (int hf = 0; hf < 2; ++hf) { const u32x4 w = __builtin_nontemporal_load((const u32x4*)(X2 + (size_t)m * D + 512 * hf + 8 * lane));
#pragma unroll
                for (int q = 0; q < 4; ++q) { v[8 * hf + 2 * q] = bflo(w[q]); v[8 * hf + 2 * q + 1] = bfhi(w[q]); }
#pragma unroll
                for (int k = 0; k < 4; ++k) { const u32x2 y = __builtin_nontemporal_load((const u32x2*)((const unsigned char*)YS + (size_t)(m * 4 + k) * D + 512 * hf + 8 * lane));
#pragma unroll
                    for (int q = 0; q < 2; ++q) { const auto lo2 = __builtin_amdgcn_cvt_pk_f32_fp8((int)y[q], false), hi2 = __builtin_amdgcn_cvt_pk_f32_fp8((int)y[q], true);
                        v[8 * hf + 4 * q] += lo2[0] * 0.0625f; v[8 * hf + 4 * q + 1] += lo2[1] * 0.0625f; v[8 * hf + 4 * q + 2] += hi2[0] * 0.0625f; v[8 * hf + 4 * q + 3] += hi2[1] * 0.0625f; } } }
#pragma unroll
            for (int j = 0; j < 16; ++j) s += v[j] * v[j];
            const float rstd = rsq_f(wave_sum(s) * (1.f / D) + EPS);
#pragma unroll
            for (int hf = 0; hf < 2; ++hf) { const f32x4 g0 = *(const f32x4*)(gfin + 512 * hf + 8 * lane), g1 = *(const f32x4*)(gfin + 512 * hf + 8 * lane + 4);
                float* o = args.out + (size_t)m * D + 512 * hf + 8 * lane;
                __builtin_nontemporal_store((f32x4){v[8 * hf] * rstd * g0.x, v[8 * hf + 1] * rstd * g0.y, v[8 * hf + 2] * rstd * g0.z, v[8 * hf + 3] * rstd * g0.w}, (f32x4*)o);
                __builtin_nontemporal_store((f32x4){v[8 * hf + 4] * rstd * g1.x, v[8 * hf + 5] * rstd * g1.y, v[8 * hf + 6] * rstd * g1.z, v[8 * hf + 7] * rstd * g1.w}, (f32x4*)(o + 4)); }
        }
    }
#undef IN
#undef SEAM
}

constexpr int N_PHASES = 14;
extern "C" void kernel_launch(void* const* d_in, const int* in_sizes, int n_in, void* d_out, int out_size, void* d_ws, size_t ws_size, hipStream_t stream) {
    static int grid = 0;
    if (grid == 0) {
        if (n_in != 37 || out_size != M * D || ws_size < WS_END) { fprintf(stderr, "kernel_launch: unexpected shapes (n_in %d, out %d, ws %zu); nothing launched\n", n_in, out_size, ws_size); grid = -1; return; }
        int dev = 0, cus = 0, per_cu = 0;
        if (hipGetDevice(&dev) != hipSuccess || hipDeviceGetAttribute(&cus, hipDeviceAttributeMultiprocessorCount, dev) != hipSuccess) { grid = -1; return; }
        if (hipFuncSetAttribute((const void*)fwd, hipFuncAttributeMaxDynamicSharedMemorySize, LDS_BYTES) != hipSuccess) { fprintf(stderr, "kernel_launch: hipFuncSetAttribute failed\n"); grid = -1; return; }
        if (hipOccupancyMaxActiveBlocksPerMultiprocessor(&per_cu, (const void*)fwd, NTHREADS, LDS_BYTES) != hipSuccess || per_cu < 1) fprintf(stderr, "kernel_launch: occupancy query says %d\n", per_cu);
        (void)hipGetLastError();
        grid = cus > 256 ? 256 : cus;
    }
    if (grid < 0) return;
    if (hipMemsetAsync((char*)d_ws + WS_CTL, 0, CTL_ZERO_BYTES, stream) != hipSuccess) return;
    Args a{};
    for (int i = 0; i < 37; ++i) a.in[i] = (const float*)d_in[i];
    a.out = (float*)d_out; a.ws = (unsigned char*)d_ws;
#if MK_ONE_LAUNCH
    a.ph_lo = 0; a.ph_hi = N_PHASES;
    hipLaunchKernelGGL(fwd, dim3(grid), dim3(NTHREADS), LDS_BYTES, stream, a);
#else
    for (int p = 0; p < N_PHASES; ++p) { a.ph_lo = p; a.ph_hi = p + 1; hipLaunchKernelGGL(fwd, dim3(grid), dim3(NTHREADS), LDS_BYTES, stream, a);
#ifdef PROBE_REPEAT_PHASE
        if (p == PROBE_REPEAT_PHASE) hipLaunchKernelGGL(fwd, dim3(grid), dim3(NTHREADS), LDS_BYTES, stream, a);
#endif
    }
#endif
}
```

```cpp
#include <hip/hip_runtime.h>
#include <cstdio>
#include <cstdint>

#ifndef MK_ONE_LAUNCH
#define MK_ONE_LAUNCH 1
#endif

#define DI __device__ __forceinline__
#define GAS __attribute__((address_space(1)))
#define LAS __attribute__((address_space(3)))
typedef unsigned short bf16;
typedef short bf16x8 __attribute__((ext_vector_type(8)));
typedef int v4i __attribute__((ext_vector_type(4)));
typedef int v8i __attribute__((ext_vector_type(8)));
typedef float f32x4 __attribute__((ext_vector_type(4)));
typedef float f32x2 __attribute__((ext_vector_type(2)));
typedef unsigned u32x4 __attribute__((ext_vector_type(4)));
typedef unsigned u32x2 __attribute__((ext_vector_type(2)));

constexpr int D = 1024, NB = 4, SEQ = 4096, M = NB * SEQ;
constexpr int MEML = 256, MROWS = NB * MEML;
constexpr int LRU_W = 512, RW = 512, NH = 8, HD = 64;
constexpr int INW = 2816;
constexpr int XH = 4, XHD = 256;
constexpr int NE = 32, TOPK = 4, DFF = 1024;
constexpr int NASSIGN = M * TOPK;
constexpr int MAXTILES = 288, MAXROWS = MAXTILES * 256;
constexpr float EPS = 1e-6f, GN_EPS = 64e-5f;

DI int fresh_tid_(int wv) { int w = wv; asm volatile("" : "+s"(w)); int l; asm volatile("v_mbcnt_lo_u32_b32 %0, -1, 0\n\tv_mbcnt_hi_u32_b32 %0, -1, %0" : "=v"(l)); return (w << 6) | (l & 63); }
#define fresh_tid() fresh_tid_(wv0)
namespace pg8 {
constexpr int BM = 256, BK = 64, HALF = 128, HTB = HALF * BK * 2, STAGE_BYTES = 8 * HTB, NXCD = 8, WGM = 8;
__host__ __device__ __forceinline__ int lds_byte(int r, int c) { const int st = (r >> 4) * 2 + (c >> 5), rr = r & 15, cc = c & 31, ob = rr * 64 + cc * 2; return st * 1024 + (ob ^ (((ob >> 9) & 1) << 5)); }
__host__ __device__ __forceinline__ void stage_rc(int b, int& R, int& C) { const int st = b / 1024, sb = b % 1024, swz = sb ^ (((sb >> 9) & 1) << 5); R = (st >> 1) * 16 + swz / 64; C = (st & 1) * 32 + (swz % 64) / 2; }
__host__ __device__ __forceinline__ int perm32(int rho) { const int n = rho >> 4, i = rho & 15; return 8 * (i >> 2) + 4 * n + (i & 3); }

struct Unit { int pm, pn, e; };

struct StaticOrder {
    int nM, nN, nwg, G, c;
    __host__ __device__ void init_tiles(int nM_, int nN_, int G_, int c_) { nM = nM_; nN = nN_; nwg = nM * nN; G = G_; c = c_; }
    __host__ __device__ bool next(int i, Unit& u) const {
        const long L = (long)i * G + c; if (L >= nwg) return false;
        int wgid = (int)L; { const int q = nwg / NXCD, r = nwg % NXCD, xcd = wgid % NXCD, off = wgid / NXCD; wgid = (xcd < r ? xcd * (q + 1) : r * (q + 1) + (xcd - r) * q) + off; }
        const int nig = WGM * nN, gid = wgid / nig, fm = gid * WGM, gsz = (nM - fm) < WGM ? (nM - fm) : WGM;
        u.pm = fm + ((wgid % nig) % gsz); u.pn = (wgid % nig) / gsz; u.e = 0; return true;
    }
};
struct DenseSched {
    static constexpr bool GATHER = false, B_TILED = false;
    StaticOrder o; const char* A; const char* B; size_t tstep;
    DI bool next(int i, Unit& u) const { return o.next(i, u); }
    DI const char* a_ptr(const Unit& u) const { return A + (size_t)u.pm * tstep; }
    DI const char* b_ptr(const Unit& u) const { return B + (size_t)u.pn * tstep; }
    DI void a_voff(const Unit&, int K, const int (&R)[2], const int (&C)[2], unsigned (&vo)[2][2]) const {
#pragma unroll
        for (int h = 0; h < 2; ++h)
#pragma unroll
            for (int i = 0; i < 2; ++i) vo[h][i] = (unsigned)((h * HALF + R[i]) * K + C[i]) * 2u; }
};
struct MoeSched {
    static constexpr bool GATHER = false, B_TILED = true;
    StaticOrder o; const char* A; const char* B; const int* tile_e; const int* utab; size_t tstep, estep;
    DI bool next(int i, Unit& u) const { const int L = i * o.G + o.c; if (L >= o.nwg) return false; int en; asm volatile("s_load_dword %0, %1, 0x0\n\ts_waitcnt lgkmcnt(0)" : "=s"(en) : "s"(utab + L) : "memory");     u.pm = en & 0xfff; u.pn = (en >> 12) & 15; u.e = en >> 16; return true; }
    DI const char* a_ptr(const Unit& u) const { return A + (size_t)u.pm * tstep; }
    DI const char* b_ptr(const Unit& u) const { return B + (size_t)u.e * estep + (size_t)u.pn * tstep; }
    DI void a_voff(const Unit&, int K, const int (&R)[2], const int (&C)[2], unsigned (&vo)[2][2]) const {
#pragma unroll
        for (int h = 0; h < 2; ++h)
#pragma unroll
            for (int i = 0; i < 2; ++i) vo[h][i] = (unsigned)((h * HALF + R[i]) * K + C[i]) * 2u; }
};
struct MoeGatherSched {
    static constexpr bool GATHER = true, B_TILED = true;
    StaticOrder o; const char* A; const char* B; const int* tile_e; const int* utab; const int* rtok; size_t tstep, estep;
    DI bool next(int i, Unit& u) const { const int L = i * o.G + o.c; if (L >= o.nwg) return false; int en; asm volatile("s_load_dword %0, %1, 0x0\n\ts_waitcnt lgkmcnt(0)" : "=s"(en) : "s"(utab + L) : "memory");     u.pm = en & 0xfff; u.pn = (en >> 12) & 15; u.e = en >> 16; return true; }
    DI const char* a_ptr(const Unit&) const { return A; }
    DI const char* b_ptr(const Unit& u) const { return B + (size_t)u.e * estep + (size_t)u.pn * tstep; }
    DI void a_voff(const Unit& u, int K, const int (&R)[2], const int (&C)[2], unsigned (&vo)[2][2]) const {
#pragma unroll
        for (int h = 0; h < 2; ++h)
#pragma unroll
            for (int i = 0; i < 2; ++i) vo[h][i] = (unsigned)(rtok[u.pm * BM + h * HALF + R[i]] * K + C[i]) * 2u; }
};

struct BatchBSched {
    static constexpr bool GATHER = false, B_TILED = false;
    StaticOrder o; const char* A; const char* B; size_t tstep, bstep;
    DI bool next(int i, Unit& u) const { return o.next(i, u); }
    DI const char* a_ptr(const Unit& u) const { return A + (size_t)u.pm * tstep; }
    DI const char* b_ptr(const Unit& u) const { return B + (size_t)(u.pm >> 4) * bstep + (size_t)u.pn * tstep; }
    DI void a_voff(const Unit&, int K, const int (&R)[2], const int (&C)[2], unsigned (&vo)[2][2]) const {
#pragma unroll
        for (int h = 0; h < 2; ++h)
#pragma unroll
            for (int i = 0; i < 2; ++i) vo[h][i] = (unsigned)((h * HALF + R[i]) * K + C[i]) * 2u; }
};
template <int MODE> struct FoldSched {
    static constexpr bool GATHER = false, B_TILED = false;
    const char* A; const char* B; int G, c;
    DI bool next(int i, Unit& u) const { const int L = i * G + c; if (L >= 64) return false; u.pm = L >> 2; u.pn = L & 3; u.e = 0; return true; }
    DI const char* a_ptr(const Unit& u) const { const int b = u.pm >> 2, h = u.pm & 3; return A + ((size_t)(MODE == 0 ? b * 256 : u.pn * 256) * 1024 + h * 256) * 2; }
    DI const char* b_ptr(const Unit& u) const { const int b = u.pm >> 2, h = u.pm & 3; return B + ((size_t)(MODE == 0 ? u.pn * 256 : b * 256) * 1024 + h * 256) * 2; }
    DI void a_voff(const Unit&, int K, const int (&R)[2], const int (&C)[2], unsigned (&vo)[2][2]) const {
#pragma unroll
        for (int h = 0; h < 2; ++h)
#pragma unroll
            for (int i = 0; i < 2; ++i) vo[h][i] = (unsigned)((h * HALF + R[i]) * K + C[i]) * 2u; }
};

DI unsigned cvt_pk_bf16(float lo, float hi) { unsigned r; asm volatile("v_cvt_pk_bf16_f32 %0, %1, %2" : "=v"(r) : "v"(lo), "v"(hi)); return r; }

template <class Epi, class Sched, bool ALIGN_EPI = true, bool FP8 = false>
DI void gemm_phase(LAS unsigned char* lds, const int K, const Sched& S, const Epi& E, const int wv0, const int ldp = 0) {
    const int ld = ldp ? ldp : K;
    const int tid = fresh_tid(), wid = __builtin_amdgcn_readfirstlane(tid >> 6), lane = tid & 63, wr = wid >> 2, wc = wid & 3, fr = lane & 15, fq = lane >> 4;
    const int nt = K / BK;
    constexpr bool GA = Sched::GATHER, BT = Sched::B_TILED;
    unsigned voffA[2][2], voffAn[2][2], voffB[2];
#pragma unroll
    for (int i = 0; i < 2; ++i) { int R, C; stage_rc(tid * 16 + i * 8192, R, C); const int Rb = Epi::PERM ? ((R & ~31) + perm32(R & 31)) : R;
        voffB[i] = BT ? (unsigned)(tid * 16 + i * 8192) : (unsigned)(Rb * ld + C) * 2u; }
#define PG8_AVOFF(unit, dst) do { int sR[2], sC[2]; const int t2_ = fresh_tid(); stage_rc(t2_ * 16, sR[0], sC[0]); stage_rc(t2_ * 16 + 8192, sR[1], sC[1]); S.a_voff(unit, ld, sR, sC, dst); } while (0)
    const size_t kstep = (size_t)(BK * 2);
    const size_t hstep = (size_t)HALF * ld * 2;
    const size_t kstepB = BT ? (size_t)(2 * HTB) : kstep, hstepB = BT ? (size_t)HTB : hstep;
    const unsigned ldsw = (unsigned)wid * 1024u;
    unsigned aoffv = (unsigned)(size_t)lds + (unsigned)lds_byte(wr * 64 + fr, fq * 8), boffv = (unsigned)(size_t)lds + (unsigned)(4 * HTB) + (unsigned)lds_byte(wc * 32 + fr, fq * 8);
    asm volatile("" : "+v"(aoffv), "+v"(boffv));
    const size_t dB = BT ? (size_t)8192 : (size_t)64 * ld * 2, dA = (size_t)64 * ld * 2;
#define PG8_SA(b, h) (((b) * 2 + (h)) * HTB)
#define PG8_SB(b, h) ((4 + (b) * 2 + (h)) * HTB)
    const unsigned ldsbase = (unsigned)__builtin_amdgcn_readfirstlane((int)((unsigned)(size_t)lds + ldsw));
#define PG8_STAGE1(bufoff, gptr, vo, i_) do { const unsigned m0v_ = ldsbase + (unsigned)(bufoff) + (unsigned)(i_) * 8192u; \
        asm volatile("s_mov_b32 m0, %2\n\ts_nop 0\n\tglobal_load_lds_dwordx4 %0, %1" :: "v"(vo), "s"((const char*)(gptr)), "s"(m0v_) : "memory", "m0"); } while (0)
#define PG8_STAGE(bufoff, gbase, voff) do { PG8_STAGE1(bufoff, gbase, (voff)[0], 0); PG8_STAGE1(bufoff, gbase, (voff)[1], 1); } while (0)
#define PG8_STAGE_D(bufoff, gbase, vo, delta) do { PG8_STAGE1(bufoff, gbase, vo, 0); PG8_STAGE1(bufoff, (const char*)(gbase) + (delta), vo, 1); } while (0)
#define PG8_LDA(dst, b, h) do { if constexpr (FP8) { _Pragma("unroll") for (int m = 0; m < 4; ++m) { const LAS v4i* p_ = (const LAS v4i*)((LAS unsigned char*)(size_t)aoffv + PG8_SA(b, h) + m * 2048); dst##8[m] = __builtin_shufflevector(p_[0], p_[64], 0, 1, 2, 3, 4, 5, 6, 7); } } \
        else { _Pragma("unroll") for (int m = 0; m < 4; ++m) _Pragma("unroll") for (int k = 0; k < 2; ++k) dst[m][k] = *(const LAS bf16x8*)((LAS unsigned char*)(size_t)aoffv + PG8_SA(b, h) + m * 2048 + k * 1024); } } while (0)
#define PG8_LDB(dst, b, h) do { if constexpr (FP8) { _Pragma("unroll") for (int n = 0; n < 2; ++n) { const LAS v4i* p_ = (const LAS v4i*)((LAS unsigned char*)(size_t)boffv + (PG8_SB(b, h) - 4 * HTB) + n * 2048); dst##8[n] = __builtin_shufflevector(p_[0], p_[64], 0, 1, 2, 3, 4, 5, 6, 7); } } \
        else { _Pragma("unroll") for (int n = 0; n < 2; ++n) _Pragma("unroll") for (int k = 0; k < 2; ++k) dst[n][k] = *(const LAS bf16x8*)((LAS unsigned char*)(size_t)boffv + (PG8_SB(b, h) - 4 * HTB) + n * 2048 + k * 1024); } } while (0)
#define PG8_MMA(ai, bj, At, Bt) do { __builtin_amdgcn_s_setprio(1); \
        if constexpr (FP8) {   \
            _Pragma("unroll") for (int m = 0; m < 4; ++m) _Pragma("unroll") for (int n = 0; n < 2; ++n) \
                acc[ai][bj][m][n] = __builtin_amdgcn_mfma_scale_f32_16x16x128_f8f6f4(Bt##8[n], At##8[m], acc[ai][bj][m][n], 0, 0, 0, 0, 0, 0); } \
        else { _Pragma("unroll") for (int m = 0; m < 4; ++m) _Pragma("unroll") for (int n = 0; n < 2; ++n) _Pragma("unroll") for (int k = 0; k < 2; ++k) \
            acc[ai][bj][m][n] = __builtin_amdgcn_mfma_f32_16x16x32_bf16(Bt[n][k], At[m][k], acc[ai][bj][m][n], 0, 0, 0); } \
        __builtin_amdgcn_s_setprio(0); } while (0)
#define PG8_WAIT_V(n) asm volatile("s_waitcnt vmcnt(" #n ")" ::: "memory")
#define PG8_WAIT_L(n) asm volatile("s_waitcnt lgkmcnt(" #n ")" ::: "memory")
#define PG8_BAR __builtin_amdgcn_s_barrier()
#define PG8_SCHED __builtin_amdgcn_sched_barrier(0)
    Unit cur, nxt; int ui = 0;
    if (!S.next(0, cur)) return;
    f32x4 acc[2][2][4][2];
#pragma unroll
    for (int a = 0; a < 2; ++a)
#pragma unroll
        for (int b = 0; b < 2; ++b)
#pragma unroll
            for (int m = 0; m < 4; ++m)
#pragma unroll
                for (int n = 0; n < 2; ++n) acc[a][b][m][n] = (f32x4){0.f, 0.f, 0.f, 0.f};
    bf16x8 At[4][2], B0[2][2], B1[2][2]; v8i At8[4], B08[2], B18[2];
    const char* cA = S.a_ptr(cur); const char* cB = S.b_ptr(cur);
    PG8_AVOFF(cur, voffA);
#define PG8_STAGE_A(bufoff, kbase, h, vo) do { if constexpr (GA) { PG8_STAGE(bufoff, kbase, (vo)[h]); } else { PG8_STAGE_D(bufoff, (kbase) + (h) * hstep, voffA[0][0], dA); } } while (0)
    PG8_STAGE_D(PG8_SB(0, 0), cB, voffB[0], dB); PG8_STAGE_D(PG8_SB(0, 1), cB + hstepB, voffB[0], dB); PG8_STAGE_A(PG8_SA(0, 0), cA, 0, voffA); PG8_STAGE_A(PG8_SA(0, 1), cA, 1, voffA);
    if (wr == 1) PG8_BAR;
    PG8_WAIT_V(2); PG8_BAR;
    PG8_STAGE_D(PG8_SB(1, 0), cB + kstepB, voffB[0], dB); PG8_STAGE_A(PG8_SA(1, 0), cA + kstep, 0, voffA); PG8_STAGE_D(PG8_SB(1, 1), cB + hstepB + kstepB, voffB[0], dB);
    PG8_WAIT_V(6); PG8_BAR;
    for (;;) {
        const bool has_next = S.next(ui + 1, nxt);
        const char* nA = has_next ? S.a_ptr(nxt) : cA; const char* nB = has_next ? S.b_ptr(nxt) : cB;
        if constexpr (GA) { if (has_next) PG8_AVOFF(nxt, voffAn);
            else {
#pragma unroll
                for (int h = 0; h < 2; ++h)
#pragma unroll
                    for (int i = 0; i < 2; ++i) voffAn[h][i] = voffA[h][i]; } }
#pragma unroll 1
        for (int t = 0; t < nt; t += 2) {
            const bool last = (t == nt - 2);
            const char* a1 = cA + (size_t)(t + 1) * kstep;
            const char* a2 = last ? nA : cA + (size_t)(t + 2) * kstep; const char* b2 = last ? nB : cB + (size_t)(t + 2) * kstepB;
            const char* a3 = a2 + kstep; const char* b3 = b2 + kstepB;
            PG8_LDB(B0, 0, 0); PG8_LDB(B1, 0, 1); PG8_SCHED; PG8_LDA(At, 0, 0); PG8_STAGE_A(PG8_SA(1, 1), a1, 1, voffA);
            if constexpr (GA) { if (last) {
#pragma unroll
                for (int h = 0; h < 2; ++h)
#pragma unroll
                    for (int i = 0; i < 2; ++i) voffA[h][i] = voffAn[h][i]; } }
            PG8_WAIT_V(8); PG8_WAIT_L(0); PG8_BAR; PG8_MMA(0, 0, At, B0); PG8_MMA(0, 1, At, B1); PG8_BAR; PG8_SCHED;
            PG8_LDA(At, 0, 1); PG8_STAGE_D(PG8_SB(0, 0), b2, voffB[0], dB); PG8_STAGE_D(PG8_SB(0, 1), b2 + hstepB, voffB[0], dB); PG8_STAGE_A(PG8_SA(0, 0), a2, 0, voffA);
            PG8_WAIT_V(8); PG8_WAIT_L(0); PG8_BAR; PG8_MMA(1, 0, At, B0); PG8_MMA(1, 1, At, B1); PG8_BAR; PG8_SCHED;
            PG8_LDB(B0, 1, 0); PG8_LDB(B1, 1, 1); PG8_SCHED; PG8_LDA(At, 1, 0); PG8_STAGE_A(PG8_SA(0, 1), a2, 1, voffA);
            PG8_WAIT_V(8); PG8_WAIT_L(0); PG8_BAR; PG8_MMA(0, 0, At, B0); PG8_MMA(0, 1, At, B1); PG8_BAR; PG8_SCHED;
            PG8_LDA(At, 1, 1); PG8_STAGE_D(PG8_SB(1, 0), b3, voffB[0], dB); PG8_STAGE_D(PG8_SB(1, 1), b3 + hstepB, voffB[0], dB); PG8_STAGE_A(PG8_SA(1, 0), a3, 0, voffA);
            PG8_WAIT_V(8); PG8_WAIT_L(0); PG8_BAR; PG8_MMA(1, 0, At, B0); PG8_MMA(1, 1, At, B1); PG8_BAR; PG8_SCHED;
        }
        if constexpr (ALIGN_EPI) { if (wr == 0) PG8_BAR; }
        { Unit ue = cur; ue.pm = __builtin_amdgcn_readfirstlane(ue.pm); ue.pn = __builtin_amdgcn_readfirstlane(ue.pn); ue.e = __builtin_amdgcn_readfirstlane(ue.e); asm volatile("" : "+s"(ue.pm), "+s"(ue.pn), "+s"(ue.e));
          const int t3_ = fresh_tid(); const int fr_ = t3_ & 15, fq_ = (t3_ & 63) >> 4;
          E(acc, ue, wr, wc, fr_, fq_); }
        if (!has_next) break;
#pragma unroll
        for (int a = 0; a < 2; ++a)
#pragma unroll
            for (int b = 0; b < 2; ++b)
#pragma unroll
                for (int m = 0; m < 4; ++m)
#pragma unroll
                    for (int n = 0; n < 2; ++n) acc[a][b][m][n] = (f32x4){0.f, 0.f, 0.f, 0.f};
        cur = nxt; cA = nA; cB = nB; ++ui;
        if constexpr (ALIGN_EPI) { if (wr == 1) PG8_BAR; }
    }
    PG8_WAIT_V(0);
    if constexpr (!ALIGN_EPI) { if (wr == 0) PG8_BAR; }
    PG8_BAR;
#undef PG8_SA
#undef PG8_SB
#undef PG8_STAGE
#undef PG8_STAGE1
#undef PG8_STAGE_D
#undef PG8_STAGE_A
#undef PG8_AVOFF
#undef PG8_LDA
#undef PG8_LDB
#undef PG8_MMA
#undef PG8_WAIT_V
#undef PG8_WAIT_L
#undef PG8_BAR
#undef PG8_SCHED
}
}
using pg8::Unit;
using pg8::cvt_pk_bf16;

DI float bflo(unsigned w) { return __uint_as_float(w << 16); }
DI float bfhi(unsigned w) { return __uint_as_float(w & 0xffff0000u); }
DI float bf2f(bf16 b) { return __uint_as_float(((unsigned)b) << 16); }
typedef __bf16 hwbf2 __attribute__((ext_vector_type(2)));
DI unsigned pk2(float lo, float hi) { const f32x2 v = {lo, hi}; return __builtin_bit_cast(unsigned, __builtin_convertvector(v, hwbf2)); }
DI unsigned f2bf(float f) { return pk2(f, 0.f) & 0xffffu; }
DI float rcp_f(float x) { return __builtin_amdgcn_rcpf(x); }
DI float rsq_f(float x) { return __builtin_amdgcn_rsqf(x); }
DI float sigmoid_f(float x) { return rcp_f(1.0f + __expf(-x)); }
DI float tanh_fast(float x) { return 1.0f - 2.0f * rcp_f(__expf(2.0f * x) + 1.0f); }
DI float softplus_f(float x) { return fmaxf(x, 0.f) + __logf(1.0f + __expf(-fabsf(x))); }
DI float softplus_fast(float x) { return fmaxf(x, 0.f) + __logf(1.0f + __expf(-fabsf(x))); }
DI float gelu_tanh_f(float x) { const float u = 0.7978845608028654f * (x + 0.044715f * x * x * x); return 0.5f * x * (1.0f + tanh_fast(u)); }
DI float wave_sum(float v) {
#pragma unroll
    for (int o = 1; o < 64; o <<= 1) v += __shfl_xor(v, o);
    return v;
}

DI unsigned pk4_fp8(float a, float b, float c, float d) { int w = 0; w = __builtin_amdgcn_cvt_pk_fp8_f32(a, b, w, false); w = __builtin_amdgcn_cvt_pk_fp8_f32(c, d, w, true); return (unsigned)w; }
struct EpiBf16Plain {
    static constexpr bool PERM = true;
    bf16* O; int ldc; float scale;
    DI void operator()(const f32x4 (&acc)[2][2][4][2], const Unit& u, int wr, int wc, int fr, int fq) const {
        const int row0 = u.pm * 256 + wr * 64 + fr, col0 = u.pn * 256 + wc * 32 + 8 * fq;
#pragma unroll
        for (int ai = 0; ai < 2; ++ai)
#pragma unroll
            for (int m = 0; m < 4; ++m) { bf16* rowp = O + (size_t)(row0 + ai * 128 + m * 16) * ldc + col0;
#pragma unroll
                for (int bj = 0; bj < 2; ++bj) { const f32x4 v0 = acc[ai][bj][m][0] * scale, v1 = acc[ai][bj][m][1] * scale;
                    u32x4 w; w.x = cvt_pk_bf16(v0[0], v0[1]); w.y = cvt_pk_bf16(v0[2], v0[3]); w.z = cvt_pk_bf16(v1[0], v1[1]); w.w = cvt_pk_bf16(v1[2], v1[3]);
                    *(u32x4*)(rowp + bj * 128) = w; } }
    }
};
template <int MODE> struct EpiFold {
    static constexpr bool PERM = true;
    unsigned char* O;
    DI void operator()(const f32x4 (&acc)[2][2][4][2], const Unit& u, int wr, int wc, int fr, int fq) const {
        const int b = u.pm >> 2, h = u.pm & 3;
        const int rbase = MODE == 0 ? h * 256 : u.pn * 256, cbase = MODE == 0 ? u.pn * 256 : h * 256;
        const unsigned boff = (unsigned)b * 1024u * 1024u + (unsigned)(rbase + wr * 64 + fr) * 1024u + (unsigned)(cbase + wc * 32 + 8 * fq);
#pragma unroll
        for (int ai = 0; ai < 2; ++ai)
#pragma unroll
            for (int m = 0; m < 4; ++m) { unsigned char* rowp = O + (boff + (unsigned)(ai * 128 + m * 16) * 1024u);
#pragma unroll
                for (int bj = 0; bj < 2; ++bj) { const f32x4 v0 = acc[ai][bj][m][0] * 4.0f, v1 = acc[ai][bj][m][1] * 4.0f;
                    u32x2 w; w.x = pk4_fp8(v0[0], v0[1], v0[2], v0[3]); w.y = pk4_fp8(v1[0], v1[1], v1[2], v1[3]);
                    *(u32x2*)(rowp + bj * 128) = w; } }
    }
};
struct EpiSoftmax {
    static constexpr bool PERM = true;
    unsigned char* O; float scale; const float* RS; LAS float* XM; LAS float* XS;
    DI void operator()(const f32x4 (&acc)[2][2][4][2], const Unit& u, int wr, int wc, int fr, int fq) const {
        const int row0 = u.pm * 256 + wr * 64 + fr, col0 = u.pn * 256 + wc * 32 + 8 * fq;
        float sc[2][4];
#pragma unroll
        for (int ai = 0; ai < 2; ++ai)
#pragma unroll
            for (int m = 0; m < 4; ++m) { const int r = row0 + ai * 128 + m * 16; const f32x4* rp = (const f32x4*)(RS + (size_t)r * 16);
                const f32x4 p0 = rp[0], p1 = rp[1], p2 = rp[2], p3 = rp[3];
                const float ss = ((p0[0] + p0[1]) + (p0[2] + p0[3])) + ((p1[0] + p1[1]) + (p1[2] + p1[3])) + ((p2[0] + p2[1]) + (p2[2] + p2[3])) + ((p3[0] + p3[1]) + (p3[2] + p3[3]));
                sc[ai][m] = scale * __builtin_amdgcn_rsqf(ss * (1.0f / 1024.0f) + 1e-6f);
                float mm = -3.0e38f;
#pragma unroll
                for (int bj = 0; bj < 2; ++bj)
#pragma unroll
                    for (int n = 0; n < 2; ++n) { const f32x4 v = acc[ai][bj][m][n]; mm = fmaxf(mm, fmaxf(fmaxf(v[0], v[1]), fmaxf(v[2], v[3]))); }
                mm *= sc[ai][m];
                mm = fmaxf(mm, __shfl_xor(mm, 16)); mm = fmaxf(mm, __shfl_xor(mm, 32));
                if (fq == 0) XM[(ai * 128 + wr * 64 + m * 16 + fr) * 4 + wc] = mm; }
        asm volatile("s_waitcnt lgkmcnt(0)" ::: "memory"); __builtin_amdgcn_s_barrier(); asm volatile("" ::: "memory");
        f32x4 (&pa)[2][2][4][2] = const_cast<f32x4 (&)[2][2][4][2]>(acc);
#pragma unroll
        for (int ai = 0; ai < 2; ++ai)
#pragma unroll
            for (int m = 0; m < 4; ++m) { const int lr = ai * 128 + wr * 64 + m * 16 + fr; const f32x4 q = *(const LAS f32x4*)(XM + lr * 4);
                const float mxr = fmaxf(fmaxf(q[0], q[1]), fmaxf(q[2], q[3])); float sm = 0.f;
#pragma unroll
                for (int bj = 0; bj < 2; ++bj)
#pragma unroll
                    for (int n = 0; n < 2; ++n)
#pragma unroll
                        for (int j = 0; j < 4; ++j) { const float p = __expf(acc[ai][bj][m][n][j] * sc[ai][m] - mxr); pa[ai][bj][m][n][j] = p; sm += p; }
                sm += __shfl_xor(sm, 16); sm += __shfl_xor(sm, 32);
                if (fq == 0) XS[lr * 4 + wc] = sm; }
        asm volatile("s_waitcnt lgkmcnt(0)" ::: "memory"); __builtin_amdgcn_s_barrier(); asm volatile("" ::: "memory");
#pragma unroll
        for (int ai = 0; ai < 2; ++ai)
#pragma unroll
            for (int m = 0; m < 4; ++m) { const int lr = ai * 128 + wr * 64 + m * 16 + fr; const f32x4 q = *(const LAS f32x4*)(XS + lr * 4);
                const float inv = 256.0f * __builtin_amdgcn_rcpf((q[0] + q[1]) + (q[2] + q[3]));
                unsigned char* rowp = O + (size_t)(row0 + ai * 128 + m * 16) * 1024 + col0;
#pragma unroll
                for (int bj = 0; bj < 2; ++bj) { const f32x4 v0 = pa[ai][bj][m][0] * inv, v1 = pa[ai][bj][m][1] * inv;
                    u32x2 w; w.x = pk4_fp8(v0[0], v0[1], v0[2], v0[3]); w.y = pk4_fp8(v1[0], v1[1], v1[2], v1[3]);
                    *(u32x2*)(rowp + bj * 128) = w; } }
        asm volatile("s_waitcnt lgkmcnt(0)" ::: "memory"); __builtin_amdgcn_s_barrier(); asm volatile("" ::: "memory");
    }
};
struct EpiBf16RowNorm {
    static constexpr bool PERM = true;
    bf16* O; int ldc; float scale; const float* RS;
    DI void operator()(const f32x4 (&acc)[2][2][4][2], const Unit& u, int wr, int wc, int fr, int fq) const {
        const int row0 = u.pm * 256 + wr * 64 + fr, col0 = u.pn * 256 + wc * 32 + 8 * fq;
#pragma unroll
        for (int ai = 0; ai < 2; ++ai)
#pragma unroll
            for (int m = 0; m < 4; ++m) { const int r = row0 + ai * 128 + m * 16; const f32x4* rp = (const f32x4*)(RS + (size_t)r * 16);
                const f32x4 p0 = rp[0], p1 = rp[1], p2 = rp[2], p3 = rp[3];
                const float ss = ((p0[0] + p0[1]) + (p0[2] + p0[3])) + ((p1[0] + p1[1]) + (p1[2] + p1[3])) + ((p2[0] + p2[1]) + (p2[2] + p2[3])) + ((p3[0] + p3[1]) + (p3[2] + p3[3]));
                const float sc = scale * __builtin_amdgcn_rsqf(ss * (1.0f / 1024.0f) + 1e-6f);
                bf16* rowp = O + (size_t)r * ldc + col0;
#pragma unroll
                for (int bj = 0; bj < 2; ++bj) { const f32x4 v0 = acc[ai][bj][m][0] * sc, v1 = acc[ai][bj][m][1] * sc;
                    u32x4 w; w.x = cvt_pk_bf16(v0[0], v0[1]); w.y = cvt_pk_bf16(v0[2], v0[3]); w.z = cvt_pk_bf16(v1[0], v1[1]); w.w = cvt_pk_bf16(v1[2], v1[3]);
                    *(u32x4*)(rowp + bj * 128) = w; } }
    }
};
template <bool RES_BF16> struct EpiBf16Res {
    static constexpr bool PERM = true;
    const void* Rz; bf16* O; int ldc; float* RS; float ascale; unsigned char* O8;
    DI void operator()(const f32x4 (&acc)[2][2][4][2], const Unit& u, int wr, int wc, int fr, int fq) const {
        const int row0 = u.pm * 256 + wr * 64 + fr, col0 = u.pn * 256 + wc * 32 + 8 * fq;
#pragma unroll
        for (int ai = 0; ai < 2; ++ai) {
            u32x4 rwb[4][2]; f32x4 rf0[4][2], rf1[4][2];
#pragma unroll
            for (int m = 0; m < 4; ++m) { const size_t off = (size_t)(row0 + ai * 128 + m * 16) * ldc + col0;
#pragma unroll
                for (int bj = 0; bj < 2; ++bj) {
                    if (RES_BF16) rwb[m][bj] = __builtin_nontemporal_load((const u32x4*)((const bf16*)Rz + off + bj * 128));
                    else { rf0[m][bj] = __builtin_nontemporal_load((const f32x4*)((const float*)Rz + off + bj * 128)); rf1[m][bj] = __builtin_nontemporal_load((const f32x4*)((const float*)Rz + off + bj * 128 + 4)); } } }
#pragma unroll
            for (int m = 0; m < 4; ++m) { const size_t off = (size_t)(row0 + ai * 128 + m * 16) * ldc + col0; float ssq = 0.f;
#pragma unroll
                for (int bj = 0; bj < 2; ++bj) { f32x4 r0, r1;
                    if (RES_BF16) { const u32x4 rw = rwb[m][bj]; r0 = (f32x4){bflo(rw.x), bfhi(rw.x), bflo(rw.y), bfhi(rw.y)}; r1 = (f32x4){bflo(rw.z), bfhi(rw.z), bflo(rw.w), bfhi(rw.w)}; }
                    else { r0 = rf0[m][bj]; r1 = rf1[m][bj]; }
                    const f32x4 v0 = r0 + acc[ai][bj][m][0] * ascale, v1 = r1 + acc[ai][bj][m][1] * ascale;
                    if (O8) { u32x2 w8; w8.x = pk4_fp8(v0[0], v0[1], v0[2], v0[3]); w8.y = pk4_fp8(v1[0], v1[1], v1[2], v1[3]); *(u32x2*)(O8 + off + bj * 128) = w8; }
                    ssq += (v0[0] * v0[0] + v0[1] * v0[1]) + (v0[2] * v0[2] + v0[3] * v0[3]) + (v1[0] * v1[0] + v1[1] * v1[1]) + (v1[2] * v1[2] + v1[3] * v1[3]);
                    u32x4 w; w.x = cvt_pk_bf16(v0[0], v0[1]); w.y = cvt_pk_bf16(v0[2], v0[3]); w.z = cvt_pk_bf16(v1[0], v1[1]); w.w = cvt_pk_bf16(v1[2], v1[3]);
                    *(u32x4*)(O + off + bj * 128) = w; }
                if (RS) { ssq += __shfl_xor(ssq, 16); ssq += __shfl_xor(ssq, 32); if (fq == 0) RS[(size_t)(row0 + ai * 128 + m * 16) * 16 + u.pn * 4 + wc] = ssq; } } }
    }
};
struct EpiLora {
    static constexpr bool PERM = false;
    float* LWp; bf16* AAp; bf16* GGp; const float* w0; const float* a0;
    DI void operator()(const f32x4 (&acc)[2][2][4][2], const Unit& u, int wr, int wc, int fr, int fq) const {
        const int kind = u.pn >> 1;
        const int row0 = u.pm * 256 + wr * 64 + fr, col0 = (u.pn & 1) * 256 + wc * 32 + 4 * fq;
#pragma unroll
        for (int bj = 0; bj < 2; ++bj)
#pragma unroll
            for (int n = 0; n < 2; ++n) {
                const int c = col0 + bj * 128 + n * 16;
                f32x4 bias = (f32x4){0.f, 0.f, 0.f, 0.f};
                if (kind == 0) bias = *(const f32x4*)(w0 + c); else if (kind == 1) bias = *(const f32x4*)(a0 + c);
#pragma unroll
                for (int ai = 0; ai < 2; ++ai)
#pragma unroll
                    for (int m = 0; m < 4; ++m) {
                        f32x4 v = acc[ai][bj][m][n] + bias;
                        if (kind == 0) {
#pragma unroll
                            for (int j = 0; j < 4; ++j) { const float w = -softplus_fast(-v[j]) - 0.5f; v[j] = -__expf(w);     }
                        } else if (kind == 1) {
#pragma unroll
                            for (int j = 0; j < 4; ++j) v[j] = sigmoid_f(v[j]);
                        }
                        const size_t o_ = (size_t)(row0 + ai * 128 + m * 16) * 512 + c;
                        if (kind == 0) *(f32x4*)(LWp + o_) = v;
                        else { u32x2 w_; w_.x = cvt_pk_bf16(v[0], v[1]); w_.y = cvt_pk_bf16(v[2], v[3]); *(u32x2*)((kind == 1 ? AAp : GGp) + o_) = w_; }
                    }
            }
    }
};
typedef float f32x2_t __attribute__((ext_vector_type(2)));
struct EpiSwiglu {
    static constexpr bool PERM = true;
    bf16* ACT; const float* b_gu;
    DI void operator()(const f32x4 (&acc)[2][2][4][2], const Unit& u, int wr, int wc, int fr, int fq) const {
        const int row0 = u.pm * 256 + wr * 64 + fr, j0 = u.pn * 128 + wc * 32 + 8 * fq;
        const float* bg = b_gu + (size_t)u.e * 2048 + j0; const float* bu = bg + 1024;
        const f32x4 bg0 = *(const f32x4*)bg, bg1 = *(const f32x4*)(bg + 4), bu0 = *(const f32x4*)bu, bu1 = *(const f32x4*)(bu + 4);
#pragma unroll
        for (int ai = 0; ai < 2; ++ai)
#pragma unroll
            for (int m = 0; m < 4; ++m) {
                float o[8];
#pragma unroll
                for (int n = 0; n < 2; ++n) { const f32x4 g4 = acc[ai][0][m][n] * 0.015625f + (n ? bg1 : bg0), u4 = acc[ai][1][m][n] * 0.015625f + (n ? bu1 : bu0);
#pragma unroll
                    for (int p = 0; p < 2; ++p) {
                        f32x2_t g, up; g.x = fminf(g4[2 * p], 7.0f); g.y = fminf(g4[2 * p + 1], 7.0f); up.x = fminf(fmaxf(u4[2 * p], -7.0f), 7.0f); up.y = fminf(fmaxf(u4[2 * p + 1], -7.0f), 7.0f);
                        const f32x2_t ex = g * (-1.702f * 1.44269504089f); f32x2_t d; d.x = __builtin_amdgcn_exp2f(ex.x); d.y = __builtin_amdgcn_exp2f(ex.y); d = d + 1.0f;
                        f32x2_t r; r.x = __builtin_amdgcn_rcpf(d.x); r.y = __builtin_amdgcn_rcpf(d.y);
                        const f32x2_t ov = (up + 1.0f) * (g * r); o[n * 4 + 2 * p] = ov.x; o[n * 4 + 2 * p + 1] = ov.y; } }
                u32x2 w; w.x = pk4_fp8(o[0], o[1], o[2], o[3]); w.y = pk4_fp8(o[4], o[5], o[6], o[7]);
                *(u32x2*)((unsigned char*)ACT + (size_t)(row0 + ai * 128 + m * 16) * 1024 + j0) = w;
            }
    }
};
struct EpiDown {
    static constexpr bool PERM = true;
    bf16* YS; const float* b_dn; const u32x2* row_sg;
    DI void operator()(const f32x4 (&acc)[2][2][4][2], const Unit& u, int wr, int wc, int fr, int fq) const {
        const int row0 = u.pm * 256 + wr * 64 + fr, col0 = u.pn * 256 + wc * 32 + 8 * fq;
        const float* bb = b_dn + (size_t)u.e * 1024 + col0;
        f32x4 bv[2][2];
#pragma unroll
        for (int bj = 0; bj < 2; ++bj)
#pragma unroll
            for (int n = 0; n < 2; ++n) bv[bj][n] = *(const f32x4*)(bb + bj * 128 + 4 * n);
        int slots[8]; float gts[8];
        { const u32x2* sgp = row_sg + row0;
#pragma unroll
        for (int q = 0; q < 8; ++q) { const u32x2 sg = sgp[(q >> 2) * 128 + (q & 3) * 16]; slots[q] = (int)sg.x; gts[q] = __uint_as_float(sg.y); } }
#pragma unroll
        for (int ai = 0; ai < 2; ++ai)
#pragma unroll
            for (int m = 0; m < 4; ++m) {
                const int slot = slots[ai * 4 + m]; const float gt = gts[ai * 4 + m];
                if (slot >= 0) { unsigned char* rowp = (unsigned char*)YS + (size_t)slot * 1024 + col0; const float g16 = gt * 16.0f;
#pragma unroll
                    for (int bj = 0; bj < 2; ++bj) { const f32x4 v0 = (acc[ai][bj][m][0] * 0.015625f + bv[bj][0]) * g16, v1 = (acc[ai][bj][m][1] * 0.015625f + bv[bj][1]) * g16;
                        u32x2 w; w.x = pk4_fp8(v0[0], v0[1], v0[2], v0[3]); w.y = pk4_fp8(v1[0], v1[1], v1[2], v1[3]);
                        *(u32x2*)(rowp + bj * 128) = w; } }
            }
    }
};

constexpr size_t MiB = 1u << 20;
constexpr size_t WS_CTL = 0, CTL_ZERO_BYTES = 1 * MiB;
constexpr size_t WS_WIN = 1 * MiB, WS_WOUT = 7 * MiB, WS_WQ = 9 * MiB, WS_WK = 11 * MiB, WS_WV = 13 * MiB, WS_WO = 15 * MiB, WS_LORAB = 17 * MiB, WS_LRUW = 18 * MiB;
constexpr size_t WS_ROUTE = 19 * MiB;
constexpr size_t WS_WGU = 22 * MiB, WS_WDN = 150 * MiB;
constexpr size_t WS_HN = 214 * MiB, WS_MEMN = 246 * MiB, WS_KM = 248 * MiB, WS_VT = 250 * MiB;
constexpr size_t WS_X1 = 252 * MiB, WS_X2 = 316 * MiB;
constexpr size_t WS_U = 380 * MiB, WS_R = 468 * MiB, WS_KRAW = 500 * MiB, WS_V = 532 * MiB, WS_KKN = 564 * MiB, WS_WD = 596 * MiB, WS_AA = 628 * MiB, WS_G = 660 * MiB;
constexpr size_t WS_LA = 692 * MiB, WS_LB = 724 * MiB, WS_AP = 756 * MiB, WS_CAT = 764 * MiB, WS_Q = 796 * MiB;
constexpr size_t WS_XS = 380 * MiB, WS_ACT = 524 * MiB, WS_YS = 668 * MiB;
constexpr size_t WS_GP = 796 * MiB, WS_HF = 860 * MiB, WS_RP = 924 * MiB, WS_Y1F = 940 * MiB, WS_ADD = 972 * MiB, WS_END = 1004 * MiB;
constexpr size_t WS_GC = 468 * MiB, WS_HC = 484 * MiB, WS_ZS = 500 * MiB;
static_assert(WS_AA == WS_WD + 32 * MiB && WS_G == WS_AA + 32 * MiB, "EpiLora strides");
static_assert(WS_U + (size_t)M * INW * 2 <= WS_R && WS_XS + (size_t)MAXROWS * 2048 <= WS_ACT && WS_ACT + (size_t)MAXROWS * 2048 <= WS_YS && WS_YS + (size_t)NASSIGN * 2048 <= WS_Q, "ws map");
constexpr size_t RT_E = 0, RT_POS = 256 * 1024, RT_G = 512 * 1024, RT_SLOT = 768 * 1024, RT_GATE = 1088 * 1024, RT_TILE = 1408 * 1024, RT_TOK = 1472 * 1024, RT_UGU = 1792 * 1024, RT_UDN = 1808 * 1024;
constexpr int CW_BAR = 4096, CW_CNT = 8192, CW_CONV = 12288;

constexpr int RING_BYTES = 131072, MISC_OFF = RING_BYTES + 320, LDS_BYTES = 147456;
constexpr int NWAVES = 8, NTHREADS = 512;
constexpr int CONV_P9 = 10240;
constexpr int CONV_P9D = 16384;

#define XB_TMO      128
#define XB_XCNT(j)  (256  + 64 * (j))
#define XB_XSUB(j)  (1280 + 64 * (j))
#define XB_XGEN(j)  (2304 + 64 * (j))
#define XB_TOP      3328
#define XB_TOPGEN   3392
#define XCD_BAR_WORDS 3456
#define XB_SPIN_CAP (1u << 18)
DI unsigned xb_ld(unsigned* p)              { return __hip_atomic_load(p, __ATOMIC_RELAXED, __HIP_MEMORY_SCOPE_AGENT); }
DI unsigned xb_add(unsigned* p, unsigned v) { return __hip_atomic_fetch_add(p, v, __ATOMIC_RELAXED, __HIP_MEMORY_SCOPE_AGENT); }
DI unsigned xb_xcc_id() { return (unsigned)__builtin_amdgcn_s_getreg((3 << 11) | 20) & 0xFu; }
#define XB_SPIN(cond, bar) do { unsigned _sp = 0; while (cond) { __builtin_amdgcn_s_sleep(1); \
    if ((++_sp & 255u) == 0u) { if (xb_ld(&(bar)[XB_TMO])) break; if (_sp > XB_SPIN_CAP) { atomicAdd(&(bar)[XB_TMO], 1u); break; } } } } while (0)
struct XcdBarrier { unsigned* bar; unsigned x; volatile LAS unsigned* st; int w0; };
DI XcdBarrier xcd_barrier_post(unsigned* bar, volatile LAS unsigned* st, int w0) {
    XcdBarrier b; b.bar = bar; b.x = xb_xcc_id(); b.st = st; b.w0 = w0;
    if (fresh_tid_(w0) == 0) (void)xb_add(&bar[XB_XCNT(b.x)], 1u);
    return b;
}
DI void xcd_barrier_complete(unsigned* bar, unsigned x, unsigned& nloc, unsigned& nx) {
    const unsigned G = gridDim.x * gridDim.y * gridDim.z;
    unsigned sum, cnt, mine, sp = 0u;
    for (;;) {
        sum = 0u; cnt = 0u; mine = 0u;
#pragma unroll
        for (unsigned j = 0; j < 16; ++j) { const unsigned c = xb_ld(&bar[XB_XCNT(j)]); sum += c; cnt += (c > 0u) ? 1u : 0u; mine = (j == x) ? c : mine; }
        if (sum == G) break;
        __builtin_amdgcn_s_sleep(1);
        if ((++sp & 255u) == 0u) { if (xb_ld(&bar[XB_TMO])) break; if (sp > XB_SPIN_CAP) { atomicAdd(&bar[XB_TMO], 1u); break; } }
    }
    nloc = mine > 0u ? mine : 1u; nx = cnt > 0u ? cnt : 1u;
}
DI void xcd_barrier(const XcdBarrier& b) {
    asm volatile("s_waitcnt vmcnt(0)" ::: "memory");
    __syncthreads();
    if (fresh_tid_(b.w0) == 0) {
        unsigned* bar = b.bar;
        __builtin_amdgcn_s_waitcnt(0);
        unsigned nloc = b.st[0], nx = b.st[1];
        if (nloc == 0u) { xcd_barrier_complete(bar, b.x, nloc, nx); b.st[0] = nloc; b.st[1] = nx; }
        const unsigned old = xb_add(&bar[XB_XSUB(b.x)], 1u);
        const unsigned gen = old / nloc;
        if (old + 1u == (gen + 1u) * nloc) {
            __builtin_amdgcn_fence(__ATOMIC_RELEASE, "agent");
            asm volatile("s_waitcnt vmcnt(0)" ::: "memory");
            const unsigned og = xb_add(&bar[XB_TOP], 1u);
            const unsigned tg = og / nx;
            if (og + 1u == (tg + 1u) * nx) xb_add(&bar[XB_TOPGEN], 1u);
            else XB_SPIN(xb_ld(&bar[XB_TOPGEN]) == tg, bar);
            __builtin_amdgcn_fence(__ATOMIC_ACQUIRE, "agent");
            xb_add(&bar[XB_XGEN(b.x)], 1u);
            asm volatile("s_waitcnt vmcnt(0)" ::: "memory");
        } else {
            XB_SPIN(xb_ld(&bar[XB_XGEN(b.x)]) == gen, bar);
            __builtin_amdgcn_fence(__ATOMIC_ACQUIRE, "agent");
            asm volatile("s_waitcnt vmcnt(0)" ::: "memory");
        }
    }
    __syncthreads();
}

struct Args { const float* in[37]; float* out; unsigned char* ws; int ph_lo, ph_hi; };
enum { I_X = 0, I_MEM, I_NMIXG, I_WIN, I_CONVW, I_CONVB, I_LWX, I_LBX, I_LWA, I_LBA, I_LAM, I_MU, I_W0, I_WUP, I_A0, I_AUP, I_GUP, I_KK, I_KA, I_RK, I_LNG, I_LNB,
       I_WOUT, I_NXAG, I_NMEMG, I_WQ, I_WK, I_WV, I_WO, I_NFFG, I_WR, I_BR, I_WGU, I_BGU, I_WDN, I_BDN, I_FNG };

DI void transpose_item(const float* W, int ldw, int K, bf16* WT, int k0, int n0, int drow0, LAS float* scr, int lane, const float* rs = nullptr) {
    f32x4 t[8];
    const float* src = W + (size_t)(k0 + (lane >> 3)) * ldw + n0 + 4 * (lane & 7);
#pragma unroll
    for (int i = 0; i < 8; ++i) t[i] = *(const f32x4*)(src + (size_t)(8 * i) * ldw);
#pragma unroll
    for (int i = 0; i < 8; ++i) { const float sc_ = rs ? rs[k0 + 8 * i + (lane >> 3)] : 1.0f; LAS float* d = scr + (8 * i + (lane >> 3)) * 33 + 4 * (lane & 7); d[0] = t[i].x * sc_; d[1] = t[i].y * sc_; d[2] = t[i].z * sc_; d[3] = t[i].w * sc_; }
    asm volatile("s_waitcnt lgkmcnt(0)" ::: "memory");
    const int c = lane & 7;
#pragma unroll
    for (int j = 0; j < 4; ++j) { const int n = (lane >> 3) + 8 * j; const LAS float* s = scr + (8 * c) * 33 + n;
        u32x4 o; o.x = pk2(s[0 * 33], s[1 * 33]); o.y = pk2(s[2 * 33], s[3 * 33]); o.z = pk2(s[4 * 33], s[5 * 33]); o.w = pk2(s[6 * 33], s[7 * 33]);
        *(u32x4*)(WT + (size_t)(drow0 + n) * K + k0 + 8 * c) = o; }
    asm volatile("s_waitcnt lgkmcnt(0)" ::: "memory");
}
DI void transpose_item_tiled(const float* W, int ldw, int K, bf16* WTe, int k0, int n0, int drow0, LAS float* scr, int lane) {
    f32x4 t[8];
    const float* src = W + (size_t)(k0 + (lane >> 3)) * ldw + n0 + 4 * (lane & 7);
#pragma unroll
    for (int i = 0; i < 8; ++i) t[i] = *(const f32x4*)(src + (size_t)(8 * i) * ldw);
#pragma unroll
    for (int i = 0; i < 8; ++i) { LAS float* d = scr + (8 * i + (lane >> 3)) * 33 + 4 * (lane & 7); d[0] = t[i].x; d[1] = t[i].y; d[2] = t[i].z; d[3] = t[i].w; }
    asm volatile("s_waitcnt lgkmcnt(0)" ::: "memory");
    const int c = lane & 7;
#pragma unroll
    for (int j = 0; j < 4; ++j) { const int n = (lane >> 3) + 8 * j; const LAS float* s = scr + (8 * c) * 33 + n;
        u32x4 o; o.x = pk2(s[0 * 33], s[1 * 33]); o.y = pk2(s[2 * 33], s[3 * 33]); o.z = pk2(s[4 * 33], s[5 * 33]); o.w = pk2(s[6 * 33], s[7 * 33]);
        const int drow = drow0 + n, pn = drow >> 8, half = (drow >> 7) & 1, r = drow & 127, x = r & 31;
        const int rslot = (r & ~31) + 16 * ((x >> 2) & 1) + 4 * (x >> 3) + (x & 3);
        const size_t tb = ((size_t)(pn * (K / 64) + (k0 >> 6)) * 2 + half) * 16384 + pg8::lds_byte(rslot, 8 * c);
        *(u32x4*)((char*)WTe + tb) = o; }
    asm volatile("s_waitcnt lgkmcnt(0)" ::: "memory");
}
DI void transpose_item_tiled_nolds(const float* W, int ldw, int K, bf16* WTe, int k0, int n0, int drow0, int lane) {
    const int n = lane & 31, kh = lane >> 5;
    const float* src = W + (size_t)(k0 + 32 * kh) * ldw + n0 + n;
    float t[32];
#pragma unroll
    for (int i = 0; i < 32; ++i) t[i] = src[(size_t)i * ldw];
    const int drow = drow0 + n, pn = drow >> 8, half = (drow >> 7) & 1, r = drow & 127, x = r & 31;
    const int rslot = (r & ~31) + 16 * ((x >> 2) & 1) + 4 * (x >> 3) + (x & 3);
    const size_t tb0 = ((size_t)(pn * (K / 64) + (k0 >> 6)) * 2 + half) * 16384;
#pragma unroll
    for (int c = 0; c < 4; ++c) { u32x4 o; o.x = pk2(t[8 * c], t[8 * c + 1]); o.y = pk2(t[8 * c + 2], t[8 * c + 3]); o.z = pk2(t[8 * c + 4], t[8 * c + 5]); o.w = pk2(t[8 * c + 6], t[8 * c + 7]);
        *(u32x4*)((char*)WTe + tb0 + pg8::lds_byte(rslot, 32 * kh + 8 * c)) = o; }
}
DI void transpose_item_tiled_fp8_nolds(const float* W, int ldw, int K, unsigned char* WTe, int k0, int n0, int drow0, int lane) {
    const int n = lane & 31, kh = lane >> 5;
    const float* src = W + (size_t)(k0 + 32 * kh) * ldw + n0 + n;
    float t[32];
#pragma unroll
    for (int i = 0; i < 32; ++i) t[i] = __builtin_nontemporal_load(src + (size_t)i * ldw) * 64.f;
    const int drow = drow0 + n, pn = drow >> 8, half = (drow >> 7) & 1, r = drow & 127, x = r & 31;
    const int rslot = (r & ~31) + 16 * ((x >> 2) & 1) + 4 * (x >> 3) + (x & 3);
    const size_t tb0 = ((size_t)(pn * (K / 128) + (k0 >> 7)) * 2 + half) * 16384;
#pragma unroll
    for (int c = 0; c < 2; ++c) { u32x4 o; o.x = pk4_fp8(t[16 * c], t[16 * c + 1], t[16 * c + 2], t[16 * c + 3]); o.y = pk4_fp8(t[16 * c + 4], t[16 * c + 5], t[16 * c + 6], t[16 * c + 7]);
        o.z = pk4_fp8(t[16 * c + 8], t[16 * c + 9], t[16 * c + 10], t[16 * c + 11]); o.w = pk4_fp8(t[16 * c + 12], t[16 * c + 13], t[16 * c + 14], t[16 * c + 15]);
        const int bc = (k0 & 64) + 32 * kh + 16 * c;
        *(u32x4*)(WTe + tb0 + pg8::lds_byte(rslot, bc >> 1)) = o; }
}
DI void transpose_item_tiled_fp8(const float* W, int ldw, int K, unsigned char* WTe, int k0, int n0, int drow0, LAS float* scr, int lane) {
    f32x4 t[8];
    const float* src = W + (size_t)(k0 + (lane >> 3)) * ldw + n0 + 4 * (lane & 7);
#pragma unroll
    for (int i = 0; i < 8; ++i) t[i] = __builtin_nontemporal_load((const f32x4*)(src + (size_t)(8 * i) * ldw));
#pragma unroll
    for (int i = 0; i < 8; ++i) { LAS float* d = scr + (8 * i + (lane >> 3)) * 33 + 4 * (lane & 7); d[0] = t[i].x * 64.f; d[1] = t[i].y * 64.f; d[2] = t[i].z * 64.f; d[3] = t[i].w * 64.f; }
    asm volatile("s_waitcnt lgkmcnt(0)" ::: "memory");
    const int c = lane & 3;
#pragma unroll
    for (int j = 0; j < 2; ++j) { const int n = (lane >> 2) + 16 * j; const LAS float* sp = scr + (16 * c) * 33 + n;
        u32x4 o; o.x = pk4_fp8(sp[0 * 33], sp[1 * 33], sp[2 * 33], sp[3 * 33]); o.y = pk4_fp8(sp[4 * 33], sp[5 * 33], sp[6 * 33], sp[7 * 33]);
        o.z = pk4_fp8(sp[8 * 33], sp[9 * 33], sp[10 * 33], sp[11 * 33]); o.w = pk4_fp8(sp[12 * 33], sp[13 * 33], sp[14 * 33], sp[15 * 33]);
        const int drow = drow0 + n, pn = drow >> 8, half = (drow >> 7) & 1, r = drow & 127, x = r & 31;
        const int rslot = (r & ~31) + 16 * ((x >> 2) & 1) + 4 * (x >> 3) + (x & 3);
        const int bc = (k0 & 64) + 16 * c;
        const size_t tb = ((size_t)(pn * (K / 128) + (k0 >> 7)) * 2 + half) * 16384 + pg8::lds_byte(rslot, bc >> 1);
        *(u32x4*)(WTe + tb) = o; }
    asm volatile("s_waitcnt lgkmcnt(0)" ::: "memory");
}
DI void rms_row_to_bf16(const float* xrow, const float* g, bf16* orow, int lane) {
    const f32x4* xr = (const f32x4*)xrow + lane; const f32x4* gr = (const f32x4*)g + lane;
    f32x4 v[4]; float s = 0.f;
#pragma unroll
    for (int j = 0; j < 4; ++j) { v[j] = __builtin_nontemporal_load(xr + 64 * j); s += (v[j].x * v[j].x + v[j].y * v[j].y) + (v[j].z * v[j].z + v[j].w * v[j].w); }
    const float rstd = rsq_f(wave_sum(s) * (1.f / D) + EPS);
    u32x2* o8 = (u32x2*)orow + lane;
#pragma unroll
    for (int j = 0; j < 4; ++j) { const f32x4 gg = gr[64 * j]; u32x2 w; w.x = pk2(v[j].x * rstd * gg.x, v[j].y * rstd * gg.y); w.y = pk2(v[j].z * rstd * gg.z, v[j].w * rstd * gg.w); o8[64 * j] = w; }
}

DI void rms_rowbf_to_bf16(const bf16* xrow, const float* g, bf16* orow, int lane) {
    float v[16]; float s = 0.f;
#pragma unroll
    for (int hf = 0; hf < 2; ++hf) { const u32x4 w = *(const u32x4*)(xrow + 512 * hf + 8 * lane);
#pragma unroll
        for (int q = 0; q < 4; ++q) { v[8 * hf + 2 * q] = bflo(w[q]); v[8 * hf + 2 * q + 1] = bfhi(w[q]); } }
#pragma unroll
    for (int j = 0; j < 16; ++j) s += v[j] * v[j];
    const float rstd = rsq_f(wave_sum(s) * (1.f / D) + EPS);
#pragma unroll
    for (int hf = 0; hf < 2; ++hf) { const f32x4 g0 = *(const f32x4*)(g + 512 * hf + 8 * lane), g1 = *(const f32x4*)(g + 512 * hf + 8 * lane + 4);
        u32x4 w; w.x = pk2(v[8 * hf] * rstd * g0.x, v[8 * hf + 1] * rstd * g0.y); w.y = pk2(v[8 * hf + 2] * rstd * g0.z, v[8 * hf + 3] * rstd * g0.w);
        w.z = pk2(v[8 * hf + 4] * rstd * g1.x, v[8 * hf + 5] * rstd * g1.y); w.w = pk2(v[8 * hf + 6] * rstd * g1.z, v[8 * hf + 7] * rstd * g1.w);
        *(u32x4*)(orow + 512 * hf + 8 * lane) = w; }
}

__global__ void __launch_bounds__(NTHREADS, 2) fwd(Args args) {
    extern __shared__ __attribute__((aligned(16))) unsigned char lds_raw[];
    LAS unsigned char* lds = (LAS unsigned char*)lds_raw;
    volatile LAS unsigned* MISC = (volatile LAS unsigned*)(lds + MISC_OFF);
    const int G = gridDim.x, bid = blockIdx.x, NGW = G * NWAVES;
    const int wv0 = __builtin_amdgcn_readfirstlane((int)(threadIdx.x >> 6));
#define PHASE_IDS const int tid = fresh_tid(), lane = tid & 63, wave = __builtin_amdgcn_readfirstlane(tid >> 6), gw = bid * NWAVES + wave; (void)tid; (void)lane; (void)wave; (void)gw
    unsigned char* ws = args.ws;
    unsigned* ctl = (unsigned*)(ws + WS_CTL);
    const int lo = args.ph_lo, hi = args.ph_hi;

    for (int u = fresh_tid(); u < (LDS_BYTES - RING_BYTES) / 4; u += NTHREADS) ((LAS unsigned*)(lds + RING_BYTES))[u] = 0u;
    __syncthreads();
    XcdBarrier bar; bar.bar = ctl + CW_BAR; bar.x = 0; bar.st = nullptr; bar.w0 = wv0;
    if (hi - lo > 1) bar = xcd_barrier_post(ctl + CW_BAR, MISC + 8, wv0);
#define IN(k) (lo <= (k) && (k) < hi)
#define SEAM(k) do { if (IN(k) && IN((k) + 1)) xcd_barrier(bar); } while (0)

#define Win_t ((bf16*)(ws + WS_WIN))
#define Wout_t ((bf16*)(ws + WS_WOUT))
#define Wq_t ((bf16*)(ws + WS_WQ))
#define Wk_t ((bf16*)(ws + WS_WK))
#define Wv_t ((bf16*)(ws + WS_WV))
#define Wo_t ((bf16*)(ws + WS_WO))
#define LoraB ((bf16*)(ws + WS_LORAB))
#define LruW ((bf16*)(ws + WS_LRUW))
#define WrT ((bf16*)(ws + WS_LRUW + 512 * 1024))
#define Wgu_t ((bf16*)(ws + WS_WGU))
#define Wdn_t ((bf16*)(ws + WS_WDN))
#define HN ((bf16*)(ws + WS_HN))
#define MEMN ((bf16*)(ws + WS_MEMN))
#define KM ((bf16*)(ws + WS_KM))
#define VT ((bf16*)(ws + WS_VT))
#define X1 ((bf16*)(ws + WS_X1))
#define X2 ((bf16*)(ws + WS_X2))
#define U ((bf16*)(ws + WS_U))
#define Rr ((float*)(ws + WS_R))
#define KRAW ((float*)(ws + WS_KRAW))
#define Vv ((float*)(ws + WS_V))
#define KKN ((float*)(ws + WS_KKN))
#define WD ((float*)(ws + WS_WD))
#define AA ((float*)(ws + WS_AA))
#define GG ((float*)(ws + WS_G))
#define LA ((bf16*)(ws + WS_LA))
#define LB ((bf16*)(ws + WS_LB))
#define AP ((bf16*)(ws + WS_AP))
#define CAT ((bf16*)(ws + WS_CAT))
#define Qb ((bf16*)(ws + WS_Q))
#define Ob CAT
#define LACT ((bf16*)(ws + WS_CAT))
#define X1F8 ((unsigned char*)(ws + WS_XS))
#define XS ((bf16*)(ws + WS_XS))
#define ACT ((bf16*)(ws + WS_ACT))
#define YS ((bf16*)(ws + WS_YS))
#define route_e ((int*)(ws + WS_ROUTE + RT_E))
#define route_pos ((int*)(ws + WS_ROUTE + RT_POS))
#define route_g ((float*)(ws + WS_ROUTE + RT_G))
#define row_sg ((u32x2*)(ws + WS_ROUTE + RT_SLOT))
#define tile_tab ((int*)(ws + WS_ROUTE + RT_TILE))
#define row_tok ((int*)(ws + WS_ROUTE + RT_TOK))
#define ecnt (ctl + CW_CNT)

    if (IN(0)) { PHASE_IDS;
        LAS float* scr = (LAS float*)(lds + wave * 16384);
        constexpr int I_IN = 16 * (INW / 32), I_SQ = 16 * 32;
        constexpr int N_ITEMS = I_IN + 5 * I_SQ;
        for (int it = gw; it < N_ITEMS; it += NGW) {
            int r = it;
            if (r < I_IN) { const int nblk = INW / 32, kb = r / nblk, nb = r % nblk; transpose_item(args.in[I_WIN], INW, D, Win_t, 64 * kb, 32 * nb, 32 * nb, scr, lane); continue; } r -= I_IN;
            { const int w = r / I_SQ, q = r % I_SQ, kb = q / 32, nb = q % 32;
                if (w == 1) continue;
                const float* src = w == 0 ? args.in[I_WOUT] : w == 2 ? args.in[I_WK] : w == 3 ? args.in[I_WV] : args.in[I_WO];
                bf16* dst = w == 0 ? Wout_t : w == 2 ? Wk_t : w == 3 ? Wv_t : Wo_t;
                transpose_item(src, D, D, dst, 64 * kb, 32 * nb, 32 * nb, scr, lane); }
        }
        for (int idx = bid * NTHREADS + tid; idx < D * D / 4; idx += G * NTHREADS) { const f32x4 v = ((const f32x4*)args.in[I_WQ])[idx]; const float gk = args.in[I_NXAG][idx >> 8];
            u32x2 w; w.x = pk2(v.x * gk, v.y * gk); w.y = pk2(v.z * gk, v.w * gk); ((u32x2*)Wq_t)[idx] = w; }
        for (int idx = bid * NTHREADS + tid; idx < 1536 * 256; idx += G * NTHREADS) {
            const int e = idx & 7, ln = (idx >> 3) & 63, ks = (idx >> 9) & 7, ct = (idx >> 12) & 3, hk = idx >> 14, hh = hk / 3, kind = hk - 3 * hh;
            const int k = 32 * ks + 8 * (ln >> 4) + e, n = hh * 64 + 16 * ct + (ln & 15); float v = 0.f;
            if (kind == 0) { if (k < 64) v = args.in[I_WUP][k * 512 + n]; }
            else if (kind == 1) { if (k >= 64 && k < 128) v = args.in[I_AUP][(k - 64) * 512 + n]; }
            else { if (k >= 128) v = args.in[I_GUP][(k - 128) * 512 + n]; }
            LoraB[idx] = (bf16)f2bf(v);
        }
        for (int idx = bid * NTHREADS + tid; idx < 8 * 128 * 64; idx += G * NTHREADS) {
            const int nb = idx >> 13, col = (idx >> 6) & 127, k = idx & 63;
            const float v = col < 64 ? args.in[I_LWX][nb * 4096 + k * 64 + col] : args.in[I_LWA][nb * 4096 + k * 64 + (col - 64)];
            LruW[idx] = (bf16)f2bf(v);
        }
        for (int idx = bid * NTHREADS + tid; idx < NE * D; idx += G * NTHREADS) {
            const int e = idx >> 10, k = idx & 1023; const float v = args.in[I_WR][k * NE + e];
            const unsigned hi = f2bf(v); const float lo = v - __uint_as_float(hi << 16);
            WrT[idx] = (bf16)hi; WrT[NE * D + idx] = (bf16)f2bf(lo);
        }
        for (int m = gw; m < M; m += NGW) rms_row_to_bf16(args.in[I_X] + (size_t)m * D, args.in[I_NMIXG], HN + (size_t)m * D, lane);
        for (int m = gw; m < MROWS; m += NGW) rms_row_to_bf16(args.in[I_MEM] + (size_t)m * D, args.in[I_NMEMG], MEMN + (size_t)m * D, lane);
        {
            LAS float* scr = (LAS float*)(lds + wave * 16384);
            constexpr int I_GU = 16 * 64, I_DN = 16 * 32;
            for (int it = CONV_P9 + gw; it < NE * I_GU; it += NGW) {
                int r = it;
                if (r < NE * I_GU) { const int e = r / I_GU, q = r % I_GU, kb = q / 64, nb = q % 64; const int n0 = 32 * nb;
                    const int drow = n0 < 1024 ? (256 * (n0 >> 7) + (n0 & 127)) : (256 * ((n0 - 1024) >> 7) + 128 + ((n0 - 1024) & 127));
                    transpose_item_tiled_fp8(args.in[I_WGU] + (size_t)e * D * 2048, 2048, D, (unsigned char*)Wgu_t + (size_t)e * 2048 * D, 64 * kb, n0, drow, scr, lane); continue; } r -= NE * I_GU;
                { const int e = r / I_DN, q = r % I_DN, kb = q / 32, nb = q % 32;
                  transpose_item_tiled(args.in[I_WDN] + (size_t)e * DFF * D, D, DFF, Wdn_t + (size_t)e * D * DFF, 64 * kb, 32 * nb, 32 * nb, scr, lane); }
            }
        }
    }
    SEAM(0);

    if (IN(1)) { PHASE_IDS;
        { pg8::DenseSched S; S.o.init_tiles(M / 256, INW / 256, G, bid); S.A = (const char*)HN; S.B = (const char*)Win_t; S.tstep = (size_t)256 * D * 2;
          EpiBf16Plain E{U, INW, 1.0f}; pg8::gemm_phase(lds, D, S, E, wv0); }
        { pg8::DenseSched S; S.o.init_tiles(MROWS / 256, D / 256, G, (bid + 64) & (G - 1)); S.A = (const char*)MEMN; S.B = (const char*)Wk_t; S.tstep = (size_t)256 * D * 2;
          EpiBf16Plain E{KM, D, 1.0f}; pg8::gemm_phase(lds, D, S, E, wv0); }
        { pg8::DenseSched S; S.o.init_tiles(MROWS / 256, D / 256, G, (bid + 48) & (G - 1)); S.A = (const char*)MEMN; S.B = (const char*)Wv_t; S.tstep = (size_t)256 * D * 2;
          EpiBf16Plain E{VT, D, 1.0f}; pg8::gemm_phase(lds, D, S, E, wv0); }
    }
    SEAM(1);

    if (IN(2)) { PHASE_IDS;
        const float* conv_w = args.in[I_CONVW]; const float* conv_b = args.in[I_CONVB];
        LAS float* xs = (LAS float*)(lds + wave * 16384);
        LAS bf16* tP = (LAS bf16*)(lds + wave * 16384 + 4096); LAS bf16* tH = tP + 1024;
        const int i = lane & 15, kg = lane >> 4;
        for (int unit = gw; unit < (M / 64) * 8; unit += NGW) {
            const int seg = unit >> 3, nb = unit & 7, m0s = seg * 64, s0s = m0s & (SEQ - 1);
            bf16x8 wf[8][2];
#pragma unroll
            for (int ct = 0; ct < 8; ++ct)
#pragma unroll
                for (int ks = 0; ks < 2; ++ks) wf[ct][ks] = *(const bf16x8*)(LruW + ((size_t)(nb * 128 + 16 * ct + i) * 64 + 32 * ks + 8 * kg));
            float bxv[4], bav[4], spv[4], Arun[4], Brun[4];
#pragma unroll
            for (int ct = 0; ct < 4; ++ct) { const int ch = nb * 64 + 16 * ct + i; bxv[ct] = args.in[I_LBX][ch]; bav[ct] = args.in[I_LBA][ch]; spv[ct] = softplus_f(-args.in[I_LAM][ch]); Arun[ct] = 1.f; Brun[ct] = 0.f; }
#pragma unroll 1
            for (int jt = 0; jt < 4; ++jt) {
                const int m0 = m0s + 16 * jt, s0 = s0s + 16 * jt;
                bf16x8 af[2];
#pragma unroll
                for (int ks = 0; ks < 2; ++ks) {
                    const int chb = nb * 64 + 32 * ks + 8 * kg;
                    f32x4 x0 = *(const f32x4*)(conv_b + chb), x1 = *(const f32x4*)(conv_b + chb + 4);
#pragma unroll
                    for (int j = 0; j < 4; ++j) {
                        const bool ok = s0 + i - 3 + j >= 0;
                        u32x4 uw = *(const u32x4*)(U + (size_t)(ok ? m0 + i - 3 + j : m0) * INW + chb); if (!ok) uw = (u32x4){0u, 0u, 0u, 0u};
                        const f32x4 w0 = *(const f32x4*)(conv_w + j * 512 + chb), w1 = *(const f32x4*)(conv_w + j * 512 + chb + 4);
                        x0.x += w0.x * bflo(uw.x); x0.y += w0.y * bfhi(uw.x); x0.z += w0.z * bflo(uw.y); x0.w += w0.w * bfhi(uw.y);
                        x1.x += w1.x * bflo(uw.z); x1.y += w1.y * bfhi(uw.z); x1.z += w1.z * bflo(uw.w); x1.w += w1.w * bfhi(uw.w);
                    }
                    *(LAS f32x4*)(xs + i * 64 + 32 * ks + 8 * kg) = x0; *(LAS f32x4*)(xs + i * 64 + 32 * ks + 8 * kg + 4) = x1;
                    u32x4 p; p.x = pk2(x0.x, x0.y); p.y = pk2(x0.z, x0.w); p.z = pk2(x1.x, x1.y); p.w = pk2(x1.z, x1.w);
                    af[ks] = __builtin_bit_cast(bf16x8, p);
                }
                f32x4 acc[8];
#pragma unroll
                for (int ct = 0; ct < 8; ++ct) { acc[ct] = (f32x4){0.f, 0.f, 0.f, 0.f};
#pragma unroll
                    for (int ks = 0; ks < 2; ++ks) acc[ct] = __builtin_amdgcn_mfma_f32_16x16x32_bf16(af[ks], wf[ct][ks], acc[ct], 0, 0, 0); }
#pragma unroll
                for (int ct = 0; ct < 4; ++ct) {
                    const int col = 16 * ct + i;
                    float hl[4], pl[4]; float hprev = 0.f, pprev = 1.f;
#pragma unroll
                    for (int e = 0; e < 4; ++e) {
                        const float gx = sigmoid_f(acc[ct][e] + bxv[ct]), ga = sigmoid_f(acc[ct + 4][e] + bav[ct]);
                        const float la = -8.0f * ga * spv[ct], av = __expf(la), xcv = xs[(4 * kg + e) * 64 + col];
                        const float bt = __builtin_amdgcn_sqrtf(fmaxf(1.0f - av * av, 0.f)) * gx * xcv;
                        hprev = av * hprev + bt; pprev *= av; hl[e] = hprev; pl[e] = pprev;
                    }
                    float Ag[4], Bg[4];
#pragma unroll
                    for (int gq = 0; gq < 4; ++gq) { Ag[gq] = __shfl(pl[3], i + 16 * gq); Bg[gq] = __shfl(hl[3], i + 16 * gq); }
                    float Ain = Arun[ct], Bin = Brun[ct];
#pragma unroll
                    for (int gq = 0; gq < 3; ++gq) if (gq < kg) { Bin = Ag[gq] * Bin + Bg[gq]; Ain *= Ag[gq]; }
                    float At = 1.f, Bt = 0.f;
#pragma unroll
                    for (int gq = 0; gq < 4; ++gq) { Bt = Ag[gq] * Bt + Bg[gq]; At *= Ag[gq]; }
                    Brun[ct] = At * Brun[ct] + Bt; Arun[ct] *= At;
#pragma unroll
                    for (int e = 0; e < 4; ++e) { const int ti_ = (4 * kg + e) * 64 + col; tP[ti_] = (bf16)f2bf(pl[e] * Ain); tH[ti_] = (bf16)f2bf(hl[e] + pl[e] * Bin); }
                }
                { const int rr = lane >> 2, cq = lane & 3;
                  bf16* pp = LA + (size_t)(m0 + rr) * 512 + nb * 64 + 16 * cq; bf16* hp = LB + (size_t)(m0 + rr) * 512 + nb * 64 + 16 * cq;
                  *(u32x4*)pp = *(const LAS u32x4*)(tP + rr * 64 + 16 * cq); *(u32x4*)(pp + 8) = *(const LAS u32x4*)(tP + rr * 64 + 16 * cq + 8);
                  *(u32x4*)hp = *(const LAS u32x4*)(tH + rr * 64 + 16 * cq); *(u32x4*)(hp + 8) = *(const LAS u32x4*)(tH + rr * 64 + 16 * cq + 8); }
            }
            if (kg == 0) {
#pragma unroll
                for (int ct = 0; ct < 4; ++ct) { f32x2 ab; ab.x = Arun[ct]; ab.y = Brun[ct];
                    *(f32x2*)((float*)(ws + WS_AP) + ((size_t)(((seg >> 6) * 8 + nb) * 64 + (seg & 63)) * 64 + 16 * ct + i) * 2) = ab; }
            }
        }
        { const int rsub = lane >> 5, chunk = lane & 31;
          const f32x4 m0 = *(const f32x4*)(args.in[I_MU] + 1536 + 8 * chunk), m1 = *(const f32x4*)(args.in[I_MU] + 1536 + 8 * chunk + 4);
          const bool actid = chunk >= 8 && chunk < 16; const float actc = chunk < 8 ? 2.8853900818f : -1.4426950409f, actp = chunk < 8 ? 1.0f : 0.0f, actq = chunk < 8 ? -2.0f : 1.0f;
          for (int rp = gw; rp < M / 2; rp += NGW) { const size_t mr = (size_t)2 * rp + rsub; const bool hp2 = (mr & (SEQ - 1)) != 0; const bf16* ua = U + mr * INW + 2560 + 8 * chunk;
              const u32x4 cu = *(const u32x4*)ua; u32x4 pu = *(const u32x4*)(ua - (hp2 ? INW : 0)); if (!hp2) pu = (u32x4){0u, 0u, 0u, 0u};
              float o8[8];
#pragma unroll
              for (int q = 0; q < 4; ++q) { const float c0 = bflo(cu[q]), c1 = bfhi(cu[q]), p0 = bflo(pu[q]), p1 = bfhi(pu[q]); const float mm0 = q < 2 ? m0[2 * q] : m1[2 * q - 4], mm1 = q < 2 ? m0[2 * q + 1] : m1[2 * q - 3];
                  float x0 = c0 + (p0 - c0) * mm0, x1 = c1 + (p1 - c1) * mm1;
                  const float r0 = __builtin_amdgcn_rcpf(__builtin_amdgcn_exp2f(actc * x0) + 1.0f), r1 = __builtin_amdgcn_rcpf(__builtin_amdgcn_exp2f(actc * x1) + 1.0f);
                  o8[2 * q] = actid ? x0 : actp + actq * r0; o8[2 * q + 1] = actid ? x1 : actp + actq * r1; }
              u32x4 pw; pw.x = pk2(o8[0], o8[1]); pw.y = pk2(o8[2], o8[3]); pw.z = pk2(o8[4], o8[5]); pw.w = pk2(o8[6], o8[7]);
              *(u32x4*)(LACT + mr * 256 + 8 * chunk) = pw; } }
    }
    SEAM(2);


#define RW_ZB(zz, zb) do { _Pragma("unroll") for (int ks_ = 0; ks_ < 2; ++ks_) { u32x4 p_; p_.x = pk2(zz[2 * ks_][0], zz[2 * ks_][1]); p_.y = pk2(zz[2 * ks_][2], zz[2 * ks_][3]); \
        p_.z = pk2(zz[2 * ks_ + 1][0], zz[2 * ks_ + 1][1]); p_.w = pk2(zz[2 * ks_ + 1][2], zz[2 * ks_ + 1][3]); zb[ks_] = __builtin_bit_cast(bf16x8, p_); } } while (0)
    if (IN(3)) { PHASE_IDS;
        for (int u64 = gw; u64 < NB * NH * (SEQ / 64); u64 += NGW) {
#pragma unroll 1
        for (int jj = 0; jj < 4; ++jj) {
        LAS unsigned char* wl = lds + wave * 16384;
        LAS bf16* Arm = (LAS bf16*)(wl); LAS bf16* Brm = (LAS bf16*)(wl + 2048); LAS bf16* Krm = (LAS bf16*)(wl + 4096); LAS bf16* Rrm = (LAS bf16*)(wl + 6144);
        LAS bf16* ATt = (LAS bf16*)(wl + 8192); LAS bf16* BTt = (LAS bf16*)(wl + 10240); LAS bf16* KTt = (LAS bf16*)(wl + 12288); LAS bf16* VTt = (LAS bf16*)(wl + 14336);
        LAS float* MabT = (LAS float*)(wl); LAS bf16* Mak = (LAS bf16*)(wl + 1024); LAS bf16* Mrb = (LAS bf16*)(wl + 1536); LAS bf16* Mrk = (LAS bf16*)(wl + 2048); LAS bf16* Tm = (LAS bf16*)(wl + 2560);
        LAS float* PLs = (LAS float*)(wl + 3072); LAS bf16* Q0T = (LAS bf16*)(wl + 4096);
        const int lane = fresh_tid() & 63, l15 = lane & 15, g = lane >> 4, te = lane >> 2, kq = lane & 3;
        const bf16x8 z8 = (bf16x8){0, 0, 0, 0, 0, 0, 0, 0};
        const f32x4 z4 = (f32x4){0.f, 0.f, 0.f, 0.f};
            const int un = u64 * 4 + jj;
            const int bh = un >> 8, c = un & 255, b = bh >> 3, h = bh & 7;
            const size_t mrow = (size_t)b * SEQ + c * 16 + te, off = mrow * 512 + h * 64 + 16 * kq;
            const int hc = h * 64 + 16 * kq;
            LAS float* tmpL = (LAS float*)wl;
            {
                const int rsub = lane >> 5, chunk = lane & 31; const size_t mt0 = (size_t)b * SEQ + c * 16;
                u32x4 cu[8];
#pragma unroll
                for (int i = 0; i < 8; ++i) cu[i] = *(const u32x4*)(LACT + (mt0 + 2 * i + rsub) * 256 + 8 * chunk);
#pragma unroll
                for (int i = 0; i < 8; ++i) { const int row = 2 * i + rsub; *(LAS u32x4*)(wl + row * 512 + ((chunk ^ (row & 7)) << 4)) = cu[i]; }
                bf16x8 af[8];
#pragma unroll
                for (int ks = 0; ks < 8; ++ks) af[ks] = *(const LAS bf16x8*)(wl + l15 * 512 + (((4 * ks + g) ^ (l15 & 7)) << 4));
                asm volatile("s_waitcnt lgkmcnt(0)" ::: "memory");
#pragma unroll
                for (int kind = 0; kind < 3; ++kind)
#pragma unroll
                    for (int ct = 0; ct < 4; ++ct) {
                        const bf16* lb = LoraB + ((size_t)((h * 3 + kind) * 4 + ct) * 8 * 64 + lane) * 8;
                        f32x4 a4 = z4;
#pragma unroll
                        for (int ks = (kind == 0 ? 0 : kind == 1 ? 2 : 4); ks < (kind == 0 ? 2 : kind == 1 ? 4 : 8); ++ks) a4 = __builtin_amdgcn_mfma_f32_16x16x32_bf16(af[ks], *(const bf16x8*)(lb + ks * 512), a4, 0, 0, 0);
#pragma unroll
                        for (int e = 0; e < 4; ++e) tmpL[kind * 1088 + (4 * g + e) * 68 + 16 * ct + l15] = a4[e];
                    }
            }
            asm volatile("s_waitcnt lgkmcnt(0)" ::: "memory");
            float cl[16], eP[16];
            {
                float lwv[16], rl[16], kl[16], vl[16], kn[16], av[16];
                const bool hp = (mrow & (SEQ - 1)) != 0;
                const bf16* ub = U + mrow * INW + 1024 + hc;
#pragma unroll
                for (int hh = 0; hh < 2; ++hh) {
#pragma unroll
                    for (int a3 = 0; a3 < 3; ++a3) {
                        const u32x4 cu = *(const u32x4*)(ub + 512 * a3 + 8 * hh); u32x4 pu = *(const u32x4*)(ub - (hp ? INW : 0) + 512 * a3 + 8 * hh); if (!hp) pu = (u32x4){0u, 0u, 0u, 0u};
                        const f32x4 m0 = *(const f32x4*)(args.in[I_MU] + 512 * a3 + hc + 8 * hh), m1 = *(const f32x4*)(args.in[I_MU] + 512 * a3 + hc + 8 * hh + 4);
                        float o8[8];
#pragma unroll
                        for (int q = 0; q < 4; ++q) { const float c0 = bflo(cu[q]), c1 = bfhi(cu[q]), p0 = bflo(pu[q]), p1 = bfhi(pu[q]); const float mm0 = q < 2 ? m0[2 * q] : m1[2 * q - 4], mm1 = q < 2 ? m0[2 * q + 1] : m1[2 * q - 3];
                            o8[2 * q] = c0 + (p0 - c0) * mm0; o8[2 * q + 1] = c1 + (p1 - c1) * mm1; }
#pragma unroll
                        for (int q = 0; q < 8; ++q) { if (a3 == 0) rl[8 * hh + q] = o8[q]; else if (a3 == 1) kl[8 * hh + q] = o8[q]; else vl[8 * hh + q] = o8[q]; }
                    }
                }
                float gv[16];
#pragma unroll
                for (int j4 = 0; j4 < 4; ++j4) { const f32x4 xl = *(const LAS f32x4*)(tmpL + te * 68 + 16 * kq + 4 * j4), xa = *(const LAS f32x4*)(tmpL + 1088 + te * 68 + 16 * kq + 4 * j4), xg = *(const LAS f32x4*)(tmpL + 2176 + te * 68 + 16 * kq + 4 * j4);
                    const f32x4 w0v = *(const f32x4*)(args.in[I_W0] + hc + 4 * j4), a0v = *(const f32x4*)(args.in[I_A0] + hc + 4 * j4);
#pragma unroll
                    for (int q = 0; q < 4; ++q) { lwv[4 * j4 + q] = -0.6065306597f * sigmoid_f(xl[q] + w0v[q]);        av[4 * j4 + q] = sigmoid_f(xa[q] + a0v[q]); gv[4 * j4 + q] = xg[q]; } }
                asm volatile("s_waitcnt lgkmcnt(0)" ::: "memory");
                float ss = 0.f;
#pragma unroll
                for (int j4 = 0; j4 < 4; ++j4) { const f32x4 kk4 = *(const f32x4*)(args.in[I_KK] + hc + 4 * j4);
#pragma unroll
                    for (int q = 0; q < 4; ++q) { kn[4 * j4 + q] = kl[4 * j4 + q] * kk4[q]; ss += kn[4 * j4 + q] * kn[4 * j4 + q]; } }
                ss += __shfl_xor(ss, 1); ss += __shfl_xor(ss, 2);
                const float kinv = rsq_f(fmaxf(ss, 1e-24f));
#pragma unroll
                for (int j = 0; j < 16; ++j) { float x = lwv[j];
#pragma unroll
                    for (int sft = 4; sft < 64; sft <<= 1) { const float y = __shfl_up(x, sft); if (lane >= sft) x += y; }
                    cl[j] = x; }
                float bon = 0.f;
                u32x4 pa[2], pb[2], pk[2], pr[2];
#pragma unroll
                for (int j4 = 0; j4 < 4; ++j4) {
                    const f32x4 ka = *(const f32x4*)(args.in[I_KA] + hc + 4 * j4), rk = *(const f32x4*)(args.in[I_RK] + hc + 4 * j4);
                    float at4[4], bt4[4], kt4[4], rt4[4];
#pragma unroll
                    for (int q = 0; q < 4; ++q) { const int j = 4 * j4 + q;
                        const float p = __expf(cl[j]), pn = __expf(-cl[j]), pm1 = __expf(cl[j] - lwv[j]); eP[j] = p;
                        const float knj = kn[j] * kinv;
                        const float kp = kl[j] * (1.0f + (av[j] - 1.0f) * ka[q]);
                        at4[q] = -knj * pm1; bt4[q] = knj * av[j] * pn; kt4[q] = kp * pn; rt4[q] = rl[j] * p;
                        bon += rl[j] * kp * rk[q];
                        const int kk = 16 * kq + j;
                        ATt[kk * 16 + te] = (bf16)f2bf(at4[q]); BTt[kk * 16 + te] = (bf16)f2bf(bt4[q]); KTt[kk * 16 + te] = (bf16)f2bf(kt4[q]); VTt[kk * 16 + te] = (bf16)f2bf(vl[j]); }
                    const int hh = j4 >> 1, w2 = (j4 & 1) * 2;
                    pa[hh][w2] = pk2(at4[0], at4[1]); pa[hh][w2 + 1] = pk2(at4[2], at4[3]); pb[hh][w2] = pk2(bt4[0], bt4[1]); pb[hh][w2 + 1] = pk2(bt4[2], bt4[3]);
                    pk[hh][w2] = pk2(kt4[0], kt4[1]); pk[hh][w2 + 1] = pk2(kt4[2], kt4[3]); pr[hh][w2] = pk2(rt4[0], rt4[1]); pr[hh][w2 + 1] = pk2(rt4[2], rt4[3]);
                }
#pragma unroll
                for (int hh = 0; hh < 2; ++hh) { const int po = te * 64 + 8 * ((2 * kq + hh) ^ (te & 7));
                    *(LAS u32x4*)(Arm + po) = pa[hh]; *(LAS u32x4*)(Brm + po) = pb[hh]; *(LAS u32x4*)(Krm + po) = pk[hh]; *(LAS u32x4*)(Rrm + po) = pr[hh]; }
                bon += __shfl_xor(bon, 1); bon += __shfl_xor(bon, 2);
                f32x4 lbv[4], lgv[4];
#pragma unroll
                for (int j4 = 0; j4 < 4; ++j4) { lbv[j4] = *(const f32x4*)(args.in[I_LNB] + hc + 4 * j4); lgv[j4] = *(const f32x4*)(args.in[I_LNG] + hc + 4 * j4); }
#pragma unroll
                for (int j4 = 0; j4 < 4; ++j4) { const f32x4 lb = lbv[j4], lgn = lgv[j4]; const int j0 = 4 * j4;
                    u32x2 ow, gw2; ow.x = pk2((lb.x + vl[j0] * bon) * gv[j0], (lb.y + vl[j0 + 1] * bon) * gv[j0 + 1]); ow.y = pk2((lb.z + vl[j0 + 2] * bon) * gv[j0 + 2], (lb.w + vl[j0 + 3] * bon) * gv[j0 + 3]);
                    gw2.x = pk2(lgn.x * gv[j0], lgn.y * gv[j0 + 1]); gw2.y = pk2(lgn.z * gv[j0 + 2], lgn.w * gv[j0 + 3]);
                    *(u32x2*)((bf16*)(ws + WS_ADD) + off + j0) = ow; *(u32x2*)((bf16*)(ws + WS_G) + off + j0) = gw2; }
            }
            asm volatile("s_waitcnt lgkmcnt(0)" ::: "memory");
            {
                bf16x8 fa[2], fr[2], fb[2], fk[2];
#pragma unroll
                for (int ks = 0; ks < 2; ++ks) { const int po = l15 * 64 + 8 * ((4 * ks + g) ^ (l15 & 7));
                    fa[ks] = *(const LAS bf16x8*)(Arm + po); fr[ks] = *(const LAS bf16x8*)(Rrm + po); fb[ks] = *(const LAS bf16x8*)(Brm + po); fk[ks] = *(const LAS bf16x8*)(Krm + po); }
                f32x4 mab = z4, mak = z4, mrb = z4, mrk = z4;
#pragma unroll
                for (int ks = 0; ks < 2; ++ks) { mab = __builtin_amdgcn_mfma_f32_16x16x32_bf16(fb[ks], fa[ks], mab, 0, 0, 0); mak = __builtin_amdgcn_mfma_f32_16x16x32_bf16(fk[ks], fa[ks], mak, 0, 0, 0);
                    mrb = __builtin_amdgcn_mfma_f32_16x16x32_bf16(fb[ks], fr[ks], mrb, 0, 0, 0); mrk = __builtin_amdgcn_mfma_f32_16x16x32_bf16(fk[ks], fr[ks], mrk, 0, 0, 0); }
#pragma unroll
                for (int e = 0; e < 4; ++e) { const int i = 4 * g + e; if (!(i < l15)) { mab[e] = 0.f; mak[e] = 0.f; } if (!(i <= l15)) { mrb[e] = 0.f; mrk[e] = 0.f; } }
                asm volatile("s_waitcnt lgkmcnt(0)" ::: "memory");
#pragma unroll
                for (int e = 0; e < 4; ++e) MabT[(4 * g + e) * 16 + l15] = mab[e];
                u32x2 w; w.x = pk2(mak[0], mak[1]); w.y = pk2(mak[2], mak[3]); *(LAS u32x2*)(Mak + l15 * 16 + 4 * g) = w;
                w.x = pk2(mrb[0], mrb[1]); w.y = pk2(mrb[2], mrb[3]); *(LAS u32x2*)(Mrb + l15 * 16 + 4 * g) = w;
                w.x = pk2(mrk[0], mrk[1]); w.y = pk2(mrk[2], mrk[3]); *(LAS u32x2*)(Mrk + l15 * 16 + 4 * g) = w;
                if (te == 15) {
#pragma unroll
                    for (int j = 0; j < 16; ++j) PLs[16 * kq + j] = eP[j]; }
            }
            asm volatile("s_waitcnt lgkmcnt(0)" ::: "memory");
            {
                f32x4 mq[15][4];
#pragma unroll
                for (int j = 0; j < 15; ++j)
#pragma unroll
                    for (int q = 0; q < 4; ++q) if (4 * q + 3 > j) mq[j][q] = *(const LAS f32x4*)(MabT + j * 16 + 4 * q);
                float y[16];
#pragma unroll
                for (int j = 15; j >= 0; --j) {
                    float acc = (j == l15) ? 1.0f : 0.0f;
#pragma unroll
                    for (int i = j + 1; i < 16; ++i) acc += y[i] * mq[j < 15 ? j : 0][i >> 2][i & 3];
                    y[j] = acc;
                }
                if (g == 0) { u32x4 t0, t1; t0.x = pk2(y[0], y[1]); t0.y = pk2(y[2], y[3]); t0.z = pk2(y[4], y[5]); t0.w = pk2(y[6], y[7]); t1.x = pk2(y[8], y[9]); t1.y = pk2(y[10], y[11]); t1.z = pk2(y[12], y[13]); t1.w = pk2(y[14], y[15]);
                    *(LAS u32x4*)(Tm + l15 * 16) = t0; *(LAS u32x4*)(Tm + l15 * 16 + 8) = t1; }
            }
            asm volatile("s_waitcnt lgkmcnt(0)" ::: "memory");
            {
                const bool act = g < 2; const int fo = l15 * 16 + 8 * g;
                const bf16x8 fT = act ? *(const LAS bf16x8*)(Tm + fo) : z8, fMak = act ? *(const LAS bf16x8*)(Mak + fo) : z8, fMrb = act ? *(const LAS bf16x8*)(Mrb + fo) : z8, fMrk = act ? *(const LAS bf16x8*)(Mrk + fo) : z8;
                bf16x8 fV[4], fQ1[4], fAh[4], fBT[4], fKT[4];
#pragma unroll
                for (int vt = 0; vt < 4; ++vt) { fV[vt] = act ? *(const LAS bf16x8*)(VTt + vt * 256 + fo) : z8; fBT[vt] = act ? *(const LAS bf16x8*)(BTt + vt * 256 + fo) : z8; fKT[vt] = act ? *(const LAS bf16x8*)(KTt + vt * 256 + fo) : z8; }
#pragma unroll
                for (int vt = 0; vt < 4; ++vt) { const f32x4 q0 = __builtin_amdgcn_mfma_f32_16x16x32_bf16(fMak, fV[vt], z4, 0, 0, 0);
                    u32x2 w; w.x = pk2(q0[0], q0[1]); w.y = pk2(q0[2], q0[3]); *(LAS u32x2*)(Q0T + vt * 256 + l15 * 16 + 4 * g) = w; }
#pragma unroll
                for (int kt = 0; kt < 4; ++kt) { const bf16x8 fA = act ? *(const LAS bf16x8*)(ATt + kt * 256 + fo) : z8; const f32x4 ah = __builtin_amdgcn_mfma_f32_16x16x32_bf16(fT, fA, z4, 0, 0, 0);
                    u32x2 w; w.x = pk2(ah[0], ah[1]); w.y = pk2(ah[2], ah[3]); *(LAS u32x2*)(ATt + kt * 256 + l15 * 16 + 4 * g) = w; }
                asm volatile("s_waitcnt lgkmcnt(0)" ::: "memory");
#pragma unroll
                for (int vt = 0; vt < 4; ++vt) { const bf16x8 fQ0 = act ? *(const LAS bf16x8*)(Q0T + vt * 256 + fo) : z8; const f32x4 q1 = __builtin_amdgcn_mfma_f32_16x16x32_bf16(fT, fQ0, z4, 0, 0, 0);
                    u32x2 w; w.x = pk2(q1[0], q1[1]); w.y = pk2(q1[2], q1[3]); *(LAS u32x2*)(Q0T + vt * 256 + l15 * 16 + 4 * g) = w; }
                asm volatile("s_waitcnt lgkmcnt(0)" ::: "memory");
#pragma unroll
                for (int vt = 0; vt < 4; ++vt) { fQ1[vt] = act ? *(const LAS bf16x8*)(Q0T + vt * 256 + fo) : z8; fAh[vt] = act ? *(const LAS bf16x8*)(ATt + vt * 256 + fo) : z8; }
                bf16* rp = (bf16*)(ws + WS_RP) + (size_t)un * 1024 + l15 * 64;
#pragma unroll
                for (int kt = 0; kt < 4; ++kt) {
                    const u32x2 rr = *(const LAS u32x2*)(Rrm + l15 * 64 + 8 * ((2 * kt + (g >> 1)) ^ (l15 & 7)) + 4 * (g & 1));
                    f32x4 ini; ini[0] = bflo(rr.x); ini[1] = bfhi(rr.x); ini[2] = bflo(rr.y); ini[3] = bfhi(rr.y);
                    const f32x4 rh = __builtin_amdgcn_mfma_f32_16x16x32_bf16(fAh[kt], fMrb, ini, 0, 0, 0);
                    u32x2 w; w.x = pk2(rh[0], rh[1]); w.y = pk2(rh[2], rh[3]); *(u32x2*)(rp + 32 * (kt >> 1) + 8 * g + 4 * (kt & 1)) = w;
                }
#pragma unroll
                for (int vt = 0; vt < 4; ++vt) { f32x4 y1 = __builtin_amdgcn_mfma_f32_16x16x32_bf16(fMrb, fQ1[vt], z4, 0, 0, 0); y1 = __builtin_amdgcn_mfma_f32_16x16x32_bf16(fMrk, fV[vt], y1, 0, 0, 0);
                    *(f32x4*)((float*)(ws + WS_Y1F) + ((size_t)(un * 4 + vt) * 64 + lane) * 4) = y1; }
                LAS bf16* tgs = (LAS bf16*)(wl + 8192);
#pragma unroll
                for (int krt = 0; krt < 4; ++krt) { const float pl = PLs[16 * krt + l15];
#pragma unroll
                    for (int kct = 0; kct < 4; ++kct) { f32x4 ga = __builtin_amdgcn_mfma_f32_16x16x32_bf16(fAh[kct], fBT[krt], z4, 0, 0, 0);
                        if (kct == krt) {
#pragma unroll
                            for (int e = 0; e < 4; ++e) if (4 * g + e == l15) ga[e] += 1.0f; }
                        u32x2 w; w.x = pk2(ga[0] * pl, ga[1] * pl); w.y = pk2(ga[2] * pl, ga[3] * pl);
                        *(LAS u32x2*)(tgs + (16 * krt + l15) * 64 + 32 * (kct >> 1) + 8 * g + 4 * (kct & 1)) = w; } }
                { u32x4* gp16 = (u32x4*)((bf16*)(ws + WS_GP) + (size_t)un * 4096);
#pragma unroll
                  for (int i = 0; i < 8; ++i) gp16[i * 64 + lane] = *(const LAS u32x4*)(tgs + (i * 64 + lane) * 8); }
#pragma unroll
                for (int mt = 0; mt < 4; ++mt) { const f32x4 pl4 = *(const LAS f32x4*)(PLs + 16 * mt + 4 * g);
#pragma unroll
                    for (int vt = 0; vt < 4; ++vt) { f32x4 ha = __builtin_amdgcn_mfma_f32_16x16x32_bf16(fBT[mt], fQ1[vt], z4, 0, 0, 0); ha = __builtin_amdgcn_mfma_f32_16x16x32_bf16(fKT[mt], fV[vt], ha, 0, 0, 0);
                        u32x2 w; w.x = pk2(ha[0] * pl4[0], ha[1] * pl4[1]); w.y = pk2(ha[2] * pl4[2], ha[3] * pl4[3]);
                        *(u32x2*)((bf16*)(ws + WS_HF) + ((size_t)((un * 4 + vt) * 4 + mt) * 64 + lane) * 4) = w; } }
            }
            asm volatile("s_waitcnt lgkmcnt(0)" ::: "memory");
        }
        asm volatile("s_waitcnt vmcnt(0)" ::: "memory");
        { const int ltid = fresh_tid() & 63, l15 = ltid & 15, g = ltid >> 4, lane = ltid;
#define CP_LOADG(gf_, j_) do { const bf16* gp_ = (const bf16*)(ws + WS_GP) + ((size_t)u64 * 4 + (j_)) * 4096 + l15 * 64 + 8 * g; \
            _Pragma("unroll") for (int mt = 0; mt < 4; ++mt) { gf_[mt][0] = *(const bf16x8*)(gp_ + mt * 1024); gf_[mt][1] = *(const bf16x8*)(gp_ + mt * 1024 + 32); } } while (0)
#define CP_LOADH(hf_, j_) do { _Pragma("unroll") for (int sl = 0; sl < 4; ++sl) _Pragma("unroll") for (int mt = 0; mt < 4; ++mt) \
            hf_[sl][mt] = *(const u32x2*)((const bf16*)(ws + WS_HF) + ((size_t)((((size_t)u64 * 4 + (j_)) * 4 + sl) * 4 + mt) * 64 + lane) * 4); } while (0)
#define CP_STEP(gf_, hf_, useh_) do { _Pragma("unroll") for (int sl = 0; sl < 4; ++sl) { bf16x8 zb[2]; RW_ZB(z[sl], zb); \
            _Pragma("unroll") for (int mt = 0; mt < 4; ++mt) { f32x4 a_ = (f32x4){0.f, 0.f, 0.f, 0.f}; \
                if (useh_) { a_[0] = bflo(hf_[sl][mt].x); a_[1] = bfhi(hf_[sl][mt].x); a_[2] = bflo(hf_[sl][mt].y); a_[3] = bfhi(hf_[sl][mt].y); } \
                a_ = __builtin_amdgcn_mfma_f32_16x16x32_bf16(gf_[mt][0], zb[0], a_, 0, 0, 0); a_ = __builtin_amdgcn_mfma_f32_16x16x32_bf16(gf_[mt][1], zb[1], a_, 0, 0, 0); z[sl][mt] = a_; } } } while (0)
        {
            f32x4 z[4][4];
#pragma unroll
            for (int sl = 0; sl < 4; ++sl)
#pragma unroll
                for (int mt = 0; mt < 4; ++mt)
#pragma unroll
                    for (int e = 0; e < 4; ++e) z[sl][mt][e] = (sl == mt && 4 * g + e == l15) ? 1.0f : 0.0f;
            bf16x8 gA[4][2], gB[4][2]; u32x2 hdum[4][4];
            CP_LOADG(gA, 0); CP_LOADG(gB, 1);
            CP_STEP(gA, hdum, false); CP_LOADG(gA, 2);
            CP_STEP(gB, hdum, false); CP_LOADG(gB, 3);
            CP_STEP(gA, hdum, false);
            CP_STEP(gB, hdum, false);
            LAS bf16* tg = (LAS bf16*)(lds + wave * 16384);
#pragma unroll
            for (int sl = 0; sl < 4; ++sl) { const int pc = 32 * (sl >> 1) + 8 * (l15 >> 2) + 4 * (sl & 1) + (l15 & 3);
#pragma unroll
                for (int mt = 0; mt < 4; ++mt)
#pragma unroll
                    for (int e = 0; e < 4; ++e) tg[(16 * mt + 4 * g + e) * 64 + pc] = (bf16)f2bf(z[sl][mt][e]); }
            u32x4* gc = (u32x4*)((bf16*)(ws + WS_GC) + (size_t)u64 * 4096);
#pragma unroll
            for (int i = 0; i < 8; ++i) gc[i * 64 + lane] = *(const LAS u32x4*)(tg + (i * 64 + lane) * 8);
        }
        {
            f32x4 z[4][4];
#pragma unroll
            for (int sl = 0; sl < 4; ++sl)
#pragma unroll
                for (int mt = 0; mt < 4; ++mt) z[sl][mt] = (f32x4){0.f, 0.f, 0.f, 0.f};
            bf16x8 gA[4][2], gB[4][2]; u32x2 hA[4][4], hB[4][4];
            CP_LOADG(gA, 0); CP_LOADH(hA, 0); CP_LOADG(gB, 1); CP_LOADH(hB, 1);
            CP_STEP(gA, hA, true); CP_LOADG(gA, 2); CP_LOADH(hA, 2);
            CP_STEP(gB, hB, true); CP_LOADG(gB, 3); CP_LOADH(hB, 3);
            CP_STEP(gA, hA, true);
            CP_STEP(gB, hB, true);
#pragma unroll
            for (int sl = 0; sl < 4; ++sl)
#pragma unroll
                for (int mt = 0; mt < 4; ++mt) { u32x2 w; w.x = pk2(z[sl][mt][0], z[sl][mt][1]); w.y = pk2(z[sl][mt][2], z[sl][mt][3]);
                    *(u32x2*)((bf16*)(ws + WS_HC) + ((size_t)((u64 * 4 + sl) * 4 + mt) * 64 + lane) * 4) = w; }
        }
#undef CP_LOADG
#undef CP_LOADH
#undef CP_STEP
        }
        }
    }
    SEAM(3);


    if (IN(4)) { PHASE_IDS;
        if (!(bid < 128 && wave == 0)) {
            const int wi = bid < 128 ? bid * 7 + (wave - 1) : 896 + (bid - 128) * 8 + wave, NW = 896 + (G - 128) * 8;
        } else {
            const int l15 = lane & 15, g = lane >> 4, bh = bid >> 2, vs = bid & 3;
            f32x4 z[4];
#pragma unroll
            for (int mt = 0; mt < 4; ++mt) z[mt] = (f32x4){0.f, 0.f, 0.f, 0.f};
            bf16x8 gA[4][2], gB[4][2], gC[4][2], gD[4][2]; u32x2 hA[4], hB[4], hC[4], hD[4];
#define SC_LOAD(gf, hf, C) do { const size_t u64_ = (size_t)bh * 64 + (C); const bf16* gp_ = (const bf16*)(ws + WS_GC) + u64_ * 4096 + l15 * 64 + 8 * g; \
                _Pragma("unroll") for (int mt = 0; mt < 4; ++mt) { gf[mt][0] = *(const bf16x8*)(gp_ + mt * 1024); gf[mt][1] = *(const bf16x8*)(gp_ + mt * 1024 + 32); \
                    hf[mt] = *(const u32x2*)((const bf16*)(ws + WS_HC) + ((size_t)((u64_ * 4 + vs) * 4 + mt) * 64 + lane) * 4); } } while (0)
#define SC_STEP(gf, hf, C) do { const size_t u64_ = (size_t)bh * 64 + (C); bf16* zs_ = (bf16*)(ws + WS_ZS) + ((size_t)((u64_ * 4 + vs) * 4) * 64 + lane) * 4; \
                _Pragma("unroll") for (int mt = 0; mt < 4; ++mt) { u32x2 zw_; zw_.x = pk2(z[mt][0], z[mt][1]); zw_.y = pk2(z[mt][2], z[mt][3]); *(u32x2*)(zs_ + mt * 256) = zw_; } \
                bf16x8 zb[2]; RW_ZB(z, zb); \
                _Pragma("unroll") for (int mt = 0; mt < 4; ++mt) { f32x4 a; a[0] = bflo(hf[mt].x); a[1] = bfhi(hf[mt].x); a[2] = bflo(hf[mt].y); a[3] = bfhi(hf[mt].y); \
                    a = __builtin_amdgcn_mfma_f32_16x16x32_bf16(gf[mt][0], zb[0], a, 0, 0, 0); a = __builtin_amdgcn_mfma_f32_16x16x32_bf16(gf[mt][1], zb[1], a, 0, 0, 0); z[mt] = a; } } while (0)
            bf16x8 gE[4][2]; u32x2 hE[4];
            SC_LOAD(gA, hA, 0); SC_LOAD(gB, hB, 1); SC_LOAD(gC, hC, 2); SC_LOAD(gD, hD, 3);
#pragma unroll 1
            for (int C = 0; C < 60; C += 5) {
                SC_LOAD(gE, hE, C + 4);
                SC_STEP(gA, hA, C);     SC_LOAD(gA, hA, C + 5);
                SC_STEP(gB, hB, C + 1); SC_LOAD(gB, hB, C + 6);
                SC_STEP(gC, hC, C + 2); SC_LOAD(gC, hC, C + 7);
                SC_STEP(gD, hD, C + 3); SC_LOAD(gD, hD, C + 8);
                SC_STEP(gE, hE, C + 4);
            }
            SC_STEP(gA, hA, 60); SC_STEP(gB, hB, 61); SC_STEP(gC, hC, 62); SC_STEP(gD, hD, 63);
#undef SC_LOAD
#undef SC_STEP
        }
    }
    if (IN(4)) { PHASE_IDS;
        if (bid < 32 && wave == 1) { const int bc = bid; const f32x2* ag = (const f32x2*)((const float*)(ws + WS_AP)) + (size_t)(bc * 64) * 64 + lane;
            float* car = (float*)(ws + WS_AP + 4 * MiB) + (size_t)(bc * 64) * 64 + lane; float hst = 0.f;
            f32x2 abv[64];
#pragma unroll
            for (int sg = 0; sg < 64; ++sg) abv[sg] = ag[(size_t)sg * 64];
#pragma unroll
            for (int sg = 0; sg < 64; ++sg) { car[(size_t)sg * 64] = hst; hst = abv[sg].x * hst + abv[sg].y; } }
    }
    if (IN(4)) { PHASE_IDS;
        bf16* WKt = HN; bf16* VWt = HN + (size_t)4 * 1024 * 1024;
        __syncthreads();
        if (bid >= 128 && bid < 192) { pg8::FoldSched<0> S; S.A = (const char*)KM; S.B = (const char*)Wq_t; S.G = 64; S.c = bid - 128; EpiFold<0> E{(unsigned char*)WKt}; pg8::gemm_phase(lds, 256, S, E, wv0, 1024); }
        else if (bid >= 192) { pg8::FoldSched<1> S; S.A = (const char*)Wo_t; S.B = (const char*)VT; S.G = 64; S.c = bid - 192; EpiFold<1> E{(unsigned char*)VWt}; pg8::gemm_phase(lds, 256, S, E, wv0, 1024); }
    }
    SEAM(4);

    if (IN(5)) { PHASE_IDS;
        {
            for (int lu = gw; lu < (M / 64) * 8; lu += NGW) {
                const int seg = lu >> 3, nb = lu & 7, rr = lane >> 3, cq = lane & 7;
                const float* cp = (const float*)(ws + WS_AP + 4 * MiB) + ((size_t)(((seg >> 6) * 8 + nb) * 64 + (seg & 63)) * 64 + 8 * cq);
                const f32x4 c0 = *(const f32x4*)cp, c1 = *(const f32x4*)(cp + 4);
#pragma unroll
                for (int it = 0; it < 8; ++it) { const size_t m = (size_t)seg * 64 + 8 * it + rr; const size_t o = m * 512 + nb * 64 + 8 * cq;
                    const u32x4 pw = __builtin_nontemporal_load((const u32x4*)(LA + o)), hw = __builtin_nontemporal_load((const u32x4*)(LB + o)), gw_ = __builtin_nontemporal_load((const u32x4*)(U + m * INW + 512 + nb * 64 + 8 * cq));
                    float y[8];
#pragma unroll
                    for (int q = 0; q < 4; ++q) { const float ca = q < 2 ? c0[2 * q] : c1[2 * q - 4], cb = q < 2 ? c0[2 * q + 1] : c1[2 * q - 3];
                        y[2 * q] = (bflo(hw[q]) + bflo(pw[q]) * ca) * gelu_tanh_f(bflo(gw_[q])); y[2 * q + 1] = (bfhi(hw[q]) + bfhi(pw[q]) * cb) * gelu_tanh_f(bfhi(gw_[q])); }
                    u32x4 w; w.x = pk2(y[0], y[1]); w.y = pk2(y[2], y[3]); w.z = pk2(y[4], y[5]); w.w = pk2(y[6], y[7]);
                    *(u32x4*)(CAT + m * 1024 + nb * 64 + 8 * cq) = w; }
            }
        }
        const int l15 = lane & 15, g = lane >> 4;
        LAS bf16* tGL = (LAS bf16*)(lds + wave * 16384); LAS bf16* tAD = tGL + 1024; LAS bf16* tOUT = tGL + 2048;
        const int ct = lane >> 3, cc = lane & 7;
        for (int u64 = gw; u64 < NB * NH * (SEQ / 64); u64 += NGW) {
            const int bh = u64 >> 6, C = u64 & 63, b = bh >> 3, h = bh & 7;
            f32x4 z[4][4];
#pragma unroll
            for (int sl = 0; sl < 4; ++sl)
#pragma unroll
                for (int mt = 0; mt < 4; ++mt) { const u32x2 zw = *(const u32x2*)((const bf16*)(ws + WS_ZS) + ((size_t)((u64 * 4 + sl) * 4 + mt) * 64 + lane) * 4); z[sl][mt] = (f32x4){bflo(zw.x), bfhi(zw.x), bflo(zw.y), bfhi(zw.y)}; }
#pragma unroll 1
            for (int j = 0; j < 4; ++j) {
                const size_t un = (size_t)u64 * 4 + j; const size_t m0 = (size_t)b * SEQ + (C * 4 + j) * 16;
                const bf16* rp = (const bf16*)(ws + WS_RP) + un * 1024 + l15 * 64 + 8 * g;
                const bf16x8 rf0 = __builtin_nontemporal_load((const bf16x8*)rp), rf1 = __builtin_nontemporal_load((const bf16x8*)(rp + 32));
                f32x4 y[4];
#pragma unroll
                for (int sl = 0; sl < 4; ++sl) y[sl] = __builtin_nontemporal_load((const f32x4*)((const float*)(ws + WS_Y1F) + ((size_t)(un * 4 + sl) * 64 + lane) * 4));
                const size_t rg = (m0 + ct) * 512 + h * 64 + 8 * cc;
                const u32x4 gl0 = __builtin_nontemporal_load((const u32x4*)((const bf16*)(ws + WS_G) + rg)), gl1 = __builtin_nontemporal_load((const u32x4*)((const bf16*)(ws + WS_G) + rg + 8 * 512));
                const u32x4 ad0 = __builtin_nontemporal_load((const u32x4*)((const bf16*)(ws + WS_ADD) + rg)), ad1 = __builtin_nontemporal_load((const u32x4*)((const bf16*)(ws + WS_ADD) + rg + 8 * 512));
                bf16x8 gf[4][2]; u32x2 hfr[4][4];
                if (j < 3) {
                    const bf16* gp = (const bf16*)(ws + WS_GP) + un * 4096 + l15 * 64 + 8 * g;
#pragma unroll
                    for (int mt = 0; mt < 4; ++mt) { gf[mt][0] = __builtin_nontemporal_load((const bf16x8*)(gp + mt * 1024)); gf[mt][1] = __builtin_nontemporal_load((const bf16x8*)(gp + mt * 1024 + 32)); }
#pragma unroll
                    for (int sl = 0; sl < 4; ++sl)
#pragma unroll
                        for (int mt = 0; mt < 4; ++mt) hfr[sl][mt] = __builtin_nontemporal_load((const u32x2*)((const bf16*)(ws + WS_HF) + ((size_t)((un * 4 + sl) * 4 + mt) * 64 + lane) * 4));
                }
                *(LAS u32x4*)(tGL + ct * 64 + 8 * cc) = gl0; *(LAS u32x4*)(tGL + (ct + 8) * 64 + 8 * cc) = gl1;
                *(LAS u32x4*)(tAD + ct * 64 + 8 * cc) = ad0; *(LAS u32x4*)(tAD + (ct + 8) * 64 + 8 * cc) = ad1;
                bf16x8 zb[4][2];
#pragma unroll
                for (int sl = 0; sl < 4; ++sl) { RW_ZB(z[sl], zb[sl]);
                    y[sl] = __builtin_amdgcn_mfma_f32_16x16x32_bf16(rf0, zb[sl][0], y[sl], 0, 0, 0); y[sl] = __builtin_amdgcn_mfma_f32_16x16x32_bf16(rf1, zb[sl][1], y[sl], 0, 0, 0); }
#pragma unroll
                for (int e = 0; e < 4; ++e) {
                    float s1 = (y[0][e] + y[1][e]) + (y[2][e] + y[3][e]);
                    s1 += __shfl_xor(s1, 1); s1 += __shfl_xor(s1, 2); s1 += __shfl_xor(s1, 4); s1 += __shfl_xor(s1, 8);
                    const float mean = s1 * (1.0f / 64.0f);
                    float d0 = y[0][e] - mean, d1 = y[1][e] - mean, d2 = y[2][e] - mean, d3 = y[3][e] - mean;
                    float s2 = (d0 * d0 + d1 * d1) + (d2 * d2 + d3 * d3);
                    s2 += __shfl_xor(s2, 1); s2 += __shfl_xor(s2, 2); s2 += __shfl_xor(s2, 4); s2 += __shfl_xor(s2, 8);
                    const float rstd = rsq_f(s2 * (1.0f / 64.0f) + GN_EPS);
                    const float dd[4] = {d0, d1, d2, d3};
#pragma unroll
                    for (int sl = 0; sl < 4; ++sl) { const int ti_ = (4 * g + e) * 64 + 16 * sl + l15;
                        const float o = dd[sl] * rstd * bf2f(tGL[ti_]) + bf2f(tAD[ti_]); tOUT[ti_] = (bf16)f2bf(o); }
                }
                { bf16* cp = CAT + (m0 + ct) * 1024 + 512 + h * 64 + 8 * cc;
                  *(u32x4*)cp = *(const LAS u32x4*)(tOUT + ct * 64 + 8 * cc); *(u32x4*)(cp + 8 * 1024) = *(const LAS u32x4*)(tOUT + (ct + 8) * 64 + 8 * cc); }
                if (j < 3) {
#pragma unroll
                    for (int sl = 0; sl < 4; ++sl)
#pragma unroll
                        for (int mt = 0; mt < 4; ++mt) { const u32x2 hh = hfr[sl][mt];
                            f32x4 a; a[0] = bflo(hh.x); a[1] = bfhi(hh.x); a[2] = bflo(hh.y); a[3] = bfhi(hh.y);
                            a = __builtin_amdgcn_mfma_f32_16x16x32_bf16(gf[mt][0], zb[sl][0], a, 0, 0, 0); a = __builtin_amdgcn_mfma_f32_16x16x32_bf16(gf[mt][1], zb[sl][1], a, 0, 0, 0); z[sl][mt] = a; }
                }
            }
        }
    }
    SEAM(5);
#undef RW_ZB


    if (IN(6)) { PHASE_IDS;
        pg8::DenseSched S; S.o.init_tiles(M / 256, D / 256, G, bid); S.A = (const char*)CAT; S.B = (const char*)Wout_t; S.tstep = (size_t)256 * D * 2;
        EpiBf16Res<false> E{args.in[I_X], X1, D, (float*)(ws + WS_AP + 2 * MiB), 1.0f, X1F8}; pg8::gemm_phase(lds, D, S, E, wv0);
    }
    SEAM(6);
    if (IN(7)) { PHASE_IDS;
        pg8::BatchBSched S; S.o.init_tiles(M / 256, D / 256, G, bid); S.A = (const char*)X1F8; S.B = (const char*)HN; S.tstep = (size_t)256 * 1024; S.bstep = (size_t)1024 * 1024;
        EpiSoftmax E{(unsigned char*)Qb, 0.0625f * 0.25f, (const float*)(ws + WS_AP + 2 * MiB), (LAS float*)(lds + RING_BYTES + 1024), (LAS float*)(lds + RING_BYTES + 1024 + 4096)};
        pg8::gemm_phase<EpiSoftmax, pg8::BatchBSched, true, true>(lds, 512, S, E, wv0);
    }
    SEAM(7);
    if (IN(8)) { PHASE_IDS;
        pg8::BatchBSched S; S.o.init_tiles(M / 256, D / 256, G, bid); S.A = (const char*)Qb; S.B = (const char*)(HN + (size_t)4 * 1024 * 1024); S.tstep = (size_t)256 * 1024; S.bstep = (size_t)1024 * 1024;
        EpiBf16Res<true> E{X1, X2, D, nullptr, 1.0f / 1024.0f, nullptr}; pg8::gemm_phase<EpiBf16Res<true>, pg8::BatchBSched, true, true>(lds, 512, S, E, wv0);
    }
    SEAM(8);
    if (IN(9)) { PHASE_IDS;
        for (int cid = tid; cid < 2 * NE * 128; cid += NTHREADS) { const int t = cid >> 12, row = (cid >> 7) & 31, c = cid & 127;
            *(LAS u32x4*)(lds + t * 65536 + row * 2048 + ((c ^ (row & 7)) << 4)) = *(const u32x4*)(WrT + (size_t)t * NE * D + row * D + 8 * c); }
        __syncthreads();
        const int l15 = lane & 15, g = lane >> 4;
        LAS float* LG = (LAS float*)(lds + RING_BYTES + 1024 + wave * 2304);
        const float* gfn = args.in[I_NFFG];
        LAS unsigned* cntl = (LAS unsigned*)(lds + RING_BYTES + 640);
        for (int t0 = 0; t0 < M / 16; t0 += G * 4) {
        if (tid < 64) cntl[tid] = 0u;
        __syncthreads();
        if (t0 == 0 && wave >= 4) {
            constexpr int I_DN = 16 * 32, I_GU = 16 * 64;
            for (int r = bid * 4 + (wave - 4); r < CONV_P9D; r += G * 4) { const int e = r / I_DN, q = r % I_DN, kb = q / 32, nb = q % 32;
                transpose_item_tiled_fp8_nolds(args.in[I_WDN] + (size_t)e * DFF * D, D, DFF, (unsigned char*)Wdn_t + (size_t)e * D * DFF, 64 * kb, 32 * nb, 32 * nb, lane); }
        }
        const int tile = t0 + bid * 4 + wave; const bool active = wave < 4 && tile < M / 16;
        int me = 0, lpos = 0, ai = 0; float mg = 0.f;
        if (active) {
            const int m0 = tile * 16;
            const bf16* xrow = X2 + (size_t)(m0 + l15) * D + 8 * g;
            float ss = 0.f;
#pragma unroll 8
            for (int ks = 0; ks < 32; ++ks) { const u32x4 xw = *(const u32x4*)(xrow + 32 * ks);
#pragma unroll
                for (int q = 0; q < 4; ++q) { const float a = bflo(xw[q]), c = bfhi(xw[q]); ss += a * a + c * c; } }
            ss += __shfl_xor(ss, 16); ss += __shfl_xor(ss, 32);
            const float rstd = rsq_f(ss * (1.f / D) + EPS);
            f32x4 acc0 = (f32x4){0.f, 0.f, 0.f, 0.f}, acc1 = acc0;
            unsigned char* hrow = (unsigned char*)HN + (size_t)(m0 + l15) * D + 8 * g;
#pragma unroll 2
            for (int ks = 0; ks < 32; ++ks) {
                const f32x4 g0 = *(const f32x4*)(gfn + 32 * ks + 8 * g), g1 = *(const f32x4*)(gfn + 32 * ks + 8 * g + 4);
                const u32x4 xw = *(const u32x4*)(xrow + 32 * ks);
                float hf[8];
#pragma unroll
                for (int q = 0; q < 4; ++q) { hf[2 * q] = bflo(xw[q]) * rstd * (q < 2 ? g0[2 * q] : g1[2 * q - 4]); hf[2 * q + 1] = bfhi(xw[q]) * rstd * (q < 2 ? g0[2 * q + 1] : g1[2 * q - 3]); }
                u32x4 hi, lo;
#pragma unroll
                for (int q = 0; q < 4; ++q) { hi[q] = pk2(hf[2 * q], hf[2 * q + 1]); lo[q] = pk2(hf[2 * q] - bflo(hi[q]), hf[2 * q + 1] - bfhi(hi[q])); }
                { u32x2 h8; h8.x = pk4_fp8(hf[0], hf[1], hf[2], hf[3]); h8.y = pk4_fp8(hf[4], hf[5], hf[6], hf[7]); *(u32x2*)(hrow + 32 * ks) = h8; }
                const bf16x8 ah = __builtin_bit_cast(bf16x8, hi), al = __builtin_bit_cast(bf16x8, lo);
                const int c = 4 * ks + g;
#pragma unroll
                for (int nt = 0; nt < 2; ++nt) { const int row = 16 * nt + l15; const int off = row * 2048 + ((c ^ (row & 7)) << 4);
                    const bf16x8 bh = *(const LAS bf16x8*)(lds + off), bl = *(const LAS bf16x8*)(lds + 65536 + off);
                    f32x4 a = nt ? acc1 : acc0;
                    a = __builtin_amdgcn_mfma_f32_16x16x32_bf16(ah, bh, a, 0, 0, 0); a = __builtin_amdgcn_mfma_f32_16x16x32_bf16(ah, bl, a, 0, 0, 0); a = __builtin_amdgcn_mfma_f32_16x16x32_bf16(al, bh, a, 0, 0, 0);
                    if (nt) acc1 = a; else acc0 = a; }
            }
            { const float b0 = args.in[I_BR][l15], b1 = args.in[I_BR][16 + l15];
#pragma unroll
              for (int j = 0; j < 4; ++j) { LG[(4 * g + j) * 33 + l15] = acc0[j] + b0; LG[(4 * g + j) * 33 + 16 + l15] = acc1[j] + b1; } }
            const int rrow = lane >> 2, qq = lane & 3;
            float tv[4] = {-3.0e38f, -3.0e38f, -3.0e38f, -3.0e38f}; int ti[4] = {64, 65, 66, 67};
#define TOP_INS(xv_, xi_) do { float x_ = (xv_); int i_ = (xi_); _Pragma("unroll") for (int p_ = 0; p_ < 4; ++p_) { const bool b_ = x_ > tv[p_] || (x_ == tv[p_] && i_ < ti[p_]); \
                const float ov_ = tv[p_]; const int oi_ = ti[p_]; tv[p_] = b_ ? x_ : ov_; ti[p_] = b_ ? i_ : oi_; x_ = b_ ? ov_ : x_; i_ = b_ ? oi_ : i_; } } while (0)
#pragma unroll
            for (int j = 0; j < 8; ++j) TOP_INS(LG[rrow * 33 + 8 * qq + j], 8 * qq + j);
#pragma unroll
            for (int st = 1; st < 4; st <<= 1) { float pv[4]; int pi[4];
#pragma unroll
                for (int p = 0; p < 4; ++p) { pv[p] = __shfl_xor(tv[p], st); pi[p] = __shfl_xor(ti[p], st); }
#pragma unroll
                for (int p = 0; p < 4; ++p) TOP_INS(pv[p], pi[p]); }
#undef TOP_INS
            const float e1 = __expf(tv[1] - tv[0]), e2 = __expf(tv[2] - tv[0]), e3 = __expf(tv[3] - tv[0]);
            const float inv = rcp_f(1.0f + e1 + e2 + e3);
            me = qq == 0 ? ti[0] : qq == 1 ? ti[1] : qq == 2 ? ti[2] : ti[3];
            mg = (qq == 0 ? 1.0f : qq == 1 ? e1 : qq == 2 ? e2 : e3) * inv;
            lpos = (int)__hip_atomic_fetch_add(cntl + me, 1u, __ATOMIC_RELAXED, __HIP_MEMORY_SCOPE_WORKGROUP);
            ai = (m0 + rrow) * 4 + qq;
        }
        __syncthreads();
        if (tid < NE) { const unsigned c = cntl[tid]; cntl[32 + tid] = c ? atomicAdd(ecnt + 64 * tid, c) : 0u; }
        __syncthreads();
        if (active) { route_e[ai] = me; route_pos[ai] = (int)cntl[32 + me] + lpos; route_g[ai] = mg; }
        __syncthreads();
        }
        { LAS float* scr = (LAS float*)(lds + wave * 16384); constexpr int I_GU = 16 * 64;
          for (int r = gw; r < CONV_P9; r += NGW) { const int e = r / I_GU, q = r % I_GU, kb = q / 64, nb = q % 64; const int n0 = 32 * nb;
              const int drow = n0 < 1024 ? (256 * (n0 >> 7) + (n0 & 127)) : (256 * ((n0 - 1024) >> 7) + 128 + ((n0 - 1024) & 127));
              transpose_item_tiled_fp8(args.in[I_WGU] + (size_t)e * D * 2048, 2048, D, (unsigned char*)Wgu_t + (size_t)e * 2048 * D, 64 * kb, n0, drow, scr, lane); } }
    }
    SEAM(9);
    if (IN(10)) { PHASE_IDS;
        LAS int* pst = (LAS int*)lds;
        if (wave == 0) {
            const int c = lane < NE ? (int)__hip_atomic_load(ecnt + 64 * lane, __ATOMIC_RELAXED, __HIP_MEMORY_SCOPE_AGENT) : 0; const int pc = (c + 255) & ~255;
            int x = pc;
#pragma unroll
            for (int d = 1; d < 32; d <<= 1) { const int y = __shfl_up(x, d); if (lane >= d) x += y; }
            if (lane < NE) { pst[lane] = x - pc; pst[64 + lane] = c; } if (lane == NE - 1) pst[32] = x; }
        __syncthreads();
        for (int ai = bid * NTHREADS + tid; ai < NASSIGN; ai += G * NTHREADS) {
            const int e = route_e[ai]; const int row = pst[e] + route_pos[ai]; { u32x2 sg_; sg_.x = (unsigned)ai; sg_.y = __float_as_uint(route_g[ai]); row_sg[row] = sg_; } row_tok[row] = ai >> 2; }
        if (bid < NE) { const int e = bid, c = pst[64 + e], pe = (c + 255) & ~255; for (int p = c + tid; p < pe; p += NTHREADS) { u32x2 sg_; sg_.x = 0xffffffffu; sg_.y = 0u; row_sg[pst[e] + p] = sg_; row_tok[pst[e] + p] = 0; } }
        if (bid == 0 && tid == 0) tile_tab[0] = pst[32] >> 8;
        if (bid >= 128 && bid < 136) { const int nt = pst[32] >> 8, nN = bid < 132 ? 8 : 4; int* tab = (int*)(ws + WS_ROUTE + (bid < 132 ? RT_UGU : RT_UDN));
            for (int L = (bid & 3) * NTHREADS + tid; L < nt * nN; L += 4 * NTHREADS) { Unit uu; { const int nwg = nt * nN; int wgid = L; { const int q = nwg / 8, r = nwg % 8, xcd = wgid % 8, off = wgid / 8; wgid = (xcd < r ? xcd * (q + 1) : r * (q + 1) + (xcd - r) * q) + off; }
                    const int nig = 8 * nN, gid = wgid / nig, fm = gid * 8, gsz = (nt - fm) < 8 ? (nt - fm) : 8; uu.pm = fm + ((wgid % nig) % gsz); uu.pn = (wgid % nig) / gsz; uu.e = 0; }
                int e = 0;
#pragma unroll
                for (int st = 16; st >= 1; st >>= 1) { if ((pst[e + st] >> 8) <= uu.pm) e += st; }
                tab[L] = uu.pm | (uu.pn << 12) | (e << 16); } }
        __syncthreads();
    }
    SEAM(10);
    if (IN(11)) {
        const int ntiles = tile_tab[0];
        pg8::MoeGatherSched S; S.o.init_tiles(ntiles, 2048 / 256, G, bid); S.A = (const char*)HN; S.B = (const char*)Wgu_t; S.tile_e = tile_tab + 16; S.utab = (const int*)(ws + WS_ROUTE + RT_UGU); S.rtok = row_tok; S.tstep = (size_t)256 * 1024; S.estep = (size_t)2048 * 1024;
        EpiSwiglu E{ACT, args.in[I_BGU]}; pg8::gemm_phase<EpiSwiglu, pg8::MoeGatherSched, true, true>(lds, 512, S, E, wv0);
        if constexpr (CONV_P9D < NE * 16 * 32) { PHASE_IDS; LAS float* scr = (LAS float*)(lds + wave * 16384); constexpr int I_DN = 16 * 32;
          for (;;) { int c0 = 0; if (lane == 0) c0 = (int)atomicAdd(ctl + CW_CONV, 8u); c0 = __builtin_amdgcn_readfirstlane(c0);
              c0 += CONV_P9D; if (c0 >= NE * I_DN) break;
              for (int r = c0; r < c0 + 8; ++r) { const int e = r / I_DN, q = r % I_DN, kb = q / 32, nb = q % 32;
                  transpose_item_tiled_fp8(args.in[I_WDN] + (size_t)e * DFF * D, D, DFF, (unsigned char*)Wdn_t + (size_t)e * D * DFF, 64 * kb, 32 * nb, 32 * nb, scr, lane); } } }
    }
    SEAM(11);
    if (IN(12)) {
        const int ntiles = tile_tab[0];
        pg8::MoeSched S; S.o.init_tiles(ntiles, D / 256, G, bid); S.A = (const char*)ACT; S.B = (const char*)Wdn_t; S.tile_e = tile_tab + 16; S.utab = (const int*)(ws + WS_ROUTE + RT_UDN); S.tstep = (size_t)256 * 1024; S.estep = (size_t)1024 * 1024;
        EpiDown E{YS, args.in[I_BDN], row_sg}; pg8::gemm_phase<EpiDown, pg8::MoeSched, true, true>(lds, 512, S, E, wv0);
    }
    SEAM(12);
    if (IN(13)) { PHASE_IDS;
        const float* gfin = args.in[I_FNG];
        for (int m = gw; m < M; m += NGW) {
            float v[16]; float s = 0.f;
#pragma unroll
            for (int hf = 0; hf < 2; ++hf) { const u32x4 w = __builtin_nontemporal_load((const u32x4*)(X2 + (size_t)m * D + 512 * hf + 8 * lane));
#pragma unroll
                for (int q = 0; q < 4; ++q) { v[8 * hf + 2 * q] = bflo(w[q]); v[8 * hf + 2 * q + 1] = bfhi(w[q]); }
#pragma unroll
                for (int k = 0; k < 4; ++k) { const u32x2 y = __builtin_nontemporal_load((const u32x2*)((const unsigned char*)YS + (size_t)(m * 4 + k) * D + 512 * hf + 8 * lane));
#pragma unroll
                    for (int q = 0; q < 2; ++q) { const auto lo2 = __builtin_amdgcn_cvt_pk_f32_fp8((int)y[q], false), hi2 = __builtin_amdgcn_cvt_pk_f32_fp8((int)y[q], true);
                        v[8 * hf + 4 * q] += lo2[0] * 0.0625f; v[8 * hf + 4 * q + 1] += lo2[1] * 0.0625f; v[8 * hf + 4 * q + 2] += hi2[0] * 0.0625f; v[8 * hf + 4 * q + 3] += hi2[1] * 0.0625f; } } }
#pragma unroll
            for (int j = 0; j < 16; ++j) s += v[j] * v[j];
            const float rstd = rsq_f(wave_sum(s) * (1.f / D) + EPS);
#pragma unroll
            for (int hf = 0; hf < 2; ++hf) { const f32x4 g0 = *(const f32x4*)(gfin + 512 * hf + 8 * lane), g1 = *(const f32x4*)(gfin + 512 * hf + 8 * lane + 4);
                float* o = args.out + (size_t)m * D + 512 * hf + 8 * lane;
                __builtin_nontemporal_store((f32x4){v[8 * hf] * rstd * g0.x, v[8 * hf + 1] * rstd * g0.y, v[8 * hf + 2] * rstd * g0.z, v[8 * hf + 3] * rstd * g0.w}, (f32x4*)o);
                __builtin_nontemporal_store((f32x4){v[8 * hf + 4] * rstd * g1.x, v[8 * hf + 5] * rstd * g1.y, v[8 * hf + 6] * rstd * g1.z, v[8 * hf + 7] * rstd * g1.w}, (f32x4*)(o + 4)); }
        }
    }
#undef IN
#undef SEAM
}

constexpr int N_PHASES = 14;
extern "C" void kernel_launch(void* const* d_in, const int* in_sizes, int n_in, void* d_out, int out_size, void* d_ws, size_t ws_size, hipStream_t stream) {
    static int grid = 0;
    if (grid == 0) {
        if (n_in != 37 || out_size != M * D || ws_size < WS_END) { fprintf(stderr, "kernel_launch: unexpected shapes (n_in %d, out %d, ws %zu); nothing launched\n", n_in, out_size, ws_size); grid = -1; return; }
        int dev = 0, cus = 0, per_cu = 0;
        if (hipGetDevice(&dev) != hipSuccess || hipDeviceGetAttribute(&cus, hipDeviceAttributeMultiprocessorCount, dev) != hipSuccess) { grid = -1; return; }
        if (hipFuncSetAttribute((const void*)fwd, hipFuncAttributeMaxDynamicSharedMemorySize, LDS_BYTES) != hipSuccess) { fprintf(stderr, "kernel_launch: hipFuncSetAttribute failed\n"); grid = -1; return; }
        if (hipOccupancyMaxActiveBlocksPerMultiprocessor(&per_cu, (const void*)fwd, NTHREADS, LDS_BYTES) != hipSuccess || per_cu < 1) fprintf(stderr, "kernel_launch: occupancy query says %d\n", per_cu);
        (void)hipGetLastError();
        grid = cus > 256 ? 256 : cus;
    }
    if (grid < 0) return;
    if (hipMemsetAsync((char*)d_ws + WS_CTL, 0, CTL_ZERO_BYTES, stream) != hipSuccess) return;
    Args a{};
    for (int i = 0; i < 37; ++i) a.in[i] = (const float*)d_in[i];
    a.out = (float*)d_out; a.ws = (unsigned char*)d_ws;
#if MK_ONE_LAUNCH
    a.ph_lo = 0; a.ph_hi = N_PHASES;
    hipLaunchKernelGGL(fwd, dim3(grid), dim3(NTHREADS), LDS_BYTES, stream, a);
#else
    for (int p = 0; p < N_PHASES; ++p) { a.ph_lo = p; a.ph_hi = p + 1; hipLaunchKernelGGL(fwd, dim3(grid), dim3(NTHREADS), LDS_BYTES, stream, a);
#ifdef PROBE_REPEAT_PHASE
        if (p == PROBE_REPEAT_PHASE) hipLaunchKernelGGL(fwd, dim3(grid), dim3(NTHREADS), LDS_BYTES, stream, a);
#endif
    }
#endif
}
```

```cpp
#include <hip/hip_runtime.h>
#include <cstdio>
#include <cstdint>

#ifndef MK_ONE_LAUNCH
#define MK_ONE_LAUNCH 1
#endif

#define DI __device__ __forceinline__
#define GAS __attribute__((address_space(1)))
#define LAS __attribute__((address_space(3)))
typedef unsigned short bf16;
typedef short bf16x8 __attribute__((ext_vector_type(8)));
typedef int v4i __attribute__((ext_vector_type(4)));
typedef int v8i __attribute__((ext_vector_type(8)));
typedef float f32x4 __attribute__((ext_vector_type(4)));
typedef float f32x2 __attribute__((ext_vector_type(2)));
typedef unsigned u32x4 __attribute__((ext_vector_type(4)));
typedef unsigned u32x2 __attribute__((ext_vector_type(2)));

constexpr int D = 1024, NB = 4, SEQ = 4096, M = NB * SEQ;
constexpr int MEML = 256, MROWS = NB * MEML;
constexpr int LRU_W = 512, RW = 512, NH = 8, HD = 64;
constexpr int INW = 2816;
constexpr int XH = 4, XHD = 256;
constexpr int NE = 32, TOPK = 4, DFF = 1024;
constexpr int NASSIGN = M * TOPK;
constexpr int MAXTILES = 288, MAXROWS = MAXTILES * 256;
constexpr float EPS = 1e-6f, GN_EPS = 64e-5f;

DI int fresh_tid_(int wv) { int w = wv; asm volatile("" : "+s"(w)); int l; asm volatile("v_mbcnt_lo_u32_b32 %0, -1, 0\n\tv_mbcnt_hi_u32_b32 %0, -1, %0" : "=v"(l)); return (w << 6) | (l & 63); }
#define fresh_tid() fresh_tid_(wv0)
namespace pg8 {
constexpr int BM = 256, BK = 64, HALF = 128, HTB = HALF * BK * 2, STAGE_BYTES = 8 * HTB, NXCD = 8, WGM = 8;
__host__ __device__ __forceinline__ int lds_byte(int r, int c) { const int st = (r >> 4) * 2 + (c >> 5), rr = r & 15, cc = c & 31, ob = rr * 64 + cc * 2; return st * 1024 + (ob ^ (((ob >> 9) & 1) << 5)); }
__host__ __device__ __forceinline__ void stage_rc(int b, int& R, int& C) { const int st = b / 1024, sb = b % 1024, swz = sb ^ (((sb >> 9) & 1) << 5); R = (st >> 1) * 16 + swz / 64; C = (st & 1) * 32 + (swz % 64) / 2; }
__host__ __device__ __forceinline__ int perm32(int rho) { const int n = rho >> 4, i = rho & 15; return 8 * (i >> 2) + 4 * n + (i & 3); }

struct Unit { int pm, pn, e; };

struct StaticOrder {
    int nM, nN, nwg, G, c;
    __host__ __device__ void init_tiles(int nM_, int nN_, int G_, int c_) { nM = nM_; nN = nN_; nwg = nM * nN; G = G_; c = c_; }
    __host__ __device__ bool next(int i, Unit& u) const {
        const long L = (long)i * G + c; if (L >= nwg) return false;
        int wgid = (int)L; { const int q = nwg / NXCD, r = nwg % NXCD, xcd = wgid % NXCD, off = wgid / NXCD; wgid = (xcd < r ? xcd * (q + 1) : r * (q + 1) + (xcd - r) * q) + off; }
        const int nig = WGM * nN, gid = wgid / nig, fm = gid * WGM, gsz = (nM - fm) < WGM ? (nM - fm) : WGM;
        u.pm = fm + ((wgid % nig) % gsz); u.pn = (wgid % nig) / gsz; u.e = 0; return true;
    }
};
struct DenseSched {
    static constexpr bool GATHER = false, B_TILED = false;
    StaticOrder o; const char* A; const char* B; size_t tstep;
    DI bool next(int i, Unit& u) const { return o.next(i, u); }
    DI const char* a_ptr(const Unit& u) const { return A + (size_t)u.pm * tstep; }
    DI const char* b_ptr(const Unit& u) const { return B + (size_t)u.pn * tstep; }
    DI void a_voff(const Unit&, int K, const int (&R)[2], const int (&C)[2], unsigned (&vo)[2][2]) const {
#pragma unroll
        for (int h = 0; h < 2; ++h)
#pragma unroll
            for (int i = 0; i < 2; ++i) vo[h][i] = (unsigned)((h * HALF + R[i]) * K + C[i]) * 2u; }
};
struct MoeSched {
    static constexpr bool GATHER = false, B_TILED = true;
    StaticOrder o; const char* A; const char* B; const int* tile_e; const int* utab; size_t tstep, estep;
    DI bool next(int i, Unit& u) const { const int L = i * o.G + o.c; if (L >= o.nwg) return false; int en; asm volatile("s_load_dword %0, %1, 0x0\n\ts_waitcnt lgkmcnt(0)" : "=s"(en) : "s"(utab + L) : "memory");     u.pm = en & 0xfff; u.pn = (en >> 12) & 15; u.e = en >> 16; return true; }
    DI const char* a_ptr(const Unit& u) const { return A + (size_t)u.pm * tstep; }
    DI const char* b_ptr(const Unit& u) const { return B + (size_t)u.e * estep + (size_t)u.pn * tstep; }
    DI void a_voff(const Unit&, int K, const int (&R)[2], const int (&C)[2], unsigned (&vo)[2][2]) const {
#pragma unroll
        for (int h = 0; h < 2; ++h)
#pragma unroll
            for (int i = 0; i < 2; ++i) vo[h][i] = (unsigned)((h * HALF + R[i]) * K + C[i]) * 2u; }
};
struct MoeGatherSched {
    static constexpr bool GATHER = true, B_TILED = true;
    StaticOrder o; const char* A; const char* B; const int* tile_e; const int* utab; const int* rtok; size_t tstep, estep;
    DI bool next(int i, Unit& u) const { const int L = i * o.G + o.c; if (L >= o.nwg) return false; int en; asm volatile("s_load_dword %0, %1, 0x0\n\ts_waitcnt lgkmcnt(0)" : "=s"(en) : "s"(utab + L) : "memory");     u.pm = en & 0xfff; u.pn = (en >> 12) & 15; u.e = en >> 16; return true; }
    DI const char* a_ptr(const Unit&) const { return A; }
    DI const char* b_ptr(const Unit& u) const { return B + (size_t)u.e * estep + (size_t)u.pn * tstep; }
    DI void a_voff(const Unit& u, int K, const int (&R)[2], const int (&C)[2], unsigned (&vo)[2][2]) const {
#pragma unroll
        for (int h = 0; h < 2; ++h)
#pragma unroll
            for (int i = 0; i < 2; ++i) vo[h][i] = (unsigned)(rtok[u.pm * BM + h * HALF + R[i]] * K + C[i]) * 2u; }
};

struct BatchBSched {
    static constexpr bool GATHER = false, B_TILED = false;
    StaticOrder o; const char* A; const char* B; size_t tstep, bstep;
    DI bool next(int i, Unit& u) const { return o.next(i, u); }
    DI const char* a_ptr(const Unit& u) const { return A + (size_t)u.pm * tstep; }
    DI const char* b_ptr(const Unit& u) const { return B + (size_t)(u.pm >> 4) * bstep + (size_t)u.pn * tstep; }
    DI void a_voff(const Unit&, int K, const int (&R)[2], const int (&C)[2], unsigned (&vo)[2][2]) const {
#pragma unroll
        for (int h = 0; h < 2; ++h)
#pragma unroll
            for (int i = 0; i < 2; ++i) vo[h][i] = (unsigned)((h * HALF + R[i]) * K + C[i]) * 2u; }
};
template <int MODE> struct FoldSched {
    static constexpr bool GATHER = false, B_TILED = false;
    const char* A; const char* B; int G, c;
    DI bool next(int i, Unit& u) const { const int L = i * G + c; if (L >= 64) return false; u.pm = L >> 2; u.pn = L & 3; u.e = 0; return true; }
    DI const char* a_ptr(const Unit& u) const { const int b = u.pm >> 2, h = u.pm & 3; return A + ((size_t)(MODE == 0 ? b * 256 : u.pn * 256) * 1024 + h * 256) * 2; }
    DI const char* b_ptr(const Unit& u) const { const int b = u.pm >> 2, h = u.pm & 3; return B + ((size_t)(MODE == 0 ? u.pn * 256 : b * 256) * 1024 + h * 256) * 2; }
    DI void a_voff(const Unit&, int K, const int (&R)[2], const int (&C)[2], unsigned (&vo)[2][2]) const {
#pragma unroll
        for (int h = 0; h < 2; ++h)
#pragma unroll
            for (int i = 0; i < 2; ++i) vo[h][i] = (unsigned)((h * HALF + R[i]) * K + C[i]) * 2u; }
};

DI unsigned cvt_pk_bf16(float lo, float hi) { unsigned r; asm volatile("v_cvt_pk_bf16_f32 %0, %1, %2" : "=v"(r) : "v"(lo), "v"(hi)); return r; }

template <class Epi, class Sched, bool ALIGN_EPI = true, bool FP8 = false>
DI void gemm_phase(LAS unsigned char* lds, const int K, const Sched& S, const Epi& E, const int wv0, const int ldp = 0) {
    const int ld = ldp ? ldp : K;
    const int tid = fresh_tid(), wid = __builtin_amdgcn_readfirstlane(tid >> 6), lane = tid & 63, wr = wid >> 2, wc = wid & 3, fr = lane & 15, fq = lane >> 4;
    const int nt = K / BK;
    constexpr bool GA = Sched::GATHER, BT = Sched::B_TILED;
    unsigned voffA[2][2], voffAn[2][2], voffB[2];
#pragma unroll
    for (int i = 0; i < 2; ++i) { int R, C; stage_rc(tid * 16 + i * 8192, R, C); const int Rb = Epi::PERM ? ((R & ~31) + perm32(R & 31)) : R;
        voffB[i] = BT ? (unsigned)(tid * 16 + i * 8192) : (unsigned)(Rb * ld + C) * 2u; }
#define PG8_AVOFF(unit, dst) do { int sR[2], sC[2]; const int t2_ = fresh_tid(); stage_rc(t2_ * 16, sR[0], sC[0]); stage_rc(t2_ * 16 + 8192, sR[1], sC[1]); S.a_voff(unit, ld, sR, sC, dst); } while (0)
    const size_t kstep = (size_t)(BK * 2);
    const size_t hstep = (size_t)HALF * ld * 2;
    const size_t kstepB = BT ? (size_t)(2 * HTB) : kstep, hstepB = BT ? (size_t)HTB : hstep;
    const unsigned ldsw = (unsigned)wid * 1024u;
    unsigned aoffv = (unsigned)(size_t)lds + (unsigned)lds_byte(wr * 64 + fr, fq * 8), boffv = (unsigned)(size_t)lds + (unsigned)(4 * HTB) + (unsigned)lds_byte(wc * 32 + fr, fq * 8);
    asm volatile("" : "+v"(aoffv), "+v"(boffv));
    const size_t dB = BT ? (size_t)8192 : (size_t)64 * ld * 2, dA = (size_t)64 * ld * 2;
#define PG8_SA(b, h) (((b) * 2 + (h)) * HTB)
#define PG8_SB(b, h) ((4 + (b) * 2 + (h)) * HTB)
    const unsigned ldsbase = (unsigned)__builtin_amdgcn_readfirstlane((int)((unsigned)(size_t)lds + ldsw));
#define PG8_STAGE1(bufoff, gptr, vo, i_) do { const unsigned m0v_ = ldsbase + (unsigned)(bufoff) + (unsigned)(i_) * 8192u; \
        asm volatile("s_mov_b32 m0, %2\n\ts_nop 0\n\tglobal_load_lds_dwordx4 %0, %1" :: "v"(vo), "s"((const char*)(gptr)), "s"(m0v_) : "memory", "m0"); } while (0)
#define PG8_STAGE(bufoff, gbase, voff) do { PG8_STAGE1(bufoff, gbase, (voff)[0], 0); PG8_STAGE1(bufoff, gbase, (voff)[1], 1); } while (0)
#define PG8_STAGE_D(bufoff, gbase, vo, delta) do { PG8_STAGE1(bufoff, gbase, vo, 0); PG8_STAGE1(bufoff, (const char*)(gbase) + (delta), vo, 1); } while (0)
#define PG8_LDA(dst, b, h) do { if constexpr (FP8) { _Pragma("unroll") for (int m = 0; m < 4; ++m) { const LAS v4i* p_ = (const LAS v4i*)((LAS unsigned char*)(size_t)aoffv + PG8_SA(b, h) + m * 2048); dst##8[m] = __builtin_shufflevector(p_[0], p_[64], 0, 1, 2, 3, 4, 5, 6, 7); } } \
        else { _Pragma("unroll") for (int m = 0; m < 4; ++m) _Pragma("unroll") for (int k = 0; k < 2; ++k) dst[m][k] = *(const LAS bf16x8*)((LAS unsigned char*)(size_t)aoffv + PG8_SA(b, h) + m * 2048 + k * 1024); } } while (0)
#define PG8_LDB(dst, b, h) do { if constexpr (FP8) { _Pragma("unroll") for (int n = 0; n < 2; ++n) { const LAS v4i* p_ = (const LAS v4i*)((LAS unsigned char*)(size_t)boffv + (PG8_SB(b, h) - 4 * HTB) + n * 2048); dst##8[n] = __builtin_shufflevector(p_[0], p_[64], 0, 1, 2, 3, 4, 5, 6, 7); } } \
        else { _Pragma("unroll") for (int n = 0; n < 2; ++n) _Pragma("unroll") for (int k = 0; k < 2; ++k) dst[n][k] = *(const LAS bf16x8*)((LAS unsigned char*)(size_t)boffv + (PG8_SB(b, h) - 4 * HTB) + n * 2048 + k * 1024); } } while (0)
#define PG8_MMA(ai, bj, At, Bt) do { __builtin_amdgcn_s_setprio(1); \
        if constexpr (FP8) {   \
            _Pragma("unroll") for (int m = 0; m < 4; ++m) _Pragma("unroll") for (int n = 0; n < 2; ++n) \
                acc[ai][bj][m][n] = __builtin_amdgcn_mfma_scale_f32_16x16x128_f8f6f4(Bt##8[n], At##8[m], acc[ai][bj][m][n], 0, 0, 0, 0, 0, 0); } \
        else { _Pragma("unroll") for (int m = 0; m < 4; ++m) _Pragma("unroll") for (int n = 0; n < 2; ++n) _Pragma("unroll") for (int k = 0; k < 2; ++k) \
            acc[ai][bj][m][n] = __builtin_amdgcn_mfma_f32_16x16x32_bf16(Bt[n][k], At[m][k], acc[ai][bj][m][n], 0, 0, 0); } \
        __builtin_amdgcn_s_setprio(0); } while (0)
#define PG8_WAIT_V(n) asm volatile("s_waitcnt vmcnt(" #n ")" ::: "memory")
#define PG8_WAIT_L(n) asm volatile("s_waitcnt lgkmcnt(" #n ")" ::: "memory")
#define PG8_BAR __builtin_amdgcn_s_barrier()
#define PG8_SCHED __builtin_amdgcn_sched_barrier(0)
    Unit cur, nxt; int ui = 0;
    if (!S.next(0, cur)) return;
    f32x4 acc[2][2][4][2];
#pragma unroll
    for (int a = 0; a < 2; ++a)
#pragma unroll
        for (int b = 0; b < 2; ++b)
#pragma unroll
            for (int m = 0; m < 4; ++m)
#pragma unroll
                for (int n = 0; n < 2; ++n) acc[a][b][m][n] = (f32x4){0.f, 0.f, 0.f, 0.f};
    bf16x8 At[4][2], B0[2][2], B1[2][2]; v8i At8[4], B08[2], B18[2];
    const char* cA = S.a_ptr(cur); const char* cB = S.b_ptr(cur);
    PG8_AVOFF(cur, voffA);
#define PG8_STAGE_A(bufoff, kbase, h, vo) do { if constexpr (GA) { PG8_STAGE(bufoff, kbase, (vo)[h]); } else { PG8_STAGE_D(bufoff, (kbase) + (h) * hstep, voffA[0][0], dA); } } while (0)
    PG8_STAGE_D(PG8_SB(0, 0), cB, voffB[0], dB); PG8_STAGE_D(PG8_SB(0, 1), cB + hstepB, voffB[0], dB); PG8_STAGE_A(PG8_SA(0, 0), cA, 0, voffA); PG8_STAGE_A(PG8_SA(0, 1), cA, 1, voffA);
    if (wr == 1) PG8_BAR;
    PG8_WAIT_V(2); PG8_BAR;
    PG8_STAGE_D(PG8_SB(1, 0), cB + kstepB, voffB[0], dB); PG8_STAGE_A(PG8_SA(1, 0), cA + kstep, 0, voffA); PG8_STAGE_D(PG8_SB(1, 1), cB + hstepB + kstepB, voffB[0], dB);
    PG8_WAIT_V(6); PG8_BAR;
    for (;;) {
        const bool has_next = S.next(ui + 1, nxt);
        const char* nA = has_next ? S.a_ptr(nxt) : cA; const char* nB = has_next ? S.b_ptr(nxt) : cB;
        if constexpr (GA) { if (has_next) PG8_AVOFF(nxt, voffAn);
            else {
#pragma unroll
                for (int h = 0; h < 2; ++h)
#pragma unroll
                    for (int i = 0; i < 2; ++i) voffAn[h][i] = voffA[h][i]; } }
#pragma unroll 1
        for (int t = 0; t < nt; t += 2) {
            const bool last = (t == nt - 2);
            const char* a1 = cA + (size_t)(t + 1) * kstep;
            const char* a2 = last ? nA : cA + (size_t)(t + 2) * kstep; const char* b2 = last ? nB : cB + (size_t)(t + 2) * kstepB;
            const char* a3 = a2 + kstep; const char* b3 = b2 + kstepB;
            PG8_LDB(B0, 0, 0); PG8_LDB(B1, 0, 1); PG8_SCHED; PG8_LDA(At, 0, 0); PG8_STAGE_A(PG8_SA(1, 1), a1, 1, voffA);
            if constexpr (GA) { if (last) {
#pragma unroll
                for (int h = 0; h < 2; ++h)
#pragma unroll
                    for (int i = 0; i < 2; ++i) voffA[h][i] = voffAn[h][i]; } }
            PG8_WAIT_V(8); PG8_WAIT_L(0); PG8_BAR; PG8_MMA(0, 0, At, B0); PG8_MMA(0, 1, At, B1); PG8_BAR; PG8_SCHED;
            PG8_LDA(At, 0, 1); PG8_STAGE_D(PG8_SB(0, 0), b2, voffB[0], dB); PG8_STAGE_D(PG8_SB(0, 1), b2 + hstepB, voffB[0], dB); PG8_STAGE_A(PG8_SA(0, 0), a2, 0, voffA);
            PG8_WAIT_V(8); PG8_WAIT_L(0); PG8_BAR; PG8_MMA(1, 0, At, B0); PG8_MMA(1, 1, At, B1); PG8_BAR; PG8_SCHED;
            PG8_LDB(B0, 1, 0); PG8_LDB(B1, 1, 1); PG8_SCHED; PG8_LDA(At, 1, 0); PG8_STAGE_A(PG8_SA(0, 1), a2, 1, voffA);
            PG8_WAIT_V(8); PG8_WAIT_L(0); PG8_BAR; PG8_MMA(0, 0, At, B0); PG8_MMA(0, 1, At, B1); PG8_BAR; PG8_SCHED;
            PG8_LDA(At, 1, 1); PG8_STAGE_D(PG8_SB(1, 0), b3, voffB[0], dB); PG8_STAGE_D(PG8_SB(1, 1), b3 + hstepB, voffB[0], dB); PG8_STAGE_A(PG8_SA(1, 0), a3, 0, voffA);
            PG8_WAIT_V(8); PG8_WAIT_L(0); PG8_BAR; PG8_MMA(1, 0, At, B0); PG8_MMA(1, 1, At, B1); PG8_BAR; PG8_SCHED;
        }
        if constexpr (ALIGN_EPI) { if (wr == 0) PG8_BAR; }
        { Unit ue = cur; ue.pm = __builtin_amdgcn_readfirstlane(ue.pm); ue.pn = __builtin_amdgcn_readfirstlane(ue.pn); ue.e = __builtin_amdgcn_readfirstlane(ue.e); asm volatile("" : "+s"(ue.pm), "+s"(ue.pn), "+s"(ue.e));
          const int t3_ = fresh_tid(); const int fr_ = t3_ & 15, fq_ = (t3_ & 63) >> 4;
          E(acc, ue, wr, wc, fr_, fq_); }
        if (!has_next) break;
#pragma unroll
        for (int a = 0; a < 2; ++a)
#pragma unroll
            for (int b = 0; b < 2; ++b)
#pragma unroll
                for (int m = 0; m < 4; ++m)
#pragma unroll
                    for (int n = 0; n < 2; ++n) acc[a][b][m][n] = (f32x4){0.f, 0.f, 0.f, 0.f};
        cur = nxt; cA = nA; cB = nB; ++ui;
        if constexpr (ALIGN_EPI) { if (wr == 1) PG8_BAR; }
    }
    PG8_WAIT_V(0);
    if constexpr (!ALIGN_EPI) { if (wr == 0) PG8_BAR; }
    PG8_BAR;
#undef PG8_SA
#undef PG8_SB
#undef PG8_STAGE
#undef PG8_STAGE1
#undef PG8_STAGE_D
#undef PG8_STAGE_A
#undef PG8_AVOFF
#undef PG8_LDA
#undef PG8_LDB
#undef PG8_MMA
#undef PG8_WAIT_V
#undef PG8_WAIT_L
#undef PG8_BAR
#undef PG8_SCHED
}
}
using pg8::Unit;
using pg8::cvt_pk_bf16;

DI float bflo(unsigned w) { return __uint_as_float(w << 16); }
DI float bfhi(unsigned w) { return __uint_as_float(w & 0xffff0000u); }
DI float bf2f(bf16 b) { return __uint_as_float(((unsigned)b) << 16); }
typedef __bf16 hwbf2 __attribute__((ext_vector_type(2)));
DI unsigned pk2(float lo, float hi) { const f32x2 v = {lo, hi}; return __builtin_bit_cast(unsigned, __builtin_convertvector(v, hwbf2)); }
DI unsigned f2bf(float f) { return pk2(f, 0.f) & 0xffffu; }
DI float rcp_f(float x) { return __builtin_amdgcn_rcpf(x); }
DI float rsq_f(float x) { return __builtin_amdgcn_rsqf(x); }
DI float sigmoid_f(float x) { return rcp_f(1.0f + __expf(-x)); }
DI float tanh_fast(float x) { return 1.0f - 2.0f * rcp_f(__expf(2.0f * x) + 1.0f); }
DI float softplus_f(float x) { return fmaxf(x, 0.f) + __logf(1.0f + __expf(-fabsf(x))); }
DI float softplus_fast(float x) { return fmaxf(x, 0.f) + __logf(1.0f + __expf(-fabsf(x))); }
DI float gelu_tanh_f(float x) { const float u = 0.7978845608028654f * (x + 0.044715f * x * x * x); return 0.5f * x * (1.0f + tanh_fast(u)); }
DI float wave_sum(float v) {
#pragma unroll
    for (int o = 1; o < 64; o <<= 1) v += __shfl_xor(v, o);
    return v;
}

DI unsigned pk4_fp8(float a, float b, float c, float d) { int w = 0; w = __builtin_amdgcn_cvt_pk_fp8_f32(a, b, w, false); w = __builtin_amdgcn_cvt_pk_fp8_f32(c, d, w, true); return (unsigned)w; }
struct EpiBf16Plain {
    static constexpr bool PERM = true;
    bf16* O; int ldc; float scale;
    DI void operator()(const f32x4 (&acc)[2][2][4][2], const Unit& u, int wr, int wc, int fr, int fq) const {
        const int row0 = u.pm * 256 + wr * 64 + fr, col0 = u.pn * 256 + wc * 32 + 8 * fq;
#pragma unroll
        for (int ai = 0; ai < 2; ++ai)
#pragma unroll
            for (int m = 0; m < 4; ++m) { bf16* rowp = O + (size_t)(row0 + ai * 128 + m * 16) * ldc + col0;
#pragma unroll
                for (int bj = 0; bj < 2; ++bj) { const f32x4 v0 = acc[ai][bj][m][0] * scale, v1 = acc[ai][bj][m][1] * scale;
                    u32x4 w; w.x = cvt_pk_bf16(v0[0], v0[1]); w.y = cvt_pk_bf16(v0[2], v0[3]); w.z = cvt_pk_bf16(v1[0], v1[1]); w.w = cvt_pk_bf16(v1[2], v1[3]);
                    *(u32x4*)(rowp + bj * 128) = w; } }
    }
};
template <int MODE> struct EpiFold {
    static constexpr bool PERM = true;
    unsigned char* O;
    DI void operator()(const f32x4 (&acc)[2][2][4][2], const Unit& u, int wr, int wc, int fr, int fq) const {
        const int b = u.pm >> 2, h = u.pm & 3;
        const int rbase = MODE == 0 ? h * 256 : u.pn * 256, cbase = MODE == 0 ? u.pn * 256 : h * 256;
        const unsigned boff = (unsigned)b * 1024u * 1024u + (unsigned)(rbase + wr * 64 + fr) * 1024u + (unsigned)(cbase + wc * 32 + 8 * fq);
#pragma unroll
        for (int ai = 0; ai < 2; ++ai)
#pragma unroll
            for (int m = 0; m < 4; ++m) { unsigned char* rowp = O + (boff + (unsigned)(ai * 128 + m * 16) * 1024u);
#pragma unroll
                for (int bj = 0; bj < 2; ++bj) { const f32x4 v0 = acc[ai][bj][m][0] * 4.0f, v1 = acc[ai][bj][m][1] * 4.0f;
                    u32x2 w; w.x = pk4_fp8(v0[0], v0[1], v0[2], v0[3]); w.y = pk4_fp8(v1[0], v1[1], v1[2], v1[3]);
                    *(u32x2*)(rowp + bj * 128) = w; } }
    }
};
struct EpiSoftmax {
    static constexpr bool PERM = true;
    unsigned char* O; float scale; const float* RS; LAS float* XM; LAS float* XS;
    DI void operator()(const f32x4 (&acc)[2][2][4][2], const Unit& u, int wr, int wc, int fr, int fq) const {
        const int row0 = u.pm * 256 + wr * 64 + fr, col0 = u.pn * 256 + wc * 32 + 8 * fq;
        float sc[2][4];
#pragma unroll
        for (int ai = 0; ai < 2; ++ai)
#pragma unroll
            for (int m = 0; m < 4; ++m) { const int r = row0 + ai * 128 + m * 16; const f32x4* rp = (const f32x4*)(RS + (size_t)r * 16);
                const f32x4 p0 = rp[0], p1 = rp[1], p2 = rp[2], p3 = rp[3];
                const float ss = ((p0[0] + p0[1]) + (p0[2] + p0[3])) + ((p1[0] + p1[1]) + (p1[2] + p1[3])) + ((p2[0] + p2[1]) + (p2[2] + p2[3])) + ((p3[0] + p3[1]) + (p3[2] + p3[3]));
                sc[ai][m] = scale * __builtin_amdgcn_rsqf(ss * (1.0f / 1024.0f) + 1e-6f);
                float mm = -3.0e38f;
#pragma unroll
                for (int bj = 0; bj < 2; ++bj)
#pragma unroll
                    for (int n = 0; n < 2; ++n) { const f32x4 v = acc[ai][bj][m][n]; mm = fmaxf(mm, fmaxf(fmaxf(v[0], v[1]), fmaxf(v[2], v[3]))); }
                mm *= sc[ai][m];
                mm = fmaxf(mm, __shfl_xor(mm, 16)); mm = fmaxf(mm, __shfl_xor(mm, 32));
                if (fq == 0) XM[(ai * 128 + wr * 64 + m * 16 + fr) * 4 + wc] = mm; }
        asm volatile("s_waitcnt lgkmcnt(0)" ::: "memory"); __builtin_amdgcn_s_barrier(); asm volatile("" ::: "memory");
        f32x4 (&pa)[2][2][4][2] = const_cast<f32x4 (&)[2][2][4][2]>(acc);
#pragma unroll
        for (int ai = 0; ai < 2; ++ai)
#pragma unroll
            for (int m = 0; m < 4; ++m) { const int lr = ai * 128 + wr * 64 + m * 16 + fr; const f32x4 q = *(const LAS f32x4*)(XM + lr * 4);
                const float mxr = fmaxf(fmaxf(q[0], q[1]), fmaxf(q[2], q[3])); float sm = 0.f;
#pragma unroll
                for (int bj = 0; bj < 2; ++bj)
#pragma unroll
                    for (int n = 0; n < 2; ++n)
#pragma unroll
                        for (int j = 0; j < 4; ++j) { const float p = __expf(acc[ai][bj][m][n][j] * sc[ai][m] - mxr); pa[ai][bj][m][n][j] = p; sm += p; }
                sm += __shfl_xor(sm, 16); sm += __shfl_xor(sm, 32);
                if (fq == 0) XS[lr * 4 + wc] = sm; }
        asm volatile("s_waitcnt lgkmcnt(0)" ::: "memory"); __builtin_amdgcn_s_barrier(); asm volatile("" ::: "memory");
#pragma unroll
        for (int ai = 0; ai < 2; ++ai)
#pragma unroll
            for (int m = 0; m < 4; ++m) { const int lr = ai * 128 + wr * 64 + m * 16 + fr; const f32x4 q = *(const LAS f32x4*)(XS + lr * 4);
                const float inv = 256.0f * __builtin_amdgcn_rcpf((q[0] + q[1]) + (q[2] + q[3]));
                unsigned char* rowp = O + (size_t)(row0 + ai * 128 + m * 16) * 1024 + col0;
#pragma unroll
                for (int bj = 0; bj < 2; ++bj) { const f32x4 v0 = pa[ai][bj][m][0] * inv, v1 = pa[ai][bj][m][1] * inv;
                    u32x2 w; w.x = pk4_fp8(v0[0], v0[1], v0[2], v0[3]); w.y = pk4_fp8(v1[0], v1[1], v1[2], v1[3]);
                    *(u32x2*)(rowp + bj * 128) = w; } }
        asm volatile("s_waitcnt lgkmcnt(0)" ::: "memory"); __builtin_amdgcn_s_barrier(); asm volatile("" ::: "memory");
    }
};
struct EpiBf16RowNorm {
    static constexpr bool PERM = true;
    bf16* O; int ldc; float scale; const float* RS;
    DI void operator()(const f32x4 (&acc)[2][2][4][2], const Unit& u, int wr, int wc, int fr, int fq) const {
        const int row0 = u.pm * 256 + wr * 64 + fr, col0 = u.pn * 256 + wc * 32 + 8 * fq;
#pragma unroll
        for (int ai = 0; ai < 2; ++ai)
#pragma unroll
            for (int m = 0; m < 4; ++m) { const int r = row0 + ai * 128 + m * 16; const f32x4* rp = (const f32x4*)(RS + (size_t)r * 16);
                const f32x4 p0 = rp[0], p1 = rp[1], p2 = rp[2], p3 = rp[3];
                const float ss = ((p0[0] + p0[1]) + (p0[2] + p0[3])) + ((p1[0] + p1[1]) + (p1[2] + p1[3])) + ((p2[0] + p2[1]) + (p2[2] + p2[3])) + ((p3[0] + p3[1]) + (p3[2] + p3[3]));
                const float sc = scale * __builtin_amdgcn_rsqf(ss * (1.0f / 1024.0f) + 1e-6f);
                bf16* rowp = O + (size_t)r * ldc + col0;
#pragma unroll
                for (int bj = 0; bj < 2; ++bj) { const f32x4 v0 = acc[ai][bj][m][0] * sc, v1 = acc[ai][bj][m][1] * sc;
                    u32x4 w; w.x = cvt_pk_bf16(v0[0], v0[1]); w.y = cvt_pk_bf16(v0[2], v0[3]); w.z = cvt_pk_bf16(v1[0], v1[1]); w.w = cvt_pk_bf16(v1[2], v1[3]);
                    *(u32x4*)(rowp + bj * 128) = w; } }
    }
};
template <bool RES_BF16> struct EpiBf16Res {
    static constexpr bool PERM = true;
    const void* Rz; bf16* O; int ldc; float* RS; float ascale; unsigned char* O8;
    DI void operator()(const f32x4 (&acc)[2][2][4][2], const Unit& u, int wr, int wc, int fr, int fq) const {
        const int row0 = u.pm * 256 + wr * 64 + fr, col0 = u.pn * 256 + wc * 32 + 8 * fq;
#pragma unroll
        for (int ai = 0; ai < 2; ++ai) {
            u32x4 rwb[4][2]; f32x4 rf0[4][2], rf1[4][2];
#pragma unroll
            for (int m = 0; m < 4; ++m) { const size_t off = (size_t)(row0 + ai * 128 + m * 16) * ldc + col0;
#pragma unroll
                for (int bj = 0; bj < 2; ++bj) {
                    if (RES_BF16) rwb[m][bj] = __builtin_nontemporal_load((const u32x4*)((const bf16*)Rz + off + bj * 128));
                    else { rf0[m][bj] = __builtin_nontemporal_load((const f32x4*)((const float*)Rz + off + bj * 128)); rf1[m][bj] = __builtin_nontemporal_load((const f32x4*)((const float*)Rz + off + bj * 128 + 4)); } } }
#pragma unroll
            for (int m = 0; m < 4; ++m) { const size_t off = (size_t)(row0 + ai * 128 + m * 16) * ldc + col0; float ssq = 0.f;
#pragma unroll
                for (int bj = 0; bj < 2; ++bj) { f32x4 r0, r1;
                    if (RES_BF16) { const u32x4 rw = rwb[m][bj]; r0 = (f32x4){bflo(rw.x), bfhi(rw.x), bflo(rw.y), bfhi(rw.y)}; r1 = (f32x4){bflo(rw.z), bfhi(rw.z), bflo(rw.w), bfhi(rw.w)}; }
                    else { r0 = rf0[m][bj]; r1 = rf1[m][bj]; }
                    const f32x4 v0 = r0 + acc[ai][bj][m][0] * ascale, v1 = r1 + acc[ai][bj][m][1] * ascale;
                    if (O8) { u32x2 w8; w8.x = pk4_fp8(v0[0], v0[1], v0[2], v0[3]); w8.y = pk4_fp8(v1[0], v1[1], v1[2], v1[3]); *(u32x2*)(O8 + off + bj * 128) = w8; }
                    ssq += (v0[0] * v0[0] + v0[1] * v0[1]) + (v0[2] * v0[2] + v0[3] * v0[3]) + (v1[0] * v1[0] + v1[1] * v1[1]) + (v1[2] * v1[2] + v1[3] * v1[3]);
                    u32x4 w; w.x = cvt_pk_bf16(v0[0], v0[1]); w.y = cvt_pk_bf16(v0[2], v0[3]); w.z = cvt_pk_bf16(v1[0], v1[1]); w.w = cvt_pk_bf16(v1[2], v1[3]);
                    *(u32x4*)(O + off + bj * 128) = w; }
                if (RS) { ssq += __shfl_xor(ssq, 16); ssq += __shfl_xor(ssq, 32); if (fq == 0) RS[(size_t)(row0 + ai * 128 + m * 16) * 16 + u.pn * 4 + wc] = ssq; } } }
    }
};
struct EpiLora {
    static constexpr bool PERM = false;
    float* LWp; bf16* AAp; bf16* GGp; const float* w0; const float* a0;
    DI void operator()(const f32x4 (&acc)[2][2][4][2], const Unit& u, int wr, int wc, int fr, int fq) const {
        const int kind = u.pn >> 1;
        const int row0 = u.pm * 256 + wr * 64 + fr, col0 = (u.pn & 1) * 256 + wc * 32 + 4 * fq;
#pragma unroll
        for (int bj = 0; bj < 2; ++bj)
#pragma unroll
            for (int n = 0; n < 2; ++n) {
                const int c = col0 + bj * 128 + n * 16;
                f32x4 bias = (f32x4){0.f, 0.f, 0.f, 0.f};
                if (kind == 0) bias = *(const f32x4*)(w0 + c); else if (kind == 1) bias = *(const f32x4*)(a0 + c);
#pragma unroll
                for (int ai = 0; ai < 2; ++ai)
#pragma unroll
                    for (int m = 0; m < 4; ++m) {
                        f32x4 v = acc[ai][bj][m][n] + bias;
                        if (kind == 0) {
#pragma unroll
                            for (int j = 0; j < 4; ++j) { const float w = -softplus_fast(-v[j]) - 0.5f; v[j] = -__expf(w);     }
                        } else if (kind == 1) {
#pragma unroll
                            for (int j = 0; j < 4; ++j) v[j] = sigmoid_f(v[j]);
                        }
                        const size_t o_ = (size_t)(row0 + ai * 128 + m * 16) * 512 + c;
                        if (kind == 0) *(f32x4*)(LWp + o_) = v;
                        else { u32x2 w_; w_.x = cvt_pk_bf16(v[0], v[1]); w_.y = cvt_pk_bf16(v[2], v[3]); *(u32x2*)((kind == 1 ? AAp : GGp) + o_) = w_; }
                    }
            }
    }
};
typedef float f32x2_t __attribute__((ext_vector_type(2)));
struct EpiSwiglu {
    static constexpr bool PERM = true;
    bf16* ACT; const float* b_gu;
    DI void operator()(const f32x4 (&acc)[2][2][4][2], const Unit& u, int wr, int wc, int fr, int fq) const {
        const int row0 = u.pm * 256 + wr * 64 + fr, j0 = u.pn * 128 + wc * 32 + 8 * fq;
        const float* bg = b_gu + (size_t)u.e * 2048 + j0; const float* bu = bg + 1024;
        const f32x4 bg0 = *(const f32x4*)bg, bg1 = *(const f32x4*)(bg + 4), bu0 = *(const f32x4*)bu, bu1 = *(const f32x4*)(bu + 4);
#pragma unroll
        for (int ai = 0; ai < 2; ++ai)
#pragma unroll
            for (int m = 0; m < 4; ++m) {
                float o[8];
#pragma unroll
                for (int n = 0; n < 2; ++n) { const f32x4 g4 = acc[ai][0][m][n] * 0.015625f + (n ? bg1 : bg0), u4 = acc[ai][1][m][n] * 0.015625f + (n ? bu1 : bu0);
#pragma unroll
                    for (int p = 0; p < 2; ++p) {
                        f32x2_t g, up; g.x = fminf(g4[2 * p], 7.0f); g.y = fminf(g4[2 * p + 1], 7.0f); up.x = fminf(fmaxf(u4[2 * p], -7.0f), 7.0f); up.y = fminf(fmaxf(u4[2 * p + 1], -7.0f), 7.0f);
                        const f32x2_t ex = g * (-1.702f * 1.44269504089f); f32x2_t d; d.x = __builtin_amdgcn_exp2f(ex.x); d.y = __builtin_amdgcn_exp2f(ex.y); d = d + 1.0f;
                        f32x2_t r; r.x = __builtin_amdgcn_rcpf(d.x); r.y = __builtin_amdgcn_rcpf(d.y);
                        const f32x2_t ov = (up + 1.0f) * (g * r); o[n * 4 + 2 * p] = ov.x; o[n * 4 + 2 * p + 1] = ov.y; } }
                u32x2 w; w.x = pk4_fp8(o[0], o[1], o[2], o[3]); w.y = pk4_fp8(o[4], o[5], o[6], o[7]);
                *(u32x2*)((unsigned char*)ACT + (size_t)(row0 + ai * 128 + m * 16) * 1024 + j0) = w;
            }
    }
};
struct EpiDown {
    static constexpr bool PERM = true;
    bf16* YS; const float* b_dn; const u32x2* row_sg;
    DI void operator()(const f32x4 (&acc)[2][2][4][2], const Unit& u, int wr, int wc, int fr, int fq) const {
        const int row0 = u.pm * 256 + wr * 64 + fr, col0 = u.pn * 256 + wc * 32 + 8 * fq;
        const float* bb = b_dn + (size_t)u.e * 1024 + col0;
        f32x4 bv[2][2];
#pragma unroll
        for (int bj = 0; bj < 2; ++bj)
#pragma unroll
            for (int n = 0; n < 2; ++n) bv[bj][n] = *(const f32x4*)(bb + bj * 128 + 4 * n);
        int slots[8]; float gts[8];
        { const u32x2* sgp = row_sg + row0;
#pragma unroll
        for (int q = 0; q < 8; ++q) { const u32x2 sg = sgp[(q >> 2) * 128 + (q & 3) * 16]; slots[q] = (int)sg.x; gts[q] = __uint_as_float(sg.y); } }
#pragma unroll
        for (int ai = 0; ai < 2; ++ai)
#pragma unroll
            for (int m = 0; m < 4; ++m) {
                const int slot = slots[ai * 4 + m]; const float gt = gts[ai * 4 + m];
                if (slot >= 0) { unsigned char* rowp = (unsigned char*)YS + (size_t)slot * 1024 + col0; const float g16 = gt * 16.0f;
#pragma unroll
                    for (int bj = 0; bj < 2; ++bj) { const f32x4 v0 = (acc[ai][bj][m][0] * 0.015625f + bv[bj][0]) * g16, v1 = (acc[ai][bj][m][1] * 0.015625f + bv[bj][1]) * g16;
                        u32x2 w; w.x = pk4_fp8(v0[0], v0[1], v0[2], v0[3]); w.y = pk4_fp8(v1[0], v1[1], v1[2], v1[3]);
                        *(u32x2*)(rowp + bj * 128) = w; } }
            }
    }
};

constexpr size_t MiB = 1u << 20;
constexpr size_t WS_CTL = 0, CTL_ZERO_BYTES = 1 * MiB;
constexpr size_t WS_WIN = 1 * MiB, WS_WOUT = 7 * MiB, WS_WQ = 9 * MiB, WS_WK = 11 * MiB, WS_WV = 13 * MiB, WS_WO = 15 * MiB, WS_LORAB = 17 * MiB, WS_LRUW = 18 * MiB;
constexpr size_t WS_ROUTE = 19 * MiB;
constexpr size_t WS_WGU = 22 * MiB, WS_WDN = 150 * MiB;
constexpr size_t WS_HN = 214 * MiB, WS_MEMN = 246 * MiB, WS_KM = 248 * MiB, WS_VT = 250 * MiB;
constexpr size_t WS_X1 = 252 * MiB, WS_X2 = 316 * MiB;
constexpr size_t WS_U = 380 * MiB, WS_R = 468 * MiB, WS_KRAW = 500 * MiB, WS_V = 532 * MiB, WS_KKN = 564 * MiB, WS_WD = 596 * MiB, WS_AA = 628 * MiB, WS_G = 660 * MiB;
constexpr size_t WS_LA = 692 * MiB, WS_LB = 724 * MiB, WS_AP = 756 * MiB, WS_CAT = 764 * MiB, WS_Q = 796 * MiB;
constexpr size_t WS_XS = 380 * MiB, WS_ACT = 524 * MiB, WS_YS = 668 * MiB;
constexpr size_t WS_GP = 796 * MiB, WS_HF = 860 * MiB, WS_RP = 924 * MiB, WS_Y1F = 940 * MiB, WS_ADD = 972 * MiB, WS_END = 1004 * MiB;
constexpr size_t WS_GC = 468 * MiB, WS_HC = 484 * MiB, WS_ZS = 500 * MiB;
static_assert(WS_AA == WS_WD + 32 * MiB && WS_G == WS_AA + 32 * MiB, "EpiLora strides");
static_assert(WS_U + (size_t)M * INW * 2 <= WS_R && WS_XS + (size_t)MAXROWS * 2048 <= WS_ACT && WS_ACT + (size_t)MAXROWS * 2048 <= WS_YS && WS_YS + (size_t)NASSIGN * 2048 <= WS_Q, "ws map");
constexpr size_t RT_E = 0, RT_POS = 256 * 1024, RT_G = 512 * 1024, RT_SLOT = 768 * 1024, RT_GATE = 1088 * 1024, RT_TILE = 1408 * 1024, RT_TOK = 1472 * 1024, RT_UGU = 1792 * 1024, RT_UDN = 1808 * 1024;
constexpr int CW_BAR = 4096, CW_CNT = 8192, CW_CONV = 12288;

constexpr int RING_BYTES = 131072, MISC_OFF = RING_BYTES + 320, LDS_BYTES = 147456;
constexpr int NWAVES = 8, NTHREADS = 512;
constexpr int CONV_P9 = 10240;
constexpr int CONV_P9D = 16384;

#define XB_TMO      128
#define XB_XCNT(j)  (256  + 64 * (j))
#define XB_XSUB(j)  (1280 + 64 * (j))
#define XB_XGEN(j)  (2304 + 64 * (j))
#define XB_TOP      3328
#define XB_TOPGEN   3392
#define XCD_BAR_WORDS 3456
#define XB_SPIN_CAP (1u << 18)
DI unsigned xb_ld(unsigned* p)              { return __hip_atomic_load(p, __ATOMIC_RELAXED, __HIP_MEMORY_SCOPE_AGENT); }
DI unsigned xb_add(unsigned* p, unsigned v) { return __hip_atomic_fetch_add(p, v, __ATOMIC_RELAXED, __HIP_MEMORY_SCOPE_AGENT); }
DI unsigned xb_xcc_id() { return (unsigned)__builtin_amdgcn_s_getreg((3 << 11) | 20) & 0xFu; }
#define XB_SPIN(cond, bar) do { unsigned _sp = 0; while (cond) { __builtin_amdgcn_s_sleep(1); \
    if ((++_sp & 255u) == 0u) { if (xb_ld(&(bar)[XB_TMO])) break; if (_sp > XB_SPIN_CAP) { atomicAdd(&(bar)[XB_TMO], 1u); break; } } } } while (0)
struct XcdBarrier { unsigned* bar; unsigned x; volatile LAS unsigned* st; int w0; };
DI XcdBarrier xcd_barrier_post(unsigned* bar, volatile LAS unsigned* st, int w0) {
    XcdBarrier b; b.bar = bar; b.x = xb_xcc_id(); b.st = st; b.w0 = w0;
    if (fresh_tid_(w0) == 0) (void)xb_add(&bar[XB_XCNT(b.x)], 1u);
    return b;
}
DI void xcd_barrier_complete(unsigned* bar, unsigned x, unsigned& nloc, unsigned& nx) {
    const unsigned G = gridDim.x * gridDim.y * gridDim.z;
    unsigned sum, cnt, mine, sp = 0u;
    for (;;) {
        sum = 0u; cnt = 0u; mine = 0u;
#pragma unroll
        for (unsigned j = 0; j < 16; ++j) { const unsigned c = xb_ld(&bar[XB_XCNT(j)]); sum += c; cnt += (c > 0u) ? 1u : 0u; mine = (j == x) ? c : mine; }
        if (sum == G) break;
        __builtin_amdgcn_s_sleep(1);
        if ((++sp & 255u) == 0u) { if (xb_ld(&bar[XB_TMO])) break; if (sp > XB_SPIN_CAP) { atomicAdd(&bar[XB_TMO], 1u); break; } }
    }
    nloc = mine > 0u ? mine : 1u; nx = cnt > 0u ? cnt : 1u;
}
DI void xcd_barrier(const XcdBarrier& b) {
    asm volatile("s_waitcnt vmcnt(0)" ::: "memory");
    __syncthreads();
    if (fresh_tid_(b.w0) == 0) {
        unsigned* bar = b.bar;
        __builtin_amdgcn_s_waitcnt(0);
        unsigned nloc = b.st[0], nx = b.st[1];
        if (nloc == 0u) { xcd_barrier_complete(bar, b.x, nloc, nx); b.st[0] = nloc; b.st[1] = nx; }
        const unsigned old = xb_add(&bar[XB_XSUB(b.x)], 1u);
        const unsigned gen = old / nloc;
        if (old + 1u == (gen + 1u) * nloc) {
            __builtin_amdgcn_fence(__ATOMIC_RELEASE, "agent");
            asm volatile("s_waitcnt vmcnt(0)" ::: "memory");
            const unsigned og = xb_add(&bar[XB_TOP], 1u);
            const unsigned tg = og / nx;
            if (og + 1u == (tg + 1u) * nx) xb_add(&bar[XB_TOPGEN], 1u);
            else XB_SPIN(xb_ld(&bar[XB_TOPGEN]) == tg, bar);
            __builtin_amdgcn_fence(__ATOMIC_ACQUIRE, "agent");
            xb_add(&bar[XB_XGEN(b.x)], 1u);
            asm volatile("s_waitcnt vmcnt(0)" ::: "memory");
        } else {
            XB_SPIN(xb_ld(&bar[XB_XGEN(b.x)]) == gen, bar);
            __builtin_amdgcn_fence(__ATOMIC_ACQUIRE, "agent");
            asm volatile("s_waitcnt vmcnt(0)" ::: "memory");
        }
    }
    __syncthreads();
}

struct Args { const float* in[37]; float* out; unsigned char* ws; int ph_lo, ph_hi; };
enum { I_X = 0, I_MEM, I_NMIXG, I_WIN, I_CONVW, I_CONVB, I_LWX, I_LBX, I_LWA, I_LBA, I_LAM, I_MU, I_W0, I_WUP, I_A0, I_AUP, I_GUP, I_KK, I_KA, I_RK, I_LNG, I_LNB,
       I_WOUT, I_NXAG, I_NMEMG, I_WQ, I_WK, I_WV, I_WO, I_NFFG, I_WR, I_BR, I_WGU, I_BGU, I_WDN, I_BDN, I_FNG };

DI void transpose_item(const float* W, int ldw, int K, bf16* WT, int k0, int n0, int drow0, LAS float* scr, int lane, const float* rs = nullptr) {
    f32x4 t[8];
    const float* src = W + (size_t)(k0 + (lane >> 3)) * ldw + n0 + 4 * (lane & 7);
#pragma unroll
    for (int i = 0; i < 8; ++i) t[i] = *(const f32x4*)(src + (size_t)(8 * i) * ldw);
#pragma unroll
    for (int i = 0; i < 8; ++i) { const float sc_ = rs ? rs[k0 + 8 * i + (lane >> 3)] : 1.0f; LAS float* d = scr + (8 * i + (lane >> 3)) * 33 + 4 * (lane & 7); d[0] = t[i].x * sc_; d[1] = t[i].y * sc_; d[2] = t[i].z * sc_; d[3] = t[i].w * sc_; }
    asm volatile("s_waitcnt lgkmcnt(0)" ::: "memory");
    const int c = lane & 7;
#pragma unroll
    for (int j = 0; j < 4; ++j) { const int n = (lane >> 3) + 8 * j; const LAS float* s = scr + (8 * c) * 33 + n;
        u32x4 o; o.x = pk2(s[0 * 33], s[1 * 33]); o.y = pk2(s[2 * 33], s[3 * 33]); o.z = pk2(s[4 * 33], s[5 * 33]); o.w = pk2(s[6 * 33], s[7 * 33]);
        *(u32x4*)(WT + (size_t)(drow0 + n) * K + k0 + 8 * c) = o; }
    asm volatile("s_waitcnt lgkmcnt(0)" ::: "memory");
}
DI void transpose_item_tiled(const float* W, int ldw, int K, bf16* WTe, int k0, int n0, int drow0, LAS float* scr, int lane) {
    f32x4 t[8];
    const float* src = W + (size_t)(k0 + (lane >> 3)) * ldw + n0 + 4 * (lane & 7);
#pragma unroll
    for (int i = 0; i < 8; ++i) t[i] = *(const f32x4*)(src + (size_t)(8 * i) * ldw);
#pragma unroll
    for (int i = 0; i < 8; ++i) { LAS float* d = scr + (8 * i + (lane >> 3)) * 33 + 4 * (lane & 7); d[0] = t[i].x; d[1] = t[i].y; d[2] = t[i].z; d[3] = t[i].w; }
    asm volatile("s_waitcnt lgkmcnt(0)" ::: "memory");
    const int c = lane & 7;
#pragma unroll
    for (int j = 0; j < 4; ++j) { const int n = (lane >> 3) + 8 * j; const LAS float* s = scr + (8 * c) * 33 + n;
        u32x4 o; o.x = pk2(s[0 * 33], s[1 * 33]); o.y = pk2(s[2 * 33], s[3 * 33]); o.z = pk2(s[4 * 33], s[5 * 33]); o.w = pk2(s[6 * 33], s[7 * 33]);
        const int drow = drow0 + n, pn = drow >> 8, half = (drow >> 7) & 1, r = drow & 127, x = r & 31;
        const int rslot = (r & ~31) + 16 * ((x >> 2) & 1) + 4 * (x >> 3) + (x & 3);
        const size_t tb = ((size_t)(pn * (K / 64) + (k0 >> 6)) * 2 + half) * 16384 + pg8::lds_byte(rslot, 8 * c);
        *(u32x4*)((char*)WTe + tb) = o; }
    asm volatile("s_waitcnt lgkmcnt(0)" ::: "memory");
}
DI void transpose_item_tiled_nolds(const float* W, int ldw, int K, bf16* WTe, int k0, int n0, int drow0, int lane) {
    const int n = lane & 31, kh = lane >> 5;
    const float* src = W + (size_t)(k0 + 32 * kh) * ldw + n0 + n;
    float t[32];
#pragma unroll
    for (int i = 0; i < 32; ++i) t[i] = src[(size_t)i * ldw];
    const int drow = drow0 + n, pn = drow >> 8, half = (drow >> 7) & 1, r = drow & 127, x = r & 31;
    const int rslot = (r & ~31) + 16 * ((x >> 2) & 1) + 4 * (x >> 3) + (x & 3);
    const size_t tb0 = ((size_t)(pn * (K / 64) + (k0 >> 6)) * 2 + half) * 16384;
#pragma unroll
    for (int c = 0; c < 4; ++c) { u32x4 o; o.x = pk2(t[8 * c], t[8 * c + 1]); o.y = pk2(t[8 * c + 2], t[8 * c + 3]); o.z = pk2(t[8 * c + 4], t[8 * c + 5]); o.w = pk2(t[8 * c + 6], t[8 * c + 7]);
        *(u32x4*)((char*)WTe + tb0 + pg8::lds_byte(rslot, 32 * kh + 8 * c)) = o; }
}
DI void transpose_item_tiled_fp8_nolds(const float* W, int ldw, int K, unsigned char* WTe, int k0, int n0, int drow0, int lane) {
    const int n = lane & 31, kh = lane >> 5;
    const float* src = W + (size_t)(k0 + 32 * kh) * ldw + n0 + n;
    float t[32];
#pragma unroll
    for (int i = 0; i < 32; ++i) t[i] = __builtin_nontemporal_load(src + (size_t)i * ldw) * 64.f;
    const int drow = drow0 + n, pn = drow >> 8, half = (drow >> 7) & 1, r = drow & 127, x = r & 31;
    const int rslot = (r & ~31) + 16 * ((x >> 2) & 1) + 4 * (x >> 3) + (x & 3);
    const size_t tb0 = ((size_t)(pn * (K / 128) + (k0 >> 7)) * 2 + half) * 16384;
#pragma unroll
    for (int c = 0; c < 2; ++c) { u32x4 o; o.x = pk4_fp8(t[16 * c], t[16 * c + 1], t[16 * c + 2], t[16 * c + 3]); o.y = pk4_fp8(t[16 * c + 4], t[16 * c + 5], t[16 * c + 6], t[16 * c + 7]);
        o.z = pk4_fp8(t[16 * c + 8], t[16 * c + 9], t[16 * c + 10], t[16 * c + 11]); o.w = pk4_fp8(t[16 * c + 12], t[16 * c + 13], t[16 * c + 14], t[16 * c + 15]);
        const int bc = (k0 & 64) + 32 * kh + 16 * c;
        *(u32x4*)(WTe + tb0 + pg8::lds_byte(rslot, bc >> 1)) = o; }
}
DI void transpose_item_tiled_fp8(const float* W, int ldw, int K, unsigned char* WTe, int k0, int n0, int drow0, LAS float* scr, int lane) {
    f32x4 t[8];
    const float* src = W + (size_t)(k0 + (lane >> 3)) * ldw + n0 + 4 * (lane & 7);
#pragma unroll
    for (int i = 0; i < 8; ++i) t[i] = __builtin_nontemporal_load((const f32x4*)(src + (size_t)(8 * i) * ldw));
#pragma unroll
    for (int i = 0; i < 8; ++i) { LAS float* d = scr + (8 * i + (lane >> 3)) * 33 + 4 * (lane & 7); d[0] = t[i].x * 64.f; d[1] = t[i].y * 64.f; d[2] = t[i].z * 64.f; d[3] = t[i].w * 64.f; }
    asm volatile("s_waitcnt lgkmcnt(0)" ::: "memory");
    const int c = lane & 3;
#pragma unroll
    for (int j = 0; j < 2; ++j) { const int n = (lane >> 2) + 16 * j; const LAS float* sp = scr + (16 * c) * 33 + n;
        u32x4 o; o.x = pk4_fp8(sp[0 * 33], sp[1 * 33], sp[2 * 33], sp[3 * 33]); o.y = pk4_fp8(sp[4 * 33], sp[5 * 33], sp[6 * 33], sp[7 * 33]);
        o.z = pk4_fp8(sp[8 * 33], sp[9 * 33], sp[10 * 33], sp[11 * 33]); o.w = pk4_fp8(sp[12 * 33], sp[13 * 33], sp[14 * 33], sp[15 * 33]);
        const int drow = drow0 + n, pn = drow >> 8, half = (drow >> 7) & 1, r = drow & 127, x = r & 31;
        const int rslot = (r & ~31) + 16 * ((x >> 2) & 1) + 4 * (x >> 3) + (x & 3);
        const int bc = (k0 & 64) + 16 * c;
        const size_t tb = ((size_t)(pn * (K / 128) + (k0 >> 7)) * 2 + half) * 16384 + pg8::lds_byte(rslot, bc >> 1);
        *(u32x4*)(WTe + tb) = o; }
    asm volatile("s_waitcnt lgkmcnt(0)" ::: "memory");
}
DI void rms_row_to_bf16(const float* xrow, const float* g, bf16* orow, int lane) {
    const f32x4* xr = (const f32x4*)xrow + lane; const f32x4* gr = (const f32x4*)g + lane;
    f32x4 v[4]; float s = 0.f;
#pragma unroll
    for (int j = 0; j < 4; ++j) { v[j] = __builtin_nontemporal_load(xr + 64 * j); s += (v[j].x * v[j].x + v[j].y * v[j].y) + (v[j].z * v[j].z + v[j].w * v[j].w); }
    const float rstd = rsq_f(wave_sum(s) * (1.f / D) + EPS);
    u32x2* o8 = (u32x2*)orow + lane;
#pragma unroll
    for (int j = 0; j < 4; ++j) { const f32x4 gg = gr[64 * j]; u32x2 w; w.x = pk2(v[j].x * rstd * gg.x, v[j].y * rstd * gg.y); w.y = pk2(v[j].z * rstd * gg.z, v[j].w * rstd * gg.w); o8[64 * j] = w; }
}

DI void rms_rowbf_to_bf16(const bf16* xrow, const float* g, bf16* orow, int lane) {
    float v[16]; float s = 0.f;
#pragma unroll
    for (int hf = 0; hf < 2; ++hf) { const u32x4 w = *(const u32x4*)(xrow + 512 * hf + 8 * lane);
#pragma unroll
        for (int q = 0; q < 4; ++q) { v[8 * hf + 2 * q] = bflo(w[q]); v[8 * hf + 2 * q + 1] = bfhi(w[q]); } }
#pragma unroll
    for (int j = 0; j < 16; ++j) s += v[j] * v[j];
    const float rstd = rsq_f(wave_sum(s) * (1.f / D) + EPS);
#pragma unroll
    for (int hf = 0; hf < 2; ++hf) { const f32x4 g0 = *(const f32x4*)(g + 512 * hf + 8 * lane), g1 = *(const f32x4*)(g + 512 * hf + 8 * lane + 4);
        u32x4 w; w.x = pk2(v[8 * hf] * rstd * g0.x, v[8 * hf + 1] * rstd * g0.y); w.y = pk2(v[8 * hf + 2] * rstd * g0.z, v[8 * hf + 3] * rstd * g0.w);
        w.z = pk2(v[8 * hf + 4] * rstd * g1.x, v[8 * hf + 5] * rstd * g1.y); w.w = pk2(v[8 * hf + 6] * rstd * g1.z, v[8 * hf + 7] * rstd * g1.w);
        *(u32x4*)(orow + 512 * hf + 8 * lane) = w; }
}

__global__ void __launch_bounds__(NTHREADS, 2) fwd(Args args) {
    extern __shared__ __attribute__((aligned(16))) unsigned char lds_raw[];
    LAS unsigned char* lds = (LAS unsigned char*)lds_raw;
    volatile LAS unsigned* MISC = (volatile LAS unsigned*)(lds + MISC_OFF);
    const int G = gridDim.x, bid = blockIdx.x, NGW = G * NWAVES;
    const int wv0 = __builtin_amdgcn_readfirstlane((int)(threadIdx.x >> 6));
#define PHASE_IDS const int tid = fresh_tid(), lane = tid & 63, wave = __builtin_amdgcn_readfirstlane(tid >> 6), gw = bid * NWAVES + wave; (void)tid; (void)lane; (void)wave; (void)gw
    unsigned char* ws = args.ws;
    unsigned* ctl = (unsigned*)(ws + WS_CTL);
    const int lo = args.ph_lo, hi = args.ph_hi;

    for (int u = fresh_tid(); u < (LDS_BYTES - RING_BYTES) / 4; u += NTHREADS) ((LAS unsigned*)(lds + RING_BYTES))[u] = 0u;
    __syncthreads();
    XcdBarrier bar; bar.bar = ctl + CW_BAR; bar.x = 0; bar.st = nullptr; bar.w0 = wv0;
    if (hi - lo > 1) bar = xcd_barrier_post(ctl + CW_BAR, MISC + 8, wv0);
#define IN(k) (lo <= (k) && (k) < hi)
#define SEAM(k) do { if (IN(k) && IN((k) + 1)) xcd_barrier(bar); } while (0)

#define Win_t ((bf16*)(ws + WS_WIN))
#define Wout_t ((bf16*)(ws + WS_WOUT))
#define Wq_t ((bf16*)(ws + WS_WQ))
#define Wk_t ((bf16*)(ws + WS_WK))
#define Wv_t ((bf16*)(ws + WS_WV))
#define Wo_t ((bf16*)(ws + WS_WO))
#define LoraB ((bf16*)(ws + WS_LORAB))
#define LruW ((bf16*)(ws + WS_LRUW))
#define WrT ((bf16*)(ws + WS_LRUW + 512 * 1024))
#define Wgu_t ((bf16*)(ws + WS_WGU))
#define Wdn_t ((bf16*)(ws + WS_WDN))
#define HN ((bf16*)(ws + WS_HN))
#define MEMN ((bf16*)(ws + WS_MEMN))
#define KM ((bf16*)(ws + WS_KM))
#define VT ((bf16*)(ws + WS_VT))
#define X1 ((bf16*)(ws + WS_X1))
#define X2 ((bf16*)(ws + WS_X2))
#define U ((bf16*)(ws + WS_U))
#define Rr ((float*)(ws + WS_R))
#define KRAW ((float*)(ws + WS_KRAW))
#define Vv ((float*)(ws + WS_V))
#define KKN ((float*)(ws + WS_KKN))
#define WD ((float*)(ws + WS_WD))
#define AA ((float*)(ws + WS_AA))
#define GG ((float*)(ws + WS_G))
#define LA ((bf16*)(ws + WS_LA))
#define LB ((bf16*)(ws + WS_LB))
#define AP ((bf16*)(ws + WS_AP))
#define CAT ((bf16*)(ws + WS_CAT))
#define Qb ((bf16*)(ws + WS_Q))
#define Ob CAT
#define LACT ((bf16*)(ws + WS_CAT))
#define X1F8 ((unsigned char*)(ws + WS_XS))
#define XS ((bf16*)(ws + WS_XS))
#define ACT ((bf16*)(ws + WS_ACT))
#define YS ((bf16*)(ws + WS_YS))
#define route_e ((int*)(ws + WS_ROUTE + RT_E))
#define route_pos ((int*)(ws + WS_ROUTE + RT_POS))
#define route_g ((float*)(ws + WS_ROUTE + RT_G))
#define row_sg ((u32x2*)(ws + WS_ROUTE + RT_SLOT))
#define tile_tab ((int*)(ws + WS_ROUTE + RT_TILE))
#define row_tok ((int*)(ws + WS_ROUTE + RT_TOK))
#define ecnt (ctl + CW_CNT)

    if (IN(0)) { PHASE_IDS;
        LAS float* scr = (LAS float*)(lds + wave * 16384);
        constexpr int I_IN = 16 * (INW / 32), I_SQ = 16 * 32;
        constexpr int N_ITEMS = I_IN + 5 * I_SQ;
        for (int it = gw; it < N_ITEMS; it += NGW) {
            int r = it;
            if (r < I_IN) { const int nblk = INW / 32, kb = r / nblk, nb = r % nblk; transpose_item(args.in[I_WIN], INW, D, Win_t, 64 * kb, 32 * nb, 32 * nb, scr, lane); continue; } r -= I_IN;
            { const int w = r / I_SQ, q = r % I_SQ, kb = q / 32, nb = q % 32;
                if (w == 1) continue;
                const float* src = w == 0 ? args.in[I_WOUT] : w == 2 ? args.in[I_WK] : w == 3 ? args.in[I_WV] : args.in[I_WO];
                bf16* dst = w == 0 ? Wout_t : w == 2 ? Wk_t : w == 3 ? Wv_t : Wo_t;
                transpose_item(src, D, D, dst, 64 * kb, 32 * nb, 32 * nb, scr, lane); }
        }
        for (int idx = bid * NTHREADS + tid; idx < D * D / 4; idx += G * NTHREADS) { const f32x4 v = ((const f32x4*)args.in[I_WQ])[idx]; const float gk = args.in[I_NXAG][idx >> 8];
            u32x2 w; w.x = pk2(v.x * gk, v.y * gk); w.y = pk2(v.z * gk, v.w * gk); ((u32x2*)Wq_t)[idx] = w; }
        for (int idx = bid * NTHREADS + tid; idx < 1536 * 256; idx += G * NTHREADS) {
            const int e = idx & 7, ln = (idx >> 3) & 63, ks = (idx >> 9) & 7, ct = (idx >> 12) & 3, hk = idx >> 14, hh = hk / 3, kind = hk - 3 * hh;
            const int k = 32 * ks + 8 * (ln >> 4) + e, n = hh * 64 + 16 * ct + (ln & 15); float v = 0.f;
            if (kind == 0) { if (k < 64) v = args.in[I_WUP][k * 512 + n]; }
            else if (kind == 1) { if (k >= 64 && k < 128) v = args.in[I_AUP][(k - 64) * 512 + n]; }
            else { if (k >= 128) v = args.in[I_GUP][(k - 128) * 512 + n]; }
            LoraB[idx] = (bf16)f2bf(v);
        }
        for (int idx = bid * NTHREADS + tid; idx < 8 * 128 * 64; idx += G * NTHREADS) {
            const int nb = idx >> 13, col = (idx >> 6) & 127, k = idx & 63;
            const float v = col < 64 ? args.in[I_LWX][nb * 4096 + k * 64 + col] : args.in[I_LWA][nb * 4096 + k * 64 + (col - 64)];
            LruW[idx] = (bf16)f2bf(v);
        }
        for (int idx = bid * NTHREADS + tid; idx < NE * D; idx += G * NTHREADS) {
            const int e = idx >> 10, k = idx & 1023; const float v = args.in[I_WR][k * NE + e];
            const unsigned hi = f2bf(v); const float lo = v - __uint_as_float(hi << 16);
            WrT[idx] = (bf16)hi; WrT[NE * D + idx] = (bf16)f2bf(lo);
        }
        for (int m = gw; m < M; m += NGW) rms_row_to_bf16(args.in[I_X] + (size_t)m * D, args.in[I_NMIXG], HN + (size_t)m * D, lane);
        for (int m = gw; m < MROWS; m += NGW) rms_row_to_bf16(args.in[I_MEM] + (size_t)m * D, args.in[I_NMEMG], MEMN + (size_t)m * D, lane);
        {
            LAS float* scr = (LAS float*)(lds + wave * 16384);
            constexpr int I_GU = 16 * 64, I_DN = 16 * 32;
            for (int it = CONV_P9 + gw; it < NE * I_GU; it += NGW) {
                int r = it;
                if (r < NE * I_GU) { const int e = r / I_GU, q = r % I_GU, kb = q / 64, nb = q % 64; const int n0 = 32 * nb;
                    const int drow = n0 < 1024 ? (256 * (n0 >> 7) + (n0 & 127)) : (256 * ((n0 - 1024) >> 7) + 128 + ((n0 - 1024) & 127));
                    transpose_item_tiled_fp8(args.in[I_WGU] + (size_t)e * D * 2048, 2048, D, (unsigned char*)Wgu_t + (size_t)e * 2048 * D, 64 * kb, n0, drow, scr, lane); continue; } r -= NE * I_GU;
                { const int e = r / I_DN, q = r % I_DN, kb = q / 32, nb = q % 32;
                  transpose_item_tiled(args.in[I_WDN] + (size_t)e * DFF * D, D, DFF, Wdn_t + (size_t)e * D * DFF, 64 * kb, 32 * nb, 32 * nb, scr, lane); }
            }
        }
    }
    SEAM(0);

    if (IN(1)) { PHASE_IDS;
        { pg8::DenseSched S; S.o.init_tiles(M / 256, INW / 256, G, bid); S.A = (const char*)HN; S.B = (const char*)Win_t; S.tstep = (size_t)256 * D * 2;
          EpiBf16Plain E{U, INW, 1.0f}; pg8::gemm_phase(lds, D, S, E, wv0); }
        { pg8::DenseSched S; S.o.init_tiles(MROWS / 256, D / 256, G, (bid + 64) & (G - 1)); S.A = (const char*)MEMN; S.B = (const char*)Wk_t; S.tstep = (size_t)256 * D * 2;
          EpiBf16Plain E{KM, D, 1.0f}; pg8::gemm_phase(lds, D, S, E, wv0); }
        { pg8::DenseSched S; S.o.init_tiles(MROWS / 256, D / 256, G, (bid + 48) & (G - 1)); S.A = (const char*)MEMN; S.B = (const char*)Wv_t; S.tstep = (size_t)256 * D * 2;
          EpiBf16Plain E{VT, D, 1.0f}; pg8::gemm_phase(lds, D, S, E, wv0); }
    }
    SEAM(1);

    if (IN(2)) { PHASE_IDS;
        const float* conv_w = args.in[I_CONVW]; const float* conv_b = args.in[I_CONVB];
        LAS float* xs = (LAS float*)(lds + wave * 16384);
        LAS bf16* tP = (LAS bf16*)(lds + wave * 16384 + 4096); LAS bf16* tH = tP + 1024;
        const int i = lane & 15, kg = lane >> 4;
        for (int unit = gw; unit < (M / 64) * 8; unit += NGW) {
            const int seg = unit >> 3, nb = unit & 7, m0s = seg * 64, s0s = m0s & (SEQ - 1);
            bf16x8 wf[8][2];
#pragma unroll
            for (int ct = 0; ct < 8; ++ct)
#pragma unroll
                for (int ks = 0; ks < 2; ++ks) wf[ct][ks] = *(const bf16x8*)(LruW + ((size_t)(nb * 128 + 16 * ct + i) * 64 + 32 * ks + 8 * kg));
            float bxv[4], bav[4], spv[4], Arun[4], Brun[4];
#pragma unroll
            for (int ct = 0; ct < 4; ++ct) { const int ch = nb * 64 + 16 * ct + i; bxv[ct] = args.in[I_LBX][ch]; bav[ct] = args.in[I_LBA][ch]; spv[ct] = softplus_f(-args.in[I_LAM][ch]); Arun[ct] = 1.f; Brun[ct] = 0.f; }
#pragma unroll 1
            for (int jt = 0; jt < 4; ++jt) {
                const int m0 = m0s + 16 * jt, s0 = s0s + 16 * jt;
                bf16x8 af[2];
#pragma unroll
                for (int ks = 0; ks < 2; ++ks) {
                    const int chb = nb * 64 + 32 * ks + 8 * kg;
                    f32x4 x0 = *(const f32x4*)(conv_b + chb), x1 = *(const f32x4*)(conv_b + chb + 4);
#pragma unroll
                    for (int j = 0; j < 4; ++j) {
                        const bool ok = s0 + i - 3 + j >= 0;
                        u32x4 uw = *(const u32x4*)(U + (size_t)(ok ? m0 + i - 3 + j : m0) * INW + chb); if (!ok) uw = (u32x4){0u, 0u, 0u, 0u};
                        const f32x4 w0 = *(const f32x4*)(conv_w + j * 512 + chb), w1 = *(const f32x4*)(conv_w + j * 512 + chb + 4);
                        x0.x += w0.x * bflo(uw.x); x0.y += w0.y * bfhi(uw.x); x0.z += w0.z * bflo(uw.y); x0.w += w0.w * bfhi(uw.y);
                        x1.x += w1.x * bflo(uw.z); x1.y += w1.y * bfhi(uw.z); x1.z += w1.z * bflo(uw.w); x1.w += w1.w * bfhi(uw.w);
                    }
                    *(LAS f32x4*)(xs + i * 64 + 32 * ks + 8 * kg) = x0; *(LAS f32x4*)(xs + i * 64 + 32 * ks + 8 * kg + 4) = x1;
                    u32x4 p; p.x = pk2(x0.x, x0.y); p.y = pk2(x0.z, x0.w); p.z = pk2(x1.x, x1.y); p.w = pk2(x1.z, x1.w);
                    af[ks] = __builtin_bit_cast(bf16x8, p);
                }
                f32x4 acc[8];
#pragma unroll
                for (int ct = 0; ct < 8; ++ct) { acc[ct] = (f32x4){0.f, 0.f, 0.f, 0.f};
#pragma unroll
                    for (int ks = 0; ks < 2; ++ks) acc[ct] = __builtin_amdgcn_mfma_f32_16x16x32_bf16(af[ks], wf[ct][ks], acc[ct], 0, 0, 0); }
#pragma unroll
                for (int ct = 0; ct < 4; ++ct) {
                    const int col = 16 * ct + i;
                    float hl[4], pl[4]; float hprev = 0.f, pprev = 1.f;
#pragma unroll
                    for (int e = 0; e < 4; ++e) {
                        const float gx = sigmoid_f(acc[ct][e] + bxv[ct]), ga = sigmoid_f(acc[ct + 4][e] + bav[ct]);
                        const float la = -8.0f * ga * spv[ct], av = __expf(la), xcv = xs[(4 * kg + e) * 64 + col];
                        const float bt = __builtin_amdgcn_sqrtf(fmaxf(1.0f - av * av, 0.f)) * gx * xcv;
                        hprev = av * hprev + bt; pprev *= av; hl[e] = hprev; pl[e] = pprev;
                    }
                    float Ag[4], Bg[4];
#pragma unroll
                    for (int gq = 0; gq < 4; ++gq) { Ag[gq] = __shfl(pl[3], i + 16 * gq); Bg[gq] = __shfl(hl[3], i + 16 * gq); }
                    float Ain = Arun[ct], Bin = Brun[ct];
#pragma unroll
                    for (int gq = 0; gq < 3; ++gq) if (gq < kg) { Bin = Ag[gq] * Bin + Bg[gq]; Ain *= Ag[gq]; }
                    float At = 1.f, Bt = 0.f;
#pragma unroll
                    for (int gq = 0; gq < 4; ++gq) { Bt = Ag[gq] * Bt + Bg[gq]; At *= Ag[gq]; }
                    Brun[ct] = At * Brun[ct] + Bt; Arun[ct] *= At;
#pragma unroll
                    for (int e = 0; e < 4; ++e) { const int ti_ = (4 * kg + e) * 64 + col; tP[ti_] = (bf16)f2bf(pl[e] * Ain); tH[ti_] = (bf16)f2bf(hl[e] + pl[e] * Bin); }
                }
                { const int rr = lane >> 2, cq = lane & 3;
                  bf16* pp = LA + (size_t)(m0 + rr) * 512 + nb * 64 + 16 * cq; bf16* hp = LB + (size_t)(m0 + rr) * 512 + nb * 64 + 16 * cq;
                  *(u32x4*)pp = *(const LAS u32x4*)(tP + rr * 64 + 16 * cq); *(u32x4*)(pp + 8) = *(const LAS u32x4*)(tP + rr * 64 + 16 * cq + 8);
                  *(u32x4*)hp = *(const LAS u32x4*)(tH + rr * 64 + 16 * cq); *(u32x4*)(hp + 8) = *(const LAS u32x4*)(tH + rr * 64 + 16 * cq + 8); }
            }
            if (kg == 0) {
#pragma unroll
                for (int ct = 0; ct < 4; ++ct) { f32x2 ab; ab.x = Arun[ct]; ab.y = Brun[ct];
                    *(f32x2*)((float*)(ws + WS_AP) + ((size_t)(((seg >> 6) * 8 + nb) * 64 + (seg & 63)) * 64 + 16 * ct + i) * 2) = ab; }
            }
        }
        { const int rsub = lane >> 5, chunk = lane & 31;
          const f32x4 m0 = *(const f32x4*)(args.in[I_MU] + 1536 + 8 * chunk), m1 = *(const f32x4*)(args.in[I_MU] + 1536 + 8 * chunk + 4);
          const bool actid = chunk >= 8 && chunk < 16; const float actc = chunk < 8 ? 2.8853900818f : -1.4426950409f, actp = chunk < 8 ? 1.0f : 0.0f, actq = chunk < 8 ? -2.0f : 1.0f;
          for (int rp = gw; rp < M / 2; rp += NGW) { const size_t mr = (size_t)2 * rp + rsub; const bool hp2 = (mr & (SEQ - 1)) != 0; const bf16* ua = U + mr * INW + 2560 + 8 * chunk;
              const u32x4 cu = *(const u32x4*)ua; u32x4 pu = *(const u32x4*)(ua - (hp2 ? INW : 0)); if (!hp2) pu = (u32x4){0u, 0u, 0u, 0u};
              float o8[8];
#pragma unroll
              for (int q = 0; q < 4; ++q) { const float c0 = bflo(cu[q]), c1 = bfhi(cu[q]), p0 = bflo(pu[q]), p1 = bfhi(pu[q]); const float mm0 = q < 2 ? m0[2 * q] : m1[2 * q - 4], mm1 = q < 2 ? m0[2 * q + 1] : m1[2 * q - 3];
                  float x0 = c0 + (p0 - c0) * mm0, x1 = c1 + (p1 - c1) * mm1;
                  const float r0 = __builtin_amdgcn_rcpf(__builtin_amdgcn_exp2f(actc * x0) + 1.0f), r1 = __builtin_amdgcn_rcpf(__builtin_amdgcn_exp2f(actc * x1) + 1.0f);
                  o8[2 * q] = actid ? x0 : actp + actq * r0; o8[2 * q + 1] = actid ? x1 : actp + actq * r1; }
              u32x4 pw; pw.x = pk2(o8[0], o8[1]); pw.y = pk2(o8[2], o8[3]); pw.z = pk2(o8[4], o8[5]); pw.w = pk2(o8[6], o8[7]);
              *(u32x4*)(LACT + mr * 256 + 8 * chunk) = pw; } }
    }
    SEAM(2);


#define RW_ZB(zz, zb) do { _Pragma("unroll") for (int ks_ = 0; ks_ < 2; ++ks_) { u32x4 p_; p_.x = pk2(zz[2 * ks_][0], zz[2 * ks_][1]); p_.y = pk2(zz[2 * ks_][2], zz[2 * ks_][3]); \
        p_.z = pk2(zz[2 * ks_ + 1][0], zz[2 * ks_ + 1][1]); p_.w = pk2(zz[2 * ks_ + 1][2], zz[2 * ks_ + 1][3]); zb[ks_] = __builtin_bit_cast(bf16x8, p_); } } while (0)
    if (IN(3)) { PHASE_IDS;
        for (int u64 = gw; u64 < NB * NH * (SEQ / 64); u64 += NGW) {
#pragma unroll 1
        for (int jj = 0; jj < 4; ++jj) {
        LAS unsigned char* wl = lds + wave * 16384;
        LAS bf16* Arm = (LAS bf16*)(wl); LAS bf16* Brm = (LAS bf16*)(wl + 2048); LAS bf16* Krm = (LAS bf16*)(wl + 4096); LAS bf16* Rrm = (LAS bf16*)(wl + 6144);
        LAS bf16* ATt = (LAS bf16*)(wl + 8192); LAS bf16* BTt = (LAS bf16*)(wl + 10240); LAS bf16* KTt = (LAS bf16*)(wl + 12288); LAS bf16* VTt = (LAS bf16*)(wl + 14336);
        LAS float* MabT = (LAS float*)(wl); LAS bf16* Mak = (LAS bf16*)(wl + 1024); LAS bf16* Mrb = (LAS bf16*)(wl + 1536); LAS bf16* Mrk = (LAS bf16*)(wl + 2048); LAS bf16* Tm = (LAS bf16*)(wl + 2560);
        LAS float* PLs = (LAS float*)(wl + 3072); LAS bf16* Q0T = (LAS bf16*)(wl + 4096);
        const int lane = fresh_tid() & 63, l15 = lane & 15, g = lane >> 4, te = lane >> 2, kq = lane & 3;
        const bf16x8 z8 = (bf16x8){0, 0, 0, 0, 0, 0, 0, 0};
        const f32x4 z4 = (f32x4){0.f, 0.f, 0.f, 0.f};
            const int un = u64 * 4 + jj;
            const int bh = un >> 8, c = un & 255, b = bh >> 3, h = bh & 7;
            const size_t mrow = (size_t)b * SEQ + c * 16 + te, off = mrow * 512 + h * 64 + 16 * kq;
            const int hc = h * 64 + 16 * kq;
            LAS float* tmpL = (LAS float*)wl;
            {
                const int rsub = lane >> 5, chunk = lane & 31; const size_t mt0 = (size_t)b * SEQ + c * 16;
                u32x4 cu[8];
#pragma unroll
                for (int i = 0; i < 8; ++i) cu[i] = *(const u32x4*)(LACT + (mt0 + 2 * i + rsub) * 256 + 8 * chunk);
#pragma unroll
                for (int i = 0; i < 8; ++i) { const int row = 2 * i + rsub; *(LAS u32x4*)(wl + row * 512 + ((chunk ^ (row & 7)) << 4)) = cu[i]; }
                bf16x8 af[8];
#pragma unroll
                for (int ks = 0; ks < 8; ++ks) af[ks] = *(const LAS bf16x8*)(wl + l15 * 512 + (((4 * ks + g) ^ (l15 & 7)) << 4));
                asm volatile("s_waitcnt lgkmcnt(0)" ::: "memory");
#pragma unroll
                for (int kind = 0; kind < 3; ++kind)
#pragma unroll
                    for (int ct = 0; ct < 4; ++ct) {
                        const bf16* lb = LoraB + ((size_t)((h * 3 + kind) * 4 + ct) * 8 * 64 + lane) * 8;
                        f32x4 a4 = z4;
#pragma unroll
                        for (int ks = (kind == 0 ? 0 : kind == 1 ? 2 : 4); ks < (kind == 0 ? 2 : kind == 1 ? 4 : 8); ++ks) a4 = __builtin_amdgcn_mfma_f32_16x16x32_bf16(af[ks], *(const bf16x8*)(lb + ks * 512), a4, 0, 0, 0);
#pragma unroll
                        for (int e = 0; e < 4; ++e) tmpL[kind * 1088 + (4 * g + e) * 68 + 16 * ct + l15] = a4[e];
                    }
            }
            asm volatile("s_waitcnt lgkmcnt(0)" ::: "memory");
            float cl[16], eP[16];
            {
                float lwv[16], rl[16], kl[16], vl[16], kn[16], av[16];
                const bool hp = (mrow & (SEQ - 1)) != 0;
                const bf16* ub = U + mrow * INW + 1024 + hc;
#pragma unroll
                for (int hh = 0; hh < 2; ++hh) {
#pragma unroll
                    for (int a3 = 0; a3 < 3; ++a3) {
                        const u32x4 cu = *(const u32x4*)(ub + 512 * a3 + 8 * hh); u32x4 pu = *(const u32x4*)(ub - (hp ? INW : 0) + 512 * a3 + 8 * hh); if (!hp) pu = (u32x4){0u, 0u, 0u, 0u};
                        const f32x4 m0 = *(const f32x4*)(args.in[I_MU] + 512 * a3 + hc + 8 * hh), m1 = *(const f32x4*)(args.in[I_MU] + 512 * a3 + hc + 8 * hh + 4);
                        float o8[8];
#pragma unroll
                        for (int q = 0; q < 4; ++q) { const float c0 = bflo(cu[q]), c1 = bfhi(cu[q]), p0 = bflo(pu[q]), p1 = bfhi(pu[q]); const float mm0 = q < 2 ? m0[2 * q] : m1[2 * q - 4], mm1 = q < 2 ? m0[2 * q + 1] : m1[2 * q - 3];
                            o8[2 * q] = c0 + (p0 - c0) * mm0; o8[2 * q + 1] = c1 + (p1 - c1) * mm1; }
#pragma unroll
                        for (int q = 0; q < 8; ++q) { if (a3 == 0) rl[8 * hh + q] = o8[q]; else if (a3 == 1) kl[8 * hh + q] = o8[q]; else vl[8 * hh + q] = o8[q]; }
                    }
                }
                float gv[16];
#pragma unroll
                for (int j4 = 0; j4 < 4; ++j4) { const f32x4 xl = *(const LAS f32x4*)(tmpL + te * 68 + 16 * kq + 4 * j4), xa = *(const LAS f32x4*)(tmpL + 1088 + te * 68 + 16 * kq + 4 * j4), xg = *(const LAS f32x4*)(tmpL + 2176 + te * 68 + 16 * kq + 4 * j4);
                    const f32x4 w0v = *(const f32x4*)(args.in[I_W0] + hc + 4 * j4), a0v = *(const f32x4*)(args.in[I_A0] + hc + 4 * j4);
#pragma unroll
                    for (int q = 0; q < 4; ++q) { lwv[4 * j4 + q] = -0.6065306597f * sigmoid_f(xl[q] + w0v[q]);        av[4 * j4 + q] = sigmoid_f(xa[q] + a0v[q]); gv[4 * j4 + q] = xg[q]; } }
                asm volatile("s_waitcnt lgkmcnt(0)" ::: "memory");
                float ss = 0.f;
#pragma unroll
                for (int j4 = 0; j4 < 4; ++j4) { const f32x4 kk4 = *(const f32x4*)(args.in[I_KK] + hc + 4 * j4);
#pragma unroll
                    for (int q = 0; q < 4; ++q) { kn[4 * j4 + q] = kl[4 * j4 + q] * kk4[q]; ss += kn[4 * j4 + q] * kn[4 * j4 + q]; } }
                ss += __shfl_xor(ss, 1); ss += __shfl_xor(ss, 2);
                const float kinv = rsq_f(fmaxf(ss, 1e-24f));
#pragma unroll
                for (int j = 0; j < 16; ++j) { float x = lwv[j];
#pragma unroll
                    for (int sft = 4; sft < 64; sft <<= 1) { const float y = __shfl_up(x, sft); if (lane >= sft) x += y; }
                    cl[j] = x; }
                float bon = 0.f;
                u32x4 pa[2], pb[2], pk[2], pr[2];
#pragma unroll
                for (int j4 = 0; j4 < 4; ++j4) {
                    const f32x4 ka = *(const f32x4*)(args.in[I_KA] + hc + 4 * j4), rk = *(const f32x4*)(args.in[I_RK] + hc + 4 * j4);
                    float at4[4], bt4[4], kt4[4], rt4[4];
#pragma unroll
                    for (int q = 0; q < 4; ++q) { const int j = 4 * j4 + q;
                        const float p = __expf(cl[j]), pn = __expf(-cl[j]), pm1 = __expf(cl[j] - lwv[j]); eP[j] = p;
                        const float knj = kn[j] * kinv;
                        const float kp = kl[j] * (1.0f + (av[j] - 1.0f) * ka[q]);
                        at4[q] = -knj * pm1; bt4[q] = knj * av[j] * pn; kt4[q] = kp * pn; rt4[q] = rl[j] * p;
                        bon += rl[j] * kp * rk[q];
                        const int kk = 16 * kq + j;
                        ATt[kk * 16 + te] = (bf16)f2bf(at4[q]); BTt[kk * 16 + te] = (bf16)f2bf(bt4[q]); KTt[kk * 16 + te] = (bf16)f2bf(kt4[q]); VTt[kk * 16 + te] = (bf16)f2bf(vl[j]); }
                    const int hh = j4 >> 1, w2 = (j4 & 1) * 2;
                    pa[hh][w2] = pk2(at4[0], at4[1]); pa[hh][w2 + 1] = pk2(at4[2], at4[3]); pb[hh][w2] = pk2(bt4[0], bt4[1]); pb[hh][w2 + 1] = pk2(bt4[2], bt4[3]);
                    pk[hh][w2] = pk2(kt4[0], kt4[1]); pk[hh][w2 + 1] = pk2(kt4[2], kt4[3]); pr[hh][w2] = pk2(rt4[0], rt4[1]); pr[hh][w2 + 1] = pk2(rt4[2], rt4[3]);
                }
#pragma unroll
                for (int hh = 0; hh < 2; ++hh) { const int po = te * 64 + 8 * ((2 * kq + hh) ^ (te & 7));
                    *(LAS u32x4*)(Arm + po) = pa[hh]; *(LAS u32x4*)(Brm + po) = pb[hh]; *(LAS u32x4*)(Krm + po) = pk[hh]; *(LAS u32x4*)(Rrm + po) = pr[hh]; }
                bon += __shfl_xor(bon, 1); bon += __shfl_xor(bon, 2);
                f32x4 lbv[4], lgv[4];
#pragma unroll
                for (int j4 = 0; j4 < 4; ++j4) { lbv[j4] = *(const f32x4*)(args.in[I_LNB] + hc + 4 * j4); lgv[j4] = *(const f32x4*)(args.in[I_LNG] + hc + 4 * j4); }
#pragma unroll
                for (int j4 = 0; j4 < 4; ++j4) { const f32x4 lb = lbv[j4], lgn = lgv[j4]; const int j0 = 4 * j4;
                    u32x2 ow, gw2; ow.x = pk2((lb.x + vl[j0] * bon) * gv[j0], (lb.y + vl[j0 + 1] * bon) * gv[j0 + 1]); ow.y = pk2((lb.z + vl[j0 + 2] * bon) * gv[j0 + 2], (lb.w + vl[j0 + 3] * bon) * gv[j0 + 3]);
                    gw2.x = pk2(lgn.x * gv[j0], lgn.y * gv[j0 + 1]); gw2.y = pk2(lgn.z * gv[j0 + 2], lgn.w * gv[j0 + 3]);
                    *(u32x2*)((bf16*)(ws + WS_ADD) + off + j0) = ow; *(u32x2*)((bf16*)(ws + WS_G) + off + j0) = gw2; }
            }
            asm volatile("s_waitcnt lgkmcnt(0)" ::: "memory");
            {
                bf16x8 fa[2], fr[2], fb[2], fk[2];
#pragma unroll
                for (int ks = 0; ks < 2; ++ks) { const int po = l15 * 64 + 8 * ((4 * ks + g) ^ (l15 & 7));
                    fa[ks] = *(const LAS bf16x8*)(Arm + po); fr[ks] = *(const LAS bf16x8*)(Rrm + po); fb[ks] = *(const LAS bf16x8*)(Brm + po); fk[ks] = *(const LAS bf16x8*)(Krm + po); }
                f32x4 mab = z4, mak = z4, mrb = z4, mrk = z4;
#pragma unroll
                for (int ks = 0; ks < 2; ++ks) { mab = __builtin_amdgcn_mfma_f32_16x16x32_bf16(fb[ks], fa[ks], mab, 0, 0, 0); mak = __builtin_amdgcn_mfma_f32_16x16x32_bf16(fk[ks], fa[ks], mak, 0, 0, 0);
                    mrb = __builtin_amdgcn_mfma_f32_16x16x32_bf16(fb[ks], fr[ks], mrb, 0, 0, 0); mrk = __builtin_amdgcn_mfma_f32_16x16x32_bf16(fk[ks], fr[ks], mrk, 0, 0, 0); }
#pragma unroll
                for (int e = 0; e < 4; ++e) { const int i = 4 * g + e; if (!(i < l15)) { mab[e] = 0.f; mak[e] = 0.f; } if (!(i <= l15)) { mrb[e] = 0.f; mrk[e] = 0.f; } }
                asm volatile("s_waitcnt lgkmcnt(0)" ::: "memory");
#pragma unroll
                for (int e = 0; e < 4; ++e) MabT[(4 * g + e) * 16 + l15] = mab[e];
                u32x2 w; w.x = pk2(mak[0], mak[1]); w.y = pk2(mak[2], mak[3]); *(LAS u32x2*)(Mak + l15 * 16 + 4 * g) = w;
                w.x = pk2(mrb[0], mrb[1]); w.y = pk2(mrb[2], mrb[3]); *(LAS u32x2*)(Mrb + l15 * 16 + 4 * g) = w;
                w.x = pk2(mrk[0], mrk[1]); w.y = pk2(mrk[2], mrk[3]); *(LAS u32x2*)(Mrk + l15 * 16 + 4 * g) = w;
                if (te == 15) {
#pragma unroll
                    for (int j = 0; j < 16; ++j) PLs[16 * kq + j] = eP[j]; }
            }
            asm volatile("s_waitcnt lgkmcnt(0)" ::: "memory");
            {
                f32x4 mq[15][4];
#pragma unroll
                for (int j = 0; j < 15; ++j)
#pragma unroll
                    for (int q = 0; q < 4; ++q) if (4 * q + 3 > j) mq[j][q] = *(const LAS f32x4*)(MabT + j * 16 + 4 * q);
                float y[16];
#pragma unroll
                for (int j = 15; j >= 0; --j) {
                    float acc = (j == l15) ? 1.0f : 0.0f;
#pragma unroll
                    for (int i = j + 1; i < 16; ++i) acc += y[i] * mq[j < 15 ? j : 0][i >> 2][i & 3];
                    y[j] = acc;
                }
                if (g == 0) { u32x4 t0, t1; t0.x = pk2(y[0], y[1]); t0.y = pk2(y[2], y[3]); t0.z = pk2(y[4], y[5]); t0.w = pk2(y[6], y[7]); t1.x = pk2(y[8], y[9]); t1.y = pk2(y[10], y[11]); t1.z = pk2(y[12], y[13]); t1.w = pk2(y[14], y[15]);
                    *(LAS u32x4*)(Tm + l15 * 16) = t0; *(LAS u32x4*)(Tm + l15 * 16 + 8) = t1; }
            }
            asm volatile("s_waitcnt lgkmcnt(0)" ::: "memory");
            {
                const bool act = g < 2; const int fo = l15 * 16 + 8 * g;
                const bf16x8 fT = act ? *(const LAS bf16x8*)(Tm + fo) : z8, fMak = act ? *(const LAS bf16x8*)(Mak + fo) : z8, fMrb = act ? *(const LAS bf16x8*)(Mrb + fo) : z8, fMrk = act ? *(const LAS bf16x8*)(Mrk + fo) : z8;
                bf16x8 fV[4], fQ1[4], fAh[4], fBT[4], fKT[4];
#pragma unroll
                for (int vt = 0; vt < 4; ++vt) { fV[vt] = act ? *(const LAS bf16x8*)(VTt + vt * 256 + fo) : z8; fBT[vt] = act ? *(const LAS bf16x8*)(BTt + vt * 256 + fo) : z8; fKT[vt] = act ? *(const LAS bf16x8*)(KTt + vt * 256 + fo) : z8; }
#pragma unroll
                for (int vt = 0; vt < 4; ++vt) { const f32x4 q0 = __builtin_amdgcn_mfma_f32_16x16x32_bf16(fMak, fV[vt], z4, 0, 0, 0);
                    u32x2 w; w.x = pk2(q0[0], q0[1]); w.y = pk2(q0[2], q0[3]); *(LAS u32x2*)(Q0T + vt * 256 + l15 * 16 + 4 * g) = w; }
#pragma unroll
                for (int kt = 0; kt < 4; ++kt) { const bf16x8 fA = act ? *(const LAS bf16x8*)(ATt + kt * 256 + fo) : z8; const f32x4 ah = __builtin_amdgcn_mfma_f32_16x16x32_bf16(fT, fA, z4, 0, 0, 0);
                    u32x2 w; w.x = pk2(ah[0], ah[1]); w.y = pk2(ah[2], ah[3]); *(LAS u32x2*)(ATt + kt * 256 + l15 * 16 + 4 * g) = w; }
                asm volatile("s_waitcnt lgkmcnt(0)" ::: "memory");
#pragma unroll
                for (int vt = 0; vt < 4; ++vt) { const bf16x8 fQ0 = act ? *(const LAS bf16x8*)(Q0T + vt * 256 + fo) : z8; const f32x4 q1 = __builtin_amdgcn_mfma_f32_16x16x32_bf16(fT, fQ0, z4, 0, 0, 0);
                    u32x2 w; w.x = pk2(q1[0], q1[1]); w.y = pk2(q1[2], q1[3]); *(LAS u32x2*)(Q0T + vt * 256 + l15 * 16 + 4 * g) = w; }
                asm volatile("s_waitcnt lgkmcnt(0)" ::: "memory");
#pragma unroll
                for (int vt = 0; vt < 4; ++vt) { fQ1[vt] = act ? *(const LAS bf16x8*)(Q0T + vt * 256 + fo) : z8; fAh[vt] = act ? *(const LAS bf16x8*)(ATt + vt * 256 + fo) : z8; }
                bf16* rp = (bf16*)(ws + WS_RP) + (size_t)un * 1024 + l15 * 64;
#pragma unroll
                for (int kt = 0; kt < 4; ++kt) {
                    const u32x2 rr = *(const LAS u32x2*)(Rrm + l15 * 64 + 8 * ((2 * kt + (g >> 1)) ^ (l15 & 7)) + 4 * (g & 1));
                    f32x4 ini; ini[0] = bflo(rr.x); ini[1] = bfhi(rr.x); ini[2] = bflo(rr.y); ini[3] = bfhi(rr.y);
                    const f32x4 rh = __builtin_amdgcn_mfma_f32_16x16x32_bf16(fAh[kt], fMrb, ini, 0, 0, 0);
                    u32x2 w; w.x = pk2(rh[0], rh[1]); w.y = pk2(rh[2], rh[3]); *(u32x2*)(rp + 32 * (kt >> 1) + 8 * g + 4 * (kt & 1)) = w;
                }
#pragma unroll
                for (int vt = 0; vt < 4; ++vt) { f32x4 y1 = __builtin_amdgcn_mfma_f32_16x16x32_bf16(fMrb, fQ1[vt], z4, 0, 0, 0); y1 = __builtin_amdgcn_mfma_f32_16x16x32_bf16(fMrk, fV[vt], y1, 0, 0, 0);
                    *(f32x4*)((float*)(ws + WS_Y1F) + ((size_t)(un * 4 + vt) * 64 + lane) * 4) = y1; }
                LAS bf16* tgs = (LAS bf16*)(wl + 8192);
#pragma unroll
                for (int krt = 0; krt < 4; ++krt) { const float pl = PLs[16 * krt + l15];
#pragma unroll
                    for (int kct = 0; kct < 4; ++kct) { f32x4 ga = __builtin_amdgcn_mfma_f32_16x16x32_bf16(fAh[kct], fBT[krt], z4, 0, 0, 0);
                        if (kct == krt) {
#pragma unroll
                            for (int e = 0; e < 4; ++e) if (4 * g + e == l15) ga[e] += 1.0f; }
                        u32x2 w; w.x = pk2(ga[0] * pl, ga[1] * pl); w.y = pk2(ga[2] * pl, ga[3] * pl);
                        *(LAS u32x2*)(tgs + (16 * krt + l15) * 64 + 32 * (kct >> 1) + 8 * g + 4 * (kct & 1)) = w; } }
                { u32x4* gp16 = (u32x4*)((bf16*)(ws + WS_GP) + (size_t)un * 4096);
#pragma unroll
                  for (int i = 0; i < 8; ++i) gp16[i * 64 + lane] = *(const LAS u32x4*)(tgs + (i * 64 + lane) * 8); }
#pragma unroll
                for (int mt = 0; mt < 4; ++mt) { const f32x4 pl4 = *(const LAS f32x4*)(PLs + 16 * mt + 4 * g);
#pragma unroll
                    for (int vt = 0; vt < 4; ++vt) { f32x4 ha = __builtin_amdgcn_mfma_f32_16x16x32_bf16(fBT[mt], fQ1[vt], z4, 0, 0, 0); ha = __builtin_amdgcn_mfma_f32_16x16x32_bf16(fKT[mt], fV[vt], ha, 0, 0, 0);
                        u32x2 w; w.x = pk2(ha[0] * pl4[0], ha[1] * pl4[1]); w.y = pk2(ha[2] * pl4[2], ha[3] * pl4[3]);
                        *(u32x2*)((bf16*)(ws + WS_HF) + ((size_t)((un * 4 + vt) * 4 + mt) * 64 + lane) * 4) = w; } }
            }
            asm volatile("s_waitcnt lgkmcnt(0)" ::: "memory");
        }
        asm volatile("s_waitcnt vmcnt(0)" ::: "memory");
        { const int ltid = fresh_tid() & 63, l15 = ltid & 15, g = ltid >> 4, lane = ltid;
#define CP_LOADG(gf_, j_) do { const bf16* gp_ = (const bf16*)(ws + WS_GP) + ((size_t)u64 * 4 + (j_)) * 4096 + l15 * 64 + 8 * g; \
            _Pragma("unroll") for (int mt = 0; mt < 4; ++mt) { gf_[mt][0] = *(const bf16x8*)(gp_ + mt * 1024); gf_[mt][1] = *(const bf16x8*)(gp_ + mt * 1024 + 32); } } while (0)
#define CP_LOADH(hf_, j_) do { _Pragma("unroll") for (int sl = 0; sl < 4; ++sl) _Pragma("unroll") for (int mt = 0; mt < 4; ++mt) \
            hf_[sl][mt] = *(const u32x2*)((const bf16*)(ws + WS_HF) + ((size_t)((((size_t)u64 * 4 + (j_)) * 4 + sl) * 4 + mt) * 64 + lane) * 4); } while (0)
#define CP_STEP(gf_, hf_, useh_) do { _Pragma("unroll") for (int sl = 0; sl < 4; ++sl) { bf16x8 zb[2]; RW_ZB(z[sl], zb); \
            _Pragma("unroll") for (int mt = 0; mt < 4; ++mt) { f32x4 a_ = (f32x4){0.f, 0.f, 0.f, 0.f}; \
                if (useh_) { a_[0] = bflo(hf_[sl][mt].x); a_[1] = bfhi(hf_[sl][mt].x); a_[2] = bflo(hf_[sl][mt].y); a_[3] = bfhi(hf_[sl][mt].y); } \
                a_ = __builtin_amdgcn_mfma_f32_16x16x32_bf16(gf_[mt][0], zb[0], a_, 0, 0, 0); a_ = __builtin_amdgcn_mfma_f32_16x16x32_bf16(gf_[mt][1], zb[1], a_, 0, 0, 0); z[sl][mt] = a_; } } } while (0)
        {
            f32x4 z[4][4];
#pragma unroll
            for (int sl = 0; sl < 4; ++sl)
#pragma unroll
                for (int mt = 0; mt < 4; ++mt)
#pragma unroll
                    for (int e = 0; e < 4; ++e) z[sl][mt][e] = (sl == mt && 4 * g + e == l15) ? 1.0f : 0.0f;
            bf16x8 gA[4][2], gB[4][2]; u32x2 hdum[4][4];
            CP_LOADG(gA, 0); CP_LOADG(gB, 1);
            CP_STEP(gA, hdum, false); CP_LOADG(gA, 2);
            CP_STEP(gB, hdum, false); CP_LOADG(gB, 3);
            CP_STEP(gA, hdum, false);
            CP_STEP(gB, hdum, false);
            LAS bf16* tg = (LAS bf16*)(lds + wave * 16384);
#pragma unroll
            for (int sl = 0; sl < 4; ++sl) { const int pc = 32 * (sl >> 1) + 8 * (l15 >> 2) + 4 * (sl & 1) + (l15 & 3);
#pragma unroll
                for (int mt = 0; mt < 4; ++mt)
#pragma unroll
                    for (int e = 0; e < 4; ++e) tg[(16 * mt + 4 * g + e) * 64 + pc] = (bf16)f2bf(z[sl][mt][e]); }
            u32x4* gc = (u32x4*)((bf16*)(ws + WS_GC) + (size_t)u64 * 4096);
#pragma unroll
            for (int i = 0; i < 8; ++i) gc[i * 64 + lane] = *(const LAS u32x4*)(tg + (i * 64 + lane) * 8);
        }
        {
            f32x4 z[4][4];
#pragma unroll
            for (int sl = 0; sl < 4; ++sl)
#pragma unroll
                for (int mt = 0; mt < 4; ++mt) z[sl][mt] = (f32x4){0.f, 0.f, 0.f, 0.f};
            bf16x8 gA[4][2], gB[4][2]; u32x2 hA[4][4], hB[4][4];
            CP_LOADG(gA, 0); CP_LOADH(hA, 0); CP_LOADG(gB, 1); CP_LOADH(hB, 1);
            CP_STEP(gA, hA, true); CP_LOADG(gA, 2); CP_LOADH(hA, 2);
            CP_STEP(gB, hB, true); CP_LOADG(gB, 3); CP_LOADH(hB, 3);
            CP_STEP(gA, hA, true);
            CP_STEP(gB, hB, true);
#pragma unroll
            for (int sl = 0; sl < 4; ++sl)
#pragma unroll
                for (int mt = 0; mt < 4; ++mt) { u32x2 w; w.x = pk2(z[sl][mt][0], z[sl][mt][1]); w.y = pk2(z[sl][mt][2], z[sl][mt][3]);
                    *(u32x2*)((bf16*)(ws + WS_HC) + ((size_t)((u64 * 4 + sl) * 4 + mt) * 64 + lane) * 4) = w; }
        }
#undef CP_LOADG
#undef CP_LOADH
#undef CP_STEP
        }
        }
    }
    SEAM(3);


    if (IN(4)) { PHASE_IDS;
        if (!(bid < 128 && wave == 0)) {
            const int wi = bid < 128 ? bid * 7 + (wave - 1) : 896 + (bid - 128) * 8 + wave, NW = 896 + (G - 128) * 8;
        } else {
            const int l15 = lane & 15, g = lane >> 4, bh = bid >> 2, vs = bid & 3;
            f32x4 z[4];
#pragma unroll
            for (int mt = 0; mt < 4; ++mt) z[mt] = (f32x4){0.f, 0.f, 0.f, 0.f};
            bf16x8 gA[4][2], gB[4][2], gC[4][2], gD[4][2]; u32x2 hA[4], hB[4], hC[4], hD[4];
#define SC_LOAD(gf, hf, C) do { const size_t u64_ = (size_t)bh * 64 + (C); const bf16* gp_ = (const bf16*)(ws + WS_GC) + u64_ * 4096 + l15 * 64 + 8 * g; \
                _Pragma("unroll") for (int mt = 0; mt < 4; ++mt) { gf[mt][0] = *(const bf16x8*)(gp_ + mt * 1024); gf[mt][1] = *(const bf16x8*)(gp_ + mt * 1024 + 32); \
                    hf[mt] = *(const u32x2*)((const bf16*)(ws + WS_HC) + ((size_t)((u64_ * 4 + vs) * 4 + mt) * 64 + lane) * 4); } } while (0)
#define SC_STEP(gf, hf, C) do { const size_t u64_ = (size_t)bh * 64 + (C); bf16* zs_ = (bf16*)(ws + WS_ZS) + ((size_t)((u64_ * 4 + vs) * 4) * 64 + lane) * 4; \
                _Pragma("unroll") for (int mt = 0; mt < 4; ++mt) { u32x2 zw_; zw_.x = pk2(z[mt][0], z[mt][1]); zw_.y = pk2(z[mt][2], z[mt][3]); *(u32x2*)(zs_ + mt * 256) = zw_; } \
                bf16x8 zb[2]; RW_ZB(z, zb); \
                _Pragma("unroll") for (int mt = 0; mt < 4; ++mt) { f32x4 a; a[0] = bflo(hf[mt].x); a[1] = bfhi(hf[mt].x); a[2] = bflo(hf[mt].y); a[3] = bfhi(hf[mt].y); \
                    a = __builtin_amdgcn_mfma_f32_16x16x32_bf16(gf[mt][0], zb[0], a, 0, 0, 0); a = __builtin_amdgcn_mfma_f32_16x16x32_bf16(gf[mt][1], zb[1], a, 0, 0, 0); z[mt] = a; } } while (0)
            bf16x8 gE[4][2]; u32x2 hE[4];
            SC_LOAD(gA, hA, 0); SC_LOAD(gB, hB, 1); SC_LOAD(gC, hC, 2); SC_LOAD(gD, hD, 3);
#pragma unroll 1
            for (int C = 0; C < 60; C += 5) {
                SC_LOAD(gE, hE, C + 4);
                SC_STEP(gA, hA, C);     SC_LOAD(gA, hA, C + 5);
                SC_STEP(gB, hB, C + 1); SC_LOAD(gB, hB, C + 6);
                SC_STEP(gC, hC, C + 2); SC_LOAD(gC, hC, C + 7);
                SC_STEP(gD, hD, C + 3); SC_LOAD(gD, hD, C + 8);
                SC_STEP(gE, hE, C + 4);
            }
            SC_STEP(gA, hA, 60); SC_STEP(gB, hB, 61); SC_STEP(gC, hC, 62); SC_STEP(gD, hD, 63);
#undef SC_LOAD
#undef SC_STEP
        }
    }
    if (IN(4)) { PHASE_IDS;
        if (bid < 32 && wave == 1) { const int bc = bid; const f32x2* ag = (const f32x2*)((const float*)(ws + WS_AP)) + (size_t)(bc * 64) * 64 + lane;
            float* car = (float*)(ws + WS_AP + 4 * MiB) + (size_t)(bc * 64) * 64 + lane; float hst = 0.f;
            f32x2 abv[64];
#pragma unroll
            for (int sg = 0; sg < 64; ++sg) abv[sg] = ag[(size_t)sg * 64];
#pragma unroll
            for (int sg = 0; sg < 64; ++sg) { car[(size_t)sg * 64] = hst; hst = abv[sg].x * hst + abv[sg].y; } }
    }
    if (IN(4)) { PHASE_IDS;
        bf16* WKt = HN; bf16* VWt = HN + (size_t)4 * 1024 * 1024;
        __syncthreads();
        if (bid >= 128 && bid < 192) { pg8::FoldSched<0> S; S.A = (const char*)KM; S.B = (const char*)Wq_t; S.G = 64; S.c = bid - 128; EpiFold<0> E{(unsigned char*)WKt}; pg8::gemm_phase(lds, 256, S, E, wv0, 1024); }
        else if (bid >= 192) { pg8::FoldSched<1> S; S.A = (const char*)Wo_t; S.B = (const char*)VT; S.G = 64; S.c = bid - 192; EpiFold<1> E{(unsigned char*)VWt}; pg8::gemm_phase(lds, 256, S, E, wv0, 1024); }
    }
    SEAM(4);

    if (IN(5)) { PHASE_IDS;
        {
            for (int lu = gw; lu < (M / 64) * 8; lu += NGW) {
                const int seg = lu >> 3, nb = lu & 7, rr = lane >> 3, cq = lane & 7;
                const float* cp = (const float*)(ws + WS_AP + 4 * MiB) + ((size_t)(((seg >> 6) * 8 + nb) * 64 + (seg & 63)) * 64 + 8 * cq);
                const f32x4 c0 = *(const f32x4*)cp, c1 = *(const f32x4*)(cp + 4);
#pragma unroll 1
                for (int ih = 0; ih < 2; ++ih) {
                u32x4 pws[4], hws[4], gws[4];
#pragma unroll
                for (int i4 = 0; i4 < 4; ++i4) { const int it = 4 * ih + i4; const size_t m = (size_t)seg * 64 + 8 * it + rr; const size_t o = m * 512 + nb * 64 + 8 * cq;
                    pws[i4] = __builtin_nontemporal_load((const u32x4*)(LA + o)); hws[i4] = __builtin_nontemporal_load((const u32x4*)(LB + o)); gws[i4] = __builtin_nontemporal_load((const u32x4*)(U + m * INW + 512 + nb * 64 + 8 * cq)); }
#pragma unroll
                for (int i4 = 0; i4 < 4; ++i4) { const int it = 4 * ih + i4; const size_t m = (size_t)seg * 64 + 8 * it + rr;
                    const u32x4 pw = pws[i4], hw = hws[i4], gw_ = gws[i4];
                    float y[8];
#pragma unroll
                    for (int q = 0; q < 4; ++q) { const float ca = q < 2 ? c0[2 * q] : c1[2 * q - 4], cb = q < 2 ? c0[2 * q + 1] : c1[2 * q - 3];
                        y[2 * q] = (bflo(hw[q]) + bflo(pw[q]) * ca) * gelu_tanh_f(bflo(gw_[q])); y[2 * q + 1] = (bfhi(hw[q]) + bfhi(pw[q]) * cb) * gelu_tanh_f(bfhi(gw_[q])); }
                    u32x4 w; w.x = pk2(y[0], y[1]); w.y = pk2(y[2], y[3]); w.z = pk2(y[4], y[5]); w.w = pk2(y[6], y[7]);
                    *(u32x4*)(CAT + m * 1024 + nb * 64 + 8 * cq) = w; }
                }
            }
        }
        const int l15 = lane & 15, g = lane >> 4;
        LAS bf16* tGL = (LAS bf16*)(lds + wave * 16384); LAS bf16* tAD = tGL + 1024; LAS bf16* tOUT = tGL + 2048;
        const int ct = lane >> 3, cc = lane & 7;
        for (int u64 = gw; u64 < NB * NH * (SEQ / 64); u64 += NGW) {
            const int bh = u64 >> 6, C = u64 & 63, b = bh >> 3, h = bh & 7;
            f32x4 z[4][4];
#pragma unroll
            for (int sl = 0; sl < 4; ++sl)
#pragma unroll
                for (int mt = 0; mt < 4; ++mt) { const u32x2 zw = *(const u32x2*)((const bf16*)(ws + WS_ZS) + ((size_t)((u64 * 4 + sl) * 4 + mt) * 64 + lane) * 4); z[sl][mt] = (f32x4){bflo(zw.x), bfhi(zw.x), bflo(zw.y), bfhi(zw.y)}; }
#pragma unroll 1
            for (int j = 0; j < 4; ++j) {
                const size_t un = (size_t)u64 * 4 + j; const size_t m0 = (size_t)b * SEQ + (C * 4 + j) * 16;
                const bf16* rp = (const bf16*)(ws + WS_RP) + un * 1024 + l15 * 64 + 8 * g;
                const bf16x8 rf0 = __builtin_nontemporal_load((const bf16x8*)rp), rf1 = __builtin_nontemporal_load((const bf16x8*)(rp + 32));
                f32x4 y[4];
#pragma unroll
                for (int sl = 0; sl < 4; ++sl) y[sl] = __builtin_nontemporal_load((const f32x4*)((const float*)(ws + WS_Y1F) + ((size_t)(un * 4 + sl) * 64 + lane) * 4));
                const size_t rg = (m0 + ct) * 512 + h * 64 + 8 * cc;
                const u32x4 gl0 = __builtin_nontemporal_load((const u32x4*)((const bf16*)(ws + WS_G) + rg)), gl1 = __builtin_nontemporal_load((const u32x4*)((const bf16*)(ws + WS_G) + rg + 8 * 512));
                const u32x4 ad0 = __builtin_nontemporal_load((const u32x4*)((const bf16*)(ws + WS_ADD) + rg)), ad1 = __builtin_nontemporal_load((const u32x4*)((const bf16*)(ws + WS_ADD) + rg + 8 * 512));
                bf16x8 gf[4][2]; u32x2 hfr[4][4];
                if (j < 3) {
                    const bf16* gp = (const bf16*)(ws + WS_GP) + un * 4096 + l15 * 64 + 8 * g;
#pragma unroll
                    for (int mt = 0; mt < 4; ++mt) { gf[mt][0] = __builtin_nontemporal_load((const bf16x8*)(gp + mt * 1024)); gf[mt][1] = __builtin_nontemporal_load((const bf16x8*)(gp + mt * 1024 + 32)); }
#pragma unroll
                    for (int sl = 0; sl < 4; ++sl)
#pragma unroll
                        for (int mt = 0; mt < 4; ++mt) hfr[sl][mt] = __builtin_nontemporal_load((const u32x2*)((const bf16*)(ws + WS_HF) + ((size_t)((un * 4 + sl) * 4 + mt) * 64 + lane) * 4));
                }
                *(LAS u32x4*)(tGL + ct * 64 + 8 * cc) = gl0; *(LAS u32x4*)(tGL + (ct + 8) * 64 + 8 * cc) = gl1;
                *(LAS u32x4*)(tAD + ct * 64 + 8 * cc) = ad0; *(LAS u32x4*)(tAD + (ct + 8) * 64 + 8 * cc) = ad1;
                bf16x8 zb[4][2];
#pragma unroll
                for (int sl = 0; sl < 4; ++sl) { RW_ZB(z[sl], zb[sl]);
                    y[sl] = __builtin_amdgcn_mfma_f32_16x16x32_bf16(rf0, zb[sl][0], y[sl], 0, 0, 0); y[sl] = __builtin_amdgcn_mfma_f32_16x16x32_bf16(rf1, zb[sl][1], y[sl], 0, 0, 0); }
#pragma unroll
                for (int e = 0; e < 4; ++e) {
                    float s1 = (y[0][e] + y[1][e]) + (y[2][e] + y[3][e]);
                    s1 += __shfl_xor(s1, 1); s1 += __shfl_xor(s1, 2); s1 += __shfl_xor(s1, 4); s1 += __shfl_xor(s1, 8);
                    const float mean = s1 * (1.0f / 64.0f);
                    float d0 = y[0][e] - mean, d1 = y[1][e] - mean, d2 = y[2][e] - mean, d3 = y[3][e] - mean;
                    float s2 = (d0 * d0 + d1 * d1) + (d2 * d2 + d3 * d3);
                    s2 += __shfl_xor(s2, 1); s2 += __shfl_xor(s2, 2); s2 += __shfl_xor(s2, 4); s2 += __shfl_xor(s2, 8);
                    const float rstd = rsq_f(s2 * (1.0f / 64.0f) + GN_EPS);
                    const float dd[4] = {d0, d1, d2, d3};
#pragma unroll
                    for (int sl = 0; sl < 4; ++sl) { const int ti_ = (4 * g + e) * 64 + 16 * sl + l15;
                        const float o = dd[sl] * rstd * bf2f(tGL[ti_]) + bf2f(tAD[ti_]); tOUT[ti_] = (bf16)f2bf(o); }
                }
                { bf16* cp = CAT + (m0 + ct) * 1024 + 512 + h * 64 + 8 * cc;
                  *(u32x4*)cp = *(const LAS u32x4*)(tOUT + ct * 64 + 8 * cc); *(u32x4*)(cp + 8 * 1024) = *(const LAS u32x4*)(tOUT + (ct + 8) * 64 + 8 * cc); }
                if (j < 3) {
#pragma unroll
                    for (int sl = 0; sl < 4; ++sl)
#pragma unroll
                        for (int mt = 0; mt < 4; ++mt) { const u32x2 hh = hfr[sl][mt];
                            f32x4 a; a[0] = bflo(hh.x); a[1] = bfhi(hh.x); a[2] = bflo(hh.y); a[3] = bfhi(hh.y);
                            a = __builtin_amdgcn_mfma_f32_16x16x32_bf16(gf[mt][0], zb[sl][0], a, 0, 0, 0); a = __builtin_amdgcn_mfma_f32_16x16x32_bf16(gf[mt][1], zb[sl][1], a, 0, 0, 0); z[sl][mt] = a; }
                }
            }
        }
    }
    SEAM(5);
#undef RW_ZB


    if (IN(6)) { PHASE_IDS;
        pg8::DenseSched S; S.o.init_tiles(M / 256, D / 256, G, bid); S.A = (const char*)CAT; S.B = (const char*)Wout_t; S.tstep = (size_t)256 * D * 2;
        EpiBf16Res<false> E{args.in[I_X], X1, D, (float*)(ws + WS_AP + 2 * MiB), 1.0f, X1F8}; pg8::gemm_phase(lds, D, S, E, wv0);
    }
    SEAM(6);
    if (IN(7)) { PHASE_IDS;
        pg8::BatchBSched S; S.o.init_tiles(M / 256, D / 256, G, bid); S.A = (const char*)X1F8; S.B = (const char*)HN; S.tstep = (size_t)256 * 1024; S.bstep = (size_t)1024 * 1024;
        EpiSoftmax E{(unsigned char*)Qb, 0.0625f * 0.25f, (const float*)(ws + WS_AP + 2 * MiB), (LAS float*)(lds + RING_BYTES + 1024), (LAS float*)(lds + RING_BYTES + 1024 + 4096)};
        pg8::gemm_phase<EpiSoftmax, pg8::BatchBSched, true, true>(lds, 512, S, E, wv0);
    }
    SEAM(7);
    if (IN(8)) { PHASE_IDS;
        pg8::BatchBSched S; S.o.init_tiles(M / 256, D / 256, G, bid); S.A = (const char*)Qb; S.B = (const char*)(HN + (size_t)4 * 1024 * 1024); S.tstep = (size_t)256 * 1024; S.bstep = (size_t)1024 * 1024;
        EpiBf16Res<true> E{X1, X2, D, nullptr, 1.0f / 1024.0f, nullptr}; pg8::gemm_phase<EpiBf16Res<true>, pg8::BatchBSched, true, true>(lds, 512, S, E, wv0);
    }
    SEAM(8);
    if (IN(9)) { PHASE_IDS;
        for (int cid = tid; cid < 2 * NE * 128; cid += NTHREADS) { const int t = cid >> 12, row = (cid >> 7) & 31, c = cid & 127;
            *(LAS u32x4*)(lds + t * 65536 + row * 2048 + ((c ^ (row & 7)) << 4)) = *(const u32x4*)(WrT + (size_t)t * NE * D + row * D + 8 * c); }
        __syncthreads();
        const int l15 = lane & 15, g = lane >> 4;
        LAS float* LG = (LAS float*)(lds + RING_BYTES + 1024 + wave * 2304);
        const float* gfn = args.in[I_NFFG];
        LAS unsigned* cntl = (LAS unsigned*)(lds + RING_BYTES + 640);
        for (int t0 = 0; t0 < M / 16; t0 += G * 4) {
        if (tid < 64) cntl[tid] = 0u;
        __syncthreads();
        if (t0 == 0 && wave >= 4) {
            constexpr int I_DN = 16 * 32, I_GU = 16 * 64;
            for (int r = bid * 4 + (wave - 4); r < CONV_P9D; r += G * 4) { const int e = r / I_DN, q = r % I_DN, kb = q / 32, nb = q % 32;
                transpose_item_tiled_fp8_nolds(args.in[I_WDN] + (size_t)e * DFF * D, D, DFF, (unsigned char*)Wdn_t + (size_t)e * D * DFF, 64 * kb, 32 * nb, 32 * nb, lane); }
        }
        const int tile = t0 + bid * 4 + wave; const bool active = wave < 4 && tile < M / 16;
        int me = 0, lpos = 0, ai = 0; float mg = 0.f;
        if (active) {
            const int m0 = tile * 16;
            const bf16* xrow = X2 + (size_t)(m0 + l15) * D + 8 * g;
            float ss = 0.f;
#pragma unroll 8
            for (int ks = 0; ks < 32; ++ks) { const u32x4 xw = *(const u32x4*)(xrow + 32 * ks);
#pragma unroll
                for (int q = 0; q < 4; ++q) { const float a = bflo(xw[q]), c = bfhi(xw[q]); ss += a * a + c * c; } }
            ss += __shfl_xor(ss, 16); ss += __shfl_xor(ss, 32);
            const float rstd = rsq_f(ss * (1.f / D) + EPS);
            f32x4 acc0 = (f32x4){0.f, 0.f, 0.f, 0.f}, acc1 = acc0;
            unsigned char* hrow = (unsigned char*)HN + (size_t)(m0 + l15) * D + 8 * g;
#pragma unroll 2
            for (int ks = 0; ks < 32; ++ks) {
                const f32x4 g0 = *(const f32x4*)(gfn + 32 * ks + 8 * g), g1 = *(const f32x4*)(gfn + 32 * ks + 8 * g + 4);
                const u32x4 xw = *(const u32x4*)(xrow + 32 * ks);
                float hf[8];
#pragma unroll
                for (int q = 0; q < 4; ++q) { hf[2 * q] = bflo(xw[q]) * rstd * (q < 2 ? g0[2 * q] : g1[2 * q - 4]); hf[2 * q + 1] = bfhi(xw[q]) * rstd * (q < 2 ? g0[2 * q + 1] : g1[2 * q - 3]); }
                u32x4 hi, lo;
#pragma unroll
                for (int q = 0; q < 4; ++q) { hi[q] = pk2(hf[2 * q], hf[2 * q + 1]); lo[q] = pk2(hf[2 * q] - bflo(hi[q]), hf[2 * q + 1] - bfhi(hi[q])); }
                { u32x2 h8; h8.x = pk4_fp8(hf[0], hf[1], hf[2], hf[3]); h8.y = pk4_fp8(hf[4], hf[5], hf[6], hf[7]); *(u32x2*)(hrow + 32 * ks) = h8; }
                const bf16x8 ah = __builtin_bit_cast(bf16x8, hi), al = __builtin_bit_cast(bf16x8, lo);
                const int c = 4 * ks + g;
#pragma unroll
                for (int nt = 0; nt < 2; ++nt) { const int row = 16 * nt + l15; const int off = row * 2048 + ((c ^ (row & 7)) << 4);
                    const bf16x8 bh = *(const LAS bf16x8*)(lds + off), bl = *(const LAS bf16x8*)(lds + 65536 + off);
                    f32x4 a = nt ? acc1 : acc0;
                    a = __builtin_amdgcn_mfma_f32_16x16x32_bf16(ah, bh, a, 0, 0, 0); a = __builtin_amdgcn_mfma_f32_16x16x32_bf16(ah, bl, a, 0, 0, 0); a = __builtin_amdgcn_mfma_f32_16x16x32_bf16(al, bh, a, 0, 0, 0);
                    if (nt) acc1 = a; else acc0 = a; }
            }
            { const float b0 = args.in[I_BR][l15], b1 = args.in[I_BR][16 + l15];
#pragma unroll
              for (int j = 0; j < 4; ++j) { LG[(4 * g + j) * 33 + l15] = acc0[j] + b0; LG[(4 * g + j) * 33 + 16 + l15] = acc1[j] + b1; } }
            const int rrow = lane >> 2, qq = lane & 3;
            float tv[4] = {-3.0e38f, -3.0e38f, -3.0e38f, -3.0e38f}; int ti[4] = {64, 65, 66, 67};
#define TOP_INS(xv_, xi_) do { float x_ = (xv_); int i_ = (xi_); _Pragma("unroll") for (int p_ = 0; p_ < 4; ++p_) { const bool b_ = x_ > tv[p_] || (x_ == tv[p_] && i_ < ti[p_]); \
                const float ov_ = tv[p_]; const int oi_ = ti[p_]; tv[p_] = b_ ? x_ : ov_; ti[p_] = b_ ? i_ : oi_; x_ = b_ ? ov_ : x_; i_ = b_ ? oi_ : i_; } } while (0)
#pragma unroll
            for (int j = 0; j < 8; ++j) TOP_INS(LG[rrow * 33 + 8 * qq + j], 8 * qq + j);
#pragma unroll
            for (int st = 1; st < 4; st <<= 1) { float pv[4]; int pi[4];
#pragma unroll
                for (int p = 0; p < 4; ++p) { pv[p] = __shfl_xor(tv[p], st); pi[p] = __shfl_xor(ti[p], st); }
#pragma unroll
                for (int p = 0; p < 4; ++p) TOP_INS(pv[p], pi[p]); }
#undef TOP_INS
            const float e1 = __expf(tv[1] - tv[0]), e2 = __expf(tv[2] - tv[0]), e3 = __expf(tv[3] - tv[0]);
            const float inv = rcp_f(1.0f + e1 + e2 + e3);
            me = qq == 0 ? ti[0] : qq == 1 ? ti[1] : qq == 2 ? ti[2] : ti[3];
            mg = (qq == 0 ? 1.0f : qq == 1 ? e1 : qq == 2 ? e2 : e3) * inv;
            lpos = (int)__hip_atomic_fetch_add(cntl + me, 1u, __ATOMIC_RELAXED, __HIP_MEMORY_SCOPE_WORKGROUP);
            ai = (m0 + rrow) * 4 + qq;
        }
        __syncthreads();
        if (tid < NE) { const unsigned c = cntl[tid]; cntl[32 + tid] = c ? atomicAdd(ecnt + 64 * tid, c) : 0u; }
        __syncthreads();
        if (active) { route_e[ai] = me; route_pos[ai] = (int)cntl[32 + me] + lpos; route_g[ai] = mg; }
        __syncthreads();
        }
        { LAS float* scr = (LAS float*)(lds + wave * 16384); constexpr int I_GU = 16 * 64;
          for (int r = gw; r < CONV_P9; r += NGW) { const int e = r / I_GU, q = r % I_GU, kb = q / 64, nb = q % 64; const int n0 = 32 * nb;
              const int drow = n0 < 1024 ? (256 * (n0 >> 7) + (n0 & 127)) : (256 * ((n0 - 1024) >> 7) + 128 + ((n0 - 1024) & 127));
              transpose_item_tiled_fp8(args.in[I_WGU] + (size_t)e * D * 2048, 2048, D, (unsigned char*)Wgu_t + (size_t)e * 2048 * D, 64 * kb, n0, drow, scr, lane); } }
    }
    SEAM(9);
    if (IN(10)) { PHASE_IDS;
        LAS int* pst = (LAS int*)lds;
        if (wave == 0) {
            const int c = lane < NE ? (int)__hip_atomic_load(ecnt + 64 * lane, __ATOMIC_RELAXED, __HIP_MEMORY_SCOPE_AGENT) : 0; const int pc = (c + 255) & ~255;
            int x = pc;
#pragma unroll
            for (int d = 1; d < 32; d <<= 1) { const int y = __shfl_up(x, d); if (lane >= d) x += y; }
            if (lane < NE) { pst[lane] = x - pc; pst[64 + lane] = c; } if (lane == NE - 1) pst[32] = x; }
        __syncthreads();
        for (int ai = bid * NTHREADS + tid; ai < NASSIGN; ai += G * NTHREADS) {
            const int e = route_e[ai]; const int row = pst[e] + route_pos[ai]; { u32x2 sg_; sg_.x = (unsigned)ai; sg_.y = __float_as_uint(route_g[ai]); row_sg[row] = sg_; } row_tok[row] = ai >> 2; }
        if (bid < NE) { const int e = bid, c = pst[64 + e], pe = (c + 255) & ~255; for (int p = c + tid; p < pe; p += NTHREADS) { u32x2 sg_; sg_.x = 0xffffffffu; sg_.y = 0u; row_sg[pst[e] + p] = sg_; row_tok[pst[e] + p] = 0; } }
        if (bid == 0 && tid == 0) tile_tab[0] = pst[32] >> 8;
        if (bid >= 128 && bid < 136) { const int nt = pst[32] >> 8, nN = bid < 132 ? 8 : 4; int* tab = (int*)(ws + WS_ROUTE + (bid < 132 ? RT_UGU : RT_UDN));
            for (int L = (bid & 3) * NTHREADS + tid; L < nt * nN; L += 4 * NTHREADS) { Unit uu; { const int nwg = nt * nN; int wgid = L; { const int q = nwg / 8, r = nwg % 8, xcd = wgid % 8, off = wgid / 8; wgid = (xcd < r ? xcd * (q + 1) : r * (q + 1) + (xcd - r) * q) + off; }
                    const int nig = 8 * nN, gid = wgid / nig, fm = gid * 8, gsz = (nt - fm) < 8 ? (nt - fm) : 8; uu.pm = fm + ((wgid % nig) % gsz); uu.pn = (wgid % nig) / gsz; uu.e = 0; }
                int e = 0;
#pragma unroll
                for (int st = 16; st >= 1; st >>= 1) { if ((pst[e + st] >> 8) <= uu.pm) e += st; }
                tab[L] = uu.pm | (uu.pn << 12) | (e << 16); } }
        __syncthreads();
    }
    SEAM(10);
    if (IN(11)) {
        const int ntiles = tile_tab[0];
        pg8::MoeGatherSched S; S.o.init_tiles(ntiles, 2048 / 256, G, bid); S.A = (const char*)HN; S.B = (const char*)Wgu_t; S.tile_e = tile_tab + 16; S.utab = (const int*)(ws + WS_ROUTE + RT_UGU); S.rtok = row_tok; S.tstep = (size_t)256 * 1024; S.estep = (size_t)2048 * 1024;
        EpiSwiglu E{ACT, args.in[I_BGU]}; pg8::gemm_phase<EpiSwiglu, pg8::MoeGatherSched, true, true>(lds, 512, S, E, wv0);
        if constexpr (CONV_P9D < NE * 16 * 32) { PHASE_IDS; LAS float* scr = (LAS float*)(lds + wave * 16384); constexpr int I_DN = 16 * 32;
          for (;;) { int c0 = 0; if (lane == 0) c0 = (int)atomicAdd(ctl + CW_CONV, 8u); c0 = __builtin_amdgcn_readfirstlane(c0);
              c0 += CONV_P9D; if (c0 >= NE * I_DN) break;
              for (int r = c0; r < c0 + 8; ++r) { const int e = r / I_DN, q = r % I_DN, kb = q / 32, nb = q % 32;
                  transpose_item_tiled_fp8(args.in[I_WDN] + (size_t)e * DFF * D, D, DFF, (unsigned char*)Wdn_t + (size_t)e * D * DFF, 64 * kb, 32 * nb, 32 * nb, scr, lane); } } }
    }
    SEAM(11);
    if (IN(12)) {
        const int ntiles = tile_tab[0];
        pg8::MoeSched S; S.o.init_tiles(ntiles, D / 256, G, bid); S.A = (const char*)ACT; S.B = (const char*)Wdn_t; S.tile_e = tile_tab + 16; S.utab = (const int*)(ws + WS_ROUTE + RT_UDN); S.tstep = (size_t)256 * 1024; S.estep = (size_t)1024 * 1024;
        EpiDown E{YS, args.in[I_BDN], row_sg}; pg8::gemm_phase<EpiDown, pg8::MoeSched, true, true>(lds, 512, S, E, wv0);
    }
    SEAM(12);
    if (IN(13)) { PHASE_IDS;
        const float* gfin = args.in[I_FNG];
        for (int m = gw; m < M; m += NGW) {
            float v[16]; float s = 0.f;
#pragma unroll
            for (int hf = 0; hf < 2; ++hf) { const u32x4 w = __builtin_nontemporal_load((const u32x4*)(X2 + (size_t)m * D + 512 * hf + 8 * lane));
#pragma unroll
                for (int q = 0; q < 4; ++q) { v[8 * hf + 2 * q] = bflo(w[q]); v[8 * hf + 2 * q + 1] = bfhi(w[q]); }
#pragma unroll
                for (int k = 0; k < 4; ++k) { const u32x2 y = __builtin_nontemporal_load((const u32x2*)((const unsigned char*)YS + (size_t)(m * 4 + k) * D + 512 * hf + 8 * lane));
#pragma unroll
                    for (int q = 0; q < 2; ++q) { const auto lo2 = __builtin_amdgcn_cvt_pk_f32_fp8((int)y[q], false), hi2 = __builtin_amdgcn_cvt_pk_f32_fp8((int)y[q], true);
                        v[8 * hf + 4 * q] += lo2[0] * 0.0625f; v[8 * hf + 4 * q + 1] += lo2[1] * 0.0625f; v[8 * hf + 4 * q + 2] += hi2[0] * 0.0625f; v[8 * hf + 4 * q + 3] += hi2[1] * 0.0625f; } } }
#pragma unroll
            for (int j = 0; j < 16; ++j) s += v[j] * v[j];
            const float rstd = rsq_f(wave_sum(s) * (1.f / D) + EPS);
#pragma unroll
            for (int hf = 0; hf < 2; ++hf) { const f32x4 g0 = *(const f32x4*)(gfin + 512 * hf + 8 * lane), g1 = *(const f32x4*)(gfin + 512 * hf + 8 * lane + 4);
                float* o = args.out + (size_t)m * D + 512 * hf + 8 * lane;
                __builtin_nontemporal_store((f32x4){v[8 * hf] * rstd * g0.x, v[8 * hf + 1] * rstd * g0.y, v[8 * hf + 2] * rstd * g0.z, v[8 * hf + 3] * rstd * g0.w}, (f32x4*)o);
                __builtin_nontemporal_store((f32x4){v[8 * hf + 4] * rstd * g1.x, v[8 * hf + 5] * rstd * g1.y, v[8 * hf + 6] * rstd * g1.z, v[8 * hf + 7] * rstd * g1.w}, (f32x4*)(o + 4)); }
        }
    }
#undef IN
#undef SEAM
}

constexpr int N_PHASES = 14;
extern "C" void kernel_launch(void* const* d_in, const int* in_sizes, int n_in, void* d_out, int out_size, void* d_ws, size_t ws_size, hipStream_t stream) {
    static int grid = 0;
    if (grid == 0) {
        if (n_in != 37 || out_size != M * D || ws_size < WS_END) { fprintf(stderr, "kernel_launch: unexpected shapes (n_in %d, out %d, ws %zu); nothing launched\n", n_in, out_size, ws_size); grid = -1; return; }
        int dev = 0, cus = 0, per_cu = 0;
        if (hipGetDevice(&dev) != hipSuccess || hipDeviceGetAttribute(&cus, hipDeviceAttributeMultiprocessorCount, dev) != hipSuccess) { grid = -1; return; }
        if (hipFuncSetAttribute((const void*)fwd, hipFuncAttributeMaxDynamicSharedMemorySize, LDS_BYTES) != hipSuccess) { fprintf(stderr, "kernel_launch: hipFuncSetAttribute failed\n"); grid = -1; return; }
        if (hipOccupancyMaxActiveBlocksPerMultiprocessor(&per_cu, (const void*)fwd, NTHREADS, LDS_BYTES) != hipSuccess || per_cu < 1) fprintf(stderr, "kernel_launch: occupancy query says %d\n", per_cu);
        (void)hipGetLastError();
        grid = cus > 256 ? 256 : cus;
    }
    if (grid < 0) return;
    if (hipMemsetAsync((char*)d_ws + WS_CTL, 0, CTL_ZERO_BYTES, stream) != hipSuccess) return;
    Args a{};
    for (int i = 0; i < 37; ++i) a.in[i] = (const float*)d_in[i];
    a.out = (float*)d_out; a.ws = (unsigned char*)d_ws;
#if MK_ONE_LAUNCH
    a.ph_lo = 0; a.ph_hi = N_PHASES;
    hipLaunchKernelGGL(fwd, dim3(grid), dim3(NTHREADS), LDS_BYTES, stream, a);
#else
    for (int p = 0; p < N_PHASES; ++p) { a.ph_lo = p; a.ph_hi = p + 1; hipLaunchKernelGGL(fwd, dim3(grid), dim3(NTHREADS), LDS_BYTES, stream, a);
#ifdef PROBE_REPEAT_PHASE
        if (p == PROBE_REPEAT_PHASE) hipLaunchKernelGGL(fwd, dim3(grid), dim3(NTHREADS), LDS_BYTES, stream, a);
#endif
    }
#endif
}
```

```cpp
#include <hip/hip_runtime.h>
#include <cstdio>
#include <cstdint>

#ifndef MK_ONE_LAUNCH
#define MK_ONE_LAUNCH 1
#endif

#define DI __device__ __forceinline__
#define GAS __attribute__((address_space(1)))
#define LAS __attribute__((address_space(3)))
typedef unsigned short bf16;
typedef short bf16x8 __attribute__((ext_vector_type(8)));
typedef int v4i __attribute__((ext_vector_type(4)));
typedef int v8i __attribute__((ext_vector_type(8)));
typedef float f32x4 __attribute__((ext_vector_type(4)));
typedef float f32x2 __attribute__((ext_vector_type(2)));
typedef unsigned u32x4 __attribute__((ext_vector_type(4)));
typedef unsigned u32x2 __attribute__((ext_vector_type(2)));

constexpr int D = 1024, NB = 4, SEQ = 4096, M = NB * SEQ;
constexpr int MEML = 256, MROWS = NB * MEML;
constexpr int LRU_W = 512, RW = 512, NH = 8, HD = 64;
constexpr int INW = 2816;
constexpr int XH = 4, XHD = 256;
constexpr int NE = 32, TOPK = 4, DFF = 1024;
constexpr int NASSIGN = M * TOPK;
constexpr int MAXTILES = 288, MAXROWS = MAXTILES * 256;
constexpr float EPS = 1e-6f, GN_EPS = 64e-5f;

DI int fresh_tid_(int wv) { int w = wv; asm volatile("" : "+s"(w)); int l; asm volatile("v_mbcnt_lo_u32_b32 %0, -1, 0\n\tv_mbcnt_hi_u32_b32 %0, -1, %0" : "=v"(l)); return (w << 6) | (l & 63); }
#define fresh_tid() fresh_tid_(wv0)
namespace pg8 {
constexpr int BM = 256, BK = 64, HALF = 128, HTB = HALF * BK * 2, STAGE_BYTES = 8 * HTB, NXCD = 8, WGM = 8;
__host__ __device__ __forceinline__ int lds_byte(int r, int c) { const int st = (r >> 4) * 2 + (c >> 5), rr = r & 15, cc = c & 31, ob = rr * 64 + cc * 2; return st * 1024 + (ob ^ (((ob >> 9) & 1) << 5)); }
__host__ __device__ __forceinline__ void stage_rc(int b, int& R, int& C) { const int st = b / 1024, sb = b % 1024, swz = sb ^ (((sb >> 9) & 1) << 5); R = (st >> 1) * 16 + swz / 64; C = (st & 1) * 32 + (swz % 64) / 2; }
__host__ __device__ __forceinline__ int perm32(int rho) { const int n = rho >> 4, i = rho & 15; return 8 * (i >> 2) + 4 * n + (i & 3); }

struct Unit { int pm, pn, e; };

struct StaticOrder {
    int nM, nN, nwg, G, c;
    __host__ __device__ void init_tiles(int nM_, int nN_, int G_, int c_) { nM = nM_; nN = nN_; nwg = nM * nN; G = G_; c = c_; }
    __host__ __device__ bool next(int i, Unit& u) const {
        const long L = (long)i * G + c; if (L >= nwg) return false;
        int wgid = (int)L; { const int q = nwg / NXCD, r = nwg % NXCD, xcd = wgid % NXCD, off = wgid / NXCD; wgid = (xcd < r ? xcd * (q + 1) : r * (q + 1) + (xcd - r) * q) + off; }
        const int nig = WGM * nN, gid = wgid / nig, fm = gid * WGM, gsz = (nM - fm) < WGM ? (nM - fm) : WGM;
        u.pm = fm + ((wgid % nig) % gsz); u.pn = (wgid % nig) / gsz; u.e = 0; return true;
    }
};
struct DenseSched {
    static constexpr bool GATHER = false, B_TILED = false;
    StaticOrder o; const char* A; const char* B; size_t tstep;
    DI bool next(int i, Unit& u) const { return o.next(i, u); }
    DI const char* a_ptr(const Unit& u) const { return A + (size_t)u.pm * tstep; }
    DI const char* b_ptr(const Unit& u) const { return B + (size_t)u.pn * tstep; }
    DI void a_voff(const Unit&, int K, const int (&R)[2], const int (&C)[2], unsigned (&vo)[2][2]) const {
#pragma unroll
        for (int h = 0; h < 2; ++h)
#pragma unroll
            for (int i = 0; i < 2; ++i) vo[h][i] = (unsigned)((h * HALF + R[i]) * K + C[i]) * 2u; }
};
struct MoeSched {
    static constexpr bool GATHER = false, B_TILED = true;
    StaticOrder o; const char* A; const char* B; const int* tile_e; const int* utab; size_t tstep, estep;
    DI bool next(int i, Unit& u) const { const int L = i * o.G + o.c; if (L >= o.nwg) return false; int en; asm volatile("s_load_dword %0, %1, 0x0\n\ts_waitcnt lgkmcnt(0)" : "=s"(en) : "s"(utab + L) : "memory");     u.pm = en & 0xfff; u.pn = (en >> 12) & 15; u.e = en >> 16; return true; }
    DI const char* a_ptr(const Unit& u) const { return A + (size_t)u.pm * tstep; }
    DI const char* b_ptr(const Unit& u) const { return B + (size_t)u.e * estep + (size_t)u.pn * tstep; }
    DI void a_voff(const Unit&, int K, const int (&R)[2], const int (&C)[2], unsigned (&vo)[2][2]) const {
#pragma unroll
        for (int h = 0; h < 2; ++h)
#pragma unroll
            for (int i = 0; i < 2; ++i) vo[h][i] = (unsigned)((h * HALF + R[i]) * K + C[i]) * 2u; }
};
struct MoeGatherSched {
    static constexpr bool GATHER = true, B_TILED = true;
    StaticOrder o; const char* A; const char* B; const int* tile_e; const int* utab; const int* rtok; size_t tstep, estep;
    DI bool next(int i, Unit& u) const { const int L = i * o.G + o.c; if (L >= o.nwg) return false; int en; asm volatile("s_load_dword %0, %1, 0x0\n\ts_waitcnt lgkmcnt(0)" : "=s"(en) : "s"(utab + L) : "memory");     u.pm = en & 0xfff; u.pn = (en >> 12) & 15; u.e = en >> 16; return true; }
    DI const char* a_ptr(const Unit&) const { return A; }
    DI const char* b_ptr(const Unit& u) const { return B + (size_t)u.e * estep + (size_t)u.pn * tstep; }
    DI void a_voff(const Unit& u, int K, const int (&R)[2], const int (&C)[2], unsigned (&vo)[2][2]) const {
#pragma unroll
        for (int h = 0; h < 2; ++h)
#pragma unroll
            for (int i = 0; i < 2; ++i) vo[h][i] = (unsigned)(rtok[u.pm * BM + h * HALF + R[i]] * K + C[i]) * 2u; }
};

struct BatchBSched {
    static constexpr bool GATHER = false, B_TILED = false;
    StaticOrder o; const char* A; const char* B; size_t tstep, bstep;
    DI bool next(int i, Unit& u) const { return o.next(i, u); }
    DI const char* a_ptr(const Unit& u) const { return A + (size_t)u.pm * tstep; }
    DI const char* b_ptr(const Unit& u) const { return B + (size_t)(u.pm >> 4) * bstep + (size_t)u.pn * tstep; }
    DI void a_voff(const Unit&, int K, const int (&R)[2], const int (&C)[2], unsigned (&vo)[2][2]) const {
#pragma unroll
        for (int h = 0; h < 2; ++h)
#pragma unroll
            for (int i = 0; i < 2; ++i) vo[h][i] = (unsigned)((h * HALF + R[i]) * K + C[i]) * 2u; }
};
template <int MODE> struct FoldSched {
    static constexpr bool GATHER = false, B_TILED = false;
    const char* A; const char* B; int G, c;
    DI bool next(int i, Unit& u) const { const int L = i * G + c; if (L >= 64) return false; u.pm = L >> 2; u.pn = L & 3; u.e = 0; return true; }
    DI const char* a_ptr(const Unit& u) const { const int b = u.pm >> 2, h = u.pm & 3; return A + ((size_t)(MODE == 0 ? b * 256 : u.pn * 256) * 1024 + h * 256) * 2; }
    DI const char* b_ptr(const Unit& u) const { const int b = u.pm >> 2, h = u.pm & 3; return B + ((size_t)(MODE == 0 ? u.pn * 256 : b * 256) * 1024 + h * 256) * 2; }
    DI void a_voff(const Unit&, int K, const int (&R)[2], const int (&C)[2], unsigned (&vo)[2][2]) const {
#pragma unroll
        for (int h = 0; h < 2; ++h)
#pragma unroll
            for (int i = 0; i < 2; ++i) vo[h][i] = (unsigned)((h * HALF + R[i]) * K + C[i]) * 2u; }
};

DI unsigned cvt_pk_bf16(float lo, float hi) { unsigned r; asm volatile("v_cvt_pk_bf16_f32 %0, %1, %2" : "=v"(r) : "v"(lo), "v"(hi)); return r; }

template <class Epi, class Sched, bool ALIGN_EPI = true, bool FP8 = false>
DI void gemm_phase(LAS unsigned char* lds, const int K, const Sched& S, const Epi& E, const int wv0, const int ldp = 0) {
    const int ld = ldp ? ldp : K;
    const int tid = fresh_tid(), wid = __builtin_amdgcn_readfirstlane(tid >> 6), lane = tid & 63, wr = wid >> 2, wc = wid & 3, fr = lane & 15, fq = lane >> 4;
    const int nt = K / BK;
    constexpr bool GA = Sched::GATHER, BT = Sched::B_TILED;
    unsigned voffA[2][2], voffAn[2][2], voffB[2];
#pragma unroll
    for (int i = 0; i < 2; ++i) { int R, C; stage_rc(tid * 16 + i * 8192, R, C); const int Rb = Epi::PERM ? ((R & ~31) + perm32(R & 31)) : R;
        voffB[i] = BT ? (unsigned)(tid * 16 + i * 8192) : (unsigned)(Rb * ld + C) * 2u; }
#define PG8_AVOFF(unit, dst) do { int sR[2], sC[2]; const int t2_ = fresh_tid(); stage_rc(t2_ * 16, sR[0], sC[0]); stage_rc(t2_ * 16 + 8192, sR[1], sC[1]); S.a_voff(unit, ld, sR, sC, dst); } while (0)
    const size_t kstep = (size_t)(BK * 2);
    const size_t hstep = (size_t)HALF * ld * 2;
    const size_t kstepB = BT ? (size_t)(2 * HTB) : kstep, hstepB = BT ? (size_t)HTB : hstep;
    const unsigned ldsw = (unsigned)wid * 1024u;
    unsigned aoffv = (unsigned)(size_t)lds + (unsigned)lds_byte(wr * 64 + fr, fq * 8), boffv = (unsigned)(size_t)lds + (unsigned)(4 * HTB) + (unsigned)lds_byte(wc * 32 + fr, fq * 8);
    asm volatile("" : "+v"(aoffv), "+v"(boffv));
    const size_t dB = BT ? (size_t)8192 : (size_t)64 * ld * 2, dA = (size_t)64 * ld * 2;
#define PG8_SA(b, h) (((b) * 2 + (h)) * HTB)
#define PG8_SB(b, h) ((4 + (b) * 2 + (h)) * HTB)
    const unsigned ldsbase = (unsigned)__builtin_amdgcn_readfirstlane((int)((unsigned)(size_t)lds + ldsw));
#define PG8_STAGE1(bufoff, gptr, vo, i_) do { const unsigned m0v_ = ldsbase + (unsigned)(bufoff) + (unsigned)(i_) * 8192u; \
        asm volatile("s_mov_b32 m0, %2\n\ts_nop 0\n\tglobal_load_lds_dwordx4 %0, %1" :: "v"(vo), "s"((const char*)(gptr)), "s"(m0v_) : "memory", "m0"); } while (0)
#define PG8_STAGE(bufoff, gbase, voff) do { PG8_STAGE1(bufoff, gbase, (voff)[0], 0); PG8_STAGE1(bufoff, gbase, (voff)[1], 1); } while (0)
#define PG8_STAGE_D(bufoff, gbase, vo, delta) do { PG8_STAGE1(bufoff, gbase, vo, 0); PG8_STAGE1(bufoff, (const char*)(gbase) + (delta), vo, 1); } while (0)
#define PG8_LDA(dst, b, h) do { if constexpr (FP8) { _Pragma("unroll") for (int m = 0; m < 4; ++m) { const LAS v4i* p_ = (const LAS v4i*)((LAS unsigned char*)(size_t)aoffv + PG8_SA(b, h) + m * 2048); dst##8[m] = __builtin_shufflevector(p_[0], p_[64], 0, 1, 2, 3, 4, 5, 6, 7); } } \
        else { _Pragma("unroll") for (int m = 0; m < 4; ++m) _Pragma("unroll") for (int k = 0; k < 2; ++k) dst[m][k] = *(const LAS bf16x8*)((LAS unsigned char*)(size_t)aoffv + PG8_SA(b, h) + m * 2048 + k * 1024); } } while (0)
#define PG8_LDB(dst, b, h) do { if constexpr (FP8) { _Pragma("unroll") for (int n = 0; n < 2; ++n) { const LAS v4i* p_ = (const LAS v4i*)((LAS unsigned char*)(size_t)boffv + (PG8_SB(b, h) - 4 * HTB) + n * 2048); dst##8[n] = __builtin_shufflevector(p_[0], p_[64], 0, 1, 2, 3, 4, 5, 6, 7); } } \
        else { _Pragma("unroll") for (int n = 0; n < 2; ++n) _Pragma("unroll") for (int k = 0; k < 2; ++k) dst[n][k] = *(const LAS bf16x8*)((LAS unsigned char*)(size_t)boffv + (PG8_SB(b, h) - 4 * HTB) + n * 2048 + k * 1024); } } while (0)
#define PG8_MMA(ai, bj, At, Bt) do { __builtin_amdgcn_s_setprio(1); \
        if constexpr (FP8) {   \
            _Pragma("unroll") for (int m = 0; m < 4; ++m) _Pragma("unroll") for (int n = 0; n < 2; ++n) \
                acc[ai][bj][m][n] = __builtin_amdgcn_mfma_scale_f32_16x16x128_f8f6f4(Bt##8[n], At##8[m], acc[ai][bj][m][n], 0, 0, 0, 0, 0, 0); } \
        else { _Pragma("unroll") for (int m = 0; m < 4; ++m) _Pragma("unroll") for (int n = 0; n < 2; ++n) _Pragma("unroll") for (int k = 0; k < 2; ++k) \
            acc[ai][bj][m][n] = __builtin_amdgcn_mfma_f32_16x16x32_bf16(Bt[n][k], At[m][k], acc[ai][bj][m][n], 0, 0, 0); } \
        __builtin_amdgcn_s_setprio(0); } while (0)
#define PG8_WAIT_V(n) asm volatile("s_waitcnt vmcnt(" #n ")" ::: "memory")
#define PG8_WAIT_L(n) asm volatile("s_waitcnt lgkmcnt(" #n ")" ::: "memory")
#define PG8_BAR __builtin_amdgcn_s_barrier()
#define PG8_SCHED __builtin_amdgcn_sched_barrier(0)
    Unit cur, nxt; int ui = 0;
    if (!S.next(0, cur)) return;
    f32x4 acc[2][2][4][2];
#pragma unroll
    for (int a = 0; a < 2; ++a)
#pragma unroll
        for (int b = 0; b < 2; ++b)
#pragma unroll
            for (int m = 0; m < 4; ++m)
#pragma unroll
                for (int n = 0; n < 2; ++n) acc[a][b][m][n] = (f32x4){0.f, 0.f, 0.f, 0.f};
    bf16x8 At[4][2], B0[2][2], B1[2][2]; v8i At8[4], B08[2], B18[2];
    const char* cA = S.a_ptr(cur); const char* cB = S.b_ptr(cur);
    PG8_AVOFF(cur, voffA);
#define PG8_STAGE_A(bufoff, kbase, h, vo) do { if constexpr (GA) { PG8_STAGE(bufoff, kbase, (vo)[h]); } else { PG8_STAGE_D(bufoff, (kbase) + (h) * hstep, voffA[0][0], dA); } } while (0)
    PG8_STAGE_D(PG8_SB(0, 0), cB, voffB[0], dB); PG8_STAGE_D(PG8_SB(0, 1), cB + hstepB, voffB[0], dB); PG8_STAGE_A(PG8_SA(0, 0), cA, 0, voffA); PG8_STAGE_A(PG8_SA(0, 1), cA, 1, voffA);
    if (wr == 1) PG8_BAR;
    PG8_WAIT_V(2); PG8_BAR;
    PG8_STAGE_D(PG8_SB(1, 0), cB + kstepB, voffB[0], dB); PG8_STAGE_A(PG8_SA(1, 0), cA + kstep, 0, voffA); PG8_STAGE_D(PG8_SB(1, 1), cB + hstepB + kstepB, voffB[0], dB);
    PG8_WAIT_V(6); PG8_BAR;
    for (;;) {
        const bool has_next = S.next(ui + 1, nxt);
        const char* nA = has_next ? S.a_ptr(nxt) : cA; const char* nB = has_next ? S.b_ptr(nxt) : cB;
        if constexpr (GA) { if (has_next) { int sR[2], sC[2]; const int t2_ = fresh_tid(); stage_rc(t2_ * 16, sR[0], sC[0]); stage_rc(t2_ * 16 + 8192, sR[1], sC[1]);
#pragma unroll
                for (int h = 0; h < 2; ++h)
#pragma unroll
                    for (int i = 0; i < 2; ++i) { const unsigned to_ = (unsigned)(nxt.pm * BM + h * HALF + sR[i]) * 4u;
                        asm volatile("global_load_dword %0, %1, %2" : "=v"(voffAn[h][i]) : "v"(to_), "s"(S.rtok) : "memory"); } } }
#pragma unroll 1
        for (int t = 0; t < nt; t += 2) {
            const bool last = (t == nt - 2);
            const char* a1 = cA + (size_t)(t + 1) * kstep;
            const char* a2 = last ? nA : cA + (size_t)(t + 2) * kstep; const char* b2 = last ? nB : cB + (size_t)(t + 2) * kstepB;
            const char* a3 = a2 + kstep; const char* b3 = b2 + kstepB;
            PG8_LDB(B0, 0, 0); PG8_LDB(B1, 0, 1); PG8_SCHED; PG8_LDA(At, 0, 0); PG8_STAGE_A(PG8_SA(1, 1), a1, 1, voffA);
            if constexpr (GA) { if (last && has_next) {
                asm volatile("" : "+v"(voffAn[0][0]), "+v"(voffAn[0][1]), "+v"(voffAn[1][0]), "+v"(voffAn[1][1]));
                int sR[2], sC[2]; const int t2_ = fresh_tid(); stage_rc(t2_ * 16, sR[0], sC[0]); stage_rc(t2_ * 16 + 8192, sR[1], sC[1]);
#pragma unroll
                for (int h = 0; h < 2; ++h)
#pragma unroll
                    for (int i = 0; i < 2; ++i) voffA[h][i] = (voffAn[h][i] * (unsigned)ld + (unsigned)sC[i]) * 2u; } }
            PG8_WAIT_V(8); PG8_WAIT_L(0); PG8_BAR; PG8_MMA(0, 0, At, B0); PG8_MMA(0, 1, At, B1); PG8_BAR; PG8_SCHED;
            PG8_LDA(At, 0, 1); PG8_STAGE_D(PG8_SB(0, 0), b2, voffB[0], dB); PG8_STAGE_D(PG8_SB(0, 1), b2 + hstepB, voffB[0], dB); PG8_STAGE_A(PG8_SA(0, 0), a2, 0, voffA);
            PG8_WAIT_V(8); PG8_WAIT_L(0); PG8_BAR; PG8_MMA(1, 0, At, B0); PG8_MMA(1, 1, At, B1); PG8_BAR; PG8_SCHED;
            PG8_LDB(B0, 1, 0); PG8_LDB(B1, 1, 1); PG8_SCHED; PG8_LDA(At, 1, 0); PG8_STAGE_A(PG8_SA(0, 1), a2, 1, voffA);
            PG8_WAIT_V(8); PG8_WAIT_L(0); PG8_BAR; PG8_MMA(0, 0, At, B0); PG8_MMA(0, 1, At, B1); PG8_BAR; PG8_SCHED;
            PG8_LDA(At, 1, 1); PG8_STAGE_D(PG8_SB(1, 0), b3, voffB[0], dB); PG8_STAGE_D(PG8_SB(1, 1), b3 + hstepB, voffB[0], dB); PG8_STAGE_A(PG8_SA(1, 0), a3, 0, voffA);
            PG8_WAIT_V(8); PG8_WAIT_L(0); PG8_BAR; PG8_MMA(1, 0, At, B0); PG8_MMA(1, 1, At, B1); PG8_BAR; PG8_SCHED;
        }
        if constexpr (ALIGN_EPI) { if (wr == 0) PG8_BAR; }
        { Unit ue = cur; ue.pm = __builtin_amdgcn_readfirstlane(ue.pm); ue.pn = __builtin_amdgcn_readfirstlane(ue.pn); ue.e = __builtin_amdgcn_readfirstlane(ue.e); asm volatile("" : "+s"(ue.pm), "+s"(ue.pn), "+s"(ue.e));
          const int t3_ = fresh_tid(); const int fr_ = t3_ & 15, fq_ = (t3_ & 63) >> 4;
          E(acc, ue, wr, wc, fr_, fq_); }
        if (!has_next) break;
#pragma unroll
        for (int a = 0; a < 2; ++a)
#pragma unroll
            for (int b = 0; b < 2; ++b)
#pragma unroll
                for (int m = 0; m < 4; ++m)
#pragma unroll
                    for (int n = 0; n < 2; ++n) acc[a][b][m][n] = (f32x4){0.f, 0.f, 0.f, 0.f};
        cur = nxt; cA = nA; cB = nB; ++ui;
        if constexpr (ALIGN_EPI) { if (wr == 1) PG8_BAR; }
    }
    PG8_WAIT_V(0);
    if constexpr (!ALIGN_EPI) { if (wr == 0) PG8_BAR; }
    PG8_BAR;
#undef PG8_SA
#undef PG8_SB
#undef PG8_STAGE
#undef PG8_STAGE1
#undef PG8_STAGE_D
#undef PG8_STAGE_A
#undef PG8_AVOFF
#undef PG8_LDA
#undef PG8_LDB
#undef PG8_MMA
#undef PG8_WAIT_V
#undef PG8_WAIT_L
#undef PG8_BAR
#undef PG8_SCHED
}
}
using pg8::Unit;
using pg8::cvt_pk_bf16;

DI float bflo(unsigned w) { return __uint_as_float(w << 16); }
DI float bfhi(unsigned w) { return __uint_as_float(w & 0xffff0000u); }
DI float bf2f(bf16 b) { return __uint_as_float(((unsigned)b) << 16); }
typedef __bf16 hwbf2 __attribute__((ext_vector_type(2)));
DI unsigned pk2(float lo, float hi) { const f32x2 v = {lo, hi}; return __builtin_bit_cast(unsigned, __builtin_convertvector(v, hwbf2)); }
DI unsigned f2bf(float f) { return pk2(f, 0.f) & 0xffffu; }
DI float rcp_f(float x) { return __builtin_amdgcn_rcpf(x); }
DI float rsq_f(float x) { return __builtin_amdgcn_rsqf(x); }
DI float sigmoid_f(float x) { return rcp_f(1.0f + __expf(-x)); }
DI float tanh_fast(float x) { return 1.0f - 2.0f * rcp_f(__expf(2.0f * x) + 1.0f); }
DI float softplus_f(float x) { return fmaxf(x, 0.f) + __logf(1.0f + __expf(-fabsf(x))); }
DI float softplus_fast(float x) { return fmaxf(x, 0.f) + __logf(1.0f + __expf(-fabsf(x))); }
DI float gelu_tanh_f(float x) { const float u = 0.7978845608028654f * (x + 0.044715f * x * x * x); return 0.5f * x * (1.0f + tanh_fast(u)); }
DI float wave_sum(float v) {
#pragma unroll
    for (int o = 1; o < 64; o <<= 1) v += __shfl_xor(v, o);
    return v;
}

DI unsigned pk4_fp8(float a, float b, float c, float d) { int w = 0; w = __builtin_amdgcn_cvt_pk_fp8_f32(a, b, w, false); w = __builtin_amdgcn_cvt_pk_fp8_f32(c, d, w, true); return (unsigned)w; }
struct EpiBf16Plain {
    static constexpr bool PERM = true;
    bf16* O; int ldc; float scale;
    DI void operator()(const f32x4 (&acc)[2][2][4][2], const Unit& u, int wr, int wc, int fr, int fq) const {
        const int row0 = u.pm * 256 + wr * 64 + fr, col0 = u.pn * 256 + wc * 32 + 8 * fq;
#pragma unroll
        for (int ai = 0; ai < 2; ++ai)
#pragma unroll
            for (int m = 0; m < 4; ++m) { bf16* rowp = O + (size_t)(row0 + ai * 128 + m * 16) * ldc + col0;
#pragma unroll
                for (int bj = 0; bj < 2; ++bj) { const f32x4 v0 = acc[ai][bj][m][0] * scale, v1 = acc[ai][bj][m][1] * scale;
                    u32x4 w; w.x = cvt_pk_bf16(v0[0], v0[1]); w.y = cvt_pk_bf16(v0[2], v0[3]); w.z = cvt_pk_bf16(v1[0], v1[1]); w.w = cvt_pk_bf16(v1[2], v1[3]);
                    *(u32x4*)(rowp + bj * 128) = w; } }
    }
};
template <int MODE> struct EpiFold {
    static constexpr bool PERM = true;
    unsigned char* O;
    DI void operator()(const f32x4 (&acc)[2][2][4][2], const Unit& u, int wr, int wc, int fr, int fq) const {
        const int b = u.pm >> 2, h = u.pm & 3;
        const int rbase = MODE == 0 ? h * 256 : u.pn * 256, cbase = MODE == 0 ? u.pn * 256 : h * 256;
        const unsigned boff = (unsigned)b * 1024u * 1024u + (unsigned)(rbase + wr * 64 + fr) * 1024u + (unsigned)(cbase + wc * 32 + 8 * fq);
#pragma unroll
        for (int ai = 0; ai < 2; ++ai)
#pragma unroll
            for (int m = 0; m < 4; ++m) { unsigned char* rowp = O + (boff + (unsigned)(ai * 128 + m * 16) * 1024u);
#pragma unroll
                for (int bj = 0; bj < 2; ++bj) { const f32x4 v0 = acc[ai][bj][m][0] * 4.0f, v1 = acc[ai][bj][m][1] * 4.0f;
                    u32x2 w; w.x = pk4_fp8(v0[0], v0[1], v0[2], v0[3]); w.y = pk4_fp8(v1[0], v1[1], v1[2], v1[3]);
                    *(u32x2*)(rowp + bj * 128) = w; } }
    }
};
struct EpiSoftmax {
    static constexpr bool PERM = true;
    unsigned char* O; float scale; const float* RS; LAS float* XM; LAS float* XS;
    DI void operator()(const f32x4 (&acc)[2][2][4][2], const Unit& u, int wr, int wc, int fr, int fq) const {
        const int row0 = u.pm * 256 + wr * 64 + fr, col0 = u.pn * 256 + wc * 32 + 8 * fq;
        float sc[2][4];
#pragma unroll
        for (int ai = 0; ai < 2; ++ai)
#pragma unroll
            for (int m = 0; m < 4; ++m) { const int r = row0 + ai * 128 + m * 16; const f32x4* rp = (const f32x4*)(RS + (size_t)r * 16);
                const f32x4 p0 = rp[0], p1 = rp[1], p2 = rp[2], p3 = rp[3];
                const float ss = ((p0[0] + p0[1]) + (p0[2] + p0[3])) + ((p1[0] + p1[1]) + (p1[2] + p1[3])) + ((p2[0] + p2[1]) + (p2[2] + p2[3])) + ((p3[0] + p3[1]) + (p3[2] + p3[3]));
                sc[ai][m] = scale * __builtin_amdgcn_rsqf(ss * (1.0f / 1024.0f) + 1e-6f);
                float mm = -3.0e38f;
#pragma unroll
                for (int bj = 0; bj < 2; ++bj)
#pragma unroll
                    for (int n = 0; n < 2; ++n) { const f32x4 v = acc[ai][bj][m][n]; mm = fmaxf(mm, fmaxf(fmaxf(v[0], v[1]), fmaxf(v[2], v[3]))); }
                mm *= sc[ai][m];
                mm = fmaxf(mm, __shfl_xor(mm, 16)); mm = fmaxf(mm, __shfl_xor(mm, 32));
                if (fq == 0) XM[(ai * 128 + wr * 64 + m * 16 + fr) * 4 + wc] = mm; }
        asm volatile("s_waitcnt lgkmcnt(0)" ::: "memory"); __builtin_amdgcn_s_barrier(); asm volatile("" ::: "memory");
        f32x4 (&pa)[2][2][4][2] = const_cast<f32x4 (&)[2][2][4][2]>(acc);
#pragma unroll
        for (int ai = 0; ai < 2; ++ai)
#pragma unroll
            for (int m = 0; m < 4; ++m) { const int lr = ai * 128 + wr * 64 + m * 16 + fr; const f32x4 q = *(const LAS f32x4*)(XM + lr * 4);
                const float mxr = fmaxf(fmaxf(q[0], q[1]), fmaxf(q[2], q[3])); float sm = 0.f;
#pragma unroll
                for (int bj = 0; bj < 2; ++bj)
#pragma unroll
                    for (int n = 0; n < 2; ++n)
#pragma unroll
                        for (int j = 0; j < 4; ++j) { const float p = __expf(acc[ai][bj][m][n][j] * sc[ai][m] - mxr); pa[ai][bj][m][n][j] = p; sm += p; }
                sm += __shfl_xor(sm, 16); sm += __shfl_xor(sm, 32);
                if (fq == 0) XS[lr * 4 + wc] = sm; }
        asm volatile("s_waitcnt lgkmcnt(0)" ::: "memory"); __builtin_amdgcn_s_barrier(); asm volatile("" ::: "memory");
#pragma unroll
        for (int ai = 0; ai < 2; ++ai)
#pragma unroll
            for (int m = 0; m < 4; ++m) { const int lr = ai * 128 + wr * 64 + m * 16 + fr; const f32x4 q = *(const LAS f32x4*)(XS + lr * 4);
                const float inv = 256.0f * __builtin_amdgcn_rcpf((q[0] + q[1]) + (q[2] + q[3]));
                unsigned char* rowp = O + (size_t)(row0 + ai * 128 + m * 16) * 1024 + col0;
#pragma unroll
                for (int bj = 0; bj < 2; ++bj) { const f32x4 v0 = pa[ai][bj][m][0] * inv, v1 = pa[ai][bj][m][1] * inv;
                    u32x2 w; w.x = pk4_fp8(v0[0], v0[1], v0[2], v0[3]); w.y = pk4_fp8(v1[0], v1[1], v1[2], v1[3]);
                    *(u32x2*)(rowp + bj * 128) = w; } }
        asm volatile("s_waitcnt lgkmcnt(0)" ::: "memory"); __builtin_amdgcn_s_barrier(); asm volatile("" ::: "memory");
    }
};
struct EpiBf16RowNorm {
    static constexpr bool PERM = true;
    bf16* O; int ldc; float scale; const float* RS;
    DI void operator()(const f32x4 (&acc)[2][2][4][2], const Unit& u, int wr, int wc, int fr, int fq) const {
        const int row0 = u.pm * 256 + wr * 64 + fr, col0 = u.pn * 256 + wc * 32 + 8 * fq;
#pragma unroll
        for (int ai = 0; ai < 2; ++ai)
#pragma unroll
            for (int m = 0; m < 4; ++m) { const int r = row0 + ai * 128 + m * 16; const f32x4* rp = (const f32x4*)(RS + (size_t)r * 16);
                const f32x4 p0 = rp[0], p1 = rp[1], p2 = rp[2], p3 = rp[3];
                const float ss = ((p0[0] + p0[1]) + (p0[2] + p0[3])) + ((p1[0] + p1[1]) + (p1[2] + p1[3])) + ((p2[0] + p2[1]) + (p2[2] + p2[3])) + ((p3[0] + p3[1]) + (p3[2] + p3[3]));
                const float sc = scale * __builtin_amdgcn_rsqf(ss * (1.0f / 1024.0f) + 1e-6f);
                bf16* rowp = O + (size_t)r * ldc + col0;
#pragma unroll
                for (int bj = 0; bj < 2; ++bj) { const f32x4 v0 = acc[ai][bj][m][0] * sc, v1 = acc[ai][bj][m][1] * sc;
                    u32x4 w; w.x = cvt_pk_bf16(v0[0], v0[1]); w.y = cvt_pk_bf16(v0[2], v0[3]); w.z = cvt_pk_bf16(v1[0], v1[1]); w.w = cvt_pk_bf16(v1[2], v1[3]);
                    *(u32x4*)(rowp + bj * 128) = w; } }
    }
};
template <bool RES_BF16> struct EpiBf16Res {
    static constexpr bool PERM = true;
    const void* Rz; bf16* O; int ldc; float* RS; float ascale; unsigned char* O8;
    DI void operator()(const f32x4 (&acc)[2][2][4][2], const Unit& u, int wr, int wc, int fr, int fq) const {
        const int row0 = u.pm * 256 + wr * 64 + fr, col0 = u.pn * 256 + wc * 32 + 8 * fq;
#pragma unroll
        for (int ai = 0; ai < 2; ++ai) {
            u32x4 rwb[4][2]; f32x4 rf0[4][2], rf1[4][2];
#pragma unroll
            for (int m = 0; m < 4; ++m) { const size_t off = (size_t)(row0 + ai * 128 + m * 16) * ldc + col0;
#pragma unroll
                for (int bj = 0; bj < 2; ++bj) {
                    if (RES_BF16) rwb[m][bj] = __builtin_nontemporal_load((const u32x4*)((const bf16*)Rz + off + bj * 128));
                    else { rf0[m][bj] = __builtin_nontemporal_load((const f32x4*)((const float*)Rz + off + bj * 128)); rf1[m][bj] = __builtin_nontemporal_load((const f32x4*)((const float*)Rz + off + bj * 128 + 4)); } } }
#pragma unroll
            for (int m = 0; m < 4; ++m) { const size_t off = (size_t)(row0 + ai * 128 + m * 16) * ldc + col0; float ssq = 0.f;
#pragma unroll
                for (int bj = 0; bj < 2; ++bj) { f32x4 r0, r1;
                    if (RES_BF16) { const u32x4 rw = rwb[m][bj]; r0 = (f32x4){bflo(rw.x), bfhi(rw.x), bflo(rw.y), bfhi(rw.y)}; r1 = (f32x4){bflo(rw.z), bfhi(rw.z), bflo(rw.w), bfhi(rw.w)}; }
                    else { r0 = rf0[m][bj]; r1 = rf1[m][bj]; }
                    const f32x4 v0 = r0 + acc[ai][bj][m][0] * ascale, v1 = r1 + acc[ai][bj][m][1] * ascale;
                    if (O8) { u32x2 w8; w8.x = pk4_fp8(v0[0], v0[1], v0[2], v0[3]); w8.y = pk4_fp8(v1[0], v1[1], v1[2], v1[3]); *(u32x2*)(O8 + off + bj * 128) = w8; }
                    ssq += (v0[0] * v0[0] + v0[1] * v0[1]) + (v0[2] * v0[2] + v0[3] * v0[3]) + (v1[0] * v1[0] + v1[1] * v1[1]) + (v1[2] * v1[2] + v1[3] * v1[3]);
                    u32x4 w; w.x = cvt_pk_bf16(v0[0], v0[1]); w.y = cvt_pk_bf16(v0[2], v0[3]); w.z = cvt_pk_bf16(v1[0], v1[1]); w.w = cvt_pk_bf16(v1[2], v1[3]);
                    *(u32x4*)(O + off + bj * 128) = w; }
                if (RS) { ssq += __shfl_xor(ssq, 16); ssq += __shfl_xor(ssq, 32); if (fq == 0) RS[(size_t)(row0 + ai * 128 + m * 16) * 16 + u.pn * 4 + wc] = ssq; } } }
    }
};
struct EpiLora {
    static constexpr bool PERM = false;
    float* LWp; bf16* AAp; bf16* GGp; const float* w0; const float* a0;
    DI void operator()(const f32x4 (&acc)[2][2][4][2], const Unit& u, int wr, int wc, int fr, int fq) const {
        const int kind = u.pn >> 1;
        const int row0 = u.pm * 256 + wr * 64 + fr, col0 = (u.pn & 1) * 256 + wc * 32 + 4 * fq;
#pragma unroll
        for (int bj = 0; bj < 2; ++bj)
#pragma unroll
            for (int n = 0; n < 2; ++n) {
                const int c = col0 + bj * 128 + n * 16;
                f32x4 bias = (f32x4){0.f, 0.f, 0.f, 0.f};
                if (kind == 0) bias = *(const f32x4*)(w0 + c); else if (kind == 1) bias = *(const f32x4*)(a0 + c);
#pragma unroll
                for (int ai = 0; ai < 2; ++ai)
#pragma unroll
                    for (int m = 0; m < 4; ++m) {
                        f32x4 v = acc[ai][bj][m][n] + bias;
                        if (kind == 0) {
#pragma unroll
                            for (int j = 0; j < 4; ++j) { const float w = -softplus_fast(-v[j]) - 0.5f; v[j] = -__expf(w);     }
                        } else if (kind == 1) {
#pragma unroll
                            for (int j = 0; j < 4; ++j) v[j] = sigmoid_f(v[j]);
                        }
                        const size_t o_ = (size_t)(row0 + ai * 128 + m * 16) * 512 + c;
                        if (kind == 0) *(f32x4*)(LWp + o_) = v;
                        else { u32x2 w_; w_.x = cvt_pk_bf16(v[0], v[1]); w_.y = cvt_pk_bf16(v[2], v[3]); *(u32x2*)((kind == 1 ? AAp : GGp) + o_) = w_; }
                    }
            }
    }
};
typedef float f32x2_t __attribute__((ext_vector_type(2)));
struct EpiSwiglu {
    static constexpr bool PERM = true;
    bf16* ACT; const float* b_gu;
    DI void operator()(const f32x4 (&acc)[2][2][4][2], const Unit& u, int wr, int wc, int fr, int fq) const {
        const int row0 = u.pm * 256 + wr * 64 + fr, j0 = u.pn * 128 + wc * 32 + 8 * fq;
        const float* bg = b_gu + (size_t)u.e * 2048 + j0; const float* bu = bg + 1024;
        const f32x4 bg0 = *(const f32x4*)bg, bg1 = *(const f32x4*)(bg + 4), bu0 = *(const f32x4*)bu, bu1 = *(const f32x4*)(bu + 4);
#pragma unroll
        for (int ai = 0; ai < 2; ++ai)
#pragma unroll
            for (int m = 0; m < 4; ++m) {
                float o[8];
#pragma unroll
                for (int n = 0; n < 2; ++n) { const f32x4 g4 = acc[ai][0][m][n] * 0.015625f + (n ? bg1 : bg0), u4 = acc[ai][1][m][n] * 0.015625f + (n ? bu1 : bu0);
#pragma unroll
                    for (int p = 0; p < 2; ++p) {
                        f32x2_t g, up; g.x = fminf(g4[2 * p], 7.0f); g.y = fminf(g4[2 * p + 1], 7.0f); up.x = fminf(fmaxf(u4[2 * p], -7.0f), 7.0f); up.y = fminf(fmaxf(u4[2 * p + 1], -7.0f), 7.0f);
                        const f32x2_t ex = g * (-1.702f * 1.44269504089f); f32x2_t d; d.x = __builtin_amdgcn_exp2f(ex.x); d.y = __builtin_amdgcn_exp2f(ex.y); d = d + 1.0f;
                        f32x2_t r; r.x = __builtin_amdgcn_rcpf(d.x); r.y = __builtin_amdgcn_rcpf(d.y);
                        const f32x2_t ov = (up + 1.0f) * (g * r); o[n * 4 + 2 * p] = ov.x; o[n * 4 + 2 * p + 1] = ov.y; } }
                u32x2 w; w.x = pk4_fp8(o[0], o[1], o[2], o[3]); w.y = pk4_fp8(o[4], o[5], o[6], o[7]);
                *(u32x2*)((unsigned char*)ACT + (size_t)(row0 + ai * 128 + m * 16) * 1024 + j0) = w;
            }
    }
};
struct EpiDown {
    static constexpr bool PERM = true;
    bf16* YS; const float* b_dn; const u32x2* row_sg;
    DI void operator()(const f32x4 (&acc)[2][2][4][2], const Unit& u, int wr, int wc, int fr, int fq) const {
        const int row0 = u.pm * 256 + wr * 64 + fr, col0 = u.pn * 256 + wc * 32 + 8 * fq;
        const float* bb = b_dn + (size_t)u.e * 1024 + col0;
        f32x4 bv[2][2];
#pragma unroll
        for (int bj = 0; bj < 2; ++bj)
#pragma unroll
            for (int n = 0; n < 2; ++n) bv[bj][n] = *(const f32x4*)(bb + bj * 128 + 4 * n);
        int slots[8]; float gts[8];
        { const u32x2* sgp = row_sg + row0;
#pragma unroll
        for (int q = 0; q < 8; ++q) { const u32x2 sg = sgp[(q >> 2) * 128 + (q & 3) * 16]; slots[q] = (int)sg.x; gts[q] = __uint_as_float(sg.y); } }
#pragma unroll
        for (int ai = 0; ai < 2; ++ai)
#pragma unroll
            for (int m = 0; m < 4; ++m) {
                const int slot = slots[ai * 4 + m]; const float gt = gts[ai * 4 + m];
                if (slot >= 0) { unsigned char* rowp = (unsigned char*)YS + (size_t)slot * 1024 + col0; const float g16 = gt * 16.0f;
#pragma unroll
                    for (int bj = 0; bj < 2; ++bj) { const f32x4 v0 = (acc[ai][bj][m][0] * 0.015625f + bv[bj][0]) * g16, v1 = (acc[ai][bj][m][1] * 0.015625f + bv[bj][1]) * g16;
                        u32x2 w; w.x = pk4_fp8(v0[0], v0[1], v0[2], v0[3]); w.y = pk4_fp8(v1[0], v1[1], v1[2], v1[3]);
                        *(u32x2*)(rowp + bj * 128) = w; } }
            }
    }
};

constexpr size_t MiB = 1u << 20;
constexpr size_t WS_CTL = 0, CTL_ZERO_BYTES = 1 * MiB;
constexpr size_t WS_WIN = 1 * MiB, WS_WOUT = 7 * MiB, WS_WQ = 9 * MiB, WS_WK = 11 * MiB, WS_WV = 13 * MiB, WS_WO = 15 * MiB, WS_LORAB = 17 * MiB, WS_LRUW = 18 * MiB;
constexpr size_t WS_ROUTE = 19 * MiB;
constexpr size_t WS_WGU = 22 * MiB, WS_WDN = 150 * MiB;
constexpr size_t WS_HN = 214 * MiB, WS_MEMN = 246 * MiB, WS_KM = 248 * MiB, WS_VT = 250 * MiB;
constexpr size_t WS_X1 = 252 * MiB, WS_X2 = 316 * MiB;
constexpr size_t WS_U = 380 * MiB, WS_R = 468 * MiB, WS_KRAW = 500 * MiB, WS_V = 532 * MiB, WS_KKN = 564 * MiB, WS_WD = 596 * MiB, WS_AA = 628 * MiB, WS_G = 660 * MiB;
constexpr size_t WS_LA = 692 * MiB, WS_LB = 724 * MiB, WS_AP = 756 * MiB, WS_CAT = 764 * MiB, WS_Q = 796 * MiB;
constexpr size_t WS_XS = 380 * MiB, WS_ACT = 524 * MiB, WS_YS = 668 * MiB;
constexpr size_t WS_GP = 796 * MiB, WS_HF = 860 * MiB, WS_RP = 924 * MiB, WS_Y1F = 940 * MiB, WS_ADD = 972 * MiB, WS_END = 1004 * MiB;
constexpr size_t WS_GC = 468 * MiB, WS_HC = 484 * MiB, WS_ZS = 500 * MiB;
static_assert(WS_AA == WS_WD + 32 * MiB && WS_G == WS_AA + 32 * MiB, "EpiLora strides");
static_assert(WS_U + (size_t)M * INW * 2 <= WS_R && WS_XS + (size_t)MAXROWS * 2048 <= WS_ACT && WS_ACT + (size_t)MAXROWS * 2048 <= WS_YS && WS_YS + (size_t)NASSIGN * 2048 <= WS_Q, "ws map");
constexpr size_t RT_E = 0, RT_POS = 256 * 1024, RT_G = 512 * 1024, RT_SLOT = 768 * 1024, RT_GATE = 1088 * 1024, RT_TILE = 1408 * 1024, RT_TOK = 1472 * 1024, RT_UGU = 1792 * 1024, RT_UDN = 1808 * 1024;
constexpr int CW_BAR = 4096, CW_CNT = 8192, CW_CONV = 12288;

constexpr int RING_BYTES = 131072, MISC_OFF = RING_BYTES + 320, LDS_BYTES = 147456;
constexpr int NWAVES = 8, NTHREADS = 512;
constexpr int CONV_P9 = 10240;
constexpr int CONV_P9D = 16384;

#define XB_TMO      128
#define XB_XCNT(j)  (256  + 64 * (j))
#define XB_XSUB(j)  (1280 + 64 * (j))
#define XB_XGEN(j)  (2304 + 64 * (j))
#define XB_TOP      3328
#define XB_TOPGEN   3392
#define XCD_BAR_WORDS 3456
#define XB_SPIN_CAP (1u << 18)
DI unsigned xb_ld(unsigned* p)              { return __hip_atomic_load(p, __ATOMIC_RELAXED, __HIP_MEMORY_SCOPE_AGENT); }
DI unsigned xb_add(unsigned* p, unsigned v) { return __hip_atomic_fetch_add(p, v, __ATOMIC_RELAXED, __HIP_MEMORY_SCOPE_AGENT); }
DI unsigned xb_xcc_id() { return (unsigned)__builtin_amdgcn_s_getreg((3 << 11) | 20) & 0xFu; }
#define XB_SPIN(cond, bar) do { unsigned _sp = 0; while (cond) { __builtin_amdgcn_s_sleep(1); \
    if ((++_sp & 255u) == 0u) { if (xb_ld(&(bar)[XB_TMO])) break; if (_sp > XB_SPIN_CAP) { atomicAdd(&(bar)[XB_TMO], 1u); break; } } } } while (0)
struct XcdBarrier { unsigned* bar; unsigned x; volatile LAS unsigned* st; int w0; };
DI XcdBarrier xcd_barrier_post(unsigned* bar, volatile LAS unsigned* st, int w0) {
    XcdBarrier b; b.bar = bar; b.x = xb_xcc_id(); b.st = st; b.w0 = w0;
    if (fresh_tid_(w0) == 0) (void)xb_add(&bar[XB_XCNT(b.x)], 1u);
    return b;
}
DI void xcd_barrier_complete(unsigned* bar, unsigned x, unsigned& nloc, unsigned& nx) {
    const unsigned G = gridDim.x * gridDim.y * gridDim.z;
    unsigned sum, cnt, mine, sp = 0u;
    for (;;) {
        sum = 0u; cnt = 0u; mine = 0u;
#pragma unroll
        for (unsigned j = 0; j < 16; ++j) { const unsigned c = xb_ld(&bar[XB_XCNT(j)]); sum += c; cnt += (c > 0u) ? 1u : 0u; mine = (j == x) ? c : mine; }
        if (sum == G) break;
        __builtin_amdgcn_s_sleep(1);
        if ((++sp & 255u) == 0u) { if (xb_ld(&bar[XB_TMO])) break; if (sp > XB_SPIN_CAP) { atomicAdd(&bar[XB_TMO], 1u); break; } }
    }
    nloc = mine > 0u ? mine : 1u; nx = cnt > 0u ? cnt : 1u;
}
DI void xcd_barrier(const XcdBarrier& b) {
    asm volatile("s_waitcnt vmcnt(0)" ::: "memory");
    __syncthreads();
    if (fresh_tid_(b.w0) == 0) {
        unsigned* bar = b.bar;
        __builtin_amdgcn_s_waitcnt(0);
        unsigned nloc = b.st[0], nx = b.st[1];
        if (nloc == 0u) { xcd_barrier_complete(bar, b.x, nloc, nx); b.st[0] = nloc; b.st[1] = nx; }
        const unsigned old = xb_add(&bar[XB_XSUB(b.x)], 1u);
        const unsigned gen = old / nloc;
        if (old + 1u == (gen + 1u) * nloc) {
            __builtin_amdgcn_fence(__ATOMIC_RELEASE, "agent");
            asm volatile("s_waitcnt vmcnt(0)" ::: "memory");
            const unsigned og = xb_add(&bar[XB_TOP], 1u);
            const unsigned tg = og / nx;
            if (og + 1u == (tg + 1u) * nx) xb_add(&bar[XB_TOPGEN], 1u);
            else XB_SPIN(xb_ld(&bar[XB_TOPGEN]) == tg, bar);
            __builtin_amdgcn_fence(__ATOMIC_ACQUIRE, "agent");
            xb_add(&bar[XB_XGEN(b.x)], 1u);
            asm volatile("s_waitcnt vmcnt(0)" ::: "memory");
        } else {
            XB_SPIN(xb_ld(&bar[XB_XGEN(b.x)]) == gen, bar);
            __builtin_amdgcn_fence(__ATOMIC_ACQUIRE, "agent");
            asm volatile("s_waitcnt vmcnt(0)" ::: "memory");
        }
    }
    __syncthreads();
}

struct Args { const float* in[37]; float* out; unsigned char* ws; int ph_lo, ph_hi; };
enum { I_X = 0, I_MEM, I_NMIXG, I_WIN, I_CONVW, I_CONVB, I_LWX, I_LBX, I_LWA, I_LBA, I_LAM, I_MU, I_W0, I_WUP, I_A0, I_AUP, I_GUP, I_KK, I_KA, I_RK, I_LNG, I_LNB,
       I_WOUT, I_NXAG, I_NMEMG, I_WQ, I_WK, I_WV, I_WO, I_NFFG, I_WR, I_BR, I_WGU, I_BGU, I_WDN, I_BDN, I_FNG };

DI void transpose_item(const float* W, int ldw, int K, bf16* WT, int k0, int n0, int drow0, LAS float* scr, int lane, const float* rs = nullptr) {
    f32x4 t[8];
    const float* src = W + (size_t)(k0 + (lane >> 3)) * ldw + n0 + 4 * (lane & 7);
#pragma unroll
    for (int i = 0; i < 8; ++i) t[i] = *(const f32x4*)(src + (size_t)(8 * i) * ldw);
#pragma unroll
    for (int i = 0; i < 8; ++i) { const float sc_ = rs ? rs[k0 + 8 * i + (lane >> 3)] : 1.0f; LAS float* d = scr + (8 * i + (lane >> 3)) * 33 + 4 * (lane & 7); d[0] = t[i].x * sc_; d[1] = t[i].y * sc_; d[2] = t[i].z * sc_; d[3] = t[i].w * sc_; }
    asm volatile("s_waitcnt lgkmcnt(0)" ::: "memory");
    const int c = lane & 7;
#pragma unroll
    for (int j = 0; j < 4; ++j) { const int n = (lane >> 3) + 8 * j; const LAS float* s = scr + (8 * c) * 33 + n;
        u32x4 o; o.x = pk2(s[0 * 33], s[1 * 33]); o.y = pk2(s[2 * 33], s[3 * 33]); o.z = pk2(s[4 * 33], s[5 * 33]); o.w = pk2(s[6 * 33], s[7 * 33]);
        *(u32x4*)(WT + (size_t)(drow0 + n) * K + k0 + 8 * c) = o; }
    asm volatile("s_waitcnt lgkmcnt(0)" ::: "memory");
}
DI void transpose_item_tiled(const float* W, int ldw, int K, bf16* WTe, int k0, int n0, int drow0, LAS float* scr, int lane) {
    f32x4 t[8];
    const float* src = W + (size_t)(k0 + (lane >> 3)) * ldw + n0 + 4 * (lane & 7);
#pragma unroll
    for (int i = 0; i < 8; ++i) t[i] = *(const f32x4*)(src + (size_t)(8 * i) * ldw);
#pragma unroll
    for (int i = 0; i < 8; ++i) { LAS float* d = scr + (8 * i + (lane >> 3)) * 33 + 4 * (lane & 7); d[0] = t[i].x; d[1] = t[i].y; d[2] = t[i].z; d[3] = t[i].w; }
    asm volatile("s_waitcnt lgkmcnt(0)" ::: "memory");
    const int c = lane & 7;
#pragma unroll
    for (int j = 0; j < 4; ++j) { const int n = (lane >> 3) + 8 * j; const LAS float* s = scr + (8 * c) * 33 + n;
        u32x4 o; o.x = pk2(s[0 * 33], s[1 * 33]); o.y = pk2(s[2 * 33], s[3 * 33]); o.z = pk2(s[4 * 33], s[5 * 33]); o.w = pk2(s[6 * 33], s[7 * 33]);
        const int drow = drow0 + n, pn = drow >> 8, half = (drow >> 7) & 1, r = drow & 127, x = r & 31;
        const int rslot = (r & ~31) + 16 * ((x >> 2) & 1) + 4 * (x >> 3) + (x & 3);
        const size_t tb = ((size_t)(pn * (K / 64) + (k0 >> 6)) * 2 + half) * 16384 + pg8::lds_byte(rslot, 8 * c);
        *(u32x4*)((char*)WTe + tb) = o; }
    asm volatile("s_waitcnt lgkmcnt(0)" ::: "memory");
}
DI void transpose_item_tiled_nolds(const float* W, int ldw, int K, bf16* WTe, int k0, int n0, int drow0, int lane) {
    const int n = lane & 31, kh = lane >> 5;
    const float* src = W + (size_t)(k0 + 32 * kh) * ldw + n0 + n;
    float t[32];
#pragma unroll
    for (int i = 0; i < 32; ++i) t[i] = src[(size_t)i * ldw];
    const int drow = drow0 + n, pn = drow >> 8, half = (drow >> 7) & 1, r = drow & 127, x = r & 31;
    const int rslot = (r & ~31) + 16 * ((x >> 2) & 1) + 4 * (x >> 3) + (x & 3);
    const size_t tb0 = ((size_t)(pn * (K / 64) + (k0 >> 6)) * 2 + half) * 16384;
#pragma unroll
    for (int c = 0; c < 4; ++c) { u32x4 o; o.x = pk2(t[8 * c], t[8 * c + 1]); o.y = pk2(t[8 * c + 2], t[8 * c + 3]); o.z = pk2(t[8 * c + 4], t[8 * c + 5]); o.w = pk2(t[8 * c + 6], t[8 * c + 7]);
        *(u32x4*)((char*)WTe + tb0 + pg8::lds_byte(rslot, 32 * kh + 8 * c)) = o; }
}
DI void transpose_item_tiled_fp8_nolds(const float* W, int ldw, int K, unsigned char* WTe, int k0, int n0, int drow0, int lane) {
    const int n = lane & 31, kh = lane >> 5;
    const float* src = W + (size_t)(k0 + 32 * kh) * ldw + n0 + n;
    float t[32];
#pragma unroll
    for (int i = 0; i < 32; ++i) t[i] = __builtin_nontemporal_load(src + (size_t)i * ldw) * 64.f;
    const int drow = drow0 + n, pn = drow >> 8, half = (drow >> 7) & 1, r = drow & 127, x = r & 31;
    const int rslot = (r & ~31) + 16 * ((x >> 2) & 1) + 4 * (x >> 3) + (x & 3);
    const size_t tb0 = ((size_t)(pn * (K / 128) + (k0 >> 7)) * 2 + half) * 16384;
#pragma unroll
    for (int c = 0; c < 2; ++c) { u32x4 o; o.x = pk4_fp8(t[16 * c], t[16 * c + 1], t[16 * c + 2], t[16 * c + 3]); o.y = pk4_fp8(t[16 * c + 4], t[16 * c + 5], t[16 * c + 6], t[16 * c + 7]);
        o.z = pk4_fp8(t[16 * c + 8], t[16 * c + 9], t[16 * c + 10], t[16 * c + 11]); o.w = pk4_fp8(t[16 * c + 12], t[16 * c + 13], t[16 * c + 14], t[16 * c + 15]);
        const int bc = (k0 & 64) + 32 * kh + 16 * c;
        *(u32x4*)(WTe + tb0 + pg8::lds_byte(rslot, bc >> 1)) = o; }
}
DI void transpose_item_tiled_fp8(const float* W, int ldw, int K, unsigned char* WTe, int k0, int n0, int drow0, LAS float* scr, int lane) {
    f32x4 t[8];
    const float* src = W + (size_t)(k0 + (lane >> 3)) * ldw + n0 + 4 * (lane & 7);
#pragma unroll
    for (int i = 0; i < 8; ++i) t[i] = __builtin_nontemporal_load((const f32x4*)(src + (size_t)(8 * i) * ldw));
#pragma unroll
    for (int i = 0; i < 8; ++i) { LAS float* d = scr + (8 * i + (lane >> 3)) * 33 + 4 * (lane & 7); d[0] = t[i].x * 64.f; d[1] = t[i].y * 64.f; d[2] = t[i].z * 64.f; d[3] = t[i].w * 64.f; }
    asm volatile("s_waitcnt lgkmcnt(0)" ::: "memory");
    const int c = lane & 3;
#pragma unroll
    for (int j = 0; j < 2; ++j) { const int n = (lane >> 2) + 16 * j; const LAS float* sp = scr + (16 * c) * 33 + n;
        u32x4 o; o.x = pk4_fp8(sp[0 * 33], sp[1 * 33], sp[2 * 33], sp[3 * 33]); o.y = pk4_fp8(sp[4 * 33], sp[5 * 33], sp[6 * 33], sp[7 * 33]);
        o.z = pk4_fp8(sp[8 * 33], sp[9 * 33], sp[10 * 33], sp[11 * 33]); o.w = pk4_fp8(sp[12 * 33], sp[13 * 33], sp[14 * 33], sp[15 * 33]);
        const int drow = drow0 + n, pn = drow >> 8, half = (drow >> 7) & 1, r = drow & 127, x = r & 31;
        const int rslot = (r & ~31) + 16 * ((x >> 2) & 1) + 4 * (x >> 3) + (x & 3);
        const int bc = (k0 & 64) + 16 * c;
        const size_t tb = ((size_t)(pn * (K / 128) + (k0 >> 7)) * 2 + half) * 16384 + pg8::lds_byte(rslot, bc >> 1);
        *(u32x4*)(WTe + tb) = o; }
    asm volatile("s_waitcnt lgkmcnt(0)" ::: "memory");
}
DI void rms_row_to_bf16(const float* xrow, const float* g, bf16* orow, int lane) {
    const f32x4* xr = (const f32x4*)xrow + lane; const f32x4* gr = (const f32x4*)g + lane;
    f32x4 v[4]; float s = 0.f;
#pragma unroll
    for (int j = 0; j < 4; ++j) { v[j] = __builtin_nontemporal_load(xr + 64 * j); s += (v[j].x * v[j].x + v[j].y * v[j].y) + (v[j].z * v[j].z + v[j].w * v[j].w); }
    const float rstd = rsq_f(wave_sum(s) * (1.f / D) + EPS);
    u32x2* o8 = (u32x2*)orow + lane;
#pragma unroll
    for (int j = 0; j < 4; ++j) { const f32x4 gg = gr[64 * j]; u32x2 w; w.x = pk2(v[j].x * rstd * gg.x, v[j].y * rstd * gg.y); w.y = pk2(v[j].z * rstd * gg.z, v[j].w * rstd * gg.w); o8[64 * j] = w; }
}

DI void rms_rowbf_to_bf16(const bf16* xrow, const float* g, bf16* orow, int lane) {
    float v[16]; float s = 0.f;
#pragma unroll
    for (int hf = 0; hf < 2; ++hf) { const u32x4 w = *(const u32x4*)(xrow + 512 * hf + 8 * lane);
#pragma unroll
        for (int q = 0; q < 4; ++q) { v[8 * hf + 2 * q] = bflo(w[q]); v[8 * hf + 2 * q + 1] = bfhi(w[q]); } }
#pragma unroll
    for (int j = 0; j < 16; ++j) s += v[j] * v[j];
    const float rstd = rsq_f(wave_sum(s) * (1.f / D) + EPS);
#pragma unroll
    for (int hf = 0; hf < 2; ++hf) { const f32x4 g0 = *(const f32x4*)(g + 512 * hf + 8 * lane), g1 = *(const f32x4*)(g + 512 * hf + 8 * lane + 4);
        u32x4 w; w.x = pk2(v[8 * hf] * rstd * g0.x, v[8 * hf + 1] * rstd * g0.y); w.y = pk2(v[8 * hf + 2] * rstd * g0.z, v[8 * hf + 3] * rstd * g0.w);
        w.z = pk2(v[8 * hf + 4] * rstd * g1.x, v[8 * hf + 5] * rstd * g1.y); w.w = pk2(v[8 * hf + 6] * rstd * g1.z, v[8 * hf + 7] * rstd * g1.w);
        *(u32x4*)(orow + 512 * hf + 8 * lane) = w; }
}

__global__ void __launch_bounds__(NTHREADS, 2) fwd(Args args) {
    extern __shared__ __attribute__((aligned(16))) unsigned char lds_raw[];
    LAS unsigned char* lds = (LAS unsigned char*)lds_raw;
    volatile LAS unsigned* MISC = (volatile LAS unsigned*)(lds + MISC_OFF);
    const int G = gridDim.x, bid = blockIdx.x, NGW = G * NWAVES;
    const int wv0 = __builtin_amdgcn_readfirstlane((int)(threadIdx.x >> 6));
#define PHASE_IDS const int tid = fresh_tid(), lane = tid & 63, wave = __builtin_amdgcn_readfirstlane(tid >> 6), gw = bid * NWAVES + wave; (void)tid; (void)lane; (void)wave; (void)gw
    unsigned char* ws = args.ws;
    unsigned* ctl = (unsigned*)(ws + WS_CTL);
    const int lo = args.ph_lo, hi = args.ph_hi;

    for (int u = fresh_tid(); u < (LDS_BYTES - RING_BYTES) / 4; u += NTHREADS) ((LAS unsigned*)(lds + RING_BYTES))[u] = 0u;
    __syncthreads();
    XcdBarrier bar; bar.bar = ctl + CW_BAR; bar.x = 0; bar.st = nullptr; bar.w0 = wv0;
    if (hi - lo > 1) bar = xcd_barrier_post(ctl + CW_BAR, MISC + 8, wv0);
#define IN(k) (lo <= (k) && (k) < hi)
#define SEAM(k) do { if (IN(k) && IN((k) + 1)) xcd_barrier(bar); } while (0)

#define Win_t ((bf16*)(ws + WS_WIN))
#define Wout_t ((bf16*)(ws + WS_WOUT))
#define Wq_t ((bf16*)(ws + WS_WQ))
#define Wk_t ((bf16*)(ws + WS_WK))
#define Wv_t ((bf16*)(ws + WS_WV))
#define Wo_t ((bf16*)(ws + WS_WO))
#define LoraB ((bf16*)(ws + WS_LORAB))
#define LruW ((bf16*)(ws + WS_LRUW))
#define WrT ((bf16*)(ws + WS_LRUW + 512 * 1024))
#define Wgu_t ((bf16*)(ws + WS_WGU))
#define Wdn_t ((bf16*)(ws + WS_WDN))
#define HN ((bf16*)(ws + WS_HN))
#define MEMN ((bf16*)(ws + WS_MEMN))
#define KM ((bf16*)(ws + WS_KM))
#define VT ((bf16*)(ws + WS_VT))
#define X1 ((bf16*)(ws + WS_X1))
#define X2 ((bf16*)(ws + WS_X2))
#define U ((bf16*)(ws + WS_U))
#define Rr ((float*)(ws + WS_R))
#define KRAW ((float*)(ws + WS_KRAW))
#define Vv ((float*)(ws + WS_V))
#define KKN ((float*)(ws + WS_KKN))
#define WD ((float*)(ws + WS_WD))
#define AA ((float*)(ws + WS_AA))
#define GG ((float*)(ws + WS_G))
#define LA ((bf16*)(ws + WS_LA))
#define LB ((bf16*)(ws + WS_LB))
#define AP ((bf16*)(ws + WS_AP))
#define CAT ((bf16*)(ws + WS_CAT))
#define Qb ((bf16*)(ws + WS_Q))
#define Ob CAT
#define LACT ((bf16*)(ws + WS_CAT))
#define X1F8 ((unsigned char*)(ws + WS_XS))
#define XS ((bf16*)(ws + WS_XS))
#define ACT ((bf16*)(ws + WS_ACT))
#define YS ((bf16*)(ws + WS_YS))
#define route_e ((int*)(ws + WS_ROUTE + RT_E))
#define route_pos ((int*)(ws + WS_ROUTE + RT_POS))
#define route_g ((float*)(ws + WS_ROUTE + RT_G))
#define row_sg ((u32x2*)(ws + WS_ROUTE + RT_SLOT))
#define tile_tab ((int*)(ws + WS_ROUTE + RT_TILE))
#define row_tok ((int*)(ws + WS_ROUTE + RT_TOK))
#define ecnt (ctl + CW_CNT)

    if (IN(0)) { PHASE_IDS;
        LAS float* scr = (LAS float*)(lds + wave * 16384);
        constexpr int I_IN = 16 * (INW / 32), I_SQ = 16 * 32;
        constexpr int N_ITEMS = I_IN + 5 * I_SQ;
        for (int it = gw; it < N_ITEMS; it += NGW) {
            int r = it;
            if (r < I_IN) { const int nblk = INW / 32, kb = r / nblk, nb = r % nblk; transpose_item(args.in[I_WIN], INW, D, Win_t, 64 * kb, 32 * nb, 32 * nb, scr, lane); continue; } r -= I_IN;
            { const int w = r / I_SQ, q = r % I_SQ, kb = q / 32, nb = q % 32;
                if (w == 1) continue;
                const float* src = w == 0 ? args.in[I_WOUT] : w == 2 ? args.in[I_WK] : w == 3 ? args.in[I_WV] : args.in[I_WO];
                bf16* dst = w == 0 ? Wout_t : w == 2 ? Wk_t : w == 3 ? Wv_t : Wo_t;
                transpose_item(src, D, D, dst, 64 * kb, 32 * nb, 32 * nb, scr, lane); }
        }
        for (int idx = bid * NTHREADS + tid; idx < D * D / 4; idx += G * NTHREADS) { const f32x4 v = ((const f32x4*)args.in[I_WQ])[idx]; const float gk = args.in[I_NXAG][idx >> 8];
            u32x2 w; w.x = pk2(v.x * gk, v.y * gk); w.y = pk2(v.z * gk, v.w * gk); ((u32x2*)Wq_t)[idx] = w; }
        for (int idx = bid * NTHREADS + tid; idx < 1536 * 256; idx += G * NTHREADS) {
            const int e = idx & 7, ln = (idx >> 3) & 63, ks = (idx >> 9) & 7, ct = (idx >> 12) & 3, hk = idx >> 14, hh = hk / 3, kind = hk - 3 * hh;
            const int k = 32 * ks + 8 * (ln >> 4) + e, n = hh * 64 + 16 * ct + (ln & 15); float v = 0.f;
            if (kind == 0) { if (k < 64) v = args.in[I_WUP][k * 512 + n]; }
            else if (kind == 1) { if (k >= 64 && k < 128) v = args.in[I_AUP][(k - 64) * 512 + n]; }
            else { if (k >= 128) v = args.in[I_GUP][(k - 128) * 512 + n]; }
            LoraB[idx] = (bf16)f2bf(v);
        }
        for (int idx = bid * NTHREADS + tid; idx < 8 * 128 * 64; idx += G * NTHREADS) {
            const int nb = idx >> 13, col = (idx >> 6) & 127, k = idx & 63;
            const float v = col < 64 ? args.in[I_LWX][nb * 4096 + k * 64 + col] : args.in[I_LWA][nb * 4096 + k * 64 + (col - 64)];
            LruW[idx] = (bf16)f2bf(v);
        }
        for (int idx = bid * NTHREADS + tid; idx < NE * D; idx += G * NTHREADS) {
            const int e = idx >> 10, k = idx & 1023; const float v = args.in[I_WR][k * NE + e];
            const unsigned hi = f2bf(v); const float lo = v - __uint_as_float(hi << 16);
            WrT[idx] = (bf16)hi; WrT[NE * D + idx] = (bf16)f2bf(lo);
        }
        for (int m = gw; m < M; m += NGW) rms_row_to_bf16(args.in[I_X] + (size_t)m * D, args.in[I_NMIXG], HN + (size_t)m * D, lane);
        for (int m = gw; m < MROWS; m += NGW) rms_row_to_bf16(args.in[I_MEM] + (size_t)m * D, args.in[I_NMEMG], MEMN + (size_t)m * D, lane);
        {
            LAS float* scr = (LAS float*)(lds + wave * 16384);
            constexpr int I_GU = 16 * 64, I_DN = 16 * 32;
            for (int it = CONV_P9 + gw; it < NE * I_GU; it += NGW) {
                int r = it;
                if (r < NE * I_GU) { const int e = r / I_GU, q = r % I_GU, kb = q / 64, nb = q % 64; const int n0 = 32 * nb;
                    const int drow = n0 < 1024 ? (256 * (n0 >> 7) + (n0 & 127)) : (256 * ((n0 - 1024) >> 7) + 128 + ((n0 - 1024) & 127));
                    transpose_item_tiled_fp8(args.in[I_WGU] + (size_t)e * D * 2048, 2048, D, (unsigned char*)Wgu_t + (size_t)e * 2048 * D, 64 * kb, n0, drow, scr, lane); continue; } r -= NE * I_GU;
                { const int e = r / I_DN, q = r % I_DN, kb = q / 32, nb = q % 32;
                  transpose_item_tiled(args.in[I_WDN] + (size_t)e * DFF * D, D, DFF, Wdn_t + (size_t)e * D * DFF, 64 * kb, 32 * nb, 32 * nb, scr, lane); }
            }
        }
    }
    SEAM(0);

    if (IN(1)) { PHASE_IDS;
        { pg8::DenseSched S; S.o.init_tiles(M / 256, INW / 256, G, bid); S.A = (const char*)HN; S.B = (const char*)Win_t; S.tstep = (size_t)256 * D * 2;
          EpiBf16Plain E{U, INW, 1.0f}; pg8::gemm_phase(lds, D, S, E, wv0); }
        { pg8::DenseSched S; S.o.init_tiles(MROWS / 256, D / 256, G, (bid + 64) & (G - 1)); S.A = (const char*)MEMN; S.B = (const char*)Wk_t; S.tstep = (size_t)256 * D * 2;
          EpiBf16Plain E{KM, D, 1.0f}; pg8::gemm_phase(lds, D, S, E, wv0); }
        { pg8::DenseSched S; S.o.init_tiles(MROWS / 256, D / 256, G, (bid + 48) & (G - 1)); S.A = (const char*)MEMN; S.B = (const char*)Wv_t; S.tstep = (size_t)256 * D * 2;
          EpiBf16Plain E{VT, D, 1.0f}; pg8::gemm_phase(lds, D, S, E, wv0); }
    }
    SEAM(1);

    if (IN(2)) { PHASE_IDS;
        const float* conv_w = args.in[I_CONVW]; const float* conv_b = args.in[I_CONVB];
        LAS float* xs = (LAS float*)(lds + wave * 16384);
        LAS bf16* tP = (LAS bf16*)(lds + wave * 16384 + 4096); LAS bf16* tH = tP + 1024;
        const int i = lane & 15, kg = lane >> 4;
        for (int unit = gw; unit < (M / 64) * 8; unit += NGW) {
            const int seg = unit >> 3, nb = unit & 7, m0s = seg * 64, s0s = m0s & (SEQ - 1);
            bf16x8 wf[8][2];
#pragma unroll
            for (int ct = 0; ct < 8; ++ct)
#pragma unroll
                for (int ks = 0; ks < 2; ++ks) wf[ct][ks] = *(const bf16x8*)(LruW + ((size_t)(nb * 128 + 16 * ct + i) * 64 + 32 * ks + 8 * kg));
            float bxv[4], bav[4], spv[4], Arun[4], Brun[4];
#pragma unroll
            for (int ct = 0; ct < 4; ++ct) { const int ch = nb * 64 + 16 * ct + i; bxv[ct] = args.in[I_LBX][ch]; bav[ct] = args.in[I_LBA][ch]; spv[ct] = softplus_f(-args.in[I_LAM][ch]); Arun[ct] = 1.f; Brun[ct] = 0.f; }
#pragma unroll 1
            for (int jt = 0; jt < 4; ++jt) {
                const int m0 = m0s + 16 * jt, s0 = s0s + 16 * jt;
                bf16x8 af[2];
#pragma unroll
                for (int ks = 0; ks < 2; ++ks) {
                    const int chb = nb * 64 + 32 * ks + 8 * kg;
                    f32x4 x0 = *(const f32x4*)(conv_b + chb), x1 = *(const f32x4*)(conv_b + chb + 4);
#pragma unroll
                    for (int j = 0; j < 4; ++j) {
                        const bool ok = s0 + i - 3 + j >= 0;
                        u32x4 uw = *(const u32x4*)(U + (size_t)(ok ? m0 + i - 3 + j : m0) * INW + chb); if (!ok) uw = (u32x4){0u, 0u, 0u, 0u};
                        const f32x4 w0 = *(const f32x4*)(conv_w + j * 512 + chb), w1 = *(const f32x4*)(conv_w + j * 512 + chb + 4);
                        x0.x += w0.x * bflo(uw.x); x0.y += w0.y * bfhi(uw.x); x0.z += w0.z * bflo(uw.y); x0.w += w0.w * bfhi(uw.y);
                        x1.x += w1.x * bflo(uw.z); x1.y += w1.y * bfhi(uw.z); x1.z += w1.z * bflo(uw.w); x1.w += w1.w * bfhi(uw.w);
                    }
                    *(LAS f32x4*)(xs + i * 64 + 32 * ks + 8 * kg) = x0; *(LAS f32x4*)(xs + i * 64 + 32 * ks + 8 * kg + 4) = x1;
                    u32x4 p; p.x = pk2(x0.x, x0.y); p.y = pk2(x0.z, x0.w); p.z = pk2(x1.x, x1.y); p.w = pk2(x1.z, x1.w);
                    af[ks] = __builtin_bit_cast(bf16x8, p);
                }
                f32x4 acc[8];
#pragma unroll
                for (int ct = 0; ct < 8; ++ct) { acc[ct] = (f32x4){0.f, 0.f, 0.f, 0.f};
#pragma unroll
                    for (int ks = 0; ks < 2; ++ks) acc[ct] = __builtin_amdgcn_mfma_f32_16x16x32_bf16(af[ks], wf[ct][ks], acc[ct], 0, 0, 0); }
#pragma unroll
                for (int ct = 0; ct < 4; ++ct) {
                    const int col = 16 * ct + i;
                    float hl[4], pl[4]; float hprev = 0.f, pprev = 1.f;
#pragma unroll
                    for (int e = 0; e < 4; ++e) {
                        const float gx = sigmoid_f(acc[ct][e] + bxv[ct]), ga = sigmoid_f(acc[ct + 4][e] + bav[ct]);
                        const float la = -8.0f * ga * spv[ct], av = __expf(la), xcv = xs[(4 * kg + e) * 64 + col];
                        const float bt = __builtin_amdgcn_sqrtf(fmaxf(1.0f - av * av, 0.f)) * gx * xcv;
                        hprev = av * hprev + bt; pprev *= av; hl[e] = hprev; pl[e] = pprev;
                    }
                    float Ag[4], Bg[4];
#pragma unroll
                    for (int gq = 0; gq < 4; ++gq) { Ag[gq] = __shfl(pl[3], i + 16 * gq); Bg[gq] = __shfl(hl[3], i + 16 * gq); }
                    float Ain = Arun[ct], Bin = Brun[ct];
#pragma unroll
                    for (int gq = 0; gq < 3; ++gq) if (gq < kg) { Bin = Ag[gq] * Bin + Bg[gq]; Ain *= Ag[gq]; }
                    float At = 1.f, Bt = 0.f;
#pragma unroll
                    for (int gq = 0; gq < 4; ++gq) { Bt = Ag[gq] * Bt + Bg[gq]; At *= Ag[gq]; }
                    Brun[ct] = At * Brun[ct] + Bt; Arun[ct] *= At;
#pragma unroll
                    for (int e = 0; e < 4; ++e) { const int ti_ = (4 * kg + e) * 64 + col; tP[ti_] = (bf16)f2bf(pl[e] * Ain); tH[ti_] = (bf16)f2bf(hl[e] + pl[e] * Bin); }
                }
                { const int rr = lane >> 2, cq = lane & 3;
                  bf16* pp = LA + (size_t)(m0 + rr) * 512 + nb * 64 + 16 * cq; bf16* hp = LB + (size_t)(m0 + rr) * 512 + nb * 64 + 16 * cq;
                  *(u32x4*)pp = *(const LAS u32x4*)(tP + rr * 64 + 16 * cq); *(u32x4*)(pp + 8) = *(const LAS u32x4*)(tP + rr * 64 + 16 * cq + 8);
                  *(u32x4*)hp = *(const LAS u32x4*)(tH + rr * 64 + 16 * cq); *(u32x4*)(hp + 8) = *(const LAS u32x4*)(tH + rr * 64 + 16 * cq + 8); }
            }
            if (kg == 0) {
#pragma unroll
                for (int ct = 0; ct < 4; ++ct) { f32x2 ab; ab.x = Arun[ct]; ab.y = Brun[ct];
                    *(f32x2*)((float*)(ws + WS_AP) + ((size_t)(((seg >> 6) * 8 + nb) * 64 + (seg & 63)) * 64 + 16 * ct + i) * 2) = ab; }
            }
        }
        { const int rsub = lane >> 5, chunk = lane & 31;
          const f32x4 m0 = *(const f32x4*)(args.in[I_MU] + 1536 + 8 * chunk), m1 = *(const f32x4*)(args.in[I_MU] + 1536 + 8 * chunk + 4);
          const bool actid = chunk >= 8 && chunk < 16; const float actc = chunk < 8 ? 2.8853900818f : -1.4426950409f, actp = chunk < 8 ? 1.0f : 0.0f, actq = chunk < 8 ? -2.0f : 1.0f;
          for (int rp = gw; rp < M / 2; rp += NGW) { const size_t mr = (size_t)2 * rp + rsub; const bool hp2 = (mr & (SEQ - 1)) != 0; const bf16* ua = U + mr * INW + 2560 + 8 * chunk;
              const u32x4 cu = *(const u32x4*)ua; u32x4 pu = *(const u32x4*)(ua - (hp2 ? INW : 0)); if (!hp2) pu = (u32x4){0u, 0u, 0u, 0u};
              float o8[8];
#pragma unroll
              for (int q = 0; q < 4; ++q) { const float c0 = bflo(cu[q]), c1 = bfhi(cu[q]), p0 = bflo(pu[q]), p1 = bfhi(pu[q]); const float mm0 = q < 2 ? m0[2 * q] : m1[2 * q - 4], mm1 = q < 2 ? m0[2 * q + 1] : m1[2 * q - 3];
                  float x0 = c0 + (p0 - c0) * mm0, x1 = c1 + (p1 - c1) * mm1;
                  const float r0 = __builtin_amdgcn_rcpf(__builtin_amdgcn_exp2f(actc * x0) + 1.0f), r1 = __builtin_amdgcn_rcpf(__builtin_amdgcn_exp2f(actc * x1) + 1.0f);
                  o8[2 * q] = actid ? x0 : actp + actq * r0; o8[2 * q + 1] = actid ? x1 : actp + actq * r1; }
              u32x4 pw; pw.x = pk2(o8[0], o8[1]); pw.y = pk2(o8[2], o8[3]); pw.z = pk2(o8[4], o8[5]); pw.w = pk2(o8[6], o8[7]);
              *(u32x4*)(LACT + mr * 256 + 8 * chunk) = pw; } }
    }
    SEAM(2);


#define RW_ZB(zz, zb) do { _Pragma("unroll") for (int ks_ = 0; ks_ < 2; ++ks_) { u32x4 p_; p_.x = pk2(zz[2 * ks_][0], zz[2 * ks_][1]); p_.y = pk2(zz[2 * ks_][2], zz[2 * ks_][3]); \
        p_.z = pk2(zz[2 * ks_ + 1][0], zz[2 * ks_ + 1][1]); p_.w = pk2(zz[2 * ks_ + 1][2], zz[2 * ks_ + 1][3]); zb[ks_] = __builtin_bit_cast(bf16x8, p_); } } while (0)
    if (IN(3)) { PHASE_IDS;
        for (int u64 = gw; u64 < NB * NH * (SEQ / 64); u64 += NGW) {
#pragma unroll 1
        for (int jj = 0; jj < 4; ++jj) {
        LAS unsigned char* wl = lds + wave * 16384;
        LAS bf16* Arm = (LAS bf16*)(wl); LAS bf16* Brm = (LAS bf16*)(wl + 2048); LAS bf16* Krm = (LAS bf16*)(wl + 4096); LAS bf16* Rrm = (LAS bf16*)(wl + 6144);
        LAS bf16* ATt = (LAS bf16*)(wl + 8192); LAS bf16* BTt = (LAS bf16*)(wl + 10240); LAS bf16* KTt = (LAS bf16*)(wl + 12288); LAS bf16* VTt = (LAS bf16*)(wl + 14336);
        LAS float* MabT = (LAS float*)(wl); LAS bf16* Mak = (LAS bf16*)(wl + 1024); LAS bf16* Mrb = (LAS bf16*)(wl + 1536); LAS bf16* Mrk = (LAS bf16*)(wl + 2048); LAS bf16* Tm = (LAS bf16*)(wl + 2560);
        LAS float* PLs = (LAS float*)(wl + 3072); LAS bf16* Q0T = (LAS bf16*)(wl + 4096);
        const int lane = fresh_tid() & 63, l15 = lane & 15, g = lane >> 4, te = lane >> 2, kq = lane & 3;
        const bf16x8 z8 = (bf16x8){0, 0, 0, 0, 0, 0, 0, 0};
        const f32x4 z4 = (f32x4){0.f, 0.f, 0.f, 0.f};
            const int un = u64 * 4 + jj;
            const int bh = un >> 8, c = un & 255, b = bh >> 3, h = bh & 7;
            const size_t mrow = (size_t)b * SEQ + c * 16 + te, off = mrow * 512 + h * 64 + 16 * kq;
            const int hc = h * 64 + 16 * kq;
            LAS float* tmpL = (LAS float*)wl;
            {
                const int rsub = lane >> 5, chunk = lane & 31; const size_t mt0 = (size_t)b * SEQ + c * 16;
                u32x4 cu[8];
#pragma unroll
                for (int i = 0; i < 8; ++i) cu[i] = *(const u32x4*)(LACT + (mt0 + 2 * i + rsub) * 256 + 8 * chunk);
#pragma unroll
                for (int i = 0; i < 8; ++i) { const int row = 2 * i + rsub; *(LAS u32x4*)(wl + row * 512 + ((chunk ^ (row & 7)) << 4)) = cu[i]; }
                bf16x8 af[8];
#pragma unroll
                for (int ks = 0; ks < 8; ++ks) af[ks] = *(const LAS bf16x8*)(wl + l15 * 512 + (((4 * ks + g) ^ (l15 & 7)) << 4));
                asm volatile("s_waitcnt lgkmcnt(0)" ::: "memory");
#pragma unroll
                for (int kind = 0; kind < 3; ++kind)
#pragma unroll
                    for (int ct = 0; ct < 4; ++ct) {
                        const bf16* lb = LoraB + ((size_t)((h * 3 + kind) * 4 + ct) * 8 * 64 + lane) * 8;
                        f32x4 a4 = z4;
#pragma unroll
                        for (int ks = (kind == 0 ? 0 : kind == 1 ? 2 : 4); ks < (kind == 0 ? 2 : kind == 1 ? 4 : 8); ++ks) a4 = __builtin_amdgcn_mfma_f32_16x16x32_bf16(af[ks], *(const bf16x8*)(lb + ks * 512), a4, 0, 0, 0);
#pragma unroll
                        for (int e = 0; e < 4; ++e) tmpL[kind * 1088 + (4 * g + e) * 68 + 16 * ct + l15] = a4[e];
                    }
            }
            asm volatile("s_waitcnt lgkmcnt(0)" ::: "memory");
            float cl[16], eP[16];
            {
                float lwv[16], rl[16], kl[16], vl[16], kn[16], av[16];
                const bool hp = (mrow & (SEQ - 1)) != 0;
                const bf16* ub = U + mrow * INW + 1024 + hc;
#pragma unroll
                for (int hh = 0; hh < 2; ++hh) {
#pragma unroll
                    for (int a3 = 0; a3 < 3; ++a3) {
                        const u32x4 cu = *(const u32x4*)(ub + 512 * a3 + 8 * hh); u32x4 pu = *(const u32x4*)(ub - (hp ? INW : 0) + 512 * a3 + 8 * hh); if (!hp) pu = (u32x4){0u, 0u, 0u, 0u};
                        const f32x4 m0 = *(const f32x4*)(args.in[I_MU] + 512 * a3 + hc + 8 * hh), m1 = *(const f32x4*)(args.in[I_MU] + 512 * a3 + hc + 8 * hh + 4);
                        float o8[8];
#pragma unroll
                        for (int q = 0; q < 4; ++q) { const float c0 = bflo(cu[q]), c1 = bfhi(cu[q]), p0 = bflo(pu[q]), p1 = bfhi(pu[q]); const float mm0 = q < 2 ? m0[2 * q] : m1[2 * q - 4], mm1 = q < 2 ? m0[2 * q + 1] : m1[2 * q - 3];
                            o8[2 * q] = c0 + (p0 - c0) * mm0; o8[2 * q + 1] = c1 + (p1 - c1) * mm1; }
#pragma unroll
                        for (int q = 0; q < 8; ++q) { if (a3 == 0) rl[8 * hh + q] = o8[q]; else if (a3 == 1) kl[8 * hh + q] = o8[q]; else vl[8 * hh + q] = o8[q]; }
                    }
                }
                float gv[16];
#pragma unroll
                for (int j4 = 0; j4 < 4; ++j4) { const f32x4 xl = *(const LAS f32x4*)(tmpL + te * 68 + 16 * kq + 4 * j4), xa = *(const LAS f32x4*)(tmpL + 1088 + te * 68 + 16 * kq + 4 * j4), xg = *(const LAS f32x4*)(tmpL + 2176 + te * 68 + 16 * kq + 4 * j4);
                    const f32x4 w0v = *(const f32x4*)(args.in[I_W0] + hc + 4 * j4), a0v = *(const f32x4*)(args.in[I_A0] + hc + 4 * j4);
#pragma unroll
                    for (int q = 0; q < 4; ++q) { lwv[4 * j4 + q] = -0.6065306597f * sigmoid_f(xl[q] + w0v[q]);        av[4 * j4 + q] = sigmoid_f(xa[q] + a0v[q]); gv[4 * j4 + q] = xg[q]; } }
                asm volatile("s_waitcnt lgkmcnt(0)" ::: "memory");
                float ss = 0.f;
#pragma unroll
                for (int j4 = 0; j4 < 4; ++j4) { const f32x4 kk4 = *(const f32x4*)(args.in[I_KK] + hc + 4 * j4);
#pragma unroll
                    for (int q = 0; q < 4; ++q) { kn[4 * j4 + q] = kl[4 * j4 + q] * kk4[q]; ss += kn[4 * j4 + q] * kn[4 * j4 + q]; } }
                ss += __shfl_xor(ss, 1); ss += __shfl_xor(ss, 2);
                const float kinv = rsq_f(fmaxf(ss, 1e-24f));
#pragma unroll
                for (int j = 0; j < 16; ++j) { float x = lwv[j];
#pragma unroll
                    for (int sft = 4; sft < 64; sft <<= 1) { const float y = __shfl_up(x, sft); if (lane >= sft) x += y; }
                    cl[j] = x; }
                float bon = 0.f;
                u32x4 pa[2], pb[2], pk[2], pr[2];
#pragma unroll
                for (int j4 = 0; j4 < 4; ++j4) {
                    const f32x4 ka = *(const f32x4*)(args.in[I_KA] + hc + 4 * j4), rk = *(const f32x4*)(args.in[I_RK] + hc + 4 * j4);
                    float at4[4], bt4[4], kt4[4], rt4[4];
#pragma unroll
                    for (int q = 0; q < 4; ++q) { const int j = 4 * j4 + q;
                        const float p = __expf(cl[j]), pn = __expf(-cl[j]), pm1 = __expf(cl[j] - lwv[j]); eP[j] = p;
                        const float knj = kn[j] * kinv;
                        const float kp = kl[j] * (1.0f + (av[j] - 1.0f) * ka[q]);
                        at4[q] = -knj * pm1; bt4[q] = knj * av[j] * pn; kt4[q] = kp * pn; rt4[q] = rl[j] * p;
                        bon += rl[j] * kp * rk[q];
                        const int kk = 16 * kq + j;
                        ATt[kk * 16 + te] = (bf16)f2bf(at4[q]); BTt[kk * 16 + te] = (bf16)f2bf(bt4[q]); KTt[kk * 16 + te] = (bf16)f2bf(kt4[q]); VTt[kk * 16 + te] = (bf16)f2bf(vl[j]); }
                    const int hh = j4 >> 1, w2 = (j4 & 1) * 2;
                    pa[hh][w2] = pk2(at4[0], at4[1]); pa[hh][w2 + 1] = pk2(at4[2], at4[3]); pb[hh][w2] = pk2(bt4[0], bt4[1]); pb[hh][w2 + 1] = pk2(bt4[2], bt4[3]);
                    pk[hh][w2] = pk2(kt4[0], kt4[1]); pk[hh][w2 + 1] = pk2(kt4[2], kt4[3]); pr[hh][w2] = pk2(rt4[0], rt4[1]); pr[hh][w2 + 1] = pk2(rt4[2], rt4[3]);
                }
#pragma unroll
                for (int hh = 0; hh < 2; ++hh) { const int po = te * 64 + 8 * ((2 * kq + hh) ^ (te & 7));
                    *(LAS u32x4*)(Arm + po) = pa[hh]; *(LAS u32x4*)(Brm + po) = pb[hh]; *(LAS u32x4*)(Krm + po) = pk[hh]; *(LAS u32x4*)(Rrm + po) = pr[hh]; }
                bon += __shfl_xor(bon, 1); bon += __shfl_xor(bon, 2);
                f32x4 lbv[4], lgv[4];
#pragma unroll
                for (int j4 = 0; j4 < 4; ++j4) { lbv[j4] = *(const f32x4*)(args.in[I_LNB] + hc + 4 * j4); lgv[j4] = *(const f32x4*)(args.in[I_LNG] + hc + 4 * j4); }
#pragma unroll
                for (int j4 = 0; j4 < 4; ++j4) { const f32x4 lb = lbv[j4], lgn = lgv[j4]; const int j0 = 4 * j4;
                    u32x2 ow, gw2; ow.x = pk2((lb.x + vl[j0] * bon) * gv[j0], (lb.y + vl[j0 + 1] * bon) * gv[j0 + 1]); ow.y = pk2((lb.z + vl[j0 + 2] * bon) * gv[j0 + 2], (lb.w + vl[j0 + 3] * bon) * gv[j0 + 3]);
                    gw2.x = pk2(lgn.x * gv[j0], lgn.y * gv[j0 + 1]); gw2.y = pk2(lgn.z * gv[j0 + 2], lgn.w * gv[j0 + 3]);
                    *(u32x2*)((bf16*)(ws + WS_ADD) + off + j0) = ow; *(u32x2*)((bf16*)(ws + WS_G) + off + j0) = gw2; }
            }
            asm volatile("s_waitcnt lgkmcnt(0)" ::: "memory");
            {
                bf16x8 fa[2], fr[2], fb[2], fk[2];
#pragma unroll
                for (int ks = 0; ks < 2; ++ks) { const int po = l15 * 64 + 8 * ((4 * ks + g) ^ (l15 & 7));
                    fa[ks] = *(const LAS bf16x8*)(Arm + po); fr[ks] = *(const LAS bf16x8*)(Rrm + po); fb[ks] = *(const LAS bf16x8*)(Brm + po); fk[ks] = *(const LAS bf16x8*)(Krm + po); }
                f32x4 mab = z4, mak = z4, mrb = z4, mrk = z4;
#pragma unroll
                for (int ks = 0; ks < 2; ++ks) { mab = __builtin_amdgcn_mfma_f32_16x16x32_bf16(fb[ks], fa[ks], mab, 0, 0, 0); mak = __builtin_amdgcn_mfma_f32_16x16x32_bf16(fk[ks], fa[ks], mak, 0, 0, 0);
                    mrb = __builtin_amdgcn_mfma_f32_16x16x32_bf16(fb[ks], fr[ks], mrb, 0, 0, 0); mrk = __builtin_amdgcn_mfma_f32_16x16x32_bf16(fk[ks], fr[ks], mrk, 0, 0, 0); }
#pragma unroll
                for (int e = 0; e < 4; ++e) { const int i = 4 * g + e; if (!(i < l15)) { mab[e] = 0.f; mak[e] = 0.f; } if (!(i <= l15)) { mrb[e] = 0.f; mrk[e] = 0.f; } }
                asm volatile("s_waitcnt lgkmcnt(0)" ::: "memory");
#pragma unroll
                for (int e = 0; e < 4; ++e) MabT[(4 * g + e) * 16 + l15] = mab[e];
                u32x2 w; w.x = pk2(mak[0], mak[1]); w.y = pk2(mak[2], mak[3]); *(LAS u32x2*)(Mak + l15 * 16 + 4 * g) = w;
                w.x = pk2(mrb[0], mrb[1]); w.y = pk2(mrb[2], mrb[3]); *(LAS u32x2*)(Mrb + l15 * 16 + 4 * g) = w;
                w.x = pk2(mrk[0], mrk[1]); w.y = pk2(mrk[2], mrk[3]); *(LAS u32x2*)(Mrk + l15 * 16 + 4 * g) = w;
                if (te == 15) {
#pragma unroll
                    for (int j = 0; j < 16; ++j) PLs[16 * kq + j] = eP[j]; }
            }
            asm volatile("s_waitcnt lgkmcnt(0)" ::: "memory");
            {
                f32x4 mq[15][4];
#pragma unroll
                for (int j = 0; j < 15; ++j)
#pragma unroll
                    for (int q = 0; q < 4; ++q) if (4 * q + 3 > j) mq[j][q] = *(const LAS f32x4*)(MabT + j * 16 + 4 * q);
                float y[16];
#pragma unroll
                for (int j = 15; j >= 0; --j) {
                    float acc = (j == l15) ? 1.0f : 0.0f;
#pragma unroll
                    for (int i = j + 1; i < 16; ++i) acc += y[i] * mq[j < 15 ? j : 0][i >> 2][i & 3];
                    y[j] = acc;
                }
                if (g == 0) { u32x4 t0, t1; t0.x = pk2(y[0], y[1]); t0.y = pk2(y[2], y[3]); t0.z = pk2(y[4], y[5]); t0.w = pk2(y[6], y[7]); t1.x = pk2(y[8], y[9]); t1.y = pk2(y[10], y[11]); t1.z = pk2(y[12], y[13]); t1.w = pk2(y[14], y[15]);
                    *(LAS u32x4*)(Tm + l15 * 16) = t0; *(LAS u32x4*)(Tm + l15 * 16 + 8) = t1; }
            }
            asm volatile("s_waitcnt lgkmcnt(0)" ::: "memory");
            {
                const bool act = g < 2; const int fo = l15 * 16 + 8 * g;
                const bf16x8 fT = act ? *(const LAS bf16x8*)(Tm + fo) : z8, fMak = act ? *(const LAS bf16x8*)(Mak + fo) : z8, fMrb = act ? *(const LAS bf16x8*)(Mrb + fo) : z8, fMrk = act ? *(const LAS bf16x8*)(Mrk + fo) : z8;
                bf16x8 fV[4], fQ1[4], fAh[4], fBT[4], fKT[4];
#pragma unroll
                for (int vt = 0; vt < 4; ++vt) { fV[vt] = act ? *(const LAS bf16x8*)(VTt + vt * 256 + fo) : z8; fBT[vt] = act ? *(const LAS bf16x8*)(BTt + vt * 256 + fo) : z8; fKT[vt] = act ? *(const LAS bf16x8*)(KTt + vt * 256 + fo) : z8; }
#pragma unroll
                for (int vt = 0; vt < 4; ++vt) { const f32x4 q0 = __builtin_amdgcn_mfma_f32_16x16x32_bf16(fMak, fV[vt], z4, 0, 0, 0);
                    u32x2 w; w.x = pk2(q0[0], q0[1]); w.y = pk2(q0[2], q0[3]); *(LAS u32x2*)(Q0T + vt * 256 + l15 * 16 + 4 * g) = w; }
#pragma unroll
                for (int kt = 0; kt < 4; ++kt) { const bf16x8 fA = act ? *(const LAS bf16x8*)(ATt + kt * 256 + fo) : z8; const f32x4 ah = __builtin_amdgcn_mfma_f32_16x16x32_bf16(fT, fA, z4, 0, 0, 0);
                    u32x2 w; w.x = pk2(ah[0], ah[1]); w.y = pk2(ah[2], ah[3]); *(LAS u32x2*)(ATt + kt * 256 + l15 * 16 + 4 * g) = w; }
                asm volatile("s_waitcnt lgkmcnt(0)" ::: "memory");
#pragma unroll
                for (int vt = 0; vt < 4; ++vt) { const bf16x8 fQ0 = act ? *(const LAS bf16x8*)(Q0T + vt * 256 + fo) : z8; const f32x4 q1 = __builtin_amdgcn_mfma_f32_16x16x32_bf16(fT, fQ0, z4, 0, 0, 0);
                    u32x2 w; w.x = pk2(q1[0], q1[1]); w.y = pk2(q1[2], q1[3]); *(LAS u32x2*)(Q0T + vt * 256 + l15 * 16 + 4 * g) = w; }
                asm volatile("s_waitcnt lgkmcnt(0)" ::: "memory");
#pragma unroll
                for (int vt = 0; vt < 4; ++vt) { fQ1[vt] = act ? *(const LAS bf16x8*)(Q0T + vt * 256 + fo) : z8; fAh[vt] = act ? *(const LAS bf16x8*)(ATt + vt * 256 + fo) : z8; }
                bf16* rp = (bf16*)(ws + WS_RP) + (size_t)un * 1024 + l15 * 64;
#pragma unroll
                for (int kt = 0; kt < 4; ++kt) {
                    const u32x2 rr = *(const LAS u32x2*)(Rrm + l15 * 64 + 8 * ((2 * kt + (g >> 1)) ^ (l15 & 7)) + 4 * (g & 1));
                    f32x4 ini; ini[0] = bflo(rr.x); ini[1] = bfhi(rr.x); ini[2] = bflo(rr.y); ini[3] = bfhi(rr.y);
                    const f32x4 rh = __builtin_amdgcn_mfma_f32_16x16x32_bf16(fAh[kt], fMrb, ini, 0, 0, 0);
                    u32x2 w; w.x = pk2(rh[0], rh[1]); w.y = pk2(rh[2], rh[3]); *(u32x2*)(rp + 32 * (kt >> 1) + 8 * g + 4 * (kt & 1)) = w;
                }
#pragma unroll
                for (int vt = 0; vt < 4; ++vt) { f32x4 y1 = __builtin_amdgcn_mfma_f32_16x16x32_bf16(fMrb, fQ1[vt], z4, 0, 0, 0); y1 = __builtin_amdgcn_mfma_f32_16x16x32_bf16(fMrk, fV[vt], y1, 0, 0, 0);
                    *(f32x4*)((float*)(ws + WS_Y1F) + ((size_t)(un * 4 + vt) * 64 + lane) * 4) = y1; }
                LAS bf16* tgs = (LAS bf16*)(wl + 8192);
#pragma unroll
                for (int krt = 0; krt < 4; ++krt) { const float pl = PLs[16 * krt + l15];
#pragma unroll
                    for (int kct = 0; kct < 4; ++kct) { f32x4 ga = __builtin_amdgcn_mfma_f32_16x16x32_bf16(fAh[kct], fBT[krt], z4, 0, 0, 0);
                        if (kct == krt) {
#pragma unroll
                            for (int e = 0; e < 4; ++e) if (4 * g + e == l15) ga[e] += 1.0f; }
                        u32x2 w; w.x = pk2(ga[0] * pl, ga[1] * pl); w.y = pk2(ga[2] * pl, ga[3] * pl);
                        *(LAS u32x2*)(tgs + (16 * krt + l15) * 64 + 32 * (kct >> 1) + 8 * g + 4 * (kct & 1)) = w; } }
                { u32x4* gp16 = (u32x4*)((bf16*)(ws + WS_GP) + (size_t)un * 4096);
#pragma unroll
                  for (int i = 0; i < 8; ++i) gp16[i * 64 + lane] = *(const LAS u32x4*)(tgs + (i * 64 + lane) * 8); }
#pragma unroll
                for (int mt = 0; mt < 4; ++mt) { const f32x4 pl4 = *(const LAS f32x4*)(PLs + 16 * mt + 4 * g);
#pragma unroll
                    for (int vt = 0; vt < 4; ++vt) { f32x4 ha = __builtin_amdgcn_mfma_f32_16x16x32_bf16(fBT[mt], fQ1[vt], z4, 0, 0, 0); ha = __builtin_amdgcn_mfma_f32_16x16x32_bf16(fKT[mt], fV[vt], ha, 0, 0, 0);
                        u32x2 w; w.x = pk2(ha[0] * pl4[0], ha[1] * pl4[1]); w.y = pk2(ha[2] * pl4[2], ha[3] * pl4[3]);
                        *(u32x2*)((bf16*)(ws + WS_HF) + ((size_t)((un * 4 + vt) * 4 + mt) * 64 + lane) * 4) = w; } }
            }
            asm volatile("s_waitcnt lgkmcnt(0)" ::: "memory");
        }
        asm volatile("s_waitcnt vmcnt(0)" ::: "memory");
        { const int ltid = fresh_tid() & 63, l15 = ltid & 15, g = ltid >> 4, lane = ltid;
#define CP_LOADG(gf_, j_) do { const bf16* gp_ = (const bf16*)(ws + WS_GP) + ((size_t)u64 * 4 + (j_)) * 4096 + l15 * 64 + 8 * g; \
            _Pragma("unroll") for (int mt = 0; mt < 4; ++mt) { gf_[mt][0] = *(const bf16x8*)(gp_ + mt * 1024); gf_[mt][1] = *(const bf16x8*)(gp_ + mt * 1024 + 32); } } while (0)
#define CP_LOADH(hf_, j_) do { _Pragma("unroll") for (int sl = 0; sl < 4; ++sl) _Pragma("unroll") for (int mt = 0; mt < 4; ++mt) \
            hf_[sl][mt] = *(const u32x2*)((const bf16*)(ws + WS_HF) + ((size_t)((((size_t)u64 * 4 + (j_)) * 4 + sl) * 4 + mt) * 64 + lane) * 4); } while (0)
#define CP_STEP(gf_, hf_, useh_) do { _Pragma("unroll") for (int sl = 0; sl < 4; ++sl) { bf16x8 zb[2]; RW_ZB(z[sl], zb); \
            _Pragma("unroll") for (int mt = 0; mt < 4; ++mt) { f32x4 a_ = (f32x4){0.f, 0.f, 0.f, 0.f}; \
                if (useh_) { a_[0] = bflo(hf_[sl][mt].x); a_[1] = bfhi(hf_[sl][mt].x); a_[2] = bflo(hf_[sl][mt].y); a_[3] = bfhi(hf_[sl][mt].y); } \
                a_ = __builtin_amdgcn_mfma_f32_16x16x32_bf16(gf_[mt][0], zb[0], a_, 0, 0, 0); a_ = __builtin_amdgcn_mfma_f32_16x16x32_bf16(gf_[mt][1], zb[1], a_, 0, 0, 0); z[sl][mt] = a_; } } } while (0)
        {
            f32x4 z[4][4];
#pragma unroll
            for (int sl = 0; sl < 4; ++sl)
#pragma unroll
                for (int mt = 0; mt < 4; ++mt)
#pragma unroll
                    for (int e = 0; e < 4; ++e) z[sl][mt][e] = (sl == mt && 4 * g + e == l15) ? 1.0f : 0.0f;
            bf16x8 gA[4][2], gB[4][2]; u32x2 hdum[4][4];
            CP_LOADG(gA, 0); CP_LOADG(gB, 1);
            CP_STEP(gA, hdum, false); CP_LOADG(gA, 2);
            CP_STEP(gB, hdum, false); CP_LOADG(gB, 3);
            CP_STEP(gA, hdum, false);
            CP_STEP(gB, hdum, false);
            LAS bf16* tg = (LAS bf16*)(lds + wave * 16384);
#pragma unroll
            for (int sl = 0; sl < 4; ++sl) { const int pc = 32 * (sl >> 1) + 8 * (l15 >> 2) + 4 * (sl & 1) + (l15 & 3);
#pragma unroll
                for (int mt = 0; mt < 4; ++mt)
#pragma unroll
                    for (int e = 0; e < 4; ++e) tg[(16 * mt + 4 * g + e) * 64 + pc] = (bf16)f2bf(z[sl][mt][e]); }
            u32x4* gc = (u32x4*)((bf16*)(ws + WS_GC) + (size_t)u64 * 4096);
#pragma unroll
            for (int i = 0; i < 8; ++i) gc[i * 64 + lane] = *(const LAS u32x4*)(tg + (i * 64 + lane) * 8);
        }
        {
            f32x4 z[4][4];
#pragma unroll
            for (int sl = 0; sl < 4; ++sl)
#pragma unroll
                for (int mt = 0; mt < 4; ++mt) z[sl][mt] = (f32x4){0.f, 0.f, 0.f, 0.f};
            bf16x8 gA[4][2], gB[4][2]; u32x2 hA[4][4], hB[4][4];
            CP_LOADG(gA, 0); CP_LOADH(hA, 0); CP_LOADG(gB, 1); CP_LOADH(hB, 1);
            CP_STEP(gA, hA, true); CP_LOADG(gA, 2); CP_LOADH(hA, 2);
            CP_STEP(gB, hB, true); CP_LOADG(gB, 3); CP_LOADH(hB, 3);
            CP_STEP(gA, hA, true);
            CP_STEP(gB, hB, true);
#pragma unroll
            for (int sl = 0; sl < 4; ++sl)
#pragma unroll
                for (int mt = 0; mt < 4; ++mt) { u32x2 w; w.x = pk2(z[sl][mt][0], z[sl][mt][1]); w.y = pk2(z[sl][mt][2], z[sl][mt][3]);
                    *(u32x2*)((bf16*)(ws + WS_HC) + ((size_t)((u64 * 4 + sl) * 4 + mt) * 64 + lane) * 4) = w; }
        }
#undef CP_LOADG
#undef CP_LOADH
#undef CP_STEP
        }
        }
    }
    SEAM(3);


    if (IN(4)) { PHASE_IDS;
        if (!(bid < 128 && wave == 0)) {
            const int wi = bid < 128 ? bid * 7 + (wave - 1) : 896 + (bid - 128) * 8 + wave, NW = 896 + (G - 128) * 8;
        } else {
            const int l15 = lane & 15, g = lane >> 4, bh = bid >> 2, vs = bid & 3;
            f32x4 z[4];
#pragma unroll
            for (int mt = 0; mt < 4; ++mt) z[mt] = (f32x4){0.f, 0.f, 0.f, 0.f};
            bf16x8 gA[4][2], gB[4][2], gC[4][2], gD[4][2]; u32x2 hA[4], hB[4], hC[4], hD[4];
#define SC_LOAD(gf, hf, C) do { const size_t u64_ = (size_t)bh * 64 + (C); const bf16* gp_ = (const bf16*)(ws + WS_GC) + u64_ * 4096 + l15 * 64 + 8 * g; \
                _Pragma("unroll") for (int mt = 0; mt < 4; ++mt) { gf[mt][0] = *(const bf16x8*)(gp_ + mt * 1024); gf[mt][1] = *(const bf16x8*)(gp_ + mt * 1024 + 32); \
                    hf[mt] = *(const u32x2*)((const bf16*)(ws + WS_HC) + ((size_t)((u64_ * 4 + vs) * 4 + mt) * 64 + lane) * 4); } } while (0)
#define SC_STEP(gf, hf, C) do { const size_t u64_ = (size_t)bh * 64 + (C); bf16* zs_ = (bf16*)(ws + WS_ZS) + ((size_t)((u64_ * 4 + vs) * 4) * 64 + lane) * 4; \
                _Pragma("unroll") for (int mt = 0; mt < 4; ++mt) { u32x2 zw_; zw_.x = pk2(z[mt][0], z[mt][1]); zw_.y = pk2(z[mt][2], z[mt][3]); *(u32x2*)(zs_ + mt * 256) = zw_; } \
                bf16x8 zb[2]; RW_ZB(z, zb); \
                _Pragma("unroll") for (int mt = 0; mt < 4; ++mt) { f32x4 a; a[0] = bflo(hf[mt].x); a[1] = bfhi(hf[mt].x); a[2] = bflo(hf[mt].y); a[3] = bfhi(hf[mt].y); \
                    a = __builtin_amdgcn_mfma_f32_16x16x32_bf16(gf[mt][0], zb[0], a, 0, 0, 0); a = __builtin_amdgcn_mfma_f32_16x16x32_bf16(gf[mt][1], zb[1], a, 0, 0, 0); z[mt] = a; } } while (0)
            bf16x8 gE[4][2]; u32x2 hE[4];
            SC_LOAD(gA, hA, 0); SC_LOAD(gB, hB, 1); SC_LOAD(gC, hC, 2); SC_LOAD(gD, hD, 3);
#pragma unroll 1
            for (int C = 0; C < 60; C += 5) {
                SC_LOAD(gE, hE, C + 4);
                SC_STEP(gA, hA, C);     SC_LOAD(gA, hA, C + 5);
                SC_STEP(gB, hB, C + 1); SC_LOAD(gB, hB, C + 6);
                SC_STEP(gC, hC, C + 2); SC_LOAD(gC, hC, C + 7);
                SC_STEP(gD, hD, C + 3); SC_LOAD(gD, hD, C + 8);
                SC_STEP(gE, hE, C + 4);
            }
            SC_STEP(gA, hA, 60); SC_STEP(gB, hB, 61); SC_STEP(gC, hC, 62); SC_STEP(gD, hD, 63);
#undef SC_LOAD
#undef SC_STEP
        }
    }
    if (IN(4)) { PHASE_IDS;
        if (bid < 32 && wave == 1) { const int bc = bid; const f32x2* ag = (const f32x2*)((const float*)(ws + WS_AP)) + (size_t)(bc * 64) * 64 + lane;
            float* car = (float*)(ws + WS_AP + 4 * MiB) + (size_t)(bc * 64) * 64 + lane; float hst = 0.f;
            f32x2 abv[64];
#pragma unroll
            for (int sg = 0; sg < 64; ++sg) abv[sg] = ag[(size_t)sg * 64];
#pragma unroll
            for (int sg = 0; sg < 64; ++sg) { car[(size_t)sg * 64] = hst; hst = abv[sg].x * hst + abv[sg].y; } }
    }
    if (IN(4)) { PHASE_IDS;
        bf16* WKt = HN; bf16* VWt = HN + (size_t)4 * 1024 * 1024;
        __syncthreads();
        if (bid >= 128 && bid < 192) { pg8::FoldSched<0> S; S.A = (const char*)KM; S.B = (const char*)Wq_t; S.G = 64; S.c = bid - 128; EpiFold<0> E{(unsigned char*)WKt}; pg8::gemm_phase(lds, 256, S, E, wv0, 1024); }
        else if (bid >= 192) { pg8::FoldSched<1> S; S.A = (const char*)Wo_t; S.B = (const char*)VT; S.G = 64; S.c = bid - 192; EpiFold<1> E{(unsigned char*)VWt}; pg8::gemm_phase(lds, 256, S, E, wv0, 1024); }
    }
    SEAM(4);

    if (IN(5)) { PHASE_IDS;
        {
            for (int lu = gw; lu < (M / 64) * 8; lu += NGW) {
                const int seg = lu >> 3, nb = lu & 7, rr = lane >> 3, cq = lane & 7;
                const float* cp = (const float*)(ws + WS_AP + 4 * MiB) + ((size_t)(((seg >> 6) * 8 + nb) * 64 + (seg & 63)) * 64 + 8 * cq);
                const f32x4 c0 = *(const f32x4*)cp, c1 = *(const f32x4*)(cp + 4);
#pragma unroll 1
                for (int ih = 0; ih < 2; ++ih) {
                u32x4 pws[4], hws[4], gws[4];
#pragma unroll
                for (int i4 = 0; i4 < 4; ++i4) { const int it = 4 * ih + i4; const size_t m = (size_t)seg * 64 + 8 * it + rr; const size_t o = m * 512 + nb * 64 + 8 * cq;
                    pws[i4] = __builtin_nontemporal_load((const u32x4*)(LA + o)); hws[i4] = __builtin_nontemporal_load((const u32x4*)(LB + o)); gws[i4] = __builtin_nontemporal_load((const u32x4*)(U + m * INW + 512 + nb * 64 + 8 * cq)); }
#pragma unroll
                for (int i4 = 0; i4 < 4; ++i4) { const int it = 4 * ih + i4; const size_t m = (size_t)seg * 64 + 8 * it + rr;
                    const u32x4 pw = pws[i4], hw = hws[i4], gw_ = gws[i4];
                    float y[8];
#pragma unroll
                    for (int q = 0; q < 4; ++q) { const float ca = q < 2 ? c0[2 * q] : c1[2 * q - 4], cb = q < 2 ? c0[2 * q + 1] : c1[2 * q - 3];
                        y[2 * q] = (bflo(hw[q]) + bflo(pw[q]) * ca) * gelu_tanh_f(bflo(gw_[q])); y[2 * q + 1] = (bfhi(hw[q]) + bfhi(pw[q]) * cb) * gelu_tanh_f(bfhi(gw_[q])); }
                    u32x4 w; w.x = pk2(y[0], y[1]); w.y = pk2(y[2], y[3]); w.z = pk2(y[4], y[5]); w.w = pk2(y[6], y[7]);
                    *(u32x4*)(CAT + m * 1024 + nb * 64 + 8 * cq) = w; }
                }
            }
        }
        const int l15 = lane & 15, g = lane >> 4;
        LAS bf16* tGL = (LAS bf16*)(lds + wave * 16384); LAS bf16* tAD = tGL + 1024; LAS bf16* tOUT = tGL + 2048;
        const int ct = lane >> 3, cc = lane & 7;
        for (int u64 = gw; u64 < NB * NH * (SEQ / 64); u64 += NGW) {
            const int bh = u64 >> 6, C = u64 & 63, b = bh >> 3, h = bh & 7;
            f32x4 z[4][4];
#pragma unroll
            for (int sl = 0; sl < 4; ++sl)
#pragma unroll
                for (int mt = 0; mt < 4; ++mt) { const u32x2 zw = *(const u32x2*)((const bf16*)(ws + WS_ZS) + ((size_t)((u64 * 4 + sl) * 4 + mt) * 64 + lane) * 4); z[sl][mt] = (f32x4){bflo(zw.x), bfhi(zw.x), bflo(zw.y), bfhi(zw.y)}; }
#pragma unroll 1
            for (int j = 0; j < 4; ++j) {
                const size_t un = (size_t)u64 * 4 + j; const size_t m0 = (size_t)b * SEQ + (C * 4 + j) * 16;
                const bf16* rp = (const bf16*)(ws + WS_RP) + un * 1024 + l15 * 64 + 8 * g;
                const bf16x8 rf0 = __builtin_nontemporal_load((const bf16x8*)rp), rf1 = __builtin_nontemporal_load((const bf16x8*)(rp + 32));
                f32x4 y[4];
#pragma unroll
                for (int sl = 0; sl < 4; ++sl) y[sl] = __builtin_nontemporal_load((const f32x4*)((const float*)(ws + WS_Y1F) + ((size_t)(un * 4 + sl) * 64 + lane) * 4));
                const size_t rg = (m0 + ct) * 512 + h * 64 + 8 * cc;
                const u32x4 gl0 = __builtin_nontemporal_load((const u32x4*)((const bf16*)(ws + WS_G) + rg)), gl1 = __builtin_nontemporal_load((const u32x4*)((const bf16*)(ws + WS_G) + rg + 8 * 512));
                const u32x4 ad0 = __builtin_nontemporal_load((const u32x4*)((const bf16*)(ws + WS_ADD) + rg)), ad1 = __builtin_nontemporal_load((const u32x4*)((const bf16*)(ws + WS_ADD) + rg + 8 * 512));
                bf16x8 gf[4][2]; u32x2 hfr[4][4];
                if (j < 3) {
                    const bf16* gp = (const bf16*)(ws + WS_GP) + un * 4096 + l15 * 64 + 8 * g;
#pragma unroll
                    for (int mt = 0; mt < 4; ++mt) { gf[mt][0] = __builtin_nontemporal_load((const bf16x8*)(gp + mt * 1024)); gf[mt][1] = __builtin_nontemporal_load((const bf16x8*)(gp + mt * 1024 + 32)); }
#pragma unroll
                    for (int sl = 0; sl < 4; ++sl)
#pragma unroll
                        for (int mt = 0; mt < 4; ++mt) hfr[sl][mt] = __builtin_nontemporal_load((const u32x2*)((const bf16*)(ws + WS_HF) + ((size_t)((un * 4 + sl) * 4 + mt) * 64 + lane) * 4));
                }
                *(LAS u32x4*)(tGL + ct * 64 + 8 * cc) = gl0; *(LAS u32x4*)(tGL + (ct + 8) * 64 + 8 * cc) = gl1;
                *(LAS u32x4*)(tAD + ct * 64 + 8 * cc) = ad0; *(LAS u32x4*)(tAD + (ct + 8) * 64 + 8 * cc) = ad1;
                bf16x8 zb[4][2];
#pragma unroll
                for (int sl = 0; sl < 4; ++sl) { RW_ZB(z[sl], zb[sl]);
                    y[sl] = __builtin_amdgcn_mfma_f32_16x16x32_bf16(rf0, zb[sl][0], y[sl], 0, 0, 0); y[sl] = __builtin_amdgcn_mfma_f32_16x16x32_bf16(rf1, zb[sl][1], y[sl], 0, 0, 0); }
#pragma unroll
                for (int e = 0; e < 4; ++e) {
                    float s1 = (y[0][e] + y[1][e]) + (y[2][e] + y[3][e]);
                    s1 += __shfl_xor(s1, 1); s1 += __shfl_xor(s1, 2); s1 += __shfl_xor(s1, 4); s1 += __shfl_xor(s1, 8);
                    const float mean = s1 * (1.0f / 64.0f);
                    float d0 = y[0][e] - mean, d1 = y[1][e] - mean, d2 = y[2][e] - mean, d3 = y[3][e] - mean;
                    float s2 = (d0 * d0 + d1 * d1) + (d2 * d2 + d3 * d3);
                    s2 += __shfl_xor(s2, 1); s2 += __shfl_xor(s2, 2); s2 += __shfl_xor(s2, 4); s2 += __shfl_xor(s2, 8);
                    const float rstd = rsq_f(s2 * (1.0f / 64.0f) + GN_EPS);
                    const float dd[4] = {d0, d1, d2, d3};
#pragma unroll
                    for (int sl = 0; sl < 4; ++sl) { const int ti_ = (4 * g + e) * 64 + 16 * sl + l15;
                        const float o = dd[sl] * rstd * bf2f(tGL[ti_]) + bf2f(tAD[ti_]); tOUT[ti_] = (bf16)f2bf(o); }
                }
                { bf16* cp = CAT + (m0 + ct) * 1024 + 512 + h * 64 + 8 * cc;
                  *(u32x4*)cp = *(const LAS u32x4*)(tOUT + ct * 64 + 8 * cc); *(u32x4*)(cp + 8 * 1024) = *(const LAS u32x4*)(tOUT + (ct + 8) * 64 + 8 * cc); }
                if (j < 3) {
#pragma unroll
                    for (int sl = 0; sl < 4; ++sl)
#pragma unroll
                        for (int mt = 0; mt < 4; ++mt) { const u32x2 hh = hfr[sl][mt];
                            f32x4 a; a[0] = bflo(hh.x); a[1] = bfhi(hh.x); a[2] = bflo(hh.y); a[3] = bfhi(hh.y);
                            a = __builtin_amdgcn_mfma_f32_16x16x32_bf16(gf[mt][0], zb[sl][0], a, 0, 0, 0); a = __builtin_amdgcn_mfma_f32_16x16x32_bf16(gf[mt][1], zb[sl][1], a, 0, 0, 0); z[sl][mt] = a; }
                }
            }
        }
    }
    SEAM(5);
#undef RW_ZB


    if (IN(6)) { PHASE_IDS;
        pg8::DenseSched S; S.o.init_tiles(M / 256, D / 256, G, bid); S.A = (const char*)CAT; S.B = (const char*)Wout_t; S.tstep = (size_t)256 * D * 2;
        EpiBf16Res<false> E{args.in[I_X], X1, D, (float*)(ws + WS_AP + 2 * MiB), 1.0f, X1F8}; pg8::gemm_phase(lds, D, S, E, wv0);
    }
    SEAM(6);
    if (IN(7)) { PHASE_IDS;
        pg8::BatchBSched S; S.o.init_tiles(M / 256, D / 256, G, bid); S.A = (const char*)X1F8; S.B = (const char*)HN; S.tstep = (size_t)256 * 1024; S.bstep = (size_t)1024 * 1024;
        EpiSoftmax E{(unsigned char*)Qb, 0.0625f * 0.25f, (const float*)(ws + WS_AP + 2 * MiB), (LAS float*)(lds + RING_BYTES + 1024), (LAS float*)(lds + RING_BYTES + 1024 + 4096)};
        pg8::gemm_phase<EpiSoftmax, pg8::BatchBSched, true, true>(lds, 512, S, E, wv0);
    }
    SEAM(7);
    if (IN(8)) { PHASE_IDS;
        pg8::BatchBSched S; S.o.init_tiles(M / 256, D / 256, G, bid); S.A = (const char*)Qb; S.B = (const char*)(HN + (size_t)4 * 1024 * 1024); S.tstep = (size_t)256 * 1024; S.bstep = (size_t)1024 * 1024;
        EpiBf16Res<true> E{X1, X2, D, nullptr, 1.0f / 1024.0f, nullptr}; pg8::gemm_phase<EpiBf16Res<true>, pg8::BatchBSched, true, true>(lds, 512, S, E, wv0);
    }
    SEAM(8);
    if (IN(9)) { PHASE_IDS;
        for (int cid = tid; cid < 2 * NE * 128; cid += NTHREADS) { const int t = cid >> 12, row = (cid >> 7) & 31, c = cid & 127;
            *(LAS u32x4*)(lds + t * 65536 + row * 2048 + ((c ^ (row & 7)) << 4)) = *(const u32x4*)(WrT + (size_t)t * NE * D + row * D + 8 * c); }
        __syncthreads();
        const int l15 = lane & 15, g = lane >> 4;
        LAS float* LG = (LAS float*)(lds + RING_BYTES + 1024 + wave * 2304);
        const float* gfn = args.in[I_NFFG];
        LAS unsigned* cntl = (LAS unsigned*)(lds + RING_BYTES + 640);
        for (int t0 = 0; t0 < M / 16; t0 += G * 4) {
        if (tid < 64) cntl[tid] = 0u;
        __syncthreads();
        if (t0 == 0 && wave >= 4) {
            constexpr int I_DN = 16 * 32, I_GU = 16 * 64;
            for (int r = bid * 4 + (wave - 4); r < CONV_P9D; r += G * 4) { const int e = r / I_DN, q = r % I_DN, kb = q / 32, nb = q % 32;
                transpose_item_tiled_fp8_nolds(args.in[I_WDN] + (size_t)e * DFF * D, D, DFF, (unsigned char*)Wdn_t + (size_t)e * D * DFF, 64 * kb, 32 * nb, 32 * nb, lane); }
        }
        const int tile = t0 + bid * 4 + wave; const bool active = wave < 4 && tile < M / 16;
        int me = 0, lpos = 0, ai = 0; float mg = 0.f;
        if (active) {
            const int m0 = tile * 16;
            const bf16* xrow = X2 + (size_t)(m0 + l15) * D + 8 * g;
            float ss = 0.f;
#pragma unroll 8
            for (int ks = 0; ks < 32; ++ks) { const u32x4 xw = *(const u32x4*)(xrow + 32 * ks);
#pragma unroll
                for (int q = 0; q < 4; ++q) { const float a = bflo(xw[q]), c = bfhi(xw[q]); ss += a * a + c * c; } }
            ss += __shfl_xor(ss, 16); ss += __shfl_xor(ss, 32);
            const float rstd = rsq_f(ss * (1.f / D) + EPS);
            f32x4 acc0 = (f32x4){0.f, 0.f, 0.f, 0.f}, acc1 = acc0;
            unsigned char* hrow = (unsigned char*)HN + (size_t)(m0 + l15) * D + 8 * g;
#pragma unroll 2
            for (int ks = 0; ks < 32; ++ks) {
                const f32x4 g0 = *(const f32x4*)(gfn + 32 * ks + 8 * g), g1 = *(const f32x4*)(gfn + 32 * ks + 8 * g + 4);
                const u32x4 xw = *(const u32x4*)(xrow + 32 * ks);
                float hf[8];
#pragma unroll
                for (int q = 0; q < 4; ++q) { hf[2 * q] = bflo(xw[q]) * rstd * (q < 2 ? g0[2 * q] : g1[2 * q - 4]); hf[2 * q + 1] = bfhi(xw[q]) * rstd * (q < 2 ? g0[2 * q + 1] : g1[2 * q - 3]); }
                u32x4 hi, lo;
#pragma unroll
                for (int q = 0; q < 4; ++q) { hi[q] = pk2(hf[2 * q], hf[2 * q + 1]); lo[q] = pk2(hf[2 * q] - bflo(hi[q]), hf[2 * q + 1] - bfhi(hi[q])); }
                { u32x2 h8; h8.x = pk4_fp8(hf[0], hf[1], hf[2], hf[3]); h8.y = pk4_fp8(hf[4], hf[5], hf[6], hf[7]); *(u32x2*)(hrow + 32 * ks) = h8; }
                const bf16x8 ah = __builtin_bit_cast(bf16x8, hi), al = __builtin_bit_cast(bf16x8, lo);
                const int c = 4 * ks + g;
#pragma unroll
                for (int nt = 0; nt < 2; ++nt) { const int row = 16 * nt + l15; const int off = row * 2048 + ((c ^ (row & 7)) << 4);
                    const bf16x8 bh = *(const LAS bf16x8*)(lds + off), bl = *(const LAS bf16x8*)(lds + 65536 + off);
                    f32x4 a = nt ? acc1 : acc0;
                    a = __builtin_amdgcn_mfma_f32_16x16x32_bf16(ah, bh, a, 0, 0, 0); a = __builtin_amdgcn_mfma_f32_16x16x32_bf16(ah, bl, a, 0, 0, 0); a = __builtin_amdgcn_mfma_f32_16x16x32_bf16(al, bh, a, 0, 0, 0);
                    if (nt) acc1 = a; else acc0 = a; }
            }
            { const float b0 = args.in[I_BR][l15], b1 = args.in[I_BR][16 + l15];
#pragma unroll
              for (int j = 0; j < 4; ++j) { LG[(4 * g + j) * 33 + l15] = acc0[j] + b0; LG[(4 * g + j) * 33 + 16 + l15] = acc1[j] + b1; } }
            const int rrow = lane >> 2, qq = lane & 3;
            float tv[4] = {-3.0e38f, -3.0e38f, -3.0e38f, -3.0e38f}; int ti[4] = {64, 65, 66, 67};
#define TOP_INS(xv_, xi_) do { float x_ = (xv_); int i_ = (xi_); _Pragma("unroll") for (int p_ = 0; p_ < 4; ++p_) { const bool b_ = x_ > tv[p_] || (x_ == tv[p_] && i_ < ti[p_]); \
                const float ov_ = tv[p_]; const int oi_ = ti[p_]; tv[p_] = b_ ? x_ : ov_; ti[p_] = b_ ? i_ : oi_; x_ = b_ ? ov_ : x_; i_ = b_ ? oi_ : i_; } } while (0)
#pragma unroll
            for (int j = 0; j < 8; ++j) TOP_INS(LG[rrow * 33 + 8 * qq + j], 8 * qq + j);
#pragma unroll
            for (int st = 1; st < 4; st <<= 1) { float pv[4]; int pi[4];
#pragma unroll
                for (int p = 0; p < 4; ++p) { pv[p] = __shfl_xor(tv[p], st); pi[p] = __shfl_xor(ti[p], st); }
#pragma unroll
                for (int p = 0; p < 4; ++p) TOP_INS(pv[p], pi[p]); }
#undef TOP_INS
            const float e1 = __expf(tv[1] - tv[0]), e2 = __expf(tv[2] - tv[0]), e3 = __expf(tv[3] - tv[0]);
            const float inv = rcp_f(1.0f + e1 + e2 + e3);
            me = qq == 0 ? ti[0] : qq == 1 ? ti[1] : qq == 2 ? ti[2] : ti[3];
            mg = (qq == 0 ? 1.0f : qq == 1 ? e1 : qq == 2 ? e2 : e3) * inv;
            lpos = (int)__hip_atomic_fetch_add(cntl + me, 1u, __ATOMIC_RELAXED, __HIP_MEMORY_SCOPE_WORKGROUP);
            ai = (m0 + rrow) * 4 + qq;
        }
        __syncthreads();
        if (tid < NE) { const unsigned c = cntl[tid]; cntl[32 + tid] = c ? atomicAdd(ecnt + 64 * tid, c) : 0u; }
        __syncthreads();
        if (active) { route_e[ai] = me; route_pos[ai] = (int)cntl[32 + me] + lpos; route_g[ai] = mg; }
        __syncthreads();
        }
        { LAS float* scr = (LAS float*)(lds + wave * 16384); constexpr int I_GU = 16 * 64;
          for (int r = gw; r < CONV_P9; r += NGW) { const int e = r / I_GU, q = r % I_GU, kb = q / 64, nb = q % 64; const int n0 = 32 * nb;
              const int drow = n0 < 1024 ? (256 * (n0 >> 7) + (n0 & 127)) : (256 * ((n0 - 1024) >> 7) + 128 + ((n0 - 1024) & 127));
              transpose_item_tiled_fp8(args.in[I_WGU] + (size_t)e * D * 2048, 2048, D, (unsigned char*)Wgu_t + (size_t)e * 2048 * D, 64 * kb, n0, drow, scr, lane); } }
    }
    SEAM(9);
    if (IN(10)) { PHASE_IDS;
        LAS int* pst = (LAS int*)lds;
        if (wave == 0) {
            const int c = lane < NE ? (int)__hip_atomic_load(ecnt + 64 * lane, __ATOMIC_RELAXED, __HIP_MEMORY_SCOPE_AGENT) : 0; const int pc = (c + 255) & ~255;
            int x = pc;
#pragma unroll
            for (int d = 1; d < 32; d <<= 1) { const int y = __shfl_up(x, d); if (lane >= d) x += y; }
            if (lane < NE) { pst[lane] = x - pc; pst[64 + lane] = c; } if (lane == NE - 1) pst[32] = x; }
        __syncthreads();
        for (int ai = bid * NTHREADS + tid; ai < NASSIGN; ai += G * NTHREADS) {
            const int e = route_e[ai]; const int row = pst[e] + route_pos[ai]; { u32x2 sg_; sg_.x = (unsigned)ai; sg_.y = __float_as_uint(route_g[ai]); row_sg[row] = sg_; } row_tok[row] = ai >> 2; }
        if (bid < NE) { const int e = bid, c = pst[64 + e], pe = (c + 255) & ~255; for (int p = c + tid; p < pe; p += NTHREADS) { u32x2 sg_; sg_.x = 0xffffffffu; sg_.y = 0u; row_sg[pst[e] + p] = sg_; row_tok[pst[e] + p] = 0; } }
        if (bid == 0 && tid == 0) tile_tab[0] = pst[32] >> 8;
        if (bid >= 128 && bid < 136) { const int nt = pst[32] >> 8, nN = bid < 132 ? 8 : 4; int* tab = (int*)(ws + WS_ROUTE + (bid < 132 ? RT_UGU : RT_UDN));
            for (int L = (bid & 3) * NTHREADS + tid; L < nt * nN; L += 4 * NTHREADS) { Unit uu; { const int nwg = nt * nN; int wgid = L; { const int q = nwg / 8, r = nwg % 8, xcd = wgid % 8, off = wgid / 8; wgid = (xcd < r ? xcd * (q + 1) : r * (q + 1) + (xcd - r) * q) + off; }
                    const int nig = 8 * nN, gid = wgid / nig, fm = gid * 8, gsz = (nt - fm) < 8 ? (nt - fm) : 8; uu.pm = fm + ((wgid % nig) % gsz); uu.pn = (wgid % nig) / gsz; uu.e = 0; }
                int e = 0;
#pragma unroll
                for (int st = 16; st >= 1; st >>= 1) { if ((pst[e + st] >> 8) <= uu.pm) e += st; }
                tab[L] = uu.pm | (uu.pn << 12) | (e << 16); } }
        __syncthreads();
    }
    SEAM(10);
    if (IN(11)) {
        const int ntiles = tile_tab[0];
        pg8::MoeGatherSched S; S.o.init_tiles(ntiles, 2048 / 256, G, bid); S.A = (const char*)HN; S.B = (const char*)Wgu_t; S.tile_e = tile_tab + 16; S.utab = (const int*)(ws + WS_ROUTE + RT_UGU); S.rtok = row_tok; S.tstep = (size_t)256 * 1024; S.estep = (size_t)2048 * 1024;
        EpiSwiglu E{ACT, args.in[I_BGU]}; pg8::gemm_phase<EpiSwiglu, pg8::MoeGatherSched, true, true>(lds, 512, S, E, wv0);
        if constexpr (CONV_P9D < NE * 16 * 32) { PHASE_IDS; LAS float* scr = (LAS float*)(lds + wave * 16384); constexpr int I_DN = 16 * 32;
          for (;;) { int c0 = 0; if (lane == 0) c0 = (int)atomicAdd(ctl + CW_CONV, 8u); c0 = __builtin_amdgcn_readfirstlane(c0);
              c0 += CONV_P9D; if (c0 >= NE * I_DN) break;
              for (int r = c0; r < c0 + 8; ++r) { const int e = r / I_DN, q = r % I_DN, kb = q / 32, nb = q % 32;
                  transpose_item_tiled_fp8(args.in[I_WDN] + (size_t)e * DFF * D, D, DFF, (unsigned char*)Wdn_t + (size_t)e * D * DFF, 64 * kb, 32 * nb, 32 * nb, scr, lane); } } }
    }
    SEAM(11);
    if (IN(12)) {
        const int ntiles = tile_tab[0];
        pg8::MoeSched S; S.o.init_tiles(ntiles, D / 256, G, bid); S.A = (const char*)ACT; S.B = (const char*)Wdn_t; S.tile_e = tile_tab + 16; S.utab = (const int*)(ws + WS_ROUTE + RT_UDN); S.tstep = (size_t)256 * 1024; S.estep = (size_t)1024 * 1024;
        EpiDown E{YS, args.in[I_BDN], row_sg}; pg8::gemm_phase<EpiDown, pg8::MoeSched, true, true>(lds, 512, S, E, wv0);
    }
    SEAM(12);
    if (IN(13)) { PHASE_IDS;
        const float* gfin = args.in[I_FNG];
        for (int m = gw; m < M; m += NGW) {
            float v[16]; float s = 0.f;
#pragma unroll
            for (int hf = 0; hf < 2; ++hf) { const u32x4 w = __builtin_nontemporal_load((const u32x4*)(X2 + (size_t)m * D + 512 * hf + 8 * lane));
#pragma unroll
                for (int q = 0; q < 4; ++q) { v[8 * hf + 2 * q] = bflo(w[q]); v[8 * hf + 2 * q + 1] = bfhi(w[q]); }
#pragma unroll
                for (int k = 0; k < 4; ++k) { const u32x2 y = __builtin_nontemporal_load((const u32x2*)((const unsigned char*)YS + (size_t)(m * 4 + k) * D + 512 * hf + 8 * lane));
#pragma unroll
                    for (int q = 0; q < 2; ++q) { const auto lo2 = __builtin_amdgcn_cvt_pk_f32_fp8((int)y[q], false), hi2 = __builtin_amdgcn_cvt_pk_f32_fp8((int)y[q], true);
                        v[8 * hf + 4 * q] += lo2[0] * 0.0625f; v[8 * hf + 4 * q + 1] += lo2[1] * 0.0625f; v[8 * hf + 4 * q + 2] += hi2[0] * 0.0625f; v[8 * hf + 4 * q + 3] += hi2[1] * 0.0625f; } } }
#pragma unroll
            for (int j = 0; j < 16; ++j) s += v[j] * v[j];
            const float rstd = rsq_f(wave_sum(s) * (1.f / D) + EPS);
#pragma unroll
            for (int hf = 0; hf < 2; ++hf) { const f32x4 g0 = *(const f32x4*)(gfin + 512 * hf + 8 * lane), g1 = *(const f32x4*)(gfin + 512 * hf + 8 * lane + 4);
                float* o = args.out + (size_t)m * D + 512 * hf + 8 * lane;
                __builtin_nontemporal_store((f32x4){v[8 * hf] * rstd * g0.x, v[8 * hf + 1] * rstd * g0.y, v[8 * hf + 2] * rstd * g0.z, v[8 * hf + 3] * rstd * g0.w}, (f32x4*)o);
                __builtin_nontemporal_store((f32x4){v[8 * hf + 4] * rstd * g1.x, v[8 * hf + 5] * rstd * g1.y, v[8 * hf + 6] * rstd * g1.z, v[8 * hf + 7] * rstd * g1.w}, (f32x4*)(o + 4)); }
        }
    }
#undef IN
#undef SEAM
}

constexpr int N_PHASES = 14;
extern "C" void kernel_launch(void* const* d_in, const int* in_sizes, int n_in, void* d_out, int out_size, void* d_ws, size_t ws_size, hipStream_t stream) {
    static int grid = 0;
    if (grid == 0) {
        if (n_in != 37 || out_size != M * D || ws_size < WS_END) { fprintf(stderr, "kernel_launch: unexpected shapes (n_in %d, out %d, ws %zu); nothing launched\n", n_in, out_size, ws_size); grid = -1; return; }
        int dev = 0, cus = 0, per_cu = 0;
        if (hipGetDevice(&dev) != hipSuccess || hipDeviceGetAttribute(&cus, hipDeviceAttributeMultiprocessorCount, dev) != hipSuccess) { grid = -1; return; }
        if (hipFuncSetAttribute((const void*)fwd, hipFuncAttributeMaxDynamicSharedMemorySize, LDS_BYTES) != hipSuccess) { fprintf(stderr, "kernel_launch: hipFuncSetAttribute failed\n"); grid = -1; return; }
        if (hipOccupancyMaxActiveBlocksPerMultiprocessor(&per_cu, (const void*)fwd, NTHREADS, LDS_BYTES) != hipSuccess || per_cu < 1) fprintf(stderr, "kernel_launch: occupancy query says %d\n", per_cu);
        (void)hipGetLastError();
        grid = cus > 256 ? 256 : cus;
    }
    if (grid < 0) return;
    if (hipMemsetAsync((char*)d_ws + WS_CTL, 0, CTL_ZERO_BYTES, stream) != hipSuccess) return;
    Args a{};
    for (int i = 0; i < 37; ++i) a.in[i] = (const float*)d_in[i];
    a.out = (float*)d_out; a.ws = (unsigned char*)d_ws;
#if MK_ONE_LAUNCH
    a.ph_lo = 0; a.ph_hi = N_PHASES;
    hipLaunchKernelGGL(fwd, dim3(grid), dim3(NTHREADS), LDS_BYTES, stream, a);
#else
    for (int p = 0; p < N_PHASES; ++p) { a.ph_lo = p; a.ph_hi = p + 1; hipLaunchKernelGGL(fwd, dim3(grid), dim3(NTHREADS), LDS_BYTES, stream, a);
#ifdef PROBE_REPEAT_PHASE
        if (p == PROBE_REPEAT_PHASE) hipLaunchKernelGGL(fwd, dim3(grid), dim3(NTHREADS), LDS_BYTES, stream, a);
#endif
    }
#endif
}
```
